# Optimizing an MI355X kernel written in HIP

```python
import math
import jax, jax.numpy as jnp
from jax import lax
import numpy as np

D_MODEL = 2048
BATCH = 4
SEQ = 4096
DEPTH = 2

CTX_LEN = 256
GRID_W = 64
N_BRANCH = 4
BRANCH_W = 512
SHORT_K = 3
EPS = 1e-6

HY_ORDER = 2
HY_EMB = 33
HY_BANDS = (HY_EMB - 1) // 2
HY_FFN = 64
HY_FILTERS = HY_ORDER * 2 * BRANCH_W
HY_DECAY_MIN = -math.log(1e-2) / 1.5
HY_DECAY_MAX = -math.log(1e-2) / 0.3

ML_HEADS = 4
ML_HD = BRANCH_W // ML_HEADS
ML_CHUNK = 64

S5_GROUP = 16
S5_GROUPS = BRANCH_W // S5_GROUP
S5_STATE = 64

SSD_HD = 64
SSD_HEADS = BRANCH_W // SSD_HD
SSD_GROUPS = 2
SSD_STATE = 128
SSD_CHUNK = 128
SSD_XBC = BRANCH_W + 2 * SSD_GROUPS * SSD_STATE

N_EXPERTS = 16
EC_CAPACITY = 2
D_EXPERT = 1536

HY_OFF = 0
ML_OFF = HY_OFF + 3 * BRANCH_W
S5_OFF = ML_OFF + 4 * BRANCH_W + 4 * ML_HEADS
SSD_OFF = S5_OFF + BRANCH_W
GATE_OFF = SSD_OFF + BRANCH_W + SSD_XBC + 2 * SSD_HEADS
IN_WIDTH = GATE_OFF + N_BRANCH * D_MODEL

kernel_name = "hybrid_hyena_mlstm_s5_ssd_ecmoe_diffusion"


def f32(a):
    return a.astype(jnp.float32)


def rmsnorm(x, g):
    x32 = f32(x)
    y = x32 * lax.rsqrt(jnp.mean(x32 * x32, axis=-1, keepdims=True) + EPS)
    return (y * f32(g)).astype(x.dtype)


def modulate(h, shift, scale):
    return h * (1 + scale) + shift


def short_conv(u, w, b, rows):
    bsz, L, ch = u.shape
    if rows is not None:
        u = u.reshape(bsz * rows, GRID_W, ch)
    y = lax.conv_general_dilated(u, w[:, None, :].astype(u.dtype), window_strides=(1,), padding="SAME",
                                 dimension_numbers=("NWC", "WIO", "NWC"), feature_group_count=ch)
    return y.reshape(bsz, L, ch) + b.astype(u.dtype)


def hyena_filter_spectra(L, w1, b1, fr1, w2, b2, fr2, w3, decay):
    t = jnp.arange(L, dtype=jnp.float32)
    t_norm = t / (L - 1)
    freqs = jnp.linspace(1e-4, HY_BANDS - 1, HY_BANDS, dtype=jnp.float32)
    ang = (2.0 * math.pi / L) * t[:, None] * freqs[None, :]
    feats = jnp.concatenate([t_norm[:, None], jnp.cos(ang), -jnp.sin(ang)], axis=-1)
    hdn = jnp.sin(f32(fr1) * (feats @ f32(w1) + f32(b1)))
    hdn = jnp.sin(f32(fr2) * (hdn @ f32(w2) + f32(b2)))
    h = (hdn @ f32(w3)) * jnp.exp(-t_norm[:, None] * jnp.abs(f32(decay)))
    h = h.reshape(L, HY_ORDER, 2, BRANCH_W)
    h = h / jnp.sum(jnp.abs(h), axis=(0, 2), keepdims=True)
    filt = jnp.concatenate([h[:, :, 0], jnp.zeros((1, HY_ORDER, BRANCH_W), jnp.float32), h[:0:-1, :, 1]], axis=0)
    return jnp.fft.rfft(filt, axis=0)


def long_conv(z, spec, bias):
    L = z.shape[1]
    Z = jnp.fft.rfft(z, n=2 * L, axis=1)
    return jnp.fft.irfft(Z * spec[None], n=2 * L, axis=1)[:, :L] + bias * z


def hyena_branch(cols, rows, conv_w, conv_b, w1, b1, fr1, w2, b2, fr2, w3, decay, bias):
    L = cols.shape[1]
    u = f32(short_conv(cols, conv_w, conv_b, rows))
    v, x1, x2 = jnp.split(u, 3, axis=-1)
    spec = hyena_filter_spectra(L, w1, b1, fr1, w2, b2, fr2, w3, decay)
    bias = f32(bias)
    z = x1 * long_conv(v, spec[:, 0], bias[0])
    y = x2 * long_conv(z, spec[:, 1], bias[1])
    return y.astype(cols.dtype)


def mlstm_scan(q, k, v, ig, lf, state):
    bsz, L, H, d = q.shape
    nc = L // ML_CHUNK

    def chunks(a):
        a = a.reshape((bsz, nc, ML_CHUNK) + a.shape[2:])
        return jnp.moveaxis(jnp.moveaxis(a, 1, 0), 3, 2)

    tril = jnp.tril(jnp.ones((ML_CHUNK, ML_CHUNK), bool))

    def step(carry, xs):
        C, n, m = carry
        qc, kc, vc, ic, fc = xs
        b = jnp.cumsum(fc, axis=-1)
        a = b + m[..., None]
        dmat = jnp.where(tril, b[..., :, None] - b[..., None, :] + ic[..., None, :], -jnp.inf)
        mt = jnp.maximum(a, jnp.max(dmat, axis=-1))
        inter = jnp.exp(a - mt)
        s = jnp.einsum('bhtd,bhsd->bhts', qc, kc) * jnp.exp(dmat - mt[..., None])
        num = jnp.einsum('bhts,bhse->bhte', s, vc) + inter[..., None] * jnp.einsum('bhed,bhtd->bhte', C, qc)
        den = jnp.sum(s, axis=-1) + inter * jnp.einsum('bhd,bhtd->bht', n, qc)
        h = num / jnp.maximum(jnp.abs(den), jnp.exp(-mt))[..., None]
        m_new = mt[..., -1]
        ws = jnp.exp(b[..., -1:] - b + ic - m_new[..., None])
        dec = jnp.exp(b[..., -1] + m - m_new)
        C_new = dec[..., None, None] * C + jnp.einsum('bhs,bhse,bhsd->bhed', ws, vc, kc)
        n_new = dec[..., None] * n + jnp.einsum('bhs,bhsd->bhd', ws, kc)
        return (C_new, n_new, m_new), h

    state, hs = lax.scan(step, state, (chunks(q), chunks(k), chunks(v), chunks(ig), chunks(lf)))
    hs = jnp.moveaxis(jnp.moveaxis(hs, 2, 3), 0, 1).reshape(bsz, L, H, d)
    return hs, state


def mlstm_branch(cols_ctx, cols_lat, rows, with_ctx_out, conv_w, conv_b, gate_b, norm_g):
    W = BRANCH_W

    def prep(cols, rws):
        bsz, L, _ = cols.shape
        qk = f32(jax.nn.silu(short_conv(cols[..., :2 * W], conv_w, conv_b, rws)))
        heads = lambda a: f32(a).reshape(bsz, L, ML_HEADS, ML_HD)
        q = heads(qk[..., :W])
        k = heads(qk[..., W:]) * (ML_HD ** -0.5)
        v = heads(cols[..., 2 * W:3 * W])
        o = cols[..., 3 * W:4 * W]
        g = f32(cols[..., 4 * W:]).reshape(bsz, L, 4, ML_HEADS) + f32(gate_b)
        return q, k, v, o, g

    def bidir(q, k, v, g, st_f, st_b):
        flip = lambda a: a[:, ::-1]
        h_f, st_f = mlstm_scan(q, k, v, g[:, :, 0], jax.nn.log_sigmoid(g[:, :, 1]), st_f)
        h_b, st_b = mlstm_scan(flip(q), flip(k), flip(v), flip(g[:, :, 2]),
                               jax.nn.log_sigmoid(flip(g[:, :, 3])), st_b)
        return h_f + flip(h_b), st_f, st_b

    def finish(h, o):
        bsz, L = h.shape[:2]
        h = h * lax.rsqrt(jnp.mean(h * h, axis=-1, keepdims=True) + EPS)
        h = h.reshape(bsz, L, W) * f32(norm_g) * jax.nn.sigmoid(f32(o))
        return h.astype(o.dtype)

    bsz = cols_ctx.shape[0]
    zero = (jnp.zeros((bsz, ML_HEADS, ML_HD, ML_HD), jnp.float32),
            jnp.zeros((bsz, ML_HEADS, ML_HD), jnp.float32),
            jnp.zeros((bsz, ML_HEADS), jnp.float32))
    qc, kc, vc, oc, gc = prep(cols_ctx, None)
    h_ctx, st_f, st_b = bidir(qc, kc, vc, gc, zero, zero)
    ql, kl, vl, ol, gl = prep(cols_lat, rows)
    h_lat, _, _ = bidir(ql, kl, vl, gl, st_f, st_b)
    y_ctx = finish(h_ctx, oc) if with_ctx_out else None
    return y_ctx, finish(h_lat, ol)


def s5_discretise(a_re, a_im, log_dt, b_re, b_im):
    lam_re = jnp.minimum(a_re, -1e-4)
    dt = jnp.exp(log_dt)[:, None]
    mag = jnp.exp(lam_re * dt)
    ab_re, ab_im = mag * jnp.cos(a_im * dt), mag * jnp.sin(a_im * dt)
    den = lam_re * lam_re + a_im * a_im
    nr, ni = ab_re - 1.0, ab_im
    f_re = (nr * lam_re + ni * a_im) / den
    f_im = (ni * lam_re - nr * a_im) / den
    bb_re = f_re[..., None] * b_re - f_im[..., None] * b_im
    bb_im = f_re[..., None] * b_im + f_im[..., None] * b_re
    return ab_re, ab_im, bb_re, bb_im


def s5_scan(u, ab_re, ab_im, bb_re, bb_im, s0, reverse):
    L = u.shape[1]
    bu_re = jnp.einsum('blgc,gnc->blgn', u, bb_re)
    bu_im = jnp.einsum('blgc,gnc->blgn', u, bb_im)
    a_re = jnp.broadcast_to(ab_re, (1, L) + ab_re.shape)
    a_im = jnp.broadcast_to(ab_im, (1, L) + ab_im.shape)

    def combine(e1, e2):
        a1r, a1i, b1r, b1i = e1
        a2r, a2i, b2r, b2i = e2
        return (a2r * a1r - a2i * a1i, a2r * a1i + a2i * a1r,
                a2r * b1r - a2i * b1i + b2r, a2r * b1i + a2i * b1r + b2i)

    ac_re, ac_im, x_re, x_im = lax.associative_scan(combine, (a_re, a_im, bu_re, bu_im), reverse=reverse, axis=1)
    if s0 is not None:
        s_re, s_im = s0[0][:, None], s0[1][:, None]
        x_re = x_re + ac_re * s_re - ac_im * s_im
        x_im = x_im + ac_re * s_im + ac_im * s_re
    return x_re, x_im


def s5_branch(u_ctx, u_lat, with_ctx_out, a_re, a_im, log_dt, b_re, b_im, c_re, c_im, d_skip, glu_w, glu_b):
    disc = [s5_discretise(f32(a_re[d]), f32(a_im[d]), f32(log_dt[d]), f32(b_re), f32(b_im)) for d in range(2)]
    c_re, c_im = f32(c_re), f32(c_im)

    def run_states(u, inits):
        bsz, L, _ = u.shape
        ug = f32(u).reshape(bsz, L, S5_GROUPS, S5_GROUP)
        fr, fi = s5_scan(ug, *disc[0], inits[0], reverse=False)
        br, bi = s5_scan(ug, *disc[1], inits[1], reverse=True)
        finals = ((fr[:, -1], fi[:, -1]), (br[:, 0], bi[:, 0]))
        return fr + br, fi + bi, finals

    def readout(u, s_re, s_im):
        bsz, L, _ = u.shape
        y = jnp.einsum('blgn,gcn->blgc', s_re, c_re) - jnp.einsum('blgn,gcn->blgc', s_im, c_im)
        y = y.reshape(bsz, L, BRANCH_W) + f32(d_skip) * f32(u)
        g = jax.nn.gelu(y)
        return (g * jax.nn.sigmoid(g @ f32(glu_w) + f32(glu_b))).astype(u.dtype)

    sc_re, sc_im, finals = run_states(u_ctx, (None, None))
    sl_re, sl_im, _ = run_states(u_lat, finals)
    y_ctx = readout(u_ctx, sc_re, sc_im) if with_ctx_out else None
    return y_ctx, readout(u_lat, sl_re, sl_im)


def segsum(a):
    T = a.shape[-1]
    cs = jnp.cumsum(a, axis=-1)
    mask = jnp.tril(jnp.ones((T, T), bool))
    return jnp.where(mask, cs[..., :, None] - cs[..., None, :], -jnp.inf)


def ssd_scan(x, dt, A, Bm, Cm, init):
    bsz, L, H, P = x.shape
    nc, l = L // SSD_CHUNK, SSD_CHUNK
    X = (x * dt[..., None]).reshape(bsz, nc, l, H, P)
    Bc = Bm.reshape(bsz, nc, l, H, -1)
    Cc = Cm.reshape(bsz, nc, l, H, -1)
    a = jnp.moveaxis((dt * A).reshape(bsz, nc, l, H), 3, 1)
    a_cs = jnp.cumsum(a, axis=-1)
    scores = jnp.einsum('bclhn,bcshn->bhcls', Cc, Bc) * jnp.exp(segsum(a))
    y_diag = jnp.einsum('bhcls,bcshp->bclhp', scores, X)
    decay_states = jnp.moveaxis(jnp.exp(a_cs[..., -1:] - a_cs), 1, 3)
    states = jnp.einsum('bclhn,bclhp->bchpn', Bc * decay_states[..., None], X)
    states = jnp.concatenate([init[:, None], states], axis=1)
    chunk_decay = jnp.exp(segsum(jnp.pad(a_cs[..., -1], ((0, 0), (0, 0), (1, 0)))))
    states = jnp.einsum('bhzc,bchpn->bzhpn', chunk_decay, states)
    y_off = jnp.einsum('bclhn,bchpn->bclhp', Cc, states[:, :-1]) * jnp.moveaxis(jnp.exp(a_cs), 1, 3)[..., None]
    return (y_diag + y_off).reshape(bsz, L, H, P), states[:, -1]


def ssd_branch(cols_ctx, cols_lat, rows, with_ctx_out, conv_w, conv_b, dt_bias, a_log, d_skip, norm_g):
    W = BRANCH_W
    GN = SSD_GROUPS * SSD_STATE
    rep = SSD_HEADS // SSD_GROUPS
    A = -jnp.exp(f32(a_log))

    def prep(cols, rws):
        bsz, L, _ = cols.shape
        xbc = f32(jax.nn.silu(short_conv(cols[..., W:W + SSD_XBC], conv_w, conv_b, rws)))
        x = xbc[..., :W].reshape(bsz, L, SSD_HEADS, SSD_HD)
        Bm = jnp.repeat(xbc[..., W:W + GN].reshape(bsz, L, SSD_GROUPS, SSD_STATE), rep, axis=2)
        Cm = jnp.repeat(xbc[..., W + GN:].reshape(bsz, L, SSD_GROUPS, SSD_STATE), rep, axis=2)
        dt = jax.nn.softplus(f32(cols[..., W + SSD_XBC:]).reshape(bsz, L, 2, SSD_HEADS) + f32(dt_bias))
        return x, Bm, Cm, dt

    def bidir(x, Bm, Cm, dt, s_f, s_b):
        flip = lambda a: a[:, ::-1]
        y_f, s_f = ssd_scan(x, dt[:, :, 0], A[0], Bm, Cm, s_f)
        y_b, s_b = ssd_scan(flip(x), flip(dt[:, :, 1]), A[1], flip(Bm), flip(Cm), s_b)
        return y_f + flip(y_b) + f32(d_skip)[:, None] * x, s_f, s_b

    def finish(y, cols):
        bsz, L = y.shape[:2]
        z = f32(cols[..., :W])
        return rmsnorm(y.reshape(bsz, L, W) * jax.nn.silu(z), norm_g).astype(cols.dtype)

    bsz = cols_ctx.shape[0]
    zero = jnp.zeros((bsz, SSD_HEADS, SSD_HD, SSD_STATE), jnp.float32)
    xc, Bc, Cc, dtc = prep(cols_ctx, None)
    y_ctx, s_f, s_b = bidir(xc, Bc, Cc, dtc, zero, zero)
    xl, Bl, Cl, dtl = prep(cols_lat, rows)
    y_lat, _, _ = bidir(xl, Bl, Cl, dtl, s_f, s_b)
    out_ctx = finish(y_ctx, cols_ctx) if with_ctx_out else None
    return out_ctx, finish(y_lat, cols_lat)


def token_mixers(h_ctx, h_lat, rows, with_ctx_out, w_in, hy_p, ml_p, s5_p, ssd_p, w_branch, w_out):
    p_ctx = h_ctx @ w_in
    p_lat = h_lat @ w_in
    hy_lat = hyena_branch(p_lat[..., HY_OFF:ML_OFF], rows, *hy_p)
    hy_ctx = hyena_branch(p_ctx[..., HY_OFF:ML_OFF], None, *hy_p) if with_ctx_out else None
    ml_ctx, ml_lat = mlstm_branch(p_ctx[..., ML_OFF:S5_OFF], p_lat[..., ML_OFF:S5_OFF], rows, with_ctx_out, *ml_p)
    s5_ctx, s5_lat = s5_branch(p_ctx[..., S5_OFF:SSD_OFF], p_lat[..., S5_OFF:SSD_OFF], with_ctx_out, *s5_p)
    ssd_ctx, ssd_lat = ssd_branch(p_ctx[..., SSD_OFF:GATE_OFF], p_lat[..., SSD_OFF:GATE_OFF], rows, with_ctx_out, *ssd_p)

    def merge(p, branches):
        acc = None
        for k, y in enumerate(branches):
            g = jax.nn.sigmoid(p[..., GATE_OFF + k * D_MODEL:GATE_OFF + (k + 1) * D_MODEL])
            term = g * (y @ w_branch[k])
            acc = term if acc is None else acc + term
        return acc @ w_out

    y_lat = merge(p_lat, (hy_lat, ml_lat, s5_lat, ssd_lat))
    y_ctx = merge(p_ctx, (hy_ctx, ml_ctx, s5_ctx, ssd_ctx)) if with_ctx_out else None
    return y_ctx, y_lat


def ec_moe(h, w_router, w_gate, w_up, w_down):
    bsz, n, _ = h.shape
    cap = EC_CAPACITY * n // N_EXPERTS
    probs = jax.nn.softmax(f32(h @ w_router), axis=-1)
    gate, idx = lax.top_k(jnp.swapaxes(probs, 1, 2), cap)
    bidx = jnp.arange(bsz)[:, None, None]
    xs = h[bidx, idx]
    hid = jax.nn.silu(jnp.einsum('becd,edf->becf', xs, w_gate)) * jnp.einsum('becd,edf->becf', xs, w_up)
    y = jnp.einsum('becf,efd->becd', hid, w_down) * gate[..., None].astype(h.dtype)
    return jnp.zeros_like(h).at[bidx, idx].add(y)


def setup_inputs(seed: int = 0) -> dict:
    key = jax.random.key(seed)
    ks = iter(jax.random.split(key, 64))

    def nrm(shape, scale):
        return scale * jax.random.normal(next(ks), shape, jnp.float32)

    def unif(shape, lo, hi):
        return jax.random.uniform(next(ks), shape, jnp.float32, lo, hi)

    D, W, Lr = D_MODEL, BRANCH_W, DEPTH
    inp = {}
    inp["x"] = nrm((BATCH, SEQ, D), 1.0)
    inp["c"] = nrm((BATCH, D), 1.0)
    inp["ctx"] = nrm((BATCH, CTX_LEN, D), 1.0)
    inp["c_ctx"] = nrm((D,), 1.0)
    inp["ada_w"] = nrm((Lr, D, 6 * D), 0.5 * D ** -0.5)
    inp["ada_b"] = nrm((Lr, 6 * D), 0.01)
    inp["norm_mix"] = 1.0 + nrm((Lr, D), 0.05)
    inp["norm_ffn"] = 1.0 + nrm((Lr, D), 0.05)
    inp["w_in"] = nrm((Lr, D, IN_WIDTH), D ** -0.5)
    inp["hy_conv_w"] = nrm((Lr, SHORT_K, 3 * W), SHORT_K ** -0.5)
    inp["hy_conv_b"] = nrm((Lr, 3 * W), 0.02)
    inp["hy_w1"] = nrm((Lr, HY_EMB, HY_FFN), HY_EMB ** -0.5)
    inp["hy_b1"] = nrm((Lr, HY_FFN), 0.1)
    inp["hy_fr1"] = 1.0 + nrm((Lr, HY_FFN), 0.01)
    inp["hy_w2"] = nrm((Lr, HY_FFN, HY_FFN), HY_FFN ** -0.5)
    inp["hy_b2"] = nrm((Lr, HY_FFN), 0.1)
    inp["hy_fr2"] = 1.0 + nrm((Lr, HY_FFN), 0.01)
    inp["hy_w3"] = nrm((Lr, HY_FFN, HY_FILTERS), HY_FFN ** -0.5)
    inp["hy_decay"] = jnp.tile(jnp.linspace(HY_DECAY_MIN, HY_DECAY_MAX, W, dtype=jnp.float32), HY_ORDER * 2)[None] + nrm((Lr, HY_FILTERS), 0.1)
    inp["hy_bias"] = nrm((Lr, HY_ORDER, W), 0.5)
    inp["ml_conv_w"] = nrm((Lr, SHORT_K, 2 * W), SHORT_K ** -0.5)
    inp["ml_conv_b"] = nrm((Lr, 2 * W), 0.02)
    fb = jnp.linspace(3.0, 6.0, ML_HEADS, dtype=jnp.float32)
    zb = jnp.zeros((ML_HEADS,), jnp.float32)
    inp["ml_gate_b"] = jnp.stack([zb, fb, zb, fb])[None] + nrm((Lr, 4, ML_HEADS), 0.1)
    inp["ml_norm"] = 1.0 + nrm((Lr, W), 0.05)
    inp["s5_a_re"] = -0.5 + nrm((Lr, 2, S5_GROUPS, S5_STATE), 0.01)
    inp["s5_a_im"] = math.pi * jnp.arange(S5_STATE, dtype=jnp.float32) + nrm((Lr, 2, S5_GROUPS, S5_STATE), 0.01)
    inp["s5_log_dt"] = unif((Lr, 2, S5_GROUPS), math.log(1e-3), math.log(1e-1))
    inp["s5_b_re"] = nrm((Lr, S5_GROUPS, S5_STATE, S5_GROUP), (2 * S5_GROUP) ** -0.5)
    inp["s5_b_im"] = nrm((Lr, S5_GROUPS, S5_STATE, S5_GROUP), (2 * S5_GROUP) ** -0.5)
    inp["s5_c_re"] = nrm((Lr, S5_GROUPS, S5_GROUP, S5_STATE), (2 * S5_STATE) ** -0.5)
    inp["s5_c_im"] = nrm((Lr, S5_GROUPS, S5_GROUP, S5_STATE), (2 * S5_STATE) ** -0.5)
    inp["s5_d"] = nrm((Lr, W), 0.5)
    inp["s5_glu_w"] = nrm((Lr, W, W), W ** -0.5)
    inp["s5_glu_b"] = nrm((Lr, W), 0.01)
    inp["ssd_conv_w"] = nrm((Lr, SHORT_K, SSD_XBC), SHORT_K ** -0.5)
    inp["ssd_conv_b"] = nrm((Lr, SSD_XBC), 0.02)
    dt0 = jnp.exp(unif((Lr, 2, SSD_HEADS), math.log(1e-3), math.log(1e-1)))
    inp["ssd_dt_bias"] = dt0 + jnp.log(-jnp.expm1(-dt0))
    inp["ssd_a_log"] = jnp.log(unif((Lr, 2, SSD_HEADS), 1.0, 16.0))
    inp["ssd_d"] = 1.0 + nrm((Lr, SSD_HEADS), 0.1)
    inp["ssd_norm"] = 1.0 + nrm((Lr, W), 0.05)
    inp["w_branch"] = nrm((Lr, N_BRANCH, W, D), W ** -0.5)
    inp["w_out"] = nrm((Lr, D, D), D ** -0.5)
    inp["w_router"] = nrm((Lr, D, N_EXPERTS), D ** -0.5)
    inp["w_gate"] = nrm((Lr, N_EXPERTS, D, D_EXPERT), D ** -0.5)
    inp["w_up"] = nrm((Lr, N_EXPERTS, D, D_EXPERT), D ** -0.5)
    inp["w_down"] = nrm((Lr, N_EXPERTS, D_EXPERT, D), D_EXPERT ** -0.5)
    inp["final_norm"] = 1.0 + nrm((D,), 0.05)
    return inp


def reference(x, c, ctx, c_ctx, ada_w, ada_b, norm_mix, norm_ffn, w_in,
              hy_conv_w, hy_conv_b, hy_w1, hy_b1, hy_fr1, hy_w2, hy_b2, hy_fr2, hy_w3, hy_decay, hy_bias,
              ml_conv_w, ml_conv_b, ml_gate_b, ml_norm,
              s5_a_re, s5_a_im, s5_log_dt, s5_b_re, s5_b_im, s5_c_re, s5_c_im, s5_d, s5_glu_w, s5_glu_b,
              ssd_conv_w, ssd_conv_b, ssd_dt_bias, ssd_a_log, ssd_d, ssd_norm,
              w_branch, w_out, w_router, w_gate, w_up, w_down, final_norm):
    rows = x.shape[1] // GRID_W
    for i in range(DEPTH):
        last = i == DEPTH - 1
        m_lat = (jax.nn.silu(c) @ ada_w[i] + ada_b[i]).reshape(c.shape[0], 6, 1, D_MODEL)
        m_ctx = (jax.nn.silu(c_ctx) @ ada_w[i] + ada_b[i]).reshape(6, 1, 1, D_MODEL)
        hy_p = (hy_conv_w[i], hy_conv_b[i], hy_w1[i], hy_b1[i], hy_fr1[i], hy_w2[i], hy_b2[i], hy_fr2[i],
                hy_w3[i], hy_decay[i], hy_bias[i])
        ml_p = (ml_conv_w[i], ml_conv_b[i], ml_gate_b[i], ml_norm[i])
        s5_p = (s5_a_re[i], s5_a_im[i], s5_log_dt[i], s5_b_re[i], s5_b_im[i], s5_c_re[i], s5_c_im[i],
                s5_d[i], s5_glu_w[i], s5_glu_b[i])
        ssd_p = (ssd_conv_w[i], ssd_conv_b[i], ssd_dt_bias[i], ssd_a_log[i], ssd_d[i], ssd_norm[i])
        moe_p = (w_router[i], w_gate[i], w_up[i], w_down[i])

        h_lat = modulate(rmsnorm(x, norm_mix[i]), m_lat[:, 0], m_lat[:, 1])
        h_ctx = modulate(rmsnorm(ctx, norm_mix[i]), m_ctx[0], m_ctx[1])
        y_ctx, y_lat = token_mixers(h_ctx, h_lat, rows, not last, w_in[i], hy_p, ml_p, s5_p, ssd_p,
                                    w_branch[i], w_out[i])
        x = x + m_lat[:, 2] * y_lat
        x = x + m_lat[:, 5] * ec_moe(modulate(rmsnorm(x, norm_ffn[i]), m_lat[:, 3], m_lat[:, 4]), *moe_p)
        if not last:
            ctx = ctx + m_ctx[2] * y_ctx
            ctx = ctx + m_ctx[5] * ec_moe(modulate(rmsnorm(ctx, norm_ffn[i]), m_ctx[3], m_ctx[4]), *moe_p)
    return rmsnorm(x, final_norm)
```

```cpp
#include <hip/hip_runtime.h>
#include <stdint.h>
#include <stdio.h>

#define DM 2048
#define NB 4
#define SEQ 4096
#define CTXL 256
#define BW 512
#define NLAT 16384
#define NCTX 1024
#define NTOK 17408
#define IN_W 13856
#define HY_OFF 0
#define ML_OFF 1536
#define S5_OFF 3600
#define SSD_OFF 4112
#define GATE_OFF 5664
#define NEXP 16
#define DEXP 1536
#define MOE_ROWS 2176

typedef short bf16x8 __attribute__((ext_vector_type(8)));
typedef float f32x4 __attribute__((ext_vector_type(4)));

__device__ __forceinline__ unsigned short f2bf(float f) { unsigned u = __float_as_uint(f); u += 0x7FFFu + ((u >> 16) & 1u); return (unsigned short)(u >> 16); }
__device__ __forceinline__ float sigmoidf_(float x) { return 1.0f / (1.0f + expf(-x)); }
__device__ __forceinline__ float siluf_(float x) { return x / (1.0f + expf(-x)); }

__device__ __forceinline__ float wave_sum(float v) {
#pragma unroll
    for (int o = 32; o >= 1; o >>= 1) v += __shfl_xor(v, o);
    return v;
}
__device__ __forceinline__ float block_sum256(float v, float* red) {
    v = wave_sum(v);
    const int lane = threadIdx.x & 63, w = threadIdx.x >> 6;
    __syncthreads();
    if (lane == 0) red[w] = v;
    __syncthreads();
    return red[0] + red[1] + red[2] + red[3];
}

__device__ __forceinline__ int step_tok(int b, int dir, int i) {
    if (i < CTXL) { const int tt = dir ? (CTXL - 1 - i) : i; return NLAT + b * CTXL + tt; }
    const int j = i - CTXL; const int tt = dir ? (SEQ - 1 - j) : j; return b * SEQ + tt;
}

__global__ __launch_bounds__(256) void k_mod(const float* __restrict__ c, const float* __restrict__ c_ctx, const float* __restrict__ ada_w,
                                             const float* __restrict__ ada_b, float* __restrict__ MOD) {
    __shared__ float s[5][DM];
    const int l = blockIdx.y; const int j = blockIdx.x * 256 + threadIdx.x;
    for (int i = threadIdx.x; i < 5 * DM; i += 256) { const int r = i / DM, k = i % DM; const float v = r < 4 ? c[r * DM + k] : c_ctx[k]; s[r][k] = siluf_(v); }
    __syncthreads();
    const float* w = ada_w + (size_t)l * DM * (6 * DM) + j;
    float a0 = 0.f, a1 = 0.f, a2 = 0.f, a3 = 0.f, a4 = 0.f;
    for (int k = 0; k < DM; ++k) { const float wv = w[(size_t)k * (6 * DM)]; a0 += s[0][k] * wv; a1 += s[1][k] * wv; a2 += s[2][k] * wv; a3 += s[3][k] * wv; a4 += s[4][k] * wv; }
    const float bb = ada_b[l * 6 * DM + j];
    float* o = MOD + (size_t)l * 5 * 6 * DM + j;
    o[0 * 6 * DM] = a0 + bb; o[1 * 6 * DM] = a1 + bb; o[2 * 6 * DM] = a2 + bb; o[3 * 6 * DM] = a3 + bb; o[4 * 6 * DM] = a4 + bb;
}

__global__ __launch_bounds__(256) void k_norm_mod(const float* __restrict__ X, const float* __restrict__ gain, const float* __restrict__ MODl, int shiftIdx, int scaleIdx,
                                                  float* __restrict__ H) {
    __shared__ float red[4];
    const int tok = blockIdx.x; const int r = tok < NLAT ? tok / SEQ : 4;
    const float* x = X + (size_t)tok * DM;
    float v[8]; float ss = 0.f;
#pragma unroll
    for (int i = 0; i < 8; ++i) { v[i] = x[threadIdx.x + i * 256]; ss += v[i] * v[i]; }
    ss = block_sum256(ss, red);
    const float rs = rsqrtf(ss * (1.0f / DM) + 1e-6f);
    const float* sh = MODl + (size_t)(r * 6 + shiftIdx) * DM; const float* sc = MODl + (size_t)(r * 6 + scaleIdx) * DM;
#pragma unroll
    for (int i = 0; i < 8; ++i) { const int d = threadIdx.x + i * 256; H[(size_t)tok * DM + d] = v[i] * rs * gain[d] * (1.0f + sc[d]) + sh[d]; }
}

__global__ __launch_bounds__(256) void k_final_norm(const float* __restrict__ X, const float* __restrict__ gain, float* __restrict__ out) {
    __shared__ float red[4];
    const int tok = blockIdx.x;
    const float* x = X + (size_t)tok * DM;
    float v[8]; float ss = 0.f;
#pragma unroll
    for (int i = 0; i < 8; ++i) { v[i] = x[threadIdx.x + i * 256]; ss += v[i] * v[i]; }
    ss = block_sum256(ss, red);
    const float rs = rsqrtf(ss * (1.0f / DM) + 1e-6f);
#pragma unroll
    for (int i = 0; i < 8; ++i) { const int d = threadIdx.x + i * 256; out[(size_t)tok * DM + d] = v[i] * rs * gain[d]; }
}

struct GemmP {
    const float* A; const float* B; const int* rowidx; long long strideA, strideB;
    int lda, ldb, ridxStride, M, N, K;
};
template <class Epi>
__global__ __launch_bounds__(256) void gemm_k(GemmP g, Epi epi) {
    __shared__ __attribute__((aligned(16))) unsigned short sA[128][40];
    __shared__ __attribute__((aligned(16))) unsigned short sB[128][40];
    const int tid = threadIdx.x, lane = tid & 63, wid = tid >> 6, wr = wid >> 1, wc = wid & 1;
    const int z = blockIdx.z;
    const float* A = g.A + (size_t)z * g.strideA; const float* Bm = g.B + (size_t)z * g.strideB;
    const int* ridx = g.rowidx ? g.rowidx + (size_t)z * g.ridxStride : nullptr;
    const int m0 = blockIdx.y * 128, n0 = blockIdx.x * 128;
    f32x4 acc[4][4];
#pragma unroll
    for (int i = 0; i < 4; ++i)
#pragma unroll
        for (int j = 0; j < 4; ++j) acc[i][j] = (f32x4){0.f, 0.f, 0.f, 0.f};
    const float* arow[4];
#pragma unroll
    for (int i = 0; i < 4; ++i) { const int idx = tid + i * 256; const int r = idx >> 3; int gr = m0 + r; if (gr >= g.M) gr = g.M - 1; const int src = ridx ? ridx[gr] : gr; arow[i] = A + (size_t)src * g.lda + (idx & 7) * 4; }
    for (int k0 = 0; k0 < g.K; k0 += 32) {
#pragma unroll
        for (int i = 0; i < 4; ++i) { const int idx = tid + i * 256; const int r = idx >> 3, c4 = idx & 7; const float4 v = *(const float4*)(arow[i] + k0);
            uint2 pk; pk.x = (unsigned)f2bf(v.x) | ((unsigned)f2bf(v.y) << 16); pk.y = (unsigned)f2bf(v.z) | ((unsigned)f2bf(v.w) << 16); *(uint2*)&sA[r][c4 * 4] = pk; }
#pragma unroll
        for (int i = 0; i < 4; ++i) { const int idx = tid + i * 256; const int kk = idx >> 5, n4 = idx & 31; const int gn = n0 + n4 * 4;
            float4 v = make_float4(0.f, 0.f, 0.f, 0.f); if (gn < g.N) v = *(const float4*)(Bm + (size_t)(k0 + kk) * g.ldb + gn);
            sB[n4 * 4 + 0][kk] = f2bf(v.x); sB[n4 * 4 + 1][kk] = f2bf(v.y); sB[n4 * 4 + 2][kk] = f2bf(v.z); sB[n4 * 4 + 3][kk] = f2bf(v.w); }
        __syncthreads();
        bf16x8 a[4], b[4];
#pragma unroll
        for (int i = 0; i < 4; ++i) a[i] = *(const bf16x8*)&sA[wr * 64 + i * 16 + (lane & 15)][(lane >> 4) * 8];
#pragma unroll
        for (int i = 0; i < 4; ++i) b[i] = *(const bf16x8*)&sB[wc * 64 + i * 16 + (lane & 15)][(lane >> 4) * 8];
#pragma unroll
        for (int i = 0; i < 4; ++i)
#pragma unroll
            for (int j = 0; j < 4; ++j) acc[i][j] = __builtin_amdgcn_mfma_f32_16x16x32_bf16(a[i], b[j], acc[i][j], 0, 0, 0);
        __syncthreads();
    }
#pragma unroll
    for (int i = 0; i < 4; ++i)
#pragma unroll
        for (int j = 0; j < 4; ++j)
#pragma unroll
            for (int q = 0; q < 4; ++q) { const int row = m0 + wr * 64 + i * 16 + (lane >> 4) * 4 + q; const int col = n0 + wc * 64 + j * 16 + (lane & 15);
                if (row < g.M && col < g.N) epi(z, row, col, acc[i][j][q]); }
}

struct EpiStore { float* C; long long strideC; int ldc; int pad0;
    __device__ __forceinline__ void operator()(int z, int row, int col, float v) const { C[(size_t)z * strideC + (size_t)row * ldc + col] = v; } };
struct EpiGlu { const float* GG; const float* bias; float* out;
    __device__ __forceinline__ void operator()(int, int row, int col, float v) const { const float gg = GG[(size_t)row * BW + col]; out[(size_t)row * BW + col] = gg * sigmoidf_(v + bias[col]); } };
struct EpiBranch { const float* P; float* ACC; int k; int pad0;
    __device__ __forceinline__ void operator()(int, int row, int col, float v) const { const float gt = sigmoidf_(P[(size_t)row * IN_W + GATE_OFF + k * DM + col]); float* o = ACC + (size_t)row * DM + col; const float prev = k ? *o : 0.f; *o = prev + gt * v; } };
struct EpiResid { float* XS; const float* MODl; int gidx; int pad0;
    __device__ __forceinline__ void operator()(int, int row, int col, float v) const { const int r = row < NLAT ? row / SEQ : 4; float* o = XS + (size_t)row * DM + col; *o = *o + MODl[(size_t)(r * 6 + gidx) * DM + col] * v; } };
struct EpiSiluMul { const float* G1; float* HID; long long strideC;
    __device__ __forceinline__ void operator()(int z, int row, int col, float v) const { const size_t o = (size_t)z * strideC + (size_t)row * DEXP + col; HID[o] = siluf_(G1[o]) * v; } };
struct EpiMoeDown { float* XS; const float* MODl; const int* ROWTOK; const float* ROWGATE;
    __device__ __forceinline__ void operator()(int z, int row, int col, float v) const { const int tok = ROWTOK[z * MOE_ROWS + row]; const float gt = ROWGATE[z * MOE_ROWS + row]; const int r = tok < NLAT ? tok / SEQ : 4;
        atomicAdd(XS + (size_t)tok * DM + col, MODl[(size_t)(r * 6 + 5) * DM + col] * gt * v); } };

__global__ __launch_bounds__(256) void k_conv(const float* __restrict__ P, int col0, int C, const float* __restrict__ w, const float* __restrict__ b, int do_silu, float* __restrict__ out) {
    const int tok = blockIdx.y; const int c = blockIdx.x * 256 + threadIdx.x; if (c >= C) return;
    const bool lat = tok < NLAT; const int t = lat ? (tok & (SEQ - 1)) : ((tok - NLAT) & (CTXL - 1));
    const bool hasL = lat ? ((t & 63) != 0) : (t != 0);
    const bool hasR = lat ? ((t & 63) != 63) : (t != CTXL - 1);
    const float* p = P + (size_t)tok * IN_W + col0 + c;
    float acc = b[c] + w[C + c] * p[0];
    if (hasL) acc += w[c] * p[-IN_W];
    if (hasR) acc += w[2 * C + c] * p[IN_W];
    if (do_silu) acc = siluf_(acc);
    out[(size_t)tok * C + c] = acc;
}

__global__ __launch_bounds__(256) void k_hy_filter(int L, const float* __restrict__ w1, const float* __restrict__ b1, const float* __restrict__ fr1, const float* __restrict__ w2,
                                                   const float* __restrict__ b2, const float* __restrict__ fr2, const float* __restrict__ w3, const float* __restrict__ decay, float* __restrict__ HRAW) {
    __shared__ float feats[33], h1[64], h2[64];
    const int t = blockIdx.x, tid = threadIdx.x;
    const float tn = (float)t / (float)(L - 1);
    if (tid < 33) {
        if (tid == 0) feats[0] = tn;
        else { const int j = (tid - 1) & 15; const double fr = 1e-4 + (double)j * ((15.0 - 1e-4) / 15.0); const double ang = (2.0 * 3.14159265358979323846 / (double)L) * (double)t * fr;
            feats[tid] = tid <= 16 ? (float)cos(ang) : (float)(-sin(ang)); }
    }
    __syncthreads();
    if (tid < 64) { float a = b1[tid]; for (int i = 0; i < 33; ++i) a += feats[i] * w1[i * 64 + tid]; h1[tid] = sinf(fr1[tid] * a); }
    __syncthreads();
    if (tid < 64) { float a = b2[tid]; for (int i = 0; i < 64; ++i) a += h1[i] * w2[i * 64 + tid]; h2[tid] = sinf(fr2[tid] * a); }
    __syncthreads();
    for (int k = 0; k < 8; ++k) { const int f = tid + k * 256; float a = 0.f; for (int i = 0; i < 64; ++i) a += h2[i] * w3[i * 2048 + f];
        HRAW[(size_t)t * 2048 + f] = a * expf(-tn * fabsf(decay[f])); }
}
__global__ __launch_bounds__(256) void k_hy_norm(int L, const float* __restrict__ HRAW, float* __restrict__ PART) {
    const int oc = blockIdx.x * 256 + threadIdx.x; const int o = oc >> 9, c = oc & 511; const int slice = blockIdx.y; const int per = L / 64;
    float s = 0.f;
    for (int t = slice * per; t < (slice + 1) * per; ++t) { s += fabsf(HRAW[(size_t)t * 2048 + o * 1024 + c]) + fabsf(HRAW[(size_t)t * 2048 + o * 1024 + 512 + c]); }
    PART[slice * 1024 + oc] = s;
}
__global__ __launch_bounds__(256) void k_hy_k2(int L, const float* __restrict__ HRAW, const float* __restrict__ PART, float* __restrict__ K2) {
    const int oc = blockIdx.x * 256 + threadIdx.x; const int o = oc >> 9, c = oc & 511; const int j = blockIdx.y;
    float s = 0.f; for (int i = 0; i < 64; ++i) s += PART[i * 1024 + oc];
    const int lag = j - (L - 1);
    const float v = lag >= 0 ? HRAW[(size_t)lag * 2048 + o * 1024 + c] : HRAW[(size_t)(-lag) * 2048 + o * 1024 + 512 + c];
    K2[((size_t)j * 2 + o) * 512 + c] = v / s;
}
__global__ __launch_bounds__(256) void k_hy_conv(int L, int tokbase, const float* __restrict__ zin, int zstride, const float* __restrict__ mul, int mstride, const float* __restrict__ K2, int o,
                                                 const float* __restrict__ bias, float* __restrict__ out, int ostride) {
    const int c = blockIdx.x * 256 + threadIdx.x; const int t0 = blockIdx.y * 8; const int b = blockIdx.z;
    const float* zb = zin + (size_t)(tokbase + b * L) * zstride + c;
    float acc[8];
#pragma unroll
    for (int i = 0; i < 8; ++i) acc[i] = 0.f;
    const int base = t0 + L - 1;
    for (int s = 0; s < L; s += 8) {
        float k[15];
#pragma unroll
        for (int m = 0; m < 15; ++m) k[m] = K2[((size_t)(base - s - 7 + m) * 2 + o) * 512 + c];
#pragma unroll
        for (int ds = 0; ds < 8; ++ds) { const float z = zb[(size_t)(s + ds) * zstride];
#pragma unroll
            for (int i = 0; i < 8; ++i) acc[i] += k[i - ds + 7] * z; }
    }
#pragma unroll
    for (int i = 0; i < 8; ++i) { const size_t tok = (size_t)(tokbase + b * L + t0 + i); const float zt = zin[tok * zstride + c];
        out[tok * ostride + c] = (acc[i] + bias[c] * zt) * mul[tok * mstride + c]; }
}

__global__ __launch_bounds__(256) void k_mlstm_scan(const float* __restrict__ P, const float* __restrict__ QKC, const float* __restrict__ gate_b, float* __restrict__ HF, float* __restrict__ HB) {
    const int blk = blockIdx.x; const int dir = blk & 1, h = (blk >> 1) & 3, b = blk >> 3;
    __shared__ float sq[2][128], sk[2][128], sv[2][128], sg[2][2];
    const int tid = threadIdx.x, e = tid >> 1, dh = tid & 1;
    float C[64], nn[64];
#pragma unroll
    for (int d = 0; d < 64; ++d) { C[d] = 0.f; nn[d] = 0.f; }
    float m = 0.f;
    float* Hout = dir ? HB : HF;
    const float gbi = gate_b[(dir * 2 + 0) * 4 + h], gbf = gate_b[(dir * 2 + 1) * 4 + h];
    const int total = CTXL + SEQ;
    float r0 = 0.f, r1 = 0.f;
    {   const size_t tok = (size_t)step_tok(b, dir, 0);
        if (tid < 128) { r0 = QKC[tok * 1024 + h * 128 + tid]; r1 = P[tok * IN_W + ML_OFF + 1024 + h * 128 + tid]; }
        else { r0 = QKC[tok * 1024 + 512 + h * 128 + (tid - 128)] * 0.08838834764831845f; if (tid == 128) r1 = P[tok * IN_W + ML_OFF + 2048 + (dir * 2 + 0) * 4 + h] + gbi; if (tid == 129) r1 = P[tok * IN_W + ML_OFF + 2048 + (dir * 2 + 1) * 4 + h] + gbf; }
        if (tid < 128) { sq[0][tid] = r0; sv[0][tid] = r1; } else { sk[0][tid - 128] = r0; if (tid == 128) sg[0][0] = r1; if (tid == 129) sg[0][1] = r1; }
    }
    __syncthreads();
    for (int i = 0; i < total; ++i) {
        const int cur = i & 1;
        const size_t tokc = (size_t)step_tok(b, dir, i);
        if (i + 1 < total) { const size_t tok = (size_t)step_tok(b, dir, i + 1);
            if (tid < 128) { r0 = QKC[tok * 1024 + h * 128 + tid]; r1 = P[tok * IN_W + ML_OFF + 1024 + h * 128 + tid]; }
            else { r0 = QKC[tok * 1024 + 512 + h * 128 + (tid - 128)] * 0.08838834764831845f; if (tid == 128) r1 = P[tok * IN_W + ML_OFF + 2048 + (dir * 2 + 0) * 4 + h] + gbi; if (tid == 129) r1 = P[tok * IN_W + ML_OFF + 2048 + (dir * 2 + 1) * 4 + h] + gbf; } }
        const float ig = sg[cur][0], fg = sg[cur][1];
        const float lf = fminf(fg, 0.f) - log1pf(expf(-fabsf(fg)));
        const float mn = fmaxf(lf + m, ig); const float fp = expf(lf + m - mn), ip = expf(ig - mn); m = mn;
        const float ve = sv[cur][e] * ip;
        float num = 0.f, den = 0.f;
#pragma unroll
        for (int d = 0; d < 64; ++d) { const float kd = sk[cur][d * 2 + dh], qd = sq[cur][d * 2 + dh];
            C[d] = fp * C[d] + ve * kd; nn[d] = fp * nn[d] + ip * kd; num += C[d] * qd; den += nn[d] * qd; }
        num += __shfl_xor(num, 1); den += __shfl_xor(den, 1);
        const float hv = num / fmaxf(fabsf(den), expf(-m));
        if (dh == 0) Hout[tokc * BW + h * 128 + e] = hv;
        if (i + 1 < total) { const int nb = cur ^ 1;
            if (tid < 128) { sq[nb][tid] = r0; sv[nb][tid] = r1; } else { sk[nb][tid - 128] = r0; if (tid == 128) sg[nb][0] = r1; if (tid == 129) sg[nb][1] = r1; } }
        __syncthreads();
    }
}
__global__ __launch_bounds__(256) void k_mlstm_finish(const float* __restrict__ P, const float* __restrict__ HF, const float* __restrict__ HB, const float* __restrict__ norm_g, float* __restrict__ Y) {
    const int tok = blockIdx.x; const int c0 = threadIdx.x * 2;
    const float h0 = HF[(size_t)tok * BW + c0] + HB[(size_t)tok * BW + c0], h1 = HF[(size_t)tok * BW + c0 + 1] + HB[(size_t)tok * BW + c0 + 1];
    const float ss = wave_sum(h0 * h0 + h1 * h1);
    const float rs = rsqrtf(ss * (1.0f / 128.0f) + 1e-6f);
    const float o0 = P[(size_t)tok * IN_W + ML_OFF + 1536 + c0], o1 = P[(size_t)tok * IN_W + ML_OFF + 1536 + c0 + 1];
    Y[(size_t)tok * BW + c0] = h0 * rs * norm_g[c0] * sigmoidf_(o0);
    Y[(size_t)tok * BW + c0 + 1] = h1 * rs * norm_g[c0 + 1] * sigmoidf_(o1);
}

__global__ __launch_bounds__(64) void k_s5_scan(const float* __restrict__ P, const float* __restrict__ a_re, const float* __restrict__ a_im, const float* __restrict__ log_dt,
                                                const float* __restrict__ b_re, const float* __restrict__ b_im, float* __restrict__ SST) {
    const int blk = blockIdx.x; const int g = blk & 31, b = blk >> 5; const int n = threadIdx.x;
    for (int dir = 0; dir < 2; ++dir) {
        float abr, abi, bbr[16], bbi[16];
        {   const double are = (double)a_re[(dir * 32 + g) * 64 + n], aim = (double)a_im[(dir * 32 + g) * 64 + n];
            const double lam = are < -1e-4 ? are : -1e-4; const double dt = exp((double)log_dt[dir * 32 + g]);
            const double mag = exp(lam * dt); const double ar = mag * cos(aim * dt), ai = mag * sin(aim * dt);
            const double den = lam * lam + aim * aim; const double nr = ar - 1.0, ni = ai;
            const double fre = (nr * lam + ni * aim) / den, fim = (ni * lam - nr * aim) / den;
            abr = (float)ar; abi = (float)ai;
#pragma unroll
            for (int c = 0; c < 16; ++c) { const double br = (double)b_re[(g * 64 + n) * 16 + c], bi = (double)b_im[(g * 64 + n) * 16 + c]; bbr[c] = (float)(fre * br - fim * bi); bbi[c] = (float)(fre * bi + fim * br); }
        }
        float xr = 0.f, xi = 0.f;
#pragma unroll 4
        for (int i = 0; i < CTXL + SEQ; ++i) {
            const size_t tok = (size_t)step_tok(b, dir, i);
            const float4* up = (const float4*)(P + tok * IN_W + S5_OFF + g * 16);
            const float4 u0 = up[0], u1 = up[1], u2 = up[2], u3 = up[3];
            const float u[16] = {u0.x, u0.y, u0.z, u0.w, u1.x, u1.y, u1.z, u1.w, u2.x, u2.y, u2.z, u2.w, u3.x, u3.y, u3.z, u3.w};
            float bur = 0.f, bui = 0.f;
#pragma unroll
            for (int c = 0; c < 16; ++c) { bur += u[c] * bbr[c]; bui += u[c] * bbi[c]; }
            const float nxr = abr * xr - abi * xi + bur, nxi = abr * xi + abi * xr + bui; xr = nxr; xi = nxi;
            float2* dst = (float2*)SST + (tok * 32 + g) * 64 + n;
            if (dir == 0) *dst = make_float2(xr, xi); else { float2 v = *dst; v.x += xr; v.y += xi; *dst = v; }
        }
    }
}
__global__ __launch_bounds__(256) void k_s5_readout(const float* __restrict__ P, const float* __restrict__ SST, const float* __restrict__ c_re, const float* __restrict__ c_im,
                                                    const float* __restrict__ d_skip, float* __restrict__ GG) {
    const size_t idx = (size_t)blockIdx.x * 256 + threadIdx.x; const size_t tok = idx >> 9; const int ch = (int)(idx & 511); const int g = ch >> 4;
    const float2* s = (const float2*)SST + (tok * 32 + g) * 64; const float* cr = c_re + (size_t)ch * 64; const float* ci = c_im + (size_t)ch * 64;
    float y = 0.f;
    for (int n = 0; n < 64; ++n) { const float2 sv = s[n]; y += sv.x * cr[n] - sv.y * ci[n]; }
    y += d_skip[ch] * P[tok * IN_W + S5_OFF + ch];
    const float gl = 0.5f * y * (1.0f + tanhf(0.7978845608028654f * (y + 0.044715f * y * y * y)));
    GG[tok * BW + ch] = gl;
}

__global__ __launch_bounds__(256) void k_ssd_scan(const float* __restrict__ P, const float* __restrict__ XBC, const float* __restrict__ dt_bias, const float* __restrict__ a_log,
                                                  float* __restrict__ YF, float* __restrict__ YB) {
    const int blk = blockIdx.x; const int dir = blk & 1, h = (blk >> 1) & 7, b = blk >> 4;
    __shared__ float sBC[2][256], sx[2][64], sdt[2][2];
    const int tid = threadIdx.x, p = tid >> 2, nq = tid & 3;
    const float A = -expf(a_log[dir * 8 + h]); const float dtb = dt_bias[dir * 8 + h]; const int grp = h >> 2;
    float S[32];
#pragma unroll
    for (int i = 0; i < 32; ++i) S[i] = 0.f;
    float* Yout = dir ? YB : YF;
    const int total = CTXL + SEQ;
    float r0 = 0.f, r1 = 0.f;
    {   const size_t tok = (size_t)step_tok(b, dir, 0);
        r0 = tid < 128 ? XBC[tok * 1024 + 512 + grp * 128 + tid] : XBC[tok * 1024 + 768 + grp * 128 + (tid - 128)];
        if (tid < 64) r1 = XBC[tok * 1024 + h * 64 + tid];
        if (tid == 64) { const float x = P[tok * IN_W + SSD_OFF + 1536 + dir * 8 + h] + dtb; r1 = x > 20.f ? x : log1pf(expf(x)); }
        sBC[0][tid] = r0; if (tid < 64) sx[0][tid] = r1; if (tid == 64) sdt[0][0] = r1;
    }
    __syncthreads();
    for (int i = 0; i < total; ++i) {
        const int cur = i & 1;
        const size_t tokc = (size_t)step_tok(b, dir, i);
        if (i + 1 < total) { const size_t tok = (size_t)step_tok(b, dir, i + 1);
            r0 = tid < 128 ? XBC[tok * 1024 + 512 + grp * 128 + tid] : XBC[tok * 1024 + 768 + grp * 128 + (tid - 128)];
            if (tid < 64) r1 = XBC[tok * 1024 + h * 64 + tid];
            if (tid == 64) { const float x = P[tok * IN_W + SSD_OFF + 1536 + dir * 8 + h] + dtb; r1 = x > 20.f ? x : log1pf(expf(x)); } }
        const float dtv = sdt[cur][0]; const float dA = expf(dtv * A); const float xv = sx[cur][p] * dtv;
        float y = 0.f;
#pragma unroll
        for (int j = 0; j < 32; ++j) { const int n = j * 4 + nq; S[j] = dA * S[j] + xv * sBC[cur][n]; y += S[j] * sBC[cur][128 + n]; }
        y += __shfl_xor(y, 1); y += __shfl_xor(y, 2);
        if (nq == 0) Yout[tokc * BW + h * 64 + p] = y;
        if (i + 1 < total) { const int nb = cur ^ 1; sBC[nb][tid] = r0; if (tid < 64) sx[nb][tid] = r1; if (tid == 64) sdt[nb][0] = r1; }
        __syncthreads();
    }
}
__global__ __launch_bounds__(256) void k_ssd_finish(const float* __restrict__ P, const float* __restrict__ XBC, const float* __restrict__ YF, const float* __restrict__ YB,
                                                    const float* __restrict__ d_skip, const float* __restrict__ norm_g, float* __restrict__ Y) {
    __shared__ float red[4];
    const int tok = blockIdx.x; float v[2]; float ss = 0.f;
#pragma unroll
    for (int i = 0; i < 2; ++i) { const int c = threadIdx.x + i * 256; const int h = c >> 6;
        float y = YF[(size_t)tok * BW + c] + YB[(size_t)tok * BW + c] + d_skip[h] * XBC[(size_t)tok * 1024 + c];
        const float z = P[(size_t)tok * IN_W + SSD_OFF + c]; y *= siluf_(z); v[i] = y; ss += y * y; }
    ss = block_sum256(ss, red);
    const float rs = rsqrtf(ss * (1.0f / BW) + 1e-6f);
#pragma unroll
    for (int i = 0; i < 2; ++i) { const int c = threadIdx.x + i * 256; Y[(size_t)tok * BW + c] = v[i] * rs * norm_g[c]; }
}

__global__ __launch_bounds__(256) void k_router(const float* __restrict__ H2, const float* __restrict__ wr, float* __restrict__ PROBS) {
    const int tok = blockIdx.x * 4 + (threadIdx.x >> 6); const int lane = threadIdx.x & 63;
    float acc[16];
#pragma unroll
    for (int e = 0; e < 16; ++e) acc[e] = 0.f;
    for (int i = 0; i < 32; ++i) { const int d = lane + 64 * i; const float hv = H2[(size_t)tok * DM + d]; const float4* w4 = (const float4*)(wr + (size_t)d * 16);
        const float4 w0 = w4[0], w1 = w4[1], w2 = w4[2], w3 = w4[3];
        acc[0] += hv * w0.x; acc[1] += hv * w0.y; acc[2] += hv * w0.z; acc[3] += hv * w0.w; acc[4] += hv * w1.x; acc[5] += hv * w1.y; acc[6] += hv * w1.z; acc[7] += hv * w1.w;
        acc[8] += hv * w2.x; acc[9] += hv * w2.y; acc[10] += hv * w2.z; acc[11] += hv * w2.w; acc[12] += hv * w3.x; acc[13] += hv * w3.y; acc[14] += hv * w3.z; acc[15] += hv * w3.w; }
    float mx = -1e30f;
#pragma unroll
    for (int e = 0; e < 16; ++e) { acc[e] = wave_sum(acc[e]); mx = fmaxf(mx, acc[e]); }
    float s = 0.f;
#pragma unroll
    for (int e = 0; e < 16; ++e) { acc[e] = expf(acc[e] - mx); s += acc[e]; }
    const float inv = 1.0f / s;
    if (lane == 0) {
#pragma unroll
        for (int e = 0; e < 16; ++e) PROBS[(size_t)tok * 16 + e] = acc[e] * inv; }
}
__global__ __launch_bounds__(256) void k_topk(const float* __restrict__ PROBS, int* __restrict__ ROWTOK, float* __restrict__ ROWGATE) {
    const int e = blockIdx.x, b = blockIdx.y, set = blockIdx.z; const int n = set ? CTXL : SEQ; const int cap = set ? 32 : 512; const int tokbase = set ? NLAT + b * CTXL : b * SEQ;
    __shared__ float sp[SEQ];
    for (int i = threadIdx.x; i < n; i += 256) sp[i] = PROBS[(size_t)(tokbase + i) * 16 + e];
    __syncthreads();
    for (int i = threadIdx.x; i < n; i += 256) { const float pi = sp[i]; int rank = 0;
        for (int j = 0; j < n; ++j) { const float pj = sp[j]; rank += (pj > pi || (pj == pi && j < i)) ? 1 : 0; }
        if (rank < cap) { const int row = set ? 2048 + b * 32 + rank : b * 512 + rank; ROWTOK[e * MOE_ROWS + row] = tokbase + i; ROWGATE[e * MOE_ROWS + row] = pi; } }
}

template <class Epi> static void launch_gemm(const GemmP& g, const Epi& e, int nz, hipStream_t st) {
    dim3 grid((g.N + 127) / 128, (g.M + 127) / 128, nz);
    hipLaunchKernelGGL(gemm_k<Epi>, grid, dim3(256), 0, st, g, e);
}

extern "C" void kernel_launch(void* const* d_in, const int* in_sizes, int n_in, void* d_out, int out_size, void* d_ws, size_t ws_size, hipStream_t stream) {
    const float* x = (const float*)d_in[0]; const float* c = (const float*)d_in[1]; const float* ctx = (const float*)d_in[2]; const float* c_ctx = (const float*)d_in[3];
    const float* ada_w = (const float*)d_in[4]; const float* ada_b = (const float*)d_in[5]; const float* norm_mix = (const float*)d_in[6]; const float* norm_ffn = (const float*)d_in[7];
    const float* w_in = (const float*)d_in[8];
    const float* hy_conv_w = (const float*)d_in[9]; const float* hy_conv_b = (const float*)d_in[10]; const float* hy_w1 = (const float*)d_in[11]; const float* hy_b1 = (const float*)d_in[12];
    const float* hy_fr1 = (const float*)d_in[13]; const float* hy_w2 = (const float*)d_in[14]; const float* hy_b2 = (const float*)d_in[15]; const float* hy_fr2 = (const float*)d_in[16];
    const float* hy_w3 = (const float*)d_in[17]; const float* hy_decay = (const float*)d_in[18]; const float* hy_bias = (const float*)d_in[19];
    const float* ml_conv_w = (const float*)d_in[20]; const float* ml_conv_b = (const float*)d_in[21]; const float* ml_gate_b = (const float*)d_in[22]; const float* ml_norm = (const float*)d_in[23];
    const float* s5_a_re = (const float*)d_in[24]; const float* s5_a_im = (const float*)d_in[25]; const float* s5_log_dt = (const float*)d_in[26]; const float* s5_b_re = (const float*)d_in[27];
    const float* s5_b_im = (const float*)d_in[28]; const float* s5_c_re = (const float*)d_in[29]; const float* s5_c_im = (const float*)d_in[30]; const float* s5_d = (const float*)d_in[31];
    const float* s5_glu_w = (const float*)d_in[32]; const float* s5_glu_b = (const float*)d_in[33];
    const float* ssd_conv_w = (const float*)d_in[34]; const float* ssd_conv_b = (const float*)d_in[35]; const float* ssd_dt_bias = (const float*)d_in[36]; const float* ssd_a_log = (const float*)d_in[37];
    const float* ssd_d = (const float*)d_in[38]; const float* ssd_norm = (const float*)d_in[39];
    const float* w_branch = (const float*)d_in[40]; const float* w_out = (const float*)d_in[41]; const float* w_router = (const float*)d_in[42];
    const float* w_gate = (const float*)d_in[43]; const float* w_up = (const float*)d_in[44]; const float* w_down = (const float*)d_in[45]; const float* final_norm = (const float*)d_in[46];
    float* out = (float*)d_out;

    char* ws = (char*)d_ws; size_t off = 0;
    auto take = [&](size_t bytes) { char* p = ws + off; off += (bytes + 255) & ~(size_t)255; return p; };
    float* XS = (float*)take((size_t)NTOK * DM * 4);
    float* Pb = (float*)take((size_t)NTOK * IN_W * 4);
    float* Y4 = (float*)take((size_t)4 * NTOK * BW * 4);
    float* MOD = (float*)take((size_t)2 * 5 * 6 * DM * 4);
    float* PROBS = (float*)take((size_t)NTOK * 16 * 4);
    int* ROWTOK = (int*)take((size_t)NEXP * MOE_ROWS * 4);
    float* ROWGATE = (float*)take((size_t)NEXP * MOE_ROWS * 4);
    float* HPART = (float*)take((size_t)64 * 1024 * 4);
    float* K2L = (float*)take((size_t)(2 * SEQ) * 2 * 512 * 4);
    float* K2C = (float*)take((size_t)(2 * CTXL) * 2 * 512 * 4);
    char* SCR = take((size_t)330 * 1024 * 1024);
    if (off > ws_size) { fprintf(stderr, "kernel_launch: workspace too small: need %zu have %zu\n", off, ws_size); return; }
    float* H = (float*)SCR;
    float* U = (float*)SCR; float* Z = U + (size_t)NTOK * 1536; float* HRAW = Z + (size_t)NTOK * 512;
    float* QKC = (float*)SCR; float* HF = QKC + (size_t)NTOK * 1024; float* HB = HF + (size_t)NTOK * 512;
    float* SST = (float*)SCR; float* GG = SST + (size_t)NTOK * 32 * 64 * 2;
    float* XBC = (float*)SCR; float* YF = XBC + (size_t)NTOK * 1024; float* YB = YF + (size_t)NTOK * 512;
    float* ACC = (float*)SCR + (size_t)NTOK * DM;
    float* G1 = Pb; float* HID = Pb + (size_t)NEXP * MOE_ROWS * DEXP;

    (void)hipMemcpyAsync(XS, x, (size_t)NLAT * DM * 4, hipMemcpyDeviceToDevice, stream);
    (void)hipMemcpyAsync(XS + (size_t)NLAT * DM, ctx, (size_t)NCTX * DM * 4, hipMemcpyDeviceToDevice, stream);
    hipLaunchKernelGGL(k_mod, dim3(6 * DM / 256, 2), dim3(256), 0, stream, c, c_ctx, ada_w, ada_b, MOD);

    for (int l = 0; l < 2; ++l) {
        const bool last = (l == 1);
        const float* MODl = MOD + (size_t)l * 5 * 6 * DM;
        const int M2 = last ? NLAT : NTOK;
        hipLaunchKernelGGL(k_norm_mod, dim3(NTOK), dim3(256), 0, stream, XS, norm_mix + l * DM, MODl, 0, 1, H);
        { GemmP g{}; g.A = H; g.lda = DM; g.B = w_in + (size_t)l * DM * IN_W; g.ldb = IN_W; g.M = NTOK; g.N = IN_W; g.K = DM; EpiStore e{}; e.C = Pb; e.ldc = IN_W; launch_gemm(g, e, 1, stream); }
        hipLaunchKernelGGL(k_conv, dim3(6, NTOK), dim3(256), 0, stream, Pb, HY_OFF, 1536, hy_conv_w + l * 3 * 1536, hy_conv_b + l * 1536, 0, U);
        for (int set = 0; set < (last ? 1 : 2); ++set) {
            const int L = set ? CTXL : SEQ; float* K2 = set ? K2C : K2L; const int tokbase = set ? NLAT : 0;
            hipLaunchKernelGGL(k_hy_filter, dim3(L), dim3(256), 0, stream, L, hy_w1 + l * 33 * 64, hy_b1 + l * 64, hy_fr1 + l * 64, hy_w2 + l * 64 * 64, hy_b2 + l * 64, hy_fr2 + l * 64,
                               hy_w3 + l * 64 * 2048, hy_decay + l * 2048, HRAW);
            hipLaunchKernelGGL(k_hy_norm, dim3(4, 64), dim3(256), 0, stream, L, HRAW, HPART);
            hipLaunchKernelGGL(k_hy_k2, dim3(4, 2 * L - 1), dim3(256), 0, stream, L, HRAW, HPART, K2);
            hipLaunchKernelGGL(k_hy_conv, dim3(2, L / 8, NB), dim3(256), 0, stream, L, tokbase, U, 1536, U + 512, 1536, K2, 0, hy_bias + l * 1024, Z, 512);
            hipLaunchKernelGGL(k_hy_conv, dim3(2, L / 8, NB), dim3(256), 0, stream, L, tokbase, Z, 512, U + 1024, 1536, K2, 1, hy_bias + l * 1024 + 512, Y4, 512);
        }
        hipLaunchKernelGGL(k_conv, dim3(4, NTOK), dim3(256), 0, stream, Pb, ML_OFF, 1024, ml_conv_w + l * 3 * 1024, ml_conv_b + l * 1024, 1, QKC);
        hipLaunchKernelGGL(k_mlstm_scan, dim3(32), dim3(256), 0, stream, Pb, QKC, ml_gate_b + l * 16, HF, HB);
        hipLaunchKernelGGL(k_mlstm_finish, dim3(NTOK), dim3(256), 0, stream, Pb, HF, HB, ml_norm + l * BW, Y4 + (size_t)1 * NTOK * BW);
        hipLaunchKernelGGL(k_s5_scan, dim3(NB * 32), dim3(64), 0, stream, Pb, s5_a_re + l * 2 * 32 * 64, s5_a_im + l * 2 * 32 * 64, s5_log_dt + l * 64, s5_b_re + l * 32 * 64 * 16, s5_b_im + l * 32 * 64 * 16, SST);
        hipLaunchKernelGGL(k_s5_readout, dim3(NTOK * 2), dim3(256), 0, stream, Pb, SST, s5_c_re + l * 32 * 16 * 64, s5_c_im + l * 32 * 16 * 64, s5_d + l * BW, GG);
        { GemmP g{}; g.A = GG; g.lda = BW; g.B = s5_glu_w + (size_t)l * BW * BW; g.ldb = BW; g.M = NTOK; g.N = BW; g.K = BW; EpiGlu e{}; e.GG = GG; e.bias = s5_glu_b + l * BW; e.out = Y4 + (size_t)2 * NTOK * BW; launch_gemm(g, e, 1, stream); }
        hipLaunchKernelGGL(k_conv, dim3(4, NTOK), dim3(256), 0, stream, Pb, SSD_OFF + 512, 1024, ssd_conv_w + l * 3 * 1024, ssd_conv_b + l * 1024, 1, XBC);
        hipLaunchKernelGGL(k_ssd_scan, dim3(64), dim3(256), 0, stream, Pb, XBC, ssd_dt_bias + l * 16, ssd_a_log + l * 16, YF, YB);
        hipLaunchKernelGGL(k_ssd_finish, dim3(NTOK), dim3(256), 0, stream, Pb, XBC, YF, YB, ssd_d + l * 8, ssd_norm + l * BW, Y4 + (size_t)3 * NTOK * BW);
        for (int k = 0; k < 4; ++k) { GemmP g{}; g.A = Y4 + (size_t)k * NTOK * BW; g.lda = BW; g.B = w_branch + ((size_t)l * 4 + k) * BW * DM; g.ldb = DM; g.M = M2; g.N = DM; g.K = BW;
            EpiBranch e{}; e.P = Pb; e.ACC = ACC; e.k = k; launch_gemm(g, e, 1, stream); }
        { GemmP g{}; g.A = ACC; g.lda = DM; g.B = w_out + (size_t)l * DM * DM; g.ldb = DM; g.M = M2; g.N = DM; g.K = DM; EpiResid e{}; e.XS = XS; e.MODl = MODl; e.gidx = 2; launch_gemm(g, e, 1, stream); }
        hipLaunchKernelGGL(k_norm_mod, dim3(M2), dim3(256), 0, stream, XS, norm_ffn + l * DM, MODl, 3, 4, H);
        hipLaunchKernelGGL(k_router, dim3(M2 / 4), dim3(256), 0, stream, H, w_router + (size_t)l * DM * 16, PROBS);
        hipLaunchKernelGGL(k_topk, dim3(NEXP, NB, last ? 1 : 2), dim3(256), 0, stream, PROBS, ROWTOK, ROWGATE);
        const int Me = last ? 2048 : MOE_ROWS;
        { GemmP g{}; g.A = H; g.lda = DM; g.rowidx = ROWTOK; g.ridxStride = MOE_ROWS; g.B = w_gate + (size_t)l * NEXP * DM * DEXP; g.strideB = (long long)DM * DEXP; g.ldb = DEXP; g.M = Me; g.N = DEXP; g.K = DM;
            EpiStore e{}; e.C = G1; e.strideC = (long long)MOE_ROWS * DEXP; e.ldc = DEXP; launch_gemm(g, e, NEXP, stream); }
        { GemmP g{}; g.A = H; g.lda = DM; g.rowidx = ROWTOK; g.ridxStride = MOE_ROWS; g.B = w_up + (size_t)l * NEXP * DM * DEXP; g.strideB = (long long)DM * DEXP; g.ldb = DEXP; g.M = Me; g.N = DEXP; g.K = DM;
            EpiSiluMul e{}; e.G1 = G1; e.HID = HID; e.strideC = (long long)MOE_ROWS * DEXP; launch_gemm(g, e, NEXP, stream); }
        { GemmP g{}; g.A = HID; g.strideA = (long long)MOE_ROWS * DEXP; g.lda = DEXP; g.B = w_down + (size_t)l * NEXP * DEXP * DM; g.strideB = (long long)DEXP * DM; g.ldb = DM; g.M = Me; g.N = DM; g.K = DEXP;
            EpiMoeDown e{}; e.XS = XS; e.MODl = MODl; e.ROWTOK = ROWTOK; e.ROWGATE = ROWGATE; launch_gemm(g, e, NEXP, stream); }
    }
    hipLaunchKernelGGL(k_final_norm, dim3(NLAT), dim3(256), 0, stream, XS, final_norm, out);
}
```

```cpp
#include <hip/hip_runtime.h>
#include <stdint.h>
#include <stdio.h>

#ifndef MK_ONE_LAUNCH
#define MK_ONE_LAUNCH 1
#endif

#define DM 2048
#define NB 4
#define SEQ 4096
#define CTXL 256
#define BW 512
#define NLAT 16384
#define NCTX 1024
#define NTOK 17408
#define IN_W 13856
#define LDP 14080
#define HY_OFF 0
#define ML_OFF 1536
#define S5_OFF 3600
#define SSD_OFF 4112
#define GATE_OFF 5664
#define NEXP 16
#define DEXP 1536
#define MOE_ROWS 2176
#define MOE_PAD 2304
#define NTHR 512
#define LDS_BYTES 147456
#define LAS __attribute__((address_space(3)))

typedef unsigned short bf16_t;
typedef short bf16x8 __attribute__((ext_vector_type(8)));
typedef float f32x4 __attribute__((ext_vector_type(4)));
typedef unsigned u32x4 __attribute__((ext_vector_type(4)));
typedef unsigned u32x2 __attribute__((ext_vector_type(2)));

#define XB_TMO      128
#define XB_XCNT(j)  (256  + 64 * (j))
#define XB_XSUB(j)  (1280 + 64 * (j))
#define XB_XGEN(j)  (2304 + 64 * (j))
#define XB_TOP      3328
#define XB_TOPGEN   3392
#define XCD_BAR_WORDS 3456
#define XB_SPIN_CAP (1u << 18)
__device__ __forceinline__ unsigned xb_ld(unsigned* p)              { return __hip_atomic_load(p, __ATOMIC_RELAXED, __HIP_MEMORY_SCOPE_AGENT); }
__device__ __forceinline__ unsigned xb_add(unsigned* p, unsigned v) { return __hip_atomic_fetch_add(p, v, __ATOMIC_RELAXED, __HIP_MEMORY_SCOPE_AGENT); }
__device__ __forceinline__ unsigned xb_xcc_id() { return (unsigned)__builtin_amdgcn_s_getreg((3 << 11) | 20) & 0xFu; }
#define XB_SPIN(cond, bar) do { unsigned _sp = 0; while (cond) { __builtin_amdgcn_s_sleep(1); \
    if ((++_sp & 255u) == 0u) { if (xb_ld(&(bar)[XB_TMO])) break; if (_sp > XB_SPIN_CAP) { atomicAdd(&(bar)[XB_TMO], 1u); break; } } } } while (0)
struct XcdBarrier { unsigned* bar; unsigned x; volatile LAS unsigned* st; };
__device__ __forceinline__ XcdBarrier xcd_barrier_post(unsigned* bar, volatile LAS unsigned* st) {
    XcdBarrier b; b.bar = bar; b.x = xb_xcc_id(); b.st = st;
    if (threadIdx.x == 0) (void)xb_add(&bar[XB_XCNT(b.x)], 1u);
    return b;
}
__device__ __forceinline__ void xcd_barrier_complete(unsigned* bar, unsigned x, unsigned& nloc, unsigned& nx) {
    const unsigned G = gridDim.x * gridDim.y * gridDim.z;
    unsigned sum, cnt, mine, sp = 0u;
    for (;;) {
        sum = 0u; cnt = 0u; mine = 0u;
#pragma unroll
        for (unsigned j = 0; j < 16; ++j) { const unsigned c = xb_ld(&bar[XB_XCNT(j)]); sum += c; cnt += (c > 0u) ? 1u : 0u; mine = (j == x) ? c : mine; }
        if (sum == G) break;
        __builtin_amdgcn_s_sleep(1);
        if ((++sp & 255u) == 0u) { if (xb_ld(&bar[XB_TMO])) break; if (sp > XB_SPIN_CAP) { atomicAdd(&bar[XB_TMO], 1u); break; } }
    }
    nloc = mine > 0u ? mine : 1u; nx = cnt > 0u ? cnt : 1u;
}
__device__ __forceinline__ void xcd_barrier(const XcdBarrier& b) {
    asm volatile("s_waitcnt vmcnt(0)" ::: "memory");
    __syncthreads();
    if (threadIdx.x == 0) {
        unsigned* bar = b.bar;
        __builtin_amdgcn_s_waitcnt(0);
        unsigned nloc = b.st[0], nx = b.st[1];
        if (nloc == 0u) { xcd_barrier_complete(bar, b.x, nloc, nx); b.st[0] = nloc; b.st[1] = nx; }
        const unsigned old = xb_add(&bar[XB_XSUB(b.x)], 1u);
        const unsigned gen = old / nloc;
        if (old + 1u == (gen + 1u) * nloc) {
            __builtin_amdgcn_fence(__ATOMIC_RELEASE, "agent");
            asm volatile("s_waitcnt vmcnt(0)" ::: "memory");
            const unsigned og = xb_add(&bar[XB_TOP], 1u);
            const unsigned tg = og / nx;
            if (og + 1u == (tg + 1u) * nx) xb_add(&bar[XB_TOPGEN], 1u);
            else XB_SPIN(xb_ld(&bar[XB_TOPGEN]) == tg, bar);
            __builtin_amdgcn_fence(__ATOMIC_ACQUIRE, "agent");
            xb_add(&bar[XB_XGEN(b.x)], 1u);
            asm volatile("s_waitcnt vmcnt(0)" ::: "memory");
        } else {
            XB_SPIN(xb_ld(&bar[XB_XGEN(b.x)]) == gen, bar);
            __builtin_amdgcn_fence(__ATOMIC_ACQUIRE, "agent");
            asm volatile("s_waitcnt vmcnt(0)" ::: "memory");
        }
    }
    __syncthreads();
}

__device__ __forceinline__ unsigned short f2bf(float f) { unsigned u = __float_as_uint(f); u += 0x7FFFu + ((u >> 16) & 1u); return (unsigned short)(u >> 16); }
__device__ __forceinline__ float bf2f(unsigned short b) { return __uint_as_float(((unsigned)b) << 16); }
__device__ __forceinline__ unsigned pk2(float lo, float hi) { return (unsigned)f2bf(lo) | ((unsigned)f2bf(hi) << 16); }
__device__ __forceinline__ float sigmoidf_(float x) { return 1.0f / (1.0f + expf(-x)); }
__device__ __forceinline__ float siluf_(float x) { return x / (1.0f + expf(-x)); }
__device__ __forceinline__ float wave_sum(float v) {
#pragma unroll
    for (int o = 32; o >= 1; o >>= 1) v += __shfl_xor(v, o);
    return v;
}
__device__ __forceinline__ const float* uptr(const float* p) { const unsigned long long v = (unsigned long long)p;
    const unsigned lo = __builtin_amdgcn_readfirstlane((unsigned)v), hi = __builtin_amdgcn_readfirstlane((unsigned)(v >> 32)); return (const float*)(((unsigned long long)hi << 32) | lo); }
#define PT(k) uptr(ptab[k])
__device__ __forceinline__ int step_tok(int b, int dir, int i) {
    if (i < CTXL) { const int tt = dir ? (CTXL - 1 - i) : i; return NLAT + b * CTXL + tt; }
    const int j = i - CTXL; const int tt = dir ? (SEQ - 1 - j) : j; return b * SEQ + tt;
}
__device__ __forceinline__ void unpack8(const u32x4 w, float (&f)[8]) {
    f[0] = __uint_as_float(w.x << 16); f[1] = __uint_as_float(w.x & 0xFFFF0000u); f[2] = __uint_as_float(w.y << 16); f[3] = __uint_as_float(w.y & 0xFFFF0000u);
    f[4] = __uint_as_float(w.z << 16); f[5] = __uint_as_float(w.z & 0xFFFF0000u); f[6] = __uint_as_float(w.w << 16); f[7] = __uint_as_float(w.w & 0xFFFF0000u);
}

namespace pg8 {
constexpr int BM = 256, BK = 64, HALF = 128, HTB = HALF * BK * 2, STAGE_BYTES = 8 * HTB, NXCD = 8, WGM = 8;
__host__ __device__ __forceinline__ int lds_byte(int r, int c) { const int st = (r >> 4) * 2 + (c >> 5), rr = r & 15, cc = c & 31, ob = rr * 64 + cc * 2; return st * 1024 + (ob ^ (((ob >> 9) & 1) << 5)); }
__host__ __device__ __forceinline__ void stage_rc(int b, int& R, int& C) { const int st = b / 1024, sb = b % 1024, swz = sb ^ (((sb >> 9) & 1) << 5); R = (st >> 1) * 16 + swz / 64; C = (st & 1) * 32 + (swz % 64) / 2; }
__host__ __device__ __forceinline__ int perm32(int rho) { const int n = rho >> 4, i = rho & 15; return 8 * (i >> 2) + 4 * n + (i & 3); }
struct Unit { int pm, pn, z, k; long long ao, bo; };
struct Gemm { const bf16_t* A; const bf16_t* Bt; int lda, ldb, K; };

__device__ __forceinline__ void tile_of(int wgid, int nM, int nN, int& pm, int& pn) {
    const int nwg = nM * nN; { const int q = nwg / NXCD, r = nwg % NXCD, xcd = wgid % NXCD, off = wgid / NXCD; wgid = (xcd < r ? xcd * (q + 1) : r * (q + 1) + (xcd - r) * q) + off; }
    const int nig = WGM * nN, gid = wgid / nig, fm = gid * WGM, gsz = (nM - fm) < WGM ? (nM - fm) : WGM;
    pm = fm + ((wgid % nig) % gsz); pn = (wgid % nig) / gsz;
}
struct SchedStd {
    int nM, nN, G, c, lda, ldb;
    __device__ __forceinline__ bool next(int i, Unit& u) const { const long L = (long)i * G + c; if (L >= (long)nM * nN) return false; tile_of((int)L, nM, nN, u.pm, u.pn); u.z = 0; u.k = 0;
        u.ao = (long long)u.pm * BM * lda * 2; u.bo = (long long)u.pn * BM * ldb * 2; return true; }
    __device__ __forceinline__ void a_ready(const Unit&) const {}
    __device__ __forceinline__ void done(const Unit&) const {}
};
struct SchedBranch {
    int nM, nN, G, c;
    __device__ __forceinline__ bool next(int i, Unit& u) const { const long L = (long)(i >> 2) * G + c; if (L >= (long)nM * nN) return false; tile_of((int)L, nM, nN, u.pm, u.pn); u.z = 0; u.k = i & 3;
        u.ao = ((long long)u.pm * BM * DM + u.k * BW) * 2; u.bo = ((long long)u.k * DM + u.pn * BM) * BW * 2; return true; }
    __device__ __forceinline__ void a_ready(const Unit&) const {}
    __device__ __forceinline__ void done(const Unit&) const {}
};
struct SchedMoe {
    int nPm, nPn, G, c, lda, ldb, nBrows;
    __device__ __forceinline__ bool next(int i, Unit& u) const { const long L = (long)i * G + c; const int per = nPm * nPn; if (L >= (long)NEXP * per) return false; const int e = (int)(L / per), rem = (int)(L % per);
        u.z = e; u.k = 0; u.pm = rem % nPm; u.pn = rem / nPm; u.ao = ((long long)e * MOE_PAD + u.pm * BM) * lda * 2; u.bo = ((long long)e * nBrows + u.pn * BM) * ldb * 2; return true; }
    __device__ __forceinline__ void a_ready(const Unit&) const {}
    __device__ __forceinline__ void done(const Unit&) const {}
};

typedef f32x4 Acc[2][2][4][2];
template <class Epi, class Sched>
__device__ __forceinline__ void gemm_phase(LAS unsigned char* lds, const Gemm g, const Sched& S, const Epi& E) {
    int tid = threadIdx.x; asm volatile("" : "+v"(tid));
    const int wid = __builtin_amdgcn_readfirstlane(tid >> 6), lane = tid & 63, wr = wid >> 2, wc = wid & 3, fr = lane & 15, fq = lane >> 4;
    const int K = g.K, nt = K / BK;
    unsigned voffA[2], voffB[2];
#pragma unroll
    for (int i = 0; i < 2; ++i) { int R, C; stage_rc(tid * 16 + i * 8192, R, C); const int Rb = Epi::PERM ? ((R & ~31) + perm32(R & 31)) : R;
        voffA[i] = (unsigned)(R * g.lda + C) * 2u; voffB[i] = (unsigned)(Rb * g.ldb + C) * 2u; }
    const size_t kstep = (size_t)(BK * 2);
    const size_t hstepA = (size_t)HALF * g.lda * 2, hstepB = (size_t)HALF * g.ldb * 2;
    const unsigned ldsw = (unsigned)wid * 1024u;
    const int aoff = lds_byte(wr * 64 + fr, fq * 8), boff = lds_byte(wc * 32 + fr, fq * 8);
#define PG8_SA(b, h) (((b) * 2 + (h)) * HTB)
#define PG8_SB(b, h) ((4 + (b) * 2 + (h)) * HTB)
#define PG8_STAGE(bufoff, gbase, voff) do { _Pragma("unroll") for (int _i = 0; _i < 2; ++_i) \
        __builtin_amdgcn_global_load_lds((const unsigned*)((const char*)(gbase) + (voff)[_i]), (LAS unsigned*)(lds + (bufoff) + ldsw + _i * 8192), 16, 0, 0); } while (0)
#define PG8_LDA(dst, b, h) do { _Pragma("unroll") for (int m = 0; m < 4; ++m) _Pragma("unroll") for (int k = 0; k < 2; ++k) dst[m][k] = *(const LAS bf16x8*)(lds + PG8_SA(b, h) + aoff + m * 2048 + k * 1024); } while (0)
#define PG8_LDB(dst, b, h) do { _Pragma("unroll") for (int n = 0; n < 2; ++n) _Pragma("unroll") for (int k = 0; k < 2; ++k) dst[n][k] = *(const LAS bf16x8*)(lds + PG8_SB(b, h) + boff + n * 2048 + k * 1024); } while (0)
#define PG8_MMA(ai, bj, At, Bt) do { __builtin_amdgcn_s_setprio(1); _Pragma("unroll") for (int m = 0; m < 4; ++m) _Pragma("unroll") for (int n = 0; n < 2; ++n) _Pragma("unroll") for (int k = 0; k < 2; ++k) \
        acc[ai][bj][m][n] = __builtin_amdgcn_mfma_f32_16x16x32_bf16(Bt[n][k], At[m][k], acc[ai][bj][m][n], 0, 0, 0); __builtin_amdgcn_s_setprio(0); } while (0)
#define PG8_WAIT_V(n) asm volatile("s_waitcnt vmcnt(" #n ")" ::: "memory")
#define PG8_WAIT_L(n) asm volatile("s_waitcnt lgkmcnt(" #n ")" ::: "memory")
#define PG8_BAR __builtin_amdgcn_s_barrier()
#define PG8_SCHED __builtin_amdgcn_sched_barrier(0)
    Unit cur, nxt; int ui = 0;
    if (!S.next(0, cur)) return;
    Acc acc;
#pragma unroll
    for (int a = 0; a < 2; ++a)
#pragma unroll
        for (int b = 0; b < 2; ++b)
#pragma unroll
            for (int m = 0; m < 4; ++m)
#pragma unroll
                for (int n = 0; n < 2; ++n) acc[a][b][m][n] = (f32x4){0.f, 0.f, 0.f, 0.f};
    bf16x8 At[4][2], B0[2][2], B1[2][2];
    const char* cA = (const char*)g.A + cur.ao; const char* cB = (const char*)g.Bt + cur.bo;
    S.a_ready(cur);
    PG8_STAGE(PG8_SB(0, 0), cB, voffB); PG8_STAGE(PG8_SA(0, 0), cA, voffA); PG8_STAGE(PG8_SB(0, 1), cB + hstepB, voffB); PG8_STAGE(PG8_SA(0, 1), cA + hstepA, voffA);
    if (wr == 1) PG8_BAR;
    PG8_WAIT_V(4); PG8_BAR;
    PG8_STAGE(PG8_SB(1, 0), cB + kstep, voffB); PG8_STAGE(PG8_SA(1, 0), cA + kstep, voffA); PG8_STAGE(PG8_SB(1, 1), cB + hstepB + kstep, voffB);
    PG8_WAIT_V(6); PG8_BAR;
    for (;;) {
        const bool has_next = S.next(ui + 1, nxt);
        const char* nA = has_next ? (const char*)g.A + nxt.ao : cA; const char* nB = has_next ? (const char*)g.Bt + nxt.bo : cB;
        for (int t = 0; t < nt; t += 2) {
            const bool last = (t == nt - 2);
            const char* a1 = cA + (size_t)(t + 1) * kstep;
            const char* a2 = last ? nA : cA + (size_t)(t + 2) * kstep; const char* b2 = last ? nB : cB + (size_t)(t + 2) * kstep;
            const char* a3 = a2 + kstep; const char* b3 = b2 + kstep;
            if (last && has_next) S.a_ready(nxt);
            PG8_LDB(B0, 0, 0); PG8_SCHED; PG8_LDA(At, 0, 0); PG8_STAGE(PG8_SA(1, 1), a1 + hstepA, voffA);
            PG8_WAIT_L(8); PG8_BAR; PG8_WAIT_L(0); PG8_MMA(0, 0, At, B0); PG8_BAR; PG8_SCHED;
            PG8_LDB(B1, 0, 1); PG8_STAGE(PG8_SB(0, 0), b2, voffB);
            PG8_BAR; PG8_WAIT_L(0); PG8_MMA(0, 1, At, B1); PG8_BAR;
            PG8_LDA(At, 0, 1); PG8_STAGE(PG8_SA(0, 0), a2, voffA);
            PG8_BAR; PG8_WAIT_L(0); PG8_MMA(1, 0, At, B0); PG8_BAR; PG8_SCHED;
            PG8_STAGE(PG8_SB(0, 1), b2 + hstepB, voffB);
            PG8_WAIT_V(6); PG8_BAR; PG8_MMA(1, 1, At, B1); PG8_BAR;
            PG8_LDB(B0, 1, 0); PG8_SCHED; PG8_LDA(At, 1, 0); PG8_STAGE(PG8_SA(0, 1), a2 + hstepA, voffA);
            PG8_WAIT_L(8); PG8_BAR; PG8_WAIT_L(0); PG8_MMA(0, 0, At, B0); PG8_BAR; PG8_SCHED;
            PG8_LDB(B1, 1, 1); PG8_STAGE(PG8_SB(1, 0), b3, voffB);
            PG8_BAR; PG8_WAIT_L(0); PG8_MMA(0, 1, At, B1); PG8_BAR;
            PG8_LDA(At, 1, 1); PG8_STAGE(PG8_SA(1, 0), a3, voffA);
            PG8_BAR; PG8_WAIT_L(0); PG8_MMA(1, 0, At, B0); PG8_BAR; PG8_SCHED;
            PG8_STAGE(PG8_SB(1, 1), b3 + hstepB, voffB);
            PG8_WAIT_V(6); PG8_BAR; PG8_MMA(1, 1, At, B1); PG8_BAR;
        }
        const bool keep = E(acc, cur, wr, wc, fr, fq); S.done(cur);
        if (!has_next) break;
        if (!keep) {
#pragma unroll
        for (int a = 0; a < 2; ++a)
#pragma unroll
            for (int b = 0; b < 2; ++b)
#pragma unroll
                for (int m = 0; m < 4; ++m)
#pragma unroll
                    for (int n = 0; n < 2; ++n) acc[a][b][m][n] = (f32x4){0.f, 0.f, 0.f, 0.f};
        }
        cur = nxt; cA = nA; cB = nB; ++ui;
    }
    PG8_WAIT_V(0);
    if (wr == 0) PG8_BAR;
    PG8_BAR;
#undef PG8_SA
#undef PG8_SB
#undef PG8_STAGE
#undef PG8_LDA
#undef PG8_LDB
#undef PG8_MMA
#undef PG8_WAIT_V
#undef PG8_WAIT_L
#undef PG8_BAR
#undef PG8_SCHED
}

struct EpiBf16Store {
    static constexpr bool PERM = true;
    bf16_t* O; int ldc;
    __device__ __forceinline__ bool operator()(Acc& acc, const Unit& u, int wr, int wc, int fr, int fq) const {
        const int row0 = u.pm * BM + wr * 64 + fr, col0 = u.pn * BM + wc * 32 + 8 * fq;
#pragma unroll
        for (int ai = 0; ai < 2; ++ai)
#pragma unroll
            for (int m = 0; m < 4; ++m) { bf16_t* rowp = O + (size_t)(row0 + ai * HALF + m * 16) * ldc + col0;
#pragma unroll
                for (int bj = 0; bj < 2; ++bj) { const f32x4 v0 = acc[ai][bj][m][0], v1 = acc[ai][bj][m][1];
                    u32x4 w; w.x = pk2(v0[0], v0[1]); w.y = pk2(v0[2], v0[3]); w.z = pk2(v1[0], v1[1]); w.w = pk2(v1[2], v1[3]);
                    *(u32x4*)(rowp + bj * HALF) = w; } }
        return false;
    }
};
struct EpiGlu {
    static constexpr bool PERM = true;
    const bf16_t* GG; const float* bias; bf16_t* Y4;
    __device__ __forceinline__ bool operator()(Acc& acc, const Unit& u, int wr, int wc, int fr, int fq) const {
        const int row0 = u.pm * BM + wr * 64 + fr, col0 = u.pn * BM + wc * 32 + 8 * fq;
#pragma unroll
        for (int bj = 0; bj < 2; ++bj) { const int col = col0 + bj * HALF; const f32x4 b0 = *(const f32x4*)(bias + col), b1 = *(const f32x4*)(bias + col + 4);
#pragma unroll
            for (int ai = 0; ai < 2; ++ai)
#pragma unroll
                for (int m = 0; m < 4; ++m) { const size_t row = (size_t)(row0 + ai * HALF + m * 16);
                    float gg[8]; unpack8(*(const u32x4*)(GG + row * BW + col), gg);
                    const f32x4 v0 = acc[ai][bj][m][0] + b0, v1 = acc[ai][bj][m][1] + b1;
                    u32x4 w; w.x = pk2(gg[0] * sigmoidf_(v0[0]), gg[1] * sigmoidf_(v0[1])); w.y = pk2(gg[2] * sigmoidf_(v0[2]), gg[3] * sigmoidf_(v0[3]));
                    w.z = pk2(gg[4] * sigmoidf_(v1[0]), gg[5] * sigmoidf_(v1[1])); w.w = pk2(gg[6] * sigmoidf_(v1[2]), gg[7] * sigmoidf_(v1[3]));
                    *(u32x4*)(Y4 + row * DM + 1024 + col) = w; } }
        return false;
    }
};
struct EpiBranch {
    static constexpr bool PERM = true;
    const bf16_t* P; bf16_t* ACCb;
    __device__ __forceinline__ bool operator()(Acc& acc, const Unit& u, int wr, int wc, int fr, int fq) const {
        const int row0 = u.pm * BM + wr * 64 + fr, col0 = u.pn * BM + wc * 32 + 8 * fq; const int k = u.k;
#pragma unroll
        for (int ai = 0; ai < 2; ++ai)
#pragma unroll
            for (int m = 0; m < 4; ++m) { const size_t row = (size_t)(row0 + ai * HALF + m * 16);
#pragma unroll
                for (int bj = 0; bj < 2; ++bj) { const int col = col0 + bj * HALF;
                    float g0[8]; unpack8(*(const u32x4*)(P + row * LDP + GATE_OFF + k * DM + col), g0);
                    float s[8];
                    if (k < 3) { float g1[8]; unpack8(*(const u32x4*)(P + row * LDP + GATE_OFF + (k + 1) * DM + col), g1);
#pragma unroll
                        for (int j = 0; j < 8; ++j) s[j] = (1.0f + __expf(-g1[j])) / (1.0f + __expf(-g0[j])); }
                    else {
#pragma unroll
                        for (int j = 0; j < 8; ++j) s[j] = 1.0f / (1.0f + __expf(-g0[j])); }
                    f32x4 v0 = acc[ai][bj][m][0], v1 = acc[ai][bj][m][1];
                    v0[0] *= s[0]; v0[1] *= s[1]; v0[2] *= s[2]; v0[3] *= s[3]; v1[0] *= s[4]; v1[1] *= s[5]; v1[2] *= s[6]; v1[3] *= s[7];
                    if (k < 3) { acc[ai][bj][m][0] = v0; acc[ai][bj][m][1] = v1; }
                    else { u32x4 w; w.x = pk2(v0[0], v0[1]); w.y = pk2(v0[2], v0[3]); w.z = pk2(v1[0], v1[1]); w.w = pk2(v1[2], v1[3]); *(u32x4*)(ACCb + row * DM + col) = w; } } }
        return k < 3;
    }
};
struct EpiResid {
    static constexpr bool PERM = false;
    float* XS; const float* MODl; int gidx;
    __device__ __forceinline__ bool operator()(Acc& acc, const Unit& u, int wr, int wc, int fr, int fq) const {
        const int row0 = u.pm * BM + wr * 64 + fr, col0 = u.pn * BM + wc * 32 + 4 * fq;
        const int r = (u.pm * BM) < NLAT ? (u.pm * BM) / SEQ : 4;
        const float* mg = MODl + (size_t)(r * 6 + gidx) * DM;
#pragma unroll
        for (int bj = 0; bj < 2; ++bj)
#pragma unroll
            for (int n = 0; n < 2; ++n) { const int col = col0 + bj * HALF + n * 16; const f32x4 gm = *(const f32x4*)(mg + col);
#pragma unroll
                for (int ai = 0; ai < 2; ++ai)
#pragma unroll
                    for (int m = 0; m < 4; ++m) { float* p = XS + (size_t)(row0 + ai * HALF + m * 16) * DM + col; *(f32x4*)p = *(const f32x4*)p + gm * acc[ai][bj][m][n]; } }
        return false;
    }
};
struct EpiMoe1 {
    static constexpr bool PERM = false;
    bf16_t* HID;
    __device__ __forceinline__ bool operator()(Acc& acc, const Unit& u, int wr, int wc, int fr, int fq) const {
        const size_t row0 = (size_t)u.z * MOE_PAD + u.pm * BM + wr * 64 + fr; const int col0 = u.pn * HALF + wc * 16 + 4 * fq;
#pragma unroll
        for (int ai = 0; ai < 2; ++ai)
#pragma unroll
            for (int m = 0; m < 4; ++m)
#pragma unroll
                for (int bj = 0; bj < 2; ++bj) { const f32x4 gt = acc[ai][bj][m][0], up = acc[ai][bj][m][1];
                    u32x2 w; w.x = pk2(siluf_(gt[0]) * up[0], siluf_(gt[1]) * up[1]); w.y = pk2(siluf_(gt[2]) * up[2], siluf_(gt[3]) * up[3]);
                    *(u32x2*)(HID + (row0 + ai * HALF + m * 16) * DEXP + col0 + bj * 64) = w; }
        return false;
    }
};
struct EpiMoe2 {
    static constexpr bool PERM = false;
    float* XS; const float* MODl; const int* ROWTOK; const float* ROWGATE;
    __device__ __forceinline__ bool operator()(Acc& acc, const Unit& u, int wr, int wc, int fr, int fq) const {
        const int rowb = u.z * MOE_PAD + u.pm * BM + wr * 64 + fr; const int col0 = u.pn * BM + wc * 32 + 4 * fq;
#pragma unroll
        for (int ai = 0; ai < 2; ++ai)
#pragma unroll
            for (int m = 0; m < 4; ++m) { const int R = rowb + ai * HALF + m * 16; const int tok = ROWTOK[R];
                if (tok >= 0) { const float gt = ROWGATE[R]; const int r = tok < NLAT ? tok / SEQ : 4; const float* mg = MODl + (size_t)(r * 6 + 5) * DM; float* xr = XS + (size_t)tok * DM;
#pragma unroll
                    for (int bj = 0; bj < 2; ++bj)
#pragma unroll
                        for (int n = 0; n < 2; ++n) { const int col = col0 + bj * HALF + n * 16; const f32x4 gm = *(const f32x4*)(mg + col); const f32x4 v = acc[ai][bj][m][n];
                            atomicAdd(xr + col + 0, gm[0] * gt * v[0]); atomicAdd(xr + col + 1, gm[1] * gt * v[1]); atomicAdd(xr + col + 2, gm[2] * gt * v[2]); atomicAdd(xr + col + 3, gm[3] * gt * v[3]); } } }
        return false;
    }
};
}

constexpr size_t al256(size_t x) { return (x + 255) & ~(size_t)255; }
constexpr size_t O_BAR = 0;
constexpr size_t O_MOD = 16384;
constexpr size_t O_NORM = O_MOD + al256((size_t)2 * 5 * 6 * DM * 4);
constexpr size_t O_ZERO_END = O_NORM + al256((size_t)2 * 2 * 1024 * 4);
constexpr size_t O_XS = O_ZERO_END;
constexpr size_t O_HB = O_XS + al256((size_t)NTOK * DM * 4);
constexpr size_t O_P = O_HB + al256((size_t)NTOK * DM * 2);
constexpr size_t O_WIN = O_P + al256((size_t)NTOK * LDP * 2);
constexpr size_t O_WBR = O_WIN + al256((size_t)LDP * DM * 2);
constexpr size_t O_WOUT = O_WBR + al256((size_t)4 * DM * BW * 2);
constexpr size_t O_WGU = O_WOUT + al256((size_t)DM * DM * 2);
constexpr size_t O_WD = O_WGU + al256((size_t)NEXP * 2 * DEXP * DM * 2);
constexpr size_t O_GLU = O_WD + al256((size_t)NEXP * DM * DEXP * 2);
constexpr size_t O_Y4 = O_GLU + al256((size_t)BW * BW * 2);
constexpr size_t O_U = O_Y4 + al256((size_t)NTOK * DM * 2);
constexpr size_t O_QKC = O_U + al256((size_t)NTOK * 1536 * 4);
constexpr size_t O_XBC = O_QKC + al256((size_t)NTOK * 1024 * 4);
constexpr size_t O_HF = O_XBC + al256((size_t)NTOK * 1024 * 4);
constexpr size_t O_YF = O_HF + al256((size_t)2 * NTOK * BW * 4);
constexpr size_t O_SF = O_YF + al256((size_t)2 * NTOK * BW * 4);
constexpr size_t O_Z = O_SF + al256((size_t)2 * NTOK * BW * 4);
constexpr size_t O_HRAW = O_Z + al256((size_t)NTOK * BW * 4);
constexpr size_t O_K2L = O_HRAW + al256((size_t)(SEQ + CTXL) * 2048 * 4);
constexpr size_t O_K2C = O_K2L + al256((size_t)(2 * SEQ) * 1024 * 4);
constexpr size_t O_GG = O_K2C + al256((size_t)(2 * CTXL) * 1024 * 4);
constexpr size_t O_PROBS = O_GG + al256((size_t)NTOK * BW * 2);
constexpr size_t O_ROWTOK = O_PROBS + al256((size_t)NTOK * 16 * 4);
constexpr size_t O_ROWGATE = O_ROWTOK + al256((size_t)NEXP * MOE_PAD * 4);
constexpr size_t WS_END = O_ROWGATE + al256((size_t)NEXP * MOE_PAD * 4);
constexpr size_t O_XG = O_P;
constexpr size_t O_HID = O_P + al256((size_t)NEXP * MOE_PAD * DM * 2);
static_assert(O_HID + (size_t)NEXP * MOE_PAD * DEXP * 2 <= O_WIN, "MoE temporaries must fit inside P");
static_assert((size_t)NTOK * DM * 2 <= (size_t)NTOK * 1536 * 4, "ACCb must fit inside U");
static_assert(WS_END <= (size_t)1851000000, "workspace map exceeds the guaranteed size");

struct Args {
    const float* in[47];
    float* out; unsigned char* ws;
    int ph_lo, ph_hi;
};

__device__ __forceinline__ void conv_tile(const float* __restrict__ src, int ldsrc, int nvalid, int k0, int n0, bf16_t* __restrict__ dst, int lddst, int mode, float* T, int tid) {
    { const int n = tid & 63, kr = tid >> 6;
#pragma unroll
      for (int i = 0; i < 8; ++i) { const int k = i * 8 + kr; T[k * 65 + n] = (n0 + n < nvalid) ? src[(size_t)(k0 + k) * ldsrc + n0 + n] : 0.f; } }
    __syncthreads();
    { const int n = tid >> 3, kc = (tid & 7) * 8; const int gn = n0 + n;
      const int drow = mode == 0 ? gn : (32 * (gn >> 4) + (mode == 2 ? 16 : 0) + (gn & 15));
      u32x4 w; w.x = pk2(T[(kc + 0) * 65 + n], T[(kc + 1) * 65 + n]); w.y = pk2(T[(kc + 2) * 65 + n], T[(kc + 3) * 65 + n]);
      w.z = pk2(T[(kc + 4) * 65 + n], T[(kc + 5) * 65 + n]); w.w = pk2(T[(kc + 6) * 65 + n], T[(kc + 7) * 65 + n]);
      *(u32x4*)(dst + (size_t)drow * lddst + k0 + kc) = w; }
    __syncthreads();
}

#define IN(id) (lo <= (id) && (id) < hi)
#define SEAM(id) do { if (hi > (id) + 1) xcd_barrier(bar); } while (0)
#define PH_BEGIN int tid = threadIdx.x; asm volatile("" : "+v"(tid) :: "memory"); const int lane = tid & 63, wave = tid >> 6; (void)lane; (void)wave;

#define x_in (PT(0))
#define c_in (PT(1))
#define ctx_in (PT(2))
#define cctx_in (PT(3))
#define ada_w (PT(4))
#define ada_b (PT(5))
#define norm_mix (PT(6))
#define norm_ffn (PT(7))
#define w_in (PT(8))
#define XS ((float*)(a.ws + O_XS))
#define MOD ((float*)(a.ws + O_MOD))
#define NORM ((float*)(a.ws + O_NORM))
#define MODl (MOD + (size_t)l * 5 * 6 * DM)
#define HB ((bf16_t*)(a.ws + O_HB))
#define P ((bf16_t*)(a.ws + O_P))
#define WIN ((bf16_t*)(a.ws + O_WIN))
#define WBR ((bf16_t*)(a.ws + O_WBR))
#define WOUT ((bf16_t*)(a.ws + O_WOUT))
#define WGU ((bf16_t*)(a.ws + O_WGU))
#define WD ((bf16_t*)(a.ws + O_WD))
#define GLU ((bf16_t*)(a.ws + O_GLU))
#define Y4 ((bf16_t*)(a.ws + O_Y4))
#define U ((float*)(a.ws + O_U))
#define ACCb ((bf16_t*)(a.ws + O_U))
#define QKC ((float*)(a.ws + O_QKC))
#define XBC ((float*)(a.ws + O_XBC))
#define HF ((float*)(a.ws + O_HF))
#define HBk (HF + (size_t)NTOK * BW)
#define YF ((float*)(a.ws + O_YF))
#define YB (YF + (size_t)NTOK * BW)
#define SF ((float*)(a.ws + O_SF))
#define SB (SF + (size_t)NTOK * BW)
#define Z ((float*)(a.ws + O_Z))
#define HRAW ((float*)(a.ws + O_HRAW))
#define K2L ((float*)(a.ws + O_K2L))
#define K2C ((float*)(a.ws + O_K2C))
#define GG ((bf16_t*)(a.ws + O_GG))
#define PROBS ((float*)(a.ws + O_PROBS))
#define ROWTOK ((int*)(a.ws + O_ROWTOK))
#define ROWGATE ((float*)(a.ws + O_ROWGATE))
#define XG ((bf16_t*)(a.ws + O_XG))
#define HID ((bf16_t*)(a.ws + O_HID))


template <int LAYER>
__device__ __forceinline__ void layer_body(const Args& a, const XcdBarrier& bar, const int lo, const int hi, const int bid, const int G, unsigned char* const shm, float* const sf, const float** const ptab) {
        constexpr int l = LAYER;
        constexpr int PB = 1 + 16 * l;
        const bool lastl = (l == 1);

        const int nPanels = lastl ? 64 : 68;
        const int M2 = nPanels * 256;

        if (IN(PB + 0)) {
            PH_BEGIN
            {   const float* wbr = PT(40) + (size_t)l * 4 * BW * DM; const float* wout = PT(41) + (size_t)l * DM * DM;
                const float* wg = PT(43) + (size_t)l * NEXP * DM * DEXP; const float* wu = PT(44) + (size_t)l * NEXP * DM * DEXP; const float* wd = PT(45) + (size_t)l * NEXP * DEXP * DM;
                const float* wglu = PT(32) + (size_t)l * BW * BW; const float* win = w_in + (size_t)l * DM * IN_W;
                const int n_win = 32 * 220, n_br = 4 * 8 * 32, n_out = 32 * 32, n_gu = 16 * 2 * 32 * 24, n_d = 16 * 24 * 32, n_glu = 64;
                const int total = n_win + n_br + n_out + n_gu + n_d + n_glu;
                for (int t = bid; t < total; t += G) { int q = t;
                    if (q < n_win) { conv_tile(win, IN_W, IN_W, (q / 220) * 64, (q % 220) * 64, WIN, DM, 0, sf, tid); continue; } q -= n_win;
                    if (q < n_br) { const int k = q / 256, r = q % 256; conv_tile(wbr + (size_t)k * BW * DM, DM, DM, (r / 32) * 64, (r % 32) * 64, WBR + (size_t)k * DM * BW, BW, 0, sf, tid); continue; } q -= n_br;
                    if (q < n_out) { conv_tile(wout, DM, DM, (q / 32) * 64, (q % 32) * 64, WOUT, DM, 0, sf, tid); continue; } q -= n_out;
                    if (q < n_gu) { const int e = q / 1536, r = q % 1536, up = r / 768, r2 = r % 768; conv_tile((up ? wu : wg) + (size_t)e * DM * DEXP, DEXP, DEXP, (r2 / 24) * 64, (r2 % 24) * 64, WGU + (size_t)e * 2 * DEXP * DM, DM, 1 + up, sf, tid); continue; } q -= n_gu;
                    if (q < n_d) { const int e = q / 768, r = q % 768; conv_tile(wd + (size_t)e * DEXP * DM, DM, DM, (r / 32) * 64, (r % 32) * 64, WD + (size_t)e * DM * DEXP, DEXP, 0, sf, tid); continue; } q -= n_d;
                    conv_tile(wglu, BW, BW, (q / 8) * 64, (q % 8) * 64, GLU, BW, 0, sf, tid);
                }
            }
            for (int set = 0; set < (lastl ? 1 : 2); ++set) {
                const int L = set ? CTXL : SEQ; float* HR = HRAW + (set ? (size_t)SEQ * 2048 : 0);
                const float* w1 = PT(11) + l * 33 * 64; const float* b1 = PT(12) + l * 64; const float* fr1 = PT(13) + l * 64; const float* w2 = PT(14) + l * 64 * 64; const float* b2 = PT(15) + l * 64;
                const float* fr2 = PT(16) + l * 64; const float* w3 = PT(17) + l * 64 * 2048; const float* decay = PT(18) + l * 2048;
                float* feats = sf; float* h1 = sf + 64; float* h2 = sf + 128;
                float nacc[4] = {0.f, 0.f, 0.f, 0.f};
                for (int t = bid; t < L; t += G) {
                    const float tn = (float)t / (float)(L - 1);
                    __syncthreads();
                    if (tid < 33) { if (tid == 0) feats[0] = tn; else { const int j = (tid - 1) & 15; const double fr = 1e-4 + (double)j * ((15.0 - 1e-4) / 15.0); const double ang = (2.0 * 3.14159265358979323846 / (double)L) * (double)t * fr;
                        feats[tid] = tid <= 16 ? (float)cos(ang) : (float)(-sin(ang)); } }
                    __syncthreads();
                    if (tid < 64) { float s = b1[tid];
_Pragma("unroll 1")
                        for (int i = 0; i < 33; ++i) s += feats[i] * w1[i * 64 + tid]; h1[tid] = sinf(fr1[tid] * s); }
                    __syncthreads();
                    if (tid < 64) { float s = b2[tid];
_Pragma("unroll 1")
                        for (int i = 0; i < 64; ++i) s += h1[i] * w2[i * 64 + tid]; h2[tid] = sinf(fr2[tid] * s); }
                    __syncthreads();
                    float s4[4] = {0.f, 0.f, 0.f, 0.f};
#pragma unroll 2
                    for (int i = 0; i < 64; ++i) { const float hv = h2[i]; const float* wrow = w3 + (size_t)i * 2048 + tid;
                        s4[0] += hv * wrow[0]; s4[1] += hv * wrow[512]; s4[2] += hv * wrow[1024]; s4[3] += hv * wrow[1536]; }
#pragma unroll
                    for (int k = 0; k < 4; ++k) { const int f = tid + k * 512;
                        const float v = s4[k] * expf(-tn * fabsf(decay[f])); HR[(size_t)t * 2048 + f] = v; nacc[k] += fabsf(v); }
                }
                float* nrm = NORM + (size_t)(l * 2 + set) * 1024;
#pragma unroll
                for (int k = 0; k < 4; ++k) atomicAdd(nrm + (k >> 1) * 512 + tid, nacc[k]);
            }
            for (int tok = bid * 8 + wave; tok < NTOK; tok += G * 8) {
                const int r = tok < NLAT ? tok / SEQ : 4; const float* xr = XS + (size_t)tok * DM; const float* gn = norm_mix + l * DM;
                const float* sh = MODl + (size_t)(r * 6 + 0) * DM; const float* sc = MODl + (size_t)(r * 6 + 1) * DM;
                float4 v[8]; float ss = 0.f;
#pragma unroll
                for (int i = 0; i < 8; ++i) { v[i] = *(const float4*)(xr + i * 256 + lane * 4); ss += v[i].x * v[i].x + v[i].y * v[i].y + v[i].z * v[i].z + v[i].w * v[i].w; }
                ss = wave_sum(ss); const float rs = rsqrtf(ss * (1.0f / DM) + 1e-6f);
#pragma unroll
                for (int i = 0; i < 8; ++i) { const int d = i * 256 + lane * 4; const float4 g4 = *(const float4*)(gn + d), s4 = *(const float4*)(sc + d), h4 = *(const float4*)(sh + d);
                    u32x2 w; w.x = pk2(v[i].x * rs * g4.x * (1.f + s4.x) + h4.x, v[i].y * rs * g4.y * (1.f + s4.y) + h4.y); w.y = pk2(v[i].z * rs * g4.z * (1.f + s4.z) + h4.z, v[i].w * rs * g4.w * (1.f + s4.w) + h4.w);
                    *(u32x2*)(HB + (size_t)tok * DM + d) = w; }
            }
            SEAM(PB + 0);
        }

        if (IN(PB + 1)) {
            PH_BEGIN
            pg8::Gemm g{HB, WIN, DM, DM, DM}; pg8::SchedStd S{68, 55, G, bid, DM, DM}; pg8::EpiBf16Store E{P, LDP};
            pg8::gemm_phase(( LAS unsigned char*)shm, g, S, E);
            SEAM(PB + 1);
        }

        if (IN(PB + 2)) {
            PH_BEGIN
            const float* hcw = PT(9) + l * 3 * 1536; const float* hcb = PT(10) + l * 1536; const float* mcw = PT(20) + l * 3 * 1024; const float* mcb = PT(21) + l * 1024;
            const float* scw = PT(34) + l * 3 * 1024; const float* scb = PT(35) + l * 1024;
            for (int tok = bid; tok < NTOK; tok += G) {
                const bool lat = tok < NLAT; const int t = lat ? (tok & (SEQ - 1)) : ((tok - NLAT) & (CTXL - 1));
                const bool hasL = lat ? ((t & 63) != 0) : (t != 0); const bool hasR = lat ? ((t & 63) != 63) : (t != CTXL - 1);
                const bf16_t* pr = P + (size_t)tok * LDP;
#pragma unroll
                for (int j = 0; j < 7; ++j) { const int ci = tid + j * 512;
                    int col, C, cc; const float* w; const float* b; float* o;
                    if (j < 3) { cc = ci; C = 1536; col = HY_OFF + cc; w = hcw; b = hcb; o = U + (size_t)tok * 1536 + cc; }
                    else if (j < 5) { cc = ci - 1536; C = 1024; col = ML_OFF + cc; w = mcw; b = mcb; o = QKC + (size_t)tok * 1024 + cc; }
                    else { cc = ci - 2560; C = 1024; col = SSD_OFF + 512 + cc; w = scw; b = scb; o = XBC + (size_t)tok * 1024 + cc; }
                    float acc = b[cc] + w[C + cc] * bf2f(pr[col]);
                    if (hasL) acc += w[cc] * bf2f(pr[col - LDP]);
                    if (hasR) acc += w[2 * C + cc] * bf2f(pr[col + LDP]);
                    if (j >= 3) acc = siluf_(acc);
                    *o = acc; }
            }
            for (int set = 0; set < (lastl ? 1 : 2); ++set) {
                const int L = set ? CTXL : SEQ; const float* HR = HRAW + (set ? (size_t)SEQ * 2048 : 0); float* K2 = set ? K2C : K2L; const float* nrm = NORM + (size_t)(l * 2 + set) * 1024;
                const size_t total = (size_t)(2 * L - 1) * 1024;
                for (size_t i = (size_t)bid * NTHR + tid; i < total; i += (size_t)G * NTHR) { const int j = (int)(i >> 10), oc = (int)(i & 1023), o = oc >> 9, c = oc & 511; const int lag = j - (L - 1);
                    const float v = lag >= 0 ? HR[(size_t)lag * 2048 + o * 1024 + c] : HR[(size_t)(-lag) * 2048 + o * 1024 + 512 + c];
                    K2[((size_t)j * 2 + o) * 512 + c] = v / nrm[oc]; }
            }
            SEAM(PB + 2);
        }

        if (IN(PB + 3)) {
            PH_BEGIN
            if (bid < 32) {
                const int dir = bid & 1, h = (bid >> 1) & 3, b = bid >> 3; const int e = tid >> 2, dq = tid & 3;
                float* sq = sf; float* sk = sf + 256; float* sv = sf + 512; float* sg = sf + 768;
                const float* gate_b = PT(22) + l * 16; const float gbi = gate_b[(dir * 2 + 0) * 4 + h], gbf = gate_b[(dir * 2 + 1) * 4 + h];
                float C[32], nn[32];
#pragma unroll
                for (int d = 0; d < 32; ++d) { C[d] = 0.f; nn[d] = 0.f; }
                float m = 0.f; float* Hout = dir ? HBk : HF; const int total = CTXL + SEQ; float r0 = 0.f;
#define ML_LD(i_) do { const size_t tok_ = (size_t)step_tok(b, dir, (i_)); \
                    if (tid < 128) r0 = QKC[tok_ * 1024 + h * 128 + tid]; \
                    else if (tid < 256) r0 = QKC[tok_ * 1024 + 512 + h * 128 + (tid - 128)] * 0.08838834764831845f; \
                    else if (tid < 384) r0 = bf2f(P[tok_ * LDP + ML_OFF + 1024 + h * 128 + (tid - 256)]); \
                    else if (tid == 384) r0 = bf2f(P[tok_ * LDP + ML_OFF + 2048 + (dir * 2 + 0) * 4 + h]) + gbi; \
                    else if (tid == 385) r0 = bf2f(P[tok_ * LDP + ML_OFF + 2048 + (dir * 2 + 1) * 4 + h]) + gbf; } while (0)
#define ML_ST(buf_) do { if (tid < 128) sq[(buf_) * 128 + tid] = r0; else if (tid < 256) sk[(buf_) * 128 + tid - 128] = r0; else if (tid < 384) sv[(buf_) * 128 + tid - 256] = r0; else if (tid < 386) sg[(buf_) * 2 + tid - 384] = r0; } while (0)
                __syncthreads();
                ML_LD(0); ML_ST(0);
                __syncthreads();
                for (int i = 0; i < total; ++i) {
                    const int cur = i & 1; const size_t tokc = (size_t)step_tok(b, dir, i);
                    if (i + 1 < total) ML_LD(i + 1);
                    const float ig = sg[cur * 2 + 0], fg = sg[cur * 2 + 1];
                    const float lf = fminf(fg, 0.f) - log1pf(expf(-fabsf(fg)));
                    const float mn = fmaxf(lf + m, ig); const float fp = expf(lf + m - mn), ip = expf(ig - mn); m = mn;
                    const float ve = sv[cur * 128 + e] * ip;
                    float num = 0.f, den = 0.f;
#pragma unroll
                    for (int d = 0; d < 32; ++d) { const float kd = sk[cur * 128 + d * 4 + dq], qd = sq[cur * 128 + d * 4 + dq];
                        C[d] = fp * C[d] + ve * kd; nn[d] = fp * nn[d] + ip * kd; num += C[d] * qd; den += nn[d] * qd; }
                    num += __shfl_xor(num, 1); den += __shfl_xor(den, 1); num += __shfl_xor(num, 2); den += __shfl_xor(den, 2);
                    const float hv = num / fmaxf(fabsf(den), expf(-m));
                    if (dq == 0) Hout[tokc * BW + h * 128 + e] = hv;
                    if (i + 1 < total) ML_ST(cur ^ 1);
                    __syncthreads();
                }
#undef ML_LD
#undef ML_ST
            } else if (bid < 96) {
                const int ch = bid - 32; const int dir = ch & 1, h = (ch >> 1) & 7, b = ch >> 4; const int p = tid >> 3, nq = tid & 7;
                float* sBC = sf; float* sx = sf + 512; float* sdt = sf + 640;
                const float Aa = -expf(PT(37)[l * 16 + dir * 8 + h]); const float dtb = PT(36)[l * 16 + dir * 8 + h]; const int grp = h >> 2;
                float S[16];
#pragma unroll
                for (int j = 0; j < 16; ++j) S[j] = 0.f;
                float* Yout = dir ? YB : YF; const int total = CTXL + SEQ; float r0 = 0.f;
#define SD_LD(i_) do { const size_t tok_ = (size_t)step_tok(b, dir, (i_)); \
                    if (tid < 128) r0 = XBC[tok_ * 1024 + 512 + grp * 128 + tid]; \
                    else if (tid < 256) r0 = XBC[tok_ * 1024 + 768 + grp * 128 + (tid - 128)]; \
                    else if (tid < 320) r0 = XBC[tok_ * 1024 + h * 64 + (tid - 256)]; \
                    else if (tid == 320) { const float xv_ = bf2f(P[tok_ * LDP + SSD_OFF + 1536 + dir * 8 + h]) + dtb; r0 = xv_ > 20.f ? xv_ : log1pf(expf(xv_)); } } while (0)
#define SD_ST(buf_) do { if (tid < 256) sBC[(buf_) * 256 + tid] = r0; else if (tid < 320) sx[(buf_) * 64 + tid - 256] = r0; else if (tid == 320) sdt[(buf_)] = r0; } while (0)
                __syncthreads();
                SD_LD(0); SD_ST(0);
                __syncthreads();
                for (int i = 0; i < total; ++i) {
                    const int cur = i & 1; const size_t tokc = (size_t)step_tok(b, dir, i);
                    if (i + 1 < total) SD_LD(i + 1);
                    const float dtv = sdt[cur]; const float dA = expf(dtv * Aa); const float xv = sx[cur * 64 + p] * dtv;
                    float y = 0.f;
#pragma unroll
                    for (int j = 0; j < 16; ++j) { const int n = j * 8 + nq; S[j] = dA * S[j] + xv * sBC[cur * 256 + n]; y += S[j] * sBC[cur * 256 + 128 + n]; }
                    y += __shfl_xor(y, 1); y += __shfl_xor(y, 2); y += __shfl_xor(y, 4);
                    if (nq == 0) Yout[tokc * BW + h * 64 + p] = y;
                    if (i + 1 < total) SD_ST(cur ^ 1);
                    __syncthreads();
                }
#undef SD_LD
#undef SD_ST
            } else if (bid < 128) {
                const int widx = (bid - 96) * 8 + wave; const int dir = widx & 1, g = (widx >> 1) & 31, b = widx >> 6; const int n = lane;
                float2* xb = (float2*)(shm + (size_t)wave * 16640); float2* ctab = xb + 16 * 65;
                const float* a_re = PT(24) + l * 2 * 32 * 64; const float* a_im = PT(25) + l * 2 * 32 * 64; const float* log_dt = PT(26) + l * 64;
                const float* b_re = PT(27) + l * 32 * 64 * 16; const float* b_im = PT(28) + l * 32 * 64 * 16; const float* c_re = PT(29) + l * 32 * 16 * 64; const float* c_im = PT(30) + l * 32 * 16 * 64;
#pragma unroll
                for (int c = 0; c < 16; ++c) ctab[c * 65 + lane] = make_float2(c_re[(g * 16 + c) * 64 + lane], c_im[(g * 16 + c) * 64 + lane]);
                float abr, abi, bbr[16], bbi[16];
                {   const double are = (double)a_re[(dir * 32 + g) * 64 + n], aim = (double)a_im[(dir * 32 + g) * 64 + n];
                    const double lam = are < -1e-4 ? are : -1e-4; const double dt = exp((double)log_dt[dir * 32 + g]);
                    const double mag = exp(lam * dt); const double ar = mag * cos(aim * dt), ai = mag * sin(aim * dt);
                    const double den = lam * lam + aim * aim; const double nr = ar - 1.0, ni = ai;
                    const double fre = (nr * lam + ni * aim) / den, fim = (ni * lam - nr * aim) / den;
                    abr = (float)ar; abi = (float)ai;
#pragma unroll
                    for (int c = 0; c < 16; ++c) { const double br = (double)b_re[(g * 64 + n) * 16 + c], bi = (double)b_im[(g * 64 + n) * 16 + c]; bbr[c] = (float)(fre * br - fim * bi); bbi[c] = (float)(fre * bi + fim * br); }
                }
                float xr = 0.f, xi = 0.f; float* Sout = dir ? SB : SF;
                const int s = lane >> 2, cg = lane & 3;
                for (int i0 = 0; i0 < CTXL + SEQ; i0 += 16) {
#pragma unroll 4
                    for (int ss = 0; ss < 16; ++ss) {
                        const size_t tok = (size_t)step_tok(b, dir, i0 + ss);
                        const u32x4* up = (const u32x4*)(P + tok * LDP + S5_OFF + g * 16);
                        float t0[8], t1[8]; unpack8(up[0], t0); unpack8(up[1], t1);
                        float bur = 0.f, bui = 0.f;
#pragma unroll
                        for (int c = 0; c < 8; ++c) { bur += t0[c] * bbr[c] + t1[c] * bbr[8 + c]; bui += t0[c] * bbi[c] + t1[c] * bbi[8 + c]; }
                        const float nxr = abr * xr - abi * xi + bur, nxi = abr * xi + abi * xr + bui; xr = nxr; xi = nxi;
                        xb[ss * 65 + lane] = make_float2(xr, xi);
                    }
                    asm volatile("s_waitcnt lgkmcnt(0)" ::: "memory");
                    float y0 = 0.f, y1 = 0.f, y2 = 0.f, y3 = 0.f;
                    for (int nn2 = 0; nn2 < 64; ++nn2) { const float2 xv = xb[s * 65 + nn2];
                        const float2 c0 = ctab[(cg * 4 + 0) * 65 + nn2], c1 = ctab[(cg * 4 + 1) * 65 + nn2], c2 = ctab[(cg * 4 + 2) * 65 + nn2], c3 = ctab[(cg * 4 + 3) * 65 + nn2];
                        y0 += xv.x * c0.x - xv.y * c0.y; y1 += xv.x * c1.x - xv.y * c1.y; y2 += xv.x * c2.x - xv.y * c2.y; y3 += xv.x * c3.x - xv.y * c3.y; }
                    const size_t toks = (size_t)step_tok(b, dir, i0 + s);
                    *(float4*)(Sout + toks * BW + g * 16 + cg * 4) = make_float4(y0, y1, y2, y3);
                    asm volatile("s_waitcnt lgkmcnt(0)" ::: "memory");
                }
            } else {
                const int nhb = G - 128, hb = bid - 128; const float* bias = PT(19) + l * 1024; const int c = tid;
                const int nitems = 4 * (SEQ / 8) + (lastl ? 0 : 4 * (CTXL / 8));
                for (int it = hb; it < nitems; it += nhb) {
                    int L, tokbase, b, t0; const float* K2;
                    if (it < 4 * (SEQ / 8)) { L = SEQ; tokbase = 0; b = it / (SEQ / 8); t0 = (it % (SEQ / 8)) * 8; K2 = K2L; } else { const int q = it - 4 * (SEQ / 8); L = CTXL; tokbase = NLAT; b = q / (CTXL / 8); t0 = (q % (CTXL / 8)) * 8; K2 = K2C; }
                    const float* zb = U + (size_t)(tokbase + b * L) * 1536 + c;
                    float acc[8];
#pragma unroll
                    for (int i = 0; i < 8; ++i) acc[i] = 0.f;
                    const int base = t0 + L - 1;
                    for (int s = 0; s < L; s += 8) {
                        float k[15];
#pragma unroll
                        for (int mm = 0; mm < 15; ++mm) k[mm] = K2[((size_t)(base - s - 7 + mm) * 2 + 0) * 512 + c];
#pragma unroll
                        for (int ds = 0; ds < 8; ++ds) { const float z = zb[(size_t)(s + ds) * 1536];
#pragma unroll
                            for (int i = 0; i < 8; ++i) acc[i] += k[i - ds + 7] * z; }
                    }
#pragma unroll
                    for (int i = 0; i < 8; ++i) { const size_t tok = (size_t)(tokbase + b * L + t0 + i); const float zt = U[tok * 1536 + c]; Z[tok * BW + c] = (acc[i] + bias[c] * zt) * U[tok * 1536 + 512 + c]; }
                }
            }
            SEAM(PB + 3);
        }

        if (IN(PB + 4)) {
            PH_BEGIN
            const float* ml_norm = PT(23) + l * BW; const float* ssd_d = PT(38) + l * 8; const float* ssd_norm = PT(39) + l * BW; const float* s5_d = PT(31) + l * BW;
            float* red = sf;
            for (int tok = bid; tok < NTOK; tok += G) {
                const int c = tid; const bf16_t* pr = P + (size_t)tok * LDP;
                const float hm = HF[(size_t)tok * BW + c] + HBk[(size_t)tok * BW + c];
                float ys = YF[(size_t)tok * BW + c] + YB[(size_t)tok * BW + c] + ssd_d[c >> 6] * XBC[(size_t)tok * 1024 + c];
                ys *= siluf_(bf2f(pr[SSD_OFF + c]));
                const float s1 = wave_sum(hm * hm), s2 = wave_sum(ys * ys);
                __syncthreads();
                if (lane == 0) { red[wave] = s1; red[8 + wave] = s2; }
                __syncthreads();
                const float hs = red[(wave & ~1)] + red[(wave | 1)];
                const float tot = red[8] + red[9] + red[10] + red[11] + red[12] + red[13] + red[14] + red[15];
                const float o = bf2f(pr[ML_OFF + 1536 + c]);
                Y4[(size_t)tok * DM + 512 + c] = f2bf(hm * rsqrtf(hs * (1.0f / 128.0f) + 1e-6f) * ml_norm[c] * sigmoidf_(o));
                Y4[(size_t)tok * DM + 1536 + c] = f2bf(ys * rsqrtf(tot * (1.0f / BW) + 1e-6f) * ssd_norm[c]);
                const float y5 = SF[(size_t)tok * BW + c] + SB[(size_t)tok * BW + c] + s5_d[c] * bf2f(pr[S5_OFF + c]);
                GG[(size_t)tok * BW + c] = f2bf(0.5f * y5 * (1.0f + tanhf(0.7978845608028654f * (y5 + 0.044715f * y5 * y5 * y5))));
            }
            {   const float* bias = PT(19) + l * 1024 + 512; const int c = tid;
                const int nitems = 4 * (SEQ / 8) + (lastl ? 0 : 4 * (CTXL / 8));
                for (int it = bid; it < nitems; it += G) {
                    int L, tokbase, b, t0; const float* K2;
                    if (it < 4 * (SEQ / 8)) { L = SEQ; tokbase = 0; b = it / (SEQ / 8); t0 = (it % (SEQ / 8)) * 8; K2 = K2L; } else { const int q = it - 4 * (SEQ / 8); L = CTXL; tokbase = NLAT; b = q / (CTXL / 8); t0 = (q % (CTXL / 8)) * 8; K2 = K2C; }
                    const float* zb = Z + (size_t)(tokbase + b * L) * BW + c;
                    float acc[8];
#pragma unroll
                    for (int i = 0; i < 8; ++i) acc[i] = 0.f;
                    const int base = t0 + L - 1;
                    for (int s = 0; s < L; s += 8) {
                        float k[15];
#pragma unroll
                        for (int mm = 0; mm < 15; ++mm) k[mm] = K2[((size_t)(base - s - 7 + mm) * 2 + 1) * 512 + c];
#pragma unroll
                        for (int ds = 0; ds < 8; ++ds) { const float z = zb[(size_t)(s + ds) * BW];
#pragma unroll
                            for (int i = 0; i < 8; ++i) acc[i] += k[i - ds + 7] * z; }
                    }
#pragma unroll
                    for (int i = 0; i < 8; ++i) { const size_t tok = (size_t)(tokbase + b * L + t0 + i); const float zt = Z[tok * BW + c]; Y4[tok * DM + c] = f2bf((acc[i] + bias[c] * zt) * U[tok * 1536 + 1024 + c]); }
                }
            }
            SEAM(PB + 4);
        }

        if (IN(PB + 5)) {
            PH_BEGIN
            pg8::Gemm g{GG, GLU, BW, BW, BW}; pg8::SchedStd S{68, 2, G, bid, BW, BW}; pg8::EpiGlu E{GG, PT(33) + l * BW, Y4};
            pg8::gemm_phase((LAS unsigned char*)shm, g, S, E);
            SEAM(PB + 5);
        }
        if (IN(PB + 6)) {
            PH_BEGIN
            pg8::Gemm g{Y4, WBR, DM, BW, BW}; pg8::SchedBranch S{nPanels, 8, G, bid}; pg8::EpiBranch E{P, ACCb};
            pg8::gemm_phase((LAS unsigned char*)shm, g, S, E);
            SEAM(PB + 6);
        }
        if (IN(PB + 7)) {
            PH_BEGIN
            pg8::Gemm g{ACCb, WOUT, DM, DM, DM}; pg8::SchedStd S{nPanels, 8, G, bid, DM, DM}; pg8::EpiResid E{XS, MODl, 2};
            pg8::gemm_phase((LAS unsigned char*)shm, g, S, E);
            SEAM(PB + 7);
        }
        if (IN(PB + 8)) {
            PH_BEGIN
            for (int i = bid * NTHR + tid; i < NEXP * MOE_PAD; i += G * NTHR) ROWTOK[i] = -1;
            const float* wr = PT(42) + (size_t)l * DM * 16; const float* gn = norm_ffn + l * DM;
            for (int tok = bid * 8 + wave; tok < M2; tok += G * 8) {
                const int r = tok < NLAT ? tok / SEQ : 4; const float* xr = XS + (size_t)tok * DM;
                const float* sh = MODl + (size_t)(r * 6 + 3) * DM; const float* sc = MODl + (size_t)(r * 6 + 4) * DM;
                float ss = 0.f;
#pragma unroll 2
                for (int i = 0; i < 8; ++i) { const float4 t4 = *(const float4*)(xr + i * 256 + lane * 4); ss += t4.x * t4.x + t4.y * t4.y + t4.z * t4.z + t4.w * t4.w; }
                ss = wave_sum(ss); const float rs = rsqrtf(ss * (1.0f / DM) + 1e-6f);
                float lg[16];
#pragma unroll
                for (int e = 0; e < 16; ++e) lg[e] = 0.f;
#pragma unroll 1
                for (int i = 0; i < 8; ++i) { const int d = i * 256 + lane * 4; const float4 xv = *(const float4*)(xr + d);
                    const float4 g4 = *(const float4*)(gn + d), s4 = *(const float4*)(sc + d), h4 = *(const float4*)(sh + d);
                    const float hv[4] = {xv.x * rs * g4.x * (1.f + s4.x) + h4.x, xv.y * rs * g4.y * (1.f + s4.y) + h4.y, xv.z * rs * g4.z * (1.f + s4.z) + h4.z, xv.w * rs * g4.w * (1.f + s4.w) + h4.w};
                    u32x2 w; w.x = pk2(hv[0], hv[1]); w.y = pk2(hv[2], hv[3]); *(u32x2*)(HB + (size_t)tok * DM + d) = w;
                    const float4* wq = (const float4*)(wr + (size_t)d * 16);
#pragma unroll
                    for (int q = 0; q < 4; ++q) { const float4 w0 = wq[q * 4 + 0], w1 = wq[q * 4 + 1], w2 = wq[q * 4 + 2], w3 = wq[q * 4 + 3];
                        lg[0] += hv[q] * w0.x; lg[1] += hv[q] * w0.y; lg[2] += hv[q] * w0.z; lg[3] += hv[q] * w0.w; lg[4] += hv[q] * w1.x; lg[5] += hv[q] * w1.y; lg[6] += hv[q] * w1.z; lg[7] += hv[q] * w1.w;
                        lg[8] += hv[q] * w2.x; lg[9] += hv[q] * w2.y; lg[10] += hv[q] * w2.z; lg[11] += hv[q] * w2.w; lg[12] += hv[q] * w3.x; lg[13] += hv[q] * w3.y; lg[14] += hv[q] * w3.z; lg[15] += hv[q] * w3.w; } }
                float mx = -1e30f;
#pragma unroll
                for (int e = 0; e < 16; ++e) { lg[e] = wave_sum(lg[e]); mx = fmaxf(mx, lg[e]); }
                float s = 0.f;
#pragma unroll
                for (int e = 0; e < 16; ++e) { lg[e] = expf(lg[e] - mx); s += lg[e]; }
                const float inv = 1.0f / s;
                if (lane == 0) {
#pragma unroll
                    for (int e = 0; e < 16; e += 4) *(float4*)(PROBS + (size_t)tok * 16 + e) = make_float4(lg[e] * inv, lg[e + 1] * inv, lg[e + 2] * inv, lg[e + 3] * inv); }
            }
            SEAM(PB + 8);
        }
        if (IN(PB + 9)) {
            PH_BEGIN
            const int nitems = 128 + (lastl ? 0 : 64);
            for (int it = bid; it < nitems; it += G) {
                int set, b, e, part;
                if (it < 128) { set = 0; part = it & 1; e = (it >> 1) & 15; b = it >> 5; } else { const int q = it - 128; set = 1; part = 0; e = q & 15; b = q >> 4; }
                const int n = set ? CTXL : SEQ, cap = set ? 32 : 512, tokbase = set ? NLAT + b * CTXL : b * SEQ;
                __syncthreads();
                for (int i = tid; i < n; i += NTHR) sf[i] = PROBS[(size_t)(tokbase + i) * 16 + e];
                __syncthreads();
                const int i0 = set ? 0 : part * 2048, i1 = set ? CTXL : i0 + 2048;
                for (int i = i0 + tid; i < i1; i += NTHR) { const float pi = sf[i]; int rank = 0;
                    for (int j = 0; j < n; ++j) { const float pj = sf[j]; rank += (pj > pi || (pj == pi && j < i)) ? 1 : 0; }
                    if (rank < cap) { const int row = e * MOE_PAD + (set ? 2048 + b * 32 + rank : b * 512 + rank); ROWTOK[row] = tokbase + i; ROWGATE[row] = pi; } }
            }
            SEAM(PB + 9);
        }
        if (IN(PB + 10)) {
            PH_BEGIN
            for (int R = bid * 8 + wave; R < NEXP * MOE_PAD; R += G * 8) { const int tok = ROWTOK[R];
                u32x4* d = (u32x4*)(XG + (size_t)R * DM);
                if (tok >= 0) { const u32x4* s = (const u32x4*)(HB + (size_t)tok * DM);
#pragma unroll
                    for (int i = 0; i < 4; ++i) d[i * 64 + lane] = s[i * 64 + lane]; }
                else {
#pragma unroll
                    for (int i = 0; i < 4; ++i) d[i * 64 + lane] = (u32x4){0u, 0u, 0u, 0u}; } }
            SEAM(PB + 10);
        }
        if (IN(PB + 11)) {
            PH_BEGIN
            pg8::Gemm g{XG, WGU, DM, DM, DM}; pg8::SchedMoe S{lastl ? 8 : 9, 12, G, bid, DM, DM, 2 * DEXP}; pg8::EpiMoe1 E{HID};
            pg8::gemm_phase((LAS unsigned char*)shm, g, S, E);
            SEAM(PB + 11);
        }
        if (IN(PB + 12)) {
            PH_BEGIN
            pg8::Gemm g{HID, WD, DEXP, DEXP, DEXP}; pg8::SchedMoe S{lastl ? 8 : 9, 8, G, bid, DEXP, DEXP, DM}; pg8::EpiMoe2 E{XS, MODl, ROWTOK, ROWGATE};
            pg8::gemm_phase((LAS unsigned char*)shm, g, S, E);
            SEAM(PB + 12);
        }

}

__global__ __launch_bounds__(NTHR, 2) void fwd(Args a) {
    extern __shared__ __attribute__((aligned(16))) unsigned char shm[];
    const int bid = blockIdx.x, G = gridDim.x;
    float* const sf = (float*)shm;
    volatile LAS unsigned* xbw = (volatile LAS unsigned*)((LAS unsigned char*)shm + (LDS_BYTES - 16));
    if (threadIdx.x == 0) { xbw[0] = 0u; xbw[1] = 0u; xbw[2] = 0u; xbw[3] = 0u; }
    const float** const ptab = (const float**)(shm + (LDS_BYTES - 16 - 512));
    if (threadIdx.x == 0) {
#pragma unroll
        for (int i = 0; i < 47; ++i) ptab[i] = a.in[i]; }
    __syncthreads();
    XcdBarrier bar = xcd_barrier_post((unsigned*)(a.ws + O_BAR), xbw);
    const int lo = a.ph_lo, hi = a.ph_hi;
    if (IN(0)) {
        PH_BEGIN
        { const float4* s0 = (const float4*)x_in; const float4* s1 = (const float4*)ctx_in; float4* d = (float4*)XS; const size_t n0 = (size_t)NLAT * DM / 4, n1 = (size_t)NCTX * DM / 4;
          for (size_t i = (size_t)bid * NTHR + tid; i < n0 + n1; i += (size_t)G * NTHR) d[i] = i < n0 ? s0[i] : s1[i - n0]; }
        for (int unit = bid; unit < 2 * 24 * 8; unit += G) { const int l = unit / 192, rem = unit % 192, jb = rem >> 3, ks = rem & 7;
            __syncthreads();
            for (int i = tid; i < 5 * 256; i += NTHR) { const int r = i >> 8, k = ks * 256 + (i & 255); const float v = r < 4 ? c_in[r * DM + k] : cctx_in[k]; sf[i] = siluf_(v); }
            __syncthreads();
            const int j = jb * 512 + tid; const float* w = ada_w + (size_t)l * DM * (6 * DM) + (size_t)(ks * 256) * (6 * DM) + j;
            float a0 = 0.f, a1 = 0.f, a2 = 0.f, a3 = 0.f, a4 = 0.f;
            for (int k = 0; k < 256; ++k) { const float wv = w[(size_t)k * (6 * DM)]; a0 += sf[k] * wv; a1 += sf[256 + k] * wv; a2 += sf[512 + k] * wv; a3 += sf[768 + k] * wv; a4 += sf[1024 + k] * wv; }
            const float bb = ks == 0 ? ada_b[l * 6 * DM + j] : 0.f;
            float* o = MOD + (size_t)l * 5 * 6 * DM + j;
            atomicAdd(o + 0 * 6 * DM, a0 + bb); atomicAdd(o + 1 * 6 * DM, a1 + bb); atomicAdd(o + 2 * 6 * DM, a2 + bb); atomicAdd(o + 3 * 6 * DM, a3 + bb); atomicAdd(o + 4 * 6 * DM, a4 + bb);
        }
        SEAM(0);
    }

    layer_body<0>(a, bar, lo, hi, bid, G, shm, sf, ptab);
    layer_body<1>(a, bar, lo, hi, bid, G, shm, sf, ptab);
    if (IN(33)) {
        PH_BEGIN
        const float* gn = PT(46);
        for (int tok = bid * 8 + wave; tok < NLAT; tok += G * 8) {
            const float* xr = XS + (size_t)tok * DM; float4 v[8]; float ss = 0.f;
#pragma unroll
            for (int i = 0; i < 8; ++i) { v[i] = *(const float4*)(xr + i * 256 + lane * 4); ss += v[i].x * v[i].x + v[i].y * v[i].y + v[i].z * v[i].z + v[i].w * v[i].w; }
            ss = wave_sum(ss); const float rs = rsqrtf(ss * (1.0f / DM) + 1e-6f);
#pragma unroll
            for (int i = 0; i < 8; ++i) { const int d = i * 256 + lane * 4; const float4 g4 = *(const float4*)(gn + d);
                *(float4*)(a.out + (size_t)tok * DM + d) = make_float4(v[i].x * rs * g4.x, v[i].y * rs * g4.y, v[i].z * rs * g4.z, v[i].w * rs * g4.w); }
        }
    }
#undef IN
#undef SEAM
}


extern "C" void kernel_launch(void* const* d_in, const int* in_sizes, int n_in, void* d_out, int out_size, void* d_ws, size_t ws_size, hipStream_t stream) {
    static int grid = 0;
    if (grid == 0) {
        if (n_in != 47 || ws_size < WS_END) { fprintf(stderr, "kernel_launch: expected 47 inputs and >= %zu bytes of workspace; got %d, %zu\n", (size_t)WS_END, n_in, ws_size); grid = -1; return; }
        int dev = 0, cus = 0;
        if (hipGetDevice(&dev) != hipSuccess || hipDeviceGetAttribute(&cus, hipDeviceAttributeMultiprocessorCount, dev) != hipSuccess) { grid = -1; return; }
        if (hipFuncSetAttribute((const void*)fwd, hipFuncAttributeMaxDynamicSharedMemorySize, LDS_BYTES) != hipSuccess) { fprintf(stderr, "kernel_launch: hipFuncSetAttribute failed\n"); grid = -1; return; }
        int per_cu = 0;
        if (hipOccupancyMaxActiveBlocksPerMultiprocessor(&per_cu, (const void*)fwd, NTHR, LDS_BYTES) != hipSuccess || per_cu < 1) fprintf(stderr, "kernel_launch: occupancy query reports %d\n", per_cu);
        (void)hipGetLastError();
        grid = cus;
        if (grid < 160) { fprintf(stderr, "kernel_launch: needs >= 160 CUs (got %d)\n", grid); grid = -1; return; }
    }
    if (grid < 0) return;
    (void)hipMemsetAsync((char*)d_ws, 0, O_ZERO_END, stream);
    Args a{};
    for (int i = 0; i < 47; ++i) a.in[i] = (const float*)d_in[i];
    a.out = (float*)d_out; a.ws = (unsigned char*)d_ws;
#if MK_ONE_LAUNCH
    a.ph_lo = 0; a.ph_hi = 64;
    hipLaunchKernelGGL(fwd, dim3(grid), dim3(NTHR), LDS_BYTES, stream, a);
#else
    const int ids[] = {0, 1,2,3,4,5,6,7,8,9,10,11,12,13, 17,18,19,20,21,22,23,24,25,26,27,28,29, 33};
    for (int k = 0; k < (int)(sizeof(ids) / sizeof(ids[0])); ++k) { a.ph_lo = ids[k]; a.ph_hi = ids[k] + 1; hipLaunchKernelGGL(fwd, dim3(grid), dim3(NTHR), LDS_BYTES, stream, a); }
#endif
}
```

```cpp
#include <hip/hip_runtime.h>
#include <stdint.h>
#include <stdio.h>

#ifndef MK_ONE_LAUNCH
#define MK_ONE_LAUNCH 1
#endif

#define DM 2048
#define NB 4
#define SEQ 4096
#define CTXL 256
#define BW 512
#define NLAT 16384
#define NCTX 1024
#define NTOK 17408
#define IN_W 13856
#define LDP 14080
#define HY_OFF 0
#define ML_OFF 1536
#define S5_OFF 3600
#define SSD_OFF 4112
#define GATE_OFF 5664
#define NEXP 16
#define DEXP 1536
#define MOE_ROWS 2176
#define MOE_PAD 2304
#define NTHR 512
#define LDS_BYTES 147456
#define LAS __attribute__((address_space(3)))

typedef unsigned short bf16_t;
typedef short bf16x8 __attribute__((ext_vector_type(8)));
typedef float f32x4 __attribute__((ext_vector_type(4)));
typedef unsigned u32x4 __attribute__((ext_vector_type(4)));
typedef unsigned u32x2 __attribute__((ext_vector_type(2)));

#define XB_TMO      128
#define XB_XCNT(j)  (256  + 64 * (j))
#define XB_XSUB(j)  (1280 + 64 * (j))
#define XB_XGEN(j)  (2304 + 64 * (j))
#define XB_TOP      3328
#define XB_TOPGEN   3392
#define XCD_BAR_WORDS 3456
#define XB_SPIN_CAP (1u << 18)
__device__ __forceinline__ unsigned xb_ld(unsigned* p)              { return __hip_atomic_load(p, __ATOMIC_RELAXED, __HIP_MEMORY_SCOPE_AGENT); }
__device__ __forceinline__ unsigned xb_add(unsigned* p, unsigned v) { return __hip_atomic_fetch_add(p, v, __ATOMIC_RELAXED, __HIP_MEMORY_SCOPE_AGENT); }
__device__ __forceinline__ unsigned xb_xcc_id() { return (unsigned)__builtin_amdgcn_s_getreg((3 << 11) | 20) & 0xFu; }
#define XB_SPIN(cond, bar) do { unsigned _sp = 0; while (cond) { __builtin_amdgcn_s_sleep(1); \
    if ((++_sp & 255u) == 0u) { if (xb_ld(&(bar)[XB_TMO])) break; if (_sp > XB_SPIN_CAP) { atomicAdd(&(bar)[XB_TMO], 1u); break; } } } } while (0)
struct XcdBarrier { unsigned* bar; unsigned x; volatile LAS unsigned* st; };
__device__ __forceinline__ XcdBarrier xcd_barrier_post(unsigned* bar, volatile LAS unsigned* st) {
    XcdBarrier b; b.bar = bar; b.x = xb_xcc_id(); b.st = st;
    if (threadIdx.x == 0) (void)xb_add(&bar[XB_XCNT(b.x)], 1u);
    return b;
}
__device__ __forceinline__ void xcd_barrier_complete(unsigned* bar, unsigned x, unsigned& nloc, unsigned& nx) {
    const unsigned G = gridDim.x * gridDim.y * gridDim.z;
    unsigned sum, cnt, mine, sp = 0u;
    for (;;) {
        sum = 0u; cnt = 0u; mine = 0u;
#pragma unroll
        for (unsigned j = 0; j < 16; ++j) { const unsigned c = xb_ld(&bar[XB_XCNT(j)]); sum += c; cnt += (c > 0u) ? 1u : 0u; mine = (j == x) ? c : mine; }
        if (sum == G) break;
        __builtin_amdgcn_s_sleep(1);
        if ((++sp & 255u) == 0u) { if (xb_ld(&bar[XB_TMO])) break; if (sp > XB_SPIN_CAP) { atomicAdd(&bar[XB_TMO], 1u); break; } }
    }
    nloc = mine > 0u ? mine : 1u; nx = cnt > 0u ? cnt : 1u;
}
__device__ __forceinline__ void xcd_barrier(const XcdBarrier& b) {
    asm volatile("s_waitcnt vmcnt(0)" ::: "memory");
    __syncthreads();
    if (threadIdx.x == 0) {
        unsigned* bar = b.bar;
        __builtin_amdgcn_s_waitcnt(0);
        unsigned nloc = b.st[0], nx = b.st[1];
        if (nloc == 0u) { xcd_barrier_complete(bar, b.x, nloc, nx); b.st[0] = nloc; b.st[1] = nx; }
        const unsigned old = xb_add(&bar[XB_XSUB(b.x)], 1u);
        const unsigned gen = old / nloc;
        if (old + 1u == (gen + 1u) * nloc) {
            __builtin_amdgcn_fence(__ATOMIC_RELEASE, "agent");
            asm volatile("s_waitcnt vmcnt(0)" ::: "memory");
            const unsigned og = xb_add(&bar[XB_TOP], 1u);
            const unsigned tg = og / nx;
            if (og + 1u == (tg + 1u) * nx) xb_add(&bar[XB_TOPGEN], 1u);
            else XB_SPIN(xb_ld(&bar[XB_TOPGEN]) == tg, bar);
            __builtin_amdgcn_fence(__ATOMIC_ACQUIRE, "agent");
            xb_add(&bar[XB_XGEN(b.x)], 1u);
            asm volatile("s_waitcnt vmcnt(0)" ::: "memory");
        } else {
            XB_SPIN(xb_ld(&bar[XB_XGEN(b.x)]) == gen, bar);
            __builtin_amdgcn_fence(__ATOMIC_ACQUIRE, "agent");
            asm volatile("s_waitcnt vmcnt(0)" ::: "memory");
        }
    }
    __syncthreads();
}

__device__ __forceinline__ unsigned short f2bf(float f) { unsigned u = __float_as_uint(f); u += 0x7FFFu + ((u >> 16) & 1u); return (unsigned short)(u >> 16); }
__device__ __forceinline__ float bf2f(unsigned short b) { return __uint_as_float(((unsigned)b) << 16); }
__device__ __forceinline__ unsigned pk2(float lo, float hi) { return (unsigned)f2bf(lo) | ((unsigned)f2bf(hi) << 16); }
__device__ __forceinline__ float sigmoidf_(float x) { return 1.0f / (1.0f + expf(-x)); }
__device__ __forceinline__ float siluf_(float x) { return x / (1.0f + expf(-x)); }
__device__ __forceinline__ float wave_sum(float v) {
#pragma unroll
    for (int o = 32; o >= 1; o >>= 1) v += __shfl_xor(v, o);
    return v;
}
__device__ __forceinline__ const float* uptr(const float* p) { const unsigned long long v = (unsigned long long)p;
    const unsigned lo = __builtin_amdgcn_readfirstlane((unsigned)v), hi = __builtin_amdgcn_readfirstlane((unsigned)(v >> 32)); return (const float*)(((unsigned long long)hi << 32) | lo); }
#define PT(k) uptr(ptab[k])
__device__ __forceinline__ int step_tok(int b, int dir, int i) {
    if (i < CTXL) { const int tt = dir ? (CTXL - 1 - i) : i; return NLAT + b * CTXL + tt; }
    const int j = i - CTXL; const int tt = dir ? (SEQ - 1 - j) : j; return b * SEQ + tt;
}
__device__ __forceinline__ void unpack8(const u32x4 w, float (&f)[8]) {
    f[0] = __uint_as_float(w.x << 16); f[1] = __uint_as_float(w.x & 0xFFFF0000u); f[2] = __uint_as_float(w.y << 16); f[3] = __uint_as_float(w.y & 0xFFFF0000u);
    f[4] = __uint_as_float(w.z << 16); f[5] = __uint_as_float(w.z & 0xFFFF0000u); f[6] = __uint_as_float(w.w << 16); f[7] = __uint_as_float(w.w & 0xFFFF0000u);
}

namespace pg8 {
constexpr int BM = 256, BK = 64, HALF = 128, HTB = HALF * BK * 2, STAGE_BYTES = 8 * HTB, NXCD = 8, WGM = 8;
__host__ __device__ __forceinline__ int lds_byte(int r, int c) { const int st = (r >> 4) * 2 + (c >> 5), rr = r & 15, cc = c & 31, ob = rr * 64 + cc * 2; return st * 1024 + (ob ^ (((ob >> 9) & 1) << 5)); }
__host__ __device__ __forceinline__ void stage_rc(int b, int& R, int& C) { const int st = b / 1024, sb = b % 1024, swz = sb ^ (((sb >> 9) & 1) << 5); R = (st >> 1) * 16 + swz / 64; C = (st & 1) * 32 + (swz % 64) / 2; }
__host__ __device__ __forceinline__ int perm32(int rho) { const int n = rho >> 4, i = rho & 15; return 8 * (i >> 2) + 4 * n + (i & 3); }
struct Unit { int pm, pn, z, k; long long ao, bo; };
struct Gemm { const bf16_t* A; const bf16_t* Bt; int lda, ldb, K; };

__device__ __forceinline__ void tile_of(int wgid, int nM, int nN, int& pm, int& pn) {
    const int nwg = nM * nN; { const int q = nwg / NXCD, r = nwg % NXCD, xcd = wgid % NXCD, off = wgid / NXCD; wgid = (xcd < r ? xcd * (q + 1) : r * (q + 1) + (xcd - r) * q) + off; }
    const int nig = WGM * nN, gid = wgid / nig, fm = gid * WGM, gsz = (nM - fm) < WGM ? (nM - fm) : WGM;
    pm = fm + ((wgid % nig) % gsz); pn = (wgid % nig) / gsz;
}
struct SchedStd {
    int nM, nN, G, c, lda, ldb;
    __device__ __forceinline__ bool next(int i, Unit& u) const { const long L = (long)i * G + c; if (L >= (long)nM * nN) return false; tile_of((int)L, nM, nN, u.pm, u.pn); u.z = 0; u.k = 0;
        u.ao = (long long)u.pm * BM * lda * 2; u.bo = (long long)u.pn * BM * ldb * 2; return true; }
    __device__ __forceinline__ void a_ready(const Unit&) const {}
    __device__ __forceinline__ void done(const Unit&) const {}
};
struct SchedBranch {
    int nM, nN, G, c;
    __device__ __forceinline__ bool next(int i, Unit& u) const { const long L = (long)(i >> 2) * G + c; if (L >= (long)nM * nN) return false; tile_of((int)L, nM, nN, u.pm, u.pn); u.z = 0; u.k = i & 3;
        u.ao = ((long long)u.pm * BM * DM + u.k * BW) * 2; u.bo = ((long long)u.k * DM + u.pn * BM) * BW * 2; return true; }
    __device__ __forceinline__ void a_ready(const Unit&) const {}
    __device__ __forceinline__ void done(const Unit&) const {}
};
struct SchedMoe {
    int nPm, nPn, G, c, lda, ldb, nBrows;
    __device__ __forceinline__ bool next(int i, Unit& u) const { const long L = (long)i * G + c; const int per = nPm * nPn; if (L >= (long)NEXP * per) return false; const int e = (int)(L / per), rem = (int)(L % per);
        u.z = e; u.k = 0; u.pm = rem % nPm; u.pn = rem / nPm; u.ao = ((long long)e * MOE_PAD + u.pm * BM) * lda * 2; u.bo = ((long long)e * nBrows + u.pn * BM) * ldb * 2; return true; }
    __device__ __forceinline__ void a_ready(const Unit&) const {}
    __device__ __forceinline__ void done(const Unit&) const {}
};

typedef f32x4 Acc[2][2][4][2];
template <class Epi, class Sched>
__device__ __forceinline__ void gemm_phase(LAS unsigned char* lds, const Gemm g, const Sched& S, const Epi& E) {
    int tid = threadIdx.x; asm volatile("" : "+v"(tid));
    const int wid = __builtin_amdgcn_readfirstlane(tid >> 6), lane = tid & 63, wr = wid >> 2, wc = wid & 3, fr = lane & 15, fq = lane >> 4;
    const int K = g.K, nt = K / BK;
    unsigned voffA[2], voffB[2];
#pragma unroll
    for (int i = 0; i < 2; ++i) { int R, C; stage_rc(tid * 16 + i * 8192, R, C); const int Rb = Epi::PERM ? ((R & ~31) + perm32(R & 31)) : R;
        voffA[i] = (unsigned)(R * g.lda + C) * 2u; voffB[i] = (unsigned)(Rb * g.ldb + C) * 2u; }
    const size_t kstep = (size_t)(BK * 2);
    const size_t hstepA = (size_t)HALF * g.lda * 2, hstepB = (size_t)HALF * g.ldb * 2;
    const unsigned ldsw = (unsigned)wid * 1024u;
    const int aoff = lds_byte(wr * 64 + fr, fq * 8), boff = lds_byte(wc * 32 + fr, fq * 8);
#define PG8_SA(b, h) (((b) * 2 + (h)) * HTB)
#define PG8_SB(b, h) ((4 + (b) * 2 + (h)) * HTB)
#define PG8_STAGE(bufoff, gbase, voff) do { _Pragma("unroll") for (int _i = 0; _i < 2; ++_i) \
        __builtin_amdgcn_global_load_lds((const unsigned*)((const char*)(gbase) + (voff)[_i]), (LAS unsigned*)(lds + (bufoff) + ldsw + _i * 8192), 16, 0, 0); } while (0)
#define PG8_LDA(dst, b, h) do { _Pragma("unroll") for (int m = 0; m < 4; ++m) _Pragma("unroll") for (int k = 0; k < 2; ++k) dst[m][k] = *(const LAS bf16x8*)(lds + PG8_SA(b, h) + aoff + m * 2048 + k * 1024); } while (0)
#define PG8_LDB(dst, b, h) do { _Pragma("unroll") for (int n = 0; n < 2; ++n) _Pragma("unroll") for (int k = 0; k < 2; ++k) dst[n][k] = *(const LAS bf16x8*)(lds + PG8_SB(b, h) + boff + n * 2048 + k * 1024); } while (0)
#define PG8_MMA(ai, bj, At, Bt) do { __builtin_amdgcn_s_setprio(1); _Pragma("unroll") for (int m = 0; m < 4; ++m) _Pragma("unroll") for (int n = 0; n < 2; ++n) _Pragma("unroll") for (int k = 0; k < 2; ++k) \
        acc[ai][bj][m][n] = __builtin_amdgcn_mfma_f32_16x16x32_bf16(Bt[n][k], At[m][k], acc[ai][bj][m][n], 0, 0, 0); __builtin_amdgcn_s_setprio(0); } while (0)
#define PG8_WAIT_V(n) asm volatile("s_waitcnt vmcnt(" #n ")" ::: "memory")
#define PG8_WAIT_L(n) asm volatile("s_waitcnt lgkmcnt(" #n ")" ::: "memory")
#define PG8_BAR __builtin_amdgcn_s_barrier()
#define PG8_SCHED __builtin_amdgcn_sched_barrier(0)
    Unit cur, nxt; int ui = 0;
    if (!S.next(0, cur)) return;
    Acc acc;
#pragma unroll
    for (int a = 0; a < 2; ++a)
#pragma unroll
        for (int b = 0; b < 2; ++b)
#pragma unroll
            for (int m = 0; m < 4; ++m)
#pragma unroll
                for (int n = 0; n < 2; ++n) acc[a][b][m][n] = (f32x4){0.f, 0.f, 0.f, 0.f};
    bf16x8 At[4][2], B0[2][2], B1[2][2];
    const char* cA = (const char*)g.A + cur.ao; const char* cB = (const char*)g.Bt + cur.bo;
    S.a_ready(cur);
    PG8_STAGE(PG8_SB(0, 0), cB, voffB); PG8_STAGE(PG8_SA(0, 0), cA, voffA); PG8_STAGE(PG8_SB(0, 1), cB + hstepB, voffB); PG8_STAGE(PG8_SA(0, 1), cA + hstepA, voffA);
    if (wr == 1) PG8_BAR;
    PG8_WAIT_V(4); PG8_BAR;
    PG8_STAGE(PG8_SB(1, 0), cB + kstep, voffB); PG8_STAGE(PG8_SA(1, 0), cA + kstep, voffA); PG8_STAGE(PG8_SB(1, 1), cB + hstepB + kstep, voffB);
    PG8_WAIT_V(6); PG8_BAR;
    for (;;) {
        const bool has_next = S.next(ui + 1, nxt);
        const char* nA = has_next ? (const char*)g.A + nxt.ao : cA; const char* nB = has_next ? (const char*)g.Bt + nxt.bo : cB;
        for (int t = 0; t < nt; t += 2) {
            const bool last = (t == nt - 2);
            const char* a1 = cA + (size_t)(t + 1) * kstep;
            const char* a2 = last ? nA : cA + (size_t)(t + 2) * kstep; const char* b2 = last ? nB : cB + (size_t)(t + 2) * kstep;
            const char* a3 = a2 + kstep; const char* b3 = b2 + kstep;
            if (last && has_next) S.a_ready(nxt);
            PG8_LDB(B0, 0, 0); PG8_SCHED; PG8_LDA(At, 0, 0); PG8_STAGE(PG8_SA(1, 1), a1 + hstepA, voffA);
            PG8_WAIT_L(8); PG8_BAR; PG8_WAIT_L(0); PG8_MMA(0, 0, At, B0); PG8_BAR; PG8_SCHED;
            PG8_LDB(B1, 0, 1); PG8_STAGE(PG8_SB(0, 0), b2, voffB);
            PG8_BAR; PG8_WAIT_L(0); PG8_MMA(0, 1, At, B1); PG8_BAR;
            PG8_LDA(At, 0, 1); PG8_STAGE(PG8_SA(0, 0), a2, voffA);
            PG8_BAR; PG8_WAIT_L(0); PG8_MMA(1, 0, At, B0); PG8_BAR; PG8_SCHED;
            PG8_STAGE(PG8_SB(0, 1), b2 + hstepB, voffB);
            PG8_WAIT_V(6); PG8_BAR; PG8_MMA(1, 1, At, B1); PG8_BAR;
            PG8_LDB(B0, 1, 0); PG8_SCHED; PG8_LDA(At, 1, 0); PG8_STAGE(PG8_SA(0, 1), a2 + hstepA, voffA);
            PG8_WAIT_L(8); PG8_BAR; PG8_WAIT_L(0); PG8_MMA(0, 0, At, B0); PG8_BAR; PG8_SCHED;
            PG8_LDB(B1, 1, 1); PG8_STAGE(PG8_SB(1, 0), b3, voffB);
            PG8_BAR; PG8_WAIT_L(0); PG8_MMA(0, 1, At, B1); PG8_BAR;
            PG8_LDA(At, 1, 1); PG8_STAGE(PG8_SA(1, 0), a3, voffA);
            PG8_BAR; PG8_WAIT_L(0); PG8_MMA(1, 0, At, B0); PG8_BAR; PG8_SCHED;
            PG8_STAGE(PG8_SB(1, 1), b3 + hstepB, voffB);
            PG8_WAIT_V(6); PG8_BAR; PG8_MMA(1, 1, At, B1); PG8_BAR;
        }
        const bool keep = E(acc, cur, wr, wc, fr, fq); S.done(cur);
        if (!has_next) break;
        if (!keep) {
#pragma unroll
        for (int a = 0; a < 2; ++a)
#pragma unroll
            for (int b = 0; b < 2; ++b)
#pragma unroll
                for (int m = 0; m < 4; ++m)
#pragma unroll
                    for (int n = 0; n < 2; ++n) acc[a][b][m][n] = (f32x4){0.f, 0.f, 0.f, 0.f};
        }
        cur = nxt; cA = nA; cB = nB; ++ui;
    }
    PG8_WAIT_V(0);
    if (wr == 0) PG8_BAR;
    PG8_BAR;
#undef PG8_SA
#undef PG8_SB
#undef PG8_STAGE
#undef PG8_LDA
#undef PG8_LDB
#undef PG8_MMA
#undef PG8_WAIT_V
#undef PG8_WAIT_L
#undef PG8_BAR
#undef PG8_SCHED
}

struct EpiBf16Store {
    static constexpr bool PERM = true;
    bf16_t* O; int ldc;
    __device__ __forceinline__ bool operator()(Acc& acc, const Unit& u, int wr, int wc, int fr, int fq) const {
        const int row0 = u.pm * BM + wr * 64 + fr, col0 = u.pn * BM + wc * 32 + 8 * fq;
#pragma unroll
        for (int ai = 0; ai < 2; ++ai)
#pragma unroll
            for (int m = 0; m < 4; ++m) { bf16_t* rowp = O + (size_t)(row0 + ai * HALF + m * 16) * ldc + col0;
#pragma unroll
                for (int bj = 0; bj < 2; ++bj) { const f32x4 v0 = acc[ai][bj][m][0], v1 = acc[ai][bj][m][1];
                    u32x4 w; w.x = pk2(v0[0], v0[1]); w.y = pk2(v0[2], v0[3]); w.z = pk2(v1[0], v1[1]); w.w = pk2(v1[2], v1[3]);
                    *(u32x4*)(rowp + bj * HALF) = w; } }
        return false;
    }
};
struct EpiGlu {
    static constexpr bool PERM = true;
    const bf16_t* GG; const float* bias; bf16_t* Y4;
    __device__ __forceinline__ bool operator()(Acc& acc, const Unit& u, int wr, int wc, int fr, int fq) const {
        const int row0 = u.pm * BM + wr * 64 + fr, col0 = u.pn * BM + wc * 32 + 8 * fq;
#pragma unroll
        for (int bj = 0; bj < 2; ++bj) { const int col = col0 + bj * HALF; const f32x4 b0 = *(const f32x4*)(bias + col), b1 = *(const f32x4*)(bias + col + 4);
#pragma unroll
            for (int ai = 0; ai < 2; ++ai)
#pragma unroll
                for (int m = 0; m < 4; ++m) { const size_t row = (size_t)(row0 + ai * HALF + m * 16);
                    float gg[8]; unpack8(*(const u32x4*)(GG + row * BW + col), gg);
                    const f32x4 v0 = acc[ai][bj][m][0] + b0, v1 = acc[ai][bj][m][1] + b1;
                    u32x4 w; w.x = pk2(gg[0] * sigmoidf_(v0[0]), gg[1] * sigmoidf_(v0[1])); w.y = pk2(gg[2] * sigmoidf_(v0[2]), gg[3] * sigmoidf_(v0[3]));
                    w.z = pk2(gg[4] * sigmoidf_(v1[0]), gg[5] * sigmoidf_(v1[1])); w.w = pk2(gg[6] * sigmoidf_(v1[2]), gg[7] * sigmoidf_(v1[3]));
                    *(u32x4*)(Y4 + row * DM + 1024 + col) = w; } }
        return false;
    }
};
struct EpiBranch {
    static constexpr bool PERM = true;
    const bf16_t* P; bf16_t* ACCb;
    __device__ __forceinline__ bool operator()(Acc& acc, const Unit& u, int wr, int wc, int fr, int fq) const {
        const int row0 = u.pm * BM + wr * 64 + fr, col0 = u.pn * BM + wc * 32 + 8 * fq; const int k = u.k;
#pragma unroll
        for (int ai = 0; ai < 2; ++ai)
#pragma unroll
            for (int m = 0; m < 4; ++m) { const size_t row = (size_t)(row0 + ai * HALF + m * 16);
#pragma unroll
                for (int bj = 0; bj < 2; ++bj) { const int col = col0 + bj * HALF;
                    float g0[8]; unpack8(*(const u32x4*)(P + row * LDP + GATE_OFF + k * DM + col), g0);
                    float s[8];
                    if (k < 3) { float g1[8]; unpack8(*(const u32x4*)(P + row * LDP + GATE_OFF + (k + 1) * DM + col), g1);
#pragma unroll
                        for (int j = 0; j < 8; ++j) s[j] = (1.0f + __expf(-g1[j])) / (1.0f + __expf(-g0[j])); }
                    else {
#pragma unroll
                        for (int j = 0; j < 8; ++j) s[j] = 1.0f / (1.0f + __expf(-g0[j])); }
                    f32x4 v0 = acc[ai][bj][m][0], v1 = acc[ai][bj][m][1];
                    v0[0] *= s[0]; v0[1] *= s[1]; v0[2] *= s[2]; v0[3] *= s[3]; v1[0] *= s[4]; v1[1] *= s[5]; v1[2] *= s[6]; v1[3] *= s[7];
                    if (k < 3) { acc[ai][bj][m][0] = v0; acc[ai][bj][m][1] = v1; }
                    else { u32x4 w; w.x = pk2(v0[0], v0[1]); w.y = pk2(v0[2], v0[3]); w.z = pk2(v1[0], v1[1]); w.w = pk2(v1[2], v1[3]); *(u32x4*)(ACCb + row * DM + col) = w; } } }
        return k < 3;
    }
};
struct EpiResid {
    static constexpr bool PERM = false;
    float* XS; const float* MODl; int gidx;
    __device__ __forceinline__ bool operator()(Acc& acc, const Unit& u, int wr, int wc, int fr, int fq) const {
        const int row0 = u.pm * BM + wr * 64 + fr, col0 = u.pn * BM + wc * 32 + 4 * fq;
        const int r = (u.pm * BM) < NLAT ? (u.pm * BM) / SEQ : 4;
        const float* mg = MODl + (size_t)(r * 6 + gidx) * DM;
#pragma unroll
        for (int bj = 0; bj < 2; ++bj)
#pragma unroll
            for (int n = 0; n < 2; ++n) { const int col = col0 + bj * HALF + n * 16; const f32x4 gm = *(const f32x4*)(mg + col);
#pragma unroll
                for (int ai = 0; ai < 2; ++ai)
#pragma unroll
                    for (int m = 0; m < 4; ++m) { float* p = XS + (size_t)(row0 + ai * HALF + m * 16) * DM + col; *(f32x4*)p = *(const f32x4*)p + gm * acc[ai][bj][m][n]; } }
        return false;
    }
};
struct EpiMoe1 {
    static constexpr bool PERM = false;
    bf16_t* HID;
    __device__ __forceinline__ bool operator()(Acc& acc, const Unit& u, int wr, int wc, int fr, int fq) const {
        const size_t row0 = (size_t)u.z * MOE_PAD + u.pm * BM + wr * 64 + fr; const int col0 = u.pn * HALF + wc * 16 + 4 * fq;
#pragma unroll
        for (int ai = 0; ai < 2; ++ai)
#pragma unroll
            for (int m = 0; m < 4; ++m)
#pragma unroll
                for (int bj = 0; bj < 2; ++bj) { const f32x4 gt = acc[ai][bj][m][0], up = acc[ai][bj][m][1];
                    u32x2 w; w.x = pk2(siluf_(gt[0]) * up[0], siluf_(gt[1]) * up[1]); w.y = pk2(siluf_(gt[2]) * up[2], siluf_(gt[3]) * up[3]);
                    *(u32x2*)(HID + (row0 + ai * HALF + m * 16) * DEXP + col0 + bj * 64) = w; }
        return false;
    }
};
struct EpiMoe2 {
    static constexpr bool PERM = false;
    float* XS; const float* MODl; const int* ROWTOK; const float* ROWGATE;
    __device__ __forceinline__ bool operator()(Acc& acc, const Unit& u, int wr, int wc, int fr, int fq) const {
        const int rowb = u.z * MOE_PAD + u.pm * BM + wr * 64 + fr; const int col0 = u.pn * BM + wc * 32 + 4 * fq;
#pragma unroll
        for (int ai = 0; ai < 2; ++ai)
#pragma unroll
            for (int m = 0; m < 4; ++m) { const int R = rowb + ai * HALF + m * 16; const int tok = ROWTOK[R];
                if (tok >= 0) { const float gt = ROWGATE[R]; const int r = tok < NLAT ? tok / SEQ : 4; const float* mg = MODl + (size_t)(r * 6 + 5) * DM; float* xr = XS + (size_t)tok * DM;
#pragma unroll
                    for (int bj = 0; bj < 2; ++bj)
#pragma unroll
                        for (int n = 0; n < 2; ++n) { const int col = col0 + bj * HALF + n * 16; const f32x4 gm = *(const f32x4*)(mg + col); const f32x4 v = acc[ai][bj][m][n];
                            atomicAdd(xr + col + 0, gm[0] * gt * v[0]); atomicAdd(xr + col + 1, gm[1] * gt * v[1]); atomicAdd(xr + col + 2, gm[2] * gt * v[2]); atomicAdd(xr + col + 3, gm[3] * gt * v[3]); } } }
        return false;
    }
};
}


__device__ __forceinline__ float wave_scan_incl(float v, int lane) {
#pragma unroll
    for (int o = 1; o < 64; o <<= 1) { const float t = __shfl_up(v, o); if (lane >= o) v += t; }
    return v;
}
__device__ __forceinline__ float wave_scanmax_incl(float v, int lane) {
#pragma unroll
    for (int o = 1; o < 64; o <<= 1) { const float t = __shfl_up(v, o); if (lane >= o) v = fmaxf(v, t); }
    return v;
}
__device__ __forceinline__ float wave_max(float v) {
#pragma unroll
    for (int o = 32; o >= 1; o >>= 1) v = fmaxf(v, __shfl_xor(v, o));
    return v;
}
__device__ __forceinline__ void unpack8h(const u32x4 w, bf16_t (&h)[8]) {
    h[0] = (bf16_t)(w.x & 0xFFFFu); h[1] = (bf16_t)(w.x >> 16); h[2] = (bf16_t)(w.y & 0xFFFFu); h[3] = (bf16_t)(w.y >> 16);
    h[4] = (bf16_t)(w.z & 0xFFFFu); h[5] = (bf16_t)(w.z >> 16); h[6] = (bf16_t)(w.w & 0xFFFFu); h[7] = (bf16_t)(w.w >> 16);
}

__device__ __forceinline__ void mlstm_state_pass(const int chain, const bf16_t* __restrict__ Pm, const bf16_t* __restrict__ QKb, const float* __restrict__ gate_b,
                                                 bf16_t* __restrict__ CST, float* __restrict__ NST, float* __restrict__ MST, unsigned char* shm, const int tid) {
    const int dir = chain & 1, h = (chain >> 1) & 3, b = chain >> 3, lane = tid & 63, w = tid >> 6;
    bf16_t* VT = (bf16_t*)shm; bf16_t* KT = (bf16_t*)(shm + 36864); float* wsb = (float*)(shm + 73728);
    const float gbi = gate_b[(dir * 2 + 0) * 4 + h], gbf = gate_b[(dir * 2 + 1) * 4 + h];
    f32x4 acc[8];
#pragma unroll
    for (int j = 0; j < 8; ++j) acc[j] = (f32x4){0.f, 0.f, 0.f, 0.f};
    float nvec = 0.f, m = 0.f;
    __syncthreads();
    for (int c = 0; c < 68; ++c) {
        const int buf = c & 1;
        const size_t tokl = (size_t)step_tok(b, dir, c * 64 + lane);
        const float ig = bf2f(Pm[tokl * LDP + ML_OFF + 2048 + (dir * 2 + 0) * 4 + h]) + gbi;
        const float fg = bf2f(Pm[tokl * LDP + ML_OFF + 2048 + (dir * 2 + 1) * 4 + h]) + gbf;
        const float lf = fminf(fg, 0.f) - log1pf(expf(-fabsf(fg)));
        const float bcs = wave_scan_incl(lf, lane);
        const float blast = __shfl(bcs, 63);
        const float beta = wave_max(blast - bcs + ig);
        const float mo = fmaxf(m + blast, beta);
        const float wsv = expf(blast - bcs + ig - mo); const float dec = expf(blast + m - mo);
        {   bf16_t* cs = CST + (size_t)(chain * 68 + c) * 128 * 128; const int e = 16 * w + (lane & 15);
#pragma unroll
            for (int j = 0; j < 8; ++j) { const int d0 = 16 * j + (lane >> 4) * 4; u32x2 pk; pk.x = pk2(acc[j][0], acc[j][1]); pk.y = pk2(acc[j][2], acc[j][3]); *(u32x2*)(cs + (size_t)e * 128 + d0) = pk; }
            if (tid < 128) NST[(size_t)(chain * 68 + c) * 128 + tid] = nvec;
            if (tid == 0) MST[chain * 68 + c] = m; }
        if (w == 0) wsb[buf * 64 + lane] = wsv;
#pragma unroll
        for (int i = 0; i < 2; ++i) { const int pid = tid + i * 512; const int s = pid >> 4, x0 = (pid & 15) * 8; const size_t toks = (size_t)step_tok(b, dir, c * 64 + s); const float wss = __shfl(wsv, s);
            float f[8]; unpack8(*(const u32x4*)(Pm + toks * LDP + ML_OFF + 1024 + h * 128 + x0), f);
            bf16_t kh[8]; unpack8h(*(const u32x4*)(QKb + toks * 1024 + 512 + h * 128 + x0), kh);
#pragma unroll
            for (int j = 0; j < 8; ++j) { VT[(buf * 128 + x0 + j) * 72 + s] = f2bf(f[j] * wss); KT[(buf * 128 + x0 + j) * 72 + s] = kh[j]; } }
        __syncthreads();
        if (tid < 128) { float sa = 0.f; const bf16_t* kr = KT + (buf * 128 + tid) * 72;
#pragma unroll 8
            for (int s = 0; s < 64; ++s) sa += wsb[buf * 64 + s] * bf2f(kr[s]);
            nvec = dec * nvec + sa; }
#pragma unroll
        for (int j = 0; j < 8; ++j) acc[j] = acc[j] * dec;
#pragma unroll
        for (int ks = 0; ks < 2; ++ks) { const bf16x8 vfrag = *(const bf16x8*)(VT + (buf * 128 + 16 * w + (lane & 15)) * 72 + ks * 32 + (lane >> 4) * 8);
#pragma unroll
            for (int j = 0; j < 8; ++j) { const bf16x8 kfrag = *(const bf16x8*)(KT + (buf * 128 + 16 * j + (lane & 15)) * 72 + ks * 32 + (lane >> 4) * 8);
                acc[j] = __builtin_amdgcn_mfma_f32_16x16x32_bf16(kfrag, vfrag, acc[j], 0, 0, 0); } }
        m = mo;
    }
}
__device__ __forceinline__ void mlstm_out_item(const int chain, const int c, const bf16_t* __restrict__ Pm, const bf16_t* __restrict__ QKb, const float* __restrict__ gate_b,
                                               const bf16_t* __restrict__ CST, const float* __restrict__ NST, const float* __restrict__ MST, float* __restrict__ Hout, unsigned char* shm, const int tid) {
    const int dir = chain & 1, h = (chain >> 1) & 3, b = chain >> 3, lane = tid & 63, w = tid >> 6;
    bf16_t* Qs = (bf16_t*)shm; bf16_t* Ks = (bf16_t*)(shm + 17408); bf16_t* VT = (bf16_t*)(shm + 34816); bf16_t* Cs = (bf16_t*)(shm + 53248); bf16_t* Ss = (bf16_t*)(shm + 88064);
    float* sc = (float*)(shm + 97280);
    __syncthreads();
#pragma unroll
    for (int i = 0; i < 2; ++i) { const int pid = tid + i * 512; const int s = pid >> 4, x0 = (pid & 15) * 8; const size_t toks = (size_t)step_tok(b, dir, c * 64 + s);
        *(u32x4*)(Qs + s * 136 + x0) = *(const u32x4*)(QKb + toks * 1024 + h * 128 + x0);
        *(u32x4*)(Ks + s * 136 + x0) = *(const u32x4*)(QKb + toks * 1024 + 512 + h * 128 + x0);
        bf16_t vh[8]; unpack8h(*(const u32x4*)(Pm + toks * LDP + ML_OFF + 1024 + h * 128 + x0), vh);
#pragma unroll
        for (int j = 0; j < 8; ++j) VT[(x0 + j) * 72 + s] = vh[j]; }
#pragma unroll
    for (int i = 0; i < 4; ++i) { const int pid = tid + i * 512; const int e = pid >> 4, x0 = (pid & 15) * 8;
        *(u32x4*)(Cs + e * 136 + x0) = *(const u32x4*)(CST + ((size_t)(chain * 68 + c) * 128 + e) * 128 + x0); }
    if (tid < 128) sc[384 + tid] = NST[(size_t)(chain * 68 + c) * 128 + tid];
    if (w == 0) {
        const float gbi = gate_b[(dir * 2 + 0) * 4 + h], gbf = gate_b[(dir * 2 + 1) * 4 + h];
        const size_t tokl = (size_t)step_tok(b, dir, c * 64 + lane);
        const float ig = bf2f(Pm[tokl * LDP + ML_OFF + 2048 + (dir * 2 + 0) * 4 + h]) + gbi;
        const float fg = bf2f(Pm[tokl * LDP + ML_OFF + 2048 + (dir * 2 + 1) * 4 + h]) + gbf;
        const float lf = fminf(fg, 0.f) - log1pf(expf(-fabsf(fg)));
        const float bcs = wave_scan_incl(lf, lane); const float gsv = ig - bcs; const float pm = wave_scanmax_incl(gsv, lane);
        const float m_in = MST[chain * 68 + c]; const float mt = bcs + fmaxf(m_in, pm);
        sc[lane] = bcs; sc[64 + lane] = gsv; sc[128 + lane] = mt; sc[192 + lane] = expf(bcs + m_in - mt); sc[256 + lane] = expf(-mt); sc[320 + lane] = 0.f;
    }
    __syncthreads();
    const int tt = w >> 1;
    {   f32x4 aS[2] = {(f32x4){0.f, 0.f, 0.f, 0.f}, (f32x4){0.f, 0.f, 0.f, 0.f}};
#pragma unroll
        for (int ks = 0; ks < 4; ++ks) { const bf16x8 af = *(const bf16x8*)(Qs + (16 * tt + (lane & 15)) * 136 + ks * 32 + (lane >> 4) * 8);
#pragma unroll
            for (int i = 0; i < 2; ++i) { const int st = (w & 1) * 2 + i; const bf16x8 bfr = *(const bf16x8*)(Ks + (16 * st + (lane & 15)) * 136 + ks * 32 + (lane >> 4) * 8);
                aS[i] = __builtin_amdgcn_mfma_f32_16x16x32_bf16(af, bfr, aS[i], 0, 0, 0); } }
        float rs[4] = {0.f, 0.f, 0.f, 0.f};
#pragma unroll
        for (int i = 0; i < 2; ++i) { const int s = 16 * ((w & 1) * 2 + i) + (lane & 15); const float gsv = sc[64 + s];
#pragma unroll
            for (int q = 0; q < 4; ++q) { const int t = 16 * tt + (lane >> 4) * 4 + q; const float val = (s <= t) ? aS[i][q] * expf(sc[t] + gsv - sc[128 + t]) : 0.f; Ss[t * 72 + s] = f2bf(val); rs[q] += val; } }
#pragma unroll
        for (int q = 0; q < 4; ++q) { float r = rs[q]; r += __shfl_xor(r, 1); r += __shfl_xor(r, 2); r += __shfl_xor(r, 4); r += __shfl_xor(r, 8);
            if ((lane & 15) == 0) atomicAdd(&sc[320 + 16 * tt + (lane >> 4) * 4 + q], r); }
        {   const int t = tid >> 3, part = tid & 7; float dot = 0.f;
#pragma unroll
            for (int j = 0; j < 16; ++j) dot += bf2f(Qs[t * 136 + part * 16 + j]) * sc[384 + part * 16 + j];
            dot += __shfl_xor(dot, 1); dot += __shfl_xor(dot, 2); dot += __shfl_xor(dot, 4);
            if (part == 0) atomicAdd(&sc[320 + t], sc[192 + t] * dot); }
    }
    __syncthreads();
    {   f32x4 aN[4];
#pragma unroll
        for (int i = 0; i < 4; ++i) aN[i] = (f32x4){0.f, 0.f, 0.f, 0.f};
#pragma unroll
        for (int ks = 0; ks < 4; ++ks) { const bf16x8 af = *(const bf16x8*)(Qs + (16 * tt + (lane & 15)) * 136 + ks * 32 + (lane >> 4) * 8);
#pragma unroll
            for (int i = 0; i < 4; ++i) { const int et = (w & 1) * 4 + i; const bf16x8 bfr = *(const bf16x8*)(Cs + (16 * et + (lane & 15)) * 136 + ks * 32 + (lane >> 4) * 8);
                aN[i] = __builtin_amdgcn_mfma_f32_16x16x32_bf16(af, bfr, aN[i], 0, 0, 0); } }
#pragma unroll
        for (int q = 0; q < 4; ++q) { const float it = sc[192 + 16 * tt + (lane >> 4) * 4 + q];
#pragma unroll
            for (int i = 0; i < 4; ++i) aN[i][q] *= it; }
#pragma unroll
        for (int ks = 0; ks < 2; ++ks) { const bf16x8 af = *(const bf16x8*)(Ss + (16 * tt + (lane & 15)) * 72 + ks * 32 + (lane >> 4) * 8);
#pragma unroll
            for (int i = 0; i < 4; ++i) { const int et = (w & 1) * 4 + i; const bf16x8 bfr = *(const bf16x8*)(VT + (16 * et + (lane & 15)) * 72 + ks * 32 + (lane >> 4) * 8);
                aN[i] = __builtin_amdgcn_mfma_f32_16x16x32_bf16(af, bfr, aN[i], 0, 0, 0); } }
#pragma unroll
        for (int q = 0; q < 4; ++q) { const int t = 16 * tt + (lane >> 4) * 4 + q; const size_t tokt = (size_t)step_tok(b, dir, c * 64 + t); const float dn = fmaxf(fabsf(sc[320 + t]), sc[256 + t]);
#pragma unroll
            for (int i = 0; i < 4; ++i) { const int e = 16 * ((w & 1) * 4 + i) + (lane & 15); Hout[tokt * BW + h * 128 + e] = aN[i][q] / dn; } }
    }
}


__device__ __forceinline__ void ssd_state_pass(const int chain, const bf16_t* __restrict__ Pm, const bf16_t* __restrict__ XBb, const float Aa, const float dtb,
                                               bf16_t* __restrict__ SSTb, unsigned char* shm, const int tid) {
    const int dir = chain & 1, h = (chain >> 1) & 7, b = chain >> 4, grp = h >> 2, lane = tid & 63, w = tid >> 6;
    bf16_t* BT = (bf16_t*)shm; bf16_t* XT = (bf16_t*)(shm + 36864);
    f32x4 acc[4];
#pragma unroll
    for (int j = 0; j < 4; ++j) acc[j] = (f32x4){0.f, 0.f, 0.f, 0.f};
    __syncthreads();
    for (int c = 0; c < 68; ++c) {
        const int buf = c & 1;
        const size_t tokl = (size_t)step_tok(b, dir, c * 64 + lane);
        const float xv = bf2f(Pm[tokl * LDP + SSD_OFF + 1536 + dir * 8 + h]) + dtb; const float dtv = xv > 20.f ? xv : log1pf(expf(xv));
        const float cs = wave_scan_incl(dtv * Aa, lane); const float cl = __shfl(cs, 63);
        const float scl = dtv * expf(cl - cs); const float dec = expf(cl);
        {   bf16_t* ss = SSTb + (size_t)(chain * 68 + c) * 64 * 128; const int p = 16 * (w & 3) + (lane & 15);
#pragma unroll
            for (int j = 0; j < 4; ++j) { const int n0 = 16 * ((w >> 2) * 4 + j) + (lane >> 4) * 4; u32x2 pk; pk.x = pk2(acc[j][0], acc[j][1]); pk.y = pk2(acc[j][2], acc[j][3]); *(u32x2*)(ss + (size_t)p * 128 + n0) = pk; } }
#pragma unroll
        for (int i = 0; i < 2; ++i) { const int pid = tid + i * 512; const int s = pid >> 4, x0 = (pid & 15) * 8; const size_t toks = (size_t)step_tok(b, dir, c * 64 + s);
            bf16_t bh[8]; unpack8h(*(const u32x4*)(XBb + toks * 1024 + 512 + grp * 128 + x0), bh);
#pragma unroll
            for (int j = 0; j < 8; ++j) BT[(buf * 128 + x0 + j) * 72 + s] = bh[j]; }
        {   const int s = tid >> 3, x0 = (tid & 7) * 8; const size_t toks = (size_t)step_tok(b, dir, c * 64 + s); const float sv = __shfl(scl, s);
            float f[8]; unpack8(*(const u32x4*)(XBb + toks * 1024 + h * 64 + x0), f);
#pragma unroll
            for (int j = 0; j < 8; ++j) XT[(buf * 64 + x0 + j) * 72 + s] = f2bf(f[j] * sv); }
        __syncthreads();
#pragma unroll
        for (int j = 0; j < 4; ++j) acc[j] = acc[j] * dec;
#pragma unroll
        for (int ks = 0; ks < 2; ++ks) { const bf16x8 xfrag = *(const bf16x8*)(XT + (buf * 64 + 16 * (w & 3) + (lane & 15)) * 72 + ks * 32 + (lane >> 4) * 8);
#pragma unroll
            for (int j = 0; j < 4; ++j) { const bf16x8 bfrag = *(const bf16x8*)(BT + (buf * 128 + 16 * ((w >> 2) * 4 + j) + (lane & 15)) * 72 + ks * 32 + (lane >> 4) * 8);
                acc[j] = __builtin_amdgcn_mfma_f32_16x16x32_bf16(bfrag, xfrag, acc[j], 0, 0, 0); } }
    }
}
__device__ __forceinline__ void ssd_out_item(const int chain, const int c, const bf16_t* __restrict__ Pm, const bf16_t* __restrict__ XBb, const float Aa, const float dtb,
                                             const bf16_t* __restrict__ SSTb, float* __restrict__ Yout, unsigned char* shm, const int tid) {
    const int dir = chain & 1, h = (chain >> 1) & 7, b = chain >> 4, grp = h >> 2, lane = tid & 63, w = tid >> 6;
    bf16_t* Cs = (bf16_t*)shm; bf16_t* Bs = (bf16_t*)(shm + 17408); bf16_t* XT = (bf16_t*)(shm + 34816); bf16_t* Sin = (bf16_t*)(shm + 44032); bf16_t* Gs = (bf16_t*)(shm + 61440);
    float* sc = (float*)(shm + 70656);
    __syncthreads();
#pragma unroll
    for (int i = 0; i < 2; ++i) { const int pid = tid + i * 512; const int s = pid >> 4, x0 = (pid & 15) * 8; const size_t toks = (size_t)step_tok(b, dir, c * 64 + s);
        *(u32x4*)(Bs + s * 136 + x0) = *(const u32x4*)(XBb + toks * 1024 + 512 + grp * 128 + x0);
        *(u32x4*)(Cs + s * 136 + x0) = *(const u32x4*)(XBb + toks * 1024 + 768 + grp * 128 + x0);
        const int p = pid >> 4;
        *(u32x4*)(Sin + p * 136 + x0) = *(const u32x4*)(SSTb + ((size_t)(chain * 68 + c) * 64 + p) * 128 + x0); }
    {   const int s = tid >> 3, x0 = (tid & 7) * 8; const size_t toks = (size_t)step_tok(b, dir, c * 64 + s);
        bf16_t xh[8]; unpack8h(*(const u32x4*)(XBb + toks * 1024 + h * 64 + x0), xh);
#pragma unroll
        for (int j = 0; j < 8; ++j) XT[(x0 + j) * 72 + s] = xh[j]; }
    if (w == 0) { const size_t tokl = (size_t)step_tok(b, dir, c * 64 + lane);
        const float xv = bf2f(Pm[tokl * LDP + SSD_OFF + 1536 + dir * 8 + h]) + dtb; const float dtv = xv > 20.f ? xv : log1pf(expf(xv));
        sc[lane] = wave_scan_incl(dtv * Aa, lane); sc[64 + lane] = dtv; }
    __syncthreads();
    {   const int lt = w >> 1;
        f32x4 aG[2] = {(f32x4){0.f, 0.f, 0.f, 0.f}, (f32x4){0.f, 0.f, 0.f, 0.f}};
#pragma unroll
        for (int ks = 0; ks < 4; ++ks) { const bf16x8 af = *(const bf16x8*)(Cs + (16 * lt + (lane & 15)) * 136 + ks * 32 + (lane >> 4) * 8);
#pragma unroll
            for (int i = 0; i < 2; ++i) { const int st = (w & 1) * 2 + i; const bf16x8 bfr = *(const bf16x8*)(Bs + (16 * st + (lane & 15)) * 136 + ks * 32 + (lane >> 4) * 8);
                aG[i] = __builtin_amdgcn_mfma_f32_16x16x32_bf16(af, bfr, aG[i], 0, 0, 0); } }
#pragma unroll
        for (int i = 0; i < 2; ++i) { const int s = 16 * ((w & 1) * 2 + i) + (lane & 15); const float css = sc[s], dts = sc[64 + s];
#pragma unroll
            for (int q = 0; q < 4; ++q) { const int t = 16 * lt + (lane >> 4) * 4 + q; const float val = (s <= t) ? aG[i][q] * expf(sc[t] - css) * dts : 0.f; Gs[t * 72 + s] = f2bf(val); } }
    }
    __syncthreads();
    {   const int lt = w >> 1;
        f32x4 aY[2] = {(f32x4){0.f, 0.f, 0.f, 0.f}, (f32x4){0.f, 0.f, 0.f, 0.f}};
#pragma unroll
        for (int ks = 0; ks < 4; ++ks) { const bf16x8 af = *(const bf16x8*)(Cs + (16 * lt + (lane & 15)) * 136 + ks * 32 + (lane >> 4) * 8);
#pragma unroll
            for (int i = 0; i < 2; ++i) { const int pt = (w & 1) * 2 + i; const bf16x8 bfr = *(const bf16x8*)(Sin + (16 * pt + (lane & 15)) * 136 + ks * 32 + (lane >> 4) * 8);
                aY[i] = __builtin_amdgcn_mfma_f32_16x16x32_bf16(af, bfr, aY[i], 0, 0, 0); } }
#pragma unroll
        for (int q = 0; q < 4; ++q) { const float ec = expf(sc[16 * lt + (lane >> 4) * 4 + q]); aY[0][q] *= ec; aY[1][q] *= ec; }
#pragma unroll
        for (int ks = 0; ks < 2; ++ks) { const bf16x8 af = *(const bf16x8*)(Gs + (16 * lt + (lane & 15)) * 72 + ks * 32 + (lane >> 4) * 8);
#pragma unroll
            for (int i = 0; i < 2; ++i) { const int pt = (w & 1) * 2 + i; const bf16x8 bfr = *(const bf16x8*)(XT + (16 * pt + (lane & 15)) * 72 + ks * 32 + (lane >> 4) * 8);
                aY[i] = __builtin_amdgcn_mfma_f32_16x16x32_bf16(af, bfr, aY[i], 0, 0, 0); } }
#pragma unroll
        for (int q = 0; q < 4; ++q) { const int t = 16 * lt + (lane >> 4) * 4 + q; const size_t tokt = (size_t)step_tok(b, dir, c * 64 + t);
#pragma unroll
            for (int i = 0; i < 2; ++i) { const int p = 16 * ((w & 1) * 2 + i) + (lane & 15); Yout[tokt * BW + h * 64 + p] = aY[i][q]; } }
    }
}


#define FIDX(i) ((i) + ((i) >> 4))
#define FFT_X_BYTES 69632
template <int R, bool INV>
__device__ __forceinline__ void fft_pass(float2* __restrict__ X, const float2* __restrict__ TW, const int s0, const int gidx) {
    const int lowbits = 13 - s0 - R; const int stride = 1 << lowbits;
    const int low = gidx & (stride - 1), high = gidx >> lowbits; const int base = (high << (lowbits + R)) | low;
    static_assert(13 - 0 - R >= 0, "radix");
    const int p0 = FIDX(base);
#define FFT_SLOT(k) (lowbits >= 4 ? p0 + (k) * (stride + (stride >> 4)) : p0 + (k) + ((k) >> 4))
    float2 v[1 << R];
#pragma unroll
    for (int k = 0; k < (1 << R); ++k) v[k] = X[FFT_SLOT(k)];
    if (!INV) {
#pragma unroll
        for (int j = 0; j < R; ++j) { const int hk = 1 << (R - 1 - j);
#pragma unroll
            for (int k = 0; k < (1 << R); ++k) if (!(k & hk)) { const int kk = k & (hk - 1); const int m = (low + stride * kk) << (s0 + j);
                const float2 a = v[k], b = v[k + hk], w = TW[m]; v[k] = make_float2(a.x + b.x, a.y + b.y); const float dx = a.x - b.x, dy = a.y - b.y; v[k + hk] = make_float2(dx * w.x - dy * w.y, dx * w.y + dy * w.x); } }
    } else {
#pragma unroll
        for (int j = R - 1; j >= 0; --j) { const int hk = 1 << (R - 1 - j);
#pragma unroll
            for (int k = 0; k < (1 << R); ++k) if (!(k & hk)) { const int kk = k & (hk - 1); const int m = (low + stride * kk) << (s0 + j);
                const float2 a = v[k], b = v[k + hk], w = TW[m]; const float tx = b.x * w.x + b.y * w.y, ty = b.y * w.x - b.x * w.y;
                v[k] = make_float2(a.x + tx, a.y + ty); v[k + hk] = make_float2(a.x - tx, a.y - ty); } }
    }
#pragma unroll
    for (int k = 0; k < (1 << R); ++k) X[FFT_SLOT(k)] = v[k];
#undef FFT_SLOT
}
__device__ __forceinline__ void fft_fwd(float2* X, const float2* TW, const int tid) {
    fft_pass<4, false>(X, TW, 0, tid); __syncthreads(); fft_pass<4, false>(X, TW, 4, tid); __syncthreads(); if (tid < 256) fft_pass<5, false>(X, TW, 8, tid); __syncthreads(); }
__device__ __forceinline__ void fft_inv(float2* X, const float2* TW, const int tid) {
    if (tid < 256) fft_pass<5, true>(X, TW, 8, tid); __syncthreads(); fft_pass<4, true>(X, TW, 4, tid); __syncthreads(); fft_pass<4, true>(X, TW, 0, tid); __syncthreads(); }
__device__ __forceinline__ void fft_twiddles(float2* TW, const int tid) {
#pragma unroll
    for (int k = 0; k < 8; ++k) { const int m = tid + k * 512; const float xx = (float)m * (1.0f / 4096.0f); TW[m] = make_float2(cospif(xx), -sinpif(xx)); }
}
__device__ __forceinline__ void hyena_spec_item(const int oc, const float* __restrict__ HR, const float* __restrict__ nrm, float2* __restrict__ HSPEC, unsigned char* shm, const int tid) {
    float2* X = (float2*)shm; const float2* TW = (const float2*)(shm + FFT_X_BYTES);
    const int o = oc >> 9, c = oc & 511; const float inv = 1.0f / nrm[oc];
    __syncthreads();
#pragma unroll 2
    for (int k = 0; k < 16; ++k) { const int j = tid + k * 512; float v;
        if (j < SEQ) v = HR[(unsigned)j * 2048u + o * 1024 + c] * inv; else if (j == SEQ) v = 0.f; else v = HR[(unsigned)(2 * SEQ - j) * 2048u + o * 1024 + 512 + c] * inv;
        X[FIDX(j)] = make_float2(v, 0.f); }
    __syncthreads();
    fft_fwd(X, TW, tid);
    float4* out = (float4*)(HSPEC + (size_t)oc * 8192 + tid * 16); const float2* xs = X + 17 * tid;
#pragma unroll
    for (int k = 0; k < 8; ++k) { const float2 x0 = xs[2 * k], x1 = xs[2 * k + 1]; out[k] = make_float4(x0.x * (1.0f / 8192.0f), x0.y * (1.0f / 8192.0f), x1.x * (1.0f / 8192.0f), x1.y * (1.0f / 8192.0f)); }
}
__device__ __forceinline__ void fft_mul_spec(float2* X, const float2* __restrict__ H, const int tid) {
    const float4* h4 = (const float4*)(H + tid * 16); float2* xs = X + 17 * tid;
#pragma unroll
    for (int k = 0; k < 8; ++k) { const float4 hv = h4[k]; const float2 x0 = xs[2 * k], x1 = xs[2 * k + 1];
        xs[2 * k] = make_float2(x0.x * hv.x - x0.y * hv.y, x0.x * hv.y + x0.y * hv.x); xs[2 * k + 1] = make_float2(x1.x * hv.z - x1.y * hv.w, x1.x * hv.w + x1.y * hv.z); }
}
__device__ __forceinline__ void hyena_fft_item(const int item, const float* __restrict__ UT, const float2* __restrict__ HSPEC, const float* __restrict__ bias, float* __restrict__ YT, unsigned char* shm, const int tid) {
    float2* X = (float2*)shm; const float2* TW = (const float2*)(shm + FFT_X_BYTES);
    const int c = item >> 1, b0 = (item & 1) * 2, b1 = b0 + 1;
    const float* u0 = UT + (size_t)(b0 * 1536 + c) * SEQ + tid * 8; const float* u1 = UT + (size_t)(b1 * 1536 + c) * SEQ + tid * 8;
    const float bias0 = bias[c], bias1 = bias[512 + c];
    float2* xs = X + FIDX(8 * tid);
    float vr[8], vi[8];
    __syncthreads();
    { const float4 a0 = *(const float4*)u0, a1 = *(const float4*)(u0 + 4), c0 = *(const float4*)u1, c1 = *(const float4*)(u1 + 4);
      vr[0] = a0.x; vr[1] = a0.y; vr[2] = a0.z; vr[3] = a0.w; vr[4] = a1.x; vr[5] = a1.y; vr[6] = a1.z; vr[7] = a1.w;
      vi[0] = c0.x; vi[1] = c0.y; vi[2] = c0.z; vi[3] = c0.w; vi[4] = c1.x; vi[5] = c1.y; vi[6] = c1.z; vi[7] = c1.w; }
#pragma unroll
    for (int k = 0; k < 8; ++k) { xs[k] = make_float2(vr[k], vi[k]); xs[4352 + k] = make_float2(0.f, 0.f); }
    __syncthreads();
    fft_fwd(X, TW, tid);
    fft_mul_spec(X, HSPEC + (size_t)c * 8192, tid);
    __syncthreads();
    fft_inv(X, TW, tid);
    { const float* p0 = u0 + (size_t)512 * SEQ; const float* p1 = u1 + (size_t)512 * SEQ;
      const float4 a0 = *(const float4*)p0, a1 = *(const float4*)(p0 + 4), c0 = *(const float4*)p1, c1 = *(const float4*)(p1 + 4);
      const float xr[8] = {a0.x, a0.y, a0.z, a0.w, a1.x, a1.y, a1.z, a1.w}, xi[8] = {c0.x, c0.y, c0.z, c0.w, c1.x, c1.y, c1.z, c1.w};
#pragma unroll
      for (int k = 0; k < 8; ++k) { const float2 cv = xs[k]; const float zr = xr[k] * (cv.x + bias0 * vr[k]), zi = xi[k] * (cv.y + bias0 * vi[k]);
          vr[k] = zr; vi[k] = zi; xs[k] = make_float2(zr, zi); xs[4352 + k] = make_float2(0.f, 0.f); } }
    __syncthreads();
    fft_fwd(X, TW, tid);
    fft_mul_spec(X, HSPEC + (size_t)(512 + c) * 8192, tid);
    __syncthreads();
    fft_inv(X, TW, tid);
    { const float* p0 = u0 + (size_t)1024 * SEQ; const float* p1 = u1 + (size_t)1024 * SEQ;
      const float4 a0 = *(const float4*)p0, a1 = *(const float4*)(p0 + 4), c0 = *(const float4*)p1, c1 = *(const float4*)(p1 + 4);
      const float xr[8] = {a0.x, a0.y, a0.z, a0.w, a1.x, a1.y, a1.z, a1.w}, xi[8] = {c0.x, c0.y, c0.z, c0.w, c1.x, c1.y, c1.z, c1.w};
      float yr[8], yi[8];
#pragma unroll
      for (int k = 0; k < 8; ++k) { const float2 cv = xs[k]; yr[k] = xr[k] * (cv.x + bias1 * vr[k]); yi[k] = xi[k] * (cv.y + bias1 * vi[k]); }
      float* y0 = YT + (size_t)(b0 * 512 + c) * SEQ + tid * 8; float* y1 = YT + (size_t)(b1 * 512 + c) * SEQ + tid * 8;
      *(float4*)y0 = make_float4(yr[0], yr[1], yr[2], yr[3]); *(float4*)(y0 + 4) = make_float4(yr[4], yr[5], yr[6], yr[7]);
      *(float4*)y1 = make_float4(yi[0], yi[1], yi[2], yi[3]); *(float4*)(y1 + 4) = make_float4(yi[4], yi[5], yi[6], yi[7]); }
}

constexpr size_t al256(size_t x) { return (x + 255) & ~(size_t)255; }
constexpr size_t O_BAR = 0;
constexpr size_t O_MOD = 16384;
constexpr size_t O_NORM = O_MOD + al256((size_t)2 * 5 * 6 * DM * 4);
constexpr size_t O_QCTR = O_NORM + al256((size_t)2 * 2 * 1024 * 4);
constexpr size_t O_ZERO_END = O_QCTR + 512;
constexpr size_t O_XS = O_ZERO_END;
constexpr size_t O_HB = O_XS + al256((size_t)NTOK * DM * 4);
constexpr size_t O_P = O_HB + al256((size_t)NTOK * DM * 2);
constexpr size_t O_WIN = O_P + al256((size_t)NTOK * LDP * 2);
constexpr size_t O_WBR = O_WIN + al256((size_t)LDP * DM * 2);
constexpr size_t O_WOUT = O_WBR + al256((size_t)4 * DM * BW * 2);
constexpr size_t O_WGU = O_WOUT + al256((size_t)DM * DM * 2);
constexpr size_t O_WD = O_WGU + al256((size_t)NEXP * 2 * DEXP * DM * 2);
constexpr size_t O_GLU = O_WD + al256((size_t)NEXP * DM * DEXP * 2);
constexpr size_t O_Y4 = O_GLU + al256((size_t)BW * BW * 2);
constexpr size_t O_U = O_Y4 + al256((size_t)NTOK * DM * 2);
constexpr size_t O_QKB = O_U + al256((size_t)NTOK * 1536 * 4);
constexpr size_t O_CST = O_QKB + al256((size_t)NTOK * 1024 * 2);
constexpr size_t O_NST = O_CST + al256((size_t)32 * 68 * 128 * 128 * 2);
constexpr size_t O_MST = O_NST + al256((size_t)32 * 68 * 128 * 4);
constexpr size_t O_XBC = O_MST + al256((size_t)32 * 68 * 4);
constexpr size_t O_SST = O_XBC + al256((size_t)NTOK * 1024 * 2);
constexpr size_t O_HF = O_SST + al256((size_t)64 * 68 * 64 * 128 * 2);
constexpr size_t O_YF = O_HF + al256((size_t)2 * NTOK * BW * 4);
constexpr size_t O_SF = O_YF + al256((size_t)2 * NTOK * BW * 4);
constexpr size_t O_Z = O_SF + al256((size_t)2 * NTOK * BW * 4);
constexpr size_t O_HRAW = O_Z + al256((size_t)NTOK * BW * 4);
constexpr size_t O_HSPEC = O_HRAW + al256((size_t)(SEQ + CTXL) * 2048 * 4);
constexpr size_t O_K2C = O_HSPEC + al256((size_t)1024 * 8192 * 8);
constexpr size_t O_GG = O_K2C + al256((size_t)(2 * CTXL) * 1024 * 4);
constexpr size_t O_PROBS = O_GG + al256((size_t)NTOK * BW * 2);
constexpr size_t O_ROWTOK = O_PROBS + al256((size_t)NTOK * 16 * 4);
constexpr size_t O_ROWGATE = O_ROWTOK + al256((size_t)NEXP * MOE_PAD * 4);
constexpr size_t WS_END = O_ROWGATE + al256((size_t)NEXP * MOE_PAD * 4);
constexpr size_t O_XG = O_P;
constexpr size_t O_HID = O_P + al256((size_t)NEXP * MOE_PAD * DM * 2);
static_assert(O_HID + (size_t)NEXP * MOE_PAD * DEXP * 2 <= O_WIN, "MoE temporaries must fit inside P");
static_assert((size_t)NTOK * DM * 2 <= (size_t)NTOK * 1536 * 4, "ACCb must fit inside U");
static_assert(WS_END <= (size_t)1851000000, "workspace map exceeds the guaranteed size");

struct Args {
    const float* in[47];
    float* out; unsigned char* ws;
    int ph_lo, ph_hi;
};

__device__ __forceinline__ void conv_tile(const float* __restrict__ src, int ldsrc, int nvalid, int k0, int n0, bf16_t* __restrict__ dst, int lddst, int mode, float* T, int tid) {
    { const int n = tid & 63, kr = tid >> 6;
#pragma unroll
      for (int i = 0; i < 8; ++i) { const int k = i * 8 + kr; T[k * 65 + n] = (n0 + n < nvalid) ? src[(size_t)(k0 + k) * ldsrc + n0 + n] : 0.f; } }
    __syncthreads();
    { const int n = tid >> 3, kc = (tid & 7) * 8; const int gn = n0 + n;
      const int drow = mode == 0 ? gn : (32 * (gn >> 4) + (mode == 2 ? 16 : 0) + (gn & 15));
      u32x4 w; w.x = pk2(T[(kc + 0) * 65 + n], T[(kc + 1) * 65 + n]); w.y = pk2(T[(kc + 2) * 65 + n], T[(kc + 3) * 65 + n]);
      w.z = pk2(T[(kc + 4) * 65 + n], T[(kc + 5) * 65 + n]); w.w = pk2(T[(kc + 6) * 65 + n], T[(kc + 7) * 65 + n]);
      *(u32x4*)(dst + (size_t)drow * lddst + k0 + kc) = w; }
    __syncthreads();
}

#define IN(id) (lo <= (id) && (id) < hi)
#define SEAM(id) do { if (hi > (id) + 1) xcd_barrier(bar); } while (0)
#define PH_BEGIN int tid = threadIdx.x; asm volatile("" : "+v"(tid) :: "memory"); const int lane = tid & 63, wave = tid >> 6; (void)lane; (void)wave;

#define x_in (PT(0))
#define c_in (PT(1))
#define ctx_in (PT(2))
#define cctx_in (PT(3))
#define ada_w (PT(4))
#define ada_b (PT(5))
#define norm_mix (PT(6))
#define norm_ffn (PT(7))
#define w_in (PT(8))
#define XS ((float*)(a.ws + O_XS))
#define MOD ((float*)(a.ws + O_MOD))
#define NORM ((float*)(a.ws + O_NORM))
#define MODl (MOD + (size_t)l * 5 * 6 * DM)
#define HB ((bf16_t*)(a.ws + O_HB))
#define P ((bf16_t*)(a.ws + O_P))
#define WIN ((bf16_t*)(a.ws + O_WIN))
#define WBR ((bf16_t*)(a.ws + O_WBR))
#define WOUT ((bf16_t*)(a.ws + O_WOUT))
#define WGU ((bf16_t*)(a.ws + O_WGU))
#define WD ((bf16_t*)(a.ws + O_WD))
#define GLU ((bf16_t*)(a.ws + O_GLU))
#define Y4 ((bf16_t*)(a.ws + O_Y4))
#define U ((float*)(a.ws + O_U))
#define ACCb ((bf16_t*)(a.ws + O_U))
#define QKB ((bf16_t*)(a.ws + O_QKB))
#define CST ((bf16_t*)(a.ws + O_CST))
#define NST ((float*)(a.ws + O_NST))
#define MST ((float*)(a.ws + O_MST))
#define XBC ((bf16_t*)(a.ws + O_XBC))
#define SSTB ((bf16_t*)(a.ws + O_SST))
#define HF ((float*)(a.ws + O_HF))
#define HBk (HF + (size_t)NTOK * BW)
#define YF ((float*)(a.ws + O_YF))
#define YB (YF + (size_t)NTOK * BW)
#define SF ((float*)(a.ws + O_SF))
#define SB (SF + (size_t)NTOK * BW)
#define Z ((float*)(a.ws + O_Z))
#define HRAW ((float*)(a.ws + O_HRAW))
#define HSPEC ((float2*)(a.ws + O_HSPEC))
#define UT ((float*)(a.ws + O_U))
#define YT ((float*)(a.ws + O_Z))
#define QCTR ((int*)(a.ws + O_QCTR))
#define K2C ((float*)(a.ws + O_K2C))
#define GG ((bf16_t*)(a.ws + O_GG))
#define PROBS ((float*)(a.ws + O_PROBS))
#define ROWTOK ((int*)(a.ws + O_ROWTOK))
#define ROWGATE ((float*)(a.ws + O_ROWGATE))
#define XG ((bf16_t*)(a.ws + O_XG))
#define HID ((bf16_t*)(a.ws + O_HID))


template <int LAYER>
__device__ __forceinline__ void layer_body(const Args& a, const XcdBarrier& bar, const int lo, const int hi, const int bid, const int G, unsigned char* const shm, float* const sf, const float** const ptab) {
        constexpr int l = LAYER;
        constexpr int PB = 1 + 16 * l;
        const bool lastl = (l == 1);

        const int nPanels = lastl ? 64 : 68;
        const int M2 = nPanels * 256;

        if (IN(PB + 0)) {
            PH_BEGIN
            {   const float* wbr = PT(40) + (size_t)l * 4 * BW * DM; const float* wout = PT(41) + (size_t)l * DM * DM;
                const float* wg = PT(43) + (size_t)l * NEXP * DM * DEXP; const float* wu = PT(44) + (size_t)l * NEXP * DM * DEXP; const float* wd = PT(45) + (size_t)l * NEXP * DEXP * DM;
                const float* wglu = PT(32) + (size_t)l * BW * BW; const float* win = w_in + (size_t)l * DM * IN_W;
                const int n_win = 32 * 220, n_br = 4 * 8 * 32, n_out = 32 * 32, n_gu = 16 * 2 * 32 * 24, n_d = 16 * 24 * 32, n_glu = 64;
                const int total = n_win + n_br + n_out + n_gu + n_d + n_glu;
                for (int t = bid; t < total; t += G) { int q = t;
                    if (q < n_win) { conv_tile(win, IN_W, IN_W, (q / 220) * 64, (q % 220) * 64, WIN, DM, 0, sf, tid); continue; } q -= n_win;
                    if (q < n_br) { const int k = q / 256, r = q % 256; conv_tile(wbr + (size_t)k * BW * DM, DM, DM, (r / 32) * 64, (r % 32) * 64, WBR + (size_t)k * DM * BW, BW, 0, sf, tid); continue; } q -= n_br;
                    if (q < n_out) { conv_tile(wout, DM, DM, (q / 32) * 64, (q % 32) * 64, WOUT, DM, 0, sf, tid); continue; } q -= n_out;
                    if (q < n_gu) { const int e = q / 1536, r = q % 1536, up = r / 768, r2 = r % 768; conv_tile((up ? wu : wg) + (size_t)e * DM * DEXP, DEXP, DEXP, (r2 / 24) * 64, (r2 % 24) * 64, WGU + (size_t)e * 2 * DEXP * DM, DM, 1 + up, sf, tid); continue; } q -= n_gu;
                    if (q < n_d) { const int e = q / 768, r = q % 768; conv_tile(wd + (size_t)e * DEXP * DM, DM, DM, (r / 32) * 64, (r % 32) * 64, WD + (size_t)e * DM * DEXP, DEXP, 0, sf, tid); continue; } q -= n_d;
                    conv_tile(wglu, BW, BW, (q / 8) * 64, (q % 8) * 64, GLU, BW, 0, sf, tid);
                }
            }
            for (int set = 0; set < (lastl ? 1 : 2); ++set) {
                const int L = set ? CTXL : SEQ; float* HR = HRAW + (set ? (size_t)SEQ * 2048 : 0);
                const float* w1 = PT(11) + l * 33 * 64; const float* b1 = PT(12) + l * 64; const float* fr1 = PT(13) + l * 64; const float* w2 = PT(14) + l * 64 * 64; const float* b2 = PT(15) + l * 64;
                const float* fr2 = PT(16) + l * 64; const float* w3 = PT(17) + l * 64 * 2048; const float* decay = PT(18) + l * 2048;
                float* feats = sf; float* h1 = sf + 64; float* h2 = sf + 128;
                float nacc[4] = {0.f, 0.f, 0.f, 0.f};
                for (int t = bid; t < L; t += G) {
                    const float tn = (float)t / (float)(L - 1);
                    __syncthreads();
                    if (tid < 33) { if (tid == 0) feats[0] = tn; else { const int j = (tid - 1) & 15; const double fr = 1e-4 + (double)j * ((15.0 - 1e-4) / 15.0); const double ang = (2.0 * 3.14159265358979323846 / (double)L) * (double)t * fr;
                        feats[tid] = tid <= 16 ? (float)cos(ang) : (float)(-sin(ang)); } }
                    __syncthreads();
                    if (tid < 64) { float s = b1[tid];
_Pragma("unroll 1")
                        for (int i = 0; i < 33; ++i) s += feats[i] * w1[i * 64 + tid]; h1[tid] = sinf(fr1[tid] * s); }
                    __syncthreads();
                    if (tid < 64) { float s = b2[tid];
_Pragma("unroll 1")
                        for (int i = 0; i < 64; ++i) s += h1[i] * w2[i * 64 + tid]; h2[tid] = sinf(fr2[tid] * s); }
                    __syncthreads();
                    float s4[4] = {0.f, 0.f, 0.f, 0.f};
#pragma unroll 2
                    for (int i = 0; i < 64; ++i) { const float hv = h2[i]; const float* wrow = w3 + (size_t)i * 2048 + tid;
                        s4[0] += hv * wrow[0]; s4[1] += hv * wrow[512]; s4[2] += hv * wrow[1024]; s4[3] += hv * wrow[1536]; }
#pragma unroll
                    for (int k = 0; k < 4; ++k) { const int f = tid + k * 512;
                        const float v = s4[k] * expf(-tn * fabsf(decay[f])); HR[(size_t)t * 2048 + f] = v; nacc[k] += fabsf(v); }
                }
                float* nrm = NORM + (size_t)(l * 2 + set) * 1024;
#pragma unroll
                for (int k = 0; k < 4; ++k) atomicAdd(nrm + (k >> 1) * 512 + tid, nacc[k]);
            }
            for (int tok = bid * 8 + wave; tok < NTOK; tok += G * 8) {
                const int r = tok < NLAT ? tok / SEQ : 4; const float* xr = XS + (size_t)tok * DM; const float* gn = norm_mix + l * DM;
                const float* sh = MODl + (size_t)(r * 6 + 0) * DM; const float* sc = MODl + (size_t)(r * 6 + 1) * DM;
                float4 v[8]; float ss = 0.f;
#pragma unroll
                for (int i = 0; i < 8; ++i) { v[i] = *(const float4*)(xr + i * 256 + lane * 4); ss += v[i].x * v[i].x + v[i].y * v[i].y + v[i].z * v[i].z + v[i].w * v[i].w; }
                ss = wave_sum(ss); const float rs = rsqrtf(ss * (1.0f / DM) + 1e-6f);
#pragma unroll
                for (int i = 0; i < 8; ++i) { const int d = i * 256 + lane * 4; const float4 g4 = *(const float4*)(gn + d), s4 = *(const float4*)(sc + d), h4 = *(const float4*)(sh + d);
                    u32x2 w; w.x = pk2(v[i].x * rs * g4.x * (1.f + s4.x) + h4.x, v[i].y * rs * g4.y * (1.f + s4.y) + h4.y); w.y = pk2(v[i].z * rs * g4.z * (1.f + s4.z) + h4.z, v[i].w * rs * g4.w * (1.f + s4.w) + h4.w);
                    *(u32x2*)(HB + (size_t)tok * DM + d) = w; }
            }
            SEAM(PB + 0);
        }

        if (IN(PB + 1)) {
            PH_BEGIN
            pg8::Gemm g{HB, WIN, DM, DM, DM}; pg8::SchedStd S{68, 55, G, bid, DM, DM}; pg8::EpiBf16Store E{P, LDP};
            pg8::gemm_phase(( LAS unsigned char*)shm, g, S, E);
            SEAM(PB + 1);
        }

        if (IN(PB + 2)) {
            PH_BEGIN
            const float* hcw = PT(9) + l * 3 * 1536; const float* hcb = PT(10) + l * 1536; const float* mcw = PT(20) + l * 3 * 1024; const float* mcb = PT(21) + l * 1024;
            const float* scw = PT(34) + l * 3 * 1024; const float* scb = PT(35) + l * 1024;
            for (int tok = bid; tok < NTOK; tok += G) {
                const bool lat = tok < NLAT; const int t = lat ? (tok & (SEQ - 1)) : ((tok - NLAT) & (CTXL - 1));
                const bool hasL = lat ? ((t & 63) != 0) : (t != 0); const bool hasR = lat ? ((t & 63) != 63) : (t != CTXL - 1);
                const bf16_t* pr = P + (size_t)tok * LDP;
#pragma unroll
                for (int j = 0; j < 7; ++j) { const int ci = tid + j * 512;
                    int col, C, cc; const float* w; const float* b;
                    if (j < 3) { cc = ci; C = 1536; col = HY_OFF + cc; w = hcw; b = hcb; }
                    else if (j < 5) { cc = ci - 1536; C = 1024; col = ML_OFF + cc; w = mcw; b = mcb; }
                    else { cc = ci - 2560; C = 1024; col = SSD_OFF + 512 + cc; w = scw; b = scb; }
                    float acc = b[cc] + w[C + cc] * bf2f(pr[col]);
                    if (hasL) acc += w[cc] * bf2f(pr[col - LDP]);
                    if (hasR) acc += w[2 * C + cc] * bf2f(pr[col + LDP]);
                    if (j >= 3) acc = siluf_(acc);
                    if (j < 3) { if (!lat) U[(size_t)tok * 1536 + cc] = acc; }
                    else if (j < 5) QKB[(size_t)tok * 1024 + cc] = f2bf(j == 4 ? acc * 0.08838834764831845f : acc);
                    else XBC[(size_t)tok * 1024 + cc] = f2bf(acc); }
            }
            {   float* T = sf;
                for (int unit = bid; unit < 4 * 64 * 24; unit += G) { const int b = unit / (64 * 24), r = (unit / 24) % 64, c0 = (unit % 24) * 64; const size_t tok0 = (size_t)b * SEQ + r * 64;
                    __syncthreads();
#pragma unroll
                    for (int i = 0; i < 8; ++i) { const int c = tid & 63, t = (tid >> 6) + 8 * i; T[t * 65 + c] = bf2f(P[(tok0 + t) * LDP + HY_OFF + c0 + c]); }
                    __syncthreads();
                    const int c = tid >> 3, tq = (tid & 7) * 8, cc = c0 + c; const float w0 = hcw[cc], w1 = hcw[1536 + cc], w2 = hcw[3072 + cc], bb = hcb[cc];
                    float o8[8];
#pragma unroll
                    for (int i = 0; i < 8; ++i) { const int t = tq + i; float acc = bb + w1 * T[t * 65 + c]; if (t > 0) acc += w0 * T[(t - 1) * 65 + c]; if (t < 63) acc += w2 * T[(t + 1) * 65 + c]; o8[i] = acc; }
                    float* dst = UT + ((size_t)b * 1536 + cc) * SEQ + r * 64 + tq;
                    *(float4*)dst = make_float4(o8[0], o8[1], o8[2], o8[3]); *(float4*)(dst + 4) = make_float4(o8[4], o8[5], o8[6], o8[7]);
                } }
            if (!lastl) {
                const int L = CTXL; const float* HR = HRAW + (size_t)SEQ * 2048; float* K2 = K2C; const float* nrm = NORM + (size_t)(l * 2 + 1) * 1024;
                const size_t total = (size_t)(2 * L - 1) * 1024;
                for (size_t i = (size_t)bid * NTHR + tid; i < total; i += (size_t)G * NTHR) { const int j = (int)(i >> 10), oc = (int)(i & 1023), o = oc >> 9, c = oc & 511; const int lag = j - (L - 1);
                    const float v = lag >= 0 ? HR[(size_t)lag * 2048 + o * 1024 + c] : HR[(size_t)(-lag) * 2048 + o * 1024 + 512 + c];
                    K2[((size_t)j * 2 + o) * 512 + c] = v / nrm[oc]; }
            }
            {   __syncthreads(); fft_twiddles((float2*)(shm + FFT_X_BYTES), tid);
                for (int oc = bid; oc < 1024; oc += G) hyena_spec_item(oc, HRAW, NORM + (size_t)(l * 2 + 0) * 1024, HSPEC, shm, tid);
                __syncthreads(); }
            SEAM(PB + 2);
        }

        if (IN(PB + 3)) {
            PH_BEGIN
            if (bid < 32) {
                mlstm_state_pass(bid, P, QKB, PT(22) + l * 16, CST, NST, MST, shm, tid);
            } else if (bid < 96) {
                { const int ch = bid - 32; const int dir_ = ch & 1, h_ = (ch >> 1) & 7; ssd_state_pass(ch, P, XBC, -expf(PT(37)[l * 16 + dir_ * 8 + h_]), PT(36)[l * 16 + dir_ * 8 + h_], SSTB, shm, tid); }
            } else if (bid < 128) {
                const int widx = (bid - 96) * 8 + wave; const int dir = widx & 1, g = (widx >> 1) & 31, b = widx >> 6; const int n = lane;
                float2* xb = (float2*)(shm + (size_t)wave * 16640); float2* ctab = xb + 16 * 65;
                const float* a_re = PT(24) + l * 2 * 32 * 64; const float* a_im = PT(25) + l * 2 * 32 * 64; const float* log_dt = PT(26) + l * 64;
                const float* b_re = PT(27) + l * 32 * 64 * 16; const float* b_im = PT(28) + l * 32 * 64 * 16; const float* c_re = PT(29) + l * 32 * 16 * 64; const float* c_im = PT(30) + l * 32 * 16 * 64;
#pragma unroll
                for (int c = 0; c < 16; ++c) ctab[c * 65 + lane] = make_float2(c_re[(g * 16 + c) * 64 + lane], c_im[(g * 16 + c) * 64 + lane]);
                float abr, abi, bbr[16], bbi[16];
                {   const double are = (double)a_re[(dir * 32 + g) * 64 + n], aim = (double)a_im[(dir * 32 + g) * 64 + n];
                    const double lam = are < -1e-4 ? are : -1e-4; const double dt = exp((double)log_dt[dir * 32 + g]);
                    const double mag = exp(lam * dt); const double ar = mag * cos(aim * dt), ai = mag * sin(aim * dt);
                    const double den = lam * lam + aim * aim; const double nr = ar - 1.0, ni = ai;
                    const double fre = (nr * lam + ni * aim) / den, fim = (ni * lam - nr * aim) / den;
                    abr = (float)ar; abi = (float)ai;
#pragma unroll
                    for (int c = 0; c < 16; ++c) { const double br = (double)b_re[(g * 64 + n) * 16 + c], bi = (double)b_im[(g * 64 + n) * 16 + c]; bbr[c] = (float)(fre * br - fim * bi); bbi[c] = (float)(fre * bi + fim * br); }
                }
                float xr = 0.f, xi = 0.f; float* Sout = dir ? SB : SF;
                const int s = lane >> 2, cg = lane & 3;
                for (int i0 = 0; i0 < CTXL + SEQ; i0 += 16) {
#pragma unroll 4
                    for (int ss = 0; ss < 16; ++ss) {
                        const size_t tok = (size_t)step_tok(b, dir, i0 + ss);
                        const u32x4* up = (const u32x4*)(P + tok * LDP + S5_OFF + g * 16);
                        float t0[8], t1[8]; unpack8(up[0], t0); unpack8(up[1], t1);
                        float bur = 0.f, bui = 0.f;
#pragma unroll
                        for (int c = 0; c < 8; ++c) { bur += t0[c] * bbr[c] + t1[c] * bbr[8 + c]; bui += t0[c] * bbi[c] + t1[c] * bbi[8 + c]; }
                        const float nxr = abr * xr - abi * xi + bur, nxi = abr * xi + abi * xr + bui; xr = nxr; xi = nxi;
                        xb[ss * 65 + lane] = make_float2(xr, xi);
                    }
                    asm volatile("s_waitcnt lgkmcnt(0)" ::: "memory");
                    float y0 = 0.f, y1 = 0.f, y2 = 0.f, y3 = 0.f;
                    for (int nn2 = 0; nn2 < 64; ++nn2) { const float2 xv = xb[s * 65 + nn2];
                        const float2 c0 = ctab[(cg * 4 + 0) * 65 + nn2], c1 = ctab[(cg * 4 + 1) * 65 + nn2], c2 = ctab[(cg * 4 + 2) * 65 + nn2], c3 = ctab[(cg * 4 + 3) * 65 + nn2];
                        y0 += xv.x * c0.x - xv.y * c0.y; y1 += xv.x * c1.x - xv.y * c1.y; y2 += xv.x * c2.x - xv.y * c2.y; y3 += xv.x * c3.x - xv.y * c3.y; }
                    const size_t toks = (size_t)step_tok(b, dir, i0 + s);
                    *(float4*)(Sout + toks * BW + g * 16 + cg * 4) = make_float4(y0, y1, y2, y3);
                    asm volatile("s_waitcnt lgkmcnt(0)" ::: "memory");
                }
            } else {
                const int nhb = G - 128, hb = bid - 128; const float* bias = PT(19) + l * 1024; const int c = tid;
                const int nitems = lastl ? 0 : 4 * (CTXL / 8);
                for (int it = hb; it < nitems; it += nhb) {
                    int L, tokbase, b, t0; const float* K2;
                    { const int q = it; L = CTXL; tokbase = NLAT; b = q / (CTXL / 8); t0 = (q % (CTXL / 8)) * 8; K2 = K2C; }
                    const float* zb = U + (size_t)(tokbase + b * L) * 1536 + c;
                    float acc[8];
#pragma unroll
                    for (int i = 0; i < 8; ++i) acc[i] = 0.f;
                    const int base = t0 + L - 1;
                    for (int s = 0; s < L; s += 8) {
                        float k[15];
#pragma unroll
                        for (int mm = 0; mm < 15; ++mm) k[mm] = K2[((size_t)(base - s - 7 + mm) * 2 + 0) * 512 + c];
#pragma unroll
                        for (int ds = 0; ds < 8; ++ds) { const float z = zb[(size_t)(s + ds) * 1536];
#pragma unroll
                            for (int i = 0; i < 8; ++i) acc[i] += k[i - ds + 7] * z; }
                    }
#pragma unroll
                    for (int i = 0; i < 8; ++i) { const size_t tok = (size_t)(tokbase + b * L + t0 + i); const float zt = U[tok * 1536 + c]; Z[tok * BW + c] = (acc[i] + bias[c] * zt) * U[tok * 1536 + 512 + c]; }
                }
            }
            {   __syncthreads(); fft_twiddles((float2*)(shm + FFT_X_BYTES), tid);
                int* qslot = (int*)(shm + FFT_X_BYTES + 32768);
                for (;;) { __syncthreads(); if (tid == 0) *qslot = atomicAdd(QCTR + l * 64, 1); __syncthreads(); const int it = *qslot; if (it >= 1024) break;
                    hyena_fft_item(it, UT, HSPEC, PT(19) + l * 1024, YT, shm, tid); }
            }
            SEAM(PB + 3);
        }

        if (IN(PB + 4)) {
            PH_BEGIN
            for (int it = bid; it < 32 * 68; it += G) { const int chain = it / 68, c = it % 68; mlstm_out_item(chain, c, P, QKB, PT(22) + l * 16, CST, NST, MST, (chain & 1) ? HBk : HF, shm, tid); }
            for (int it = bid; it < 64 * 68; it += G) { const int chain = it / 68, c = it % 68; const int dir_ = chain & 1, h_ = (chain >> 1) & 7;
                ssd_out_item(chain, c, P, XBC, -expf(PT(37)[l * 16 + dir_ * 8 + h_]), PT(36)[l * 16 + dir_ * 8 + h_], SSTB, dir_ ? YB : YF, shm, tid); }
            __syncthreads();
            {   const float* bias = PT(19) + l * 1024 + 512; const int c = tid;
                const int nitems = lastl ? 0 : 4 * (CTXL / 8);
                for (int it = bid; it < nitems; it += G) {
                    int L, tokbase, b, t0; const float* K2;
                    { const int q = it; L = CTXL; tokbase = NLAT; b = q / (CTXL / 8); t0 = (q % (CTXL / 8)) * 8; K2 = K2C; }
                    const float* zb = Z + (size_t)(tokbase + b * L) * BW + c;
                    float acc[8];
#pragma unroll
                    for (int i = 0; i < 8; ++i) acc[i] = 0.f;
                    const int base = t0 + L - 1;
                    for (int s = 0; s < L; s += 8) {
                        float k[15];
#pragma unroll
                        for (int mm = 0; mm < 15; ++mm) k[mm] = K2[((size_t)(base - s - 7 + mm) * 2 + 1) * 512 + c];
#pragma unroll
                        for (int ds = 0; ds < 8; ++ds) { const float z = zb[(size_t)(s + ds) * BW];
#pragma unroll
                            for (int i = 0; i < 8; ++i) acc[i] += k[i - ds + 7] * z; }
                    }
#pragma unroll
                    for (int i = 0; i < 8; ++i) { const size_t tok = (size_t)(tokbase + b * L + t0 + i); const float zt = Z[tok * BW + c]; Y4[tok * DM + c] = f2bf((acc[i] + bias[c] * zt) * U[tok * 1536 + 1024 + c]); }
                }
            }
            SEAM(PB + 4);
        }

        if (IN(PB + 5)) {
            PH_BEGIN
            const float* ml_norm = PT(23) + l * BW; const float* ssd_d = PT(38) + l * 8; const float* ssd_norm = PT(39) + l * BW; const float* s5_d = PT(31) + l * BW;
            float* red = sf;
            for (int tok = bid; tok < NTOK; tok += G) {
                const int c = tid; const bf16_t* pr = P + (size_t)tok * LDP;
                const float hm = HF[(size_t)tok * BW + c] + HBk[(size_t)tok * BW + c];
                float ys = YF[(size_t)tok * BW + c] + YB[(size_t)tok * BW + c] + ssd_d[c >> 6] * bf2f(XBC[(size_t)tok * 1024 + c]);
                ys *= siluf_(bf2f(pr[SSD_OFF + c]));
                const float s1 = wave_sum(hm * hm), s2 = wave_sum(ys * ys);
                __syncthreads();
                if (lane == 0) { red[wave] = s1; red[8 + wave] = s2; }
                __syncthreads();
                const float hs = red[(wave & ~1)] + red[(wave | 1)];
                const float tot = red[8] + red[9] + red[10] + red[11] + red[12] + red[13] + red[14] + red[15];
                const float o = bf2f(pr[ML_OFF + 1536 + c]);
                Y4[(size_t)tok * DM + 512 + c] = f2bf(hm * rsqrtf(hs * (1.0f / 128.0f) + 1e-6f) * ml_norm[c] * sigmoidf_(o));
                Y4[(size_t)tok * DM + 1536 + c] = f2bf(ys * rsqrtf(tot * (1.0f / BW) + 1e-6f) * ssd_norm[c]);
                const float y5 = SF[(size_t)tok * BW + c] + SB[(size_t)tok * BW + c] + s5_d[c] * bf2f(pr[S5_OFF + c]);
                GG[(size_t)tok * BW + c] = f2bf(0.5f * y5 * (1.0f + tanhf(0.7978845608028654f * (y5 + 0.044715f * y5 * y5 * y5))));
            }
            {   float* T = sf;
                for (int unit = bid; unit < 4 * 64 * 8; unit += G) { const int b = unit / 512, t0 = ((unit >> 3) & 63) * 64, c0 = (unit & 7) * 64;
                    __syncthreads();
#pragma unroll
                    for (int i = 0; i < 8; ++i) { const int t = tid & 63, c = (tid >> 6) + 8 * i; T[c * 65 + t] = YT[((size_t)b * 512 + c0 + c) * SEQ + t0 + t]; }
                    __syncthreads();
                    const int t = tid >> 3, cq = (tid & 7) * 8;
                    u32x4 w; w.x = pk2(T[(cq + 0) * 65 + t], T[(cq + 1) * 65 + t]); w.y = pk2(T[(cq + 2) * 65 + t], T[(cq + 3) * 65 + t]); w.z = pk2(T[(cq + 4) * 65 + t], T[(cq + 5) * 65 + t]); w.w = pk2(T[(cq + 6) * 65 + t], T[(cq + 7) * 65 + t]);
                    *(u32x4*)(Y4 + ((size_t)b * SEQ + t0 + t) * DM + c0 + cq) = w;
                } }
            SEAM(PB + 5);
        }

        if (IN(PB + 6)) {
            PH_BEGIN
            pg8::Gemm g{GG, GLU, BW, BW, BW}; pg8::SchedStd S{68, 2, G, bid, BW, BW}; pg8::EpiGlu E{GG, PT(33) + l * BW, Y4};
            pg8::gemm_phase((LAS unsigned char*)shm, g, S, E);
            SEAM(PB + 6);
        }
        if (IN(PB + 7)) {
            PH_BEGIN
            pg8::Gemm g{Y4, WBR, DM, BW, BW}; pg8::SchedBranch S{nPanels, 8, G, bid}; pg8::EpiBranch E{P, ACCb};
            pg8::gemm_phase((LAS unsigned char*)shm, g, S, E);
            SEAM(PB + 7);
        }
        if (IN(PB + 8)) {
            PH_BEGIN
            pg8::Gemm g{ACCb, WOUT, DM, DM, DM}; pg8::SchedStd S{nPanels, 8, G, bid, DM, DM}; pg8::EpiResid E{XS, MODl, 2};
            pg8::gemm_phase((LAS unsigned char*)shm, g, S, E);
            SEAM(PB + 8);
        }
        if (IN(PB + 9)) {
            PH_BEGIN
            for (int i = bid * NTHR + tid; i < NEXP * MOE_PAD; i += G * NTHR) ROWTOK[i] = -1;
            const float* wr = PT(42) + (size_t)l * DM * 16; const float* gn = norm_ffn + l * DM;
            for (int tok = bid * 8 + wave; tok < M2; tok += G * 8) {
                const int r = tok < NLAT ? tok / SEQ : 4; const float* xr = XS + (size_t)tok * DM;
                const float* sh = MODl + (size_t)(r * 6 + 3) * DM; const float* sc = MODl + (size_t)(r * 6 + 4) * DM;
                float ss = 0.f;
#pragma unroll 2
                for (int i = 0; i < 8; ++i) { const float4 t4 = *(const float4*)(xr + i * 256 + lane * 4); ss += t4.x * t4.x + t4.y * t4.y + t4.z * t4.z + t4.w * t4.w; }
                ss = wave_sum(ss); const float rs = rsqrtf(ss * (1.0f / DM) + 1e-6f);
                float lg[16];
#pragma unroll
                for (int e = 0; e < 16; ++e) lg[e] = 0.f;
#pragma unroll 1
                for (int i = 0; i < 8; ++i) { const int d = i * 256 + lane * 4; const float4 xv = *(const float4*)(xr + d);
                    const float4 g4 = *(const float4*)(gn + d), s4 = *(const float4*)(sc + d), h4 = *(const float4*)(sh + d);
                    const float hv[4] = {xv.x * rs * g4.x * (1.f + s4.x) + h4.x, xv.y * rs * g4.y * (1.f + s4.y) + h4.y, xv.z * rs * g4.z * (1.f + s4.z) + h4.z, xv.w * rs * g4.w * (1.f + s4.w) + h4.w};
                    u32x2 w; w.x = pk2(hv[0], hv[1]); w.y = pk2(hv[2], hv[3]); *(u32x2*)(HB + (size_t)tok * DM + d) = w;
                    const float4* wq = (const float4*)(wr + (size_t)d * 16);
#pragma unroll
                    for (int q = 0; q < 4; ++q) { const float4 w0 = wq[q * 4 + 0], w1 = wq[q * 4 + 1], w2 = wq[q * 4 + 2], w3 = wq[q * 4 + 3];
                        lg[0] += hv[q] * w0.x; lg[1] += hv[q] * w0.y; lg[2] += hv[q] * w0.z; lg[3] += hv[q] * w0.w; lg[4] += hv[q] * w1.x; lg[5] += hv[q] * w1.y; lg[6] += hv[q] * w1.z; lg[7] += hv[q] * w1.w;
                        lg[8] += hv[q] * w2.x; lg[9] += hv[q] * w2.y; lg[10] += hv[q] * w2.z; lg[11] += hv[q] * w2.w; lg[12] += hv[q] * w3.x; lg[13] += hv[q] * w3.y; lg[14] += hv[q] * w3.z; lg[15] += hv[q] * w3.w; } }
                float mx = -1e30f;
#pragma unroll
                for (int e = 0; e < 16; ++e) { lg[e] = wave_sum(lg[e]); mx = fmaxf(mx, lg[e]); }
                float s = 0.f;
#pragma unroll
                for (int e = 0; e < 16; ++e) { lg[e] = expf(lg[e] - mx); s += lg[e]; }
                const float inv = 1.0f / s;
                if (lane == 0) {
#pragma unroll
                    for (int e = 0; e < 16; e += 4) *(float4*)(PROBS + (size_t)tok * 16 + e) = make_float4(lg[e] * inv, lg[e + 1] * inv, lg[e + 2] * inv, lg[e + 3] * inv); }
            }
            SEAM(PB + 9);
        }
        if (IN(PB + 10)) {
            PH_BEGIN
            const int nitems = 128 + (lastl ? 0 : 64);
            for (int it = bid; it < nitems; it += G) {
                int set, b, e, part;
                if (it < 128) { set = 0; part = it & 1; e = (it >> 1) & 15; b = it >> 5; } else { const int q = it - 128; set = 1; part = 0; e = q & 15; b = q >> 4; }
                const int n = set ? CTXL : SEQ, cap = set ? 32 : 512, tokbase = set ? NLAT + b * CTXL : b * SEQ;
                __syncthreads();
                for (int i = tid; i < n; i += NTHR) sf[i] = PROBS[(size_t)(tokbase + i) * 16 + e];
                __syncthreads();
                const int i0 = set ? 0 : part * 2048, i1 = set ? CTXL : i0 + 2048;
                for (int i = i0 + tid; i < i1; i += NTHR) { const float pi = sf[i]; int rank = 0;
                    for (int j = 0; j < n; ++j) { const float pj = sf[j]; rank += (pj > pi || (pj == pi && j < i)) ? 1 : 0; }
                    if (rank < cap) { const int row = e * MOE_PAD + (set ? 2048 + b * 32 + rank : b * 512 + rank); ROWTOK[row] = tokbase + i; ROWGATE[row] = pi; } }
            }
            SEAM(PB + 10);
        }
        if (IN(PB + 11)) {
            PH_BEGIN
            for (int R = bid * 8 + wave; R < NEXP * MOE_PAD; R += G * 8) { const int tok = ROWTOK[R];
                u32x4* d = (u32x4*)(XG + (size_t)R * DM);
                if (tok >= 0) { const u32x4* s = (const u32x4*)(HB + (size_t)tok * DM);
#pragma unroll
                    for (int i = 0; i < 4; ++i) d[i * 64 + lane] = s[i * 64 + lane]; }
                else {
#pragma unroll
                    for (int i = 0; i < 4; ++i) d[i * 64 + lane] = (u32x4){0u, 0u, 0u, 0u}; } }
            SEAM(PB + 11);
        }
        if (IN(PB + 12)) {
            PH_BEGIN
            pg8::Gemm g{XG, WGU, DM, DM, DM}; pg8::SchedMoe S{lastl ? 8 : 9, 12, G, bid, DM, DM, 2 * DEXP}; pg8::EpiMoe1 E{HID};
            pg8::gemm_phase((LAS unsigned char*)shm, g, S, E);
            SEAM(PB + 12);
        }
        if (IN(PB + 13)) {
            PH_BEGIN
            pg8::Gemm g{HID, WD, DEXP, DEXP, DEXP}; pg8::SchedMoe S{lastl ? 8 : 9, 8, G, bid, DEXP, DEXP, DM}; pg8::EpiMoe2 E{XS, MODl, ROWTOK, ROWGATE};
            pg8::gemm_phase((LAS unsigned char*)shm, g, S, E);
            SEAM(PB + 13);
        }

}

__global__ __launch_bounds__(NTHR, 2) void fwd(Args a) {
    extern __shared__ __attribute__((aligned(16))) unsigned char shm[];
    const int bid = blockIdx.x, G = gridDim.x;
    float* const sf = (float*)shm;
    volatile LAS unsigned* xbw = (volatile LAS unsigned*)((LAS unsigned char*)shm + (LDS_BYTES - 16));
    if (threadIdx.x == 0) { xbw[0] = 0u; xbw[1] = 0u; xbw[2] = 0u; xbw[3] = 0u; }
    const float** const ptab = (const float**)(shm + (LDS_BYTES - 16 - 512));
    if (threadIdx.x == 0) {
#pragma unroll
        for (int i = 0; i < 47; ++i) ptab[i] = a.in[i]; }
    __syncthreads();
    XcdBarrier bar = xcd_barrier_post((unsigned*)(a.ws + O_BAR), xbw);
    const int lo = a.ph_lo, hi = a.ph_hi;
    if (IN(0)) {
        PH_BEGIN
        { const float4* s0 = (const float4*)x_in; const float4* s1 = (const float4*)ctx_in; float4* d = (float4*)XS; const size_t n0 = (size_t)NLAT * DM / 4, n1 = (size_t)NCTX * DM / 4;
          for (size_t i = (size_t)bid * NTHR + tid; i < n0 + n1; i += (size_t)G * NTHR) d[i] = i < n0 ? s0[i] : s1[i - n0]; }
        for (int unit = bid; unit < 2 * 24 * 8; unit += G) { const int l = unit / 192, rem = unit % 192, jb = rem >> 3, ks = rem & 7;
            __syncthreads();
            for (int i = tid; i < 5 * 256; i += NTHR) { const int r = i >> 8, k = ks * 256 + (i & 255); const float v = r < 4 ? c_in[r * DM + k] : cctx_in[k]; sf[i] = siluf_(v); }
            __syncthreads();
            const int j = jb * 512 + tid; const float* w = ada_w + (size_t)l * DM * (6 * DM) + (size_t)(ks * 256) * (6 * DM) + j;
            float a0 = 0.f, a1 = 0.f, a2 = 0.f, a3 = 0.f, a4 = 0.f;
            for (int k = 0; k < 256; ++k) { const float wv = w[(size_t)k * (6 * DM)]; a0 += sf[k] * wv; a1 += sf[256 + k] * wv; a2 += sf[512 + k] * wv; a3 += sf[768 + k] * wv; a4 += sf[1024 + k] * wv; }
            const float bb = ks == 0 ? ada_b[l * 6 * DM + j] : 0.f;
            float* o = MOD + (size_t)l * 5 * 6 * DM + j;
            atomicAdd(o + 0 * 6 * DM, a0 + bb); atomicAdd(o + 1 * 6 * DM, a1 + bb); atomicAdd(o + 2 * 6 * DM, a2 + bb); atomicAdd(o + 3 * 6 * DM, a3 + bb); atomicAdd(o + 4 * 6 * DM, a4 + bb);
        }
        SEAM(0);
    }

    layer_body<0>(a, bar, lo, hi, bid, G, shm, sf, ptab);
    layer_body<1>(a, bar, lo, hi, bid, G, shm, sf, ptab);
    if (IN(33)) {
        PH_BEGIN
        const float* gn = PT(46);
        for (int tok = bid * 8 + wave; tok < NLAT; tok += G * 8) {
            const float* xr = XS + (size_t)tok * DM; float4 v[8]; float ss = 0.f;
#pragma unroll
            for (int i = 0; i < 8; ++i) { v[i] = *(const float4*)(xr + i * 256 + lane * 4); ss += v[i].x * v[i].x + v[i].y * v[i].y + v[i].z * v[i].z + v[i].w * v[i].w; }
            ss = wave_sum(ss); const float rs = rsqrtf(ss * (1.0f / DM) + 1e-6f);
#pragma unroll
            for (int i = 0; i < 8; ++i) { const int d = i * 256 + lane * 4; const float4 g4 = *(const float4*)(gn + d);
                *(float4*)(a.out + (size_t)tok * DM + d) = make_float4(v[i].x * rs * g4.x, v[i].y * rs * g4.y, v[i].z * rs * g4.z, v[i].w * rs * g4.w); }
        }
    }
#undef IN
#undef SEAM
}


extern "C" void kernel_launch(void* const* d_in, const int* in_sizes, int n_in, void* d_out, int out_size, void* d_ws, size_t ws_size, hipStream_t stream) {
    static int grid = 0;
    if (grid == 0) {
        if (n_in != 47 || ws_size < WS_END) { fprintf(stderr, "kernel_launch: expected 47 inputs and >= %zu bytes of workspace; got %d, %zu\n", (size_t)WS_END, n_in, ws_size); grid = -1; return; }
        int dev = 0, cus = 0;
        if (hipGetDevice(&dev) != hipSuccess || hipDeviceGetAttribute(&cus, hipDeviceAttributeMultiprocessorCount, dev) != hipSuccess) { grid = -1; return; }
        if (hipFuncSetAttribute((const void*)fwd, hipFuncAttributeMaxDynamicSharedMemorySize, LDS_BYTES) != hipSuccess) { fprintf(stderr, "kernel_launch: hipFuncSetAttribute failed\n"); grid = -1; return; }
        int per_cu = 0;
        if (hipOccupancyMaxActiveBlocksPerMultiprocessor(&per_cu, (const void*)fwd, NTHR, LDS_BYTES) != hipSuccess || per_cu < 1) fprintf(stderr, "kernel_launch: occupancy query reports %d\n", per_cu);
        (void)hipGetLastError();
        grid = cus;
        if (grid < 160) { fprintf(stderr, "kernel_launch: needs >= 160 CUs (got %d)\n", grid); grid = -1; return; }
    }
    if (grid < 0) return;
    (void)hipMemsetAsync((char*)d_ws, 0, O_ZERO_END, stream);
    Args a{};
    for (int i = 0; i < 47; ++i) a.in[i] = (const float*)d_in[i];
    a.out = (float*)d_out; a.ws = (unsigned char*)d_ws;
#if MK_ONE_LAUNCH
    a.ph_lo = 0; a.ph_hi = 64;
    hipLaunchKernelGGL(fwd, dim3(grid), dim3(NTHR), LDS_BYTES, stream, a);
#else
    const int ids[] = {0, 1,2,3,4,5,6,7,8,9,10,11,12,13,14, 17,18,19,20,21,22,23,24,25,26,27,28,29,30, 33};
    for (int k = 0; k < (int)(sizeof(ids) / sizeof(ids[0])); ++k) { a.ph_lo = ids[k]; a.ph_hi = ids[k] + 1; hipLaunchKernelGGL(fwd, dim3(grid), dim3(NTHR), LDS_BYTES, stream, a); }
#endif
}
```

```cpp
#include <hip/hip_runtime.h>
#include <stdint.h>
#include <stdio.h>

#ifndef PROBE_MASK
#define PROBE_MASK 0
#endif
#define PROBE_REPS(k) ((((PROBE_MASK) >> (k)) & 1) + 1)
#ifndef MK_ONE_LAUNCH
#define MK_ONE_LAUNCH 1
#endif

#define DM 2048
#define NB 4
#define SEQ 4096
#define CTXL 256
#define BW 512
#define NLAT 16384
#define NCTX 1024
#define NTOK 17408
#define IN_W 13856
#define LDP 14080
#define HY_OFF 0
#define ML_OFF 1536
#define S5_OFF 3600
#define SSD_OFF 4112
#define GATE_OFF 5664
#define NEXP 16
#define DEXP 1536
#define MOE_ROWS 2176
#define MOE_PAD 2304
#define NTHR 512
#define LDS_BYTES 147456
#define LAS __attribute__((address_space(3)))

typedef unsigned short bf16_t;
typedef short bf16x8 __attribute__((ext_vector_type(8)));
typedef float f32x4 __attribute__((ext_vector_type(4)));
typedef unsigned u32x4 __attribute__((ext_vector_type(4)));
typedef unsigned u32x2 __attribute__((ext_vector_type(2)));

#define XB_TMO      128
#define XB_XCNT(j)  (256  + 64 * (j))
#define XB_XSUB(j)  (1280 + 64 * (j))
#define XB_XGEN(j)  (2304 + 64 * (j))
#define XB_TOP      3328
#define XB_TOPGEN   3392
#define XCD_BAR_WORDS 3456
#define XB_SPIN_CAP (1u << 18)
__device__ __forceinline__ unsigned xb_ld(unsigned* p)              { return __hip_atomic_load(p, __ATOMIC_RELAXED, __HIP_MEMORY_SCOPE_AGENT); }
__device__ __forceinline__ unsigned xb_add(unsigned* p, unsigned v) { return __hip_atomic_fetch_add(p, v, __ATOMIC_RELAXED, __HIP_MEMORY_SCOPE_AGENT); }
__device__ __forceinline__ unsigned xb_xcc_id() { return (unsigned)__builtin_amdgcn_s_getreg((3 << 11) | 20) & 0xFu; }
#define XB_SPIN(cond, bar) do { unsigned _sp = 0; while (cond) { __builtin_amdgcn_s_sleep(1); \
    if ((++_sp & 255u) == 0u) { if (xb_ld(&(bar)[XB_TMO])) break; if (_sp > XB_SPIN_CAP) { atomicAdd(&(bar)[XB_TMO], 1u); break; } } } } while (0)
struct XcdBarrier { unsigned* bar; unsigned x; volatile LAS unsigned* st; };
__device__ __forceinline__ XcdBarrier xcd_barrier_post(unsigned* bar, volatile LAS unsigned* st) {
    XcdBarrier b; b.bar = bar; b.x = xb_xcc_id(); b.st = st;
    if (threadIdx.x == 0) (void)xb_add(&bar[XB_XCNT(b.x)], 1u);
    return b;
}
__device__ __forceinline__ void xcd_barrier_complete(unsigned* bar, unsigned x, unsigned& nloc, unsigned& nx) {
    const unsigned G = gridDim.x * gridDim.y * gridDim.z;
    unsigned sum, cnt, mine, sp = 0u;
    for (;;) {
        sum = 0u; cnt = 0u; mine = 0u;
#pragma unroll
        for (unsigned j = 0; j < 16; ++j) { const unsigned c = xb_ld(&bar[XB_XCNT(j)]); sum += c; cnt += (c > 0u) ? 1u : 0u; mine = (j == x) ? c : mine; }
        if (sum == G) break;
        __builtin_amdgcn_s_sleep(1);
        if ((++sp & 255u) == 0u) { if (xb_ld(&bar[XB_TMO])) break; if (sp > XB_SPIN_CAP) { atomicAdd(&bar[XB_TMO], 1u); break; } }
    }
    nloc = mine > 0u ? mine : 1u; nx = cnt > 0u ? cnt : 1u;
}
__device__ __forceinline__ void xcd_barrier(const XcdBarrier& b) {
    asm volatile("s_waitcnt vmcnt(0)" ::: "memory");
    __syncthreads();
    if (threadIdx.x == 0) {
        unsigned* bar = b.bar;
        __builtin_amdgcn_s_waitcnt(0);
        unsigned nloc = b.st[0], nx = b.st[1];
        if (nloc == 0u) { xcd_barrier_complete(bar, b.x, nloc, nx); b.st[0] = nloc; b.st[1] = nx; }
        const unsigned old = xb_add(&bar[XB_XSUB(b.x)], 1u);
        const unsigned gen = old / nloc;
        if (old + 1u == (gen + 1u) * nloc) {
            __builtin_amdgcn_fence(__ATOMIC_RELEASE, "agent");
            asm volatile("s_waitcnt vmcnt(0)" ::: "memory");
            const unsigned og = xb_add(&bar[XB_TOP], 1u);
            const unsigned tg = og / nx;
            if (og + 1u == (tg + 1u) * nx) xb_add(&bar[XB_TOPGEN], 1u);
            else XB_SPIN(xb_ld(&bar[XB_TOPGEN]) == tg, bar);
            __builtin_amdgcn_fence(__ATOMIC_ACQUIRE, "agent");
            xb_add(&bar[XB_XGEN(b.x)], 1u);
            asm volatile("s_waitcnt vmcnt(0)" ::: "memory");
        } else {
            XB_SPIN(xb_ld(&bar[XB_XGEN(b.x)]) == gen, bar);
            __builtin_amdgcn_fence(__ATOMIC_ACQUIRE, "agent");
            asm volatile("s_waitcnt vmcnt(0)" ::: "memory");
        }
    }
    __syncthreads();
}

__device__ __forceinline__ unsigned short f2bf(float f) { unsigned u = __float_as_uint(f); u += 0x7FFFu + ((u >> 16) & 1u); return (unsigned short)(u >> 16); }
__device__ __forceinline__ float bf2f(unsigned short b) { return __uint_as_float(((unsigned)b) << 16); }
__device__ __forceinline__ unsigned pk2(float lo, float hi) { return (unsigned)f2bf(lo) | ((unsigned)f2bf(hi) << 16); }
__device__ __forceinline__ float sigmoidf_(float x) { return 1.0f / (1.0f + expf(-x)); }
__device__ __forceinline__ float siluf_(float x) { return x / (1.0f + expf(-x)); }
__device__ __forceinline__ float wave_sum(float v) {
#pragma unroll
    for (int o = 32; o >= 1; o >>= 1) v += __shfl_xor(v, o);
    return v;
}
__device__ __forceinline__ const float* uptr(const float* p) { const unsigned long long v = (unsigned long long)p;
    const unsigned lo = __builtin_amdgcn_readfirstlane((unsigned)v), hi = __builtin_amdgcn_readfirstlane((unsigned)(v >> 32)); return (const float*)(((unsigned long long)hi << 32) | lo); }
#define PT(k) uptr(ptab[k])
__device__ __forceinline__ int step_tok(int b, int dir, int i) {
    if (i < CTXL) { const int tt = dir ? (CTXL - 1 - i) : i; return NLAT + b * CTXL + tt; }
    const int j = i - CTXL; const int tt = dir ? (SEQ - 1 - j) : j; return b * SEQ + tt;
}
__device__ __forceinline__ void unpack8(const u32x4 w, float (&f)[8]) {
    f[0] = __uint_as_float(w.x << 16); f[1] = __uint_as_float(w.x & 0xFFFF0000u); f[2] = __uint_as_float(w.y << 16); f[3] = __uint_as_float(w.y & 0xFFFF0000u);
    f[4] = __uint_as_float(w.z << 16); f[5] = __uint_as_float(w.z & 0xFFFF0000u); f[6] = __uint_as_float(w.w << 16); f[7] = __uint_as_float(w.w & 0xFFFF0000u);
}

namespace pg8 {
constexpr int BM = 256, BK = 64, HALF = 128, HTB = HALF * BK * 2, STAGE_BYTES = 8 * HTB, NXCD = 8, WGM = 8;
__host__ __device__ __forceinline__ int lds_byte(int r, int c) { const int st = (r >> 4) * 2 + (c >> 5), rr = r & 15, cc = c & 31, ob = rr * 64 + cc * 2; return st * 1024 + (ob ^ (((ob >> 9) & 1) << 5)); }
__host__ __device__ __forceinline__ void stage_rc(int b, int& R, int& C) { const int st = b / 1024, sb = b % 1024, swz = sb ^ (((sb >> 9) & 1) << 5); R = (st >> 1) * 16 + swz / 64; C = (st & 1) * 32 + (swz % 64) / 2; }
__host__ __device__ __forceinline__ int perm32(int rho) { const int n = rho >> 4, i = rho & 15; return 8 * (i >> 2) + 4 * n + (i & 3); }
struct Unit { int pm, pn, z, k; long long ao, bo; };
struct Gemm { const bf16_t* A; const bf16_t* Bt; int lda, ldb, K; };

__device__ __forceinline__ void tile_of(int wgid, int nM, int nN, int& pm, int& pn) {
    const int nwg = nM * nN; { const int q = nwg / NXCD, r = nwg % NXCD, xcd = wgid % NXCD, off = wgid / NXCD; wgid = (xcd < r ? xcd * (q + 1) : r * (q + 1) + (xcd - r) * q) + off; }
    const int nig = WGM * nN, gid = wgid / nig, fm = gid * WGM, gsz = (nM - fm) < WGM ? (nM - fm) : WGM;
    pm = fm + ((wgid % nig) % gsz); pn = (wgid % nig) / gsz;
}
struct SchedStd {
    int nM, nN, G, c, lda, ldb;
    __device__ __forceinline__ bool next(int i, Unit& u) const { const long L = (long)i * G + c; if (L >= (long)nM * nN) return false; tile_of((int)L, nM, nN, u.pm, u.pn); u.z = 0; u.k = 0;
        u.ao = (long long)u.pm * BM * lda * 2; u.bo = (long long)u.pn * BM * ldb * 2; return true; }
    __device__ __forceinline__ void a_ready(const Unit&) const {}
    __device__ __forceinline__ void done(const Unit&) const {}
};
struct SchedBranch {
    int nM, nN, G, c;
    __device__ __forceinline__ bool next(int i, Unit& u) const { const long L = (long)(i >> 2) * G + c; if (L >= (long)nM * nN) return false; tile_of((int)L, nM, nN, u.pm, u.pn); u.z = 0; u.k = i & 3;
        u.ao = ((long long)u.pm * BM * DM + u.k * BW) * 2; u.bo = ((long long)u.k * DM + u.pn * BM) * BW * 2; return true; }
    __device__ __forceinline__ void a_ready(const Unit&) const {}
    __device__ __forceinline__ void done(const Unit&) const {}
};
struct SchedMoe {
    int nPm, nPn, G, c, lda, ldb, nBrows;
    __device__ __forceinline__ bool next(int i, Unit& u) const { const long L = (long)i * G + c; const int per = nPm * nPn; if (L >= (long)NEXP * per) return false; const int e = (int)(L / per), rem = (int)(L % per);
        u.z = e; u.k = 0; u.pm = rem % nPm; u.pn = rem / nPm; u.ao = ((long long)e * MOE_PAD + u.pm * BM) * lda * 2; u.bo = ((long long)e * nBrows + u.pn * BM) * ldb * 2; return true; }
    __device__ __forceinline__ void a_ready(const Unit&) const {}
    __device__ __forceinline__ void done(const Unit&) const {}
};

typedef f32x4 Acc[2][2][4][2];
template <class Epi, class Sched>
__device__ __forceinline__ void gemm_phase(LAS unsigned char* lds, const Gemm g, const Sched& S, const Epi& E) {
    int tid = threadIdx.x; asm volatile("" : "+v"(tid));
    const int wid = __builtin_amdgcn_readfirstlane(tid >> 6), lane = tid & 63, wr = wid >> 2, wc = wid & 3, fr = lane & 15, fq = lane >> 4;
    const int K = g.K, nt = K / BK;
    unsigned voffA[2], voffB[2];
#pragma unroll
    for (int i = 0; i < 2; ++i) { int R, C; stage_rc(tid * 16 + i * 8192, R, C); const int Rb = Epi::PERM ? ((R & ~31) + perm32(R & 31)) : R;
        voffA[i] = (unsigned)(R * g.lda + C) * 2u; voffB[i] = (unsigned)(Rb * g.ldb + C) * 2u; }
    const size_t kstep = (size_t)(BK * 2);
    const size_t hstepA = (size_t)HALF * g.lda * 2, hstepB = (size_t)HALF * g.ldb * 2;
    const unsigned ldsw = (unsigned)wid * 1024u;
    const int aoff = lds_byte(wr * 64 + fr, fq * 8), boff = lds_byte(wc * 32 + fr, fq * 8);
#define PG8_SA(b, h) (((b) * 2 + (h)) * HTB)
#define PG8_SB(b, h) ((4 + (b) * 2 + (h)) * HTB)
#define PG8_STAGE(bufoff, gbase, voff) do { _Pragma("unroll") for (int _i = 0; _i < 2; ++_i) \
        __builtin_amdgcn_global_load_lds((const unsigned*)((const char*)(gbase) + (voff)[_i]), (LAS unsigned*)(lds + (bufoff) + ldsw + _i * 8192), 16, 0, 0); } while (0)
#define PG8_LDA(dst, b, h) do { _Pragma("unroll") for (int m = 0; m < 4; ++m) _Pragma("unroll") for (int k = 0; k < 2; ++k) dst[m][k] = *(const LAS bf16x8*)(lds + PG8_SA(b, h) + aoff + m * 2048 + k * 1024); } while (0)
#define PG8_LDB(dst, b, h) do { _Pragma("unroll") for (int n = 0; n < 2; ++n) _Pragma("unroll") for (int k = 0; k < 2; ++k) dst[n][k] = *(const LAS bf16x8*)(lds + PG8_SB(b, h) + boff + n * 2048 + k * 1024); } while (0)
#define PG8_MMA(ai, bj, At, Bt) do { __builtin_amdgcn_s_setprio(1); _Pragma("unroll") for (int m = 0; m < 4; ++m) _Pragma("unroll") for (int n = 0; n < 2; ++n) _Pragma("unroll") for (int k = 0; k < 2; ++k) \
        acc[ai][bj][m][n] = __builtin_amdgcn_mfma_f32_16x16x32_bf16(Bt[n][k], At[m][k], acc[ai][bj][m][n], 0, 0, 0); __builtin_amdgcn_s_setprio(0); } while (0)
#define PG8_WAIT_V(n) asm volatile("s_waitcnt vmcnt(" #n ")" ::: "memory")
#define PG8_WAIT_L(n) asm volatile("s_waitcnt lgkmcnt(" #n ")" ::: "memory")
#define PG8_BAR __builtin_amdgcn_s_barrier()
#define PG8_SCHED __builtin_amdgcn_sched_barrier(0)
    Unit cur, nxt; int ui = 0;
    if (!S.next(0, cur)) return;
    Acc acc;
#pragma unroll
    for (int a = 0; a < 2; ++a)
#pragma unroll
        for (int b = 0; b < 2; ++b)
#pragma unroll
            for (int m = 0; m < 4; ++m)
#pragma unroll
                for (int n = 0; n < 2; ++n) acc[a][b][m][n] = (f32x4){0.f, 0.f, 0.f, 0.f};
    bf16x8 At[4][2], B0[2][2], B1[2][2];
    const char* cA = (const char*)g.A + cur.ao; const char* cB = (const char*)g.Bt + cur.bo;
    S.a_ready(cur);
    PG8_STAGE(PG8_SB(0, 0), cB, voffB); PG8_STAGE(PG8_SA(0, 0), cA, voffA); PG8_STAGE(PG8_SB(0, 1), cB + hstepB, voffB); PG8_STAGE(PG8_SA(0, 1), cA + hstepA, voffA);
    if (wr == 1) PG8_BAR;
    PG8_WAIT_V(4); PG8_BAR;
    PG8_STAGE(PG8_SB(1, 0), cB + kstep, voffB); PG8_STAGE(PG8_SA(1, 0), cA + kstep, voffA); PG8_STAGE(PG8_SB(1, 1), cB + hstepB + kstep, voffB);
    PG8_WAIT_V(6); PG8_BAR;
    for (;;) {
        const bool has_next = S.next(ui + 1, nxt);
        const char* nA = has_next ? (const char*)g.A + nxt.ao : cA; const char* nB = has_next ? (const char*)g.Bt + nxt.bo : cB;
        for (int t = 0; t < nt; t += 2) {
            const bool last = (t == nt - 2);
            const char* a1 = cA + (size_t)(t + 1) * kstep;
            const char* a2 = last ? nA : cA + (size_t)(t + 2) * kstep; const char* b2 = last ? nB : cB + (size_t)(t + 2) * kstep;
            const char* a3 = a2 + kstep; const char* b3 = b2 + kstep;
            if (last && has_next) S.a_ready(nxt);
            PG8_LDB(B0, 0, 0); PG8_SCHED; PG8_LDA(At, 0, 0); PG8_STAGE(PG8_SA(1, 1), a1 + hstepA, voffA);
            PG8_WAIT_L(8); PG8_BAR; PG8_WAIT_L(0); PG8_MMA(0, 0, At, B0); PG8_BAR; PG8_SCHED;
            PG8_LDB(B1, 0, 1); PG8_STAGE(PG8_SB(0, 0), b2, voffB);
            PG8_BAR; PG8_WAIT_L(0); PG8_MMA(0, 1, At, B1); PG8_BAR;
            PG8_LDA(At, 0, 1); PG8_STAGE(PG8_SA(0, 0), a2, voffA);
            PG8_BAR; PG8_WAIT_L(0); PG8_MMA(1, 0, At, B0); PG8_BAR; PG8_SCHED;
            PG8_STAGE(PG8_SB(0, 1), b2 + hstepB, voffB);
            PG8_WAIT_V(6); PG8_BAR; PG8_MMA(1, 1, At, B1); PG8_BAR;
            PG8_LDB(B0, 1, 0); PG8_SCHED; PG8_LDA(At, 1, 0); PG8_STAGE(PG8_SA(0, 1), a2 + hstepA, voffA);
            PG8_WAIT_L(8); PG8_BAR; PG8_WAIT_L(0); PG8_MMA(0, 0, At, B0); PG8_BAR; PG8_SCHED;
            PG8_LDB(B1, 1, 1); PG8_STAGE(PG8_SB(1, 0), b3, voffB);
            PG8_BAR; PG8_WAIT_L(0); PG8_MMA(0, 1, At, B1); PG8_BAR;
            PG8_LDA(At, 1, 1); PG8_STAGE(PG8_SA(1, 0), a3, voffA);
            PG8_BAR; PG8_WAIT_L(0); PG8_MMA(1, 0, At, B0); PG8_BAR; PG8_SCHED;
            PG8_STAGE(PG8_SB(1, 1), b3 + hstepB, voffB);
            PG8_WAIT_V(6); PG8_BAR; PG8_MMA(1, 1, At, B1); PG8_BAR;
        }
        const bool keep = E(acc, cur, wr, wc, fr, fq); S.done(cur);
        if (!has_next) break;
        if (!keep) {
#pragma unroll
        for (int a = 0; a < 2; ++a)
#pragma unroll
            for (int b = 0; b < 2; ++b)
#pragma unroll
                for (int m = 0; m < 4; ++m)
#pragma unroll
                    for (int n = 0; n < 2; ++n) acc[a][b][m][n] = (f32x4){0.f, 0.f, 0.f, 0.f};
        }
        cur = nxt; cA = nA; cB = nB; ++ui;
    }
    PG8_WAIT_V(0);
    if (wr == 0) PG8_BAR;
    PG8_BAR;
#undef PG8_SA
#undef PG8_SB
#undef PG8_STAGE
#undef PG8_LDA
#undef PG8_LDB
#undef PG8_MMA
#undef PG8_WAIT_V
#undef PG8_WAIT_L
#undef PG8_BAR
#undef PG8_SCHED
}

struct EpiBf16Store {
    static constexpr bool PERM = true;
    bf16_t* O; int ldc;
    __device__ __forceinline__ bool operator()(Acc& acc, const Unit& u, int wr, int wc, int fr, int fq) const {
        const int row0 = u.pm * BM + wr * 64 + fr, col0 = u.pn * BM + wc * 32 + 8 * fq;
#pragma unroll
        for (int ai = 0; ai < 2; ++ai)
#pragma unroll
            for (int m = 0; m < 4; ++m) { bf16_t* rowp = O + (size_t)(row0 + ai * HALF + m * 16) * ldc + col0;
#pragma unroll
                for (int bj = 0; bj < 2; ++bj) { const f32x4 v0 = acc[ai][bj][m][0], v1 = acc[ai][bj][m][1];
                    u32x4 w; w.x = pk2(v0[0], v0[1]); w.y = pk2(v0[2], v0[3]); w.z = pk2(v1[0], v1[1]); w.w = pk2(v1[2], v1[3]);
                    *(u32x4*)(rowp + bj * HALF) = w; } }
        return false;
    }
};
struct EpiGlu {
    static constexpr bool PERM = true;
    const bf16_t* GG; const float* bias; bf16_t* Y4;
    __device__ __forceinline__ bool operator()(Acc& acc, const Unit& u, int wr, int wc, int fr, int fq) const {
        const int row0 = u.pm * BM + wr * 64 + fr, col0 = u.pn * BM + wc * 32 + 8 * fq;
#pragma unroll
        for (int bj = 0; bj < 2; ++bj) { const int col = col0 + bj * HALF; const f32x4 b0 = *(const f32x4*)(bias + col), b1 = *(const f32x4*)(bias + col + 4);
#pragma unroll
            for (int ai = 0; ai < 2; ++ai)
#pragma unroll
                for (int m = 0; m < 4; ++m) { const size_t row = (size_t)(row0 + ai * HALF + m * 16);
                    float gg[8]; unpack8(*(const u32x4*)(GG + row * BW + col), gg);
                    const f32x4 v0 = acc[ai][bj][m][0] + b0, v1 = acc[ai][bj][m][1] + b1;
                    u32x4 w; w.x = pk2(gg[0] * sigmoidf_(v0[0]), gg[1] * sigmoidf_(v0[1])); w.y = pk2(gg[2] * sigmoidf_(v0[2]), gg[3] * sigmoidf_(v0[3]));
                    w.z = pk2(gg[4] * sigmoidf_(v1[0]), gg[5] * sigmoidf_(v1[1])); w.w = pk2(gg[6] * sigmoidf_(v1[2]), gg[7] * sigmoidf_(v1[3]));
                    *(u32x4*)(Y4 + row * DM + 1024 + col) = w; } }
        return false;
    }
};
struct EpiBranch {
    static constexpr bool PERM = true;
    const bf16_t* P; bf16_t* ACCb;
    __device__ __forceinline__ bool operator()(Acc& acc, const Unit& u, int wr, int wc, int fr, int fq) const {
        const int row0 = u.pm * BM + wr * 64 + fr, col0 = u.pn * BM + wc * 32 + 8 * fq; const int k = u.k;
#pragma unroll
        for (int ai = 0; ai < 2; ++ai)
#pragma unroll
            for (int m = 0; m < 4; ++m) { const size_t row = (size_t)(row0 + ai * HALF + m * 16);
#pragma unroll
                for (int bj = 0; bj < 2; ++bj) { const int col = col0 + bj * HALF;
                    float g0[8]; unpack8(*(const u32x4*)(P + row * LDP + GATE_OFF + k * DM + col), g0);
                    float s[8];
                    if (k < 3) { float g1[8]; unpack8(*(const u32x4*)(P + row * LDP + GATE_OFF + (k + 1) * DM + col), g1);
#pragma unroll
                        for (int j = 0; j < 8; ++j) s[j] = (1.0f + __expf(-g1[j])) / (1.0f + __expf(-g0[j])); }
                    else {
#pragma unroll
                        for (int j = 0; j < 8; ++j) s[j] = 1.0f / (1.0f + __expf(-g0[j])); }
                    f32x4 v0 = acc[ai][bj][m][0], v1 = acc[ai][bj][m][1];
                    v0[0] *= s[0]; v0[1] *= s[1]; v0[2] *= s[2]; v0[3] *= s[3]; v1[0] *= s[4]; v1[1] *= s[5]; v1[2] *= s[6]; v1[3] *= s[7];
                    if (k < 3) { acc[ai][bj][m][0] = v0; acc[ai][bj][m][1] = v1; }
                    else { u32x4 w; w.x = pk2(v0[0], v0[1]); w.y = pk2(v0[2], v0[3]); w.z = pk2(v1[0], v1[1]); w.w = pk2(v1[2], v1[3]); *(u32x4*)(ACCb + row * DM + col) = w; } } }
        return k < 3;
    }
};
struct EpiResid {
    static constexpr bool PERM = false;
    float* XS; const float* MODl; int gidx;
    __device__ __forceinline__ bool operator()(Acc& acc, const Unit& u, int wr, int wc, int fr, int fq) const {
        const int row0 = u.pm * BM + wr * 64 + fr, col0 = u.pn * BM + wc * 32 + 4 * fq;
        const int r = (u.pm * BM) < NLAT ? (u.pm * BM) / SEQ : 4;
        const float* mg = MODl + (size_t)(r * 6 + gidx) * DM;
#pragma unroll
        for (int bj = 0; bj < 2; ++bj)
#pragma unroll
            for (int n = 0; n < 2; ++n) { const int col = col0 + bj * HALF + n * 16; const f32x4 gm = *(const f32x4*)(mg + col);
#pragma unroll
                for (int ai = 0; ai < 2; ++ai)
#pragma unroll
                    for (int m = 0; m < 4; ++m) { float* p = XS + (size_t)(row0 + ai * HALF + m * 16) * DM + col; *(f32x4*)p = *(const f32x4*)p + gm * acc[ai][bj][m][n]; } }
        return false;
    }
};
struct EpiMoe1 {
    static constexpr bool PERM = false;
    bf16_t* HID;
    __device__ __forceinline__ bool operator()(Acc& acc, const Unit& u, int wr, int wc, int fr, int fq) const {
        const size_t row0 = (size_t)u.z * MOE_PAD + u.pm * BM + wr * 64 + fr; const int col0 = u.pn * HALF + wc * 16 + 4 * fq;
#pragma unroll
        for (int ai = 0; ai < 2; ++ai)
#pragma unroll
            for (int m = 0; m < 4; ++m)
#pragma unroll
                for (int bj = 0; bj < 2; ++bj) { const f32x4 gt = acc[ai][bj][m][0], up = acc[ai][bj][m][1];
                    u32x2 w; w.x = pk2(siluf_(gt[0]) * up[0], siluf_(gt[1]) * up[1]); w.y = pk2(siluf_(gt[2]) * up[2], siluf_(gt[3]) * up[3]);
                    *(u32x2*)(HID + (row0 + ai * HALF + m * 16) * DEXP + col0 + bj * 64) = w; }
        return false;
    }
};
struct EpiMoe2 {
    static constexpr bool PERM = false;
    float* XS; const float* MODl; const int* ROWTOK; const float* ROWGATE;
    __device__ __forceinline__ bool operator()(Acc& acc, const Unit& u, int wr, int wc, int fr, int fq) const {
        const int rowb = u.z * MOE_PAD + u.pm * BM + wr * 64 + fr; const int col0 = u.pn * BM + wc * 32 + 4 * fq;
#pragma unroll
        for (int ai = 0; ai < 2; ++ai)
#pragma unroll
            for (int m = 0; m < 4; ++m) { const int R = rowb + ai * HALF + m * 16; const int tok = ROWTOK[R];
                if (tok >= 0) { const float gt = ROWGATE[R]; const int r = tok < NLAT ? tok / SEQ : 4; const float* mg = MODl + (size_t)(r * 6 + 5) * DM; float* xr = XS + (size_t)tok * DM;
#pragma unroll
                    for (int bj = 0; bj < 2; ++bj)
#pragma unroll
                        for (int n = 0; n < 2; ++n) { const int col = col0 + bj * HALF + n * 16; const f32x4 gm = *(const f32x4*)(mg + col); const f32x4 v = acc[ai][bj][m][n];
                            atomicAdd(xr + col + 0, gm[0] * gt * v[0]); atomicAdd(xr + col + 1, gm[1] * gt * v[1]); atomicAdd(xr + col + 2, gm[2] * gt * v[2]); atomicAdd(xr + col + 3, gm[3] * gt * v[3]); } } }
        return false;
    }
};

struct SchedS5a {
    int c;
    __device__ __forceinline__ bool next(int i, Unit& u) const { if (i > 0 || c >= 64) return false; u.z = c >> 1; u.pm = c & 1; u.pn = 0; u.k = 0;
        u.ao = ((long long)u.z * 512 + u.pm * BM) * 768 * 2; u.bo = (long long)u.z * 256 * 512 * 2; return true; }
    __device__ __forceinline__ void a_ready(const Unit&) const {}
    __device__ __forceinline__ void done(const Unit&) const {}
};
struct SchedS5b {
    int c;
    __device__ __forceinline__ bool next(int i, Unit& u) const { if (i > 0 || c >= 128) return false; u.z = c >> 2; u.pm = (c >> 1) & 1; u.pn = c & 1; u.k = 0;
        u.ao = ((long long)u.z * 512 + u.pm * BM) * 768 * 2; u.bo = ((long long)u.z * 512 + u.pn * BM) * 768 * 2; return true; }
    __device__ __forceinline__ void a_ready(const Unit&) const {}
    __device__ __forceinline__ void done(const Unit&) const {}
};
struct EpiXloc {
    static constexpr bool PERM = false;
    float* XL;
    __device__ __forceinline__ bool operator()(Acc& acc, const Unit& u, int wr, int wc, int fr, int fq) const {
        const int row0 = u.pm * BM + wr * 64 + fr, col0 = wc * 32 + 4 * fq; float* base = XL + (size_t)u.z * 512 * 256;
#pragma unroll
        for (int ai = 0; ai < 2; ++ai)
#pragma unroll
            for (int m = 0; m < 4; ++m) { float* rowp = base + (size_t)(row0 + ai * HALF + m * 16) * 256 + col0;
#pragma unroll
                for (int bj = 0; bj < 2; ++bj)
#pragma unroll
                    for (int n = 0; n < 2; ++n) *(f32x4*)(rowp + bj * HALF + n * 16) = acc[ai][bj][m][n]; }
        return false;
    }
};
struct EpiS5Out {
    static constexpr bool PERM = true;
    const bf16_t* P; const float* dskip; bf16_t* GG;
    __device__ __forceinline__ bool operator()(Acc& acc, const Unit& u, int wr, int wc, int fr, int fq) const {
        const int row0 = u.pm * BM + wr * 64 + fr, col0 = u.pn * BM + wc * 32 + 8 * fq; const int g = u.z;
#pragma unroll
        for (int bj = 0; bj < 2; ++bj) { const int col = col0 + bj * HALF; const int t = col >> 4, c0 = col & 15;
            const f32x4 d0 = *(const f32x4*)(dskip + g * 16 + c0), d1 = *(const f32x4*)(dskip + g * 16 + c0 + 4);
#pragma unroll
            for (int ai = 0; ai < 2; ++ai)
#pragma unroll
                for (int m = 0; m < 4; ++m) { const size_t tok = (size_t)(row0 + ai * HALF + m * 16) * 32 + t;
                    float uu[8]; unpack8(*(const u32x4*)(P + tok * LDP + S5_OFF + g * 16 + c0), uu);
                    const f32x4 v0 = acc[ai][bj][m][0], v1 = acc[ai][bj][m][1];
                    float y[8] = {v0[0] + d0[0] * uu[0], v0[1] + d0[1] * uu[1], v0[2] + d0[2] * uu[2], v0[3] + d0[3] * uu[3], v1[0] + d1[0] * uu[4], v1[1] + d1[1] * uu[5], v1[2] + d1[2] * uu[6], v1[3] + d1[3] * uu[7]};
#pragma unroll
                    for (int j = 0; j < 8; ++j) y[j] = 0.5f * y[j] * (1.0f + tanhf(0.7978845608028654f * (y[j] + 0.044715f * y[j] * y[j] * y[j])));
                    u32x4 w; w.x = pk2(y[0], y[1]); w.y = pk2(y[2], y[3]); w.z = pk2(y[4], y[5]); w.w = pk2(y[6], y[7]);
                    *(u32x4*)(GG + tok * BW + g * 16 + c0) = w; } }
        return false;
    }
};
}


__device__ __forceinline__ float wave_scan_incl(float v, int lane) {
#pragma unroll
    for (int o = 1; o < 64; o <<= 1) { const float t = __shfl_up(v, o); if (lane >= o) v += t; }
    return v;
}
__device__ __forceinline__ float wave_scanmax_incl(float v, int lane) {
#pragma unroll
    for (int o = 1; o < 64; o <<= 1) { const float t = __shfl_up(v, o); if (lane >= o) v = fmaxf(v, t); }
    return v;
}
__device__ __forceinline__ float wave_max(float v) {
#pragma unroll
    for (int o = 32; o >= 1; o >>= 1) v = fmaxf(v, __shfl_xor(v, o));
    return v;
}
__device__ __forceinline__ void unpack8h(const u32x4 w, bf16_t (&h)[8]) {
    h[0] = (bf16_t)(w.x & 0xFFFFu); h[1] = (bf16_t)(w.x >> 16); h[2] = (bf16_t)(w.y & 0xFFFFu); h[3] = (bf16_t)(w.y >> 16);
    h[4] = (bf16_t)(w.z & 0xFFFFu); h[5] = (bf16_t)(w.z >> 16); h[6] = (bf16_t)(w.w & 0xFFFFu); h[7] = (bf16_t)(w.w >> 16);
}

__device__ __forceinline__ void mlstm_state_pass(const int chain, const bf16_t* __restrict__ Pm, const bf16_t* __restrict__ QKb, const float* __restrict__ gate_b,
                                                 bf16_t* __restrict__ CST, float* __restrict__ NST, float* __restrict__ MST, unsigned char* shm, const int tid) {
    const int dir = chain & 1, h = (chain >> 1) & 3, b = chain >> 3, lane = tid & 63, w = tid >> 6;
    bf16_t* VT = (bf16_t*)shm; bf16_t* KT = (bf16_t*)(shm + 36864); float* wsb = (float*)(shm + 73728);
    const float gbi = gate_b[(dir * 2 + 0) * 4 + h], gbf = gate_b[(dir * 2 + 1) * 4 + h];
    f32x4 acc[8];
#pragma unroll
    for (int j = 0; j < 8; ++j) acc[j] = (f32x4){0.f, 0.f, 0.f, 0.f};
    float nvec = 0.f, m = 0.f;
    const int gcol_i = ML_OFF + 2048 + (dir * 2 + 0) * 4 + h, gcol_f = ML_OFF + 2048 + (dir * 2 + 1) * 4 + h;
    const int s0 = tid >> 4, x0 = (tid & 15) * 8;
    bf16_t gi0, gf0, gi1, gf1; u32x4 vq[2], kq[2];
    { const size_t t0 = (size_t)step_tok(b, dir, lane), t1 = (size_t)step_tok(b, dir, 64 + lane);
      gi0 = Pm[t0 * LDP + gcol_i]; gf0 = Pm[t0 * LDP + gcol_f]; gi1 = Pm[t1 * LDP + gcol_i]; gf1 = Pm[t1 * LDP + gcol_f];
#pragma unroll
      for (int i = 0; i < 2; ++i) { const size_t toks = (size_t)step_tok(b, dir, s0 + 32 * i); vq[i] = *(const u32x4*)(Pm + toks * LDP + ML_OFF + 1024 + h * 128 + x0); kq[i] = *(const u32x4*)(QKb + toks * 1024 + 512 + h * 128 + x0); } }
    __syncthreads();
    for (int c = 0; c < 68; ++c) {
        const int buf = c & 1;
        const float ig = bf2f(gi0) + gbi, fg = bf2f(gf0) + gbf;
        gi0 = gi1; gf0 = gf1;
        if (c + 2 < 68) { const size_t t2 = (size_t)step_tok(b, dir, (c + 2) * 64 + lane); gi1 = Pm[t2 * LDP + gcol_i]; gf1 = Pm[t2 * LDP + gcol_f]; }
        const float lf = fminf(fg, 0.f) - log1pf(expf(-fabsf(fg)));
        const float bcs = wave_scan_incl(lf, lane);
        const float blast = __shfl(bcs, 63);
        const float beta = wave_max(blast - bcs + ig);
        const float mo = fmaxf(m + blast, beta);
        const float wsv = expf(blast - bcs + ig - mo); const float dec = expf(blast + m - mo);
        {   bf16_t* cs = CST + (size_t)(chain * 68 + c) * 128 * 128; const int e = 16 * w + (lane & 15);
#pragma unroll
            for (int j = 0; j < 8; ++j) { const int d0 = 16 * j + (lane >> 4) * 4; u32x2 pk; pk.x = pk2(acc[j][0], acc[j][1]); pk.y = pk2(acc[j][2], acc[j][3]); *(u32x2*)(cs + (size_t)e * 128 + d0) = pk; }
            if (tid < 128) NST[(size_t)(chain * 68 + c) * 128 + tid] = nvec;
            if (tid == 0) MST[chain * 68 + c] = m; }
        if (w == 0) wsb[buf * 64 + lane] = wsv;
#pragma unroll
        for (int i = 0; i < 2; ++i) { const int s = s0 + 32 * i; const float wss = __shfl(wsv, s);
            float f[8]; unpack8(vq[i], f); bf16_t kh[8]; unpack8h(kq[i], kh);
#pragma unroll
            for (int j = 0; j < 8; ++j) { VT[(buf * 128 + x0 + j) * 72 + s] = f2bf(f[j] * wss); KT[(buf * 128 + x0 + j) * 72 + s] = kh[j]; } }
        __syncthreads();
        if (c + 1 < 68) {
#pragma unroll
            for (int i = 0; i < 2; ++i) { const size_t toks = (size_t)step_tok(b, dir, (c + 1) * 64 + s0 + 32 * i); vq[i] = *(const u32x4*)(Pm + toks * LDP + ML_OFF + 1024 + h * 128 + x0); kq[i] = *(const u32x4*)(QKb + toks * 1024 + 512 + h * 128 + x0); } }
        if (tid < 128) { float sa = 0.f; const bf16_t* kr = KT + (buf * 128 + tid) * 72;
#pragma unroll 8
            for (int s = 0; s < 64; ++s) sa += wsb[buf * 64 + s] * bf2f(kr[s]);
            nvec = dec * nvec + sa; }
#pragma unroll
        for (int j = 0; j < 8; ++j) acc[j] = acc[j] * dec;
#pragma unroll
        for (int ks = 0; ks < 2; ++ks) { const bf16x8 vfrag = *(const bf16x8*)(VT + (buf * 128 + 16 * w + (lane & 15)) * 72 + ks * 32 + (lane >> 4) * 8);
#pragma unroll
            for (int j = 0; j < 8; ++j) { const bf16x8 kfrag = *(const bf16x8*)(KT + (buf * 128 + 16 * j + (lane & 15)) * 72 + ks * 32 + (lane >> 4) * 8);
                acc[j] = __builtin_amdgcn_mfma_f32_16x16x32_bf16(kfrag, vfrag, acc[j], 0, 0, 0); } }
        m = mo;
    }
}
__device__ __forceinline__ void mlstm_out_item(const int chain, const int c, const bf16_t* __restrict__ Pm, const bf16_t* __restrict__ QKb, const float* __restrict__ gate_b,
                                               const bf16_t* __restrict__ CST, const float* __restrict__ NST, const float* __restrict__ MST, float* __restrict__ Hout, unsigned char* shm, const int tid) {
    const int dir = chain & 1, h = (chain >> 1) & 3, b = chain >> 3, lane = tid & 63, w = tid >> 6;
    bf16_t* Qs = (bf16_t*)shm; bf16_t* Ks = (bf16_t*)(shm + 17408); bf16_t* VT = (bf16_t*)(shm + 34816); bf16_t* Cs = (bf16_t*)(shm + 53248); bf16_t* Ss = (bf16_t*)(shm + 88064);
    float* sc = (float*)(shm + 97280);
    __syncthreads();
#pragma unroll
    for (int i = 0; i < 2; ++i) { const int pid = tid + i * 512; const int s = pid >> 4, x0 = (pid & 15) * 8; const size_t toks = (size_t)step_tok(b, dir, c * 64 + s);
        *(u32x4*)(Qs + s * 136 + x0) = *(const u32x4*)(QKb + toks * 1024 + h * 128 + x0);
        *(u32x4*)(Ks + s * 136 + x0) = *(const u32x4*)(QKb + toks * 1024 + 512 + h * 128 + x0);
        bf16_t vh[8]; unpack8h(*(const u32x4*)(Pm + toks * LDP + ML_OFF + 1024 + h * 128 + x0), vh);
#pragma unroll
        for (int j = 0; j < 8; ++j) VT[(x0 + j) * 72 + s] = vh[j]; }
#pragma unroll
    for (int i = 0; i < 4; ++i) { const int pid = tid + i * 512; const int e = pid >> 4, x0 = (pid & 15) * 8;
        *(u32x4*)(Cs + e * 136 + x0) = *(const u32x4*)(CST + ((size_t)(chain * 68 + c) * 128 + e) * 128 + x0); }
    if (tid < 128) sc[384 + tid] = NST[(size_t)(chain * 68 + c) * 128 + tid];
    if (w == 0) {
        const float gbi = gate_b[(dir * 2 + 0) * 4 + h], gbf = gate_b[(dir * 2 + 1) * 4 + h];
        const size_t tokl = (size_t)step_tok(b, dir, c * 64 + lane);
        const float ig = bf2f(Pm[tokl * LDP + ML_OFF + 2048 + (dir * 2 + 0) * 4 + h]) + gbi;
        const float fg = bf2f(Pm[tokl * LDP + ML_OFF + 2048 + (dir * 2 + 1) * 4 + h]) + gbf;
        const float lf = fminf(fg, 0.f) - log1pf(expf(-fabsf(fg)));
        const float bcs = wave_scan_incl(lf, lane); const float gsv = ig - bcs; const float pm = wave_scanmax_incl(gsv, lane);
        const float m_in = MST[chain * 68 + c]; const float mt = bcs + fmaxf(m_in, pm);
        sc[lane] = bcs; sc[64 + lane] = gsv; sc[128 + lane] = mt; sc[192 + lane] = expf(bcs + m_in - mt); sc[256 + lane] = expf(-mt); sc[320 + lane] = 0.f;
    }
    __syncthreads();
    const int tt = w >> 1;
    {   f32x4 aS[2] = {(f32x4){0.f, 0.f, 0.f, 0.f}, (f32x4){0.f, 0.f, 0.f, 0.f}};
#pragma unroll
        for (int ks = 0; ks < 4; ++ks) { const bf16x8 af = *(const bf16x8*)(Qs + (16 * tt + (lane & 15)) * 136 + ks * 32 + (lane >> 4) * 8);
#pragma unroll
            for (int i = 0; i < 2; ++i) { const int st = (w & 1) * 2 + i; const bf16x8 bfr = *(const bf16x8*)(Ks + (16 * st + (lane & 15)) * 136 + ks * 32 + (lane >> 4) * 8);
                aS[i] = __builtin_amdgcn_mfma_f32_16x16x32_bf16(af, bfr, aS[i], 0, 0, 0); } }
        float rs[4] = {0.f, 0.f, 0.f, 0.f};
#pragma unroll
        for (int i = 0; i < 2; ++i) { const int s = 16 * ((w & 1) * 2 + i) + (lane & 15); const float gsv = sc[64 + s];
#pragma unroll
            for (int q = 0; q < 4; ++q) { const int t = 16 * tt + (lane >> 4) * 4 + q; const float val = (s <= t) ? aS[i][q] * expf(sc[t] + gsv - sc[128 + t]) : 0.f; Ss[t * 72 + s] = f2bf(val); rs[q] += val; } }
#pragma unroll
        for (int q = 0; q < 4; ++q) { float r = rs[q]; r += __shfl_xor(r, 1); r += __shfl_xor(r, 2); r += __shfl_xor(r, 4); r += __shfl_xor(r, 8);
            if ((lane & 15) == 0) atomicAdd(&sc[320 + 16 * tt + (lane >> 4) * 4 + q], r); }
        {   const int t = tid >> 3, part = tid & 7; float dot = 0.f;
#pragma unroll
            for (int j = 0; j < 16; ++j) dot += bf2f(Qs[t * 136 + part * 16 + j]) * sc[384 + part * 16 + j];
            dot += __shfl_xor(dot, 1); dot += __shfl_xor(dot, 2); dot += __shfl_xor(dot, 4);
            if (part == 0) atomicAdd(&sc[320 + t], sc[192 + t] * dot); }
    }
    __syncthreads();
    {   f32x4 aN[4];
#pragma unroll
        for (int i = 0; i < 4; ++i) aN[i] = (f32x4){0.f, 0.f, 0.f, 0.f};
#pragma unroll
        for (int ks = 0; ks < 4; ++ks) { const bf16x8 af = *(const bf16x8*)(Qs + (16 * tt + (lane & 15)) * 136 + ks * 32 + (lane >> 4) * 8);
#pragma unroll
            for (int i = 0; i < 4; ++i) { const int et = (w & 1) * 4 + i; const bf16x8 bfr = *(const bf16x8*)(Cs + (16 * et + (lane & 15)) * 136 + ks * 32 + (lane >> 4) * 8);
                aN[i] = __builtin_amdgcn_mfma_f32_16x16x32_bf16(af, bfr, aN[i], 0, 0, 0); } }
#pragma unroll
        for (int q = 0; q < 4; ++q) { const float it = sc[192 + 16 * tt + (lane >> 4) * 4 + q];
#pragma unroll
            for (int i = 0; i < 4; ++i) aN[i][q] *= it; }
#pragma unroll
        for (int ks = 0; ks < 2; ++ks) { const bf16x8 af = *(const bf16x8*)(Ss + (16 * tt + (lane & 15)) * 72 + ks * 32 + (lane >> 4) * 8);
#pragma unroll
            for (int i = 0; i < 4; ++i) { const int et = (w & 1) * 4 + i; const bf16x8 bfr = *(const bf16x8*)(VT + (16 * et + (lane & 15)) * 72 + ks * 32 + (lane >> 4) * 8);
                aN[i] = __builtin_amdgcn_mfma_f32_16x16x32_bf16(af, bfr, aN[i], 0, 0, 0); } }
#pragma unroll
        for (int q = 0; q < 4; ++q) { const int t = 16 * tt + (lane >> 4) * 4 + q; const size_t tokt = (size_t)step_tok(b, dir, c * 64 + t); const float dn = fmaxf(fabsf(sc[320 + t]), sc[256 + t]);
#pragma unroll
            for (int i = 0; i < 4; ++i) { const int e = 16 * ((w & 1) * 4 + i) + (lane & 15); Hout[tokt * BW + h * 128 + e] = aN[i][q] / dn; } }
    }
}


__device__ __forceinline__ void ssd_state_pass(const int chain, const bf16_t* __restrict__ Pm, const bf16_t* __restrict__ XBb, const float Aa, const float dtb,
                                               bf16_t* __restrict__ SSTb, unsigned char* shm, const int tid) {
    const int dir = chain & 1, h = (chain >> 1) & 7, b = chain >> 4, grp = h >> 2, lane = tid & 63, w = tid >> 6;
    bf16_t* BT = (bf16_t*)shm; bf16_t* XT = (bf16_t*)(shm + 36864);
    f32x4 acc[4];
#pragma unroll
    for (int j = 0; j < 4; ++j) acc[j] = (f32x4){0.f, 0.f, 0.f, 0.f};
    const int dcol = SSD_OFF + 1536 + dir * 8 + h;
    const int s0 = tid >> 4, x0 = (tid & 15) * 8, sx = tid >> 3, xx0 = (tid & 7) * 8;
    bf16_t d0, d1; u32x4 bq[2], xq;
    { d0 = Pm[(size_t)step_tok(b, dir, lane) * LDP + dcol]; d1 = Pm[(size_t)step_tok(b, dir, 64 + lane) * LDP + dcol];
#pragma unroll
      for (int i = 0; i < 2; ++i) bq[i] = *(const u32x4*)(XBb + (size_t)step_tok(b, dir, s0 + 32 * i) * 1024 + 512 + grp * 128 + x0);
      xq = *(const u32x4*)(XBb + (size_t)step_tok(b, dir, sx) * 1024 + h * 64 + xx0); }
    __syncthreads();
    for (int c = 0; c < 68; ++c) {
        const int buf = c & 1;
        const float xv = bf2f(d0) + dtb; const float dtv = xv > 20.f ? xv : log1pf(expf(xv));
        d0 = d1; if (c + 2 < 68) d1 = Pm[(size_t)step_tok(b, dir, (c + 2) * 64 + lane) * LDP + dcol];
        const float cs = wave_scan_incl(dtv * Aa, lane); const float cl = __shfl(cs, 63);
        const float scl = dtv * expf(cl - cs); const float dec = expf(cl);
        {   bf16_t* ss = SSTb + (size_t)(chain * 68 + c) * 64 * 128; const int p = 16 * (w & 3) + (lane & 15);
#pragma unroll
            for (int j = 0; j < 4; ++j) { const int n0 = 16 * ((w >> 2) * 4 + j) + (lane >> 4) * 4; u32x2 pk; pk.x = pk2(acc[j][0], acc[j][1]); pk.y = pk2(acc[j][2], acc[j][3]); *(u32x2*)(ss + (size_t)p * 128 + n0) = pk; } }
#pragma unroll
        for (int i = 0; i < 2; ++i) { const int s = s0 + 32 * i; bf16_t bh[8]; unpack8h(bq[i], bh);
#pragma unroll
            for (int j = 0; j < 8; ++j) BT[(buf * 128 + x0 + j) * 72 + s] = bh[j]; }
        {   const float sv = __shfl(scl, sx); float f[8]; unpack8(xq, f);
#pragma unroll
            for (int j = 0; j < 8; ++j) XT[(buf * 64 + xx0 + j) * 72 + sx] = f2bf(f[j] * sv); }
        __syncthreads();
        if (c + 1 < 68) {
#pragma unroll
            for (int i = 0; i < 2; ++i) bq[i] = *(const u32x4*)(XBb + (size_t)step_tok(b, dir, (c + 1) * 64 + s0 + 32 * i) * 1024 + 512 + grp * 128 + x0);
            xq = *(const u32x4*)(XBb + (size_t)step_tok(b, dir, (c + 1) * 64 + sx) * 1024 + h * 64 + xx0); }
#pragma unroll
        for (int j = 0; j < 4; ++j) acc[j] = acc[j] * dec;
#pragma unroll
        for (int ks = 0; ks < 2; ++ks) { const bf16x8 xfrag = *(const bf16x8*)(XT + (buf * 64 + 16 * (w & 3) + (lane & 15)) * 72 + ks * 32 + (lane >> 4) * 8);
#pragma unroll
            for (int j = 0; j < 4; ++j) { const bf16x8 bfrag = *(const bf16x8*)(BT + (buf * 128 + 16 * ((w >> 2) * 4 + j) + (lane & 15)) * 72 + ks * 32 + (lane >> 4) * 8);
                acc[j] = __builtin_amdgcn_mfma_f32_16x16x32_bf16(bfrag, xfrag, acc[j], 0, 0, 0); } }
    }
}
__device__ __forceinline__ void ssd_out_item(const int chain, const int c, const bf16_t* __restrict__ Pm, const bf16_t* __restrict__ XBb, const float Aa, const float dtb,
                                             const bf16_t* __restrict__ SSTb, float* __restrict__ Yout, unsigned char* shm, const int tid) {
    const int dir = chain & 1, h = (chain >> 1) & 7, b = chain >> 4, grp = h >> 2, lane = tid & 63, w = tid >> 6;
    bf16_t* Cs = (bf16_t*)shm; bf16_t* Bs = (bf16_t*)(shm + 17408); bf16_t* XT = (bf16_t*)(shm + 34816); bf16_t* Sin = (bf16_t*)(shm + 44032); bf16_t* Gs = (bf16_t*)(shm + 61440);
    float* sc = (float*)(shm + 70656);
    __syncthreads();
#pragma unroll
    for (int i = 0; i < 2; ++i) { const int pid = tid + i * 512; const int s = pid >> 4, x0 = (pid & 15) * 8; const size_t toks = (size_t)step_tok(b, dir, c * 64 + s);
        *(u32x4*)(Bs + s * 136 + x0) = *(const u32x4*)(XBb + toks * 1024 + 512 + grp * 128 + x0);
        *(u32x4*)(Cs + s * 136 + x0) = *(const u32x4*)(XBb + toks * 1024 + 768 + grp * 128 + x0);
        const int p = pid >> 4;
        *(u32x4*)(Sin + p * 136 + x0) = *(const u32x4*)(SSTb + ((size_t)(chain * 68 + c) * 64 + p) * 128 + x0); }
    {   const int s = tid >> 3, x0 = (tid & 7) * 8; const size_t toks = (size_t)step_tok(b, dir, c * 64 + s);
        bf16_t xh[8]; unpack8h(*(const u32x4*)(XBb + toks * 1024 + h * 64 + x0), xh);
#pragma unroll
        for (int j = 0; j < 8; ++j) XT[(x0 + j) * 72 + s] = xh[j]; }
    if (w == 0) { const size_t tokl = (size_t)step_tok(b, dir, c * 64 + lane);
        const float xv = bf2f(Pm[tokl * LDP + SSD_OFF + 1536 + dir * 8 + h]) + dtb; const float dtv = xv > 20.f ? xv : log1pf(expf(xv));
        sc[lane] = wave_scan_incl(dtv * Aa, lane); sc[64 + lane] = dtv; }
    __syncthreads();
    {   const int lt = w >> 1;
        f32x4 aG[2] = {(f32x4){0.f, 0.f, 0.f, 0.f}, (f32x4){0.f, 0.f, 0.f, 0.f}};
#pragma unroll
        for (int ks = 0; ks < 4; ++ks) { const bf16x8 af = *(const bf16x8*)(Cs + (16 * lt + (lane & 15)) * 136 + ks * 32 + (lane >> 4) * 8);
#pragma unroll
            for (int i = 0; i < 2; ++i) { const int st = (w & 1) * 2 + i; const bf16x8 bfr = *(const bf16x8*)(Bs + (16 * st + (lane & 15)) * 136 + ks * 32 + (lane >> 4) * 8);
                aG[i] = __builtin_amdgcn_mfma_f32_16x16x32_bf16(af, bfr, aG[i], 0, 0, 0); } }
#pragma unroll
        for (int i = 0; i < 2; ++i) { const int s = 16 * ((w & 1) * 2 + i) + (lane & 15); const float css = sc[s], dts = sc[64 + s];
#pragma unroll
            for (int q = 0; q < 4; ++q) { const int t = 16 * lt + (lane >> 4) * 4 + q; const float val = (s <= t) ? aG[i][q] * expf(sc[t] - css) * dts : 0.f; Gs[t * 72 + s] = f2bf(val); } }
    }
    __syncthreads();
    {   const int lt = w >> 1;
        f32x4 aY[2] = {(f32x4){0.f, 0.f, 0.f, 0.f}, (f32x4){0.f, 0.f, 0.f, 0.f}};
#pragma unroll
        for (int ks = 0; ks < 4; ++ks) { const bf16x8 af = *(const bf16x8*)(Cs + (16 * lt + (lane & 15)) * 136 + ks * 32 + (lane >> 4) * 8);
#pragma unroll
            for (int i = 0; i < 2; ++i) { const int pt = (w & 1) * 2 + i; const bf16x8 bfr = *(const bf16x8*)(Sin + (16 * pt + (lane & 15)) * 136 + ks * 32 + (lane >> 4) * 8);
                aY[i] = __builtin_amdgcn_mfma_f32_16x16x32_bf16(af, bfr, aY[i], 0, 0, 0); } }
#pragma unroll
        for (int q = 0; q < 4; ++q) { const float ec = expf(sc[16 * lt + (lane >> 4) * 4 + q]); aY[0][q] *= ec; aY[1][q] *= ec; }
#pragma unroll
        for (int ks = 0; ks < 2; ++ks) { const bf16x8 af = *(const bf16x8*)(Gs + (16 * lt + (lane & 15)) * 72 + ks * 32 + (lane >> 4) * 8);
#pragma unroll
            for (int i = 0; i < 2; ++i) { const int pt = (w & 1) * 2 + i; const bf16x8 bfr = *(const bf16x8*)(XT + (16 * pt + (lane & 15)) * 72 + ks * 32 + (lane >> 4) * 8);
                aY[i] = __builtin_amdgcn_mfma_f32_16x16x32_bf16(af, bfr, aY[i], 0, 0, 0); } }
#pragma unroll
        for (int q = 0; q < 4; ++q) { const int t = 16 * lt + (lane >> 4) * 4 + q; const size_t tokt = (size_t)step_tok(b, dir, c * 64 + t);
#pragma unroll
            for (int i = 0; i < 2; ++i) { const int p = 16 * ((w & 1) * 2 + i) + (lane & 15); Yout[tokt * BW + h * 64 + p] = aY[i][q]; } }
    }
}


#define FIDX(i) ((i) + ((i) >> 4))
#define FFT_X_BYTES 69632
template <int R, bool INV>
__device__ __forceinline__ void fft_pass(float2* __restrict__ X, const float2* __restrict__ TW, const int s0, const int gidx) {
    const int lowbits = 13 - s0 - R; const int stride = 1 << lowbits;
    const int low = gidx & (stride - 1), high = gidx >> lowbits; const int base = (high << (lowbits + R)) | low;
    static_assert(13 - 0 - R >= 0, "radix");
    const int p0 = FIDX(base);
#define FFT_SLOT(k) (lowbits >= 4 ? p0 + (k) * (stride + (stride >> 4)) : p0 + (k) + ((k) >> 4))
    float2 v[1 << R];
#pragma unroll
    for (int k = 0; k < (1 << R); ++k) v[k] = X[FFT_SLOT(k)];
    if (!INV) {
#pragma unroll
        for (int j = 0; j < R; ++j) { const int hk = 1 << (R - 1 - j);
#pragma unroll
            for (int k = 0; k < (1 << R); ++k) if (!(k & hk)) { const int kk = k & (hk - 1); const int m = (low + stride * kk) << (s0 + j);
                const float2 a = v[k], b = v[k + hk], w = TW[m]; v[k] = make_float2(a.x + b.x, a.y + b.y); const float dx = a.x - b.x, dy = a.y - b.y; v[k + hk] = make_float2(dx * w.x - dy * w.y, dx * w.y + dy * w.x); } }
    } else {
#pragma unroll
        for (int j = R - 1; j >= 0; --j) { const int hk = 1 << (R - 1 - j);
#pragma unroll
            for (int k = 0; k < (1 << R); ++k) if (!(k & hk)) { const int kk = k & (hk - 1); const int m = (low + stride * kk) << (s0 + j);
                const float2 a = v[k], b = v[k + hk], w = TW[m]; const float tx = b.x * w.x + b.y * w.y, ty = b.y * w.x - b.x * w.y;
                v[k] = make_float2(a.x + tx, a.y + ty); v[k + hk] = make_float2(a.x - tx, a.y - ty); } }
    }
#pragma unroll
    for (int k = 0; k < (1 << R); ++k) X[FFT_SLOT(k)] = v[k];
#undef FFT_SLOT
}
__device__ __forceinline__ void fft_fwd(float2* X, const float2* TW, const int tid) {
    fft_pass<4, false>(X, TW, 0, tid); __syncthreads(); fft_pass<4, false>(X, TW, 4, tid); __syncthreads(); if (tid < 256) fft_pass<5, false>(X, TW, 8, tid); __syncthreads(); }
__device__ __forceinline__ void fft_inv(float2* X, const float2* TW, const int tid) {
    if (tid < 256) fft_pass<5, true>(X, TW, 8, tid); __syncthreads(); fft_pass<4, true>(X, TW, 4, tid); __syncthreads(); fft_pass<4, true>(X, TW, 0, tid); __syncthreads(); }
__device__ __forceinline__ void fft_twiddles(float2* TW, const int tid) {
#pragma unroll
    for (int k = 0; k < 8; ++k) { const int m = tid + k * 512; const float xx = (float)m * (1.0f / 4096.0f); TW[m] = make_float2(cospif(xx), -sinpif(xx)); }
}
__device__ __forceinline__ void hyena_spec_item(const int oc, const float* __restrict__ HR, const float* __restrict__ nrm, float2* __restrict__ HSPEC, unsigned char* shm, const int tid) {
    float2* X = (float2*)shm; const float2* TW = (const float2*)(shm + FFT_X_BYTES);
    const int o = oc >> 9, c = oc & 511; const float inv = 1.0f / nrm[oc];
    __syncthreads();
#pragma unroll 2
    for (int k = 0; k < 16; ++k) { const int j = tid + k * 512; float v;
        if (j < SEQ) v = HR[(unsigned)j * 2048u + o * 1024 + c] * inv; else if (j == SEQ) v = 0.f; else v = HR[(unsigned)(2 * SEQ - j) * 2048u + o * 1024 + 512 + c] * inv;
        X[FIDX(j)] = make_float2(v, 0.f); }
    __syncthreads();
    fft_fwd(X, TW, tid);
    float4* out = (float4*)(HSPEC + (size_t)oc * 8192 + tid * 16); const float2* xs = X + 17 * tid;
#pragma unroll
    for (int k = 0; k < 8; ++k) { const float2 x0 = xs[2 * k], x1 = xs[2 * k + 1]; out[k] = make_float4(x0.x * (1.0f / 8192.0f), x0.y * (1.0f / 8192.0f), x1.x * (1.0f / 8192.0f), x1.y * (1.0f / 8192.0f)); }
}
__device__ __forceinline__ void fft_mul_spec(float2* X, const float2* __restrict__ H, const int tid) {
    const float4* h4 = (const float4*)(H + tid * 16); float2* xs = X + 17 * tid;
#pragma unroll
    for (int k = 0; k < 8; ++k) { const float4 hv = h4[k]; const float2 x0 = xs[2 * k], x1 = xs[2 * k + 1];
        xs[2 * k] = make_float2(x0.x * hv.x - x0.y * hv.y, x0.x * hv.y + x0.y * hv.x); xs[2 * k + 1] = make_float2(x1.x * hv.z - x1.y * hv.w, x1.x * hv.w + x1.y * hv.z); }
}
__device__ __forceinline__ void hyena_fft_item(const int item, const float* __restrict__ UT, const float2* __restrict__ HSPEC, const float* __restrict__ bias, float* __restrict__ YT, unsigned char* shm, const int tid) {
    float2* X = (float2*)shm; const float2* TW = (const float2*)(shm + FFT_X_BYTES);
    const int c = item >> 1, b0 = (item & 1) * 2, b1 = b0 + 1;
    const float* u0 = UT + (size_t)(b0 * 1536 + c) * SEQ + tid * 8; const float* u1 = UT + (size_t)(b1 * 1536 + c) * SEQ + tid * 8;
    const float bias0 = bias[c], bias1 = bias[512 + c];
    float2* xs = X + FIDX(8 * tid);
    float vr[8], vi[8];
    __syncthreads();
    { const float4 a0 = *(const float4*)u0, a1 = *(const float4*)(u0 + 4), c0 = *(const float4*)u1, c1 = *(const float4*)(u1 + 4);
      vr[0] = a0.x; vr[1] = a0.y; vr[2] = a0.z; vr[3] = a0.w; vr[4] = a1.x; vr[5] = a1.y; vr[6] = a1.z; vr[7] = a1.w;
      vi[0] = c0.x; vi[1] = c0.y; vi[2] = c0.z; vi[3] = c0.w; vi[4] = c1.x; vi[5] = c1.y; vi[6] = c1.z; vi[7] = c1.w; }
#pragma unroll
    for (int k = 0; k < 8; ++k) { xs[k] = make_float2(vr[k], vi[k]); xs[4352 + k] = make_float2(0.f, 0.f); }
    __syncthreads();
    fft_fwd(X, TW, tid);
    fft_mul_spec(X, HSPEC + (size_t)c * 8192, tid);
    __syncthreads();
    fft_inv(X, TW, tid);
    { const float* p0 = u0 + (size_t)512 * SEQ; const float* p1 = u1 + (size_t)512 * SEQ;
      const float4 a0 = *(const float4*)p0, a1 = *(const float4*)(p0 + 4), c0 = *(const float4*)p1, c1 = *(const float4*)(p1 + 4);
      const float xr[8] = {a0.x, a0.y, a0.z, a0.w, a1.x, a1.y, a1.z, a1.w}, xi[8] = {c0.x, c0.y, c0.z, c0.w, c1.x, c1.y, c1.z, c1.w};
#pragma unroll
      for (int k = 0; k < 8; ++k) { const float2 cv = xs[k]; const float zr = xr[k] * (cv.x + bias0 * vr[k]), zi = xi[k] * (cv.y + bias0 * vi[k]);
          vr[k] = zr; vi[k] = zi; xs[k] = make_float2(zr, zi); xs[4352 + k] = make_float2(0.f, 0.f); } }
    __syncthreads();
    fft_fwd(X, TW, tid);
    fft_mul_spec(X, HSPEC + (size_t)(512 + c) * 8192, tid);
    __syncthreads();
    fft_inv(X, TW, tid);
    { const float* p0 = u0 + (size_t)1024 * SEQ; const float* p1 = u1 + (size_t)1024 * SEQ;
      const float4 a0 = *(const float4*)p0, a1 = *(const float4*)(p0 + 4), c0 = *(const float4*)p1, c1 = *(const float4*)(p1 + 4);
      const float xr[8] = {a0.x, a0.y, a0.z, a0.w, a1.x, a1.y, a1.z, a1.w}, xi[8] = {c0.x, c0.y, c0.z, c0.w, c1.x, c1.y, c1.z, c1.w};
      float yr[8], yi[8];
#pragma unroll
      for (int k = 0; k < 8; ++k) { const float2 cv = xs[k]; yr[k] = xr[k] * (cv.x + bias1 * vr[k]); yi[k] = xi[k] * (cv.y + bias1 * vi[k]); }
      float* y0 = YT + (size_t)(b0 * 512 + c) * SEQ + tid * 8; float* y1 = YT + (size_t)(b1 * 512 + c) * SEQ + tid * 8;
      *(float4*)y0 = make_float4(yr[0], yr[1], yr[2], yr[3]); *(float4*)(y0 + 4) = make_float4(yr[4], yr[5], yr[6], yr[7]);
      *(float4*)y1 = make_float4(yi[0], yi[1], yi[2], yi[3]); *(float4*)(y1 + 4) = make_float4(yi[4], yi[5], yi[6], yi[7]); }
}

constexpr size_t al256(size_t x) { return (x + 255) & ~(size_t)255; }
constexpr size_t O_BAR = 0;
constexpr size_t O_MOD = 16384;
constexpr size_t O_NORM = O_MOD + al256((size_t)2 * 5 * 6 * DM * 4);
constexpr size_t O_QCTR = O_NORM + al256((size_t)2 * 2 * 1024 * 4);
constexpr size_t O_ZERO_END = O_QCTR + 512;
constexpr size_t O_XS = O_ZERO_END;
constexpr size_t O_HB = O_XS + al256((size_t)NTOK * DM * 4);
constexpr size_t O_P = O_HB + al256((size_t)NTOK * DM * 2);
constexpr size_t O_WIN = O_P + al256((size_t)NTOK * LDP * 2);
constexpr size_t O_WBR = O_WIN + al256((size_t)LDP * DM * 2);
constexpr size_t O_WOUT = O_WBR + al256((size_t)4 * DM * BW * 2);
constexpr size_t O_WGU = O_WOUT + al256((size_t)DM * DM * 2);
constexpr size_t O_WD = O_WGU + al256((size_t)NEXP * 2 * DEXP * DM * 2);
constexpr size_t O_GLU = O_WD + al256((size_t)NEXP * DM * DEXP * 2);
constexpr size_t O_Y4 = O_GLU + al256((size_t)BW * BW * 2);
constexpr size_t O_U = O_Y4 + al256((size_t)NTOK * DM * 2);
constexpr size_t O_QKB = O_U + al256((size_t)NTOK * 1536 * 4);
constexpr size_t O_CST = O_QKB + al256((size_t)NTOK * 1024 * 2);
constexpr size_t O_NST = O_CST + al256((size_t)32 * 68 * 128 * 128 * 2);
constexpr size_t O_MST = O_NST + al256((size_t)32 * 68 * 128 * 4);
constexpr size_t O_XBC = O_MST + al256((size_t)32 * 68 * 4);
constexpr size_t O_SST = O_XBC + al256((size_t)NTOK * 1024 * 2);
constexpr size_t O_HF = O_SST + al256((size_t)64 * 68 * 64 * 128 * 2);
constexpr size_t O_YF = O_HF + al256((size_t)2 * NTOK * BW * 4);
constexpr size_t O_SF = O_YF + al256((size_t)2 * NTOK * BW * 4);
constexpr size_t O_LDT = O_SF + al256((size_t)2 * NCTX * BW * 4);
constexpr size_t O_AP = O_LDT + al256((size_t)4096 * 16);
constexpr size_t O_BBT = O_AP + al256((size_t)4096 * 33 * 8);
constexpr size_t O_KT = O_BBT + al256((size_t)4096 * 16 * 8);
constexpr size_t O_S5A = O_KT + al256((size_t)32 * 2 * 32 * 256 * 4);
constexpr size_t O_S5B = O_S5A + al256((size_t)32 * 512 * 768 * 2);
constexpr size_t O_XCTX = O_S5B + al256((size_t)32 * 512 * 768 * 2);
constexpr size_t O_Z = O_XCTX + al256((size_t)4 * 32 * 2 * 64 * 8);
constexpr size_t O_HRAW = O_Z + al256((size_t)NTOK * BW * 4);
constexpr size_t O_HSPEC = O_HRAW + al256((size_t)(SEQ + CTXL) * 2048 * 4);
constexpr size_t O_K2C = O_HSPEC + al256((size_t)1024 * 8192 * 8);
constexpr size_t O_GG = O_K2C + al256((size_t)(2 * CTXL) * 1024 * 4);
constexpr size_t O_PROBS = O_GG + al256((size_t)NTOK * BW * 2);
constexpr size_t O_ROWTOK = O_PROBS + al256((size_t)NTOK * 16 * 4);
constexpr size_t O_ROWGATE = O_ROWTOK + al256((size_t)NEXP * MOE_PAD * 4);
constexpr size_t WS_END = O_ROWGATE + al256((size_t)NEXP * MOE_PAD * 4);
constexpr size_t O_XG = O_P;
constexpr size_t O_HID = O_P + al256((size_t)NEXP * MOE_PAD * DM * 2);
static_assert(O_HID + (size_t)NEXP * MOE_PAD * DEXP * 2 <= O_WIN, "MoE temporaries must fit inside P");
static_assert((size_t)NTOK * DM * 2 <= (size_t)NTOK * 1536 * 4, "ACCb must fit inside U");
static_assert(WS_END <= (size_t)1851000000, "workspace map exceeds the guaranteed size");

struct Args {
    const float* in[47];
    float* out; unsigned char* ws;
    int ph_lo, ph_hi;
};

__device__ __forceinline__ void conv_tile(const float* __restrict__ src, int ldsrc, int nvalid, int k0, int n0, bf16_t* __restrict__ dst, int lddst, int mode, float* T, int tid) {
    { const int n = tid & 63, kr = tid >> 6;
#pragma unroll
      for (int i = 0; i < 8; ++i) { const int k = i * 8 + kr; T[k * 65 + n] = (n0 + n < nvalid) ? src[(size_t)(k0 + k) * ldsrc + n0 + n] : 0.f; } }
    __syncthreads();
    { const int n = tid >> 3, kc = (tid & 7) * 8; const int gn = n0 + n;
      const int drow = mode == 0 ? gn : (32 * (gn >> 4) + (mode == 2 ? 16 : 0) + (gn & 15));
      u32x4 w; w.x = pk2(T[(kc + 0) * 65 + n], T[(kc + 1) * 65 + n]); w.y = pk2(T[(kc + 2) * 65 + n], T[(kc + 3) * 65 + n]);
      w.z = pk2(T[(kc + 4) * 65 + n], T[(kc + 5) * 65 + n]); w.w = pk2(T[(kc + 6) * 65 + n], T[(kc + 7) * 65 + n]);
      *(u32x4*)(dst + (size_t)drow * lddst + k0 + kc) = w; }
    __syncthreads();
}

#define IN(id) (lo <= (id) && (id) < hi)
#define SEAM(id) do { if (hi > (id) + 1) xcd_barrier(bar); } while (0)
#define PH_BEGIN int tid = threadIdx.x; asm volatile("" : "+v"(tid) :: "memory"); const int lane = tid & 63, wave = tid >> 6; (void)lane; (void)wave;

#define x_in (PT(0))
#define c_in (PT(1))
#define ctx_in (PT(2))
#define cctx_in (PT(3))
#define ada_w (PT(4))
#define ada_b (PT(5))
#define norm_mix (PT(6))
#define norm_ffn (PT(7))
#define w_in (PT(8))
#define XS ((float*)(a.ws + O_XS))
#define MOD ((float*)(a.ws + O_MOD))
#define NORM ((float*)(a.ws + O_NORM))
#define MODl (MOD + (size_t)l * 5 * 6 * DM)
#define HB ((bf16_t*)(a.ws + O_HB))
#define P ((bf16_t*)(a.ws + O_P))
#define WIN ((bf16_t*)(a.ws + O_WIN))
#define WBR ((bf16_t*)(a.ws + O_WBR))
#define WOUT ((bf16_t*)(a.ws + O_WOUT))
#define WGU ((bf16_t*)(a.ws + O_WGU))
#define WD ((bf16_t*)(a.ws + O_WD))
#define GLU ((bf16_t*)(a.ws + O_GLU))
#define Y4 ((bf16_t*)(a.ws + O_Y4))
#define U ((float*)(a.ws + O_U))
#define ACCb ((bf16_t*)(a.ws + O_U))
#define QKB ((bf16_t*)(a.ws + O_QKB))
#define CST ((bf16_t*)(a.ws + O_CST))
#define NST ((float*)(a.ws + O_NST))
#define MST ((float*)(a.ws + O_MST))
#define XBC ((bf16_t*)(a.ws + O_XBC))
#define SSTB ((bf16_t*)(a.ws + O_SST))
#define HF ((float*)(a.ws + O_HF))
#define HBk (HF + (size_t)NTOK * BW)
#define YF ((float*)(a.ws + O_YF))
#define YB (YF + (size_t)NTOK * BW)
#define SF ((float*)(a.ws + O_SF))
#define SB (SF + (size_t)NCTX * BW)
#define LDT ((double2*)(a.ws + O_LDT))
#define APW ((float2*)(a.ws + O_AP))
#define BBT ((float2*)(a.ws + O_BBT))
#define KTB ((float*)(a.ws + O_KT))
#define S5A ((bf16_t*)(a.ws + O_S5A))
#define S5B ((bf16_t*)(a.ws + O_S5B))
#define XCTX ((float2*)(a.ws + O_XCTX))
#define S5P ((bf16_t*)(a.ws + O_HB))
#define XLOC ((float*)(a.ws + O_HB + (size_t)32 * 256 * 512 * 2))
#define Z ((float*)(a.ws + O_Z))
#define HRAW ((float*)(a.ws + O_HRAW))
#define HSPEC ((float2*)(a.ws + O_HSPEC))
#define UT ((float*)(a.ws + O_U))
#define YT ((float*)(a.ws + O_Z))
#define QCTR ((int*)(a.ws + O_QCTR))
#define K2C ((float*)(a.ws + O_K2C))
#define GG ((bf16_t*)(a.ws + O_GG))
#define PROBS ((float*)(a.ws + O_PROBS))
#define ROWTOK ((int*)(a.ws + O_ROWTOK))
#define ROWGATE ((float*)(a.ws + O_ROWGATE))
#define XG ((bf16_t*)(a.ws + O_XG))
#define HID ((bf16_t*)(a.ws + O_HID))


struct CvU { const float* src; bf16_t* dst; int ldsrc, nvalid, k0, n0, lddst, mode; };
__device__ __forceinline__ void cv_load(const CvU& u, float4 (&r)[8], const int tid) {
#pragma unroll
    for (int i = 0; i < 8; ++i) { const int idx = tid + i * 512; const int k = idx >> 6, n = u.n0 + (idx & 63) * 4;
        r[i] = (n < u.nvalid) ? *(const float4*)(u.src + (size_t)(u.k0 + k) * u.ldsrc + n) : make_float4(0.f, 0.f, 0.f, 0.f); }
}
__device__ __forceinline__ void cv_stage(float* T, const float4 (&r)[8], const int tid) {
#pragma unroll
    for (int i = 0; i < 8; ++i) { const int idx = tid + i * 512; float* p = T + (idx >> 6) * 257 + (idx & 63) * 4; p[0] = r[i].x; p[1] = r[i].y; p[2] = r[i].z; p[3] = r[i].w; }
}
__device__ __forceinline__ void cv_store(const CvU& u, const float* T, const int tid) {
#pragma unroll
    for (int j = 0; j < 4; ++j) { const int o = tid + j * 512; const int kc = (o & 7) * 8, n = o >> 3; const int gn = u.n0 + n;
        const int drow = u.mode == 0 ? gn : (32 * (gn >> 4) + (u.mode == 2 ? 16 : 0) + (gn & 15));
        const float* t = T + kc * 257 + n;
        u32x4 w; w.x = pk2(t[0], t[257]); w.y = pk2(t[2 * 257], t[3 * 257]); w.z = pk2(t[4 * 257], t[5 * 257]); w.w = pk2(t[6 * 257], t[7 * 257]);
        *(u32x4*)(u.dst + (size_t)drow * u.lddst + u.k0 + kc) = w; }
}
template <int LAYER>
__device__ __forceinline__ void layer_body(const Args& a, const XcdBarrier& bar, const int lo, const int hi, const int bid, const int G, unsigned char* const shm, float* const sf, const float** const ptab) {
        constexpr int l = LAYER;
        constexpr int PB = 1 + 16 * l;
        const bool lastl = (l == 1);

        const int nPanels = lastl ? 64 : 68;
        const int M2 = nPanels * 256;

        if (IN(PB + 0)) for (int rep_ = 0; rep_ < PROBE_REPS(0); ++rep_) {
            PH_BEGIN
            {   const float* wbr = PT(40) + (size_t)l * 4 * BW * DM; const float* wout = PT(41) + (size_t)l * DM * DM;
                const float* wg = PT(43) + (size_t)l * NEXP * DM * DEXP; const float* wu = PT(44) + (size_t)l * NEXP * DM * DEXP; const float* wd = PT(45) + (size_t)l * NEXP * DEXP * DM;
                const float* wglu = PT(32) + (size_t)l * BW * BW; const float* win = w_in + (size_t)l * DM * IN_W;
                const int n_win = 32 * 55, n_br = 4 * 64, n_out = 32 * 8, n_gu = 16 * 2 * 192, n_d = 16 * 192, n_glu = 16;
                const int total = n_win + n_br + n_out + n_gu + n_d + n_glu;
#define CV_DECODE(q_, u_) do { int qq_ = (q_); \
                    if (qq_ < n_win) { u_ = CvU{win, WIN, IN_W, IN_W, (qq_ / 55) * 64, (qq_ % 55) * 256, DM, 0}; } else { qq_ -= n_win; \
                    if (qq_ < n_br) { const int k = qq_ >> 6, r = qq_ & 63; u_ = CvU{wbr + (size_t)k * BW * DM, WBR + (size_t)k * DM * BW, DM, DM, (r >> 3) * 64, (r & 7) * 256, BW, 0}; } else { qq_ -= n_br; \
                    if (qq_ < n_out) { u_ = CvU{wout, WOUT, DM, DM, (qq_ >> 3) * 64, (qq_ & 7) * 256, DM, 0}; } else { qq_ -= n_out; \
                    if (qq_ < n_gu) { const int e = qq_ / 384, r = qq_ % 384, up = r / 192, r2 = r % 192; u_ = CvU{(up ? wu : wg) + (size_t)e * DM * DEXP, WGU + (size_t)e * 2 * DEXP * DM, DEXP, DEXP, (r2 / 6) * 64, (r2 % 6) * 256, DM, 1 + up}; } else { qq_ -= n_gu; \
                    if (qq_ < n_d) { const int e = qq_ / 192, r = qq_ % 192; u_ = CvU{wd + (size_t)e * DEXP * DM, WD + (size_t)e * DM * DEXP, DM, DM, (r >> 3) * 64, (r & 7) * 256, DEXP, 0}; } else { qq_ -= n_d; \
                    u_ = CvU{wglu, GLU, BW, BW, (qq_ >> 1) * 64, (qq_ & 1) * 256, BW, 0}; } } } } } } while (0)
                __syncthreads();
                int q = bid; int buf = 0; CvU u; float4 r[8];
                if (q < total) { CV_DECODE(q, u); cv_load(u, r, tid); }
                while (q < total) {
                    float* T = sf + buf * (64 * 257);
                    cv_stage(T, r, tid);
                    __syncthreads();
                    const CvU cur = u; const int qn = q + G;
                    if (qn < total) { CV_DECODE(qn, u); cv_load(u, r, tid); }
                    cv_store(cur, T, tid);
                    buf ^= 1; q = qn;
                }
#undef CV_DECODE
                __syncthreads();
            }
            for (int set = 0; set < (lastl ? 1 : 2); ++set) {
                const int L = set ? CTXL : SEQ; float* HR = HRAW + (set ? (size_t)SEQ * 2048 : 0);
                const float* w1 = PT(11) + l * 33 * 64; const float* b1 = PT(12) + l * 64; const float* fr1 = PT(13) + l * 64; const float* w2 = PT(14) + l * 64 * 64; const float* b2 = PT(15) + l * 64;
                const float* fr2 = PT(16) + l * 64; const float* w3 = PT(17) + l * 64 * 2048; const float* decay = PT(18) + l * 2048;
                float* feats = sf; float* h1 = sf + 16 * 33; float* h2 = h1 + 16 * 64;
                float nacc[4] = {0.f, 0.f, 0.f, 0.f};
                for (int base = bid; base < L; base += 16 * G) {
                    __syncthreads();
                    for (int e = tid; e < 16 * 33; e += NTHR) { const int ti = e / 33, fi = e % 33; int t = base + ti * G; if (t > L - 1) t = L - 1;
                        float v;
                        if (fi == 0) v = (float)t / (float)(L - 1);
                        else { const int j = (fi - 1) & 15; const double fr = 1e-4 + (double)j * ((15.0 - 1e-4) / 15.0); const double ang = (2.0 * 3.14159265358979323846 / (double)L) * (double)t * fr; v = fi <= 16 ? (float)cos(ang) : (float)(-sin(ang)); }
                        feats[e] = v; }
                    __syncthreads();
                    { const int j = tid & 63, ti = tid >> 6; float s0 = b1[j], s1 = s0;
_Pragma("unroll 3")
                      for (int i = 0; i < 33; ++i) { const float wv = w1[i * 64 + j]; s0 += feats[ti * 33 + i] * wv; s1 += feats[(ti + 8) * 33 + i] * wv; }
                      const float f1 = fr1[j]; h1[ti * 64 + j] = sinf(f1 * s0); h1[(ti + 8) * 64 + j] = sinf(f1 * s1); }
                    __syncthreads();
                    { const int j = tid & 63, ti = tid >> 6; float s0 = b2[j], s1 = s0;
_Pragma("unroll 4")
                      for (int i = 0; i < 64; ++i) { const float wv = w2[i * 64 + j]; s0 += h1[ti * 64 + i] * wv; s1 += h1[(ti + 8) * 64 + i] * wv; }
                      const float f2 = fr2[j]; h2[ti * 64 + j] = sinf(f2 * s0); h2[(ti + 8) * 64 + j] = sinf(f2 * s1); }
                    __syncthreads();
                    float acc[16][4];
#pragma unroll
                    for (int ti = 0; ti < 16; ++ti) { acc[ti][0] = 0.f; acc[ti][1] = 0.f; acc[ti][2] = 0.f; acc[ti][3] = 0.f; }
#pragma unroll 2
                    for (int i = 0; i < 64; ++i) { const float* wrow = w3 + (size_t)i * 2048 + tid; const float wa = wrow[0], wb = wrow[512], wc2 = wrow[1024], wd2 = wrow[1536];
#pragma unroll
                        for (int ti = 0; ti < 16; ++ti) { const float hv = h2[ti * 64 + i]; acc[ti][0] += hv * wa; acc[ti][1] += hv * wb; acc[ti][2] += hv * wc2; acc[ti][3] += hv * wd2; } }
                    float dk[4];
#pragma unroll
                    for (int k = 0; k < 4; ++k) dk[k] = fabsf(decay[tid + k * 512]);
#pragma unroll
                    for (int ti = 0; ti < 16; ++ti) { const int t = base + ti * G; if (t < L) { const float tn = (float)t / (float)(L - 1);
#pragma unroll
                        for (int k = 0; k < 4; ++k) { const float v = acc[ti][k] * expf(-tn * dk[k]); HR[(size_t)t * 2048 + tid + k * 512] = v; nacc[k] += fabsf(v); } } }
                }
                float* nrm = NORM + (size_t)(l * 2 + set) * 1024;
#pragma unroll
                for (int k = 0; k < 4; ++k) atomicAdd(nrm + (k >> 1) * 512 + tid, nacc[k]);
            }
            for (int idx = bid * NTHR + tid; idx < 4096; idx += G * NTHR) { const int n = idx & 63, g = (idx >> 6) & 31, dir = idx >> 11;
                const double are = (double)(PT(24) + l * 4096)[idx], aim = (double)(PT(25) + l * 4096)[idx]; const double lam = are < -1e-4 ? are : -1e-4; const double dt = exp((double)(PT(26) + l * 64)[dir * 32 + g]);
                const double ldre = lam * dt, ldim = aim * dt; LDT[idx] = make_double2(ldre, ldim);
                const double mag = exp(ldre); const double ar = mag * cos(ldim), ai = mag * sin(ldim);
                const double den = lam * lam + aim * aim; const double nr = ar - 1.0, ni = ai; const double fre = (nr * lam + ni * aim) / den, fim = (ni * lam - nr * aim) / den;
                const float* b_re = PT(27) + l * 32 * 64 * 16; const float* b_im = PT(28) + l * 32 * 64 * 16;
#pragma unroll 4
                for (int c = 0; c < 16; ++c) { const double br = (double)b_re[(g * 64 + n) * 16 + c], bi = (double)b_im[(g * 64 + n) * 16 + c]; BBT[idx * 16 + c] = make_float2((float)(fre * br - fim * bi), (float)(fre * bi + fim * br)); }
#pragma unroll 1
                for (int k = 0; k <= 32; ++k) { const double mk = exp(ldre * k); APW[idx * 33 + k] = make_float2((float)(mk * cos(ldim * k)), (float)(mk * sin(ldim * k))); }
            }
            for (int tok = bid * 8 + wave; tok < NTOK; tok += G * 8) {
                const int r = tok < NLAT ? tok / SEQ : 4; const float* xr = XS + (size_t)tok * DM; const float* gn = norm_mix + l * DM;
                const float* sh = MODl + (size_t)(r * 6 + 0) * DM; const float* sc = MODl + (size_t)(r * 6 + 1) * DM;
                float4 v[8]; float ss = 0.f;
#pragma unroll
                for (int i = 0; i < 8; ++i) { v[i] = *(const float4*)(xr + i * 256 + lane * 4); ss += v[i].x * v[i].x + v[i].y * v[i].y + v[i].z * v[i].z + v[i].w * v[i].w; }
                ss = wave_sum(ss); const float rs = rsqrtf(ss * (1.0f / DM) + 1e-6f);
#pragma unroll
                for (int i = 0; i < 8; ++i) { const int d = i * 256 + lane * 4; const float4 g4 = *(const float4*)(gn + d), s4 = *(const float4*)(sc + d), h4 = *(const float4*)(sh + d);
                    u32x2 w; w.x = pk2(v[i].x * rs * g4.x * (1.f + s4.x) + h4.x, v[i].y * rs * g4.y * (1.f + s4.y) + h4.y); w.y = pk2(v[i].z * rs * g4.z * (1.f + s4.z) + h4.z, v[i].w * rs * g4.w * (1.f + s4.w) + h4.w);
                    *(u32x2*)(HB + (size_t)tok * DM + d) = w; }
            }
            SEAM(PB + 0);
        }

        if (IN(PB + 1)) for (int rep_ = 0; rep_ < PROBE_REPS(1); ++rep_) {
            PH_BEGIN
            for (int idx = bid * NTHR + tid; idx < 32768; idx += G * NTHR) { const int c = idx & 15, lag = (idx >> 4) & 31, dir = (idx >> 9) & 1, g = idx >> 10;
                const float* c_re = PT(29) + l * 32 * 16 * 64 + (g * 16 + c) * 64; const float* c_im = PT(30) + l * 32 * 16 * 64 + (g * 16 + c) * 64;
                float acc[16];
#pragma unroll
                for (int j = 0; j < 16; ++j) acc[j] = 0.f;
#pragma unroll 2
                for (int n = 0; n < 64; ++n) { const int pi = (dir * 32 + g) * 64 + n; const float2 ap = APW[pi * 33 + lag]; const float cr = c_re[n], ci = c_im[n]; const float wr_ = cr * ap.x - ci * ap.y, wi_ = cr * ap.y + ci * ap.x;
                    const float4* bb = (const float4*)(BBT + pi * 16);
#pragma unroll
                    for (int j = 0; j < 8; ++j) { const float4 b2 = bb[j]; acc[2 * j] += wr_ * b2.x - wi_ * b2.y; acc[2 * j + 1] += wr_ * b2.z - wi_ * b2.w; } }
                float4* o = (float4*)(KTB + (size_t)idx * 16);
                o[0] = make_float4(acc[0], acc[1], acc[2], acc[3]); o[1] = make_float4(acc[4], acc[5], acc[6], acc[7]); o[2] = make_float4(acc[8], acc[9], acc[10], acc[11]); o[3] = make_float4(acc[12], acc[13], acc[14], acc[15]);
            }
            __syncthreads();
            pg8::Gemm g{HB, WIN, DM, DM, DM}; pg8::SchedStd S{68, 55, G, bid, DM, DM}; pg8::EpiBf16Store E{P, LDP};
            pg8::gemm_phase(( LAS unsigned char*)shm, g, S, E);
            SEAM(PB + 1);
        }

        if (IN(PB + 2)) for (int rep_ = 0; rep_ < PROBE_REPS(2); ++rep_) {
            PH_BEGIN
            const float* hcw = PT(9) + l * 3 * 1536; const float* hcb = PT(10) + l * 1536; const float* mcw = PT(20) + l * 3 * 1024; const float* mcb = PT(21) + l * 1024;
            const float* scw = PT(34) + l * 3 * 1024; const float* scb = PT(35) + l * 1024;
            for (int unit = bid; unit < 272 * 2; unit += G) { const int seg = unit >> 1, hf = unit & 1; const bool lat = seg < 256; const size_t tok0 = lat ? (size_t)seg * 64 : (size_t)NLAT + (size_t)(seg - 256) * 64;
                const int c = tid * 2; const int col = (hf ? SSD_OFF + 512 : ML_OFF) + c; const float* w = hf ? scw : mcw; const float* bsp = hf ? scb : mcb; bf16_t* dst = (hf ? XBC : QKB) + tok0 * 1024 + c;
                const float2 w0 = *(const float2*)(w + c), w1 = *(const float2*)(w + 1024 + c), w2 = *(const float2*)(w + 2048 + c), bb = *(const float2*)(bsp + c);
                const float osc = (!hf && c >= 512) ? 0.08838834764831845f : 1.0f;
                const bool hasPrev = !lat && ((tok0 - NLAT) & (CTXL - 1)) != 0, hasNext = !lat && (((tok0 - NLAT) + 63) & (CTXL - 1)) != CTXL - 1;
                const bf16_t* pp = P + tok0 * LDP + col;
                unsigned raw[66];
#pragma unroll
                for (int t = 0; t < 66; ++t) raw[t] = ((t == 0 && !hasPrev) || (t == 65 && !hasNext)) ? 0u : *(const unsigned*)(pp + (ptrdiff_t)(t - 1) * LDP);
#pragma unroll
                for (int t = 0; t < 64; ++t) { const unsigned p0 = raw[t], p1 = raw[t + 1], p2 = raw[t + 2];
                    float a0 = bb.x + w0.x * __uint_as_float(p0 << 16) + w1.x * __uint_as_float(p1 << 16) + w2.x * __uint_as_float(p2 << 16);
                    float a1 = bb.y + w0.y * __uint_as_float(p0 & 0xFFFF0000u) + w1.y * __uint_as_float(p1 & 0xFFFF0000u) + w2.y * __uint_as_float(p2 & 0xFFFF0000u);
                    a0 = siluf_(a0) * osc; a1 = siluf_(a1) * osc;
                    *(unsigned*)(dst + (size_t)t * 1024) = pk2(a0, a1); }
            }
            if (!lastl) for (int tok = NLAT + bid; tok < NTOK; tok += G) {
                const int t = (tok - NLAT) & (CTXL - 1); const bool hasL = (t != 0), hasR = (t != CTXL - 1); const bf16_t* pr = P + (size_t)tok * LDP;
#pragma unroll
                for (int j = 0; j < 3; ++j) { const int cc = tid + j * 512;
                    float acc = hcb[cc] + hcw[1536 + cc] * bf2f(pr[HY_OFF + cc]);
                    if (hasL) acc += hcw[cc] * bf2f(pr[HY_OFF + cc - LDP]);
                    if (hasR) acc += hcw[2 * 1536 + cc] * bf2f(pr[HY_OFF + cc + LDP]);
                    U[(size_t)tok * 1536 + cc] = acc; }
            }
            for (int idx = bid * NTHR + tid; idx < 16384 * 64; idx += G * NTHR) { const int half = idx & 1, g = (idx >> 1) & 31, tok = idx >> 6;
                *(u32x4*)(S5A + ((size_t)g * 512 + (tok >> 5)) * 768 + (tok & 31) * 16 + half * 8) = *(const u32x4*)(P + (size_t)tok * LDP + S5_OFF + g * 16 + half * 8); }
            for (int idx = bid * NTHR + tid; idx < 32 * 512 * 32 * 2; idx += G * NTHR) { const int half = idx & 1, sI = (idx >> 1) & 31, row = (idx >> 6) & 511, g = idx >> 15; const int t = row >> 4, c = row & 15; const int lag = t - sI;
                float v[8];
                if (lag > 0) { const float4* k4 = (const float4*)(KTB + ((size_t)((g * 2 + 0) * 32 + lag) * 16 + c) * 16 + half * 8); const float4 a0 = k4[0], a1 = k4[1]; v[0] = a0.x; v[1] = a0.y; v[2] = a0.z; v[3] = a0.w; v[4] = a1.x; v[5] = a1.y; v[6] = a1.z; v[7] = a1.w; }
                else if (lag < 0) { const float4* k4 = (const float4*)(KTB + ((size_t)((g * 2 + 1) * 32 - lag) * 16 + c) * 16 + half * 8); const float4 a0 = k4[0], a1 = k4[1]; v[0] = a0.x; v[1] = a0.y; v[2] = a0.z; v[3] = a0.w; v[4] = a1.x; v[5] = a1.y; v[6] = a1.z; v[7] = a1.w; }
                else { const float4* k4 = (const float4*)(KTB + ((size_t)((g * 2 + 0) * 32) * 16 + c) * 16 + half * 8); const float4* q4 = (const float4*)(KTB + ((size_t)((g * 2 + 1) * 32) * 16 + c) * 16 + half * 8); const float4 a0 = k4[0], a1 = k4[1], b0 = q4[0], b1 = q4[1];
                    v[0] = a0.x + b0.x; v[1] = a0.y + b0.y; v[2] = a0.z + b0.z; v[3] = a0.w + b0.w; v[4] = a1.x + b1.x; v[5] = a1.y + b1.y; v[6] = a1.z + b1.z; v[7] = a1.w + b1.w; }
                u32x4 w; w.x = pk2(v[0], v[1]); w.y = pk2(v[2], v[3]); w.z = pk2(v[4], v[5]); w.w = pk2(v[6], v[7]);
                *(u32x4*)(S5B + ((size_t)g * 512 + row) * 768 + sI * 16 + half * 8) = w; }
            for (int idx = bid * NTHR + tid; idx < 32 * 512 * 64; idx += G * NTHR) { const int n = idx & 63, row = (idx >> 6) & 511, g = idx >> 15; const int t = row >> 4, c = row & 15;
                const float cr = (PT(29) + l * 32 * 16 * 64)[(g * 16 + c) * 64 + n], ci = (PT(30) + l * 32 * 16 * 64)[(g * 16 + c) * 64 + n];
                const float2 af = APW[((0 * 32 + g) * 64 + n) * 33 + t + 1], ab = APW[((1 * 32 + g) * 64 + n) * 33 + 32 - t];
                bf16_t* d = S5B + ((size_t)g * 512 + row) * 768 + 512 + 2 * n;
                *(unsigned*)d = pk2(cr * af.x - ci * af.y, -(cr * af.y + ci * af.x)); *(unsigned*)(d + 128) = pk2(cr * ab.x - ci * ab.y, -(cr * ab.y + ci * ab.x)); }
            for (int idx = bid * NTHR + tid; idx < 32 * 2 * 64 * 32; idx += G * NTHR) { const int sI = idx & 31, n = (idx >> 5) & 63, dir = (idx >> 11) & 1, g = idx >> 12; const int pi = (dir * 32 + g) * 64 + n;
                const float2 pw = APW[pi * 33 + (dir ? sI : 31 - sI)]; const float4* bb = (const float4*)(BBT + pi * 16);
                float re[16], im[16];
#pragma unroll
                for (int j = 0; j < 8; ++j) { const float4 b2 = bb[j]; re[2 * j] = pw.x * b2.x - pw.y * b2.y; im[2 * j] = pw.x * b2.y + pw.y * b2.x; re[2 * j + 1] = pw.x * b2.z - pw.y * b2.w; im[2 * j + 1] = pw.x * b2.w + pw.y * b2.z; }
                bf16_t* d = S5P + ((size_t)g * 256 + dir * 128 + 2 * n) * 512 + sI * 16;
                u32x4 w0, w1; w0.x = pk2(re[0], re[1]); w0.y = pk2(re[2], re[3]); w0.z = pk2(re[4], re[5]); w0.w = pk2(re[6], re[7]); w1.x = pk2(re[8], re[9]); w1.y = pk2(re[10], re[11]); w1.z = pk2(re[12], re[13]); w1.w = pk2(re[14], re[15]);
                *(u32x4*)d = w0; *(u32x4*)(d + 8) = w1;
                w0.x = pk2(im[0], im[1]); w0.y = pk2(im[2], im[3]); w0.z = pk2(im[4], im[5]); w0.w = pk2(im[6], im[7]); w1.x = pk2(im[8], im[9]); w1.y = pk2(im[10], im[11]); w1.z = pk2(im[12], im[13]); w1.w = pk2(im[14], im[15]);
                *(u32x4*)(d + 512) = w0; *(u32x4*)(d + 520) = w1; }
            {   float* T = sf;
                for (int unit = bid; unit < 4 * 64 * 24; unit += G) { const int b = unit / (64 * 24), r = (unit / 24) % 64, c0 = (unit % 24) * 64; const size_t tok0 = (size_t)b * SEQ + r * 64;
                    __syncthreads();
#pragma unroll
                    for (int i = 0; i < 8; ++i) { const int c = tid & 63, t = (tid >> 6) + 8 * i; T[t * 65 + c] = bf2f(P[(tok0 + t) * LDP + HY_OFF + c0 + c]); }
                    __syncthreads();
                    const int c = tid >> 3, tq = (tid & 7) * 8, cc = c0 + c; const float w0 = hcw[cc], w1 = hcw[1536 + cc], w2 = hcw[3072 + cc], bb = hcb[cc];
                    float o8[8];
#pragma unroll
                    for (int i = 0; i < 8; ++i) { const int t = tq + i; float acc = bb + w1 * T[t * 65 + c]; if (t > 0) acc += w0 * T[(t - 1) * 65 + c]; if (t < 63) acc += w2 * T[(t + 1) * 65 + c]; o8[i] = acc; }
                    float* dst = UT + ((size_t)b * 1536 + cc) * SEQ + r * 64 + tq;
                    *(float4*)dst = make_float4(o8[0], o8[1], o8[2], o8[3]); *(float4*)(dst + 4) = make_float4(o8[4], o8[5], o8[6], o8[7]);
                } }
            if (!lastl) {
                const int L = CTXL; const float* HR = HRAW + (size_t)SEQ * 2048; float* K2 = K2C; const float* nrm = NORM + (size_t)(l * 2 + 1) * 1024;
                const size_t total = (size_t)(2 * L - 1) * 1024;
                for (size_t i = (size_t)bid * NTHR + tid; i < total; i += (size_t)G * NTHR) { const int j = (int)(i >> 10), oc = (int)(i & 1023), o = oc >> 9, c = oc & 511; const int lag = j - (L - 1);
                    const float v = lag >= 0 ? HR[(size_t)lag * 2048 + o * 1024 + c] : HR[(size_t)(-lag) * 2048 + o * 1024 + 512 + c];
                    K2[((size_t)j * 2 + o) * 512 + c] = v / nrm[oc]; }
            }
            {   __syncthreads(); fft_twiddles((float2*)(shm + FFT_X_BYTES), tid);
                for (int oc = bid; oc < 1024; oc += G) hyena_spec_item(oc, HRAW, NORM + (size_t)(l * 2 + 0) * 1024, HSPEC, shm, tid);
                __syncthreads(); }
            SEAM(PB + 2);
        }

        if (IN(PB + 3)) for (int rep_ = 0; rep_ < PROBE_REPS(3); ++rep_) {
            PH_BEGIN
            if (bid < 32) {
                mlstm_state_pass(bid, P, QKB, PT(22) + l * 16, CST, NST, MST, shm, tid);
            } else if (bid < 96) {
                { const int ch = bid - 32; const int dir_ = ch & 1, h_ = (ch >> 1) & 7; ssd_state_pass(ch, P, XBC, -expf(PT(37)[l * 16 + dir_ * 8 + h_]), PT(36)[l * 16 + dir_ * 8 + h_], SSTB, shm, tid); }
            } else if (bid < 128) {
                const int widx = (bid - 96) * 8 + wave; const int dir = widx & 1, g = (widx >> 1) & 31, b = widx >> 6; const int n = lane;
                float2* xb = (float2*)(shm + (size_t)wave * 16640); float2* ctab = xb + 16 * 65;
                const float* a_re = PT(24) + l * 2 * 32 * 64; const float* a_im = PT(25) + l * 2 * 32 * 64; const float* log_dt = PT(26) + l * 64;
                const float* b_re = PT(27) + l * 32 * 64 * 16; const float* b_im = PT(28) + l * 32 * 64 * 16; const float* c_re = PT(29) + l * 32 * 16 * 64; const float* c_im = PT(30) + l * 32 * 16 * 64;
#pragma unroll
                for (int c = 0; c < 16; ++c) ctab[c * 65 + lane] = make_float2(c_re[(g * 16 + c) * 64 + lane], c_im[(g * 16 + c) * 64 + lane]);
                float abr, abi, bbr[16], bbi[16];
                {   const double are = (double)a_re[(dir * 32 + g) * 64 + n], aim = (double)a_im[(dir * 32 + g) * 64 + n];
                    const double lam = are < -1e-4 ? are : -1e-4; const double dt = exp((double)log_dt[dir * 32 + g]);
                    const double mag = exp(lam * dt); const double ar = mag * cos(aim * dt), ai = mag * sin(aim * dt);
                    const double den = lam * lam + aim * aim; const double nr = ar - 1.0, ni = ai;
                    const double fre = (nr * lam + ni * aim) / den, fim = (ni * lam - nr * aim) / den;
                    abr = (float)ar; abi = (float)ai;
#pragma unroll
                    for (int c = 0; c < 16; ++c) { const double br = (double)b_re[(g * 64 + n) * 16 + c], bi = (double)b_im[(g * 64 + n) * 16 + c]; bbr[c] = (float)(fre * br - fim * bi); bbi[c] = (float)(fre * bi + fim * br); }
                }
                float xr = 0.f, xi = 0.f; float* Sout = (dir ? SB : SF) - (size_t)NLAT * BW;
                const int s = lane >> 2, cg = lane & 3;
                for (int i0 = 0; i0 < CTXL; i0 += 16) {
#pragma unroll 4
                    for (int ss = 0; ss < 16; ++ss) {
                        const size_t tok = (size_t)step_tok(b, dir, i0 + ss);
                        const u32x4* up = (const u32x4*)(P + tok * LDP + S5_OFF + g * 16);
                        float t0[8], t1[8]; unpack8(up[0], t0); unpack8(up[1], t1);
                        float bur = 0.f, bui = 0.f;
#pragma unroll
                        for (int c = 0; c < 8; ++c) { bur += t0[c] * bbr[c] + t1[c] * bbr[8 + c]; bui += t0[c] * bbi[c] + t1[c] * bbi[8 + c]; }
                        const float nxr = abr * xr - abi * xi + bur, nxi = abr * xi + abi * xr + bui; xr = nxr; xi = nxi;
                        xb[ss * 65 + lane] = make_float2(xr, xi);
                    }
                    asm volatile("s_waitcnt lgkmcnt(0)" ::: "memory");
                    float y0 = 0.f, y1 = 0.f, y2 = 0.f, y3 = 0.f;
                    for (int nn2 = 0; nn2 < 64; ++nn2) { const float2 xv = xb[s * 65 + nn2];
                        const float2 c0 = ctab[(cg * 4 + 0) * 65 + nn2], c1 = ctab[(cg * 4 + 1) * 65 + nn2], c2 = ctab[(cg * 4 + 2) * 65 + nn2], c3 = ctab[(cg * 4 + 3) * 65 + nn2];
                        y0 += xv.x * c0.x - xv.y * c0.y; y1 += xv.x * c1.x - xv.y * c1.y; y2 += xv.x * c2.x - xv.y * c2.y; y3 += xv.x * c3.x - xv.y * c3.y; }
                    const size_t toks = (size_t)step_tok(b, dir, i0 + s);
                    *(float4*)(Sout + toks * BW + g * 16 + cg * 4) = make_float4(y0, y1, y2, y3);
                    asm volatile("s_waitcnt lgkmcnt(0)" ::: "memory");
                }
                XCTX[((b * 32 + g) * 2 + dir) * 64 + n] = make_float2(xr, xi);
            } else {
                if (bid < 192) {
                    pg8::Gemm gg_{S5A, S5P, 768, 512, 512}; pg8::SchedS5a S_{bid - 128}; pg8::EpiXloc E_{XLOC};
                    pg8::gemm_phase((LAS unsigned char*)shm, gg_, S_, E_);
                    __syncthreads();
                }
                const int nhb = G - 128, hb = bid - 128; const float* bias = PT(19) + l * 1024; const int c = tid;
                const int nitems = lastl ? 0 : 4 * (CTXL / 8);
                for (int it = hb; it < nitems; it += nhb) {
                    int L, tokbase, b, t0; const float* K2;
                    { const int q = it; L = CTXL; tokbase = NLAT; b = q / (CTXL / 8); t0 = (q % (CTXL / 8)) * 8; K2 = K2C; }
                    const float* zb = U + (size_t)(tokbase + b * L) * 1536 + c;
                    float acc[8];
#pragma unroll
                    for (int i = 0; i < 8; ++i) acc[i] = 0.f;
                    const int base = t0 + L - 1;
                    for (int s = 0; s < L; s += 8) {
                        float k[15];
#pragma unroll
                        for (int mm = 0; mm < 15; ++mm) k[mm] = K2[((size_t)(base - s - 7 + mm) * 2 + 0) * 512 + c];
#pragma unroll
                        for (int ds = 0; ds < 8; ++ds) { const float z = zb[(size_t)(s + ds) * 1536];
#pragma unroll
                            for (int i = 0; i < 8; ++i) acc[i] += k[i - ds + 7] * z; }
                    }
#pragma unroll
                    for (int i = 0; i < 8; ++i) { const size_t tok = (size_t)(tokbase + b * L + t0 + i); const float zt = U[tok * 1536 + c]; Z[tok * BW + c] = (acc[i] + bias[c] * zt) * U[tok * 1536 + 512 + c]; }
                }
            }
            {   __syncthreads(); fft_twiddles((float2*)(shm + FFT_X_BYTES), tid);
                int* qslot = (int*)(shm + FFT_X_BYTES + 32768);
                for (;;) { __syncthreads(); if (tid == 0) *qslot = atomicAdd(QCTR + l * 64, 1); __syncthreads(); const int it = *qslot; if (it >= 1024) break;
                    hyena_fft_item(it, UT, HSPEC, PT(19) + l * 1024, YT, shm, tid); }
            }
            SEAM(PB + 3);
        }

        if (IN(PB + 4)) for (int rep_ = 0; rep_ < PROBE_REPS(4); ++rep_) {
            PH_BEGIN
            if (bid >= G - 32) for (int idx = (bid - (G - 32)) * NTHR + tid; idx < 16384; idx += 32 * NTHR) { const int n = idx & 63, dir = (idx >> 6) & 1, b = (idx >> 7) & 3, g = idx >> 9;
                const float2 a32 = APW[((dir * 32 + g) * 64 + n) * 33 + 32]; float2 X = XCTX[((b * 32 + g) * 2 + dir) * 64 + n];
                const float* __restrict__ xl = XLOC + ((size_t)g * 512 + b * 128) * 256 + dir * 128 + 2 * n; bf16_t* __restrict__ dst = S5A + ((size_t)g * 512 + b * 128) * 768 + 512 + dir * 128 + 2 * n;
#pragma unroll 8
                for (int jj = 0; jj < 128; ++jj) { const int j = dir ? 127 - jj : jj; const float2 xv = *(const float2*)(xl + (size_t)j * 256);
                    *(unsigned*)(dst + (size_t)j * 768) = pk2(X.x, X.y);
                    const float nx = a32.x * X.x - a32.y * X.y + xv.x, ny = a32.x * X.y + a32.y * X.x + xv.y; X.x = nx; X.y = ny; } }
            {   int* qslot = (int*)(shm + 102400);
                for (;;) { __syncthreads(); if (tid == 0) *qslot = atomicAdd(QCTR + l * 64 + 32, 1); __syncthreads(); const int it = *qslot; if (it >= 32 * 68 + 64 * 68) break;
                    if (it < 32 * 68) { const int chain = it / 68, c = it % 68; mlstm_out_item(chain, c, P, QKB, PT(22) + l * 16, CST, NST, MST, (chain & 1) ? HBk : HF, shm, tid); }
                    else { const int i2 = it - 32 * 68; const int chain = i2 / 68, c = i2 % 68; const int dir_ = chain & 1, h_ = (chain >> 1) & 7;
                        ssd_out_item(chain, c, P, XBC, -expf(PT(37)[l * 16 + dir_ * 8 + h_]), PT(36)[l * 16 + dir_ * 8 + h_], SSTB, dir_ ? YB : YF, shm, tid); } }
            }
            __syncthreads();
            {   const float* bias = PT(19) + l * 1024 + 512; const int c = tid;
                const int nitems = lastl ? 0 : 4 * (CTXL / 8);
                for (int it = bid; it < nitems; it += G) {
                    int L, tokbase, b, t0; const float* K2;
                    { const int q = it; L = CTXL; tokbase = NLAT; b = q / (CTXL / 8); t0 = (q % (CTXL / 8)) * 8; K2 = K2C; }
                    const float* zb = Z + (size_t)(tokbase + b * L) * BW + c;
                    float acc[8];
#pragma unroll
                    for (int i = 0; i < 8; ++i) acc[i] = 0.f;
                    const int base = t0 + L - 1;
                    for (int s = 0; s < L; s += 8) {
                        float k[15];
#pragma unroll
                        for (int mm = 0; mm < 15; ++mm) k[mm] = K2[((size_t)(base - s - 7 + mm) * 2 + 1) * 512 + c];
#pragma unroll
                        for (int ds = 0; ds < 8; ++ds) { const float z = zb[(size_t)(s + ds) * BW];
#pragma unroll
                            for (int i = 0; i < 8; ++i) acc[i] += k[i - ds + 7] * z; }
                    }
#pragma unroll
                    for (int i = 0; i < 8; ++i) { const size_t tok = (size_t)(tokbase + b * L + t0 + i); const float zt = Z[tok * BW + c]; Y4[tok * DM + c] = f2bf((acc[i] + bias[c] * zt) * U[tok * 1536 + 1024 + c]); }
                }
            }
            SEAM(PB + 4);
        }

        if (IN(PB + 5)) for (int rep_ = 0; rep_ < PROBE_REPS(5); ++rep_) {
            PH_BEGIN
            const float* ml_norm = PT(23) + l * BW; const float* ssd_d = PT(38) + l * 8; const float* ssd_norm = PT(39) + l * BW; const float* s5_d = PT(31) + l * BW;
            if (bid < 128) {
                pg8::Gemm gg_{S5A, S5B, 768, 768, 768}; pg8::SchedS5b S_{bid}; pg8::EpiS5Out E_{P, s5_d, GG};
                pg8::gemm_phase((LAS unsigned char*)shm, gg_, S_, E_);
                __syncthreads();
            }
            for (int tok = bid * 8 + wave; tok < NTOK; tok += G * 8) {
                const int c0 = lane * 8; const bf16_t* pr = P + (size_t)tok * LDP; const size_t o5 = (size_t)tok * BW + c0;
                float hm[8], ys[8];
                { const float4 a0 = *(const float4*)(HF + o5), a1 = *(const float4*)(HF + o5 + 4), b0 = *(const float4*)(HBk + o5), b1 = *(const float4*)(HBk + o5 + 4);
                  hm[0] = a0.x + b0.x; hm[1] = a0.y + b0.y; hm[2] = a0.z + b0.z; hm[3] = a0.w + b0.w; hm[4] = a1.x + b1.x; hm[5] = a1.y + b1.y; hm[6] = a1.z + b1.z; hm[7] = a1.w + b1.w; }
                { const float4 a0 = *(const float4*)(YF + o5), a1 = *(const float4*)(YF + o5 + 4), b0 = *(const float4*)(YB + o5), b1 = *(const float4*)(YB + o5 + 4);
                  float xx[8], zz[8]; unpack8(*(const u32x4*)(XBC + (size_t)tok * 1024 + c0), xx); unpack8(*(const u32x4*)(pr + SSD_OFF + c0), zz); const float dsk = ssd_d[c0 >> 6];
                  ys[0] = a0.x + b0.x; ys[1] = a0.y + b0.y; ys[2] = a0.z + b0.z; ys[3] = a0.w + b0.w; ys[4] = a1.x + b1.x; ys[5] = a1.y + b1.y; ys[6] = a1.z + b1.z; ys[7] = a1.w + b1.w;
#pragma unroll
                  for (int j = 0; j < 8; ++j) ys[j] = (ys[j] + dsk * xx[j]) * siluf_(zz[j]); }
                float s1 = 0.f, s2 = 0.f;
#pragma unroll
                for (int j = 0; j < 8; ++j) { s1 += hm[j] * hm[j]; s2 += ys[j] * ys[j]; }
                s1 += __shfl_xor(s1, 1); s1 += __shfl_xor(s1, 2); s1 += __shfl_xor(s1, 4); s1 += __shfl_xor(s1, 8);
                s2 = wave_sum(s2);
                const float r1 = rsqrtf(s1 * (1.0f / 128.0f) + 1e-6f), r2 = rsqrtf(s2 * (1.0f / BW) + 1e-6f);
                float oo[8]; unpack8(*(const u32x4*)(pr + ML_OFF + 1536 + c0), oo);
                const float4 g0 = *(const float4*)(ml_norm + c0), g1 = *(const float4*)(ml_norm + c0 + 4), n0 = *(const float4*)(ssd_norm + c0), n1 = *(const float4*)(ssd_norm + c0 + 4);
                const float gm[8] = {g0.x, g0.y, g0.z, g0.w, g1.x, g1.y, g1.z, g1.w}, gs[8] = {n0.x, n0.y, n0.z, n0.w, n1.x, n1.y, n1.z, n1.w};
                u32x4 w;
                w.x = pk2(hm[0] * r1 * gm[0] * sigmoidf_(oo[0]), hm[1] * r1 * gm[1] * sigmoidf_(oo[1])); w.y = pk2(hm[2] * r1 * gm[2] * sigmoidf_(oo[2]), hm[3] * r1 * gm[3] * sigmoidf_(oo[3]));
                w.z = pk2(hm[4] * r1 * gm[4] * sigmoidf_(oo[4]), hm[5] * r1 * gm[5] * sigmoidf_(oo[5])); w.w = pk2(hm[6] * r1 * gm[6] * sigmoidf_(oo[6]), hm[7] * r1 * gm[7] * sigmoidf_(oo[7]));
                *(u32x4*)(Y4 + (size_t)tok * DM + 512 + c0) = w;
                w.x = pk2(ys[0] * r2 * gs[0], ys[1] * r2 * gs[1]); w.y = pk2(ys[2] * r2 * gs[2], ys[3] * r2 * gs[3]); w.z = pk2(ys[4] * r2 * gs[4], ys[5] * r2 * gs[5]); w.w = pk2(ys[6] * r2 * gs[6], ys[7] * r2 * gs[7]);
                *(u32x4*)(Y4 + (size_t)tok * DM + 1536 + c0) = w;
                if (tok >= NLAT) { const size_t oc = (size_t)(tok - NLAT) * BW + c0; float uu[8]; unpack8(*(const u32x4*)(pr + S5_OFF + c0), uu);
                    const float4 a0 = *(const float4*)(SF + oc), a1 = *(const float4*)(SF + oc + 4), b0 = *(const float4*)(SB + oc), b1 = *(const float4*)(SB + oc + 4), d0 = *(const float4*)(s5_d + c0), d1 = *(const float4*)(s5_d + c0 + 4);
                    float y[8] = {a0.x + b0.x + d0.x * uu[0], a0.y + b0.y + d0.y * uu[1], a0.z + b0.z + d0.z * uu[2], a0.w + b0.w + d0.w * uu[3], a1.x + b1.x + d1.x * uu[4], a1.y + b1.y + d1.y * uu[5], a1.z + b1.z + d1.z * uu[6], a1.w + b1.w + d1.w * uu[7]};
#pragma unroll
                    for (int j = 0; j < 8; ++j) y[j] = 0.5f * y[j] * (1.0f + tanhf(0.7978845608028654f * (y[j] + 0.044715f * y[j] * y[j] * y[j])));
                    w.x = pk2(y[0], y[1]); w.y = pk2(y[2], y[3]); w.z = pk2(y[4], y[5]); w.w = pk2(y[6], y[7]);
                    *(u32x4*)(GG + (size_t)tok * BW + c0) = w; }
            }
            __syncthreads();
            {   float* T = sf;
                for (int unit = (G > 128 ? bid - 128 : bid); unit >= 0 && unit < 4 * 64 * 8; unit += (G > 128 ? G - 128 : G)) { const int b = unit / 512, t0 = ((unit >> 3) & 63) * 64, c0 = (unit & 7) * 64;
                    __syncthreads();
#pragma unroll
                    for (int i = 0; i < 8; ++i) { const int t = tid & 63, c = (tid >> 6) + 8 * i; T[c * 65 + t] = YT[((size_t)b * 512 + c0 + c) * SEQ + t0 + t]; }
                    __syncthreads();
                    const int t = tid >> 3, cq = (tid & 7) * 8;
                    u32x4 w; w.x = pk2(T[(cq + 0) * 65 + t], T[(cq + 1) * 65 + t]); w.y = pk2(T[(cq + 2) * 65 + t], T[(cq + 3) * 65 + t]); w.z = pk2(T[(cq + 4) * 65 + t], T[(cq + 5) * 65 + t]); w.w = pk2(T[(cq + 6) * 65 + t], T[(cq + 7) * 65 + t]);
                    *(u32x4*)(Y4 + ((size_t)b * SEQ + t0 + t) * DM + c0 + cq) = w;
                } }
            SEAM(PB + 5);
        }

        if (IN(PB + 6)) for (int rep_ = 0; rep_ < PROBE_REPS(6); ++rep_) {
            PH_BEGIN
            pg8::Gemm g{GG, GLU, BW, BW, BW}; pg8::SchedStd S{68, 2, G, bid, BW, BW}; pg8::EpiGlu E{GG, PT(33) + l * BW, Y4};
            pg8::gemm_phase((LAS unsigned char*)shm, g, S, E);
            SEAM(PB + 6);
        }
        if (IN(PB + 7)) for (int rep_ = 0; rep_ < PROBE_REPS(7); ++rep_) {
            PH_BEGIN
            pg8::Gemm g{Y4, WBR, DM, BW, BW}; pg8::SchedBranch S{nPanels, 8, G, bid}; pg8::EpiBranch E{P, ACCb};
            pg8::gemm_phase((LAS unsigned char*)shm, g, S, E);
            SEAM(PB + 7);
        }
        if (IN(PB + 8)) for (int rep_ = 0; rep_ < PROBE_REPS(8); ++rep_) {
            PH_BEGIN
            pg8::Gemm g{ACCb, WOUT, DM, DM, DM}; pg8::SchedStd S{nPanels, 8, G, bid, DM, DM}; pg8::EpiResid E{XS, MODl, 2};
            pg8::gemm_phase((LAS unsigned char*)shm, g, S, E);
            SEAM(PB + 8);
        }
        if (IN(PB + 9)) for (int rep_ = 0; rep_ < PROBE_REPS(9); ++rep_) {
            PH_BEGIN
            for (int i = bid * NTHR + tid; i < NEXP * MOE_PAD; i += G * NTHR) ROWTOK[i] = -1;
            const float* wr = PT(42) + (size_t)l * DM * 16; const float* gn = norm_ffn + l * DM;
            for (int tok = bid * 8 + wave; tok < M2; tok += G * 8) {
                const int r = tok < NLAT ? tok / SEQ : 4; const float* xr = XS + (size_t)tok * DM;
                const float* sh = MODl + (size_t)(r * 6 + 3) * DM; const float* sc = MODl + (size_t)(r * 6 + 4) * DM;
                float ss = 0.f;
#pragma unroll 2
                for (int i = 0; i < 8; ++i) { const float4 t4 = *(const float4*)(xr + i * 256 + lane * 4); ss += t4.x * t4.x + t4.y * t4.y + t4.z * t4.z + t4.w * t4.w; }
                ss = wave_sum(ss); const float rs = rsqrtf(ss * (1.0f / DM) + 1e-6f);
                float lg[16];
#pragma unroll
                for (int e = 0; e < 16; ++e) lg[e] = 0.f;
#pragma unroll 1
                for (int i = 0; i < 8; ++i) { const int d = i * 256 + lane * 4; const float4 xv = *(const float4*)(xr + d);
                    const float4 g4 = *(const float4*)(gn + d), s4 = *(const float4*)(sc + d), h4 = *(const float4*)(sh + d);
                    const float hv[4] = {xv.x * rs * g4.x * (1.f + s4.x) + h4.x, xv.y * rs * g4.y * (1.f + s4.y) + h4.y, xv.z * rs * g4.z * (1.f + s4.z) + h4.z, xv.w * rs * g4.w * (1.f + s4.w) + h4.w};
                    u32x2 w; w.x = pk2(hv[0], hv[1]); w.y = pk2(hv[2], hv[3]); *(u32x2*)(HB + (size_t)tok * DM + d) = w;
                    const float4* wq = (const float4*)(wr + (size_t)d * 16);
#pragma unroll
                    for (int q = 0; q < 4; ++q) { const float4 w0 = wq[q * 4 + 0], w1 = wq[q * 4 + 1], w2 = wq[q * 4 + 2], w3 = wq[q * 4 + 3];
                        lg[0] += hv[q] * w0.x; lg[1] += hv[q] * w0.y; lg[2] += hv[q] * w0.z; lg[3] += hv[q] * w0.w; lg[4] += hv[q] * w1.x; lg[5] += hv[q] * w1.y; lg[6] += hv[q] * w1.z; lg[7] += hv[q] * w1.w;
                        lg[8] += hv[q] * w2.x; lg[9] += hv[q] * w2.y; lg[10] += hv[q] * w2.z; lg[11] += hv[q] * w2.w; lg[12] += hv[q] * w3.x; lg[13] += hv[q] * w3.y; lg[14] += hv[q] * w3.z; lg[15] += hv[q] * w3.w; } }
                float mx = -1e30f;
#pragma unroll
                for (int e = 0; e < 16; ++e) { lg[e] = wave_sum(lg[e]); mx = fmaxf(mx, lg[e]); }
                float s = 0.f;
#pragma unroll
                for (int e = 0; e < 16; ++e) { lg[e] = expf(lg[e] - mx); s += lg[e]; }
                const float inv = 1.0f / s;
                if (lane == 0) {
#pragma unroll
                    for (int e = 0; e < 16; e += 4) *(float4*)(PROBS + (size_t)tok * 16 + e) = make_float4(lg[e] * inv, lg[e + 1] * inv, lg[e + 2] * inv, lg[e + 3] * inv); }
            }
            SEAM(PB + 9);
        }
        if (IN(PB + 10)) for (int rep_ = 0; rep_ < PROBE_REPS(10); ++rep_) {
            PH_BEGIN
            const int nitems = 64 + (lastl ? 0 : 64);
            unsigned long long* keys = (unsigned long long*)shm;
            for (int it = bid; it < nitems; it += G) {
                const int set = it >> 6, e = it & 15, b = (it >> 4) & 3;
                const int n = set ? CTXL : SEQ, cap = set ? 32 : 512, tokbase = set ? NLAT + b * CTXL : b * SEQ;
                __syncthreads();
                for (int i = tid; i < n; i += NTHR) keys[i] = ((unsigned long long)__float_as_uint(PROBS[(size_t)(tokbase + i) * 16 + e]) << 32) | (unsigned long long)(0xFFFFFFFFu - (unsigned)i);
                __syncthreads();
                for (int k = 2; k <= n; k <<= 1)
                    for (int j = k >> 1; j > 0; j >>= 1) {
                        for (int p = tid; p < (n >> 1); p += NTHR) { const int i = ((p & ~(j - 1)) << 1) | (p & (j - 1)); const int m = i | j;
                            const unsigned long long ka = keys[i], kb = keys[m]; const bool desc = ((i & k) == 0);
                            if ((ka < kb) == desc) { keys[i] = kb; keys[m] = ka; } }
                        __syncthreads();
                    }
                for (int r = tid; r < cap; r += NTHR) { const unsigned long long kk = keys[r]; const int row = e * MOE_PAD + (set ? 2048 + b * 32 + r : b * 512 + r);
                    ROWTOK[row] = tokbase + (int)(0xFFFFFFFFu - (unsigned)(kk & 0xFFFFFFFFull)); ROWGATE[row] = __uint_as_float((unsigned)(kk >> 32)); }
            }
            SEAM(PB + 10);
        }
        if (IN(PB + 11)) for (int rep_ = 0; rep_ < PROBE_REPS(11); ++rep_) {
            PH_BEGIN
            for (int R = bid * 8 + wave; R < NEXP * MOE_PAD; R += G * 8) { const int tok = ROWTOK[R];
                u32x4* d = (u32x4*)(XG + (size_t)R * DM);
                if (tok >= 0) { const u32x4* s = (const u32x4*)(HB + (size_t)tok * DM);
#pragma unroll
                    for (int i = 0; i < 4; ++i) d[i * 64 + lane] = s[i * 64 + lane]; }
                else {
#pragma unroll
                    for (int i = 0; i < 4; ++i) d[i * 64 + lane] = (u32x4){0u, 0u, 0u, 0u}; } }
            SEAM(PB + 11);
        }
        if (IN(PB + 12)) for (int rep_ = 0; rep_ < PROBE_REPS(12); ++rep_) {
            PH_BEGIN
            pg8::Gemm g{XG, WGU, DM, DM, DM}; pg8::SchedMoe S{lastl ? 8 : 9, 12, G, bid, DM, DM, 2 * DEXP}; pg8::EpiMoe1 E{HID};
            pg8::gemm_phase((LAS unsigned char*)shm, g, S, E);
            SEAM(PB + 12);
        }
        if (IN(PB + 13)) for (int rep_ = 0; rep_ < PROBE_REPS(13); ++rep_) {
            PH_BEGIN
            pg8::Gemm g{HID, WD, DEXP, DEXP, DEXP}; pg8::SchedMoe S{lastl ? 8 : 9, 8, G, bid, DEXP, DEXP, DM}; pg8::EpiMoe2 E{XS, MODl, ROWTOK, ROWGATE};
            pg8::gemm_phase((LAS unsigned char*)shm, g, S, E);
            SEAM(PB + 13);
        }

}

__global__ __launch_bounds__(NTHR, 2) void fwd(Args a) {
    extern __shared__ __attribute__((aligned(16))) unsigned char shm[];
    const int bid = blockIdx.x, G = gridDim.x;
    float* const sf = (float*)shm;
    volatile LAS unsigned* xbw = (volatile LAS unsigned*)((LAS unsigned char*)shm + (LDS_BYTES - 16));
    if (threadIdx.x == 0) { xbw[0] = 0u; xbw[1] = 0u; xbw[2] = 0u; xbw[3] = 0u; }
    const float** const ptab = (const float**)(shm + (LDS_BYTES - 16 - 512));
    if (threadIdx.x == 0) {
#pragma unroll
        for (int i = 0; i < 47; ++i) ptab[i] = a.in[i]; }
    __syncthreads();
    XcdBarrier bar = xcd_barrier_post((unsigned*)(a.ws + O_BAR), xbw);
    const int lo = a.ph_lo, hi = a.ph_hi;
    if (IN(0)) {
        PH_BEGIN
        { const float4* s0 = (const float4*)x_in; const float4* s1 = (const float4*)ctx_in; float4* d = (float4*)XS; const size_t n0 = (size_t)NLAT * DM / 4, n1 = (size_t)NCTX * DM / 4;
          for (size_t i = (size_t)bid * NTHR + tid; i < n0 + n1; i += (size_t)G * NTHR) d[i] = i < n0 ? s0[i] : s1[i - n0]; }
        for (int unit = bid; unit < 2 * 24 * 8; unit += G) { const int l = unit / 192, rem = unit % 192, jb = rem >> 3, ks = rem & 7;
            __syncthreads();
            for (int i = tid; i < 5 * 256; i += NTHR) { const int r = i >> 8, k = ks * 256 + (i & 255); const float v = r < 4 ? c_in[r * DM + k] : cctx_in[k]; sf[i] = siluf_(v); }
            __syncthreads();
            const int j = jb * 512 + tid; const float* w = ada_w + (size_t)l * DM * (6 * DM) + (size_t)(ks * 256) * (6 * DM) + j;
            float a0 = 0.f, a1 = 0.f, a2 = 0.f, a3 = 0.f, a4 = 0.f;
            for (int k = 0; k < 256; ++k) { const float wv = w[(size_t)k * (6 * DM)]; a0 += sf[k] * wv; a1 += sf[256 + k] * wv; a2 += sf[512 + k] * wv; a3 += sf[768 + k] * wv; a4 += sf[1024 + k] * wv; }
            const float bb = ks == 0 ? ada_b[l * 6 * DM + j] : 0.f;
            float* o = MOD + (size_t)l * 5 * 6 * DM + j;
            atomicAdd(o + 0 * 6 * DM, a0 + bb); atomicAdd(o + 1 * 6 * DM, a1 + bb); atomicAdd(o + 2 * 6 * DM, a2 + bb); atomicAdd(o + 3 * 6 * DM, a3 + bb); atomicAdd(o + 4 * 6 * DM, a4 + bb);
        }
        SEAM(0);
    }

    layer_body<0>(a, bar, lo, hi, bid, G, shm, sf, ptab);
    layer_body<1>(a, bar, lo, hi, bid, G, shm, sf, ptab);
    if (IN(33)) {
        PH_BEGIN
        const float* gn = PT(46);
        for (int tok = bid * 8 + wave; tok < NLAT; tok += G * 8) {
            const float* xr = XS + (size_t)tok * DM; float4 v[8]; float ss = 0.f;
#pragma unroll
            for (int i = 0; i < 8; ++i) { v[i] = *(const float4*)(xr + i * 256 + lane * 4); ss += v[i].x * v[i].x + v[i].y * v[i].y + v[i].z * v[i].z + v[i].w * v[i].w; }
            ss = wave_sum(ss); const float rs = rsqrtf(ss * (1.0f / DM) + 1e-6f);
#pragma unroll
            for (int i = 0; i < 8; ++i) { const int d = i * 256 + lane * 4; const float4 g4 = *(const float4*)(gn + d);
                *(float4*)(a.out + (size_t)tok * DM + d) = make_float4(v[i].x * rs * g4.x, v[i].y * rs * g4.y, v[i].z * rs * g4.z, v[i].w * rs * g4.w); }
        }
    }
#undef IN
#undef SEAM
}


extern "C" void kernel_launch(void* const* d_in, const int* in_sizes, int n_in, void* d_out, int out_size, void* d_ws, size_t ws_size, hipStream_t stream) {
    static int grid = 0;
    if (grid == 0) {
        if (n_in != 47 || ws_size < WS_END) { fprintf(stderr, "kernel_launch: expected 47 inputs and >= %zu bytes of workspace; got %d, %zu\n", (size_t)WS_END, n_in, ws_size); grid = -1; return; }
        int dev = 0, cus = 0;
        if (hipGetDevice(&dev) != hipSuccess || hipDeviceGetAttribute(&cus, hipDeviceAttributeMultiprocessorCount, dev) != hipSuccess) { grid = -1; return; }
        if (hipFuncSetAttribute((const void*)fwd, hipFuncAttributeMaxDynamicSharedMemorySize, LDS_BYTES) != hipSuccess) { fprintf(stderr, "kernel_launch: hipFuncSetAttribute failed\n"); grid = -1; return; }
        int per_cu = 0;
        if (hipOccupancyMaxActiveBlocksPerMultiprocessor(&per_cu, (const void*)fwd, NTHR, LDS_BYTES) != hipSuccess || per_cu < 1) fprintf(stderr, "kernel_launch: occupancy query reports %d\n", per_cu);
        (void)hipGetLastError();
        grid = cus;
        if (grid < 160) { fprintf(stderr, "kernel_launch: needs >= 160 CUs (got %d)\n", grid); grid = -1; return; }
    }
    if (grid < 0) return;
    (void)hipMemsetAsync((char*)d_ws, 0, O_ZERO_END, stream);
    Args a{};
    for (int i = 0; i < 47; ++i) a.in[i] = (const float*)d_in[i];
    a.out = (float*)d_out; a.ws = (unsigned char*)d_ws;
#if MK_ONE_LAUNCH
    a.ph_lo = 0; a.ph_hi = 64;
    hipLaunchKernelGGL(fwd, dim3(grid), dim3(NTHR), LDS_BYTES, stream, a);
#else
    const int ids[] = {0, 1,2,3,4,5,6,7,8,9,10,11,12,13,14, 17,18,19,20,21,22,23,24,25,26,27,28,29,30, 33};
    for (int k = 0; k < (int)(sizeof(ids) / sizeof(ids[0])); ++k) { a.ph_lo = ids[k]; a.ph_hi = ids[k] + 1; hipLaunchKernelGGL(fwd, dim3(grid), dim3(NTHR), LDS_BYTES, stream, a); }
#endif
}
```

```cpp
#include <hip/hip_runtime.h>
#include <stdint.h>
#include <stdio.h>

#ifndef PROBE_MASK
#define PROBE_MASK 0
#endif
#define PROBE_REPS(k) ((((PROBE_MASK) >> (k)) & 1) + 1)
#ifndef MK_ONE_LAUNCH
#define MK_ONE_LAUNCH 1
#endif

#define DM 2048
#define NB 4
#define SEQ 4096
#define CTXL 256
#define BW 512
#define NLAT 16384
#define NCTX 1024
#define NTOK 17408
#define IN_W 13856
#define LDP 14080
#define HY_OFF 0
#define ML_OFF 1536
#define S5_OFF 3600
#define SSD_OFF 4112
#define GATE_OFF 5664
#define NEXP 16
#define DEXP 1536
#define MOE_ROWS 2176
#define MOE_PAD 2304
#define NTHR 512
#define LDS_BYTES 147456
#define LAS __attribute__((address_space(3)))

typedef unsigned short bf16_t;
typedef short bf16x8 __attribute__((ext_vector_type(8)));
typedef float f32x4 __attribute__((ext_vector_type(4)));
typedef unsigned u32x4 __attribute__((ext_vector_type(4)));
typedef unsigned u32x2 __attribute__((ext_vector_type(2)));

#define XB_TMO      128
#define XB_XCNT(j)  (256  + 64 * (j))
#define XB_XSUB(j)  (1280 + 64 * (j))
#define XB_XGEN(j)  (2304 + 64 * (j))
#define XB_TOP      3328
#define XB_TOPGEN   3392
#define XCD_BAR_WORDS 3456
#define XB_SPIN_CAP (1u << 18)
__device__ __forceinline__ unsigned xb_ld(unsigned* p)              { return __hip_atomic_load(p, __ATOMIC_RELAXED, __HIP_MEMORY_SCOPE_AGENT); }
__device__ __forceinline__ unsigned xb_add(unsigned* p, unsigned v) { return __hip_atomic_fetch_add(p, v, __ATOMIC_RELAXED, __HIP_MEMORY_SCOPE_AGENT); }
__device__ __forceinline__ unsigned xb_xcc_id() { return (unsigned)__builtin_amdgcn_s_getreg((3 << 11) | 20) & 0xFu; }
#define XB_SPIN(cond, bar) do { unsigned _sp = 0; while (cond) { __builtin_amdgcn_s_sleep(1); \
    if ((++_sp & 255u) == 0u) { if (xb_ld(&(bar)[XB_TMO])) break; if (_sp > XB_SPIN_CAP) { atomicAdd(&(bar)[XB_TMO], 1u); break; } } } } while (0)
struct XcdBarrier { unsigned* bar; unsigned x; volatile LAS unsigned* st; };
__device__ __forceinline__ XcdBarrier xcd_barrier_post(unsigned* bar, volatile LAS unsigned* st) {
    XcdBarrier b; b.bar = bar; b.x = xb_xcc_id(); b.st = st;
    if (threadIdx.x == 0) (void)xb_add(&bar[XB_XCNT(b.x)], 1u);
    return b;
}
__device__ __forceinline__ void xcd_barrier_complete(unsigned* bar, unsigned x, unsigned& nloc, unsigned& nx) {
    const unsigned G = gridDim.x * gridDim.y * gridDim.z;
    unsigned sum, cnt, mine, sp = 0u;
    for (;;) {
        sum = 0u; cnt = 0u; mine = 0u;
#pragma unroll
        for (unsigned j = 0; j < 16; ++j) { const unsigned c = xb_ld(&bar[XB_XCNT(j)]); sum += c; cnt += (c > 0u) ? 1u : 0u; mine = (j == x) ? c : mine; }
        if (sum == G) break;
        __builtin_amdgcn_s_sleep(1);
        if ((++sp & 255u) == 0u) { if (xb_ld(&bar[XB_TMO])) break; if (sp > XB_SPIN_CAP) { atomicAdd(&bar[XB_TMO], 1u); break; } }
    }
    nloc = mine > 0u ? mine : 1u; nx = cnt > 0u ? cnt : 1u;
}
__device__ __forceinline__ void xcd_barrier(const XcdBarrier& b) {
    asm volatile("s_waitcnt vmcnt(0)" ::: "memory");
    __syncthreads();
    if (threadIdx.x == 0) {
        unsigned* bar = b.bar;
        __builtin_amdgcn_s_waitcnt(0);
        unsigned nloc = b.st[0], nx = b.st[1];
        if (nloc == 0u) { xcd_barrier_complete(bar, b.x, nloc, nx); b.st[0] = nloc; b.st[1] = nx; }
        const unsigned old = xb_add(&bar[XB_XSUB(b.x)], 1u);
        const unsigned gen = old / nloc;
        if (old + 1u == (gen + 1u) * nloc) {
            __builtin_amdgcn_fence(__ATOMIC_RELEASE, "agent");
            asm volatile("s_waitcnt vmcnt(0)" ::: "memory");
            const unsigned og = xb_add(&bar[XB_TOP], 1u);
            const unsigned tg = og / nx;
            if (og + 1u == (tg + 1u) * nx) xb_add(&bar[XB_TOPGEN], 1u);
            else XB_SPIN(xb_ld(&bar[XB_TOPGEN]) == tg, bar);
            __builtin_amdgcn_fence(__ATOMIC_ACQUIRE, "agent");
            xb_add(&bar[XB_XGEN(b.x)], 1u);
            asm volatile("s_waitcnt vmcnt(0)" ::: "memory");
        } else {
            XB_SPIN(xb_ld(&bar[XB_XGEN(b.x)]) == gen, bar);
            __builtin_amdgcn_fence(__ATOMIC_ACQUIRE, "agent");
            asm volatile("s_waitcnt vmcnt(0)" ::: "memory");
        }
    }
    __syncthreads();
}

__device__ __forceinline__ unsigned short f2bf(float f) { unsigned u = __float_as_uint(f); u += 0x7FFFu + ((u >> 16) & 1u); return (unsigned short)(u >> 16); }
__device__ __forceinline__ float bf2f(unsigned short b) { return __uint_as_float(((unsigned)b) << 16); }
__device__ __forceinline__ unsigned pk2(float lo, float hi) { unsigned r; asm("v_cvt_pk_bf16_f32 %0, %1, %2" : "=v"(r) : "v"(lo), "v"(hi)); return r; }
__device__ __forceinline__ float sigmoidf_(float x) { return 1.0f / (1.0f + expf(-x)); }
__device__ __forceinline__ float siluf_(float x) { return x / (1.0f + expf(-x)); }
__device__ __forceinline__ float wave_sum(float v) {
#pragma unroll
    for (int o = 32; o >= 1; o >>= 1) v += __shfl_xor(v, o);
    return v;
}
__device__ __forceinline__ const float* uptr(const float* p) { const unsigned long long v = (unsigned long long)p;
    const unsigned lo = __builtin_amdgcn_readfirstlane((unsigned)v), hi = __builtin_amdgcn_readfirstlane((unsigned)(v >> 32)); return (const float*)(((unsigned long long)hi << 32) | lo); }
#define PT(k) uptr(ptab[k])
__device__ __forceinline__ int step_tok(int b, int dir, int i) {
    if (i < CTXL) { const int tt = dir ? (CTXL - 1 - i) : i; return NLAT + b * CTXL + tt; }
    const int j = i - CTXL; const int tt = dir ? (SEQ - 1 - j) : j; return b * SEQ + tt;
}
__device__ __forceinline__ void unpack8(const u32x4 w, float (&f)[8]) {
    f[0] = __uint_as_float(w.x << 16); f[1] = __uint_as_float(w.x & 0xFFFF0000u); f[2] = __uint_as_float(w.y << 16); f[3] = __uint_as_float(w.y & 0xFFFF0000u);
    f[4] = __uint_as_float(w.z << 16); f[5] = __uint_as_float(w.z & 0xFFFF0000u); f[6] = __uint_as_float(w.w << 16); f[7] = __uint_as_float(w.w & 0xFFFF0000u);
}

namespace pg8 {
constexpr int BM = 256, BK = 64, HALF = 128, HTB = HALF * BK * 2, STAGE_BYTES = 8 * HTB, NXCD = 8, WGM = 8;
__host__ __device__ __forceinline__ int lds_byte(int r, int c) { const int st = (r >> 4) * 2 + (c >> 5), rr = r & 15, cc = c & 31, ob = rr * 64 + cc * 2; return st * 1024 + (ob ^ (((ob >> 9) & 1) << 5)); }
__host__ __device__ __forceinline__ void stage_rc(int b, int& R, int& C) { const int st = b / 1024, sb = b % 1024, swz = sb ^ (((sb >> 9) & 1) << 5); R = (st >> 1) * 16 + swz / 64; C = (st & 1) * 32 + (swz % 64) / 2; }
__host__ __device__ __forceinline__ int perm32(int rho) { const int n = rho >> 4, i = rho & 15; return 8 * (i >> 2) + 4 * n + (i & 3); }
struct Unit { int pm, pn, z, k; long long ao, bo; };
struct Gemm { const bf16_t* A; const bf16_t* Bt; int lda, ldb, K; };

__device__ __forceinline__ void tile_of(int wgid, int nM, int nN, int& pm, int& pn) {
    const int nwg = nM * nN; { const int q = nwg / NXCD, r = nwg % NXCD, xcd = wgid % NXCD, off = wgid / NXCD; wgid = (xcd < r ? xcd * (q + 1) : r * (q + 1) + (xcd - r) * q) + off; }
    const int nig = WGM * nN, gid = wgid / nig, fm = gid * WGM, gsz = (nM - fm) < WGM ? (nM - fm) : WGM;
    pm = fm + ((wgid % nig) % gsz); pn = (wgid % nig) / gsz;
}
struct SchedStd {
    int nM, nN, G, c, lda, ldb;
    __device__ __forceinline__ bool next(int i, Unit& u) const { const long L = (long)i * G + c; if (L >= (long)nM * nN) return false; tile_of((int)L, nM, nN, u.pm, u.pn); u.z = 0; u.k = 0;
        u.ao = (long long)u.pm * BM * lda * 2; u.bo = (long long)u.pn * BM * ldb * 2; return true; }
    __device__ __forceinline__ void a_ready(const Unit&) const {}
    __device__ __forceinline__ void done(const Unit&) const {}
};
struct SchedBranch {
    int nM, nN, G, c;
    __device__ __forceinline__ bool next(int i, Unit& u) const { const long L = (long)(i >> 2) * G + c; if (L >= (long)nM * nN) return false; tile_of((int)L, nM, nN, u.pm, u.pn); u.z = 0; u.k = i & 3;
        u.ao = ((long long)u.pm * BM * DM + u.k * BW) * 2; u.bo = ((long long)u.k * DM + u.pn * BM) * BW * 2; return true; }
    __device__ __forceinline__ void a_ready(const Unit&) const {}
    __device__ __forceinline__ void done(const Unit&) const {}
};
struct SchedMoe {
    int nPm, nPn, G, c, lda, ldb, nBrows;
    __device__ __forceinline__ bool next(int i, Unit& u) const { const long L = (long)i * G + c; const int per = nPm * nPn; if (L >= (long)NEXP * per) return false; const int e = (int)(L / per), rem = (int)(L % per);
        u.z = e; u.k = 0; u.pm = rem % nPm; u.pn = rem / nPm; u.ao = ((long long)e * MOE_PAD + u.pm * BM) * lda * 2; u.bo = ((long long)e * nBrows + u.pn * BM) * ldb * 2; return true; }
    __device__ __forceinline__ void a_ready(const Unit&) const {}
    __device__ __forceinline__ void done(const Unit&) const {}
};

typedef f32x4 Acc[2][2][4][2];
template <class Epi, class Sched>
__device__ __forceinline__ void gemm_phase(LAS unsigned char* lds, const Gemm g, const Sched& S, const Epi& E) {
    int tid = threadIdx.x; asm volatile("" : "+v"(tid));
    const int wid = __builtin_amdgcn_readfirstlane(tid >> 6), lane = tid & 63, wr = wid >> 2, wc = wid & 3, fr = lane & 15, fq = lane >> 4;
    const int K = g.K, nt = K / BK;
    unsigned voffA[2], voffB[2];
#pragma unroll
    for (int i = 0; i < 2; ++i) { int R, C; stage_rc(tid * 16 + i * 8192, R, C); const int Rb = Epi::PERM ? ((R & ~31) + perm32(R & 31)) : R;
        voffA[i] = (unsigned)(R * g.lda + C) * 2u; voffB[i] = (unsigned)(Rb * g.ldb + C) * 2u; }
    const size_t kstep = (size_t)(BK * 2);
    const size_t hstepA = (size_t)HALF * g.lda * 2, hstepB = (size_t)HALF * g.ldb * 2;
    const unsigned ldsw = (unsigned)wid * 1024u;
    const int aoff = lds_byte(wr * 64 + fr, fq * 8), boff = lds_byte(wc * 32 + fr, fq * 8);
#define PG8_SA(b, h) (((b) * 2 + (h)) * HTB)
#define PG8_SB(b, h) ((4 + (b) * 2 + (h)) * HTB)
#define PG8_STAGE(bufoff, gbase, voff) do { _Pragma("unroll") for (int _i = 0; _i < 2; ++_i) \
        __builtin_amdgcn_global_load_lds((const unsigned*)((const char*)(gbase) + (voff)[_i]), (LAS unsigned*)(lds + (bufoff) + ldsw + _i * 8192), 16, 0, 0); } while (0)
#define PG8_LDA(dst, b, h) do { _Pragma("unroll") for (int m = 0; m < 4; ++m) _Pragma("unroll") for (int k = 0; k < 2; ++k) dst[m][k] = *(const LAS bf16x8*)(lds + PG8_SA(b, h) + aoff + m * 2048 + k * 1024); } while (0)
#define PG8_LDB(dst, b, h) do { _Pragma("unroll") for (int n = 0; n < 2; ++n) _Pragma("unroll") for (int k = 0; k < 2; ++k) dst[n][k] = *(const LAS bf16x8*)(lds + PG8_SB(b, h) + boff + n * 2048 + k * 1024); } while (0)
#define PG8_MMA(ai, bj, At, Bt) do { __builtin_amdgcn_s_setprio(1); _Pragma("unroll") for (int m = 0; m < 4; ++m) _Pragma("unroll") for (int n = 0; n < 2; ++n) _Pragma("unroll") for (int k = 0; k < 2; ++k) \
        acc[ai][bj][m][n] = __builtin_amdgcn_mfma_f32_16x16x32_bf16(Bt[n][k], At[m][k], acc[ai][bj][m][n], 0, 0, 0); __builtin_amdgcn_s_setprio(0); } while (0)
#define PG8_WAIT_V(n) asm volatile("s_waitcnt vmcnt(" #n ")" ::: "memory")
#define PG8_WAIT_L(n) asm volatile("s_waitcnt lgkmcnt(" #n ")" ::: "memory")
#define PG8_BAR __builtin_amdgcn_s_barrier()
#define PG8_SCHED __builtin_amdgcn_sched_barrier(0)
    Unit cur, nxt; int ui = 0;
    if (!S.next(0, cur)) return;
    Acc acc;
#pragma unroll
    for (int a = 0; a < 2; ++a)
#pragma unroll
        for (int b = 0; b < 2; ++b)
#pragma unroll
            for (int m = 0; m < 4; ++m)
#pragma unroll
                for (int n = 0; n < 2; ++n) acc[a][b][m][n] = (f32x4){0.f, 0.f, 0.f, 0.f};
    bf16x8 At[4][2], B0[2][2], B1[2][2];
    const char* cA = (const char*)g.A + cur.ao; const char* cB = (const char*)g.Bt + cur.bo;
    S.a_ready(cur);
    PG8_STAGE(PG8_SB(0, 0), cB, voffB); PG8_STAGE(PG8_SA(0, 0), cA, voffA); PG8_STAGE(PG8_SB(0, 1), cB + hstepB, voffB); PG8_STAGE(PG8_SA(0, 1), cA + hstepA, voffA);
    if (wr == 1) PG8_BAR;
    PG8_WAIT_V(4); PG8_BAR;
    PG8_STAGE(PG8_SB(1, 0), cB + kstep, voffB); PG8_STAGE(PG8_SA(1, 0), cA + kstep, voffA); PG8_STAGE(PG8_SB(1, 1), cB + hstepB + kstep, voffB);
    PG8_WAIT_V(6); PG8_BAR;
    for (;;) {
        const bool has_next = S.next(ui + 1, nxt);
        const char* nA = has_next ? (const char*)g.A + nxt.ao : cA; const char* nB = has_next ? (const char*)g.Bt + nxt.bo : cB;
        for (int t = 0; t < nt; t += 2) {
            const bool last = (t == nt - 2);
            const char* a1 = cA + (size_t)(t + 1) * kstep;
            const char* a2 = last ? nA : cA + (size_t)(t + 2) * kstep; const char* b2 = last ? nB : cB + (size_t)(t + 2) * kstep;
            const char* a3 = a2 + kstep; const char* b3 = b2 + kstep;
            if (last && has_next) S.a_ready(nxt);
            PG8_LDB(B0, 0, 0); PG8_SCHED; PG8_LDA(At, 0, 0); PG8_STAGE(PG8_SA(1, 1), a1 + hstepA, voffA);
            PG8_WAIT_L(8); PG8_BAR; PG8_WAIT_L(0); PG8_MMA(0, 0, At, B0); PG8_BAR; PG8_SCHED;
            PG8_LDB(B1, 0, 1); PG8_STAGE(PG8_SB(0, 0), b2, voffB);
            PG8_BAR; PG8_WAIT_L(0); PG8_MMA(0, 1, At, B1); PG8_BAR;
            PG8_LDA(At, 0, 1); PG8_STAGE(PG8_SA(0, 0), a2, voffA);
            PG8_BAR; PG8_WAIT_L(0); PG8_MMA(1, 0, At, B0); PG8_BAR; PG8_SCHED;
            PG8_STAGE(PG8_SB(0, 1), b2 + hstepB, voffB);
            PG8_WAIT_V(6); PG8_BAR; PG8_MMA(1, 1, At, B1); PG8_BAR;
            PG8_LDB(B0, 1, 0); PG8_SCHED; PG8_LDA(At, 1, 0); PG8_STAGE(PG8_SA(0, 1), a2 + hstepA, voffA);
            PG8_WAIT_L(8); PG8_BAR; PG8_WAIT_L(0); PG8_MMA(0, 0, At, B0); PG8_BAR; PG8_SCHED;
            PG8_LDB(B1, 1, 1); PG8_STAGE(PG8_SB(1, 0), b3, voffB);
            PG8_BAR; PG8_WAIT_L(0); PG8_MMA(0, 1, At, B1); PG8_BAR;
            PG8_LDA(At, 1, 1); PG8_STAGE(PG8_SA(1, 0), a3, voffA);
            PG8_BAR; PG8_WAIT_L(0); PG8_MMA(1, 0, At, B0); PG8_BAR; PG8_SCHED;
            PG8_STAGE(PG8_SB(1, 1), b3 + hstepB, voffB);
            PG8_WAIT_V(6); PG8_BAR; PG8_MMA(1, 1, At, B1); PG8_BAR;
        }
        const bool keep = E(acc, cur, wr, wc, fr, fq); S.done(cur);
        if (!has_next) break;
        if (!keep) {
#pragma unroll
        for (int a = 0; a < 2; ++a)
#pragma unroll
            for (int b = 0; b < 2; ++b)
#pragma unroll
                for (int m = 0; m < 4; ++m)
#pragma unroll
                    for (int n = 0; n < 2; ++n) acc[a][b][m][n] = (f32x4){0.f, 0.f, 0.f, 0.f};
        }
        cur = nxt; cA = nA; cB = nB; ++ui;
    }
    PG8_WAIT_V(0);
    if (wr == 0) PG8_BAR;
    PG8_BAR;
#undef PG8_SA
#undef PG8_SB
#undef PG8_STAGE
#undef PG8_LDA
#undef PG8_LDB
#undef PG8_MMA
#undef PG8_WAIT_V
#undef PG8_WAIT_L
#undef PG8_BAR
#undef PG8_SCHED
}

struct EpiBf16Store {
    static constexpr bool PERM = true;
    bf16_t* O; int ldc;
    __device__ __forceinline__ bool operator()(Acc& acc, const Unit& u, int wr, int wc, int fr, int fq) const {
        const int row0 = u.pm * BM + wr * 64 + fr, col0 = u.pn * BM + wc * 32 + 8 * fq;
#pragma unroll
        for (int ai = 0; ai < 2; ++ai)
#pragma unroll
            for (int m = 0; m < 4; ++m) { bf16_t* rowp = O + (size_t)(row0 + ai * HALF + m * 16) * ldc + col0;
#pragma unroll
                for (int bj = 0; bj < 2; ++bj) { const f32x4 v0 = acc[ai][bj][m][0], v1 = acc[ai][bj][m][1];
                    u32x4 w; w.x = pk2(v0[0], v0[1]); w.y = pk2(v0[2], v0[3]); w.z = pk2(v1[0], v1[1]); w.w = pk2(v1[2], v1[3]);
                    *(u32x4*)(rowp + bj * HALF) = w; } }
        return false;
    }
};
struct EpiWin {
    static constexpr bool PERM = true;
    bf16_t* O; int ldc;
    __device__ __forceinline__ bool operator()(Acc& acc, const Unit& u, int wr, int wc, int fr, int fq) const {
        const int row0 = u.pm * BM + wr * 64 + fr, col0 = u.pn * BM + wc * 32 + 8 * fq;
#pragma unroll
        for (int bj = 0; bj < 2; ++bj) { const bool gate = (col0 + bj * HALF) >= GATE_OFF;
#pragma unroll
            for (int ai = 0; ai < 2; ++ai)
#pragma unroll
                for (int m = 0; m < 4; ++m) { f32x4 v0 = acc[ai][bj][m][0], v1 = acc[ai][bj][m][1];
                    if (gate) {
#pragma unroll
                        for (int j = 0; j < 4; ++j) { v0[j] = __builtin_amdgcn_rcpf(1.0f + __expf(-v0[j])); v1[j] = __builtin_amdgcn_rcpf(1.0f + __expf(-v1[j])); } }
                    u32x4 w; w.x = pk2(v0[0], v0[1]); w.y = pk2(v0[2], v0[3]); w.z = pk2(v1[0], v1[1]); w.w = pk2(v1[2], v1[3]);
                    *(u32x4*)(O + (size_t)(row0 + ai * HALF + m * 16) * ldc + col0 + bj * HALF) = w; } }
        return false;
    }
};
struct EpiGlu {
    static constexpr bool PERM = true;
    const bf16_t* GG; const float* bias; bf16_t* Y4;
    __device__ __forceinline__ bool operator()(Acc& acc, const Unit& u, int wr, int wc, int fr, int fq) const {
        const int row0 = u.pm * BM + wr * 64 + fr, col0 = u.pn * BM + wc * 32 + 8 * fq;
#pragma unroll
        for (int bj = 0; bj < 2; ++bj) { const int col = col0 + bj * HALF; const f32x4 b0 = *(const f32x4*)(bias + col), b1 = *(const f32x4*)(bias + col + 4);
#pragma unroll
            for (int ai = 0; ai < 2; ++ai)
#pragma unroll
                for (int m = 0; m < 4; ++m) { const size_t row = (size_t)(row0 + ai * HALF + m * 16);
                    float gg[8]; unpack8(*(const u32x4*)(GG + row * BW + col), gg);
                    const f32x4 v0 = acc[ai][bj][m][0] + b0, v1 = acc[ai][bj][m][1] + b1;
                    u32x4 w; w.x = pk2(gg[0] * sigmoidf_(v0[0]), gg[1] * sigmoidf_(v0[1])); w.y = pk2(gg[2] * sigmoidf_(v0[2]), gg[3] * sigmoidf_(v0[3]));
                    w.z = pk2(gg[4] * sigmoidf_(v1[0]), gg[5] * sigmoidf_(v1[1])); w.w = pk2(gg[6] * sigmoidf_(v1[2]), gg[7] * sigmoidf_(v1[3]));
                    *(u32x4*)(Y4 + row * DM + 1024 + col) = w; } }
        return false;
    }
};
struct EpiBranch {
    static constexpr bool PERM = true;
    const bf16_t* P; bf16_t* ACCb;
    __device__ __forceinline__ bool operator()(Acc& acc, const Unit& u, int wr, int wc, int fr, int fq) const {
        const int row0 = u.pm * BM + wr * 64 + fr, col0 = u.pn * BM + wc * 32 + 8 * fq; const int k = u.k;
#pragma unroll
        for (int ai = 0; ai < 2; ++ai)
#pragma unroll
            for (int m = 0; m < 4; ++m) { const size_t row = (size_t)(row0 + ai * HALF + m * 16);
#pragma unroll
                for (int bj = 0; bj < 2; ++bj) { const int col = col0 + bj * HALF;
                    float g0[8]; unpack8(*(const u32x4*)(P + row * LDP + GATE_OFF + k * DM + col), g0);
                    float s[8];
                    if (k < 3) { float g1[8]; unpack8(*(const u32x4*)(P + row * LDP + GATE_OFF + (k + 1) * DM + col), g1);
#pragma unroll
                        for (int j = 0; j < 8; ++j) s[j] = g0[j] * __builtin_amdgcn_rcpf(g1[j]); }
                    else {
#pragma unroll
                        for (int j = 0; j < 8; ++j) s[j] = g0[j]; }
                    f32x4 v0 = acc[ai][bj][m][0], v1 = acc[ai][bj][m][1];
                    v0[0] *= s[0]; v0[1] *= s[1]; v0[2] *= s[2]; v0[3] *= s[3]; v1[0] *= s[4]; v1[1] *= s[5]; v1[2] *= s[6]; v1[3] *= s[7];
                    if (k < 3) { acc[ai][bj][m][0] = v0; acc[ai][bj][m][1] = v1; }
                    else { u32x4 w; w.x = pk2(v0[0], v0[1]); w.y = pk2(v0[2], v0[3]); w.z = pk2(v1[0], v1[1]); w.w = pk2(v1[2], v1[3]); *(u32x4*)(ACCb + row * DM + col) = w; } } }
        return k < 3;
    }
};
struct EpiResid {
    static constexpr bool PERM = false;
    float* XS; const float* MODl; int gidx;
    __device__ __forceinline__ bool operator()(Acc& acc, const Unit& u, int wr, int wc, int fr, int fq) const {
        const int row0 = u.pm * BM + wr * 64 + fr, col0 = u.pn * BM + wc * 32 + 4 * fq;
        const int r = (u.pm * BM) < NLAT ? (u.pm * BM) / SEQ : 4;
        const float* mg = MODl + (size_t)(r * 6 + gidx) * DM;
#pragma unroll
        for (int bj = 0; bj < 2; ++bj)
#pragma unroll
            for (int n = 0; n < 2; ++n) { const int col = col0 + bj * HALF + n * 16; const f32x4 gm = *(const f32x4*)(mg + col);
#pragma unroll
                for (int ai = 0; ai < 2; ++ai)
#pragma unroll
                    for (int m = 0; m < 4; ++m) { float* p = XS + (size_t)(row0 + ai * HALF + m * 16) * DM + col; *(f32x4*)p = *(const f32x4*)p + gm * acc[ai][bj][m][n]; } }
        return false;
    }
};
struct EpiMoe1 {
    static constexpr bool PERM = false;
    bf16_t* HID;
    __device__ __forceinline__ bool operator()(Acc& acc, const Unit& u, int wr, int wc, int fr, int fq) const {
        const size_t row0 = (size_t)u.z * MOE_PAD + u.pm * BM + wr * 64 + fr; const int col0 = u.pn * HALF + wc * 16 + 4 * fq;
#pragma unroll
        for (int ai = 0; ai < 2; ++ai)
#pragma unroll
            for (int m = 0; m < 4; ++m)
#pragma unroll
                for (int bj = 0; bj < 2; ++bj) { const f32x4 gt = acc[ai][bj][m][0], up = acc[ai][bj][m][1];
                    u32x2 w; w.x = pk2(siluf_(gt[0]) * up[0], siluf_(gt[1]) * up[1]); w.y = pk2(siluf_(gt[2]) * up[2], siluf_(gt[3]) * up[3]);
                    *(u32x2*)(HID + (row0 + ai * HALF + m * 16) * DEXP + col0 + bj * 64) = w; }
        return false;
    }
};
struct EpiMoe2 {
    static constexpr bool PERM = false;
    int* XS; const float* MODl; const int* ROWTOK; const float* ROWGATE;
    __device__ __forceinline__ bool operator()(Acc& acc, const Unit& u, int wr, int wc, int fr, int fq) const {
        const int rowb = u.z * MOE_PAD + u.pm * BM + wr * 64 + fr; const int col0 = u.pn * BM + wc * 32 + 4 * fq;
#pragma unroll
        for (int ai = 0; ai < 2; ++ai)
#pragma unroll
            for (int m = 0; m < 4; ++m) { const int R = rowb + ai * HALF + m * 16; const int tok = ROWTOK[R];
                if (tok >= 0) { const float gt = ROWGATE[R]; const int r = tok < NLAT ? tok / SEQ : 4; const float* mg = MODl + (size_t)(r * 6 + 5) * DM; int* xr = XS + (size_t)tok * DM;
#pragma unroll
                    for (int bj = 0; bj < 2; ++bj)
#pragma unroll
                        for (int n = 0; n < 2; ++n) { const int col = col0 + bj * HALF + n * 16; const f32x4 gm = *(const f32x4*)(mg + col); const f32x4 v = acc[ai][bj][m][n];
                            atomicAdd(xr + col + 0, __float2int_rn(gm[0] * gt * v[0] * 1048576.0f)); atomicAdd(xr + col + 1, __float2int_rn(gm[1] * gt * v[1] * 1048576.0f));
                            atomicAdd(xr + col + 2, __float2int_rn(gm[2] * gt * v[2] * 1048576.0f)); atomicAdd(xr + col + 3, __float2int_rn(gm[3] * gt * v[3] * 1048576.0f)); } } }
        return false;
    }
};

struct SchedS5a {
    int c;
    __device__ __forceinline__ bool next(int i, Unit& u) const { if (i > 0 || c >= 64) return false; u.z = c >> 1; u.pm = c & 1; u.pn = 0; u.k = 0;
        u.ao = ((long long)u.z * 512 + u.pm * BM) * 768 * 2; u.bo = (long long)u.z * 256 * 512 * 2; return true; }
    __device__ __forceinline__ void a_ready(const Unit&) const {}
    __device__ __forceinline__ void done(const Unit&) const {}
};
struct SchedS5b {
    int c;
    __device__ __forceinline__ bool next(int i, Unit& u) const { if (i > 0 || c >= 128) return false; u.z = c >> 2; u.pm = (c >> 1) & 1; u.pn = c & 1; u.k = 0;
        u.ao = ((long long)u.z * 512 + u.pm * BM) * 768 * 2; u.bo = ((long long)u.z * 512 + u.pn * BM) * 768 * 2; return true; }
    __device__ __forceinline__ void a_ready(const Unit&) const {}
    __device__ __forceinline__ void done(const Unit&) const {}
};
struct EpiXloc {
    static constexpr bool PERM = false;
    float* XL;
    __device__ __forceinline__ bool operator()(Acc& acc, const Unit& u, int wr, int wc, int fr, int fq) const {
        const int row0 = u.pm * BM + wr * 64 + fr, col0 = wc * 32 + 4 * fq; float* base = XL + (size_t)u.z * 512 * 256;
#pragma unroll
        for (int ai = 0; ai < 2; ++ai)
#pragma unroll
            for (int m = 0; m < 4; ++m) { float* rowp = base + (size_t)(row0 + ai * HALF + m * 16) * 256 + col0;
#pragma unroll
                for (int bj = 0; bj < 2; ++bj)
#pragma unroll
                    for (int n = 0; n < 2; ++n) *(f32x4*)(rowp + bj * HALF + n * 16) = acc[ai][bj][m][n]; }
        return false;
    }
};
struct EpiS5Out {
    static constexpr bool PERM = true;
    const bf16_t* P; const float* dskip; bf16_t* GG;
    __device__ __forceinline__ bool operator()(Acc& acc, const Unit& u, int wr, int wc, int fr, int fq) const {
        const int row0 = u.pm * BM + wr * 64 + fr, col0 = u.pn * BM + wc * 32 + 8 * fq; const int g = u.z;
#pragma unroll
        for (int bj = 0; bj < 2; ++bj) { const int col = col0 + bj * HALF; const int t = col >> 4, c0 = col & 15;
            const f32x4 d0 = *(const f32x4*)(dskip + g * 16 + c0), d1 = *(const f32x4*)(dskip + g * 16 + c0 + 4);
#pragma unroll
            for (int ai = 0; ai < 2; ++ai)
#pragma unroll
                for (int m = 0; m < 4; ++m) { const size_t tok = (size_t)(row0 + ai * HALF + m * 16) * 32 + t;
                    float uu[8]; unpack8(*(const u32x4*)(P + tok * LDP + S5_OFF + g * 16 + c0), uu);
                    const f32x4 v0 = acc[ai][bj][m][0], v1 = acc[ai][bj][m][1];
                    float y[8] = {v0[0] + d0[0] * uu[0], v0[1] + d0[1] * uu[1], v0[2] + d0[2] * uu[2], v0[3] + d0[3] * uu[3], v1[0] + d1[0] * uu[4], v1[1] + d1[1] * uu[5], v1[2] + d1[2] * uu[6], v1[3] + d1[3] * uu[7]};
#pragma unroll
                    for (int j = 0; j < 8; ++j) y[j] = 0.5f * y[j] * (1.0f + tanhf(0.7978845608028654f * (y[j] + 0.044715f * y[j] * y[j] * y[j])));
                    u32x4 w; w.x = pk2(y[0], y[1]); w.y = pk2(y[2], y[3]); w.z = pk2(y[4], y[5]); w.w = pk2(y[6], y[7]);
                    *(u32x4*)(GG + tok * BW + g * 16 + c0) = w; } }
        return false;
    }
};
}


__device__ __forceinline__ float wave_scan_incl(float v, int lane) {
#pragma unroll
    for (int o = 1; o < 64; o <<= 1) { const float t = __shfl_up(v, o); if (lane >= o) v += t; }
    return v;
}
__device__ __forceinline__ float wave_scanmax_incl(float v, int lane) {
#pragma unroll
    for (int o = 1; o < 64; o <<= 1) { const float t = __shfl_up(v, o); if (lane >= o) v = fmaxf(v, t); }
    return v;
}
__device__ __forceinline__ float wave_max(float v) {
#pragma unroll
    for (int o = 32; o >= 1; o >>= 1) v = fmaxf(v, __shfl_xor(v, o));
    return v;
}
__device__ __forceinline__ void unpack8h(const u32x4 w, bf16_t (&h)[8]) {
    h[0] = (bf16_t)(w.x & 0xFFFFu); h[1] = (bf16_t)(w.x >> 16); h[2] = (bf16_t)(w.y & 0xFFFFu); h[3] = (bf16_t)(w.y >> 16);
    h[4] = (bf16_t)(w.z & 0xFFFFu); h[5] = (bf16_t)(w.z >> 16); h[6] = (bf16_t)(w.w & 0xFFFFu); h[7] = (bf16_t)(w.w >> 16);
}

__device__ __forceinline__ void mlstm_state_pass(const int chain, const bf16_t* __restrict__ Pm, const bf16_t* __restrict__ QKb, const float* __restrict__ gate_b,
                                                 bf16_t* __restrict__ CST, float* __restrict__ NST, float* __restrict__ MST, unsigned char* shm, const int tid) {
    const int dir = chain & 1, h = (chain >> 1) & 3, b = chain >> 3, lane = tid & 63, w = tid >> 6;
    bf16_t* VT = (bf16_t*)shm; bf16_t* KT = (bf16_t*)(shm + 36864); float* wsb = (float*)(shm + 73728);
    const float gbi = gate_b[(dir * 2 + 0) * 4 + h], gbf = gate_b[(dir * 2 + 1) * 4 + h];
    f32x4 acc[8];
#pragma unroll
    for (int j = 0; j < 8; ++j) acc[j] = (f32x4){0.f, 0.f, 0.f, 0.f};
    float nvec = 0.f, m = 0.f;
    const int gcol_i = ML_OFF + 2048 + (dir * 2 + 0) * 4 + h, gcol_f = ML_OFF + 2048 + (dir * 2 + 1) * 4 + h;
    const int s0 = tid >> 4, x0 = (tid & 15) * 8;
    bf16_t gi0, gf0, gi1, gf1; u32x4 vq[2], kq[2];
    { const size_t t0 = (size_t)step_tok(b, dir, lane), t1 = (size_t)step_tok(b, dir, 64 + lane);
      gi0 = Pm[t0 * LDP + gcol_i]; gf0 = Pm[t0 * LDP + gcol_f]; gi1 = Pm[t1 * LDP + gcol_i]; gf1 = Pm[t1 * LDP + gcol_f];
#pragma unroll
      for (int i = 0; i < 2; ++i) { const size_t toks = (size_t)step_tok(b, dir, s0 + 32 * i); vq[i] = *(const u32x4*)(Pm + toks * LDP + ML_OFF + 1024 + h * 128 + x0); kq[i] = *(const u32x4*)(QKb + toks * 1024 + 512 + h * 128 + x0); } }
    __syncthreads();
    for (int c = 0; c < 68; ++c) {
        const int buf = c & 1;
        const float ig = bf2f(gi0) + gbi, fg = bf2f(gf0) + gbf;
        gi0 = gi1; gf0 = gf1;
        if (c + 2 < 68) { const size_t t2 = (size_t)step_tok(b, dir, (c + 2) * 64 + lane); gi1 = Pm[t2 * LDP + gcol_i]; gf1 = Pm[t2 * LDP + gcol_f]; }
        const float lf = fminf(fg, 0.f) - log1pf(expf(-fabsf(fg)));
        const float bcs = wave_scan_incl(lf, lane);
        const float blast = __shfl(bcs, 63);
        const float beta = wave_max(blast - bcs + ig);
        const float mo = fmaxf(m + blast, beta);
        const float wsv = expf(blast - bcs + ig - mo); const float dec = expf(blast + m - mo);
        {   bf16_t* cs = CST + (size_t)(chain * 68 + c) * 128 * 128; const int e = 16 * w + (lane & 15);
#pragma unroll
            for (int j = 0; j < 8; ++j) { const int d0 = 16 * j + (lane >> 4) * 4; u32x2 pk; pk.x = pk2(acc[j][0], acc[j][1]); pk.y = pk2(acc[j][2], acc[j][3]); *(u32x2*)(cs + (size_t)e * 128 + d0) = pk; }
            if (tid < 128) NST[(size_t)(chain * 68 + c) * 128 + tid] = nvec;
            if (tid == 0) MST[chain * 68 + c] = m; }
        if (w == 0) wsb[buf * 64 + lane] = wsv;
#pragma unroll
        for (int i = 0; i < 2; ++i) { const int s = s0 + 32 * i; const float wss = __shfl(wsv, s);
            float f[8]; unpack8(vq[i], f); bf16_t kh[8]; unpack8h(kq[i], kh);
#pragma unroll
            for (int j = 0; j < 8; ++j) { VT[(buf * 128 + x0 + j) * 72 + s] = f2bf(f[j] * wss); KT[(buf * 128 + x0 + j) * 72 + s] = kh[j]; } }
        __syncthreads();
        if (c + 1 < 68) {
#pragma unroll
            for (int i = 0; i < 2; ++i) { const size_t toks = (size_t)step_tok(b, dir, (c + 1) * 64 + s0 + 32 * i); vq[i] = *(const u32x4*)(Pm + toks * LDP + ML_OFF + 1024 + h * 128 + x0); kq[i] = *(const u32x4*)(QKb + toks * 1024 + 512 + h * 128 + x0); } }
        if (tid < 128) { float sa = 0.f; const bf16_t* kr = KT + (buf * 128 + tid) * 72;
#pragma unroll 8
            for (int s = 0; s < 64; ++s) sa += wsb[buf * 64 + s] * bf2f(kr[s]);
            nvec = dec * nvec + sa; }
#pragma unroll
        for (int j = 0; j < 8; ++j) acc[j] = acc[j] * dec;
#pragma unroll
        for (int ks = 0; ks < 2; ++ks) { const bf16x8 vfrag = *(const bf16x8*)(VT + (buf * 128 + 16 * w + (lane & 15)) * 72 + ks * 32 + (lane >> 4) * 8);
#pragma unroll
            for (int j = 0; j < 8; ++j) { const bf16x8 kfrag = *(const bf16x8*)(KT + (buf * 128 + 16 * j + (lane & 15)) * 72 + ks * 32 + (lane >> 4) * 8);
                acc[j] = __builtin_amdgcn_mfma_f32_16x16x32_bf16(kfrag, vfrag, acc[j], 0, 0, 0); } }
        m = mo;
    }
}
__device__ __forceinline__ void mlstm_out_item(const int chain, const int c, const bf16_t* __restrict__ Pm, const bf16_t* __restrict__ QKb, const float* __restrict__ gate_b,
                                               const bf16_t* __restrict__ CST, const float* __restrict__ NST, const float* __restrict__ MST, float* __restrict__ Hout, unsigned char* shm, const int tid) {
    const int dir = chain & 1, h = (chain >> 1) & 3, b = chain >> 3, lane = tid & 63, w = tid >> 6;
    bf16_t* Qs = (bf16_t*)shm; bf16_t* Ks = (bf16_t*)(shm + 17408); bf16_t* VT = (bf16_t*)(shm + 34816); bf16_t* Cs = (bf16_t*)(shm + 53248); bf16_t* Ss = (bf16_t*)(shm + 88064);
    float* sc = (float*)(shm + 97280);
    __syncthreads();
#pragma unroll
    for (int i = 0; i < 2; ++i) { const int pid = tid + i * 512; const int s = pid >> 4, x0 = (pid & 15) * 8; const size_t toks = (size_t)step_tok(b, dir, c * 64 + s);
        *(u32x4*)(Qs + s * 136 + x0) = *(const u32x4*)(QKb + toks * 1024 + h * 128 + x0);
        *(u32x4*)(Ks + s * 136 + x0) = *(const u32x4*)(QKb + toks * 1024 + 512 + h * 128 + x0);
        bf16_t vh[8]; unpack8h(*(const u32x4*)(Pm + toks * LDP + ML_OFF + 1024 + h * 128 + x0), vh);
#pragma unroll
        for (int j = 0; j < 8; ++j) VT[(x0 + j) * 72 + s] = vh[j]; }
#pragma unroll
    for (int i = 0; i < 4; ++i) { const int pid = tid + i * 512; const int e = pid >> 4, x0 = (pid & 15) * 8;
        *(u32x4*)(Cs + e * 136 + x0) = *(const u32x4*)(CST + ((size_t)(chain * 68 + c) * 128 + e) * 128 + x0); }
    if (tid < 128) sc[384 + tid] = NST[(size_t)(chain * 68 + c) * 128 + tid];
    if (w == 0) {
        const float gbi = gate_b[(dir * 2 + 0) * 4 + h], gbf = gate_b[(dir * 2 + 1) * 4 + h];
        const size_t tokl = (size_t)step_tok(b, dir, c * 64 + lane);
        const float ig = bf2f(Pm[tokl * LDP + ML_OFF + 2048 + (dir * 2 + 0) * 4 + h]) + gbi;
        const float fg = bf2f(Pm[tokl * LDP + ML_OFF + 2048 + (dir * 2 + 1) * 4 + h]) + gbf;
        const float lf = fminf(fg, 0.f) - log1pf(expf(-fabsf(fg)));
        const float bcs = wave_scan_incl(lf, lane); const float gsv = ig - bcs; const float pm = wave_scanmax_incl(gsv, lane);
        const float m_in = MST[chain * 68 + c]; const float mt = bcs + fmaxf(m_in, pm);
        sc[lane] = bcs; sc[64 + lane] = gsv; sc[128 + lane] = mt; sc[192 + lane] = expf(bcs + m_in - mt); sc[256 + lane] = expf(-mt);
    }
    __syncthreads();
    const int tt = w >> 1;
    {   f32x4 aS[2] = {(f32x4){0.f, 0.f, 0.f, 0.f}, (f32x4){0.f, 0.f, 0.f, 0.f}};
#pragma unroll
        for (int ks = 0; ks < 4; ++ks) { const bf16x8 af = *(const bf16x8*)(Qs + (16 * tt + (lane & 15)) * 136 + ks * 32 + (lane >> 4) * 8);
#pragma unroll
            for (int i = 0; i < 2; ++i) { const int st = (w & 1) * 2 + i; const bf16x8 bfr = *(const bf16x8*)(Ks + (16 * st + (lane & 15)) * 136 + ks * 32 + (lane >> 4) * 8);
                aS[i] = __builtin_amdgcn_mfma_f32_16x16x32_bf16(af, bfr, aS[i], 0, 0, 0); } }
        float rs[4] = {0.f, 0.f, 0.f, 0.f};
#pragma unroll
        for (int i = 0; i < 2; ++i) { const int s = 16 * ((w & 1) * 2 + i) + (lane & 15); const float gsv = sc[64 + s];
#pragma unroll
            for (int q = 0; q < 4; ++q) { const int t = 16 * tt + (lane >> 4) * 4 + q; const float val = (s <= t) ? aS[i][q] * expf(sc[t] + gsv - sc[128 + t]) : 0.f; Ss[t * 72 + s] = f2bf(val); rs[q] += val; } }
#pragma unroll
        for (int q = 0; q < 4; ++q) { float r = rs[q]; r += __shfl_xor(r, 1); r += __shfl_xor(r, 2); r += __shfl_xor(r, 4); r += __shfl_xor(r, 8);
            if ((lane & 15) == 0) sc[512 + (w & 1) * 64 + 16 * tt + (lane >> 4) * 4 + q] = r; }
        {   const int t = tid >> 3, part = tid & 7; float dot = 0.f;
#pragma unroll
            for (int j = 0; j < 16; ++j) dot += bf2f(Qs[t * 136 + part * 16 + j]) * sc[384 + part * 16 + j];
            dot += __shfl_xor(dot, 1); dot += __shfl_xor(dot, 2); dot += __shfl_xor(dot, 4);
            if (part == 0) sc[640 + t] = sc[192 + t] * dot; }
    }
    __syncthreads();
    {   f32x4 aN[4];
#pragma unroll
        for (int i = 0; i < 4; ++i) aN[i] = (f32x4){0.f, 0.f, 0.f, 0.f};
#pragma unroll
        for (int ks = 0; ks < 4; ++ks) { const bf16x8 af = *(const bf16x8*)(Qs + (16 * tt + (lane & 15)) * 136 + ks * 32 + (lane >> 4) * 8);
#pragma unroll
            for (int i = 0; i < 4; ++i) { const int et = (w & 1) * 4 + i; const bf16x8 bfr = *(const bf16x8*)(Cs + (16 * et + (lane & 15)) * 136 + ks * 32 + (lane >> 4) * 8);
                aN[i] = __builtin_amdgcn_mfma_f32_16x16x32_bf16(af, bfr, aN[i], 0, 0, 0); } }
#pragma unroll
        for (int q = 0; q < 4; ++q) { const float it = sc[192 + 16 * tt + (lane >> 4) * 4 + q];
#pragma unroll
            for (int i = 0; i < 4; ++i) aN[i][q] *= it; }
#pragma unroll
        for (int ks = 0; ks < 2; ++ks) { const bf16x8 af = *(const bf16x8*)(Ss + (16 * tt + (lane & 15)) * 72 + ks * 32 + (lane >> 4) * 8);
#pragma unroll
            for (int i = 0; i < 4; ++i) { const int et = (w & 1) * 4 + i; const bf16x8 bfr = *(const bf16x8*)(VT + (16 * et + (lane & 15)) * 72 + ks * 32 + (lane >> 4) * 8);
                aN[i] = __builtin_amdgcn_mfma_f32_16x16x32_bf16(af, bfr, aN[i], 0, 0, 0); } }
#pragma unroll
        for (int q = 0; q < 4; ++q) { const int t = 16 * tt + (lane >> 4) * 4 + q; const size_t tokt = (size_t)step_tok(b, dir, c * 64 + t); const float dn = fmaxf(fabsf((sc[512 + t] + sc[576 + t]) + sc[640 + t]), sc[256 + t]);
#pragma unroll
            for (int i = 0; i < 4; ++i) { const int e = 16 * ((w & 1) * 4 + i) + (lane & 15); Hout[tokt * BW + h * 128 + e] = aN[i][q] / dn; } }
    }
}


__device__ __forceinline__ void ssd_state_pass(const int chain, const bf16_t* __restrict__ Pm, const bf16_t* __restrict__ XBb, const float Aa, const float dtb,
                                               bf16_t* __restrict__ SSTb, unsigned char* shm, const int tid) {
    const int dir = chain & 1, h = (chain >> 1) & 7, b = chain >> 4, grp = h >> 2, lane = tid & 63, w = tid >> 6;
    bf16_t* BT = (bf16_t*)shm; bf16_t* XT = (bf16_t*)(shm + 36864);
    f32x4 acc[4];
#pragma unroll
    for (int j = 0; j < 4; ++j) acc[j] = (f32x4){0.f, 0.f, 0.f, 0.f};
    const int dcol = SSD_OFF + 1536 + dir * 8 + h;
    const int s0 = tid >> 4, x0 = (tid & 15) * 8, sx = tid >> 3, xx0 = (tid & 7) * 8;
    bf16_t d0, d1; u32x4 bq[2], xq;
    { d0 = Pm[(size_t)step_tok(b, dir, lane) * LDP + dcol]; d1 = Pm[(size_t)step_tok(b, dir, 64 + lane) * LDP + dcol];
#pragma unroll
      for (int i = 0; i < 2; ++i) bq[i] = *(const u32x4*)(XBb + (size_t)step_tok(b, dir, s0 + 32 * i) * 1024 + 512 + grp * 128 + x0);
      xq = *(const u32x4*)(XBb + (size_t)step_tok(b, dir, sx) * 1024 + h * 64 + xx0); }
    __syncthreads();
    for (int c = 0; c < 68; ++c) {
        const int buf = c & 1;
        const float xv = bf2f(d0) + dtb; const float dtv = xv > 20.f ? xv : log1pf(expf(xv));
        d0 = d1; if (c + 2 < 68) d1 = Pm[(size_t)step_tok(b, dir, (c + 2) * 64 + lane) * LDP + dcol];
        const float cs = wave_scan_incl(dtv * Aa, lane); const float cl = __shfl(cs, 63);
        const float scl = dtv * expf(cl - cs); const float dec = expf(cl);
        {   bf16_t* ss = SSTb + (size_t)(chain * 68 + c) * 64 * 128; const int p = 16 * (w & 3) + (lane & 15);
#pragma unroll
            for (int j = 0; j < 4; ++j) { const int n0 = 16 * ((w >> 2) * 4 + j) + (lane >> 4) * 4; u32x2 pk; pk.x = pk2(acc[j][0], acc[j][1]); pk.y = pk2(acc[j][2], acc[j][3]); *(u32x2*)(ss + (size_t)p * 128 + n0) = pk; } }
#pragma unroll
        for (int i = 0; i < 2; ++i) { const int s = s0 + 32 * i; bf16_t bh[8]; unpack8h(bq[i], bh);
#pragma unroll
            for (int j = 0; j < 8; ++j) BT[(buf * 128 + x0 + j) * 72 + s] = bh[j]; }
        {   const float sv = __shfl(scl, sx); float f[8]; unpack8(xq, f);
#pragma unroll
            for (int j = 0; j < 8; ++j) XT[(buf * 64 + xx0 + j) * 72 + sx] = f2bf(f[j] * sv); }
        __syncthreads();
        if (c + 1 < 68) {
#pragma unroll
            for (int i = 0; i < 2; ++i) bq[i] = *(const u32x4*)(XBb + (size_t)step_tok(b, dir, (c + 1) * 64 + s0 + 32 * i) * 1024 + 512 + grp * 128 + x0);
            xq = *(const u32x4*)(XBb + (size_t)step_tok(b, dir, (c + 1) * 64 + sx) * 1024 + h * 64 + xx0); }
#pragma unroll
        for (int j = 0; j < 4; ++j) acc[j] = acc[j] * dec;
#pragma unroll
        for (int ks = 0; ks < 2; ++ks) { const bf16x8 xfrag = *(const bf16x8*)(XT + (buf * 64 + 16 * (w & 3) + (lane & 15)) * 72 + ks * 32 + (lane >> 4) * 8);
#pragma unroll
            for (int j = 0; j < 4; ++j) { const bf16x8 bfrag = *(const bf16x8*)(BT + (buf * 128 + 16 * ((w >> 2) * 4 + j) + (lane & 15)) * 72 + ks * 32 + (lane >> 4) * 8);
                acc[j] = __builtin_amdgcn_mfma_f32_16x16x32_bf16(bfrag, xfrag, acc[j], 0, 0, 0); } }
    }
}
__device__ __forceinline__ void ssd_out_item(const int chain, const int c, const bf16_t* __restrict__ Pm, const bf16_t* __restrict__ XBb, const float Aa, const float dtb,
                                             const bf16_t* __restrict__ SSTb, float* __restrict__ Yout, unsigned char* shm, const int tid) {
    const int dir = chain & 1, h = (chain >> 1) & 7, b = chain >> 4, grp = h >> 2, lane = tid & 63, w = tid >> 6;
    bf16_t* Cs = (bf16_t*)shm; bf16_t* Bs = (bf16_t*)(shm + 17408); bf16_t* XT = (bf16_t*)(shm + 34816); bf16_t* Sin = (bf16_t*)(shm + 44032); bf16_t* Gs = (bf16_t*)(shm + 61440);
    float* sc = (float*)(shm + 70656);
    __syncthreads();
#pragma unroll
    for (int i = 0; i < 2; ++i) { const int pid = tid + i * 512; const int s = pid >> 4, x0 = (pid & 15) * 8; const size_t toks = (size_t)step_tok(b, dir, c * 64 + s);
        *(u32x4*)(Bs + s * 136 + x0) = *(const u32x4*)(XBb + toks * 1024 + 512 + grp * 128 + x0);
        *(u32x4*)(Cs + s * 136 + x0) = *(const u32x4*)(XBb + toks * 1024 + 768 + grp * 128 + x0);
        const int p = pid >> 4;
        *(u32x4*)(Sin + p * 136 + x0) = *(const u32x4*)(SSTb + ((size_t)(chain * 68 + c) * 64 + p) * 128 + x0); }
    {   const int s = tid >> 3, x0 = (tid & 7) * 8; const size_t toks = (size_t)step_tok(b, dir, c * 64 + s);
        bf16_t xh[8]; unpack8h(*(const u32x4*)(XBb + toks * 1024 + h * 64 + x0), xh);
#pragma unroll
        for (int j = 0; j < 8; ++j) XT[(x0 + j) * 72 + s] = xh[j]; }
    if (w == 0) { const size_t tokl = (size_t)step_tok(b, dir, c * 64 + lane);
        const float xv = bf2f(Pm[tokl * LDP + SSD_OFF + 1536 + dir * 8 + h]) + dtb; const float dtv = xv > 20.f ? xv : log1pf(expf(xv));
        sc[lane] = wave_scan_incl(dtv * Aa, lane); sc[64 + lane] = dtv; }
    __syncthreads();
    {   const int lt = w >> 1;
        f32x4 aG[2] = {(f32x4){0.f, 0.f, 0.f, 0.f}, (f32x4){0.f, 0.f, 0.f, 0.f}};
#pragma unroll
        for (int ks = 0; ks < 4; ++ks) { const bf16x8 af = *(const bf16x8*)(Cs + (16 * lt + (lane & 15)) * 136 + ks * 32 + (lane >> 4) * 8);
#pragma unroll
            for (int i = 0; i < 2; ++i) { const int st = (w & 1) * 2 + i; const bf16x8 bfr = *(const bf16x8*)(Bs + (16 * st + (lane & 15)) * 136 + ks * 32 + (lane >> 4) * 8);
                aG[i] = __builtin_amdgcn_mfma_f32_16x16x32_bf16(af, bfr, aG[i], 0, 0, 0); } }
#pragma unroll
        for (int i = 0; i < 2; ++i) { const int s = 16 * ((w & 1) * 2 + i) + (lane & 15); const float css = sc[s], dts = sc[64 + s];
#pragma unroll
            for (int q = 0; q < 4; ++q) { const int t = 16 * lt + (lane >> 4) * 4 + q; const float val = (s <= t) ? aG[i][q] * expf(sc[t] - css) * dts : 0.f; Gs[t * 72 + s] = f2bf(val); } }
    }
    __syncthreads();
    {   const int lt = w >> 1;
        f32x4 aY[2] = {(f32x4){0.f, 0.f, 0.f, 0.f}, (f32x4){0.f, 0.f, 0.f, 0.f}};
#pragma unroll
        for (int ks = 0; ks < 4; ++ks) { const bf16x8 af = *(const bf16x8*)(Cs + (16 * lt + (lane & 15)) * 136 + ks * 32 + (lane >> 4) * 8);
#pragma unroll
            for (int i = 0; i < 2; ++i) { const int pt = (w & 1) * 2 + i; const bf16x8 bfr = *(const bf16x8*)(Sin + (16 * pt + (lane & 15)) * 136 + ks * 32 + (lane >> 4) * 8);
                aY[i] = __builtin_amdgcn_mfma_f32_16x16x32_bf16(af, bfr, aY[i], 0, 0, 0); } }
#pragma unroll
        for (int q = 0; q < 4; ++q) { const float ec = expf(sc[16 * lt + (lane >> 4) * 4 + q]); aY[0][q] *= ec; aY[1][q] *= ec; }
#pragma unroll
        for (int ks = 0; ks < 2; ++ks) { const bf16x8 af = *(const bf16x8*)(Gs + (16 * lt + (lane & 15)) * 72 + ks * 32 + (lane >> 4) * 8);
#pragma unroll
            for (int i = 0; i < 2; ++i) { const int pt = (w & 1) * 2 + i; const bf16x8 bfr = *(const bf16x8*)(XT + (16 * pt + (lane & 15)) * 72 + ks * 32 + (lane >> 4) * 8);
                aY[i] = __builtin_amdgcn_mfma_f32_16x16x32_bf16(af, bfr, aY[i], 0, 0, 0); } }
#pragma unroll
        for (int q = 0; q < 4; ++q) { const int t = 16 * lt + (lane >> 4) * 4 + q; const size_t tokt = (size_t)step_tok(b, dir, c * 64 + t);
#pragma unroll
            for (int i = 0; i < 2; ++i) { const int p = 16 * ((w & 1) * 2 + i) + (lane & 15); Yout[tokt * BW + h * 64 + p] = aY[i][q]; } }
    }
}


#define FIDX(i) ((i) + ((i) >> 4))
#define FFT_X_BYTES 69632
template <int R, bool INV>
__device__ __forceinline__ void fft_pass(float2* __restrict__ X, const float2* __restrict__ TW, const int s0, const int gidx) {
    const int lowbits = 13 - s0 - R; const int stride = 1 << lowbits;
    const int low = gidx & (stride - 1), high = gidx >> lowbits; const int base = (high << (lowbits + R)) | low;
    static_assert(13 - 0 - R >= 0, "radix");
    const int p0 = FIDX(base);
#define FFT_SLOT(k) (lowbits >= 4 ? p0 + (k) * (stride + (stride >> 4)) : p0 + (k) + ((k) >> 4))
    float2 v[1 << R];
#pragma unroll
    for (int k = 0; k < (1 << R); ++k) v[k] = X[FFT_SLOT(k)];
    if (!INV) {
#pragma unroll
        for (int j = 0; j < R; ++j) { const int hk = 1 << (R - 1 - j);
#pragma unroll
            for (int k = 0; k < (1 << R); ++k) if (!(k & hk)) { const int kk = k & (hk - 1); const int m = (low + stride * kk) << (s0 + j);
                const float2 a = v[k], b = v[k + hk], w = TW[m]; v[k] = make_float2(a.x + b.x, a.y + b.y); const float dx = a.x - b.x, dy = a.y - b.y; v[k + hk] = make_float2(dx * w.x - dy * w.y, dx * w.y + dy * w.x); } }
    } else {
#pragma unroll
        for (int j = R - 1; j >= 0; --j) { const int hk = 1 << (R - 1 - j);
#pragma unroll
            for (int k = 0; k < (1 << R); ++k) if (!(k & hk)) { const int kk = k & (hk - 1); const int m = (low + stride * kk) << (s0 + j);
                const float2 a = v[k], b = v[k + hk], w = TW[m]; const float tx = b.x * w.x + b.y * w.y, ty = b.y * w.x - b.x * w.y;
                v[k] = make_float2(a.x + tx, a.y + ty); v[k + hk] = make_float2(a.x - tx, a.y - ty); } }
    }
#pragma unroll
    for (int k = 0; k < (1 << R); ++k) X[FFT_SLOT(k)] = v[k];
#undef FFT_SLOT
}
__device__ __forceinline__ void fft_fwd(float2* X, const float2* TW, const int tid) {
    fft_pass<4, false>(X, TW, 0, tid); __syncthreads(); fft_pass<4, false>(X, TW, 4, tid); __syncthreads(); if (tid < 256) fft_pass<5, false>(X, TW, 8, tid); __syncthreads(); }
__device__ __forceinline__ void fft_inv(float2* X, const float2* TW, const int tid) {
    if (tid < 256) fft_pass<5, true>(X, TW, 8, tid); __syncthreads(); fft_pass<4, true>(X, TW, 4, tid); __syncthreads(); fft_pass<4, true>(X, TW, 0, tid); __syncthreads(); }
__device__ __forceinline__ void fft_twiddles(float2* TW, const int tid) {
#pragma unroll
    for (int k = 0; k < 8; ++k) { const int m = tid + k * 512; const float xx = (float)m * (1.0f / 4096.0f); TW[m] = make_float2(cospif(xx), -sinpif(xx)); }
}
__device__ __forceinline__ void hyena_spec_item(const int oc, const float* __restrict__ HR, const float* __restrict__ nrm, float2* __restrict__ HSPEC, unsigned char* shm, const int tid) {
    float2* X = (float2*)shm; const float2* TW = (const float2*)(shm + FFT_X_BYTES);
    const int o = oc >> 9, c = oc & 511; const float inv = 1.0f / nrm[oc];
    __syncthreads();
#pragma unroll 2
    for (int k = 0; k < 16; ++k) { const int j = tid + k * 512; float v;
        if (j < SEQ) v = HR[(unsigned)j * 2048u + o * 1024 + c] * inv; else if (j == SEQ) v = 0.f; else v = HR[(unsigned)(2 * SEQ - j) * 2048u + o * 1024 + 512 + c] * inv;
        X[FIDX(j)] = make_float2(v, 0.f); }
    __syncthreads();
    fft_fwd(X, TW, tid);
    float4* out = (float4*)(HSPEC + (size_t)oc * 8192 + tid * 16); const float2* xs = X + 17 * tid;
#pragma unroll
    for (int k = 0; k < 8; ++k) { const float2 x0 = xs[2 * k], x1 = xs[2 * k + 1]; out[k] = make_float4(x0.x * (1.0f / 8192.0f), x0.y * (1.0f / 8192.0f), x1.x * (1.0f / 8192.0f), x1.y * (1.0f / 8192.0f)); }
}
__device__ __forceinline__ void fft_mul_spec(float2* X, const float2* __restrict__ H, const int tid) {
    const float4* h4 = (const float4*)(H + tid * 16); float2* xs = X + 17 * tid;
#pragma unroll
    for (int k = 0; k < 8; ++k) { const float4 hv = h4[k]; const float2 x0 = xs[2 * k], x1 = xs[2 * k + 1];
        xs[2 * k] = make_float2(x0.x * hv.x - x0.y * hv.y, x0.x * hv.y + x0.y * hv.x); xs[2 * k + 1] = make_float2(x1.x * hv.z - x1.y * hv.w, x1.x * hv.w + x1.y * hv.z); }
}
__device__ __forceinline__ void hyena_fft_item(const int item, const float* __restrict__ UT, const float2* __restrict__ HSPEC, const float* __restrict__ bias, float* __restrict__ YT, unsigned char* shm, const int tid) {
    float2* X = (float2*)shm; const float2* TW = (const float2*)(shm + FFT_X_BYTES);
    const int c = item >> 1, b0 = (item & 1) * 2, b1 = b0 + 1;
    const float* u0 = UT + (size_t)(b0 * 1536 + c) * SEQ + tid * 8; const float* u1 = UT + (size_t)(b1 * 1536 + c) * SEQ + tid * 8;
    const float bias0 = bias[c], bias1 = bias[512 + c];
    float2* xs = X + FIDX(8 * tid);
    float vr[8], vi[8];
    __syncthreads();
    { const float4 a0 = *(const float4*)u0, a1 = *(const float4*)(u0 + 4), c0 = *(const float4*)u1, c1 = *(const float4*)(u1 + 4);
      vr[0] = a0.x; vr[1] = a0.y; vr[2] = a0.z; vr[3] = a0.w; vr[4] = a1.x; vr[5] = a1.y; vr[6] = a1.z; vr[7] = a1.w;
      vi[0] = c0.x; vi[1] = c0.y; vi[2] = c0.z; vi[3] = c0.w; vi[4] = c1.x; vi[5] = c1.y; vi[6] = c1.z; vi[7] = c1.w; }
#pragma unroll
    for (int k = 0; k < 8; ++k) { xs[k] = make_float2(vr[k], vi[k]); xs[4352 + k] = make_float2(0.f, 0.f); }
    __syncthreads();
    fft_fwd(X, TW, tid);
    fft_mul_spec(X, HSPEC + (size_t)c * 8192, tid);
    __syncthreads();
    fft_inv(X, TW, tid);
    { const float* p0 = u0 + (size_t)512 * SEQ; const float* p1 = u1 + (size_t)512 * SEQ;
      const float4 a0 = *(const float4*)p0, a1 = *(const float4*)(p0 + 4), c0 = *(const float4*)p1, c1 = *(const float4*)(p1 + 4);
      const float xr[8] = {a0.x, a0.y, a0.z, a0.w, a1.x, a1.y, a1.z, a1.w}, xi[8] = {c0.x, c0.y, c0.z, c0.w, c1.x, c1.y, c1.z, c1.w};
#pragma unroll
      for (int k = 0; k < 8; ++k) { const float2 cv = xs[k]; const float zr = xr[k] * (cv.x + bias0 * vr[k]), zi = xi[k] * (cv.y + bias0 * vi[k]);
          vr[k] = zr; vi[k] = zi; xs[k] = make_float2(zr, zi); xs[4352 + k] = make_float2(0.f, 0.f); } }
    __syncthreads();
    fft_fwd(X, TW, tid);
    fft_mul_spec(X, HSPEC + (size_t)(512 + c) * 8192, tid);
    __syncthreads();
    fft_inv(X, TW, tid);
    { const float* p0 = u0 + (size_t)1024 * SEQ; const float* p1 = u1 + (size_t)1024 * SEQ;
      const float4 a0 = *(const float4*)p0, a1 = *(const float4*)(p0 + 4), c0 = *(const float4*)p1, c1 = *(const float4*)(p1 + 4);
      const float xr[8] = {a0.x, a0.y, a0.z, a0.w, a1.x, a1.y, a1.z, a1.w}, xi[8] = {c0.x, c0.y, c0.z, c0.w, c1.x, c1.y, c1.z, c1.w};
      float yr[8], yi[8];
#pragma unroll
      for (int k = 0; k < 8; ++k) { const float2 cv = xs[k]; yr[k] = xr[k] * (cv.x + bias1 * vr[k]); yi[k] = xi[k] * (cv.y + bias1 * vi[k]); }
      float* y0 = YT + (size_t)(b0 * 512 + c) * SEQ + tid * 8; float* y1 = YT + (size_t)(b1 * 512 + c) * SEQ + tid * 8;
      *(float4*)y0 = make_float4(yr[0], yr[1], yr[2], yr[3]); *(float4*)(y0 + 4) = make_float4(yr[4], yr[5], yr[6], yr[7]);
      *(float4*)y1 = make_float4(yi[0], yi[1], yi[2], yi[3]); *(float4*)(y1 + 4) = make_float4(yi[4], yi[5], yi[6], yi[7]); }
}

constexpr size_t al256(size_t x) { return (x + 255) & ~(size_t)255; }
constexpr size_t O_BAR = 0;
constexpr size_t O_MOD = 16384;
constexpr size_t O_NORM = O_MOD + al256((size_t)2 * 5 * 6 * DM * 4);
constexpr size_t O_QCTR = O_NORM + al256((size_t)2 * 2 * 1024 * 4);
constexpr size_t O_ZERO_END = O_QCTR + 512;
constexpr size_t O_XS = O_ZERO_END;
constexpr size_t O_HB = O_XS + al256((size_t)NTOK * DM * 4);
constexpr size_t O_P = O_HB + al256((size_t)NTOK * DM * 2);
constexpr size_t O_WIN = O_P + al256((size_t)NTOK * LDP * 2);
constexpr size_t O_WBR = O_WIN + al256((size_t)LDP * DM * 2);
constexpr size_t O_WOUT = O_WBR + al256((size_t)4 * DM * BW * 2);
constexpr size_t O_WGU = O_WOUT + al256((size_t)DM * DM * 2);
constexpr size_t O_WD = O_WGU + al256((size_t)NEXP * 2 * DEXP * DM * 2);
constexpr size_t O_GLU = O_WD + al256((size_t)NEXP * DM * DEXP * 2);
constexpr size_t O_Y4 = O_GLU + al256((size_t)BW * BW * 2);
constexpr size_t O_U = O_Y4 + al256((size_t)NTOK * DM * 2);
constexpr size_t O_QKB = O_U + al256((size_t)NTOK * 1536 * 4);
constexpr size_t O_CST = O_QKB + al256((size_t)NTOK * 1024 * 2);
constexpr size_t O_NST = O_CST + al256((size_t)32 * 68 * 128 * 128 * 2);
constexpr size_t O_MST = O_NST + al256((size_t)32 * 68 * 128 * 4);
constexpr size_t O_XBC = O_MST + al256((size_t)32 * 68 * 4);
constexpr size_t O_SST = O_XBC + al256((size_t)NTOK * 1024 * 2);
constexpr size_t O_HF = O_SST + al256((size_t)64 * 68 * 64 * 128 * 2);
constexpr size_t O_YF = O_HF + al256((size_t)2 * NTOK * BW * 4);
constexpr size_t O_SF = O_YF + al256((size_t)2 * NTOK * BW * 4);
constexpr size_t O_LDT = O_SF + al256((size_t)2 * NCTX * BW * 4);
constexpr size_t O_AP = O_LDT + al256((size_t)4096 * 16);
constexpr size_t O_BBT = O_AP + al256((size_t)4096 * 33 * 8);
constexpr size_t O_KT = O_BBT + al256((size_t)4096 * 16 * 8);
constexpr size_t O_S5A = O_KT + al256((size_t)32 * 2 * 32 * 256 * 4);
constexpr size_t O_S5B = O_S5A + al256((size_t)32 * 512 * 768 * 2);
constexpr size_t O_XCTX = O_S5B + al256((size_t)32 * 512 * 768 * 2);
constexpr size_t O_Z = O_XCTX + al256((size_t)4 * 32 * 2 * 64 * 8);
constexpr size_t O_HRAW = O_Z + al256((size_t)NTOK * BW * 4);
constexpr size_t O_HSPEC = O_HRAW + al256((size_t)(SEQ + CTXL) * 2048 * 4);
constexpr size_t O_K2C = O_HSPEC + al256((size_t)1024 * 8192 * 8);
constexpr size_t O_GG = O_K2C + al256((size_t)(2 * CTXL) * 1024 * 4);
constexpr size_t O_PROBS = O_GG + al256((size_t)NTOK * BW * 2);
constexpr size_t O_ROWTOK = O_PROBS + al256((size_t)NTOK * 16 * 4);
constexpr size_t O_ROWGATE = O_ROWTOK + al256((size_t)NEXP * MOE_PAD * 4);
constexpr size_t O_NORMP = O_ROWGATE + al256((size_t)NEXP * MOE_PAD * 4);
constexpr size_t WS_END = O_NORMP + al256((size_t)4 * 256 * 2048 * 4);
constexpr size_t O_XG = O_P;
constexpr size_t O_HID = O_P + al256((size_t)NEXP * MOE_PAD * DM * 2);
constexpr size_t O_MOEI = O_HID + al256((size_t)NEXP * MOE_PAD * DEXP * 2);
static_assert(O_MOEI + (size_t)NTOK * DM * 4 <= O_WIN, "MoE temporaries must fit inside P");
static_assert((size_t)NTOK * DM * 2 <= (size_t)NTOK * 1536 * 4, "ACCb must fit inside U");
static_assert(WS_END <= (size_t)1851000000, "workspace map exceeds the guaranteed size");

struct Args {
    const float* in[47];
    float* out; unsigned char* ws;
    int ph_lo, ph_hi;
};

__device__ __forceinline__ void conv_tile(const float* __restrict__ src, int ldsrc, int nvalid, int k0, int n0, bf16_t* __restrict__ dst, int lddst, int mode, float* T, int tid) {
    { const int n = tid & 63, kr = tid >> 6;
#pragma unroll
      for (int i = 0; i < 8; ++i) { const int k = i * 8 + kr; T[k * 65 + n] = (n0 + n < nvalid) ? src[(size_t)(k0 + k) * ldsrc + n0 + n] : 0.f; } }
    __syncthreads();
    { const int n = tid >> 3, kc = (tid & 7) * 8; const int gn = n0 + n;
      const int drow = mode == 0 ? gn : (32 * (gn >> 4) + (mode == 2 ? 16 : 0) + (gn & 15));
      u32x4 w; w.x = pk2(T[(kc + 0) * 65 + n], T[(kc + 1) * 65 + n]); w.y = pk2(T[(kc + 2) * 65 + n], T[(kc + 3) * 65 + n]);
      w.z = pk2(T[(kc + 4) * 65 + n], T[(kc + 5) * 65 + n]); w.w = pk2(T[(kc + 6) * 65 + n], T[(kc + 7) * 65 + n]);
      *(u32x4*)(dst + (size_t)drow * lddst + k0 + kc) = w; }
    __syncthreads();
}

#define IN(id) (lo <= (id) && (id) < hi)
#define SEAM(id) do { if (hi > (id) + 1) xcd_barrier(bar); } while (0)
#define PH_BEGIN int tid = threadIdx.x; asm volatile("" : "+v"(tid) :: "memory"); const int lane = tid & 63, wave = tid >> 6; (void)lane; (void)wave;

#define x_in (PT(0))
#define c_in (PT(1))
#define ctx_in (PT(2))
#define cctx_in (PT(3))
#define ada_w (PT(4))
#define ada_b (PT(5))
#define norm_mix (PT(6))
#define norm_ffn (PT(7))
#define w_in (PT(8))
#define XS ((float*)(a.ws + O_XS))
#define MOD ((float*)(a.ws + O_MOD))
#define NORM ((float*)(a.ws + O_NORM))
#define NORMP ((float*)(a.ws + O_NORMP))
#define MODl (MOD + (size_t)l * 5 * 6 * DM)
#define HB ((bf16_t*)(a.ws + O_HB))
#define P ((bf16_t*)(a.ws + O_P))
#define WIN ((bf16_t*)(a.ws + O_WIN))
#define WBR ((bf16_t*)(a.ws + O_WBR))
#define WOUT ((bf16_t*)(a.ws + O_WOUT))
#define WGU ((bf16_t*)(a.ws + O_WGU))
#define WD ((bf16_t*)(a.ws + O_WD))
#define GLU ((bf16_t*)(a.ws + O_GLU))
#define Y4 ((bf16_t*)(a.ws + O_Y4))
#define U ((float*)(a.ws + O_U))
#define ACCb ((bf16_t*)(a.ws + O_U))
#define QKB ((bf16_t*)(a.ws + O_QKB))
#define CST ((bf16_t*)(a.ws + O_CST))
#define NST ((float*)(a.ws + O_NST))
#define MST ((float*)(a.ws + O_MST))
#define XBC ((bf16_t*)(a.ws + O_XBC))
#define SSTB ((bf16_t*)(a.ws + O_SST))
#define HF ((float*)(a.ws + O_HF))
#define HBk (HF + (size_t)NTOK * BW)
#define YF ((float*)(a.ws + O_YF))
#define YB (YF + (size_t)NTOK * BW)
#define SF ((float*)(a.ws + O_SF))
#define SB (SF + (size_t)NCTX * BW)
#define LDT ((double2*)(a.ws + O_LDT))
#define APW ((float2*)(a.ws + O_AP))
#define BBT ((float2*)(a.ws + O_BBT))
#define KTB ((float*)(a.ws + O_KT))
#define S5A ((bf16_t*)(a.ws + O_S5A))
#define S5B ((bf16_t*)(a.ws + O_S5B))
#define XCTX ((float2*)(a.ws + O_XCTX))
#define S5P ((bf16_t*)(a.ws + O_HB))
#define XLOC ((float*)(a.ws + O_HB + (size_t)32 * 256 * 512 * 2))
#define Z ((float*)(a.ws + O_Z))
#define HRAW ((float*)(a.ws + O_HRAW))
#define HSPEC ((float2*)(a.ws + O_HSPEC))
#define UT ((float*)(a.ws + O_U))
#define YT ((float*)(a.ws + O_Z))
#define QCTR ((int*)(a.ws + O_QCTR))
#define K2C ((float*)(a.ws + O_K2C))
#define GG ((bf16_t*)(a.ws + O_GG))
#define PROBS ((float*)(a.ws + O_PROBS))
#define ROWTOK ((int*)(a.ws + O_ROWTOK))
#define ROWGATE ((float*)(a.ws + O_ROWGATE))
#define XG ((bf16_t*)(a.ws + O_XG))
#define HID ((bf16_t*)(a.ws + O_HID))
#define MOEI ((int*)(a.ws + O_MOEI))


struct CvU { const float* src; bf16_t* dst; int ldsrc, nvalid, k0, n0, lddst, mode; };
__device__ __forceinline__ void cv_load(const CvU& u, float4 (&r)[8], const int tid) {
#pragma unroll
    for (int i = 0; i < 8; ++i) { const int idx = tid + i * 512; const int k = idx >> 6, n = u.n0 + (idx & 63) * 4;
        r[i] = (n < u.nvalid) ? *(const float4*)(u.src + (size_t)(u.k0 + k) * u.ldsrc + n) : make_float4(0.f, 0.f, 0.f, 0.f); }
}
__device__ __forceinline__ void cv_stage(float* T, const float4 (&r)[8], const int tid) {
#pragma unroll
    for (int i = 0; i < 8; ++i) { const int idx = tid + i * 512; float* p = T + (idx >> 6) * 257 + (idx & 63) * 4; p[0] = r[i].x; p[1] = r[i].y; p[2] = r[i].z; p[3] = r[i].w; }
}
__device__ __forceinline__ void cv_store(const CvU& u, const float* T, const int tid) {
#pragma unroll
    for (int j = 0; j < 4; ++j) { const int o = tid + j * 512; const int kc = (o & 7) * 8, n = o >> 3; const int gn = u.n0 + n;
        const int drow = u.mode == 0 ? gn : (32 * (gn >> 4) + (u.mode == 2 ? 16 : 0) + (gn & 15));
        const float* t = T + kc * 257 + n;
        u32x4 w; w.x = pk2(t[0], t[257]); w.y = pk2(t[2 * 257], t[3 * 257]); w.z = pk2(t[4 * 257], t[5 * 257]); w.w = pk2(t[6 * 257], t[7 * 257]);
        *(u32x4*)(u.dst + (size_t)drow * u.lddst + u.k0 + kc) = w; }
}
template <int LAYER>
__device__ __forceinline__ void layer_body(const Args& a, const XcdBarrier& bar, const int lo, const int hi, const int bid, const int G, unsigned char* const shm, float* const sf, const float** const ptab) {
        constexpr int l = LAYER;
        constexpr int PB = 1 + 16 * l;
        const bool lastl = (l == 1);

        const int nPanels = lastl ? 64 : 68;
        const int M2 = nPanels * 256;

        if (IN(PB + 0)) for (int rep_ = 0; rep_ < PROBE_REPS(0); ++rep_) {
            PH_BEGIN
            {   const float* wbr = PT(40) + (size_t)l * 4 * BW * DM; const float* wout = PT(41) + (size_t)l * DM * DM;
                const float* wg = PT(43) + (size_t)l * NEXP * DM * DEXP; const float* wu = PT(44) + (size_t)l * NEXP * DM * DEXP; const float* wd = PT(45) + (size_t)l * NEXP * DEXP * DM;
                const float* wglu = PT(32) + (size_t)l * BW * BW; const float* win = w_in + (size_t)l * DM * IN_W;
                const int n_win = 32 * 55, n_br = 4 * 64, n_out = 32 * 8, n_gu = 16 * 2 * 192, n_d = 16 * 192, n_glu = 16;
                const int total = n_win + n_br + n_out + n_gu + n_d + n_glu;
#define CV_DECODE(q_, u_) do { int qq_ = (q_); \
                    if (qq_ < n_win) { u_ = CvU{win, WIN, IN_W, IN_W, (qq_ / 55) * 64, (qq_ % 55) * 256, DM, 0}; } else { qq_ -= n_win; \
                    if (qq_ < n_br) { const int k = qq_ >> 6, r = qq_ & 63; u_ = CvU{wbr + (size_t)k * BW * DM, WBR + (size_t)k * DM * BW, DM, DM, (r >> 3) * 64, (r & 7) * 256, BW, 0}; } else { qq_ -= n_br; \
                    if (qq_ < n_out) { u_ = CvU{wout, WOUT, DM, DM, (qq_ >> 3) * 64, (qq_ & 7) * 256, DM, 0}; } else { qq_ -= n_out; \
                    if (qq_ < n_gu) { const int e = qq_ / 384, r = qq_ % 384, up = r / 192, r2 = r % 192; u_ = CvU{(up ? wu : wg) + (size_t)e * DM * DEXP, WGU + (size_t)e * 2 * DEXP * DM, DEXP, DEXP, (r2 / 6) * 64, (r2 % 6) * 256, DM, 1 + up}; } else { qq_ -= n_gu; \
                    if (qq_ < n_d) { const int e = qq_ / 192, r = qq_ % 192; u_ = CvU{wd + (size_t)e * DEXP * DM, WD + (size_t)e * DM * DEXP, DM, DM, (r >> 3) * 64, (r & 7) * 256, DEXP, 0}; } else { qq_ -= n_d; \
                    u_ = CvU{wglu, GLU, BW, BW, (qq_ >> 1) * 64, (qq_ & 1) * 256, BW, 0}; } } } } } } while (0)
                __syncthreads();
                int q = bid; int buf = 0; CvU u; float4 r[8];
                if (q < total) { CV_DECODE(q, u); cv_load(u, r, tid); }
                while (q < total) {
                    float* T = sf + buf * (64 * 257);
                    cv_stage(T, r, tid);
                    __syncthreads();
                    const CvU cur = u; const int qn = q + G;
                    if (qn < total) { CV_DECODE(qn, u); cv_load(u, r, tid); }
                    cv_store(cur, T, tid);
                    buf ^= 1; q = qn;
                }
#undef CV_DECODE
                __syncthreads();
            }
            for (int set = 0; set < (lastl ? 1 : 2); ++set) {
                const int L = set ? CTXL : SEQ; float* HR = HRAW + (set ? (size_t)SEQ * 2048 : 0);
                const float* w1 = PT(11) + l * 33 * 64; const float* b1 = PT(12) + l * 64; const float* fr1 = PT(13) + l * 64; const float* w2 = PT(14) + l * 64 * 64; const float* b2 = PT(15) + l * 64;
                const float* fr2 = PT(16) + l * 64; const float* w3 = PT(17) + l * 64 * 2048; const float* decay = PT(18) + l * 2048;
                float* feats = sf; float* h1 = sf + 16 * 33; float* h2 = h1 + 16 * 64;
                float nacc[4] = {0.f, 0.f, 0.f, 0.f};
                for (int base = bid; base < L; base += 16 * G) {
                    __syncthreads();
                    for (int e = tid; e < 16 * 33; e += NTHR) { const int ti = e / 33, fi = e % 33; int t = base + ti * G; if (t > L - 1) t = L - 1;
                        float v;
                        if (fi == 0) v = (float)t / (float)(L - 1);
                        else { const int j = (fi - 1) & 15; const double fr = 1e-4 + (double)j * ((15.0 - 1e-4) / 15.0); const double ang = (2.0 * 3.14159265358979323846 / (double)L) * (double)t * fr; v = fi <= 16 ? (float)cos(ang) : (float)(-sin(ang)); }
                        feats[e] = v; }
                    __syncthreads();
                    { const int j = tid & 63, ti = tid >> 6; float s0 = b1[j], s1 = s0;
_Pragma("unroll 3")
                      for (int i = 0; i < 33; ++i) { const float wv = w1[i * 64 + j]; s0 += feats[ti * 33 + i] * wv; s1 += feats[(ti + 8) * 33 + i] * wv; }
                      const float f1 = fr1[j]; h1[ti * 64 + j] = sinf(f1 * s0); h1[(ti + 8) * 64 + j] = sinf(f1 * s1); }
                    __syncthreads();
                    { const int j = tid & 63, ti = tid >> 6; float s0 = b2[j], s1 = s0;
_Pragma("unroll 4")
                      for (int i = 0; i < 64; ++i) { const float wv = w2[i * 64 + j]; s0 += h1[ti * 64 + i] * wv; s1 += h1[(ti + 8) * 64 + i] * wv; }
                      const float f2 = fr2[j]; h2[ti * 64 + j] = sinf(f2 * s0); h2[(ti + 8) * 64 + j] = sinf(f2 * s1); }
                    __syncthreads();
                    float acc[16][4];
#pragma unroll
                    for (int ti = 0; ti < 16; ++ti) { acc[ti][0] = 0.f; acc[ti][1] = 0.f; acc[ti][2] = 0.f; acc[ti][3] = 0.f; }
#pragma unroll 2
                    for (int i = 0; i < 64; ++i) { const float* wrow = w3 + (size_t)i * 2048 + tid; const float wa = wrow[0], wb = wrow[512], wc2 = wrow[1024], wd2 = wrow[1536];
#pragma unroll
                        for (int ti = 0; ti < 16; ++ti) { const float hv = h2[ti * 64 + i]; acc[ti][0] += hv * wa; acc[ti][1] += hv * wb; acc[ti][2] += hv * wc2; acc[ti][3] += hv * wd2; } }
                    float dk[4];
#pragma unroll
                    for (int k = 0; k < 4; ++k) dk[k] = fabsf(decay[tid + k * 512]);
#pragma unroll
                    for (int ti = 0; ti < 16; ++ti) { const int t = base + ti * G; if (t < L) { const float tn = (float)t / (float)(L - 1);
#pragma unroll
                        for (int k = 0; k < 4; ++k) { const float v = acc[ti][k] * expf(-tn * dk[k]); HR[(size_t)t * 2048 + tid + k * 512] = v; nacc[k] += fabsf(v); } } }
                }
                float* nrp = NORMP + ((size_t)(l * 2 + set) * 256 + bid) * 2048;
#pragma unroll
                for (int k = 0; k < 4; ++k) nrp[tid + k * 512] = nacc[k];
            }
            for (int idx = bid * NTHR + tid; idx < 4096; idx += G * NTHR) { const int n = idx & 63, g = (idx >> 6) & 31, dir = idx >> 11;
                const double are = (double)(PT(24) + l * 4096)[idx], aim = (double)(PT(25) + l * 4096)[idx]; const double lam = are < -1e-4 ? are : -1e-4; const double dt = exp((double)(PT(26) + l * 64)[dir * 32 + g]);
                const double ldre = lam * dt, ldim = aim * dt; LDT[idx] = make_double2(ldre, ldim);
                const double mag = exp(ldre); const double ar = mag * cos(ldim), ai = mag * sin(ldim);
                const double den = lam * lam + aim * aim; const double nr = ar - 1.0, ni = ai; const double fre = (nr * lam + ni * aim) / den, fim = (ni * lam - nr * aim) / den;
                const float* b_re = PT(27) + l * 32 * 64 * 16; const float* b_im = PT(28) + l * 32 * 64 * 16;
#pragma unroll 4
                for (int c = 0; c < 16; ++c) { const double br = (double)b_re[(g * 64 + n) * 16 + c], bi = (double)b_im[(g * 64 + n) * 16 + c]; BBT[idx * 16 + c] = make_float2((float)(fre * br - fim * bi), (float)(fre * bi + fim * br)); }
#pragma unroll 1
                for (int k = 0; k <= 32; ++k) { const double mk = exp(ldre * k); APW[idx * 33 + k] = make_float2((float)(mk * cos(ldim * k)), (float)(mk * sin(ldim * k))); }
            }
            for (int tok = bid * 8 + wave; tok < NTOK; tok += G * 8) {
                const int r = tok < NLAT ? tok / SEQ : 4; const float* xr = XS + (size_t)tok * DM; const float* gn = norm_mix + l * DM;
                const float* sh = MODl + (size_t)(r * 6 + 0) * DM; const float* sc = MODl + (size_t)(r * 6 + 1) * DM;
                float4 v[8]; float ss = 0.f;
#pragma unroll
                for (int i = 0; i < 8; ++i) { v[i] = *(const float4*)(xr + i * 256 + lane * 4);
                    if (l > 0) { const int4 mi = *(const int4*)(MOEI + (size_t)tok * DM + i * 256 + lane * 4);
                        v[i].x += (float)mi.x * (1.0f / 1048576.0f); v[i].y += (float)mi.y * (1.0f / 1048576.0f); v[i].z += (float)mi.z * (1.0f / 1048576.0f); v[i].w += (float)mi.w * (1.0f / 1048576.0f);
                        *(float4*)(XS + (size_t)tok * DM + i * 256 + lane * 4) = v[i]; }
                    ss += v[i].x * v[i].x + v[i].y * v[i].y + v[i].z * v[i].z + v[i].w * v[i].w; }
                ss = wave_sum(ss); const float rs = rsqrtf(ss * (1.0f / DM) + 1e-6f);
#pragma unroll
                for (int i = 0; i < 8; ++i) { const int d = i * 256 + lane * 4; const float4 g4 = *(const float4*)(gn + d), s4 = *(const float4*)(sc + d), h4 = *(const float4*)(sh + d);
                    u32x2 w; w.x = pk2(v[i].x * rs * g4.x * (1.f + s4.x) + h4.x, v[i].y * rs * g4.y * (1.f + s4.y) + h4.y); w.y = pk2(v[i].z * rs * g4.z * (1.f + s4.z) + h4.z, v[i].w * rs * g4.w * (1.f + s4.w) + h4.w);
                    *(u32x2*)(HB + (size_t)tok * DM + d) = w; }
            }
            SEAM(PB + 0);
        }

        if (IN(PB + 1)) for (int rep_ = 0; rep_ < PROBE_REPS(1); ++rep_) {
            PH_BEGIN
            for (int idx = bid * NTHR + tid; idx < (lastl ? 1 : 2) * 1024; idx += G * NTHR) { const int set = idx >> 10, oc = idx & 1023, o = oc >> 9, c = oc & 511;
                const float* pp = NORMP + (size_t)(l * 2 + set) * 256 * 2048 + o * 1024 + c; float sacc = 0.f;
                for (int bb = 0; bb < G; ++bb) sacc += pp[(size_t)bb * 2048] + pp[(size_t)bb * 2048 + 512];
                NORM[(size_t)(l * 2 + set) * 1024 + oc] = sacc; }
            for (int idx = bid * NTHR + tid; idx < 32768; idx += G * NTHR) { const int c = idx & 15, lag = (idx >> 4) & 31, dir = (idx >> 9) & 1, g = idx >> 10;
                const float* c_re = PT(29) + l * 32 * 16 * 64 + (g * 16 + c) * 64; const float* c_im = PT(30) + l * 32 * 16 * 64 + (g * 16 + c) * 64;
                float acc[16];
#pragma unroll
                for (int j = 0; j < 16; ++j) acc[j] = 0.f;
#pragma unroll 2
                for (int n = 0; n < 64; ++n) { const int pi = (dir * 32 + g) * 64 + n; const float2 ap = APW[pi * 33 + lag]; const float cr = c_re[n], ci = c_im[n]; const float wr_ = cr * ap.x - ci * ap.y, wi_ = cr * ap.y + ci * ap.x;
                    const float4* bb = (const float4*)(BBT + pi * 16);
#pragma unroll
                    for (int j = 0; j < 8; ++j) { const float4 b2 = bb[j]; acc[2 * j] += wr_ * b2.x - wi_ * b2.y; acc[2 * j + 1] += wr_ * b2.z - wi_ * b2.w; } }
                float4* o = (float4*)(KTB + (size_t)idx * 16);
                o[0] = make_float4(acc[0], acc[1], acc[2], acc[3]); o[1] = make_float4(acc[4], acc[5], acc[6], acc[7]); o[2] = make_float4(acc[8], acc[9], acc[10], acc[11]); o[3] = make_float4(acc[12], acc[13], acc[14], acc[15]);
            }
            __syncthreads();
            pg8::Gemm g{HB, WIN, DM, DM, DM}; pg8::SchedStd S{68, 55, G, bid, DM, DM}; pg8::EpiWin E{P, LDP};
            pg8::gemm_phase(( LAS unsigned char*)shm, g, S, E);
            SEAM(PB + 1);
        }

        if (IN(PB + 2)) for (int rep_ = 0; rep_ < PROBE_REPS(2); ++rep_) {
            PH_BEGIN
            const float* hcw = PT(9) + l * 3 * 1536; const float* hcb = PT(10) + l * 1536; const float* mcw = PT(20) + l * 3 * 1024; const float* mcb = PT(21) + l * 1024;
            const float* scw = PT(34) + l * 3 * 1024; const float* scb = PT(35) + l * 1024;
            for (int unit = bid; unit < 272 * 2; unit += G) { const int seg = unit >> 1, hf = unit & 1; const bool lat = seg < 256; const size_t tok0 = lat ? (size_t)seg * 64 : (size_t)NLAT + (size_t)(seg - 256) * 64;
                const int c = tid * 2; const int col = (hf ? SSD_OFF + 512 : ML_OFF) + c; const float* w = hf ? scw : mcw; const float* bsp = hf ? scb : mcb; bf16_t* dst = (hf ? XBC : QKB) + tok0 * 1024 + c;
                const float2 w0 = *(const float2*)(w + c), w1 = *(const float2*)(w + 1024 + c), w2 = *(const float2*)(w + 2048 + c), bb = *(const float2*)(bsp + c);
                const float osc = (!hf && c >= 512) ? 0.08838834764831845f : 1.0f;
                const bool hasPrev = !lat && ((tok0 - NLAT) & (CTXL - 1)) != 0, hasNext = !lat && (((tok0 - NLAT) + 63) & (CTXL - 1)) != CTXL - 1;
                const bf16_t* pp = P + tok0 * LDP + col;
                unsigned raw[66];
#pragma unroll
                for (int t = 0; t < 66; ++t) raw[t] = ((t == 0 && !hasPrev) || (t == 65 && !hasNext)) ? 0u : *(const unsigned*)(pp + (ptrdiff_t)(t - 1) * LDP);
#pragma unroll
                for (int t = 0; t < 64; ++t) { const unsigned p0 = raw[t], p1 = raw[t + 1], p2 = raw[t + 2];
                    float a0 = bb.x + w0.x * __uint_as_float(p0 << 16) + w1.x * __uint_as_float(p1 << 16) + w2.x * __uint_as_float(p2 << 16);
                    float a1 = bb.y + w0.y * __uint_as_float(p0 & 0xFFFF0000u) + w1.y * __uint_as_float(p1 & 0xFFFF0000u) + w2.y * __uint_as_float(p2 & 0xFFFF0000u);
                    a0 = siluf_(a0) * osc; a1 = siluf_(a1) * osc;
                    *(unsigned*)(dst + (size_t)t * 1024) = pk2(a0, a1); }
            }
            if (!lastl) for (int tok = NLAT + bid; tok < NTOK; tok += G) {
                const int t = (tok - NLAT) & (CTXL - 1); const bool hasL = (t != 0), hasR = (t != CTXL - 1); const bf16_t* pr = P + (size_t)tok * LDP;
#pragma unroll
                for (int j = 0; j < 3; ++j) { const int cc = tid + j * 512;
                    float acc = hcb[cc] + hcw[1536 + cc] * bf2f(pr[HY_OFF + cc]);
                    if (hasL) acc += hcw[cc] * bf2f(pr[HY_OFF + cc - LDP]);
                    if (hasR) acc += hcw[2 * 1536 + cc] * bf2f(pr[HY_OFF + cc + LDP]);
                    U[(size_t)tok * 1536 + cc] = acc; }
            }
            for (int idx = bid * NTHR + tid; idx < 16384 * 64; idx += G * NTHR) { const int half = idx & 1, g = (idx >> 1) & 31, tok = idx >> 6;
                *(u32x4*)(S5A + ((size_t)g * 512 + (tok >> 5)) * 768 + (tok & 31) * 16 + half * 8) = *(const u32x4*)(P + (size_t)tok * LDP + S5_OFF + g * 16 + half * 8); }
            for (int idx = bid * NTHR + tid; idx < 32 * 512 * 32 * 2; idx += G * NTHR) { const int half = idx & 1, sI = (idx >> 1) & 31, row = (idx >> 6) & 511, g = idx >> 15; const int t = row >> 4, c = row & 15; const int lag = t - sI;
                float v[8];
                if (lag > 0) { const float4* k4 = (const float4*)(KTB + ((size_t)((g * 2 + 0) * 32 + lag) * 16 + c) * 16 + half * 8); const float4 a0 = k4[0], a1 = k4[1]; v[0] = a0.x; v[1] = a0.y; v[2] = a0.z; v[3] = a0.w; v[4] = a1.x; v[5] = a1.y; v[6] = a1.z; v[7] = a1.w; }
                else if (lag < 0) { const float4* k4 = (const float4*)(KTB + ((size_t)((g * 2 + 1) * 32 - lag) * 16 + c) * 16 + half * 8); const float4 a0 = k4[0], a1 = k4[1]; v[0] = a0.x; v[1] = a0.y; v[2] = a0.z; v[3] = a0.w; v[4] = a1.x; v[5] = a1.y; v[6] = a1.z; v[7] = a1.w; }
                else { const float4* k4 = (const float4*)(KTB + ((size_t)((g * 2 + 0) * 32) * 16 + c) * 16 + half * 8); const float4* q4 = (const float4*)(KTB + ((size_t)((g * 2 + 1) * 32) * 16 + c) * 16 + half * 8); const float4 a0 = k4[0], a1 = k4[1], b0 = q4[0], b1 = q4[1];
                    v[0] = a0.x + b0.x; v[1] = a0.y + b0.y; v[2] = a0.z + b0.z; v[3] = a0.w + b0.w; v[4] = a1.x + b1.x; v[5] = a1.y + b1.y; v[6] = a1.z + b1.z; v[7] = a1.w + b1.w; }
                u32x4 w; w.x = pk2(v[0], v[1]); w.y = pk2(v[2], v[3]); w.z = pk2(v[4], v[5]); w.w = pk2(v[6], v[7]);
                *(u32x4*)(S5B + ((size_t)g * 512 + row) * 768 + sI * 16 + half * 8) = w; }
            for (int idx = bid * NTHR + tid; idx < 32 * 512 * 64; idx += G * NTHR) { const int n = idx & 63, row = (idx >> 6) & 511, g = idx >> 15; const int t = row >> 4, c = row & 15;
                const float cr = (PT(29) + l * 32 * 16 * 64)[(g * 16 + c) * 64 + n], ci = (PT(30) + l * 32 * 16 * 64)[(g * 16 + c) * 64 + n];
                const float2 af = APW[((0 * 32 + g) * 64 + n) * 33 + t + 1], ab = APW[((1 * 32 + g) * 64 + n) * 33 + 32 - t];
                bf16_t* d = S5B + ((size_t)g * 512 + row) * 768 + 512 + 2 * n;
                *(unsigned*)d = pk2(cr * af.x - ci * af.y, -(cr * af.y + ci * af.x)); *(unsigned*)(d + 128) = pk2(cr * ab.x - ci * ab.y, -(cr * ab.y + ci * ab.x)); }
            for (int idx = bid * NTHR + tid; idx < 32 * 2 * 64 * 32; idx += G * NTHR) { const int sI = idx & 31, n = (idx >> 5) & 63, dir = (idx >> 11) & 1, g = idx >> 12; const int pi = (dir * 32 + g) * 64 + n;
                const float2 pw = APW[pi * 33 + (dir ? sI : 31 - sI)]; const float4* bb = (const float4*)(BBT + pi * 16);
                float re[16], im[16];
#pragma unroll
                for (int j = 0; j < 8; ++j) { const float4 b2 = bb[j]; re[2 * j] = pw.x * b2.x - pw.y * b2.y; im[2 * j] = pw.x * b2.y + pw.y * b2.x; re[2 * j + 1] = pw.x * b2.z - pw.y * b2.w; im[2 * j + 1] = pw.x * b2.w + pw.y * b2.z; }
                bf16_t* d = S5P + ((size_t)g * 256 + dir * 128 + 2 * n) * 512 + sI * 16;
                u32x4 w0, w1; w0.x = pk2(re[0], re[1]); w0.y = pk2(re[2], re[3]); w0.z = pk2(re[4], re[5]); w0.w = pk2(re[6], re[7]); w1.x = pk2(re[8], re[9]); w1.y = pk2(re[10], re[11]); w1.z = pk2(re[12], re[13]); w1.w = pk2(re[14], re[15]);
                *(u32x4*)d = w0; *(u32x4*)(d + 8) = w1;
                w0.x = pk2(im[0], im[1]); w0.y = pk2(im[2], im[3]); w0.z = pk2(im[4], im[5]); w0.w = pk2(im[6], im[7]); w1.x = pk2(im[8], im[9]); w1.y = pk2(im[10], im[11]); w1.z = pk2(im[12], im[13]); w1.w = pk2(im[14], im[15]);
                *(u32x4*)(d + 512) = w0; *(u32x4*)(d + 520) = w1; }
            {   float* T = sf;
                for (int unit = bid; unit < 4 * 64 * 24; unit += G) { const int b = unit / (64 * 24), r = (unit / 24) % 64, c0 = (unit % 24) * 64; const size_t tok0 = (size_t)b * SEQ + r * 64;
                    __syncthreads();
#pragma unroll
                    for (int i = 0; i < 8; ++i) { const int c = tid & 63, t = (tid >> 6) + 8 * i; T[t * 65 + c] = bf2f(P[(tok0 + t) * LDP + HY_OFF + c0 + c]); }
                    __syncthreads();
                    const int c = tid >> 3, tq = (tid & 7) * 8, cc = c0 + c; const float w0 = hcw[cc], w1 = hcw[1536 + cc], w2 = hcw[3072 + cc], bb = hcb[cc];
                    float o8[8];
#pragma unroll
                    for (int i = 0; i < 8; ++i) { const int t = tq + i; float acc = bb + w1 * T[t * 65 + c]; if (t > 0) acc += w0 * T[(t - 1) * 65 + c]; if (t < 63) acc += w2 * T[(t + 1) * 65 + c]; o8[i] = acc; }
                    float* dst = UT + ((size_t)b * 1536 + cc) * SEQ + r * 64 + tq;
                    *(float4*)dst = make_float4(o8[0], o8[1], o8[2], o8[3]); *(float4*)(dst + 4) = make_float4(o8[4], o8[5], o8[6], o8[7]);
                } }
            if (!lastl) {
                const int L = CTXL; const float* HR = HRAW + (size_t)SEQ * 2048; float* K2 = K2C; const float* nrm = NORM + (size_t)(l * 2 + 1) * 1024;
                const size_t total = (size_t)(2 * L - 1) * 1024;
                for (size_t i = (size_t)bid * NTHR + tid; i < total; i += (size_t)G * NTHR) { const int j = (int)(i >> 10), oc = (int)(i & 1023), o = oc >> 9, c = oc & 511; const int lag = j - (L - 1);
                    const float v = lag >= 0 ? HR[(size_t)lag * 2048 + o * 1024 + c] : HR[(size_t)(-lag) * 2048 + o * 1024 + 512 + c];
                    K2[((size_t)j * 2 + o) * 512 + c] = v / nrm[oc]; }
            }
            {   __syncthreads(); fft_twiddles((float2*)(shm + FFT_X_BYTES), tid);
                for (int oc = bid; oc < 1024; oc += G) hyena_spec_item(oc, HRAW, NORM + (size_t)(l * 2 + 0) * 1024, HSPEC, shm, tid);
                __syncthreads(); }
            SEAM(PB + 2);
        }

        if (IN(PB + 3)) for (int rep_ = 0; rep_ < PROBE_REPS(3); ++rep_) {
            PH_BEGIN
            if (bid < 32) {
                mlstm_state_pass(bid, P, QKB, PT(22) + l * 16, CST, NST, MST, shm, tid);
            } else if (bid < 96) {
                { const int ch = bid - 32; const int dir_ = ch & 1, h_ = (ch >> 1) & 7; ssd_state_pass(ch, P, XBC, -expf(PT(37)[l * 16 + dir_ * 8 + h_]), PT(36)[l * 16 + dir_ * 8 + h_], SSTB, shm, tid); }
            } else if (bid < 128) {
                const int widx = (bid - 96) * 8 + wave; const int dir = widx & 1, g = (widx >> 1) & 31, b = widx >> 6; const int n = lane;
                float2* xb = (float2*)(shm + (size_t)wave * 16640); float2* ctab = xb + 16 * 65;
                const float* a_re = PT(24) + l * 2 * 32 * 64; const float* a_im = PT(25) + l * 2 * 32 * 64; const float* log_dt = PT(26) + l * 64;
                const float* b_re = PT(27) + l * 32 * 64 * 16; const float* b_im = PT(28) + l * 32 * 64 * 16; const float* c_re = PT(29) + l * 32 * 16 * 64; const float* c_im = PT(30) + l * 32 * 16 * 64;
#pragma unroll
                for (int c = 0; c < 16; ++c) ctab[c * 65 + lane] = make_float2(c_re[(g * 16 + c) * 64 + lane], c_im[(g * 16 + c) * 64 + lane]);
                float abr, abi, bbr[16], bbi[16];
                {   const double are = (double)a_re[(dir * 32 + g) * 64 + n], aim = (double)a_im[(dir * 32 + g) * 64 + n];
                    const double lam = are < -1e-4 ? are : -1e-4; const double dt = exp((double)log_dt[dir * 32 + g]);
                    const double mag = exp(lam * dt); const double ar = mag * cos(aim * dt), ai = mag * sin(aim * dt);
                    const double den = lam * lam + aim * aim; const double nr = ar - 1.0, ni = ai;
                    const double fre = (nr * lam + ni * aim) / den, fim = (ni * lam - nr * aim) / den;
                    abr = (float)ar; abi = (float)ai;
#pragma unroll
                    for (int c = 0; c < 16; ++c) { const double br = (double)b_re[(g * 64 + n) * 16 + c], bi = (double)b_im[(g * 64 + n) * 16 + c]; bbr[c] = (float)(fre * br - fim * bi); bbi[c] = (float)(fre * bi + fim * br); }
                }
                float xr = 0.f, xi = 0.f; float* Sout = (dir ? SB : SF) - (size_t)NLAT * BW;
                const int s = lane >> 2, cg = lane & 3;
                for (int i0 = 0; i0 < CTXL; i0 += 16) {
#pragma unroll 4
                    for (int ss = 0; ss < 16; ++ss) {
                        const size_t tok = (size_t)step_tok(b, dir, i0 + ss);
                        const u32x4* up = (const u32x4*)(P + tok * LDP + S5_OFF + g * 16);
                        float t0[8], t1[8]; unpack8(up[0], t0); unpack8(up[1], t1);
                        float bur = 0.f, bui = 0.f;
#pragma unroll
                        for (int c = 0; c < 8; ++c) { bur += t0[c] * bbr[c] + t1[c] * bbr[8 + c]; bui += t0[c] * bbi[c] + t1[c] * bbi[8 + c]; }
                        const float nxr = abr * xr - abi * xi + bur, nxi = abr * xi + abi * xr + bui; xr = nxr; xi = nxi;
                        xb[ss * 65 + lane] = make_float2(xr, xi);
                    }
                    asm volatile("s_waitcnt lgkmcnt(0)" ::: "memory");
                    float y0 = 0.f, y1 = 0.f, y2 = 0.f, y3 = 0.f;
                    for (int nn2 = 0; nn2 < 64; ++nn2) { const float2 xv = xb[s * 65 + nn2];
                        const float2 c0 = ctab[(cg * 4 + 0) * 65 + nn2], c1 = ctab[(cg * 4 + 1) * 65 + nn2], c2 = ctab[(cg * 4 + 2) * 65 + nn2], c3 = ctab[(cg * 4 + 3) * 65 + nn2];
                        y0 += xv.x * c0.x - xv.y * c0.y; y1 += xv.x * c1.x - xv.y * c1.y; y2 += xv.x * c2.x - xv.y * c2.y; y3 += xv.x * c3.x - xv.y * c3.y; }
                    const size_t toks = (size_t)step_tok(b, dir, i0 + s);
                    *(float4*)(Sout + toks * BW + g * 16 + cg * 4) = make_float4(y0, y1, y2, y3);
                    asm volatile("s_waitcnt lgkmcnt(0)" ::: "memory");
                }
                XCTX[((b * 32 + g) * 2 + dir) * 64 + n] = make_float2(xr, xi);
            } else {
                if (bid < 192) {
                    pg8::Gemm gg_{S5A, S5P, 768, 512, 512}; pg8::SchedS5a S_{bid - 128}; pg8::EpiXloc E_{XLOC};
                    pg8::gemm_phase((LAS unsigned char*)shm, gg_, S_, E_);
                    __syncthreads();
                }
                const int nhb = G - 128, hb = bid - 128; const float* bias = PT(19) + l * 1024; const int c = tid;
                const int nitems = lastl ? 0 : 4 * (CTXL / 8);
                for (int it = hb; it < nitems; it += nhb) {
                    int L, tokbase, b, t0; const float* K2;
                    { const int q = it; L = CTXL; tokbase = NLAT; b = q / (CTXL / 8); t0 = (q % (CTXL / 8)) * 8; K2 = K2C; }
                    const float* zb = U + (size_t)(tokbase + b * L) * 1536 + c;
                    float acc[8];
#pragma unroll
                    for (int i = 0; i < 8; ++i) acc[i] = 0.f;
                    const int base = t0 + L - 1;
                    for (int s = 0; s < L; s += 8) {
                        float k[15];
#pragma unroll
                        for (int mm = 0; mm < 15; ++mm) k[mm] = K2[((size_t)(base - s - 7 + mm) * 2 + 0) * 512 + c];
#pragma unroll
                        for (int ds = 0; ds < 8; ++ds) { const float z = zb[(size_t)(s + ds) * 1536];
#pragma unroll
                            for (int i = 0; i < 8; ++i) acc[i] += k[i - ds + 7] * z; }
                    }
#pragma unroll
                    for (int i = 0; i < 8; ++i) { const size_t tok = (size_t)(tokbase + b * L + t0 + i); const float zt = U[tok * 1536 + c]; Z[tok * BW + c] = (acc[i] + bias[c] * zt) * U[tok * 1536 + 512 + c]; }
                }
            }
            {   __syncthreads(); fft_twiddles((float2*)(shm + FFT_X_BYTES), tid);
                int* qslot = (int*)(shm + FFT_X_BYTES + 32768);
                for (;;) { __syncthreads(); if (tid == 0) *qslot = atomicAdd(QCTR + l * 64, 1); __syncthreads(); const int it = *qslot; if (it >= 1024) break;
                    hyena_fft_item(it, UT, HSPEC, PT(19) + l * 1024, YT, shm, tid); }
            }
            SEAM(PB + 3);
        }

        if (IN(PB + 4)) for (int rep_ = 0; rep_ < PROBE_REPS(4); ++rep_) {
            PH_BEGIN
            if (bid >= G - 32) for (int idx = (bid - (G - 32)) * NTHR + tid; idx < 16384; idx += 32 * NTHR) { const int n = idx & 63, dir = (idx >> 6) & 1, b = (idx >> 7) & 3, g = idx >> 9;
                const float2 a32 = APW[((dir * 32 + g) * 64 + n) * 33 + 32]; float2 X = XCTX[((b * 32 + g) * 2 + dir) * 64 + n];
                const float* __restrict__ xl = XLOC + ((size_t)g * 512 + b * 128) * 256 + dir * 128 + 2 * n; bf16_t* __restrict__ dst = S5A + ((size_t)g * 512 + b * 128) * 768 + 512 + dir * 128 + 2 * n;
#pragma unroll 8
                for (int jj = 0; jj < 128; ++jj) { const int j = dir ? 127 - jj : jj; const float2 xv = *(const float2*)(xl + (size_t)j * 256);
                    *(unsigned*)(dst + (size_t)j * 768) = pk2(X.x, X.y);
                    const float nx = a32.x * X.x - a32.y * X.y + xv.x, ny = a32.x * X.y + a32.y * X.x + xv.y; X.x = nx; X.y = ny; } }
            {   int* qslot = (int*)(shm + 102400);
                for (;;) { __syncthreads(); if (tid == 0) *qslot = atomicAdd(QCTR + l * 64 + 32, 1); __syncthreads(); const int it = *qslot; if (it >= 32 * 68 + 64 * 68) break;
                    if (it < 32 * 68) { const int chain = it / 68, c = it % 68; mlstm_out_item(chain, c, P, QKB, PT(22) + l * 16, CST, NST, MST, (chain & 1) ? HBk : HF, shm, tid); }
                    else { const int i2 = it - 32 * 68; const int chain = i2 / 68, c = i2 % 68; const int dir_ = chain & 1, h_ = (chain >> 1) & 7;
                        ssd_out_item(chain, c, P, XBC, -expf(PT(37)[l * 16 + dir_ * 8 + h_]), PT(36)[l * 16 + dir_ * 8 + h_], SSTB, dir_ ? YB : YF, shm, tid); } }
            }
            __syncthreads();
            {   const float* bias = PT(19) + l * 1024 + 512; const int c = tid;
                const int nitems = lastl ? 0 : 4 * (CTXL / 8);
                for (int it = bid; it < nitems; it += G) {
                    int L, tokbase, b, t0; const float* K2;
                    { const int q = it; L = CTXL; tokbase = NLAT; b = q / (CTXL / 8); t0 = (q % (CTXL / 8)) * 8; K2 = K2C; }
                    const float* zb = Z + (size_t)(tokbase + b * L) * BW + c;
                    float acc[8];
#pragma unroll
                    for (int i = 0; i < 8; ++i) acc[i] = 0.f;
                    const int base = t0 + L - 1;
                    for (int s = 0; s < L; s += 8) {
                        float k[15];
#pragma unroll
                        for (int mm = 0; mm < 15; ++mm) k[mm] = K2[((size_t)(base - s - 7 + mm) * 2 + 1) * 512 + c];
#pragma unroll
                        for (int ds = 0; ds < 8; ++ds) { const float z = zb[(size_t)(s + ds) * BW];
#pragma unroll
                            for (int i = 0; i < 8; ++i) acc[i] += k[i - ds + 7] * z; }
                    }
#pragma unroll
                    for (int i = 0; i < 8; ++i) { const size_t tok = (size_t)(tokbase + b * L + t0 + i); const float zt = Z[tok * BW + c]; Y4[tok * DM + c] = f2bf((acc[i] + bias[c] * zt) * U[tok * 1536 + 1024 + c]); }
                }
            }
            SEAM(PB + 4);
        }

        if (IN(PB + 5)) for (int rep_ = 0; rep_ < PROBE_REPS(5); ++rep_) {
            PH_BEGIN
            const float* ml_norm = PT(23) + l * BW; const float* ssd_d = PT(38) + l * 8; const float* ssd_norm = PT(39) + l * BW; const float* s5_d = PT(31) + l * BW;
            if (bid < 128) {
                pg8::Gemm gg_{S5A, S5B, 768, 768, 768}; pg8::SchedS5b S_{bid}; pg8::EpiS5Out E_{P, s5_d, GG};
                pg8::gemm_phase((LAS unsigned char*)shm, gg_, S_, E_);
                __syncthreads();
            }
            for (int tok = bid * 8 + wave; tok < NTOK; tok += G * 8) {
                const int c0 = lane * 8; const bf16_t* pr = P + (size_t)tok * LDP; const size_t o5 = (size_t)tok * BW + c0;
                float hm[8], ys[8];
                { const float4 a0 = *(const float4*)(HF + o5), a1 = *(const float4*)(HF + o5 + 4), b0 = *(const float4*)(HBk + o5), b1 = *(const float4*)(HBk + o5 + 4);
                  hm[0] = a0.x + b0.x; hm[1] = a0.y + b0.y; hm[2] = a0.z + b0.z; hm[3] = a0.w + b0.w; hm[4] = a1.x + b1.x; hm[5] = a1.y + b1.y; hm[6] = a1.z + b1.z; hm[7] = a1.w + b1.w; }
                { const float4 a0 = *(const float4*)(YF + o5), a1 = *(const float4*)(YF + o5 + 4), b0 = *(const float4*)(YB + o5), b1 = *(const float4*)(YB + o5 + 4);
                  float xx[8], zz[8]; unpack8(*(const u32x4*)(XBC + (size_t)tok * 1024 + c0), xx); unpack8(*(const u32x4*)(pr + SSD_OFF + c0), zz); const float dsk = ssd_d[c0 >> 6];
                  ys[0] = a0.x + b0.x; ys[1] = a0.y + b0.y; ys[2] = a0.z + b0.z; ys[3] = a0.w + b0.w; ys[4] = a1.x + b1.x; ys[5] = a1.y + b1.y; ys[6] = a1.z + b1.z; ys[7] = a1.w + b1.w;
#pragma unroll
                  for (int j = 0; j < 8; ++j) ys[j] = (ys[j] + dsk * xx[j]) * siluf_(zz[j]); }
                float s1 = 0.f, s2 = 0.f;
#pragma unroll
                for (int j = 0; j < 8; ++j) { s1 += hm[j] * hm[j]; s2 += ys[j] * ys[j]; }
                s1 += __shfl_xor(s1, 1); s1 += __shfl_xor(s1, 2); s1 += __shfl_xor(s1, 4); s1 += __shfl_xor(s1, 8);
                s2 = wave_sum(s2);
                const float r1 = rsqrtf(s1 * (1.0f / 128.0f) + 1e-6f), r2 = rsqrtf(s2 * (1.0f / BW) + 1e-6f);
                float oo[8]; unpack8(*(const u32x4*)(pr + ML_OFF + 1536 + c0), oo);
                const float4 g0 = *(const float4*)(ml_norm + c0), g1 = *(const float4*)(ml_norm + c0 + 4), n0 = *(const float4*)(ssd_norm + c0), n1 = *(const float4*)(ssd_norm + c0 + 4);
                const float gm[8] = {g0.x, g0.y, g0.z, g0.w, g1.x, g1.y, g1.z, g1.w}, gs[8] = {n0.x, n0.y, n0.z, n0.w, n1.x, n1.y, n1.z, n1.w};
                u32x4 w;
                w.x = pk2(hm[0] * r1 * gm[0] * sigmoidf_(oo[0]), hm[1] * r1 * gm[1] * sigmoidf_(oo[1])); w.y = pk2(hm[2] * r1 * gm[2] * sigmoidf_(oo[2]), hm[3] * r1 * gm[3] * sigmoidf_(oo[3]));
                w.z = pk2(hm[4] * r1 * gm[4] * sigmoidf_(oo[4]), hm[5] * r1 * gm[5] * sigmoidf_(oo[5])); w.w = pk2(hm[6] * r1 * gm[6] * sigmoidf_(oo[6]), hm[7] * r1 * gm[7] * sigmoidf_(oo[7]));
                *(u32x4*)(Y4 + (size_t)tok * DM + 512 + c0) = w;
                w.x = pk2(ys[0] * r2 * gs[0], ys[1] * r2 * gs[1]); w.y = pk2(ys[2] * r2 * gs[2], ys[3] * r2 * gs[3]); w.z = pk2(ys[4] * r2 * gs[4], ys[5] * r2 * gs[5]); w.w = pk2(ys[6] * r2 * gs[6], ys[7] * r2 * gs[7]);
                *(u32x4*)(Y4 + (size_t)tok * DM + 1536 + c0) = w;
                if (tok >= NLAT) { const size_t oc = (size_t)(tok - NLAT) * BW + c0; float uu[8]; unpack8(*(const u32x4*)(pr + S5_OFF + c0), uu);
                    const float4 a0 = *(const float4*)(SF + oc), a1 = *(const float4*)(SF + oc + 4), b0 = *(const float4*)(SB + oc), b1 = *(const float4*)(SB + oc + 4), d0 = *(const float4*)(s5_d + c0), d1 = *(const float4*)(s5_d + c0 + 4);
                    float y[8] = {a0.x + b0.x + d0.x * uu[0], a0.y + b0.y + d0.y * uu[1], a0.z + b0.z + d0.z * uu[2], a0.w + b0.w + d0.w * uu[3], a1.x + b1.x + d1.x * uu[4], a1.y + b1.y + d1.y * uu[5], a1.z + b1.z + d1.z * uu[6], a1.w + b1.w + d1.w * uu[7]};
#pragma unroll
                    for (int j = 0; j < 8; ++j) y[j] = 0.5f * y[j] * (1.0f + tanhf(0.7978845608028654f * (y[j] + 0.044715f * y[j] * y[j] * y[j])));
                    w.x = pk2(y[0], y[1]); w.y = pk2(y[2], y[3]); w.z = pk2(y[4], y[5]); w.w = pk2(y[6], y[7]);
                    *(u32x4*)(GG + (size_t)tok * BW + c0) = w; }
            }
            __syncthreads();
            {   float* T = sf;
                for (int unit = (G > 128 ? bid - 128 : bid); unit >= 0 && unit < 4 * 64 * 8; unit += (G > 128 ? G - 128 : G)) { const int b = unit / 512, t0 = ((unit >> 3) & 63) * 64, c0 = (unit & 7) * 64;
                    __syncthreads();
#pragma unroll
                    for (int i = 0; i < 8; ++i) { const int t = tid & 63, c = (tid >> 6) + 8 * i; T[c * 65 + t] = YT[((size_t)b * 512 + c0 + c) * SEQ + t0 + t]; }
                    __syncthreads();
                    const int t = tid >> 3, cq = (tid & 7) * 8;
                    u32x4 w; w.x = pk2(T[(cq + 0) * 65 + t], T[(cq + 1) * 65 + t]); w.y = pk2(T[(cq + 2) * 65 + t], T[(cq + 3) * 65 + t]); w.z = pk2(T[(cq + 4) * 65 + t], T[(cq + 5) * 65 + t]); w.w = pk2(T[(cq + 6) * 65 + t], T[(cq + 7) * 65 + t]);
                    *(u32x4*)(Y4 + ((size_t)b * SEQ + t0 + t) * DM + c0 + cq) = w;
                } }
            SEAM(PB + 5);
        }

        if (IN(PB + 6)) for (int rep_ = 0; rep_ < PROBE_REPS(6); ++rep_) {
            PH_BEGIN
            pg8::Gemm g{GG, GLU, BW, BW, BW}; pg8::SchedStd S{68, 2, G, bid, BW, BW}; pg8::EpiGlu E{GG, PT(33) + l * BW, Y4};
            pg8::gemm_phase((LAS unsigned char*)shm, g, S, E);
            SEAM(PB + 6);
        }
        if (IN(PB + 7)) for (int rep_ = 0; rep_ < PROBE_REPS(7); ++rep_) {
            PH_BEGIN
            pg8::Gemm g{Y4, WBR, DM, BW, BW}; pg8::SchedBranch S{nPanels, 8, G, bid}; pg8::EpiBranch E{P, ACCb};
            pg8::gemm_phase((LAS unsigned char*)shm, g, S, E);
            SEAM(PB + 7);
        }
        if (IN(PB + 8)) for (int rep_ = 0; rep_ < PROBE_REPS(8); ++rep_) {
            PH_BEGIN
            pg8::Gemm g{ACCb, WOUT, DM, DM, DM}; pg8::SchedStd S{nPanels, 8, G, bid, DM, DM}; pg8::EpiResid E{XS, MODl, 2};
            pg8::gemm_phase((LAS unsigned char*)shm, g, S, E);
            SEAM(PB + 8);
        }
        if (IN(PB + 9)) for (int rep_ = 0; rep_ < PROBE_REPS(9); ++rep_) {
            PH_BEGIN
            for (int i = bid * NTHR + tid; i < NEXP * MOE_PAD; i += G * NTHR) ROWTOK[i] = -1;
            { u32x4* z = (u32x4*)MOEI; for (size_t i = (size_t)bid * NTHR + tid; i < (size_t)NTOK * DM / 4; i += (size_t)G * NTHR) z[i] = (u32x4){0u, 0u, 0u, 0u}; }
            const float* wr = PT(42) + (size_t)l * DM * 16; const float* gn = norm_ffn + l * DM;
            for (int tok0 = (bid * 8 + wave) * 4; tok0 < M2; tok0 += G * 32) {
                const int r = tok0 < NLAT ? tok0 / SEQ : 4; const float* xr = XS + (size_t)tok0 * DM;
                const float* sh = MODl + (size_t)(r * 6 + 3) * DM; const float* sc = MODl + (size_t)(r * 6 + 4) * DM;
                float rs[4];
#pragma unroll
                for (int tk = 0; tk < 4; ++tk) { float ss = 0.f;
#pragma unroll 4
                    for (int i = 0; i < 8; ++i) { const float4 t4 = *(const float4*)(xr + (size_t)tk * DM + i * 256 + lane * 4); ss += t4.x * t4.x + t4.y * t4.y + t4.z * t4.z + t4.w * t4.w; }
                    ss = wave_sum(ss); rs[tk] = rsqrtf(ss * (1.0f / DM) + 1e-6f); }
                float lg[4][16];
#pragma unroll
                for (int tk = 0; tk < 4; ++tk)
#pragma unroll
                    for (int e = 0; e < 16; ++e) lg[tk][e] = 0.f;
#pragma unroll 1
                for (int i = 0; i < 8; ++i) { const int d = i * 256 + lane * 4;
                    const float4 g4 = *(const float4*)(gn + d), s4 = *(const float4*)(sc + d), h4 = *(const float4*)(sh + d);
                    float hv[4][4];
#pragma unroll
                    for (int tk = 0; tk < 4; ++tk) { const float4 xv = *(const float4*)(xr + (size_t)tk * DM + d); const float rr = rs[tk];
                        hv[tk][0] = xv.x * rr * g4.x * (1.f + s4.x) + h4.x; hv[tk][1] = xv.y * rr * g4.y * (1.f + s4.y) + h4.y; hv[tk][2] = xv.z * rr * g4.z * (1.f + s4.z) + h4.z; hv[tk][3] = xv.w * rr * g4.w * (1.f + s4.w) + h4.w;
                        u32x2 w; w.x = pk2(hv[tk][0], hv[tk][1]); w.y = pk2(hv[tk][2], hv[tk][3]); *(u32x2*)(HB + (size_t)(tok0 + tk) * DM + d) = w; }
                    const float4* wq = (const float4*)(wr + (size_t)d * 16);
#pragma unroll
                    for (int q = 0; q < 4; ++q) { const float4 w0 = wq[q * 4 + 0], w1 = wq[q * 4 + 1], w2 = wq[q * 4 + 2], w3 = wq[q * 4 + 3];
#pragma unroll
                        for (int tk = 0; tk < 4; ++tk) { const float hq = hv[tk][q];
                            lg[tk][0] += hq * w0.x; lg[tk][1] += hq * w0.y; lg[tk][2] += hq * w0.z; lg[tk][3] += hq * w0.w; lg[tk][4] += hq * w1.x; lg[tk][5] += hq * w1.y; lg[tk][6] += hq * w1.z; lg[tk][7] += hq * w1.w;
                            lg[tk][8] += hq * w2.x; lg[tk][9] += hq * w2.y; lg[tk][10] += hq * w2.z; lg[tk][11] += hq * w2.w; lg[tk][12] += hq * w3.x; lg[tk][13] += hq * w3.y; lg[tk][14] += hq * w3.z; lg[tk][15] += hq * w3.w; } } }
#pragma unroll
                for (int tk = 0; tk < 4; ++tk) { float mx = -1e30f;
#pragma unroll
                    for (int e = 0; e < 16; ++e) { lg[tk][e] = wave_sum(lg[tk][e]); mx = fmaxf(mx, lg[tk][e]); }
                    float sm = 0.f;
#pragma unroll
                    for (int e = 0; e < 16; ++e) { lg[tk][e] = expf(lg[tk][e] - mx); sm += lg[tk][e]; }
                    const float inv = 1.0f / sm;
                    if (lane == 0) {
#pragma unroll
                        for (int e = 0; e < 16; e += 4) *(float4*)(PROBS + (size_t)(tok0 + tk) * 16 + e) = make_float4(lg[tk][e] * inv, lg[tk][e + 1] * inv, lg[tk][e + 2] * inv, lg[tk][e + 3] * inv); } }
            }
            SEAM(PB + 9);
        }
        if (IN(PB + 10)) for (int rep_ = 0; rep_ < PROBE_REPS(10); ++rep_) {
            PH_BEGIN
            const int nitems = 64 + (lastl ? 0 : 64);
            unsigned long long* keys = (unsigned long long*)shm;
            for (int it = bid; it < nitems; it += G) {
                const int set = it >> 6, e = it & 15, b = (it >> 4) & 3;
                const int n = set ? CTXL : SEQ, cap = set ? 32 : 512, tokbase = set ? NLAT + b * CTXL : b * SEQ;
                __syncthreads();
                for (int i = tid; i < n; i += NTHR) keys[i] = ((unsigned long long)__float_as_uint(PROBS[(size_t)(tokbase + i) * 16 + e]) << 32) | (unsigned long long)(0xFFFFFFFFu - (unsigned)i);
                __syncthreads();
                for (int k = 2; k <= n; k <<= 1)
                    for (int j = k >> 1; j > 0; j >>= 1) {
                        for (int p = tid; p < (n >> 1); p += NTHR) { const int i = ((p & ~(j - 1)) << 1) | (p & (j - 1)); const int m = i | j;
                            const unsigned long long ka = keys[i], kb = keys[m]; const bool desc = ((i & k) == 0);
                            if ((ka < kb) == desc) { keys[i] = kb; keys[m] = ka; } }
                        __syncthreads();
                    }
                for (int r = tid; r < cap; r += NTHR) { const unsigned long long kk = keys[r]; const int row = e * MOE_PAD + (set ? 2048 + b * 32 + r : b * 512 + r);
                    ROWTOK[row] = tokbase + (int)(0xFFFFFFFFu - (unsigned)(kk & 0xFFFFFFFFull)); ROWGATE[row] = __uint_as_float((unsigned)(kk >> 32)); }
                for (int r = wave; r < cap; r += 8) { const int tok = tokbase + (int)(0xFFFFFFFFu - (unsigned)(keys[r] & 0xFFFFFFFFull)); const int row = e * MOE_PAD + (set ? 2048 + b * 32 + r : b * 512 + r);
                    const u32x4* sp = (const u32x4*)(HB + (size_t)tok * DM); u32x4* dp = (u32x4*)(XG + (size_t)row * DM);
#pragma unroll
                    for (int i = 0; i < 4; ++i) dp[i * 64 + lane] = sp[i * 64 + lane]; }
            }
            {   const int pad0 = lastl ? 2048 : MOE_ROWS, npad = MOE_PAD - pad0;
                for (int R = bid * 8 + wave; R < NEXP * npad; R += G * 8) { const int e = R / npad, rr = pad0 + R % npad; u32x4* dp = (u32x4*)(XG + ((size_t)e * MOE_PAD + rr) * DM);
#pragma unroll
                    for (int i = 0; i < 4; ++i) dp[i * 64 + lane] = (u32x4){0u, 0u, 0u, 0u}; } }
            SEAM(PB + 10);
        }
        if (IN(PB + 12)) for (int rep_ = 0; rep_ < PROBE_REPS(12); ++rep_) {
            PH_BEGIN
            pg8::Gemm g{XG, WGU, DM, DM, DM}; pg8::SchedMoe S{lastl ? 8 : 9, 12, G, bid, DM, DM, 2 * DEXP}; pg8::EpiMoe1 E{HID};
            pg8::gemm_phase((LAS unsigned char*)shm, g, S, E);
            SEAM(PB + 12);
        }
        if (IN(PB + 13)) for (int rep_ = 0; rep_ < PROBE_REPS(13); ++rep_) {
            PH_BEGIN
            pg8::Gemm g{HID, WD, DEXP, DEXP, DEXP}; pg8::SchedMoe S{lastl ? 8 : 9, 8, G, bid, DEXP, DEXP, DM}; pg8::EpiMoe2 E{MOEI, MODl, ROWTOK, ROWGATE};
            pg8::gemm_phase((LAS unsigned char*)shm, g, S, E);
            SEAM(PB + 13);
        }

}

__global__ __launch_bounds__(NTHR, 2) void fwd(Args a) {
    extern __shared__ __attribute__((aligned(16))) unsigned char shm[];
    const int bid = blockIdx.x, G = gridDim.x;
    float* const sf = (float*)shm;
    volatile LAS unsigned* xbw = (volatile LAS unsigned*)((LAS unsigned char*)shm + (LDS_BYTES - 16));
    if (threadIdx.x == 0) { xbw[0] = 0u; xbw[1] = 0u; xbw[2] = 0u; xbw[3] = 0u; }
    const float** const ptab = (const float**)(shm + (LDS_BYTES - 16 - 512));
    if (threadIdx.x == 0) {
#pragma unroll
        for (int i = 0; i < 47; ++i) ptab[i] = a.in[i]; }
    __syncthreads();
    XcdBarrier bar = xcd_barrier_post((unsigned*)(a.ws + O_BAR), xbw);
    const int lo = a.ph_lo, hi = a.ph_hi;
    if (IN(0)) {
        PH_BEGIN
        { const float4* s0 = (const float4*)x_in; const float4* s1 = (const float4*)ctx_in; float4* d = (float4*)XS; const size_t n0 = (size_t)NLAT * DM / 4, n1 = (size_t)NCTX * DM / 4;
          for (size_t i = (size_t)bid * NTHR + tid; i < n0 + n1; i += (size_t)G * NTHR) d[i] = i < n0 ? s0[i] : s1[i - n0]; }
        {
            __syncthreads();
            for (int i = tid; i < 5 * DM; i += NTHR) { const int r = i >> 11, k = i & (DM - 1); const float v = r < 4 ? c_in[r * DM + k] : cctx_in[k]; sf[i] = siluf_(v); }
            __syncthreads();
            float* red = sf + 5 * DM;
            for (int unit = bid; unit < 2 * 96; unit += G) { const int l = unit / 96, j = (unit % 96) * 128 + (tid & 127), kq = tid >> 7;
                const float* w = ada_w + (size_t)l * DM * (6 * DM) + (size_t)(kq * 512) * (6 * DM) + j; const float* sv = sf + kq * 512;
                float a0 = 0.f, a1 = 0.f, a2 = 0.f, a3 = 0.f, a4 = 0.f;
#pragma unroll 8
                for (int k = 0; k < 512; ++k) { const float wv = w[(size_t)k * (6 * DM)]; a0 += sv[k] * wv; a1 += sv[DM + k] * wv; a2 += sv[2 * DM + k] * wv; a3 += sv[3 * DM + k] * wv; a4 += sv[4 * DM + k] * wv; }
                __syncthreads();
                { float* rp = red + (kq * 5) * 128 + (tid & 127); rp[0] = a0; rp[128] = a1; rp[256] = a2; rp[384] = a3; rp[512] = a4; }
                __syncthreads();
                if (tid < 128) { const float bb = ada_b[l * 6 * DM + j]; float* o = MOD + (size_t)l * 5 * 6 * DM + j;
#pragma unroll
                    for (int r = 0; r < 5; ++r) o[(size_t)r * 6 * DM] = ((red[(0 * 5 + r) * 128 + tid] + red[(1 * 5 + r) * 128 + tid]) + (red[(2 * 5 + r) * 128 + tid] + red[(3 * 5 + r) * 128 + tid])) + bb; }
            }
        }
        SEAM(0);
    }

    layer_body<0>(a, bar, lo, hi, bid, G, shm, sf, ptab);
    layer_body<1>(a, bar, lo, hi, bid, G, shm, sf, ptab);
    if (IN(33)) {
        PH_BEGIN
        const float* gn = PT(46);
        for (int tok = bid * 8 + wave; tok < NLAT; tok += G * 8) {
            const float* xr = XS + (size_t)tok * DM; float4 v[8]; float ss = 0.f;
#pragma unroll
            for (int i = 0; i < 8; ++i) { v[i] = *(const float4*)(xr + i * 256 + lane * 4);
                { const int4 mi = *(const int4*)(MOEI + (size_t)tok * DM + i * 256 + lane * 4);
                  v[i].x += (float)mi.x * (1.0f / 1048576.0f); v[i].y += (float)mi.y * (1.0f / 1048576.0f); v[i].z += (float)mi.z * (1.0f / 1048576.0f); v[i].w += (float)mi.w * (1.0f / 1048576.0f); }
                ss += v[i].x * v[i].x + v[i].y * v[i].y + v[i].z * v[i].z + v[i].w * v[i].w; }
            ss = wave_sum(ss); const float rs = rsqrtf(ss * (1.0f / DM) + 1e-6f);
#pragma unroll
            for (int i = 0; i < 8; ++i) { const int d = i * 256 + lane * 4; const float4 g4 = *(const float4*)(gn + d);
                *(float4*)(a.out + (size_t)tok * DM + d) = make_float4(v[i].x * rs * g4.x, v[i].y * rs * g4.y, v[i].z * rs * g4.z, v[i].w * rs * g4.w); }
        }
    }
#undef IN
#undef SEAM
}


extern "C" void kernel_launch(void* const* d_in, const int* in_sizes, int n_in, void* d_out, int out_size, void* d_ws, size_t ws_size, hipStream_t stream) {
    static int grid = 0;
    if (grid == 0) {
        if (n_in != 47 || ws_size < WS_END) { fprintf(stderr, "kernel_launch: expected 47 inputs and >= %zu bytes of workspace; got %d, %zu\n", (size_t)WS_END, n_in, ws_size); grid = -1; return; }
        int dev = 0, cus = 0;
        if (hipGetDevice(&dev) != hipSuccess || hipDeviceGetAttribute(&cus, hipDeviceAttributeMultiprocessorCount, dev) != hipSuccess) { grid = -1; return; }
        if (hipFuncSetAttribute((const void*)fwd, hipFuncAttributeMaxDynamicSharedMemorySize, LDS_BYTES) != hipSuccess) { fprintf(stderr, "kernel_launch: hipFuncSetAttribute failed\n"); grid = -1; return; }
        int per_cu = 0;
        if (hipOccupancyMaxActiveBlocksPerMultiprocessor(&per_cu, (const void*)fwd, NTHR, LDS_BYTES) != hipSuccess || per_cu < 1) fprintf(stderr, "kernel_launch: occupancy query reports %d\n", per_cu);
        (void)hipGetLastError();
        grid = cus > 256 ? 256 : cus;
        if (grid < 160) { fprintf(stderr, "kernel_launch: needs >= 160 CUs (got %d)\n", grid); grid = -1; return; }
    }
    if (grid < 0) return;
    (void)hipMemsetAsync((char*)d_ws, 0, O_ZERO_END, stream);
    Args a{};
    for (int i = 0; i < 47; ++i) a.in[i] = (const float*)d_in[i];
    a.out = (float*)d_out; a.ws = (unsigned char*)d_ws;
#if MK_ONE_LAUNCH
    a.ph_lo = 0; a.ph_hi = 64;
    hipLaunchKernelGGL(fwd, dim3(grid), dim3(NTHR), LDS_BYTES, stream, a);
#else
    const int ids[] = {0, 1,2,3,4,5,6,7,8,9,10,11,12,13,14, 17,18,19,20,21,22,23,24,25,26,27,28,29,30, 33};
    for (int k = 0; k < (int)(sizeof(ids) / sizeof(ids[0])); ++k) { a.ph_lo = ids[k]; a.ph_hi = ids[k] + 1; hipLaunchKernelGGL(fwd, dim3(grid), dim3(NTHR), LDS_BYTES, stream, a); }
#endif
}
```

```cpp
#include <hip/hip_runtime.h>
#include <stdint.h>
#include <stdio.h>

#ifndef PROBE_MASK
#define PROBE_MASK 0
#endif
#ifndef PROBE_SP
#define PROBE_SP 1
#endif
#define PROBE_REPS(k) ((((PROBE_MASK) >> (k)) & 1) + 1)
#ifndef MK_ONE_LAUNCH
#define MK_ONE_LAUNCH 1
#endif

#define DM 2048
#define NB 4
#define SEQ 4096
#define CTXL 256
#define BW 512
#define NLAT 16384
#define NCTX 1024
#define NTOK 17408
#define IN_W 13856
#define LDP 14080
#define HY_OFF 0
#define ML_OFF 1536
#define S5_OFF 3600
#define SSD_OFF 4112
#define GATE_OFF 5664
#define NEXP 16
#define DEXP 1536
#define MOE_ROWS 2176
#define MOE_PAD 2304
#define NTHR 512
#define LDS_BYTES 147456
#define LAS __attribute__((address_space(3)))

typedef unsigned short bf16_t;
typedef short bf16x8 __attribute__((ext_vector_type(8)));
typedef float f32x4 __attribute__((ext_vector_type(4)));
typedef unsigned u32x4 __attribute__((ext_vector_type(4)));
typedef unsigned u32x2 __attribute__((ext_vector_type(2)));

#define XB_TMO      128
#define XB_XCNT(j)  (256  + 64 * (j))
#define XB_XSUB(j)  (1280 + 64 * (j))
#define XB_XGEN(j)  (2304 + 64 * (j))
#define XB_TOP      3328
#define XB_TOPGEN   3392
#define XCD_BAR_WORDS 3456
#define XB_SPIN_CAP (1u << 18)
__device__ __forceinline__ unsigned xb_ld(unsigned* p)              { return __hip_atomic_load(p, __ATOMIC_RELAXED, __HIP_MEMORY_SCOPE_AGENT); }
__device__ __forceinline__ unsigned xb_add(unsigned* p, unsigned v) { return __hip_atomic_fetch_add(p, v, __ATOMIC_RELAXED, __HIP_MEMORY_SCOPE_AGENT); }
__device__ __forceinline__ unsigned xb_xcc_id() { return (unsigned)__builtin_amdgcn_s_getreg((3 << 11) | 20) & 0xFu; }
#define XB_SPIN(cond, bar) do { unsigned _sp = 0; while (cond) { __builtin_amdgcn_s_sleep(1); \
    if ((++_sp & 255u) == 0u) { if (xb_ld(&(bar)[XB_TMO])) break; if (_sp > XB_SPIN_CAP) { atomicAdd(&(bar)[XB_TMO], 1u); break; } } } } while (0)
struct XcdBarrier { unsigned* bar; unsigned x; volatile LAS unsigned* st; };
__device__ __forceinline__ XcdBarrier xcd_barrier_post(unsigned* bar, volatile LAS unsigned* st) {
    XcdBarrier b; b.bar = bar; b.x = xb_xcc_id(); b.st = st;
    if (threadIdx.x == 0) (void)xb_add(&bar[XB_XCNT(b.x)], 1u);
    return b;
}
__device__ __forceinline__ void xcd_barrier_complete(unsigned* bar, unsigned x, unsigned& nloc, unsigned& nx) {
    const unsigned G = gridDim.x * gridDim.y * gridDim.z;
    unsigned sum, cnt, mine, sp = 0u;
    for (;;) {
        sum = 0u; cnt = 0u; mine = 0u;
#pragma unroll
        for (unsigned j = 0; j < 16; ++j) { const unsigned c = xb_ld(&bar[XB_XCNT(j)]); sum += c; cnt += (c > 0u) ? 1u : 0u; mine = (j == x) ? c : mine; }
        if (sum == G) break;
        __builtin_amdgcn_s_sleep(1);
        if ((++sp & 255u) == 0u) { if (xb_ld(&bar[XB_TMO])) break; if (sp > XB_SPIN_CAP) { atomicAdd(&bar[XB_TMO], 1u); break; } }
    }
    nloc = mine > 0u ? mine : 1u; nx = cnt > 0u ? cnt : 1u;
}
__device__ __forceinline__ void xcd_barrier(const XcdBarrier& b) {
    asm volatile("s_waitcnt vmcnt(0)" ::: "memory");
    __syncthreads();
    if (threadIdx.x == 0) {
        unsigned* bar = b.bar;
        __builtin_amdgcn_s_waitcnt(0);
        unsigned nloc = b.st[0], nx = b.st[1];
        if (nloc == 0u) { xcd_barrier_complete(bar, b.x, nloc, nx); b.st[0] = nloc; b.st[1] = nx; }
        const unsigned old = xb_add(&bar[XB_XSUB(b.x)], 1u);
        const unsigned gen = old / nloc;
        if (old + 1u == (gen + 1u) * nloc) {
            __builtin_amdgcn_fence(__ATOMIC_RELEASE, "agent");
            asm volatile("s_waitcnt vmcnt(0)" ::: "memory");
            const unsigned og = xb_add(&bar[XB_TOP], 1u);
            const unsigned tg = og / nx;
            if (og + 1u == (tg + 1u) * nx) xb_add(&bar[XB_TOPGEN], 1u);
            else XB_SPIN(xb_ld(&bar[XB_TOPGEN]) == tg, bar);
            __builtin_amdgcn_fence(__ATOMIC_ACQUIRE, "agent");
            xb_add(&bar[XB_XGEN(b.x)], 1u);
            asm volatile("s_waitcnt vmcnt(0)" ::: "memory");
        } else {
            XB_SPIN(xb_ld(&bar[XB_XGEN(b.x)]) == gen, bar);
            __builtin_amdgcn_fence(__ATOMIC_ACQUIRE, "agent");
            asm volatile("s_waitcnt vmcnt(0)" ::: "memory");
        }
    }
    __syncthreads();
}

__device__ __forceinline__ unsigned short f2bf(float f) { unsigned u = __float_as_uint(f); u += 0x7FFFu + ((u >> 16) & 1u); return (unsigned short)(u >> 16); }
__device__ __forceinline__ float bf2f(unsigned short b) { return __uint_as_float(((unsigned)b) << 16); }
__device__ __forceinline__ unsigned pk2(float lo, float hi) { unsigned r; asm("v_cvt_pk_bf16_f32 %0, %1, %2" : "=v"(r) : "v"(lo), "v"(hi)); return r; }
__device__ __forceinline__ float sigmoidf_(float x) { return 1.0f / (1.0f + expf(-x)); }
__device__ __forceinline__ float siluf_(float x) { return x / (1.0f + expf(-x)); }
__device__ __forceinline__ float wave_sum(float v) {
#pragma unroll
    for (int o = 32; o >= 1; o >>= 1) v += __shfl_xor(v, o);
    return v;
}
__device__ __forceinline__ const float* uptr(const float* p) { const unsigned long long v = (unsigned long long)p;
    const unsigned lo = __builtin_amdgcn_readfirstlane((unsigned)v), hi = __builtin_amdgcn_readfirstlane((unsigned)(v >> 32)); return (const float*)(((unsigned long long)hi << 32) | lo); }
#define PT(k) uptr(ptab[k])
__device__ __forceinline__ int step_tok(int b, int dir, int i) {
    if (i < CTXL) { const int tt = dir ? (CTXL - 1 - i) : i; return NLAT + b * CTXL + tt; }
    const int j = i - CTXL; const int tt = dir ? (SEQ - 1 - j) : j; return b * SEQ + tt;
}
__device__ __forceinline__ void unpack8(const u32x4 w, float (&f)[8]) {
    f[0] = __uint_as_float(w.x << 16); f[1] = __uint_as_float(w.x & 0xFFFF0000u); f[2] = __uint_as_float(w.y << 16); f[3] = __uint_as_float(w.y & 0xFFFF0000u);
    f[4] = __uint_as_float(w.z << 16); f[5] = __uint_as_float(w.z & 0xFFFF0000u); f[6] = __uint_as_float(w.w << 16); f[7] = __uint_as_float(w.w & 0xFFFF0000u);
}

namespace pg8 {
constexpr int BM = 256, BK = 64, HALF = 128, HTB = HALF * BK * 2, STAGE_BYTES = 8 * HTB, NXCD = 8, WGM = 8;
__host__ __device__ __forceinline__ int lds_byte(int r, int c) { const int st = (r >> 4) * 2 + (c >> 5), rr = r & 15, cc = c & 31, ob = rr * 64 + cc * 2; return st * 1024 + (ob ^ (((ob >> 9) & 1) << 5)); }
__host__ __device__ __forceinline__ void stage_rc(int b, int& R, int& C) { const int st = b / 1024, sb = b % 1024, swz = sb ^ (((sb >> 9) & 1) << 5); R = (st >> 1) * 16 + swz / 64; C = (st & 1) * 32 + (swz % 64) / 2; }
__host__ __device__ __forceinline__ int perm32(int rho) { const int n = rho >> 4, i = rho & 15; return 8 * (i >> 2) + 4 * n + (i & 3); }
struct Unit { int pm, pn, z, k; long long ao, bo; };
struct Gemm { const bf16_t* A; const bf16_t* Bt; int lda, ldb, K; };

__device__ __forceinline__ void tile_of(int wgid, int nM, int nN, int& pm, int& pn) {
    const int nwg = nM * nN; { const int q = nwg / NXCD, r = nwg % NXCD, xcd = wgid % NXCD, off = wgid / NXCD; wgid = (xcd < r ? xcd * (q + 1) : r * (q + 1) + (xcd - r) * q) + off; }
    const int nig = WGM * nN, gid = wgid / nig, fm = gid * WGM, gsz = (nM - fm) < WGM ? (nM - fm) : WGM;
    pm = fm + ((wgid % nig) % gsz); pn = (wgid % nig) / gsz;
}
struct SchedStd {
    int nM, nN, G, c, lda, ldb;
    __device__ __forceinline__ bool next(int i, Unit& u) const { const long L = (long)i * G + c; if (L >= (long)nM * nN) return false; tile_of((int)L, nM, nN, u.pm, u.pn); u.z = 0; u.k = 0;
        u.ao = (long long)u.pm * BM * lda * 2; u.bo = (long long)u.pn * BM * ldb * 2; return true; }
    __device__ __forceinline__ void a_ready(const Unit&) const {}
    __device__ __forceinline__ void done(const Unit&) const {}
};
struct SchedBranch {
    int nM, nN, G, c;
    __device__ __forceinline__ bool next(int i, Unit& u) const { const long L = (long)(i >> 2) * G + c; if (L >= (long)nM * nN) return false; tile_of((int)L, nM, nN, u.pm, u.pn); u.z = 0; u.k = i & 3;
        u.ao = ((long long)u.pm * BM * DM + u.k * BW) * 2; u.bo = ((long long)u.k * DM + u.pn * BM) * BW * 2; return true; }
    __device__ __forceinline__ void a_ready(const Unit&) const {}
    __device__ __forceinline__ void done(const Unit&) const {}
};
struct SchedMoe {
    int nPm, nPn, G, c, lda, ldb, nBrows;
    __device__ __forceinline__ bool next(int i, Unit& u) const { const long L = (long)i * G + c; const int per = nPm * nPn; if (L >= (long)NEXP * per) return false; const int e = (int)(L / per), rem = (int)(L % per);
        u.z = e; u.k = 0; u.pm = rem % nPm; u.pn = rem / nPm; u.ao = ((long long)e * MOE_PAD + u.pm * BM) * lda * 2; u.bo = ((long long)e * nBrows + u.pn * BM) * ldb * 2; return true; }
    __device__ __forceinline__ void a_ready(const Unit&) const {}
    __device__ __forceinline__ void done(const Unit&) const {}
};

typedef f32x4 Acc[2][2][4][2];
template <class Epi, class Sched>
__device__ __forceinline__ void gemm_phase(LAS unsigned char* lds, const Gemm g, const Sched& S, const Epi& E) {
    int tid = threadIdx.x; asm volatile("" : "+v"(tid));
    const int wid = __builtin_amdgcn_readfirstlane(tid >> 6), lane = tid & 63, wr = wid >> 2, wc = wid & 3, fr = lane & 15, fq = lane >> 4;
    const int K = g.K, nt = K / BK;
    unsigned voffA[2], voffB[2];
#pragma unroll
    for (int i = 0; i < 2; ++i) { int R, C; stage_rc(tid * 16 + i * 8192, R, C); const int Rb = Epi::PERM ? ((R & ~31) + perm32(R & 31)) : R;
        voffA[i] = (unsigned)(R * g.lda + C) * 2u; voffB[i] = (unsigned)(Rb * g.ldb + C) * 2u; }
    const size_t kstep = (size_t)(BK * 2);
    const size_t hstepA = (size_t)HALF * g.lda * 2, hstepB = (size_t)HALF * g.ldb * 2;
    const unsigned ldsw = (unsigned)wid * 1024u;
    const int aoff = lds_byte(wr * 64 + fr, fq * 8), boff = lds_byte(wc * 32 + fr, fq * 8);
#define PG8_SA(b, h) (((b) * 2 + (h)) * HTB)
#define PG8_SB(b, h) ((4 + (b) * 2 + (h)) * HTB)
#define PG8_STAGE(bufoff, gbase, voff) do { _Pragma("unroll") for (int _i = 0; _i < 2; ++_i) \
        __builtin_amdgcn_global_load_lds((const unsigned*)((const char*)(gbase) + (voff)[_i]), (LAS unsigned*)(lds + (bufoff) + ldsw + _i * 8192), 16, 0, 0); } while (0)
#define PG8_LDA(dst, b, h) do { _Pragma("unroll") for (int m = 0; m < 4; ++m) _Pragma("unroll") for (int k = 0; k < 2; ++k) dst[m][k] = *(const LAS bf16x8*)(lds + PG8_SA(b, h) + aoff + m * 2048 + k * 1024); } while (0)
#define PG8_LDB(dst, b, h) do { _Pragma("unroll") for (int n = 0; n < 2; ++n) _Pragma("unroll") for (int k = 0; k < 2; ++k) dst[n][k] = *(const LAS bf16x8*)(lds + PG8_SB(b, h) + boff + n * 2048 + k * 1024); } while (0)
#define PG8_MMA(ai, bj, At, Bt) do { __builtin_amdgcn_s_setprio(1); _Pragma("unroll") for (int m = 0; m < 4; ++m) _Pragma("unroll") for (int n = 0; n < 2; ++n) _Pragma("unroll") for (int k = 0; k < 2; ++k) \
        acc[ai][bj][m][n] = __builtin_amdgcn_mfma_f32_16x16x32_bf16(Bt[n][k], At[m][k], acc[ai][bj][m][n], 0, 0, 0); __builtin_amdgcn_s_setprio(0); } while (0)
#define PG8_WAIT_V(n) asm volatile("s_waitcnt vmcnt(" #n ")" ::: "memory")
#define PG8_WAIT_L(n) asm volatile("s_waitcnt lgkmcnt(" #n ")" ::: "memory")
#define PG8_BAR __builtin_amdgcn_s_barrier()
#define PG8_SCHED __builtin_amdgcn_sched_barrier(0)
    Unit cur, nxt; int ui = 0;
    if (!S.next(0, cur)) return;
    Acc acc;
#pragma unroll
    for (int a = 0; a < 2; ++a)
#pragma unroll
        for (int b = 0; b < 2; ++b)
#pragma unroll
            for (int m = 0; m < 4; ++m)
#pragma unroll
                for (int n = 0; n < 2; ++n) acc[a][b][m][n] = (f32x4){0.f, 0.f, 0.f, 0.f};
    bf16x8 At[4][2], B0[2][2], B1[2][2];
    const char* cA = (const char*)g.A + cur.ao; const char* cB = (const char*)g.Bt + cur.bo;
    S.a_ready(cur);
    PG8_STAGE(PG8_SB(0, 0), cB, voffB); PG8_STAGE(PG8_SA(0, 0), cA, voffA); PG8_STAGE(PG8_SB(0, 1), cB + hstepB, voffB); PG8_STAGE(PG8_SA(0, 1), cA + hstepA, voffA);
    if (wr == 1) PG8_BAR;
    PG8_WAIT_V(4); PG8_BAR;
    PG8_STAGE(PG8_SB(1, 0), cB + kstep, voffB); PG8_STAGE(PG8_SA(1, 0), cA + kstep, voffA); PG8_STAGE(PG8_SB(1, 1), cB + hstepB + kstep, voffB);
    PG8_WAIT_V(6); PG8_BAR;
    for (;;) {
        const bool has_next = S.next(ui + 1, nxt);
        const char* nA = has_next ? (const char*)g.A + nxt.ao : cA; const char* nB = has_next ? (const char*)g.Bt + nxt.bo : cB;
        for (int t = 0; t < nt; t += 2) {
            const bool last = (t == nt - 2);
            const char* a1 = cA + (size_t)(t + 1) * kstep;
            const char* a2 = last ? nA : cA + (size_t)(t + 2) * kstep; const char* b2 = last ? nB : cB + (size_t)(t + 2) * kstep;
            const char* a3 = a2 + kstep; const char* b3 = b2 + kstep;
            if (last && has_next) S.a_ready(nxt);
            PG8_LDB(B0, 0, 0); PG8_SCHED; PG8_LDA(At, 0, 0); PG8_STAGE(PG8_SA(1, 1), a1 + hstepA, voffA);
            PG8_WAIT_L(8); PG8_BAR; PG8_WAIT_L(0); PG8_MMA(0, 0, At, B0); PG8_BAR; PG8_SCHED;
            PG8_LDB(B1, 0, 1); PG8_STAGE(PG8_SB(0, 0), b2, voffB);
            PG8_BAR; PG8_WAIT_L(0); PG8_MMA(0, 1, At, B1); PG8_BAR;
            PG8_LDA(At, 0, 1); PG8_STAGE(PG8_SA(0, 0), a2, voffA);
            PG8_BAR; PG8_WAIT_L(0); PG8_MMA(1, 0, At, B0); PG8_BAR; PG8_SCHED;
            PG8_STAGE(PG8_SB(0, 1), b2 + hstepB, voffB);
            PG8_WAIT_V(6); PG8_BAR; PG8_MMA(1, 1, At, B1); PG8_BAR;
            PG8_LDB(B0, 1, 0); PG8_SCHED; PG8_LDA(At, 1, 0); PG8_STAGE(PG8_SA(0, 1), a2 + hstepA, voffA);
            PG8_WAIT_L(8); PG8_BAR; PG8_WAIT_L(0); PG8_MMA(0, 0, At, B0); PG8_BAR; PG8_SCHED;
            PG8_LDB(B1, 1, 1); PG8_STAGE(PG8_SB(1, 0), b3, voffB);
            PG8_BAR; PG8_WAIT_L(0); PG8_MMA(0, 1, At, B1); PG8_BAR;
            PG8_LDA(At, 1, 1); PG8_STAGE(PG8_SA(1, 0), a3, voffA);
            PG8_BAR; PG8_WAIT_L(0); PG8_MMA(1, 0, At, B0); PG8_BAR; PG8_SCHED;
            PG8_STAGE(PG8_SB(1, 1), b3 + hstepB, voffB);
            PG8_WAIT_V(6); PG8_BAR; PG8_MMA(1, 1, At, B1); PG8_BAR;
        }
        const bool keep = E(acc, cur, wr, wc, fr, fq); S.done(cur);
        if (!has_next) break;
        if (!keep) {
#pragma unroll
        for (int a = 0; a < 2; ++a)
#pragma unroll
            for (int b = 0; b < 2; ++b)
#pragma unroll
                for (int m = 0; m < 4; ++m)
#pragma unroll
                    for (int n = 0; n < 2; ++n) acc[a][b][m][n] = (f32x4){0.f, 0.f, 0.f, 0.f};
        }
        cur = nxt; cA = nA; cB = nB; ++ui;
    }
    PG8_WAIT_V(0);
    if (wr == 0) PG8_BAR;
    PG8_BAR;
#undef PG8_SA
#undef PG8_SB
#undef PG8_STAGE
#undef PG8_LDA
#undef PG8_LDB
#undef PG8_MMA
#undef PG8_WAIT_V
#undef PG8_WAIT_L
#undef PG8_BAR
#undef PG8_SCHED
}

struct EpiBf16Store {
    static constexpr bool PERM = true;
    bf16_t* O; int ldc;
    __device__ __forceinline__ bool operator()(Acc& acc, const Unit& u, int wr, int wc, int fr, int fq) const {
        const int row0 = u.pm * BM + wr * 64 + fr, col0 = u.pn * BM + wc * 32 + 8 * fq;
#pragma unroll
        for (int ai = 0; ai < 2; ++ai)
#pragma unroll
            for (int m = 0; m < 4; ++m) { bf16_t* rowp = O + (size_t)(row0 + ai * HALF + m * 16) * ldc + col0;
#pragma unroll
                for (int bj = 0; bj < 2; ++bj) { const f32x4 v0 = acc[ai][bj][m][0], v1 = acc[ai][bj][m][1];
                    u32x4 w; w.x = pk2(v0[0], v0[1]); w.y = pk2(v0[2], v0[3]); w.z = pk2(v1[0], v1[1]); w.w = pk2(v1[2], v1[3]);
                    *(u32x4*)(rowp + bj * HALF) = w; } }
        return false;
    }
};
struct EpiWin {
    static constexpr bool PERM = true;
    bf16_t* O; int ldc;
    __device__ __forceinline__ bool operator()(Acc& acc, const Unit& u, int wr, int wc, int fr, int fq) const {
        const int row0 = u.pm * BM + wr * 64 + fr, col0 = u.pn * BM + wc * 32 + 8 * fq;
#pragma unroll
        for (int bj = 0; bj < 2; ++bj) { const bool gate = (col0 + bj * HALF) >= GATE_OFF;
#pragma unroll
            for (int ai = 0; ai < 2; ++ai)
#pragma unroll
                for (int m = 0; m < 4; ++m) { f32x4 v0 = acc[ai][bj][m][0], v1 = acc[ai][bj][m][1];
                    if (gate) {
#pragma unroll
                        for (int j = 0; j < 4; ++j) { v0[j] = __builtin_amdgcn_rcpf(1.0f + __expf(-v0[j])); v1[j] = __builtin_amdgcn_rcpf(1.0f + __expf(-v1[j])); } }
                    u32x4 w; w.x = pk2(v0[0], v0[1]); w.y = pk2(v0[2], v0[3]); w.z = pk2(v1[0], v1[1]); w.w = pk2(v1[2], v1[3]);
                    *(u32x4*)(O + (size_t)(row0 + ai * HALF + m * 16) * ldc + col0 + bj * HALF) = w; } }
        return false;
    }
};
struct EpiNone { static constexpr bool PERM = true;
    __device__ __forceinline__ bool operator()(Acc& acc, const Unit&, int, int, int, int) const {
#pragma unroll
        for (int a = 0; a < 2; ++a)
#pragma unroll
            for (int b = 0; b < 2; ++b)
#pragma unroll
                for (int m = 0; m < 4; ++m)
#pragma unroll
                    for (int n = 0; n < 2; ++n) asm volatile("" :: "v"(acc[a][b][m][n]));
        return false; } };
struct EpiGlu {
    static constexpr bool PERM = true;
    const bf16_t* GG; const float* bias; bf16_t* Y4;
    __device__ __forceinline__ bool operator()(Acc& acc, const Unit& u, int wr, int wc, int fr, int fq) const {
        const int row0 = u.pm * BM + wr * 64 + fr, col0 = u.pn * BM + wc * 32 + 8 * fq;
#pragma unroll
        for (int bj = 0; bj < 2; ++bj) { const int col = col0 + bj * HALF; const f32x4 b0 = *(const f32x4*)(bias + col), b1 = *(const f32x4*)(bias + col + 4);
#pragma unroll
            for (int ai = 0; ai < 2; ++ai)
#pragma unroll
                for (int m = 0; m < 4; ++m) { const size_t row = (size_t)(row0 + ai * HALF + m * 16);
                    float gg[8]; unpack8(*(const u32x4*)(GG + row * BW + col), gg);
                    const f32x4 v0 = acc[ai][bj][m][0] + b0, v1 = acc[ai][bj][m][1] + b1;
                    u32x4 w; w.x = pk2(gg[0] * sigmoidf_(v0[0]), gg[1] * sigmoidf_(v0[1])); w.y = pk2(gg[2] * sigmoidf_(v0[2]), gg[3] * sigmoidf_(v0[3]));
                    w.z = pk2(gg[4] * sigmoidf_(v1[0]), gg[5] * sigmoidf_(v1[1])); w.w = pk2(gg[6] * sigmoidf_(v1[2]), gg[7] * sigmoidf_(v1[3]));
                    *(u32x4*)(Y4 + row * DM + 1024 + col) = w; } }
        return false;
    }
};
struct EpiBranch {
    static constexpr bool PERM = true;
    const bf16_t* P; bf16_t* ACCb;
    __device__ __forceinline__ bool operator()(Acc& acc, const Unit& u, int wr, int wc, int fr, int fq) const {
        const int row0 = u.pm * BM + wr * 64 + fr, col0 = u.pn * BM + wc * 32 + 8 * fq; const int k = u.k;
#pragma unroll
        for (int ai = 0; ai < 2; ++ai)
#pragma unroll
            for (int m = 0; m < 4; ++m) { const size_t row = (size_t)(row0 + ai * HALF + m * 16);
#pragma unroll
                for (int bj = 0; bj < 2; ++bj) { const int col = col0 + bj * HALF;
                    float g0[8]; unpack8(*(const u32x4*)(P + row * LDP + GATE_OFF + k * DM + col), g0);
                    float s[8];
                    if (k < 3) { float g1[8]; unpack8(*(const u32x4*)(P + row * LDP + GATE_OFF + (k + 1) * DM + col), g1);
#pragma unroll
                        for (int j = 0; j < 8; ++j) s[j] = g0[j] * __builtin_amdgcn_rcpf(g1[j]); }
                    else {
#pragma unroll
                        for (int j = 0; j < 8; ++j) s[j] = g0[j]; }
                    f32x4 v0 = acc[ai][bj][m][0], v1 = acc[ai][bj][m][1];
                    v0[0] *= s[0]; v0[1] *= s[1]; v0[2] *= s[2]; v0[3] *= s[3]; v1[0] *= s[4]; v1[1] *= s[5]; v1[2] *= s[6]; v1[3] *= s[7];
                    if (k < 3) { acc[ai][bj][m][0] = v0; acc[ai][bj][m][1] = v1; }
                    else { u32x4 w; w.x = pk2(v0[0], v0[1]); w.y = pk2(v0[2], v0[3]); w.z = pk2(v1[0], v1[1]); w.w = pk2(v1[2], v1[3]); *(u32x4*)(ACCb + row * DM + col) = w; } } }
        return k < 3;
    }
};
struct EpiResid {
    static constexpr bool PERM = false;
    float* XS; const float* srcLat; const float* srcCtx; const float* MODl; int gidx;
    __device__ __forceinline__ bool operator()(Acc& acc, const Unit& u, int wr, int wc, int fr, int fq) const {
        const int row0 = u.pm * BM + wr * 64 + fr, col0 = u.pn * BM + wc * 32 + 4 * fq;
        const int r = (u.pm * BM) < NLAT ? (u.pm * BM) / SEQ : 4;
        const float* src = (u.pm * BM) < NLAT ? srcLat : srcCtx;
        const float* mg = MODl + (size_t)(r * 6 + gidx) * DM;
#pragma unroll
        for (int bj = 0; bj < 2; ++bj)
#pragma unroll
            for (int n = 0; n < 2; ++n) { const int col = col0 + bj * HALF + n * 16; const f32x4 gm = *(const f32x4*)(mg + col);
#pragma unroll
                for (int ai = 0; ai < 2; ++ai)
#pragma unroll
                    for (int m = 0; m < 4; ++m) { const size_t o = (size_t)(row0 + ai * HALF + m * 16) * DM + col; *(f32x4*)(XS + o) = *(const f32x4*)(src + o) + gm * acc[ai][bj][m][n]; } }
        return false;
    }
};
struct EpiMoe1 {
    static constexpr bool PERM = false;
    bf16_t* HID;
    __device__ __forceinline__ bool operator()(Acc& acc, const Unit& u, int wr, int wc, int fr, int fq) const {
        const size_t row0 = (size_t)u.z * MOE_PAD + u.pm * BM + wr * 64 + fr; const int col0 = u.pn * HALF + wc * 16 + 4 * fq;
#pragma unroll
        for (int ai = 0; ai < 2; ++ai)
#pragma unroll
            for (int m = 0; m < 4; ++m)
#pragma unroll
                for (int bj = 0; bj < 2; ++bj) { const f32x4 gt = acc[ai][bj][m][0], up = acc[ai][bj][m][1];
                    u32x2 w; w.x = pk2(siluf_(gt[0]) * up[0], siluf_(gt[1]) * up[1]); w.y = pk2(siluf_(gt[2]) * up[2], siluf_(gt[3]) * up[3]);
                    *(u32x2*)(HID + (row0 + ai * HALF + m * 16) * DEXP + col0 + bj * 64) = w; }
        return false;
    }
};
struct EpiMoeY {
    static constexpr bool PERM = true;
    bf16_t* O;
    __device__ __forceinline__ bool operator()(Acc& acc, const Unit& u, int wr, int wc, int fr, int fq) const {
        const size_t row0 = (size_t)u.z * MOE_PAD + u.pm * BM + wr * 64 + fr; const int col0 = u.pn * BM + wc * 32 + 8 * fq;
#pragma unroll
        for (int ai = 0; ai < 2; ++ai)
#pragma unroll
            for (int m = 0; m < 4; ++m) { bf16_t* rowp = O + (row0 + ai * HALF + m * 16) * DM + col0;
#pragma unroll
                for (int bj = 0; bj < 2; ++bj) { const f32x4 v0 = acc[ai][bj][m][0], v1 = acc[ai][bj][m][1];
                    u32x4 w; w.x = pk2(v0[0], v0[1]); w.y = pk2(v0[2], v0[3]); w.z = pk2(v1[0], v1[1]); w.w = pk2(v1[2], v1[3]);
                    *(u32x4*)(rowp + bj * HALF) = w; } }
        return false;
    }
};

struct SchedS5a {
    int c;
    __device__ __forceinline__ bool next(int i, Unit& u) const { if (i > 0 || c >= 64) return false; u.z = c >> 1; u.pm = c & 1; u.pn = 0; u.k = 0;
        u.ao = ((long long)u.z * 512 + u.pm * BM) * 768 * 2; u.bo = (long long)u.z * 256 * 512 * 2; return true; }
    __device__ __forceinline__ void a_ready(const Unit&) const {}
    __device__ __forceinline__ void done(const Unit&) const {}
};
struct SchedS5b {
    int c;
    __device__ __forceinline__ bool next(int i, Unit& u) const { if (i > 0 || c >= 128) return false; u.z = c >> 2; u.pm = (c >> 1) & 1; u.pn = c & 1; u.k = 0;
        u.ao = ((long long)u.z * 512 + u.pm * BM) * 768 * 2; u.bo = ((long long)u.z * 512 + u.pn * BM) * 768 * 2; return true; }
    __device__ __forceinline__ void a_ready(const Unit&) const {}
    __device__ __forceinline__ void done(const Unit&) const {}
};
struct EpiXloc {
    static constexpr bool PERM = false;
    float* XL;
    __device__ __forceinline__ bool operator()(Acc& acc, const Unit& u, int wr, int wc, int fr, int fq) const {
        const int row0 = u.pm * BM + wr * 64 + fr, col0 = wc * 32 + 4 * fq; float* base = XL + (size_t)u.z * 512 * 256;
#pragma unroll
        for (int ai = 0; ai < 2; ++ai)
#pragma unroll
            for (int m = 0; m < 4; ++m) { float* rowp = base + (size_t)(row0 + ai * HALF + m * 16) * 256 + col0;
#pragma unroll
                for (int bj = 0; bj < 2; ++bj)
#pragma unroll
                    for (int n = 0; n < 2; ++n) *(f32x4*)(rowp + bj * HALF + n * 16) = acc[ai][bj][m][n]; }
        return false;
    }
};
struct EpiS5Out {
    static constexpr bool PERM = true;
    const bf16_t* P; const float* dskip; bf16_t* GG;
    __device__ __forceinline__ bool operator()(Acc& acc, const Unit& u, int wr, int wc, int fr, int fq) const {
        const int row0 = u.pm * BM + wr * 64 + fr, col0 = u.pn * BM + wc * 32 + 8 * fq; const int g = u.z;
#pragma unroll
        for (int bj = 0; bj < 2; ++bj) { const int col = col0 + bj * HALF; const int t = col >> 4, c0 = col & 15;
            const f32x4 d0 = *(const f32x4*)(dskip + g * 16 + c0), d1 = *(const f32x4*)(dskip + g * 16 + c0 + 4);
#pragma unroll
            for (int ai = 0; ai < 2; ++ai)
#pragma unroll
                for (int m = 0; m < 4; ++m) { const size_t tok = (size_t)(row0 + ai * HALF + m * 16) * 32 + t;
                    float uu[8]; unpack8(*(const u32x4*)(P + tok * LDP + S5_OFF + g * 16 + c0), uu);
                    const f32x4 v0 = acc[ai][bj][m][0], v1 = acc[ai][bj][m][1];
                    float y[8] = {v0[0] + d0[0] * uu[0], v0[1] + d0[1] * uu[1], v0[2] + d0[2] * uu[2], v0[3] + d0[3] * uu[3], v1[0] + d1[0] * uu[4], v1[1] + d1[1] * uu[5], v1[2] + d1[2] * uu[6], v1[3] + d1[3] * uu[7]};
#pragma unroll
                    for (int j = 0; j < 8; ++j) y[j] = 0.5f * y[j] * (1.0f + tanhf(0.7978845608028654f * (y[j] + 0.044715f * y[j] * y[j] * y[j])));
                    u32x4 w; w.x = pk2(y[0], y[1]); w.y = pk2(y[2], y[3]); w.z = pk2(y[4], y[5]); w.w = pk2(y[6], y[7]);
                    *(u32x4*)(GG + tok * BW + g * 16 + c0) = w; } }
        return false;
    }
};
}


__device__ __forceinline__ float wave_scan_incl(float v, int lane) {
#pragma unroll
    for (int o = 1; o < 64; o <<= 1) { const float t = __shfl_up(v, o); if (lane >= o) v += t; }
    return v;
}
__device__ __forceinline__ float wave_scanmax_incl(float v, int lane) {
#pragma unroll
    for (int o = 1; o < 64; o <<= 1) { const float t = __shfl_up(v, o); if (lane >= o) v = fmaxf(v, t); }
    return v;
}
__device__ __forceinline__ float wave_max(float v) {
#pragma unroll
    for (int o = 32; o >= 1; o >>= 1) v = fmaxf(v, __shfl_xor(v, o));
    return v;
}
__device__ __forceinline__ void unpack8h(const u32x4 w, bf16_t (&h)[8]) {
    h[0] = (bf16_t)(w.x & 0xFFFFu); h[1] = (bf16_t)(w.x >> 16); h[2] = (bf16_t)(w.y & 0xFFFFu); h[3] = (bf16_t)(w.y >> 16);
    h[4] = (bf16_t)(w.z & 0xFFFFu); h[5] = (bf16_t)(w.z >> 16); h[6] = (bf16_t)(w.w & 0xFFFFu); h[7] = (bf16_t)(w.w >> 16);
}

__device__ __forceinline__ int tokblock_of(int b, int dir, int c) { if (c < 4) return 256 + b * 4 + (dir ? 3 - c : c); const int j = c - 4; return b * 64 + (dir ? 63 - j : j); }
__device__ __forceinline__ u32x4 rev8h(const u32x4 v) { u32x4 r; r.x = (v.w >> 16) | (v.w << 16); r.y = (v.z >> 16) | (v.z << 16); r.z = (v.y >> 16) | (v.y << 16); r.w = (v.x >> 16) | (v.x << 16); return r; }
__device__ __forceinline__ u32x4 scale8h(const u32x4 v, const float4 a, const float4 b) { float f[8]; unpack8(v, f); u32x4 r; r.x = pk2(f[0] * a.x, f[1] * a.y); r.y = pk2(f[2] * a.z, f[3] * a.w); r.z = pk2(f[4] * b.x, f[5] * b.y); r.w = pk2(f[6] * b.z, f[7] * b.w); return r; }
__device__ __forceinline__ float dot8h(const u32x4 v, const float4 a, const float4 b) { float f[8]; unpack8(v, f); return (f[0] * a.x + f[1] * a.y) + (f[2] * a.z + f[3] * a.w) + (f[4] * b.x + f[5] * b.y) + (f[6] * b.z + f[7] * b.w); }
#define ML_FRAG_LOAD(KF, VF, cc_) do { const int tb_ = tokblock_of(b, dir, (cc_)); const bf16_t* kb_ = KTg + ((size_t)tb_ * 512 + h * 128 + 64 * wd + r16) * 64 + q4 * 8; const bf16_t* vb_ = VTg + ((size_t)tb_ * 512 + h * 128 + 32 * we + r16) * 64 + q4 * 8; \
        _Pragma("unroll") for (int ks_ = 0; ks_ < 2; ++ks_) { _Pragma("unroll") for (int j_ = 0; j_ < 2; ++j_) VF[j_][ks_] = *(const u32x4*)(vb_ + (size_t)j_ * 16 * 64 + ks_ * 32); \
            _Pragma("unroll") for (int j_ = 0; j_ < 4; ++j_) KF[j_][ks_] = *(const u32x4*)(kb_ + (size_t)j_ * 16 * 64 + ks_ * 32); } } while (0)
#define ML_CHUNK(c_, KF, VF, KFN, VFN) do { const int c = (c_); \
        if (c + 1 < 68) ML_FRAG_LOAD(KFN, VFN, c + 1);                        \
        const float ig = bf2f(gi0) + gbi, fg = bf2f(gf0) + gbf; gi0 = gi1; gf0 = gf1; \
        if (c + 2 < 68) { const size_t t2 = (size_t)step_tok(b, dir, (c + 2) * 64 + lane); gi1 = Pm[t2 * LDP + gcol_i]; gf1 = Pm[t2 * LDP + gcol_f]; } \
        const float lf = fminf(fg, 0.f) - log1pf(expf(-fabsf(fg))); \
        const float bcs = wave_scan_incl(lf, lane); const float blast = __shfl(bcs, 63); const float beta = wave_max(blast - bcs + ig); \
        const float mo = fmaxf(m + blast, beta); const float wsv = expf(blast - bcs + ig - mo); const float dec = expf(blast + m - mo); \
        wsl[dir ? 63 - lane : lane] = wsv; \
        {   bf16_t* cs = CST + (size_t)(chain * 68 + c) * 128 * 128; \
            _Pragma("unroll") for (int je = 0; je < 2; ++je) _Pragma("unroll") for (int jd = 0; jd < 4; ++jd) { const int e = 32 * we + 16 * je + r16, d0 = 64 * wd + 16 * jd + q4 * 4; \
                u32x2 pk; pk.x = pk2(acc[je][jd][0], acc[je][jd][1]); pk.y = pk2(acc[je][jd][2], acc[je][jd][3]); *(u32x2*)(cs + (size_t)e * 128 + d0) = pk; } \
            if (we == 0) { _Pragma("unroll") for (int jd = 0; jd < 4; ++jd) { float nv = npart[jd]; nv += __shfl_xor(nv, 16); nv += __shfl_xor(nv, 32); if (q4 == 0) NST[(size_t)(chain * 68 + c) * 128 + 64 * wd + 16 * jd + r16] = nv; } \
                if (tid == 0) MST[chain * 68 + c] = m; } } \
        asm volatile("s_waitcnt lgkmcnt(0)" ::: "memory"); \
        bf16x8 vfr[2][2]; \
        _Pragma("unroll") for (int ks = 0; ks < 2; ++ks) { const float4 wa = *(const float4*)(wsl + ks * 32 + q4 * 8), wb = *(const float4*)(wsl + ks * 32 + q4 * 8 + 4); \
            _Pragma("unroll") for (int je = 0; je < 2; ++je) { const u32x4 sv = scale8h(VF[je][ks], wa, wb); vfr[je][ks] = *(const bf16x8*)&sv; } \
            if (we == 0) { _Pragma("unroll") for (int jd = 0; jd < 4; ++jd) npart[jd] = (ks == 0 ? dec * npart[jd] : npart[jd]) + dot8h(KF[jd][ks], wa, wb); } } \
        asm volatile("" ::: "memory"); \
        _Pragma("unroll") for (int je = 0; je < 2; ++je) _Pragma("unroll") for (int jd = 0; jd < 4; ++jd) acc[je][jd] = acc[je][jd] * dec; \
        _Pragma("unroll") for (int ks = 0; ks < 2; ++ks) _Pragma("unroll") for (int je = 0; je < 2; ++je) _Pragma("unroll") for (int jd = 0; jd < 4; ++jd) \
            acc[je][jd] = __builtin_amdgcn_mfma_f32_16x16x32_bf16(*(const bf16x8*)&KF[jd][ks], vfr[je][ks], acc[je][jd], 0, 0, 0); \
        m = mo; } while (0)
__device__ __forceinline__ void mlstm_state_pass(const int chain, const bf16_t* __restrict__ Pm, const bf16_t* __restrict__ KTg, const bf16_t* __restrict__ VTg, const float* __restrict__ gate_b,
                                                 bf16_t* __restrict__ CST, float* __restrict__ NST, float* __restrict__ MST, unsigned char* shm, const int tid) {
    const int dir = chain & 1, h = (chain >> 1) & 3, b = chain >> 3, lane = tid & 63, w = tid >> 6, we = w >> 1, wd = w & 1, q4 = lane >> 4, r16 = lane & 15;
    float* wsl = (float*)shm + w * 64;
    const float gbi = gate_b[(dir * 2 + 0) * 4 + h], gbf = gate_b[(dir * 2 + 1) * 4 + h];
    f32x4 acc[2][4];
#pragma unroll
    for (int je = 0; je < 2; ++je)
#pragma unroll
        for (int jd = 0; jd < 4; ++jd) acc[je][jd] = (f32x4){0.f, 0.f, 0.f, 0.f};
    float npart[4] = {0.f, 0.f, 0.f, 0.f};
    float m = 0.f;
    const int gcol_i = ML_OFF + 2048 + (dir * 2 + 0) * 4 + h, gcol_f = ML_OFF + 2048 + (dir * 2 + 1) * 4 + h;
    bf16_t gi0, gf0, gi1, gf1; u32x4 kfA[4][2], vfA[2][2], kfB[4][2], vfB[2][2];
    { const size_t t0 = (size_t)step_tok(b, dir, lane), t1 = (size_t)step_tok(b, dir, 64 + lane);
      gi0 = Pm[t0 * LDP + gcol_i]; gf0 = Pm[t0 * LDP + gcol_f]; gi1 = Pm[t1 * LDP + gcol_i]; gf1 = Pm[t1 * LDP + gcol_f]; }
    ML_FRAG_LOAD(kfA, vfA, 0);
    for (int c2 = 0; c2 < 68; c2 += 2) { ML_CHUNK(c2, kfA, vfA, kfB, vfB); ML_CHUNK(c2 + 1, kfB, vfB, kfA, vfA); }
}
#undef ML_CHUNK
#undef ML_FRAG_LOAD
__device__ __forceinline__ void mlstm_out_item(const int chain, const int c, const bf16_t* __restrict__ Pm, const bf16_t* __restrict__ QKb, const bf16_t* __restrict__ VTg, const float* __restrict__ gate_b,
                                               const bf16_t* __restrict__ CST, const float* __restrict__ NST, const float* __restrict__ MST, float* __restrict__ Hout, unsigned char* shm, const int tid) {
    const int dir = chain & 1, h = (chain >> 1) & 3, b = chain >> 3, lane = tid & 63, w = tid >> 6;
    bf16_t* Qs = (bf16_t*)shm; bf16_t* Ks = (bf16_t*)(shm + 17408); bf16_t* VT = (bf16_t*)(shm + 34816); bf16_t* Cs = (bf16_t*)(shm + 53248); bf16_t* Ss = (bf16_t*)(shm + 88064);
    float* sc = (float*)(shm + 97280);
    __syncthreads();
#pragma unroll
    for (int i = 0; i < 2; ++i) { const int pid = tid + i * 512; const int s = pid >> 4, x0 = (pid & 15) * 8; const size_t toks = (size_t)step_tok(b, dir, c * 64 + s);
        *(u32x4*)(Qs + s * 136 + x0) = *(const u32x4*)(QKb + toks * 1024 + h * 128 + x0);
        *(u32x4*)(Ks + s * 136 + x0) = *(const u32x4*)(QKb + toks * 1024 + 512 + h * 128 + x0);
        { const int e = pid >> 3, o = pid & 7;
          const u32x4 vv = *(const u32x4*)(VTg + ((size_t)tokblock_of(b, dir, c) * 512 + h * 128 + e) * 64 + (dir ? 7 - o : o) * 8);
          *(u32x4*)(VT + e * 72 + o * 8) = dir ? rev8h(vv) : vv; } }
#pragma unroll
    for (int i = 0; i < 4; ++i) { const int pid = tid + i * 512; const int e = pid >> 4, x0 = (pid & 15) * 8;
        *(u32x4*)(Cs + e * 136 + x0) = *(const u32x4*)(CST + ((size_t)(chain * 68 + c) * 128 + e) * 128 + x0); }
    if (tid < 128) sc[384 + tid] = NST[(size_t)(chain * 68 + c) * 128 + tid];
    if (w == 0) {
        const float gbi = gate_b[(dir * 2 + 0) * 4 + h], gbf = gate_b[(dir * 2 + 1) * 4 + h];
        const size_t tokl = (size_t)step_tok(b, dir, c * 64 + lane);
        const float ig = bf2f(Pm[tokl * LDP + ML_OFF + 2048 + (dir * 2 + 0) * 4 + h]) + gbi;
        const float fg = bf2f(Pm[tokl * LDP + ML_OFF + 2048 + (dir * 2 + 1) * 4 + h]) + gbf;
        const float lf = fminf(fg, 0.f) - log1pf(expf(-fabsf(fg)));
        const float bcs = wave_scan_incl(lf, lane); const float gsv = ig - bcs; const float pm = wave_scanmax_incl(gsv, lane);
        const float m_in = MST[chain * 68 + c]; const float mt = bcs + fmaxf(m_in, pm);
        sc[lane] = bcs; sc[64 + lane] = gsv; sc[128 + lane] = mt; sc[192 + lane] = expf(bcs + m_in - mt); sc[256 + lane] = expf(-mt);
    }
    __syncthreads();
    const int tt = w >> 1;
    {   f32x4 aS[2] = {(f32x4){0.f, 0.f, 0.f, 0.f}, (f32x4){0.f, 0.f, 0.f, 0.f}};
#pragma unroll
        for (int ks = 0; ks < 4; ++ks) { const bf16x8 af = *(const bf16x8*)(Qs + (16 * tt + (lane & 15)) * 136 + ks * 32 + (lane >> 4) * 8);
#pragma unroll
            for (int i = 0; i < 2; ++i) { const int st = (w & 1) * 2 + i; const bf16x8 bfr = *(const bf16x8*)(Ks + (16 * st + (lane & 15)) * 136 + ks * 32 + (lane >> 4) * 8);
                aS[i] = __builtin_amdgcn_mfma_f32_16x16x32_bf16(af, bfr, aS[i], 0, 0, 0); } }
        float rs[4] = {0.f, 0.f, 0.f, 0.f};
#pragma unroll
        for (int i = 0; i < 2; ++i) { const int s = 16 * ((w & 1) * 2 + i) + (lane & 15); const float gsv = sc[64 + s];
#pragma unroll
            for (int q = 0; q < 4; ++q) { const int t = 16 * tt + (lane >> 4) * 4 + q; const float val = (s <= t) ? aS[i][q] * expf(sc[t] + gsv - sc[128 + t]) : 0.f; Ss[t * 72 + s] = f2bf(val); rs[q] += val; } }
#pragma unroll
        for (int q = 0; q < 4; ++q) { float r = rs[q]; r += __shfl_xor(r, 1); r += __shfl_xor(r, 2); r += __shfl_xor(r, 4); r += __shfl_xor(r, 8);
            if ((lane & 15) == 0) sc[512 + (w & 1) * 64 + 16 * tt + (lane >> 4) * 4 + q] = r; }
        {   const int t = tid >> 3, part = tid & 7; float dot = 0.f;
#pragma unroll
            for (int j = 0; j < 16; ++j) dot += bf2f(Qs[t * 136 + part * 16 + j]) * sc[384 + part * 16 + j];
            dot += __shfl_xor(dot, 1); dot += __shfl_xor(dot, 2); dot += __shfl_xor(dot, 4);
            if (part == 0) sc[640 + t] = sc[192 + t] * dot; }
    }
    __syncthreads();
    {   f32x4 aN[4];
#pragma unroll
        for (int i = 0; i < 4; ++i) aN[i] = (f32x4){0.f, 0.f, 0.f, 0.f};
#pragma unroll
        for (int ks = 0; ks < 4; ++ks) { const bf16x8 af = *(const bf16x8*)(Qs + (16 * tt + (lane & 15)) * 136 + ks * 32 + (lane >> 4) * 8);
#pragma unroll
            for (int i = 0; i < 4; ++i) { const int et = (w & 1) * 4 + i; const bf16x8 bfr = *(const bf16x8*)(Cs + (16 * et + (lane & 15)) * 136 + ks * 32 + (lane >> 4) * 8);
                aN[i] = __builtin_amdgcn_mfma_f32_16x16x32_bf16(af, bfr, aN[i], 0, 0, 0); } }
#pragma unroll
        for (int q = 0; q < 4; ++q) { const float it = sc[192 + 16 * tt + (lane >> 4) * 4 + q];
#pragma unroll
            for (int i = 0; i < 4; ++i) aN[i][q] *= it; }
#pragma unroll
        for (int ks = 0; ks < 2; ++ks) { const bf16x8 af = *(const bf16x8*)(Ss + (16 * tt + (lane & 15)) * 72 + ks * 32 + (lane >> 4) * 8);
#pragma unroll
            for (int i = 0; i < 4; ++i) { const int et = (w & 1) * 4 + i; const bf16x8 bfr = *(const bf16x8*)(VT + (16 * et + (lane & 15)) * 72 + ks * 32 + (lane >> 4) * 8);
                aN[i] = __builtin_amdgcn_mfma_f32_16x16x32_bf16(af, bfr, aN[i], 0, 0, 0); } }
#pragma unroll
        for (int q = 0; q < 4; ++q) { const int t = 16 * tt + (lane >> 4) * 4 + q; const size_t tokt = (size_t)step_tok(b, dir, c * 64 + t); const float dn = fmaxf(fabsf((sc[512 + t] + sc[576 + t]) + sc[640 + t]), sc[256 + t]);
#pragma unroll
            for (int i = 0; i < 4; ++i) { const int e = 16 * ((w & 1) * 4 + i) + (lane & 15); Hout[tokt * BW + h * 128 + e] = aN[i][q] / dn; } }
    }
}


#define SD_FRAG_LOAD(BF, XF, cc_) do { const int tb_ = tokblock_of(b, dir, (cc_)); const bf16_t* bb_ = BTg + ((size_t)tb_ * 256 + grp * 128 + 64 * (w >> 2) + r16) * 64 + q4 * 8; const bf16_t* xb_ = XTg + ((size_t)tb_ * 512 + h * 64 + 16 * (w & 3) + r16) * 64 + q4 * 8; \
        _Pragma("unroll") for (int ks_ = 0; ks_ < 2; ++ks_) { XF[ks_] = *(const u32x4*)(xb_ + ks_ * 32); _Pragma("unroll") for (int j_ = 0; j_ < 4; ++j_) BF[j_][ks_] = *(const u32x4*)(bb_ + (size_t)j_ * 16 * 64 + ks_ * 32); } } while (0)
#define SD_CHUNK(c_, BF, XF, BFN, XFN) do { const int c = (c_); \
        if (c + 1 < 68) SD_FRAG_LOAD(BFN, XFN, c + 1); \
        const float xv = bf2f(d0) + dtb; const float dtv = xv > 20.f ? xv : log1pf(expf(xv)); \
        d0 = d1; if (c + 2 < 68) d1 = Pm[(size_t)step_tok(b, dir, (c + 2) * 64 + lane) * LDP + dcol]; \
        const float cs = wave_scan_incl(dtv * Aa, lane); const float cl = __shfl(cs, 63); const float scl = dtv * expf(cl - cs); const float dec = expf(cl); \
        wsl[dir ? 63 - lane : lane] = scl; \
        {   bf16_t* ss = SSTb + (size_t)(chain * 68 + c) * 64 * 128; const int p = 16 * (w & 3) + r16; \
            _Pragma("unroll") for (int j = 0; j < 4; ++j) { const int n0 = 16 * ((w >> 2) * 4 + j) + q4 * 4; u32x2 pk; pk.x = pk2(acc[j][0], acc[j][1]); pk.y = pk2(acc[j][2], acc[j][3]); *(u32x2*)(ss + (size_t)p * 128 + n0) = pk; } } \
        asm volatile("s_waitcnt lgkmcnt(0)" ::: "memory"); \
        bf16x8 xfr[2]; \
        _Pragma("unroll") for (int ks = 0; ks < 2; ++ks) { const float4 wa = *(const float4*)(wsl + ks * 32 + q4 * 8), wb = *(const float4*)(wsl + ks * 32 + q4 * 8 + 4); const u32x4 sv = scale8h(XF[ks], wa, wb); xfr[ks] = *(const bf16x8*)&sv; } \
        asm volatile("" ::: "memory"); \
        _Pragma("unroll") for (int j = 0; j < 4; ++j) acc[j] = acc[j] * dec; \
        _Pragma("unroll") for (int ks = 0; ks < 2; ++ks) _Pragma("unroll") for (int j = 0; j < 4; ++j) acc[j] = __builtin_amdgcn_mfma_f32_16x16x32_bf16(*(const bf16x8*)&BF[j][ks], xfr[ks], acc[j], 0, 0, 0); } while (0)
__device__ __forceinline__ void ssd_state_pass(const int chain, const bf16_t* __restrict__ Pm, const bf16_t* __restrict__ BTg, const bf16_t* __restrict__ XTg, const float Aa, const float dtb,
                                               bf16_t* __restrict__ SSTb, unsigned char* shm, const int tid) {
    const int dir = chain & 1, h = (chain >> 1) & 7, b = chain >> 4, grp = h >> 2, lane = tid & 63, w = tid >> 6, q4 = lane >> 4, r16 = lane & 15;
    float* wsl = (float*)shm + w * 64;
    f32x4 acc[4];
#pragma unroll
    for (int j = 0; j < 4; ++j) acc[j] = (f32x4){0.f, 0.f, 0.f, 0.f};
    const int dcol = SSD_OFF + 1536 + dir * 8 + h;
    bf16_t d0, d1; u32x4 bfA[4][2], xfA[2], bfB[4][2], xfB[2];
    d0 = Pm[(size_t)step_tok(b, dir, lane) * LDP + dcol]; d1 = Pm[(size_t)step_tok(b, dir, 64 + lane) * LDP + dcol];
    SD_FRAG_LOAD(bfA, xfA, 0);
    for (int c2 = 0; c2 < 68; c2 += 2) { SD_CHUNK(c2, bfA, xfA, bfB, xfB); SD_CHUNK(c2 + 1, bfB, xfB, bfA, xfA); }
}
#undef SD_CHUNK
#undef SD_FRAG_LOAD
__device__ __forceinline__ void ssd_out_item(const int chain, const int c, const bf16_t* __restrict__ Pm, const bf16_t* __restrict__ XBb, const bf16_t* __restrict__ XTg, const float Aa, const float dtb,
                                             const bf16_t* __restrict__ SSTb, float* __restrict__ Yout, unsigned char* shm, const int tid) {
    const int dir = chain & 1, h = (chain >> 1) & 7, b = chain >> 4, grp = h >> 2, lane = tid & 63, w = tid >> 6;
    bf16_t* Cs = (bf16_t*)shm; bf16_t* Bs = (bf16_t*)(shm + 17408); bf16_t* XT = (bf16_t*)(shm + 34816); bf16_t* Sin = (bf16_t*)(shm + 44032); bf16_t* Gs = (bf16_t*)(shm + 61440);
    float* sc = (float*)(shm + 70656);
    __syncthreads();
#pragma unroll
    for (int i = 0; i < 2; ++i) { const int pid = tid + i * 512; const int s = pid >> 4, x0 = (pid & 15) * 8; const size_t toks = (size_t)step_tok(b, dir, c * 64 + s);
        *(u32x4*)(Bs + s * 136 + x0) = *(const u32x4*)(XBb + toks * 1024 + 512 + grp * 128 + x0);
        *(u32x4*)(Cs + s * 136 + x0) = *(const u32x4*)(XBb + toks * 1024 + 768 + grp * 128 + x0);
        const int p = pid >> 4;
        *(u32x4*)(Sin + p * 136 + x0) = *(const u32x4*)(SSTb + ((size_t)(chain * 68 + c) * 64 + p) * 128 + x0); }
    {   const int p = tid >> 3, o = tid & 7;
        const u32x4 vv = *(const u32x4*)(XTg + ((size_t)tokblock_of(b, dir, c) * 512 + h * 64 + p) * 64 + (dir ? 7 - o : o) * 8);
        *(u32x4*)(XT + p * 72 + o * 8) = dir ? rev8h(vv) : vv; }
    if (w == 0) { const size_t tokl = (size_t)step_tok(b, dir, c * 64 + lane);
        const float xv = bf2f(Pm[tokl * LDP + SSD_OFF + 1536 + dir * 8 + h]) + dtb; const float dtv = xv > 20.f ? xv : log1pf(expf(xv));
        sc[lane] = wave_scan_incl(dtv * Aa, lane); sc[64 + lane] = dtv; }
    __syncthreads();
    {   const int lt = w >> 1;
        f32x4 aG[2] = {(f32x4){0.f, 0.f, 0.f, 0.f}, (f32x4){0.f, 0.f, 0.f, 0.f}};
#pragma unroll
        for (int ks = 0; ks < 4; ++ks) { const bf16x8 af = *(const bf16x8*)(Cs + (16 * lt + (lane & 15)) * 136 + ks * 32 + (lane >> 4) * 8);
#pragma unroll
            for (int i = 0; i < 2; ++i) { const int st = (w & 1) * 2 + i; const bf16x8 bfr = *(const bf16x8*)(Bs + (16 * st + (lane & 15)) * 136 + ks * 32 + (lane >> 4) * 8);
                aG[i] = __builtin_amdgcn_mfma_f32_16x16x32_bf16(af, bfr, aG[i], 0, 0, 0); } }
#pragma unroll
        for (int i = 0; i < 2; ++i) { const int s = 16 * ((w & 1) * 2 + i) + (lane & 15); const float css = sc[s], dts = sc[64 + s];
#pragma unroll
            for (int q = 0; q < 4; ++q) { const int t = 16 * lt + (lane >> 4) * 4 + q; const float val = (s <= t) ? aG[i][q] * expf(sc[t] - css) * dts : 0.f; Gs[t * 72 + s] = f2bf(val); } }
    }
    __syncthreads();
    {   const int lt = w >> 1;
        f32x4 aY[2] = {(f32x4){0.f, 0.f, 0.f, 0.f}, (f32x4){0.f, 0.f, 0.f, 0.f}};
#pragma unroll
        for (int ks = 0; ks < 4; ++ks) { const bf16x8 af = *(const bf16x8*)(Cs + (16 * lt + (lane & 15)) * 136 + ks * 32 + (lane >> 4) * 8);
#pragma unroll
            for (int i = 0; i < 2; ++i) { const int pt = (w & 1) * 2 + i; const bf16x8 bfr = *(const bf16x8*)(Sin + (16 * pt + (lane & 15)) * 136 + ks * 32 + (lane >> 4) * 8);
                aY[i] = __builtin_amdgcn_mfma_f32_16x16x32_bf16(af, bfr, aY[i], 0, 0, 0); } }
#pragma unroll
        for (int q = 0; q < 4; ++q) { const float ec = expf(sc[16 * lt + (lane >> 4) * 4 + q]); aY[0][q] *= ec; aY[1][q] *= ec; }
#pragma unroll
        for (int ks = 0; ks < 2; ++ks) { const bf16x8 af = *(const bf16x8*)(Gs + (16 * lt + (lane & 15)) * 72 + ks * 32 + (lane >> 4) * 8);
#pragma unroll
            for (int i = 0; i < 2; ++i) { const int pt = (w & 1) * 2 + i; const bf16x8 bfr = *(const bf16x8*)(XT + (16 * pt + (lane & 15)) * 72 + ks * 32 + (lane >> 4) * 8);
                aY[i] = __builtin_amdgcn_mfma_f32_16x16x32_bf16(af, bfr, aY[i], 0, 0, 0); } }
#pragma unroll
        for (int q = 0; q < 4; ++q) { const int t = 16 * lt + (lane >> 4) * 4 + q; const size_t tokt = (size_t)step_tok(b, dir, c * 64 + t);
#pragma unroll
            for (int i = 0; i < 2; ++i) { const int p = 16 * ((w & 1) * 2 + i) + (lane & 15); Yout[tokt * BW + h * 64 + p] = aY[i][q]; } }
    }
}


#define FIDX(i) ((i) + ((i) >> 4))
#define FFT_X_BYTES 69632
template <int R, bool INV>
__device__ __forceinline__ void fft_pass(float2* __restrict__ X, const float2* __restrict__ TW, const int s0, const int gidx) {
    const int lowbits = 13 - s0 - R; const int stride = 1 << lowbits;
    const int low = gidx & (stride - 1), high = gidx >> lowbits; const int base = (high << (lowbits + R)) | low;
    static_assert(13 - 0 - R >= 0, "radix");
    const int p0 = FIDX(base);
#define FFT_SLOT(k) (lowbits >= 4 ? p0 + (k) * (stride + (stride >> 4)) : p0 + (k) + ((k) >> 4))
    float2 v[1 << R];
#pragma unroll
    for (int k = 0; k < (1 << R); ++k) v[k] = X[FFT_SLOT(k)];
    if (!INV) {
#pragma unroll
        for (int j = 0; j < R; ++j) { const int hk = 1 << (R - 1 - j);
#pragma unroll
            for (int k = 0; k < (1 << R); ++k) if (!(k & hk)) { const int kk = k & (hk - 1); const int m = (low + stride * kk) << (s0 + j);
                const float2 a = v[k], b = v[k + hk], w = TW[m]; v[k] = make_float2(a.x + b.x, a.y + b.y); const float dx = a.x - b.x, dy = a.y - b.y; v[k + hk] = make_float2(dx * w.x - dy * w.y, dx * w.y + dy * w.x); } }
    } else {
#pragma unroll
        for (int j = R - 1; j >= 0; --j) { const int hk = 1 << (R - 1 - j);
#pragma unroll
            for (int k = 0; k < (1 << R); ++k) if (!(k & hk)) { const int kk = k & (hk - 1); const int m = (low + stride * kk) << (s0 + j);
                const float2 a = v[k], b = v[k + hk], w = TW[m]; const float tx = b.x * w.x + b.y * w.y, ty = b.y * w.x - b.x * w.y;
                v[k] = make_float2(a.x + tx, a.y + ty); v[k + hk] = make_float2(a.x - tx, a.y - ty); } }
    }
#pragma unroll
    for (int k = 0; k < (1 << R); ++k) X[FFT_SLOT(k)] = v[k];
#undef FFT_SLOT
}
__device__ __forceinline__ void fft_fwd(float2* X, const float2* TW, const int tid) {
    fft_pass<4, false>(X, TW, 0, tid); __syncthreads(); fft_pass<4, false>(X, TW, 4, tid); __syncthreads(); if (tid < 256) fft_pass<5, false>(X, TW, 8, tid); __syncthreads(); }
__device__ __forceinline__ void fft_inv(float2* X, const float2* TW, const int tid) {
    if (tid < 256) fft_pass<5, true>(X, TW, 8, tid); __syncthreads(); fft_pass<4, true>(X, TW, 4, tid); __syncthreads(); fft_pass<4, true>(X, TW, 0, tid); __syncthreads(); }
__device__ __forceinline__ void fft_twiddles(float2* TW, const int tid) {
#pragma unroll
    for (int k = 0; k < 8; ++k) { const int m = tid + k * 512; const float xx = (float)m * (1.0f / 4096.0f); TW[m] = make_float2(cospif(xx), -sinpif(xx)); }
}
__device__ __forceinline__ void hyena_spec_item(const int oc, const float* __restrict__ HR, const float* __restrict__ nrm, float2* __restrict__ HSPEC, unsigned char* shm, const int tid) {
    float2* X = (float2*)shm; const float2* TW = (const float2*)(shm + FFT_X_BYTES);
    const int o = oc >> 9, c = oc & 511; const float inv = 1.0f / nrm[oc];
    __syncthreads();
#pragma unroll 2
    for (int k = 0; k < 16; ++k) { const int j = tid + k * 512; float v;
        if (j < SEQ) v = HR[(unsigned)j * 2048u + o * 1024 + c] * inv; else if (j == SEQ) v = 0.f; else v = HR[(unsigned)(2 * SEQ - j) * 2048u + o * 1024 + 512 + c] * inv;
        X[FIDX(j)] = make_float2(v, 0.f); }
    __syncthreads();
    fft_fwd(X, TW, tid);
    float4* out = (float4*)(HSPEC + (size_t)oc * 8192 + tid * 16); const float2* xs = X + 17 * tid;
#pragma unroll
    for (int k = 0; k < 8; ++k) { const float2 x0 = xs[2 * k], x1 = xs[2 * k + 1]; out[k] = make_float4(x0.x * (1.0f / 8192.0f), x0.y * (1.0f / 8192.0f), x1.x * (1.0f / 8192.0f), x1.y * (1.0f / 8192.0f)); }
}
__device__ __forceinline__ void fft_mul_spec(float2* X, const float2* __restrict__ H, const int tid) {
    const float4* h4 = (const float4*)(H + tid * 16); float2* xs = X + 17 * tid;
#pragma unroll
    for (int k = 0; k < 8; ++k) { const float4 hv = h4[k]; const float2 x0 = xs[2 * k], x1 = xs[2 * k + 1];
        xs[2 * k] = make_float2(x0.x * hv.x - x0.y * hv.y, x0.x * hv.y + x0.y * hv.x); xs[2 * k + 1] = make_float2(x1.x * hv.z - x1.y * hv.w, x1.x * hv.w + x1.y * hv.z); }
}
__device__ __forceinline__ void hyena_fft_item(const int item, const float* __restrict__ UT, const float2* __restrict__ HSPEC, const float* __restrict__ bias, float* __restrict__ YT, unsigned char* shm, const int tid) {
    float2* X = (float2*)shm; const float2* TW = (const float2*)(shm + FFT_X_BYTES);
    const int c = item >> 1, b0 = (item & 1) * 2, b1 = b0 + 1;
    const float* u0 = UT + (size_t)(b0 * 1536 + c) * SEQ + tid * 8; const float* u1 = UT + (size_t)(b1 * 1536 + c) * SEQ + tid * 8;
    const float bias0 = bias[c], bias1 = bias[512 + c];
    float2* xs = X + FIDX(8 * tid);
    float vr[8], vi[8];
    __syncthreads();
    { const float4 a0 = *(const float4*)u0, a1 = *(const float4*)(u0 + 4), c0 = *(const float4*)u1, c1 = *(const float4*)(u1 + 4);
      vr[0] = a0.x; vr[1] = a0.y; vr[2] = a0.z; vr[3] = a0.w; vr[4] = a1.x; vr[5] = a1.y; vr[6] = a1.z; vr[7] = a1.w;
      vi[0] = c0.x; vi[1] = c0.y; vi[2] = c0.z; vi[3] = c0.w; vi[4] = c1.x; vi[5] = c1.y; vi[6] = c1.z; vi[7] = c1.w; }
#pragma unroll
    for (int k = 0; k < 8; ++k) { xs[k] = make_float2(vr[k], vi[k]); xs[4352 + k] = make_float2(0.f, 0.f); }
    __syncthreads();
    fft_fwd(X, TW, tid);
    fft_mul_spec(X, HSPEC + (size_t)c * 8192, tid);
    __syncthreads();
    fft_inv(X, TW, tid);
    { const float* p0 = u0 + (size_t)512 * SEQ; const float* p1 = u1 + (size_t)512 * SEQ;
      const float4 a0 = *(const float4*)p0, a1 = *(const float4*)(p0 + 4), c0 = *(const float4*)p1, c1 = *(const float4*)(p1 + 4);
      const float xr[8] = {a0.x, a0.y, a0.z, a0.w, a1.x, a1.y, a1.z, a1.w}, xi[8] = {c0.x, c0.y, c0.z, c0.w, c1.x, c1.y, c1.z, c1.w};
#pragma unroll
      for (int k = 0; k < 8; ++k) { const float2 cv = xs[k]; const float zr = xr[k] * (cv.x + bias0 * vr[k]), zi = xi[k] * (cv.y + bias0 * vi[k]);
          vr[k] = zr; vi[k] = zi; xs[k] = make_float2(zr, zi); xs[4352 + k] = make_float2(0.f, 0.f); } }
    __syncthreads();
    fft_fwd(X, TW, tid);
    fft_mul_spec(X, HSPEC + (size_t)(512 + c) * 8192, tid);
    __syncthreads();
    fft_inv(X, TW, tid);
    { const float* p0 = u0 + (size_t)1024 * SEQ; const float* p1 = u1 + (size_t)1024 * SEQ;
      const float4 a0 = *(const float4*)p0, a1 = *(const float4*)(p0 + 4), c0 = *(const float4*)p1, c1 = *(const float4*)(p1 + 4);
      const float xr[8] = {a0.x, a0.y, a0.z, a0.w, a1.x, a1.y, a1.z, a1.w}, xi[8] = {c0.x, c0.y, c0.z, c0.w, c1.x, c1.y, c1.z, c1.w};
      float yr[8], yi[8];
#pragma unroll
      for (int k = 0; k < 8; ++k) { const float2 cv = xs[k]; yr[k] = xr[k] * (cv.x + bias1 * vr[k]); yi[k] = xi[k] * (cv.y + bias1 * vi[k]); }
      float* y0 = YT + (size_t)(b0 * 512 + c) * SEQ + tid * 8; float* y1 = YT + (size_t)(b1 * 512 + c) * SEQ + tid * 8;
      *(float4*)y0 = make_float4(yr[0], yr[1], yr[2], yr[3]); *(float4*)(y0 + 4) = make_float4(yr[4], yr[5], yr[6], yr[7]);
      *(float4*)y1 = make_float4(yi[0], yi[1], yi[2], yi[3]); *(float4*)(y1 + 4) = make_float4(yi[4], yi[5], yi[6], yi[7]); }
}

constexpr size_t al256(size_t x) { return (x + 255) & ~(size_t)255; }
constexpr size_t O_BAR = 0;
constexpr size_t O_MOD = 16384;
constexpr size_t O_NORM = O_MOD + al256((size_t)2 * 5 * 6 * DM * 4);
constexpr size_t O_QCTR = O_NORM + al256((size_t)2 * 2 * 1024 * 4);
constexpr size_t O_ZERO_END = O_QCTR + 512;
constexpr size_t O_XS = O_ZERO_END;
constexpr size_t O_HB = O_XS + al256((size_t)NTOK * DM * 4);
constexpr size_t O_P = O_HB + al256((size_t)NTOK * DM * 2);
constexpr size_t O_WIN = O_P + al256((size_t)NTOK * LDP * 2);
constexpr size_t O_WBR = O_WIN + al256((size_t)LDP * DM * 2);
constexpr size_t O_WOUT = O_WBR + al256((size_t)4 * DM * BW * 2);
constexpr size_t O_WGU = O_WOUT + al256((size_t)DM * DM * 2);
constexpr size_t O_WD = O_WGU + al256((size_t)NEXP * 2 * DEXP * DM * 2);
constexpr size_t O_GLU = O_WD + al256((size_t)NEXP * DM * DEXP * 2);
constexpr size_t O_Y4 = O_GLU + al256((size_t)BW * BW * 2);
constexpr size_t O_U = O_Y4 + al256((size_t)NTOK * DM * 2);
constexpr size_t O_QKB = O_U + al256((size_t)NTOK * 1536 * 4);
constexpr size_t O_CST = O_QKB + al256((size_t)NTOK * 1024 * 2);
constexpr size_t O_NST = O_CST + al256((size_t)32 * 68 * 128 * 128 * 2);
constexpr size_t O_MST = O_NST + al256((size_t)32 * 68 * 128 * 4);
constexpr size_t O_XBC = O_MST + al256((size_t)32 * 68 * 4);
constexpr size_t O_SST = O_XBC + al256((size_t)NTOK * 1024 * 2);
constexpr size_t O_HF = O_SST + al256((size_t)64 * 68 * 64 * 128 * 2);
constexpr size_t O_YF = O_HF + al256((size_t)2 * NTOK * BW * 4);
constexpr size_t O_SF = O_YF + al256((size_t)2 * NTOK * BW * 4);
constexpr size_t O_LDT = O_SF + al256((size_t)2 * NCTX * BW * 4);
constexpr size_t O_AP = O_LDT + al256((size_t)4096 * 16);
constexpr size_t O_BBT = O_AP + al256((size_t)4096 * 33 * 8);
constexpr size_t O_KT = O_BBT + al256((size_t)4096 * 16 * 8);
constexpr size_t O_S5A = O_KT + al256((size_t)32 * 2 * 32 * 256 * 4);
constexpr size_t O_S5B = O_S5A + al256((size_t)32 * 512 * 768 * 2);
constexpr size_t O_XCTX = O_S5B + al256((size_t)32 * 512 * 768 * 2);
constexpr size_t O_Z = O_XCTX + al256((size_t)4 * 32 * 2 * 64 * 8);
constexpr size_t O_HRAW = O_Z + al256((size_t)NTOK * BW * 4);
constexpr size_t O_HSPEC = O_HRAW + al256((size_t)(SEQ + CTXL) * 2048 * 4);
constexpr size_t O_K2C = O_HSPEC + al256((size_t)1024 * 8192 * 8);
constexpr size_t O_GG = O_K2C + al256((size_t)(2 * CTXL) * 1024 * 4);
constexpr size_t O_PROBS = O_GG + al256((size_t)NTOK * BW * 2);
constexpr size_t O_ROWTOK = O_PROBS + al256((size_t)NTOK * 16 * 4);
constexpr size_t O_ROWGATE = O_ROWTOK + al256((size_t)NEXP * MOE_PAD * 4);
constexpr size_t O_INV = O_ROWGATE + al256((size_t)NEXP * MOE_PAD * 4);
constexpr size_t O_NORMP = O_INV + al256((size_t)NTOK * 16 * 4);
constexpr size_t WS_END = O_NORMP + al256((size_t)4 * 256 * 2048 * 4);
constexpr size_t O_XG = O_P;
constexpr size_t O_HID = O_P + al256((size_t)NEXP * MOE_PAD * DM * 2);
constexpr size_t O_YEXP = O_HID + al256((size_t)NEXP * MOE_PAD * DEXP * 2);
static_assert(O_YEXP + (size_t)NEXP * MOE_PAD * DM * 2 <= O_WIN, "MoE temporaries must fit inside P");
static_assert((size_t)NTOK * DM * 2 <= (size_t)NTOK * 1536 * 4, "ACCb must fit inside U");
static_assert((size_t)26214400 + (size_t)2 * 17825792 + (size_t)272 * 256 * 64 * 2 <= (size_t)NTOK * DM * 2, "strip buffers must fit inside HB");
static_assert(WS_END <= (size_t)1851000000, "workspace map exceeds the guaranteed size");

struct Args {
    const float* in[47];
    float* out; unsigned char* ws;
    int ph_lo, ph_hi;
};

__device__ __forceinline__ void conv_tile(const float* __restrict__ src, int ldsrc, int nvalid, int k0, int n0, bf16_t* __restrict__ dst, int lddst, int mode, float* T, int tid) {
    { const int n = tid & 63, kr = tid >> 6;
#pragma unroll
      for (int i = 0; i < 8; ++i) { const int k = i * 8 + kr; T[k * 65 + n] = (n0 + n < nvalid) ? src[(size_t)(k0 + k) * ldsrc + n0 + n] : 0.f; } }
    __syncthreads();
    { const int n = tid >> 3, kc = (tid & 7) * 8; const int gn = n0 + n;
      const int drow = mode == 0 ? gn : (32 * (gn >> 4) + (mode == 2 ? 16 : 0) + (gn & 15));
      u32x4 w; w.x = pk2(T[(kc + 0) * 65 + n], T[(kc + 1) * 65 + n]); w.y = pk2(T[(kc + 2) * 65 + n], T[(kc + 3) * 65 + n]);
      w.z = pk2(T[(kc + 4) * 65 + n], T[(kc + 5) * 65 + n]); w.w = pk2(T[(kc + 6) * 65 + n], T[(kc + 7) * 65 + n]);
      *(u32x4*)(dst + (size_t)drow * lddst + k0 + kc) = w; }
    __syncthreads();
}

#define IN(id) (lo <= (id) && (id) < hi)
#define SEAM(id) do { if (hi > (id) + 1) xcd_barrier(bar); } while (0)
#define PH_BEGIN int tid = threadIdx.x; asm volatile("" : "+v"(tid) :: "memory"); const int lane = tid & 63, wave = tid >> 6; (void)lane; (void)wave;

#define x_in (PT(0))
#define c_in (PT(1))
#define ctx_in (PT(2))
#define cctx_in (PT(3))
#define ada_w (PT(4))
#define ada_b (PT(5))
#define norm_mix (PT(6))
#define norm_ffn (PT(7))
#define w_in (PT(8))
#define XS ((float*)(a.ws + O_XS))
#define MOD ((float*)(a.ws + O_MOD))
#define NORM ((float*)(a.ws + O_NORM))
#define NORMP ((float*)(a.ws + O_NORMP))
#define MODl (MOD + (size_t)l * 5 * 6 * DM)
#define HB ((bf16_t*)(a.ws + O_HB))
#define P ((bf16_t*)(a.ws + O_P))
#define WIN ((bf16_t*)(a.ws + O_WIN))
#define WBR ((bf16_t*)(a.ws + O_WBR))
#define WOUT ((bf16_t*)(a.ws + O_WOUT))
#define WGU ((bf16_t*)(a.ws + O_WGU))
#define WD ((bf16_t*)(a.ws + O_WD))
#define GLU ((bf16_t*)(a.ws + O_GLU))
#define Y4 ((bf16_t*)(a.ws + O_Y4))
#define U ((float*)(a.ws + O_U))
#define ACCb ((bf16_t*)(a.ws + O_U))
#define QKB ((bf16_t*)(a.ws + O_QKB))
#define CST ((bf16_t*)(a.ws + O_CST))
#define NST ((float*)(a.ws + O_NST))
#define MST ((float*)(a.ws + O_MST))
#define XBC ((bf16_t*)(a.ws + O_XBC))
#define SSTB ((bf16_t*)(a.ws + O_SST))
#define HF ((float*)(a.ws + O_HF))
#define HBk (HF + (size_t)NTOK * BW)
#define YF ((float*)(a.ws + O_YF))
#define YB (YF + (size_t)NTOK * BW)
#define SF ((float*)(a.ws + O_SF))
#define SB (SF + (size_t)NCTX * BW)
#define LDT ((double2*)(a.ws + O_LDT))
#define APW ((float2*)(a.ws + O_AP))
#define BBT ((float2*)(a.ws + O_BBT))
#define KTB ((float*)(a.ws + O_KT))
#define S5A ((bf16_t*)(a.ws + O_S5A))
#define S5B ((bf16_t*)(a.ws + O_S5B))
#define XCTX ((float2*)(a.ws + O_XCTX))
#define S5P ((bf16_t*)(a.ws + O_HB))
#define XLOC ((float*)(a.ws + O_HB + (size_t)32 * 256 * 512 * 2))
#define KTG ((bf16_t*)(a.ws + O_HB + (size_t)26214400))
#define VTG ((bf16_t*)(a.ws + O_HB + (size_t)26214400 + (size_t)17825792))
#define BTG ((bf16_t*)(a.ws + O_HB + (size_t)26214400 + (size_t)2 * 17825792))
#define XTG ((bf16_t*)(a.ws + O_GG))
#define Z ((float*)(a.ws + O_Z))
#define HRAW ((float*)(a.ws + O_HRAW))
#define HSPEC ((float2*)(a.ws + O_HSPEC))
#define UT ((float*)(a.ws + O_U))
#define YT ((float*)(a.ws + O_Z))
#define QCTR ((int*)(a.ws + O_QCTR))
#define K2C ((float*)(a.ws + O_K2C))
#define GG ((bf16_t*)(a.ws + O_GG))
#define PROBS ((float*)(a.ws + O_PROBS))
#define ROWTOK ((int*)(a.ws + O_ROWTOK))
#define ROWGATE ((float*)(a.ws + O_ROWGATE))
#define XG ((bf16_t*)(a.ws + O_XG))
#define HID ((bf16_t*)(a.ws + O_HID))
#define YEXP ((bf16_t*)(a.ws + O_YEXP))
#define INV ((int*)(a.ws + O_INV))


__device__ __forceinline__ void moe_combine(float4 (&v)[8], const int tok, const int lane, const int* __restrict__ inv, const float* __restrict__ rowgate, const bf16_t* __restrict__ yexp, const float* __restrict__ m5) {
    float4 a[8];
#pragma unroll
    for (int i = 0; i < 8; ++i) a[i] = make_float4(0.f, 0.f, 0.f, 0.f);
    for (int e = 0; e < 16; ++e) { const int row = __builtin_amdgcn_readfirstlane(inv[tok * 16 + e]);
        if (row >= 0) { const float gt = rowgate[row]; const bf16_t* yr = yexp + (size_t)row * DM + lane * 4;
#pragma unroll
            for (int i = 0; i < 8; ++i) { const u32x2 w = *(const u32x2*)(yr + i * 256);
                a[i].x += gt * __uint_as_float(w.x << 16); a[i].y += gt * __uint_as_float(w.x & 0xFFFF0000u); a[i].z += gt * __uint_as_float(w.y << 16); a[i].w += gt * __uint_as_float(w.y & 0xFFFF0000u); } } }
#pragma unroll
    for (int i = 0; i < 8; ++i) { const float4 mm = *(const float4*)(m5 + i * 256 + lane * 4); v[i].x += mm.x * a[i].x; v[i].y += mm.y * a[i].y; v[i].z += mm.z * a[i].z; v[i].w += mm.w * a[i].w; }
}
struct CvU { const float* src; bf16_t* dst; int ldsrc, nvalid, k0, n0, lddst, mode; };
__device__ __forceinline__ void cv_load(const CvU& u, float4 (&r)[8], const int tid) {
#pragma unroll
    for (int i = 0; i < 8; ++i) { const int idx = tid + i * 512; const int k = idx >> 6, n = u.n0 + (idx & 63) * 4;
        r[i] = (n < u.nvalid) ? *(const float4*)(u.src + (size_t)(u.k0 + k) * u.ldsrc + n) : make_float4(0.f, 0.f, 0.f, 0.f); }
}
__device__ __forceinline__ void cv_stage(float* T, const float4 (&r)[8], const int tid) {
#pragma unroll
    for (int i = 0; i < 8; ++i) { const int idx = tid + i * 512; float* p = T + (idx >> 6) * 257 + (idx & 63) * 4; p[0] = r[i].x; p[1] = r[i].y; p[2] = r[i].z; p[3] = r[i].w; }
}
__device__ __forceinline__ void cv_store(const CvU& u, const float* T, const int tid) {
#pragma unroll
    for (int j = 0; j < 4; ++j) { const int o = tid + j * 512; const int kc = (o & 7) * 8, n = o >> 3; const int gn = u.n0 + n;
        const int drow = u.mode == 0 ? gn : (32 * (gn >> 4) + (u.mode == 2 ? 16 : 0) + (gn & 15));
        const float* t = T + kc * 257 + n;
        u32x4 w; w.x = pk2(t[0], t[257]); w.y = pk2(t[2 * 257], t[3 * 257]); w.z = pk2(t[4 * 257], t[5 * 257]); w.w = pk2(t[6 * 257], t[7 * 257]);
        *(u32x4*)(u.dst + (size_t)drow * u.lddst + u.k0 + kc) = w; }
}
template <int LAYER>
__device__ __forceinline__ void layer_body(const Args& a, const XcdBarrier& bar, const int lo, const int hi, const int bid, const int G, unsigned char* const shm, float* const sf, const float** const ptab) {
        constexpr int l = LAYER;
        constexpr int PB = 1 + 16 * l;
        const bool lastl = (l == 1);

        const int nPanels = lastl ? 64 : 68;
        const int M2 = nPanels * 256;

        if (IN(PB + 0)) for (int rep_ = 0; rep_ < (l == 0 ? PROBE_REPS(0) : 1); ++rep_) {
            PH_BEGIN
            {   const float* wbr = PT(40) + (size_t)l * 4 * BW * DM; const float* wout = PT(41) + (size_t)l * DM * DM;
                const float* wg = PT(43) + (size_t)l * NEXP * DM * DEXP; const float* wu = PT(44) + (size_t)l * NEXP * DM * DEXP; const float* wd = PT(45) + (size_t)l * NEXP * DEXP * DM;
                const float* wglu = PT(32) + (size_t)l * BW * BW; const float* win = w_in + (size_t)l * DM * IN_W;
                const int n_win = 32 * 55, n_br = 4 * 64, n_out = 32 * 8, n_gu = 16 * 2 * 192, n_d = 16 * 192, n_glu = 16;
                const int total = n_win + n_br + n_out + n_gu + n_d + n_glu;
#define CV_DECODE(q_, u_) do { int qq_ = (q_); \
                    if (qq_ < n_win) { u_ = CvU{win, WIN, IN_W, IN_W, (qq_ / 55) * 64, (qq_ % 55) * 256, DM, 0}; } else { qq_ -= n_win; \
                    if (qq_ < n_br) { const int k = qq_ >> 6, r = qq_ & 63; u_ = CvU{wbr + (size_t)k * BW * DM, WBR + (size_t)k * DM * BW, DM, DM, (r >> 3) * 64, (r & 7) * 256, BW, 0}; } else { qq_ -= n_br; \
                    if (qq_ < n_out) { u_ = CvU{wout, WOUT, DM, DM, (qq_ >> 3) * 64, (qq_ & 7) * 256, DM, 0}; } else { qq_ -= n_out; \
                    if (qq_ < n_gu) { const int e = qq_ / 384, r = qq_ % 384, up = r / 192, r2 = r % 192; u_ = CvU{(up ? wu : wg) + (size_t)e * DM * DEXP, WGU + (size_t)e * 2 * DEXP * DM, DEXP, DEXP, (r2 / 6) * 64, (r2 % 6) * 256, DM, 1 + up}; } else { qq_ -= n_gu; \
                    if (qq_ < n_d) { const int e = qq_ / 192, r = qq_ % 192; u_ = CvU{wd + (size_t)e * DEXP * DM, WD + (size_t)e * DM * DEXP, DM, DM, (r >> 3) * 64, (r & 7) * 256, DEXP, 0}; } else { qq_ -= n_d; \
                    u_ = CvU{wglu, GLU, BW, BW, (qq_ >> 1) * 64, (qq_ & 1) * 256, BW, 0}; } } } } } } while (0)
                __syncthreads();
                int q = bid; int buf = 0; CvU u; float4 r[8];
                if (q < total) { CV_DECODE(q, u); cv_load(u, r, tid); }
                while (q < total) {
                    float* T = sf + buf * (64 * 257);
                    cv_stage(T, r, tid);
                    __syncthreads();
                    const CvU cur = u; const int qn = q + G;
                    if (qn < total) { CV_DECODE(qn, u); cv_load(u, r, tid); }
                    cv_store(cur, T, tid);
                    buf ^= 1; q = qn;
                }
#undef CV_DECODE
                __syncthreads();
            }
            for (int set = 0; set < (lastl ? 1 : 2); ++set) {
                const int L = set ? CTXL : SEQ; float* HR = HRAW + (set ? (size_t)SEQ * 2048 : 0);
                const float* w1 = PT(11) + l * 33 * 64; const float* b1 = PT(12) + l * 64; const float* fr1 = PT(13) + l * 64; const float* w2 = PT(14) + l * 64 * 64; const float* b2 = PT(15) + l * 64;
                const float* fr2 = PT(16) + l * 64; const float* w3 = PT(17) + l * 64 * 2048; const float* decay = PT(18) + l * 2048;
                float* feats = sf; float* h1 = sf + 16 * 33; float* h2 = h1 + 16 * 64;
                float nacc[4] = {0.f, 0.f, 0.f, 0.f};
                for (int base = bid; base < L; base += 16 * G) {
                    __syncthreads();
                    for (int e = tid; e < 16 * 33; e += NTHR) { const int ti = e / 33, fi = e % 33; int t = base + ti * G; if (t > L - 1) t = L - 1;
                        float v;
                        if (fi == 0) v = (float)t / (float)(L - 1);
                        else { const int j = (fi - 1) & 15; const double fr = 1e-4 + (double)j * ((15.0 - 1e-4) / 15.0); const double ang = (2.0 * 3.14159265358979323846 / (double)L) * (double)t * fr; v = fi <= 16 ? (float)cos(ang) : (float)(-sin(ang)); }
                        feats[e] = v; }
                    __syncthreads();
                    { const int j = tid & 63, ti = tid >> 6; float s0 = b1[j], s1 = s0;
_Pragma("unroll 3")
                      for (int i = 0; i < 33; ++i) { const float wv = w1[i * 64 + j]; s0 += feats[ti * 33 + i] * wv; s1 += feats[(ti + 8) * 33 + i] * wv; }
                      const float f1 = fr1[j]; h1[ti * 64 + j] = sinf(f1 * s0); h1[(ti + 8) * 64 + j] = sinf(f1 * s1); }
                    __syncthreads();
                    { const int j = tid & 63, ti = tid >> 6; float s0 = b2[j], s1 = s0;
_Pragma("unroll 4")
                      for (int i = 0; i < 64; ++i) { const float wv = w2[i * 64 + j]; s0 += h1[ti * 64 + i] * wv; s1 += h1[(ti + 8) * 64 + i] * wv; }
                      const float f2 = fr2[j]; h2[ti * 64 + j] = sinf(f2 * s0); h2[(ti + 8) * 64 + j] = sinf(f2 * s1); }
                    __syncthreads();
                    float acc[16][4];
#pragma unroll
                    for (int ti = 0; ti < 16; ++ti) { acc[ti][0] = 0.f; acc[ti][1] = 0.f; acc[ti][2] = 0.f; acc[ti][3] = 0.f; }
#pragma unroll 2
                    for (int i = 0; i < 64; ++i) { const float* wrow = w3 + (size_t)i * 2048 + tid; const float wa = wrow[0], wb = wrow[512], wc2 = wrow[1024], wd2 = wrow[1536];
#pragma unroll
                        for (int ti = 0; ti < 16; ++ti) { const float hv = h2[ti * 64 + i]; acc[ti][0] += hv * wa; acc[ti][1] += hv * wb; acc[ti][2] += hv * wc2; acc[ti][3] += hv * wd2; } }
                    float dk[4];
#pragma unroll
                    for (int k = 0; k < 4; ++k) dk[k] = fabsf(decay[tid + k * 512]);
#pragma unroll
                    for (int ti = 0; ti < 16; ++ti) { const int t = base + ti * G; if (t < L) { const float tn = (float)t / (float)(L - 1);
#pragma unroll
                        for (int k = 0; k < 4; ++k) { const float v = acc[ti][k] * expf(-tn * dk[k]); HR[(size_t)t * 2048 + tid + k * 512] = v; nacc[k] += fabsf(v); } } }
                }
                float* nrp = NORMP + ((size_t)(l * 2 + set) * 256 + bid) * 2048;
#pragma unroll
                for (int k = 0; k < 4; ++k) nrp[tid + k * 512] = nacc[k];
            }
            for (int idx = bid * NTHR + tid; idx < 4096; idx += G * NTHR) { const int n = idx & 63, g = (idx >> 6) & 31, dir = idx >> 11;
                const double are = (double)(PT(24) + l * 4096)[idx], aim = (double)(PT(25) + l * 4096)[idx]; const double lam = are < -1e-4 ? are : -1e-4; const double dt = exp((double)(PT(26) + l * 64)[dir * 32 + g]);
                const double ldre = lam * dt, ldim = aim * dt; LDT[idx] = make_double2(ldre, ldim);
                const double mag = exp(ldre); const double ar = mag * cos(ldim), ai = mag * sin(ldim);
                const double den = lam * lam + aim * aim; const double nr = ar - 1.0, ni = ai; const double fre = (nr * lam + ni * aim) / den, fim = (ni * lam - nr * aim) / den;
                const float* b_re = PT(27) + l * 32 * 64 * 16; const float* b_im = PT(28) + l * 32 * 64 * 16;
#pragma unroll 4
                for (int c = 0; c < 16; ++c) { const double br = (double)b_re[(g * 64 + n) * 16 + c], bi = (double)b_im[(g * 64 + n) * 16 + c]; BBT[idx * 16 + c] = make_float2((float)(fre * br - fim * bi), (float)(fre * bi + fim * br)); }
#pragma unroll 1
                for (int k = 0; k <= 32; ++k) { const double mk = exp(ldre * k); APW[idx * 33 + k] = make_float2((float)(mk * cos(ldim * k)), (float)(mk * sin(ldim * k))); }
            }
            if (l == 0 && lo == 0) xcd_barrier(bar);
            for (int tok = bid * 8 + wave; tok < NTOK; tok += G * 8) {
                const int r = tok < NLAT ? tok / SEQ : 4; const float* xr = l == 0 ? (tok < NLAT ? x_in + (size_t)tok * DM : ctx_in + (size_t)(tok - NLAT) * DM) : XS + (size_t)tok * DM; const float* gn = norm_mix + l * DM;
                const float* sh = MODl + (size_t)(r * 6 + 0) * DM; const float* sc = MODl + (size_t)(r * 6 + 1) * DM;
                float4 v[8]; float ss = 0.f;
#pragma unroll
                for (int i = 0; i < 8; ++i) v[i] = *(const float4*)(xr + i * 256 + lane * 4);
                if (l > 0) {
                    moe_combine(v, tok, lane, INV, ROWGATE, YEXP, MOD + (size_t)((l - 1) * 5 + r) * 6 * DM + 5 * DM);
#pragma unroll
                    for (int i = 0; i < 8; ++i) *(float4*)(XS + (size_t)tok * DM + i * 256 + lane * 4) = v[i]; }
#pragma unroll
                for (int i = 0; i < 8; ++i) ss += v[i].x * v[i].x + v[i].y * v[i].y + v[i].z * v[i].z + v[i].w * v[i].w;
                ss = wave_sum(ss); const float rs = rsqrtf(ss * (1.0f / DM) + 1e-6f);
#pragma unroll
                for (int i = 0; i < 8; ++i) { const int d = i * 256 + lane * 4; const float4 g4 = *(const float4*)(gn + d), s4 = *(const float4*)(sc + d), h4 = *(const float4*)(sh + d);
                    u32x2 w; w.x = pk2(v[i].x * rs * g4.x * (1.f + s4.x) + h4.x, v[i].y * rs * g4.y * (1.f + s4.y) + h4.y); w.y = pk2(v[i].z * rs * g4.z * (1.f + s4.z) + h4.z, v[i].w * rs * g4.w * (1.f + s4.w) + h4.w);
                    *(u32x2*)(HB + (size_t)tok * DM + d) = w; }
            }
            SEAM(PB + 0);
        }

        if (IN(PB + 1)) for (int rep_ = 0; rep_ < PROBE_REPS(1); ++rep_) {
            PH_BEGIN
            for (int idx = bid * NTHR + tid; idx < (lastl ? 1 : 2) * 1024; idx += G * NTHR) { const int set = idx >> 10, oc = idx & 1023, o = oc >> 9, c = oc & 511;
                const float* pp = NORMP + (size_t)(l * 2 + set) * 256 * 2048 + o * 1024 + c; float sacc = 0.f;
                for (int bb = 0; bb < G; ++bb) sacc += pp[(size_t)bb * 2048] + pp[(size_t)bb * 2048 + 512];
                NORM[(size_t)(l * 2 + set) * 1024 + oc] = sacc; }
            for (int idx = bid * NTHR + tid; idx < 32768; idx += G * NTHR) { const int c = idx & 15, lag = (idx >> 4) & 31, dir = (idx >> 9) & 1, g = idx >> 10;
                const float* c_re = PT(29) + l * 32 * 16 * 64 + (g * 16 + c) * 64; const float* c_im = PT(30) + l * 32 * 16 * 64 + (g * 16 + c) * 64;
                float acc[16];
#pragma unroll
                for (int j = 0; j < 16; ++j) acc[j] = 0.f;
#pragma unroll 2
                for (int n = 0; n < 64; ++n) { const int pi = (dir * 32 + g) * 64 + n; const float2 ap = APW[pi * 33 + lag]; const float cr = c_re[n], ci = c_im[n]; const float wr_ = cr * ap.x - ci * ap.y, wi_ = cr * ap.y + ci * ap.x;
                    const float4* bb = (const float4*)(BBT + pi * 16);
#pragma unroll
                    for (int j = 0; j < 8; ++j) { const float4 b2 = bb[j]; acc[2 * j] += wr_ * b2.x - wi_ * b2.y; acc[2 * j + 1] += wr_ * b2.z - wi_ * b2.w; } }
                float4* o = (float4*)(KTB + (size_t)idx * 16);
                o[0] = make_float4(acc[0], acc[1], acc[2], acc[3]); o[1] = make_float4(acc[4], acc[5], acc[6], acc[7]); o[2] = make_float4(acc[8], acc[9], acc[10], acc[11]); o[3] = make_float4(acc[12], acc[13], acc[14], acc[15]);
            }
            __syncthreads();
            pg8::Gemm g{HB, WIN, DM, DM, DM}; pg8::SchedStd S{68, 55, G, bid, DM, DM}; pg8::EpiWin E{P, LDP};
            pg8::gemm_phase(( LAS unsigned char*)shm, g, S, E);
#if defined(PROBE_BNOEPI)
            { __syncthreads(); pg8::EpiNone E0; pg8::gemm_phase((LAS unsigned char*)shm, g, S, E0); }
#endif
            SEAM(PB + 1);
        }

        if (IN(PB + 2)) for (int rep_ = 0; rep_ < PROBE_REPS(2); ++rep_) {
            PH_BEGIN
            const float* hcw = PT(9) + l * 3 * 1536; const float* hcb = PT(10) + l * 1536; const float* mcw = PT(20) + l * 3 * 1024; const float* mcb = PT(21) + l * 1024;
            const float* scw = PT(34) + l * 3 * 1024; const float* scb = PT(35) + l * 1024;
            for (int unit = bid; unit < 272 * 3; unit += G) { const int seg = unit / 3, kind = unit % 3; const bool lat = seg < 256; const size_t tok0 = lat ? (size_t)seg * 64 : (size_t)NLAT + (size_t)(seg - 256) * 64;
                if (kind < 2) { const int hf = kind;
                    const int c = tid * 2; const int col = (hf ? SSD_OFF + 512 : ML_OFF) + c; const float* w = hf ? scw : mcw; const float* bsp = hf ? scb : mcb; bf16_t* dst = (hf ? XBC : QKB) + tok0 * 1024 + c;
                    const float2 w0 = *(const float2*)(w + c), w1 = *(const float2*)(w + 1024 + c), w2 = *(const float2*)(w + 2048 + c), bb = *(const float2*)(bsp + c);
                    const float osc = (!hf && c >= 512) ? 0.08838834764831845f : 1.0f;
                    const bool hasPrev = !lat && ((tok0 - NLAT) & (CTXL - 1)) != 0, hasNext = !lat && (((tok0 - NLAT) + 63) & (CTXL - 1)) != CTXL - 1;
                    bf16_t* strip = nullptr;
                    if (!hf) { if (c >= 512) strip = KTG + ((size_t)seg * 512 + (c - 512)) * 64; }
                    else { if (c < 512) strip = XTG + ((size_t)seg * 512 + c) * 64; else if (c < 768) strip = BTG + ((size_t)seg * 256 + (c - 512)) * 64; }
                    const bf16_t* pp = P + tok0 * LDP + col;
                    unsigned raw[66];
#pragma unroll
                    for (int t = 0; t < 66; ++t) raw[t] = ((t == 0 && !hasPrev) || (t == 65 && !hasNext)) ? 0u : *(const unsigned*)(pp + (ptrdiff_t)(t - 1) * LDP);
#pragma unroll
                    for (int t8 = 0; t8 < 8; ++t8) { float v0[8], v1[8];
#pragma unroll
                        for (int tt = 0; tt < 8; ++tt) { const int t = t8 * 8 + tt; const unsigned p0 = raw[t], p1 = raw[t + 1], p2 = raw[t + 2];
                            float a0 = bb.x + w0.x * __uint_as_float(p0 << 16) + w1.x * __uint_as_float(p1 << 16) + w2.x * __uint_as_float(p2 << 16);
                            float a1 = bb.y + w0.y * __uint_as_float(p0 & 0xFFFF0000u) + w1.y * __uint_as_float(p1 & 0xFFFF0000u) + w2.y * __uint_as_float(p2 & 0xFFFF0000u);
                            a0 = siluf_(a0) * osc; a1 = siluf_(a1) * osc; v0[tt] = a0; v1[tt] = a1;
                            *(unsigned*)(dst + (size_t)t * 1024) = pk2(a0, a1); }
                        if (strip) { u32x4 s0, s1; s0.x = pk2(v0[0], v0[1]); s0.y = pk2(v0[2], v0[3]); s0.z = pk2(v0[4], v0[5]); s0.w = pk2(v0[6], v0[7]); s1.x = pk2(v1[0], v1[1]); s1.y = pk2(v1[2], v1[3]); s1.z = pk2(v1[4], v1[5]); s1.w = pk2(v1[6], v1[7]);
                            *(u32x4*)(strip + t8 * 8) = s0; *(u32x4*)(strip + 64 + t8 * 8) = s1; } }
                } else {
                    const int c = (tid & 255) * 2, th = tid >> 8; const bf16_t* pp = P + (tok0 + th * 32) * LDP + ML_OFF + 1024 + c; bf16_t* strip = VTG + ((size_t)seg * 512 + c) * 64 + th * 32;
                    unsigned rv[32];
#pragma unroll
                    for (int t = 0; t < 32; ++t) rv[t] = *(const unsigned*)(pp + (size_t)t * LDP);
#pragma unroll
                    for (int t8 = 0; t8 < 4; ++t8) { u32x4 s0, s1;
                        s0.x = (rv[t8 * 8 + 0] & 0xFFFFu) | (rv[t8 * 8 + 1] << 16); s0.y = (rv[t8 * 8 + 2] & 0xFFFFu) | (rv[t8 * 8 + 3] << 16); s0.z = (rv[t8 * 8 + 4] & 0xFFFFu) | (rv[t8 * 8 + 5] << 16); s0.w = (rv[t8 * 8 + 6] & 0xFFFFu) | (rv[t8 * 8 + 7] << 16);
                        s1.x = (rv[t8 * 8 + 0] >> 16) | (rv[t8 * 8 + 1] & 0xFFFF0000u); s1.y = (rv[t8 * 8 + 2] >> 16) | (rv[t8 * 8 + 3] & 0xFFFF0000u); s1.z = (rv[t8 * 8 + 4] >> 16) | (rv[t8 * 8 + 5] & 0xFFFF0000u); s1.w = (rv[t8 * 8 + 6] >> 16) | (rv[t8 * 8 + 7] & 0xFFFF0000u);
                        *(u32x4*)(strip + t8 * 8) = s0; *(u32x4*)(strip + 64 + t8 * 8) = s1; }
                }
            }
            if (!lastl) for (int tok = NLAT + bid; tok < NTOK; tok += G) {
                const int t = (tok - NLAT) & (CTXL - 1); const bool hasL = (t != 0), hasR = (t != CTXL - 1); const bf16_t* pr = P + (size_t)tok * LDP;
#pragma unroll
                for (int j = 0; j < 3; ++j) { const int cc = tid + j * 512;
                    float acc = hcb[cc] + hcw[1536 + cc] * bf2f(pr[HY_OFF + cc]);
                    if (hasL) acc += hcw[cc] * bf2f(pr[HY_OFF + cc - LDP]);
                    if (hasR) acc += hcw[2 * 1536 + cc] * bf2f(pr[HY_OFF + cc + LDP]);
                    U[(size_t)tok * 1536 + cc] = acc; }
            }
            for (int idx = bid * NTHR + tid; idx < 16384 * 64; idx += G * NTHR) { const int half = idx & 1, g = (idx >> 1) & 31, tok = idx >> 6;
                *(u32x4*)(S5A + ((size_t)g * 512 + (tok >> 5)) * 768 + (tok & 31) * 16 + half * 8) = *(const u32x4*)(P + (size_t)tok * LDP + S5_OFF + g * 16 + half * 8); }
            for (int idx = bid * NTHR + tid; idx < 32 * 512 * 32 * 2; idx += G * NTHR) { const int half = idx & 1, sI = (idx >> 1) & 31, row = (idx >> 6) & 511, g = idx >> 15; const int t = row >> 4, c = row & 15; const int lag = t - sI;
                float v[8];
                if (lag > 0) { const float4* k4 = (const float4*)(KTB + ((size_t)((g * 2 + 0) * 32 + lag) * 16 + c) * 16 + half * 8); const float4 a0 = k4[0], a1 = k4[1]; v[0] = a0.x; v[1] = a0.y; v[2] = a0.z; v[3] = a0.w; v[4] = a1.x; v[5] = a1.y; v[6] = a1.z; v[7] = a1.w; }
                else if (lag < 0) { const float4* k4 = (const float4*)(KTB + ((size_t)((g * 2 + 1) * 32 - lag) * 16 + c) * 16 + half * 8); const float4 a0 = k4[0], a1 = k4[1]; v[0] = a0.x; v[1] = a0.y; v[2] = a0.z; v[3] = a0.w; v[4] = a1.x; v[5] = a1.y; v[6] = a1.z; v[7] = a1.w; }
                else { const float4* k4 = (const float4*)(KTB + ((size_t)((g * 2 + 0) * 32) * 16 + c) * 16 + half * 8); const float4* q4 = (const float4*)(KTB + ((size_t)((g * 2 + 1) * 32) * 16 + c) * 16 + half * 8); const float4 a0 = k4[0], a1 = k4[1], b0 = q4[0], b1 = q4[1];
                    v[0] = a0.x + b0.x; v[1] = a0.y + b0.y; v[2] = a0.z + b0.z; v[3] = a0.w + b0.w; v[4] = a1.x + b1.x; v[5] = a1.y + b1.y; v[6] = a1.z + b1.z; v[7] = a1.w + b1.w; }
                u32x4 w; w.x = pk2(v[0], v[1]); w.y = pk2(v[2], v[3]); w.z = pk2(v[4], v[5]); w.w = pk2(v[6], v[7]);
                *(u32x4*)(S5B + ((size_t)g * 512 + row) * 768 + sI * 16 + half * 8) = w; }
            for (int idx = bid * NTHR + tid; idx < 32 * 512 * 64; idx += G * NTHR) { const int n = idx & 63, row = (idx >> 6) & 511, g = idx >> 15; const int t = row >> 4, c = row & 15;
                const float cr = (PT(29) + l * 32 * 16 * 64)[(g * 16 + c) * 64 + n], ci = (PT(30) + l * 32 * 16 * 64)[(g * 16 + c) * 64 + n];
                const float2 af = APW[((0 * 32 + g) * 64 + n) * 33 + t + 1], ab = APW[((1 * 32 + g) * 64 + n) * 33 + 32 - t];
                bf16_t* d = S5B + ((size_t)g * 512 + row) * 768 + 512 + 2 * n;
                *(unsigned*)d = pk2(cr * af.x - ci * af.y, -(cr * af.y + ci * af.x)); *(unsigned*)(d + 128) = pk2(cr * ab.x - ci * ab.y, -(cr * ab.y + ci * ab.x)); }
            for (int idx = bid * NTHR + tid; idx < 32 * 2 * 64 * 32; idx += G * NTHR) { const int sI = idx & 31, n = (idx >> 5) & 63, dir = (idx >> 11) & 1, g = idx >> 12; const int pi = (dir * 32 + g) * 64 + n;
                const float2 pw = APW[pi * 33 + (dir ? sI : 31 - sI)]; const float4* bb = (const float4*)(BBT + pi * 16);
                float re[16], im[16];
#pragma unroll
                for (int j = 0; j < 8; ++j) { const float4 b2 = bb[j]; re[2 * j] = pw.x * b2.x - pw.y * b2.y; im[2 * j] = pw.x * b2.y + pw.y * b2.x; re[2 * j + 1] = pw.x * b2.z - pw.y * b2.w; im[2 * j + 1] = pw.x * b2.w + pw.y * b2.z; }
                bf16_t* d = S5P + ((size_t)g * 256 + dir * 128 + 2 * n) * 512 + sI * 16;
                u32x4 w0, w1; w0.x = pk2(re[0], re[1]); w0.y = pk2(re[2], re[3]); w0.z = pk2(re[4], re[5]); w0.w = pk2(re[6], re[7]); w1.x = pk2(re[8], re[9]); w1.y = pk2(re[10], re[11]); w1.z = pk2(re[12], re[13]); w1.w = pk2(re[14], re[15]);
                *(u32x4*)d = w0; *(u32x4*)(d + 8) = w1;
                w0.x = pk2(im[0], im[1]); w0.y = pk2(im[2], im[3]); w0.z = pk2(im[4], im[5]); w0.w = pk2(im[6], im[7]); w1.x = pk2(im[8], im[9]); w1.y = pk2(im[10], im[11]); w1.z = pk2(im[12], im[13]); w1.w = pk2(im[14], im[15]);
                *(u32x4*)(d + 512) = w0; *(u32x4*)(d + 520) = w1; }
            {   float* T = sf;
                for (int unit = bid; unit < 4 * 64 * 24; unit += G) { const int b = unit / (64 * 24), r = (unit / 24) % 64, c0 = (unit % 24) * 64; const size_t tok0 = (size_t)b * SEQ + r * 64;
                    __syncthreads();
#pragma unroll
                    for (int i = 0; i < 8; ++i) { const int c = tid & 63, t = (tid >> 6) + 8 * i; T[t * 65 + c] = bf2f(P[(tok0 + t) * LDP + HY_OFF + c0 + c]); }
                    __syncthreads();
                    const int c = tid >> 3, tq = (tid & 7) * 8, cc = c0 + c; const float w0 = hcw[cc], w1 = hcw[1536 + cc], w2 = hcw[3072 + cc], bb = hcb[cc];
                    float o8[8];
#pragma unroll
                    for (int i = 0; i < 8; ++i) { const int t = tq + i; float acc = bb + w1 * T[t * 65 + c]; if (t > 0) acc += w0 * T[(t - 1) * 65 + c]; if (t < 63) acc += w2 * T[(t + 1) * 65 + c]; o8[i] = acc; }
                    float* dst = UT + ((size_t)b * 1536 + cc) * SEQ + r * 64 + tq;
                    *(float4*)dst = make_float4(o8[0], o8[1], o8[2], o8[3]); *(float4*)(dst + 4) = make_float4(o8[4], o8[5], o8[6], o8[7]);
                } }
            if (!lastl) {
                const int L = CTXL; const float* HR = HRAW + (size_t)SEQ * 2048; float* K2 = K2C; const float* nrm = NORM + (size_t)(l * 2 + 1) * 1024;
                const size_t total = (size_t)(2 * L - 1) * 1024;
                for (size_t i = (size_t)bid * NTHR + tid; i < total; i += (size_t)G * NTHR) { const int j = (int)(i >> 10), oc = (int)(i & 1023), o = oc >> 9, c = oc & 511; const int lag = j - (L - 1);
                    const float v = lag >= 0 ? HR[(size_t)lag * 2048 + o * 1024 + c] : HR[(size_t)(-lag) * 2048 + o * 1024 + 512 + c];
                    K2[((size_t)j * 2 + o) * 512 + c] = v / nrm[oc]; }
            }
            {   __syncthreads(); fft_twiddles((float2*)(shm + FFT_X_BYTES), tid);
                for (int oc = bid; oc < 1024; oc += G) hyena_spec_item(oc, HRAW, NORM + (size_t)(l * 2 + 0) * 1024, HSPEC, shm, tid);
                __syncthreads(); }
            SEAM(PB + 2);
        }

        if (IN(PB + 3)) for (int rep_ = 0; rep_ < PROBE_REPS(3); ++rep_) {
            PH_BEGIN
            if (rep_ > 0) { if (bid == 0 && tid == 0) __hip_atomic_store(QCTR + l * 64, 0, __ATOMIC_RELAXED, __HIP_MEMORY_SCOPE_AGENT); xcd_barrier(bar); }
            if (bid < 32) {
                for (int rp_ = 0; rp_ < PROBE_SP; ++rp_) mlstm_state_pass(bid, P, KTG, VTG, PT(22) + l * 16, CST, NST, MST, shm, tid);
            } else if (bid < 96) {
                { const int ch = bid - 32; const int dir_ = ch & 1, h_ = (ch >> 1) & 7; for (int rp_ = 0; rp_ < PROBE_SP; ++rp_) ssd_state_pass(ch, P, BTG, XTG, -expf(PT(37)[l * 16 + dir_ * 8 + h_]), PT(36)[l * 16 + dir_ * 8 + h_], SSTB, shm, tid); }
            } else if (bid < 128) {
                const int widx = (bid - 96) * 8 + wave; const int dir = widx & 1, g = (widx >> 1) & 31, b = widx >> 6; const int n = lane;
                float2* xb = (float2*)(shm + (size_t)wave * 16640); float2* ctab = xb + 16 * 65;
                const float* a_re = PT(24) + l * 2 * 32 * 64; const float* a_im = PT(25) + l * 2 * 32 * 64; const float* log_dt = PT(26) + l * 64;
                const float* b_re = PT(27) + l * 32 * 64 * 16; const float* b_im = PT(28) + l * 32 * 64 * 16; const float* c_re = PT(29) + l * 32 * 16 * 64; const float* c_im = PT(30) + l * 32 * 16 * 64;
#pragma unroll
                for (int c = 0; c < 16; ++c) ctab[c * 65 + lane] = make_float2(c_re[(g * 16 + c) * 64 + lane], c_im[(g * 16 + c) * 64 + lane]);
                float abr, abi, bbr[16], bbi[16];
                {   const double are = (double)a_re[(dir * 32 + g) * 64 + n], aim = (double)a_im[(dir * 32 + g) * 64 + n];
                    const double lam = are < -1e-4 ? are : -1e-4; const double dt = exp((double)log_dt[dir * 32 + g]);
                    const double mag = exp(lam * dt); const double ar = mag * cos(aim * dt), ai = mag * sin(aim * dt);
                    const double den = lam * lam + aim * aim; const double nr = ar - 1.0, ni = ai;
                    const double fre = (nr * lam + ni * aim) / den, fim = (ni * lam - nr * aim) / den;
                    abr = (float)ar; abi = (float)ai;
#pragma unroll
                    for (int c = 0; c < 16; ++c) { const double br = (double)b_re[(g * 64 + n) * 16 + c], bi = (double)b_im[(g * 64 + n) * 16 + c]; bbr[c] = (float)(fre * br - fim * bi); bbi[c] = (float)(fre * bi + fim * br); }
                }
                float xr = 0.f, xi = 0.f; float* Sout = (dir ? SB : SF) - (size_t)NLAT * BW;
                const int s = lane >> 2, cg = lane & 3;
                for (int i0 = 0; i0 < CTXL; i0 += 16) {
#pragma unroll 4
                    for (int ss = 0; ss < 16; ++ss) {
                        const size_t tok = (size_t)step_tok(b, dir, i0 + ss);
                        const u32x4* up = (const u32x4*)(P + tok * LDP + S5_OFF + g * 16);
                        float t0[8], t1[8]; unpack8(up[0], t0); unpack8(up[1], t1);
                        float bur = 0.f, bui = 0.f;
#pragma unroll
                        for (int c = 0; c < 8; ++c) { bur += t0[c] * bbr[c] + t1[c] * bbr[8 + c]; bui += t0[c] * bbi[c] + t1[c] * bbi[8 + c]; }
                        const float nxr = abr * xr - abi * xi + bur, nxi = abr * xi + abi * xr + bui; xr = nxr; xi = nxi;
                        xb[ss * 65 + lane] = make_float2(xr, xi);
                    }
                    asm volatile("s_waitcnt lgkmcnt(0)" ::: "memory");
                    float y0 = 0.f, y1 = 0.f, y2 = 0.f, y3 = 0.f;
                    for (int nn2 = 0; nn2 < 64; ++nn2) { const float2 xv = xb[s * 65 + nn2];
                        const float2 c0 = ctab[(cg * 4 + 0) * 65 + nn2], c1 = ctab[(cg * 4 + 1) * 65 + nn2], c2 = ctab[(cg * 4 + 2) * 65 + nn2], c3 = ctab[(cg * 4 + 3) * 65 + nn2];
                        y0 += xv.x * c0.x - xv.y * c0.y; y1 += xv.x * c1.x - xv.y * c1.y; y2 += xv.x * c2.x - xv.y * c2.y; y3 += xv.x * c3.x - xv.y * c3.y; }
                    const size_t toks = (size_t)step_tok(b, dir, i0 + s);
                    *(float4*)(Sout + toks * BW + g * 16 + cg * 4) = make_float4(y0, y1, y2, y3);
                    asm volatile("s_waitcnt lgkmcnt(0)" ::: "memory");
                }
                XCTX[((b * 32 + g) * 2 + dir) * 64 + n] = make_float2(xr, xi);
            } else {
                if (bid < 192) {
                    pg8::Gemm gg_{S5A, S5P, 768, 512, 512}; pg8::SchedS5a S_{bid - 128}; pg8::EpiXloc E_{XLOC};
                    pg8::gemm_phase((LAS unsigned char*)shm, gg_, S_, E_);
                    __syncthreads();
                }
                const int nhb = G - 128, hb = bid - 128; const float* bias = PT(19) + l * 1024; const int c = tid;
                const int nitems = lastl ? 0 : 4 * (CTXL / 8);
                for (int it = hb; it < nitems; it += nhb) {
                    int L, tokbase, b, t0; const float* K2;
                    { const int q = it; L = CTXL; tokbase = NLAT; b = q / (CTXL / 8); t0 = (q % (CTXL / 8)) * 8; K2 = K2C; }
                    const float* zb = U + (size_t)(tokbase + b * L) * 1536 + c;
                    float acc[8];
#pragma unroll
                    for (int i = 0; i < 8; ++i) acc[i] = 0.f;
                    const int base = t0 + L - 1;
                    for (int s = 0; s < L; s += 8) {
                        float k[15];
#pragma unroll
                        for (int mm = 0; mm < 15; ++mm) k[mm] = K2[((size_t)(base - s - 7 + mm) * 2 + 0) * 512 + c];
#pragma unroll
                        for (int ds = 0; ds < 8; ++ds) { const float z = zb[(size_t)(s + ds) * 1536];
#pragma unroll
                            for (int i = 0; i < 8; ++i) acc[i] += k[i - ds + 7] * z; }
                    }
#pragma unroll
                    for (int i = 0; i < 8; ++i) { const size_t tok = (size_t)(tokbase + b * L + t0 + i); const float zt = U[tok * 1536 + c]; Z[tok * BW + c] = (acc[i] + bias[c] * zt) * U[tok * 1536 + 512 + c]; }
                }
            }
            {   __syncthreads(); fft_twiddles((float2*)(shm + FFT_X_BYTES), tid);
                int* qslot = (int*)(shm + FFT_X_BYTES + 32768);
                for (;;) { __syncthreads(); if (tid == 0) *qslot = atomicAdd(QCTR + l * 64, 1); __syncthreads(); const int it = *qslot; if (it >= 1024) break;
                    hyena_fft_item(it, UT, HSPEC, PT(19) + l * 1024, YT, shm, tid); }
            }
            SEAM(PB + 3);
        }

        if (IN(PB + 4)) for (int rep_ = 0; rep_ < PROBE_REPS(4); ++rep_) {
            PH_BEGIN
            if (rep_ > 0) { if (bid == 0 && tid == 0) __hip_atomic_store(QCTR + l * 64 + 32, 0, __ATOMIC_RELAXED, __HIP_MEMORY_SCOPE_AGENT); xcd_barrier(bar); }
            if (bid >= G - 32) for (int idx = (bid - (G - 32)) * NTHR + tid; idx < 16384; idx += 32 * NTHR) { const int n = idx & 63, dir = (idx >> 6) & 1, b = (idx >> 7) & 3, g = idx >> 9;
                const float2 a32 = APW[((dir * 32 + g) * 64 + n) * 33 + 32]; float2 X = XCTX[((b * 32 + g) * 2 + dir) * 64 + n];
                const float* __restrict__ xl = XLOC + ((size_t)g * 512 + b * 128) * 256 + dir * 128 + 2 * n; bf16_t* __restrict__ dst = S5A + ((size_t)g * 512 + b * 128) * 768 + 512 + dir * 128 + 2 * n;
#pragma unroll 8
                for (int jj = 0; jj < 128; ++jj) { const int j = dir ? 127 - jj : jj; const float2 xv = *(const float2*)(xl + (size_t)j * 256);
                    *(unsigned*)(dst + (size_t)j * 768) = pk2(X.x, X.y);
                    const float nx = a32.x * X.x - a32.y * X.y + xv.x, ny = a32.x * X.y + a32.y * X.x + xv.y; X.x = nx; X.y = ny; } }
            {   int* qslot = (int*)(shm + 102400);
                for (;;) { __syncthreads(); if (tid == 0) *qslot = atomicAdd(QCTR + l * 64 + 32, 1); __syncthreads(); const int it = *qslot; if (it >= 32 * 68 + 64 * 68) break;
                    if (it < 32 * 68) { const int chain = it / 68, c = it % 68; mlstm_out_item(chain, c, P, QKB, VTG, PT(22) + l * 16, CST, NST, MST, (chain & 1) ? HBk : HF, shm, tid); }
                    else { const int i2 = it - 32 * 68; const int chain = i2 / 68, c = i2 % 68; const int dir_ = chain & 1, h_ = (chain >> 1) & 7;
                        ssd_out_item(chain, c, P, XBC, XTG, -expf(PT(37)[l * 16 + dir_ * 8 + h_]), PT(36)[l * 16 + dir_ * 8 + h_], SSTB, dir_ ? YB : YF, shm, tid); } }
            }
            __syncthreads();
            {   const float* bias = PT(19) + l * 1024 + 512; const int c = tid;
                const int nitems = lastl ? 0 : 4 * (CTXL / 8);
                for (int it = bid; it < nitems; it += G) {
                    int L, tokbase, b, t0; const float* K2;
                    { const int q = it; L = CTXL; tokbase = NLAT; b = q / (CTXL / 8); t0 = (q % (CTXL / 8)) * 8; K2 = K2C; }
                    const float* zb = Z + (size_t)(tokbase + b * L) * BW + c;
                    float acc[8];
#pragma unroll
                    for (int i = 0; i < 8; ++i) acc[i] = 0.f;
                    const int base = t0 + L - 1;
                    for (int s = 0; s < L; s += 8) {
                        float k[15];
#pragma unroll
                        for (int mm = 0; mm < 15; ++mm) k[mm] = K2[((size_t)(base - s - 7 + mm) * 2 + 1) * 512 + c];
#pragma unroll
                        for (int ds = 0; ds < 8; ++ds) { const float z = zb[(size_t)(s + ds) * BW];
#pragma unroll
                            for (int i = 0; i < 8; ++i) acc[i] += k[i - ds + 7] * z; }
                    }
#pragma unroll
                    for (int i = 0; i < 8; ++i) { const size_t tok = (size_t)(tokbase + b * L + t0 + i); const float zt = Z[tok * BW + c]; Y4[tok * DM + c] = f2bf((acc[i] + bias[c] * zt) * U[tok * 1536 + 1024 + c]); }
                }
            }
            SEAM(PB + 4);
        }

        if (IN(PB + 5)) for (int rep_ = 0; rep_ < PROBE_REPS(5); ++rep_) {
            PH_BEGIN
            const float* ml_norm = PT(23) + l * BW; const float* ssd_d = PT(38) + l * 8; const float* ssd_norm = PT(39) + l * BW; const float* s5_d = PT(31) + l * BW;
            if (bid < 128) {
                pg8::Gemm gg_{S5A, S5B, 768, 768, 768}; pg8::SchedS5b S_{bid}; pg8::EpiS5Out E_{P, s5_d, GG};
                pg8::gemm_phase((LAS unsigned char*)shm, gg_, S_, E_);
                __syncthreads();
            }
            for (int tok = bid * 8 + wave; tok < NTOK; tok += G * 8) {
                const int c0 = lane * 8; const bf16_t* pr = P + (size_t)tok * LDP; const size_t o5 = (size_t)tok * BW + c0;
                float hm[8], ys[8];
                { const float4 a0 = *(const float4*)(HF + o5), a1 = *(const float4*)(HF + o5 + 4), b0 = *(const float4*)(HBk + o5), b1 = *(const float4*)(HBk + o5 + 4);
                  hm[0] = a0.x + b0.x; hm[1] = a0.y + b0.y; hm[2] = a0.z + b0.z; hm[3] = a0.w + b0.w; hm[4] = a1.x + b1.x; hm[5] = a1.y + b1.y; hm[6] = a1.z + b1.z; hm[7] = a1.w + b1.w; }
                { const float4 a0 = *(const float4*)(YF + o5), a1 = *(const float4*)(YF + o5 + 4), b0 = *(const float4*)(YB + o5), b1 = *(const float4*)(YB + o5 + 4);
                  float xx[8], zz[8]; unpack8(*(const u32x4*)(XBC + (size_t)tok * 1024 + c0), xx); unpack8(*(const u32x4*)(pr + SSD_OFF + c0), zz); const float dsk = ssd_d[c0 >> 6];
                  ys[0] = a0.x + b0.x; ys[1] = a0.y + b0.y; ys[2] = a0.z + b0.z; ys[3] = a0.w + b0.w; ys[4] = a1.x + b1.x; ys[5] = a1.y + b1.y; ys[6] = a1.z + b1.z; ys[7] = a1.w + b1.w;
#pragma unroll
                  for (int j = 0; j < 8; ++j) ys[j] = (ys[j] + dsk * xx[j]) * siluf_(zz[j]); }
                float s1 = 0.f, s2 = 0.f;
#pragma unroll
                for (int j = 0; j < 8; ++j) { s1 += hm[j] * hm[j]; s2 += ys[j] * ys[j]; }
                s1 += __shfl_xor(s1, 1); s1 += __shfl_xor(s1, 2); s1 += __shfl_xor(s1, 4); s1 += __shfl_xor(s1, 8);
                s2 = wave_sum(s2);
                const float r1 = rsqrtf(s1 * (1.0f / 128.0f) + 1e-6f), r2 = rsqrtf(s2 * (1.0f / BW) + 1e-6f);
                float oo[8]; unpack8(*(const u32x4*)(pr + ML_OFF + 1536 + c0), oo);
                const float4 g0 = *(const float4*)(ml_norm + c0), g1 = *(const float4*)(ml_norm + c0 + 4), n0 = *(const float4*)(ssd_norm + c0), n1 = *(const float4*)(ssd_norm + c0 + 4);
                const float gm[8] = {g0.x, g0.y, g0.z, g0.w, g1.x, g1.y, g1.z, g1.w}, gs[8] = {n0.x, n0.y, n0.z, n0.w, n1.x, n1.y, n1.z, n1.w};
                u32x4 w;
                w.x = pk2(hm[0] * r1 * gm[0] * sigmoidf_(oo[0]), hm[1] * r1 * gm[1] * sigmoidf_(oo[1])); w.y = pk2(hm[2] * r1 * gm[2] * sigmoidf_(oo[2]), hm[3] * r1 * gm[3] * sigmoidf_(oo[3]));
                w.z = pk2(hm[4] * r1 * gm[4] * sigmoidf_(oo[4]), hm[5] * r1 * gm[5] * sigmoidf_(oo[5])); w.w = pk2(hm[6] * r1 * gm[6] * sigmoidf_(oo[6]), hm[7] * r1 * gm[7] * sigmoidf_(oo[7]));
                *(u32x4*)(Y4 + (size_t)tok * DM + 512 + c0) = w;
                w.x = pk2(ys[0] * r2 * gs[0], ys[1] * r2 * gs[1]); w.y = pk2(ys[2] * r2 * gs[2], ys[3] * r2 * gs[3]); w.z = pk2(ys[4] * r2 * gs[4], ys[5] * r2 * gs[5]); w.w = pk2(ys[6] * r2 * gs[6], ys[7] * r2 * gs[7]);
                *(u32x4*)(Y4 + (size_t)tok * DM + 1536 + c0) = w;
                if (tok >= NLAT) { const size_t oc = (size_t)(tok - NLAT) * BW + c0; float uu[8]; unpack8(*(const u32x4*)(pr + S5_OFF + c0), uu);
                    const float4 a0 = *(const float4*)(SF + oc), a1 = *(const float4*)(SF + oc + 4), b0 = *(const float4*)(SB + oc), b1 = *(const float4*)(SB + oc + 4), d0 = *(const float4*)(s5_d + c0), d1 = *(const float4*)(s5_d + c0 + 4);
                    float y[8] = {a0.x + b0.x + d0.x * uu[0], a0.y + b0.y + d0.y * uu[1], a0.z + b0.z + d0.z * uu[2], a0.w + b0.w + d0.w * uu[3], a1.x + b1.x + d1.x * uu[4], a1.y + b1.y + d1.y * uu[5], a1.z + b1.z + d1.z * uu[6], a1.w + b1.w + d1.w * uu[7]};
#pragma unroll
                    for (int j = 0; j < 8; ++j) y[j] = 0.5f * y[j] * (1.0f + tanhf(0.7978845608028654f * (y[j] + 0.044715f * y[j] * y[j] * y[j])));
                    w.x = pk2(y[0], y[1]); w.y = pk2(y[2], y[3]); w.z = pk2(y[4], y[5]); w.w = pk2(y[6], y[7]);
                    *(u32x4*)(GG + (size_t)tok * BW + c0) = w; }
            }
            __syncthreads();
            {   float* T = sf;
                for (int unit = (G > 128 ? bid - 128 : bid); unit >= 0 && unit < 4 * 64 * 8; unit += (G > 128 ? G - 128 : G)) { const int b = unit / 512, t0 = ((unit >> 3) & 63) * 64, c0 = (unit & 7) * 64;
                    __syncthreads();
#pragma unroll
                    for (int i = 0; i < 8; ++i) { const int t = tid & 63, c = (tid >> 6) + 8 * i; T[c * 65 + t] = YT[((size_t)b * 512 + c0 + c) * SEQ + t0 + t]; }
                    __syncthreads();
                    const int t = tid >> 3, cq = (tid & 7) * 8;
                    u32x4 w; w.x = pk2(T[(cq + 0) * 65 + t], T[(cq + 1) * 65 + t]); w.y = pk2(T[(cq + 2) * 65 + t], T[(cq + 3) * 65 + t]); w.z = pk2(T[(cq + 4) * 65 + t], T[(cq + 5) * 65 + t]); w.w = pk2(T[(cq + 6) * 65 + t], T[(cq + 7) * 65 + t]);
                    *(u32x4*)(Y4 + ((size_t)b * SEQ + t0 + t) * DM + c0 + cq) = w;
                } }
            SEAM(PB + 5);
        }

        if (IN(PB + 6)) for (int rep_ = 0; rep_ < PROBE_REPS(6); ++rep_) {
            PH_BEGIN
            pg8::Gemm g{GG, GLU, BW, BW, BW}; pg8::SchedStd S{68, 2, G, bid, BW, BW}; pg8::EpiGlu E{GG, PT(33) + l * BW, Y4};
            pg8::gemm_phase((LAS unsigned char*)shm, g, S, E);
            SEAM(PB + 6);
        }
        if (IN(PB + 7)) for (int rep_ = 0; rep_ < PROBE_REPS(7); ++rep_) {
            PH_BEGIN
            pg8::Gemm g{Y4, WBR, DM, BW, BW}; pg8::SchedBranch S{nPanels, 8, G, bid}; pg8::EpiBranch E{P, ACCb};
            pg8::gemm_phase((LAS unsigned char*)shm, g, S, E);
            SEAM(PB + 7);
        }
        if (IN(PB + 8)) for (int rep_ = 0; rep_ < PROBE_REPS(8); ++rep_) {
            PH_BEGIN
            pg8::Gemm g{ACCb, WOUT, DM, DM, DM}; pg8::SchedStd S{nPanels, 8, G, bid, DM, DM}; pg8::EpiResid E{XS, l == 0 ? x_in : (const float*)XS, l == 0 ? ctx_in - (size_t)NLAT * DM : (const float*)XS, MODl, 2};
            pg8::gemm_phase((LAS unsigned char*)shm, g, S, E);
            SEAM(PB + 8);
        }
        if (IN(PB + 9)) for (int rep_ = 0; rep_ < PROBE_REPS(9); ++rep_) {
            PH_BEGIN
            for (int i = bid * NTHR + tid; i < NEXP * MOE_PAD; i += G * NTHR) ROWTOK[i] = -1;
            for (int i = bid * NTHR + tid; i < NTOK * 16; i += G * NTHR) INV[i] = -1;
            const float* wr = PT(42) + (size_t)l * DM * 16; const float* gn = norm_ffn + l * DM;
            for (int tok0 = (bid * 8 + wave) * 4; tok0 < M2; tok0 += G * 32) {
                const int r = tok0 < NLAT ? tok0 / SEQ : 4; const float* xr = XS + (size_t)tok0 * DM;
                const float* sh = MODl + (size_t)(r * 6 + 3) * DM; const float* sc = MODl + (size_t)(r * 6 + 4) * DM;
                float rs[4];
#pragma unroll
                for (int tk = 0; tk < 4; ++tk) { float ss = 0.f;
#pragma unroll 4
                    for (int i = 0; i < 8; ++i) { const float4 t4 = *(const float4*)(xr + (size_t)tk * DM + i * 256 + lane * 4); ss += t4.x * t4.x + t4.y * t4.y + t4.z * t4.z + t4.w * t4.w; }
                    ss = wave_sum(ss); rs[tk] = rsqrtf(ss * (1.0f / DM) + 1e-6f); }
                float lg[4][16];
#pragma unroll
                for (int tk = 0; tk < 4; ++tk)
#pragma unroll
                    for (int e = 0; e < 16; ++e) lg[tk][e] = 0.f;
#pragma unroll 1
                for (int i = 0; i < 8; ++i) { const int d = i * 256 + lane * 4;
                    const float4 g4 = *(const float4*)(gn + d), s4 = *(const float4*)(sc + d), h4 = *(const float4*)(sh + d);
                    float hv[4][4];
#pragma unroll
                    for (int tk = 0; tk < 4; ++tk) { const float4 xv = *(const float4*)(xr + (size_t)tk * DM + d); const float rr = rs[tk];
                        hv[tk][0] = xv.x * rr * g4.x * (1.f + s4.x) + h4.x; hv[tk][1] = xv.y * rr * g4.y * (1.f + s4.y) + h4.y; hv[tk][2] = xv.z * rr * g4.z * (1.f + s4.z) + h4.z; hv[tk][3] = xv.w * rr * g4.w * (1.f + s4.w) + h4.w;
                        u32x2 w; w.x = pk2(hv[tk][0], hv[tk][1]); w.y = pk2(hv[tk][2], hv[tk][3]); *(u32x2*)(HB + (size_t)(tok0 + tk) * DM + d) = w; }
                    const float4* wq = (const float4*)(wr + (size_t)d * 16);
#pragma unroll
                    for (int q = 0; q < 4; ++q) { const float4 w0 = wq[q * 4 + 0], w1 = wq[q * 4 + 1], w2 = wq[q * 4 + 2], w3 = wq[q * 4 + 3];
#pragma unroll
                        for (int tk = 0; tk < 4; ++tk) { const float hq = hv[tk][q];
                            lg[tk][0] += hq * w0.x; lg[tk][1] += hq * w0.y; lg[tk][2] += hq * w0.z; lg[tk][3] += hq * w0.w; lg[tk][4] += hq * w1.x; lg[tk][5] += hq * w1.y; lg[tk][6] += hq * w1.z; lg[tk][7] += hq * w1.w;
                            lg[tk][8] += hq * w2.x; lg[tk][9] += hq * w2.y; lg[tk][10] += hq * w2.z; lg[tk][11] += hq * w2.w; lg[tk][12] += hq * w3.x; lg[tk][13] += hq * w3.y; lg[tk][14] += hq * w3.z; lg[tk][15] += hq * w3.w; } } }
#pragma unroll
                for (int tk = 0; tk < 4; ++tk) { float mx = -1e30f;
#pragma unroll
                    for (int e = 0; e < 16; ++e) { lg[tk][e] = wave_sum(lg[tk][e]); mx = fmaxf(mx, lg[tk][e]); }
                    float sm = 0.f;
#pragma unroll
                    for (int e = 0; e < 16; ++e) { lg[tk][e] = expf(lg[tk][e] - mx); sm += lg[tk][e]; }
                    const float inv = 1.0f / sm;
                    if (lane == 0) {
#pragma unroll
                        for (int e = 0; e < 16; e += 4) *(float4*)(PROBS + (size_t)(tok0 + tk) * 16 + e) = make_float4(lg[tk][e] * inv, lg[tk][e + 1] * inv, lg[tk][e + 2] * inv, lg[tk][e + 3] * inv); } }
            }
            SEAM(PB + 9);
        }
        if (IN(PB + 10)) for (int rep_ = 0; rep_ < PROBE_REPS(10); ++rep_) {
            PH_BEGIN
            const int nitems = 64 + (lastl ? 0 : 64);
            unsigned long long* keys = (unsigned long long*)shm;
            for (int it = bid; it < nitems; it += G) {
                const int set = it >> 6, e = it & 15, b = (it >> 4) & 3;
                const int n = set ? CTXL : SEQ, cap = set ? 32 : 512, tokbase = set ? NLAT + b * CTXL : b * SEQ;
                __syncthreads();
                for (int i = tid; i < n; i += NTHR) keys[i] = ((unsigned long long)__float_as_uint(PROBS[(size_t)(tokbase + i) * 16 + e]) << 32) | (unsigned long long)(0xFFFFFFFFu - (unsigned)i);
                __syncthreads();
                for (int k = 2; k <= n; k <<= 1)
                    for (int j = k >> 1; j > 0; j >>= 1) {
                        for (int p = tid; p < (n >> 1); p += NTHR) { const int i = ((p & ~(j - 1)) << 1) | (p & (j - 1)); const int m = i | j;
                            const unsigned long long ka = keys[i], kb = keys[m]; const bool desc = ((i & k) == 0);
                            if ((ka < kb) == desc) { keys[i] = kb; keys[m] = ka; } }
                        __syncthreads();
                    }
                for (int r = tid; r < cap; r += NTHR) { const unsigned long long kk = keys[r]; const int row = e * MOE_PAD + (set ? 2048 + b * 32 + r : b * 512 + r);
                    const int tk_ = tokbase + (int)(0xFFFFFFFFu - (unsigned)(kk & 0xFFFFFFFFull)); ROWTOK[row] = tk_; ROWGATE[row] = __uint_as_float((unsigned)(kk >> 32)); INV[tk_ * 16 + e] = row; }
                for (int r = wave; r < cap; r += 8) { const int tok = tokbase + (int)(0xFFFFFFFFu - (unsigned)(keys[r] & 0xFFFFFFFFull)); const int row = e * MOE_PAD + (set ? 2048 + b * 32 + r : b * 512 + r);
                    const u32x4* sp = (const u32x4*)(HB + (size_t)tok * DM); u32x4* dp = (u32x4*)(XG + (size_t)row * DM);
#pragma unroll
                    for (int i = 0; i < 4; ++i) dp[i * 64 + lane] = sp[i * 64 + lane]; }
            }
            {   const int pad0 = lastl ? 2048 : MOE_ROWS, npad = MOE_PAD - pad0;
                for (int R = bid * 8 + wave; R < NEXP * npad; R += G * 8) { const int e = R / npad, rr = pad0 + R % npad; u32x4* dp = (u32x4*)(XG + ((size_t)e * MOE_PAD + rr) * DM);
#pragma unroll
                    for (int i = 0; i < 4; ++i) dp[i * 64 + lane] = (u32x4){0u, 0u, 0u, 0u}; } }
            SEAM(PB + 10);
        }
        if (IN(PB + 12)) for (int rep_ = 0; rep_ < PROBE_REPS(12); ++rep_) {
            PH_BEGIN
            pg8::Gemm g{XG, WGU, DM, DM, DM}; pg8::SchedMoe S{lastl ? 8 : 9, 12, G, bid, DM, DM, 2 * DEXP}; pg8::EpiMoe1 E{HID};
            pg8::gemm_phase((LAS unsigned char*)shm, g, S, E);
            SEAM(PB + 12);
        }
        if (IN(PB + 13)) for (int rep_ = 0; rep_ < PROBE_REPS(13); ++rep_) {
            PH_BEGIN
            pg8::Gemm g{HID, WD, DEXP, DEXP, DEXP}; pg8::SchedMoe S{lastl ? 8 : 9, 8, G, bid, DEXP, DEXP, DM}; pg8::EpiMoeY E{YEXP};
            pg8::gemm_phase((LAS unsigned char*)shm, g, S, E);
            SEAM(PB + 13);
        }

}

__global__ __launch_bounds__(NTHR, 2) void fwd(Args a) {
    extern __shared__ __attribute__((aligned(16))) unsigned char shm[];
    const int bid = blockIdx.x, G = gridDim.x;
    float* const sf = (float*)shm;
    volatile LAS unsigned* xbw = (volatile LAS unsigned*)((LAS unsigned char*)shm + (LDS_BYTES - 16));
    if (threadIdx.x == 0) { xbw[0] = 0u; xbw[1] = 0u; xbw[2] = 0u; xbw[3] = 0u; }
    const float** const ptab = (const float**)(shm + (LDS_BYTES - 16 - 512));
    if (threadIdx.x == 0) {
#pragma unroll
        for (int i = 0; i < 47; ++i) ptab[i] = a.in[i]; }
    __syncthreads();
    XcdBarrier bar = xcd_barrier_post((unsigned*)(a.ws + O_BAR), xbw);
    const int lo = a.ph_lo, hi = a.ph_hi;
    if (IN(0)) {
        PH_BEGIN
        {
            __syncthreads();
            for (int i = tid; i < 5 * DM; i += NTHR) { const int r = i >> 11, k = i & (DM - 1); const float v = r < 4 ? c_in[r * DM + k] : cctx_in[k]; sf[i] = siluf_(v); }
            __syncthreads();
            float* red = sf + 5 * DM;
            for (int unit = bid; unit < 2 * 96; unit += G) { const int l = unit / 96, j = (unit % 96) * 128 + (tid & 127), kq = tid >> 7;
                const float* w = ada_w + (size_t)l * DM * (6 * DM) + (size_t)(kq * 512) * (6 * DM) + j; const float* sv = sf + kq * 512;
                float a0 = 0.f, a1 = 0.f, a2 = 0.f, a3 = 0.f, a4 = 0.f;
#pragma unroll 8
                for (int k = 0; k < 512; ++k) { const float wv = w[(size_t)k * (6 * DM)]; a0 += sv[k] * wv; a1 += sv[DM + k] * wv; a2 += sv[2 * DM + k] * wv; a3 += sv[3 * DM + k] * wv; a4 += sv[4 * DM + k] * wv; }
                __syncthreads();
                { float* rp = red + (kq * 5) * 128 + (tid & 127); rp[0] = a0; rp[128] = a1; rp[256] = a2; rp[384] = a3; rp[512] = a4; }
                __syncthreads();
                if (tid < 128) { const float bb = ada_b[l * 6 * DM + j]; float* o = MOD + (size_t)l * 5 * 6 * DM + j;
#pragma unroll
                    for (int r = 0; r < 5; ++r) o[(size_t)r * 6 * DM] = ((red[(0 * 5 + r) * 128 + tid] + red[(1 * 5 + r) * 128 + tid]) + (red[(2 * 5 + r) * 128 + tid] + red[(3 * 5 + r) * 128 + tid])) + bb; }
            }
        }
    }

    layer_body<0>(a, bar, lo, hi, bid, G, shm, sf, ptab);
    layer_body<1>(a, bar, lo, hi, bid, G, shm, sf, ptab);
    if (IN(33)) {
        PH_BEGIN
        const float* gn = PT(46);
        for (int tok = bid * 8 + wave; tok < NLAT; tok += G * 8) {
            const float* xr = XS + (size_t)tok * DM; float4 v[8]; float ss = 0.f;
#pragma unroll
            for (int i = 0; i < 8; ++i) v[i] = *(const float4*)(xr + i * 256 + lane * 4);
            moe_combine(v, tok, lane, INV, ROWGATE, YEXP, MOD + (size_t)(1 * 5 + tok / SEQ) * 6 * DM + 5 * DM);
#pragma unroll
            for (int i = 0; i < 8; ++i) {                 ss += v[i].x * v[i].x + v[i].y * v[i].y + v[i].z * v[i].z + v[i].w * v[i].w; }
            ss = wave_sum(ss); const float rs = rsqrtf(ss * (1.0f / DM) + 1e-6f);
#pragma unroll
            for (int i = 0; i < 8; ++i) { const int d = i * 256 + lane * 4; const float4 g4 = *(const float4*)(gn + d);
                *(float4*)(a.out + (size_t)tok * DM + d) = make_float4(v[i].x * rs * g4.x, v[i].y * rs * g4.y, v[i].z * rs * g4.z, v[i].w * rs * g4.w); }
        }
    }
#undef IN
#undef SEAM
}


extern "C" void kernel_launch(void* const* d_in, const int* in_sizes, int n_in, void* d_out, int out_size, void* d_ws, size_t ws_size, hipStream_t stream) {
    static int grid = 0;
    if (grid == 0) {
        if (n_in != 47 || ws_size < WS_END) { fprintf(stderr, "kernel_launch: expected 47 inputs and >= %zu bytes of workspace; got %d, %zu\n", (size_t)WS_END, n_in, ws_size); grid = -1; return; }
        int dev = 0, cus = 0;
        if (hipGetDevice(&dev) != hipSuccess || hipDeviceGetAttribute(&cus, hipDeviceAttributeMultiprocessorCount, dev) != hipSuccess) { grid = -1; return; }
        if (hipFuncSetAttribute((const void*)fwd, hipFuncAttributeMaxDynamicSharedMemorySize, LDS_BYTES) != hipSuccess) { fprintf(stderr, "kernel_launch: hipFuncSetAttribute failed\n"); grid = -1; return; }
        int per_cu = 0;
        if (hipOccupancyMaxActiveBlocksPerMultiprocessor(&per_cu, (const void*)fwd, NTHR, LDS_BYTES) != hipSuccess || per_cu < 1) fprintf(stderr, "kernel_launch: occupancy query reports %d\n", per_cu);
        (void)hipGetLastError();
        grid = cus > 256 ? 256 : cus;
        if (grid < 160) { fprintf(stderr, "kernel_launch: needs >= 160 CUs (got %d)\n", grid); grid = -1; return; }
    }
    if (grid < 0) return;
    (void)hipMemsetAsync((char*)d_ws, 0, O_ZERO_END, stream);
    Args a{};
    for (int i = 0; i < 47; ++i) a.in[i] = (const float*)d_in[i];
    a.out = (float*)d_out; a.ws = (unsigned char*)d_ws;
#if MK_ONE_LAUNCH
    a.ph_lo = 0; a.ph_hi = 64;
    hipLaunchKernelGGL(fwd, dim3(grid), dim3(NTHR), LDS_BYTES, stream, a);
#else
    const int ids[] = {0, 1,2,3,4,5,6,7,8,9,10,11,12,13,14, 17,18,19,20,21,22,23,24,25,26,27,28,29,30, 33};
    for (int k = 0; k < (int)(sizeof(ids) / sizeof(ids[0])); ++k) { a.ph_lo = ids[k]; a.ph_hi = ids[k] + 1; hipLaunchKernelGGL(fwd, dim3(grid), dim3(NTHR), LDS_BYTES, stream, a); }
#endif
}
```

```cpp
#include <hip/hip_runtime.h>
#include <stdint.h>
#include <stdio.h>

#ifndef PROBE_MASK
#define PROBE_MASK 0
#endif
#ifndef PROBE_SP
#define PROBE_SP 1
#endif
#define PROBE_REPS(k) ((((PROBE_MASK) >> (k)) & 1) + 1)
#ifndef MK_ONE_LAUNCH
#define MK_ONE_LAUNCH 1
#endif

#define DM 2048
#define NB 4
#define SEQ 4096
#define CTXL 256
#define BW 512
#define NLAT 16384
#define NCTX 1024
#define NTOK 17408
#define IN_W 13856
#define LDP 14080
#define HY_OFF 0
#define ML_OFF 1536
#define S5_OFF 3600
#define SSD_OFF 4112
#define GATE_OFF 5664
#define NEXP 16
#define DEXP 1536
#define MOE_ROWS 2176
#define MOE_PAD 2304
#define NTHR 512
#define LDS_BYTES 147456
#define LAS __attribute__((address_space(3)))

typedef unsigned short bf16_t;
typedef short bf16x8 __attribute__((ext_vector_type(8)));
typedef float f32x4 __attribute__((ext_vector_type(4)));
typedef unsigned u32x4 __attribute__((ext_vector_type(4)));
typedef unsigned u32x2 __attribute__((ext_vector_type(2)));

#define XB_TMO      128
#define XB_XCNT(j)  (256  + 64 * (j))
#define XB_XSUB(j)  (1280 + 64 * (j))
#define XB_XGEN(j)  (2304 + 64 * (j))
#define XB_TOP      3328
#define XB_TOPGEN   3392
#define XCD_BAR_WORDS 3456
#define XB_SPIN_CAP (1u << 18)
__device__ __forceinline__ unsigned xb_ld(unsigned* p)              { return __hip_atomic_load(p, __ATOMIC_RELAXED, __HIP_MEMORY_SCOPE_AGENT); }
__device__ __forceinline__ unsigned xb_add(unsigned* p, unsigned v) { return __hip_atomic_fetch_add(p, v, __ATOMIC_RELAXED, __HIP_MEMORY_SCOPE_AGENT); }
__device__ __forceinline__ unsigned xb_xcc_id() { return (unsigned)__builtin_amdgcn_s_getreg((3 << 11) | 20) & 0xFu; }
#define XB_SPIN(cond, bar) do { unsigned _sp = 0; while (cond) { __builtin_amdgcn_s_sleep(1); \
    if ((++_sp & 255u) == 0u) { if (xb_ld(&(bar)[XB_TMO])) break; if (_sp > XB_SPIN_CAP) { atomicAdd(&(bar)[XB_TMO], 1u); break; } } } } while (0)
struct XcdBarrier { unsigned* bar; unsigned x; volatile LAS unsigned* st; };
__device__ __forceinline__ XcdBarrier xcd_barrier_post(unsigned* bar, volatile LAS unsigned* st) {
    XcdBarrier b; b.bar = bar; b.x = xb_xcc_id(); b.st = st;
    if (threadIdx.x == 0) (void)xb_add(&bar[XB_XCNT(b.x)], 1u);
    return b;
}
__device__ __forceinline__ void xcd_barrier_complete(unsigned* bar, unsigned x, unsigned& nloc, unsigned& nx) {
    const unsigned G = gridDim.x * gridDim.y * gridDim.z;
    unsigned sum, cnt, mine, sp = 0u;
    for (;;) {
        sum = 0u; cnt = 0u; mine = 0u;
#pragma unroll
        for (unsigned j = 0; j < 16; ++j) { const unsigned c = xb_ld(&bar[XB_XCNT(j)]); sum += c; cnt += (c > 0u) ? 1u : 0u; mine = (j == x) ? c : mine; }
        if (sum == G) break;
        __builtin_amdgcn_s_sleep(1);
        if ((++sp & 255u) == 0u) { if (xb_ld(&bar[XB_TMO])) break; if (sp > XB_SPIN_CAP) { atomicAdd(&bar[XB_TMO], 1u); break; } }
    }
    nloc = mine > 0u ? mine : 1u; nx = cnt > 0u ? cnt : 1u;
}
__device__ __forceinline__ void xcd_barrier(const XcdBarrier& b) {
    asm volatile("s_waitcnt vmcnt(0)" ::: "memory");
    __syncthreads();
    if (threadIdx.x == 0) {
        unsigned* bar = b.bar;
        __builtin_amdgcn_s_waitcnt(0);
        unsigned nloc = b.st[0], nx = b.st[1];
        if (nloc == 0u) { xcd_barrier_complete(bar, b.x, nloc, nx); b.st[0] = nloc; b.st[1] = nx; }
        const unsigned old = xb_add(&bar[XB_XSUB(b.x)], 1u);
        const unsigned gen = old / nloc;
        if (old + 1u == (gen + 1u) * nloc) {
            __builtin_amdgcn_fence(__ATOMIC_RELEASE, "agent");
            asm volatile("s_waitcnt vmcnt(0)" ::: "memory");
            const unsigned og = xb_add(&bar[XB_TOP], 1u);
            const unsigned tg = og / nx;
            if (og + 1u == (tg + 1u) * nx) xb_add(&bar[XB_TOPGEN], 1u);
            else XB_SPIN(xb_ld(&bar[XB_TOPGEN]) == tg, bar);
            __builtin_amdgcn_fence(__ATOMIC_ACQUIRE, "agent");
            xb_add(&bar[XB_XGEN(b.x)], 1u);
            asm volatile("s_waitcnt vmcnt(0)" ::: "memory");
        } else {
            XB_SPIN(xb_ld(&bar[XB_XGEN(b.x)]) == gen, bar);
            __builtin_amdgcn_fence(__ATOMIC_ACQUIRE, "agent");
            asm volatile("s_waitcnt vmcnt(0)" ::: "memory");
        }
    }
    __syncthreads();
}

__device__ __forceinline__ unsigned short f2bf(float f) { unsigned u = __float_as_uint(f); u += 0x7FFFu + ((u >> 16) & 1u); return (unsigned short)(u >> 16); }
__device__ __forceinline__ float bf2f(unsigned short b) { return __uint_as_float(((unsigned)b) << 16); }
__device__ __forceinline__ unsigned pk2(float lo, float hi) { unsigned r; asm("v_cvt_pk_bf16_f32 %0, %1, %2" : "=v"(r) : "v"(lo), "v"(hi)); return r; }
__device__ __forceinline__ float sigmoidf_(float x) { return 1.0f / (1.0f + expf(-x)); }
__device__ __forceinline__ float siluf_(float x) { return x / (1.0f + expf(-x)); }
__device__ __forceinline__ float wave_sum(float v) {
#pragma unroll
    for (int o = 32; o >= 1; o >>= 1) v += __shfl_xor(v, o);
    return v;
}
__device__ __forceinline__ const float* uptr(const float* p) { const unsigned long long v = (unsigned long long)p;
    const unsigned lo = __builtin_amdgcn_readfirstlane((unsigned)v), hi = __builtin_amdgcn_readfirstlane((unsigned)(v >> 32)); return (const float*)(((unsigned long long)hi << 32) | lo); }
#define PT(k) uptr(ptab[k])
__device__ __forceinline__ int step_tok(int b, int dir, int i) {
    if (i < CTXL) { const int tt = dir ? (CTXL - 1 - i) : i; return NLAT + b * CTXL + tt; }
    const int j = i - CTXL; const int tt = dir ? (SEQ - 1 - j) : j; return b * SEQ + tt;
}
__device__ __forceinline__ void unpack8(const u32x4 w, float (&f)[8]) {
    f[0] = __uint_as_float(w.x << 16); f[1] = __uint_as_float(w.x & 0xFFFF0000u); f[2] = __uint_as_float(w.y << 16); f[3] = __uint_as_float(w.y & 0xFFFF0000u);
    f[4] = __uint_as_float(w.z << 16); f[5] = __uint_as_float(w.z & 0xFFFF0000u); f[6] = __uint_as_float(w.w << 16); f[7] = __uint_as_float(w.w & 0xFFFF0000u);
}

namespace pg8 {
constexpr int BM = 256, BK = 64, HALF = 128, HTB = HALF * BK * 2, STAGE_BYTES = 8 * HTB, NXCD = 8, WGM = 8;
__host__ __device__ __forceinline__ int lds_byte(int r, int c) { const int st = (r >> 4) * 2 + (c >> 5), rr = r & 15, cc = c & 31, ob = rr * 64 + cc * 2; return st * 1024 + (ob ^ (((ob >> 9) & 1) << 5)); }
__host__ __device__ __forceinline__ void stage_rc(int b, int& R, int& C) { const int st = b / 1024, sb = b % 1024, swz = sb ^ (((sb >> 9) & 1) << 5); R = (st >> 1) * 16 + swz / 64; C = (st & 1) * 32 + (swz % 64) / 2; }
__host__ __device__ __forceinline__ int perm32(int rho) { const int n = rho >> 4, i = rho & 15; return 8 * (i >> 2) + 4 * n + (i & 3); }
struct Unit { int pm, pn, z, k; long long ao, bo; };
struct Gemm { const bf16_t* A; const bf16_t* Bt; int lda, ldb, K; };

__device__ __forceinline__ void tile_of(int wgid, int nM, int nN, int& pm, int& pn) {
    const int nwg = nM * nN; { const int q = nwg / NXCD, r = nwg % NXCD, xcd = wgid % NXCD, off = wgid / NXCD; wgid = (xcd < r ? xcd * (q + 1) : r * (q + 1) + (xcd - r) * q) + off; }
    const int nig = WGM * nN, gid = wgid / nig, fm = gid * WGM, gsz = (nM - fm) < WGM ? (nM - fm) : WGM;
    pm = fm + ((wgid % nig) % gsz); pn = (wgid % nig) / gsz;
}
struct SchedStd {
    int nM, nN, G, c, lda, ldb;
    __device__ __forceinline__ bool next(int i, Unit& u) const { const long L = (long)i * G + c; if (L >= (long)nM * nN) return false; tile_of((int)L, nM, nN, u.pm, u.pn); u.z = 0; u.k = 0;
        u.ao = (long long)u.pm * BM * lda * 2; u.bo = (long long)u.pn * BM * ldb * 2; return true; }
    __device__ __forceinline__ void a_ready(const Unit&) const {}
    __device__ __forceinline__ void done(const Unit&) const {}
};
struct SchedBranch {
    int nM, nN, G, c;
    __device__ __forceinline__ bool next(int i, Unit& u) const { const long L = (long)(i >> 2) * G + c; if (L >= (long)nM * nN) return false; tile_of((int)L, nM, nN, u.pm, u.pn); u.z = 0; u.k = i & 3;
        u.ao = ((long long)u.pm * BM * DM + u.k * BW) * 2; u.bo = ((long long)u.k * DM + u.pn * BM) * BW * 2; return true; }
    __device__ __forceinline__ void a_ready(const Unit&) const {}
    __device__ __forceinline__ void done(const Unit&) const {}
};
struct SchedMoe {
    int nPm, nPn, G, c, lda, ldb, nBrows;
    __device__ __forceinline__ bool next(int i, Unit& u) const { const long L = (long)i * G + c; const int per = nPm * nPn; if (L >= (long)NEXP * per) return false; const int e = (int)(L / per), rem = (int)(L % per);
        u.z = e; u.k = 0; u.pm = rem % nPm; u.pn = rem / nPm; u.ao = ((long long)e * MOE_PAD + u.pm * BM) * lda * 2; u.bo = ((long long)e * nBrows + u.pn * BM) * ldb * 2; return true; }
    __device__ __forceinline__ void a_ready(const Unit&) const {}
    __device__ __forceinline__ void done(const Unit&) const {}
};

typedef f32x4 Acc[2][2][4][2];
template <class Epi, class Sched>
__device__ __forceinline__ void gemm_phase(LAS unsigned char* lds, const Gemm g, const Sched& S, const Epi& E) {
    int tid = threadIdx.x; asm volatile("" : "+v"(tid));
    const int wid = __builtin_amdgcn_readfirstlane(tid >> 6), lane = tid & 63, wr = wid >> 2, wc = wid & 3, fr = lane & 15, fq = lane >> 4;
    const int K = g.K, nt = K / BK;
    unsigned voffA[2], voffB[2];
#pragma unroll
    for (int i = 0; i < 2; ++i) { int R, C; stage_rc(tid * 16 + i * 8192, R, C); const int Rb = Epi::PERM ? ((R & ~31) + perm32(R & 31)) : R;
        voffA[i] = (unsigned)(R * g.lda + C) * 2u; voffB[i] = (unsigned)(Rb * g.ldb + C) * 2u; }
    const size_t kstep = (size_t)(BK * 2);
    const size_t hstepA = (size_t)HALF * g.lda * 2, hstepB = (size_t)HALF * g.ldb * 2;
    const unsigned ldsw = (unsigned)wid * 1024u;
    const int aoff = lds_byte(wr * 64 + fr, fq * 8), boff = lds_byte(wc * 32 + fr, fq * 8);
#define PG8_SA(b, h) (((b) * 2 + (h)) * HTB)
#define PG8_SB(b, h) ((4 + (b) * 2 + (h)) * HTB)
#define PG8_STAGE(bufoff, gbase, voff) do { _Pragma("unroll") for (int _i = 0; _i < 2; ++_i) \
        __builtin_amdgcn_global_load_lds((const unsigned*)((const char*)(gbase) + (voff)[_i]), (LAS unsigned*)(lds + (bufoff) + ldsw + _i * 8192), 16, 0, 0); } while (0)
#define PG8_LDA(dst, b, h) do { _Pragma("unroll") for (int m = 0; m < 4; ++m) _Pragma("unroll") for (int k = 0; k < 2; ++k) dst[m][k] = *(const LAS bf16x8*)(lds + PG8_SA(b, h) + aoff + m * 2048 + k * 1024); } while (0)
#define PG8_LDB(dst, b, h) do { _Pragma("unroll") for (int n = 0; n < 2; ++n) _Pragma("unroll") for (int k = 0; k < 2; ++k) dst[n][k] = *(const LAS bf16x8*)(lds + PG8_SB(b, h) + boff + n * 2048 + k * 1024); } while (0)
#define PG8_MMA(ai, bj, At, Bt) do { __builtin_amdgcn_s_setprio(1); _Pragma("unroll") for (int m = 0; m < 4; ++m) _Pragma("unroll") for (int n = 0; n < 2; ++n) _Pragma("unroll") for (int k = 0; k < 2; ++k) \
        acc[ai][bj][m][n] = __builtin_amdgcn_mfma_f32_16x16x32_bf16(Bt[n][k], At[m][k], acc[ai][bj][m][n], 0, 0, 0); __builtin_amdgcn_s_setprio(0); } while (0)
#define PG8_WAIT_V(n) asm volatile("s_waitcnt vmcnt(" #n ")" ::: "memory")
#define PG8_WAIT_L(n) asm volatile("s_waitcnt lgkmcnt(" #n ")" ::: "memory")
#define PG8_BAR __builtin_amdgcn_s_barrier()
#define PG8_SCHED __builtin_amdgcn_sched_barrier(0)
    Unit cur, nxt; int ui = 0;
    if (!S.next(0, cur)) return;
    Acc acc;
#pragma unroll
    for (int a = 0; a < 2; ++a)
#pragma unroll
        for (int b = 0; b < 2; ++b)
#pragma unroll
            for (int m = 0; m < 4; ++m)
#pragma unroll
                for (int n = 0; n < 2; ++n) acc[a][b][m][n] = (f32x4){0.f, 0.f, 0.f, 0.f};
    bf16x8 At[4][2], B0[2][2], B1[2][2];
    const char* cA = (const char*)g.A + cur.ao; const char* cB = (const char*)g.Bt + cur.bo;
    S.a_ready(cur);
    PG8_STAGE(PG8_SB(0, 0), cB, voffB); PG8_STAGE(PG8_SA(0, 0), cA, voffA); PG8_STAGE(PG8_SB(0, 1), cB + hstepB, voffB); PG8_STAGE(PG8_SA(0, 1), cA + hstepA, voffA);
    if (wr == 1) PG8_BAR;
    PG8_WAIT_V(4); PG8_BAR;
    PG8_STAGE(PG8_SB(1, 0), cB + kstep, voffB); PG8_STAGE(PG8_SA(1, 0), cA + kstep, voffA); PG8_STAGE(PG8_SB(1, 1), cB + hstepB + kstep, voffB);
    PG8_WAIT_V(6); PG8_BAR;
    for (;;) {
        const bool has_next = S.next(ui + 1, nxt);
        const char* nA = has_next ? (const char*)g.A + nxt.ao : cA; const char* nB = has_next ? (const char*)g.Bt + nxt.bo : cB;
        for (int t = 0; t < nt; t += 2) {
            const bool last = (t == nt - 2);
            const char* a1 = cA + (size_t)(t + 1) * kstep;
            const char* a2 = last ? nA : cA + (size_t)(t + 2) * kstep; const char* b2 = last ? nB : cB + (size_t)(t + 2) * kstep;
            const char* a3 = a2 + kstep; const char* b3 = b2 + kstep;
            if (last && has_next) S.a_ready(nxt);
            PG8_LDB(B0, 0, 0); PG8_SCHED; PG8_LDA(At, 0, 0); PG8_STAGE(PG8_SA(1, 1), a1 + hstepA, voffA);
            PG8_WAIT_L(8); PG8_BAR; PG8_WAIT_L(0); PG8_MMA(0, 0, At, B0); PG8_BAR; PG8_SCHED;
            PG8_LDB(B1, 0, 1); PG8_STAGE(PG8_SB(0, 0), b2, voffB);
            PG8_BAR; PG8_WAIT_L(0); PG8_MMA(0, 1, At, B1); PG8_BAR;
            PG8_LDA(At, 0, 1); PG8_STAGE(PG8_SA(0, 0), a2, voffA);
            PG8_BAR; PG8_WAIT_L(0); PG8_MMA(1, 0, At, B0); PG8_BAR; PG8_SCHED;
            PG8_STAGE(PG8_SB(0, 1), b2 + hstepB, voffB);
            PG8_WAIT_V(6); PG8_BAR; PG8_MMA(1, 1, At, B1); PG8_BAR;
            PG8_LDB(B0, 1, 0); PG8_SCHED; PG8_LDA(At, 1, 0); PG8_STAGE(PG8_SA(0, 1), a2 + hstepA, voffA);
            PG8_WAIT_L(8); PG8_BAR; PG8_WAIT_L(0); PG8_MMA(0, 0, At, B0); PG8_BAR; PG8_SCHED;
            PG8_LDB(B1, 1, 1); PG8_STAGE(PG8_SB(1, 0), b3, voffB);
            PG8_BAR; PG8_WAIT_L(0); PG8_MMA(0, 1, At, B1); PG8_BAR;
            PG8_LDA(At, 1, 1); PG8_STAGE(PG8_SA(1, 0), a3, voffA);
            PG8_BAR; PG8_WAIT_L(0); PG8_MMA(1, 0, At, B0); PG8_BAR; PG8_SCHED;
            PG8_STAGE(PG8_SB(1, 1), b3 + hstepB, voffB);
            PG8_WAIT_V(6); PG8_BAR; PG8_MMA(1, 1, At, B1); PG8_BAR;
        }
        const bool keep = E(acc, cur, wr, wc, fr, fq); S.done(cur);
        if (!has_next) break;
        if (!keep) {
#pragma unroll
        for (int a = 0; a < 2; ++a)
#pragma unroll
            for (int b = 0; b < 2; ++b)
#pragma unroll
                for (int m = 0; m < 4; ++m)
#pragma unroll
                    for (int n = 0; n < 2; ++n) acc[a][b][m][n] = (f32x4){0.f, 0.f, 0.f, 0.f};
        }
        cur = nxt; cA = nA; cB = nB; ++ui;
    }
    PG8_WAIT_V(0);
    if (wr == 0) PG8_BAR;
    PG8_BAR;
#undef PG8_SA
#undef PG8_SB
#undef PG8_STAGE
#undef PG8_LDA
#undef PG8_LDB
#undef PG8_MMA
#undef PG8_WAIT_V
#undef PG8_WAIT_L
#undef PG8_BAR
#undef PG8_SCHED
}

struct EpiBf16Store {
    static constexpr bool PERM = true;
    bf16_t* O; int ldc;
    __device__ __forceinline__ bool operator()(Acc& acc, const Unit& u, int wr, int wc, int fr, int fq) const {
        const int row0 = u.pm * BM + wr * 64 + fr, col0 = u.pn * BM + wc * 32 + 8 * fq;
#pragma unroll
        for (int ai = 0; ai < 2; ++ai)
#pragma unroll
            for (int m = 0; m < 4; ++m) { bf16_t* rowp = O + (size_t)(row0 + ai * HALF + m * 16) * ldc + col0;
#pragma unroll
                for (int bj = 0; bj < 2; ++bj) { const f32x4 v0 = acc[ai][bj][m][0], v1 = acc[ai][bj][m][1];
                    u32x4 w; w.x = pk2(v0[0], v0[1]); w.y = pk2(v0[2], v0[3]); w.z = pk2(v1[0], v1[1]); w.w = pk2(v1[2], v1[3]);
                    *(u32x4*)(rowp + bj * HALF) = w; } }
        return false;
    }
};
struct EpiWin {
    static constexpr bool PERM = true;
    bf16_t* O; int ldc;
    __device__ __forceinline__ bool operator()(Acc& acc, const Unit& u, int wr, int wc, int fr, int fq) const {
        const int row0 = u.pm * BM + wr * 64 + fr, col0 = u.pn * BM + wc * 32 + 8 * fq;
#pragma unroll
        for (int bj = 0; bj < 2; ++bj) { const bool gate = (col0 + bj * HALF) >= GATE_OFF;
#pragma unroll
            for (int ai = 0; ai < 2; ++ai)
#pragma unroll
                for (int m = 0; m < 4; ++m) { f32x4 v0 = acc[ai][bj][m][0], v1 = acc[ai][bj][m][1];
                    if (gate) {
#pragma unroll
                        for (int j = 0; j < 4; ++j) { v0[j] = __builtin_amdgcn_rcpf(1.0f + __expf(-v0[j])); v1[j] = __builtin_amdgcn_rcpf(1.0f + __expf(-v1[j])); } }
                    u32x4 w; w.x = pk2(v0[0], v0[1]); w.y = pk2(v0[2], v0[3]); w.z = pk2(v1[0], v1[1]); w.w = pk2(v1[2], v1[3]);
                    *(u32x4*)(O + (size_t)(row0 + ai * HALF + m * 16) * ldc + col0 + bj * HALF) = w; } }
        return false;
    }
};
struct EpiNone { static constexpr bool PERM = true;
    __device__ __forceinline__ bool operator()(Acc& acc, const Unit&, int, int, int, int) const {
#pragma unroll
        for (int a = 0; a < 2; ++a)
#pragma unroll
            for (int b = 0; b < 2; ++b)
#pragma unroll
                for (int m = 0; m < 4; ++m)
#pragma unroll
                    for (int n = 0; n < 2; ++n) asm volatile("" :: "v"(acc[a][b][m][n]));
        return false; } };
struct EpiGlu {
    static constexpr bool PERM = true;
    const bf16_t* GG; const float* bias; bf16_t* Y4;
    __device__ __forceinline__ bool operator()(Acc& acc, const Unit& u, int wr, int wc, int fr, int fq) const {
        const int row0 = u.pm * BM + wr * 64 + fr, col0 = u.pn * BM + wc * 32 + 8 * fq;
#pragma unroll
        for (int bj = 0; bj < 2; ++bj) { const int col = col0 + bj * HALF; const f32x4 b0 = *(const f32x4*)(bias + col), b1 = *(const f32x4*)(bias + col + 4);
#pragma unroll
            for (int ai = 0; ai < 2; ++ai)
#pragma unroll
                for (int m = 0; m < 4; ++m) { const size_t row = (size_t)(row0 + ai * HALF + m * 16);
                    float gg[8]; unpack8(*(const u32x4*)(GG + row * BW + col), gg);
                    const f32x4 v0 = acc[ai][bj][m][0] + b0, v1 = acc[ai][bj][m][1] + b1;
                    u32x4 w; w.x = pk2(gg[0] * sigmoidf_(v0[0]), gg[1] * sigmoidf_(v0[1])); w.y = pk2(gg[2] * sigmoidf_(v0[2]), gg[3] * sigmoidf_(v0[3]));
                    w.z = pk2(gg[4] * sigmoidf_(v1[0]), gg[5] * sigmoidf_(v1[1])); w.w = pk2(gg[6] * sigmoidf_(v1[2]), gg[7] * sigmoidf_(v1[3]));
                    *(u32x4*)(Y4 + row * DM + 1024 + col) = w; } }
        return false;
    }
};
struct EpiBranch {
    static constexpr bool PERM = true;
    const bf16_t* P; bf16_t* ACCb;
    __device__ __forceinline__ bool operator()(Acc& acc, const Unit& u, int wr, int wc, int fr, int fq) const {
        const int row0 = u.pm * BM + wr * 64 + fr, col0 = u.pn * BM + wc * 32 + 8 * fq; const int k = u.k;
#pragma unroll
        for (int ai = 0; ai < 2; ++ai)
#pragma unroll
            for (int m = 0; m < 4; ++m) { const size_t row = (size_t)(row0 + ai * HALF + m * 16);
#pragma unroll
                for (int bj = 0; bj < 2; ++bj) { const int col = col0 + bj * HALF;
                    float g0[8]; unpack8(*(const u32x4*)(P + row * LDP + GATE_OFF + k * DM + col), g0);
                    float s[8];
                    if (k < 3) { float g1[8]; unpack8(*(const u32x4*)(P + row * LDP + GATE_OFF + (k + 1) * DM + col), g1);
#pragma unroll
                        for (int j = 0; j < 8; ++j) s[j] = g0[j] * __builtin_amdgcn_rcpf(g1[j]); }
                    else {
#pragma unroll
                        for (int j = 0; j < 8; ++j) s[j] = g0[j]; }
                    f32x4 v0 = acc[ai][bj][m][0], v1 = acc[ai][bj][m][1];
                    v0[0] *= s[0]; v0[1] *= s[1]; v0[2] *= s[2]; v0[3] *= s[3]; v1[0] *= s[4]; v1[1] *= s[5]; v1[2] *= s[6]; v1[3] *= s[7];
                    if (k < 3) { acc[ai][bj][m][0] = v0; acc[ai][bj][m][1] = v1; }
                    else { u32x4 w; w.x = pk2(v0[0], v0[1]); w.y = pk2(v0[2], v0[3]); w.z = pk2(v1[0], v1[1]); w.w = pk2(v1[2], v1[3]); *(u32x4*)(ACCb + row * DM + col) = w; } } }
        return k < 3;
    }
};
struct EpiResid {
    static constexpr bool PERM = false;
    float* XS; const float* srcLat; const float* srcCtx; const float* MODl; int gidx;
    __device__ __forceinline__ bool operator()(Acc& acc, const Unit& u, int wr, int wc, int fr, int fq) const {
        const int row0 = u.pm * BM + wr * 64 + fr, col0 = u.pn * BM + wc * 32 + 4 * fq;
        const int r = (u.pm * BM) < NLAT ? (u.pm * BM) / SEQ : 4;
        const float* src = (u.pm * BM) < NLAT ? srcLat : srcCtx;
        const float* mg = MODl + (size_t)(r * 6 + gidx) * DM;
#pragma unroll
        for (int bj = 0; bj < 2; ++bj)
#pragma unroll
            for (int n = 0; n < 2; ++n) { const int col = col0 + bj * HALF + n * 16; const f32x4 gm = *(const f32x4*)(mg + col);
#pragma unroll
                for (int ai = 0; ai < 2; ++ai)
#pragma unroll
                    for (int m = 0; m < 4; ++m) { const size_t o = (size_t)(row0 + ai * HALF + m * 16) * DM + col; *(f32x4*)(XS + o) = *(const f32x4*)(src + o) + gm * acc[ai][bj][m][n]; } }
        return false;
    }
};
struct EpiMoe1 {
    static constexpr bool PERM = true;
    bf16_t* HID;
    __device__ __forceinline__ bool operator()(Acc& acc, const Unit& u, int wr, int wc, int fr, int fq) const {
        const size_t row0 = (size_t)u.z * MOE_PAD + u.pm * BM + wr * 64 + fr; const int col0 = u.pn * HALF + wc * 32 + 8 * fq;
#pragma unroll
        for (int ai = 0; ai < 2; ++ai)
#pragma unroll
            for (int m = 0; m < 4; ++m) { const f32x4 g0 = acc[ai][0][m][0], g1 = acc[ai][0][m][1], u0 = acc[ai][1][m][0], u1 = acc[ai][1][m][1];
                float h[8];
#pragma unroll
                for (int j = 0; j < 4; ++j) { h[j] = g0[j] * __builtin_amdgcn_rcpf(1.0f + __expf(-g0[j])) * u0[j]; h[4 + j] = g1[j] * __builtin_amdgcn_rcpf(1.0f + __expf(-g1[j])) * u1[j]; }
                u32x4 w; w.x = pk2(h[0], h[1]); w.y = pk2(h[2], h[3]); w.z = pk2(h[4], h[5]); w.w = pk2(h[6], h[7]);
                *(u32x4*)(HID + (row0 + ai * HALF + m * 16) * DEXP + col0) = w; }
        return false;
    }
};
struct EpiMoeY {
    static constexpr bool PERM = true;
    bf16_t* O;
    __device__ __forceinline__ bool operator()(Acc& acc, const Unit& u, int wr, int wc, int fr, int fq) const {
        const size_t row0 = (size_t)u.z * MOE_PAD + u.pm * BM + wr * 64 + fr; const int col0 = u.pn * BM + wc * 32 + 8 * fq;
#pragma unroll
        for (int ai = 0; ai < 2; ++ai)
#pragma unroll
            for (int m = 0; m < 4; ++m) { bf16_t* rowp = O + (row0 + ai * HALF + m * 16) * DM + col0;
#pragma unroll
                for (int bj = 0; bj < 2; ++bj) { const f32x4 v0 = acc[ai][bj][m][0], v1 = acc[ai][bj][m][1];
                    u32x4 w; w.x = pk2(v0[0], v0[1]); w.y = pk2(v0[2], v0[3]); w.z = pk2(v1[0], v1[1]); w.w = pk2(v1[2], v1[3]);
                    *(u32x4*)(rowp + bj * HALF) = w; } }
        return false;
    }
};

struct SchedS5a {
    int c;
    __device__ __forceinline__ bool next(int i, Unit& u) const { if (i > 0 || c >= 64) return false; u.z = c >> 1; u.pm = c & 1; u.pn = 0; u.k = 0;
        u.ao = ((long long)u.z * 512 + u.pm * BM) * 768 * 2; u.bo = (long long)u.z * 256 * 512 * 2; return true; }
    __device__ __forceinline__ void a_ready(const Unit&) const {}
    __device__ __forceinline__ void done(const Unit&) const {}
};
struct SchedS5b {
    int c;
    __device__ __forceinline__ bool next(int i, Unit& u) const { if (i > 0 || c >= 128) return false; u.z = c >> 2; u.pm = (c >> 1) & 1; u.pn = c & 1; u.k = 0;
        u.ao = ((long long)u.z * 512 + u.pm * BM) * 768 * 2; u.bo = ((long long)u.z * 512 + u.pn * BM) * 768 * 2; return true; }
    __device__ __forceinline__ void a_ready(const Unit&) const {}
    __device__ __forceinline__ void done(const Unit&) const {}
};
struct EpiXloc {
    static constexpr bool PERM = false;
    float* XL;
    __device__ __forceinline__ bool operator()(Acc& acc, const Unit& u, int wr, int wc, int fr, int fq) const {
        const int row0 = u.pm * BM + wr * 64 + fr, col0 = wc * 32 + 4 * fq; float* base = XL + (size_t)u.z * 512 * 256;
#pragma unroll
        for (int ai = 0; ai < 2; ++ai)
#pragma unroll
            for (int m = 0; m < 4; ++m) { float* rowp = base + (size_t)(row0 + ai * HALF + m * 16) * 256 + col0;
#pragma unroll
                for (int bj = 0; bj < 2; ++bj)
#pragma unroll
                    for (int n = 0; n < 2; ++n) *(f32x4*)(rowp + bj * HALF + n * 16) = acc[ai][bj][m][n]; }
        return false;
    }
};
struct EpiS5Out {
    static constexpr bool PERM = true;
    const bf16_t* P; const float* dskip; bf16_t* GG;
    __device__ __forceinline__ bool operator()(Acc& acc, const Unit& u, int wr, int wc, int fr, int fq) const {
        const int row0 = u.pm * BM + wr * 64 + fr, col0 = u.pn * BM + wc * 32 + 8 * fq; const int g = u.z;
#pragma unroll
        for (int bj = 0; bj < 2; ++bj) { const int col = col0 + bj * HALF; const int t = col >> 4, c0 = col & 15;
            const f32x4 d0 = *(const f32x4*)(dskip + g * 16 + c0), d1 = *(const f32x4*)(dskip + g * 16 + c0 + 4);
#pragma unroll
            for (int ai = 0; ai < 2; ++ai)
#pragma unroll
                for (int m = 0; m < 4; ++m) { const size_t tok = (size_t)(row0 + ai * HALF + m * 16) * 32 + t;
                    float uu[8]; unpack8(*(const u32x4*)(P + tok * LDP + S5_OFF + g * 16 + c0), uu);
                    const f32x4 v0 = acc[ai][bj][m][0], v1 = acc[ai][bj][m][1];
                    float y[8] = {v0[0] + d0[0] * uu[0], v0[1] + d0[1] * uu[1], v0[2] + d0[2] * uu[2], v0[3] + d0[3] * uu[3], v1[0] + d1[0] * uu[4], v1[1] + d1[1] * uu[5], v1[2] + d1[2] * uu[6], v1[3] + d1[3] * uu[7]};
#pragma unroll
                    for (int j = 0; j < 8; ++j) y[j] = 0.5f * y[j] * (1.0f + tanhf(0.7978845608028654f * (y[j] + 0.044715f * y[j] * y[j] * y[j])));
                    u32x4 w; w.x = pk2(y[0], y[1]); w.y = pk2(y[2], y[3]); w.z = pk2(y[4], y[5]); w.w = pk2(y[6], y[7]);
                    *(u32x4*)(GG + tok * BW + g * 16 + c0) = w; } }
        return false;
    }
};
}


__device__ __forceinline__ float wave_scan_incl(float v, int lane) {
#pragma unroll
    for (int o = 1; o < 64; o <<= 1) { const float t = __shfl_up(v, o); if (lane >= o) v += t; }
    return v;
}
__device__ __forceinline__ float wave_scanmax_incl(float v, int lane) {
#pragma unroll
    for (int o = 1; o < 64; o <<= 1) { const float t = __shfl_up(v, o); if (lane >= o) v = fmaxf(v, t); }
    return v;
}
__device__ __forceinline__ float wave_max(float v) {
#pragma unroll
    for (int o = 32; o >= 1; o >>= 1) v = fmaxf(v, __shfl_xor(v, o));
    return v;
}
__device__ __forceinline__ void unpack8h(const u32x4 w, bf16_t (&h)[8]) {
    h[0] = (bf16_t)(w.x & 0xFFFFu); h[1] = (bf16_t)(w.x >> 16); h[2] = (bf16_t)(w.y & 0xFFFFu); h[3] = (bf16_t)(w.y >> 16);
    h[4] = (bf16_t)(w.z & 0xFFFFu); h[5] = (bf16_t)(w.z >> 16); h[6] = (bf16_t)(w.w & 0xFFFFu); h[7] = (bf16_t)(w.w >> 16);
}

__device__ __forceinline__ int tokblock_of(int b, int dir, int c) { if (c < 4) return 256 + b * 4 + (dir ? 3 - c : c); const int j = c - 4; return b * 64 + (dir ? 63 - j : j); }
__device__ __forceinline__ u32x4 rev8h(const u32x4 v) { u32x4 r; r.x = (v.w >> 16) | (v.w << 16); r.y = (v.z >> 16) | (v.z << 16); r.z = (v.y >> 16) | (v.y << 16); r.w = (v.x >> 16) | (v.x << 16); return r; }
__device__ __forceinline__ u32x4 scale8h(const u32x4 v, const float4 a, const float4 b) { float f[8]; unpack8(v, f); u32x4 r; r.x = pk2(f[0] * a.x, f[1] * a.y); r.y = pk2(f[2] * a.z, f[3] * a.w); r.z = pk2(f[4] * b.x, f[5] * b.y); r.w = pk2(f[6] * b.z, f[7] * b.w); return r; }
__device__ __forceinline__ float dot8h(const u32x4 v, const float4 a, const float4 b) { float f[8]; unpack8(v, f); return (f[0] * a.x + f[1] * a.y) + (f[2] * a.z + f[3] * a.w) + (f[4] * b.x + f[5] * b.y) + (f[6] * b.z + f[7] * b.w); }
#define ML_FRAG_LOAD(KF, VF, cc_) do { const int tb_ = tokblock_of(b, dir, (cc_)); const bf16_t* kb_ = KTg + ((size_t)tb_ * 512 + h * 128 + 64 * wd + r16) * 64 + q4 * 8; const bf16_t* vb_ = VTg + ((size_t)tb_ * 512 + h * 128 + 32 * we + r16) * 64 + q4 * 8; \
        _Pragma("unroll") for (int ks_ = 0; ks_ < 2; ++ks_) { _Pragma("unroll") for (int j_ = 0; j_ < 2; ++j_) VF[j_][ks_] = *(const u32x4*)(vb_ + (size_t)j_ * 16 * 64 + ks_ * 32); \
            _Pragma("unroll") for (int j_ = 0; j_ < 4; ++j_) KF[j_][ks_] = *(const u32x4*)(kb_ + (size_t)j_ * 16 * 64 + ks_ * 32); } } while (0)
#define ML_CHUNK(c_, KF, VF, KFN, VFN) do { const int c = (c_); \
        if (c + 1 < 68) ML_FRAG_LOAD(KFN, VFN, c + 1);                        \
        const float ig = bf2f(gi0) + gbi, fg = bf2f(gf0) + gbf; gi0 = gi1; gf0 = gf1; \
        if (c + 2 < 68) { const size_t t2 = (size_t)step_tok(b, dir, (c + 2) * 64 + lane); gi1 = Pm[t2 * LDP + gcol_i]; gf1 = Pm[t2 * LDP + gcol_f]; } \
        const float lf = fminf(fg, 0.f) - log1pf(expf(-fabsf(fg))); \
        const float bcs = wave_scan_incl(lf, lane); const float blast = __shfl(bcs, 63); const float beta = wave_max(blast - bcs + ig); \
        const float mo = fmaxf(m + blast, beta); const float wsv = expf(blast - bcs + ig - mo); const float dec = expf(blast + m - mo); \
        wsl[dir ? 63 - lane : lane] = wsv; \
        {   bf16_t* cs = CST + (size_t)(chain * 68 + c) * 128 * 128; \
            _Pragma("unroll") for (int je = 0; je < 2; ++je) _Pragma("unroll") for (int jd = 0; jd < 4; ++jd) { const int e = 32 * we + 16 * je + r16, d0 = 64 * wd + 16 * jd + q4 * 4; \
                u32x2 pk; pk.x = pk2(acc[je][jd][0], acc[je][jd][1]); pk.y = pk2(acc[je][jd][2], acc[je][jd][3]); *(u32x2*)(cs + (size_t)e * 128 + d0) = pk; } \
            if (we == 0) { _Pragma("unroll") for (int jd = 0; jd < 4; ++jd) { float nv = npart[jd]; nv += __shfl_xor(nv, 16); nv += __shfl_xor(nv, 32); if (q4 == 0) NST[(size_t)(chain * 68 + c) * 128 + 64 * wd + 16 * jd + r16] = nv; } \
                if (tid == 0) MST[chain * 68 + c] = m; } } \
        asm volatile("s_waitcnt lgkmcnt(0)" ::: "memory"); \
        bf16x8 vfr[2][2]; \
        _Pragma("unroll") for (int ks = 0; ks < 2; ++ks) { const float4 wa = *(const float4*)(wsl + ks * 32 + q4 * 8), wb = *(const float4*)(wsl + ks * 32 + q4 * 8 + 4); \
            _Pragma("unroll") for (int je = 0; je < 2; ++je) { const u32x4 sv = scale8h(VF[je][ks], wa, wb); vfr[je][ks] = *(const bf16x8*)&sv; } \
            if (we == 0) { _Pragma("unroll") for (int jd = 0; jd < 4; ++jd) npart[jd] = (ks == 0 ? dec * npart[jd] : npart[jd]) + dot8h(KF[jd][ks], wa, wb); } } \
        asm volatile("" ::: "memory"); \
        _Pragma("unroll") for (int je = 0; je < 2; ++je) _Pragma("unroll") for (int jd = 0; jd < 4; ++jd) acc[je][jd] = acc[je][jd] * dec; \
        _Pragma("unroll") for (int ks = 0; ks < 2; ++ks) _Pragma("unroll") for (int je = 0; je < 2; ++je) _Pragma("unroll") for (int jd = 0; jd < 4; ++jd) \
            acc[je][jd] = __builtin_amdgcn_mfma_f32_16x16x32_bf16(*(const bf16x8*)&KF[jd][ks], vfr[je][ks], acc[je][jd], 0, 0, 0); \
        m = mo; } while (0)
__device__ __forceinline__ void mlstm_state_pass(const int chain, const bf16_t* __restrict__ Pm, const bf16_t* __restrict__ KTg, const bf16_t* __restrict__ VTg, const float* __restrict__ gate_b,
                                                 bf16_t* __restrict__ CST, float* __restrict__ NST, float* __restrict__ MST, unsigned char* shm, const int tid) {
    const int dir = chain & 1, h = (chain >> 1) & 3, b = chain >> 3, lane = tid & 63, w = tid >> 6, we = w >> 1, wd = w & 1, q4 = lane >> 4, r16 = lane & 15;
    float* wsl = (float*)shm + w * 64;
    const float gbi = gate_b[(dir * 2 + 0) * 4 + h], gbf = gate_b[(dir * 2 + 1) * 4 + h];
    f32x4 acc[2][4];
#pragma unroll
    for (int je = 0; je < 2; ++je)
#pragma unroll
        for (int jd = 0; jd < 4; ++jd) acc[je][jd] = (f32x4){0.f, 0.f, 0.f, 0.f};
    float npart[4] = {0.f, 0.f, 0.f, 0.f};
    float m = 0.f;
    const int gcol_i = ML_OFF + 2048 + (dir * 2 + 0) * 4 + h, gcol_f = ML_OFF + 2048 + (dir * 2 + 1) * 4 + h;
    bf16_t gi0, gf0, gi1, gf1; u32x4 kfA[4][2], vfA[2][2], kfB[4][2], vfB[2][2];
    { const size_t t0 = (size_t)step_tok(b, dir, lane), t1 = (size_t)step_tok(b, dir, 64 + lane);
      gi0 = Pm[t0 * LDP + gcol_i]; gf0 = Pm[t0 * LDP + gcol_f]; gi1 = Pm[t1 * LDP + gcol_i]; gf1 = Pm[t1 * LDP + gcol_f]; }
    ML_FRAG_LOAD(kfA, vfA, 0);
    for (int c2 = 0; c2 < 68; c2 += 2) { ML_CHUNK(c2, kfA, vfA, kfB, vfB); ML_CHUNK(c2 + 1, kfB, vfB, kfA, vfA); }
}
#undef ML_CHUNK
#undef ML_FRAG_LOAD
__device__ __forceinline__ void mlstm_out_item(const int chain, const int c, const bf16_t* __restrict__ Pm, const bf16_t* __restrict__ QKb, const bf16_t* __restrict__ VTg, const float* __restrict__ gate_b,
                                               const bf16_t* __restrict__ CST, const float* __restrict__ NST, const float* __restrict__ MST, float* __restrict__ Hout, unsigned char* shm, const int tid) {
    const int dir = chain & 1, h = (chain >> 1) & 3, b = chain >> 3, lane = tid & 63, w = tid >> 6;
    bf16_t* Qs = (bf16_t*)shm; bf16_t* Ks = (bf16_t*)(shm + 17408); bf16_t* VT = (bf16_t*)(shm + 34816); bf16_t* Cs = (bf16_t*)(shm + 53248); bf16_t* Ss = (bf16_t*)(shm + 88064);
    float* sc = (float*)(shm + 97280);
    __syncthreads();
#pragma unroll
    for (int i = 0; i < 2; ++i) { const int pid = tid + i * 512; const int s = pid >> 4, x0 = (pid & 15) * 8; const size_t toks = (size_t)step_tok(b, dir, c * 64 + s);
        *(u32x4*)(Qs + s * 136 + x0) = *(const u32x4*)(QKb + toks * 1024 + h * 128 + x0);
        *(u32x4*)(Ks + s * 136 + x0) = *(const u32x4*)(QKb + toks * 1024 + 512 + h * 128 + x0);
        { const int e = pid >> 3, o = pid & 7;
          const u32x4 vv = *(const u32x4*)(VTg + ((size_t)tokblock_of(b, dir, c) * 512 + h * 128 + e) * 64 + (dir ? 7 - o : o) * 8);
          *(u32x4*)(VT + e * 72 + o * 8) = dir ? rev8h(vv) : vv; } }
#pragma unroll
    for (int i = 0; i < 4; ++i) { const int pid = tid + i * 512; const int e = pid >> 4, x0 = (pid & 15) * 8;
        *(u32x4*)(Cs + e * 136 + x0) = *(const u32x4*)(CST + ((size_t)(chain * 68 + c) * 128 + e) * 128 + x0); }
    if (tid < 128) sc[384 + tid] = NST[(size_t)(chain * 68 + c) * 128 + tid];
    if (w == 0) {
        const float gbi = gate_b[(dir * 2 + 0) * 4 + h], gbf = gate_b[(dir * 2 + 1) * 4 + h];
        const size_t tokl = (size_t)step_tok(b, dir, c * 64 + lane);
        const float ig = bf2f(Pm[tokl * LDP + ML_OFF + 2048 + (dir * 2 + 0) * 4 + h]) + gbi;
        const float fg = bf2f(Pm[tokl * LDP + ML_OFF + 2048 + (dir * 2 + 1) * 4 + h]) + gbf;
        const float lf = fminf(fg, 0.f) - log1pf(expf(-fabsf(fg)));
        const float bcs = wave_scan_incl(lf, lane); const float gsv = ig - bcs; const float pm = wave_scanmax_incl(gsv, lane);
        const float m_in = MST[chain * 68 + c]; const float mt = bcs + fmaxf(m_in, pm);
        sc[lane] = bcs; sc[64 + lane] = gsv; sc[128 + lane] = mt; sc[192 + lane] = expf(bcs + m_in - mt); sc[256 + lane] = expf(-mt);
    }
    __syncthreads();
    const int tt = w >> 1;
    {   f32x4 aS[2] = {(f32x4){0.f, 0.f, 0.f, 0.f}, (f32x4){0.f, 0.f, 0.f, 0.f}};
#pragma unroll
        for (int ks = 0; ks < 4; ++ks) { const bf16x8 af = *(const bf16x8*)(Qs + (16 * tt + (lane & 15)) * 136 + ks * 32 + (lane >> 4) * 8);
#pragma unroll
            for (int i = 0; i < 2; ++i) { const int st = (w & 1) * 2 + i; const bf16x8 bfr = *(const bf16x8*)(Ks + (16 * st + (lane & 15)) * 136 + ks * 32 + (lane >> 4) * 8);
                aS[i] = __builtin_amdgcn_mfma_f32_16x16x32_bf16(af, bfr, aS[i], 0, 0, 0); } }
        float rs[4] = {0.f, 0.f, 0.f, 0.f};
#pragma unroll
        for (int i = 0; i < 2; ++i) { const int s = 16 * ((w & 1) * 2 + i) + (lane & 15); const float gsv = sc[64 + s];
#pragma unroll
            for (int q = 0; q < 4; ++q) { const int t = 16 * tt + (lane >> 4) * 4 + q; const float val = (s <= t) ? aS[i][q] * expf(sc[t] + gsv - sc[128 + t]) : 0.f; Ss[t * 72 + s] = f2bf(val); rs[q] += val; } }
#pragma unroll
        for (int q = 0; q < 4; ++q) { float r = rs[q]; r += __shfl_xor(r, 1); r += __shfl_xor(r, 2); r += __shfl_xor(r, 4); r += __shfl_xor(r, 8);
            if ((lane & 15) == 0) sc[512 + (w & 1) * 64 + 16 * tt + (lane >> 4) * 4 + q] = r; }
        {   const int t = tid >> 3, part = tid & 7; float dot = 0.f;
#pragma unroll
            for (int j = 0; j < 16; ++j) dot += bf2f(Qs[t * 136 + part * 16 + j]) * sc[384 + part * 16 + j];
            dot += __shfl_xor(dot, 1); dot += __shfl_xor(dot, 2); dot += __shfl_xor(dot, 4);
            if (part == 0) sc[640 + t] = sc[192 + t] * dot; }
    }
    __syncthreads();
    {   f32x4 aN[4];
#pragma unroll
        for (int i = 0; i < 4; ++i) aN[i] = (f32x4){0.f, 0.f, 0.f, 0.f};
#pragma unroll
        for (int ks = 0; ks < 4; ++ks) { const bf16x8 af = *(const bf16x8*)(Qs + (16 * tt + (lane & 15)) * 136 + ks * 32 + (lane >> 4) * 8);
#pragma unroll
            for (int i = 0; i < 4; ++i) { const int et = (w & 1) * 4 + i; const bf16x8 bfr = *(const bf16x8*)(Cs + (16 * et + (lane & 15)) * 136 + ks * 32 + (lane >> 4) * 8);
                aN[i] = __builtin_amdgcn_mfma_f32_16x16x32_bf16(af, bfr, aN[i], 0, 0, 0); } }
#pragma unroll
        for (int q = 0; q < 4; ++q) { const float it = sc[192 + 16 * tt + (lane >> 4) * 4 + q];
#pragma unroll
            for (int i = 0; i < 4; ++i) aN[i][q] *= it; }
#pragma unroll
        for (int ks = 0; ks < 2; ++ks) { const bf16x8 af = *(const bf16x8*)(Ss + (16 * tt + (lane & 15)) * 72 + ks * 32 + (lane >> 4) * 8);
#pragma unroll
            for (int i = 0; i < 4; ++i) { const int et = (w & 1) * 4 + i; const bf16x8 bfr = *(const bf16x8*)(VT + (16 * et + (lane & 15)) * 72 + ks * 32 + (lane >> 4) * 8);
                aN[i] = __builtin_amdgcn_mfma_f32_16x16x32_bf16(af, bfr, aN[i], 0, 0, 0); } }
#pragma unroll
        for (int q = 0; q < 4; ++q) { const int t = 16 * tt + (lane >> 4) * 4 + q; const size_t tokt = (size_t)step_tok(b, dir, c * 64 + t); const float dn = fmaxf(fabsf((sc[512 + t] + sc[576 + t]) + sc[640 + t]), sc[256 + t]);
#pragma unroll
            for (int i = 0; i < 4; ++i) { const int e = 16 * ((w & 1) * 4 + i) + (lane & 15); Hout[tokt * BW + h * 128 + e] = aN[i][q] / dn; } }
    }
}


#define SD_FRAG_LOAD(BF, XF, cc_) do { const int tb_ = tokblock_of(b, dir, (cc_)); const bf16_t* bb_ = BTg + ((size_t)tb_ * 256 + grp * 128 + 64 * (w >> 2) + r16) * 64 + q4 * 8; const bf16_t* xb_ = XTg + ((size_t)tb_ * 512 + h * 64 + 16 * (w & 3) + r16) * 64 + q4 * 8; \
        _Pragma("unroll") for (int ks_ = 0; ks_ < 2; ++ks_) { XF[ks_] = *(const u32x4*)(xb_ + ks_ * 32); _Pragma("unroll") for (int j_ = 0; j_ < 4; ++j_) BF[j_][ks_] = *(const u32x4*)(bb_ + (size_t)j_ * 16 * 64 + ks_ * 32); } } while (0)
#define SD_CHUNK(c_, BF, XF, BFN, XFN) do { const int c = (c_); \
        if (c + 1 < 68) SD_FRAG_LOAD(BFN, XFN, c + 1); \
        const float xv = bf2f(d0) + dtb; const float dtv = xv > 20.f ? xv : log1pf(expf(xv)); \
        d0 = d1; if (c + 2 < 68) d1 = Pm[(size_t)step_tok(b, dir, (c + 2) * 64 + lane) * LDP + dcol]; \
        const float cs = wave_scan_incl(dtv * Aa, lane); const float cl = __shfl(cs, 63); const float scl = dtv * expf(cl - cs); const float dec = expf(cl); \
        wsl[dir ? 63 - lane : lane] = scl; \
        {   bf16_t* ss = SSTb + (size_t)(chain * 68 + c) * 64 * 128; const int p = 16 * (w & 3) + r16; \
            _Pragma("unroll") for (int j = 0; j < 4; ++j) { const int n0 = 16 * ((w >> 2) * 4 + j) + q4 * 4; u32x2 pk; pk.x = pk2(acc[j][0], acc[j][1]); pk.y = pk2(acc[j][2], acc[j][3]); *(u32x2*)(ss + (size_t)p * 128 + n0) = pk; } } \
        asm volatile("s_waitcnt lgkmcnt(0)" ::: "memory"); \
        bf16x8 xfr[2]; \
        _Pragma("unroll") for (int ks = 0; ks < 2; ++ks) { const float4 wa = *(const float4*)(wsl + ks * 32 + q4 * 8), wb = *(const float4*)(wsl + ks * 32 + q4 * 8 + 4); const u32x4 sv = scale8h(XF[ks], wa, wb); xfr[ks] = *(const bf16x8*)&sv; } \
        asm volatile("" ::: "memory"); \
        _Pragma("unroll") for (int j = 0; j < 4; ++j) acc[j] = acc[j] * dec; \
        _Pragma("unroll") for (int ks = 0; ks < 2; ++ks) _Pragma("unroll") for (int j = 0; j < 4; ++j) acc[j] = __builtin_amdgcn_mfma_f32_16x16x32_bf16(*(const bf16x8*)&BF[j][ks], xfr[ks], acc[j], 0, 0, 0); } while (0)
__device__ __forceinline__ void ssd_state_pass(const int chain, const bf16_t* __restrict__ Pm, const bf16_t* __restrict__ BTg, const bf16_t* __restrict__ XTg, const float Aa, const float dtb,
                                               bf16_t* __restrict__ SSTb, unsigned char* shm, const int tid) {
    const int dir = chain & 1, h = (chain >> 1) & 7, b = chain >> 4, grp = h >> 2, lane = tid & 63, w = tid >> 6, q4 = lane >> 4, r16 = lane & 15;
    float* wsl = (float*)shm + w * 64;
    f32x4 acc[4];
#pragma unroll
    for (int j = 0; j < 4; ++j) acc[j] = (f32x4){0.f, 0.f, 0.f, 0.f};
    const int dcol = SSD_OFF + 1536 + dir * 8 + h;
    bf16_t d0, d1; u32x4 bfA[4][2], xfA[2], bfB[4][2], xfB[2];
    d0 = Pm[(size_t)step_tok(b, dir, lane) * LDP + dcol]; d1 = Pm[(size_t)step_tok(b, dir, 64 + lane) * LDP + dcol];
    SD_FRAG_LOAD(bfA, xfA, 0);
    for (int c2 = 0; c2 < 68; c2 += 2) { SD_CHUNK(c2, bfA, xfA, bfB, xfB); SD_CHUNK(c2 + 1, bfB, xfB, bfA, xfA); }
}
#undef SD_CHUNK
#undef SD_FRAG_LOAD
__device__ __forceinline__ void ssd_out_item(const int chain, const int c, const bf16_t* __restrict__ Pm, const bf16_t* __restrict__ XBb, const bf16_t* __restrict__ XTg, const float Aa, const float dtb,
                                             const bf16_t* __restrict__ SSTb, float* __restrict__ Yout, unsigned char* shm, const int tid) {
    const int dir = chain & 1, h = (chain >> 1) & 7, b = chain >> 4, grp = h >> 2, lane = tid & 63, w = tid >> 6;
    bf16_t* Cs = (bf16_t*)shm; bf16_t* Bs = (bf16_t*)(shm + 17408); bf16_t* XT = (bf16_t*)(shm + 34816); bf16_t* Sin = (bf16_t*)(shm + 44032); bf16_t* Gs = (bf16_t*)(shm + 61440);
    float* sc = (float*)(shm + 70656);
    __syncthreads();
#pragma unroll
    for (int i = 0; i < 2; ++i) { const int pid = tid + i * 512; const int s = pid >> 4, x0 = (pid & 15) * 8; const size_t toks = (size_t)step_tok(b, dir, c * 64 + s);
        *(u32x4*)(Bs + s * 136 + x0) = *(const u32x4*)(XBb + toks * 1024 + 512 + grp * 128 + x0);
        *(u32x4*)(Cs + s * 136 + x0) = *(const u32x4*)(XBb + toks * 1024 + 768 + grp * 128 + x0);
        const int p = pid >> 4;
        *(u32x4*)(Sin + p * 136 + x0) = *(const u32x4*)(SSTb + ((size_t)(chain * 68 + c) * 64 + p) * 128 + x0); }
    {   const int p = tid >> 3, o = tid & 7;
        const u32x4 vv = *(const u32x4*)(XTg + ((size_t)tokblock_of(b, dir, c) * 512 + h * 64 + p) * 64 + (dir ? 7 - o : o) * 8);
        *(u32x4*)(XT + p * 72 + o * 8) = dir ? rev8h(vv) : vv; }
    if (w == 0) { const size_t tokl = (size_t)step_tok(b, dir, c * 64 + lane);
        const float xv = bf2f(Pm[tokl * LDP + SSD_OFF + 1536 + dir * 8 + h]) + dtb; const float dtv = xv > 20.f ? xv : log1pf(expf(xv));
        sc[lane] = wave_scan_incl(dtv * Aa, lane); sc[64 + lane] = dtv; }
    __syncthreads();
    {   const int lt = w >> 1;
        f32x4 aG[2] = {(f32x4){0.f, 0.f, 0.f, 0.f}, (f32x4){0.f, 0.f, 0.f, 0.f}};
#pragma unroll
        for (int ks = 0; ks < 4; ++ks) { const bf16x8 af = *(const bf16x8*)(Cs + (16 * lt + (lane & 15)) * 136 + ks * 32 + (lane >> 4) * 8);
#pragma unroll
            for (int i = 0; i < 2; ++i) { const int st = (w & 1) * 2 + i; const bf16x8 bfr = *(const bf16x8*)(Bs + (16 * st + (lane & 15)) * 136 + ks * 32 + (lane >> 4) * 8);
                aG[i] = __builtin_amdgcn_mfma_f32_16x16x32_bf16(af, bfr, aG[i], 0, 0, 0); } }
#pragma unroll
        for (int i = 0; i < 2; ++i) { const int s = 16 * ((w & 1) * 2 + i) + (lane & 15); const float css = sc[s], dts = sc[64 + s];
#pragma unroll
            for (int q = 0; q < 4; ++q) { const int t = 16 * lt + (lane >> 4) * 4 + q; const float val = (s <= t) ? aG[i][q] * expf(sc[t] - css) * dts : 0.f; Gs[t * 72 + s] = f2bf(val); } }
    }
    __syncthreads();
    {   const int lt = w >> 1;
        f32x4 aY[2] = {(f32x4){0.f, 0.f, 0.f, 0.f}, (f32x4){0.f, 0.f, 0.f, 0.f}};
#pragma unroll
        for (int ks = 0; ks < 4; ++ks) { const bf16x8 af = *(const bf16x8*)(Cs + (16 * lt + (lane & 15)) * 136 + ks * 32 + (lane >> 4) * 8);
#pragma unroll
            for (int i = 0; i < 2; ++i) { const int pt = (w & 1) * 2 + i; const bf16x8 bfr = *(const bf16x8*)(Sin + (16 * pt + (lane & 15)) * 136 + ks * 32 + (lane >> 4) * 8);
                aY[i] = __builtin_amdgcn_mfma_f32_16x16x32_bf16(af, bfr, aY[i], 0, 0, 0); } }
#pragma unroll
        for (int q = 0; q < 4; ++q) { const float ec = expf(sc[16 * lt + (lane >> 4) * 4 + q]); aY[0][q] *= ec; aY[1][q] *= ec; }
#pragma unroll
        for (int ks = 0; ks < 2; ++ks) { const bf16x8 af = *(const bf16x8*)(Gs + (16 * lt + (lane & 15)) * 72 + ks * 32 + (lane >> 4) * 8);
#pragma unroll
            for (int i = 0; i < 2; ++i) { const int pt = (w & 1) * 2 + i; const bf16x8 bfr = *(const bf16x8*)(XT + (16 * pt + (lane & 15)) * 72 + ks * 32 + (lane >> 4) * 8);
                aY[i] = __builtin_amdgcn_mfma_f32_16x16x32_bf16(af, bfr, aY[i], 0, 0, 0); } }
#pragma unroll
        for (int q = 0; q < 4; ++q) { const int t = 16 * lt + (lane >> 4) * 4 + q; const size_t tokt = (size_t)step_tok(b, dir, c * 64 + t);
#pragma unroll
            for (int i = 0; i < 2; ++i) { const int p = 16 * ((w & 1) * 2 + i) + (lane & 15); Yout[tokt * BW + h * 64 + p] = aY[i][q]; } }
    }
}


#define FIDX(i) ((i) + ((i) >> 4))
#define FFT_X_BYTES 69632
template <int R, bool INV>
__device__ __forceinline__ void fft_pass(float2* __restrict__ X, const float2* __restrict__ TW, const int s0, const int gidx) {
    const int lowbits = 13 - s0 - R; const int stride = 1 << lowbits;
    const int low = gidx & (stride - 1), high = gidx >> lowbits; const int base = (high << (lowbits + R)) | low;
    static_assert(13 - 0 - R >= 0, "radix");
    const int p0 = FIDX(base);
#define FFT_SLOT(k) (lowbits >= 4 ? p0 + (k) * (stride + (stride >> 4)) : p0 + (k) + ((k) >> 4))
    float2 v[1 << R];
#pragma unroll
    for (int k = 0; k < (1 << R); ++k) v[k] = X[FFT_SLOT(k)];
    if (!INV) {
#pragma unroll
        for (int j = 0; j < R; ++j) { const int hk = 1 << (R - 1 - j);
#pragma unroll
            for (int k = 0; k < (1 << R); ++k) if (!(k & hk)) { const int kk = k & (hk - 1); const int m = (low + stride * kk) << (s0 + j);
                const float2 a = v[k], b = v[k + hk], w = TW[m]; v[k] = make_float2(a.x + b.x, a.y + b.y); const float dx = a.x - b.x, dy = a.y - b.y; v[k + hk] = make_float2(dx * w.x - dy * w.y, dx * w.y + dy * w.x); } }
    } else {
#pragma unroll
        for (int j = R - 1; j >= 0; --j) { const int hk = 1 << (R - 1 - j);
#pragma unroll
            for (int k = 0; k < (1 << R); ++k) if (!(k & hk)) { const int kk = k & (hk - 1); const int m = (low + stride * kk) << (s0 + j);
                const float2 a = v[k], b = v[k + hk], w = TW[m]; const float tx = b.x * w.x + b.y * w.y, ty = b.y * w.x - b.x * w.y;
                v[k] = make_float2(a.x + tx, a.y + ty); v[k + hk] = make_float2(a.x - tx, a.y - ty); } }
    }
#pragma unroll
    for (int k = 0; k < (1 << R); ++k) X[FFT_SLOT(k)] = v[k];
#undef FFT_SLOT
}
__device__ __forceinline__ void fft_fwd(float2* X, const float2* TW, const int tid) {
    fft_pass<4, false>(X, TW, 0, tid); __syncthreads(); fft_pass<4, false>(X, TW, 4, tid); __syncthreads(); if (tid < 256) fft_pass<5, false>(X, TW, 8, tid); __syncthreads(); }
__device__ __forceinline__ void fft_inv(float2* X, const float2* TW, const int tid) {
    if (tid < 256) fft_pass<5, true>(X, TW, 8, tid); __syncthreads(); fft_pass<4, true>(X, TW, 4, tid); __syncthreads(); fft_pass<4, true>(X, TW, 0, tid); __syncthreads(); }
__device__ __forceinline__ void fft_twiddles(float2* TW, const int tid) {
#pragma unroll
    for (int k = 0; k < 8; ++k) { const int m = tid + k * 512; const float xx = (float)m * (1.0f / 4096.0f); TW[m] = make_float2(cospif(xx), -sinpif(xx)); }
}
__device__ __forceinline__ void hyena_spec_item(const int oc, const float* __restrict__ HR, const float* __restrict__ nrm, float2* __restrict__ HSPEC, unsigned char* shm, const int tid) {
    float2* X = (float2*)shm; const float2* TW = (const float2*)(shm + FFT_X_BYTES);
    const int o = oc >> 9, c = oc & 511; const float inv = 1.0f / nrm[oc];
    __syncthreads();
#pragma unroll 2
    for (int k = 0; k < 16; ++k) { const int j = tid + k * 512; float v;
        if (j < SEQ) v = HR[(unsigned)j * 2048u + o * 1024 + c] * inv; else if (j == SEQ) v = 0.f; else v = HR[(unsigned)(2 * SEQ - j) * 2048u + o * 1024 + 512 + c] * inv;
        X[FIDX(j)] = make_float2(v, 0.f); }
    __syncthreads();
    fft_fwd(X, TW, tid);
    float4* out = (float4*)(HSPEC + (size_t)oc * 8192 + tid * 16); const float2* xs = X + 17 * tid;
#pragma unroll
    for (int k = 0; k < 8; ++k) { const float2 x0 = xs[2 * k], x1 = xs[2 * k + 1]; out[k] = make_float4(x0.x * (1.0f / 8192.0f), x0.y * (1.0f / 8192.0f), x1.x * (1.0f / 8192.0f), x1.y * (1.0f / 8192.0f)); }
}
__device__ __forceinline__ void fft_mul_spec(float2* X, const float2* __restrict__ H, const int tid) {
    const float4* h4 = (const float4*)(H + tid * 16); float2* xs = X + 17 * tid;
#pragma unroll
    for (int k = 0; k < 8; ++k) { const float4 hv = h4[k]; const float2 x0 = xs[2 * k], x1 = xs[2 * k + 1];
        xs[2 * k] = make_float2(x0.x * hv.x - x0.y * hv.y, x0.x * hv.y + x0.y * hv.x); xs[2 * k + 1] = make_float2(x1.x * hv.z - x1.y * hv.w, x1.x * hv.w + x1.y * hv.z); }
}
__device__ __forceinline__ void hyena_fft_item(const int item, const float* __restrict__ UT, const float2* __restrict__ HSPEC, const float* __restrict__ bias, float* __restrict__ YT, unsigned char* shm, const int tid) {
    float2* X = (float2*)shm; const float2* TW = (const float2*)(shm + FFT_X_BYTES);
    const int c = item >> 1, b0 = (item & 1) * 2, b1 = b0 + 1;
    const float* u0 = UT + (size_t)(b0 * 1536 + c) * SEQ + tid * 8; const float* u1 = UT + (size_t)(b1 * 1536 + c) * SEQ + tid * 8;
    const float bias0 = bias[c], bias1 = bias[512 + c];
    float2* xs = X + FIDX(8 * tid);
    float vr[8], vi[8];
    __syncthreads();
    { const float4 a0 = *(const float4*)u0, a1 = *(const float4*)(u0 + 4), c0 = *(const float4*)u1, c1 = *(const float4*)(u1 + 4);
      vr[0] = a0.x; vr[1] = a0.y; vr[2] = a0.z; vr[3] = a0.w; vr[4] = a1.x; vr[5] = a1.y; vr[6] = a1.z; vr[7] = a1.w;
      vi[0] = c0.x; vi[1] = c0.y; vi[2] = c0.z; vi[3] = c0.w; vi[4] = c1.x; vi[5] = c1.y; vi[6] = c1.z; vi[7] = c1.w; }
#pragma unroll
    for (int k = 0; k < 8; ++k) { xs[k] = make_float2(vr[k], vi[k]); xs[4352 + k] = make_float2(0.f, 0.f); }
    __syncthreads();
    fft_fwd(X, TW, tid);
    fft_mul_spec(X, HSPEC + (size_t)c * 8192, tid);
    __syncthreads();
    fft_inv(X, TW, tid);
    { const float* p0 = u0 + (size_t)512 * SEQ; const float* p1 = u1 + (size_t)512 * SEQ;
      const float4 a0 = *(const float4*)p0, a1 = *(const float4*)(p0 + 4), c0 = *(const float4*)p1, c1 = *(const float4*)(p1 + 4);
      const float xr[8] = {a0.x, a0.y, a0.z, a0.w, a1.x, a1.y, a1.z, a1.w}, xi[8] = {c0.x, c0.y, c0.z, c0.w, c1.x, c1.y, c1.z, c1.w};
#pragma unroll
      for (int k = 0; k < 8; ++k) { const float2 cv = xs[k]; const float zr = xr[k] * (cv.x + bias0 * vr[k]), zi = xi[k] * (cv.y + bias0 * vi[k]);
          vr[k] = zr; vi[k] = zi; xs[k] = make_float2(zr, zi); xs[4352 + k] = make_float2(0.f, 0.f); } }
    __syncthreads();
    fft_fwd(X, TW, tid);
    fft_mul_spec(X, HSPEC + (size_t)(512 + c) * 8192, tid);
    __syncthreads();
    fft_inv(X, TW, tid);
    { const float* p0 = u0 + (size_t)1024 * SEQ; const float* p1 = u1 + (size_t)1024 * SEQ;
      const float4 a0 = *(const float4*)p0, a1 = *(const float4*)(p0 + 4), c0 = *(const float4*)p1, c1 = *(const float4*)(p1 + 4);
      const float xr[8] = {a0.x, a0.y, a0.z, a0.w, a1.x, a1.y, a1.z, a1.w}, xi[8] = {c0.x, c0.y, c0.z, c0.w, c1.x, c1.y, c1.z, c1.w};
      float yr[8], yi[8];
#pragma unroll
      for (int k = 0; k < 8; ++k) { const float2 cv = xs[k]; yr[k] = xr[k] * (cv.x + bias1 * vr[k]); yi[k] = xi[k] * (cv.y + bias1 * vi[k]); }
      float* y0 = YT + (size_t)(b0 * 512 + c) * SEQ + tid * 8; float* y1 = YT + (size_t)(b1 * 512 + c) * SEQ + tid * 8;
      *(float4*)y0 = make_float4(yr[0], yr[1], yr[2], yr[3]); *(float4*)(y0 + 4) = make_float4(yr[4], yr[5], yr[6], yr[7]);
      *(float4*)y1 = make_float4(yi[0], yi[1], yi[2], yi[3]); *(float4*)(y1 + 4) = make_float4(yi[4], yi[5], yi[6], yi[7]); }
}

constexpr size_t al256(size_t x) { return (x + 255) & ~(size_t)255; }
constexpr size_t O_BAR = 0;
constexpr size_t O_MOD = 16384;
constexpr size_t O_NORM = O_MOD + al256((size_t)2 * 5 * 6 * DM * 4);
constexpr size_t O_QCTR = O_NORM + al256((size_t)2 * 2 * 1024 * 4);
constexpr size_t O_ZERO_END = O_QCTR + 512;
constexpr size_t O_XS = O_ZERO_END;
constexpr size_t O_HB = O_XS + al256((size_t)NTOK * DM * 4);
constexpr size_t O_P = O_HB + al256((size_t)NTOK * DM * 2);
constexpr size_t O_WIN = O_P + al256((size_t)NTOK * LDP * 2);
constexpr size_t O_WBR = O_WIN + al256((size_t)LDP * DM * 2);
constexpr size_t O_WOUT = O_WBR + al256((size_t)4 * DM * BW * 2);
constexpr size_t O_WGU = O_WOUT + al256((size_t)DM * DM * 2);
constexpr size_t O_WD = O_WGU + al256((size_t)NEXP * 2 * DEXP * DM * 2);
constexpr size_t O_GLU = O_WD + al256((size_t)NEXP * DM * DEXP * 2);
constexpr size_t O_Y4 = O_GLU + al256((size_t)BW * BW * 2);
constexpr size_t O_U = O_Y4 + al256((size_t)NTOK * DM * 2);
constexpr size_t O_QKB = O_U + al256((size_t)NTOK * 1536 * 4);
constexpr size_t O_CST = O_QKB + al256((size_t)NTOK * 1024 * 2);
constexpr size_t O_NST = O_CST + al256((size_t)32 * 68 * 128 * 128 * 2);
constexpr size_t O_MST = O_NST + al256((size_t)32 * 68 * 128 * 4);
constexpr size_t O_XBC = O_MST + al256((size_t)32 * 68 * 4);
constexpr size_t O_SST = O_XBC + al256((size_t)NTOK * 1024 * 2);
constexpr size_t O_HF = O_SST + al256((size_t)64 * 68 * 64 * 128 * 2);
constexpr size_t O_YF = O_HF + al256((size_t)2 * NTOK * BW * 4);
constexpr size_t O_SF = O_YF + al256((size_t)2 * NTOK * BW * 4);
constexpr size_t O_LDT = O_SF + al256((size_t)2 * NCTX * BW * 4);
constexpr size_t O_AP = O_LDT + al256((size_t)4096 * 16);
constexpr size_t O_BBT = O_AP + al256((size_t)4096 * 33 * 8);
constexpr size_t O_KT = O_BBT + al256((size_t)4096 * 16 * 8);
constexpr size_t O_S5A = O_KT + al256((size_t)32 * 2 * 32 * 256 * 4);
constexpr size_t O_S5B = O_S5A + al256((size_t)32 * 512 * 768 * 2);
constexpr size_t O_XCTX = O_S5B + al256((size_t)32 * 512 * 768 * 2);
constexpr size_t O_Z = O_XCTX + al256((size_t)4 * 32 * 2 * 64 * 8);
constexpr size_t O_HRAW = O_Z + al256((size_t)NTOK * BW * 4);
constexpr size_t O_HSPEC = O_HRAW + al256((size_t)(SEQ + CTXL) * 2048 * 4);
constexpr size_t O_K2C = O_HSPEC + al256((size_t)1024 * 8192 * 8);
constexpr size_t O_GG = O_K2C + al256((size_t)(2 * CTXL) * 1024 * 4);
constexpr size_t O_PROBS = O_GG + al256((size_t)NTOK * BW * 2);
constexpr size_t O_ROWTOK = O_PROBS + al256((size_t)NTOK * 16 * 4);
constexpr size_t O_ROWGATE = O_ROWTOK + al256((size_t)NEXP * MOE_PAD * 4);
constexpr size_t O_INV = O_ROWGATE + al256((size_t)NEXP * MOE_PAD * 4);
constexpr size_t O_NORMP = O_INV + al256((size_t)NTOK * 16 * 4);
constexpr size_t WS_END = O_NORMP + al256((size_t)4 * 256 * 2048 * 4);
constexpr size_t O_XG = O_P;
constexpr size_t O_HID = O_P + al256((size_t)NEXP * MOE_PAD * DM * 2);
constexpr size_t O_YEXP = O_HID + al256((size_t)NEXP * MOE_PAD * DEXP * 2);
static_assert(O_YEXP + (size_t)NEXP * MOE_PAD * DM * 2 <= O_WIN, "MoE temporaries must fit inside P");
static_assert((size_t)NTOK * DM * 2 <= (size_t)NTOK * 1536 * 4, "ACCb must fit inside U");
static_assert((size_t)26214400 + (size_t)2 * 17825792 + (size_t)272 * 256 * 64 * 2 <= (size_t)NTOK * DM * 2, "strip buffers must fit inside HB");
static_assert(WS_END <= (size_t)1851000000, "workspace map exceeds the guaranteed size");

struct Args {
    const float* in[47];
    float* out; unsigned char* ws;
    int ph_lo, ph_hi;
};

__device__ __forceinline__ void conv_tile(const float* __restrict__ src, int ldsrc, int nvalid, int k0, int n0, bf16_t* __restrict__ dst, int lddst, int mode, float* T, int tid) {
    { const int n = tid & 63, kr = tid >> 6;
#pragma unroll
      for (int i = 0; i < 8; ++i) { const int k = i * 8 + kr; T[k * 65 + n] = (n0 + n < nvalid) ? src[(size_t)(k0 + k) * ldsrc + n0 + n] : 0.f; } }
    __syncthreads();
    { const int n = tid >> 3, kc = (tid & 7) * 8; const int gn = n0 + n;
      const int drow = mode == 0 ? gn : (32 * (gn >> 4) + (mode == 2 ? 16 : 0) + (gn & 15));
      u32x4 w; w.x = pk2(T[(kc + 0) * 65 + n], T[(kc + 1) * 65 + n]); w.y = pk2(T[(kc + 2) * 65 + n], T[(kc + 3) * 65 + n]);
      w.z = pk2(T[(kc + 4) * 65 + n], T[(kc + 5) * 65 + n]); w.w = pk2(T[(kc + 6) * 65 + n], T[(kc + 7) * 65 + n]);
      *(u32x4*)(dst + (size_t)drow * lddst + k0 + kc) = w; }
    __syncthreads();
}

#define IN(id) (lo <= (id) && (id) < hi)
#define SEAM(id) do { if (hi > (id) + 1) xcd_barrier(bar); } while (0)
#define PH_BEGIN int tid = threadIdx.x; asm volatile("" : "+v"(tid) :: "memory"); const int lane = tid & 63, wave = tid >> 6; (void)lane; (void)wave;

#define x_in (PT(0))
#define c_in (PT(1))
#define ctx_in (PT(2))
#define cctx_in (PT(3))
#define ada_w (PT(4))
#define ada_b (PT(5))
#define norm_mix (PT(6))
#define norm_ffn (PT(7))
#define w_in (PT(8))
#define XS ((float*)(a.ws + O_XS))
#define MOD ((float*)(a.ws + O_MOD))
#define NORM ((float*)(a.ws + O_NORM))
#define NORMP ((float*)(a.ws + O_NORMP))
#define MODl (MOD + (size_t)l * 5 * 6 * DM)
#define HB ((bf16_t*)(a.ws + O_HB))
#define P ((bf16_t*)(a.ws + O_P))
#define WIN ((bf16_t*)(a.ws + O_WIN))
#define WBR ((bf16_t*)(a.ws + O_WBR))
#define WOUT ((bf16_t*)(a.ws + O_WOUT))
#define WGU ((bf16_t*)(a.ws + O_WGU))
#define WD ((bf16_t*)(a.ws + O_WD))
#define GLU ((bf16_t*)(a.ws + O_GLU))
#define Y4 ((bf16_t*)(a.ws + O_Y4))
#define U ((float*)(a.ws + O_U))
#define ACCb ((bf16_t*)(a.ws + O_U))
#define QKB ((bf16_t*)(a.ws + O_QKB))
#define CST ((bf16_t*)(a.ws + O_CST))
#define NST ((float*)(a.ws + O_NST))
#define MST ((float*)(a.ws + O_MST))
#define XBC ((bf16_t*)(a.ws + O_XBC))
#define SSTB ((bf16_t*)(a.ws + O_SST))
#define HF ((float*)(a.ws + O_HF))
#define HBk (HF + (size_t)NTOK * BW)
#define YF ((float*)(a.ws + O_YF))
#define YB (YF + (size_t)NTOK * BW)
#define SF ((float*)(a.ws + O_SF))
#define SB (SF + (size_t)NCTX * BW)
#define LDT ((double2*)(a.ws + O_LDT))
#define APW ((float2*)(a.ws + O_AP))
#define BBT ((float2*)(a.ws + O_BBT))
#define KTB ((float*)(a.ws + O_KT))
#define S5A ((bf16_t*)(a.ws + O_S5A))
#define S5B ((bf16_t*)(a.ws + O_S5B))
#define XCTX ((float2*)(a.ws + O_XCTX))
#define S5P ((bf16_t*)(a.ws + O_HB))
#define XLOC ((float*)(a.ws + O_HB + (size_t)32 * 256 * 512 * 2))
#define KTG ((bf16_t*)(a.ws + O_HB + (size_t)26214400))
#define VTG ((bf16_t*)(a.ws + O_HB + (size_t)26214400 + (size_t)17825792))
#define BTG ((bf16_t*)(a.ws + O_HB + (size_t)26214400 + (size_t)2 * 17825792))
#define XTG ((bf16_t*)(a.ws + O_GG))
#define Z ((float*)(a.ws + O_Z))
#define HRAW ((float*)(a.ws + O_HRAW))
#define HSPEC ((float2*)(a.ws + O_HSPEC))
#define UT ((float*)(a.ws + O_U))
#define YT ((float*)(a.ws + O_Z))
#define QCTR ((int*)(a.ws + O_QCTR))
#define K2C ((float*)(a.ws + O_K2C))
#define GG ((bf16_t*)(a.ws + O_GG))
#define PROBS ((float*)(a.ws + O_PROBS))
#define ROWTOK ((int*)(a.ws + O_ROWTOK))
#define ROWGATE ((float*)(a.ws + O_ROWGATE))
#define XG ((bf16_t*)(a.ws + O_XG))
#define HID ((bf16_t*)(a.ws + O_HID))
#define YEXP ((bf16_t*)(a.ws + O_YEXP))
#define INV ((int*)(a.ws + O_INV))


__device__ __forceinline__ void moe_combine(float4 (&v)[8], const int tok, const int lane, const int* __restrict__ inv, const float* __restrict__ rowgate, const bf16_t* __restrict__ yexp, const float* __restrict__ m5) {
    float4 a[8];
#pragma unroll
    for (int i = 0; i < 8; ++i) a[i] = make_float4(0.f, 0.f, 0.f, 0.f);
    for (int e = 0; e < 16; ++e) { const int row = __builtin_amdgcn_readfirstlane(inv[tok * 16 + e]);
        if (row >= 0) { const float gt = rowgate[row]; const bf16_t* yr = yexp + (size_t)row * DM + lane * 4;
#pragma unroll
            for (int i = 0; i < 8; ++i) { const u32x2 w = *(const u32x2*)(yr + i * 256);
                a[i].x += gt * __uint_as_float(w.x << 16); a[i].y += gt * __uint_as_float(w.x & 0xFFFF0000u); a[i].z += gt * __uint_as_float(w.y << 16); a[i].w += gt * __uint_as_float(w.y & 0xFFFF0000u); } } }
#pragma unroll
    for (int i = 0; i < 8; ++i) { const float4 mm = *(const float4*)(m5 + i * 256 + lane * 4); v[i].x += mm.x * a[i].x; v[i].y += mm.y * a[i].y; v[i].z += mm.z * a[i].z; v[i].w += mm.w * a[i].w; }
}
struct CvU { const float* src; bf16_t* dst; int ldsrc, nvalid, k0, n0, lddst, mode; };
__device__ __forceinline__ void cv_load(const CvU& u, float4 (&r)[8], const int tid) {
#pragma unroll
    for (int i = 0; i < 8; ++i) { const int idx = tid + i * 512; const int k = idx >> 6, n = u.n0 + (idx & 63) * 4;
        r[i] = (n < u.nvalid) ? *(const float4*)(u.src + (size_t)(u.k0 + k) * u.ldsrc + n) : make_float4(0.f, 0.f, 0.f, 0.f); }
}
__device__ __forceinline__ void cv_stage(float* T, const float4 (&r)[8], const int tid) {
#pragma unroll
    for (int i = 0; i < 8; ++i) { const int idx = tid + i * 512; float* p = T + (idx >> 6) * 257 + (idx & 63) * 4; p[0] = r[i].x; p[1] = r[i].y; p[2] = r[i].z; p[3] = r[i].w; }
}
__device__ __forceinline__ void cv_store(const CvU& u, const float* T, const int tid) {
#pragma unroll
    for (int j = 0; j < 4; ++j) { const int o = tid + j * 512; const int kc = (o & 7) * 8, n = o >> 3; const int gn = u.n0 + n;
        const int drow = u.mode == 0 ? gn : (256 * (gn >> 7) + (u.mode == 2 ? 128 : 0) + (gn & 127));
        const float* t = T + kc * 257 + n;
        u32x4 w; w.x = pk2(t[0], t[257]); w.y = pk2(t[2 * 257], t[3 * 257]); w.z = pk2(t[4 * 257], t[5 * 257]); w.w = pk2(t[6 * 257], t[7 * 257]);
        *(u32x4*)(u.dst + (size_t)drow * u.lddst + u.k0 + kc) = w; }
}
template <int LAYER>
__device__ __forceinline__ void layer_body(const Args& a, const XcdBarrier& bar, const int lo, const int hi, const int bid, const int G, unsigned char* const shm, float* const sf, const float** const ptab) {
        constexpr int l = LAYER;
        constexpr int PB = 1 + 16 * l;
        const bool lastl = (l == 1);

        const int nPanels = lastl ? 64 : 68;
        const int M2 = nPanels * 256;

        if (IN(PB + 0)) for (int rep_ = 0; rep_ < (l == 0 ? PROBE_REPS(0) : 1); ++rep_) {
            PH_BEGIN
            {   const float* wbr = PT(40) + (size_t)l * 4 * BW * DM; const float* wout = PT(41) + (size_t)l * DM * DM;
                const float* wg = PT(43) + (size_t)l * NEXP * DM * DEXP; const float* wu = PT(44) + (size_t)l * NEXP * DM * DEXP; const float* wd = PT(45) + (size_t)l * NEXP * DEXP * DM;
                const float* wglu = PT(32) + (size_t)l * BW * BW; const float* win = w_in + (size_t)l * DM * IN_W;
                const int n_win = 32 * 55, n_br = 4 * 64, n_out = 32 * 8, n_gu = 16 * 2 * 192, n_d = 16 * 192, n_glu = 16;
                const int total = n_win + n_br + n_out + n_gu + n_d + n_glu;
#define CV_DECODE(q_, u_) do { int qq_ = (q_); \
                    if (qq_ < n_win) { u_ = CvU{win, WIN, IN_W, IN_W, (qq_ / 55) * 64, (qq_ % 55) * 256, DM, 0}; } else { qq_ -= n_win; \
                    if (qq_ < n_br) { const int k = qq_ >> 6, r = qq_ & 63; u_ = CvU{wbr + (size_t)k * BW * DM, WBR + (size_t)k * DM * BW, DM, DM, (r >> 3) * 64, (r & 7) * 256, BW, 0}; } else { qq_ -= n_br; \
                    if (qq_ < n_out) { u_ = CvU{wout, WOUT, DM, DM, (qq_ >> 3) * 64, (qq_ & 7) * 256, DM, 0}; } else { qq_ -= n_out; \
                    if (qq_ < n_gu) { const int e = qq_ / 384, r = qq_ % 384, up = r / 192, r2 = r % 192; u_ = CvU{(up ? wu : wg) + (size_t)e * DM * DEXP, WGU + (size_t)e * 2 * DEXP * DM, DEXP, DEXP, (r2 / 6) * 64, (r2 % 6) * 256, DM, 1 + up}; } else { qq_ -= n_gu; \
                    if (qq_ < n_d) { const int e = qq_ / 192, r = qq_ % 192; u_ = CvU{wd + (size_t)e * DEXP * DM, WD + (size_t)e * DM * DEXP, DM, DM, (r >> 3) * 64, (r & 7) * 256, DEXP, 0}; } else { qq_ -= n_d; \
                    u_ = CvU{wglu, GLU, BW, BW, (qq_ >> 1) * 64, (qq_ & 1) * 256, BW, 0}; } } } } } } while (0)
                __syncthreads();
                int q = bid; int buf = 0; CvU u; float4 r[8];
                if (q < total) { CV_DECODE(q, u); cv_load(u, r, tid); }
                while (q < total) {
                    float* T = sf + buf * (64 * 257);
                    cv_stage(T, r, tid);
                    __syncthreads();
                    const CvU cur = u; const int qn = q + G;
                    if (qn < total) { CV_DECODE(qn, u); cv_load(u, r, tid); }
                    cv_store(cur, T, tid);
                    buf ^= 1; q = qn;
                }
#undef CV_DECODE
                __syncthreads();
            }
            for (int set = 0; set < (lastl ? 1 : 2); ++set) {
                const int L = set ? CTXL : SEQ; float* HR = HRAW + (set ? (size_t)SEQ * 2048 : 0);
                const float* w1 = PT(11) + l * 33 * 64; const float* b1 = PT(12) + l * 64; const float* fr1 = PT(13) + l * 64; const float* w2 = PT(14) + l * 64 * 64; const float* b2 = PT(15) + l * 64;
                const float* fr2 = PT(16) + l * 64; const float* w3 = PT(17) + l * 64 * 2048; const float* decay = PT(18) + l * 2048;
                float* feats = sf; float* h1 = sf + 16 * 33; float* h2 = h1 + 16 * 64;
                float nacc[4] = {0.f, 0.f, 0.f, 0.f};
                for (int base = bid; base < L; base += 16 * G) {
                    __syncthreads();
                    for (int e = tid; e < 16 * 33; e += NTHR) { const int ti = e / 33, fi = e % 33; int t = base + ti * G; if (t > L - 1) t = L - 1;
                        float v;
                        if (fi == 0) v = (float)t / (float)(L - 1);
                        else { const int j = (fi - 1) & 15; const double fr = 1e-4 + (double)j * ((15.0 - 1e-4) / 15.0); const double ang = (2.0 * 3.14159265358979323846 / (double)L) * (double)t * fr; v = fi <= 16 ? (float)cos(ang) : (float)(-sin(ang)); }
                        feats[e] = v; }
                    __syncthreads();
                    { const int j = tid & 63, ti = tid >> 6; float s0 = b1[j], s1 = s0;
_Pragma("unroll 3")
                      for (int i = 0; i < 33; ++i) { const float wv = w1[i * 64 + j]; s0 += feats[ti * 33 + i] * wv; s1 += feats[(ti + 8) * 33 + i] * wv; }
                      const float f1 = fr1[j]; h1[ti * 64 + j] = sinf(f1 * s0); h1[(ti + 8) * 64 + j] = sinf(f1 * s1); }
                    __syncthreads();
                    { const int j = tid & 63, ti = tid >> 6; float s0 = b2[j], s1 = s0;
_Pragma("unroll 4")
                      for (int i = 0; i < 64; ++i) { const float wv = w2[i * 64 + j]; s0 += h1[ti * 64 + i] * wv; s1 += h1[(ti + 8) * 64 + i] * wv; }
                      const float f2 = fr2[j]; h2[ti * 64 + j] = sinf(f2 * s0); h2[(ti + 8) * 64 + j] = sinf(f2 * s1); }
                    __syncthreads();
                    float acc[16][4];
#pragma unroll
                    for (int ti = 0; ti < 16; ++ti) { acc[ti][0] = 0.f; acc[ti][1] = 0.f; acc[ti][2] = 0.f; acc[ti][3] = 0.f; }
#pragma unroll 2
                    for (int i = 0; i < 64; ++i) { const float* wrow = w3 + (size_t)i * 2048 + tid; const float wa = wrow[0], wb = wrow[512], wc2 = wrow[1024], wd2 = wrow[1536];
#pragma unroll
                        for (int ti = 0; ti < 16; ++ti) { const float hv = h2[ti * 64 + i]; acc[ti][0] += hv * wa; acc[ti][1] += hv * wb; acc[ti][2] += hv * wc2; acc[ti][3] += hv * wd2; } }
                    float dk[4];
#pragma unroll
                    for (int k = 0; k < 4; ++k) dk[k] = fabsf(decay[tid + k * 512]);
#pragma unroll
                    for (int ti = 0; ti < 16; ++ti) { const int t = base + ti * G; if (t < L) { const float tn = (float)t / (float)(L - 1);
#pragma unroll
                        for (int k = 0; k < 4; ++k) { const float v = acc[ti][k] * expf(-tn * dk[k]); HR[(size_t)t * 2048 + tid + k * 512] = v; nacc[k] += fabsf(v); } } }
                }
                float* nrp = NORMP + ((size_t)(l * 2 + set) * 256 + bid) * 2048;
#pragma unroll
                for (int k = 0; k < 4; ++k) nrp[tid + k * 512] = nacc[k];
            }
            for (int idx = bid * NTHR + tid; idx < 4096; idx += G * NTHR) { const int n = idx & 63, g = (idx >> 6) & 31, dir = idx >> 11;
                const double are = (double)(PT(24) + l * 4096)[idx], aim = (double)(PT(25) + l * 4096)[idx]; const double lam = are < -1e-4 ? are : -1e-4; const double dt = exp((double)(PT(26) + l * 64)[dir * 32 + g]);
                const double ldre = lam * dt, ldim = aim * dt; LDT[idx] = make_double2(ldre, ldim);
                const double mag = exp(ldre); const double ar = mag * cos(ldim), ai = mag * sin(ldim);
                const double den = lam * lam + aim * aim; const double nr = ar - 1.0, ni = ai; const double fre = (nr * lam + ni * aim) / den, fim = (ni * lam - nr * aim) / den;
                const float* b_re = PT(27) + l * 32 * 64 * 16; const float* b_im = PT(28) + l * 32 * 64 * 16;
#pragma unroll 4
                for (int c = 0; c < 16; ++c) { const double br = (double)b_re[(g * 64 + n) * 16 + c], bi = (double)b_im[(g * 64 + n) * 16 + c]; BBT[idx * 16 + c] = make_float2((float)(fre * br - fim * bi), (float)(fre * bi + fim * br)); }
            }
            for (int e2 = bid * NTHR + tid; e2 < 4096 * 33; e2 += G * NTHR) { const int idx = e2 / 33, k = e2 - idx * 33; const int g = (idx >> 6) & 31, dir = idx >> 11;
                const double are = (double)(PT(24) + l * 4096)[idx], aim = (double)(PT(25) + l * 4096)[idx]; const double lam = are < -1e-4 ? are : -1e-4; const double dt = exp((double)(PT(26) + l * 64)[dir * 32 + g]);
                const double ldre = lam * dt, ldim = aim * dt; const double mk = exp(ldre * k); APW[e2] = make_float2((float)(mk * cos(ldim * k)), (float)(mk * sin(ldim * k))); }
            if (l == 0 && lo == 0) xcd_barrier(bar);
            for (int tok = bid * 8 + wave; tok < NTOK; tok += G * 8) {
                const int r = tok < NLAT ? tok / SEQ : 4; const float* xr = l == 0 ? (tok < NLAT ? x_in + (size_t)tok * DM : ctx_in + (size_t)(tok - NLAT) * DM) : XS + (size_t)tok * DM; const float* gn = norm_mix + l * DM;
                const float* sh = MODl + (size_t)(r * 6 + 0) * DM; const float* sc = MODl + (size_t)(r * 6 + 1) * DM;
                float4 v[8]; float ss = 0.f;
#pragma unroll
                for (int i = 0; i < 8; ++i) v[i] = *(const float4*)(xr + i * 256 + lane * 4);
                if (l > 0) {
                    moe_combine(v, tok, lane, INV, ROWGATE, YEXP, MOD + (size_t)((l - 1) * 5 + r) * 6 * DM + 5 * DM);
#pragma unroll
                    for (int i = 0; i < 8; ++i) *(float4*)(XS + (size_t)tok * DM + i * 256 + lane * 4) = v[i]; }
#pragma unroll
                for (int i = 0; i < 8; ++i) ss += v[i].x * v[i].x + v[i].y * v[i].y + v[i].z * v[i].z + v[i].w * v[i].w;
                ss = wave_sum(ss); const float rs = rsqrtf(ss * (1.0f / DM) + 1e-6f);
#pragma unroll
                for (int i = 0; i < 8; ++i) { const int d = i * 256 + lane * 4; const float4 g4 = *(const float4*)(gn + d), s4 = *(const float4*)(sc + d), h4 = *(const float4*)(sh + d);
                    u32x2 w; w.x = pk2(v[i].x * rs * g4.x * (1.f + s4.x) + h4.x, v[i].y * rs * g4.y * (1.f + s4.y) + h4.y); w.y = pk2(v[i].z * rs * g4.z * (1.f + s4.z) + h4.z, v[i].w * rs * g4.w * (1.f + s4.w) + h4.w);
                    *(u32x2*)(HB + (size_t)tok * DM + d) = w; }
            }
            SEAM(PB + 0);
        }

        if (IN(PB + 1)) for (int rep_ = 0; rep_ < PROBE_REPS(1); ++rep_) {
            PH_BEGIN
            for (int idx = bid * NTHR + tid; idx < (lastl ? 1 : 2) * 1024; idx += G * NTHR) { const int set = idx >> 10, oc = idx & 1023, o = oc >> 9, c = oc & 511;
                const float* pp = NORMP + (size_t)(l * 2 + set) * 256 * 2048 + o * 1024 + c; float sacc = 0.f;
                for (int bb = 0; bb < G; ++bb) sacc += pp[(size_t)bb * 2048] + pp[(size_t)bb * 2048 + 512];
                NORM[(size_t)(l * 2 + set) * 1024 + oc] = sacc; }
            for (int idx = bid * NTHR + tid; idx < 32768; idx += G * NTHR) { const int c = idx & 15, lag = (idx >> 4) & 31, dir = (idx >> 9) & 1, g = idx >> 10;
                const float* c_re = PT(29) + l * 32 * 16 * 64 + (g * 16 + c) * 64; const float* c_im = PT(30) + l * 32 * 16 * 64 + (g * 16 + c) * 64;
                float acc[16];
#pragma unroll
                for (int j = 0; j < 16; ++j) acc[j] = 0.f;
#pragma unroll 2
                for (int n = 0; n < 64; ++n) { const int pi = (dir * 32 + g) * 64 + n; const float2 ap = APW[pi * 33 + lag]; const float cr = c_re[n], ci = c_im[n]; const float wr_ = cr * ap.x - ci * ap.y, wi_ = cr * ap.y + ci * ap.x;
                    const float4* bb = (const float4*)(BBT + pi * 16);
#pragma unroll
                    for (int j = 0; j < 8; ++j) { const float4 b2 = bb[j]; acc[2 * j] += wr_ * b2.x - wi_ * b2.y; acc[2 * j + 1] += wr_ * b2.z - wi_ * b2.w; } }
                float4* o = (float4*)(KTB + (size_t)idx * 16);
                o[0] = make_float4(acc[0], acc[1], acc[2], acc[3]); o[1] = make_float4(acc[4], acc[5], acc[6], acc[7]); o[2] = make_float4(acc[8], acc[9], acc[10], acc[11]); o[3] = make_float4(acc[12], acc[13], acc[14], acc[15]);
            }
            __syncthreads();
            pg8::Gemm g{HB, WIN, DM, DM, DM}; pg8::SchedStd S{68, 55, G, bid, DM, DM}; pg8::EpiWin E{P, LDP};
            pg8::gemm_phase(( LAS unsigned char*)shm, g, S, E);
#if defined(PROBE_BNOEPI)
            { __syncthreads(); pg8::EpiNone E0; pg8::gemm_phase((LAS unsigned char*)shm, g, S, E0); }
#endif
            SEAM(PB + 1);
        }

        if (IN(PB + 2)) for (int rep_ = 0; rep_ < PROBE_REPS(2); ++rep_) {
            PH_BEGIN
            const float* hcw = PT(9) + l * 3 * 1536; const float* hcb = PT(10) + l * 1536; const float* mcw = PT(20) + l * 3 * 1024; const float* mcb = PT(21) + l * 1024;
            const float* scw = PT(34) + l * 3 * 1024; const float* scb = PT(35) + l * 1024;
            for (int unit = bid; unit < 272 * 3; unit += G) { const int seg = unit / 3, kind = unit % 3; const bool lat = seg < 256; const size_t tok0 = lat ? (size_t)seg * 64 : (size_t)NLAT + (size_t)(seg - 256) * 64;
                if (kind < 2) { const int hf = kind;
                    const int c = tid * 2; const int col = (hf ? SSD_OFF + 512 : ML_OFF) + c; const float* w = hf ? scw : mcw; const float* bsp = hf ? scb : mcb; bf16_t* dst = (hf ? XBC : QKB) + tok0 * 1024 + c;
                    const float2 w0 = *(const float2*)(w + c), w1 = *(const float2*)(w + 1024 + c), w2 = *(const float2*)(w + 2048 + c), bb = *(const float2*)(bsp + c);
                    const float osc = (!hf && c >= 512) ? 0.08838834764831845f : 1.0f;
                    const bool hasPrev = !lat && ((tok0 - NLAT) & (CTXL - 1)) != 0, hasNext = !lat && (((tok0 - NLAT) + 63) & (CTXL - 1)) != CTXL - 1;
                    bf16_t* strip = nullptr;
                    if (!hf) { if (c >= 512) strip = KTG + ((size_t)seg * 512 + (c - 512)) * 64; }
                    else { if (c < 512) strip = XTG + ((size_t)seg * 512 + c) * 64; else if (c < 768) strip = BTG + ((size_t)seg * 256 + (c - 512)) * 64; }
                    const bf16_t* pp = P + tok0 * LDP + col;
                    unsigned raw[66];
#pragma unroll
                    for (int t = 0; t < 66; ++t) raw[t] = ((t == 0 && !hasPrev) || (t == 65 && !hasNext)) ? 0u : *(const unsigned*)(pp + (ptrdiff_t)(t - 1) * LDP);
#pragma unroll
                    for (int t8 = 0; t8 < 8; ++t8) { float v0[8], v1[8];
#pragma unroll
                        for (int tt = 0; tt < 8; ++tt) { const int t = t8 * 8 + tt; const unsigned p0 = raw[t], p1 = raw[t + 1], p2 = raw[t + 2];
                            float a0 = bb.x + w0.x * __uint_as_float(p0 << 16) + w1.x * __uint_as_float(p1 << 16) + w2.x * __uint_as_float(p2 << 16);
                            float a1 = bb.y + w0.y * __uint_as_float(p0 & 0xFFFF0000u) + w1.y * __uint_as_float(p1 & 0xFFFF0000u) + w2.y * __uint_as_float(p2 & 0xFFFF0000u);
                            a0 = siluf_(a0) * osc; a1 = siluf_(a1) * osc; v0[tt] = a0; v1[tt] = a1;
                            *(unsigned*)(dst + (size_t)t * 1024) = pk2(a0, a1); }
                        if (strip) { u32x4 s0, s1; s0.x = pk2(v0[0], v0[1]); s0.y = pk2(v0[2], v0[3]); s0.z = pk2(v0[4], v0[5]); s0.w = pk2(v0[6], v0[7]); s1.x = pk2(v1[0], v1[1]); s1.y = pk2(v1[2], v1[3]); s1.z = pk2(v1[4], v1[5]); s1.w = pk2(v1[6], v1[7]);
                            *(u32x4*)(strip + t8 * 8) = s0; *(u32x4*)(strip + 64 + t8 * 8) = s1; } }
                } else {
                    const int c = (tid & 255) * 2, th = tid >> 8; const bf16_t* pp = P + (tok0 + th * 32) * LDP + ML_OFF + 1024 + c; bf16_t* strip = VTG + ((size_t)seg * 512 + c) * 64 + th * 32;
                    unsigned rv[32];
#pragma unroll
                    for (int t = 0; t < 32; ++t) rv[t] = *(const unsigned*)(pp + (size_t)t * LDP);
#pragma unroll
                    for (int t8 = 0; t8 < 4; ++t8) { u32x4 s0, s1;
                        s0.x = (rv[t8 * 8 + 0] & 0xFFFFu) | (rv[t8 * 8 + 1] << 16); s0.y = (rv[t8 * 8 + 2] & 0xFFFFu) | (rv[t8 * 8 + 3] << 16); s0.z = (rv[t8 * 8 + 4] & 0xFFFFu) | (rv[t8 * 8 + 5] << 16); s0.w = (rv[t8 * 8 + 6] & 0xFFFFu) | (rv[t8 * 8 + 7] << 16);
                        s1.x = (rv[t8 * 8 + 0] >> 16) | (rv[t8 * 8 + 1] & 0xFFFF0000u); s1.y = (rv[t8 * 8 + 2] >> 16) | (rv[t8 * 8 + 3] & 0xFFFF0000u); s1.z = (rv[t8 * 8 + 4] >> 16) | (rv[t8 * 8 + 5] & 0xFFFF0000u); s1.w = (rv[t8 * 8 + 6] >> 16) | (rv[t8 * 8 + 7] & 0xFFFF0000u);
                        *(u32x4*)(strip + t8 * 8) = s0; *(u32x4*)(strip + 64 + t8 * 8) = s1; }
                }
            }
            if (!lastl) for (int tok = NLAT + bid; tok < NTOK; tok += G) {
                const int t = (tok - NLAT) & (CTXL - 1); const bool hasL = (t != 0), hasR = (t != CTXL - 1); const bf16_t* pr = P + (size_t)tok * LDP;
#pragma unroll
                for (int j = 0; j < 3; ++j) { const int cc = tid + j * 512;
                    float acc = hcb[cc] + hcw[1536 + cc] * bf2f(pr[HY_OFF + cc]);
                    if (hasL) acc += hcw[cc] * bf2f(pr[HY_OFF + cc - LDP]);
                    if (hasR) acc += hcw[2 * 1536 + cc] * bf2f(pr[HY_OFF + cc + LDP]);
                    U[(size_t)tok * 1536 + cc] = acc; }
            }
            for (int idx = bid * NTHR + tid; idx < 16384 * 64; idx += G * NTHR) { const int half = idx & 1, g = (idx >> 1) & 31, tok = idx >> 6;
                *(u32x4*)(S5A + ((size_t)g * 512 + (tok >> 5)) * 768 + (tok & 31) * 16 + half * 8) = *(const u32x4*)(P + (size_t)tok * LDP + S5_OFF + g * 16 + half * 8); }
            for (int idx = bid * NTHR + tid; idx < 32 * 512 * 32 * 2; idx += G * NTHR) { const int half = idx & 1, sI = (idx >> 1) & 31, row = (idx >> 6) & 511, g = idx >> 15; const int t = row >> 4, c = row & 15; const int lag = t - sI;
                float v[8];
                if (lag > 0) { const float4* k4 = (const float4*)(KTB + ((size_t)((g * 2 + 0) * 32 + lag) * 16 + c) * 16 + half * 8); const float4 a0 = k4[0], a1 = k4[1]; v[0] = a0.x; v[1] = a0.y; v[2] = a0.z; v[3] = a0.w; v[4] = a1.x; v[5] = a1.y; v[6] = a1.z; v[7] = a1.w; }
                else if (lag < 0) { const float4* k4 = (const float4*)(KTB + ((size_t)((g * 2 + 1) * 32 - lag) * 16 + c) * 16 + half * 8); const float4 a0 = k4[0], a1 = k4[1]; v[0] = a0.x; v[1] = a0.y; v[2] = a0.z; v[3] = a0.w; v[4] = a1.x; v[5] = a1.y; v[6] = a1.z; v[7] = a1.w; }
                else { const float4* k4 = (const float4*)(KTB + ((size_t)((g * 2 + 0) * 32) * 16 + c) * 16 + half * 8); const float4* q4 = (const float4*)(KTB + ((size_t)((g * 2 + 1) * 32) * 16 + c) * 16 + half * 8); const float4 a0 = k4[0], a1 = k4[1], b0 = q4[0], b1 = q4[1];
                    v[0] = a0.x + b0.x; v[1] = a0.y + b0.y; v[2] = a0.z + b0.z; v[3] = a0.w + b0.w; v[4] = a1.x + b1.x; v[5] = a1.y + b1.y; v[6] = a1.z + b1.z; v[7] = a1.w + b1.w; }
                u32x4 w; w.x = pk2(v[0], v[1]); w.y = pk2(v[2], v[3]); w.z = pk2(v[4], v[5]); w.w = pk2(v[6], v[7]);
                *(u32x4*)(S5B + ((size_t)g * 512 + row) * 768 + sI * 16 + half * 8) = w; }
            for (int idx = bid * NTHR + tid; idx < 32 * 512 * 64; idx += G * NTHR) { const int n = idx & 63, row = (idx >> 6) & 511, g = idx >> 15; const int t = row >> 4, c = row & 15;
                const float cr = (PT(29) + l * 32 * 16 * 64)[(g * 16 + c) * 64 + n], ci = (PT(30) + l * 32 * 16 * 64)[(g * 16 + c) * 64 + n];
                const float2 af = APW[((0 * 32 + g) * 64 + n) * 33 + t + 1], ab = APW[((1 * 32 + g) * 64 + n) * 33 + 32 - t];
                bf16_t* d = S5B + ((size_t)g * 512 + row) * 768 + 512 + 2 * n;
                *(unsigned*)d = pk2(cr * af.x - ci * af.y, -(cr * af.y + ci * af.x)); *(unsigned*)(d + 128) = pk2(cr * ab.x - ci * ab.y, -(cr * ab.y + ci * ab.x)); }
            for (int idx = bid * NTHR + tid; idx < 32 * 2 * 64 * 32; idx += G * NTHR) { const int sI = idx & 31, n = (idx >> 5) & 63, dir = (idx >> 11) & 1, g = idx >> 12; const int pi = (dir * 32 + g) * 64 + n;
                const float2 pw = APW[pi * 33 + (dir ? sI : 31 - sI)]; const float4* bb = (const float4*)(BBT + pi * 16);
                float re[16], im[16];
#pragma unroll
                for (int j = 0; j < 8; ++j) { const float4 b2 = bb[j]; re[2 * j] = pw.x * b2.x - pw.y * b2.y; im[2 * j] = pw.x * b2.y + pw.y * b2.x; re[2 * j + 1] = pw.x * b2.z - pw.y * b2.w; im[2 * j + 1] = pw.x * b2.w + pw.y * b2.z; }
                bf16_t* d = S5P + ((size_t)g * 256 + dir * 128 + 2 * n) * 512 + sI * 16;
                u32x4 w0, w1; w0.x = pk2(re[0], re[1]); w0.y = pk2(re[2], re[3]); w0.z = pk2(re[4], re[5]); w0.w = pk2(re[6], re[7]); w1.x = pk2(re[8], re[9]); w1.y = pk2(re[10], re[11]); w1.z = pk2(re[12], re[13]); w1.w = pk2(re[14], re[15]);
                *(u32x4*)d = w0; *(u32x4*)(d + 8) = w1;
                w0.x = pk2(im[0], im[1]); w0.y = pk2(im[2], im[3]); w0.z = pk2(im[4], im[5]); w0.w = pk2(im[6], im[7]); w1.x = pk2(im[8], im[9]); w1.y = pk2(im[10], im[11]); w1.z = pk2(im[12], im[13]); w1.w = pk2(im[14], im[15]);
                *(u32x4*)(d + 512) = w0; *(u32x4*)(d + 520) = w1; }
            {   float* T = sf;
                for (int unit = bid; unit < 4 * 64 * 24; unit += G) { const int b = unit / (64 * 24), r = (unit / 24) % 64, c0 = (unit % 24) * 64; const size_t tok0 = (size_t)b * SEQ + r * 64;
                    __syncthreads();
#pragma unroll
                    for (int i = 0; i < 8; ++i) { const int c = tid & 63, t = (tid >> 6) + 8 * i; T[t * 65 + c] = bf2f(P[(tok0 + t) * LDP + HY_OFF + c0 + c]); }
                    __syncthreads();
                    const int c = tid >> 3, tq = (tid & 7) * 8, cc = c0 + c; const float w0 = hcw[cc], w1 = hcw[1536 + cc], w2 = hcw[3072 + cc], bb = hcb[cc];
                    float o8[8];
#pragma unroll
                    for (int i = 0; i < 8; ++i) { const int t = tq + i; float acc = bb + w1 * T[t * 65 + c]; if (t > 0) acc += w0 * T[(t - 1) * 65 + c]; if (t < 63) acc += w2 * T[(t + 1) * 65 + c]; o8[i] = acc; }
                    float* dst = UT + ((size_t)b * 1536 + cc) * SEQ + r * 64 + tq;
                    *(float4*)dst = make_float4(o8[0], o8[1], o8[2], o8[3]); *(float4*)(dst + 4) = make_float4(o8[4], o8[5], o8[6], o8[7]);
                } }
            if (!lastl) {
                const int L = CTXL; const float* HR = HRAW + (size_t)SEQ * 2048; float* K2 = K2C; const float* nrm = NORM + (size_t)(l * 2 + 1) * 1024;
                const size_t total = (size_t)(2 * L - 1) * 1024;
                for (size_t i = (size_t)bid * NTHR + tid; i < total; i += (size_t)G * NTHR) { const int j = (int)(i >> 10), oc = (int)(i & 1023), o = oc >> 9, c = oc & 511; const int lag = j - (L - 1);
                    const float v = lag >= 0 ? HR[(size_t)lag * 2048 + o * 1024 + c] : HR[(size_t)(-lag) * 2048 + o * 1024 + 512 + c];
                    K2[((size_t)j * 2 + o) * 512 + c] = v / nrm[oc]; }
            }
            {   __syncthreads(); fft_twiddles((float2*)(shm + FFT_X_BYTES), tid);
                for (int oc = bid; oc < 1024; oc += G) hyena_spec_item(oc, HRAW, NORM + (size_t)(l * 2 + 0) * 1024, HSPEC, shm, tid);
                __syncthreads(); }
            SEAM(PB + 2);
        }

        if (IN(PB + 3)) for (int rep_ = 0; rep_ < PROBE_REPS(3); ++rep_) {
            PH_BEGIN
            if (rep_ > 0) { if (bid == 0 && tid == 0) __hip_atomic_store(QCTR + l * 64, 0, __ATOMIC_RELAXED, __HIP_MEMORY_SCOPE_AGENT); xcd_barrier(bar); }
            if (bid < 32) {
                for (int rp_ = 0; rp_ < PROBE_SP; ++rp_) mlstm_state_pass(bid, P, KTG, VTG, PT(22) + l * 16, CST, NST, MST, shm, tid);
            } else if (bid < 96) {
                { const int ch = bid - 32; const int dir_ = ch & 1, h_ = (ch >> 1) & 7; for (int rp_ = 0; rp_ < PROBE_SP; ++rp_) ssd_state_pass(ch, P, BTG, XTG, -expf(PT(37)[l * 16 + dir_ * 8 + h_]), PT(36)[l * 16 + dir_ * 8 + h_], SSTB, shm, tid); }
            } else if (bid < 128) {
                const int widx = (bid - 96) * 8 + wave; const int dir = widx & 1, g = (widx >> 1) & 31, b = widx >> 6; const int n = lane;
                float2* xb = (float2*)(shm + (size_t)wave * 16640); float2* ctab = xb + 16 * 65;
                const float* a_re = PT(24) + l * 2 * 32 * 64; const float* a_im = PT(25) + l * 2 * 32 * 64; const float* log_dt = PT(26) + l * 64;
                const float* b_re = PT(27) + l * 32 * 64 * 16; const float* b_im = PT(28) + l * 32 * 64 * 16; const float* c_re = PT(29) + l * 32 * 16 * 64; const float* c_im = PT(30) + l * 32 * 16 * 64;
#pragma unroll
                for (int c = 0; c < 16; ++c) ctab[c * 65 + lane] = make_float2(c_re[(g * 16 + c) * 64 + lane], c_im[(g * 16 + c) * 64 + lane]);
                float abr, abi, bbr[16], bbi[16];
                {   const double are = (double)a_re[(dir * 32 + g) * 64 + n], aim = (double)a_im[(dir * 32 + g) * 64 + n];
                    const double lam = are < -1e-4 ? are : -1e-4; const double dt = exp((double)log_dt[dir * 32 + g]);
                    const double mag = exp(lam * dt); const double ar = mag * cos(aim * dt), ai = mag * sin(aim * dt);
                    const double den = lam * lam + aim * aim; const double nr = ar - 1.0, ni = ai;
                    const double fre = (nr * lam + ni * aim) / den, fim = (ni * lam - nr * aim) / den;
                    abr = (float)ar; abi = (float)ai;
#pragma unroll
                    for (int c = 0; c < 16; ++c) { const double br = (double)b_re[(g * 64 + n) * 16 + c], bi = (double)b_im[(g * 64 + n) * 16 + c]; bbr[c] = (float)(fre * br - fim * bi); bbi[c] = (float)(fre * bi + fim * br); }
                }
                float xr = 0.f, xi = 0.f; float* Sout = (dir ? SB : SF) - (size_t)NLAT * BW;
                const int s = lane >> 2, cg = lane & 3;
                for (int i0 = 0; i0 < CTXL; i0 += 16) {
#pragma unroll 4
                    for (int ss = 0; ss < 16; ++ss) {
                        const size_t tok = (size_t)step_tok(b, dir, i0 + ss);
                        const u32x4* up = (const u32x4*)(P + tok * LDP + S5_OFF + g * 16);
                        float t0[8], t1[8]; unpack8(up[0], t0); unpack8(up[1], t1);
                        float bur = 0.f, bui = 0.f;
#pragma unroll
                        for (int c = 0; c < 8; ++c) { bur += t0[c] * bbr[c] + t1[c] * bbr[8 + c]; bui += t0[c] * bbi[c] + t1[c] * bbi[8 + c]; }
                        const float nxr = abr * xr - abi * xi + bur, nxi = abr * xi + abi * xr + bui; xr = nxr; xi = nxi;
                        xb[ss * 65 + lane] = make_float2(xr, xi);
                    }
                    asm volatile("s_waitcnt lgkmcnt(0)" ::: "memory");
                    float y0 = 0.f, y1 = 0.f, y2 = 0.f, y3 = 0.f;
                    for (int nn2 = 0; nn2 < 64; ++nn2) { const float2 xv = xb[s * 65 + nn2];
                        const float2 c0 = ctab[(cg * 4 + 0) * 65 + nn2], c1 = ctab[(cg * 4 + 1) * 65 + nn2], c2 = ctab[(cg * 4 + 2) * 65 + nn2], c3 = ctab[(cg * 4 + 3) * 65 + nn2];
                        y0 += xv.x * c0.x - xv.y * c0.y; y1 += xv.x * c1.x - xv.y * c1.y; y2 += xv.x * c2.x - xv.y * c2.y; y3 += xv.x * c3.x - xv.y * c3.y; }
                    const size_t toks = (size_t)step_tok(b, dir, i0 + s);
                    *(float4*)(Sout + toks * BW + g * 16 + cg * 4) = make_float4(y0, y1, y2, y3);
                    asm volatile("s_waitcnt lgkmcnt(0)" ::: "memory");
                }
                XCTX[((b * 32 + g) * 2 + dir) * 64 + n] = make_float2(xr, xi);
            } else {
                if (bid < 192) {
                    pg8::Gemm gg_{S5A, S5P, 768, 512, 512}; pg8::SchedS5a S_{bid - 128}; pg8::EpiXloc E_{XLOC};
                    pg8::gemm_phase((LAS unsigned char*)shm, gg_, S_, E_);
                    __syncthreads();
                }
                const int nhb = G - 128, hb = bid - 128; const float* bias = PT(19) + l * 1024; const int c = tid;
                const int nitems = lastl ? 0 : 4 * (CTXL / 8);
                for (int it = hb; it < nitems; it += nhb) {
                    int L, tokbase, b, t0; const float* K2;
                    { const int q = it; L = CTXL; tokbase = NLAT; b = q / (CTXL / 8); t0 = (q % (CTXL / 8)) * 8; K2 = K2C; }
                    const float* zb = U + (size_t)(tokbase + b * L) * 1536 + c;
                    float acc[8];
#pragma unroll
                    for (int i = 0; i < 8; ++i) acc[i] = 0.f;
                    const int base = t0 + L - 1;
                    for (int s = 0; s < L; s += 8) {
                        float k[15];
#pragma unroll
                        for (int mm = 0; mm < 15; ++mm) k[mm] = K2[((size_t)(base - s - 7 + mm) * 2 + 0) * 512 + c];
#pragma unroll
                        for (int ds = 0; ds < 8; ++ds) { const float z = zb[(size_t)(s + ds) * 1536];
#pragma unroll
                            for (int i = 0; i < 8; ++i) acc[i] += k[i - ds + 7] * z; }
                    }
#pragma unroll
                    for (int i = 0; i < 8; ++i) { const size_t tok = (size_t)(tokbase + b * L + t0 + i); const float zt = U[tok * 1536 + c]; Z[tok * BW + c] = (acc[i] + bias[c] * zt) * U[tok * 1536 + 512 + c]; }
                }
            }
            {   __syncthreads(); fft_twiddles((float2*)(shm + FFT_X_BYTES), tid);
                int* qslot = (int*)(shm + FFT_X_BYTES + 32768);
                for (;;) { __syncthreads(); if (tid == 0) *qslot = atomicAdd(QCTR + l * 64, 1); __syncthreads(); const int it = *qslot; if (it >= 1024) break;
                    hyena_fft_item(it, UT, HSPEC, PT(19) + l * 1024, YT, shm, tid); }
            }
            SEAM(PB + 3);
        }

        if (IN(PB + 4)) for (int rep_ = 0; rep_ < PROBE_REPS(4); ++rep_) {
            PH_BEGIN
            if (rep_ > 0) { if (bid == 0 && tid == 0) __hip_atomic_store(QCTR + l * 64 + 32, 0, __ATOMIC_RELAXED, __HIP_MEMORY_SCOPE_AGENT); xcd_barrier(bar); }
            if (bid >= G - 32) for (int idx = (bid - (G - 32)) * NTHR + tid; idx < 16384; idx += 32 * NTHR) { const int n = idx & 63, dir = (idx >> 6) & 1, b = (idx >> 7) & 3, g = idx >> 9;
                const float2 a32 = APW[((dir * 32 + g) * 64 + n) * 33 + 32]; float2 X = XCTX[((b * 32 + g) * 2 + dir) * 64 + n];
                const float* __restrict__ xl = XLOC + ((size_t)g * 512 + b * 128) * 256 + dir * 128 + 2 * n; bf16_t* __restrict__ dst = S5A + ((size_t)g * 512 + b * 128) * 768 + 512 + dir * 128 + 2 * n;
#pragma unroll 8
                for (int jj = 0; jj < 128; ++jj) { const int j = dir ? 127 - jj : jj; const float2 xv = *(const float2*)(xl + (size_t)j * 256);
                    *(unsigned*)(dst + (size_t)j * 768) = pk2(X.x, X.y);
                    const float nx = a32.x * X.x - a32.y * X.y + xv.x, ny = a32.x * X.y + a32.y * X.x + xv.y; X.x = nx; X.y = ny; } }
            {   int* qslot = (int*)(shm + 102400);
                for (;;) { __syncthreads(); if (tid == 0) *qslot = atomicAdd(QCTR + l * 64 + 32, 1); __syncthreads(); const int it = *qslot; if (it >= 32 * 68 + 64 * 68) break;
                    if (it < 32 * 68) { const int chain = it / 68, c = it % 68; mlstm_out_item(chain, c, P, QKB, VTG, PT(22) + l * 16, CST, NST, MST, (chain & 1) ? HBk : HF, shm, tid); }
                    else { const int i2 = it - 32 * 68; const int chain = i2 / 68, c = i2 % 68; const int dir_ = chain & 1, h_ = (chain >> 1) & 7;
                        ssd_out_item(chain, c, P, XBC, XTG, -expf(PT(37)[l * 16 + dir_ * 8 + h_]), PT(36)[l * 16 + dir_ * 8 + h_], SSTB, dir_ ? YB : YF, shm, tid); } }
            }
            __syncthreads();
            {   const float* bias = PT(19) + l * 1024 + 512; const int c = tid;
                const int nitems = lastl ? 0 : 4 * (CTXL / 8);
                for (int it = bid; it < nitems; it += G) {
                    int L, tokbase, b, t0; const float* K2;
                    { const int q = it; L = CTXL; tokbase = NLAT; b = q / (CTXL / 8); t0 = (q % (CTXL / 8)) * 8; K2 = K2C; }
                    const float* zb = Z + (size_t)(tokbase + b * L) * BW + c;
                    float acc[8];
#pragma unroll
                    for (int i = 0; i < 8; ++i) acc[i] = 0.f;
                    const int base = t0 + L - 1;
                    for (int s = 0; s < L; s += 8) {
                        float k[15];
#pragma unroll
                        for (int mm = 0; mm < 15; ++mm) k[mm] = K2[((size_t)(base - s - 7 + mm) * 2 + 1) * 512 + c];
#pragma unroll
                        for (int ds = 0; ds < 8; ++ds) { const float z = zb[(size_t)(s + ds) * BW];
#pragma unroll
                            for (int i = 0; i < 8; ++i) acc[i] += k[i - ds + 7] * z; }
                    }
#pragma unroll
                    for (int i = 0; i < 8; ++i) { const size_t tok = (size_t)(tokbase + b * L + t0 + i); const float zt = Z[tok * BW + c]; Y4[tok * DM + c] = f2bf((acc[i] + bias[c] * zt) * U[tok * 1536 + 1024 + c]); }
                }
            }
            SEAM(PB + 4);
        }

        if (IN(PB + 5)) for (int rep_ = 0; rep_ < PROBE_REPS(5); ++rep_) {
            PH_BEGIN
            const float* ml_norm = PT(23) + l * BW; const float* ssd_d = PT(38) + l * 8; const float* ssd_norm = PT(39) + l * BW; const float* s5_d = PT(31) + l * BW;
            if (bid < 128) {
                pg8::Gemm gg_{S5A, S5B, 768, 768, 768}; pg8::SchedS5b S_{bid}; pg8::EpiS5Out E_{P, s5_d, GG};
                pg8::gemm_phase((LAS unsigned char*)shm, gg_, S_, E_);
                __syncthreads();
            }
            for (int tok = bid * 8 + wave; tok < NTOK; tok += G * 8) {
                const int c0 = lane * 8; const bf16_t* pr = P + (size_t)tok * LDP; const size_t o5 = (size_t)tok * BW + c0;
                float hm[8], ys[8];
                { const float4 a0 = *(const float4*)(HF + o5), a1 = *(const float4*)(HF + o5 + 4), b0 = *(const float4*)(HBk + o5), b1 = *(const float4*)(HBk + o5 + 4);
                  hm[0] = a0.x + b0.x; hm[1] = a0.y + b0.y; hm[2] = a0.z + b0.z; hm[3] = a0.w + b0.w; hm[4] = a1.x + b1.x; hm[5] = a1.y + b1.y; hm[6] = a1.z + b1.z; hm[7] = a1.w + b1.w; }
                { const float4 a0 = *(const float4*)(YF + o5), a1 = *(const float4*)(YF + o5 + 4), b0 = *(const float4*)(YB + o5), b1 = *(const float4*)(YB + o5 + 4);
                  float xx[8], zz[8]; unpack8(*(const u32x4*)(XBC + (size_t)tok * 1024 + c0), xx); unpack8(*(const u32x4*)(pr + SSD_OFF + c0), zz); const float dsk = ssd_d[c0 >> 6];
                  ys[0] = a0.x + b0.x; ys[1] = a0.y + b0.y; ys[2] = a0.z + b0.z; ys[3] = a0.w + b0.w; ys[4] = a1.x + b1.x; ys[5] = a1.y + b1.y; ys[6] = a1.z + b1.z; ys[7] = a1.w + b1.w;
#pragma unroll
                  for (int j = 0; j < 8; ++j) ys[j] = (ys[j] + dsk * xx[j]) * siluf_(zz[j]); }
                float s1 = 0.f, s2 = 0.f;
#pragma unroll
                for (int j = 0; j < 8; ++j) { s1 += hm[j] * hm[j]; s2 += ys[j] * ys[j]; }
                s1 += __shfl_xor(s1, 1); s1 += __shfl_xor(s1, 2); s1 += __shfl_xor(s1, 4); s1 += __shfl_xor(s1, 8);
                s2 = wave_sum(s2);
                const float r1 = rsqrtf(s1 * (1.0f / 128.0f) + 1e-6f), r2 = rsqrtf(s2 * (1.0f / BW) + 1e-6f);
                float oo[8]; unpack8(*(const u32x4*)(pr + ML_OFF + 1536 + c0), oo);
                const float4 g0 = *(const float4*)(ml_norm + c0), g1 = *(const float4*)(ml_norm + c0 + 4), n0 = *(const float4*)(ssd_norm + c0), n1 = *(const float4*)(ssd_norm + c0 + 4);
                const float gm[8] = {g0.x, g0.y, g0.z, g0.w, g1.x, g1.y, g1.z, g1.w}, gs[8] = {n0.x, n0.y, n0.z, n0.w, n1.x, n1.y, n1.z, n1.w};
                u32x4 w;
                w.x = pk2(hm[0] * r1 * gm[0] * sigmoidf_(oo[0]), hm[1] * r1 * gm[1] * sigmoidf_(oo[1])); w.y = pk2(hm[2] * r1 * gm[2] * sigmoidf_(oo[2]), hm[3] * r1 * gm[3] * sigmoidf_(oo[3]));
                w.z = pk2(hm[4] * r1 * gm[4] * sigmoidf_(oo[4]), hm[5] * r1 * gm[5] * sigmoidf_(oo[5])); w.w = pk2(hm[6] * r1 * gm[6] * sigmoidf_(oo[6]), hm[7] * r1 * gm[7] * sigmoidf_(oo[7]));
                *(u32x4*)(Y4 + (size_t)tok * DM + 512 + c0) = w;
                w.x = pk2(ys[0] * r2 * gs[0], ys[1] * r2 * gs[1]); w.y = pk2(ys[2] * r2 * gs[2], ys[3] * r2 * gs[3]); w.z = pk2(ys[4] * r2 * gs[4], ys[5] * r2 * gs[5]); w.w = pk2(ys[6] * r2 * gs[6], ys[7] * r2 * gs[7]);
                *(u32x4*)(Y4 + (size_t)tok * DM + 1536 + c0) = w;
                if (tok >= NLAT) { const size_t oc = (size_t)(tok - NLAT) * BW + c0; float uu[8]; unpack8(*(const u32x4*)(pr + S5_OFF + c0), uu);
                    const float4 a0 = *(const float4*)(SF + oc), a1 = *(const float4*)(SF + oc + 4), b0 = *(const float4*)(SB + oc), b1 = *(const float4*)(SB + oc + 4), d0 = *(const float4*)(s5_d + c0), d1 = *(const float4*)(s5_d + c0 + 4);
                    float y[8] = {a0.x + b0.x + d0.x * uu[0], a0.y + b0.y + d0.y * uu[1], a0.z + b0.z + d0.z * uu[2], a0.w + b0.w + d0.w * uu[3], a1.x + b1.x + d1.x * uu[4], a1.y + b1.y + d1.y * uu[5], a1.z + b1.z + d1.z * uu[6], a1.w + b1.w + d1.w * uu[7]};
#pragma unroll
                    for (int j = 0; j < 8; ++j) y[j] = 0.5f * y[j] * (1.0f + tanhf(0.7978845608028654f * (y[j] + 0.044715f * y[j] * y[j] * y[j])));
                    w.x = pk2(y[0], y[1]); w.y = pk2(y[2], y[3]); w.z = pk2(y[4], y[5]); w.w = pk2(y[6], y[7]);
                    *(u32x4*)(GG + (size_t)tok * BW + c0) = w; }
            }
            __syncthreads();
            {   float* T = sf;
                for (int unit = (G > 128 ? bid - 128 : bid); unit >= 0 && unit < 4 * 64 * 8; unit += (G > 128 ? G - 128 : G)) { const int b = unit / 512, t0 = ((unit >> 3) & 63) * 64, c0 = (unit & 7) * 64;
                    __syncthreads();
#pragma unroll
                    for (int i = 0; i < 8; ++i) { const int t = tid & 63, c = (tid >> 6) + 8 * i; T[c * 65 + t] = YT[((size_t)b * 512 + c0 + c) * SEQ + t0 + t]; }
                    __syncthreads();
                    const int t = tid >> 3, cq = (tid & 7) * 8;
                    u32x4 w; w.x = pk2(T[(cq + 0) * 65 + t], T[(cq + 1) * 65 + t]); w.y = pk2(T[(cq + 2) * 65 + t], T[(cq + 3) * 65 + t]); w.z = pk2(T[(cq + 4) * 65 + t], T[(cq + 5) * 65 + t]); w.w = pk2(T[(cq + 6) * 65 + t], T[(cq + 7) * 65 + t]);
                    *(u32x4*)(Y4 + ((size_t)b * SEQ + t0 + t) * DM + c0 + cq) = w;
                } }
            SEAM(PB + 5);
        }

        if (IN(PB + 6)) for (int rep_ = 0; rep_ < PROBE_REPS(6); ++rep_) {
            PH_BEGIN
            pg8::Gemm g{GG, GLU, BW, BW, BW}; pg8::SchedStd S{68, 2, G, bid, BW, BW}; pg8::EpiGlu E{GG, PT(33) + l * BW, Y4};
            pg8::gemm_phase((LAS unsigned char*)shm, g, S, E);
            SEAM(PB + 6);
        }
        if (IN(PB + 7)) for (int rep_ = 0; rep_ < PROBE_REPS(7); ++rep_) {
            PH_BEGIN
            pg8::Gemm g{Y4, WBR, DM, BW, BW}; pg8::SchedBranch S{nPanels, 8, G, bid}; pg8::EpiBranch E{P, ACCb};
            pg8::gemm_phase((LAS unsigned char*)shm, g, S, E);
            SEAM(PB + 7);
        }
        if (IN(PB + 8)) for (int rep_ = 0; rep_ < PROBE_REPS(8); ++rep_) {
            PH_BEGIN
            pg8::Gemm g{ACCb, WOUT, DM, DM, DM}; pg8::SchedStd S{nPanels, 8, G, bid, DM, DM}; pg8::EpiResid E{XS, l == 0 ? x_in : (const float*)XS, l == 0 ? ctx_in - (size_t)NLAT * DM : (const float*)XS, MODl, 2};
            pg8::gemm_phase((LAS unsigned char*)shm, g, S, E);
            SEAM(PB + 8);
        }
        if (IN(PB + 9)) for (int rep_ = 0; rep_ < PROBE_REPS(9); ++rep_) {
            PH_BEGIN
            for (int i = bid * NTHR + tid; i < NEXP * MOE_PAD; i += G * NTHR) ROWTOK[i] = -1;
            for (int i = bid * NTHR + tid; i < NTOK * 16; i += G * NTHR) INV[i] = -1;
            const float* wr = PT(42) + (size_t)l * DM * 16; const float* gn = norm_ffn + l * DM;
            for (int tok0 = (bid * 8 + wave) * 4; tok0 < M2; tok0 += G * 32) {
                const int r = tok0 < NLAT ? tok0 / SEQ : 4; const float* xr = XS + (size_t)tok0 * DM;
                const float* sh = MODl + (size_t)(r * 6 + 3) * DM; const float* sc = MODl + (size_t)(r * 6 + 4) * DM;
                float rs[4];
#pragma unroll
                for (int tk = 0; tk < 4; ++tk) { float ss = 0.f;
#pragma unroll 4
                    for (int i = 0; i < 8; ++i) { const float4 t4 = *(const float4*)(xr + (size_t)tk * DM + i * 256 + lane * 4); ss += t4.x * t4.x + t4.y * t4.y + t4.z * t4.z + t4.w * t4.w; }
                    ss = wave_sum(ss); rs[tk] = rsqrtf(ss * (1.0f / DM) + 1e-6f); }
                float lg[4][16];
#pragma unroll
                for (int tk = 0; tk < 4; ++tk)
#pragma unroll
                    for (int e = 0; e < 16; ++e) lg[tk][e] = 0.f;
#pragma unroll 1
                for (int i = 0; i < 8; ++i) { const int d = i * 256 + lane * 4;
                    const float4 g4 = *(const float4*)(gn + d), s4 = *(const float4*)(sc + d), h4 = *(const float4*)(sh + d);
                    float hv[4][4];
#pragma unroll
                    for (int tk = 0; tk < 4; ++tk) { const float4 xv = *(const float4*)(xr + (size_t)tk * DM + d); const float rr = rs[tk];
                        hv[tk][0] = xv.x * rr * g4.x * (1.f + s4.x) + h4.x; hv[tk][1] = xv.y * rr * g4.y * (1.f + s4.y) + h4.y; hv[tk][2] = xv.z * rr * g4.z * (1.f + s4.z) + h4.z; hv[tk][3] = xv.w * rr * g4.w * (1.f + s4.w) + h4.w;
                        u32x2 w; w.x = pk2(hv[tk][0], hv[tk][1]); w.y = pk2(hv[tk][2], hv[tk][3]); *(u32x2*)(HB + (size_t)(tok0 + tk) * DM + d) = w; }
                    const float4* wq = (const float4*)(wr + (size_t)d * 16);
#pragma unroll
                    for (int q = 0; q < 4; ++q) { const float4 w0 = wq[q * 4 + 0], w1 = wq[q * 4 + 1], w2 = wq[q * 4 + 2], w3 = wq[q * 4 + 3];
#pragma unroll
                        for (int tk = 0; tk < 4; ++tk) { const float hq = hv[tk][q];
                            lg[tk][0] += hq * w0.x; lg[tk][1] += hq * w0.y; lg[tk][2] += hq * w0.z; lg[tk][3] += hq * w0.w; lg[tk][4] += hq * w1.x; lg[tk][5] += hq * w1.y; lg[tk][6] += hq * w1.z; lg[tk][7] += hq * w1.w;
                            lg[tk][8] += hq * w2.x; lg[tk][9] += hq * w2.y; lg[tk][10] += hq * w2.z; lg[tk][11] += hq * w2.w; lg[tk][12] += hq * w3.x; lg[tk][13] += hq * w3.y; lg[tk][14] += hq * w3.z; lg[tk][15] += hq * w3.w; } } }
#pragma unroll
                for (int tk = 0; tk < 4; ++tk) { float mx = -1e30f;
#pragma unroll
                    for (int e = 0; e < 16; ++e) { lg[tk][e] = wave_sum(lg[tk][e]); mx = fmaxf(mx, lg[tk][e]); }
                    float sm = 0.f;
#pragma unroll
                    for (int e = 0; e < 16; ++e) { lg[tk][e] = expf(lg[tk][e] - mx); sm += lg[tk][e]; }
                    const float inv = 1.0f / sm;
                    if (lane == 0) {
#pragma unroll
                        for (int e = 0; e < 16; e += 4) *(float4*)(PROBS + (size_t)(tok0 + tk) * 16 + e) = make_float4(lg[tk][e] * inv, lg[tk][e + 1] * inv, lg[tk][e + 2] * inv, lg[tk][e + 3] * inv); } }
            }
            SEAM(PB + 9);
        }
        if (IN(PB + 10)) for (int rep_ = 0; rep_ < PROBE_REPS(10); ++rep_) {
            PH_BEGIN
            const int nitems = 64 + (lastl ? 0 : 64);
            unsigned long long* keys = (unsigned long long*)shm;
            for (int it = bid; it < nitems; it += G) {
                const int set = it >> 6, e = it & 15, b = (it >> 4) & 3;
                const int n = set ? CTXL : SEQ, cap = set ? 32 : 512, tokbase = set ? NLAT + b * CTXL : b * SEQ;
                __syncthreads();
                for (int i = tid; i < n; i += NTHR) keys[i] = ((unsigned long long)__float_as_uint(PROBS[(size_t)(tokbase + i) * 16 + e]) << 32) | (unsigned long long)(0xFFFFFFFFu - (unsigned)i);
                __syncthreads();
                for (int k = 2; k <= n; k <<= 1)
                    for (int j = k >> 1; j > 0; j >>= 1) {
                        for (int p = tid; p < (n >> 1); p += NTHR) { const int i = ((p & ~(j - 1)) << 1) | (p & (j - 1)); const int m = i | j;
                            const unsigned long long ka = keys[i], kb = keys[m]; const bool desc = ((i & k) == 0);
                            if ((ka < kb) == desc) { keys[i] = kb; keys[m] = ka; } }
                        __syncthreads();
                    }
                for (int r = tid; r < cap; r += NTHR) { const unsigned long long kk = keys[r]; const int row = e * MOE_PAD + (set ? 2048 + b * 32 + r : b * 512 + r);
                    const int tk_ = tokbase + (int)(0xFFFFFFFFu - (unsigned)(kk & 0xFFFFFFFFull)); ROWTOK[row] = tk_; ROWGATE[row] = __uint_as_float((unsigned)(kk >> 32)); INV[tk_ * 16 + e] = row; }
                for (int r = wave; r < cap; r += 8) { const int tok = tokbase + (int)(0xFFFFFFFFu - (unsigned)(keys[r] & 0xFFFFFFFFull)); const int row = e * MOE_PAD + (set ? 2048 + b * 32 + r : b * 512 + r);
                    const u32x4* sp = (const u32x4*)(HB + (size_t)tok * DM); u32x4* dp = (u32x4*)(XG + (size_t)row * DM);
#pragma unroll
                    for (int i = 0; i < 4; ++i) dp[i * 64 + lane] = sp[i * 64 + lane]; }
            }
            {   const int pad0 = lastl ? 2048 : MOE_ROWS, npad = MOE_PAD - pad0;
                for (int R = bid * 8 + wave; R < NEXP * npad; R += G * 8) { const int e = R / npad, rr = pad0 + R % npad; u32x4* dp = (u32x4*)(XG + ((size_t)e * MOE_PAD + rr) * DM);
#pragma unroll
                    for (int i = 0; i < 4; ++i) dp[i * 64 + lane] = (u32x4){0u, 0u, 0u, 0u}; } }
            SEAM(PB + 10);
        }
        if (IN(PB + 12)) for (int rep_ = 0; rep_ < PROBE_REPS(12); ++rep_) {
            PH_BEGIN
            pg8::Gemm g{XG, WGU, DM, DM, DM}; pg8::SchedMoe S{lastl ? 8 : 9, 12, G, bid, DM, DM, 2 * DEXP}; pg8::EpiMoe1 E{HID};
            pg8::gemm_phase((LAS unsigned char*)shm, g, S, E);
            SEAM(PB + 12);
        }
        if (IN(PB + 13)) for (int rep_ = 0; rep_ < PROBE_REPS(13); ++rep_) {
            PH_BEGIN
            pg8::Gemm g{HID, WD, DEXP, DEXP, DEXP}; pg8::SchedMoe S{lastl ? 8 : 9, 8, G, bid, DEXP, DEXP, DM}; pg8::EpiMoeY E{YEXP};
            pg8::gemm_phase((LAS unsigned char*)shm, g, S, E);
            SEAM(PB + 13);
        }

}

__global__ __launch_bounds__(NTHR, 2) void fwd(Args a) {
    extern __shared__ __attribute__((aligned(16))) unsigned char shm[];
    const int bid = blockIdx.x, G = gridDim.x;
    float* const sf = (float*)shm;
    volatile LAS unsigned* xbw = (volatile LAS unsigned*)((LAS unsigned char*)shm + (LDS_BYTES - 16));
    if (threadIdx.x == 0) { xbw[0] = 0u; xbw[1] = 0u; xbw[2] = 0u; xbw[3] = 0u; }
    const float** const ptab = (const float**)(shm + (LDS_BYTES - 16 - 512));
    if (threadIdx.x == 0) {
#pragma unroll
        for (int i = 0; i < 47; ++i) ptab[i] = a.in[i]; }
    __syncthreads();
    XcdBarrier bar = xcd_barrier_post((unsigned*)(a.ws + O_BAR), xbw);
    const int lo = a.ph_lo, hi = a.ph_hi;
    if (IN(0)) {
        PH_BEGIN
        {
            __syncthreads();
            for (int i = tid; i < 5 * DM; i += NTHR) { const int r = i >> 11, k = i & (DM - 1); const float v = r < 4 ? c_in[r * DM + k] : cctx_in[k]; sf[i] = siluf_(v); }
            __syncthreads();
            float* red = sf + 5 * DM;
            for (int unit = bid; unit < 2 * 96; unit += G) { const int l = unit / 96, j = (unit % 96) * 128 + (tid & 127), kq = tid >> 7;
                const float* w = ada_w + (size_t)l * DM * (6 * DM) + (size_t)(kq * 512) * (6 * DM) + j; const float* sv = sf + kq * 512;
                float a0 = 0.f, a1 = 0.f, a2 = 0.f, a3 = 0.f, a4 = 0.f;
#pragma unroll 8
                for (int k = 0; k < 512; ++k) { const float wv = w[(size_t)k * (6 * DM)]; a0 += sv[k] * wv; a1 += sv[DM + k] * wv; a2 += sv[2 * DM + k] * wv; a3 += sv[3 * DM + k] * wv; a4 += sv[4 * DM + k] * wv; }
                __syncthreads();
                { float* rp = red + (kq * 5) * 128 + (tid & 127); rp[0] = a0; rp[128] = a1; rp[256] = a2; rp[384] = a3; rp[512] = a4; }
                __syncthreads();
                if (tid < 128) { const float bb = ada_b[l * 6 * DM + j]; float* o = MOD + (size_t)l * 5 * 6 * DM + j;
#pragma unroll
                    for (int r = 0; r < 5; ++r) o[(size_t)r * 6 * DM] = ((red[(0 * 5 + r) * 128 + tid] + red[(1 * 5 + r) * 128 + tid]) + (red[(2 * 5 + r) * 128 + tid] + red[(3 * 5 + r) * 128 + tid])) + bb; }
            }
        }
    }

    layer_body<0>(a, bar, lo, hi, bid, G, shm, sf, ptab);
    layer_body<1>(a, bar, lo, hi, bid, G, shm, sf, ptab);
    if (IN(33)) {
        PH_BEGIN
        const float* gn = PT(46);
        for (int tok = bid * 8 + wave; tok < NLAT; tok += G * 8) {
            const float* xr = XS + (size_t)tok * DM; float4 v[8]; float ss = 0.f;
#pragma unroll
            for (int i = 0; i < 8; ++i) v[i] = *(const float4*)(xr + i * 256 + lane * 4);
            moe_combine(v, tok, lane, INV, ROWGATE, YEXP, MOD + (size_t)(1 * 5 + tok / SEQ) * 6 * DM + 5 * DM);
#pragma unroll
            for (int i = 0; i < 8; ++i) {                 ss += v[i].x * v[i].x + v[i].y * v[i].y + v[i].z * v[i].z + v[i].w * v[i].w; }
            ss = wave_sum(ss); const float rs = rsqrtf(ss * (1.0f / DM) + 1e-6f);
#pragma unroll
            for (int i = 0; i < 8; ++i) { const int d = i * 256 + lane * 4; const float4 g4 = *(const float4*)(gn + d);
                *(float4*)(a.out + (size_t)tok * DM + d) = make_float4(v[i].x * rs * g4.x, v[i].y * rs * g4.y, v[i].z * rs * g4.z, v[i].w * rs * g4.w); }
        }
    }
#undef IN
#undef SEAM
}


extern "C" void kernel_launch(void* const* d_in, const int* in_sizes, int n_in, void* d_out, int out_size, void* d_ws, size_t ws_size, hipStream_t stream) {
    static int grid = 0;
    if (grid == 0) {
        if (n_in != 47 || ws_size < WS_END) { fprintf(stderr, "kernel_launch: expected 47 inputs and >= %zu bytes of workspace; got %d, %zu\n", (size_t)WS_END, n_in, ws_size); grid = -1; return; }
        int dev = 0, cus = 0;
        if (hipGetDevice(&dev) != hipSuccess || hipDeviceGetAttribute(&cus, hipDeviceAttributeMultiprocessorCount, dev) != hipSuccess) { grid = -1; return; }
        if (hipFuncSetAttribute((const void*)fwd, hipFuncAttributeMaxDynamicSharedMemorySize, LDS_BYTES) != hipSuccess) { fprintf(stderr, "kernel_launch: hipFuncSetAttribute failed\n"); grid = -1; return; }
        int per_cu = 0;
        if (hipOccupancyMaxActiveBlocksPerMultiprocessor(&per_cu, (const void*)fwd, NTHR, LDS_BYTES) != hipSuccess || per_cu < 1) fprintf(stderr, "kernel_launch: occupancy query reports %d\n", per_cu);
        (void)hipGetLastError();
        grid = cus > 256 ? 256 : cus;
        if (grid < 160) { fprintf(stderr, "kernel_launch: needs >= 160 CUs (got %d)\n", grid); grid = -1; return; }
    }
    if (grid < 0) return;
    (void)hipMemsetAsync((char*)d_ws, 0, O_ZERO_END, stream);
    Args a{};
    for (int i = 0; i < 47; ++i) a.in[i] = (const float*)d_in[i];
    a.out = (float*)d_out; a.ws = (unsigned char*)d_ws;
#if MK_ONE_LAUNCH
    a.ph_lo = 0; a.ph_hi = 64;
    hipLaunchKernelGGL(fwd, dim3(grid), dim3(NTHR), LDS_BYTES, stream, a);
#else
    const int ids[] = {0, 1,2,3,4,5,6,7,8,9,10,11,12,13,14, 17,18,19,20,21,22,23,24,25,26,27,28,29,30, 33};
    for (int k = 0; k < (int)(sizeof(ids) / sizeof(ids[0])); ++k) { a.ph_lo = ids[k]; a.ph_hi = ids[k] + 1; hipLaunchKernelGGL(fwd, dim3(grid), dim3(NTHR), LDS_BYTES, stream, a); }
#endif
}
```

```cpp
#include <hip/hip_runtime.h>
#include <stdint.h>
#include <stdio.h>

#ifndef PROBE_MASK
#define PROBE_MASK 0
#endif
#ifndef PROBE_SP
#define PROBE_SP 1
#endif
#define PROBE_REPS(k) ((((PROBE_MASK) >> (k)) & 1) + 1)
#ifndef MK_ONE_LAUNCH
#define MK_ONE_LAUNCH 1
#endif

#define DM 2048
#define NB 4
#define SEQ 4096
#define CTXL 256
#define BW 512
#define NLAT 16384
#define NCTX 1024
#define NTOK 17408
#define IN_W 13856
#define LDP 14080
#define HY_OFF 0
#define ML_OFF 1536
#define S5_OFF 3600
#define SSD_OFF 4112
#define GATE_OFF 5664
#define NEXP 16
#define DEXP 1536
#define MOE_ROWS 2176
#define MOE_PAD 2304
#define NTHR 512
#define LDS_BYTES 147456
#define LAS __attribute__((address_space(3)))

typedef unsigned short bf16_t;
typedef short bf16x8 __attribute__((ext_vector_type(8)));
typedef float f32x4 __attribute__((ext_vector_type(4)));
typedef unsigned u32x4 __attribute__((ext_vector_type(4)));
typedef unsigned u32x2 __attribute__((ext_vector_type(2)));

#define XB_TMO      128
#define XB_XCNT(j)  (256  + 64 * (j))
#define XB_XSUB(j)  (1280 + 64 * (j))
#define XB_XGEN(j)  (2304 + 64 * (j))
#define XB_TOP      3328
#define XB_TOPGEN   3392
#define XCD_BAR_WORDS 3456
#define XB_SPIN_CAP (1u << 18)
__device__ __forceinline__ unsigned xb_ld(unsigned* p)              { return __hip_atomic_load(p, __ATOMIC_RELAXED, __HIP_MEMORY_SCOPE_AGENT); }
__device__ __forceinline__ unsigned xb_add(unsigned* p, unsigned v) { return __hip_atomic_fetch_add(p, v, __ATOMIC_RELAXED, __HIP_MEMORY_SCOPE_AGENT); }
__device__ __forceinline__ unsigned xb_xcc_id() { return (unsigned)__builtin_amdgcn_s_getreg((3 << 11) | 20) & 0xFu; }
#define XB_SPIN(cond, bar) do { unsigned _sp = 0; while (cond) { __builtin_amdgcn_s_sleep(1); \
    if ((++_sp & 255u) == 0u) { if (xb_ld(&(bar)[XB_TMO])) break; if (_sp > XB_SPIN_CAP) { atomicAdd(&(bar)[XB_TMO], 1u); break; } } } } while (0)
struct XcdBarrier { unsigned* bar; unsigned x; volatile LAS unsigned* st; };
__device__ __forceinline__ XcdBarrier xcd_barrier_post(unsigned* bar, volatile LAS unsigned* st) {
    XcdBarrier b; b.bar = bar; b.x = xb_xcc_id(); b.st = st;
    if (threadIdx.x == 0) (void)xb_add(&bar[XB_XCNT(b.x)], 1u);
    return b;
}
__device__ __forceinline__ void xcd_barrier_complete(unsigned* bar, unsigned x, unsigned& nloc, unsigned& nx) {
    const unsigned G = gridDim.x * gridDim.y * gridDim.z;
    unsigned sum, cnt, mine, sp = 0u;
    for (;;) {
        sum = 0u; cnt = 0u; mine = 0u;
#pragma unroll
        for (unsigned j = 0; j < 16; ++j) { const unsigned c = xb_ld(&bar[XB_XCNT(j)]); sum += c; cnt += (c > 0u) ? 1u : 0u; mine = (j == x) ? c : mine; }
        if (sum == G) break;
        __builtin_amdgcn_s_sleep(1);
        if ((++sp & 255u) == 0u) { if (xb_ld(&bar[XB_TMO])) break; if (sp > XB_SPIN_CAP) { atomicAdd(&bar[XB_TMO], 1u); break; } }
    }
    nloc = mine > 0u ? mine : 1u; nx = cnt > 0u ? cnt : 1u;
}
__device__ __forceinline__ void xcd_barrier(const XcdBarrier& b) {
    asm volatile("s_waitcnt vmcnt(0)" ::: "memory");
    __syncthreads();
    if (threadIdx.x == 0) {
        unsigned* bar = b.bar;
        __builtin_amdgcn_s_waitcnt(0);
        unsigned nloc = b.st[0], nx = b.st[1];
        if (nloc == 0u) { xcd_barrier_complete(bar, b.x, nloc, nx); b.st[0] = nloc; b.st[1] = nx; }
        const unsigned old = xb_add(&bar[XB_XSUB(b.x)], 1u);
        const unsigned gen = old / nloc;
        if (old + 1u == (gen + 1u) * nloc) {
            __builtin_amdgcn_fence(__ATOMIC_RELEASE, "agent");
            asm volatile("s_waitcnt vmcnt(0)" ::: "memory");
            const unsigned og = xb_add(&bar[XB_TOP], 1u);
            const unsigned tg = og / nx;
            if (og + 1u == (tg + 1u) * nx) xb_add(&bar[XB_TOPGEN], 1u);
            else XB_SPIN(xb_ld(&bar[XB_TOPGEN]) == tg, bar);
            __builtin_amdgcn_fence(__ATOMIC_ACQUIRE, "agent");
            xb_add(&bar[XB_XGEN(b.x)], 1u);
            asm volatile("s_waitcnt vmcnt(0)" ::: "memory");
        } else {
            XB_SPIN(xb_ld(&bar[XB_XGEN(b.x)]) == gen, bar);
            __builtin_amdgcn_fence(__ATOMIC_ACQUIRE, "agent");
            asm volatile("s_waitcnt vmcnt(0)" ::: "memory");
        }
    }
    __syncthreads();
}

__device__ __forceinline__ unsigned short f2bf(float f) { unsigned u = __float_as_uint(f); u += 0x7FFFu + ((u >> 16) & 1u); return (unsigned short)(u >> 16); }
__device__ __forceinline__ float bf2f(unsigned short b) { return __uint_as_float(((unsigned)b) << 16); }
__device__ __forceinline__ unsigned pk2(float lo, float hi) { unsigned r; asm("v_cvt_pk_bf16_f32 %0, %1, %2" : "=v"(r) : "v"(lo), "v"(hi)); return r; }
__device__ __forceinline__ float sigmoidf_(float x) { return 1.0f / (1.0f + expf(-x)); }
__device__ __forceinline__ float siluf_(float x) { return x / (1.0f + expf(-x)); }
__device__ __forceinline__ float wave_sum(float v) {
#pragma unroll
    for (int o = 32; o >= 1; o >>= 1) v += __shfl_xor(v, o);
    return v;
}
__device__ __forceinline__ const float* uptr(const float* p) { const unsigned long long v = (unsigned long long)p;
    const unsigned lo = __builtin_amdgcn_readfirstlane((unsigned)v), hi = __builtin_amdgcn_readfirstlane((unsigned)(v >> 32)); return (const float*)(((unsigned long long)hi << 32) | lo); }
#define PT(k) uptr(ptab[k])
__device__ __forceinline__ int step_tok(int b, int dir, int i) {
    if (i < CTXL) { const int tt = dir ? (CTXL - 1 - i) : i; return NLAT + b * CTXL + tt; }
    const int j = i - CTXL; const int tt = dir ? (SEQ - 1 - j) : j; return b * SEQ + tt;
}
__device__ __forceinline__ void unpack8(const u32x4 w, float (&f)[8]) {
    f[0] = __uint_as_float(w.x << 16); f[1] = __uint_as_float(w.x & 0xFFFF0000u); f[2] = __uint_as_float(w.y << 16); f[3] = __uint_as_float(w.y & 0xFFFF0000u);
    f[4] = __uint_as_float(w.z << 16); f[5] = __uint_as_float(w.z & 0xFFFF0000u); f[6] = __uint_as_float(w.w << 16); f[7] = __uint_as_float(w.w & 0xFFFF0000u);
}

namespace pg8 {
constexpr int BM = 256, BK = 64, HALF = 128, HTB = HALF * BK * 2, STAGE_BYTES = 8 * HTB, NXCD = 8, WGM = 8;
__host__ __device__ __forceinline__ int lds_byte(int r, int c) { const int st = (r >> 4) * 2 + (c >> 5), rr = r & 15, cc = c & 31, ob = rr * 64 + cc * 2; return st * 1024 + (ob ^ (((ob >> 9) & 1) << 5)); }
__host__ __device__ __forceinline__ void stage_rc(int b, int& R, int& C) { const int st = b / 1024, sb = b % 1024, swz = sb ^ (((sb >> 9) & 1) << 5); R = (st >> 1) * 16 + swz / 64; C = (st & 1) * 32 + (swz % 64) / 2; }
__host__ __device__ __forceinline__ int perm32(int rho) { const int n = rho >> 4, i = rho & 15; return 8 * (i >> 2) + 4 * n + (i & 3); }
struct Unit { int pm, pn, z, k; long long ao, bo; };
struct Gemm { const bf16_t* A; const bf16_t* Bt; int lda, ldb, K; };

__device__ __forceinline__ void tile_of(int wgid, int nM, int nN, int& pm, int& pn) {
    const int nwg = nM * nN; { const int q = nwg / NXCD, r = nwg % NXCD, xcd = wgid % NXCD, off = wgid / NXCD; wgid = (xcd < r ? xcd * (q + 1) : r * (q + 1) + (xcd - r) * q) + off; }
    const int nig = WGM * nN, gid = wgid / nig, fm = gid * WGM, gsz = (nM - fm) < WGM ? (nM - fm) : WGM;
    pm = fm + ((wgid % nig) % gsz); pn = (wgid % nig) / gsz;
}
struct SchedStd {
    int nM, nN, G, c, lda, ldb;
    __device__ __forceinline__ bool next(int i, Unit& u) const { const long L = (long)i * G + c; if (L >= (long)nM * nN) return false; tile_of((int)L, nM, nN, u.pm, u.pn); u.z = 0; u.k = 0;
        u.ao = (long long)u.pm * BM * lda * 2; u.bo = (long long)u.pn * BM * ldb * 2; return true; }
    __device__ __forceinline__ void a_ready(const Unit&) const {}
    __device__ __forceinline__ void done(const Unit&) const {}
};
struct SchedBranch {
    int nM, nN, G, c;
    __device__ __forceinline__ bool next(int i, Unit& u) const { const long L = (long)(i >> 2) * G + c; if (L >= (long)nM * nN) return false; tile_of((int)L, nM, nN, u.pm, u.pn); u.z = 0; u.k = i & 3;
        u.ao = ((long long)u.pm * BM * DM + u.k * BW) * 2; u.bo = ((long long)u.k * DM + u.pn * BM) * BW * 2; return true; }
    __device__ __forceinline__ void a_ready(const Unit&) const {}
    __device__ __forceinline__ void done(const Unit&) const {}
};
struct SchedMoe {
    int nPm, nPn, G, c, lda, ldb, nBrows;
    __device__ __forceinline__ bool next(int i, Unit& u) const { const long L = (long)i * G + c; const int per = nPm * nPn; if (L >= (long)NEXP * per) return false; const int e = (int)(L / per), rem = (int)(L % per);
        u.z = e; u.k = 0; u.pm = rem % nPm; u.pn = rem / nPm; u.ao = ((long long)e * MOE_PAD + u.pm * BM) * lda * 2; u.bo = ((long long)e * nBrows + u.pn * BM) * ldb * 2; return true; }
    __device__ __forceinline__ void a_ready(const Unit&) const {}
    __device__ __forceinline__ void done(const Unit&) const {}
};

typedef f32x4 Acc[2][2][4][2];
template <class Epi, class Sched>
__device__ __forceinline__ void gemm_phase(LAS unsigned char* lds, const Gemm g, const Sched& S, const Epi& E) {
    int tid = threadIdx.x; asm volatile("" : "+v"(tid));
    const int wid = __builtin_amdgcn_readfirstlane(tid >> 6), lane = tid & 63, wr = wid >> 2, wc = wid & 3, fr = lane & 15, fq = lane >> 4;
    const int K = g.K, nt = K / BK;
    unsigned voffA[2], voffB[2];
#pragma unroll
    for (int i = 0; i < 2; ++i) { int R, C; stage_rc(tid * 16 + i * 8192, R, C); const int Rb = Epi::PERM ? ((R & ~31) + perm32(R & 31)) : R;
        voffA[i] = (unsigned)(R * g.lda + C) * 2u; voffB[i] = (unsigned)(Rb * g.ldb + C) * 2u; }
    const size_t kstep = (size_t)(BK * 2);
    const size_t hstepA = (size_t)HALF * g.lda * 2, hstepB = (size_t)HALF * g.ldb * 2;
    const unsigned ldsw = (unsigned)wid * 1024u;
    const int aoff = lds_byte(wr * 64 + fr, fq * 8), boff = lds_byte(wc * 32 + fr, fq * 8);
#define PG8_SA(b, h) (((b) * 2 + (h)) * HTB)
#define PG8_SB(b, h) ((4 + (b) * 2 + (h)) * HTB)
#define PG8_STAGE(bufoff, gbase, voff) do { _Pragma("unroll") for (int _i = 0; _i < 2; ++_i) \
        __builtin_amdgcn_global_load_lds((const unsigned*)((const char*)(gbase) + (voff)[_i]), (LAS unsigned*)(lds + (bufoff) + ldsw + _i * 8192), 16, 0, 0); } while (0)
#define PG8_LDA(dst, b, h) do { _Pragma("unroll") for (int m = 0; m < 4; ++m) _Pragma("unroll") for (int k = 0; k < 2; ++k) dst[m][k] = *(const LAS bf16x8*)(lds + PG8_SA(b, h) + aoff + m * 2048 + k * 1024); } while (0)
#define PG8_LDB(dst, b, h) do { _Pragma("unroll") for (int n = 0; n < 2; ++n) _Pragma("unroll") for (int k = 0; k < 2; ++k) dst[n][k] = *(const LAS bf16x8*)(lds + PG8_SB(b, h) + boff + n * 2048 + k * 1024); } while (0)
#define PG8_MMA(ai, bj, At, Bt) do { __builtin_amdgcn_s_setprio(1); _Pragma("unroll") for (int m = 0; m < 4; ++m) _Pragma("unroll") for (int n = 0; n < 2; ++n) _Pragma("unroll") for (int k = 0; k < 2; ++k) \
        acc[ai][bj][m][n] = __builtin_amdgcn_mfma_f32_16x16x32_bf16(Bt[n][k], At[m][k], acc[ai][bj][m][n], 0, 0, 0); __builtin_amdgcn_s_setprio(0); } while (0)
#define PG8_WAIT_V(n) asm volatile("s_waitcnt vmcnt(" #n ")" ::: "memory")
#define PG8_WAIT_L(n) asm volatile("s_waitcnt lgkmcnt(" #n ")" ::: "memory")
#define PG8_BAR __builtin_amdgcn_s_barrier()
#define PG8_SCHED __builtin_amdgcn_sched_barrier(0)
    Unit cur, nxt; int ui = 0;
    if (!S.next(0, cur)) return;
    Acc acc;
#pragma unroll
    for (int a = 0; a < 2; ++a)
#pragma unroll
        for (int b = 0; b < 2; ++b)
#pragma unroll
            for (int m = 0; m < 4; ++m)
#pragma unroll
                for (int n = 0; n < 2; ++n) acc[a][b][m][n] = (f32x4){0.f, 0.f, 0.f, 0.f};
    bf16x8 At[4][2], B0[2][2], B1[2][2];
    const char* cA = (const char*)g.A + cur.ao; const char* cB = (const char*)g.Bt + cur.bo;
    S.a_ready(cur);
    PG8_STAGE(PG8_SB(0, 0), cB, voffB); PG8_STAGE(PG8_SA(0, 0), cA, voffA); PG8_STAGE(PG8_SB(0, 1), cB + hstepB, voffB); PG8_STAGE(PG8_SA(0, 1), cA + hstepA, voffA);
    if (wr == 1) PG8_BAR;
    PG8_WAIT_V(4); PG8_BAR;
    PG8_STAGE(PG8_SB(1, 0), cB + kstep, voffB); PG8_STAGE(PG8_SA(1, 0), cA + kstep, voffA); PG8_STAGE(PG8_SB(1, 1), cB + hstepB + kstep, voffB);
    PG8_WAIT_V(6); PG8_BAR;
    for (;;) {
        const bool has_next = S.next(ui + 1, nxt);
        const char* nA = has_next ? (const char*)g.A + nxt.ao : cA; const char* nB = has_next ? (const char*)g.Bt + nxt.bo : cB;
        for (int t = 0; t < nt; t += 2) {
            const bool last = (t == nt - 2);
            const char* a1 = cA + (size_t)(t + 1) * kstep;
            const char* a2 = last ? nA : cA + (size_t)(t + 2) * kstep; const char* b2 = last ? nB : cB + (size_t)(t + 2) * kstep;
            const char* a3 = a2 + kstep; const char* b3 = b2 + kstep;
            if (last && has_next) S.a_ready(nxt);
            PG8_LDB(B0, 0, 0); PG8_SCHED; PG8_LDA(At, 0, 0); PG8_STAGE(PG8_SA(1, 1), a1 + hstepA, voffA);
            PG8_WAIT_L(8); PG8_BAR; PG8_WAIT_L(0); PG8_MMA(0, 0, At, B0); PG8_BAR; PG8_SCHED;
            PG8_LDB(B1, 0, 1); PG8_STAGE(PG8_SB(0, 0), b2, voffB);
            PG8_BAR; PG8_WAIT_L(0); PG8_MMA(0, 1, At, B1); PG8_BAR;
            PG8_LDA(At, 0, 1); PG8_STAGE(PG8_SA(0, 0), a2, voffA);
            PG8_BAR; PG8_WAIT_L(0); PG8_MMA(1, 0, At, B0); PG8_BAR; PG8_SCHED;
            PG8_STAGE(PG8_SB(0, 1), b2 + hstepB, voffB);
            PG8_WAIT_V(6); PG8_BAR; PG8_MMA(1, 1, At, B1); PG8_BAR;
            PG8_LDB(B0, 1, 0); PG8_SCHED; PG8_LDA(At, 1, 0); PG8_STAGE(PG8_SA(0, 1), a2 + hstepA, voffA);
            PG8_WAIT_L(8); PG8_BAR; PG8_WAIT_L(0); PG8_MMA(0, 0, At, B0); PG8_BAR; PG8_SCHED;
            PG8_LDB(B1, 1, 1); PG8_STAGE(PG8_SB(1, 0), b3, voffB);
            PG8_BAR; PG8_WAIT_L(0); PG8_MMA(0, 1, At, B1); PG8_BAR;
            PG8_LDA(At, 1, 1); PG8_STAGE(PG8_SA(1, 0), a3, voffA);
            PG8_BAR; PG8_WAIT_L(0); PG8_MMA(1, 0, At, B0); PG8_BAR; PG8_SCHED;
            PG8_STAGE(PG8_SB(1, 1), b3 + hstepB, voffB);
            PG8_WAIT_V(6); PG8_BAR; PG8_MMA(1, 1, At, B1); PG8_BAR;
        }
        const bool keep = E(acc, cur, wr, wc, fr, fq); S.done(cur);
        if (!has_next) break;
        if (!keep) {
#pragma unroll
        for (int a = 0; a < 2; ++a)
#pragma unroll
            for (int b = 0; b < 2; ++b)
#pragma unroll
                for (int m = 0; m < 4; ++m)
#pragma unroll
                    for (int n = 0; n < 2; ++n) acc[a][b][m][n] = (f32x4){0.f, 0.f, 0.f, 0.f};
        }
        cur = nxt; cA = nA; cB = nB; ++ui;
    }
    PG8_WAIT_V(0);
    if (wr == 0) PG8_BAR;
    PG8_BAR;
#undef PG8_SA
#undef PG8_SB
#undef PG8_STAGE
#undef PG8_LDA
#undef PG8_LDB
#undef PG8_MMA
#undef PG8_WAIT_V
#undef PG8_WAIT_L
#undef PG8_BAR
#undef PG8_SCHED
}

struct EpiBf16Store {
    static constexpr bool PERM = true;
    bf16_t* O; int ldc;
    __device__ __forceinline__ bool operator()(Acc& acc, const Unit& u, int wr, int wc, int fr, int fq) const {
        const int row0 = u.pm * BM + wr * 64 + fr, col0 = u.pn * BM + wc * 32 + 8 * fq;
#pragma unroll
        for (int ai = 0; ai < 2; ++ai)
#pragma unroll
            for (int m = 0; m < 4; ++m) { bf16_t* rowp = O + (size_t)(row0 + ai * HALF + m * 16) * ldc + col0;
#pragma unroll
                for (int bj = 0; bj < 2; ++bj) { const f32x4 v0 = acc[ai][bj][m][0], v1 = acc[ai][bj][m][1];
                    u32x4 w; w.x = pk2(v0[0], v0[1]); w.y = pk2(v0[2], v0[3]); w.z = pk2(v1[0], v1[1]); w.w = pk2(v1[2], v1[3]);
                    *(u32x4*)(rowp + bj * HALF) = w; } }
        return false;
    }
};
struct EpiWin {
    static constexpr bool PERM = true;
    bf16_t* O; int ldc;
    __device__ __forceinline__ bool operator()(Acc& acc, const Unit& u, int wr, int wc, int fr, int fq) const {
        const int row0 = u.pm * BM + wr * 64 + fr, col0 = u.pn * BM + wc * 32 + 8 * fq;
#pragma unroll
        for (int bj = 0; bj < 2; ++bj) { const bool gate = (col0 + bj * HALF) >= GATE_OFF;
#pragma unroll
            for (int ai = 0; ai < 2; ++ai)
#pragma unroll
                for (int m = 0; m < 4; ++m) { f32x4 v0 = acc[ai][bj][m][0], v1 = acc[ai][bj][m][1];
                    if (gate) {
#pragma unroll
                        for (int j = 0; j < 4; ++j) { v0[j] = __builtin_amdgcn_rcpf(1.0f + __expf(-v0[j])); v1[j] = __builtin_amdgcn_rcpf(1.0f + __expf(-v1[j])); } }
                    u32x4 w; w.x = pk2(v0[0], v0[1]); w.y = pk2(v0[2], v0[3]); w.z = pk2(v1[0], v1[1]); w.w = pk2(v1[2], v1[3]);
                    *(u32x4*)(O + (size_t)(row0 + ai * HALF + m * 16) * ldc + col0 + bj * HALF) = w; } }
        return false;
    }
};
struct EpiNone { static constexpr bool PERM = true;
    __device__ __forceinline__ bool operator()(Acc& acc, const Unit&, int, int, int, int) const {
#pragma unroll
        for (int a = 0; a < 2; ++a)
#pragma unroll
            for (int b = 0; b < 2; ++b)
#pragma unroll
                for (int m = 0; m < 4; ++m)
#pragma unroll
                    for (int n = 0; n < 2; ++n) asm volatile("" :: "v"(acc[a][b][m][n]));
        return false; } };
struct EpiGlu {
    static constexpr bool PERM = true;
    const bf16_t* GG; const float* bias; bf16_t* Y4;
    __device__ __forceinline__ bool operator()(Acc& acc, const Unit& u, int wr, int wc, int fr, int fq) const {
        const int row0 = u.pm * BM + wr * 64 + fr, col0 = u.pn * BM + wc * 32 + 8 * fq;
#pragma unroll
        for (int bj = 0; bj < 2; ++bj) { const int col = col0 + bj * HALF; const f32x4 b0 = *(const f32x4*)(bias + col), b1 = *(const f32x4*)(bias + col + 4);
#pragma unroll
            for (int ai = 0; ai < 2; ++ai)
#pragma unroll
                for (int m = 0; m < 4; ++m) { const size_t row = (size_t)(row0 + ai * HALF + m * 16);
                    float gg[8]; unpack8(*(const u32x4*)(GG + row * BW + col), gg);
                    const f32x4 v0 = acc[ai][bj][m][0] + b0, v1 = acc[ai][bj][m][1] + b1;
                    u32x4 w; w.x = pk2(gg[0] * sigmoidf_(v0[0]), gg[1] * sigmoidf_(v0[1])); w.y = pk2(gg[2] * sigmoidf_(v0[2]), gg[3] * sigmoidf_(v0[3]));
                    w.z = pk2(gg[4] * sigmoidf_(v1[0]), gg[5] * sigmoidf_(v1[1])); w.w = pk2(gg[6] * sigmoidf_(v1[2]), gg[7] * sigmoidf_(v1[3]));
                    *(u32x4*)(Y4 + row * DM + 1024 + col) = w; } }
        return false;
    }
};
struct EpiBranch {
    static constexpr bool PERM = true;
    const bf16_t* P; bf16_t* ACCb;
    __device__ __forceinline__ bool operator()(Acc& acc, const Unit& u, int wr, int wc, int fr, int fq) const {
        const int row0 = u.pm * BM + wr * 64 + fr, col0 = u.pn * BM + wc * 32 + 8 * fq; const int k = u.k;
#pragma unroll
        for (int ai = 0; ai < 2; ++ai)
#pragma unroll
            for (int m = 0; m < 4; ++m) { const size_t row = (size_t)(row0 + ai * HALF + m * 16);
#pragma unroll
                for (int bj = 0; bj < 2; ++bj) { const int col = col0 + bj * HALF;
                    float g0[8]; unpack8(*(const u32x4*)(P + row * LDP + GATE_OFF + k * DM + col), g0);
                    float s[8];
                    if (k < 3) { float g1[8]; unpack8(*(const u32x4*)(P + row * LDP + GATE_OFF + (k + 1) * DM + col), g1);
#pragma unroll
                        for (int j = 0; j < 8; ++j) s[j] = g0[j] * __builtin_amdgcn_rcpf(g1[j]); }
                    else {
#pragma unroll
                        for (int j = 0; j < 8; ++j) s[j] = g0[j]; }
                    f32x4 v0 = acc[ai][bj][m][0], v1 = acc[ai][bj][m][1];
                    v0[0] *= s[0]; v0[1] *= s[1]; v0[2] *= s[2]; v0[3] *= s[3]; v1[0] *= s[4]; v1[1] *= s[5]; v1[2] *= s[6]; v1[3] *= s[7];
                    if (k < 3) { acc[ai][bj][m][0] = v0; acc[ai][bj][m][1] = v1; }
                    else { u32x4 w; w.x = pk2(v0[0], v0[1]); w.y = pk2(v0[2], v0[3]); w.z = pk2(v1[0], v1[1]); w.w = pk2(v1[2], v1[3]); *(u32x4*)(ACCb + row * DM + col) = w; } } }
        return k < 3;
    }
};
struct EpiResid {
    static constexpr bool PERM = false;
    float* XS; const float* srcLat; const float* srcCtx; const float* MODl; int gidx;
    __device__ __forceinline__ bool operator()(Acc& acc, const Unit& u, int wr, int wc, int fr, int fq) const {
        const int row0 = u.pm * BM + wr * 64 + fr, col0 = u.pn * BM + wc * 32 + 4 * fq;
        const int r = (u.pm * BM) < NLAT ? (u.pm * BM) / SEQ : 4;
        const float* src = (u.pm * BM) < NLAT ? srcLat : srcCtx;
        const float* mg = MODl + (size_t)(r * 6 + gidx) * DM;
#pragma unroll
        for (int bj = 0; bj < 2; ++bj)
#pragma unroll
            for (int n = 0; n < 2; ++n) { const int col = col0 + bj * HALF + n * 16; const f32x4 gm = *(const f32x4*)(mg + col);
#pragma unroll
                for (int ai = 0; ai < 2; ++ai)
#pragma unroll
                    for (int m = 0; m < 4; ++m) { const size_t o = (size_t)(row0 + ai * HALF + m * 16) * DM + col; *(f32x4*)(XS + o) = *(const f32x4*)(src + o) + gm * acc[ai][bj][m][n]; } }
        return false;
    }
};
struct EpiMoe1 {
    static constexpr bool PERM = true;
    bf16_t* HID;
    __device__ __forceinline__ bool operator()(Acc& acc, const Unit& u, int wr, int wc, int fr, int fq) const {
        const size_t row0 = (size_t)u.z * MOE_PAD + u.pm * BM + wr * 64 + fr; const int col0 = u.pn * HALF + wc * 32 + 8 * fq;
#pragma unroll
        for (int ai = 0; ai < 2; ++ai)
#pragma unroll
            for (int m = 0; m < 4; ++m) { const f32x4 g0 = acc[ai][0][m][0], g1 = acc[ai][0][m][1], u0 = acc[ai][1][m][0], u1 = acc[ai][1][m][1];
                float h[8];
#pragma unroll
                for (int j = 0; j < 4; ++j) { h[j] = g0[j] * __builtin_amdgcn_rcpf(1.0f + __expf(-g0[j])) * u0[j]; h[4 + j] = g1[j] * __builtin_amdgcn_rcpf(1.0f + __expf(-g1[j])) * u1[j]; }
                u32x4 w; w.x = pk2(h[0], h[1]); w.y = pk2(h[2], h[3]); w.z = pk2(h[4], h[5]); w.w = pk2(h[6], h[7]);
                *(u32x4*)(HID + (row0 + ai * HALF + m * 16) * DEXP + col0) = w; }
        return false;
    }
};
struct EpiMoeY {
    static constexpr bool PERM = true;
    bf16_t* O;
    __device__ __forceinline__ bool operator()(Acc& acc, const Unit& u, int wr, int wc, int fr, int fq) const {
        const size_t row0 = (size_t)u.z * MOE_PAD + u.pm * BM + wr * 64 + fr; const int col0 = u.pn * BM + wc * 32 + 8 * fq;
#pragma unroll
        for (int ai = 0; ai < 2; ++ai)
#pragma unroll
            for (int m = 0; m < 4; ++m) { bf16_t* rowp = O + (row0 + ai * HALF + m * 16) * DM + col0;
#pragma unroll
                for (int bj = 0; bj < 2; ++bj) { const f32x4 v0 = acc[ai][bj][m][0], v1 = acc[ai][bj][m][1];
                    u32x4 w; w.x = pk2(v0[0], v0[1]); w.y = pk2(v0[2], v0[3]); w.z = pk2(v1[0], v1[1]); w.w = pk2(v1[2], v1[3]);
                    *(u32x4*)(rowp + bj * HALF) = w; } }
        return false;
    }
};

struct SchedS5a {
    int c;
    __device__ __forceinline__ bool next(int i, Unit& u) const { if (i > 0 || c >= 64) return false; u.z = c >> 1; u.pm = c & 1; u.pn = 0; u.k = 0;
        u.ao = ((long long)u.z * 512 + u.pm * BM) * 768 * 2; u.bo = (long long)u.z * 256 * 512 * 2; return true; }
    __device__ __forceinline__ void a_ready(const Unit&) const {}
    __device__ __forceinline__ void done(const Unit&) const {}
};
struct SchedS5b {
    int c;
    __device__ __forceinline__ bool next(int i, Unit& u) const { if (i > 0 || c >= 128) return false; u.z = c >> 2; u.pm = (c >> 1) & 1; u.pn = c & 1; u.k = 0;
        u.ao = ((long long)u.z * 512 + u.pm * BM) * 768 * 2; u.bo = ((long long)u.z * 512 + u.pn * BM) * 768 * 2; return true; }
    __device__ __forceinline__ void a_ready(const Unit&) const {}
    __device__ __forceinline__ void done(const Unit&) const {}
};
struct EpiXloc {
    static constexpr bool PERM = false;
    float* XL;
    __device__ __forceinline__ bool operator()(Acc& acc, const Unit& u, int wr, int wc, int fr, int fq) const {
        const int row0 = u.pm * BM + wr * 64 + fr, col0 = wc * 32 + 4 * fq; float* base = XL + (size_t)u.z * 512 * 256;
#pragma unroll
        for (int ai = 0; ai < 2; ++ai)
#pragma unroll
            for (int m = 0; m < 4; ++m) { float* rowp = base + (size_t)(row0 + ai * HALF + m * 16) * 256 + col0;
#pragma unroll
                for (int bj = 0; bj < 2; ++bj)
#pragma unroll
                    for (int n = 0; n < 2; ++n) *(f32x4*)(rowp + bj * HALF + n * 16) = acc[ai][bj][m][n]; }
        return false;
    }
};
struct EpiS5Out {
    static constexpr bool PERM = true;
    const bf16_t* P; const float* dskip; bf16_t* GG;
    __device__ __forceinline__ bool operator()(Acc& acc, const Unit& u, int wr, int wc, int fr, int fq) const {
        const int row0 = u.pm * BM + wr * 64 + fr, col0 = u.pn * BM + wc * 32 + 8 * fq; const int g = u.z;
#pragma unroll
        for (int bj = 0; bj < 2; ++bj) { const int col = col0 + bj * HALF; const int t = col >> 4, c0 = col & 15;
            const f32x4 d0 = *(const f32x4*)(dskip + g * 16 + c0), d1 = *(const f32x4*)(dskip + g * 16 + c0 + 4);
#pragma unroll
            for (int ai = 0; ai < 2; ++ai)
#pragma unroll
                for (int m = 0; m < 4; ++m) { const size_t tok = (size_t)(row0 + ai * HALF + m * 16) * 32 + t;
                    float uu[8]; unpack8(*(const u32x4*)(P + tok * LDP + S5_OFF + g * 16 + c0), uu);
                    const f32x4 v0 = acc[ai][bj][m][0], v1 = acc[ai][bj][m][1];
                    float y[8] = {v0[0] + d0[0] * uu[0], v0[1] + d0[1] * uu[1], v0[2] + d0[2] * uu[2], v0[3] + d0[3] * uu[3], v1[0] + d1[0] * uu[4], v1[1] + d1[1] * uu[5], v1[2] + d1[2] * uu[6], v1[3] + d1[3] * uu[7]};
#pragma unroll
                    for (int j = 0; j < 8; ++j) y[j] = 0.5f * y[j] * (1.0f + tanhf(0.7978845608028654f * (y[j] + 0.044715f * y[j] * y[j] * y[j])));
                    u32x4 w; w.x = pk2(y[0], y[1]); w.y = pk2(y[2], y[3]); w.z = pk2(y[4], y[5]); w.w = pk2(y[6], y[7]);
                    *(u32x4*)(GG + tok * BW + g * 16 + c0) = w; } }
        return false;
    }
};
}


__device__ __forceinline__ float wave_scan_incl(float v, int lane) {
#pragma unroll
    for (int o = 1; o < 64; o <<= 1) { const float t = __shfl_up(v, o); if (lane >= o) v += t; }
    return v;
}
__device__ __forceinline__ float wave_scanmax_incl(float v, int lane) {
#pragma unroll
    for (int o = 1; o < 64; o <<= 1) { const float t = __shfl_up(v, o); if (lane >= o) v = fmaxf(v, t); }
    return v;
}
__device__ __forceinline__ float wave_max(float v) {
#pragma unroll
    for (int o = 32; o >= 1; o >>= 1) v = fmaxf(v, __shfl_xor(v, o));
    return v;
}
__device__ __forceinline__ void unpack8h(const u32x4 w, bf16_t (&h)[8]) {
    h[0] = (bf16_t)(w.x & 0xFFFFu); h[1] = (bf16_t)(w.x >> 16); h[2] = (bf16_t)(w.y & 0xFFFFu); h[3] = (bf16_t)(w.y >> 16);
    h[4] = (bf16_t)(w.z & 0xFFFFu); h[5] = (bf16_t)(w.z >> 16); h[6] = (bf16_t)(w.w & 0xFFFFu); h[7] = (bf16_t)(w.w >> 16);
}

__device__ __forceinline__ int tokblock_of(int b, int dir, int c) { if (c < 4) return 256 + b * 4 + (dir ? 3 - c : c); const int j = c - 4; return b * 64 + (dir ? 63 - j : j); }
__device__ __forceinline__ u32x4 rev8h(const u32x4 v) { u32x4 r; r.x = (v.w >> 16) | (v.w << 16); r.y = (v.z >> 16) | (v.z << 16); r.z = (v.y >> 16) | (v.y << 16); r.w = (v.x >> 16) | (v.x << 16); return r; }
__device__ __forceinline__ u32x4 scale8h(const u32x4 v, const float4 a, const float4 b) { float f[8]; unpack8(v, f); u32x4 r; r.x = pk2(f[0] * a.x, f[1] * a.y); r.y = pk2(f[2] * a.z, f[3] * a.w); r.z = pk2(f[4] * b.x, f[5] * b.y); r.w = pk2(f[6] * b.z, f[7] * b.w); return r; }
__device__ __forceinline__ float dot8h(const u32x4 v, const float4 a, const float4 b) { float f[8]; unpack8(v, f); return (f[0] * a.x + f[1] * a.y) + (f[2] * a.z + f[3] * a.w) + (f[4] * b.x + f[5] * b.y) + (f[6] * b.z + f[7] * b.w); }
#define ML_FRAG_LOAD(KF, VF, cc_) do { const int tb_ = tokblock_of(b, dir, (cc_)); const bf16_t* kb_ = KTg + ((size_t)tb_ * 512 + h * 128 + 32 * wd + r16) * 64 + q4 * 8; const bf16_t* vb_ = VTg + ((size_t)tb_ * 512 + h * 128 + 64 * half + 32 * we + r16) * 64 + q4 * 8; \
        _Pragma("unroll") for (int ks_ = 0; ks_ < 2; ++ks_) _Pragma("unroll") for (int j_ = 0; j_ < 2; ++j_) { VF[j_][ks_] = *(const u32x4*)(vb_ + (size_t)j_ * 16 * 64 + ks_ * 32); KF[j_][ks_] = *(const u32x4*)(kb_ + (size_t)j_ * 16 * 64 + ks_ * 32); } } while (0)
#define ML_CHUNK(c_, KF, VF, KFN, VFN) do { const int c = (c_); \
        if (c + 1 < 68) ML_FRAG_LOAD(KFN, VFN, c + 1);                        \
        const float dec = sDEC[c]; \
        {   bf16_t* cs = CST + (size_t)(chain * 68 + c) * 128 * 128; \
            _Pragma("unroll") for (int je = 0; je < 2; ++je) _Pragma("unroll") for (int jd = 0; jd < 2; ++jd) { const int e = 64 * half + 32 * we + 16 * je + r16, d0 = 32 * wd + 16 * jd + q4 * 4; \
                u32x2 pk; pk.x = pk2(acc[je][jd][0], acc[je][jd][1]); pk.y = pk2(acc[je][jd][2], acc[je][jd][3]); *(u32x2*)(cs + (size_t)e * 128 + d0) = pk; } \
            if (nown) { _Pragma("unroll") for (int jd = 0; jd < 2; ++jd) { float nv = npart[jd]; nv += __shfl_xor(nv, 16); nv += __shfl_xor(nv, 32); if (q4 == 0) NST[(size_t)(chain * 68 + c) * 128 + 32 * wd + 16 * jd + r16] = nv; } } } \
        bf16x8 vfr[2][2]; \
        _Pragma("unroll") for (int ks = 0; ks < 2; ++ks) { const float4 wa = *(const float4*)(sWS + c * 64 + ks * 32 + q4 * 8), wb = *(const float4*)(sWS + c * 64 + ks * 32 + q4 * 8 + 4); \
            _Pragma("unroll") for (int je = 0; je < 2; ++je) { const u32x4 sv = scale8h(VF[je][ks], wa, wb); vfr[je][ks] = *(const bf16x8*)&sv; } \
            if (nown) { _Pragma("unroll") for (int jd = 0; jd < 2; ++jd) npart[jd] = (ks == 0 ? dec * npart[jd] : npart[jd]) + dot8h(KF[jd][ks], wa, wb); } } \
        _Pragma("unroll") for (int je = 0; je < 2; ++je) _Pragma("unroll") for (int jd = 0; jd < 2; ++jd) acc[je][jd] = acc[je][jd] * dec; \
        _Pragma("unroll") for (int ks = 0; ks < 2; ++ks) _Pragma("unroll") for (int je = 0; je < 2; ++je) _Pragma("unroll") for (int jd = 0; jd < 2; ++jd) \
            acc[je][jd] = __builtin_amdgcn_mfma_f32_16x16x32_bf16(*(const bf16x8*)&KF[jd][ks], vfr[je][ks], acc[je][jd], 0, 0, 0); } while (0)
__device__ __forceinline__ void mlstm_state_pass(const int chain, const int half, const bf16_t* __restrict__ Pm, const bf16_t* __restrict__ KTg, const bf16_t* __restrict__ VTg, const float* __restrict__ gate_b,
                                                 bf16_t* __restrict__ CST, float* __restrict__ NST, float* __restrict__ MST, unsigned char* shm, const int tid) {
    const int dir = chain & 1, h = (chain >> 1) & 3, b = chain >> 3, lane = tid & 63, w = tid >> 6, we = w >> 2, wd = w & 3, q4 = lane >> 4, r16 = lane & 15;
    const bool nown = (half == 0) && (we == 0);
    float* sE = (float*)shm; float* sWS = sE + 68 * 64; float* sAL = sWS + 68 * 64; float* sBE = sAL + 68; float* sMO = sBE + 68; float* sDEC = sMO + 68; float* sMB = sDEC + 68;
    const float gbi = gate_b[(dir * 2 + 0) * 4 + h], gbf = gate_b[(dir * 2 + 1) * 4 + h];
    const int gcol_i = ML_OFF + 2048 + (dir * 2 + 0) * 4 + h, gcol_f = ML_OFF + 2048 + (dir * 2 + 1) * 4 + h;
    u32x4 kfA[2][2], vfA[2][2], kfB[2][2], vfB[2][2];
    ML_FRAG_LOAD(kfA, vfA, 0);
    __syncthreads();
    for (int c = w; c < 68; c += 8) { const size_t tokl = (size_t)step_tok(b, dir, c * 64 + lane);
        const float ig = bf2f(Pm[tokl * LDP + gcol_i]) + gbi, fg = bf2f(Pm[tokl * LDP + gcol_f]) + gbf;
        const float lf = fminf(fg, 0.f) - log1pf(expf(-fabsf(fg)));
        const float bcs = wave_scan_incl(lf, lane); const float blast = __shfl(bcs, 63); const float ei = blast - bcs + ig; const float beta = wave_max(ei);
        sE[c * 64 + lane] = ei; if (lane == 0) { sAL[c] = blast; sBE[c] = beta; } }
    __syncthreads();
    if (tid == 0) { float m = 0.f; for (int c = 0; c < 68; ++c) { sMB[c] = m; const float mo = fmaxf(m + sAL[c], sBE[c]); sDEC[c] = expf(sAL[c] + m - mo); sMO[c] = mo; m = mo; } }
    __syncthreads();
    for (int idx = tid; idx < 68 * 64; idx += NTHR) { const int c = idx >> 6, i = idx & 63; sWS[c * 64 + (dir ? 63 - i : i)] = expf(sE[idx] - sMO[c]); }
    if (half == 0 && tid < 68) MST[chain * 68 + tid] = sMB[tid];
    __syncthreads();
    f32x4 acc[2][2];
#pragma unroll
    for (int je = 0; je < 2; ++je)
#pragma unroll
        for (int jd = 0; jd < 2; ++jd) acc[je][jd] = (f32x4){0.f, 0.f, 0.f, 0.f};
    float npart[2] = {0.f, 0.f};
    for (int c2 = 0; c2 < 68; c2 += 2) { ML_CHUNK(c2, kfA, vfA, kfB, vfB); ML_CHUNK(c2 + 1, kfB, vfB, kfA, vfA); }
    __syncthreads();
}
#undef ML_CHUNK
#undef ML_FRAG_LOAD
__device__ __forceinline__ void mlstm_out_item(const int chain, const int c, const bf16_t* __restrict__ Pm, const bf16_t* __restrict__ QKb, const bf16_t* __restrict__ VTg, const float* __restrict__ gate_b,
                                               const bf16_t* __restrict__ CST, const float* __restrict__ NST, const float* __restrict__ MST, float* __restrict__ Hout, unsigned char* shm, const int tid) {
    const int dir = chain & 1, h = (chain >> 1) & 3, b = chain >> 3, lane = tid & 63, w = tid >> 6;
    bf16_t* Qs = (bf16_t*)shm; bf16_t* Ks = (bf16_t*)(shm + 17408); bf16_t* VT = (bf16_t*)(shm + 34816); bf16_t* Cs = (bf16_t*)(shm + 53248); bf16_t* Ss = (bf16_t*)(shm + 88064);
    float* sc = (float*)(shm + 97280);
    __syncthreads();
#pragma unroll
    for (int i = 0; i < 2; ++i) { const int pid = tid + i * 512; const int s = pid >> 4, x0 = (pid & 15) * 8; const size_t toks = (size_t)step_tok(b, dir, c * 64 + s);
        *(u32x4*)(Qs + s * 136 + x0) = *(const u32x4*)(QKb + toks * 1024 + h * 128 + x0);
        *(u32x4*)(Ks + s * 136 + x0) = *(const u32x4*)(QKb + toks * 1024 + 512 + h * 128 + x0);
        { const int e = pid >> 3, o = pid & 7;
          const u32x4 vv = *(const u32x4*)(VTg + ((size_t)tokblock_of(b, dir, c) * 512 + h * 128 + e) * 64 + (dir ? 7 - o : o) * 8);
          *(u32x4*)(VT + e * 72 + o * 8) = dir ? rev8h(vv) : vv; } }
#pragma unroll
    for (int i = 0; i < 4; ++i) { const int pid = tid + i * 512; const int e = pid >> 4, x0 = (pid & 15) * 8;
        *(u32x4*)(Cs + e * 136 + x0) = *(const u32x4*)(CST + ((size_t)(chain * 68 + c) * 128 + e) * 128 + x0); }
    if (tid < 128) sc[384 + tid] = NST[(size_t)(chain * 68 + c) * 128 + tid];
    if (w == 0) {
        const float gbi = gate_b[(dir * 2 + 0) * 4 + h], gbf = gate_b[(dir * 2 + 1) * 4 + h];
        const size_t tokl = (size_t)step_tok(b, dir, c * 64 + lane);
        const float ig = bf2f(Pm[tokl * LDP + ML_OFF + 2048 + (dir * 2 + 0) * 4 + h]) + gbi;
        const float fg = bf2f(Pm[tokl * LDP + ML_OFF + 2048 + (dir * 2 + 1) * 4 + h]) + gbf;
        const float lf = fminf(fg, 0.f) - log1pf(expf(-fabsf(fg)));
        const float bcs = wave_scan_incl(lf, lane); const float gsv = ig - bcs; const float pm = wave_scanmax_incl(gsv, lane);
        const float m_in = MST[chain * 68 + c]; const float mt = bcs + fmaxf(m_in, pm);
        sc[lane] = bcs; sc[64 + lane] = gsv; sc[128 + lane] = mt; sc[192 + lane] = expf(bcs + m_in - mt); sc[256 + lane] = expf(-mt);
    }
    __syncthreads();
    const int tt = w >> 1;
    {   f32x4 aS[2] = {(f32x4){0.f, 0.f, 0.f, 0.f}, (f32x4){0.f, 0.f, 0.f, 0.f}};
#pragma unroll
        for (int ks = 0; ks < 4; ++ks) { const bf16x8 af = *(const bf16x8*)(Qs + (16 * tt + (lane & 15)) * 136 + ks * 32 + (lane >> 4) * 8);
#pragma unroll
            for (int i = 0; i < 2; ++i) { const int st = (w & 1) * 2 + i; const bf16x8 bfr = *(const bf16x8*)(Ks + (16 * st + (lane & 15)) * 136 + ks * 32 + (lane >> 4) * 8);
                aS[i] = __builtin_amdgcn_mfma_f32_16x16x32_bf16(af, bfr, aS[i], 0, 0, 0); } }
        float rs[4] = {0.f, 0.f, 0.f, 0.f};
#pragma unroll
        for (int i = 0; i < 2; ++i) { const int s = 16 * ((w & 1) * 2 + i) + (lane & 15); const float gsv = sc[64 + s];
#pragma unroll
            for (int q = 0; q < 4; ++q) { const int t = 16 * tt + (lane >> 4) * 4 + q; const float val = (s <= t) ? aS[i][q] * expf(sc[t] + gsv - sc[128 + t]) : 0.f; Ss[t * 72 + s] = f2bf(val); rs[q] += val; } }
#pragma unroll
        for (int q = 0; q < 4; ++q) { float r = rs[q]; r += __shfl_xor(r, 1); r += __shfl_xor(r, 2); r += __shfl_xor(r, 4); r += __shfl_xor(r, 8);
            if ((lane & 15) == 0) sc[512 + (w & 1) * 64 + 16 * tt + (lane >> 4) * 4 + q] = r; }
        {   const int t = tid >> 3, part = tid & 7; float dot = 0.f;
#pragma unroll
            for (int j = 0; j < 16; ++j) dot += bf2f(Qs[t * 136 + part * 16 + j]) * sc[384 + part * 16 + j];
            dot += __shfl_xor(dot, 1); dot += __shfl_xor(dot, 2); dot += __shfl_xor(dot, 4);
            if (part == 0) sc[640 + t] = sc[192 + t] * dot; }
    }
    __syncthreads();
    {   f32x4 aN[4];
#pragma unroll
        for (int i = 0; i < 4; ++i) aN[i] = (f32x4){0.f, 0.f, 0.f, 0.f};
#pragma unroll
        for (int ks = 0; ks < 4; ++ks) { const bf16x8 af = *(const bf16x8*)(Qs + (16 * tt + (lane & 15)) * 136 + ks * 32 + (lane >> 4) * 8);
#pragma unroll
            for (int i = 0; i < 4; ++i) { const int et = (w & 1) * 4 + i; const bf16x8 bfr = *(const bf16x8*)(Cs + (16 * et + (lane & 15)) * 136 + ks * 32 + (lane >> 4) * 8);
                aN[i] = __builtin_amdgcn_mfma_f32_16x16x32_bf16(af, bfr, aN[i], 0, 0, 0); } }
#pragma unroll
        for (int q = 0; q < 4; ++q) { const float it = sc[192 + 16 * tt + (lane >> 4) * 4 + q];
#pragma unroll
            for (int i = 0; i < 4; ++i) aN[i][q] *= it; }
#pragma unroll
        for (int ks = 0; ks < 2; ++ks) { const bf16x8 af = *(const bf16x8*)(Ss + (16 * tt + (lane & 15)) * 72 + ks * 32 + (lane >> 4) * 8);
#pragma unroll
            for (int i = 0; i < 4; ++i) { const int et = (w & 1) * 4 + i; const bf16x8 bfr = *(const bf16x8*)(VT + (16 * et + (lane & 15)) * 72 + ks * 32 + (lane >> 4) * 8);
                aN[i] = __builtin_amdgcn_mfma_f32_16x16x32_bf16(af, bfr, aN[i], 0, 0, 0); } }
#pragma unroll
        for (int q = 0; q < 4; ++q) { const int t = 16 * tt + (lane >> 4) * 4 + q; const size_t tokt = (size_t)step_tok(b, dir, c * 64 + t); const float dn = fmaxf(fabsf((sc[512 + t] + sc[576 + t]) + sc[640 + t]), sc[256 + t]);
#pragma unroll
            for (int i = 0; i < 4; ++i) { const int e = 16 * ((w & 1) * 4 + i) + (lane & 15); Hout[tokt * BW + h * 128 + e] = aN[i][q] / dn; } }
    }
}


#define SD_FRAG_LOAD(BF, XF, cc_) do { const int tb_ = tokblock_of(b, dir, (cc_)); const bf16_t* bb_ = BTg + ((size_t)tb_ * 256 + grp * 128 + 64 * (w >> 2) + r16) * 64 + q4 * 8; const bf16_t* xb_ = XTg + ((size_t)tb_ * 512 + h * 64 + 16 * (w & 3) + r16) * 64 + q4 * 8; \
        _Pragma("unroll") for (int ks_ = 0; ks_ < 2; ++ks_) { XF[ks_] = *(const u32x4*)(xb_ + ks_ * 32); _Pragma("unroll") for (int j_ = 0; j_ < 4; ++j_) BF[j_][ks_] = *(const u32x4*)(bb_ + (size_t)j_ * 16 * 64 + ks_ * 32); } } while (0)
#define SD_CHUNK(c_, BF, XF, BFN, XFN) do { const int c = (c_); \
        if (c + 1 < 68) SD_FRAG_LOAD(BFN, XFN, c + 1); \
        const float dec = sDEC[c]; \
        {   bf16_t* ss = SSTb + (size_t)(chain * 68 + c) * 64 * 128; const int p = 16 * (w & 3) + r16; \
            _Pragma("unroll") for (int j = 0; j < 4; ++j) { const int n0 = 16 * ((w >> 2) * 4 + j) + q4 * 4; u32x2 pk; pk.x = pk2(acc[j][0], acc[j][1]); pk.y = pk2(acc[j][2], acc[j][3]); *(u32x2*)(ss + (size_t)p * 128 + n0) = pk; } } \
        bf16x8 xfr[2]; \
        _Pragma("unroll") for (int ks = 0; ks < 2; ++ks) { const float4 wa = *(const float4*)(sSC + c * 64 + ks * 32 + q4 * 8), wb = *(const float4*)(sSC + c * 64 + ks * 32 + q4 * 8 + 4); const u32x4 sv = scale8h(XF[ks], wa, wb); xfr[ks] = *(const bf16x8*)&sv; } \
        _Pragma("unroll") for (int j = 0; j < 4; ++j) acc[j] = acc[j] * dec; \
        _Pragma("unroll") for (int ks = 0; ks < 2; ++ks) _Pragma("unroll") for (int j = 0; j < 4; ++j) acc[j] = __builtin_amdgcn_mfma_f32_16x16x32_bf16(*(const bf16x8*)&BF[j][ks], xfr[ks], acc[j], 0, 0, 0); } while (0)
__device__ __forceinline__ void ssd_state_pass(const int chain, const bf16_t* __restrict__ Pm, const bf16_t* __restrict__ BTg, const bf16_t* __restrict__ XTg, const float Aa, const float dtb,
                                               bf16_t* __restrict__ SSTb, unsigned char* shm, const int tid) {
    const int dir = chain & 1, h = (chain >> 1) & 7, b = chain >> 4, grp = h >> 2, lane = tid & 63, w = tid >> 6, q4 = lane >> 4, r16 = lane & 15;
    float* sSC = (float*)shm; float* sDEC = sSC + 68 * 64;
    const int dcol = SSD_OFF + 1536 + dir * 8 + h;
    u32x4 bfA[4][2], xfA[2], bfB[4][2], xfB[2];
    SD_FRAG_LOAD(bfA, xfA, 0);
    __syncthreads();
    for (int c = w; c < 68; c += 8) { const float xv = bf2f(Pm[(size_t)step_tok(b, dir, c * 64 + lane) * LDP + dcol]) + dtb; const float dtv = xv > 20.f ? xv : log1pf(expf(xv));
        const float cs = wave_scan_incl(dtv * Aa, lane); const float cl = __shfl(cs, 63);
        sSC[c * 64 + (dir ? 63 - lane : lane)] = dtv * expf(cl - cs); if (lane == 0) sDEC[c] = expf(cl); }
    __syncthreads();
    f32x4 acc[4];
#pragma unroll
    for (int j = 0; j < 4; ++j) acc[j] = (f32x4){0.f, 0.f, 0.f, 0.f};
    for (int c2 = 0; c2 < 68; c2 += 2) { SD_CHUNK(c2, bfA, xfA, bfB, xfB); SD_CHUNK(c2 + 1, bfB, xfB, bfA, xfA); }
    __syncthreads();
}
#undef SD_CHUNK
#undef SD_FRAG_LOAD
__device__ __forceinline__ void ssd_out_item(const int chain, const int c, const bf16_t* __restrict__ Pm, const bf16_t* __restrict__ XBb, const bf16_t* __restrict__ XTg, const float Aa, const float dtb,
                                             const bf16_t* __restrict__ SSTb, float* __restrict__ Yout, unsigned char* shm, const int tid) {
    const int dir = chain & 1, h = (chain >> 1) & 7, b = chain >> 4, grp = h >> 2, lane = tid & 63, w = tid >> 6;
    bf16_t* Cs = (bf16_t*)shm; bf16_t* Bs = (bf16_t*)(shm + 17408); bf16_t* XT = (bf16_t*)(shm + 34816); bf16_t* Sin = (bf16_t*)(shm + 44032); bf16_t* Gs = (bf16_t*)(shm + 61440);
    float* sc = (float*)(shm + 70656);
    __syncthreads();
#pragma unroll
    for (int i = 0; i < 2; ++i) { const int pid = tid + i * 512; const int s = pid >> 4, x0 = (pid & 15) * 8; const size_t toks = (size_t)step_tok(b, dir, c * 64 + s);
        *(u32x4*)(Bs + s * 136 + x0) = *(const u32x4*)(XBb + toks * 1024 + 512 + grp * 128 + x0);
        *(u32x4*)(Cs + s * 136 + x0) = *(const u32x4*)(XBb + toks * 1024 + 768 + grp * 128 + x0);
        const int p = pid >> 4;
        *(u32x4*)(Sin + p * 136 + x0) = *(const u32x4*)(SSTb + ((size_t)(chain * 68 + c) * 64 + p) * 128 + x0); }
    {   const int p = tid >> 3, o = tid & 7;
        const u32x4 vv = *(const u32x4*)(XTg + ((size_t)tokblock_of(b, dir, c) * 512 + h * 64 + p) * 64 + (dir ? 7 - o : o) * 8);
        *(u32x4*)(XT + p * 72 + o * 8) = dir ? rev8h(vv) : vv; }
    if (w == 0) { const size_t tokl = (size_t)step_tok(b, dir, c * 64 + lane);
        const float xv = bf2f(Pm[tokl * LDP + SSD_OFF + 1536 + dir * 8 + h]) + dtb; const float dtv = xv > 20.f ? xv : log1pf(expf(xv));
        sc[lane] = wave_scan_incl(dtv * Aa, lane); sc[64 + lane] = dtv; }
    __syncthreads();
    {   const int lt = w >> 1;
        f32x4 aG[2] = {(f32x4){0.f, 0.f, 0.f, 0.f}, (f32x4){0.f, 0.f, 0.f, 0.f}};
#pragma unroll
        for (int ks = 0; ks < 4; ++ks) { const bf16x8 af = *(const bf16x8*)(Cs + (16 * lt + (lane & 15)) * 136 + ks * 32 + (lane >> 4) * 8);
#pragma unroll
            for (int i = 0; i < 2; ++i) { const int st = (w & 1) * 2 + i; const bf16x8 bfr = *(const bf16x8*)(Bs + (16 * st + (lane & 15)) * 136 + ks * 32 + (lane >> 4) * 8);
                aG[i] = __builtin_amdgcn_mfma_f32_16x16x32_bf16(af, bfr, aG[i], 0, 0, 0); } }
#pragma unroll
        for (int i = 0; i < 2; ++i) { const int s = 16 * ((w & 1) * 2 + i) + (lane & 15); const float css = sc[s], dts = sc[64 + s];
#pragma unroll
            for (int q = 0; q < 4; ++q) { const int t = 16 * lt + (lane >> 4) * 4 + q; const float val = (s <= t) ? aG[i][q] * expf(sc[t] - css) * dts : 0.f; Gs[t * 72 + s] = f2bf(val); } }
    }
    __syncthreads();
    {   const int lt = w >> 1;
        f32x4 aY[2] = {(f32x4){0.f, 0.f, 0.f, 0.f}, (f32x4){0.f, 0.f, 0.f, 0.f}};
#pragma unroll
        for (int ks = 0; ks < 4; ++ks) { const bf16x8 af = *(const bf16x8*)(Cs + (16 * lt + (lane & 15)) * 136 + ks * 32 + (lane >> 4) * 8);
#pragma unroll
            for (int i = 0; i < 2; ++i) { const int pt = (w & 1) * 2 + i; const bf16x8 bfr = *(const bf16x8*)(Sin + (16 * pt + (lane & 15)) * 136 + ks * 32 + (lane >> 4) * 8);
                aY[i] = __builtin_amdgcn_mfma_f32_16x16x32_bf16(af, bfr, aY[i], 0, 0, 0); } }
#pragma unroll
        for (int q = 0; q < 4; ++q) { const float ec = expf(sc[16 * lt + (lane >> 4) * 4 + q]); aY[0][q] *= ec; aY[1][q] *= ec; }
#pragma unroll
        for (int ks = 0; ks < 2; ++ks) { const bf16x8 af = *(const bf16x8*)(Gs + (16 * lt + (lane & 15)) * 72 + ks * 32 + (lane >> 4) * 8);
#pragma unroll
            for (int i = 0; i < 2; ++i) { const int pt = (w & 1) * 2 + i; const bf16x8 bfr = *(const bf16x8*)(XT + (16 * pt + (lane & 15)) * 72 + ks * 32 + (lane >> 4) * 8);
                aY[i] = __builtin_amdgcn_mfma_f32_16x16x32_bf16(af, bfr, aY[i], 0, 0, 0); } }
#pragma unroll
        for (int q = 0; q < 4; ++q) { const int t = 16 * lt + (lane >> 4) * 4 + q; const size_t tokt = (size_t)step_tok(b, dir, c * 64 + t);
#pragma unroll
            for (int i = 0; i < 2; ++i) { const int p = 16 * ((w & 1) * 2 + i) + (lane & 15); Yout[tokt * BW + h * 64 + p] = aY[i][q]; } }
    }
}


#define FIDX(i) ((i) + ((i) >> 4))
#define FFT_X_BYTES 69632
__device__ constexpr float FFT_CW_RE[6][16] = {{0.f, 0.f, 0.f, 0.f, 0.f, 0.f, 0.f, 0.f, 0.f, 0.f, 0.f, 0.f, 0.f, 0.f, 0.f, 0.f}, {1.0f, 0.f, 0.f, 0.f, 0.f, 0.f, 0.f, 0.f, 0.f, 0.f, 0.f, 0.f, 0.f, 0.f, 0.f, 0.f}, {1.0f, 6.123233995736766e-17f, 0.f, 0.f, 0.f, 0.f, 0.f, 0.f, 0.f, 0.f, 0.f, 0.f, 0.f, 0.f, 0.f, 0.f}, {1.0f, 0.7071067811865476f, 6.123233995736766e-17f, -0.7071067811865475f, 0.f, 0.f, 0.f, 0.f, 0.f, 0.f, 0.f, 0.f, 0.f, 0.f, 0.f, 0.f}, {1.0f, 0.9238795325112867f, 0.7071067811865476f, 0.38268343236508984f, 6.123233995736766e-17f, -0.3826834323650897f, -0.7071067811865475f, -0.9238795325112867f, 0.f, 0.f, 0.f, 0.f, 0.f, 0.f, 0.f, 0.f}, {1.0f, 0.9807852804032304f, 0.9238795325112867f, 0.8314696123025452f, 0.7071067811865476f, 0.5555702330196023f, 0.38268343236508984f, 0.19509032201612833f, 6.123233995736766e-17f, -0.1950903220161282f, -0.3826834323650897f, -0.555570233019602f, -0.7071067811865475f, -0.8314696123025453f, -0.9238795325112867f, -0.9807852804032304f}};
__device__ constexpr float FFT_CW_IM[6][16] = {{0.f, 0.f, 0.f, 0.f, 0.f, 0.f, 0.f, 0.f, 0.f, 0.f, 0.f, 0.f, 0.f, 0.f, 0.f, 0.f}, {-0.0f, 0.f, 0.f, 0.f, 0.f, 0.f, 0.f, 0.f, 0.f, 0.f, 0.f, 0.f, 0.f, 0.f, 0.f, 0.f}, {-0.0f, -1.0f, 0.f, 0.f, 0.f, 0.f, 0.f, 0.f, 0.f, 0.f, 0.f, 0.f, 0.f, 0.f, 0.f, 0.f}, {-0.0f, -0.7071067811865475f, -1.0f, -0.7071067811865476f, 0.f, 0.f, 0.f, 0.f, 0.f, 0.f, 0.f, 0.f, 0.f, 0.f, 0.f, 0.f}, {-0.0f, -0.3826834323650898f, -0.7071067811865475f, -0.9238795325112867f, -1.0f, -0.9238795325112867f, -0.7071067811865476f, -0.3826834323650899f, 0.f, 0.f, 0.f, 0.f, 0.f, 0.f, 0.f, 0.f}, {-0.0f, -0.19509032201612825f, -0.3826834323650898f, -0.5555702330196022f, -0.7071067811865475f, -0.8314696123025452f, -0.9238795325112867f, -0.9807852804032304f, -1.0f, -0.9807852804032304f, -0.9238795325112867f, -0.8314696123025455f, -0.7071067811865476f, -0.5555702330196022f, -0.3826834323650899f, -0.1950903220161286f}};
__host__ __device__ constexpr int fft_bitrev(int k, int R) { int r = 0; for (int i = 0; i < R; ++i) if (k & (1 << i)) r |= 1 << (R - 1 - i); return r; }
template <int R, bool INV>
__device__ __forceinline__ void fft_pass(float2* __restrict__ X, const float2* __restrict__ TW, const int s0, const int gidx) {
    const int lowbits = 13 - s0 - R; const int stride = 1 << lowbits;
    const int low = gidx & (stride - 1), high = gidx >> lowbits; const int base = (high << (lowbits + R)) | low;
    const int p0 = FIDX(base);
#define FFT_SLOT(k) (lowbits >= 4 ? p0 + (k) * (stride + (stride >> 4)) : p0 + (k) + ((k) >> 4))
    float2 v[1 << R];
#pragma unroll
    for (int k = 0; k < (1 << R); ++k) v[k] = X[FFT_SLOT(k)];
    const int lw = low << s0;
    if (!INV) {
#pragma unroll
        for (int j = 0; j < R; ++j) { const int hk = 1 << (R - 1 - j);
#pragma unroll
            for (int k = 0; k < (1 << R); ++k) if (!(k & hk)) { const int kk = k & (hk - 1);
                const float2 a = v[k], b = v[k + hk]; v[k] = make_float2(a.x + b.x, a.y + b.y); const float dx = a.x - b.x, dy = a.y - b.y;
                if (kk == 0) v[k + hk] = make_float2(dx, dy);
                else if (2 * kk == hk) v[k + hk] = make_float2(dy, -dx);
                else { const float cr = FFT_CW_RE[R - j][kk], ci = FFT_CW_IM[R - j][kk]; v[k + hk] = make_float2(dx * cr - dy * ci, dx * ci + dy * cr); } } }
        if (lowbits > 0) {
#pragma unroll
            for (int k = 1; k < (1 << R); ++k) { const float2 w = TW[(lw * fft_bitrev(k, R)) & 8191]; const float2 a = v[k]; v[k] = make_float2(a.x * w.x - a.y * w.y, a.x * w.y + a.y * w.x); } }
    } else {
        if (lowbits > 0) {
#pragma unroll
            for (int k = 1; k < (1 << R); ++k) { const float2 w = TW[(lw * fft_bitrev(k, R)) & 8191]; const float2 a = v[k]; v[k] = make_float2(a.x * w.x + a.y * w.y, a.y * w.x - a.x * w.y); } }
#pragma unroll
        for (int j = R - 1; j >= 0; --j) { const int hk = 1 << (R - 1 - j);
#pragma unroll
            for (int k = 0; k < (1 << R); ++k) if (!(k & hk)) { const int kk = k & (hk - 1);
                const float2 a = v[k], b = v[k + hk]; float tx, ty;
                if (kk == 0) { tx = b.x; ty = b.y; }
                else if (2 * kk == hk) { tx = -b.y; ty = b.x; }
                else { const float cr = FFT_CW_RE[R - j][kk], ci = FFT_CW_IM[R - j][kk]; tx = b.x * cr + b.y * ci; ty = b.y * cr - b.x * ci; }
                v[k] = make_float2(a.x + tx, a.y + ty); v[k + hk] = make_float2(a.x - tx, a.y - ty); } }
    }
#pragma unroll
    for (int k = 0; k < (1 << R); ++k) X[FFT_SLOT(k)] = v[k];
#undef FFT_SLOT
}
__device__ __forceinline__ void fft_fwd(float2* X, const float2* TW, const int tid) {
    fft_pass<4, false>(X, TW, 0, tid); __syncthreads(); fft_pass<4, false>(X, TW, 4, tid); __syncthreads(); if (tid < 256) fft_pass<5, false>(X, TW, 8, tid); __syncthreads(); }
__device__ __forceinline__ void fft_inv(float2* X, const float2* TW, const int tid) {
    if (tid < 256) fft_pass<5, true>(X, TW, 8, tid); __syncthreads(); fft_pass<4, true>(X, TW, 4, tid); __syncthreads(); fft_pass<4, true>(X, TW, 0, tid); __syncthreads(); }
__device__ __forceinline__ void fft_twiddles(float2* TW, const int tid) {
#pragma unroll
    for (int k = 0; k < 16; ++k) { const int m = tid + k * 512; const float xx = (float)m * (1.0f / 4096.0f); TW[m] = make_float2(cospif(xx), -sinpif(xx)); }
}
__device__ __forceinline__ void hyena_spec_item(const int oc, const float* __restrict__ HR, const float* __restrict__ nrm, float2* __restrict__ HSPEC, unsigned char* shm, const int tid) {
    float2* X = (float2*)shm; const float2* TW = (const float2*)(shm + FFT_X_BYTES);
    const int o = oc >> 9, c = oc & 511; const float inv = 1.0f / nrm[oc];
    __syncthreads();
#pragma unroll 2
    for (int k = 0; k < 16; ++k) { const int j = tid + k * 512; float v;
        if (j < SEQ) v = HR[(unsigned)j * 2048u + o * 1024 + c] * inv; else if (j == SEQ) v = 0.f; else v = HR[(unsigned)(2 * SEQ - j) * 2048u + o * 1024 + 512 + c] * inv;
        X[FIDX(j)] = make_float2(v, 0.f); }
    __syncthreads();
    fft_fwd(X, TW, tid);
    float4* out = (float4*)(HSPEC + (size_t)oc * 8192 + tid * 16); const float2* xs = X + 17 * tid;
#pragma unroll
    for (int k = 0; k < 8; ++k) { const float2 x0 = xs[2 * k], x1 = xs[2 * k + 1]; out[k] = make_float4(x0.x * (1.0f / 8192.0f), x0.y * (1.0f / 8192.0f), x1.x * (1.0f / 8192.0f), x1.y * (1.0f / 8192.0f)); }
}
__device__ __forceinline__ void fft_mul_spec(float2* X, const float2* __restrict__ H, const int tid) {
    const float4* h4 = (const float4*)(H + tid * 16); float2* xs = X + 17 * tid;
#pragma unroll
    for (int k = 0; k < 8; ++k) { const float4 hv = h4[k]; const float2 x0 = xs[2 * k], x1 = xs[2 * k + 1];
        xs[2 * k] = make_float2(x0.x * hv.x - x0.y * hv.y, x0.x * hv.y + x0.y * hv.x); xs[2 * k + 1] = make_float2(x1.x * hv.z - x1.y * hv.w, x1.x * hv.w + x1.y * hv.z); }
}
__device__ __forceinline__ void hyena_fft_item(const int item, const float* __restrict__ UT, const float2* __restrict__ HSPEC, const float* __restrict__ bias, float* __restrict__ YT, unsigned char* shm, const int tid) {
    float2* X = (float2*)shm; const float2* TW = (const float2*)(shm + FFT_X_BYTES);
    const int c = item >> 1, b0 = (item & 1) * 2, b1 = b0 + 1;
    const float* u0 = UT + (size_t)(b0 * 1536 + c) * SEQ + tid * 8; const float* u1 = UT + (size_t)(b1 * 1536 + c) * SEQ + tid * 8;
    const float bias0 = bias[c], bias1 = bias[512 + c];
    float2* xs = X + FIDX(8 * tid);
    float vr[8], vi[8];
    __syncthreads();
    { const float4 a0 = *(const float4*)u0, a1 = *(const float4*)(u0 + 4), c0 = *(const float4*)u1, c1 = *(const float4*)(u1 + 4);
      vr[0] = a0.x; vr[1] = a0.y; vr[2] = a0.z; vr[3] = a0.w; vr[4] = a1.x; vr[5] = a1.y; vr[6] = a1.z; vr[7] = a1.w;
      vi[0] = c0.x; vi[1] = c0.y; vi[2] = c0.z; vi[3] = c0.w; vi[4] = c1.x; vi[5] = c1.y; vi[6] = c1.z; vi[7] = c1.w; }
#pragma unroll
    for (int k = 0; k < 8; ++k) { xs[k] = make_float2(vr[k], vi[k]); xs[4352 + k] = make_float2(0.f, 0.f); }
    __syncthreads();
    fft_fwd(X, TW, tid);
    fft_mul_spec(X, HSPEC + (size_t)c * 8192, tid);
    __syncthreads();
    fft_inv(X, TW, tid);
    { const float* p0 = u0 + (size_t)512 * SEQ; const float* p1 = u1 + (size_t)512 * SEQ;
      const float4 a0 = *(const float4*)p0, a1 = *(const float4*)(p0 + 4), c0 = *(const float4*)p1, c1 = *(const float4*)(p1 + 4);
      const float xr[8] = {a0.x, a0.y, a0.z, a0.w, a1.x, a1.y, a1.z, a1.w}, xi[8] = {c0.x, c0.y, c0.z, c0.w, c1.x, c1.y, c1.z, c1.w};
#pragma unroll
      for (int k = 0; k < 8; ++k) { const float2 cv = xs[k]; const float zr = xr[k] * (cv.x + bias0 * vr[k]), zi = xi[k] * (cv.y + bias0 * vi[k]);
          vr[k] = zr; vi[k] = zi; xs[k] = make_float2(zr, zi); xs[4352 + k] = make_float2(0.f, 0.f); } }
    __syncthreads();
    fft_fwd(X, TW, tid);
    fft_mul_spec(X, HSPEC + (size_t)(512 + c) * 8192, tid);
    __syncthreads();
    fft_inv(X, TW, tid);
    { const float* p0 = u0 + (size_t)1024 * SEQ; const float* p1 = u1 + (size_t)1024 * SEQ;
      const float4 a0 = *(const float4*)p0, a1 = *(const float4*)(p0 + 4), c0 = *(const float4*)p1, c1 = *(const float4*)(p1 + 4);
      const float xr[8] = {a0.x, a0.y, a0.z, a0.w, a1.x, a1.y, a1.z, a1.w}, xi[8] = {c0.x, c0.y, c0.z, c0.w, c1.x, c1.y, c1.z, c1.w};
      float yr[8], yi[8];
#pragma unroll
      for (int k = 0; k < 8; ++k) { const float2 cv = xs[k]; yr[k] = xr[k] * (cv.x + bias1 * vr[k]); yi[k] = xi[k] * (cv.y + bias1 * vi[k]); }
      float* y0 = YT + (size_t)(b0 * 512 + c) * SEQ + tid * 8; float* y1 = YT + (size_t)(b1 * 512 + c) * SEQ + tid * 8;
      *(float4*)y0 = make_float4(yr[0], yr[1], yr[2], yr[3]); *(float4*)(y0 + 4) = make_float4(yr[4], yr[5], yr[6], yr[7]);
      *(float4*)y1 = make_float4(yi[0], yi[1], yi[2], yi[3]); *(float4*)(y1 + 4) = make_float4(yi[4], yi[5], yi[6], yi[7]); }
}

constexpr size_t al256(size_t x) { return (x + 255) & ~(size_t)255; }
constexpr size_t O_BAR = 0;
constexpr size_t O_MOD = 16384;
constexpr size_t O_NORM = O_MOD + al256((size_t)2 * 5 * 6 * DM * 4);
constexpr size_t O_QCTR = O_NORM + al256((size_t)2 * 2 * 1024 * 4);
constexpr size_t O_ZERO_END = O_QCTR + 512;
constexpr size_t O_XS = O_ZERO_END;
constexpr size_t O_HB = O_XS + al256((size_t)NTOK * DM * 4);
constexpr size_t O_P = O_HB + al256((size_t)NTOK * DM * 2);
constexpr size_t O_WIN = O_P + al256((size_t)NTOK * LDP * 2);
constexpr size_t O_WBR = O_WIN + al256((size_t)LDP * DM * 2);
constexpr size_t O_WOUT = O_WBR + al256((size_t)4 * DM * BW * 2);
constexpr size_t O_WGU = O_WOUT + al256((size_t)DM * DM * 2);
constexpr size_t O_WD = O_WGU + al256((size_t)NEXP * 2 * DEXP * DM * 2);
constexpr size_t O_GLU = O_WD + al256((size_t)NEXP * DM * DEXP * 2);
constexpr size_t O_Y4 = O_GLU + al256((size_t)BW * BW * 2);
constexpr size_t O_U = O_Y4 + al256((size_t)NTOK * DM * 2);
constexpr size_t O_QKB = O_U + al256((size_t)NTOK * 1536 * 4);
constexpr size_t O_CST = O_QKB + al256((size_t)NTOK * 1024 * 2);
constexpr size_t O_NST = O_CST + al256((size_t)32 * 68 * 128 * 128 * 2);
constexpr size_t O_MST = O_NST + al256((size_t)32 * 68 * 128 * 4);
constexpr size_t O_XBC = O_MST + al256((size_t)32 * 68 * 4);
constexpr size_t O_SST = O_XBC + al256((size_t)NTOK * 1024 * 2);
constexpr size_t O_HF = O_SST + al256((size_t)64 * 68 * 64 * 128 * 2);
constexpr size_t O_YF = O_HF + al256((size_t)2 * NTOK * BW * 4);
constexpr size_t O_SF = O_YF + al256((size_t)2 * NTOK * BW * 4);
constexpr size_t O_LDT = O_SF + al256((size_t)2 * NCTX * BW * 4);
constexpr size_t O_AP = O_LDT + al256((size_t)4096 * 16);
constexpr size_t O_BBT = O_AP + al256((size_t)4096 * 33 * 8);
constexpr size_t O_KT = O_BBT + al256((size_t)4096 * 16 * 8);
constexpr size_t O_S5A = O_KT + al256((size_t)32 * 2 * 32 * 256 * 4);
constexpr size_t O_S5B = O_S5A + al256((size_t)32 * 512 * 768 * 2);
constexpr size_t O_XCTX = O_S5B + al256((size_t)32 * 512 * 768 * 2);
constexpr size_t O_Z = O_XCTX + al256((size_t)4 * 32 * 2 * 64 * 8);
constexpr size_t O_HRAW = O_Z + al256((size_t)NTOK * BW * 4);
constexpr size_t O_HSPEC = O_HRAW + al256((size_t)(SEQ + CTXL) * 2048 * 4);
constexpr size_t O_K2C = O_HSPEC + al256((size_t)1024 * 8192 * 8);
constexpr size_t O_GG = O_K2C + al256((size_t)(2 * CTXL) * 1024 * 4);
constexpr size_t O_PROBS = O_GG + al256((size_t)NTOK * BW * 2);
constexpr size_t O_ROWTOK = O_PROBS + al256((size_t)NTOK * 16 * 4);
constexpr size_t O_ROWGATE = O_ROWTOK + al256((size_t)NEXP * MOE_PAD * 4);
constexpr size_t O_INV = O_ROWGATE + al256((size_t)NEXP * MOE_PAD * 4);
constexpr size_t O_NORMP = O_INV + al256((size_t)NTOK * 16 * 4);
constexpr size_t WS_END = O_NORMP + al256((size_t)4 * 256 * 2048 * 4);
constexpr size_t O_XG = O_P;
constexpr size_t O_HID = O_P + al256((size_t)NEXP * MOE_PAD * DM * 2);
constexpr size_t O_YEXP = O_HID + al256((size_t)NEXP * MOE_PAD * DEXP * 2);
static_assert(O_YEXP + (size_t)NEXP * MOE_PAD * DM * 2 <= O_WIN, "MoE temporaries must fit inside P");
static_assert((size_t)NTOK * DM * 2 <= (size_t)NTOK * 1536 * 4, "ACCb must fit inside U");
static_assert((size_t)26214400 + (size_t)2 * 17825792 + (size_t)272 * 256 * 64 * 2 <= (size_t)NTOK * DM * 2, "strip buffers must fit inside HB");
static_assert(WS_END <= (size_t)1851000000, "workspace map exceeds the guaranteed size");

struct Args {
    const float* in[47];
    float* out; unsigned char* ws;
    int ph_lo, ph_hi;
};

__device__ __forceinline__ void conv_tile(const float* __restrict__ src, int ldsrc, int nvalid, int k0, int n0, bf16_t* __restrict__ dst, int lddst, int mode, float* T, int tid) {
    { const int n = tid & 63, kr = tid >> 6;
#pragma unroll
      for (int i = 0; i < 8; ++i) { const int k = i * 8 + kr; T[k * 65 + n] = (n0 + n < nvalid) ? src[(size_t)(k0 + k) * ldsrc + n0 + n] : 0.f; } }
    __syncthreads();
    { const int n = tid >> 3, kc = (tid & 7) * 8; const int gn = n0 + n;
      const int drow = mode == 0 ? gn : (32 * (gn >> 4) + (mode == 2 ? 16 : 0) + (gn & 15));
      u32x4 w; w.x = pk2(T[(kc + 0) * 65 + n], T[(kc + 1) * 65 + n]); w.y = pk2(T[(kc + 2) * 65 + n], T[(kc + 3) * 65 + n]);
      w.z = pk2(T[(kc + 4) * 65 + n], T[(kc + 5) * 65 + n]); w.w = pk2(T[(kc + 6) * 65 + n], T[(kc + 7) * 65 + n]);
      *(u32x4*)(dst + (size_t)drow * lddst + k0 + kc) = w; }
    __syncthreads();
}

#define IN(id) (lo <= (id) && (id) < hi)
#define SEAM(id) do { if (hi > (id) + 1) xcd_barrier(bar); } while (0)
#define PH_BEGIN int tid = threadIdx.x; asm volatile("" : "+v"(tid) :: "memory"); const int lane = tid & 63, wave = tid >> 6; (void)lane; (void)wave;

#define x_in (PT(0))
#define c_in (PT(1))
#define ctx_in (PT(2))
#define cctx_in (PT(3))
#define ada_w (PT(4))
#define ada_b (PT(5))
#define norm_mix (PT(6))
#define norm_ffn (PT(7))
#define w_in (PT(8))
#define XS ((float*)(a.ws + O_XS))
#define MOD ((float*)(a.ws + O_MOD))
#define NORM ((float*)(a.ws + O_NORM))
#define NORMP ((float*)(a.ws + O_NORMP))
#define MODl (MOD + (size_t)l * 5 * 6 * DM)
#define HB ((bf16_t*)(a.ws + O_HB))
#define P ((bf16_t*)(a.ws + O_P))
#define WIN ((bf16_t*)(a.ws + O_WIN))
#define WBR ((bf16_t*)(a.ws + O_WBR))
#define WOUT ((bf16_t*)(a.ws + O_WOUT))
#define WGU ((bf16_t*)(a.ws + O_WGU))
#define WD ((bf16_t*)(a.ws + O_WD))
#define GLU ((bf16_t*)(a.ws + O_GLU))
#define Y4 ((bf16_t*)(a.ws + O_Y4))
#define U ((float*)(a.ws + O_U))
#define ACCb ((bf16_t*)(a.ws + O_U))
#define QKB ((bf16_t*)(a.ws + O_QKB))
#define CST ((bf16_t*)(a.ws + O_CST))
#define NST ((float*)(a.ws + O_NST))
#define MST ((float*)(a.ws + O_MST))
#define XBC ((bf16_t*)(a.ws + O_XBC))
#define SSTB ((bf16_t*)(a.ws + O_SST))
#define HF ((float*)(a.ws + O_HF))
#define HBk (HF + (size_t)NTOK * BW)
#define YF ((float*)(a.ws + O_YF))
#define YB (YF + (size_t)NTOK * BW)
#define SF ((float*)(a.ws + O_SF))
#define SB (SF + (size_t)NCTX * BW)
#define LDT ((double2*)(a.ws + O_LDT))
#define APW ((float2*)(a.ws + O_AP))
#define BBT ((float2*)(a.ws + O_BBT))
#define KTB ((float*)(a.ws + O_KT))
#define S5A ((bf16_t*)(a.ws + O_S5A))
#define S5B ((bf16_t*)(a.ws + O_S5B))
#define XCTX ((float2*)(a.ws + O_XCTX))
#define S5P ((bf16_t*)(a.ws + O_HB))
#define XLOC ((float*)(a.ws + O_HB + (size_t)32 * 256 * 512 * 2))
#define KTG ((bf16_t*)(a.ws + O_HB + (size_t)26214400))
#define VTG ((bf16_t*)(a.ws + O_HB + (size_t)26214400 + (size_t)17825792))
#define BTG ((bf16_t*)(a.ws + O_HB + (size_t)26214400 + (size_t)2 * 17825792))
#define XTG ((bf16_t*)(a.ws + O_GG))
#define Z ((float*)(a.ws + O_Z))
#define HRAW ((float*)(a.ws + O_HRAW))
#define HSPEC ((float2*)(a.ws + O_HSPEC))
#define UT ((float*)(a.ws + O_U))
#define YT ((float*)(a.ws + O_Z))
#define QCTR ((int*)(a.ws + O_QCTR))
#define K2C ((float*)(a.ws + O_K2C))
#define GG ((bf16_t*)(a.ws + O_GG))
#define PROBS ((float*)(a.ws + O_PROBS))
#define ROWTOK ((int*)(a.ws + O_ROWTOK))
#define ROWGATE ((float*)(a.ws + O_ROWGATE))
#define XG ((bf16_t*)(a.ws + O_XG))
#define HID ((bf16_t*)(a.ws + O_HID))
#define YEXP ((bf16_t*)(a.ws + O_YEXP))
#define INV ((int*)(a.ws + O_INV))


__device__ __forceinline__ void moe_combine(float4 (&v)[8], const int tok, const int lane, const int* __restrict__ inv, const float* __restrict__ rowgate, const bf16_t* __restrict__ yexp, const float* __restrict__ m5) {
    float4 a[8];
#pragma unroll
    for (int i = 0; i < 8; ++i) a[i] = make_float4(0.f, 0.f, 0.f, 0.f);
    for (int e = 0; e < 16; ++e) { const int row = __builtin_amdgcn_readfirstlane(inv[tok * 16 + e]);
        if (row >= 0) { const float gt = rowgate[row]; const bf16_t* yr = yexp + (size_t)row * DM + lane * 4;
#pragma unroll
            for (int i = 0; i < 8; ++i) { const u32x2 w = *(const u32x2*)(yr + i * 256);
                a[i].x += gt * __uint_as_float(w.x << 16); a[i].y += gt * __uint_as_float(w.x & 0xFFFF0000u); a[i].z += gt * __uint_as_float(w.y << 16); a[i].w += gt * __uint_as_float(w.y & 0xFFFF0000u); } } }
#pragma unroll
    for (int i = 0; i < 8; ++i) { const float4 mm = *(const float4*)(m5 + i * 256 + lane * 4); v[i].x += mm.x * a[i].x; v[i].y += mm.y * a[i].y; v[i].z += mm.z * a[i].z; v[i].w += mm.w * a[i].w; }
}
struct CvU { const float* src; bf16_t* dst; int ldsrc, nvalid, k0, n0, lddst, mode; };
__device__ __forceinline__ void cv_load(const CvU& u, float4 (&r)[8], const int tid) {
#pragma unroll
    for (int i = 0; i < 8; ++i) { const int idx = tid + i * 512; const int k = idx >> 6, n = u.n0 + (idx & 63) * 4;
        r[i] = (n < u.nvalid) ? *(const float4*)(u.src + (size_t)(u.k0 + k) * u.ldsrc + n) : make_float4(0.f, 0.f, 0.f, 0.f); }
}
__device__ __forceinline__ void cv_stage(float* T, const float4 (&r)[8], const int tid) {
#pragma unroll
    for (int i = 0; i < 8; ++i) { const int idx = tid + i * 512; float* p = T + (idx >> 6) * 257 + (idx & 63) * 4; p[0] = r[i].x; p[1] = r[i].y; p[2] = r[i].z; p[3] = r[i].w; }
}
__device__ __forceinline__ void cv_store(const CvU& u, const float* T, const int tid) {
#pragma unroll
    for (int j = 0; j < 4; ++j) { const int o = tid + j * 512; const int kc = (o & 7) * 8, n = o >> 3; const int gn = u.n0 + n;
        const int drow = u.mode == 0 ? gn : (256 * (gn >> 7) + (u.mode == 2 ? 128 : 0) + (gn & 127));
        const float* t = T + kc * 257 + n;
        u32x4 w; w.x = pk2(t[0], t[257]); w.y = pk2(t[2 * 257], t[3 * 257]); w.z = pk2(t[4 * 257], t[5 * 257]); w.w = pk2(t[6 * 257], t[7 * 257]);
        *(u32x4*)(u.dst + (size_t)drow * u.lddst + u.k0 + kc) = w; }
}
template <int LAYER>
__device__ __forceinline__ void layer_body(const Args& a, const XcdBarrier& bar, const int lo, const int hi, const int bid, const int G, unsigned char* const shm, float* const sf, const float** const ptab) {
        constexpr int l = LAYER;
        constexpr int PB = 1 + 16 * l;
        const bool lastl = (l == 1);

        const int nPanels = lastl ? 64 : 68;
        const int M2 = nPanels * 256;

        if (IN(PB + 0)) for (int rep_ = 0; rep_ < (l == 0 ? PROBE_REPS(0) : 1); ++rep_) {
            PH_BEGIN
            {   const float* wbr = PT(40) + (size_t)l * 4 * BW * DM; const float* wout = PT(41) + (size_t)l * DM * DM;
                const float* wg = PT(43) + (size_t)l * NEXP * DM * DEXP; const float* wu = PT(44) + (size_t)l * NEXP * DM * DEXP; const float* wd = PT(45) + (size_t)l * NEXP * DEXP * DM;
                const float* wglu = PT(32) + (size_t)l * BW * BW; const float* win = w_in + (size_t)l * DM * IN_W;
                const int n_win = 32 * 55, n_br = 4 * 64, n_out = 32 * 8, n_gu = 16 * 2 * 192, n_d = 16 * 192, n_glu = 16;
                const int total = n_win + n_br + n_out + n_gu + n_d + n_glu;
#define CV_DECODE(q_, u_) do { int qq_ = (q_); \
                    if (qq_ < n_win) { u_ = CvU{win, WIN, IN_W, IN_W, (qq_ / 55) * 64, (qq_ % 55) * 256, DM, 0}; } else { qq_ -= n_win; \
                    if (qq_ < n_br) { const int k = qq_ >> 6, r = qq_ & 63; u_ = CvU{wbr + (size_t)k * BW * DM, WBR + (size_t)k * DM * BW, DM, DM, (r >> 3) * 64, (r & 7) * 256, BW, 0}; } else { qq_ -= n_br; \
                    if (qq_ < n_out) { u_ = CvU{wout, WOUT, DM, DM, (qq_ >> 3) * 64, (qq_ & 7) * 256, DM, 0}; } else { qq_ -= n_out; \
                    if (qq_ < n_gu) { const int e = qq_ / 384, r = qq_ % 384, up = r / 192, r2 = r % 192; u_ = CvU{(up ? wu : wg) + (size_t)e * DM * DEXP, WGU + (size_t)e * 2 * DEXP * DM, DEXP, DEXP, (r2 / 6) * 64, (r2 % 6) * 256, DM, 1 + up}; } else { qq_ -= n_gu; \
                    if (qq_ < n_d) { const int e = qq_ / 192, r = qq_ % 192; u_ = CvU{wd + (size_t)e * DEXP * DM, WD + (size_t)e * DM * DEXP, DM, DM, (r >> 3) * 64, (r & 7) * 256, DEXP, 0}; } else { qq_ -= n_d; \
                    u_ = CvU{wglu, GLU, BW, BW, (qq_ >> 1) * 64, (qq_ & 1) * 256, BW, 0}; } } } } } } while (0)
                __syncthreads();
                int q = bid; int buf = 0; CvU u; float4 r[8];
                if (q < total) { CV_DECODE(q, u); cv_load(u, r, tid); }
                while (q < total) {
                    float* T = sf + buf * (64 * 257);
                    cv_stage(T, r, tid);
                    __syncthreads();
                    const CvU cur = u; const int qn = q + G;
                    if (qn < total) { CV_DECODE(qn, u); cv_load(u, r, tid); }
                    cv_store(cur, T, tid);
                    buf ^= 1; q = qn;
                }
#undef CV_DECODE
                __syncthreads();
            }
            for (int set = 0; set < (lastl ? 1 : 2); ++set) {
                const int L = set ? CTXL : SEQ; float* HR = HRAW + (set ? (size_t)SEQ * 2048 : 0);
                const float* w1 = PT(11) + l * 33 * 64; const float* b1 = PT(12) + l * 64; const float* fr1 = PT(13) + l * 64; const float* w2 = PT(14) + l * 64 * 64; const float* b2 = PT(15) + l * 64;
                const float* fr2 = PT(16) + l * 64; const float* w3 = PT(17) + l * 64 * 2048; const float* decay = PT(18) + l * 2048;
                float* feats = sf; float* h1 = sf + 16 * 33; float* h2 = h1 + 16 * 64;
                float nacc[4] = {0.f, 0.f, 0.f, 0.f};
                for (int base = bid; base < L; base += 16 * G) {
                    __syncthreads();
                    for (int e = tid; e < 16 * 33; e += NTHR) { const int ti = e / 33, fi = e % 33; int t = base + ti * G; if (t > L - 1) t = L - 1;
                        float v;
                        if (fi == 0) v = (float)t / (float)(L - 1);
                        else { const int j = (fi - 1) & 15; const double fr = 1e-4 + (double)j * ((15.0 - 1e-4) / 15.0); const double ang = (2.0 * 3.14159265358979323846 / (double)L) * (double)t * fr; v = fi <= 16 ? (float)cos(ang) : (float)(-sin(ang)); }
                        feats[e] = v; }
                    __syncthreads();
                    { const int j = tid & 63, ti = tid >> 6; float s0 = b1[j], s1 = s0;
_Pragma("unroll 3")
                      for (int i = 0; i < 33; ++i) { const float wv = w1[i * 64 + j]; s0 += feats[ti * 33 + i] * wv; s1 += feats[(ti + 8) * 33 + i] * wv; }
                      const float f1 = fr1[j]; h1[ti * 64 + j] = sinf(f1 * s0); h1[(ti + 8) * 64 + j] = sinf(f1 * s1); }
                    __syncthreads();
                    { const int j = tid & 63, ti = tid >> 6; float s0 = b2[j], s1 = s0;
_Pragma("unroll 4")
                      for (int i = 0; i < 64; ++i) { const float wv = w2[i * 64 + j]; s0 += h1[ti * 64 + i] * wv; s1 += h1[(ti + 8) * 64 + i] * wv; }
                      const float f2 = fr2[j]; h2[ti * 64 + j] = sinf(f2 * s0); h2[(ti + 8) * 64 + j] = sinf(f2 * s1); }
                    __syncthreads();
                    float acc[16][4];
#pragma unroll
                    for (int ti = 0; ti < 16; ++ti) { acc[ti][0] = 0.f; acc[ti][1] = 0.f; acc[ti][2] = 0.f; acc[ti][3] = 0.f; }
#pragma unroll 2
                    for (int i = 0; i < 64; ++i) { const float* wrow = w3 + (size_t)i * 2048 + tid; const float wa = wrow[0], wb = wrow[512], wc2 = wrow[1024], wd2 = wrow[1536];
#pragma unroll
                        for (int ti = 0; ti < 16; ++ti) { const float hv = h2[ti * 64 + i]; acc[ti][0] += hv * wa; acc[ti][1] += hv * wb; acc[ti][2] += hv * wc2; acc[ti][3] += hv * wd2; } }
                    float dk[4];
#pragma unroll
                    for (int k = 0; k < 4; ++k) dk[k] = fabsf(decay[tid + k * 512]);
#pragma unroll
                    for (int ti = 0; ti < 16; ++ti) { const int t = base + ti * G; if (t < L) { const float tn = (float)t / (float)(L - 1);
#pragma unroll
                        for (int k = 0; k < 4; ++k) { const float v = acc[ti][k] * expf(-tn * dk[k]); HR[(size_t)t * 2048 + tid + k * 512] = v; nacc[k] += fabsf(v); } } }
                }
                float* nrp = NORMP + ((size_t)(l * 2 + set) * 256 + bid) * 2048;
#pragma unroll
                for (int k = 0; k < 4; ++k) nrp[tid + k * 512] = nacc[k];
            }
            for (int idx = bid * NTHR + tid; idx < 4096; idx += G * NTHR) { const int n = idx & 63, g = (idx >> 6) & 31, dir = idx >> 11;
                const double are = (double)(PT(24) + l * 4096)[idx], aim = (double)(PT(25) + l * 4096)[idx]; const double lam = are < -1e-4 ? are : -1e-4; const double dt = exp((double)(PT(26) + l * 64)[dir * 32 + g]);
                const double ldre = lam * dt, ldim = aim * dt; LDT[idx] = make_double2(ldre, ldim);
                const double mag = exp(ldre); const double ar = mag * cos(ldim), ai = mag * sin(ldim);
                const double den = lam * lam + aim * aim; const double nr = ar - 1.0, ni = ai; const double fre = (nr * lam + ni * aim) / den, fim = (ni * lam - nr * aim) / den;
                const float* b_re = PT(27) + l * 32 * 64 * 16; const float* b_im = PT(28) + l * 32 * 64 * 16;
#pragma unroll 4
                for (int c = 0; c < 16; ++c) { const double br = (double)b_re[(g * 64 + n) * 16 + c], bi = (double)b_im[(g * 64 + n) * 16 + c]; BBT[idx * 16 + c] = make_float2((float)(fre * br - fim * bi), (float)(fre * bi + fim * br)); }
            }
            for (int e2 = bid * NTHR + tid; e2 < 4096 * 33; e2 += G * NTHR) { const int idx = e2 / 33, k = e2 - idx * 33; const int g = (idx >> 6) & 31, dir = idx >> 11;
                const double are = (double)(PT(24) + l * 4096)[idx], aim = (double)(PT(25) + l * 4096)[idx]; const double lam = are < -1e-4 ? are : -1e-4; const double dt = exp((double)(PT(26) + l * 64)[dir * 32 + g]);
                const double ldre = lam * dt, ldim = aim * dt; const double mk = exp(ldre * k); APW[e2] = make_float2((float)(mk * cos(ldim * k)), (float)(mk * sin(ldim * k))); }
            if (l == 0 && lo == 0) xcd_barrier(bar);
            for (int tok = bid * 8 + wave; tok < NTOK; tok += G * 8) {
                const int r = tok < NLAT ? tok / SEQ : 4; const float* xr = l == 0 ? (tok < NLAT ? x_in + (size_t)tok * DM : ctx_in + (size_t)(tok - NLAT) * DM) : XS + (size_t)tok * DM; const float* gn = norm_mix + l * DM;
                const float* sh = MODl + (size_t)(r * 6 + 0) * DM; const float* sc = MODl + (size_t)(r * 6 + 1) * DM;
                float4 v[8]; float ss = 0.f;
#pragma unroll
                for (int i = 0; i < 8; ++i) v[i] = *(const float4*)(xr + i * 256 + lane * 4);
                if (l > 0) {
                    moe_combine(v, tok, lane, INV, ROWGATE, YEXP, MOD + (size_t)((l - 1) * 5 + r) * 6 * DM + 5 * DM);
#pragma unroll
                    for (int i = 0; i < 8; ++i) *(float4*)(XS + (size_t)tok * DM + i * 256 + lane * 4) = v[i]; }
#pragma unroll
                for (int i = 0; i < 8; ++i) ss += v[i].x * v[i].x + v[i].y * v[i].y + v[i].z * v[i].z + v[i].w * v[i].w;
                ss = wave_sum(ss); const float rs = rsqrtf(ss * (1.0f / DM) + 1e-6f);
#pragma unroll
                for (int i = 0; i < 8; ++i) { const int d = i * 256 + lane * 4; const float4 g4 = *(const float4*)(gn + d), s4 = *(const float4*)(sc + d), h4 = *(const float4*)(sh + d);
                    u32x2 w; w.x = pk2(v[i].x * rs * g4.x * (1.f + s4.x) + h4.x, v[i].y * rs * g4.y * (1.f + s4.y) + h4.y); w.y = pk2(v[i].z * rs * g4.z * (1.f + s4.z) + h4.z, v[i].w * rs * g4.w * (1.f + s4.w) + h4.w);
                    *(u32x2*)(HB + (size_t)tok * DM + d) = w; }
            }
            SEAM(PB + 0);
        }

        if (IN(PB + 1)) for (int rep_ = 0; rep_ < PROBE_REPS(1); ++rep_) {
            PH_BEGIN
            for (int idx = bid * NTHR + tid; idx < (lastl ? 1 : 2) * 1024; idx += G * NTHR) { const int set = idx >> 10, oc = idx & 1023, o = oc >> 9, c = oc & 511;
                const float* pp = NORMP + (size_t)(l * 2 + set) * 256 * 2048 + o * 1024 + c; float sacc = 0.f;
                for (int bb = 0; bb < G; ++bb) sacc += pp[(size_t)bb * 2048] + pp[(size_t)bb * 2048 + 512];
                NORM[(size_t)(l * 2 + set) * 1024 + oc] = sacc; }
            for (int idx = bid * NTHR + tid; idx < 32768; idx += G * NTHR) { const int c = idx & 15, lag = (idx >> 4) & 31, dir = (idx >> 9) & 1, g = idx >> 10;
                const float* c_re = PT(29) + l * 32 * 16 * 64 + (g * 16 + c) * 64; const float* c_im = PT(30) + l * 32 * 16 * 64 + (g * 16 + c) * 64;
                float acc[16];
#pragma unroll
                for (int j = 0; j < 16; ++j) acc[j] = 0.f;
#pragma unroll 2
                for (int n = 0; n < 64; ++n) { const int pi = (dir * 32 + g) * 64 + n; const float2 ap = APW[pi * 33 + lag]; const float cr = c_re[n], ci = c_im[n]; const float wr_ = cr * ap.x - ci * ap.y, wi_ = cr * ap.y + ci * ap.x;
                    const float4* bb = (const float4*)(BBT + pi * 16);
#pragma unroll
                    for (int j = 0; j < 8; ++j) { const float4 b2 = bb[j]; acc[2 * j] += wr_ * b2.x - wi_ * b2.y; acc[2 * j + 1] += wr_ * b2.z - wi_ * b2.w; } }
                float4* o = (float4*)(KTB + (size_t)idx * 16);
                o[0] = make_float4(acc[0], acc[1], acc[2], acc[3]); o[1] = make_float4(acc[4], acc[5], acc[6], acc[7]); o[2] = make_float4(acc[8], acc[9], acc[10], acc[11]); o[3] = make_float4(acc[12], acc[13], acc[14], acc[15]);
            }
            __syncthreads();
            pg8::Gemm g{HB, WIN, DM, DM, DM}; pg8::SchedStd S{68, 55, G, bid, DM, DM}; pg8::EpiWin E{P, LDP};
            pg8::gemm_phase(( LAS unsigned char*)shm, g, S, E);
#if defined(PROBE_BNOEPI)
            { __syncthreads(); pg8::EpiNone E0; pg8::gemm_phase((LAS unsigned char*)shm, g, S, E0); }
#endif
            SEAM(PB + 1);
        }

        if (IN(PB + 2)) for (int rep_ = 0; rep_ < PROBE_REPS(2); ++rep_) {
            PH_BEGIN
            const float* hcw = PT(9) + l * 3 * 1536; const float* hcb = PT(10) + l * 1536; const float* mcw = PT(20) + l * 3 * 1024; const float* mcb = PT(21) + l * 1024;
            const float* scw = PT(34) + l * 3 * 1024; const float* scb = PT(35) + l * 1024;
            for (int unit = bid; unit < 272 * 3; unit += G) { const int seg = unit / 3, kind = unit % 3; const bool lat = seg < 256; const size_t tok0 = lat ? (size_t)seg * 64 : (size_t)NLAT + (size_t)(seg - 256) * 64;
                if (kind < 2) { const int hf = kind;
                    const int c = tid * 2; const int col = (hf ? SSD_OFF + 512 : ML_OFF) + c; const float* w = hf ? scw : mcw; const float* bsp = hf ? scb : mcb; bf16_t* dst = (hf ? XBC : QKB) + tok0 * 1024 + c;
                    const float2 w0 = *(const float2*)(w + c), w1 = *(const float2*)(w + 1024 + c), w2 = *(const float2*)(w + 2048 + c), bb = *(const float2*)(bsp + c);
                    const float osc = (!hf && c >= 512) ? 0.08838834764831845f : 1.0f;
                    const bool hasPrev = !lat && ((tok0 - NLAT) & (CTXL - 1)) != 0, hasNext = !lat && (((tok0 - NLAT) + 63) & (CTXL - 1)) != CTXL - 1;
                    bf16_t* strip = nullptr;
                    if (!hf) { if (c >= 512) strip = KTG + ((size_t)seg * 512 + (c - 512)) * 64; }
                    else { if (c < 512) strip = XTG + ((size_t)seg * 512 + c) * 64; else if (c < 768) strip = BTG + ((size_t)seg * 256 + (c - 512)) * 64; }
                    const bf16_t* pp = P + tok0 * LDP + col;
                    unsigned raw[66];
#pragma unroll
                    for (int t = 0; t < 66; ++t) raw[t] = ((t == 0 && !hasPrev) || (t == 65 && !hasNext)) ? 0u : *(const unsigned*)(pp + (ptrdiff_t)(t - 1) * LDP);
#pragma unroll
                    for (int t8 = 0; t8 < 8; ++t8) { float v0[8], v1[8];
#pragma unroll
                        for (int tt = 0; tt < 8; ++tt) { const int t = t8 * 8 + tt; const unsigned p0 = raw[t], p1 = raw[t + 1], p2 = raw[t + 2];
                            float a0 = bb.x + w0.x * __uint_as_float(p0 << 16) + w1.x * __uint_as_float(p1 << 16) + w2.x * __uint_as_float(p2 << 16);
                            float a1 = bb.y + w0.y * __uint_as_float(p0 & 0xFFFF0000u) + w1.y * __uint_as_float(p1 & 0xFFFF0000u) + w2.y * __uint_as_float(p2 & 0xFFFF0000u);
                            a0 = siluf_(a0) * osc; a1 = siluf_(a1) * osc; v0[tt] = a0; v1[tt] = a1;
                            *(unsigned*)(dst + (size_t)t * 1024) = pk2(a0, a1); }
                        if (strip) { u32x4 s0, s1; s0.x = pk2(v0[0], v0[1]); s0.y = pk2(v0[2], v0[3]); s0.z = pk2(v0[4], v0[5]); s0.w = pk2(v0[6], v0[7]); s1.x = pk2(v1[0], v1[1]); s1.y = pk2(v1[2], v1[3]); s1.z = pk2(v1[4], v1[5]); s1.w = pk2(v1[6], v1[7]);
                            *(u32x4*)(strip + t8 * 8) = s0; *(u32x4*)(strip + 64 + t8 * 8) = s1; } }
                } else {
                    const int c = (tid & 255) * 2, th = tid >> 8; const bf16_t* pp = P + (tok0 + th * 32) * LDP + ML_OFF + 1024 + c; bf16_t* strip = VTG + ((size_t)seg * 512 + c) * 64 + th * 32;
                    unsigned rv[32];
#pragma unroll
                    for (int t = 0; t < 32; ++t) rv[t] = *(const unsigned*)(pp + (size_t)t * LDP);
#pragma unroll
                    for (int t8 = 0; t8 < 4; ++t8) { u32x4 s0, s1;
                        s0.x = (rv[t8 * 8 + 0] & 0xFFFFu) | (rv[t8 * 8 + 1] << 16); s0.y = (rv[t8 * 8 + 2] & 0xFFFFu) | (rv[t8 * 8 + 3] << 16); s0.z = (rv[t8 * 8 + 4] & 0xFFFFu) | (rv[t8 * 8 + 5] << 16); s0.w = (rv[t8 * 8 + 6] & 0xFFFFu) | (rv[t8 * 8 + 7] << 16);
                        s1.x = (rv[t8 * 8 + 0] >> 16) | (rv[t8 * 8 + 1] & 0xFFFF0000u); s1.y = (rv[t8 * 8 + 2] >> 16) | (rv[t8 * 8 + 3] & 0xFFFF0000u); s1.z = (rv[t8 * 8 + 4] >> 16) | (rv[t8 * 8 + 5] & 0xFFFF0000u); s1.w = (rv[t8 * 8 + 6] >> 16) | (rv[t8 * 8 + 7] & 0xFFFF0000u);
                        *(u32x4*)(strip + t8 * 8) = s0; *(u32x4*)(strip + 64 + t8 * 8) = s1; }
                }
            }
            if (!lastl) for (int tok = NLAT + bid; tok < NTOK; tok += G) {
                const int t = (tok - NLAT) & (CTXL - 1); const bool hasL = (t != 0), hasR = (t != CTXL - 1); const bf16_t* pr = P + (size_t)tok * LDP;
#pragma unroll
                for (int j = 0; j < 3; ++j) { const int cc = tid + j * 512;
                    float acc = hcb[cc] + hcw[1536 + cc] * bf2f(pr[HY_OFF + cc]);
                    if (hasL) acc += hcw[cc] * bf2f(pr[HY_OFF + cc - LDP]);
                    if (hasR) acc += hcw[2 * 1536 + cc] * bf2f(pr[HY_OFF + cc + LDP]);
                    U[(size_t)tok * 1536 + cc] = acc; }
            }
            for (int idx = bid * NTHR + tid; idx < 16384 * 64; idx += G * NTHR) { const int half = idx & 1, g = (idx >> 1) & 31, tok = idx >> 6;
                *(u32x4*)(S5A + ((size_t)g * 512 + (tok >> 5)) * 768 + (tok & 31) * 16 + half * 8) = *(const u32x4*)(P + (size_t)tok * LDP + S5_OFF + g * 16 + half * 8); }
            for (int idx = bid * NTHR + tid; idx < 32 * 512 * 32 * 2; idx += G * NTHR) { const int half = idx & 1, sI = (idx >> 1) & 31, row = (idx >> 6) & 511, g = idx >> 15; const int t = row >> 4, c = row & 15; const int lag = t - sI;
                float v[8];
                if (lag > 0) { const float4* k4 = (const float4*)(KTB + ((size_t)((g * 2 + 0) * 32 + lag) * 16 + c) * 16 + half * 8); const float4 a0 = k4[0], a1 = k4[1]; v[0] = a0.x; v[1] = a0.y; v[2] = a0.z; v[3] = a0.w; v[4] = a1.x; v[5] = a1.y; v[6] = a1.z; v[7] = a1.w; }
                else if (lag < 0) { const float4* k4 = (const float4*)(KTB + ((size_t)((g * 2 + 1) * 32 - lag) * 16 + c) * 16 + half * 8); const float4 a0 = k4[0], a1 = k4[1]; v[0] = a0.x; v[1] = a0.y; v[2] = a0.z; v[3] = a0.w; v[4] = a1.x; v[5] = a1.y; v[6] = a1.z; v[7] = a1.w; }
                else { const float4* k4 = (const float4*)(KTB + ((size_t)((g * 2 + 0) * 32) * 16 + c) * 16 + half * 8); const float4* q4 = (const float4*)(KTB + ((size_t)((g * 2 + 1) * 32) * 16 + c) * 16 + half * 8); const float4 a0 = k4[0], a1 = k4[1], b0 = q4[0], b1 = q4[1];
                    v[0] = a0.x + b0.x; v[1] = a0.y + b0.y; v[2] = a0.z + b0.z; v[3] = a0.w + b0.w; v[4] = a1.x + b1.x; v[5] = a1.y + b1.y; v[6] = a1.z + b1.z; v[7] = a1.w + b1.w; }
                u32x4 w; w.x = pk2(v[0], v[1]); w.y = pk2(v[2], v[3]); w.z = pk2(v[4], v[5]); w.w = pk2(v[6], v[7]);
                *(u32x4*)(S5B + ((size_t)g * 512 + row) * 768 + sI * 16 + half * 8) = w; }
            for (int idx = bid * NTHR + tid; idx < 32 * 512 * 64; idx += G * NTHR) { const int n = idx & 63, row = (idx >> 6) & 511, g = idx >> 15; const int t = row >> 4, c = row & 15;
                const float cr = (PT(29) + l * 32 * 16 * 64)[(g * 16 + c) * 64 + n], ci = (PT(30) + l * 32 * 16 * 64)[(g * 16 + c) * 64 + n];
                const float2 af = APW[((0 * 32 + g) * 64 + n) * 33 + t + 1], ab = APW[((1 * 32 + g) * 64 + n) * 33 + 32 - t];
                bf16_t* d = S5B + ((size_t)g * 512 + row) * 768 + 512 + 2 * n;
                *(unsigned*)d = pk2(cr * af.x - ci * af.y, -(cr * af.y + ci * af.x)); *(unsigned*)(d + 128) = pk2(cr * ab.x - ci * ab.y, -(cr * ab.y + ci * ab.x)); }
            for (int idx = bid * NTHR + tid; idx < 32 * 2 * 64 * 32; idx += G * NTHR) { const int sI = idx & 31, n = (idx >> 5) & 63, dir = (idx >> 11) & 1, g = idx >> 12; const int pi = (dir * 32 + g) * 64 + n;
                const float2 pw = APW[pi * 33 + (dir ? sI : 31 - sI)]; const float4* bb = (const float4*)(BBT + pi * 16);
                float re[16], im[16];
#pragma unroll
                for (int j = 0; j < 8; ++j) { const float4 b2 = bb[j]; re[2 * j] = pw.x * b2.x - pw.y * b2.y; im[2 * j] = pw.x * b2.y + pw.y * b2.x; re[2 * j + 1] = pw.x * b2.z - pw.y * b2.w; im[2 * j + 1] = pw.x * b2.w + pw.y * b2.z; }
                bf16_t* d = S5P + ((size_t)g * 256 + dir * 128 + 2 * n) * 512 + sI * 16;
                u32x4 w0, w1; w0.x = pk2(re[0], re[1]); w0.y = pk2(re[2], re[3]); w0.z = pk2(re[4], re[5]); w0.w = pk2(re[6], re[7]); w1.x = pk2(re[8], re[9]); w1.y = pk2(re[10], re[11]); w1.z = pk2(re[12], re[13]); w1.w = pk2(re[14], re[15]);
                *(u32x4*)d = w0; *(u32x4*)(d + 8) = w1;
                w0.x = pk2(im[0], im[1]); w0.y = pk2(im[2], im[3]); w0.z = pk2(im[4], im[5]); w0.w = pk2(im[6], im[7]); w1.x = pk2(im[8], im[9]); w1.y = pk2(im[10], im[11]); w1.z = pk2(im[12], im[13]); w1.w = pk2(im[14], im[15]);
                *(u32x4*)(d + 512) = w0; *(u32x4*)(d + 520) = w1; }
            {   float* T = sf;
                for (int unit = bid; unit < 4 * 64 * 24; unit += G) { const int b = unit / (64 * 24), r = (unit / 24) % 64, c0 = (unit % 24) * 64; const size_t tok0 = (size_t)b * SEQ + r * 64;
                    __syncthreads();
#pragma unroll
                    for (int i = 0; i < 8; ++i) { const int c = tid & 63, t = (tid >> 6) + 8 * i; T[t * 65 + c] = bf2f(P[(tok0 + t) * LDP + HY_OFF + c0 + c]); }
                    __syncthreads();
                    const int c = tid >> 3, tq = (tid & 7) * 8, cc = c0 + c; const float w0 = hcw[cc], w1 = hcw[1536 + cc], w2 = hcw[3072 + cc], bb = hcb[cc];
                    float o8[8];
#pragma unroll
                    for (int i = 0; i < 8; ++i) { const int t = tq + i; float acc = bb + w1 * T[t * 65 + c]; if (t > 0) acc += w0 * T[(t - 1) * 65 + c]; if (t < 63) acc += w2 * T[(t + 1) * 65 + c]; o8[i] = acc; }
                    float* dst = UT + ((size_t)b * 1536 + cc) * SEQ + r * 64 + tq;
                    *(float4*)dst = make_float4(o8[0], o8[1], o8[2], o8[3]); *(float4*)(dst + 4) = make_float4(o8[4], o8[5], o8[6], o8[7]);
                } }
            if (!lastl) {
                const int L = CTXL; const float* HR = HRAW + (size_t)SEQ * 2048; float* K2 = K2C; const float* nrm = NORM + (size_t)(l * 2 + 1) * 1024;
                const size_t total = (size_t)(2 * L - 1) * 1024;
                for (size_t i = (size_t)bid * NTHR + tid; i < total; i += (size_t)G * NTHR) { const int j = (int)(i >> 10), oc = (int)(i & 1023), o = oc >> 9, c = oc & 511; const int lag = j - (L - 1);
                    const float v = lag >= 0 ? HR[(size_t)lag * 2048 + o * 1024 + c] : HR[(size_t)(-lag) * 2048 + o * 1024 + 512 + c];
                    K2[((size_t)j * 2 + o) * 512 + c] = v / nrm[oc]; }
            }
            {   __syncthreads(); fft_twiddles((float2*)(shm + FFT_X_BYTES), tid);
                for (int oc = bid; oc < 1024; oc += G) hyena_spec_item(oc, HRAW, NORM + (size_t)(l * 2 + 0) * 1024, HSPEC, shm, tid);
                __syncthreads(); }
            SEAM(PB + 2);
        }

        if (IN(PB + 3)) for (int rep_ = 0; rep_ < PROBE_REPS(3); ++rep_) {
            PH_BEGIN
            if (rep_ > 0) { if (bid == 0 && tid == 0) __hip_atomic_store(QCTR + l * 64, 0, __ATOMIC_RELAXED, __HIP_MEMORY_SCOPE_AGENT); xcd_barrier(bar); }
            if (bid < 64) {
                mlstm_state_pass(bid >> 1, bid & 1, P, KTG, VTG, PT(22) + l * 16, CST, NST, MST, shm, tid);
            } else if (bid < 128) {
                { const int ch = bid - 64; const int dir_ = ch & 1, h_ = (ch >> 1) & 7; ssd_state_pass(ch, P, BTG, XTG, -expf(PT(37)[l * 16 + dir_ * 8 + h_]), PT(36)[l * 16 + dir_ * 8 + h_], SSTB, shm, tid); }
            } else if (bid < 160) {
                const int widx = (bid - 128) * 8 + wave; const int dir = widx & 1, g = (widx >> 1) & 31, b = widx >> 6; const int n = lane;
                float2* xb = (float2*)(shm + (size_t)wave * 16640); float2* ctab = xb + 16 * 65;
                const float* a_re = PT(24) + l * 2 * 32 * 64; const float* a_im = PT(25) + l * 2 * 32 * 64; const float* log_dt = PT(26) + l * 64;
                const float* b_re = PT(27) + l * 32 * 64 * 16; const float* b_im = PT(28) + l * 32 * 64 * 16; const float* c_re = PT(29) + l * 32 * 16 * 64; const float* c_im = PT(30) + l * 32 * 16 * 64;
#pragma unroll
                for (int c = 0; c < 16; ++c) ctab[c * 65 + lane] = make_float2(c_re[(g * 16 + c) * 64 + lane], c_im[(g * 16 + c) * 64 + lane]);
                float abr, abi, bbr[16], bbi[16];
                {   const double are = (double)a_re[(dir * 32 + g) * 64 + n], aim = (double)a_im[(dir * 32 + g) * 64 + n];
                    const double lam = are < -1e-4 ? are : -1e-4; const double dt = exp((double)log_dt[dir * 32 + g]);
                    const double mag = exp(lam * dt); const double ar = mag * cos(aim * dt), ai = mag * sin(aim * dt);
                    const double den = lam * lam + aim * aim; const double nr = ar - 1.0, ni = ai;
                    const double fre = (nr * lam + ni * aim) / den, fim = (ni * lam - nr * aim) / den;
                    abr = (float)ar; abi = (float)ai;
#pragma unroll
                    for (int c = 0; c < 16; ++c) { const double br = (double)b_re[(g * 64 + n) * 16 + c], bi = (double)b_im[(g * 64 + n) * 16 + c]; bbr[c] = (float)(fre * br - fim * bi); bbi[c] = (float)(fre * bi + fim * br); }
                }
                float xr = 0.f, xi = 0.f; float* Sout = (dir ? SB : SF) - (size_t)NLAT * BW;
                const int s = lane >> 2, cg = lane & 3;
                for (int i0 = 0; i0 < CTXL; i0 += 16) {
#pragma unroll 4
                    for (int ss = 0; ss < 16; ++ss) {
                        const size_t tok = (size_t)step_tok(b, dir, i0 + ss);
                        const u32x4* up = (const u32x4*)(P + tok * LDP + S5_OFF + g * 16);
                        float t0[8], t1[8]; unpack8(up[0], t0); unpack8(up[1], t1);
                        float bur = 0.f, bui = 0.f;
#pragma unroll
                        for (int c = 0; c < 8; ++c) { bur += t0[c] * bbr[c] + t1[c] * bbr[8 + c]; bui += t0[c] * bbi[c] + t1[c] * bbi[8 + c]; }
                        const float nxr = abr * xr - abi * xi + bur, nxi = abr * xi + abi * xr + bui; xr = nxr; xi = nxi;
                        xb[ss * 65 + lane] = make_float2(xr, xi);
                    }
                    asm volatile("s_waitcnt lgkmcnt(0)" ::: "memory");
                    float y0 = 0.f, y1 = 0.f, y2 = 0.f, y3 = 0.f;
                    for (int nn2 = 0; nn2 < 64; ++nn2) { const float2 xv = xb[s * 65 + nn2];
                        const float2 c0 = ctab[(cg * 4 + 0) * 65 + nn2], c1 = ctab[(cg * 4 + 1) * 65 + nn2], c2 = ctab[(cg * 4 + 2) * 65 + nn2], c3 = ctab[(cg * 4 + 3) * 65 + nn2];
                        y0 += xv.x * c0.x - xv.y * c0.y; y1 += xv.x * c1.x - xv.y * c1.y; y2 += xv.x * c2.x - xv.y * c2.y; y3 += xv.x * c3.x - xv.y * c3.y; }
                    const size_t toks = (size_t)step_tok(b, dir, i0 + s);
                    *(float4*)(Sout + toks * BW + g * 16 + cg * 4) = make_float4(y0, y1, y2, y3);
                    asm volatile("s_waitcnt lgkmcnt(0)" ::: "memory");
                }
                XCTX[((b * 32 + g) * 2 + dir) * 64 + n] = make_float2(xr, xi);
            } else {
                if (bid < 224) {
                    pg8::Gemm gg_{S5A, S5P, 768, 512, 512}; pg8::SchedS5a S_{bid - 160}; pg8::EpiXloc E_{XLOC};
                    pg8::gemm_phase((LAS unsigned char*)shm, gg_, S_, E_);
                    __syncthreads();
                }
                const int nhb = G - 160, hb = bid - 160; const float* bias = PT(19) + l * 1024; const int c = tid;
                const int nitems = lastl ? 0 : 4 * (CTXL / 8);
                for (int it = hb; it < nitems; it += nhb) {
                    int L, tokbase, b, t0; const float* K2;
                    { const int q = it; L = CTXL; tokbase = NLAT; b = q / (CTXL / 8); t0 = (q % (CTXL / 8)) * 8; K2 = K2C; }
                    const float* zb = U + (size_t)(tokbase + b * L) * 1536 + c;
                    float acc[8];
#pragma unroll
                    for (int i = 0; i < 8; ++i) acc[i] = 0.f;
                    const int base = t0 + L - 1;
                    for (int s = 0; s < L; s += 8) {
                        float k[15];
#pragma unroll
                        for (int mm = 0; mm < 15; ++mm) k[mm] = K2[((size_t)(base - s - 7 + mm) * 2 + 0) * 512 + c];
#pragma unroll
                        for (int ds = 0; ds < 8; ++ds) { const float z = zb[(size_t)(s + ds) * 1536];
#pragma unroll
                            for (int i = 0; i < 8; ++i) acc[i] += k[i - ds + 7] * z; }
                    }
#pragma unroll
                    for (int i = 0; i < 8; ++i) { const size_t tok = (size_t)(tokbase + b * L + t0 + i); const float zt = U[tok * 1536 + c]; Z[tok * BW + c] = (acc[i] + bias[c] * zt) * U[tok * 1536 + 512 + c]; }
                }
            }
            {   __syncthreads(); fft_twiddles((float2*)(shm + FFT_X_BYTES), tid);
                int* qslot = (int*)(shm + FFT_X_BYTES + 65536);
                for (;;) { __syncthreads(); if (tid == 0) *qslot = atomicAdd(QCTR + l * 64, 1); __syncthreads(); const int it = *qslot; if (it >= 1024) break;
                    hyena_fft_item(it, UT, HSPEC, PT(19) + l * 1024, YT, shm, tid); }
            }
            SEAM(PB + 3);
        }

        if (IN(PB + 4)) for (int rep_ = 0; rep_ < PROBE_REPS(4); ++rep_) {
            PH_BEGIN
            if (rep_ > 0) { if (bid == 0 && tid == 0) __hip_atomic_store(QCTR + l * 64 + 32, 0, __ATOMIC_RELAXED, __HIP_MEMORY_SCOPE_AGENT); xcd_barrier(bar); }
            if (bid >= G - 32) for (int idx = (bid - (G - 32)) * NTHR + tid; idx < 16384; idx += 32 * NTHR) { const int n = idx & 63, dir = (idx >> 6) & 1, b = (idx >> 7) & 3, g = idx >> 9;
                const float2 a32 = APW[((dir * 32 + g) * 64 + n) * 33 + 32]; float2 X = XCTX[((b * 32 + g) * 2 + dir) * 64 + n];
                const float* __restrict__ xl = XLOC + ((size_t)g * 512 + b * 128) * 256 + dir * 128 + 2 * n; bf16_t* __restrict__ dst = S5A + ((size_t)g * 512 + b * 128) * 768 + 512 + dir * 128 + 2 * n;
#pragma unroll 8
                for (int jj = 0; jj < 128; ++jj) { const int j = dir ? 127 - jj : jj; const float2 xv = *(const float2*)(xl + (size_t)j * 256);
                    *(unsigned*)(dst + (size_t)j * 768) = pk2(X.x, X.y);
                    const float nx = a32.x * X.x - a32.y * X.y + xv.x, ny = a32.x * X.y + a32.y * X.x + xv.y; X.x = nx; X.y = ny; } }
            {   int* qslot = (int*)(shm + 102400);
                for (;;) { __syncthreads(); if (tid == 0) *qslot = atomicAdd(QCTR + l * 64 + 32, 1); __syncthreads(); const int it = *qslot; if (it >= 32 * 68 + 64 * 68) break;
                    if (it < 32 * 68) { const int chain = it / 68, c = it % 68; mlstm_out_item(chain, c, P, QKB, VTG, PT(22) + l * 16, CST, NST, MST, (chain & 1) ? HBk : HF, shm, tid); }
                    else { const int i2 = it - 32 * 68; const int chain = i2 / 68, c = i2 % 68; const int dir_ = chain & 1, h_ = (chain >> 1) & 7;
                        ssd_out_item(chain, c, P, XBC, XTG, -expf(PT(37)[l * 16 + dir_ * 8 + h_]), PT(36)[l * 16 + dir_ * 8 + h_], SSTB, dir_ ? YB : YF, shm, tid); } }
            }
            __syncthreads();
            {   const float* bias = PT(19) + l * 1024 + 512; const int c = tid;
                const int nitems = lastl ? 0 : 4 * (CTXL / 8);
                for (int it = bid; it < nitems; it += G) {
                    int L, tokbase, b, t0; const float* K2;
                    { const int q = it; L = CTXL; tokbase = NLAT; b = q / (CTXL / 8); t0 = (q % (CTXL / 8)) * 8; K2 = K2C; }
                    const float* zb = Z + (size_t)(tokbase + b * L) * BW + c;
                    float acc[8];
#pragma unroll
                    for (int i = 0; i < 8; ++i) acc[i] = 0.f;
                    const int base = t0 + L - 1;
                    for (int s = 0; s < L; s += 8) {
                        float k[15];
#pragma unroll
                        for (int mm = 0; mm < 15; ++mm) k[mm] = K2[((size_t)(base - s - 7 + mm) * 2 + 1) * 512 + c];
#pragma unroll
                        for (int ds = 0; ds < 8; ++ds) { const float z = zb[(size_t)(s + ds) * BW];
#pragma unroll
                            for (int i = 0; i < 8; ++i) acc[i] += k[i - ds + 7] * z; }
                    }
#pragma unroll
                    for (int i = 0; i < 8; ++i) { const size_t tok = (size_t)(tokbase + b * L + t0 + i); const float zt = Z[tok * BW + c]; Y4[tok * DM + c] = f2bf((acc[i] + bias[c] * zt) * U[tok * 1536 + 1024 + c]); }
                }
            }
            SEAM(PB + 4);
        }

        if (IN(PB + 5)) for (int rep_ = 0; rep_ < PROBE_REPS(5); ++rep_) {
            PH_BEGIN
            const float* ml_norm = PT(23) + l * BW; const float* ssd_d = PT(38) + l * 8; const float* ssd_norm = PT(39) + l * BW; const float* s5_d = PT(31) + l * BW;
            if (bid < 128) {
                pg8::Gemm gg_{S5A, S5B, 768, 768, 768}; pg8::SchedS5b S_{bid}; pg8::EpiS5Out E_{P, s5_d, GG};
                pg8::gemm_phase((LAS unsigned char*)shm, gg_, S_, E_);
                __syncthreads();
            }
            for (int tok = bid * 8 + wave; tok < NTOK; tok += G * 8) {
                const int c0 = lane * 8; const bf16_t* pr = P + (size_t)tok * LDP; const size_t o5 = (size_t)tok * BW + c0;
                float hm[8], ys[8];
                { const float4 a0 = *(const float4*)(HF + o5), a1 = *(const float4*)(HF + o5 + 4), b0 = *(const float4*)(HBk + o5), b1 = *(const float4*)(HBk + o5 + 4);
                  hm[0] = a0.x + b0.x; hm[1] = a0.y + b0.y; hm[2] = a0.z + b0.z; hm[3] = a0.w + b0.w; hm[4] = a1.x + b1.x; hm[5] = a1.y + b1.y; hm[6] = a1.z + b1.z; hm[7] = a1.w + b1.w; }
                { const float4 a0 = *(const float4*)(YF + o5), a1 = *(const float4*)(YF + o5 + 4), b0 = *(const float4*)(YB + o5), b1 = *(const float4*)(YB + o5 + 4);
                  float xx[8], zz[8]; unpack8(*(const u32x4*)(XBC + (size_t)tok * 1024 + c0), xx); unpack8(*(const u32x4*)(pr + SSD_OFF + c0), zz); const float dsk = ssd_d[c0 >> 6];
                  ys[0] = a0.x + b0.x; ys[1] = a0.y + b0.y; ys[2] = a0.z + b0.z; ys[3] = a0.w + b0.w; ys[4] = a1.x + b1.x; ys[5] = a1.y + b1.y; ys[6] = a1.z + b1.z; ys[7] = a1.w + b1.w;
#pragma unroll
                  for (int j = 0; j < 8; ++j) ys[j] = (ys[j] + dsk * xx[j]) * siluf_(zz[j]); }
                float s1 = 0.f, s2 = 0.f;
#pragma unroll
                for (int j = 0; j < 8; ++j) { s1 += hm[j] * hm[j]; s2 += ys[j] * ys[j]; }
                s1 += __shfl_xor(s1, 1); s1 += __shfl_xor(s1, 2); s1 += __shfl_xor(s1, 4); s1 += __shfl_xor(s1, 8);
                s2 = wave_sum(s2);
                const float r1 = rsqrtf(s1 * (1.0f / 128.0f) + 1e-6f), r2 = rsqrtf(s2 * (1.0f / BW) + 1e-6f);
                float oo[8]; unpack8(*(const u32x4*)(pr + ML_OFF + 1536 + c0), oo);
                const float4 g0 = *(const float4*)(ml_norm + c0), g1 = *(const float4*)(ml_norm + c0 + 4), n0 = *(const float4*)(ssd_norm + c0), n1 = *(const float4*)(ssd_norm + c0 + 4);
                const float gm[8] = {g0.x, g0.y, g0.z, g0.w, g1.x, g1.y, g1.z, g1.w}, gs[8] = {n0.x, n0.y, n0.z, n0.w, n1.x, n1.y, n1.z, n1.w};
                u32x4 w;
                w.x = pk2(hm[0] * r1 * gm[0] * sigmoidf_(oo[0]), hm[1] * r1 * gm[1] * sigmoidf_(oo[1])); w.y = pk2(hm[2] * r1 * gm[2] * sigmoidf_(oo[2]), hm[3] * r1 * gm[3] * sigmoidf_(oo[3]));
                w.z = pk2(hm[4] * r1 * gm[4] * sigmoidf_(oo[4]), hm[5] * r1 * gm[5] * sigmoidf_(oo[5])); w.w = pk2(hm[6] * r1 * gm[6] * sigmoidf_(oo[6]), hm[7] * r1 * gm[7] * sigmoidf_(oo[7]));
                *(u32x4*)(Y4 + (size_t)tok * DM + 512 + c0) = w;
                w.x = pk2(ys[0] * r2 * gs[0], ys[1] * r2 * gs[1]); w.y = pk2(ys[2] * r2 * gs[2], ys[3] * r2 * gs[3]); w.z = pk2(ys[4] * r2 * gs[4], ys[5] * r2 * gs[5]); w.w = pk2(ys[6] * r2 * gs[6], ys[7] * r2 * gs[7]);
                *(u32x4*)(Y4 + (size_t)tok * DM + 1536 + c0) = w;
                if (tok >= NLAT) { const size_t oc = (size_t)(tok - NLAT) * BW + c0; float uu[8]; unpack8(*(const u32x4*)(pr + S5_OFF + c0), uu);
                    const float4 a0 = *(const float4*)(SF + oc), a1 = *(const float4*)(SF + oc + 4), b0 = *(const float4*)(SB + oc), b1 = *(const float4*)(SB + oc + 4), d0 = *(const float4*)(s5_d + c0), d1 = *(const float4*)(s5_d + c0 + 4);
                    float y[8] = {a0.x + b0.x + d0.x * uu[0], a0.y + b0.y + d0.y * uu[1], a0.z + b0.z + d0.z * uu[2], a0.w + b0.w + d0.w * uu[3], a1.x + b1.x + d1.x * uu[4], a1.y + b1.y + d1.y * uu[5], a1.z + b1.z + d1.z * uu[6], a1.w + b1.w + d1.w * uu[7]};
#pragma unroll
                    for (int j = 0; j < 8; ++j) y[j] = 0.5f * y[j] * (1.0f + tanhf(0.7978845608028654f * (y[j] + 0.044715f * y[j] * y[j] * y[j])));
                    w.x = pk2(y[0], y[1]); w.y = pk2(y[2], y[3]); w.z = pk2(y[4], y[5]); w.w = pk2(y[6], y[7]);
                    *(u32x4*)(GG + (size_t)tok * BW + c0) = w; }
            }
            __syncthreads();
            {   float* T = sf;
                for (int unit = (G > 128 ? bid - 128 : bid); unit >= 0 && unit < 4 * 64 * 8; unit += (G > 128 ? G - 128 : G)) { const int b = unit / 512, t0 = ((unit >> 3) & 63) * 64, c0 = (unit & 7) * 64;
                    __syncthreads();
#pragma unroll
                    for (int i = 0; i < 8; ++i) { const int t = tid & 63, c = (tid >> 6) + 8 * i; T[c * 65 + t] = YT[((size_t)b * 512 + c0 + c) * SEQ + t0 + t]; }
                    __syncthreads();
                    const int t = tid >> 3, cq = (tid & 7) * 8;
                    u32x4 w; w.x = pk2(T[(cq + 0) * 65 + t], T[(cq + 1) * 65 + t]); w.y = pk2(T[(cq + 2) * 65 + t], T[(cq + 3) * 65 + t]); w.z = pk2(T[(cq + 4) * 65 + t], T[(cq + 5) * 65 + t]); w.w = pk2(T[(cq + 6) * 65 + t], T[(cq + 7) * 65 + t]);
                    *(u32x4*)(Y4 + ((size_t)b * SEQ + t0 + t) * DM + c0 + cq) = w;
                } }
            SEAM(PB + 5);
        }

        if (IN(PB + 6)) for (int rep_ = 0; rep_ < PROBE_REPS(6); ++rep_) {
            PH_BEGIN
            pg8::Gemm g{GG, GLU, BW, BW, BW}; pg8::SchedStd S{68, 2, G, bid, BW, BW}; pg8::EpiGlu E{GG, PT(33) + l * BW, Y4};
            pg8::gemm_phase((LAS unsigned char*)shm, g, S, E);
            SEAM(PB + 6);
        }
        if (IN(PB + 7)) for (int rep_ = 0; rep_ < PROBE_REPS(7); ++rep_) {
            PH_BEGIN
            pg8::Gemm g{Y4, WBR, DM, BW, BW}; pg8::SchedBranch S{nPanels, 8, G, bid}; pg8::EpiBranch E{P, ACCb};
            pg8::gemm_phase((LAS unsigned char*)shm, g, S, E);
            SEAM(PB + 7);
        }
        if (IN(PB + 8)) for (int rep_ = 0; rep_ < PROBE_REPS(8); ++rep_) {
            PH_BEGIN
            pg8::Gemm g{ACCb, WOUT, DM, DM, DM}; pg8::SchedStd S{nPanels, 8, G, bid, DM, DM}; pg8::EpiResid E{XS, l == 0 ? x_in : (const float*)XS, l == 0 ? ctx_in - (size_t)NLAT * DM : (const float*)XS, MODl, 2};
            pg8::gemm_phase((LAS unsigned char*)shm, g, S, E);
            SEAM(PB + 8);
        }
        if (IN(PB + 9)) for (int rep_ = 0; rep_ < PROBE_REPS(9); ++rep_) {
            PH_BEGIN
            for (int i = bid * NTHR + tid; i < NEXP * MOE_PAD; i += G * NTHR) ROWTOK[i] = -1;
            for (int i = bid * NTHR + tid; i < NTOK * 16; i += G * NTHR) INV[i] = -1;
            const float* wr = PT(42) + (size_t)l * DM * 16; const float* gn = norm_ffn + l * DM;
            for (int tok0 = (bid * 8 + wave) * 4; tok0 < M2; tok0 += G * 32) {
                const int r = tok0 < NLAT ? tok0 / SEQ : 4; const float* xr = XS + (size_t)tok0 * DM;
                const float* sh = MODl + (size_t)(r * 6 + 3) * DM; const float* sc = MODl + (size_t)(r * 6 + 4) * DM;
                float rs[4];
#pragma unroll
                for (int tk = 0; tk < 4; ++tk) { float ss = 0.f;
#pragma unroll 4
                    for (int i = 0; i < 8; ++i) { const float4 t4 = *(const float4*)(xr + (size_t)tk * DM + i * 256 + lane * 4); ss += t4.x * t4.x + t4.y * t4.y + t4.z * t4.z + t4.w * t4.w; }
                    ss = wave_sum(ss); rs[tk] = rsqrtf(ss * (1.0f / DM) + 1e-6f); }
                float lg[4][16];
#pragma unroll
                for (int tk = 0; tk < 4; ++tk)
#pragma unroll
                    for (int e = 0; e < 16; ++e) lg[tk][e] = 0.f;
#pragma unroll 1
                for (int i = 0; i < 8; ++i) { const int d = i * 256 + lane * 4;
                    const float4 g4 = *(const float4*)(gn + d), s4 = *(const float4*)(sc + d), h4 = *(const float4*)(sh + d);
                    float hv[4][4];
#pragma unroll
                    for (int tk = 0; tk < 4; ++tk) { const float4 xv = *(const float4*)(xr + (size_t)tk * DM + d); const float rr = rs[tk];
                        hv[tk][0] = xv.x * rr * g4.x * (1.f + s4.x) + h4.x; hv[tk][1] = xv.y * rr * g4.y * (1.f + s4.y) + h4.y; hv[tk][2] = xv.z * rr * g4.z * (1.f + s4.z) + h4.z; hv[tk][3] = xv.w * rr * g4.w * (1.f + s4.w) + h4.w;
                        u32x2 w; w.x = pk2(hv[tk][0], hv[tk][1]); w.y = pk2(hv[tk][2], hv[tk][3]); *(u32x2*)(HB + (size_t)(tok0 + tk) * DM + d) = w; }
                    const float4* wq = (const float4*)(wr + (size_t)d * 16);
#pragma unroll
                    for (int q = 0; q < 4; ++q) { const float4 w0 = wq[q * 4 + 0], w1 = wq[q * 4 + 1], w2 = wq[q * 4 + 2], w3 = wq[q * 4 + 3];
#pragma unroll
                        for (int tk = 0; tk < 4; ++tk) { const float hq = hv[tk][q];
                            lg[tk][0] += hq * w0.x; lg[tk][1] += hq * w0.y; lg[tk][2] += hq * w0.z; lg[tk][3] += hq * w0.w; lg[tk][4] += hq * w1.x; lg[tk][5] += hq * w1.y; lg[tk][6] += hq * w1.z; lg[tk][7] += hq * w1.w;
                            lg[tk][8] += hq * w2.x; lg[tk][9] += hq * w2.y; lg[tk][10] += hq * w2.z; lg[tk][11] += hq * w2.w; lg[tk][12] += hq * w3.x; lg[tk][13] += hq * w3.y; lg[tk][14] += hq * w3.z; lg[tk][15] += hq * w3.w; } } }
#pragma unroll
                for (int tk = 0; tk < 4; ++tk) { float mx = -1e30f;
#pragma unroll
                    for (int e = 0; e < 16; ++e) { lg[tk][e] = wave_sum(lg[tk][e]); mx = fmaxf(mx, lg[tk][e]); }
                    float sm = 0.f;
#pragma unroll
                    for (int e = 0; e < 16; ++e) { lg[tk][e] = expf(lg[tk][e] - mx); sm += lg[tk][e]; }
                    const float inv = 1.0f / sm;
                    if (lane == 0) {
#pragma unroll
                        for (int e = 0; e < 16; e += 4) *(float4*)(PROBS + (size_t)(tok0 + tk) * 16 + e) = make_float4(lg[tk][e] * inv, lg[tk][e + 1] * inv, lg[tk][e + 2] * inv, lg[tk][e + 3] * inv); } }
            }
            SEAM(PB + 9);
        }
        if (IN(PB + 10)) for (int rep_ = 0; rep_ < PROBE_REPS(10); ++rep_) {
            PH_BEGIN
            const int nitems = 64 + (lastl ? 0 : 64);
            unsigned long long* keys = (unsigned long long*)shm;
            for (int it = bid; it < nitems; it += G) {
                const int set = it >> 6, e = it & 15, b = (it >> 4) & 3;
                const int n = set ? CTXL : SEQ, cap = set ? 32 : 512, tokbase = set ? NLAT + b * CTXL : b * SEQ;
                __syncthreads();
                for (int i = tid; i < n; i += NTHR) keys[i] = ((unsigned long long)__float_as_uint(PROBS[(size_t)(tokbase + i) * 16 + e]) << 32) | (unsigned long long)(0xFFFFFFFFu - (unsigned)i);
                __syncthreads();
                for (int k = 2; k <= n; k <<= 1)
                    for (int j = k >> 1; j > 0; j >>= 1) {
                        for (int p = tid; p < (n >> 1); p += NTHR) { const int i = ((p & ~(j - 1)) << 1) | (p & (j - 1)); const int m = i | j;
                            const unsigned long long ka = keys[i], kb = keys[m]; const bool desc = ((i & k) == 0);
                            if ((ka < kb) == desc) { keys[i] = kb; keys[m] = ka; } }
                        __syncthreads();
                    }
                for (int r = tid; r < cap; r += NTHR) { const unsigned long long kk = keys[r]; const int row = e * MOE_PAD + (set ? 2048 + b * 32 + r : b * 512 + r);
                    const int tk_ = tokbase + (int)(0xFFFFFFFFu - (unsigned)(kk & 0xFFFFFFFFull)); ROWTOK[row] = tk_; ROWGATE[row] = __uint_as_float((unsigned)(kk >> 32)); INV[tk_ * 16 + e] = row; }
                for (int r = wave; r < cap; r += 8) { const int tok = tokbase + (int)(0xFFFFFFFFu - (unsigned)(keys[r] & 0xFFFFFFFFull)); const int row = e * MOE_PAD + (set ? 2048 + b * 32 + r : b * 512 + r);
                    const u32x4* sp = (const u32x4*)(HB + (size_t)tok * DM); u32x4* dp = (u32x4*)(XG + (size_t)row * DM);
#pragma unroll
                    for (int i = 0; i < 4; ++i) dp[i * 64 + lane] = sp[i * 64 + lane]; }
            }
            {   const int pad0 = lastl ? 2048 : MOE_ROWS, npad = MOE_PAD - pad0;
                for (int R = bid * 8 + wave; R < NEXP * npad; R += G * 8) { const int e = R / npad, rr = pad0 + R % npad; u32x4* dp = (u32x4*)(XG + ((size_t)e * MOE_PAD + rr) * DM);
#pragma unroll
                    for (int i = 0; i < 4; ++i) dp[i * 64 + lane] = (u32x4){0u, 0u, 0u, 0u}; } }
            SEAM(PB + 10);
        }
        if (IN(PB + 12)) for (int rep_ = 0; rep_ < PROBE_REPS(12); ++rep_) {
            PH_BEGIN
            pg8::Gemm g{XG, WGU, DM, DM, DM}; pg8::SchedMoe S{lastl ? 8 : 9, 12, G, bid, DM, DM, 2 * DEXP}; pg8::EpiMoe1 E{HID};
            pg8::gemm_phase((LAS unsigned char*)shm, g, S, E);
            SEAM(PB + 12);
        }
        if (IN(PB + 13)) for (int rep_ = 0; rep_ < PROBE_REPS(13); ++rep_) {
            PH_BEGIN
            pg8::Gemm g{HID, WD, DEXP, DEXP, DEXP}; pg8::SchedMoe S{lastl ? 8 : 9, 8, G, bid, DEXP, DEXP, DM}; pg8::EpiMoeY E{YEXP};
            pg8::gemm_phase((LAS unsigned char*)shm, g, S, E);
            SEAM(PB + 13);
        }

}

__global__ __launch_bounds__(NTHR, 2) void fwd(Args a) {
    extern __shared__ __attribute__((aligned(16))) unsigned char shm[];
    const int bid = blockIdx.x, G = gridDim.x;
    float* const sf = (float*)shm;
    volatile LAS unsigned* xbw = (volatile LAS unsigned*)((LAS unsigned char*)shm + (LDS_BYTES - 16));
    if (threadIdx.x == 0) { xbw[0] = 0u; xbw[1] = 0u; xbw[2] = 0u; xbw[3] = 0u; }
    const float** const ptab = (const float**)(shm + (LDS_BYTES - 16 - 512));
    if (threadIdx.x == 0) {
#pragma unroll
        for (int i = 0; i < 47; ++i) ptab[i] = a.in[i]; }
    __syncthreads();
    XcdBarrier bar = xcd_barrier_post((unsigned*)(a.ws + O_BAR), xbw);
    const int lo = a.ph_lo, hi = a.ph_hi;
    if (IN(0)) {
        PH_BEGIN
        {
            __syncthreads();
            for (int i = tid; i < 5 * DM; i += NTHR) { const int r = i >> 11, k = i & (DM - 1); const float v = r < 4 ? c_in[r * DM + k] : cctx_in[k]; sf[i] = siluf_(v); }
            __syncthreads();
            float* red = sf + 5 * DM;
            for (int unit = bid; unit < 2 * 96; unit += G) { const int l = unit / 96, j = (unit % 96) * 128 + (tid & 127), kq = tid >> 7;
                const float* w = ada_w + (size_t)l * DM * (6 * DM) + (size_t)(kq * 512) * (6 * DM) + j; const float* sv = sf + kq * 512;
                float a0 = 0.f, a1 = 0.f, a2 = 0.f, a3 = 0.f, a4 = 0.f;
#pragma unroll 8
                for (int k = 0; k < 512; ++k) { const float wv = w[(size_t)k * (6 * DM)]; a0 += sv[k] * wv; a1 += sv[DM + k] * wv; a2 += sv[2 * DM + k] * wv; a3 += sv[3 * DM + k] * wv; a4 += sv[4 * DM + k] * wv; }
                __syncthreads();
                { float* rp = red + (kq * 5) * 128 + (tid & 127); rp[0] = a0; rp[128] = a1; rp[256] = a2; rp[384] = a3; rp[512] = a4; }
                __syncthreads();
                if (tid < 128) { const float bb = ada_b[l * 6 * DM + j]; float* o = MOD + (size_t)l * 5 * 6 * DM + j;
#pragma unroll
                    for (int r = 0; r < 5; ++r) o[(size_t)r * 6 * DM] = ((red[(0 * 5 + r) * 128 + tid] + red[(1 * 5 + r) * 128 + tid]) + (red[(2 * 5 + r) * 128 + tid] + red[(3 * 5 + r) * 128 + tid])) + bb; }
            }
        }
    }

    layer_body<0>(a, bar, lo, hi, bid, G, shm, sf, ptab);
    layer_body<1>(a, bar, lo, hi, bid, G, shm, sf, ptab);
    if (IN(33)) {
        PH_BEGIN
        const float* gn = PT(46);
        for (int tok = bid * 8 + wave; tok < NLAT; tok += G * 8) {
            const float* xr = XS + (size_t)tok * DM; float4 v[8]; float ss = 0.f;
#pragma unroll
            for (int i = 0; i < 8; ++i) v[i] = *(const float4*)(xr + i * 256 + lane * 4);
            moe_combine(v, tok, lane, INV, ROWGATE, YEXP, MOD + (size_t)(1 * 5 + tok / SEQ) * 6 * DM + 5 * DM);
#pragma unroll
            for (int i = 0; i < 8; ++i) {                 ss += v[i].x * v[i].x + v[i].y * v[i].y + v[i].z * v[i].z + v[i].w * v[i].w; }
            ss = wave_sum(ss); const float rs = rsqrtf(ss * (1.0f / DM) + 1e-6f);
#pragma unroll
            for (int i = 0; i < 8; ++i) { const int d = i * 256 + lane * 4; const float4 g4 = *(const float4*)(gn + d);
                *(float4*)(a.out + (size_t)tok * DM + d) = make_float4(v[i].x * rs * g4.x, v[i].y * rs * g4.y, v[i].z * rs * g4.z, v[i].w * rs * g4.w); }
        }
    }
#undef IN
#undef SEAM
}


extern "C" void kernel_launch(void* const* d_in, const int* in_sizes, int n_in, void* d_out, int out_size, void* d_ws, size_t ws_size, hipStream_t stream) {
    static int grid = 0;
    if (grid == 0) {
        if (n_in != 47 || ws_size < WS_END) { fprintf(stderr, "kernel_launch: expected 47 inputs and >= %zu bytes of workspace; got %d, %zu\n", (size_t)WS_END, n_in, ws_size); grid = -1; return; }
        int dev = 0, cus = 0;
        if (hipGetDevice(&dev) != hipSuccess || hipDeviceGetAttribute(&cus, hipDeviceAttributeMultiprocessorCount, dev) != hipSuccess) { grid = -1; return; }
        if (hipFuncSetAttribute((const void*)fwd, hipFuncAttributeMaxDynamicSharedMemorySize, LDS_BYTES) != hipSuccess) { fprintf(stderr, "kernel_launch: hipFuncSetAttribute failed\n"); grid = -1; return; }
        int per_cu = 0;
        if (hipOccupancyMaxActiveBlocksPerMultiprocessor(&per_cu, (const void*)fwd, NTHR, LDS_BYTES) != hipSuccess || per_cu < 1) fprintf(stderr, "kernel_launch: occupancy query reports %d\n", per_cu);
        (void)hipGetLastError();
        grid = cus > 256 ? 256 : cus;
        if (grid < 224) { fprintf(stderr, "kernel_launch: needs >= 224 CUs (got %d)\n", grid); grid = -1; return; }
    }
    if (grid < 0) return;
    (void)hipMemsetAsync((char*)d_ws, 0, O_ZERO_END, stream);
    Args a{};
    for (int i = 0; i < 47; ++i) a.in[i] = (const float*)d_in[i];
    a.out = (float*)d_out; a.ws = (unsigned char*)d_ws;
#if MK_ONE_LAUNCH
    a.ph_lo = 0; a.ph_hi = 64;
    hipLaunchKernelGGL(fwd, dim3(grid), dim3(NTHR), LDS_BYTES, stream, a);
#else
    const int ids[] = {0, 1,2,3,4,5,6,7,8,9,10,11,12,13,14, 17,18,19,20,21,22,23,24,25,26,27,28,29,30, 33};
    for (int k = 0; k < (int)(sizeof(ids) / sizeof(ids[0])); ++k) { a.ph_lo = ids[k]; a.ph_hi = ids[k] + 1; hipLaunchKernelGGL(fwd, dim3(grid), dim3(NTHR), LDS_BYTES, stream, a); }
#endif
}
```

```cpp
#include <hip/hip_runtime.h>
#include <stdint.h>
#include <stdio.h>

#ifndef PROBE_MASK
#define PROBE_MASK 0
#endif
#ifndef PROBE_SP
#define PROBE_SP 1
#endif
#define PROBE_REPS(k) ((((PROBE_MASK) >> (k)) & 1) + 1)
#ifndef MK_ONE_LAUNCH
#define MK_ONE_LAUNCH 1
#endif

#define DM 2048
#define NB 4
#define SEQ 4096
#define CTXL 256
#define BW 512
#define NLAT 16384
#define NCTX 1024
#define NTOK 17408
#define IN_W 13856
#define LDP 14080
#define HY_OFF 0
#define ML_OFF 1536
#define S5_OFF 3600
#define SSD_OFF 4112
#define GATE_OFF 5664
#define NEXP 16
#define DEXP 1536
#define MOE_ROWS 2176
#define MOE_PAD 2304
#define NTHR 512
#define LDS_BYTES 147456
#define LAS __attribute__((address_space(3)))

typedef unsigned short bf16_t;
typedef short bf16x8 __attribute__((ext_vector_type(8)));
typedef float f32x4 __attribute__((ext_vector_type(4)));
typedef unsigned u32x4 __attribute__((ext_vector_type(4)));
typedef unsigned u32x2 __attribute__((ext_vector_type(2)));

#define XB_TMO      128
#define XB_XCNT(j)  (256  + 64 * (j))
#define XB_XSUB(j)  (1280 + 64 * (j))
#define XB_XGEN(j)  (2304 + 64 * (j))
#define XB_TOP      3328
#define XB_TOPGEN   3392
#define XCD_BAR_WORDS 3456
#define XB_SPIN_CAP (1u << 18)
__device__ __forceinline__ unsigned xb_ld(unsigned* p)              { return __hip_atomic_load(p, __ATOMIC_RELAXED, __HIP_MEMORY_SCOPE_AGENT); }
__device__ __forceinline__ unsigned xb_add(unsigned* p, unsigned v) { return __hip_atomic_fetch_add(p, v, __ATOMIC_RELAXED, __HIP_MEMORY_SCOPE_AGENT); }
__device__ __forceinline__ unsigned xb_xcc_id() { return (unsigned)__builtin_amdgcn_s_getreg((3 << 11) | 20) & 0xFu; }
#define XB_SPIN(cond, bar) do { unsigned _sp = 0; while (cond) { __builtin_amdgcn_s_sleep(1); \
    if ((++_sp & 255u) == 0u) { if (xb_ld(&(bar)[XB_TMO])) break; if (_sp > XB_SPIN_CAP) { atomicAdd(&(bar)[XB_TMO], 1u); break; } } } } while (0)
struct XcdBarrier { unsigned* bar; unsigned x; volatile LAS unsigned* st; };
__device__ __forceinline__ XcdBarrier xcd_barrier_post(unsigned* bar, volatile LAS unsigned* st) {
    XcdBarrier b; b.bar = bar; b.x = xb_xcc_id(); b.st = st;
    if (threadIdx.x == 0) (void)xb_add(&bar[XB_XCNT(b.x)], 1u);
    return b;
}
__device__ __forceinline__ void xcd_barrier_complete(unsigned* bar, unsigned x, unsigned& nloc, unsigned& nx) {
    const unsigned G = gridDim.x * gridDim.y * gridDim.z;
    unsigned sum, cnt, mine, sp = 0u;
    for (;;) {
        sum = 0u; cnt = 0u; mine = 0u;
#pragma unroll
        for (unsigned j = 0; j < 16; ++j) { const unsigned c = xb_ld(&bar[XB_XCNT(j)]); sum += c; cnt += (c > 0u) ? 1u : 0u; mine = (j == x) ? c : mine; }
        if (sum == G) break;
        __builtin_amdgcn_s_sleep(1);
        if ((++sp & 255u) == 0u) { if (xb_ld(&bar[XB_TMO])) break; if (sp > XB_SPIN_CAP) { atomicAdd(&bar[XB_TMO], 1u); break; } }
    }
    nloc = mine > 0u ? mine : 1u; nx = cnt > 0u ? cnt : 1u;
}
__device__ __forceinline__ void xcd_barrier(const XcdBarrier& b) {
    asm volatile("s_waitcnt vmcnt(0)" ::: "memory");
    __syncthreads();
    if (threadIdx.x == 0) {
        unsigned* bar = b.bar;
        __builtin_amdgcn_s_waitcnt(0);
        unsigned nloc = b.st[0], nx = b.st[1];
        if (nloc == 0u) { xcd_barrier_complete(bar, b.x, nloc, nx); b.st[0] = nloc; b.st[1] = nx; }
        const unsigned old = xb_add(&bar[XB_XSUB(b.x)], 1u);
        const unsigned gen = old / nloc;
        if (old + 1u == (gen + 1u) * nloc) {
            __builtin_amdgcn_fence(__ATOMIC_RELEASE, "agent");
            asm volatile("s_waitcnt vmcnt(0)" ::: "memory");
            const unsigned og = xb_add(&bar[XB_TOP], 1u);
            const unsigned tg = og / nx;
            if (og + 1u == (tg + 1u) * nx) xb_add(&bar[XB_TOPGEN], 1u);
            else XB_SPIN(xb_ld(&bar[XB_TOPGEN]) == tg, bar);
            __builtin_amdgcn_fence(__ATOMIC_ACQUIRE, "agent");
            xb_add(&bar[XB_XGEN(b.x)], 1u);
            asm volatile("s_waitcnt vmcnt(0)" ::: "memory");
        } else {
            XB_SPIN(xb_ld(&bar[XB_XGEN(b.x)]) == gen, bar);
            __builtin_amdgcn_fence(__ATOMIC_ACQUIRE, "agent");
            asm volatile("s_waitcnt vmcnt(0)" ::: "memory");
        }
    }
    __syncthreads();
}

__device__ __forceinline__ unsigned short f2bf(float f) { unsigned u = __float_as_uint(f); u += 0x7FFFu + ((u >> 16) & 1u); return (unsigned short)(u >> 16); }
__device__ __forceinline__ float bf2f(unsigned short b) { return __uint_as_float(((unsigned)b) << 16); }
__device__ __forceinline__ unsigned pk2(float lo, float hi) { unsigned r; asm("v_cvt_pk_bf16_f32 %0, %1, %2" : "=v"(r) : "v"(lo), "v"(hi)); return r; }
__device__ __forceinline__ float sigmoidf_(float x) { return 1.0f / (1.0f + expf(-x)); }
__device__ __forceinline__ float siluf_(float x) { return x / (1.0f + expf(-x)); }
__device__ __forceinline__ float wave_sum(float v) {
#pragma unroll
    for (int o = 32; o >= 1; o >>= 1) v += __shfl_xor(v, o);
    return v;
}
__device__ __forceinline__ const float* uptr(const float* p) { const unsigned long long v = (unsigned long long)p;
    const unsigned lo = __builtin_amdgcn_readfirstlane((unsigned)v), hi = __builtin_amdgcn_readfirstlane((unsigned)(v >> 32)); return (const float*)(((unsigned long long)hi << 32) | lo); }
#define PT(k) uptr(ptab[k])
__device__ __forceinline__ int step_tok(int b, int dir, int i) {
    if (i < CTXL) { const int tt = dir ? (CTXL - 1 - i) : i; return NLAT + b * CTXL + tt; }
    const int j = i - CTXL; const int tt = dir ? (SEQ - 1 - j) : j; return b * SEQ + tt;
}
__device__ __forceinline__ void unpack8(const u32x4 w, float (&f)[8]) {
    f[0] = __uint_as_float(w.x << 16); f[1] = __uint_as_float(w.x & 0xFFFF0000u); f[2] = __uint_as_float(w.y << 16); f[3] = __uint_as_float(w.y & 0xFFFF0000u);
    f[4] = __uint_as_float(w.z << 16); f[5] = __uint_as_float(w.z & 0xFFFF0000u); f[6] = __uint_as_float(w.w << 16); f[7] = __uint_as_float(w.w & 0xFFFF0000u);
}

namespace pg8 {
constexpr int BM = 256, BK = 64, HALF = 128, HTB = HALF * BK * 2, STAGE_BYTES = 8 * HTB, NXCD = 8, WGM = 8;
__host__ __device__ __forceinline__ int lds_byte(int r, int c) { const int st = (r >> 4) * 2 + (c >> 5), rr = r & 15, cc = c & 31, ob = rr * 64 + cc * 2; return st * 1024 + (ob ^ (((ob >> 9) & 1) << 5)); }
__host__ __device__ __forceinline__ void stage_rc(int b, int& R, int& C) { const int st = b / 1024, sb = b % 1024, swz = sb ^ (((sb >> 9) & 1) << 5); R = (st >> 1) * 16 + swz / 64; C = (st & 1) * 32 + (swz % 64) / 2; }
__host__ __device__ __forceinline__ int perm32(int rho) { const int n = rho >> 4, i = rho & 15; return 8 * (i >> 2) + 4 * n + (i & 3); }
struct Unit { int pm, pn, z, k; long long ao, bo; };
struct Gemm { const bf16_t* A; const bf16_t* Bt; int lda, ldb, K; };

__device__ __forceinline__ void tile_of(int wgid, int nM, int nN, int& pm, int& pn) {
    const int nwg = nM * nN; { const int q = nwg / NXCD, r = nwg % NXCD, xcd = wgid % NXCD, off = wgid / NXCD; wgid = (xcd < r ? xcd * (q + 1) : r * (q + 1) + (xcd - r) * q) + off; }
    const int nig = WGM * nN, gid = wgid / nig, fm = gid * WGM, gsz = (nM - fm) < WGM ? (nM - fm) : WGM;
    pm = fm + ((wgid % nig) % gsz); pn = (wgid % nig) / gsz;
}
struct SchedStd {
    int nM, nN, G, c, lda, ldb;
    __device__ __forceinline__ bool next(int i, Unit& u) const { const long L = (long)i * G + c; if (L >= (long)nM * nN) return false; tile_of((int)L, nM, nN, u.pm, u.pn); u.z = 0; u.k = 0;
        u.ao = (long long)u.pm * BM * lda * 2; u.bo = (long long)u.pn * BM * ldb * 2; return true; }
    __device__ __forceinline__ void a_ready(const Unit&) const {}
    __device__ __forceinline__ void done(const Unit&) const {}
};
struct SchedBranch {
    int nM, nN, G, c;
    __device__ __forceinline__ bool next(int i, Unit& u) const { const long L = (long)(i >> 2) * G + c; if (L >= (long)nM * nN) return false; tile_of((int)L, nM, nN, u.pm, u.pn); u.z = 0; u.k = i & 3;
        u.ao = ((long long)u.pm * BM * DM + u.k * BW) * 2; u.bo = ((long long)u.k * DM + u.pn * BM) * BW * 2; return true; }
    __device__ __forceinline__ void a_ready(const Unit&) const {}
    __device__ __forceinline__ void done(const Unit&) const {}
};
struct SchedMoe {
    int nPm, nPn, G, c, lda, ldb, nBrows;
    __device__ __forceinline__ bool next(int i, Unit& u) const { const long L = (long)i * G + c; const int per = nPm * nPn; if (L >= (long)NEXP * per) return false; const int e = (int)(L / per), rem = (int)(L % per);
        u.z = e; u.k = 0; u.pm = rem % nPm; u.pn = rem / nPm; u.ao = ((long long)e * MOE_PAD + u.pm * BM) * lda * 2; u.bo = ((long long)e * nBrows + u.pn * BM) * ldb * 2; return true; }
    __device__ __forceinline__ void a_ready(const Unit&) const {}
    __device__ __forceinline__ void done(const Unit&) const {}
};

typedef f32x4 Acc[2][2][4][2];
template <class Epi, class Sched>
__device__ __forceinline__ void gemm_phase(LAS unsigned char* lds, const Gemm g, const Sched& S, const Epi& E) {
    int tid = threadIdx.x; asm volatile("" : "+v"(tid));
    const int wid = __builtin_amdgcn_readfirstlane(tid >> 6), lane = tid & 63, wr = wid >> 2, wc = wid & 3, fr = lane & 15, fq = lane >> 4;
    const int K = g.K, nt = K / BK;
    unsigned voffA[2], voffB[2];
#pragma unroll
    for (int i = 0; i < 2; ++i) { int R, C; stage_rc(tid * 16 + i * 8192, R, C); const int Rb = Epi::PERM ? ((R & ~31) + perm32(R & 31)) : R;
        voffA[i] = (unsigned)(R * g.lda + C) * 2u; voffB[i] = (unsigned)(Rb * g.ldb + C) * 2u; }
    const size_t kstep = (size_t)(BK * 2);
    const size_t hstepA = (size_t)HALF * g.lda * 2, hstepB = (size_t)HALF * g.ldb * 2;
    const unsigned ldsw = (unsigned)wid * 1024u;
    const int aoff = lds_byte(wr * 64 + fr, fq * 8), boff = lds_byte(wc * 32 + fr, fq * 8);
#define PG8_SA(b, h) (((b) * 2 + (h)) * HTB)
#define PG8_SB(b, h) ((4 + (b) * 2 + (h)) * HTB)
#define PG8_STAGE(bufoff, gbase, voff) do { _Pragma("unroll") for (int _i = 0; _i < 2; ++_i) \
        __builtin_amdgcn_global_load_lds((const unsigned*)((const char*)(gbase) + (voff)[_i]), (LAS unsigned*)(lds + (bufoff) + ldsw + _i * 8192), 16, 0, 0); } while (0)
#define PG8_LDA(dst, b, h) do { _Pragma("unroll") for (int m = 0; m < 4; ++m) _Pragma("unroll") for (int k = 0; k < 2; ++k) dst[m][k] = *(const LAS bf16x8*)(lds + PG8_SA(b, h) + aoff + m * 2048 + k * 1024); } while (0)
#define PG8_LDB(dst, b, h) do { _Pragma("unroll") for (int n = 0; n < 2; ++n) _Pragma("unroll") for (int k = 0; k < 2; ++k) dst[n][k] = *(const LAS bf16x8*)(lds + PG8_SB(b, h) + boff + n * 2048 + k * 1024); } while (0)
#define PG8_MMA(ai, bj, At, Bt) do { __builtin_amdgcn_s_setprio(1); _Pragma("unroll") for (int m = 0; m < 4; ++m) _Pragma("unroll") for (int n = 0; n < 2; ++n) _Pragma("unroll") for (int k = 0; k < 2; ++k) \
        acc[ai][bj][m][n] = __builtin_amdgcn_mfma_f32_16x16x32_bf16(Bt[n][k], At[m][k], acc[ai][bj][m][n], 0, 0, 0); __builtin_amdgcn_s_setprio(0); } while (0)
#define PG8_WAIT_V(n) asm volatile("s_waitcnt vmcnt(" #n ")" ::: "memory")
#define PG8_WAIT_L(n) asm volatile("s_waitcnt lgkmcnt(" #n ")" ::: "memory")
#define PG8_BAR __builtin_amdgcn_s_barrier()
#define PG8_SCHED __builtin_amdgcn_sched_barrier(0)
    Unit cur, nxt; int ui = 0;
    if (!S.next(0, cur)) return;
    Acc acc;
#pragma unroll
    for (int a = 0; a < 2; ++a)
#pragma unroll
        for (int b = 0; b < 2; ++b)
#pragma unroll
            for (int m = 0; m < 4; ++m)
#pragma unroll
                for (int n = 0; n < 2; ++n) acc[a][b][m][n] = (f32x4){0.f, 0.f, 0.f, 0.f};
    bf16x8 At[4][2], B0[2][2], B1[2][2];
    const char* cA = (const char*)g.A + cur.ao; const char* cB = (const char*)g.Bt + cur.bo;
    S.a_ready(cur);
    PG8_STAGE(PG8_SB(0, 0), cB, voffB); PG8_STAGE(PG8_SA(0, 0), cA, voffA); PG8_STAGE(PG8_SB(0, 1), cB + hstepB, voffB); PG8_STAGE(PG8_SA(0, 1), cA + hstepA, voffA);
    if (wr == 1) PG8_BAR;
    PG8_WAIT_V(4); PG8_BAR;
    PG8_STAGE(PG8_SB(1, 0), cB + kstep, voffB); PG8_STAGE(PG8_SA(1, 0), cA + kstep, voffA); PG8_STAGE(PG8_SB(1, 1), cB + hstepB + kstep, voffB);
    PG8_WAIT_V(6); PG8_BAR;
    for (;;) {
        const bool has_next = S.next(ui + 1, nxt);
        const char* nA = has_next ? (const char*)g.A + nxt.ao : cA; const char* nB = has_next ? (const char*)g.Bt + nxt.bo : cB;
        for (int t = 0; t < nt; t += 2) {
            const bool last = (t == nt - 2);
            const char* a1 = cA + (size_t)(t + 1) * kstep;
            const char* a2 = last ? nA : cA + (size_t)(t + 2) * kstep; const char* b2 = last ? nB : cB + (size_t)(t + 2) * kstep;
            const char* a3 = a2 + kstep; const char* b3 = b2 + kstep;
            if (last && has_next) S.a_ready(nxt);
            PG8_LDB(B0, 0, 0); PG8_SCHED; PG8_LDA(At, 0, 0); PG8_STAGE(PG8_SA(1, 1), a1 + hstepA, voffA);
            PG8_WAIT_L(8); PG8_BAR; PG8_WAIT_L(0); PG8_MMA(0, 0, At, B0); PG8_BAR; PG8_SCHED;
            PG8_LDB(B1, 0, 1); PG8_STAGE(PG8_SB(0, 0), b2, voffB);
            PG8_BAR; PG8_WAIT_L(0); PG8_MMA(0, 1, At, B1); PG8_BAR;
            PG8_LDA(At, 0, 1); PG8_STAGE(PG8_SA(0, 0), a2, voffA);
            PG8_BAR; PG8_WAIT_L(0); PG8_MMA(1, 0, At, B0); PG8_BAR; PG8_SCHED;
            PG8_STAGE(PG8_SB(0, 1), b2 + hstepB, voffB);
            PG8_WAIT_V(6); PG8_BAR; PG8_MMA(1, 1, At, B1); PG8_BAR;
            PG8_LDB(B0, 1, 0); PG8_SCHED; PG8_LDA(At, 1, 0); PG8_STAGE(PG8_SA(0, 1), a2 + hstepA, voffA);
            PG8_WAIT_L(8); PG8_BAR; PG8_WAIT_L(0); PG8_MMA(0, 0, At, B0); PG8_BAR; PG8_SCHED;
            PG8_LDB(B1, 1, 1); PG8_STAGE(PG8_SB(1, 0), b3, voffB);
            PG8_BAR; PG8_WAIT_L(0); PG8_MMA(0, 1, At, B1); PG8_BAR;
            PG8_LDA(At, 1, 1); PG8_STAGE(PG8_SA(1, 0), a3, voffA);
            PG8_BAR; PG8_WAIT_L(0); PG8_MMA(1, 0, At, B0); PG8_BAR; PG8_SCHED;
            PG8_STAGE(PG8_SB(1, 1), b3 + hstepB, voffB);
            PG8_WAIT_V(6); PG8_BAR; PG8_MMA(1, 1, At, B1); PG8_BAR;
        }
        const bool keep = E(acc, cur, wr, wc, fr, fq); S.done(cur);
        if (!has_next) break;
        if (!keep) {
#pragma unroll
        for (int a = 0; a < 2; ++a)
#pragma unroll
            for (int b = 0; b < 2; ++b)
#pragma unroll
                for (int m = 0; m < 4; ++m)
#pragma unroll
                    for (int n = 0; n < 2; ++n) acc[a][b][m][n] = (f32x4){0.f, 0.f, 0.f, 0.f};
        }
        cur = nxt; cA = nA; cB = nB; ++ui;
    }
    PG8_WAIT_V(0);
    if (wr == 0) PG8_BAR;
    PG8_BAR;
#undef PG8_SA
#undef PG8_SB
#undef PG8_STAGE
#undef PG8_LDA
#undef PG8_LDB
#undef PG8_MMA
#undef PG8_WAIT_V
#undef PG8_WAIT_L
#undef PG8_BAR
#undef PG8_SCHED
}

struct EpiBf16Store {
    static constexpr bool PERM = true;
    bf16_t* O; int ldc;
    __device__ __forceinline__ bool operator()(Acc& acc, const Unit& u, int wr, int wc, int fr, int fq) const {
        const int row0 = u.pm * BM + wr * 64 + fr, col0 = u.pn * BM + wc * 32 + 8 * fq;
#pragma unroll
        for (int ai = 0; ai < 2; ++ai)
#pragma unroll
            for (int m = 0; m < 4; ++m) { bf16_t* rowp = O + (size_t)(row0 + ai * HALF + m * 16) * ldc + col0;
#pragma unroll
                for (int bj = 0; bj < 2; ++bj) { const f32x4 v0 = acc[ai][bj][m][0], v1 = acc[ai][bj][m][1];
                    u32x4 w; w.x = pk2(v0[0], v0[1]); w.y = pk2(v0[2], v0[3]); w.z = pk2(v1[0], v1[1]); w.w = pk2(v1[2], v1[3]);
                    *(u32x4*)(rowp + bj * HALF) = w; } }
        return false;
    }
};
struct EpiWin {
    static constexpr bool PERM = true;
    bf16_t* O; int ldc;
    __device__ __forceinline__ bool operator()(Acc& acc, const Unit& u, int wr, int wc, int fr, int fq) const {
        const int row0 = u.pm * BM + wr * 64 + fr, col0 = u.pn * BM + wc * 32 + 8 * fq;
#pragma unroll
        for (int bj = 0; bj < 2; ++bj) { const bool gate = (col0 + bj * HALF) >= GATE_OFF;
#pragma unroll
            for (int ai = 0; ai < 2; ++ai)
#pragma unroll
                for (int m = 0; m < 4; ++m) { f32x4 v0 = acc[ai][bj][m][0], v1 = acc[ai][bj][m][1];
                    if (gate) {
#pragma unroll
                        for (int j = 0; j < 4; ++j) { v0[j] = __builtin_amdgcn_rcpf(1.0f + __expf(-v0[j])); v1[j] = __builtin_amdgcn_rcpf(1.0f + __expf(-v1[j])); } }
                    u32x4 w; w.x = pk2(v0[0], v0[1]); w.y = pk2(v0[2], v0[3]); w.z = pk2(v1[0], v1[1]); w.w = pk2(v1[2], v1[3]);
                    *(u32x4*)(O + (size_t)(row0 + ai * HALF + m * 16) * ldc + col0 + bj * HALF) = w; } }
        return false;
    }
};
struct EpiNone { static constexpr bool PERM = true;
    __device__ __forceinline__ bool operator()(Acc& acc, const Unit&, int, int, int, int) const {
#pragma unroll
        for (int a = 0; a < 2; ++a)
#pragma unroll
            for (int b = 0; b < 2; ++b)
#pragma unroll
                for (int m = 0; m < 4; ++m)
#pragma unroll
                    for (int n = 0; n < 2; ++n) asm volatile("" :: "v"(acc[a][b][m][n]));
        return false; } };
struct EpiGlu {
    static constexpr bool PERM = true;
    const bf16_t* GG; const float* bias; bf16_t* Y4;
    __device__ __forceinline__ bool operator()(Acc& acc, const Unit& u, int wr, int wc, int fr, int fq) const {
        const int row0 = u.pm * BM + wr * 64 + fr, col0 = u.pn * BM + wc * 32 + 8 * fq;
#pragma unroll
        for (int bj = 0; bj < 2; ++bj) { const int col = col0 + bj * HALF; const f32x4 b0 = *(const f32x4*)(bias + col), b1 = *(const f32x4*)(bias + col + 4);
#pragma unroll
            for (int ai = 0; ai < 2; ++ai)
#pragma unroll
                for (int m = 0; m < 4; ++m) { const size_t row = (size_t)(row0 + ai * HALF + m * 16);
                    float gg[8]; unpack8(*(const u32x4*)(GG + row * BW + col), gg);
                    const f32x4 v0 = acc[ai][bj][m][0] + b0, v1 = acc[ai][bj][m][1] + b1;
                    u32x4 w; w.x = pk2(gg[0] * sigmoidf_(v0[0]), gg[1] * sigmoidf_(v0[1])); w.y = pk2(gg[2] * sigmoidf_(v0[2]), gg[3] * sigmoidf_(v0[3]));
                    w.z = pk2(gg[4] * sigmoidf_(v1[0]), gg[5] * sigmoidf_(v1[1])); w.w = pk2(gg[6] * sigmoidf_(v1[2]), gg[7] * sigmoidf_(v1[3]));
                    *(u32x4*)(Y4 + row * DM + 1024 + col) = w; } }
        return false;
    }
};
struct EpiBranch {
    static constexpr bool PERM = true;
    const bf16_t* P; bf16_t* ACCb;
    __device__ __forceinline__ bool operator()(Acc& acc, const Unit& u, int wr, int wc, int fr, int fq) const {
        const int row0 = u.pm * BM + wr * 64 + fr, col0 = u.pn * BM + wc * 32 + 8 * fq; const int k = u.k;
        const bf16_t* gbase = P + (size_t)row0 * LDP + GATE_OFF + k * DM + col0;
        if (k < 3) {
#pragma unroll
            for (int ai = 0; ai < 2; ++ai) {
                u32x4 ga[8], gb[8];
#pragma unroll
                for (int m = 0; m < 4; ++m)
#pragma unroll
                    for (int bj = 0; bj < 2; ++bj) { const bf16_t* p = gbase + (size_t)(ai * HALF + m * 16) * LDP + bj * HALF; ga[m * 2 + bj] = *(const u32x4*)p; gb[m * 2 + bj] = *(const u32x4*)(p + DM); }
#pragma unroll
                for (int m = 0; m < 4; ++m)
#pragma unroll
                    for (int bj = 0; bj < 2; ++bj) { float g0[8], g1[8]; unpack8(ga[m * 2 + bj], g0); unpack8(gb[m * 2 + bj], g1);
                        float s[8];
#pragma unroll
                        for (int j = 0; j < 8; ++j) s[j] = g0[j] * __builtin_amdgcn_rcpf(g1[j]);
                        f32x4 v0 = acc[ai][bj][m][0], v1 = acc[ai][bj][m][1];
                        v0[0] *= s[0]; v0[1] *= s[1]; v0[2] *= s[2]; v0[3] *= s[3]; v1[0] *= s[4]; v1[1] *= s[5]; v1[2] *= s[6]; v1[3] *= s[7];
                        acc[ai][bj][m][0] = v0; acc[ai][bj][m][1] = v1; } }
            return true;
        }
#pragma unroll
        for (int ai = 0; ai < 2; ++ai) {
            u32x4 ga[8];
#pragma unroll
            for (int m = 0; m < 4; ++m)
#pragma unroll
                for (int bj = 0; bj < 2; ++bj) ga[m * 2 + bj] = *(const u32x4*)(gbase + (size_t)(ai * HALF + m * 16) * LDP + bj * HALF);
#pragma unroll
            for (int m = 0; m < 4; ++m)
#pragma unroll
                for (int bj = 0; bj < 2; ++bj) { float s[8]; unpack8(ga[m * 2 + bj], s);
                    f32x4 v0 = acc[ai][bj][m][0], v1 = acc[ai][bj][m][1];
                    v0[0] *= s[0]; v0[1] *= s[1]; v0[2] *= s[2]; v0[3] *= s[3]; v1[0] *= s[4]; v1[1] *= s[5]; v1[2] *= s[6]; v1[3] *= s[7];
                    u32x4 w; w.x = pk2(v0[0], v0[1]); w.y = pk2(v0[2], v0[3]); w.z = pk2(v1[0], v1[1]); w.w = pk2(v1[2], v1[3]);
                    *(u32x4*)(ACCb + (size_t)(row0 + ai * HALF + m * 16) * DM + col0 + bj * HALF) = w; } }
        return false;
    }
};
struct EpiResid {
    static constexpr bool PERM = false;
    float* XS; const float* srcLat; const float* srcCtx; const float* MODl; int gidx;
    __device__ __forceinline__ bool operator()(Acc& acc, const Unit& u, int wr, int wc, int fr, int fq) const {
        const int row0 = u.pm * BM + wr * 64 + fr, col0 = u.pn * BM + wc * 32 + 4 * fq;
        const int r = (u.pm * BM) < NLAT ? (u.pm * BM) / SEQ : 4;
        const float* src = (u.pm * BM) < NLAT ? srcLat : srcCtx;
        const float* mg = MODl + (size_t)(r * 6 + gidx) * DM;
#pragma unroll
        for (int bj = 0; bj < 2; ++bj)
#pragma unroll
            for (int n = 0; n < 2; ++n) { const int col = col0 + bj * HALF + n * 16; const f32x4 gm = *(const f32x4*)(mg + col);
#pragma unroll
                for (int ai = 0; ai < 2; ++ai)
#pragma unroll
                    for (int m = 0; m < 4; ++m) { const size_t o = (size_t)(row0 + ai * HALF + m * 16) * DM + col; *(f32x4*)(XS + o) = *(const f32x4*)(src + o) + gm * acc[ai][bj][m][n]; } }
        return false;
    }
};
struct EpiMoe1 {
    static constexpr bool PERM = true;
    bf16_t* HID;
    __device__ __forceinline__ bool operator()(Acc& acc, const Unit& u, int wr, int wc, int fr, int fq) const {
        const size_t row0 = (size_t)u.z * MOE_PAD + u.pm * BM + wr * 64 + fr; const int col0 = u.pn * HALF + wc * 32 + 8 * fq;
#pragma unroll
        for (int ai = 0; ai < 2; ++ai)
#pragma unroll
            for (int m = 0; m < 4; ++m) { const f32x4 g0 = acc[ai][0][m][0], g1 = acc[ai][0][m][1], u0 = acc[ai][1][m][0], u1 = acc[ai][1][m][1];
                float h[8];
#pragma unroll
                for (int j = 0; j < 4; ++j) { h[j] = g0[j] * __builtin_amdgcn_rcpf(1.0f + __expf(-g0[j])) * u0[j]; h[4 + j] = g1[j] * __builtin_amdgcn_rcpf(1.0f + __expf(-g1[j])) * u1[j]; }
                u32x4 w; w.x = pk2(h[0], h[1]); w.y = pk2(h[2], h[3]); w.z = pk2(h[4], h[5]); w.w = pk2(h[6], h[7]);
                *(u32x4*)(HID + (row0 + ai * HALF + m * 16) * DEXP + col0) = w; }
        return false;
    }
};
struct EpiMoeY {
    static constexpr bool PERM = true;
    bf16_t* O;
    __device__ __forceinline__ bool operator()(Acc& acc, const Unit& u, int wr, int wc, int fr, int fq) const {
        const size_t row0 = (size_t)u.z * MOE_PAD + u.pm * BM + wr * 64 + fr; const int col0 = u.pn * BM + wc * 32 + 8 * fq;
#pragma unroll
        for (int ai = 0; ai < 2; ++ai)
#pragma unroll
            for (int m = 0; m < 4; ++m) { bf16_t* rowp = O + (row0 + ai * HALF + m * 16) * DM + col0;
#pragma unroll
                for (int bj = 0; bj < 2; ++bj) { const f32x4 v0 = acc[ai][bj][m][0], v1 = acc[ai][bj][m][1];
                    u32x4 w; w.x = pk2(v0[0], v0[1]); w.y = pk2(v0[2], v0[3]); w.z = pk2(v1[0], v1[1]); w.w = pk2(v1[2], v1[3]);
                    *(u32x4*)(rowp + bj * HALF) = w; } }
        return false;
    }
};

struct SchedS5a {
    int c;
    __device__ __forceinline__ bool next(int i, Unit& u) const { if (i > 0 || c >= 64) return false; u.z = c >> 1; u.pm = c & 1; u.pn = 0; u.k = 0;
        u.ao = ((long long)u.z * 512 + u.pm * BM) * 768 * 2; u.bo = (long long)u.z * 256 * 512 * 2; return true; }
    __device__ __forceinline__ void a_ready(const Unit&) const {}
    __device__ __forceinline__ void done(const Unit&) const {}
};
struct SchedS5b {
    int c;
    __device__ __forceinline__ bool next(int i, Unit& u) const { if (i > 0 || c >= 128) return false; u.z = c >> 2; u.pm = (c >> 1) & 1; u.pn = c & 1; u.k = 0;
        u.ao = ((long long)u.z * 512 + u.pm * BM) * 768 * 2; u.bo = ((long long)u.z * 512 + u.pn * BM) * 768 * 2; return true; }
    __device__ __forceinline__ void a_ready(const Unit&) const {}
    __device__ __forceinline__ void done(const Unit&) const {}
};
struct EpiXloc {
    static constexpr bool PERM = false;
    float* XL;
    __device__ __forceinline__ bool operator()(Acc& acc, const Unit& u, int wr, int wc, int fr, int fq) const {
        const int row0 = u.pm * BM + wr * 64 + fr, col0 = wc * 32 + 4 * fq; float* base = XL + (size_t)u.z * 512 * 256;
#pragma unroll
        for (int ai = 0; ai < 2; ++ai)
#pragma unroll
            for (int m = 0; m < 4; ++m) { float* rowp = base + (size_t)(row0 + ai * HALF + m * 16) * 256 + col0;
#pragma unroll
                for (int bj = 0; bj < 2; ++bj)
#pragma unroll
                    for (int n = 0; n < 2; ++n) *(f32x4*)(rowp + bj * HALF + n * 16) = acc[ai][bj][m][n]; }
        return false;
    }
};
struct EpiS5Out {
    static constexpr bool PERM = true;
    const bf16_t* P; const float* dskip; bf16_t* GG;
    __device__ __forceinline__ bool operator()(Acc& acc, const Unit& u, int wr, int wc, int fr, int fq) const {
        const int row0 = u.pm * BM + wr * 64 + fr, col0 = u.pn * BM + wc * 32 + 8 * fq; const int g = u.z;
#pragma unroll
        for (int bj = 0; bj < 2; ++bj) { const int col = col0 + bj * HALF; const int t = col >> 4, c0 = col & 15;
            const f32x4 d0 = *(const f32x4*)(dskip + g * 16 + c0), d1 = *(const f32x4*)(dskip + g * 16 + c0 + 4);
#pragma unroll
            for (int ai = 0; ai < 2; ++ai)
#pragma unroll
                for (int m = 0; m < 4; ++m) { const size_t tok = (size_t)(row0 + ai * HALF + m * 16) * 32 + t;
                    float uu[8]; unpack8(*(const u32x4*)(P + tok * LDP + S5_OFF + g * 16 + c0), uu);
                    const f32x4 v0 = acc[ai][bj][m][0], v1 = acc[ai][bj][m][1];
                    float y[8] = {v0[0] + d0[0] * uu[0], v0[1] + d0[1] * uu[1], v0[2] + d0[2] * uu[2], v0[3] + d0[3] * uu[3], v1[0] + d1[0] * uu[4], v1[1] + d1[1] * uu[5], v1[2] + d1[2] * uu[6], v1[3] + d1[3] * uu[7]};
#pragma unroll
                    for (int j = 0; j < 8; ++j) y[j] = 0.5f * y[j] * (1.0f + tanhf(0.7978845608028654f * (y[j] + 0.044715f * y[j] * y[j] * y[j])));
                    u32x4 w; w.x = pk2(y[0], y[1]); w.y = pk2(y[2], y[3]); w.z = pk2(y[4], y[5]); w.w = pk2(y[6], y[7]);
                    *(u32x4*)(GG + tok * BW + g * 16 + c0) = w; } }
        return false;
    }
};
}


__device__ __forceinline__ float wave_scan_incl(float v, int lane) {
#pragma unroll
    for (int o = 1; o < 64; o <<= 1) { const float t = __shfl_up(v, o); if (lane >= o) v += t; }
    return v;
}
__device__ __forceinline__ float wave_scanmax_incl(float v, int lane) {
#pragma unroll
    for (int o = 1; o < 64; o <<= 1) { const float t = __shfl_up(v, o); if (lane >= o) v = fmaxf(v, t); }
    return v;
}
__device__ __forceinline__ float wave_max(float v) {
#pragma unroll
    for (int o = 32; o >= 1; o >>= 1) v = fmaxf(v, __shfl_xor(v, o));
    return v;
}
__device__ __forceinline__ void unpack8h(const u32x4 w, bf16_t (&h)[8]) {
    h[0] = (bf16_t)(w.x & 0xFFFFu); h[1] = (bf16_t)(w.x >> 16); h[2] = (bf16_t)(w.y & 0xFFFFu); h[3] = (bf16_t)(w.y >> 16);
    h[4] = (bf16_t)(w.z & 0xFFFFu); h[5] = (bf16_t)(w.z >> 16); h[6] = (bf16_t)(w.w & 0xFFFFu); h[7] = (bf16_t)(w.w >> 16);
}

__device__ __forceinline__ int tokblock_of(int b, int dir, int c) { if (c < 4) return 256 + b * 4 + (dir ? 3 - c : c); const int j = c - 4; return b * 64 + (dir ? 63 - j : j); }
__device__ __forceinline__ u32x4 rev8h(const u32x4 v) { u32x4 r; r.x = (v.w >> 16) | (v.w << 16); r.y = (v.z >> 16) | (v.z << 16); r.z = (v.y >> 16) | (v.y << 16); r.w = (v.x >> 16) | (v.x << 16); return r; }
__device__ __forceinline__ u32x4 scale8h(const u32x4 v, const float4 a, const float4 b) { float f[8]; unpack8(v, f); u32x4 r; r.x = pk2(f[0] * a.x, f[1] * a.y); r.y = pk2(f[2] * a.z, f[3] * a.w); r.z = pk2(f[4] * b.x, f[5] * b.y); r.w = pk2(f[6] * b.z, f[7] * b.w); return r; }
__device__ __forceinline__ float dot8h(const u32x4 v, const float4 a, const float4 b) { float f[8]; unpack8(v, f); return (f[0] * a.x + f[1] * a.y) + (f[2] * a.z + f[3] * a.w) + (f[4] * b.x + f[5] * b.y) + (f[6] * b.z + f[7] * b.w); }
#define ML_FRAG_LOAD(KF, VF, cc_) do { const int tb_ = tokblock_of(b, dir, (cc_)); const bf16_t* kb_ = KTg + ((size_t)tb_ * 512 + h * 128 + 32 * wd + r16) * 64 + q4 * 8; const bf16_t* vb_ = VTg + ((size_t)tb_ * 512 + h * 128 + 64 * half + 32 * we + r16) * 64 + q4 * 8; \
        _Pragma("unroll") for (int ks_ = 0; ks_ < 2; ++ks_) _Pragma("unroll") for (int j_ = 0; j_ < 2; ++j_) { VF[j_][ks_] = *(const u32x4*)(vb_ + (size_t)j_ * 16 * 64 + ks_ * 32); KF[j_][ks_] = *(const u32x4*)(kb_ + (size_t)j_ * 16 * 64 + ks_ * 32); } } while (0)
#define ML_CHUNK(c_, KF, VF, KFN, VFN) do { const int c = (c_); \
        if (c + 1 < 68) ML_FRAG_LOAD(KFN, VFN, c + 1);                        \
        const float dec = sDEC[c]; \
        {   bf16_t* cs = CST + (size_t)(chain * 68 + c) * 128 * 128; \
            _Pragma("unroll") for (int je = 0; je < 2; ++je) _Pragma("unroll") for (int jd = 0; jd < 2; ++jd) { const int e = 64 * half + 32 * we + 16 * je + r16, d0 = 32 * wd + 16 * jd + q4 * 4; \
                u32x2 pk; pk.x = pk2(acc[je][jd][0], acc[je][jd][1]); pk.y = pk2(acc[je][jd][2], acc[je][jd][3]); *(u32x2*)(cs + (size_t)e * 128 + d0) = pk; } \
            if (nown) { _Pragma("unroll") for (int jd = 0; jd < 2; ++jd) { float nv = npart[jd]; nv += __shfl_xor(nv, 16); nv += __shfl_xor(nv, 32); if (q4 == 0) NST[(size_t)(chain * 68 + c) * 128 + 32 * wd + 16 * jd + r16] = nv; } } } \
        bf16x8 vfr[2][2]; \
        _Pragma("unroll") for (int ks = 0; ks < 2; ++ks) { const float4 wa = *(const float4*)(sWS + c * 64 + ks * 32 + q4 * 8), wb = *(const float4*)(sWS + c * 64 + ks * 32 + q4 * 8 + 4); \
            _Pragma("unroll") for (int je = 0; je < 2; ++je) { const u32x4 sv = scale8h(VF[je][ks], wa, wb); vfr[je][ks] = *(const bf16x8*)&sv; } \
            if (nown) { _Pragma("unroll") for (int jd = 0; jd < 2; ++jd) npart[jd] = (ks == 0 ? dec * npart[jd] : npart[jd]) + dot8h(KF[jd][ks], wa, wb); } } \
        _Pragma("unroll") for (int je = 0; je < 2; ++je) _Pragma("unroll") for (int jd = 0; jd < 2; ++jd) acc[je][jd] = acc[je][jd] * dec; \
        _Pragma("unroll") for (int ks = 0; ks < 2; ++ks) _Pragma("unroll") for (int je = 0; je < 2; ++je) _Pragma("unroll") for (int jd = 0; jd < 2; ++jd) \
            acc[je][jd] = __builtin_amdgcn_mfma_f32_16x16x32_bf16(*(const bf16x8*)&KF[jd][ks], vfr[je][ks], acc[je][jd], 0, 0, 0); } while (0)
__device__ __forceinline__ void mlstm_state_pass(const int chain, const int half, const bf16_t* __restrict__ Pm, const bf16_t* __restrict__ KTg, const bf16_t* __restrict__ VTg, const float* __restrict__ gate_b,
                                                 bf16_t* __restrict__ CST, float* __restrict__ NST, float* __restrict__ MST, unsigned char* shm, const int tid) {
    const int dir = chain & 1, h = (chain >> 1) & 3, b = chain >> 3, lane = tid & 63, w = tid >> 6, we = w >> 2, wd = w & 3, q4 = lane >> 4, r16 = lane & 15;
    const bool nown = (half == 0) && (we == 0);
    float* sE = (float*)shm; float* sWS = sE + 68 * 64; float* sAL = sWS + 68 * 64; float* sBE = sAL + 68; float* sMO = sBE + 68; float* sDEC = sMO + 68; float* sMB = sDEC + 68;
    const float gbi = gate_b[(dir * 2 + 0) * 4 + h], gbf = gate_b[(dir * 2 + 1) * 4 + h];
    const int gcol_i = ML_OFF + 2048 + (dir * 2 + 0) * 4 + h, gcol_f = ML_OFF + 2048 + (dir * 2 + 1) * 4 + h;
    u32x4 kfA[2][2], vfA[2][2], kfB[2][2], vfB[2][2];
    ML_FRAG_LOAD(kfA, vfA, 0);
    __syncthreads();
    for (int c = w; c < 68; c += 8) { const size_t tokl = (size_t)step_tok(b, dir, c * 64 + lane);
        const float ig = bf2f(Pm[tokl * LDP + gcol_i]) + gbi, fg = bf2f(Pm[tokl * LDP + gcol_f]) + gbf;
        const float lf = fminf(fg, 0.f) - log1pf(expf(-fabsf(fg)));
        const float bcs = wave_scan_incl(lf, lane); const float blast = __shfl(bcs, 63); const float ei = blast - bcs + ig; const float beta = wave_max(ei);
        sE[c * 64 + lane] = ei; if (lane == 0) { sAL[c] = blast; sBE[c] = beta; } }
    __syncthreads();
    if (tid == 0) { float m = 0.f; for (int c = 0; c < 68; ++c) { sMB[c] = m; const float mo = fmaxf(m + sAL[c], sBE[c]); sDEC[c] = expf(sAL[c] + m - mo); sMO[c] = mo; m = mo; } }
    __syncthreads();
    for (int idx = tid; idx < 68 * 64; idx += NTHR) { const int c = idx >> 6, i = idx & 63; sWS[c * 64 + (dir ? 63 - i : i)] = expf(sE[idx] - sMO[c]); }
    if (half == 0 && tid < 68) MST[chain * 68 + tid] = sMB[tid];
    __syncthreads();
    f32x4 acc[2][2];
#pragma unroll
    for (int je = 0; je < 2; ++je)
#pragma unroll
        for (int jd = 0; jd < 2; ++jd) acc[je][jd] = (f32x4){0.f, 0.f, 0.f, 0.f};
    float npart[2] = {0.f, 0.f};
    for (int c2 = 0; c2 < 68; c2 += 2) { ML_CHUNK(c2, kfA, vfA, kfB, vfB); ML_CHUNK(c2 + 1, kfB, vfB, kfA, vfA); }
    __syncthreads();
}
#undef ML_CHUNK
#undef ML_FRAG_LOAD
__device__ __forceinline__ void mlstm_out_item(const int chain, const int c, const bf16_t* __restrict__ Pm, const bf16_t* __restrict__ QKb, const bf16_t* __restrict__ VTg, const float* __restrict__ gate_b,
                                               const bf16_t* __restrict__ CST, const float* __restrict__ NST, const float* __restrict__ MST, float* __restrict__ Hout, unsigned char* shm, const int tid) {
    const int dir = chain & 1, h = (chain >> 1) & 3, b = chain >> 3, lane = tid & 63, w = tid >> 6;
    bf16_t* Qs = (bf16_t*)shm; bf16_t* Ks = (bf16_t*)(shm + 17408); bf16_t* VT = (bf16_t*)(shm + 34816); bf16_t* Cs = (bf16_t*)(shm + 53248); bf16_t* Ss = (bf16_t*)(shm + 88064);
    float* sc = (float*)(shm + 97280);
    __syncthreads();
#pragma unroll
    for (int i = 0; i < 2; ++i) { const int pid = tid + i * 512; const int s = pid >> 4, x0 = (pid & 15) * 8; const size_t toks = (size_t)step_tok(b, dir, c * 64 + s);
        *(u32x4*)(Qs + s * 136 + x0) = *(const u32x4*)(QKb + toks * 1024 + h * 128 + x0);
        *(u32x4*)(Ks + s * 136 + x0) = *(const u32x4*)(QKb + toks * 1024 + 512 + h * 128 + x0);
        { const int e = pid >> 3, o = pid & 7;
          const u32x4 vv = *(const u32x4*)(VTg + ((size_t)tokblock_of(b, dir, c) * 512 + h * 128 + e) * 64 + (dir ? 7 - o : o) * 8);
          *(u32x4*)(VT + e * 72 + o * 8) = dir ? rev8h(vv) : vv; } }
#pragma unroll
    for (int i = 0; i < 4; ++i) { const int pid = tid + i * 512; const int e = pid >> 4, x0 = (pid & 15) * 8;
        *(u32x4*)(Cs + e * 136 + x0) = *(const u32x4*)(CST + ((size_t)(chain * 68 + c) * 128 + e) * 128 + x0); }
    if (tid < 128) sc[384 + tid] = NST[(size_t)(chain * 68 + c) * 128 + tid];
    if (w == 0) {
        const float gbi = gate_b[(dir * 2 + 0) * 4 + h], gbf = gate_b[(dir * 2 + 1) * 4 + h];
        const size_t tokl = (size_t)step_tok(b, dir, c * 64 + lane);
        const float ig = bf2f(Pm[tokl * LDP + ML_OFF + 2048 + (dir * 2 + 0) * 4 + h]) + gbi;
        const float fg = bf2f(Pm[tokl * LDP + ML_OFF + 2048 + (dir * 2 + 1) * 4 + h]) + gbf;
        const float lf = fminf(fg, 0.f) - log1pf(expf(-fabsf(fg)));
        const float bcs = wave_scan_incl(lf, lane); const float gsv = ig - bcs; const float pm = wave_scanmax_incl(gsv, lane);
        const float m_in = MST[chain * 68 + c]; const float mt = bcs + fmaxf(m_in, pm);
        sc[lane] = bcs; sc[64 + lane] = gsv; sc[128 + lane] = mt; sc[192 + lane] = expf(bcs + m_in - mt); sc[256 + lane] = expf(-mt);
    }
    __syncthreads();
    const int tt = w >> 1;
    {   f32x4 aS[2] = {(f32x4){0.f, 0.f, 0.f, 0.f}, (f32x4){0.f, 0.f, 0.f, 0.f}};
#pragma unroll
        for (int ks = 0; ks < 4; ++ks) { const bf16x8 af = *(const bf16x8*)(Qs + (16 * tt + (lane & 15)) * 136 + ks * 32 + (lane >> 4) * 8);
#pragma unroll
            for (int i = 0; i < 2; ++i) { const int st = (w & 1) * 2 + i; const bf16x8 bfr = *(const bf16x8*)(Ks + (16 * st + (lane & 15)) * 136 + ks * 32 + (lane >> 4) * 8);
                aS[i] = __builtin_amdgcn_mfma_f32_16x16x32_bf16(af, bfr, aS[i], 0, 0, 0); } }
        float rs[4] = {0.f, 0.f, 0.f, 0.f};
#pragma unroll
        for (int i = 0; i < 2; ++i) { const int s = 16 * ((w & 1) * 2 + i) + (lane & 15); const float gsv = sc[64 + s];
#pragma unroll
            for (int q = 0; q < 4; ++q) { const int t = 16 * tt + (lane >> 4) * 4 + q; const float val = (s <= t) ? aS[i][q] * expf(sc[t] + gsv - sc[128 + t]) : 0.f; Ss[t * 72 + s] = f2bf(val); rs[q] += val; } }
#pragma unroll
        for (int q = 0; q < 4; ++q) { float r = rs[q]; r += __shfl_xor(r, 1); r += __shfl_xor(r, 2); r += __shfl_xor(r, 4); r += __shfl_xor(r, 8);
            if ((lane & 15) == 0) sc[512 + (w & 1) * 64 + 16 * tt + (lane >> 4) * 4 + q] = r; }
        {   const int t = tid >> 3, part = tid & 7; float dot = 0.f;
#pragma unroll
            for (int j = 0; j < 16; ++j) dot += bf2f(Qs[t * 136 + part * 16 + j]) * sc[384 + part * 16 + j];
            dot += __shfl_xor(dot, 1); dot += __shfl_xor(dot, 2); dot += __shfl_xor(dot, 4);
            if (part == 0) sc[640 + t] = sc[192 + t] * dot; }
    }
    __syncthreads();
    {   f32x4 aN[4];
#pragma unroll
        for (int i = 0; i < 4; ++i) aN[i] = (f32x4){0.f, 0.f, 0.f, 0.f};
#pragma unroll
        for (int ks = 0; ks < 4; ++ks) { const bf16x8 af = *(const bf16x8*)(Qs + (16 * tt + (lane & 15)) * 136 + ks * 32 + (lane >> 4) * 8);
#pragma unroll
            for (int i = 0; i < 4; ++i) { const int et = (w & 1) * 4 + i; const bf16x8 bfr = *(const bf16x8*)(Cs + (16 * et + (lane & 15)) * 136 + ks * 32 + (lane >> 4) * 8);
                aN[i] = __builtin_amdgcn_mfma_f32_16x16x32_bf16(af, bfr, aN[i], 0, 0, 0); } }
#pragma unroll
        for (int q = 0; q < 4; ++q) { const float it = sc[192 + 16 * tt + (lane >> 4) * 4 + q];
#pragma unroll
            for (int i = 0; i < 4; ++i) aN[i][q] *= it; }
#pragma unroll
        for (int ks = 0; ks < 2; ++ks) { const bf16x8 af = *(const bf16x8*)(Ss + (16 * tt + (lane & 15)) * 72 + ks * 32 + (lane >> 4) * 8);
#pragma unroll
            for (int i = 0; i < 4; ++i) { const int et = (w & 1) * 4 + i; const bf16x8 bfr = *(const bf16x8*)(VT + (16 * et + (lane & 15)) * 72 + ks * 32 + (lane >> 4) * 8);
                aN[i] = __builtin_amdgcn_mfma_f32_16x16x32_bf16(af, bfr, aN[i], 0, 0, 0); } }
#pragma unroll
        for (int q = 0; q < 4; ++q) { const int t = 16 * tt + (lane >> 4) * 4 + q; const size_t tokt = (size_t)step_tok(b, dir, c * 64 + t); const float dn = fmaxf(fabsf((sc[512 + t] + sc[576 + t]) + sc[640 + t]), sc[256 + t]);
#pragma unroll
            for (int i = 0; i < 4; ++i) { const int e = 16 * ((w & 1) * 4 + i) + (lane & 15); Hout[tokt * BW + h * 128 + e] = aN[i][q] / dn; } }
    }
}


#define SD_FRAG_LOAD(BF, XF, cc_) do { const int tb_ = tokblock_of(b, dir, (cc_)); const bf16_t* bb_ = BTg + ((size_t)tb_ * 256 + grp * 128 + 64 * (w >> 2) + r16) * 64 + q4 * 8; const bf16_t* xb_ = XTg + ((size_t)tb_ * 512 + h * 64 + 16 * (w & 3) + r16) * 64 + q4 * 8; \
        _Pragma("unroll") for (int ks_ = 0; ks_ < 2; ++ks_) { XF[ks_] = *(const u32x4*)(xb_ + ks_ * 32); _Pragma("unroll") for (int j_ = 0; j_ < 4; ++j_) BF[j_][ks_] = *(const u32x4*)(bb_ + (size_t)j_ * 16 * 64 + ks_ * 32); } } while (0)
#define SD_CHUNK(c_, BF, XF, BFN, XFN) do { const int c = (c_); \
        if (c + 1 < 68) SD_FRAG_LOAD(BFN, XFN, c + 1); \
        const float dec = sDEC[c]; \
        {   bf16_t* ss = SSTb + (size_t)(chain * 68 + c) * 64 * 128; const int p = 16 * (w & 3) + r16; \
            _Pragma("unroll") for (int j = 0; j < 4; ++j) { const int n0 = 16 * ((w >> 2) * 4 + j) + q4 * 4; u32x2 pk; pk.x = pk2(acc[j][0], acc[j][1]); pk.y = pk2(acc[j][2], acc[j][3]); *(u32x2*)(ss + (size_t)p * 128 + n0) = pk; } } \
        bf16x8 xfr[2]; \
        _Pragma("unroll") for (int ks = 0; ks < 2; ++ks) { const float4 wa = *(const float4*)(sSC + c * 64 + ks * 32 + q4 * 8), wb = *(const float4*)(sSC + c * 64 + ks * 32 + q4 * 8 + 4); const u32x4 sv = scale8h(XF[ks], wa, wb); xfr[ks] = *(const bf16x8*)&sv; } \
        _Pragma("unroll") for (int j = 0; j < 4; ++j) acc[j] = acc[j] * dec; \
        _Pragma("unroll") for (int ks = 0; ks < 2; ++ks) _Pragma("unroll") for (int j = 0; j < 4; ++j) acc[j] = __builtin_amdgcn_mfma_f32_16x16x32_bf16(*(const bf16x8*)&BF[j][ks], xfr[ks], acc[j], 0, 0, 0); } while (0)
__device__ __forceinline__ void ssd_state_pass(const int chain, const bf16_t* __restrict__ Pm, const bf16_t* __restrict__ BTg, const bf16_t* __restrict__ XTg, const float Aa, const float dtb,
                                               bf16_t* __restrict__ SSTb, unsigned char* shm, const int tid) {
    const int dir = chain & 1, h = (chain >> 1) & 7, b = chain >> 4, grp = h >> 2, lane = tid & 63, w = tid >> 6, q4 = lane >> 4, r16 = lane & 15;
    float* sSC = (float*)shm; float* sDEC = sSC + 68 * 64;
    const int dcol = SSD_OFF + 1536 + dir * 8 + h;
    u32x4 bfA[4][2], xfA[2], bfB[4][2], xfB[2];
    SD_FRAG_LOAD(bfA, xfA, 0);
    __syncthreads();
    for (int c = w; c < 68; c += 8) { const float xv = bf2f(Pm[(size_t)step_tok(b, dir, c * 64 + lane) * LDP + dcol]) + dtb; const float dtv = xv > 20.f ? xv : log1pf(expf(xv));
        const float cs = wave_scan_incl(dtv * Aa, lane); const float cl = __shfl(cs, 63);
        sSC[c * 64 + (dir ? 63 - lane : lane)] = dtv * expf(cl - cs); if (lane == 0) sDEC[c] = expf(cl); }
    __syncthreads();
    f32x4 acc[4];
#pragma unroll
    for (int j = 0; j < 4; ++j) acc[j] = (f32x4){0.f, 0.f, 0.f, 0.f};
    for (int c2 = 0; c2 < 68; c2 += 2) { SD_CHUNK(c2, bfA, xfA, bfB, xfB); SD_CHUNK(c2 + 1, bfB, xfB, bfA, xfA); }
    __syncthreads();
}
#undef SD_CHUNK
#undef SD_FRAG_LOAD
__device__ __forceinline__ void ssd_out_item(const int chain, const int c, const bf16_t* __restrict__ Pm, const bf16_t* __restrict__ XBb, const bf16_t* __restrict__ XTg, const float Aa, const float dtb,
                                             const bf16_t* __restrict__ SSTb, float* __restrict__ Yout, unsigned char* shm, const int tid) {
    const int dir = chain & 1, h = (chain >> 1) & 7, b = chain >> 4, grp = h >> 2, lane = tid & 63, w = tid >> 6;
    bf16_t* Cs = (bf16_t*)shm; bf16_t* Bs = (bf16_t*)(shm + 17408); bf16_t* XT = (bf16_t*)(shm + 34816); bf16_t* Sin = (bf16_t*)(shm + 44032); bf16_t* Gs = (bf16_t*)(shm + 61440);
    float* sc = (float*)(shm + 70656);
    __syncthreads();
#pragma unroll
    for (int i = 0; i < 2; ++i) { const int pid = tid + i * 512; const int s = pid >> 4, x0 = (pid & 15) * 8; const size_t toks = (size_t)step_tok(b, dir, c * 64 + s);
        *(u32x4*)(Bs + s * 136 + x0) = *(const u32x4*)(XBb + toks * 1024 + 512 + grp * 128 + x0);
        *(u32x4*)(Cs + s * 136 + x0) = *(const u32x4*)(XBb + toks * 1024 + 768 + grp * 128 + x0);
        const int p = pid >> 4;
        *(u32x4*)(Sin + p * 136 + x0) = *(const u32x4*)(SSTb + ((size_t)(chain * 68 + c) * 64 + p) * 128 + x0); }
    {   const int p = tid >> 3, o = tid & 7;
        const u32x4 vv = *(const u32x4*)(XTg + ((size_t)tokblock_of(b, dir, c) * 512 + h * 64 + p) * 64 + (dir ? 7 - o : o) * 8);
        *(u32x4*)(XT + p * 72 + o * 8) = dir ? rev8h(vv) : vv; }
    if (w == 0) { const size_t tokl = (size_t)step_tok(b, dir, c * 64 + lane);
        const float xv = bf2f(Pm[tokl * LDP + SSD_OFF + 1536 + dir * 8 + h]) + dtb; const float dtv = xv > 20.f ? xv : log1pf(expf(xv));
        sc[lane] = wave_scan_incl(dtv * Aa, lane); sc[64 + lane] = dtv; }
    __syncthreads();
    {   const int lt = w >> 1;
        f32x4 aG[2] = {(f32x4){0.f, 0.f, 0.f, 0.f}, (f32x4){0.f, 0.f, 0.f, 0.f}};
#pragma unroll
        for (int ks = 0; ks < 4; ++ks) { const bf16x8 af = *(const bf16x8*)(Cs + (16 * lt + (lane & 15)) * 136 + ks * 32 + (lane >> 4) * 8);
#pragma unroll
            for (int i = 0; i < 2; ++i) { const int st = (w & 1) * 2 + i; const bf16x8 bfr = *(const bf16x8*)(Bs + (16 * st + (lane & 15)) * 136 + ks * 32 + (lane >> 4) * 8);
                aG[i] = __builtin_amdgcn_mfma_f32_16x16x32_bf16(af, bfr, aG[i], 0, 0, 0); } }
#pragma unroll
        for (int i = 0; i < 2; ++i) { const int s = 16 * ((w & 1) * 2 + i) + (lane & 15); const float css = sc[s], dts = sc[64 + s];
#pragma unroll
            for (int q = 0; q < 4; ++q) { const int t = 16 * lt + (lane >> 4) * 4 + q; const float val = (s <= t) ? aG[i][q] * expf(sc[t] - css) * dts : 0.f; Gs[t * 72 + s] = f2bf(val); } }
    }
    __syncthreads();
    {   const int lt = w >> 1;
        f32x4 aY[2] = {(f32x4){0.f, 0.f, 0.f, 0.f}, (f32x4){0.f, 0.f, 0.f, 0.f}};
#pragma unroll
        for (int ks = 0; ks < 4; ++ks) { const bf16x8 af = *(const bf16x8*)(Cs + (16 * lt + (lane & 15)) * 136 + ks * 32 + (lane >> 4) * 8);
#pragma unroll
            for (int i = 0; i < 2; ++i) { const int pt = (w & 1) * 2 + i; const bf16x8 bfr = *(const bf16x8*)(Sin + (16 * pt + (lane & 15)) * 136 + ks * 32 + (lane >> 4) * 8);
                aY[i] = __builtin_amdgcn_mfma_f32_16x16x32_bf16(af, bfr, aY[i], 0, 0, 0); } }
#pragma unroll
        for (int q = 0; q < 4; ++q) { const float ec = expf(sc[16 * lt + (lane >> 4) * 4 + q]); aY[0][q] *= ec; aY[1][q] *= ec; }
#pragma unroll
        for (int ks = 0; ks < 2; ++ks) { const bf16x8 af = *(const bf16x8*)(Gs + (16 * lt + (lane & 15)) * 72 + ks * 32 + (lane >> 4) * 8);
#pragma unroll
            for (int i = 0; i < 2; ++i) { const int pt = (w & 1) * 2 + i; const bf16x8 bfr = *(const bf16x8*)(XT + (16 * pt + (lane & 15)) * 72 + ks * 32 + (lane >> 4) * 8);
                aY[i] = __builtin_amdgcn_mfma_f32_16x16x32_bf16(af, bfr, aY[i], 0, 0, 0); } }
#pragma unroll
        for (int q = 0; q < 4; ++q) { const int t = 16 * lt + (lane >> 4) * 4 + q; const size_t tokt = (size_t)step_tok(b, dir, c * 64 + t);
#pragma unroll
            for (int i = 0; i < 2; ++i) { const int p = 16 * ((w & 1) * 2 + i) + (lane & 15); Yout[tokt * BW + h * 64 + p] = aY[i][q]; } }
    }
}


#define FIDX(i) ((i) + ((i) >> 4))
#define FFT_X_BYTES 69632
__device__ constexpr float FFT_CW_RE[6][16] = {{0.f, 0.f, 0.f, 0.f, 0.f, 0.f, 0.f, 0.f, 0.f, 0.f, 0.f, 0.f, 0.f, 0.f, 0.f, 0.f}, {1.0f, 0.f, 0.f, 0.f, 0.f, 0.f, 0.f, 0.f, 0.f, 0.f, 0.f, 0.f, 0.f, 0.f, 0.f, 0.f}, {1.0f, 6.123233995736766e-17f, 0.f, 0.f, 0.f, 0.f, 0.f, 0.f, 0.f, 0.f, 0.f, 0.f, 0.f, 0.f, 0.f, 0.f}, {1.0f, 0.7071067811865476f, 6.123233995736766e-17f, -0.7071067811865475f, 0.f, 0.f, 0.f, 0.f, 0.f, 0.f, 0.f, 0.f, 0.f, 0.f, 0.f, 0.f}, {1.0f, 0.9238795325112867f, 0.7071067811865476f, 0.38268343236508984f, 6.123233995736766e-17f, -0.3826834323650897f, -0.7071067811865475f, -0.9238795325112867f, 0.f, 0.f, 0.f, 0.f, 0.f, 0.f, 0.f, 0.f}, {1.0f, 0.9807852804032304f, 0.9238795325112867f, 0.8314696123025452f, 0.7071067811865476f, 0.5555702330196023f, 0.38268343236508984f, 0.19509032201612833f, 6.123233995736766e-17f, -0.1950903220161282f, -0.3826834323650897f, -0.555570233019602f, -0.7071067811865475f, -0.8314696123025453f, -0.9238795325112867f, -0.9807852804032304f}};
__device__ constexpr float FFT_CW_IM[6][16] = {{0.f, 0.f, 0.f, 0.f, 0.f, 0.f, 0.f, 0.f, 0.f, 0.f, 0.f, 0.f, 0.f, 0.f, 0.f, 0.f}, {-0.0f, 0.f, 0.f, 0.f, 0.f, 0.f, 0.f, 0.f, 0.f, 0.f, 0.f, 0.f, 0.f, 0.f, 0.f, 0.f}, {-0.0f, -1.0f, 0.f, 0.f, 0.f, 0.f, 0.f, 0.f, 0.f, 0.f, 0.f, 0.f, 0.f, 0.f, 0.f, 0.f}, {-0.0f, -0.7071067811865475f, -1.0f, -0.7071067811865476f, 0.f, 0.f, 0.f, 0.f, 0.f, 0.f, 0.f, 0.f, 0.f, 0.f, 0.f, 0.f}, {-0.0f, -0.3826834323650898f, -0.7071067811865475f, -0.9238795325112867f, -1.0f, -0.9238795325112867f, -0.7071067811865476f, -0.3826834323650899f, 0.f, 0.f, 0.f, 0.f, 0.f, 0.f, 0.f, 0.f}, {-0.0f, -0.19509032201612825f, -0.3826834323650898f, -0.5555702330196022f, -0.7071067811865475f, -0.8314696123025452f, -0.9238795325112867f, -0.9807852804032304f, -1.0f, -0.9807852804032304f, -0.9238795325112867f, -0.8314696123025455f, -0.7071067811865476f, -0.5555702330196022f, -0.3826834323650899f, -0.1950903220161286f}};
__host__ __device__ constexpr int fft_bitrev(int k, int R) { int r = 0; for (int i = 0; i < R; ++i) if (k & (1 << i)) r |= 1 << (R - 1 - i); return r; }
template <int R, bool INV>
__device__ __forceinline__ void fft_pass(float2* __restrict__ X, const float2* __restrict__ TW, const int s0, const int gidx) {
    const int lowbits = 13 - s0 - R; const int stride = 1 << lowbits;
    const int low = gidx & (stride - 1), high = gidx >> lowbits; const int base = (high << (lowbits + R)) | low;
    const int p0 = FIDX(base);
#define FFT_SLOT(k) (lowbits >= 4 ? p0 + (k) * (stride + (stride >> 4)) : p0 + (k) + ((k) >> 4))
    float2 v[1 << R];
#pragma unroll
    for (int k = 0; k < (1 << R); ++k) v[k] = X[FFT_SLOT(k)];
    const int lw = low << s0;
    if (!INV) {
#pragma unroll
        for (int j = 0; j < R; ++j) { const int hk = 1 << (R - 1 - j);
#pragma unroll
            for (int k = 0; k < (1 << R); ++k) if (!(k & hk)) { const int kk = k & (hk - 1);
                const float2 a = v[k], b = v[k + hk]; v[k] = make_float2(a.x + b.x, a.y + b.y); const float dx = a.x - b.x, dy = a.y - b.y;
                if (kk == 0) v[k + hk] = make_float2(dx, dy);
                else if (2 * kk == hk) v[k + hk] = make_float2(dy, -dx);
                else { const float cr = FFT_CW_RE[R - j][kk], ci = FFT_CW_IM[R - j][kk]; v[k + hk] = make_float2(dx * cr - dy * ci, dx * ci + dy * cr); } } }
        if (lowbits > 0) {
#pragma unroll
            for (int k = 1; k < (1 << R); ++k) { const float2 w = TW[(lw * fft_bitrev(k, R)) & 8191]; const float2 a = v[k]; v[k] = make_float2(a.x * w.x - a.y * w.y, a.x * w.y + a.y * w.x); } }
    } else {
        if (lowbits > 0) {
#pragma unroll
            for (int k = 1; k < (1 << R); ++k) { const float2 w = TW[(lw * fft_bitrev(k, R)) & 8191]; const float2 a = v[k]; v[k] = make_float2(a.x * w.x + a.y * w.y, a.y * w.x - a.x * w.y); } }
#pragma unroll
        for (int j = R - 1; j >= 0; --j) { const int hk = 1 << (R - 1 - j);
#pragma unroll
            for (int k = 0; k < (1 << R); ++k) if (!(k & hk)) { const int kk = k & (hk - 1);
                const float2 a = v[k], b = v[k + hk]; float tx, ty;
                if (kk == 0) { tx = b.x; ty = b.y; }
                else if (2 * kk == hk) { tx = -b.y; ty = b.x; }
                else { const float cr = FFT_CW_RE[R - j][kk], ci = FFT_CW_IM[R - j][kk]; tx = b.x * cr + b.y * ci; ty = b.y * cr - b.x * ci; }
                v[k] = make_float2(a.x + tx, a.y + ty); v[k + hk] = make_float2(a.x - tx, a.y - ty); } }
    }
#pragma unroll
    for (int k = 0; k < (1 << R); ++k) X[FFT_SLOT(k)] = v[k];
#undef FFT_SLOT
}
__device__ __forceinline__ void fft_fwd(float2* X, const float2* TW, const int tid) {
    fft_pass<4, false>(X, TW, 0, tid); __syncthreads(); fft_pass<4, false>(X, TW, 4, tid); __syncthreads(); if (tid < 256) fft_pass<5, false>(X, TW, 8, tid); __syncthreads(); }
__device__ __forceinline__ void fft_inv(float2* X, const float2* TW, const int tid) {
    if (tid < 256) fft_pass<5, true>(X, TW, 8, tid); __syncthreads(); fft_pass<4, true>(X, TW, 4, tid); __syncthreads(); fft_pass<4, true>(X, TW, 0, tid); __syncthreads(); }
__device__ __forceinline__ void fft_twiddles(float2* TW, const int tid) {
#pragma unroll
    for (int k = 0; k < 16; ++k) { const int m = tid + k * 512; const float xx = (float)m * (1.0f / 4096.0f); TW[m] = make_float2(cospif(xx), -sinpif(xx)); }
}
__device__ __forceinline__ void hyena_spec_item(const int oc, const float* __restrict__ HR, const float* __restrict__ nrm, float2* __restrict__ HSPEC, unsigned char* shm, const int tid) {
    float2* X = (float2*)shm; const float2* TW = (const float2*)(shm + FFT_X_BYTES);
    const int o = oc >> 9, c = oc & 511; const float inv = 1.0f / nrm[oc];
    __syncthreads();
#pragma unroll 2
    for (int k = 0; k < 16; ++k) { const int j = tid + k * 512; float v;
        if (j < SEQ) v = HR[(unsigned)j * 2048u + o * 1024 + c] * inv; else if (j == SEQ) v = 0.f; else v = HR[(unsigned)(2 * SEQ - j) * 2048u + o * 1024 + 512 + c] * inv;
        X[FIDX(j)] = make_float2(v, 0.f); }
    __syncthreads();
    fft_fwd(X, TW, tid);
    float4* out = (float4*)(HSPEC + (size_t)oc * 8192 + tid * 16); const float2* xs = X + 17 * tid;
#pragma unroll
    for (int k = 0; k < 8; ++k) { const float2 x0 = xs[2 * k], x1 = xs[2 * k + 1]; out[k] = make_float4(x0.x * (1.0f / 8192.0f), x0.y * (1.0f / 8192.0f), x1.x * (1.0f / 8192.0f), x1.y * (1.0f / 8192.0f)); }
}
__device__ __forceinline__ void fft_mul_spec(float2* X, const float2* __restrict__ H, const int tid) {
    const float4* h4 = (const float4*)(H + tid * 16); float2* xs = X + 17 * tid;
#pragma unroll
    for (int k = 0; k < 8; ++k) { const float4 hv = h4[k]; const float2 x0 = xs[2 * k], x1 = xs[2 * k + 1];
        xs[2 * k] = make_float2(x0.x * hv.x - x0.y * hv.y, x0.x * hv.y + x0.y * hv.x); xs[2 * k + 1] = make_float2(x1.x * hv.z - x1.y * hv.w, x1.x * hv.w + x1.y * hv.z); }
}
__device__ __forceinline__ void hyena_fft_item(const int item, const float* __restrict__ UT, const float2* __restrict__ HSPEC, const float* __restrict__ bias, float* __restrict__ YT, unsigned char* shm, const int tid) {
    float2* X = (float2*)shm; const float2* TW = (const float2*)(shm + FFT_X_BYTES);
    const int c = item >> 1, b0 = (item & 1) * 2, b1 = b0 + 1;
    const float* u0 = UT + (size_t)(b0 * 1536 + c) * SEQ + tid * 8; const float* u1 = UT + (size_t)(b1 * 1536 + c) * SEQ + tid * 8;
    const float bias0 = bias[c], bias1 = bias[512 + c];
    float2* xs = X + FIDX(8 * tid);
    float vr[8], vi[8];
    __syncthreads();
    { const float4 a0 = *(const float4*)u0, a1 = *(const float4*)(u0 + 4), c0 = *(const float4*)u1, c1 = *(const float4*)(u1 + 4);
      vr[0] = a0.x; vr[1] = a0.y; vr[2] = a0.z; vr[3] = a0.w; vr[4] = a1.x; vr[5] = a1.y; vr[6] = a1.z; vr[7] = a1.w;
      vi[0] = c0.x; vi[1] = c0.y; vi[2] = c0.z; vi[3] = c0.w; vi[4] = c1.x; vi[5] = c1.y; vi[6] = c1.z; vi[7] = c1.w; }
#pragma unroll
    for (int k = 0; k < 8; ++k) { xs[k] = make_float2(vr[k], vi[k]); xs[4352 + k] = make_float2(0.f, 0.f); }
    __syncthreads();
    fft_fwd(X, TW, tid);
    fft_mul_spec(X, HSPEC + (size_t)c * 8192, tid);
    __syncthreads();
    fft_inv(X, TW, tid);
    { const float* p0 = u0 + (size_t)512 * SEQ; const float* p1 = u1 + (size_t)512 * SEQ;
      const float4 a0 = *(const float4*)p0, a1 = *(const float4*)(p0 + 4), c0 = *(const float4*)p1, c1 = *(const float4*)(p1 + 4);
      const float xr[8] = {a0.x, a0.y, a0.z, a0.w, a1.x, a1.y, a1.z, a1.w}, xi[8] = {c0.x, c0.y, c0.z, c0.w, c1.x, c1.y, c1.z, c1.w};
#pragma unroll
      for (int k = 0; k < 8; ++k) { const float2 cv = xs[k]; const float zr = xr[k] * (cv.x + bias0 * vr[k]), zi = xi[k] * (cv.y + bias0 * vi[k]);
          vr[k] = zr; vi[k] = zi; xs[k] = make_float2(zr, zi); xs[4352 + k] = make_float2(0.f, 0.f); } }
    __syncthreads();
    fft_fwd(X, TW, tid);
    fft_mul_spec(X, HSPEC + (size_t)(512 + c) * 8192, tid);
    __syncthreads();
    fft_inv(X, TW, tid);
    { const float* p0 = u0 + (size_t)1024 * SEQ; const float* p1 = u1 + (size_t)1024 * SEQ;
      const float4 a0 = *(const float4*)p0, a1 = *(const float4*)(p0 + 4), c0 = *(const float4*)p1, c1 = *(const float4*)(p1 + 4);
      const float xr[8] = {a0.x, a0.y, a0.z, a0.w, a1.x, a1.y, a1.z, a1.w}, xi[8] = {c0.x, c0.y, c0.z, c0.w, c1.x, c1.y, c1.z, c1.w};
      float yr[8], yi[8];
#pragma unroll
      for (int k = 0; k < 8; ++k) { const float2 cv = xs[k]; yr[k] = xr[k] * (cv.x + bias1 * vr[k]); yi[k] = xi[k] * (cv.y + bias1 * vi[k]); }
      float* y0 = YT + (size_t)(b0 * 512 + c) * SEQ + tid * 8; float* y1 = YT + (size_t)(b1 * 512 + c) * SEQ + tid * 8;
      *(float4*)y0 = make_float4(yr[0], yr[1], yr[2], yr[3]); *(float4*)(y0 + 4) = make_float4(yr[4], yr[5], yr[6], yr[7]);
      *(float4*)y1 = make_float4(yi[0], yi[1], yi[2], yi[3]); *(float4*)(y1 + 4) = make_float4(yi[4], yi[5], yi[6], yi[7]); }
}

constexpr size_t al256(size_t x) { return (x + 255) & ~(size_t)255; }
constexpr size_t O_BAR = 0;
constexpr size_t O_MOD = 16384;
constexpr size_t O_NORM = O_MOD + al256((size_t)2 * 5 * 6 * DM * 4);
constexpr size_t O_QCTR = O_NORM + al256((size_t)2 * 2 * 1024 * 4);
constexpr size_t O_ZERO_END = O_QCTR + 512;
constexpr size_t O_XS = O_ZERO_END;
constexpr size_t O_HB = O_XS + al256((size_t)NTOK * DM * 4);
constexpr size_t O_P = O_HB + al256((size_t)NTOK * DM * 2);
constexpr size_t O_WIN = O_P + al256((size_t)NTOK * LDP * 2);
constexpr size_t O_WBR = O_WIN + al256((size_t)LDP * DM * 2);
constexpr size_t O_WOUT = O_WBR + al256((size_t)4 * DM * BW * 2);
constexpr size_t O_WGU = O_WOUT + al256((size_t)DM * DM * 2);
constexpr size_t O_WD = O_WGU + al256((size_t)NEXP * 2 * DEXP * DM * 2);
constexpr size_t O_GLU = O_WD + al256((size_t)NEXP * DM * DEXP * 2);
constexpr size_t O_Y4 = O_GLU + al256((size_t)BW * BW * 2);
constexpr size_t O_U = O_Y4 + al256((size_t)NTOK * DM * 2);
constexpr size_t O_QKB = O_U + al256((size_t)NTOK * 1536 * 4);
constexpr size_t O_CST = O_QKB + al256((size_t)NTOK * 1024 * 2);
constexpr size_t O_NST = O_CST + al256((size_t)32 * 68 * 128 * 128 * 2);
constexpr size_t O_MST = O_NST + al256((size_t)32 * 68 * 128 * 4);
constexpr size_t O_XBC = O_MST + al256((size_t)32 * 68 * 4);
constexpr size_t O_SST = O_XBC + al256((size_t)NTOK * 1024 * 2);
constexpr size_t O_HF = O_SST + al256((size_t)64 * 68 * 64 * 128 * 2);
constexpr size_t O_YF = O_HF + al256((size_t)2 * NTOK * BW * 4);
constexpr size_t O_SF = O_YF + al256((size_t)2 * NTOK * BW * 4);
constexpr size_t O_LDT = O_SF + al256((size_t)2 * NCTX * BW * 4);
constexpr size_t O_AP = O_LDT + al256((size_t)4096 * 16);
constexpr size_t O_BBT = O_AP + al256((size_t)4096 * 33 * 8);
constexpr size_t O_KT = O_BBT + al256((size_t)4096 * 16 * 8);
constexpr size_t O_S5A = O_KT + al256((size_t)32 * 2 * 32 * 256 * 4);
constexpr size_t O_S5B = O_S5A + al256((size_t)32 * 512 * 768 * 2);
constexpr size_t O_XCTX = O_S5B + al256((size_t)32 * 512 * 768 * 2);
constexpr size_t O_Z = O_XCTX + al256((size_t)4 * 32 * 2 * 64 * 8);
constexpr size_t O_HRAW = O_Z + al256((size_t)NTOK * BW * 4);
constexpr size_t O_HSPEC = O_HRAW + al256((size_t)(SEQ + CTXL) * 2048 * 4);
constexpr size_t O_K2C = O_HSPEC + al256((size_t)1024 * 8192 * 8);
constexpr size_t O_GG = O_K2C + al256((size_t)(2 * CTXL) * 1024 * 4);
constexpr size_t O_PROBS = O_GG + al256((size_t)NTOK * BW * 2);
constexpr size_t O_ROWTOK = O_PROBS + al256((size_t)NTOK * 16 * 4);
constexpr size_t O_ROWGATE = O_ROWTOK + al256((size_t)NEXP * MOE_PAD * 4);
constexpr size_t O_INV = O_ROWGATE + al256((size_t)NEXP * MOE_PAD * 4);
constexpr size_t O_NORMP = O_INV + al256((size_t)NTOK * 16 * 4);
constexpr size_t WS_END = O_NORMP + al256((size_t)4 * 256 * 2048 * 4);
constexpr size_t O_XG = O_P;
constexpr size_t O_HID = O_P + al256((size_t)NEXP * MOE_PAD * DM * 2);
constexpr size_t O_YEXP = O_HID + al256((size_t)NEXP * MOE_PAD * DEXP * 2);
static_assert(O_YEXP + (size_t)NEXP * MOE_PAD * DM * 2 <= O_WIN, "MoE temporaries must fit inside P");
static_assert((size_t)NTOK * DM * 2 <= (size_t)NTOK * 1536 * 4, "ACCb must fit inside U");
static_assert((size_t)26214400 + (size_t)2 * 17825792 + (size_t)272 * 256 * 64 * 2 <= (size_t)NTOK * DM * 2, "strip buffers must fit inside HB");
static_assert(WS_END <= (size_t)1851000000, "workspace map exceeds the guaranteed size");

struct Args {
    const float* in[47];
    float* out; unsigned char* ws;
    int ph_lo, ph_hi;
};

__device__ __forceinline__ void conv_tile(const float* __restrict__ src, int ldsrc, int nvalid, int k0, int n0, bf16_t* __restrict__ dst, int lddst, int mode, float* T, int tid) {
    { const int n = tid & 63, kr = tid >> 6;
#pragma unroll
      for (int i = 0; i < 8; ++i) { const int k = i * 8 + kr; T[k * 65 + n] = (n0 + n < nvalid) ? src[(size_t)(k0 + k) * ldsrc + n0 + n] : 0.f; } }
    __syncthreads();
    { const int n = tid >> 3, kc = (tid & 7) * 8; const int gn = n0 + n;
      const int drow = mode == 0 ? gn : (32 * (gn >> 4) + (mode == 2 ? 16 : 0) + (gn & 15));
      u32x4 w; w.x = pk2(T[(kc + 0) * 65 + n], T[(kc + 1) * 65 + n]); w.y = pk2(T[(kc + 2) * 65 + n], T[(kc + 3) * 65 + n]);
      w.z = pk2(T[(kc + 4) * 65 + n], T[(kc + 5) * 65 + n]); w.w = pk2(T[(kc + 6) * 65 + n], T[(kc + 7) * 65 + n]);
      *(u32x4*)(dst + (size_t)drow * lddst + k0 + kc) = w; }
    __syncthreads();
}

#define IN(id) (lo <= (id) && (id) < hi)
#define SEAM(id) do { if (hi > (id) + 1) xcd_barrier(bar); } while (0)
#define PH_BEGIN int tid = threadIdx.x; asm volatile("" : "+v"(tid) :: "memory"); const int lane = tid & 63, wave = tid >> 6; (void)lane; (void)wave;

#define x_in (PT(0))
#define c_in (PT(1))
#define ctx_in (PT(2))
#define cctx_in (PT(3))
#define ada_w (PT(4))
#define ada_b (PT(5))
#define norm_mix (PT(6))
#define norm_ffn (PT(7))
#define w_in (PT(8))
#define XS ((float*)(a.ws + O_XS))
#define MOD ((float*)(a.ws + O_MOD))
#define NORM ((float*)(a.ws + O_NORM))
#define NORMP ((float*)(a.ws + O_NORMP))
#define MODl (MOD + (size_t)l * 5 * 6 * DM)
#define HB ((bf16_t*)(a.ws + O_HB))
#define P ((bf16_t*)(a.ws + O_P))
#define WIN ((bf16_t*)(a.ws + O_WIN))
#define WBR ((bf16_t*)(a.ws + O_WBR))
#define WOUT ((bf16_t*)(a.ws + O_WOUT))
#define WGU ((bf16_t*)(a.ws + O_WGU))
#define WD ((bf16_t*)(a.ws + O_WD))
#define GLU ((bf16_t*)(a.ws + O_GLU))
#define Y4 ((bf16_t*)(a.ws + O_Y4))
#define U ((float*)(a.ws + O_U))
#define ACCb ((bf16_t*)(a.ws + O_U))
#define QKB ((bf16_t*)(a.ws + O_QKB))
#define CST ((bf16_t*)(a.ws + O_CST))
#define NST ((float*)(a.ws + O_NST))
#define MST ((float*)(a.ws + O_MST))
#define XBC ((bf16_t*)(a.ws + O_XBC))
#define SSTB ((bf16_t*)(a.ws + O_SST))
#define HF ((float*)(a.ws + O_HF))
#define HBk (HF + (size_t)NTOK * BW)
#define YF ((float*)(a.ws + O_YF))
#define YB (YF + (size_t)NTOK * BW)
#define SF ((float*)(a.ws + O_SF))
#define SB (SF + (size_t)NCTX * BW)
#define LDT ((double2*)(a.ws + O_LDT))
#define APW ((float2*)(a.ws + O_AP))
#define BBT ((float2*)(a.ws + O_BBT))
#define KTB ((float*)(a.ws + O_KT))
#define S5A ((bf16_t*)(a.ws + O_S5A))
#define S5B ((bf16_t*)(a.ws + O_S5B))
#define XCTX ((float2*)(a.ws + O_XCTX))
#define S5P ((bf16_t*)(a.ws + O_HB))
#define XLOC ((float*)(a.ws + O_HB + (size_t)32 * 256 * 512 * 2))
#define KTG ((bf16_t*)(a.ws + O_HB + (size_t)26214400))
#define VTG ((bf16_t*)(a.ws + O_HB + (size_t)26214400 + (size_t)17825792))
#define BTG ((bf16_t*)(a.ws + O_HB + (size_t)26214400 + (size_t)2 * 17825792))
#define XTG ((bf16_t*)(a.ws + O_GG))
#define Z ((float*)(a.ws + O_Z))
#define HRAW ((float*)(a.ws + O_HRAW))
#define HSPEC ((float2*)(a.ws + O_HSPEC))
#define UT ((float*)(a.ws + O_U))
#define YT ((float*)(a.ws + O_Z))
#define QCTR ((int*)(a.ws + O_QCTR))
#define K2C ((float*)(a.ws + O_K2C))
#define GG ((bf16_t*)(a.ws + O_GG))
#define PROBS ((float*)(a.ws + O_PROBS))
#define ROWTOK ((int*)(a.ws + O_ROWTOK))
#define ROWGATE ((float*)(a.ws + O_ROWGATE))
#define XG ((bf16_t*)(a.ws + O_XG))
#define HID ((bf16_t*)(a.ws + O_HID))
#define YEXP ((bf16_t*)(a.ws + O_YEXP))
#define INV ((int*)(a.ws + O_INV))


__device__ __forceinline__ void moe_combine(float4 (&v)[8], const int tok, const int lane, const int* __restrict__ inv, const float* __restrict__ rowgate, const bf16_t* __restrict__ yexp, const float* __restrict__ m5) {
    float4 a[8];
#pragma unroll
    for (int i = 0; i < 8; ++i) a[i] = make_float4(0.f, 0.f, 0.f, 0.f);
    for (int e = 0; e < 16; ++e) { const int row = __builtin_amdgcn_readfirstlane(inv[tok * 16 + e]);
        if (row >= 0) { const float gt = rowgate[row]; const bf16_t* yr = yexp + (size_t)row * DM + lane * 4;
#pragma unroll
            for (int i = 0; i < 8; ++i) { const u32x2 w = *(const u32x2*)(yr + i * 256);
                a[i].x += gt * __uint_as_float(w.x << 16); a[i].y += gt * __uint_as_float(w.x & 0xFFFF0000u); a[i].z += gt * __uint_as_float(w.y << 16); a[i].w += gt * __uint_as_float(w.y & 0xFFFF0000u); } } }
#pragma unroll
    for (int i = 0; i < 8; ++i) { const float4 mm = *(const float4*)(m5 + i * 256 + lane * 4); v[i].x += mm.x * a[i].x; v[i].y += mm.y * a[i].y; v[i].z += mm.z * a[i].z; v[i].w += mm.w * a[i].w; }
}
struct CvU { const float* src; bf16_t* dst; int ldsrc, nvalid, k0, n0, lddst, mode; };
__device__ __forceinline__ void cv_load(const CvU& u, float4 (&r)[8], const int tid) {
#pragma unroll
    for (int i = 0; i < 8; ++i) { const int idx = tid + i * 512; const int k = idx >> 6, n = u.n0 + (idx & 63) * 4;
        r[i] = (n < u.nvalid) ? *(const float4*)(u.src + (size_t)(u.k0 + k) * u.ldsrc + n) : make_float4(0.f, 0.f, 0.f, 0.f); }
}
__device__ __forceinline__ void cv_stage(float* T, const float4 (&r)[8], const int tid) {
#pragma unroll
    for (int i = 0; i < 8; ++i) { const int idx = tid + i * 512; float* p = T + (idx >> 6) * 257 + (idx & 63) * 4; p[0] = r[i].x; p[1] = r[i].y; p[2] = r[i].z; p[3] = r[i].w; }
}
__device__ __forceinline__ void cv_store(const CvU& u, const float* T, const int tid) {
#pragma unroll
    for (int j = 0; j < 4; ++j) { const int o = tid + j * 512; const int kc = (o & 7) * 8, n = o >> 3; const int gn = u.n0 + n;
        const int drow = u.mode == 0 ? gn : (256 * (gn >> 7) + (u.mode == 2 ? 128 : 0) + (gn & 127));
        const float* t = T + kc * 257 + n;
        u32x4 w; w.x = pk2(t[0], t[257]); w.y = pk2(t[2 * 257], t[3 * 257]); w.z = pk2(t[4 * 257], t[5 * 257]); w.w = pk2(t[6 * 257], t[7 * 257]);
        *(u32x4*)(u.dst + (size_t)drow * u.lddst + u.k0 + kc) = w; }
}
template <int LAYER>
__device__ __forceinline__ void layer_body(const Args& a, const XcdBarrier& bar, const int lo, const int hi, const int bid, const int G, unsigned char* const shm, float* const sf, const float** const ptab) {
        constexpr int l = LAYER;
        constexpr int PB = 1 + 16 * l;
        const bool lastl = (l == 1);

        const int nPanels = lastl ? 64 : 68;
        const int M2 = nPanels * 256;

        if (IN(PB + 0)) for (int rep_ = 0; rep_ < (l == 0 ? PROBE_REPS(0) : 1); ++rep_) {
            PH_BEGIN
            {   const float* wbr = PT(40) + (size_t)l * 4 * BW * DM; const float* wout = PT(41) + (size_t)l * DM * DM;
                const float* wg = PT(43) + (size_t)l * NEXP * DM * DEXP; const float* wu = PT(44) + (size_t)l * NEXP * DM * DEXP; const float* wd = PT(45) + (size_t)l * NEXP * DEXP * DM;
                const float* wglu = PT(32) + (size_t)l * BW * BW; const float* win = w_in + (size_t)l * DM * IN_W;
                const int n_win = 32 * 55, n_br = 4 * 64, n_out = 32 * 8, n_gu = 16 * 2 * 192, n_d = 16 * 192, n_glu = 16;
                const int total = n_win + n_br + n_out + n_gu + n_d + n_glu;
#define CV_DECODE(q_, u_) do { int qq_ = (q_); \
                    if (qq_ < n_win) { u_ = CvU{win, WIN, IN_W, IN_W, (qq_ / 55) * 64, (qq_ % 55) * 256, DM, 0}; } else { qq_ -= n_win; \
                    if (qq_ < n_br) { const int k = qq_ >> 6, r = qq_ & 63; u_ = CvU{wbr + (size_t)k * BW * DM, WBR + (size_t)k * DM * BW, DM, DM, (r >> 3) * 64, (r & 7) * 256, BW, 0}; } else { qq_ -= n_br; \
                    if (qq_ < n_out) { u_ = CvU{wout, WOUT, DM, DM, (qq_ >> 3) * 64, (qq_ & 7) * 256, DM, 0}; } else { qq_ -= n_out; \
                    if (qq_ < n_gu) { const int e = qq_ / 384, r = qq_ % 384, up = r / 192, r2 = r % 192; u_ = CvU{(up ? wu : wg) + (size_t)e * DM * DEXP, WGU + (size_t)e * 2 * DEXP * DM, DEXP, DEXP, (r2 / 6) * 64, (r2 % 6) * 256, DM, 1 + up}; } else { qq_ -= n_gu; \
                    if (qq_ < n_d) { const int e = qq_ / 192, r = qq_ % 192; u_ = CvU{wd + (size_t)e * DEXP * DM, WD + (size_t)e * DM * DEXP, DM, DM, (r >> 3) * 64, (r & 7) * 256, DEXP, 0}; } else { qq_ -= n_d; \
                    u_ = CvU{wglu, GLU, BW, BW, (qq_ >> 1) * 64, (qq_ & 1) * 256, BW, 0}; } } } } } } while (0)
                __syncthreads();
                int q = bid; int buf = 0; CvU u; float4 r[8];
                if (q < total) { CV_DECODE(q, u); cv_load(u, r, tid); }
                while (q < total) {
                    float* T = sf + buf * (64 * 257);
                    cv_stage(T, r, tid);
                    __syncthreads();
                    const CvU cur = u; const int qn = q + G;
                    if (qn < total) { CV_DECODE(qn, u); cv_load(u, r, tid); }
                    cv_store(cur, T, tid);
                    buf ^= 1; q = qn;
                }
#undef CV_DECODE
                __syncthreads();
            }
            for (int set = 0; set < (lastl ? 1 : 2); ++set) {
                const int L = set ? CTXL : SEQ; float* HR = HRAW + (set ? (size_t)SEQ * 2048 : 0);
                const float* w1 = PT(11) + l * 33 * 64; const float* b1 = PT(12) + l * 64; const float* fr1 = PT(13) + l * 64; const float* w2 = PT(14) + l * 64 * 64; const float* b2 = PT(15) + l * 64;
                const float* fr2 = PT(16) + l * 64; const float* w3 = PT(17) + l * 64 * 2048; const float* decay = PT(18) + l * 2048;
                float* feats = sf; float* h1 = sf + 16 * 33; float* h2 = h1 + 16 * 64;
                float nacc[4] = {0.f, 0.f, 0.f, 0.f};
                for (int base = bid; base < L; base += 16 * G) {
                    __syncthreads();
                    for (int e = tid; e < 16 * 33; e += NTHR) { const int ti = e / 33, fi = e % 33; int t = base + ti * G; if (t > L - 1) t = L - 1;
                        float v;
                        if (fi == 0) v = (float)t / (float)(L - 1);
                        else { const int j = (fi - 1) & 15; const double fr = 1e-4 + (double)j * ((15.0 - 1e-4) / 15.0); const double ang = (2.0 * 3.14159265358979323846 / (double)L) * (double)t * fr; v = fi <= 16 ? (float)cos(ang) : (float)(-sin(ang)); }
                        feats[e] = v; }
                    __syncthreads();
                    { const int j = tid & 63, ti = tid >> 6; float s0 = b1[j], s1 = s0;
_Pragma("unroll 3")
                      for (int i = 0; i < 33; ++i) { const float wv = w1[i * 64 + j]; s0 += feats[ti * 33 + i] * wv; s1 += feats[(ti + 8) * 33 + i] * wv; }
                      const float f1 = fr1[j]; h1[ti * 64 + j] = sinf(f1 * s0); h1[(ti + 8) * 64 + j] = sinf(f1 * s1); }
                    __syncthreads();
                    { const int j = tid & 63, ti = tid >> 6; float s0 = b2[j], s1 = s0;
_Pragma("unroll 4")
                      for (int i = 0; i < 64; ++i) { const float wv = w2[i * 64 + j]; s0 += h1[ti * 64 + i] * wv; s1 += h1[(ti + 8) * 64 + i] * wv; }
                      const float f2 = fr2[j]; h2[ti * 64 + j] = sinf(f2 * s0); h2[(ti + 8) * 64 + j] = sinf(f2 * s1); }
                    __syncthreads();
                    float acc[16][4];
#pragma unroll
                    for (int ti = 0; ti < 16; ++ti) { acc[ti][0] = 0.f; acc[ti][1] = 0.f; acc[ti][2] = 0.f; acc[ti][3] = 0.f; }
#pragma unroll 2
                    for (int i = 0; i < 64; ++i) { const float* wrow = w3 + (size_t)i * 2048 + tid; const float wa = wrow[0], wb = wrow[512], wc2 = wrow[1024], wd2 = wrow[1536];
#pragma unroll
                        for (int ti = 0; ti < 16; ++ti) { const float hv = h2[ti * 64 + i]; acc[ti][0] += hv * wa; acc[ti][1] += hv * wb; acc[ti][2] += hv * wc2; acc[ti][3] += hv * wd2; } }
                    float dk[4];
#pragma unroll
                    for (int k = 0; k < 4; ++k) dk[k] = fabsf(decay[tid + k * 512]);
#pragma unroll
                    for (int ti = 0; ti < 16; ++ti) { const int t = base + ti * G; if (t < L) { const float tn = (float)t / (float)(L - 1);
#pragma unroll
                        for (int k = 0; k < 4; ++k) { const float v = acc[ti][k] * expf(-tn * dk[k]); HR[(size_t)t * 2048 + tid + k * 512] = v; nacc[k] += fabsf(v); } } }
                }
                float* nrp = NORMP + ((size_t)(l * 2 + set) * 256 + bid) * 2048;
#pragma unroll
                for (int k = 0; k < 4; ++k) nrp[tid + k * 512] = nacc[k];
            }
            for (int idx = bid * NTHR + tid; idx < 4096; idx += G * NTHR) { const int n = idx & 63, g = (idx >> 6) & 31, dir = idx >> 11;
                const double are = (double)(PT(24) + l * 4096)[idx], aim = (double)(PT(25) + l * 4096)[idx]; const double lam = are < -1e-4 ? are : -1e-4; const double dt = exp((double)(PT(26) + l * 64)[dir * 32 + g]);
                const double ldre = lam * dt, ldim = aim * dt; LDT[idx] = make_double2(ldre, ldim);
                const double mag = exp(ldre); const double ar = mag * cos(ldim), ai = mag * sin(ldim);
                const double den = lam * lam + aim * aim; const double nr = ar - 1.0, ni = ai; const double fre = (nr * lam + ni * aim) / den, fim = (ni * lam - nr * aim) / den;
                const float* b_re = PT(27) + l * 32 * 64 * 16; const float* b_im = PT(28) + l * 32 * 64 * 16;
#pragma unroll 4
                for (int c = 0; c < 16; ++c) { const double br = (double)b_re[(g * 64 + n) * 16 + c], bi = (double)b_im[(g * 64 + n) * 16 + c]; BBT[idx * 16 + c] = make_float2((float)(fre * br - fim * bi), (float)(fre * bi + fim * br)); }
            }
            for (int e2 = bid * NTHR + tid; e2 < 4096 * 33; e2 += G * NTHR) { const int idx = e2 / 33, k = e2 - idx * 33; const int g = (idx >> 6) & 31, dir = idx >> 11;
                const double are = (double)(PT(24) + l * 4096)[idx], aim = (double)(PT(25) + l * 4096)[idx]; const double lam = are < -1e-4 ? are : -1e-4; const double dt = exp((double)(PT(26) + l * 64)[dir * 32 + g]);
                const double ldre = lam * dt, ldim = aim * dt; const double mk = exp(ldre * k); APW[e2] = make_float2((float)(mk * cos(ldim * k)), (float)(mk * sin(ldim * k))); }
            if (l == 0 && lo == 0) xcd_barrier(bar);
            for (int tok = bid * 8 + wave; tok < NTOK; tok += G * 8) {
                const int r = tok < NLAT ? tok / SEQ : 4; const float* xr = l == 0 ? (tok < NLAT ? x_in + (size_t)tok * DM : ctx_in + (size_t)(tok - NLAT) * DM) : XS + (size_t)tok * DM; const float* gn = norm_mix + l * DM;
                const float* sh = MODl + (size_t)(r * 6 + 0) * DM; const float* sc = MODl + (size_t)(r * 6 + 1) * DM;
                float4 v[8]; float ss = 0.f;
#pragma unroll
                for (int i = 0; i < 8; ++i) v[i] = *(const float4*)(xr + i * 256 + lane * 4);
                if (l > 0) {
                    moe_combine(v, tok, lane, INV, ROWGATE, YEXP, MOD + (size_t)((l - 1) * 5 + r) * 6 * DM + 5 * DM);
#pragma unroll
                    for (int i = 0; i < 8; ++i) *(float4*)(XS + (size_t)tok * DM + i * 256 + lane * 4) = v[i]; }
#pragma unroll
                for (int i = 0; i < 8; ++i) ss += v[i].x * v[i].x + v[i].y * v[i].y + v[i].z * v[i].z + v[i].w * v[i].w;
                ss = wave_sum(ss); const float rs = rsqrtf(ss * (1.0f / DM) + 1e-6f);
#pragma unroll
                for (int i = 0; i < 8; ++i) { const int d = i * 256 + lane * 4; const float4 g4 = *(const float4*)(gn + d), s4 = *(const float4*)(sc + d), h4 = *(const float4*)(sh + d);
                    u32x2 w; w.x = pk2(v[i].x * rs * g4.x * (1.f + s4.x) + h4.x, v[i].y * rs * g4.y * (1.f + s4.y) + h4.y); w.y = pk2(v[i].z * rs * g4.z * (1.f + s4.z) + h4.z, v[i].w * rs * g4.w * (1.f + s4.w) + h4.w);
                    *(u32x2*)(HB + (size_t)tok * DM + d) = w; }
            }
            SEAM(PB + 0);
        }

        if (IN(PB + 1)) for (int rep_ = 0; rep_ < PROBE_REPS(1); ++rep_) {
            PH_BEGIN
            for (int idx = bid * NTHR + tid; idx < (lastl ? 1 : 2) * 1024; idx += G * NTHR) { const int set = idx >> 10, oc = idx & 1023, o = oc >> 9, c = oc & 511;
                const float* pp = NORMP + (size_t)(l * 2 + set) * 256 * 2048 + o * 1024 + c; float sacc = 0.f;
                for (int bb = 0; bb < G; ++bb) sacc += pp[(size_t)bb * 2048] + pp[(size_t)bb * 2048 + 512];
                NORM[(size_t)(l * 2 + set) * 1024 + oc] = sacc; }
            for (int idx = bid * NTHR + tid; idx < 32768; idx += G * NTHR) { const int c = idx & 15, lag = (idx >> 4) & 31, dir = (idx >> 9) & 1, g = idx >> 10;
                const float* c_re = PT(29) + l * 32 * 16 * 64 + (g * 16 + c) * 64; const float* c_im = PT(30) + l * 32 * 16 * 64 + (g * 16 + c) * 64;
                float acc[16];
#pragma unroll
                for (int j = 0; j < 16; ++j) acc[j] = 0.f;
#pragma unroll 2
                for (int n = 0; n < 64; ++n) { const int pi = (dir * 32 + g) * 64 + n; const float2 ap = APW[pi * 33 + lag]; const float cr = c_re[n], ci = c_im[n]; const float wr_ = cr * ap.x - ci * ap.y, wi_ = cr * ap.y + ci * ap.x;
                    const float4* bb = (const float4*)(BBT + pi * 16);
#pragma unroll
                    for (int j = 0; j < 8; ++j) { const float4 b2 = bb[j]; acc[2 * j] += wr_ * b2.x - wi_ * b2.y; acc[2 * j + 1] += wr_ * b2.z - wi_ * b2.w; } }
                float4* o = (float4*)(KTB + (size_t)idx * 16);
                o[0] = make_float4(acc[0], acc[1], acc[2], acc[3]); o[1] = make_float4(acc[4], acc[5], acc[6], acc[7]); o[2] = make_float4(acc[8], acc[9], acc[10], acc[11]); o[3] = make_float4(acc[12], acc[13], acc[14], acc[15]);
            }
            __syncthreads();
            pg8::Gemm g{HB, WIN, DM, DM, DM}; pg8::SchedStd S{68, 55, G, bid, DM, DM}; pg8::EpiWin E{P, LDP};
            pg8::gemm_phase(( LAS unsigned char*)shm, g, S, E);
#if defined(PROBE_BNOEPI)
            { __syncthreads(); pg8::EpiNone E0; pg8::gemm_phase((LAS unsigned char*)shm, g, S, E0); }
#endif
            SEAM(PB + 1);
        }

        if (IN(PB + 2)) for (int rep_ = 0; rep_ < PROBE_REPS(2); ++rep_) {
            PH_BEGIN
            const float* hcw = PT(9) + l * 3 * 1536; const float* hcb = PT(10) + l * 1536; const float* mcw = PT(20) + l * 3 * 1024; const float* mcb = PT(21) + l * 1024;
            const float* scw = PT(34) + l * 3 * 1024; const float* scb = PT(35) + l * 1024;
            for (int unit = bid; unit < 272 * 3; unit += G) { const int seg = unit / 3, kind = unit % 3; const bool lat = seg < 256; const size_t tok0 = lat ? (size_t)seg * 64 : (size_t)NLAT + (size_t)(seg - 256) * 64;
                if (kind < 2) { const int hf = kind;
                    const int c = tid * 2; const int col = (hf ? SSD_OFF + 512 : ML_OFF) + c; const float* w = hf ? scw : mcw; const float* bsp = hf ? scb : mcb; bf16_t* dst = (hf ? XBC : QKB) + tok0 * 1024 + c;
                    const float2 w0 = *(const float2*)(w + c), w1 = *(const float2*)(w + 1024 + c), w2 = *(const float2*)(w + 2048 + c), bb = *(const float2*)(bsp + c);
                    const float osc = (!hf && c >= 512) ? 0.08838834764831845f : 1.0f;
                    const bool hasPrev = !lat && ((tok0 - NLAT) & (CTXL - 1)) != 0, hasNext = !lat && (((tok0 - NLAT) + 63) & (CTXL - 1)) != CTXL - 1;
                    bf16_t* strip = nullptr;
                    if (!hf) { if (c >= 512) strip = KTG + ((size_t)seg * 512 + (c - 512)) * 64; }
                    else { if (c < 512) strip = XTG + ((size_t)seg * 512 + c) * 64; else if (c < 768) strip = BTG + ((size_t)seg * 256 + (c - 512)) * 64; }
                    const bf16_t* pp = P + tok0 * LDP + col;
                    unsigned raw[66];
#pragma unroll
                    for (int t = 0; t < 66; ++t) raw[t] = ((t == 0 && !hasPrev) || (t == 65 && !hasNext)) ? 0u : *(const unsigned*)(pp + (ptrdiff_t)(t - 1) * LDP);
#pragma unroll
                    for (int t8 = 0; t8 < 8; ++t8) { float v0[8], v1[8];
#pragma unroll
                        for (int tt = 0; tt < 8; ++tt) { const int t = t8 * 8 + tt; const unsigned p0 = raw[t], p1 = raw[t + 1], p2 = raw[t + 2];
                            float a0 = bb.x + w0.x * __uint_as_float(p0 << 16) + w1.x * __uint_as_float(p1 << 16) + w2.x * __uint_as_float(p2 << 16);
                            float a1 = bb.y + w0.y * __uint_as_float(p0 & 0xFFFF0000u) + w1.y * __uint_as_float(p1 & 0xFFFF0000u) + w2.y * __uint_as_float(p2 & 0xFFFF0000u);
                            a0 = siluf_(a0) * osc; a1 = siluf_(a1) * osc; v0[tt] = a0; v1[tt] = a1;
                            *(unsigned*)(dst + (size_t)t * 1024) = pk2(a0, a1); }
                        if (strip) { u32x4 s0, s1; s0.x = pk2(v0[0], v0[1]); s0.y = pk2(v0[2], v0[3]); s0.z = pk2(v0[4], v0[5]); s0.w = pk2(v0[6], v0[7]); s1.x = pk2(v1[0], v1[1]); s1.y = pk2(v1[2], v1[3]); s1.z = pk2(v1[4], v1[5]); s1.w = pk2(v1[6], v1[7]);
                            *(u32x4*)(strip + t8 * 8) = s0; *(u32x4*)(strip + 64 + t8 * 8) = s1; } }
                } else {
                    const int c = (tid & 255) * 2, th = tid >> 8; const bf16_t* pp = P + (tok0 + th * 32) * LDP + ML_OFF + 1024 + c; bf16_t* strip = VTG + ((size_t)seg * 512 + c) * 64 + th * 32;
                    unsigned rv[32];
#pragma unroll
                    for (int t = 0; t < 32; ++t) rv[t] = *(const unsigned*)(pp + (size_t)t * LDP);
#pragma unroll
                    for (int t8 = 0; t8 < 4; ++t8) { u32x4 s0, s1;
                        s0.x = (rv[t8 * 8 + 0] & 0xFFFFu) | (rv[t8 * 8 + 1] << 16); s0.y = (rv[t8 * 8 + 2] & 0xFFFFu) | (rv[t8 * 8 + 3] << 16); s0.z = (rv[t8 * 8 + 4] & 0xFFFFu) | (rv[t8 * 8 + 5] << 16); s0.w = (rv[t8 * 8 + 6] & 0xFFFFu) | (rv[t8 * 8 + 7] << 16);
                        s1.x = (rv[t8 * 8 + 0] >> 16) | (rv[t8 * 8 + 1] & 0xFFFF0000u); s1.y = (rv[t8 * 8 + 2] >> 16) | (rv[t8 * 8 + 3] & 0xFFFF0000u); s1.z = (rv[t8 * 8 + 4] >> 16) | (rv[t8 * 8 + 5] & 0xFFFF0000u); s1.w = (rv[t8 * 8 + 6] >> 16) | (rv[t8 * 8 + 7] & 0xFFFF0000u);
                        *(u32x4*)(strip + t8 * 8) = s0; *(u32x4*)(strip + 64 + t8 * 8) = s1; }
                }
            }
            if (!lastl) for (int tok = NLAT + bid; tok < NTOK; tok += G) {
                const int t = (tok - NLAT) & (CTXL - 1); const bool hasL = (t != 0), hasR = (t != CTXL - 1); const bf16_t* pr = P + (size_t)tok * LDP;
#pragma unroll
                for (int j = 0; j < 3; ++j) { const int cc = tid + j * 512;
                    float acc = hcb[cc] + hcw[1536 + cc] * bf2f(pr[HY_OFF + cc]);
                    if (hasL) acc += hcw[cc] * bf2f(pr[HY_OFF + cc - LDP]);
                    if (hasR) acc += hcw[2 * 1536 + cc] * bf2f(pr[HY_OFF + cc + LDP]);
                    U[(size_t)tok * 1536 + cc] = acc; }
            }
            for (int idx = bid * NTHR + tid; idx < 16384 * 64; idx += G * NTHR) { const int half = idx & 1, g = (idx >> 1) & 31, tok = idx >> 6;
                *(u32x4*)(S5A + ((size_t)g * 512 + (tok >> 5)) * 768 + (tok & 31) * 16 + half * 8) = *(const u32x4*)(P + (size_t)tok * LDP + S5_OFF + g * 16 + half * 8); }
            for (int idx = bid * NTHR + tid; idx < 32 * 512 * 32 * 2; idx += G * NTHR) { const int half = idx & 1, sI = (idx >> 1) & 31, row = (idx >> 6) & 511, g = idx >> 15; const int t = row >> 4, c = row & 15; const int lag = t - sI;
                float v[8];
                if (lag > 0) { const float4* k4 = (const float4*)(KTB + ((size_t)((g * 2 + 0) * 32 + lag) * 16 + c) * 16 + half * 8); const float4 a0 = k4[0], a1 = k4[1]; v[0] = a0.x; v[1] = a0.y; v[2] = a0.z; v[3] = a0.w; v[4] = a1.x; v[5] = a1.y; v[6] = a1.z; v[7] = a1.w; }
                else if (lag < 0) { const float4* k4 = (const float4*)(KTB + ((size_t)((g * 2 + 1) * 32 - lag) * 16 + c) * 16 + half * 8); const float4 a0 = k4[0], a1 = k4[1]; v[0] = a0.x; v[1] = a0.y; v[2] = a0.z; v[3] = a0.w; v[4] = a1.x; v[5] = a1.y; v[6] = a1.z; v[7] = a1.w; }
                else { const float4* k4 = (const float4*)(KTB + ((size_t)((g * 2 + 0) * 32) * 16 + c) * 16 + half * 8); const float4* q4 = (const float4*)(KTB + ((size_t)((g * 2 + 1) * 32) * 16 + c) * 16 + half * 8); const float4 a0 = k4[0], a1 = k4[1], b0 = q4[0], b1 = q4[1];
                    v[0] = a0.x + b0.x; v[1] = a0.y + b0.y; v[2] = a0.z + b0.z; v[3] = a0.w + b0.w; v[4] = a1.x + b1.x; v[5] = a1.y + b1.y; v[6] = a1.z + b1.z; v[7] = a1.w + b1.w; }
                u32x4 w; w.x = pk2(v[0], v[1]); w.y = pk2(v[2], v[3]); w.z = pk2(v[4], v[5]); w.w = pk2(v[6], v[7]);
                *(u32x4*)(S5B + ((size_t)g * 512 + row) * 768 + sI * 16 + half * 8) = w; }
            for (int idx = bid * NTHR + tid; idx < 32 * 512 * 64; idx += G * NTHR) { const int n = idx & 63, row = (idx >> 6) & 511, g = idx >> 15; const int t = row >> 4, c = row & 15;
                const float cr = (PT(29) + l * 32 * 16 * 64)[(g * 16 + c) * 64 + n], ci = (PT(30) + l * 32 * 16 * 64)[(g * 16 + c) * 64 + n];
                const float2 af = APW[((0 * 32 + g) * 64 + n) * 33 + t + 1], ab = APW[((1 * 32 + g) * 64 + n) * 33 + 32 - t];
                bf16_t* d = S5B + ((size_t)g * 512 + row) * 768 + 512 + 2 * n;
                *(unsigned*)d = pk2(cr * af.x - ci * af.y, -(cr * af.y + ci * af.x)); *(unsigned*)(d + 128) = pk2(cr * ab.x - ci * ab.y, -(cr * ab.y + ci * ab.x)); }
            for (int idx = bid * NTHR + tid; idx < 32 * 2 * 64 * 32; idx += G * NTHR) { const int sI = idx & 31, n = (idx >> 5) & 63, dir = (idx >> 11) & 1, g = idx >> 12; const int pi = (dir * 32 + g) * 64 + n;
                const float2 pw = APW[pi * 33 + (dir ? sI : 31 - sI)]; const float4* bb = (const float4*)(BBT + pi * 16);
                float re[16], im[16];
#pragma unroll
                for (int j = 0; j < 8; ++j) { const float4 b2 = bb[j]; re[2 * j] = pw.x * b2.x - pw.y * b2.y; im[2 * j] = pw.x * b2.y + pw.y * b2.x; re[2 * j + 1] = pw.x * b2.z - pw.y * b2.w; im[2 * j + 1] = pw.x * b2.w + pw.y * b2.z; }
                bf16_t* d = S5P + ((size_t)g * 256 + dir * 128 + 2 * n) * 512 + sI * 16;
                u32x4 w0, w1; w0.x = pk2(re[0], re[1]); w0.y = pk2(re[2], re[3]); w0.z = pk2(re[4], re[5]); w0.w = pk2(re[6], re[7]); w1.x = pk2(re[8], re[9]); w1.y = pk2(re[10], re[11]); w1.z = pk2(re[12], re[13]); w1.w = pk2(re[14], re[15]);
                *(u32x4*)d = w0; *(u32x4*)(d + 8) = w1;
                w0.x = pk2(im[0], im[1]); w0.y = pk2(im[2], im[3]); w0.z = pk2(im[4], im[5]); w0.w = pk2(im[6], im[7]); w1.x = pk2(im[8], im[9]); w1.y = pk2(im[10], im[11]); w1.z = pk2(im[12], im[13]); w1.w = pk2(im[14], im[15]);
                *(u32x4*)(d + 512) = w0; *(u32x4*)(d + 520) = w1; }
            {   float* T = sf;
                for (int unit = bid; unit < 4 * 64 * 24; unit += G) { const int b = unit / (64 * 24), r = (unit / 24) % 64, c0 = (unit % 24) * 64; const size_t tok0 = (size_t)b * SEQ + r * 64;
                    __syncthreads();
#pragma unroll
                    for (int i = 0; i < 8; ++i) { const int c = tid & 63, t = (tid >> 6) + 8 * i; T[t * 65 + c] = bf2f(P[(tok0 + t) * LDP + HY_OFF + c0 + c]); }
                    __syncthreads();
                    const int c = tid >> 3, tq = (tid & 7) * 8, cc = c0 + c; const float w0 = hcw[cc], w1 = hcw[1536 + cc], w2 = hcw[3072 + cc], bb = hcb[cc];
                    float o8[8];
#pragma unroll
                    for (int i = 0; i < 8; ++i) { const int t = tq + i; float acc = bb + w1 * T[t * 65 + c]; if (t > 0) acc += w0 * T[(t - 1) * 65 + c]; if (t < 63) acc += w2 * T[(t + 1) * 65 + c]; o8[i] = acc; }
                    float* dst = UT + ((size_t)b * 1536 + cc) * SEQ + r * 64 + tq;
                    *(float4*)dst = make_float4(o8[0], o8[1], o8[2], o8[3]); *(float4*)(dst + 4) = make_float4(o8[4], o8[5], o8[6], o8[7]);
                } }
            if (!lastl) {
                const int L = CTXL; const float* HR = HRAW + (size_t)SEQ * 2048; float* K2 = K2C; const float* nrm = NORM + (size_t)(l * 2 + 1) * 1024;
                const size_t total = (size_t)(2 * L - 1) * 1024;
                for (size_t i = (size_t)bid * NTHR + tid; i < total; i += (size_t)G * NTHR) { const int j = (int)(i >> 10), oc = (int)(i & 1023), o = oc >> 9, c = oc & 511; const int lag = j - (L - 1);
                    const float v = lag >= 0 ? HR[(size_t)lag * 2048 + o * 1024 + c] : HR[(size_t)(-lag) * 2048 + o * 1024 + 512 + c];
                    K2[((size_t)j * 2 + o) * 512 + c] = v / nrm[oc]; }
            }
            {   __syncthreads(); fft_twiddles((float2*)(shm + FFT_X_BYTES), tid);
                for (int oc = bid; oc < 1024; oc += G) hyena_spec_item(oc, HRAW, NORM + (size_t)(l * 2 + 0) * 1024, HSPEC, shm, tid);
                __syncthreads(); }
            SEAM(PB + 2);
        }

        if (IN(PB + 3)) for (int rep_ = 0; rep_ < PROBE_REPS(3); ++rep_) {
            PH_BEGIN
            if (rep_ > 0) { if (bid == 0 && tid == 0) __hip_atomic_store(QCTR + l * 64, 0, __ATOMIC_RELAXED, __HIP_MEMORY_SCOPE_AGENT); xcd_barrier(bar); }
            if (bid < 64) {
                mlstm_state_pass(bid >> 1, bid & 1, P, KTG, VTG, PT(22) + l * 16, CST, NST, MST, shm, tid);
            } else if (bid < 128) {
                { const int ch = bid - 64; const int dir_ = ch & 1, h_ = (ch >> 1) & 7; ssd_state_pass(ch, P, BTG, XTG, -expf(PT(37)[l * 16 + dir_ * 8 + h_]), PT(36)[l * 16 + dir_ * 8 + h_], SSTB, shm, tid); }
            } else if (bid < 160) {
                const int widx = (bid - 128) * 8 + wave; const int dir = widx & 1, g = (widx >> 1) & 31, b = widx >> 6; const int n = lane;
                float2* xb = (float2*)(shm + (size_t)wave * 16640); float2* ctab = xb + 16 * 65;
                const float* a_re = PT(24) + l * 2 * 32 * 64; const float* a_im = PT(25) + l * 2 * 32 * 64; const float* log_dt = PT(26) + l * 64;
                const float* b_re = PT(27) + l * 32 * 64 * 16; const float* b_im = PT(28) + l * 32 * 64 * 16; const float* c_re = PT(29) + l * 32 * 16 * 64; const float* c_im = PT(30) + l * 32 * 16 * 64;
#pragma unroll
                for (int c = 0; c < 16; ++c) ctab[c * 65 + lane] = make_float2(c_re[(g * 16 + c) * 64 + lane], c_im[(g * 16 + c) * 64 + lane]);
                float abr, abi, bbr[16], bbi[16];
                {   const double are = (double)a_re[(dir * 32 + g) * 64 + n], aim = (double)a_im[(dir * 32 + g) * 64 + n];
                    const double lam = are < -1e-4 ? are : -1e-4; const double dt = exp((double)log_dt[dir * 32 + g]);
                    const double mag = exp(lam * dt); const double ar = mag * cos(aim * dt), ai = mag * sin(aim * dt);
                    const double den = lam * lam + aim * aim; const double nr = ar - 1.0, ni = ai;
                    const double fre = (nr * lam + ni * aim) / den, fim = (ni * lam - nr * aim) / den;
                    abr = (float)ar; abi = (float)ai;
#pragma unroll
                    for (int c = 0; c < 16; ++c) { const double br = (double)b_re[(g * 64 + n) * 16 + c], bi = (double)b_im[(g * 64 + n) * 16 + c]; bbr[c] = (float)(fre * br - fim * bi); bbi[c] = (float)(fre * bi + fim * br); }
                }
                float xr = 0.f, xi = 0.f; float* Sout = (dir ? SB : SF) - (size_t)NLAT * BW;
                const int s = lane >> 2, cg = lane & 3;
                for (int i0 = 0; i0 < CTXL; i0 += 16) {
#pragma unroll 4
                    for (int ss = 0; ss < 16; ++ss) {
                        const size_t tok = (size_t)step_tok(b, dir, i0 + ss);
                        const u32x4* up = (const u32x4*)(P + tok * LDP + S5_OFF + g * 16);
                        float t0[8], t1[8]; unpack8(up[0], t0); unpack8(up[1], t1);
                        float bur = 0.f, bui = 0.f;
#pragma unroll
                        for (int c = 0; c < 8; ++c) { bur += t0[c] * bbr[c] + t1[c] * bbr[8 + c]; bui += t0[c] * bbi[c] + t1[c] * bbi[8 + c]; }
                        const float nxr = abr * xr - abi * xi + bur, nxi = abr * xi + abi * xr + bui; xr = nxr; xi = nxi;
                        xb[ss * 65 + lane] = make_float2(xr, xi);
                    }
                    asm volatile("s_waitcnt lgkmcnt(0)" ::: "memory");
                    float y0 = 0.f, y1 = 0.f, y2 = 0.f, y3 = 0.f;
                    for (int nn2 = 0; nn2 < 64; ++nn2) { const float2 xv = xb[s * 65 + nn2];
                        const float2 c0 = ctab[(cg * 4 + 0) * 65 + nn2], c1 = ctab[(cg * 4 + 1) * 65 + nn2], c2 = ctab[(cg * 4 + 2) * 65 + nn2], c3 = ctab[(cg * 4 + 3) * 65 + nn2];
                        y0 += xv.x * c0.x - xv.y * c0.y; y1 += xv.x * c1.x - xv.y * c1.y; y2 += xv.x * c2.x - xv.y * c2.y; y3 += xv.x * c3.x - xv.y * c3.y; }
                    const size_t toks = (size_t)step_tok(b, dir, i0 + s);
                    *(float4*)(Sout + toks * BW + g * 16 + cg * 4) = make_float4(y0, y1, y2, y3);
                    asm volatile("s_waitcnt lgkmcnt(0)" ::: "memory");
                }
                XCTX[((b * 32 + g) * 2 + dir) * 64 + n] = make_float2(xr, xi);
            } else {
                if (bid < 224) {
                    pg8::Gemm gg_{S5A, S5P, 768, 512, 512}; pg8::SchedS5a S_{bid - 160}; pg8::EpiXloc E_{XLOC};
                    pg8::gemm_phase((LAS unsigned char*)shm, gg_, S_, E_);
                    __syncthreads();
                }
                const int nhb = G - 160, hb = bid - 160; const float* bias = PT(19) + l * 1024; const int c = tid;
                const int nitems = lastl ? 0 : 4 * (CTXL / 8);
                for (int it = hb; it < nitems; it += nhb) {
                    int L, tokbase, b, t0; const float* K2;
                    { const int q = it; L = CTXL; tokbase = NLAT; b = q / (CTXL / 8); t0 = (q % (CTXL / 8)) * 8; K2 = K2C; }
                    const float* zb = U + (size_t)(tokbase + b * L) * 1536 + c;
                    float acc[8];
#pragma unroll
                    for (int i = 0; i < 8; ++i) acc[i] = 0.f;
                    const int base = t0 + L - 1;
                    for (int s = 0; s < L; s += 8) {
                        float k[15];
#pragma unroll
                        for (int mm = 0; mm < 15; ++mm) k[mm] = K2[((size_t)(base - s - 7 + mm) * 2 + 0) * 512 + c];
#pragma unroll
                        for (int ds = 0; ds < 8; ++ds) { const float z = zb[(size_t)(s + ds) * 1536];
#pragma unroll
                            for (int i = 0; i < 8; ++i) acc[i] += k[i - ds + 7] * z; }
                    }
#pragma unroll
                    for (int i = 0; i < 8; ++i) { const size_t tok = (size_t)(tokbase + b * L + t0 + i); const float zt = U[tok * 1536 + c]; Z[tok * BW + c] = (acc[i] + bias[c] * zt) * U[tok * 1536 + 512 + c]; }
                }
            }
            {   __syncthreads(); fft_twiddles((float2*)(shm + FFT_X_BYTES), tid);
                int* qslot = (int*)(shm + FFT_X_BYTES + 65536);
                for (;;) { __syncthreads(); if (tid == 0) *qslot = atomicAdd(QCTR + l * 64, 1); __syncthreads(); const int it = *qslot; if (it >= 1024) break;
                    hyena_fft_item(it, UT, HSPEC, PT(19) + l * 1024, YT, shm, tid); }
            }
            SEAM(PB + 3);
        }

        if (IN(PB + 4)) for (int rep_ = 0; rep_ < PROBE_REPS(4); ++rep_) {
            PH_BEGIN
            if (rep_ > 0) { if (bid == 0 && tid == 0) __hip_atomic_store(QCTR + l * 64 + 32, 0, __ATOMIC_RELAXED, __HIP_MEMORY_SCOPE_AGENT); xcd_barrier(bar); }
            if (bid >= G - 32) for (int idx = (bid - (G - 32)) * NTHR + tid; idx < 16384; idx += 32 * NTHR) { const int n = idx & 63, dir = (idx >> 6) & 1, b = (idx >> 7) & 3, g = idx >> 9;
                const float2 a32 = APW[((dir * 32 + g) * 64 + n) * 33 + 32]; float2 X = XCTX[((b * 32 + g) * 2 + dir) * 64 + n];
                const float* __restrict__ xl = XLOC + ((size_t)g * 512 + b * 128) * 256 + dir * 128 + 2 * n; bf16_t* __restrict__ dst = S5A + ((size_t)g * 512 + b * 128) * 768 + 512 + dir * 128 + 2 * n;
#pragma unroll 8
                for (int jj = 0; jj < 128; ++jj) { const int j = dir ? 127 - jj : jj; const float2 xv = *(const float2*)(xl + (size_t)j * 256);
                    *(unsigned*)(dst + (size_t)j * 768) = pk2(X.x, X.y);
                    const float nx = a32.x * X.x - a32.y * X.y + xv.x, ny = a32.x * X.y + a32.y * X.x + xv.y; X.x = nx; X.y = ny; } }
            {   int* qslot = (int*)(shm + 102400);
                for (;;) { __syncthreads(); if (tid == 0) *qslot = atomicAdd(QCTR + l * 64 + 32, 1); __syncthreads(); const int it = *qslot; if (it >= 32 * 68 + 64 * 68) break;
                    if (it < 32 * 68) { const int chain = it / 68, c = it % 68; mlstm_out_item(chain, c, P, QKB, VTG, PT(22) + l * 16, CST, NST, MST, (chain & 1) ? HBk : HF, shm, tid); }
                    else { const int i2 = it - 32 * 68; const int chain = i2 / 68, c = i2 % 68; const int dir_ = chain & 1, h_ = (chain >> 1) & 7;
                        ssd_out_item(chain, c, P, XBC, XTG, -expf(PT(37)[l * 16 + dir_ * 8 + h_]), PT(36)[l * 16 + dir_ * 8 + h_], SSTB, dir_ ? YB : YF, shm, tid); } }
            }
            __syncthreads();
            {   const float* bias = PT(19) + l * 1024 + 512; const int c = tid;
                const int nitems = lastl ? 0 : 4 * (CTXL / 8);
                for (int it = bid; it < nitems; it += G) {
                    int L, tokbase, b, t0; const float* K2;
                    { const int q = it; L = CTXL; tokbase = NLAT; b = q / (CTXL / 8); t0 = (q % (CTXL / 8)) * 8; K2 = K2C; }
                    const float* zb = Z + (size_t)(tokbase + b * L) * BW + c;
                    float acc[8];
#pragma unroll
                    for (int i = 0; i < 8; ++i) acc[i] = 0.f;
                    const int base = t0 + L - 1;
                    for (int s = 0; s < L; s += 8) {
                        float k[15];
#pragma unroll
                        for (int mm = 0; mm < 15; ++mm) k[mm] = K2[((size_t)(base - s - 7 + mm) * 2 + 1) * 512 + c];
#pragma unroll
                        for (int ds = 0; ds < 8; ++ds) { const float z = zb[(size_t)(s + ds) * BW];
#pragma unroll
                            for (int i = 0; i < 8; ++i) acc[i] += k[i - ds + 7] * z; }
                    }
#pragma unroll
                    for (int i = 0; i < 8; ++i) { const size_t tok = (size_t)(tokbase + b * L + t0 + i); const float zt = Z[tok * BW + c]; Y4[tok * DM + c] = f2bf((acc[i] + bias[c] * zt) * U[tok * 1536 + 1024 + c]); }
                }
            }
            SEAM(PB + 4);
        }

        if (IN(PB + 5)) for (int rep_ = 0; rep_ < PROBE_REPS(5); ++rep_) {
            PH_BEGIN
            const float* ml_norm = PT(23) + l * BW; const float* ssd_d = PT(38) + l * 8; const float* ssd_norm = PT(39) + l * BW; const float* s5_d = PT(31) + l * BW;
            if (bid < 128) {
                pg8::Gemm gg_{S5A, S5B, 768, 768, 768}; pg8::SchedS5b S_{bid}; pg8::EpiS5Out E_{P, s5_d, GG};
                pg8::gemm_phase((LAS unsigned char*)shm, gg_, S_, E_);
                __syncthreads();
            }
            for (int tok = bid * 8 + wave; tok < NTOK; tok += G * 8) {
                const int c0 = lane * 8; const bf16_t* pr = P + (size_t)tok * LDP; const size_t o5 = (size_t)tok * BW + c0;
                float hm[8], ys[8];
                { const float4 a0 = *(const float4*)(HF + o5), a1 = *(const float4*)(HF + o5 + 4), b0 = *(const float4*)(HBk + o5), b1 = *(const float4*)(HBk + o5 + 4);
                  hm[0] = a0.x + b0.x; hm[1] = a0.y + b0.y; hm[2] = a0.z + b0.z; hm[3] = a0.w + b0.w; hm[4] = a1.x + b1.x; hm[5] = a1.y + b1.y; hm[6] = a1.z + b1.z; hm[7] = a1.w + b1.w; }
                { const float4 a0 = *(const float4*)(YF + o5), a1 = *(const float4*)(YF + o5 + 4), b0 = *(const float4*)(YB + o5), b1 = *(const float4*)(YB + o5 + 4);
                  float xx[8], zz[8]; unpack8(*(const u32x4*)(XBC + (size_t)tok * 1024 + c0), xx); unpack8(*(const u32x4*)(pr + SSD_OFF + c0), zz); const float dsk = ssd_d[c0 >> 6];
                  ys[0] = a0.x + b0.x; ys[1] = a0.y + b0.y; ys[2] = a0.z + b0.z; ys[3] = a0.w + b0.w; ys[4] = a1.x + b1.x; ys[5] = a1.y + b1.y; ys[6] = a1.z + b1.z; ys[7] = a1.w + b1.w;
#pragma unroll
                  for (int j = 0; j < 8; ++j) ys[j] = (ys[j] + dsk * xx[j]) * siluf_(zz[j]); }
                float s1 = 0.f, s2 = 0.f;
#pragma unroll
                for (int j = 0; j < 8; ++j) { s1 += hm[j] * hm[j]; s2 += ys[j] * ys[j]; }
                s1 += __shfl_xor(s1, 1); s1 += __shfl_xor(s1, 2); s1 += __shfl_xor(s1, 4); s1 += __shfl_xor(s1, 8);
                s2 = wave_sum(s2);
                const float r1 = rsqrtf(s1 * (1.0f / 128.0f) + 1e-6f), r2 = rsqrtf(s2 * (1.0f / BW) + 1e-6f);
                float oo[8]; unpack8(*(const u32x4*)(pr + ML_OFF + 1536 + c0), oo);
                const float4 g0 = *(const float4*)(ml_norm + c0), g1 = *(const float4*)(ml_norm + c0 + 4), n0 = *(const float4*)(ssd_norm + c0), n1 = *(const float4*)(ssd_norm + c0 + 4);
                const float gm[8] = {g0.x, g0.y, g0.z, g0.w, g1.x, g1.y, g1.z, g1.w}, gs[8] = {n0.x, n0.y, n0.z, n0.w, n1.x, n1.y, n1.z, n1.w};
                u32x4 w;
                w.x = pk2(hm[0] * r1 * gm[0] * sigmoidf_(oo[0]), hm[1] * r1 * gm[1] * sigmoidf_(oo[1])); w.y = pk2(hm[2] * r1 * gm[2] * sigmoidf_(oo[2]), hm[3] * r1 * gm[3] * sigmoidf_(oo[3]));
                w.z = pk2(hm[4] * r1 * gm[4] * sigmoidf_(oo[4]), hm[5] * r1 * gm[5] * sigmoidf_(oo[5])); w.w = pk2(hm[6] * r1 * gm[6] * sigmoidf_(oo[6]), hm[7] * r1 * gm[7] * sigmoidf_(oo[7]));
                *(u32x4*)(Y4 + (size_t)tok * DM + 512 + c0) = w;
                w.x = pk2(ys[0] * r2 * gs[0], ys[1] * r2 * gs[1]); w.y = pk2(ys[2] * r2 * gs[2], ys[3] * r2 * gs[3]); w.z = pk2(ys[4] * r2 * gs[4], ys[5] * r2 * gs[5]); w.w = pk2(ys[6] * r2 * gs[6], ys[7] * r2 * gs[7]);
                *(u32x4*)(Y4 + (size_t)tok * DM + 1536 + c0) = w;
                if (tok >= NLAT) { const size_t oc = (size_t)(tok - NLAT) * BW + c0; float uu[8]; unpack8(*(const u32x4*)(pr + S5_OFF + c0), uu);
                    const float4 a0 = *(const float4*)(SF + oc), a1 = *(const float4*)(SF + oc + 4), b0 = *(const float4*)(SB + oc), b1 = *(const float4*)(SB + oc + 4), d0 = *(const float4*)(s5_d + c0), d1 = *(const float4*)(s5_d + c0 + 4);
                    float y[8] = {a0.x + b0.x + d0.x * uu[0], a0.y + b0.y + d0.y * uu[1], a0.z + b0.z + d0.z * uu[2], a0.w + b0.w + d0.w * uu[3], a1.x + b1.x + d1.x * uu[4], a1.y + b1.y + d1.y * uu[5], a1.z + b1.z + d1.z * uu[6], a1.w + b1.w + d1.w * uu[7]};
#pragma unroll
                    for (int j = 0; j < 8; ++j) y[j] = 0.5f * y[j] * (1.0f + tanhf(0.7978845608028654f * (y[j] + 0.044715f * y[j] * y[j] * y[j])));
                    w.x = pk2(y[0], y[1]); w.y = pk2(y[2], y[3]); w.z = pk2(y[4], y[5]); w.w = pk2(y[6], y[7]);
                    *(u32x4*)(GG + (size_t)tok * BW + c0) = w; }
            }
            __syncthreads();
            {   float* T = sf;
                for (int unit = (G > 128 ? bid - 128 : bid); unit >= 0 && unit < 4 * 64 * 8; unit += (G > 128 ? G - 128 : G)) { const int b = unit / 512, t0 = ((unit >> 3) & 63) * 64, c0 = (unit & 7) * 64;
                    __syncthreads();
#pragma unroll
                    for (int i = 0; i < 8; ++i) { const int t = tid & 63, c = (tid >> 6) + 8 * i; T[c * 65 + t] = YT[((size_t)b * 512 + c0 + c) * SEQ + t0 + t]; }
                    __syncthreads();
                    const int t = tid >> 3, cq = (tid & 7) * 8;
                    u32x4 w; w.x = pk2(T[(cq + 0) * 65 + t], T[(cq + 1) * 65 + t]); w.y = pk2(T[(cq + 2) * 65 + t], T[(cq + 3) * 65 + t]); w.z = pk2(T[(cq + 4) * 65 + t], T[(cq + 5) * 65 + t]); w.w = pk2(T[(cq + 6) * 65 + t], T[(cq + 7) * 65 + t]);
                    *(u32x4*)(Y4 + ((size_t)b * SEQ + t0 + t) * DM + c0 + cq) = w;
                } }
            SEAM(PB + 5);
        }

        if (IN(PB + 6)) for (int rep_ = 0; rep_ < PROBE_REPS(6); ++rep_) {
            PH_BEGIN
            pg8::Gemm g{GG, GLU, BW, BW, BW}; pg8::SchedStd S{68, 2, G, bid, BW, BW}; pg8::EpiGlu E{GG, PT(33) + l * BW, Y4};
            pg8::gemm_phase((LAS unsigned char*)shm, g, S, E);
            SEAM(PB + 6);
        }
        if (IN(PB + 7)) for (int rep_ = 0; rep_ < PROBE_REPS(7); ++rep_) {
            PH_BEGIN
            pg8::Gemm g{Y4, WBR, DM, BW, BW}; pg8::SchedBranch S{nPanels, 8, G, bid}; pg8::EpiBranch E{P, ACCb};
            pg8::gemm_phase((LAS unsigned char*)shm, g, S, E);
            SEAM(PB + 7);
        }
        if (IN(PB + 8)) for (int rep_ = 0; rep_ < PROBE_REPS(8); ++rep_) {
            PH_BEGIN
            pg8::Gemm g{ACCb, WOUT, DM, DM, DM}; pg8::SchedStd S{nPanels, 8, G, bid, DM, DM}; pg8::EpiResid E{XS, l == 0 ? x_in : (const float*)XS, l == 0 ? ctx_in - (size_t)NLAT * DM : (const float*)XS, MODl, 2};
            pg8::gemm_phase((LAS unsigned char*)shm, g, S, E);
            SEAM(PB + 8);
        }
        if (IN(PB + 9)) for (int rep_ = 0; rep_ < PROBE_REPS(9); ++rep_) {
            PH_BEGIN
            for (int i = bid * NTHR + tid; i < NEXP * MOE_PAD; i += G * NTHR) ROWTOK[i] = -1;
            for (int i = bid * NTHR + tid; i < NTOK * 16; i += G * NTHR) INV[i] = -1;
            const float* wr = PT(42) + (size_t)l * DM * 16; const float* gn = norm_ffn + l * DM;
            for (int tok0 = (bid * 8 + wave) * 4; tok0 < M2; tok0 += G * 32) {
                const int r = tok0 < NLAT ? tok0 / SEQ : 4; const float* xr = XS + (size_t)tok0 * DM;
                const float* sh = MODl + (size_t)(r * 6 + 3) * DM; const float* sc = MODl + (size_t)(r * 6 + 4) * DM;
                float rs[4];
#pragma unroll
                for (int tk = 0; tk < 4; ++tk) { float ss = 0.f;
#pragma unroll 4
                    for (int i = 0; i < 8; ++i) { const float4 t4 = *(const float4*)(xr + (size_t)tk * DM + i * 256 + lane * 4); ss += t4.x * t4.x + t4.y * t4.y + t4.z * t4.z + t4.w * t4.w; }
                    ss = wave_sum(ss); rs[tk] = rsqrtf(ss * (1.0f / DM) + 1e-6f); }
                float lg[4][16];
#pragma unroll
                for (int tk = 0; tk < 4; ++tk)
#pragma unroll
                    for (int e = 0; e < 16; ++e) lg[tk][e] = 0.f;
#pragma unroll 1
                for (int i = 0; i < 8; ++i) { const int d = i * 256 + lane * 4;
                    const float4 g4 = *(const float4*)(gn + d), s4 = *(const float4*)(sc + d), h4 = *(const float4*)(sh + d);
                    float hv[4][4];
#pragma unroll
                    for (int tk = 0; tk < 4; ++tk) { const float4 xv = *(const float4*)(xr + (size_t)tk * DM + d); const float rr = rs[tk];
                        hv[tk][0] = xv.x * rr * g4.x * (1.f + s4.x) + h4.x; hv[tk][1] = xv.y * rr * g4.y * (1.f + s4.y) + h4.y; hv[tk][2] = xv.z * rr * g4.z * (1.f + s4.z) + h4.z; hv[tk][3] = xv.w * rr * g4.w * (1.f + s4.w) + h4.w;
                        u32x2 w; w.x = pk2(hv[tk][0], hv[tk][1]); w.y = pk2(hv[tk][2], hv[tk][3]); *(u32x2*)(HB + (size_t)(tok0 + tk) * DM + d) = w; }
                    const float4* wq = (const float4*)(wr + (size_t)d * 16);
#pragma unroll
                    for (int q = 0; q < 4; ++q) { const float4 w0 = wq[q * 4 + 0], w1 = wq[q * 4 + 1], w2 = wq[q * 4 + 2], w3 = wq[q * 4 + 3];
#pragma unroll
                        for (int tk = 0; tk < 4; ++tk) { const float hq = hv[tk][q];
                            lg[tk][0] += hq * w0.x; lg[tk][1] += hq * w0.y; lg[tk][2] += hq * w0.z; lg[tk][3] += hq * w0.w; lg[tk][4] += hq * w1.x; lg[tk][5] += hq * w1.y; lg[tk][6] += hq * w1.z; lg[tk][7] += hq * w1.w;
                            lg[tk][8] += hq * w2.x; lg[tk][9] += hq * w2.y; lg[tk][10] += hq * w2.z; lg[tk][11] += hq * w2.w; lg[tk][12] += hq * w3.x; lg[tk][13] += hq * w3.y; lg[tk][14] += hq * w3.z; lg[tk][15] += hq * w3.w; } } }
#pragma unroll
                for (int tk = 0; tk < 4; ++tk) { float mx = -1e30f;
#pragma unroll
                    for (int e = 0; e < 16; ++e) { lg[tk][e] = wave_sum(lg[tk][e]); mx = fmaxf(mx, lg[tk][e]); }
                    float sm = 0.f;
#pragma unroll
                    for (int e = 0; e < 16; ++e) { lg[tk][e] = expf(lg[tk][e] - mx); sm += lg[tk][e]; }
                    const float inv = 1.0f / sm;
                    if (lane == 0) {
#pragma unroll
                        for (int e = 0; e < 16; e += 4) *(float4*)(PROBS + (size_t)(tok0 + tk) * 16 + e) = make_float4(lg[tk][e] * inv, lg[tk][e + 1] * inv, lg[tk][e + 2] * inv, lg[tk][e + 3] * inv); } }
            }
            SEAM(PB + 9);
        }
        if (IN(PB + 10)) for (int rep_ = 0; rep_ < PROBE_REPS(10); ++rep_) {
            PH_BEGIN
            const int nitems = 64 + (lastl ? 0 : 64);
            unsigned long long* keys = (unsigned long long*)shm;
            for (int it = bid; it < nitems; it += G) {
                const int set = it >> 6, e = it & 15, b = (it >> 4) & 3;
                const int n = set ? CTXL : SEQ, cap = set ? 32 : 512, tokbase = set ? NLAT + b * CTXL : b * SEQ;
                __syncthreads();
                for (int i = tid; i < n; i += NTHR) keys[i] = ((unsigned long long)__float_as_uint(PROBS[(size_t)(tokbase + i) * 16 + e]) << 32) | (unsigned long long)(0xFFFFFFFFu - (unsigned)i);
                __syncthreads();
                for (int k = 2; k <= n; k <<= 1)
                    for (int j = k >> 1; j > 0; j >>= 1) {
                        for (int p = tid; p < (n >> 1); p += NTHR) { const int i = ((p & ~(j - 1)) << 1) | (p & (j - 1)); const int m = i | j;
                            const unsigned long long ka = keys[i], kb = keys[m]; const bool desc = ((i & k) == 0);
                            if ((ka < kb) == desc) { keys[i] = kb; keys[m] = ka; } }
                        __syncthreads();
                    }
                for (int r = tid; r < cap; r += NTHR) { const unsigned long long kk = keys[r]; const int row = e * MOE_PAD + (set ? 2048 + b * 32 + r : b * 512 + r);
                    const int tk_ = tokbase + (int)(0xFFFFFFFFu - (unsigned)(kk & 0xFFFFFFFFull)); ROWTOK[row] = tk_; ROWGATE[row] = __uint_as_float((unsigned)(kk >> 32)); INV[tk_ * 16 + e] = row; }
                for (int r = wave; r < cap; r += 8) { const int tok = tokbase + (int)(0xFFFFFFFFu - (unsigned)(keys[r] & 0xFFFFFFFFull)); const int row = e * MOE_PAD + (set ? 2048 + b * 32 + r : b * 512 + r);
                    const u32x4* sp = (const u32x4*)(HB + (size_t)tok * DM); u32x4* dp = (u32x4*)(XG + (size_t)row * DM);
#pragma unroll
                    for (int i = 0; i < 4; ++i) dp[i * 64 + lane] = sp[i * 64 + lane]; }
            }
            {   const int pad0 = lastl ? 2048 : MOE_ROWS, npad = MOE_PAD - pad0;
                for (int R = bid * 8 + wave; R < NEXP * npad; R += G * 8) { const int e = R / npad, rr = pad0 + R % npad; u32x4* dp = (u32x4*)(XG + ((size_t)e * MOE_PAD + rr) * DM);
#pragma unroll
                    for (int i = 0; i < 4; ++i) dp[i * 64 + lane] = (u32x4){0u, 0u, 0u, 0u}; } }
            SEAM(PB + 10);
        }
        if (IN(PB + 12)) for (int rep_ = 0; rep_ < PROBE_REPS(12); ++rep_) {
            PH_BEGIN
            pg8::Gemm g{XG, WGU, DM, DM, DM}; pg8::SchedMoe S{lastl ? 8 : 9, 12, G, bid, DM, DM, 2 * DEXP}; pg8::EpiMoe1 E{HID};
            pg8::gemm_phase((LAS unsigned char*)shm, g, S, E);
            SEAM(PB + 12);
        }
        if (IN(PB + 13)) for (int rep_ = 0; rep_ < PROBE_REPS(13); ++rep_) {
            PH_BEGIN
            pg8::Gemm g{HID, WD, DEXP, DEXP, DEXP}; pg8::SchedMoe S{lastl ? 8 : 9, 8, G, bid, DEXP, DEXP, DM}; pg8::EpiMoeY E{YEXP};
            pg8::gemm_phase((LAS unsigned char*)shm, g, S, E);
            SEAM(PB + 13);
        }

}

__global__ __launch_bounds__(NTHR, 2) void fwd(Args a) {
    extern __shared__ __attribute__((aligned(16))) unsigned char shm[];
    const int bid = blockIdx.x, G = gridDim.x;
    float* const sf = (float*)shm;
    volatile LAS unsigned* xbw = (volatile LAS unsigned*)((LAS unsigned char*)shm + (LDS_BYTES - 16));
    if (threadIdx.x == 0) { xbw[0] = 0u; xbw[1] = 0u; xbw[2] = 0u; xbw[3] = 0u; }
    const float** const ptab = (const float**)(shm + (LDS_BYTES - 16 - 512));
    if (threadIdx.x == 0) {
#pragma unroll
        for (int i = 0; i < 47; ++i) ptab[i] = a.in[i]; }
    __syncthreads();
    XcdBarrier bar = xcd_barrier_post((unsigned*)(a.ws + O_BAR), xbw);
    const int lo = a.ph_lo, hi = a.ph_hi;
    if (IN(0)) {
        PH_BEGIN
        {
            __syncthreads();
            for (int i = tid; i < 5 * DM; i += NTHR) { const int r = i >> 11, k = i & (DM - 1); const float v = r < 4 ? c_in[r * DM + k] : cctx_in[k]; sf[i] = siluf_(v); }
            __syncthreads();
            float* red = sf + 5 * DM;
            for (int unit = bid; unit < 2 * 96; unit += G) { const int l = unit / 96, j = (unit % 96) * 128 + (tid & 127), kq = tid >> 7;
                const float* w = ada_w + (size_t)l * DM * (6 * DM) + (size_t)(kq * 512) * (6 * DM) + j; const float* sv = sf + kq * 512;
                float a0 = 0.f, a1 = 0.f, a2 = 0.f, a3 = 0.f, a4 = 0.f;
#pragma unroll 8
                for (int k = 0; k < 512; ++k) { const float wv = w[(size_t)k * (6 * DM)]; a0 += sv[k] * wv; a1 += sv[DM + k] * wv; a2 += sv[2 * DM + k] * wv; a3 += sv[3 * DM + k] * wv; a4 += sv[4 * DM + k] * wv; }
                __syncthreads();
                { float* rp = red + (kq * 5) * 128 + (tid & 127); rp[0] = a0; rp[128] = a1; rp[256] = a2; rp[384] = a3; rp[512] = a4; }
                __syncthreads();
                if (tid < 128) { const float bb = ada_b[l * 6 * DM + j]; float* o = MOD + (size_t)l * 5 * 6 * DM + j;
#pragma unroll
                    for (int r = 0; r < 5; ++r) o[(size_t)r * 6 * DM] = ((red[(0 * 5 + r) * 128 + tid] + red[(1 * 5 + r) * 128 + tid]) + (red[(2 * 5 + r) * 128 + tid] + red[(3 * 5 + r) * 128 + tid])) + bb; }
            }
        }
    }

    layer_body<0>(a, bar, lo, hi, bid, G, shm, sf, ptab);
    layer_body<1>(a, bar, lo, hi, bid, G, shm, sf, ptab);
    if (IN(33)) {
        PH_BEGIN
        const float* gn = PT(46);
        for (int tok = bid * 8 + wave; tok < NLAT; tok += G * 8) {
            const float* xr = XS + (size_t)tok * DM; float4 v[8]; float ss = 0.f;
#pragma unroll
            for (int i = 0; i < 8; ++i) v[i] = *(const float4*)(xr + i * 256 + lane * 4);
            moe_combine(v, tok, lane, INV, ROWGATE, YEXP, MOD + (size_t)(1 * 5 + tok / SEQ) * 6 * DM + 5 * DM);
#pragma unroll
            for (int i = 0; i < 8; ++i) {                 ss += v[i].x * v[i].x + v[i].y * v[i].y + v[i].z * v[i].z + v[i].w * v[i].w; }
            ss = wave_sum(ss); const float rs = rsqrtf(ss * (1.0f / DM) + 1e-6f);
#pragma unroll
            for (int i = 0; i < 8; ++i) { const int d = i * 256 + lane * 4; const float4 g4 = *(const float4*)(gn + d);
                *(float4*)(a.out + (size_t)tok * DM + d) = make_float4(v[i].x * rs * g4.x, v[i].y * rs * g4.y, v[i].z * rs * g4.z, v[i].w * rs * g4.w); }
        }
    }
#undef IN
#undef SEAM
}


extern "C" void kernel_launch(void* const* d_in, const int* in_sizes, int n_in, void* d_out, int out_size, void* d_ws, size_t ws_size, hipStream_t stream) {
    static int grid = 0;
    if (grid == 0) {
        if (n_in != 47 || ws_size < WS_END) { fprintf(stderr, "kernel_launch: expected 47 inputs and >= %zu bytes of workspace; got %d, %zu\n", (size_t)WS_END, n_in, ws_size); grid = -1; return; }
        int dev = 0, cus = 0;
        if (hipGetDevice(&dev) != hipSuccess || hipDeviceGetAttribute(&cus, hipDeviceAttributeMultiprocessorCount, dev) != hipSuccess) { grid = -1; return; }
        if (hipFuncSetAttribute((const void*)fwd, hipFuncAttributeMaxDynamicSharedMemorySize, LDS_BYTES) != hipSuccess) { fprintf(stderr, "kernel_launch: hipFuncSetAttribute failed\n"); grid = -1; return; }
        int per_cu = 0;
        if (hipOccupancyMaxActiveBlocksPerMultiprocessor(&per_cu, (const void*)fwd, NTHR, LDS_BYTES) != hipSuccess || per_cu < 1) fprintf(stderr, "kernel_launch: occupancy query reports %d\n", per_cu);
        (void)hipGetLastError();
        grid = cus > 256 ? 256 : cus;
        if (grid < 224) { fprintf(stderr, "kernel_launch: needs >= 224 CUs (got %d)\n", grid); grid = -1; return; }
    }
    if (grid < 0) return;
    (void)hipMemsetAsync((char*)d_ws, 0, O_ZERO_END, stream);
    Args a{};
    for (int i = 0; i < 47; ++i) a.in[i] = (const float*)d_in[i];
    a.out = (float*)d_out; a.ws = (unsigned char*)d_ws;
#if MK_ONE_LAUNCH
    a.ph_lo = 0; a.ph_hi = 64;
    hipLaunchKernelGGL(fwd, dim3(grid), dim3(NTHR), LDS_BYTES, stream, a);
#else
    const int ids[] = {0, 1,2,3,4,5,6,7,8,9,10,11,12,13,14, 17,18,19,20,21,22,23,24,25,26,27,28,29,30, 33};
    for (int k = 0; k < (int)(sizeof(ids) / sizeof(ids[0])); ++k) { a.ph_lo = ids[k]; a.ph_hi = ids[k] + 1; hipLaunchKernelGGL(fwd, dim3(grid), dim3(NTHR), LDS_BYTES, stream, a); }
#endif
}
```

```cpp
#include <hip/hip_runtime.h>
#include <stdint.h>
#include <stdio.h>

#ifndef PROBE_MASK
#define PROBE_MASK 0
#endif
#ifndef PROBE_SP
#define PROBE_SP 1
#endif
#define PROBE_REPS(k) ((((PROBE_MASK) >> (k)) & 1) + 1)
#ifndef MK_ONE_LAUNCH
#define MK_ONE_LAUNCH 1
#endif

#define DM 2048
#define NB 4
#define SEQ 4096
#define CTXL 256
#define BW 512
#define NLAT 16384
#define NCTX 1024
#define NTOK 17408
#define IN_W 13856
#define LDP 14080
#define HY_OFF 0
#define ML_OFF 1536
#define S5_OFF 3600
#define SSD_OFF 4112
#define GATE_OFF 5664
#define NEXP 16
#define DEXP 1536
#define MOE_ROWS 2176
#define MOE_PAD 2304
#define NTHR 512
#define LDS_BYTES 147456
#define LAS __attribute__((address_space(3)))

typedef unsigned short bf16_t;
typedef short bf16x8 __attribute__((ext_vector_type(8)));
typedef float f32x4 __attribute__((ext_vector_type(4)));
typedef unsigned u32x4 __attribute__((ext_vector_type(4)));
typedef unsigned u32x2 __attribute__((ext_vector_type(2)));

#define XB_TMO      128
#define XB_XCNT(j)  (256  + 64 * (j))
#define XB_XSUB(j)  (1280 + 64 * (j))
#define XB_XGEN(j)  (2304 + 64 * (j))
#define XB_TOP      3328
#define XB_TOPGEN   3392
#define XCD_BAR_WORDS 3456
#define XB_SPIN_CAP (1u << 18)
__device__ __forceinline__ unsigned xb_ld(unsigned* p)              { return __hip_atomic_load(p, __ATOMIC_RELAXED, __HIP_MEMORY_SCOPE_AGENT); }
__device__ __forceinline__ unsigned xb_add(unsigned* p, unsigned v) { return __hip_atomic_fetch_add(p, v, __ATOMIC_RELAXED, __HIP_MEMORY_SCOPE_AGENT); }
__device__ __forceinline__ unsigned xb_xcc_id() { return (unsigned)__builtin_amdgcn_s_getreg((3 << 11) | 20) & 0xFu; }
#define XB_SPIN(cond, bar) do { unsigned _sp = 0; while (cond) { __builtin_amdgcn_s_sleep(1); \
    if ((++_sp & 255u) == 0u) { if (xb_ld(&(bar)[XB_TMO])) break; if (_sp > XB_SPIN_CAP) { atomicAdd(&(bar)[XB_TMO], 1u); break; } } } } while (0)
struct XcdBarrier { unsigned* bar; unsigned x; volatile LAS unsigned* st; };
__device__ __forceinline__ XcdBarrier xcd_barrier_post(unsigned* bar, volatile LAS unsigned* st) {
    XcdBarrier b; b.bar = bar; b.x = xb_xcc_id(); b.st = st;
    if (threadIdx.x == 0) (void)xb_add(&bar[XB_XCNT(b.x)], 1u);
    return b;
}
__device__ __forceinline__ void xcd_barrier_complete(unsigned* bar, unsigned x, unsigned& nloc, unsigned& nx) {
    const unsigned G = gridDim.x * gridDim.y * gridDim.z;
    unsigned sum, cnt, mine, sp = 0u;
    for (;;) {
        sum = 0u; cnt = 0u; mine = 0u;
#pragma unroll
        for (unsigned j = 0; j < 16; ++j) { const unsigned c = xb_ld(&bar[XB_XCNT(j)]); sum += c; cnt += (c > 0u) ? 1u : 0u; mine = (j == x) ? c : mine; }
        if (sum == G) break;
        __builtin_amdgcn_s_sleep(1);
        if ((++sp & 255u) == 0u) { if (xb_ld(&bar[XB_TMO])) break; if (sp > XB_SPIN_CAP) { atomicAdd(&bar[XB_TMO], 1u); break; } }
    }
    nloc = mine > 0u ? mine : 1u; nx = cnt > 0u ? cnt : 1u;
}
__device__ __forceinline__ void xcd_barrier(const XcdBarrier& b) {
    asm volatile("s_waitcnt vmcnt(0)" ::: "memory");
    __syncthreads();
    if (threadIdx.x == 0) {
        unsigned* bar = b.bar;
        __builtin_amdgcn_s_waitcnt(0);
        unsigned nloc = b.st[0], nx = b.st[1];
        if (nloc == 0u) { xcd_barrier_complete(bar, b.x, nloc, nx); b.st[0] = nloc; b.st[1] = nx; }
        const unsigned old = xb_add(&bar[XB_XSUB(b.x)], 1u);
        const unsigned gen = old / nloc;
        if (old + 1u == (gen + 1u) * nloc) {
            __builtin_amdgcn_fence(__ATOMIC_RELEASE, "agent");
            asm volatile("s_waitcnt vmcnt(0)" ::: "memory");
            const unsigned og = xb_add(&bar[XB_TOP], 1u);
            const unsigned tg = og / nx;
            if (og + 1u == (tg + 1u) * nx) xb_add(&bar[XB_TOPGEN], 1u);
            else XB_SPIN(xb_ld(&bar[XB_TOPGEN]) == tg, bar);
            __builtin_amdgcn_fence(__ATOMIC_ACQUIRE, "agent");
            xb_add(&bar[XB_XGEN(b.x)], 1u);
            asm volatile("s_waitcnt vmcnt(0)" ::: "memory");
        } else {
            XB_SPIN(xb_ld(&bar[XB_XGEN(b.x)]) == gen, bar);
            __builtin_amdgcn_fence(__ATOMIC_ACQUIRE, "agent");
            asm volatile("s_waitcnt vmcnt(0)" ::: "memory");
        }
    }
    __syncthreads();
}

__device__ __forceinline__ unsigned short f2bf(float f) { unsigned u = __float_as_uint(f); u += 0x7FFFu + ((u >> 16) & 1u); return (unsigned short)(u >> 16); }
__device__ __forceinline__ float bf2f(unsigned short b) { return __uint_as_float(((unsigned)b) << 16); }
__device__ __forceinline__ unsigned pk2(float lo, float hi) { unsigned r; asm("v_cvt_pk_bf16_f32 %0, %1, %2" : "=v"(r) : "v"(lo), "v"(hi)); return r; }
__device__ __forceinline__ float sigmoidf_(float x) { return 1.0f / (1.0f + expf(-x)); }
__device__ __forceinline__ float siluf_(float x) { return x / (1.0f + expf(-x)); }
__device__ __forceinline__ float wave_sum(float v) {
#pragma unroll
    for (int o = 32; o >= 1; o >>= 1) v += __shfl_xor(v, o);
    return v;
}
__device__ __forceinline__ const float* uptr(const float* p) { const unsigned long long v = (unsigned long long)p;
    const unsigned lo = __builtin_amdgcn_readfirstlane((unsigned)v), hi = __builtin_amdgcn_readfirstlane((unsigned)(v >> 32)); return (const float*)(((unsigned long long)hi << 32) | lo); }
#define PT(k) uptr(ptab[k])
__device__ __forceinline__ int step_tok(int b, int dir, int i) {
    if (i < CTXL) { const int tt = dir ? (CTXL - 1 - i) : i; return NLAT + b * CTXL + tt; }
    const int j = i - CTXL; const int tt = dir ? (SEQ - 1 - j) : j; return b * SEQ + tt;
}
__device__ __forceinline__ void unpack8(const u32x4 w, float (&f)[8]) {
    f[0] = __uint_as_float(w.x << 16); f[1] = __uint_as_float(w.x & 0xFFFF0000u); f[2] = __uint_as_float(w.y << 16); f[3] = __uint_as_float(w.y & 0xFFFF0000u);
    f[4] = __uint_as_float(w.z << 16); f[5] = __uint_as_float(w.z & 0xFFFF0000u); f[6] = __uint_as_float(w.w << 16); f[7] = __uint_as_float(w.w & 0xFFFF0000u);
}

namespace pg8 {
constexpr int BM = 256, BK = 64, HALF = 128, HTB = HALF * BK * 2, STAGE_BYTES = 8 * HTB, NXCD = 8, WGM = 8;
__host__ __device__ __forceinline__ int lds_byte(int r, int c) { const int st = (r >> 4) * 2 + (c >> 5), rr = r & 15, cc = c & 31, ob = rr * 64 + cc * 2; return st * 1024 + (ob ^ (((ob >> 9) & 1) << 5)); }
__host__ __device__ __forceinline__ void stage_rc(int b, int& R, int& C) { const int st = b / 1024, sb = b % 1024, swz = sb ^ (((sb >> 9) & 1) << 5); R = (st >> 1) * 16 + swz / 64; C = (st & 1) * 32 + (swz % 64) / 2; }
__host__ __device__ __forceinline__ int perm32(int rho) { const int n = rho >> 4, i = rho & 15; return 8 * (i >> 2) + 4 * n + (i & 3); }
struct Unit { int pm, pn, z, k; long long ao, bo; };
struct Gemm { const bf16_t* A; const bf16_t* Bt; int lda, ldb, K; };

__device__ __forceinline__ void tile_of(int wgid, int nM, int nN, int& pm, int& pn) {
    const int nwg = nM * nN; { const int q = nwg / NXCD, r = nwg % NXCD, xcd = wgid % NXCD, off = wgid / NXCD; wgid = (xcd < r ? xcd * (q + 1) : r * (q + 1) + (xcd - r) * q) + off; }
    const int nig = WGM * nN, gid = wgid / nig, fm = gid * WGM, gsz = (nM - fm) < WGM ? (nM - fm) : WGM;
    pm = fm + ((wgid % nig) % gsz); pn = (wgid % nig) / gsz;
}
struct SchedStd {
    int nM, nN, G, c, lda, ldb;
    __device__ __forceinline__ bool next(int i, Unit& u) const { const long L = (long)i * G + c; if (L >= (long)nM * nN) return false; tile_of((int)L, nM, nN, u.pm, u.pn); u.z = 0; u.k = 0;
        u.ao = (long long)u.pm * BM * lda * 2; u.bo = (long long)u.pn * BM * ldb * 2; return true; }
    __device__ __forceinline__ void a_ready(const Unit&) const {}
    __device__ __forceinline__ void done(const Unit&) const {}
};
struct SchedBranch {
    int nM, nN, G, c;
    __device__ __forceinline__ bool next(int i, Unit& u) const { const long L = (long)(i >> 2) * G + c; if (L >= (long)nM * nN) return false; tile_of((int)L, nM, nN, u.pm, u.pn); u.z = 0; u.k = i & 3;
        u.ao = ((long long)u.pm * BM * DM + u.k * BW) * 2; u.bo = ((long long)u.k * DM + u.pn * BM) * BW * 2; return true; }
    __device__ __forceinline__ void a_ready(const Unit&) const {}
    __device__ __forceinline__ void done(const Unit&) const {}
};
struct SchedMoe {
    int nPm, nPn, G, c, lda, ldb, nBrows;
    __device__ __forceinline__ bool next(int i, Unit& u) const { const long L = (long)i * G + c; const int per = nPm * nPn; if (L >= (long)NEXP * per) return false; const int e = (int)(L / per), rem = (int)(L % per);
        u.z = e; u.k = 0; u.pm = rem % nPm; u.pn = rem / nPm; u.ao = ((long long)e * MOE_PAD + u.pm * BM) * lda * 2; u.bo = ((long long)e * nBrows + u.pn * BM) * ldb * 2; return true; }
    __device__ __forceinline__ void a_ready(const Unit&) const {}
    __device__ __forceinline__ void done(const Unit&) const {}
};

typedef f32x4 Acc[2][2][4][2];
template <class Epi, class Sched>
__device__ __forceinline__ void gemm_phase(LAS unsigned char* lds, const Gemm g, const Sched& S, const Epi& E) {
    int tid = threadIdx.x; asm volatile("" : "+v"(tid));
    const int wid = __builtin_amdgcn_readfirstlane(tid >> 6), lane = tid & 63, wr = wid >> 2, wc = wid & 3, fr = lane & 15, fq = lane >> 4;
    const int K = g.K, nt = K / BK;
    unsigned voffA[2], voffB[2];
#pragma unroll
    for (int i = 0; i < 2; ++i) { int R, C; stage_rc(tid * 16 + i * 8192, R, C); const int Rb = Epi::PERM ? ((R & ~31) + perm32(R & 31)) : R;
        voffA[i] = (unsigned)(R * g.lda + C) * 2u; voffB[i] = (unsigned)(Rb * g.ldb + C) * 2u; }
    const size_t kstep = (size_t)(BK * 2);
    const size_t hstepA = (size_t)HALF * g.lda * 2, hstepB = (size_t)HALF * g.ldb * 2;
    const unsigned ldsw = (unsigned)wid * 1024u;
    const int aoff = lds_byte(wr * 64 + fr, fq * 8), boff = lds_byte(wc * 32 + fr, fq * 8);
#define PG8_SA(b, h) (((b) * 2 + (h)) * HTB)
#define PG8_SB(b, h) ((4 + (b) * 2 + (h)) * HTB)
#define PG8_STAGE(bufoff, gbase, voff) do { _Pragma("unroll") for (int _i = 0; _i < 2; ++_i) \
        __builtin_amdgcn_global_load_lds((const unsigned*)((const char*)(gbase) + (voff)[_i]), (LAS unsigned*)(lds + (bufoff) + ldsw + _i * 8192), 16, 0, 0); } while (0)
#define PG8_LDA(dst, b, h) do { _Pragma("unroll") for (int m = 0; m < 4; ++m) _Pragma("unroll") for (int k = 0; k < 2; ++k) dst[m][k] = *(const LAS bf16x8*)(lds + PG8_SA(b, h) + aoff + m * 2048 + k * 1024); } while (0)
#define PG8_LDB(dst, b, h) do { _Pragma("unroll") for (int n = 0; n < 2; ++n) _Pragma("unroll") for (int k = 0; k < 2; ++k) dst[n][k] = *(const LAS bf16x8*)(lds + PG8_SB(b, h) + boff + n * 2048 + k * 1024); } while (0)
#define PG8_MMA(ai, bj, At, Bt) do { __builtin_amdgcn_s_setprio(1); _Pragma("unroll") for (int m = 0; m < 4; ++m) _Pragma("unroll") for (int n = 0; n < 2; ++n) _Pragma("unroll") for (int k = 0; k < 2; ++k) \
        acc[ai][bj][m][n] = __builtin_amdgcn_mfma_f32_16x16x32_bf16(Bt[n][k], At[m][k], acc[ai][bj][m][n], 0, 0, 0); __builtin_amdgcn_s_setprio(0); } while (0)
#define PG8_WAIT_V(n) asm volatile("s_waitcnt vmcnt(" #n ")" ::: "memory")
#define PG8_WAIT_L(n) asm volatile("s_waitcnt lgkmcnt(" #n ")" ::: "memory")
#define PG8_BAR __builtin_amdgcn_s_barrier()
#define PG8_SCHED __builtin_amdgcn_sched_barrier(0)
    Unit cur, nxt; int ui = 0;
    if (!S.next(0, cur)) return;
    Acc acc;
#pragma unroll
    for (int a = 0; a < 2; ++a)
#pragma unroll
        for (int b = 0; b < 2; ++b)
#pragma unroll
            for (int m = 0; m < 4; ++m)
#pragma unroll
                for (int n = 0; n < 2; ++n) acc[a][b][m][n] = (f32x4){0.f, 0.f, 0.f, 0.f};
    bf16x8 At[4][2], B0[2][2], B1[2][2];
    const char* cA = (const char*)g.A + cur.ao; const char* cB = (const char*)g.Bt + cur.bo;
    S.a_ready(cur);
    PG8_STAGE(PG8_SB(0, 0), cB, voffB); PG8_STAGE(PG8_SA(0, 0), cA, voffA); PG8_STAGE(PG8_SB(0, 1), cB + hstepB, voffB); PG8_STAGE(PG8_SA(0, 1), cA + hstepA, voffA);
    if (wr == 1) PG8_BAR;
    PG8_WAIT_V(4); PG8_BAR;
    PG8_STAGE(PG8_SB(1, 0), cB + kstep, voffB); PG8_STAGE(PG8_SA(1, 0), cA + kstep, voffA); PG8_STAGE(PG8_SB(1, 1), cB + hstepB + kstep, voffB);
    PG8_WAIT_V(6); PG8_BAR;
    for (;;) {
        const bool has_next = S.next(ui + 1, nxt);
        const char* nA = has_next ? (const char*)g.A + nxt.ao : cA; const char* nB = has_next ? (const char*)g.Bt + nxt.bo : cB;
        for (int t = 0; t < nt; t += 2) {
            const bool last = (t == nt - 2);
            const char* a1 = cA + (size_t)(t + 1) * kstep;
            const char* a2 = last ? nA : cA + (size_t)(t + 2) * kstep; const char* b2 = last ? nB : cB + (size_t)(t + 2) * kstep;
            const char* a3 = a2 + kstep; const char* b3 = b2 + kstep;
            if (last && has_next) S.a_ready(nxt);
            PG8_LDB(B0, 0, 0); PG8_SCHED; PG8_LDA(At, 0, 0); PG8_STAGE(PG8_SA(1, 1), a1 + hstepA, voffA);
            PG8_WAIT_L(8); PG8_BAR; PG8_WAIT_L(0); PG8_MMA(0, 0, At, B0); PG8_BAR; PG8_SCHED;
            PG8_LDB(B1, 0, 1); PG8_STAGE(PG8_SB(0, 0), b2, voffB);
            PG8_BAR; PG8_WAIT_L(0); PG8_MMA(0, 1, At, B1); PG8_BAR;
            PG8_LDA(At, 0, 1); PG8_STAGE(PG8_SA(0, 0), a2, voffA);
            PG8_BAR; PG8_WAIT_L(0); PG8_MMA(1, 0, At, B0); PG8_BAR; PG8_SCHED;
            PG8_STAGE(PG8_SB(0, 1), b2 + hstepB, voffB);
            PG8_WAIT_V(6); PG8_BAR; PG8_MMA(1, 1, At, B1); PG8_BAR;
            PG8_LDB(B0, 1, 0); PG8_SCHED; PG8_LDA(At, 1, 0); PG8_STAGE(PG8_SA(0, 1), a2 + hstepA, voffA);
            PG8_WAIT_L(8); PG8_BAR; PG8_WAIT_L(0); PG8_MMA(0, 0, At, B0); PG8_BAR; PG8_SCHED;
            PG8_LDB(B1, 1, 1); PG8_STAGE(PG8_SB(1, 0), b3, voffB);
            PG8_BAR; PG8_WAIT_L(0); PG8_MMA(0, 1, At, B1); PG8_BAR;
            PG8_LDA(At, 1, 1); PG8_STAGE(PG8_SA(1, 0), a3, voffA);
            PG8_BAR; PG8_WAIT_L(0); PG8_MMA(1, 0, At, B0); PG8_BAR; PG8_SCHED;
            PG8_STAGE(PG8_SB(1, 1), b3 + hstepB, voffB);
            PG8_WAIT_V(6); PG8_BAR; PG8_MMA(1, 1, At, B1); PG8_BAR;
        }
        const bool keep = E(acc, cur, wr, wc, fr, fq); S.done(cur);
        if (!has_next) break;
        if (!keep) {
#pragma unroll
        for (int a = 0; a < 2; ++a)
#pragma unroll
            for (int b = 0; b < 2; ++b)
#pragma unroll
                for (int m = 0; m < 4; ++m)
#pragma unroll
                    for (int n = 0; n < 2; ++n) acc[a][b][m][n] = (f32x4){0.f, 0.f, 0.f, 0.f};
        }
        cur = nxt; cA = nA; cB = nB; ++ui;
    }
    PG8_WAIT_V(0);
    if (wr == 0) PG8_BAR;
    PG8_BAR;
#undef PG8_SA
#undef PG8_SB
#undef PG8_STAGE
#undef PG8_LDA
#undef PG8_LDB
#undef PG8_MMA
#undef PG8_WAIT_V
#undef PG8_WAIT_L
#undef PG8_BAR
#undef PG8_SCHED
}

struct EpiBf16Store {
    static constexpr bool PERM = true;
    bf16_t* O; int ldc;
    __device__ __forceinline__ bool operator()(Acc& acc, const Unit& u, int wr, int wc, int fr, int fq) const {
        const int row0 = u.pm * BM + wr * 64 + fr, col0 = u.pn * BM + wc * 32 + 8 * fq;
#pragma unroll
        for (int ai = 0; ai < 2; ++ai)
#pragma unroll
            for (int m = 0; m < 4; ++m) { bf16_t* rowp = O + (size_t)(row0 + ai * HALF + m * 16) * ldc + col0;
#pragma unroll
                for (int bj = 0; bj < 2; ++bj) { const f32x4 v0 = acc[ai][bj][m][0], v1 = acc[ai][bj][m][1];
                    u32x4 w; w.x = pk2(v0[0], v0[1]); w.y = pk2(v0[2], v0[3]); w.z = pk2(v1[0], v1[1]); w.w = pk2(v1[2], v1[3]);
                    *(u32x4*)(rowp + bj * HALF) = w; } }
        return false;
    }
};
struct EpiWin {
    static constexpr bool PERM = true;
    bf16_t* O; int ldc;
    __device__ __forceinline__ bool operator()(Acc& acc, const Unit& u, int wr, int wc, int fr, int fq) const {
        const int row0 = u.pm * BM + wr * 64 + fr, col0 = u.pn * BM + wc * 32 + 8 * fq;
#pragma unroll
        for (int bj = 0; bj < 2; ++bj) { const bool gate = (col0 + bj * HALF) >= GATE_OFF;
#pragma unroll
            for (int ai = 0; ai < 2; ++ai)
#pragma unroll
                for (int m = 0; m < 4; ++m) { f32x4 v0 = acc[ai][bj][m][0], v1 = acc[ai][bj][m][1];
                    if (gate) {
#pragma unroll
                        for (int j = 0; j < 4; ++j) { v0[j] = __builtin_amdgcn_rcpf(1.0f + __expf(-v0[j])); v1[j] = __builtin_amdgcn_rcpf(1.0f + __expf(-v1[j])); } }
                    u32x4 w; w.x = pk2(v0[0], v0[1]); w.y = pk2(v0[2], v0[3]); w.z = pk2(v1[0], v1[1]); w.w = pk2(v1[2], v1[3]);
                    *(u32x4*)(O + (size_t)(row0 + ai * HALF + m * 16) * ldc + col0 + bj * HALF) = w; } }
        return false;
    }
};
struct EpiNone { static constexpr bool PERM = true;
    __device__ __forceinline__ bool operator()(Acc& acc, const Unit&, int, int, int, int) const {
#pragma unroll
        for (int a = 0; a < 2; ++a)
#pragma unroll
            for (int b = 0; b < 2; ++b)
#pragma unroll
                for (int m = 0; m < 4; ++m)
#pragma unroll
                    for (int n = 0; n < 2; ++n) asm volatile("" :: "v"(acc[a][b][m][n]));
        return false; } };
struct EpiGlu {
    static constexpr bool PERM = true;
    const bf16_t* GG; const float* bias; bf16_t* Y4;
    __device__ __forceinline__ bool operator()(Acc& acc, const Unit& u, int wr, int wc, int fr, int fq) const {
        const int row0 = u.pm * BM + wr * 64 + fr, col0 = u.pn * BM + wc * 32 + 8 * fq;
#pragma unroll
        for (int bj = 0; bj < 2; ++bj) { const int col = col0 + bj * HALF; const f32x4 b0 = *(const f32x4*)(bias + col), b1 = *(const f32x4*)(bias + col + 4);
            u32x4 gq[2][4];
#pragma unroll
            for (int ai = 0; ai < 2; ++ai)
#pragma unroll
                for (int m = 0; m < 4; ++m) gq[ai][m] = *(const u32x4*)(GG + (size_t)(row0 + ai * HALF + m * 16) * BW + col);
#pragma unroll
            for (int ai = 0; ai < 2; ++ai)
#pragma unroll
                for (int m = 0; m < 4; ++m) { const size_t row = (size_t)(row0 + ai * HALF + m * 16);
                    float gg[8]; unpack8(gq[ai][m], gg);
                    const f32x4 v0 = acc[ai][bj][m][0] + b0, v1 = acc[ai][bj][m][1] + b1;
                    u32x4 w; w.x = pk2(gg[0] * sigmoidf_(v0[0]), gg[1] * sigmoidf_(v0[1])); w.y = pk2(gg[2] * sigmoidf_(v0[2]), gg[3] * sigmoidf_(v0[3]));
                    w.z = pk2(gg[4] * sigmoidf_(v1[0]), gg[5] * sigmoidf_(v1[1])); w.w = pk2(gg[6] * sigmoidf_(v1[2]), gg[7] * sigmoidf_(v1[3]));
                    *(u32x4*)(Y4 + row * DM + 1024 + col) = w; } }
        return false;
    }
};
struct EpiBranch {
    static constexpr bool PERM = true;
    const bf16_t* P; bf16_t* ACCb;
    __device__ __forceinline__ bool operator()(Acc& acc, const Unit& u, int wr, int wc, int fr, int fq) const {
        const int row0 = u.pm * BM + wr * 64 + fr, col0 = u.pn * BM + wc * 32 + 8 * fq; const int k = u.k;
        const bf16_t* gbase = P + (size_t)row0 * LDP + GATE_OFF + k * DM + col0;
        if (k < 3) {
#pragma unroll
            for (int ai = 0; ai < 2; ++ai) {
                u32x4 ga[8], gb[8];
#pragma unroll
                for (int m = 0; m < 4; ++m)
#pragma unroll
                    for (int bj = 0; bj < 2; ++bj) { const bf16_t* p = gbase + (size_t)(ai * HALF + m * 16) * LDP + bj * HALF; ga[m * 2 + bj] = *(const u32x4*)p; gb[m * 2 + bj] = *(const u32x4*)(p + DM); }
#pragma unroll
                for (int m = 0; m < 4; ++m)
#pragma unroll
                    for (int bj = 0; bj < 2; ++bj) { float g0[8], g1[8]; unpack8(ga[m * 2 + bj], g0); unpack8(gb[m * 2 + bj], g1);
                        float s[8];
#pragma unroll
                        for (int j = 0; j < 8; ++j) s[j] = g0[j] * __builtin_amdgcn_rcpf(g1[j]);
                        f32x4 v0 = acc[ai][bj][m][0], v1 = acc[ai][bj][m][1];
                        v0[0] *= s[0]; v0[1] *= s[1]; v0[2] *= s[2]; v0[3] *= s[3]; v1[0] *= s[4]; v1[1] *= s[5]; v1[2] *= s[6]; v1[3] *= s[7];
                        acc[ai][bj][m][0] = v0; acc[ai][bj][m][1] = v1; } }
            return true;
        }
#pragma unroll
        for (int ai = 0; ai < 2; ++ai) {
            u32x4 ga[8];
#pragma unroll
            for (int m = 0; m < 4; ++m)
#pragma unroll
                for (int bj = 0; bj < 2; ++bj) ga[m * 2 + bj] = *(const u32x4*)(gbase + (size_t)(ai * HALF + m * 16) * LDP + bj * HALF);
#pragma unroll
            for (int m = 0; m < 4; ++m)
#pragma unroll
                for (int bj = 0; bj < 2; ++bj) { float s[8]; unpack8(ga[m * 2 + bj], s);
                    f32x4 v0 = acc[ai][bj][m][0], v1 = acc[ai][bj][m][1];
                    v0[0] *= s[0]; v0[1] *= s[1]; v0[2] *= s[2]; v0[3] *= s[3]; v1[0] *= s[4]; v1[1] *= s[5]; v1[2] *= s[6]; v1[3] *= s[7];
                    u32x4 w; w.x = pk2(v0[0], v0[1]); w.y = pk2(v0[2], v0[3]); w.z = pk2(v1[0], v1[1]); w.w = pk2(v1[2], v1[3]);
                    *(u32x4*)(ACCb + (size_t)(row0 + ai * HALF + m * 16) * DM + col0 + bj * HALF) = w; } }
        return false;
    }
};
struct EpiResid {
    static constexpr bool PERM = false;
    float* XS; const float* srcLat; const float* srcCtx; const float* MODl; int gidx;
    __device__ __forceinline__ bool operator()(Acc& acc, const Unit& u, int wr, int wc, int fr, int fq) const {
        const int row0 = u.pm * BM + wr * 64 + fr, col0 = u.pn * BM + wc * 32 + 4 * fq;
        const int r = (u.pm * BM) < NLAT ? (u.pm * BM) / SEQ : 4;
        const float* src = (u.pm * BM) < NLAT ? srcLat : srcCtx;
        const float* mg = MODl + (size_t)(r * 6 + gidx) * DM;
#pragma unroll
        for (int bj = 0; bj < 2; ++bj) {
            f32x4 gm[2], xs[2][2][4];
#pragma unroll
            for (int n = 0; n < 2; ++n) { const int col = col0 + bj * HALF + n * 16; gm[n] = *(const f32x4*)(mg + col);
#pragma unroll
                for (int ai = 0; ai < 2; ++ai)
#pragma unroll
                    for (int m = 0; m < 4; ++m) xs[n][ai][m] = *(const f32x4*)(src + (size_t)(row0 + ai * HALF + m * 16) * DM + col); }
#pragma unroll
            for (int n = 0; n < 2; ++n) { const int col = col0 + bj * HALF + n * 16;
#pragma unroll
                for (int ai = 0; ai < 2; ++ai)
#pragma unroll
                    for (int m = 0; m < 4; ++m) *(f32x4*)(XS + (size_t)(row0 + ai * HALF + m * 16) * DM + col) = xs[n][ai][m] + gm[n] * acc[ai][bj][m][n]; } }
        return false;
    }
};
struct EpiMoe1 {
    static constexpr bool PERM = true;
    bf16_t* HID;
    __device__ __forceinline__ bool operator()(Acc& acc, const Unit& u, int wr, int wc, int fr, int fq) const {
        const size_t row0 = (size_t)u.z * MOE_PAD + u.pm * BM + wr * 64 + fr; const int col0 = u.pn * HALF + wc * 32 + 8 * fq;
#pragma unroll
        for (int ai = 0; ai < 2; ++ai)
#pragma unroll
            for (int m = 0; m < 4; ++m) { const f32x4 g0 = acc[ai][0][m][0], g1 = acc[ai][0][m][1], u0 = acc[ai][1][m][0], u1 = acc[ai][1][m][1];
                float h[8];
#pragma unroll
                for (int j = 0; j < 4; ++j) { h[j] = g0[j] * __builtin_amdgcn_rcpf(1.0f + __expf(-g0[j])) * u0[j]; h[4 + j] = g1[j] * __builtin_amdgcn_rcpf(1.0f + __expf(-g1[j])) * u1[j]; }
                u32x4 w; w.x = pk2(h[0], h[1]); w.y = pk2(h[2], h[3]); w.z = pk2(h[4], h[5]); w.w = pk2(h[6], h[7]);
                *(u32x4*)(HID + (row0 + ai * HALF + m * 16) * DEXP + col0) = w; }
        return false;
    }
};
struct EpiMoeY {
    static constexpr bool PERM = true;
    bf16_t* O;
    __device__ __forceinline__ bool operator()(Acc& acc, const Unit& u, int wr, int wc, int fr, int fq) const {
        const size_t row0 = (size_t)u.z * MOE_PAD + u.pm * BM + wr * 64 + fr; const int col0 = u.pn * BM + wc * 32 + 8 * fq;
#pragma unroll
        for (int ai = 0; ai < 2; ++ai)
#pragma unroll
            for (int m = 0; m < 4; ++m) { bf16_t* rowp = O + (row0 + ai * HALF + m * 16) * DM + col0;
#pragma unroll
                for (int bj = 0; bj < 2; ++bj) { const f32x4 v0 = acc[ai][bj][m][0], v1 = acc[ai][bj][m][1];
                    u32x4 w; w.x = pk2(v0[0], v0[1]); w.y = pk2(v0[2], v0[3]); w.z = pk2(v1[0], v1[1]); w.w = pk2(v1[2], v1[3]);
                    *(u32x4*)(rowp + bj * HALF) = w; } }
        return false;
    }
};

struct SchedS5a {
    int c;
    __device__ __forceinline__ bool next(int i, Unit& u) const { if (i > 0 || c >= 64) return false; u.z = c >> 1; u.pm = c & 1; u.pn = 0; u.k = 0;
        u.ao = ((long long)u.z * 512 + u.pm * BM) * 768 * 2; u.bo = (long long)u.z * 256 * 512 * 2; return true; }
    __device__ __forceinline__ void a_ready(const Unit&) const {}
    __device__ __forceinline__ void done(const Unit&) const {}
};
struct SchedS5b {
    int c;
    __device__ __forceinline__ bool next(int i, Unit& u) const { if (i > 0 || c >= 128) return false; u.z = c >> 2; u.pm = (c >> 1) & 1; u.pn = c & 1; u.k = 0;
        u.ao = ((long long)u.z * 512 + u.pm * BM) * 768 * 2; u.bo = ((long long)u.z * 512 + u.pn * BM) * 768 * 2; return true; }
    __device__ __forceinline__ void a_ready(const Unit&) const {}
    __device__ __forceinline__ void done(const Unit&) const {}
};
struct EpiXloc {
    static constexpr bool PERM = false;
    float* XL;
    __device__ __forceinline__ bool operator()(Acc& acc, const Unit& u, int wr, int wc, int fr, int fq) const {
        const int row0 = u.pm * BM + wr * 64 + fr, col0 = wc * 32 + 4 * fq; float* base = XL + (size_t)u.z * 512 * 256;
#pragma unroll
        for (int ai = 0; ai < 2; ++ai)
#pragma unroll
            for (int m = 0; m < 4; ++m) { float* rowp = base + (size_t)(row0 + ai * HALF + m * 16) * 256 + col0;
#pragma unroll
                for (int bj = 0; bj < 2; ++bj)
#pragma unroll
                    for (int n = 0; n < 2; ++n) *(f32x4*)(rowp + bj * HALF + n * 16) = acc[ai][bj][m][n]; }
        return false;
    }
};
struct EpiS5Out {
    static constexpr bool PERM = true;
    const bf16_t* P; const float* dskip; bf16_t* GG;
    __device__ __forceinline__ bool operator()(Acc& acc, const Unit& u, int wr, int wc, int fr, int fq) const {
        const int row0 = u.pm * BM + wr * 64 + fr, col0 = u.pn * BM + wc * 32 + 8 * fq; const int g = u.z;
#pragma unroll
        for (int bj = 0; bj < 2; ++bj) { const int col = col0 + bj * HALF; const int t = col >> 4, c0 = col & 15;
            const f32x4 d0 = *(const f32x4*)(dskip + g * 16 + c0), d1 = *(const f32x4*)(dskip + g * 16 + c0 + 4);
            u32x4 uq[2][4];
#pragma unroll
            for (int ai = 0; ai < 2; ++ai)
#pragma unroll
                for (int m = 0; m < 4; ++m) uq[ai][m] = *(const u32x4*)(P + ((size_t)(row0 + ai * HALF + m * 16) * 32 + t) * LDP + S5_OFF + g * 16 + c0);
#pragma unroll
            for (int ai = 0; ai < 2; ++ai)
#pragma unroll
                for (int m = 0; m < 4; ++m) { const size_t tok = (size_t)(row0 + ai * HALF + m * 16) * 32 + t;
                    float uu[8]; unpack8(uq[ai][m], uu);
                    const f32x4 v0 = acc[ai][bj][m][0], v1 = acc[ai][bj][m][1];
                    float y[8] = {v0[0] + d0[0] * uu[0], v0[1] + d0[1] * uu[1], v0[2] + d0[2] * uu[2], v0[3] + d0[3] * uu[3], v1[0] + d1[0] * uu[4], v1[1] + d1[1] * uu[5], v1[2] + d1[2] * uu[6], v1[3] + d1[3] * uu[7]};
#pragma unroll
                    for (int j = 0; j < 8; ++j) y[j] = 0.5f * y[j] * (1.0f + tanhf(0.7978845608028654f * (y[j] + 0.044715f * y[j] * y[j] * y[j])));
                    u32x4 w; w.x = pk2(y[0], y[1]); w.y = pk2(y[2], y[3]); w.z = pk2(y[4], y[5]); w.w = pk2(y[6], y[7]);
                    *(u32x4*)(GG + tok * BW + g * 16 + c0) = w; } }
        return false;
    }
};
}


__device__ __forceinline__ float wave_scan_incl(float v, int lane) {
#pragma unroll
    for (int o = 1; o < 64; o <<= 1) { const float t = __shfl_up(v, o); if (lane >= o) v += t; }
    return v;
}
__device__ __forceinline__ float wave_scanmax_incl(float v, int lane) {
#pragma unroll
    for (int o = 1; o < 64; o <<= 1) { const float t = __shfl_up(v, o); if (lane >= o) v = fmaxf(v, t); }
    return v;
}
__device__ __forceinline__ float wave_max(float v) {
#pragma unroll
    for (int o = 32; o >= 1; o >>= 1) v = fmaxf(v, __shfl_xor(v, o));
    return v;
}
__device__ __forceinline__ void unpack8h(const u32x4 w, bf16_t (&h)[8]) {
    h[0] = (bf16_t)(w.x & 0xFFFFu); h[1] = (bf16_t)(w.x >> 16); h[2] = (bf16_t)(w.y & 0xFFFFu); h[3] = (bf16_t)(w.y >> 16);
    h[4] = (bf16_t)(w.z & 0xFFFFu); h[5] = (bf16_t)(w.z >> 16); h[6] = (bf16_t)(w.w & 0xFFFFu); h[7] = (bf16_t)(w.w >> 16);
}

__device__ __forceinline__ int tokblock_of(int b, int dir, int c) { if (c < 4) return 256 + b * 4 + (dir ? 3 - c : c); const int j = c - 4; return b * 64 + (dir ? 63 - j : j); }
__device__ __forceinline__ u32x4 rev8h(const u32x4 v) { u32x4 r; r.x = (v.w >> 16) | (v.w << 16); r.y = (v.z >> 16) | (v.z << 16); r.z = (v.y >> 16) | (v.y << 16); r.w = (v.x >> 16) | (v.x << 16); return r; }
__device__ __forceinline__ u32x4 scale8h(const u32x4 v, const float4 a, const float4 b) { float f[8]; unpack8(v, f); u32x4 r; r.x = pk2(f[0] * a.x, f[1] * a.y); r.y = pk2(f[2] * a.z, f[3] * a.w); r.z = pk2(f[4] * b.x, f[5] * b.y); r.w = pk2(f[6] * b.z, f[7] * b.w); return r; }
__device__ __forceinline__ float dot8h(const u32x4 v, const float4 a, const float4 b) { float f[8]; unpack8(v, f); return (f[0] * a.x + f[1] * a.y) + (f[2] * a.z + f[3] * a.w) + (f[4] * b.x + f[5] * b.y) + (f[6] * b.z + f[7] * b.w); }
#define ML_FRAG_LOAD(KF, VF, cc_) do { const int tb_ = tokblock_of(b, dir, (cc_)); const bf16_t* kb_ = KTg + ((size_t)tb_ * 512 + h * 128 + 32 * wd + r16) * 64 + q4 * 8; const bf16_t* vb_ = VTg + ((size_t)tb_ * 512 + h * 128 + 64 * half + 32 * we + r16) * 64 + q4 * 8; \
        _Pragma("unroll") for (int ks_ = 0; ks_ < 2; ++ks_) _Pragma("unroll") for (int j_ = 0; j_ < 2; ++j_) { VF[j_][ks_] = *(const u32x4*)(vb_ + (size_t)j_ * 16 * 64 + ks_ * 32); KF[j_][ks_] = *(const u32x4*)(kb_ + (size_t)j_ * 16 * 64 + ks_ * 32); } } while (0)
#define ML_CHUNK(c_, KF, VF, KFN, VFN) do { const int c = (c_); \
        if (c + 1 < 68) ML_FRAG_LOAD(KFN, VFN, c + 1);                        \
        const float dec = sDEC[c]; \
        {   bf16_t* cs = CST + (size_t)(chain * 68 + c) * 128 * 128; \
            _Pragma("unroll") for (int je = 0; je < 2; ++je) _Pragma("unroll") for (int jd = 0; jd < 2; ++jd) { const int e = 64 * half + 32 * we + 16 * je + r16, d0 = 32 * wd + 16 * jd + q4 * 4; \
                u32x2 pk; pk.x = pk2(acc[je][jd][0], acc[je][jd][1]); pk.y = pk2(acc[je][jd][2], acc[je][jd][3]); *(u32x2*)(cs + (size_t)e * 128 + d0) = pk; } \
            if (nown) { _Pragma("unroll") for (int jd = 0; jd < 2; ++jd) { float nv = npart[jd]; nv += __shfl_xor(nv, 16); nv += __shfl_xor(nv, 32); if (q4 == 0) NST[(size_t)(chain * 68 + c) * 128 + 32 * wd + 16 * jd + r16] = nv; } } } \
        bf16x8 vfr[2][2]; \
        _Pragma("unroll") for (int ks = 0; ks < 2; ++ks) { const float4 wa = *(const float4*)(sWS + c * 64 + ks * 32 + q4 * 8), wb = *(const float4*)(sWS + c * 64 + ks * 32 + q4 * 8 + 4); \
            _Pragma("unroll") for (int je = 0; je < 2; ++je) { const u32x4 sv = scale8h(VF[je][ks], wa, wb); vfr[je][ks] = *(const bf16x8*)&sv; } \
            if (nown) { _Pragma("unroll") for (int jd = 0; jd < 2; ++jd) npart[jd] = (ks == 0 ? dec * npart[jd] : npart[jd]) + dot8h(KF[jd][ks], wa, wb); } } \
        _Pragma("unroll") for (int je = 0; je < 2; ++je) _Pragma("unroll") for (int jd = 0; jd < 2; ++jd) acc[je][jd] = acc[je][jd] * dec; \
        _Pragma("unroll") for (int ks = 0; ks < 2; ++ks) _Pragma("unroll") for (int je = 0; je < 2; ++je) _Pragma("unroll") for (int jd = 0; jd < 2; ++jd) \
            acc[je][jd] = __builtin_amdgcn_mfma_f32_16x16x32_bf16(*(const bf16x8*)&KF[jd][ks], vfr[je][ks], acc[je][jd], 0, 0, 0); } while (0)
__device__ __forceinline__ void mlstm_state_pass(const int chain, const int half, const bf16_t* __restrict__ Pm, const bf16_t* __restrict__ KTg, const bf16_t* __restrict__ VTg, const float* __restrict__ gate_b,
                                                 bf16_t* __restrict__ CST, float* __restrict__ NST, float* __restrict__ MST, unsigned char* shm, const int tid) {
    const int dir = chain & 1, h = (chain >> 1) & 3, b = chain >> 3, lane = tid & 63, w = tid >> 6, we = w >> 2, wd = w & 3, q4 = lane >> 4, r16 = lane & 15;
    const bool nown = (half == 0) && (we == 0);
    float* sE = (float*)shm; float* sWS = sE + 68 * 64; float* sAL = sWS + 68 * 64; float* sBE = sAL + 68; float* sMO = sBE + 68; float* sDEC = sMO + 68; float* sMB = sDEC + 68;
    const float gbi = gate_b[(dir * 2 + 0) * 4 + h], gbf = gate_b[(dir * 2 + 1) * 4 + h];
    const int gcol_i = ML_OFF + 2048 + (dir * 2 + 0) * 4 + h, gcol_f = ML_OFF + 2048 + (dir * 2 + 1) * 4 + h;
    u32x4 kfA[2][2], vfA[2][2], kfB[2][2], vfB[2][2];
    ML_FRAG_LOAD(kfA, vfA, 0);
    __syncthreads();
    for (int c = w; c < 68; c += 8) { const size_t tokl = (size_t)step_tok(b, dir, c * 64 + lane);
        const float ig = bf2f(Pm[tokl * LDP + gcol_i]) + gbi, fg = bf2f(Pm[tokl * LDP + gcol_f]) + gbf;
        const float lf = fminf(fg, 0.f) - log1pf(expf(-fabsf(fg)));
        const float bcs = wave_scan_incl(lf, lane); const float blast = __shfl(bcs, 63); const float ei = blast - bcs + ig; const float beta = wave_max(ei);
        sE[c * 64 + lane] = ei; if (lane == 0) { sAL[c] = blast; sBE[c] = beta; } }
    __syncthreads();
    if (tid == 0) { float m = 0.f; for (int c = 0; c < 68; ++c) { sMB[c] = m; const float mo = fmaxf(m + sAL[c], sBE[c]); sDEC[c] = expf(sAL[c] + m - mo); sMO[c] = mo; m = mo; } }
    __syncthreads();
    for (int idx = tid; idx < 68 * 64; idx += NTHR) { const int c = idx >> 6, i = idx & 63; sWS[c * 64 + (dir ? 63 - i : i)] = expf(sE[idx] - sMO[c]); }
    if (half == 0 && tid < 68) MST[chain * 68 + tid] = sMB[tid];
    __syncthreads();
    f32x4 acc[2][2];
#pragma unroll
    for (int je = 0; je < 2; ++je)
#pragma unroll
        for (int jd = 0; jd < 2; ++jd) acc[je][jd] = (f32x4){0.f, 0.f, 0.f, 0.f};
    float npart[2] = {0.f, 0.f};
    for (int c2 = 0; c2 < 68; c2 += 2) { ML_CHUNK(c2, kfA, vfA, kfB, vfB); ML_CHUNK(c2 + 1, kfB, vfB, kfA, vfA); }
    __syncthreads();
}
#undef ML_CHUNK
#undef ML_FRAG_LOAD
__device__ __forceinline__ void mlstm_out_item(const int chain, const int c, const bf16_t* __restrict__ Pm, const bf16_t* __restrict__ QKb, const bf16_t* __restrict__ VTg, const float* __restrict__ gate_b,
                                               const bf16_t* __restrict__ CST, const float* __restrict__ NST, const float* __restrict__ MST, float* __restrict__ Hout, unsigned char* shm, const int tid) {
    const int dir = chain & 1, h = (chain >> 1) & 3, b = chain >> 3, lane = tid & 63, w = tid >> 6;
    bf16_t* Qs = (bf16_t*)shm; bf16_t* Ks = (bf16_t*)(shm + 17408); bf16_t* VT = (bf16_t*)(shm + 34816); bf16_t* Cs = (bf16_t*)(shm + 53248); bf16_t* Ss = (bf16_t*)(shm + 88064);
    float* sc = (float*)(shm + 97280);
    __syncthreads();
#pragma unroll
    for (int i = 0; i < 2; ++i) { const int pid = tid + i * 512; const int s = pid >> 4, x0 = (pid & 15) * 8; const size_t toks = (size_t)step_tok(b, dir, c * 64 + s);
        *(u32x4*)(Qs + s * 136 + x0) = *(const u32x4*)(QKb + toks * 1024 + h * 128 + x0);
        *(u32x4*)(Ks + s * 136 + x0) = *(const u32x4*)(QKb + toks * 1024 + 512 + h * 128 + x0);
        { const int e = pid >> 3, o = pid & 7;
          const u32x4 vv = *(const u32x4*)(VTg + ((size_t)tokblock_of(b, dir, c) * 512 + h * 128 + e) * 64 + (dir ? 7 - o : o) * 8);
          *(u32x4*)(VT + e * 72 + o * 8) = dir ? rev8h(vv) : vv; } }
#pragma unroll
    for (int i = 0; i < 4; ++i) { const int pid = tid + i * 512; const int e = pid >> 4, x0 = (pid & 15) * 8;
        *(u32x4*)(Cs + e * 136 + x0) = *(const u32x4*)(CST + ((size_t)(chain * 68 + c) * 128 + e) * 128 + x0); }
    if (tid < 128) sc[384 + tid] = NST[(size_t)(chain * 68 + c) * 128 + tid];
    if (w == 0) {
        const float gbi = gate_b[(dir * 2 + 0) * 4 + h], gbf = gate_b[(dir * 2 + 1) * 4 + h];
        const size_t tokl = (size_t)step_tok(b, dir, c * 64 + lane);
        const float ig = bf2f(Pm[tokl * LDP + ML_OFF + 2048 + (dir * 2 + 0) * 4 + h]) + gbi;
        const float fg = bf2f(Pm[tokl * LDP + ML_OFF + 2048 + (dir * 2 + 1) * 4 + h]) + gbf;
        const float lf = fminf(fg, 0.f) - log1pf(expf(-fabsf(fg)));
        const float bcs = wave_scan_incl(lf, lane); const float gsv = ig - bcs; const float pm = wave_scanmax_incl(gsv, lane);
        const float m_in = MST[chain * 68 + c]; const float mt = bcs + fmaxf(m_in, pm);
        sc[lane] = bcs; sc[64 + lane] = gsv; sc[128 + lane] = mt; sc[192 + lane] = expf(bcs + m_in - mt); sc[256 + lane] = expf(-mt);
    }
    __syncthreads();
    const int tt = w >> 1;
    {   f32x4 aS[2] = {(f32x4){0.f, 0.f, 0.f, 0.f}, (f32x4){0.f, 0.f, 0.f, 0.f}};
#pragma unroll
        for (int ks = 0; ks < 4; ++ks) { const bf16x8 af = *(const bf16x8*)(Qs + (16 * tt + (lane & 15)) * 136 + ks * 32 + (lane >> 4) * 8);
#pragma unroll
            for (int i = 0; i < 2; ++i) { const int st = (w & 1) * 2 + i; const bf16x8 bfr = *(const bf16x8*)(Ks + (16 * st + (lane & 15)) * 136 + ks * 32 + (lane >> 4) * 8);
                aS[i] = __builtin_amdgcn_mfma_f32_16x16x32_bf16(af, bfr, aS[i], 0, 0, 0); } }
        float rs[4] = {0.f, 0.f, 0.f, 0.f};
#pragma unroll
        for (int i = 0; i < 2; ++i) { const int s = 16 * ((w & 1) * 2 + i) + (lane & 15); const float gsv = sc[64 + s];
#pragma unroll
            for (int q = 0; q < 4; ++q) { const int t = 16 * tt + (lane >> 4) * 4 + q; const float val = (s <= t) ? aS[i][q] * expf(sc[t] + gsv - sc[128 + t]) : 0.f; Ss[t * 72 + s] = f2bf(val); rs[q] += val; } }
#pragma unroll
        for (int q = 0; q < 4; ++q) { float r = rs[q]; r += __shfl_xor(r, 1); r += __shfl_xor(r, 2); r += __shfl_xor(r, 4); r += __shfl_xor(r, 8);
            if ((lane & 15) == 0) sc[512 + (w & 1) * 64 + 16 * tt + (lane >> 4) * 4 + q] = r; }
        {   const int t = tid >> 3, part = tid & 7; float dot = 0.f;
#pragma unroll
            for (int j = 0; j < 16; ++j) dot += bf2f(Qs[t * 136 + part * 16 + j]) * sc[384 + part * 16 + j];
            dot += __shfl_xor(dot, 1); dot += __shfl_xor(dot, 2); dot += __shfl_xor(dot, 4);
            if (part == 0) sc[640 + t] = sc[192 + t] * dot; }
    }
    __syncthreads();
    {   f32x4 aN[4];
#pragma unroll
        for (int i = 0; i < 4; ++i) aN[i] = (f32x4){0.f, 0.f, 0.f, 0.f};
#pragma unroll
        for (int ks = 0; ks < 4; ++ks) { const bf16x8 af = *(const bf16x8*)(Qs + (16 * tt + (lane & 15)) * 136 + ks * 32 + (lane >> 4) * 8);
#pragma unroll
            for (int i = 0; i < 4; ++i) { const int et = (w & 1) * 4 + i; const bf16x8 bfr = *(const bf16x8*)(Cs + (16 * et + (lane & 15)) * 136 + ks * 32 + (lane >> 4) * 8);
                aN[i] = __builtin_amdgcn_mfma_f32_16x16x32_bf16(af, bfr, aN[i], 0, 0, 0); } }
#pragma unroll
        for (int q = 0; q < 4; ++q) { const float it = sc[192 + 16 * tt + (lane >> 4) * 4 + q];
#pragma unroll
            for (int i = 0; i < 4; ++i) aN[i][q] *= it; }
#pragma unroll
        for (int ks = 0; ks < 2; ++ks) { const bf16x8 af = *(const bf16x8*)(Ss + (16 * tt + (lane & 15)) * 72 + ks * 32 + (lane >> 4) * 8);
#pragma unroll
            for (int i = 0; i < 4; ++i) { const int et = (w & 1) * 4 + i; const bf16x8 bfr = *(const bf16x8*)(VT + (16 * et + (lane & 15)) * 72 + ks * 32 + (lane >> 4) * 8);
                aN[i] = __builtin_amdgcn_mfma_f32_16x16x32_bf16(af, bfr, aN[i], 0, 0, 0); } }
#pragma unroll
        for (int q = 0; q < 4; ++q) { const int t = 16 * tt + (lane >> 4) * 4 + q; const size_t tokt = (size_t)step_tok(b, dir, c * 64 + t); const float dn = fmaxf(fabsf((sc[512 + t] + sc[576 + t]) + sc[640 + t]), sc[256 + t]);
#pragma unroll
            for (int i = 0; i < 4; ++i) { const int e = 16 * ((w & 1) * 4 + i) + (lane & 15); Hout[tokt * BW + h * 128 + e] = aN[i][q] / dn; } }
    }
}


#define SD_FRAG_LOAD(BF, XF, cc_) do { const int tb_ = tokblock_of(b, dir, (cc_)); const bf16_t* bb_ = BTg + ((size_t)tb_ * 256 + grp * 128 + 64 * (w >> 2) + r16) * 64 + q4 * 8; const bf16_t* xb_ = XTg + ((size_t)tb_ * 512 + h * 64 + 16 * (w & 3) + r16) * 64 + q4 * 8; \
        _Pragma("unroll") for (int ks_ = 0; ks_ < 2; ++ks_) { XF[ks_] = *(const u32x4*)(xb_ + ks_ * 32); _Pragma("unroll") for (int j_ = 0; j_ < 4; ++j_) BF[j_][ks_] = *(const u32x4*)(bb_ + (size_t)j_ * 16 * 64 + ks_ * 32); } } while (0)
#define SD_CHUNK(c_, BF, XF, BFN, XFN) do { const int c = (c_); \
        if (c + 1 < 68) SD_FRAG_LOAD(BFN, XFN, c + 1); \
        const float dec = sDEC[c]; \
        {   bf16_t* ss = SSTb + (size_t)(chain * 68 + c) * 64 * 128; const int p = 16 * (w & 3) + r16; \
            _Pragma("unroll") for (int j = 0; j < 4; ++j) { const int n0 = 16 * ((w >> 2) * 4 + j) + q4 * 4; u32x2 pk; pk.x = pk2(acc[j][0], acc[j][1]); pk.y = pk2(acc[j][2], acc[j][3]); *(u32x2*)(ss + (size_t)p * 128 + n0) = pk; } } \
        bf16x8 xfr[2]; \
        _Pragma("unroll") for (int ks = 0; ks < 2; ++ks) { const float4 wa = *(const float4*)(sSC + c * 64 + ks * 32 + q4 * 8), wb = *(const float4*)(sSC + c * 64 + ks * 32 + q4 * 8 + 4); const u32x4 sv = scale8h(XF[ks], wa, wb); xfr[ks] = *(const bf16x8*)&sv; } \
        _Pragma("unroll") for (int j = 0; j < 4; ++j) acc[j] = acc[j] * dec; \
        _Pragma("unroll") for (int ks = 0; ks < 2; ++ks) _Pragma("unroll") for (int j = 0; j < 4; ++j) acc[j] = __builtin_amdgcn_mfma_f32_16x16x32_bf16(*(const bf16x8*)&BF[j][ks], xfr[ks], acc[j], 0, 0, 0); } while (0)
__device__ __forceinline__ void ssd_state_pass(const int chain, const bf16_t* __restrict__ Pm, const bf16_t* __restrict__ BTg, const bf16_t* __restrict__ XTg, const float Aa, const float dtb,
                                               bf16_t* __restrict__ SSTb, unsigned char* shm, const int tid) {
    const int dir = chain & 1, h = (chain >> 1) & 7, b = chain >> 4, grp = h >> 2, lane = tid & 63, w = tid >> 6, q4 = lane >> 4, r16 = lane & 15;
    float* sSC = (float*)shm; float* sDEC = sSC + 68 * 64;
    const int dcol = SSD_OFF + 1536 + dir * 8 + h;
    u32x4 bfA[4][2], xfA[2], bfB[4][2], xfB[2];
    SD_FRAG_LOAD(bfA, xfA, 0);
    __syncthreads();
    for (int c = w; c < 68; c += 8) { const float xv = bf2f(Pm[(size_t)step_tok(b, dir, c * 64 + lane) * LDP + dcol]) + dtb; const float dtv = xv > 20.f ? xv : log1pf(expf(xv));
        const float cs = wave_scan_incl(dtv * Aa, lane); const float cl = __shfl(cs, 63);
        sSC[c * 64 + (dir ? 63 - lane : lane)] = dtv * expf(cl - cs); if (lane == 0) sDEC[c] = expf(cl); }
    __syncthreads();
    f32x4 acc[4];
#pragma unroll
    for (int j = 0; j < 4; ++j) acc[j] = (f32x4){0.f, 0.f, 0.f, 0.f};
    for (int c2 = 0; c2 < 68; c2 += 2) { SD_CHUNK(c2, bfA, xfA, bfB, xfB); SD_CHUNK(c2 + 1, bfB, xfB, bfA, xfA); }
    __syncthreads();
}
#undef SD_CHUNK
#undef SD_FRAG_LOAD
__device__ __forceinline__ void ssd_out_item(const int chain, const int c, const bf16_t* __restrict__ Pm, const bf16_t* __restrict__ XBb, const bf16_t* __restrict__ XTg, const float Aa, const float dtb,
                                             const bf16_t* __restrict__ SSTb, float* __restrict__ Yout, unsigned char* shm, const int tid) {
    const int dir = chain & 1, h = (chain >> 1) & 7, b = chain >> 4, grp = h >> 2, lane = tid & 63, w = tid >> 6;
    bf16_t* Cs = (bf16_t*)shm; bf16_t* Bs = (bf16_t*)(shm + 17408); bf16_t* XT = (bf16_t*)(shm + 34816); bf16_t* Sin = (bf16_t*)(shm + 44032); bf16_t* Gs = (bf16_t*)(shm + 61440);
    float* sc = (float*)(shm + 70656);
    __syncthreads();
#pragma unroll
    for (int i = 0; i < 2; ++i) { const int pid = tid + i * 512; const int s = pid >> 4, x0 = (pid & 15) * 8; const size_t toks = (size_t)step_tok(b, dir, c * 64 + s);
        *(u32x4*)(Bs + s * 136 + x0) = *(const u32x4*)(XBb + toks * 1024 + 512 + grp * 128 + x0);
        *(u32x4*)(Cs + s * 136 + x0) = *(const u32x4*)(XBb + toks * 1024 + 768 + grp * 128 + x0);
        const int p = pid >> 4;
        *(u32x4*)(Sin + p * 136 + x0) = *(const u32x4*)(SSTb + ((size_t)(chain * 68 + c) * 64 + p) * 128 + x0); }
    {   const int p = tid >> 3, o = tid & 7;
        const u32x4 vv = *(const u32x4*)(XTg + ((size_t)tokblock_of(b, dir, c) * 512 + h * 64 + p) * 64 + (dir ? 7 - o : o) * 8);
        *(u32x4*)(XT + p * 72 + o * 8) = dir ? rev8h(vv) : vv; }
    if (w == 0) { const size_t tokl = (size_t)step_tok(b, dir, c * 64 + lane);
        const float xv = bf2f(Pm[tokl * LDP + SSD_OFF + 1536 + dir * 8 + h]) + dtb; const float dtv = xv > 20.f ? xv : log1pf(expf(xv));
        sc[lane] = wave_scan_incl(dtv * Aa, lane); sc[64 + lane] = dtv; }
    __syncthreads();
    {   const int lt = w >> 1;
        f32x4 aG[2] = {(f32x4){0.f, 0.f, 0.f, 0.f}, (f32x4){0.f, 0.f, 0.f, 0.f}};
#pragma unroll
        for (int ks = 0; ks < 4; ++ks) { const bf16x8 af = *(const bf16x8*)(Cs + (16 * lt + (lane & 15)) * 136 + ks * 32 + (lane >> 4) * 8);
#pragma unroll
            for (int i = 0; i < 2; ++i) { const int st = (w & 1) * 2 + i; const bf16x8 bfr = *(const bf16x8*)(Bs + (16 * st + (lane & 15)) * 136 + ks * 32 + (lane >> 4) * 8);
                aG[i] = __builtin_amdgcn_mfma_f32_16x16x32_bf16(af, bfr, aG[i], 0, 0, 0); } }
#pragma unroll
        for (int i = 0; i < 2; ++i) { const int s = 16 * ((w & 1) * 2 + i) + (lane & 15); const float css = sc[s], dts = sc[64 + s];
#pragma unroll
            for (int q = 0; q < 4; ++q) { const int t = 16 * lt + (lane >> 4) * 4 + q; const float val = (s <= t) ? aG[i][q] * expf(sc[t] - css) * dts : 0.f; Gs[t * 72 + s] = f2bf(val); } }
    }
    __syncthreads();
    {   const int lt = w >> 1;
        f32x4 aY[2] = {(f32x4){0.f, 0.f, 0.f, 0.f}, (f32x4){0.f, 0.f, 0.f, 0.f}};
#pragma unroll
        for (int ks = 0; ks < 4; ++ks) { const bf16x8 af = *(const bf16x8*)(Cs + (16 * lt + (lane & 15)) * 136 + ks * 32 + (lane >> 4) * 8);
#pragma unroll
            for (int i = 0; i < 2; ++i) { const int pt = (w & 1) * 2 + i; const bf16x8 bfr = *(const bf16x8*)(Sin + (16 * pt + (lane & 15)) * 136 + ks * 32 + (lane >> 4) * 8);
                aY[i] = __builtin_amdgcn_mfma_f32_16x16x32_bf16(af, bfr, aY[i], 0, 0, 0); } }
#pragma unroll
        for (int q = 0; q < 4; ++q) { const float ec = expf(sc[16 * lt + (lane >> 4) * 4 + q]); aY[0][q] *= ec; aY[1][q] *= ec; }
#pragma unroll
        for (int ks = 0; ks < 2; ++ks) { const bf16x8 af = *(const bf16x8*)(Gs + (16 * lt + (lane & 15)) * 72 + ks * 32 + (lane >> 4) * 8);
#pragma unroll
            for (int i = 0; i < 2; ++i) { const int pt = (w & 1) * 2 + i; const bf16x8 bfr = *(const bf16x8*)(XT + (16 * pt + (lane & 15)) * 72 + ks * 32 + (lane >> 4) * 8);
                aY[i] = __builtin_amdgcn_mfma_f32_16x16x32_bf16(af, bfr, aY[i], 0, 0, 0); } }
#pragma unroll
        for (int q = 0; q < 4; ++q) { const int t = 16 * lt + (lane >> 4) * 4 + q; const size_t tokt = (size_t)step_tok(b, dir, c * 64 + t);
#pragma unroll
            for (int i = 0; i < 2; ++i) { const int p = 16 * ((w & 1) * 2 + i) + (lane & 15); Yout[tokt * BW + h * 64 + p] = aY[i][q]; } }
    }
}


#define FIDX(i) ((i) + ((i) >> 4))
#define FFT_X_BYTES 69632
__device__ constexpr float FFT_CW_RE[6][16] = {{0.f, 0.f, 0.f, 0.f, 0.f, 0.f, 0.f, 0.f, 0.f, 0.f, 0.f, 0.f, 0.f, 0.f, 0.f, 0.f}, {1.0f, 0.f, 0.f, 0.f, 0.f, 0.f, 0.f, 0.f, 0.f, 0.f, 0.f, 0.f, 0.f, 0.f, 0.f, 0.f}, {1.0f, 6.123233995736766e-17f, 0.f, 0.f, 0.f, 0.f, 0.f, 0.f, 0.f, 0.f, 0.f, 0.f, 0.f, 0.f, 0.f, 0.f}, {1.0f, 0.7071067811865476f, 6.123233995736766e-17f, -0.7071067811865475f, 0.f, 0.f, 0.f, 0.f, 0.f, 0.f, 0.f, 0.f, 0.f, 0.f, 0.f, 0.f}, {1.0f, 0.9238795325112867f, 0.7071067811865476f, 0.38268343236508984f, 6.123233995736766e-17f, -0.3826834323650897f, -0.7071067811865475f, -0.9238795325112867f, 0.f, 0.f, 0.f, 0.f, 0.f, 0.f, 0.f, 0.f}, {1.0f, 0.9807852804032304f, 0.9238795325112867f, 0.8314696123025452f, 0.7071067811865476f, 0.5555702330196023f, 0.38268343236508984f, 0.19509032201612833f, 6.123233995736766e-17f, -0.1950903220161282f, -0.3826834323650897f, -0.555570233019602f, -0.7071067811865475f, -0.8314696123025453f, -0.9238795325112867f, -0.9807852804032304f}};
__device__ constexpr float FFT_CW_IM[6][16] = {{0.f, 0.f, 0.f, 0.f, 0.f, 0.f, 0.f, 0.f, 0.f, 0.f, 0.f, 0.f, 0.f, 0.f, 0.f, 0.f}, {-0.0f, 0.f, 0.f, 0.f, 0.f, 0.f, 0.f, 0.f, 0.f, 0.f, 0.f, 0.f, 0.f, 0.f, 0.f, 0.f}, {-0.0f, -1.0f, 0.f, 0.f, 0.f, 0.f, 0.f, 0.f, 0.f, 0.f, 0.f, 0.f, 0.f, 0.f, 0.f, 0.f}, {-0.0f, -0.7071067811865475f, -1.0f, -0.7071067811865476f, 0.f, 0.f, 0.f, 0.f, 0.f, 0.f, 0.f, 0.f, 0.f, 0.f, 0.f, 0.f}, {-0.0f, -0.3826834323650898f, -0.7071067811865475f, -0.9238795325112867f, -1.0f, -0.9238795325112867f, -0.7071067811865476f, -0.3826834323650899f, 0.f, 0.f, 0.f, 0.f, 0.f, 0.f, 0.f, 0.f}, {-0.0f, -0.19509032201612825f, -0.3826834323650898f, -0.5555702330196022f, -0.7071067811865475f, -0.8314696123025452f, -0.9238795325112867f, -0.9807852804032304f, -1.0f, -0.9807852804032304f, -0.9238795325112867f, -0.8314696123025455f, -0.7071067811865476f, -0.5555702330196022f, -0.3826834323650899f, -0.1950903220161286f}};
__host__ __device__ constexpr int fft_bitrev(int k, int R) { int r = 0; for (int i = 0; i < R; ++i) if (k & (1 << i)) r |= 1 << (R - 1 - i); return r; }
template <int R, bool INV>
__device__ __forceinline__ void fft_pass(float2* __restrict__ X, const float2* __restrict__ TW, const int s0, const int gidx) {
    const int lowbits = 13 - s0 - R; const int stride = 1 << lowbits;
    const int low = gidx & (stride - 1), high = gidx >> lowbits; const int base = (high << (lowbits + R)) | low;
    const int p0 = FIDX(base);
#define FFT_SLOT(k) (lowbits >= 4 ? p0 + (k) * (stride + (stride >> 4)) : p0 + (k) + ((k) >> 4))
    float2 v[1 << R];
#pragma unroll
    for (int k = 0; k < (1 << R); ++k) v[k] = X[FFT_SLOT(k)];
    const int lw = low << s0;
    if (!INV) {
#pragma unroll
        for (int j = 0; j < R; ++j) { const int hk = 1 << (R - 1 - j);
#pragma unroll
            for (int k = 0; k < (1 << R); ++k) if (!(k & hk)) { const int kk = k & (hk - 1);
                const float2 a = v[k], b = v[k + hk]; v[k] = make_float2(a.x + b.x, a.y + b.y); const float dx = a.x - b.x, dy = a.y - b.y;
                if (kk == 0) v[k + hk] = make_float2(dx, dy);
                else if (2 * kk == hk) v[k + hk] = make_float2(dy, -dx);
                else { const float cr = FFT_CW_RE[R - j][kk], ci = FFT_CW_IM[R - j][kk]; v[k + hk] = make_float2(dx * cr - dy * ci, dx * ci + dy * cr); } } }
        if (lowbits > 0) {
#pragma unroll
            for (int k = 1; k < (1 << R); ++k) { const float2 w = TW[(lw * fft_bitrev(k, R)) & 8191]; const float2 a = v[k]; v[k] = make_float2(a.x * w.x - a.y * w.y, a.x * w.y + a.y * w.x); } }
    } else {
        if (lowbits > 0) {
#pragma unroll
            for (int k = 1; k < (1 << R); ++k) { const float2 w = TW[(lw * fft_bitrev(k, R)) & 8191]; const float2 a = v[k]; v[k] = make_float2(a.x * w.x + a.y * w.y, a.y * w.x - a.x * w.y); } }
#pragma unroll
        for (int j = R - 1; j >= 0; --j) { const int hk = 1 << (R - 1 - j);
#pragma unroll
            for (int k = 0; k < (1 << R); ++k) if (!(k & hk)) { const int kk = k & (hk - 1);
                const float2 a = v[k], b = v[k + hk]; float tx, ty;
                if (kk == 0) { tx = b.x; ty = b.y; }
                else if (2 * kk == hk) { tx = -b.y; ty = b.x; }
                else { const float cr = FFT_CW_RE[R - j][kk], ci = FFT_CW_IM[R - j][kk]; tx = b.x * cr + b.y * ci; ty = b.y * cr - b.x * ci; }
                v[k] = make_float2(a.x + tx, a.y + ty); v[k + hk] = make_float2(a.x - tx, a.y - ty); } }
    }
#pragma unroll
    for (int k = 0; k < (1 << R); ++k) X[FFT_SLOT(k)] = v[k];
#undef FFT_SLOT
}
__device__ __forceinline__ void fft_fwd(float2* X, const float2* TW, const int tid) {
    fft_pass<4, false>(X, TW, 0, tid); __syncthreads(); fft_pass<4, false>(X, TW, 4, tid); __syncthreads(); if (tid < 256) fft_pass<5, false>(X, TW, 8, tid); __syncthreads(); }
__device__ __forceinline__ void fft_inv(float2* X, const float2* TW, const int tid) {
    if (tid < 256) fft_pass<5, true>(X, TW, 8, tid); __syncthreads(); fft_pass<4, true>(X, TW, 4, tid); __syncthreads(); fft_pass<4, true>(X, TW, 0, tid); __syncthreads(); }
__device__ __forceinline__ void fft_twiddles(float2* TW, const int tid) {
#pragma unroll
    for (int k = 0; k < 16; ++k) { const int m = tid + k * 512; const float xx = (float)m * (1.0f / 4096.0f); TW[m] = make_float2(cospif(xx), -sinpif(xx)); }
}
__device__ __forceinline__ void hyena_spec_item(const int oc, const float* __restrict__ HR, const float* __restrict__ nrm, float2* __restrict__ HSPEC, unsigned char* shm, const int tid) {
    float2* X = (float2*)shm; const float2* TW = (const float2*)(shm + FFT_X_BYTES);
    const int o = oc >> 9, c = oc & 511; const float inv = 1.0f / nrm[oc];
    __syncthreads();
#pragma unroll 2
    for (int k = 0; k < 16; ++k) { const int j = tid + k * 512; float v;
        if (j < SEQ) v = HR[(unsigned)j * 2048u + o * 1024 + c] * inv; else if (j == SEQ) v = 0.f; else v = HR[(unsigned)(2 * SEQ - j) * 2048u + o * 1024 + 512 + c] * inv;
        X[FIDX(j)] = make_float2(v, 0.f); }
    __syncthreads();
    fft_fwd(X, TW, tid);
    float4* out = (float4*)(HSPEC + (size_t)oc * 8192 + tid * 16); const float2* xs = X + 17 * tid;
#pragma unroll
    for (int k = 0; k < 8; ++k) { const float2 x0 = xs[2 * k], x1 = xs[2 * k + 1]; out[k] = make_float4(x0.x * (1.0f / 8192.0f), x0.y * (1.0f / 8192.0f), x1.x * (1.0f / 8192.0f), x1.y * (1.0f / 8192.0f)); }
}
__device__ __forceinline__ void fft_mul_spec(float2* X, const float2* __restrict__ H, const int tid) {
    const float4* h4 = (const float4*)(H + tid * 16); float2* xs = X + 17 * tid;
#pragma unroll
    for (int k = 0; k < 8; ++k) { const float4 hv = h4[k]; const float2 x0 = xs[2 * k], x1 = xs[2 * k + 1];
        xs[2 * k] = make_float2(x0.x * hv.x - x0.y * hv.y, x0.x * hv.y + x0.y * hv.x); xs[2 * k + 1] = make_float2(x1.x * hv.z - x1.y * hv.w, x1.x * hv.w + x1.y * hv.z); }
}
__device__ __forceinline__ void hyena_fft_item(const int item, const float* __restrict__ UT, const float2* __restrict__ HSPEC, const float* __restrict__ bias, float* __restrict__ YT, unsigned char* shm, const int tid) {
    float2* X = (float2*)shm; const float2* TW = (const float2*)(shm + FFT_X_BYTES);
    const int c = item >> 1, b0 = (item & 1) * 2, b1 = b0 + 1;
    const float* u0 = UT + (size_t)(b0 * 1536 + c) * SEQ + tid * 8; const float* u1 = UT + (size_t)(b1 * 1536 + c) * SEQ + tid * 8;
    const float bias0 = bias[c], bias1 = bias[512 + c];
    float2* xs = X + FIDX(8 * tid);
    float vr[8], vi[8];
    __syncthreads();
    { const float4 a0 = *(const float4*)u0, a1 = *(const float4*)(u0 + 4), c0 = *(const float4*)u1, c1 = *(const float4*)(u1 + 4);
      vr[0] = a0.x; vr[1] = a0.y; vr[2] = a0.z; vr[3] = a0.w; vr[4] = a1.x; vr[5] = a1.y; vr[6] = a1.z; vr[7] = a1.w;
      vi[0] = c0.x; vi[1] = c0.y; vi[2] = c0.z; vi[3] = c0.w; vi[4] = c1.x; vi[5] = c1.y; vi[6] = c1.z; vi[7] = c1.w; }
#pragma unroll
    for (int k = 0; k < 8; ++k) { xs[k] = make_float2(vr[k], vi[k]); xs[4352 + k] = make_float2(0.f, 0.f); }
    __syncthreads();
    fft_fwd(X, TW, tid);
    fft_mul_spec(X, HSPEC + (size_t)c * 8192, tid);
    __syncthreads();
    fft_inv(X, TW, tid);
    { const float* p0 = u0 + (size_t)512 * SEQ; const float* p1 = u1 + (size_t)512 * SEQ;
      const float4 a0 = *(const float4*)p0, a1 = *(const float4*)(p0 + 4), c0 = *(const float4*)p1, c1 = *(const float4*)(p1 + 4);
      const float xr[8] = {a0.x, a0.y, a0.z, a0.w, a1.x, a1.y, a1.z, a1.w}, xi[8] = {c0.x, c0.y, c0.z, c0.w, c1.x, c1.y, c1.z, c1.w};
#pragma unroll
      for (int k = 0; k < 8; ++k) { const float2 cv = xs[k]; const float zr = xr[k] * (cv.x + bias0 * vr[k]), zi = xi[k] * (cv.y + bias0 * vi[k]);
          vr[k] = zr; vi[k] = zi; xs[k] = make_float2(zr, zi); xs[4352 + k] = make_float2(0.f, 0.f); } }
    __syncthreads();
    fft_fwd(X, TW, tid);
    fft_mul_spec(X, HSPEC + (size_t)(512 + c) * 8192, tid);
    __syncthreads();
    fft_inv(X, TW, tid);
    { const float* p0 = u0 + (size_t)1024 * SEQ; const float* p1 = u1 + (size_t)1024 * SEQ;
      const float4 a0 = *(const float4*)p0, a1 = *(const float4*)(p0 + 4), c0 = *(const float4*)p1, c1 = *(const float4*)(p1 + 4);
      const float xr[8] = {a0.x, a0.y, a0.z, a0.w, a1.x, a1.y, a1.z, a1.w}, xi[8] = {c0.x, c0.y, c0.z, c0.w, c1.x, c1.y, c1.z, c1.w};
      float yr[8], yi[8];
#pragma unroll
      for (int k = 0; k < 8; ++k) { const float2 cv = xs[k]; yr[k] = xr[k] * (cv.x + bias1 * vr[k]); yi[k] = xi[k] * (cv.y + bias1 * vi[k]); }
      float* y0 = YT + (size_t)(b0 * 512 + c) * SEQ + tid * 8; float* y1 = YT + (size_t)(b1 * 512 + c) * SEQ + tid * 8;
      *(float4*)y0 = make_float4(yr[0], yr[1], yr[2], yr[3]); *(float4*)(y0 + 4) = make_float4(yr[4], yr[5], yr[6], yr[7]);
      *(float4*)y1 = make_float4(yi[0], yi[1], yi[2], yi[3]); *(float4*)(y1 + 4) = make_float4(yi[4], yi[5], yi[6], yi[7]); }
}

constexpr size_t al256(size_t x) { return (x + 255) & ~(size_t)255; }
constexpr size_t O_BAR = 0;
constexpr size_t O_MOD = 16384;
constexpr size_t O_NORM = O_MOD + al256((size_t)2 * 5 * 6 * DM * 4);
constexpr size_t O_QCTR = O_NORM + al256((size_t)2 * 2 * 1024 * 4);
constexpr size_t O_ZERO_END = O_QCTR + 512;
constexpr size_t O_XS = O_ZERO_END;
constexpr size_t O_HB = O_XS + al256((size_t)NTOK * DM * 4);
constexpr size_t O_P = O_HB + al256((size_t)NTOK * DM * 2);
constexpr size_t O_WIN = O_P + al256((size_t)NTOK * LDP * 2);
constexpr size_t O_WBR = O_WIN + al256((size_t)LDP * DM * 2);
constexpr size_t O_WOUT = O_WBR + al256((size_t)4 * DM * BW * 2);
constexpr size_t O_WGU = O_WOUT + al256((size_t)DM * DM * 2);
constexpr size_t O_WD = O_WGU + al256((size_t)NEXP * 2 * DEXP * DM * 2);
constexpr size_t O_GLU = O_WD + al256((size_t)NEXP * DM * DEXP * 2);
constexpr size_t O_Y4 = O_GLU + al256((size_t)BW * BW * 2);
constexpr size_t O_U = O_Y4 + al256((size_t)NTOK * DM * 2);
constexpr size_t O_QKB = O_U + al256((size_t)NTOK * 1536 * 4);
constexpr size_t O_CST = O_QKB + al256((size_t)NTOK * 1024 * 2);
constexpr size_t O_NST = O_CST + al256((size_t)32 * 68 * 128 * 128 * 2);
constexpr size_t O_MST = O_NST + al256((size_t)32 * 68 * 128 * 4);
constexpr size_t O_XBC = O_MST + al256((size_t)32 * 68 * 4);
constexpr size_t O_SST = O_XBC + al256((size_t)NTOK * 1024 * 2);
constexpr size_t O_HF = O_SST + al256((size_t)64 * 68 * 64 * 128 * 2);
constexpr size_t O_YF = O_HF + al256((size_t)2 * NTOK * BW * 4);
constexpr size_t O_SF = O_YF + al256((size_t)2 * NTOK * BW * 4);
constexpr size_t O_LDT = O_SF + al256((size_t)2 * NCTX * BW * 4);
constexpr size_t O_AP = O_LDT + al256((size_t)4096 * 16);
constexpr size_t O_BBT = O_AP + al256((size_t)4096 * 33 * 8);
constexpr size_t O_KT = O_BBT + al256((size_t)4096 * 16 * 8);
constexpr size_t O_S5A = O_KT + al256((size_t)32 * 2 * 32 * 256 * 4);
constexpr size_t O_S5B = O_S5A + al256((size_t)32 * 512 * 768 * 2);
constexpr size_t O_XCTX = O_S5B + al256((size_t)32 * 512 * 768 * 2);
constexpr size_t O_Z = O_XCTX + al256((size_t)4 * 32 * 2 * 64 * 8);
constexpr size_t O_HRAW = O_Z + al256((size_t)NTOK * BW * 4);
constexpr size_t O_HSPEC = O_HRAW + al256((size_t)(SEQ + CTXL) * 2048 * 4);
constexpr size_t O_K2C = O_HSPEC + al256((size_t)1024 * 8192 * 8);
constexpr size_t O_GG = O_K2C + al256((size_t)(2 * CTXL) * 1024 * 4);
constexpr size_t O_PROBS = O_GG + al256((size_t)NTOK * BW * 2);
constexpr size_t O_ROWTOK = O_PROBS + al256((size_t)NTOK * 16 * 4);
constexpr size_t O_ROWGATE = O_ROWTOK + al256((size_t)NEXP * MOE_PAD * 4);
constexpr size_t O_INV = O_ROWGATE + al256((size_t)NEXP * MOE_PAD * 4);
constexpr size_t O_NORMP = O_INV + al256((size_t)NTOK * 16 * 4);
constexpr size_t WS_END = O_NORMP + al256((size_t)4 * 256 * 2048 * 4);
constexpr size_t O_XG = O_P;
constexpr size_t O_HID = O_P + al256((size_t)NEXP * MOE_PAD * DM * 2);
constexpr size_t O_YEXP = O_HID + al256((size_t)NEXP * MOE_PAD * DEXP * 2);
static_assert(O_YEXP + (size_t)NEXP * MOE_PAD * DM * 2 <= O_WIN, "MoE temporaries must fit inside P");
static_assert((size_t)NTOK * DM * 2 <= (size_t)NTOK * 1536 * 4, "ACCb must fit inside U");
static_assert((size_t)26214400 + (size_t)2 * 17825792 + (size_t)272 * 256 * 64 * 2 <= (size_t)NTOK * DM * 2, "strip buffers must fit inside HB");
static_assert(WS_END <= (size_t)1851000000, "workspace map exceeds the guaranteed size");

struct Args {
    const float* in[47];
    float* out; unsigned char* ws;
    int ph_lo, ph_hi;
};

__device__ __forceinline__ void conv_tile(const float* __restrict__ src, int ldsrc, int nvalid, int k0, int n0, bf16_t* __restrict__ dst, int lddst, int mode, float* T, int tid) {
    { const int n = tid & 63, kr = tid >> 6;
#pragma unroll
      for (int i = 0; i < 8; ++i) { const int k = i * 8 + kr; T[k * 65 + n] = (n0 + n < nvalid) ? src[(size_t)(k0 + k) * ldsrc + n0 + n] : 0.f; } }
    __syncthreads();
    { const int n = tid >> 3, kc = (tid & 7) * 8; const int gn = n0 + n;
      const int drow = mode == 0 ? gn : (32 * (gn >> 4) + (mode == 2 ? 16 : 0) + (gn & 15));
      u32x4 w; w.x = pk2(T[(kc + 0) * 65 + n], T[(kc + 1) * 65 + n]); w.y = pk2(T[(kc + 2) * 65 + n], T[(kc + 3) * 65 + n]);
      w.z = pk2(T[(kc + 4) * 65 + n], T[(kc + 5) * 65 + n]); w.w = pk2(T[(kc + 6) * 65 + n], T[(kc + 7) * 65 + n]);
      *(u32x4*)(dst + (size_t)drow * lddst + k0 + kc) = w; }
    __syncthreads();
}

#define IN(id) (lo <= (id) && (id) < hi)
#define SEAM(id) do { if (hi > (id) + 1) xcd_barrier(bar); } while (0)
#define PH_BEGIN int tid = threadIdx.x; asm volatile("" : "+v"(tid) :: "memory"); const int lane = tid & 63, wave = tid >> 6; (void)lane; (void)wave;

#define x_in (PT(0))
#define c_in (PT(1))
#define ctx_in (PT(2))
#define cctx_in (PT(3))
#define ada_w (PT(4))
#define ada_b (PT(5))
#define norm_mix (PT(6))
#define norm_ffn (PT(7))
#define w_in (PT(8))
#define XS ((float*)(a.ws + O_XS))
#define MOD ((float*)(a.ws + O_MOD))
#define NORM ((float*)(a.ws + O_NORM))
#define NORMP ((float*)(a.ws + O_NORMP))
#define MODl (MOD + (size_t)l * 5 * 6 * DM)
#define HB ((bf16_t*)(a.ws + O_HB))
#define P ((bf16_t*)(a.ws + O_P))
#define WIN ((bf16_t*)(a.ws + O_WIN))
#define WBR ((bf16_t*)(a.ws + O_WBR))
#define WOUT ((bf16_t*)(a.ws + O_WOUT))
#define WGU ((bf16_t*)(a.ws + O_WGU))
#define WD ((bf16_t*)(a.ws + O_WD))
#define GLU ((bf16_t*)(a.ws + O_GLU))
#define Y4 ((bf16_t*)(a.ws + O_Y4))
#define U ((float*)(a.ws + O_U))
#define ACCb ((bf16_t*)(a.ws + O_U))
#define QKB ((bf16_t*)(a.ws + O_QKB))
#define CST ((bf16_t*)(a.ws + O_CST))
#define NST ((float*)(a.ws + O_NST))
#define MST ((float*)(a.ws + O_MST))
#define XBC ((bf16_t*)(a.ws + O_XBC))
#define SSTB ((bf16_t*)(a.ws + O_SST))
#define HF ((float*)(a.ws + O_HF))
#define HBk (HF + (size_t)NTOK * BW)
#define YF ((float*)(a.ws + O_YF))
#define YB (YF + (size_t)NTOK * BW)
#define SF ((float*)(a.ws + O_SF))
#define SB (SF + (size_t)NCTX * BW)
#define LDT ((double2*)(a.ws + O_LDT))
#define APW ((float2*)(a.ws + O_AP))
#define BBT ((float2*)(a.ws + O_BBT))
#define KTB ((float*)(a.ws + O_KT))
#define S5A ((bf16_t*)(a.ws + O_S5A))
#define S5B ((bf16_t*)(a.ws + O_S5B))
#define XCTX ((float2*)(a.ws + O_XCTX))
#define S5P ((bf16_t*)(a.ws + O_HB))
#define XLOC ((float*)(a.ws + O_HB + (size_t)32 * 256 * 512 * 2))
#define KTG ((bf16_t*)(a.ws + O_HB + (size_t)26214400))
#define VTG ((bf16_t*)(a.ws + O_HB + (size_t)26214400 + (size_t)17825792))
#define BTG ((bf16_t*)(a.ws + O_HB + (size_t)26214400 + (size_t)2 * 17825792))
#define XTG ((bf16_t*)(a.ws + O_GG))
#define Z ((float*)(a.ws + O_Z))
#define HRAW ((float*)(a.ws + O_HRAW))
#define HSPEC ((float2*)(a.ws + O_HSPEC))
#define UT ((float*)(a.ws + O_U))
#define YT ((float*)(a.ws + O_Z))
#define QCTR ((int*)(a.ws + O_QCTR))
#define K2C ((float*)(a.ws + O_K2C))
#define GG ((bf16_t*)(a.ws + O_GG))
#define PROBS ((float*)(a.ws + O_PROBS))
#define ROWTOK ((int*)(a.ws + O_ROWTOK))
#define ROWGATE ((float*)(a.ws + O_ROWGATE))
#define XG ((bf16_t*)(a.ws + O_XG))
#define HID ((bf16_t*)(a.ws + O_HID))
#define YEXP ((bf16_t*)(a.ws + O_YEXP))
#define INV ((int*)(a.ws + O_INV))


__device__ __forceinline__ void moe_combine(float4 (&v)[8], const int tok, const int lane, const int* __restrict__ inv, const float* __restrict__ rowgate, const bf16_t* __restrict__ yexp, const float* __restrict__ m5) {
    float4 a[8];
#pragma unroll
    for (int i = 0; i < 8; ++i) a[i] = make_float4(0.f, 0.f, 0.f, 0.f);
    for (int e = 0; e < 16; ++e) { const int row = __builtin_amdgcn_readfirstlane(inv[tok * 16 + e]);
        if (row >= 0) { const float gt = rowgate[row]; const bf16_t* yr = yexp + (size_t)row * DM + lane * 4;
#pragma unroll
            for (int i = 0; i < 8; ++i) { const u32x2 w = *(const u32x2*)(yr + i * 256);
                a[i].x += gt * __uint_as_float(w.x << 16); a[i].y += gt * __uint_as_float(w.x & 0xFFFF0000u); a[i].z += gt * __uint_as_float(w.y << 16); a[i].w += gt * __uint_as_float(w.y & 0xFFFF0000u); } } }
#pragma unroll
    for (int i = 0; i < 8; ++i) { const float4 mm = *(const float4*)(m5 + i * 256 + lane * 4); v[i].x += mm.x * a[i].x; v[i].y += mm.y * a[i].y; v[i].z += mm.z * a[i].z; v[i].w += mm.w * a[i].w; }
}
struct CvU { const float* src; bf16_t* dst; int ldsrc, nvalid, k0, n0, lddst, mode; };
__device__ __forceinline__ void cv_load(const CvU& u, float4 (&r)[8], const int tid) {
#pragma unroll
    for (int i = 0; i < 8; ++i) { const int idx = tid + i * 512; const int k = idx >> 6, n = u.n0 + (idx & 63) * 4;
        r[i] = (n < u.nvalid) ? *(const float4*)(u.src + (size_t)(u.k0 + k) * u.ldsrc + n) : make_float4(0.f, 0.f, 0.f, 0.f); }
}
__device__ __forceinline__ void cv_stage(float* T, const float4 (&r)[8], const int tid) {
#pragma unroll
    for (int i = 0; i < 8; ++i) { const int idx = tid + i * 512; float* p = T + (idx >> 6) * 257 + (idx & 63) * 4; p[0] = r[i].x; p[1] = r[i].y; p[2] = r[i].z; p[3] = r[i].w; }
}
__device__ __forceinline__ void cv_store(const CvU& u, const float* T, const int tid) {
#pragma unroll
    for (int j = 0; j < 4; ++j) { const int o = tid + j * 512; const int kc = (o & 7) * 8, n = o >> 3; const int gn = u.n0 + n;
        const int drow = u.mode == 0 ? gn : (256 * (gn >> 7) + (u.mode == 2 ? 128 : 0) + (gn & 127));
        const float* t = T + kc * 257 + n;
        u32x4 w; w.x = pk2(t[0], t[257]); w.y = pk2(t[2 * 257], t[3 * 257]); w.z = pk2(t[4 * 257], t[5 * 257]); w.w = pk2(t[6 * 257], t[7 * 257]);
        *(u32x4*)(u.dst + (size_t)drow * u.lddst + u.k0 + kc) = w; }
}
template <int LAYER>
__device__ __forceinline__ void layer_body(const Args& a, const XcdBarrier& bar, const int lo, const int hi, const int bid, const int G, unsigned char* const shm, float* const sf, const float** const ptab) {
        constexpr int l = LAYER;
        constexpr int PB = 1 + 16 * l;
        const bool lastl = (l == 1);

        const int nPanels = lastl ? 64 : 68;
        const int M2 = nPanels * 256;

        if (IN(PB + 0)) for (int rep_ = 0; rep_ < (l == 0 ? PROBE_REPS(0) : 1); ++rep_) {
            PH_BEGIN
            {   const float* wbr = PT(40) + (size_t)l * 4 * BW * DM; const float* wout = PT(41) + (size_t)l * DM * DM;
                const float* wg = PT(43) + (size_t)l * NEXP * DM * DEXP; const float* wu = PT(44) + (size_t)l * NEXP * DM * DEXP; const float* wd = PT(45) + (size_t)l * NEXP * DEXP * DM;
                const float* wglu = PT(32) + (size_t)l * BW * BW; const float* win = w_in + (size_t)l * DM * IN_W;
                const int n_win = 32 * 55, n_br = 4 * 64, n_out = 32 * 8, n_gu = 16 * 2 * 192, n_d = 16 * 192, n_glu = 16;
                const int total = n_win + n_br + n_out + n_gu + n_d + n_glu;
#define CV_DECODE(q_, u_) do { int qq_ = (q_); \
                    if (qq_ < n_win) { u_ = CvU{win, WIN, IN_W, IN_W, (qq_ / 55) * 64, (qq_ % 55) * 256, DM, 0}; } else { qq_ -= n_win; \
                    if (qq_ < n_br) { const int k = qq_ >> 6, r = qq_ & 63; u_ = CvU{wbr + (size_t)k * BW * DM, WBR + (size_t)k * DM * BW, DM, DM, (r >> 3) * 64, (r & 7) * 256, BW, 0}; } else { qq_ -= n_br; \
                    if (qq_ < n_out) { u_ = CvU{wout, WOUT, DM, DM, (qq_ >> 3) * 64, (qq_ & 7) * 256, DM, 0}; } else { qq_ -= n_out; \
                    if (qq_ < n_gu) { const int e = qq_ / 384, r = qq_ % 384, up = r / 192, r2 = r % 192; u_ = CvU{(up ? wu : wg) + (size_t)e * DM * DEXP, WGU + (size_t)e * 2 * DEXP * DM, DEXP, DEXP, (r2 / 6) * 64, (r2 % 6) * 256, DM, 1 + up}; } else { qq_ -= n_gu; \
                    if (qq_ < n_d) { const int e = qq_ / 192, r = qq_ % 192; u_ = CvU{wd + (size_t)e * DEXP * DM, WD + (size_t)e * DM * DEXP, DM, DM, (r >> 3) * 64, (r & 7) * 256, DEXP, 0}; } else { qq_ -= n_d; \
                    u_ = CvU{wglu, GLU, BW, BW, (qq_ >> 1) * 64, (qq_ & 1) * 256, BW, 0}; } } } } } } while (0)
                __syncthreads();
                int q = bid; int buf = 0; CvU u; float4 r[8];
                if (q < total) { CV_DECODE(q, u); cv_load(u, r, tid); }
                while (q < total) {
                    float* T = sf + buf * (64 * 257);
                    cv_stage(T, r, tid);
                    __syncthreads();
                    const CvU cur = u; const int qn = q + G;
                    if (qn < total) { CV_DECODE(qn, u); cv_load(u, r, tid); }
                    cv_store(cur, T, tid);
                    buf ^= 1; q = qn;
                }
#undef CV_DECODE
                __syncthreads();
            }
            for (int set = 0; set < (lastl ? 1 : 2); ++set) {
                const int L = set ? CTXL : SEQ; float* HR = HRAW + (set ? (size_t)SEQ * 2048 : 0);
                const float* w1 = PT(11) + l * 33 * 64; const float* b1 = PT(12) + l * 64; const float* fr1 = PT(13) + l * 64; const float* w2 = PT(14) + l * 64 * 64; const float* b2 = PT(15) + l * 64;
                const float* fr2 = PT(16) + l * 64; const float* w3 = PT(17) + l * 64 * 2048; const float* decay = PT(18) + l * 2048;
                float* feats = sf; float* h1 = sf + 16 * 33; float* h2 = h1 + 16 * 64;
                float nacc[4] = {0.f, 0.f, 0.f, 0.f};
                for (int base = bid; base < L; base += 16 * G) {
                    __syncthreads();
                    for (int e = tid; e < 16 * 33; e += NTHR) { const int ti = e / 33, fi = e % 33; int t = base + ti * G; if (t > L - 1) t = L - 1;
                        float v;
                        if (fi == 0) v = (float)t / (float)(L - 1);
                        else { const int j = (fi - 1) & 15; const double fr = 1e-4 + (double)j * ((15.0 - 1e-4) / 15.0); const double ang = (2.0 * 3.14159265358979323846 / (double)L) * (double)t * fr; v = fi <= 16 ? (float)cos(ang) : (float)(-sin(ang)); }
                        feats[e] = v; }
                    __syncthreads();
                    { const int j = tid & 63, ti = tid >> 6; float s0 = b1[j], s1 = s0;
_Pragma("unroll 3")
                      for (int i = 0; i < 33; ++i) { const float wv = w1[i * 64 + j]; s0 += feats[ti * 33 + i] * wv; s1 += feats[(ti + 8) * 33 + i] * wv; }
                      const float f1 = fr1[j]; h1[ti * 64 + j] = sinf(f1 * s0); h1[(ti + 8) * 64 + j] = sinf(f1 * s1); }
                    __syncthreads();
                    { const int j = tid & 63, ti = tid >> 6; float s0 = b2[j], s1 = s0;
_Pragma("unroll 4")
                      for (int i = 0; i < 64; ++i) { const float wv = w2[i * 64 + j]; s0 += h1[ti * 64 + i] * wv; s1 += h1[(ti + 8) * 64 + i] * wv; }
                      const float f2 = fr2[j]; h2[ti * 64 + j] = sinf(f2 * s0); h2[(ti + 8) * 64 + j] = sinf(f2 * s1); }
                    __syncthreads();
                    float acc[16][4];
#pragma unroll
                    for (int ti = 0; ti < 16; ++ti) { acc[ti][0] = 0.f; acc[ti][1] = 0.f; acc[ti][2] = 0.f; acc[ti][3] = 0.f; }
#pragma unroll 2
                    for (int i = 0; i < 64; ++i) { const float* wrow = w3 + (size_t)i * 2048 + tid; const float wa = wrow[0], wb = wrow[512], wc2 = wrow[1024], wd2 = wrow[1536];
#pragma unroll
                        for (int ti = 0; ti < 16; ++ti) { const float hv = h2[ti * 64 + i]; acc[ti][0] += hv * wa; acc[ti][1] += hv * wb; acc[ti][2] += hv * wc2; acc[ti][3] += hv * wd2; } }
                    float dk[4];
#pragma unroll
                    for (int k = 0; k < 4; ++k) dk[k] = fabsf(decay[tid + k * 512]);
#pragma unroll
                    for (int ti = 0; ti < 16; ++ti) { const int t = base + ti * G; if (t < L) { const float tn = (float)t / (float)(L - 1);
#pragma unroll
                        for (int k = 0; k < 4; ++k) { const float v = acc[ti][k] * expf(-tn * dk[k]); HR[(size_t)t * 2048 + tid + k * 512] = v; nacc[k] += fabsf(v); } } }
                }
                float* nrp = NORMP + ((size_t)(l * 2 + set) * 256 + bid) * 2048;
#pragma unroll
                for (int k = 0; k < 4; ++k) nrp[tid + k * 512] = nacc[k];
            }
            for (int idx = bid * NTHR + tid; idx < 4096; idx += G * NTHR) { const int n = idx & 63, g = (idx >> 6) & 31, dir = idx >> 11;
                const double are = (double)(PT(24) + l * 4096)[idx], aim = (double)(PT(25) + l * 4096)[idx]; const double lam = are < -1e-4 ? are : -1e-4; const double dt = exp((double)(PT(26) + l * 64)[dir * 32 + g]);
                const double ldre = lam * dt, ldim = aim * dt; LDT[idx] = make_double2(ldre, ldim);
                const double mag = exp(ldre); const double ar = mag * cos(ldim), ai = mag * sin(ldim);
                const double den = lam * lam + aim * aim; const double nr = ar - 1.0, ni = ai; const double fre = (nr * lam + ni * aim) / den, fim = (ni * lam - nr * aim) / den;
                const float* b_re = PT(27) + l * 32 * 64 * 16; const float* b_im = PT(28) + l * 32 * 64 * 16;
#pragma unroll 4
                for (int c = 0; c < 16; ++c) { const double br = (double)b_re[(g * 64 + n) * 16 + c], bi = (double)b_im[(g * 64 + n) * 16 + c]; BBT[idx * 16 + c] = make_float2((float)(fre * br - fim * bi), (float)(fre * bi + fim * br)); }
            }
            for (int e2 = bid * NTHR + tid; e2 < 4096 * 33; e2 += G * NTHR) { const int idx = e2 / 33, k = e2 - idx * 33; const int g = (idx >> 6) & 31, dir = idx >> 11;
                const double are = (double)(PT(24) + l * 4096)[idx], aim = (double)(PT(25) + l * 4096)[idx]; const double lam = are < -1e-4 ? are : -1e-4; const double dt = exp((double)(PT(26) + l * 64)[dir * 32 + g]);
                const double ldre = lam * dt, ldim = aim * dt; const double mk = exp(ldre * k); APW[e2] = make_float2((float)(mk * cos(ldim * k)), (float)(mk * sin(ldim * k))); }
            if (l == 0 && lo == 0) xcd_barrier(bar);
            for (int tok = bid * 8 + wave; tok < NTOK; tok += G * 8) {
                const int r = tok < NLAT ? tok / SEQ : 4; const float* xr = l == 0 ? (tok < NLAT ? x_in + (size_t)tok * DM : ctx_in + (size_t)(tok - NLAT) * DM) : XS + (size_t)tok * DM; const float* gn = norm_mix + l * DM;
                const float* sh = MODl + (size_t)(r * 6 + 0) * DM; const float* sc = MODl + (size_t)(r * 6 + 1) * DM;
                float4 v[8]; float ss = 0.f;
#pragma unroll
                for (int i = 0; i < 8; ++i) v[i] = *(const float4*)(xr + i * 256 + lane * 4);
                if (l > 0) {
                    moe_combine(v, tok, lane, INV, ROWGATE, YEXP, MOD + (size_t)((l - 1) * 5 + r) * 6 * DM + 5 * DM);
#pragma unroll
                    for (int i = 0; i < 8; ++i) *(float4*)(XS + (size_t)tok * DM + i * 256 + lane * 4) = v[i]; }
#pragma unroll
                for (int i = 0; i < 8; ++i) ss += v[i].x * v[i].x + v[i].y * v[i].y + v[i].z * v[i].z + v[i].w * v[i].w;
                ss = wave_sum(ss); const float rs = rsqrtf(ss * (1.0f / DM) + 1e-6f);
#pragma unroll
                for (int i = 0; i < 8; ++i) { const int d = i * 256 + lane * 4; const float4 g4 = *(const float4*)(gn + d), s4 = *(const float4*)(sc + d), h4 = *(const float4*)(sh + d);
                    v[i].x = v[i].x * rs * g4.x * (1.f + s4.x) + h4.x; v[i].y = v[i].y * rs * g4.y * (1.f + s4.y) + h4.y; v[i].z = v[i].z * rs * g4.z * (1.f + s4.z) + h4.z; v[i].w = v[i].w * rs * g4.w * (1.f + s4.w) + h4.w; }
#pragma unroll
                for (int i = 0; i < 8; ++i) { u32x2 w; w.x = pk2(v[i].x, v[i].y); w.y = pk2(v[i].z, v[i].w); *(u32x2*)(HB + (size_t)tok * DM + i * 256 + lane * 4) = w; }
            }
            SEAM(PB + 0);
        }

        if (IN(PB + 1)) for (int rep_ = 0; rep_ < PROBE_REPS(1); ++rep_) {
            PH_BEGIN
            for (int base = bid * 8; base < (lastl ? 1 : 2) * 1024; base += G * 8) {
                const int idx = base + (tid & 7), sl = tid >> 3; const int set = idx >> 10, oc = idx & 1023, o = oc >> 9, c = oc & 511;
                const float* pp = NORMP + (size_t)(l * 2 + set) * 256 * 2048 + o * 1024 + c + (size_t)(sl * 4) * 2048; float sacc = 0.f;
#pragma unroll
                for (int j = 0; j < 4; ++j) if (sl * 4 + j < G) sacc += pp[(size_t)j * 2048] + pp[(size_t)j * 2048 + 512];
                sf[sl * 8 + (tid & 7)] = sacc; __syncthreads();
                if (tid < 8) { float t = 0.f;
#pragma unroll 8
                    for (int q = 0; q < 64; ++q) t += sf[q * 8 + tid];
                    NORM[(size_t)(l * 2 + set) * 1024 + oc] = t; }
                __syncthreads(); }
            for (int idx = (G - 1 - bid) * NTHR + tid; idx < 32768; idx += G * NTHR) { const int c = idx & 15, lag = (idx >> 4) & 31, dir = (idx >> 9) & 1, g = idx >> 10;
                const float* c_re = PT(29) + l * 32 * 16 * 64 + (g * 16 + c) * 64; const float* c_im = PT(30) + l * 32 * 16 * 64 + (g * 16 + c) * 64;
                float acc[16];
#pragma unroll
                for (int j = 0; j < 16; ++j) acc[j] = 0.f;
#pragma unroll 2
                for (int n = 0; n < 64; ++n) { const int pi = (dir * 32 + g) * 64 + n; const float2 ap = APW[pi * 33 + lag]; const float cr = c_re[n], ci = c_im[n]; const float wr_ = cr * ap.x - ci * ap.y, wi_ = cr * ap.y + ci * ap.x;
                    const float4* bb = (const float4*)(BBT + pi * 16);
#pragma unroll
                    for (int j = 0; j < 8; ++j) { const float4 b2 = bb[j]; acc[2 * j] += wr_ * b2.x - wi_ * b2.y; acc[2 * j + 1] += wr_ * b2.z - wi_ * b2.w; } }
                float4* o = (float4*)(KTB + (size_t)idx * 16);
                o[0] = make_float4(acc[0], acc[1], acc[2], acc[3]); o[1] = make_float4(acc[4], acc[5], acc[6], acc[7]); o[2] = make_float4(acc[8], acc[9], acc[10], acc[11]); o[3] = make_float4(acc[12], acc[13], acc[14], acc[15]);
            }
            __syncthreads();
            pg8::Gemm g{HB, WIN, DM, DM, DM}; pg8::SchedStd S{68, 55, G, bid, DM, DM}; pg8::EpiWin E{P, LDP};
            pg8::gemm_phase(( LAS unsigned char*)shm, g, S, E);
#if defined(PROBE_BNOEPI)
            { __syncthreads(); pg8::EpiNone E0; pg8::gemm_phase((LAS unsigned char*)shm, g, S, E0); }
#endif
            SEAM(PB + 1);
        }

        if (IN(PB + 2)) for (int rep_ = 0; rep_ < PROBE_REPS(2); ++rep_) {
            PH_BEGIN
            const float* hcw = PT(9) + l * 3 * 1536; const float* hcb = PT(10) + l * 1536; const float* mcw = PT(20) + l * 3 * 1024; const float* mcb = PT(21) + l * 1024;
            const float* scw = PT(34) + l * 3 * 1024; const float* scb = PT(35) + l * 1024;
            for (int unit = bid; unit < 272 * 3; unit += G) { const int seg = unit / 3, kind = unit % 3; const bool lat = seg < 256; const size_t tok0 = lat ? (size_t)seg * 64 : (size_t)NLAT + (size_t)(seg - 256) * 64;
                if (kind < 2) { const int hf = kind;
                    const int c = tid * 2; const int col = (hf ? SSD_OFF + 512 : ML_OFF) + c; const float* w = hf ? scw : mcw; const float* bsp = hf ? scb : mcb; bf16_t* dst = (hf ? XBC : QKB) + tok0 * 1024 + c;
                    const float2 w0 = *(const float2*)(w + c), w1 = *(const float2*)(w + 1024 + c), w2 = *(const float2*)(w + 2048 + c), bb = *(const float2*)(bsp + c);
                    const float osc = (!hf && c >= 512) ? 0.08838834764831845f : 1.0f;
                    const bool hasPrev = !lat && ((tok0 - NLAT) & (CTXL - 1)) != 0, hasNext = !lat && (((tok0 - NLAT) + 63) & (CTXL - 1)) != CTXL - 1;
                    bf16_t* strip = nullptr;
                    if (!hf) { if (c >= 512) strip = KTG + ((size_t)seg * 512 + (c - 512)) * 64; }
                    else { if (c < 512) strip = XTG + ((size_t)seg * 512 + c) * 64; else if (c < 768) strip = BTG + ((size_t)seg * 256 + (c - 512)) * 64; }
                    const bf16_t* pp = P + tok0 * LDP + col;
                    unsigned raw[66];
#pragma unroll
                    for (int t = 0; t < 66; ++t) raw[t] = ((t == 0 && !hasPrev) || (t == 65 && !hasNext)) ? 0u : *(const unsigned*)(pp + (ptrdiff_t)(t - 1) * LDP);
#pragma unroll
                    for (int t8 = 0; t8 < 8; ++t8) { float v0[8], v1[8];
#pragma unroll
                        for (int tt = 0; tt < 8; ++tt) { const int t = t8 * 8 + tt; const unsigned p0 = raw[t], p1 = raw[t + 1], p2 = raw[t + 2];
                            float a0 = bb.x + w0.x * __uint_as_float(p0 << 16) + w1.x * __uint_as_float(p1 << 16) + w2.x * __uint_as_float(p2 << 16);
                            float a1 = bb.y + w0.y * __uint_as_float(p0 & 0xFFFF0000u) + w1.y * __uint_as_float(p1 & 0xFFFF0000u) + w2.y * __uint_as_float(p2 & 0xFFFF0000u);
                            a0 = siluf_(a0) * osc; a1 = siluf_(a1) * osc; v0[tt] = a0; v1[tt] = a1;
                            *(unsigned*)(dst + (size_t)t * 1024) = pk2(a0, a1); }
                        if (strip) { u32x4 s0, s1; s0.x = pk2(v0[0], v0[1]); s0.y = pk2(v0[2], v0[3]); s0.z = pk2(v0[4], v0[5]); s0.w = pk2(v0[6], v0[7]); s1.x = pk2(v1[0], v1[1]); s1.y = pk2(v1[2], v1[3]); s1.z = pk2(v1[4], v1[5]); s1.w = pk2(v1[6], v1[7]);
                            *(u32x4*)(strip + t8 * 8) = s0; *(u32x4*)(strip + 64 + t8 * 8) = s1; } }
                } else {
                    const int c = (tid & 255) * 2, th = tid >> 8; const bf16_t* pp = P + (tok0 + th * 32) * LDP + ML_OFF + 1024 + c; bf16_t* strip = VTG + ((size_t)seg * 512 + c) * 64 + th * 32;
                    unsigned rv[32];
#pragma unroll
                    for (int t = 0; t < 32; ++t) rv[t] = *(const unsigned*)(pp + (size_t)t * LDP);
#pragma unroll
                    for (int t8 = 0; t8 < 4; ++t8) { u32x4 s0, s1;
                        s0.x = (rv[t8 * 8 + 0] & 0xFFFFu) | (rv[t8 * 8 + 1] << 16); s0.y = (rv[t8 * 8 + 2] & 0xFFFFu) | (rv[t8 * 8 + 3] << 16); s0.z = (rv[t8 * 8 + 4] & 0xFFFFu) | (rv[t8 * 8 + 5] << 16); s0.w = (rv[t8 * 8 + 6] & 0xFFFFu) | (rv[t8 * 8 + 7] << 16);
                        s1.x = (rv[t8 * 8 + 0] >> 16) | (rv[t8 * 8 + 1] & 0xFFFF0000u); s1.y = (rv[t8 * 8 + 2] >> 16) | (rv[t8 * 8 + 3] & 0xFFFF0000u); s1.z = (rv[t8 * 8 + 4] >> 16) | (rv[t8 * 8 + 5] & 0xFFFF0000u); s1.w = (rv[t8 * 8 + 6] >> 16) | (rv[t8 * 8 + 7] & 0xFFFF0000u);
                        *(u32x4*)(strip + t8 * 8) = s0; *(u32x4*)(strip + 64 + t8 * 8) = s1; }
                }
            }
            if (!lastl) for (int tok = NLAT + bid; tok < NTOK; tok += G) {
                const int t = (tok - NLAT) & (CTXL - 1); const bool hasL = (t != 0), hasR = (t != CTXL - 1); const bf16_t* pr = P + (size_t)tok * LDP;
#pragma unroll
                for (int j = 0; j < 3; ++j) { const int cc = tid + j * 512;
                    float acc = hcb[cc] + hcw[1536 + cc] * bf2f(pr[HY_OFF + cc]);
                    if (hasL) acc += hcw[cc] * bf2f(pr[HY_OFF + cc - LDP]);
                    if (hasR) acc += hcw[2 * 1536 + cc] * bf2f(pr[HY_OFF + cc + LDP]);
                    U[(size_t)tok * 1536 + cc] = acc; }
            }
            for (int idx0 = bid * NTHR + tid; idx0 < 16384 * 64; idx0 += 4 * G * NTHR) { u32x4 t4[4];
#pragma unroll
                for (int q = 0; q < 4; ++q) { const int idx = idx0 + q * G * NTHR; const int half = idx & 1, g = (idx >> 1) & 31, tok = idx >> 6;
                    if (idx < 16384 * 64) t4[q] = *(const u32x4*)(P + (size_t)tok * LDP + S5_OFF + g * 16 + half * 8); }
#pragma unroll
                for (int q = 0; q < 4; ++q) { const int idx = idx0 + q * G * NTHR; const int half = idx & 1, g = (idx >> 1) & 31, tok = idx >> 6;
                    if (idx < 16384 * 64) *(u32x4*)(S5A + ((size_t)g * 512 + (tok >> 5)) * 768 + (tok & 31) * 16 + half * 8) = t4[q]; } }
            for (int idx = bid * NTHR + tid; idx < 32 * 512 * 32 * 2; idx += G * NTHR) { const int half = idx & 1, sI = (idx >> 1) & 31, row = (idx >> 6) & 511, g = idx >> 15; const int t = row >> 4, c = row & 15; const int lag = t - sI;
                float v[8];
                if (lag > 0) { const float4* k4 = (const float4*)(KTB + ((size_t)((g * 2 + 0) * 32 + lag) * 16 + c) * 16 + half * 8); const float4 a0 = k4[0], a1 = k4[1]; v[0] = a0.x; v[1] = a0.y; v[2] = a0.z; v[3] = a0.w; v[4] = a1.x; v[5] = a1.y; v[6] = a1.z; v[7] = a1.w; }
                else if (lag < 0) { const float4* k4 = (const float4*)(KTB + ((size_t)((g * 2 + 1) * 32 - lag) * 16 + c) * 16 + half * 8); const float4 a0 = k4[0], a1 = k4[1]; v[0] = a0.x; v[1] = a0.y; v[2] = a0.z; v[3] = a0.w; v[4] = a1.x; v[5] = a1.y; v[6] = a1.z; v[7] = a1.w; }
                else { const float4* k4 = (const float4*)(KTB + ((size_t)((g * 2 + 0) * 32) * 16 + c) * 16 + half * 8); const float4* q4 = (const float4*)(KTB + ((size_t)((g * 2 + 1) * 32) * 16 + c) * 16 + half * 8); const float4 a0 = k4[0], a1 = k4[1], b0 = q4[0], b1 = q4[1];
                    v[0] = a0.x + b0.x; v[1] = a0.y + b0.y; v[2] = a0.z + b0.z; v[3] = a0.w + b0.w; v[4] = a1.x + b1.x; v[5] = a1.y + b1.y; v[6] = a1.z + b1.z; v[7] = a1.w + b1.w; }
                u32x4 w; w.x = pk2(v[0], v[1]); w.y = pk2(v[2], v[3]); w.z = pk2(v[4], v[5]); w.w = pk2(v[6], v[7]);
                *(u32x4*)(S5B + ((size_t)g * 512 + row) * 768 + sI * 16 + half * 8) = w; }
            for (int idx = bid * NTHR + tid; idx < 32 * 512 * 64; idx += G * NTHR) { const int n = idx & 63, row = (idx >> 6) & 511, g = idx >> 15; const int t = row >> 4, c = row & 15;
                const float cr = (PT(29) + l * 32 * 16 * 64)[(g * 16 + c) * 64 + n], ci = (PT(30) + l * 32 * 16 * 64)[(g * 16 + c) * 64 + n];
                const float2 af = APW[((0 * 32 + g) * 64 + n) * 33 + t + 1], ab = APW[((1 * 32 + g) * 64 + n) * 33 + 32 - t];
                bf16_t* d = S5B + ((size_t)g * 512 + row) * 768 + 512 + 2 * n;
                *(unsigned*)d = pk2(cr * af.x - ci * af.y, -(cr * af.y + ci * af.x)); *(unsigned*)(d + 128) = pk2(cr * ab.x - ci * ab.y, -(cr * ab.y + ci * ab.x)); }
            for (int idx = bid * NTHR + tid; idx < 32 * 2 * 64 * 32; idx += G * NTHR) { const int sI = idx & 31, n = (idx >> 5) & 63, dir = (idx >> 11) & 1, g = idx >> 12; const int pi = (dir * 32 + g) * 64 + n;
                const float2 pw = APW[pi * 33 + (dir ? sI : 31 - sI)]; const float4* bb = (const float4*)(BBT + pi * 16);
                float re[16], im[16];
#pragma unroll
                for (int j = 0; j < 8; ++j) { const float4 b2 = bb[j]; re[2 * j] = pw.x * b2.x - pw.y * b2.y; im[2 * j] = pw.x * b2.y + pw.y * b2.x; re[2 * j + 1] = pw.x * b2.z - pw.y * b2.w; im[2 * j + 1] = pw.x * b2.w + pw.y * b2.z; }
                bf16_t* d = S5P + ((size_t)g * 256 + dir * 128 + 2 * n) * 512 + sI * 16;
                u32x4 w0, w1; w0.x = pk2(re[0], re[1]); w0.y = pk2(re[2], re[3]); w0.z = pk2(re[4], re[5]); w0.w = pk2(re[6], re[7]); w1.x = pk2(re[8], re[9]); w1.y = pk2(re[10], re[11]); w1.z = pk2(re[12], re[13]); w1.w = pk2(re[14], re[15]);
                *(u32x4*)d = w0; *(u32x4*)(d + 8) = w1;
                w0.x = pk2(im[0], im[1]); w0.y = pk2(im[2], im[3]); w0.z = pk2(im[4], im[5]); w0.w = pk2(im[6], im[7]); w1.x = pk2(im[8], im[9]); w1.y = pk2(im[10], im[11]); w1.z = pk2(im[12], im[13]); w1.w = pk2(im[14], im[15]);
                *(u32x4*)(d + 512) = w0; *(u32x4*)(d + 520) = w1; }
            {   float* T = sf;
                for (int unit = bid; unit < 4 * 64 * 24; unit += G) { const int b = unit / (64 * 24), r = (unit / 24) % 64, c0 = (unit % 24) * 64; const size_t tok0 = (size_t)b * SEQ + r * 64;
                    __syncthreads();
#pragma unroll
                    for (int i = 0; i < 8; ++i) { const int c = tid & 63, t = (tid >> 6) + 8 * i; T[t * 65 + c] = bf2f(P[(tok0 + t) * LDP + HY_OFF + c0 + c]); }
                    __syncthreads();
                    const int c = tid >> 3, tq = (tid & 7) * 8, cc = c0 + c; const float w0 = hcw[cc], w1 = hcw[1536 + cc], w2 = hcw[3072 + cc], bb = hcb[cc];
                    float o8[8];
#pragma unroll
                    for (int i = 0; i < 8; ++i) { const int t = tq + i; float acc = bb + w1 * T[t * 65 + c]; if (t > 0) acc += w0 * T[(t - 1) * 65 + c]; if (t < 63) acc += w2 * T[(t + 1) * 65 + c]; o8[i] = acc; }
                    float* dst = UT + ((size_t)b * 1536 + cc) * SEQ + r * 64 + tq;
                    *(float4*)dst = make_float4(o8[0], o8[1], o8[2], o8[3]); *(float4*)(dst + 4) = make_float4(o8[4], o8[5], o8[6], o8[7]);
                } }
            if (!lastl) {
                const int L = CTXL; const float* HR = HRAW + (size_t)SEQ * 2048; float* K2 = K2C; const float* nrm = NORM + (size_t)(l * 2 + 1) * 1024;
                const size_t total = (size_t)(2 * L - 1) * 1024;
                for (size_t i = (size_t)bid * NTHR + tid; i < total; i += (size_t)G * NTHR) { const int j = (int)(i >> 10), oc = (int)(i & 1023), o = oc >> 9, c = oc & 511; const int lag = j - (L - 1);
                    const float v = lag >= 0 ? HR[(size_t)lag * 2048 + o * 1024 + c] : HR[(size_t)(-lag) * 2048 + o * 1024 + 512 + c];
                    K2[((size_t)j * 2 + o) * 512 + c] = v / nrm[oc]; }
            }
            {   __syncthreads(); fft_twiddles((float2*)(shm + FFT_X_BYTES), tid);
                for (int oc = bid; oc < 1024; oc += G) hyena_spec_item(oc, HRAW, NORM + (size_t)(l * 2 + 0) * 1024, HSPEC, shm, tid);
                __syncthreads(); }
            SEAM(PB + 2);
        }

        if (IN(PB + 3)) for (int rep_ = 0; rep_ < PROBE_REPS(3); ++rep_) {
            PH_BEGIN
            if (rep_ > 0) { if (bid == 0 && tid == 0) __hip_atomic_store(QCTR + l * 64, 0, __ATOMIC_RELAXED, __HIP_MEMORY_SCOPE_AGENT); xcd_barrier(bar); }
            if (bid < 64) {
                mlstm_state_pass(bid >> 1, bid & 1, P, KTG, VTG, PT(22) + l * 16, CST, NST, MST, shm, tid);
            } else if (bid < 128) {
                { const int ch = bid - 64; const int dir_ = ch & 1, h_ = (ch >> 1) & 7; ssd_state_pass(ch, P, BTG, XTG, -expf(PT(37)[l * 16 + dir_ * 8 + h_]), PT(36)[l * 16 + dir_ * 8 + h_], SSTB, shm, tid); }
            } else if (bid < 160) {
                const int widx = (bid - 128) * 8 + wave; const int dir = widx & 1, g = (widx >> 1) & 31, b = widx >> 6; const int n = lane;
                float2* xb = (float2*)(shm + (size_t)wave * 16640); float2* ctab = xb + 16 * 65;
                const float* a_re = PT(24) + l * 2 * 32 * 64; const float* a_im = PT(25) + l * 2 * 32 * 64; const float* log_dt = PT(26) + l * 64;
                const float* b_re = PT(27) + l * 32 * 64 * 16; const float* b_im = PT(28) + l * 32 * 64 * 16; const float* c_re = PT(29) + l * 32 * 16 * 64; const float* c_im = PT(30) + l * 32 * 16 * 64;
#pragma unroll
                for (int c = 0; c < 16; ++c) ctab[c * 65 + lane] = make_float2(c_re[(g * 16 + c) * 64 + lane], c_im[(g * 16 + c) * 64 + lane]);
                float abr, abi, bbr[16], bbi[16];
                {   const double are = (double)a_re[(dir * 32 + g) * 64 + n], aim = (double)a_im[(dir * 32 + g) * 64 + n];
                    const double lam = are < -1e-4 ? are : -1e-4; const double dt = exp((double)log_dt[dir * 32 + g]);
                    const double mag = exp(lam * dt); const double ar = mag * cos(aim * dt), ai = mag * sin(aim * dt);
                    const double den = lam * lam + aim * aim; const double nr = ar - 1.0, ni = ai;
                    const double fre = (nr * lam + ni * aim) / den, fim = (ni * lam - nr * aim) / den;
                    abr = (float)ar; abi = (float)ai;
#pragma unroll
                    for (int c = 0; c < 16; ++c) { const double br = (double)b_re[(g * 64 + n) * 16 + c], bi = (double)b_im[(g * 64 + n) * 16 + c]; bbr[c] = (float)(fre * br - fim * bi); bbi[c] = (float)(fre * bi + fim * br); }
                }
                float xr = 0.f, xi = 0.f; float* Sout = (dir ? SB : SF) - (size_t)NLAT * BW;
                const int s = lane >> 2, cg = lane & 3;
                for (int i0 = 0; i0 < CTXL; i0 += 16) {
#pragma unroll 4
                    for (int ss = 0; ss < 16; ++ss) {
                        const size_t tok = (size_t)step_tok(b, dir, i0 + ss);
                        const u32x4* up = (const u32x4*)(P + tok * LDP + S5_OFF + g * 16);
                        float t0[8], t1[8]; unpack8(up[0], t0); unpack8(up[1], t1);
                        float bur = 0.f, bui = 0.f;
#pragma unroll
                        for (int c = 0; c < 8; ++c) { bur += t0[c] * bbr[c] + t1[c] * bbr[8 + c]; bui += t0[c] * bbi[c] + t1[c] * bbi[8 + c]; }
                        const float nxr = abr * xr - abi * xi + bur, nxi = abr * xi + abi * xr + bui; xr = nxr; xi = nxi;
                        xb[ss * 65 + lane] = make_float2(xr, xi);
                    }
                    asm volatile("s_waitcnt lgkmcnt(0)" ::: "memory");
                    float y0 = 0.f, y1 = 0.f, y2 = 0.f, y3 = 0.f;
                    for (int nn2 = 0; nn2 < 64; ++nn2) { const float2 xv = xb[s * 65 + nn2];
                        const float2 c0 = ctab[(cg * 4 + 0) * 65 + nn2], c1 = ctab[(cg * 4 + 1) * 65 + nn2], c2 = ctab[(cg * 4 + 2) * 65 + nn2], c3 = ctab[(cg * 4 + 3) * 65 + nn2];
                        y0 += xv.x * c0.x - xv.y * c0.y; y1 += xv.x * c1.x - xv.y * c1.y; y2 += xv.x * c2.x - xv.y * c2.y; y3 += xv.x * c3.x - xv.y * c3.y; }
                    const size_t toks = (size_t)step_tok(b, dir, i0 + s);
                    *(float4*)(Sout + toks * BW + g * 16 + cg * 4) = make_float4(y0, y1, y2, y3);
                    asm volatile("s_waitcnt lgkmcnt(0)" ::: "memory");
                }
                XCTX[((b * 32 + g) * 2 + dir) * 64 + n] = make_float2(xr, xi);
            } else {
                if (bid < 224) {
                    pg8::Gemm gg_{S5A, S5P, 768, 512, 512}; pg8::SchedS5a S_{bid - 160}; pg8::EpiXloc E_{XLOC};
                    pg8::gemm_phase((LAS unsigned char*)shm, gg_, S_, E_);
                    __syncthreads();
                }
                const int nhb = G - 160, hb = bid - 160; const float* bias = PT(19) + l * 1024; const int c = tid;
                const int nitems = lastl ? 0 : 4 * (CTXL / 8);
                for (int it = hb; it < nitems; it += nhb) {
                    int L, tokbase, b, t0; const float* K2;
                    { const int q = it; L = CTXL; tokbase = NLAT; b = q / (CTXL / 8); t0 = (q % (CTXL / 8)) * 8; K2 = K2C; }
                    const float* zb = U + (size_t)(tokbase + b * L) * 1536 + c;
                    float acc[8];
#pragma unroll
                    for (int i = 0; i < 8; ++i) acc[i] = 0.f;
                    const int base = t0 + L - 1;
                    for (int s = 0; s < L; s += 8) {
                        float k[15];
#pragma unroll
                        for (int mm = 0; mm < 15; ++mm) k[mm] = K2[((size_t)(base - s - 7 + mm) * 2 + 0) * 512 + c];
#pragma unroll
                        for (int ds = 0; ds < 8; ++ds) { const float z = zb[(size_t)(s + ds) * 1536];
#pragma unroll
                            for (int i = 0; i < 8; ++i) acc[i] += k[i - ds + 7] * z; }
                    }
#pragma unroll
                    for (int i = 0; i < 8; ++i) { const size_t tok = (size_t)(tokbase + b * L + t0 + i); const float zt = U[tok * 1536 + c]; Z[tok * BW + c] = (acc[i] + bias[c] * zt) * U[tok * 1536 + 512 + c]; }
                }
            }
            {   __syncthreads(); fft_twiddles((float2*)(shm + FFT_X_BYTES), tid);
                int* qslot = (int*)(shm + FFT_X_BYTES + 65536);
                for (;;) { __syncthreads(); if (tid == 0) *qslot = atomicAdd(QCTR + l * 64, 1); __syncthreads(); const int it = *qslot; if (it >= 1024) break;
                    hyena_fft_item(it, UT, HSPEC, PT(19) + l * 1024, YT, shm, tid); }
            }
            SEAM(PB + 3);
        }

        if (IN(PB + 4)) for (int rep_ = 0; rep_ < PROBE_REPS(4); ++rep_) {
            PH_BEGIN
            if (rep_ > 0) { if (bid == 0 && tid == 0) __hip_atomic_store(QCTR + l * 64 + 32, 0, __ATOMIC_RELAXED, __HIP_MEMORY_SCOPE_AGENT); xcd_barrier(bar); }
            if (bid >= G - 32) for (int idx = (bid - (G - 32)) * NTHR + tid; idx < 16384; idx += 32 * NTHR) { const int n = idx & 63, dir = (idx >> 6) & 1, b = (idx >> 7) & 3, g = idx >> 9;
                const float2 a32 = APW[((dir * 32 + g) * 64 + n) * 33 + 32]; float2 X = XCTX[((b * 32 + g) * 2 + dir) * 64 + n];
                const float* __restrict__ xl = XLOC + ((size_t)g * 512 + b * 128) * 256 + dir * 128 + 2 * n; bf16_t* __restrict__ dst = S5A + ((size_t)g * 512 + b * 128) * 768 + 512 + dir * 128 + 2 * n;
#pragma unroll 1
                for (int j0 = 0; j0 < 128; j0 += 16) { float2 xv[16];
#pragma unroll
                    for (int q = 0; q < 16; ++q) { const int j = dir ? 127 - (j0 + q) : j0 + q; xv[q] = *(const float2*)(xl + (size_t)j * 256); }
#pragma unroll
                    for (int q = 0; q < 16; ++q) { const int j = dir ? 127 - (j0 + q) : j0 + q;
                        *(unsigned*)(dst + (size_t)j * 768) = pk2(X.x, X.y);
                        const float nx = a32.x * X.x - a32.y * X.y + xv[q].x, ny = a32.x * X.y + a32.y * X.x + xv[q].y; X.x = nx; X.y = ny; } } }
            {   int* qslot = (int*)(shm + 102400);
                for (;;) { __syncthreads(); if (tid == 0) *qslot = atomicAdd(QCTR + l * 64 + 32, 1); __syncthreads(); const int it = *qslot; if (it >= 32 * 68 + 64 * 68) break;
                    if (it < 32 * 68) { const int chain = it / 68, c = it % 68; mlstm_out_item(chain, c, P, QKB, VTG, PT(22) + l * 16, CST, NST, MST, (chain & 1) ? HBk : HF, shm, tid); }
                    else { const int i2 = it - 32 * 68; const int chain = i2 / 68, c = i2 % 68; const int dir_ = chain & 1, h_ = (chain >> 1) & 7;
                        ssd_out_item(chain, c, P, XBC, XTG, -expf(PT(37)[l * 16 + dir_ * 8 + h_]), PT(36)[l * 16 + dir_ * 8 + h_], SSTB, dir_ ? YB : YF, shm, tid); } }
            }
            __syncthreads();
            {   const float* bias = PT(19) + l * 1024 + 512; const int c = tid;
                const int nitems = lastl ? 0 : 4 * (CTXL / 8);
                for (int it = bid; it < nitems; it += G) {
                    int L, tokbase, b, t0; const float* K2;
                    { const int q = it; L = CTXL; tokbase = NLAT; b = q / (CTXL / 8); t0 = (q % (CTXL / 8)) * 8; K2 = K2C; }
                    const float* zb = Z + (size_t)(tokbase + b * L) * BW + c;
                    float acc[8];
#pragma unroll
                    for (int i = 0; i < 8; ++i) acc[i] = 0.f;
                    const int base = t0 + L - 1;
                    for (int s = 0; s < L; s += 8) {
                        float k[15];
#pragma unroll
                        for (int mm = 0; mm < 15; ++mm) k[mm] = K2[((size_t)(base - s - 7 + mm) * 2 + 1) * 512 + c];
#pragma unroll
                        for (int ds = 0; ds < 8; ++ds) { const float z = zb[(size_t)(s + ds) * BW];
#pragma unroll
                            for (int i = 0; i < 8; ++i) acc[i] += k[i - ds + 7] * z; }
                    }
#pragma unroll
                    for (int i = 0; i < 8; ++i) { const size_t tok = (size_t)(tokbase + b * L + t0 + i); const float zt = Z[tok * BW + c]; Y4[tok * DM + c] = f2bf((acc[i] + bias[c] * zt) * U[tok * 1536 + 1024 + c]); }
                }
            }
            SEAM(PB + 4);
        }

        if (IN(PB + 5)) for (int rep_ = 0; rep_ < PROBE_REPS(5); ++rep_) {
            PH_BEGIN
            const float* ml_norm = PT(23) + l * BW; const float* ssd_d = PT(38) + l * 8; const float* ssd_norm = PT(39) + l * BW; const float* s5_d = PT(31) + l * BW;
            if (bid < 128) {
                pg8::Gemm gg_{S5A, S5B, 768, 768, 768}; pg8::SchedS5b S_{bid}; pg8::EpiS5Out E_{P, s5_d, GG};
                pg8::gemm_phase((LAS unsigned char*)shm, gg_, S_, E_);
                __syncthreads();
            }
            for (int tok = bid * 8 + wave; tok < NTOK; tok += G * 8) {
                const int c0 = lane * 8; const bf16_t* pr = P + (size_t)tok * LDP; const size_t o5 = (size_t)tok * BW + c0;
                float hm[8], ys[8];
                { const float4 a0 = *(const float4*)(HF + o5), a1 = *(const float4*)(HF + o5 + 4), b0 = *(const float4*)(HBk + o5), b1 = *(const float4*)(HBk + o5 + 4);
                  hm[0] = a0.x + b0.x; hm[1] = a0.y + b0.y; hm[2] = a0.z + b0.z; hm[3] = a0.w + b0.w; hm[4] = a1.x + b1.x; hm[5] = a1.y + b1.y; hm[6] = a1.z + b1.z; hm[7] = a1.w + b1.w; }
                { const float4 a0 = *(const float4*)(YF + o5), a1 = *(const float4*)(YF + o5 + 4), b0 = *(const float4*)(YB + o5), b1 = *(const float4*)(YB + o5 + 4);
                  float xx[8], zz[8]; unpack8(*(const u32x4*)(XBC + (size_t)tok * 1024 + c0), xx); unpack8(*(const u32x4*)(pr + SSD_OFF + c0), zz); const float dsk = ssd_d[c0 >> 6];
                  ys[0] = a0.x + b0.x; ys[1] = a0.y + b0.y; ys[2] = a0.z + b0.z; ys[3] = a0.w + b0.w; ys[4] = a1.x + b1.x; ys[5] = a1.y + b1.y; ys[6] = a1.z + b1.z; ys[7] = a1.w + b1.w;
#pragma unroll
                  for (int j = 0; j < 8; ++j) ys[j] = (ys[j] + dsk * xx[j]) * siluf_(zz[j]); }
                float s1 = 0.f, s2 = 0.f;
#pragma unroll
                for (int j = 0; j < 8; ++j) { s1 += hm[j] * hm[j]; s2 += ys[j] * ys[j]; }
                s1 += __shfl_xor(s1, 1); s1 += __shfl_xor(s1, 2); s1 += __shfl_xor(s1, 4); s1 += __shfl_xor(s1, 8);
                s2 = wave_sum(s2);
                const float r1 = rsqrtf(s1 * (1.0f / 128.0f) + 1e-6f), r2 = rsqrtf(s2 * (1.0f / BW) + 1e-6f);
                float oo[8]; unpack8(*(const u32x4*)(pr + ML_OFF + 1536 + c0), oo);
                const float4 g0 = *(const float4*)(ml_norm + c0), g1 = *(const float4*)(ml_norm + c0 + 4), n0 = *(const float4*)(ssd_norm + c0), n1 = *(const float4*)(ssd_norm + c0 + 4);
                const float gm[8] = {g0.x, g0.y, g0.z, g0.w, g1.x, g1.y, g1.z, g1.w}, gs[8] = {n0.x, n0.y, n0.z, n0.w, n1.x, n1.y, n1.z, n1.w};
                u32x4 w;
                w.x = pk2(hm[0] * r1 * gm[0] * sigmoidf_(oo[0]), hm[1] * r1 * gm[1] * sigmoidf_(oo[1])); w.y = pk2(hm[2] * r1 * gm[2] * sigmoidf_(oo[2]), hm[3] * r1 * gm[3] * sigmoidf_(oo[3]));
                w.z = pk2(hm[4] * r1 * gm[4] * sigmoidf_(oo[4]), hm[5] * r1 * gm[5] * sigmoidf_(oo[5])); w.w = pk2(hm[6] * r1 * gm[6] * sigmoidf_(oo[6]), hm[7] * r1 * gm[7] * sigmoidf_(oo[7]));
                *(u32x4*)(Y4 + (size_t)tok * DM + 512 + c0) = w;
                w.x = pk2(ys[0] * r2 * gs[0], ys[1] * r2 * gs[1]); w.y = pk2(ys[2] * r2 * gs[2], ys[3] * r2 * gs[3]); w.z = pk2(ys[4] * r2 * gs[4], ys[5] * r2 * gs[5]); w.w = pk2(ys[6] * r2 * gs[6], ys[7] * r2 * gs[7]);
                *(u32x4*)(Y4 + (size_t)tok * DM + 1536 + c0) = w;
                if (tok >= NLAT) { const size_t oc = (size_t)(tok - NLAT) * BW + c0; float uu[8]; unpack8(*(const u32x4*)(pr + S5_OFF + c0), uu);
                    const float4 a0 = *(const float4*)(SF + oc), a1 = *(const float4*)(SF + oc + 4), b0 = *(const float4*)(SB + oc), b1 = *(const float4*)(SB + oc + 4), d0 = *(const float4*)(s5_d + c0), d1 = *(const float4*)(s5_d + c0 + 4);
                    float y[8] = {a0.x + b0.x + d0.x * uu[0], a0.y + b0.y + d0.y * uu[1], a0.z + b0.z + d0.z * uu[2], a0.w + b0.w + d0.w * uu[3], a1.x + b1.x + d1.x * uu[4], a1.y + b1.y + d1.y * uu[5], a1.z + b1.z + d1.z * uu[6], a1.w + b1.w + d1.w * uu[7]};
#pragma unroll
                    for (int j = 0; j < 8; ++j) y[j] = 0.5f * y[j] * (1.0f + tanhf(0.7978845608028654f * (y[j] + 0.044715f * y[j] * y[j] * y[j])));
                    w.x = pk2(y[0], y[1]); w.y = pk2(y[2], y[3]); w.z = pk2(y[4], y[5]); w.w = pk2(y[6], y[7]);
                    *(u32x4*)(GG + (size_t)tok * BW + c0) = w; }
            }
            __syncthreads();
            {   float* T = sf;
                for (int unit = (G > 128 ? bid - 128 : bid); unit >= 0 && unit < 4 * 64 * 8; unit += (G > 128 ? G - 128 : G)) { const int b = unit / 512, t0 = ((unit >> 3) & 63) * 64, c0 = (unit & 7) * 64;
                    __syncthreads();
#pragma unroll
                    for (int i = 0; i < 8; ++i) { const int t = tid & 63, c = (tid >> 6) + 8 * i; T[c * 65 + t] = YT[((size_t)b * 512 + c0 + c) * SEQ + t0 + t]; }
                    __syncthreads();
                    const int t = tid >> 3, cq = (tid & 7) * 8;
                    u32x4 w; w.x = pk2(T[(cq + 0) * 65 + t], T[(cq + 1) * 65 + t]); w.y = pk2(T[(cq + 2) * 65 + t], T[(cq + 3) * 65 + t]); w.z = pk2(T[(cq + 4) * 65 + t], T[(cq + 5) * 65 + t]); w.w = pk2(T[(cq + 6) * 65 + t], T[(cq + 7) * 65 + t]);
                    *(u32x4*)(Y4 + ((size_t)b * SEQ + t0 + t) * DM + c0 + cq) = w;
                } }
            SEAM(PB + 5);
        }

        if (IN(PB + 6)) for (int rep_ = 0; rep_ < PROBE_REPS(6); ++rep_) {
            PH_BEGIN
            pg8::Gemm g{GG, GLU, BW, BW, BW}; pg8::SchedStd S{68, 2, G, bid, BW, BW}; pg8::EpiGlu E{GG, PT(33) + l * BW, Y4};
            pg8::gemm_phase((LAS unsigned char*)shm, g, S, E);
            SEAM(PB + 6);
        }
        if (IN(PB + 7)) for (int rep_ = 0; rep_ < PROBE_REPS(7); ++rep_) {
            PH_BEGIN
            pg8::Gemm g{Y4, WBR, DM, BW, BW}; pg8::SchedBranch S{nPanels, 8, G, bid}; pg8::EpiBranch E{P, ACCb};
            pg8::gemm_phase((LAS unsigned char*)shm, g, S, E);
            SEAM(PB + 7);
        }
        if (IN(PB + 8)) for (int rep_ = 0; rep_ < PROBE_REPS(8); ++rep_) {
            PH_BEGIN
            pg8::Gemm g{ACCb, WOUT, DM, DM, DM}; pg8::SchedStd S{nPanels, 8, G, bid, DM, DM}; pg8::EpiResid E{XS, l == 0 ? x_in : (const float*)XS, l == 0 ? ctx_in - (size_t)NLAT * DM : (const float*)XS, MODl, 2};
            pg8::gemm_phase((LAS unsigned char*)shm, g, S, E);
            SEAM(PB + 8);
        }
        if (IN(PB + 9)) for (int rep_ = 0; rep_ < PROBE_REPS(9); ++rep_) {
            PH_BEGIN
            for (int i = bid * NTHR + tid; i < NEXP * MOE_PAD; i += G * NTHR) ROWTOK[i] = -1;
            for (int i = bid * NTHR + tid; i < NTOK * 16; i += G * NTHR) INV[i] = -1;
            const float* wr = PT(42) + (size_t)l * DM * 16; const float* gn = norm_ffn + l * DM;
            for (int tok0 = (bid * 8 + wave) * 4; tok0 < M2; tok0 += G * 32) {
                const int r = tok0 < NLAT ? tok0 / SEQ : 4; const float* xr = XS + (size_t)tok0 * DM;
                const float* sh = MODl + (size_t)(r * 6 + 3) * DM; const float* sc = MODl + (size_t)(r * 6 + 4) * DM;
                float rs[4];
#pragma unroll
                for (int tk = 0; tk < 4; ++tk) { float ss = 0.f;
#pragma unroll 4
                    for (int i = 0; i < 8; ++i) { const float4 t4 = *(const float4*)(xr + (size_t)tk * DM + i * 256 + lane * 4); ss += t4.x * t4.x + t4.y * t4.y + t4.z * t4.z + t4.w * t4.w; }
                    ss = wave_sum(ss); rs[tk] = rsqrtf(ss * (1.0f / DM) + 1e-6f); }
                float lg[4][16];
#pragma unroll
                for (int tk = 0; tk < 4; ++tk)
#pragma unroll
                    for (int e = 0; e < 16; ++e) lg[tk][e] = 0.f;
#pragma unroll 1
                for (int i = 0; i < 8; ++i) { const int d = i * 256 + lane * 4;
                    const float4 g4 = *(const float4*)(gn + d), s4 = *(const float4*)(sc + d), h4 = *(const float4*)(sh + d);
                    float hv[4][4];
#pragma unroll
                    for (int tk = 0; tk < 4; ++tk) { const float4 xv = *(const float4*)(xr + (size_t)tk * DM + d); const float rr = rs[tk];
                        hv[tk][0] = xv.x * rr * g4.x * (1.f + s4.x) + h4.x; hv[tk][1] = xv.y * rr * g4.y * (1.f + s4.y) + h4.y; hv[tk][2] = xv.z * rr * g4.z * (1.f + s4.z) + h4.z; hv[tk][3] = xv.w * rr * g4.w * (1.f + s4.w) + h4.w;
                        u32x2 w; w.x = pk2(hv[tk][0], hv[tk][1]); w.y = pk2(hv[tk][2], hv[tk][3]); *(u32x2*)(HB + (size_t)(tok0 + tk) * DM + d) = w; }
                    const float4* wq = (const float4*)(wr + (size_t)d * 16);
#pragma unroll
                    for (int q = 0; q < 4; ++q) { const float4 w0 = wq[q * 4 + 0], w1 = wq[q * 4 + 1], w2 = wq[q * 4 + 2], w3 = wq[q * 4 + 3];
#pragma unroll
                        for (int tk = 0; tk < 4; ++tk) { const float hq = hv[tk][q];
                            lg[tk][0] += hq * w0.x; lg[tk][1] += hq * w0.y; lg[tk][2] += hq * w0.z; lg[tk][3] += hq * w0.w; lg[tk][4] += hq * w1.x; lg[tk][5] += hq * w1.y; lg[tk][6] += hq * w1.z; lg[tk][7] += hq * w1.w;
                            lg[tk][8] += hq * w2.x; lg[tk][9] += hq * w2.y; lg[tk][10] += hq * w2.z; lg[tk][11] += hq * w2.w; lg[tk][12] += hq * w3.x; lg[tk][13] += hq * w3.y; lg[tk][14] += hq * w3.z; lg[tk][15] += hq * w3.w; } } }
#pragma unroll
                for (int tk = 0; tk < 4; ++tk) { float mx = -1e30f;
#pragma unroll
                    for (int e = 0; e < 16; ++e) { lg[tk][e] = wave_sum(lg[tk][e]); mx = fmaxf(mx, lg[tk][e]); }
                    float sm = 0.f;
#pragma unroll
                    for (int e = 0; e < 16; ++e) { lg[tk][e] = expf(lg[tk][e] - mx); sm += lg[tk][e]; }
                    const float inv = 1.0f / sm;
                    if (lane == 0) {
#pragma unroll
                        for (int e = 0; e < 16; e += 4) *(float4*)(PROBS + (size_t)(tok0 + tk) * 16 + e) = make_float4(lg[tk][e] * inv, lg[tk][e + 1] * inv, lg[tk][e + 2] * inv, lg[tk][e + 3] * inv); } }
            }
            SEAM(PB + 9);
        }
        if (IN(PB + 10)) for (int rep_ = 0; rep_ < PROBE_REPS(10); ++rep_) {
            PH_BEGIN
            const int nitems = 64 + (lastl ? 0 : 64);
            unsigned long long* keys = (unsigned long long*)shm;
            for (int it = bid; it < nitems; it += G) {
                const int set = it >> 6, e = it & 15, b = (it >> 4) & 3;
                const int n = set ? CTXL : SEQ, cap = set ? 32 : 512, tokbase = set ? NLAT + b * CTXL : b * SEQ;
                __syncthreads();
                for (int i = tid; i < n; i += NTHR) keys[i] = ((unsigned long long)__float_as_uint(PROBS[(size_t)(tokbase + i) * 16 + e]) << 32) | (unsigned long long)(0xFFFFFFFFu - (unsigned)i);
                __syncthreads();
                for (int k = 2; k <= n; k <<= 1)
                    for (int j = k >> 1; j > 0; j >>= 1) {
                        for (int p = tid; p < (n >> 1); p += NTHR) { const int i = ((p & ~(j - 1)) << 1) | (p & (j - 1)); const int m = i | j;
                            const unsigned long long ka = keys[i], kb = keys[m]; const bool desc = ((i & k) == 0);
                            if ((ka < kb) == desc) { keys[i] = kb; keys[m] = ka; } }
                        __syncthreads();
                    }
                for (int r = tid; r < cap; r += NTHR) { const unsigned long long kk = keys[r]; const int row = e * MOE_PAD + (set ? 2048 + b * 32 + r : b * 512 + r);
                    const int tk_ = tokbase + (int)(0xFFFFFFFFu - (unsigned)(kk & 0xFFFFFFFFull)); ROWTOK[row] = tk_; ROWGATE[row] = __uint_as_float((unsigned)(kk >> 32)); INV[tk_ * 16 + e] = row; }
                for (int r = wave; r < cap; r += 8) { const int tok = tokbase + (int)(0xFFFFFFFFu - (unsigned)(keys[r] & 0xFFFFFFFFull)); const int row = e * MOE_PAD + (set ? 2048 + b * 32 + r : b * 512 + r);
                    const u32x4* sp = (const u32x4*)(HB + (size_t)tok * DM); u32x4* dp = (u32x4*)(XG + (size_t)row * DM);
#pragma unroll
                    for (int i = 0; i < 4; ++i) dp[i * 64 + lane] = sp[i * 64 + lane]; }
            }
            {   const int pad0 = lastl ? 2048 : MOE_ROWS, npad = MOE_PAD - pad0;
                for (int R = bid * 8 + wave; R < NEXP * npad; R += G * 8) { const int e = R / npad, rr = pad0 + R % npad; u32x4* dp = (u32x4*)(XG + ((size_t)e * MOE_PAD + rr) * DM);
#pragma unroll
                    for (int i = 0; i < 4; ++i) dp[i * 64 + lane] = (u32x4){0u, 0u, 0u, 0u}; } }
            SEAM(PB + 10);
        }
        if (IN(PB + 12)) for (int rep_ = 0; rep_ < PROBE_REPS(12); ++rep_) {
            PH_BEGIN
            pg8::Gemm g{XG, WGU, DM, DM, DM}; pg8::SchedMoe S{lastl ? 8 : 9, 12, G, bid, DM, DM, 2 * DEXP}; pg8::EpiMoe1 E{HID};
            pg8::gemm_phase((LAS unsigned char*)shm, g, S, E);
            SEAM(PB + 12);
        }
        if (IN(PB + 13)) for (int rep_ = 0; rep_ < PROBE_REPS(13); ++rep_) {
            PH_BEGIN
            pg8::Gemm g{HID, WD, DEXP, DEXP, DEXP}; pg8::SchedMoe S{lastl ? 8 : 9, 8, G, bid, DEXP, DEXP, DM}; pg8::EpiMoeY E{YEXP};
            pg8::gemm_phase((LAS unsigned char*)shm, g, S, E);
            SEAM(PB + 13);
        }

}

__global__ __launch_bounds__(NTHR, 2) void fwd(Args a) {
    extern __shared__ __attribute__((aligned(16))) unsigned char shm[];
    const int bid = blockIdx.x, G = gridDim.x;
    float* const sf = (float*)shm;
    volatile LAS unsigned* xbw = (volatile LAS unsigned*)((LAS unsigned char*)shm + (LDS_BYTES - 16));
    if (threadIdx.x == 0) { xbw[0] = 0u; xbw[1] = 0u; xbw[2] = 0u; xbw[3] = 0u; }
    const float** const ptab = (const float**)(shm + (LDS_BYTES - 16 - 512));
    if (threadIdx.x == 0) {
#pragma unroll
        for (int i = 0; i < 47; ++i) ptab[i] = a.in[i]; }
    __syncthreads();
    XcdBarrier bar = xcd_barrier_post((unsigned*)(a.ws + O_BAR), xbw);
    const int lo = a.ph_lo, hi = a.ph_hi;
    if (IN(0)) {
        PH_BEGIN
        {
            __syncthreads();
            for (int i = tid; i < 5 * DM; i += NTHR) { const int r = i >> 11, k = i & (DM - 1); const float v = r < 4 ? c_in[r * DM + k] : cctx_in[k]; sf[i] = siluf_(v); }
            __syncthreads();
            float* red = sf + 5 * DM;
            for (int unit = bid; unit < 2 * 96; unit += G) { const int l = unit / 96, j = (unit % 96) * 128 + (tid & 127), kq = tid >> 7;
                const float* w = ada_w + (size_t)l * DM * (6 * DM) + (size_t)(kq * 512) * (6 * DM) + j; const float* sv = sf + kq * 512;
                float a0 = 0.f, a1 = 0.f, a2 = 0.f, a3 = 0.f, a4 = 0.f;
#pragma unroll 8
                for (int k = 0; k < 512; ++k) { const float wv = w[(size_t)k * (6 * DM)]; a0 += sv[k] * wv; a1 += sv[DM + k] * wv; a2 += sv[2 * DM + k] * wv; a3 += sv[3 * DM + k] * wv; a4 += sv[4 * DM + k] * wv; }
                __syncthreads();
                { float* rp = red + (kq * 5) * 128 + (tid & 127); rp[0] = a0; rp[128] = a1; rp[256] = a2; rp[384] = a3; rp[512] = a4; }
                __syncthreads();
                if (tid < 128) { const float bb = ada_b[l * 6 * DM + j]; float* o = MOD + (size_t)l * 5 * 6 * DM + j;
#pragma unroll
                    for (int r = 0; r < 5; ++r) o[(size_t)r * 6 * DM] = ((red[(0 * 5 + r) * 128 + tid] + red[(1 * 5 + r) * 128 + tid]) + (red[(2 * 5 + r) * 128 + tid] + red[(3 * 5 + r) * 128 + tid])) + bb; }
            }
        }
    }

    layer_body<0>(a, bar, lo, hi, bid, G, shm, sf, ptab);
    layer_body<1>(a, bar, lo, hi, bid, G, shm, sf, ptab);
    if (IN(33)) {
        PH_BEGIN
        const float* gn = PT(46);
        for (int tok = bid * 8 + wave; tok < NLAT; tok += G * 8) {
            const float* xr = XS + (size_t)tok * DM; float4 v[8]; float ss = 0.f;
#pragma unroll
            for (int i = 0; i < 8; ++i) v[i] = *(const float4*)(xr + i * 256 + lane * 4);
            moe_combine(v, tok, lane, INV, ROWGATE, YEXP, MOD + (size_t)(1 * 5 + tok / SEQ) * 6 * DM + 5 * DM);
#pragma unroll
            for (int i = 0; i < 8; ++i) {                 ss += v[i].x * v[i].x + v[i].y * v[i].y + v[i].z * v[i].z + v[i].w * v[i].w; }
            ss = wave_sum(ss); const float rs = rsqrtf(ss * (1.0f / DM) + 1e-6f);
#pragma unroll
            for (int i = 0; i < 8; ++i) { const int d = i * 256 + lane * 4; const float4 g4 = *(const float4*)(gn + d);
                *(float4*)(a.out + (size_t)tok * DM + d) = make_float4(v[i].x * rs * g4.x, v[i].y * rs * g4.y, v[i].z * rs * g4.z, v[i].w * rs * g4.w); }
        }
    }
#undef IN
#undef SEAM
}


extern "C" void kernel_launch(void* const* d_in, const int* in_sizes, int n_in, void* d_out, int out_size, void* d_ws, size_t ws_size, hipStream_t stream) {
    static int grid = 0;
    if (grid == 0) {
        if (n_in != 47 || ws_size < WS_END) { fprintf(stderr, "kernel_launch: expected 47 inputs and >= %zu bytes of workspace; got %d, %zu\n", (size_t)WS_END, n_in, ws_size); grid = -1; return; }
        int dev = 0, cus = 0;
        if (hipGetDevice(&dev) != hipSuccess || hipDeviceGetAttribute(&cus, hipDeviceAttributeMultiprocessorCount, dev) != hipSuccess) { grid = -1; return; }
        if (hipFuncSetAttribute((const void*)fwd, hipFuncAttributeMaxDynamicSharedMemorySize, LDS_BYTES) != hipSuccess) { fprintf(stderr, "kernel_launch: hipFuncSetAttribute failed\n"); grid = -1; return; }
        int per_cu = 0;
        if (hipOccupancyMaxActiveBlocksPerMultiprocessor(&per_cu, (const void*)fwd, NTHR, LDS_BYTES) != hipSuccess || per_cu < 1) fprintf(stderr, "kernel_launch: occupancy query reports %d\n", per_cu);
        (void)hipGetLastError();
        grid = cus > 256 ? 256 : cus;
        if (grid < 224) { fprintf(stderr, "kernel_launch: needs >= 224 CUs (got %d)\n", grid); grid = -1; return; }
    }
    if (grid < 0) return;
    (void)hipMemsetAsync((char*)d_ws, 0, O_ZERO_END, stream);
    Args a{};
    for (int i = 0; i < 47; ++i) a.in[i] = (const float*)d_in[i];
    a.out = (float*)d_out; a.ws = (unsigned char*)d_ws;
#if MK_ONE_LAUNCH
    a.ph_lo = 0; a.ph_hi = 64;
    hipLaunchKernelGGL(fwd, dim3(grid), dim3(NTHR), LDS_BYTES, stream, a);
#else
    const int ids[] = {0, 1,2,3,4,5,6,7,8,9,10,11,12,13,14, 17,18,19,20,21,22,23,24,25,26,27,28,29,30, 33};
    for (int k = 0; k < (int)(sizeof(ids) / sizeof(ids[0])); ++k) { a.ph_lo = ids[k]; a.ph_hi = ids[k] + 1; hipLaunchKernelGGL(fwd, dim3(grid), dim3(NTHR), LDS_BYTES, stream, a); }
#endif
}
```

```cpp
#include <hip/hip_runtime.h>
#include <stdint.h>
#include <stdio.h>

#ifndef PROBE_MASK
#define PROBE_MASK 0
#endif
#ifndef PROBE_SP
#define PROBE_SP 1
#endif
#define PROBE_REPS(k) ((((PROBE_MASK) >> (k)) & 1) + 1)
#ifndef MK_ONE_LAUNCH
#define MK_ONE_LAUNCH 1
#endif

#define DM 2048
#define NB 4
#define SEQ 4096
#define CTXL 256
#define BW 512
#define NLAT 16384
#define NCTX 1024
#define NTOK 17408
#define IN_W 13856
#define LDP 14080
#define HY_OFF 0
#define ML_OFF 1536
#define S5_OFF 3600
#define SSD_OFF 4112
#define GATE_OFF 5664
#define NEXP 16
#define DEXP 1536
#define MOE_ROWS 2176
#define MOE_PAD 2304
#define NTHR 512
#define LDS_BYTES 147456
#define LAS __attribute__((address_space(3)))

typedef unsigned short bf16_t;
typedef short bf16x8 __attribute__((ext_vector_type(8)));
typedef float f32x4 __attribute__((ext_vector_type(4)));
typedef unsigned u32x4 __attribute__((ext_vector_type(4)));
typedef unsigned u32x2 __attribute__((ext_vector_type(2)));

#define XB_TMO      128
#define XB_XCNT(j)  (256  + 64 * (j))
#define XB_XSUB(j)  (1280 + 64 * (j))
#define XB_XGEN(j)  (2304 + 64 * (j))
#define XB_TOP      3328
#define XB_TOPGEN   3392
#define XCD_BAR_WORDS 3456
#define XB_SPIN_CAP (1u << 18)
__device__ __forceinline__ unsigned xb_ld(unsigned* p)              { return __hip_atomic_load(p, __ATOMIC_RELAXED, __HIP_MEMORY_SCOPE_AGENT); }
__device__ __forceinline__ unsigned xb_add(unsigned* p, unsigned v) { return __hip_atomic_fetch_add(p, v, __ATOMIC_RELAXED, __HIP_MEMORY_SCOPE_AGENT); }
__device__ __forceinline__ unsigned xb_xcc_id() { return (unsigned)__builtin_amdgcn_s_getreg((3 << 11) | 20) & 0xFu; }
#define XB_SPIN(cond, bar) do { unsigned _sp = 0; while (cond) { __builtin_amdgcn_s_sleep(1); \
    if ((++_sp & 255u) == 0u) { if (xb_ld(&(bar)[XB_TMO])) break; if (_sp > XB_SPIN_CAP) { atomicAdd(&(bar)[XB_TMO], 1u); break; } } } } while (0)
struct XcdBarrier { unsigned* bar; unsigned x; volatile LAS unsigned* st; };
__device__ __forceinline__ XcdBarrier xcd_barrier_post(unsigned* bar, volatile LAS unsigned* st) {
    XcdBarrier b; b.bar = bar; b.x = xb_xcc_id(); b.st = st;
    if (threadIdx.x == 0) (void)xb_add(&bar[XB_XCNT(b.x)], 1u);
    return b;
}
__device__ __forceinline__ void xcd_barrier_complete(unsigned* bar, unsigned x, unsigned& nloc, unsigned& nx) {
    const unsigned G = gridDim.x * gridDim.y * gridDim.z;
    unsigned sum, cnt, mine, sp = 0u;
    for (;;) {
        sum = 0u; cnt = 0u; mine = 0u;
#pragma unroll
        for (unsigned j = 0; j < 16; ++j) { const unsigned c = xb_ld(&bar[XB_XCNT(j)]); sum += c; cnt += (c > 0u) ? 1u : 0u; mine = (j == x) ? c : mine; }
        if (sum == G) break;
        __builtin_amdgcn_s_sleep(1);
        if ((++sp & 255u) == 0u) { if (xb_ld(&bar[XB_TMO])) break; if (sp > XB_SPIN_CAP) { atomicAdd(&bar[XB_TMO], 1u); break; } }
    }
    nloc = mine > 0u ? mine : 1u; nx = cnt > 0u ? cnt : 1u;
}
__device__ __forceinline__ void xcd_barrier(const XcdBarrier& b) {
    asm volatile("s_waitcnt vmcnt(0)" ::: "memory");
    __syncthreads();
    if (threadIdx.x == 0) {
        unsigned* bar = b.bar;
        __builtin_amdgcn_s_waitcnt(0);
        unsigned nloc = b.st[0], nx = b.st[1];
        if (nloc == 0u) { xcd_barrier_complete(bar, b.x, nloc, nx); b.st[0] = nloc; b.st[1] = nx; }
        const unsigned old = xb_add(&bar[XB_XSUB(b.x)], 1u);
        const unsigned gen = old / nloc;
        if (old + 1u == (gen + 1u) * nloc) {
            __builtin_amdgcn_fence(__ATOMIC_RELEASE, "agent");
            asm volatile("s_waitcnt vmcnt(0)" ::: "memory");
            const unsigned og = xb_add(&bar[XB_TOP], 1u);
            const unsigned tg = og / nx;
            if (og + 1u == (tg + 1u) * nx) xb_add(&bar[XB_TOPGEN], 1u);
            else XB_SPIN(xb_ld(&bar[XB_TOPGEN]) == tg, bar);
            __builtin_amdgcn_fence(__ATOMIC_ACQUIRE, "agent");
            xb_add(&bar[XB_XGEN(b.x)], 1u);
            asm volatile("s_waitcnt vmcnt(0)" ::: "memory");
        } else {
            XB_SPIN(xb_ld(&bar[XB_XGEN(b.x)]) == gen, bar);
            __builtin_amdgcn_fence(__ATOMIC_ACQUIRE, "agent");
            asm volatile("s_waitcnt vmcnt(0)" ::: "memory");
        }
    }
    __syncthreads();
}

__device__ __forceinline__ unsigned short f2bf(float f) { unsigned u = __float_as_uint(f); u += 0x7FFFu + ((u >> 16) & 1u); return (unsigned short)(u >> 16); }
__device__ __forceinline__ float bf2f(unsigned short b) { return __uint_as_float(((unsigned)b) << 16); }
__device__ __forceinline__ unsigned pk2(float lo, float hi) { unsigned r; asm("v_cvt_pk_bf16_f32 %0, %1, %2" : "=v"(r) : "v"(lo), "v"(hi)); return r; }
__device__ __forceinline__ float sigmoidf_(float x) { return 1.0f / (1.0f + expf(-x)); }
__device__ __forceinline__ float siluf_(float x) { return x / (1.0f + expf(-x)); }
__device__ __forceinline__ float wave_sum(float v) {
#pragma unroll
    for (int o = 32; o >= 1; o >>= 1) v += __shfl_xor(v, o);
    return v;
}
__device__ __forceinline__ const float* uptr(const float* p) { const unsigned long long v = (unsigned long long)p;
    const unsigned lo = __builtin_amdgcn_readfirstlane((unsigned)v), hi = __builtin_amdgcn_readfirstlane((unsigned)(v >> 32)); return (const float*)(((unsigned long long)hi << 32) | lo); }
#define PT(k) uptr(ptab[k])
__device__ __forceinline__ int step_tok(int b, int dir, int i) {
    if (i < CTXL) { const int tt = dir ? (CTXL - 1 - i) : i; return NLAT + b * CTXL + tt; }
    const int j = i - CTXL; const int tt = dir ? (SEQ - 1 - j) : j; return b * SEQ + tt;
}
__device__ __forceinline__ void unpack8(const u32x4 w, float (&f)[8]) {
    f[0] = __uint_as_float(w.x << 16); f[1] = __uint_as_float(w.x & 0xFFFF0000u); f[2] = __uint_as_float(w.y << 16); f[3] = __uint_as_float(w.y & 0xFFFF0000u);
    f[4] = __uint_as_float(w.z << 16); f[5] = __uint_as_float(w.z & 0xFFFF0000u); f[6] = __uint_as_float(w.w << 16); f[7] = __uint_as_float(w.w & 0xFFFF0000u);
}

namespace pg8 {
constexpr int BM = 256, BK = 64, HALF = 128, HTB = HALF * BK * 2, STAGE_BYTES = 8 * HTB, NXCD = 8, WGM = 8;
__host__ __device__ __forceinline__ int lds_byte(int r, int c) { const int st = (r >> 4) * 2 + (c >> 5), rr = r & 15, cc = c & 31, ob = rr * 64 + cc * 2; return st * 1024 + (ob ^ (((ob >> 9) & 1) << 5)); }
__host__ __device__ __forceinline__ void stage_rc(int b, int& R, int& C) { const int st = b / 1024, sb = b % 1024, swz = sb ^ (((sb >> 9) & 1) << 5); R = (st >> 1) * 16 + swz / 64; C = (st & 1) * 32 + (swz % 64) / 2; }
__host__ __device__ __forceinline__ int perm32(int rho) { const int n = rho >> 4, i = rho & 15; return 8 * (i >> 2) + 4 * n + (i & 3); }
struct Unit { int pm, pn, z, k; long long ao, bo; };
struct Gemm { const bf16_t* A; const bf16_t* Bt; int lda, ldb, K; };

__device__ __forceinline__ void tile_of(int wgid, int nM, int nN, int& pm, int& pn) {
    const int nwg = nM * nN; { const int q = nwg / NXCD, r = nwg % NXCD, xcd = wgid % NXCD, off = wgid / NXCD; wgid = (xcd < r ? xcd * (q + 1) : r * (q + 1) + (xcd - r) * q) + off; }
    const int nig = WGM * nN, gid = wgid / nig, fm = gid * WGM, gsz = (nM - fm) < WGM ? (nM - fm) : WGM;
    pm = fm + ((wgid % nig) % gsz); pn = (wgid % nig) / gsz;
}
struct SchedStd {
    int nM, nN, G, c, lda, ldb;
    __device__ __forceinline__ bool next(int i, Unit& u) const { const long L = (long)i * G + c; if (L >= (long)nM * nN) return false; tile_of((int)L, nM, nN, u.pm, u.pn); u.z = 0; u.k = 0;
        u.ao = (long long)u.pm * BM * lda * 2; u.bo = (long long)u.pn * BM * ldb * 2; return true; }
    __device__ __forceinline__ void a_ready(const Unit&) const {}
    __device__ __forceinline__ void done(const Unit&) const {}
};
struct SchedBranch {
    int nM, nN, G, c;
    __device__ __forceinline__ bool next(int i, Unit& u) const { const long L = (long)(i >> 2) * G + c; if (L >= (long)nM * nN) return false; tile_of((int)L, nM, nN, u.pm, u.pn); u.z = 0; u.k = i & 3;
        u.ao = ((long long)u.pm * BM * DM + u.k * BW) * 2; u.bo = ((long long)u.k * DM + u.pn * BM) * BW * 2; return true; }
    __device__ __forceinline__ void a_ready(const Unit&) const {}
    __device__ __forceinline__ void done(const Unit&) const {}
};
struct SchedMoe {
    int nPm, nPn, G, c, lda, ldb, nBrows;
    __device__ __forceinline__ bool next(int i, Unit& u) const { const long L = (long)i * G + c; const int per = nPm * nPn; if (L >= (long)NEXP * per) return false; const int e = (int)(L / per), rem = (int)(L % per);
        u.z = e; u.k = 0; u.pm = rem % nPm; u.pn = rem / nPm; u.ao = ((long long)e * MOE_PAD + u.pm * BM) * lda * 2; u.bo = ((long long)e * nBrows + u.pn * BM) * ldb * 2; return true; }
    __device__ __forceinline__ void a_ready(const Unit&) const {}
    __device__ __forceinline__ void done(const Unit&) const {}
};

typedef f32x4 Acc[2][2][4][2];
template <class Epi, class Sched>
__device__ __forceinline__ void gemm_phase(LAS unsigned char* lds, const Gemm g, const Sched& S, const Epi& E) {
    int tid = threadIdx.x; asm volatile("" : "+v"(tid));
    const int wid = __builtin_amdgcn_readfirstlane(tid >> 6), lane = tid & 63, wr = wid >> 2, wc = wid & 3, fr = lane & 15, fq = lane >> 4;
    const int K = g.K, nt = K / BK;
    unsigned voffA[2], voffB[2];
#pragma unroll
    for (int i = 0; i < 2; ++i) { int R, C; stage_rc(tid * 16 + i * 8192, R, C); const int Rb = Epi::PERM ? ((R & ~31) + perm32(R & 31)) : R;
        voffA[i] = (unsigned)(R * g.lda + C) * 2u; voffB[i] = (unsigned)(Rb * g.ldb + C) * 2u; }
    const size_t kstep = (size_t)(BK * 2);
    const size_t hstepA = (size_t)HALF * g.lda * 2, hstepB = (size_t)HALF * g.ldb * 2;
    const unsigned ldsw = (unsigned)wid * 1024u;
    const int aoff = lds_byte(wr * 64 + fr, fq * 8), boff = lds_byte(wc * 32 + fr, fq * 8);
#define PG8_SA(b, h) (((b) * 2 + (h)) * HTB)
#define PG8_SB(b, h) ((4 + (b) * 2 + (h)) * HTB)
#define PG8_STAGE(bufoff, gbase, voff) do { _Pragma("unroll") for (int _i = 0; _i < 2; ++_i) \
        __builtin_amdgcn_global_load_lds((const unsigned*)((const char*)(gbase) + (voff)[_i]), (LAS unsigned*)(lds + (bufoff) + ldsw + _i * 8192), 16, 0, 0); } while (0)
#define PG8_LDA(dst, b, h) do { _Pragma("unroll") for (int m = 0; m < 4; ++m) _Pragma("unroll") for (int k = 0; k < 2; ++k) dst[m][k] = *(const LAS bf16x8*)(lds + PG8_SA(b, h) + aoff + m * 2048 + k * 1024); } while (0)
#define PG8_LDB(dst, b, h) do { _Pragma("unroll") for (int n = 0; n < 2; ++n) _Pragma("unroll") for (int k = 0; k < 2; ++k) dst[n][k] = *(const LAS bf16x8*)(lds + PG8_SB(b, h) + boff + n * 2048 + k * 1024); } while (0)
#define PG8_MMA(ai, bj, At, Bt) do { __builtin_amdgcn_s_setprio(1); _Pragma("unroll") for (int m = 0; m < 4; ++m) _Pragma("unroll") for (int n = 0; n < 2; ++n) _Pragma("unroll") for (int k = 0; k < 2; ++k) \
        acc[ai][bj][m][n] = __builtin_amdgcn_mfma_f32_16x16x32_bf16(Bt[n][k], At[m][k], acc[ai][bj][m][n], 0, 0, 0); __builtin_amdgcn_s_setprio(0); } while (0)
#define PG8_WAIT_V(n) asm volatile("s_waitcnt vmcnt(" #n ")" ::: "memory")
#define PG8_WAIT_L(n) asm volatile("s_waitcnt lgkmcnt(" #n ")" ::: "memory")
#define PG8_BAR __builtin_amdgcn_s_barrier()
#define PG8_SCHED __builtin_amdgcn_sched_barrier(0)
    Unit cur, nxt; int ui = 0;
    if (!S.next(0, cur)) return;
    Acc acc;
#pragma unroll
    for (int a = 0; a < 2; ++a)
#pragma unroll
        for (int b = 0; b < 2; ++b)
#pragma unroll
            for (int m = 0; m < 4; ++m)
#pragma unroll
                for (int n = 0; n < 2; ++n) acc[a][b][m][n] = (f32x4){0.f, 0.f, 0.f, 0.f};
    bf16x8 At[4][2], B0[2][2], B1[2][2];
    const char* cA = (const char*)g.A + cur.ao; const char* cB = (const char*)g.Bt + cur.bo;
    S.a_ready(cur);
    PG8_STAGE(PG8_SB(0, 0), cB, voffB); PG8_STAGE(PG8_SA(0, 0), cA, voffA); PG8_STAGE(PG8_SB(0, 1), cB + hstepB, voffB); PG8_STAGE(PG8_SA(0, 1), cA + hstepA, voffA);
    if (wr == 1) PG8_BAR;
    PG8_WAIT_V(4); PG8_BAR;
    PG8_STAGE(PG8_SB(1, 0), cB + kstep, voffB); PG8_STAGE(PG8_SA(1, 0), cA + kstep, voffA); PG8_STAGE(PG8_SB(1, 1), cB + hstepB + kstep, voffB);
    PG8_WAIT_V(6); PG8_BAR;
    for (;;) {
        const bool has_next = S.next(ui + 1, nxt);
        const char* nA = has_next ? (const char*)g.A + nxt.ao : cA; const char* nB = has_next ? (const char*)g.Bt + nxt.bo : cB;
        for (int t = 0; t < nt; t += 2) {
            const bool last = (t == nt - 2);
            const char* a1 = cA + (size_t)(t + 1) * kstep;
            const char* a2 = last ? nA : cA + (size_t)(t + 2) * kstep; const char* b2 = last ? nB : cB + (size_t)(t + 2) * kstep;
            const char* a3 = a2 + kstep; const char* b3 = b2 + kstep;
            if (last && has_next) S.a_ready(nxt);
            PG8_LDB(B0, 0, 0); PG8_SCHED; PG8_LDA(At, 0, 0); PG8_STAGE(PG8_SA(1, 1), a1 + hstepA, voffA);
            PG8_WAIT_L(8); PG8_BAR; PG8_WAIT_L(0); PG8_MMA(0, 0, At, B0); PG8_BAR; PG8_SCHED;
            PG8_LDB(B1, 0, 1); PG8_STAGE(PG8_SB(0, 0), b2, voffB);
            PG8_BAR; PG8_WAIT_L(0); PG8_MMA(0, 1, At, B1); PG8_BAR;
            PG8_LDA(At, 0, 1); PG8_STAGE(PG8_SA(0, 0), a2, voffA);
            PG8_BAR; PG8_WAIT_L(0); PG8_MMA(1, 0, At, B0); PG8_BAR; PG8_SCHED;
            PG8_STAGE(PG8_SB(0, 1), b2 + hstepB, voffB);
            PG8_WAIT_V(6); PG8_BAR; PG8_MMA(1, 1, At, B1); PG8_BAR;
            PG8_LDB(B0, 1, 0); PG8_SCHED; PG8_LDA(At, 1, 0); PG8_STAGE(PG8_SA(0, 1), a2 + hstepA, voffA);
            PG8_WAIT_L(8); PG8_BAR; PG8_WAIT_L(0); PG8_MMA(0, 0, At, B0); PG8_BAR; PG8_SCHED;
            PG8_LDB(B1, 1, 1); PG8_STAGE(PG8_SB(1, 0), b3, voffB);
            PG8_BAR; PG8_WAIT_L(0); PG8_MMA(0, 1, At, B1); PG8_BAR;
            PG8_LDA(At, 1, 1); PG8_STAGE(PG8_SA(1, 0), a3, voffA);
            PG8_BAR; PG8_WAIT_L(0); PG8_MMA(1, 0, At, B0); PG8_BAR; PG8_SCHED;
            PG8_STAGE(PG8_SB(1, 1), b3 + hstepB, voffB);
            PG8_WAIT_V(6); PG8_BAR; PG8_MMA(1, 1, At, B1); PG8_BAR;
        }
        const bool keep = E(acc, cur, wr, wc, fr, fq); S.done(cur);
        if (!has_next) break;
        if (!keep) {
#pragma unroll
        for (int a = 0; a < 2; ++a)
#pragma unroll
            for (int b = 0; b < 2; ++b)
#pragma unroll
                for (int m = 0; m < 4; ++m)
#pragma unroll
                    for (int n = 0; n < 2; ++n) acc[a][b][m][n] = (f32x4){0.f, 0.f, 0.f, 0.f};
        }
        cur = nxt; cA = nA; cB = nB; ++ui;
    }
    PG8_WAIT_V(0);
    if (wr == 0) PG8_BAR;
    PG8_BAR;
#undef PG8_SA
#undef PG8_SB
#undef PG8_STAGE
#undef PG8_LDA
#undef PG8_LDB
#undef PG8_MMA
#undef PG8_WAIT_V
#undef PG8_WAIT_L
#undef PG8_BAR
#undef PG8_SCHED
}

struct EpiBf16Store {
    static constexpr bool PERM = true;
    bf16_t* O; int ldc;
    __device__ __forceinline__ bool operator()(Acc& acc, const Unit& u, int wr, int wc, int fr, int fq) const {
        const int row0 = u.pm * BM + wr * 64 + fr, col0 = u.pn * BM + wc * 32 + 8 * fq;
#pragma unroll
        for (int ai = 0; ai < 2; ++ai)
#pragma unroll
            for (int m = 0; m < 4; ++m) { bf16_t* rowp = O + (size_t)(row0 + ai * HALF + m * 16) * ldc + col0;
#pragma unroll
                for (int bj = 0; bj < 2; ++bj) { const f32x4 v0 = acc[ai][bj][m][0], v1 = acc[ai][bj][m][1];
                    u32x4 w; w.x = pk2(v0[0], v0[1]); w.y = pk2(v0[2], v0[3]); w.z = pk2(v1[0], v1[1]); w.w = pk2(v1[2], v1[3]);
                    *(u32x4*)(rowp + bj * HALF) = w; } }
        return false;
    }
};
struct EpiWin {
    static constexpr bool PERM = true;
    bf16_t* O; int ldc;
    __device__ __forceinline__ bool operator()(Acc& acc, const Unit& u, int wr, int wc, int fr, int fq) const {
        const int row0 = u.pm * BM + wr * 64 + fr, col0 = u.pn * BM + wc * 32 + 8 * fq;
#pragma unroll
        for (int bj = 0; bj < 2; ++bj) { const bool gate = (col0 + bj * HALF) >= GATE_OFF;
#pragma unroll
            for (int ai = 0; ai < 2; ++ai)
#pragma unroll
                for (int m = 0; m < 4; ++m) { f32x4 v0 = acc[ai][bj][m][0], v1 = acc[ai][bj][m][1];
                    if (gate) {
#pragma unroll
                        for (int j = 0; j < 4; ++j) { v0[j] = __builtin_amdgcn_rcpf(1.0f + __expf(-v0[j])); v1[j] = __builtin_amdgcn_rcpf(1.0f + __expf(-v1[j])); } }
                    u32x4 w; w.x = pk2(v0[0], v0[1]); w.y = pk2(v0[2], v0[3]); w.z = pk2(v1[0], v1[1]); w.w = pk2(v1[2], v1[3]);
                    *(u32x4*)(O + (size_t)(row0 + ai * HALF + m * 16) * ldc + col0 + bj * HALF) = w; } }
        return false;
    }
};
struct EpiNone { static constexpr bool PERM = true;
    __device__ __forceinline__ bool operator()(Acc& acc, const Unit&, int, int, int, int) const {
#pragma unroll
        for (int a = 0; a < 2; ++a)
#pragma unroll
            for (int b = 0; b < 2; ++b)
#pragma unroll
                for (int m = 0; m < 4; ++m)
#pragma unroll
                    for (int n = 0; n < 2; ++n) asm volatile("" :: "v"(acc[a][b][m][n]));
        return false; } };
struct EpiGlu {
    static constexpr bool PERM = true;
    const bf16_t* GG; const float* bias; bf16_t* Y4;
    __device__ __forceinline__ bool operator()(Acc& acc, const Unit& u, int wr, int wc, int fr, int fq) const {
        const int row0 = u.pm * BM + wr * 64 + fr, col0 = u.pn * BM + wc * 32 + 8 * fq;
#pragma unroll
        for (int bj = 0; bj < 2; ++bj) { const int col = col0 + bj * HALF; const f32x4 b0 = *(const f32x4*)(bias + col), b1 = *(const f32x4*)(bias + col + 4);
            u32x4 gq[2][4];
#pragma unroll
            for (int ai = 0; ai < 2; ++ai)
#pragma unroll
                for (int m = 0; m < 4; ++m) gq[ai][m] = *(const u32x4*)(GG + (size_t)(row0 + ai * HALF + m * 16) * BW + col);
#pragma unroll
            for (int ai = 0; ai < 2; ++ai)
#pragma unroll
                for (int m = 0; m < 4; ++m) { const size_t row = (size_t)(row0 + ai * HALF + m * 16);
                    float gg[8]; unpack8(gq[ai][m], gg);
                    const f32x4 v0 = acc[ai][bj][m][0] + b0, v1 = acc[ai][bj][m][1] + b1;
                    u32x4 w; w.x = pk2(gg[0] * sigmoidf_(v0[0]), gg[1] * sigmoidf_(v0[1])); w.y = pk2(gg[2] * sigmoidf_(v0[2]), gg[3] * sigmoidf_(v0[3]));
                    w.z = pk2(gg[4] * sigmoidf_(v1[0]), gg[5] * sigmoidf_(v1[1])); w.w = pk2(gg[6] * sigmoidf_(v1[2]), gg[7] * sigmoidf_(v1[3]));
                    *(u32x4*)(Y4 + row * DM + 1024 + col) = w; } }
        return false;
    }
};
struct EpiBranch {
    static constexpr bool PERM = true;
    const bf16_t* P; bf16_t* ACCb;
    __device__ __forceinline__ bool operator()(Acc& acc, const Unit& u, int wr, int wc, int fr, int fq) const {
        const int row0 = u.pm * BM + wr * 64 + fr, col0 = u.pn * BM + wc * 32 + 8 * fq; const int k = u.k;
        const bf16_t* gbase = P + (size_t)row0 * LDP + GATE_OFF + k * DM + col0;
        if (k < 3) {
#pragma unroll
            for (int ai = 0; ai < 2; ++ai) {
                u32x4 ga[8], gb[8];
#pragma unroll
                for (int m = 0; m < 4; ++m)
#pragma unroll
                    for (int bj = 0; bj < 2; ++bj) { const bf16_t* p = gbase + (size_t)(ai * HALF + m * 16) * LDP + bj * HALF; ga[m * 2 + bj] = *(const u32x4*)p; gb[m * 2 + bj] = *(const u32x4*)(p + DM); }
#pragma unroll
                for (int m = 0; m < 4; ++m)
#pragma unroll
                    for (int bj = 0; bj < 2; ++bj) { float g0[8], g1[8]; unpack8(ga[m * 2 + bj], g0); unpack8(gb[m * 2 + bj], g1);
                        float s[8];
#pragma unroll
                        for (int j = 0; j < 8; ++j) s[j] = g0[j] * __builtin_amdgcn_rcpf(g1[j]);
                        f32x4 v0 = acc[ai][bj][m][0], v1 = acc[ai][bj][m][1];
                        v0[0] *= s[0]; v0[1] *= s[1]; v0[2] *= s[2]; v0[3] *= s[3]; v1[0] *= s[4]; v1[1] *= s[5]; v1[2] *= s[6]; v1[3] *= s[7];
                        acc[ai][bj][m][0] = v0; acc[ai][bj][m][1] = v1; } }
            return true;
        }
#pragma unroll
        for (int ai = 0; ai < 2; ++ai) {
            u32x4 ga[8];
#pragma unroll
            for (int m = 0; m < 4; ++m)
#pragma unroll
                for (int bj = 0; bj < 2; ++bj) ga[m * 2 + bj] = *(const u32x4*)(gbase + (size_t)(ai * HALF + m * 16) * LDP + bj * HALF);
#pragma unroll
            for (int m = 0; m < 4; ++m)
#pragma unroll
                for (int bj = 0; bj < 2; ++bj) { float s[8]; unpack8(ga[m * 2 + bj], s);
                    f32x4 v0 = acc[ai][bj][m][0], v1 = acc[ai][bj][m][1];
                    v0[0] *= s[0]; v0[1] *= s[1]; v0[2] *= s[2]; v0[3] *= s[3]; v1[0] *= s[4]; v1[1] *= s[5]; v1[2] *= s[6]; v1[3] *= s[7];
                    u32x4 w; w.x = pk2(v0[0], v0[1]); w.y = pk2(v0[2], v0[3]); w.z = pk2(v1[0], v1[1]); w.w = pk2(v1[2], v1[3]);
                    *(u32x4*)(ACCb + (size_t)(row0 + ai * HALF + m * 16) * DM + col0 + bj * HALF) = w; } }
        return false;
    }
};
struct EpiResid {
    static constexpr bool PERM = false;
    float* XS; const float* srcLat; const float* srcCtx; const float* MODl; int gidx;
    __device__ __forceinline__ bool operator()(Acc& acc, const Unit& u, int wr, int wc, int fr, int fq) const {
        const int row0 = u.pm * BM + wr * 64 + fr, col0 = u.pn * BM + wc * 32 + 4 * fq;
        const int r = (u.pm * BM) < NLAT ? (u.pm * BM) / SEQ : 4;
        const float* src = (u.pm * BM) < NLAT ? srcLat : srcCtx;
        const float* mg = MODl + (size_t)(r * 6 + gidx) * DM;
#pragma unroll
        for (int bj = 0; bj < 2; ++bj) {
            f32x4 gm[2], xs[2][2][4];
#pragma unroll
            for (int n = 0; n < 2; ++n) { const int col = col0 + bj * HALF + n * 16; gm[n] = *(const f32x4*)(mg + col);
#pragma unroll
                for (int ai = 0; ai < 2; ++ai)
#pragma unroll
                    for (int m = 0; m < 4; ++m) xs[n][ai][m] = *(const f32x4*)(src + (size_t)(row0 + ai * HALF + m * 16) * DM + col); }
#pragma unroll
            for (int n = 0; n < 2; ++n) { const int col = col0 + bj * HALF + n * 16;
#pragma unroll
                for (int ai = 0; ai < 2; ++ai)
#pragma unroll
                    for (int m = 0; m < 4; ++m) *(f32x4*)(XS + (size_t)(row0 + ai * HALF + m * 16) * DM + col) = xs[n][ai][m] + gm[n] * acc[ai][bj][m][n]; } }
        return false;
    }
};
struct EpiMoe1 {
    static constexpr bool PERM = true;
    bf16_t* HID;
    __device__ __forceinline__ bool operator()(Acc& acc, const Unit& u, int wr, int wc, int fr, int fq) const {
        const size_t row0 = (size_t)u.z * MOE_PAD + u.pm * BM + wr * 64 + fr; const int col0 = u.pn * HALF + wc * 32 + 8 * fq;
#pragma unroll
        for (int ai = 0; ai < 2; ++ai)
#pragma unroll
            for (int m = 0; m < 4; ++m) { const f32x4 g0 = acc[ai][0][m][0], g1 = acc[ai][0][m][1], u0 = acc[ai][1][m][0], u1 = acc[ai][1][m][1];
                float h[8];
#pragma unroll
                for (int j = 0; j < 4; ++j) { h[j] = g0[j] * __builtin_amdgcn_rcpf(1.0f + __expf(-g0[j])) * u0[j]; h[4 + j] = g1[j] * __builtin_amdgcn_rcpf(1.0f + __expf(-g1[j])) * u1[j]; }
                u32x4 w; w.x = pk2(h[0], h[1]); w.y = pk2(h[2], h[3]); w.z = pk2(h[4], h[5]); w.w = pk2(h[6], h[7]);
                *(u32x4*)(HID + (row0 + ai * HALF + m * 16) * DEXP + col0) = w; }
        return false;
    }
};
struct EpiMoeY {
    static constexpr bool PERM = true;
    bf16_t* O;
    __device__ __forceinline__ bool operator()(Acc& acc, const Unit& u, int wr, int wc, int fr, int fq) const {
        const size_t row0 = (size_t)u.z * MOE_PAD + u.pm * BM + wr * 64 + fr; const int col0 = u.pn * BM + wc * 32 + 8 * fq;
#pragma unroll
        for (int ai = 0; ai < 2; ++ai)
#pragma unroll
            for (int m = 0; m < 4; ++m) { bf16_t* rowp = O + (row0 + ai * HALF + m * 16) * DM + col0;
#pragma unroll
                for (int bj = 0; bj < 2; ++bj) { const f32x4 v0 = acc[ai][bj][m][0], v1 = acc[ai][bj][m][1];
                    u32x4 w; w.x = pk2(v0[0], v0[1]); w.y = pk2(v0[2], v0[3]); w.z = pk2(v1[0], v1[1]); w.w = pk2(v1[2], v1[3]);
                    *(u32x4*)(rowp + bj * HALF) = w; } }
        return false;
    }
};

struct SchedS5a {
    int c;
    __device__ __forceinline__ bool next(int i, Unit& u) const { if (i > 0 || c >= 64) return false; u.z = c >> 1; u.pm = c & 1; u.pn = 0; u.k = 0;
        u.ao = ((long long)u.z * 512 + u.pm * BM) * 768 * 2; u.bo = (long long)u.z * 256 * 512 * 2; return true; }
    __device__ __forceinline__ void a_ready(const Unit&) const {}
    __device__ __forceinline__ void done(const Unit&) const {}
};
struct SchedS5b {
    int c;
    __device__ __forceinline__ bool next(int i, Unit& u) const { if (i > 0 || c >= 128) return false; u.z = c >> 2; u.pm = (c >> 1) & 1; u.pn = c & 1; u.k = 0;
        u.ao = ((long long)u.z * 512 + u.pm * BM) * 768 * 2; u.bo = ((long long)u.z * 512 + u.pn * BM) * 768 * 2; return true; }
    __device__ __forceinline__ void a_ready(const Unit&) const {}
    __device__ __forceinline__ void done(const Unit&) const {}
};
struct EpiXloc {
    static constexpr bool PERM = false;
    float* XL;
    __device__ __forceinline__ bool operator()(Acc& acc, const Unit& u, int wr, int wc, int fr, int fq) const {
        const int row0 = u.pm * BM + wr * 64 + fr, col0 = wc * 32 + 4 * fq; float* base = XL + (size_t)u.z * 512 * 256;
#pragma unroll
        for (int ai = 0; ai < 2; ++ai)
#pragma unroll
            for (int m = 0; m < 4; ++m) { float* rowp = base + (size_t)(row0 + ai * HALF + m * 16) * 256 + col0;
#pragma unroll
                for (int bj = 0; bj < 2; ++bj)
#pragma unroll
                    for (int n = 0; n < 2; ++n) *(f32x4*)(rowp + bj * HALF + n * 16) = acc[ai][bj][m][n]; }
        return false;
    }
};
struct EpiS5Out {
    static constexpr bool PERM = true;
    const bf16_t* P; const float* dskip; bf16_t* GG;
    __device__ __forceinline__ bool operator()(Acc& acc, const Unit& u, int wr, int wc, int fr, int fq) const {
        const int row0 = u.pm * BM + wr * 64 + fr, col0 = u.pn * BM + wc * 32 + 8 * fq; const int g = u.z;
#pragma unroll
        for (int bj = 0; bj < 2; ++bj) { const int col = col0 + bj * HALF; const int t = col >> 4, c0 = col & 15;
            const f32x4 d0 = *(const f32x4*)(dskip + g * 16 + c0), d1 = *(const f32x4*)(dskip + g * 16 + c0 + 4);
            u32x4 uq[2][4];
#pragma unroll
            for (int ai = 0; ai < 2; ++ai)
#pragma unroll
                for (int m = 0; m < 4; ++m) uq[ai][m] = *(const u32x4*)(P + ((size_t)(row0 + ai * HALF + m * 16) * 32 + t) * LDP + S5_OFF + g * 16 + c0);
#pragma unroll
            for (int ai = 0; ai < 2; ++ai)
#pragma unroll
                for (int m = 0; m < 4; ++m) { const size_t tok = (size_t)(row0 + ai * HALF + m * 16) * 32 + t;
                    float uu[8]; unpack8(uq[ai][m], uu);
                    const f32x4 v0 = acc[ai][bj][m][0], v1 = acc[ai][bj][m][1];
                    float y[8] = {v0[0] + d0[0] * uu[0], v0[1] + d0[1] * uu[1], v0[2] + d0[2] * uu[2], v0[3] + d0[3] * uu[3], v1[0] + d1[0] * uu[4], v1[1] + d1[1] * uu[5], v1[2] + d1[2] * uu[6], v1[3] + d1[3] * uu[7]};
#pragma unroll
                    for (int j = 0; j < 8; ++j) y[j] = 0.5f * y[j] * (1.0f + tanhf(0.7978845608028654f * (y[j] + 0.044715f * y[j] * y[j] * y[j])));
                    u32x4 w; w.x = pk2(y[0], y[1]); w.y = pk2(y[2], y[3]); w.z = pk2(y[4], y[5]); w.w = pk2(y[6], y[7]);
                    *(u32x4*)(GG + tok * BW + g * 16 + c0) = w; } }
        return false;
    }
};
}


__device__ __forceinline__ float wave_scan_incl(float v, int lane) {
#pragma unroll
    for (int o = 1; o < 64; o <<= 1) { const float t = __shfl_up(v, o); if (lane >= o) v += t; }
    return v;
}
__device__ __forceinline__ float wave_scanmax_incl(float v, int lane) {
#pragma unroll
    for (int o = 1; o < 64; o <<= 1) { const float t = __shfl_up(v, o); if (lane >= o) v = fmaxf(v, t); }
    return v;
}
__device__ __forceinline__ float wave_max(float v) {
#pragma unroll
    for (int o = 32; o >= 1; o >>= 1) v = fmaxf(v, __shfl_xor(v, o));
    return v;
}
__device__ __forceinline__ void unpack8h(const u32x4 w, bf16_t (&h)[8]) {
    h[0] = (bf16_t)(w.x & 0xFFFFu); h[1] = (bf16_t)(w.x >> 16); h[2] = (bf16_t)(w.y & 0xFFFFu); h[3] = (bf16_t)(w.y >> 16);
    h[4] = (bf16_t)(w.z & 0xFFFFu); h[5] = (bf16_t)(w.z >> 16); h[6] = (bf16_t)(w.w & 0xFFFFu); h[7] = (bf16_t)(w.w >> 16);
}

__device__ __forceinline__ int tokblock_of(int b, int dir, int c) { if (c < 4) return 256 + b * 4 + (dir ? 3 - c : c); const int j = c - 4; return b * 64 + (dir ? 63 - j : j); }
__device__ __forceinline__ u32x4 rev8h(const u32x4 v) { u32x4 r; r.x = (v.w >> 16) | (v.w << 16); r.y = (v.z >> 16) | (v.z << 16); r.z = (v.y >> 16) | (v.y << 16); r.w = (v.x >> 16) | (v.x << 16); return r; }
__device__ __forceinline__ u32x4 scale8h(const u32x4 v, const float4 a, const float4 b) { float f[8]; unpack8(v, f); u32x4 r; r.x = pk2(f[0] * a.x, f[1] * a.y); r.y = pk2(f[2] * a.z, f[3] * a.w); r.z = pk2(f[4] * b.x, f[5] * b.y); r.w = pk2(f[6] * b.z, f[7] * b.w); return r; }
__device__ __forceinline__ float dot8h(const u32x4 v, const float4 a, const float4 b) { float f[8]; unpack8(v, f); return (f[0] * a.x + f[1] * a.y) + (f[2] * a.z + f[3] * a.w) + (f[4] * b.x + f[5] * b.y) + (f[6] * b.z + f[7] * b.w); }
#define ML_FRAG_LOAD(KF, VF, cc_) do { const int tb_ = tokblock_of(b, dir, (cc_)); const bf16_t* kb_ = KTg + ((size_t)tb_ * 512 + h * 128 + 32 * wd + r16) * 64 + q4 * 8; const bf16_t* vb_ = VTg + ((size_t)tb_ * 512 + h * 128 + 64 * half + 32 * we + r16) * 64 + q4 * 8; \
        _Pragma("unroll") for (int ks_ = 0; ks_ < 2; ++ks_) _Pragma("unroll") for (int j_ = 0; j_ < 2; ++j_) { VF[j_][ks_] = *(const u32x4*)(vb_ + (size_t)j_ * 16 * 64 + ks_ * 32); KF[j_][ks_] = *(const u32x4*)(kb_ + (size_t)j_ * 16 * 64 + ks_ * 32); } } while (0)
#define ML_CHUNK(c_, KF, VF, KFN, VFN) do { const int c = (c_); \
        if (c + 1 < 68) ML_FRAG_LOAD(KFN, VFN, c + 1);                        \
        const float dec = sDEC[c]; \
        {   bf16_t* cs = CST + (size_t)(chain * 68 + c) * 128 * 128; \
            _Pragma("unroll") for (int je = 0; je < 2; ++je) _Pragma("unroll") for (int jd = 0; jd < 2; ++jd) { const int e = 64 * half + 32 * we + 16 * je + r16, d0 = 32 * wd + 16 * jd + q4 * 4; \
                u32x2 pk; pk.x = pk2(acc[je][jd][0], acc[je][jd][1]); pk.y = pk2(acc[je][jd][2], acc[je][jd][3]); *(u32x2*)(cs + (size_t)e * 128 + d0) = pk; } \
            if (nown) { _Pragma("unroll") for (int jd = 0; jd < 2; ++jd) { float nv = npart[jd]; nv += __shfl_xor(nv, 16); nv += __shfl_xor(nv, 32); if (q4 == 0) NST[(size_t)(chain * 68 + c) * 128 + 32 * wd + 16 * jd + r16] = nv; } } } \
        bf16x8 vfr[2][2]; \
        _Pragma("unroll") for (int ks = 0; ks < 2; ++ks) { const float4 wa = *(const float4*)(sWS + c * 64 + ks * 32 + q4 * 8), wb = *(const float4*)(sWS + c * 64 + ks * 32 + q4 * 8 + 4); \
            _Pragma("unroll") for (int je = 0; je < 2; ++je) { const u32x4 sv = scale8h(VF[je][ks], wa, wb); vfr[je][ks] = *(const bf16x8*)&sv; } \
            if (nown) { _Pragma("unroll") for (int jd = 0; jd < 2; ++jd) npart[jd] = (ks == 0 ? dec * npart[jd] : npart[jd]) + dot8h(KF[jd][ks], wa, wb); } } \
        _Pragma("unroll") for (int je = 0; je < 2; ++je) _Pragma("unroll") for (int jd = 0; jd < 2; ++jd) acc[je][jd] = acc[je][jd] * dec; \
        _Pragma("unroll") for (int ks = 0; ks < 2; ++ks) _Pragma("unroll") for (int je = 0; je < 2; ++je) _Pragma("unroll") for (int jd = 0; jd < 2; ++jd) \
            acc[je][jd] = __builtin_amdgcn_mfma_f32_16x16x32_bf16(*(const bf16x8*)&KF[jd][ks], vfr[je][ks], acc[je][jd], 0, 0, 0); } while (0)
__device__ __forceinline__ void mlstm_state_pass(const int chain, const int half, const bf16_t* __restrict__ Pm, const bf16_t* __restrict__ KTg, const bf16_t* __restrict__ VTg, const float* __restrict__ gate_b,
                                                 bf16_t* __restrict__ CST, float* __restrict__ NST, float* __restrict__ MST, unsigned char* shm, const int tid) {
    const int dir = chain & 1, h = (chain >> 1) & 3, b = chain >> 3, lane = tid & 63, w = tid >> 6, we = w >> 2, wd = w & 3, q4 = lane >> 4, r16 = lane & 15;
    const bool nown = (half == 0) && (we == 0);
    float* sE = (float*)shm; float* sWS = sE + 68 * 64; float* sAL = sWS + 68 * 64; float* sBE = sAL + 68; float* sMO = sBE + 68; float* sDEC = sMO + 68; float* sMB = sDEC + 68;
    const float gbi = gate_b[(dir * 2 + 0) * 4 + h], gbf = gate_b[(dir * 2 + 1) * 4 + h];
    const int gcol_i = ML_OFF + 2048 + (dir * 2 + 0) * 4 + h, gcol_f = ML_OFF + 2048 + (dir * 2 + 1) * 4 + h;
    u32x4 kfA[2][2], vfA[2][2], kfB[2][2], vfB[2][2];
    ML_FRAG_LOAD(kfA, vfA, 0);
    __syncthreads();
    unsigned short gi_[9], gf_[9];
#pragma unroll
    for (int q = 0; q < 9; ++q) { const int c = min(w + 8 * q, 67); const size_t tokl = (size_t)step_tok(b, dir, c * 64 + lane); gi_[q] = Pm[tokl * LDP + gcol_i]; gf_[q] = Pm[tokl * LDP + gcol_f]; }
#pragma unroll
    for (int q = 0; q < 9; ++q) { const int c = w + 8 * q; if (c >= 68) break;
        const float ig = bf2f(gi_[q]) + gbi, fg = bf2f(gf_[q]) + gbf;
        const float lf = fminf(fg, 0.f) - log1pf(expf(-fabsf(fg)));
        const float bcs = wave_scan_incl(lf, lane); const float blast = __shfl(bcs, 63); const float ei = blast - bcs + ig; const float beta = wave_max(ei);
        sE[c * 64 + lane] = ei; if (lane == 0) { sAL[c] = blast; sBE[c] = beta; } }
    __syncthreads();
    if (tid == 0) { float m = 0.f; for (int c = 0; c < 68; ++c) { sMB[c] = m; const float mo = fmaxf(m + sAL[c], sBE[c]); sDEC[c] = expf(sAL[c] + m - mo); sMO[c] = mo; m = mo; } }
    __syncthreads();
    for (int idx = tid; idx < 68 * 64; idx += NTHR) { const int c = idx >> 6, i = idx & 63; sWS[c * 64 + (dir ? 63 - i : i)] = expf(sE[idx] - sMO[c]); }
    if (half == 0 && tid < 68) MST[chain * 68 + tid] = sMB[tid];
    __syncthreads();
    f32x4 acc[2][2];
#pragma unroll
    for (int je = 0; je < 2; ++je)
#pragma unroll
        for (int jd = 0; jd < 2; ++jd) acc[je][jd] = (f32x4){0.f, 0.f, 0.f, 0.f};
    float npart[2] = {0.f, 0.f};
    for (int c2 = 0; c2 < 68; c2 += 2) { ML_CHUNK(c2, kfA, vfA, kfB, vfB); ML_CHUNK(c2 + 1, kfB, vfB, kfA, vfA); }
    __syncthreads();
}
#undef ML_CHUNK
#undef ML_FRAG_LOAD
__device__ __forceinline__ void mlstm_out_item(const int chain, const int c, const bf16_t* __restrict__ Pm, const bf16_t* __restrict__ QKb, const bf16_t* __restrict__ VTg, const float* __restrict__ gate_b,
                                               const bf16_t* __restrict__ CST, const float* __restrict__ NST, const float* __restrict__ MST, float* __restrict__ Hout, unsigned char* shm, const int tid) {
    const int dir = chain & 1, h = (chain >> 1) & 3, b = chain >> 3, lane = tid & 63, w = tid >> 6;
    bf16_t* Qs = (bf16_t*)shm; bf16_t* Ks = (bf16_t*)(shm + 17408); bf16_t* VT = (bf16_t*)(shm + 34816); bf16_t* Cs = (bf16_t*)(shm + 53248); bf16_t* Ss = (bf16_t*)(shm + 88064);
    float* sc = (float*)(shm + 97280);
    __syncthreads();
#pragma unroll
    for (int i = 0; i < 2; ++i) { const int pid = tid + i * 512; const int s = pid >> 4, x0 = (pid & 15) * 8; const size_t toks = (size_t)step_tok(b, dir, c * 64 + s);
        *(u32x4*)(Qs + s * 136 + x0) = *(const u32x4*)(QKb + toks * 1024 + h * 128 + x0);
        *(u32x4*)(Ks + s * 136 + x0) = *(const u32x4*)(QKb + toks * 1024 + 512 + h * 128 + x0);
        { const int e = pid >> 3, o = pid & 7;
          const u32x4 vv = *(const u32x4*)(VTg + ((size_t)tokblock_of(b, dir, c) * 512 + h * 128 + e) * 64 + (dir ? 7 - o : o) * 8);
          *(u32x4*)(VT + e * 72 + o * 8) = dir ? rev8h(vv) : vv; } }
#pragma unroll
    for (int i = 0; i < 4; ++i) { const int pid = tid + i * 512; const int e = pid >> 4, x0 = (pid & 15) * 8;
        *(u32x4*)(Cs + e * 136 + x0) = *(const u32x4*)(CST + ((size_t)(chain * 68 + c) * 128 + e) * 128 + x0); }
    if (tid < 128) sc[384 + tid] = NST[(size_t)(chain * 68 + c) * 128 + tid];
    if (w == 0) {
        const float gbi = gate_b[(dir * 2 + 0) * 4 + h], gbf = gate_b[(dir * 2 + 1) * 4 + h];
        const size_t tokl = (size_t)step_tok(b, dir, c * 64 + lane);
        const float ig = bf2f(Pm[tokl * LDP + ML_OFF + 2048 + (dir * 2 + 0) * 4 + h]) + gbi;
        const float fg = bf2f(Pm[tokl * LDP + ML_OFF + 2048 + (dir * 2 + 1) * 4 + h]) + gbf;
        const float lf = fminf(fg, 0.f) - log1pf(expf(-fabsf(fg)));
        const float bcs = wave_scan_incl(lf, lane); const float gsv = ig - bcs; const float pm = wave_scanmax_incl(gsv, lane);
        const float m_in = MST[chain * 68 + c]; const float mt = bcs + fmaxf(m_in, pm);
        sc[lane] = bcs; sc[64 + lane] = gsv; sc[128 + lane] = mt; sc[192 + lane] = expf(bcs + m_in - mt); sc[256 + lane] = expf(-mt);
    }
    __syncthreads();
    const int tt = w >> 1;
    {   f32x4 aS[2] = {(f32x4){0.f, 0.f, 0.f, 0.f}, (f32x4){0.f, 0.f, 0.f, 0.f}};
#pragma unroll
        for (int ks = 0; ks < 4; ++ks) { const bf16x8 af = *(const bf16x8*)(Qs + (16 * tt + (lane & 15)) * 136 + ks * 32 + (lane >> 4) * 8);
#pragma unroll
            for (int i = 0; i < 2; ++i) { const int st = (w & 1) * 2 + i; const bf16x8 bfr = *(const bf16x8*)(Ks + (16 * st + (lane & 15)) * 136 + ks * 32 + (lane >> 4) * 8);
                aS[i] = __builtin_amdgcn_mfma_f32_16x16x32_bf16(af, bfr, aS[i], 0, 0, 0); } }
        float rs[4] = {0.f, 0.f, 0.f, 0.f};
#pragma unroll
        for (int i = 0; i < 2; ++i) { const int s = 16 * ((w & 1) * 2 + i) + (lane & 15); const float gsv = sc[64 + s];
#pragma unroll
            for (int q = 0; q < 4; ++q) { const int t = 16 * tt + (lane >> 4) * 4 + q; const float val = (s <= t) ? aS[i][q] * expf(sc[t] + gsv - sc[128 + t]) : 0.f; Ss[t * 72 + s] = f2bf(val); rs[q] += val; } }
#pragma unroll
        for (int q = 0; q < 4; ++q) { float r = rs[q]; r += __shfl_xor(r, 1); r += __shfl_xor(r, 2); r += __shfl_xor(r, 4); r += __shfl_xor(r, 8);
            if ((lane & 15) == 0) sc[512 + (w & 1) * 64 + 16 * tt + (lane >> 4) * 4 + q] = r; }
        {   const int t = tid >> 3, part = tid & 7; float dot = 0.f;
#pragma unroll
            for (int j = 0; j < 16; ++j) dot += bf2f(Qs[t * 136 + part * 16 + j]) * sc[384 + part * 16 + j];
            dot += __shfl_xor(dot, 1); dot += __shfl_xor(dot, 2); dot += __shfl_xor(dot, 4);
            if (part == 0) sc[640 + t] = sc[192 + t] * dot; }
    }
    __syncthreads();
    {   f32x4 aN[4];
#pragma unroll
        for (int i = 0; i < 4; ++i) aN[i] = (f32x4){0.f, 0.f, 0.f, 0.f};
#pragma unroll
        for (int ks = 0; ks < 4; ++ks) { const bf16x8 af = *(const bf16x8*)(Qs + (16 * tt + (lane & 15)) * 136 + ks * 32 + (lane >> 4) * 8);
#pragma unroll
            for (int i = 0; i < 4; ++i) { const int et = (w & 1) * 4 + i; const bf16x8 bfr = *(const bf16x8*)(Cs + (16 * et + (lane & 15)) * 136 + ks * 32 + (lane >> 4) * 8);
                aN[i] = __builtin_amdgcn_mfma_f32_16x16x32_bf16(af, bfr, aN[i], 0, 0, 0); } }
#pragma unroll
        for (int q = 0; q < 4; ++q) { const float it = sc[192 + 16 * tt + (lane >> 4) * 4 + q];
#pragma unroll
            for (int i = 0; i < 4; ++i) aN[i][q] *= it; }
#pragma unroll
        for (int ks = 0; ks < 2; ++ks) { const bf16x8 af = *(const bf16x8*)(Ss + (16 * tt + (lane & 15)) * 72 + ks * 32 + (lane >> 4) * 8);
#pragma unroll
            for (int i = 0; i < 4; ++i) { const int et = (w & 1) * 4 + i; const bf16x8 bfr = *(const bf16x8*)(VT + (16 * et + (lane & 15)) * 72 + ks * 32 + (lane >> 4) * 8);
                aN[i] = __builtin_amdgcn_mfma_f32_16x16x32_bf16(af, bfr, aN[i], 0, 0, 0); } }
#pragma unroll
        for (int q = 0; q < 4; ++q) { const int t = 16 * tt + (lane >> 4) * 4 + q; const size_t tokt = (size_t)step_tok(b, dir, c * 64 + t); const float dn = fmaxf(fabsf((sc[512 + t] + sc[576 + t]) + sc[640 + t]), sc[256 + t]);
#pragma unroll
            for (int i = 0; i < 4; ++i) { const int e = 16 * ((w & 1) * 4 + i) + (lane & 15); Hout[tokt * BW + h * 128 + e] = aN[i][q] / dn; } }
    }
}


#define SD_FRAG_LOAD(BF, XF, cc_) do { const int tb_ = tokblock_of(b, dir, (cc_)); const bf16_t* bb_ = BTg + ((size_t)tb_ * 256 + grp * 128 + 64 * (w >> 2) + r16) * 64 + q4 * 8; const bf16_t* xb_ = XTg + ((size_t)tb_ * 512 + h * 64 + 16 * (w & 3) + r16) * 64 + q4 * 8; \
        _Pragma("unroll") for (int ks_ = 0; ks_ < 2; ++ks_) { XF[ks_] = *(const u32x4*)(xb_ + ks_ * 32); _Pragma("unroll") for (int j_ = 0; j_ < 4; ++j_) BF[j_][ks_] = *(const u32x4*)(bb_ + (size_t)j_ * 16 * 64 + ks_ * 32); } } while (0)
#define SD_CHUNK(c_, BF, XF, BFN, XFN) do { const int c = (c_); \
        if (c + 1 < 68) SD_FRAG_LOAD(BFN, XFN, c + 1); \
        const float dec = sDEC[c]; \
        {   bf16_t* ss = SSTb + (size_t)(chain * 68 + c) * 64 * 128; const int p = 16 * (w & 3) + r16; \
            _Pragma("unroll") for (int j = 0; j < 4; ++j) { const int n0 = 16 * ((w >> 2) * 4 + j) + q4 * 4; u32x2 pk; pk.x = pk2(acc[j][0], acc[j][1]); pk.y = pk2(acc[j][2], acc[j][3]); *(u32x2*)(ss + (size_t)p * 128 + n0) = pk; } } \
        bf16x8 xfr[2]; \
        _Pragma("unroll") for (int ks = 0; ks < 2; ++ks) { const float4 wa = *(const float4*)(sSC + c * 64 + ks * 32 + q4 * 8), wb = *(const float4*)(sSC + c * 64 + ks * 32 + q4 * 8 + 4); const u32x4 sv = scale8h(XF[ks], wa, wb); xfr[ks] = *(const bf16x8*)&sv; } \
        _Pragma("unroll") for (int j = 0; j < 4; ++j) acc[j] = acc[j] * dec; \
        _Pragma("unroll") for (int ks = 0; ks < 2; ++ks) _Pragma("unroll") for (int j = 0; j < 4; ++j) acc[j] = __builtin_amdgcn_mfma_f32_16x16x32_bf16(*(const bf16x8*)&BF[j][ks], xfr[ks], acc[j], 0, 0, 0); } while (0)
__device__ __forceinline__ void ssd_state_pass(const int chain, const bf16_t* __restrict__ Pm, const bf16_t* __restrict__ BTg, const bf16_t* __restrict__ XTg, const float Aa, const float dtb,
                                               bf16_t* __restrict__ SSTb, unsigned char* shm, const int tid) {
    const int dir = chain & 1, h = (chain >> 1) & 7, b = chain >> 4, grp = h >> 2, lane = tid & 63, w = tid >> 6, q4 = lane >> 4, r16 = lane & 15;
    float* sSC = (float*)shm; float* sDEC = sSC + 68 * 64;
    const int dcol = SSD_OFF + 1536 + dir * 8 + h;
    u32x4 bfA[4][2], xfA[2], bfB[4][2], xfB[2];
    SD_FRAG_LOAD(bfA, xfA, 0);
    __syncthreads();
    unsigned short dt_[9];
#pragma unroll
    for (int q = 0; q < 9; ++q) { const int c = min(w + 8 * q, 67); dt_[q] = Pm[(size_t)step_tok(b, dir, c * 64 + lane) * LDP + dcol]; }
#pragma unroll
    for (int q = 0; q < 9; ++q) { const int c = w + 8 * q; if (c >= 68) break;
        const float xv = bf2f(dt_[q]) + dtb; const float dtv = xv > 20.f ? xv : log1pf(expf(xv));
        const float cs = wave_scan_incl(dtv * Aa, lane); const float cl = __shfl(cs, 63);
        sSC[c * 64 + (dir ? 63 - lane : lane)] = dtv * expf(cl - cs); if (lane == 0) sDEC[c] = expf(cl); }
    __syncthreads();
    f32x4 acc[4];
#pragma unroll
    for (int j = 0; j < 4; ++j) acc[j] = (f32x4){0.f, 0.f, 0.f, 0.f};
    for (int c2 = 0; c2 < 68; c2 += 2) { SD_CHUNK(c2, bfA, xfA, bfB, xfB); SD_CHUNK(c2 + 1, bfB, xfB, bfA, xfA); }
    __syncthreads();
}
#undef SD_CHUNK
#undef SD_FRAG_LOAD
__device__ __forceinline__ void ssd_out_item(const int chain, const int c, const bf16_t* __restrict__ Pm, const bf16_t* __restrict__ XBb, const bf16_t* __restrict__ XTg, const float Aa, const float dtb,
                                             const bf16_t* __restrict__ SSTb, float* __restrict__ Yout, unsigned char* shm, const int tid) {
    const int dir = chain & 1, h = (chain >> 1) & 7, b = chain >> 4, grp = h >> 2, lane = tid & 63, w = tid >> 6;
    bf16_t* Cs = (bf16_t*)shm; bf16_t* Bs = (bf16_t*)(shm + 17408); bf16_t* XT = (bf16_t*)(shm + 34816); bf16_t* Sin = (bf16_t*)(shm + 44032); bf16_t* Gs = (bf16_t*)(shm + 61440);
    float* sc = (float*)(shm + 70656);
    __syncthreads();
#pragma unroll
    for (int i = 0; i < 2; ++i) { const int pid = tid + i * 512; const int s = pid >> 4, x0 = (pid & 15) * 8; const size_t toks = (size_t)step_tok(b, dir, c * 64 + s);
        *(u32x4*)(Bs + s * 136 + x0) = *(const u32x4*)(XBb + toks * 1024 + 512 + grp * 128 + x0);
        *(u32x4*)(Cs + s * 136 + x0) = *(const u32x4*)(XBb + toks * 1024 + 768 + grp * 128 + x0);
        const int p = pid >> 4;
        *(u32x4*)(Sin + p * 136 + x0) = *(const u32x4*)(SSTb + ((size_t)(chain * 68 + c) * 64 + p) * 128 + x0); }
    {   const int p = tid >> 3, o = tid & 7;
        const u32x4 vv = *(const u32x4*)(XTg + ((size_t)tokblock_of(b, dir, c) * 512 + h * 64 + p) * 64 + (dir ? 7 - o : o) * 8);
        *(u32x4*)(XT + p * 72 + o * 8) = dir ? rev8h(vv) : vv; }
    if (w == 0) { const size_t tokl = (size_t)step_tok(b, dir, c * 64 + lane);
        const float xv = bf2f(Pm[tokl * LDP + SSD_OFF + 1536 + dir * 8 + h]) + dtb; const float dtv = xv > 20.f ? xv : log1pf(expf(xv));
        sc[lane] = wave_scan_incl(dtv * Aa, lane); sc[64 + lane] = dtv; }
    __syncthreads();
    {   const int lt = w >> 1;
        f32x4 aG[2] = {(f32x4){0.f, 0.f, 0.f, 0.f}, (f32x4){0.f, 0.f, 0.f, 0.f}};
#pragma unroll
        for (int ks = 0; ks < 4; ++ks) { const bf16x8 af = *(const bf16x8*)(Cs + (16 * lt + (lane & 15)) * 136 + ks * 32 + (lane >> 4) * 8);
#pragma unroll
            for (int i = 0; i < 2; ++i) { const int st = (w & 1) * 2 + i; const bf16x8 bfr = *(const bf16x8*)(Bs + (16 * st + (lane & 15)) * 136 + ks * 32 + (lane >> 4) * 8);
                aG[i] = __builtin_amdgcn_mfma_f32_16x16x32_bf16(af, bfr, aG[i], 0, 0, 0); } }
#pragma unroll
        for (int i = 0; i < 2; ++i) { const int s = 16 * ((w & 1) * 2 + i) + (lane & 15); const float css = sc[s], dts = sc[64 + s];
#pragma unroll
            for (int q = 0; q < 4; ++q) { const int t = 16 * lt + (lane >> 4) * 4 + q; const float val = (s <= t) ? aG[i][q] * expf(sc[t] - css) * dts : 0.f; Gs[t * 72 + s] = f2bf(val); } }
    }
    __syncthreads();
    {   const int lt = w >> 1;
        f32x4 aY[2] = {(f32x4){0.f, 0.f, 0.f, 0.f}, (f32x4){0.f, 0.f, 0.f, 0.f}};
#pragma unroll
        for (int ks = 0; ks < 4; ++ks) { const bf16x8 af = *(const bf16x8*)(Cs + (16 * lt + (lane & 15)) * 136 + ks * 32 + (lane >> 4) * 8);
#pragma unroll
            for (int i = 0; i < 2; ++i) { const int pt = (w & 1) * 2 + i; const bf16x8 bfr = *(const bf16x8*)(Sin + (16 * pt + (lane & 15)) * 136 + ks * 32 + (lane >> 4) * 8);
                aY[i] = __builtin_amdgcn_mfma_f32_16x16x32_bf16(af, bfr, aY[i], 0, 0, 0); } }
#pragma unroll
        for (int q = 0; q < 4; ++q) { const float ec = expf(sc[16 * lt + (lane >> 4) * 4 + q]); aY[0][q] *= ec; aY[1][q] *= ec; }
#pragma unroll
        for (int ks = 0; ks < 2; ++ks) { const bf16x8 af = *(const bf16x8*)(Gs + (16 * lt + (lane & 15)) * 72 + ks * 32 + (lane >> 4) * 8);
#pragma unroll
            for (int i = 0; i < 2; ++i) { const int pt = (w & 1) * 2 + i; const bf16x8 bfr = *(const bf16x8*)(XT + (16 * pt + (lane & 15)) * 72 + ks * 32 + (lane >> 4) * 8);
                aY[i] = __builtin_amdgcn_mfma_f32_16x16x32_bf16(af, bfr, aY[i], 0, 0, 0); } }
#pragma unroll
        for (int q = 0; q < 4; ++q) { const int t = 16 * lt + (lane >> 4) * 4 + q; const size_t tokt = (size_t)step_tok(b, dir, c * 64 + t);
#pragma unroll
            for (int i = 0; i < 2; ++i) { const int p = 16 * ((w & 1) * 2 + i) + (lane & 15); Yout[tokt * BW + h * 64 + p] = aY[i][q]; } }
    }
}


#define FIDX(i) ((i) + ((i) >> 4))
#define FFT_X_BYTES 69632
__device__ constexpr float FFT_CW_RE[6][16] = {{0.f, 0.f, 0.f, 0.f, 0.f, 0.f, 0.f, 0.f, 0.f, 0.f, 0.f, 0.f, 0.f, 0.f, 0.f, 0.f}, {1.0f, 0.f, 0.f, 0.f, 0.f, 0.f, 0.f, 0.f, 0.f, 0.f, 0.f, 0.f, 0.f, 0.f, 0.f, 0.f}, {1.0f, 6.123233995736766e-17f, 0.f, 0.f, 0.f, 0.f, 0.f, 0.f, 0.f, 0.f, 0.f, 0.f, 0.f, 0.f, 0.f, 0.f}, {1.0f, 0.7071067811865476f, 6.123233995736766e-17f, -0.7071067811865475f, 0.f, 0.f, 0.f, 0.f, 0.f, 0.f, 0.f, 0.f, 0.f, 0.f, 0.f, 0.f}, {1.0f, 0.9238795325112867f, 0.7071067811865476f, 0.38268343236508984f, 6.123233995736766e-17f, -0.3826834323650897f, -0.7071067811865475f, -0.9238795325112867f, 0.f, 0.f, 0.f, 0.f, 0.f, 0.f, 0.f, 0.f}, {1.0f, 0.9807852804032304f, 0.9238795325112867f, 0.8314696123025452f, 0.7071067811865476f, 0.5555702330196023f, 0.38268343236508984f, 0.19509032201612833f, 6.123233995736766e-17f, -0.1950903220161282f, -0.3826834323650897f, -0.555570233019602f, -0.7071067811865475f, -0.8314696123025453f, -0.9238795325112867f, -0.9807852804032304f}};
__device__ constexpr float FFT_CW_IM[6][16] = {{0.f, 0.f, 0.f, 0.f, 0.f, 0.f, 0.f, 0.f, 0.f, 0.f, 0.f, 0.f, 0.f, 0.f, 0.f, 0.f}, {-0.0f, 0.f, 0.f, 0.f, 0.f, 0.f, 0.f, 0.f, 0.f, 0.f, 0.f, 0.f, 0.f, 0.f, 0.f, 0.f}, {-0.0f, -1.0f, 0.f, 0.f, 0.f, 0.f, 0.f, 0.f, 0.f, 0.f, 0.f, 0.f, 0.f, 0.f, 0.f, 0.f}, {-0.0f, -0.7071067811865475f, -1.0f, -0.7071067811865476f, 0.f, 0.f, 0.f, 0.f, 0.f, 0.f, 0.f, 0.f, 0.f, 0.f, 0.f, 0.f}, {-0.0f, -0.3826834323650898f, -0.7071067811865475f, -0.9238795325112867f, -1.0f, -0.9238795325112867f, -0.7071067811865476f, -0.3826834323650899f, 0.f, 0.f, 0.f, 0.f, 0.f, 0.f, 0.f, 0.f}, {-0.0f, -0.19509032201612825f, -0.3826834323650898f, -0.5555702330196022f, -0.7071067811865475f, -0.8314696123025452f, -0.9238795325112867f, -0.9807852804032304f, -1.0f, -0.9807852804032304f, -0.9238795325112867f, -0.8314696123025455f, -0.7071067811865476f, -0.5555702330196022f, -0.3826834323650899f, -0.1950903220161286f}};
__host__ __device__ constexpr int fft_bitrev(int k, int R) { int r = 0; for (int i = 0; i < R; ++i) if (k & (1 << i)) r |= 1 << (R - 1 - i); return r; }
template <int R, bool INV>
__device__ __forceinline__ void fft_pass(float2* __restrict__ X, const float2* __restrict__ TW, const int s0, const int gidx) {
    const int lowbits = 13 - s0 - R; const int stride = 1 << lowbits;
    const int low = gidx & (stride - 1), high = gidx >> lowbits; const int base = (high << (lowbits + R)) | low;
    const int p0 = FIDX(base);
#define FFT_SLOT(k) (lowbits >= 4 ? p0 + (k) * (stride + (stride >> 4)) : p0 + (k) + ((k) >> 4))
    float2 v[1 << R];
#pragma unroll
    for (int k = 0; k < (1 << R); ++k) v[k] = X[FFT_SLOT(k)];
    const int lw = low << s0;
    if (!INV) {
#pragma unroll
        for (int j = 0; j < R; ++j) { const int hk = 1 << (R - 1 - j);
#pragma unroll
            for (int k = 0; k < (1 << R); ++k) if (!(k & hk)) { const int kk = k & (hk - 1);
                const float2 a = v[k], b = v[k + hk]; v[k] = make_float2(a.x + b.x, a.y + b.y); const float dx = a.x - b.x, dy = a.y - b.y;
                if (kk == 0) v[k + hk] = make_float2(dx, dy);
                else if (2 * kk == hk) v[k + hk] = make_float2(dy, -dx);
                else { const float cr = FFT_CW_RE[R - j][kk], ci = FFT_CW_IM[R - j][kk]; v[k + hk] = make_float2(dx * cr - dy * ci, dx * ci + dy * cr); } } }
        if (lowbits > 0) {
#pragma unroll
            for (int k = 1; k < (1 << R); ++k) { const float2 w = TW[(lw * fft_bitrev(k, R)) & 8191]; const float2 a = v[k]; v[k] = make_float2(a.x * w.x - a.y * w.y, a.x * w.y + a.y * w.x); } }
    } else {
        if (lowbits > 0) {
#pragma unroll
            for (int k = 1; k < (1 << R); ++k) { const float2 w = TW[(lw * fft_bitrev(k, R)) & 8191]; const float2 a = v[k]; v[k] = make_float2(a.x * w.x + a.y * w.y, a.y * w.x - a.x * w.y); } }
#pragma unroll
        for (int j = R - 1; j >= 0; --j) { const int hk = 1 << (R - 1 - j);
#pragma unroll
            for (int k = 0; k < (1 << R); ++k) if (!(k & hk)) { const int kk = k & (hk - 1);
                const float2 a = v[k], b = v[k + hk]; float tx, ty;
                if (kk == 0) { tx = b.x; ty = b.y; }
                else if (2 * kk == hk) { tx = -b.y; ty = b.x; }
                else { const float cr = FFT_CW_RE[R - j][kk], ci = FFT_CW_IM[R - j][kk]; tx = b.x * cr + b.y * ci; ty = b.y * cr - b.x * ci; }
                v[k] = make_float2(a.x + tx, a.y + ty); v[k + hk] = make_float2(a.x - tx, a.y - ty); } }
    }
#pragma unroll
    for (int k = 0; k < (1 << R); ++k) X[FFT_SLOT(k)] = v[k];
#undef FFT_SLOT
}
__device__ __forceinline__ void fft_fwd(float2* X, const float2* TW, const int tid) {
    fft_pass<4, false>(X, TW, 0, tid); __syncthreads(); fft_pass<4, false>(X, TW, 4, tid); __syncthreads(); if (tid < 256) fft_pass<5, false>(X, TW, 8, tid); __syncthreads(); }
__device__ __forceinline__ void fft_inv(float2* X, const float2* TW, const int tid) {
    if (tid < 256) fft_pass<5, true>(X, TW, 8, tid); __syncthreads(); fft_pass<4, true>(X, TW, 4, tid); __syncthreads(); fft_pass<4, true>(X, TW, 0, tid); __syncthreads(); }
__device__ __forceinline__ void fft_twiddles(float2* TW, const int tid) {
#pragma unroll
    for (int k = 0; k < 16; ++k) { const int m = tid + k * 512; const float xx = (float)m * (1.0f / 4096.0f); TW[m] = make_float2(cospif(xx), -sinpif(xx)); }
}
__device__ __forceinline__ void hyena_spec_item(const int oc, const float* __restrict__ HR, const float* __restrict__ nrm, float2* __restrict__ HSPEC, unsigned char* shm, const int tid) {
    float2* X = (float2*)shm; const float2* TW = (const float2*)(shm + FFT_X_BYTES);
    const int o = oc >> 9, c = oc & 511; const float inv = 1.0f / nrm[oc];
    __syncthreads();
    float hv[16];
#pragma unroll
    for (int k = 0; k < 16; ++k) { const int j = tid + k * 512;
        const unsigned off = j < SEQ ? (unsigned)j * 2048u + o * 1024 + c : j == SEQ ? (unsigned)(o * 1024 + c) : (unsigned)(2 * SEQ - j) * 2048u + o * 1024 + 512 + c;
        hv[k] = HR[off]; }
#pragma unroll
    for (int k = 0; k < 16; ++k) { const int j = tid + k * 512; X[FIDX(j)] = make_float2(j == SEQ ? 0.f : hv[k] * inv, 0.f); }
    __syncthreads();
    fft_fwd(X, TW, tid);
    float4* out = (float4*)(HSPEC + (size_t)oc * 8192 + tid * 16); const float2* xs = X + 17 * tid;
#pragma unroll
    for (int k = 0; k < 8; ++k) { const float2 x0 = xs[2 * k], x1 = xs[2 * k + 1]; out[k] = make_float4(x0.x * (1.0f / 8192.0f), x0.y * (1.0f / 8192.0f), x1.x * (1.0f / 8192.0f), x1.y * (1.0f / 8192.0f)); }
}
__device__ __forceinline__ void fft_mul_spec(float2* X, const float2* __restrict__ H, const int tid) {
    const float4* h4 = (const float4*)(H + tid * 16); float2* xs = X + 17 * tid;
#pragma unroll
    for (int k = 0; k < 8; ++k) { const float4 hv = h4[k]; const float2 x0 = xs[2 * k], x1 = xs[2 * k + 1];
        xs[2 * k] = make_float2(x0.x * hv.x - x0.y * hv.y, x0.x * hv.y + x0.y * hv.x); xs[2 * k + 1] = make_float2(x1.x * hv.z - x1.y * hv.w, x1.x * hv.w + x1.y * hv.z); }
}
__device__ __forceinline__ void hyena_fft_item(const int item, const float* __restrict__ UT, const float2* __restrict__ HSPEC, const float* __restrict__ bias, float* __restrict__ YT, unsigned char* shm, const int tid) {
    float2* X = (float2*)shm; const float2* TW = (const float2*)(shm + FFT_X_BYTES);
    const int c = item >> 1, b0 = (item & 1) * 2, b1 = b0 + 1;
    const float* u0 = UT + (size_t)(b0 * 1536 + c) * SEQ + tid * 8; const float* u1 = UT + (size_t)(b1 * 1536 + c) * SEQ + tid * 8;
    const float bias0 = bias[c], bias1 = bias[512 + c];
    float2* xs = X + FIDX(8 * tid);
    float vr[8], vi[8];
    __syncthreads();
    { const float4 a0 = *(const float4*)u0, a1 = *(const float4*)(u0 + 4), c0 = *(const float4*)u1, c1 = *(const float4*)(u1 + 4);
      vr[0] = a0.x; vr[1] = a0.y; vr[2] = a0.z; vr[3] = a0.w; vr[4] = a1.x; vr[5] = a1.y; vr[6] = a1.z; vr[7] = a1.w;
      vi[0] = c0.x; vi[1] = c0.y; vi[2] = c0.z; vi[3] = c0.w; vi[4] = c1.x; vi[5] = c1.y; vi[6] = c1.z; vi[7] = c1.w; }
#pragma unroll
    for (int k = 0; k < 8; ++k) { xs[k] = make_float2(vr[k], vi[k]); xs[4352 + k] = make_float2(0.f, 0.f); }
    __syncthreads();
    fft_fwd(X, TW, tid);
    fft_mul_spec(X, HSPEC + (size_t)c * 8192, tid);
    __syncthreads();
    fft_inv(X, TW, tid);
    { const float* p0 = u0 + (size_t)512 * SEQ; const float* p1 = u1 + (size_t)512 * SEQ;
      const float4 a0 = *(const float4*)p0, a1 = *(const float4*)(p0 + 4), c0 = *(const float4*)p1, c1 = *(const float4*)(p1 + 4);
      const float xr[8] = {a0.x, a0.y, a0.z, a0.w, a1.x, a1.y, a1.z, a1.w}, xi[8] = {c0.x, c0.y, c0.z, c0.w, c1.x, c1.y, c1.z, c1.w};
#pragma unroll
      for (int k = 0; k < 8; ++k) { const float2 cv = xs[k]; const float zr = xr[k] * (cv.x + bias0 * vr[k]), zi = xi[k] * (cv.y + bias0 * vi[k]);
          vr[k] = zr; vi[k] = zi; xs[k] = make_float2(zr, zi); xs[4352 + k] = make_float2(0.f, 0.f); } }
    __syncthreads();
    fft_fwd(X, TW, tid);
    fft_mul_spec(X, HSPEC + (size_t)(512 + c) * 8192, tid);
    __syncthreads();
    fft_inv(X, TW, tid);
    { const float* p0 = u0 + (size_t)1024 * SEQ; const float* p1 = u1 + (size_t)1024 * SEQ;
      const float4 a0 = *(const float4*)p0, a1 = *(const float4*)(p0 + 4), c0 = *(const float4*)p1, c1 = *(const float4*)(p1 + 4);
      const float xr[8] = {a0.x, a0.y, a0.z, a0.w, a1.x, a1.y, a1.z, a1.w}, xi[8] = {c0.x, c0.y, c0.z, c0.w, c1.x, c1.y, c1.z, c1.w};
      float yr[8], yi[8];
#pragma unroll
      for (int k = 0; k < 8; ++k) { const float2 cv = xs[k]; yr[k] = xr[k] * (cv.x + bias1 * vr[k]); yi[k] = xi[k] * (cv.y + bias1 * vi[k]); }
      float* y0 = YT + (size_t)(b0 * 512 + c) * SEQ + tid * 8; float* y1 = YT + (size_t)(b1 * 512 + c) * SEQ + tid * 8;
      *(float4*)y0 = make_float4(yr[0], yr[1], yr[2], yr[3]); *(float4*)(y0 + 4) = make_float4(yr[4], yr[5], yr[6], yr[7]);
      *(float4*)y1 = make_float4(yi[0], yi[1], yi[2], yi[3]); *(float4*)(y1 + 4) = make_float4(yi[4], yi[5], yi[6], yi[7]); }
}

constexpr size_t al256(size_t x) { return (x + 255) & ~(size_t)255; }
constexpr size_t O_BAR = 0;
constexpr size_t O_MOD = 16384;
constexpr size_t O_NORM = O_MOD + al256((size_t)2 * 5 * 6 * DM * 4);
constexpr size_t O_QCTR = O_NORM + al256((size_t)2 * 2 * 1024 * 4);
constexpr size_t O_ZERO_END = O_QCTR + 512;
constexpr size_t O_XS = O_ZERO_END;
constexpr size_t O_HB = O_XS + al256((size_t)NTOK * DM * 4);
constexpr size_t O_P = O_HB + al256((size_t)NTOK * DM * 2);
constexpr size_t O_WIN = O_P + al256((size_t)NTOK * LDP * 2);
constexpr size_t O_WBR = O_WIN + al256((size_t)LDP * DM * 2);
constexpr size_t O_WOUT = O_WBR + al256((size_t)4 * DM * BW * 2);
constexpr size_t O_WGU = O_WOUT + al256((size_t)DM * DM * 2);
constexpr size_t O_WD = O_WGU + al256((size_t)NEXP * 2 * DEXP * DM * 2);
constexpr size_t O_GLU = O_WD + al256((size_t)NEXP * DM * DEXP * 2);
constexpr size_t O_Y4 = O_GLU + al256((size_t)BW * BW * 2);
constexpr size_t O_U = O_Y4 + al256((size_t)NTOK * DM * 2);
constexpr size_t O_QKB = O_U + al256((size_t)NTOK * 1536 * 4);
constexpr size_t O_CST = O_QKB + al256((size_t)NTOK * 1024 * 2);
constexpr size_t O_NST = O_CST + al256((size_t)32 * 68 * 128 * 128 * 2);
constexpr size_t O_MST = O_NST + al256((size_t)32 * 68 * 128 * 4);
constexpr size_t O_XBC = O_MST + al256((size_t)32 * 68 * 4);
constexpr size_t O_SST = O_XBC + al256((size_t)NTOK * 1024 * 2);
constexpr size_t O_HF = O_SST + al256((size_t)64 * 68 * 64 * 128 * 2);
constexpr size_t O_YF = O_HF + al256((size_t)2 * NTOK * BW * 4);
constexpr size_t O_SF = O_YF + al256((size_t)2 * NTOK * BW * 4);
constexpr size_t O_LDT = O_SF + al256((size_t)2 * NCTX * BW * 4);
constexpr size_t O_AP = O_LDT + al256((size_t)4096 * 16);
constexpr size_t O_BBT = O_AP + al256((size_t)4096 * 33 * 8);
constexpr size_t O_KT = O_BBT + al256((size_t)4096 * 16 * 8);
constexpr size_t O_S5A = O_KT + al256((size_t)32 * 2 * 32 * 256 * 4);
constexpr size_t O_S5B = O_S5A + al256((size_t)32 * 512 * 768 * 2);
constexpr size_t O_XCTX = O_S5B + al256((size_t)32 * 512 * 768 * 2);
constexpr size_t O_Z = O_XCTX + al256((size_t)4 * 32 * 2 * 64 * 8);
constexpr size_t O_HRAW = O_Z + al256((size_t)NTOK * BW * 4);
constexpr size_t O_HSPEC = O_HRAW + al256((size_t)(SEQ + CTXL) * 2048 * 4);
constexpr size_t O_K2C = O_HSPEC + al256((size_t)1024 * 8192 * 8);
constexpr size_t O_GG = O_K2C + al256((size_t)(2 * CTXL) * 1024 * 4);
constexpr size_t O_PROBS = O_GG + al256((size_t)NTOK * BW * 2);
constexpr size_t O_ROWTOK = O_PROBS + al256((size_t)NTOK * 16 * 4);
constexpr size_t O_ROWGATE = O_ROWTOK + al256((size_t)NEXP * MOE_PAD * 4);
constexpr size_t O_INV = O_ROWGATE + al256((size_t)NEXP * MOE_PAD * 4);
constexpr size_t O_NORMP = O_INV + al256((size_t)NTOK * 16 * 4);
constexpr size_t WS_END = O_NORMP + al256((size_t)4 * 256 * 2048 * 4);
constexpr size_t O_XG = O_P;
constexpr size_t O_HID = O_P + al256((size_t)NEXP * MOE_PAD * DM * 2);
constexpr size_t O_YEXP = O_HID + al256((size_t)NEXP * MOE_PAD * DEXP * 2);
static_assert(O_YEXP + (size_t)NEXP * MOE_PAD * DM * 2 <= O_WIN, "MoE temporaries must fit inside P");
static_assert((size_t)NTOK * DM * 2 <= (size_t)NTOK * 1536 * 4, "ACCb must fit inside U");
static_assert((size_t)26214400 + (size_t)2 * 17825792 + (size_t)272 * 256 * 64 * 2 <= (size_t)NTOK * DM * 2, "strip buffers must fit inside HB");
static_assert(WS_END <= (size_t)1851000000, "workspace map exceeds the guaranteed size");

struct Args {
    const float* in[47];
    float* out; unsigned char* ws;
    int ph_lo, ph_hi;
};

__device__ __forceinline__ void conv_tile(const float* __restrict__ src, int ldsrc, int nvalid, int k0, int n0, bf16_t* __restrict__ dst, int lddst, int mode, float* T, int tid) {
    { const int n = tid & 63, kr = tid >> 6;
#pragma unroll
      for (int i = 0; i < 8; ++i) { const int k = i * 8 + kr; T[k * 65 + n] = (n0 + n < nvalid) ? src[(size_t)(k0 + k) * ldsrc + n0 + n] : 0.f; } }
    __syncthreads();
    { const int n = tid >> 3, kc = (tid & 7) * 8; const int gn = n0 + n;
      const int drow = mode == 0 ? gn : (32 * (gn >> 4) + (mode == 2 ? 16 : 0) + (gn & 15));
      u32x4 w; w.x = pk2(T[(kc + 0) * 65 + n], T[(kc + 1) * 65 + n]); w.y = pk2(T[(kc + 2) * 65 + n], T[(kc + 3) * 65 + n]);
      w.z = pk2(T[(kc + 4) * 65 + n], T[(kc + 5) * 65 + n]); w.w = pk2(T[(kc + 6) * 65 + n], T[(kc + 7) * 65 + n]);
      *(u32x4*)(dst + (size_t)drow * lddst + k0 + kc) = w; }
    __syncthreads();
}

#define IN(id) (lo <= (id) && (id) < hi)
#define SEAM(id) do { if (hi > (id) + 1) xcd_barrier(bar); } while (0)
#define PH_BEGIN int tid = threadIdx.x; asm volatile("" : "+v"(tid) :: "memory"); const int lane = tid & 63, wave = tid >> 6; (void)lane; (void)wave;

#define x_in (PT(0))
#define c_in (PT(1))
#define ctx_in (PT(2))
#define cctx_in (PT(3))
#define ada_w (PT(4))
#define ada_b (PT(5))
#define norm_mix (PT(6))
#define norm_ffn (PT(7))
#define w_in (PT(8))
#define XS ((float*)(a.ws + O_XS))
#define MOD ((float*)(a.ws + O_MOD))
#define NORM ((float*)(a.ws + O_NORM))
#define NORMP ((float*)(a.ws + O_NORMP))
#define MODl (MOD + (size_t)l * 5 * 6 * DM)
#define HB ((bf16_t*)(a.ws + O_HB))
#define P ((bf16_t*)(a.ws + O_P))
#define WIN ((bf16_t*)(a.ws + O_WIN))
#define WBR ((bf16_t*)(a.ws + O_WBR))
#define WOUT ((bf16_t*)(a.ws + O_WOUT))
#define WGU ((bf16_t*)(a.ws + O_WGU))
#define WD ((bf16_t*)(a.ws + O_WD))
#define GLU ((bf16_t*)(a.ws + O_GLU))
#define Y4 ((bf16_t*)(a.ws + O_Y4))
#define U ((float*)(a.ws + O_U))
#define ACCb ((bf16_t*)(a.ws + O_U))
#define QKB ((bf16_t*)(a.ws + O_QKB))
#define CST ((bf16_t*)(a.ws + O_CST))
#define NST ((float*)(a.ws + O_NST))
#define MST ((float*)(a.ws + O_MST))
#define XBC ((bf16_t*)(a.ws + O_XBC))
#define SSTB ((bf16_t*)(a.ws + O_SST))
#define HF ((float*)(a.ws + O_HF))
#define HBk (HF + (size_t)NTOK * BW)
#define YF ((float*)(a.ws + O_YF))
#define YB (YF + (size_t)NTOK * BW)
#define SF ((float*)(a.ws + O_SF))
#define SB (SF + (size_t)NCTX * BW)
#define LDT ((double2*)(a.ws + O_LDT))
#define APW ((float2*)(a.ws + O_AP))
#define BBT ((float2*)(a.ws + O_BBT))
#define KTB ((float*)(a.ws + O_KT))
#define S5A ((bf16_t*)(a.ws + O_S5A))
#define S5B ((bf16_t*)(a.ws + O_S5B))
#define XCTX ((float2*)(a.ws + O_XCTX))
#define S5P ((bf16_t*)(a.ws + O_HB))
#define XLOC ((float*)(a.ws + O_HB + (size_t)32 * 256 * 512 * 2))
#define KTG ((bf16_t*)(a.ws + O_HB + (size_t)26214400))
#define VTG ((bf16_t*)(a.ws + O_HB + (size_t)26214400 + (size_t)17825792))
#define BTG ((bf16_t*)(a.ws + O_HB + (size_t)26214400 + (size_t)2 * 17825792))
#define XTG ((bf16_t*)(a.ws + O_GG))
#define Z ((float*)(a.ws + O_Z))
#define HRAW ((float*)(a.ws + O_HRAW))
#define HSPEC ((float2*)(a.ws + O_HSPEC))
#define UT ((float*)(a.ws + O_U))
#define YT ((float*)(a.ws + O_Z))
#define QCTR ((int*)(a.ws + O_QCTR))
#define K2C ((float*)(a.ws + O_K2C))
#define GG ((bf16_t*)(a.ws + O_GG))
#define PROBS ((float*)(a.ws + O_PROBS))
#define ROWTOK ((int*)(a.ws + O_ROWTOK))
#define ROWGATE ((float*)(a.ws + O_ROWGATE))
#define XG ((bf16_t*)(a.ws + O_XG))
#define HID ((bf16_t*)(a.ws + O_HID))
#define YEXP ((bf16_t*)(a.ws + O_YEXP))
#define INV ((int*)(a.ws + O_INV))


__device__ __forceinline__ void moe_combine(float4 (&v)[8], const int tok, const int lane, const int* __restrict__ inv, const float* __restrict__ rowgate, const bf16_t* __restrict__ yexp, const float* __restrict__ m5) {
    float4 a[8];
#pragma unroll
    for (int i = 0; i < 8; ++i) a[i] = make_float4(0.f, 0.f, 0.f, 0.f);
    for (int e = 0; e < 16; ++e) { const int row = __builtin_amdgcn_readfirstlane(inv[tok * 16 + e]);
        if (row >= 0) { const float gt = rowgate[row]; const bf16_t* yr = yexp + (size_t)row * DM + lane * 4;
#pragma unroll
            for (int i = 0; i < 8; ++i) { const u32x2 w = *(const u32x2*)(yr + i * 256);
                a[i].x += gt * __uint_as_float(w.x << 16); a[i].y += gt * __uint_as_float(w.x & 0xFFFF0000u); a[i].z += gt * __uint_as_float(w.y << 16); a[i].w += gt * __uint_as_float(w.y & 0xFFFF0000u); } } }
#pragma unroll
    for (int i = 0; i < 8; ++i) { const float4 mm = *(const float4*)(m5 + i * 256 + lane * 4); v[i].x += mm.x * a[i].x; v[i].y += mm.y * a[i].y; v[i].z += mm.z * a[i].z; v[i].w += mm.w * a[i].w; }
}
struct CvU { const float* src; bf16_t* dst; int ldsrc, nvalid, k0, n0, lddst, mode; };
__device__ __forceinline__ void cv_load(const CvU& u, float4 (&r)[8], const int tid) {
#pragma unroll
    for (int i = 0; i < 8; ++i) { const int idx = tid + i * 512; const int k = idx >> 6, n = u.n0 + (idx & 63) * 4;
        r[i] = (n < u.nvalid) ? *(const float4*)(u.src + (size_t)(u.k0 + k) * u.ldsrc + n) : make_float4(0.f, 0.f, 0.f, 0.f); }
}
__device__ __forceinline__ void cv_stage(float* T, const float4 (&r)[8], const int tid) {
#pragma unroll
    for (int i = 0; i < 8; ++i) { const int idx = tid + i * 512; float* p = T + (idx >> 6) * 257 + (idx & 63) * 4; p[0] = r[i].x; p[1] = r[i].y; p[2] = r[i].z; p[3] = r[i].w; }
}
__device__ __forceinline__ void cv_store(const CvU& u, const float* T, const int tid) {
#pragma unroll
    for (int j = 0; j < 4; ++j) { const int o = tid + j * 512; const int kc = (o & 7) * 8, n = o >> 3; const int gn = u.n0 + n;
        const int drow = u.mode == 0 ? gn : (256 * (gn >> 7) + (u.mode == 2 ? 128 : 0) + (gn & 127));
        const float* t = T + kc * 257 + n;
        u32x4 w; w.x = pk2(t[0], t[257]); w.y = pk2(t[2 * 257], t[3 * 257]); w.z = pk2(t[4 * 257], t[5 * 257]); w.w = pk2(t[6 * 257], t[7 * 257]);
        *(u32x4*)(u.dst + (size_t)drow * u.lddst + u.k0 + kc) = w; }
}
template <int LAYER>
__device__ __forceinline__ void layer_body(const Args& a, const XcdBarrier& bar, const int lo, const int hi, const int bid, const int G, unsigned char* const shm, float* const sf, const float** const ptab) {
        constexpr int l = LAYER;
        constexpr int PB = 1 + 16 * l;
        const bool lastl = (l == 1);

        const int nPanels = lastl ? 64 : 68;
        const int M2 = nPanels * 256;

        if (IN(PB + 0)) for (int rep_ = 0; rep_ < (l == 0 ? PROBE_REPS(0) : 1); ++rep_) {
            PH_BEGIN
            {   const float* wbr = PT(40) + (size_t)l * 4 * BW * DM; const float* wout = PT(41) + (size_t)l * DM * DM;
                const float* wg = PT(43) + (size_t)l * NEXP * DM * DEXP; const float* wu = PT(44) + (size_t)l * NEXP * DM * DEXP; const float* wd = PT(45) + (size_t)l * NEXP * DEXP * DM;
                const float* wglu = PT(32) + (size_t)l * BW * BW; const float* win = w_in + (size_t)l * DM * IN_W;
                const int n_win = 32 * 55, n_br = 4 * 64, n_out = 32 * 8, n_gu = 16 * 2 * 192, n_d = 16 * 192, n_glu = 16;
                const int total = n_win + n_br + n_out + n_gu + n_d + n_glu;
#define CV_DECODE(q_, u_) do { int qq_ = (q_); \
                    if (qq_ < n_win) { u_ = CvU{win, WIN, IN_W, IN_W, (qq_ / 55) * 64, (qq_ % 55) * 256, DM, 0}; } else { qq_ -= n_win; \
                    if (qq_ < n_br) { const int k = qq_ >> 6, r = qq_ & 63; u_ = CvU{wbr + (size_t)k * BW * DM, WBR + (size_t)k * DM * BW, DM, DM, (r >> 3) * 64, (r & 7) * 256, BW, 0}; } else { qq_ -= n_br; \
                    if (qq_ < n_out) { u_ = CvU{wout, WOUT, DM, DM, (qq_ >> 3) * 64, (qq_ & 7) * 256, DM, 0}; } else { qq_ -= n_out; \
                    if (qq_ < n_gu) { const int e = qq_ / 384, r = qq_ % 384, up = r / 192, r2 = r % 192; u_ = CvU{(up ? wu : wg) + (size_t)e * DM * DEXP, WGU + (size_t)e * 2 * DEXP * DM, DEXP, DEXP, (r2 / 6) * 64, (r2 % 6) * 256, DM, 1 + up}; } else { qq_ -= n_gu; \
                    if (qq_ < n_d) { const int e = qq_ / 192, r = qq_ % 192; u_ = CvU{wd + (size_t)e * DEXP * DM, WD + (size_t)e * DM * DEXP, DM, DM, (r >> 3) * 64, (r & 7) * 256, DEXP, 0}; } else { qq_ -= n_d; \
                    u_ = CvU{wglu, GLU, BW, BW, (qq_ >> 1) * 64, (qq_ & 1) * 256, BW, 0}; } } } } } } while (0)
                __syncthreads();
                int q = bid; int buf = 0; CvU u; float4 r[8];
                if (q < total) { CV_DECODE(q, u); cv_load(u, r, tid); }
                while (q < total) {
                    float* T = sf + buf * (64 * 257);
                    cv_stage(T, r, tid);
                    __syncthreads();
                    const CvU cur = u; const int qn = q + G;
                    if (qn < total) { CV_DECODE(qn, u); cv_load(u, r, tid); }
                    cv_store(cur, T, tid);
                    buf ^= 1; q = qn;
                }
#undef CV_DECODE
                __syncthreads();
            }
            for (int set = 0; set < (lastl ? 1 : 2); ++set) {
                const int L = set ? CTXL : SEQ; float* HR = HRAW + (set ? (size_t)SEQ * 2048 : 0);
                const float* w1 = PT(11) + l * 33 * 64; const float* b1 = PT(12) + l * 64; const float* fr1 = PT(13) + l * 64; const float* w2 = PT(14) + l * 64 * 64; const float* b2 = PT(15) + l * 64;
                const float* fr2 = PT(16) + l * 64; const float* w3 = PT(17) + l * 64 * 2048; const float* decay = PT(18) + l * 2048;
                float* feats = sf; float* h1 = sf + 16 * 33; float* h2 = h1 + 16 * 64;
                float nacc[4] = {0.f, 0.f, 0.f, 0.f};
                for (int base = bid; base < L; base += 16 * G) {
                    __syncthreads();
                    for (int e = tid; e < 16 * 33; e += NTHR) { const int ti = e / 33, fi = e % 33; int t = base + ti * G; if (t > L - 1) t = L - 1;
                        float v;
                        if (fi == 0) v = (float)t / (float)(L - 1);
                        else { const int j = (fi - 1) & 15; const double fr = 1e-4 + (double)j * ((15.0 - 1e-4) / 15.0); const double ang = (2.0 * 3.14159265358979323846 / (double)L) * (double)t * fr; v = fi <= 16 ? (float)cos(ang) : (float)(-sin(ang)); }
                        feats[e] = v; }
                    __syncthreads();
                    { const int j = tid & 63, ti = tid >> 6; float s0 = b1[j], s1 = s0;
_Pragma("unroll 3")
                      for (int i = 0; i < 33; ++i) { const float wv = w1[i * 64 + j]; s0 += feats[ti * 33 + i] * wv; s1 += feats[(ti + 8) * 33 + i] * wv; }
                      const float f1 = fr1[j]; h1[ti * 64 + j] = sinf(f1 * s0); h1[(ti + 8) * 64 + j] = sinf(f1 * s1); }
                    __syncthreads();
                    { const int j = tid & 63, ti = tid >> 6; float s0 = b2[j], s1 = s0;
_Pragma("unroll 4")
                      for (int i = 0; i < 64; ++i) { const float wv = w2[i * 64 + j]; s0 += h1[ti * 64 + i] * wv; s1 += h1[(ti + 8) * 64 + i] * wv; }
                      const float f2 = fr2[j]; h2[ti * 64 + j] = sinf(f2 * s0); h2[(ti + 8) * 64 + j] = sinf(f2 * s1); }
                    __syncthreads();
                    float acc[16][4];
#pragma unroll
                    for (int ti = 0; ti < 16; ++ti) { acc[ti][0] = 0.f; acc[ti][1] = 0.f; acc[ti][2] = 0.f; acc[ti][3] = 0.f; }
#pragma unroll 2
                    for (int i = 0; i < 64; ++i) { const float* wrow = w3 + (size_t)i * 2048 + tid; const float wa = wrow[0], wb = wrow[512], wc2 = wrow[1024], wd2 = wrow[1536];
#pragma unroll
                        for (int ti = 0; ti < 16; ++ti) { const float hv = h2[ti * 64 + i]; acc[ti][0] += hv * wa; acc[ti][1] += hv * wb; acc[ti][2] += hv * wc2; acc[ti][3] += hv * wd2; } }
                    float dk[4];
#pragma unroll
                    for (int k = 0; k < 4; ++k) dk[k] = fabsf(decay[tid + k * 512]);
#pragma unroll
                    for (int ti = 0; ti < 16; ++ti) { const int t = base + ti * G; if (t < L) { const float tn = (float)t / (float)(L - 1);
#pragma unroll
                        for (int k = 0; k < 4; ++k) { const float v = acc[ti][k] * expf(-tn * dk[k]); HR[(size_t)t * 2048 + tid + k * 512] = v; nacc[k] += fabsf(v); } } }
                }
                float* nrp = NORMP + ((size_t)(l * 2 + set) * 256 + bid) * 2048;
#pragma unroll
                for (int k = 0; k < 4; ++k) nrp[tid + k * 512] = nacc[k];
            }
            for (int idx = bid * NTHR + tid; idx < 4096; idx += G * NTHR) { const int n = idx & 63, g = (idx >> 6) & 31, dir = idx >> 11;
                const double are = (double)(PT(24) + l * 4096)[idx], aim = (double)(PT(25) + l * 4096)[idx]; const double lam = are < -1e-4 ? are : -1e-4; const double dt = exp((double)(PT(26) + l * 64)[dir * 32 + g]);
                const double ldre = lam * dt, ldim = aim * dt; LDT[idx] = make_double2(ldre, ldim);
                const double mag = exp(ldre); const double ar = mag * cos(ldim), ai = mag * sin(ldim);
                const double den = lam * lam + aim * aim; const double nr = ar - 1.0, ni = ai; const double fre = (nr * lam + ni * aim) / den, fim = (ni * lam - nr * aim) / den;
                const float* b_re = PT(27) + l * 32 * 64 * 16; const float* b_im = PT(28) + l * 32 * 64 * 16;
#pragma unroll 4
                for (int c = 0; c < 16; ++c) { const double br = (double)b_re[(g * 64 + n) * 16 + c], bi = (double)b_im[(g * 64 + n) * 16 + c]; BBT[idx * 16 + c] = make_float2((float)(fre * br - fim * bi), (float)(fre * bi + fim * br)); }
            }
            for (int e2 = bid * NTHR + tid; e2 < 4096 * 33; e2 += G * NTHR) { const int idx = e2 / 33, k = e2 - idx * 33; const int g = (idx >> 6) & 31, dir = idx >> 11;
                const double are = (double)(PT(24) + l * 4096)[idx], aim = (double)(PT(25) + l * 4096)[idx]; const double lam = are < -1e-4 ? are : -1e-4; const double dt = exp((double)(PT(26) + l * 64)[dir * 32 + g]);
                const double ldre = lam * dt, ldim = aim * dt; const double mk = exp(ldre * k); APW[e2] = make_float2((float)(mk * cos(ldim * k)), (float)(mk * sin(ldim * k))); }
            if (l == 0 && lo == 0) xcd_barrier(bar);
            for (int tok = bid * 8 + wave; tok < NTOK; tok += G * 8) {
                const int r = tok < NLAT ? tok / SEQ : 4; const float* xr = l == 0 ? (tok < NLAT ? x_in + (size_t)tok * DM : ctx_in + (size_t)(tok - NLAT) * DM) : XS + (size_t)tok * DM; const float* gn = norm_mix + l * DM;
                const float* sh = MODl + (size_t)(r * 6 + 0) * DM; const float* sc = MODl + (size_t)(r * 6 + 1) * DM;
                float4 v[8]; float ss = 0.f;
#pragma unroll
                for (int i = 0; i < 8; ++i) v[i] = *(const float4*)(xr + i * 256 + lane * 4);
                if (l > 0) {
                    moe_combine(v, tok, lane, INV, ROWGATE, YEXP, MOD + (size_t)((l - 1) * 5 + r) * 6 * DM + 5 * DM);
#pragma unroll
                    for (int i = 0; i < 8; ++i) *(float4*)(XS + (size_t)tok * DM + i * 256 + lane * 4) = v[i]; }
#pragma unroll
                for (int i = 0; i < 8; ++i) ss += v[i].x * v[i].x + v[i].y * v[i].y + v[i].z * v[i].z + v[i].w * v[i].w;
                ss = wave_sum(ss); const float rs = rsqrtf(ss * (1.0f / DM) + 1e-6f);
#pragma unroll
                for (int i = 0; i < 8; ++i) { const int d = i * 256 + lane * 4; const float4 g4 = *(const float4*)(gn + d), s4 = *(const float4*)(sc + d), h4 = *(const float4*)(sh + d);
                    v[i].x = v[i].x * rs * g4.x * (1.f + s4.x) + h4.x; v[i].y = v[i].y * rs * g4.y * (1.f + s4.y) + h4.y; v[i].z = v[i].z * rs * g4.z * (1.f + s4.z) + h4.z; v[i].w = v[i].w * rs * g4.w * (1.f + s4.w) + h4.w; }
#pragma unroll
                for (int i = 0; i < 8; ++i) { u32x2 w; w.x = pk2(v[i].x, v[i].y); w.y = pk2(v[i].z, v[i].w); *(u32x2*)(HB + (size_t)tok * DM + i * 256 + lane * 4) = w; }
            }
            SEAM(PB + 0);
        }

        if (IN(PB + 1)) for (int rep_ = 0; rep_ < PROBE_REPS(1); ++rep_) {
            PH_BEGIN
            for (int base = bid * 8; base < (lastl ? 1 : 2) * 1024; base += G * 8) {
                const int idx = base + (tid & 7), sl = tid >> 3; const int set = idx >> 10, oc = idx & 1023, o = oc >> 9, c = oc & 511;
                const float* pp = NORMP + (size_t)(l * 2 + set) * 256 * 2048 + o * 1024 + c + (size_t)(sl * 4) * 2048; float sacc = 0.f;
#pragma unroll
                for (int j = 0; j < 4; ++j) { const float p0 = pp[(size_t)j * 2048], p1 = pp[(size_t)j * 2048 + 512]; sacc += (sl * 4 + j < G) ? p0 + p1 : 0.f; }
                sf[sl * 8 + (tid & 7)] = sacc; __syncthreads();
                if (tid < 8) { float t = 0.f;
#pragma unroll 8
                    for (int q = 0; q < 64; ++q) t += sf[q * 8 + tid];
                    NORM[(size_t)(l * 2 + set) * 1024 + oc] = t; }
                __syncthreads(); }
            for (int idx = (G - 1 - bid) * NTHR + tid; idx < 32768; idx += G * NTHR) { const int c = idx & 15, lag = (idx >> 4) & 31, dir = (idx >> 9) & 1, g = idx >> 10;
                const float* c_re = PT(29) + l * 32 * 16 * 64 + (g * 16 + c) * 64; const float* c_im = PT(30) + l * 32 * 16 * 64 + (g * 16 + c) * 64;
                float acc[16];
#pragma unroll
                for (int j = 0; j < 16; ++j) acc[j] = 0.f;
#pragma unroll 2
                for (int n = 0; n < 64; ++n) { const int pi = (dir * 32 + g) * 64 + n; const float2 ap = APW[pi * 33 + lag]; const float cr = c_re[n], ci = c_im[n]; const float wr_ = cr * ap.x - ci * ap.y, wi_ = cr * ap.y + ci * ap.x;
                    const float4* bb = (const float4*)(BBT + pi * 16);
#pragma unroll
                    for (int j = 0; j < 8; ++j) { const float4 b2 = bb[j]; acc[2 * j] += wr_ * b2.x - wi_ * b2.y; acc[2 * j + 1] += wr_ * b2.z - wi_ * b2.w; } }
                float4* o = (float4*)(KTB + (size_t)idx * 16);
                o[0] = make_float4(acc[0], acc[1], acc[2], acc[3]); o[1] = make_float4(acc[4], acc[5], acc[6], acc[7]); o[2] = make_float4(acc[8], acc[9], acc[10], acc[11]); o[3] = make_float4(acc[12], acc[13], acc[14], acc[15]);
            }
            __syncthreads();
            pg8::Gemm g{HB, WIN, DM, DM, DM}; pg8::SchedStd S{68, 55, G, bid, DM, DM}; pg8::EpiWin E{P, LDP};
            pg8::gemm_phase(( LAS unsigned char*)shm, g, S, E);
#if defined(PROBE_BNOEPI)
            { __syncthreads(); pg8::EpiNone E0; pg8::gemm_phase((LAS unsigned char*)shm, g, S, E0); }
#endif
            SEAM(PB + 1);
        }

        if (IN(PB + 2)) for (int rep_ = 0; rep_ < PROBE_REPS(2); ++rep_) {
            PH_BEGIN
            const float* hcw = PT(9) + l * 3 * 1536; const float* hcb = PT(10) + l * 1536; const float* mcw = PT(20) + l * 3 * 1024; const float* mcb = PT(21) + l * 1024;
            const float* scw = PT(34) + l * 3 * 1024; const float* scb = PT(35) + l * 1024;
            for (int unit = bid; unit < 272 * 3; unit += G) { const int seg = unit / 3, kind = unit % 3; const bool lat = seg < 256; const size_t tok0 = lat ? (size_t)seg * 64 : (size_t)NLAT + (size_t)(seg - 256) * 64;
                if (kind < 2) { const int hf = kind;
                    const int c = tid * 2; const int col = (hf ? SSD_OFF + 512 : ML_OFF) + c; const float* w = hf ? scw : mcw; const float* bsp = hf ? scb : mcb; bf16_t* dst = (hf ? XBC : QKB) + tok0 * 1024 + c;
                    const float2 w0 = *(const float2*)(w + c), w1 = *(const float2*)(w + 1024 + c), w2 = *(const float2*)(w + 2048 + c), bb = *(const float2*)(bsp + c);
                    const float osc = (!hf && c >= 512) ? 0.08838834764831845f : 1.0f;
                    const bool hasPrev = !lat && ((tok0 - NLAT) & (CTXL - 1)) != 0, hasNext = !lat && (((tok0 - NLAT) + 63) & (CTXL - 1)) != CTXL - 1;
                    bf16_t* strip = nullptr;
                    if (!hf) { if (c >= 512) strip = KTG + ((size_t)seg * 512 + (c - 512)) * 64; }
                    else { if (c < 512) strip = XTG + ((size_t)seg * 512 + c) * 64; else if (c < 768) strip = BTG + ((size_t)seg * 256 + (c - 512)) * 64; }
                    const bf16_t* pp = P + tok0 * LDP + col;
                    unsigned raw[66];
#pragma unroll
                    for (int t = 0; t < 66; ++t) raw[t] = ((t == 0 && !hasPrev) || (t == 65 && !hasNext)) ? 0u : *(const unsigned*)(pp + (ptrdiff_t)(t - 1) * LDP);
#pragma unroll
                    for (int t8 = 0; t8 < 8; ++t8) { float v0[8], v1[8];
#pragma unroll
                        for (int tt = 0; tt < 8; ++tt) { const int t = t8 * 8 + tt; const unsigned p0 = raw[t], p1 = raw[t + 1], p2 = raw[t + 2];
                            float a0 = bb.x + w0.x * __uint_as_float(p0 << 16) + w1.x * __uint_as_float(p1 << 16) + w2.x * __uint_as_float(p2 << 16);
                            float a1 = bb.y + w0.y * __uint_as_float(p0 & 0xFFFF0000u) + w1.y * __uint_as_float(p1 & 0xFFFF0000u) + w2.y * __uint_as_float(p2 & 0xFFFF0000u);
                            a0 = siluf_(a0) * osc; a1 = siluf_(a1) * osc; v0[tt] = a0; v1[tt] = a1;
                            *(unsigned*)(dst + (size_t)t * 1024) = pk2(a0, a1); }
                        if (strip) { u32x4 s0, s1; s0.x = pk2(v0[0], v0[1]); s0.y = pk2(v0[2], v0[3]); s0.z = pk2(v0[4], v0[5]); s0.w = pk2(v0[6], v0[7]); s1.x = pk2(v1[0], v1[1]); s1.y = pk2(v1[2], v1[3]); s1.z = pk2(v1[4], v1[5]); s1.w = pk2(v1[6], v1[7]);
                            *(u32x4*)(strip + t8 * 8) = s0; *(u32x4*)(strip + 64 + t8 * 8) = s1; } }
                } else {
                    const int c = (tid & 255) * 2, th = tid >> 8; const bf16_t* pp = P + (tok0 + th * 32) * LDP + ML_OFF + 1024 + c; bf16_t* strip = VTG + ((size_t)seg * 512 + c) * 64 + th * 32;
                    unsigned rv[32];
#pragma unroll
                    for (int t = 0; t < 32; ++t) rv[t] = *(const unsigned*)(pp + (size_t)t * LDP);
#pragma unroll
                    for (int t8 = 0; t8 < 4; ++t8) { u32x4 s0, s1;
                        s0.x = (rv[t8 * 8 + 0] & 0xFFFFu) | (rv[t8 * 8 + 1] << 16); s0.y = (rv[t8 * 8 + 2] & 0xFFFFu) | (rv[t8 * 8 + 3] << 16); s0.z = (rv[t8 * 8 + 4] & 0xFFFFu) | (rv[t8 * 8 + 5] << 16); s0.w = (rv[t8 * 8 + 6] & 0xFFFFu) | (rv[t8 * 8 + 7] << 16);
                        s1.x = (rv[t8 * 8 + 0] >> 16) | (rv[t8 * 8 + 1] & 0xFFFF0000u); s1.y = (rv[t8 * 8 + 2] >> 16) | (rv[t8 * 8 + 3] & 0xFFFF0000u); s1.z = (rv[t8 * 8 + 4] >> 16) | (rv[t8 * 8 + 5] & 0xFFFF0000u); s1.w = (rv[t8 * 8 + 6] >> 16) | (rv[t8 * 8 + 7] & 0xFFFF0000u);
                        *(u32x4*)(strip + t8 * 8) = s0; *(u32x4*)(strip + 64 + t8 * 8) = s1; }
                }
            }
            if (!lastl) for (int tok = NLAT + bid; tok < NTOK; tok += G) {
                const int t = (tok - NLAT) & (CTXL - 1); const bool hasL = (t != 0), hasR = (t != CTXL - 1); const bf16_t* pr = P + (size_t)tok * LDP;
                const bf16_t* prL = hasL ? pr - LDP : pr; const bf16_t* prR = hasR ? pr + LDP : pr;
                unsigned short xc[3], xl[3], xr[3];
#pragma unroll
                for (int j = 0; j < 3; ++j) { const int cc = tid + j * 512; xc[j] = pr[HY_OFF + cc]; xl[j] = prL[HY_OFF + cc]; xr[j] = prR[HY_OFF + cc]; }
#pragma unroll
                for (int j = 0; j < 3; ++j) { const int cc = tid + j * 512;
                    float acc = hcb[cc] + hcw[1536 + cc] * bf2f(xc[j]);
                    acc += hasL ? hcw[cc] * bf2f(xl[j]) : 0.f;
                    acc += hasR ? hcw[2 * 1536 + cc] * bf2f(xr[j]) : 0.f;
                    U[(size_t)tok * 1536 + cc] = acc; }
            }
            for (int idx0 = bid * NTHR + tid; idx0 < 16384 * 64; idx0 += 4 * G * NTHR) { u32x4 t4[4];
#pragma unroll
                for (int q = 0; q < 4; ++q) { const int idx = idx0 + q * G * NTHR; const int half = idx & 1, g = (idx >> 1) & 31, tok = idx >> 6;
                    if (idx < 16384 * 64) t4[q] = *(const u32x4*)(P + (size_t)tok * LDP + S5_OFF + g * 16 + half * 8); }
#pragma unroll
                for (int q = 0; q < 4; ++q) { const int idx = idx0 + q * G * NTHR; const int half = idx & 1, g = (idx >> 1) & 31, tok = idx >> 6;
                    if (idx < 16384 * 64) *(u32x4*)(S5A + ((size_t)g * 512 + (tok >> 5)) * 768 + (tok & 31) * 16 + half * 8) = t4[q]; } }
            for (int idx = bid * NTHR + tid; idx < 32 * 512 * 32 * 2; idx += G * NTHR) { const int half = idx & 1, sI = (idx >> 1) & 31, row = (idx >> 6) & 511, g = idx >> 15; const int t = row >> 4, c = row & 15; const int lag = t - sI;
                float v[8];
                if (lag > 0) { const float4* k4 = (const float4*)(KTB + ((size_t)((g * 2 + 0) * 32 + lag) * 16 + c) * 16 + half * 8); const float4 a0 = k4[0], a1 = k4[1]; v[0] = a0.x; v[1] = a0.y; v[2] = a0.z; v[3] = a0.w; v[4] = a1.x; v[5] = a1.y; v[6] = a1.z; v[7] = a1.w; }
                else if (lag < 0) { const float4* k4 = (const float4*)(KTB + ((size_t)((g * 2 + 1) * 32 - lag) * 16 + c) * 16 + half * 8); const float4 a0 = k4[0], a1 = k4[1]; v[0] = a0.x; v[1] = a0.y; v[2] = a0.z; v[3] = a0.w; v[4] = a1.x; v[5] = a1.y; v[6] = a1.z; v[7] = a1.w; }
                else { const float4* k4 = (const float4*)(KTB + ((size_t)((g * 2 + 0) * 32) * 16 + c) * 16 + half * 8); const float4* q4 = (const float4*)(KTB + ((size_t)((g * 2 + 1) * 32) * 16 + c) * 16 + half * 8); const float4 a0 = k4[0], a1 = k4[1], b0 = q4[0], b1 = q4[1];
                    v[0] = a0.x + b0.x; v[1] = a0.y + b0.y; v[2] = a0.z + b0.z; v[3] = a0.w + b0.w; v[4] = a1.x + b1.x; v[5] = a1.y + b1.y; v[6] = a1.z + b1.z; v[7] = a1.w + b1.w; }
                u32x4 w; w.x = pk2(v[0], v[1]); w.y = pk2(v[2], v[3]); w.z = pk2(v[4], v[5]); w.w = pk2(v[6], v[7]);
                *(u32x4*)(S5B + ((size_t)g * 512 + row) * 768 + sI * 16 + half * 8) = w; }
            for (int idx = bid * NTHR + tid; idx < 32 * 512 * 64; idx += G * NTHR) { const int n = idx & 63, row = (idx >> 6) & 511, g = idx >> 15; const int t = row >> 4, c = row & 15;
                const float cr = (PT(29) + l * 32 * 16 * 64)[(g * 16 + c) * 64 + n], ci = (PT(30) + l * 32 * 16 * 64)[(g * 16 + c) * 64 + n];
                const float2 af = APW[((0 * 32 + g) * 64 + n) * 33 + t + 1], ab = APW[((1 * 32 + g) * 64 + n) * 33 + 32 - t];
                bf16_t* d = S5B + ((size_t)g * 512 + row) * 768 + 512 + 2 * n;
                *(unsigned*)d = pk2(cr * af.x - ci * af.y, -(cr * af.y + ci * af.x)); *(unsigned*)(d + 128) = pk2(cr * ab.x - ci * ab.y, -(cr * ab.y + ci * ab.x)); }
            for (int idx = bid * NTHR + tid; idx < 32 * 2 * 64 * 32; idx += G * NTHR) { const int sI = idx & 31, n = (idx >> 5) & 63, dir = (idx >> 11) & 1, g = idx >> 12; const int pi = (dir * 32 + g) * 64 + n;
                const float2 pw = APW[pi * 33 + (dir ? sI : 31 - sI)]; const float4* bb = (const float4*)(BBT + pi * 16);
                float re[16], im[16];
#pragma unroll
                for (int j = 0; j < 8; ++j) { const float4 b2 = bb[j]; re[2 * j] = pw.x * b2.x - pw.y * b2.y; im[2 * j] = pw.x * b2.y + pw.y * b2.x; re[2 * j + 1] = pw.x * b2.z - pw.y * b2.w; im[2 * j + 1] = pw.x * b2.w + pw.y * b2.z; }
                bf16_t* d = S5P + ((size_t)g * 256 + dir * 128 + 2 * n) * 512 + sI * 16;
                u32x4 w0, w1; w0.x = pk2(re[0], re[1]); w0.y = pk2(re[2], re[3]); w0.z = pk2(re[4], re[5]); w0.w = pk2(re[6], re[7]); w1.x = pk2(re[8], re[9]); w1.y = pk2(re[10], re[11]); w1.z = pk2(re[12], re[13]); w1.w = pk2(re[14], re[15]);
                *(u32x4*)d = w0; *(u32x4*)(d + 8) = w1;
                w0.x = pk2(im[0], im[1]); w0.y = pk2(im[2], im[3]); w0.z = pk2(im[4], im[5]); w0.w = pk2(im[6], im[7]); w1.x = pk2(im[8], im[9]); w1.y = pk2(im[10], im[11]); w1.z = pk2(im[12], im[13]); w1.w = pk2(im[14], im[15]);
                *(u32x4*)(d + 512) = w0; *(u32x4*)(d + 520) = w1; }
            {   float* T = sf;
                for (int unit = bid; unit < 4 * 64 * 24; unit += G) { const int b = unit / (64 * 24), r = (unit / 24) % 64, c0 = (unit % 24) * 64; const size_t tok0 = (size_t)b * SEQ + r * 64;
                    __syncthreads();
#pragma unroll
                    for (int i = 0; i < 8; ++i) { const int c = tid & 63, t = (tid >> 6) + 8 * i; T[t * 65 + c] = bf2f(P[(tok0 + t) * LDP + HY_OFF + c0 + c]); }
                    __syncthreads();
                    const int c = tid >> 3, tq = (tid & 7) * 8, cc = c0 + c; const float w0 = hcw[cc], w1 = hcw[1536 + cc], w2 = hcw[3072 + cc], bb = hcb[cc];
                    float o8[8];
#pragma unroll
                    for (int i = 0; i < 8; ++i) { const int t = tq + i; float acc = bb + w1 * T[t * 65 + c]; if (t > 0) acc += w0 * T[(t - 1) * 65 + c]; if (t < 63) acc += w2 * T[(t + 1) * 65 + c]; o8[i] = acc; }
                    float* dst = UT + ((size_t)b * 1536 + cc) * SEQ + r * 64 + tq;
                    *(float4*)dst = make_float4(o8[0], o8[1], o8[2], o8[3]); *(float4*)(dst + 4) = make_float4(o8[4], o8[5], o8[6], o8[7]);
                } }
            if (!lastl) {
                const int L = CTXL; const float* HR = HRAW + (size_t)SEQ * 2048; float* K2 = K2C; const float* nrm = NORM + (size_t)(l * 2 + 1) * 1024;
                const size_t total = (size_t)(2 * L - 1) * 1024;
                for (size_t i = (size_t)bid * NTHR + tid; i < total; i += (size_t)G * NTHR) { const int j = (int)(i >> 10), oc = (int)(i & 1023), o = oc >> 9, c = oc & 511; const int lag = j - (L - 1);
                    const float v = lag >= 0 ? HR[(size_t)lag * 2048 + o * 1024 + c] : HR[(size_t)(-lag) * 2048 + o * 1024 + 512 + c];
                    K2[((size_t)j * 2 + o) * 512 + c] = v / nrm[oc]; }
            }
            {   __syncthreads(); fft_twiddles((float2*)(shm + FFT_X_BYTES), tid);
                for (int oc = bid; oc < 1024; oc += G) hyena_spec_item(oc, HRAW, NORM + (size_t)(l * 2 + 0) * 1024, HSPEC, shm, tid);
                __syncthreads(); }
            SEAM(PB + 2);
        }

        if (IN(PB + 3)) for (int rep_ = 0; rep_ < PROBE_REPS(3); ++rep_) {
            PH_BEGIN
            if (rep_ > 0) { if (bid == 0 && tid == 0) __hip_atomic_store(QCTR + l * 64, 0, __ATOMIC_RELAXED, __HIP_MEMORY_SCOPE_AGENT); xcd_barrier(bar); }
            if (bid < 64) {
                mlstm_state_pass(bid >> 1, bid & 1, P, KTG, VTG, PT(22) + l * 16, CST, NST, MST, shm, tid);
            } else if (bid < 128) {
                { const int ch = bid - 64; const int dir_ = ch & 1, h_ = (ch >> 1) & 7; ssd_state_pass(ch, P, BTG, XTG, -expf(PT(37)[l * 16 + dir_ * 8 + h_]), PT(36)[l * 16 + dir_ * 8 + h_], SSTB, shm, tid); }
            } else if (bid < 160) {
                const int widx = (bid - 128) * 8 + wave; const int dir = widx & 1, g = (widx >> 1) & 31, b = widx >> 6; const int n = lane;
                float2* xb = (float2*)(shm + (size_t)wave * 16640); float2* ctab = xb + 16 * 65;
                const float* a_re = PT(24) + l * 2 * 32 * 64; const float* a_im = PT(25) + l * 2 * 32 * 64; const float* log_dt = PT(26) + l * 64;
                const float* b_re = PT(27) + l * 32 * 64 * 16; const float* b_im = PT(28) + l * 32 * 64 * 16; const float* c_re = PT(29) + l * 32 * 16 * 64; const float* c_im = PT(30) + l * 32 * 16 * 64;
#pragma unroll
                for (int c = 0; c < 16; ++c) ctab[c * 65 + lane] = make_float2(c_re[(g * 16 + c) * 64 + lane], c_im[(g * 16 + c) * 64 + lane]);
                float abr, abi, bbr[16], bbi[16];
                {   const double are = (double)a_re[(dir * 32 + g) * 64 + n], aim = (double)a_im[(dir * 32 + g) * 64 + n];
                    const double lam = are < -1e-4 ? are : -1e-4; const double dt = exp((double)log_dt[dir * 32 + g]);
                    const double mag = exp(lam * dt); const double ar = mag * cos(aim * dt), ai = mag * sin(aim * dt);
                    const double den = lam * lam + aim * aim; const double nr = ar - 1.0, ni = ai;
                    const double fre = (nr * lam + ni * aim) / den, fim = (ni * lam - nr * aim) / den;
                    abr = (float)ar; abi = (float)ai;
#pragma unroll
                    for (int c = 0; c < 16; ++c) { const double br = (double)b_re[(g * 64 + n) * 16 + c], bi = (double)b_im[(g * 64 + n) * 16 + c]; bbr[c] = (float)(fre * br - fim * bi); bbi[c] = (float)(fre * bi + fim * br); }
                }
                float xr = 0.f, xi = 0.f; float* Sout = (dir ? SB : SF) - (size_t)NLAT * BW;
                const int s = lane >> 2, cg = lane & 3;
                for (int i0 = 0; i0 < CTXL; i0 += 16) {
#pragma unroll 4
                    for (int ss = 0; ss < 16; ++ss) {
                        const size_t tok = (size_t)step_tok(b, dir, i0 + ss);
                        const u32x4* up = (const u32x4*)(P + tok * LDP + S5_OFF + g * 16);
                        float t0[8], t1[8]; unpack8(up[0], t0); unpack8(up[1], t1);
                        float bur = 0.f, bui = 0.f;
#pragma unroll
                        for (int c = 0; c < 8; ++c) { bur += t0[c] * bbr[c] + t1[c] * bbr[8 + c]; bui += t0[c] * bbi[c] + t1[c] * bbi[8 + c]; }
                        const float nxr = abr * xr - abi * xi + bur, nxi = abr * xi + abi * xr + bui; xr = nxr; xi = nxi;
                        xb[ss * 65 + lane] = make_float2(xr, xi);
                    }
                    asm volatile("s_waitcnt lgkmcnt(0)" ::: "memory");
                    float y0 = 0.f, y1 = 0.f, y2 = 0.f, y3 = 0.f;
                    for (int nn2 = 0; nn2 < 64; ++nn2) { const float2 xv = xb[s * 65 + nn2];
                        const float2 c0 = ctab[(cg * 4 + 0) * 65 + nn2], c1 = ctab[(cg * 4 + 1) * 65 + nn2], c2 = ctab[(cg * 4 + 2) * 65 + nn2], c3 = ctab[(cg * 4 + 3) * 65 + nn2];
                        y0 += xv.x * c0.x - xv.y * c0.y; y1 += xv.x * c1.x - xv.y * c1.y; y2 += xv.x * c2.x - xv.y * c2.y; y3 += xv.x * c3.x - xv.y * c3.y; }
                    const size_t toks = (size_t)step_tok(b, dir, i0 + s);
                    *(float4*)(Sout + toks * BW + g * 16 + cg * 4) = make_float4(y0, y1, y2, y3);
                    asm volatile("s_waitcnt lgkmcnt(0)" ::: "memory");
                }
                XCTX[((b * 32 + g) * 2 + dir) * 64 + n] = make_float2(xr, xi);
            } else {
                if (bid < 224) {
                    pg8::Gemm gg_{S5A, S5P, 768, 512, 512}; pg8::SchedS5a S_{bid - 160}; pg8::EpiXloc E_{XLOC};
                    pg8::gemm_phase((LAS unsigned char*)shm, gg_, S_, E_);
                    __syncthreads();
                }
                const int nhb = G - 160, hb = bid - 160; const float* bias = PT(19) + l * 1024; const int c = tid;
                const int nitems = lastl ? 0 : 4 * (CTXL / 8);
                for (int it = hb; it < nitems; it += nhb) {
                    int L, tokbase, b, t0; const float* K2;
                    { const int q = it; L = CTXL; tokbase = NLAT; b = q / (CTXL / 8); t0 = (q % (CTXL / 8)) * 8; K2 = K2C; }
                    const float* zb = U + (size_t)(tokbase + b * L) * 1536 + c;
                    float acc[8];
#pragma unroll
                    for (int i = 0; i < 8; ++i) acc[i] = 0.f;
                    const int base = t0 + L - 1;
                    for (int s = 0; s < L; s += 8) {
                        float k[15];
#pragma unroll
                        for (int mm = 0; mm < 15; ++mm) k[mm] = K2[((size_t)(base - s - 7 + mm) * 2 + 0) * 512 + c];
#pragma unroll
                        for (int ds = 0; ds < 8; ++ds) { const float z = zb[(size_t)(s + ds) * 1536];
#pragma unroll
                            for (int i = 0; i < 8; ++i) acc[i] += k[i - ds + 7] * z; }
                    }
#pragma unroll
                    for (int i = 0; i < 8; ++i) { const size_t tok = (size_t)(tokbase + b * L + t0 + i); const float zt = U[tok * 1536 + c]; Z[tok * BW + c] = (acc[i] + bias[c] * zt) * U[tok * 1536 + 512 + c]; }
                }
            }
            {   __syncthreads(); fft_twiddles((float2*)(shm + FFT_X_BYTES), tid);
                int* qslot = (int*)(shm + FFT_X_BYTES + 65536);
                for (;;) { __syncthreads(); if (tid == 0) *qslot = atomicAdd(QCTR + l * 64, 1); __syncthreads(); const int it = *qslot; if (it >= 1024) break;
                    hyena_fft_item(it, UT, HSPEC, PT(19) + l * 1024, YT, shm, tid); }
            }
            SEAM(PB + 3);
        }

        if (IN(PB + 4)) for (int rep_ = 0; rep_ < PROBE_REPS(4); ++rep_) {
            PH_BEGIN
            if (rep_ > 0) { if (bid == 0 && tid == 0) __hip_atomic_store(QCTR + l * 64 + 32, 0, __ATOMIC_RELAXED, __HIP_MEMORY_SCOPE_AGENT); xcd_barrier(bar); }
            if (bid >= G - 32) for (int idx = (bid - (G - 32)) * NTHR + tid; idx < 16384; idx += 32 * NTHR) { const int n = idx & 63, dir = (idx >> 6) & 1, b = (idx >> 7) & 3, g = idx >> 9;
                const float2 a32 = APW[((dir * 32 + g) * 64 + n) * 33 + 32]; float2 X = XCTX[((b * 32 + g) * 2 + dir) * 64 + n];
                const float* __restrict__ xl = XLOC + ((size_t)g * 512 + b * 128) * 256 + dir * 128 + 2 * n; bf16_t* __restrict__ dst = S5A + ((size_t)g * 512 + b * 128) * 768 + 512 + dir * 128 + 2 * n;
#pragma unroll 1
                for (int j0 = 0; j0 < 128; j0 += 16) { float2 xv[16];
#pragma unroll
                    for (int q = 0; q < 16; ++q) { const int j = dir ? 127 - (j0 + q) : j0 + q; xv[q] = *(const float2*)(xl + (size_t)j * 256); }
#pragma unroll
                    for (int q = 0; q < 16; ++q) { const int j = dir ? 127 - (j0 + q) : j0 + q;
                        *(unsigned*)(dst + (size_t)j * 768) = pk2(X.x, X.y);
                        const float nx = a32.x * X.x - a32.y * X.y + xv[q].x, ny = a32.x * X.y + a32.y * X.x + xv[q].y; X.x = nx; X.y = ny; } } }
            {   int* qslot = (int*)(shm + 102400);
                for (;;) { __syncthreads(); if (tid == 0) *qslot = atomicAdd(QCTR + l * 64 + 32, 1); __syncthreads(); const int it = *qslot; if (it >= 32 * 68 + 64 * 68) break;
                    if (it < 32 * 68) { const int chain = it / 68, c = it % 68; mlstm_out_item(chain, c, P, QKB, VTG, PT(22) + l * 16, CST, NST, MST, (chain & 1) ? HBk : HF, shm, tid); }
                    else { const int i2 = it - 32 * 68; const int chain = i2 / 68, c = i2 % 68; const int dir_ = chain & 1, h_ = (chain >> 1) & 7;
                        ssd_out_item(chain, c, P, XBC, XTG, -expf(PT(37)[l * 16 + dir_ * 8 + h_]), PT(36)[l * 16 + dir_ * 8 + h_], SSTB, dir_ ? YB : YF, shm, tid); } }
            }
            __syncthreads();
            {   const float* bias = PT(19) + l * 1024 + 512; const int c = tid;
                const int nitems = lastl ? 0 : 4 * (CTXL / 8);
                for (int it = bid; it < nitems; it += G) {
                    int L, tokbase, b, t0; const float* K2;
                    { const int q = it; L = CTXL; tokbase = NLAT; b = q / (CTXL / 8); t0 = (q % (CTXL / 8)) * 8; K2 = K2C; }
                    const float* zb = Z + (size_t)(tokbase + b * L) * BW + c;
                    float acc[8];
#pragma unroll
                    for (int i = 0; i < 8; ++i) acc[i] = 0.f;
                    const int base = t0 + L - 1;
                    for (int s = 0; s < L; s += 8) {
                        float k[15];
#pragma unroll
                        for (int mm = 0; mm < 15; ++mm) k[mm] = K2[((size_t)(base - s - 7 + mm) * 2 + 1) * 512 + c];
#pragma unroll
                        for (int ds = 0; ds < 8; ++ds) { const float z = zb[(size_t)(s + ds) * BW];
#pragma unroll
                            for (int i = 0; i < 8; ++i) acc[i] += k[i - ds + 7] * z; }
                    }
#pragma unroll
                    for (int i = 0; i < 8; ++i) { const size_t tok = (size_t)(tokbase + b * L + t0 + i); const float zt = Z[tok * BW + c]; Y4[tok * DM + c] = f2bf((acc[i] + bias[c] * zt) * U[tok * 1536 + 1024 + c]); }
                }
            }
            SEAM(PB + 4);
        }

        if (IN(PB + 5)) for (int rep_ = 0; rep_ < PROBE_REPS(5); ++rep_) {
            PH_BEGIN
            const float* ml_norm = PT(23) + l * BW; const float* ssd_d = PT(38) + l * 8; const float* ssd_norm = PT(39) + l * BW; const float* s5_d = PT(31) + l * BW;
            if (bid < 128) {
                pg8::Gemm gg_{S5A, S5B, 768, 768, 768}; pg8::SchedS5b S_{bid}; pg8::EpiS5Out E_{P, s5_d, GG};
                pg8::gemm_phase((LAS unsigned char*)shm, gg_, S_, E_);
                __syncthreads();
            }
            for (int tok = bid * 8 + wave; tok < NTOK; tok += G * 8) {
                const int c0 = lane * 8; const bf16_t* pr = P + (size_t)tok * LDP; const size_t o5 = (size_t)tok * BW + c0;
                float hm[8], ys[8];
                const u32x4 ooq = *(const u32x4*)(pr + ML_OFF + 1536 + c0);
                const float4 g0 = *(const float4*)(ml_norm + c0), g1 = *(const float4*)(ml_norm + c0 + 4), n0 = *(const float4*)(ssd_norm + c0), n1 = *(const float4*)(ssd_norm + c0 + 4);
                { const float4 a0 = *(const float4*)(HF + o5), a1 = *(const float4*)(HF + o5 + 4), b0 = *(const float4*)(HBk + o5), b1 = *(const float4*)(HBk + o5 + 4);
                  hm[0] = a0.x + b0.x; hm[1] = a0.y + b0.y; hm[2] = a0.z + b0.z; hm[3] = a0.w + b0.w; hm[4] = a1.x + b1.x; hm[5] = a1.y + b1.y; hm[6] = a1.z + b1.z; hm[7] = a1.w + b1.w; }
                { const float4 a0 = *(const float4*)(YF + o5), a1 = *(const float4*)(YF + o5 + 4), b0 = *(const float4*)(YB + o5), b1 = *(const float4*)(YB + o5 + 4);
                  float xx[8], zz[8]; unpack8(*(const u32x4*)(XBC + (size_t)tok * 1024 + c0), xx); unpack8(*(const u32x4*)(pr + SSD_OFF + c0), zz); const float dsk = ssd_d[c0 >> 6];
                  ys[0] = a0.x + b0.x; ys[1] = a0.y + b0.y; ys[2] = a0.z + b0.z; ys[3] = a0.w + b0.w; ys[4] = a1.x + b1.x; ys[5] = a1.y + b1.y; ys[6] = a1.z + b1.z; ys[7] = a1.w + b1.w;
#pragma unroll
                  for (int j = 0; j < 8; ++j) ys[j] = (ys[j] + dsk * xx[j]) * siluf_(zz[j]); }
                float s1 = 0.f, s2 = 0.f;
#pragma unroll
                for (int j = 0; j < 8; ++j) { s1 += hm[j] * hm[j]; s2 += ys[j] * ys[j]; }
                s1 += __shfl_xor(s1, 1); s1 += __shfl_xor(s1, 2); s1 += __shfl_xor(s1, 4); s1 += __shfl_xor(s1, 8);
                s2 = wave_sum(s2);
                const float r1 = rsqrtf(s1 * (1.0f / 128.0f) + 1e-6f), r2 = rsqrtf(s2 * (1.0f / BW) + 1e-6f);
                float oo[8]; unpack8(ooq, oo);
                const float gm[8] = {g0.x, g0.y, g0.z, g0.w, g1.x, g1.y, g1.z, g1.w}, gs[8] = {n0.x, n0.y, n0.z, n0.w, n1.x, n1.y, n1.z, n1.w};
                u32x4 w;
                w.x = pk2(hm[0] * r1 * gm[0] * sigmoidf_(oo[0]), hm[1] * r1 * gm[1] * sigmoidf_(oo[1])); w.y = pk2(hm[2] * r1 * gm[2] * sigmoidf_(oo[2]), hm[3] * r1 * gm[3] * sigmoidf_(oo[3]));
                w.z = pk2(hm[4] * r1 * gm[4] * sigmoidf_(oo[4]), hm[5] * r1 * gm[5] * sigmoidf_(oo[5])); w.w = pk2(hm[6] * r1 * gm[6] * sigmoidf_(oo[6]), hm[7] * r1 * gm[7] * sigmoidf_(oo[7]));
                *(u32x4*)(Y4 + (size_t)tok * DM + 512 + c0) = w;
                w.x = pk2(ys[0] * r2 * gs[0], ys[1] * r2 * gs[1]); w.y = pk2(ys[2] * r2 * gs[2], ys[3] * r2 * gs[3]); w.z = pk2(ys[4] * r2 * gs[4], ys[5] * r2 * gs[5]); w.w = pk2(ys[6] * r2 * gs[6], ys[7] * r2 * gs[7]);
                *(u32x4*)(Y4 + (size_t)tok * DM + 1536 + c0) = w;
                if (tok >= NLAT) { const size_t oc = (size_t)(tok - NLAT) * BW + c0; float uu[8]; unpack8(*(const u32x4*)(pr + S5_OFF + c0), uu);
                    const float4 a0 = *(const float4*)(SF + oc), a1 = *(const float4*)(SF + oc + 4), b0 = *(const float4*)(SB + oc), b1 = *(const float4*)(SB + oc + 4), d0 = *(const float4*)(s5_d + c0), d1 = *(const float4*)(s5_d + c0 + 4);
                    float y[8] = {a0.x + b0.x + d0.x * uu[0], a0.y + b0.y + d0.y * uu[1], a0.z + b0.z + d0.z * uu[2], a0.w + b0.w + d0.w * uu[3], a1.x + b1.x + d1.x * uu[4], a1.y + b1.y + d1.y * uu[5], a1.z + b1.z + d1.z * uu[6], a1.w + b1.w + d1.w * uu[7]};
#pragma unroll
                    for (int j = 0; j < 8; ++j) y[j] = 0.5f * y[j] * (1.0f + tanhf(0.7978845608028654f * (y[j] + 0.044715f * y[j] * y[j] * y[j])));
                    w.x = pk2(y[0], y[1]); w.y = pk2(y[2], y[3]); w.z = pk2(y[4], y[5]); w.w = pk2(y[6], y[7]);
                    *(u32x4*)(GG + (size_t)tok * BW + c0) = w; }
            }
            __syncthreads();
            {   float* T = sf;
                for (int unit = (G > 128 ? bid - 128 : bid); unit >= 0 && unit < 4 * 64 * 8; unit += (G > 128 ? G - 128 : G)) { const int b = unit / 512, t0 = ((unit >> 3) & 63) * 64, c0 = (unit & 7) * 64;
                    __syncthreads();
#pragma unroll
                    for (int i = 0; i < 8; ++i) { const int t = tid & 63, c = (tid >> 6) + 8 * i; T[c * 65 + t] = YT[((size_t)b * 512 + c0 + c) * SEQ + t0 + t]; }
                    __syncthreads();
                    const int t = tid >> 3, cq = (tid & 7) * 8;
                    u32x4 w; w.x = pk2(T[(cq + 0) * 65 + t], T[(cq + 1) * 65 + t]); w.y = pk2(T[(cq + 2) * 65 + t], T[(cq + 3) * 65 + t]); w.z = pk2(T[(cq + 4) * 65 + t], T[(cq + 5) * 65 + t]); w.w = pk2(T[(cq + 6) * 65 + t], T[(cq + 7) * 65 + t]);
                    *(u32x4*)(Y4 + ((size_t)b * SEQ + t0 + t) * DM + c0 + cq) = w;
                } }
            SEAM(PB + 5);
        }

        if (IN(PB + 6)) for (int rep_ = 0; rep_ < PROBE_REPS(6); ++rep_) {
            PH_BEGIN
            pg8::Gemm g{GG, GLU, BW, BW, BW}; pg8::SchedStd S{68, 2, G, bid, BW, BW}; pg8::EpiGlu E{GG, PT(33) + l * BW, Y4};
            pg8::gemm_phase((LAS unsigned char*)shm, g, S, E);
            SEAM(PB + 6);
        }
        if (IN(PB + 7)) for (int rep_ = 0; rep_ < PROBE_REPS(7); ++rep_) {
            PH_BEGIN
            pg8::Gemm g{Y4, WBR, DM, BW, BW}; pg8::SchedBranch S{nPanels, 8, G, bid}; pg8::EpiBranch E{P, ACCb};
            pg8::gemm_phase((LAS unsigned char*)shm, g, S, E);
            SEAM(PB + 7);
        }
        if (IN(PB + 8)) for (int rep_ = 0; rep_ < PROBE_REPS(8); ++rep_) {
            PH_BEGIN
            pg8::Gemm g{ACCb, WOUT, DM, DM, DM}; pg8::SchedStd S{nPanels, 8, G, bid, DM, DM}; pg8::EpiResid E{XS, l == 0 ? x_in : (const float*)XS, l == 0 ? ctx_in - (size_t)NLAT * DM : (const float*)XS, MODl, 2};
            pg8::gemm_phase((LAS unsigned char*)shm, g, S, E);
            SEAM(PB + 8);
        }
        if (IN(PB + 9)) for (int rep_ = 0; rep_ < PROBE_REPS(9); ++rep_) {
            PH_BEGIN
            for (int i = bid * NTHR + tid; i < NEXP * MOE_PAD; i += G * NTHR) ROWTOK[i] = -1;
            for (int i = bid * NTHR + tid; i < NTOK * 16; i += G * NTHR) INV[i] = -1;
            const float* wr = PT(42) + (size_t)l * DM * 16; const float* gn = norm_ffn + l * DM;
            for (int tok0 = (bid * 8 + wave) * 4; tok0 < M2; tok0 += G * 32) {
                const int r = tok0 < NLAT ? tok0 / SEQ : 4; const float* xr = XS + (size_t)tok0 * DM;
                const float* sh = MODl + (size_t)(r * 6 + 3) * DM; const float* sc = MODl + (size_t)(r * 6 + 4) * DM;
                float rs[4];
#pragma unroll
                for (int tk = 0; tk < 4; ++tk) { float ss = 0.f;
#pragma unroll 4
                    for (int i = 0; i < 8; ++i) { const float4 t4 = *(const float4*)(xr + (size_t)tk * DM + i * 256 + lane * 4); ss += t4.x * t4.x + t4.y * t4.y + t4.z * t4.z + t4.w * t4.w; }
                    ss = wave_sum(ss); rs[tk] = rsqrtf(ss * (1.0f / DM) + 1e-6f); }
                float lg[4][16];
#pragma unroll
                for (int tk = 0; tk < 4; ++tk)
#pragma unroll
                    for (int e = 0; e < 16; ++e) lg[tk][e] = 0.f;
#pragma unroll 1
                for (int i = 0; i < 8; ++i) { const int d = i * 256 + lane * 4;
                    const float4 g4 = *(const float4*)(gn + d), s4 = *(const float4*)(sc + d), h4 = *(const float4*)(sh + d);
                    float4 xq[4], ww[16];
#pragma unroll
                    for (int tk = 0; tk < 4; ++tk) xq[tk] = *(const float4*)(xr + (size_t)tk * DM + d);
                    const float4* wq = (const float4*)(wr + (size_t)d * 16);
#pragma unroll
                    for (int q = 0; q < 16; ++q) ww[q] = wq[q];
                    float hv[4][4];
#pragma unroll
                    for (int tk = 0; tk < 4; ++tk) { const float4 xv = xq[tk]; const float rr = rs[tk];
                        hv[tk][0] = xv.x * rr * g4.x * (1.f + s4.x) + h4.x; hv[tk][1] = xv.y * rr * g4.y * (1.f + s4.y) + h4.y; hv[tk][2] = xv.z * rr * g4.z * (1.f + s4.z) + h4.z; hv[tk][3] = xv.w * rr * g4.w * (1.f + s4.w) + h4.w;
                        u32x2 w; w.x = pk2(hv[tk][0], hv[tk][1]); w.y = pk2(hv[tk][2], hv[tk][3]); *(u32x2*)(HB + (size_t)(tok0 + tk) * DM + d) = w; }
#pragma unroll
                    for (int q = 0; q < 4; ++q) { const float4 w0 = ww[q * 4 + 0], w1 = ww[q * 4 + 1], w2 = ww[q * 4 + 2], w3 = ww[q * 4 + 3];
#pragma unroll
                        for (int tk = 0; tk < 4; ++tk) { const float hq = hv[tk][q];
                            lg[tk][0] += hq * w0.x; lg[tk][1] += hq * w0.y; lg[tk][2] += hq * w0.z; lg[tk][3] += hq * w0.w; lg[tk][4] += hq * w1.x; lg[tk][5] += hq * w1.y; lg[tk][6] += hq * w1.z; lg[tk][7] += hq * w1.w;
                            lg[tk][8] += hq * w2.x; lg[tk][9] += hq * w2.y; lg[tk][10] += hq * w2.z; lg[tk][11] += hq * w2.w; lg[tk][12] += hq * w3.x; lg[tk][13] += hq * w3.y; lg[tk][14] += hq * w3.z; lg[tk][15] += hq * w3.w; } } }
#pragma unroll
                for (int tk = 0; tk < 4; ++tk) { float mx = -1e30f;
#pragma unroll
                    for (int e = 0; e < 16; ++e) { lg[tk][e] = wave_sum(lg[tk][e]); mx = fmaxf(mx, lg[tk][e]); }
                    float sm = 0.f;
#pragma unroll
                    for (int e = 0; e < 16; ++e) { lg[tk][e] = expf(lg[tk][e] - mx); sm += lg[tk][e]; }
                    const float inv = 1.0f / sm;
                    if (lane == 0) {
#pragma unroll
                        for (int e = 0; e < 16; e += 4) *(float4*)(PROBS + (size_t)(tok0 + tk) * 16 + e) = make_float4(lg[tk][e] * inv, lg[tk][e + 1] * inv, lg[tk][e + 2] * inv, lg[tk][e + 3] * inv); } }
            }
            SEAM(PB + 9);
        }
        if (IN(PB + 10)) for (int rep_ = 0; rep_ < PROBE_REPS(10); ++rep_) {
            PH_BEGIN
            const int nitems = 64 + (lastl ? 0 : 64);
            unsigned long long* keys = (unsigned long long*)shm;
            for (int it = bid; it < nitems; it += G) {
                const int set = it >> 6, e = it & 15, b = (it >> 4) & 3;
                const int n = set ? CTXL : SEQ, cap = set ? 32 : 512, tokbase = set ? NLAT + b * CTXL : b * SEQ;
                __syncthreads();
                for (int i = tid; i < n; i += NTHR) keys[i] = ((unsigned long long)__float_as_uint(PROBS[(size_t)(tokbase + i) * 16 + e]) << 32) | (unsigned long long)(0xFFFFFFFFu - (unsigned)i);
                __syncthreads();
                for (int k = 2; k <= n; k <<= 1)
                    for (int j = k >> 1; j > 0; j >>= 1) {
                        for (int p = tid; p < (n >> 1); p += NTHR) { const int i = ((p & ~(j - 1)) << 1) | (p & (j - 1)); const int m = i | j;
                            const unsigned long long ka = keys[i], kb = keys[m]; const bool desc = ((i & k) == 0);
                            if ((ka < kb) == desc) { keys[i] = kb; keys[m] = ka; } }
                        __syncthreads();
                    }
                for (int r = tid; r < cap; r += NTHR) { const unsigned long long kk = keys[r]; const int row = e * MOE_PAD + (set ? 2048 + b * 32 + r : b * 512 + r);
                    const int tk_ = tokbase + (int)(0xFFFFFFFFu - (unsigned)(kk & 0xFFFFFFFFull)); ROWTOK[row] = tk_; ROWGATE[row] = __uint_as_float((unsigned)(kk >> 32)); INV[tk_ * 16 + e] = row; }
                for (int r = wave; r < cap; r += 8) { const int tok = tokbase + (int)(0xFFFFFFFFu - (unsigned)(keys[r] & 0xFFFFFFFFull)); const int row = e * MOE_PAD + (set ? 2048 + b * 32 + r : b * 512 + r);
                    const u32x4* sp = (const u32x4*)(HB + (size_t)tok * DM); u32x4* dp = (u32x4*)(XG + (size_t)row * DM);
#pragma unroll
                    for (int i = 0; i < 4; ++i) dp[i * 64 + lane] = sp[i * 64 + lane]; }
            }
            {   const int pad0 = lastl ? 2048 : MOE_ROWS, npad = MOE_PAD - pad0;
                for (int R = bid * 8 + wave; R < NEXP * npad; R += G * 8) { const int e = R / npad, rr = pad0 + R % npad; u32x4* dp = (u32x4*)(XG + ((size_t)e * MOE_PAD + rr) * DM);
#pragma unroll
                    for (int i = 0; i < 4; ++i) dp[i * 64 + lane] = (u32x4){0u, 0u, 0u, 0u}; } }
            SEAM(PB + 10);
        }
        if (IN(PB + 12)) for (int rep_ = 0; rep_ < PROBE_REPS(12); ++rep_) {
            PH_BEGIN
            pg8::Gemm g{XG, WGU, DM, DM, DM}; pg8::SchedMoe S{lastl ? 8 : 9, 12, G, bid, DM, DM, 2 * DEXP}; pg8::EpiMoe1 E{HID};
            pg8::gemm_phase((LAS unsigned char*)shm, g, S, E);
            SEAM(PB + 12);
        }
        if (IN(PB + 13)) for (int rep_ = 0; rep_ < PROBE_REPS(13); ++rep_) {
            PH_BEGIN
            pg8::Gemm g{HID, WD, DEXP, DEXP, DEXP}; pg8::SchedMoe S{lastl ? 8 : 9, 8, G, bid, DEXP, DEXP, DM}; pg8::EpiMoeY E{YEXP};
            pg8::gemm_phase((LAS unsigned char*)shm, g, S, E);
            SEAM(PB + 13);
        }

}

__global__ __launch_bounds__(NTHR, 2) void fwd(Args a) {
    extern __shared__ __attribute__((aligned(16))) unsigned char shm[];
    const int bid = blockIdx.x, G = gridDim.x;
    float* const sf = (float*)shm;
    volatile LAS unsigned* xbw = (volatile LAS unsigned*)((LAS unsigned char*)shm + (LDS_BYTES - 16));
    if (threadIdx.x == 0) { xbw[0] = 0u; xbw[1] = 0u; xbw[2] = 0u; xbw[3] = 0u; }
    const float** const ptab = (const float**)(shm + (LDS_BYTES - 16 - 512));
    if (threadIdx.x == 0) {
#pragma unroll
        for (int i = 0; i < 47; ++i) ptab[i] = a.in[i]; }
    __syncthreads();
    XcdBarrier bar = xcd_barrier_post((unsigned*)(a.ws + O_BAR), xbw);
    const int lo = a.ph_lo, hi = a.ph_hi;
    if (IN(0)) {
        PH_BEGIN
        {
            __syncthreads();
            for (int i = tid; i < 5 * DM; i += NTHR) { const int r = i >> 11, k = i & (DM - 1); const float v = r < 4 ? c_in[r * DM + k] : cctx_in[k]; sf[i] = siluf_(v); }
            __syncthreads();
            float* red = sf + 5 * DM;
            for (int unit = bid; unit < 2 * 96; unit += G) { const int l = unit / 96, j = (unit % 96) * 128 + (tid & 127), kq = tid >> 7;
                const float* w = ada_w + (size_t)l * DM * (6 * DM) + (size_t)(kq * 512) * (6 * DM) + j; const float* sv = sf + kq * 512;
                float a0 = 0.f, a1 = 0.f, a2 = 0.f, a3 = 0.f, a4 = 0.f;
#pragma unroll 8
                for (int k = 0; k < 512; ++k) { const float wv = w[(size_t)k * (6 * DM)]; a0 += sv[k] * wv; a1 += sv[DM + k] * wv; a2 += sv[2 * DM + k] * wv; a3 += sv[3 * DM + k] * wv; a4 += sv[4 * DM + k] * wv; }
                __syncthreads();
                { float* rp = red + (kq * 5) * 128 + (tid & 127); rp[0] = a0; rp[128] = a1; rp[256] = a2; rp[384] = a3; rp[512] = a4; }
                __syncthreads();
                if (tid < 128) { const float bb = ada_b[l * 6 * DM + j]; float* o = MOD + (size_t)l * 5 * 6 * DM + j;
#pragma unroll
                    for (int r = 0; r < 5; ++r) o[(size_t)r * 6 * DM] = ((red[(0 * 5 + r) * 128 + tid] + red[(1 * 5 + r) * 128 + tid]) + (red[(2 * 5 + r) * 128 + tid] + red[(3 * 5 + r) * 128 + tid])) + bb; }
            }
        }
    }

    layer_body<0>(a, bar, lo, hi, bid, G, shm, sf, ptab);
    layer_body<1>(a, bar, lo, hi, bid, G, shm, sf, ptab);
    if (IN(33)) {
        PH_BEGIN
        const float* gn = PT(46);
        for (int tok = bid * 8 + wave; tok < NLAT; tok += G * 8) {
            const float* xr = XS + (size_t)tok * DM; float4 v[8]; float ss = 0.f;
#pragma unroll
            for (int i = 0; i < 8; ++i) v[i] = *(const float4*)(xr + i * 256 + lane * 4);
            moe_combine(v, tok, lane, INV, ROWGATE, YEXP, MOD + (size_t)(1 * 5 + tok / SEQ) * 6 * DM + 5 * DM);
#pragma unroll
            for (int i = 0; i < 8; ++i) {                 ss += v[i].x * v[i].x + v[i].y * v[i].y + v[i].z * v[i].z + v[i].w * v[i].w; }
            ss = wave_sum(ss); const float rs = rsqrtf(ss * (1.0f / DM) + 1e-6f);
#pragma unroll
            for (int i = 0; i < 8; ++i) { const int d = i * 256 + lane * 4; const float4 g4 = *(const float4*)(gn + d);
                *(float4*)(a.out + (size_t)tok * DM + d) = make_float4(v[i].x * rs * g4.x, v[i].y * rs * g4.y, v[i].z * rs * g4.z, v[i].w * rs * g4.w); }
        }
    }
#undef IN
#undef SEAM
}


extern "C" void kernel_launch(void* const* d_in, const int* in_sizes, int n_in, void* d_out, int out_size, void* d_ws, size_t ws_size, hipStream_t stream) {
    static int grid = 0;
    if (grid == 0) {
        if (n_in != 47 || ws_size < WS_END) { fprintf(stderr, "kernel_launch: expected 47 inputs and >= %zu bytes of workspace; got %d, %zu\n", (size_t)WS_END, n_in, ws_size); grid = -1; return; }
        int dev = 0, cus = 0;
        if (hipGetDevice(&dev) != hipSuccess || hipDeviceGetAttribute(&cus, hipDeviceAttributeMultiprocessorCount, dev) != hipSuccess) { grid = -1; return; }
        if (hipFuncSetAttribute((const void*)fwd, hipFuncAttributeMaxDynamicSharedMemorySize, LDS_BYTES) != hipSuccess) { fprintf(stderr, "kernel_launch: hipFuncSetAttribute failed\n"); grid = -1; return; }
        int per_cu = 0;
        if (hipOccupancyMaxActiveBlocksPerMultiprocessor(&per_cu, (const void*)fwd, NTHR, LDS_BYTES) != hipSuccess || per_cu < 1) fprintf(stderr, "kernel_launch: occupancy query reports %d\n", per_cu);
        (void)hipGetLastError();
        grid = cus > 256 ? 256 : cus;
        if (grid < 224) { fprintf(stderr, "kernel_launch: needs >= 224 CUs (got %d)\n", grid); grid = -1; return; }
    }
    if (grid < 0) return;
    (void)hipMemsetAsync((char*)d_ws, 0, O_ZERO_END, stream);
    Args a{};
    for (int i = 0; i < 47; ++i) a.in[i] = (const float*)d_in[i];
    a.out = (float*)d_out; a.ws = (unsigned char*)d_ws;
#if MK_ONE_LAUNCH
    a.ph_lo = 0; a.ph_hi = 64;
    hipLaunchKernelGGL(fwd, dim3(grid), dim3(NTHR), LDS_BYTES, stream, a);
#else
    const int ids[] = {0, 1,2,3,4,5,6,7,8,9,10,11,12,13,14, 17,18,19,20,21,22,23,24,25,26,27,28,29,30, 33};
    for (int k = 0; k < (int)(sizeof(ids) / sizeof(ids[0])); ++k) { a.ph_lo = ids[k]; a.ph_hi = ids[k] + 1; hipLaunchKernelGGL(fwd, dim3(grid), dim3(NTHR), LDS_BYTES, stream, a); }
#endif
}
```

```cpp
#include <hip/hip_runtime.h>
#include <stdint.h>
#include <stdio.h>

#ifndef PROBE_MASK
#define PROBE_MASK 0
#endif
#ifndef PROBE_SP
#define PROBE_SP 1
#endif
#define PROBE_REPS(k) ((((PROBE_MASK) >> (k)) & 1) + 1)
#ifndef MK_ONE_LAUNCH
#define MK_ONE_LAUNCH 1
#endif

#define DM 2048
#define NB 4
#define SEQ 4096
#define CTXL 256
#define BW 512
#define NLAT 16384
#define NCTX 1024
#define NTOK 17408
#define IN_W 13856
#define LDP 14080
#define HY_OFF 0
#define ML_OFF 1536
#define S5_OFF 3600
#define SSD_OFF 4112
#define GATE_OFF 5664
#define NEXP 16
#define DEXP 1536
#define MOE_ROWS 2176
#define MOE_PAD 2304
#define NTHR 512
#define LDS_BYTES 147456
#define LAS __attribute__((address_space(3)))

typedef unsigned short bf16_t;
typedef short bf16x8 __attribute__((ext_vector_type(8)));
typedef float f32x4 __attribute__((ext_vector_type(4)));
typedef unsigned u32x4 __attribute__((ext_vector_type(4)));
typedef unsigned u32x2 __attribute__((ext_vector_type(2)));

#define XB_TMO      128
#define XB_XCNT(j)  (256  + 64 * (j))
#define XB_XSUB(j)  (1280 + 64 * (j))
#define XB_XGEN(j)  (2304 + 64 * (j))
#define XB_TOP      3328
#define XB_TOPGEN   3392
#define XCD_BAR_WORDS 3456
#define XB_SPIN_CAP (1u << 18)
__device__ __forceinline__ unsigned xb_ld(unsigned* p)              { return __hip_atomic_load(p, __ATOMIC_RELAXED, __HIP_MEMORY_SCOPE_AGENT); }
__device__ __forceinline__ unsigned xb_add(unsigned* p, unsigned v) { return __hip_atomic_fetch_add(p, v, __ATOMIC_RELAXED, __HIP_MEMORY_SCOPE_AGENT); }
__device__ __forceinline__ unsigned xb_xcc_id() { return (unsigned)__builtin_amdgcn_s_getreg((3 << 11) | 20) & 0xFu; }
#define XB_SPIN(cond, bar) do { unsigned _sp = 0; while (cond) { __builtin_amdgcn_s_sleep(1); \
    if ((++_sp & 255u) == 0u) { if (xb_ld(&(bar)[XB_TMO])) break; if (_sp > XB_SPIN_CAP) { atomicAdd(&(bar)[XB_TMO], 1u); break; } } } } while (0)
struct XcdBarrier { unsigned* bar; unsigned x; volatile LAS unsigned* st; };
__device__ __forceinline__ XcdBarrier xcd_barrier_post(unsigned* bar, volatile LAS unsigned* st) {
    XcdBarrier b; b.bar = bar; b.x = xb_xcc_id(); b.st = st;
    if (threadIdx.x == 0) (void)xb_add(&bar[XB_XCNT(b.x)], 1u);
    return b;
}
__device__ __forceinline__ void xcd_barrier_complete(unsigned* bar, unsigned x, unsigned& nloc, unsigned& nx) {
    const unsigned G = gridDim.x * gridDim.y * gridDim.z;
    unsigned sum, cnt, mine, sp = 0u;
    for (;;) {
        sum = 0u; cnt = 0u; mine = 0u;
#pragma unroll
        for (unsigned j = 0; j < 16; ++j) { const unsigned c = xb_ld(&bar[XB_XCNT(j)]); sum += c; cnt += (c > 0u) ? 1u : 0u; mine = (j == x) ? c : mine; }
        if (sum == G) break;
        __builtin_amdgcn_s_sleep(1);
        if ((++sp & 255u) == 0u) { if (xb_ld(&bar[XB_TMO])) break; if (sp > XB_SPIN_CAP) { atomicAdd(&bar[XB_TMO], 1u); break; } }
    }
    nloc = mine > 0u ? mine : 1u; nx = cnt > 0u ? cnt : 1u;
}
__device__ __forceinline__ void xcd_barrier(const XcdBarrier& b) {
    asm volatile("s_waitcnt vmcnt(0)" ::: "memory");
    __syncthreads();
    if (threadIdx.x == 0) {
        unsigned* bar = b.bar;
        __builtin_amdgcn_s_waitcnt(0);
        unsigned nloc = b.st[0], nx = b.st[1];
        if (nloc == 0u) { xcd_barrier_complete(bar, b.x, nloc, nx); b.st[0] = nloc; b.st[1] = nx; }
        const unsigned old = xb_add(&bar[XB_XSUB(b.x)], 1u);
        const unsigned gen = old / nloc;
        if (old + 1u == (gen + 1u) * nloc) {
            __builtin_amdgcn_fence(__ATOMIC_RELEASE, "agent");
            asm volatile("s_waitcnt vmcnt(0)" ::: "memory");
            const unsigned og = xb_add(&bar[XB_TOP], 1u);
            const unsigned tg = og / nx;
            if (og + 1u == (tg + 1u) * nx) xb_add(&bar[XB_TOPGEN], 1u);
            else XB_SPIN(xb_ld(&bar[XB_TOPGEN]) == tg, bar);
            __builtin_amdgcn_fence(__ATOMIC_ACQUIRE, "agent");
            xb_add(&bar[XB_XGEN(b.x)], 1u);
            asm volatile("s_waitcnt vmcnt(0)" ::: "memory");
        } else {
            XB_SPIN(xb_ld(&bar[XB_XGEN(b.x)]) == gen, bar);
            __builtin_amdgcn_fence(__ATOMIC_ACQUIRE, "agent");
            asm volatile("s_waitcnt vmcnt(0)" ::: "memory");
        }
    }
    __syncthreads();
}

__device__ __forceinline__ unsigned short f2bf(float f) { unsigned u = __float_as_uint(f); u += 0x7FFFu + ((u >> 16) & 1u); return (unsigned short)(u >> 16); }
__device__ __forceinline__ float bf2f(unsigned short b) { return __uint_as_float(((unsigned)b) << 16); }
__device__ __forceinline__ unsigned pk2(float lo, float hi) { unsigned r; asm("v_cvt_pk_bf16_f32 %0, %1, %2" : "=v"(r) : "v"(lo), "v"(hi)); return r; }
__device__ __forceinline__ float sigmoidf_(float x) { return 1.0f / (1.0f + expf(-x)); }
__device__ __forceinline__ float siluf_(float x) { return x / (1.0f + expf(-x)); }
__device__ __forceinline__ float wave_sum(float v) {
#pragma unroll
    for (int o = 32; o >= 1; o >>= 1) v += __shfl_xor(v, o);
    return v;
}
__device__ __forceinline__ const float* uptr(const float* p) { const unsigned long long v = (unsigned long long)p;
    const unsigned lo = __builtin_amdgcn_readfirstlane((unsigned)v), hi = __builtin_amdgcn_readfirstlane((unsigned)(v >> 32)); return (const float*)(((unsigned long long)hi << 32) | lo); }
#define PT(k) uptr(ptab[k])
__device__ __forceinline__ int step_tok(int b, int dir, int i) {
    if (i < CTXL) { const int tt = dir ? (CTXL - 1 - i) : i; return NLAT + b * CTXL + tt; }
    const int j = i - CTXL; const int tt = dir ? (SEQ - 1 - j) : j; return b * SEQ + tt;
}
__device__ __forceinline__ void unpack8(const u32x4 w, float (&f)[8]) {
    f[0] = __uint_as_float(w.x << 16); f[1] = __uint_as_float(w.x & 0xFFFF0000u); f[2] = __uint_as_float(w.y << 16); f[3] = __uint_as_float(w.y & 0xFFFF0000u);
    f[4] = __uint_as_float(w.z << 16); f[5] = __uint_as_float(w.z & 0xFFFF0000u); f[6] = __uint_as_float(w.w << 16); f[7] = __uint_as_float(w.w & 0xFFFF0000u);
}

namespace pg8 {
constexpr int BM = 256, BK = 64, HALF = 128, HTB = HALF * BK * 2, STAGE_BYTES = 8 * HTB, NXCD = 8, WGM = 8;
__host__ __device__ __forceinline__ int lds_byte(int r, int c) { const int st = (r >> 4) * 2 + (c >> 5), rr = r & 15, cc = c & 31, ob = rr * 64 + cc * 2; return st * 1024 + (ob ^ (((ob >> 9) & 1) << 5)); }
__host__ __device__ __forceinline__ void stage_rc(int b, int& R, int& C) { const int st = b / 1024, sb = b % 1024, swz = sb ^ (((sb >> 9) & 1) << 5); R = (st >> 1) * 16 + swz / 64; C = (st & 1) * 32 + (swz % 64) / 2; }
__host__ __device__ __forceinline__ int perm32(int rho) { const int n = rho >> 4, i = rho & 15; return 8 * (i >> 2) + 4 * n + (i & 3); }
struct Unit { int pm, pn, z, k; long long ao, bo; };
struct Gemm { const bf16_t* A; const bf16_t* Bt; int lda, ldb, K; };

__device__ __forceinline__ void tile_of(int wgid, int nM, int nN, int& pm, int& pn) {
    const int nwg = nM * nN; { const int q = nwg / NXCD, r = nwg % NXCD, xcd = wgid % NXCD, off = wgid / NXCD; wgid = (xcd < r ? xcd * (q + 1) : r * (q + 1) + (xcd - r) * q) + off; }
    const int nig = WGM * nN, gid = wgid / nig, fm = gid * WGM, gsz = (nM - fm) < WGM ? (nM - fm) : WGM;
    pm = fm + ((wgid % nig) % gsz); pn = (wgid % nig) / gsz;
}
struct SchedStd {
    int nM, nN, G, c, lda, ldb;
    __device__ __forceinline__ bool next(int i, Unit& u) const { const long L = (long)i * G + c; if (L >= (long)nM * nN) return false; tile_of((int)L, nM, nN, u.pm, u.pn); u.z = 0; u.k = 0;
        u.ao = (long long)u.pm * BM * lda * 2; u.bo = (long long)u.pn * BM * ldb * 2; return true; }
    __device__ __forceinline__ void a_ready(const Unit&) const {}
    __device__ __forceinline__ void done(const Unit&) const {}
};
struct SchedBranch {
    int nM, nN, G, c;
    __device__ __forceinline__ bool next(int i, Unit& u) const { const long L = (long)(i >> 2) * G + c; if (L >= (long)nM * nN) return false; tile_of((int)L, nM, nN, u.pm, u.pn); u.z = 0; u.k = i & 3;
        u.ao = ((long long)u.pm * BM * DM + u.k * BW) * 2; u.bo = ((long long)u.k * DM + u.pn * BM) * BW * 2; return true; }
    __device__ __forceinline__ void a_ready(const Unit&) const {}
    __device__ __forceinline__ void done(const Unit&) const {}
};
struct SchedMoe {
    int nPm, nPn, G, c, lda, ldb, nBrows;
    __device__ __forceinline__ bool next(int i, Unit& u) const { const long L = (long)i * G + c; const int per = nPm * nPn; if (L >= (long)NEXP * per) return false; const int e = (int)(L / per), rem = (int)(L % per);
        u.z = e; u.k = 0; u.pm = rem % nPm; u.pn = rem / nPm; u.ao = ((long long)e * MOE_PAD + u.pm * BM) * lda * 2; u.bo = ((long long)e * nBrows + u.pn * BM) * ldb * 2; return true; }
    __device__ __forceinline__ void a_ready(const Unit&) const {}
    __device__ __forceinline__ void done(const Unit&) const {}
};

typedef f32x4 Acc[2][2][4][2];
template <class Epi, class Sched>
__device__ __forceinline__ void gemm_phase(LAS unsigned char* lds, const Gemm g, const Sched& S, const Epi& E) {
    int tid = threadIdx.x; asm volatile("" : "+v"(tid));
    const int wid = __builtin_amdgcn_readfirstlane(tid >> 6), lane = tid & 63, wr = wid >> 2, wc = wid & 3, fr = lane & 15, fq = lane >> 4;
    const int K = g.K, nt = K / BK;
    unsigned voffA[2], voffB[2];
#pragma unroll
    for (int i = 0; i < 2; ++i) { int R, C; stage_rc(tid * 16 + i * 8192, R, C); const int Rb = Epi::PERM ? ((R & ~31) + perm32(R & 31)) : R;
        voffA[i] = (unsigned)(R * g.lda + C) * 2u; voffB[i] = (unsigned)(Rb * g.ldb + C) * 2u; }
    const size_t kstep = (size_t)(BK * 2);
    const size_t hstepA = (size_t)HALF * g.lda * 2, hstepB = (size_t)HALF * g.ldb * 2;
    const unsigned ldsw = (unsigned)wid * 1024u;
    const int aoff = lds_byte(wr * 64 + fr, fq * 8), boff = lds_byte(wc * 32 + fr, fq * 8);
#define PG8_SA(b, h) (((b) * 2 + (h)) * HTB)
#define PG8_SB(b, h) ((4 + (b) * 2 + (h)) * HTB)
#define PG8_STAGE(bufoff, gbase, voff) do { _Pragma("unroll") for (int _i = 0; _i < 2; ++_i) \
        __builtin_amdgcn_global_load_lds((const unsigned*)((const char*)(gbase) + (voff)[_i]), (LAS unsigned*)(lds + (bufoff) + ldsw + _i * 8192), 16, 0, 0); } while (0)
#define PG8_LDA(dst, b, h) do { _Pragma("unroll") for (int m = 0; m < 4; ++m) _Pragma("unroll") for (int k = 0; k < 2; ++k) dst[m][k] = *(const LAS bf16x8*)(lds + PG8_SA(b, h) + aoff + m * 2048 + k * 1024); } while (0)
#define PG8_LDB(dst, b, h) do { _Pragma("unroll") for (int n = 0; n < 2; ++n) _Pragma("unroll") for (int k = 0; k < 2; ++k) dst[n][k] = *(const LAS bf16x8*)(lds + PG8_SB(b, h) + boff + n * 2048 + k * 1024); } while (0)
#define PG8_MMA(ai, bj, At, Bt) do { __builtin_amdgcn_s_setprio(1); _Pragma("unroll") for (int m = 0; m < 4; ++m) _Pragma("unroll") for (int n = 0; n < 2; ++n) _Pragma("unroll") for (int k = 0; k < 2; ++k) \
        acc[ai][bj][m][n] = __builtin_amdgcn_mfma_f32_16x16x32_bf16(Bt[n][k], At[m][k], acc[ai][bj][m][n], 0, 0, 0); __builtin_amdgcn_s_setprio(0); } while (0)
#define PG8_WAIT_V(n) asm volatile("s_waitcnt vmcnt(" #n ")" ::: "memory")
#define PG8_WAIT_L(n) asm volatile("s_waitcnt lgkmcnt(" #n ")" ::: "memory")
#define PG8_BAR __builtin_amdgcn_s_barrier()
#define PG8_SCHED __builtin_amdgcn_sched_barrier(0)
    Unit cur, nxt; int ui = 0;
    if (!S.next(0, cur)) return;
    Acc acc;
#pragma unroll
    for (int a = 0; a < 2; ++a)
#pragma unroll
        for (int b = 0; b < 2; ++b)
#pragma unroll
            for (int m = 0; m < 4; ++m)
#pragma unroll
                for (int n = 0; n < 2; ++n) acc[a][b][m][n] = (f32x4){0.f, 0.f, 0.f, 0.f};
    bf16x8 At[4][2], B0[2][2], B1[2][2];
    const char* cA = (const char*)g.A + cur.ao; const char* cB = (const char*)g.Bt + cur.bo;
    S.a_ready(cur);
    PG8_STAGE(PG8_SB(0, 0), cB, voffB); PG8_STAGE(PG8_SA(0, 0), cA, voffA); PG8_STAGE(PG8_SB(0, 1), cB + hstepB, voffB); PG8_STAGE(PG8_SA(0, 1), cA + hstepA, voffA);
    if (wr == 1) PG8_BAR;
    PG8_WAIT_V(4); PG8_BAR;
    PG8_STAGE(PG8_SB(1, 0), cB + kstep, voffB); PG8_STAGE(PG8_SA(1, 0), cA + kstep, voffA); PG8_STAGE(PG8_SB(1, 1), cB + hstepB + kstep, voffB);
    PG8_WAIT_V(6); PG8_BAR;
    for (;;) {
        const bool has_next = S.next(ui + 1, nxt);
        const char* nA = has_next ? (const char*)g.A + nxt.ao : cA; const char* nB = has_next ? (const char*)g.Bt + nxt.bo : cB;
        for (int t = 0; t < nt; t += 2) {
            const bool last = (t == nt - 2);
            const char* a1 = cA + (size_t)(t + 1) * kstep;
            const char* a2 = last ? nA : cA + (size_t)(t + 2) * kstep; const char* b2 = last ? nB : cB + (size_t)(t + 2) * kstep;
            const char* a3 = a2 + kstep; const char* b3 = b2 + kstep;
            if (last && has_next) S.a_ready(nxt);
            PG8_LDB(B0, 0, 0); PG8_SCHED; PG8_LDA(At, 0, 0); PG8_STAGE(PG8_SA(1, 1), a1 + hstepA, voffA);
            PG8_WAIT_L(8); PG8_BAR; PG8_WAIT_L(0); PG8_MMA(0, 0, At, B0); PG8_BAR; PG8_SCHED;
            PG8_LDB(B1, 0, 1); PG8_STAGE(PG8_SB(0, 0), b2, voffB);
            PG8_BAR; PG8_WAIT_L(0); PG8_MMA(0, 1, At, B1); PG8_BAR;
            PG8_LDA(At, 0, 1); PG8_STAGE(PG8_SA(0, 0), a2, voffA);
            PG8_BAR; PG8_WAIT_L(0); PG8_MMA(1, 0, At, B0); PG8_BAR; PG8_SCHED;
            PG8_STAGE(PG8_SB(0, 1), b2 + hstepB, voffB);
            PG8_WAIT_V(6); PG8_BAR; PG8_MMA(1, 1, At, B1); PG8_BAR;
            PG8_LDB(B0, 1, 0); PG8_SCHED; PG8_LDA(At, 1, 0); PG8_STAGE(PG8_SA(0, 1), a2 + hstepA, voffA);
            PG8_WAIT_L(8); PG8_BAR; PG8_WAIT_L(0); PG8_MMA(0, 0, At, B0); PG8_BAR; PG8_SCHED;
            PG8_LDB(B1, 1, 1); PG8_STAGE(PG8_SB(1, 0), b3, voffB);
            PG8_BAR; PG8_WAIT_L(0); PG8_MMA(0, 1, At, B1); PG8_BAR;
            PG8_LDA(At, 1, 1); PG8_STAGE(PG8_SA(1, 0), a3, voffA);
            PG8_BAR; PG8_WAIT_L(0); PG8_MMA(1, 0, At, B0); PG8_BAR; PG8_SCHED;
            PG8_STAGE(PG8_SB(1, 1), b3 + hstepB, voffB);
            PG8_WAIT_V(6); PG8_BAR; PG8_MMA(1, 1, At, B1); PG8_BAR;
        }
        const bool keep = E(acc, cur, wr, wc, fr, fq); S.done(cur);
        if (!has_next) break;
        if (!keep) {
#pragma unroll
        for (int a = 0; a < 2; ++a)
#pragma unroll
            for (int b = 0; b < 2; ++b)
#pragma unroll
                for (int m = 0; m < 4; ++m)
#pragma unroll
                    for (int n = 0; n < 2; ++n) acc[a][b][m][n] = (f32x4){0.f, 0.f, 0.f, 0.f};
        }
        cur = nxt; cA = nA; cB = nB; ++ui;
    }
    PG8_WAIT_V(0);
    if (wr == 0) PG8_BAR;
    PG8_BAR;
#undef PG8_SA
#undef PG8_SB
#undef PG8_STAGE
#undef PG8_LDA
#undef PG8_LDB
#undef PG8_MMA
#undef PG8_WAIT_V
#undef PG8_WAIT_L
#undef PG8_BAR
#undef PG8_SCHED
}

struct EpiBf16Store {
    static constexpr bool PERM = true;
    bf16_t* O; int ldc;
    __device__ __forceinline__ bool operator()(Acc& acc, const Unit& u, int wr, int wc, int fr, int fq) const {
        const int row0 = u.pm * BM + wr * 64 + fr, col0 = u.pn * BM + wc * 32 + 8 * fq;
#pragma unroll
        for (int ai = 0; ai < 2; ++ai)
#pragma unroll
            for (int m = 0; m < 4; ++m) { bf16_t* rowp = O + (size_t)(row0 + ai * HALF + m * 16) * ldc + col0;
#pragma unroll
                for (int bj = 0; bj < 2; ++bj) { const f32x4 v0 = acc[ai][bj][m][0], v1 = acc[ai][bj][m][1];
                    u32x4 w; w.x = pk2(v0[0], v0[1]); w.y = pk2(v0[2], v0[3]); w.z = pk2(v1[0], v1[1]); w.w = pk2(v1[2], v1[3]);
                    *(u32x4*)(rowp + bj * HALF) = w; } }
        return false;
    }
};
struct EpiWin {
    static constexpr bool PERM = true;
    bf16_t* O; int ldc;
    __device__ __forceinline__ bool operator()(Acc& acc, const Unit& u, int wr, int wc, int fr, int fq) const {
        const int row0 = u.pm * BM + wr * 64 + fr, col0 = u.pn * BM + wc * 32 + 8 * fq;
#pragma unroll
        for (int bj = 0; bj < 2; ++bj) { const bool gate = (col0 + bj * HALF) >= GATE_OFF;
#pragma unroll
            for (int ai = 0; ai < 2; ++ai)
#pragma unroll
                for (int m = 0; m < 4; ++m) { f32x4 v0 = acc[ai][bj][m][0], v1 = acc[ai][bj][m][1];
                    if (gate) {
#pragma unroll
                        for (int j = 0; j < 4; ++j) { v0[j] = __builtin_amdgcn_rcpf(1.0f + __expf(-v0[j])); v1[j] = __builtin_amdgcn_rcpf(1.0f + __expf(-v1[j])); } }
                    u32x4 w; w.x = pk2(v0[0], v0[1]); w.y = pk2(v0[2], v0[3]); w.z = pk2(v1[0], v1[1]); w.w = pk2(v1[2], v1[3]);
                    *(u32x4*)(O + (size_t)(row0 + ai * HALF + m * 16) * ldc + col0 + bj * HALF) = w; } }
        return false;
    }
};
struct EpiNone { static constexpr bool PERM = true;
    __device__ __forceinline__ bool operator()(Acc& acc, const Unit&, int, int, int, int) const {
#pragma unroll
        for (int a = 0; a < 2; ++a)
#pragma unroll
            for (int b = 0; b < 2; ++b)
#pragma unroll
                for (int m = 0; m < 4; ++m)
#pragma unroll
                    for (int n = 0; n < 2; ++n) asm volatile("" :: "v"(acc[a][b][m][n]));
        return false; } };
struct EpiGlu {
    static constexpr bool PERM = true;
    const bf16_t* GG; const float* bias; bf16_t* Y4;
    __device__ __forceinline__ bool operator()(Acc& acc, const Unit& u, int wr, int wc, int fr, int fq) const {
        const int row0 = u.pm * BM + wr * 64 + fr, col0 = u.pn * BM + wc * 32 + 8 * fq;
#pragma unroll
        for (int bj = 0; bj < 2; ++bj) { const int col = col0 + bj * HALF; const f32x4 b0 = *(const f32x4*)(bias + col), b1 = *(const f32x4*)(bias + col + 4);
            u32x4 gq[2][4];
#pragma unroll
            for (int ai = 0; ai < 2; ++ai)
#pragma unroll
                for (int m = 0; m < 4; ++m) gq[ai][m] = *(const u32x4*)(GG + (size_t)(row0 + ai * HALF + m * 16) * BW + col);
#pragma unroll
            for (int ai = 0; ai < 2; ++ai)
#pragma unroll
                for (int m = 0; m < 4; ++m) { const size_t row = (size_t)(row0 + ai * HALF + m * 16);
                    float gg[8]; unpack8(gq[ai][m], gg);
                    const f32x4 v0 = acc[ai][bj][m][0] + b0, v1 = acc[ai][bj][m][1] + b1;
                    u32x4 w; w.x = pk2(gg[0] * sigmoidf_(v0[0]), gg[1] * sigmoidf_(v0[1])); w.y = pk2(gg[2] * sigmoidf_(v0[2]), gg[3] * sigmoidf_(v0[3]));
                    w.z = pk2(gg[4] * sigmoidf_(v1[0]), gg[5] * sigmoidf_(v1[1])); w.w = pk2(gg[6] * sigmoidf_(v1[2]), gg[7] * sigmoidf_(v1[3]));
                    *(u32x4*)(Y4 + row * DM + 1024 + col) = w; } }
        return false;
    }
};
struct EpiBranch {
    static constexpr bool PERM = true;
    const bf16_t* P; bf16_t* ACCb;
    __device__ __forceinline__ bool operator()(Acc& acc, const Unit& u, int wr, int wc, int fr, int fq) const {
        const int row0 = u.pm * BM + wr * 64 + fr, col0 = u.pn * BM + wc * 32 + 8 * fq; const int k = u.k;
        const bf16_t* gbase = P + (size_t)row0 * LDP + GATE_OFF + k * DM + col0;
        if (k < 3) {
#pragma unroll
            for (int ai = 0; ai < 2; ++ai) {
                u32x4 ga[8], gb[8];
#pragma unroll
                for (int m = 0; m < 4; ++m)
#pragma unroll
                    for (int bj = 0; bj < 2; ++bj) { const bf16_t* p = gbase + (size_t)(ai * HALF + m * 16) * LDP + bj * HALF; ga[m * 2 + bj] = *(const u32x4*)p; gb[m * 2 + bj] = *(const u32x4*)(p + DM); }
#pragma unroll
                for (int m = 0; m < 4; ++m)
#pragma unroll
                    for (int bj = 0; bj < 2; ++bj) { float g0[8], g1[8]; unpack8(ga[m * 2 + bj], g0); unpack8(gb[m * 2 + bj], g1);
                        float s[8];
#pragma unroll
                        for (int j = 0; j < 8; ++j) s[j] = g0[j] * __builtin_amdgcn_rcpf(g1[j]);
                        f32x4 v0 = acc[ai][bj][m][0], v1 = acc[ai][bj][m][1];
                        v0[0] *= s[0]; v0[1] *= s[1]; v0[2] *= s[2]; v0[3] *= s[3]; v1[0] *= s[4]; v1[1] *= s[5]; v1[2] *= s[6]; v1[3] *= s[7];
                        acc[ai][bj][m][0] = v0; acc[ai][bj][m][1] = v1; } }
            return true;
        }
#pragma unroll
        for (int ai = 0; ai < 2; ++ai) {
            u32x4 ga[8];
#pragma unroll
            for (int m = 0; m < 4; ++m)
#pragma unroll
                for (int bj = 0; bj < 2; ++bj) ga[m * 2 + bj] = *(const u32x4*)(gbase + (size_t)(ai * HALF + m * 16) * LDP + bj * HALF);
#pragma unroll
            for (int m = 0; m < 4; ++m)
#pragma unroll
                for (int bj = 0; bj < 2; ++bj) { float s[8]; unpack8(ga[m * 2 + bj], s);
                    f32x4 v0 = acc[ai][bj][m][0], v1 = acc[ai][bj][m][1];
                    v0[0] *= s[0]; v0[1] *= s[1]; v0[2] *= s[2]; v0[3] *= s[3]; v1[0] *= s[4]; v1[1] *= s[5]; v1[2] *= s[6]; v1[3] *= s[7];
                    u32x4 w; w.x = pk2(v0[0], v0[1]); w.y = pk2(v0[2], v0[3]); w.z = pk2(v1[0], v1[1]); w.w = pk2(v1[2], v1[3]);
                    *(u32x4*)(ACCb + (size_t)(row0 + ai * HALF + m * 16) * DM + col0 + bj * HALF) = w; } }
        return false;
    }
};
struct EpiResid {
    static constexpr bool PERM = false;
    float* XS; const float* srcLat; const float* srcCtx; const float* MODl; int gidx;
    __device__ __forceinline__ bool operator()(Acc& acc, const Unit& u, int wr, int wc, int fr, int fq) const {
        const int row0 = u.pm * BM + wr * 64 + fr, col0 = u.pn * BM + wc * 32 + 4 * fq;
        const int r = (u.pm * BM) < NLAT ? (u.pm * BM) / SEQ : 4;
        const float* src = (u.pm * BM) < NLAT ? srcLat : srcCtx;
        const float* mg = MODl + (size_t)(r * 6 + gidx) * DM;
#pragma unroll
        for (int bj = 0; bj < 2; ++bj) {
            f32x4 gm[2], xs[2][2][4];
#pragma unroll
            for (int n = 0; n < 2; ++n) { const int col = col0 + bj * HALF + n * 16; gm[n] = *(const f32x4*)(mg + col);
#pragma unroll
                for (int ai = 0; ai < 2; ++ai)
#pragma unroll
                    for (int m = 0; m < 4; ++m) xs[n][ai][m] = *(const f32x4*)(src + (size_t)(row0 + ai * HALF + m * 16) * DM + col); }
#pragma unroll
            for (int n = 0; n < 2; ++n) { const int col = col0 + bj * HALF + n * 16;
#pragma unroll
                for (int ai = 0; ai < 2; ++ai)
#pragma unroll
                    for (int m = 0; m < 4; ++m) *(f32x4*)(XS + (size_t)(row0 + ai * HALF + m * 16) * DM + col) = xs[n][ai][m] + gm[n] * acc[ai][bj][m][n]; } }
        return false;
    }
};
struct EpiMoe1 {
    static constexpr bool PERM = true;
    bf16_t* HID;
    __device__ __forceinline__ bool operator()(Acc& acc, const Unit& u, int wr, int wc, int fr, int fq) const {
        const size_t row0 = (size_t)u.z * MOE_PAD + u.pm * BM + wr * 64 + fr; const int col0 = u.pn * HALF + wc * 32 + 8 * fq;
#pragma unroll
        for (int ai = 0; ai < 2; ++ai)
#pragma unroll
            for (int m = 0; m < 4; ++m) { const f32x4 g0 = acc[ai][0][m][0], g1 = acc[ai][0][m][1], u0 = acc[ai][1][m][0], u1 = acc[ai][1][m][1];
                float h[8];
#pragma unroll
                for (int j = 0; j < 4; ++j) { h[j] = g0[j] * __builtin_amdgcn_rcpf(1.0f + __expf(-g0[j])) * u0[j]; h[4 + j] = g1[j] * __builtin_amdgcn_rcpf(1.0f + __expf(-g1[j])) * u1[j]; }
                u32x4 w; w.x = pk2(h[0], h[1]); w.y = pk2(h[2], h[3]); w.z = pk2(h[4], h[5]); w.w = pk2(h[6], h[7]);
                *(u32x4*)(HID + (row0 + ai * HALF + m * 16) * DEXP + col0) = w; }
        return false;
    }
};
struct EpiMoeY {
    static constexpr bool PERM = true;
    bf16_t* O;
    __device__ __forceinline__ bool operator()(Acc& acc, const Unit& u, int wr, int wc, int fr, int fq) const {
        const size_t row0 = (size_t)u.z * MOE_PAD + u.pm * BM + wr * 64 + fr; const int col0 = u.pn * BM + wc * 32 + 8 * fq;
#pragma unroll
        for (int ai = 0; ai < 2; ++ai)
#pragma unroll
            for (int m = 0; m < 4; ++m) { bf16_t* rowp = O + (row0 + ai * HALF + m * 16) * DM + col0;
#pragma unroll
                for (int bj = 0; bj < 2; ++bj) { const f32x4 v0 = acc[ai][bj][m][0], v1 = acc[ai][bj][m][1];
                    u32x4 w; w.x = pk2(v0[0], v0[1]); w.y = pk2(v0[2], v0[3]); w.z = pk2(v1[0], v1[1]); w.w = pk2(v1[2], v1[3]);
                    *(u32x4*)(rowp + bj * HALF) = w; } }
        return false;
    }
};

struct SchedS5a {
    int c;
    __device__ __forceinline__ bool next(int i, Unit& u) const { if (i > 0 || c >= 64) return false; u.z = c >> 1; u.pm = c & 1; u.pn = 0; u.k = 0;
        u.ao = ((long long)u.z * 512 + u.pm * BM) * 768 * 2; u.bo = (long long)u.z * 256 * 512 * 2; return true; }
    __device__ __forceinline__ void a_ready(const Unit&) const {}
    __device__ __forceinline__ void done(const Unit&) const {}
};
struct SchedS5b {
    int c;
    __device__ __forceinline__ bool next(int i, Unit& u) const { if (i > 0 || c >= 128) return false; u.z = c >> 2; u.pm = (c >> 1) & 1; u.pn = c & 1; u.k = 0;
        u.ao = ((long long)u.z * 512 + u.pm * BM) * 768 * 2; u.bo = ((long long)u.z * 512 + u.pn * BM) * 768 * 2; return true; }
    __device__ __forceinline__ void a_ready(const Unit&) const {}
    __device__ __forceinline__ void done(const Unit&) const {}
};
struct EpiXloc {
    static constexpr bool PERM = false;
    float* XL;
    __device__ __forceinline__ bool operator()(Acc& acc, const Unit& u, int wr, int wc, int fr, int fq) const {
        const int row0 = u.pm * BM + wr * 64 + fr, col0 = wc * 32 + 4 * fq; float* base = XL + (size_t)u.z * 512 * 256;
#pragma unroll
        for (int ai = 0; ai < 2; ++ai)
#pragma unroll
            for (int m = 0; m < 4; ++m) { float* rowp = base + (size_t)(row0 + ai * HALF + m * 16) * 256 + col0;
#pragma unroll
                for (int bj = 0; bj < 2; ++bj)
#pragma unroll
                    for (int n = 0; n < 2; ++n) *(f32x4*)(rowp + bj * HALF + n * 16) = acc[ai][bj][m][n]; }
        return false;
    }
};
struct EpiS5Out {
    static constexpr bool PERM = true;
    const bf16_t* P; const float* dskip; bf16_t* GG;
    __device__ __forceinline__ bool operator()(Acc& acc, const Unit& u, int wr, int wc, int fr, int fq) const {
        const int row0 = u.pm * BM + wr * 64 + fr, col0 = u.pn * BM + wc * 32 + 8 * fq; const int g = u.z;
#pragma unroll
        for (int bj = 0; bj < 2; ++bj) { const int col = col0 + bj * HALF; const int t = col >> 4, c0 = col & 15;
            const f32x4 d0 = *(const f32x4*)(dskip + g * 16 + c0), d1 = *(const f32x4*)(dskip + g * 16 + c0 + 4);
            u32x4 uq[2][4];
#pragma unroll
            for (int ai = 0; ai < 2; ++ai)
#pragma unroll
                for (int m = 0; m < 4; ++m) uq[ai][m] = *(const u32x4*)(P + ((size_t)(row0 + ai * HALF + m * 16) * 32 + t) * LDP + S5_OFF + g * 16 + c0);
#pragma unroll
            for (int ai = 0; ai < 2; ++ai)
#pragma unroll
                for (int m = 0; m < 4; ++m) { const size_t tok = (size_t)(row0 + ai * HALF + m * 16) * 32 + t;
                    float uu[8]; unpack8(uq[ai][m], uu);
                    const f32x4 v0 = acc[ai][bj][m][0], v1 = acc[ai][bj][m][1];
                    float y[8] = {v0[0] + d0[0] * uu[0], v0[1] + d0[1] * uu[1], v0[2] + d0[2] * uu[2], v0[3] + d0[3] * uu[3], v1[0] + d1[0] * uu[4], v1[1] + d1[1] * uu[5], v1[2] + d1[2] * uu[6], v1[3] + d1[3] * uu[7]};
#pragma unroll
                    for (int j = 0; j < 8; ++j) y[j] = 0.5f * y[j] * (1.0f + tanhf(0.7978845608028654f * (y[j] + 0.044715f * y[j] * y[j] * y[j])));
                    u32x4 w; w.x = pk2(y[0], y[1]); w.y = pk2(y[2], y[3]); w.z = pk2(y[4], y[5]); w.w = pk2(y[6], y[7]);
                    *(u32x4*)(GG + tok * BW + g * 16 + c0) = w; } }
        return false;
    }
};
}


__device__ __forceinline__ float wave_scan_incl(float v, int lane) {
#pragma unroll
    for (int o = 1; o < 64; o <<= 1) { const float t = __shfl_up(v, o); if (lane >= o) v += t; }
    return v;
}
__device__ __forceinline__ float wave_scanmax_incl(float v, int lane) {
#pragma unroll
    for (int o = 1; o < 64; o <<= 1) { const float t = __shfl_up(v, o); if (lane >= o) v = fmaxf(v, t); }
    return v;
}
__device__ __forceinline__ float wave_max(float v) {
#pragma unroll
    for (int o = 32; o >= 1; o >>= 1) v = fmaxf(v, __shfl_xor(v, o));
    return v;
}
__device__ __forceinline__ void unpack8h(const u32x4 w, bf16_t (&h)[8]) {
    h[0] = (bf16_t)(w.x & 0xFFFFu); h[1] = (bf16_t)(w.x >> 16); h[2] = (bf16_t)(w.y & 0xFFFFu); h[3] = (bf16_t)(w.y >> 16);
    h[4] = (bf16_t)(w.z & 0xFFFFu); h[5] = (bf16_t)(w.z >> 16); h[6] = (bf16_t)(w.w & 0xFFFFu); h[7] = (bf16_t)(w.w >> 16);
}

__device__ __forceinline__ int tokblock_of(int b, int dir, int c) { if (c < 4) return 256 + b * 4 + (dir ? 3 - c : c); const int j = c - 4; return b * 64 + (dir ? 63 - j : j); }
__device__ __forceinline__ u32x4 rev8h(const u32x4 v) { u32x4 r; r.x = (v.w >> 16) | (v.w << 16); r.y = (v.z >> 16) | (v.z << 16); r.z = (v.y >> 16) | (v.y << 16); r.w = (v.x >> 16) | (v.x << 16); return r; }
__device__ __forceinline__ u32x4 scale8h(const u32x4 v, const float4 a, const float4 b) { float f[8]; unpack8(v, f); u32x4 r; r.x = pk2(f[0] * a.x, f[1] * a.y); r.y = pk2(f[2] * a.z, f[3] * a.w); r.z = pk2(f[4] * b.x, f[5] * b.y); r.w = pk2(f[6] * b.z, f[7] * b.w); return r; }
__device__ __forceinline__ float dot8h(const u32x4 v, const float4 a, const float4 b) { float f[8]; unpack8(v, f); return (f[0] * a.x + f[1] * a.y) + (f[2] * a.z + f[3] * a.w) + (f[4] * b.x + f[5] * b.y) + (f[6] * b.z + f[7] * b.w); }
#define ML_FRAG_LOAD(KF, VF, cc_) do { const int tb_ = tokblock_of(b, dir, (cc_)); const bf16_t* kb_ = KTg + ((size_t)tb_ * 512 + h * 128 + 32 * wd + r16) * 64 + q4 * 8; const bf16_t* vb_ = VTg + ((size_t)tb_ * 512 + h * 128 + 64 * half + 32 * we + r16) * 64 + q4 * 8; \
        _Pragma("unroll") for (int ks_ = 0; ks_ < 2; ++ks_) _Pragma("unroll") for (int j_ = 0; j_ < 2; ++j_) { VF[j_][ks_] = *(const u32x4*)(vb_ + (size_t)j_ * 16 * 64 + ks_ * 32); KF[j_][ks_] = *(const u32x4*)(kb_ + (size_t)j_ * 16 * 64 + ks_ * 32); } } while (0)
#define ML_CHUNK(c_, KF, VF, KFN, VFN) do { const int c = (c_); \
        if (c + 1 < 68) ML_FRAG_LOAD(KFN, VFN, c + 1);                        \
        const float dec = sDEC[c]; \
        {   bf16_t* cs = CST + (size_t)(chain * 68 + c) * 128 * 128; \
            _Pragma("unroll") for (int je = 0; je < 2; ++je) _Pragma("unroll") for (int jd = 0; jd < 2; ++jd) { const int e = 64 * half + 32 * we + 16 * je + r16, d0 = 32 * wd + 16 * jd + q4 * 4; \
                u32x2 pk; pk.x = pk2(acc[je][jd][0], acc[je][jd][1]); pk.y = pk2(acc[je][jd][2], acc[je][jd][3]); *(u32x2*)(cs + (size_t)e * 128 + d0) = pk; } \
            if (nown) { _Pragma("unroll") for (int jd = 0; jd < 2; ++jd) { float nv = npart[jd]; nv += __shfl_xor(nv, 16); nv += __shfl_xor(nv, 32); if (q4 == 0) NST[(size_t)(chain * 68 + c) * 128 + 32 * wd + 16 * jd + r16] = nv; } } } \
        bf16x8 vfr[2][2]; \
        _Pragma("unroll") for (int ks = 0; ks < 2; ++ks) { const float4 wa = *(const float4*)(sWS + c * 64 + ks * 32 + q4 * 8), wb = *(const float4*)(sWS + c * 64 + ks * 32 + q4 * 8 + 4); \
            _Pragma("unroll") for (int je = 0; je < 2; ++je) { const u32x4 sv = scale8h(VF[je][ks], wa, wb); vfr[je][ks] = *(const bf16x8*)&sv; } \
            if (nown) { _Pragma("unroll") for (int jd = 0; jd < 2; ++jd) npart[jd] = (ks == 0 ? dec * npart[jd] : npart[jd]) + dot8h(KF[jd][ks], wa, wb); } } \
        _Pragma("unroll") for (int je = 0; je < 2; ++je) _Pragma("unroll") for (int jd = 0; jd < 2; ++jd) acc[je][jd] = acc[je][jd] * dec; \
        _Pragma("unroll") for (int ks = 0; ks < 2; ++ks) _Pragma("unroll") for (int je = 0; je < 2; ++je) _Pragma("unroll") for (int jd = 0; jd < 2; ++jd) \
            acc[je][jd] = __builtin_amdgcn_mfma_f32_16x16x32_bf16(*(const bf16x8*)&KF[jd][ks], vfr[je][ks], acc[je][jd], 0, 0, 0); } while (0)
__device__ __forceinline__ void mlstm_state_pass(const int chain, const int half, const bf16_t* __restrict__ Pm, const bf16_t* __restrict__ KTg, const bf16_t* __restrict__ VTg, const float* __restrict__ gate_b,
                                                 bf16_t* __restrict__ CST, float* __restrict__ NST, float* __restrict__ MST, unsigned char* shm, const int tid) {
    const int dir = chain & 1, h = (chain >> 1) & 3, b = chain >> 3, lane = tid & 63, w = tid >> 6, we = w >> 2, wd = w & 3, q4 = lane >> 4, r16 = lane & 15;
    const bool nown = (half == 0) && (we == 0);
    float* sE = (float*)shm; float* sWS = sE + 68 * 64; float* sAL = sWS + 68 * 64; float* sBE = sAL + 68; float* sMO = sBE + 68; float* sDEC = sMO + 68; float* sMB = sDEC + 68;
    const float gbi = gate_b[(dir * 2 + 0) * 4 + h], gbf = gate_b[(dir * 2 + 1) * 4 + h];
    const int gcol_i = ML_OFF + 2048 + (dir * 2 + 0) * 4 + h, gcol_f = ML_OFF + 2048 + (dir * 2 + 1) * 4 + h;
    u32x4 kfA[2][2], vfA[2][2], kfB[2][2], vfB[2][2];
    ML_FRAG_LOAD(kfA, vfA, 0);
    __syncthreads();
    unsigned short gi_[9], gf_[9];
#pragma unroll
    for (int q = 0; q < 9; ++q) { const int c = min(w + 8 * q, 67); const size_t tokl = (size_t)step_tok(b, dir, c * 64 + lane); gi_[q] = Pm[tokl * LDP + gcol_i]; gf_[q] = Pm[tokl * LDP + gcol_f]; }
#pragma unroll
    for (int q = 0; q < 9; ++q) { const int c = w + 8 * q; if (c >= 68) break;
        const float ig = bf2f(gi_[q]) + gbi, fg = bf2f(gf_[q]) + gbf;
        const float lf = fminf(fg, 0.f) - log1pf(expf(-fabsf(fg)));
        const float bcs = wave_scan_incl(lf, lane); const float blast = __shfl(bcs, 63); const float ei = blast - bcs + ig; const float beta = wave_max(ei);
        sE[c * 64 + lane] = ei; if (lane == 0) { sAL[c] = blast; sBE[c] = beta; } }
    __syncthreads();
    if (tid == 0) { float m = 0.f; for (int c = 0; c < 68; ++c) { sMB[c] = m; const float mo = fmaxf(m + sAL[c], sBE[c]); sDEC[c] = expf(sAL[c] + m - mo); sMO[c] = mo; m = mo; } }
    __syncthreads();
    for (int idx = tid; idx < 68 * 64; idx += NTHR) { const int c = idx >> 6, i = idx & 63; sWS[c * 64 + (dir ? 63 - i : i)] = expf(sE[idx] - sMO[c]); }
    if (half == 0 && tid < 68) MST[chain * 68 + tid] = sMB[tid];
    __syncthreads();
    f32x4 acc[2][2];
#pragma unroll
    for (int je = 0; je < 2; ++je)
#pragma unroll
        for (int jd = 0; jd < 2; ++jd) acc[je][jd] = (f32x4){0.f, 0.f, 0.f, 0.f};
    float npart[2] = {0.f, 0.f};
    for (int c2 = 0; c2 < 68; c2 += 2) { ML_CHUNK(c2, kfA, vfA, kfB, vfB); ML_CHUNK(c2 + 1, kfB, vfB, kfA, vfA); }
    __syncthreads();
}
#undef ML_CHUNK
#undef ML_FRAG_LOAD
__device__ __forceinline__ void mlstm_out_item(const int chain, const int c, const bf16_t* __restrict__ Pm, const bf16_t* __restrict__ QKb, const bf16_t* __restrict__ VTg, const float* __restrict__ gate_b,
                                               const bf16_t* __restrict__ CST, const float* __restrict__ NST, const float* __restrict__ MST, float* __restrict__ Hout, unsigned char* shm, const int tid) {
    const int dir = chain & 1, h = (chain >> 1) & 3, b = chain >> 3, lane = tid & 63, w = tid >> 6;
    bf16_t* Qs = (bf16_t*)shm; bf16_t* Ks = (bf16_t*)(shm + 17408); bf16_t* VT = (bf16_t*)(shm + 34816); bf16_t* Cs = (bf16_t*)(shm + 53248); bf16_t* Ss = (bf16_t*)(shm + 88064);
    float* sc = (float*)(shm + 97280);
    __syncthreads();
#pragma unroll
    for (int i = 0; i < 2; ++i) { const int pid = tid + i * 512; const int s = pid >> 4, x0 = (pid & 15) * 8; const size_t toks = (size_t)step_tok(b, dir, c * 64 + s);
        *(u32x4*)(Qs + s * 136 + x0) = *(const u32x4*)(QKb + toks * 1024 + h * 128 + x0);
        *(u32x4*)(Ks + s * 136 + x0) = *(const u32x4*)(QKb + toks * 1024 + 512 + h * 128 + x0);
        { const int e = pid >> 3, o = pid & 7;
          const u32x4 vv = *(const u32x4*)(VTg + ((size_t)tokblock_of(b, dir, c) * 512 + h * 128 + e) * 64 + (dir ? 7 - o : o) * 8);
          *(u32x4*)(VT + e * 72 + o * 8) = dir ? rev8h(vv) : vv; } }
#pragma unroll
    for (int i = 0; i < 4; ++i) { const int pid = tid + i * 512; const int e = pid >> 4, x0 = (pid & 15) * 8;
        *(u32x4*)(Cs + e * 136 + x0) = *(const u32x4*)(CST + ((size_t)(chain * 68 + c) * 128 + e) * 128 + x0); }
    if (tid < 128) sc[384 + tid] = NST[(size_t)(chain * 68 + c) * 128 + tid];
    if (w == 0) {
        const float gbi = gate_b[(dir * 2 + 0) * 4 + h], gbf = gate_b[(dir * 2 + 1) * 4 + h];
        const size_t tokl = (size_t)step_tok(b, dir, c * 64 + lane);
        const float ig = bf2f(Pm[tokl * LDP + ML_OFF + 2048 + (dir * 2 + 0) * 4 + h]) + gbi;
        const float fg = bf2f(Pm[tokl * LDP + ML_OFF + 2048 + (dir * 2 + 1) * 4 + h]) + gbf;
        const float lf = fminf(fg, 0.f) - log1pf(expf(-fabsf(fg)));
        const float bcs = wave_scan_incl(lf, lane); const float gsv = ig - bcs; const float pm = wave_scanmax_incl(gsv, lane);
        const float m_in = MST[chain * 68 + c]; const float mt = bcs + fmaxf(m_in, pm);
        sc[lane] = bcs; sc[64 + lane] = gsv; sc[128 + lane] = mt; sc[192 + lane] = expf(bcs + m_in - mt); sc[256 + lane] = expf(-mt);
    }
    __syncthreads();
    const int tt = w >> 1;
    {   f32x4 aS[2] = {(f32x4){0.f, 0.f, 0.f, 0.f}, (f32x4){0.f, 0.f, 0.f, 0.f}};
#pragma unroll
        for (int ks = 0; ks < 4; ++ks) { const bf16x8 af = *(const bf16x8*)(Qs + (16 * tt + (lane & 15)) * 136 + ks * 32 + (lane >> 4) * 8);
#pragma unroll
            for (int i = 0; i < 2; ++i) { const int st = (w & 1) * 2 + i; const bf16x8 bfr = *(const bf16x8*)(Ks + (16 * st + (lane & 15)) * 136 + ks * 32 + (lane >> 4) * 8);
                aS[i] = __builtin_amdgcn_mfma_f32_16x16x32_bf16(af, bfr, aS[i], 0, 0, 0); } }
        float rs[4] = {0.f, 0.f, 0.f, 0.f};
#pragma unroll
        for (int i = 0; i < 2; ++i) { const int s = 16 * ((w & 1) * 2 + i) + (lane & 15); const float gsv = sc[64 + s];
#pragma unroll
            for (int q = 0; q < 4; ++q) { const int t = 16 * tt + (lane >> 4) * 4 + q; const float val = (s <= t) ? aS[i][q] * expf(sc[t] + gsv - sc[128 + t]) : 0.f; Ss[t * 72 + s] = f2bf(val); rs[q] += val; } }
#pragma unroll
        for (int q = 0; q < 4; ++q) { float r = rs[q]; r += __shfl_xor(r, 1); r += __shfl_xor(r, 2); r += __shfl_xor(r, 4); r += __shfl_xor(r, 8);
            if ((lane & 15) == 0) sc[512 + (w & 1) * 64 + 16 * tt + (lane >> 4) * 4 + q] = r; }
        {   const int t = tid >> 3, part = tid & 7; float dot = 0.f;
#pragma unroll
            for (int j = 0; j < 16; ++j) dot += bf2f(Qs[t * 136 + part * 16 + j]) * sc[384 + part * 16 + j];
            dot += __shfl_xor(dot, 1); dot += __shfl_xor(dot, 2); dot += __shfl_xor(dot, 4);
            if (part == 0) sc[640 + t] = sc[192 + t] * dot; }
    }
    __syncthreads();
    {   f32x4 aN[4];
#pragma unroll
        for (int i = 0; i < 4; ++i) aN[i] = (f32x4){0.f, 0.f, 0.f, 0.f};
#pragma unroll
        for (int ks = 0; ks < 4; ++ks) { const bf16x8 af = *(const bf16x8*)(Qs + (16 * tt + (lane & 15)) * 136 + ks * 32 + (lane >> 4) * 8);
#pragma unroll
            for (int i = 0; i < 4; ++i) { const int et = (w & 1) * 4 + i; const bf16x8 bfr = *(const bf16x8*)(Cs + (16 * et + (lane & 15)) * 136 + ks * 32 + (lane >> 4) * 8);
                aN[i] = __builtin_amdgcn_mfma_f32_16x16x32_bf16(af, bfr, aN[i], 0, 0, 0); } }
#pragma unroll
        for (int q = 0; q < 4; ++q) { const float it = sc[192 + 16 * tt + (lane >> 4) * 4 + q];
#pragma unroll
            for (int i = 0; i < 4; ++i) aN[i][q] *= it; }
#pragma unroll
        for (int ks = 0; ks < 2; ++ks) { const bf16x8 af = *(const bf16x8*)(Ss + (16 * tt + (lane & 15)) * 72 + ks * 32 + (lane >> 4) * 8);
#pragma unroll
            for (int i = 0; i < 4; ++i) { const int et = (w & 1) * 4 + i; const bf16x8 bfr = *(const bf16x8*)(VT + (16 * et + (lane & 15)) * 72 + ks * 32 + (lane >> 4) * 8);
                aN[i] = __builtin_amdgcn_mfma_f32_16x16x32_bf16(af, bfr, aN[i], 0, 0, 0); } }
#pragma unroll
        for (int q = 0; q < 4; ++q) { const int t = 16 * tt + (lane >> 4) * 4 + q; const size_t tokt = (size_t)step_tok(b, dir, c * 64 + t); const float dn = fmaxf(fabsf((sc[512 + t] + sc[576 + t]) + sc[640 + t]), sc[256 + t]);
#pragma unroll
            for (int i = 0; i < 4; ++i) { const int e = 16 * ((w & 1) * 4 + i) + (lane & 15); Hout[tokt * BW + h * 128 + e] = aN[i][q] / dn; } }
    }
}


#define SD_FRAG_LOAD(BF, XF, cc_) do { const int tb_ = tokblock_of(b, dir, (cc_)); const bf16_t* bb_ = BTg + ((size_t)tb_ * 256 + grp * 128 + 64 * (w >> 2) + r16) * 64 + q4 * 8; const bf16_t* xb_ = XTg + ((size_t)tb_ * 512 + h * 64 + 16 * (w & 3) + r16) * 64 + q4 * 8; \
        _Pragma("unroll") for (int ks_ = 0; ks_ < 2; ++ks_) { XF[ks_] = *(const u32x4*)(xb_ + ks_ * 32); _Pragma("unroll") for (int j_ = 0; j_ < 4; ++j_) BF[j_][ks_] = *(const u32x4*)(bb_ + (size_t)j_ * 16 * 64 + ks_ * 32); } } while (0)
#define SD_CHUNK(c_, BF, XF, BFN, XFN) do { const int c = (c_); \
        if (c + 1 < 68) SD_FRAG_LOAD(BFN, XFN, c + 1); \
        const float dec = sDEC[c]; \
        {   bf16_t* ss = SSTb + (size_t)(chain * 68 + c) * 64 * 128; const int p = 16 * (w & 3) + r16; \
            _Pragma("unroll") for (int j = 0; j < 4; ++j) { const int n0 = 16 * ((w >> 2) * 4 + j) + q4 * 4; u32x2 pk; pk.x = pk2(acc[j][0], acc[j][1]); pk.y = pk2(acc[j][2], acc[j][3]); *(u32x2*)(ss + (size_t)p * 128 + n0) = pk; } } \
        bf16x8 xfr[2]; \
        _Pragma("unroll") for (int ks = 0; ks < 2; ++ks) { const float4 wa = *(const float4*)(sSC + c * 64 + ks * 32 + q4 * 8), wb = *(const float4*)(sSC + c * 64 + ks * 32 + q4 * 8 + 4); const u32x4 sv = scale8h(XF[ks], wa, wb); xfr[ks] = *(const bf16x8*)&sv; } \
        _Pragma("unroll") for (int j = 0; j < 4; ++j) acc[j] = acc[j] * dec; \
        _Pragma("unroll") for (int ks = 0; ks < 2; ++ks) _Pragma("unroll") for (int j = 0; j < 4; ++j) acc[j] = __builtin_amdgcn_mfma_f32_16x16x32_bf16(*(const bf16x8*)&BF[j][ks], xfr[ks], acc[j], 0, 0, 0); } while (0)
__device__ __forceinline__ void ssd_state_pass(const int chain, const bf16_t* __restrict__ Pm, const bf16_t* __restrict__ BTg, const bf16_t* __restrict__ XTg, const float Aa, const float dtb,
                                               bf16_t* __restrict__ SSTb, unsigned char* shm, const int tid) {
    const int dir = chain & 1, h = (chain >> 1) & 7, b = chain >> 4, grp = h >> 2, lane = tid & 63, w = tid >> 6, q4 = lane >> 4, r16 = lane & 15;
    float* sSC = (float*)shm; float* sDEC = sSC + 68 * 64;
    const int dcol = SSD_OFF + 1536 + dir * 8 + h;
    u32x4 bfA[4][2], xfA[2], bfB[4][2], xfB[2];
    SD_FRAG_LOAD(bfA, xfA, 0);
    __syncthreads();
    unsigned short dt_[9];
#pragma unroll
    for (int q = 0; q < 9; ++q) { const int c = min(w + 8 * q, 67); dt_[q] = Pm[(size_t)step_tok(b, dir, c * 64 + lane) * LDP + dcol]; }
#pragma unroll
    for (int q = 0; q < 9; ++q) { const int c = w + 8 * q; if (c >= 68) break;
        const float xv = bf2f(dt_[q]) + dtb; const float dtv = xv > 20.f ? xv : log1pf(expf(xv));
        const float cs = wave_scan_incl(dtv * Aa, lane); const float cl = __shfl(cs, 63);
        sSC[c * 64 + (dir ? 63 - lane : lane)] = dtv * expf(cl - cs); if (lane == 0) sDEC[c] = expf(cl); }
    __syncthreads();
    f32x4 acc[4];
#pragma unroll
    for (int j = 0; j < 4; ++j) acc[j] = (f32x4){0.f, 0.f, 0.f, 0.f};
    for (int c2 = 0; c2 < 68; c2 += 2) { SD_CHUNK(c2, bfA, xfA, bfB, xfB); SD_CHUNK(c2 + 1, bfB, xfB, bfA, xfA); }
    __syncthreads();
}
#undef SD_CHUNK
#undef SD_FRAG_LOAD
__device__ __forceinline__ void ssd_out_item(const int chain, const int c, const bf16_t* __restrict__ Pm, const bf16_t* __restrict__ XBb, const bf16_t* __restrict__ XTg, const float Aa, const float dtb,
                                             const bf16_t* __restrict__ SSTb, float* __restrict__ Yout, unsigned char* shm, const int tid) {
    const int dir = chain & 1, h = (chain >> 1) & 7, b = chain >> 4, grp = h >> 2, lane = tid & 63, w = tid >> 6;
    bf16_t* Cs = (bf16_t*)shm; bf16_t* Bs = (bf16_t*)(shm + 17408); bf16_t* XT = (bf16_t*)(shm + 34816); bf16_t* Sin = (bf16_t*)(shm + 44032); bf16_t* Gs = (bf16_t*)(shm + 61440);
    float* sc = (float*)(shm + 70656);
    __syncthreads();
#pragma unroll
    for (int i = 0; i < 2; ++i) { const int pid = tid + i * 512; const int s = pid >> 4, x0 = (pid & 15) * 8; const size_t toks = (size_t)step_tok(b, dir, c * 64 + s);
        *(u32x4*)(Bs + s * 136 + x0) = *(const u32x4*)(XBb + toks * 1024 + 512 + grp * 128 + x0);
        *(u32x4*)(Cs + s * 136 + x0) = *(const u32x4*)(XBb + toks * 1024 + 768 + grp * 128 + x0);
        const int p = pid >> 4;
        *(u32x4*)(Sin + p * 136 + x0) = *(const u32x4*)(SSTb + ((size_t)(chain * 68 + c) * 64 + p) * 128 + x0); }
    {   const int p = tid >> 3, o = tid & 7;
        const u32x4 vv = *(const u32x4*)(XTg + ((size_t)tokblock_of(b, dir, c) * 512 + h * 64 + p) * 64 + (dir ? 7 - o : o) * 8);
        *(u32x4*)(XT + p * 72 + o * 8) = dir ? rev8h(vv) : vv; }
    if (w == 0) { const size_t tokl = (size_t)step_tok(b, dir, c * 64 + lane);
        const float xv = bf2f(Pm[tokl * LDP + SSD_OFF + 1536 + dir * 8 + h]) + dtb; const float dtv = xv > 20.f ? xv : log1pf(expf(xv));
        sc[lane] = wave_scan_incl(dtv * Aa, lane); sc[64 + lane] = dtv; }
    __syncthreads();
    {   const int lt = w >> 1;
        f32x4 aG[2] = {(f32x4){0.f, 0.f, 0.f, 0.f}, (f32x4){0.f, 0.f, 0.f, 0.f}};
#pragma unroll
        for (int ks = 0; ks < 4; ++ks) { const bf16x8 af = *(const bf16x8*)(Cs + (16 * lt + (lane & 15)) * 136 + ks * 32 + (lane >> 4) * 8);
#pragma unroll
            for (int i = 0; i < 2; ++i) { const int st = (w & 1) * 2 + i; const bf16x8 bfr = *(const bf16x8*)(Bs + (16 * st + (lane & 15)) * 136 + ks * 32 + (lane >> 4) * 8);
                aG[i] = __builtin_amdgcn_mfma_f32_16x16x32_bf16(af, bfr, aG[i], 0, 0, 0); } }
#pragma unroll
        for (int i = 0; i < 2; ++i) { const int s = 16 * ((w & 1) * 2 + i) + (lane & 15); const float css = sc[s], dts = sc[64 + s];
#pragma unroll
            for (int q = 0; q < 4; ++q) { const int t = 16 * lt + (lane >> 4) * 4 + q; const float val = (s <= t) ? aG[i][q] * expf(sc[t] - css) * dts : 0.f; Gs[t * 72 + s] = f2bf(val); } }
    }
    __syncthreads();
    {   const int lt = w >> 1;
        f32x4 aY[2] = {(f32x4){0.f, 0.f, 0.f, 0.f}, (f32x4){0.f, 0.f, 0.f, 0.f}};
#pragma unroll
        for (int ks = 0; ks < 4; ++ks) { const bf16x8 af = *(const bf16x8*)(Cs + (16 * lt + (lane & 15)) * 136 + ks * 32 + (lane >> 4) * 8);
#pragma unroll
            for (int i = 0; i < 2; ++i) { const int pt = (w & 1) * 2 + i; const bf16x8 bfr = *(const bf16x8*)(Sin + (16 * pt + (lane & 15)) * 136 + ks * 32 + (lane >> 4) * 8);
                aY[i] = __builtin_amdgcn_mfma_f32_16x16x32_bf16(af, bfr, aY[i], 0, 0, 0); } }
#pragma unroll
        for (int q = 0; q < 4; ++q) { const float ec = expf(sc[16 * lt + (lane >> 4) * 4 + q]); aY[0][q] *= ec; aY[1][q] *= ec; }
#pragma unroll
        for (int ks = 0; ks < 2; ++ks) { const bf16x8 af = *(const bf16x8*)(Gs + (16 * lt + (lane & 15)) * 72 + ks * 32 + (lane >> 4) * 8);
#pragma unroll
            for (int i = 0; i < 2; ++i) { const int pt = (w & 1) * 2 + i; const bf16x8 bfr = *(const bf16x8*)(XT + (16 * pt + (lane & 15)) * 72 + ks * 32 + (lane >> 4) * 8);
                aY[i] = __builtin_amdgcn_mfma_f32_16x16x32_bf16(af, bfr, aY[i], 0, 0, 0); } }
#pragma unroll
        for (int q = 0; q < 4; ++q) { const int t = 16 * lt + (lane >> 4) * 4 + q; const size_t tokt = (size_t)step_tok(b, dir, c * 64 + t);
#pragma unroll
            for (int i = 0; i < 2; ++i) { const int p = 16 * ((w & 1) * 2 + i) + (lane & 15); Yout[tokt * BW + h * 64 + p] = aY[i][q]; } }
    }
}


#define FIDX(i) ((i) + ((i) >> 4))
#define FFT_X_BYTES 69632
__device__ constexpr float FFT_CW_RE[6][16] = {{0.f, 0.f, 0.f, 0.f, 0.f, 0.f, 0.f, 0.f, 0.f, 0.f, 0.f, 0.f, 0.f, 0.f, 0.f, 0.f}, {1.0f, 0.f, 0.f, 0.f, 0.f, 0.f, 0.f, 0.f, 0.f, 0.f, 0.f, 0.f, 0.f, 0.f, 0.f, 0.f}, {1.0f, 6.123233995736766e-17f, 0.f, 0.f, 0.f, 0.f, 0.f, 0.f, 0.f, 0.f, 0.f, 0.f, 0.f, 0.f, 0.f, 0.f}, {1.0f, 0.7071067811865476f, 6.123233995736766e-17f, -0.7071067811865475f, 0.f, 0.f, 0.f, 0.f, 0.f, 0.f, 0.f, 0.f, 0.f, 0.f, 0.f, 0.f}, {1.0f, 0.9238795325112867f, 0.7071067811865476f, 0.38268343236508984f, 6.123233995736766e-17f, -0.3826834323650897f, -0.7071067811865475f, -0.9238795325112867f, 0.f, 0.f, 0.f, 0.f, 0.f, 0.f, 0.f, 0.f}, {1.0f, 0.9807852804032304f, 0.9238795325112867f, 0.8314696123025452f, 0.7071067811865476f, 0.5555702330196023f, 0.38268343236508984f, 0.19509032201612833f, 6.123233995736766e-17f, -0.1950903220161282f, -0.3826834323650897f, -0.555570233019602f, -0.7071067811865475f, -0.8314696123025453f, -0.9238795325112867f, -0.9807852804032304f}};
__device__ constexpr float FFT_CW_IM[6][16] = {{0.f, 0.f, 0.f, 0.f, 0.f, 0.f, 0.f, 0.f, 0.f, 0.f, 0.f, 0.f, 0.f, 0.f, 0.f, 0.f}, {-0.0f, 0.f, 0.f, 0.f, 0.f, 0.f, 0.f, 0.f, 0.f, 0.f, 0.f, 0.f, 0.f, 0.f, 0.f, 0.f}, {-0.0f, -1.0f, 0.f, 0.f, 0.f, 0.f, 0.f, 0.f, 0.f, 0.f, 0.f, 0.f, 0.f, 0.f, 0.f, 0.f}, {-0.0f, -0.7071067811865475f, -1.0f, -0.7071067811865476f, 0.f, 0.f, 0.f, 0.f, 0.f, 0.f, 0.f, 0.f, 0.f, 0.f, 0.f, 0.f}, {-0.0f, -0.3826834323650898f, -0.7071067811865475f, -0.9238795325112867f, -1.0f, -0.9238795325112867f, -0.7071067811865476f, -0.3826834323650899f, 0.f, 0.f, 0.f, 0.f, 0.f, 0.f, 0.f, 0.f}, {-0.0f, -0.19509032201612825f, -0.3826834323650898f, -0.5555702330196022f, -0.7071067811865475f, -0.8314696123025452f, -0.9238795325112867f, -0.9807852804032304f, -1.0f, -0.9807852804032304f, -0.9238795325112867f, -0.8314696123025455f, -0.7071067811865476f, -0.5555702330196022f, -0.3826834323650899f, -0.1950903220161286f}};
__host__ __device__ constexpr int fft_bitrev(int k, int R) { int r = 0; for (int i = 0; i < R; ++i) if (k & (1 << i)) r |= 1 << (R - 1 - i); return r; }
template <int R, bool INV>
__device__ __forceinline__ void fft_pass(float2* __restrict__ X, const float2* __restrict__ TW, const int s0, const int gidx) {
    const int lowbits = 13 - s0 - R; const int stride = 1 << lowbits;
    const int low = gidx & (stride - 1), high = gidx >> lowbits; const int base = (high << (lowbits + R)) | low;
    const int p0 = FIDX(base);
#define FFT_SLOT(k) (lowbits >= 4 ? p0 + (k) * (stride + (stride >> 4)) : p0 + (k) + ((k) >> 4))
    float2 v[1 << R];
#pragma unroll
    for (int k = 0; k < (1 << R); ++k) v[k] = X[FFT_SLOT(k)];
    const int lw = low << s0;
    if (!INV) {
#pragma unroll
        for (int j = 0; j < R; ++j) { const int hk = 1 << (R - 1 - j);
#pragma unroll
            for (int k = 0; k < (1 << R); ++k) if (!(k & hk)) { const int kk = k & (hk - 1);
                const float2 a = v[k], b = v[k + hk]; v[k] = make_float2(a.x + b.x, a.y + b.y); const float dx = a.x - b.x, dy = a.y - b.y;
                if (kk == 0) v[k + hk] = make_float2(dx, dy);
                else if (2 * kk == hk) v[k + hk] = make_float2(dy, -dx);
                else { const float cr = FFT_CW_RE[R - j][kk], ci = FFT_CW_IM[R - j][kk]; v[k + hk] = make_float2(dx * cr - dy * ci, dx * ci + dy * cr); } } }
        if (lowbits > 0) {
#pragma unroll
            for (int k = 1; k < (1 << R); ++k) { const float2 w = TW[(lw * fft_bitrev(k, R)) & 8191]; const float2 a = v[k]; v[k] = make_float2(a.x * w.x - a.y * w.y, a.x * w.y + a.y * w.x); } }
    } else {
        if (lowbits > 0) {
#pragma unroll
            for (int k = 1; k < (1 << R); ++k) { const float2 w = TW[(lw * fft_bitrev(k, R)) & 8191]; const float2 a = v[k]; v[k] = make_float2(a.x * w.x + a.y * w.y, a.y * w.x - a.x * w.y); } }
#pragma unroll
        for (int j = R - 1; j >= 0; --j) { const int hk = 1 << (R - 1 - j);
#pragma unroll
            for (int k = 0; k < (1 << R); ++k) if (!(k & hk)) { const int kk = k & (hk - 1);
                const float2 a = v[k], b = v[k + hk]; float tx, ty;
                if (kk == 0) { tx = b.x; ty = b.y; }
                else if (2 * kk == hk) { tx = -b.y; ty = b.x; }
                else { const float cr = FFT_CW_RE[R - j][kk], ci = FFT_CW_IM[R - j][kk]; tx = b.x * cr + b.y * ci; ty = b.y * cr - b.x * ci; }
                v[k] = make_float2(a.x + tx, a.y + ty); v[k + hk] = make_float2(a.x - tx, a.y - ty); } }
    }
#pragma unroll
    for (int k = 0; k < (1 << R); ++k) X[FFT_SLOT(k)] = v[k];
#undef FFT_SLOT
}
__device__ __forceinline__ void fft_fwd(float2* X, const float2* TW, const int tid) {
    fft_pass<4, false>(X, TW, 0, tid); __syncthreads(); fft_pass<4, false>(X, TW, 4, tid); __syncthreads(); if (tid < 256) fft_pass<5, false>(X, TW, 8, tid); __syncthreads(); }
__device__ __forceinline__ void fft_inv(float2* X, const float2* TW, const int tid) {
    if (tid < 256) fft_pass<5, true>(X, TW, 8, tid); __syncthreads(); fft_pass<4, true>(X, TW, 4, tid); __syncthreads(); fft_pass<4, true>(X, TW, 0, tid); __syncthreads(); }
__device__ __forceinline__ void fft_twiddles(float2* TW, const int tid) {
#pragma unroll
    for (int k = 0; k < 16; ++k) { const int m = tid + k * 512; const float xx = (float)m * (1.0f / 4096.0f); TW[m] = make_float2(cospif(xx), -sinpif(xx)); }
}
__device__ __forceinline__ void hyena_spec_item(const int oc, const float* __restrict__ HR, const float* __restrict__ nrm, float2* __restrict__ HSPEC, unsigned char* shm, const int tid) {
    float2* X = (float2*)shm; const float2* TW = (const float2*)(shm + FFT_X_BYTES);
    const int o = oc >> 9, c = oc & 511; const float inv = 1.0f / nrm[oc];
    __syncthreads();
    float hv[16];
#pragma unroll
    for (int k = 0; k < 16; ++k) { const int j = tid + k * 512;
        const unsigned off = j < SEQ ? (unsigned)j * 2048u + o * 1024 + c : j == SEQ ? (unsigned)(o * 1024 + c) : (unsigned)(2 * SEQ - j) * 2048u + o * 1024 + 512 + c;
        hv[k] = HR[off]; }
#pragma unroll
    for (int k = 0; k < 16; ++k) { const int j = tid + k * 512; X[FIDX(j)] = make_float2(j == SEQ ? 0.f : hv[k] * inv, 0.f); }
    __syncthreads();
    fft_fwd(X, TW, tid);
    float4* out = (float4*)(HSPEC + (size_t)oc * 8192 + tid * 16); const float2* xs = X + 17 * tid;
#pragma unroll
    for (int k = 0; k < 8; ++k) { const float2 x0 = xs[2 * k], x1 = xs[2 * k + 1]; out[k] = make_float4(x0.x * (1.0f / 8192.0f), x0.y * (1.0f / 8192.0f), x1.x * (1.0f / 8192.0f), x1.y * (1.0f / 8192.0f)); }
}
__device__ __forceinline__ void fft_mul_spec(float2* X, const float2* __restrict__ H, const int tid) {
    const float4* h4 = (const float4*)(H + tid * 16); float2* xs = X + 17 * tid;
#pragma unroll
    for (int k = 0; k < 8; ++k) { const float4 hv = h4[k]; const float2 x0 = xs[2 * k], x1 = xs[2 * k + 1];
        xs[2 * k] = make_float2(x0.x * hv.x - x0.y * hv.y, x0.x * hv.y + x0.y * hv.x); xs[2 * k + 1] = make_float2(x1.x * hv.z - x1.y * hv.w, x1.x * hv.w + x1.y * hv.z); }
}
__device__ __forceinline__ void hyena_fft_item(const int item, const float* __restrict__ UT, const float2* __restrict__ HSPEC, const float* __restrict__ bias, float* __restrict__ YT, unsigned char* shm, const int tid) {
    float2* X = (float2*)shm; const float2* TW = (const float2*)(shm + FFT_X_BYTES);
    const int c = item >> 1, b0 = (item & 1) * 2, b1 = b0 + 1;
    const float* u0 = UT + (size_t)(b0 * 1536 + c) * SEQ + tid * 8; const float* u1 = UT + (size_t)(b1 * 1536 + c) * SEQ + tid * 8;
    const float bias0 = bias[c], bias1 = bias[512 + c];
    float2* xs = X + FIDX(8 * tid);
    float vr[8], vi[8];
    __syncthreads();
    { const float4 a0 = *(const float4*)u0, a1 = *(const float4*)(u0 + 4), c0 = *(const float4*)u1, c1 = *(const float4*)(u1 + 4);
      vr[0] = a0.x; vr[1] = a0.y; vr[2] = a0.z; vr[3] = a0.w; vr[4] = a1.x; vr[5] = a1.y; vr[6] = a1.z; vr[7] = a1.w;
      vi[0] = c0.x; vi[1] = c0.y; vi[2] = c0.z; vi[3] = c0.w; vi[4] = c1.x; vi[5] = c1.y; vi[6] = c1.z; vi[7] = c1.w; }
#pragma unroll
    for (int k = 0; k < 8; ++k) { xs[k] = make_float2(vr[k], vi[k]); xs[4352 + k] = make_float2(0.f, 0.f); }
    __syncthreads();
    fft_fwd(X, TW, tid);
    fft_mul_spec(X, HSPEC + (size_t)c * 8192, tid);
    __syncthreads();
    fft_inv(X, TW, tid);
    { const float* p0 = u0 + (size_t)512 * SEQ; const float* p1 = u1 + (size_t)512 * SEQ;
      const float4 a0 = *(const float4*)p0, a1 = *(const float4*)(p0 + 4), c0 = *(const float4*)p1, c1 = *(const float4*)(p1 + 4);
      const float xr[8] = {a0.x, a0.y, a0.z, a0.w, a1.x, a1.y, a1.z, a1.w}, xi[8] = {c0.x, c0.y, c0.z, c0.w, c1.x, c1.y, c1.z, c1.w};
#pragma unroll
      for (int k = 0; k < 8; ++k) { const float2 cv = xs[k]; const float zr = xr[k] * (cv.x + bias0 * vr[k]), zi = xi[k] * (cv.y + bias0 * vi[k]);
          vr[k] = zr; vi[k] = zi; xs[k] = make_float2(zr, zi); xs[4352 + k] = make_float2(0.f, 0.f); } }
    __syncthreads();
    fft_fwd(X, TW, tid);
    fft_mul_spec(X, HSPEC + (size_t)(512 + c) * 8192, tid);
    __syncthreads();
    fft_inv(X, TW, tid);
    { const float* p0 = u0 + (size_t)1024 * SEQ; const float* p1 = u1 + (size_t)1024 * SEQ;
      const float4 a0 = *(const float4*)p0, a1 = *(const float4*)(p0 + 4), c0 = *(const float4*)p1, c1 = *(const float4*)(p1 + 4);
      const float xr[8] = {a0.x, a0.y, a0.z, a0.w, a1.x, a1.y, a1.z, a1.w}, xi[8] = {c0.x, c0.y, c0.z, c0.w, c1.x, c1.y, c1.z, c1.w};
      float yr[8], yi[8];
#pragma unroll
      for (int k = 0; k < 8; ++k) { const float2 cv = xs[k]; yr[k] = xr[k] * (cv.x + bias1 * vr[k]); yi[k] = xi[k] * (cv.y + bias1 * vi[k]); }
      float* y0 = YT + (size_t)(b0 * 512 + c) * SEQ + tid * 8; float* y1 = YT + (size_t)(b1 * 512 + c) * SEQ + tid * 8;
      *(float4*)y0 = make_float4(yr[0], yr[1], yr[2], yr[3]); *(float4*)(y0 + 4) = make_float4(yr[4], yr[5], yr[6], yr[7]);
      *(float4*)y1 = make_float4(yi[0], yi[1], yi[2], yi[3]); *(float4*)(y1 + 4) = make_float4(yi[4], yi[5], yi[6], yi[7]); }
}

constexpr size_t al256(size_t x) { return (x + 255) & ~(size_t)255; }
constexpr size_t O_BAR = 0;
constexpr size_t O_MOD = 16384;
constexpr size_t O_NORM = O_MOD + al256((size_t)2 * 5 * 6 * DM * 4);
constexpr size_t O_QCTR = O_NORM + al256((size_t)2 * 2 * 1024 * 4);
constexpr size_t O_ZERO_END = O_QCTR + 512;
constexpr size_t O_XS = O_ZERO_END;
constexpr size_t O_HB = O_XS + al256((size_t)NTOK * DM * 4);
constexpr size_t O_P = O_HB + al256((size_t)NTOK * DM * 2);
constexpr size_t O_WIN = O_P + al256((size_t)NTOK * LDP * 2);
constexpr size_t O_WBR = O_WIN + al256((size_t)LDP * DM * 2);
constexpr size_t O_WOUT = O_WBR + al256((size_t)4 * DM * BW * 2);
constexpr size_t O_WGU = O_WOUT + al256((size_t)DM * DM * 2);
constexpr size_t O_WD = O_WGU + al256((size_t)NEXP * 2 * DEXP * DM * 2);
constexpr size_t O_GLU = O_WD + al256((size_t)NEXP * DM * DEXP * 2);
constexpr size_t O_Y4 = O_GLU + al256((size_t)BW * BW * 2);
constexpr size_t O_U = O_Y4 + al256((size_t)NTOK * DM * 2);
constexpr size_t O_QKB = O_U + al256((size_t)NTOK * 1536 * 4);
constexpr size_t O_CST = O_QKB + al256((size_t)NTOK * 1024 * 2);
constexpr size_t O_NST = O_CST + al256((size_t)32 * 68 * 128 * 128 * 2);
constexpr size_t O_MST = O_NST + al256((size_t)32 * 68 * 128 * 4);
constexpr size_t O_XBC = O_MST + al256((size_t)32 * 68 * 4);
constexpr size_t O_SST = O_XBC + al256((size_t)NTOK * 1024 * 2);
constexpr size_t O_HF = O_SST + al256((size_t)64 * 68 * 64 * 128 * 2);
constexpr size_t O_YF = O_HF + al256((size_t)2 * NTOK * BW * 4);
constexpr size_t O_SF = O_YF + al256((size_t)2 * NTOK * BW * 4);
constexpr size_t O_LDT = O_SF + al256((size_t)2 * NCTX * BW * 4);
constexpr size_t O_AP = O_LDT + al256((size_t)4096 * 16);
constexpr size_t O_BBT = O_AP + al256((size_t)4096 * 33 * 8);
constexpr size_t O_KT = O_BBT + al256((size_t)4096 * 16 * 8);
constexpr size_t O_S5A = O_KT + al256((size_t)32 * 2 * 32 * 256 * 4);
constexpr size_t O_S5B = O_S5A + al256((size_t)32 * 512 * 768 * 2);
constexpr size_t O_XCTX = O_S5B + al256((size_t)32 * 512 * 768 * 2);
constexpr size_t O_Z = O_XCTX + al256((size_t)4 * 32 * 2 * 64 * 8);
constexpr size_t O_HRAW = O_Z + al256((size_t)NTOK * BW * 4);
constexpr size_t O_HSPEC = O_HRAW + al256((size_t)(SEQ + CTXL) * 2048 * 4);
constexpr size_t O_K2C = O_HSPEC + al256((size_t)1024 * 8192 * 8);
constexpr size_t O_GG = O_K2C + al256((size_t)(2 * CTXL) * 1024 * 4);
constexpr size_t O_PROBS = O_GG + al256((size_t)NTOK * BW * 2);
constexpr size_t O_ROWTOK = O_PROBS + al256((size_t)NTOK * 16 * 4);
constexpr size_t O_ROWGATE = O_ROWTOK + al256((size_t)NEXP * MOE_PAD * 4);
constexpr size_t O_INV = O_ROWGATE + al256((size_t)NEXP * MOE_PAD * 4);
constexpr size_t O_NORMP = O_INV + al256((size_t)NTOK * 16 * 4);
constexpr size_t WS_END = O_NORMP + al256((size_t)4 * 256 * 2048 * 4);
constexpr size_t O_XG = O_P;
constexpr size_t O_HID = O_P + al256((size_t)NEXP * MOE_PAD * DM * 2);
constexpr size_t O_YEXP = O_HID + al256((size_t)NEXP * MOE_PAD * DEXP * 2);
static_assert(O_YEXP + (size_t)NEXP * MOE_PAD * DM * 2 <= O_WIN, "MoE temporaries must fit inside P");
static_assert((size_t)NTOK * DM * 2 <= (size_t)NTOK * 1536 * 4, "ACCb must fit inside U");
static_assert((size_t)26214400 + (size_t)2 * 17825792 + (size_t)272 * 256 * 64 * 2 <= (size_t)NTOK * DM * 2, "strip buffers must fit inside HB");
static_assert(WS_END <= (size_t)1851000000, "workspace map exceeds the guaranteed size");

struct Args {
    const float* in[47];
    float* out; unsigned char* ws;
    int ph_lo, ph_hi;
};

__device__ __forceinline__ void conv_tile(const float* __restrict__ src, int ldsrc, int nvalid, int k0, int n0, bf16_t* __restrict__ dst, int lddst, int mode, float* T, int tid) {
    { const int n = tid & 63, kr = tid >> 6;
#pragma unroll
      for (int i = 0; i < 8; ++i) { const int k = i * 8 + kr; T[k * 65 + n] = (n0 + n < nvalid) ? src[(size_t)(k0 + k) * ldsrc + n0 + n] : 0.f; } }
    __syncthreads();
    { const int n = tid >> 3, kc = (tid & 7) * 8; const int gn = n0 + n;
      const int drow = mode == 0 ? gn : (32 * (gn >> 4) + (mode == 2 ? 16 : 0) + (gn & 15));
      u32x4 w; w.x = pk2(T[(kc + 0) * 65 + n], T[(kc + 1) * 65 + n]); w.y = pk2(T[(kc + 2) * 65 + n], T[(kc + 3) * 65 + n]);
      w.z = pk2(T[(kc + 4) * 65 + n], T[(kc + 5) * 65 + n]); w.w = pk2(T[(kc + 6) * 65 + n], T[(kc + 7) * 65 + n]);
      *(u32x4*)(dst + (size_t)drow * lddst + k0 + kc) = w; }
    __syncthreads();
}

#define IN(id) (lo <= (id) && (id) < hi)
#define SEAM(id) do { if (hi > (id) + 1) xcd_barrier(bar); } while (0)
#define PH_BEGIN int tid = threadIdx.x; asm volatile("" : "+v"(tid) :: "memory"); const int lane = tid & 63, wave = tid >> 6; (void)lane; (void)wave;

#define x_in (PT(0))
#define c_in (PT(1))
#define ctx_in (PT(2))
#define cctx_in (PT(3))
#define ada_w (PT(4))
#define ada_b (PT(5))
#define norm_mix (PT(6))
#define norm_ffn (PT(7))
#define w_in (PT(8))
#define XS ((float*)(a.ws + O_XS))
#define MOD ((float*)(a.ws + O_MOD))
#define NORM ((float*)(a.ws + O_NORM))
#define NORMP ((float*)(a.ws + O_NORMP))
#define MODl (MOD + (size_t)l * 5 * 6 * DM)
#define HB ((bf16_t*)(a.ws + O_HB))
#define P ((bf16_t*)(a.ws + O_P))
#define WIN ((bf16_t*)(a.ws + O_WIN))
#define WBR ((bf16_t*)(a.ws + O_WBR))
#define WOUT ((bf16_t*)(a.ws + O_WOUT))
#define WGU ((bf16_t*)(a.ws + O_WGU))
#define WD ((bf16_t*)(a.ws + O_WD))
#define GLU ((bf16_t*)(a.ws + O_GLU))
#define Y4 ((bf16_t*)(a.ws + O_Y4))
#define U ((float*)(a.ws + O_U))
#define ACCb ((bf16_t*)(a.ws + O_U))
#define QKB ((bf16_t*)(a.ws + O_QKB))
#define CST ((bf16_t*)(a.ws + O_CST))
#define NST ((float*)(a.ws + O_NST))
#define MST ((float*)(a.ws + O_MST))
#define XBC ((bf16_t*)(a.ws + O_XBC))
#define SSTB ((bf16_t*)(a.ws + O_SST))
#define HF ((float*)(a.ws + O_HF))
#define HBk (HF + (size_t)NTOK * BW)
#define YF ((float*)(a.ws + O_YF))
#define YB (YF + (size_t)NTOK * BW)
#define SF ((float*)(a.ws + O_SF))
#define SB (SF + (size_t)NCTX * BW)
#define LDT ((double2*)(a.ws + O_LDT))
#define APW ((float2*)(a.ws + O_AP))
#define BBT ((float2*)(a.ws + O_BBT))
#define KTB ((float*)(a.ws + O_KT))
#define S5A ((bf16_t*)(a.ws + O_S5A))
#define S5B ((bf16_t*)(a.ws + O_S5B))
#define XCTX ((float2*)(a.ws + O_XCTX))
#define S5P ((bf16_t*)(a.ws + O_HB))
#define XLOC ((float*)(a.ws + O_HB + (size_t)32 * 256 * 512 * 2))
#define KTG ((bf16_t*)(a.ws + O_HB + (size_t)26214400))
#define VTG ((bf16_t*)(a.ws + O_HB + (size_t)26214400 + (size_t)17825792))
#define BTG ((bf16_t*)(a.ws + O_HB + (size_t)26214400 + (size_t)2 * 17825792))
#define XTG ((bf16_t*)(a.ws + O_GG))
#define Z ((float*)(a.ws + O_Z))
#define HRAW ((float*)(a.ws + O_HRAW))
#define HSPEC ((float2*)(a.ws + O_HSPEC))
#define UT ((float*)(a.ws + O_U))
#define YT ((float*)(a.ws + O_Z))
#define QCTR ((int*)(a.ws + O_QCTR))
#define K2C ((float*)(a.ws + O_K2C))
#define GG ((bf16_t*)(a.ws + O_GG))
#define PROBS ((float*)(a.ws + O_PROBS))
#define ROWTOK ((int*)(a.ws + O_ROWTOK))
#define ROWGATE ((float*)(a.ws + O_ROWGATE))
#define XG ((bf16_t*)(a.ws + O_XG))
#define HID ((bf16_t*)(a.ws + O_HID))
#define YEXP ((bf16_t*)(a.ws + O_YEXP))
#define INV ((int*)(a.ws + O_INV))


__device__ __forceinline__ void moe_pair(float4 (&a)[8], const int r1, const int r2, const float g2scale, const int lane, const float* __restrict__ rowgate, const bf16_t* __restrict__ yexp) {
    const float gt1 = rowgate[r1], gt2 = rowgate[r2] * g2scale;
    const bf16_t* y1 = yexp + (size_t)r1 * DM + lane * 4; const bf16_t* y2 = yexp + (size_t)r2 * DM + lane * 4;
    u32x2 w1[8], w2[8];
#pragma unroll
    for (int i = 0; i < 8; ++i) { w1[i] = *(const u32x2*)(y1 + i * 256); w2[i] = *(const u32x2*)(y2 + i * 256); }
#pragma unroll
    for (int i = 0; i < 8; ++i) {
        a[i].x += gt1 * __uint_as_float(w1[i].x << 16); a[i].y += gt1 * __uint_as_float(w1[i].x & 0xFFFF0000u); a[i].z += gt1 * __uint_as_float(w1[i].y << 16); a[i].w += gt1 * __uint_as_float(w1[i].y & 0xFFFF0000u);
        a[i].x += gt2 * __uint_as_float(w2[i].x << 16); a[i].y += gt2 * __uint_as_float(w2[i].x & 0xFFFF0000u); a[i].z += gt2 * __uint_as_float(w2[i].y << 16); a[i].w += gt2 * __uint_as_float(w2[i].y & 0xFFFF0000u); }
}
__device__ __forceinline__ void moe_combine(float4 (&v)[8], const int tok, const int lane, const int* __restrict__ inv, const float* __restrict__ rowgate, const bf16_t* __restrict__ yexp, const float* __restrict__ m5) {
    float4 a[8];
#pragma unroll
    for (int i = 0; i < 8; ++i) a[i] = make_float4(0.f, 0.f, 0.f, 0.f);
    const int4* ip = (const int4*)(inv + (size_t)tok * 16);
    const int4 q0 = ip[0], q1 = ip[1], q2 = ip[2], q3 = ip[3];
    const int rows[16] = {q0.x, q0.y, q0.z, q0.w, q1.x, q1.y, q1.z, q1.w, q2.x, q2.y, q2.z, q2.w, q3.x, q3.y, q3.z, q3.w};
    int prow = -1;
#pragma unroll
    for (int e = 0; e < 16; ++e) { const int row = __builtin_amdgcn_readfirstlane(rows[e]);
        if (row >= 0) { if (prow >= 0) { moe_pair(a, prow, row, 1.0f, lane, rowgate, yexp); prow = -1; } else prow = row; } }
    if (prow >= 0) moe_pair(a, prow, prow, 0.0f, lane, rowgate, yexp);
#pragma unroll
    for (int i = 0; i < 8; ++i) { const float4 mm = *(const float4*)(m5 + i * 256 + lane * 4); v[i].x += mm.x * a[i].x; v[i].y += mm.y * a[i].y; v[i].z += mm.z * a[i].z; v[i].w += mm.w * a[i].w; }
}
struct CvU { const float* src; bf16_t* dst; int ldsrc, nvalid, k0, n0, lddst, mode; };
__device__ __forceinline__ void cv_load(const CvU& u, float4 (&r)[8], const int tid) {
#pragma unroll
    for (int i = 0; i < 8; ++i) { const int idx = tid + i * 512; const int k = idx >> 6, n = u.n0 + (idx & 63) * 4;
        r[i] = (n < u.nvalid) ? *(const float4*)(u.src + (size_t)(u.k0 + k) * u.ldsrc + n) : make_float4(0.f, 0.f, 0.f, 0.f); }
}
__device__ __forceinline__ void cv_stage(float* T, const float4 (&r)[8], const int tid) {
#pragma unroll
    for (int i = 0; i < 8; ++i) { const int idx = tid + i * 512; float* p = T + (idx >> 6) * 257 + (idx & 63) * 4; p[0] = r[i].x; p[1] = r[i].y; p[2] = r[i].z; p[3] = r[i].w; }
}
__device__ __forceinline__ void cv_store(const CvU& u, const float* T, const int tid) {
#pragma unroll
    for (int j = 0; j < 4; ++j) { const int o = tid + j * 512; const int kc = (o & 7) * 8, n = o >> 3; const int gn = u.n0 + n;
        const int drow = u.mode == 0 ? gn : (256 * (gn >> 7) + (u.mode == 2 ? 128 : 0) + (gn & 127));
        const float* t = T + kc * 257 + n;
        u32x4 w; w.x = pk2(t[0], t[257]); w.y = pk2(t[2 * 257], t[3 * 257]); w.z = pk2(t[4 * 257], t[5 * 257]); w.w = pk2(t[6 * 257], t[7 * 257]);
        *(u32x4*)(u.dst + (size_t)drow * u.lddst + u.k0 + kc) = w; }
}
template <int LAYER>
__device__ __forceinline__ void layer_body(const Args& a, const XcdBarrier& bar, const int lo, const int hi, const int bid, const int G, unsigned char* const shm, float* const sf, const float** const ptab) {
        constexpr int l = LAYER;
        constexpr int PB = 1 + 16 * l;
        const bool lastl = (l == 1);

        const int nPanels = lastl ? 64 : 68;
        const int M2 = nPanels * 256;

        if (IN(PB + 0)) for (int rep_ = 0; rep_ < (l == 0 ? PROBE_REPS(0) : 1); ++rep_) {
            PH_BEGIN
            {   const float* wbr = PT(40) + (size_t)l * 4 * BW * DM; const float* wout = PT(41) + (size_t)l * DM * DM;
                const float* wg = PT(43) + (size_t)l * NEXP * DM * DEXP; const float* wu = PT(44) + (size_t)l * NEXP * DM * DEXP; const float* wd = PT(45) + (size_t)l * NEXP * DEXP * DM;
                const float* wglu = PT(32) + (size_t)l * BW * BW; const float* win = w_in + (size_t)l * DM * IN_W;
                const int n_win = 32 * 55, n_br = 4 * 64, n_out = 32 * 8, n_gu = 16 * 2 * 192, n_d = 16 * 192, n_glu = 16;
                const int total = n_win + n_br + n_out + n_gu + n_d + n_glu;
#define CV_DECODE(q_, u_) do { int qq_ = (q_); \
                    if (qq_ < n_win) { u_ = CvU{win, WIN, IN_W, IN_W, (qq_ / 55) * 64, (qq_ % 55) * 256, DM, 0}; } else { qq_ -= n_win; \
                    if (qq_ < n_br) { const int k = qq_ >> 6, r = qq_ & 63; u_ = CvU{wbr + (size_t)k * BW * DM, WBR + (size_t)k * DM * BW, DM, DM, (r >> 3) * 64, (r & 7) * 256, BW, 0}; } else { qq_ -= n_br; \
                    if (qq_ < n_out) { u_ = CvU{wout, WOUT, DM, DM, (qq_ >> 3) * 64, (qq_ & 7) * 256, DM, 0}; } else { qq_ -= n_out; \
                    if (qq_ < n_gu) { const int e = qq_ / 384, r = qq_ % 384, up = r / 192, r2 = r % 192; u_ = CvU{(up ? wu : wg) + (size_t)e * DM * DEXP, WGU + (size_t)e * 2 * DEXP * DM, DEXP, DEXP, (r2 / 6) * 64, (r2 % 6) * 256, DM, 1 + up}; } else { qq_ -= n_gu; \
                    if (qq_ < n_d) { const int e = qq_ / 192, r = qq_ % 192; u_ = CvU{wd + (size_t)e * DEXP * DM, WD + (size_t)e * DM * DEXP, DM, DM, (r >> 3) * 64, (r & 7) * 256, DEXP, 0}; } else { qq_ -= n_d; \
                    u_ = CvU{wglu, GLU, BW, BW, (qq_ >> 1) * 64, (qq_ & 1) * 256, BW, 0}; } } } } } } while (0)
                __syncthreads();
                int q = bid; int buf = 0; CvU u; float4 r[8];
                if (q < total) { CV_DECODE(q, u); cv_load(u, r, tid); }
                while (q < total) {
                    float* T = sf + buf * (64 * 257);
                    cv_stage(T, r, tid);
                    __syncthreads();
                    const CvU cur = u; const int qn = q + G;
                    if (qn < total) { CV_DECODE(qn, u); cv_load(u, r, tid); }
                    cv_store(cur, T, tid);
                    buf ^= 1; q = qn;
                }
#undef CV_DECODE
                __syncthreads();
            }
            for (int set = 0; set < (lastl ? 1 : 2); ++set) {
                const int L = set ? CTXL : SEQ; float* HR = HRAW + (set ? (size_t)SEQ * 2048 : 0);
                const float* w1 = PT(11) + l * 33 * 64; const float* b1 = PT(12) + l * 64; const float* fr1 = PT(13) + l * 64; const float* w2 = PT(14) + l * 64 * 64; const float* b2 = PT(15) + l * 64;
                const float* fr2 = PT(16) + l * 64; const float* w3 = PT(17) + l * 64 * 2048; const float* decay = PT(18) + l * 2048;
                float* feats = sf; float* h1 = sf + 16 * 33; float* h2 = h1 + 16 * 64;
                float nacc[4] = {0.f, 0.f, 0.f, 0.f};
                for (int base = bid; base < L; base += 16 * G) {
                    __syncthreads();
                    for (int e = tid; e < 16 * 33; e += NTHR) { const int ti = e / 33, fi = e % 33; int t = base + ti * G; if (t > L - 1) t = L - 1;
                        float v;
                        if (fi == 0) v = (float)t / (float)(L - 1);
                        else { const int j = (fi - 1) & 15; const double fr = 1e-4 + (double)j * ((15.0 - 1e-4) / 15.0); const double ang = (2.0 * 3.14159265358979323846 / (double)L) * (double)t * fr; v = fi <= 16 ? (float)cos(ang) : (float)(-sin(ang)); }
                        feats[e] = v; }
                    __syncthreads();
                    { const int j = tid & 63, ti = tid >> 6; float s0 = b1[j], s1 = s0;
_Pragma("unroll 3")
                      for (int i = 0; i < 33; ++i) { const float wv = w1[i * 64 + j]; s0 += feats[ti * 33 + i] * wv; s1 += feats[(ti + 8) * 33 + i] * wv; }
                      const float f1 = fr1[j]; h1[ti * 64 + j] = sinf(f1 * s0); h1[(ti + 8) * 64 + j] = sinf(f1 * s1); }
                    __syncthreads();
                    { const int j = tid & 63, ti = tid >> 6; float s0 = b2[j], s1 = s0;
_Pragma("unroll 4")
                      for (int i = 0; i < 64; ++i) { const float wv = w2[i * 64 + j]; s0 += h1[ti * 64 + i] * wv; s1 += h1[(ti + 8) * 64 + i] * wv; }
                      const float f2 = fr2[j]; h2[ti * 64 + j] = sinf(f2 * s0); h2[(ti + 8) * 64 + j] = sinf(f2 * s1); }
                    __syncthreads();
                    float acc[16][4];
#pragma unroll
                    for (int ti = 0; ti < 16; ++ti) { acc[ti][0] = 0.f; acc[ti][1] = 0.f; acc[ti][2] = 0.f; acc[ti][3] = 0.f; }
#pragma unroll 2
                    for (int i = 0; i < 64; ++i) { const float* wrow = w3 + (size_t)i * 2048 + tid; const float wa = wrow[0], wb = wrow[512], wc2 = wrow[1024], wd2 = wrow[1536];
#pragma unroll
                        for (int ti = 0; ti < 16; ++ti) { const float hv = h2[ti * 64 + i]; acc[ti][0] += hv * wa; acc[ti][1] += hv * wb; acc[ti][2] += hv * wc2; acc[ti][3] += hv * wd2; } }
                    float dk[4];
#pragma unroll
                    for (int k = 0; k < 4; ++k) dk[k] = fabsf(decay[tid + k * 512]);
#pragma unroll
                    for (int ti = 0; ti < 16; ++ti) { const int t = base + ti * G; if (t < L) { const float tn = (float)t / (float)(L - 1);
#pragma unroll
                        for (int k = 0; k < 4; ++k) { const float v = acc[ti][k] * expf(-tn * dk[k]); HR[(size_t)t * 2048 + tid + k * 512] = v; nacc[k] += fabsf(v); } } }
                }
                float* nrp = NORMP + ((size_t)(l * 2 + set) * 256 + bid) * 2048;
#pragma unroll
                for (int k = 0; k < 4; ++k) nrp[tid + k * 512] = nacc[k];
            }
            for (int idx = bid * NTHR + tid; idx < 4096; idx += G * NTHR) { const int n = idx & 63, g = (idx >> 6) & 31, dir = idx >> 11;
                const double are = (double)(PT(24) + l * 4096)[idx], aim = (double)(PT(25) + l * 4096)[idx]; const double lam = are < -1e-4 ? are : -1e-4; const double dt = exp((double)(PT(26) + l * 64)[dir * 32 + g]);
                const double ldre = lam * dt, ldim = aim * dt; LDT[idx] = make_double2(ldre, ldim);
                const double mag = exp(ldre); const double ar = mag * cos(ldim), ai = mag * sin(ldim);
                const double den = lam * lam + aim * aim; const double nr = ar - 1.0, ni = ai; const double fre = (nr * lam + ni * aim) / den, fim = (ni * lam - nr * aim) / den;
                const float* b_re = PT(27) + l * 32 * 64 * 16; const float* b_im = PT(28) + l * 32 * 64 * 16;
#pragma unroll 4
                for (int c = 0; c < 16; ++c) { const double br = (double)b_re[(g * 64 + n) * 16 + c], bi = (double)b_im[(g * 64 + n) * 16 + c]; BBT[idx * 16 + c] = make_float2((float)(fre * br - fim * bi), (float)(fre * bi + fim * br)); }
            }
            for (int e2 = bid * NTHR + tid; e2 < 4096 * 33; e2 += G * NTHR) { const int idx = e2 / 33, k = e2 - idx * 33; const int g = (idx >> 6) & 31, dir = idx >> 11;
                const double are = (double)(PT(24) + l * 4096)[idx], aim = (double)(PT(25) + l * 4096)[idx]; const double lam = are < -1e-4 ? are : -1e-4; const double dt = exp((double)(PT(26) + l * 64)[dir * 32 + g]);
                const double ldre = lam * dt, ldim = aim * dt; const double mk = exp(ldre * k); APW[e2] = make_float2((float)(mk * cos(ldim * k)), (float)(mk * sin(ldim * k))); }
            if (l == 0 && lo == 0) xcd_barrier(bar);
            for (int tok = bid * 8 + wave; tok < NTOK; tok += G * 8) {
                const int r = tok < NLAT ? tok / SEQ : 4; const float* xr = l == 0 ? (tok < NLAT ? x_in + (size_t)tok * DM : ctx_in + (size_t)(tok - NLAT) * DM) : XS + (size_t)tok * DM; const float* gn = norm_mix + l * DM;
                const float* sh = MODl + (size_t)(r * 6 + 0) * DM; const float* sc = MODl + (size_t)(r * 6 + 1) * DM;
                float4 v[8]; float ss = 0.f;
#pragma unroll
                for (int i = 0; i < 8; ++i) v[i] = *(const float4*)(xr + i * 256 + lane * 4);
                if (l > 0) {
                    moe_combine(v, tok, lane, INV, ROWGATE, YEXP, MOD + (size_t)((l - 1) * 5 + r) * 6 * DM + 5 * DM);
#pragma unroll
                    for (int i = 0; i < 8; ++i) *(float4*)(XS + (size_t)tok * DM + i * 256 + lane * 4) = v[i]; }
#pragma unroll
                for (int i = 0; i < 8; ++i) ss += v[i].x * v[i].x + v[i].y * v[i].y + v[i].z * v[i].z + v[i].w * v[i].w;
                ss = wave_sum(ss); const float rs = rsqrtf(ss * (1.0f / DM) + 1e-6f);
#pragma unroll
                for (int i = 0; i < 8; ++i) { const int d = i * 256 + lane * 4; const float4 g4 = *(const float4*)(gn + d), s4 = *(const float4*)(sc + d), h4 = *(const float4*)(sh + d);
                    v[i].x = v[i].x * rs * g4.x * (1.f + s4.x) + h4.x; v[i].y = v[i].y * rs * g4.y * (1.f + s4.y) + h4.y; v[i].z = v[i].z * rs * g4.z * (1.f + s4.z) + h4.z; v[i].w = v[i].w * rs * g4.w * (1.f + s4.w) + h4.w; }
#pragma unroll
                for (int i = 0; i < 8; ++i) { u32x2 w; w.x = pk2(v[i].x, v[i].y); w.y = pk2(v[i].z, v[i].w); *(u32x2*)(HB + (size_t)tok * DM + i * 256 + lane * 4) = w; }
            }
            SEAM(PB + 0);
        }

        if (IN(PB + 1)) for (int rep_ = 0; rep_ < PROBE_REPS(1); ++rep_) {
            PH_BEGIN
            for (int base = bid * 8; base < (lastl ? 1 : 2) * 1024; base += G * 8) {
                const int idx = base + (tid & 7), sl = tid >> 3; const int set = idx >> 10, oc = idx & 1023, o = oc >> 9, c = oc & 511;
                const float* pp = NORMP + (size_t)(l * 2 + set) * 256 * 2048 + o * 1024 + c + (size_t)(sl * 4) * 2048; float sacc = 0.f;
#pragma unroll
                for (int j = 0; j < 4; ++j) { const float p0 = pp[(size_t)j * 2048], p1 = pp[(size_t)j * 2048 + 512]; sacc += (sl * 4 + j < G) ? p0 + p1 : 0.f; }
                sf[sl * 8 + (tid & 7)] = sacc; __syncthreads();
                if (tid < 8) { float t = 0.f;
#pragma unroll 8
                    for (int q = 0; q < 64; ++q) t += sf[q * 8 + tid];
                    NORM[(size_t)(l * 2 + set) * 1024 + oc] = t; }
                __syncthreads(); }
            for (int idx = (G - 1 - bid) * NTHR + tid; idx < 32768; idx += G * NTHR) { const int c = idx & 15, lag = (idx >> 4) & 31, dir = (idx >> 9) & 1, g = idx >> 10;
                const float* c_re = PT(29) + l * 32 * 16 * 64 + (g * 16 + c) * 64; const float* c_im = PT(30) + l * 32 * 16 * 64 + (g * 16 + c) * 64;
                float acc[16];
#pragma unroll
                for (int j = 0; j < 16; ++j) acc[j] = 0.f;
#pragma unroll 2
                for (int n = 0; n < 64; ++n) { const int pi = (dir * 32 + g) * 64 + n; const float2 ap = APW[pi * 33 + lag]; const float cr = c_re[n], ci = c_im[n]; const float wr_ = cr * ap.x - ci * ap.y, wi_ = cr * ap.y + ci * ap.x;
                    const float4* bb = (const float4*)(BBT + pi * 16);
#pragma unroll
                    for (int j = 0; j < 8; ++j) { const float4 b2 = bb[j]; acc[2 * j] += wr_ * b2.x - wi_ * b2.y; acc[2 * j + 1] += wr_ * b2.z - wi_ * b2.w; } }
                float4* o = (float4*)(KTB + (size_t)idx * 16);
                o[0] = make_float4(acc[0], acc[1], acc[2], acc[3]); o[1] = make_float4(acc[4], acc[5], acc[6], acc[7]); o[2] = make_float4(acc[8], acc[9], acc[10], acc[11]); o[3] = make_float4(acc[12], acc[13], acc[14], acc[15]);
            }
            __syncthreads();
            pg8::Gemm g{HB, WIN, DM, DM, DM}; pg8::SchedStd S{68, 55, G, bid, DM, DM}; pg8::EpiWin E{P, LDP};
            pg8::gemm_phase(( LAS unsigned char*)shm, g, S, E);
#if defined(PROBE_BNOEPI)
            { __syncthreads(); pg8::EpiNone E0; pg8::gemm_phase((LAS unsigned char*)shm, g, S, E0); }
#endif
            SEAM(PB + 1);
        }

        if (IN(PB + 2)) for (int rep_ = 0; rep_ < PROBE_REPS(2); ++rep_) {
            PH_BEGIN
            const float* hcw = PT(9) + l * 3 * 1536; const float* hcb = PT(10) + l * 1536; const float* mcw = PT(20) + l * 3 * 1024; const float* mcb = PT(21) + l * 1024;
            const float* scw = PT(34) + l * 3 * 1024; const float* scb = PT(35) + l * 1024;
            for (int unit = bid; unit < 272 * 3; unit += G) { const int seg = unit / 3, kind = unit % 3; const bool lat = seg < 256; const size_t tok0 = lat ? (size_t)seg * 64 : (size_t)NLAT + (size_t)(seg - 256) * 64;
                if (kind < 2) { const int hf = kind;
                    const int c = tid * 2; const int col = (hf ? SSD_OFF + 512 : ML_OFF) + c; const float* w = hf ? scw : mcw; const float* bsp = hf ? scb : mcb; bf16_t* dst = (hf ? XBC : QKB) + tok0 * 1024 + c;
                    const float2 w0 = *(const float2*)(w + c), w1 = *(const float2*)(w + 1024 + c), w2 = *(const float2*)(w + 2048 + c), bb = *(const float2*)(bsp + c);
                    const float osc = (!hf && c >= 512) ? 0.08838834764831845f : 1.0f;
                    const bool hasPrev = !lat && ((tok0 - NLAT) & (CTXL - 1)) != 0, hasNext = !lat && (((tok0 - NLAT) + 63) & (CTXL - 1)) != CTXL - 1;
                    bf16_t* strip = nullptr;
                    if (!hf) { if (c >= 512) strip = KTG + ((size_t)seg * 512 + (c - 512)) * 64; }
                    else { if (c < 512) strip = XTG + ((size_t)seg * 512 + c) * 64; else if (c < 768) strip = BTG + ((size_t)seg * 256 + (c - 512)) * 64; }
                    const bf16_t* pp = P + tok0 * LDP + col;
                    unsigned raw[66];
#pragma unroll
                    for (int t = 0; t < 66; ++t) raw[t] = ((t == 0 && !hasPrev) || (t == 65 && !hasNext)) ? 0u : *(const unsigned*)(pp + (ptrdiff_t)(t - 1) * LDP);
#pragma unroll
                    for (int t8 = 0; t8 < 8; ++t8) { float v0[8], v1[8];
#pragma unroll
                        for (int tt = 0; tt < 8; ++tt) { const int t = t8 * 8 + tt; const unsigned p0 = raw[t], p1 = raw[t + 1], p2 = raw[t + 2];
                            float a0 = bb.x + w0.x * __uint_as_float(p0 << 16) + w1.x * __uint_as_float(p1 << 16) + w2.x * __uint_as_float(p2 << 16);
                            float a1 = bb.y + w0.y * __uint_as_float(p0 & 0xFFFF0000u) + w1.y * __uint_as_float(p1 & 0xFFFF0000u) + w2.y * __uint_as_float(p2 & 0xFFFF0000u);
                            a0 = siluf_(a0) * osc; a1 = siluf_(a1) * osc; v0[tt] = a0; v1[tt] = a1;
                            *(unsigned*)(dst + (size_t)t * 1024) = pk2(a0, a1); }
                        if (strip) { u32x4 s0, s1; s0.x = pk2(v0[0], v0[1]); s0.y = pk2(v0[2], v0[3]); s0.z = pk2(v0[4], v0[5]); s0.w = pk2(v0[6], v0[7]); s1.x = pk2(v1[0], v1[1]); s1.y = pk2(v1[2], v1[3]); s1.z = pk2(v1[4], v1[5]); s1.w = pk2(v1[6], v1[7]);
                            *(u32x4*)(strip + t8 * 8) = s0; *(u32x4*)(strip + 64 + t8 * 8) = s1; } }
                } else {
                    const int c = (tid & 255) * 2, th = tid >> 8; const bf16_t* pp = P + (tok0 + th * 32) * LDP + ML_OFF + 1024 + c; bf16_t* strip = VTG + ((size_t)seg * 512 + c) * 64 + th * 32;
                    unsigned rv[32];
#pragma unroll
                    for (int t = 0; t < 32; ++t) rv[t] = *(const unsigned*)(pp + (size_t)t * LDP);
#pragma unroll
                    for (int t8 = 0; t8 < 4; ++t8) { u32x4 s0, s1;
                        s0.x = (rv[t8 * 8 + 0] & 0xFFFFu) | (rv[t8 * 8 + 1] << 16); s0.y = (rv[t8 * 8 + 2] & 0xFFFFu) | (rv[t8 * 8 + 3] << 16); s0.z = (rv[t8 * 8 + 4] & 0xFFFFu) | (rv[t8 * 8 + 5] << 16); s0.w = (rv[t8 * 8 + 6] & 0xFFFFu) | (rv[t8 * 8 + 7] << 16);
                        s1.x = (rv[t8 * 8 + 0] >> 16) | (rv[t8 * 8 + 1] & 0xFFFF0000u); s1.y = (rv[t8 * 8 + 2] >> 16) | (rv[t8 * 8 + 3] & 0xFFFF0000u); s1.z = (rv[t8 * 8 + 4] >> 16) | (rv[t8 * 8 + 5] & 0xFFFF0000u); s1.w = (rv[t8 * 8 + 6] >> 16) | (rv[t8 * 8 + 7] & 0xFFFF0000u);
                        *(u32x4*)(strip + t8 * 8) = s0; *(u32x4*)(strip + 64 + t8 * 8) = s1; }
                }
            }
            if (!lastl) for (int tok = NLAT + bid; tok < NTOK; tok += G) {
                const int t = (tok - NLAT) & (CTXL - 1); const bool hasL = (t != 0), hasR = (t != CTXL - 1); const bf16_t* pr = P + (size_t)tok * LDP;
                const bf16_t* prL = hasL ? pr - LDP : pr; const bf16_t* prR = hasR ? pr + LDP : pr;
                unsigned short xc[3], xl[3], xr[3];
#pragma unroll
                for (int j = 0; j < 3; ++j) { const int cc = tid + j * 512; xc[j] = pr[HY_OFF + cc]; xl[j] = prL[HY_OFF + cc]; xr[j] = prR[HY_OFF + cc]; }
#pragma unroll
                for (int j = 0; j < 3; ++j) { const int cc = tid + j * 512;
                    float acc = hcb[cc] + hcw[1536 + cc] * bf2f(xc[j]);
                    acc += hasL ? hcw[cc] * bf2f(xl[j]) : 0.f;
                    acc += hasR ? hcw[2 * 1536 + cc] * bf2f(xr[j]) : 0.f;
                    U[(size_t)tok * 1536 + cc] = acc; }
            }
            for (int idx0 = bid * NTHR + tid; idx0 < 16384 * 64; idx0 += 4 * G * NTHR) { u32x4 t4[4];
#pragma unroll
                for (int q = 0; q < 4; ++q) { const int idx = idx0 + q * G * NTHR; const int half = idx & 1, g = (idx >> 1) & 31, tok = idx >> 6;
                    if (idx < 16384 * 64) t4[q] = *(const u32x4*)(P + (size_t)tok * LDP + S5_OFF + g * 16 + half * 8); }
#pragma unroll
                for (int q = 0; q < 4; ++q) { const int idx = idx0 + q * G * NTHR; const int half = idx & 1, g = (idx >> 1) & 31, tok = idx >> 6;
                    if (idx < 16384 * 64) *(u32x4*)(S5A + ((size_t)g * 512 + (tok >> 5)) * 768 + (tok & 31) * 16 + half * 8) = t4[q]; } }
            for (int idx = bid * NTHR + tid; idx < 32 * 512 * 32 * 2; idx += G * NTHR) { const int half = idx & 1, sI = (idx >> 1) & 31, row = (idx >> 6) & 511, g = idx >> 15; const int t = row >> 4, c = row & 15; const int lag = t - sI;
                float v[8];
                if (lag > 0) { const float4* k4 = (const float4*)(KTB + ((size_t)((g * 2 + 0) * 32 + lag) * 16 + c) * 16 + half * 8); const float4 a0 = k4[0], a1 = k4[1]; v[0] = a0.x; v[1] = a0.y; v[2] = a0.z; v[3] = a0.w; v[4] = a1.x; v[5] = a1.y; v[6] = a1.z; v[7] = a1.w; }
                else if (lag < 0) { const float4* k4 = (const float4*)(KTB + ((size_t)((g * 2 + 1) * 32 - lag) * 16 + c) * 16 + half * 8); const float4 a0 = k4[0], a1 = k4[1]; v[0] = a0.x; v[1] = a0.y; v[2] = a0.z; v[3] = a0.w; v[4] = a1.x; v[5] = a1.y; v[6] = a1.z; v[7] = a1.w; }
                else { const float4* k4 = (const float4*)(KTB + ((size_t)((g * 2 + 0) * 32) * 16 + c) * 16 + half * 8); const float4* q4 = (const float4*)(KTB + ((size_t)((g * 2 + 1) * 32) * 16 + c) * 16 + half * 8); const float4 a0 = k4[0], a1 = k4[1], b0 = q4[0], b1 = q4[1];
                    v[0] = a0.x + b0.x; v[1] = a0.y + b0.y; v[2] = a0.z + b0.z; v[3] = a0.w + b0.w; v[4] = a1.x + b1.x; v[5] = a1.y + b1.y; v[6] = a1.z + b1.z; v[7] = a1.w + b1.w; }
                u32x4 w; w.x = pk2(v[0], v[1]); w.y = pk2(v[2], v[3]); w.z = pk2(v[4], v[5]); w.w = pk2(v[6], v[7]);
                *(u32x4*)(S5B + ((size_t)g * 512 + row) * 768 + sI * 16 + half * 8) = w; }
            for (int idx = bid * NTHR + tid; idx < 32 * 512 * 64; idx += G * NTHR) { const int n = idx & 63, row = (idx >> 6) & 511, g = idx >> 15; const int t = row >> 4, c = row & 15;
                const float cr = (PT(29) + l * 32 * 16 * 64)[(g * 16 + c) * 64 + n], ci = (PT(30) + l * 32 * 16 * 64)[(g * 16 + c) * 64 + n];
                const float2 af = APW[((0 * 32 + g) * 64 + n) * 33 + t + 1], ab = APW[((1 * 32 + g) * 64 + n) * 33 + 32 - t];
                bf16_t* d = S5B + ((size_t)g * 512 + row) * 768 + 512 + 2 * n;
                *(unsigned*)d = pk2(cr * af.x - ci * af.y, -(cr * af.y + ci * af.x)); *(unsigned*)(d + 128) = pk2(cr * ab.x - ci * ab.y, -(cr * ab.y + ci * ab.x)); }
            for (int idx = bid * NTHR + tid; idx < 32 * 2 * 64 * 32; idx += G * NTHR) { const int sI = idx & 31, n = (idx >> 5) & 63, dir = (idx >> 11) & 1, g = idx >> 12; const int pi = (dir * 32 + g) * 64 + n;
                const float2 pw = APW[pi * 33 + (dir ? sI : 31 - sI)]; const float4* bb = (const float4*)(BBT + pi * 16);
                float re[16], im[16];
#pragma unroll
                for (int j = 0; j < 8; ++j) { const float4 b2 = bb[j]; re[2 * j] = pw.x * b2.x - pw.y * b2.y; im[2 * j] = pw.x * b2.y + pw.y * b2.x; re[2 * j + 1] = pw.x * b2.z - pw.y * b2.w; im[2 * j + 1] = pw.x * b2.w + pw.y * b2.z; }
                bf16_t* d = S5P + ((size_t)g * 256 + dir * 128 + 2 * n) * 512 + sI * 16;
                u32x4 w0, w1; w0.x = pk2(re[0], re[1]); w0.y = pk2(re[2], re[3]); w0.z = pk2(re[4], re[5]); w0.w = pk2(re[6], re[7]); w1.x = pk2(re[8], re[9]); w1.y = pk2(re[10], re[11]); w1.z = pk2(re[12], re[13]); w1.w = pk2(re[14], re[15]);
                *(u32x4*)d = w0; *(u32x4*)(d + 8) = w1;
                w0.x = pk2(im[0], im[1]); w0.y = pk2(im[2], im[3]); w0.z = pk2(im[4], im[5]); w0.w = pk2(im[6], im[7]); w1.x = pk2(im[8], im[9]); w1.y = pk2(im[10], im[11]); w1.z = pk2(im[12], im[13]); w1.w = pk2(im[14], im[15]);
                *(u32x4*)(d + 512) = w0; *(u32x4*)(d + 520) = w1; }
            {   float* T = sf;
                for (int unit = bid; unit < 4 * 64 * 24; unit += G) { const int b = unit / (64 * 24), r = (unit / 24) % 64, c0 = (unit % 24) * 64; const size_t tok0 = (size_t)b * SEQ + r * 64;
                    __syncthreads();
#pragma unroll
                    for (int i = 0; i < 8; ++i) { const int c = tid & 63, t = (tid >> 6) + 8 * i; T[t * 65 + c] = bf2f(P[(tok0 + t) * LDP + HY_OFF + c0 + c]); }
                    __syncthreads();
                    const int c = tid >> 3, tq = (tid & 7) * 8, cc = c0 + c; const float w0 = hcw[cc], w1 = hcw[1536 + cc], w2 = hcw[3072 + cc], bb = hcb[cc];
                    float o8[8];
#pragma unroll
                    for (int i = 0; i < 8; ++i) { const int t = tq + i; float acc = bb + w1 * T[t * 65 + c]; if (t > 0) acc += w0 * T[(t - 1) * 65 + c]; if (t < 63) acc += w2 * T[(t + 1) * 65 + c]; o8[i] = acc; }
                    float* dst = UT + ((size_t)b * 1536 + cc) * SEQ + r * 64 + tq;
                    *(float4*)dst = make_float4(o8[0], o8[1], o8[2], o8[3]); *(float4*)(dst + 4) = make_float4(o8[4], o8[5], o8[6], o8[7]);
                } }
            if (!lastl) {
                const int L = CTXL; const float* HR = HRAW + (size_t)SEQ * 2048; float* K2 = K2C; const float* nrm = NORM + (size_t)(l * 2 + 1) * 1024;
                const size_t total = (size_t)(2 * L - 1) * 1024;
                for (size_t i = (size_t)bid * NTHR + tid; i < total; i += (size_t)G * NTHR) { const int j = (int)(i >> 10), oc = (int)(i & 1023), o = oc >> 9, c = oc & 511; const int lag = j - (L - 1);
                    const float v = lag >= 0 ? HR[(size_t)lag * 2048 + o * 1024 + c] : HR[(size_t)(-lag) * 2048 + o * 1024 + 512 + c];
                    K2[((size_t)j * 2 + o) * 512 + c] = v / nrm[oc]; }
            }
            {   __syncthreads(); fft_twiddles((float2*)(shm + FFT_X_BYTES), tid);
                for (int oc = bid; oc < 1024; oc += G) hyena_spec_item(oc, HRAW, NORM + (size_t)(l * 2 + 0) * 1024, HSPEC, shm, tid);
                __syncthreads(); }
            SEAM(PB + 2);
        }

        if (IN(PB + 3)) for (int rep_ = 0; rep_ < PROBE_REPS(3); ++rep_) {
            PH_BEGIN
            if (rep_ > 0) { if (bid == 0 && tid == 0) __hip_atomic_store(QCTR + l * 64, 0, __ATOMIC_RELAXED, __HIP_MEMORY_SCOPE_AGENT); xcd_barrier(bar); }
            if (bid < 64) {
                mlstm_state_pass(bid >> 1, bid & 1, P, KTG, VTG, PT(22) + l * 16, CST, NST, MST, shm, tid);
            } else if (bid < 128) {
                { const int ch = bid - 64; const int dir_ = ch & 1, h_ = (ch >> 1) & 7; ssd_state_pass(ch, P, BTG, XTG, -expf(PT(37)[l * 16 + dir_ * 8 + h_]), PT(36)[l * 16 + dir_ * 8 + h_], SSTB, shm, tid); }
            } else if (bid < 160) {
                const int widx = (bid - 128) * 8 + wave; const int dir = widx & 1, g = (widx >> 1) & 31, b = widx >> 6; const int n = lane;
                float2* xb = (float2*)(shm + (size_t)wave * 16640); float2* ctab = xb + 16 * 65;
                const float* a_re = PT(24) + l * 2 * 32 * 64; const float* a_im = PT(25) + l * 2 * 32 * 64; const float* log_dt = PT(26) + l * 64;
                const float* b_re = PT(27) + l * 32 * 64 * 16; const float* b_im = PT(28) + l * 32 * 64 * 16; const float* c_re = PT(29) + l * 32 * 16 * 64; const float* c_im = PT(30) + l * 32 * 16 * 64;
#pragma unroll
                for (int c = 0; c < 16; ++c) ctab[c * 65 + lane] = make_float2(c_re[(g * 16 + c) * 64 + lane], c_im[(g * 16 + c) * 64 + lane]);
                float abr, abi, bbr[16], bbi[16];
                {   const double are = (double)a_re[(dir * 32 + g) * 64 + n], aim = (double)a_im[(dir * 32 + g) * 64 + n];
                    const double lam = are < -1e-4 ? are : -1e-4; const double dt = exp((double)log_dt[dir * 32 + g]);
                    const double mag = exp(lam * dt); const double ar = mag * cos(aim * dt), ai = mag * sin(aim * dt);
                    const double den = lam * lam + aim * aim; const double nr = ar - 1.0, ni = ai;
                    const double fre = (nr * lam + ni * aim) / den, fim = (ni * lam - nr * aim) / den;
                    abr = (float)ar; abi = (float)ai;
#pragma unroll
                    for (int c = 0; c < 16; ++c) { const double br = (double)b_re[(g * 64 + n) * 16 + c], bi = (double)b_im[(g * 64 + n) * 16 + c]; bbr[c] = (float)(fre * br - fim * bi); bbi[c] = (float)(fre * bi + fim * br); }
                }
                float xr = 0.f, xi = 0.f; float* Sout = (dir ? SB : SF) - (size_t)NLAT * BW;
                const int s = lane >> 2, cg = lane & 3;
                for (int i0 = 0; i0 < CTXL; i0 += 16) {
#pragma unroll 4
                    for (int ss = 0; ss < 16; ++ss) {
                        const size_t tok = (size_t)step_tok(b, dir, i0 + ss);
                        const u32x4* up = (const u32x4*)(P + tok * LDP + S5_OFF + g * 16);
                        float t0[8], t1[8]; unpack8(up[0], t0); unpack8(up[1], t1);
                        float bur = 0.f, bui = 0.f;
#pragma unroll
                        for (int c = 0; c < 8; ++c) { bur += t0[c] * bbr[c] + t1[c] * bbr[8 + c]; bui += t0[c] * bbi[c] + t1[c] * bbi[8 + c]; }
                        const float nxr = abr * xr - abi * xi + bur, nxi = abr * xi + abi * xr + bui; xr = nxr; xi = nxi;
                        xb[ss * 65 + lane] = make_float2(xr, xi);
                    }
                    asm volatile("s_waitcnt lgkmcnt(0)" ::: "memory");
                    float y0 = 0.f, y1 = 0.f, y2 = 0.f, y3 = 0.f;
                    for (int nn2 = 0; nn2 < 64; ++nn2) { const float2 xv = xb[s * 65 + nn2];
                        const float2 c0 = ctab[(cg * 4 + 0) * 65 + nn2], c1 = ctab[(cg * 4 + 1) * 65 + nn2], c2 = ctab[(cg * 4 + 2) * 65 + nn2], c3 = ctab[(cg * 4 + 3) * 65 + nn2];
                        y0 += xv.x * c0.x - xv.y * c0.y; y1 += xv.x * c1.x - xv.y * c1.y; y2 += xv.x * c2.x - xv.y * c2.y; y3 += xv.x * c3.x - xv.y * c3.y; }
                    const size_t toks = (size_t)step_tok(b, dir, i0 + s);
                    *(float4*)(Sout + toks * BW + g * 16 + cg * 4) = make_float4(y0, y1, y2, y3);
                    asm volatile("s_waitcnt lgkmcnt(0)" ::: "memory");
                }
                XCTX[((b * 32 + g) * 2 + dir) * 64 + n] = make_float2(xr, xi);
            } else {
                if (bid < 224) {
                    pg8::Gemm gg_{S5A, S5P, 768, 512, 512}; pg8::SchedS5a S_{bid - 160}; pg8::EpiXloc E_{XLOC};
                    pg8::gemm_phase((LAS unsigned char*)shm, gg_, S_, E_);
                    __syncthreads();
                }
                const int nhb = G - 160, hb = bid - 160; const float* bias = PT(19) + l * 1024; const int c = tid;
                const int nitems = lastl ? 0 : 4 * (CTXL / 8);
                for (int it = hb; it < nitems; it += nhb) {
                    int L, tokbase, b, t0; const float* K2;
                    { const int q = it; L = CTXL; tokbase = NLAT; b = q / (CTXL / 8); t0 = (q % (CTXL / 8)) * 8; K2 = K2C; }
                    const float* zb = U + (size_t)(tokbase + b * L) * 1536 + c;
                    float acc[8];
#pragma unroll
                    for (int i = 0; i < 8; ++i) acc[i] = 0.f;
                    const int base = t0 + L - 1;
                    for (int s = 0; s < L; s += 8) {
                        float k[15];
#pragma unroll
                        for (int mm = 0; mm < 15; ++mm) k[mm] = K2[((size_t)(base - s - 7 + mm) * 2 + 0) * 512 + c];
#pragma unroll
                        for (int ds = 0; ds < 8; ++ds) { const float z = zb[(size_t)(s + ds) * 1536];
#pragma unroll
                            for (int i = 0; i < 8; ++i) acc[i] += k[i - ds + 7] * z; }
                    }
#pragma unroll
                    for (int i = 0; i < 8; ++i) { const size_t tok = (size_t)(tokbase + b * L + t0 + i); const float zt = U[tok * 1536 + c]; Z[tok * BW + c] = (acc[i] + bias[c] * zt) * U[tok * 1536 + 512 + c]; }
                }
            }
            {   __syncthreads(); fft_twiddles((float2*)(shm + FFT_X_BYTES), tid);
                int* qslot = (int*)(shm + FFT_X_BYTES + 65536);
                for (;;) { __syncthreads(); if (tid == 0) *qslot = atomicAdd(QCTR + l * 64, 1); __syncthreads(); const int it = *qslot; if (it >= 1024) break;
                    hyena_fft_item(it, UT, HSPEC, PT(19) + l * 1024, YT, shm, tid); }
            }
            SEAM(PB + 3);
        }

        if (IN(PB + 4)) for (int rep_ = 0; rep_ < PROBE_REPS(4); ++rep_) {
            PH_BEGIN
            if (rep_ > 0) { if (bid == 0 && tid == 0) __hip_atomic_store(QCTR + l * 64 + 32, 0, __ATOMIC_RELAXED, __HIP_MEMORY_SCOPE_AGENT); xcd_barrier(bar); }
            if (bid >= G - 32) for (int idx = (bid - (G - 32)) * NTHR + tid; idx < 16384; idx += 32 * NTHR) { const int n = idx & 63, dir = (idx >> 6) & 1, b = (idx >> 7) & 3, g = idx >> 9;
                const float2 a32 = APW[((dir * 32 + g) * 64 + n) * 33 + 32]; float2 X = XCTX[((b * 32 + g) * 2 + dir) * 64 + n];
                const float* __restrict__ xl = XLOC + ((size_t)g * 512 + b * 128) * 256 + dir * 128 + 2 * n; bf16_t* __restrict__ dst = S5A + ((size_t)g * 512 + b * 128) * 768 + 512 + dir * 128 + 2 * n;
#pragma unroll 1
                for (int j0 = 0; j0 < 128; j0 += 16) { float2 xv[16];
#pragma unroll
                    for (int q = 0; q < 16; ++q) { const int j = dir ? 127 - (j0 + q) : j0 + q; xv[q] = *(const float2*)(xl + (size_t)j * 256); }
#pragma unroll
                    for (int q = 0; q < 16; ++q) { const int j = dir ? 127 - (j0 + q) : j0 + q;
                        *(unsigned*)(dst + (size_t)j * 768) = pk2(X.x, X.y);
                        const float nx = a32.x * X.x - a32.y * X.y + xv[q].x, ny = a32.x * X.y + a32.y * X.x + xv[q].y; X.x = nx; X.y = ny; } } }
            {   int* qslot = (int*)(shm + 102400);
                for (;;) { __syncthreads(); if (tid == 0) *qslot = atomicAdd(QCTR + l * 64 + 32, 1); __syncthreads(); const int it = *qslot; if (it >= 32 * 68 + 64 * 68) break;
                    if (it < 32 * 68) { const int chain = it / 68, c = it % 68; mlstm_out_item(chain, c, P, QKB, VTG, PT(22) + l * 16, CST, NST, MST, (chain & 1) ? HBk : HF, shm, tid); }
                    else { const int i2 = it - 32 * 68; const int chain = i2 / 68, c = i2 % 68; const int dir_ = chain & 1, h_ = (chain >> 1) & 7;
                        ssd_out_item(chain, c, P, XBC, XTG, -expf(PT(37)[l * 16 + dir_ * 8 + h_]), PT(36)[l * 16 + dir_ * 8 + h_], SSTB, dir_ ? YB : YF, shm, tid); } }
            }
            __syncthreads();
            {   const float* bias = PT(19) + l * 1024 + 512; const int c = tid;
                const int nitems = lastl ? 0 : 4 * (CTXL / 8);
                for (int it = bid; it < nitems; it += G) {
                    int L, tokbase, b, t0; const float* K2;
                    { const int q = it; L = CTXL; tokbase = NLAT; b = q / (CTXL / 8); t0 = (q % (CTXL / 8)) * 8; K2 = K2C; }
                    const float* zb = Z + (size_t)(tokbase + b * L) * BW + c;
                    float acc[8];
#pragma unroll
                    for (int i = 0; i < 8; ++i) acc[i] = 0.f;
                    const int base = t0 + L - 1;
                    for (int s = 0; s < L; s += 8) {
                        float k[15];
#pragma unroll
                        for (int mm = 0; mm < 15; ++mm) k[mm] = K2[((size_t)(base - s - 7 + mm) * 2 + 1) * 512 + c];
#pragma unroll
                        for (int ds = 0; ds < 8; ++ds) { const float z = zb[(size_t)(s + ds) * BW];
#pragma unroll
                            for (int i = 0; i < 8; ++i) acc[i] += k[i - ds + 7] * z; }
                    }
#pragma unroll
                    for (int i = 0; i < 8; ++i) { const size_t tok = (size_t)(tokbase + b * L + t0 + i); const float zt = Z[tok * BW + c]; Y4[tok * DM + c] = f2bf((acc[i] + bias[c] * zt) * U[tok * 1536 + 1024 + c]); }
                }
            }
            SEAM(PB + 4);
        }

        if (IN(PB + 5)) for (int rep_ = 0; rep_ < PROBE_REPS(5); ++rep_) {
            PH_BEGIN
            const float* ml_norm = PT(23) + l * BW; const float* ssd_d = PT(38) + l * 8; const float* ssd_norm = PT(39) + l * BW; const float* s5_d = PT(31) + l * BW;
            if (bid < 128) {
                pg8::Gemm gg_{S5A, S5B, 768, 768, 768}; pg8::SchedS5b S_{bid}; pg8::EpiS5Out E_{P, s5_d, GG};
                pg8::gemm_phase((LAS unsigned char*)shm, gg_, S_, E_);
                __syncthreads();
            }
            for (int tok = bid * 8 + wave; tok < NTOK; tok += G * 8) {
                const int c0 = lane * 8; const bf16_t* pr = P + (size_t)tok * LDP; const size_t o5 = (size_t)tok * BW + c0;
                float hm[8], ys[8];
                const u32x4 ooq = *(const u32x4*)(pr + ML_OFF + 1536 + c0);
                const float4 g0 = *(const float4*)(ml_norm + c0), g1 = *(const float4*)(ml_norm + c0 + 4), n0 = *(const float4*)(ssd_norm + c0), n1 = *(const float4*)(ssd_norm + c0 + 4);
                { const float4 a0 = *(const float4*)(HF + o5), a1 = *(const float4*)(HF + o5 + 4), b0 = *(const float4*)(HBk + o5), b1 = *(const float4*)(HBk + o5 + 4);
                  hm[0] = a0.x + b0.x; hm[1] = a0.y + b0.y; hm[2] = a0.z + b0.z; hm[3] = a0.w + b0.w; hm[4] = a1.x + b1.x; hm[5] = a1.y + b1.y; hm[6] = a1.z + b1.z; hm[7] = a1.w + b1.w; }
                { const float4 a0 = *(const float4*)(YF + o5), a1 = *(const float4*)(YF + o5 + 4), b0 = *(const float4*)(YB + o5), b1 = *(const float4*)(YB + o5 + 4);
                  float xx[8], zz[8]; unpack8(*(const u32x4*)(XBC + (size_t)tok * 1024 + c0), xx); unpack8(*(const u32x4*)(pr + SSD_OFF + c0), zz); const float dsk = ssd_d[c0 >> 6];
                  ys[0] = a0.x + b0.x; ys[1] = a0.y + b0.y; ys[2] = a0.z + b0.z; ys[3] = a0.w + b0.w; ys[4] = a1.x + b1.x; ys[5] = a1.y + b1.y; ys[6] = a1.z + b1.z; ys[7] = a1.w + b1.w;
#pragma unroll
                  for (int j = 0; j < 8; ++j) ys[j] = (ys[j] + dsk * xx[j]) * siluf_(zz[j]); }
                float s1 = 0.f, s2 = 0.f;
#pragma unroll
                for (int j = 0; j < 8; ++j) { s1 += hm[j] * hm[j]; s2 += ys[j] * ys[j]; }
                s1 += __shfl_xor(s1, 1); s1 += __shfl_xor(s1, 2); s1 += __shfl_xor(s1, 4); s1 += __shfl_xor(s1, 8);
                s2 = wave_sum(s2);
                const float r1 = rsqrtf(s1 * (1.0f / 128.0f) + 1e-6f), r2 = rsqrtf(s2 * (1.0f / BW) + 1e-6f);
                float oo[8]; unpack8(ooq, oo);
                const float gm[8] = {g0.x, g0.y, g0.z, g0.w, g1.x, g1.y, g1.z, g1.w}, gs[8] = {n0.x, n0.y, n0.z, n0.w, n1.x, n1.y, n1.z, n1.w};
                u32x4 w;
                w.x = pk2(hm[0] * r1 * gm[0] * sigmoidf_(oo[0]), hm[1] * r1 * gm[1] * sigmoidf_(oo[1])); w.y = pk2(hm[2] * r1 * gm[2] * sigmoidf_(oo[2]), hm[3] * r1 * gm[3] * sigmoidf_(oo[3]));
                w.z = pk2(hm[4] * r1 * gm[4] * sigmoidf_(oo[4]), hm[5] * r1 * gm[5] * sigmoidf_(oo[5])); w.w = pk2(hm[6] * r1 * gm[6] * sigmoidf_(oo[6]), hm[7] * r1 * gm[7] * sigmoidf_(oo[7]));
                *(u32x4*)(Y4 + (size_t)tok * DM + 512 + c0) = w;
                w.x = pk2(ys[0] * r2 * gs[0], ys[1] * r2 * gs[1]); w.y = pk2(ys[2] * r2 * gs[2], ys[3] * r2 * gs[3]); w.z = pk2(ys[4] * r2 * gs[4], ys[5] * r2 * gs[5]); w.w = pk2(ys[6] * r2 * gs[6], ys[7] * r2 * gs[7]);
                *(u32x4*)(Y4 + (size_t)tok * DM + 1536 + c0) = w;
                if (tok >= NLAT) { const size_t oc = (size_t)(tok - NLAT) * BW + c0; float uu[8]; unpack8(*(const u32x4*)(pr + S5_OFF + c0), uu);
                    const float4 a0 = *(const float4*)(SF + oc), a1 = *(const float4*)(SF + oc + 4), b0 = *(const float4*)(SB + oc), b1 = *(const float4*)(SB + oc + 4), d0 = *(const float4*)(s5_d + c0), d1 = *(const float4*)(s5_d + c0 + 4);
                    float y[8] = {a0.x + b0.x + d0.x * uu[0], a0.y + b0.y + d0.y * uu[1], a0.z + b0.z + d0.z * uu[2], a0.w + b0.w + d0.w * uu[3], a1.x + b1.x + d1.x * uu[4], a1.y + b1.y + d1.y * uu[5], a1.z + b1.z + d1.z * uu[6], a1.w + b1.w + d1.w * uu[7]};
#pragma unroll
                    for (int j = 0; j < 8; ++j) y[j] = 0.5f * y[j] * (1.0f + tanhf(0.7978845608028654f * (y[j] + 0.044715f * y[j] * y[j] * y[j])));
                    w.x = pk2(y[0], y[1]); w.y = pk2(y[2], y[3]); w.z = pk2(y[4], y[5]); w.w = pk2(y[6], y[7]);
                    *(u32x4*)(GG + (size_t)tok * BW + c0) = w; }
            }
            __syncthreads();
            {   float* T = sf;
                for (int unit = (G > 128 ? bid - 128 : bid); unit >= 0 && unit < 4 * 64 * 8; unit += (G > 128 ? G - 128 : G)) { const int b = unit / 512, t0 = ((unit >> 3) & 63) * 64, c0 = (unit & 7) * 64;
                    __syncthreads();
#pragma unroll
                    for (int i = 0; i < 8; ++i) { const int t = tid & 63, c = (tid >> 6) + 8 * i; T[c * 65 + t] = YT[((size_t)b * 512 + c0 + c) * SEQ + t0 + t]; }
                    __syncthreads();
                    const int t = tid >> 3, cq = (tid & 7) * 8;
                    u32x4 w; w.x = pk2(T[(cq + 0) * 65 + t], T[(cq + 1) * 65 + t]); w.y = pk2(T[(cq + 2) * 65 + t], T[(cq + 3) * 65 + t]); w.z = pk2(T[(cq + 4) * 65 + t], T[(cq + 5) * 65 + t]); w.w = pk2(T[(cq + 6) * 65 + t], T[(cq + 7) * 65 + t]);
                    *(u32x4*)(Y4 + ((size_t)b * SEQ + t0 + t) * DM + c0 + cq) = w;
                } }
            SEAM(PB + 5);
        }

        if (IN(PB + 6)) for (int rep_ = 0; rep_ < PROBE_REPS(6); ++rep_) {
            PH_BEGIN
            pg8::Gemm g{GG, GLU, BW, BW, BW}; pg8::SchedStd S{68, 2, G, bid, BW, BW}; pg8::EpiGlu E{GG, PT(33) + l * BW, Y4};
            pg8::gemm_phase((LAS unsigned char*)shm, g, S, E);
            SEAM(PB + 6);
        }
        if (IN(PB + 7)) for (int rep_ = 0; rep_ < PROBE_REPS(7); ++rep_) {
            PH_BEGIN
            pg8::Gemm g{Y4, WBR, DM, BW, BW}; pg8::SchedBranch S{nPanels, 8, G, bid}; pg8::EpiBranch E{P, ACCb};
            pg8::gemm_phase((LAS unsigned char*)shm, g, S, E);
            SEAM(PB + 7);
        }
        if (IN(PB + 8)) for (int rep_ = 0; rep_ < PROBE_REPS(8); ++rep_) {
            PH_BEGIN
            pg8::Gemm g{ACCb, WOUT, DM, DM, DM}; pg8::SchedStd S{nPanels, 8, G, bid, DM, DM}; pg8::EpiResid E{XS, l == 0 ? x_in : (const float*)XS, l == 0 ? ctx_in - (size_t)NLAT * DM : (const float*)XS, MODl, 2};
            pg8::gemm_phase((LAS unsigned char*)shm, g, S, E);
            SEAM(PB + 8);
        }
        if (IN(PB + 9)) for (int rep_ = 0; rep_ < PROBE_REPS(9); ++rep_) {
            PH_BEGIN
            for (int i = bid * NTHR + tid; i < NEXP * MOE_PAD; i += G * NTHR) ROWTOK[i] = -1;
            for (int i = bid * NTHR + tid; i < NTOK * 16; i += G * NTHR) INV[i] = -1;
            const float* wr = PT(42) + (size_t)l * DM * 16; const float* gn = norm_ffn + l * DM;
            for (int tok0 = (bid * 8 + wave) * 4; tok0 < M2; tok0 += G * 32) {
                const int r = tok0 < NLAT ? tok0 / SEQ : 4; const float* xr = XS + (size_t)tok0 * DM;
                const float* sh = MODl + (size_t)(r * 6 + 3) * DM; const float* sc = MODl + (size_t)(r * 6 + 4) * DM;
                float rs[4];
#pragma unroll
                for (int tk = 0; tk < 4; ++tk) { float ss = 0.f;
#pragma unroll 4
                    for (int i = 0; i < 8; ++i) { const float4 t4 = *(const float4*)(xr + (size_t)tk * DM + i * 256 + lane * 4); ss += t4.x * t4.x + t4.y * t4.y + t4.z * t4.z + t4.w * t4.w; }
                    ss = wave_sum(ss); rs[tk] = rsqrtf(ss * (1.0f / DM) + 1e-6f); }
                float lg[4][16];
#pragma unroll
                for (int tk = 0; tk < 4; ++tk)
#pragma unroll
                    for (int e = 0; e < 16; ++e) lg[tk][e] = 0.f;
#pragma unroll 1
                for (int i = 0; i < 8; ++i) { const int d = i * 256 + lane * 4;
                    const float4 g4 = *(const float4*)(gn + d), s4 = *(const float4*)(sc + d), h4 = *(const float4*)(sh + d);
                    float4 xq[4], ww[16];
#pragma unroll
                    for (int tk = 0; tk < 4; ++tk) xq[tk] = *(const float4*)(xr + (size_t)tk * DM + d);
                    const float4* wq = (const float4*)(wr + (size_t)d * 16);
#pragma unroll
                    for (int q = 0; q < 16; ++q) ww[q] = wq[q];
                    float hv[4][4];
#pragma unroll
                    for (int tk = 0; tk < 4; ++tk) { const float4 xv = xq[tk]; const float rr = rs[tk];
                        hv[tk][0] = xv.x * rr * g4.x * (1.f + s4.x) + h4.x; hv[tk][1] = xv.y * rr * g4.y * (1.f + s4.y) + h4.y; hv[tk][2] = xv.z * rr * g4.z * (1.f + s4.z) + h4.z; hv[tk][3] = xv.w * rr * g4.w * (1.f + s4.w) + h4.w;
                        u32x2 w; w.x = pk2(hv[tk][0], hv[tk][1]); w.y = pk2(hv[tk][2], hv[tk][3]); *(u32x2*)(HB + (size_t)(tok0 + tk) * DM + d) = w; }
#pragma unroll
                    for (int q = 0; q < 4; ++q) { const float4 w0 = ww[q * 4 + 0], w1 = ww[q * 4 + 1], w2 = ww[q * 4 + 2], w3 = ww[q * 4 + 3];
#pragma unroll
                        for (int tk = 0; tk < 4; ++tk) { const float hq = hv[tk][q];
                            lg[tk][0] += hq * w0.x; lg[tk][1] += hq * w0.y; lg[tk][2] += hq * w0.z; lg[tk][3] += hq * w0.w; lg[tk][4] += hq * w1.x; lg[tk][5] += hq * w1.y; lg[tk][6] += hq * w1.z; lg[tk][7] += hq * w1.w;
                            lg[tk][8] += hq * w2.x; lg[tk][9] += hq * w2.y; lg[tk][10] += hq * w2.z; lg[tk][11] += hq * w2.w; lg[tk][12] += hq * w3.x; lg[tk][13] += hq * w3.y; lg[tk][14] += hq * w3.z; lg[tk][15] += hq * w3.w; } } }
#pragma unroll
                for (int tk = 0; tk < 4; ++tk) { float mx = -1e30f;
#pragma unroll
                    for (int e = 0; e < 16; ++e) { lg[tk][e] = wave_sum(lg[tk][e]); mx = fmaxf(mx, lg[tk][e]); }
                    float sm = 0.f;
#pragma unroll
                    for (int e = 0; e < 16; ++e) { lg[tk][e] = expf(lg[tk][e] - mx); sm += lg[tk][e]; }
                    const float inv = 1.0f / sm;
                    if (lane == 0) {
#pragma unroll
                        for (int e = 0; e < 16; e += 4) *(float4*)(PROBS + (size_t)(tok0 + tk) * 16 + e) = make_float4(lg[tk][e] * inv, lg[tk][e + 1] * inv, lg[tk][e + 2] * inv, lg[tk][e + 3] * inv); } }
            }
            SEAM(PB + 9);
        }
        if (IN(PB + 10)) for (int rep_ = 0; rep_ < PROBE_REPS(10); ++rep_) {
            PH_BEGIN
            const int nitems = 64 + (lastl ? 0 : 64);
            unsigned long long* keys = (unsigned long long*)shm;
            for (int it = bid; it < nitems; it += G) {
                const int set = it >> 6, e = it & 15, b = (it >> 4) & 3;
                const int n = set ? CTXL : SEQ, cap = set ? 32 : 512, tokbase = set ? NLAT + b * CTXL : b * SEQ;
                __syncthreads();
                for (int i = tid; i < n; i += NTHR) keys[i] = ((unsigned long long)__float_as_uint(PROBS[(size_t)(tokbase + i) * 16 + e]) << 32) | (unsigned long long)(0xFFFFFFFFu - (unsigned)i);
                __syncthreads();
                for (int k = 2; k <= n; k <<= 1)
                    for (int j = k >> 1; j > 0; j >>= 1) {
                        for (int p = tid; p < (n >> 1); p += NTHR) { const int i = ((p & ~(j - 1)) << 1) | (p & (j - 1)); const int m = i | j;
                            const unsigned long long ka = keys[i], kb = keys[m]; const bool desc = ((i & k) == 0);
                            if ((ka < kb) == desc) { keys[i] = kb; keys[m] = ka; } }
                        __syncthreads();
                    }
                for (int r = tid; r < cap; r += NTHR) { const unsigned long long kk = keys[r]; const int row = e * MOE_PAD + (set ? 2048 + b * 32 + r : b * 512 + r);
                    const int tk_ = tokbase + (int)(0xFFFFFFFFu - (unsigned)(kk & 0xFFFFFFFFull)); ROWTOK[row] = tk_; ROWGATE[row] = __uint_as_float((unsigned)(kk >> 32)); INV[tk_ * 16 + e] = row; }
                for (int r = wave; r < cap; r += 8) { const int tok = tokbase + (int)(0xFFFFFFFFu - (unsigned)(keys[r] & 0xFFFFFFFFull)); const int row = e * MOE_PAD + (set ? 2048 + b * 32 + r : b * 512 + r);
                    const u32x4* sp = (const u32x4*)(HB + (size_t)tok * DM); u32x4* dp = (u32x4*)(XG + (size_t)row * DM);
#pragma unroll
                    for (int i = 0; i < 4; ++i) dp[i * 64 + lane] = sp[i * 64 + lane]; }
            }
            {   const int pad0 = lastl ? 2048 : MOE_ROWS, npad = MOE_PAD - pad0;
                for (int R = bid * 8 + wave; R < NEXP * npad; R += G * 8) { const int e = R / npad, rr = pad0 + R % npad; u32x4* dp = (u32x4*)(XG + ((size_t)e * MOE_PAD + rr) * DM);
#pragma unroll
                    for (int i = 0; i < 4; ++i) dp[i * 64 + lane] = (u32x4){0u, 0u, 0u, 0u}; } }
            SEAM(PB + 10);
        }
        if (IN(PB + 12)) for (int rep_ = 0; rep_ < PROBE_REPS(12); ++rep_) {
            PH_BEGIN
            pg8::Gemm g{XG, WGU, DM, DM, DM}; pg8::SchedMoe S{lastl ? 8 : 9, 12, G, bid, DM, DM, 2 * DEXP}; pg8::EpiMoe1 E{HID};
            pg8::gemm_phase((LAS unsigned char*)shm, g, S, E);
            SEAM(PB + 12);
        }
        if (IN(PB + 13)) for (int rep_ = 0; rep_ < PROBE_REPS(13); ++rep_) {
            PH_BEGIN
            pg8::Gemm g{HID, WD, DEXP, DEXP, DEXP}; pg8::SchedMoe S{lastl ? 8 : 9, 8, G, bid, DEXP, DEXP, DM}; pg8::EpiMoeY E{YEXP};
            pg8::gemm_phase((LAS unsigned char*)shm, g, S, E);
            SEAM(PB + 13);
        }

}

__global__ __launch_bounds__(NTHR, 2) void fwd(Args a) {
    extern __shared__ __attribute__((aligned(16))) unsigned char shm[];
    const int bid = blockIdx.x, G = gridDim.x;
    float* const sf = (float*)shm;
    volatile LAS unsigned* xbw = (volatile LAS unsigned*)((LAS unsigned char*)shm + (LDS_BYTES - 16));
    if (threadIdx.x == 0) { xbw[0] = 0u; xbw[1] = 0u; xbw[2] = 0u; xbw[3] = 0u; }
    const float** const ptab = (const float**)(shm + (LDS_BYTES - 16 - 512));
    if (threadIdx.x == 0) {
#pragma unroll
        for (int i = 0; i < 47; ++i) ptab[i] = a.in[i]; }
    __syncthreads();
    XcdBarrier bar = xcd_barrier_post((unsigned*)(a.ws + O_BAR), xbw);
    const int lo = a.ph_lo, hi = a.ph_hi;
    if (IN(0)) {
        PH_BEGIN
        {
            __syncthreads();
            for (int i = tid; i < 5 * DM; i += NTHR) { const int r = i >> 11, k = i & (DM - 1); const float v = r < 4 ? c_in[r * DM + k] : cctx_in[k]; sf[i] = siluf_(v); }
            __syncthreads();
            float* red = sf + 5 * DM;
            for (int unit = bid; unit < 2 * 96; unit += G) { const int l = unit / 96, j = (unit % 96) * 128 + (tid & 127), kq = tid >> 7;
                const float* w = ada_w + (size_t)l * DM * (6 * DM) + (size_t)(kq * 512) * (6 * DM) + j; const float* sv = sf + kq * 512;
                float a0 = 0.f, a1 = 0.f, a2 = 0.f, a3 = 0.f, a4 = 0.f;
#pragma unroll 8
                for (int k = 0; k < 512; ++k) { const float wv = w[(size_t)k * (6 * DM)]; a0 += sv[k] * wv; a1 += sv[DM + k] * wv; a2 += sv[2 * DM + k] * wv; a3 += sv[3 * DM + k] * wv; a4 += sv[4 * DM + k] * wv; }
                __syncthreads();
                { float* rp = red + (kq * 5) * 128 + (tid & 127); rp[0] = a0; rp[128] = a1; rp[256] = a2; rp[384] = a3; rp[512] = a4; }
                __syncthreads();
                if (tid < 128) { const float bb = ada_b[l * 6 * DM + j]; float* o = MOD + (size_t)l * 5 * 6 * DM + j;
#pragma unroll
                    for (int r = 0; r < 5; ++r) o[(size_t)r * 6 * DM] = ((red[(0 * 5 + r) * 128 + tid] + red[(1 * 5 + r) * 128 + tid]) + (red[(2 * 5 + r) * 128 + tid] + red[(3 * 5 + r) * 128 + tid])) + bb; }
            }
        }
    }

    layer_body<0>(a, bar, lo, hi, bid, G, shm, sf, ptab);
    layer_body<1>(a, bar, lo, hi, bid, G, shm, sf, ptab);
    if (IN(33)) {
        PH_BEGIN
        const float* gn = PT(46);
        for (int tok = bid * 8 + wave; tok < NLAT; tok += G * 8) {
            const float* xr = XS + (size_t)tok * DM; float4 v[8]; float ss = 0.f;
#pragma unroll
            for (int i = 0; i < 8; ++i) v[i] = *(const float4*)(xr + i * 256 + lane * 4);
            moe_combine(v, tok, lane, INV, ROWGATE, YEXP, MOD + (size_t)(1 * 5 + tok / SEQ) * 6 * DM + 5 * DM);
#pragma unroll
            for (int i = 0; i < 8; ++i) {                 ss += v[i].x * v[i].x + v[i].y * v[i].y + v[i].z * v[i].z + v[i].w * v[i].w; }
            ss = wave_sum(ss); const float rs = rsqrtf(ss * (1.0f / DM) + 1e-6f);
#pragma unroll
            for (int i = 0; i < 8; ++i) { const int d = i * 256 + lane * 4; const float4 g4 = *(const float4*)(gn + d);
                *(float4*)(a.out + (size_t)tok * DM + d) = make_float4(v[i].x * rs * g4.x, v[i].y * rs * g4.y, v[i].z * rs * g4.z, v[i].w * rs * g4.w); }
        }
    }
#undef IN
#undef SEAM
}


extern "C" void kernel_launch(void* const* d_in, const int* in_sizes, int n_in, void* d_out, int out_size, void* d_ws, size_t ws_size, hipStream_t stream) {
    static int grid = 0;
    if (grid == 0) {
        if (n_in != 47 || ws_size < WS_END) { fprintf(stderr, "kernel_launch: expected 47 inputs and >= %zu bytes of workspace; got %d, %zu\n", (size_t)WS_END, n_in, ws_size); grid = -1; return; }
        int dev = 0, cus = 0;
        if (hipGetDevice(&dev) != hipSuccess || hipDeviceGetAttribute(&cus, hipDeviceAttributeMultiprocessorCount, dev) != hipSuccess) { grid = -1; return; }
        if (hipFuncSetAttribute((const void*)fwd, hipFuncAttributeMaxDynamicSharedMemorySize, LDS_BYTES) != hipSuccess) { fprintf(stderr, "kernel_launch: hipFuncSetAttribute failed\n"); grid = -1; return; }
        int per_cu = 0;
        if (hipOccupancyMaxActiveBlocksPerMultiprocessor(&per_cu, (const void*)fwd, NTHR, LDS_BYTES) != hipSuccess || per_cu < 1) fprintf(stderr, "kernel_launch: occupancy query reports %d\n", per_cu);
        (void)hipGetLastError();
        grid = cus > 256 ? 256 : cus;
        if (grid < 224) { fprintf(stderr, "kernel_launch: needs >= 224 CUs (got %d)\n", grid); grid = -1; return; }
    }
    if (grid < 0) return;
    (void)hipMemsetAsync((char*)d_ws, 0, O_ZERO_END, stream);
    Args a{};
    for (int i = 0; i < 47; ++i) a.in[i] = (const float*)d_in[i];
    a.out = (float*)d_out; a.ws = (unsigned char*)d_ws;
#if MK_ONE_LAUNCH
    a.ph_lo = 0; a.ph_hi = 64;
    hipLaunchKernelGGL(fwd, dim3(grid), dim3(NTHR), LDS_BYTES, stream, a);
#else
    const int ids[] = {0, 1,2,3,4,5,6,7,8,9,10,11,12,13,14, 17,18,19,20,21,22,23,24,25,26,27,28,29,30, 33};
    for (int k = 0; k < (int)(sizeof(ids) / sizeof(ids[0])); ++k) { a.ph_lo = ids[k]; a.ph_hi = ids[k] + 1; hipLaunchKernelGGL(fwd, dim3(grid), dim3(NTHR), LDS_BYTES, stream, a); }
#endif
}
```

```cpp
#include <hip/hip_runtime.h>
#include <stdint.h>
#include <stdio.h>

#ifndef PROBE_MASK
#define PROBE_MASK 0
#endif
#ifndef PROBE_SP
#define PROBE_SP 1
#endif
#define PROBE_REPS(k) ((((PROBE_MASK) >> (k)) & 1) + 1)
#ifndef MK_ONE_LAUNCH
#define MK_ONE_LAUNCH 1
#endif

#define DM 2048
#define NB 4
#define SEQ 4096
#define CTXL 256
#define BW 512
#define NLAT 16384
#define NCTX 1024
#define NTOK 17408
#define IN_W 13856
#define LDP 14080
#define HY_OFF 0
#define ML_OFF 1536
#define S5_OFF 3600
#define SSD_OFF 4112
#define GATE_OFF 5664
#define NEXP 16
#define DEXP 1536
#define MOE_ROWS 2176
#define MOE_PAD 2304
#define NTHR 512
#define LDS_BYTES 147456
#define LAS __attribute__((address_space(3)))

typedef unsigned short bf16_t;
typedef short bf16x8 __attribute__((ext_vector_type(8)));
typedef float f32x4 __attribute__((ext_vector_type(4)));
typedef unsigned u32x4 __attribute__((ext_vector_type(4)));
typedef unsigned u32x2 __attribute__((ext_vector_type(2)));

#define XB_TMO      128
#define XB_XCNT(j)  (256  + 64 * (j))
#define XB_XSUB(j)  (1280 + 64 * (j))
#define XB_XGEN(j)  (2304 + 64 * (j))
#define XB_TOP      3328
#define XB_TOPGEN   3392
#define XCD_BAR_WORDS 3456
#define XB_SPIN_CAP (1u << 18)
__device__ __forceinline__ unsigned xb_ld(unsigned* p)              { return __hip_atomic_load(p, __ATOMIC_RELAXED, __HIP_MEMORY_SCOPE_AGENT); }
__device__ __forceinline__ unsigned xb_add(unsigned* p, unsigned v) { return __hip_atomic_fetch_add(p, v, __ATOMIC_RELAXED, __HIP_MEMORY_SCOPE_AGENT); }
__device__ __forceinline__ unsigned xb_xcc_id() { return (unsigned)__builtin_amdgcn_s_getreg((3 << 11) | 20) & 0xFu; }
#define XB_SPIN(cond, bar) do { unsigned _sp = 0; while (cond) { __builtin_amdgcn_s_sleep(1); \
    if ((++_sp & 255u) == 0u) { if (xb_ld(&(bar)[XB_TMO])) break; if (_sp > XB_SPIN_CAP) { atomicAdd(&(bar)[XB_TMO], 1u); break; } } } } while (0)
struct XcdBarrier { unsigned* bar; unsigned x; volatile LAS unsigned* st; };
__device__ __forceinline__ XcdBarrier xcd_barrier_post(unsigned* bar, volatile LAS unsigned* st) {
    XcdBarrier b; b.bar = bar; b.x = xb_xcc_id(); b.st = st;
    if (threadIdx.x == 0) (void)xb_add(&bar[XB_XCNT(b.x)], 1u);
    return b;
}
__device__ __forceinline__ void xcd_barrier_complete(unsigned* bar, unsigned x, unsigned& nloc, unsigned& nx) {
    const unsigned G = gridDim.x * gridDim.y * gridDim.z;
    unsigned sum, cnt, mine, sp = 0u;
    for (;;) {
        sum = 0u; cnt = 0u; mine = 0u;
#pragma unroll
        for (unsigned j = 0; j < 16; ++j) { const unsigned c = xb_ld(&bar[XB_XCNT(j)]); sum += c; cnt += (c > 0u) ? 1u : 0u; mine = (j == x) ? c : mine; }
        if (sum == G) break;
        __builtin_amdgcn_s_sleep(1);
        if ((++sp & 255u) == 0u) { if (xb_ld(&bar[XB_TMO])) break; if (sp > XB_SPIN_CAP) { atomicAdd(&bar[XB_TMO], 1u); break; } }
    }
    nloc = mine > 0u ? mine : 1u; nx = cnt > 0u ? cnt : 1u;
}
__device__ __forceinline__ void xcd_barrier(const XcdBarrier& b) {
    asm volatile("s_waitcnt vmcnt(0)" ::: "memory");
    __syncthreads();
    if (threadIdx.x == 0) {
        unsigned* bar = b.bar;
        __builtin_amdgcn_s_waitcnt(0);
        unsigned nloc = b.st[0], nx = b.st[1];
        if (nloc == 0u) { xcd_barrier_complete(bar, b.x, nloc, nx); b.st[0] = nloc; b.st[1] = nx; }
        const unsigned old = xb_add(&bar[XB_XSUB(b.x)], 1u);
        const unsigned gen = old / nloc;
        if (old + 1u == (gen + 1u) * nloc) {
            __builtin_amdgcn_fence(__ATOMIC_RELEASE, "agent");
            asm volatile("s_waitcnt vmcnt(0)" ::: "memory");
            const unsigned og = xb_add(&bar[XB_TOP], 1u);
            const unsigned tg = og / nx;
            if (og + 1u == (tg + 1u) * nx) xb_add(&bar[XB_TOPGEN], 1u);
            else XB_SPIN(xb_ld(&bar[XB_TOPGEN]) == tg, bar);
            __builtin_amdgcn_fence(__ATOMIC_ACQUIRE, "agent");
            xb_add(&bar[XB_XGEN(b.x)], 1u);
            asm volatile("s_waitcnt vmcnt(0)" ::: "memory");
        } else {
            XB_SPIN(xb_ld(&bar[XB_XGEN(b.x)]) == gen, bar);
            __builtin_amdgcn_fence(__ATOMIC_ACQUIRE, "agent");
            asm volatile("s_waitcnt vmcnt(0)" ::: "memory");
        }
    }
    __syncthreads();
}

__device__ __forceinline__ unsigned short f2bf(float f) { unsigned u = __float_as_uint(f); u += 0x7FFFu + ((u >> 16) & 1u); return (unsigned short)(u >> 16); }
__device__ __forceinline__ float bf2f(unsigned short b) { return __uint_as_float(((unsigned)b) << 16); }
__device__ __forceinline__ unsigned pk2(float lo, float hi) { unsigned r; asm("v_cvt_pk_bf16_f32 %0, %1, %2" : "=v"(r) : "v"(lo), "v"(hi)); return r; }
__device__ __forceinline__ float sigmoidf_(float x) { return 1.0f / (1.0f + expf(-x)); }
__device__ __forceinline__ float siluf_(float x) { return x / (1.0f + expf(-x)); }
__device__ __forceinline__ float wave_sum(float v) {
#pragma unroll
    for (int o = 32; o >= 1; o >>= 1) v += __shfl_xor(v, o);
    return v;
}
__device__ __forceinline__ const float* uptr(const float* p) { const unsigned long long v = (unsigned long long)p;
    const unsigned lo = __builtin_amdgcn_readfirstlane((unsigned)v), hi = __builtin_amdgcn_readfirstlane((unsigned)(v >> 32)); return (const float*)(((unsigned long long)hi << 32) | lo); }
#define PT(k) uptr(ptab[k])
__device__ __forceinline__ int step_tok(int b, int dir, int i) {
    if (i < CTXL) { const int tt = dir ? (CTXL - 1 - i) : i; return NLAT + b * CTXL + tt; }
    const int j = i - CTXL; const int tt = dir ? (SEQ - 1 - j) : j; return b * SEQ + tt;
}
__device__ __forceinline__ void unpack8(const u32x4 w, float (&f)[8]) {
    f[0] = __uint_as_float(w.x << 16); f[1] = __uint_as_float(w.x & 0xFFFF0000u); f[2] = __uint_as_float(w.y << 16); f[3] = __uint_as_float(w.y & 0xFFFF0000u);
    f[4] = __uint_as_float(w.z << 16); f[5] = __uint_as_float(w.z & 0xFFFF0000u); f[6] = __uint_as_float(w.w << 16); f[7] = __uint_as_float(w.w & 0xFFFF0000u);
}

namespace pg8 {
constexpr int BM = 256, BK = 64, HALF = 128, HTB = HALF * BK * 2, STAGE_BYTES = 8 * HTB, NXCD = 8, WGM = 8;
__host__ __device__ __forceinline__ int lds_byte(int r, int c) { const int st = (r >> 4) * 2 + (c >> 5), rr = r & 15, cc = c & 31, ob = rr * 64 + cc * 2; return st * 1024 + (ob ^ (((ob >> 9) & 1) << 5)); }
__host__ __device__ __forceinline__ void stage_rc(int b, int& R, int& C) { const int st = b / 1024, sb = b % 1024, swz = sb ^ (((sb >> 9) & 1) << 5); R = (st >> 1) * 16 + swz / 64; C = (st & 1) * 32 + (swz % 64) / 2; }
__host__ __device__ __forceinline__ int perm32(int rho) { const int n = rho >> 4, i = rho & 15; return 8 * (i >> 2) + 4 * n + (i & 3); }
struct Unit { int pm, pn, z, k; long long ao, bo; };
struct Gemm { const bf16_t* A; const bf16_t* Bt; int lda, ldb, K; };

__device__ __forceinline__ void tile_of(int wgid, int nM, int nN, int& pm, int& pn) {
    const int nwg = nM * nN; { const int q = nwg / NXCD, r = nwg % NXCD, xcd = wgid % NXCD, off = wgid / NXCD; wgid = (xcd < r ? xcd * (q + 1) : r * (q + 1) + (xcd - r) * q) + off; }
    const int nig = WGM * nN, gid = wgid / nig, fm = gid * WGM, gsz = (nM - fm) < WGM ? (nM - fm) : WGM;
    pm = fm + ((wgid % nig) % gsz); pn = (wgid % nig) / gsz;
}
struct SchedStd {
    int nM, nN, G, c, lda, ldb;
    __device__ __forceinline__ bool next(int i, Unit& u) const { const long L = (long)i * G + c; if (L >= (long)nM * nN) return false; tile_of((int)L, nM, nN, u.pm, u.pn); u.z = 0; u.k = 0;
        u.ao = (long long)u.pm * BM * lda * 2; u.bo = (long long)u.pn * BM * ldb * 2; return true; }
    __device__ __forceinline__ void a_ready(const Unit&) const {}
    __device__ __forceinline__ void done(const Unit&) const {}
};
struct SchedBranch {
    int nM, nN, G, c;
    __device__ __forceinline__ bool next(int i, Unit& u) const { const long L = (long)(i >> 2) * G + c; if (L >= (long)nM * nN) return false; tile_of((int)L, nM, nN, u.pm, u.pn); u.z = 0; u.k = i & 3;
        u.ao = ((long long)u.pm * BM * DM + u.k * BW) * 2; u.bo = ((long long)u.k * DM + u.pn * BM) * BW * 2; return true; }
    __device__ __forceinline__ void a_ready(const Unit&) const {}
    __device__ __forceinline__ void done(const Unit&) const {}
};
struct SchedMoe {
    int nPm, nPn, G, c, lda, ldb, nBrows;
    __device__ __forceinline__ bool next(int i, Unit& u) const { const long L = (long)i * G + c; const int per = nPm * nPn; if (L >= (long)NEXP * per) return false; const int e = (int)(L / per), rem = (int)(L % per);
        u.z = e; u.k = 0; u.pm = rem % nPm; u.pn = rem / nPm; u.ao = ((long long)e * MOE_PAD + u.pm * BM) * lda * 2; u.bo = ((long long)e * nBrows + u.pn * BM) * ldb * 2; return true; }
    __device__ __forceinline__ void a_ready(const Unit&) const {}
    __device__ __forceinline__ void done(const Unit&) const {}
};

typedef f32x4 Acc[2][2][4][2];
template <class Epi, class Sched>
__device__ __forceinline__ void gemm_phase(LAS unsigned char* lds, const Gemm g, const Sched& S, const Epi& E) {
    int tid = threadIdx.x; asm volatile("" : "+v"(tid));
    const int wid = __builtin_amdgcn_readfirstlane(tid >> 6), lane = tid & 63, wr = wid >> 2, wc = wid & 3, fr = lane & 15, fq = lane >> 4;
    const int K = g.K, nt = K / BK;
    unsigned voffA[2], voffB[2];
#pragma unroll
    for (int i = 0; i < 2; ++i) { int R, C; stage_rc(tid * 16 + i * 8192, R, C); const int Rb = Epi::PERM ? ((R & ~31) + perm32(R & 31)) : R;
        voffA[i] = (unsigned)(R * g.lda + C) * 2u; voffB[i] = (unsigned)(Rb * g.ldb + C) * 2u; }
    const size_t kstep = (size_t)(BK * 2);
    const size_t hstepA = (size_t)HALF * g.lda * 2, hstepB = (size_t)HALF * g.ldb * 2;
    const unsigned ldsw = (unsigned)wid * 1024u;
    const int aoff = lds_byte(wr * 64 + fr, fq * 8), boff = lds_byte(wc * 32 + fr, fq * 8);
#define PG8_SA(b, h) (((b) * 2 + (h)) * HTB)
#define PG8_SB(b, h) ((4 + (b) * 2 + (h)) * HTB)
#define PG8_STAGE(bufoff, gbase, voff) do { _Pragma("unroll") for (int _i = 0; _i < 2; ++_i) \
        __builtin_amdgcn_global_load_lds((const unsigned*)((const char*)(gbase) + (voff)[_i]), (LAS unsigned*)(lds + (bufoff) + ldsw + _i * 8192), 16, 0, 0); } while (0)
#define PG8_LDA(dst, b, h) do { _Pragma("unroll") for (int m = 0; m < 4; ++m) _Pragma("unroll") for (int k = 0; k < 2; ++k) dst[m][k] = *(const LAS bf16x8*)(lds + PG8_SA(b, h) + aoff + m * 2048 + k * 1024); } while (0)
#define PG8_LDB(dst, b, h) do { _Pragma("unroll") for (int n = 0; n < 2; ++n) _Pragma("unroll") for (int k = 0; k < 2; ++k) dst[n][k] = *(const LAS bf16x8*)(lds + PG8_SB(b, h) + boff + n * 2048 + k * 1024); } while (0)
#define PG8_MMA(ai, bj, At, Bt) do { __builtin_amdgcn_s_setprio(1); _Pragma("unroll") for (int m = 0; m < 4; ++m) _Pragma("unroll") for (int n = 0; n < 2; ++n) _Pragma("unroll") for (int k = 0; k < 2; ++k) \
        acc[ai][bj][m][n] = __builtin_amdgcn_mfma_f32_16x16x32_bf16(Bt[n][k], At[m][k], acc[ai][bj][m][n], 0, 0, 0); __builtin_amdgcn_s_setprio(0); } while (0)
#define PG8_WAIT_V(n) asm volatile("s_waitcnt vmcnt(" #n ")" ::: "memory")
#define PG8_WAIT_L(n) asm volatile("s_waitcnt lgkmcnt(" #n ")" ::: "memory")
#define PG8_BAR __builtin_amdgcn_s_barrier()
#define PG8_SCHED __builtin_amdgcn_sched_barrier(0)
    Unit cur, nxt; int ui = 0;
    if (!S.next(0, cur)) return;
    Acc acc;
#pragma unroll
    for (int a = 0; a < 2; ++a)
#pragma unroll
        for (int b = 0; b < 2; ++b)
#pragma unroll
            for (int m = 0; m < 4; ++m)
#pragma unroll
                for (int n = 0; n < 2; ++n) acc[a][b][m][n] = (f32x4){0.f, 0.f, 0.f, 0.f};
    bf16x8 At[4][2], B0[2][2], B1[2][2];
    const char* cA = (const char*)g.A + cur.ao; const char* cB = (const char*)g.Bt + cur.bo;
    S.a_ready(cur);
    PG8_STAGE(PG8_SB(0, 0), cB, voffB); PG8_STAGE(PG8_SA(0, 0), cA, voffA); PG8_STAGE(PG8_SB(0, 1), cB + hstepB, voffB); PG8_STAGE(PG8_SA(0, 1), cA + hstepA, voffA);
    if (wr == 1) PG8_BAR;
    PG8_WAIT_V(4); PG8_BAR;
    PG8_STAGE(PG8_SB(1, 0), cB + kstep, voffB); PG8_STAGE(PG8_SA(1, 0), cA + kstep, voffA); PG8_STAGE(PG8_SB(1, 1), cB + hstepB + kstep, voffB);
    PG8_WAIT_V(6); PG8_BAR;
    for (;;) {
        const bool has_next = S.next(ui + 1, nxt);
        const char* nA = has_next ? (const char*)g.A + nxt.ao : cA; const char* nB = has_next ? (const char*)g.Bt + nxt.bo : cB;
        for (int t = 0; t < nt; t += 2) {
            const bool last = (t == nt - 2);
            const char* a1 = cA + (size_t)(t + 1) * kstep;
            const char* a2 = last ? nA : cA + (size_t)(t + 2) * kstep; const char* b2 = last ? nB : cB + (size_t)(t + 2) * kstep;
            const char* a3 = a2 + kstep; const char* b3 = b2 + kstep;
            if (last && has_next) S.a_ready(nxt);
            PG8_LDB(B0, 0, 0); PG8_SCHED; PG8_LDA(At, 0, 0); PG8_STAGE(PG8_SA(1, 1), a1 + hstepA, voffA);
            PG8_WAIT_L(8); PG8_BAR; PG8_WAIT_L(0); PG8_MMA(0, 0, At, B0); PG8_BAR; PG8_SCHED;
            PG8_LDB(B1, 0, 1); PG8_STAGE(PG8_SB(0, 0), b2, voffB);
            PG8_BAR; PG8_WAIT_L(0); PG8_MMA(0, 1, At, B1); PG8_BAR;
            PG8_LDA(At, 0, 1); PG8_STAGE(PG8_SA(0, 0), a2, voffA);
            PG8_BAR; PG8_WAIT_L(0); PG8_MMA(1, 0, At, B0); PG8_BAR; PG8_SCHED;
            PG8_STAGE(PG8_SB(0, 1), b2 + hstepB, voffB);
            PG8_WAIT_V(6); PG8_BAR; PG8_MMA(1, 1, At, B1); PG8_BAR;
            PG8_LDB(B0, 1, 0); PG8_SCHED; PG8_LDA(At, 1, 0); PG8_STAGE(PG8_SA(0, 1), a2 + hstepA, voffA);
            PG8_WAIT_L(8); PG8_BAR; PG8_WAIT_L(0); PG8_MMA(0, 0, At, B0); PG8_BAR; PG8_SCHED;
            PG8_LDB(B1, 1, 1); PG8_STAGE(PG8_SB(1, 0), b3, voffB);
            PG8_BAR; PG8_WAIT_L(0); PG8_MMA(0, 1, At, B1); PG8_BAR;
            PG8_LDA(At, 1, 1); PG8_STAGE(PG8_SA(1, 0), a3, voffA);
            PG8_BAR; PG8_WAIT_L(0); PG8_MMA(1, 0, At, B0); PG8_BAR; PG8_SCHED;
            PG8_STAGE(PG8_SB(1, 1), b3 + hstepB, voffB);
            PG8_WAIT_V(6); PG8_BAR; PG8_MMA(1, 1, At, B1); PG8_BAR;
        }
        const bool keep = E(acc, cur, wr, wc, fr, fq); S.done(cur);
        if (!has_next) break;
        if (!keep) {
#pragma unroll
        for (int a = 0; a < 2; ++a)
#pragma unroll
            for (int b = 0; b < 2; ++b)
#pragma unroll
                for (int m = 0; m < 4; ++m)
#pragma unroll
                    for (int n = 0; n < 2; ++n) acc[a][b][m][n] = (f32x4){0.f, 0.f, 0.f, 0.f};
        }
        cur = nxt; cA = nA; cB = nB; ++ui;
    }
    PG8_WAIT_V(0);
    if (wr == 0) PG8_BAR;
    PG8_BAR;
#undef PG8_SA
#undef PG8_SB
#undef PG8_STAGE
#undef PG8_LDA
#undef PG8_LDB
#undef PG8_MMA
#undef PG8_WAIT_V
#undef PG8_WAIT_L
#undef PG8_BAR
#undef PG8_SCHED
}

struct EpiBf16Store {
    static constexpr bool PERM = true;
    bf16_t* O; int ldc;
    __device__ __forceinline__ bool operator()(Acc& acc, const Unit& u, int wr, int wc, int fr, int fq) const {
        const int row0 = u.pm * BM + wr * 64 + fr, col0 = u.pn * BM + wc * 32 + 8 * fq;
#pragma unroll
        for (int ai = 0; ai < 2; ++ai)
#pragma unroll
            for (int m = 0; m < 4; ++m) { bf16_t* rowp = O + (size_t)(row0 + ai * HALF + m * 16) * ldc + col0;
#pragma unroll
                for (int bj = 0; bj < 2; ++bj) { const f32x4 v0 = acc[ai][bj][m][0], v1 = acc[ai][bj][m][1];
                    u32x4 w; w.x = pk2(v0[0], v0[1]); w.y = pk2(v0[2], v0[3]); w.z = pk2(v1[0], v1[1]); w.w = pk2(v1[2], v1[3]);
                    *(u32x4*)(rowp + bj * HALF) = w; } }
        return false;
    }
};
struct EpiWin {
    static constexpr bool PERM = true;
    bf16_t* O; int ldc;
    __device__ __forceinline__ bool operator()(Acc& acc, const Unit& u, int wr, int wc, int fr, int fq) const {
        const int row0 = u.pm * BM + wr * 64 + fr, col0 = u.pn * BM + wc * 32 + 8 * fq;
#pragma unroll
        for (int bj = 0; bj < 2; ++bj) { const bool gate = (col0 + bj * HALF) >= GATE_OFF;
#pragma unroll
            for (int ai = 0; ai < 2; ++ai)
#pragma unroll
                for (int m = 0; m < 4; ++m) { f32x4 v0 = acc[ai][bj][m][0], v1 = acc[ai][bj][m][1];
                    if (gate) {
#pragma unroll
                        for (int j = 0; j < 4; ++j) { v0[j] = __builtin_amdgcn_rcpf(1.0f + __expf(-v0[j])); v1[j] = __builtin_amdgcn_rcpf(1.0f + __expf(-v1[j])); } }
                    u32x4 w; w.x = pk2(v0[0], v0[1]); w.y = pk2(v0[2], v0[3]); w.z = pk2(v1[0], v1[1]); w.w = pk2(v1[2], v1[3]);
                    *(u32x4*)(O + (size_t)(row0 + ai * HALF + m * 16) * ldc + col0 + bj * HALF) = w; } }
        return false;
    }
};
struct EpiNone { static constexpr bool PERM = true;
    __device__ __forceinline__ bool operator()(Acc& acc, const Unit&, int, int, int, int) const {
#pragma unroll
        for (int a = 0; a < 2; ++a)
#pragma unroll
            for (int b = 0; b < 2; ++b)
#pragma unroll
                for (int m = 0; m < 4; ++m)
#pragma unroll
                    for (int n = 0; n < 2; ++n) asm volatile("" :: "v"(acc[a][b][m][n]));
        return false; } };
struct EpiGlu {
    static constexpr bool PERM = true;
    const bf16_t* GG; const float* bias; bf16_t* Y4;
    __device__ __forceinline__ bool operator()(Acc& acc, const Unit& u, int wr, int wc, int fr, int fq) const {
        const int row0 = u.pm * BM + wr * 64 + fr, col0 = u.pn * BM + wc * 32 + 8 * fq;
#pragma unroll
        for (int bj = 0; bj < 2; ++bj) { const int col = col0 + bj * HALF; const f32x4 b0 = *(const f32x4*)(bias + col), b1 = *(const f32x4*)(bias + col + 4);
            u32x4 gq[2][4];
#pragma unroll
            for (int ai = 0; ai < 2; ++ai)
#pragma unroll
                for (int m = 0; m < 4; ++m) gq[ai][m] = *(const u32x4*)(GG + (size_t)(row0 + ai * HALF + m * 16) * BW + col);
#pragma unroll
            for (int ai = 0; ai < 2; ++ai)
#pragma unroll
                for (int m = 0; m < 4; ++m) { const size_t row = (size_t)(row0 + ai * HALF + m * 16);
                    float gg[8]; unpack8(gq[ai][m], gg);
                    const f32x4 v0 = acc[ai][bj][m][0] + b0, v1 = acc[ai][bj][m][1] + b1;
                    u32x4 w; w.x = pk2(gg[0] * sigmoidf_(v0[0]), gg[1] * sigmoidf_(v0[1])); w.y = pk2(gg[2] * sigmoidf_(v0[2]), gg[3] * sigmoidf_(v0[3]));
                    w.z = pk2(gg[4] * sigmoidf_(v1[0]), gg[5] * sigmoidf_(v1[1])); w.w = pk2(gg[6] * sigmoidf_(v1[2]), gg[7] * sigmoidf_(v1[3]));
                    *(u32x4*)(Y4 + row * DM + 1024 + col) = w; } }
        return false;
    }
};
struct EpiBranch {
    static constexpr bool PERM = true;
    const bf16_t* P; bf16_t* ACCb;
    __device__ __forceinline__ bool operator()(Acc& acc, const Unit& u, int wr, int wc, int fr, int fq) const {
        const int row0 = u.pm * BM + wr * 64 + fr, col0 = u.pn * BM + wc * 32 + 8 * fq; const int k = u.k;
        const bf16_t* gbase = P + (size_t)row0 * LDP + GATE_OFF + k * DM + col0;
        if (k < 3) {
#pragma unroll
            for (int ai = 0; ai < 2; ++ai) {
                u32x4 ga[8], gb[8];
#pragma unroll
                for (int m = 0; m < 4; ++m)
#pragma unroll
                    for (int bj = 0; bj < 2; ++bj) { const bf16_t* p = gbase + (size_t)(ai * HALF + m * 16) * LDP + bj * HALF; ga[m * 2 + bj] = *(const u32x4*)p; gb[m * 2 + bj] = *(const u32x4*)(p + DM); }
#pragma unroll
                for (int m = 0; m < 4; ++m)
#pragma unroll
                    for (int bj = 0; bj < 2; ++bj) { float g0[8], g1[8]; unpack8(ga[m * 2 + bj], g0); unpack8(gb[m * 2 + bj], g1);
                        float s[8];
#pragma unroll
                        for (int j = 0; j < 8; ++j) s[j] = g0[j] * __builtin_amdgcn_rcpf(g1[j]);
                        f32x4 v0 = acc[ai][bj][m][0], v1 = acc[ai][bj][m][1];
                        v0[0] *= s[0]; v0[1] *= s[1]; v0[2] *= s[2]; v0[3] *= s[3]; v1[0] *= s[4]; v1[1] *= s[5]; v1[2] *= s[6]; v1[3] *= s[7];
                        acc[ai][bj][m][0] = v0; acc[ai][bj][m][1] = v1; } }
            return true;
        }
#pragma unroll
        for (int ai = 0; ai < 2; ++ai) {
            u32x4 ga[8];
#pragma unroll
            for (int m = 0; m < 4; ++m)
#pragma unroll
                for (int bj = 0; bj < 2; ++bj) ga[m * 2 + bj] = *(const u32x4*)(gbase + (size_t)(ai * HALF + m * 16) * LDP + bj * HALF);
#pragma unroll
            for (int m = 0; m < 4; ++m)
#pragma unroll
                for (int bj = 0; bj < 2; ++bj) { float s[8]; unpack8(ga[m * 2 + bj], s);
                    f32x4 v0 = acc[ai][bj][m][0], v1 = acc[ai][bj][m][1];
                    v0[0] *= s[0]; v0[1] *= s[1]; v0[2] *= s[2]; v0[3] *= s[3]; v1[0] *= s[4]; v1[1] *= s[5]; v1[2] *= s[6]; v1[3] *= s[7];
                    u32x4 w; w.x = pk2(v0[0], v0[1]); w.y = pk2(v0[2], v0[3]); w.z = pk2(v1[0], v1[1]); w.w = pk2(v1[2], v1[3]);
                    *(u32x4*)(ACCb + (size_t)(row0 + ai * HALF + m * 16) * DM + col0 + bj * HALF) = w; } }
        return false;
    }
};
struct EpiResid {
    static constexpr bool PERM = false;
    float* XS; const float* srcLat; const float* srcCtx; const float* MODl; int gidx;
    __device__ __forceinline__ bool operator()(Acc& acc, const Unit& u, int wr, int wc, int fr, int fq) const {
        const int row0 = u.pm * BM + wr * 64 + fr, col0 = u.pn * BM + wc * 32 + 4 * fq;
        const int r = (u.pm * BM) < NLAT ? (u.pm * BM) / SEQ : 4;
        const float* src = (u.pm * BM) < NLAT ? srcLat : srcCtx;
        const float* mg = MODl + (size_t)(r * 6 + gidx) * DM;
#pragma unroll
        for (int bj = 0; bj < 2; ++bj) {
            f32x4 gm[2], xs[2][2][4];
#pragma unroll
            for (int n = 0; n < 2; ++n) { const int col = col0 + bj * HALF + n * 16; gm[n] = *(const f32x4*)(mg + col);
#pragma unroll
                for (int ai = 0; ai < 2; ++ai)
#pragma unroll
                    for (int m = 0; m < 4; ++m) xs[n][ai][m] = *(const f32x4*)(src + (size_t)(row0 + ai * HALF + m * 16) * DM + col); }
#pragma unroll
            for (int n = 0; n < 2; ++n) { const int col = col0 + bj * HALF + n * 16;
#pragma unroll
                for (int ai = 0; ai < 2; ++ai)
#pragma unroll
                    for (int m = 0; m < 4; ++m) *(f32x4*)(XS + (size_t)(row0 + ai * HALF + m * 16) * DM + col) = xs[n][ai][m] + gm[n] * acc[ai][bj][m][n]; } }
        return false;
    }
};
struct EpiMoe1 {
    static constexpr bool PERM = true;
    bf16_t* HID;
    __device__ __forceinline__ bool operator()(Acc& acc, const Unit& u, int wr, int wc, int fr, int fq) const {
        const size_t row0 = (size_t)u.z * MOE_PAD + u.pm * BM + wr * 64 + fr; const int col0 = u.pn * HALF + wc * 32 + 8 * fq;
#pragma unroll
        for (int ai = 0; ai < 2; ++ai)
#pragma unroll
            for (int m = 0; m < 4; ++m) { const f32x4 g0 = acc[ai][0][m][0], g1 = acc[ai][0][m][1], u0 = acc[ai][1][m][0], u1 = acc[ai][1][m][1];
                float h[8];
#pragma unroll
                for (int j = 0; j < 4; ++j) { h[j] = g0[j] * __builtin_amdgcn_rcpf(1.0f + __expf(-g0[j])) * u0[j]; h[4 + j] = g1[j] * __builtin_amdgcn_rcpf(1.0f + __expf(-g1[j])) * u1[j]; }
                u32x4 w; w.x = pk2(h[0], h[1]); w.y = pk2(h[2], h[3]); w.z = pk2(h[4], h[5]); w.w = pk2(h[6], h[7]);
                *(u32x4*)(HID + (row0 + ai * HALF + m * 16) * DEXP + col0) = w; }
        return false;
    }
};
struct EpiMoeY {
    static constexpr bool PERM = true;
    bf16_t* O;
    __device__ __forceinline__ bool operator()(Acc& acc, const Unit& u, int wr, int wc, int fr, int fq) const {
        const size_t row0 = (size_t)u.z * MOE_PAD + u.pm * BM + wr * 64 + fr; const int col0 = u.pn * BM + wc * 32 + 8 * fq;
#pragma unroll
        for (int ai = 0; ai < 2; ++ai)
#pragma unroll
            for (int m = 0; m < 4; ++m) { bf16_t* rowp = O + (row0 + ai * HALF + m * 16) * DM + col0;
#pragma unroll
                for (int bj = 0; bj < 2; ++bj) { const f32x4 v0 = acc[ai][bj][m][0], v1 = acc[ai][bj][m][1];
                    u32x4 w; w.x = pk2(v0[0], v0[1]); w.y = pk2(v0[2], v0[3]); w.z = pk2(v1[0], v1[1]); w.w = pk2(v1[2], v1[3]);
                    *(u32x4*)(rowp + bj * HALF) = w; } }
        return false;
    }
};

struct SchedS5a {
    int c;
    __device__ __forceinline__ bool next(int i, Unit& u) const { if (i > 0 || c >= 64) return false; u.z = c >> 1; u.pm = c & 1; u.pn = 0; u.k = 0;
        u.ao = ((long long)u.z * 512 + u.pm * BM) * 768 * 2; u.bo = (long long)u.z * 256 * 512 * 2; return true; }
    __device__ __forceinline__ void a_ready(const Unit&) const {}
    __device__ __forceinline__ void done(const Unit&) const {}
};
struct SchedS5b {
    int c;
    __device__ __forceinline__ bool next(int i, Unit& u) const { if (i > 0 || c >= 128) return false; u.z = c >> 2; u.pm = (c >> 1) & 1; u.pn = c & 1; u.k = 0;
        u.ao = ((long long)u.z * 512 + u.pm * BM) * 768 * 2; u.bo = ((long long)u.z * 512 + u.pn * BM) * 768 * 2; return true; }
    __device__ __forceinline__ void a_ready(const Unit&) const {}
    __device__ __forceinline__ void done(const Unit&) const {}
};
struct EpiXloc {
    static constexpr bool PERM = false;
    float* XL;
    __device__ __forceinline__ bool operator()(Acc& acc, const Unit& u, int wr, int wc, int fr, int fq) const {
        const int row0 = u.pm * BM + wr * 64 + fr, col0 = wc * 32 + 4 * fq; float* base = XL + (size_t)u.z * 512 * 256;
#pragma unroll
        for (int ai = 0; ai < 2; ++ai)
#pragma unroll
            for (int m = 0; m < 4; ++m) { float* rowp = base + (size_t)(row0 + ai * HALF + m * 16) * 256 + col0;
#pragma unroll
                for (int bj = 0; bj < 2; ++bj)
#pragma unroll
                    for (int n = 0; n < 2; ++n) *(f32x4*)(rowp + bj * HALF + n * 16) = acc[ai][bj][m][n]; }
        return false;
    }
};
struct EpiS5Out {
    static constexpr bool PERM = true;
    const bf16_t* P; const float* dskip; bf16_t* GG;
    __device__ __forceinline__ bool operator()(Acc& acc, const Unit& u, int wr, int wc, int fr, int fq) const {
        const int row0 = u.pm * BM + wr * 64 + fr, col0 = u.pn * BM + wc * 32 + 8 * fq; const int g = u.z;
#pragma unroll
        for (int bj = 0; bj < 2; ++bj) { const int col = col0 + bj * HALF; const int t = col >> 4, c0 = col & 15;
            const f32x4 d0 = *(const f32x4*)(dskip + g * 16 + c0), d1 = *(const f32x4*)(dskip + g * 16 + c0 + 4);
            u32x4 uq[2][4];
#pragma unroll
            for (int ai = 0; ai < 2; ++ai)
#pragma unroll
                for (int m = 0; m < 4; ++m) uq[ai][m] = *(const u32x4*)(P + ((size_t)(row0 + ai * HALF + m * 16) * 32 + t) * LDP + S5_OFF + g * 16 + c0);
#pragma unroll
            for (int ai = 0; ai < 2; ++ai)
#pragma unroll
                for (int m = 0; m < 4; ++m) { const size_t tok = (size_t)(row0 + ai * HALF + m * 16) * 32 + t;
                    float uu[8]; unpack8(uq[ai][m], uu);
                    const f32x4 v0 = acc[ai][bj][m][0], v1 = acc[ai][bj][m][1];
                    float y[8] = {v0[0] + d0[0] * uu[0], v0[1] + d0[1] * uu[1], v0[2] + d0[2] * uu[2], v0[3] + d0[3] * uu[3], v1[0] + d1[0] * uu[4], v1[1] + d1[1] * uu[5], v1[2] + d1[2] * uu[6], v1[3] + d1[3] * uu[7]};
#pragma unroll
                    for (int j = 0; j < 8; ++j) y[j] = 0.5f * y[j] * (1.0f + tanhf(0.7978845608028654f * (y[j] + 0.044715f * y[j] * y[j] * y[j])));
                    u32x4 w; w.x = pk2(y[0], y[1]); w.y = pk2(y[2], y[3]); w.z = pk2(y[4], y[5]); w.w = pk2(y[6], y[7]);
                    *(u32x4*)(GG + tok * BW + g * 16 + c0) = w; } }
        return false;
    }
};
}


__device__ __forceinline__ float wave_scan_incl(float v, int lane) {
#pragma unroll
    for (int o = 1; o < 64; o <<= 1) { const float t = __shfl_up(v, o); if (lane >= o) v += t; }
    return v;
}
__device__ __forceinline__ float wave_scanmax_incl(float v, int lane) {
#pragma unroll
    for (int o = 1; o < 64; o <<= 1) { const float t = __shfl_up(v, o); if (lane >= o) v = fmaxf(v, t); }
    return v;
}
__device__ __forceinline__ float wave_max(float v) {
#pragma unroll
    for (int o = 32; o >= 1; o >>= 1) v = fmaxf(v, __shfl_xor(v, o));
    return v;
}
__device__ __forceinline__ void unpack8h(const u32x4 w, bf16_t (&h)[8]) {
    h[0] = (bf16_t)(w.x & 0xFFFFu); h[1] = (bf16_t)(w.x >> 16); h[2] = (bf16_t)(w.y & 0xFFFFu); h[3] = (bf16_t)(w.y >> 16);
    h[4] = (bf16_t)(w.z & 0xFFFFu); h[5] = (bf16_t)(w.z >> 16); h[6] = (bf16_t)(w.w & 0xFFFFu); h[7] = (bf16_t)(w.w >> 16);
}

__device__ __forceinline__ int tokblock_of(int b, int dir, int c) { if (c < 4) return 256 + b * 4 + (dir ? 3 - c : c); const int j = c - 4; return b * 64 + (dir ? 63 - j : j); }
__device__ __forceinline__ u32x4 rev8h(const u32x4 v) { u32x4 r; r.x = (v.w >> 16) | (v.w << 16); r.y = (v.z >> 16) | (v.z << 16); r.z = (v.y >> 16) | (v.y << 16); r.w = (v.x >> 16) | (v.x << 16); return r; }
__device__ __forceinline__ u32x4 scale8h(const u32x4 v, const float4 a, const float4 b) { float f[8]; unpack8(v, f); u32x4 r; r.x = pk2(f[0] * a.x, f[1] * a.y); r.y = pk2(f[2] * a.z, f[3] * a.w); r.z = pk2(f[4] * b.x, f[5] * b.y); r.w = pk2(f[6] * b.z, f[7] * b.w); return r; }
__device__ __forceinline__ float dot8h(const u32x4 v, const float4 a, const float4 b) { float f[8]; unpack8(v, f); return (f[0] * a.x + f[1] * a.y) + (f[2] * a.z + f[3] * a.w) + (f[4] * b.x + f[5] * b.y) + (f[6] * b.z + f[7] * b.w); }
#define ML_FRAG_LOAD(KF, VF, cc_) do { const int tb_ = tokblock_of(b, dir, (cc_)); const bf16_t* kb_ = KTg + ((size_t)tb_ * 512 + h * 128 + 32 * wd + r16) * 64 + q4 * 8; const bf16_t* vb_ = VTg + ((size_t)tb_ * 512 + h * 128 + 64 * half + 32 * we + r16) * 64 + q4 * 8; \
        _Pragma("unroll") for (int ks_ = 0; ks_ < 2; ++ks_) _Pragma("unroll") for (int j_ = 0; j_ < 2; ++j_) { VF[j_][ks_] = *(const u32x4*)(vb_ + (size_t)j_ * 16 * 64 + ks_ * 32); KF[j_][ks_] = *(const u32x4*)(kb_ + (size_t)j_ * 16 * 64 + ks_ * 32); } } while (0)
#define ML_CHUNK(c_, KF, VF, KFN, VFN) do { const int c = (c_); \
        if (c + 1 < 68) ML_FRAG_LOAD(KFN, VFN, c + 1);                        \
        const float dec = sDEC[c]; \
        {   bf16_t* cs = CST + (size_t)(chain * 68 + c) * 128 * 128; \
            _Pragma("unroll") for (int je = 0; je < 2; ++je) _Pragma("unroll") for (int jd = 0; jd < 2; ++jd) { const int e = 64 * half + 32 * we + 16 * je + r16, d0 = 32 * wd + 16 * jd + q4 * 4; \
                u32x2 pk; pk.x = pk2(acc[je][jd][0], acc[je][jd][1]); pk.y = pk2(acc[je][jd][2], acc[je][jd][3]); *(u32x2*)(cs + (size_t)e * 128 + d0) = pk; } \
            if (nown) { _Pragma("unroll") for (int jd = 0; jd < 2; ++jd) { float nv = npart[jd]; nv += __shfl_xor(nv, 16); nv += __shfl_xor(nv, 32); if (q4 == 0) NST[(size_t)(chain * 68 + c) * 128 + 32 * wd + 16 * jd + r16] = nv; } } } \
        bf16x8 vfr[2][2]; \
        _Pragma("unroll") for (int ks = 0; ks < 2; ++ks) { const float4 wa = *(const float4*)(sWS + c * 64 + ks * 32 + q4 * 8), wb = *(const float4*)(sWS + c * 64 + ks * 32 + q4 * 8 + 4); \
            _Pragma("unroll") for (int je = 0; je < 2; ++je) { const u32x4 sv = scale8h(VF[je][ks], wa, wb); vfr[je][ks] = *(const bf16x8*)&sv; } \
            if (nown) { _Pragma("unroll") for (int jd = 0; jd < 2; ++jd) npart[jd] = (ks == 0 ? dec * npart[jd] : npart[jd]) + dot8h(KF[jd][ks], wa, wb); } } \
        _Pragma("unroll") for (int je = 0; je < 2; ++je) _Pragma("unroll") for (int jd = 0; jd < 2; ++jd) acc[je][jd] = acc[je][jd] * dec; \
        _Pragma("unroll") for (int ks = 0; ks < 2; ++ks) _Pragma("unroll") for (int je = 0; je < 2; ++je) _Pragma("unroll") for (int jd = 0; jd < 2; ++jd) \
            acc[je][jd] = __builtin_amdgcn_mfma_f32_16x16x32_bf16(*(const bf16x8*)&KF[jd][ks], vfr[je][ks], acc[je][jd], 0, 0, 0); } while (0)
__device__ __forceinline__ void mlstm_state_pass(const int chain, const int half, const bf16_t* __restrict__ Pm, const bf16_t* __restrict__ KTg, const bf16_t* __restrict__ VTg, const float* __restrict__ gate_b,
                                                 bf16_t* __restrict__ CST, float* __restrict__ NST, float* __restrict__ MST, unsigned char* shm, const int tid) {
    const int dir = chain & 1, h = (chain >> 1) & 3, b = chain >> 3, lane = tid & 63, w = tid >> 6, we = w >> 2, wd = w & 3, q4 = lane >> 4, r16 = lane & 15;
    const bool nown = (half == 0) && (we == 0);
    float* sE = (float*)shm; float* sWS = sE + 68 * 64; float* sAL = sWS + 68 * 64; float* sBE = sAL + 68; float* sMO = sBE + 68; float* sDEC = sMO + 68; float* sMB = sDEC + 68;
    const float gbi = gate_b[(dir * 2 + 0) * 4 + h], gbf = gate_b[(dir * 2 + 1) * 4 + h];
    const int gcol_i = ML_OFF + 2048 + (dir * 2 + 0) * 4 + h, gcol_f = ML_OFF + 2048 + (dir * 2 + 1) * 4 + h;
    u32x4 kfA[2][2], vfA[2][2], kfB[2][2], vfB[2][2];
    ML_FRAG_LOAD(kfA, vfA, 0);
    __syncthreads();
    unsigned short gi_[9], gf_[9];
#pragma unroll
    for (int q = 0; q < 9; ++q) { const int c = min(w + 8 * q, 67); const size_t tokl = (size_t)step_tok(b, dir, c * 64 + lane); gi_[q] = Pm[tokl * LDP + gcol_i]; gf_[q] = Pm[tokl * LDP + gcol_f]; }
#pragma unroll
    for (int q = 0; q < 9; ++q) { const int c = w + 8 * q; if (c >= 68) break;
        const float ig = bf2f(gi_[q]) + gbi, fg = bf2f(gf_[q]) + gbf;
        const float lf = fminf(fg, 0.f) - log1pf(expf(-fabsf(fg)));
        const float bcs = wave_scan_incl(lf, lane); const float blast = __shfl(bcs, 63); const float ei = blast - bcs + ig; const float beta = wave_max(ei);
        sE[c * 64 + lane] = ei; if (lane == 0) { sAL[c] = blast; sBE[c] = beta; } }
    __syncthreads();
    if (tid == 0) { float m = 0.f; for (int c = 0; c < 68; ++c) { sMB[c] = m; const float mo = fmaxf(m + sAL[c], sBE[c]); sDEC[c] = expf(sAL[c] + m - mo); sMO[c] = mo; m = mo; } }
    __syncthreads();
    for (int idx = tid; idx < 68 * 64; idx += NTHR) { const int c = idx >> 6, i = idx & 63; sWS[c * 64 + (dir ? 63 - i : i)] = expf(sE[idx] - sMO[c]); }
    if (half == 0 && tid < 68) MST[chain * 68 + tid] = sMB[tid];
    __syncthreads();
    f32x4 acc[2][2];
#pragma unroll
    for (int je = 0; je < 2; ++je)
#pragma unroll
        for (int jd = 0; jd < 2; ++jd) acc[je][jd] = (f32x4){0.f, 0.f, 0.f, 0.f};
    float npart[2] = {0.f, 0.f};
    for (int c2 = 0; c2 < 68; c2 += 2) { ML_CHUNK(c2, kfA, vfA, kfB, vfB); ML_CHUNK(c2 + 1, kfB, vfB, kfA, vfA); }
    __syncthreads();
}
#undef ML_CHUNK
#undef ML_FRAG_LOAD
__device__ __forceinline__ void mlstm_out_item(const int chain, const int c, const bf16_t* __restrict__ Pm, const bf16_t* __restrict__ QKb, const bf16_t* __restrict__ VTg, const float* __restrict__ gate_b,
                                               const bf16_t* __restrict__ CST, const float* __restrict__ NST, const float* __restrict__ MST, float* __restrict__ Hout, unsigned char* shm, const int tid) {
    const int dir = chain & 1, h = (chain >> 1) & 3, b = chain >> 3, lane = tid & 63, w = tid >> 6;
    bf16_t* Qs = (bf16_t*)shm; bf16_t* Ks = (bf16_t*)(shm + 17408); bf16_t* VT = (bf16_t*)(shm + 34816); bf16_t* Cs = (bf16_t*)(shm + 53248); bf16_t* Ss = (bf16_t*)(shm + 88064);
    float* sc = (float*)(shm + 97280);
    __syncthreads();
#pragma unroll
    for (int i = 0; i < 2; ++i) { const int pid = tid + i * 512; const int s = pid >> 4, x0 = (pid & 15) * 8; const size_t toks = (size_t)step_tok(b, dir, c * 64 + s);
        *(u32x4*)(Qs + s * 136 + x0) = *(const u32x4*)(QKb + toks * 1024 + h * 128 + x0);
        *(u32x4*)(Ks + s * 136 + x0) = *(const u32x4*)(QKb + toks * 1024 + 512 + h * 128 + x0);
        { const int e = pid >> 3, o = pid & 7;
          const u32x4 vv = *(const u32x4*)(VTg + ((size_t)tokblock_of(b, dir, c) * 512 + h * 128 + e) * 64 + (dir ? 7 - o : o) * 8);
          *(u32x4*)(VT + e * 72 + o * 8) = dir ? rev8h(vv) : vv; } }
#pragma unroll
    for (int i = 0; i < 4; ++i) { const int pid = tid + i * 512; const int e = pid >> 4, x0 = (pid & 15) * 8;
        *(u32x4*)(Cs + e * 136 + x0) = *(const u32x4*)(CST + ((size_t)(chain * 68 + c) * 128 + e) * 128 + x0); }
    if (tid < 128) sc[384 + tid] = NST[(size_t)(chain * 68 + c) * 128 + tid];
    if (w == 0) {
        const float gbi = gate_b[(dir * 2 + 0) * 4 + h], gbf = gate_b[(dir * 2 + 1) * 4 + h];
        const size_t tokl = (size_t)step_tok(b, dir, c * 64 + lane);
        const float ig = bf2f(Pm[tokl * LDP + ML_OFF + 2048 + (dir * 2 + 0) * 4 + h]) + gbi;
        const float fg = bf2f(Pm[tokl * LDP + ML_OFF + 2048 + (dir * 2 + 1) * 4 + h]) + gbf;
        const float lf = fminf(fg, 0.f) - log1pf(expf(-fabsf(fg)));
        const float bcs = wave_scan_incl(lf, lane); const float gsv = ig - bcs; const float pm = wave_scanmax_incl(gsv, lane);
        const float m_in = MST[chain * 68 + c]; const float mt = bcs + fmaxf(m_in, pm);
        sc[lane] = bcs; sc[64 + lane] = gsv; sc[128 + lane] = mt; sc[192 + lane] = expf(bcs + m_in - mt); sc[256 + lane] = expf(-mt);
    }
    __syncthreads();
    const int tt = w >> 1;
    {   f32x4 aS[2] = {(f32x4){0.f, 0.f, 0.f, 0.f}, (f32x4){0.f, 0.f, 0.f, 0.f}};
#pragma unroll
        for (int ks = 0; ks < 4; ++ks) { const bf16x8 af = *(const bf16x8*)(Qs + (16 * tt + (lane & 15)) * 136 + ks * 32 + (lane >> 4) * 8);
#pragma unroll
            for (int i = 0; i < 2; ++i) { const int st = (w & 1) * 2 + i; const bf16x8 bfr = *(const bf16x8*)(Ks + (16 * st + (lane & 15)) * 136 + ks * 32 + (lane >> 4) * 8);
                aS[i] = __builtin_amdgcn_mfma_f32_16x16x32_bf16(af, bfr, aS[i], 0, 0, 0); } }
        float rs[4] = {0.f, 0.f, 0.f, 0.f};
#pragma unroll
        for (int i = 0; i < 2; ++i) { const int s = 16 * ((w & 1) * 2 + i) + (lane & 15); const float gsv = sc[64 + s];
#pragma unroll
            for (int q = 0; q < 4; ++q) { const int t = 16 * tt + (lane >> 4) * 4 + q; const float val = (s <= t) ? aS[i][q] * expf(sc[t] + gsv - sc[128 + t]) : 0.f; Ss[t * 72 + s] = f2bf(val); rs[q] += val; } }
#pragma unroll
        for (int q = 0; q < 4; ++q) { float r = rs[q]; r += __shfl_xor(r, 1); r += __shfl_xor(r, 2); r += __shfl_xor(r, 4); r += __shfl_xor(r, 8);
            if ((lane & 15) == 0) sc[512 + (w & 1) * 64 + 16 * tt + (lane >> 4) * 4 + q] = r; }
        {   const int t = tid >> 3, part = tid & 7; float dot = 0.f;
#pragma unroll
            for (int j = 0; j < 16; ++j) dot += bf2f(Qs[t * 136 + part * 16 + j]) * sc[384 + part * 16 + j];
            dot += __shfl_xor(dot, 1); dot += __shfl_xor(dot, 2); dot += __shfl_xor(dot, 4);
            if (part == 0) sc[640 + t] = sc[192 + t] * dot; }
    }
    __syncthreads();
    {   f32x4 aN[4];
#pragma unroll
        for (int i = 0; i < 4; ++i) aN[i] = (f32x4){0.f, 0.f, 0.f, 0.f};
#pragma unroll
        for (int ks = 0; ks < 4; ++ks) { const bf16x8 af = *(const bf16x8*)(Qs + (16 * tt + (lane & 15)) * 136 + ks * 32 + (lane >> 4) * 8);
#pragma unroll
            for (int i = 0; i < 4; ++i) { const int et = (w & 1) * 4 + i; const bf16x8 bfr = *(const bf16x8*)(Cs + (16 * et + (lane & 15)) * 136 + ks * 32 + (lane >> 4) * 8);
                aN[i] = __builtin_amdgcn_mfma_f32_16x16x32_bf16(af, bfr, aN[i], 0, 0, 0); } }
#pragma unroll
        for (int q = 0; q < 4; ++q) { const float it = sc[192 + 16 * tt + (lane >> 4) * 4 + q];
#pragma unroll
            for (int i = 0; i < 4; ++i) aN[i][q] *= it; }
#pragma unroll
        for (int ks = 0; ks < 2; ++ks) { const bf16x8 af = *(const bf16x8*)(Ss + (16 * tt + (lane & 15)) * 72 + ks * 32 + (lane >> 4) * 8);
#pragma unroll
            for (int i = 0; i < 4; ++i) { const int et = (w & 1) * 4 + i; const bf16x8 bfr = *(const bf16x8*)(VT + (16 * et + (lane & 15)) * 72 + ks * 32 + (lane >> 4) * 8);
                aN[i] = __builtin_amdgcn_mfma_f32_16x16x32_bf16(af, bfr, aN[i], 0, 0, 0); } }
#pragma unroll
        for (int q = 0; q < 4; ++q) { const int t = 16 * tt + (lane >> 4) * 4 + q; const size_t tokt = (size_t)step_tok(b, dir, c * 64 + t); const float dn = fmaxf(fabsf((sc[512 + t] + sc[576 + t]) + sc[640 + t]), sc[256 + t]);
#pragma unroll
            for (int i = 0; i < 4; ++i) { const int e = 16 * ((w & 1) * 4 + i) + (lane & 15); Hout[tokt * BW + h * 128 + e] = aN[i][q] / dn; } }
    }
}


#define SD_FRAG_LOAD(BF, XF, cc_) do { const int tb_ = tokblock_of(b, dir, (cc_)); const bf16_t* bb_ = BTg + ((size_t)tb_ * 256 + grp * 128 + 64 * (w >> 2) + r16) * 64 + q4 * 8; const bf16_t* xb_ = XTg + ((size_t)tb_ * 512 + h * 64 + 16 * (w & 3) + r16) * 64 + q4 * 8; \
        _Pragma("unroll") for (int ks_ = 0; ks_ < 2; ++ks_) { XF[ks_] = *(const u32x4*)(xb_ + ks_ * 32); _Pragma("unroll") for (int j_ = 0; j_ < 4; ++j_) BF[j_][ks_] = *(const u32x4*)(bb_ + (size_t)j_ * 16 * 64 + ks_ * 32); } } while (0)
#define SD_CHUNK(c_, BF, XF, BFN, XFN) do { const int c = (c_); \
        if (c + 1 < 68) SD_FRAG_LOAD(BFN, XFN, c + 1); \
        const float dec = sDEC[c]; \
        {   bf16_t* ss = SSTb + (size_t)(chain * 68 + c) * 64 * 128; const int p = 16 * (w & 3) + r16; \
            _Pragma("unroll") for (int j = 0; j < 4; ++j) { const int n0 = 16 * ((w >> 2) * 4 + j) + q4 * 4; u32x2 pk; pk.x = pk2(acc[j][0], acc[j][1]); pk.y = pk2(acc[j][2], acc[j][3]); *(u32x2*)(ss + (size_t)p * 128 + n0) = pk; } } \
        bf16x8 xfr[2]; \
        _Pragma("unroll") for (int ks = 0; ks < 2; ++ks) { const float4 wa = *(const float4*)(sSC + c * 64 + ks * 32 + q4 * 8), wb = *(const float4*)(sSC + c * 64 + ks * 32 + q4 * 8 + 4); const u32x4 sv = scale8h(XF[ks], wa, wb); xfr[ks] = *(const bf16x8*)&sv; } \
        _Pragma("unroll") for (int j = 0; j < 4; ++j) acc[j] = acc[j] * dec; \
        _Pragma("unroll") for (int ks = 0; ks < 2; ++ks) _Pragma("unroll") for (int j = 0; j < 4; ++j) acc[j] = __builtin_amdgcn_mfma_f32_16x16x32_bf16(*(const bf16x8*)&BF[j][ks], xfr[ks], acc[j], 0, 0, 0); } while (0)
__device__ __forceinline__ void ssd_state_pass(const int chain, const bf16_t* __restrict__ Pm, const bf16_t* __restrict__ BTg, const bf16_t* __restrict__ XTg, const float Aa, const float dtb,
                                               bf16_t* __restrict__ SSTb, unsigned char* shm, const int tid) {
    const int dir = chain & 1, h = (chain >> 1) & 7, b = chain >> 4, grp = h >> 2, lane = tid & 63, w = tid >> 6, q4 = lane >> 4, r16 = lane & 15;
    float* sSC = (float*)shm; float* sDEC = sSC + 68 * 64;
    const int dcol = SSD_OFF + 1536 + dir * 8 + h;
    u32x4 bfA[4][2], xfA[2], bfB[4][2], xfB[2];
    SD_FRAG_LOAD(bfA, xfA, 0);
    __syncthreads();
    unsigned short dt_[9];
#pragma unroll
    for (int q = 0; q < 9; ++q) { const int c = min(w + 8 * q, 67); dt_[q] = Pm[(size_t)step_tok(b, dir, c * 64 + lane) * LDP + dcol]; }
#pragma unroll
    for (int q = 0; q < 9; ++q) { const int c = w + 8 * q; if (c >= 68) break;
        const float xv = bf2f(dt_[q]) + dtb; const float dtv = xv > 20.f ? xv : log1pf(expf(xv));
        const float cs = wave_scan_incl(dtv * Aa, lane); const float cl = __shfl(cs, 63);
        sSC[c * 64 + (dir ? 63 - lane : lane)] = dtv * expf(cl - cs); if (lane == 0) sDEC[c] = expf(cl); }
    __syncthreads();
    f32x4 acc[4];
#pragma unroll
    for (int j = 0; j < 4; ++j) acc[j] = (f32x4){0.f, 0.f, 0.f, 0.f};
    for (int c2 = 0; c2 < 68; c2 += 2) { SD_CHUNK(c2, bfA, xfA, bfB, xfB); SD_CHUNK(c2 + 1, bfB, xfB, bfA, xfA); }
    __syncthreads();
}
#undef SD_CHUNK
#undef SD_FRAG_LOAD
__device__ __forceinline__ void ssd_out_item(const int chain, const int c, const bf16_t* __restrict__ Pm, const bf16_t* __restrict__ XBb, const bf16_t* __restrict__ XTg, const float Aa, const float dtb,
                                             const bf16_t* __restrict__ SSTb, float* __restrict__ Yout, unsigned char* shm, const int tid) {
    const int dir = chain & 1, h = (chain >> 1) & 7, b = chain >> 4, grp = h >> 2, lane = tid & 63, w = tid >> 6;
    bf16_t* Cs = (bf16_t*)shm; bf16_t* Bs = (bf16_t*)(shm + 17408); bf16_t* XT = (bf16_t*)(shm + 34816); bf16_t* Sin = (bf16_t*)(shm + 44032); bf16_t* Gs = (bf16_t*)(shm + 61440);
    float* sc = (float*)(shm + 70656);
    __syncthreads();
#pragma unroll
    for (int i = 0; i < 2; ++i) { const int pid = tid + i * 512; const int s = pid >> 4, x0 = (pid & 15) * 8; const size_t toks = (size_t)step_tok(b, dir, c * 64 + s);
        *(u32x4*)(Bs + s * 136 + x0) = *(const u32x4*)(XBb + toks * 1024 + 512 + grp * 128 + x0);
        *(u32x4*)(Cs + s * 136 + x0) = *(const u32x4*)(XBb + toks * 1024 + 768 + grp * 128 + x0);
        const int p = pid >> 4;
        *(u32x4*)(Sin + p * 136 + x0) = *(const u32x4*)(SSTb + ((size_t)(chain * 68 + c) * 64 + p) * 128 + x0); }
    {   const int p = tid >> 3, o = tid & 7;
        const u32x4 vv = *(const u32x4*)(XTg + ((size_t)tokblock_of(b, dir, c) * 512 + h * 64 + p) * 64 + (dir ? 7 - o : o) * 8);
        *(u32x4*)(XT + p * 72 + o * 8) = dir ? rev8h(vv) : vv; }
    if (w == 0) { const size_t tokl = (size_t)step_tok(b, dir, c * 64 + lane);
        const float xv = bf2f(Pm[tokl * LDP + SSD_OFF + 1536 + dir * 8 + h]) + dtb; const float dtv = xv > 20.f ? xv : log1pf(expf(xv));
        sc[lane] = wave_scan_incl(dtv * Aa, lane); sc[64 + lane] = dtv; }
    __syncthreads();
    {   const int lt = w >> 1;
        f32x4 aG[2] = {(f32x4){0.f, 0.f, 0.f, 0.f}, (f32x4){0.f, 0.f, 0.f, 0.f}};
#pragma unroll
        for (int ks = 0; ks < 4; ++ks) { const bf16x8 af = *(const bf16x8*)(Cs + (16 * lt + (lane & 15)) * 136 + ks * 32 + (lane >> 4) * 8);
#pragma unroll
            for (int i = 0; i < 2; ++i) { const int st = (w & 1) * 2 + i; const bf16x8 bfr = *(const bf16x8*)(Bs + (16 * st + (lane & 15)) * 136 + ks * 32 + (lane >> 4) * 8);
                aG[i] = __builtin_amdgcn_mfma_f32_16x16x32_bf16(af, bfr, aG[i], 0, 0, 0); } }
#pragma unroll
        for (int i = 0; i < 2; ++i) { const int s = 16 * ((w & 1) * 2 + i) + (lane & 15); const float css = sc[s], dts = sc[64 + s];
#pragma unroll
            for (int q = 0; q < 4; ++q) { const int t = 16 * lt + (lane >> 4) * 4 + q; const float val = (s <= t) ? aG[i][q] * expf(sc[t] - css) * dts : 0.f; Gs[t * 72 + s] = f2bf(val); } }
    }
    __syncthreads();
    {   const int lt = w >> 1;
        f32x4 aY[2] = {(f32x4){0.f, 0.f, 0.f, 0.f}, (f32x4){0.f, 0.f, 0.f, 0.f}};
#pragma unroll
        for (int ks = 0; ks < 4; ++ks) { const bf16x8 af = *(const bf16x8*)(Cs + (16 * lt + (lane & 15)) * 136 + ks * 32 + (lane >> 4) * 8);
#pragma unroll
            for (int i = 0; i < 2; ++i) { const int pt = (w & 1) * 2 + i; const bf16x8 bfr = *(const bf16x8*)(Sin + (16 * pt + (lane & 15)) * 136 + ks * 32 + (lane >> 4) * 8);
                aY[i] = __builtin_amdgcn_mfma_f32_16x16x32_bf16(af, bfr, aY[i], 0, 0, 0); } }
#pragma unroll
        for (int q = 0; q < 4; ++q) { const float ec = expf(sc[16 * lt + (lane >> 4) * 4 + q]); aY[0][q] *= ec; aY[1][q] *= ec; }
#pragma unroll
        for (int ks = 0; ks < 2; ++ks) { const bf16x8 af = *(const bf16x8*)(Gs + (16 * lt + (lane & 15)) * 72 + ks * 32 + (lane >> 4) * 8);
#pragma unroll
            for (int i = 0; i < 2; ++i) { const int pt = (w & 1) * 2 + i; const bf16x8 bfr = *(const bf16x8*)(XT + (16 * pt + (lane & 15)) * 72 + ks * 32 + (lane >> 4) * 8);
                aY[i] = __builtin_amdgcn_mfma_f32_16x16x32_bf16(af, bfr, aY[i], 0, 0, 0); } }
#pragma unroll
        for (int q = 0; q < 4; ++q) { const int t = 16 * lt + (lane >> 4) * 4 + q; const size_t tokt = (size_t)step_tok(b, dir, c * 64 + t);
#pragma unroll
            for (int i = 0; i < 2; ++i) { const int p = 16 * ((w & 1) * 2 + i) + (lane & 15); Yout[tokt * BW + h * 64 + p] = aY[i][q]; } }
    }
}


#define FIDX(i) ((i) + ((i) >> 4))
#define FFT_X_BYTES 69632
__device__ constexpr float FFT_CW_RE[6][16] = {{0.f, 0.f, 0.f, 0.f, 0.f, 0.f, 0.f, 0.f, 0.f, 0.f, 0.f, 0.f, 0.f, 0.f, 0.f, 0.f}, {1.0f, 0.f, 0.f, 0.f, 0.f, 0.f, 0.f, 0.f, 0.f, 0.f, 0.f, 0.f, 0.f, 0.f, 0.f, 0.f}, {1.0f, 6.123233995736766e-17f, 0.f, 0.f, 0.f, 0.f, 0.f, 0.f, 0.f, 0.f, 0.f, 0.f, 0.f, 0.f, 0.f, 0.f}, {1.0f, 0.7071067811865476f, 6.123233995736766e-17f, -0.7071067811865475f, 0.f, 0.f, 0.f, 0.f, 0.f, 0.f, 0.f, 0.f, 0.f, 0.f, 0.f, 0.f}, {1.0f, 0.9238795325112867f, 0.7071067811865476f, 0.38268343236508984f, 6.123233995736766e-17f, -0.3826834323650897f, -0.7071067811865475f, -0.9238795325112867f, 0.f, 0.f, 0.f, 0.f, 0.f, 0.f, 0.f, 0.f}, {1.0f, 0.9807852804032304f, 0.9238795325112867f, 0.8314696123025452f, 0.7071067811865476f, 0.5555702330196023f, 0.38268343236508984f, 0.19509032201612833f, 6.123233995736766e-17f, -0.1950903220161282f, -0.3826834323650897f, -0.555570233019602f, -0.7071067811865475f, -0.8314696123025453f, -0.9238795325112867f, -0.9807852804032304f}};
__device__ constexpr float FFT_CW_IM[6][16] = {{0.f, 0.f, 0.f, 0.f, 0.f, 0.f, 0.f, 0.f, 0.f, 0.f, 0.f, 0.f, 0.f, 0.f, 0.f, 0.f}, {-0.0f, 0.f, 0.f, 0.f, 0.f, 0.f, 0.f, 0.f, 0.f, 0.f, 0.f, 0.f, 0.f, 0.f, 0.f, 0.f}, {-0.0f, -1.0f, 0.f, 0.f, 0.f, 0.f, 0.f, 0.f, 0.f, 0.f, 0.f, 0.f, 0.f, 0.f, 0.f, 0.f}, {-0.0f, -0.7071067811865475f, -1.0f, -0.7071067811865476f, 0.f, 0.f, 0.f, 0.f, 0.f, 0.f, 0.f, 0.f, 0.f, 0.f, 0.f, 0.f}, {-0.0f, -0.3826834323650898f, -0.7071067811865475f, -0.9238795325112867f, -1.0f, -0.9238795325112867f, -0.7071067811865476f, -0.3826834323650899f, 0.f, 0.f, 0.f, 0.f, 0.f, 0.f, 0.f, 0.f}, {-0.0f, -0.19509032201612825f, -0.3826834323650898f, -0.5555702330196022f, -0.7071067811865475f, -0.8314696123025452f, -0.9238795325112867f, -0.9807852804032304f, -1.0f, -0.9807852804032304f, -0.9238795325112867f, -0.8314696123025455f, -0.7071067811865476f, -0.5555702330196022f, -0.3826834323650899f, -0.1950903220161286f}};
__host__ __device__ constexpr int fft_bitrev(int k, int R) { int r = 0; for (int i = 0; i < R; ++i) if (k & (1 << i)) r |= 1 << (R - 1 - i); return r; }
template <int R, bool INV>
__device__ __forceinline__ void fft_pass(float2* __restrict__ X, const float2* __restrict__ TW, const int s0, const int gidx) {
    const int lowbits = 13 - s0 - R; const int stride = 1 << lowbits;
    const int low = gidx & (stride - 1), high = gidx >> lowbits; const int base = (high << (lowbits + R)) | low;
    const int p0 = FIDX(base);
#define FFT_SLOT(k) (lowbits >= 4 ? p0 + (k) * (stride + (stride >> 4)) : p0 + (k) + ((k) >> 4))
    float2 v[1 << R];
#pragma unroll
    for (int k = 0; k < (1 << R); ++k) v[k] = X[FFT_SLOT(k)];
    const int lw = low << s0;
    if (!INV) {
#pragma unroll
        for (int j = 0; j < R; ++j) { const int hk = 1 << (R - 1 - j);
#pragma unroll
            for (int k = 0; k < (1 << R); ++k) if (!(k & hk)) { const int kk = k & (hk - 1);
                const float2 a = v[k], b = v[k + hk]; v[k] = make_float2(a.x + b.x, a.y + b.y); const float dx = a.x - b.x, dy = a.y - b.y;
                if (kk == 0) v[k + hk] = make_float2(dx, dy);
                else if (2 * kk == hk) v[k + hk] = make_float2(dy, -dx);
                else { const float cr = FFT_CW_RE[R - j][kk], ci = FFT_CW_IM[R - j][kk]; v[k + hk] = make_float2(dx * cr - dy * ci, dx * ci + dy * cr); } } }
        if (lowbits > 0) {
#pragma unroll
            for (int k = 1; k < (1 << R); ++k) { const float2 w = TW[(lw * fft_bitrev(k, R)) & 8191]; const float2 a = v[k]; v[k] = make_float2(a.x * w.x - a.y * w.y, a.x * w.y + a.y * w.x); } }
    } else {
        if (lowbits > 0) {
#pragma unroll
            for (int k = 1; k < (1 << R); ++k) { const float2 w = TW[(lw * fft_bitrev(k, R)) & 8191]; const float2 a = v[k]; v[k] = make_float2(a.x * w.x + a.y * w.y, a.y * w.x - a.x * w.y); } }
#pragma unroll
        for (int j = R - 1; j >= 0; --j) { const int hk = 1 << (R - 1 - j);
#pragma unroll
            for (int k = 0; k < (1 << R); ++k) if (!(k & hk)) { const int kk = k & (hk - 1);
                const float2 a = v[k], b = v[k + hk]; float tx, ty;
                if (kk == 0) { tx = b.x; ty = b.y; }
                else if (2 * kk == hk) { tx = -b.y; ty = b.x; }
                else { const float cr = FFT_CW_RE[R - j][kk], ci = FFT_CW_IM[R - j][kk]; tx = b.x * cr + b.y * ci; ty = b.y * cr - b.x * ci; }
                v[k] = make_float2(a.x + tx, a.y + ty); v[k + hk] = make_float2(a.x - tx, a.y - ty); } }
    }
#pragma unroll
    for (int k = 0; k < (1 << R); ++k) X[FFT_SLOT(k)] = v[k];
#undef FFT_SLOT
}
__device__ __forceinline__ void fft_fwd(float2* X, const float2* TW, const int tid) {
    fft_pass<4, false>(X, TW, 0, tid); __syncthreads(); fft_pass<4, false>(X, TW, 4, tid); __syncthreads(); if (tid < 256) fft_pass<5, false>(X, TW, 8, tid); __syncthreads(); }
__device__ __forceinline__ void fft_inv(float2* X, const float2* TW, const int tid) {
    if (tid < 256) fft_pass<5, true>(X, TW, 8, tid); __syncthreads(); fft_pass<4, true>(X, TW, 4, tid); __syncthreads(); fft_pass<4, true>(X, TW, 0, tid); __syncthreads(); }
__device__ __forceinline__ void fft_twiddles(float2* TW, const int tid) {
#pragma unroll
    for (int k = 0; k < 16; ++k) { const int m = tid + k * 512; const float xx = (float)m * (1.0f / 4096.0f); TW[m] = make_float2(cospif(xx), -sinpif(xx)); }
}
__device__ __forceinline__ void hyena_spec_item(const int oc, const float* __restrict__ HR, const float* __restrict__ nrm, float2* __restrict__ HSPEC, unsigned char* shm, const int tid) {
    float2* X = (float2*)shm; const float2* TW = (const float2*)(shm + FFT_X_BYTES);
    const int o = oc >> 9, c = oc & 511; const float inv = 1.0f / nrm[oc];
    __syncthreads();
    float hv[16];
#pragma unroll
    for (int k = 0; k < 16; ++k) { const int j = tid + k * 512;
        const unsigned off = j < SEQ ? (unsigned)j * 2048u + o * 1024 + c : j == SEQ ? (unsigned)(o * 1024 + c) : (unsigned)(2 * SEQ - j) * 2048u + o * 1024 + 512 + c;
        hv[k] = HR[off]; }
#pragma unroll
    for (int k = 0; k < 16; ++k) { const int j = tid + k * 512; X[FIDX(j)] = make_float2(j == SEQ ? 0.f : hv[k] * inv, 0.f); }
    __syncthreads();
    fft_fwd(X, TW, tid);
    float4* out = (float4*)(HSPEC + (size_t)oc * 8192 + tid * 16); const float2* xs = X + 17 * tid;
#pragma unroll
    for (int k = 0; k < 8; ++k) { const float2 x0 = xs[2 * k], x1 = xs[2 * k + 1]; out[k] = make_float4(x0.x * (1.0f / 8192.0f), x0.y * (1.0f / 8192.0f), x1.x * (1.0f / 8192.0f), x1.y * (1.0f / 8192.0f)); }
}
__device__ __forceinline__ void fft_mul_spec(float2* X, const float2* __restrict__ H, const int tid) {
    const float4* h4 = (const float4*)(H + tid * 16); float2* xs = X + 17 * tid;
#pragma unroll
    for (int k = 0; k < 8; ++k) { const float4 hv = h4[k]; const float2 x0 = xs[2 * k], x1 = xs[2 * k + 1];
        xs[2 * k] = make_float2(x0.x * hv.x - x0.y * hv.y, x0.x * hv.y + x0.y * hv.x); xs[2 * k + 1] = make_float2(x1.x * hv.z - x1.y * hv.w, x1.x * hv.w + x1.y * hv.z); }
}
__device__ __forceinline__ void hyena_fft_item(const int item, const float* __restrict__ UT, const float2* __restrict__ HSPEC, const float* __restrict__ bias, float* __restrict__ YT, unsigned char* shm, const int tid) {
    float2* X = (float2*)shm; const float2* TW = (const float2*)(shm + FFT_X_BYTES);
    const int c = item >> 1, b0 = (item & 1) * 2, b1 = b0 + 1;
    const float* u0 = UT + (size_t)(b0 * 1536 + c) * SEQ + tid * 8; const float* u1 = UT + (size_t)(b1 * 1536 + c) * SEQ + tid * 8;
    const float bias0 = bias[c], bias1 = bias[512 + c];
    float2* xs = X + FIDX(8 * tid);
    float vr[8], vi[8];
    __syncthreads();
    { const float4 a0 = *(const float4*)u0, a1 = *(const float4*)(u0 + 4), c0 = *(const float4*)u1, c1 = *(const float4*)(u1 + 4);
      vr[0] = a0.x; vr[1] = a0.y; vr[2] = a0.z; vr[3] = a0.w; vr[4] = a1.x; vr[5] = a1.y; vr[6] = a1.z; vr[7] = a1.w;
      vi[0] = c0.x; vi[1] = c0.y; vi[2] = c0.z; vi[3] = c0.w; vi[4] = c1.x; vi[5] = c1.y; vi[6] = c1.z; vi[7] = c1.w; }
#pragma unroll
    for (int k = 0; k < 8; ++k) { xs[k] = make_float2(vr[k], vi[k]); xs[4352 + k] = make_float2(0.f, 0.f); }
    __syncthreads();
    fft_fwd(X, TW, tid);
    fft_mul_spec(X, HSPEC + (size_t)c * 8192, tid);
    __syncthreads();
    fft_inv(X, TW, tid);
    { const float* p0 = u0 + (size_t)512 * SEQ; const float* p1 = u1 + (size_t)512 * SEQ;
      const float4 a0 = *(const float4*)p0, a1 = *(const float4*)(p0 + 4), c0 = *(const float4*)p1, c1 = *(const float4*)(p1 + 4);
      const float xr[8] = {a0.x, a0.y, a0.z, a0.w, a1.x, a1.y, a1.z, a1.w}, xi[8] = {c0.x, c0.y, c0.z, c0.w, c1.x, c1.y, c1.z, c1.w};
#pragma unroll
      for (int k = 0; k < 8; ++k) { const float2 cv = xs[k]; const float zr = xr[k] * (cv.x + bias0 * vr[k]), zi = xi[k] * (cv.y + bias0 * vi[k]);
          vr[k] = zr; vi[k] = zi; xs[k] = make_float2(zr, zi); xs[4352 + k] = make_float2(0.f, 0.f); } }
    __syncthreads();
    fft_fwd(X, TW, tid);
    fft_mul_spec(X, HSPEC + (size_t)(512 + c) * 8192, tid);
    __syncthreads();
    fft_inv(X, TW, tid);
    { const float* p0 = u0 + (size_t)1024 * SEQ; const float* p1 = u1 + (size_t)1024 * SEQ;
      const float4 a0 = *(const float4*)p0, a1 = *(const float4*)(p0 + 4), c0 = *(const float4*)p1, c1 = *(const float4*)(p1 + 4);
      const float xr[8] = {a0.x, a0.y, a0.z, a0.w, a1.x, a1.y, a1.z, a1.w}, xi[8] = {c0.x, c0.y, c0.z, c0.w, c1.x, c1.y, c1.z, c1.w};
      float yr[8], yi[8];
#pragma unroll
      for (int k = 0; k < 8; ++k) { const float2 cv = xs[k]; yr[k] = xr[k] * (cv.x + bias1 * vr[k]); yi[k] = xi[k] * (cv.y + bias1 * vi[k]); }
      float* y0 = YT + (size_t)(b0 * 512 + c) * SEQ + tid * 8; float* y1 = YT + (size_t)(b1 * 512 + c) * SEQ + tid * 8;
      *(float4*)y0 = make_float4(yr[0], yr[1], yr[2], yr[3]); *(float4*)(y0 + 4) = make_float4(yr[4], yr[5], yr[6], yr[7]);
      *(float4*)y1 = make_float4(yi[0], yi[1], yi[2], yi[3]); *(float4*)(y1 + 4) = make_float4(yi[4], yi[5], yi[6], yi[7]); }
}

constexpr size_t al256(size_t x) { return (x + 255) & ~(size_t)255; }
constexpr size_t O_BAR = 0;
constexpr size_t O_MOD = 16384;
constexpr size_t O_NORM = O_MOD + al256((size_t)2 * 5 * 6 * DM * 4);
constexpr size_t O_QCTR = O_NORM + al256((size_t)2 * 2 * 1024 * 4);
constexpr size_t O_ZERO_END = O_QCTR + 512;
constexpr size_t O_XS = O_ZERO_END;
constexpr size_t O_HB = O_XS + al256((size_t)NTOK * DM * 4);
constexpr size_t O_P = O_HB + al256((size_t)NTOK * DM * 2);
constexpr size_t O_WIN = O_P + al256((size_t)NTOK * LDP * 2);
constexpr size_t O_WBR = O_WIN + al256((size_t)LDP * DM * 2);
constexpr size_t O_WOUT = O_WBR + al256((size_t)4 * DM * BW * 2);
constexpr size_t O_WGU = O_WOUT + al256((size_t)DM * DM * 2);
constexpr size_t O_WD = O_WGU + al256((size_t)NEXP * 2 * DEXP * DM * 2);
constexpr size_t O_GLU = O_WD + al256((size_t)NEXP * DM * DEXP * 2);
constexpr size_t O_Y4 = O_GLU + al256((size_t)BW * BW * 2);
constexpr size_t O_U = O_Y4 + al256((size_t)NTOK * DM * 2);
constexpr size_t O_QKB = O_U + al256((size_t)NTOK * 1536 * 4);
constexpr size_t O_CST = O_QKB + al256((size_t)NTOK * 1024 * 2);
constexpr size_t O_NST = O_CST + al256((size_t)32 * 68 * 128 * 128 * 2);
constexpr size_t O_MST = O_NST + al256((size_t)32 * 68 * 128 * 4);
constexpr size_t O_XBC = O_MST + al256((size_t)32 * 68 * 4);
constexpr size_t O_SST = O_XBC + al256((size_t)NTOK * 1024 * 2);
constexpr size_t O_HF = O_SST + al256((size_t)64 * 68 * 64 * 128 * 2);
constexpr size_t O_YF = O_HF + al256((size_t)2 * NTOK * BW * 4);
constexpr size_t O_SF = O_YF + al256((size_t)2 * NTOK * BW * 4);
constexpr size_t O_LDT = O_SF + al256((size_t)2 * NCTX * BW * 4);
constexpr size_t O_AP = O_LDT + al256((size_t)4096 * 16);
constexpr size_t O_BBT = O_AP + al256((size_t)4096 * 33 * 8);
constexpr size_t O_KT = O_BBT + al256((size_t)4096 * 16 * 8);
constexpr size_t O_S5A = O_KT + al256((size_t)32 * 2 * 32 * 256 * 4);
constexpr size_t O_S5B = O_S5A + al256((size_t)32 * 512 * 768 * 2);
constexpr size_t O_XCTX = O_S5B + al256((size_t)32 * 512 * 768 * 2);
constexpr size_t O_Z = O_XCTX + al256((size_t)4 * 32 * 2 * 64 * 8);
constexpr size_t O_HRAW = O_Z + al256((size_t)NTOK * BW * 4);
constexpr size_t O_HSPEC = O_HRAW + al256((size_t)(SEQ + CTXL) * 2048 * 4);
constexpr size_t O_K2C = O_HSPEC + al256((size_t)1024 * 8192 * 8);
constexpr size_t O_GG = O_K2C + al256((size_t)(2 * CTXL) * 1024 * 4);
constexpr size_t O_PROBS = O_GG + al256((size_t)NTOK * BW * 2);
constexpr size_t O_ROWTOK = O_PROBS + al256((size_t)NTOK * 16 * 4);
constexpr size_t O_ROWGATE = O_ROWTOK + al256((size_t)NEXP * MOE_PAD * 4);
constexpr size_t O_INV = O_ROWGATE + al256((size_t)NEXP * MOE_PAD * 4);
constexpr size_t O_NORMP = O_INV + al256((size_t)NTOK * 16 * 4);
constexpr size_t WS_END = O_NORMP + al256((size_t)4 * 256 * 2048 * 4);
constexpr size_t O_XG = O_P;
constexpr size_t O_HID = O_P + al256((size_t)NEXP * MOE_PAD * DM * 2);
constexpr size_t O_YEXP = O_HID + al256((size_t)NEXP * MOE_PAD * DEXP * 2);
static_assert(O_YEXP + (size_t)NEXP * MOE_PAD * DM * 2 <= O_WIN, "MoE temporaries must fit inside P");
static_assert((size_t)NTOK * DM * 2 <= (size_t)NTOK * 1536 * 4, "ACCb must fit inside U");
static_assert((size_t)26214400 + (size_t)2 * 17825792 + (size_t)272 * 256 * 64 * 2 <= (size_t)NTOK * DM * 2, "strip buffers must fit inside HB");
static_assert(WS_END <= (size_t)1851000000, "workspace map exceeds the guaranteed size");

struct Args {
    const float* in[47];
    float* out; unsigned char* ws;
    int ph_lo, ph_hi;
};

__device__ __forceinline__ void conv_tile(const float* __restrict__ src, int ldsrc, int nvalid, int k0, int n0, bf16_t* __restrict__ dst, int lddst, int mode, float* T, int tid) {
    { const int n = tid & 63, kr = tid >> 6;
#pragma unroll
      for (int i = 0; i < 8; ++i) { const int k = i * 8 + kr; T[k * 65 + n] = (n0 + n < nvalid) ? src[(size_t)(k0 + k) * ldsrc + n0 + n] : 0.f; } }
    __syncthreads();
    { const int n = tid >> 3, kc = (tid & 7) * 8; const int gn = n0 + n;
      const int drow = mode == 0 ? gn : (32 * (gn >> 4) + (mode == 2 ? 16 : 0) + (gn & 15));
      u32x4 w; w.x = pk2(T[(kc + 0) * 65 + n], T[(kc + 1) * 65 + n]); w.y = pk2(T[(kc + 2) * 65 + n], T[(kc + 3) * 65 + n]);
      w.z = pk2(T[(kc + 4) * 65 + n], T[(kc + 5) * 65 + n]); w.w = pk2(T[(kc + 6) * 65 + n], T[(kc + 7) * 65 + n]);
      *(u32x4*)(dst + (size_t)drow * lddst + k0 + kc) = w; }
    __syncthreads();
}

#define IN(id) (lo <= (id) && (id) < hi)
#define SEAM(id) do { if (hi > (id) + 1) xcd_barrier(bar); } while (0)
#define PH_BEGIN int tid = threadIdx.x; asm volatile("" : "+v"(tid) :: "memory"); const int lane = tid & 63, wave = tid >> 6; (void)lane; (void)wave;

#define x_in (PT(0))
#define c_in (PT(1))
#define ctx_in (PT(2))
#define cctx_in (PT(3))
#define ada_w (PT(4))
#define ada_b (PT(5))
#define norm_mix (PT(6))
#define norm_ffn (PT(7))
#define w_in (PT(8))
#define XS ((float*)(a.ws + O_XS))
#define MOD ((float*)(a.ws + O_MOD))
#define NORM ((float*)(a.ws + O_NORM))
#define NORMP ((float*)(a.ws + O_NORMP))
#define MODl (MOD + (size_t)l * 5 * 6 * DM)
#define HB ((bf16_t*)(a.ws + O_HB))
#define P ((bf16_t*)(a.ws + O_P))
#define WIN ((bf16_t*)(a.ws + O_WIN))
#define WBR ((bf16_t*)(a.ws + O_WBR))
#define WOUT ((bf16_t*)(a.ws + O_WOUT))
#define WGU ((bf16_t*)(a.ws + O_WGU))
#define WD ((bf16_t*)(a.ws + O_WD))
#define GLU ((bf16_t*)(a.ws + O_GLU))
#define Y4 ((bf16_t*)(a.ws + O_Y4))
#define U ((float*)(a.ws + O_U))
#define ACCb ((bf16_t*)(a.ws + O_U))
#define QKB ((bf16_t*)(a.ws + O_QKB))
#define CST ((bf16_t*)(a.ws + O_CST))
#define NST ((float*)(a.ws + O_NST))
#define MST ((float*)(a.ws + O_MST))
#define XBC ((bf16_t*)(a.ws + O_XBC))
#define SSTB ((bf16_t*)(a.ws + O_SST))
#define HF ((float*)(a.ws + O_HF))
#define HBk (HF + (size_t)NTOK * BW)
#define YF ((float*)(a.ws + O_YF))
#define YB (YF + (size_t)NTOK * BW)
#define SF ((float*)(a.ws + O_SF))
#define SB (SF + (size_t)NCTX * BW)
#define LDT ((double2*)(a.ws + O_LDT))
#define APW ((float2*)(a.ws + O_AP))
#define BBT ((float2*)(a.ws + O_BBT))
#define KTB ((float*)(a.ws + O_KT))
#define S5A ((bf16_t*)(a.ws + O_S5A))
#define S5B ((bf16_t*)(a.ws + O_S5B))
#define XCTX ((float2*)(a.ws + O_XCTX))
#define S5P ((bf16_t*)(a.ws + O_HB))
#define XLOC ((float*)(a.ws + O_HB + (size_t)32 * 256 * 512 * 2))
#define KTG ((bf16_t*)(a.ws + O_HB + (size_t)26214400))
#define VTG ((bf16_t*)(a.ws + O_HB + (size_t)26214400 + (size_t)17825792))
#define BTG ((bf16_t*)(a.ws + O_HB + (size_t)26214400 + (size_t)2 * 17825792))
#define XTG ((bf16_t*)(a.ws + O_GG))
#define Z ((float*)(a.ws + O_Z))
#define HRAW ((float*)(a.ws + O_HRAW))
#define HSPEC ((float2*)(a.ws + O_HSPEC))
#define UT ((float*)(a.ws + O_U))
#define YT ((float*)(a.ws + O_Z))
#define QCTR ((int*)(a.ws + O_QCTR))
#define K2C ((float*)(a.ws + O_K2C))
#define GG ((bf16_t*)(a.ws + O_GG))
#define PROBS ((float*)(a.ws + O_PROBS))
#define ROWTOK ((int*)(a.ws + O_ROWTOK))
#define ROWGATE ((float*)(a.ws + O_ROWGATE))
#define XG ((bf16_t*)(a.ws + O_XG))
#define HID ((bf16_t*)(a.ws + O_HID))
#define YEXP ((bf16_t*)(a.ws + O_YEXP))
#define INV ((int*)(a.ws + O_INV))


__device__ __forceinline__ void moe_pair(float4 (&a)[8], const int r1, const int r2, const float g2scale, const int lane, const float* __restrict__ rowgate, const bf16_t* __restrict__ yexp) {
    const float gt1 = rowgate[r1], gt2 = rowgate[r2] * g2scale;
    const bf16_t* y1 = yexp + (size_t)r1 * DM + lane * 4; const bf16_t* y2 = yexp + (size_t)r2 * DM + lane * 4;
    u32x2 w1[8], w2[8];
#pragma unroll
    for (int i = 0; i < 8; ++i) { w1[i] = *(const u32x2*)(y1 + i * 256); w2[i] = *(const u32x2*)(y2 + i * 256); }
#pragma unroll
    for (int i = 0; i < 8; ++i) {
        a[i].x += gt1 * __uint_as_float(w1[i].x << 16); a[i].y += gt1 * __uint_as_float(w1[i].x & 0xFFFF0000u); a[i].z += gt1 * __uint_as_float(w1[i].y << 16); a[i].w += gt1 * __uint_as_float(w1[i].y & 0xFFFF0000u);
        a[i].x += gt2 * __uint_as_float(w2[i].x << 16); a[i].y += gt2 * __uint_as_float(w2[i].x & 0xFFFF0000u); a[i].z += gt2 * __uint_as_float(w2[i].y << 16); a[i].w += gt2 * __uint_as_float(w2[i].y & 0xFFFF0000u); }
}
__device__ __forceinline__ void moe_combine(float4 (&v)[8], const int tok, const int lane, const int* __restrict__ inv, const float* __restrict__ rowgate, const bf16_t* __restrict__ yexp, const float* __restrict__ m5) {
    float4 a[8];
#pragma unroll
    for (int i = 0; i < 8; ++i) a[i] = make_float4(0.f, 0.f, 0.f, 0.f);
    const int4* ip = (const int4*)(inv + (size_t)tok * 16);
    const int4 q0 = ip[0], q1 = ip[1], q2 = ip[2], q3 = ip[3];
    const int rows[16] = {q0.x, q0.y, q0.z, q0.w, q1.x, q1.y, q1.z, q1.w, q2.x, q2.y, q2.z, q2.w, q3.x, q3.y, q3.z, q3.w};
    int prow = -1;
#pragma unroll
    for (int e = 0; e < 16; ++e) { const int row = __builtin_amdgcn_readfirstlane(rows[e]);
        if (row >= 0) { if (prow >= 0) { moe_pair(a, prow, row, 1.0f, lane, rowgate, yexp); prow = -1; } else prow = row; } }
    if (prow >= 0) moe_pair(a, prow, prow, 0.0f, lane, rowgate, yexp);
#pragma unroll
    for (int i = 0; i < 8; ++i) { const float4 mm = *(const float4*)(m5 + i * 256 + lane * 4); v[i].x += mm.x * a[i].x; v[i].y += mm.y * a[i].y; v[i].z += mm.z * a[i].z; v[i].w += mm.w * a[i].w; }
}
struct CvU { const float* src; bf16_t* dst; int ldsrc, nvalid, k0, n0, lddst, mode; };
__device__ __forceinline__ void cv_load(const CvU& u, float4 (&r)[8], const int tid) {
#pragma unroll
    for (int i = 0; i < 8; ++i) { const int idx = tid + i * 512; const int k = idx >> 6, n = u.n0 + (idx & 63) * 4;
        r[i] = (n < u.nvalid) ? *(const float4*)(u.src + (size_t)(u.k0 + k) * u.ldsrc + n) : make_float4(0.f, 0.f, 0.f, 0.f); }
}
__device__ __forceinline__ void cv_stage(float* T, const float4 (&r)[8], const int tid) {
#pragma unroll
    for (int i = 0; i < 8; ++i) { const int idx = tid + i * 512; float* p = T + (idx >> 6) * 257 + (idx & 63) * 4; p[0] = r[i].x; p[1] = r[i].y; p[2] = r[i].z; p[3] = r[i].w; }
}
__device__ __forceinline__ void cv_store(const CvU& u, const float* T, const int tid) {
#pragma unroll
    for (int j = 0; j < 4; ++j) { const int o = tid + j * 512; const int kc = (o & 7) * 8, n = o >> 3; const int gn = u.n0 + n;
        const int drow = u.mode == 0 ? gn : (256 * (gn >> 7) + (u.mode == 2 ? 128 : 0) + (gn & 127));
        const float* t = T + kc * 257 + n;
        u32x4 w; w.x = pk2(t[0], t[257]); w.y = pk2(t[2 * 257], t[3 * 257]); w.z = pk2(t[4 * 257], t[5 * 257]); w.w = pk2(t[6 * 257], t[7 * 257]);
        *(u32x4*)(u.dst + (size_t)drow * u.lddst + u.k0 + kc) = w; }
}
template <int LAYER>
__device__ __forceinline__ void layer_body(const Args& a, const XcdBarrier& bar, const int lo, const int hi, const int bid, const int G, unsigned char* const shm, float* const sf, const float** const ptab) {
        constexpr int l = LAYER;
        constexpr int PB = 1 + 16 * l;
        const bool lastl = (l == 1);

        const int nPanels = lastl ? 64 : 68;
        const int M2 = nPanels * 256;

        if (IN(PB + 0)) for (int rep_ = 0; rep_ < (l == 0 ? PROBE_REPS(0) : 1); ++rep_) {
            PH_BEGIN
            {   const float* wbr = PT(40) + (size_t)l * 4 * BW * DM; const float* wout = PT(41) + (size_t)l * DM * DM;
                const float* wg = PT(43) + (size_t)l * NEXP * DM * DEXP; const float* wu = PT(44) + (size_t)l * NEXP * DM * DEXP; const float* wd = PT(45) + (size_t)l * NEXP * DEXP * DM;
                const float* wglu = PT(32) + (size_t)l * BW * BW; const float* win = w_in + (size_t)l * DM * IN_W;
                const int n_win = 32 * 55, n_br = 4 * 64, n_out = 32 * 8, n_gu = 16 * 2 * 192, n_d = 16 * 192, n_glu = 16;
                const int total = n_win + n_br + n_out + n_gu + n_d + n_glu;
#define CV_DECODE(q_, u_) do { int qq_ = (q_); \
                    if (qq_ < n_win) { u_ = CvU{win, WIN, IN_W, IN_W, (qq_ / 55) * 64, (qq_ % 55) * 256, DM, 0}; } else { qq_ -= n_win; \
                    if (qq_ < n_br) { const int k = qq_ >> 6, r = qq_ & 63; u_ = CvU{wbr + (size_t)k * BW * DM, WBR + (size_t)k * DM * BW, DM, DM, (r >> 3) * 64, (r & 7) * 256, BW, 0}; } else { qq_ -= n_br; \
                    if (qq_ < n_out) { u_ = CvU{wout, WOUT, DM, DM, (qq_ >> 3) * 64, (qq_ & 7) * 256, DM, 0}; } else { qq_ -= n_out; \
                    if (qq_ < n_gu) { const int e = qq_ / 384, r = qq_ % 384, up = r / 192, r2 = r % 192; u_ = CvU{(up ? wu : wg) + (size_t)e * DM * DEXP, WGU + (size_t)e * 2 * DEXP * DM, DEXP, DEXP, (r2 / 6) * 64, (r2 % 6) * 256, DM, 1 + up}; } else { qq_ -= n_gu; \
                    if (qq_ < n_d) { const int e = qq_ / 192, r = qq_ % 192; u_ = CvU{wd + (size_t)e * DEXP * DM, WD + (size_t)e * DM * DEXP, DM, DM, (r >> 3) * 64, (r & 7) * 256, DEXP, 0}; } else { qq_ -= n_d; \
                    u_ = CvU{wglu, GLU, BW, BW, (qq_ >> 1) * 64, (qq_ & 1) * 256, BW, 0}; } } } } } } while (0)
                __syncthreads();
                int q = bid; int buf = 0; CvU u; float4 r[8];
                if (q < total) { CV_DECODE(q, u); cv_load(u, r, tid); }
                while (q < total) {
                    float* T = sf + buf * (64 * 257);
                    cv_stage(T, r, tid);
                    __syncthreads();
                    const CvU cur = u; const int qn = q + G;
                    if (qn < total) { CV_DECODE(qn, u); cv_load(u, r, tid); }
                    cv_store(cur, T, tid);
                    buf ^= 1; q = qn;
                }
#undef CV_DECODE
                __syncthreads();
            }
            for (int set = 0; set < (lastl ? 1 : 2); ++set) {
                const int L = set ? CTXL : SEQ; float* HR = HRAW + (set ? (size_t)SEQ * 2048 : 0);
                const float* w1 = PT(11) + l * 33 * 64; const float* b1 = PT(12) + l * 64; const float* fr1 = PT(13) + l * 64; const float* w2 = PT(14) + l * 64 * 64; const float* b2 = PT(15) + l * 64;
                const float* fr2 = PT(16) + l * 64; const float* w3 = PT(17) + l * 64 * 2048; const float* decay = PT(18) + l * 2048;
                float* feats = sf; float* h1 = sf + 16 * 33; float* h2 = h1 + 16 * 64;
                float nacc[4] = {0.f, 0.f, 0.f, 0.f};
                for (int base = bid; base < L; base += 16 * G) {
                    __syncthreads();
                    for (int e = tid; e < 16 * 33; e += NTHR) { const int ti = e / 33, fi = e % 33; int t = base + ti * G; if (t > L - 1) t = L - 1;
                        float v;
                        if (fi == 0) v = (float)t / (float)(L - 1);
                        else { const int j = (fi - 1) & 15; const double fr = 1e-4 + (double)j * ((15.0 - 1e-4) / 15.0); const double ang = (2.0 * 3.14159265358979323846 / (double)L) * (double)t * fr; v = fi <= 16 ? (float)cos(ang) : (float)(-sin(ang)); }
                        feats[e] = v; }
                    __syncthreads();
                    { const int j = tid & 63, ti = tid >> 6; float s0 = b1[j], s1 = s0;
_Pragma("unroll 3")
                      for (int i = 0; i < 33; ++i) { const float wv = w1[i * 64 + j]; s0 += feats[ti * 33 + i] * wv; s1 += feats[(ti + 8) * 33 + i] * wv; }
                      const float f1 = fr1[j]; h1[ti * 64 + j] = sinf(f1 * s0); h1[(ti + 8) * 64 + j] = sinf(f1 * s1); }
                    __syncthreads();
                    { const int j = tid & 63, ti = tid >> 6; float s0 = b2[j], s1 = s0;
_Pragma("unroll 4")
                      for (int i = 0; i < 64; ++i) { const float wv = w2[i * 64 + j]; s0 += h1[ti * 64 + i] * wv; s1 += h1[(ti + 8) * 64 + i] * wv; }
                      const float f2 = fr2[j]; h2[ti * 64 + j] = sinf(f2 * s0); h2[(ti + 8) * 64 + j] = sinf(f2 * s1); }
                    __syncthreads();
                    float acc[16][4];
#pragma unroll
                    for (int ti = 0; ti < 16; ++ti) { acc[ti][0] = 0.f; acc[ti][1] = 0.f; acc[ti][2] = 0.f; acc[ti][3] = 0.f; }
#pragma unroll 2
                    for (int i = 0; i < 64; ++i) { const float* wrow = w3 + (size_t)i * 2048 + tid; const float wa = wrow[0], wb = wrow[512], wc2 = wrow[1024], wd2 = wrow[1536];
#pragma unroll
                        for (int ti = 0; ti < 16; ++ti) { const float hv = h2[ti * 64 + i]; acc[ti][0] += hv * wa; acc[ti][1] += hv * wb; acc[ti][2] += hv * wc2; acc[ti][3] += hv * wd2; } }
                    float dk[4];
#pragma unroll
                    for (int k = 0; k < 4; ++k) dk[k] = fabsf(decay[tid + k * 512]);
#pragma unroll
                    for (int ti = 0; ti < 16; ++ti) { const int t = base + ti * G; if (t < L) { const float tn = (float)t / (float)(L - 1);
#pragma unroll
                        for (int k = 0; k < 4; ++k) { const float v = acc[ti][k] * expf(-tn * dk[k]); HR[(size_t)t * 2048 + tid + k * 512] = v; nacc[k] += fabsf(v); } } }
                }
                float* nrp = NORMP + ((size_t)(l * 2 + set) * 256 + bid) * 2048;
#pragma unroll
                for (int k = 0; k < 4; ++k) nrp[tid + k * 512] = nacc[k];
            }
            for (int idx = bid * NTHR + tid; idx < 4096; idx += G * NTHR) { const int n = idx & 63, g = (idx >> 6) & 31, dir = idx >> 11;
                const double are = (double)(PT(24) + l * 4096)[idx], aim = (double)(PT(25) + l * 4096)[idx]; const double lam = are < -1e-4 ? are : -1e-4; const double dt = exp((double)(PT(26) + l * 64)[dir * 32 + g]);
                const double ldre = lam * dt, ldim = aim * dt; LDT[idx] = make_double2(ldre, ldim);
                const double mag = exp(ldre); const double ar = mag * cos(ldim), ai = mag * sin(ldim);
                const double den = lam * lam + aim * aim; const double nr = ar - 1.0, ni = ai; const double fre = (nr * lam + ni * aim) / den, fim = (ni * lam - nr * aim) / den;
                const float* b_re = PT(27) + l * 32 * 64 * 16; const float* b_im = PT(28) + l * 32 * 64 * 16;
#pragma unroll 4
                for (int c = 0; c < 16; ++c) { const double br = (double)b_re[(g * 64 + n) * 16 + c], bi = (double)b_im[(g * 64 + n) * 16 + c]; BBT[idx * 16 + c] = make_float2((float)(fre * br - fim * bi), (float)(fre * bi + fim * br)); }
            }
            for (int e2 = bid * NTHR + tid; e2 < 4096 * 33; e2 += G * NTHR) { const int idx = e2 / 33, k = e2 - idx * 33; const int g = (idx >> 6) & 31, dir = idx >> 11;
                const double are = (double)(PT(24) + l * 4096)[idx], aim = (double)(PT(25) + l * 4096)[idx]; const double lam = are < -1e-4 ? are : -1e-4; const double dt = exp((double)(PT(26) + l * 64)[dir * 32 + g]);
                const double ldre = lam * dt, ldim = aim * dt; const double mk = exp(ldre * k); APW[e2] = make_float2((float)(mk * cos(ldim * k)), (float)(mk * sin(ldim * k))); }
            if (l == 0 && lo == 0) xcd_barrier(bar);
            for (int tok = bid * 8 + wave; tok < NTOK; tok += G * 8) {
                const int r = tok < NLAT ? tok / SEQ : 4; const float* xr = l == 0 ? (tok < NLAT ? x_in + (size_t)tok * DM : ctx_in + (size_t)(tok - NLAT) * DM) : XS + (size_t)tok * DM; const float* gn = norm_mix + l * DM;
                const float* sh = MODl + (size_t)(r * 6 + 0) * DM; const float* sc = MODl + (size_t)(r * 6 + 1) * DM;
                float4 v[8]; float ss = 0.f;
#pragma unroll
                for (int i = 0; i < 8; ++i) v[i] = *(const float4*)(xr + i * 256 + lane * 4);
                if (l > 0) {
                    moe_combine(v, tok, lane, INV, ROWGATE, YEXP, MOD + (size_t)((l - 1) * 5 + r) * 6 * DM + 5 * DM);
#pragma unroll
                    for (int i = 0; i < 8; ++i) *(float4*)(XS + (size_t)tok * DM + i * 256 + lane * 4) = v[i]; }
#pragma unroll
                for (int i = 0; i < 8; ++i) ss += v[i].x * v[i].x + v[i].y * v[i].y + v[i].z * v[i].z + v[i].w * v[i].w;
                ss = wave_sum(ss); const float rs = rsqrtf(ss * (1.0f / DM) + 1e-6f);
#pragma unroll
                for (int i = 0; i < 8; ++i) { const int d = i * 256 + lane * 4; const float4 g4 = *(const float4*)(gn + d), s4 = *(const float4*)(sc + d), h4 = *(const float4*)(sh + d);
                    v[i].x = v[i].x * rs * g4.x * (1.f + s4.x) + h4.x; v[i].y = v[i].y * rs * g4.y * (1.f + s4.y) + h4.y; v[i].z = v[i].z * rs * g4.z * (1.f + s4.z) + h4.z; v[i].w = v[i].w * rs * g4.w * (1.f + s4.w) + h4.w; }
#pragma unroll
                for (int i = 0; i < 8; ++i) { u32x2 w; w.x = pk2(v[i].x, v[i].y); w.y = pk2(v[i].z, v[i].w); *(u32x2*)(HB + (size_t)tok * DM + i * 256 + lane * 4) = w; }
            }
            SEAM(PB + 0);
        }

        if (IN(PB + 1)) for (int rep_ = 0; rep_ < PROBE_REPS(1); ++rep_) {
            PH_BEGIN
            for (int base = bid * 8; base < (lastl ? 1 : 2) * 1024; base += G * 8) {
                const int idx = base + (tid & 7), sl = tid >> 3; const int set = idx >> 10, oc = idx & 1023, o = oc >> 9, c = oc & 511;
                const float* pp = NORMP + (size_t)(l * 2 + set) * 256 * 2048 + o * 1024 + c + (size_t)(sl * 4) * 2048; float sacc = 0.f;
#pragma unroll
                for (int j = 0; j < 4; ++j) { const float p0 = pp[(size_t)j * 2048], p1 = pp[(size_t)j * 2048 + 512]; sacc += (sl * 4 + j < G) ? p0 + p1 : 0.f; }
                sf[sl * 8 + (tid & 7)] = sacc; __syncthreads();
                if (tid < 8) { float t = 0.f;
#pragma unroll 8
                    for (int q = 0; q < 64; ++q) t += sf[q * 8 + tid];
                    NORM[(size_t)(l * 2 + set) * 1024 + oc] = t; }
                __syncthreads(); }
            for (int idx = (G - 1 - bid) * NTHR + tid; idx < 32768; idx += G * NTHR) { const int c = idx & 15, lag = (idx >> 4) & 31, dir = (idx >> 9) & 1, g = idx >> 10;
                const float* c_re = PT(29) + l * 32 * 16 * 64 + (g * 16 + c) * 64; const float* c_im = PT(30) + l * 32 * 16 * 64 + (g * 16 + c) * 64;
                float acc[16];
#pragma unroll
                for (int j = 0; j < 16; ++j) acc[j] = 0.f;
#pragma unroll 2
                for (int n = 0; n < 64; ++n) { const int pi = (dir * 32 + g) * 64 + n; const float2 ap = APW[pi * 33 + lag]; const float cr = c_re[n], ci = c_im[n]; const float wr_ = cr * ap.x - ci * ap.y, wi_ = cr * ap.y + ci * ap.x;
                    const float4* bb = (const float4*)(BBT + pi * 16);
#pragma unroll
                    for (int j = 0; j < 8; ++j) { const float4 b2 = bb[j]; acc[2 * j] += wr_ * b2.x - wi_ * b2.y; acc[2 * j + 1] += wr_ * b2.z - wi_ * b2.w; } }
                float4* o = (float4*)(KTB + (size_t)idx * 16);
                o[0] = make_float4(acc[0], acc[1], acc[2], acc[3]); o[1] = make_float4(acc[4], acc[5], acc[6], acc[7]); o[2] = make_float4(acc[8], acc[9], acc[10], acc[11]); o[3] = make_float4(acc[12], acc[13], acc[14], acc[15]);
            }
            __syncthreads();
            pg8::Gemm g{HB, WIN, DM, DM, DM}; pg8::SchedStd S{68, 55, G, bid, DM, DM}; pg8::EpiWin E{P, LDP};
            pg8::gemm_phase(( LAS unsigned char*)shm, g, S, E);
#if defined(PROBE_BNOEPI)
            { __syncthreads(); pg8::EpiNone E0; pg8::gemm_phase((LAS unsigned char*)shm, g, S, E0); }
#endif
            SEAM(PB + 1);
        }

        if (IN(PB + 2)) for (int rep_ = 0; rep_ < PROBE_REPS(2); ++rep_) {
            PH_BEGIN
            const float* hcw = PT(9) + l * 3 * 1536; const float* hcb = PT(10) + l * 1536; const float* mcw = PT(20) + l * 3 * 1024; const float* mcb = PT(21) + l * 1024;
            const float* scw = PT(34) + l * 3 * 1024; const float* scb = PT(35) + l * 1024;
            for (int unit = bid; unit < 272 * 3; unit += G) { const int seg = unit / 3, kind = unit % 3; const bool lat = seg < 256; const size_t tok0 = lat ? (size_t)seg * 64 : (size_t)NLAT + (size_t)(seg - 256) * 64;
                if (kind < 2) { const int hf = kind;
                    const int c = tid * 2; const int col = (hf ? SSD_OFF + 512 : ML_OFF) + c; const float* w = hf ? scw : mcw; const float* bsp = hf ? scb : mcb; bf16_t* dst = (hf ? XBC : QKB) + tok0 * 1024 + c;
                    const float2 w0 = *(const float2*)(w + c), w1 = *(const float2*)(w + 1024 + c), w2 = *(const float2*)(w + 2048 + c), bb = *(const float2*)(bsp + c);
                    const float osc = (!hf && c >= 512) ? 0.08838834764831845f : 1.0f;
                    const bool hasPrev = !lat && ((tok0 - NLAT) & (CTXL - 1)) != 0, hasNext = !lat && (((tok0 - NLAT) + 63) & (CTXL - 1)) != CTXL - 1;
                    bf16_t* strip = nullptr;
                    if (!hf) { if (c >= 512) strip = KTG + ((size_t)seg * 512 + (c - 512)) * 64; }
                    else { if (c < 512) strip = XTG + ((size_t)seg * 512 + c) * 64; else if (c < 768) strip = BTG + ((size_t)seg * 256 + (c - 512)) * 64; }
                    const bf16_t* pp = P + tok0 * LDP + col;
                    unsigned raw[66];
#pragma unroll
                    for (int t = 0; t < 66; ++t) raw[t] = ((t == 0 && !hasPrev) || (t == 65 && !hasNext)) ? 0u : *(const unsigned*)(pp + (ptrdiff_t)(t - 1) * LDP);
#pragma unroll
                    for (int t8 = 0; t8 < 8; ++t8) { float v0[8], v1[8];
#pragma unroll
                        for (int tt = 0; tt < 8; ++tt) { const int t = t8 * 8 + tt; const unsigned p0 = raw[t], p1 = raw[t + 1], p2 = raw[t + 2];
                            float a0 = bb.x + w0.x * __uint_as_float(p0 << 16) + w1.x * __uint_as_float(p1 << 16) + w2.x * __uint_as_float(p2 << 16);
                            float a1 = bb.y + w0.y * __uint_as_float(p0 & 0xFFFF0000u) + w1.y * __uint_as_float(p1 & 0xFFFF0000u) + w2.y * __uint_as_float(p2 & 0xFFFF0000u);
                            a0 = siluf_(a0) * osc; a1 = siluf_(a1) * osc; v0[tt] = a0; v1[tt] = a1;
                            *(unsigned*)(dst + (size_t)t * 1024) = pk2(a0, a1); }
                        if (strip) { u32x4 s0, s1; s0.x = pk2(v0[0], v0[1]); s0.y = pk2(v0[2], v0[3]); s0.z = pk2(v0[4], v0[5]); s0.w = pk2(v0[6], v0[7]); s1.x = pk2(v1[0], v1[1]); s1.y = pk2(v1[2], v1[3]); s1.z = pk2(v1[4], v1[5]); s1.w = pk2(v1[6], v1[7]);
                            *(u32x4*)(strip + t8 * 8) = s0; *(u32x4*)(strip + 64 + t8 * 8) = s1; } }
                } else {
                    const int c = (tid & 255) * 2, th = tid >> 8; const bf16_t* pp = P + (tok0 + th * 32) * LDP + ML_OFF + 1024 + c; bf16_t* strip = VTG + ((size_t)seg * 512 + c) * 64 + th * 32;
                    unsigned rv[32];
#pragma unroll
                    for (int t = 0; t < 32; ++t) rv[t] = *(const unsigned*)(pp + (size_t)t * LDP);
#pragma unroll
                    for (int t8 = 0; t8 < 4; ++t8) { u32x4 s0, s1;
                        s0.x = (rv[t8 * 8 + 0] & 0xFFFFu) | (rv[t8 * 8 + 1] << 16); s0.y = (rv[t8 * 8 + 2] & 0xFFFFu) | (rv[t8 * 8 + 3] << 16); s0.z = (rv[t8 * 8 + 4] & 0xFFFFu) | (rv[t8 * 8 + 5] << 16); s0.w = (rv[t8 * 8 + 6] & 0xFFFFu) | (rv[t8 * 8 + 7] << 16);
                        s1.x = (rv[t8 * 8 + 0] >> 16) | (rv[t8 * 8 + 1] & 0xFFFF0000u); s1.y = (rv[t8 * 8 + 2] >> 16) | (rv[t8 * 8 + 3] & 0xFFFF0000u); s1.z = (rv[t8 * 8 + 4] >> 16) | (rv[t8 * 8 + 5] & 0xFFFF0000u); s1.w = (rv[t8 * 8 + 6] >> 16) | (rv[t8 * 8 + 7] & 0xFFFF0000u);
                        *(u32x4*)(strip + t8 * 8) = s0; *(u32x4*)(strip + 64 + t8 * 8) = s1; }
                }
            }
            if (!lastl) for (int tok = NLAT + bid; tok < NTOK; tok += G) {
                const int t = (tok - NLAT) & (CTXL - 1); const bool hasL = (t != 0), hasR = (t != CTXL - 1); const bf16_t* pr = P + (size_t)tok * LDP;
                const bf16_t* prL = hasL ? pr - LDP : pr; const bf16_t* prR = hasR ? pr + LDP : pr;
                unsigned short xc[3], xl[3], xr[3];
#pragma unroll
                for (int j = 0; j < 3; ++j) { const int cc = tid + j * 512; xc[j] = pr[HY_OFF + cc]; xl[j] = prL[HY_OFF + cc]; xr[j] = prR[HY_OFF + cc]; }
#pragma unroll
                for (int j = 0; j < 3; ++j) { const int cc = tid + j * 512;
                    float acc = hcb[cc] + hcw[1536 + cc] * bf2f(xc[j]);
                    acc += hasL ? hcw[cc] * bf2f(xl[j]) : 0.f;
                    acc += hasR ? hcw[2 * 1536 + cc] * bf2f(xr[j]) : 0.f;
                    U[(size_t)tok * 1536 + cc] = acc; }
            }
            for (int idx0 = bid * NTHR + tid; idx0 < 16384 * 64; idx0 += 4 * G * NTHR) { u32x4 t4[4];
#pragma unroll
                for (int q = 0; q < 4; ++q) { const int idx = idx0 + q * G * NTHR; const int half = idx & 1, g = (idx >> 1) & 31, tok = idx >> 6;
                    if (idx < 16384 * 64) t4[q] = *(const u32x4*)(P + (size_t)tok * LDP + S5_OFF + g * 16 + half * 8); }
#pragma unroll
                for (int q = 0; q < 4; ++q) { const int idx = idx0 + q * G * NTHR; const int half = idx & 1, g = (idx >> 1) & 31, tok = idx >> 6;
                    if (idx < 16384 * 64) *(u32x4*)(S5A + ((size_t)g * 512 + (tok >> 5)) * 768 + (tok & 31) * 16 + half * 8) = t4[q]; } }
            for (int idx = bid * NTHR + tid; idx < 32 * 512 * 32 * 2; idx += G * NTHR) { const int half = idx & 1, sI = (idx >> 1) & 31, row = (idx >> 6) & 511, g = idx >> 15; const int t = row >> 4, c = row & 15; const int lag = t - sI;
                float v[8];
                if (lag > 0) { const float4* k4 = (const float4*)(KTB + ((size_t)((g * 2 + 0) * 32 + lag) * 16 + c) * 16 + half * 8); const float4 a0 = k4[0], a1 = k4[1]; v[0] = a0.x; v[1] = a0.y; v[2] = a0.z; v[3] = a0.w; v[4] = a1.x; v[5] = a1.y; v[6] = a1.z; v[7] = a1.w; }
                else if (lag < 0) { const float4* k4 = (const float4*)(KTB + ((size_t)((g * 2 + 1) * 32 - lag) * 16 + c) * 16 + half * 8); const float4 a0 = k4[0], a1 = k4[1]; v[0] = a0.x; v[1] = a0.y; v[2] = a0.z; v[3] = a0.w; v[4] = a1.x; v[5] = a1.y; v[6] = a1.z; v[7] = a1.w; }
                else { const float4* k4 = (const float4*)(KTB + ((size_t)((g * 2 + 0) * 32) * 16 + c) * 16 + half * 8); const float4* q4 = (const float4*)(KTB + ((size_t)((g * 2 + 1) * 32) * 16 + c) * 16 + half * 8); const float4 a0 = k4[0], a1 = k4[1], b0 = q4[0], b1 = q4[1];
                    v[0] = a0.x + b0.x; v[1] = a0.y + b0.y; v[2] = a0.z + b0.z; v[3] = a0.w + b0.w; v[4] = a1.x + b1.x; v[5] = a1.y + b1.y; v[6] = a1.z + b1.z; v[7] = a1.w + b1.w; }
                u32x4 w; w.x = pk2(v[0], v[1]); w.y = pk2(v[2], v[3]); w.z = pk2(v[4], v[5]); w.w = pk2(v[6], v[7]);
                *(u32x4*)(S5B + ((size_t)g * 512 + row) * 768 + sI * 16 + half * 8) = w; }
            for (int idx = bid * NTHR + tid; idx < 32 * 512 * 64; idx += G * NTHR) { const int n = idx & 63, row = (idx >> 6) & 511, g = idx >> 15; const int t = row >> 4, c = row & 15;
                const float cr = (PT(29) + l * 32 * 16 * 64)[(g * 16 + c) * 64 + n], ci = (PT(30) + l * 32 * 16 * 64)[(g * 16 + c) * 64 + n];
                const float2 af = APW[((0 * 32 + g) * 64 + n) * 33 + t + 1], ab = APW[((1 * 32 + g) * 64 + n) * 33 + 32 - t];
                bf16_t* d = S5B + ((size_t)g * 512 + row) * 768 + 512 + 2 * n;
                *(unsigned*)d = pk2(cr * af.x - ci * af.y, -(cr * af.y + ci * af.x)); *(unsigned*)(d + 128) = pk2(cr * ab.x - ci * ab.y, -(cr * ab.y + ci * ab.x)); }
            for (int idx = bid * NTHR + tid; idx < 32 * 2 * 64 * 32; idx += G * NTHR) { const int sI = idx & 31, n = (idx >> 5) & 63, dir = (idx >> 11) & 1, g = idx >> 12; const int pi = (dir * 32 + g) * 64 + n;
                const float2 pw = APW[pi * 33 + (dir ? sI : 31 - sI)]; const float4* bb = (const float4*)(BBT + pi * 16);
                float re[16], im[16];
#pragma unroll
                for (int j = 0; j < 8; ++j) { const float4 b2 = bb[j]; re[2 * j] = pw.x * b2.x - pw.y * b2.y; im[2 * j] = pw.x * b2.y + pw.y * b2.x; re[2 * j + 1] = pw.x * b2.z - pw.y * b2.w; im[2 * j + 1] = pw.x * b2.w + pw.y * b2.z; }
                bf16_t* d = S5P + ((size_t)g * 256 + dir * 128 + 2 * n) * 512 + sI * 16;
                u32x4 w0, w1; w0.x = pk2(re[0], re[1]); w0.y = pk2(re[2], re[3]); w0.z = pk2(re[4], re[5]); w0.w = pk2(re[6], re[7]); w1.x = pk2(re[8], re[9]); w1.y = pk2(re[10], re[11]); w1.z = pk2(re[12], re[13]); w1.w = pk2(re[14], re[15]);
                *(u32x4*)d = w0; *(u32x4*)(d + 8) = w1;
                w0.x = pk2(im[0], im[1]); w0.y = pk2(im[2], im[3]); w0.z = pk2(im[4], im[5]); w0.w = pk2(im[6], im[7]); w1.x = pk2(im[8], im[9]); w1.y = pk2(im[10], im[11]); w1.z = pk2(im[12], im[13]); w1.w = pk2(im[14], im[15]);
                *(u32x4*)(d + 512) = w0; *(u32x4*)(d + 520) = w1; }
            {   float* T = sf;
                for (int unit = bid; unit < 4 * 64 * 24; unit += G) { const int b = unit / (64 * 24), r = (unit / 24) % 64, c0 = (unit % 24) * 64; const size_t tok0 = (size_t)b * SEQ + r * 64;
                    __syncthreads();
#pragma unroll
                    for (int i = 0; i < 8; ++i) { const int c = tid & 63, t = (tid >> 6) + 8 * i; T[t * 65 + c] = bf2f(P[(tok0 + t) * LDP + HY_OFF + c0 + c]); }
                    __syncthreads();
                    const int c = tid >> 3, tq = (tid & 7) * 8, cc = c0 + c; const float w0 = hcw[cc], w1 = hcw[1536 + cc], w2 = hcw[3072 + cc], bb = hcb[cc];
                    float o8[8];
#pragma unroll
                    for (int i = 0; i < 8; ++i) { const int t = tq + i; float acc = bb + w1 * T[t * 65 + c]; if (t > 0) acc += w0 * T[(t - 1) * 65 + c]; if (t < 63) acc += w2 * T[(t + 1) * 65 + c]; o8[i] = acc; }
                    float* dst = UT + ((size_t)b * 1536 + cc) * SEQ + r * 64 + tq;
                    *(float4*)dst = make_float4(o8[0], o8[1], o8[2], o8[3]); *(float4*)(dst + 4) = make_float4(o8[4], o8[5], o8[6], o8[7]);
                } }
            if (!lastl) {
                const int L = CTXL; const float* HR = HRAW + (size_t)SEQ * 2048; float* K2 = K2C; const float* nrm = NORM + (size_t)(l * 2 + 1) * 1024;
                const size_t total = (size_t)(2 * L - 1) * 1024;
                for (size_t i = (size_t)bid * NTHR + tid; i < total; i += (size_t)G * NTHR) { const int j = (int)(i >> 10), oc = (int)(i & 1023), o = oc >> 9, c = oc & 511; const int lag = j - (L - 1);
                    const float v = lag >= 0 ? HR[(size_t)lag * 2048 + o * 1024 + c] : HR[(size_t)(-lag) * 2048 + o * 1024 + 512 + c];
                    K2[((size_t)j * 2 + o) * 512 + c] = v / nrm[oc]; }
            }
            {   __syncthreads(); fft_twiddles((float2*)(shm + FFT_X_BYTES), tid);
                for (int oc = bid; oc < 1024; oc += G) hyena_spec_item(oc, HRAW, NORM + (size_t)(l * 2 + 0) * 1024, HSPEC, shm, tid);
                __syncthreads(); }
            SEAM(PB + 2);
        }

        if (IN(PB + 3)) for (int rep_ = 0; rep_ < PROBE_REPS(3); ++rep_) {
            PH_BEGIN
            if (rep_ > 0) { if (bid == 0 && tid == 0) __hip_atomic_store(QCTR + l * 64, 0, __ATOMIC_RELAXED, __HIP_MEMORY_SCOPE_AGENT); xcd_barrier(bar); }
            if (bid < 64) {
                mlstm_state_pass(bid >> 1, bid & 1, P, KTG, VTG, PT(22) + l * 16, CST, NST, MST, shm, tid);
            } else if (bid < 128) {
                { const int ch = bid - 64; const int dir_ = ch & 1, h_ = (ch >> 1) & 7; ssd_state_pass(ch, P, BTG, XTG, -expf(PT(37)[l * 16 + dir_ * 8 + h_]), PT(36)[l * 16 + dir_ * 8 + h_], SSTB, shm, tid); }
            } else if (bid < 160) {
                const int widx = (bid - 128) * 8 + wave; const int dir = widx & 1, g = (widx >> 1) & 31, b = widx >> 6; const int n = lane;
                float2* xb = (float2*)(shm + (size_t)wave * 16640); float2* ctab = xb + 16 * 65;
                const float* a_re = PT(24) + l * 2 * 32 * 64; const float* a_im = PT(25) + l * 2 * 32 * 64; const float* log_dt = PT(26) + l * 64;
                const float* b_re = PT(27) + l * 32 * 64 * 16; const float* b_im = PT(28) + l * 32 * 64 * 16; const float* c_re = PT(29) + l * 32 * 16 * 64; const float* c_im = PT(30) + l * 32 * 16 * 64;
#pragma unroll
                for (int c = 0; c < 16; ++c) ctab[c * 65 + lane] = make_float2(c_re[(g * 16 + c) * 64 + lane], c_im[(g * 16 + c) * 64 + lane]);
                float abr, abi, bbr[16], bbi[16];
                {   const double are = (double)a_re[(dir * 32 + g) * 64 + n], aim = (double)a_im[(dir * 32 + g) * 64 + n];
                    const double lam = are < -1e-4 ? are : -1e-4; const double dt = exp((double)log_dt[dir * 32 + g]);
                    const double mag = exp(lam * dt); const double ar = mag * cos(aim * dt), ai = mag * sin(aim * dt);
                    const double den = lam * lam + aim * aim; const double nr = ar - 1.0, ni = ai;
                    const double fre = (nr * lam + ni * aim) / den, fim = (ni * lam - nr * aim) / den;
                    abr = (float)ar; abi = (float)ai;
#pragma unroll
                    for (int c = 0; c < 16; ++c) { const double br = (double)b_re[(g * 64 + n) * 16 + c], bi = (double)b_im[(g * 64 + n) * 16 + c]; bbr[c] = (float)(fre * br - fim * bi); bbi[c] = (float)(fre * bi + fim * br); }
                }
                float xr = 0.f, xi = 0.f; float* Sout = (dir ? SB : SF) - (size_t)NLAT * BW;
                const int s = lane >> 2, cg = lane & 3;
                for (int i0 = 0; i0 < CTXL; i0 += 16) {
#pragma unroll 4
                    for (int ss = 0; ss < 16; ++ss) {
                        const size_t tok = (size_t)step_tok(b, dir, i0 + ss);
                        const u32x4* up = (const u32x4*)(P + tok * LDP + S5_OFF + g * 16);
                        float t0[8], t1[8]; unpack8(up[0], t0); unpack8(up[1], t1);
                        float bur = 0.f, bui = 0.f;
#pragma unroll
                        for (int c = 0; c < 8; ++c) { bur += t0[c] * bbr[c] + t1[c] * bbr[8 + c]; bui += t0[c] * bbi[c] + t1[c] * bbi[8 + c]; }
                        const float nxr = abr * xr - abi * xi + bur, nxi = abr * xi + abi * xr + bui; xr = nxr; xi = nxi;
                        xb[ss * 65 + lane] = make_float2(xr, xi);
                    }
                    asm volatile("s_waitcnt lgkmcnt(0)" ::: "memory");
                    float y0 = 0.f, y1 = 0.f, y2 = 0.f, y3 = 0.f;
                    for (int nn2 = 0; nn2 < 64; ++nn2) { const float2 xv = xb[s * 65 + nn2];
                        const float2 c0 = ctab[(cg * 4 + 0) * 65 + nn2], c1 = ctab[(cg * 4 + 1) * 65 + nn2], c2 = ctab[(cg * 4 + 2) * 65 + nn2], c3 = ctab[(cg * 4 + 3) * 65 + nn2];
                        y0 += xv.x * c0.x - xv.y * c0.y; y1 += xv.x * c1.x - xv.y * c1.y; y2 += xv.x * c2.x - xv.y * c2.y; y3 += xv.x * c3.x - xv.y * c3.y; }
                    const size_t toks = (size_t)step_tok(b, dir, i0 + s);
                    *(float4*)(Sout + toks * BW + g * 16 + cg * 4) = make_float4(y0, y1, y2, y3);
                    asm volatile("s_waitcnt lgkmcnt(0)" ::: "memory");
                }
                XCTX[((b * 32 + g) * 2 + dir) * 64 + n] = make_float2(xr, xi);
            } else {
                if (bid < 224) {
                    pg8::Gemm gg_{S5A, S5P, 768, 512, 512}; pg8::SchedS5a S_{bid - 160}; pg8::EpiXloc E_{XLOC};
                    pg8::gemm_phase((LAS unsigned char*)shm, gg_, S_, E_);
                    __syncthreads();
                }
                const int nhb = G - 160, hb = bid - 160; const float* bias = PT(19) + l * 1024; const int c = tid;
                const int nitems = lastl ? 0 : 4 * (CTXL / 8);
                for (int it = hb; it < nitems; it += nhb) {
                    int L, tokbase, b, t0; const float* K2;
                    { const int q = it; L = CTXL; tokbase = NLAT; b = q / (CTXL / 8); t0 = (q % (CTXL / 8)) * 8; K2 = K2C; }
                    const float* zb = U + (size_t)(tokbase + b * L) * 1536 + c;
                    float acc[8];
#pragma unroll
                    for (int i = 0; i < 8; ++i) acc[i] = 0.f;
                    const int base = t0 + L - 1;
                    for (int s = 0; s < L; s += 8) {
                        float k[15];
#pragma unroll
                        for (int mm = 0; mm < 15; ++mm) k[mm] = K2[((size_t)(base - s - 7 + mm) * 2 + 0) * 512 + c];
#pragma unroll
                        for (int ds = 0; ds < 8; ++ds) { const float z = zb[(size_t)(s + ds) * 1536];
#pragma unroll
                            for (int i = 0; i < 8; ++i) acc[i] += k[i - ds + 7] * z; }
                    }
#pragma unroll
                    for (int i = 0; i < 8; ++i) { const size_t tok = (size_t)(tokbase + b * L + t0 + i); const float zt = U[tok * 1536 + c]; Z[tok * BW + c] = (acc[i] + bias[c] * zt) * U[tok * 1536 + 512 + c]; }
                }
            }
            {   __syncthreads(); fft_twiddles((float2*)(shm + FFT_X_BYTES), tid);
                int* qslot = (int*)(shm + FFT_X_BYTES + 65536);
                for (;;) { __syncthreads(); if (tid == 0) *qslot = atomicAdd(QCTR + l * 64, 1); __syncthreads(); const int it = *qslot; if (it >= 1024) break;
                    hyena_fft_item(it, UT, HSPEC, PT(19) + l * 1024, YT, shm, tid); }
            }
            SEAM(PB + 3);
        }

        if (IN(PB + 4)) for (int rep_ = 0; rep_ < PROBE_REPS(4); ++rep_) {
            PH_BEGIN
            if (rep_ > 0) { if (bid == 0 && tid == 0) __hip_atomic_store(QCTR + l * 64 + 32, 0, __ATOMIC_RELAXED, __HIP_MEMORY_SCOPE_AGENT); xcd_barrier(bar); }
            if (bid >= G - 32) for (int idx = (bid - (G - 32)) * NTHR + tid; idx < 16384; idx += 32 * NTHR) { const int n = idx & 63, dir = (idx >> 6) & 1, b = (idx >> 7) & 3, g = idx >> 9;
                const float2 a32 = APW[((dir * 32 + g) * 64 + n) * 33 + 32]; float2 X = XCTX[((b * 32 + g) * 2 + dir) * 64 + n];
                const float* __restrict__ xl = XLOC + ((size_t)g * 512 + b * 128) * 256 + dir * 128 + 2 * n; bf16_t* __restrict__ dst = S5A + ((size_t)g * 512 + b * 128) * 768 + 512 + dir * 128 + 2 * n;
#pragma unroll 1
                for (int j0 = 0; j0 < 128; j0 += 16) { float2 xv[16];
#pragma unroll
                    for (int q = 0; q < 16; ++q) { const int j = dir ? 127 - (j0 + q) : j0 + q; xv[q] = *(const float2*)(xl + (size_t)j * 256); }
#pragma unroll
                    for (int q = 0; q < 16; ++q) { const int j = dir ? 127 - (j0 + q) : j0 + q;
                        *(unsigned*)(dst + (size_t)j * 768) = pk2(X.x, X.y);
                        const float nx = a32.x * X.x - a32.y * X.y + xv[q].x, ny = a32.x * X.y + a32.y * X.x + xv[q].y; X.x = nx; X.y = ny; } } }
            {   int* qslot = (int*)(shm + 102400);
                for (;;) { __syncthreads(); if (tid == 0) *qslot = atomicAdd(QCTR + l * 64 + 32, 1); __syncthreads(); const int it = *qslot; if (it >= 32 * 68 + 64 * 68) break;
                    if (it < 32 * 68) { const int chain = it / 68, c = it % 68; mlstm_out_item(chain, c, P, QKB, VTG, PT(22) + l * 16, CST, NST, MST, (chain & 1) ? HBk : HF, shm, tid); }
                    else { const int i2 = it - 32 * 68; const int chain = i2 / 68, c = i2 % 68; const int dir_ = chain & 1, h_ = (chain >> 1) & 7;
                        ssd_out_item(chain, c, P, XBC, XTG, -expf(PT(37)[l * 16 + dir_ * 8 + h_]), PT(36)[l * 16 + dir_ * 8 + h_], SSTB, dir_ ? YB : YF, shm, tid); } }
            }
            __syncthreads();
            {   const float* bias = PT(19) + l * 1024 + 512; const int c = tid;
                const int nitems = lastl ? 0 : 4 * (CTXL / 8);
                for (int it = bid; it < nitems; it += G) {
                    int L, tokbase, b, t0; const float* K2;
                    { const int q = it; L = CTXL; tokbase = NLAT; b = q / (CTXL / 8); t0 = (q % (CTXL / 8)) * 8; K2 = K2C; }
                    const float* zb = Z + (size_t)(tokbase + b * L) * BW + c;
                    float acc[8];
#pragma unroll
                    for (int i = 0; i < 8; ++i) acc[i] = 0.f;
                    const int base = t0 + L - 1;
                    for (int s = 0; s < L; s += 8) {
                        float k[15];
#pragma unroll
                        for (int mm = 0; mm < 15; ++mm) k[mm] = K2[((size_t)(base - s - 7 + mm) * 2 + 1) * 512 + c];
#pragma unroll
                        for (int ds = 0; ds < 8; ++ds) { const float z = zb[(size_t)(s + ds) * BW];
#pragma unroll
                            for (int i = 0; i < 8; ++i) acc[i] += k[i - ds + 7] * z; }
                    }
#pragma unroll
                    for (int i = 0; i < 8; ++i) { const size_t tok = (size_t)(tokbase + b * L + t0 + i); const float zt = Z[tok * BW + c]; Y4[tok * DM + c] = f2bf((acc[i] + bias[c] * zt) * U[tok * 1536 + 1024 + c]); }
                }
            }
            SEAM(PB + 4);
        }

        if (IN(PB + 5)) for (int rep_ = 0; rep_ < PROBE_REPS(5); ++rep_) {
            PH_BEGIN
            const float* ml_norm = PT(23) + l * BW; const float* ssd_d = PT(38) + l * 8; const float* ssd_norm = PT(39) + l * BW; const float* s5_d = PT(31) + l * BW;
            if (bid < 128) {
                pg8::Gemm gg_{S5A, S5B, 768, 768, 768}; pg8::SchedS5b S_{bid}; pg8::EpiS5Out E_{P, s5_d, GG};
                pg8::gemm_phase((LAS unsigned char*)shm, gg_, S_, E_);
                __syncthreads();
            }
            for (int tok = bid * 8 + wave; tok < NTOK; tok += G * 8) {
                const int c0 = lane * 8; const bf16_t* pr = P + (size_t)tok * LDP; const size_t o5 = (size_t)tok * BW + c0;
                float hm[8], ys[8];
                const u32x4 ooq = *(const u32x4*)(pr + ML_OFF + 1536 + c0);
                const float4 g0 = *(const float4*)(ml_norm + c0), g1 = *(const float4*)(ml_norm + c0 + 4), n0 = *(const float4*)(ssd_norm + c0), n1 = *(const float4*)(ssd_norm + c0 + 4);
                { const float4 a0 = *(const float4*)(HF + o5), a1 = *(const float4*)(HF + o5 + 4), b0 = *(const float4*)(HBk + o5), b1 = *(const float4*)(HBk + o5 + 4);
                  hm[0] = a0.x + b0.x; hm[1] = a0.y + b0.y; hm[2] = a0.z + b0.z; hm[3] = a0.w + b0.w; hm[4] = a1.x + b1.x; hm[5] = a1.y + b1.y; hm[6] = a1.z + b1.z; hm[7] = a1.w + b1.w; }
                { const float4 a0 = *(const float4*)(YF + o5), a1 = *(const float4*)(YF + o5 + 4), b0 = *(const float4*)(YB + o5), b1 = *(const float4*)(YB + o5 + 4);
                  float xx[8], zz[8]; unpack8(*(const u32x4*)(XBC + (size_t)tok * 1024 + c0), xx); unpack8(*(const u32x4*)(pr + SSD_OFF + c0), zz); const float dsk = ssd_d[c0 >> 6];
                  ys[0] = a0.x + b0.x; ys[1] = a0.y + b0.y; ys[2] = a0.z + b0.z; ys[3] = a0.w + b0.w; ys[4] = a1.x + b1.x; ys[5] = a1.y + b1.y; ys[6] = a1.z + b1.z; ys[7] = a1.w + b1.w;
#pragma unroll
                  for (int j = 0; j < 8; ++j) ys[j] = (ys[j] + dsk * xx[j]) * siluf_(zz[j]); }
                float s1 = 0.f, s2 = 0.f;
#pragma unroll
                for (int j = 0; j < 8; ++j) { s1 += hm[j] * hm[j]; s2 += ys[j] * ys[j]; }
                s1 += __shfl_xor(s1, 1); s1 += __shfl_xor(s1, 2); s1 += __shfl_xor(s1, 4); s1 += __shfl_xor(s1, 8);
                s2 = wave_sum(s2);
                const float r1 = rsqrtf(s1 * (1.0f / 128.0f) + 1e-6f), r2 = rsqrtf(s2 * (1.0f / BW) + 1e-6f);
                float oo[8]; unpack8(ooq, oo);
                const float gm[8] = {g0.x, g0.y, g0.z, g0.w, g1.x, g1.y, g1.z, g1.w}, gs[8] = {n0.x, n0.y, n0.z, n0.w, n1.x, n1.y, n1.z, n1.w};
                u32x4 w;
                w.x = pk2(hm[0] * r1 * gm[0] * sigmoidf_(oo[0]), hm[1] * r1 * gm[1] * sigmoidf_(oo[1])); w.y = pk2(hm[2] * r1 * gm[2] * sigmoidf_(oo[2]), hm[3] * r1 * gm[3] * sigmoidf_(oo[3]));
                w.z = pk2(hm[4] * r1 * gm[4] * sigmoidf_(oo[4]), hm[5] * r1 * gm[5] * sigmoidf_(oo[5])); w.w = pk2(hm[6] * r1 * gm[6] * sigmoidf_(oo[6]), hm[7] * r1 * gm[7] * sigmoidf_(oo[7]));
                *(u32x4*)(Y4 + (size_t)tok * DM + 512 + c0) = w;
                w.x = pk2(ys[0] * r2 * gs[0], ys[1] * r2 * gs[1]); w.y = pk2(ys[2] * r2 * gs[2], ys[3] * r2 * gs[3]); w.z = pk2(ys[4] * r2 * gs[4], ys[5] * r2 * gs[5]); w.w = pk2(ys[6] * r2 * gs[6], ys[7] * r2 * gs[7]);
                *(u32x4*)(Y4 + (size_t)tok * DM + 1536 + c0) = w;
                if (tok >= NLAT) { const size_t oc = (size_t)(tok - NLAT) * BW + c0; float uu[8]; unpack8(*(const u32x4*)(pr + S5_OFF + c0), uu);
                    const float4 a0 = *(const float4*)(SF + oc), a1 = *(const float4*)(SF + oc + 4), b0 = *(const float4*)(SB + oc), b1 = *(const float4*)(SB + oc + 4), d0 = *(const float4*)(s5_d + c0), d1 = *(const float4*)(s5_d + c0 + 4);
                    float y[8] = {a0.x + b0.x + d0.x * uu[0], a0.y + b0.y + d0.y * uu[1], a0.z + b0.z + d0.z * uu[2], a0.w + b0.w + d0.w * uu[3], a1.x + b1.x + d1.x * uu[4], a1.y + b1.y + d1.y * uu[5], a1.z + b1.z + d1.z * uu[6], a1.w + b1.w + d1.w * uu[7]};
#pragma unroll
                    for (int j = 0; j < 8; ++j) y[j] = 0.5f * y[j] * (1.0f + tanhf(0.7978845608028654f * (y[j] + 0.044715f * y[j] * y[j] * y[j])));
                    w.x = pk2(y[0], y[1]); w.y = pk2(y[2], y[3]); w.z = pk2(y[4], y[5]); w.w = pk2(y[6], y[7]);
                    *(u32x4*)(GG + (size_t)tok * BW + c0) = w; }
            }
            __syncthreads();
            {   float* T = sf;
                for (int unit = (G > 128 ? bid - 128 : bid); unit >= 0 && unit < 4 * 64 * 8; unit += (G > 128 ? G - 128 : G)) { const int b = unit / 512, t0 = ((unit >> 3) & 63) * 64, c0 = (unit & 7) * 64;
                    __syncthreads();
#pragma unroll
                    for (int i = 0; i < 8; ++i) { const int t = tid & 63, c = (tid >> 6) + 8 * i; T[c * 65 + t] = YT[((size_t)b * 512 + c0 + c) * SEQ + t0 + t]; }
                    __syncthreads();
                    const int t = tid >> 3, cq = (tid & 7) * 8;
                    u32x4 w; w.x = pk2(T[(cq + 0) * 65 + t], T[(cq + 1) * 65 + t]); w.y = pk2(T[(cq + 2) * 65 + t], T[(cq + 3) * 65 + t]); w.z = pk2(T[(cq + 4) * 65 + t], T[(cq + 5) * 65 + t]); w.w = pk2(T[(cq + 6) * 65 + t], T[(cq + 7) * 65 + t]);
                    *(u32x4*)(Y4 + ((size_t)b * SEQ + t0 + t) * DM + c0 + cq) = w;
                } }
            SEAM(PB + 5);
        }

        if (IN(PB + 6)) for (int rep_ = 0; rep_ < PROBE_REPS(6); ++rep_) {
            PH_BEGIN
            pg8::Gemm g{GG, GLU, BW, BW, BW}; pg8::SchedStd S{68, 2, G, bid, BW, BW}; pg8::EpiGlu E{GG, PT(33) + l * BW, Y4};
            pg8::gemm_phase((LAS unsigned char*)shm, g, S, E);
            SEAM(PB + 6);
        }
        if (IN(PB + 7)) for (int rep_ = 0; rep_ < PROBE_REPS(7); ++rep_) {
            PH_BEGIN
            pg8::Gemm g{Y4, WBR, DM, BW, BW}; pg8::SchedBranch S{nPanels, 8, G, bid}; pg8::EpiBranch E{P, ACCb};
            pg8::gemm_phase((LAS unsigned char*)shm, g, S, E);
            SEAM(PB + 7);
        }
        if (IN(PB + 8)) for (int rep_ = 0; rep_ < PROBE_REPS(8); ++rep_) {
            PH_BEGIN
            pg8::Gemm g{ACCb, WOUT, DM, DM, DM}; pg8::SchedStd S{nPanels, 8, G, bid, DM, DM}; pg8::EpiResid E{XS, l == 0 ? x_in : (const float*)XS, l == 0 ? ctx_in - (size_t)NLAT * DM : (const float*)XS, MODl, 2};
            pg8::gemm_phase((LAS unsigned char*)shm, g, S, E);
            SEAM(PB + 8);
        }
        if (IN(PB + 9)) for (int rep_ = 0; rep_ < PROBE_REPS(9); ++rep_) {
            PH_BEGIN
            for (int i = bid * NTHR + tid; i < NEXP * MOE_PAD; i += G * NTHR) ROWTOK[i] = -1;
            for (int i = bid * NTHR + tid; i < NTOK * 16; i += G * NTHR) INV[i] = -1;
            const float* wr = PT(42) + (size_t)l * DM * 16; const float* gn = norm_ffn + l * DM;
            for (int tok0 = (bid * 8 + wave) * 4; tok0 < M2; tok0 += G * 32) {
                const int r = tok0 < NLAT ? tok0 / SEQ : 4; const float* xr = XS + (size_t)tok0 * DM;
                const float* sh = MODl + (size_t)(r * 6 + 3) * DM; const float* sc = MODl + (size_t)(r * 6 + 4) * DM;
                float rs[4];
#pragma unroll
                for (int tk = 0; tk < 4; ++tk) { float ss = 0.f;
#pragma unroll 4
                    for (int i = 0; i < 8; ++i) { const float4 t4 = *(const float4*)(xr + (size_t)tk * DM + i * 256 + lane * 4); ss += t4.x * t4.x + t4.y * t4.y + t4.z * t4.z + t4.w * t4.w; }
                    ss = wave_sum(ss); rs[tk] = rsqrtf(ss * (1.0f / DM) + 1e-6f); }
                float lg[4][16];
#pragma unroll
                for (int tk = 0; tk < 4; ++tk)
#pragma unroll
                    for (int e = 0; e < 16; ++e) lg[tk][e] = 0.f;
#pragma unroll 1
                for (int i = 0; i < 8; ++i) { const int d = i * 256 + lane * 4;
                    const float4 g4 = *(const float4*)(gn + d), s4 = *(const float4*)(sc + d), h4 = *(const float4*)(sh + d);
                    float4 xq[4], ww[16];
#pragma unroll
                    for (int tk = 0; tk < 4; ++tk) xq[tk] = *(const float4*)(xr + (size_t)tk * DM + d);
                    const float4* wq = (const float4*)(wr + (size_t)d * 16);
#pragma unroll
                    for (int q = 0; q < 16; ++q) ww[q] = wq[q];
                    float hv[4][4];
#pragma unroll
                    for (int tk = 0; tk < 4; ++tk) { const float4 xv = xq[tk]; const float rr = rs[tk];
                        hv[tk][0] = xv.x * rr * g4.x * (1.f + s4.x) + h4.x; hv[tk][1] = xv.y * rr * g4.y * (1.f + s4.y) + h4.y; hv[tk][2] = xv.z * rr * g4.z * (1.f + s4.z) + h4.z; hv[tk][3] = xv.w * rr * g4.w * (1.f + s4.w) + h4.w;
                        u32x2 w; w.x = pk2(hv[tk][0], hv[tk][1]); w.y = pk2(hv[tk][2], hv[tk][3]); *(u32x2*)(HB + (size_t)(tok0 + tk) * DM + d) = w; }
#pragma unroll
                    for (int q = 0; q < 4; ++q) { const float4 w0 = ww[q * 4 + 0], w1 = ww[q * 4 + 1], w2 = ww[q * 4 + 2], w3 = ww[q * 4 + 3];
#pragma unroll
                        for (int tk = 0; tk < 4; ++tk) { const float hq = hv[tk][q];
                            lg[tk][0] += hq * w0.x; lg[tk][1] += hq * w0.y; lg[tk][2] += hq * w0.z; lg[tk][3] += hq * w0.w; lg[tk][4] += hq * w1.x; lg[tk][5] += hq * w1.y; lg[tk][6] += hq * w1.z; lg[tk][7] += hq * w1.w;
                            lg[tk][8] += hq * w2.x; lg[tk][9] += hq * w2.y; lg[tk][10] += hq * w2.z; lg[tk][11] += hq * w2.w; lg[tk][12] += hq * w3.x; lg[tk][13] += hq * w3.y; lg[tk][14] += hq * w3.z; lg[tk][15] += hq * w3.w; } } }
#pragma unroll
                for (int tk = 0; tk < 4; ++tk) { float mx = -1e30f;
#pragma unroll
                    for (int e = 0; e < 16; ++e) { lg[tk][e] = wave_sum(lg[tk][e]); mx = fmaxf(mx, lg[tk][e]); }
                    float sm = 0.f;
#pragma unroll
                    for (int e = 0; e < 16; ++e) { lg[tk][e] = expf(lg[tk][e] - mx); sm += lg[tk][e]; }
                    const float inv = 1.0f / sm;
                    if (lane == 0) {
#pragma unroll
                        for (int e = 0; e < 16; e += 4) *(float4*)(PROBS + (size_t)(tok0 + tk) * 16 + e) = make_float4(lg[tk][e] * inv, lg[tk][e + 1] * inv, lg[tk][e + 2] * inv, lg[tk][e + 3] * inv); } }
            }
            SEAM(PB + 9);
        }
        if (IN(PB + 10)) for (int rep_ = 0; rep_ < PROBE_REPS(10); ++rep_) {
            PH_BEGIN
            const int nitems = 64 + (lastl ? 0 : 64);
            unsigned long long* keys = (unsigned long long*)shm;
            for (int it = bid; it < nitems; it += G) {
                const int set = it >> 6, e = it & 15, b = (it >> 4) & 3;
                const int n = set ? CTXL : SEQ, cap = set ? 32 : 512, tokbase = set ? NLAT + b * CTXL : b * SEQ;
                __syncthreads();
                for (int i = tid; i < n; i += NTHR) keys[i] = ((unsigned long long)__float_as_uint(PROBS[(size_t)(tokbase + i) * 16 + e]) << 32) | (unsigned long long)(0xFFFFFFFFu - (unsigned)i);
                __syncthreads();
                for (int k = 2; k <= n; k <<= 1)
                    for (int j = k >> 1; j > 0; j >>= 1) {
                        for (int p = tid; p < (n >> 1); p += NTHR) { const int i = ((p & ~(j - 1)) << 1) | (p & (j - 1)); const int m = i | j;
                            const unsigned long long ka = keys[i], kb = keys[m]; const bool desc = ((i & k) == 0);
                            if ((ka < kb) == desc) { keys[i] = kb; keys[m] = ka; } }
                        __syncthreads();
                    }
                for (int r = tid; r < cap; r += NTHR) { const unsigned long long kk = keys[r]; const int row = e * MOE_PAD + (set ? 2048 + b * 32 + r : b * 512 + r);
                    const int tk_ = tokbase + (int)(0xFFFFFFFFu - (unsigned)(kk & 0xFFFFFFFFull)); ROWTOK[row] = tk_; ROWGATE[row] = __uint_as_float((unsigned)(kk >> 32)); INV[tk_ * 16 + e] = row; }
                for (int rb = 0; rb < cap; rb += 32) {
                    u32x4 t4[4][4];
#pragma unroll
                    for (int q = 0; q < 4; ++q) { const int r = rb + wave + 8 * q; const int tok = tokbase + (int)(0xFFFFFFFFu - (unsigned)(keys[r] & 0xFFFFFFFFull));
                        const u32x4* sp = (const u32x4*)(HB + (size_t)tok * DM);
#pragma unroll
                        for (int i = 0; i < 4; ++i) t4[q][i] = sp[i * 64 + lane]; }
#pragma unroll
                    for (int q = 0; q < 4; ++q) { const int r = rb + wave + 8 * q; const int row = e * MOE_PAD + (set ? 2048 + b * 32 + r : b * 512 + r);
                        u32x4* dp = (u32x4*)(XG + (size_t)row * DM);
#pragma unroll
                        for (int i = 0; i < 4; ++i) dp[i * 64 + lane] = t4[q][i]; } }
            }
            {   const int pad0 = lastl ? 2048 : MOE_ROWS, npad = MOE_PAD - pad0;
                for (int R = bid * 8 + wave; R < NEXP * npad; R += G * 8) { const int e = R / npad, rr = pad0 + R % npad; u32x4* dp = (u32x4*)(XG + ((size_t)e * MOE_PAD + rr) * DM);
#pragma unroll
                    for (int i = 0; i < 4; ++i) dp[i * 64 + lane] = (u32x4){0u, 0u, 0u, 0u}; } }
            SEAM(PB + 10);
        }
        if (IN(PB + 12)) for (int rep_ = 0; rep_ < PROBE_REPS(12); ++rep_) {
            PH_BEGIN
            pg8::Gemm g{XG, WGU, DM, DM, DM}; pg8::SchedMoe S{lastl ? 8 : 9, 12, G, bid, DM, DM, 2 * DEXP}; pg8::EpiMoe1 E{HID};
            pg8::gemm_phase((LAS unsigned char*)shm, g, S, E);
            SEAM(PB + 12);
        }
        if (IN(PB + 13)) for (int rep_ = 0; rep_ < PROBE_REPS(13); ++rep_) {
            PH_BEGIN
            pg8::Gemm g{HID, WD, DEXP, DEXP, DEXP}; pg8::SchedMoe S{lastl ? 8 : 9, 8, G, bid, DEXP, DEXP, DM}; pg8::EpiMoeY E{YEXP};
            pg8::gemm_phase((LAS unsigned char*)shm, g, S, E);
            SEAM(PB + 13);
        }

}

__global__ __launch_bounds__(NTHR, 2) void fwd(Args a) {
    extern __shared__ __attribute__((aligned(16))) unsigned char shm[];
    const int bid = blockIdx.x, G = gridDim.x;
    float* const sf = (float*)shm;
    volatile LAS unsigned* xbw = (volatile LAS unsigned*)((LAS unsigned char*)shm + (LDS_BYTES - 16));
    if (threadIdx.x == 0) { xbw[0] = 0u; xbw[1] = 0u; xbw[2] = 0u; xbw[3] = 0u; }
    const float** const ptab = (const float**)(shm + (LDS_BYTES - 16 - 512));
    if (threadIdx.x == 0) {
#pragma unroll
        for (int i = 0; i < 47; ++i) ptab[i] = a.in[i]; }
    __syncthreads();
    XcdBarrier bar = xcd_barrier_post((unsigned*)(a.ws + O_BAR), xbw);
    const int lo = a.ph_lo, hi = a.ph_hi;
    if (IN(0)) {
        PH_BEGIN
        {
            __syncthreads();
            for (int i = tid; i < 5 * DM; i += NTHR) { const int r = i >> 11, k = i & (DM - 1); const float v = r < 4 ? c_in[r * DM + k] : cctx_in[k]; sf[i] = siluf_(v); }
            __syncthreads();
            float* red = sf + 5 * DM;
            for (int unit = bid; unit < 2 * 96; unit += G) { const int l = unit / 96, j = (unit % 96) * 128 + (tid & 127), kq = tid >> 7;
                const float* w = ada_w + (size_t)l * DM * (6 * DM) + (size_t)(kq * 512) * (6 * DM) + j; const float* sv = sf + kq * 512;
                float a0 = 0.f, a1 = 0.f, a2 = 0.f, a3 = 0.f, a4 = 0.f;
#pragma unroll 8
                for (int k = 0; k < 512; ++k) { const float wv = w[(size_t)k * (6 * DM)]; a0 += sv[k] * wv; a1 += sv[DM + k] * wv; a2 += sv[2 * DM + k] * wv; a3 += sv[3 * DM + k] * wv; a4 += sv[4 * DM + k] * wv; }
                __syncthreads();
                { float* rp = red + (kq * 5) * 128 + (tid & 127); rp[0] = a0; rp[128] = a1; rp[256] = a2; rp[384] = a3; rp[512] = a4; }
                __syncthreads();
                if (tid < 128) { const float bb = ada_b[l * 6 * DM + j]; float* o = MOD + (size_t)l * 5 * 6 * DM + j;
#pragma unroll
                    for (int r = 0; r < 5; ++r) o[(size_t)r * 6 * DM] = ((red[(0 * 5 + r) * 128 + tid] + red[(1 * 5 + r) * 128 + tid]) + (red[(2 * 5 + r) * 128 + tid] + red[(3 * 5 + r) * 128 + tid])) + bb; }
            }
        }
    }

    layer_body<0>(a, bar, lo, hi, bid, G, shm, sf, ptab);
    layer_body<1>(a, bar, lo, hi, bid, G, shm, sf, ptab);
    if (IN(33)) {
        PH_BEGIN
        const float* gn = PT(46);
        for (int tok = bid * 8 + wave; tok < NLAT; tok += G * 8) {
            const float* xr = XS + (size_t)tok * DM; float4 v[8]; float ss = 0.f;
#pragma unroll
            for (int i = 0; i < 8; ++i) v[i] = *(const float4*)(xr + i * 256 + lane * 4);
            moe_combine(v, tok, lane, INV, ROWGATE, YEXP, MOD + (size_t)(1 * 5 + tok / SEQ) * 6 * DM + 5 * DM);
#pragma unroll
            for (int i = 0; i < 8; ++i) {                 ss += v[i].x * v[i].x + v[i].y * v[i].y + v[i].z * v[i].z + v[i].w * v[i].w; }
            ss = wave_sum(ss); const float rs = rsqrtf(ss * (1.0f / DM) + 1e-6f);
#pragma unroll
            for (int i = 0; i < 8; ++i) { const int d = i * 256 + lane * 4; const float4 g4 = *(const float4*)(gn + d);
                *(float4*)(a.out + (size_t)tok * DM + d) = make_float4(v[i].x * rs * g4.x, v[i].y * rs * g4.y, v[i].z * rs * g4.z, v[i].w * rs * g4.w); }
        }
    }
#undef IN
#undef SEAM
}


extern "C" void kernel_launch(void* const* d_in, const int* in_sizes, int n_in, void* d_out, int out_size, void* d_ws, size_t ws_size, hipStream_t stream) {
    static int grid = 0;
    if (grid == 0) {
        if (n_in != 47 || ws_size < WS_END) { fprintf(stderr, "kernel_launch: expected 47 inputs and >= %zu bytes of workspace; got %d, %zu\n", (size_t)WS_END, n_in, ws_size); grid = -1; return; }
        int dev = 0, cus = 0;
        if (hipGetDevice(&dev) != hipSuccess || hipDeviceGetAttribute(&cus, hipDeviceAttributeMultiprocessorCount, dev) != hipSuccess) { grid = -1; return; }
        if (hipFuncSetAttribute((const void*)fwd, hipFuncAttributeMaxDynamicSharedMemorySize, LDS_BYTES) != hipSuccess) { fprintf(stderr, "kernel_launch: hipFuncSetAttribute failed\n"); grid = -1; return; }
        int per_cu = 0;
        if (hipOccupancyMaxActiveBlocksPerMultiprocessor(&per_cu, (const void*)fwd, NTHR, LDS_BYTES) != hipSuccess || per_cu < 1) fprintf(stderr, "kernel_launch: occupancy query reports %d\n", per_cu);
        (void)hipGetLastError();
        grid = cus > 256 ? 256 : cus;
        if (grid < 224) { fprintf(stderr, "kernel_launch: needs >= 224 CUs (got %d)\n", grid); grid = -1; return; }
    }
    if (grid < 0) return;
    (void)hipMemsetAsync((char*)d_ws, 0, O_ZERO_END, stream);
    Args a{};
    for (int i = 0; i < 47; ++i) a.in[i] = (const float*)d_in[i];
    a.out = (float*)d_out; a.ws = (unsigned char*)d_ws;
#if MK_ONE_LAUNCH
    a.ph_lo = 0; a.ph_hi = 64;
    hipLaunchKernelGGL(fwd, dim3(grid), dim3(NTHR), LDS_BYTES, stream, a);
#else
    const int ids[] = {0, 1,2,3,4,5,6,7,8,9,10,11,12,13,14, 17,18,19,20,21,22,23,24,25,26,27,28,29,30, 33};
    for (int k = 0; k < (int)(sizeof(ids) / sizeof(ids[0])); ++k) { a.ph_lo = ids[k]; a.ph_hi = ids[k] + 1; hipLaunchKernelGGL(fwd, dim3(grid), dim3(NTHR), LDS_BYTES, stream, a); }
#endif
}
```

```cpp
#include <hip/hip_runtime.h>
#include <stdint.h>
#include <stdio.h>

#ifndef PROBE_MASK
#define PROBE_MASK 0
#endif
#ifndef PROBE_SP
#define PROBE_SP 1
#endif
#define PROBE_REPS(k) ((((PROBE_MASK) >> (k)) & 1) + 1)
#ifndef MK_ONE_LAUNCH
#define MK_ONE_LAUNCH 1
#endif

#define DM 2048
#define NB 4
#define SEQ 4096
#define CTXL 256
#define BW 512
#define NLAT 16384
#define NCTX 1024
#define NTOK 17408
#define IN_W 13856
#define LDP 14080
#define HY_OFF 0
#define ML_OFF 1536
#define S5_OFF 3600
#define SSD_OFF 4112
#define GATE_OFF 5664
#define NEXP 16
#define DEXP 1536
#define MOE_ROWS 2176
#define MOE_PAD 2304
#define NTHR 512
#define LDS_BYTES 147456
#define LAS __attribute__((address_space(3)))

typedef unsigned short bf16_t;
typedef short bf16x8 __attribute__((ext_vector_type(8)));
typedef float f32x4 __attribute__((ext_vector_type(4)));
typedef unsigned u32x4 __attribute__((ext_vector_type(4)));
typedef unsigned u32x2 __attribute__((ext_vector_type(2)));

#define XB_TMO      128
#define XB_XCNT(j)  (256  + 64 * (j))
#define XB_XSUB(j)  (1280 + 64 * (j))
#define XB_XGEN(j)  (2304 + 64 * (j))
#define XB_TOP      3328
#define XB_TOPGEN   3392
#define XCD_BAR_WORDS 3456
#define XB_SPIN_CAP (1u << 18)
__device__ __forceinline__ unsigned xb_ld(unsigned* p)              { return __hip_atomic_load(p, __ATOMIC_RELAXED, __HIP_MEMORY_SCOPE_AGENT); }
__device__ __forceinline__ unsigned xb_add(unsigned* p, unsigned v) { return __hip_atomic_fetch_add(p, v, __ATOMIC_RELAXED, __HIP_MEMORY_SCOPE_AGENT); }
__device__ __forceinline__ unsigned xb_xcc_id() { return (unsigned)__builtin_amdgcn_s_getreg((3 << 11) | 20) & 0xFu; }
#define XB_SPIN(cond, bar) do { unsigned _sp = 0; while (cond) { __builtin_amdgcn_s_sleep(1); \
    if ((++_sp & 255u) == 0u) { if (xb_ld(&(bar)[XB_TMO])) break; if (_sp > XB_SPIN_CAP) { atomicAdd(&(bar)[XB_TMO], 1u); break; } } } } while (0)
struct XcdBarrier { unsigned* bar; unsigned x; volatile LAS unsigned* st; };
__device__ __forceinline__ XcdBarrier xcd_barrier_post(unsigned* bar, volatile LAS unsigned* st) {
    XcdBarrier b; b.bar = bar; b.x = xb_xcc_id(); b.st = st;
    if (threadIdx.x == 0) (void)xb_add(&bar[XB_XCNT(b.x)], 1u);
    return b;
}
__device__ __forceinline__ void xcd_barrier_complete(unsigned* bar, unsigned x, unsigned& nloc, unsigned& nx) {
    const unsigned G = gridDim.x * gridDim.y * gridDim.z;
    unsigned sum, cnt, mine, sp = 0u;
    for (;;) {
        sum = 0u; cnt = 0u; mine = 0u;
#pragma unroll
        for (unsigned j = 0; j < 16; ++j) { const unsigned c = xb_ld(&bar[XB_XCNT(j)]); sum += c; cnt += (c > 0u) ? 1u : 0u; mine = (j == x) ? c : mine; }
        if (sum == G) break;
        __builtin_amdgcn_s_sleep(1);
        if ((++sp & 255u) == 0u) { if (xb_ld(&bar[XB_TMO])) break; if (sp > XB_SPIN_CAP) { atomicAdd(&bar[XB_TMO], 1u); break; } }
    }
    nloc = mine > 0u ? mine : 1u; nx = cnt > 0u ? cnt : 1u;
}
__device__ __forceinline__ void xcd_barrier(const XcdBarrier& b) {
    asm volatile("s_waitcnt vmcnt(0)" ::: "memory");
    __syncthreads();
    if (threadIdx.x == 0) {
        unsigned* bar = b.bar;
        __builtin_amdgcn_s_waitcnt(0);
        unsigned nloc = b.st[0], nx = b.st[1];
        if (nloc == 0u) { xcd_barrier_complete(bar, b.x, nloc, nx); b.st[0] = nloc; b.st[1] = nx; }
        const unsigned old = xb_add(&bar[XB_XSUB(b.x)], 1u);
        const unsigned gen = old / nloc;
        if (old + 1u == (gen + 1u) * nloc) {
            __builtin_amdgcn_fence(__ATOMIC_RELEASE, "agent");
            asm volatile("s_waitcnt vmcnt(0)" ::: "memory");
            const unsigned og = xb_add(&bar[XB_TOP], 1u);
            const unsigned tg = og / nx;
            if (og + 1u == (tg + 1u) * nx) xb_add(&bar[XB_TOPGEN], 1u);
            else XB_SPIN(xb_ld(&bar[XB_TOPGEN]) == tg, bar);
            __builtin_amdgcn_fence(__ATOMIC_ACQUIRE, "agent");
            xb_add(&bar[XB_XGEN(b.x)], 1u);
            asm volatile("s_waitcnt vmcnt(0)" ::: "memory");
        } else {
            XB_SPIN(xb_ld(&bar[XB_XGEN(b.x)]) == gen, bar);
            __builtin_amdgcn_fence(__ATOMIC_ACQUIRE, "agent");
            asm volatile("s_waitcnt vmcnt(0)" ::: "memory");
        }
    }
    __syncthreads();
}

__device__ __forceinline__ unsigned short f2bf(float f) { unsigned u = __float_as_uint(f); u += 0x7FFFu + ((u >> 16) & 1u); return (unsigned short)(u >> 16); }
__device__ __forceinline__ float bf2f(unsigned short b) { return __uint_as_float(((unsigned)b) << 16); }
__device__ __forceinline__ unsigned pk2(float lo, float hi) { unsigned r; asm("v_cvt_pk_bf16_f32 %0, %1, %2" : "=v"(r) : "v"(lo), "v"(hi)); return r; }
__device__ __forceinline__ float sigmoidf_(float x) { return 1.0f / (1.0f + expf(-x)); }
__device__ __forceinline__ float siluf_(float x) { return x / (1.0f + expf(-x)); }
__device__ __forceinline__ float wave_sum(float v) {
#pragma unroll
    for (int o = 32; o >= 1; o >>= 1) v += __shfl_xor(v, o);
    return v;
}
__device__ __forceinline__ const float* uptr(const float* p) { const unsigned long long v = (unsigned long long)p;
    const unsigned lo = __builtin_amdgcn_readfirstlane((unsigned)v), hi = __builtin_amdgcn_readfirstlane((unsigned)(v >> 32)); return (const float*)(((unsigned long long)hi << 32) | lo); }
#define PT(k) uptr(ptab[k])
__device__ __forceinline__ int step_tok(int b, int dir, int i) {
    if (i < CTXL) { const int tt = dir ? (CTXL - 1 - i) : i; return NLAT + b * CTXL + tt; }
    const int j = i - CTXL; const int tt = dir ? (SEQ - 1 - j) : j; return b * SEQ + tt;
}
__device__ __forceinline__ void unpack8(const u32x4 w, float (&f)[8]) {
    f[0] = __uint_as_float(w.x << 16); f[1] = __uint_as_float(w.x & 0xFFFF0000u); f[2] = __uint_as_float(w.y << 16); f[3] = __uint_as_float(w.y & 0xFFFF0000u);
    f[4] = __uint_as_float(w.z << 16); f[5] = __uint_as_float(w.z & 0xFFFF0000u); f[6] = __uint_as_float(w.w << 16); f[7] = __uint_as_float(w.w & 0xFFFF0000u);
}

namespace pg8 {
constexpr int BM = 256, BK = 64, HALF = 128, HTB = HALF * BK * 2, STAGE_BYTES = 8 * HTB, NXCD = 8, WGM = 8;
__host__ __device__ __forceinline__ int lds_byte(int r, int c) { const int st = (r >> 4) * 2 + (c >> 5), rr = r & 15, cc = c & 31, ob = rr * 64 + cc * 2; return st * 1024 + (ob ^ (((ob >> 9) & 1) << 5)); }
__host__ __device__ __forceinline__ void stage_rc(int b, int& R, int& C) { const int st = b / 1024, sb = b % 1024, swz = sb ^ (((sb >> 9) & 1) << 5); R = (st >> 1) * 16 + swz / 64; C = (st & 1) * 32 + (swz % 64) / 2; }
__host__ __device__ __forceinline__ int perm32(int rho) { const int n = rho >> 4, i = rho & 15; return 8 * (i >> 2) + 4 * n + (i & 3); }
struct Unit { int pm, pn, z, k; long long ao, bo; };
struct Gemm { const bf16_t* A; const bf16_t* Bt; int lda, ldb, K; };

__device__ __forceinline__ void tile_of(int wgid, int nM, int nN, int& pm, int& pn) {
    const int nwg = nM * nN; { const int q = nwg / NXCD, r = nwg % NXCD, xcd = wgid % NXCD, off = wgid / NXCD; wgid = (xcd < r ? xcd * (q + 1) : r * (q + 1) + (xcd - r) * q) + off; }
    const int nig = WGM * nN, gid = wgid / nig, fm = gid * WGM, gsz = (nM - fm) < WGM ? (nM - fm) : WGM;
    pm = fm + ((wgid % nig) % gsz); pn = (wgid % nig) / gsz;
}
struct SchedStd {
    int nM, nN, G, c, lda, ldb;
    __device__ __forceinline__ bool next(int i, Unit& u) const { const long L = (long)i * G + c; if (L >= (long)nM * nN) return false; tile_of((int)L, nM, nN, u.pm, u.pn); u.z = 0; u.k = 0;
        u.ao = (long long)u.pm * BM * lda * 2; u.bo = (long long)u.pn * BM * ldb * 2; return true; }
    __device__ __forceinline__ void a_ready(const Unit&) const {}
    __device__ __forceinline__ void done(const Unit&) const {}
};
struct SchedBranch {
    int nM, nN, G, c;
    __device__ __forceinline__ bool next(int i, Unit& u) const { const long L = (long)(i >> 2) * G + c; if (L >= (long)nM * nN) return false; tile_of((int)L, nM, nN, u.pm, u.pn); u.z = 0; u.k = i & 3;
        u.ao = ((long long)u.pm * BM * DM + u.k * BW) * 2; u.bo = ((long long)u.k * DM + u.pn * BM) * BW * 2; return true; }
    __device__ __forceinline__ void a_ready(const Unit&) const {}
    __device__ __forceinline__ void done(const Unit&) const {}
};
struct SchedMoe {
    int nPm, nPn, G, c, lda, ldb, nBrows;
    __device__ __forceinline__ bool next(int i, Unit& u) const { const long L = (long)i * G + c; const int per = nPm * nPn; if (L >= (long)NEXP * per) return false; const int e = (int)(L / per), rem = (int)(L % per);
        u.z = e; u.k = 0; u.pm = rem % nPm; u.pn = rem / nPm; u.ao = ((long long)e * MOE_PAD + u.pm * BM) * lda * 2; u.bo = ((long long)e * nBrows + u.pn * BM) * ldb * 2; return true; }
    __device__ __forceinline__ void a_ready(const Unit&) const {}
    __device__ __forceinline__ void done(const Unit&) const {}
};

typedef f32x4 Acc[2][2][4][2];
template <class Epi, class Sched>
__device__ __forceinline__ void gemm_phase(LAS unsigned char* lds, const Gemm g, const Sched& S, const Epi& E) {
    int tid = threadIdx.x; asm volatile("" : "+v"(tid));
    const int wid = __builtin_amdgcn_readfirstlane(tid >> 6), lane = tid & 63, wr = wid >> 2, wc = wid & 3, fr = lane & 15, fq = lane >> 4;
    const int K = g.K, nt = K / BK;
    unsigned voffA[2], voffB[2];
#pragma unroll
    for (int i = 0; i < 2; ++i) { int R, C; stage_rc(tid * 16 + i * 8192, R, C); const int Rb = Epi::PERM ? ((R & ~31) + perm32(R & 31)) : R;
        voffA[i] = (unsigned)(R * g.lda + C) * 2u; voffB[i] = (unsigned)(Rb * g.ldb + C) * 2u; }
    const size_t kstep = (size_t)(BK * 2);
    const size_t hstepA = (size_t)HALF * g.lda * 2, hstepB = (size_t)HALF * g.ldb * 2;
    const unsigned ldsw = (unsigned)wid * 1024u;
    const int aoff = lds_byte(wr * 64 + fr, fq * 8), boff = lds_byte(wc * 32 + fr, fq * 8);
#define PG8_SA(b, h) (((b) * 2 + (h)) * HTB)
#define PG8_SB(b, h) ((4 + (b) * 2 + (h)) * HTB)
#define PG8_STAGE(bufoff, gbase, voff) do { _Pragma("unroll") for (int _i = 0; _i < 2; ++_i) \
        __builtin_amdgcn_global_load_lds((const unsigned*)((const char*)(gbase) + (voff)[_i]), (LAS unsigned*)(lds + (bufoff) + ldsw + _i * 8192), 16, 0, 0); } while (0)
#define PG8_LDA(dst, b, h) do { _Pragma("unroll") for (int m = 0; m < 4; ++m) _Pragma("unroll") for (int k = 0; k < 2; ++k) dst[m][k] = *(const LAS bf16x8*)(lds + PG8_SA(b, h) + aoff + m * 2048 + k * 1024); } while (0)
#define PG8_LDB(dst, b, h) do { _Pragma("unroll") for (int n = 0; n < 2; ++n) _Pragma("unroll") for (int k = 0; k < 2; ++k) dst[n][k] = *(const LAS bf16x8*)(lds + PG8_SB(b, h) + boff + n * 2048 + k * 1024); } while (0)
#define PG8_MMA(ai, bj, At, Bt) do { __builtin_amdgcn_s_setprio(1); _Pragma("unroll") for (int m = 0; m < 4; ++m) _Pragma("unroll") for (int n = 0; n < 2; ++n) _Pragma("unroll") for (int k = 0; k < 2; ++k) \
        acc[ai][bj][m][n] = __builtin_amdgcn_mfma_f32_16x16x32_bf16(Bt[n][k], At[m][k], acc[ai][bj][m][n], 0, 0, 0); __builtin_amdgcn_s_setprio(0); } while (0)
#define PG8_WAIT_V(n) asm volatile("s_waitcnt vmcnt(" #n ")" ::: "memory")
#define PG8_WAIT_L(n) asm volatile("s_waitcnt lgkmcnt(" #n ")" ::: "memory")
#define PG8_BAR __builtin_amdgcn_s_barrier()
#define PG8_SCHED __builtin_amdgcn_sched_barrier(0)
    Unit cur, nxt; int ui = 0;
    if (!S.next(0, cur)) return;
    Acc acc;
#pragma unroll
    for (int a = 0; a < 2; ++a)
#pragma unroll
        for (int b = 0; b < 2; ++b)
#pragma unroll
            for (int m = 0; m < 4; ++m)
#pragma unroll
                for (int n = 0; n < 2; ++n) acc[a][b][m][n] = (f32x4){0.f, 0.f, 0.f, 0.f};
    bf16x8 At[4][2], B0[2][2], B1[2][2];
    const char* cA = (const char*)g.A + cur.ao; const char* cB = (const char*)g.Bt + cur.bo;
    S.a_ready(cur);
    PG8_STAGE(PG8_SB(0, 0), cB, voffB); PG8_STAGE(PG8_SA(0, 0), cA, voffA); PG8_STAGE(PG8_SB(0, 1), cB + hstepB, voffB); PG8_STAGE(PG8_SA(0, 1), cA + hstepA, voffA);
    if (wr == 1) PG8_BAR;
    PG8_WAIT_V(4); PG8_BAR;
    PG8_STAGE(PG8_SB(1, 0), cB + kstep, voffB); PG8_STAGE(PG8_SA(1, 0), cA + kstep, voffA); PG8_STAGE(PG8_SB(1, 1), cB + hstepB + kstep, voffB);
    PG8_WAIT_V(6); PG8_BAR;
    for (;;) {
        const bool has_next = S.next(ui + 1, nxt);
        const char* nA = has_next ? (const char*)g.A + nxt.ao : cA; const char* nB = has_next ? (const char*)g.Bt + nxt.bo : cB;
        for (int t = 0; t < nt; t += 2) {
            const bool last = (t == nt - 2);
            const char* a1 = cA + (size_t)(t + 1) * kstep;
            const char* a2 = last ? nA : cA + (size_t)(t + 2) * kstep; const char* b2 = last ? nB : cB + (size_t)(t + 2) * kstep;
            const char* a3 = a2 + kstep; const char* b3 = b2 + kstep;
            if (last && has_next) S.a_ready(nxt);
            PG8_LDB(B0, 0, 0); PG8_SCHED; PG8_LDA(At, 0, 0); PG8_STAGE(PG8_SA(1, 1), a1 + hstepA, voffA);
            PG8_WAIT_L(8); PG8_BAR; PG8_WAIT_L(0); PG8_MMA(0, 0, At, B0); PG8_BAR; PG8_SCHED;
            PG8_LDB(B1, 0, 1); PG8_STAGE(PG8_SB(0, 0), b2, voffB);
            PG8_BAR; PG8_WAIT_L(0); PG8_MMA(0, 1, At, B1); PG8_BAR;
            PG8_LDA(At, 0, 1); PG8_STAGE(PG8_SA(0, 0), a2, voffA);
            PG8_BAR; PG8_WAIT_L(0); PG8_MMA(1, 0, At, B0); PG8_BAR; PG8_SCHED;
            PG8_STAGE(PG8_SB(0, 1), b2 + hstepB, voffB);
            PG8_WAIT_V(6); PG8_BAR; PG8_MMA(1, 1, At, B1); PG8_BAR;
            PG8_LDB(B0, 1, 0); PG8_SCHED; PG8_LDA(At, 1, 0); PG8_STAGE(PG8_SA(0, 1), a2 + hstepA, voffA);
            PG8_WAIT_L(8); PG8_BAR; PG8_WAIT_L(0); PG8_MMA(0, 0, At, B0); PG8_BAR; PG8_SCHED;
            PG8_LDB(B1, 1, 1); PG8_STAGE(PG8_SB(1, 0), b3, voffB);
            PG8_BAR; PG8_WAIT_L(0); PG8_MMA(0, 1, At, B1); PG8_BAR;
            PG8_LDA(At, 1, 1); PG8_STAGE(PG8_SA(1, 0), a3, voffA);
            PG8_BAR; PG8_WAIT_L(0); PG8_MMA(1, 0, At, B0); PG8_BAR; PG8_SCHED;
            PG8_STAGE(PG8_SB(1, 1), b3 + hstepB, voffB);
            PG8_WAIT_V(6); PG8_BAR; PG8_MMA(1, 1, At, B1); PG8_BAR;
        }
        const bool keep = E(acc, cur, wr, wc, fr, fq); S.done(cur);
        if (!has_next) break;
        if (!keep) {
#pragma unroll
        for (int a = 0; a < 2; ++a)
#pragma unroll
            for (int b = 0; b < 2; ++b)
#pragma unroll
                for (int m = 0; m < 4; ++m)
#pragma unroll
                    for (int n = 0; n < 2; ++n) acc[a][b][m][n] = (f32x4){0.f, 0.f, 0.f, 0.f};
        }
        cur = nxt; cA = nA; cB = nB; ++ui;
    }
    PG8_WAIT_V(0);
    if (wr == 0) PG8_BAR;
    PG8_BAR;
#undef PG8_SA
#undef PG8_SB
#undef PG8_STAGE
#undef PG8_LDA
#undef PG8_LDB
#undef PG8_MMA
#undef PG8_WAIT_V
#undef PG8_WAIT_L
#undef PG8_BAR
#undef PG8_SCHED
}

struct EpiBf16Store {
    static constexpr bool PERM = true;
    bf16_t* O; int ldc;
    __device__ __forceinline__ bool operator()(Acc& acc, const Unit& u, int wr, int wc, int fr, int fq) const {
        const int row0 = u.pm * BM + wr * 64 + fr, col0 = u.pn * BM + wc * 32 + 8 * fq;
#pragma unroll
        for (int ai = 0; ai < 2; ++ai)
#pragma unroll
            for (int m = 0; m < 4; ++m) { bf16_t* rowp = O + (size_t)(row0 + ai * HALF + m * 16) * ldc + col0;
#pragma unroll
                for (int bj = 0; bj < 2; ++bj) { const f32x4 v0 = acc[ai][bj][m][0], v1 = acc[ai][bj][m][1];
                    u32x4 w; w.x = pk2(v0[0], v0[1]); w.y = pk2(v0[2], v0[3]); w.z = pk2(v1[0], v1[1]); w.w = pk2(v1[2], v1[3]);
                    *(u32x4*)(rowp + bj * HALF) = w; } }
        return false;
    }
};
struct EpiWin {
    static constexpr bool PERM = true;
    bf16_t* O; int ldc;
    __device__ __forceinline__ bool operator()(Acc& acc, const Unit& u, int wr, int wc, int fr, int fq) const {
        const int row0 = u.pm * BM + wr * 64 + fr, col0 = u.pn * BM + wc * 32 + 8 * fq;
#pragma unroll
        for (int bj = 0; bj < 2; ++bj) { const bool gate = (col0 + bj * HALF) >= GATE_OFF;
#pragma unroll
            for (int ai = 0; ai < 2; ++ai)
#pragma unroll
                for (int m = 0; m < 4; ++m) { f32x4 v0 = acc[ai][bj][m][0], v1 = acc[ai][bj][m][1];
                    if (gate) {
#pragma unroll
                        for (int j = 0; j < 4; ++j) { v0[j] = __builtin_amdgcn_rcpf(1.0f + __expf(-v0[j])); v1[j] = __builtin_amdgcn_rcpf(1.0f + __expf(-v1[j])); } }
                    u32x4 w; w.x = pk2(v0[0], v0[1]); w.y = pk2(v0[2], v0[3]); w.z = pk2(v1[0], v1[1]); w.w = pk2(v1[2], v1[3]);
                    *(u32x4*)(O + (size_t)(row0 + ai * HALF + m * 16) * ldc + col0 + bj * HALF) = w; } }
        return false;
    }
};
struct EpiNone { static constexpr bool PERM = true;
    __device__ __forceinline__ bool operator()(Acc& acc, const Unit&, int, int, int, int) const {
#pragma unroll
        for (int a = 0; a < 2; ++a)
#pragma unroll
            for (int b = 0; b < 2; ++b)
#pragma unroll
                for (int m = 0; m < 4; ++m)
#pragma unroll
                    for (int n = 0; n < 2; ++n) asm volatile("" :: "v"(acc[a][b][m][n]));
        return false; } };
struct EpiGlu {
    static constexpr bool PERM = true;
    const bf16_t* GG; const float* bias; bf16_t* Y4;
    __device__ __forceinline__ bool operator()(Acc& acc, const Unit& u, int wr, int wc, int fr, int fq) const {
        const int row0 = u.pm * BM + wr * 64 + fr, col0 = u.pn * BM + wc * 32 + 8 * fq;
#pragma unroll
        for (int bj = 0; bj < 2; ++bj) { const int col = col0 + bj * HALF; const f32x4 b0 = *(const f32x4*)(bias + col), b1 = *(const f32x4*)(bias + col + 4);
            u32x4 gq[2][4];
#pragma unroll
            for (int ai = 0; ai < 2; ++ai)
#pragma unroll
                for (int m = 0; m < 4; ++m) gq[ai][m] = *(const u32x4*)(GG + (size_t)(row0 + ai * HALF + m * 16) * BW + col);
#pragma unroll
            for (int ai = 0; ai < 2; ++ai)
#pragma unroll
                for (int m = 0; m < 4; ++m) { const size_t row = (size_t)(row0 + ai * HALF + m * 16);
                    float gg[8]; unpack8(gq[ai][m], gg);
                    const f32x4 v0 = acc[ai][bj][m][0] + b0, v1 = acc[ai][bj][m][1] + b1;
                    u32x4 w; w.x = pk2(gg[0] * sigmoidf_(v0[0]), gg[1] * sigmoidf_(v0[1])); w.y = pk2(gg[2] * sigmoidf_(v0[2]), gg[3] * sigmoidf_(v0[3]));
                    w.z = pk2(gg[4] * sigmoidf_(v1[0]), gg[5] * sigmoidf_(v1[1])); w.w = pk2(gg[6] * sigmoidf_(v1[2]), gg[7] * sigmoidf_(v1[3]));
                    *(u32x4*)(Y4 + row * DM + 1024 + col) = w; } }
        return false;
    }
};
struct EpiBranch {
    static constexpr bool PERM = true;
    const bf16_t* P; bf16_t* ACCb;
    __device__ __forceinline__ bool operator()(Acc& acc, const Unit& u, int wr, int wc, int fr, int fq) const {
        const int row0 = u.pm * BM + wr * 64 + fr, col0 = u.pn * BM + wc * 32 + 8 * fq; const int k = u.k;
        const bf16_t* gbase = P + (size_t)row0 * LDP + GATE_OFF + k * DM + col0;
        if (k < 3) {
#pragma unroll
            for (int ai = 0; ai < 2; ++ai) {
                u32x4 ga[8], gb[8];
#pragma unroll
                for (int m = 0; m < 4; ++m)
#pragma unroll
                    for (int bj = 0; bj < 2; ++bj) { const bf16_t* p = gbase + (size_t)(ai * HALF + m * 16) * LDP + bj * HALF; ga[m * 2 + bj] = *(const u32x4*)p; gb[m * 2 + bj] = *(const u32x4*)(p + DM); }
#pragma unroll
                for (int m = 0; m < 4; ++m)
#pragma unroll
                    for (int bj = 0; bj < 2; ++bj) { float g0[8], g1[8]; unpack8(ga[m * 2 + bj], g0); unpack8(gb[m * 2 + bj], g1);
                        float s[8];
#pragma unroll
                        for (int j = 0; j < 8; ++j) s[j] = g0[j] * __builtin_amdgcn_rcpf(g1[j]);
                        f32x4 v0 = acc[ai][bj][m][0], v1 = acc[ai][bj][m][1];
                        v0[0] *= s[0]; v0[1] *= s[1]; v0[2] *= s[2]; v0[3] *= s[3]; v1[0] *= s[4]; v1[1] *= s[5]; v1[2] *= s[6]; v1[3] *= s[7];
                        acc[ai][bj][m][0] = v0; acc[ai][bj][m][1] = v1; } }
            return true;
        }
#pragma unroll
        for (int ai = 0; ai < 2; ++ai) {
            u32x4 ga[8];
#pragma unroll
            for (int m = 0; m < 4; ++m)
#pragma unroll
                for (int bj = 0; bj < 2; ++bj) ga[m * 2 + bj] = *(const u32x4*)(gbase + (size_t)(ai * HALF + m * 16) * LDP + bj * HALF);
#pragma unroll
            for (int m = 0; m < 4; ++m)
#pragma unroll
                for (int bj = 0; bj < 2; ++bj) { float s[8]; unpack8(ga[m * 2 + bj], s);
                    f32x4 v0 = acc[ai][bj][m][0], v1 = acc[ai][bj][m][1];
                    v0[0] *= s[0]; v0[1] *= s[1]; v0[2] *= s[2]; v0[3] *= s[3]; v1[0] *= s[4]; v1[1] *= s[5]; v1[2] *= s[6]; v1[3] *= s[7];
                    u32x4 w; w.x = pk2(v0[0], v0[1]); w.y = pk2(v0[2], v0[3]); w.z = pk2(v1[0], v1[1]); w.w = pk2(v1[2], v1[3]);
                    *(u32x4*)(ACCb + (size_t)(row0 + ai * HALF + m * 16) * DM + col0 + bj * HALF) = w; } }
        return false;
    }
};
struct EpiResid {
    static constexpr bool PERM = false;
    float* XS; const float* srcLat; const float* srcCtx; const float* MODl; int gidx;
    __device__ __forceinline__ bool operator()(Acc& acc, const Unit& u, int wr, int wc, int fr, int fq) const {
        const int row0 = u.pm * BM + wr * 64 + fr, col0 = u.pn * BM + wc * 32 + 4 * fq;
        const int r = (u.pm * BM) < NLAT ? (u.pm * BM) / SEQ : 4;
        const float* src = (u.pm * BM) < NLAT ? srcLat : srcCtx;
        const float* mg = MODl + (size_t)(r * 6 + gidx) * DM;
#pragma unroll
        for (int bj = 0; bj < 2; ++bj) {
            f32x4 gm[2], xs[2][2][4];
#pragma unroll
            for (int n = 0; n < 2; ++n) { const int col = col0 + bj * HALF + n * 16; gm[n] = *(const f32x4*)(mg + col);
#pragma unroll
                for (int ai = 0; ai < 2; ++ai)
#pragma unroll
                    for (int m = 0; m < 4; ++m) xs[n][ai][m] = *(const f32x4*)(src + (size_t)(row0 + ai * HALF + m * 16) * DM + col); }
#pragma unroll
            for (int n = 0; n < 2; ++n) { const int col = col0 + bj * HALF + n * 16;
#pragma unroll
                for (int ai = 0; ai < 2; ++ai)
#pragma unroll
                    for (int m = 0; m < 4; ++m) *(f32x4*)(XS + (size_t)(row0 + ai * HALF + m * 16) * DM + col) = xs[n][ai][m] + gm[n] * acc[ai][bj][m][n]; } }
        return false;
    }
};
struct EpiMoe1 {
    static constexpr bool PERM = true;
    bf16_t* HID;
    __device__ __forceinline__ bool operator()(Acc& acc, const Unit& u, int wr, int wc, int fr, int fq) const {
        const size_t row0 = (size_t)u.z * MOE_PAD + u.pm * BM + wr * 64 + fr; const int col0 = u.pn * HALF + wc * 32 + 8 * fq;
#pragma unroll
        for (int ai = 0; ai < 2; ++ai)
#pragma unroll
            for (int m = 0; m < 4; ++m) { const f32x4 g0 = acc[ai][0][m][0], g1 = acc[ai][0][m][1], u0 = acc[ai][1][m][0], u1 = acc[ai][1][m][1];
                float h[8];
#pragma unroll
                for (int j = 0; j < 4; ++j) { h[j] = g0[j] * __builtin_amdgcn_rcpf(1.0f + __expf(-g0[j])) * u0[j]; h[4 + j] = g1[j] * __builtin_amdgcn_rcpf(1.0f + __expf(-g1[j])) * u1[j]; }
                u32x4 w; w.x = pk2(h[0], h[1]); w.y = pk2(h[2], h[3]); w.z = pk2(h[4], h[5]); w.w = pk2(h[6], h[7]);
                *(u32x4*)(HID + (row0 + ai * HALF + m * 16) * DEXP + col0) = w; }
        return false;
    }
};
struct EpiMoeY {
    static constexpr bool PERM = true;
    bf16_t* O;
    __device__ __forceinline__ bool operator()(Acc& acc, const Unit& u, int wr, int wc, int fr, int fq) const {
        const size_t row0 = (size_t)u.z * MOE_PAD + u.pm * BM + wr * 64 + fr; const int col0 = u.pn * BM + wc * 32 + 8 * fq;
#pragma unroll
        for (int ai = 0; ai < 2; ++ai)
#pragma unroll
            for (int m = 0; m < 4; ++m) { bf16_t* rowp = O + (row0 + ai * HALF + m * 16) * DM + col0;
#pragma unroll
                for (int bj = 0; bj < 2; ++bj) { const f32x4 v0 = acc[ai][bj][m][0], v1 = acc[ai][bj][m][1];
                    u32x4 w; w.x = pk2(v0[0], v0[1]); w.y = pk2(v0[2], v0[3]); w.z = pk2(v1[0], v1[1]); w.w = pk2(v1[2], v1[3]);
                    *(u32x4*)(rowp + bj * HALF) = w; } }
        return false;
    }
};

struct SchedS5a {
    int c;
    __device__ __forceinline__ bool next(int i, Unit& u) const { if (i > 0 || c >= 64) return false; u.z = c >> 1; u.pm = c & 1; u.pn = 0; u.k = 0;
        u.ao = ((long long)u.z * 512 + u.pm * BM) * 768 * 2; u.bo = (long long)u.z * 256 * 512 * 2; return true; }
    __device__ __forceinline__ void a_ready(const Unit&) const {}
    __device__ __forceinline__ void done(const Unit&) const {}
};
struct SchedS5b {
    int c;
    __device__ __forceinline__ bool next(int i, Unit& u) const { if (i > 0 || c >= 128) return false; u.z = c >> 2; u.pm = (c >> 1) & 1; u.pn = c & 1; u.k = 0;
        u.ao = ((long long)u.z * 512 + u.pm * BM) * 768 * 2; u.bo = ((long long)u.z * 512 + u.pn * BM) * 768 * 2; return true; }
    __device__ __forceinline__ void a_ready(const Unit&) const {}
    __device__ __forceinline__ void done(const Unit&) const {}
};
struct EpiXloc {
    static constexpr bool PERM = false;
    float* XL;
    __device__ __forceinline__ bool operator()(Acc& acc, const Unit& u, int wr, int wc, int fr, int fq) const {
        const int row0 = u.pm * BM + wr * 64 + fr, col0 = wc * 32 + 4 * fq; float* base = XL + (size_t)u.z * 512 * 256;
#pragma unroll
        for (int ai = 0; ai < 2; ++ai)
#pragma unroll
            for (int m = 0; m < 4; ++m) { float* rowp = base + (size_t)(row0 + ai * HALF + m * 16) * 256 + col0;
#pragma unroll
                for (int bj = 0; bj < 2; ++bj)
#pragma unroll
                    for (int n = 0; n < 2; ++n) *(f32x4*)(rowp + bj * HALF + n * 16) = acc[ai][bj][m][n]; }
        return false;
    }
};
struct EpiS5Out {
    static constexpr bool PERM = true;
    const bf16_t* P; const float* dskip; bf16_t* GG;
    __device__ __forceinline__ bool operator()(Acc& acc, const Unit& u, int wr, int wc, int fr, int fq) const {
        const int row0 = u.pm * BM + wr * 64 + fr, col0 = u.pn * BM + wc * 32 + 8 * fq; const int g = u.z;
#pragma unroll
        for (int bj = 0; bj < 2; ++bj) { const int col = col0 + bj * HALF; const int t = col >> 4, c0 = col & 15;
            const f32x4 d0 = *(const f32x4*)(dskip + g * 16 + c0), d1 = *(const f32x4*)(dskip + g * 16 + c0 + 4);
            u32x4 uq[2][4];
#pragma unroll
            for (int ai = 0; ai < 2; ++ai)
#pragma unroll
                for (int m = 0; m < 4; ++m) uq[ai][m] = *(const u32x4*)(P + ((size_t)(row0 + ai * HALF + m * 16) * 32 + t) * LDP + S5_OFF + g * 16 + c0);
#pragma unroll
            for (int ai = 0; ai < 2; ++ai)
#pragma unroll
                for (int m = 0; m < 4; ++m) { const size_t tok = (size_t)(row0 + ai * HALF + m * 16) * 32 + t;
                    float uu[8]; unpack8(uq[ai][m], uu);
                    const f32x4 v0 = acc[ai][bj][m][0], v1 = acc[ai][bj][m][1];
                    float y[8] = {v0[0] + d0[0] * uu[0], v0[1] + d0[1] * uu[1], v0[2] + d0[2] * uu[2], v0[3] + d0[3] * uu[3], v1[0] + d1[0] * uu[4], v1[1] + d1[1] * uu[5], v1[2] + d1[2] * uu[6], v1[3] + d1[3] * uu[7]};
#pragma unroll
                    for (int j = 0; j < 8; ++j) y[j] = 0.5f * y[j] * (1.0f + tanhf(0.7978845608028654f * (y[j] + 0.044715f * y[j] * y[j] * y[j])));
                    u32x4 w; w.x = pk2(y[0], y[1]); w.y = pk2(y[2], y[3]); w.z = pk2(y[4], y[5]); w.w = pk2(y[6], y[7]);
                    *(u32x4*)(GG + tok * BW + g * 16 + c0) = w; } }
        return false;
    }
};
}


__device__ __forceinline__ float wave_scan_incl(float v, int lane) {
#pragma unroll
    for (int o = 1; o < 64; o <<= 1) { const float t = __shfl_up(v, o); if (lane >= o) v += t; }
    return v;
}
__device__ __forceinline__ float wave_scanmax_incl(float v, int lane) {
#pragma unroll
    for (int o = 1; o < 64; o <<= 1) { const float t = __shfl_up(v, o); if (lane >= o) v = fmaxf(v, t); }
    return v;
}
__device__ __forceinline__ float wave_max(float v) {
#pragma unroll
    for (int o = 32; o >= 1; o >>= 1) v = fmaxf(v, __shfl_xor(v, o));
    return v;
}
__device__ __forceinline__ void unpack8h(const u32x4 w, bf16_t (&h)[8]) {
    h[0] = (bf16_t)(w.x & 0xFFFFu); h[1] = (bf16_t)(w.x >> 16); h[2] = (bf16_t)(w.y & 0xFFFFu); h[3] = (bf16_t)(w.y >> 16);
    h[4] = (bf16_t)(w.z & 0xFFFFu); h[5] = (bf16_t)(w.z >> 16); h[6] = (bf16_t)(w.w & 0xFFFFu); h[7] = (bf16_t)(w.w >> 16);
}

__device__ __forceinline__ int tokblock_of(int b, int dir, int c) { if (c < 4) return 256 + b * 4 + (dir ? 3 - c : c); const int j = c - 4; return b * 64 + (dir ? 63 - j : j); }
__device__ __forceinline__ u32x4 rev8h(const u32x4 v) { u32x4 r; r.x = (v.w >> 16) | (v.w << 16); r.y = (v.z >> 16) | (v.z << 16); r.z = (v.y >> 16) | (v.y << 16); r.w = (v.x >> 16) | (v.x << 16); return r; }
__device__ __forceinline__ u32x4 scale8h(const u32x4 v, const float4 a, const float4 b) { float f[8]; unpack8(v, f); u32x4 r; r.x = pk2(f[0] * a.x, f[1] * a.y); r.y = pk2(f[2] * a.z, f[3] * a.w); r.z = pk2(f[4] * b.x, f[5] * b.y); r.w = pk2(f[6] * b.z, f[7] * b.w); return r; }
__device__ __forceinline__ float dot8h(const u32x4 v, const float4 a, const float4 b) { float f[8]; unpack8(v, f); return (f[0] * a.x + f[1] * a.y) + (f[2] * a.z + f[3] * a.w) + (f[4] * b.x + f[5] * b.y) + (f[6] * b.z + f[7] * b.w); }
#define ML_FRAG_LOAD(KF, VF, cc_) do { const int tb_ = tokblock_of(b, dir, (cc_)); const bf16_t* kb_ = KTg + ((size_t)tb_ * 512 + h * 128 + 32 * wd + r16) * 64 + q4 * 8; const bf16_t* vb_ = VTg + ((size_t)tb_ * 512 + h * 128 + 64 * half + 32 * we + r16) * 64 + q4 * 8; \
        _Pragma("unroll") for (int ks_ = 0; ks_ < 2; ++ks_) _Pragma("unroll") for (int j_ = 0; j_ < 2; ++j_) { VF[j_][ks_] = *(const u32x4*)(vb_ + (size_t)j_ * 16 * 64 + ks_ * 32); KF[j_][ks_] = *(const u32x4*)(kb_ + (size_t)j_ * 16 * 64 + ks_ * 32); } } while (0)
#define ML_CHUNK(c_, KF, VF, KFN, VFN) do { const int c = (c_); \
        if (c + 1 < 68) ML_FRAG_LOAD(KFN, VFN, c + 1);                        \
        const float dec = sDEC[c]; \
        {   bf16_t* cs = CST + (size_t)(chain * 68 + c) * 128 * 128; \
            _Pragma("unroll") for (int je = 0; je < 2; ++je) _Pragma("unroll") for (int jd = 0; jd < 2; ++jd) { const int e = 64 * half + 32 * we + 16 * je + r16, d0 = 32 * wd + 16 * jd + q4 * 4; \
                u32x2 pk; pk.x = pk2(acc[je][jd][0], acc[je][jd][1]); pk.y = pk2(acc[je][jd][2], acc[je][jd][3]); *(u32x2*)(cs + (size_t)e * 128 + d0) = pk; } \
            if (nown) { _Pragma("unroll") for (int jd = 0; jd < 2; ++jd) { float nv = npart[jd]; nv += __shfl_xor(nv, 16); nv += __shfl_xor(nv, 32); if (q4 == 0) NST[(size_t)(chain * 68 + c) * 128 + 32 * wd + 16 * jd + r16] = nv; } } } \
        bf16x8 vfr[2][2]; \
        _Pragma("unroll") for (int ks = 0; ks < 2; ++ks) { const float4 wa = *(const float4*)(sWS + c * 64 + ks * 32 + q4 * 8), wb = *(const float4*)(sWS + c * 64 + ks * 32 + q4 * 8 + 4); \
            _Pragma("unroll") for (int je = 0; je < 2; ++je) { const u32x4 sv = scale8h(VF[je][ks], wa, wb); vfr[je][ks] = *(const bf16x8*)&sv; } \
            if (nown) { _Pragma("unroll") for (int jd = 0; jd < 2; ++jd) npart[jd] = (ks == 0 ? dec * npart[jd] : npart[jd]) + dot8h(KF[jd][ks], wa, wb); } } \
        _Pragma("unroll") for (int je = 0; je < 2; ++je) _Pragma("unroll") for (int jd = 0; jd < 2; ++jd) acc[je][jd] = acc[je][jd] * dec; \
        _Pragma("unroll") for (int ks = 0; ks < 2; ++ks) _Pragma("unroll") for (int je = 0; je < 2; ++je) _Pragma("unroll") for (int jd = 0; jd < 2; ++jd) \
            acc[je][jd] = __builtin_amdgcn_mfma_f32_16x16x32_bf16(*(const bf16x8*)&KF[jd][ks], vfr[je][ks], acc[je][jd], 0, 0, 0); } while (0)
__device__ __forceinline__ void mlstm_state_pass(const int chain, const int half, const bf16_t* __restrict__ Pm, const bf16_t* __restrict__ KTg, const bf16_t* __restrict__ VTg, const float* __restrict__ gate_b,
                                                 bf16_t* __restrict__ CST, float* __restrict__ NST, float* __restrict__ MST, unsigned char* shm, const int tid) {
    const int dir = chain & 1, h = (chain >> 1) & 3, b = chain >> 3, lane = tid & 63, w = tid >> 6, we = w >> 2, wd = w & 3, q4 = lane >> 4, r16 = lane & 15;
    const bool nown = (half == 0) && (we == 0);
    float* sE = (float*)shm; float* sWS = sE + 68 * 64; float* sAL = sWS + 68 * 64; float* sBE = sAL + 68; float* sMO = sBE + 68; float* sDEC = sMO + 68; float* sMB = sDEC + 68;
    const float gbi = gate_b[(dir * 2 + 0) * 4 + h], gbf = gate_b[(dir * 2 + 1) * 4 + h];
    const int gcol_i = ML_OFF + 2048 + (dir * 2 + 0) * 4 + h, gcol_f = ML_OFF + 2048 + (dir * 2 + 1) * 4 + h;
    u32x4 kfA[2][2], vfA[2][2], kfB[2][2], vfB[2][2];
    ML_FRAG_LOAD(kfA, vfA, 0);
    __syncthreads();
    unsigned gi_[9], gf_[9];
#pragma unroll
    for (int q = 0; q < 9; ++q) { const int c = min(w + 8 * q, 67); const size_t tokl = (size_t)step_tok(b, dir, c * 64 + lane); gi_[q] = Pm[tokl * LDP + gcol_i]; gf_[q] = Pm[tokl * LDP + gcol_f]; }
#pragma unroll
    for (int q = 0; q < 9; ++q) { const int c = w + 8 * q; if (c >= 68) break;
        const float ig = __uint_as_float(gi_[q] << 16) + gbi, fg = __uint_as_float(gf_[q] << 16) + gbf;
        const float lf = fminf(fg, 0.f) - log1pf(expf(-fabsf(fg)));
        const float bcs = wave_scan_incl(lf, lane); const float blast = __shfl(bcs, 63); const float ei = blast - bcs + ig; const float beta = wave_max(ei);
        sE[c * 64 + lane] = ei; if (lane == 0) { sAL[c] = blast; sBE[c] = beta; } }
    __syncthreads();
    if (tid == 0) { float m = 0.f; for (int c = 0; c < 68; ++c) { sMB[c] = m; const float mo = fmaxf(m + sAL[c], sBE[c]); sDEC[c] = expf(sAL[c] + m - mo); sMO[c] = mo; m = mo; } }
    __syncthreads();
    for (int idx = tid; idx < 68 * 64; idx += NTHR) { const int c = idx >> 6, i = idx & 63; sWS[c * 64 + (dir ? 63 - i : i)] = expf(sE[idx] - sMO[c]); }
    if (half == 0 && tid < 68) MST[chain * 68 + tid] = sMB[tid];
    __syncthreads();
    f32x4 acc[2][2];
#pragma unroll
    for (int je = 0; je < 2; ++je)
#pragma unroll
        for (int jd = 0; jd < 2; ++jd) acc[je][jd] = (f32x4){0.f, 0.f, 0.f, 0.f};
    float npart[2] = {0.f, 0.f};
    for (int c2 = 0; c2 < 68; c2 += 2) { ML_CHUNK(c2, kfA, vfA, kfB, vfB); ML_CHUNK(c2 + 1, kfB, vfB, kfA, vfA); }
    __syncthreads();
}
#undef ML_CHUNK
#undef ML_FRAG_LOAD
__device__ __forceinline__ void mlstm_out_item(const int chain, const int c, const bf16_t* __restrict__ Pm, const bf16_t* __restrict__ QKb, const bf16_t* __restrict__ VTg, const float* __restrict__ gate_b,
                                               const bf16_t* __restrict__ CST, const float* __restrict__ NST, const float* __restrict__ MST, float* __restrict__ Hout, unsigned char* shm, const int tid) {
    const int dir = chain & 1, h = (chain >> 1) & 3, b = chain >> 3, lane = tid & 63, w = tid >> 6;
    bf16_t* Qs = (bf16_t*)shm; bf16_t* Ks = (bf16_t*)(shm + 17408); bf16_t* VT = (bf16_t*)(shm + 34816); bf16_t* Cs = (bf16_t*)(shm + 53248); bf16_t* Ss = (bf16_t*)(shm + 88064);
    float* sc = (float*)(shm + 97280);
    __syncthreads();
#pragma unroll
    for (int i = 0; i < 2; ++i) { const int pid = tid + i * 512; const int s = pid >> 4, x0 = (pid & 15) * 8; const size_t toks = (size_t)step_tok(b, dir, c * 64 + s);
        *(u32x4*)(Qs + s * 136 + x0) = *(const u32x4*)(QKb + toks * 1024 + h * 128 + x0);
        *(u32x4*)(Ks + s * 136 + x0) = *(const u32x4*)(QKb + toks * 1024 + 512 + h * 128 + x0);
        { const int e = pid >> 3, o = pid & 7;
          const u32x4 vv = *(const u32x4*)(VTg + ((size_t)tokblock_of(b, dir, c) * 512 + h * 128 + e) * 64 + (dir ? 7 - o : o) * 8);
          *(u32x4*)(VT + e * 72 + o * 8) = dir ? rev8h(vv) : vv; } }
#pragma unroll
    for (int i = 0; i < 4; ++i) { const int pid = tid + i * 512; const int e = pid >> 4, x0 = (pid & 15) * 8;
        *(u32x4*)(Cs + e * 136 + x0) = *(const u32x4*)(CST + ((size_t)(chain * 68 + c) * 128 + e) * 128 + x0); }
    if (tid < 128) sc[384 + tid] = NST[(size_t)(chain * 68 + c) * 128 + tid];
    if (w == 0) {
        const float gbi = gate_b[(dir * 2 + 0) * 4 + h], gbf = gate_b[(dir * 2 + 1) * 4 + h];
        const size_t tokl = (size_t)step_tok(b, dir, c * 64 + lane);
        const float ig = bf2f(Pm[tokl * LDP + ML_OFF + 2048 + (dir * 2 + 0) * 4 + h]) + gbi;
        const float fg = bf2f(Pm[tokl * LDP + ML_OFF + 2048 + (dir * 2 + 1) * 4 + h]) + gbf;
        const float lf = fminf(fg, 0.f) - log1pf(expf(-fabsf(fg)));
        const float bcs = wave_scan_incl(lf, lane); const float gsv = ig - bcs; const float pm = wave_scanmax_incl(gsv, lane);
        const float m_in = MST[chain * 68 + c]; const float mt = bcs + fmaxf(m_in, pm);
        sc[lane] = bcs; sc[64 + lane] = gsv; sc[128 + lane] = mt; sc[192 + lane] = expf(bcs + m_in - mt); sc[256 + lane] = expf(-mt);
    }
    __syncthreads();
    const int tt = w >> 1;
    {   f32x4 aS[2] = {(f32x4){0.f, 0.f, 0.f, 0.f}, (f32x4){0.f, 0.f, 0.f, 0.f}};
#pragma unroll
        for (int ks = 0; ks < 4; ++ks) { const bf16x8 af = *(const bf16x8*)(Qs + (16 * tt + (lane & 15)) * 136 + ks * 32 + (lane >> 4) * 8);
#pragma unroll
            for (int i = 0; i < 2; ++i) { const int st = (w & 1) * 2 + i; const bf16x8 bfr = *(const bf16x8*)(Ks + (16 * st + (lane & 15)) * 136 + ks * 32 + (lane >> 4) * 8);
                aS[i] = __builtin_amdgcn_mfma_f32_16x16x32_bf16(af, bfr, aS[i], 0, 0, 0); } }
        float rs[4] = {0.f, 0.f, 0.f, 0.f};
#pragma unroll
        for (int i = 0; i < 2; ++i) { const int s = 16 * ((w & 1) * 2 + i) + (lane & 15); const float gsv = sc[64 + s];
#pragma unroll
            for (int q = 0; q < 4; ++q) { const int t = 16 * tt + (lane >> 4) * 4 + q; const float val = (s <= t) ? aS[i][q] * expf(sc[t] + gsv - sc[128 + t]) : 0.f; Ss[t * 72 + s] = f2bf(val); rs[q] += val; } }
#pragma unroll
        for (int q = 0; q < 4; ++q) { float r = rs[q]; r += __shfl_xor(r, 1); r += __shfl_xor(r, 2); r += __shfl_xor(r, 4); r += __shfl_xor(r, 8);
            if ((lane & 15) == 0) sc[512 + (w & 1) * 64 + 16 * tt + (lane >> 4) * 4 + q] = r; }
        {   const int t = tid >> 3, part = tid & 7; float dot = 0.f;
#pragma unroll
            for (int j = 0; j < 16; ++j) dot += bf2f(Qs[t * 136 + part * 16 + j]) * sc[384 + part * 16 + j];
            dot += __shfl_xor(dot, 1); dot += __shfl_xor(dot, 2); dot += __shfl_xor(dot, 4);
            if (part == 0) sc[640 + t] = sc[192 + t] * dot; }
    }
    __syncthreads();
    {   f32x4 aN[4];
#pragma unroll
        for (int i = 0; i < 4; ++i) aN[i] = (f32x4){0.f, 0.f, 0.f, 0.f};
#pragma unroll
        for (int ks = 0; ks < 4; ++ks) { const bf16x8 af = *(const bf16x8*)(Qs + (16 * tt + (lane & 15)) * 136 + ks * 32 + (lane >> 4) * 8);
#pragma unroll
            for (int i = 0; i < 4; ++i) { const int et = (w & 1) * 4 + i; const bf16x8 bfr = *(const bf16x8*)(Cs + (16 * et + (lane & 15)) * 136 + ks * 32 + (lane >> 4) * 8);
                aN[i] = __builtin_amdgcn_mfma_f32_16x16x32_bf16(af, bfr, aN[i], 0, 0, 0); } }
#pragma unroll
        for (int q = 0; q < 4; ++q) { const float it = sc[192 + 16 * tt + (lane >> 4) * 4 + q];
#pragma unroll
            for (int i = 0; i < 4; ++i) aN[i][q] *= it; }
#pragma unroll
        for (int ks = 0; ks < 2; ++ks) { const bf16x8 af = *(const bf16x8*)(Ss + (16 * tt + (lane & 15)) * 72 + ks * 32 + (lane >> 4) * 8);
#pragma unroll
            for (int i = 0; i < 4; ++i) { const int et = (w & 1) * 4 + i; const bf16x8 bfr = *(const bf16x8*)(VT + (16 * et + (lane & 15)) * 72 + ks * 32 + (lane >> 4) * 8);
                aN[i] = __builtin_amdgcn_mfma_f32_16x16x32_bf16(af, bfr, aN[i], 0, 0, 0); } }
#pragma unroll
        for (int q = 0; q < 4; ++q) { const int t = 16 * tt + (lane >> 4) * 4 + q; const size_t tokt = (size_t)step_tok(b, dir, c * 64 + t); const float dn = fmaxf(fabsf((sc[512 + t] + sc[576 + t]) + sc[640 + t]), sc[256 + t]);
#pragma unroll
            for (int i = 0; i < 4; ++i) { const int e = 16 * ((w & 1) * 4 + i) + (lane & 15); Hout[tokt * BW + h * 128 + e] = aN[i][q] / dn; } }
    }
}


#define SD_FRAG_LOAD(BF, XF, cc_) do { const int tb_ = tokblock_of(b, dir, (cc_)); const bf16_t* bb_ = BTg + ((size_t)tb_ * 256 + grp * 128 + 64 * (w >> 2) + r16) * 64 + q4 * 8; const bf16_t* xb_ = XTg + ((size_t)tb_ * 512 + h * 64 + 16 * (w & 3) + r16) * 64 + q4 * 8; \
        _Pragma("unroll") for (int ks_ = 0; ks_ < 2; ++ks_) { XF[ks_] = *(const u32x4*)(xb_ + ks_ * 32); _Pragma("unroll") for (int j_ = 0; j_ < 4; ++j_) BF[j_][ks_] = *(const u32x4*)(bb_ + (size_t)j_ * 16 * 64 + ks_ * 32); } } while (0)
#define SD_CHUNK(c_, BF, XF, BFN, XFN) do { const int c = (c_); \
        if (c + 1 < 68) SD_FRAG_LOAD(BFN, XFN, c + 1); \
        const float dec = sDEC[c]; \
        {   bf16_t* ss = SSTb + (size_t)(chain * 68 + c) * 64 * 128; const int p = 16 * (w & 3) + r16; \
            _Pragma("unroll") for (int j = 0; j < 4; ++j) { const int n0 = 16 * ((w >> 2) * 4 + j) + q4 * 4; u32x2 pk; pk.x = pk2(acc[j][0], acc[j][1]); pk.y = pk2(acc[j][2], acc[j][3]); *(u32x2*)(ss + (size_t)p * 128 + n0) = pk; } } \
        bf16x8 xfr[2]; \
        _Pragma("unroll") for (int ks = 0; ks < 2; ++ks) { const float4 wa = *(const float4*)(sSC + c * 64 + ks * 32 + q4 * 8), wb = *(const float4*)(sSC + c * 64 + ks * 32 + q4 * 8 + 4); const u32x4 sv = scale8h(XF[ks], wa, wb); xfr[ks] = *(const bf16x8*)&sv; } \
        _Pragma("unroll") for (int j = 0; j < 4; ++j) acc[j] = acc[j] * dec; \
        _Pragma("unroll") for (int ks = 0; ks < 2; ++ks) _Pragma("unroll") for (int j = 0; j < 4; ++j) acc[j] = __builtin_amdgcn_mfma_f32_16x16x32_bf16(*(const bf16x8*)&BF[j][ks], xfr[ks], acc[j], 0, 0, 0); } while (0)
__device__ __forceinline__ void ssd_state_pass(const int chain, const bf16_t* __restrict__ Pm, const bf16_t* __restrict__ BTg, const bf16_t* __restrict__ XTg, const float Aa, const float dtb,
                                               bf16_t* __restrict__ SSTb, unsigned char* shm, const int tid) {
    const int dir = chain & 1, h = (chain >> 1) & 7, b = chain >> 4, grp = h >> 2, lane = tid & 63, w = tid >> 6, q4 = lane >> 4, r16 = lane & 15;
    float* sSC = (float*)shm; float* sDEC = sSC + 68 * 64;
    const int dcol = SSD_OFF + 1536 + dir * 8 + h;
    u32x4 bfA[4][2], xfA[2], bfB[4][2], xfB[2];
    SD_FRAG_LOAD(bfA, xfA, 0);
    __syncthreads();
    unsigned dt_[9];
#pragma unroll
    for (int q = 0; q < 9; ++q) { const int c = min(w + 8 * q, 67); dt_[q] = Pm[(size_t)step_tok(b, dir, c * 64 + lane) * LDP + dcol]; }
#pragma unroll
    for (int q = 0; q < 9; ++q) { const int c = w + 8 * q; if (c >= 68) break;
        const float xv = __uint_as_float(dt_[q] << 16) + dtb; const float dtv = xv > 20.f ? xv : log1pf(expf(xv));
        const float cs = wave_scan_incl(dtv * Aa, lane); const float cl = __shfl(cs, 63);
        sSC[c * 64 + (dir ? 63 - lane : lane)] = dtv * expf(cl - cs); if (lane == 0) sDEC[c] = expf(cl); }
    __syncthreads();
    f32x4 acc[4];
#pragma unroll
    for (int j = 0; j < 4; ++j) acc[j] = (f32x4){0.f, 0.f, 0.f, 0.f};
    for (int c2 = 0; c2 < 68; c2 += 2) { SD_CHUNK(c2, bfA, xfA, bfB, xfB); SD_CHUNK(c2 + 1, bfB, xfB, bfA, xfA); }
    __syncthreads();
}
#undef SD_CHUNK
#undef SD_FRAG_LOAD
__device__ __forceinline__ void ssd_out_item(const int chain, const int c, const bf16_t* __restrict__ Pm, const bf16_t* __restrict__ XBb, const bf16_t* __restrict__ XTg, const float Aa, const float dtb,
                                             const bf16_t* __restrict__ SSTb, float* __restrict__ Yout, unsigned char* shm, const int tid) {
    const int dir = chain & 1, h = (chain >> 1) & 7, b = chain >> 4, grp = h >> 2, lane = tid & 63, w = tid >> 6;
    bf16_t* Cs = (bf16_t*)shm; bf16_t* Bs = (bf16_t*)(shm + 17408); bf16_t* XT = (bf16_t*)(shm + 34816); bf16_t* Sin = (bf16_t*)(shm + 44032); bf16_t* Gs = (bf16_t*)(shm + 61440);
    float* sc = (float*)(shm + 70656);
    __syncthreads();
#pragma unroll
    for (int i = 0; i < 2; ++i) { const int pid = tid + i * 512; const int s = pid >> 4, x0 = (pid & 15) * 8; const size_t toks = (size_t)step_tok(b, dir, c * 64 + s);
        *(u32x4*)(Bs + s * 136 + x0) = *(const u32x4*)(XBb + toks * 1024 + 512 + grp * 128 + x0);
        *(u32x4*)(Cs + s * 136 + x0) = *(const u32x4*)(XBb + toks * 1024 + 768 + grp * 128 + x0);
        const int p = pid >> 4;
        *(u32x4*)(Sin + p * 136 + x0) = *(const u32x4*)(SSTb + ((size_t)(chain * 68 + c) * 64 + p) * 128 + x0); }
    {   const int p = tid >> 3, o = tid & 7;
        const u32x4 vv = *(const u32x4*)(XTg + ((size_t)tokblock_of(b, dir, c) * 512 + h * 64 + p) * 64 + (dir ? 7 - o : o) * 8);
        *(u32x4*)(XT + p * 72 + o * 8) = dir ? rev8h(vv) : vv; }
    if (w == 0) { const size_t tokl = (size_t)step_tok(b, dir, c * 64 + lane);
        const float xv = bf2f(Pm[tokl * LDP + SSD_OFF + 1536 + dir * 8 + h]) + dtb; const float dtv = xv > 20.f ? xv : log1pf(expf(xv));
        sc[lane] = wave_scan_incl(dtv * Aa, lane); sc[64 + lane] = dtv; }
    __syncthreads();
    {   const int lt = w >> 1;
        f32x4 aG[2] = {(f32x4){0.f, 0.f, 0.f, 0.f}, (f32x4){0.f, 0.f, 0.f, 0.f}};
#pragma unroll
        for (int ks = 0; ks < 4; ++ks) { const bf16x8 af = *(const bf16x8*)(Cs + (16 * lt + (lane & 15)) * 136 + ks * 32 + (lane >> 4) * 8);
#pragma unroll
            for (int i = 0; i < 2; ++i) { const int st = (w & 1) * 2 + i; const bf16x8 bfr = *(const bf16x8*)(Bs + (16 * st + (lane & 15)) * 136 + ks * 32 + (lane >> 4) * 8);
                aG[i] = __builtin_amdgcn_mfma_f32_16x16x32_bf16(af, bfr, aG[i], 0, 0, 0); } }
#pragma unroll
        for (int i = 0; i < 2; ++i) { const int s = 16 * ((w & 1) * 2 + i) + (lane & 15); const float css = sc[s], dts = sc[64 + s];
#pragma unroll
            for (int q = 0; q < 4; ++q) { const int t = 16 * lt + (lane >> 4) * 4 + q; const float val = (s <= t) ? aG[i][q] * expf(sc[t] - css) * dts : 0.f; Gs[t * 72 + s] = f2bf(val); } }
    }
    __syncthreads();
    {   const int lt = w >> 1;
        f32x4 aY[2] = {(f32x4){0.f, 0.f, 0.f, 0.f}, (f32x4){0.f, 0.f, 0.f, 0.f}};
#pragma unroll
        for (int ks = 0; ks < 4; ++ks) { const bf16x8 af = *(const bf16x8*)(Cs + (16 * lt + (lane & 15)) * 136 + ks * 32 + (lane >> 4) * 8);
#pragma unroll
            for (int i = 0; i < 2; ++i) { const int pt = (w & 1) * 2 + i; const bf16x8 bfr = *(const bf16x8*)(Sin + (16 * pt + (lane & 15)) * 136 + ks * 32 + (lane >> 4) * 8);
                aY[i] = __builtin_amdgcn_mfma_f32_16x16x32_bf16(af, bfr, aY[i], 0, 0, 0); } }
#pragma unroll
        for (int q = 0; q < 4; ++q) { const float ec = expf(sc[16 * lt + (lane >> 4) * 4 + q]); aY[0][q] *= ec; aY[1][q] *= ec; }
#pragma unroll
        for (int ks = 0; ks < 2; ++ks) { const bf16x8 af = *(const bf16x8*)(Gs + (16 * lt + (lane & 15)) * 72 + ks * 32 + (lane >> 4) * 8);
#pragma unroll
            for (int i = 0; i < 2; ++i) { const int pt = (w & 1) * 2 + i; const bf16x8 bfr = *(const bf16x8*)(XT + (16 * pt + (lane & 15)) * 72 + ks * 32 + (lane >> 4) * 8);
                aY[i] = __builtin_amdgcn_mfma_f32_16x16x32_bf16(af, bfr, aY[i], 0, 0, 0); } }
#pragma unroll
        for (int q = 0; q < 4; ++q) { const int t = 16 * lt + (lane >> 4) * 4 + q; const size_t tokt = (size_t)step_tok(b, dir, c * 64 + t);
#pragma unroll
            for (int i = 0; i < 2; ++i) { const int p = 16 * ((w & 1) * 2 + i) + (lane & 15); Yout[tokt * BW + h * 64 + p] = aY[i][q]; } }
    }
}


#define FIDX(i) ((i) + ((i) >> 4))
#define FFT_X_BYTES 69632
__device__ constexpr float FFT_CW_RE[6][16] = {{0.f, 0.f, 0.f, 0.f, 0.f, 0.f, 0.f, 0.f, 0.f, 0.f, 0.f, 0.f, 0.f, 0.f, 0.f, 0.f}, {1.0f, 0.f, 0.f, 0.f, 0.f, 0.f, 0.f, 0.f, 0.f, 0.f, 0.f, 0.f, 0.f, 0.f, 0.f, 0.f}, {1.0f, 6.123233995736766e-17f, 0.f, 0.f, 0.f, 0.f, 0.f, 0.f, 0.f, 0.f, 0.f, 0.f, 0.f, 0.f, 0.f, 0.f}, {1.0f, 0.7071067811865476f, 6.123233995736766e-17f, -0.7071067811865475f, 0.f, 0.f, 0.f, 0.f, 0.f, 0.f, 0.f, 0.f, 0.f, 0.f, 0.f, 0.f}, {1.0f, 0.9238795325112867f, 0.7071067811865476f, 0.38268343236508984f, 6.123233995736766e-17f, -0.3826834323650897f, -0.7071067811865475f, -0.9238795325112867f, 0.f, 0.f, 0.f, 0.f, 0.f, 0.f, 0.f, 0.f}, {1.0f, 0.9807852804032304f, 0.9238795325112867f, 0.8314696123025452f, 0.7071067811865476f, 0.5555702330196023f, 0.38268343236508984f, 0.19509032201612833f, 6.123233995736766e-17f, -0.1950903220161282f, -0.3826834323650897f, -0.555570233019602f, -0.7071067811865475f, -0.8314696123025453f, -0.9238795325112867f, -0.9807852804032304f}};
__device__ constexpr float FFT_CW_IM[6][16] = {{0.f, 0.f, 0.f, 0.f, 0.f, 0.f, 0.f, 0.f, 0.f, 0.f, 0.f, 0.f, 0.f, 0.f, 0.f, 0.f}, {-0.0f, 0.f, 0.f, 0.f, 0.f, 0.f, 0.f, 0.f, 0.f, 0.f, 0.f, 0.f, 0.f, 0.f, 0.f, 0.f}, {-0.0f, -1.0f, 0.f, 0.f, 0.f, 0.f, 0.f, 0.f, 0.f, 0.f, 0.f, 0.f, 0.f, 0.f, 0.f, 0.f}, {-0.0f, -0.7071067811865475f, -1.0f, -0.7071067811865476f, 0.f, 0.f, 0.f, 0.f, 0.f, 0.f, 0.f, 0.f, 0.f, 0.f, 0.f, 0.f}, {-0.0f, -0.3826834323650898f, -0.7071067811865475f, -0.9238795325112867f, -1.0f, -0.9238795325112867f, -0.7071067811865476f, -0.3826834323650899f, 0.f, 0.f, 0.f, 0.f, 0.f, 0.f, 0.f, 0.f}, {-0.0f, -0.19509032201612825f, -0.3826834323650898f, -0.5555702330196022f, -0.7071067811865475f, -0.8314696123025452f, -0.9238795325112867f, -0.9807852804032304f, -1.0f, -0.9807852804032304f, -0.9238795325112867f, -0.8314696123025455f, -0.7071067811865476f, -0.5555702330196022f, -0.3826834323650899f, -0.1950903220161286f}};
__host__ __device__ constexpr int fft_bitrev(int k, int R) { int r = 0; for (int i = 0; i < R; ++i) if (k & (1 << i)) r |= 1 << (R - 1 - i); return r; }
template <int R, bool INV>
__device__ __forceinline__ void fft_pass(float2* __restrict__ X, const float2* __restrict__ TW, const int s0, const int gidx) {
    const int lowbits = 13 - s0 - R; const int stride = 1 << lowbits;
    const int low = gidx & (stride - 1), high = gidx >> lowbits; const int base = (high << (lowbits + R)) | low;
    const int p0 = FIDX(base);
#define FFT_SLOT(k) (lowbits >= 4 ? p0 + (k) * (stride + (stride >> 4)) : p0 + (k) + ((k) >> 4))
    float2 v[1 << R];
#pragma unroll
    for (int k = 0; k < (1 << R); ++k) v[k] = X[FFT_SLOT(k)];
    const int lw = low << s0;
    if (!INV) {
#pragma unroll
        for (int j = 0; j < R; ++j) { const int hk = 1 << (R - 1 - j);
#pragma unroll
            for (int k = 0; k < (1 << R); ++k) if (!(k & hk)) { const int kk = k & (hk - 1);
                const float2 a = v[k], b = v[k + hk]; v[k] = make_float2(a.x + b.x, a.y + b.y); const float dx = a.x - b.x, dy = a.y - b.y;
                if (kk == 0) v[k + hk] = make_float2(dx, dy);
                else if (2 * kk == hk) v[k + hk] = make_float2(dy, -dx);
                else { const float cr = FFT_CW_RE[R - j][kk], ci = FFT_CW_IM[R - j][kk]; v[k + hk] = make_float2(dx * cr - dy * ci, dx * ci + dy * cr); } } }
        if (lowbits > 0) {
#pragma unroll
            for (int k = 1; k < (1 << R); ++k) { const float2 w = TW[(lw * fft_bitrev(k, R)) & 8191]; const float2 a = v[k]; v[k] = make_float2(a.x * w.x - a.y * w.y, a.x * w.y + a.y * w.x); } }
    } else {
        if (lowbits > 0) {
#pragma unroll
            for (int k = 1; k < (1 << R); ++k) { const float2 w = TW[(lw * fft_bitrev(k, R)) & 8191]; const float2 a = v[k]; v[k] = make_float2(a.x * w.x + a.y * w.y, a.y * w.x - a.x * w.y); } }
#pragma unroll
        for (int j = R - 1; j >= 0; --j) { const int hk = 1 << (R - 1 - j);
#pragma unroll
            for (int k = 0; k < (1 << R); ++k) if (!(k & hk)) { const int kk = k & (hk - 1);
                const float2 a = v[k], b = v[k + hk]; float tx, ty;
                if (kk == 0) { tx = b.x; ty = b.y; }
                else if (2 * kk == hk) { tx = -b.y; ty = b.x; }
                else { const float cr = FFT_CW_RE[R - j][kk], ci = FFT_CW_IM[R - j][kk]; tx = b.x * cr + b.y * ci; ty = b.y * cr - b.x * ci; }
                v[k] = make_float2(a.x + tx, a.y + ty); v[k + hk] = make_float2(a.x - tx, a.y - ty); } }
    }
#pragma unroll
    for (int k = 0; k < (1 << R); ++k) X[FFT_SLOT(k)] = v[k];
#undef FFT_SLOT
}
__device__ __forceinline__ void fft_fwd(float2* X, const float2* TW, const int tid) {
    fft_pass<4, false>(X, TW, 0, tid); __syncthreads(); fft_pass<4, false>(X, TW, 4, tid); __syncthreads(); if (tid < 256) fft_pass<5, false>(X, TW, 8, tid); __syncthreads(); }
__device__ __forceinline__ void fft_inv(float2* X, const float2* TW, const int tid) {
    if (tid < 256) fft_pass<5, true>(X, TW, 8, tid); __syncthreads(); fft_pass<4, true>(X, TW, 4, tid); __syncthreads(); fft_pass<4, true>(X, TW, 0, tid); __syncthreads(); }
__device__ __forceinline__ void fft_twiddles(float2* TW, const int tid) {
#pragma unroll
    for (int k = 0; k < 16; ++k) { const int m = tid + k * 512; const float xx = (float)m * (1.0f / 4096.0f); TW[m] = make_float2(cospif(xx), -sinpif(xx)); }
}
__device__ __forceinline__ void hyena_spec_item(const int oc, const float* __restrict__ HR, const float* __restrict__ nrm, float2* __restrict__ HSPEC, unsigned char* shm, const int tid) {
    float2* X = (float2*)shm; const float2* TW = (const float2*)(shm + FFT_X_BYTES);
    const int o = oc >> 9, c = oc & 511; const float inv = 1.0f / nrm[oc];
    __syncthreads();
    float hv[16];
#pragma unroll
    for (int k = 0; k < 16; ++k) { const int j = tid + k * 512;
        const unsigned off = j < SEQ ? (unsigned)j * 2048u + o * 1024 + c : j == SEQ ? (unsigned)(o * 1024 + c) : (unsigned)(2 * SEQ - j) * 2048u + o * 1024 + 512 + c;
        hv[k] = HR[off]; }
#pragma unroll
    for (int k = 0; k < 16; ++k) { const int j = tid + k * 512; X[FIDX(j)] = make_float2(j == SEQ ? 0.f : hv[k] * inv, 0.f); }
    __syncthreads();
    fft_fwd(X, TW, tid);
    float4* out = (float4*)(HSPEC + (size_t)oc * 8192 + tid * 16); const float2* xs = X + 17 * tid;
#pragma unroll
    for (int k = 0; k < 8; ++k) { const float2 x0 = xs[2 * k], x1 = xs[2 * k + 1]; out[k] = make_float4(x0.x * (1.0f / 8192.0f), x0.y * (1.0f / 8192.0f), x1.x * (1.0f / 8192.0f), x1.y * (1.0f / 8192.0f)); }
}
__device__ __forceinline__ void fft_mul_spec(float2* X, const float2* __restrict__ H, const int tid) {
    const float4* h4 = (const float4*)(H + tid * 16); float2* xs = X + 17 * tid;
#pragma unroll
    for (int k = 0; k < 8; ++k) { const float4 hv = h4[k]; const float2 x0 = xs[2 * k], x1 = xs[2 * k + 1];
        xs[2 * k] = make_float2(x0.x * hv.x - x0.y * hv.y, x0.x * hv.y + x0.y * hv.x); xs[2 * k + 1] = make_float2(x1.x * hv.z - x1.y * hv.w, x1.x * hv.w + x1.y * hv.z); }
}
__device__ __forceinline__ void hyena_fft_item(const int item, const float* __restrict__ UT, const float2* __restrict__ HSPEC, const float* __restrict__ bias, float* __restrict__ YT, unsigned char* shm, const int tid) {
    float2* X = (float2*)shm; const float2* TW = (const float2*)(shm + FFT_X_BYTES);
    const int c = item >> 1, b0 = (item & 1) * 2, b1 = b0 + 1;
    const float* u0 = UT + (size_t)(b0 * 1536 + c) * SEQ + tid * 8; const float* u1 = UT + (size_t)(b1 * 1536 + c) * SEQ + tid * 8;
    const float bias0 = bias[c], bias1 = bias[512 + c];
    float2* xs = X + FIDX(8 * tid);
    float vr[8], vi[8];
    __syncthreads();
    { const float4 a0 = *(const float4*)u0, a1 = *(const float4*)(u0 + 4), c0 = *(const float4*)u1, c1 = *(const float4*)(u1 + 4);
      vr[0] = a0.x; vr[1] = a0.y; vr[2] = a0.z; vr[3] = a0.w; vr[4] = a1.x; vr[5] = a1.y; vr[6] = a1.z; vr[7] = a1.w;
      vi[0] = c0.x; vi[1] = c0.y; vi[2] = c0.z; vi[3] = c0.w; vi[4] = c1.x; vi[5] = c1.y; vi[6] = c1.z; vi[7] = c1.w; }
#pragma unroll
    for (int k = 0; k < 8; ++k) { xs[k] = make_float2(vr[k], vi[k]); xs[4352 + k] = make_float2(0.f, 0.f); }
    __syncthreads();
    fft_fwd(X, TW, tid);
    fft_mul_spec(X, HSPEC + (size_t)c * 8192, tid);
    __syncthreads();
    fft_inv(X, TW, tid);
    { const float* p0 = u0 + (size_t)512 * SEQ; const float* p1 = u1 + (size_t)512 * SEQ;
      const float4 a0 = *(const float4*)p0, a1 = *(const float4*)(p0 + 4), c0 = *(const float4*)p1, c1 = *(const float4*)(p1 + 4);
      const float xr[8] = {a0.x, a0.y, a0.z, a0.w, a1.x, a1.y, a1.z, a1.w}, xi[8] = {c0.x, c0.y, c0.z, c0.w, c1.x, c1.y, c1.z, c1.w};
#pragma unroll
      for (int k = 0; k < 8; ++k) { const float2 cv = xs[k]; const float zr = xr[k] * (cv.x + bias0 * vr[k]), zi = xi[k] * (cv.y + bias0 * vi[k]);
          vr[k] = zr; vi[k] = zi; xs[k] = make_float2(zr, zi); xs[4352 + k] = make_float2(0.f, 0.f); } }
    __syncthreads();
    fft_fwd(X, TW, tid);
    fft_mul_spec(X, HSPEC + (size_t)(512 + c) * 8192, tid);
    __syncthreads();
    fft_inv(X, TW, tid);
    { const float* p0 = u0 + (size_t)1024 * SEQ; const float* p1 = u1 + (size_t)1024 * SEQ;
      const float4 a0 = *(const float4*)p0, a1 = *(const float4*)(p0 + 4), c0 = *(const float4*)p1, c1 = *(const float4*)(p1 + 4);
      const float xr[8] = {a0.x, a0.y, a0.z, a0.w, a1.x, a1.y, a1.z, a1.w}, xi[8] = {c0.x, c0.y, c0.z, c0.w, c1.x, c1.y, c1.z, c1.w};
      float yr[8], yi[8];
#pragma unroll
      for (int k = 0; k < 8; ++k) { const float2 cv = xs[k]; yr[k] = xr[k] * (cv.x + bias1 * vr[k]); yi[k] = xi[k] * (cv.y + bias1 * vi[k]); }
      float* y0 = YT + (size_t)(b0 * 512 + c) * SEQ + tid * 8; float* y1 = YT + (size_t)(b1 * 512 + c) * SEQ + tid * 8;
      *(float4*)y0 = make_float4(yr[0], yr[1], yr[2], yr[3]); *(float4*)(y0 + 4) = make_float4(yr[4], yr[5], yr[6], yr[7]);
      *(float4*)y1 = make_float4(yi[0], yi[1], yi[2], yi[3]); *(float4*)(y1 + 4) = make_float4(yi[4], yi[5], yi[6], yi[7]); }
}

constexpr size_t al256(size_t x) { return (x + 255) & ~(size_t)255; }
constexpr size_t O_BAR = 0;
constexpr size_t O_MOD = 16384;
constexpr size_t O_NORM = O_MOD + al256((size_t)2 * 5 * 6 * DM * 4);
constexpr size_t O_QCTR = O_NORM + al256((size_t)2 * 2 * 1024 * 4);
constexpr size_t O_ZERO_END = O_QCTR + 512;
constexpr size_t O_XS = O_ZERO_END;
constexpr size_t O_HB = O_XS + al256((size_t)NTOK * DM * 4);
constexpr size_t O_P = O_HB + al256((size_t)NTOK * DM * 2);
constexpr size_t O_WIN = O_P + al256((size_t)NTOK * LDP * 2);
constexpr size_t O_WBR = O_WIN + al256((size_t)LDP * DM * 2);
constexpr size_t O_WOUT = O_WBR + al256((size_t)4 * DM * BW * 2);
constexpr size_t O_WGU = O_WOUT + al256((size_t)DM * DM * 2);
constexpr size_t O_WD = O_WGU + al256((size_t)NEXP * 2 * DEXP * DM * 2);
constexpr size_t O_GLU = O_WD + al256((size_t)NEXP * DM * DEXP * 2);
constexpr size_t O_Y4 = O_GLU + al256((size_t)BW * BW * 2);
constexpr size_t O_U = O_Y4 + al256((size_t)NTOK * DM * 2);
constexpr size_t O_QKB = O_U + al256((size_t)NTOK * 1536 * 4);
constexpr size_t O_CST = O_QKB + al256((size_t)NTOK * 1024 * 2);
constexpr size_t O_NST = O_CST + al256((size_t)32 * 68 * 128 * 128 * 2);
constexpr size_t O_MST = O_NST + al256((size_t)32 * 68 * 128 * 4);
constexpr size_t O_XBC = O_MST + al256((size_t)32 * 68 * 4);
constexpr size_t O_SST = O_XBC + al256((size_t)NTOK * 1024 * 2);
constexpr size_t O_HF = O_SST + al256((size_t)64 * 68 * 64 * 128 * 2);
constexpr size_t O_YF = O_HF + al256((size_t)2 * NTOK * BW * 4);
constexpr size_t O_SF = O_YF + al256((size_t)2 * NTOK * BW * 4);
constexpr size_t O_LDT = O_SF + al256((size_t)2 * NCTX * BW * 4);
constexpr size_t O_AP = O_LDT + al256((size_t)4096 * 16);
constexpr size_t O_BBT = O_AP + al256((size_t)4096 * 33 * 8);
constexpr size_t O_KT = O_BBT + al256((size_t)4096 * 16 * 8);
constexpr size_t O_S5A = O_KT + al256((size_t)32 * 2 * 32 * 256 * 4);
constexpr size_t O_S5B = O_S5A + al256((size_t)32 * 512 * 768 * 2);
constexpr size_t O_XCTX = O_S5B + al256((size_t)32 * 512 * 768 * 2);
constexpr size_t O_Z = O_XCTX + al256((size_t)4 * 32 * 2 * 64 * 8);
constexpr size_t O_HRAW = O_Z + al256((size_t)NTOK * BW * 4);
constexpr size_t O_HSPEC = O_HRAW + al256((size_t)(SEQ + CTXL) * 2048 * 4);
constexpr size_t O_K2C = O_HSPEC + al256((size_t)1024 * 8192 * 8);
constexpr size_t O_GG = O_K2C + al256((size_t)(2 * CTXL) * 1024 * 4);
constexpr size_t O_PROBS = O_GG + al256((size_t)NTOK * BW * 2);
constexpr size_t O_ROWTOK = O_PROBS + al256((size_t)NTOK * 16 * 4);
constexpr size_t O_ROWGATE = O_ROWTOK + al256((size_t)NEXP * MOE_PAD * 4);
constexpr size_t O_INV = O_ROWGATE + al256((size_t)NEXP * MOE_PAD * 4);
constexpr size_t O_NORMP = O_INV + al256((size_t)NTOK * 16 * 4);
constexpr size_t WS_END = O_NORMP + al256((size_t)4 * 256 * 2048 * 4);
constexpr size_t O_XG = O_P;
constexpr size_t O_HID = O_P + al256((size_t)NEXP * MOE_PAD * DM * 2);
constexpr size_t O_YEXP = O_HID + al256((size_t)NEXP * MOE_PAD * DEXP * 2);
static_assert(O_YEXP + (size_t)NEXP * MOE_PAD * DM * 2 <= O_WIN, "MoE temporaries must fit inside P");
static_assert((size_t)NTOK * DM * 2 <= (size_t)NTOK * 1536 * 4, "ACCb must fit inside U");
static_assert((size_t)26214400 + (size_t)2 * 17825792 + (size_t)272 * 256 * 64 * 2 <= (size_t)NTOK * DM * 2, "strip buffers must fit inside HB");
static_assert(WS_END <= (size_t)1851000000, "workspace map exceeds the guaranteed size");

struct Args {
    const float* in[47];
    float* out; unsigned char* ws;
    int ph_lo, ph_hi;
};

__device__ __forceinline__ void conv_tile(const float* __restrict__ src, int ldsrc, int nvalid, int k0, int n0, bf16_t* __restrict__ dst, int lddst, int mode, float* T, int tid) {
    { const int n = tid & 63, kr = tid >> 6;
#pragma unroll
      for (int i = 0; i < 8; ++i) { const int k = i * 8 + kr; T[k * 65 + n] = (n0 + n < nvalid) ? src[(size_t)(k0 + k) * ldsrc + n0 + n] : 0.f; } }
    __syncthreads();
    { const int n = tid >> 3, kc = (tid & 7) * 8; const int gn = n0 + n;
      const int drow = mode == 0 ? gn : (32 * (gn >> 4) + (mode == 2 ? 16 : 0) + (gn & 15));
      u32x4 w; w.x = pk2(T[(kc + 0) * 65 + n], T[(kc + 1) * 65 + n]); w.y = pk2(T[(kc + 2) * 65 + n], T[(kc + 3) * 65 + n]);
      w.z = pk2(T[(kc + 4) * 65 + n], T[(kc + 5) * 65 + n]); w.w = pk2(T[(kc + 6) * 65 + n], T[(kc + 7) * 65 + n]);
      *(u32x4*)(dst + (size_t)drow * lddst + k0 + kc) = w; }
    __syncthreads();
}

#define IN(id) (lo <= (id) && (id) < hi)
#define SEAM(id) do { if (hi > (id) + 1) xcd_barrier(bar); } while (0)
#define PH_BEGIN int tid = threadIdx.x; asm volatile("" : "+v"(tid) :: "memory"); const int lane = tid & 63, wave = tid >> 6; (void)lane; (void)wave;

#define x_in (PT(0))
#define c_in (PT(1))
#define ctx_in (PT(2))
#define cctx_in (PT(3))
#define ada_w (PT(4))
#define ada_b (PT(5))
#define norm_mix (PT(6))
#define norm_ffn (PT(7))
#define w_in (PT(8))
#define XS ((float*)(a.ws + O_XS))
#define MOD ((float*)(a.ws + O_MOD))
#define NORM ((float*)(a.ws + O_NORM))
#define NORMP ((float*)(a.ws + O_NORMP))
#define MODl (MOD + (size_t)l * 5 * 6 * DM)
#define HB ((bf16_t*)(a.ws + O_HB))
#define P ((bf16_t*)(a.ws + O_P))
#define WIN ((bf16_t*)(a.ws + O_WIN))
#define WBR ((bf16_t*)(a.ws + O_WBR))
#define WOUT ((bf16_t*)(a.ws + O_WOUT))
#define WGU ((bf16_t*)(a.ws + O_WGU))
#define WD ((bf16_t*)(a.ws + O_WD))
#define GLU ((bf16_t*)(a.ws + O_GLU))
#define Y4 ((bf16_t*)(a.ws + O_Y4))
#define U ((float*)(a.ws + O_U))
#define ACCb ((bf16_t*)(a.ws + O_U))
#define QKB ((bf16_t*)(a.ws + O_QKB))
#define CST ((bf16_t*)(a.ws + O_CST))
#define NST ((float*)(a.ws + O_NST))
#define MST ((float*)(a.ws + O_MST))
#define XBC ((bf16_t*)(a.ws + O_XBC))
#define SSTB ((bf16_t*)(a.ws + O_SST))
#define HF ((float*)(a.ws + O_HF))
#define HBk (HF + (size_t)NTOK * BW)
#define YF ((float*)(a.ws + O_YF))
#define YB (YF + (size_t)NTOK * BW)
#define SF ((float*)(a.ws + O_SF))
#define SB (SF + (size_t)NCTX * BW)
#define LDT ((double2*)(a.ws + O_LDT))
#define APW ((float2*)(a.ws + O_AP))
#define BBT ((float2*)(a.ws + O_BBT))
#define KTB ((float*)(a.ws + O_KT))
#define S5A ((bf16_t*)(a.ws + O_S5A))
#define S5B ((bf16_t*)(a.ws + O_S5B))
#define XCTX ((float2*)(a.ws + O_XCTX))
#define S5P ((bf16_t*)(a.ws + O_HB))
#define XLOC ((float*)(a.ws + O_HB + (size_t)32 * 256 * 512 * 2))
#define KTG ((bf16_t*)(a.ws + O_HB + (size_t)26214400))
#define VTG ((bf16_t*)(a.ws + O_HB + (size_t)26214400 + (size_t)17825792))
#define BTG ((bf16_t*)(a.ws + O_HB + (size_t)26214400 + (size_t)2 * 17825792))
#define XTG ((bf16_t*)(a.ws + O_GG))
#define Z ((float*)(a.ws + O_Z))
#define HRAW ((float*)(a.ws + O_HRAW))
#define HSPEC ((float2*)(a.ws + O_HSPEC))
#define UT ((float*)(a.ws + O_U))
#define YT ((float*)(a.ws + O_Z))
#define QCTR ((int*)(a.ws + O_QCTR))
#define K2C ((float*)(a.ws + O_K2C))
#define GG ((bf16_t*)(a.ws + O_GG))
#define PROBS ((float*)(a.ws + O_PROBS))
#define ROWTOK ((int*)(a.ws + O_ROWTOK))
#define ROWGATE ((float*)(a.ws + O_ROWGATE))
#define XG ((bf16_t*)(a.ws + O_XG))
#define HID ((bf16_t*)(a.ws + O_HID))
#define YEXP ((bf16_t*)(a.ws + O_YEXP))
#define INV ((int*)(a.ws + O_INV))


__device__ __forceinline__ void moe_pair(float4 (&a)[8], const int r1, const int r2, const float g2scale, const int lane, const float* __restrict__ rowgate, const bf16_t* __restrict__ yexp) {
    const float gt1 = rowgate[r1], gt2 = rowgate[r2] * g2scale;
    const bf16_t* y1 = yexp + (size_t)r1 * DM + lane * 4; const bf16_t* y2 = yexp + (size_t)r2 * DM + lane * 4;
    u32x2 w1[8], w2[8];
#pragma unroll
    for (int i = 0; i < 8; ++i) { w1[i] = *(const u32x2*)(y1 + i * 256); w2[i] = *(const u32x2*)(y2 + i * 256); }
#pragma unroll
    for (int i = 0; i < 8; ++i) {
        a[i].x += gt1 * __uint_as_float(w1[i].x << 16); a[i].y += gt1 * __uint_as_float(w1[i].x & 0xFFFF0000u); a[i].z += gt1 * __uint_as_float(w1[i].y << 16); a[i].w += gt1 * __uint_as_float(w1[i].y & 0xFFFF0000u);
        a[i].x += gt2 * __uint_as_float(w2[i].x << 16); a[i].y += gt2 * __uint_as_float(w2[i].x & 0xFFFF0000u); a[i].z += gt2 * __uint_as_float(w2[i].y << 16); a[i].w += gt2 * __uint_as_float(w2[i].y & 0xFFFF0000u); }
}
__device__ __forceinline__ void moe_combine(float4 (&v)[8], const int tok, const int lane, const int* __restrict__ inv, const float* __restrict__ rowgate, const bf16_t* __restrict__ yexp, const float* __restrict__ m5) {
    float4 a[8], mm[8];
#pragma unroll
    for (int i = 0; i < 8; ++i) { a[i] = make_float4(0.f, 0.f, 0.f, 0.f); mm[i] = *(const float4*)(m5 + i * 256 + lane * 4); }
    const int4* ip = (const int4*)(inv + (size_t)tok * 16);
    const int4 q0 = ip[0], q1 = ip[1], q2 = ip[2], q3 = ip[3];
    const int rows[16] = {q0.x, q0.y, q0.z, q0.w, q1.x, q1.y, q1.z, q1.w, q2.x, q2.y, q2.z, q2.w, q3.x, q3.y, q3.z, q3.w};
    int prow = -1;
#pragma unroll
    for (int e = 0; e < 16; ++e) { const int row = __builtin_amdgcn_readfirstlane(rows[e]);
        if (row >= 0) { if (prow >= 0) { moe_pair(a, prow, row, 1.0f, lane, rowgate, yexp); prow = -1; } else prow = row; } }
    if (prow >= 0) moe_pair(a, prow, prow, 0.0f, lane, rowgate, yexp);
#pragma unroll
    for (int i = 0; i < 8; ++i) { v[i].x += mm[i].x * a[i].x; v[i].y += mm[i].y * a[i].y; v[i].z += mm[i].z * a[i].z; v[i].w += mm[i].w * a[i].w; }
}
struct CvU { const float* src; bf16_t* dst; int ldsrc, nvalid, k0, n0, lddst, mode; };
__device__ __forceinline__ void cv_load(const CvU& u, float4 (&r)[8], const int tid) {
#pragma unroll
    for (int i = 0; i < 8; ++i) { const int idx = tid + i * 512; const int k = idx >> 6, n = u.n0 + (idx & 63) * 4;
        r[i] = (n < u.nvalid) ? *(const float4*)(u.src + (size_t)(u.k0 + k) * u.ldsrc + n) : make_float4(0.f, 0.f, 0.f, 0.f); }
}
__device__ __forceinline__ void cv_stage(float* T, const float4 (&r)[8], const int tid) {
#pragma unroll
    for (int i = 0; i < 8; ++i) { const int idx = tid + i * 512; float* p = T + (idx >> 6) * 257 + (idx & 63) * 4; p[0] = r[i].x; p[1] = r[i].y; p[2] = r[i].z; p[3] = r[i].w; }
}
__device__ __forceinline__ void cv_store(const CvU& u, const float* T, const int tid) {
#pragma unroll
    for (int j = 0; j < 4; ++j) { const int o = tid + j * 512; const int kc = (o & 7) * 8, n = o >> 3; const int gn = u.n0 + n;
        const int drow = u.mode == 0 ? gn : (256 * (gn >> 7) + (u.mode == 2 ? 128 : 0) + (gn & 127));
        const float* t = T + kc * 257 + n;
        u32x4 w; w.x = pk2(t[0], t[257]); w.y = pk2(t[2 * 257], t[3 * 257]); w.z = pk2(t[4 * 257], t[5 * 257]); w.w = pk2(t[6 * 257], t[7 * 257]);
        *(u32x4*)(u.dst + (size_t)drow * u.lddst + u.k0 + kc) = w; }
}
template <int LAYER>
__device__ __forceinline__ void layer_body(const Args& a, const XcdBarrier& bar, const int lo, const int hi, const int bid, const int G, unsigned char* const shm, float* const sf, const float** const ptab) {
        constexpr int l = LAYER;
        constexpr int PB = 1 + 16 * l;
        const bool lastl = (l == 1);

        const int nPanels = lastl ? 64 : 68;
        const int M2 = nPanels * 256;

        if (IN(PB + 0)) for (int rep_ = 0; rep_ < (l == 0 ? PROBE_REPS(0) : 1); ++rep_) {
            PH_BEGIN
            {   const float* wbr = PT(40) + (size_t)l * 4 * BW * DM; const float* wout = PT(41) + (size_t)l * DM * DM;
                const float* wg = PT(43) + (size_t)l * NEXP * DM * DEXP; const float* wu = PT(44) + (size_t)l * NEXP * DM * DEXP; const float* wd = PT(45) + (size_t)l * NEXP * DEXP * DM;
                const float* wglu = PT(32) + (size_t)l * BW * BW; const float* win = w_in + (size_t)l * DM * IN_W;
                const int n_win = 32 * 55, n_br = 4 * 64, n_out = 32 * 8, n_gu = 16 * 2 * 192, n_d = 16 * 192, n_glu = 16;
                const int total = n_win + n_br + n_out + n_gu + n_d + n_glu;
#define CV_DECODE(q_, u_) do { int qq_ = (q_); \
                    if (qq_ < n_win) { u_ = CvU{win, WIN, IN_W, IN_W, (qq_ / 55) * 64, (qq_ % 55) * 256, DM, 0}; } else { qq_ -= n_win; \
                    if (qq_ < n_br) { const int k = qq_ >> 6, r = qq_ & 63; u_ = CvU{wbr + (size_t)k * BW * DM, WBR + (size_t)k * DM * BW, DM, DM, (r >> 3) * 64, (r & 7) * 256, BW, 0}; } else { qq_ -= n_br; \
                    if (qq_ < n_out) { u_ = CvU{wout, WOUT, DM, DM, (qq_ >> 3) * 64, (qq_ & 7) * 256, DM, 0}; } else { qq_ -= n_out; \
                    if (qq_ < n_gu) { const int e = qq_ / 384, r = qq_ % 384, up = r / 192, r2 = r % 192; u_ = CvU{(up ? wu : wg) + (size_t)e * DM * DEXP, WGU + (size_t)e * 2 * DEXP * DM, DEXP, DEXP, (r2 / 6) * 64, (r2 % 6) * 256, DM, 1 + up}; } else { qq_ -= n_gu; \
                    if (qq_ < n_d) { const int e = qq_ / 192, r = qq_ % 192; u_ = CvU{wd + (size_t)e * DEXP * DM, WD + (size_t)e * DM * DEXP, DM, DM, (r >> 3) * 64, (r & 7) * 256, DEXP, 0}; } else { qq_ -= n_d; \
                    u_ = CvU{wglu, GLU, BW, BW, (qq_ >> 1) * 64, (qq_ & 1) * 256, BW, 0}; } } } } } } while (0)
                __syncthreads();
                int q = bid; int buf = 0; CvU u; float4 r[8];
                if (q < total) { CV_DECODE(q, u); cv_load(u, r, tid); }
                while (q < total) {
                    float* T = sf + buf * (64 * 257);
                    cv_stage(T, r, tid);
                    __syncthreads();
                    const CvU cur = u; const int qn = q + G;
                    if (qn < total) { CV_DECODE(qn, u); cv_load(u, r, tid); }
                    cv_store(cur, T, tid);
                    buf ^= 1; q = qn;
                }
#undef CV_DECODE
                __syncthreads();
            }
            for (int set = 0; set < (lastl ? 1 : 2); ++set) {
                const int L = set ? CTXL : SEQ; float* HR = HRAW + (set ? (size_t)SEQ * 2048 : 0);
                const float* w1 = PT(11) + l * 33 * 64; const float* b1 = PT(12) + l * 64; const float* fr1 = PT(13) + l * 64; const float* w2 = PT(14) + l * 64 * 64; const float* b2 = PT(15) + l * 64;
                const float* fr2 = PT(16) + l * 64; const float* w3 = PT(17) + l * 64 * 2048; const float* decay = PT(18) + l * 2048;
                float* feats = sf; float* h1 = sf + 16 * 33; float* h2 = h1 + 16 * 64;
                float nacc[4] = {0.f, 0.f, 0.f, 0.f};
                for (int base = bid; base < L; base += 16 * G) {
                    __syncthreads();
                    for (int e = tid; e < 16 * 33; e += NTHR) { const int ti = e / 33, fi = e % 33; int t = base + ti * G; if (t > L - 1) t = L - 1;
                        float v;
                        if (fi == 0) v = (float)t / (float)(L - 1);
                        else { const int j = (fi - 1) & 15; const double fr = 1e-4 + (double)j * ((15.0 - 1e-4) / 15.0); const double ang = (2.0 * 3.14159265358979323846 / (double)L) * (double)t * fr; v = fi <= 16 ? (float)cos(ang) : (float)(-sin(ang)); }
                        feats[e] = v; }
                    __syncthreads();
                    { const int j = tid & 63, ti = tid >> 6; float s0 = b1[j], s1 = s0;
_Pragma("unroll 3")
                      for (int i = 0; i < 33; ++i) { const float wv = w1[i * 64 + j]; s0 += feats[ti * 33 + i] * wv; s1 += feats[(ti + 8) * 33 + i] * wv; }
                      const float f1 = fr1[j]; h1[ti * 64 + j] = sinf(f1 * s0); h1[(ti + 8) * 64 + j] = sinf(f1 * s1); }
                    __syncthreads();
                    { const int j = tid & 63, ti = tid >> 6; float s0 = b2[j], s1 = s0;
_Pragma("unroll 4")
                      for (int i = 0; i < 64; ++i) { const float wv = w2[i * 64 + j]; s0 += h1[ti * 64 + i] * wv; s1 += h1[(ti + 8) * 64 + i] * wv; }
                      const float f2 = fr2[j]; h2[ti * 64 + j] = sinf(f2 * s0); h2[(ti + 8) * 64 + j] = sinf(f2 * s1); }
                    __syncthreads();
                    float acc[16][4];
#pragma unroll
                    for (int ti = 0; ti < 16; ++ti) { acc[ti][0] = 0.f; acc[ti][1] = 0.f; acc[ti][2] = 0.f; acc[ti][3] = 0.f; }
#pragma unroll 2
                    for (int i = 0; i < 64; ++i) { const float* wrow = w3 + (size_t)i * 2048 + tid; const float wa = wrow[0], wb = wrow[512], wc2 = wrow[1024], wd2 = wrow[1536];
#pragma unroll
                        for (int ti = 0; ti < 16; ++ti) { const float hv = h2[ti * 64 + i]; acc[ti][0] += hv * wa; acc[ti][1] += hv * wb; acc[ti][2] += hv * wc2; acc[ti][3] += hv * wd2; } }
                    float dk[4];
#pragma unroll
                    for (int k = 0; k < 4; ++k) dk[k] = fabsf(decay[tid + k * 512]);
#pragma unroll
                    for (int ti = 0; ti < 16; ++ti) { const int t = base + ti * G; if (t < L) { const float tn = (float)t / (float)(L - 1);
#pragma unroll
                        for (int k = 0; k < 4; ++k) { const float v = acc[ti][k] * expf(-tn * dk[k]); HR[(size_t)t * 2048 + tid + k * 512] = v; nacc[k] += fabsf(v); } } }
                }
                float* nrp = NORMP + ((size_t)(l * 2 + set) * 256 + bid) * 2048;
#pragma unroll
                for (int k = 0; k < 4; ++k) nrp[tid + k * 512] = nacc[k];
            }
            for (int idx = bid * NTHR + tid; idx < 4096; idx += G * NTHR) { const int n = idx & 63, g = (idx >> 6) & 31, dir = idx >> 11;
                const double are = (double)(PT(24) + l * 4096)[idx], aim = (double)(PT(25) + l * 4096)[idx]; const double lam = are < -1e-4 ? are : -1e-4; const double dt = exp((double)(PT(26) + l * 64)[dir * 32 + g]);
                const double ldre = lam * dt, ldim = aim * dt; LDT[idx] = make_double2(ldre, ldim);
                const double mag = exp(ldre); const double ar = mag * cos(ldim), ai = mag * sin(ldim);
                const double den = lam * lam + aim * aim; const double nr = ar - 1.0, ni = ai; const double fre = (nr * lam + ni * aim) / den, fim = (ni * lam - nr * aim) / den;
                const float* b_re = PT(27) + l * 32 * 64 * 16; const float* b_im = PT(28) + l * 32 * 64 * 16;
#pragma unroll 4
                for (int c = 0; c < 16; ++c) { const double br = (double)b_re[(g * 64 + n) * 16 + c], bi = (double)b_im[(g * 64 + n) * 16 + c]; BBT[idx * 16 + c] = make_float2((float)(fre * br - fim * bi), (float)(fre * bi + fim * br)); }
            }
            for (int e2 = bid * NTHR + tid; e2 < 4096 * 33; e2 += G * NTHR) { const int idx = e2 / 33, k = e2 - idx * 33; const int g = (idx >> 6) & 31, dir = idx >> 11;
                const double are = (double)(PT(24) + l * 4096)[idx], aim = (double)(PT(25) + l * 4096)[idx]; const double lam = are < -1e-4 ? are : -1e-4; const double dt = exp((double)(PT(26) + l * 64)[dir * 32 + g]);
                const double ldre = lam * dt, ldim = aim * dt; const double mk = exp(ldre * k); APW[e2] = make_float2((float)(mk * cos(ldim * k)), (float)(mk * sin(ldim * k))); }
            if (l == 0 && lo == 0) xcd_barrier(bar);
            for (int tok = bid * 8 + wave; tok < NTOK; tok += G * 8) {
                const int r = tok < NLAT ? tok / SEQ : 4; const float* xr = l == 0 ? (tok < NLAT ? x_in + (size_t)tok * DM : ctx_in + (size_t)(tok - NLAT) * DM) : XS + (size_t)tok * DM; const float* gn = norm_mix + l * DM;
                const float* sh = MODl + (size_t)(r * 6 + 0) * DM; const float* sc = MODl + (size_t)(r * 6 + 1) * DM;
                float4 v[8]; float ss = 0.f;
#pragma unroll
                for (int i = 0; i < 8; ++i) v[i] = *(const float4*)(xr + i * 256 + lane * 4);
                if (l > 0) {
                    moe_combine(v, tok, lane, INV, ROWGATE, YEXP, MOD + (size_t)((l - 1) * 5 + r) * 6 * DM + 5 * DM);
#pragma unroll
                    for (int i = 0; i < 8; ++i) *(float4*)(XS + (size_t)tok * DM + i * 256 + lane * 4) = v[i]; }
#pragma unroll
                for (int i = 0; i < 8; ++i) ss += v[i].x * v[i].x + v[i].y * v[i].y + v[i].z * v[i].z + v[i].w * v[i].w;
                ss = wave_sum(ss); const float rs = rsqrtf(ss * (1.0f / DM) + 1e-6f);
#pragma unroll
                for (int i = 0; i < 8; ++i) { const int d = i * 256 + lane * 4; const float4 g4 = *(const float4*)(gn + d), s4 = *(const float4*)(sc + d), h4 = *(const float4*)(sh + d);
                    v[i].x = v[i].x * rs * g4.x * (1.f + s4.x) + h4.x; v[i].y = v[i].y * rs * g4.y * (1.f + s4.y) + h4.y; v[i].z = v[i].z * rs * g4.z * (1.f + s4.z) + h4.z; v[i].w = v[i].w * rs * g4.w * (1.f + s4.w) + h4.w; }
#pragma unroll
                for (int i = 0; i < 8; ++i) { u32x2 w; w.x = pk2(v[i].x, v[i].y); w.y = pk2(v[i].z, v[i].w); *(u32x2*)(HB + (size_t)tok * DM + i * 256 + lane * 4) = w; }
            }
            SEAM(PB + 0);
        }

        if (IN(PB + 1)) for (int rep_ = 0; rep_ < PROBE_REPS(1); ++rep_) {
            PH_BEGIN
            for (int base = bid * 8; base < (lastl ? 1 : 2) * 1024; base += G * 8) {
                const int idx = base + (tid & 7), sl = tid >> 3; const int set = idx >> 10, oc = idx & 1023, o = oc >> 9, c = oc & 511;
                const float* pp = NORMP + (size_t)(l * 2 + set) * 256 * 2048 + o * 1024 + c + (size_t)(sl * 4) * 2048; float sacc = 0.f;
#pragma unroll
                for (int j = 0; j < 4; ++j) { const float p0 = pp[(size_t)j * 2048], p1 = pp[(size_t)j * 2048 + 512]; sacc += (sl * 4 + j < G) ? p0 + p1 : 0.f; }
                sf[sl * 8 + (tid & 7)] = sacc; __syncthreads();
                if (tid < 8) { float t = 0.f;
#pragma unroll 8
                    for (int q = 0; q < 64; ++q) t += sf[q * 8 + tid];
                    NORM[(size_t)(l * 2 + set) * 1024 + oc] = t; }
                __syncthreads(); }
            for (int idx = (G - 1 - bid) * NTHR + tid; idx < 32768; idx += G * NTHR) { const int c = idx & 15, lag = (idx >> 4) & 31, dir = (idx >> 9) & 1, g = idx >> 10;
                const float* c_re = PT(29) + l * 32 * 16 * 64 + (g * 16 + c) * 64; const float* c_im = PT(30) + l * 32 * 16 * 64 + (g * 16 + c) * 64;
                float acc[16];
#pragma unroll
                for (int j = 0; j < 16; ++j) acc[j] = 0.f;
#pragma unroll 2
                for (int n = 0; n < 64; ++n) { const int pi = (dir * 32 + g) * 64 + n; const float2 ap = APW[pi * 33 + lag]; const float cr = c_re[n], ci = c_im[n]; const float wr_ = cr * ap.x - ci * ap.y, wi_ = cr * ap.y + ci * ap.x;
                    const float4* bb = (const float4*)(BBT + pi * 16);
#pragma unroll
                    for (int j = 0; j < 8; ++j) { const float4 b2 = bb[j]; acc[2 * j] += wr_ * b2.x - wi_ * b2.y; acc[2 * j + 1] += wr_ * b2.z - wi_ * b2.w; } }
                float4* o = (float4*)(KTB + (size_t)idx * 16);
                o[0] = make_float4(acc[0], acc[1], acc[2], acc[3]); o[1] = make_float4(acc[4], acc[5], acc[6], acc[7]); o[2] = make_float4(acc[8], acc[9], acc[10], acc[11]); o[3] = make_float4(acc[12], acc[13], acc[14], acc[15]);
            }
            __syncthreads();
            pg8::Gemm g{HB, WIN, DM, DM, DM}; pg8::SchedStd S{68, 55, G, bid, DM, DM}; pg8::EpiWin E{P, LDP};
            pg8::gemm_phase(( LAS unsigned char*)shm, g, S, E);
#if defined(PROBE_BNOEPI)
            { __syncthreads(); pg8::EpiNone E0; pg8::gemm_phase((LAS unsigned char*)shm, g, S, E0); }
#endif
            SEAM(PB + 1);
        }

        if (IN(PB + 2)) for (int rep_ = 0; rep_ < PROBE_REPS(2); ++rep_) {
            PH_BEGIN
            const float* hcw = PT(9) + l * 3 * 1536; const float* hcb = PT(10) + l * 1536; const float* mcw = PT(20) + l * 3 * 1024; const float* mcb = PT(21) + l * 1024;
            const float* scw = PT(34) + l * 3 * 1024; const float* scb = PT(35) + l * 1024;
            for (int unit = bid; unit < 272 * 3; unit += G) { const int seg = unit / 3, kind = unit % 3; const bool lat = seg < 256; const size_t tok0 = lat ? (size_t)seg * 64 : (size_t)NLAT + (size_t)(seg - 256) * 64;
                if (kind < 2) { const int hf = kind;
                    const int c = tid * 2; const int col = (hf ? SSD_OFF + 512 : ML_OFF) + c; const float* w = hf ? scw : mcw; const float* bsp = hf ? scb : mcb; bf16_t* dst = (hf ? XBC : QKB) + tok0 * 1024 + c;
                    const float2 w0 = *(const float2*)(w + c), w1 = *(const float2*)(w + 1024 + c), w2 = *(const float2*)(w + 2048 + c), bb = *(const float2*)(bsp + c);
                    const float osc = (!hf && c >= 512) ? 0.08838834764831845f : 1.0f;
                    const bool hasPrev = !lat && ((tok0 - NLAT) & (CTXL - 1)) != 0, hasNext = !lat && (((tok0 - NLAT) + 63) & (CTXL - 1)) != CTXL - 1;
                    bf16_t* strip = nullptr;
                    if (!hf) { if (c >= 512) strip = KTG + ((size_t)seg * 512 + (c - 512)) * 64; }
                    else { if (c < 512) strip = XTG + ((size_t)seg * 512 + c) * 64; else if (c < 768) strip = BTG + ((size_t)seg * 256 + (c - 512)) * 64; }
                    const bf16_t* pp = P + tok0 * LDP + col;
                    unsigned raw[66];
#pragma unroll
                    for (int t = 0; t < 66; ++t) raw[t] = ((t == 0 && !hasPrev) || (t == 65 && !hasNext)) ? 0u : *(const unsigned*)(pp + (ptrdiff_t)(t - 1) * LDP);
#pragma unroll
                    for (int t8 = 0; t8 < 8; ++t8) { float v0[8], v1[8];
#pragma unroll
                        for (int tt = 0; tt < 8; ++tt) { const int t = t8 * 8 + tt; const unsigned p0 = raw[t], p1 = raw[t + 1], p2 = raw[t + 2];
                            float a0 = bb.x + w0.x * __uint_as_float(p0 << 16) + w1.x * __uint_as_float(p1 << 16) + w2.x * __uint_as_float(p2 << 16);
                            float a1 = bb.y + w0.y * __uint_as_float(p0 & 0xFFFF0000u) + w1.y * __uint_as_float(p1 & 0xFFFF0000u) + w2.y * __uint_as_float(p2 & 0xFFFF0000u);
                            a0 = siluf_(a0) * osc; a1 = siluf_(a1) * osc; v0[tt] = a0; v1[tt] = a1;
                            *(unsigned*)(dst + (size_t)t * 1024) = pk2(a0, a1); }
                        if (strip) { u32x4 s0, s1; s0.x = pk2(v0[0], v0[1]); s0.y = pk2(v0[2], v0[3]); s0.z = pk2(v0[4], v0[5]); s0.w = pk2(v0[6], v0[7]); s1.x = pk2(v1[0], v1[1]); s1.y = pk2(v1[2], v1[3]); s1.z = pk2(v1[4], v1[5]); s1.w = pk2(v1[6], v1[7]);
                            *(u32x4*)(strip + t8 * 8) = s0; *(u32x4*)(strip + 64 + t8 * 8) = s1; } }
                } else {
                    const int c = (tid & 255) * 2, th = tid >> 8; const bf16_t* pp = P + (tok0 + th * 32) * LDP + ML_OFF + 1024 + c; bf16_t* strip = VTG + ((size_t)seg * 512 + c) * 64 + th * 32;
                    unsigned rv[32];
#pragma unroll
                    for (int t = 0; t < 32; ++t) rv[t] = *(const unsigned*)(pp + (size_t)t * LDP);
#pragma unroll
                    for (int t8 = 0; t8 < 4; ++t8) { u32x4 s0, s1;
                        s0.x = (rv[t8 * 8 + 0] & 0xFFFFu) | (rv[t8 * 8 + 1] << 16); s0.y = (rv[t8 * 8 + 2] & 0xFFFFu) | (rv[t8 * 8 + 3] << 16); s0.z = (rv[t8 * 8 + 4] & 0xFFFFu) | (rv[t8 * 8 + 5] << 16); s0.w = (rv[t8 * 8 + 6] & 0xFFFFu) | (rv[t8 * 8 + 7] << 16);
                        s1.x = (rv[t8 * 8 + 0] >> 16) | (rv[t8 * 8 + 1] & 0xFFFF0000u); s1.y = (rv[t8 * 8 + 2] >> 16) | (rv[t8 * 8 + 3] & 0xFFFF0000u); s1.z = (rv[t8 * 8 + 4] >> 16) | (rv[t8 * 8 + 5] & 0xFFFF0000u); s1.w = (rv[t8 * 8 + 6] >> 16) | (rv[t8 * 8 + 7] & 0xFFFF0000u);
                        *(u32x4*)(strip + t8 * 8) = s0; *(u32x4*)(strip + 64 + t8 * 8) = s1; }
                }
            }
            if (!lastl) for (int tok = NLAT + bid; tok < NTOK; tok += G) {
                const int t = (tok - NLAT) & (CTXL - 1); const bool hasL = (t != 0), hasR = (t != CTXL - 1); const bf16_t* pr = P + (size_t)tok * LDP;
                const bf16_t* prL = hasL ? pr - LDP : pr; const bf16_t* prR = hasR ? pr + LDP : pr;
                unsigned xc[3], xl[3], xr[3];
#pragma unroll
                for (int j = 0; j < 3; ++j) { const int cc = tid + j * 512; xc[j] = pr[HY_OFF + cc]; xl[j] = prL[HY_OFF + cc]; xr[j] = prR[HY_OFF + cc]; }
#pragma unroll
                for (int j = 0; j < 3; ++j) { const int cc = tid + j * 512;
                    float acc = hcb[cc] + hcw[1536 + cc] * __uint_as_float(xc[j] << 16);
                    acc += hasL ? hcw[cc] * __uint_as_float(xl[j] << 16) : 0.f;
                    acc += hasR ? hcw[2 * 1536 + cc] * __uint_as_float(xr[j] << 16) : 0.f;
                    U[(size_t)tok * 1536 + cc] = acc; }
            }
            for (int idx0 = bid * NTHR + tid; idx0 < 16384 * 64; idx0 += 4 * G * NTHR) { u32x4 t4[4];
#pragma unroll
                for (int q = 0; q < 4; ++q) { const int idx = idx0 + q * G * NTHR; const int half = idx & 1, g = (idx >> 1) & 31, tok = idx >> 6;
                    if (idx < 16384 * 64) t4[q] = *(const u32x4*)(P + (size_t)tok * LDP + S5_OFF + g * 16 + half * 8); }
#pragma unroll
                for (int q = 0; q < 4; ++q) { const int idx = idx0 + q * G * NTHR; const int half = idx & 1, g = (idx >> 1) & 31, tok = idx >> 6;
                    if (idx < 16384 * 64) *(u32x4*)(S5A + ((size_t)g * 512 + (tok >> 5)) * 768 + (tok & 31) * 16 + half * 8) = t4[q]; } }
            for (int idx = bid * NTHR + tid; idx < 32 * 512 * 32 * 2; idx += G * NTHR) { const int half = idx & 1, sI = (idx >> 1) & 31, row = (idx >> 6) & 511, g = idx >> 15; const int t = row >> 4, c = row & 15; const int lag = t - sI;
                float v[8];
                if (lag > 0) { const float4* k4 = (const float4*)(KTB + ((size_t)((g * 2 + 0) * 32 + lag) * 16 + c) * 16 + half * 8); const float4 a0 = k4[0], a1 = k4[1]; v[0] = a0.x; v[1] = a0.y; v[2] = a0.z; v[3] = a0.w; v[4] = a1.x; v[5] = a1.y; v[6] = a1.z; v[7] = a1.w; }
                else if (lag < 0) { const float4* k4 = (const float4*)(KTB + ((size_t)((g * 2 + 1) * 32 - lag) * 16 + c) * 16 + half * 8); const float4 a0 = k4[0], a1 = k4[1]; v[0] = a0.x; v[1] = a0.y; v[2] = a0.z; v[3] = a0.w; v[4] = a1.x; v[5] = a1.y; v[6] = a1.z; v[7] = a1.w; }
                else { const float4* k4 = (const float4*)(KTB + ((size_t)((g * 2 + 0) * 32) * 16 + c) * 16 + half * 8); const float4* q4 = (const float4*)(KTB + ((size_t)((g * 2 + 1) * 32) * 16 + c) * 16 + half * 8); const float4 a0 = k4[0], a1 = k4[1], b0 = q4[0], b1 = q4[1];
                    v[0] = a0.x + b0.x; v[1] = a0.y + b0.y; v[2] = a0.z + b0.z; v[3] = a0.w + b0.w; v[4] = a1.x + b1.x; v[5] = a1.y + b1.y; v[6] = a1.z + b1.z; v[7] = a1.w + b1.w; }
                u32x4 w; w.x = pk2(v[0], v[1]); w.y = pk2(v[2], v[3]); w.z = pk2(v[4], v[5]); w.w = pk2(v[6], v[7]);
                *(u32x4*)(S5B + ((size_t)g * 512 + row) * 768 + sI * 16 + half * 8) = w; }
            for (int idx = bid * NTHR + tid; idx < 32 * 512 * 64; idx += G * NTHR) { const int n = idx & 63, row = (idx >> 6) & 511, g = idx >> 15; const int t = row >> 4, c = row & 15;
                const float cr = (PT(29) + l * 32 * 16 * 64)[(g * 16 + c) * 64 + n], ci = (PT(30) + l * 32 * 16 * 64)[(g * 16 + c) * 64 + n];
                const float2 af = APW[((0 * 32 + g) * 64 + n) * 33 + t + 1], ab = APW[((1 * 32 + g) * 64 + n) * 33 + 32 - t];
                bf16_t* d = S5B + ((size_t)g * 512 + row) * 768 + 512 + 2 * n;
                *(unsigned*)d = pk2(cr * af.x - ci * af.y, -(cr * af.y + ci * af.x)); *(unsigned*)(d + 128) = pk2(cr * ab.x - ci * ab.y, -(cr * ab.y + ci * ab.x)); }
            for (int idx = bid * NTHR + tid; idx < 32 * 2 * 64 * 32; idx += G * NTHR) { const int sI = idx & 31, n = (idx >> 5) & 63, dir = (idx >> 11) & 1, g = idx >> 12; const int pi = (dir * 32 + g) * 64 + n;
                const float2 pw = APW[pi * 33 + (dir ? sI : 31 - sI)]; const float4* bb = (const float4*)(BBT + pi * 16);
                float re[16], im[16];
#pragma unroll
                for (int j = 0; j < 8; ++j) { const float4 b2 = bb[j]; re[2 * j] = pw.x * b2.x - pw.y * b2.y; im[2 * j] = pw.x * b2.y + pw.y * b2.x; re[2 * j + 1] = pw.x * b2.z - pw.y * b2.w; im[2 * j + 1] = pw.x * b2.w + pw.y * b2.z; }
                bf16_t* d = S5P + ((size_t)g * 256 + dir * 128 + 2 * n) * 512 + sI * 16;
                u32x4 w0, w1; w0.x = pk2(re[0], re[1]); w0.y = pk2(re[2], re[3]); w0.z = pk2(re[4], re[5]); w0.w = pk2(re[6], re[7]); w1.x = pk2(re[8], re[9]); w1.y = pk2(re[10], re[11]); w1.z = pk2(re[12], re[13]); w1.w = pk2(re[14], re[15]);
                *(u32x4*)d = w0; *(u32x4*)(d + 8) = w1;
                w0.x = pk2(im[0], im[1]); w0.y = pk2(im[2], im[3]); w0.z = pk2(im[4], im[5]); w0.w = pk2(im[6], im[7]); w1.x = pk2(im[8], im[9]); w1.y = pk2(im[10], im[11]); w1.z = pk2(im[12], im[13]); w1.w = pk2(im[14], im[15]);
                *(u32x4*)(d + 512) = w0; *(u32x4*)(d + 520) = w1; }
            {   float* T = sf;
                for (int unit = bid; unit < 4 * 64 * 24; unit += G) { const int b = unit / (64 * 24), r = (unit / 24) % 64, c0 = (unit % 24) * 64; const size_t tok0 = (size_t)b * SEQ + r * 64;
                    __syncthreads();
#pragma unroll
                    for (int i = 0; i < 8; ++i) { const int c = tid & 63, t = (tid >> 6) + 8 * i; T[t * 65 + c] = bf2f(P[(tok0 + t) * LDP + HY_OFF + c0 + c]); }
                    __syncthreads();
                    const int c = tid >> 3, tq = (tid & 7) * 8, cc = c0 + c; const float w0 = hcw[cc], w1 = hcw[1536 + cc], w2 = hcw[3072 + cc], bb = hcb[cc];
                    float o8[8];
#pragma unroll
                    for (int i = 0; i < 8; ++i) { const int t = tq + i; float acc = bb + w1 * T[t * 65 + c]; if (t > 0) acc += w0 * T[(t - 1) * 65 + c]; if (t < 63) acc += w2 * T[(t + 1) * 65 + c]; o8[i] = acc; }
                    float* dst = UT + ((size_t)b * 1536 + cc) * SEQ + r * 64 + tq;
                    *(float4*)dst = make_float4(o8[0], o8[1], o8[2], o8[3]); *(float4*)(dst + 4) = make_float4(o8[4], o8[5], o8[6], o8[7]);
                } }
            if (!lastl) {
                const int L = CTXL; const float* HR = HRAW + (size_t)SEQ * 2048; float* K2 = K2C; const float* nrm = NORM + (size_t)(l * 2 + 1) * 1024;
                const size_t total = (size_t)(2 * L - 1) * 1024;
                for (size_t i = (size_t)bid * NTHR + tid; i < total; i += (size_t)G * NTHR) { const int j = (int)(i >> 10), oc = (int)(i & 1023), o = oc >> 9, c = oc & 511; const int lag = j - (L - 1);
                    const float v = lag >= 0 ? HR[(size_t)lag * 2048 + o * 1024 + c] : HR[(size_t)(-lag) * 2048 + o * 1024 + 512 + c];
                    K2[((size_t)j * 2 + o) * 512 + c] = v / nrm[oc]; }
            }
            {   __syncthreads(); fft_twiddles((float2*)(shm + FFT_X_BYTES), tid);
                for (int oc = bid; oc < 1024; oc += G) hyena_spec_item(oc, HRAW, NORM + (size_t)(l * 2 + 0) * 1024, HSPEC, shm, tid);
                __syncthreads(); }
            SEAM(PB + 2);
        }

        if (IN(PB + 3)) for (int rep_ = 0; rep_ < PROBE_REPS(3); ++rep_) {
            PH_BEGIN
            if (rep_ > 0) { if (bid == 0 && tid == 0) __hip_atomic_store(QCTR + l * 64, 0, __ATOMIC_RELAXED, __HIP_MEMORY_SCOPE_AGENT); xcd_barrier(bar); }
            if (bid < 64) {
                mlstm_state_pass(bid >> 1, bid & 1, P, KTG, VTG, PT(22) + l * 16, CST, NST, MST, shm, tid);
            } else if (bid < 128) {
                { const int ch = bid - 64; const int dir_ = ch & 1, h_ = (ch >> 1) & 7; ssd_state_pass(ch, P, BTG, XTG, -expf(PT(37)[l * 16 + dir_ * 8 + h_]), PT(36)[l * 16 + dir_ * 8 + h_], SSTB, shm, tid); }
            } else if (bid < 160) {
                const int widx = (bid - 128) * 8 + wave; const int dir = widx & 1, g = (widx >> 1) & 31, b = widx >> 6; const int n = lane;
                float2* xb = (float2*)(shm + (size_t)wave * 16640); float2* ctab = xb + 16 * 65;
                const float* a_re = PT(24) + l * 2 * 32 * 64; const float* a_im = PT(25) + l * 2 * 32 * 64; const float* log_dt = PT(26) + l * 64;
                const float* b_re = PT(27) + l * 32 * 64 * 16; const float* b_im = PT(28) + l * 32 * 64 * 16; const float* c_re = PT(29) + l * 32 * 16 * 64; const float* c_im = PT(30) + l * 32 * 16 * 64;
#pragma unroll
                for (int c = 0; c < 16; ++c) ctab[c * 65 + lane] = make_float2(c_re[(g * 16 + c) * 64 + lane], c_im[(g * 16 + c) * 64 + lane]);
                float abr, abi, bbr[16], bbi[16];
                {   const double are = (double)a_re[(dir * 32 + g) * 64 + n], aim = (double)a_im[(dir * 32 + g) * 64 + n];
                    const double lam = are < -1e-4 ? are : -1e-4; const double dt = exp((double)log_dt[dir * 32 + g]);
                    const double mag = exp(lam * dt); const double ar = mag * cos(aim * dt), ai = mag * sin(aim * dt);
                    const double den = lam * lam + aim * aim; const double nr = ar - 1.0, ni = ai;
                    const double fre = (nr * lam + ni * aim) / den, fim = (ni * lam - nr * aim) / den;
                    abr = (float)ar; abi = (float)ai;
#pragma unroll
                    for (int c = 0; c < 16; ++c) { const double br = (double)b_re[(g * 64 + n) * 16 + c], bi = (double)b_im[(g * 64 + n) * 16 + c]; bbr[c] = (float)(fre * br - fim * bi); bbi[c] = (float)(fre * bi + fim * br); }
                }
                float xr = 0.f, xi = 0.f; float* Sout = (dir ? SB : SF) - (size_t)NLAT * BW;
                const int s = lane >> 2, cg = lane & 3;
                for (int i0 = 0; i0 < CTXL; i0 += 16) {
#pragma unroll 4
                    for (int ss = 0; ss < 16; ++ss) {
                        const size_t tok = (size_t)step_tok(b, dir, i0 + ss);
                        const u32x4* up = (const u32x4*)(P + tok * LDP + S5_OFF + g * 16);
                        float t0[8], t1[8]; unpack8(up[0], t0); unpack8(up[1], t1);
                        float bur = 0.f, bui = 0.f;
#pragma unroll
                        for (int c = 0; c < 8; ++c) { bur += t0[c] * bbr[c] + t1[c] * bbr[8 + c]; bui += t0[c] * bbi[c] + t1[c] * bbi[8 + c]; }
                        const float nxr = abr * xr - abi * xi + bur, nxi = abr * xi + abi * xr + bui; xr = nxr; xi = nxi;
                        xb[ss * 65 + lane] = make_float2(xr, xi);
                    }
                    asm volatile("s_waitcnt lgkmcnt(0)" ::: "memory");
                    float y0 = 0.f, y1 = 0.f, y2 = 0.f, y3 = 0.f;
                    for (int nn2 = 0; nn2 < 64; ++nn2) { const float2 xv = xb[s * 65 + nn2];
                        const float2 c0 = ctab[(cg * 4 + 0) * 65 + nn2], c1 = ctab[(cg * 4 + 1) * 65 + nn2], c2 = ctab[(cg * 4 + 2) * 65 + nn2], c3 = ctab[(cg * 4 + 3) * 65 + nn2];
                        y0 += xv.x * c0.x - xv.y * c0.y; y1 += xv.x * c1.x - xv.y * c1.y; y2 += xv.x * c2.x - xv.y * c2.y; y3 += xv.x * c3.x - xv.y * c3.y; }
                    const size_t toks = (size_t)step_tok(b, dir, i0 + s);
                    *(float4*)(Sout + toks * BW + g * 16 + cg * 4) = make_float4(y0, y1, y2, y3);
                    asm volatile("s_waitcnt lgkmcnt(0)" ::: "memory");
                }
                XCTX[((b * 32 + g) * 2 + dir) * 64 + n] = make_float2(xr, xi);
            } else {
                if (bid < 224) {
                    pg8::Gemm gg_{S5A, S5P, 768, 512, 512}; pg8::SchedS5a S_{bid - 160}; pg8::EpiXloc E_{XLOC};
                    pg8::gemm_phase((LAS unsigned char*)shm, gg_, S_, E_);
                    __syncthreads();
                }
                const int nhb = G - 160, hb = bid - 160; const float* bias = PT(19) + l * 1024; const int c = tid;
                const int nitems = lastl ? 0 : 4 * (CTXL / 8);
                for (int it = hb; it < nitems; it += nhb) {
                    int L, tokbase, b, t0; const float* K2;
                    { const int q = it; L = CTXL; tokbase = NLAT; b = q / (CTXL / 8); t0 = (q % (CTXL / 8)) * 8; K2 = K2C; }
                    const float* zb = U + (size_t)(tokbase + b * L) * 1536 + c;
                    float acc[8];
#pragma unroll
                    for (int i = 0; i < 8; ++i) acc[i] = 0.f;
                    const int base = t0 + L - 1;
                    for (int s = 0; s < L; s += 8) {
                        float k[15];
#pragma unroll
                        for (int mm = 0; mm < 15; ++mm) k[mm] = K2[((size_t)(base - s - 7 + mm) * 2 + 0) * 512 + c];
#pragma unroll
                        for (int ds = 0; ds < 8; ++ds) { const float z = zb[(size_t)(s + ds) * 1536];
#pragma unroll
                            for (int i = 0; i < 8; ++i) acc[i] += k[i - ds + 7] * z; }
                    }
#pragma unroll
                    for (int i = 0; i < 8; ++i) { const size_t tok = (size_t)(tokbase + b * L + t0 + i); const float zt = U[tok * 1536 + c]; Z[tok * BW + c] = (acc[i] + bias[c] * zt) * U[tok * 1536 + 512 + c]; }
                }
            }
            {   __syncthreads(); fft_twiddles((float2*)(shm + FFT_X_BYTES), tid);
                int* qslot = (int*)(shm + FFT_X_BYTES + 65536);
                for (;;) { __syncthreads(); if (tid == 0) *qslot = atomicAdd(QCTR + l * 64, 1); __syncthreads(); const int it = *qslot; if (it >= 1024) break;
                    hyena_fft_item(it, UT, HSPEC, PT(19) + l * 1024, YT, shm, tid); }
            }
            SEAM(PB + 3);
        }

        if (IN(PB + 4)) for (int rep_ = 0; rep_ < PROBE_REPS(4); ++rep_) {
            PH_BEGIN
            if (rep_ > 0) { if (bid == 0 && tid == 0) __hip_atomic_store(QCTR + l * 64 + 32, 0, __ATOMIC_RELAXED, __HIP_MEMORY_SCOPE_AGENT); xcd_barrier(bar); }
            if (bid >= G - 32) for (int idx = (bid - (G - 32)) * NTHR + tid; idx < 16384; idx += 32 * NTHR) { const int n = idx & 63, dir = (idx >> 6) & 1, b = (idx >> 7) & 3, g = idx >> 9;
                const float2 a32 = APW[((dir * 32 + g) * 64 + n) * 33 + 32]; float2 X = XCTX[((b * 32 + g) * 2 + dir) * 64 + n];
                const float* __restrict__ xl = XLOC + ((size_t)g * 512 + b * 128) * 256 + dir * 128 + 2 * n; bf16_t* __restrict__ dst = S5A + ((size_t)g * 512 + b * 128) * 768 + 512 + dir * 128 + 2 * n;
#pragma unroll 1
                for (int j0 = 0; j0 < 128; j0 += 16) { float2 xv[16];
#pragma unroll
                    for (int q = 0; q < 16; ++q) { const int j = dir ? 127 - (j0 + q) : j0 + q; xv[q] = *(const float2*)(xl + (size_t)j * 256); }
#pragma unroll
                    for (int q = 0; q < 16; ++q) { const int j = dir ? 127 - (j0 + q) : j0 + q;
                        *(unsigned*)(dst + (size_t)j * 768) = pk2(X.x, X.y);
                        const float nx = a32.x * X.x - a32.y * X.y + xv[q].x, ny = a32.x * X.y + a32.y * X.x + xv[q].y; X.x = nx; X.y = ny; } } }
            {   int* qslot = (int*)(shm + 102400);
                for (;;) { __syncthreads(); if (tid == 0) *qslot = atomicAdd(QCTR + l * 64 + 32, 1); __syncthreads(); const int it = *qslot; if (it >= 32 * 68 + 64 * 68) break;
                    if (it < 32 * 68) { const int chain = it / 68, c = it % 68; mlstm_out_item(chain, c, P, QKB, VTG, PT(22) + l * 16, CST, NST, MST, (chain & 1) ? HBk : HF, shm, tid); }
                    else { const int i2 = it - 32 * 68; const int chain = i2 / 68, c = i2 % 68; const int dir_ = chain & 1, h_ = (chain >> 1) & 7;
                        ssd_out_item(chain, c, P, XBC, XTG, -expf(PT(37)[l * 16 + dir_ * 8 + h_]), PT(36)[l * 16 + dir_ * 8 + h_], SSTB, dir_ ? YB : YF, shm, tid); } }
            }
            __syncthreads();
            {   const float* bias = PT(19) + l * 1024 + 512; const int c = tid;
                const int nitems = lastl ? 0 : 4 * (CTXL / 8);
                for (int it = bid; it < nitems; it += G) {
                    int L, tokbase, b, t0; const float* K2;
                    { const int q = it; L = CTXL; tokbase = NLAT; b = q / (CTXL / 8); t0 = (q % (CTXL / 8)) * 8; K2 = K2C; }
                    const float* zb = Z + (size_t)(tokbase + b * L) * BW + c;
                    float acc[8];
#pragma unroll
                    for (int i = 0; i < 8; ++i) acc[i] = 0.f;
                    const int base = t0 + L - 1;
                    for (int s = 0; s < L; s += 8) {
                        float k[15];
#pragma unroll
                        for (int mm = 0; mm < 15; ++mm) k[mm] = K2[((size_t)(base - s - 7 + mm) * 2 + 1) * 512 + c];
#pragma unroll
                        for (int ds = 0; ds < 8; ++ds) { const float z = zb[(size_t)(s + ds) * BW];
#pragma unroll
                            for (int i = 0; i < 8; ++i) acc[i] += k[i - ds + 7] * z; }
                    }
#pragma unroll
                    for (int i = 0; i < 8; ++i) { const size_t tok = (size_t)(tokbase + b * L + t0 + i); const float zt = Z[tok * BW + c]; Y4[tok * DM + c] = f2bf((acc[i] + bias[c] * zt) * U[tok * 1536 + 1024 + c]); }
                }
            }
            SEAM(PB + 4);
        }

        if (IN(PB + 5)) for (int rep_ = 0; rep_ < PROBE_REPS(5); ++rep_) {
            PH_BEGIN
            const float* ml_norm = PT(23) + l * BW; const float* ssd_d = PT(38) + l * 8; const float* ssd_norm = PT(39) + l * BW; const float* s5_d = PT(31) + l * BW;
            if (bid < 128) {
                pg8::Gemm gg_{S5A, S5B, 768, 768, 768}; pg8::SchedS5b S_{bid}; pg8::EpiS5Out E_{P, s5_d, GG};
                pg8::gemm_phase((LAS unsigned char*)shm, gg_, S_, E_);
                __syncthreads();
            }
            for (int tok = bid * 8 + wave; tok < NTOK; tok += G * 8) {
                const int c0 = lane * 8; const bf16_t* pr = P + (size_t)tok * LDP; const size_t o5 = (size_t)tok * BW + c0;
                float hm[8], ys[8];
                const u32x4 ooq = *(const u32x4*)(pr + ML_OFF + 1536 + c0);
                const float4 g0 = *(const float4*)(ml_norm + c0), g1 = *(const float4*)(ml_norm + c0 + 4), n0 = *(const float4*)(ssd_norm + c0), n1 = *(const float4*)(ssd_norm + c0 + 4);
                { const float4 a0 = *(const float4*)(HF + o5), a1 = *(const float4*)(HF + o5 + 4), b0 = *(const float4*)(HBk + o5), b1 = *(const float4*)(HBk + o5 + 4);
                  hm[0] = a0.x + b0.x; hm[1] = a0.y + b0.y; hm[2] = a0.z + b0.z; hm[3] = a0.w + b0.w; hm[4] = a1.x + b1.x; hm[5] = a1.y + b1.y; hm[6] = a1.z + b1.z; hm[7] = a1.w + b1.w; }
                { const float4 a0 = *(const float4*)(YF + o5), a1 = *(const float4*)(YF + o5 + 4), b0 = *(const float4*)(YB + o5), b1 = *(const float4*)(YB + o5 + 4);
                  float xx[8], zz[8]; unpack8(*(const u32x4*)(XBC + (size_t)tok * 1024 + c0), xx); unpack8(*(const u32x4*)(pr + SSD_OFF + c0), zz); const float dsk = ssd_d[c0 >> 6];
                  ys[0] = a0.x + b0.x; ys[1] = a0.y + b0.y; ys[2] = a0.z + b0.z; ys[3] = a0.w + b0.w; ys[4] = a1.x + b1.x; ys[5] = a1.y + b1.y; ys[6] = a1.z + b1.z; ys[7] = a1.w + b1.w;
#pragma unroll
                  for (int j = 0; j < 8; ++j) ys[j] = (ys[j] + dsk * xx[j]) * siluf_(zz[j]); }
                float s1 = 0.f, s2 = 0.f;
#pragma unroll
                for (int j = 0; j < 8; ++j) { s1 += hm[j] * hm[j]; s2 += ys[j] * ys[j]; }
                s1 += __shfl_xor(s1, 1); s1 += __shfl_xor(s1, 2); s1 += __shfl_xor(s1, 4); s1 += __shfl_xor(s1, 8);
                s2 = wave_sum(s2);
                const float r1 = rsqrtf(s1 * (1.0f / 128.0f) + 1e-6f), r2 = rsqrtf(s2 * (1.0f / BW) + 1e-6f);
                float oo[8]; unpack8(ooq, oo);
                const float gm[8] = {g0.x, g0.y, g0.z, g0.w, g1.x, g1.y, g1.z, g1.w}, gs[8] = {n0.x, n0.y, n0.z, n0.w, n1.x, n1.y, n1.z, n1.w};
                u32x4 w;
                w.x = pk2(hm[0] * r1 * gm[0] * sigmoidf_(oo[0]), hm[1] * r1 * gm[1] * sigmoidf_(oo[1])); w.y = pk2(hm[2] * r1 * gm[2] * sigmoidf_(oo[2]), hm[3] * r1 * gm[3] * sigmoidf_(oo[3]));
                w.z = pk2(hm[4] * r1 * gm[4] * sigmoidf_(oo[4]), hm[5] * r1 * gm[5] * sigmoidf_(oo[5])); w.w = pk2(hm[6] * r1 * gm[6] * sigmoidf_(oo[6]), hm[7] * r1 * gm[7] * sigmoidf_(oo[7]));
                *(u32x4*)(Y4 + (size_t)tok * DM + 512 + c0) = w;
                w.x = pk2(ys[0] * r2 * gs[0], ys[1] * r2 * gs[1]); w.y = pk2(ys[2] * r2 * gs[2], ys[3] * r2 * gs[3]); w.z = pk2(ys[4] * r2 * gs[4], ys[5] * r2 * gs[5]); w.w = pk2(ys[6] * r2 * gs[6], ys[7] * r2 * gs[7]);
                *(u32x4*)(Y4 + (size_t)tok * DM + 1536 + c0) = w;
                if (tok >= NLAT) { const size_t oc = (size_t)(tok - NLAT) * BW + c0; float uu[8]; unpack8(*(const u32x4*)(pr + S5_OFF + c0), uu);
                    const float4 a0 = *(const float4*)(SF + oc), a1 = *(const float4*)(SF + oc + 4), b0 = *(const float4*)(SB + oc), b1 = *(const float4*)(SB + oc + 4), d0 = *(const float4*)(s5_d + c0), d1 = *(const float4*)(s5_d + c0 + 4);
                    float y[8] = {a0.x + b0.x + d0.x * uu[0], a0.y + b0.y + d0.y * uu[1], a0.z + b0.z + d0.z * uu[2], a0.w + b0.w + d0.w * uu[3], a1.x + b1.x + d1.x * uu[4], a1.y + b1.y + d1.y * uu[5], a1.z + b1.z + d1.z * uu[6], a1.w + b1.w + d1.w * uu[7]};
#pragma unroll
                    for (int j = 0; j < 8; ++j) y[j] = 0.5f * y[j] * (1.0f + tanhf(0.7978845608028654f * (y[j] + 0.044715f * y[j] * y[j] * y[j])));
                    w.x = pk2(y[0], y[1]); w.y = pk2(y[2], y[3]); w.z = pk2(y[4], y[5]); w.w = pk2(y[6], y[7]);
                    *(u32x4*)(GG + (size_t)tok * BW + c0) = w; }
            }
            __syncthreads();
            {   float* T = sf;
                for (int unit = (G > 128 ? bid - 128 : bid); unit >= 0 && unit < 4 * 64 * 8; unit += (G > 128 ? G - 128 : G)) { const int b = unit / 512, t0 = ((unit >> 3) & 63) * 64, c0 = (unit & 7) * 64;
                    __syncthreads();
#pragma unroll
                    for (int i = 0; i < 8; ++i) { const int t = tid & 63, c = (tid >> 6) + 8 * i; T[c * 65 + t] = YT[((size_t)b * 512 + c0 + c) * SEQ + t0 + t]; }
                    __syncthreads();
                    const int t = tid >> 3, cq = (tid & 7) * 8;
                    u32x4 w; w.x = pk2(T[(cq + 0) * 65 + t], T[(cq + 1) * 65 + t]); w.y = pk2(T[(cq + 2) * 65 + t], T[(cq + 3) * 65 + t]); w.z = pk2(T[(cq + 4) * 65 + t], T[(cq + 5) * 65 + t]); w.w = pk2(T[(cq + 6) * 65 + t], T[(cq + 7) * 65 + t]);
                    *(u32x4*)(Y4 + ((size_t)b * SEQ + t0 + t) * DM + c0 + cq) = w;
                } }
            SEAM(PB + 5);
        }

        if (IN(PB + 6)) for (int rep_ = 0; rep_ < PROBE_REPS(6); ++rep_) {
            PH_BEGIN
            pg8::Gemm g{GG, GLU, BW, BW, BW}; pg8::SchedStd S{68, 2, G, bid, BW, BW}; pg8::EpiGlu E{GG, PT(33) + l * BW, Y4};
            pg8::gemm_phase((LAS unsigned char*)shm, g, S, E);
            SEAM(PB + 6);
        }
        if (IN(PB + 7)) for (int rep_ = 0; rep_ < PROBE_REPS(7); ++rep_) {
            PH_BEGIN
            pg8::Gemm g{Y4, WBR, DM, BW, BW}; pg8::SchedBranch S{nPanels, 8, G, bid}; pg8::EpiBranch E{P, ACCb};
            pg8::gemm_phase((LAS unsigned char*)shm, g, S, E);
            SEAM(PB + 7);
        }
        if (IN(PB + 8)) for (int rep_ = 0; rep_ < PROBE_REPS(8); ++rep_) {
            PH_BEGIN
            pg8::Gemm g{ACCb, WOUT, DM, DM, DM}; pg8::SchedStd S{nPanels, 8, G, bid, DM, DM}; pg8::EpiResid E{XS, l == 0 ? x_in : (const float*)XS, l == 0 ? ctx_in - (size_t)NLAT * DM : (const float*)XS, MODl, 2};
            pg8::gemm_phase((LAS unsigned char*)shm, g, S, E);
            SEAM(PB + 8);
        }
        if (IN(PB + 9)) for (int rep_ = 0; rep_ < PROBE_REPS(9); ++rep_) {
            PH_BEGIN
            for (int i = bid * NTHR + tid; i < NEXP * MOE_PAD; i += G * NTHR) ROWTOK[i] = -1;
            for (int i = bid * NTHR + tid; i < NTOK * 16; i += G * NTHR) INV[i] = -1;
            const float* wr = PT(42) + (size_t)l * DM * 16; const float* gn = norm_ffn + l * DM;
            for (int tok0 = (bid * 8 + wave) * 4; tok0 < M2; tok0 += G * 32) {
                const int r = tok0 < NLAT ? tok0 / SEQ : 4; const float* xr = XS + (size_t)tok0 * DM;
                const float* sh = MODl + (size_t)(r * 6 + 3) * DM; const float* sc = MODl + (size_t)(r * 6 + 4) * DM;
                float rs[4];
#pragma unroll
                for (int tk = 0; tk < 4; ++tk) { float ss = 0.f;
#pragma unroll 4
                    for (int i = 0; i < 8; ++i) { const float4 t4 = *(const float4*)(xr + (size_t)tk * DM + i * 256 + lane * 4); ss += t4.x * t4.x + t4.y * t4.y + t4.z * t4.z + t4.w * t4.w; }
                    ss = wave_sum(ss); rs[tk] = rsqrtf(ss * (1.0f / DM) + 1e-6f); }
                float lg[4][16];
#pragma unroll
                for (int tk = 0; tk < 4; ++tk)
#pragma unroll
                    for (int e = 0; e < 16; ++e) lg[tk][e] = 0.f;
#pragma unroll 1
                for (int i = 0; i < 8; ++i) { const int d = i * 256 + lane * 4;
                    const float4 g4 = *(const float4*)(gn + d), s4 = *(const float4*)(sc + d), h4 = *(const float4*)(sh + d);
                    float4 xq[4], ww[16];
#pragma unroll
                    for (int tk = 0; tk < 4; ++tk) xq[tk] = *(const float4*)(xr + (size_t)tk * DM + d);
                    const float4* wq = (const float4*)(wr + (size_t)d * 16);
#pragma unroll
                    for (int q = 0; q < 16; ++q) ww[q] = wq[q];
                    float hv[4][4];
#pragma unroll
                    for (int tk = 0; tk < 4; ++tk) { const float4 xv = xq[tk]; const float rr = rs[tk];
                        hv[tk][0] = xv.x * rr * g4.x * (1.f + s4.x) + h4.x; hv[tk][1] = xv.y * rr * g4.y * (1.f + s4.y) + h4.y; hv[tk][2] = xv.z * rr * g4.z * (1.f + s4.z) + h4.z; hv[tk][3] = xv.w * rr * g4.w * (1.f + s4.w) + h4.w;
                        u32x2 w; w.x = pk2(hv[tk][0], hv[tk][1]); w.y = pk2(hv[tk][2], hv[tk][3]); *(u32x2*)(HB + (size_t)(tok0 + tk) * DM + d) = w; }
#pragma unroll
                    for (int q = 0; q < 4; ++q) { const float4 w0 = ww[q * 4 + 0], w1 = ww[q * 4 + 1], w2 = ww[q * 4 + 2], w3 = ww[q * 4 + 3];
#pragma unroll
                        for (int tk = 0; tk < 4; ++tk) { const float hq = hv[tk][q];
                            lg[tk][0] += hq * w0.x; lg[tk][1] += hq * w0.y; lg[tk][2] += hq * w0.z; lg[tk][3] += hq * w0.w; lg[tk][4] += hq * w1.x; lg[tk][5] += hq * w1.y; lg[tk][6] += hq * w1.z; lg[tk][7] += hq * w1.w;
                            lg[tk][8] += hq * w2.x; lg[tk][9] += hq * w2.y; lg[tk][10] += hq * w2.z; lg[tk][11] += hq * w2.w; lg[tk][12] += hq * w3.x; lg[tk][13] += hq * w3.y; lg[tk][14] += hq * w3.z; lg[tk][15] += hq * w3.w; } } }
#pragma unroll
                for (int tk = 0; tk < 4; ++tk) { float mx = -1e30f;
#pragma unroll
                    for (int e = 0; e < 16; ++e) { lg[tk][e] = wave_sum(lg[tk][e]); mx = fmaxf(mx, lg[tk][e]); }
                    float sm = 0.f;
#pragma unroll
                    for (int e = 0; e < 16; ++e) { lg[tk][e] = expf(lg[tk][e] - mx); sm += lg[tk][e]; }
                    const float inv = 1.0f / sm;
                    if (lane == 0) {
#pragma unroll
                        for (int e = 0; e < 16; e += 4) *(float4*)(PROBS + (size_t)(tok0 + tk) * 16 + e) = make_float4(lg[tk][e] * inv, lg[tk][e + 1] * inv, lg[tk][e + 2] * inv, lg[tk][e + 3] * inv); } }
            }
            SEAM(PB + 9);
        }
        if (IN(PB + 10)) for (int rep_ = 0; rep_ < PROBE_REPS(10); ++rep_) {
            PH_BEGIN
            const int nitems = 64 + (lastl ? 0 : 64);
            unsigned long long* keys = (unsigned long long*)shm;
            for (int it = bid; it < nitems; it += G) {
                const int set = it >> 6, e = it & 15, b = (it >> 4) & 3;
                const int n = set ? CTXL : SEQ, cap = set ? 32 : 512, tokbase = set ? NLAT + b * CTXL : b * SEQ;
                __syncthreads();
                for (int i = tid; i < n; i += NTHR) keys[i] = ((unsigned long long)__float_as_uint(PROBS[(size_t)(tokbase + i) * 16 + e]) << 32) | (unsigned long long)(0xFFFFFFFFu - (unsigned)i);
                __syncthreads();
                for (int k = 2; k <= n; k <<= 1)
                    for (int j = k >> 1; j > 0; j >>= 1) {
                        for (int p = tid; p < (n >> 1); p += NTHR) { const int i = ((p & ~(j - 1)) << 1) | (p & (j - 1)); const int m = i | j;
                            const unsigned long long ka = keys[i], kb = keys[m]; const bool desc = ((i & k) == 0);
                            if ((ka < kb) == desc) { keys[i] = kb; keys[m] = ka; } }
                        __syncthreads();
                    }
                for (int r = tid; r < cap; r += NTHR) { const unsigned long long kk = keys[r]; const int row = e * MOE_PAD + (set ? 2048 + b * 32 + r : b * 512 + r);
                    const int tk_ = tokbase + (int)(0xFFFFFFFFu - (unsigned)(kk & 0xFFFFFFFFull)); ROWTOK[row] = tk_; ROWGATE[row] = __uint_as_float((unsigned)(kk >> 32)); INV[tk_ * 16 + e] = row; }
                for (int rb = 0; rb < cap; rb += 32) {
                    u32x4 t4[4][4];
#pragma unroll
                    for (int q = 0; q < 4; ++q) { const int r = rb + wave + 8 * q; const int tok = tokbase + (int)(0xFFFFFFFFu - (unsigned)(keys[r] & 0xFFFFFFFFull));
                        const u32x4* sp = (const u32x4*)(HB + (size_t)tok * DM);
#pragma unroll
                        for (int i = 0; i < 4; ++i) t4[q][i] = sp[i * 64 + lane]; }
#pragma unroll
                    for (int q = 0; q < 4; ++q) { const int r = rb + wave + 8 * q; const int row = e * MOE_PAD + (set ? 2048 + b * 32 + r : b * 512 + r);
                        u32x4* dp = (u32x4*)(XG + (size_t)row * DM);
#pragma unroll
                        for (int i = 0; i < 4; ++i) dp[i * 64 + lane] = t4[q][i]; } }
            }
            {   const int pad0 = lastl ? 2048 : MOE_ROWS, npad = MOE_PAD - pad0;
                for (int R = bid * 8 + wave; R < NEXP * npad; R += G * 8) { const int e = R / npad, rr = pad0 + R % npad; u32x4* dp = (u32x4*)(XG + ((size_t)e * MOE_PAD + rr) * DM);
#pragma unroll
                    for (int i = 0; i < 4; ++i) dp[i * 64 + lane] = (u32x4){0u, 0u, 0u, 0u}; } }
            SEAM(PB + 10);
        }
        if (IN(PB + 12)) for (int rep_ = 0; rep_ < PROBE_REPS(12); ++rep_) {
            PH_BEGIN
            pg8::Gemm g{XG, WGU, DM, DM, DM}; pg8::SchedMoe S{lastl ? 8 : 9, 12, G, bid, DM, DM, 2 * DEXP}; pg8::EpiMoe1 E{HID};
            pg8::gemm_phase((LAS unsigned char*)shm, g, S, E);
            SEAM(PB + 12);
        }
        if (IN(PB + 13)) for (int rep_ = 0; rep_ < PROBE_REPS(13); ++rep_) {
            PH_BEGIN
            pg8::Gemm g{HID, WD, DEXP, DEXP, DEXP}; pg8::SchedMoe S{lastl ? 8 : 9, 8, G, bid, DEXP, DEXP, DM}; pg8::EpiMoeY E{YEXP};
            pg8::gemm_phase((LAS unsigned char*)shm, g, S, E);
            SEAM(PB + 13);
        }

}

__global__ __launch_bounds__(NTHR, 2) void fwd(Args a) {
    extern __shared__ __attribute__((aligned(16))) unsigned char shm[];
    const int bid = blockIdx.x, G = gridDim.x;
    float* const sf = (float*)shm;
    volatile LAS unsigned* xbw = (volatile LAS unsigned*)((LAS unsigned char*)shm + (LDS_BYTES - 16));
    if (threadIdx.x == 0) { xbw[0] = 0u; xbw[1] = 0u; xbw[2] = 0u; xbw[3] = 0u; }
    const float** const ptab = (const float**)(shm + (LDS_BYTES - 16 - 512));
    if (threadIdx.x == 0) {
#pragma unroll
        for (int i = 0; i < 47; ++i) ptab[i] = a.in[i]; }
    __syncthreads();
    XcdBarrier bar = xcd_barrier_post((unsigned*)(a.ws + O_BAR), xbw);
    const int lo = a.ph_lo, hi = a.ph_hi;
    if (IN(0)) {
        PH_BEGIN
        {
            __syncthreads();
            for (int i = tid; i < 5 * DM; i += NTHR) { const int r = i >> 11, k = i & (DM - 1); const float v = r < 4 ? c_in[r * DM + k] : cctx_in[k]; sf[i] = siluf_(v); }
            __syncthreads();
            float* red = sf + 5 * DM;
            for (int unit = bid; unit < 2 * 96; unit += G) { const int l = unit / 96, j = (unit % 96) * 128 + (tid & 127), kq = tid >> 7;
                const float* w = ada_w + (size_t)l * DM * (6 * DM) + (size_t)(kq * 512) * (6 * DM) + j; const float* sv = sf + kq * 512;
                float a0 = 0.f, a1 = 0.f, a2 = 0.f, a3 = 0.f, a4 = 0.f;
#pragma unroll 8
                for (int k = 0; k < 512; ++k) { const float wv = w[(size_t)k * (6 * DM)]; a0 += sv[k] * wv; a1 += sv[DM + k] * wv; a2 += sv[2 * DM + k] * wv; a3 += sv[3 * DM + k] * wv; a4 += sv[4 * DM + k] * wv; }
                __syncthreads();
                { float* rp = red + (kq * 5) * 128 + (tid & 127); rp[0] = a0; rp[128] = a1; rp[256] = a2; rp[384] = a3; rp[512] = a4; }
                __syncthreads();
                if (tid < 128) { const float bb = ada_b[l * 6 * DM + j]; float* o = MOD + (size_t)l * 5 * 6 * DM + j;
#pragma unroll
                    for (int r = 0; r < 5; ++r) o[(size_t)r * 6 * DM] = ((red[(0 * 5 + r) * 128 + tid] + red[(1 * 5 + r) * 128 + tid]) + (red[(2 * 5 + r) * 128 + tid] + red[(3 * 5 + r) * 128 + tid])) + bb; }
            }
        }
    }

    layer_body<0>(a, bar, lo, hi, bid, G, shm, sf, ptab);
    layer_body<1>(a, bar, lo, hi, bid, G, shm, sf, ptab);
    if (IN(33)) {
        PH_BEGIN
        const float* gn = PT(46);
        for (int tok = bid * 8 + wave; tok < NLAT; tok += G * 8) {
            const float* xr = XS + (size_t)tok * DM; float4 v[8]; float ss = 0.f;
#pragma unroll
            for (int i = 0; i < 8; ++i) v[i] = *(const float4*)(xr + i * 256 + lane * 4);
            moe_combine(v, tok, lane, INV, ROWGATE, YEXP, MOD + (size_t)(1 * 5 + tok / SEQ) * 6 * DM + 5 * DM);
#pragma unroll
            for (int i = 0; i < 8; ++i) {                 ss += v[i].x * v[i].x + v[i].y * v[i].y + v[i].z * v[i].z + v[i].w * v[i].w; }
            ss = wave_sum(ss); const float rs = rsqrtf(ss * (1.0f / DM) + 1e-6f);
#pragma unroll
            for (int i = 0; i < 8; ++i) { const int d = i * 256 + lane * 4; const float4 g4 = *(const float4*)(gn + d);
                *(float4*)(a.out + (size_t)tok * DM + d) = make_float4(v[i].x * rs * g4.x, v[i].y * rs * g4.y, v[i].z * rs * g4.z, v[i].w * rs * g4.w); }
        }
    }
#undef IN
#undef SEAM
}


extern "C" void kernel_launch(void* const* d_in, const int* in_sizes, int n_in, void* d_out, int out_size, void* d_ws, size_t ws_size, hipStream_t stream) {
    static int grid = 0;
    if (grid == 0) {
        if (n_in != 47 || ws_size < WS_END) { fprintf(stderr, "kernel_launch: expected 47 inputs and >= %zu bytes of workspace; got %d, %zu\n", (size_t)WS_END, n_in, ws_size); grid = -1; return; }
        int dev = 0, cus = 0;
        if (hipGetDevice(&dev) != hipSuccess || hipDeviceGetAttribute(&cus, hipDeviceAttributeMultiprocessorCount, dev) != hipSuccess) { grid = -1; return; }
        if (hipFuncSetAttribute((const void*)fwd, hipFuncAttributeMaxDynamicSharedMemorySize, LDS_BYTES) != hipSuccess) { fprintf(stderr, "kernel_launch: hipFuncSetAttribute failed\n"); grid = -1; return; }
        int per_cu = 0;
        if (hipOccupancyMaxActiveBlocksPerMultiprocessor(&per_cu, (const void*)fwd, NTHR, LDS_BYTES) != hipSuccess || per_cu < 1) fprintf(stderr, "kernel_launch: occupancy query reports %d\n", per_cu);
        (void)hipGetLastError();
        grid = cus > 256 ? 256 : cus;
        if (grid < 224) { fprintf(stderr, "kernel_launch: needs >= 224 CUs (got %d)\n", grid); grid = -1; return; }
    }
    if (grid < 0) return;
    (void)hipMemsetAsync((char*)d_ws, 0, O_ZERO_END, stream);
    Args a{};
    for (int i = 0; i < 47; ++i) a.in[i] = (const float*)d_in[i];
    a.out = (float*)d_out; a.ws = (unsigned char*)d_ws;
#if MK_ONE_LAUNCH
    a.ph_lo = 0; a.ph_hi = 64;
    hipLaunchKernelGGL(fwd, dim3(grid), dim3(NTHR), LDS_BYTES, stream, a);
#else
    const int ids[] = {0, 1,2,3,4,5,6,7,8,9,10,11,12,13,14, 17,18,19,20,21,22,23,24,25,26,27,28,29,30, 33};
    for (int k = 0; k < (int)(sizeof(ids) / sizeof(ids[0])); ++k) { a.ph_lo = ids[k]; a.ph_hi = ids[k] + 1; hipLaunchKernelGGL(fwd, dim3(grid), dim3(NTHR), LDS_BYTES, stream, a); }
#endif
}
```

```cpp
#include <hip/hip_runtime.h>
#include <stdint.h>
#include <stdio.h>

#ifndef PROBE_MASK
#define PROBE_MASK 0
#endif
#ifndef PROBE_SP
#define PROBE_SP 1
#endif
#define PROBE_REPS(k) ((((PROBE_MASK) >> (k)) & 1) + 1)
#ifndef MK_ONE_LAUNCH
#define MK_ONE_LAUNCH 1
#endif

#define DM 2048
#define NB 4
#define SEQ 4096
#define CTXL 256
#define BW 512
#define NLAT 16384
#define NCTX 1024
#define NTOK 17408
#define IN_W 13856
#define LDP 14080
#define HY_OFF 0
#define ML_OFF 1536
#define S5_OFF 3600
#define SSD_OFF 4112
#define GATE_OFF 5664
#define NEXP 16
#define DEXP 1536
#define MOE_ROWS 2176
#define MOE_PAD 2304
#define NTHR 512
#define LDS_BYTES 147456
#define LAS __attribute__((address_space(3)))

typedef unsigned short bf16_t;
typedef short bf16x8 __attribute__((ext_vector_type(8)));
typedef float f32x4 __attribute__((ext_vector_type(4)));
typedef unsigned u32x4 __attribute__((ext_vector_type(4)));
typedef unsigned u32x2 __attribute__((ext_vector_type(2)));

#define XB_TMO      128
#define XB_XCNT(j)  (256  + 64 * (j))
#define XB_XSUB(j)  (1280 + 64 * (j))
#define XB_XGEN(j)  (2304 + 64 * (j))
#define XB_TOP      3328
#define XB_TOPGEN   3392
#define XCD_BAR_WORDS 3456
#define XB_SPIN_CAP (1u << 18)
__device__ __forceinline__ unsigned xb_ld(unsigned* p)              { return __hip_atomic_load(p, __ATOMIC_RELAXED, __HIP_MEMORY_SCOPE_AGENT); }
__device__ __forceinline__ unsigned xb_add(unsigned* p, unsigned v) { return __hip_atomic_fetch_add(p, v, __ATOMIC_RELAXED, __HIP_MEMORY_SCOPE_AGENT); }
__device__ __forceinline__ unsigned xb_xcc_id() { return (unsigned)__builtin_amdgcn_s_getreg((3 << 11) | 20) & 0xFu; }
#define XB_SPIN(cond, bar) do { unsigned _sp = 0; while (cond) { __builtin_amdgcn_s_sleep(1); \
    if ((++_sp & 255u) == 0u) { if (xb_ld(&(bar)[XB_TMO])) break; if (_sp > XB_SPIN_CAP) { atomicAdd(&(bar)[XB_TMO], 1u); break; } } } } while (0)
struct XcdBarrier { unsigned* bar; unsigned x; volatile LAS unsigned* st; };
__device__ __forceinline__ XcdBarrier xcd_barrier_post(unsigned* bar, volatile LAS unsigned* st) {
    XcdBarrier b; b.bar = bar; b.x = xb_xcc_id(); b.st = st;
    if (threadIdx.x == 0) (void)xb_add(&bar[XB_XCNT(b.x)], 1u);
    return b;
}
__device__ __forceinline__ void xcd_barrier_complete(unsigned* bar, unsigned x, unsigned& nloc, unsigned& nx) {
    const unsigned G = gridDim.x * gridDim.y * gridDim.z;
    unsigned sum, cnt, mine, sp = 0u;
    for (;;) {
        sum = 0u; cnt = 0u; mine = 0u;
#pragma unroll
        for (unsigned j = 0; j < 16; ++j) { const unsigned c = xb_ld(&bar[XB_XCNT(j)]); sum += c; cnt += (c > 0u) ? 1u : 0u; mine = (j == x) ? c : mine; }
        if (sum == G) break;
        __builtin_amdgcn_s_sleep(1);
        if ((++sp & 255u) == 0u) { if (xb_ld(&bar[XB_TMO])) break; if (sp > XB_SPIN_CAP) { atomicAdd(&bar[XB_TMO], 1u); break; } }
    }
    nloc = mine > 0u ? mine : 1u; nx = cnt > 0u ? cnt : 1u;
}
__device__ __forceinline__ void xcd_barrier(const XcdBarrier& b) {
    asm volatile("s_waitcnt vmcnt(0)" ::: "memory");
    __syncthreads();
    if (threadIdx.x == 0) {
        unsigned* bar = b.bar;
        __builtin_amdgcn_s_waitcnt(0);
        unsigned nloc = b.st[0], nx = b.st[1];
        if (nloc == 0u) { xcd_barrier_complete(bar, b.x, nloc, nx); b.st[0] = nloc; b.st[1] = nx; }
        const unsigned old = xb_add(&bar[XB_XSUB(b.x)], 1u);
        const unsigned gen = old / nloc;
        if (old + 1u == (gen + 1u) * nloc) {
            __builtin_amdgcn_fence(__ATOMIC_RELEASE, "agent");
            asm volatile("s_waitcnt vmcnt(0)" ::: "memory");
            const unsigned og = xb_add(&bar[XB_TOP], 1u);
            const unsigned tg = og / nx;
            if (og + 1u == (tg + 1u) * nx) xb_add(&bar[XB_TOPGEN], 1u);
            else XB_SPIN(xb_ld(&bar[XB_TOPGEN]) == tg, bar);
            __builtin_amdgcn_fence(__ATOMIC_ACQUIRE, "agent");
            xb_add(&bar[XB_XGEN(b.x)], 1u);
            asm volatile("s_waitcnt vmcnt(0)" ::: "memory");
        } else {
            XB_SPIN(xb_ld(&bar[XB_XGEN(b.x)]) == gen, bar);
            __builtin_amdgcn_fence(__ATOMIC_ACQUIRE, "agent");
            asm volatile("s_waitcnt vmcnt(0)" ::: "memory");
        }
    }
    __syncthreads();
}

__device__ __forceinline__ unsigned short f2bf(float f) { unsigned u = __float_as_uint(f); u += 0x7FFFu + ((u >> 16) & 1u); return (unsigned short)(u >> 16); }
__device__ __forceinline__ float bf2f(unsigned short b) { return __uint_as_float(((unsigned)b) << 16); }
__device__ __forceinline__ unsigned pk2(float lo, float hi) { unsigned r; asm("v_cvt_pk_bf16_f32 %0, %1, %2" : "=v"(r) : "v"(lo), "v"(hi)); return r; }
__device__ __forceinline__ float sigmoidf_(float x) { return 1.0f / (1.0f + expf(-x)); }
__device__ __forceinline__ float siluf_(float x) { return x / (1.0f + expf(-x)); }
__device__ __forceinline__ float wave_sum(float v) {
#pragma unroll
    for (int o = 32; o >= 1; o >>= 1) v += __shfl_xor(v, o);
    return v;
}
__device__ __forceinline__ const float* uptr(const float* p) { const unsigned long long v = (unsigned long long)p;
    const unsigned lo = __builtin_amdgcn_readfirstlane((unsigned)v), hi = __builtin_amdgcn_readfirstlane((unsigned)(v >> 32)); return (const float*)(((unsigned long long)hi << 32) | lo); }
#define PT(k) uptr(ptab[k])
__device__ __forceinline__ int step_tok(int b, int dir, int i) {
    if (i < CTXL) { const int tt = dir ? (CTXL - 1 - i) : i; return NLAT + b * CTXL + tt; }
    const int j = i - CTXL; const int tt = dir ? (SEQ - 1 - j) : j; return b * SEQ + tt;
}
__device__ __forceinline__ void unpack8(const u32x4 w, float (&f)[8]) {
    f[0] = __uint_as_float(w.x << 16); f[1] = __uint_as_float(w.x & 0xFFFF0000u); f[2] = __uint_as_float(w.y << 16); f[3] = __uint_as_float(w.y & 0xFFFF0000u);
    f[4] = __uint_as_float(w.z << 16); f[5] = __uint_as_float(w.z & 0xFFFF0000u); f[6] = __uint_as_float(w.w << 16); f[7] = __uint_as_float(w.w & 0xFFFF0000u);
}

namespace pg8 {
constexpr int BM = 256, BK = 64, HALF = 128, HTB = HALF * BK * 2, STAGE_BYTES = 8 * HTB, NXCD = 8, WGM = 8;
__host__ __device__ __forceinline__ int lds_byte(int r, int c) { const int st = (r >> 4) * 2 + (c >> 5), rr = r & 15, cc = c & 31, ob = rr * 64 + cc * 2; return st * 1024 + (ob ^ (((ob >> 9) & 1) << 5)); }
__host__ __device__ __forceinline__ void stage_rc(int b, int& R, int& C) { const int st = b / 1024, sb = b % 1024, swz = sb ^ (((sb >> 9) & 1) << 5); R = (st >> 1) * 16 + swz / 64; C = (st & 1) * 32 + (swz % 64) / 2; }
__host__ __device__ __forceinline__ int perm32(int rho) { const int n = rho >> 4, i = rho & 15; return 8 * (i >> 2) + 4 * n + (i & 3); }
struct Unit { int pm, pn, z, k; long long ao, bo; };
struct Gemm { const bf16_t* A; const bf16_t* Bt; int lda, ldb, K; };

__device__ __forceinline__ void tile_of(int wgid, int nM, int nN, int& pm, int& pn) {
    const int nwg = nM * nN; { const int q = nwg / NXCD, r = nwg % NXCD, xcd = wgid % NXCD, off = wgid / NXCD; wgid = (xcd < r ? xcd * (q + 1) : r * (q + 1) + (xcd - r) * q) + off; }
    const int nig = WGM * nN, gid = wgid / nig, fm = gid * WGM, gsz = (nM - fm) < WGM ? (nM - fm) : WGM;
    pm = fm + ((wgid % nig) % gsz); pn = (wgid % nig) / gsz;
}
struct SchedStd {
    int nM, nN, G, c, lda, ldb;
    __device__ __forceinline__ bool next(int i, Unit& u) const { const long L = (long)i * G + c; if (L >= (long)nM * nN) return false; tile_of((int)L, nM, nN, u.pm, u.pn); u.z = 0; u.k = 0;
        u.ao = (long long)u.pm * BM * lda * 2; u.bo = (long long)u.pn * BM * ldb * 2; return true; }
    __device__ __forceinline__ void a_ready(const Unit&) const {}
    __device__ __forceinline__ void done(const Unit&) const {}
};
struct SchedBranch {
    int nM, nN, G, c;
    __device__ __forceinline__ bool next(int i, Unit& u) const { const long L = (long)(i >> 2) * G + c; if (L >= (long)nM * nN) return false; tile_of((int)L, nM, nN, u.pm, u.pn); u.z = 0; u.k = i & 3;
        u.ao = ((long long)u.pm * BM * DM + u.k * BW) * 2; u.bo = ((long long)u.k * DM + u.pn * BM) * BW * 2; return true; }
    __device__ __forceinline__ void a_ready(const Unit&) const {}
    __device__ __forceinline__ void done(const Unit&) const {}
};
struct SchedMoe {
    int nPm, nPn, G, c, lda, ldb, nBrows;
    __device__ __forceinline__ bool next(int i, Unit& u) const { const long L = (long)i * G + c; const int per = nPm * nPn; if (L >= (long)NEXP * per) return false; const int e = (int)(L / per), rem = (int)(L % per);
        u.z = e; u.k = 0; u.pm = rem % nPm; u.pn = rem / nPm; u.ao = ((long long)e * MOE_PAD + u.pm * BM) * lda * 2; u.bo = ((long long)e * nBrows + u.pn * BM) * ldb * 2; return true; }
    __device__ __forceinline__ void a_ready(const Unit&) const {}
    __device__ __forceinline__ void done(const Unit&) const {}
};

typedef f32x4 Acc[2][2][4][2];
template <class Epi, class Sched>
__device__ __forceinline__ void gemm_phase(LAS unsigned char* lds, const Gemm g, const Sched& S, const Epi& E) {
    int tid = threadIdx.x; asm volatile("" : "+v"(tid));
    const int wid = __builtin_amdgcn_readfirstlane(tid >> 6), lane = tid & 63, wr = wid >> 2, wc = wid & 3, fr = lane & 15, fq = lane >> 4;
    const int K = g.K, nt = K / BK;
    unsigned voffA[2], voffB[2];
#pragma unroll
    for (int i = 0; i < 2; ++i) { int R, C; stage_rc(tid * 16 + i * 8192, R, C); const int Rb = Epi::PERM ? ((R & ~31) + perm32(R & 31)) : R;
        voffA[i] = (unsigned)(R * g.lda + C) * 2u; voffB[i] = (unsigned)(Rb * g.ldb + C) * 2u; }
    const size_t kstep = (size_t)(BK * 2);
    const size_t hstepA = (size_t)HALF * g.lda * 2, hstepB = (size_t)HALF * g.ldb * 2;
    const unsigned ldsw = (unsigned)wid * 1024u;
    const int aoff = lds_byte(wr * 64 + fr, fq * 8), boff = lds_byte(wc * 32 + fr, fq * 8);
#define PG8_SA(b, h) (((b) * 2 + (h)) * HTB)
#define PG8_SB(b, h) ((4 + (b) * 2 + (h)) * HTB)
#define PG8_STAGE(bufoff, gbase, voff) do { _Pragma("unroll") for (int _i = 0; _i < 2; ++_i) \
        __builtin_amdgcn_global_load_lds((const unsigned*)((const char*)(gbase) + (voff)[_i]), (LAS unsigned*)(lds + (bufoff) + ldsw + _i * 8192), 16, 0, 0); } while (0)
#define PG8_LDA(dst, b, h) do { _Pragma("unroll") for (int m = 0; m < 4; ++m) _Pragma("unroll") for (int k = 0; k < 2; ++k) dst[m][k] = *(const LAS bf16x8*)(lds + PG8_SA(b, h) + aoff + m * 2048 + k * 1024); } while (0)
#define PG8_LDB(dst, b, h) do { _Pragma("unroll") for (int n = 0; n < 2; ++n) _Pragma("unroll") for (int k = 0; k < 2; ++k) dst[n][k] = *(const LAS bf16x8*)(lds + PG8_SB(b, h) + boff + n * 2048 + k * 1024); } while (0)
#define PG8_MMA(ai, bj, At, Bt) do { __builtin_amdgcn_s_setprio(1); _Pragma("unroll") for (int m = 0; m < 4; ++m) _Pragma("unroll") for (int n = 0; n < 2; ++n) _Pragma("unroll") for (int k = 0; k < 2; ++k) \
        acc[ai][bj][m][n] = __builtin_amdgcn_mfma_f32_16x16x32_bf16(Bt[n][k], At[m][k], acc[ai][bj][m][n], 0, 0, 0); __builtin_amdgcn_s_setprio(0); } while (0)
#define PG8_WAIT_V(n) asm volatile("s_waitcnt vmcnt(" #n ")" ::: "memory")
#define PG8_WAIT_L(n) asm volatile("s_waitcnt lgkmcnt(" #n ")" ::: "memory")
#define PG8_BAR __builtin_amdgcn_s_barrier()
#define PG8_SCHED __builtin_amdgcn_sched_barrier(0)
    Unit cur, nxt; int ui = 0;
    if (!S.next(0, cur)) return;
    Acc acc;
#pragma unroll
    for (int a = 0; a < 2; ++a)
#pragma unroll
        for (int b = 0; b < 2; ++b)
#pragma unroll
            for (int m = 0; m < 4; ++m)
#pragma unroll
                for (int n = 0; n < 2; ++n) acc[a][b][m][n] = (f32x4){0.f, 0.f, 0.f, 0.f};
    bf16x8 At[4][2], B0[2][2], B1[2][2];
    const char* cA = (const char*)g.A + cur.ao; const char* cB = (const char*)g.Bt + cur.bo;
    S.a_ready(cur);
    PG8_STAGE(PG8_SB(0, 0), cB, voffB); PG8_STAGE(PG8_SA(0, 0), cA, voffA); PG8_STAGE(PG8_SB(0, 1), cB + hstepB, voffB); PG8_STAGE(PG8_SA(0, 1), cA + hstepA, voffA);
    if (wr == 1) PG8_BAR;
    PG8_WAIT_V(4); PG8_BAR;
    PG8_STAGE(PG8_SB(1, 0), cB + kstep, voffB); PG8_STAGE(PG8_SA(1, 0), cA + kstep, voffA); PG8_STAGE(PG8_SB(1, 1), cB + hstepB + kstep, voffB);
    PG8_WAIT_V(6); PG8_BAR;
    for (;;) {
        const bool has_next = S.next(ui + 1, nxt);
        const char* nA = has_next ? (const char*)g.A + nxt.ao : cA; const char* nB = has_next ? (const char*)g.Bt + nxt.bo : cB;
        for (int t = 0; t < nt; t += 2) {
            const bool last = (t == nt - 2);
            const char* a1 = cA + (size_t)(t + 1) * kstep;
            const char* a2 = last ? nA : cA + (size_t)(t + 2) * kstep; const char* b2 = last ? nB : cB + (size_t)(t + 2) * kstep;
            const char* a3 = a2 + kstep; const char* b3 = b2 + kstep;
            if (last && has_next) S.a_ready(nxt);
            PG8_LDB(B0, 0, 0); PG8_SCHED; PG8_LDA(At, 0, 0); PG8_STAGE(PG8_SA(1, 1), a1 + hstepA, voffA);
            PG8_WAIT_L(8); PG8_BAR; PG8_WAIT_L(0); PG8_MMA(0, 0, At, B0); PG8_BAR; PG8_SCHED;
            PG8_LDB(B1, 0, 1); PG8_STAGE(PG8_SB(0, 0), b2, voffB);
            PG8_BAR; PG8_WAIT_L(0); PG8_MMA(0, 1, At, B1); PG8_BAR;
            PG8_LDA(At, 0, 1); PG8_STAGE(PG8_SA(0, 0), a2, voffA);
            PG8_BAR; PG8_WAIT_L(0); PG8_MMA(1, 0, At, B0); PG8_BAR; PG8_SCHED;
            PG8_STAGE(PG8_SB(0, 1), b2 + hstepB, voffB);
            PG8_WAIT_V(6); PG8_BAR; PG8_MMA(1, 1, At, B1); PG8_BAR;
            PG8_LDB(B0, 1, 0); PG8_SCHED; PG8_LDA(At, 1, 0); PG8_STAGE(PG8_SA(0, 1), a2 + hstepA, voffA);
            PG8_WAIT_L(8); PG8_BAR; PG8_WAIT_L(0); PG8_MMA(0, 0, At, B0); PG8_BAR; PG8_SCHED;
            PG8_LDB(B1, 1, 1); PG8_STAGE(PG8_SB(1, 0), b3, voffB);
            PG8_BAR; PG8_WAIT_L(0); PG8_MMA(0, 1, At, B1); PG8_BAR;
            PG8_LDA(At, 1, 1); PG8_STAGE(PG8_SA(1, 0), a3, voffA);
            PG8_BAR; PG8_WAIT_L(0); PG8_MMA(1, 0, At, B0); PG8_BAR; PG8_SCHED;
            PG8_STAGE(PG8_SB(1, 1), b3 + hstepB, voffB);
            PG8_WAIT_V(6); PG8_BAR; PG8_MMA(1, 1, At, B1); PG8_BAR;
        }
        const bool keep = E(acc, cur, wr, wc, fr, fq); S.done(cur);
        if (!has_next) break;
        if (!keep) {
#pragma unroll
        for (int a = 0; a < 2; ++a)
#pragma unroll
            for (int b = 0; b < 2; ++b)
#pragma unroll
                for (int m = 0; m < 4; ++m)
#pragma unroll
                    for (int n = 0; n < 2; ++n) acc[a][b][m][n] = (f32x4){0.f, 0.f, 0.f, 0.f};
        }
        cur = nxt; cA = nA; cB = nB; ++ui;
    }
    PG8_WAIT_V(0);
    if (wr == 0) PG8_BAR;
    PG8_BAR;
#undef PG8_SA
#undef PG8_SB
#undef PG8_STAGE
#undef PG8_LDA
#undef PG8_LDB
#undef PG8_MMA
#undef PG8_WAIT_V
#undef PG8_WAIT_L
#undef PG8_BAR
#undef PG8_SCHED
}

struct EpiBf16Store {
    static constexpr bool PERM = true;
    bf16_t* O; int ldc;
    __device__ __forceinline__ bool operator()(Acc& acc, const Unit& u, int wr, int wc, int fr, int fq) const {
        const int row0 = u.pm * BM + wr * 64 + fr, col0 = u.pn * BM + wc * 32 + 8 * fq;
#pragma unroll
        for (int ai = 0; ai < 2; ++ai)
#pragma unroll
            for (int m = 0; m < 4; ++m) { bf16_t* rowp = O + (size_t)(row0 + ai * HALF + m * 16) * ldc + col0;
#pragma unroll
                for (int bj = 0; bj < 2; ++bj) { const f32x4 v0 = acc[ai][bj][m][0], v1 = acc[ai][bj][m][1];
                    u32x4 w; w.x = pk2(v0[0], v0[1]); w.y = pk2(v0[2], v0[3]); w.z = pk2(v1[0], v1[1]); w.w = pk2(v1[2], v1[3]);
                    *(u32x4*)(rowp + bj * HALF) = w; } }
        return false;
    }
};
struct EpiWin {
    static constexpr bool PERM = true;
    bf16_t* O; int ldc;
    __device__ __forceinline__ bool operator()(Acc& acc, const Unit& u, int wr, int wc, int fr, int fq) const {
        const int row0 = u.pm * BM + wr * 64 + fr, col0 = u.pn * BM + wc * 32 + 8 * fq;
#pragma unroll
        for (int bj = 0; bj < 2; ++bj) { const bool gate = (col0 + bj * HALF) >= GATE_OFF;
#pragma unroll
            for (int ai = 0; ai < 2; ++ai)
#pragma unroll
                for (int m = 0; m < 4; ++m) { f32x4 v0 = acc[ai][bj][m][0], v1 = acc[ai][bj][m][1];
                    if (gate) {
#pragma unroll
                        for (int j = 0; j < 4; ++j) { v0[j] = __builtin_amdgcn_rcpf(1.0f + __expf(-v0[j])); v1[j] = __builtin_amdgcn_rcpf(1.0f + __expf(-v1[j])); } }
                    u32x4 w; w.x = pk2(v0[0], v0[1]); w.y = pk2(v0[2], v0[3]); w.z = pk2(v1[0], v1[1]); w.w = pk2(v1[2], v1[3]);
                    *(u32x4*)(O + (size_t)(row0 + ai * HALF + m * 16) * ldc + col0 + bj * HALF) = w; } }
        return false;
    }
};
struct EpiNone { static constexpr bool PERM = true;
    __device__ __forceinline__ bool operator()(Acc& acc, const Unit&, int, int, int, int) const {
#pragma unroll
        for (int a = 0; a < 2; ++a)
#pragma unroll
            for (int b = 0; b < 2; ++b)
#pragma unroll
                for (int m = 0; m < 4; ++m)
#pragma unroll
                    for (int n = 0; n < 2; ++n) asm volatile("" :: "v"(acc[a][b][m][n]));
        return false; } };
struct EpiGlu {
    static constexpr bool PERM = true;
    const bf16_t* GG; const float* bias; bf16_t* Y4;
    __device__ __forceinline__ bool operator()(Acc& acc, const Unit& u, int wr, int wc, int fr, int fq) const {
        const int row0 = u.pm * BM + wr * 64 + fr, col0 = u.pn * BM + wc * 32 + 8 * fq;
#pragma unroll
        for (int bj = 0; bj < 2; ++bj) { const int col = col0 + bj * HALF; const f32x4 b0 = *(const f32x4*)(bias + col), b1 = *(const f32x4*)(bias + col + 4);
            u32x4 gq[2][4];
#pragma unroll
            for (int ai = 0; ai < 2; ++ai)
#pragma unroll
                for (int m = 0; m < 4; ++m) gq[ai][m] = *(const u32x4*)(GG + (size_t)(row0 + ai * HALF + m * 16) * BW + col);
#pragma unroll
            for (int ai = 0; ai < 2; ++ai)
#pragma unroll
                for (int m = 0; m < 4; ++m) { const size_t row = (size_t)(row0 + ai * HALF + m * 16);
                    float gg[8]; unpack8(gq[ai][m], gg);
                    const f32x4 v0 = acc[ai][bj][m][0] + b0, v1 = acc[ai][bj][m][1] + b1;
                    u32x4 w; w.x = pk2(gg[0] * sigmoidf_(v0[0]), gg[1] * sigmoidf_(v0[1])); w.y = pk2(gg[2] * sigmoidf_(v0[2]), gg[3] * sigmoidf_(v0[3]));
                    w.z = pk2(gg[4] * sigmoidf_(v1[0]), gg[5] * sigmoidf_(v1[1])); w.w = pk2(gg[6] * sigmoidf_(v1[2]), gg[7] * sigmoidf_(v1[3]));
                    *(u32x4*)(Y4 + row * DM + 1024 + col) = w; } }
        return false;
    }
};
struct EpiBranch {
    static constexpr bool PERM = true;
    const bf16_t* P; bf16_t* ACCb;
    __device__ __forceinline__ bool operator()(Acc& acc, const Unit& u, int wr, int wc, int fr, int fq) const {
        const int row0 = u.pm * BM + wr * 64 + fr, col0 = u.pn * BM + wc * 32 + 8 * fq; const int k = u.k;
        const bf16_t* gbase = P + (size_t)row0 * LDP + GATE_OFF + k * DM + col0;
        if (k < 3) {
#pragma unroll
            for (int ai = 0; ai < 2; ++ai) {
                u32x4 ga[8], gb[8];
#pragma unroll
                for (int m = 0; m < 4; ++m)
#pragma unroll
                    for (int bj = 0; bj < 2; ++bj) { const bf16_t* p = gbase + (size_t)(ai * HALF + m * 16) * LDP + bj * HALF; ga[m * 2 + bj] = *(const u32x4*)p; gb[m * 2 + bj] = *(const u32x4*)(p + DM); }
#pragma unroll
                for (int m = 0; m < 4; ++m)
#pragma unroll
                    for (int bj = 0; bj < 2; ++bj) { float g0[8], g1[8]; unpack8(ga[m * 2 + bj], g0); unpack8(gb[m * 2 + bj], g1);
                        float s[8];
#pragma unroll
                        for (int j = 0; j < 8; ++j) s[j] = g0[j] * __builtin_amdgcn_rcpf(g1[j]);
                        f32x4 v0 = acc[ai][bj][m][0], v1 = acc[ai][bj][m][1];
                        v0[0] *= s[0]; v0[1] *= s[1]; v0[2] *= s[2]; v0[3] *= s[3]; v1[0] *= s[4]; v1[1] *= s[5]; v1[2] *= s[6]; v1[3] *= s[7];
                        acc[ai][bj][m][0] = v0; acc[ai][bj][m][1] = v1; } }
            return true;
        }
#pragma unroll
        for (int ai = 0; ai < 2; ++ai) {
            u32x4 ga[8];
#pragma unroll
            for (int m = 0; m < 4; ++m)
#pragma unroll
                for (int bj = 0; bj < 2; ++bj) ga[m * 2 + bj] = *(const u32x4*)(gbase + (size_t)(ai * HALF + m * 16) * LDP + bj * HALF);
#pragma unroll
            for (int m = 0; m < 4; ++m)
#pragma unroll
                for (int bj = 0; bj < 2; ++bj) { float s[8]; unpack8(ga[m * 2 + bj], s);
                    f32x4 v0 = acc[ai][bj][m][0], v1 = acc[ai][bj][m][1];
                    v0[0] *= s[0]; v0[1] *= s[1]; v0[2] *= s[2]; v0[3] *= s[3]; v1[0] *= s[4]; v1[1] *= s[5]; v1[2] *= s[6]; v1[3] *= s[7];
                    u32x4 w; w.x = pk2(v0[0], v0[1]); w.y = pk2(v0[2], v0[3]); w.z = pk2(v1[0], v1[1]); w.w = pk2(v1[2], v1[3]);
                    *(u32x4*)(ACCb + (size_t)(row0 + ai * HALF + m * 16) * DM + col0 + bj * HALF) = w; } }
        return false;
    }
};
struct EpiResid {
    static constexpr bool PERM = false;
    float* XS; const float* srcLat; const float* srcCtx; const float* MODl; int gidx;
    __device__ __forceinline__ bool operator()(Acc& acc, const Unit& u, int wr, int wc, int fr, int fq) const {
        const int row0 = u.pm * BM + wr * 64 + fr, col0 = u.pn * BM + wc * 32 + 4 * fq;
        const int r = (u.pm * BM) < NLAT ? (u.pm * BM) / SEQ : 4;
        const float* src = (u.pm * BM) < NLAT ? srcLat : srcCtx;
        const float* mg = MODl + (size_t)(r * 6 + gidx) * DM;
#pragma unroll
        for (int bj = 0; bj < 2; ++bj) {
            f32x4 gm[2], xs[2][2][4];
#pragma unroll
            for (int n = 0; n < 2; ++n) { const int col = col0 + bj * HALF + n * 16; gm[n] = *(const f32x4*)(mg + col);
#pragma unroll
                for (int ai = 0; ai < 2; ++ai)
#pragma unroll
                    for (int m = 0; m < 4; ++m) xs[n][ai][m] = *(const f32x4*)(src + (size_t)(row0 + ai * HALF + m * 16) * DM + col); }
#pragma unroll
            for (int n = 0; n < 2; ++n) { const int col = col0 + bj * HALF + n * 16;
#pragma unroll
                for (int ai = 0; ai < 2; ++ai)
#pragma unroll
                    for (int m = 0; m < 4; ++m) *(f32x4*)(XS + (size_t)(row0 + ai * HALF + m * 16) * DM + col) = xs[n][ai][m] + gm[n] * acc[ai][bj][m][n]; } }
        return false;
    }
};
struct EpiMoe1 {
    static constexpr bool PERM = true;
    bf16_t* HID;
    __device__ __forceinline__ bool operator()(Acc& acc, const Unit& u, int wr, int wc, int fr, int fq) const {
        const size_t row0 = (size_t)u.z * MOE_PAD + u.pm * BM + wr * 64 + fr; const int col0 = u.pn * HALF + wc * 32 + 8 * fq;
#pragma unroll
        for (int ai = 0; ai < 2; ++ai)
#pragma unroll
            for (int m = 0; m < 4; ++m) { const f32x4 g0 = acc[ai][0][m][0], g1 = acc[ai][0][m][1], u0 = acc[ai][1][m][0], u1 = acc[ai][1][m][1];
                float h[8];
#pragma unroll
                for (int j = 0; j < 4; ++j) { h[j] = g0[j] * __builtin_amdgcn_rcpf(1.0f + __expf(-g0[j])) * u0[j]; h[4 + j] = g1[j] * __builtin_amdgcn_rcpf(1.0f + __expf(-g1[j])) * u1[j]; }
                u32x4 w; w.x = pk2(h[0], h[1]); w.y = pk2(h[2], h[3]); w.z = pk2(h[4], h[5]); w.w = pk2(h[6], h[7]);
                *(u32x4*)(HID + (row0 + ai * HALF + m * 16) * DEXP + col0) = w; }
        return false;
    }
};
struct EpiMoeY {
    static constexpr bool PERM = true;
    bf16_t* O;
    __device__ __forceinline__ bool operator()(Acc& acc, const Unit& u, int wr, int wc, int fr, int fq) const {
        const size_t row0 = (size_t)u.z * MOE_PAD + u.pm * BM + wr * 64 + fr; const int col0 = u.pn * BM + wc * 32 + 8 * fq;
#pragma unroll
        for (int ai = 0; ai < 2; ++ai)
#pragma unroll
            for (int m = 0; m < 4; ++m) { bf16_t* rowp = O + (row0 + ai * HALF + m * 16) * DM + col0;
#pragma unroll
                for (int bj = 0; bj < 2; ++bj) { const f32x4 v0 = acc[ai][bj][m][0], v1 = acc[ai][bj][m][1];
                    u32x4 w; w.x = pk2(v0[0], v0[1]); w.y = pk2(v0[2], v0[3]); w.z = pk2(v1[0], v1[1]); w.w = pk2(v1[2], v1[3]);
                    *(u32x4*)(rowp + bj * HALF) = w; } }
        return false;
    }
};

struct SchedS5a {
    int c;
    __device__ __forceinline__ bool next(int i, Unit& u) const { if (i > 0 || c >= 64) return false; u.z = c >> 1; u.pm = c & 1; u.pn = 0; u.k = 0;
        u.ao = ((long long)u.z * 512 + u.pm * BM) * 768 * 2; u.bo = (long long)u.z * 256 * 512 * 2; return true; }
    __device__ __forceinline__ void a_ready(const Unit&) const {}
    __device__ __forceinline__ void done(const Unit&) const {}
};
struct SchedS5b {
    int c;
    __device__ __forceinline__ bool next(int i, Unit& u) const { if (i > 0 || c >= 128) return false; u.z = c >> 2; u.pm = (c >> 1) & 1; u.pn = c & 1; u.k = 0;
        u.ao = ((long long)u.z * 512 + u.pm * BM) * 768 * 2; u.bo = ((long long)u.z * 512 + u.pn * BM) * 768 * 2; return true; }
    __device__ __forceinline__ void a_ready(const Unit&) const {}
    __device__ __forceinline__ void done(const Unit&) const {}
};
struct EpiXloc {
    static constexpr bool PERM = false;
    float* XL;
    __device__ __forceinline__ bool operator()(Acc& acc, const Unit& u, int wr, int wc, int fr, int fq) const {
        const int row0 = u.pm * BM + wr * 64 + fr, col0 = wc * 32 + 4 * fq; float* base = XL + (size_t)u.z * 512 * 256;
#pragma unroll
        for (int ai = 0; ai < 2; ++ai)
#pragma unroll
            for (int m = 0; m < 4; ++m) { float* rowp = base + (size_t)(row0 + ai * HALF + m * 16) * 256 + col0;
#pragma unroll
                for (int bj = 0; bj < 2; ++bj)
#pragma unroll
                    for (int n = 0; n < 2; ++n) *(f32x4*)(rowp + bj * HALF + n * 16) = acc[ai][bj][m][n]; }
        return false;
    }
};
struct EpiS5Out {
    static constexpr bool PERM = true;
    const bf16_t* P; const float* dskip; bf16_t* GG;
    __device__ __forceinline__ bool operator()(Acc& acc, const Unit& u, int wr, int wc, int fr, int fq) const {
        const int row0 = u.pm * BM + wr * 64 + fr, col0 = u.pn * BM + wc * 32 + 8 * fq; const int g = u.z;
#pragma unroll
        for (int bj = 0; bj < 2; ++bj) { const int col = col0 + bj * HALF; const int t = col >> 4, c0 = col & 15;
            const f32x4 d0 = *(const f32x4*)(dskip + g * 16 + c0), d1 = *(const f32x4*)(dskip + g * 16 + c0 + 4);
            u32x4 uq[2][4];
#pragma unroll
            for (int ai = 0; ai < 2; ++ai)
#pragma unroll
                for (int m = 0; m < 4; ++m) uq[ai][m] = *(const u32x4*)(P + ((size_t)(row0 + ai * HALF + m * 16) * 32 + t) * LDP + S5_OFF + g * 16 + c0);
#pragma unroll
            for (int ai = 0; ai < 2; ++ai)
#pragma unroll
                for (int m = 0; m < 4; ++m) { const size_t tok = (size_t)(row0 + ai * HALF + m * 16) * 32 + t;
                    float uu[8]; unpack8(uq[ai][m], uu);
                    const f32x4 v0 = acc[ai][bj][m][0], v1 = acc[ai][bj][m][1];
                    float y[8] = {v0[0] + d0[0] * uu[0], v0[1] + d0[1] * uu[1], v0[2] + d0[2] * uu[2], v0[3] + d0[3] * uu[3], v1[0] + d1[0] * uu[4], v1[1] + d1[1] * uu[5], v1[2] + d1[2] * uu[6], v1[3] + d1[3] * uu[7]};
#pragma unroll
                    for (int j = 0; j < 8; ++j) y[j] = 0.5f * y[j] * (1.0f + tanhf(0.7978845608028654f * (y[j] + 0.044715f * y[j] * y[j] * y[j])));
                    u32x4 w; w.x = pk2(y[0], y[1]); w.y = pk2(y[2], y[3]); w.z = pk2(y[4], y[5]); w.w = pk2(y[6], y[7]);
                    *(u32x4*)(GG + tok * BW + g * 16 + c0) = w; } }
        return false;
    }
};
}


__device__ __forceinline__ float wave_scan_incl(float v, int lane) {
#pragma unroll
    for (int o = 1; o < 64; o <<= 1) { const float t = __shfl_up(v, o); if (lane >= o) v += t; }
    return v;
}
__device__ __forceinline__ float wave_scanmax_incl(float v, int lane) {
#pragma unroll
    for (int o = 1; o < 64; o <<= 1) { const float t = __shfl_up(v, o); if (lane >= o) v = fmaxf(v, t); }
    return v;
}
__device__ __forceinline__ float wave_max(float v) {
#pragma unroll
    for (int o = 32; o >= 1; o >>= 1) v = fmaxf(v, __shfl_xor(v, o));
    return v;
}
__device__ __forceinline__ void unpack8h(const u32x4 w, bf16_t (&h)[8]) {
    h[0] = (bf16_t)(w.x & 0xFFFFu); h[1] = (bf16_t)(w.x >> 16); h[2] = (bf16_t)(w.y & 0xFFFFu); h[3] = (bf16_t)(w.y >> 16);
    h[4] = (bf16_t)(w.z & 0xFFFFu); h[5] = (bf16_t)(w.z >> 16); h[6] = (bf16_t)(w.w & 0xFFFFu); h[7] = (bf16_t)(w.w >> 16);
}

__device__ __forceinline__ int tokblock_of(int b, int dir, int c) { if (c < 4) return 256 + b * 4 + (dir ? 3 - c : c); const int j = c - 4; return b * 64 + (dir ? 63 - j : j); }
__device__ __forceinline__ u32x4 rev8h(const u32x4 v) { u32x4 r; r.x = (v.w >> 16) | (v.w << 16); r.y = (v.z >> 16) | (v.z << 16); r.z = (v.y >> 16) | (v.y << 16); r.w = (v.x >> 16) | (v.x << 16); return r; }
__device__ __forceinline__ u32x4 scale8h(const u32x4 v, const float4 a, const float4 b) { float f[8]; unpack8(v, f); u32x4 r; r.x = pk2(f[0] * a.x, f[1] * a.y); r.y = pk2(f[2] * a.z, f[3] * a.w); r.z = pk2(f[4] * b.x, f[5] * b.y); r.w = pk2(f[6] * b.z, f[7] * b.w); return r; }
__device__ __forceinline__ float dot8h(const u32x4 v, const float4 a, const float4 b) { float f[8]; unpack8(v, f); return (f[0] * a.x + f[1] * a.y) + (f[2] * a.z + f[3] * a.w) + (f[4] * b.x + f[5] * b.y) + (f[6] * b.z + f[7] * b.w); }
#define ML_FRAG_LOAD(KF, VF, cc_) do { const int tb_ = tokblock_of(b, dir, (cc_)); const bf16_t* kb_ = KTg + ((size_t)tb_ * 512 + h * 128 + 32 * wd + r16) * 64 + q4 * 8; const bf16_t* vb_ = VTg + ((size_t)tb_ * 512 + h * 128 + 64 * half + 32 * we + r16) * 64 + q4 * 8; \
        _Pragma("unroll") for (int ks_ = 0; ks_ < 2; ++ks_) _Pragma("unroll") for (int j_ = 0; j_ < 2; ++j_) { VF[j_][ks_] = *(const u32x4*)(vb_ + (size_t)j_ * 16 * 64 + ks_ * 32); KF[j_][ks_] = *(const u32x4*)(kb_ + (size_t)j_ * 16 * 64 + ks_ * 32); } } while (0)
#define ML_CHUNK(c_, KF, VF, KFN, VFN) do { const int c = (c_); \
        if (c + 1 < 68) ML_FRAG_LOAD(KFN, VFN, c + 1);                        \
        const float dec = sDEC[c]; \
        {   bf16_t* cs = CST + (size_t)(chain * 68 + c) * 128 * 128; \
            _Pragma("unroll") for (int je = 0; je < 2; ++je) _Pragma("unroll") for (int jd = 0; jd < 2; ++jd) { const int e = 64 * half + 32 * we + 16 * je + r16, d0 = 32 * wd + 16 * jd + q4 * 4; \
                u32x2 pk; pk.x = pk2(acc[je][jd][0], acc[je][jd][1]); pk.y = pk2(acc[je][jd][2], acc[je][jd][3]); *(u32x2*)(cs + (size_t)e * 128 + d0) = pk; } \
            if (nown) { _Pragma("unroll") for (int jd = 0; jd < 2; ++jd) { float nv = npart[jd]; nv += __shfl_xor(nv, 16); nv += __shfl_xor(nv, 32); if (q4 == 0) NST[(size_t)(chain * 68 + c) * 128 + 32 * wd + 16 * jd + r16] = nv; } } } \
        bf16x8 vfr[2][2]; \
        _Pragma("unroll") for (int ks = 0; ks < 2; ++ks) { const float4 wa = *(const float4*)(sWS + c * 64 + ks * 32 + q4 * 8), wb = *(const float4*)(sWS + c * 64 + ks * 32 + q4 * 8 + 4); \
            _Pragma("unroll") for (int je = 0; je < 2; ++je) { const u32x4 sv = scale8h(VF[je][ks], wa, wb); vfr[je][ks] = *(const bf16x8*)&sv; } \
            if (nown) { _Pragma("unroll") for (int jd = 0; jd < 2; ++jd) npart[jd] = (ks == 0 ? dec * npart[jd] : npart[jd]) + dot8h(KF[jd][ks], wa, wb); } } \
        _Pragma("unroll") for (int je = 0; je < 2; ++je) _Pragma("unroll") for (int jd = 0; jd < 2; ++jd) acc[je][jd] = acc[je][jd] * dec; \
        _Pragma("unroll") for (int ks = 0; ks < 2; ++ks) _Pragma("unroll") for (int je = 0; je < 2; ++je) _Pragma("unroll") for (int jd = 0; jd < 2; ++jd) \
            acc[je][jd] = __builtin_amdgcn_mfma_f32_16x16x32_bf16(*(const bf16x8*)&KF[jd][ks], vfr[je][ks], acc[je][jd], 0, 0, 0); } while (0)
__device__ __forceinline__ void mlstm_state_pass(const int chain, const int half, const bf16_t* __restrict__ Pm, const bf16_t* __restrict__ KTg, const bf16_t* __restrict__ VTg, const float* __restrict__ gate_b,
                                                 bf16_t* __restrict__ CST, float* __restrict__ NST, float* __restrict__ MST, unsigned char* shm, const int tid) {
    const int dir = chain & 1, h = (chain >> 1) & 3, b = chain >> 3, lane = tid & 63, w = tid >> 6, we = w >> 2, wd = w & 3, q4 = lane >> 4, r16 = lane & 15;
    const bool nown = (half == 0) && (we == 0);
    float* sE = (float*)shm; float* sWS = sE + 68 * 64; float* sAL = sWS + 68 * 64; float* sBE = sAL + 68; float* sMO = sBE + 68; float* sDEC = sMO + 68; float* sMB = sDEC + 68;
    const float gbi = gate_b[(dir * 2 + 0) * 4 + h], gbf = gate_b[(dir * 2 + 1) * 4 + h];
    const int gcol_i = ML_OFF + 2048 + (dir * 2 + 0) * 4 + h, gcol_f = ML_OFF + 2048 + (dir * 2 + 1) * 4 + h;
    u32x4 kfA[2][2], vfA[2][2], kfB[2][2], vfB[2][2];
    ML_FRAG_LOAD(kfA, vfA, 0);
    __syncthreads();
    unsigned gi_[9], gf_[9];
#pragma unroll
    for (int q = 0; q < 9; ++q) { const int c = min(w + 8 * q, 67); const size_t tokl = (size_t)step_tok(b, dir, c * 64 + lane); gi_[q] = Pm[tokl * LDP + gcol_i]; gf_[q] = Pm[tokl * LDP + gcol_f]; }
#pragma unroll
    for (int q = 0; q < 9; ++q) { const int c = w + 8 * q; if (c >= 68) break;
        const float ig = __uint_as_float(gi_[q] << 16) + gbi, fg = __uint_as_float(gf_[q] << 16) + gbf;
        const float lf = fminf(fg, 0.f) - log1pf(expf(-fabsf(fg)));
        const float bcs = wave_scan_incl(lf, lane); const float blast = __shfl(bcs, 63); const float ei = blast - bcs + ig; const float beta = wave_max(ei);
        sE[c * 64 + lane] = ei; if (lane == 0) { sAL[c] = blast; sBE[c] = beta; } }
    __syncthreads();
    if (tid == 0) { float m = 0.f; for (int c = 0; c < 68; ++c) { sMB[c] = m; const float mo = fmaxf(m + sAL[c], sBE[c]); sDEC[c] = expf(sAL[c] + m - mo); sMO[c] = mo; m = mo; } }
    __syncthreads();
    for (int idx = tid; idx < 68 * 64; idx += NTHR) { const int c = idx >> 6, i = idx & 63; sWS[c * 64 + (dir ? 63 - i : i)] = expf(sE[idx] - sMO[c]); }
    if (half == 0 && tid < 68) MST[chain * 68 + tid] = sMB[tid];
    __syncthreads();
    f32x4 acc[2][2];
#pragma unroll
    for (int je = 0; je < 2; ++je)
#pragma unroll
        for (int jd = 0; jd < 2; ++jd) acc[je][jd] = (f32x4){0.f, 0.f, 0.f, 0.f};
    float npart[2] = {0.f, 0.f};
    for (int c2 = 0; c2 < 68; c2 += 2) { ML_CHUNK(c2, kfA, vfA, kfB, vfB); ML_CHUNK(c2 + 1, kfB, vfB, kfA, vfA); }
    __syncthreads();
}
#undef ML_CHUNK
#undef ML_FRAG_LOAD
__device__ __forceinline__ void mlstm_out_item(const int chain, const int c, const bf16_t* __restrict__ Pm, const bf16_t* __restrict__ QKb, const bf16_t* __restrict__ VTg, const float* __restrict__ gate_b,
                                               const bf16_t* __restrict__ CST, const float* __restrict__ NST, const float* __restrict__ MST, float* __restrict__ Hout, unsigned char* shm, const int tid) {
    const int dir = chain & 1, h = (chain >> 1) & 3, b = chain >> 3, lane = tid & 63, w = tid >> 6;
    bf16_t* Qs = (bf16_t*)shm; bf16_t* Ks = (bf16_t*)(shm + 17408); bf16_t* VT = (bf16_t*)(shm + 34816); bf16_t* Cs = (bf16_t*)(shm + 53248); bf16_t* Ss = (bf16_t*)(shm + 88064);
    float* sc = (float*)(shm + 97280);
    __syncthreads();
#pragma unroll
    for (int i = 0; i < 2; ++i) { const int pid = tid + i * 512; const int s = pid >> 4, x0 = (pid & 15) * 8; const size_t toks = (size_t)step_tok(b, dir, c * 64 + s);
        *(u32x4*)(Qs + s * 136 + x0) = *(const u32x4*)(QKb + toks * 1024 + h * 128 + x0);
        *(u32x4*)(Ks + s * 136 + x0) = *(const u32x4*)(QKb + toks * 1024 + 512 + h * 128 + x0);
        { const int e = pid >> 3, o = pid & 7;
          const u32x4 vv = *(const u32x4*)(VTg + ((size_t)tokblock_of(b, dir, c) * 512 + h * 128 + e) * 64 + (dir ? 7 - o : o) * 8);
          *(u32x4*)(VT + e * 72 + o * 8) = dir ? rev8h(vv) : vv; } }
#pragma unroll
    for (int i = 0; i < 4; ++i) { const int pid = tid + i * 512; const int e = pid >> 4, x0 = (pid & 15) * 8;
        *(u32x4*)(Cs + e * 136 + x0) = *(const u32x4*)(CST + ((size_t)(chain * 68 + c) * 128 + e) * 128 + x0); }
    if (tid < 128) sc[384 + tid] = NST[(size_t)(chain * 68 + c) * 128 + tid];
    if (w == 0) {
        const float gbi = gate_b[(dir * 2 + 0) * 4 + h], gbf = gate_b[(dir * 2 + 1) * 4 + h];
        const size_t tokl = (size_t)step_tok(b, dir, c * 64 + lane);
        const float ig = bf2f(Pm[tokl * LDP + ML_OFF + 2048 + (dir * 2 + 0) * 4 + h]) + gbi;
        const float fg = bf2f(Pm[tokl * LDP + ML_OFF + 2048 + (dir * 2 + 1) * 4 + h]) + gbf;
        const float lf = fminf(fg, 0.f) - log1pf(expf(-fabsf(fg)));
        const float bcs = wave_scan_incl(lf, lane); const float gsv = ig - bcs; const float pm = wave_scanmax_incl(gsv, lane);
        const float m_in = MST[chain * 68 + c]; const float mt = bcs + fmaxf(m_in, pm);
        sc[lane] = bcs; sc[64 + lane] = gsv; sc[128 + lane] = mt; sc[192 + lane] = expf(bcs + m_in - mt); sc[256 + lane] = expf(-mt);
    }
    __syncthreads();
    const int tt = w >> 1;
    {   f32x4 aS[2] = {(f32x4){0.f, 0.f, 0.f, 0.f}, (f32x4){0.f, 0.f, 0.f, 0.f}};
#pragma unroll
        for (int ks = 0; ks < 4; ++ks) { const bf16x8 af = *(const bf16x8*)(Qs + (16 * tt + (lane & 15)) * 136 + ks * 32 + (lane >> 4) * 8);
#pragma unroll
            for (int i = 0; i < 2; ++i) { const int st = (w & 1) * 2 + i; const bf16x8 bfr = *(const bf16x8*)(Ks + (16 * st + (lane & 15)) * 136 + ks * 32 + (lane >> 4) * 8);
                aS[i] = __builtin_amdgcn_mfma_f32_16x16x32_bf16(af, bfr, aS[i], 0, 0, 0); } }
        float rs[4] = {0.f, 0.f, 0.f, 0.f};
#pragma unroll
        for (int i = 0; i < 2; ++i) { const int s = 16 * ((w & 1) * 2 + i) + (lane & 15); const float gsv = sc[64 + s];
#pragma unroll
            for (int q = 0; q < 4; ++q) { const int t = 16 * tt + (lane >> 4) * 4 + q; const float val = (s <= t) ? aS[i][q] * expf(sc[t] + gsv - sc[128 + t]) : 0.f; Ss[t * 72 + s] = f2bf(val); rs[q] += val; } }
#pragma unroll
        for (int q = 0; q < 4; ++q) { float r = rs[q]; r += __shfl_xor(r, 1); r += __shfl_xor(r, 2); r += __shfl_xor(r, 4); r += __shfl_xor(r, 8);
            if ((lane & 15) == 0) sc[512 + (w & 1) * 64 + 16 * tt + (lane >> 4) * 4 + q] = r; }
        {   const int t = tid >> 3, part = tid & 7; float dot = 0.f;
#pragma unroll
            for (int j = 0; j < 16; ++j) dot += bf2f(Qs[t * 136 + part * 16 + j]) * sc[384 + part * 16 + j];
            dot += __shfl_xor(dot, 1); dot += __shfl_xor(dot, 2); dot += __shfl_xor(dot, 4);
            if (part == 0) sc[640 + t] = sc[192 + t] * dot; }
    }
    __syncthreads();
    {   f32x4 aN[4];
#pragma unroll
        for (int i = 0; i < 4; ++i) aN[i] = (f32x4){0.f, 0.f, 0.f, 0.f};
#pragma unroll
        for (int ks = 0; ks < 4; ++ks) { const bf16x8 af = *(const bf16x8*)(Qs + (16 * tt + (lane & 15)) * 136 + ks * 32 + (lane >> 4) * 8);
#pragma unroll
            for (int i = 0; i < 4; ++i) { const int et = (w & 1) * 4 + i; const bf16x8 bfr = *(const bf16x8*)(Cs + (16 * et + (lane & 15)) * 136 + ks * 32 + (lane >> 4) * 8);
                aN[i] = __builtin_amdgcn_mfma_f32_16x16x32_bf16(af, bfr, aN[i], 0, 0, 0); } }
#pragma unroll
        for (int q = 0; q < 4; ++q) { const float it = sc[192 + 16 * tt + (lane >> 4) * 4 + q];
#pragma unroll
            for (int i = 0; i < 4; ++i) aN[i][q] *= it; }
#pragma unroll
        for (int ks = 0; ks < 2; ++ks) { const bf16x8 af = *(const bf16x8*)(Ss + (16 * tt + (lane & 15)) * 72 + ks * 32 + (lane >> 4) * 8);
#pragma unroll
            for (int i = 0; i < 4; ++i) { const int et = (w & 1) * 4 + i; const bf16x8 bfr = *(const bf16x8*)(VT + (16 * et + (lane & 15)) * 72 + ks * 32 + (lane >> 4) * 8);
                aN[i] = __builtin_amdgcn_mfma_f32_16x16x32_bf16(af, bfr, aN[i], 0, 0, 0); } }
#pragma unroll
        for (int q = 0; q < 4; ++q) { const int t = 16 * tt + (lane >> 4) * 4 + q; const size_t tokt = (size_t)step_tok(b, dir, c * 64 + t); const float dn = fmaxf(fabsf((sc[512 + t] + sc[576 + t]) + sc[640 + t]), sc[256 + t]);
#pragma unroll
            for (int i = 0; i < 4; ++i) { const int e = 16 * ((w & 1) * 4 + i) + (lane & 15); Hout[tokt * BW + h * 128 + e] = aN[i][q] / dn; } }
    }
}


#define SD_FRAG_LOAD(BF, XF, cc_) do { const int tb_ = tokblock_of(b, dir, (cc_)); const bf16_t* bb_ = BTg + ((size_t)tb_ * 256 + grp * 128 + 64 * (w >> 2) + r16) * 64 + q4 * 8; const bf16_t* xb_ = XTg + ((size_t)tb_ * 512 + h * 64 + 16 * (w & 3) + r16) * 64 + q4 * 8; \
        _Pragma("unroll") for (int ks_ = 0; ks_ < 2; ++ks_) { XF[ks_] = *(const u32x4*)(xb_ + ks_ * 32); _Pragma("unroll") for (int j_ = 0; j_ < 4; ++j_) BF[j_][ks_] = *(const u32x4*)(bb_ + (size_t)j_ * 16 * 64 + ks_ * 32); } } while (0)
#define SD_CHUNK(c_, BF, XF, BFN, XFN) do { const int c = (c_); \
        if (c + 1 < 68) SD_FRAG_LOAD(BFN, XFN, c + 1); \
        const float dec = sDEC[c]; \
        {   bf16_t* ss = SSTb + (size_t)(chain * 68 + c) * 64 * 128; const int p = 16 * (w & 3) + r16; \
            _Pragma("unroll") for (int j = 0; j < 4; ++j) { const int n0 = 16 * ((w >> 2) * 4 + j) + q4 * 4; u32x2 pk; pk.x = pk2(acc[j][0], acc[j][1]); pk.y = pk2(acc[j][2], acc[j][3]); *(u32x2*)(ss + (size_t)p * 128 + n0) = pk; } } \
        bf16x8 xfr[2]; \
        _Pragma("unroll") for (int ks = 0; ks < 2; ++ks) { const float4 wa = *(const float4*)(sSC + c * 64 + ks * 32 + q4 * 8), wb = *(const float4*)(sSC + c * 64 + ks * 32 + q4 * 8 + 4); const u32x4 sv = scale8h(XF[ks], wa, wb); xfr[ks] = *(const bf16x8*)&sv; } \
        _Pragma("unroll") for (int j = 0; j < 4; ++j) acc[j] = acc[j] * dec; \
        _Pragma("unroll") for (int ks = 0; ks < 2; ++ks) _Pragma("unroll") for (int j = 0; j < 4; ++j) acc[j] = __builtin_amdgcn_mfma_f32_16x16x32_bf16(*(const bf16x8*)&BF[j][ks], xfr[ks], acc[j], 0, 0, 0); } while (0)
__device__ __forceinline__ void ssd_state_pass(const int chain, const bf16_t* __restrict__ Pm, const bf16_t* __restrict__ BTg, const bf16_t* __restrict__ XTg, const float Aa, const float dtb,
                                               bf16_t* __restrict__ SSTb, unsigned char* shm, const int tid) {
    const int dir = chain & 1, h = (chain >> 1) & 7, b = chain >> 4, grp = h >> 2, lane = tid & 63, w = tid >> 6, q4 = lane >> 4, r16 = lane & 15;
    float* sSC = (float*)shm; float* sDEC = sSC + 68 * 64;
    const int dcol = SSD_OFF + 1536 + dir * 8 + h;
    u32x4 bfA[4][2], xfA[2], bfB[4][2], xfB[2];
    SD_FRAG_LOAD(bfA, xfA, 0);
    __syncthreads();
    unsigned dt_[9];
#pragma unroll
    for (int q = 0; q < 9; ++q) { const int c = min(w + 8 * q, 67); dt_[q] = Pm[(size_t)step_tok(b, dir, c * 64 + lane) * LDP + dcol]; }
#pragma unroll
    for (int q = 0; q < 9; ++q) { const int c = w + 8 * q; if (c >= 68) break;
        const float xv = __uint_as_float(dt_[q] << 16) + dtb; const float dtv = xv > 20.f ? xv : log1pf(expf(xv));
        const float cs = wave_scan_incl(dtv * Aa, lane); const float cl = __shfl(cs, 63);
        sSC[c * 64 + (dir ? 63 - lane : lane)] = dtv * expf(cl - cs); if (lane == 0) sDEC[c] = expf(cl); }
    __syncthreads();
    f32x4 acc[4];
#pragma unroll
    for (int j = 0; j < 4; ++j) acc[j] = (f32x4){0.f, 0.f, 0.f, 0.f};
    for (int c2 = 0; c2 < 68; c2 += 2) { SD_CHUNK(c2, bfA, xfA, bfB, xfB); SD_CHUNK(c2 + 1, bfB, xfB, bfA, xfA); }
    __syncthreads();
}
#undef SD_CHUNK
#undef SD_FRAG_LOAD
__device__ __forceinline__ void ssd_out_item(const int chain, const int c, const bf16_t* __restrict__ Pm, const bf16_t* __restrict__ XBb, const bf16_t* __restrict__ XTg, const float Aa, const float dtb,
                                             const bf16_t* __restrict__ SSTb, float* __restrict__ Yout, unsigned char* shm, const int tid) {
    const int dir = chain & 1, h = (chain >> 1) & 7, b = chain >> 4, grp = h >> 2, lane = tid & 63, w = tid >> 6;
    bf16_t* Cs = (bf16_t*)shm; bf16_t* Bs = (bf16_t*)(shm + 17408); bf16_t* XT = (bf16_t*)(shm + 34816); bf16_t* Sin = (bf16_t*)(shm + 44032); bf16_t* Gs = (bf16_t*)(shm + 61440);
    float* sc = (float*)(shm + 70656);
    __syncthreads();
#pragma unroll
    for (int i = 0; i < 2; ++i) { const int pid = tid + i * 512; const int s = pid >> 4, x0 = (pid & 15) * 8; const size_t toks = (size_t)step_tok(b, dir, c * 64 + s);
        *(u32x4*)(Bs + s * 136 + x0) = *(const u32x4*)(XBb + toks * 1024 + 512 + grp * 128 + x0);
        *(u32x4*)(Cs + s * 136 + x0) = *(const u32x4*)(XBb + toks * 1024 + 768 + grp * 128 + x0);
        const int p = pid >> 4;
        *(u32x4*)(Sin + p * 136 + x0) = *(const u32x4*)(SSTb + ((size_t)(chain * 68 + c) * 64 + p) * 128 + x0); }
    {   const int p = tid >> 3, o = tid & 7;
        const u32x4 vv = *(const u32x4*)(XTg + ((size_t)tokblock_of(b, dir, c) * 512 + h * 64 + p) * 64 + (dir ? 7 - o : o) * 8);
        *(u32x4*)(XT + p * 72 + o * 8) = dir ? rev8h(vv) : vv; }
    if (w == 0) { const size_t tokl = (size_t)step_tok(b, dir, c * 64 + lane);
        const float xv = bf2f(Pm[tokl * LDP + SSD_OFF + 1536 + dir * 8 + h]) + dtb; const float dtv = xv > 20.f ? xv : log1pf(expf(xv));
        sc[lane] = wave_scan_incl(dtv * Aa, lane); sc[64 + lane] = dtv; }
    __syncthreads();
    {   const int lt = w >> 1;
        f32x4 aG[2] = {(f32x4){0.f, 0.f, 0.f, 0.f}, (f32x4){0.f, 0.f, 0.f, 0.f}};
#pragma unroll
        for (int ks = 0; ks < 4; ++ks) { const bf16x8 af = *(const bf16x8*)(Cs + (16 * lt + (lane & 15)) * 136 + ks * 32 + (lane >> 4) * 8);
#pragma unroll
            for (int i = 0; i < 2; ++i) { const int st = (w & 1) * 2 + i; const bf16x8 bfr = *(const bf16x8*)(Bs + (16 * st + (lane & 15)) * 136 + ks * 32 + (lane >> 4) * 8);
                aG[i] = __builtin_amdgcn_mfma_f32_16x16x32_bf16(af, bfr, aG[i], 0, 0, 0); } }
#pragma unroll
        for (int i = 0; i < 2; ++i) { const int s = 16 * ((w & 1) * 2 + i) + (lane & 15); const float css = sc[s], dts = sc[64 + s];
#pragma unroll
            for (int q = 0; q < 4; ++q) { const int t = 16 * lt + (lane >> 4) * 4 + q; const float val = (s <= t) ? aG[i][q] * expf(sc[t] - css) * dts : 0.f; Gs[t * 72 + s] = f2bf(val); } }
    }
    __syncthreads();
    {   const int lt = w >> 1;
        f32x4 aY[2] = {(f32x4){0.f, 0.f, 0.f, 0.f}, (f32x4){0.f, 0.f, 0.f, 0.f}};
#pragma unroll
        for (int ks = 0; ks < 4; ++ks) { const bf16x8 af = *(const bf16x8*)(Cs + (16 * lt + (lane & 15)) * 136 + ks * 32 + (lane >> 4) * 8);
#pragma unroll
            for (int i = 0; i < 2; ++i) { const int pt = (w & 1) * 2 + i; const bf16x8 bfr = *(const bf16x8*)(Sin + (16 * pt + (lane & 15)) * 136 + ks * 32 + (lane >> 4) * 8);
                aY[i] = __builtin_amdgcn_mfma_f32_16x16x32_bf16(af, bfr, aY[i], 0, 0, 0); } }
#pragma unroll
        for (int q = 0; q < 4; ++q) { const float ec = expf(sc[16 * lt + (lane >> 4) * 4 + q]); aY[0][q] *= ec; aY[1][q] *= ec; }
#pragma unroll
        for (int ks = 0; ks < 2; ++ks) { const bf16x8 af = *(const bf16x8*)(Gs + (16 * lt + (lane & 15)) * 72 + ks * 32 + (lane >> 4) * 8);
#pragma unroll
            for (int i = 0; i < 2; ++i) { const int pt = (w & 1) * 2 + i; const bf16x8 bfr = *(const bf16x8*)(XT + (16 * pt + (lane & 15)) * 72 + ks * 32 + (lane >> 4) * 8);
                aY[i] = __builtin_amdgcn_mfma_f32_16x16x32_bf16(af, bfr, aY[i], 0, 0, 0); } }
#pragma unroll
        for (int q = 0; q < 4; ++q) { const int t = 16 * lt + (lane >> 4) * 4 + q; const size_t tokt = (size_t)step_tok(b, dir, c * 64 + t);
#pragma unroll
            for (int i = 0; i < 2; ++i) { const int p = 16 * ((w & 1) * 2 + i) + (lane & 15); Yout[tokt * BW + h * 64 + p] = aY[i][q]; } }
    }
}


#define FIDX(i) ((i) + ((i) >> 4))
#define FFT_X_BYTES 69632
__device__ constexpr float FFT_CW_RE[6][16] = {{0.f, 0.f, 0.f, 0.f, 0.f, 0.f, 0.f, 0.f, 0.f, 0.f, 0.f, 0.f, 0.f, 0.f, 0.f, 0.f}, {1.0f, 0.f, 0.f, 0.f, 0.f, 0.f, 0.f, 0.f, 0.f, 0.f, 0.f, 0.f, 0.f, 0.f, 0.f, 0.f}, {1.0f, 6.123233995736766e-17f, 0.f, 0.f, 0.f, 0.f, 0.f, 0.f, 0.f, 0.f, 0.f, 0.f, 0.f, 0.f, 0.f, 0.f}, {1.0f, 0.7071067811865476f, 6.123233995736766e-17f, -0.7071067811865475f, 0.f, 0.f, 0.f, 0.f, 0.f, 0.f, 0.f, 0.f, 0.f, 0.f, 0.f, 0.f}, {1.0f, 0.9238795325112867f, 0.7071067811865476f, 0.38268343236508984f, 6.123233995736766e-17f, -0.3826834323650897f, -0.7071067811865475f, -0.9238795325112867f, 0.f, 0.f, 0.f, 0.f, 0.f, 0.f, 0.f, 0.f}, {1.0f, 0.9807852804032304f, 0.9238795325112867f, 0.8314696123025452f, 0.7071067811865476f, 0.5555702330196023f, 0.38268343236508984f, 0.19509032201612833f, 6.123233995736766e-17f, -0.1950903220161282f, -0.3826834323650897f, -0.555570233019602f, -0.7071067811865475f, -0.8314696123025453f, -0.9238795325112867f, -0.9807852804032304f}};
__device__ constexpr float FFT_CW_IM[6][16] = {{0.f, 0.f, 0.f, 0.f, 0.f, 0.f, 0.f, 0.f, 0.f, 0.f, 0.f, 0.f, 0.f, 0.f, 0.f, 0.f}, {-0.0f, 0.f, 0.f, 0.f, 0.f, 0.f, 0.f, 0.f, 0.f, 0.f, 0.f, 0.f, 0.f, 0.f, 0.f, 0.f}, {-0.0f, -1.0f, 0.f, 0.f, 0.f, 0.f, 0.f, 0.f, 0.f, 0.f, 0.f, 0.f, 0.f, 0.f, 0.f, 0.f}, {-0.0f, -0.7071067811865475f, -1.0f, -0.7071067811865476f, 0.f, 0.f, 0.f, 0.f, 0.f, 0.f, 0.f, 0.f, 0.f, 0.f, 0.f, 0.f}, {-0.0f, -0.3826834323650898f, -0.7071067811865475f, -0.9238795325112867f, -1.0f, -0.9238795325112867f, -0.7071067811865476f, -0.3826834323650899f, 0.f, 0.f, 0.f, 0.f, 0.f, 0.f, 0.f, 0.f}, {-0.0f, -0.19509032201612825f, -0.3826834323650898f, -0.5555702330196022f, -0.7071067811865475f, -0.8314696123025452f, -0.9238795325112867f, -0.9807852804032304f, -1.0f, -0.9807852804032304f, -0.9238795325112867f, -0.8314696123025455f, -0.7071067811865476f, -0.5555702330196022f, -0.3826834323650899f, -0.1950903220161286f}};
__host__ __device__ constexpr int fft_bitrev(int k, int R) { int r = 0; for (int i = 0; i < R; ++i) if (k & (1 << i)) r |= 1 << (R - 1 - i); return r; }
template <int R, bool INV>
__device__ __forceinline__ void fft_pass(float2* __restrict__ X, const float2* __restrict__ TW, const int s0, const int gidx) {
    const int lowbits = 13 - s0 - R; const int stride = 1 << lowbits;
    const int low = gidx & (stride - 1), high = gidx >> lowbits; const int base = (high << (lowbits + R)) | low;
    const int p0 = FIDX(base);
#define FFT_SLOT(k) (lowbits >= 4 ? p0 + (k) * (stride + (stride >> 4)) : p0 + (k) + ((k) >> 4))
    float2 v[1 << R];
#pragma unroll
    for (int k = 0; k < (1 << R); ++k) v[k] = X[FFT_SLOT(k)];
    const int lw = low << s0;
    if (!INV) {
#pragma unroll
        for (int j = 0; j < R; ++j) { const int hk = 1 << (R - 1 - j);
#pragma unroll
            for (int k = 0; k < (1 << R); ++k) if (!(k & hk)) { const int kk = k & (hk - 1);
                const float2 a = v[k], b = v[k + hk]; v[k] = make_float2(a.x + b.x, a.y + b.y); const float dx = a.x - b.x, dy = a.y - b.y;
                if (kk == 0) v[k + hk] = make_float2(dx, dy);
                else if (2 * kk == hk) v[k + hk] = make_float2(dy, -dx);
                else { const float cr = FFT_CW_RE[R - j][kk], ci = FFT_CW_IM[R - j][kk]; v[k + hk] = make_float2(dx * cr - dy * ci, dx * ci + dy * cr); } } }
        if (lowbits > 0) {
#pragma unroll
            for (int k = 1; k < (1 << R); ++k) { const float2 w = TW[(lw * fft_bitrev(k, R)) & 8191]; const float2 a = v[k]; v[k] = make_float2(a.x * w.x - a.y * w.y, a.x * w.y + a.y * w.x); } }
    } else {
        if (lowbits > 0) {
#pragma unroll
            for (int k = 1; k < (1 << R); ++k) { const float2 w = TW[(lw * fft_bitrev(k, R)) & 8191]; const float2 a = v[k]; v[k] = make_float2(a.x * w.x + a.y * w.y, a.y * w.x - a.x * w.y); } }
#pragma unroll
        for (int j = R - 1; j >= 0; --j) { const int hk = 1 << (R - 1 - j);
#pragma unroll
            for (int k = 0; k < (1 << R); ++k) if (!(k & hk)) { const int kk = k & (hk - 1);
                const float2 a = v[k], b = v[k + hk]; float tx, ty;
                if (kk == 0) { tx = b.x; ty = b.y; }
                else if (2 * kk == hk) { tx = -b.y; ty = b.x; }
                else { const float cr = FFT_CW_RE[R - j][kk], ci = FFT_CW_IM[R - j][kk]; tx = b.x * cr + b.y * ci; ty = b.y * cr - b.x * ci; }
                v[k] = make_float2(a.x + tx, a.y + ty); v[k + hk] = make_float2(a.x - tx, a.y - ty); } }
    }
#pragma unroll
    for (int k = 0; k < (1 << R); ++k) X[FFT_SLOT(k)] = v[k];
#undef FFT_SLOT
}
__device__ __forceinline__ void fft_fwd(float2* X, const float2* TW, const int tid) {
    fft_pass<4, false>(X, TW, 0, tid); __syncthreads(); fft_pass<4, false>(X, TW, 4, tid); __syncthreads(); if (tid < 256) fft_pass<5, false>(X, TW, 8, tid); __syncthreads(); }
__device__ __forceinline__ void fft_inv(float2* X, const float2* TW, const int tid) {
    if (tid < 256) fft_pass<5, true>(X, TW, 8, tid); __syncthreads(); fft_pass<4, true>(X, TW, 4, tid); __syncthreads(); fft_pass<4, true>(X, TW, 0, tid); __syncthreads(); }
__device__ __forceinline__ void fft_twiddles(float2* TW, const int tid) {
#pragma unroll
    for (int k = 0; k < 16; ++k) { const int m = tid + k * 512; const float xx = (float)m * (1.0f / 4096.0f); TW[m] = make_float2(cospif(xx), -sinpif(xx)); }
}
__device__ __forceinline__ void hyena_spec_item(const int oc, const float* __restrict__ HR, const float* __restrict__ nrm, float2* __restrict__ HSPEC, unsigned char* shm, const int tid) {
    float2* X = (float2*)shm; const float2* TW = (const float2*)(shm + FFT_X_BYTES);
    const int o = oc >> 9, c = oc & 511; const float inv = 1.0f / nrm[oc];
    __syncthreads();
    float hv[16];
#pragma unroll
    for (int k = 0; k < 16; ++k) { const int j = tid + k * 512;
        const unsigned off = j < SEQ ? (unsigned)j * 2048u + o * 1024 + c : j == SEQ ? (unsigned)(o * 1024 + c) : (unsigned)(2 * SEQ - j) * 2048u + o * 1024 + 512 + c;
        hv[k] = HR[off]; }
#pragma unroll
    for (int k = 0; k < 16; ++k) { const int j = tid + k * 512; X[FIDX(j)] = make_float2(j == SEQ ? 0.f : hv[k] * inv, 0.f); }
    __syncthreads();
    fft_fwd(X, TW, tid);
    float4* out = (float4*)(HSPEC + (size_t)oc * 8192 + tid * 16); const float2* xs = X + 17 * tid;
#pragma unroll
    for (int k = 0; k < 8; ++k) { const float2 x0 = xs[2 * k], x1 = xs[2 * k + 1]; out[k] = make_float4(x0.x * (1.0f / 8192.0f), x0.y * (1.0f / 8192.0f), x1.x * (1.0f / 8192.0f), x1.y * (1.0f / 8192.0f)); }
}
__device__ __forceinline__ void fft_mul_spec(float2* X, const float2* __restrict__ H, const int tid) {
    const float4* h4 = (const float4*)(H + tid * 16); float2* xs = X + 17 * tid;
#pragma unroll
    for (int k = 0; k < 8; ++k) { const float4 hv = h4[k]; const float2 x0 = xs[2 * k], x1 = xs[2 * k + 1];
        xs[2 * k] = make_float2(x0.x * hv.x - x0.y * hv.y, x0.x * hv.y + x0.y * hv.x); xs[2 * k + 1] = make_float2(x1.x * hv.z - x1.y * hv.w, x1.x * hv.w + x1.y * hv.z); }
}
__device__ __forceinline__ void hyena_fft_item(const int item, const float* __restrict__ UT, const float2* __restrict__ HSPEC, const float* __restrict__ bias, float* __restrict__ YT, unsigned char* shm, const int tid) {
    float2* X = (float2*)shm; const float2* TW = (const float2*)(shm + FFT_X_BYTES);
    const int c = item >> 1, b0 = (item & 1) * 2, b1 = b0 + 1;
    const float* u0 = UT + (size_t)(b0 * 1536 + c) * SEQ + tid * 8; const float* u1 = UT + (size_t)(b1 * 1536 + c) * SEQ + tid * 8;
    const float bias0 = bias[c], bias1 = bias[512 + c];
    float2* xs = X + FIDX(8 * tid);
    float vr[8], vi[8];
    __syncthreads();
    { const float4 a0 = *(const float4*)u0, a1 = *(const float4*)(u0 + 4), c0 = *(const float4*)u1, c1 = *(const float4*)(u1 + 4);
      vr[0] = a0.x; vr[1] = a0.y; vr[2] = a0.z; vr[3] = a0.w; vr[4] = a1.x; vr[5] = a1.y; vr[6] = a1.z; vr[7] = a1.w;
      vi[0] = c0.x; vi[1] = c0.y; vi[2] = c0.z; vi[3] = c0.w; vi[4] = c1.x; vi[5] = c1.y; vi[6] = c1.z; vi[7] = c1.w; }
#pragma unroll
    for (int k = 0; k < 8; ++k) { xs[k] = make_float2(vr[k], vi[k]); xs[4352 + k] = make_float2(0.f, 0.f); }
    __syncthreads();
    fft_fwd(X, TW, tid);
    fft_mul_spec(X, HSPEC + (size_t)c * 8192, tid);
    __syncthreads();
    fft_inv(X, TW, tid);
    { const float* p0 = u0 + (size_t)512 * SEQ; const float* p1 = u1 + (size_t)512 * SEQ;
      const float4 a0 = *(const float4*)p0, a1 = *(const float4*)(p0 + 4), c0 = *(const float4*)p1, c1 = *(const float4*)(p1 + 4);
      const float xr[8] = {a0.x, a0.y, a0.z, a0.w, a1.x, a1.y, a1.z, a1.w}, xi[8] = {c0.x, c0.y, c0.z, c0.w, c1.x, c1.y, c1.z, c1.w};
#pragma unroll
      for (int k = 0; k < 8; ++k) { const float2 cv = xs[k]; const float zr = xr[k] * (cv.x + bias0 * vr[k]), zi = xi[k] * (cv.y + bias0 * vi[k]);
          vr[k] = zr; vi[k] = zi; xs[k] = make_float2(zr, zi); xs[4352 + k] = make_float2(0.f, 0.f); } }
    __syncthreads();
    fft_fwd(X, TW, tid);
    fft_mul_spec(X, HSPEC + (size_t)(512 + c) * 8192, tid);
    __syncthreads();
    fft_inv(X, TW, tid);
    { const float* p0 = u0 + (size_t)1024 * SEQ; const float* p1 = u1 + (size_t)1024 * SEQ;
      const float4 a0 = *(const float4*)p0, a1 = *(const float4*)(p0 + 4), c0 = *(const float4*)p1, c1 = *(const float4*)(p1 + 4);
      const float xr[8] = {a0.x, a0.y, a0.z, a0.w, a1.x, a1.y, a1.z, a1.w}, xi[8] = {c0.x, c0.y, c0.z, c0.w, c1.x, c1.y, c1.z, c1.w};
      float yr[8], yi[8];
#pragma unroll
      for (int k = 0; k < 8; ++k) { const float2 cv = xs[k]; yr[k] = xr[k] * (cv.x + bias1 * vr[k]); yi[k] = xi[k] * (cv.y + bias1 * vi[k]); }
      float* y0 = YT + (size_t)(b0 * 512 + c) * SEQ + tid * 8; float* y1 = YT + (size_t)(b1 * 512 + c) * SEQ + tid * 8;
      *(float4*)y0 = make_float4(yr[0], yr[1], yr[2], yr[3]); *(float4*)(y0 + 4) = make_float4(yr[4], yr[5], yr[6], yr[7]);
      *(float4*)y1 = make_float4(yi[0], yi[1], yi[2], yi[3]); *(float4*)(y1 + 4) = make_float4(yi[4], yi[5], yi[6], yi[7]); }
}

constexpr size_t al256(size_t x) { return (x + 255) & ~(size_t)255; }
constexpr size_t O_BAR = 0;
constexpr size_t O_MOD = 16384;
constexpr size_t O_NORM = O_MOD + al256((size_t)2 * 5 * 6 * DM * 4);
constexpr size_t O_QCTR = O_NORM + al256((size_t)2 * 2 * 1024 * 4);
constexpr size_t O_ZERO_END = O_QCTR + 512;
constexpr size_t O_XS = O_ZERO_END;
constexpr size_t O_HB = O_XS + al256((size_t)NTOK * DM * 4);
constexpr size_t O_P = O_HB + al256((size_t)NTOK * DM * 2);
constexpr size_t O_WIN = O_P + al256((size_t)NTOK * LDP * 2);
constexpr size_t O_WBR = O_WIN + al256((size_t)LDP * DM * 2);
constexpr size_t O_WOUT = O_WBR + al256((size_t)4 * DM * BW * 2);
constexpr size_t O_WGU = O_WOUT + al256((size_t)DM * DM * 2);
constexpr size_t O_WD = O_WGU + al256((size_t)NEXP * 2 * DEXP * DM * 2);
constexpr size_t O_GLU = O_WD + al256((size_t)NEXP * DM * DEXP * 2);
constexpr size_t O_Y4 = O_GLU + al256((size_t)BW * BW * 2);
constexpr size_t O_U = O_Y4 + al256((size_t)NTOK * DM * 2);
constexpr size_t O_QKB = O_U + al256((size_t)NTOK * 1536 * 4);
constexpr size_t O_CST = O_QKB + al256((size_t)NTOK * 1024 * 2);
constexpr size_t O_NST = O_CST + al256((size_t)32 * 68 * 128 * 128 * 2);
constexpr size_t O_MST = O_NST + al256((size_t)32 * 68 * 128 * 4);
constexpr size_t O_XBC = O_MST + al256((size_t)32 * 68 * 4);
constexpr size_t O_SST = O_XBC + al256((size_t)NTOK * 1024 * 2);
constexpr size_t O_HF = O_SST + al256((size_t)64 * 68 * 64 * 128 * 2);
constexpr size_t O_YF = O_HF + al256((size_t)2 * NTOK * BW * 4);
constexpr size_t O_SF = O_YF + al256((size_t)2 * NTOK * BW * 4);
constexpr size_t O_LDT = O_SF + al256((size_t)2 * NCTX * BW * 4);
constexpr size_t O_AP = O_LDT + al256((size_t)4096 * 16);
constexpr size_t O_BBT = O_AP + al256((size_t)4096 * 33 * 8);
constexpr size_t O_KT = O_BBT + al256((size_t)4096 * 16 * 8);
constexpr size_t O_S5A = O_KT + al256((size_t)32 * 2 * 32 * 256 * 4);
constexpr size_t O_S5B = O_S5A + al256((size_t)32 * 512 * 768 * 2);
constexpr size_t O_XCTX = O_S5B + al256((size_t)32 * 512 * 768 * 2);
constexpr size_t O_Z = O_XCTX + al256((size_t)4 * 32 * 2 * 64 * 8);
constexpr size_t O_HRAW = O_Z + al256((size_t)NTOK * BW * 4);
constexpr size_t O_HSPEC = O_HRAW + al256((size_t)(SEQ + CTXL) * 2048 * 4);
constexpr size_t O_K2C = O_HSPEC + al256((size_t)1024 * 8192 * 8);
constexpr size_t O_GG = O_K2C + al256((size_t)(2 * CTXL) * 1024 * 4);
constexpr size_t O_PROBS = O_GG + al256((size_t)NTOK * BW * 2);
constexpr size_t O_ROWTOK = O_PROBS + al256((size_t)NTOK * 16 * 4);
constexpr size_t O_ROWGATE = O_ROWTOK + al256((size_t)NEXP * MOE_PAD * 4);
constexpr size_t O_INV = O_ROWGATE + al256((size_t)NEXP * MOE_PAD * 4);
constexpr size_t O_NORMP = O_INV + al256((size_t)NTOK * 16 * 4);
constexpr size_t WS_END = O_NORMP + al256((size_t)4 * 256 * 2048 * 4);
constexpr size_t O_XG = O_P;
constexpr size_t O_HID = O_P + al256((size_t)NEXP * MOE_PAD * DM * 2);
constexpr size_t O_YEXP = O_HID + al256((size_t)NEXP * MOE_PAD * DEXP * 2);
static_assert(O_YEXP + (size_t)NEXP * MOE_PAD * DM * 2 <= O_WIN, "MoE temporaries must fit inside P");
static_assert((size_t)NTOK * DM * 2 <= (size_t)NTOK * 1536 * 4, "ACCb must fit inside U");
static_assert((size_t)26214400 + (size_t)2 * 17825792 + (size_t)272 * 256 * 64 * 2 <= (size_t)NTOK * DM * 2, "strip buffers must fit inside HB");
static_assert(WS_END <= (size_t)1851000000, "workspace map exceeds the guaranteed size");

struct Args {
    const float* in[47];
    float* out; unsigned char* ws;
    int ph_lo, ph_hi;
};

__device__ __forceinline__ void conv_tile(const float* __restrict__ src, int ldsrc, int nvalid, int k0, int n0, bf16_t* __restrict__ dst, int lddst, int mode, float* T, int tid) {
    { const int n = tid & 63, kr = tid >> 6;
#pragma unroll
      for (int i = 0; i < 8; ++i) { const int k = i * 8 + kr; T[k * 65 + n] = (n0 + n < nvalid) ? src[(size_t)(k0 + k) * ldsrc + n0 + n] : 0.f; } }
    __syncthreads();
    { const int n = tid >> 3, kc = (tid & 7) * 8; const int gn = n0 + n;
      const int drow = mode == 0 ? gn : (32 * (gn >> 4) + (mode == 2 ? 16 : 0) + (gn & 15));
      u32x4 w; w.x = pk2(T[(kc + 0) * 65 + n], T[(kc + 1) * 65 + n]); w.y = pk2(T[(kc + 2) * 65 + n], T[(kc + 3) * 65 + n]);
      w.z = pk2(T[(kc + 4) * 65 + n], T[(kc + 5) * 65 + n]); w.w = pk2(T[(kc + 6) * 65 + n], T[(kc + 7) * 65 + n]);
      *(u32x4*)(dst + (size_t)drow * lddst + k0 + kc) = w; }
    __syncthreads();
}

#define IN(id) (lo <= (id) && (id) < hi)
#define SEAM(id) do { if (hi > (id) + 1) xcd_barrier(bar); } while (0)
#define PH_BEGIN int tid = threadIdx.x; asm volatile("" : "+v"(tid) :: "memory"); const int lane = tid & 63, wave = tid >> 6; (void)lane; (void)wave;

#define x_in (PT(0))
#define c_in (PT(1))
#define ctx_in (PT(2))
#define cctx_in (PT(3))
#define ada_w (PT(4))
#define ada_b (PT(5))
#define norm_mix (PT(6))
#define norm_ffn (PT(7))
#define w_in (PT(8))
#define XS ((float*)(a.ws + O_XS))
#define MOD ((float*)(a.ws + O_MOD))
#define NORM ((float*)(a.ws + O_NORM))
#define NORMP ((float*)(a.ws + O_NORMP))
#define MODl (MOD + (size_t)l * 5 * 6 * DM)
#define HB ((bf16_t*)(a.ws + O_HB))
#define P ((bf16_t*)(a.ws + O_P))
#define WIN ((bf16_t*)(a.ws + O_WIN))
#define WBR ((bf16_t*)(a.ws + O_WBR))
#define WOUT ((bf16_t*)(a.ws + O_WOUT))
#define WGU ((bf16_t*)(a.ws + O_WGU))
#define WD ((bf16_t*)(a.ws + O_WD))
#define GLU ((bf16_t*)(a.ws + O_GLU))
#define Y4 ((bf16_t*)(a.ws + O_Y4))
#define U ((float*)(a.ws + O_U))
#define ACCb ((bf16_t*)(a.ws + O_U))
#define QKB ((bf16_t*)(a.ws + O_QKB))
#define CST ((bf16_t*)(a.ws + O_CST))
#define NST ((float*)(a.ws + O_NST))
#define MST ((float*)(a.ws + O_MST))
#define XBC ((bf16_t*)(a.ws + O_XBC))
#define SSTB ((bf16_t*)(a.ws + O_SST))
#define HF ((float*)(a.ws + O_HF))
#define HBk (HF + (size_t)NTOK * BW)
#define YF ((float*)(a.ws + O_YF))
#define YB (YF + (size_t)NTOK * BW)
#define SF ((float*)(a.ws + O_SF))
#define SB (SF + (size_t)NCTX * BW)
#define LDT ((double2*)(a.ws + O_LDT))
#define APW ((float2*)(a.ws + O_AP))
#define BBT ((float2*)(a.ws + O_BBT))
#define KTB ((float*)(a.ws + O_KT))
#define S5A ((bf16_t*)(a.ws + O_S5A))
#define S5B ((bf16_t*)(a.ws + O_S5B))
#define XCTX ((float2*)(a.ws + O_XCTX))
#define S5P ((bf16_t*)(a.ws + O_HB))
#define XLOC ((float*)(a.ws + O_HB + (size_t)32 * 256 * 512 * 2))
#define KTG ((bf16_t*)(a.ws + O_HB + (size_t)26214400))
#define VTG ((bf16_t*)(a.ws + O_HB + (size_t)26214400 + (size_t)17825792))
#define BTG ((bf16_t*)(a.ws + O_HB + (size_t)26214400 + (size_t)2 * 17825792))
#define XTG ((bf16_t*)(a.ws + O_GG))
#define Z ((float*)(a.ws + O_Z))
#define HRAW ((float*)(a.ws + O_HRAW))
#define HSPEC ((float2*)(a.ws + O_HSPEC))
#define UT ((float*)(a.ws + O_U))
#define YT ((float*)(a.ws + O_Z))
#define QCTR ((int*)(a.ws + O_QCTR))
#define K2C ((float*)(a.ws + O_K2C))
#define GG ((bf16_t*)(a.ws + O_GG))
#define PROBS ((float*)(a.ws + O_PROBS))
#define ROWTOK ((int*)(a.ws + O_ROWTOK))
#define ROWGATE ((float*)(a.ws + O_ROWGATE))
#define XG ((bf16_t*)(a.ws + O_XG))
#define HID ((bf16_t*)(a.ws + O_HID))
#define YEXP ((bf16_t*)(a.ws + O_YEXP))
#define INV ((int*)(a.ws + O_INV))


__device__ __forceinline__ void moe_pair(float4 (&a)[8], const int r1, const int r2, const float g2scale, const int lane, const float* __restrict__ rowgate, const bf16_t* __restrict__ yexp) {
    const float gt1 = rowgate[r1], gt2 = rowgate[r2] * g2scale;
    const bf16_t* y1 = yexp + (size_t)r1 * DM + lane * 4; const bf16_t* y2 = yexp + (size_t)r2 * DM + lane * 4;
    u32x2 w1[8], w2[8];
#pragma unroll
    for (int i = 0; i < 8; ++i) { w1[i] = *(const u32x2*)(y1 + i * 256); w2[i] = *(const u32x2*)(y2 + i * 256); }
#pragma unroll
    for (int i = 0; i < 8; ++i) {
        a[i].x += gt1 * __uint_as_float(w1[i].x << 16); a[i].y += gt1 * __uint_as_float(w1[i].x & 0xFFFF0000u); a[i].z += gt1 * __uint_as_float(w1[i].y << 16); a[i].w += gt1 * __uint_as_float(w1[i].y & 0xFFFF0000u);
        a[i].x += gt2 * __uint_as_float(w2[i].x << 16); a[i].y += gt2 * __uint_as_float(w2[i].x & 0xFFFF0000u); a[i].z += gt2 * __uint_as_float(w2[i].y << 16); a[i].w += gt2 * __uint_as_float(w2[i].y & 0xFFFF0000u); }
}
__device__ __forceinline__ void moe_combine(float4 (&v)[8], const int tok, const int lane, const int* __restrict__ inv, const float* __restrict__ rowgate, const bf16_t* __restrict__ yexp, const float* __restrict__ m5) {
    float4 a[8], mm[8];
#pragma unroll
    for (int i = 0; i < 8; ++i) { a[i] = make_float4(0.f, 0.f, 0.f, 0.f); mm[i] = *(const float4*)(m5 + i * 256 + lane * 4); }
    const int4* ip = (const int4*)(inv + (size_t)tok * 16);
    const int4 q0 = ip[0], q1 = ip[1], q2 = ip[2], q3 = ip[3];
    const int rows[16] = {q0.x, q0.y, q0.z, q0.w, q1.x, q1.y, q1.z, q1.w, q2.x, q2.y, q2.z, q2.w, q3.x, q3.y, q3.z, q3.w};
    int prow = -1;
#pragma unroll
    for (int e = 0; e < 16; ++e) { const int row = __builtin_amdgcn_readfirstlane(rows[e]);
        if (row >= 0) { if (prow >= 0) { moe_pair(a, prow, row, 1.0f, lane, rowgate, yexp); prow = -1; } else prow = row; } }
    if (prow >= 0) moe_pair(a, prow, prow, 0.0f, lane, rowgate, yexp);
#pragma unroll
    for (int i = 0; i < 8; ++i) { v[i].x += mm[i].x * a[i].x; v[i].y += mm[i].y * a[i].y; v[i].z += mm[i].z * a[i].z; v[i].w += mm[i].w * a[i].w; }
}
struct CvU { const float* src; bf16_t* dst; int ldsrc, nvalid, k0, n0, lddst, mode; };
__device__ __forceinline__ void cv_load(const CvU& u, float4 (&r)[8], const int tid) {
#pragma unroll
    for (int i = 0; i < 8; ++i) { const int idx = tid + i * 512; const int k = idx >> 6, n = u.n0 + (idx & 63) * 4;
        r[i] = (n < u.nvalid) ? *(const float4*)(u.src + (size_t)(u.k0 + k) * u.ldsrc + n) : make_float4(0.f, 0.f, 0.f, 0.f); }
}
__device__ __forceinline__ void cv_stage(float* T, const float4 (&r)[8], const int tid) {
#pragma unroll
    for (int i = 0; i < 8; ++i) { const int idx = tid + i * 512; float* p = T + (idx >> 6) * 257 + (idx & 63) * 4; p[0] = r[i].x; p[1] = r[i].y; p[2] = r[i].z; p[3] = r[i].w; }
}
__device__ __forceinline__ void cv_store(const CvU& u, const float* T, const int tid) {
#pragma unroll
    for (int j = 0; j < 4; ++j) { const int o = tid + j * 512; const int kc = (o & 7) * 8, n = o >> 3; const int gn = u.n0 + n;
        const int drow = u.mode == 0 ? gn : (256 * (gn >> 7) + (u.mode == 2 ? 128 : 0) + (gn & 127));
        const float* t = T + kc * 257 + n;
        u32x4 w; w.x = pk2(t[0], t[257]); w.y = pk2(t[2 * 257], t[3 * 257]); w.z = pk2(t[4 * 257], t[5 * 257]); w.w = pk2(t[6 * 257], t[7 * 257]);
        *(u32x4*)(u.dst + (size_t)drow * u.lddst + u.k0 + kc) = w; }
}
#define CV_RUN(LL, QSTART, QSTEP, QEND) do { \
                const float* wbr = PT(40) + (size_t)(LL) * 4 * BW * DM; const float* wout = PT(41) + (size_t)(LL) * DM * DM; \
                const float* wg = PT(43) + (size_t)(LL) * NEXP * DM * DEXP; const float* wu = PT(44) + (size_t)(LL) * NEXP * DM * DEXP; const float* wd = PT(45) + (size_t)(LL) * NEXP * DEXP * DM; \
                const float* wglu = PT(32) + (size_t)(LL) * BW * BW; const float* win = w_in + (size_t)(LL) * DM * IN_W; \
                const int cv_step = (QSTEP), cv_end = (QEND); \
                __syncthreads(); \
                int q = (QSTART); int buf = 0; CvU u; float4 r[8]; \
                if (q < cv_end) { CV_DECODE(q, u); cv_load(u, r, tid); } \
                while (q < cv_end) { \
                    float* T = sf + buf * (64 * 257); \
                    cv_stage(T, r, tid); \
                    __syncthreads(); \
                    const CvU cur = u; const int qn = q + cv_step; \
                    if (qn < cv_end) { CV_DECODE(qn, u); cv_load(u, r, tid); } \
                    cv_store(cur, T, tid); \
                    buf ^= 1; q = qn; \
                } \
                __syncthreads(); } while (0)
#define CV_DECODE(q_, u_) do { int qq_ = (q_); \
                    if (qq_ < n_win) { u_ = CvU{win, WIN, IN_W, IN_W, (qq_ / 55) * 64, (qq_ % 55) * 256, DM, 0}; } else { qq_ -= n_win; \
                    if (qq_ < n_br) { const int k = qq_ >> 6, r = qq_ & 63; u_ = CvU{wbr + (size_t)k * BW * DM, WBR + (size_t)k * DM * BW, DM, DM, (r >> 3) * 64, (r & 7) * 256, BW, 0}; } else { qq_ -= n_br; \
                    if (qq_ < n_out) { u_ = CvU{wout, WOUT, DM, DM, (qq_ >> 3) * 64, (qq_ & 7) * 256, DM, 0}; } else { qq_ -= n_out; \
                    if (qq_ < n_glu) { u_ = CvU{wglu, GLU, BW, BW, (qq_ >> 1) * 64, (qq_ & 1) * 256, BW, 0}; } else { qq_ -= n_glu; \
                    if (qq_ < n_gu) { const int e = qq_ / 384, r = qq_ % 384, up = r / 192, r2 = r % 192; u_ = CvU{(up ? wu : wg) + (size_t)e * DM * DEXP, WGU + (size_t)e * 2 * DEXP * DM, DEXP, DEXP, (r2 / 6) * 64, (r2 % 6) * 256, DM, 1 + up}; } else { qq_ -= n_gu; \
                    { const int e = qq_ / 192, r = qq_ % 192; u_ = CvU{wd + (size_t)e * DEXP * DM, WD + (size_t)e * DM * DEXP, DM, DM, (r >> 3) * 64, (r & 7) * 256, DEXP, 0}; } } } } } } } while (0)
template <int LAYER>
__device__ __forceinline__ void layer_body(const Args& a, const XcdBarrier& bar, const int lo, const int hi, const int bid, const int G, unsigned char* const shm, float* const sf, const float** const ptab) {
        constexpr int l = LAYER;
        constexpr int PB = 1 + 16 * l;
        const bool lastl = (l == 1);

        const int nPanels = lastl ? 64 : 68;
        const int M2 = nPanels * 256;

        if (IN(PB + 0)) for (int rep_ = 0; rep_ < (l == 0 ? PROBE_REPS(0) : 1); ++rep_) {
            PH_BEGIN
            {   const int n_win = 32 * 55, n_br = 4 * 64, n_out = 32 * 8, n_glu = 16, n_gu = 16 * 2 * 192, n_d = 16 * 192;
                const int n_grp1 = n_win + n_br + n_out + n_glu, total = n_grp1 + n_gu + n_d;
                const int q_lo = (l > 0 && G > 128) ? n_grp1 : 0;
                CV_RUN(l, q_lo + bid, G, total);
            }
            for (int set = 0; set < (lastl ? 1 : 2); ++set) {
                const int L = set ? CTXL : SEQ; float* HR = HRAW + (set ? (size_t)SEQ * 2048 : 0);
                const float* w1 = PT(11) + l * 33 * 64; const float* b1 = PT(12) + l * 64; const float* fr1 = PT(13) + l * 64; const float* w2 = PT(14) + l * 64 * 64; const float* b2 = PT(15) + l * 64;
                const float* fr2 = PT(16) + l * 64; const float* w3 = PT(17) + l * 64 * 2048; const float* decay = PT(18) + l * 2048;
                float* feats = sf; float* h1 = sf + 16 * 33; float* h2 = h1 + 16 * 64;
                float nacc[4] = {0.f, 0.f, 0.f, 0.f};
                for (int base = bid; base < L; base += 16 * G) {
                    __syncthreads();
                    for (int e = tid; e < 16 * 33; e += NTHR) { const int ti = e / 33, fi = e % 33; int t = base + ti * G; if (t > L - 1) t = L - 1;
                        float v;
                        if (fi == 0) v = (float)t / (float)(L - 1);
                        else { const int j = (fi - 1) & 15; const double fr = 1e-4 + (double)j * ((15.0 - 1e-4) / 15.0); const double ang = (2.0 * 3.14159265358979323846 / (double)L) * (double)t * fr; v = fi <= 16 ? (float)cos(ang) : (float)(-sin(ang)); }
                        feats[e] = v; }
                    __syncthreads();
                    { const int j = tid & 63, ti = tid >> 6; float s0 = b1[j], s1 = s0;
_Pragma("unroll 3")
                      for (int i = 0; i < 33; ++i) { const float wv = w1[i * 64 + j]; s0 += feats[ti * 33 + i] * wv; s1 += feats[(ti + 8) * 33 + i] * wv; }
                      const float f1 = fr1[j]; h1[ti * 64 + j] = sinf(f1 * s0); h1[(ti + 8) * 64 + j] = sinf(f1 * s1); }
                    __syncthreads();
                    { const int j = tid & 63, ti = tid >> 6; float s0 = b2[j], s1 = s0;
_Pragma("unroll 4")
                      for (int i = 0; i < 64; ++i) { const float wv = w2[i * 64 + j]; s0 += h1[ti * 64 + i] * wv; s1 += h1[(ti + 8) * 64 + i] * wv; }
                      const float f2 = fr2[j]; h2[ti * 64 + j] = sinf(f2 * s0); h2[(ti + 8) * 64 + j] = sinf(f2 * s1); }
                    __syncthreads();
                    float acc[16][4];
#pragma unroll
                    for (int ti = 0; ti < 16; ++ti) { acc[ti][0] = 0.f; acc[ti][1] = 0.f; acc[ti][2] = 0.f; acc[ti][3] = 0.f; }
#pragma unroll 2
                    for (int i = 0; i < 64; ++i) { const float* wrow = w3 + (size_t)i * 2048 + tid; const float wa = wrow[0], wb = wrow[512], wc2 = wrow[1024], wd2 = wrow[1536];
#pragma unroll
                        for (int ti = 0; ti < 16; ++ti) { const float hv = h2[ti * 64 + i]; acc[ti][0] += hv * wa; acc[ti][1] += hv * wb; acc[ti][2] += hv * wc2; acc[ti][3] += hv * wd2; } }
                    float dk[4];
#pragma unroll
                    for (int k = 0; k < 4; ++k) dk[k] = fabsf(decay[tid + k * 512]);
#pragma unroll
                    for (int ti = 0; ti < 16; ++ti) { const int t = base + ti * G; if (t < L) { const float tn = (float)t / (float)(L - 1);
#pragma unroll
                        for (int k = 0; k < 4; ++k) { const float v = acc[ti][k] * expf(-tn * dk[k]); HR[(size_t)t * 2048 + tid + k * 512] = v; nacc[k] += fabsf(v); } } }
                }
                float* nrp = NORMP + ((size_t)(l * 2 + set) * 256 + bid) * 2048;
#pragma unroll
                for (int k = 0; k < 4; ++k) nrp[tid + k * 512] = nacc[k];
            }
            for (int idx = bid * NTHR + tid; idx < 4096; idx += G * NTHR) { const int n = idx & 63, g = (idx >> 6) & 31, dir = idx >> 11;
                const double are = (double)(PT(24) + l * 4096)[idx], aim = (double)(PT(25) + l * 4096)[idx]; const double lam = are < -1e-4 ? are : -1e-4; const double dt = exp((double)(PT(26) + l * 64)[dir * 32 + g]);
                const double ldre = lam * dt, ldim = aim * dt; LDT[idx] = make_double2(ldre, ldim);
                const double mag = exp(ldre); const double ar = mag * cos(ldim), ai = mag * sin(ldim);
                const double den = lam * lam + aim * aim; const double nr = ar - 1.0, ni = ai; const double fre = (nr * lam + ni * aim) / den, fim = (ni * lam - nr * aim) / den;
                const float* b_re = PT(27) + l * 32 * 64 * 16; const float* b_im = PT(28) + l * 32 * 64 * 16;
#pragma unroll 4
                for (int c = 0; c < 16; ++c) { const double br = (double)b_re[(g * 64 + n) * 16 + c], bi = (double)b_im[(g * 64 + n) * 16 + c]; BBT[idx * 16 + c] = make_float2((float)(fre * br - fim * bi), (float)(fre * bi + fim * br)); }
            }
            for (int e2 = bid * NTHR + tid; e2 < 4096 * 33; e2 += G * NTHR) { const int idx = e2 / 33, k = e2 - idx * 33; const int g = (idx >> 6) & 31, dir = idx >> 11;
                const double are = (double)(PT(24) + l * 4096)[idx], aim = (double)(PT(25) + l * 4096)[idx]; const double lam = are < -1e-4 ? are : -1e-4; const double dt = exp((double)(PT(26) + l * 64)[dir * 32 + g]);
                const double ldre = lam * dt, ldim = aim * dt; const double mk = exp(ldre * k); APW[e2] = make_float2((float)(mk * cos(ldim * k)), (float)(mk * sin(ldim * k))); }
            if (l == 0 && lo == 0) xcd_barrier(bar);
            for (int tok = bid * 8 + wave; tok < NTOK; tok += G * 8) {
                const int r = tok < NLAT ? tok / SEQ : 4; const float* xr = l == 0 ? (tok < NLAT ? x_in + (size_t)tok * DM : ctx_in + (size_t)(tok - NLAT) * DM) : XS + (size_t)tok * DM; const float* gn = norm_mix + l * DM;
                const float* sh = MODl + (size_t)(r * 6 + 0) * DM; const float* sc = MODl + (size_t)(r * 6 + 1) * DM;
                float4 v[8]; float ss = 0.f;
#pragma unroll
                for (int i = 0; i < 8; ++i) v[i] = *(const float4*)(xr + i * 256 + lane * 4);
                if (l > 0) {
                    moe_combine(v, tok, lane, INV, ROWGATE, YEXP, MOD + (size_t)((l - 1) * 5 + r) * 6 * DM + 5 * DM);
#pragma unroll
                    for (int i = 0; i < 8; ++i) *(float4*)(XS + (size_t)tok * DM + i * 256 + lane * 4) = v[i]; }
#pragma unroll
                for (int i = 0; i < 8; ++i) ss += v[i].x * v[i].x + v[i].y * v[i].y + v[i].z * v[i].z + v[i].w * v[i].w;
                ss = wave_sum(ss); const float rs = rsqrtf(ss * (1.0f / DM) + 1e-6f);
#pragma unroll
                for (int i = 0; i < 8; ++i) { const int d = i * 256 + lane * 4; const float4 g4 = *(const float4*)(gn + d), s4 = *(const float4*)(sc + d), h4 = *(const float4*)(sh + d);
                    v[i].x = v[i].x * rs * g4.x * (1.f + s4.x) + h4.x; v[i].y = v[i].y * rs * g4.y * (1.f + s4.y) + h4.y; v[i].z = v[i].z * rs * g4.z * (1.f + s4.z) + h4.z; v[i].w = v[i].w * rs * g4.w * (1.f + s4.w) + h4.w; }
#pragma unroll
                for (int i = 0; i < 8; ++i) { u32x2 w; w.x = pk2(v[i].x, v[i].y); w.y = pk2(v[i].z, v[i].w); *(u32x2*)(HB + (size_t)tok * DM + i * 256 + lane * 4) = w; }
            }
            SEAM(PB + 0);
        }

        if (IN(PB + 1)) for (int rep_ = 0; rep_ < PROBE_REPS(1); ++rep_) {
            PH_BEGIN
            for (int base = bid * 8; base < (lastl ? 1 : 2) * 1024; base += G * 8) {
                const int idx = base + (tid & 7), sl = tid >> 3; const int set = idx >> 10, oc = idx & 1023, o = oc >> 9, c = oc & 511;
                const float* pp = NORMP + (size_t)(l * 2 + set) * 256 * 2048 + o * 1024 + c + (size_t)(sl * 4) * 2048; float sacc = 0.f;
#pragma unroll
                for (int j = 0; j < 4; ++j) { const float p0 = pp[(size_t)j * 2048], p1 = pp[(size_t)j * 2048 + 512]; sacc += (sl * 4 + j < G) ? p0 + p1 : 0.f; }
                sf[sl * 8 + (tid & 7)] = sacc; __syncthreads();
                if (tid < 8) { float t = 0.f;
#pragma unroll 8
                    for (int q = 0; q < 64; ++q) t += sf[q * 8 + tid];
                    NORM[(size_t)(l * 2 + set) * 1024 + oc] = t; }
                __syncthreads(); }
            for (int idx = (G - 1 - bid) * NTHR + tid; idx < 32768; idx += G * NTHR) { const int c = idx & 15, lag = (idx >> 4) & 31, dir = (idx >> 9) & 1, g = idx >> 10;
                const float* c_re = PT(29) + l * 32 * 16 * 64 + (g * 16 + c) * 64; const float* c_im = PT(30) + l * 32 * 16 * 64 + (g * 16 + c) * 64;
                float acc[16];
#pragma unroll
                for (int j = 0; j < 16; ++j) acc[j] = 0.f;
#pragma unroll 2
                for (int n = 0; n < 64; ++n) { const int pi = (dir * 32 + g) * 64 + n; const float2 ap = APW[pi * 33 + lag]; const float cr = c_re[n], ci = c_im[n]; const float wr_ = cr * ap.x - ci * ap.y, wi_ = cr * ap.y + ci * ap.x;
                    const float4* bb = (const float4*)(BBT + pi * 16);
#pragma unroll
                    for (int j = 0; j < 8; ++j) { const float4 b2 = bb[j]; acc[2 * j] += wr_ * b2.x - wi_ * b2.y; acc[2 * j + 1] += wr_ * b2.z - wi_ * b2.w; } }
                float4* o = (float4*)(KTB + (size_t)idx * 16);
                o[0] = make_float4(acc[0], acc[1], acc[2], acc[3]); o[1] = make_float4(acc[4], acc[5], acc[6], acc[7]); o[2] = make_float4(acc[8], acc[9], acc[10], acc[11]); o[3] = make_float4(acc[12], acc[13], acc[14], acc[15]);
            }
            __syncthreads();
            pg8::Gemm g{HB, WIN, DM, DM, DM}; pg8::SchedStd S{68, 55, G, bid, DM, DM}; pg8::EpiWin E{P, LDP};
            pg8::gemm_phase(( LAS unsigned char*)shm, g, S, E);
#if defined(PROBE_BNOEPI)
            { __syncthreads(); pg8::EpiNone E0; pg8::gemm_phase((LAS unsigned char*)shm, g, S, E0); }
#endif
            SEAM(PB + 1);
        }

        if (IN(PB + 2)) for (int rep_ = 0; rep_ < PROBE_REPS(2); ++rep_) {
            PH_BEGIN
            const float* hcw = PT(9) + l * 3 * 1536; const float* hcb = PT(10) + l * 1536; const float* mcw = PT(20) + l * 3 * 1024; const float* mcb = PT(21) + l * 1024;
            const float* scw = PT(34) + l * 3 * 1024; const float* scb = PT(35) + l * 1024;
            for (int unit = bid; unit < 272 * 3; unit += G) { const int seg = unit / 3, kind = unit % 3; const bool lat = seg < 256; const size_t tok0 = lat ? (size_t)seg * 64 : (size_t)NLAT + (size_t)(seg - 256) * 64;
                if (kind < 2) { const int hf = kind;
                    const int c = tid * 2; const int col = (hf ? SSD_OFF + 512 : ML_OFF) + c; const float* w = hf ? scw : mcw; const float* bsp = hf ? scb : mcb; bf16_t* dst = (hf ? XBC : QKB) + tok0 * 1024 + c;
                    const float2 w0 = *(const float2*)(w + c), w1 = *(const float2*)(w + 1024 + c), w2 = *(const float2*)(w + 2048 + c), bb = *(const float2*)(bsp + c);
                    const float osc = (!hf && c >= 512) ? 0.08838834764831845f : 1.0f;
                    const bool hasPrev = !lat && ((tok0 - NLAT) & (CTXL - 1)) != 0, hasNext = !lat && (((tok0 - NLAT) + 63) & (CTXL - 1)) != CTXL - 1;
                    bf16_t* strip = nullptr;
                    if (!hf) { if (c >= 512) strip = KTG + ((size_t)seg * 512 + (c - 512)) * 64; }
                    else { if (c < 512) strip = XTG + ((size_t)seg * 512 + c) * 64; else if (c < 768) strip = BTG + ((size_t)seg * 256 + (c - 512)) * 64; }
                    const bf16_t* pp = P + tok0 * LDP + col;
                    unsigned raw[66];
#pragma unroll
                    for (int t = 0; t < 66; ++t) raw[t] = ((t == 0 && !hasPrev) || (t == 65 && !hasNext)) ? 0u : *(const unsigned*)(pp + (ptrdiff_t)(t - 1) * LDP);
#pragma unroll
                    for (int t8 = 0; t8 < 8; ++t8) { float v0[8], v1[8];
#pragma unroll
                        for (int tt = 0; tt < 8; ++tt) { const int t = t8 * 8 + tt; const unsigned p0 = raw[t], p1 = raw[t + 1], p2 = raw[t + 2];
                            float a0 = bb.x + w0.x * __uint_as_float(p0 << 16) + w1.x * __uint_as_float(p1 << 16) + w2.x * __uint_as_float(p2 << 16);
                            float a1 = bb.y + w0.y * __uint_as_float(p0 & 0xFFFF0000u) + w1.y * __uint_as_float(p1 & 0xFFFF0000u) + w2.y * __uint_as_float(p2 & 0xFFFF0000u);
                            a0 = siluf_(a0) * osc; a1 = siluf_(a1) * osc; v0[tt] = a0; v1[tt] = a1;
                            *(unsigned*)(dst + (size_t)t * 1024) = pk2(a0, a1); }
                        if (strip) { u32x4 s0, s1; s0.x = pk2(v0[0], v0[1]); s0.y = pk2(v0[2], v0[3]); s0.z = pk2(v0[4], v0[5]); s0.w = pk2(v0[6], v0[7]); s1.x = pk2(v1[0], v1[1]); s1.y = pk2(v1[2], v1[3]); s1.z = pk2(v1[4], v1[5]); s1.w = pk2(v1[6], v1[7]);
                            *(u32x4*)(strip + t8 * 8) = s0; *(u32x4*)(strip + 64 + t8 * 8) = s1; } }
                } else {
                    const int c = (tid & 255) * 2, th = tid >> 8; const bf16_t* pp = P + (tok0 + th * 32) * LDP + ML_OFF + 1024 + c; bf16_t* strip = VTG + ((size_t)seg * 512 + c) * 64 + th * 32;
                    unsigned rv[32];
#pragma unroll
                    for (int t = 0; t < 32; ++t) rv[t] = *(const unsigned*)(pp + (size_t)t * LDP);
#pragma unroll
                    for (int t8 = 0; t8 < 4; ++t8) { u32x4 s0, s1;
                        s0.x = (rv[t8 * 8 + 0] & 0xFFFFu) | (rv[t8 * 8 + 1] << 16); s0.y = (rv[t8 * 8 + 2] & 0xFFFFu) | (rv[t8 * 8 + 3] << 16); s0.z = (rv[t8 * 8 + 4] & 0xFFFFu) | (rv[t8 * 8 + 5] << 16); s0.w = (rv[t8 * 8 + 6] & 0xFFFFu) | (rv[t8 * 8 + 7] << 16);
                        s1.x = (rv[t8 * 8 + 0] >> 16) | (rv[t8 * 8 + 1] & 0xFFFF0000u); s1.y = (rv[t8 * 8 + 2] >> 16) | (rv[t8 * 8 + 3] & 0xFFFF0000u); s1.z = (rv[t8 * 8 + 4] >> 16) | (rv[t8 * 8 + 5] & 0xFFFF0000u); s1.w = (rv[t8 * 8 + 6] >> 16) | (rv[t8 * 8 + 7] & 0xFFFF0000u);
                        *(u32x4*)(strip + t8 * 8) = s0; *(u32x4*)(strip + 64 + t8 * 8) = s1; }
                }
            }
            if (!lastl) for (int tok = NLAT + bid; tok < NTOK; tok += G) {
                const int t = (tok - NLAT) & (CTXL - 1); const bool hasL = (t != 0), hasR = (t != CTXL - 1); const bf16_t* pr = P + (size_t)tok * LDP;
                const bf16_t* prL = hasL ? pr - LDP : pr; const bf16_t* prR = hasR ? pr + LDP : pr;
                unsigned xc[3], xl[3], xr[3];
#pragma unroll
                for (int j = 0; j < 3; ++j) { const int cc = tid + j * 512; xc[j] = pr[HY_OFF + cc]; xl[j] = prL[HY_OFF + cc]; xr[j] = prR[HY_OFF + cc]; }
#pragma unroll
                for (int j = 0; j < 3; ++j) { const int cc = tid + j * 512;
                    float acc = hcb[cc] + hcw[1536 + cc] * __uint_as_float(xc[j] << 16);
                    acc += hasL ? hcw[cc] * __uint_as_float(xl[j] << 16) : 0.f;
                    acc += hasR ? hcw[2 * 1536 + cc] * __uint_as_float(xr[j] << 16) : 0.f;
                    U[(size_t)tok * 1536 + cc] = acc; }
            }
            for (int idx0 = bid * NTHR + tid; idx0 < 16384 * 64; idx0 += 4 * G * NTHR) { u32x4 t4[4];
#pragma unroll
                for (int q = 0; q < 4; ++q) { const int idx = idx0 + q * G * NTHR; const int half = idx & 1, g = (idx >> 1) & 31, tok = idx >> 6;
                    if (idx < 16384 * 64) t4[q] = *(const u32x4*)(P + (size_t)tok * LDP + S5_OFF + g * 16 + half * 8); }
#pragma unroll
                for (int q = 0; q < 4; ++q) { const int idx = idx0 + q * G * NTHR; const int half = idx & 1, g = (idx >> 1) & 31, tok = idx >> 6;
                    if (idx < 16384 * 64) *(u32x4*)(S5A + ((size_t)g * 512 + (tok >> 5)) * 768 + (tok & 31) * 16 + half * 8) = t4[q]; } }
            for (int idx = bid * NTHR + tid; idx < 32 * 512 * 32 * 2; idx += G * NTHR) { const int half = idx & 1, sI = (idx >> 1) & 31, row = (idx >> 6) & 511, g = idx >> 15; const int t = row >> 4, c = row & 15; const int lag = t - sI;
                float v[8];
                if (lag > 0) { const float4* k4 = (const float4*)(KTB + ((size_t)((g * 2 + 0) * 32 + lag) * 16 + c) * 16 + half * 8); const float4 a0 = k4[0], a1 = k4[1]; v[0] = a0.x; v[1] = a0.y; v[2] = a0.z; v[3] = a0.w; v[4] = a1.x; v[5] = a1.y; v[6] = a1.z; v[7] = a1.w; }
                else if (lag < 0) { const float4* k4 = (const float4*)(KTB + ((size_t)((g * 2 + 1) * 32 - lag) * 16 + c) * 16 + half * 8); const float4 a0 = k4[0], a1 = k4[1]; v[0] = a0.x; v[1] = a0.y; v[2] = a0.z; v[3] = a0.w; v[4] = a1.x; v[5] = a1.y; v[6] = a1.z; v[7] = a1.w; }
                else { const float4* k4 = (const float4*)(KTB + ((size_t)((g * 2 + 0) * 32) * 16 + c) * 16 + half * 8); const float4* q4 = (const float4*)(KTB + ((size_t)((g * 2 + 1) * 32) * 16 + c) * 16 + half * 8); const float4 a0 = k4[0], a1 = k4[1], b0 = q4[0], b1 = q4[1];
                    v[0] = a0.x + b0.x; v[1] = a0.y + b0.y; v[2] = a0.z + b0.z; v[3] = a0.w + b0.w; v[4] = a1.x + b1.x; v[5] = a1.y + b1.y; v[6] = a1.z + b1.z; v[7] = a1.w + b1.w; }
                u32x4 w; w.x = pk2(v[0], v[1]); w.y = pk2(v[2], v[3]); w.z = pk2(v[4], v[5]); w.w = pk2(v[6], v[7]);
                *(u32x4*)(S5B + ((size_t)g * 512 + row) * 768 + sI * 16 + half * 8) = w; }
            for (int idx = bid * NTHR + tid; idx < 32 * 512 * 64; idx += G * NTHR) { const int n = idx & 63, row = (idx >> 6) & 511, g = idx >> 15; const int t = row >> 4, c = row & 15;
                const float cr = (PT(29) + l * 32 * 16 * 64)[(g * 16 + c) * 64 + n], ci = (PT(30) + l * 32 * 16 * 64)[(g * 16 + c) * 64 + n];
                const float2 af = APW[((0 * 32 + g) * 64 + n) * 33 + t + 1], ab = APW[((1 * 32 + g) * 64 + n) * 33 + 32 - t];
                bf16_t* d = S5B + ((size_t)g * 512 + row) * 768 + 512 + 2 * n;
                *(unsigned*)d = pk2(cr * af.x - ci * af.y, -(cr * af.y + ci * af.x)); *(unsigned*)(d + 128) = pk2(cr * ab.x - ci * ab.y, -(cr * ab.y + ci * ab.x)); }
            for (int idx = bid * NTHR + tid; idx < 32 * 2 * 64 * 32; idx += G * NTHR) { const int sI = idx & 31, n = (idx >> 5) & 63, dir = (idx >> 11) & 1, g = idx >> 12; const int pi = (dir * 32 + g) * 64 + n;
                const float2 pw = APW[pi * 33 + (dir ? sI : 31 - sI)]; const float4* bb = (const float4*)(BBT + pi * 16);
                float re[16], im[16];
#pragma unroll
                for (int j = 0; j < 8; ++j) { const float4 b2 = bb[j]; re[2 * j] = pw.x * b2.x - pw.y * b2.y; im[2 * j] = pw.x * b2.y + pw.y * b2.x; re[2 * j + 1] = pw.x * b2.z - pw.y * b2.w; im[2 * j + 1] = pw.x * b2.w + pw.y * b2.z; }
                bf16_t* d = S5P + ((size_t)g * 256 + dir * 128 + 2 * n) * 512 + sI * 16;
                u32x4 w0, w1; w0.x = pk2(re[0], re[1]); w0.y = pk2(re[2], re[3]); w0.z = pk2(re[4], re[5]); w0.w = pk2(re[6], re[7]); w1.x = pk2(re[8], re[9]); w1.y = pk2(re[10], re[11]); w1.z = pk2(re[12], re[13]); w1.w = pk2(re[14], re[15]);
                *(u32x4*)d = w0; *(u32x4*)(d + 8) = w1;
                w0.x = pk2(im[0], im[1]); w0.y = pk2(im[2], im[3]); w0.z = pk2(im[4], im[5]); w0.w = pk2(im[6], im[7]); w1.x = pk2(im[8], im[9]); w1.y = pk2(im[10], im[11]); w1.z = pk2(im[12], im[13]); w1.w = pk2(im[14], im[15]);
                *(u32x4*)(d + 512) = w0; *(u32x4*)(d + 520) = w1; }
            {   float* T = sf;
                for (int unit = bid; unit < 4 * 64 * 24; unit += G) { const int b = unit / (64 * 24), r = (unit / 24) % 64, c0 = (unit % 24) * 64; const size_t tok0 = (size_t)b * SEQ + r * 64;
                    __syncthreads();
#pragma unroll
                    for (int i = 0; i < 8; ++i) { const int c = tid & 63, t = (tid >> 6) + 8 * i; T[t * 65 + c] = bf2f(P[(tok0 + t) * LDP + HY_OFF + c0 + c]); }
                    __syncthreads();
                    const int c = tid >> 3, tq = (tid & 7) * 8, cc = c0 + c; const float w0 = hcw[cc], w1 = hcw[1536 + cc], w2 = hcw[3072 + cc], bb = hcb[cc];
                    float o8[8];
#pragma unroll
                    for (int i = 0; i < 8; ++i) { const int t = tq + i; float acc = bb + w1 * T[t * 65 + c]; if (t > 0) acc += w0 * T[(t - 1) * 65 + c]; if (t < 63) acc += w2 * T[(t + 1) * 65 + c]; o8[i] = acc; }
                    float* dst = UT + ((size_t)b * 1536 + cc) * SEQ + r * 64 + tq;
                    *(float4*)dst = make_float4(o8[0], o8[1], o8[2], o8[3]); *(float4*)(dst + 4) = make_float4(o8[4], o8[5], o8[6], o8[7]);
                } }
            if (!lastl) {
                const int L = CTXL; const float* HR = HRAW + (size_t)SEQ * 2048; float* K2 = K2C; const float* nrm = NORM + (size_t)(l * 2 + 1) * 1024;
                const size_t total = (size_t)(2 * L - 1) * 1024;
                for (size_t i = (size_t)bid * NTHR + tid; i < total; i += (size_t)G * NTHR) { const int j = (int)(i >> 10), oc = (int)(i & 1023), o = oc >> 9, c = oc & 511; const int lag = j - (L - 1);
                    const float v = lag >= 0 ? HR[(size_t)lag * 2048 + o * 1024 + c] : HR[(size_t)(-lag) * 2048 + o * 1024 + 512 + c];
                    K2[((size_t)j * 2 + o) * 512 + c] = v / nrm[oc]; }
            }
            {   __syncthreads(); fft_twiddles((float2*)(shm + FFT_X_BYTES), tid);
                for (int oc = bid; oc < 1024; oc += G) hyena_spec_item(oc, HRAW, NORM + (size_t)(l * 2 + 0) * 1024, HSPEC, shm, tid);
                __syncthreads(); }
            SEAM(PB + 2);
        }

        if (IN(PB + 3)) for (int rep_ = 0; rep_ < PROBE_REPS(3); ++rep_) {
            PH_BEGIN
            if (rep_ > 0) { if (bid == 0 && tid == 0) __hip_atomic_store(QCTR + l * 64, 0, __ATOMIC_RELAXED, __HIP_MEMORY_SCOPE_AGENT); xcd_barrier(bar); }
            if (bid < 64) {
                mlstm_state_pass(bid >> 1, bid & 1, P, KTG, VTG, PT(22) + l * 16, CST, NST, MST, shm, tid);
            } else if (bid < 128) {
                { const int ch = bid - 64; const int dir_ = ch & 1, h_ = (ch >> 1) & 7; ssd_state_pass(ch, P, BTG, XTG, -expf(PT(37)[l * 16 + dir_ * 8 + h_]), PT(36)[l * 16 + dir_ * 8 + h_], SSTB, shm, tid); }
            } else if (bid < 160) {
                const int widx = (bid - 128) * 8 + wave; const int dir = widx & 1, g = (widx >> 1) & 31, b = widx >> 6; const int n = lane;
                float2* xb = (float2*)(shm + (size_t)wave * 16640); float2* ctab = xb + 16 * 65;
                const float* a_re = PT(24) + l * 2 * 32 * 64; const float* a_im = PT(25) + l * 2 * 32 * 64; const float* log_dt = PT(26) + l * 64;
                const float* b_re = PT(27) + l * 32 * 64 * 16; const float* b_im = PT(28) + l * 32 * 64 * 16; const float* c_re = PT(29) + l * 32 * 16 * 64; const float* c_im = PT(30) + l * 32 * 16 * 64;
#pragma unroll
                for (int c = 0; c < 16; ++c) ctab[c * 65 + lane] = make_float2(c_re[(g * 16 + c) * 64 + lane], c_im[(g * 16 + c) * 64 + lane]);
                float abr, abi, bbr[16], bbi[16];
                {   const double are = (double)a_re[(dir * 32 + g) * 64 + n], aim = (double)a_im[(dir * 32 + g) * 64 + n];
                    const double lam = are < -1e-4 ? are : -1e-4; const double dt = exp((double)log_dt[dir * 32 + g]);
                    const double mag = exp(lam * dt); const double ar = mag * cos(aim * dt), ai = mag * sin(aim * dt);
                    const double den = lam * lam + aim * aim; const double nr = ar - 1.0, ni = ai;
                    const double fre = (nr * lam + ni * aim) / den, fim = (ni * lam - nr * aim) / den;
                    abr = (float)ar; abi = (float)ai;
#pragma unroll
                    for (int c = 0; c < 16; ++c) { const double br = (double)b_re[(g * 64 + n) * 16 + c], bi = (double)b_im[(g * 64 + n) * 16 + c]; bbr[c] = (float)(fre * br - fim * bi); bbi[c] = (float)(fre * bi + fim * br); }
                }
                float xr = 0.f, xi = 0.f; float* Sout = (dir ? SB : SF) - (size_t)NLAT * BW;
                const int s = lane >> 2, cg = lane & 3;
                for (int i0 = 0; i0 < CTXL; i0 += 16) {
#pragma unroll 4
                    for (int ss = 0; ss < 16; ++ss) {
                        const size_t tok = (size_t)step_tok(b, dir, i0 + ss);
                        const u32x4* up = (const u32x4*)(P + tok * LDP + S5_OFF + g * 16);
                        float t0[8], t1[8]; unpack8(up[0], t0); unpack8(up[1], t1);
                        float bur = 0.f, bui = 0.f;
#pragma unroll
                        for (int c = 0; c < 8; ++c) { bur += t0[c] * bbr[c] + t1[c] * bbr[8 + c]; bui += t0[c] * bbi[c] + t1[c] * bbi[8 + c]; }
                        const float nxr = abr * xr - abi * xi + bur, nxi = abr * xi + abi * xr + bui; xr = nxr; xi = nxi;
                        xb[ss * 65 + lane] = make_float2(xr, xi);
                    }
                    asm volatile("s_waitcnt lgkmcnt(0)" ::: "memory");
                    float y0 = 0.f, y1 = 0.f, y2 = 0.f, y3 = 0.f;
                    for (int nn2 = 0; nn2 < 64; ++nn2) { const float2 xv = xb[s * 65 + nn2];
                        const float2 c0 = ctab[(cg * 4 + 0) * 65 + nn2], c1 = ctab[(cg * 4 + 1) * 65 + nn2], c2 = ctab[(cg * 4 + 2) * 65 + nn2], c3 = ctab[(cg * 4 + 3) * 65 + nn2];
                        y0 += xv.x * c0.x - xv.y * c0.y; y1 += xv.x * c1.x - xv.y * c1.y; y2 += xv.x * c2.x - xv.y * c2.y; y3 += xv.x * c3.x - xv.y * c3.y; }
                    const size_t toks = (size_t)step_tok(b, dir, i0 + s);
                    *(float4*)(Sout + toks * BW + g * 16 + cg * 4) = make_float4(y0, y1, y2, y3);
                    asm volatile("s_waitcnt lgkmcnt(0)" ::: "memory");
                }
                XCTX[((b * 32 + g) * 2 + dir) * 64 + n] = make_float2(xr, xi);
            } else {
                if (bid < 224) {
                    pg8::Gemm gg_{S5A, S5P, 768, 512, 512}; pg8::SchedS5a S_{bid - 160}; pg8::EpiXloc E_{XLOC};
                    pg8::gemm_phase((LAS unsigned char*)shm, gg_, S_, E_);
                    __syncthreads();
                }
                const int nhb = G - 160, hb = bid - 160; const float* bias = PT(19) + l * 1024; const int c = tid;
                const int nitems = lastl ? 0 : 4 * (CTXL / 8);
                for (int it = hb; it < nitems; it += nhb) {
                    int L, tokbase, b, t0; const float* K2;
                    { const int q = it; L = CTXL; tokbase = NLAT; b = q / (CTXL / 8); t0 = (q % (CTXL / 8)) * 8; K2 = K2C; }
                    const float* zb = U + (size_t)(tokbase + b * L) * 1536 + c;
                    float acc[8];
#pragma unroll
                    for (int i = 0; i < 8; ++i) acc[i] = 0.f;
                    const int base = t0 + L - 1;
                    for (int s = 0; s < L; s += 8) {
                        float k[15];
#pragma unroll
                        for (int mm = 0; mm < 15; ++mm) k[mm] = K2[((size_t)(base - s - 7 + mm) * 2 + 0) * 512 + c];
#pragma unroll
                        for (int ds = 0; ds < 8; ++ds) { const float z = zb[(size_t)(s + ds) * 1536];
#pragma unroll
                            for (int i = 0; i < 8; ++i) acc[i] += k[i - ds + 7] * z; }
                    }
#pragma unroll
                    for (int i = 0; i < 8; ++i) { const size_t tok = (size_t)(tokbase + b * L + t0 + i); const float zt = U[tok * 1536 + c]; Z[tok * BW + c] = (acc[i] + bias[c] * zt) * U[tok * 1536 + 512 + c]; }
                }
            }
            {   __syncthreads(); fft_twiddles((float2*)(shm + FFT_X_BYTES), tid);
                int* qslot = (int*)(shm + FFT_X_BYTES + 65536);
                for (;;) { __syncthreads(); if (tid == 0) *qslot = atomicAdd(QCTR + l * 64, 1); __syncthreads(); const int it = *qslot; if (it >= 1024) break;
                    hyena_fft_item(it, UT, HSPEC, PT(19) + l * 1024, YT, shm, tid); }
            }
            SEAM(PB + 3);
        }

        if (IN(PB + 4)) for (int rep_ = 0; rep_ < PROBE_REPS(4); ++rep_) {
            PH_BEGIN
            if (rep_ > 0) { if (bid == 0 && tid == 0) __hip_atomic_store(QCTR + l * 64 + 32, 0, __ATOMIC_RELAXED, __HIP_MEMORY_SCOPE_AGENT); xcd_barrier(bar); }
            if (bid >= G - 32) for (int idx = (bid - (G - 32)) * NTHR + tid; idx < 16384; idx += 32 * NTHR) { const int n = idx & 63, dir = (idx >> 6) & 1, b = (idx >> 7) & 3, g = idx >> 9;
                const float2 a32 = APW[((dir * 32 + g) * 64 + n) * 33 + 32]; float2 X = XCTX[((b * 32 + g) * 2 + dir) * 64 + n];
                const float* __restrict__ xl = XLOC + ((size_t)g * 512 + b * 128) * 256 + dir * 128 + 2 * n; bf16_t* __restrict__ dst = S5A + ((size_t)g * 512 + b * 128) * 768 + 512 + dir * 128 + 2 * n;
#pragma unroll 1
                for (int j0 = 0; j0 < 128; j0 += 16) { float2 xv[16];
#pragma unroll
                    for (int q = 0; q < 16; ++q) { const int j = dir ? 127 - (j0 + q) : j0 + q; xv[q] = *(const float2*)(xl + (size_t)j * 256); }
#pragma unroll
                    for (int q = 0; q < 16; ++q) { const int j = dir ? 127 - (j0 + q) : j0 + q;
                        *(unsigned*)(dst + (size_t)j * 768) = pk2(X.x, X.y);
                        const float nx = a32.x * X.x - a32.y * X.y + xv[q].x, ny = a32.x * X.y + a32.y * X.x + xv[q].y; X.x = nx; X.y = ny; } } }
            {   int* qslot = (int*)(shm + 102400);
                for (;;) { __syncthreads(); if (tid == 0) *qslot = atomicAdd(QCTR + l * 64 + 32, 1); __syncthreads(); const int it = *qslot; if (it >= 32 * 68 + 64 * 68) break;
                    if (it < 32 * 68) { const int chain = it / 68, c = it % 68; mlstm_out_item(chain, c, P, QKB, VTG, PT(22) + l * 16, CST, NST, MST, (chain & 1) ? HBk : HF, shm, tid); }
                    else { const int i2 = it - 32 * 68; const int chain = i2 / 68, c = i2 % 68; const int dir_ = chain & 1, h_ = (chain >> 1) & 7;
                        ssd_out_item(chain, c, P, XBC, XTG, -expf(PT(37)[l * 16 + dir_ * 8 + h_]), PT(36)[l * 16 + dir_ * 8 + h_], SSTB, dir_ ? YB : YF, shm, tid); } }
            }
            __syncthreads();
            {   const float* bias = PT(19) + l * 1024 + 512; const int c = tid;
                const int nitems = lastl ? 0 : 4 * (CTXL / 8);
                for (int it = bid; it < nitems; it += G) {
                    int L, tokbase, b, t0; const float* K2;
                    { const int q = it; L = CTXL; tokbase = NLAT; b = q / (CTXL / 8); t0 = (q % (CTXL / 8)) * 8; K2 = K2C; }
                    const float* zb = Z + (size_t)(tokbase + b * L) * BW + c;
                    float acc[8];
#pragma unroll
                    for (int i = 0; i < 8; ++i) acc[i] = 0.f;
                    const int base = t0 + L - 1;
                    for (int s = 0; s < L; s += 8) {
                        float k[15];
#pragma unroll
                        for (int mm = 0; mm < 15; ++mm) k[mm] = K2[((size_t)(base - s - 7 + mm) * 2 + 1) * 512 + c];
#pragma unroll
                        for (int ds = 0; ds < 8; ++ds) { const float z = zb[(size_t)(s + ds) * BW];
#pragma unroll
                            for (int i = 0; i < 8; ++i) acc[i] += k[i - ds + 7] * z; }
                    }
#pragma unroll
                    for (int i = 0; i < 8; ++i) { const size_t tok = (size_t)(tokbase + b * L + t0 + i); const float zt = Z[tok * BW + c]; Y4[tok * DM + c] = f2bf((acc[i] + bias[c] * zt) * U[tok * 1536 + 1024 + c]); }
                }
            }
            SEAM(PB + 4);
        }

        if (IN(PB + 5)) for (int rep_ = 0; rep_ < PROBE_REPS(5); ++rep_) {
            PH_BEGIN
            const float* ml_norm = PT(23) + l * BW; const float* ssd_d = PT(38) + l * 8; const float* ssd_norm = PT(39) + l * BW; const float* s5_d = PT(31) + l * BW;
            if (bid < 128) {
                pg8::Gemm gg_{S5A, S5B, 768, 768, 768}; pg8::SchedS5b S_{bid}; pg8::EpiS5Out E_{P, s5_d, GG};
                pg8::gemm_phase((LAS unsigned char*)shm, gg_, S_, E_);
                __syncthreads();
            }
            for (int tok = bid * 8 + wave; tok < NTOK; tok += G * 8) {
                const int c0 = lane * 8; const bf16_t* pr = P + (size_t)tok * LDP; const size_t o5 = (size_t)tok * BW + c0;
                float hm[8], ys[8];
                const u32x4 ooq = *(const u32x4*)(pr + ML_OFF + 1536 + c0);
                const float4 g0 = *(const float4*)(ml_norm + c0), g1 = *(const float4*)(ml_norm + c0 + 4), n0 = *(const float4*)(ssd_norm + c0), n1 = *(const float4*)(ssd_norm + c0 + 4);
                { const float4 a0 = *(const float4*)(HF + o5), a1 = *(const float4*)(HF + o5 + 4), b0 = *(const float4*)(HBk + o5), b1 = *(const float4*)(HBk + o5 + 4);
                  hm[0] = a0.x + b0.x; hm[1] = a0.y + b0.y; hm[2] = a0.z + b0.z; hm[3] = a0.w + b0.w; hm[4] = a1.x + b1.x; hm[5] = a1.y + b1.y; hm[6] = a1.z + b1.z; hm[7] = a1.w + b1.w; }
                { const float4 a0 = *(const float4*)(YF + o5), a1 = *(const float4*)(YF + o5 + 4), b0 = *(const float4*)(YB + o5), b1 = *(const float4*)(YB + o5 + 4);
                  float xx[8], zz[8]; unpack8(*(const u32x4*)(XBC + (size_t)tok * 1024 + c0), xx); unpack8(*(const u32x4*)(pr + SSD_OFF + c0), zz); const float dsk = ssd_d[c0 >> 6];
                  ys[0] = a0.x + b0.x; ys[1] = a0.y + b0.y; ys[2] = a0.z + b0.z; ys[3] = a0.w + b0.w; ys[4] = a1.x + b1.x; ys[5] = a1.y + b1.y; ys[6] = a1.z + b1.z; ys[7] = a1.w + b1.w;
#pragma unroll
                  for (int j = 0; j < 8; ++j) ys[j] = (ys[j] + dsk * xx[j]) * siluf_(zz[j]); }
                float s1 = 0.f, s2 = 0.f;
#pragma unroll
                for (int j = 0; j < 8; ++j) { s1 += hm[j] * hm[j]; s2 += ys[j] * ys[j]; }
                s1 += __shfl_xor(s1, 1); s1 += __shfl_xor(s1, 2); s1 += __shfl_xor(s1, 4); s1 += __shfl_xor(s1, 8);
                s2 = wave_sum(s2);
                const float r1 = rsqrtf(s1 * (1.0f / 128.0f) + 1e-6f), r2 = rsqrtf(s2 * (1.0f / BW) + 1e-6f);
                float oo[8]; unpack8(ooq, oo);
                const float gm[8] = {g0.x, g0.y, g0.z, g0.w, g1.x, g1.y, g1.z, g1.w}, gs[8] = {n0.x, n0.y, n0.z, n0.w, n1.x, n1.y, n1.z, n1.w};
                u32x4 w;
                w.x = pk2(hm[0] * r1 * gm[0] * sigmoidf_(oo[0]), hm[1] * r1 * gm[1] * sigmoidf_(oo[1])); w.y = pk2(hm[2] * r1 * gm[2] * sigmoidf_(oo[2]), hm[3] * r1 * gm[3] * sigmoidf_(oo[3]));
                w.z = pk2(hm[4] * r1 * gm[4] * sigmoidf_(oo[4]), hm[5] * r1 * gm[5] * sigmoidf_(oo[5])); w.w = pk2(hm[6] * r1 * gm[6] * sigmoidf_(oo[6]), hm[7] * r1 * gm[7] * sigmoidf_(oo[7]));
                *(u32x4*)(Y4 + (size_t)tok * DM + 512 + c0) = w;
                w.x = pk2(ys[0] * r2 * gs[0], ys[1] * r2 * gs[1]); w.y = pk2(ys[2] * r2 * gs[2], ys[3] * r2 * gs[3]); w.z = pk2(ys[4] * r2 * gs[4], ys[5] * r2 * gs[5]); w.w = pk2(ys[6] * r2 * gs[6], ys[7] * r2 * gs[7]);
                *(u32x4*)(Y4 + (size_t)tok * DM + 1536 + c0) = w;
                if (tok >= NLAT) { const size_t oc = (size_t)(tok - NLAT) * BW + c0; float uu[8]; unpack8(*(const u32x4*)(pr + S5_OFF + c0), uu);
                    const float4 a0 = *(const float4*)(SF + oc), a1 = *(const float4*)(SF + oc + 4), b0 = *(const float4*)(SB + oc), b1 = *(const float4*)(SB + oc + 4), d0 = *(const float4*)(s5_d + c0), d1 = *(const float4*)(s5_d + c0 + 4);
                    float y[8] = {a0.x + b0.x + d0.x * uu[0], a0.y + b0.y + d0.y * uu[1], a0.z + b0.z + d0.z * uu[2], a0.w + b0.w + d0.w * uu[3], a1.x + b1.x + d1.x * uu[4], a1.y + b1.y + d1.y * uu[5], a1.z + b1.z + d1.z * uu[6], a1.w + b1.w + d1.w * uu[7]};
#pragma unroll
                    for (int j = 0; j < 8; ++j) y[j] = 0.5f * y[j] * (1.0f + tanhf(0.7978845608028654f * (y[j] + 0.044715f * y[j] * y[j] * y[j])));
                    w.x = pk2(y[0], y[1]); w.y = pk2(y[2], y[3]); w.z = pk2(y[4], y[5]); w.w = pk2(y[6], y[7]);
                    *(u32x4*)(GG + (size_t)tok * BW + c0) = w; }
            }
            __syncthreads();
            {   float* T = sf;
                for (int unit = (G > 128 ? bid - 128 : bid); unit >= 0 && unit < 4 * 64 * 8; unit += (G > 128 ? G - 128 : G)) { const int b = unit / 512, t0 = ((unit >> 3) & 63) * 64, c0 = (unit & 7) * 64;
                    __syncthreads();
#pragma unroll
                    for (int i = 0; i < 8; ++i) { const int t = tid & 63, c = (tid >> 6) + 8 * i; T[c * 65 + t] = YT[((size_t)b * 512 + c0 + c) * SEQ + t0 + t]; }
                    __syncthreads();
                    const int t = tid >> 3, cq = (tid & 7) * 8;
                    u32x4 w; w.x = pk2(T[(cq + 0) * 65 + t], T[(cq + 1) * 65 + t]); w.y = pk2(T[(cq + 2) * 65 + t], T[(cq + 3) * 65 + t]); w.z = pk2(T[(cq + 4) * 65 + t], T[(cq + 5) * 65 + t]); w.w = pk2(T[(cq + 6) * 65 + t], T[(cq + 7) * 65 + t]);
                    *(u32x4*)(Y4 + ((size_t)b * SEQ + t0 + t) * DM + c0 + cq) = w;
                } }
            SEAM(PB + 5);
        }

        if (IN(PB + 6)) for (int rep_ = 0; rep_ < PROBE_REPS(6); ++rep_) {
            PH_BEGIN
            pg8::Gemm g{GG, GLU, BW, BW, BW}; pg8::SchedStd S{68, 2, G, bid, BW, BW}; pg8::EpiGlu E{GG, PT(33) + l * BW, Y4};
            pg8::gemm_phase((LAS unsigned char*)shm, g, S, E);
            SEAM(PB + 6);
        }
        if (IN(PB + 7)) for (int rep_ = 0; rep_ < PROBE_REPS(7); ++rep_) {
            PH_BEGIN
            pg8::Gemm g{Y4, WBR, DM, BW, BW}; pg8::SchedBranch S{nPanels, 8, G, bid}; pg8::EpiBranch E{P, ACCb};
            pg8::gemm_phase((LAS unsigned char*)shm, g, S, E);
            SEAM(PB + 7);
        }
        if (IN(PB + 8)) for (int rep_ = 0; rep_ < PROBE_REPS(8); ++rep_) {
            PH_BEGIN
            pg8::Gemm g{ACCb, WOUT, DM, DM, DM}; pg8::SchedStd S{nPanels, 8, G, bid, DM, DM}; pg8::EpiResid E{XS, l == 0 ? x_in : (const float*)XS, l == 0 ? ctx_in - (size_t)NLAT * DM : (const float*)XS, MODl, 2};
            pg8::gemm_phase((LAS unsigned char*)shm, g, S, E);
            SEAM(PB + 8);
        }
        if (IN(PB + 9)) for (int rep_ = 0; rep_ < PROBE_REPS(9); ++rep_) {
            PH_BEGIN
            for (int i = bid * NTHR + tid; i < NEXP * MOE_PAD; i += G * NTHR) ROWTOK[i] = -1;
            for (int i = bid * NTHR + tid; i < NTOK * 16; i += G * NTHR) INV[i] = -1;
            const float* wr = PT(42) + (size_t)l * DM * 16; const float* gn = norm_ffn + l * DM;
            for (int tok0 = (bid * 8 + wave) * 4; tok0 < M2; tok0 += G * 32) {
                const int r = tok0 < NLAT ? tok0 / SEQ : 4; const float* xr = XS + (size_t)tok0 * DM;
                const float* sh = MODl + (size_t)(r * 6 + 3) * DM; const float* sc = MODl + (size_t)(r * 6 + 4) * DM;
                float rs[4];
#pragma unroll
                for (int tk = 0; tk < 4; ++tk) { float ss = 0.f;
#pragma unroll 4
                    for (int i = 0; i < 8; ++i) { const float4 t4 = *(const float4*)(xr + (size_t)tk * DM + i * 256 + lane * 4); ss += t4.x * t4.x + t4.y * t4.y + t4.z * t4.z + t4.w * t4.w; }
                    ss = wave_sum(ss); rs[tk] = rsqrtf(ss * (1.0f / DM) + 1e-6f); }
                float lg[4][16];
#pragma unroll
                for (int tk = 0; tk < 4; ++tk)
#pragma unroll
                    for (int e = 0; e < 16; ++e) lg[tk][e] = 0.f;
#pragma unroll 1
                for (int i = 0; i < 8; ++i) { const int d = i * 256 + lane * 4;
                    const float4 g4 = *(const float4*)(gn + d), s4 = *(const float4*)(sc + d), h4 = *(const float4*)(sh + d);
                    float4 xq[4], ww[16];
#pragma unroll
                    for (int tk = 0; tk < 4; ++tk) xq[tk] = *(const float4*)(xr + (size_t)tk * DM + d);
                    const float4* wq = (const float4*)(wr + (size_t)d * 16);
#pragma unroll
                    for (int q = 0; q < 16; ++q) ww[q] = wq[q];
                    float hv[4][4];
#pragma unroll
                    for (int tk = 0; tk < 4; ++tk) { const float4 xv = xq[tk]; const float rr = rs[tk];
                        hv[tk][0] = xv.x * rr * g4.x * (1.f + s4.x) + h4.x; hv[tk][1] = xv.y * rr * g4.y * (1.f + s4.y) + h4.y; hv[tk][2] = xv.z * rr * g4.z * (1.f + s4.z) + h4.z; hv[tk][3] = xv.w * rr * g4.w * (1.f + s4.w) + h4.w;
                        u32x2 w; w.x = pk2(hv[tk][0], hv[tk][1]); w.y = pk2(hv[tk][2], hv[tk][3]); *(u32x2*)(HB + (size_t)(tok0 + tk) * DM + d) = w; }
#pragma unroll
                    for (int q = 0; q < 4; ++q) { const float4 w0 = ww[q * 4 + 0], w1 = ww[q * 4 + 1], w2 = ww[q * 4 + 2], w3 = ww[q * 4 + 3];
#pragma unroll
                        for (int tk = 0; tk < 4; ++tk) { const float hq = hv[tk][q];
                            lg[tk][0] += hq * w0.x; lg[tk][1] += hq * w0.y; lg[tk][2] += hq * w0.z; lg[tk][3] += hq * w0.w; lg[tk][4] += hq * w1.x; lg[tk][5] += hq * w1.y; lg[tk][6] += hq * w1.z; lg[tk][7] += hq * w1.w;
                            lg[tk][8] += hq * w2.x; lg[tk][9] += hq * w2.y; lg[tk][10] += hq * w2.z; lg[tk][11] += hq * w2.w; lg[tk][12] += hq * w3.x; lg[tk][13] += hq * w3.y; lg[tk][14] += hq * w3.z; lg[tk][15] += hq * w3.w; } } }
#pragma unroll
                for (int tk = 0; tk < 4; ++tk) { float mx = -1e30f;
#pragma unroll
                    for (int e = 0; e < 16; ++e) { lg[tk][e] = wave_sum(lg[tk][e]); mx = fmaxf(mx, lg[tk][e]); }
                    float sm = 0.f;
#pragma unroll
                    for (int e = 0; e < 16; ++e) { lg[tk][e] = expf(lg[tk][e] - mx); sm += lg[tk][e]; }
                    const float inv = 1.0f / sm;
                    if (lane == 0) {
#pragma unroll
                        for (int e = 0; e < 16; e += 4) *(float4*)(PROBS + (size_t)(tok0 + tk) * 16 + e) = make_float4(lg[tk][e] * inv, lg[tk][e + 1] * inv, lg[tk][e + 2] * inv, lg[tk][e + 3] * inv); } }
            }
            SEAM(PB + 9);
        }
        if (IN(PB + 10)) for (int rep_ = 0; rep_ < PROBE_REPS(10); ++rep_) {
            PH_BEGIN
            const int nitems = 64 + (lastl ? 0 : 64);
            unsigned long long* keys = (unsigned long long*)shm;
            for (int it = bid; it < nitems; it += G) {
                const int set = it >> 6, e = it & 15, b = (it >> 4) & 3;
                const int n = set ? CTXL : SEQ, cap = set ? 32 : 512, tokbase = set ? NLAT + b * CTXL : b * SEQ;
                __syncthreads();
                for (int i = tid; i < n; i += NTHR) keys[i] = ((unsigned long long)__float_as_uint(PROBS[(size_t)(tokbase + i) * 16 + e]) << 32) | (unsigned long long)(0xFFFFFFFFu - (unsigned)i);
                __syncthreads();
                for (int k = 2; k <= n; k <<= 1)
                    for (int j = k >> 1; j > 0; j >>= 1) {
                        for (int p = tid; p < (n >> 1); p += NTHR) { const int i = ((p & ~(j - 1)) << 1) | (p & (j - 1)); const int m = i | j;
                            const unsigned long long ka = keys[i], kb = keys[m]; const bool desc = ((i & k) == 0);
                            if ((ka < kb) == desc) { keys[i] = kb; keys[m] = ka; } }
                        __syncthreads();
                    }
                for (int r = tid; r < cap; r += NTHR) { const unsigned long long kk = keys[r]; const int row = e * MOE_PAD + (set ? 2048 + b * 32 + r : b * 512 + r);
                    const int tk_ = tokbase + (int)(0xFFFFFFFFu - (unsigned)(kk & 0xFFFFFFFFull)); ROWTOK[row] = tk_; ROWGATE[row] = __uint_as_float((unsigned)(kk >> 32)); INV[tk_ * 16 + e] = row; }
                for (int rb = 0; rb < cap; rb += 32) {
                    u32x4 t4[4][4];
#pragma unroll
                    for (int q = 0; q < 4; ++q) { const int r = rb + wave + 8 * q; const int tok = tokbase + (int)(0xFFFFFFFFu - (unsigned)(keys[r] & 0xFFFFFFFFull));
                        const u32x4* sp = (const u32x4*)(HB + (size_t)tok * DM);
#pragma unroll
                        for (int i = 0; i < 4; ++i) t4[q][i] = sp[i * 64 + lane]; }
#pragma unroll
                    for (int q = 0; q < 4; ++q) { const int r = rb + wave + 8 * q; const int row = e * MOE_PAD + (set ? 2048 + b * 32 + r : b * 512 + r);
                        u32x4* dp = (u32x4*)(XG + (size_t)row * DM);
#pragma unroll
                        for (int i = 0; i < 4; ++i) dp[i * 64 + lane] = t4[q][i]; } }
            }
            if (!lastl && G > 128 && bid >= 128) {
                const int n_win = 32 * 55, n_br = 4 * 64, n_out = 32 * 8, n_glu = 16, n_gu = 16 * 2 * 192; (void)n_gu;
                CV_RUN(l + 1, bid - 128, G - 128, n_win + n_br + n_out + n_glu);
            }
            {   const int pad0 = lastl ? 2048 : MOE_ROWS, npad = MOE_PAD - pad0;
                for (int R = bid * 8 + wave; R < NEXP * npad; R += G * 8) { const int e = R / npad, rr = pad0 + R % npad; u32x4* dp = (u32x4*)(XG + ((size_t)e * MOE_PAD + rr) * DM);
#pragma unroll
                    for (int i = 0; i < 4; ++i) dp[i * 64 + lane] = (u32x4){0u, 0u, 0u, 0u}; } }
            SEAM(PB + 10);
        }
        if (IN(PB + 12)) for (int rep_ = 0; rep_ < PROBE_REPS(12); ++rep_) {
            PH_BEGIN
            pg8::Gemm g{XG, WGU, DM, DM, DM}; pg8::SchedMoe S{lastl ? 8 : 9, 12, G, bid, DM, DM, 2 * DEXP}; pg8::EpiMoe1 E{HID};
            pg8::gemm_phase((LAS unsigned char*)shm, g, S, E);
            SEAM(PB + 12);
        }
        if (IN(PB + 13)) for (int rep_ = 0; rep_ < PROBE_REPS(13); ++rep_) {
            PH_BEGIN
            pg8::Gemm g{HID, WD, DEXP, DEXP, DEXP}; pg8::SchedMoe S{lastl ? 8 : 9, 8, G, bid, DEXP, DEXP, DM}; pg8::EpiMoeY E{YEXP};
            pg8::gemm_phase((LAS unsigned char*)shm, g, S, E);
            SEAM(PB + 13);
        }

}

__global__ __launch_bounds__(NTHR, 2) void fwd(Args a) {
    extern __shared__ __attribute__((aligned(16))) unsigned char shm[];
    const int bid = blockIdx.x, G = gridDim.x;
    float* const sf = (float*)shm;
    volatile LAS unsigned* xbw = (volatile LAS unsigned*)((LAS unsigned char*)shm + (LDS_BYTES - 16));
    if (threadIdx.x == 0) { xbw[0] = 0u; xbw[1] = 0u; xbw[2] = 0u; xbw[3] = 0u; }
    const float** const ptab = (const float**)(shm + (LDS_BYTES - 16 - 512));
    if (threadIdx.x == 0) {
#pragma unroll
        for (int i = 0; i < 47; ++i) ptab[i] = a.in[i]; }
    __syncthreads();
    XcdBarrier bar = xcd_barrier_post((unsigned*)(a.ws + O_BAR), xbw);
    const int lo = a.ph_lo, hi = a.ph_hi;
    if (IN(0)) {
        PH_BEGIN
        {
            __syncthreads();
            for (int i = tid; i < 5 * DM; i += NTHR) { const int r = i >> 11, k = i & (DM - 1); const float v = r < 4 ? c_in[r * DM + k] : cctx_in[k]; sf[i] = siluf_(v); }
            __syncthreads();
            float* red = sf + 5 * DM;
            for (int unit = bid; unit < 2 * 96; unit += G) { const int l = unit / 96, j = (unit % 96) * 128 + (tid & 127), kq = tid >> 7;
                const float* w = ada_w + (size_t)l * DM * (6 * DM) + (size_t)(kq * 512) * (6 * DM) + j; const float* sv = sf + kq * 512;
                float a0 = 0.f, a1 = 0.f, a2 = 0.f, a3 = 0.f, a4 = 0.f;
#pragma unroll 8
                for (int k = 0; k < 512; ++k) { const float wv = w[(size_t)k * (6 * DM)]; a0 += sv[k] * wv; a1 += sv[DM + k] * wv; a2 += sv[2 * DM + k] * wv; a3 += sv[3 * DM + k] * wv; a4 += sv[4 * DM + k] * wv; }
                __syncthreads();
                { float* rp = red + (kq * 5) * 128 + (tid & 127); rp[0] = a0; rp[128] = a1; rp[256] = a2; rp[384] = a3; rp[512] = a4; }
                __syncthreads();
                if (tid < 128) { const float bb = ada_b[l * 6 * DM + j]; float* o = MOD + (size_t)l * 5 * 6 * DM + j;
#pragma unroll
                    for (int r = 0; r < 5; ++r) o[(size_t)r * 6 * DM] = ((red[(0 * 5 + r) * 128 + tid] + red[(1 * 5 + r) * 128 + tid]) + (red[(2 * 5 + r) * 128 + tid] + red[(3 * 5 + r) * 128 + tid])) + bb; }
            }
        }
    }

    layer_body<0>(a, bar, lo, hi, bid, G, shm, sf, ptab);
    layer_body<1>(a, bar, lo, hi, bid, G, shm, sf, ptab);
    if (IN(33)) {
        PH_BEGIN
        const float* gn = PT(46);
        for (int tok = bid * 8 + wave; tok < NLAT; tok += G * 8) {
            const float* xr = XS + (size_t)tok * DM; float4 v[8]; float ss = 0.f;
#pragma unroll
            for (int i = 0; i < 8; ++i) v[i] = *(const float4*)(xr + i * 256 + lane * 4);
            moe_combine(v, tok, lane, INV, ROWGATE, YEXP, MOD + (size_t)(1 * 5 + tok / SEQ) * 6 * DM + 5 * DM);
#pragma unroll
            for (int i = 0; i < 8; ++i) {                 ss += v[i].x * v[i].x + v[i].y * v[i].y + v[i].z * v[i].z + v[i].w * v[i].w; }
            ss = wave_sum(ss); const float rs = rsqrtf(ss * (1.0f / DM) + 1e-6f);
#pragma unroll
            for (int i = 0; i < 8; ++i) { const int d = i * 256 + lane * 4; const float4 g4 = *(const float4*)(gn + d);
                *(float4*)(a.out + (size_t)tok * DM + d) = make_float4(v[i].x * rs * g4.x, v[i].y * rs * g4.y, v[i].z * rs * g4.z, v[i].w * rs * g4.w); }
        }
    }
#undef IN
#undef SEAM
}


extern "C" void kernel_launch(void* const* d_in, const int* in_sizes, int n_in, void* d_out, int out_size, void* d_ws, size_t ws_size, hipStream_t stream) {
    static int grid = 0;
    if (grid == 0) {
        if (n_in != 47 || ws_size < WS_END) { fprintf(stderr, "kernel_launch: expected 47 inputs and >= %zu bytes of workspace; got %d, %zu\n", (size_t)WS_END, n_in, ws_size); grid = -1; return; }
        int dev = 0, cus = 0;
        if (hipGetDevice(&dev) != hipSuccess || hipDeviceGetAttribute(&cus, hipDeviceAttributeMultiprocessorCount, dev) != hipSuccess) { grid = -1; return; }
        if (hipFuncSetAttribute((const void*)fwd, hipFuncAttributeMaxDynamicSharedMemorySize, LDS_BYTES) != hipSuccess) { fprintf(stderr, "kernel_launch: hipFuncSetAttribute failed\n"); grid = -1; return; }
        int per_cu = 0;
        if (hipOccupancyMaxActiveBlocksPerMultiprocessor(&per_cu, (const void*)fwd, NTHR, LDS_BYTES) != hipSuccess || per_cu < 1) fprintf(stderr, "kernel_launch: occupancy query reports %d\n", per_cu);
        (void)hipGetLastError();
        grid = cus > 256 ? 256 : cus;
        if (grid < 224) { fprintf(stderr, "kernel_launch: needs >= 224 CUs (got %d)\n", grid); grid = -1; return; }
    }
    if (grid < 0) return;
    (void)hipMemsetAsync((char*)d_ws, 0, O_ZERO_END, stream);
    Args a{};
    for (int i = 0; i < 47; ++i) a.in[i] = (const float*)d_in[i];
    a.out = (float*)d_out; a.ws = (unsigned char*)d_ws;
#if MK_ONE_LAUNCH
    a.ph_lo = 0; a.ph_hi = 64;
    hipLaunchKernelGGL(fwd, dim3(grid), dim3(NTHR), LDS_BYTES, stream, a);
#else
    const int ids[] = {0, 1,2,3,4,5,6,7,8,9,10,11,12,13,14, 17,18,19,20,21,22,23,24,25,26,27,28,29,30, 33};
    for (int k = 0; k < (int)(sizeof(ids) / sizeof(ids[0])); ++k) { a.ph_lo = ids[k]; a.ph_hi = ids[k] + 1; hipLaunchKernelGGL(fwd, dim3(grid), dim3(NTHR), LDS_BYTES, stream, a); }
#endif
}
```

```cpp
#include <hip/hip_runtime.h>
#include <stdint.h>
#include <stdio.h>

#ifndef PROBE_MASK
#define PROBE_MASK 0
#endif
#ifndef PROBE_SP
#define PROBE_SP 1
#endif
#define PROBE_REPS(k) ((((PROBE_MASK) >> (k)) & 1) + 1)
#ifndef MK_ONE_LAUNCH
#define MK_ONE_LAUNCH 1
#endif

#define DM 2048
#define NB 4
#define SEQ 4096
#define CTXL 256
#define BW 512
#define NLAT 16384
#define NCTX 1024
#define NTOK 17408
#define IN_W 13856
#define LDP 14080
#define HY_OFF 0
#define ML_OFF 1536
#define S5_OFF 3600
#define SSD_OFF 4112
#define GATE_OFF 5664
#define NEXP 16
#define DEXP 1536
#define MOE_ROWS 2176
#define MOE_PAD 2304
#define NTHR 512
#define LDS_BYTES 147456
#define LAS __attribute__((address_space(3)))

typedef unsigned short bf16_t;
typedef short bf16x8 __attribute__((ext_vector_type(8)));
typedef float f32x4 __attribute__((ext_vector_type(4)));
typedef unsigned u32x4 __attribute__((ext_vector_type(4)));
typedef unsigned u32x2 __attribute__((ext_vector_type(2)));

#define XB_TMO      128
#define XB_XCNT(j)  (256  + 64 * (j))
#define XB_XSUB(j)  (1280 + 64 * (j))
#define XB_XGEN(j)  (2304 + 64 * (j))
#define XB_TOP      3328
#define XB_TOPGEN   3392
#define XCD_BAR_WORDS 3456
#define XB_SPIN_CAP (1u << 18)
__device__ __forceinline__ unsigned xb_ld(unsigned* p)              { return __hip_atomic_load(p, __ATOMIC_RELAXED, __HIP_MEMORY_SCOPE_AGENT); }
__device__ __forceinline__ unsigned xb_add(unsigned* p, unsigned v) { return __hip_atomic_fetch_add(p, v, __ATOMIC_RELAXED, __HIP_MEMORY_SCOPE_AGENT); }
__device__ __forceinline__ unsigned xb_xcc_id() { return (unsigned)__builtin_amdgcn_s_getreg((3 << 11) | 20) & 0xFu; }
#define XB_SPIN(cond, bar) do { unsigned _sp = 0; while (cond) { __builtin_amdgcn_s_sleep(1); \
    if ((++_sp & 255u) == 0u) { if (xb_ld(&(bar)[XB_TMO])) break; if (_sp > XB_SPIN_CAP) { atomicAdd(&(bar)[XB_TMO], 1u); break; } } } } while (0)
struct XcdBarrier { unsigned* bar; unsigned x; volatile LAS unsigned* st; };
__device__ __forceinline__ XcdBarrier xcd_barrier_post(unsigned* bar, volatile LAS unsigned* st) {
    XcdBarrier b; b.bar = bar; b.x = xb_xcc_id(); b.st = st;
    if (threadIdx.x == 0) (void)xb_add(&bar[XB_XCNT(b.x)], 1u);
    return b;
}
__device__ __forceinline__ void xcd_barrier_complete(unsigned* bar, unsigned x, unsigned& nloc, unsigned& nx) {
    const unsigned G = gridDim.x * gridDim.y * gridDim.z;
    unsigned sum, cnt, mine, sp = 0u;
    for (;;) {
        sum = 0u; cnt = 0u; mine = 0u;
#pragma unroll
        for (unsigned j = 0; j < 16; ++j) { const unsigned c = xb_ld(&bar[XB_XCNT(j)]); sum += c; cnt += (c > 0u) ? 1u : 0u; mine = (j == x) ? c : mine; }
        if (sum == G) break;
        __builtin_amdgcn_s_sleep(1);
        if ((++sp & 255u) == 0u) { if (xb_ld(&bar[XB_TMO])) break; if (sp > XB_SPIN_CAP) { atomicAdd(&bar[XB_TMO], 1u); break; } }
    }
    nloc = mine > 0u ? mine : 1u; nx = cnt > 0u ? cnt : 1u;
}
__device__ __forceinline__ void xcd_barrier(const XcdBarrier& b) {
    asm volatile("s_waitcnt vmcnt(0)" ::: "memory");
    __syncthreads();
    if (threadIdx.x == 0) {
        unsigned* bar = b.bar;
        __builtin_amdgcn_s_waitcnt(0);
        unsigned nloc = b.st[0], nx = b.st[1];
        if (nloc == 0u) { xcd_barrier_complete(bar, b.x, nloc, nx); b.st[0] = nloc; b.st[1] = nx; }
        const unsigned old = xb_add(&bar[XB_XSUB(b.x)], 1u);
        const unsigned gen = old / nloc;
        if (old + 1u == (gen + 1u) * nloc) {
            __builtin_amdgcn_fence(__ATOMIC_RELEASE, "agent");
            asm volatile("s_waitcnt vmcnt(0)" ::: "memory");
            const unsigned og = xb_add(&bar[XB_TOP], 1u);
            const unsigned tg = og / nx;
            if (og + 1u == (tg + 1u) * nx) xb_add(&bar[XB_TOPGEN], 1u);
            else XB_SPIN(xb_ld(&bar[XB_TOPGEN]) == tg, bar);
            __builtin_amdgcn_fence(__ATOMIC_ACQUIRE, "agent");
            xb_add(&bar[XB_XGEN(b.x)], 1u);
            asm volatile("s_waitcnt vmcnt(0)" ::: "memory");
        } else {
            XB_SPIN(xb_ld(&bar[XB_XGEN(b.x)]) == gen, bar);
            __builtin_amdgcn_fence(__ATOMIC_ACQUIRE, "agent");
            asm volatile("s_waitcnt vmcnt(0)" ::: "memory");
        }
    }
    __syncthreads();
}

__device__ __forceinline__ unsigned short f2bf(float f) { unsigned u = __float_as_uint(f); u += 0x7FFFu + ((u >> 16) & 1u); return (unsigned short)(u >> 16); }
__device__ __forceinline__ float bf2f(unsigned short b) { return __uint_as_float(((unsigned)b) << 16); }
__device__ __forceinline__ unsigned pk2(float lo, float hi) { unsigned r; asm("v_cvt_pk_bf16_f32 %0, %1, %2" : "=v"(r) : "v"(lo), "v"(hi)); return r; }
__device__ __forceinline__ float sigmoidf_(float x) { return 1.0f / (1.0f + expf(-x)); }
__device__ __forceinline__ float siluf_(float x) { return x / (1.0f + expf(-x)); }
__device__ __forceinline__ float wave_sum(float v) {
#pragma unroll
    for (int o = 32; o >= 1; o >>= 1) v += __shfl_xor(v, o);
    return v;
}
__device__ __forceinline__ const float* uptr(const float* p) { const unsigned long long v = (unsigned long long)p;
    const unsigned lo = __builtin_amdgcn_readfirstlane((unsigned)v), hi = __builtin_amdgcn_readfirstlane((unsigned)(v >> 32)); return (const float*)(((unsigned long long)hi << 32) | lo); }
#define PT(k) uptr(ptab[k])
__device__ __forceinline__ int step_tok(int b, int dir, int i) {
    if (i < CTXL) { const int tt = dir ? (CTXL - 1 - i) : i; return NLAT + b * CTXL + tt; }
    const int j = i - CTXL; const int tt = dir ? (SEQ - 1 - j) : j; return b * SEQ + tt;
}
__device__ __forceinline__ void unpack8(const u32x4 w, float (&f)[8]) {
    f[0] = __uint_as_float(w.x << 16); f[1] = __uint_as_float(w.x & 0xFFFF0000u); f[2] = __uint_as_float(w.y << 16); f[3] = __uint_as_float(w.y & 0xFFFF0000u);
    f[4] = __uint_as_float(w.z << 16); f[5] = __uint_as_float(w.z & 0xFFFF0000u); f[6] = __uint_as_float(w.w << 16); f[7] = __uint_as_float(w.w & 0xFFFF0000u);
}

namespace pg8 {
constexpr int BM = 256, BK = 64, HALF = 128, HTB = HALF * BK * 2, STAGE_BYTES = 8 * HTB, NXCD = 8, WGM = 8;
__host__ __device__ __forceinline__ int lds_byte(int r, int c) { const int st = (r >> 4) * 2 + (c >> 5), rr = r & 15, cc = c & 31, ob = rr * 64 + cc * 2; return st * 1024 + (ob ^ (((ob >> 9) & 1) << 5)); }
__host__ __device__ __forceinline__ void stage_rc(int b, int& R, int& C) { const int st = b / 1024, sb = b % 1024, swz = sb ^ (((sb >> 9) & 1) << 5); R = (st >> 1) * 16 + swz / 64; C = (st & 1) * 32 + (swz % 64) / 2; }
__host__ __device__ __forceinline__ int perm32(int rho) { const int n = rho >> 4, i = rho & 15; return 8 * (i >> 2) + 4 * n + (i & 3); }
struct Unit { int pm, pn, z, k; long long ao, bo; };
struct Gemm { const bf16_t* A; const bf16_t* Bt; int lda, ldb, K; };

__device__ __forceinline__ void tile_of(int wgid, int nM, int nN, int& pm, int& pn) {
    const int nwg = nM * nN; { const int q = nwg / NXCD, r = nwg % NXCD, xcd = wgid % NXCD, off = wgid / NXCD; wgid = (xcd < r ? xcd * (q + 1) : r * (q + 1) + (xcd - r) * q) + off; }
    const int nig = WGM * nN, gid = wgid / nig, fm = gid * WGM, gsz = (nM - fm) < WGM ? (nM - fm) : WGM;
    pm = fm + ((wgid % nig) % gsz); pn = (wgid % nig) / gsz;
}
struct SchedStd {
    int nM, nN, G, c, lda, ldb;
    __device__ __forceinline__ bool next(int i, Unit& u) const { const long L = (long)i * G + c; if (L >= (long)nM * nN) return false; tile_of((int)L, nM, nN, u.pm, u.pn); u.z = 0; u.k = 0;
        u.ao = (long long)u.pm * BM * lda * 2; u.bo = (long long)u.pn * BM * ldb * 2; return true; }
    __device__ __forceinline__ void a_ready(const Unit&) const {}
    __device__ __forceinline__ void done(const Unit&) const {}
};
struct SchedBranch {
    int nM, nN, G, c;
    __device__ __forceinline__ bool next(int i, Unit& u) const { const long L = (long)(i >> 2) * G + c; if (L >= (long)nM * nN) return false; tile_of((int)L, nM, nN, u.pm, u.pn); u.z = 0; u.k = i & 3;
        u.ao = ((long long)u.pm * BM * DM + u.k * BW) * 2; u.bo = ((long long)u.k * DM + u.pn * BM) * BW * 2; return true; }
    __device__ __forceinline__ void a_ready(const Unit&) const {}
    __device__ __forceinline__ void done(const Unit&) const {}
};
struct SchedMoe {
    int nPm, nPn, G, c, lda, ldb, nBrows;
    __device__ __forceinline__ bool next(int i, Unit& u) const { const long L = (long)i * G + c; const int per = nPm * nPn; if (L >= (long)NEXP * per) return false; const int e = (int)(L / per), rem = (int)(L % per);
        u.z = e; u.k = 0; u.pm = rem % nPm; u.pn = rem / nPm; u.ao = ((long long)e * MOE_PAD + u.pm * BM) * lda * 2; u.bo = ((long long)e * nBrows + u.pn * BM) * ldb * 2; return true; }
    __device__ __forceinline__ void a_ready(const Unit&) const {}
    __device__ __forceinline__ void done(const Unit&) const {}
};

typedef f32x4 Acc[2][2][4][2];
template <class Epi, class Sched>
__device__ __forceinline__ void gemm_phase(LAS unsigned char* lds, const Gemm g, const Sched& S, const Epi& E) {
    int tid = threadIdx.x; asm volatile("" : "+v"(tid));
    const int wid = __builtin_amdgcn_readfirstlane(tid >> 6), lane = tid & 63, wr = wid >> 2, wc = wid & 3, fr = lane & 15, fq = lane >> 4;
    const int K = g.K, nt = K / BK;
    unsigned voffA[2], voffB[2];
#pragma unroll
    for (int i = 0; i < 2; ++i) { int R, C; stage_rc(tid * 16 + i * 8192, R, C); const int Rb = Epi::PERM ? ((R & ~31) + perm32(R & 31)) : R;
        voffA[i] = (unsigned)(R * g.lda + C) * 2u; voffB[i] = (unsigned)(Rb * g.ldb + C) * 2u; }
    const size_t kstep = (size_t)(BK * 2);
    const size_t hstepA = (size_t)HALF * g.lda * 2, hstepB = (size_t)HALF * g.ldb * 2;
    const unsigned ldsw = (unsigned)wid * 1024u;
    const int aoff = lds_byte(wr * 64 + fr, fq * 8), boff = lds_byte(wc * 32 + fr, fq * 8);
#define PG8_SA(b, h) (((b) * 2 + (h)) * HTB)
#define PG8_SB(b, h) ((4 + (b) * 2 + (h)) * HTB)
#define PG8_STAGE(bufoff, gbase, voff) do { _Pragma("unroll") for (int _i = 0; _i < 2; ++_i) \
        __builtin_amdgcn_global_load_lds((const unsigned*)((const char*)(gbase) + (voff)[_i]), (LAS unsigned*)(lds + (bufoff) + ldsw + _i * 8192), 16, 0, 0); } while (0)
#define PG8_LDA(dst, b, h) do { _Pragma("unroll") for (int m = 0; m < 4; ++m) _Pragma("unroll") for (int k = 0; k < 2; ++k) dst[m][k] = *(const LAS bf16x8*)(lds + PG8_SA(b, h) + aoff + m * 2048 + k * 1024); } while (0)
#define PG8_LDB(dst, b, h) do { _Pragma("unroll") for (int n = 0; n < 2; ++n) _Pragma("unroll") for (int k = 0; k < 2; ++k) dst[n][k] = *(const LAS bf16x8*)(lds + PG8_SB(b, h) + boff + n * 2048 + k * 1024); } while (0)
#define PG8_MMA(ai, bj, At, Bt) do { __builtin_amdgcn_s_setprio(1); _Pragma("unroll") for (int m = 0; m < 4; ++m) _Pragma("unroll") for (int n = 0; n < 2; ++n) _Pragma("unroll") for (int k = 0; k < 2; ++k) \
        acc[ai][bj][m][n] = __builtin_amdgcn_mfma_f32_16x16x32_bf16(Bt[n][k], At[m][k], acc[ai][bj][m][n], 0, 0, 0); __builtin_amdgcn_s_setprio(0); } while (0)
#define PG8_WAIT_V(n) asm volatile("s_waitcnt vmcnt(" #n ")" ::: "memory")
#define PG8_WAIT_L(n) asm volatile("s_waitcnt lgkmcnt(" #n ")" ::: "memory")
#define PG8_BAR __builtin_amdgcn_s_barrier()
#define PG8_SCHED __builtin_amdgcn_sched_barrier(0)
    Unit cur, nxt; int ui = 0;
    if (!S.next(0, cur)) return;
    Acc acc;
#pragma unroll
    for (int a = 0; a < 2; ++a)
#pragma unroll
        for (int b = 0; b < 2; ++b)
#pragma unroll
            for (int m = 0; m < 4; ++m)
#pragma unroll
                for (int n = 0; n < 2; ++n) acc[a][b][m][n] = (f32x4){0.f, 0.f, 0.f, 0.f};
    bf16x8 At[4][2], B0[2][2], B1[2][2];
    const char* cA = (const char*)g.A + cur.ao; const char* cB = (const char*)g.Bt + cur.bo;
    S.a_ready(cur);
    PG8_STAGE(PG8_SB(0, 0), cB, voffB); PG8_STAGE(PG8_SA(0, 0), cA, voffA); PG8_STAGE(PG8_SB(0, 1), cB + hstepB, voffB); PG8_STAGE(PG8_SA(0, 1), cA + hstepA, voffA);
    if (wr == 1) PG8_BAR;
    PG8_WAIT_V(4); PG8_BAR;
    PG8_STAGE(PG8_SB(1, 0), cB + kstep, voffB); PG8_STAGE(PG8_SA(1, 0), cA + kstep, voffA); PG8_STAGE(PG8_SB(1, 1), cB + hstepB + kstep, voffB);
    PG8_WAIT_V(6); PG8_BAR;
    for (;;) {
        const bool has_next = S.next(ui + 1, nxt);
        const char* nA = has_next ? (const char*)g.A + nxt.ao : cA; const char* nB = has_next ? (const char*)g.Bt + nxt.bo : cB;
        for (int t = 0; t < nt; t += 2) {
            const bool last = (t == nt - 2);
            const char* a1 = cA + (size_t)(t + 1) * kstep;
            const char* a2 = last ? nA : cA + (size_t)(t + 2) * kstep; const char* b2 = last ? nB : cB + (size_t)(t + 2) * kstep;
            const char* a3 = a2 + kstep; const char* b3 = b2 + kstep;
            if (last && has_next) S.a_ready(nxt);
            PG8_LDB(B0, 0, 0); PG8_SCHED; PG8_LDA(At, 0, 0); PG8_STAGE(PG8_SA(1, 1), a1 + hstepA, voffA);
            PG8_WAIT_L(8); PG8_BAR; PG8_WAIT_L(0); PG8_MMA(0, 0, At, B0); PG8_BAR; PG8_SCHED;
            PG8_LDB(B1, 0, 1); PG8_STAGE(PG8_SB(0, 0), b2, voffB);
            PG8_BAR; PG8_WAIT_L(0); PG8_MMA(0, 1, At, B1); PG8_BAR;
            PG8_LDA(At, 0, 1); PG8_STAGE(PG8_SA(0, 0), a2, voffA);
            PG8_BAR; PG8_WAIT_L(0); PG8_MMA(1, 0, At, B0); PG8_BAR; PG8_SCHED;
            PG8_STAGE(PG8_SB(0, 1), b2 + hstepB, voffB);
            PG8_WAIT_V(6); PG8_BAR; PG8_MMA(1, 1, At, B1); PG8_BAR;
            PG8_LDB(B0, 1, 0); PG8_SCHED; PG8_LDA(At, 1, 0); PG8_STAGE(PG8_SA(0, 1), a2 + hstepA, voffA);
            PG8_WAIT_L(8); PG8_BAR; PG8_WAIT_L(0); PG8_MMA(0, 0, At, B0); PG8_BAR; PG8_SCHED;
            PG8_LDB(B1, 1, 1); PG8_STAGE(PG8_SB(1, 0), b3, voffB);
            PG8_BAR; PG8_WAIT_L(0); PG8_MMA(0, 1, At, B1); PG8_BAR;
            PG8_LDA(At, 1, 1); PG8_STAGE(PG8_SA(1, 0), a3, voffA);
            PG8_BAR; PG8_WAIT_L(0); PG8_MMA(1, 0, At, B0); PG8_BAR; PG8_SCHED;
            PG8_STAGE(PG8_SB(1, 1), b3 + hstepB, voffB);
            PG8_WAIT_V(6); PG8_BAR; PG8_MMA(1, 1, At, B1); PG8_BAR;
        }
        const bool keep = E(acc, cur, wr, wc, fr, fq); S.done(cur);
        if (!has_next) break;
        if (!keep) {
#pragma unroll
        for (int a = 0; a < 2; ++a)
#pragma unroll
            for (int b = 0; b < 2; ++b)
#pragma unroll
                for (int m = 0; m < 4; ++m)
#pragma unroll
                    for (int n = 0; n < 2; ++n) acc[a][b][m][n] = (f32x4){0.f, 0.f, 0.f, 0.f};
        }
        cur = nxt; cA = nA; cB = nB; ++ui;
    }
    PG8_WAIT_V(0);
    if (wr == 0) PG8_BAR;
    PG8_BAR;
#undef PG8_SA
#undef PG8_SB
#undef PG8_STAGE
#undef PG8_LDA
#undef PG8_LDB
#undef PG8_MMA
#undef PG8_WAIT_V
#undef PG8_WAIT_L
#undef PG8_BAR
#undef PG8_SCHED
}

struct EpiBf16Store {
    static constexpr bool PERM = true;
    bf16_t* O; int ldc;
    __device__ __forceinline__ bool operator()(Acc& acc, const Unit& u, int wr, int wc, int fr, int fq) const {
        const int row0 = u.pm * BM + wr * 64 + fr, col0 = u.pn * BM + wc * 32 + 8 * fq;
#pragma unroll
        for (int ai = 0; ai < 2; ++ai)
#pragma unroll
            for (int m = 0; m < 4; ++m) { bf16_t* rowp = O + (size_t)(row0 + ai * HALF + m * 16) * ldc + col0;
#pragma unroll
                for (int bj = 0; bj < 2; ++bj) { const f32x4 v0 = acc[ai][bj][m][0], v1 = acc[ai][bj][m][1];
                    u32x4 w; w.x = pk2(v0[0], v0[1]); w.y = pk2(v0[2], v0[3]); w.z = pk2(v1[0], v1[1]); w.w = pk2(v1[2], v1[3]);
                    *(u32x4*)(rowp + bj * HALF) = w; } }
        return false;
    }
};
struct EpiWin {
    static constexpr bool PERM = true;
    bf16_t* O; int ldc;
    __device__ __forceinline__ bool operator()(Acc& acc, const Unit& u, int wr, int wc, int fr, int fq) const {
        const int row0 = u.pm * BM + wr * 64 + fr, col0 = u.pn * BM + wc * 32 + 8 * fq;
#pragma unroll
        for (int bj = 0; bj < 2; ++bj) { const bool gate = (col0 + bj * HALF) >= GATE_OFF;
#pragma unroll
            for (int ai = 0; ai < 2; ++ai)
#pragma unroll
                for (int m = 0; m < 4; ++m) { f32x4 v0 = acc[ai][bj][m][0], v1 = acc[ai][bj][m][1];
                    if (gate) {
#pragma unroll
                        for (int j = 0; j < 4; ++j) { v0[j] = __builtin_amdgcn_rcpf(1.0f + __expf(-v0[j])); v1[j] = __builtin_amdgcn_rcpf(1.0f + __expf(-v1[j])); } }
                    u32x4 w; w.x = pk2(v0[0], v0[1]); w.y = pk2(v0[2], v0[3]); w.z = pk2(v1[0], v1[1]); w.w = pk2(v1[2], v1[3]);
                    *(u32x4*)(O + (size_t)(row0 + ai * HALF + m * 16) * ldc + col0 + bj * HALF) = w; } }
        return false;
    }
};
struct EpiNone { static constexpr bool PERM = true;
    __device__ __forceinline__ bool operator()(Acc& acc, const Unit&, int, int, int, int) const {
#pragma unroll
        for (int a = 0; a < 2; ++a)
#pragma unroll
            for (int b = 0; b < 2; ++b)
#pragma unroll
                for (int m = 0; m < 4; ++m)
#pragma unroll
                    for (int n = 0; n < 2; ++n) asm volatile("" :: "v"(acc[a][b][m][n]));
        return false; } };
struct EpiGlu {
    static constexpr bool PERM = true;
    const bf16_t* GG; const float* bias; bf16_t* Y4;
    __device__ __forceinline__ bool operator()(Acc& acc, const Unit& u, int wr, int wc, int fr, int fq) const {
        const int row0 = u.pm * BM + wr * 64 + fr, col0 = u.pn * BM + wc * 32 + 8 * fq;
#pragma unroll
        for (int bj = 0; bj < 2; ++bj) { const int col = col0 + bj * HALF; const f32x4 b0 = *(const f32x4*)(bias + col), b1 = *(const f32x4*)(bias + col + 4);
            u32x4 gq[2][4];
#pragma unroll
            for (int ai = 0; ai < 2; ++ai)
#pragma unroll
                for (int m = 0; m < 4; ++m) gq[ai][m] = *(const u32x4*)(GG + (size_t)(row0 + ai * HALF + m * 16) * BW + col);
#pragma unroll
            for (int ai = 0; ai < 2; ++ai)
#pragma unroll
                for (int m = 0; m < 4; ++m) { const size_t row = (size_t)(row0 + ai * HALF + m * 16);
                    float gg[8]; unpack8(gq[ai][m], gg);
                    const f32x4 v0 = acc[ai][bj][m][0] + b0, v1 = acc[ai][bj][m][1] + b1;
                    u32x4 w; w.x = pk2(gg[0] * sigmoidf_(v0[0]), gg[1] * sigmoidf_(v0[1])); w.y = pk2(gg[2] * sigmoidf_(v0[2]), gg[3] * sigmoidf_(v0[3]));
                    w.z = pk2(gg[4] * sigmoidf_(v1[0]), gg[5] * sigmoidf_(v1[1])); w.w = pk2(gg[6] * sigmoidf_(v1[2]), gg[7] * sigmoidf_(v1[3]));
                    *(u32x4*)(Y4 + row * DM + 1024 + col) = w; } }
        return false;
    }
};
struct EpiBranch {
    static constexpr bool PERM = true;
    const bf16_t* P; bf16_t* ACCb;
    __device__ __forceinline__ bool operator()(Acc& acc, const Unit& u, int wr, int wc, int fr, int fq) const {
        const int row0 = u.pm * BM + wr * 64 + fr, col0 = u.pn * BM + wc * 32 + 8 * fq; const int k = u.k;
        const bf16_t* gbase = P + (size_t)row0 * LDP + GATE_OFF + k * DM + col0;
        if (k < 3) {
#pragma unroll
            for (int ai = 0; ai < 2; ++ai) {
                u32x4 ga[8], gb[8];
#pragma unroll
                for (int m = 0; m < 4; ++m)
#pragma unroll
                    for (int bj = 0; bj < 2; ++bj) { const bf16_t* p = gbase + (size_t)(ai * HALF + m * 16) * LDP + bj * HALF; ga[m * 2 + bj] = *(const u32x4*)p; gb[m * 2 + bj] = *(const u32x4*)(p + DM); }
#pragma unroll
                for (int m = 0; m < 4; ++m)
#pragma unroll
                    for (int bj = 0; bj < 2; ++bj) { float g0[8], g1[8]; unpack8(ga[m * 2 + bj], g0); unpack8(gb[m * 2 + bj], g1);
                        float s[8];
#pragma unroll
                        for (int j = 0; j < 8; ++j) s[j] = g0[j] * __builtin_amdgcn_rcpf(g1[j]);
                        f32x4 v0 = acc[ai][bj][m][0], v1 = acc[ai][bj][m][1];
                        v0[0] *= s[0]; v0[1] *= s[1]; v0[2] *= s[2]; v0[3] *= s[3]; v1[0] *= s[4]; v1[1] *= s[5]; v1[2] *= s[6]; v1[3] *= s[7];
                        acc[ai][bj][m][0] = v0; acc[ai][bj][m][1] = v1; } }
            return true;
        }
#pragma unroll
        for (int ai = 0; ai < 2; ++ai) {
            u32x4 ga[8];
#pragma unroll
            for (int m = 0; m < 4; ++m)
#pragma unroll
                for (int bj = 0; bj < 2; ++bj) ga[m * 2 + bj] = *(const u32x4*)(gbase + (size_t)(ai * HALF + m * 16) * LDP + bj * HALF);
#pragma unroll
            for (int m = 0; m < 4; ++m)
#pragma unroll
                for (int bj = 0; bj < 2; ++bj) { float s[8]; unpack8(ga[m * 2 + bj], s);
                    f32x4 v0 = acc[ai][bj][m][0], v1 = acc[ai][bj][m][1];
                    v0[0] *= s[0]; v0[1] *= s[1]; v0[2] *= s[2]; v0[3] *= s[3]; v1[0] *= s[4]; v1[1] *= s[5]; v1[2] *= s[6]; v1[3] *= s[7];
                    u32x4 w; w.x = pk2(v0[0], v0[1]); w.y = pk2(v0[2], v0[3]); w.z = pk2(v1[0], v1[1]); w.w = pk2(v1[2], v1[3]);
                    *(u32x4*)(ACCb + (size_t)(row0 + ai * HALF + m * 16) * DM + col0 + bj * HALF) = w; } }
        return false;
    }
};
struct EpiResid {
    static constexpr bool PERM = false;
    float* XS; const float* srcLat; const float* srcCtx; const float* MODl; int gidx;
    __device__ __forceinline__ bool operator()(Acc& acc, const Unit& u, int wr, int wc, int fr, int fq) const {
        const int row0 = u.pm * BM + wr * 64 + fr, col0 = u.pn * BM + wc * 32 + 4 * fq;
        const int r = (u.pm * BM) < NLAT ? (u.pm * BM) / SEQ : 4;
        const float* src = (u.pm * BM) < NLAT ? srcLat : srcCtx;
        const float* mg = MODl + (size_t)(r * 6 + gidx) * DM;
#pragma unroll
        for (int bj = 0; bj < 2; ++bj) {
            f32x4 gm[2], xs[2][2][4];
#pragma unroll
            for (int n = 0; n < 2; ++n) { const int col = col0 + bj * HALF + n * 16; gm[n] = *(const f32x4*)(mg + col);
#pragma unroll
                for (int ai = 0; ai < 2; ++ai)
#pragma unroll
                    for (int m = 0; m < 4; ++m) xs[n][ai][m] = *(const f32x4*)(src + (size_t)(row0 + ai * HALF + m * 16) * DM + col); }
#pragma unroll
            for (int n = 0; n < 2; ++n) { const int col = col0 + bj * HALF + n * 16;
#pragma unroll
                for (int ai = 0; ai < 2; ++ai)
#pragma unroll
                    for (int m = 0; m < 4; ++m) *(f32x4*)(XS + (size_t)(row0 + ai * HALF + m * 16) * DM + col) = xs[n][ai][m] + gm[n] * acc[ai][bj][m][n]; } }
        return false;
    }
};
struct EpiMoe1 {
    static constexpr bool PERM = true;
    bf16_t* HID;
    __device__ __forceinline__ bool operator()(Acc& acc, const Unit& u, int wr, int wc, int fr, int fq) const {
        const size_t row0 = (size_t)u.z * MOE_PAD + u.pm * BM + wr * 64 + fr; const int col0 = u.pn * HALF + wc * 32 + 8 * fq;
#pragma unroll
        for (int ai = 0; ai < 2; ++ai)
#pragma unroll
            for (int m = 0; m < 4; ++m) { const f32x4 g0 = acc[ai][0][m][0], g1 = acc[ai][0][m][1], u0 = acc[ai][1][m][0], u1 = acc[ai][1][m][1];
                float h[8];
#pragma unroll
                for (int j = 0; j < 4; ++j) { h[j] = g0[j] * __builtin_amdgcn_rcpf(1.0f + __expf(-g0[j])) * u0[j]; h[4 + j] = g1[j] * __builtin_amdgcn_rcpf(1.0f + __expf(-g1[j])) * u1[j]; }
                u32x4 w; w.x = pk2(h[0], h[1]); w.y = pk2(h[2], h[3]); w.z = pk2(h[4], h[5]); w.w = pk2(h[6], h[7]);
                *(u32x4*)(HID + (row0 + ai * HALF + m * 16) * DEXP + col0) = w; }
        return false;
    }
};
struct EpiMoeY {
    static constexpr bool PERM = true;
    bf16_t* O;
    __device__ __forceinline__ bool operator()(Acc& acc, const Unit& u, int wr, int wc, int fr, int fq) const {
        const size_t row0 = (size_t)u.z * MOE_PAD + u.pm * BM + wr * 64 + fr; const int col0 = u.pn * BM + wc * 32 + 8 * fq;
#pragma unroll
        for (int ai = 0; ai < 2; ++ai)
#pragma unroll
            for (int m = 0; m < 4; ++m) { bf16_t* rowp = O + (row0 + ai * HALF + m * 16) * DM + col0;
#pragma unroll
                for (int bj = 0; bj < 2; ++bj) { const f32x4 v0 = acc[ai][bj][m][0], v1 = acc[ai][bj][m][1];
                    u32x4 w; w.x = pk2(v0[0], v0[1]); w.y = pk2(v0[2], v0[3]); w.z = pk2(v1[0], v1[1]); w.w = pk2(v1[2], v1[3]);
                    *(u32x4*)(rowp + bj * HALF) = w; } }
        return false;
    }
};

struct SchedS5a {
    int c;
    __device__ __forceinline__ bool next(int i, Unit& u) const { if (i > 0 || c >= 64) return false; u.z = c >> 1; u.pm = c & 1; u.pn = 0; u.k = 0;
        u.ao = ((long long)u.z * 512 + u.pm * BM) * 768 * 2; u.bo = (long long)u.z * 256 * 512 * 2; return true; }
    __device__ __forceinline__ void a_ready(const Unit&) const {}
    __device__ __forceinline__ void done(const Unit&) const {}
};
struct SchedS5b {
    int c;
    __device__ __forceinline__ bool next(int i, Unit& u) const { if (i > 0 || c >= 128) return false; u.z = c >> 2; u.pm = (c >> 1) & 1; u.pn = c & 1; u.k = 0;
        u.ao = ((long long)u.z * 512 + u.pm * BM) * 768 * 2; u.bo = ((long long)u.z * 512 + u.pn * BM) * 768 * 2; return true; }
    __device__ __forceinline__ void a_ready(const Unit&) const {}
    __device__ __forceinline__ void done(const Unit&) const {}
};
struct EpiXloc {
    static constexpr bool PERM = false;
    float* XL;
    __device__ __forceinline__ bool operator()(Acc& acc, const Unit& u, int wr, int wc, int fr, int fq) const {
        const int row0 = u.pm * BM + wr * 64 + fr, col0 = wc * 32 + 4 * fq; float* base = XL + (size_t)u.z * 512 * 256;
#pragma unroll
        for (int ai = 0; ai < 2; ++ai)
#pragma unroll
            for (int m = 0; m < 4; ++m) { float* rowp = base + (size_t)(row0 + ai * HALF + m * 16) * 256 + col0;
#pragma unroll
                for (int bj = 0; bj < 2; ++bj)
#pragma unroll
                    for (int n = 0; n < 2; ++n) *(f32x4*)(rowp + bj * HALF + n * 16) = acc[ai][bj][m][n]; }
        return false;
    }
};
struct EpiS5Out {
    static constexpr bool PERM = true;
    const bf16_t* P; const float* dskip; bf16_t* GG;
    __device__ __forceinline__ bool operator()(Acc& acc, const Unit& u, int wr, int wc, int fr, int fq) const {
        const int row0 = u.pm * BM + wr * 64 + fr, col0 = u.pn * BM + wc * 32 + 8 * fq; const int g = u.z;
#pragma unroll
        for (int bj = 0; bj < 2; ++bj) { const int col = col0 + bj * HALF; const int t = col >> 4, c0 = col & 15;
            const f32x4 d0 = *(const f32x4*)(dskip + g * 16 + c0), d1 = *(const f32x4*)(dskip + g * 16 + c0 + 4);
            u32x4 uq[2][4];
#pragma unroll
            for (int ai = 0; ai < 2; ++ai)
#pragma unroll
                for (int m = 0; m < 4; ++m) uq[ai][m] = *(const u32x4*)(P + ((size_t)(row0 + ai * HALF + m * 16) * 32 + t) * LDP + S5_OFF + g * 16 + c0);
#pragma unroll
            for (int ai = 0; ai < 2; ++ai)
#pragma unroll
                for (int m = 0; m < 4; ++m) { const size_t tok = (size_t)(row0 + ai * HALF + m * 16) * 32 + t;
                    float uu[8]; unpack8(uq[ai][m], uu);
                    const f32x4 v0 = acc[ai][bj][m][0], v1 = acc[ai][bj][m][1];
                    float y[8] = {v0[0] + d0[0] * uu[0], v0[1] + d0[1] * uu[1], v0[2] + d0[2] * uu[2], v0[3] + d0[3] * uu[3], v1[0] + d1[0] * uu[4], v1[1] + d1[1] * uu[5], v1[2] + d1[2] * uu[6], v1[3] + d1[3] * uu[7]};
#pragma unroll
                    for (int j = 0; j < 8; ++j) y[j] = 0.5f * y[j] * (1.0f + tanhf(0.7978845608028654f * (y[j] + 0.044715f * y[j] * y[j] * y[j])));
                    u32x4 w; w.x = pk2(y[0], y[1]); w.y = pk2(y[2], y[3]); w.z = pk2(y[4], y[5]); w.w = pk2(y[6], y[7]);
                    *(u32x4*)(GG + tok * BW + g * 16 + c0) = w; } }
        return false;
    }
};
}


__device__ __forceinline__ float wave_scan_incl(float v, int lane) {
#pragma unroll
    for (int o = 1; o < 64; o <<= 1) { const float t = __shfl_up(v, o); if (lane >= o) v += t; }
    return v;
}
__device__ __forceinline__ float wave_scanmax_incl(float v, int lane) {
#pragma unroll
    for (int o = 1; o < 64; o <<= 1) { const float t = __shfl_up(v, o); if (lane >= o) v = fmaxf(v, t); }
    return v;
}
__device__ __forceinline__ float wave_max(float v) {
#pragma unroll
    for (int o = 32; o >= 1; o >>= 1) v = fmaxf(v, __shfl_xor(v, o));
    return v;
}
__device__ __forceinline__ void unpack8h(const u32x4 w, bf16_t (&h)[8]) {
    h[0] = (bf16_t)(w.x & 0xFFFFu); h[1] = (bf16_t)(w.x >> 16); h[2] = (bf16_t)(w.y & 0xFFFFu); h[3] = (bf16_t)(w.y >> 16);
    h[4] = (bf16_t)(w.z & 0xFFFFu); h[5] = (bf16_t)(w.z >> 16); h[6] = (bf16_t)(w.w & 0xFFFFu); h[7] = (bf16_t)(w.w >> 16);
}

__device__ __forceinline__ int tokblock_of(int b, int dir, int c) { if (c < 4) return 256 + b * 4 + (dir ? 3 - c : c); const int j = c - 4; return b * 64 + (dir ? 63 - j : j); }
__device__ __forceinline__ u32x4 rev8h(const u32x4 v) { u32x4 r; r.x = (v.w >> 16) | (v.w << 16); r.y = (v.z >> 16) | (v.z << 16); r.z = (v.y >> 16) | (v.y << 16); r.w = (v.x >> 16) | (v.x << 16); return r; }
__device__ __forceinline__ u32x4 scale8h(const u32x4 v, const float4 a, const float4 b) { float f[8]; unpack8(v, f); u32x4 r; r.x = pk2(f[0] * a.x, f[1] * a.y); r.y = pk2(f[2] * a.z, f[3] * a.w); r.z = pk2(f[4] * b.x, f[5] * b.y); r.w = pk2(f[6] * b.z, f[7] * b.w); return r; }
__device__ __forceinline__ float dot8h(const u32x4 v, const float4 a, const float4 b) { float f[8]; unpack8(v, f); return (f[0] * a.x + f[1] * a.y) + (f[2] * a.z + f[3] * a.w) + (f[4] * b.x + f[5] * b.y) + (f[6] * b.z + f[7] * b.w); }
#define ML_FRAG_LOAD(KF, VF, cc_) do { const int tb_ = tokblock_of(b, dir, (cc_)); const bf16_t* kb_ = KTg + ((size_t)tb_ * 512 + h * 128 + 32 * wd + r16) * 64 + q4 * 8; const bf16_t* vb_ = VTg + ((size_t)tb_ * 512 + h * 128 + 64 * half + 32 * we + r16) * 64 + q4 * 8; \
        _Pragma("unroll") for (int ks_ = 0; ks_ < 2; ++ks_) _Pragma("unroll") for (int j_ = 0; j_ < 2; ++j_) { VF[j_][ks_] = *(const u32x4*)(vb_ + (size_t)j_ * 16 * 64 + ks_ * 32); KF[j_][ks_] = *(const u32x4*)(kb_ + (size_t)j_ * 16 * 64 + ks_ * 32); } } while (0)
#define ML_CHUNK(c_, KF, VF, KFN, VFN) do { const int c = (c_); \
        if (c + 1 < 68) ML_FRAG_LOAD(KFN, VFN, c + 1);                        \
        const float dec = sDEC[c]; \
        {   bf16_t* cs = CST + (size_t)(chain * 68 + c) * 128 * 128; \
            _Pragma("unroll") for (int je = 0; je < 2; ++je) _Pragma("unroll") for (int jd = 0; jd < 2; ++jd) { const int e = 64 * half + 32 * we + 16 * je + r16, d0 = 32 * wd + 16 * jd + q4 * 4; \
                u32x2 pk; pk.x = pk2(acc[je][jd][0], acc[je][jd][1]); pk.y = pk2(acc[je][jd][2], acc[je][jd][3]); *(u32x2*)(cs + (size_t)e * 128 + d0) = pk; } \
            if (nown) { _Pragma("unroll") for (int jd = 0; jd < 2; ++jd) { float nv = npart[jd]; nv += __shfl_xor(nv, 16); nv += __shfl_xor(nv, 32); if (q4 == 0) NST[(size_t)(chain * 68 + c) * 128 + 32 * wd + 16 * jd + r16] = nv; } } } \
        bf16x8 vfr[2][2]; \
        _Pragma("unroll") for (int ks = 0; ks < 2; ++ks) { const float4 wa = *(const float4*)(sWS + c * 64 + ks * 32 + q4 * 8), wb = *(const float4*)(sWS + c * 64 + ks * 32 + q4 * 8 + 4); \
            _Pragma("unroll") for (int je = 0; je < 2; ++je) { const u32x4 sv = scale8h(VF[je][ks], wa, wb); vfr[je][ks] = *(const bf16x8*)&sv; } \
            if (nown) { _Pragma("unroll") for (int jd = 0; jd < 2; ++jd) npart[jd] = (ks == 0 ? dec * npart[jd] : npart[jd]) + dot8h(KF[jd][ks], wa, wb); } } \
        _Pragma("unroll") for (int je = 0; je < 2; ++je) _Pragma("unroll") for (int jd = 0; jd < 2; ++jd) acc[je][jd] = acc[je][jd] * dec; \
        _Pragma("unroll") for (int ks = 0; ks < 2; ++ks) _Pragma("unroll") for (int je = 0; je < 2; ++je) _Pragma("unroll") for (int jd = 0; jd < 2; ++jd) \
            acc[je][jd] = __builtin_amdgcn_mfma_f32_16x16x32_bf16(*(const bf16x8*)&KF[jd][ks], vfr[je][ks], acc[je][jd], 0, 0, 0); } while (0)
__device__ __forceinline__ void mlstm_state_pass(const int chain, const int half, const bf16_t* __restrict__ Pm, const bf16_t* __restrict__ KTg, const bf16_t* __restrict__ VTg, const float* __restrict__ gate_b,
                                                 bf16_t* __restrict__ CST, float* __restrict__ NST, float* __restrict__ MST, unsigned char* shm, const int tid) {
    const int dir = chain & 1, h = (chain >> 1) & 3, b = chain >> 3, lane = tid & 63, w = tid >> 6, we = w >> 2, wd = w & 3, q4 = lane >> 4, r16 = lane & 15;
    const bool nown = (half == 0) && (we == 0);
    float* sE = (float*)shm; float* sWS = sE + 68 * 64; float* sAL = sWS + 68 * 64; float* sBE = sAL + 68; float* sMO = sBE + 68; float* sDEC = sMO + 68; float* sMB = sDEC + 68;
    const float gbi = gate_b[(dir * 2 + 0) * 4 + h], gbf = gate_b[(dir * 2 + 1) * 4 + h];
    const int gcol_i = ML_OFF + 2048 + (dir * 2 + 0) * 4 + h, gcol_f = ML_OFF + 2048 + (dir * 2 + 1) * 4 + h;
    u32x4 kfA[2][2], vfA[2][2], kfB[2][2], vfB[2][2];
    ML_FRAG_LOAD(kfA, vfA, 0);
    __syncthreads();
    unsigned gi_[9], gf_[9];
#pragma unroll
    for (int q = 0; q < 9; ++q) { const int c = min(w + 8 * q, 67); const size_t tokl = (size_t)step_tok(b, dir, c * 64 + lane); gi_[q] = Pm[tokl * LDP + gcol_i]; gf_[q] = Pm[tokl * LDP + gcol_f]; }
#pragma unroll
    for (int q = 0; q < 9; ++q) { const int c = w + 8 * q; if (c >= 68) break;
        const float ig = __uint_as_float(gi_[q] << 16) + gbi, fg = __uint_as_float(gf_[q] << 16) + gbf;
        const float lf = fminf(fg, 0.f) - log1pf(expf(-fabsf(fg)));
        const float bcs = wave_scan_incl(lf, lane); const float blast = __shfl(bcs, 63); const float ei = blast - bcs + ig; const float beta = wave_max(ei);
        sE[c * 64 + lane] = ei; if (lane == 0) { sAL[c] = blast; sBE[c] = beta; } }
    __syncthreads();
    if (tid == 0) { float m = 0.f; for (int c = 0; c < 68; ++c) { sMB[c] = m; const float mo = fmaxf(m + sAL[c], sBE[c]); sDEC[c] = expf(sAL[c] + m - mo); sMO[c] = mo; m = mo; } }
    __syncthreads();
    for (int idx = tid; idx < 68 * 64; idx += NTHR) { const int c = idx >> 6, i = idx & 63; sWS[c * 64 + (dir ? 63 - i : i)] = expf(sE[idx] - sMO[c]); }
    if (half == 0 && tid < 68) MST[chain * 68 + tid] = sMB[tid];
    __syncthreads();
    f32x4 acc[2][2];
#pragma unroll
    for (int je = 0; je < 2; ++je)
#pragma unroll
        for (int jd = 0; jd < 2; ++jd) acc[je][jd] = (f32x4){0.f, 0.f, 0.f, 0.f};
    float npart[2] = {0.f, 0.f};
    for (int c2 = 0; c2 < 68; c2 += 2) { ML_CHUNK(c2, kfA, vfA, kfB, vfB); ML_CHUNK(c2 + 1, kfB, vfB, kfA, vfA); }
    __syncthreads();
}
#undef ML_CHUNK
#undef ML_FRAG_LOAD
__device__ __forceinline__ void mlstm_out_item(const int chain, const int c, const bf16_t* __restrict__ Pm, const bf16_t* __restrict__ QKb, const bf16_t* __restrict__ VTg, const float* __restrict__ gate_b,
                                               const bf16_t* __restrict__ CST, const float* __restrict__ NST, const float* __restrict__ MST, float* __restrict__ Hout, unsigned char* shm, const int tid) {
    const int dir = chain & 1, h = (chain >> 1) & 3, b = chain >> 3, lane = tid & 63, w = tid >> 6;
    bf16_t* Qs = (bf16_t*)shm; bf16_t* Ks = (bf16_t*)(shm + 17408); bf16_t* VT = (bf16_t*)(shm + 34816); bf16_t* Cs = (bf16_t*)(shm + 53248); bf16_t* Ss = (bf16_t*)(shm + 88064);
    float* sc = (float*)(shm + 97280);
    __syncthreads();
#pragma unroll
    for (int i = 0; i < 2; ++i) { const int pid = tid + i * 512; const int s = pid >> 4, x0 = (pid & 15) * 8; const size_t toks = (size_t)step_tok(b, dir, c * 64 + s);
        *(u32x4*)(Qs + s * 136 + x0) = *(const u32x4*)(QKb + toks * 1024 + h * 128 + x0);
        *(u32x4*)(Ks + s * 136 + x0) = *(const u32x4*)(QKb + toks * 1024 + 512 + h * 128 + x0);
        { const int e = pid >> 3, o = pid & 7;
          const u32x4 vv = *(const u32x4*)(VTg + ((size_t)tokblock_of(b, dir, c) * 512 + h * 128 + e) * 64 + (dir ? 7 - o : o) * 8);
          *(u32x4*)(VT + e * 72 + o * 8) = dir ? rev8h(vv) : vv; } }
#pragma unroll
    for (int i = 0; i < 4; ++i) { const int pid = tid + i * 512; const int e = pid >> 4, x0 = (pid & 15) * 8;
        *(u32x4*)(Cs + e * 136 + x0) = *(const u32x4*)(CST + ((size_t)(chain * 68 + c) * 128 + e) * 128 + x0); }
    if (tid < 128) sc[384 + tid] = NST[(size_t)(chain * 68 + c) * 128 + tid];
    if (w == 0) {
        const float gbi = gate_b[(dir * 2 + 0) * 4 + h], gbf = gate_b[(dir * 2 + 1) * 4 + h];
        const size_t tokl = (size_t)step_tok(b, dir, c * 64 + lane);
        const float ig = bf2f(Pm[tokl * LDP + ML_OFF + 2048 + (dir * 2 + 0) * 4 + h]) + gbi;
        const float fg = bf2f(Pm[tokl * LDP + ML_OFF + 2048 + (dir * 2 + 1) * 4 + h]) + gbf;
        const float lf = fminf(fg, 0.f) - log1pf(expf(-fabsf(fg)));
        const float bcs = wave_scan_incl(lf, lane); const float gsv = ig - bcs; const float pm = wave_scanmax_incl(gsv, lane);
        const float m_in = MST[chain * 68 + c]; const float mt = bcs + fmaxf(m_in, pm);
        sc[lane] = bcs; sc[64 + lane] = gsv; sc[128 + lane] = mt; sc[192 + lane] = expf(bcs + m_in - mt); sc[256 + lane] = expf(-mt);
    }
    __syncthreads();
    const int tt = w >> 1;
    {   f32x4 aS[2] = {(f32x4){0.f, 0.f, 0.f, 0.f}, (f32x4){0.f, 0.f, 0.f, 0.f}};
#pragma unroll
        for (int ks = 0; ks < 4; ++ks) { const bf16x8 af = *(const bf16x8*)(Qs + (16 * tt + (lane & 15)) * 136 + ks * 32 + (lane >> 4) * 8);
#pragma unroll
            for (int i = 0; i < 2; ++i) { const int st = (w & 1) * 2 + i; const bf16x8 bfr = *(const bf16x8*)(Ks + (16 * st + (lane & 15)) * 136 + ks * 32 + (lane >> 4) * 8);
                aS[i] = __builtin_amdgcn_mfma_f32_16x16x32_bf16(af, bfr, aS[i], 0, 0, 0); } }
        float rs[4] = {0.f, 0.f, 0.f, 0.f};
#pragma unroll
        for (int i = 0; i < 2; ++i) { const int s = 16 * ((w & 1) * 2 + i) + (lane & 15); const float gsv = sc[64 + s];
#pragma unroll
            for (int q = 0; q < 4; ++q) { const int t = 16 * tt + (lane >> 4) * 4 + q; const float val = (s <= t) ? aS[i][q] * expf(sc[t] + gsv - sc[128 + t]) : 0.f; Ss[t * 72 + s] = f2bf(val); rs[q] += val; } }
#pragma unroll
        for (int q = 0; q < 4; ++q) { float r = rs[q]; r += __shfl_xor(r, 1); r += __shfl_xor(r, 2); r += __shfl_xor(r, 4); r += __shfl_xor(r, 8);
            if ((lane & 15) == 0) sc[512 + (w & 1) * 64 + 16 * tt + (lane >> 4) * 4 + q] = r; }
        {   const int t = tid >> 3, part = tid & 7; float dot = 0.f;
#pragma unroll
            for (int j = 0; j < 16; ++j) dot += bf2f(Qs[t * 136 + part * 16 + j]) * sc[384 + part * 16 + j];
            dot += __shfl_xor(dot, 1); dot += __shfl_xor(dot, 2); dot += __shfl_xor(dot, 4);
            if (part == 0) sc[640 + t] = sc[192 + t] * dot; }
    }
    __syncthreads();
    {   f32x4 aN[4];
#pragma unroll
        for (int i = 0; i < 4; ++i) aN[i] = (f32x4){0.f, 0.f, 0.f, 0.f};
#pragma unroll
        for (int ks = 0; ks < 4; ++ks) { const bf16x8 af = *(const bf16x8*)(Qs + (16 * tt + (lane & 15)) * 136 + ks * 32 + (lane >> 4) * 8);
#pragma unroll
            for (int i = 0; i < 4; ++i) { const int et = (w & 1) * 4 + i; const bf16x8 bfr = *(const bf16x8*)(Cs + (16 * et + (lane & 15)) * 136 + ks * 32 + (lane >> 4) * 8);
                aN[i] = __builtin_amdgcn_mfma_f32_16x16x32_bf16(af, bfr, aN[i], 0, 0, 0); } }
#pragma unroll
        for (int q = 0; q < 4; ++q) { const float it = sc[192 + 16 * tt + (lane >> 4) * 4 + q];
#pragma unroll
            for (int i = 0; i < 4; ++i) aN[i][q] *= it; }
#pragma unroll
        for (int ks = 0; ks < 2; ++ks) { const bf16x8 af = *(const bf16x8*)(Ss + (16 * tt + (lane & 15)) * 72 + ks * 32 + (lane >> 4) * 8);
#pragma unroll
            for (int i = 0; i < 4; ++i) { const int et = (w & 1) * 4 + i; const bf16x8 bfr = *(const bf16x8*)(VT + (16 * et + (lane & 15)) * 72 + ks * 32 + (lane >> 4) * 8);
                aN[i] = __builtin_amdgcn_mfma_f32_16x16x32_bf16(af, bfr, aN[i], 0, 0, 0); } }
#pragma unroll
        for (int q = 0; q < 4; ++q) { const int t = 16 * tt + (lane >> 4) * 4 + q; const size_t tokt = (size_t)step_tok(b, dir, c * 64 + t); const float dn = fmaxf(fabsf((sc[512 + t] + sc[576 + t]) + sc[640 + t]), sc[256 + t]);
#pragma unroll
            for (int i = 0; i < 4; ++i) { const int e = 16 * ((w & 1) * 4 + i) + (lane & 15); Hout[tokt * BW + h * 128 + e] = aN[i][q] / dn; } }
    }
}


#define SD_FRAG_LOAD(BF, XF, cc_) do { const int tb_ = tokblock_of(b, dir, (cc_)); const bf16_t* bb_ = BTg + ((size_t)tb_ * 256 + grp * 128 + 64 * (w >> 2) + r16) * 64 + q4 * 8; const bf16_t* xb_ = XTg + ((size_t)tb_ * 512 + h * 64 + 16 * (w & 3) + r16) * 64 + q4 * 8; \
        _Pragma("unroll") for (int ks_ = 0; ks_ < 2; ++ks_) { XF[ks_] = *(const u32x4*)(xb_ + ks_ * 32); _Pragma("unroll") for (int j_ = 0; j_ < 4; ++j_) BF[j_][ks_] = *(const u32x4*)(bb_ + (size_t)j_ * 16 * 64 + ks_ * 32); } } while (0)
#define SD_CHUNK(c_, BF, XF, BFN, XFN) do { const int c = (c_); \
        if (c + 1 < 68) SD_FRAG_LOAD(BFN, XFN, c + 1); \
        const float dec = sDEC[c]; \
        {   bf16_t* ss = SSTb + (size_t)(chain * 68 + c) * 64 * 128; const int p = 16 * (w & 3) + r16; \
            _Pragma("unroll") for (int j = 0; j < 4; ++j) { const int n0 = 16 * ((w >> 2) * 4 + j) + q4 * 4; u32x2 pk; pk.x = pk2(acc[j][0], acc[j][1]); pk.y = pk2(acc[j][2], acc[j][3]); *(u32x2*)(ss + (size_t)p * 128 + n0) = pk; } } \
        bf16x8 xfr[2]; \
        _Pragma("unroll") for (int ks = 0; ks < 2; ++ks) { const float4 wa = *(const float4*)(sSC + c * 64 + ks * 32 + q4 * 8), wb = *(const float4*)(sSC + c * 64 + ks * 32 + q4 * 8 + 4); const u32x4 sv = scale8h(XF[ks], wa, wb); xfr[ks] = *(const bf16x8*)&sv; } \
        _Pragma("unroll") for (int j = 0; j < 4; ++j) acc[j] = acc[j] * dec; \
        _Pragma("unroll") for (int ks = 0; ks < 2; ++ks) _Pragma("unroll") for (int j = 0; j < 4; ++j) acc[j] = __builtin_amdgcn_mfma_f32_16x16x32_bf16(*(const bf16x8*)&BF[j][ks], xfr[ks], acc[j], 0, 0, 0); } while (0)
__device__ __forceinline__ void ssd_state_pass(const int chain, const bf16_t* __restrict__ Pm, const bf16_t* __restrict__ BTg, const bf16_t* __restrict__ XTg, const float Aa, const float dtb,
                                               bf16_t* __restrict__ SSTb, unsigned char* shm, const int tid) {
    const int dir = chain & 1, h = (chain >> 1) & 7, b = chain >> 4, grp = h >> 2, lane = tid & 63, w = tid >> 6, q4 = lane >> 4, r16 = lane & 15;
    float* sSC = (float*)shm; float* sDEC = sSC + 68 * 64;
    const int dcol = SSD_OFF + 1536 + dir * 8 + h;
    u32x4 bfA[4][2], xfA[2], bfB[4][2], xfB[2];
    SD_FRAG_LOAD(bfA, xfA, 0);
    __syncthreads();
    unsigned dt_[9];
#pragma unroll
    for (int q = 0; q < 9; ++q) { const int c = min(w + 8 * q, 67); dt_[q] = Pm[(size_t)step_tok(b, dir, c * 64 + lane) * LDP + dcol]; }
#pragma unroll
    for (int q = 0; q < 9; ++q) { const int c = w + 8 * q; if (c >= 68) break;
        const float xv = __uint_as_float(dt_[q] << 16) + dtb; const float dtv = xv > 20.f ? xv : log1pf(expf(xv));
        const float cs = wave_scan_incl(dtv * Aa, lane); const float cl = __shfl(cs, 63);
        sSC[c * 64 + (dir ? 63 - lane : lane)] = dtv * expf(cl - cs); if (lane == 0) sDEC[c] = expf(cl); }
    __syncthreads();
    f32x4 acc[4];
#pragma unroll
    for (int j = 0; j < 4; ++j) acc[j] = (f32x4){0.f, 0.f, 0.f, 0.f};
    for (int c2 = 0; c2 < 68; c2 += 2) { SD_CHUNK(c2, bfA, xfA, bfB, xfB); SD_CHUNK(c2 + 1, bfB, xfB, bfA, xfA); }
    __syncthreads();
}
#undef SD_CHUNK
#undef SD_FRAG_LOAD
__device__ __forceinline__ void ssd_out_item(const int chain, const int c, const bf16_t* __restrict__ Pm, const bf16_t* __restrict__ XBb, const bf16_t* __restrict__ XTg, const float Aa, const float dtb,
                                             const bf16_t* __restrict__ SSTb, float* __restrict__ Yout, unsigned char* shm, const int tid) {
    const int dir = chain & 1, h = (chain >> 1) & 7, b = chain >> 4, grp = h >> 2, lane = tid & 63, w = tid >> 6;
    bf16_t* Cs = (bf16_t*)shm; bf16_t* Bs = (bf16_t*)(shm + 17408); bf16_t* XT = (bf16_t*)(shm + 34816); bf16_t* Sin = (bf16_t*)(shm + 44032); bf16_t* Gs = (bf16_t*)(shm + 61440);
    float* sc = (float*)(shm + 70656);
    __syncthreads();
#pragma unroll
    for (int i = 0; i < 2; ++i) { const int pid = tid + i * 512; const int s = pid >> 4, x0 = (pid & 15) * 8; const size_t toks = (size_t)step_tok(b, dir, c * 64 + s);
        *(u32x4*)(Bs + s * 136 + x0) = *(const u32x4*)(XBb + toks * 1024 + 512 + grp * 128 + x0);
        *(u32x4*)(Cs + s * 136 + x0) = *(const u32x4*)(XBb + toks * 1024 + 768 + grp * 128 + x0);
        const int p = pid >> 4;
        *(u32x4*)(Sin + p * 136 + x0) = *(const u32x4*)(SSTb + ((size_t)(chain * 68 + c) * 64 + p) * 128 + x0); }
    {   const int p = tid >> 3, o = tid & 7;
        const u32x4 vv = *(const u32x4*)(XTg + ((size_t)tokblock_of(b, dir, c) * 512 + h * 64 + p) * 64 + (dir ? 7 - o : o) * 8);
        *(u32x4*)(XT + p * 72 + o * 8) = dir ? rev8h(vv) : vv; }
    if (w == 0) { const size_t tokl = (size_t)step_tok(b, dir, c * 64 + lane);
        const float xv = bf2f(Pm[tokl * LDP + SSD_OFF + 1536 + dir * 8 + h]) + dtb; const float dtv = xv > 20.f ? xv : log1pf(expf(xv));
        sc[lane] = wave_scan_incl(dtv * Aa, lane); sc[64 + lane] = dtv; }
    __syncthreads();
    {   const int lt = w >> 1;
        f32x4 aG[2] = {(f32x4){0.f, 0.f, 0.f, 0.f}, (f32x4){0.f, 0.f, 0.f, 0.f}};
#pragma unroll
        for (int ks = 0; ks < 4; ++ks) { const bf16x8 af = *(const bf16x8*)(Cs + (16 * lt + (lane & 15)) * 136 + ks * 32 + (lane >> 4) * 8);
#pragma unroll
            for (int i = 0; i < 2; ++i) { const int st = (w & 1) * 2 + i; const bf16x8 bfr = *(const bf16x8*)(Bs + (16 * st + (lane & 15)) * 136 + ks * 32 + (lane >> 4) * 8);
                aG[i] = __builtin_amdgcn_mfma_f32_16x16x32_bf16(af, bfr, aG[i], 0, 0, 0); } }
#pragma unroll
        for (int i = 0; i < 2; ++i) { const int s = 16 * ((w & 1) * 2 + i) + (lane & 15); const float css = sc[s], dts = sc[64 + s];
#pragma unroll
            for (int q = 0; q < 4; ++q) { const int t = 16 * lt + (lane >> 4) * 4 + q; const float val = (s <= t) ? aG[i][q] * expf(sc[t] - css) * dts : 0.f; Gs[t * 72 + s] = f2bf(val); } }
    }
    __syncthreads();
    {   const int lt = w >> 1;
        f32x4 aY[2] = {(f32x4){0.f, 0.f, 0.f, 0.f}, (f32x4){0.f, 0.f, 0.f, 0.f}};
#pragma unroll
        for (int ks = 0; ks < 4; ++ks) { const bf16x8 af = *(const bf16x8*)(Cs + (16 * lt + (lane & 15)) * 136 + ks * 32 + (lane >> 4) * 8);
#pragma unroll
            for (int i = 0; i < 2; ++i) { const int pt = (w & 1) * 2 + i; const bf16x8 bfr = *(const bf16x8*)(Sin + (16 * pt + (lane & 15)) * 136 + ks * 32 + (lane >> 4) * 8);
                aY[i] = __builtin_amdgcn_mfma_f32_16x16x32_bf16(af, bfr, aY[i], 0, 0, 0); } }
#pragma unroll
        for (int q = 0; q < 4; ++q) { const float ec = expf(sc[16 * lt + (lane >> 4) * 4 + q]); aY[0][q] *= ec; aY[1][q] *= ec; }
#pragma unroll
        for (int ks = 0; ks < 2; ++ks) { const bf16x8 af = *(const bf16x8*)(Gs + (16 * lt + (lane & 15)) * 72 + ks * 32 + (lane >> 4) * 8);
#pragma unroll
            for (int i = 0; i < 2; ++i) { const int pt = (w & 1) * 2 + i; const bf16x8 bfr = *(const bf16x8*)(XT + (16 * pt + (lane & 15)) * 72 + ks * 32 + (lane >> 4) * 8);
                aY[i] = __builtin_amdgcn_mfma_f32_16x16x32_bf16(af, bfr, aY[i], 0, 0, 0); } }
#pragma unroll
        for (int q = 0; q < 4; ++q) { const int t = 16 * lt + (lane >> 4) * 4 + q; const size_t tokt = (size_t)step_tok(b, dir, c * 64 + t);
#pragma unroll
            for (int i = 0; i < 2; ++i) { const int p = 16 * ((w & 1) * 2 + i) + (lane & 15); Yout[tokt * BW + h * 64 + p] = aY[i][q]; } }
    }
}


#define FIDX(i) ((i) + ((i) >> 4))
#define FFT_X_BYTES 69632
__device__ constexpr float FFT_CW_RE[6][16] = {{0.f, 0.f, 0.f, 0.f, 0.f, 0.f, 0.f, 0.f, 0.f, 0.f, 0.f, 0.f, 0.f, 0.f, 0.f, 0.f}, {1.0f, 0.f, 0.f, 0.f, 0.f, 0.f, 0.f, 0.f, 0.f, 0.f, 0.f, 0.f, 0.f, 0.f, 0.f, 0.f}, {1.0f, 6.123233995736766e-17f, 0.f, 0.f, 0.f, 0.f, 0.f, 0.f, 0.f, 0.f, 0.f, 0.f, 0.f, 0.f, 0.f, 0.f}, {1.0f, 0.7071067811865476f, 6.123233995736766e-17f, -0.7071067811865475f, 0.f, 0.f, 0.f, 0.f, 0.f, 0.f, 0.f, 0.f, 0.f, 0.f, 0.f, 0.f}, {1.0f, 0.9238795325112867f, 0.7071067811865476f, 0.38268343236508984f, 6.123233995736766e-17f, -0.3826834323650897f, -0.7071067811865475f, -0.9238795325112867f, 0.f, 0.f, 0.f, 0.f, 0.f, 0.f, 0.f, 0.f}, {1.0f, 0.9807852804032304f, 0.9238795325112867f, 0.8314696123025452f, 0.7071067811865476f, 0.5555702330196023f, 0.38268343236508984f, 0.19509032201612833f, 6.123233995736766e-17f, -0.1950903220161282f, -0.3826834323650897f, -0.555570233019602f, -0.7071067811865475f, -0.8314696123025453f, -0.9238795325112867f, -0.9807852804032304f}};
__device__ constexpr float FFT_CW_IM[6][16] = {{0.f, 0.f, 0.f, 0.f, 0.f, 0.f, 0.f, 0.f, 0.f, 0.f, 0.f, 0.f, 0.f, 0.f, 0.f, 0.f}, {-0.0f, 0.f, 0.f, 0.f, 0.f, 0.f, 0.f, 0.f, 0.f, 0.f, 0.f, 0.f, 0.f, 0.f, 0.f, 0.f}, {-0.0f, -1.0f, 0.f, 0.f, 0.f, 0.f, 0.f, 0.f, 0.f, 0.f, 0.f, 0.f, 0.f, 0.f, 0.f, 0.f}, {-0.0f, -0.7071067811865475f, -1.0f, -0.7071067811865476f, 0.f, 0.f, 0.f, 0.f, 0.f, 0.f, 0.f, 0.f, 0.f, 0.f, 0.f, 0.f}, {-0.0f, -0.3826834323650898f, -0.7071067811865475f, -0.9238795325112867f, -1.0f, -0.9238795325112867f, -0.7071067811865476f, -0.3826834323650899f, 0.f, 0.f, 0.f, 0.f, 0.f, 0.f, 0.f, 0.f}, {-0.0f, -0.19509032201612825f, -0.3826834323650898f, -0.5555702330196022f, -0.7071067811865475f, -0.8314696123025452f, -0.9238795325112867f, -0.9807852804032304f, -1.0f, -0.9807852804032304f, -0.9238795325112867f, -0.8314696123025455f, -0.7071067811865476f, -0.5555702330196022f, -0.3826834323650899f, -0.1950903220161286f}};
__host__ __device__ constexpr int fft_bitrev(int k, int R) { int r = 0; for (int i = 0; i < R; ++i) if (k & (1 << i)) r |= 1 << (R - 1 - i); return r; }
template <int R, bool INV>
__device__ __forceinline__ void fft_pass(float2* __restrict__ X, const float2* __restrict__ TW, const int s0, const int gidx) {
    const int lowbits = 13 - s0 - R; const int stride = 1 << lowbits;
    const int low = gidx & (stride - 1), high = gidx >> lowbits; const int base = (high << (lowbits + R)) | low;
    const int p0 = FIDX(base);
#define FFT_SLOT(k) (lowbits >= 4 ? p0 + (k) * (stride + (stride >> 4)) : p0 + (k) + ((k) >> 4))
    float2 v[1 << R];
#pragma unroll
    for (int k = 0; k < (1 << R); ++k) v[k] = X[FFT_SLOT(k)];
    const int lw = low << s0;
    if (!INV) {
#pragma unroll
        for (int j = 0; j < R; ++j) { const int hk = 1 << (R - 1 - j);
#pragma unroll
            for (int k = 0; k < (1 << R); ++k) if (!(k & hk)) { const int kk = k & (hk - 1);
                const float2 a = v[k], b = v[k + hk]; v[k] = make_float2(a.x + b.x, a.y + b.y); const float dx = a.x - b.x, dy = a.y - b.y;
                if (kk == 0) v[k + hk] = make_float2(dx, dy);
                else if (2 * kk == hk) v[k + hk] = make_float2(dy, -dx);
                else { const float cr = FFT_CW_RE[R - j][kk], ci = FFT_CW_IM[R - j][kk]; v[k + hk] = make_float2(dx * cr - dy * ci, dx * ci + dy * cr); } } }
        if (lowbits > 0) {
#pragma unroll
            for (int k = 1; k < (1 << R); ++k) { const float2 w = TW[(lw * fft_bitrev(k, R)) & 8191]; const float2 a = v[k]; v[k] = make_float2(a.x * w.x - a.y * w.y, a.x * w.y + a.y * w.x); } }
    } else {
        if (lowbits > 0) {
#pragma unroll
            for (int k = 1; k < (1 << R); ++k) { const float2 w = TW[(lw * fft_bitrev(k, R)) & 8191]; const float2 a = v[k]; v[k] = make_float2(a.x * w.x + a.y * w.y, a.y * w.x - a.x * w.y); } }
#pragma unroll
        for (int j = R - 1; j >= 0; --j) { const int hk = 1 << (R - 1 - j);
#pragma unroll
            for (int k = 0; k < (1 << R); ++k) if (!(k & hk)) { const int kk = k & (hk - 1);
                const float2 a = v[k], b = v[k + hk]; float tx, ty;
                if (kk == 0) { tx = b.x; ty = b.y; }
                else if (2 * kk == hk) { tx = -b.y; ty = b.x; }
                else { const float cr = FFT_CW_RE[R - j][kk], ci = FFT_CW_IM[R - j][kk]; tx = b.x * cr + b.y * ci; ty = b.y * cr - b.x * ci; }
                v[k] = make_float2(a.x + tx, a.y + ty); v[k + hk] = make_float2(a.x - tx, a.y - ty); } }
    }
#pragma unroll
    for (int k = 0; k < (1 << R); ++k) X[FFT_SLOT(k)] = v[k];
#undef FFT_SLOT
}
__device__ __forceinline__ void fft_fwd(float2* X, const float2* TW, const int tid) {
    fft_pass<4, false>(X, TW, 0, tid); __syncthreads(); fft_pass<4, false>(X, TW, 4, tid); __syncthreads(); if (tid < 256) fft_pass<5, false>(X, TW, 8, tid); __syncthreads(); }
__device__ __forceinline__ void fft_inv(float2* X, const float2* TW, const int tid) {
    if (tid < 256) fft_pass<5, true>(X, TW, 8, tid); __syncthreads(); fft_pass<4, true>(X, TW, 4, tid); __syncthreads(); fft_pass<4, true>(X, TW, 0, tid); __syncthreads(); }
__device__ __forceinline__ void fft_twiddles(float2* TW, const int tid) {
#pragma unroll
    for (int k = 0; k < 16; ++k) { const int m = tid + k * 512; const float xx = (float)m * (1.0f / 4096.0f); TW[m] = make_float2(cospif(xx), -sinpif(xx)); }
}
__device__ __forceinline__ void hyena_spec_item(const int oc, const float* __restrict__ HR, const float* __restrict__ nrm, float2* __restrict__ HSPEC, unsigned char* shm, const int tid) {
    float2* X = (float2*)shm; const float2* TW = (const float2*)(shm + FFT_X_BYTES);
    const int o = oc >> 9, c = oc & 511; const float inv = 1.0f / nrm[oc];
    __syncthreads();
    float hv[16];
#pragma unroll
    for (int k = 0; k < 16; ++k) { const int j = tid + k * 512;
        const unsigned off = j < SEQ ? (unsigned)j * 2048u + o * 1024 + c : j == SEQ ? (unsigned)(o * 1024 + c) : (unsigned)(2 * SEQ - j) * 2048u + o * 1024 + 512 + c;
        hv[k] = HR[off]; }
#pragma unroll
    for (int k = 0; k < 16; ++k) { const int j = tid + k * 512; X[FIDX(j)] = make_float2(j == SEQ ? 0.f : hv[k] * inv, 0.f); }
    __syncthreads();
    fft_fwd(X, TW, tid);
    float4* out = (float4*)(HSPEC + (size_t)oc * 8192 + tid * 16); const float2* xs = X + 17 * tid;
#pragma unroll
    for (int k = 0; k < 8; ++k) { const float2 x0 = xs[2 * k], x1 = xs[2 * k + 1]; out[k] = make_float4(x0.x * (1.0f / 8192.0f), x0.y * (1.0f / 8192.0f), x1.x * (1.0f / 8192.0f), x1.y * (1.0f / 8192.0f)); }
}
__device__ __forceinline__ void fft_mul_spec(float2* X, const float2* __restrict__ H, const int tid) {
    const float4* h4 = (const float4*)(H + tid * 16); float2* xs = X + 17 * tid;
#pragma unroll
    for (int k = 0; k < 8; ++k) { const float4 hv = h4[k]; const float2 x0 = xs[2 * k], x1 = xs[2 * k + 1];
        xs[2 * k] = make_float2(x0.x * hv.x - x0.y * hv.y, x0.x * hv.y + x0.y * hv.x); xs[2 * k + 1] = make_float2(x1.x * hv.z - x1.y * hv.w, x1.x * hv.w + x1.y * hv.z); }
}
__device__ __forceinline__ void hyena_fft_item(const int item, const float* __restrict__ UT, const float2* __restrict__ HSPEC, const float* __restrict__ bias, float* __restrict__ YT, unsigned char* shm, const int tid) {
    float2* X = (float2*)shm; const float2* TW = (const float2*)(shm + FFT_X_BYTES);
    const int c = item >> 1, b0 = (item & 1) * 2, b1 = b0 + 1;
    const float* u0 = UT + (size_t)(b0 * 1536 + c) * SEQ + tid * 8; const float* u1 = UT + (size_t)(b1 * 1536 + c) * SEQ + tid * 8;
    const float bias0 = bias[c], bias1 = bias[512 + c];
    float2* xs = X + FIDX(8 * tid);
    float vr[8], vi[8];
    __syncthreads();
    { const float4 a0 = *(const float4*)u0, a1 = *(const float4*)(u0 + 4), c0 = *(const float4*)u1, c1 = *(const float4*)(u1 + 4);
      vr[0] = a0.x; vr[1] = a0.y; vr[2] = a0.z; vr[3] = a0.w; vr[4] = a1.x; vr[5] = a1.y; vr[6] = a1.z; vr[7] = a1.w;
      vi[0] = c0.x; vi[1] = c0.y; vi[2] = c0.z; vi[3] = c0.w; vi[4] = c1.x; vi[5] = c1.y; vi[6] = c1.z; vi[7] = c1.w; }
#pragma unroll
    for (int k = 0; k < 8; ++k) { xs[k] = make_float2(vr[k], vi[k]); xs[4352 + k] = make_float2(0.f, 0.f); }
    __syncthreads();
    fft_fwd(X, TW, tid);
    fft_mul_spec(X, HSPEC + (size_t)c * 8192, tid);
    __syncthreads();
    fft_inv(X, TW, tid);
    { const float* p0 = u0 + (size_t)512 * SEQ; const float* p1 = u1 + (size_t)512 * SEQ;
      const float4 a0 = *(const float4*)p0, a1 = *(const float4*)(p0 + 4), c0 = *(const float4*)p1, c1 = *(const float4*)(p1 + 4);
      const float xr[8] = {a0.x, a0.y, a0.z, a0.w, a1.x, a1.y, a1.z, a1.w}, xi[8] = {c0.x, c0.y, c0.z, c0.w, c1.x, c1.y, c1.z, c1.w};
#pragma unroll
      for (int k = 0; k < 8; ++k) { const float2 cv = xs[k]; const float zr = xr[k] * (cv.x + bias0 * vr[k]), zi = xi[k] * (cv.y + bias0 * vi[k]);
          vr[k] = zr; vi[k] = zi; xs[k] = make_float2(zr, zi); xs[4352 + k] = make_float2(0.f, 0.f); } }
    __syncthreads();
    fft_fwd(X, TW, tid);
    fft_mul_spec(X, HSPEC + (size_t)(512 + c) * 8192, tid);
    __syncthreads();
    fft_inv(X, TW, tid);
    { const float* p0 = u0 + (size_t)1024 * SEQ; const float* p1 = u1 + (size_t)1024 * SEQ;
      const float4 a0 = *(const float4*)p0, a1 = *(const float4*)(p0 + 4), c0 = *(const float4*)p1, c1 = *(const float4*)(p1 + 4);
      const float xr[8] = {a0.x, a0.y, a0.z, a0.w, a1.x, a1.y, a1.z, a1.w}, xi[8] = {c0.x, c0.y, c0.z, c0.w, c1.x, c1.y, c1.z, c1.w};
      float yr[8], yi[8];
#pragma unroll
      for (int k = 0; k < 8; ++k) { const float2 cv = xs[k]; yr[k] = xr[k] * (cv.x + bias1 * vr[k]); yi[k] = xi[k] * (cv.y + bias1 * vi[k]); }
      float* y0 = YT + (size_t)(b0 * 512 + c) * SEQ + tid * 8; float* y1 = YT + (size_t)(b1 * 512 + c) * SEQ + tid * 8;
      *(float4*)y0 = make_float4(yr[0], yr[1], yr[2], yr[3]); *(float4*)(y0 + 4) = make_float4(yr[4], yr[5], yr[6], yr[7]);
      *(float4*)y1 = make_float4(yi[0], yi[1], yi[2], yi[3]); *(float4*)(y1 + 4) = make_float4(yi[4], yi[5], yi[6], yi[7]); }
}

constexpr size_t al256(size_t x) { return (x + 255) & ~(size_t)255; }
constexpr size_t O_BAR = 0;
constexpr size_t O_MOD = 16384;
constexpr size_t O_NORM = O_MOD + al256((size_t)2 * 5 * 6 * DM * 4);
constexpr size_t O_QCTR = O_NORM + al256((size_t)2 * 2 * 1024 * 4);
constexpr size_t O_ZERO_END = O_QCTR + 512;
constexpr size_t O_XS = O_ZERO_END;
constexpr size_t O_HB = O_XS + al256((size_t)NTOK * DM * 4);
constexpr size_t O_P = O_HB + al256((size_t)NTOK * DM * 2);
constexpr size_t O_WIN = O_P + al256((size_t)NTOK * LDP * 2);
constexpr size_t O_WBR = O_WIN + al256((size_t)LDP * DM * 2);
constexpr size_t O_WOUT = O_WBR + al256((size_t)4 * DM * BW * 2);
constexpr size_t O_WGU = O_WOUT + al256((size_t)DM * DM * 2);
constexpr size_t O_WD = O_WGU + al256((size_t)NEXP * 2 * DEXP * DM * 2);
constexpr size_t O_GLU = O_WD + al256((size_t)NEXP * DM * DEXP * 2);
constexpr size_t O_Y4 = O_GLU + al256((size_t)BW * BW * 2);
constexpr size_t O_U = O_Y4 + al256((size_t)NTOK * DM * 2);
constexpr size_t O_QKB = O_U + al256((size_t)NTOK * 1536 * 4);
constexpr size_t O_CST = O_QKB + al256((size_t)NTOK * 1024 * 2);
constexpr size_t O_NST = O_CST + al256((size_t)32 * 68 * 128 * 128 * 2);
constexpr size_t O_MST = O_NST + al256((size_t)32 * 68 * 128 * 4);
constexpr size_t O_XBC = O_MST + al256((size_t)32 * 68 * 4);
constexpr size_t O_SST = O_XBC + al256((size_t)NTOK * 1024 * 2);
constexpr size_t O_HF = O_SST + al256((size_t)64 * 68 * 64 * 128 * 2);
constexpr size_t O_YF = O_HF + al256((size_t)2 * NTOK * BW * 4);
constexpr size_t O_SF = O_YF + al256((size_t)2 * NTOK * BW * 4);
constexpr size_t O_LDT = O_SF + al256((size_t)2 * NCTX * BW * 4);
constexpr size_t O_AP = O_LDT + al256((size_t)4096 * 16);
constexpr size_t O_BBT = O_AP + al256((size_t)4096 * 33 * 8);
constexpr size_t O_KT = O_BBT + al256((size_t)4096 * 16 * 8);
constexpr size_t O_S5A = O_KT + al256((size_t)32 * 2 * 32 * 256 * 4);
constexpr size_t O_S5B = O_S5A + al256((size_t)32 * 512 * 768 * 2);
constexpr size_t O_XCTX = O_S5B + al256((size_t)32 * 512 * 768 * 2);
constexpr size_t O_Z = O_XCTX + al256((size_t)4 * 32 * 2 * 64 * 8);
constexpr size_t O_HRAW = O_Z + al256((size_t)NTOK * BW * 4);
constexpr size_t O_HSPEC = O_HRAW + al256((size_t)(SEQ + CTXL) * 2048 * 4);
constexpr size_t O_K2C = O_HSPEC + al256((size_t)1024 * 8192 * 8);
constexpr size_t O_GG = O_K2C + al256((size_t)(2 * CTXL) * 1024 * 4);
constexpr size_t O_PROBS = O_GG + al256((size_t)NTOK * BW * 2);
constexpr size_t O_ROWTOK = O_PROBS + al256((size_t)NTOK * 16 * 4);
constexpr size_t O_ROWGATE = O_ROWTOK + al256((size_t)NEXP * MOE_PAD * 4);
constexpr size_t O_INV = O_ROWGATE + al256((size_t)NEXP * MOE_PAD * 4);
constexpr size_t O_NORMP = O_INV + al256((size_t)NTOK * 16 * 4);
constexpr size_t WS_END = O_NORMP + al256((size_t)4 * 256 * 2048 * 4);
constexpr size_t O_XG = O_P;
constexpr size_t O_HID = O_P + al256((size_t)NEXP * MOE_PAD * DM * 2);
constexpr size_t O_YEXP = O_HID + al256((size_t)NEXP * MOE_PAD * DEXP * 2);
static_assert(O_YEXP + (size_t)NEXP * MOE_PAD * DM * 2 <= O_WIN, "MoE temporaries must fit inside P");
static_assert((size_t)NTOK * DM * 2 <= (size_t)NTOK * 1536 * 4, "ACCb must fit inside U");
static_assert((size_t)26214400 + (size_t)2 * 17825792 + (size_t)272 * 256 * 64 * 2 <= (size_t)NTOK * DM * 2, "strip buffers must fit inside HB");
static_assert(WS_END <= (size_t)1851000000, "workspace map exceeds the guaranteed size");

struct Args {
    const float* in[47];
    float* out; unsigned char* ws;
    int ph_lo, ph_hi;
};

__device__ __forceinline__ void conv_tile(const float* __restrict__ src, int ldsrc, int nvalid, int k0, int n0, bf16_t* __restrict__ dst, int lddst, int mode, float* T, int tid) {
    { const int n = tid & 63, kr = tid >> 6;
#pragma unroll
      for (int i = 0; i < 8; ++i) { const int k = i * 8 + kr; T[k * 65 + n] = (n0 + n < nvalid) ? src[(size_t)(k0 + k) * ldsrc + n0 + n] : 0.f; } }
    __syncthreads();
    { const int n = tid >> 3, kc = (tid & 7) * 8; const int gn = n0 + n;
      const int drow = mode == 0 ? gn : (32 * (gn >> 4) + (mode == 2 ? 16 : 0) + (gn & 15));
      u32x4 w; w.x = pk2(T[(kc + 0) * 65 + n], T[(kc + 1) * 65 + n]); w.y = pk2(T[(kc + 2) * 65 + n], T[(kc + 3) * 65 + n]);
      w.z = pk2(T[(kc + 4) * 65 + n], T[(kc + 5) * 65 + n]); w.w = pk2(T[(kc + 6) * 65 + n], T[(kc + 7) * 65 + n]);
      *(u32x4*)(dst + (size_t)drow * lddst + k0 + kc) = w; }
    __syncthreads();
}

#define IN(id) (lo <= (id) && (id) < hi)
#define SEAM(id) do { if (hi > (id) + 1) xcd_barrier(bar); } while (0)
#define PH_BEGIN int tid = threadIdx.x; asm volatile("" : "+v"(tid) :: "memory"); const int lane = tid & 63, wave = tid >> 6; (void)lane; (void)wave;

#define x_in (PT(0))
#define c_in (PT(1))
#define ctx_in (PT(2))
#define cctx_in (PT(3))
#define ada_w (PT(4))
#define ada_b (PT(5))
#define norm_mix (PT(6))
#define norm_ffn (PT(7))
#define w_in (PT(8))
#define XS ((float*)(a.ws + O_XS))
#define MOD ((float*)(a.ws + O_MOD))
#define NORM ((float*)(a.ws + O_NORM))
#define NORMP ((float*)(a.ws + O_NORMP))
#define MODl (MOD + (size_t)l * 5 * 6 * DM)
#define HB ((bf16_t*)(a.ws + O_HB))
#define P ((bf16_t*)(a.ws + O_P))
#define WIN ((bf16_t*)(a.ws + O_WIN))
#define WBR ((bf16_t*)(a.ws + O_WBR))
#define WOUT ((bf16_t*)(a.ws + O_WOUT))
#define WGU ((bf16_t*)(a.ws + O_WGU))
#define WD ((bf16_t*)(a.ws + O_WD))
#define GLU ((bf16_t*)(a.ws + O_GLU))
#define Y4 ((bf16_t*)(a.ws + O_Y4))
#define U ((float*)(a.ws + O_U))
#define ACCb ((bf16_t*)(a.ws + O_U))
#define QKB ((bf16_t*)(a.ws + O_QKB))
#define CST ((bf16_t*)(a.ws + O_CST))
#define NST ((float*)(a.ws + O_NST))
#define MST ((float*)(a.ws + O_MST))
#define XBC ((bf16_t*)(a.ws + O_XBC))
#define SSTB ((bf16_t*)(a.ws + O_SST))
#define HF ((float*)(a.ws + O_HF))
#define HBk (HF + (size_t)NTOK * BW)
#define YF ((float*)(a.ws + O_YF))
#define YB (YF + (size_t)NTOK * BW)
#define SF ((float*)(a.ws + O_SF))
#define SB (SF + (size_t)NCTX * BW)
#define LDT ((double2*)(a.ws + O_LDT))
#define APW ((float2*)(a.ws + O_AP))
#define BBT ((float2*)(a.ws + O_BBT))
#define KTB ((float*)(a.ws + O_KT))
#define S5A ((bf16_t*)(a.ws + O_S5A))
#define S5B ((bf16_t*)(a.ws + O_S5B))
#define XCTX ((float2*)(a.ws + O_XCTX))
#define S5P ((bf16_t*)(a.ws + O_HB))
#define XLOC ((float*)(a.ws + O_HB + (size_t)32 * 256 * 512 * 2))
#define KTG ((bf16_t*)(a.ws + O_HB + (size_t)26214400))
#define VTG ((bf16_t*)(a.ws + O_HB + (size_t)26214400 + (size_t)17825792))
#define BTG ((bf16_t*)(a.ws + O_HB + (size_t)26214400 + (size_t)2 * 17825792))
#define XTG ((bf16_t*)(a.ws + O_GG))
#define Z ((float*)(a.ws + O_Z))
#define HRAW ((float*)(a.ws + O_HRAW))
#define HSPEC ((float2*)(a.ws + O_HSPEC))
#define UT ((float*)(a.ws + O_U))
#define YT ((float*)(a.ws + O_Z))
#define QCTR ((int*)(a.ws + O_QCTR))
#define K2C ((float*)(a.ws + O_K2C))
#define GG ((bf16_t*)(a.ws + O_GG))
#define PROBS ((float*)(a.ws + O_PROBS))
#define ROWTOK ((int*)(a.ws + O_ROWTOK))
#define ROWGATE ((float*)(a.ws + O_ROWGATE))
#define XG ((bf16_t*)(a.ws + O_XG))
#define HID ((bf16_t*)(a.ws + O_HID))
#define YEXP ((bf16_t*)(a.ws + O_YEXP))
#define INV ((int*)(a.ws + O_INV))


__device__ __forceinline__ void moe_pair(float4 (&a)[8], const int r1, const int r2, const float g2scale, const int lane, const float* __restrict__ rowgate, const bf16_t* __restrict__ yexp) {
    const float gt1 = rowgate[r1], gt2 = rowgate[r2] * g2scale;
    const bf16_t* y1 = yexp + (size_t)r1 * DM + lane * 4; const bf16_t* y2 = yexp + (size_t)r2 * DM + lane * 4;
    u32x2 w1[8], w2[8];
#pragma unroll
    for (int i = 0; i < 8; ++i) { w1[i] = *(const u32x2*)(y1 + i * 256); w2[i] = *(const u32x2*)(y2 + i * 256); }
#pragma unroll
    for (int i = 0; i < 8; ++i) {
        a[i].x += gt1 * __uint_as_float(w1[i].x << 16); a[i].y += gt1 * __uint_as_float(w1[i].x & 0xFFFF0000u); a[i].z += gt1 * __uint_as_float(w1[i].y << 16); a[i].w += gt1 * __uint_as_float(w1[i].y & 0xFFFF0000u);
        a[i].x += gt2 * __uint_as_float(w2[i].x << 16); a[i].y += gt2 * __uint_as_float(w2[i].x & 0xFFFF0000u); a[i].z += gt2 * __uint_as_float(w2[i].y << 16); a[i].w += gt2 * __uint_as_float(w2[i].y & 0xFFFF0000u); }
}
__device__ __forceinline__ void moe_combine(float4 (&v)[8], const int tok, const int lane, const int* __restrict__ inv, const float* __restrict__ rowgate, const bf16_t* __restrict__ yexp, const float* __restrict__ m5) {
    float4 a[8], mm[8];
#pragma unroll
    for (int i = 0; i < 8; ++i) { a[i] = make_float4(0.f, 0.f, 0.f, 0.f); mm[i] = *(const float4*)(m5 + i * 256 + lane * 4); }
    const int4* ip = (const int4*)(inv + (size_t)tok * 16);
    const int4 q0 = ip[0], q1 = ip[1], q2 = ip[2], q3 = ip[3];
    const int rows[16] = {q0.x, q0.y, q0.z, q0.w, q1.x, q1.y, q1.z, q1.w, q2.x, q2.y, q2.z, q2.w, q3.x, q3.y, q3.z, q3.w};
    int prow = -1;
#pragma unroll
    for (int e = 0; e < 16; ++e) { const int row = __builtin_amdgcn_readfirstlane(rows[e]);
        if (row >= 0) { if (prow >= 0) { moe_pair(a, prow, row, 1.0f, lane, rowgate, yexp); prow = -1; } else prow = row; } }
    if (prow >= 0) moe_pair(a, prow, prow, 0.0f, lane, rowgate, yexp);
#pragma unroll
    for (int i = 0; i < 8; ++i) { v[i].x += mm[i].x * a[i].x; v[i].y += mm[i].y * a[i].y; v[i].z += mm[i].z * a[i].z; v[i].w += mm[i].w * a[i].w; }
}
struct CvU { const float* src; bf16_t* dst; int ldsrc, nvalid, k0, n0, lddst, mode; };
__device__ __forceinline__ void cv_load(const CvU& u, float4 (&r)[8], const int tid) {
#pragma unroll
    for (int i = 0; i < 8; ++i) { const int idx = tid + i * 512; const int k = idx >> 6, n = u.n0 + (idx & 63) * 4;
        r[i] = (n < u.nvalid) ? *(const float4*)(u.src + (size_t)(u.k0 + k) * u.ldsrc + n) : make_float4(0.f, 0.f, 0.f, 0.f); }
}
__device__ __forceinline__ void cv_stage(float* T, const float4 (&r)[8], const int tid) {
#pragma unroll
    for (int i = 0; i < 8; ++i) { const int idx = tid + i * 512; float* p = T + (idx >> 6) * 257 + (idx & 63) * 4; p[0] = r[i].x; p[1] = r[i].y; p[2] = r[i].z; p[3] = r[i].w; }
}
__device__ __forceinline__ void cv_store(const CvU& u, const float* T, const int tid) {
#pragma unroll
    for (int j = 0; j < 4; ++j) { const int o = tid + j * 512; const int kc = (o & 7) * 8, n = o >> 3; const int gn = u.n0 + n;
        const int drow = u.mode == 0 ? gn : (256 * (gn >> 7) + (u.mode == 2 ? 128 : 0) + (gn & 127));
        const float* t = T + kc * 257 + n;
        u32x4 w; w.x = pk2(t[0], t[257]); w.y = pk2(t[2 * 257], t[3 * 257]); w.z = pk2(t[4 * 257], t[5 * 257]); w.w = pk2(t[6 * 257], t[7 * 257]);
        *(u32x4*)(u.dst + (size_t)drow * u.lddst + u.k0 + kc) = w; }
}
#define CV_RUN(LL, QSTART, QSTEP, QEND) do { \
                const float* wbr = PT(40) + (size_t)(LL) * 4 * BW * DM; const float* wout = PT(41) + (size_t)(LL) * DM * DM; \
                const float* wg = PT(43) + (size_t)(LL) * NEXP * DM * DEXP; const float* wu = PT(44) + (size_t)(LL) * NEXP * DM * DEXP; const float* wd = PT(45) + (size_t)(LL) * NEXP * DEXP * DM; \
                const float* wglu = PT(32) + (size_t)(LL) * BW * BW; const float* win = w_in + (size_t)(LL) * DM * IN_W; \
                const int cv_step = (QSTEP), cv_end = (QEND); \
                __syncthreads(); \
                int q = (QSTART); int buf = 0; CvU u; float4 r[8]; \
                if (q < cv_end) { CV_DECODE(q, u); cv_load(u, r, tid); } \
                while (q < cv_end) { \
                    float* T = sf + buf * (64 * 257); \
                    cv_stage(T, r, tid); \
                    __syncthreads(); \
                    const CvU cur = u; const int qn = q + cv_step; \
                    if (qn < cv_end) { CV_DECODE(qn, u); cv_load(u, r, tid); } \
                    cv_store(cur, T, tid); \
                    buf ^= 1; q = qn; \
                } \
                __syncthreads(); } while (0)
#define CV_DECODE(q_, u_) do { int qq_ = (q_); \
                    if (qq_ < n_win) { u_ = CvU{win, WIN, IN_W, IN_W, (qq_ / 55) * 64, (qq_ % 55) * 256, DM, 0}; } else { qq_ -= n_win; \
                    if (qq_ < n_br) { const int k = qq_ >> 6, r = qq_ & 63; u_ = CvU{wbr + (size_t)k * BW * DM, WBR + (size_t)k * DM * BW, DM, DM, (r >> 3) * 64, (r & 7) * 256, BW, 0}; } else { qq_ -= n_br; \
                    if (qq_ < n_out) { u_ = CvU{wout, WOUT, DM, DM, (qq_ >> 3) * 64, (qq_ & 7) * 256, DM, 0}; } else { qq_ -= n_out; \
                    if (qq_ < n_glu) { u_ = CvU{wglu, GLU, BW, BW, (qq_ >> 1) * 64, (qq_ & 1) * 256, BW, 0}; } else { qq_ -= n_glu; \
                    if (qq_ < n_gu) { const int e = qq_ / 384, r = qq_ % 384, up = r / 192, r2 = r % 192; u_ = CvU{(up ? wu : wg) + (size_t)e * DM * DEXP, WGU + (size_t)e * 2 * DEXP * DM, DEXP, DEXP, (r2 / 6) * 64, (r2 % 6) * 256, DM, 1 + up}; } else { qq_ -= n_gu; \
                    { const int e = qq_ / 192, r = qq_ % 192; u_ = CvU{wd + (size_t)e * DEXP * DM, WD + (size_t)e * DM * DEXP, DM, DM, (r >> 3) * 64, (r & 7) * 256, DEXP, 0}; } } } } } } } while (0)
template <int LAYER>
__device__ __forceinline__ void layer_body(const Args& a, const XcdBarrier& bar, const int lo, const int hi, const int bid, const int G, unsigned char* const shm, float* const sf, const float** const ptab) {
        constexpr int l = LAYER;
        constexpr int PB = 1 + 16 * l;
        const bool lastl = (l == 1);

        const int nPanels = lastl ? 64 : 68;
        const int M2 = nPanels * 256;

        if (IN(PB + 0)) for (int rep_ = 0; rep_ < (l == 0 ? PROBE_REPS(0) : 1); ++rep_) {
            PH_BEGIN
            {   const int n_win = 32 * 55, n_br = 4 * 64, n_out = 32 * 8, n_glu = 16, n_gu = 16 * 2 * 192, n_d = 16 * 192;
                const int n_grp1 = n_win + n_br + n_out + n_glu, total = n_grp1 + n_gu + n_d;
                const int q_lo = (l > 0 && G > 128) ? n_win : 0;
                CV_RUN(l, q_lo + bid, G, total);
            }
            for (int set = 0; set < (lastl ? 1 : 2); ++set) {
                const int L = set ? CTXL : SEQ; float* HR = HRAW + (set ? (size_t)SEQ * 2048 : 0);
                const float* w1 = PT(11) + l * 33 * 64; const float* b1 = PT(12) + l * 64; const float* fr1 = PT(13) + l * 64; const float* w2 = PT(14) + l * 64 * 64; const float* b2 = PT(15) + l * 64;
                const float* fr2 = PT(16) + l * 64; const float* w3 = PT(17) + l * 64 * 2048; const float* decay = PT(18) + l * 2048;
                float* feats = sf; float* h1 = sf + 16 * 33; float* h2 = h1 + 16 * 64;
                float nacc[4] = {0.f, 0.f, 0.f, 0.f};
                for (int base = bid; base < L; base += 16 * G) {
                    __syncthreads();
                    for (int e = tid; e < 16 * 33; e += NTHR) { const int ti = e / 33, fi = e % 33; int t = base + ti * G; if (t > L - 1) t = L - 1;
                        float v;
                        if (fi == 0) v = (float)t / (float)(L - 1);
                        else { const int j = (fi - 1) & 15; const double fr = 1e-4 + (double)j * ((15.0 - 1e-4) / 15.0); const double ang = (2.0 * 3.14159265358979323846 / (double)L) * (double)t * fr; v = fi <= 16 ? (float)cos(ang) : (float)(-sin(ang)); }
                        feats[e] = v; }
                    __syncthreads();
                    { const int j = tid & 63, ti = tid >> 6; float s0 = b1[j], s1 = s0;
_Pragma("unroll 3")
                      for (int i = 0; i < 33; ++i) { const float wv = w1[i * 64 + j]; s0 += feats[ti * 33 + i] * wv; s1 += feats[(ti + 8) * 33 + i] * wv; }
                      const float f1 = fr1[j]; h1[ti * 64 + j] = sinf(f1 * s0); h1[(ti + 8) * 64 + j] = sinf(f1 * s1); }
                    __syncthreads();
                    { const int j = tid & 63, ti = tid >> 6; float s0 = b2[j], s1 = s0;
_Pragma("unroll 4")
                      for (int i = 0; i < 64; ++i) { const float wv = w2[i * 64 + j]; s0 += h1[ti * 64 + i] * wv; s1 += h1[(ti + 8) * 64 + i] * wv; }
                      const float f2 = fr2[j]; h2[ti * 64 + j] = sinf(f2 * s0); h2[(ti + 8) * 64 + j] = sinf(f2 * s1); }
                    __syncthreads();
                    float acc[16][4];
#pragma unroll
                    for (int ti = 0; ti < 16; ++ti) { acc[ti][0] = 0.f; acc[ti][1] = 0.f; acc[ti][2] = 0.f; acc[ti][3] = 0.f; }
#pragma unroll 2
                    for (int i = 0; i < 64; ++i) { const float* wrow = w3 + (size_t)i * 2048 + tid; const float wa = wrow[0], wb = wrow[512], wc2 = wrow[1024], wd2 = wrow[1536];
#pragma unroll
                        for (int ti = 0; ti < 16; ++ti) { const float hv = h2[ti * 64 + i]; acc[ti][0] += hv * wa; acc[ti][1] += hv * wb; acc[ti][2] += hv * wc2; acc[ti][3] += hv * wd2; } }
                    float dk[4];
#pragma unroll
                    for (int k = 0; k < 4; ++k) dk[k] = fabsf(decay[tid + k * 512]);
#pragma unroll
                    for (int ti = 0; ti < 16; ++ti) { const int t = base + ti * G; if (t < L) { const float tn = (float)t / (float)(L - 1);
#pragma unroll
                        for (int k = 0; k < 4; ++k) { const float v = acc[ti][k] * expf(-tn * dk[k]); HR[(size_t)t * 2048 + tid + k * 512] = v; nacc[k] += fabsf(v); } } }
                }
                float* nrp = NORMP + ((size_t)(l * 2 + set) * 256 + bid) * 2048;
#pragma unroll
                for (int k = 0; k < 4; ++k) nrp[tid + k * 512] = nacc[k];
            }
            for (int idx = bid * NTHR + tid; idx < 4096; idx += G * NTHR) { const int n = idx & 63, g = (idx >> 6) & 31, dir = idx >> 11;
                const double are = (double)(PT(24) + l * 4096)[idx], aim = (double)(PT(25) + l * 4096)[idx]; const double lam = are < -1e-4 ? are : -1e-4; const double dt = exp((double)(PT(26) + l * 64)[dir * 32 + g]);
                const double ldre = lam * dt, ldim = aim * dt; LDT[idx] = make_double2(ldre, ldim);
                const double mag = exp(ldre); const double ar = mag * cos(ldim), ai = mag * sin(ldim);
                const double den = lam * lam + aim * aim; const double nr = ar - 1.0, ni = ai; const double fre = (nr * lam + ni * aim) / den, fim = (ni * lam - nr * aim) / den;
                const float* b_re = PT(27) + l * 32 * 64 * 16; const float* b_im = PT(28) + l * 32 * 64 * 16;
#pragma unroll 4
                for (int c = 0; c < 16; ++c) { const double br = (double)b_re[(g * 64 + n) * 16 + c], bi = (double)b_im[(g * 64 + n) * 16 + c]; BBT[idx * 16 + c] = make_float2((float)(fre * br - fim * bi), (float)(fre * bi + fim * br)); }
            }
            for (int e2 = bid * NTHR + tid; e2 < 4096 * 33; e2 += G * NTHR) { const int idx = e2 / 33, k = e2 - idx * 33; const int g = (idx >> 6) & 31, dir = idx >> 11;
                const double are = (double)(PT(24) + l * 4096)[idx], aim = (double)(PT(25) + l * 4096)[idx]; const double lam = are < -1e-4 ? are : -1e-4; const double dt = exp((double)(PT(26) + l * 64)[dir * 32 + g]);
                const double ldre = lam * dt, ldim = aim * dt; const double mk = exp(ldre * k); APW[e2] = make_float2((float)(mk * cos(ldim * k)), (float)(mk * sin(ldim * k))); }
            if (l == 0 && lo == 0) xcd_barrier(bar);
            for (int tok = bid * 8 + wave; tok < NTOK; tok += G * 8) {
                const int r = tok < NLAT ? tok / SEQ : 4; const float* xr = l == 0 ? (tok < NLAT ? x_in + (size_t)tok * DM : ctx_in + (size_t)(tok - NLAT) * DM) : XS + (size_t)tok * DM; const float* gn = norm_mix + l * DM;
                const float* sh = MODl + (size_t)(r * 6 + 0) * DM; const float* sc = MODl + (size_t)(r * 6 + 1) * DM;
                float4 v[8]; float ss = 0.f;
#pragma unroll
                for (int i = 0; i < 8; ++i) v[i] = *(const float4*)(xr + i * 256 + lane * 4);
                if (l > 0) {
                    moe_combine(v, tok, lane, INV, ROWGATE, YEXP, MOD + (size_t)((l - 1) * 5 + r) * 6 * DM + 5 * DM);
#pragma unroll
                    for (int i = 0; i < 8; ++i) *(float4*)(XS + (size_t)tok * DM + i * 256 + lane * 4) = v[i]; }
#pragma unroll
                for (int i = 0; i < 8; ++i) ss += v[i].x * v[i].x + v[i].y * v[i].y + v[i].z * v[i].z + v[i].w * v[i].w;
                ss = wave_sum(ss); const float rs = rsqrtf(ss * (1.0f / DM) + 1e-6f);
#pragma unroll
                for (int i = 0; i < 8; ++i) { const int d = i * 256 + lane * 4; const float4 g4 = *(const float4*)(gn + d), s4 = *(const float4*)(sc + d), h4 = *(const float4*)(sh + d);
                    v[i].x = v[i].x * rs * g4.x * (1.f + s4.x) + h4.x; v[i].y = v[i].y * rs * g4.y * (1.f + s4.y) + h4.y; v[i].z = v[i].z * rs * g4.z * (1.f + s4.z) + h4.z; v[i].w = v[i].w * rs * g4.w * (1.f + s4.w) + h4.w; }
#pragma unroll
                for (int i = 0; i < 8; ++i) { u32x2 w; w.x = pk2(v[i].x, v[i].y); w.y = pk2(v[i].z, v[i].w); *(u32x2*)(HB + (size_t)tok * DM + i * 256 + lane * 4) = w; }
            }
            SEAM(PB + 0);
        }

        if (IN(PB + 1)) for (int rep_ = 0; rep_ < PROBE_REPS(1); ++rep_) {
            PH_BEGIN
            for (int base = bid * 8; base < (lastl ? 1 : 2) * 1024; base += G * 8) {
                const int idx = base + (tid & 7), sl = tid >> 3; const int set = idx >> 10, oc = idx & 1023, o = oc >> 9, c = oc & 511;
                const float* pp = NORMP + (size_t)(l * 2 + set) * 256 * 2048 + o * 1024 + c + (size_t)(sl * 4) * 2048; float sacc = 0.f;
#pragma unroll
                for (int j = 0; j < 4; ++j) { const float p0 = pp[(size_t)j * 2048], p1 = pp[(size_t)j * 2048 + 512]; sacc += (sl * 4 + j < G) ? p0 + p1 : 0.f; }
                sf[sl * 8 + (tid & 7)] = sacc; __syncthreads();
                if (tid < 8) { float t = 0.f;
#pragma unroll 8
                    for (int q = 0; q < 64; ++q) t += sf[q * 8 + tid];
                    NORM[(size_t)(l * 2 + set) * 1024 + oc] = t; }
                __syncthreads(); }
            for (int idx = (G - 1 - bid) * NTHR + tid; idx < 32768; idx += G * NTHR) { const int c = idx & 15, lag = (idx >> 4) & 31, dir = (idx >> 9) & 1, g = idx >> 10;
                const float* c_re = PT(29) + l * 32 * 16 * 64 + (g * 16 + c) * 64; const float* c_im = PT(30) + l * 32 * 16 * 64 + (g * 16 + c) * 64;
                float acc[16];
#pragma unroll
                for (int j = 0; j < 16; ++j) acc[j] = 0.f;
#pragma unroll 2
                for (int n = 0; n < 64; ++n) { const int pi = (dir * 32 + g) * 64 + n; const float2 ap = APW[pi * 33 + lag]; const float cr = c_re[n], ci = c_im[n]; const float wr_ = cr * ap.x - ci * ap.y, wi_ = cr * ap.y + ci * ap.x;
                    const float4* bb = (const float4*)(BBT + pi * 16);
#pragma unroll
                    for (int j = 0; j < 8; ++j) { const float4 b2 = bb[j]; acc[2 * j] += wr_ * b2.x - wi_ * b2.y; acc[2 * j + 1] += wr_ * b2.z - wi_ * b2.w; } }
                float4* o = (float4*)(KTB + (size_t)idx * 16);
                o[0] = make_float4(acc[0], acc[1], acc[2], acc[3]); o[1] = make_float4(acc[4], acc[5], acc[6], acc[7]); o[2] = make_float4(acc[8], acc[9], acc[10], acc[11]); o[3] = make_float4(acc[12], acc[13], acc[14], acc[15]);
            }
            __syncthreads();
            pg8::Gemm g{HB, WIN, DM, DM, DM}; pg8::SchedStd S{68, 55, G, bid, DM, DM}; pg8::EpiWin E{P, LDP};
            pg8::gemm_phase(( LAS unsigned char*)shm, g, S, E);
#if defined(PROBE_BNOEPI)
            { __syncthreads(); pg8::EpiNone E0; pg8::gemm_phase((LAS unsigned char*)shm, g, S, E0); }
#endif
            SEAM(PB + 1);
        }

        if (IN(PB + 2)) for (int rep_ = 0; rep_ < PROBE_REPS(2); ++rep_) {
            PH_BEGIN
            const float* hcw = PT(9) + l * 3 * 1536; const float* hcb = PT(10) + l * 1536; const float* mcw = PT(20) + l * 3 * 1024; const float* mcb = PT(21) + l * 1024;
            const float* scw = PT(34) + l * 3 * 1024; const float* scb = PT(35) + l * 1024;
            for (int unit = bid; unit < 272 * 3; unit += G) { const int seg = unit / 3, kind = unit % 3; const bool lat = seg < 256; const size_t tok0 = lat ? (size_t)seg * 64 : (size_t)NLAT + (size_t)(seg - 256) * 64;
                if (kind < 2) { const int hf = kind;
                    const int c = tid * 2; const int col = (hf ? SSD_OFF + 512 : ML_OFF) + c; const float* w = hf ? scw : mcw; const float* bsp = hf ? scb : mcb; bf16_t* dst = (hf ? XBC : QKB) + tok0 * 1024 + c;
                    const float2 w0 = *(const float2*)(w + c), w1 = *(const float2*)(w + 1024 + c), w2 = *(const float2*)(w + 2048 + c), bb = *(const float2*)(bsp + c);
                    const float osc = (!hf && c >= 512) ? 0.08838834764831845f : 1.0f;
                    const bool hasPrev = !lat && ((tok0 - NLAT) & (CTXL - 1)) != 0, hasNext = !lat && (((tok0 - NLAT) + 63) & (CTXL - 1)) != CTXL - 1;
                    bf16_t* strip = nullptr;
                    if (!hf) { if (c >= 512) strip = KTG + ((size_t)seg * 512 + (c - 512)) * 64; }
                    else { if (c < 512) strip = XTG + ((size_t)seg * 512 + c) * 64; else if (c < 768) strip = BTG + ((size_t)seg * 256 + (c - 512)) * 64; }
                    const bf16_t* pp = P + tok0 * LDP + col;
                    unsigned raw[66];
#pragma unroll
                    for (int t = 0; t < 66; ++t) raw[t] = ((t == 0 && !hasPrev) || (t == 65 && !hasNext)) ? 0u : *(const unsigned*)(pp + (ptrdiff_t)(t - 1) * LDP);
#pragma unroll
                    for (int t8 = 0; t8 < 8; ++t8) { float v0[8], v1[8];
#pragma unroll
                        for (int tt = 0; tt < 8; ++tt) { const int t = t8 * 8 + tt; const unsigned p0 = raw[t], p1 = raw[t + 1], p2 = raw[t + 2];
                            float a0 = bb.x + w0.x * __uint_as_float(p0 << 16) + w1.x * __uint_as_float(p1 << 16) + w2.x * __uint_as_float(p2 << 16);
                            float a1 = bb.y + w0.y * __uint_as_float(p0 & 0xFFFF0000u) + w1.y * __uint_as_float(p1 & 0xFFFF0000u) + w2.y * __uint_as_float(p2 & 0xFFFF0000u);
                            a0 = siluf_(a0) * osc; a1 = siluf_(a1) * osc; v0[tt] = a0; v1[tt] = a1;
                            *(unsigned*)(dst + (size_t)t * 1024) = pk2(a0, a1); }
                        if (strip) { u32x4 s0, s1; s0.x = pk2(v0[0], v0[1]); s0.y = pk2(v0[2], v0[3]); s0.z = pk2(v0[4], v0[5]); s0.w = pk2(v0[6], v0[7]); s1.x = pk2(v1[0], v1[1]); s1.y = pk2(v1[2], v1[3]); s1.z = pk2(v1[4], v1[5]); s1.w = pk2(v1[6], v1[7]);
                            *(u32x4*)(strip + t8 * 8) = s0; *(u32x4*)(strip + 64 + t8 * 8) = s1; } }
                } else {
                    const int c = (tid & 255) * 2, th = tid >> 8; const bf16_t* pp = P + (tok0 + th * 32) * LDP + ML_OFF + 1024 + c; bf16_t* strip = VTG + ((size_t)seg * 512 + c) * 64 + th * 32;
                    unsigned rv[32];
#pragma unroll
                    for (int t = 0; t < 32; ++t) rv[t] = *(const unsigned*)(pp + (size_t)t * LDP);
#pragma unroll
                    for (int t8 = 0; t8 < 4; ++t8) { u32x4 s0, s1;
                        s0.x = (rv[t8 * 8 + 0] & 0xFFFFu) | (rv[t8 * 8 + 1] << 16); s0.y = (rv[t8 * 8 + 2] & 0xFFFFu) | (rv[t8 * 8 + 3] << 16); s0.z = (rv[t8 * 8 + 4] & 0xFFFFu) | (rv[t8 * 8 + 5] << 16); s0.w = (rv[t8 * 8 + 6] & 0xFFFFu) | (rv[t8 * 8 + 7] << 16);
                        s1.x = (rv[t8 * 8 + 0] >> 16) | (rv[t8 * 8 + 1] & 0xFFFF0000u); s1.y = (rv[t8 * 8 + 2] >> 16) | (rv[t8 * 8 + 3] & 0xFFFF0000u); s1.z = (rv[t8 * 8 + 4] >> 16) | (rv[t8 * 8 + 5] & 0xFFFF0000u); s1.w = (rv[t8 * 8 + 6] >> 16) | (rv[t8 * 8 + 7] & 0xFFFF0000u);
                        *(u32x4*)(strip + t8 * 8) = s0; *(u32x4*)(strip + 64 + t8 * 8) = s1; }
                }
            }
            if (!lastl) for (int tok = NLAT + bid; tok < NTOK; tok += G) {
                const int t = (tok - NLAT) & (CTXL - 1); const bool hasL = (t != 0), hasR = (t != CTXL - 1); const bf16_t* pr = P + (size_t)tok * LDP;
                const bf16_t* prL = hasL ? pr - LDP : pr; const bf16_t* prR = hasR ? pr + LDP : pr;
                unsigned xc[3], xl[3], xr[3];
#pragma unroll
                for (int j = 0; j < 3; ++j) { const int cc = tid + j * 512; xc[j] = pr[HY_OFF + cc]; xl[j] = prL[HY_OFF + cc]; xr[j] = prR[HY_OFF + cc]; }
#pragma unroll
                for (int j = 0; j < 3; ++j) { const int cc = tid + j * 512;
                    float acc = hcb[cc] + hcw[1536 + cc] * __uint_as_float(xc[j] << 16);
                    acc += hasL ? hcw[cc] * __uint_as_float(xl[j] << 16) : 0.f;
                    acc += hasR ? hcw[2 * 1536 + cc] * __uint_as_float(xr[j] << 16) : 0.f;
                    U[(size_t)tok * 1536 + cc] = acc; }
            }
            for (int idx0 = bid * NTHR + tid; idx0 < 16384 * 64; idx0 += 4 * G * NTHR) { u32x4 t4[4];
#pragma unroll
                for (int q = 0; q < 4; ++q) { const int idx = idx0 + q * G * NTHR; const int half = idx & 1, g = (idx >> 1) & 31, tok = idx >> 6;
                    if (idx < 16384 * 64) t4[q] = *(const u32x4*)(P + (size_t)tok * LDP + S5_OFF + g * 16 + half * 8); }
#pragma unroll
                for (int q = 0; q < 4; ++q) { const int idx = idx0 + q * G * NTHR; const int half = idx & 1, g = (idx >> 1) & 31, tok = idx >> 6;
                    if (idx < 16384 * 64) *(u32x4*)(S5A + ((size_t)g * 512 + (tok >> 5)) * 768 + (tok & 31) * 16 + half * 8) = t4[q]; } }
            for (int idx = bid * NTHR + tid; idx < 32 * 512 * 32 * 2; idx += G * NTHR) { const int half = idx & 1, sI = (idx >> 1) & 31, row = (idx >> 6) & 511, g = idx >> 15; const int t = row >> 4, c = row & 15; const int lag = t - sI;
                float v[8];
                if (lag > 0) { const float4* k4 = (const float4*)(KTB + ((size_t)((g * 2 + 0) * 32 + lag) * 16 + c) * 16 + half * 8); const float4 a0 = k4[0], a1 = k4[1]; v[0] = a0.x; v[1] = a0.y; v[2] = a0.z; v[3] = a0.w; v[4] = a1.x; v[5] = a1.y; v[6] = a1.z; v[7] = a1.w; }
                else if (lag < 0) { const float4* k4 = (const float4*)(KTB + ((size_t)((g * 2 + 1) * 32 - lag) * 16 + c) * 16 + half * 8); const float4 a0 = k4[0], a1 = k4[1]; v[0] = a0.x; v[1] = a0.y; v[2] = a0.z; v[3] = a0.w; v[4] = a1.x; v[5] = a1.y; v[6] = a1.z; v[7] = a1.w; }
                else { const float4* k4 = (const float4*)(KTB + ((size_t)((g * 2 + 0) * 32) * 16 + c) * 16 + half * 8); const float4* q4 = (const float4*)(KTB + ((size_t)((g * 2 + 1) * 32) * 16 + c) * 16 + half * 8); const float4 a0 = k4[0], a1 = k4[1], b0 = q4[0], b1 = q4[1];
                    v[0] = a0.x + b0.x; v[1] = a0.y + b0.y; v[2] = a0.z + b0.z; v[3] = a0.w + b0.w; v[4] = a1.x + b1.x; v[5] = a1.y + b1.y; v[6] = a1.z + b1.z; v[7] = a1.w + b1.w; }
                u32x4 w; w.x = pk2(v[0], v[1]); w.y = pk2(v[2], v[3]); w.z = pk2(v[4], v[5]); w.w = pk2(v[6], v[7]);
                *(u32x4*)(S5B + ((size_t)g * 512 + row) * 768 + sI * 16 + half * 8) = w; }
            for (int idx = bid * NTHR + tid; idx < 32 * 512 * 64; idx += G * NTHR) { const int n = idx & 63, row = (idx >> 6) & 511, g = idx >> 15; const int t = row >> 4, c = row & 15;
                const float cr = (PT(29) + l * 32 * 16 * 64)[(g * 16 + c) * 64 + n], ci = (PT(30) + l * 32 * 16 * 64)[(g * 16 + c) * 64 + n];
                const float2 af = APW[((0 * 32 + g) * 64 + n) * 33 + t + 1], ab = APW[((1 * 32 + g) * 64 + n) * 33 + 32 - t];
                bf16_t* d = S5B + ((size_t)g * 512 + row) * 768 + 512 + 2 * n;
                *(unsigned*)d = pk2(cr * af.x - ci * af.y, -(cr * af.y + ci * af.x)); *(unsigned*)(d + 128) = pk2(cr * ab.x - ci * ab.y, -(cr * ab.y + ci * ab.x)); }
            for (int idx = bid * NTHR + tid; idx < 32 * 2 * 64 * 32; idx += G * NTHR) { const int sI = idx & 31, n = (idx >> 5) & 63, dir = (idx >> 11) & 1, g = idx >> 12; const int pi = (dir * 32 + g) * 64 + n;
                const float2 pw = APW[pi * 33 + (dir ? sI : 31 - sI)]; const float4* bb = (const float4*)(BBT + pi * 16);
                float re[16], im[16];
#pragma unroll
                for (int j = 0; j < 8; ++j) { const float4 b2 = bb[j]; re[2 * j] = pw.x * b2.x - pw.y * b2.y; im[2 * j] = pw.x * b2.y + pw.y * b2.x; re[2 * j + 1] = pw.x * b2.z - pw.y * b2.w; im[2 * j + 1] = pw.x * b2.w + pw.y * b2.z; }
                bf16_t* d = S5P + ((size_t)g * 256 + dir * 128 + 2 * n) * 512 + sI * 16;
                u32x4 w0, w1; w0.x = pk2(re[0], re[1]); w0.y = pk2(re[2], re[3]); w0.z = pk2(re[4], re[5]); w0.w = pk2(re[6], re[7]); w1.x = pk2(re[8], re[9]); w1.y = pk2(re[10], re[11]); w1.z = pk2(re[12], re[13]); w1.w = pk2(re[14], re[15]);
                *(u32x4*)d = w0; *(u32x4*)(d + 8) = w1;
                w0.x = pk2(im[0], im[1]); w0.y = pk2(im[2], im[3]); w0.z = pk2(im[4], im[5]); w0.w = pk2(im[6], im[7]); w1.x = pk2(im[8], im[9]); w1.y = pk2(im[10], im[11]); w1.z = pk2(im[12], im[13]); w1.w = pk2(im[14], im[15]);
                *(u32x4*)(d + 512) = w0; *(u32x4*)(d + 520) = w1; }
            {   float* T = sf;
                for (int unit = bid; unit < 4 * 64 * 24; unit += G) { const int b = unit / (64 * 24), r = (unit / 24) % 64, c0 = (unit % 24) * 64; const size_t tok0 = (size_t)b * SEQ + r * 64;
                    __syncthreads();
#pragma unroll
                    for (int i = 0; i < 8; ++i) { const int c = tid & 63, t = (tid >> 6) + 8 * i; T[t * 65 + c] = bf2f(P[(tok0 + t) * LDP + HY_OFF + c0 + c]); }
                    __syncthreads();
                    const int c = tid >> 3, tq = (tid & 7) * 8, cc = c0 + c; const float w0 = hcw[cc], w1 = hcw[1536 + cc], w2 = hcw[3072 + cc], bb = hcb[cc];
                    float o8[8];
#pragma unroll
                    for (int i = 0; i < 8; ++i) { const int t = tq + i; float acc = bb + w1 * T[t * 65 + c]; if (t > 0) acc += w0 * T[(t - 1) * 65 + c]; if (t < 63) acc += w2 * T[(t + 1) * 65 + c]; o8[i] = acc; }
                    float* dst = UT + ((size_t)b * 1536 + cc) * SEQ + r * 64 + tq;
                    *(float4*)dst = make_float4(o8[0], o8[1], o8[2], o8[3]); *(float4*)(dst + 4) = make_float4(o8[4], o8[5], o8[6], o8[7]);
                } }
            if (!lastl) {
                const int L = CTXL; const float* HR = HRAW + (size_t)SEQ * 2048; float* K2 = K2C; const float* nrm = NORM + (size_t)(l * 2 + 1) * 1024;
                const size_t total = (size_t)(2 * L - 1) * 1024;
                for (size_t i = (size_t)bid * NTHR + tid; i < total; i += (size_t)G * NTHR) { const int j = (int)(i >> 10), oc = (int)(i & 1023), o = oc >> 9, c = oc & 511; const int lag = j - (L - 1);
                    const float v = lag >= 0 ? HR[(size_t)lag * 2048 + o * 1024 + c] : HR[(size_t)(-lag) * 2048 + o * 1024 + 512 + c];
                    K2[((size_t)j * 2 + o) * 512 + c] = v / nrm[oc]; }
            }
            {   __syncthreads(); fft_twiddles((float2*)(shm + FFT_X_BYTES), tid);
                for (int oc = bid; oc < 1024; oc += G) hyena_spec_item(oc, HRAW, NORM + (size_t)(l * 2 + 0) * 1024, HSPEC, shm, tid);
                __syncthreads(); }
            SEAM(PB + 2);
        }

        if (IN(PB + 3)) for (int rep_ = 0; rep_ < PROBE_REPS(3); ++rep_) {
            PH_BEGIN
            if (rep_ > 0) { if (bid == 0 && tid == 0) __hip_atomic_store(QCTR + l * 64, 0, __ATOMIC_RELAXED, __HIP_MEMORY_SCOPE_AGENT); xcd_barrier(bar); }
            if (bid < 64) {
                mlstm_state_pass(bid >> 1, bid & 1, P, KTG, VTG, PT(22) + l * 16, CST, NST, MST, shm, tid);
            } else if (bid < 128) {
                { const int ch = bid - 64; const int dir_ = ch & 1, h_ = (ch >> 1) & 7; ssd_state_pass(ch, P, BTG, XTG, -expf(PT(37)[l * 16 + dir_ * 8 + h_]), PT(36)[l * 16 + dir_ * 8 + h_], SSTB, shm, tid); }
            } else if (bid < 160) {
                const int widx = (bid - 128) * 8 + wave; const int dir = widx & 1, g = (widx >> 1) & 31, b = widx >> 6; const int n = lane;
                float2* xb = (float2*)(shm + (size_t)wave * 16640); float2* ctab = xb + 16 * 65;
                const float* a_re = PT(24) + l * 2 * 32 * 64; const float* a_im = PT(25) + l * 2 * 32 * 64; const float* log_dt = PT(26) + l * 64;
                const float* b_re = PT(27) + l * 32 * 64 * 16; const float* b_im = PT(28) + l * 32 * 64 * 16; const float* c_re = PT(29) + l * 32 * 16 * 64; const float* c_im = PT(30) + l * 32 * 16 * 64;
#pragma unroll
                for (int c = 0; c < 16; ++c) ctab[c * 65 + lane] = make_float2(c_re[(g * 16 + c) * 64 + lane], c_im[(g * 16 + c) * 64 + lane]);
                float abr, abi, bbr[16], bbi[16];
                {   const double are = (double)a_re[(dir * 32 + g) * 64 + n], aim = (double)a_im[(dir * 32 + g) * 64 + n];
                    const double lam = are < -1e-4 ? are : -1e-4; const double dt = exp((double)log_dt[dir * 32 + g]);
                    const double mag = exp(lam * dt); const double ar = mag * cos(aim * dt), ai = mag * sin(aim * dt);
                    const double den = lam * lam + aim * aim; const double nr = ar - 1.0, ni = ai;
                    const double fre = (nr * lam + ni * aim) / den, fim = (ni * lam - nr * aim) / den;
                    abr = (float)ar; abi = (float)ai;
#pragma unroll
                    for (int c = 0; c < 16; ++c) { const double br = (double)b_re[(g * 64 + n) * 16 + c], bi = (double)b_im[(g * 64 + n) * 16 + c]; bbr[c] = (float)(fre * br - fim * bi); bbi[c] = (float)(fre * bi + fim * br); }
                }
                float xr = 0.f, xi = 0.f; float* Sout = (dir ? SB : SF) - (size_t)NLAT * BW;
                const int s = lane >> 2, cg = lane & 3;
                for (int i0 = 0; i0 < CTXL; i0 += 16) {
#pragma unroll 4
                    for (int ss = 0; ss < 16; ++ss) {
                        const size_t tok = (size_t)step_tok(b, dir, i0 + ss);
                        const u32x4* up = (const u32x4*)(P + tok * LDP + S5_OFF + g * 16);
                        float t0[8], t1[8]; unpack8(up[0], t0); unpack8(up[1], t1);
                        float bur = 0.f, bui = 0.f;
#pragma unroll
                        for (int c = 0; c < 8; ++c) { bur += t0[c] * bbr[c] + t1[c] * bbr[8 + c]; bui += t0[c] * bbi[c] + t1[c] * bbi[8 + c]; }
                        const float nxr = abr * xr - abi * xi + bur, nxi = abr * xi + abi * xr + bui; xr = nxr; xi = nxi;
                        xb[ss * 65 + lane] = make_float2(xr, xi);
                    }
                    asm volatile("s_waitcnt lgkmcnt(0)" ::: "memory");
                    float y0 = 0.f, y1 = 0.f, y2 = 0.f, y3 = 0.f;
                    for (int nn2 = 0; nn2 < 64; ++nn2) { const float2 xv = xb[s * 65 + nn2];
                        const float2 c0 = ctab[(cg * 4 + 0) * 65 + nn2], c1 = ctab[(cg * 4 + 1) * 65 + nn2], c2 = ctab[(cg * 4 + 2) * 65 + nn2], c3 = ctab[(cg * 4 + 3) * 65 + nn2];
                        y0 += xv.x * c0.x - xv.y * c0.y; y1 += xv.x * c1.x - xv.y * c1.y; y2 += xv.x * c2.x - xv.y * c2.y; y3 += xv.x * c3.x - xv.y * c3.y; }
                    const size_t toks = (size_t)step_tok(b, dir, i0 + s);
                    *(float4*)(Sout + toks * BW + g * 16 + cg * 4) = make_float4(y0, y1, y2, y3);
                    asm volatile("s_waitcnt lgkmcnt(0)" ::: "memory");
                }
                XCTX[((b * 32 + g) * 2 + dir) * 64 + n] = make_float2(xr, xi);
            } else {
                if (bid < 224) {
                    pg8::Gemm gg_{S5A, S5P, 768, 512, 512}; pg8::SchedS5a S_{bid - 160}; pg8::EpiXloc E_{XLOC};
                    pg8::gemm_phase((LAS unsigned char*)shm, gg_, S_, E_);
                    __syncthreads();
                }
                const int nhb = G - 160, hb = bid - 160; const float* bias = PT(19) + l * 1024; const int c = tid;
                const int nitems = lastl ? 0 : 4 * (CTXL / 8);
                for (int it = hb; it < nitems; it += nhb) {
                    int L, tokbase, b, t0; const float* K2;
                    { const int q = it; L = CTXL; tokbase = NLAT; b = q / (CTXL / 8); t0 = (q % (CTXL / 8)) * 8; K2 = K2C; }
                    const float* zb = U + (size_t)(tokbase + b * L) * 1536 + c;
                    float acc[8];
#pragma unroll
                    for (int i = 0; i < 8; ++i) acc[i] = 0.f;
                    const int base = t0 + L - 1;
                    for (int s = 0; s < L; s += 8) {
                        float k[15];
#pragma unroll
                        for (int mm = 0; mm < 15; ++mm) k[mm] = K2[((size_t)(base - s - 7 + mm) * 2 + 0) * 512 + c];
#pragma unroll
                        for (int ds = 0; ds < 8; ++ds) { const float z = zb[(size_t)(s + ds) * 1536];
#pragma unroll
                            for (int i = 0; i < 8; ++i) acc[i] += k[i - ds + 7] * z; }
                    }
#pragma unroll
                    for (int i = 0; i < 8; ++i) { const size_t tok = (size_t)(tokbase + b * L + t0 + i); const float zt = U[tok * 1536 + c]; Z[tok * BW + c] = (acc[i] + bias[c] * zt) * U[tok * 1536 + 512 + c]; }
                }
            }
            {   __syncthreads(); fft_twiddles((float2*)(shm + FFT_X_BYTES), tid);
                int* qslot = (int*)(shm + FFT_X_BYTES + 65536);
                for (;;) { __syncthreads(); if (tid == 0) *qslot = atomicAdd(QCTR + l * 64, 1); __syncthreads(); const int it = *qslot; if (it >= 1024) break;
                    hyena_fft_item(it, UT, HSPEC, PT(19) + l * 1024, YT, shm, tid); }
            }
            SEAM(PB + 3);
        }

        if (IN(PB + 4)) for (int rep_ = 0; rep_ < PROBE_REPS(4); ++rep_) {
            PH_BEGIN
            if (rep_ > 0) { if (bid == 0 && tid == 0) __hip_atomic_store(QCTR + l * 64 + 32, 0, __ATOMIC_RELAXED, __HIP_MEMORY_SCOPE_AGENT); xcd_barrier(bar); }
            if (bid >= G - 32) for (int idx = (bid - (G - 32)) * NTHR + tid; idx < 16384; idx += 32 * NTHR) { const int n = idx & 63, dir = (idx >> 6) & 1, b = (idx >> 7) & 3, g = idx >> 9;
                const float2 a32 = APW[((dir * 32 + g) * 64 + n) * 33 + 32]; float2 X = XCTX[((b * 32 + g) * 2 + dir) * 64 + n];
                const float* __restrict__ xl = XLOC + ((size_t)g * 512 + b * 128) * 256 + dir * 128 + 2 * n; bf16_t* __restrict__ dst = S5A + ((size_t)g * 512 + b * 128) * 768 + 512 + dir * 128 + 2 * n;
#pragma unroll 1
                for (int j0 = 0; j0 < 128; j0 += 16) { float2 xv[16];
#pragma unroll
                    for (int q = 0; q < 16; ++q) { const int j = dir ? 127 - (j0 + q) : j0 + q; xv[q] = *(const float2*)(xl + (size_t)j * 256); }
#pragma unroll
                    for (int q = 0; q < 16; ++q) { const int j = dir ? 127 - (j0 + q) : j0 + q;
                        *(unsigned*)(dst + (size_t)j * 768) = pk2(X.x, X.y);
                        const float nx = a32.x * X.x - a32.y * X.y + xv[q].x, ny = a32.x * X.y + a32.y * X.x + xv[q].y; X.x = nx; X.y = ny; } } }
            {   int* qslot = (int*)(shm + 102400);
                for (;;) { __syncthreads(); if (tid == 0) *qslot = atomicAdd(QCTR + l * 64 + 32, 1); __syncthreads(); const int it = *qslot; if (it >= 32 * 68 + 64 * 68) break;
                    if (it < 32 * 68) { const int chain = it / 68, c = it % 68; mlstm_out_item(chain, c, P, QKB, VTG, PT(22) + l * 16, CST, NST, MST, (chain & 1) ? HBk : HF, shm, tid); }
                    else { const int i2 = it - 32 * 68; const int chain = i2 / 68, c = i2 % 68; const int dir_ = chain & 1, h_ = (chain >> 1) & 7;
                        ssd_out_item(chain, c, P, XBC, XTG, -expf(PT(37)[l * 16 + dir_ * 8 + h_]), PT(36)[l * 16 + dir_ * 8 + h_], SSTB, dir_ ? YB : YF, shm, tid); } }
            }
            __syncthreads();
            {   const float* bias = PT(19) + l * 1024 + 512; const int c = tid;
                const int nitems = lastl ? 0 : 4 * (CTXL / 8);
                for (int it = bid; it < nitems; it += G) {
                    int L, tokbase, b, t0; const float* K2;
                    { const int q = it; L = CTXL; tokbase = NLAT; b = q / (CTXL / 8); t0 = (q % (CTXL / 8)) * 8; K2 = K2C; }
                    const float* zb = Z + (size_t)(tokbase + b * L) * BW + c;
                    float acc[8];
#pragma unroll
                    for (int i = 0; i < 8; ++i) acc[i] = 0.f;
                    const int base = t0 + L - 1;
                    for (int s = 0; s < L; s += 8) {
                        float k[15];
#pragma unroll
                        for (int mm = 0; mm < 15; ++mm) k[mm] = K2[((size_t)(base - s - 7 + mm) * 2 + 1) * 512 + c];
#pragma unroll
                        for (int ds = 0; ds < 8; ++ds) { const float z = zb[(size_t)(s + ds) * BW];
#pragma unroll
                            for (int i = 0; i < 8; ++i) acc[i] += k[i - ds + 7] * z; }
                    }
#pragma unroll
                    for (int i = 0; i < 8; ++i) { const size_t tok = (size_t)(tokbase + b * L + t0 + i); const float zt = Z[tok * BW + c]; Y4[tok * DM + c] = f2bf((acc[i] + bias[c] * zt) * U[tok * 1536 + 1024 + c]); }
                }
            }
            SEAM(PB + 4);
        }

        if (IN(PB + 5)) for (int rep_ = 0; rep_ < PROBE_REPS(5); ++rep_) {
            PH_BEGIN
            const float* ml_norm = PT(23) + l * BW; const float* ssd_d = PT(38) + l * 8; const float* ssd_norm = PT(39) + l * BW; const float* s5_d = PT(31) + l * BW;
            if (bid < 128) {
                pg8::Gemm gg_{S5A, S5B, 768, 768, 768}; pg8::SchedS5b S_{bid}; pg8::EpiS5Out E_{P, s5_d, GG};
                pg8::gemm_phase((LAS unsigned char*)shm, gg_, S_, E_);
                __syncthreads();
            }
            for (int tok = bid * 8 + wave; tok < NTOK; tok += G * 8) {
                const int c0 = lane * 8; const bf16_t* pr = P + (size_t)tok * LDP; const size_t o5 = (size_t)tok * BW + c0;
                float hm[8], ys[8];
                const u32x4 ooq = *(const u32x4*)(pr + ML_OFF + 1536 + c0);
                const float4 g0 = *(const float4*)(ml_norm + c0), g1 = *(const float4*)(ml_norm + c0 + 4), n0 = *(const float4*)(ssd_norm + c0), n1 = *(const float4*)(ssd_norm + c0 + 4);
                { const float4 a0 = *(const float4*)(HF + o5), a1 = *(const float4*)(HF + o5 + 4), b0 = *(const float4*)(HBk + o5), b1 = *(const float4*)(HBk + o5 + 4);
                  hm[0] = a0.x + b0.x; hm[1] = a0.y + b0.y; hm[2] = a0.z + b0.z; hm[3] = a0.w + b0.w; hm[4] = a1.x + b1.x; hm[5] = a1.y + b1.y; hm[6] = a1.z + b1.z; hm[7] = a1.w + b1.w; }
                { const float4 a0 = *(const float4*)(YF + o5), a1 = *(const float4*)(YF + o5 + 4), b0 = *(const float4*)(YB + o5), b1 = *(const float4*)(YB + o5 + 4);
                  float xx[8], zz[8]; unpack8(*(const u32x4*)(XBC + (size_t)tok * 1024 + c0), xx); unpack8(*(const u32x4*)(pr + SSD_OFF + c0), zz); const float dsk = ssd_d[c0 >> 6];
                  ys[0] = a0.x + b0.x; ys[1] = a0.y + b0.y; ys[2] = a0.z + b0.z; ys[3] = a0.w + b0.w; ys[4] = a1.x + b1.x; ys[5] = a1.y + b1.y; ys[6] = a1.z + b1.z; ys[7] = a1.w + b1.w;
#pragma unroll
                  for (int j = 0; j < 8; ++j) ys[j] = (ys[j] + dsk * xx[j]) * siluf_(zz[j]); }
                float s1 = 0.f, s2 = 0.f;
#pragma unroll
                for (int j = 0; j < 8; ++j) { s1 += hm[j] * hm[j]; s2 += ys[j] * ys[j]; }
                s1 += __shfl_xor(s1, 1); s1 += __shfl_xor(s1, 2); s1 += __shfl_xor(s1, 4); s1 += __shfl_xor(s1, 8);
                s2 = wave_sum(s2);
                const float r1 = rsqrtf(s1 * (1.0f / 128.0f) + 1e-6f), r2 = rsqrtf(s2 * (1.0f / BW) + 1e-6f);
                float oo[8]; unpack8(ooq, oo);
                const float gm[8] = {g0.x, g0.y, g0.z, g0.w, g1.x, g1.y, g1.z, g1.w}, gs[8] = {n0.x, n0.y, n0.z, n0.w, n1.x, n1.y, n1.z, n1.w};
                u32x4 w;
                w.x = pk2(hm[0] * r1 * gm[0] * sigmoidf_(oo[0]), hm[1] * r1 * gm[1] * sigmoidf_(oo[1])); w.y = pk2(hm[2] * r1 * gm[2] * sigmoidf_(oo[2]), hm[3] * r1 * gm[3] * sigmoidf_(oo[3]));
                w.z = pk2(hm[4] * r1 * gm[4] * sigmoidf_(oo[4]), hm[5] * r1 * gm[5] * sigmoidf_(oo[5])); w.w = pk2(hm[6] * r1 * gm[6] * sigmoidf_(oo[6]), hm[7] * r1 * gm[7] * sigmoidf_(oo[7]));
                *(u32x4*)(Y4 + (size_t)tok * DM + 512 + c0) = w;
                w.x = pk2(ys[0] * r2 * gs[0], ys[1] * r2 * gs[1]); w.y = pk2(ys[2] * r2 * gs[2], ys[3] * r2 * gs[3]); w.z = pk2(ys[4] * r2 * gs[4], ys[5] * r2 * gs[5]); w.w = pk2(ys[6] * r2 * gs[6], ys[7] * r2 * gs[7]);
                *(u32x4*)(Y4 + (size_t)tok * DM + 1536 + c0) = w;
                if (tok >= NLAT) { const size_t oc = (size_t)(tok - NLAT) * BW + c0; float uu[8]; unpack8(*(const u32x4*)(pr + S5_OFF + c0), uu);
                    const float4 a0 = *(const float4*)(SF + oc), a1 = *(const float4*)(SF + oc + 4), b0 = *(const float4*)(SB + oc), b1 = *(const float4*)(SB + oc + 4), d0 = *(const float4*)(s5_d + c0), d1 = *(const float4*)(s5_d + c0 + 4);
                    float y[8] = {a0.x + b0.x + d0.x * uu[0], a0.y + b0.y + d0.y * uu[1], a0.z + b0.z + d0.z * uu[2], a0.w + b0.w + d0.w * uu[3], a1.x + b1.x + d1.x * uu[4], a1.y + b1.y + d1.y * uu[5], a1.z + b1.z + d1.z * uu[6], a1.w + b1.w + d1.w * uu[7]};
#pragma unroll
                    for (int j = 0; j < 8; ++j) y[j] = 0.5f * y[j] * (1.0f + tanhf(0.7978845608028654f * (y[j] + 0.044715f * y[j] * y[j] * y[j])));
                    w.x = pk2(y[0], y[1]); w.y = pk2(y[2], y[3]); w.z = pk2(y[4], y[5]); w.w = pk2(y[6], y[7]);
                    *(u32x4*)(GG + (size_t)tok * BW + c0) = w; }
            }
            __syncthreads();
            {   float* T = sf;
                for (int unit = (G > 128 ? bid - 128 : bid); unit >= 0 && unit < 4 * 64 * 8; unit += (G > 128 ? G - 128 : G)) { const int b = unit / 512, t0 = ((unit >> 3) & 63) * 64, c0 = (unit & 7) * 64;
                    __syncthreads();
#pragma unroll
                    for (int i = 0; i < 8; ++i) { const int t = tid & 63, c = (tid >> 6) + 8 * i; T[c * 65 + t] = YT[((size_t)b * 512 + c0 + c) * SEQ + t0 + t]; }
                    __syncthreads();
                    const int t = tid >> 3, cq = (tid & 7) * 8;
                    u32x4 w; w.x = pk2(T[(cq + 0) * 65 + t], T[(cq + 1) * 65 + t]); w.y = pk2(T[(cq + 2) * 65 + t], T[(cq + 3) * 65 + t]); w.z = pk2(T[(cq + 4) * 65 + t], T[(cq + 5) * 65 + t]); w.w = pk2(T[(cq + 6) * 65 + t], T[(cq + 7) * 65 + t]);
                    *(u32x4*)(Y4 + ((size_t)b * SEQ + t0 + t) * DM + c0 + cq) = w;
                } }
            SEAM(PB + 5);
        }

        if (IN(PB + 6)) for (int rep_ = 0; rep_ < PROBE_REPS(6); ++rep_) {
            PH_BEGIN
            pg8::Gemm g{GG, GLU, BW, BW, BW}; pg8::SchedStd S{68, 2, G, bid, BW, BW}; pg8::EpiGlu E{GG, PT(33) + l * BW, Y4};
            pg8::gemm_phase((LAS unsigned char*)shm, g, S, E);
            SEAM(PB + 6);
        }
        if (IN(PB + 7)) for (int rep_ = 0; rep_ < PROBE_REPS(7); ++rep_) {
            PH_BEGIN
            pg8::Gemm g{Y4, WBR, DM, BW, BW}; pg8::SchedBranch S{nPanels, 8, G, bid}; pg8::EpiBranch E{P, ACCb};
            pg8::gemm_phase((LAS unsigned char*)shm, g, S, E);
            SEAM(PB + 7);
        }
        if (IN(PB + 8)) for (int rep_ = 0; rep_ < PROBE_REPS(8); ++rep_) {
            PH_BEGIN
            pg8::Gemm g{ACCb, WOUT, DM, DM, DM}; pg8::SchedStd S{nPanels, 8, G, bid, DM, DM}; pg8::EpiResid E{XS, l == 0 ? x_in : (const float*)XS, l == 0 ? ctx_in - (size_t)NLAT * DM : (const float*)XS, MODl, 2};
            pg8::gemm_phase((LAS unsigned char*)shm, g, S, E);
            SEAM(PB + 8);
        }
        if (IN(PB + 9)) for (int rep_ = 0; rep_ < PROBE_REPS(9); ++rep_) {
            PH_BEGIN
            for (int i = bid * NTHR + tid; i < NEXP * MOE_PAD; i += G * NTHR) ROWTOK[i] = -1;
            for (int i = bid * NTHR + tid; i < NTOK * 16; i += G * NTHR) INV[i] = -1;
            const float* wr = PT(42) + (size_t)l * DM * 16; const float* gn = norm_ffn + l * DM;
            for (int tok0 = (bid * 8 + wave) * 4; tok0 < M2; tok0 += G * 32) {
                const int r = tok0 < NLAT ? tok0 / SEQ : 4; const float* xr = XS + (size_t)tok0 * DM;
                const float* sh = MODl + (size_t)(r * 6 + 3) * DM; const float* sc = MODl + (size_t)(r * 6 + 4) * DM;
                float rs[4];
#pragma unroll
                for (int tk = 0; tk < 4; ++tk) { float ss = 0.f;
#pragma unroll 4
                    for (int i = 0; i < 8; ++i) { const float4 t4 = *(const float4*)(xr + (size_t)tk * DM + i * 256 + lane * 4); ss += t4.x * t4.x + t4.y * t4.y + t4.z * t4.z + t4.w * t4.w; }
                    ss = wave_sum(ss); rs[tk] = rsqrtf(ss * (1.0f / DM) + 1e-6f); }
                float lg[4][16];
#pragma unroll
                for (int tk = 0; tk < 4; ++tk)
#pragma unroll
                    for (int e = 0; e < 16; ++e) lg[tk][e] = 0.f;
#pragma unroll 1
                for (int i = 0; i < 8; ++i) { const int d = i * 256 + lane * 4;
                    const float4 g4 = *(const float4*)(gn + d), s4 = *(const float4*)(sc + d), h4 = *(const float4*)(sh + d);
                    float4 xq[4], ww[16];
#pragma unroll
                    for (int tk = 0; tk < 4; ++tk) xq[tk] = *(const float4*)(xr + (size_t)tk * DM + d);
                    const float4* wq = (const float4*)(wr + (size_t)d * 16);
#pragma unroll
                    for (int q = 0; q < 16; ++q) ww[q] = wq[q];
                    float hv[4][4];
#pragma unroll
                    for (int tk = 0; tk < 4; ++tk) { const float4 xv = xq[tk]; const float rr = rs[tk];
                        hv[tk][0] = xv.x * rr * g4.x * (1.f + s4.x) + h4.x; hv[tk][1] = xv.y * rr * g4.y * (1.f + s4.y) + h4.y; hv[tk][2] = xv.z * rr * g4.z * (1.f + s4.z) + h4.z; hv[tk][3] = xv.w * rr * g4.w * (1.f + s4.w) + h4.w;
                        u32x2 w; w.x = pk2(hv[tk][0], hv[tk][1]); w.y = pk2(hv[tk][2], hv[tk][3]); *(u32x2*)(HB + (size_t)(tok0 + tk) * DM + d) = w; }
#pragma unroll
                    for (int q = 0; q < 4; ++q) { const float4 w0 = ww[q * 4 + 0], w1 = ww[q * 4 + 1], w2 = ww[q * 4 + 2], w3 = ww[q * 4 + 3];
#pragma unroll
                        for (int tk = 0; tk < 4; ++tk) { const float hq = hv[tk][q];
                            lg[tk][0] += hq * w0.x; lg[tk][1] += hq * w0.y; lg[tk][2] += hq * w0.z; lg[tk][3] += hq * w0.w; lg[tk][4] += hq * w1.x; lg[tk][5] += hq * w1.y; lg[tk][6] += hq * w1.z; lg[tk][7] += hq * w1.w;
                            lg[tk][8] += hq * w2.x; lg[tk][9] += hq * w2.y; lg[tk][10] += hq * w2.z; lg[tk][11] += hq * w2.w; lg[tk][12] += hq * w3.x; lg[tk][13] += hq * w3.y; lg[tk][14] += hq * w3.z; lg[tk][15] += hq * w3.w; } } }
#pragma unroll
                for (int tk = 0; tk < 4; ++tk) { float mx = -1e30f;
#pragma unroll
                    for (int e = 0; e < 16; ++e) { lg[tk][e] = wave_sum(lg[tk][e]); mx = fmaxf(mx, lg[tk][e]); }
                    float sm = 0.f;
#pragma unroll
                    for (int e = 0; e < 16; ++e) { lg[tk][e] = expf(lg[tk][e] - mx); sm += lg[tk][e]; }
                    const float inv = 1.0f / sm;
                    if (lane == 0) {
#pragma unroll
                        for (int e = 0; e < 16; e += 4) *(float4*)(PROBS + (size_t)(tok0 + tk) * 16 + e) = make_float4(lg[tk][e] * inv, lg[tk][e + 1] * inv, lg[tk][e + 2] * inv, lg[tk][e + 3] * inv); } }
            }
            SEAM(PB + 9);
        }
        if (IN(PB + 10)) for (int rep_ = 0; rep_ < PROBE_REPS(10); ++rep_) {
            PH_BEGIN
            const int nitems = 64 + (lastl ? 0 : 64);
            unsigned long long* keys = (unsigned long long*)shm;
            for (int it = bid; it < nitems; it += G) {
                const int set = it >> 6, e = it & 15, b = (it >> 4) & 3;
                const int n = set ? CTXL : SEQ, cap = set ? 32 : 512, tokbase = set ? NLAT + b * CTXL : b * SEQ;
                __syncthreads();
                for (int i = tid; i < n; i += NTHR) keys[i] = ((unsigned long long)__float_as_uint(PROBS[(size_t)(tokbase + i) * 16 + e]) << 32) | (unsigned long long)(0xFFFFFFFFu - (unsigned)i);
                __syncthreads();
                for (int k = 2; k <= n; k <<= 1)
                    for (int j = k >> 1; j > 0; j >>= 1) {
                        for (int p = tid; p < (n >> 1); p += NTHR) { const int i = ((p & ~(j - 1)) << 1) | (p & (j - 1)); const int m = i | j;
                            const unsigned long long ka = keys[i], kb = keys[m]; const bool desc = ((i & k) == 0);
                            if ((ka < kb) == desc) { keys[i] = kb; keys[m] = ka; } }
                        __syncthreads();
                    }
                for (int r = tid; r < cap; r += NTHR) { const unsigned long long kk = keys[r]; const int row = e * MOE_PAD + (set ? 2048 + b * 32 + r : b * 512 + r);
                    const int tk_ = tokbase + (int)(0xFFFFFFFFu - (unsigned)(kk & 0xFFFFFFFFull)); ROWTOK[row] = tk_; ROWGATE[row] = __uint_as_float((unsigned)(kk >> 32)); INV[tk_ * 16 + e] = row; }
                for (int rb = 0; rb < cap; rb += 32) {
                    u32x4 t4[4][4];
#pragma unroll
                    for (int q = 0; q < 4; ++q) { const int r = rb + wave + 8 * q; const int tok = tokbase + (int)(0xFFFFFFFFu - (unsigned)(keys[r] & 0xFFFFFFFFull));
                        const u32x4* sp = (const u32x4*)(HB + (size_t)tok * DM);
#pragma unroll
                        for (int i = 0; i < 4; ++i) t4[q][i] = sp[i * 64 + lane]; }
#pragma unroll
                    for (int q = 0; q < 4; ++q) { const int r = rb + wave + 8 * q; const int row = e * MOE_PAD + (set ? 2048 + b * 32 + r : b * 512 + r);
                        u32x4* dp = (u32x4*)(XG + (size_t)row * DM);
#pragma unroll
                        for (int i = 0; i < 4; ++i) dp[i * 64 + lane] = t4[q][i]; } }
            }
            if (!lastl && G > 128 && bid >= 128) {
                const int n_win = 32 * 55, n_br = 4 * 64, n_out = 32 * 8, n_glu = 16, n_gu = 16 * 2 * 192; (void)n_gu;
                CV_RUN(l + 1, bid - 128, G - 128, n_win); (void)n_br; (void)n_out; (void)n_glu;
            }
            {   const int pad0 = lastl ? 2048 : MOE_ROWS, npad = MOE_PAD - pad0;
                for (int R = bid * 8 + wave; R < NEXP * npad; R += G * 8) { const int e = R / npad, rr = pad0 + R % npad; u32x4* dp = (u32x4*)(XG + ((size_t)e * MOE_PAD + rr) * DM);
#pragma unroll
                    for (int i = 0; i < 4; ++i) dp[i * 64 + lane] = (u32x4){0u, 0u, 0u, 0u}; } }
            SEAM(PB + 10);
        }
        if (IN(PB + 12)) for (int rep_ = 0; rep_ < PROBE_REPS(12); ++rep_) {
            PH_BEGIN
            pg8::Gemm g{XG, WGU, DM, DM, DM}; pg8::SchedMoe S{lastl ? 8 : 9, 12, G, bid, DM, DM, 2 * DEXP}; pg8::EpiMoe1 E{HID};
            pg8::gemm_phase((LAS unsigned char*)shm, g, S, E);
            SEAM(PB + 12);
        }
        if (IN(PB + 13)) for (int rep_ = 0; rep_ < PROBE_REPS(13); ++rep_) {
            PH_BEGIN
            pg8::Gemm g{HID, WD, DEXP, DEXP, DEXP}; pg8::SchedMoe S{lastl ? 8 : 9, 8, G, bid, DEXP, DEXP, DM}; pg8::EpiMoeY E{YEXP};
            pg8::gemm_phase((LAS unsigned char*)shm, g, S, E);
            SEAM(PB + 13);
        }

}

__global__ __launch_bounds__(NTHR, 2) void fwd(Args a) {
    extern __shared__ __attribute__((aligned(16))) unsigned char shm[];
    const int bid = blockIdx.x, G = gridDim.x;
    float* const sf = (float*)shm;
    volatile LAS unsigned* xbw = (volatile LAS unsigned*)((LAS unsigned char*)shm + (LDS_BYTES - 16));
    if (threadIdx.x == 0) { xbw[0] = 0u; xbw[1] = 0u; xbw[2] = 0u; xbw[3] = 0u; }
    const float** const ptab = (const float**)(shm + (LDS_BYTES - 16 - 512));
    if (threadIdx.x == 0) {
#pragma unroll
        for (int i = 0; i < 47; ++i) ptab[i] = a.in[i]; }
    __syncthreads();
    XcdBarrier bar = xcd_barrier_post((unsigned*)(a.ws + O_BAR), xbw);
    const int lo = a.ph_lo, hi = a.ph_hi;
    if (IN(0)) {
        PH_BEGIN
        {
            __syncthreads();
            for (int i = tid; i < 5 * DM; i += NTHR) { const int r = i >> 11, k = i & (DM - 1); const float v = r < 4 ? c_in[r * DM + k] : cctx_in[k]; sf[i] = siluf_(v); }
            __syncthreads();
            float* red = sf + 5 * DM;
            for (int unit = bid; unit < 2 * 96; unit += G) { const int l = unit / 96, j = (unit % 96) * 128 + (tid & 127), kq = tid >> 7;
                const float* w = ada_w + (size_t)l * DM * (6 * DM) + (size_t)(kq * 512) * (6 * DM) + j; const float* sv = sf + kq * 512;
                float a0 = 0.f, a1 = 0.f, a2 = 0.f, a3 = 0.f, a4 = 0.f;
#pragma unroll 8
                for (int k = 0; k < 512; ++k) { const float wv = w[(size_t)k * (6 * DM)]; a0 += sv[k] * wv; a1 += sv[DM + k] * wv; a2 += sv[2 * DM + k] * wv; a3 += sv[3 * DM + k] * wv; a4 += sv[4 * DM + k] * wv; }
                __syncthreads();
                { float* rp = red + (kq * 5) * 128 + (tid & 127); rp[0] = a0; rp[128] = a1; rp[256] = a2; rp[384] = a3; rp[512] = a4; }
                __syncthreads();
                if (tid < 128) { const float bb = ada_b[l * 6 * DM + j]; float* o = MOD + (size_t)l * 5 * 6 * DM + j;
#pragma unroll
                    for (int r = 0; r < 5; ++r) o[(size_t)r * 6 * DM] = ((red[(0 * 5 + r) * 128 + tid] + red[(1 * 5 + r) * 128 + tid]) + (red[(2 * 5 + r) * 128 + tid] + red[(3 * 5 + r) * 128 + tid])) + bb; }
            }
        }
    }

    layer_body<0>(a, bar, lo, hi, bid, G, shm, sf, ptab);
    layer_body<1>(a, bar, lo, hi, bid, G, shm, sf, ptab);
    if (IN(33)) {
        PH_BEGIN
        const float* gn = PT(46);
        for (int tok = bid * 8 + wave; tok < NLAT; tok += G * 8) {
            const float* xr = XS + (size_t)tok * DM; float4 v[8]; float ss = 0.f;
#pragma unroll
            for (int i = 0; i < 8; ++i) v[i] = *(const float4*)(xr + i * 256 + lane * 4);
            moe_combine(v, tok, lane, INV, ROWGATE, YEXP, MOD + (size_t)(1 * 5 + tok / SEQ) * 6 * DM + 5 * DM);
#pragma unroll
            for (int i = 0; i < 8; ++i) {                 ss += v[i].x * v[i].x + v[i].y * v[i].y + v[i].z * v[i].z + v[i].w * v[i].w; }
            ss = wave_sum(ss); const float rs = rsqrtf(ss * (1.0f / DM) + 1e-6f);
#pragma unroll
            for (int i = 0; i < 8; ++i) { const int d = i * 256 + lane * 4; const float4 g4 = *(const float4*)(gn + d);
                *(float4*)(a.out + (size_t)tok * DM + d) = make_float4(v[i].x * rs * g4.x, v[i].y * rs * g4.y, v[i].z * rs * g4.z, v[i].w * rs * g4.w); }
        }
    }
#undef IN
#undef SEAM
}


extern "C" void kernel_launch(void* const* d_in, const int* in_sizes, int n_in, void* d_out, int out_size, void* d_ws, size_t ws_size, hipStream_t stream) {
    static int grid = 0;
    if (grid == 0) {
        if (n_in != 47 || ws_size < WS_END) { fprintf(stderr, "kernel_launch: expected 47 inputs and >= %zu bytes of workspace; got %d, %zu\n", (size_t)WS_END, n_in, ws_size); grid = -1; return; }
        int dev = 0, cus = 0;
        if (hipGetDevice(&dev) != hipSuccess || hipDeviceGetAttribute(&cus, hipDeviceAttributeMultiprocessorCount, dev) != hipSuccess) { grid = -1; return; }
        if (hipFuncSetAttribute((const void*)fwd, hipFuncAttributeMaxDynamicSharedMemorySize, LDS_BYTES) != hipSuccess) { fprintf(stderr, "kernel_launch: hipFuncSetAttribute failed\n"); grid = -1; return; }
        int per_cu = 0;
        if (hipOccupancyMaxActiveBlocksPerMultiprocessor(&per_cu, (const void*)fwd, NTHR, LDS_BYTES) != hipSuccess || per_cu < 1) fprintf(stderr, "kernel_launch: occupancy query reports %d\n", per_cu);
        (void)hipGetLastError();
        grid = cus > 256 ? 256 : cus;
        if (grid < 224) { fprintf(stderr, "kernel_launch: needs >= 224 CUs (got %d)\n", grid); grid = -1; return; }
    }
    if (grid < 0) return;
    (void)hipMemsetAsync((char*)d_ws, 0, O_ZERO_END, stream);
    Args a{};
    for (int i = 0; i < 47; ++i) a.in[i] = (const float*)d_in[i];
    a.out = (float*)d_out; a.ws = (unsigned char*)d_ws;
#if MK_ONE_LAUNCH
    a.ph_lo = 0; a.ph_hi = 64;
    hipLaunchKernelGGL(fwd, dim3(grid), dim3(NTHR), LDS_BYTES, stream, a);
#else
    const int ids[] = {0, 1,2,3,4,5,6,7,8,9,10,11,12,13,14, 17,18,19,20,21,22,23,24,25,26,27,28,29,30, 33};
    for (int k = 0; k < (int)(sizeof(ids) / sizeof(ids[0])); ++k) { a.ph_lo = ids[k]; a.ph_hi = ids[k] + 1; hipLaunchKernelGGL(fwd, dim3(grid), dim3(NTHR), LDS_BYTES, stream, a); }
#endif
}
```

```cpp
#include <hip/hip_runtime.h>
#include <stdint.h>
#include <stdio.h>

#ifndef PROBE_MASK
#define PROBE_MASK 0
#endif
#ifndef PROBE_SP
#define PROBE_SP 1
#endif
#define PROBE_REPS(k) ((((PROBE_MASK) >> (k)) & 1) + 1)
#ifndef MK_ONE_LAUNCH
#define MK_ONE_LAUNCH 1
#endif

#define DM 2048
#define NB 4
#define SEQ 4096
#define CTXL 256
#define BW 512
#define NLAT 16384
#define NCTX 1024
#define NTOK 17408
#define IN_W 13856
#define LDP 14080
#define HY_OFF 0
#define ML_OFF 1536
#define S5_OFF 3600
#define SSD_OFF 4112
#define GATE_OFF 5664
#define NEXP 16
#define DEXP 1536
#define MOE_ROWS 2176
#define MOE_PAD 2304
#define NTHR 512
#define LDS_BYTES 147456
#define LAS __attribute__((address_space(3)))

typedef unsigned short bf16_t;
typedef short bf16x8 __attribute__((ext_vector_type(8)));
typedef float f32x4 __attribute__((ext_vector_type(4)));
typedef unsigned u32x4 __attribute__((ext_vector_type(4)));
typedef unsigned u32x2 __attribute__((ext_vector_type(2)));

#define XB_TMO      128
#define XB_XCNT(j)  (256  + 64 * (j))
#define XB_XSUB(j)  (1280 + 64 * (j))
#define XB_XGEN(j)  (2304 + 64 * (j))
#define XB_TOP      3328
#define XB_TOPGEN   3392
#define XCD_BAR_WORDS 3456
#define XB_SPIN_CAP (1u << 18)
__device__ __forceinline__ unsigned xb_ld(unsigned* p)              { return __hip_atomic_load(p, __ATOMIC_RELAXED, __HIP_MEMORY_SCOPE_AGENT); }
__device__ __forceinline__ unsigned xb_add(unsigned* p, unsigned v) { return __hip_atomic_fetch_add(p, v, __ATOMIC_RELAXED, __HIP_MEMORY_SCOPE_AGENT); }
__device__ __forceinline__ unsigned xb_xcc_id() { return (unsigned)__builtin_amdgcn_s_getreg((3 << 11) | 20) & 0xFu; }
#define XB_SPIN(cond, bar) do { unsigned _sp = 0; while (cond) { __builtin_amdgcn_s_sleep(1); \
    if ((++_sp & 255u) == 0u) { if (xb_ld(&(bar)[XB_TMO])) break; if (_sp > XB_SPIN_CAP) { atomicAdd(&(bar)[XB_TMO], 1u); break; } } } } while (0)
struct XcdBarrier { unsigned* bar; unsigned x; volatile LAS unsigned* st; };
__device__ __forceinline__ XcdBarrier xcd_barrier_post(unsigned* bar, volatile LAS unsigned* st) {
    XcdBarrier b; b.bar = bar; b.x = xb_xcc_id(); b.st = st;
    if (threadIdx.x == 0) (void)xb_add(&bar[XB_XCNT(b.x)], 1u);
    return b;
}
__device__ __forceinline__ void xcd_barrier_complete(unsigned* bar, unsigned x, unsigned& nloc, unsigned& nx) {
    const unsigned G = gridDim.x * gridDim.y * gridDim.z;
    unsigned sum, cnt, mine, sp = 0u;
    for (;;) {
        sum = 0u; cnt = 0u; mine = 0u;
#pragma unroll
        for (unsigned j = 0; j < 16; ++j) { const unsigned c = xb_ld(&bar[XB_XCNT(j)]); sum += c; cnt += (c > 0u) ? 1u : 0u; mine = (j == x) ? c : mine; }
        if (sum == G) break;
        __builtin_amdgcn_s_sleep(1);
        if ((++sp & 255u) == 0u) { if (xb_ld(&bar[XB_TMO])) break; if (sp > XB_SPIN_CAP) { atomicAdd(&bar[XB_TMO], 1u); break; } }
    }
    nloc = mine > 0u ? mine : 1u; nx = cnt > 0u ? cnt : 1u;
}
__device__ __forceinline__ void xcd_barrier(const XcdBarrier& b) {
    asm volatile("s_waitcnt vmcnt(0)" ::: "memory");
    __syncthreads();
    if (threadIdx.x == 0) {
        unsigned* bar = b.bar;
        __builtin_amdgcn_s_waitcnt(0);
        unsigned nloc = b.st[0], nx = b.st[1];
        if (nloc == 0u) { xcd_barrier_complete(bar, b.x, nloc, nx); b.st[0] = nloc; b.st[1] = nx; }
        const unsigned old = xb_add(&bar[XB_XSUB(b.x)], 1u);
        const unsigned gen = old / nloc;
        if (old + 1u == (gen + 1u) * nloc) {
            __builtin_amdgcn_fence(__ATOMIC_RELEASE, "agent");
            asm volatile("s_waitcnt vmcnt(0)" ::: "memory");
            const unsigned og = xb_add(&bar[XB_TOP], 1u);
            const unsigned tg = og / nx;
            if (og + 1u == (tg + 1u) * nx) xb_add(&bar[XB_TOPGEN], 1u);
            else XB_SPIN(xb_ld(&bar[XB_TOPGEN]) == tg, bar);
            __builtin_amdgcn_fence(__ATOMIC_ACQUIRE, "agent");
            xb_add(&bar[XB_XGEN(b.x)], 1u);
            asm volatile("s_waitcnt vmcnt(0)" ::: "memory");
        } else {
            XB_SPIN(xb_ld(&bar[XB_XGEN(b.x)]) == gen, bar);
            __builtin_amdgcn_fence(__ATOMIC_ACQUIRE, "agent");
            asm volatile("s_waitcnt vmcnt(0)" ::: "memory");
        }
    }
    __syncthreads();
}

__device__ __forceinline__ unsigned short f2bf(float f) { unsigned u = __float_as_uint(f); u += 0x7FFFu + ((u >> 16) & 1u); return (unsigned short)(u >> 16); }
__device__ __forceinline__ float bf2f(unsigned short b) { return __uint_as_float(((unsigned)b) << 16); }
__device__ __forceinline__ unsigned pk2(float lo, float hi) { unsigned r; asm("v_cvt_pk_bf16_f32 %0, %1, %2" : "=v"(r) : "v"(lo), "v"(hi)); return r; }
__device__ __forceinline__ float sigmoidf_(float x) { return 1.0f / (1.0f + expf(-x)); }
__device__ __forceinline__ float siluf_(float x) { return x / (1.0f + expf(-x)); }
__device__ __forceinline__ float wave_sum(float v) {
#pragma unroll
    for (int o = 32; o >= 1; o >>= 1) v += __shfl_xor(v, o);
    return v;
}
__device__ __forceinline__ const float* uptr(const float* p) { const unsigned long long v = (unsigned long long)p;
    const unsigned lo = __builtin_amdgcn_readfirstlane((unsigned)v), hi = __builtin_amdgcn_readfirstlane((unsigned)(v >> 32)); return (const float*)(((unsigned long long)hi << 32) | lo); }
#define PT(k) uptr(ptab[k])
__device__ __forceinline__ int step_tok(int b, int dir, int i) {
    if (i < CTXL) { const int tt = dir ? (CTXL - 1 - i) : i; return NLAT + b * CTXL + tt; }
    const int j = i - CTXL; const int tt = dir ? (SEQ - 1 - j) : j; return b * SEQ + tt;
}
__device__ __forceinline__ void unpack8(const u32x4 w, float (&f)[8]) {
    f[0] = __uint_as_float(w.x << 16); f[1] = __uint_as_float(w.x & 0xFFFF0000u); f[2] = __uint_as_float(w.y << 16); f[3] = __uint_as_float(w.y & 0xFFFF0000u);
    f[4] = __uint_as_float(w.z << 16); f[5] = __uint_as_float(w.z & 0xFFFF0000u); f[6] = __uint_as_float(w.w << 16); f[7] = __uint_as_float(w.w & 0xFFFF0000u);
}

namespace pg8 {
constexpr int BM = 256, BK = 64, HALF = 128, HTB = HALF * BK * 2, STAGE_BYTES = 8 * HTB, NXCD = 8, WGM = 8;
__host__ __device__ __forceinline__ int lds_byte(int r, int c) { const int st = (r >> 4) * 2 + (c >> 5), rr = r & 15, cc = c & 31, ob = rr * 64 + cc * 2; return st * 1024 + (ob ^ (((ob >> 9) & 1) << 5)); }
__host__ __device__ __forceinline__ void stage_rc(int b, int& R, int& C) { const int st = b / 1024, sb = b % 1024, swz = sb ^ (((sb >> 9) & 1) << 5); R = (st >> 1) * 16 + swz / 64; C = (st & 1) * 32 + (swz % 64) / 2; }
__host__ __device__ __forceinline__ int perm32(int rho) { const int n = rho >> 4, i = rho & 15; return 8 * (i >> 2) + 4 * n + (i & 3); }
struct Unit { int pm, pn, z, k; long long ao, bo; };
struct Gemm { const bf16_t* A; const bf16_t* Bt; int lda, ldb, K; };

__device__ __forceinline__ void tile_of(int wgid, int nM, int nN, int& pm, int& pn) {
    const int nwg = nM * nN; { const int q = nwg / NXCD, r = nwg % NXCD, xcd = wgid % NXCD, off = wgid / NXCD; wgid = (xcd < r ? xcd * (q + 1) : r * (q + 1) + (xcd - r) * q) + off; }
    const int nig = WGM * nN, gid = wgid / nig, fm = gid * WGM, gsz = (nM - fm) < WGM ? (nM - fm) : WGM;
    pm = fm + ((wgid % nig) % gsz); pn = (wgid % nig) / gsz;
}
struct SchedStd {
    int nM, nN, G, c, lda, ldb;
    __device__ __forceinline__ bool next(int i, Unit& u) const { const long L = (long)i * G + c; if (L >= (long)nM * nN) return false; tile_of((int)L, nM, nN, u.pm, u.pn); u.z = 0; u.k = 0;
        u.ao = (long long)u.pm * BM * lda * 2; u.bo = (long long)u.pn * BM * ldb * 2; return true; }
    __device__ __forceinline__ void a_ready(const Unit&) const {}
    __device__ __forceinline__ void done(const Unit&) const {}
};
struct SchedBranch {
    int nM, nN, G, c;
    __device__ __forceinline__ bool next(int i, Unit& u) const { const long L = (long)(i >> 2) * G + c; if (L >= (long)nM * nN) return false; tile_of((int)L, nM, nN, u.pm, u.pn); u.z = 0; u.k = i & 3;
        u.ao = ((long long)u.pm * BM * DM + u.k * BW) * 2; u.bo = ((long long)u.k * DM + u.pn * BM) * BW * 2; return true; }
    __device__ __forceinline__ void a_ready(const Unit&) const {}
    __device__ __forceinline__ void done(const Unit&) const {}
};
struct SchedTail {
    int G, c;
    __device__ __forceinline__ bool next(int i, Unit& u) const { const long T = (long)i * G + c; if (T >= 128) return false; const int t = (int)(T >> 2); u.pm = 64 + (t >> 3); u.pn = t & 7; u.z = 1; u.k = (int)(T & 3);
        u.ao = ((long long)u.pm * BM * DM + u.k * BW) * 2; u.bo = ((long long)u.k * DM + u.pn * BM) * BW * 2; return true; }
    __device__ __forceinline__ void a_ready(const Unit&) const {}
    __device__ __forceinline__ void done(const Unit&) const {}
};
struct SchedMoe {
    int nPm, nPn, G, c, lda, ldb, nBrows;
    __device__ __forceinline__ bool next(int i, Unit& u) const { const long L = (long)i * G + c; const int per = nPm * nPn; if (L >= (long)NEXP * per) return false; const int e = (int)(L / per), rem = (int)(L % per);
        u.z = e; u.k = 0; u.pm = rem % nPm; u.pn = rem / nPm; u.ao = ((long long)e * MOE_PAD + u.pm * BM) * lda * 2; u.bo = ((long long)e * nBrows + u.pn * BM) * ldb * 2; return true; }
    __device__ __forceinline__ void a_ready(const Unit&) const {}
    __device__ __forceinline__ void done(const Unit&) const {}
};

typedef f32x4 Acc[2][2][4][2];
template <class Epi, class Sched>
__device__ __forceinline__ void gemm_phase(LAS unsigned char* lds, const Gemm g, const Sched& S, const Epi& E) {
    int tid = threadIdx.x; asm volatile("" : "+v"(tid));
    const int wid = __builtin_amdgcn_readfirstlane(tid >> 6), lane = tid & 63, wr = wid >> 2, wc = wid & 3, fr = lane & 15, fq = lane >> 4;
    const int K = g.K, nt = K / BK;
    unsigned voffA[2], voffB[2];
#pragma unroll
    for (int i = 0; i < 2; ++i) { int R, C; stage_rc(tid * 16 + i * 8192, R, C); const int Rb = Epi::PERM ? ((R & ~31) + perm32(R & 31)) : R;
        voffA[i] = (unsigned)(R * g.lda + C) * 2u; voffB[i] = (unsigned)(Rb * g.ldb + C) * 2u; }
    const size_t kstep = (size_t)(BK * 2);
    const size_t hstepA = (size_t)HALF * g.lda * 2, hstepB = (size_t)HALF * g.ldb * 2;
    const unsigned ldsw = (unsigned)wid * 1024u;
    const int aoff = lds_byte(wr * 64 + fr, fq * 8), boff = lds_byte(wc * 32 + fr, fq * 8);
#define PG8_SA(b, h) (((b) * 2 + (h)) * HTB)
#define PG8_SB(b, h) ((4 + (b) * 2 + (h)) * HTB)
#define PG8_STAGE(bufoff, gbase, voff) do { _Pragma("unroll") for (int _i = 0; _i < 2; ++_i) \
        __builtin_amdgcn_global_load_lds((const unsigned*)((const char*)(gbase) + (voff)[_i]), (LAS unsigned*)(lds + (bufoff) + ldsw + _i * 8192), 16, 0, 0); } while (0)
#define PG8_LDA(dst, b, h) do { _Pragma("unroll") for (int m = 0; m < 4; ++m) _Pragma("unroll") for (int k = 0; k < 2; ++k) dst[m][k] = *(const LAS bf16x8*)(lds + PG8_SA(b, h) + aoff + m * 2048 + k * 1024); } while (0)
#define PG8_LDB(dst, b, h) do { _Pragma("unroll") for (int n = 0; n < 2; ++n) _Pragma("unroll") for (int k = 0; k < 2; ++k) dst[n][k] = *(const LAS bf16x8*)(lds + PG8_SB(b, h) + boff + n * 2048 + k * 1024); } while (0)
#define PG8_MMA(ai, bj, At, Bt) do { __builtin_amdgcn_s_setprio(1); _Pragma("unroll") for (int m = 0; m < 4; ++m) _Pragma("unroll") for (int n = 0; n < 2; ++n) _Pragma("unroll") for (int k = 0; k < 2; ++k) \
        acc[ai][bj][m][n] = __builtin_amdgcn_mfma_f32_16x16x32_bf16(Bt[n][k], At[m][k], acc[ai][bj][m][n], 0, 0, 0); __builtin_amdgcn_s_setprio(0); } while (0)
#define PG8_WAIT_V(n) asm volatile("s_waitcnt vmcnt(" #n ")" ::: "memory")
#define PG8_WAIT_L(n) asm volatile("s_waitcnt lgkmcnt(" #n ")" ::: "memory")
#define PG8_BAR __builtin_amdgcn_s_barrier()
#define PG8_SCHED __builtin_amdgcn_sched_barrier(0)
    Unit cur, nxt; int ui = 0;
    if (!S.next(0, cur)) return;
    Acc acc;
#pragma unroll
    for (int a = 0; a < 2; ++a)
#pragma unroll
        for (int b = 0; b < 2; ++b)
#pragma unroll
            for (int m = 0; m < 4; ++m)
#pragma unroll
                for (int n = 0; n < 2; ++n) acc[a][b][m][n] = (f32x4){0.f, 0.f, 0.f, 0.f};
    bf16x8 At[4][2], B0[2][2], B1[2][2];
    const char* cA = (const char*)g.A + cur.ao; const char* cB = (const char*)g.Bt + cur.bo;
    S.a_ready(cur);
    PG8_STAGE(PG8_SB(0, 0), cB, voffB); PG8_STAGE(PG8_SA(0, 0), cA, voffA); PG8_STAGE(PG8_SB(0, 1), cB + hstepB, voffB); PG8_STAGE(PG8_SA(0, 1), cA + hstepA, voffA);
    if (wr == 1) PG8_BAR;
    PG8_WAIT_V(4); PG8_BAR;
    PG8_STAGE(PG8_SB(1, 0), cB + kstep, voffB); PG8_STAGE(PG8_SA(1, 0), cA + kstep, voffA); PG8_STAGE(PG8_SB(1, 1), cB + hstepB + kstep, voffB);
    PG8_WAIT_V(6); PG8_BAR;
    for (;;) {
        const bool has_next = S.next(ui + 1, nxt);
        const char* nA = has_next ? (const char*)g.A + nxt.ao : cA; const char* nB = has_next ? (const char*)g.Bt + nxt.bo : cB;
        for (int t = 0; t < nt; t += 2) {
            const bool last = (t == nt - 2);
            const char* a1 = cA + (size_t)(t + 1) * kstep;
            const char* a2 = last ? nA : cA + (size_t)(t + 2) * kstep; const char* b2 = last ? nB : cB + (size_t)(t + 2) * kstep;
            const char* a3 = a2 + kstep; const char* b3 = b2 + kstep;
            if (last && has_next) S.a_ready(nxt);
            PG8_LDB(B0, 0, 0); PG8_SCHED; PG8_LDA(At, 0, 0); PG8_STAGE(PG8_SA(1, 1), a1 + hstepA, voffA);
            PG8_WAIT_L(8); PG8_BAR; PG8_WAIT_L(0); PG8_MMA(0, 0, At, B0); PG8_BAR; PG8_SCHED;
            PG8_LDB(B1, 0, 1); PG8_STAGE(PG8_SB(0, 0), b2, voffB);
            PG8_BAR; PG8_WAIT_L(0); PG8_MMA(0, 1, At, B1); PG8_BAR;
            PG8_LDA(At, 0, 1); PG8_STAGE(PG8_SA(0, 0), a2, voffA);
            PG8_BAR; PG8_WAIT_L(0); PG8_MMA(1, 0, At, B0); PG8_BAR; PG8_SCHED;
            PG8_STAGE(PG8_SB(0, 1), b2 + hstepB, voffB);
            PG8_WAIT_V(6); PG8_BAR; PG8_MMA(1, 1, At, B1); PG8_BAR;
            PG8_LDB(B0, 1, 0); PG8_SCHED; PG8_LDA(At, 1, 0); PG8_STAGE(PG8_SA(0, 1), a2 + hstepA, voffA);
            PG8_WAIT_L(8); PG8_BAR; PG8_WAIT_L(0); PG8_MMA(0, 0, At, B0); PG8_BAR; PG8_SCHED;
            PG8_LDB(B1, 1, 1); PG8_STAGE(PG8_SB(1, 0), b3, voffB);
            PG8_BAR; PG8_WAIT_L(0); PG8_MMA(0, 1, At, B1); PG8_BAR;
            PG8_LDA(At, 1, 1); PG8_STAGE(PG8_SA(1, 0), a3, voffA);
            PG8_BAR; PG8_WAIT_L(0); PG8_MMA(1, 0, At, B0); PG8_BAR; PG8_SCHED;
            PG8_STAGE(PG8_SB(1, 1), b3 + hstepB, voffB);
            PG8_WAIT_V(6); PG8_BAR; PG8_MMA(1, 1, At, B1); PG8_BAR;
        }
        const bool keep = E(acc, cur, wr, wc, fr, fq); S.done(cur);
        if (!has_next) break;
        if (!keep) {
#pragma unroll
        for (int a = 0; a < 2; ++a)
#pragma unroll
            for (int b = 0; b < 2; ++b)
#pragma unroll
                for (int m = 0; m < 4; ++m)
#pragma unroll
                    for (int n = 0; n < 2; ++n) acc[a][b][m][n] = (f32x4){0.f, 0.f, 0.f, 0.f};
        }
        cur = nxt; cA = nA; cB = nB; ++ui;
    }
    PG8_WAIT_V(0);
    if (wr == 0) PG8_BAR;
    PG8_BAR;
#undef PG8_SA
#undef PG8_SB
#undef PG8_STAGE
#undef PG8_LDA
#undef PG8_LDB
#undef PG8_MMA
#undef PG8_WAIT_V
#undef PG8_WAIT_L
#undef PG8_BAR
#undef PG8_SCHED
}

struct EpiBf16Store {
    static constexpr bool PERM = true;
    bf16_t* O; int ldc;
    __device__ __forceinline__ bool operator()(Acc& acc, const Unit& u, int wr, int wc, int fr, int fq) const {
        const int row0 = u.pm * BM + wr * 64 + fr, col0 = u.pn * BM + wc * 32 + 8 * fq;
#pragma unroll
        for (int ai = 0; ai < 2; ++ai)
#pragma unroll
            for (int m = 0; m < 4; ++m) { bf16_t* rowp = O + (size_t)(row0 + ai * HALF + m * 16) * ldc + col0;
#pragma unroll
                for (int bj = 0; bj < 2; ++bj) { const f32x4 v0 = acc[ai][bj][m][0], v1 = acc[ai][bj][m][1];
                    u32x4 w; w.x = pk2(v0[0], v0[1]); w.y = pk2(v0[2], v0[3]); w.z = pk2(v1[0], v1[1]); w.w = pk2(v1[2], v1[3]);
                    *(u32x4*)(rowp + bj * HALF) = w; } }
        return false;
    }
};
struct EpiWin {
    static constexpr bool PERM = true;
    bf16_t* O; int ldc;
    __device__ __forceinline__ bool operator()(Acc& acc, const Unit& u, int wr, int wc, int fr, int fq) const {
        const int row0 = u.pm * BM + wr * 64 + fr, col0 = u.pn * BM + wc * 32 + 8 * fq;
#pragma unroll
        for (int bj = 0; bj < 2; ++bj) { const bool gate = (col0 + bj * HALF) >= GATE_OFF;
#pragma unroll
            for (int ai = 0; ai < 2; ++ai)
#pragma unroll
                for (int m = 0; m < 4; ++m) { f32x4 v0 = acc[ai][bj][m][0], v1 = acc[ai][bj][m][1];
                    if (gate) {
#pragma unroll
                        for (int j = 0; j < 4; ++j) { v0[j] = __builtin_amdgcn_rcpf(1.0f + __expf(-v0[j])); v1[j] = __builtin_amdgcn_rcpf(1.0f + __expf(-v1[j])); } }
                    u32x4 w; w.x = pk2(v0[0], v0[1]); w.y = pk2(v0[2], v0[3]); w.z = pk2(v1[0], v1[1]); w.w = pk2(v1[2], v1[3]);
                    *(u32x4*)(O + (size_t)(row0 + ai * HALF + m * 16) * ldc + col0 + bj * HALF) = w; } }
        return false;
    }
};
struct EpiNone { static constexpr bool PERM = true;
    __device__ __forceinline__ bool operator()(Acc& acc, const Unit&, int, int, int, int) const {
#pragma unroll
        for (int a = 0; a < 2; ++a)
#pragma unroll
            for (int b = 0; b < 2; ++b)
#pragma unroll
                for (int m = 0; m < 4; ++m)
#pragma unroll
                    for (int n = 0; n < 2; ++n) asm volatile("" :: "v"(acc[a][b][m][n]));
        return false; } };
struct EpiGlu {
    static constexpr bool PERM = true;
    const bf16_t* GG; const float* bias; bf16_t* Y4;
    __device__ __forceinline__ bool operator()(Acc& acc, const Unit& u, int wr, int wc, int fr, int fq) const {
        const int row0 = u.pm * BM + wr * 64 + fr, col0 = u.pn * BM + wc * 32 + 8 * fq;
#pragma unroll
        for (int bj = 0; bj < 2; ++bj) { const int col = col0 + bj * HALF; const f32x4 b0 = *(const f32x4*)(bias + col), b1 = *(const f32x4*)(bias + col + 4);
            u32x4 gq[2][4];
#pragma unroll
            for (int ai = 0; ai < 2; ++ai)
#pragma unroll
                for (int m = 0; m < 4; ++m) gq[ai][m] = *(const u32x4*)(GG + (size_t)(row0 + ai * HALF + m * 16) * BW + col);
#pragma unroll
            for (int ai = 0; ai < 2; ++ai)
#pragma unroll
                for (int m = 0; m < 4; ++m) { const size_t row = (size_t)(row0 + ai * HALF + m * 16);
                    float gg[8]; unpack8(gq[ai][m], gg);
                    const f32x4 v0 = acc[ai][bj][m][0] + b0, v1 = acc[ai][bj][m][1] + b1;
                    u32x4 w; w.x = pk2(gg[0] * sigmoidf_(v0[0]), gg[1] * sigmoidf_(v0[1])); w.y = pk2(gg[2] * sigmoidf_(v0[2]), gg[3] * sigmoidf_(v0[3]));
                    w.z = pk2(gg[4] * sigmoidf_(v1[0]), gg[5] * sigmoidf_(v1[1])); w.w = pk2(gg[6] * sigmoidf_(v1[2]), gg[7] * sigmoidf_(v1[3]));
                    *(u32x4*)(Y4 + row * DM + 1024 + col) = w; } }
        return false;
    }
};
struct EpiBranch {
    static constexpr bool PERM = true;
    const bf16_t* P; bf16_t* ACCb;
    __device__ __forceinline__ bool operator()(Acc& acc, const Unit& u, int wr, int wc, int fr, int fq) const {
        const int row0 = u.pm * BM + wr * 64 + fr, col0 = u.pn * BM + wc * 32 + 8 * fq; const int k = u.k;
        const bf16_t* gbase = P + (size_t)row0 * LDP + GATE_OFF + k * DM + col0;
        if (k < 3) {
#pragma unroll
            for (int ai = 0; ai < 2; ++ai) {
                u32x4 ga[8], gb[8];
#pragma unroll
                for (int m = 0; m < 4; ++m)
#pragma unroll
                    for (int bj = 0; bj < 2; ++bj) { const bf16_t* p = gbase + (size_t)(ai * HALF + m * 16) * LDP + bj * HALF; ga[m * 2 + bj] = *(const u32x4*)p; gb[m * 2 + bj] = *(const u32x4*)(p + DM); }
#pragma unroll
                for (int m = 0; m < 4; ++m)
#pragma unroll
                    for (int bj = 0; bj < 2; ++bj) { float g0[8], g1[8]; unpack8(ga[m * 2 + bj], g0); unpack8(gb[m * 2 + bj], g1);
                        float s[8];
#pragma unroll
                        for (int j = 0; j < 8; ++j) s[j] = g0[j] * __builtin_amdgcn_rcpf(g1[j]);
                        f32x4 v0 = acc[ai][bj][m][0], v1 = acc[ai][bj][m][1];
                        v0[0] *= s[0]; v0[1] *= s[1]; v0[2] *= s[2]; v0[3] *= s[3]; v1[0] *= s[4]; v1[1] *= s[5]; v1[2] *= s[6]; v1[3] *= s[7];
                        acc[ai][bj][m][0] = v0; acc[ai][bj][m][1] = v1; } }
            return true;
        }
#pragma unroll
        for (int ai = 0; ai < 2; ++ai) {
            u32x4 ga[8];
#pragma unroll
            for (int m = 0; m < 4; ++m)
#pragma unroll
                for (int bj = 0; bj < 2; ++bj) ga[m * 2 + bj] = *(const u32x4*)(gbase + (size_t)(ai * HALF + m * 16) * LDP + bj * HALF);
#pragma unroll
            for (int m = 0; m < 4; ++m)
#pragma unroll
                for (int bj = 0; bj < 2; ++bj) { float s[8]; unpack8(ga[m * 2 + bj], s);
                    f32x4 v0 = acc[ai][bj][m][0], v1 = acc[ai][bj][m][1];
                    v0[0] *= s[0]; v0[1] *= s[1]; v0[2] *= s[2]; v0[3] *= s[3]; v1[0] *= s[4]; v1[1] *= s[5]; v1[2] *= s[6]; v1[3] *= s[7];
                    u32x4 w; w.x = pk2(v0[0], v0[1]); w.y = pk2(v0[2], v0[3]); w.z = pk2(v1[0], v1[1]); w.w = pk2(v1[2], v1[3]);
                    *(u32x4*)(ACCb + (size_t)(row0 + ai * HALF + m * 16) * DM + col0 + bj * HALF) = w; } }
        return false;
    }
};
struct EpiPart {
    static constexpr bool PERM = true;
    const bf16_t* P; float* PART;
    __device__ __forceinline__ bool operator()(Acc& acc, const Unit& u, int wr, int wc, int fr, int fq) const {
        const int row0 = u.pm * BM + wr * 64 + fr, col0 = u.pn * BM + wc * 32 + 8 * fq; const int k = u.k;
        const bf16_t* gbase = P + (size_t)row0 * LDP + GATE_OFF + k * DM + col0;
        float* pbase = PART + ((size_t)k * (NTOK - NLAT) + (size_t)(row0 - NLAT)) * DM + col0;
#pragma unroll
        for (int ai = 0; ai < 2; ++ai) {
            u32x4 ga[8];
#pragma unroll
            for (int m = 0; m < 4; ++m)
#pragma unroll
                for (int bj = 0; bj < 2; ++bj) ga[m * 2 + bj] = *(const u32x4*)(gbase + (size_t)(ai * HALF + m * 16) * LDP + bj * HALF);
#pragma unroll
            for (int m = 0; m < 4; ++m)
#pragma unroll
                for (int bj = 0; bj < 2; ++bj) { float sg[8]; unpack8(ga[m * 2 + bj], sg);
                    f32x4 v0 = acc[ai][bj][m][0], v1 = acc[ai][bj][m][1];
                    v0[0] *= sg[0]; v0[1] *= sg[1]; v0[2] *= sg[2]; v0[3] *= sg[3]; v1[0] *= sg[4]; v1[1] *= sg[5]; v1[2] *= sg[6]; v1[3] *= sg[7];
                    float* pp = pbase + (size_t)(ai * HALF + m * 16) * DM + bj * HALF;
                    *(f32x4*)pp = v0; *(f32x4*)(pp + 4) = v1; } }
        return false;
    }
};
struct EpiResid {
    static constexpr bool PERM = false;
    float* XS; const float* srcLat; const float* srcCtx; const float* MODl; int gidx;
    __device__ __forceinline__ bool operator()(Acc& acc, const Unit& u, int wr, int wc, int fr, int fq) const {
        const int row0 = u.pm * BM + wr * 64 + fr, col0 = u.pn * BM + wc * 32 + 4 * fq;
        const int r = (u.pm * BM) < NLAT ? (u.pm * BM) / SEQ : 4;
        const float* src = (u.pm * BM) < NLAT ? srcLat : srcCtx;
        const float* mg = MODl + (size_t)(r * 6 + gidx) * DM;
#pragma unroll
        for (int bj = 0; bj < 2; ++bj) {
            f32x4 gm[2], xs[2][2][4];
#pragma unroll
            for (int n = 0; n < 2; ++n) { const int col = col0 + bj * HALF + n * 16; gm[n] = *(const f32x4*)(mg + col);
#pragma unroll
                for (int ai = 0; ai < 2; ++ai)
#pragma unroll
                    for (int m = 0; m < 4; ++m) xs[n][ai][m] = *(const f32x4*)(src + (size_t)(row0 + ai * HALF + m * 16) * DM + col); }
#pragma unroll
            for (int n = 0; n < 2; ++n) { const int col = col0 + bj * HALF + n * 16;
#pragma unroll
                for (int ai = 0; ai < 2; ++ai)
#pragma unroll
                    for (int m = 0; m < 4; ++m) *(f32x4*)(XS + (size_t)(row0 + ai * HALF + m * 16) * DM + col) = xs[n][ai][m] + gm[n] * acc[ai][bj][m][n]; } }
        return false;
    }
};
struct EpiMoe1 {
    static constexpr bool PERM = true;
    bf16_t* HID;
    __device__ __forceinline__ bool operator()(Acc& acc, const Unit& u, int wr, int wc, int fr, int fq) const {
        const size_t row0 = (size_t)u.z * MOE_PAD + u.pm * BM + wr * 64 + fr; const int col0 = u.pn * HALF + wc * 32 + 8 * fq;
#pragma unroll
        for (int ai = 0; ai < 2; ++ai)
#pragma unroll
            for (int m = 0; m < 4; ++m) { const f32x4 g0 = acc[ai][0][m][0], g1 = acc[ai][0][m][1], u0 = acc[ai][1][m][0], u1 = acc[ai][1][m][1];
                float h[8];
#pragma unroll
                for (int j = 0; j < 4; ++j) { h[j] = g0[j] * __builtin_amdgcn_rcpf(1.0f + __expf(-g0[j])) * u0[j]; h[4 + j] = g1[j] * __builtin_amdgcn_rcpf(1.0f + __expf(-g1[j])) * u1[j]; }
                u32x4 w; w.x = pk2(h[0], h[1]); w.y = pk2(h[2], h[3]); w.z = pk2(h[4], h[5]); w.w = pk2(h[6], h[7]);
                *(u32x4*)(HID + (row0 + ai * HALF + m * 16) * DEXP + col0) = w; }
        return false;
    }
};
struct EpiMoeY {
    static constexpr bool PERM = true;
    bf16_t* O;
    __device__ __forceinline__ bool operator()(Acc& acc, const Unit& u, int wr, int wc, int fr, int fq) const {
        const size_t row0 = (size_t)u.z * MOE_PAD + u.pm * BM + wr * 64 + fr; const int col0 = u.pn * BM + wc * 32 + 8 * fq;
#pragma unroll
        for (int ai = 0; ai < 2; ++ai)
#pragma unroll
            for (int m = 0; m < 4; ++m) { bf16_t* rowp = O + (row0 + ai * HALF + m * 16) * DM + col0;
#pragma unroll
                for (int bj = 0; bj < 2; ++bj) { const f32x4 v0 = acc[ai][bj][m][0], v1 = acc[ai][bj][m][1];
                    u32x4 w; w.x = pk2(v0[0], v0[1]); w.y = pk2(v0[2], v0[3]); w.z = pk2(v1[0], v1[1]); w.w = pk2(v1[2], v1[3]);
                    *(u32x4*)(rowp + bj * HALF) = w; } }
        return false;
    }
};

struct SchedS5a {
    int c;
    __device__ __forceinline__ bool next(int i, Unit& u) const { if (i > 0 || c >= 64) return false; u.z = c >> 1; u.pm = c & 1; u.pn = 0; u.k = 0;
        u.ao = ((long long)u.z * 512 + u.pm * BM) * 768 * 2; u.bo = (long long)u.z * 256 * 512 * 2; return true; }
    __device__ __forceinline__ void a_ready(const Unit&) const {}
    __device__ __forceinline__ void done(const Unit&) const {}
};
struct SchedS5b {
    int c;
    __device__ __forceinline__ bool next(int i, Unit& u) const { if (i > 0 || c >= 128) return false; u.z = c >> 2; u.pm = (c >> 1) & 1; u.pn = c & 1; u.k = 0;
        u.ao = ((long long)u.z * 512 + u.pm * BM) * 768 * 2; u.bo = ((long long)u.z * 512 + u.pn * BM) * 768 * 2; return true; }
    __device__ __forceinline__ void a_ready(const Unit&) const {}
    __device__ __forceinline__ void done(const Unit&) const {}
};
struct EpiXloc {
    static constexpr bool PERM = false;
    float* XL;
    __device__ __forceinline__ bool operator()(Acc& acc, const Unit& u, int wr, int wc, int fr, int fq) const {
        const int row0 = u.pm * BM + wr * 64 + fr, col0 = wc * 32 + 4 * fq; float* base = XL + (size_t)u.z * 512 * 256;
#pragma unroll
        for (int ai = 0; ai < 2; ++ai)
#pragma unroll
            for (int m = 0; m < 4; ++m) { float* rowp = base + (size_t)(row0 + ai * HALF + m * 16) * 256 + col0;
#pragma unroll
                for (int bj = 0; bj < 2; ++bj)
#pragma unroll
                    for (int n = 0; n < 2; ++n) *(f32x4*)(rowp + bj * HALF + n * 16) = acc[ai][bj][m][n]; }
        return false;
    }
};
struct EpiS5Out {
    static constexpr bool PERM = true;
    const bf16_t* P; const float* dskip; bf16_t* GG;
    __device__ __forceinline__ bool operator()(Acc& acc, const Unit& u, int wr, int wc, int fr, int fq) const {
        const int row0 = u.pm * BM + wr * 64 + fr, col0 = u.pn * BM + wc * 32 + 8 * fq; const int g = u.z;
#pragma unroll
        for (int bj = 0; bj < 2; ++bj) { const int col = col0 + bj * HALF; const int t = col >> 4, c0 = col & 15;
            const f32x4 d0 = *(const f32x4*)(dskip + g * 16 + c0), d1 = *(const f32x4*)(dskip + g * 16 + c0 + 4);
            u32x4 uq[2][4];
#pragma unroll
            for (int ai = 0; ai < 2; ++ai)
#pragma unroll
                for (int m = 0; m < 4; ++m) uq[ai][m] = *(const u32x4*)(P + ((size_t)(row0 + ai * HALF + m * 16) * 32 + t) * LDP + S5_OFF + g * 16 + c0);
#pragma unroll
            for (int ai = 0; ai < 2; ++ai)
#pragma unroll
                for (int m = 0; m < 4; ++m) { const size_t tok = (size_t)(row0 + ai * HALF + m * 16) * 32 + t;
                    float uu[8]; unpack8(uq[ai][m], uu);
                    const f32x4 v0 = acc[ai][bj][m][0], v1 = acc[ai][bj][m][1];
                    float y[8] = {v0[0] + d0[0] * uu[0], v0[1] + d0[1] * uu[1], v0[2] + d0[2] * uu[2], v0[3] + d0[3] * uu[3], v1[0] + d1[0] * uu[4], v1[1] + d1[1] * uu[5], v1[2] + d1[2] * uu[6], v1[3] + d1[3] * uu[7]};
#pragma unroll
                    for (int j = 0; j < 8; ++j) y[j] = 0.5f * y[j] * (1.0f + tanhf(0.7978845608028654f * (y[j] + 0.044715f * y[j] * y[j] * y[j])));
                    u32x4 w; w.x = pk2(y[0], y[1]); w.y = pk2(y[2], y[3]); w.z = pk2(y[4], y[5]); w.w = pk2(y[6], y[7]);
                    *(u32x4*)(GG + tok * BW + g * 16 + c0) = w; } }
        return false;
    }
};
}


__device__ __forceinline__ float wave_scan_incl(float v, int lane) {
#pragma unroll
    for (int o = 1; o < 64; o <<= 1) { const float t = __shfl_up(v, o); if (lane >= o) v += t; }
    return v;
}
__device__ __forceinline__ float wave_scanmax_incl(float v, int lane) {
#pragma unroll
    for (int o = 1; o < 64; o <<= 1) { const float t = __shfl_up(v, o); if (lane >= o) v = fmaxf(v, t); }
    return v;
}
__device__ __forceinline__ float wave_max(float v) {
#pragma unroll
    for (int o = 32; o >= 1; o >>= 1) v = fmaxf(v, __shfl_xor(v, o));
    return v;
}
__device__ __forceinline__ void unpack8h(const u32x4 w, bf16_t (&h)[8]) {
    h[0] = (bf16_t)(w.x & 0xFFFFu); h[1] = (bf16_t)(w.x >> 16); h[2] = (bf16_t)(w.y & 0xFFFFu); h[3] = (bf16_t)(w.y >> 16);
    h[4] = (bf16_t)(w.z & 0xFFFFu); h[5] = (bf16_t)(w.z >> 16); h[6] = (bf16_t)(w.w & 0xFFFFu); h[7] = (bf16_t)(w.w >> 16);
}

__device__ __forceinline__ int tokblock_of(int b, int dir, int c) { if (c < 4) return 256 + b * 4 + (dir ? 3 - c : c); const int j = c - 4; return b * 64 + (dir ? 63 - j : j); }
__device__ __forceinline__ u32x4 rev8h(const u32x4 v) { u32x4 r; r.x = (v.w >> 16) | (v.w << 16); r.y = (v.z >> 16) | (v.z << 16); r.z = (v.y >> 16) | (v.y << 16); r.w = (v.x >> 16) | (v.x << 16); return r; }
__device__ __forceinline__ u32x4 scale8h(const u32x4 v, const float4 a, const float4 b) { float f[8]; unpack8(v, f); u32x4 r; r.x = pk2(f[0] * a.x, f[1] * a.y); r.y = pk2(f[2] * a.z, f[3] * a.w); r.z = pk2(f[4] * b.x, f[5] * b.y); r.w = pk2(f[6] * b.z, f[7] * b.w); return r; }
__device__ __forceinline__ float dot8h(const u32x4 v, const float4 a, const float4 b) { float f[8]; unpack8(v, f); return (f[0] * a.x + f[1] * a.y) + (f[2] * a.z + f[3] * a.w) + (f[4] * b.x + f[5] * b.y) + (f[6] * b.z + f[7] * b.w); }
#define ML_FRAG_LOAD(KF, VF, cc_) do { const int tb_ = tokblock_of(b, dir, (cc_)); const bf16_t* kb_ = KTg + ((size_t)tb_ * 512 + h * 128 + 32 * wd + r16) * 64 + q4 * 8; const bf16_t* vb_ = VTg + ((size_t)tb_ * 512 + h * 128 + 64 * half + 32 * we + r16) * 64 + q4 * 8; \
        _Pragma("unroll") for (int ks_ = 0; ks_ < 2; ++ks_) _Pragma("unroll") for (int j_ = 0; j_ < 2; ++j_) { VF[j_][ks_] = *(const u32x4*)(vb_ + (size_t)j_ * 16 * 64 + ks_ * 32); KF[j_][ks_] = *(const u32x4*)(kb_ + (size_t)j_ * 16 * 64 + ks_ * 32); } } while (0)
#define ML_CHUNK(c_, KF, VF, KFN, VFN) do { const int c = (c_); \
        if (c + 1 < 68) ML_FRAG_LOAD(KFN, VFN, c + 1);                        \
        const float dec = sDEC[c]; \
        {   bf16_t* cs = CST + (size_t)(chain * 68 + c) * 128 * 128; \
            _Pragma("unroll") for (int je = 0; je < 2; ++je) _Pragma("unroll") for (int jd = 0; jd < 2; ++jd) { const int e = 64 * half + 32 * we + 16 * je + r16, d0 = 32 * wd + 16 * jd + q4 * 4; \
                u32x2 pk; pk.x = pk2(acc[je][jd][0], acc[je][jd][1]); pk.y = pk2(acc[je][jd][2], acc[je][jd][3]); *(u32x2*)(cs + (size_t)e * 128 + d0) = pk; } \
            if (nown) { _Pragma("unroll") for (int jd = 0; jd < 2; ++jd) { float nv = npart[jd]; nv += __shfl_xor(nv, 16); nv += __shfl_xor(nv, 32); if (q4 == 0) NST[(size_t)(chain * 68 + c) * 128 + 32 * wd + 16 * jd + r16] = nv; } } } \
        bf16x8 vfr[2][2]; \
        _Pragma("unroll") for (int ks = 0; ks < 2; ++ks) { const float4 wa = *(const float4*)(sWS + c * 64 + ks * 32 + q4 * 8), wb = *(const float4*)(sWS + c * 64 + ks * 32 + q4 * 8 + 4); \
            _Pragma("unroll") for (int je = 0; je < 2; ++je) { const u32x4 sv = scale8h(VF[je][ks], wa, wb); vfr[je][ks] = *(const bf16x8*)&sv; } \
            if (nown) { _Pragma("unroll") for (int jd = 0; jd < 2; ++jd) npart[jd] = (ks == 0 ? dec * npart[jd] : npart[jd]) + dot8h(KF[jd][ks], wa, wb); } } \
        _Pragma("unroll") for (int je = 0; je < 2; ++je) _Pragma("unroll") for (int jd = 0; jd < 2; ++jd) acc[je][jd] = acc[je][jd] * dec; \
        _Pragma("unroll") for (int ks = 0; ks < 2; ++ks) _Pragma("unroll") for (int je = 0; je < 2; ++je) _Pragma("unroll") for (int jd = 0; jd < 2; ++jd) \
            acc[je][jd] = __builtin_amdgcn_mfma_f32_16x16x32_bf16(*(const bf16x8*)&KF[jd][ks], vfr[je][ks], acc[je][jd], 0, 0, 0); } while (0)
__device__ __forceinline__ void mlstm_state_pass(const int chain, const int half, const bf16_t* __restrict__ Pm, const bf16_t* __restrict__ KTg, const bf16_t* __restrict__ VTg, const float* __restrict__ gate_b,
                                                 bf16_t* __restrict__ CST, float* __restrict__ NST, float* __restrict__ MST, unsigned char* shm, const int tid) {
    const int dir = chain & 1, h = (chain >> 1) & 3, b = chain >> 3, lane = tid & 63, w = tid >> 6, we = w >> 2, wd = w & 3, q4 = lane >> 4, r16 = lane & 15;
    const bool nown = (half == 0) && (we == 0);
    float* sE = (float*)shm; float* sWS = sE + 68 * 64; float* sAL = sWS + 68 * 64; float* sBE = sAL + 68; float* sMO = sBE + 68; float* sDEC = sMO + 68; float* sMB = sDEC + 68;
    const float gbi = gate_b[(dir * 2 + 0) * 4 + h], gbf = gate_b[(dir * 2 + 1) * 4 + h];
    const int gcol_i = ML_OFF + 2048 + (dir * 2 + 0) * 4 + h, gcol_f = ML_OFF + 2048 + (dir * 2 + 1) * 4 + h;
    u32x4 kfA[2][2], vfA[2][2], kfB[2][2], vfB[2][2];
    ML_FRAG_LOAD(kfA, vfA, 0);
    __syncthreads();
    unsigned gi_[9], gf_[9];
#pragma unroll
    for (int q = 0; q < 9; ++q) { const int c = min(w + 8 * q, 67); const size_t tokl = (size_t)step_tok(b, dir, c * 64 + lane); gi_[q] = Pm[tokl * LDP + gcol_i]; gf_[q] = Pm[tokl * LDP + gcol_f]; }
#pragma unroll
    for (int q = 0; q < 9; ++q) { const int c = w + 8 * q; if (c >= 68) break;
        const float ig = __uint_as_float(gi_[q] << 16) + gbi, fg = __uint_as_float(gf_[q] << 16) + gbf;
        const float lf = fminf(fg, 0.f) - log1pf(expf(-fabsf(fg)));
        const float bcs = wave_scan_incl(lf, lane); const float blast = __shfl(bcs, 63); const float ei = blast - bcs + ig; const float beta = wave_max(ei);
        sE[c * 64 + lane] = ei; if (lane == 0) { sAL[c] = blast; sBE[c] = beta; } }
    __syncthreads();
    if (tid == 0) { float m = 0.f; for (int c = 0; c < 68; ++c) { sMB[c] = m; const float mo = fmaxf(m + sAL[c], sBE[c]); sDEC[c] = expf(sAL[c] + m - mo); sMO[c] = mo; m = mo; } }
    __syncthreads();
    for (int idx = tid; idx < 68 * 64; idx += NTHR) { const int c = idx >> 6, i = idx & 63; sWS[c * 64 + (dir ? 63 - i : i)] = expf(sE[idx] - sMO[c]); }
    if (half == 0 && tid < 68) MST[chain * 68 + tid] = sMB[tid];
    __syncthreads();
    f32x4 acc[2][2];
#pragma unroll
    for (int je = 0; je < 2; ++je)
#pragma unroll
        for (int jd = 0; jd < 2; ++jd) acc[je][jd] = (f32x4){0.f, 0.f, 0.f, 0.f};
    float npart[2] = {0.f, 0.f};
    for (int c2 = 0; c2 < 68; c2 += 2) { ML_CHUNK(c2, kfA, vfA, kfB, vfB); ML_CHUNK(c2 + 1, kfB, vfB, kfA, vfA); }
    __syncthreads();
}
#undef ML_CHUNK
#undef ML_FRAG_LOAD
__device__ __forceinline__ void mlstm_out_item(const int chain, const int c, const bf16_t* __restrict__ Pm, const bf16_t* __restrict__ QKb, const bf16_t* __restrict__ VTg, const float* __restrict__ gate_b,
                                               const bf16_t* __restrict__ CST, const float* __restrict__ NST, const float* __restrict__ MST, float* __restrict__ Hout, unsigned char* shm, const int tid) {
    const int dir = chain & 1, h = (chain >> 1) & 3, b = chain >> 3, lane = tid & 63, w = tid >> 6;
    bf16_t* Qs = (bf16_t*)shm; bf16_t* Ks = (bf16_t*)(shm + 17408); bf16_t* VT = (bf16_t*)(shm + 34816); bf16_t* Cs = (bf16_t*)(shm + 53248); bf16_t* Ss = (bf16_t*)(shm + 88064);
    float* sc = (float*)(shm + 97280);
    __syncthreads();
#pragma unroll
    for (int i = 0; i < 2; ++i) { const int pid = tid + i * 512; const int s = pid >> 4, x0 = (pid & 15) * 8; const size_t toks = (size_t)step_tok(b, dir, c * 64 + s);
        *(u32x4*)(Qs + s * 136 + x0) = *(const u32x4*)(QKb + toks * 1024 + h * 128 + x0);
        *(u32x4*)(Ks + s * 136 + x0) = *(const u32x4*)(QKb + toks * 1024 + 512 + h * 128 + x0);
        { const int e = pid >> 3, o = pid & 7;
          const u32x4 vv = *(const u32x4*)(VTg + ((size_t)tokblock_of(b, dir, c) * 512 + h * 128 + e) * 64 + (dir ? 7 - o : o) * 8);
          *(u32x4*)(VT + e * 72 + o * 8) = dir ? rev8h(vv) : vv; } }
#pragma unroll
    for (int i = 0; i < 4; ++i) { const int pid = tid + i * 512; const int e = pid >> 4, x0 = (pid & 15) * 8;
        *(u32x4*)(Cs + e * 136 + x0) = *(const u32x4*)(CST + ((size_t)(chain * 68 + c) * 128 + e) * 128 + x0); }
    if (tid < 128) sc[384 + tid] = NST[(size_t)(chain * 68 + c) * 128 + tid];
    if (w == 0) {
        const float gbi = gate_b[(dir * 2 + 0) * 4 + h], gbf = gate_b[(dir * 2 + 1) * 4 + h];
        const size_t tokl = (size_t)step_tok(b, dir, c * 64 + lane);
        const float ig = bf2f(Pm[tokl * LDP + ML_OFF + 2048 + (dir * 2 + 0) * 4 + h]) + gbi;
        const float fg = bf2f(Pm[tokl * LDP + ML_OFF + 2048 + (dir * 2 + 1) * 4 + h]) + gbf;
        const float lf = fminf(fg, 0.f) - log1pf(expf(-fabsf(fg)));
        const float bcs = wave_scan_incl(lf, lane); const float gsv = ig - bcs; const float pm = wave_scanmax_incl(gsv, lane);
        const float m_in = MST[chain * 68 + c]; const float mt = bcs + fmaxf(m_in, pm);
        sc[lane] = bcs; sc[64 + lane] = gsv; sc[128 + lane] = mt; sc[192 + lane] = expf(bcs + m_in - mt); sc[256 + lane] = expf(-mt);
    }
    __syncthreads();
    const int tt = w >> 1;
    {   f32x4 aS[2] = {(f32x4){0.f, 0.f, 0.f, 0.f}, (f32x4){0.f, 0.f, 0.f, 0.f}};
#pragma unroll
        for (int ks = 0; ks < 4; ++ks) { const bf16x8 af = *(const bf16x8*)(Qs + (16 * tt + (lane & 15)) * 136 + ks * 32 + (lane >> 4) * 8);
#pragma unroll
            for (int i = 0; i < 2; ++i) { const int st = (w & 1) * 2 + i; const bf16x8 bfr = *(const bf16x8*)(Ks + (16 * st + (lane & 15)) * 136 + ks * 32 + (lane >> 4) * 8);
                aS[i] = __builtin_amdgcn_mfma_f32_16x16x32_bf16(af, bfr, aS[i], 0, 0, 0); } }
        float rs[4] = {0.f, 0.f, 0.f, 0.f};
#pragma unroll
        for (int i = 0; i < 2; ++i) { const int s = 16 * ((w & 1) * 2 + i) + (lane & 15); const float gsv = sc[64 + s];
#pragma unroll
            for (int q = 0; q < 4; ++q) { const int t = 16 * tt + (lane >> 4) * 4 + q; const float val = (s <= t) ? aS[i][q] * expf(sc[t] + gsv - sc[128 + t]) : 0.f; Ss[t * 72 + s] = f2bf(val); rs[q] += val; } }
#pragma unroll
        for (int q = 0; q < 4; ++q) { float r = rs[q]; r += __shfl_xor(r, 1); r += __shfl_xor(r, 2); r += __shfl_xor(r, 4); r += __shfl_xor(r, 8);
            if ((lane & 15) == 0) sc[512 + (w & 1) * 64 + 16 * tt + (lane >> 4) * 4 + q] = r; }
        {   const int t = tid >> 3, part = tid & 7; float dot = 0.f;
#pragma unroll
            for (int j = 0; j < 16; ++j) dot += bf2f(Qs[t * 136 + part * 16 + j]) * sc[384 + part * 16 + j];
            dot += __shfl_xor(dot, 1); dot += __shfl_xor(dot, 2); dot += __shfl_xor(dot, 4);
            if (part == 0) sc[640 + t] = sc[192 + t] * dot; }
    }
    __syncthreads();
    {   f32x4 aN[4];
#pragma unroll
        for (int i = 0; i < 4; ++i) aN[i] = (f32x4){0.f, 0.f, 0.f, 0.f};
#pragma unroll
        for (int ks = 0; ks < 4; ++ks) { const bf16x8 af = *(const bf16x8*)(Qs + (16 * tt + (lane & 15)) * 136 + ks * 32 + (lane >> 4) * 8);
#pragma unroll
            for (int i = 0; i < 4; ++i) { const int et = (w & 1) * 4 + i; const bf16x8 bfr = *(const bf16x8*)(Cs + (16 * et + (lane & 15)) * 136 + ks * 32 + (lane >> 4) * 8);
                aN[i] = __builtin_amdgcn_mfma_f32_16x16x32_bf16(af, bfr, aN[i], 0, 0, 0); } }
#pragma unroll
        for (int q = 0; q < 4; ++q) { const float it = sc[192 + 16 * tt + (lane >> 4) * 4 + q];
#pragma unroll
            for (int i = 0; i < 4; ++i) aN[i][q] *= it; }
#pragma unroll
        for (int ks = 0; ks < 2; ++ks) { const bf16x8 af = *(const bf16x8*)(Ss + (16 * tt + (lane & 15)) * 72 + ks * 32 + (lane >> 4) * 8);
#pragma unroll
            for (int i = 0; i < 4; ++i) { const int et = (w & 1) * 4 + i; const bf16x8 bfr = *(const bf16x8*)(VT + (16 * et + (lane & 15)) * 72 + ks * 32 + (lane >> 4) * 8);
                aN[i] = __builtin_amdgcn_mfma_f32_16x16x32_bf16(af, bfr, aN[i], 0, 0, 0); } }
#pragma unroll
        for (int q = 0; q < 4; ++q) { const int t = 16 * tt + (lane >> 4) * 4 + q; const size_t tokt = (size_t)step_tok(b, dir, c * 64 + t); const float dn = fmaxf(fabsf((sc[512 + t] + sc[576 + t]) + sc[640 + t]), sc[256 + t]);
#pragma unroll
            for (int i = 0; i < 4; ++i) { const int e = 16 * ((w & 1) * 4 + i) + (lane & 15); Hout[tokt * BW + h * 128 + e] = aN[i][q] / dn; } }
    }
}


#define SD_FRAG_LOAD(BF, XF, cc_) do { const int tb_ = tokblock_of(b, dir, (cc_)); const bf16_t* bb_ = BTg + ((size_t)tb_ * 256 + grp * 128 + 64 * (w >> 2) + r16) * 64 + q4 * 8; const bf16_t* xb_ = XTg + ((size_t)tb_ * 512 + h * 64 + 16 * (w & 3) + r16) * 64 + q4 * 8; \
        _Pragma("unroll") for (int ks_ = 0; ks_ < 2; ++ks_) { XF[ks_] = *(const u32x4*)(xb_ + ks_ * 32); _Pragma("unroll") for (int j_ = 0; j_ < 4; ++j_) BF[j_][ks_] = *(const u32x4*)(bb_ + (size_t)j_ * 16 * 64 + ks_ * 32); } } while (0)
#define SD_CHUNK(c_, BF, XF, BFN, XFN) do { const int c = (c_); \
        if (c + 1 < 68) SD_FRAG_LOAD(BFN, XFN, c + 1); \
        const float dec = sDEC[c]; \
        {   bf16_t* ss = SSTb + (size_t)(chain * 68 + c) * 64 * 128; const int p = 16 * (w & 3) + r16; \
            _Pragma("unroll") for (int j = 0; j < 4; ++j) { const int n0 = 16 * ((w >> 2) * 4 + j) + q4 * 4; u32x2 pk; pk.x = pk2(acc[j][0], acc[j][1]); pk.y = pk2(acc[j][2], acc[j][3]); *(u32x2*)(ss + (size_t)p * 128 + n0) = pk; } } \
        bf16x8 xfr[2]; \
        _Pragma("unroll") for (int ks = 0; ks < 2; ++ks) { const float4 wa = *(const float4*)(sSC + c * 64 + ks * 32 + q4 * 8), wb = *(const float4*)(sSC + c * 64 + ks * 32 + q4 * 8 + 4); const u32x4 sv = scale8h(XF[ks], wa, wb); xfr[ks] = *(const bf16x8*)&sv; } \
        _Pragma("unroll") for (int j = 0; j < 4; ++j) acc[j] = acc[j] * dec; \
        _Pragma("unroll") for (int ks = 0; ks < 2; ++ks) _Pragma("unroll") for (int j = 0; j < 4; ++j) acc[j] = __builtin_amdgcn_mfma_f32_16x16x32_bf16(*(const bf16x8*)&BF[j][ks], xfr[ks], acc[j], 0, 0, 0); } while (0)
__device__ __forceinline__ void ssd_state_pass(const int chain, const bf16_t* __restrict__ Pm, const bf16_t* __restrict__ BTg, const bf16_t* __restrict__ XTg, const float Aa, const float dtb,
                                               bf16_t* __restrict__ SSTb, unsigned char* shm, const int tid) {
    const int dir = chain & 1, h = (chain >> 1) & 7, b = chain >> 4, grp = h >> 2, lane = tid & 63, w = tid >> 6, q4 = lane >> 4, r16 = lane & 15;
    float* sSC = (float*)shm; float* sDEC = sSC + 68 * 64;
    const int dcol = SSD_OFF + 1536 + dir * 8 + h;
    u32x4 bfA[4][2], xfA[2], bfB[4][2], xfB[2];
    SD_FRAG_LOAD(bfA, xfA, 0);
    __syncthreads();
    unsigned dt_[9];
#pragma unroll
    for (int q = 0; q < 9; ++q) { const int c = min(w + 8 * q, 67); dt_[q] = Pm[(size_t)step_tok(b, dir, c * 64 + lane) * LDP + dcol]; }
#pragma unroll
    for (int q = 0; q < 9; ++q) { const int c = w + 8 * q; if (c >= 68) break;
        const float xv = __uint_as_float(dt_[q] << 16) + dtb; const float dtv = xv > 20.f ? xv : log1pf(expf(xv));
        const float cs = wave_scan_incl(dtv * Aa, lane); const float cl = __shfl(cs, 63);
        sSC[c * 64 + (dir ? 63 - lane : lane)] = dtv * expf(cl - cs); if (lane == 0) sDEC[c] = expf(cl); }
    __syncthreads();
    f32x4 acc[4];
#pragma unroll
    for (int j = 0; j < 4; ++j) acc[j] = (f32x4){0.f, 0.f, 0.f, 0.f};
    for (int c2 = 0; c2 < 68; c2 += 2) { SD_CHUNK(c2, bfA, xfA, bfB, xfB); SD_CHUNK(c2 + 1, bfB, xfB, bfA, xfA); }
    __syncthreads();
}
#undef SD_CHUNK
#undef SD_FRAG_LOAD
__device__ __forceinline__ void ssd_out_item(const int chain, const int c, const bf16_t* __restrict__ Pm, const bf16_t* __restrict__ XBb, const bf16_t* __restrict__ XTg, const float Aa, const float dtb,
                                             const bf16_t* __restrict__ SSTb, float* __restrict__ Yout, unsigned char* shm, const int tid) {
    const int dir = chain & 1, h = (chain >> 1) & 7, b = chain >> 4, grp = h >> 2, lane = tid & 63, w = tid >> 6;
    bf16_t* Cs = (bf16_t*)shm; bf16_t* Bs = (bf16_t*)(shm + 17408); bf16_t* XT = (bf16_t*)(shm + 34816); bf16_t* Sin = (bf16_t*)(shm + 44032); bf16_t* Gs = (bf16_t*)(shm + 61440);
    float* sc = (float*)(shm + 70656);
    __syncthreads();
#pragma unroll
    for (int i = 0; i < 2; ++i) { const int pid = tid + i * 512; const int s = pid >> 4, x0 = (pid & 15) * 8; const size_t toks = (size_t)step_tok(b, dir, c * 64 + s);
        *(u32x4*)(Bs + s * 136 + x0) = *(const u32x4*)(XBb + toks * 1024 + 512 + grp * 128 + x0);
        *(u32x4*)(Cs + s * 136 + x0) = *(const u32x4*)(XBb + toks * 1024 + 768 + grp * 128 + x0);
        const int p = pid >> 4;
        *(u32x4*)(Sin + p * 136 + x0) = *(const u32x4*)(SSTb + ((size_t)(chain * 68 + c) * 64 + p) * 128 + x0); }
    {   const int p = tid >> 3, o = tid & 7;
        const u32x4 vv = *(const u32x4*)(XTg + ((size_t)tokblock_of(b, dir, c) * 512 + h * 64 + p) * 64 + (dir ? 7 - o : o) * 8);
        *(u32x4*)(XT + p * 72 + o * 8) = dir ? rev8h(vv) : vv; }
    if (w == 0) { const size_t tokl = (size_t)step_tok(b, dir, c * 64 + lane);
        const float xv = bf2f(Pm[tokl * LDP + SSD_OFF + 1536 + dir * 8 + h]) + dtb; const float dtv = xv > 20.f ? xv : log1pf(expf(xv));
        sc[lane] = wave_scan_incl(dtv * Aa, lane); sc[64 + lane] = dtv; }
    __syncthreads();
    {   const int lt = w >> 1;
        f32x4 aG[2] = {(f32x4){0.f, 0.f, 0.f, 0.f}, (f32x4){0.f, 0.f, 0.f, 0.f}};
#pragma unroll
        for (int ks = 0; ks < 4; ++ks) { const bf16x8 af = *(const bf16x8*)(Cs + (16 * lt + (lane & 15)) * 136 + ks * 32 + (lane >> 4) * 8);
#pragma unroll
            for (int i = 0; i < 2; ++i) { const int st = (w & 1) * 2 + i; const bf16x8 bfr = *(const bf16x8*)(Bs + (16 * st + (lane & 15)) * 136 + ks * 32 + (lane >> 4) * 8);
                aG[i] = __builtin_amdgcn_mfma_f32_16x16x32_bf16(af, bfr, aG[i], 0, 0, 0); } }
#pragma unroll
        for (int i = 0; i < 2; ++i) { const int s = 16 * ((w & 1) * 2 + i) + (lane & 15); const float css = sc[s], dts = sc[64 + s];
#pragma unroll
            for (int q = 0; q < 4; ++q) { const int t = 16 * lt + (lane >> 4) * 4 + q; const float val = (s <= t) ? aG[i][q] * expf(sc[t] - css) * dts : 0.f; Gs[t * 72 + s] = f2bf(val); } }
    }
    __syncthreads();
    {   const int lt = w >> 1;
        f32x4 aY[2] = {(f32x4){0.f, 0.f, 0.f, 0.f}, (f32x4){0.f, 0.f, 0.f, 0.f}};
#pragma unroll
        for (int ks = 0; ks < 4; ++ks) { const bf16x8 af = *(const bf16x8*)(Cs + (16 * lt + (lane & 15)) * 136 + ks * 32 + (lane >> 4) * 8);
#pragma unroll
            for (int i = 0; i < 2; ++i) { const int pt = (w & 1) * 2 + i; const bf16x8 bfr = *(const bf16x8*)(Sin + (16 * pt + (lane & 15)) * 136 + ks * 32 + (lane >> 4) * 8);
                aY[i] = __builtin_amdgcn_mfma_f32_16x16x32_bf16(af, bfr, aY[i], 0, 0, 0); } }
#pragma unroll
        for (int q = 0; q < 4; ++q) { const float ec = expf(sc[16 * lt + (lane >> 4) * 4 + q]); aY[0][q] *= ec; aY[1][q] *= ec; }
#pragma unroll
        for (int ks = 0; ks < 2; ++ks) { const bf16x8 af = *(const bf16x8*)(Gs + (16 * lt + (lane & 15)) * 72 + ks * 32 + (lane >> 4) * 8);
#pragma unroll
            for (int i = 0; i < 2; ++i) { const int pt = (w & 1) * 2 + i; const bf16x8 bfr = *(const bf16x8*)(XT + (16 * pt + (lane & 15)) * 72 + ks * 32 + (lane >> 4) * 8);
                aY[i] = __builtin_amdgcn_mfma_f32_16x16x32_bf16(af, bfr, aY[i], 0, 0, 0); } }
#pragma unroll
        for (int q = 0; q < 4; ++q) { const int t = 16 * lt + (lane >> 4) * 4 + q; const size_t tokt = (size_t)step_tok(b, dir, c * 64 + t);
#pragma unroll
            for (int i = 0; i < 2; ++i) { const int p = 16 * ((w & 1) * 2 + i) + (lane & 15); Yout[tokt * BW + h * 64 + p] = aY[i][q]; } }
    }
}


#define FIDX(i) ((i) + ((i) >> 4))
#define FFT_X_BYTES 69632
__device__ constexpr float FFT_CW_RE[6][16] = {{0.f, 0.f, 0.f, 0.f, 0.f, 0.f, 0.f, 0.f, 0.f, 0.f, 0.f, 0.f, 0.f, 0.f, 0.f, 0.f}, {1.0f, 0.f, 0.f, 0.f, 0.f, 0.f, 0.f, 0.f, 0.f, 0.f, 0.f, 0.f, 0.f, 0.f, 0.f, 0.f}, {1.0f, 6.123233995736766e-17f, 0.f, 0.f, 0.f, 0.f, 0.f, 0.f, 0.f, 0.f, 0.f, 0.f, 0.f, 0.f, 0.f, 0.f}, {1.0f, 0.7071067811865476f, 6.123233995736766e-17f, -0.7071067811865475f, 0.f, 0.f, 0.f, 0.f, 0.f, 0.f, 0.f, 0.f, 0.f, 0.f, 0.f, 0.f}, {1.0f, 0.9238795325112867f, 0.7071067811865476f, 0.38268343236508984f, 6.123233995736766e-17f, -0.3826834323650897f, -0.7071067811865475f, -0.9238795325112867f, 0.f, 0.f, 0.f, 0.f, 0.f, 0.f, 0.f, 0.f}, {1.0f, 0.9807852804032304f, 0.9238795325112867f, 0.8314696123025452f, 0.7071067811865476f, 0.5555702330196023f, 0.38268343236508984f, 0.19509032201612833f, 6.123233995736766e-17f, -0.1950903220161282f, -0.3826834323650897f, -0.555570233019602f, -0.7071067811865475f, -0.8314696123025453f, -0.9238795325112867f, -0.9807852804032304f}};
__device__ constexpr float FFT_CW_IM[6][16] = {{0.f, 0.f, 0.f, 0.f, 0.f, 0.f, 0.f, 0.f, 0.f, 0.f, 0.f, 0.f, 0.f, 0.f, 0.f, 0.f}, {-0.0f, 0.f, 0.f, 0.f, 0.f, 0.f, 0.f, 0.f, 0.f, 0.f, 0.f, 0.f, 0.f, 0.f, 0.f, 0.f}, {-0.0f, -1.0f, 0.f, 0.f, 0.f, 0.f, 0.f, 0.f, 0.f, 0.f, 0.f, 0.f, 0.f, 0.f, 0.f, 0.f}, {-0.0f, -0.7071067811865475f, -1.0f, -0.7071067811865476f, 0.f, 0.f, 0.f, 0.f, 0.f, 0.f, 0.f, 0.f, 0.f, 0.f, 0.f, 0.f}, {-0.0f, -0.3826834323650898f, -0.7071067811865475f, -0.9238795325112867f, -1.0f, -0.9238795325112867f, -0.7071067811865476f, -0.3826834323650899f, 0.f, 0.f, 0.f, 0.f, 0.f, 0.f, 0.f, 0.f}, {-0.0f, -0.19509032201612825f, -0.3826834323650898f, -0.5555702330196022f, -0.7071067811865475f, -0.8314696123025452f, -0.9238795325112867f, -0.9807852804032304f, -1.0f, -0.9807852804032304f, -0.9238795325112867f, -0.8314696123025455f, -0.7071067811865476f, -0.5555702330196022f, -0.3826834323650899f, -0.1950903220161286f}};
__host__ __device__ constexpr int fft_bitrev(int k, int R) { int r = 0; for (int i = 0; i < R; ++i) if (k & (1 << i)) r |= 1 << (R - 1 - i); return r; }
template <int R, bool INV>
__device__ __forceinline__ void fft_pass(float2* __restrict__ X, const float2* __restrict__ TW, const int s0, const int gidx) {
    const int lowbits = 13 - s0 - R; const int stride = 1 << lowbits;
    const int low = gidx & (stride - 1), high = gidx >> lowbits; const int base = (high << (lowbits + R)) | low;
    const int p0 = FIDX(base);
#define FFT_SLOT(k) (lowbits >= 4 ? p0 + (k) * (stride + (stride >> 4)) : p0 + (k) + ((k) >> 4))
    float2 v[1 << R];
#pragma unroll
    for (int k = 0; k < (1 << R); ++k) v[k] = X[FFT_SLOT(k)];
    const int lw = low << s0;
    if (!INV) {
#pragma unroll
        for (int j = 0; j < R; ++j) { const int hk = 1 << (R - 1 - j);
#pragma unroll
            for (int k = 0; k < (1 << R); ++k) if (!(k & hk)) { const int kk = k & (hk - 1);
                const float2 a = v[k], b = v[k + hk]; v[k] = make_float2(a.x + b.x, a.y + b.y); const float dx = a.x - b.x, dy = a.y - b.y;
                if (kk == 0) v[k + hk] = make_float2(dx, dy);
                else if (2 * kk == hk) v[k + hk] = make_float2(dy, -dx);
                else { const float cr = FFT_CW_RE[R - j][kk], ci = FFT_CW_IM[R - j][kk]; v[k + hk] = make_float2(dx * cr - dy * ci, dx * ci + dy * cr); } } }
        if (lowbits > 0) {
#pragma unroll
            for (int k = 1; k < (1 << R); ++k) { const float2 w = TW[(lw * fft_bitrev(k, R)) & 8191]; const float2 a = v[k]; v[k] = make_float2(a.x * w.x - a.y * w.y, a.x * w.y + a.y * w.x); } }
    } else {
        if (lowbits > 0) {
#pragma unroll
            for (int k = 1; k < (1 << R); ++k) { const float2 w = TW[(lw * fft_bitrev(k, R)) & 8191]; const float2 a = v[k]; v[k] = make_float2(a.x * w.x + a.y * w.y, a.y * w.x - a.x * w.y); } }
#pragma unroll
        for (int j = R - 1; j >= 0; --j) { const int hk = 1 << (R - 1 - j);
#pragma unroll
            for (int k = 0; k < (1 << R); ++k) if (!(k & hk)) { const int kk = k & (hk - 1);
                const float2 a = v[k], b = v[k + hk]; float tx, ty;
                if (kk == 0) { tx = b.x; ty = b.y; }
                else if (2 * kk == hk) { tx = -b.y; ty = b.x; }
                else { const float cr = FFT_CW_RE[R - j][kk], ci = FFT_CW_IM[R - j][kk]; tx = b.x * cr + b.y * ci; ty = b.y * cr - b.x * ci; }
                v[k] = make_float2(a.x + tx, a.y + ty); v[k + hk] = make_float2(a.x - tx, a.y - ty); } }
    }
#pragma unroll
    for (int k = 0; k < (1 << R); ++k) X[FFT_SLOT(k)] = v[k];
#undef FFT_SLOT
}
__device__ __forceinline__ void fft_fwd(float2* X, const float2* TW, const int tid) {
    fft_pass<4, false>(X, TW, 0, tid); __syncthreads(); fft_pass<4, false>(X, TW, 4, tid); __syncthreads(); if (tid < 256) fft_pass<5, false>(X, TW, 8, tid); __syncthreads(); }
__device__ __forceinline__ void fft_inv(float2* X, const float2* TW, const int tid) {
    if (tid < 256) fft_pass<5, true>(X, TW, 8, tid); __syncthreads(); fft_pass<4, true>(X, TW, 4, tid); __syncthreads(); fft_pass<4, true>(X, TW, 0, tid); __syncthreads(); }
__device__ __forceinline__ void fft_twiddles(float2* TW, const int tid) {
#pragma unroll
    for (int k = 0; k < 16; ++k) { const int m = tid + k * 512; const float xx = (float)m * (1.0f / 4096.0f); TW[m] = make_float2(cospif(xx), -sinpif(xx)); }
}
__device__ __forceinline__ void hyena_spec_item(const int oc, const float* __restrict__ HR, const float* __restrict__ nrm, float2* __restrict__ HSPEC, unsigned char* shm, const int tid) {
    float2* X = (float2*)shm; const float2* TW = (const float2*)(shm + FFT_X_BYTES);
    const int o = oc >> 9, c = oc & 511; const float inv = 1.0f / nrm[oc];
    __syncthreads();
    float hv[16];
#pragma unroll
    for (int k = 0; k < 16; ++k) { const int j = tid + k * 512;
        const unsigned off = j < SEQ ? (unsigned)j * 2048u + o * 1024 + c : j == SEQ ? (unsigned)(o * 1024 + c) : (unsigned)(2 * SEQ - j) * 2048u + o * 1024 + 512 + c;
        hv[k] = HR[off]; }
#pragma unroll
    for (int k = 0; k < 16; ++k) { const int j = tid + k * 512; X[FIDX(j)] = make_float2(j == SEQ ? 0.f : hv[k] * inv, 0.f); }
    __syncthreads();
    fft_fwd(X, TW, tid);
    float4* out = (float4*)(HSPEC + (size_t)oc * 8192 + tid * 16); const float2* xs = X + 17 * tid;
#pragma unroll
    for (int k = 0; k < 8; ++k) { const float2 x0 = xs[2 * k], x1 = xs[2 * k + 1]; out[k] = make_float4(x0.x * (1.0f / 8192.0f), x0.y * (1.0f / 8192.0f), x1.x * (1.0f / 8192.0f), x1.y * (1.0f / 8192.0f)); }
}
__device__ __forceinline__ void fft_mul_spec(float2* X, const float2* __restrict__ H, const int tid) {
    const float4* h4 = (const float4*)(H + tid * 16); float2* xs = X + 17 * tid;
#pragma unroll
    for (int k = 0; k < 8; ++k) { const float4 hv = h4[k]; const float2 x0 = xs[2 * k], x1 = xs[2 * k + 1];
        xs[2 * k] = make_float2(x0.x * hv.x - x0.y * hv.y, x0.x * hv.y + x0.y * hv.x); xs[2 * k + 1] = make_float2(x1.x * hv.z - x1.y * hv.w, x1.x * hv.w + x1.y * hv.z); }
}
__device__ __forceinline__ void hyena_fft_item(const int item, const float* __restrict__ UT, const float2* __restrict__ HSPEC, const float* __restrict__ bias, float* __restrict__ YT, unsigned char* shm, const int tid) {
    float2* X = (float2*)shm; const float2* TW = (const float2*)(shm + FFT_X_BYTES);
    const int c = item >> 1, b0 = (item & 1) * 2, b1 = b0 + 1;
    const float* u0 = UT + (size_t)(b0 * 1536 + c) * SEQ + tid * 8; const float* u1 = UT + (size_t)(b1 * 1536 + c) * SEQ + tid * 8;
    const float bias0 = bias[c], bias1 = bias[512 + c];
    float2* xs = X + FIDX(8 * tid);
    float vr[8], vi[8];
    __syncthreads();
    { const float4 a0 = *(const float4*)u0, a1 = *(const float4*)(u0 + 4), c0 = *(const float4*)u1, c1 = *(const float4*)(u1 + 4);
      vr[0] = a0.x; vr[1] = a0.y; vr[2] = a0.z; vr[3] = a0.w; vr[4] = a1.x; vr[5] = a1.y; vr[6] = a1.z; vr[7] = a1.w;
      vi[0] = c0.x; vi[1] = c0.y; vi[2] = c0.z; vi[3] = c0.w; vi[4] = c1.x; vi[5] = c1.y; vi[6] = c1.z; vi[7] = c1.w; }
#pragma unroll
    for (int k = 0; k < 8; ++k) { xs[k] = make_float2(vr[k], vi[k]); xs[4352 + k] = make_float2(0.f, 0.f); }
    __syncthreads();
    fft_fwd(X, TW, tid);
    fft_mul_spec(X, HSPEC + (size_t)c * 8192, tid);
    __syncthreads();
    fft_inv(X, TW, tid);
    { const float* p0 = u0 + (size_t)512 * SEQ; const float* p1 = u1 + (size_t)512 * SEQ;
      const float4 a0 = *(const float4*)p0, a1 = *(const float4*)(p0 + 4), c0 = *(const float4*)p1, c1 = *(const float4*)(p1 + 4);
      const float xr[8] = {a0.x, a0.y, a0.z, a0.w, a1.x, a1.y, a1.z, a1.w}, xi[8] = {c0.x, c0.y, c0.z, c0.w, c1.x, c1.y, c1.z, c1.w};
#pragma unroll
      for (int k = 0; k < 8; ++k) { const float2 cv = xs[k]; const float zr = xr[k] * (cv.x + bias0 * vr[k]), zi = xi[k] * (cv.y + bias0 * vi[k]);
          vr[k] = zr; vi[k] = zi; xs[k] = make_float2(zr, zi); xs[4352 + k] = make_float2(0.f, 0.f); } }
    __syncthreads();
    fft_fwd(X, TW, tid);
    fft_mul_spec(X, HSPEC + (size_t)(512 + c) * 8192, tid);
    __syncthreads();
    fft_inv(X, TW, tid);
    { const float* p0 = u0 + (size_t)1024 * SEQ; const float* p1 = u1 + (size_t)1024 * SEQ;
      const float4 a0 = *(const float4*)p0, a1 = *(const float4*)(p0 + 4), c0 = *(const float4*)p1, c1 = *(const float4*)(p1 + 4);
      const float xr[8] = {a0.x, a0.y, a0.z, a0.w, a1.x, a1.y, a1.z, a1.w}, xi[8] = {c0.x, c0.y, c0.z, c0.w, c1.x, c1.y, c1.z, c1.w};
      float yr[8], yi[8];
#pragma unroll
      for (int k = 0; k < 8; ++k) { const float2 cv = xs[k]; yr[k] = xr[k] * (cv.x + bias1 * vr[k]); yi[k] = xi[k] * (cv.y + bias1 * vi[k]); }
      float* y0 = YT + (size_t)(b0 * 512 + c) * SEQ + tid * 8; float* y1 = YT + (size_t)(b1 * 512 + c) * SEQ + tid * 8;
      *(float4*)y0 = make_float4(yr[0], yr[1], yr[2], yr[3]); *(float4*)(y0 + 4) = make_float4(yr[4], yr[5], yr[6], yr[7]);
      *(float4*)y1 = make_float4(yi[0], yi[1], yi[2], yi[3]); *(float4*)(y1 + 4) = make_float4(yi[4], yi[5], yi[6], yi[7]); }
}

constexpr size_t al256(size_t x) { return (x + 255) & ~(size_t)255; }
constexpr size_t O_BAR = 0;
constexpr size_t O_MOD = 16384;
constexpr size_t O_NORM = O_MOD + al256((size_t)2 * 5 * 6 * DM * 4);
constexpr size_t O_QCTR = O_NORM + al256((size_t)2 * 2 * 1024 * 4);
constexpr size_t O_ZERO_END = O_QCTR + 512;
constexpr size_t O_XS = O_ZERO_END;
constexpr size_t O_HB = O_XS + al256((size_t)NTOK * DM * 4);
constexpr size_t O_P = O_HB + al256((size_t)NTOK * DM * 2);
constexpr size_t O_WIN = O_P + al256((size_t)NTOK * LDP * 2);
constexpr size_t O_WBR = O_WIN + al256((size_t)LDP * DM * 2);
constexpr size_t O_WOUT = O_WBR + al256((size_t)4 * DM * BW * 2);
constexpr size_t O_WGU = O_WOUT + al256((size_t)DM * DM * 2);
constexpr size_t O_WD = O_WGU + al256((size_t)NEXP * 2 * DEXP * DM * 2);
constexpr size_t O_GLU = O_WD + al256((size_t)NEXP * DM * DEXP * 2);
constexpr size_t O_Y4 = O_GLU + al256((size_t)BW * BW * 2);
constexpr size_t O_U = O_Y4 + al256((size_t)NTOK * DM * 2);
constexpr size_t O_QKB = O_U + al256((size_t)NTOK * 1536 * 4);
constexpr size_t O_CST = O_QKB + al256((size_t)NTOK * 1024 * 2);
constexpr size_t O_NST = O_CST + al256((size_t)32 * 68 * 128 * 128 * 2);
constexpr size_t O_MST = O_NST + al256((size_t)32 * 68 * 128 * 4);
constexpr size_t O_XBC = O_MST + al256((size_t)32 * 68 * 4);
constexpr size_t O_SST = O_XBC + al256((size_t)NTOK * 1024 * 2);
constexpr size_t O_HF = O_SST + al256((size_t)64 * 68 * 64 * 128 * 2);
constexpr size_t O_YF = O_HF + al256((size_t)2 * NTOK * BW * 4);
constexpr size_t O_SF = O_YF + al256((size_t)2 * NTOK * BW * 4);
constexpr size_t O_LDT = O_SF + al256((size_t)2 * NCTX * BW * 4);
constexpr size_t O_AP = O_LDT + al256((size_t)4096 * 16);
constexpr size_t O_BBT = O_AP + al256((size_t)4096 * 33 * 8);
constexpr size_t O_KT = O_BBT + al256((size_t)4096 * 16 * 8);
constexpr size_t O_S5A = O_KT + al256((size_t)32 * 2 * 32 * 256 * 4);
constexpr size_t O_S5B = O_S5A + al256((size_t)32 * 512 * 768 * 2);
constexpr size_t O_XCTX = O_S5B + al256((size_t)32 * 512 * 768 * 2);
constexpr size_t O_Z = O_XCTX + al256((size_t)4 * 32 * 2 * 64 * 8);
constexpr size_t O_HRAW = O_Z + al256((size_t)NTOK * BW * 4);
constexpr size_t O_HSPEC = O_HRAW + al256((size_t)(SEQ + CTXL) * 2048 * 4);
constexpr size_t O_K2C = O_HSPEC + al256((size_t)1024 * 8192 * 8);
constexpr size_t O_GG = O_K2C + al256((size_t)(2 * CTXL) * 1024 * 4);
constexpr size_t O_PROBS = O_GG + al256((size_t)NTOK * BW * 2);
constexpr size_t O_ROWTOK = O_PROBS + al256((size_t)NTOK * 16 * 4);
constexpr size_t O_ROWGATE = O_ROWTOK + al256((size_t)NEXP * MOE_PAD * 4);
constexpr size_t O_INV = O_ROWGATE + al256((size_t)NEXP * MOE_PAD * 4);
constexpr size_t O_NORMP = O_INV + al256((size_t)NTOK * 16 * 4);
constexpr size_t WS_END = O_NORMP + al256((size_t)4 * 256 * 2048 * 4);
constexpr size_t O_XG = O_P;
constexpr size_t O_HID = O_P + al256((size_t)NEXP * MOE_PAD * DM * 2);
constexpr size_t O_YEXP = O_HID + al256((size_t)NEXP * MOE_PAD * DEXP * 2);
static_assert(O_YEXP + (size_t)NEXP * MOE_PAD * DM * 2 <= O_WIN, "MoE temporaries must fit inside P");
static_assert((size_t)NTOK * DM * 2 <= (size_t)NTOK * 1536 * 4, "ACCb must fit inside U");
static_assert((size_t)26214400 + (size_t)2 * 17825792 + (size_t)272 * 256 * 64 * 2 <= (size_t)NTOK * DM * 2, "strip buffers must fit inside HB");
static_assert(WS_END <= (size_t)1851000000, "workspace map exceeds the guaranteed size");

struct Args {
    const float* in[47];
    float* out; unsigned char* ws;
    int ph_lo, ph_hi;
};

__device__ __forceinline__ void conv_tile(const float* __restrict__ src, int ldsrc, int nvalid, int k0, int n0, bf16_t* __restrict__ dst, int lddst, int mode, float* T, int tid) {
    { const int n = tid & 63, kr = tid >> 6;
#pragma unroll
      for (int i = 0; i < 8; ++i) { const int k = i * 8 + kr; T[k * 65 + n] = (n0 + n < nvalid) ? src[(size_t)(k0 + k) * ldsrc + n0 + n] : 0.f; } }
    __syncthreads();
    { const int n = tid >> 3, kc = (tid & 7) * 8; const int gn = n0 + n;
      const int drow = mode == 0 ? gn : (32 * (gn >> 4) + (mode == 2 ? 16 : 0) + (gn & 15));
      u32x4 w; w.x = pk2(T[(kc + 0) * 65 + n], T[(kc + 1) * 65 + n]); w.y = pk2(T[(kc + 2) * 65 + n], T[(kc + 3) * 65 + n]);
      w.z = pk2(T[(kc + 4) * 65 + n], T[(kc + 5) * 65 + n]); w.w = pk2(T[(kc + 6) * 65 + n], T[(kc + 7) * 65 + n]);
      *(u32x4*)(dst + (size_t)drow * lddst + k0 + kc) = w; }
    __syncthreads();
}

#define IN(id) (lo <= (id) && (id) < hi)
#define SEAM(id) do { if (hi > (id) + 1) xcd_barrier(bar); } while (0)
#define PH_BEGIN int tid = threadIdx.x; asm volatile("" : "+v"(tid) :: "memory"); const int lane = tid & 63, wave = tid >> 6; (void)lane; (void)wave;

#define x_in (PT(0))
#define c_in (PT(1))
#define ctx_in (PT(2))
#define cctx_in (PT(3))
#define ada_w (PT(4))
#define ada_b (PT(5))
#define norm_mix (PT(6))
#define norm_ffn (PT(7))
#define w_in (PT(8))
#define XS ((float*)(a.ws + O_XS))
#define MOD ((float*)(a.ws + O_MOD))
#define NORM ((float*)(a.ws + O_NORM))
#define NORMP ((float*)(a.ws + O_NORMP))
#define MODl (MOD + (size_t)l * 5 * 6 * DM)
#define HB ((bf16_t*)(a.ws + O_HB))
#define P ((bf16_t*)(a.ws + O_P))
#define WIN ((bf16_t*)(a.ws + O_WIN))
#define WBR ((bf16_t*)(a.ws + O_WBR))
#define WOUT ((bf16_t*)(a.ws + O_WOUT))
#define WGU ((bf16_t*)(a.ws + O_WGU))
#define WD ((bf16_t*)(a.ws + O_WD))
#define GLU ((bf16_t*)(a.ws + O_GLU))
#define Y4 ((bf16_t*)(a.ws + O_Y4))
#define U ((float*)(a.ws + O_U))
#define ACCb ((bf16_t*)(a.ws + O_U))
#define QKB ((bf16_t*)(a.ws + O_QKB))
#define CST ((bf16_t*)(a.ws + O_CST))
#define NST ((float*)(a.ws + O_NST))
#define MST ((float*)(a.ws + O_MST))
#define XBC ((bf16_t*)(a.ws + O_XBC))
#define SSTB ((bf16_t*)(a.ws + O_SST))
#define HF ((float*)(a.ws + O_HF))
#define HBk (HF + (size_t)NTOK * BW)
#define YF ((float*)(a.ws + O_YF))
#define YB (YF + (size_t)NTOK * BW)
#define SF ((float*)(a.ws + O_SF))
#define SB (SF + (size_t)NCTX * BW)
#define LDT ((double2*)(a.ws + O_LDT))
#define APW ((float2*)(a.ws + O_AP))
#define BBT ((float2*)(a.ws + O_BBT))
#define KTB ((float*)(a.ws + O_KT))
#define S5A ((bf16_t*)(a.ws + O_S5A))
#define S5B ((bf16_t*)(a.ws + O_S5B))
#define XCTX ((float2*)(a.ws + O_XCTX))
#define S5P ((bf16_t*)(a.ws + O_HB))
#define XLOC ((float*)(a.ws + O_HB + (size_t)32 * 256 * 512 * 2))
#define KTG ((bf16_t*)(a.ws + O_HB + (size_t)26214400))
#define VTG ((bf16_t*)(a.ws + O_HB + (size_t)26214400 + (size_t)17825792))
#define BTG ((bf16_t*)(a.ws + O_HB + (size_t)26214400 + (size_t)2 * 17825792))
#define XTG ((bf16_t*)(a.ws + O_GG))
#define Z ((float*)(a.ws + O_Z))
#define HRAW ((float*)(a.ws + O_HRAW))
#define HSPEC ((float2*)(a.ws + O_HSPEC))
#define UT ((float*)(a.ws + O_U))
#define YT ((float*)(a.ws + O_Z))
#define QCTR ((int*)(a.ws + O_QCTR))
#define K2C ((float*)(a.ws + O_K2C))
#define GG ((bf16_t*)(a.ws + O_GG))
#define PROBS ((float*)(a.ws + O_PROBS))
#define ROWTOK ((int*)(a.ws + O_ROWTOK))
#define ROWGATE ((float*)(a.ws + O_ROWGATE))
#define XG ((bf16_t*)(a.ws + O_XG))
#define HID ((bf16_t*)(a.ws + O_HID))
#define YEXP ((bf16_t*)(a.ws + O_YEXP))
#define INV ((int*)(a.ws + O_INV))


__device__ __forceinline__ void moe_pair(float4 (&a)[8], const int r1, const int r2, const float g2scale, const int lane, const float* __restrict__ rowgate, const bf16_t* __restrict__ yexp) {
    const float gt1 = rowgate[r1], gt2 = rowgate[r2] * g2scale;
    const bf16_t* y1 = yexp + (size_t)r1 * DM + lane * 4; const bf16_t* y2 = yexp + (size_t)r2 * DM + lane * 4;
    u32x2 w1[8], w2[8];
#pragma unroll
    for (int i = 0; i < 8; ++i) { w1[i] = *(const u32x2*)(y1 + i * 256); w2[i] = *(const u32x2*)(y2 + i * 256); }
#pragma unroll
    for (int i = 0; i < 8; ++i) {
        a[i].x += gt1 * __uint_as_float(w1[i].x << 16); a[i].y += gt1 * __uint_as_float(w1[i].x & 0xFFFF0000u); a[i].z += gt1 * __uint_as_float(w1[i].y << 16); a[i].w += gt1 * __uint_as_float(w1[i].y & 0xFFFF0000u);
        a[i].x += gt2 * __uint_as_float(w2[i].x << 16); a[i].y += gt2 * __uint_as_float(w2[i].x & 0xFFFF0000u); a[i].z += gt2 * __uint_as_float(w2[i].y << 16); a[i].w += gt2 * __uint_as_float(w2[i].y & 0xFFFF0000u); }
}
__device__ __forceinline__ void moe_combine(float4 (&v)[8], const int tok, const int lane, const int* __restrict__ inv, const float* __restrict__ rowgate, const bf16_t* __restrict__ yexp, const float* __restrict__ m5) {
    float4 a[8], mm[8];
#pragma unroll
    for (int i = 0; i < 8; ++i) { a[i] = make_float4(0.f, 0.f, 0.f, 0.f); mm[i] = *(const float4*)(m5 + i * 256 + lane * 4); }
    const int4* ip = (const int4*)(inv + (size_t)tok * 16);
    const int4 q0 = ip[0], q1 = ip[1], q2 = ip[2], q3 = ip[3];
    const int rows[16] = {q0.x, q0.y, q0.z, q0.w, q1.x, q1.y, q1.z, q1.w, q2.x, q2.y, q2.z, q2.w, q3.x, q3.y, q3.z, q3.w};
    int prow = -1;
#pragma unroll
    for (int e = 0; e < 16; ++e) { const int row = __builtin_amdgcn_readfirstlane(rows[e]);
        if (row >= 0) { if (prow >= 0) { moe_pair(a, prow, row, 1.0f, lane, rowgate, yexp); prow = -1; } else prow = row; } }
    if (prow >= 0) moe_pair(a, prow, prow, 0.0f, lane, rowgate, yexp);
#pragma unroll
    for (int i = 0; i < 8; ++i) { v[i].x += mm[i].x * a[i].x; v[i].y += mm[i].y * a[i].y; v[i].z += mm[i].z * a[i].z; v[i].w += mm[i].w * a[i].w; }
}
struct CvU { const float* src; bf16_t* dst; int ldsrc, nvalid, k0, n0, lddst, mode; };
__device__ __forceinline__ void cv_load(const CvU& u, float4 (&r)[8], const int tid) {
#pragma unroll
    for (int i = 0; i < 8; ++i) { const int idx = tid + i * 512; const int k = idx >> 6, n = u.n0 + (idx & 63) * 4;
        r[i] = (n < u.nvalid) ? *(const float4*)(u.src + (size_t)(u.k0 + k) * u.ldsrc + n) : make_float4(0.f, 0.f, 0.f, 0.f); }
}
__device__ __forceinline__ void cv_stage(float* T, const float4 (&r)[8], const int tid) {
#pragma unroll
    for (int i = 0; i < 8; ++i) { const int idx = tid + i * 512; float* p = T + (idx >> 6) * 257 + (idx & 63) * 4; p[0] = r[i].x; p[1] = r[i].y; p[2] = r[i].z; p[3] = r[i].w; }
}
__device__ __forceinline__ void cv_store(const CvU& u, const float* T, const int tid) {
#pragma unroll
    for (int j = 0; j < 4; ++j) { const int o = tid + j * 512; const int kc = (o & 7) * 8, n = o >> 3; const int gn = u.n0 + n;
        const int drow = u.mode == 0 ? gn : (256 * (gn >> 7) + (u.mode == 2 ? 128 : 0) + (gn & 127));
        const float* t = T + kc * 257 + n;
        u32x4 w; w.x = pk2(t[0], t[257]); w.y = pk2(t[2 * 257], t[3 * 257]); w.z = pk2(t[4 * 257], t[5 * 257]); w.w = pk2(t[6 * 257], t[7 * 257]);
        *(u32x4*)(u.dst + (size_t)drow * u.lddst + u.k0 + kc) = w; }
}
#define CV_RUN(LL, QSTART, QSTEP, QEND) do { \
                const float* wbr = PT(40) + (size_t)(LL) * 4 * BW * DM; const float* wout = PT(41) + (size_t)(LL) * DM * DM; \
                const float* wg = PT(43) + (size_t)(LL) * NEXP * DM * DEXP; const float* wu = PT(44) + (size_t)(LL) * NEXP * DM * DEXP; const float* wd = PT(45) + (size_t)(LL) * NEXP * DEXP * DM; \
                const float* wglu = PT(32) + (size_t)(LL) * BW * BW; const float* win = w_in + (size_t)(LL) * DM * IN_W; \
                const int cv_step = (QSTEP), cv_end = (QEND); \
                __syncthreads(); \
                int q = (QSTART); int buf = 0; CvU u; float4 r[8]; \
                if (q < cv_end) { CV_DECODE(q, u); cv_load(u, r, tid); } \
                while (q < cv_end) { \
                    float* T = sf + buf * (64 * 257); \
                    cv_stage(T, r, tid); \
                    __syncthreads(); \
                    const CvU cur = u; const int qn = q + cv_step; \
                    if (qn < cv_end) { CV_DECODE(qn, u); cv_load(u, r, tid); } \
                    cv_store(cur, T, tid); \
                    buf ^= 1; q = qn; \
                } \
                __syncthreads(); } while (0)
#define CV_DECODE(q_, u_) do { int qq_ = (q_); \
                    if (qq_ < n_win) { u_ = CvU{win, WIN, IN_W, IN_W, (qq_ / 55) * 64, (qq_ % 55) * 256, DM, 0}; } else { qq_ -= n_win; \
                    if (qq_ < n_br) { const int k = qq_ >> 6, r = qq_ & 63; u_ = CvU{wbr + (size_t)k * BW * DM, WBR + (size_t)k * DM * BW, DM, DM, (r >> 3) * 64, (r & 7) * 256, BW, 0}; } else { qq_ -= n_br; \
                    if (qq_ < n_out) { u_ = CvU{wout, WOUT, DM, DM, (qq_ >> 3) * 64, (qq_ & 7) * 256, DM, 0}; } else { qq_ -= n_out; \
                    if (qq_ < n_glu) { u_ = CvU{wglu, GLU, BW, BW, (qq_ >> 1) * 64, (qq_ & 1) * 256, BW, 0}; } else { qq_ -= n_glu; \
                    if (qq_ < n_gu) { const int e = qq_ / 384, r = qq_ % 384, up = r / 192, r2 = r % 192; u_ = CvU{(up ? wu : wg) + (size_t)e * DM * DEXP, WGU + (size_t)e * 2 * DEXP * DM, DEXP, DEXP, (r2 / 6) * 64, (r2 % 6) * 256, DM, 1 + up}; } else { qq_ -= n_gu; \
                    { const int e = qq_ / 192, r = qq_ % 192; u_ = CvU{wd + (size_t)e * DEXP * DM, WD + (size_t)e * DM * DEXP, DM, DM, (r >> 3) * 64, (r & 7) * 256, DEXP, 0}; } } } } } } } while (0)
template <int LAYER>
__device__ __forceinline__ void layer_body(const Args& a, const XcdBarrier& bar, const int lo, const int hi, const int bid, const int G, unsigned char* const shm, float* const sf, const float** const ptab) {
        constexpr int l = LAYER;
        constexpr int PB = 1 + 16 * l;
        const bool lastl = (l == 1);

        const int nPanels = lastl ? 64 : 68;
        const int M2 = nPanels * 256;

        if (IN(PB + 0)) for (int rep_ = 0; rep_ < (l == 0 ? PROBE_REPS(0) : 1); ++rep_) {
            PH_BEGIN
            {   const int n_win = 32 * 55, n_br = 4 * 64, n_out = 32 * 8, n_glu = 16, n_gu = 16 * 2 * 192, n_d = 16 * 192;
                const int n_grp1 = n_win + n_br + n_out + n_glu, total = n_grp1 + n_gu + n_d;
                const int q_lo = (l > 0 && G > 128) ? n_win : 0;
                CV_RUN(l, q_lo + bid, G, total);
            }
            for (int set = 0; set < (lastl ? 1 : 2); ++set) {
                const int L = set ? CTXL : SEQ; float* HR = HRAW + (set ? (size_t)SEQ * 2048 : 0);
                const float* w1 = PT(11) + l * 33 * 64; const float* b1 = PT(12) + l * 64; const float* fr1 = PT(13) + l * 64; const float* w2 = PT(14) + l * 64 * 64; const float* b2 = PT(15) + l * 64;
                const float* fr2 = PT(16) + l * 64; const float* w3 = PT(17) + l * 64 * 2048; const float* decay = PT(18) + l * 2048;
                float* feats = sf; float* h1 = sf + 16 * 33; float* h2 = h1 + 16 * 64;
                float nacc[4] = {0.f, 0.f, 0.f, 0.f};
                for (int base = bid; base < L; base += 16 * G) {
                    __syncthreads();
                    for (int e = tid; e < 16 * 33; e += NTHR) { const int ti = e / 33, fi = e % 33; int t = base + ti * G; if (t > L - 1) t = L - 1;
                        float v;
                        if (fi == 0) v = (float)t / (float)(L - 1);
                        else { const int j = (fi - 1) & 15; const double fr = 1e-4 + (double)j * ((15.0 - 1e-4) / 15.0); const double ang = (2.0 * 3.14159265358979323846 / (double)L) * (double)t * fr; v = fi <= 16 ? (float)cos(ang) : (float)(-sin(ang)); }
                        feats[e] = v; }
                    __syncthreads();
                    { const int j = tid & 63, ti = tid >> 6; float s0 = b1[j], s1 = s0;
_Pragma("unroll 3")
                      for (int i = 0; i < 33; ++i) { const float wv = w1[i * 64 + j]; s0 += feats[ti * 33 + i] * wv; s1 += feats[(ti + 8) * 33 + i] * wv; }
                      const float f1 = fr1[j]; h1[ti * 64 + j] = sinf(f1 * s0); h1[(ti + 8) * 64 + j] = sinf(f1 * s1); }
                    __syncthreads();
                    { const int j = tid & 63, ti = tid >> 6; float s0 = b2[j], s1 = s0;
_Pragma("unroll 4")
                      for (int i = 0; i < 64; ++i) { const float wv = w2[i * 64 + j]; s0 += h1[ti * 64 + i] * wv; s1 += h1[(ti + 8) * 64 + i] * wv; }
                      const float f2 = fr2[j]; h2[ti * 64 + j] = sinf(f2 * s0); h2[(ti + 8) * 64 + j] = sinf(f2 * s1); }
                    __syncthreads();
                    float acc[16][4];
#pragma unroll
                    for (int ti = 0; ti < 16; ++ti) { acc[ti][0] = 0.f; acc[ti][1] = 0.f; acc[ti][2] = 0.f; acc[ti][3] = 0.f; }
#pragma unroll 2
                    for (int i = 0; i < 64; ++i) { const float* wrow = w3 + (size_t)i * 2048 + tid; const float wa = wrow[0], wb = wrow[512], wc2 = wrow[1024], wd2 = wrow[1536];
#pragma unroll
                        for (int ti = 0; ti < 16; ++ti) { const float hv = h2[ti * 64 + i]; acc[ti][0] += hv * wa; acc[ti][1] += hv * wb; acc[ti][2] += hv * wc2; acc[ti][3] += hv * wd2; } }
                    float dk[4];
#pragma unroll
                    for (int k = 0; k < 4; ++k) dk[k] = fabsf(decay[tid + k * 512]);
#pragma unroll
                    for (int ti = 0; ti < 16; ++ti) { const int t = base + ti * G; if (t < L) { const float tn = (float)t / (float)(L - 1);
#pragma unroll
                        for (int k = 0; k < 4; ++k) { const float v = acc[ti][k] * expf(-tn * dk[k]); HR[(size_t)t * 2048 + tid + k * 512] = v; nacc[k] += fabsf(v); } } }
                }
                float* nrp = NORMP + ((size_t)(l * 2 + set) * 256 + bid) * 2048;
#pragma unroll
                for (int k = 0; k < 4; ++k) nrp[tid + k * 512] = nacc[k];
            }
            for (int idx = bid * NTHR + tid; idx < 4096; idx += G * NTHR) { const int n = idx & 63, g = (idx >> 6) & 31, dir = idx >> 11;
                const double are = (double)(PT(24) + l * 4096)[idx], aim = (double)(PT(25) + l * 4096)[idx]; const double lam = are < -1e-4 ? are : -1e-4; const double dt = exp((double)(PT(26) + l * 64)[dir * 32 + g]);
                const double ldre = lam * dt, ldim = aim * dt; LDT[idx] = make_double2(ldre, ldim);
                const double mag = exp(ldre); const double ar = mag * cos(ldim), ai = mag * sin(ldim);
                const double den = lam * lam + aim * aim; const double nr = ar - 1.0, ni = ai; const double fre = (nr * lam + ni * aim) / den, fim = (ni * lam - nr * aim) / den;
                const float* b_re = PT(27) + l * 32 * 64 * 16; const float* b_im = PT(28) + l * 32 * 64 * 16;
#pragma unroll 4
                for (int c = 0; c < 16; ++c) { const double br = (double)b_re[(g * 64 + n) * 16 + c], bi = (double)b_im[(g * 64 + n) * 16 + c]; BBT[idx * 16 + c] = make_float2((float)(fre * br - fim * bi), (float)(fre * bi + fim * br)); }
            }
            for (int e2 = bid * NTHR + tid; e2 < 4096 * 33; e2 += G * NTHR) { const int idx = e2 / 33, k = e2 - idx * 33; const int g = (idx >> 6) & 31, dir = idx >> 11;
                const double are = (double)(PT(24) + l * 4096)[idx], aim = (double)(PT(25) + l * 4096)[idx]; const double lam = are < -1e-4 ? are : -1e-4; const double dt = exp((double)(PT(26) + l * 64)[dir * 32 + g]);
                const double ldre = lam * dt, ldim = aim * dt; const double mk = exp(ldre * k); APW[e2] = make_float2((float)(mk * cos(ldim * k)), (float)(mk * sin(ldim * k))); }
            if (l == 0 && lo == 0) xcd_barrier(bar);
            for (int tok = bid * 8 + wave; tok < NTOK; tok += G * 8) {
                const int r = tok < NLAT ? tok / SEQ : 4; const float* xr = l == 0 ? (tok < NLAT ? x_in + (size_t)tok * DM : ctx_in + (size_t)(tok - NLAT) * DM) : XS + (size_t)tok * DM; const float* gn = norm_mix + l * DM;
                const float* sh = MODl + (size_t)(r * 6 + 0) * DM; const float* sc = MODl + (size_t)(r * 6 + 1) * DM;
                float4 v[8]; float ss = 0.f;
#pragma unroll
                for (int i = 0; i < 8; ++i) v[i] = *(const float4*)(xr + i * 256 + lane * 4);
                if (l > 0) {
                    moe_combine(v, tok, lane, INV, ROWGATE, YEXP, MOD + (size_t)((l - 1) * 5 + r) * 6 * DM + 5 * DM);
#pragma unroll
                    for (int i = 0; i < 8; ++i) *(float4*)(XS + (size_t)tok * DM + i * 256 + lane * 4) = v[i]; }
#pragma unroll
                for (int i = 0; i < 8; ++i) ss += v[i].x * v[i].x + v[i].y * v[i].y + v[i].z * v[i].z + v[i].w * v[i].w;
                ss = wave_sum(ss); const float rs = rsqrtf(ss * (1.0f / DM) + 1e-6f);
#pragma unroll
                for (int i = 0; i < 8; ++i) { const int d = i * 256 + lane * 4; const float4 g4 = *(const float4*)(gn + d), s4 = *(const float4*)(sc + d), h4 = *(const float4*)(sh + d);
                    v[i].x = v[i].x * rs * g4.x * (1.f + s4.x) + h4.x; v[i].y = v[i].y * rs * g4.y * (1.f + s4.y) + h4.y; v[i].z = v[i].z * rs * g4.z * (1.f + s4.z) + h4.z; v[i].w = v[i].w * rs * g4.w * (1.f + s4.w) + h4.w; }
#pragma unroll
                for (int i = 0; i < 8; ++i) { u32x2 w; w.x = pk2(v[i].x, v[i].y); w.y = pk2(v[i].z, v[i].w); *(u32x2*)(HB + (size_t)tok * DM + i * 256 + lane * 4) = w; }
            }
            SEAM(PB + 0);
        }

        if (IN(PB + 1)) for (int rep_ = 0; rep_ < PROBE_REPS(1); ++rep_) {
            PH_BEGIN
            for (int base = bid * 8; base < (lastl ? 1 : 2) * 1024; base += G * 8) {
                const int idx = base + (tid & 7), sl = tid >> 3; const int set = idx >> 10, oc = idx & 1023, o = oc >> 9, c = oc & 511;
                const float* pp = NORMP + (size_t)(l * 2 + set) * 256 * 2048 + o * 1024 + c + (size_t)(sl * 4) * 2048; float sacc = 0.f;
#pragma unroll
                for (int j = 0; j < 4; ++j) { const float p0 = pp[(size_t)j * 2048], p1 = pp[(size_t)j * 2048 + 512]; sacc += (sl * 4 + j < G) ? p0 + p1 : 0.f; }
                sf[sl * 8 + (tid & 7)] = sacc; __syncthreads();
                if (tid < 8) { float t = 0.f;
#pragma unroll 8
                    for (int q = 0; q < 64; ++q) t += sf[q * 8 + tid];
                    NORM[(size_t)(l * 2 + set) * 1024 + oc] = t; }
                __syncthreads(); }
            for (int idx = (G - 1 - bid) * NTHR + tid; idx < 32768; idx += G * NTHR) { const int c = idx & 15, lag = (idx >> 4) & 31, dir = (idx >> 9) & 1, g = idx >> 10;
                const float* c_re = PT(29) + l * 32 * 16 * 64 + (g * 16 + c) * 64; const float* c_im = PT(30) + l * 32 * 16 * 64 + (g * 16 + c) * 64;
                float acc[16];
#pragma unroll
                for (int j = 0; j < 16; ++j) acc[j] = 0.f;
#pragma unroll 2
                for (int n = 0; n < 64; ++n) { const int pi = (dir * 32 + g) * 64 + n; const float2 ap = APW[pi * 33 + lag]; const float cr = c_re[n], ci = c_im[n]; const float wr_ = cr * ap.x - ci * ap.y, wi_ = cr * ap.y + ci * ap.x;
                    const float4* bb = (const float4*)(BBT + pi * 16);
#pragma unroll
                    for (int j = 0; j < 8; ++j) { const float4 b2 = bb[j]; acc[2 * j] += wr_ * b2.x - wi_ * b2.y; acc[2 * j + 1] += wr_ * b2.z - wi_ * b2.w; } }
                float4* o = (float4*)(KTB + (size_t)idx * 16);
                o[0] = make_float4(acc[0], acc[1], acc[2], acc[3]); o[1] = make_float4(acc[4], acc[5], acc[6], acc[7]); o[2] = make_float4(acc[8], acc[9], acc[10], acc[11]); o[3] = make_float4(acc[12], acc[13], acc[14], acc[15]);
            }
            __syncthreads();
            pg8::Gemm g{HB, WIN, DM, DM, DM}; pg8::SchedStd S{68, 55, G, bid, DM, DM}; pg8::EpiWin E{P, LDP};
            pg8::gemm_phase(( LAS unsigned char*)shm, g, S, E);
#if defined(PROBE_BNOEPI)
            { __syncthreads(); pg8::EpiNone E0; pg8::gemm_phase((LAS unsigned char*)shm, g, S, E0); }
#endif
            SEAM(PB + 1);
        }

        if (IN(PB + 2)) for (int rep_ = 0; rep_ < PROBE_REPS(2); ++rep_) {
            PH_BEGIN
            const float* hcw = PT(9) + l * 3 * 1536; const float* hcb = PT(10) + l * 1536; const float* mcw = PT(20) + l * 3 * 1024; const float* mcb = PT(21) + l * 1024;
            const float* scw = PT(34) + l * 3 * 1024; const float* scb = PT(35) + l * 1024;
            for (int unit = bid; unit < 272 * 3; unit += G) { const int seg = unit / 3, kind = unit % 3; const bool lat = seg < 256; const size_t tok0 = lat ? (size_t)seg * 64 : (size_t)NLAT + (size_t)(seg - 256) * 64;
                if (kind < 2) { const int hf = kind;
                    const int c = tid * 2; const int col = (hf ? SSD_OFF + 512 : ML_OFF) + c; const float* w = hf ? scw : mcw; const float* bsp = hf ? scb : mcb; bf16_t* dst = (hf ? XBC : QKB) + tok0 * 1024 + c;
                    const float2 w0 = *(const float2*)(w + c), w1 = *(const float2*)(w + 1024 + c), w2 = *(const float2*)(w + 2048 + c), bb = *(const float2*)(bsp + c);
                    const float osc = (!hf && c >= 512) ? 0.08838834764831845f : 1.0f;
                    const bool hasPrev = !lat && ((tok0 - NLAT) & (CTXL - 1)) != 0, hasNext = !lat && (((tok0 - NLAT) + 63) & (CTXL - 1)) != CTXL - 1;
                    bf16_t* strip = nullptr;
                    if (!hf) { if (c >= 512) strip = KTG + ((size_t)seg * 512 + (c - 512)) * 64; }
                    else { if (c < 512) strip = XTG + ((size_t)seg * 512 + c) * 64; else if (c < 768) strip = BTG + ((size_t)seg * 256 + (c - 512)) * 64; }
                    const bf16_t* pp = P + tok0 * LDP + col;
                    unsigned raw[66];
#pragma unroll
                    for (int t = 0; t < 66; ++t) raw[t] = ((t == 0 && !hasPrev) || (t == 65 && !hasNext)) ? 0u : *(const unsigned*)(pp + (ptrdiff_t)(t - 1) * LDP);
#pragma unroll
                    for (int t8 = 0; t8 < 8; ++t8) { float v0[8], v1[8];
#pragma unroll
                        for (int tt = 0; tt < 8; ++tt) { const int t = t8 * 8 + tt; const unsigned p0 = raw[t], p1 = raw[t + 1], p2 = raw[t + 2];
                            float a0 = bb.x + w0.x * __uint_as_float(p0 << 16) + w1.x * __uint_as_float(p1 << 16) + w2.x * __uint_as_float(p2 << 16);
                            float a1 = bb.y + w0.y * __uint_as_float(p0 & 0xFFFF0000u) + w1.y * __uint_as_float(p1 & 0xFFFF0000u) + w2.y * __uint_as_float(p2 & 0xFFFF0000u);
                            a0 = siluf_(a0) * osc; a1 = siluf_(a1) * osc; v0[tt] = a0; v1[tt] = a1;
                            *(unsigned*)(dst + (size_t)t * 1024) = pk2(a0, a1); }
                        if (strip) { u32x4 s0, s1; s0.x = pk2(v0[0], v0[1]); s0.y = pk2(v0[2], v0[3]); s0.z = pk2(v0[4], v0[5]); s0.w = pk2(v0[6], v0[7]); s1.x = pk2(v1[0], v1[1]); s1.y = pk2(v1[2], v1[3]); s1.z = pk2(v1[4], v1[5]); s1.w = pk2(v1[6], v1[7]);
                            *(u32x4*)(strip + t8 * 8) = s0; *(u32x4*)(strip + 64 + t8 * 8) = s1; } }
                } else {
                    const int c = (tid & 255) * 2, th = tid >> 8; const bf16_t* pp = P + (tok0 + th * 32) * LDP + ML_OFF + 1024 + c; bf16_t* strip = VTG + ((size_t)seg * 512 + c) * 64 + th * 32;
                    unsigned rv[32];
#pragma unroll
                    for (int t = 0; t < 32; ++t) rv[t] = *(const unsigned*)(pp + (size_t)t * LDP);
#pragma unroll
                    for (int t8 = 0; t8 < 4; ++t8) { u32x4 s0, s1;
                        s0.x = (rv[t8 * 8 + 0] & 0xFFFFu) | (rv[t8 * 8 + 1] << 16); s0.y = (rv[t8 * 8 + 2] & 0xFFFFu) | (rv[t8 * 8 + 3] << 16); s0.z = (rv[t8 * 8 + 4] & 0xFFFFu) | (rv[t8 * 8 + 5] << 16); s0.w = (rv[t8 * 8 + 6] & 0xFFFFu) | (rv[t8 * 8 + 7] << 16);
                        s1.x = (rv[t8 * 8 + 0] >> 16) | (rv[t8 * 8 + 1] & 0xFFFF0000u); s1.y = (rv[t8 * 8 + 2] >> 16) | (rv[t8 * 8 + 3] & 0xFFFF0000u); s1.z = (rv[t8 * 8 + 4] >> 16) | (rv[t8 * 8 + 5] & 0xFFFF0000u); s1.w = (rv[t8 * 8 + 6] >> 16) | (rv[t8 * 8 + 7] & 0xFFFF0000u);
                        *(u32x4*)(strip + t8 * 8) = s0; *(u32x4*)(strip + 64 + t8 * 8) = s1; }
                }
            }
            if (!lastl) for (int tok = NLAT + bid; tok < NTOK; tok += G) {
                const int t = (tok - NLAT) & (CTXL - 1); const bool hasL = (t != 0), hasR = (t != CTXL - 1); const bf16_t* pr = P + (size_t)tok * LDP;
                const bf16_t* prL = hasL ? pr - LDP : pr; const bf16_t* prR = hasR ? pr + LDP : pr;
                unsigned xc[3], xl[3], xr[3];
#pragma unroll
                for (int j = 0; j < 3; ++j) { const int cc = tid + j * 512; xc[j] = pr[HY_OFF + cc]; xl[j] = prL[HY_OFF + cc]; xr[j] = prR[HY_OFF + cc]; }
#pragma unroll
                for (int j = 0; j < 3; ++j) { const int cc = tid + j * 512;
                    float acc = hcb[cc] + hcw[1536 + cc] * __uint_as_float(xc[j] << 16);
                    acc += hasL ? hcw[cc] * __uint_as_float(xl[j] << 16) : 0.f;
                    acc += hasR ? hcw[2 * 1536 + cc] * __uint_as_float(xr[j] << 16) : 0.f;
                    U[(size_t)tok * 1536 + cc] = acc; }
            }
            for (int idx0 = bid * NTHR + tid; idx0 < 16384 * 64; idx0 += 4 * G * NTHR) { u32x4 t4[4];
#pragma unroll
                for (int q = 0; q < 4; ++q) { const int idx = idx0 + q * G * NTHR; const int half = idx & 1, g = (idx >> 1) & 31, tok = idx >> 6;
                    if (idx < 16384 * 64) t4[q] = *(const u32x4*)(P + (size_t)tok * LDP + S5_OFF + g * 16 + half * 8); }
#pragma unroll
                for (int q = 0; q < 4; ++q) { const int idx = idx0 + q * G * NTHR; const int half = idx & 1, g = (idx >> 1) & 31, tok = idx >> 6;
                    if (idx < 16384 * 64) *(u32x4*)(S5A + ((size_t)g * 512 + (tok >> 5)) * 768 + (tok & 31) * 16 + half * 8) = t4[q]; } }
            for (int idx = bid * NTHR + tid; idx < 32 * 512 * 32 * 2; idx += G * NTHR) { const int half = idx & 1, sI = (idx >> 1) & 31, row = (idx >> 6) & 511, g = idx >> 15; const int t = row >> 4, c = row & 15; const int lag = t - sI;
                float v[8];
                if (lag > 0) { const float4* k4 = (const float4*)(KTB + ((size_t)((g * 2 + 0) * 32 + lag) * 16 + c) * 16 + half * 8); const float4 a0 = k4[0], a1 = k4[1]; v[0] = a0.x; v[1] = a0.y; v[2] = a0.z; v[3] = a0.w; v[4] = a1.x; v[5] = a1.y; v[6] = a1.z; v[7] = a1.w; }
                else if (lag < 0) { const float4* k4 = (const float4*)(KTB + ((size_t)((g * 2 + 1) * 32 - lag) * 16 + c) * 16 + half * 8); const float4 a0 = k4[0], a1 = k4[1]; v[0] = a0.x; v[1] = a0.y; v[2] = a0.z; v[3] = a0.w; v[4] = a1.x; v[5] = a1.y; v[6] = a1.z; v[7] = a1.w; }
                else { const float4* k4 = (const float4*)(KTB + ((size_t)((g * 2 + 0) * 32) * 16 + c) * 16 + half * 8); const float4* q4 = (const float4*)(KTB + ((size_t)((g * 2 + 1) * 32) * 16 + c) * 16 + half * 8); const float4 a0 = k4[0], a1 = k4[1], b0 = q4[0], b1 = q4[1];
                    v[0] = a0.x + b0.x; v[1] = a0.y + b0.y; v[2] = a0.z + b0.z; v[3] = a0.w + b0.w; v[4] = a1.x + b1.x; v[5] = a1.y + b1.y; v[6] = a1.z + b1.z; v[7] = a1.w + b1.w; }
                u32x4 w; w.x = pk2(v[0], v[1]); w.y = pk2(v[2], v[3]); w.z = pk2(v[4], v[5]); w.w = pk2(v[6], v[7]);
                *(u32x4*)(S5B + ((size_t)g * 512 + row) * 768 + sI * 16 + half * 8) = w; }
            for (int idx = bid * NTHR + tid; idx < 32 * 512 * 64; idx += G * NTHR) { const int n = idx & 63, row = (idx >> 6) & 511, g = idx >> 15; const int t = row >> 4, c = row & 15;
                const float cr = (PT(29) + l * 32 * 16 * 64)[(g * 16 + c) * 64 + n], ci = (PT(30) + l * 32 * 16 * 64)[(g * 16 + c) * 64 + n];
                const float2 af = APW[((0 * 32 + g) * 64 + n) * 33 + t + 1], ab = APW[((1 * 32 + g) * 64 + n) * 33 + 32 - t];
                bf16_t* d = S5B + ((size_t)g * 512 + row) * 768 + 512 + 2 * n;
                *(unsigned*)d = pk2(cr * af.x - ci * af.y, -(cr * af.y + ci * af.x)); *(unsigned*)(d + 128) = pk2(cr * ab.x - ci * ab.y, -(cr * ab.y + ci * ab.x)); }
            for (int idx = bid * NTHR + tid; idx < 32 * 2 * 64 * 32; idx += G * NTHR) { const int sI = idx & 31, n = (idx >> 5) & 63, dir = (idx >> 11) & 1, g = idx >> 12; const int pi = (dir * 32 + g) * 64 + n;
                const float2 pw = APW[pi * 33 + (dir ? sI : 31 - sI)]; const float4* bb = (const float4*)(BBT + pi * 16);
                float re[16], im[16];
#pragma unroll
                for (int j = 0; j < 8; ++j) { const float4 b2 = bb[j]; re[2 * j] = pw.x * b2.x - pw.y * b2.y; im[2 * j] = pw.x * b2.y + pw.y * b2.x; re[2 * j + 1] = pw.x * b2.z - pw.y * b2.w; im[2 * j + 1] = pw.x * b2.w + pw.y * b2.z; }
                bf16_t* d = S5P + ((size_t)g * 256 + dir * 128 + 2 * n) * 512 + sI * 16;
                u32x4 w0, w1; w0.x = pk2(re[0], re[1]); w0.y = pk2(re[2], re[3]); w0.z = pk2(re[4], re[5]); w0.w = pk2(re[6], re[7]); w1.x = pk2(re[8], re[9]); w1.y = pk2(re[10], re[11]); w1.z = pk2(re[12], re[13]); w1.w = pk2(re[14], re[15]);
                *(u32x4*)d = w0; *(u32x4*)(d + 8) = w1;
                w0.x = pk2(im[0], im[1]); w0.y = pk2(im[2], im[3]); w0.z = pk2(im[4], im[5]); w0.w = pk2(im[6], im[7]); w1.x = pk2(im[8], im[9]); w1.y = pk2(im[10], im[11]); w1.z = pk2(im[12], im[13]); w1.w = pk2(im[14], im[15]);
                *(u32x4*)(d + 512) = w0; *(u32x4*)(d + 520) = w1; }
            {   float* T = sf;
                for (int unit = bid; unit < 4 * 64 * 24; unit += G) { const int b = unit / (64 * 24), r = (unit / 24) % 64, c0 = (unit % 24) * 64; const size_t tok0 = (size_t)b * SEQ + r * 64;
                    __syncthreads();
#pragma unroll
                    for (int i = 0; i < 8; ++i) { const int c = tid & 63, t = (tid >> 6) + 8 * i; T[t * 65 + c] = bf2f(P[(tok0 + t) * LDP + HY_OFF + c0 + c]); }
                    __syncthreads();
                    const int c = tid >> 3, tq = (tid & 7) * 8, cc = c0 + c; const float w0 = hcw[cc], w1 = hcw[1536 + cc], w2 = hcw[3072 + cc], bb = hcb[cc];
                    float o8[8];
#pragma unroll
                    for (int i = 0; i < 8; ++i) { const int t = tq + i; float acc = bb + w1 * T[t * 65 + c]; if (t > 0) acc += w0 * T[(t - 1) * 65 + c]; if (t < 63) acc += w2 * T[(t + 1) * 65 + c]; o8[i] = acc; }
                    float* dst = UT + ((size_t)b * 1536 + cc) * SEQ + r * 64 + tq;
                    *(float4*)dst = make_float4(o8[0], o8[1], o8[2], o8[3]); *(float4*)(dst + 4) = make_float4(o8[4], o8[5], o8[6], o8[7]);
                } }
            if (!lastl) {
                const int L = CTXL; const float* HR = HRAW + (size_t)SEQ * 2048; float* K2 = K2C; const float* nrm = NORM + (size_t)(l * 2 + 1) * 1024;
                const size_t total = (size_t)(2 * L - 1) * 1024;
                for (size_t i = (size_t)bid * NTHR + tid; i < total; i += (size_t)G * NTHR) { const int j = (int)(i >> 10), oc = (int)(i & 1023), o = oc >> 9, c = oc & 511; const int lag = j - (L - 1);
                    const float v = lag >= 0 ? HR[(size_t)lag * 2048 + o * 1024 + c] : HR[(size_t)(-lag) * 2048 + o * 1024 + 512 + c];
                    K2[((size_t)j * 2 + o) * 512 + c] = v / nrm[oc]; }
            }
            {   __syncthreads(); fft_twiddles((float2*)(shm + FFT_X_BYTES), tid);
                for (int oc = bid; oc < 1024; oc += G) hyena_spec_item(oc, HRAW, NORM + (size_t)(l * 2 + 0) * 1024, HSPEC, shm, tid);
                __syncthreads(); }
            SEAM(PB + 2);
        }

        if (IN(PB + 3)) for (int rep_ = 0; rep_ < PROBE_REPS(3); ++rep_) {
            PH_BEGIN
            if (rep_ > 0) { if (bid == 0 && tid == 0) __hip_atomic_store(QCTR + l * 64, 0, __ATOMIC_RELAXED, __HIP_MEMORY_SCOPE_AGENT); xcd_barrier(bar); }
            if (bid < 64) {
                mlstm_state_pass(bid >> 1, bid & 1, P, KTG, VTG, PT(22) + l * 16, CST, NST, MST, shm, tid);
            } else if (bid < 128) {
                { const int ch = bid - 64; const int dir_ = ch & 1, h_ = (ch >> 1) & 7; ssd_state_pass(ch, P, BTG, XTG, -expf(PT(37)[l * 16 + dir_ * 8 + h_]), PT(36)[l * 16 + dir_ * 8 + h_], SSTB, shm, tid); }
            } else if (bid < 160) {
                const int widx = (bid - 128) * 8 + wave; const int dir = widx & 1, g = (widx >> 1) & 31, b = widx >> 6; const int n = lane;
                float2* xb = (float2*)(shm + (size_t)wave * 16640); float2* ctab = xb + 16 * 65;
                const float* a_re = PT(24) + l * 2 * 32 * 64; const float* a_im = PT(25) + l * 2 * 32 * 64; const float* log_dt = PT(26) + l * 64;
                const float* b_re = PT(27) + l * 32 * 64 * 16; const float* b_im = PT(28) + l * 32 * 64 * 16; const float* c_re = PT(29) + l * 32 * 16 * 64; const float* c_im = PT(30) + l * 32 * 16 * 64;
#pragma unroll
                for (int c = 0; c < 16; ++c) ctab[c * 65 + lane] = make_float2(c_re[(g * 16 + c) * 64 + lane], c_im[(g * 16 + c) * 64 + lane]);
                float abr, abi, bbr[16], bbi[16];
                {   const double are = (double)a_re[(dir * 32 + g) * 64 + n], aim = (double)a_im[(dir * 32 + g) * 64 + n];
                    const double lam = are < -1e-4 ? are : -1e-4; const double dt = exp((double)log_dt[dir * 32 + g]);
                    const double mag = exp(lam * dt); const double ar = mag * cos(aim * dt), ai = mag * sin(aim * dt);
                    const double den = lam * lam + aim * aim; const double nr = ar - 1.0, ni = ai;
                    const double fre = (nr * lam + ni * aim) / den, fim = (ni * lam - nr * aim) / den;
                    abr = (float)ar; abi = (float)ai;
#pragma unroll
                    for (int c = 0; c < 16; ++c) { const double br = (double)b_re[(g * 64 + n) * 16 + c], bi = (double)b_im[(g * 64 + n) * 16 + c]; bbr[c] = (float)(fre * br - fim * bi); bbi[c] = (float)(fre * bi + fim * br); }
                }
                float xr = 0.f, xi = 0.f; float* Sout = (dir ? SB : SF) - (size_t)NLAT * BW;
                const int s = lane >> 2, cg = lane & 3;
                for (int i0 = 0; i0 < CTXL; i0 += 16) {
#pragma unroll 4
                    for (int ss = 0; ss < 16; ++ss) {
                        const size_t tok = (size_t)step_tok(b, dir, i0 + ss);
                        const u32x4* up = (const u32x4*)(P + tok * LDP + S5_OFF + g * 16);
                        float t0[8], t1[8]; unpack8(up[0], t0); unpack8(up[1], t1);
                        float bur = 0.f, bui = 0.f;
#pragma unroll
                        for (int c = 0; c < 8; ++c) { bur += t0[c] * bbr[c] + t1[c] * bbr[8 + c]; bui += t0[c] * bbi[c] + t1[c] * bbi[8 + c]; }
                        const float nxr = abr * xr - abi * xi + bur, nxi = abr * xi + abi * xr + bui; xr = nxr; xi = nxi;
                        xb[ss * 65 + lane] = make_float2(xr, xi);
                    }
                    asm volatile("s_waitcnt lgkmcnt(0)" ::: "memory");
                    float y0 = 0.f, y1 = 0.f, y2 = 0.f, y3 = 0.f;
                    for (int nn2 = 0; nn2 < 64; ++nn2) { const float2 xv = xb[s * 65 + nn2];
                        const float2 c0 = ctab[(cg * 4 + 0) * 65 + nn2], c1 = ctab[(cg * 4 + 1) * 65 + nn2], c2 = ctab[(cg * 4 + 2) * 65 + nn2], c3 = ctab[(cg * 4 + 3) * 65 + nn2];
                        y0 += xv.x * c0.x - xv.y * c0.y; y1 += xv.x * c1.x - xv.y * c1.y; y2 += xv.x * c2.x - xv.y * c2.y; y3 += xv.x * c3.x - xv.y * c3.y; }
                    const size_t toks = (size_t)step_tok(b, dir, i0 + s);
                    *(float4*)(Sout + toks * BW + g * 16 + cg * 4) = make_float4(y0, y1, y2, y3);
                    asm volatile("s_waitcnt lgkmcnt(0)" ::: "memory");
                }
                XCTX[((b * 32 + g) * 2 + dir) * 64 + n] = make_float2(xr, xi);
            } else {
                if (bid < 224) {
                    pg8::Gemm gg_{S5A, S5P, 768, 512, 512}; pg8::SchedS5a S_{bid - 160}; pg8::EpiXloc E_{XLOC};
                    pg8::gemm_phase((LAS unsigned char*)shm, gg_, S_, E_);
                    __syncthreads();
                }
                const int nhb = G - 160, hb = bid - 160; const float* bias = PT(19) + l * 1024; const int c = tid;
                const int nitems = lastl ? 0 : 4 * (CTXL / 8);
                for (int it = hb; it < nitems; it += nhb) {
                    int L, tokbase, b, t0; const float* K2;
                    { const int q = it; L = CTXL; tokbase = NLAT; b = q / (CTXL / 8); t0 = (q % (CTXL / 8)) * 8; K2 = K2C; }
                    const float* zb = U + (size_t)(tokbase + b * L) * 1536 + c;
                    float acc[8];
#pragma unroll
                    for (int i = 0; i < 8; ++i) acc[i] = 0.f;
                    const int base = t0 + L - 1;
                    for (int s = 0; s < L; s += 8) {
                        float k[15];
#pragma unroll
                        for (int mm = 0; mm < 15; ++mm) k[mm] = K2[((size_t)(base - s - 7 + mm) * 2 + 0) * 512 + c];
#pragma unroll
                        for (int ds = 0; ds < 8; ++ds) { const float z = zb[(size_t)(s + ds) * 1536];
#pragma unroll
                            for (int i = 0; i < 8; ++i) acc[i] += k[i - ds + 7] * z; }
                    }
#pragma unroll
                    for (int i = 0; i < 8; ++i) { const size_t tok = (size_t)(tokbase + b * L + t0 + i); const float zt = U[tok * 1536 + c]; Z[tok * BW + c] = (acc[i] + bias[c] * zt) * U[tok * 1536 + 512 + c]; }
                }
            }
            {   __syncthreads(); fft_twiddles((float2*)(shm + FFT_X_BYTES), tid);
                int* qslot = (int*)(shm + FFT_X_BYTES + 65536);
                for (;;) { __syncthreads(); if (tid == 0) *qslot = atomicAdd(QCTR + l * 64, 1); __syncthreads(); const int it = *qslot; if (it >= 1024) break;
                    hyena_fft_item(it, UT, HSPEC, PT(19) + l * 1024, YT, shm, tid); }
            }
            SEAM(PB + 3);
        }

        if (IN(PB + 4)) for (int rep_ = 0; rep_ < PROBE_REPS(4); ++rep_) {
            PH_BEGIN
            if (rep_ > 0) { if (bid == 0 && tid == 0) __hip_atomic_store(QCTR + l * 64 + 32, 0, __ATOMIC_RELAXED, __HIP_MEMORY_SCOPE_AGENT); xcd_barrier(bar); }
            if (bid >= G - 32) for (int idx = (bid - (G - 32)) * NTHR + tid; idx < 16384; idx += 32 * NTHR) { const int n = idx & 63, dir = (idx >> 6) & 1, b = (idx >> 7) & 3, g = idx >> 9;
                const float2 a32 = APW[((dir * 32 + g) * 64 + n) * 33 + 32]; float2 X = XCTX[((b * 32 + g) * 2 + dir) * 64 + n];
                const float* __restrict__ xl = XLOC + ((size_t)g * 512 + b * 128) * 256 + dir * 128 + 2 * n; bf16_t* __restrict__ dst = S5A + ((size_t)g * 512 + b * 128) * 768 + 512 + dir * 128 + 2 * n;
#pragma unroll 1
                for (int j0 = 0; j0 < 128; j0 += 16) { float2 xv[16];
#pragma unroll
                    for (int q = 0; q < 16; ++q) { const int j = dir ? 127 - (j0 + q) : j0 + q; xv[q] = *(const float2*)(xl + (size_t)j * 256); }
#pragma unroll
                    for (int q = 0; q < 16; ++q) { const int j = dir ? 127 - (j0 + q) : j0 + q;
                        *(unsigned*)(dst + (size_t)j * 768) = pk2(X.x, X.y);
                        const float nx = a32.x * X.x - a32.y * X.y + xv[q].x, ny = a32.x * X.y + a32.y * X.x + xv[q].y; X.x = nx; X.y = ny; } } }
            {   int* qslot = (int*)(shm + 102400);
                for (;;) { __syncthreads(); if (tid == 0) *qslot = atomicAdd(QCTR + l * 64 + 32, 1); __syncthreads(); const int it = *qslot; if (it >= 32 * 68 + 64 * 68) break;
                    if (it < 32 * 68) { const int chain = it / 68, c = it % 68; mlstm_out_item(chain, c, P, QKB, VTG, PT(22) + l * 16, CST, NST, MST, (chain & 1) ? HBk : HF, shm, tid); }
                    else { const int i2 = it - 32 * 68; const int chain = i2 / 68, c = i2 % 68; const int dir_ = chain & 1, h_ = (chain >> 1) & 7;
                        ssd_out_item(chain, c, P, XBC, XTG, -expf(PT(37)[l * 16 + dir_ * 8 + h_]), PT(36)[l * 16 + dir_ * 8 + h_], SSTB, dir_ ? YB : YF, shm, tid); } }
            }
            __syncthreads();
            {   const float* bias = PT(19) + l * 1024 + 512; const int c = tid;
                const int nitems = lastl ? 0 : 4 * (CTXL / 8);
                for (int it = bid; it < nitems; it += G) {
                    int L, tokbase, b, t0; const float* K2;
                    { const int q = it; L = CTXL; tokbase = NLAT; b = q / (CTXL / 8); t0 = (q % (CTXL / 8)) * 8; K2 = K2C; }
                    const float* zb = Z + (size_t)(tokbase + b * L) * BW + c;
                    float acc[8];
#pragma unroll
                    for (int i = 0; i < 8; ++i) acc[i] = 0.f;
                    const int base = t0 + L - 1;
                    for (int s = 0; s < L; s += 8) {
                        float k[15];
#pragma unroll
                        for (int mm = 0; mm < 15; ++mm) k[mm] = K2[((size_t)(base - s - 7 + mm) * 2 + 1) * 512 + c];
#pragma unroll
                        for (int ds = 0; ds < 8; ++ds) { const float z = zb[(size_t)(s + ds) * BW];
#pragma unroll
                            for (int i = 0; i < 8; ++i) acc[i] += k[i - ds + 7] * z; }
                    }
#pragma unroll
                    for (int i = 0; i < 8; ++i) { const size_t tok = (size_t)(tokbase + b * L + t0 + i); const float zt = Z[tok * BW + c]; Y4[tok * DM + c] = f2bf((acc[i] + bias[c] * zt) * U[tok * 1536 + 1024 + c]); }
                }
            }
            SEAM(PB + 4);
        }

        if (IN(PB + 5)) for (int rep_ = 0; rep_ < PROBE_REPS(5); ++rep_) {
            PH_BEGIN
            const float* ml_norm = PT(23) + l * BW; const float* ssd_d = PT(38) + l * 8; const float* ssd_norm = PT(39) + l * BW; const float* s5_d = PT(31) + l * BW;
            if (bid < 128) {
                pg8::Gemm gg_{S5A, S5B, 768, 768, 768}; pg8::SchedS5b S_{bid}; pg8::EpiS5Out E_{P, s5_d, GG};
                pg8::gemm_phase((LAS unsigned char*)shm, gg_, S_, E_);
                __syncthreads();
            }
            for (int tok = bid * 8 + wave; tok < NTOK; tok += G * 8) {
                const int c0 = lane * 8; const bf16_t* pr = P + (size_t)tok * LDP; const size_t o5 = (size_t)tok * BW + c0;
                float hm[8], ys[8];
                const u32x4 ooq = *(const u32x4*)(pr + ML_OFF + 1536 + c0);
                const float4 g0 = *(const float4*)(ml_norm + c0), g1 = *(const float4*)(ml_norm + c0 + 4), n0 = *(const float4*)(ssd_norm + c0), n1 = *(const float4*)(ssd_norm + c0 + 4);
                { const float4 a0 = *(const float4*)(HF + o5), a1 = *(const float4*)(HF + o5 + 4), b0 = *(const float4*)(HBk + o5), b1 = *(const float4*)(HBk + o5 + 4);
                  hm[0] = a0.x + b0.x; hm[1] = a0.y + b0.y; hm[2] = a0.z + b0.z; hm[3] = a0.w + b0.w; hm[4] = a1.x + b1.x; hm[5] = a1.y + b1.y; hm[6] = a1.z + b1.z; hm[7] = a1.w + b1.w; }
                { const float4 a0 = *(const float4*)(YF + o5), a1 = *(const float4*)(YF + o5 + 4), b0 = *(const float4*)(YB + o5), b1 = *(const float4*)(YB + o5 + 4);
                  float xx[8], zz[8]; unpack8(*(const u32x4*)(XBC + (size_t)tok * 1024 + c0), xx); unpack8(*(const u32x4*)(pr + SSD_OFF + c0), zz); const float dsk = ssd_d[c0 >> 6];
                  ys[0] = a0.x + b0.x; ys[1] = a0.y + b0.y; ys[2] = a0.z + b0.z; ys[3] = a0.w + b0.w; ys[4] = a1.x + b1.x; ys[5] = a1.y + b1.y; ys[6] = a1.z + b1.z; ys[7] = a1.w + b1.w;
#pragma unroll
                  for (int j = 0; j < 8; ++j) ys[j] = (ys[j] + dsk * xx[j]) * siluf_(zz[j]); }
                float s1 = 0.f, s2 = 0.f;
#pragma unroll
                for (int j = 0; j < 8; ++j) { s1 += hm[j] * hm[j]; s2 += ys[j] * ys[j]; }
                s1 += __shfl_xor(s1, 1); s1 += __shfl_xor(s1, 2); s1 += __shfl_xor(s1, 4); s1 += __shfl_xor(s1, 8);
                s2 = wave_sum(s2);
                const float r1 = rsqrtf(s1 * (1.0f / 128.0f) + 1e-6f), r2 = rsqrtf(s2 * (1.0f / BW) + 1e-6f);
                float oo[8]; unpack8(ooq, oo);
                const float gm[8] = {g0.x, g0.y, g0.z, g0.w, g1.x, g1.y, g1.z, g1.w}, gs[8] = {n0.x, n0.y, n0.z, n0.w, n1.x, n1.y, n1.z, n1.w};
                u32x4 w;
                w.x = pk2(hm[0] * r1 * gm[0] * sigmoidf_(oo[0]), hm[1] * r1 * gm[1] * sigmoidf_(oo[1])); w.y = pk2(hm[2] * r1 * gm[2] * sigmoidf_(oo[2]), hm[3] * r1 * gm[3] * sigmoidf_(oo[3]));
                w.z = pk2(hm[4] * r1 * gm[4] * sigmoidf_(oo[4]), hm[5] * r1 * gm[5] * sigmoidf_(oo[5])); w.w = pk2(hm[6] * r1 * gm[6] * sigmoidf_(oo[6]), hm[7] * r1 * gm[7] * sigmoidf_(oo[7]));
                *(u32x4*)(Y4 + (size_t)tok * DM + 512 + c0) = w;
                w.x = pk2(ys[0] * r2 * gs[0], ys[1] * r2 * gs[1]); w.y = pk2(ys[2] * r2 * gs[2], ys[3] * r2 * gs[3]); w.z = pk2(ys[4] * r2 * gs[4], ys[5] * r2 * gs[5]); w.w = pk2(ys[6] * r2 * gs[6], ys[7] * r2 * gs[7]);
                *(u32x4*)(Y4 + (size_t)tok * DM + 1536 + c0) = w;
                if (tok >= NLAT) { const size_t oc = (size_t)(tok - NLAT) * BW + c0; float uu[8]; unpack8(*(const u32x4*)(pr + S5_OFF + c0), uu);
                    const float4 a0 = *(const float4*)(SF + oc), a1 = *(const float4*)(SF + oc + 4), b0 = *(const float4*)(SB + oc), b1 = *(const float4*)(SB + oc + 4), d0 = *(const float4*)(s5_d + c0), d1 = *(const float4*)(s5_d + c0 + 4);
                    float y[8] = {a0.x + b0.x + d0.x * uu[0], a0.y + b0.y + d0.y * uu[1], a0.z + b0.z + d0.z * uu[2], a0.w + b0.w + d0.w * uu[3], a1.x + b1.x + d1.x * uu[4], a1.y + b1.y + d1.y * uu[5], a1.z + b1.z + d1.z * uu[6], a1.w + b1.w + d1.w * uu[7]};
#pragma unroll
                    for (int j = 0; j < 8; ++j) y[j] = 0.5f * y[j] * (1.0f + tanhf(0.7978845608028654f * (y[j] + 0.044715f * y[j] * y[j] * y[j])));
                    w.x = pk2(y[0], y[1]); w.y = pk2(y[2], y[3]); w.z = pk2(y[4], y[5]); w.w = pk2(y[6], y[7]);
                    *(u32x4*)(GG + (size_t)tok * BW + c0) = w; }
            }
            __syncthreads();
            {   float* T = sf;
                for (int unit = (G > 128 ? bid - 128 : bid); unit >= 0 && unit < 4 * 64 * 8; unit += (G > 128 ? G - 128 : G)) { const int b = unit / 512, t0 = ((unit >> 3) & 63) * 64, c0 = (unit & 7) * 64;
                    __syncthreads();
#pragma unroll
                    for (int i = 0; i < 8; ++i) { const int t = tid & 63, c = (tid >> 6) + 8 * i; T[c * 65 + t] = YT[((size_t)b * 512 + c0 + c) * SEQ + t0 + t]; }
                    __syncthreads();
                    const int t = tid >> 3, cq = (tid & 7) * 8;
                    u32x4 w; w.x = pk2(T[(cq + 0) * 65 + t], T[(cq + 1) * 65 + t]); w.y = pk2(T[(cq + 2) * 65 + t], T[(cq + 3) * 65 + t]); w.z = pk2(T[(cq + 4) * 65 + t], T[(cq + 5) * 65 + t]); w.w = pk2(T[(cq + 6) * 65 + t], T[(cq + 7) * 65 + t]);
                    *(u32x4*)(Y4 + ((size_t)b * SEQ + t0 + t) * DM + c0 + cq) = w;
                } }
            SEAM(PB + 5);
        }

        if (IN(PB + 6)) for (int rep_ = 0; rep_ < PROBE_REPS(6); ++rep_) {
            PH_BEGIN
            pg8::Gemm g{GG, GLU, BW, BW, BW}; pg8::SchedStd S{68, 2, G, bid, BW, BW}; pg8::EpiGlu E{GG, PT(33) + l * BW, Y4};
            pg8::gemm_phase((LAS unsigned char*)shm, g, S, E);
            SEAM(PB + 6);
        }
        if (IN(PB + 7)) for (int rep_ = 0; rep_ < PROBE_REPS(7); ++rep_) {
            PH_BEGIN
            pg8::Gemm g{Y4, WBR, DM, BW, BW}; pg8::SchedBranch S{64, 8, G, bid}; pg8::EpiBranch E{P, ACCb};
            pg8::gemm_phase((LAS unsigned char*)shm, g, S, E);
            if (!lastl) { __syncthreads(); pg8::SchedTail S2{G, bid}; pg8::EpiPart E2{P, (float*)HSPEC}; pg8::gemm_phase((LAS unsigned char*)shm, g, S2, E2); }
            SEAM(PB + 7);
        }
        if (IN(PB + 8)) for (int rep_ = 0; rep_ < PROBE_REPS(8); ++rep_) {
            PH_BEGIN
            if (!lastl) {
                const float* PART = (const float*)HSPEC;
                for (int idx = bid * NTHR + tid; idx < (NTOK - NLAT) * DM / 8; idx += G * NTHR) { const size_t o = (size_t)idx * 8; f32x4 p[4][2];
#pragma unroll
                    for (int k = 0; k < 4; ++k) { p[k][0] = *(const f32x4*)(PART + (size_t)k * (NTOK - NLAT) * DM + o); p[k][1] = *(const f32x4*)(PART + (size_t)k * (NTOK - NLAT) * DM + o + 4); }
                    const f32x4 s0 = ((p[0][0] + p[1][0]) + p[2][0]) + p[3][0], s1 = ((p[0][1] + p[1][1]) + p[2][1]) + p[3][1];
                    u32x4 w; w.x = pk2(s0[0], s0[1]); w.y = pk2(s0[2], s0[3]); w.z = pk2(s1[0], s1[1]); w.w = pk2(s1[2], s1[3]);
                    *(u32x4*)(ACCb + (size_t)NLAT * DM + o) = w; }
                xcd_barrier(bar);
            }
            pg8::Gemm g{ACCb, WOUT, DM, DM, DM}; pg8::SchedStd S{nPanels, 8, G, bid, DM, DM}; pg8::EpiResid E{XS, l == 0 ? x_in : (const float*)XS, l == 0 ? ctx_in - (size_t)NLAT * DM : (const float*)XS, MODl, 2};
            pg8::gemm_phase((LAS unsigned char*)shm, g, S, E);
            SEAM(PB + 8);
        }
        if (IN(PB + 9)) for (int rep_ = 0; rep_ < PROBE_REPS(9); ++rep_) {
            PH_BEGIN
            for (int i = bid * NTHR + tid; i < NEXP * MOE_PAD; i += G * NTHR) ROWTOK[i] = -1;
            for (int i = bid * NTHR + tid; i < NTOK * 16; i += G * NTHR) INV[i] = -1;
            const float* wr = PT(42) + (size_t)l * DM * 16; const float* gn = norm_ffn + l * DM;
            for (int tok0 = (bid * 8 + wave) * 4; tok0 < M2; tok0 += G * 32) {
                const int r = tok0 < NLAT ? tok0 / SEQ : 4; const float* xr = XS + (size_t)tok0 * DM;
                const float* sh = MODl + (size_t)(r * 6 + 3) * DM; const float* sc = MODl + (size_t)(r * 6 + 4) * DM;
                float rs[4];
#pragma unroll
                for (int tk = 0; tk < 4; ++tk) { float ss = 0.f;
#pragma unroll 4
                    for (int i = 0; i < 8; ++i) { const float4 t4 = *(const float4*)(xr + (size_t)tk * DM + i * 256 + lane * 4); ss += t4.x * t4.x + t4.y * t4.y + t4.z * t4.z + t4.w * t4.w; }
                    ss = wave_sum(ss); rs[tk] = rsqrtf(ss * (1.0f / DM) + 1e-6f); }
                float lg[4][16];
#pragma unroll
                for (int tk = 0; tk < 4; ++tk)
#pragma unroll
                    for (int e = 0; e < 16; ++e) lg[tk][e] = 0.f;
#pragma unroll 1
                for (int i = 0; i < 8; ++i) { const int d = i * 256 + lane * 4;
                    const float4 g4 = *(const float4*)(gn + d), s4 = *(const float4*)(sc + d), h4 = *(const float4*)(sh + d);
                    float4 xq[4], ww[16];
#pragma unroll
                    for (int tk = 0; tk < 4; ++tk) xq[tk] = *(const float4*)(xr + (size_t)tk * DM + d);
                    const float4* wq = (const float4*)(wr + (size_t)d * 16);
#pragma unroll
                    for (int q = 0; q < 16; ++q) ww[q] = wq[q];
                    float hv[4][4];
#pragma unroll
                    for (int tk = 0; tk < 4; ++tk) { const float4 xv = xq[tk]; const float rr = rs[tk];
                        hv[tk][0] = xv.x * rr * g4.x * (1.f + s4.x) + h4.x; hv[tk][1] = xv.y * rr * g4.y * (1.f + s4.y) + h4.y; hv[tk][2] = xv.z * rr * g4.z * (1.f + s4.z) + h4.z; hv[tk][3] = xv.w * rr * g4.w * (1.f + s4.w) + h4.w;
                        u32x2 w; w.x = pk2(hv[tk][0], hv[tk][1]); w.y = pk2(hv[tk][2], hv[tk][3]); *(u32x2*)(HB + (size_t)(tok0 + tk) * DM + d) = w; }
#pragma unroll
                    for (int q = 0; q < 4; ++q) { const float4 w0 = ww[q * 4 + 0], w1 = ww[q * 4 + 1], w2 = ww[q * 4 + 2], w3 = ww[q * 4 + 3];
#pragma unroll
                        for (int tk = 0; tk < 4; ++tk) { const float hq = hv[tk][q];
                            lg[tk][0] += hq * w0.x; lg[tk][1] += hq * w0.y; lg[tk][2] += hq * w0.z; lg[tk][3] += hq * w0.w; lg[tk][4] += hq * w1.x; lg[tk][5] += hq * w1.y; lg[tk][6] += hq * w1.z; lg[tk][7] += hq * w1.w;
                            lg[tk][8] += hq * w2.x; lg[tk][9] += hq * w2.y; lg[tk][10] += hq * w2.z; lg[tk][11] += hq * w2.w; lg[tk][12] += hq * w3.x; lg[tk][13] += hq * w3.y; lg[tk][14] += hq * w3.z; lg[tk][15] += hq * w3.w; } } }
#pragma unroll
                for (int tk = 0; tk < 4; ++tk) { float mx = -1e30f;
#pragma unroll
                    for (int e = 0; e < 16; ++e) { lg[tk][e] = wave_sum(lg[tk][e]); mx = fmaxf(mx, lg[tk][e]); }
                    float sm = 0.f;
#pragma unroll
                    for (int e = 0; e < 16; ++e) { lg[tk][e] = expf(lg[tk][e] - mx); sm += lg[tk][e]; }
                    const float inv = 1.0f / sm;
                    if (lane == 0) {
#pragma unroll
                        for (int e = 0; e < 16; e += 4) *(float4*)(PROBS + (size_t)(tok0 + tk) * 16 + e) = make_float4(lg[tk][e] * inv, lg[tk][e + 1] * inv, lg[tk][e + 2] * inv, lg[tk][e + 3] * inv); } }
            }
            SEAM(PB + 9);
        }
        if (IN(PB + 10)) for (int rep_ = 0; rep_ < PROBE_REPS(10); ++rep_) {
            PH_BEGIN
            const int nitems = 64 + (lastl ? 0 : 64);
            unsigned long long* keys = (unsigned long long*)shm;
            for (int it = bid; it < nitems; it += G) {
                const int set = it >> 6, e = it & 15, b = (it >> 4) & 3;
                const int n = set ? CTXL : SEQ, cap = set ? 32 : 512, tokbase = set ? NLAT + b * CTXL : b * SEQ;
                __syncthreads();
                for (int i = tid; i < n; i += NTHR) keys[i] = ((unsigned long long)__float_as_uint(PROBS[(size_t)(tokbase + i) * 16 + e]) << 32) | (unsigned long long)(0xFFFFFFFFu - (unsigned)i);
                __syncthreads();
                for (int k = 2; k <= n; k <<= 1)
                    for (int j = k >> 1; j > 0; j >>= 1) {
                        for (int p = tid; p < (n >> 1); p += NTHR) { const int i = ((p & ~(j - 1)) << 1) | (p & (j - 1)); const int m = i | j;
                            const unsigned long long ka = keys[i], kb = keys[m]; const bool desc = ((i & k) == 0);
                            if ((ka < kb) == desc) { keys[i] = kb; keys[m] = ka; } }
                        __syncthreads();
                    }
                for (int r = tid; r < cap; r += NTHR) { const unsigned long long kk = keys[r]; const int row = e * MOE_PAD + (set ? 2048 + b * 32 + r : b * 512 + r);
                    const int tk_ = tokbase + (int)(0xFFFFFFFFu - (unsigned)(kk & 0xFFFFFFFFull)); ROWTOK[row] = tk_; ROWGATE[row] = __uint_as_float((unsigned)(kk >> 32)); INV[tk_ * 16 + e] = row; }
                for (int rb = 0; rb < cap; rb += 32) {
                    u32x4 t4[4][4];
#pragma unroll
                    for (int q = 0; q < 4; ++q) { const int r = rb + wave + 8 * q; const int tok = tokbase + (int)(0xFFFFFFFFu - (unsigned)(keys[r] & 0xFFFFFFFFull));
                        const u32x4* sp = (const u32x4*)(HB + (size_t)tok * DM);
#pragma unroll
                        for (int i = 0; i < 4; ++i) t4[q][i] = sp[i * 64 + lane]; }
#pragma unroll
                    for (int q = 0; q < 4; ++q) { const int r = rb + wave + 8 * q; const int row = e * MOE_PAD + (set ? 2048 + b * 32 + r : b * 512 + r);
                        u32x4* dp = (u32x4*)(XG + (size_t)row * DM);
#pragma unroll
                        for (int i = 0; i < 4; ++i) dp[i * 64 + lane] = t4[q][i]; } }
            }
            if (!lastl && G > 128 && bid >= 128) {
                const int n_win = 32 * 55, n_br = 4 * 64, n_out = 32 * 8, n_glu = 16, n_gu = 16 * 2 * 192; (void)n_gu;
                CV_RUN(l + 1, bid - 128, G - 128, n_win); (void)n_br; (void)n_out; (void)n_glu;
            }
            {   const int pad0 = lastl ? 2048 : MOE_ROWS, npad = MOE_PAD - pad0;
                for (int R = bid * 8 + wave; R < NEXP * npad; R += G * 8) { const int e = R / npad, rr = pad0 + R % npad; u32x4* dp = (u32x4*)(XG + ((size_t)e * MOE_PAD + rr) * DM);
#pragma unroll
                    for (int i = 0; i < 4; ++i) dp[i * 64 + lane] = (u32x4){0u, 0u, 0u, 0u}; } }
            SEAM(PB + 10);
        }
        if (IN(PB + 12)) for (int rep_ = 0; rep_ < PROBE_REPS(12); ++rep_) {
            PH_BEGIN
            pg8::Gemm g{XG, WGU, DM, DM, DM}; pg8::SchedMoe S{lastl ? 8 : 9, 12, G, bid, DM, DM, 2 * DEXP}; pg8::EpiMoe1 E{HID};
            pg8::gemm_phase((LAS unsigned char*)shm, g, S, E);
            SEAM(PB + 12);
        }
        if (IN(PB + 13)) for (int rep_ = 0; rep_ < PROBE_REPS(13); ++rep_) {
            PH_BEGIN
            pg8::Gemm g{HID, WD, DEXP, DEXP, DEXP}; pg8::SchedMoe S{lastl ? 8 : 9, 8, G, bid, DEXP, DEXP, DM}; pg8::EpiMoeY E{YEXP};
            pg8::gemm_phase((LAS unsigned char*)shm, g, S, E);
            SEAM(PB + 13);
        }

}

__global__ __launch_bounds__(NTHR, 2) void fwd(Args a) {
    extern __shared__ __attribute__((aligned(16))) unsigned char shm[];
    const int bid = blockIdx.x, G = gridDim.x;
    float* const sf = (float*)shm;
    volatile LAS unsigned* xbw = (volatile LAS unsigned*)((LAS unsigned char*)shm + (LDS_BYTES - 16));
    if (threadIdx.x == 0) { xbw[0] = 0u; xbw[1] = 0u; xbw[2] = 0u; xbw[3] = 0u; }
    const float** const ptab = (const float**)(shm + (LDS_BYTES - 16 - 512));
    if (threadIdx.x == 0) {
#pragma unroll
        for (int i = 0; i < 47; ++i) ptab[i] = a.in[i]; }
    __syncthreads();
    XcdBarrier bar = xcd_barrier_post((unsigned*)(a.ws + O_BAR), xbw);
    const int lo = a.ph_lo, hi = a.ph_hi;
    if (IN(0)) {
        PH_BEGIN
        {
            __syncthreads();
            for (int i = tid; i < 5 * DM; i += NTHR) { const int r = i >> 11, k = i & (DM - 1); const float v = r < 4 ? c_in[r * DM + k] : cctx_in[k]; sf[i] = siluf_(v); }
            __syncthreads();
            float* red = sf + 5 * DM;
            for (int unit = bid; unit < 2 * 96; unit += G) { const int l = unit / 96, j = (unit % 96) * 128 + (tid & 127), kq = tid >> 7;
                const float* w = ada_w + (size_t)l * DM * (6 * DM) + (size_t)(kq * 512) * (6 * DM) + j; const float* sv = sf + kq * 512;
                float a0 = 0.f, a1 = 0.f, a2 = 0.f, a3 = 0.f, a4 = 0.f;
#pragma unroll 8
                for (int k = 0; k < 512; ++k) { const float wv = w[(size_t)k * (6 * DM)]; a0 += sv[k] * wv; a1 += sv[DM + k] * wv; a2 += sv[2 * DM + k] * wv; a3 += sv[3 * DM + k] * wv; a4 += sv[4 * DM + k] * wv; }
                __syncthreads();
                { float* rp = red + (kq * 5) * 128 + (tid & 127); rp[0] = a0; rp[128] = a1; rp[256] = a2; rp[384] = a3; rp[512] = a4; }
                __syncthreads();
                if (tid < 128) { const float bb = ada_b[l * 6 * DM + j]; float* o = MOD + (size_t)l * 5 * 6 * DM + j;
#pragma unroll
                    for (int r = 0; r < 5; ++r) o[(size_t)r * 6 * DM] = ((red[(0 * 5 + r) * 128 + tid] + red[(1 * 5 + r) * 128 + tid]) + (red[(2 * 5 + r) * 128 + tid] + red[(3 * 5 + r) * 128 + tid])) + bb; }
            }
        }
    }

    layer_body<0>(a, bar, lo, hi, bid, G, shm, sf, ptab);
    layer_body<1>(a, bar, lo, hi, bid, G, shm, sf, ptab);
    if (IN(33)) {
        PH_BEGIN
        const float* gn = PT(46);
        for (int tok = bid * 8 + wave; tok < NLAT; tok += G * 8) {
            const float* xr = XS + (size_t)tok * DM; float4 v[8]; float ss = 0.f;
#pragma unroll
            for (int i = 0; i < 8; ++i) v[i] = *(const float4*)(xr + i * 256 + lane * 4);
            moe_combine(v, tok, lane, INV, ROWGATE, YEXP, MOD + (size_t)(1 * 5 + tok / SEQ) * 6 * DM + 5 * DM);
#pragma unroll
            for (int i = 0; i < 8; ++i) {                 ss += v[i].x * v[i].x + v[i].y * v[i].y + v[i].z * v[i].z + v[i].w * v[i].w; }
            ss = wave_sum(ss); const float rs = rsqrtf(ss * (1.0f / DM) + 1e-6f);
#pragma unroll
            for (int i = 0; i < 8; ++i) { const int d = i * 256 + lane * 4; const float4 g4 = *(const float4*)(gn + d);
                *(float4*)(a.out + (size_t)tok * DM + d) = make_float4(v[i].x * rs * g4.x, v[i].y * rs * g4.y, v[i].z * rs * g4.z, v[i].w * rs * g4.w); }
        }
    }
#undef IN
#undef SEAM
}


extern "C" void kernel_launch(void* const* d_in, const int* in_sizes, int n_in, void* d_out, int out_size, void* d_ws, size_t ws_size, hipStream_t stream) {
    static int grid = 0;
    if (grid == 0) {
        if (n_in != 47 || ws_size < WS_END) { fprintf(stderr, "kernel_launch: expected 47 inputs and >= %zu bytes of workspace; got %d, %zu\n", (size_t)WS_END, n_in, ws_size); grid = -1; return; }
        int dev = 0, cus = 0;
        if (hipGetDevice(&dev) != hipSuccess || hipDeviceGetAttribute(&cus, hipDeviceAttributeMultiprocessorCount, dev) != hipSuccess) { grid = -1; return; }
        if (hipFuncSetAttribute((const void*)fwd, hipFuncAttributeMaxDynamicSharedMemorySize, LDS_BYTES) != hipSuccess) { fprintf(stderr, "kernel_launch: hipFuncSetAttribute failed\n"); grid = -1; return; }
        int per_cu = 0;
        if (hipOccupancyMaxActiveBlocksPerMultiprocessor(&per_cu, (const void*)fwd, NTHR, LDS_BYTES) != hipSuccess || per_cu < 1) fprintf(stderr, "kernel_launch: occupancy query reports %d\n", per_cu);
        (void)hipGetLastError();
        grid = cus > 256 ? 256 : cus;
        if (grid < 224) { fprintf(stderr, "kernel_launch: needs >= 224 CUs (got %d)\n", grid); grid = -1; return; }
    }
    if (grid < 0) return;
    (void)hipMemsetAsync((char*)d_ws, 0, O_ZERO_END, stream);
    Args a{};
    for (int i = 0; i < 47; ++i) a.in[i] = (const float*)d_in[i];
    a.out = (float*)d_out; a.ws = (unsigned char*)d_ws;
#if MK_ONE_LAUNCH
    a.ph_lo = 0; a.ph_hi = 64;
    hipLaunchKernelGGL(fwd, dim3(grid), dim3(NTHR), LDS_BYTES, stream, a);
#else
    const int ids[] = {0, 1,2,3,4,5,6,7,8,9,10,11,12,13,14, 17,18,19,20,21,22,23,24,25,26,27,28,29,30, 33};
    for (int k = 0; k < (int)(sizeof(ids) / sizeof(ids[0])); ++k) { a.ph_lo = ids[k]; a.ph_hi = ids[k] + 1; hipLaunchKernelGGL(fwd, dim3(grid), dim3(NTHR), LDS_BYTES, stream, a); }
#endif
}
```

```cpp
#include <hip/hip_runtime.h>
#include <stdint.h>
#include <stdio.h>

#ifndef PROBE_MASK
#define PROBE_MASK 0
#endif
#ifndef PROBE_SP
#define PROBE_SP 1
#endif
#define PROBE_REPS(k) ((((PROBE_MASK) >> (k)) & 1) + 1)
#ifndef MK_ONE_LAUNCH
#define MK_ONE_LAUNCH 1
#endif

#define DM 2048
#define NB 4
#define SEQ 4096
#define CTXL 256
#define BW 512
#define NLAT 16384
#define NCTX 1024
#define NTOK 17408
#define IN_W 13856
#define LDP 14080
#define HY_OFF 0
#define ML_OFF 1536
#define S5_OFF 3600
#define SSD_OFF 4112
#define GATE_OFF 5664
#define NEXP 16
#define DEXP 1536
#define MOE_ROWS 2176
#define MOE_PAD 2304
#define NTHR 512
#define LDS_BYTES 147456
#define LAS __attribute__((address_space(3)))

typedef unsigned short bf16_t;
typedef short bf16x8 __attribute__((ext_vector_type(8)));
typedef float f32x4 __attribute__((ext_vector_type(4)));
typedef unsigned u32x4 __attribute__((ext_vector_type(4)));
typedef unsigned u32x2 __attribute__((ext_vector_type(2)));

#define XB_TMO      128
#define XB_XCNT(j)  (256  + 64 * (j))
#define XB_XSUB(j)  (1280 + 64 * (j))
#define XB_XGEN(j)  (2304 + 64 * (j))
#define XB_TOP      3328
#define XB_TOPGEN   3392
#define XCD_BAR_WORDS 3456
#define XB_SPIN_CAP (1u << 18)
__device__ __forceinline__ unsigned xb_ld(unsigned* p)              { return __hip_atomic_load(p, __ATOMIC_RELAXED, __HIP_MEMORY_SCOPE_AGENT); }
__device__ __forceinline__ unsigned xb_add(unsigned* p, unsigned v) { return __hip_atomic_fetch_add(p, v, __ATOMIC_RELAXED, __HIP_MEMORY_SCOPE_AGENT); }
__device__ __forceinline__ unsigned xb_xcc_id() { return (unsigned)__builtin_amdgcn_s_getreg((3 << 11) | 20) & 0xFu; }
#define XB_SPIN(cond, bar) do { unsigned _sp = 0; while (cond) { __builtin_amdgcn_s_sleep(1); \
    if ((++_sp & 255u) == 0u) { if (xb_ld(&(bar)[XB_TMO])) break; if (_sp > XB_SPIN_CAP) { atomicAdd(&(bar)[XB_TMO], 1u); break; } } } } while (0)
struct XcdBarrier { unsigned* bar; unsigned x; volatile LAS unsigned* st; };
__device__ __forceinline__ XcdBarrier xcd_barrier_post(unsigned* bar, volatile LAS unsigned* st) {
    XcdBarrier b; b.bar = bar; b.x = xb_xcc_id(); b.st = st;
    if (threadIdx.x == 0) (void)xb_add(&bar[XB_XCNT(b.x)], 1u);
    return b;
}
__device__ __forceinline__ void xcd_barrier_complete(unsigned* bar, unsigned x, unsigned& nloc, unsigned& nx) {
    const unsigned G = gridDim.x * gridDim.y * gridDim.z;
    unsigned sum, cnt, mine, sp = 0u;
    for (;;) {
        sum = 0u; cnt = 0u; mine = 0u;
#pragma unroll
        for (unsigned j = 0; j < 16; ++j) { const unsigned c = xb_ld(&bar[XB_XCNT(j)]); sum += c; cnt += (c > 0u) ? 1u : 0u; mine = (j == x) ? c : mine; }
        if (sum == G) break;
        __builtin_amdgcn_s_sleep(1);
        if ((++sp & 255u) == 0u) { if (xb_ld(&bar[XB_TMO])) break; if (sp > XB_SPIN_CAP) { atomicAdd(&bar[XB_TMO], 1u); break; } }
    }
    nloc = mine > 0u ? mine : 1u; nx = cnt > 0u ? cnt : 1u;
}
__device__ __forceinline__ void xcd_barrier(const XcdBarrier& b) {
    asm volatile("s_waitcnt vmcnt(0)" ::: "memory");
    __syncthreads();
    if (threadIdx.x == 0) {
        unsigned* bar = b.bar;
        __builtin_amdgcn_s_waitcnt(0);
        unsigned nloc = b.st[0], nx = b.st[1];
        if (nloc == 0u) { xcd_barrier_complete(bar, b.x, nloc, nx); b.st[0] = nloc; b.st[1] = nx; }
        const unsigned old = xb_add(&bar[XB_XSUB(b.x)], 1u);
        const unsigned gen = old / nloc;
        if (old + 1u == (gen + 1u) * nloc) {
            __builtin_amdgcn_fence(__ATOMIC_RELEASE, "agent");
            asm volatile("s_waitcnt vmcnt(0)" ::: "memory");
            const unsigned og = xb_add(&bar[XB_TOP], 1u);
            const unsigned tg = og / nx;
            if (og + 1u == (tg + 1u) * nx) xb_add(&bar[XB_TOPGEN], 1u);
            else XB_SPIN(xb_ld(&bar[XB_TOPGEN]) == tg, bar);
            __builtin_amdgcn_fence(__ATOMIC_ACQUIRE, "agent");
            xb_add(&bar[XB_XGEN(b.x)], 1u);
            asm volatile("s_waitcnt vmcnt(0)" ::: "memory");
        } else {
            XB_SPIN(xb_ld(&bar[XB_XGEN(b.x)]) == gen, bar);
            __builtin_amdgcn_fence(__ATOMIC_ACQUIRE, "agent");
            asm volatile("s_waitcnt vmcnt(0)" ::: "memory");
        }
    }
    __syncthreads();
}

__device__ __forceinline__ unsigned short f2bf(float f) { unsigned u = __float_as_uint(f); u += 0x7FFFu + ((u >> 16) & 1u); return (unsigned short)(u >> 16); }
__device__ __forceinline__ float bf2f(unsigned short b) { return __uint_as_float(((unsigned)b) << 16); }
__device__ __forceinline__ unsigned pk2(float lo, float hi) { unsigned r; asm("v_cvt_pk_bf16_f32 %0, %1, %2" : "=v"(r) : "v"(lo), "v"(hi)); return r; }
__device__ __forceinline__ float sigmoidf_(float x) { return 1.0f / (1.0f + expf(-x)); }
__device__ __forceinline__ float siluf_(float x) { return x / (1.0f + expf(-x)); }
__device__ __forceinline__ float wave_sum(float v) {
#pragma unroll
    for (int o = 32; o >= 1; o >>= 1) v += __shfl_xor(v, o);
    return v;
}
__device__ __forceinline__ const float* uptr(const float* p) { const unsigned long long v = (unsigned long long)p;
    const unsigned lo = __builtin_amdgcn_readfirstlane((unsigned)v), hi = __builtin_amdgcn_readfirstlane((unsigned)(v >> 32)); return (const float*)(((unsigned long long)hi << 32) | lo); }
#define PT(k) uptr(ptab[k])
__device__ __forceinline__ int step_tok(int b, int dir, int i) {
    if (i < CTXL) { const int tt = dir ? (CTXL - 1 - i) : i; return NLAT + b * CTXL + tt; }
    const int j = i - CTXL; const int tt = dir ? (SEQ - 1 - j) : j; return b * SEQ + tt;
}
__device__ __forceinline__ void unpack8(const u32x4 w, float (&f)[8]) {
    f[0] = __uint_as_float(w.x << 16); f[1] = __uint_as_float(w.x & 0xFFFF0000u); f[2] = __uint_as_float(w.y << 16); f[3] = __uint_as_float(w.y & 0xFFFF0000u);
    f[4] = __uint_as_float(w.z << 16); f[5] = __uint_as_float(w.z & 0xFFFF0000u); f[6] = __uint_as_float(w.w << 16); f[7] = __uint_as_float(w.w & 0xFFFF0000u);
}

namespace pg8 {
constexpr int BM = 256, BK = 64, HALF = 128, HTB = HALF * BK * 2, STAGE_BYTES = 8 * HTB, NXCD = 8, WGM = 8;
__host__ __device__ __forceinline__ int lds_byte(int r, int c) { const int st = (r >> 4) * 2 + (c >> 5), rr = r & 15, cc = c & 31, ob = rr * 64 + cc * 2; return st * 1024 + (ob ^ (((ob >> 9) & 1) << 5)); }
__host__ __device__ __forceinline__ void stage_rc(int b, int& R, int& C) { const int st = b / 1024, sb = b % 1024, swz = sb ^ (((sb >> 9) & 1) << 5); R = (st >> 1) * 16 + swz / 64; C = (st & 1) * 32 + (swz % 64) / 2; }
__host__ __device__ __forceinline__ int perm32(int rho) { const int n = rho >> 4, i = rho & 15; return 8 * (i >> 2) + 4 * n + (i & 3); }
struct Unit { int pm, pn, z, k; long long ao, bo; };
struct Gemm { const bf16_t* A; const bf16_t* Bt; int lda, ldb, K; };

__device__ __forceinline__ void tile_of(int wgid, int nM, int nN, int& pm, int& pn) {
    const int nwg = nM * nN; { const int q = nwg / NXCD, r = nwg % NXCD, xcd = wgid % NXCD, off = wgid / NXCD; wgid = (xcd < r ? xcd * (q + 1) : r * (q + 1) + (xcd - r) * q) + off; }
    const int nig = WGM * nN, gid = wgid / nig, fm = gid * WGM, gsz = (nM - fm) < WGM ? (nM - fm) : WGM;
    pm = fm + ((wgid % nig) % gsz); pn = (wgid % nig) / gsz;
}
struct SchedStd {
    int nM, nN, G, c, lda, ldb;
    __device__ __forceinline__ bool next(int i, Unit& u) const { const long L = (long)i * G + c; if (L >= (long)nM * nN) return false; tile_of((int)L, nM, nN, u.pm, u.pn); u.z = 0; u.k = 0;
        u.ao = (long long)u.pm * BM * lda * 2; u.bo = (long long)u.pn * BM * ldb * 2; return true; }
    __device__ __forceinline__ void a_ready(const Unit&) const {}
    __device__ __forceinline__ void done(const Unit&) const {}
};
struct SchedBranch {
    int nM, nN, G, c;
    __device__ __forceinline__ bool next(int i, Unit& u) const { const long L = (long)(i >> 2) * G + c; if (L >= (long)nM * nN) return false; tile_of((int)L, nM, nN, u.pm, u.pn); u.z = 0; u.k = i & 3;
        u.ao = ((long long)u.pm * BM * DM + u.k * BW) * 2; u.bo = ((long long)u.k * DM + u.pn * BM) * BW * 2; return true; }
    __device__ __forceinline__ void a_ready(const Unit&) const {}
    __device__ __forceinline__ void done(const Unit&) const {}
};
struct SchedTail {
    int G, c;
    __device__ __forceinline__ bool next(int i, Unit& u) const { const long T = (long)i * G + c; if (T >= 128) return false; const int t = (int)(T >> 2); u.pm = 64 + (t >> 3); u.pn = t & 7; u.z = 1; u.k = (int)(T & 3);
        u.ao = ((long long)u.pm * BM * DM + u.k * BW) * 2; u.bo = ((long long)u.k * DM + u.pn * BM) * BW * 2; return true; }
    __device__ __forceinline__ void a_ready(const Unit&) const {}
    __device__ __forceinline__ void done(const Unit&) const {}
};
struct SchedTailK {
    int G, c;
    __device__ __forceinline__ bool next(int i, Unit& u) const { const long T = (long)i * G + c; if (T >= 128) return false; const int t = (int)(T >> 2); u.pm = 64 + (t >> 3); u.pn = t & 7; u.z = 1; u.k = (int)(T & 3);
        u.ao = ((long long)u.pm * BM * DM + u.k * 512) * 2; u.bo = ((long long)u.pn * BM * DM + u.k * 512) * 2; return true; }
    __device__ __forceinline__ void a_ready(const Unit&) const {}
    __device__ __forceinline__ void done(const Unit&) const {}
};
struct SchedMoe {
    int nPm, nPn, G, c, lda, ldb, nBrows;
    __device__ __forceinline__ bool next(int i, Unit& u) const { const long L = (long)i * G + c; const int per = nPm * nPn; if (L >= (long)NEXP * per) return false; const int e = (int)(L / per), rem = (int)(L % per);
        u.z = e; u.k = 0; u.pm = rem % nPm; u.pn = rem / nPm; u.ao = ((long long)e * MOE_PAD + u.pm * BM) * lda * 2; u.bo = ((long long)e * nBrows + u.pn * BM) * ldb * 2; return true; }
    __device__ __forceinline__ void a_ready(const Unit&) const {}
    __device__ __forceinline__ void done(const Unit&) const {}
};

typedef f32x4 Acc[2][2][4][2];
template <class Epi, class Sched>
__device__ __forceinline__ void gemm_phase(LAS unsigned char* lds, const Gemm g, const Sched& S, const Epi& E) {
    int tid = threadIdx.x; asm volatile("" : "+v"(tid));
    const int wid = __builtin_amdgcn_readfirstlane(tid >> 6), lane = tid & 63, wr = wid >> 2, wc = wid & 3, fr = lane & 15, fq = lane >> 4;
    const int K = g.K, nt = K / BK;
    unsigned voffA[2], voffB[2];
#pragma unroll
    for (int i = 0; i < 2; ++i) { int R, C; stage_rc(tid * 16 + i * 8192, R, C); const int Rb = Epi::PERM ? ((R & ~31) + perm32(R & 31)) : R;
        voffA[i] = (unsigned)(R * g.lda + C) * 2u; voffB[i] = (unsigned)(Rb * g.ldb + C) * 2u; }
    const size_t kstep = (size_t)(BK * 2);
    const size_t hstepA = (size_t)HALF * g.lda * 2, hstepB = (size_t)HALF * g.ldb * 2;
    const unsigned ldsw = (unsigned)wid * 1024u;
    const int aoff = lds_byte(wr * 64 + fr, fq * 8), boff = lds_byte(wc * 32 + fr, fq * 8);
#define PG8_SA(b, h) (((b) * 2 + (h)) * HTB)
#define PG8_SB(b, h) ((4 + (b) * 2 + (h)) * HTB)
#define PG8_STAGE(bufoff, gbase, voff) do { _Pragma("unroll") for (int _i = 0; _i < 2; ++_i) \
        __builtin_amdgcn_global_load_lds((const unsigned*)((const char*)(gbase) + (voff)[_i]), (LAS unsigned*)(lds + (bufoff) + ldsw + _i * 8192), 16, 0, 0); } while (0)
#define PG8_LDA(dst, b, h) do { _Pragma("unroll") for (int m = 0; m < 4; ++m) _Pragma("unroll") for (int k = 0; k < 2; ++k) dst[m][k] = *(const LAS bf16x8*)(lds + PG8_SA(b, h) + aoff + m * 2048 + k * 1024); } while (0)
#define PG8_LDB(dst, b, h) do { _Pragma("unroll") for (int n = 0; n < 2; ++n) _Pragma("unroll") for (int k = 0; k < 2; ++k) dst[n][k] = *(const LAS bf16x8*)(lds + PG8_SB(b, h) + boff + n * 2048 + k * 1024); } while (0)
#define PG8_MMA(ai, bj, At, Bt) do { __builtin_amdgcn_s_setprio(1); _Pragma("unroll") for (int m = 0; m < 4; ++m) _Pragma("unroll") for (int n = 0; n < 2; ++n) _Pragma("unroll") for (int k = 0; k < 2; ++k) \
        acc[ai][bj][m][n] = __builtin_amdgcn_mfma_f32_16x16x32_bf16(Bt[n][k], At[m][k], acc[ai][bj][m][n], 0, 0, 0); __builtin_amdgcn_s_setprio(0); } while (0)
#define PG8_WAIT_V(n) asm volatile("s_waitcnt vmcnt(" #n ")" ::: "memory")
#define PG8_WAIT_L(n) asm volatile("s_waitcnt lgkmcnt(" #n ")" ::: "memory")
#define PG8_BAR __builtin_amdgcn_s_barrier()
#define PG8_SCHED __builtin_amdgcn_sched_barrier(0)
    Unit cur, nxt; int ui = 0;
    if (!S.next(0, cur)) return;
    Acc acc;
#pragma unroll
    for (int a = 0; a < 2; ++a)
#pragma unroll
        for (int b = 0; b < 2; ++b)
#pragma unroll
            for (int m = 0; m < 4; ++m)
#pragma unroll
                for (int n = 0; n < 2; ++n) acc[a][b][m][n] = (f32x4){0.f, 0.f, 0.f, 0.f};
    bf16x8 At[4][2], B0[2][2], B1[2][2];
    const char* cA = (const char*)g.A + cur.ao; const char* cB = (const char*)g.Bt + cur.bo;
    S.a_ready(cur);
    PG8_STAGE(PG8_SB(0, 0), cB, voffB); PG8_STAGE(PG8_SA(0, 0), cA, voffA); PG8_STAGE(PG8_SB(0, 1), cB + hstepB, voffB); PG8_STAGE(PG8_SA(0, 1), cA + hstepA, voffA);
    if (wr == 1) PG8_BAR;
    PG8_WAIT_V(4); PG8_BAR;
    PG8_STAGE(PG8_SB(1, 0), cB + kstep, voffB); PG8_STAGE(PG8_SA(1, 0), cA + kstep, voffA); PG8_STAGE(PG8_SB(1, 1), cB + hstepB + kstep, voffB);
    PG8_WAIT_V(6); PG8_BAR;
    for (;;) {
        const bool has_next = S.next(ui + 1, nxt);
        const char* nA = has_next ? (const char*)g.A + nxt.ao : cA; const char* nB = has_next ? (const char*)g.Bt + nxt.bo : cB;
        for (int t = 0; t < nt; t += 2) {
            const bool last = (t == nt - 2);
            const char* a1 = cA + (size_t)(t + 1) * kstep;
            const char* a2 = last ? nA : cA + (size_t)(t + 2) * kstep; const char* b2 = last ? nB : cB + (size_t)(t + 2) * kstep;
            const char* a3 = a2 + kstep; const char* b3 = b2 + kstep;
            if (last && has_next) S.a_ready(nxt);
            PG8_LDB(B0, 0, 0); PG8_SCHED; PG8_LDA(At, 0, 0); PG8_STAGE(PG8_SA(1, 1), a1 + hstepA, voffA);
            PG8_WAIT_L(8); PG8_BAR; PG8_WAIT_L(0); PG8_MMA(0, 0, At, B0); PG8_BAR; PG8_SCHED;
            PG8_LDB(B1, 0, 1); PG8_STAGE(PG8_SB(0, 0), b2, voffB);
            PG8_BAR; PG8_WAIT_L(0); PG8_MMA(0, 1, At, B1); PG8_BAR;
            PG8_LDA(At, 0, 1); PG8_STAGE(PG8_SA(0, 0), a2, voffA);
            PG8_BAR; PG8_WAIT_L(0); PG8_MMA(1, 0, At, B0); PG8_BAR; PG8_SCHED;
            PG8_STAGE(PG8_SB(0, 1), b2 + hstepB, voffB);
            PG8_WAIT_V(6); PG8_BAR; PG8_MMA(1, 1, At, B1); PG8_BAR;
            PG8_LDB(B0, 1, 0); PG8_SCHED; PG8_LDA(At, 1, 0); PG8_STAGE(PG8_SA(0, 1), a2 + hstepA, voffA);
            PG8_WAIT_L(8); PG8_BAR; PG8_WAIT_L(0); PG8_MMA(0, 0, At, B0); PG8_BAR; PG8_SCHED;
            PG8_LDB(B1, 1, 1); PG8_STAGE(PG8_SB(1, 0), b3, voffB);
            PG8_BAR; PG8_WAIT_L(0); PG8_MMA(0, 1, At, B1); PG8_BAR;
            PG8_LDA(At, 1, 1); PG8_STAGE(PG8_SA(1, 0), a3, voffA);
            PG8_BAR; PG8_WAIT_L(0); PG8_MMA(1, 0, At, B0); PG8_BAR; PG8_SCHED;
            PG8_STAGE(PG8_SB(1, 1), b3 + hstepB, voffB);
            PG8_WAIT_V(6); PG8_BAR; PG8_MMA(1, 1, At, B1); PG8_BAR;
        }
        const bool keep = E(acc, cur, wr, wc, fr, fq); S.done(cur);
        if (!has_next) break;
        if (!keep) {
#pragma unroll
        for (int a = 0; a < 2; ++a)
#pragma unroll
            for (int b = 0; b < 2; ++b)
#pragma unroll
                for (int m = 0; m < 4; ++m)
#pragma unroll
                    for (int n = 0; n < 2; ++n) acc[a][b][m][n] = (f32x4){0.f, 0.f, 0.f, 0.f};
        }
        cur = nxt; cA = nA; cB = nB; ++ui;
    }
    PG8_WAIT_V(0);
    if (wr == 0) PG8_BAR;
    PG8_BAR;
#undef PG8_SA
#undef PG8_SB
#undef PG8_STAGE
#undef PG8_LDA
#undef PG8_LDB
#undef PG8_MMA
#undef PG8_WAIT_V
#undef PG8_WAIT_L
#undef PG8_BAR
#undef PG8_SCHED
}

struct EpiBf16Store {
    static constexpr bool PERM = true;
    bf16_t* O; int ldc;
    __device__ __forceinline__ bool operator()(Acc& acc, const Unit& u, int wr, int wc, int fr, int fq) const {
        const int row0 = u.pm * BM + wr * 64 + fr, col0 = u.pn * BM + wc * 32 + 8 * fq;
#pragma unroll
        for (int ai = 0; ai < 2; ++ai)
#pragma unroll
            for (int m = 0; m < 4; ++m) { bf16_t* rowp = O + (size_t)(row0 + ai * HALF + m * 16) * ldc + col0;
#pragma unroll
                for (int bj = 0; bj < 2; ++bj) { const f32x4 v0 = acc[ai][bj][m][0], v1 = acc[ai][bj][m][1];
                    u32x4 w; w.x = pk2(v0[0], v0[1]); w.y = pk2(v0[2], v0[3]); w.z = pk2(v1[0], v1[1]); w.w = pk2(v1[2], v1[3]);
                    *(u32x4*)(rowp + bj * HALF) = w; } }
        return false;
    }
};
struct EpiWin {
    static constexpr bool PERM = true;
    bf16_t* O; int ldc;
    __device__ __forceinline__ bool operator()(Acc& acc, const Unit& u, int wr, int wc, int fr, int fq) const {
        const int row0 = u.pm * BM + wr * 64 + fr, col0 = u.pn * BM + wc * 32 + 8 * fq;
#pragma unroll
        for (int bj = 0; bj < 2; ++bj) { const bool gate = (col0 + bj * HALF) >= GATE_OFF;
#pragma unroll
            for (int ai = 0; ai < 2; ++ai)
#pragma unroll
                for (int m = 0; m < 4; ++m) { f32x4 v0 = acc[ai][bj][m][0], v1 = acc[ai][bj][m][1];
                    if (gate) {
#pragma unroll
                        for (int j = 0; j < 4; ++j) { v0[j] = __builtin_amdgcn_rcpf(1.0f + __expf(-v0[j])); v1[j] = __builtin_amdgcn_rcpf(1.0f + __expf(-v1[j])); } }
                    u32x4 w; w.x = pk2(v0[0], v0[1]); w.y = pk2(v0[2], v0[3]); w.z = pk2(v1[0], v1[1]); w.w = pk2(v1[2], v1[3]);
                    *(u32x4*)(O + (size_t)(row0 + ai * HALF + m * 16) * ldc + col0 + bj * HALF) = w; } }
        return false;
    }
};
struct EpiNone { static constexpr bool PERM = true;
    __device__ __forceinline__ bool operator()(Acc& acc, const Unit&, int, int, int, int) const {
#pragma unroll
        for (int a = 0; a < 2; ++a)
#pragma unroll
            for (int b = 0; b < 2; ++b)
#pragma unroll
                for (int m = 0; m < 4; ++m)
#pragma unroll
                    for (int n = 0; n < 2; ++n) asm volatile("" :: "v"(acc[a][b][m][n]));
        return false; } };
struct EpiGlu {
    static constexpr bool PERM = true;
    const bf16_t* GG; const float* bias; bf16_t* Y4;
    __device__ __forceinline__ bool operator()(Acc& acc, const Unit& u, int wr, int wc, int fr, int fq) const {
        const int row0 = u.pm * BM + wr * 64 + fr, col0 = u.pn * BM + wc * 32 + 8 * fq;
#pragma unroll
        for (int bj = 0; bj < 2; ++bj) { const int col = col0 + bj * HALF; const f32x4 b0 = *(const f32x4*)(bias + col), b1 = *(const f32x4*)(bias + col + 4);
            u32x4 gq[2][4];
#pragma unroll
            for (int ai = 0; ai < 2; ++ai)
#pragma unroll
                for (int m = 0; m < 4; ++m) gq[ai][m] = *(const u32x4*)(GG + (size_t)(row0 + ai * HALF + m * 16) * BW + col);
#pragma unroll
            for (int ai = 0; ai < 2; ++ai)
#pragma unroll
                for (int m = 0; m < 4; ++m) { const size_t row = (size_t)(row0 + ai * HALF + m * 16);
                    float gg[8]; unpack8(gq[ai][m], gg);
                    const f32x4 v0 = acc[ai][bj][m][0] + b0, v1 = acc[ai][bj][m][1] + b1;
                    u32x4 w; w.x = pk2(gg[0] * sigmoidf_(v0[0]), gg[1] * sigmoidf_(v0[1])); w.y = pk2(gg[2] * sigmoidf_(v0[2]), gg[3] * sigmoidf_(v0[3]));
                    w.z = pk2(gg[4] * sigmoidf_(v1[0]), gg[5] * sigmoidf_(v1[1])); w.w = pk2(gg[6] * sigmoidf_(v1[2]), gg[7] * sigmoidf_(v1[3]));
                    *(u32x4*)(Y4 + row * DM + 1024 + col) = w; } }
        return false;
    }
};
struct EpiBranch {
    static constexpr bool PERM = true;
    const bf16_t* P; bf16_t* ACCb;
    __device__ __forceinline__ bool operator()(Acc& acc, const Unit& u, int wr, int wc, int fr, int fq) const {
        const int row0 = u.pm * BM + wr * 64 + fr, col0 = u.pn * BM + wc * 32 + 8 * fq; const int k = u.k;
        const bf16_t* gbase = P + (size_t)row0 * LDP + GATE_OFF + k * DM + col0;
        if (k < 3) {
#pragma unroll
            for (int ai = 0; ai < 2; ++ai) {
                u32x4 ga[8], gb[8];
#pragma unroll
                for (int m = 0; m < 4; ++m)
#pragma unroll
                    for (int bj = 0; bj < 2; ++bj) { const bf16_t* p = gbase + (size_t)(ai * HALF + m * 16) * LDP + bj * HALF; ga[m * 2 + bj] = *(const u32x4*)p; gb[m * 2 + bj] = *(const u32x4*)(p + DM); }
#pragma unroll
                for (int m = 0; m < 4; ++m)
#pragma unroll
                    for (int bj = 0; bj < 2; ++bj) { float g0[8], g1[8]; unpack8(ga[m * 2 + bj], g0); unpack8(gb[m * 2 + bj], g1);
                        float s[8];
#pragma unroll
                        for (int j = 0; j < 8; ++j) s[j] = g0[j] * __builtin_amdgcn_rcpf(g1[j]);
                        f32x4 v0 = acc[ai][bj][m][0], v1 = acc[ai][bj][m][1];
                        v0[0] *= s[0]; v0[1] *= s[1]; v0[2] *= s[2]; v0[3] *= s[3]; v1[0] *= s[4]; v1[1] *= s[5]; v1[2] *= s[6]; v1[3] *= s[7];
                        acc[ai][bj][m][0] = v0; acc[ai][bj][m][1] = v1; } }
            return true;
        }
#pragma unroll
        for (int ai = 0; ai < 2; ++ai) {
            u32x4 ga[8];
#pragma unroll
            for (int m = 0; m < 4; ++m)
#pragma unroll
                for (int bj = 0; bj < 2; ++bj) ga[m * 2 + bj] = *(const u32x4*)(gbase + (size_t)(ai * HALF + m * 16) * LDP + bj * HALF);
#pragma unroll
            for (int m = 0; m < 4; ++m)
#pragma unroll
                for (int bj = 0; bj < 2; ++bj) { float s[8]; unpack8(ga[m * 2 + bj], s);
                    f32x4 v0 = acc[ai][bj][m][0], v1 = acc[ai][bj][m][1];
                    v0[0] *= s[0]; v0[1] *= s[1]; v0[2] *= s[2]; v0[3] *= s[3]; v1[0] *= s[4]; v1[1] *= s[5]; v1[2] *= s[6]; v1[3] *= s[7];
                    u32x4 w; w.x = pk2(v0[0], v0[1]); w.y = pk2(v0[2], v0[3]); w.z = pk2(v1[0], v1[1]); w.w = pk2(v1[2], v1[3]);
                    *(u32x4*)(ACCb + (size_t)(row0 + ai * HALF + m * 16) * DM + col0 + bj * HALF) = w; } }
        return false;
    }
};
struct EpiPart {
    static constexpr bool PERM = true;
    const bf16_t* P; float* PART;
    __device__ __forceinline__ bool operator()(Acc& acc, const Unit& u, int wr, int wc, int fr, int fq) const {
        const int row0 = u.pm * BM + wr * 64 + fr, col0 = u.pn * BM + wc * 32 + 8 * fq; const int k = u.k;
        const bf16_t* gbase = P + (size_t)row0 * LDP + GATE_OFF + k * DM + col0;
        float* pbase = PART + ((size_t)k * (NTOK - NLAT) + (size_t)(row0 - NLAT)) * DM + col0;
#pragma unroll
        for (int ai = 0; ai < 2; ++ai) {
            u32x4 ga[8];
#pragma unroll
            for (int m = 0; m < 4; ++m)
#pragma unroll
                for (int bj = 0; bj < 2; ++bj) ga[m * 2 + bj] = *(const u32x4*)(gbase + (size_t)(ai * HALF + m * 16) * LDP + bj * HALF);
#pragma unroll
            for (int m = 0; m < 4; ++m)
#pragma unroll
                for (int bj = 0; bj < 2; ++bj) { float sg[8]; unpack8(ga[m * 2 + bj], sg);
                    f32x4 v0 = acc[ai][bj][m][0], v1 = acc[ai][bj][m][1];
                    v0[0] *= sg[0]; v0[1] *= sg[1]; v0[2] *= sg[2]; v0[3] *= sg[3]; v1[0] *= sg[4]; v1[1] *= sg[5]; v1[2] *= sg[6]; v1[3] *= sg[7];
                    float* pp = pbase + (size_t)(ai * HALF + m * 16) * DM + bj * HALF;
                    *(f32x4*)pp = v0; *(f32x4*)(pp + 4) = v1; } }
        return false;
    }
};
struct EpiPartK {
    static constexpr bool PERM = true;
    float* PART;
    __device__ __forceinline__ bool operator()(Acc& acc, const Unit& u, int wr, int wc, int fr, int fq) const {
        const int row0 = u.pm * BM + wr * 64 + fr, col0 = u.pn * BM + wc * 32 + 8 * fq;
        float* pbase = PART + ((size_t)u.k * (NTOK - NLAT) + (size_t)(row0 - NLAT)) * DM + col0;
#pragma unroll
        for (int ai = 0; ai < 2; ++ai)
#pragma unroll
            for (int m = 0; m < 4; ++m)
#pragma unroll
                for (int bj = 0; bj < 2; ++bj) { float* pp = pbase + (size_t)(ai * HALF + m * 16) * DM + bj * HALF; *(f32x4*)pp = acc[ai][bj][m][0]; *(f32x4*)(pp + 4) = acc[ai][bj][m][1]; }
        return false;
    }
};
struct EpiResid {
    static constexpr bool PERM = false;
    float* XS; const float* srcLat; const float* srcCtx; const float* MODl; int gidx;
    __device__ __forceinline__ bool operator()(Acc& acc, const Unit& u, int wr, int wc, int fr, int fq) const {
        const int row0 = u.pm * BM + wr * 64 + fr, col0 = u.pn * BM + wc * 32 + 4 * fq;
        const int r = (u.pm * BM) < NLAT ? (u.pm * BM) / SEQ : 4;
        const float* src = (u.pm * BM) < NLAT ? srcLat : srcCtx;
        const float* mg = MODl + (size_t)(r * 6 + gidx) * DM;
#pragma unroll
        for (int bj = 0; bj < 2; ++bj) {
            f32x4 gm[2], xs[2][2][4];
#pragma unroll
            for (int n = 0; n < 2; ++n) { const int col = col0 + bj * HALF + n * 16; gm[n] = *(const f32x4*)(mg + col);
#pragma unroll
                for (int ai = 0; ai < 2; ++ai)
#pragma unroll
                    for (int m = 0; m < 4; ++m) xs[n][ai][m] = *(const f32x4*)(src + (size_t)(row0 + ai * HALF + m * 16) * DM + col); }
#pragma unroll
            for (int n = 0; n < 2; ++n) { const int col = col0 + bj * HALF + n * 16;
#pragma unroll
                for (int ai = 0; ai < 2; ++ai)
#pragma unroll
                    for (int m = 0; m < 4; ++m) *(f32x4*)(XS + (size_t)(row0 + ai * HALF + m * 16) * DM + col) = xs[n][ai][m] + gm[n] * acc[ai][bj][m][n]; } }
        return false;
    }
};
struct EpiMoe1 {
    static constexpr bool PERM = true;
    bf16_t* HID;
    __device__ __forceinline__ bool operator()(Acc& acc, const Unit& u, int wr, int wc, int fr, int fq) const {
        const size_t row0 = (size_t)u.z * MOE_PAD + u.pm * BM + wr * 64 + fr; const int col0 = u.pn * HALF + wc * 32 + 8 * fq;
#pragma unroll
        for (int ai = 0; ai < 2; ++ai)
#pragma unroll
            for (int m = 0; m < 4; ++m) { const f32x4 g0 = acc[ai][0][m][0], g1 = acc[ai][0][m][1], u0 = acc[ai][1][m][0], u1 = acc[ai][1][m][1];
                float h[8];
#pragma unroll
                for (int j = 0; j < 4; ++j) { h[j] = g0[j] * __builtin_amdgcn_rcpf(1.0f + __expf(-g0[j])) * u0[j]; h[4 + j] = g1[j] * __builtin_amdgcn_rcpf(1.0f + __expf(-g1[j])) * u1[j]; }
                u32x4 w; w.x = pk2(h[0], h[1]); w.y = pk2(h[2], h[3]); w.z = pk2(h[4], h[5]); w.w = pk2(h[6], h[7]);
                *(u32x4*)(HID + (row0 + ai * HALF + m * 16) * DEXP + col0) = w; }
        return false;
    }
};
struct EpiMoeY {
    static constexpr bool PERM = true;
    bf16_t* O;
    __device__ __forceinline__ bool operator()(Acc& acc, const Unit& u, int wr, int wc, int fr, int fq) const {
        const size_t row0 = (size_t)u.z * MOE_PAD + u.pm * BM + wr * 64 + fr; const int col0 = u.pn * BM + wc * 32 + 8 * fq;
#pragma unroll
        for (int ai = 0; ai < 2; ++ai)
#pragma unroll
            for (int m = 0; m < 4; ++m) { bf16_t* rowp = O + (row0 + ai * HALF + m * 16) * DM + col0;
#pragma unroll
                for (int bj = 0; bj < 2; ++bj) { const f32x4 v0 = acc[ai][bj][m][0], v1 = acc[ai][bj][m][1];
                    u32x4 w; w.x = pk2(v0[0], v0[1]); w.y = pk2(v0[2], v0[3]); w.z = pk2(v1[0], v1[1]); w.w = pk2(v1[2], v1[3]);
                    *(u32x4*)(rowp + bj * HALF) = w; } }
        return false;
    }
};

struct SchedS5a {
    int c;
    __device__ __forceinline__ bool next(int i, Unit& u) const { if (i > 0 || c >= 64) return false; u.z = c >> 1; u.pm = c & 1; u.pn = 0; u.k = 0;
        u.ao = ((long long)u.z * 512 + u.pm * BM) * 768 * 2; u.bo = (long long)u.z * 256 * 512 * 2; return true; }
    __device__ __forceinline__ void a_ready(const Unit&) const {}
    __device__ __forceinline__ void done(const Unit&) const {}
};
struct SchedS5b {
    int c;
    __device__ __forceinline__ bool next(int i, Unit& u) const { if (i > 0 || c >= 128) return false; u.z = c >> 2; u.pm = (c >> 1) & 1; u.pn = c & 1; u.k = 0;
        u.ao = ((long long)u.z * 512 + u.pm * BM) * 768 * 2; u.bo = ((long long)u.z * 512 + u.pn * BM) * 768 * 2; return true; }
    __device__ __forceinline__ void a_ready(const Unit&) const {}
    __device__ __forceinline__ void done(const Unit&) const {}
};
struct EpiXloc {
    static constexpr bool PERM = false;
    float* XL;
    __device__ __forceinline__ bool operator()(Acc& acc, const Unit& u, int wr, int wc, int fr, int fq) const {
        const int row0 = u.pm * BM + wr * 64 + fr, col0 = wc * 32 + 4 * fq; float* base = XL + (size_t)u.z * 512 * 256;
#pragma unroll
        for (int ai = 0; ai < 2; ++ai)
#pragma unroll
            for (int m = 0; m < 4; ++m) { float* rowp = base + (size_t)(row0 + ai * HALF + m * 16) * 256 + col0;
#pragma unroll
                for (int bj = 0; bj < 2; ++bj)
#pragma unroll
                    for (int n = 0; n < 2; ++n) *(f32x4*)(rowp + bj * HALF + n * 16) = acc[ai][bj][m][n]; }
        return false;
    }
};
struct EpiS5Out {
    static constexpr bool PERM = true;
    const bf16_t* P; const float* dskip; bf16_t* GG;
    __device__ __forceinline__ bool operator()(Acc& acc, const Unit& u, int wr, int wc, int fr, int fq) const {
        const int row0 = u.pm * BM + wr * 64 + fr, col0 = u.pn * BM + wc * 32 + 8 * fq; const int g = u.z;
#pragma unroll
        for (int bj = 0; bj < 2; ++bj) { const int col = col0 + bj * HALF; const int t = col >> 4, c0 = col & 15;
            const f32x4 d0 = *(const f32x4*)(dskip + g * 16 + c0), d1 = *(const f32x4*)(dskip + g * 16 + c0 + 4);
            u32x4 uq[2][4];
#pragma unroll
            for (int ai = 0; ai < 2; ++ai)
#pragma unroll
                for (int m = 0; m < 4; ++m) uq[ai][m] = *(const u32x4*)(P + ((size_t)(row0 + ai * HALF + m * 16) * 32 + t) * LDP + S5_OFF + g * 16 + c0);
#pragma unroll
            for (int ai = 0; ai < 2; ++ai)
#pragma unroll
                for (int m = 0; m < 4; ++m) { const size_t tok = (size_t)(row0 + ai * HALF + m * 16) * 32 + t;
                    float uu[8]; unpack8(uq[ai][m], uu);
                    const f32x4 v0 = acc[ai][bj][m][0], v1 = acc[ai][bj][m][1];
                    float y[8] = {v0[0] + d0[0] * uu[0], v0[1] + d0[1] * uu[1], v0[2] + d0[2] * uu[2], v0[3] + d0[3] * uu[3], v1[0] + d1[0] * uu[4], v1[1] + d1[1] * uu[5], v1[2] + d1[2] * uu[6], v1[3] + d1[3] * uu[7]};
#pragma unroll
                    for (int j = 0; j < 8; ++j) y[j] = 0.5f * y[j] * (1.0f + tanhf(0.7978845608028654f * (y[j] + 0.044715f * y[j] * y[j] * y[j])));
                    u32x4 w; w.x = pk2(y[0], y[1]); w.y = pk2(y[2], y[3]); w.z = pk2(y[4], y[5]); w.w = pk2(y[6], y[7]);
                    *(u32x4*)(GG + tok * BW + g * 16 + c0) = w; } }
        return false;
    }
};
}


__device__ __forceinline__ float wave_scan_incl(float v, int lane) {
#pragma unroll
    for (int o = 1; o < 64; o <<= 1) { const float t = __shfl_up(v, o); if (lane >= o) v += t; }
    return v;
}
__device__ __forceinline__ float wave_scanmax_incl(float v, int lane) {
#pragma unroll
    for (int o = 1; o < 64; o <<= 1) { const float t = __shfl_up(v, o); if (lane >= o) v = fmaxf(v, t); }
    return v;
}
__device__ __forceinline__ float wave_max(float v) {
#pragma unroll
    for (int o = 32; o >= 1; o >>= 1) v = fmaxf(v, __shfl_xor(v, o));
    return v;
}
__device__ __forceinline__ void unpack8h(const u32x4 w, bf16_t (&h)[8]) {
    h[0] = (bf16_t)(w.x & 0xFFFFu); h[1] = (bf16_t)(w.x >> 16); h[2] = (bf16_t)(w.y & 0xFFFFu); h[3] = (bf16_t)(w.y >> 16);
    h[4] = (bf16_t)(w.z & 0xFFFFu); h[5] = (bf16_t)(w.z >> 16); h[6] = (bf16_t)(w.w & 0xFFFFu); h[7] = (bf16_t)(w.w >> 16);
}

__device__ __forceinline__ int tokblock_of(int b, int dir, int c) { if (c < 4) return 256 + b * 4 + (dir ? 3 - c : c); const int j = c - 4; return b * 64 + (dir ? 63 - j : j); }
__device__ __forceinline__ u32x4 rev8h(const u32x4 v) { u32x4 r; r.x = (v.w >> 16) | (v.w << 16); r.y = (v.z >> 16) | (v.z << 16); r.z = (v.y >> 16) | (v.y << 16); r.w = (v.x >> 16) | (v.x << 16); return r; }
__device__ __forceinline__ u32x4 scale8h(const u32x4 v, const float4 a, const float4 b) { float f[8]; unpack8(v, f); u32x4 r; r.x = pk2(f[0] * a.x, f[1] * a.y); r.y = pk2(f[2] * a.z, f[3] * a.w); r.z = pk2(f[4] * b.x, f[5] * b.y); r.w = pk2(f[6] * b.z, f[7] * b.w); return r; }
__device__ __forceinline__ float dot8h(const u32x4 v, const float4 a, const float4 b) { float f[8]; unpack8(v, f); return (f[0] * a.x + f[1] * a.y) + (f[2] * a.z + f[3] * a.w) + (f[4] * b.x + f[5] * b.y) + (f[6] * b.z + f[7] * b.w); }
#define ML_FRAG_LOAD(KF, VF, cc_) do { const int tb_ = tokblock_of(b, dir, (cc_)); const bf16_t* kb_ = KTg + ((size_t)tb_ * 512 + h * 128 + 32 * wd + r16) * 64 + q4 * 8; const bf16_t* vb_ = VTg + ((size_t)tb_ * 512 + h * 128 + 64 * half + 32 * we + r16) * 64 + q4 * 8; \
        _Pragma("unroll") for (int ks_ = 0; ks_ < 2; ++ks_) _Pragma("unroll") for (int j_ = 0; j_ < 2; ++j_) { VF[j_][ks_] = *(const u32x4*)(vb_ + (size_t)j_ * 16 * 64 + ks_ * 32); KF[j_][ks_] = *(const u32x4*)(kb_ + (size_t)j_ * 16 * 64 + ks_ * 32); } } while (0)
#define ML_CHUNK(c_, KF, VF, KFN, VFN) do { const int c = (c_); \
        if (c + 1 < 68) ML_FRAG_LOAD(KFN, VFN, c + 1);                        \
        const float dec = sDEC[c]; \
        {   bf16_t* cs = CST + (size_t)(chain * 68 + c) * 128 * 128; \
            _Pragma("unroll") for (int je = 0; je < 2; ++je) _Pragma("unroll") for (int jd = 0; jd < 2; ++jd) { const int e = 64 * half + 32 * we + 16 * je + r16, d0 = 32 * wd + 16 * jd + q4 * 4; \
                u32x2 pk; pk.x = pk2(acc[je][jd][0], acc[je][jd][1]); pk.y = pk2(acc[je][jd][2], acc[je][jd][3]); *(u32x2*)(cs + (size_t)e * 128 + d0) = pk; } \
            if (nown) { _Pragma("unroll") for (int jd = 0; jd < 2; ++jd) { float nv = npart[jd]; nv += __shfl_xor(nv, 16); nv += __shfl_xor(nv, 32); if (q4 == 0) NST[(size_t)(chain * 68 + c) * 128 + 32 * wd + 16 * jd + r16] = nv; } } } \
        bf16x8 vfr[2][2]; \
        _Pragma("unroll") for (int ks = 0; ks < 2; ++ks) { const float4 wa = *(const float4*)(sWS + c * 64 + ks * 32 + q4 * 8), wb = *(const float4*)(sWS + c * 64 + ks * 32 + q4 * 8 + 4); \
            _Pragma("unroll") for (int je = 0; je < 2; ++je) { const u32x4 sv = scale8h(VF[je][ks], wa, wb); vfr[je][ks] = *(const bf16x8*)&sv; } \
            if (nown) { _Pragma("unroll") for (int jd = 0; jd < 2; ++jd) npart[jd] = (ks == 0 ? dec * npart[jd] : npart[jd]) + dot8h(KF[jd][ks], wa, wb); } } \
        _Pragma("unroll") for (int je = 0; je < 2; ++je) _Pragma("unroll") for (int jd = 0; jd < 2; ++jd) acc[je][jd] = acc[je][jd] * dec; \
        _Pragma("unroll") for (int ks = 0; ks < 2; ++ks) _Pragma("unroll") for (int je = 0; je < 2; ++je) _Pragma("unroll") for (int jd = 0; jd < 2; ++jd) \
            acc[je][jd] = __builtin_amdgcn_mfma_f32_16x16x32_bf16(*(const bf16x8*)&KF[jd][ks], vfr[je][ks], acc[je][jd], 0, 0, 0); } while (0)
__device__ __forceinline__ void mlstm_state_pass(const int chain, const int half, const bf16_t* __restrict__ Pm, const bf16_t* __restrict__ KTg, const bf16_t* __restrict__ VTg, const float* __restrict__ gate_b,
                                                 bf16_t* __restrict__ CST, float* __restrict__ NST, float* __restrict__ MST, unsigned char* shm, const int tid) {
    const int dir = chain & 1, h = (chain >> 1) & 3, b = chain >> 3, lane = tid & 63, w = tid >> 6, we = w >> 2, wd = w & 3, q4 = lane >> 4, r16 = lane & 15;
    const bool nown = (half == 0) && (we == 0);
    float* sE = (float*)shm; float* sWS = sE + 68 * 64; float* sAL = sWS + 68 * 64; float* sBE = sAL + 68; float* sMO = sBE + 68; float* sDEC = sMO + 68; float* sMB = sDEC + 68;
    const float gbi = gate_b[(dir * 2 + 0) * 4 + h], gbf = gate_b[(dir * 2 + 1) * 4 + h];
    const int gcol_i = ML_OFF + 2048 + (dir * 2 + 0) * 4 + h, gcol_f = ML_OFF + 2048 + (dir * 2 + 1) * 4 + h;
    u32x4 kfA[2][2], vfA[2][2], kfB[2][2], vfB[2][2];
    ML_FRAG_LOAD(kfA, vfA, 0);
    __syncthreads();
    unsigned gi_[9], gf_[9];
#pragma unroll
    for (int q = 0; q < 9; ++q) { const int c = min(w + 8 * q, 67); const size_t tokl = (size_t)step_tok(b, dir, c * 64 + lane); gi_[q] = Pm[tokl * LDP + gcol_i]; gf_[q] = Pm[tokl * LDP + gcol_f]; }
#pragma unroll
    for (int q = 0; q < 9; ++q) { const int c = w + 8 * q; if (c >= 68) break;
        const float ig = __uint_as_float(gi_[q] << 16) + gbi, fg = __uint_as_float(gf_[q] << 16) + gbf;
        const float lf = fminf(fg, 0.f) - log1pf(expf(-fabsf(fg)));
        const float bcs = wave_scan_incl(lf, lane); const float blast = __shfl(bcs, 63); const float ei = blast - bcs + ig; const float beta = wave_max(ei);
        sE[c * 64 + lane] = ei; if (lane == 0) { sAL[c] = blast; sBE[c] = beta; } }
    __syncthreads();
    if (tid == 0) { float m = 0.f; for (int c = 0; c < 68; ++c) { sMB[c] = m; const float mo = fmaxf(m + sAL[c], sBE[c]); sDEC[c] = expf(sAL[c] + m - mo); sMO[c] = mo; m = mo; } }
    __syncthreads();
    for (int idx = tid; idx < 68 * 64; idx += NTHR) { const int c = idx >> 6, i = idx & 63; sWS[c * 64 + (dir ? 63 - i : i)] = expf(sE[idx] - sMO[c]); }
    if (half == 0 && tid < 68) MST[chain * 68 + tid] = sMB[tid];
    __syncthreads();
    f32x4 acc[2][2];
#pragma unroll
    for (int je = 0; je < 2; ++je)
#pragma unroll
        for (int jd = 0; jd < 2; ++jd) acc[je][jd] = (f32x4){0.f, 0.f, 0.f, 0.f};
    float npart[2] = {0.f, 0.f};
    for (int c2 = 0; c2 < 68; c2 += 2) { ML_CHUNK(c2, kfA, vfA, kfB, vfB); ML_CHUNK(c2 + 1, kfB, vfB, kfA, vfA); }
    __syncthreads();
}
#undef ML_CHUNK
#undef ML_FRAG_LOAD
__device__ __forceinline__ void mlstm_out_item(const int chain, const int c, const bf16_t* __restrict__ Pm, const bf16_t* __restrict__ QKb, const bf16_t* __restrict__ VTg, const float* __restrict__ gate_b,
                                               const bf16_t* __restrict__ CST, const float* __restrict__ NST, const float* __restrict__ MST, float* __restrict__ Hout, unsigned char* shm, const int tid) {
    const int dir = chain & 1, h = (chain >> 1) & 3, b = chain >> 3, lane = tid & 63, w = tid >> 6;
    bf16_t* Qs = (bf16_t*)shm; bf16_t* Ks = (bf16_t*)(shm + 17408); bf16_t* VT = (bf16_t*)(shm + 34816); bf16_t* Cs = (bf16_t*)(shm + 53248); bf16_t* Ss = (bf16_t*)(shm + 88064);
    float* sc = (float*)(shm + 97280);
    __syncthreads();
#pragma unroll
    for (int i = 0; i < 2; ++i) { const int pid = tid + i * 512; const int s = pid >> 4, x0 = (pid & 15) * 8; const size_t toks = (size_t)step_tok(b, dir, c * 64 + s);
        *(u32x4*)(Qs + s * 136 + x0) = *(const u32x4*)(QKb + toks * 1024 + h * 128 + x0);
        *(u32x4*)(Ks + s * 136 + x0) = *(const u32x4*)(QKb + toks * 1024 + 512 + h * 128 + x0);
        { const int e = pid >> 3, o = pid & 7;
          const u32x4 vv = *(const u32x4*)(VTg + ((size_t)tokblock_of(b, dir, c) * 512 + h * 128 + e) * 64 + (dir ? 7 - o : o) * 8);
          *(u32x4*)(VT + e * 72 + o * 8) = dir ? rev8h(vv) : vv; } }
#pragma unroll
    for (int i = 0; i < 4; ++i) { const int pid = tid + i * 512; const int e = pid >> 4, x0 = (pid & 15) * 8;
        *(u32x4*)(Cs + e * 136 + x0) = *(const u32x4*)(CST + ((size_t)(chain * 68 + c) * 128 + e) * 128 + x0); }
    if (tid < 128) sc[384 + tid] = NST[(size_t)(chain * 68 + c) * 128 + tid];
    if (w == 0) {
        const float gbi = gate_b[(dir * 2 + 0) * 4 + h], gbf = gate_b[(dir * 2 + 1) * 4 + h];
        const size_t tokl = (size_t)step_tok(b, dir, c * 64 + lane);
        const float ig = bf2f(Pm[tokl * LDP + ML_OFF + 2048 + (dir * 2 + 0) * 4 + h]) + gbi;
        const float fg = bf2f(Pm[tokl * LDP + ML_OFF + 2048 + (dir * 2 + 1) * 4 + h]) + gbf;
        const float lf = fminf(fg, 0.f) - log1pf(expf(-fabsf(fg)));
        const float bcs = wave_scan_incl(lf, lane); const float gsv = ig - bcs; const float pm = wave_scanmax_incl(gsv, lane);
        const float m_in = MST[chain * 68 + c]; const float mt = bcs + fmaxf(m_in, pm);
        sc[lane] = bcs; sc[64 + lane] = gsv; sc[128 + lane] = mt; sc[192 + lane] = expf(bcs + m_in - mt); sc[256 + lane] = expf(-mt);
    }
    __syncthreads();
    const int tt = w >> 1;
    {   f32x4 aS[2] = {(f32x4){0.f, 0.f, 0.f, 0.f}, (f32x4){0.f, 0.f, 0.f, 0.f}};
#pragma unroll
        for (int ks = 0; ks < 4; ++ks) { const bf16x8 af = *(const bf16x8*)(Qs + (16 * tt + (lane & 15)) * 136 + ks * 32 + (lane >> 4) * 8);
#pragma unroll
            for (int i = 0; i < 2; ++i) { const int st = (w & 1) * 2 + i; const bf16x8 bfr = *(const bf16x8*)(Ks + (16 * st + (lane & 15)) * 136 + ks * 32 + (lane >> 4) * 8);
                aS[i] = __builtin_amdgcn_mfma_f32_16x16x32_bf16(af, bfr, aS[i], 0, 0, 0); } }
        float rs[4] = {0.f, 0.f, 0.f, 0.f};
#pragma unroll
        for (int i = 0; i < 2; ++i) { const int s = 16 * ((w & 1) * 2 + i) + (lane & 15); const float gsv = sc[64 + s];
#pragma unroll
            for (int q = 0; q < 4; ++q) { const int t = 16 * tt + (lane >> 4) * 4 + q; const float val = (s <= t) ? aS[i][q] * expf(sc[t] + gsv - sc[128 + t]) : 0.f; Ss[t * 72 + s] = f2bf(val); rs[q] += val; } }
#pragma unroll
        for (int q = 0; q < 4; ++q) { float r = rs[q]; r += __shfl_xor(r, 1); r += __shfl_xor(r, 2); r += __shfl_xor(r, 4); r += __shfl_xor(r, 8);
            if ((lane & 15) == 0) sc[512 + (w & 1) * 64 + 16 * tt + (lane >> 4) * 4 + q] = r; }
        {   const int t = tid >> 3, part = tid & 7; float dot = 0.f;
#pragma unroll
            for (int j = 0; j < 16; ++j) dot += bf2f(Qs[t * 136 + part * 16 + j]) * sc[384 + part * 16 + j];
            dot += __shfl_xor(dot, 1); dot += __shfl_xor(dot, 2); dot += __shfl_xor(dot, 4);
            if (part == 0) sc[640 + t] = sc[192 + t] * dot; }
    }
    __syncthreads();
    {   f32x4 aN[4];
#pragma unroll
        for (int i = 0; i < 4; ++i) aN[i] = (f32x4){0.f, 0.f, 0.f, 0.f};
#pragma unroll
        for (int ks = 0; ks < 4; ++ks) { const bf16x8 af = *(const bf16x8*)(Qs + (16 * tt + (lane & 15)) * 136 + ks * 32 + (lane >> 4) * 8);
#pragma unroll
            for (int i = 0; i < 4; ++i) { const int et = (w & 1) * 4 + i; const bf16x8 bfr = *(const bf16x8*)(Cs + (16 * et + (lane & 15)) * 136 + ks * 32 + (lane >> 4) * 8);
                aN[i] = __builtin_amdgcn_mfma_f32_16x16x32_bf16(af, bfr, aN[i], 0, 0, 0); } }
#pragma unroll
        for (int q = 0; q < 4; ++q) { const float it = sc[192 + 16 * tt + (lane >> 4) * 4 + q];
#pragma unroll
            for (int i = 0; i < 4; ++i) aN[i][q] *= it; }
#pragma unroll
        for (int ks = 0; ks < 2; ++ks) { const bf16x8 af = *(const bf16x8*)(Ss + (16 * tt + (lane & 15)) * 72 + ks * 32 + (lane >> 4) * 8);
#pragma unroll
            for (int i = 0; i < 4; ++i) { const int et = (w & 1) * 4 + i; const bf16x8 bfr = *(const bf16x8*)(VT + (16 * et + (lane & 15)) * 72 + ks * 32 + (lane >> 4) * 8);
                aN[i] = __builtin_amdgcn_mfma_f32_16x16x32_bf16(af, bfr, aN[i], 0, 0, 0); } }
#pragma unroll
        for (int q = 0; q < 4; ++q) { const int t = 16 * tt + (lane >> 4) * 4 + q; const size_t tokt = (size_t)step_tok(b, dir, c * 64 + t); const float dn = fmaxf(fabsf((sc[512 + t] + sc[576 + t]) + sc[640 + t]), sc[256 + t]);
#pragma unroll
            for (int i = 0; i < 4; ++i) { const int e = 16 * ((w & 1) * 4 + i) + (lane & 15); Hout[tokt * BW + h * 128 + e] = aN[i][q] / dn; } }
    }
}


#define SD_FRAG_LOAD(BF, XF, cc_) do { const int tb_ = tokblock_of(b, dir, (cc_)); const bf16_t* bb_ = BTg + ((size_t)tb_ * 256 + grp * 128 + 64 * (w >> 2) + r16) * 64 + q4 * 8; const bf16_t* xb_ = XTg + ((size_t)tb_ * 512 + h * 64 + 16 * (w & 3) + r16) * 64 + q4 * 8; \
        _Pragma("unroll") for (int ks_ = 0; ks_ < 2; ++ks_) { XF[ks_] = *(const u32x4*)(xb_ + ks_ * 32); _Pragma("unroll") for (int j_ = 0; j_ < 4; ++j_) BF[j_][ks_] = *(const u32x4*)(bb_ + (size_t)j_ * 16 * 64 + ks_ * 32); } } while (0)
#define SD_CHUNK(c_, BF, XF, BFN, XFN) do { const int c = (c_); \
        if (c + 1 < 68) SD_FRAG_LOAD(BFN, XFN, c + 1); \
        const float dec = sDEC[c]; \
        {   bf16_t* ss = SSTb + (size_t)(chain * 68 + c) * 64 * 128; const int p = 16 * (w & 3) + r16; \
            _Pragma("unroll") for (int j = 0; j < 4; ++j) { const int n0 = 16 * ((w >> 2) * 4 + j) + q4 * 4; u32x2 pk; pk.x = pk2(acc[j][0], acc[j][1]); pk.y = pk2(acc[j][2], acc[j][3]); *(u32x2*)(ss + (size_t)p * 128 + n0) = pk; } } \
        bf16x8 xfr[2]; \
        _Pragma("unroll") for (int ks = 0; ks < 2; ++ks) { const float4 wa = *(const float4*)(sSC + c * 64 + ks * 32 + q4 * 8), wb = *(const float4*)(sSC + c * 64 + ks * 32 + q4 * 8 + 4); const u32x4 sv = scale8h(XF[ks], wa, wb); xfr[ks] = *(const bf16x8*)&sv; } \
        _Pragma("unroll") for (int j = 0; j < 4; ++j) acc[j] = acc[j] * dec; \
        _Pragma("unroll") for (int ks = 0; ks < 2; ++ks) _Pragma("unroll") for (int j = 0; j < 4; ++j) acc[j] = __builtin_amdgcn_mfma_f32_16x16x32_bf16(*(const bf16x8*)&BF[j][ks], xfr[ks], acc[j], 0, 0, 0); } while (0)
__device__ __forceinline__ void ssd_state_pass(const int chain, const bf16_t* __restrict__ Pm, const bf16_t* __restrict__ BTg, const bf16_t* __restrict__ XTg, const float Aa, const float dtb,
                                               bf16_t* __restrict__ SSTb, unsigned char* shm, const int tid) {
    const int dir = chain & 1, h = (chain >> 1) & 7, b = chain >> 4, grp = h >> 2, lane = tid & 63, w = tid >> 6, q4 = lane >> 4, r16 = lane & 15;
    float* sSC = (float*)shm; float* sDEC = sSC + 68 * 64;
    const int dcol = SSD_OFF + 1536 + dir * 8 + h;
    u32x4 bfA[4][2], xfA[2], bfB[4][2], xfB[2];
    SD_FRAG_LOAD(bfA, xfA, 0);
    __syncthreads();
    unsigned dt_[9];
#pragma unroll
    for (int q = 0; q < 9; ++q) { const int c = min(w + 8 * q, 67); dt_[q] = Pm[(size_t)step_tok(b, dir, c * 64 + lane) * LDP + dcol]; }
#pragma unroll
    for (int q = 0; q < 9; ++q) { const int c = w + 8 * q; if (c >= 68) break;
        const float xv = __uint_as_float(dt_[q] << 16) + dtb; const float dtv = xv > 20.f ? xv : log1pf(expf(xv));
        const float cs = wave_scan_incl(dtv * Aa, lane); const float cl = __shfl(cs, 63);
        sSC[c * 64 + (dir ? 63 - lane : lane)] = dtv * expf(cl - cs); if (lane == 0) sDEC[c] = expf(cl); }
    __syncthreads();
    f32x4 acc[4];
#pragma unroll
    for (int j = 0; j < 4; ++j) acc[j] = (f32x4){0.f, 0.f, 0.f, 0.f};
    for (int c2 = 0; c2 < 68; c2 += 2) { SD_CHUNK(c2, bfA, xfA, bfB, xfB); SD_CHUNK(c2 + 1, bfB, xfB, bfA, xfA); }
    __syncthreads();
}
#undef SD_CHUNK
#undef SD_FRAG_LOAD
__device__ __forceinline__ void ssd_out_item(const int chain, const int c, const bf16_t* __restrict__ Pm, const bf16_t* __restrict__ XBb, const bf16_t* __restrict__ XTg, const float Aa, const float dtb,
                                             const bf16_t* __restrict__ SSTb, float* __restrict__ Yout, unsigned char* shm, const int tid) {
    const int dir = chain & 1, h = (chain >> 1) & 7, b = chain >> 4, grp = h >> 2, lane = tid & 63, w = tid >> 6;
    bf16_t* Cs = (bf16_t*)shm; bf16_t* Bs = (bf16_t*)(shm + 17408); bf16_t* XT = (bf16_t*)(shm + 34816); bf16_t* Sin = (bf16_t*)(shm + 44032); bf16_t* Gs = (bf16_t*)(shm + 61440);
    float* sc = (float*)(shm + 70656);
    __syncthreads();
#pragma unroll
    for (int i = 0; i < 2; ++i) { const int pid = tid + i * 512; const int s = pid >> 4, x0 = (pid & 15) * 8; const size_t toks = (size_t)step_tok(b, dir, c * 64 + s);
        *(u32x4*)(Bs + s * 136 + x0) = *(const u32x4*)(XBb + toks * 1024 + 512 + grp * 128 + x0);
        *(u32x4*)(Cs + s * 136 + x0) = *(const u32x4*)(XBb + toks * 1024 + 768 + grp * 128 + x0);
        const int p = pid >> 4;
        *(u32x4*)(Sin + p * 136 + x0) = *(const u32x4*)(SSTb + ((size_t)(chain * 68 + c) * 64 + p) * 128 + x0); }
    {   const int p = tid >> 3, o = tid & 7;
        const u32x4 vv = *(const u32x4*)(XTg + ((size_t)tokblock_of(b, dir, c) * 512 + h * 64 + p) * 64 + (dir ? 7 - o : o) * 8);
        *(u32x4*)(XT + p * 72 + o * 8) = dir ? rev8h(vv) : vv; }
    if (w == 0) { const size_t tokl = (size_t)step_tok(b, dir, c * 64 + lane);
        const float xv = bf2f(Pm[tokl * LDP + SSD_OFF + 1536 + dir * 8 + h]) + dtb; const float dtv = xv > 20.f ? xv : log1pf(expf(xv));
        sc[lane] = wave_scan_incl(dtv * Aa, lane); sc[64 + lane] = dtv; }
    __syncthreads();
    {   const int lt = w >> 1;
        f32x4 aG[2] = {(f32x4){0.f, 0.f, 0.f, 0.f}, (f32x4){0.f, 0.f, 0.f, 0.f}};
#pragma unroll
        for (int ks = 0; ks < 4; ++ks) { const bf16x8 af = *(const bf16x8*)(Cs + (16 * lt + (lane & 15)) * 136 + ks * 32 + (lane >> 4) * 8);
#pragma unroll
            for (int i = 0; i < 2; ++i) { const int st = (w & 1) * 2 + i; const bf16x8 bfr = *(const bf16x8*)(Bs + (16 * st + (lane & 15)) * 136 + ks * 32 + (lane >> 4) * 8);
                aG[i] = __builtin_amdgcn_mfma_f32_16x16x32_bf16(af, bfr, aG[i], 0, 0, 0); } }
#pragma unroll
        for (int i = 0; i < 2; ++i) { const int s = 16 * ((w & 1) * 2 + i) + (lane & 15); const float css = sc[s], dts = sc[64 + s];
#pragma unroll
            for (int q = 0; q < 4; ++q) { const int t = 16 * lt + (lane >> 4) * 4 + q; const float val = (s <= t) ? aG[i][q] * expf(sc[t] - css) * dts : 0.f; Gs[t * 72 + s] = f2bf(val); } }
    }
    __syncthreads();
    {   const int lt = w >> 1;
        f32x4 aY[2] = {(f32x4){0.f, 0.f, 0.f, 0.f}, (f32x4){0.f, 0.f, 0.f, 0.f}};
#pragma unroll
        for (int ks = 0; ks < 4; ++ks) { const bf16x8 af = *(const bf16x8*)(Cs + (16 * lt + (lane & 15)) * 136 + ks * 32 + (lane >> 4) * 8);
#pragma unroll
            for (int i = 0; i < 2; ++i) { const int pt = (w & 1) * 2 + i; const bf16x8 bfr = *(const bf16x8*)(Sin + (16 * pt + (lane & 15)) * 136 + ks * 32 + (lane >> 4) * 8);
                aY[i] = __builtin_amdgcn_mfma_f32_16x16x32_bf16(af, bfr, aY[i], 0, 0, 0); } }
#pragma unroll
        for (int q = 0; q < 4; ++q) { const float ec = expf(sc[16 * lt + (lane >> 4) * 4 + q]); aY[0][q] *= ec; aY[1][q] *= ec; }
#pragma unroll
        for (int ks = 0; ks < 2; ++ks) { const bf16x8 af = *(const bf16x8*)(Gs + (16 * lt + (lane & 15)) * 72 + ks * 32 + (lane >> 4) * 8);
#pragma unroll
            for (int i = 0; i < 2; ++i) { const int pt = (w & 1) * 2 + i; const bf16x8 bfr = *(const bf16x8*)(XT + (16 * pt + (lane & 15)) * 72 + ks * 32 + (lane >> 4) * 8);
                aY[i] = __builtin_amdgcn_mfma_f32_16x16x32_bf16(af, bfr, aY[i], 0, 0, 0); } }
#pragma unroll
        for (int q = 0; q < 4; ++q) { const int t = 16 * lt + (lane >> 4) * 4 + q; const size_t tokt = (size_t)step_tok(b, dir, c * 64 + t);
#pragma unroll
            for (int i = 0; i < 2; ++i) { const int p = 16 * ((w & 1) * 2 + i) + (lane & 15); Yout[tokt * BW + h * 64 + p] = aY[i][q]; } }
    }
}


#define FIDX(i) ((i) + ((i) >> 4))
#define FFT_X_BYTES 69632
__device__ constexpr float FFT_CW_RE[6][16] = {{0.f, 0.f, 0.f, 0.f, 0.f, 0.f, 0.f, 0.f, 0.f, 0.f, 0.f, 0.f, 0.f, 0.f, 0.f, 0.f}, {1.0f, 0.f, 0.f, 0.f, 0.f, 0.f, 0.f, 0.f, 0.f, 0.f, 0.f, 0.f, 0.f, 0.f, 0.f, 0.f}, {1.0f, 6.123233995736766e-17f, 0.f, 0.f, 0.f, 0.f, 0.f, 0.f, 0.f, 0.f, 0.f, 0.f, 0.f, 0.f, 0.f, 0.f}, {1.0f, 0.7071067811865476f, 6.123233995736766e-17f, -0.7071067811865475f, 0.f, 0.f, 0.f, 0.f, 0.f, 0.f, 0.f, 0.f, 0.f, 0.f, 0.f, 0.f}, {1.0f, 0.9238795325112867f, 0.7071067811865476f, 0.38268343236508984f, 6.123233995736766e-17f, -0.3826834323650897f, -0.7071067811865475f, -0.9238795325112867f, 0.f, 0.f, 0.f, 0.f, 0.f, 0.f, 0.f, 0.f}, {1.0f, 0.9807852804032304f, 0.9238795325112867f, 0.8314696123025452f, 0.7071067811865476f, 0.5555702330196023f, 0.38268343236508984f, 0.19509032201612833f, 6.123233995736766e-17f, -0.1950903220161282f, -0.3826834323650897f, -0.555570233019602f, -0.7071067811865475f, -0.8314696123025453f, -0.9238795325112867f, -0.9807852804032304f}};
__device__ constexpr float FFT_CW_IM[6][16] = {{0.f, 0.f, 0.f, 0.f, 0.f, 0.f, 0.f, 0.f, 0.f, 0.f, 0.f, 0.f, 0.f, 0.f, 0.f, 0.f}, {-0.0f, 0.f, 0.f, 0.f, 0.f, 0.f, 0.f, 0.f, 0.f, 0.f, 0.f, 0.f, 0.f, 0.f, 0.f, 0.f}, {-0.0f, -1.0f, 0.f, 0.f, 0.f, 0.f, 0.f, 0.f, 0.f, 0.f, 0.f, 0.f, 0.f, 0.f, 0.f, 0.f}, {-0.0f, -0.7071067811865475f, -1.0f, -0.7071067811865476f, 0.f, 0.f, 0.f, 0.f, 0.f, 0.f, 0.f, 0.f, 0.f, 0.f, 0.f, 0.f}, {-0.0f, -0.3826834323650898f, -0.7071067811865475f, -0.9238795325112867f, -1.0f, -0.9238795325112867f, -0.7071067811865476f, -0.3826834323650899f, 0.f, 0.f, 0.f, 0.f, 0.f, 0.f, 0.f, 0.f}, {-0.0f, -0.19509032201612825f, -0.3826834323650898f, -0.5555702330196022f, -0.7071067811865475f, -0.8314696123025452f, -0.9238795325112867f, -0.9807852804032304f, -1.0f, -0.9807852804032304f, -0.9238795325112867f, -0.8314696123025455f, -0.7071067811865476f, -0.5555702330196022f, -0.3826834323650899f, -0.1950903220161286f}};
__host__ __device__ constexpr int fft_bitrev(int k, int R) { int r = 0; for (int i = 0; i < R; ++i) if (k & (1 << i)) r |= 1 << (R - 1 - i); return r; }
template <int R, bool INV>
__device__ __forceinline__ void fft_pass(float2* __restrict__ X, const float2* __restrict__ TW, const int s0, const int gidx) {
    const int lowbits = 13 - s0 - R; const int stride = 1 << lowbits;
    const int low = gidx & (stride - 1), high = gidx >> lowbits; const int base = (high << (lowbits + R)) | low;
    const int p0 = FIDX(base);
#define FFT_SLOT(k) (lowbits >= 4 ? p0 + (k) * (stride + (stride >> 4)) : p0 + (k) + ((k) >> 4))
    float2 v[1 << R];
#pragma unroll
    for (int k = 0; k < (1 << R); ++k) v[k] = X[FFT_SLOT(k)];
    const int lw = low << s0;
    if (!INV) {
#pragma unroll
        for (int j = 0; j < R; ++j) { const int hk = 1 << (R - 1 - j);
#pragma unroll
            for (int k = 0; k < (1 << R); ++k) if (!(k & hk)) { const int kk = k & (hk - 1);
                const float2 a = v[k], b = v[k + hk]; v[k] = make_float2(a.x + b.x, a.y + b.y); const float dx = a.x - b.x, dy = a.y - b.y;
                if (kk == 0) v[k + hk] = make_float2(dx, dy);
                else if (2 * kk == hk) v[k + hk] = make_float2(dy, -dx);
                else { const float cr = FFT_CW_RE[R - j][kk], ci = FFT_CW_IM[R - j][kk]; v[k + hk] = make_float2(dx * cr - dy * ci, dx * ci + dy * cr); } } }
        if (lowbits > 0) {
#pragma unroll
            for (int k = 1; k < (1 << R); ++k) { const float2 w = TW[(lw * fft_bitrev(k, R)) & 8191]; const float2 a = v[k]; v[k] = make_float2(a.x * w.x - a.y * w.y, a.x * w.y + a.y * w.x); } }
    } else {
        if (lowbits > 0) {
#pragma unroll
            for (int k = 1; k < (1 << R); ++k) { const float2 w = TW[(lw * fft_bitrev(k, R)) & 8191]; const float2 a = v[k]; v[k] = make_float2(a.x * w.x + a.y * w.y, a.y * w.x - a.x * w.y); } }
#pragma unroll
        for (int j = R - 1; j >= 0; --j) { const int hk = 1 << (R - 1 - j);
#pragma unroll
            for (int k = 0; k < (1 << R); ++k) if (!(k & hk)) { const int kk = k & (hk - 1);
                const float2 a = v[k], b = v[k + hk]; float tx, ty;
                if (kk == 0) { tx = b.x; ty = b.y; }
                else if (2 * kk == hk) { tx = -b.y; ty = b.x; }
                else { const float cr = FFT_CW_RE[R - j][kk], ci = FFT_CW_IM[R - j][kk]; tx = b.x * cr + b.y * ci; ty = b.y * cr - b.x * ci; }
                v[k] = make_float2(a.x + tx, a.y + ty); v[k + hk] = make_float2(a.x - tx, a.y - ty); } }
    }
#pragma unroll
    for (int k = 0; k < (1 << R); ++k) X[FFT_SLOT(k)] = v[k];
#undef FFT_SLOT
}
__device__ __forceinline__ void fft_fwd(float2* X, const float2* TW, const int tid) {
    fft_pass<4, false>(X, TW, 0, tid); __syncthreads(); fft_pass<4, false>(X, TW, 4, tid); __syncthreads(); if (tid < 256) fft_pass<5, false>(X, TW, 8, tid); __syncthreads(); }
__device__ __forceinline__ void fft_inv(float2* X, const float2* TW, const int tid) {
    if (tid < 256) fft_pass<5, true>(X, TW, 8, tid); __syncthreads(); fft_pass<4, true>(X, TW, 4, tid); __syncthreads(); fft_pass<4, true>(X, TW, 0, tid); __syncthreads(); }
__device__ __forceinline__ void fft_twiddles(float2* TW, const int tid) {
#pragma unroll
    for (int k = 0; k < 16; ++k) { const int m = tid + k * 512; const float xx = (float)m * (1.0f / 4096.0f); TW[m] = make_float2(cospif(xx), -sinpif(xx)); }
}
__device__ __forceinline__ void hyena_spec_item(const int oc, const float* __restrict__ HR, const float* __restrict__ nrm, float2* __restrict__ HSPEC, unsigned char* shm, const int tid) {
    float2* X = (float2*)shm; const float2* TW = (const float2*)(shm + FFT_X_BYTES);
    const int o = oc >> 9, c = oc & 511; const float inv = 1.0f / nrm[oc];
    __syncthreads();
    float hv[16];
#pragma unroll
    for (int k = 0; k < 16; ++k) { const int j = tid + k * 512;
        const unsigned off = j < SEQ ? (unsigned)j * 2048u + o * 1024 + c : j == SEQ ? (unsigned)(o * 1024 + c) : (unsigned)(2 * SEQ - j) * 2048u + o * 1024 + 512 + c;
        hv[k] = HR[off]; }
#pragma unroll
    for (int k = 0; k < 16; ++k) { const int j = tid + k * 512; X[FIDX(j)] = make_float2(j == SEQ ? 0.f : hv[k] * inv, 0.f); }
    __syncthreads();
    fft_fwd(X, TW, tid);
    float4* out = (float4*)(HSPEC + (size_t)oc * 8192 + tid * 16); const float2* xs = X + 17 * tid;
#pragma unroll
    for (int k = 0; k < 8; ++k) { const float2 x0 = xs[2 * k], x1 = xs[2 * k + 1]; out[k] = make_float4(x0.x * (1.0f / 8192.0f), x0.y * (1.0f / 8192.0f), x1.x * (1.0f / 8192.0f), x1.y * (1.0f / 8192.0f)); }
}
__device__ __forceinline__ void fft_mul_spec(float2* X, const float2* __restrict__ H, const int tid) {
    const float4* h4 = (const float4*)(H + tid * 16); float2* xs = X + 17 * tid;
#pragma unroll
    for (int k = 0; k < 8; ++k) { const float4 hv = h4[k]; const float2 x0 = xs[2 * k], x1 = xs[2 * k + 1];
        xs[2 * k] = make_float2(x0.x * hv.x - x0.y * hv.y, x0.x * hv.y + x0.y * hv.x); xs[2 * k + 1] = make_float2(x1.x * hv.z - x1.y * hv.w, x1.x * hv.w + x1.y * hv.z); }
}
__device__ __forceinline__ void hyena_fft_item(const int item, const float* __restrict__ UT, const float2* __restrict__ HSPEC, const float* __restrict__ bias, float* __restrict__ YT, unsigned char* shm, const int tid) {
    float2* X = (float2*)shm; const float2* TW = (const float2*)(shm + FFT_X_BYTES);
    const int c = item >> 1, b0 = (item & 1) * 2, b1 = b0 + 1;
    const float* u0 = UT + (size_t)(b0 * 1536 + c) * SEQ + tid * 8; const float* u1 = UT + (size_t)(b1 * 1536 + c) * SEQ + tid * 8;
    const float bias0 = bias[c], bias1 = bias[512 + c];
    float2* xs = X + FIDX(8 * tid);
    float vr[8], vi[8];
    __syncthreads();
    { const float4 a0 = *(const float4*)u0, a1 = *(const float4*)(u0 + 4), c0 = *(const float4*)u1, c1 = *(const float4*)(u1 + 4);
      vr[0] = a0.x; vr[1] = a0.y; vr[2] = a0.z; vr[3] = a0.w; vr[4] = a1.x; vr[5] = a1.y; vr[6] = a1.z; vr[7] = a1.w;
      vi[0] = c0.x; vi[1] = c0.y; vi[2] = c0.z; vi[3] = c0.w; vi[4] = c1.x; vi[5] = c1.y; vi[6] = c1.z; vi[7] = c1.w; }
#pragma unroll
    for (int k = 0; k < 8; ++k) { xs[k] = make_float2(vr[k], vi[k]); xs[4352 + k] = make_float2(0.f, 0.f); }
    __syncthreads();
    fft_fwd(X, TW, tid);
    fft_mul_spec(X, HSPEC + (size_t)c * 8192, tid);
    __syncthreads();
    fft_inv(X, TW, tid);
    { const float* p0 = u0 + (size_t)512 * SEQ; const float* p1 = u1 + (size_t)512 * SEQ;
      const float4 a0 = *(const float4*)p0, a1 = *(const float4*)(p0 + 4), c0 = *(const float4*)p1, c1 = *(const float4*)(p1 + 4);
      const float xr[8] = {a0.x, a0.y, a0.z, a0.w, a1.x, a1.y, a1.z, a1.w}, xi[8] = {c0.x, c0.y, c0.z, c0.w, c1.x, c1.y, c1.z, c1.w};
#pragma unroll
      for (int k = 0; k < 8; ++k) { const float2 cv = xs[k]; const float zr = xr[k] * (cv.x + bias0 * vr[k]), zi = xi[k] * (cv.y + bias0 * vi[k]);
          vr[k] = zr; vi[k] = zi; xs[k] = make_float2(zr, zi); xs[4352 + k] = make_float2(0.f, 0.f); } }
    __syncthreads();
    fft_fwd(X, TW, tid);
    fft_mul_spec(X, HSPEC + (size_t)(512 + c) * 8192, tid);
    __syncthreads();
    fft_inv(X, TW, tid);
    { const float* p0 = u0 + (size_t)1024 * SEQ; const float* p1 = u1 + (size_t)1024 * SEQ;
      const float4 a0 = *(const float4*)p0, a1 = *(const float4*)(p0 + 4), c0 = *(const float4*)p1, c1 = *(const float4*)(p1 + 4);
      const float xr[8] = {a0.x, a0.y, a0.z, a0.w, a1.x, a1.y, a1.z, a1.w}, xi[8] = {c0.x, c0.y, c0.z, c0.w, c1.x, c1.y, c1.z, c1.w};
      float yr[8], yi[8];
#pragma unroll
      for (int k = 0; k < 8; ++k) { const float2 cv = xs[k]; yr[k] = xr[k] * (cv.x + bias1 * vr[k]); yi[k] = xi[k] * (cv.y + bias1 * vi[k]); }
      float* y0 = YT + (size_t)(b0 * 512 + c) * SEQ + tid * 8; float* y1 = YT + (size_t)(b1 * 512 + c) * SEQ + tid * 8;
      *(float4*)y0 = make_float4(yr[0], yr[1], yr[2], yr[3]); *(float4*)(y0 + 4) = make_float4(yr[4], yr[5], yr[6], yr[7]);
      *(float4*)y1 = make_float4(yi[0], yi[1], yi[2], yi[3]); *(float4*)(y1 + 4) = make_float4(yi[4], yi[5], yi[6], yi[7]); }
}

constexpr size_t al256(size_t x) { return (x + 255) & ~(size_t)255; }
constexpr size_t O_BAR = 0;
constexpr size_t O_MOD = 16384;
constexpr size_t O_NORM = O_MOD + al256((size_t)2 * 5 * 6 * DM * 4);
constexpr size_t O_QCTR = O_NORM + al256((size_t)2 * 2 * 1024 * 4);
constexpr size_t O_ZERO_END = O_QCTR + 512;
constexpr size_t O_XS = O_ZERO_END;
constexpr size_t O_HB = O_XS + al256((size_t)NTOK * DM * 4);
constexpr size_t O_P = O_HB + al256((size_t)NTOK * DM * 2);
constexpr size_t O_WIN = O_P + al256((size_t)NTOK * LDP * 2);
constexpr size_t O_WBR = O_WIN + al256((size_t)LDP * DM * 2);
constexpr size_t O_WOUT = O_WBR + al256((size_t)4 * DM * BW * 2);
constexpr size_t O_WGU = O_WOUT + al256((size_t)DM * DM * 2);
constexpr size_t O_WD = O_WGU + al256((size_t)NEXP * 2 * DEXP * DM * 2);
constexpr size_t O_GLU = O_WD + al256((size_t)NEXP * DM * DEXP * 2);
constexpr size_t O_Y4 = O_GLU + al256((size_t)BW * BW * 2);
constexpr size_t O_U = O_Y4 + al256((size_t)NTOK * DM * 2);
constexpr size_t O_QKB = O_U + al256((size_t)NTOK * 1536 * 4);
constexpr size_t O_CST = O_QKB + al256((size_t)NTOK * 1024 * 2);
constexpr size_t O_NST = O_CST + al256((size_t)32 * 68 * 128 * 128 * 2);
constexpr size_t O_MST = O_NST + al256((size_t)32 * 68 * 128 * 4);
constexpr size_t O_XBC = O_MST + al256((size_t)32 * 68 * 4);
constexpr size_t O_SST = O_XBC + al256((size_t)NTOK * 1024 * 2);
constexpr size_t O_HF = O_SST + al256((size_t)64 * 68 * 64 * 128 * 2);
constexpr size_t O_YF = O_HF + al256((size_t)2 * NTOK * BW * 4);
constexpr size_t O_SF = O_YF + al256((size_t)2 * NTOK * BW * 4);
constexpr size_t O_LDT = O_SF + al256((size_t)2 * NCTX * BW * 4);
constexpr size_t O_AP = O_LDT + al256((size_t)4096 * 16);
constexpr size_t O_BBT = O_AP + al256((size_t)4096 * 33 * 8);
constexpr size_t O_KT = O_BBT + al256((size_t)4096 * 16 * 8);
constexpr size_t O_S5A = O_KT + al256((size_t)32 * 2 * 32 * 256 * 4);
constexpr size_t O_S5B = O_S5A + al256((size_t)32 * 512 * 768 * 2);
constexpr size_t O_XCTX = O_S5B + al256((size_t)32 * 512 * 768 * 2);
constexpr size_t O_Z = O_XCTX + al256((size_t)4 * 32 * 2 * 64 * 8);
constexpr size_t O_HRAW = O_Z + al256((size_t)NTOK * BW * 4);
constexpr size_t O_HSPEC = O_HRAW + al256((size_t)(SEQ + CTXL) * 2048 * 4);
constexpr size_t O_K2C = O_HSPEC + al256((size_t)1024 * 8192 * 8);
constexpr size_t O_GG = O_K2C + al256((size_t)(2 * CTXL) * 1024 * 4);
constexpr size_t O_PROBS = O_GG + al256((size_t)NTOK * BW * 2);
constexpr size_t O_ROWTOK = O_PROBS + al256((size_t)NTOK * 16 * 4);
constexpr size_t O_ROWGATE = O_ROWTOK + al256((size_t)NEXP * MOE_PAD * 4);
constexpr size_t O_INV = O_ROWGATE + al256((size_t)NEXP * MOE_PAD * 4);
constexpr size_t O_NORMP = O_INV + al256((size_t)NTOK * 16 * 4);
constexpr size_t WS_END = O_NORMP + al256((size_t)4 * 256 * 2048 * 4);
constexpr size_t O_XG = O_P;
constexpr size_t O_HID = O_P + al256((size_t)NEXP * MOE_PAD * DM * 2);
constexpr size_t O_YEXP = O_HID + al256((size_t)NEXP * MOE_PAD * DEXP * 2);
static_assert(O_YEXP + (size_t)NEXP * MOE_PAD * DM * 2 <= O_WIN, "MoE temporaries must fit inside P");
static_assert((size_t)NTOK * DM * 2 <= (size_t)NTOK * 1536 * 4, "ACCb must fit inside U");
static_assert((size_t)26214400 + (size_t)2 * 17825792 + (size_t)272 * 256 * 64 * 2 <= (size_t)NTOK * DM * 2, "strip buffers must fit inside HB");
static_assert(WS_END <= (size_t)1851000000, "workspace map exceeds the guaranteed size");

struct Args {
    const float* in[47];
    float* out; unsigned char* ws;
    int ph_lo, ph_hi;
};

__device__ __forceinline__ void conv_tile(const float* __restrict__ src, int ldsrc, int nvalid, int k0, int n0, bf16_t* __restrict__ dst, int lddst, int mode, float* T, int tid) {
    { const int n = tid & 63, kr = tid >> 6;
#pragma unroll
      for (int i = 0; i < 8; ++i) { const int k = i * 8 + kr; T[k * 65 + n] = (n0 + n < nvalid) ? src[(size_t)(k0 + k) * ldsrc + n0 + n] : 0.f; } }
    __syncthreads();
    { const int n = tid >> 3, kc = (tid & 7) * 8; const int gn = n0 + n;
      const int drow = mode == 0 ? gn : (32 * (gn >> 4) + (mode == 2 ? 16 : 0) + (gn & 15));
      u32x4 w; w.x = pk2(T[(kc + 0) * 65 + n], T[(kc + 1) * 65 + n]); w.y = pk2(T[(kc + 2) * 65 + n], T[(kc + 3) * 65 + n]);
      w.z = pk2(T[(kc + 4) * 65 + n], T[(kc + 5) * 65 + n]); w.w = pk2(T[(kc + 6) * 65 + n], T[(kc + 7) * 65 + n]);
      *(u32x4*)(dst + (size_t)drow * lddst + k0 + kc) = w; }
    __syncthreads();
}

#define IN(id) (lo <= (id) && (id) < hi)
#define SEAM(id) do { if (hi > (id) + 1) xcd_barrier(bar); } while (0)
#define PH_BEGIN int tid = threadIdx.x; asm volatile("" : "+v"(tid) :: "memory"); const int lane = tid & 63, wave = tid >> 6; (void)lane; (void)wave;

#define x_in (PT(0))
#define c_in (PT(1))
#define ctx_in (PT(2))
#define cctx_in (PT(3))
#define ada_w (PT(4))
#define ada_b (PT(5))
#define norm_mix (PT(6))
#define norm_ffn (PT(7))
#define w_in (PT(8))
#define XS ((float*)(a.ws + O_XS))
#define MOD ((float*)(a.ws + O_MOD))
#define NORM ((float*)(a.ws + O_NORM))
#define NORMP ((float*)(a.ws + O_NORMP))
#define MODl (MOD + (size_t)l * 5 * 6 * DM)
#define HB ((bf16_t*)(a.ws + O_HB))
#define P ((bf16_t*)(a.ws + O_P))
#define WIN ((bf16_t*)(a.ws + O_WIN))
#define WBR ((bf16_t*)(a.ws + O_WBR))
#define WOUT ((bf16_t*)(a.ws + O_WOUT))
#define WGU ((bf16_t*)(a.ws + O_WGU))
#define WD ((bf16_t*)(a.ws + O_WD))
#define GLU ((bf16_t*)(a.ws + O_GLU))
#define Y4 ((bf16_t*)(a.ws + O_Y4))
#define U ((float*)(a.ws + O_U))
#define ACCb ((bf16_t*)(a.ws + O_U))
#define QKB ((bf16_t*)(a.ws + O_QKB))
#define CST ((bf16_t*)(a.ws + O_CST))
#define NST ((float*)(a.ws + O_NST))
#define MST ((float*)(a.ws + O_MST))
#define XBC ((bf16_t*)(a.ws + O_XBC))
#define SSTB ((bf16_t*)(a.ws + O_SST))
#define HF ((float*)(a.ws + O_HF))
#define HBk (HF + (size_t)NTOK * BW)
#define YF ((float*)(a.ws + O_YF))
#define YB (YF + (size_t)NTOK * BW)
#define SF ((float*)(a.ws + O_SF))
#define SB (SF + (size_t)NCTX * BW)
#define LDT ((double2*)(a.ws + O_LDT))
#define APW ((float2*)(a.ws + O_AP))
#define BBT ((float2*)(a.ws + O_BBT))
#define KTB ((float*)(a.ws + O_KT))
#define S5A ((bf16_t*)(a.ws + O_S5A))
#define S5B ((bf16_t*)(a.ws + O_S5B))
#define XCTX ((float2*)(a.ws + O_XCTX))
#define S5P ((bf16_t*)(a.ws + O_HB))
#define XLOC ((float*)(a.ws + O_HB + (size_t)32 * 256 * 512 * 2))
#define KTG ((bf16_t*)(a.ws + O_HB + (size_t)26214400))
#define VTG ((bf16_t*)(a.ws + O_HB + (size_t)26214400 + (size_t)17825792))
#define BTG ((bf16_t*)(a.ws + O_HB + (size_t)26214400 + (size_t)2 * 17825792))
#define XTG ((bf16_t*)(a.ws + O_GG))
#define Z ((float*)(a.ws + O_Z))
#define HRAW ((float*)(a.ws + O_HRAW))
#define HSPEC ((float2*)(a.ws + O_HSPEC))
#define UT ((float*)(a.ws + O_U))
#define YT ((float*)(a.ws + O_Z))
#define QCTR ((int*)(a.ws + O_QCTR))
#define K2C ((float*)(a.ws + O_K2C))
#define GG ((bf16_t*)(a.ws + O_GG))
#define PROBS ((float*)(a.ws + O_PROBS))
#define ROWTOK ((int*)(a.ws + O_ROWTOK))
#define ROWGATE ((float*)(a.ws + O_ROWGATE))
#define XG ((bf16_t*)(a.ws + O_XG))
#define HID ((bf16_t*)(a.ws + O_HID))
#define YEXP ((bf16_t*)(a.ws + O_YEXP))
#define INV ((int*)(a.ws + O_INV))


__device__ __forceinline__ void moe_pair(float4 (&a)[8], const int r1, const int r2, const float g2scale, const int lane, const float* __restrict__ rowgate, const bf16_t* __restrict__ yexp) {
    const float gt1 = rowgate[r1], gt2 = rowgate[r2] * g2scale;
    const bf16_t* y1 = yexp + (size_t)r1 * DM + lane * 4; const bf16_t* y2 = yexp + (size_t)r2 * DM + lane * 4;
    u32x2 w1[8], w2[8];
#pragma unroll
    for (int i = 0; i < 8; ++i) { w1[i] = *(const u32x2*)(y1 + i * 256); w2[i] = *(const u32x2*)(y2 + i * 256); }
#pragma unroll
    for (int i = 0; i < 8; ++i) {
        a[i].x += gt1 * __uint_as_float(w1[i].x << 16); a[i].y += gt1 * __uint_as_float(w1[i].x & 0xFFFF0000u); a[i].z += gt1 * __uint_as_float(w1[i].y << 16); a[i].w += gt1 * __uint_as_float(w1[i].y & 0xFFFF0000u);
        a[i].x += gt2 * __uint_as_float(w2[i].x << 16); a[i].y += gt2 * __uint_as_float(w2[i].x & 0xFFFF0000u); a[i].z += gt2 * __uint_as_float(w2[i].y << 16); a[i].w += gt2 * __uint_as_float(w2[i].y & 0xFFFF0000u); }
}
__device__ __forceinline__ void moe_combine(float4 (&v)[8], const int tok, const int lane, const int* __restrict__ inv, const float* __restrict__ rowgate, const bf16_t* __restrict__ yexp, const float* __restrict__ m5) {
    float4 a[8], mm[8];
#pragma unroll
    for (int i = 0; i < 8; ++i) { a[i] = make_float4(0.f, 0.f, 0.f, 0.f); mm[i] = *(const float4*)(m5 + i * 256 + lane * 4); }
    const int4* ip = (const int4*)(inv + (size_t)tok * 16);
    const int4 q0 = ip[0], q1 = ip[1], q2 = ip[2], q3 = ip[3];
    const int rows[16] = {q0.x, q0.y, q0.z, q0.w, q1.x, q1.y, q1.z, q1.w, q2.x, q2.y, q2.z, q2.w, q3.x, q3.y, q3.z, q3.w};
    int prow = -1;
#pragma unroll
    for (int e = 0; e < 16; ++e) { const int row = __builtin_amdgcn_readfirstlane(rows[e]);
        if (row >= 0) { if (prow >= 0) { moe_pair(a, prow, row, 1.0f, lane, rowgate, yexp); prow = -1; } else prow = row; } }
    if (prow >= 0) moe_pair(a, prow, prow, 0.0f, lane, rowgate, yexp);
#pragma unroll
    for (int i = 0; i < 8; ++i) { v[i].x += mm[i].x * a[i].x; v[i].y += mm[i].y * a[i].y; v[i].z += mm[i].z * a[i].z; v[i].w += mm[i].w * a[i].w; }
}
struct CvU { const float* src; bf16_t* dst; int ldsrc, nvalid, k0, n0, lddst, mode; };
__device__ __forceinline__ void cv_load(const CvU& u, float4 (&r)[8], const int tid) {
#pragma unroll
    for (int i = 0; i < 8; ++i) { const int idx = tid + i * 512; const int k = idx >> 6, n = u.n0 + (idx & 63) * 4;
        r[i] = (n < u.nvalid) ? *(const float4*)(u.src + (size_t)(u.k0 + k) * u.ldsrc + n) : make_float4(0.f, 0.f, 0.f, 0.f); }
}
__device__ __forceinline__ void cv_stage(float* T, const float4 (&r)[8], const int tid) {
#pragma unroll
    for (int i = 0; i < 8; ++i) { const int idx = tid + i * 512; float* p = T + (idx >> 6) * 257 + (idx & 63) * 4; p[0] = r[i].x; p[1] = r[i].y; p[2] = r[i].z; p[3] = r[i].w; }
}
__device__ __forceinline__ void cv_store(const CvU& u, const float* T, const int tid) {
#pragma unroll
    for (int j = 0; j < 4; ++j) { const int o = tid + j * 512; const int kc = (o & 7) * 8, n = o >> 3; const int gn = u.n0 + n;
        const int drow = u.mode == 0 ? gn : (256 * (gn >> 7) + (u.mode == 2 ? 128 : 0) + (gn & 127));
        const float* t = T + kc * 257 + n;
        u32x4 w; w.x = pk2(t[0], t[257]); w.y = pk2(t[2 * 257], t[3 * 257]); w.z = pk2(t[4 * 257], t[5 * 257]); w.w = pk2(t[6 * 257], t[7 * 257]);
        *(u32x4*)(u.dst + (size_t)drow * u.lddst + u.k0 + kc) = w; }
}
#define CV_RUN(LL, QSTART, QSTEP, QEND) do { \
                const float* wbr = PT(40) + (size_t)(LL) * 4 * BW * DM; const float* wout = PT(41) + (size_t)(LL) * DM * DM; \
                const float* wg = PT(43) + (size_t)(LL) * NEXP * DM * DEXP; const float* wu = PT(44) + (size_t)(LL) * NEXP * DM * DEXP; const float* wd = PT(45) + (size_t)(LL) * NEXP * DEXP * DM; \
                const float* wglu = PT(32) + (size_t)(LL) * BW * BW; const float* win = w_in + (size_t)(LL) * DM * IN_W; \
                const int cv_step = (QSTEP), cv_end = (QEND); \
                __syncthreads(); \
                int q = (QSTART); int buf = 0; CvU u; float4 r[8]; \
                if (q < cv_end) { CV_DECODE(q, u); cv_load(u, r, tid); } \
                while (q < cv_end) { \
                    float* T = sf + buf * (64 * 257); \
                    cv_stage(T, r, tid); \
                    __syncthreads(); \
                    const CvU cur = u; const int qn = q + cv_step; \
                    if (qn < cv_end) { CV_DECODE(qn, u); cv_load(u, r, tid); } \
                    cv_store(cur, T, tid); \
                    buf ^= 1; q = qn; \
                } \
                __syncthreads(); } while (0)
#define CV_DECODE(q_, u_) do { int qq_ = (q_); \
                    if (qq_ < n_win) { u_ = CvU{win, WIN, IN_W, IN_W, (qq_ / 55) * 64, (qq_ % 55) * 256, DM, 0}; } else { qq_ -= n_win; \
                    if (qq_ < n_br) { const int k = qq_ >> 6, r = qq_ & 63; u_ = CvU{wbr + (size_t)k * BW * DM, WBR + (size_t)k * DM * BW, DM, DM, (r >> 3) * 64, (r & 7) * 256, BW, 0}; } else { qq_ -= n_br; \
                    if (qq_ < n_out) { u_ = CvU{wout, WOUT, DM, DM, (qq_ >> 3) * 64, (qq_ & 7) * 256, DM, 0}; } else { qq_ -= n_out; \
                    if (qq_ < n_glu) { u_ = CvU{wglu, GLU, BW, BW, (qq_ >> 1) * 64, (qq_ & 1) * 256, BW, 0}; } else { qq_ -= n_glu; \
                    if (qq_ < n_gu) { const int e = qq_ / 384, r = qq_ % 384, up = r / 192, r2 = r % 192; u_ = CvU{(up ? wu : wg) + (size_t)e * DM * DEXP, WGU + (size_t)e * 2 * DEXP * DM, DEXP, DEXP, (r2 / 6) * 64, (r2 % 6) * 256, DM, 1 + up}; } else { qq_ -= n_gu; \
                    { const int e = qq_ / 192, r = qq_ % 192; u_ = CvU{wd + (size_t)e * DEXP * DM, WD + (size_t)e * DM * DEXP, DM, DM, (r >> 3) * 64, (r & 7) * 256, DEXP, 0}; } } } } } } } while (0)
template <int LAYER>
__device__ __forceinline__ void layer_body(const Args& a, const XcdBarrier& bar, const int lo, const int hi, const int bid, const int G, unsigned char* const shm, float* const sf, const float** const ptab) {
        constexpr int l = LAYER;
        constexpr int PB = 1 + 16 * l;
        const bool lastl = (l == 1);

        const int nPanels = lastl ? 64 : 68;
        const int M2 = nPanels * 256;

        if (IN(PB + 0)) for (int rep_ = 0; rep_ < (l == 0 ? PROBE_REPS(0) : 1); ++rep_) {
            PH_BEGIN
            {   const int n_win = 32 * 55, n_br = 4 * 64, n_out = 32 * 8, n_glu = 16, n_gu = 16 * 2 * 192, n_d = 16 * 192;
                const int n_grp1 = n_win + n_br + n_out + n_glu, total = n_grp1 + n_gu + n_d;
                const int q_lo = (l > 0 && G > 128) ? n_win : 0;
                CV_RUN(l, q_lo + bid, G, total);
            }
            for (int set = 0; set < (lastl ? 1 : 2); ++set) {
                const int L = set ? CTXL : SEQ; float* HR = HRAW + (set ? (size_t)SEQ * 2048 : 0);
                const float* w1 = PT(11) + l * 33 * 64; const float* b1 = PT(12) + l * 64; const float* fr1 = PT(13) + l * 64; const float* w2 = PT(14) + l * 64 * 64; const float* b2 = PT(15) + l * 64;
                const float* fr2 = PT(16) + l * 64; const float* w3 = PT(17) + l * 64 * 2048; const float* decay = PT(18) + l * 2048;
                float* feats = sf; float* h1 = sf + 16 * 33; float* h2 = h1 + 16 * 64;
                float nacc[4] = {0.f, 0.f, 0.f, 0.f};
                for (int base = bid; base < L; base += 16 * G) {
                    __syncthreads();
                    for (int e = tid; e < 16 * 33; e += NTHR) { const int ti = e / 33, fi = e % 33; int t = base + ti * G; if (t > L - 1) t = L - 1;
                        float v;
                        if (fi == 0) v = (float)t / (float)(L - 1);
                        else { const int j = (fi - 1) & 15; const double fr = 1e-4 + (double)j * ((15.0 - 1e-4) / 15.0); const double ang = (2.0 * 3.14159265358979323846 / (double)L) * (double)t * fr; v = fi <= 16 ? (float)cos(ang) : (float)(-sin(ang)); }
                        feats[e] = v; }
                    __syncthreads();
                    { const int j = tid & 63, ti = tid >> 6; float s0 = b1[j], s1 = s0;
_Pragma("unroll 3")
                      for (int i = 0; i < 33; ++i) { const float wv = w1[i * 64 + j]; s0 += feats[ti * 33 + i] * wv; s1 += feats[(ti + 8) * 33 + i] * wv; }
                      const float f1 = fr1[j]; h1[ti * 64 + j] = sinf(f1 * s0); h1[(ti + 8) * 64 + j] = sinf(f1 * s1); }
                    __syncthreads();
                    { const int j = tid & 63, ti = tid >> 6; float s0 = b2[j], s1 = s0;
_Pragma("unroll 4")
                      for (int i = 0; i < 64; ++i) { const float wv = w2[i * 64 + j]; s0 += h1[ti * 64 + i] * wv; s1 += h1[(ti + 8) * 64 + i] * wv; }
                      const float f2 = fr2[j]; h2[ti * 64 + j] = sinf(f2 * s0); h2[(ti + 8) * 64 + j] = sinf(f2 * s1); }
                    __syncthreads();
                    float acc[16][4];
#pragma unroll
                    for (int ti = 0; ti < 16; ++ti) { acc[ti][0] = 0.f; acc[ti][1] = 0.f; acc[ti][2] = 0.f; acc[ti][3] = 0.f; }
#pragma unroll 2
                    for (int i = 0; i < 64; ++i) { const float* wrow = w3 + (size_t)i * 2048 + tid; const float wa = wrow[0], wb = wrow[512], wc2 = wrow[1024], wd2 = wrow[1536];
#pragma unroll
                        for (int ti = 0; ti < 16; ++ti) { const float hv = h2[ti * 64 + i]; acc[ti][0] += hv * wa; acc[ti][1] += hv * wb; acc[ti][2] += hv * wc2; acc[ti][3] += hv * wd2; } }
                    float dk[4];
#pragma unroll
                    for (int k = 0; k < 4; ++k) dk[k] = fabsf(decay[tid + k * 512]);
#pragma unroll
                    for (int ti = 0; ti < 16; ++ti) { const int t = base + ti * G; if (t < L) { const float tn = (float)t / (float)(L - 1);
#pragma unroll
                        for (int k = 0; k < 4; ++k) { const float v = acc[ti][k] * expf(-tn * dk[k]); HR[(size_t)t * 2048 + tid + k * 512] = v; nacc[k] += fabsf(v); } } }
                }
                float* nrp = NORMP + ((size_t)(l * 2 + set) * 256 + bid) * 2048;
#pragma unroll
                for (int k = 0; k < 4; ++k) nrp[tid + k * 512] = nacc[k];
            }
            for (int idx = bid * NTHR + tid; idx < 4096; idx += G * NTHR) { const int n = idx & 63, g = (idx >> 6) & 31, dir = idx >> 11;
                const double are = (double)(PT(24) + l * 4096)[idx], aim = (double)(PT(25) + l * 4096)[idx]; const double lam = are < -1e-4 ? are : -1e-4; const double dt = exp((double)(PT(26) + l * 64)[dir * 32 + g]);
                const double ldre = lam * dt, ldim = aim * dt; LDT[idx] = make_double2(ldre, ldim);
                const double mag = exp(ldre); const double ar = mag * cos(ldim), ai = mag * sin(ldim);
                const double den = lam * lam + aim * aim; const double nr = ar - 1.0, ni = ai; const double fre = (nr * lam + ni * aim) / den, fim = (ni * lam - nr * aim) / den;
                const float* b_re = PT(27) + l * 32 * 64 * 16; const float* b_im = PT(28) + l * 32 * 64 * 16;
#pragma unroll 4
                for (int c = 0; c < 16; ++c) { const double br = (double)b_re[(g * 64 + n) * 16 + c], bi = (double)b_im[(g * 64 + n) * 16 + c]; BBT[idx * 16 + c] = make_float2((float)(fre * br - fim * bi), (float)(fre * bi + fim * br)); }
            }
            for (int e2 = bid * NTHR + tid; e2 < 4096 * 33; e2 += G * NTHR) { const int idx = e2 / 33, k = e2 - idx * 33; const int g = (idx >> 6) & 31, dir = idx >> 11;
                const double are = (double)(PT(24) + l * 4096)[idx], aim = (double)(PT(25) + l * 4096)[idx]; const double lam = are < -1e-4 ? are : -1e-4; const double dt = exp((double)(PT(26) + l * 64)[dir * 32 + g]);
                const double ldre = lam * dt, ldim = aim * dt; const double mk = exp(ldre * k); APW[e2] = make_float2((float)(mk * cos(ldim * k)), (float)(mk * sin(ldim * k))); }
            if (l == 0 && lo == 0) xcd_barrier(bar);
            for (int tok = bid * 8 + wave; tok < NTOK; tok += G * 8) {
                const int r = tok < NLAT ? tok / SEQ : 4; const float* xr = l == 0 ? (tok < NLAT ? x_in + (size_t)tok * DM : ctx_in + (size_t)(tok - NLAT) * DM) : XS + (size_t)tok * DM; const float* gn = norm_mix + l * DM;
                const float* sh = MODl + (size_t)(r * 6 + 0) * DM; const float* sc = MODl + (size_t)(r * 6 + 1) * DM;
                float4 v[8]; float ss = 0.f;
#pragma unroll
                for (int i = 0; i < 8; ++i) v[i] = *(const float4*)(xr + i * 256 + lane * 4);
                if (l > 0) {
                    moe_combine(v, tok, lane, INV, ROWGATE, YEXP, MOD + (size_t)((l - 1) * 5 + r) * 6 * DM + 5 * DM);
#pragma unroll
                    for (int i = 0; i < 8; ++i) *(float4*)(XS + (size_t)tok * DM + i * 256 + lane * 4) = v[i]; }
#pragma unroll
                for (int i = 0; i < 8; ++i) ss += v[i].x * v[i].x + v[i].y * v[i].y + v[i].z * v[i].z + v[i].w * v[i].w;
                ss = wave_sum(ss); const float rs = rsqrtf(ss * (1.0f / DM) + 1e-6f);
#pragma unroll
                for (int i = 0; i < 8; ++i) { const int d = i * 256 + lane * 4; const float4 g4 = *(const float4*)(gn + d), s4 = *(const float4*)(sc + d), h4 = *(const float4*)(sh + d);
                    v[i].x = v[i].x * rs * g4.x * (1.f + s4.x) + h4.x; v[i].y = v[i].y * rs * g4.y * (1.f + s4.y) + h4.y; v[i].z = v[i].z * rs * g4.z * (1.f + s4.z) + h4.z; v[i].w = v[i].w * rs * g4.w * (1.f + s4.w) + h4.w; }
#pragma unroll
                for (int i = 0; i < 8; ++i) { u32x2 w; w.x = pk2(v[i].x, v[i].y); w.y = pk2(v[i].z, v[i].w); *(u32x2*)(HB + (size_t)tok * DM + i * 256 + lane * 4) = w; }
            }
            SEAM(PB + 0);
        }

        if (IN(PB + 1)) for (int rep_ = 0; rep_ < PROBE_REPS(1); ++rep_) {
            PH_BEGIN
            for (int base = bid * 8; base < (lastl ? 1 : 2) * 1024; base += G * 8) {
                const int idx = base + (tid & 7), sl = tid >> 3; const int set = idx >> 10, oc = idx & 1023, o = oc >> 9, c = oc & 511;
                const float* pp = NORMP + (size_t)(l * 2 + set) * 256 * 2048 + o * 1024 + c + (size_t)(sl * 4) * 2048; float sacc = 0.f;
#pragma unroll
                for (int j = 0; j < 4; ++j) { const float p0 = pp[(size_t)j * 2048], p1 = pp[(size_t)j * 2048 + 512]; sacc += (sl * 4 + j < G) ? p0 + p1 : 0.f; }
                sf[sl * 8 + (tid & 7)] = sacc; __syncthreads();
                if (tid < 8) { float t = 0.f;
#pragma unroll 8
                    for (int q = 0; q < 64; ++q) t += sf[q * 8 + tid];
                    NORM[(size_t)(l * 2 + set) * 1024 + oc] = t; }
                __syncthreads(); }
            for (int idx = (G - 1 - bid) * NTHR + tid; idx < 32768; idx += G * NTHR) { const int c = idx & 15, lag = (idx >> 4) & 31, dir = (idx >> 9) & 1, g = idx >> 10;
                const float* c_re = PT(29) + l * 32 * 16 * 64 + (g * 16 + c) * 64; const float* c_im = PT(30) + l * 32 * 16 * 64 + (g * 16 + c) * 64;
                float acc[16];
#pragma unroll
                for (int j = 0; j < 16; ++j) acc[j] = 0.f;
#pragma unroll 2
                for (int n = 0; n < 64; ++n) { const int pi = (dir * 32 + g) * 64 + n; const float2 ap = APW[pi * 33 + lag]; const float cr = c_re[n], ci = c_im[n]; const float wr_ = cr * ap.x - ci * ap.y, wi_ = cr * ap.y + ci * ap.x;
                    const float4* bb = (const float4*)(BBT + pi * 16);
#pragma unroll
                    for (int j = 0; j < 8; ++j) { const float4 b2 = bb[j]; acc[2 * j] += wr_ * b2.x - wi_ * b2.y; acc[2 * j + 1] += wr_ * b2.z - wi_ * b2.w; } }
                float4* o = (float4*)(KTB + (size_t)idx * 16);
                o[0] = make_float4(acc[0], acc[1], acc[2], acc[3]); o[1] = make_float4(acc[4], acc[5], acc[6], acc[7]); o[2] = make_float4(acc[8], acc[9], acc[10], acc[11]); o[3] = make_float4(acc[12], acc[13], acc[14], acc[15]);
            }
            __syncthreads();
            pg8::Gemm g{HB, WIN, DM, DM, DM}; pg8::SchedStd S{68, 55, G, bid, DM, DM}; pg8::EpiWin E{P, LDP};
            pg8::gemm_phase(( LAS unsigned char*)shm, g, S, E);
#if defined(PROBE_BNOEPI)
            { __syncthreads(); pg8::EpiNone E0; pg8::gemm_phase((LAS unsigned char*)shm, g, S, E0); }
#endif
            SEAM(PB + 1);
        }

        if (IN(PB + 2)) for (int rep_ = 0; rep_ < PROBE_REPS(2); ++rep_) {
            PH_BEGIN
            const float* hcw = PT(9) + l * 3 * 1536; const float* hcb = PT(10) + l * 1536; const float* mcw = PT(20) + l * 3 * 1024; const float* mcb = PT(21) + l * 1024;
            const float* scw = PT(34) + l * 3 * 1024; const float* scb = PT(35) + l * 1024;
            for (int unit = bid; unit < 272 * 3; unit += G) { const int seg = unit / 3, kind = unit % 3; const bool lat = seg < 256; const size_t tok0 = lat ? (size_t)seg * 64 : (size_t)NLAT + (size_t)(seg - 256) * 64;
                if (kind < 2) { const int hf = kind;
                    const int c = tid * 2; const int col = (hf ? SSD_OFF + 512 : ML_OFF) + c; const float* w = hf ? scw : mcw; const float* bsp = hf ? scb : mcb; bf16_t* dst = (hf ? XBC : QKB) + tok0 * 1024 + c;
                    const float2 w0 = *(const float2*)(w + c), w1 = *(const float2*)(w + 1024 + c), w2 = *(const float2*)(w + 2048 + c), bb = *(const float2*)(bsp + c);
                    const float osc = (!hf && c >= 512) ? 0.08838834764831845f : 1.0f;
                    const bool hasPrev = !lat && ((tok0 - NLAT) & (CTXL - 1)) != 0, hasNext = !lat && (((tok0 - NLAT) + 63) & (CTXL - 1)) != CTXL - 1;
                    bf16_t* strip = nullptr;
                    if (!hf) { if (c >= 512) strip = KTG + ((size_t)seg * 512 + (c - 512)) * 64; }
                    else { if (c < 512) strip = XTG + ((size_t)seg * 512 + c) * 64; else if (c < 768) strip = BTG + ((size_t)seg * 256 + (c - 512)) * 64; }
                    const bf16_t* pp = P + tok0 * LDP + col;
                    unsigned raw[66];
#pragma unroll
                    for (int t = 0; t < 66; ++t) raw[t] = ((t == 0 && !hasPrev) || (t == 65 && !hasNext)) ? 0u : *(const unsigned*)(pp + (ptrdiff_t)(t - 1) * LDP);
#pragma unroll
                    for (int t8 = 0; t8 < 8; ++t8) { float v0[8], v1[8];
#pragma unroll
                        for (int tt = 0; tt < 8; ++tt) { const int t = t8 * 8 + tt; const unsigned p0 = raw[t], p1 = raw[t + 1], p2 = raw[t + 2];
                            float a0 = bb.x + w0.x * __uint_as_float(p0 << 16) + w1.x * __uint_as_float(p1 << 16) + w2.x * __uint_as_float(p2 << 16);
                            float a1 = bb.y + w0.y * __uint_as_float(p0 & 0xFFFF0000u) + w1.y * __uint_as_float(p1 & 0xFFFF0000u) + w2.y * __uint_as_float(p2 & 0xFFFF0000u);
                            a0 = siluf_(a0) * osc; a1 = siluf_(a1) * osc; v0[tt] = a0; v1[tt] = a1;
                            *(unsigned*)(dst + (size_t)t * 1024) = pk2(a0, a1); }
                        if (strip) { u32x4 s0, s1; s0.x = pk2(v0[0], v0[1]); s0.y = pk2(v0[2], v0[3]); s0.z = pk2(v0[4], v0[5]); s0.w = pk2(v0[6], v0[7]); s1.x = pk2(v1[0], v1[1]); s1.y = pk2(v1[2], v1[3]); s1.z = pk2(v1[4], v1[5]); s1.w = pk2(v1[6], v1[7]);
                            *(u32x4*)(strip + t8 * 8) = s0; *(u32x4*)(strip + 64 + t8 * 8) = s1; } }
                } else {
                    const int c = (tid & 255) * 2, th = tid >> 8; const bf16_t* pp = P + (tok0 + th * 32) * LDP + ML_OFF + 1024 + c; bf16_t* strip = VTG + ((size_t)seg * 512 + c) * 64 + th * 32;
                    unsigned rv[32];
#pragma unroll
                    for (int t = 0; t < 32; ++t) rv[t] = *(const unsigned*)(pp + (size_t)t * LDP);
#pragma unroll
                    for (int t8 = 0; t8 < 4; ++t8) { u32x4 s0, s1;
                        s0.x = (rv[t8 * 8 + 0] & 0xFFFFu) | (rv[t8 * 8 + 1] << 16); s0.y = (rv[t8 * 8 + 2] & 0xFFFFu) | (rv[t8 * 8 + 3] << 16); s0.z = (rv[t8 * 8 + 4] & 0xFFFFu) | (rv[t8 * 8 + 5] << 16); s0.w = (rv[t8 * 8 + 6] & 0xFFFFu) | (rv[t8 * 8 + 7] << 16);
                        s1.x = (rv[t8 * 8 + 0] >> 16) | (rv[t8 * 8 + 1] & 0xFFFF0000u); s1.y = (rv[t8 * 8 + 2] >> 16) | (rv[t8 * 8 + 3] & 0xFFFF0000u); s1.z = (rv[t8 * 8 + 4] >> 16) | (rv[t8 * 8 + 5] & 0xFFFF0000u); s1.w = (rv[t8 * 8 + 6] >> 16) | (rv[t8 * 8 + 7] & 0xFFFF0000u);
                        *(u32x4*)(strip + t8 * 8) = s0; *(u32x4*)(strip + 64 + t8 * 8) = s1; }
                }
            }
            if (!lastl) for (int tok = NLAT + bid; tok < NTOK; tok += G) {
                const int t = (tok - NLAT) & (CTXL - 1); const bool hasL = (t != 0), hasR = (t != CTXL - 1); const bf16_t* pr = P + (size_t)tok * LDP;
                const bf16_t* prL = hasL ? pr - LDP : pr; const bf16_t* prR = hasR ? pr + LDP : pr;
                unsigned xc[3], xl[3], xr[3];
#pragma unroll
                for (int j = 0; j < 3; ++j) { const int cc = tid + j * 512; xc[j] = pr[HY_OFF + cc]; xl[j] = prL[HY_OFF + cc]; xr[j] = prR[HY_OFF + cc]; }
#pragma unroll
                for (int j = 0; j < 3; ++j) { const int cc = tid + j * 512;
                    float acc = hcb[cc] + hcw[1536 + cc] * __uint_as_float(xc[j] << 16);
                    acc += hasL ? hcw[cc] * __uint_as_float(xl[j] << 16) : 0.f;
                    acc += hasR ? hcw[2 * 1536 + cc] * __uint_as_float(xr[j] << 16) : 0.f;
                    U[(size_t)tok * 1536 + cc] = acc; }
            }
            for (int idx0 = bid * NTHR + tid; idx0 < 16384 * 64; idx0 += 4 * G * NTHR) { u32x4 t4[4];
#pragma unroll
                for (int q = 0; q < 4; ++q) { const int idx = idx0 + q * G * NTHR; const int half = idx & 1, g = (idx >> 1) & 31, tok = idx >> 6;
                    if (idx < 16384 * 64) t4[q] = *(const u32x4*)(P + (size_t)tok * LDP + S5_OFF + g * 16 + half * 8); }
#pragma unroll
                for (int q = 0; q < 4; ++q) { const int idx = idx0 + q * G * NTHR; const int half = idx & 1, g = (idx >> 1) & 31, tok = idx >> 6;
                    if (idx < 16384 * 64) *(u32x4*)(S5A + ((size_t)g * 512 + (tok >> 5)) * 768 + (tok & 31) * 16 + half * 8) = t4[q]; } }
            for (int idx = bid * NTHR + tid; idx < 32 * 512 * 32 * 2; idx += G * NTHR) { const int half = idx & 1, sI = (idx >> 1) & 31, row = (idx >> 6) & 511, g = idx >> 15; const int t = row >> 4, c = row & 15; const int lag = t - sI;
                float v[8];
                if (lag > 0) { const float4* k4 = (const float4*)(KTB + ((size_t)((g * 2 + 0) * 32 + lag) * 16 + c) * 16 + half * 8); const float4 a0 = k4[0], a1 = k4[1]; v[0] = a0.x; v[1] = a0.y; v[2] = a0.z; v[3] = a0.w; v[4] = a1.x; v[5] = a1.y; v[6] = a1.z; v[7] = a1.w; }
                else if (lag < 0) { const float4* k4 = (const float4*)(KTB + ((size_t)((g * 2 + 1) * 32 - lag) * 16 + c) * 16 + half * 8); const float4 a0 = k4[0], a1 = k4[1]; v[0] = a0.x; v[1] = a0.y; v[2] = a0.z; v[3] = a0.w; v[4] = a1.x; v[5] = a1.y; v[6] = a1.z; v[7] = a1.w; }
                else { const float4* k4 = (const float4*)(KTB + ((size_t)((g * 2 + 0) * 32) * 16 + c) * 16 + half * 8); const float4* q4 = (const float4*)(KTB + ((size_t)((g * 2 + 1) * 32) * 16 + c) * 16 + half * 8); const float4 a0 = k4[0], a1 = k4[1], b0 = q4[0], b1 = q4[1];
                    v[0] = a0.x + b0.x; v[1] = a0.y + b0.y; v[2] = a0.z + b0.z; v[3] = a0.w + b0.w; v[4] = a1.x + b1.x; v[5] = a1.y + b1.y; v[6] = a1.z + b1.z; v[7] = a1.w + b1.w; }
                u32x4 w; w.x = pk2(v[0], v[1]); w.y = pk2(v[2], v[3]); w.z = pk2(v[4], v[5]); w.w = pk2(v[6], v[7]);
                *(u32x4*)(S5B + ((size_t)g * 512 + row) * 768 + sI * 16 + half * 8) = w; }
            for (int idx = bid * NTHR + tid; idx < 32 * 512 * 64; idx += G * NTHR) { const int n = idx & 63, row = (idx >> 6) & 511, g = idx >> 15; const int t = row >> 4, c = row & 15;
                const float cr = (PT(29) + l * 32 * 16 * 64)[(g * 16 + c) * 64 + n], ci = (PT(30) + l * 32 * 16 * 64)[(g * 16 + c) * 64 + n];
                const float2 af = APW[((0 * 32 + g) * 64 + n) * 33 + t + 1], ab = APW[((1 * 32 + g) * 64 + n) * 33 + 32 - t];
                bf16_t* d = S5B + ((size_t)g * 512 + row) * 768 + 512 + 2 * n;
                *(unsigned*)d = pk2(cr * af.x - ci * af.y, -(cr * af.y + ci * af.x)); *(unsigned*)(d + 128) = pk2(cr * ab.x - ci * ab.y, -(cr * ab.y + ci * ab.x)); }
            for (int idx = bid * NTHR + tid; idx < 32 * 2 * 64 * 32; idx += G * NTHR) { const int sI = idx & 31, n = (idx >> 5) & 63, dir = (idx >> 11) & 1, g = idx >> 12; const int pi = (dir * 32 + g) * 64 + n;
                const float2 pw = APW[pi * 33 + (dir ? sI : 31 - sI)]; const float4* bb = (const float4*)(BBT + pi * 16);
                float re[16], im[16];
#pragma unroll
                for (int j = 0; j < 8; ++j) { const float4 b2 = bb[j]; re[2 * j] = pw.x * b2.x - pw.y * b2.y; im[2 * j] = pw.x * b2.y + pw.y * b2.x; re[2 * j + 1] = pw.x * b2.z - pw.y * b2.w; im[2 * j + 1] = pw.x * b2.w + pw.y * b2.z; }
                bf16_t* d = S5P + ((size_t)g * 256 + dir * 128 + 2 * n) * 512 + sI * 16;
                u32x4 w0, w1; w0.x = pk2(re[0], re[1]); w0.y = pk2(re[2], re[3]); w0.z = pk2(re[4], re[5]); w0.w = pk2(re[6], re[7]); w1.x = pk2(re[8], re[9]); w1.y = pk2(re[10], re[11]); w1.z = pk2(re[12], re[13]); w1.w = pk2(re[14], re[15]);
                *(u32x4*)d = w0; *(u32x4*)(d + 8) = w1;
                w0.x = pk2(im[0], im[1]); w0.y = pk2(im[2], im[3]); w0.z = pk2(im[4], im[5]); w0.w = pk2(im[6], im[7]); w1.x = pk2(im[8], im[9]); w1.y = pk2(im[10], im[11]); w1.z = pk2(im[12], im[13]); w1.w = pk2(im[14], im[15]);
                *(u32x4*)(d + 512) = w0; *(u32x4*)(d + 520) = w1; }
            {   float* T = sf;
                for (int unit = bid; unit < 4 * 64 * 24; unit += G) { const int b = unit / (64 * 24), r = (unit / 24) % 64, c0 = (unit % 24) * 64; const size_t tok0 = (size_t)b * SEQ + r * 64;
                    __syncthreads();
#pragma unroll
                    for (int i = 0; i < 8; ++i) { const int c = tid & 63, t = (tid >> 6) + 8 * i; T[t * 65 + c] = bf2f(P[(tok0 + t) * LDP + HY_OFF + c0 + c]); }
                    __syncthreads();
                    const int c = tid >> 3, tq = (tid & 7) * 8, cc = c0 + c; const float w0 = hcw[cc], w1 = hcw[1536 + cc], w2 = hcw[3072 + cc], bb = hcb[cc];
                    float o8[8];
#pragma unroll
                    for (int i = 0; i < 8; ++i) { const int t = tq + i; float acc = bb + w1 * T[t * 65 + c]; if (t > 0) acc += w0 * T[(t - 1) * 65 + c]; if (t < 63) acc += w2 * T[(t + 1) * 65 + c]; o8[i] = acc; }
                    float* dst = UT + ((size_t)b * 1536 + cc) * SEQ + r * 64 + tq;
                    *(float4*)dst = make_float4(o8[0], o8[1], o8[2], o8[3]); *(float4*)(dst + 4) = make_float4(o8[4], o8[5], o8[6], o8[7]);
                } }
            if (!lastl) {
                const int L = CTXL; const float* HR = HRAW + (size_t)SEQ * 2048; float* K2 = K2C; const float* nrm = NORM + (size_t)(l * 2 + 1) * 1024;
                const size_t total = (size_t)(2 * L - 1) * 1024;
                for (size_t i = (size_t)bid * NTHR + tid; i < total; i += (size_t)G * NTHR) { const int j = (int)(i >> 10), oc = (int)(i & 1023), o = oc >> 9, c = oc & 511; const int lag = j - (L - 1);
                    const float v = lag >= 0 ? HR[(size_t)lag * 2048 + o * 1024 + c] : HR[(size_t)(-lag) * 2048 + o * 1024 + 512 + c];
                    K2[((size_t)j * 2 + o) * 512 + c] = v / nrm[oc]; }
            }
            {   __syncthreads(); fft_twiddles((float2*)(shm + FFT_X_BYTES), tid);
                for (int oc = bid; oc < 1024; oc += G) hyena_spec_item(oc, HRAW, NORM + (size_t)(l * 2 + 0) * 1024, HSPEC, shm, tid);
                __syncthreads(); }
            SEAM(PB + 2);
        }

        if (IN(PB + 3)) for (int rep_ = 0; rep_ < PROBE_REPS(3); ++rep_) {
            PH_BEGIN
            if (rep_ > 0) { if (bid == 0 && tid == 0) __hip_atomic_store(QCTR + l * 64, 0, __ATOMIC_RELAXED, __HIP_MEMORY_SCOPE_AGENT); xcd_barrier(bar); }
            if (bid < 64) {
                mlstm_state_pass(bid >> 1, bid & 1, P, KTG, VTG, PT(22) + l * 16, CST, NST, MST, shm, tid);
            } else if (bid < 128) {
                { const int ch = bid - 64; const int dir_ = ch & 1, h_ = (ch >> 1) & 7; ssd_state_pass(ch, P, BTG, XTG, -expf(PT(37)[l * 16 + dir_ * 8 + h_]), PT(36)[l * 16 + dir_ * 8 + h_], SSTB, shm, tid); }
            } else if (bid < 160) {
                const int widx = (bid - 128) * 8 + wave; const int dir = widx & 1, g = (widx >> 1) & 31, b = widx >> 6; const int n = lane;
                float2* xb = (float2*)(shm + (size_t)wave * 16640); float2* ctab = xb + 16 * 65;
                const float* a_re = PT(24) + l * 2 * 32 * 64; const float* a_im = PT(25) + l * 2 * 32 * 64; const float* log_dt = PT(26) + l * 64;
                const float* b_re = PT(27) + l * 32 * 64 * 16; const float* b_im = PT(28) + l * 32 * 64 * 16; const float* c_re = PT(29) + l * 32 * 16 * 64; const float* c_im = PT(30) + l * 32 * 16 * 64;
#pragma unroll
                for (int c = 0; c < 16; ++c) ctab[c * 65 + lane] = make_float2(c_re[(g * 16 + c) * 64 + lane], c_im[(g * 16 + c) * 64 + lane]);
                float abr, abi, bbr[16], bbi[16];
                {   const double are = (double)a_re[(dir * 32 + g) * 64 + n], aim = (double)a_im[(dir * 32 + g) * 64 + n];
                    const double lam = are < -1e-4 ? are : -1e-4; const double dt = exp((double)log_dt[dir * 32 + g]);
                    const double mag = exp(lam * dt); const double ar = mag * cos(aim * dt), ai = mag * sin(aim * dt);
                    const double den = lam * lam + aim * aim; const double nr = ar - 1.0, ni = ai;
                    const double fre = (nr * lam + ni * aim) / den, fim = (ni * lam - nr * aim) / den;
                    abr = (float)ar; abi = (float)ai;
#pragma unroll
                    for (int c = 0; c < 16; ++c) { const double br = (double)b_re[(g * 64 + n) * 16 + c], bi = (double)b_im[(g * 64 + n) * 16 + c]; bbr[c] = (float)(fre * br - fim * bi); bbi[c] = (float)(fre * bi + fim * br); }
                }
                float xr = 0.f, xi = 0.f; float* Sout = (dir ? SB : SF) - (size_t)NLAT * BW;
                const int s = lane >> 2, cg = lane & 3;
                for (int i0 = 0; i0 < CTXL; i0 += 16) {
#pragma unroll 4
                    for (int ss = 0; ss < 16; ++ss) {
                        const size_t tok = (size_t)step_tok(b, dir, i0 + ss);
                        const u32x4* up = (const u32x4*)(P + tok * LDP + S5_OFF + g * 16);
                        float t0[8], t1[8]; unpack8(up[0], t0); unpack8(up[1], t1);
                        float bur = 0.f, bui = 0.f;
#pragma unroll
                        for (int c = 0; c < 8; ++c) { bur += t0[c] * bbr[c] + t1[c] * bbr[8 + c]; bui += t0[c] * bbi[c] + t1[c] * bbi[8 + c]; }
                        const float nxr = abr * xr - abi * xi + bur, nxi = abr * xi + abi * xr + bui; xr = nxr; xi = nxi;
                        xb[ss * 65 + lane] = make_float2(xr, xi);
                    }
                    asm volatile("s_waitcnt lgkmcnt(0)" ::: "memory");
                    float y0 = 0.f, y1 = 0.f, y2 = 0.f, y3 = 0.f;
                    for (int nn2 = 0; nn2 < 64; ++nn2) { const float2 xv = xb[s * 65 + nn2];
                        const float2 c0 = ctab[(cg * 4 + 0) * 65 + nn2], c1 = ctab[(cg * 4 + 1) * 65 + nn2], c2 = ctab[(cg * 4 + 2) * 65 + nn2], c3 = ctab[(cg * 4 + 3) * 65 + nn2];
                        y0 += xv.x * c0.x - xv.y * c0.y; y1 += xv.x * c1.x - xv.y * c1.y; y2 += xv.x * c2.x - xv.y * c2.y; y3 += xv.x * c3.x - xv.y * c3.y; }
                    const size_t toks = (size_t)step_tok(b, dir, i0 + s);
                    *(float4*)(Sout + toks * BW + g * 16 + cg * 4) = make_float4(y0, y1, y2, y3);
                    asm volatile("s_waitcnt lgkmcnt(0)" ::: "memory");
                }
                XCTX[((b * 32 + g) * 2 + dir) * 64 + n] = make_float2(xr, xi);
            } else {
                if (bid < 224) {
                    pg8::Gemm gg_{S5A, S5P, 768, 512, 512}; pg8::SchedS5a S_{bid - 160}; pg8::EpiXloc E_{XLOC};
                    pg8::gemm_phase((LAS unsigned char*)shm, gg_, S_, E_);
                    __syncthreads();
                }
                const int nhb = G - 160, hb = bid - 160; const float* bias = PT(19) + l * 1024; const int c = tid;
                const int nitems = lastl ? 0 : 4 * (CTXL / 8);
                for (int it = hb; it < nitems; it += nhb) {
                    int L, tokbase, b, t0; const float* K2;
                    { const int q = it; L = CTXL; tokbase = NLAT; b = q / (CTXL / 8); t0 = (q % (CTXL / 8)) * 8; K2 = K2C; }
                    const float* zb = U + (size_t)(tokbase + b * L) * 1536 + c;
                    float acc[8];
#pragma unroll
                    for (int i = 0; i < 8; ++i) acc[i] = 0.f;
                    const int base = t0 + L - 1;
                    for (int s = 0; s < L; s += 8) {
                        float k[15];
#pragma unroll
                        for (int mm = 0; mm < 15; ++mm) k[mm] = K2[((size_t)(base - s - 7 + mm) * 2 + 0) * 512 + c];
#pragma unroll
                        for (int ds = 0; ds < 8; ++ds) { const float z = zb[(size_t)(s + ds) * 1536];
#pragma unroll
                            for (int i = 0; i < 8; ++i) acc[i] += k[i - ds + 7] * z; }
                    }
#pragma unroll
                    for (int i = 0; i < 8; ++i) { const size_t tok = (size_t)(tokbase + b * L + t0 + i); const float zt = U[tok * 1536 + c]; Z[tok * BW + c] = (acc[i] + bias[c] * zt) * U[tok * 1536 + 512 + c]; }
                }
            }
            {   __syncthreads(); fft_twiddles((float2*)(shm + FFT_X_BYTES), tid);
                int* qslot = (int*)(shm + FFT_X_BYTES + 65536);
                for (;;) { __syncthreads(); if (tid == 0) *qslot = atomicAdd(QCTR + l * 64, 1); __syncthreads(); const int it = *qslot; if (it >= 1024) break;
                    hyena_fft_item(it, UT, HSPEC, PT(19) + l * 1024, YT, shm, tid); }
            }
            SEAM(PB + 3);
        }

        if (IN(PB + 4)) for (int rep_ = 0; rep_ < PROBE_REPS(4); ++rep_) {
            PH_BEGIN
            if (rep_ > 0) { if (bid == 0 && tid == 0) __hip_atomic_store(QCTR + l * 64 + 32, 0, __ATOMIC_RELAXED, __HIP_MEMORY_SCOPE_AGENT); xcd_barrier(bar); }
            if (bid >= G - 32) for (int idx = (bid - (G - 32)) * NTHR + tid; idx < 16384; idx += 32 * NTHR) { const int n = idx & 63, dir = (idx >> 6) & 1, b = (idx >> 7) & 3, g = idx >> 9;
                const float2 a32 = APW[((dir * 32 + g) * 64 + n) * 33 + 32]; float2 X = XCTX[((b * 32 + g) * 2 + dir) * 64 + n];
                const float* __restrict__ xl = XLOC + ((size_t)g * 512 + b * 128) * 256 + dir * 128 + 2 * n; bf16_t* __restrict__ dst = S5A + ((size_t)g * 512 + b * 128) * 768 + 512 + dir * 128 + 2 * n;
#pragma unroll 1
                for (int j0 = 0; j0 < 128; j0 += 16) { float2 xv[16];
#pragma unroll
                    for (int q = 0; q < 16; ++q) { const int j = dir ? 127 - (j0 + q) : j0 + q; xv[q] = *(const float2*)(xl + (size_t)j * 256); }
#pragma unroll
                    for (int q = 0; q < 16; ++q) { const int j = dir ? 127 - (j0 + q) : j0 + q;
                        *(unsigned*)(dst + (size_t)j * 768) = pk2(X.x, X.y);
                        const float nx = a32.x * X.x - a32.y * X.y + xv[q].x, ny = a32.x * X.y + a32.y * X.x + xv[q].y; X.x = nx; X.y = ny; } } }
            {   int* qslot = (int*)(shm + 102400);
                for (;;) { __syncthreads(); if (tid == 0) *qslot = atomicAdd(QCTR + l * 64 + 32, 1); __syncthreads(); const int it = *qslot; if (it >= 32 * 68 + 64 * 68) break;
                    if (it < 32 * 68) { const int chain = it / 68, c = it % 68; mlstm_out_item(chain, c, P, QKB, VTG, PT(22) + l * 16, CST, NST, MST, (chain & 1) ? HBk : HF, shm, tid); }
                    else { const int i2 = it - 32 * 68; const int chain = i2 / 68, c = i2 % 68; const int dir_ = chain & 1, h_ = (chain >> 1) & 7;
                        ssd_out_item(chain, c, P, XBC, XTG, -expf(PT(37)[l * 16 + dir_ * 8 + h_]), PT(36)[l * 16 + dir_ * 8 + h_], SSTB, dir_ ? YB : YF, shm, tid); } }
            }
            __syncthreads();
            {   const float* bias = PT(19) + l * 1024 + 512; const int c = tid;
                const int nitems = lastl ? 0 : 4 * (CTXL / 8);
                for (int it = bid; it < nitems; it += G) {
                    int L, tokbase, b, t0; const float* K2;
                    { const int q = it; L = CTXL; tokbase = NLAT; b = q / (CTXL / 8); t0 = (q % (CTXL / 8)) * 8; K2 = K2C; }
                    const float* zb = Z + (size_t)(tokbase + b * L) * BW + c;
                    float acc[8];
#pragma unroll
                    for (int i = 0; i < 8; ++i) acc[i] = 0.f;
                    const int base = t0 + L - 1;
                    for (int s = 0; s < L; s += 8) {
                        float k[15];
#pragma unroll
                        for (int mm = 0; mm < 15; ++mm) k[mm] = K2[((size_t)(base - s - 7 + mm) * 2 + 1) * 512 + c];
#pragma unroll
                        for (int ds = 0; ds < 8; ++ds) { const float z = zb[(size_t)(s + ds) * BW];
#pragma unroll
                            for (int i = 0; i < 8; ++i) acc[i] += k[i - ds + 7] * z; }
                    }
#pragma unroll
                    for (int i = 0; i < 8; ++i) { const size_t tok = (size_t)(tokbase + b * L + t0 + i); const float zt = Z[tok * BW + c]; Y4[tok * DM + c] = f2bf((acc[i] + bias[c] * zt) * U[tok * 1536 + 1024 + c]); }
                }
            }
            SEAM(PB + 4);
        }

        if (IN(PB + 5)) for (int rep_ = 0; rep_ < PROBE_REPS(5); ++rep_) {
            PH_BEGIN
            const float* ml_norm = PT(23) + l * BW; const float* ssd_d = PT(38) + l * 8; const float* ssd_norm = PT(39) + l * BW; const float* s5_d = PT(31) + l * BW;
            if (bid < 128) {
                pg8::Gemm gg_{S5A, S5B, 768, 768, 768}; pg8::SchedS5b S_{bid}; pg8::EpiS5Out E_{P, s5_d, GG};
                pg8::gemm_phase((LAS unsigned char*)shm, gg_, S_, E_);
                __syncthreads();
            }
            for (int tok = bid * 8 + wave; tok < NTOK; tok += G * 8) {
                const int c0 = lane * 8; const bf16_t* pr = P + (size_t)tok * LDP; const size_t o5 = (size_t)tok * BW + c0;
                float hm[8], ys[8];
                const u32x4 ooq = *(const u32x4*)(pr + ML_OFF + 1536 + c0);
                const float4 g0 = *(const float4*)(ml_norm + c0), g1 = *(const float4*)(ml_norm + c0 + 4), n0 = *(const float4*)(ssd_norm + c0), n1 = *(const float4*)(ssd_norm + c0 + 4);
                { const float4 a0 = *(const float4*)(HF + o5), a1 = *(const float4*)(HF + o5 + 4), b0 = *(const float4*)(HBk + o5), b1 = *(const float4*)(HBk + o5 + 4);
                  hm[0] = a0.x + b0.x; hm[1] = a0.y + b0.y; hm[2] = a0.z + b0.z; hm[3] = a0.w + b0.w; hm[4] = a1.x + b1.x; hm[5] = a1.y + b1.y; hm[6] = a1.z + b1.z; hm[7] = a1.w + b1.w; }
                { const float4 a0 = *(const float4*)(YF + o5), a1 = *(const float4*)(YF + o5 + 4), b0 = *(const float4*)(YB + o5), b1 = *(const float4*)(YB + o5 + 4);
                  float xx[8], zz[8]; unpack8(*(const u32x4*)(XBC + (size_t)tok * 1024 + c0), xx); unpack8(*(const u32x4*)(pr + SSD_OFF + c0), zz); const float dsk = ssd_d[c0 >> 6];
                  ys[0] = a0.x + b0.x; ys[1] = a0.y + b0.y; ys[2] = a0.z + b0.z; ys[3] = a0.w + b0.w; ys[4] = a1.x + b1.x; ys[5] = a1.y + b1.y; ys[6] = a1.z + b1.z; ys[7] = a1.w + b1.w;
#pragma unroll
                  for (int j = 0; j < 8; ++j) ys[j] = (ys[j] + dsk * xx[j]) * siluf_(zz[j]); }
                float s1 = 0.f, s2 = 0.f;
#pragma unroll
                for (int j = 0; j < 8; ++j) { s1 += hm[j] * hm[j]; s2 += ys[j] * ys[j]; }
                s1 += __shfl_xor(s1, 1); s1 += __shfl_xor(s1, 2); s1 += __shfl_xor(s1, 4); s1 += __shfl_xor(s1, 8);
                s2 = wave_sum(s2);
                const float r1 = rsqrtf(s1 * (1.0f / 128.0f) + 1e-6f), r2 = rsqrtf(s2 * (1.0f / BW) + 1e-6f);
                float oo[8]; unpack8(ooq, oo);
                const float gm[8] = {g0.x, g0.y, g0.z, g0.w, g1.x, g1.y, g1.z, g1.w}, gs[8] = {n0.x, n0.y, n0.z, n0.w, n1.x, n1.y, n1.z, n1.w};
                u32x4 w;
                w.x = pk2(hm[0] * r1 * gm[0] * sigmoidf_(oo[0]), hm[1] * r1 * gm[1] * sigmoidf_(oo[1])); w.y = pk2(hm[2] * r1 * gm[2] * sigmoidf_(oo[2]), hm[3] * r1 * gm[3] * sigmoidf_(oo[3]));
                w.z = pk2(hm[4] * r1 * gm[4] * sigmoidf_(oo[4]), hm[5] * r1 * gm[5] * sigmoidf_(oo[5])); w.w = pk2(hm[6] * r1 * gm[6] * sigmoidf_(oo[6]), hm[7] * r1 * gm[7] * sigmoidf_(oo[7]));
                *(u32x4*)(Y4 + (size_t)tok * DM + 512 + c0) = w;
                w.x = pk2(ys[0] * r2 * gs[0], ys[1] * r2 * gs[1]); w.y = pk2(ys[2] * r2 * gs[2], ys[3] * r2 * gs[3]); w.z = pk2(ys[4] * r2 * gs[4], ys[5] * r2 * gs[5]); w.w = pk2(ys[6] * r2 * gs[6], ys[7] * r2 * gs[7]);
                *(u32x4*)(Y4 + (size_t)tok * DM + 1536 + c0) = w;
                if (tok >= NLAT) { const size_t oc = (size_t)(tok - NLAT) * BW + c0; float uu[8]; unpack8(*(const u32x4*)(pr + S5_OFF + c0), uu);
                    const float4 a0 = *(const float4*)(SF + oc), a1 = *(const float4*)(SF + oc + 4), b0 = *(const float4*)(SB + oc), b1 = *(const float4*)(SB + oc + 4), d0 = *(const float4*)(s5_d + c0), d1 = *(const float4*)(s5_d + c0 + 4);
                    float y[8] = {a0.x + b0.x + d0.x * uu[0], a0.y + b0.y + d0.y * uu[1], a0.z + b0.z + d0.z * uu[2], a0.w + b0.w + d0.w * uu[3], a1.x + b1.x + d1.x * uu[4], a1.y + b1.y + d1.y * uu[5], a1.z + b1.z + d1.z * uu[6], a1.w + b1.w + d1.w * uu[7]};
#pragma unroll
                    for (int j = 0; j < 8; ++j) y[j] = 0.5f * y[j] * (1.0f + tanhf(0.7978845608028654f * (y[j] + 0.044715f * y[j] * y[j] * y[j])));
                    w.x = pk2(y[0], y[1]); w.y = pk2(y[2], y[3]); w.z = pk2(y[4], y[5]); w.w = pk2(y[6], y[7]);
                    *(u32x4*)(GG + (size_t)tok * BW + c0) = w; }
            }
            __syncthreads();
            {   float* T = sf;
                for (int unit = (G > 128 ? bid - 128 : bid); unit >= 0 && unit < 4 * 64 * 8; unit += (G > 128 ? G - 128 : G)) { const int b = unit / 512, t0 = ((unit >> 3) & 63) * 64, c0 = (unit & 7) * 64;
                    __syncthreads();
#pragma unroll
                    for (int i = 0; i < 8; ++i) { const int t = tid & 63, c = (tid >> 6) + 8 * i; T[c * 65 + t] = YT[((size_t)b * 512 + c0 + c) * SEQ + t0 + t]; }
                    __syncthreads();
                    const int t = tid >> 3, cq = (tid & 7) * 8;
                    u32x4 w; w.x = pk2(T[(cq + 0) * 65 + t], T[(cq + 1) * 65 + t]); w.y = pk2(T[(cq + 2) * 65 + t], T[(cq + 3) * 65 + t]); w.z = pk2(T[(cq + 4) * 65 + t], T[(cq + 5) * 65 + t]); w.w = pk2(T[(cq + 6) * 65 + t], T[(cq + 7) * 65 + t]);
                    *(u32x4*)(Y4 + ((size_t)b * SEQ + t0 + t) * DM + c0 + cq) = w;
                } }
            SEAM(PB + 5);
        }

        if (IN(PB + 6)) for (int rep_ = 0; rep_ < PROBE_REPS(6); ++rep_) {
            PH_BEGIN
            pg8::Gemm g{GG, GLU, BW, BW, BW}; pg8::SchedStd S{68, 2, G, bid, BW, BW}; pg8::EpiGlu E{GG, PT(33) + l * BW, Y4};
            pg8::gemm_phase((LAS unsigned char*)shm, g, S, E);
            SEAM(PB + 6);
        }
        if (IN(PB + 7)) for (int rep_ = 0; rep_ < PROBE_REPS(7); ++rep_) {
            PH_BEGIN
            pg8::Gemm g{Y4, WBR, DM, BW, BW}; pg8::SchedBranch S{64, 8, G, bid}; pg8::EpiBranch E{P, ACCb};
            pg8::gemm_phase((LAS unsigned char*)shm, g, S, E);
            if (!lastl) { __syncthreads(); pg8::SchedTail S2{G, bid}; pg8::EpiPart E2{P, (float*)HSPEC}; pg8::gemm_phase((LAS unsigned char*)shm, g, S2, E2); }
            SEAM(PB + 7);
        }
        if (IN(PB + 8)) for (int rep_ = 0; rep_ < PROBE_REPS(8); ++rep_) {
            PH_BEGIN
            if (!lastl) {
                const float* PART = (const float*)HSPEC;
                for (int idx = bid * NTHR + tid; idx < (NTOK - NLAT) * DM / 8; idx += G * NTHR) { const size_t o = (size_t)idx * 8; f32x4 p[4][2];
#pragma unroll
                    for (int k = 0; k < 4; ++k) { p[k][0] = *(const f32x4*)(PART + (size_t)k * (NTOK - NLAT) * DM + o); p[k][1] = *(const f32x4*)(PART + (size_t)k * (NTOK - NLAT) * DM + o + 4); }
                    const f32x4 s0 = ((p[0][0] + p[1][0]) + p[2][0]) + p[3][0], s1 = ((p[0][1] + p[1][1]) + p[2][1]) + p[3][1];
                    u32x4 w; w.x = pk2(s0[0], s0[1]); w.y = pk2(s0[2], s0[3]); w.z = pk2(s1[0], s1[1]); w.w = pk2(s1[2], s1[3]);
                    *(u32x4*)(ACCb + (size_t)NLAT * DM + o) = w; }
                xcd_barrier(bar);
            }
            pg8::Gemm g{ACCb, WOUT, DM, DM, DM}; pg8::SchedStd S{64, 8, G, bid, DM, DM}; pg8::EpiResid E{XS, l == 0 ? x_in : (const float*)XS, l == 0 ? ctx_in - (size_t)NLAT * DM : (const float*)XS, MODl, 2};
            pg8::gemm_phase((LAS unsigned char*)shm, g, S, E);
            if (!lastl) { __syncthreads(); pg8::Gemm g2{ACCb, WOUT, DM, DM, 512}; pg8::SchedTailK S2{G, bid}; pg8::EpiPartK E2{(float*)HSPEC + (size_t)4 * (NTOK - NLAT) * DM}; pg8::gemm_phase((LAS unsigned char*)shm, g2, S2, E2); }
            SEAM(PB + 8);
        }
        if (IN(PB + 9)) for (int rep_ = 0; rep_ < PROBE_REPS(9); ++rep_) {
            PH_BEGIN
            if (!lastl) {
                const float* PART = (const float*)HSPEC + (size_t)4 * (NTOK - NLAT) * DM; const float* mg = MODl + (size_t)(4 * 6 + 2) * DM;
                const float* src = l == 0 ? ctx_in : (const float*)XS + (size_t)NLAT * DM;
                for (int idx = bid * NTHR + tid; idx < (NTOK - NLAT) * DM / 4; idx += G * NTHR) { const size_t o = (size_t)idx * 4; const int col = (int)(o & (DM - 1));
                    const f32x4 p0 = *(const f32x4*)(PART + o), p1 = *(const f32x4*)(PART + (size_t)(NTOK - NLAT) * DM + o), p2 = *(const f32x4*)(PART + (size_t)2 * (NTOK - NLAT) * DM + o), p3 = *(const f32x4*)(PART + (size_t)3 * (NTOK - NLAT) * DM + o);
                    const f32x4 sv = *(const f32x4*)(src + o), gm = *(const f32x4*)(mg + col);
                    *(f32x4*)(XS + (size_t)NLAT * DM + o) = sv + gm * (((p0 + p1) + p2) + p3); }
                xcd_barrier(bar);
            }
            for (int i = bid * NTHR + tid; i < NEXP * MOE_PAD; i += G * NTHR) ROWTOK[i] = -1;
            for (int i = bid * NTHR + tid; i < NTOK * 16; i += G * NTHR) INV[i] = -1;
            const float* wr = PT(42) + (size_t)l * DM * 16; const float* gn = norm_ffn + l * DM;
            for (int tok0 = (bid * 8 + wave) * 4; tok0 < M2; tok0 += G * 32) {
                const int r = tok0 < NLAT ? tok0 / SEQ : 4; const float* xr = XS + (size_t)tok0 * DM;
                const float* sh = MODl + (size_t)(r * 6 + 3) * DM; const float* sc = MODl + (size_t)(r * 6 + 4) * DM;
                float rs[4];
#pragma unroll
                for (int tk = 0; tk < 4; ++tk) { float ss = 0.f;
#pragma unroll 4
                    for (int i = 0; i < 8; ++i) { const float4 t4 = *(const float4*)(xr + (size_t)tk * DM + i * 256 + lane * 4); ss += t4.x * t4.x + t4.y * t4.y + t4.z * t4.z + t4.w * t4.w; }
                    ss = wave_sum(ss); rs[tk] = rsqrtf(ss * (1.0f / DM) + 1e-6f); }
                float lg[4][16];
#pragma unroll
                for (int tk = 0; tk < 4; ++tk)
#pragma unroll
                    for (int e = 0; e < 16; ++e) lg[tk][e] = 0.f;
#pragma unroll 1
                for (int i = 0; i < 8; ++i) { const int d = i * 256 + lane * 4;
                    const float4 g4 = *(const float4*)(gn + d), s4 = *(const float4*)(sc + d), h4 = *(const float4*)(sh + d);
                    float4 xq[4], ww[16];
#pragma unroll
                    for (int tk = 0; tk < 4; ++tk) xq[tk] = *(const float4*)(xr + (size_t)tk * DM + d);
                    const float4* wq = (const float4*)(wr + (size_t)d * 16);
#pragma unroll
                    for (int q = 0; q < 16; ++q) ww[q] = wq[q];
                    float hv[4][4];
#pragma unroll
                    for (int tk = 0; tk < 4; ++tk) { const float4 xv = xq[tk]; const float rr = rs[tk];
                        hv[tk][0] = xv.x * rr * g4.x * (1.f + s4.x) + h4.x; hv[tk][1] = xv.y * rr * g4.y * (1.f + s4.y) + h4.y; hv[tk][2] = xv.z * rr * g4.z * (1.f + s4.z) + h4.z; hv[tk][3] = xv.w * rr * g4.w * (1.f + s4.w) + h4.w;
                        u32x2 w; w.x = pk2(hv[tk][0], hv[tk][1]); w.y = pk2(hv[tk][2], hv[tk][3]); *(u32x2*)(HB + (size_t)(tok0 + tk) * DM + d) = w; }
#pragma unroll
                    for (int q = 0; q < 4; ++q) { const float4 w0 = ww[q * 4 + 0], w1 = ww[q * 4 + 1], w2 = ww[q * 4 + 2], w3 = ww[q * 4 + 3];
#pragma unroll
                        for (int tk = 0; tk < 4; ++tk) { const float hq = hv[tk][q];
                            lg[tk][0] += hq * w0.x; lg[tk][1] += hq * w0.y; lg[tk][2] += hq * w0.z; lg[tk][3] += hq * w0.w; lg[tk][4] += hq * w1.x; lg[tk][5] += hq * w1.y; lg[tk][6] += hq * w1.z; lg[tk][7] += hq * w1.w;
                            lg[tk][8] += hq * w2.x; lg[tk][9] += hq * w2.y; lg[tk][10] += hq * w2.z; lg[tk][11] += hq * w2.w; lg[tk][12] += hq * w3.x; lg[tk][13] += hq * w3.y; lg[tk][14] += hq * w3.z; lg[tk][15] += hq * w3.w; } } }
#pragma unroll
                for (int tk = 0; tk < 4; ++tk) { float mx = -1e30f;
#pragma unroll
                    for (int e = 0; e < 16; ++e) { lg[tk][e] = wave_sum(lg[tk][e]); mx = fmaxf(mx, lg[tk][e]); }
                    float sm = 0.f;
#pragma unroll
                    for (int e = 0; e < 16; ++e) { lg[tk][e] = expf(lg[tk][e] - mx); sm += lg[tk][e]; }
                    const float inv = 1.0f / sm;
                    if (lane == 0) {
#pragma unroll
                        for (int e = 0; e < 16; e += 4) *(float4*)(PROBS + (size_t)(tok0 + tk) * 16 + e) = make_float4(lg[tk][e] * inv, lg[tk][e + 1] * inv, lg[tk][e + 2] * inv, lg[tk][e + 3] * inv); } }
            }
            SEAM(PB + 9);
        }
        if (IN(PB + 10)) for (int rep_ = 0; rep_ < PROBE_REPS(10); ++rep_) {
            PH_BEGIN
            const int nitems = 64 + (lastl ? 0 : 64);
            unsigned long long* keys = (unsigned long long*)shm;
            for (int it = bid; it < nitems; it += G) {
                const int set = it >> 6, e = it & 15, b = (it >> 4) & 3;
                const int n = set ? CTXL : SEQ, cap = set ? 32 : 512, tokbase = set ? NLAT + b * CTXL : b * SEQ;
                __syncthreads();
                for (int i = tid; i < n; i += NTHR) keys[i] = ((unsigned long long)__float_as_uint(PROBS[(size_t)(tokbase + i) * 16 + e]) << 32) | (unsigned long long)(0xFFFFFFFFu - (unsigned)i);
                __syncthreads();
                for (int k = 2; k <= n; k <<= 1)
                    for (int j = k >> 1; j > 0; j >>= 1) {
                        for (int p = tid; p < (n >> 1); p += NTHR) { const int i = ((p & ~(j - 1)) << 1) | (p & (j - 1)); const int m = i | j;
                            const unsigned long long ka = keys[i], kb = keys[m]; const bool desc = ((i & k) == 0);
                            if ((ka < kb) == desc) { keys[i] = kb; keys[m] = ka; } }
                        __syncthreads();
                    }
                for (int r = tid; r < cap; r += NTHR) { const unsigned long long kk = keys[r]; const int row = e * MOE_PAD + (set ? 2048 + b * 32 + r : b * 512 + r);
                    const int tk_ = tokbase + (int)(0xFFFFFFFFu - (unsigned)(kk & 0xFFFFFFFFull)); ROWTOK[row] = tk_; ROWGATE[row] = __uint_as_float((unsigned)(kk >> 32)); INV[tk_ * 16 + e] = row; }
                for (int rb = 0; rb < cap; rb += 32) {
                    u32x4 t4[4][4];
#pragma unroll
                    for (int q = 0; q < 4; ++q) { const int r = rb + wave + 8 * q; const int tok = tokbase + (int)(0xFFFFFFFFu - (unsigned)(keys[r] & 0xFFFFFFFFull));
                        const u32x4* sp = (const u32x4*)(HB + (size_t)tok * DM);
#pragma unroll
                        for (int i = 0; i < 4; ++i) t4[q][i] = sp[i * 64 + lane]; }
#pragma unroll
                    for (int q = 0; q < 4; ++q) { const int r = rb + wave + 8 * q; const int row = e * MOE_PAD + (set ? 2048 + b * 32 + r : b * 512 + r);
                        u32x4* dp = (u32x4*)(XG + (size_t)row * DM);
#pragma unroll
                        for (int i = 0; i < 4; ++i) dp[i * 64 + lane] = t4[q][i]; } }
            }
            if (!lastl && G > 128 && bid >= 128) {
                const int n_win = 32 * 55, n_br = 4 * 64, n_out = 32 * 8, n_glu = 16, n_gu = 16 * 2 * 192; (void)n_gu;
                CV_RUN(l + 1, bid - 128, G - 128, n_win); (void)n_br; (void)n_out; (void)n_glu;
            }
            {   const int pad0 = lastl ? 2048 : MOE_ROWS, npad = MOE_PAD - pad0;
                for (int R = bid * 8 + wave; R < NEXP * npad; R += G * 8) { const int e = R / npad, rr = pad0 + R % npad; u32x4* dp = (u32x4*)(XG + ((size_t)e * MOE_PAD + rr) * DM);
#pragma unroll
                    for (int i = 0; i < 4; ++i) dp[i * 64 + lane] = (u32x4){0u, 0u, 0u, 0u}; } }
            SEAM(PB + 10);
        }
        if (IN(PB + 12)) for (int rep_ = 0; rep_ < PROBE_REPS(12); ++rep_) {
            PH_BEGIN
            pg8::Gemm g{XG, WGU, DM, DM, DM}; pg8::SchedMoe S{lastl ? 8 : 9, 12, G, bid, DM, DM, 2 * DEXP}; pg8::EpiMoe1 E{HID};
            pg8::gemm_phase((LAS unsigned char*)shm, g, S, E);
            SEAM(PB + 12);
        }
        if (IN(PB + 13)) for (int rep_ = 0; rep_ < PROBE_REPS(13); ++rep_) {
            PH_BEGIN
            pg8::Gemm g{HID, WD, DEXP, DEXP, DEXP}; pg8::SchedMoe S{lastl ? 8 : 9, 8, G, bid, DEXP, DEXP, DM}; pg8::EpiMoeY E{YEXP};
            pg8::gemm_phase((LAS unsigned char*)shm, g, S, E);
            SEAM(PB + 13);
        }

}

__global__ __launch_bounds__(NTHR, 2) void fwd(Args a) {
    extern __shared__ __attribute__((aligned(16))) unsigned char shm[];
    const int bid = blockIdx.x, G = gridDim.x;
    float* const sf = (float*)shm;
    volatile LAS unsigned* xbw = (volatile LAS unsigned*)((LAS unsigned char*)shm + (LDS_BYTES - 16));
    if (threadIdx.x == 0) { xbw[0] = 0u; xbw[1] = 0u; xbw[2] = 0u; xbw[3] = 0u; }
    const float** const ptab = (const float**)(shm + (LDS_BYTES - 16 - 512));
    if (threadIdx.x == 0) {
#pragma unroll
        for (int i = 0; i < 47; ++i) ptab[i] = a.in[i]; }
    __syncthreads();
    XcdBarrier bar = xcd_barrier_post((unsigned*)(a.ws + O_BAR), xbw);
    const int lo = a.ph_lo, hi = a.ph_hi;
    if (IN(0)) {
        PH_BEGIN
        {
            __syncthreads();
            for (int i = tid; i < 5 * DM; i += NTHR) { const int r = i >> 11, k = i & (DM - 1); const float v = r < 4 ? c_in[r * DM + k] : cctx_in[k]; sf[i] = siluf_(v); }
            __syncthreads();
            float* red = sf + 5 * DM;
            for (int unit = bid; unit < 2 * 96; unit += G) { const int l = unit / 96, j = (unit % 96) * 128 + (tid & 127), kq = tid >> 7;
                const float* w = ada_w + (size_t)l * DM * (6 * DM) + (size_t)(kq * 512) * (6 * DM) + j; const float* sv = sf + kq * 512;
                float a0 = 0.f, a1 = 0.f, a2 = 0.f, a3 = 0.f, a4 = 0.f;
#pragma unroll 8
                for (int k = 0; k < 512; ++k) { const float wv = w[(size_t)k * (6 * DM)]; a0 += sv[k] * wv; a1 += sv[DM + k] * wv; a2 += sv[2 * DM + k] * wv; a3 += sv[3 * DM + k] * wv; a4 += sv[4 * DM + k] * wv; }
                __syncthreads();
                { float* rp = red + (kq * 5) * 128 + (tid & 127); rp[0] = a0; rp[128] = a1; rp[256] = a2; rp[384] = a3; rp[512] = a4; }
                __syncthreads();
                if (tid < 128) { const float bb = ada_b[l * 6 * DM + j]; float* o = MOD + (size_t)l * 5 * 6 * DM + j;
#pragma unroll
                    for (int r = 0; r < 5; ++r) o[(size_t)r * 6 * DM] = ((red[(0 * 5 + r) * 128 + tid] + red[(1 * 5 + r) * 128 + tid]) + (red[(2 * 5 + r) * 128 + tid] + red[(3 * 5 + r) * 128 + tid])) + bb; }
            }
        }
    }

    layer_body<0>(a, bar, lo, hi, bid, G, shm, sf, ptab);
    layer_body<1>(a, bar, lo, hi, bid, G, shm, sf, ptab);
    if (IN(33)) {
        PH_BEGIN
        const float* gn = PT(46);
        for (int tok = bid * 8 + wave; tok < NLAT; tok += G * 8) {
            const float* xr = XS + (size_t)tok * DM; float4 v[8]; float ss = 0.f;
#pragma unroll
            for (int i = 0; i < 8; ++i) v[i] = *(const float4*)(xr + i * 256 + lane * 4);
            moe_combine(v, tok, lane, INV, ROWGATE, YEXP, MOD + (size_t)(1 * 5 + tok / SEQ) * 6 * DM + 5 * DM);
#pragma unroll
            for (int i = 0; i < 8; ++i) {                 ss += v[i].x * v[i].x + v[i].y * v[i].y + v[i].z * v[i].z + v[i].w * v[i].w; }
            ss = wave_sum(ss); const float rs = rsqrtf(ss * (1.0f / DM) + 1e-6f);
#pragma unroll
            for (int i = 0; i < 8; ++i) { const int d = i * 256 + lane * 4; const float4 g4 = *(const float4*)(gn + d);
                *(float4*)(a.out + (size_t)tok * DM + d) = make_float4(v[i].x * rs * g4.x, v[i].y * rs * g4.y, v[i].z * rs * g4.z, v[i].w * rs * g4.w); }
        }
    }
#undef IN
#undef SEAM
}


extern "C" void kernel_launch(void* const* d_in, const int* in_sizes, int n_in, void* d_out, int out_size, void* d_ws, size_t ws_size, hipStream_t stream) {
    static int grid = 0;
    if (grid == 0) {
        if (n_in != 47 || ws_size < WS_END) { fprintf(stderr, "kernel_launch: expected 47 inputs and >= %zu bytes of workspace; got %d, %zu\n", (size_t)WS_END, n_in, ws_size); grid = -1; return; }
        int dev = 0, cus = 0;
        if (hipGetDevice(&dev) != hipSuccess || hipDeviceGetAttribute(&cus, hipDeviceAttributeMultiprocessorCount, dev) != hipSuccess) { grid = -1; return; }
        if (hipFuncSetAttribute((const void*)fwd, hipFuncAttributeMaxDynamicSharedMemorySize, LDS_BYTES) != hipSuccess) { fprintf(stderr, "kernel_launch: hipFuncSetAttribute failed\n"); grid = -1; return; }
        int per_cu = 0;
        if (hipOccupancyMaxActiveBlocksPerMultiprocessor(&per_cu, (const void*)fwd, NTHR, LDS_BYTES) != hipSuccess || per_cu < 1) fprintf(stderr, "kernel_launch: occupancy query reports %d\n", per_cu);
        (void)hipGetLastError();
        grid = cus > 256 ? 256 : cus;
        if (grid < 224) { fprintf(stderr, "kernel_launch: needs >= 224 CUs (got %d)\n", grid); grid = -1; return; }
    }
    if (grid < 0) return;
    (void)hipMemsetAsync((char*)d_ws, 0, O_ZERO_END, stream);
    Args a{};
    for (int i = 0; i < 47; ++i) a.in[i] = (const float*)d_in[i];
    a.out = (float*)d_out; a.ws = (unsigned char*)d_ws;
#if MK_ONE_LAUNCH
    a.ph_lo = 0; a.ph_hi = 64;
    hipLaunchKernelGGL(fwd, dim3(grid), dim3(NTHR), LDS_BYTES, stream, a);
#else
    const int ids[] = {0, 1,2,3,4,5,6,7,8,9,10,11,12,13,14, 17,18,19,20,21,22,23,24,25,26,27,28,29,30, 33};
    for (int k = 0; k < (int)(sizeof(ids) / sizeof(ids[0])); ++k) { a.ph_lo = ids[k]; a.ph_hi = ids[k] + 1; hipLaunchKernelGGL(fwd, dim3(grid), dim3(NTHR), LDS_BYTES, stream, a); }
#endif
}
```

```cpp
#include <hip/hip_runtime.h>
#include <stdint.h>
#include <stdio.h>

#ifndef PROBE_MASK
#define PROBE_MASK 0
#endif
#ifndef PROBE_SP
#define PROBE_SP 1
#endif
#define PROBE_REPS(k) ((((PROBE_MASK) >> (k)) & 1) + 1)
#ifndef MK_ONE_LAUNCH
#define MK_ONE_LAUNCH 1
#endif

#define DM 2048
#define NB 4
#define SEQ 4096
#define CTXL 256
#define BW 512
#define NLAT 16384
#define NCTX 1024
#define NTOK 17408
#define IN_W 13856
#define LDP 14080
#define HY_OFF 0
#define ML_OFF 1536
#define S5_OFF 3600
#define SSD_OFF 4112
#define GATE_OFF 5664
#define NEXP 16
#define DEXP 1536
#define MOE_ROWS 2176
#define MOE_PAD 2304
#define NTHR 512
#define LDS_BYTES 147456
#define LAS __attribute__((address_space(3)))

typedef unsigned short bf16_t;
typedef short bf16x8 __attribute__((ext_vector_type(8)));
typedef float f32x4 __attribute__((ext_vector_type(4)));
typedef unsigned u32x4 __attribute__((ext_vector_type(4)));
typedef unsigned u32x2 __attribute__((ext_vector_type(2)));

#define XB_TMO      128
#define XB_XCNT(j)  (256  + 64 * (j))
#define XB_XSUB(j)  (1280 + 64 * (j))
#define XB_XGEN(j)  (2304 + 64 * (j))
#define XB_TOP      3328
#define XB_TOPGEN   3392
#define XCD_BAR_WORDS 3456
#define XB_SPIN_CAP (1u << 18)
__device__ __forceinline__ unsigned xb_ld(unsigned* p)              { return __hip_atomic_load(p, __ATOMIC_RELAXED, __HIP_MEMORY_SCOPE_AGENT); }
__device__ __forceinline__ unsigned xb_add(unsigned* p, unsigned v) { return __hip_atomic_fetch_add(p, v, __ATOMIC_RELAXED, __HIP_MEMORY_SCOPE_AGENT); }
__device__ __forceinline__ unsigned xb_xcc_id() { return (unsigned)__builtin_amdgcn_s_getreg((3 << 11) | 20) & 0xFu; }
#define XB_SPIN(cond, bar) do { unsigned _sp = 0; while (cond) { __builtin_amdgcn_s_sleep(1); \
    if ((++_sp & 255u) == 0u) { if (xb_ld(&(bar)[XB_TMO])) break; if (_sp > XB_SPIN_CAP) { atomicAdd(&(bar)[XB_TMO], 1u); break; } } } } while (0)
struct XcdBarrier { unsigned* bar; unsigned x; volatile LAS unsigned* st; };
__device__ __forceinline__ XcdBarrier xcd_barrier_post(unsigned* bar, volatile LAS unsigned* st) {
    XcdBarrier b; b.bar = bar; b.x = xb_xcc_id(); b.st = st;
    if (threadIdx.x == 0) (void)xb_add(&bar[XB_XCNT(b.x)], 1u);
    return b;
}
__device__ __forceinline__ void xcd_barrier_complete(unsigned* bar, unsigned x, unsigned& nloc, unsigned& nx) {
    const unsigned G = gridDim.x * gridDim.y * gridDim.z;
    unsigned sum, cnt, mine, sp = 0u;
    for (;;) {
        sum = 0u; cnt = 0u; mine = 0u;
#pragma unroll
        for (unsigned j = 0; j < 16; ++j) { const unsigned c = xb_ld(&bar[XB_XCNT(j)]); sum += c; cnt += (c > 0u) ? 1u : 0u; mine = (j == x) ? c : mine; }
        if (sum == G) break;
        __builtin_amdgcn_s_sleep(1);
        if ((++sp & 255u) == 0u) { if (xb_ld(&bar[XB_TMO])) break; if (sp > XB_SPIN_CAP) { atomicAdd(&bar[XB_TMO], 1u); break; } }
    }
    nloc = mine > 0u ? mine : 1u; nx = cnt > 0u ? cnt : 1u;
}
__device__ __forceinline__ void xcd_barrier(const XcdBarrier& b) {
    asm volatile("s_waitcnt vmcnt(0)" ::: "memory");
    __syncthreads();
    if (threadIdx.x == 0) {
        unsigned* bar = b.bar;
        __builtin_amdgcn_s_waitcnt(0);
        unsigned nloc = b.st[0], nx = b.st[1];
        if (nloc == 0u) { xcd_barrier_complete(bar, b.x, nloc, nx); b.st[0] = nloc; b.st[1] = nx; }
        const unsigned old = xb_add(&bar[XB_XSUB(b.x)], 1u);
        const unsigned gen = old / nloc;
        if (old + 1u == (gen + 1u) * nloc) {
            __builtin_amdgcn_fence(__ATOMIC_RELEASE, "agent");
            asm volatile("s_waitcnt vmcnt(0)" ::: "memory");
            const unsigned og = xb_add(&bar[XB_TOP], 1u);
            const unsigned tg = og / nx;
            if (og + 1u == (tg + 1u) * nx) xb_add(&bar[XB_TOPGEN], 1u);
            else XB_SPIN(xb_ld(&bar[XB_TOPGEN]) == tg, bar);
            __builtin_amdgcn_fence(__ATOMIC_ACQUIRE, "agent");
            xb_add(&bar[XB_XGEN(b.x)], 1u);
            asm volatile("s_waitcnt vmcnt(0)" ::: "memory");
        } else {
            XB_SPIN(xb_ld(&bar[XB_XGEN(b.x)]) == gen, bar);
            __builtin_amdgcn_fence(__ATOMIC_ACQUIRE, "agent");
            asm volatile("s_waitcnt vmcnt(0)" ::: "memory");
        }
    }
    __syncthreads();
}

__device__ __forceinline__ unsigned short f2bf(float f) { unsigned u = __float_as_uint(f); u += 0x7FFFu + ((u >> 16) & 1u); return (unsigned short)(u >> 16); }
__device__ __forceinline__ float bf2f(unsigned short b) { return __uint_as_float(((unsigned)b) << 16); }
__device__ __forceinline__ unsigned pk2(float lo, float hi) { unsigned r; asm("v_cvt_pk_bf16_f32 %0, %1, %2" : "=v"(r) : "v"(lo), "v"(hi)); return r; }
__device__ __forceinline__ float sigmoidf_(float x) { return 1.0f / (1.0f + expf(-x)); }
__device__ __forceinline__ float siluf_(float x) { return x / (1.0f + expf(-x)); }
__device__ __forceinline__ float wave_sum(float v) {
#pragma unroll
    for (int o = 32; o >= 1; o >>= 1) v += __shfl_xor(v, o);
    return v;
}
__device__ __forceinline__ const float* uptr(const float* p) { const unsigned long long v = (unsigned long long)p;
    const unsigned lo = __builtin_amdgcn_readfirstlane((unsigned)v), hi = __builtin_amdgcn_readfirstlane((unsigned)(v >> 32)); return (const float*)(((unsigned long long)hi << 32) | lo); }
#define PT(k) uptr(ptab[k])
__device__ __forceinline__ int step_tok(int b, int dir, int i) {
    if (i < CTXL) { const int tt = dir ? (CTXL - 1 - i) : i; return NLAT + b * CTXL + tt; }
    const int j = i - CTXL; const int tt = dir ? (SEQ - 1 - j) : j; return b * SEQ + tt;
}
__device__ __forceinline__ void unpack8(const u32x4 w, float (&f)[8]) {
    f[0] = __uint_as_float(w.x << 16); f[1] = __uint_as_float(w.x & 0xFFFF0000u); f[2] = __uint_as_float(w.y << 16); f[3] = __uint_as_float(w.y & 0xFFFF0000u);
    f[4] = __uint_as_float(w.z << 16); f[5] = __uint_as_float(w.z & 0xFFFF0000u); f[6] = __uint_as_float(w.w << 16); f[7] = __uint_as_float(w.w & 0xFFFF0000u);
}

namespace pg8 {
constexpr int BM = 256, BK = 64, HALF = 128, HTB = HALF * BK * 2, STAGE_BYTES = 8 * HTB, NXCD = 8, WGM = 8;
__host__ __device__ __forceinline__ int lds_byte(int r, int c) { const int st = (r >> 4) * 2 + (c >> 5), rr = r & 15, cc = c & 31, ob = rr * 64 + cc * 2; return st * 1024 + (ob ^ (((ob >> 9) & 1) << 5)); }
__host__ __device__ __forceinline__ void stage_rc(int b, int& R, int& C) { const int st = b / 1024, sb = b % 1024, swz = sb ^ (((sb >> 9) & 1) << 5); R = (st >> 1) * 16 + swz / 64; C = (st & 1) * 32 + (swz % 64) / 2; }
__host__ __device__ __forceinline__ int perm32(int rho) { const int n = rho >> 4, i = rho & 15; return 8 * (i >> 2) + 4 * n + (i & 3); }
struct Unit { int pm, pn, z, k; long long ao, bo; };
struct Gemm { const bf16_t* A; const bf16_t* Bt; int lda, ldb, K; };

__device__ __forceinline__ void tile_of(int wgid, int nM, int nN, int& pm, int& pn) {
    const int nwg = nM * nN; { const int q = nwg / NXCD, r = nwg % NXCD, xcd = wgid % NXCD, off = wgid / NXCD; wgid = (xcd < r ? xcd * (q + 1) : r * (q + 1) + (xcd - r) * q) + off; }
    const int nig = WGM * nN, gid = wgid / nig, fm = gid * WGM, gsz = (nM - fm) < WGM ? (nM - fm) : WGM;
    pm = fm + ((wgid % nig) % gsz); pn = (wgid % nig) / gsz;
}
struct SchedStd {
    int nM, nN, G, c, lda, ldb;
    __device__ __forceinline__ bool next(int i, Unit& u) const { const long L = (long)i * G + c; if (L >= (long)nM * nN) return false; tile_of((int)L, nM, nN, u.pm, u.pn); u.z = 0; u.k = 0;
        u.ao = (long long)u.pm * BM * lda * 2; u.bo = (long long)u.pn * BM * ldb * 2; return true; }
    __device__ __forceinline__ void a_ready(const Unit&) const {}
    __device__ __forceinline__ void done(const Unit&) const {}
};
struct SchedBranch {
    int nM, nN, G, c;
    __device__ __forceinline__ bool next(int i, Unit& u) const { const long L = (long)(i >> 2) * G + c; if (L >= (long)nM * nN) return false; tile_of((int)L, nM, nN, u.pm, u.pn); u.z = 0; u.k = i & 3;
        u.ao = ((long long)u.pm * BM * DM + u.k * BW) * 2; u.bo = ((long long)u.k * DM + u.pn * BM) * BW * 2; return true; }
    __device__ __forceinline__ void a_ready(const Unit&) const {}
    __device__ __forceinline__ void done(const Unit&) const {}
};
struct SchedTail {
    int G, c;
    __device__ __forceinline__ bool next(int i, Unit& u) const { const long T = (long)i * G + c; if (T >= 128) return false; const int t = (int)(T >> 2); u.pm = 64 + (t >> 3); u.pn = t & 7; u.z = 1; u.k = (int)(T & 3);
        u.ao = ((long long)u.pm * BM * DM + u.k * BW) * 2; u.bo = ((long long)u.k * DM + u.pn * BM) * BW * 2; return true; }
    __device__ __forceinline__ void a_ready(const Unit&) const {}
    __device__ __forceinline__ void done(const Unit&) const {}
};
struct SchedTailK {
    int G, c;
    __device__ __forceinline__ bool next(int i, Unit& u) const { const long T = (long)i * G + c; if (T >= 128) return false; const int t = (int)(T >> 2); u.pm = 64 + (t >> 3); u.pn = t & 7; u.z = 1; u.k = (int)(T & 3);
        u.ao = ((long long)u.pm * BM * DM + u.k * 512) * 2; u.bo = ((long long)u.pn * BM * DM + u.k * 512) * 2; return true; }
    __device__ __forceinline__ void a_ready(const Unit&) const {}
    __device__ __forceinline__ void done(const Unit&) const {}
};
struct SchedMoe {
    int nPm, nPn, G, c, lda, ldb, nBrows;
    __device__ __forceinline__ bool next(int i, Unit& u) const { const long L = (long)i * G + c; const int per = nPm * nPn; if (L >= (long)NEXP * per) return false; const int e = (int)(L / per), rem = (int)(L % per);
        u.z = e; u.k = 0; u.pm = rem % nPm; u.pn = rem / nPm; u.ao = ((long long)e * MOE_PAD + u.pm * BM) * lda * 2; u.bo = ((long long)e * nBrows + u.pn * BM) * ldb * 2; return true; }
    __device__ __forceinline__ void a_ready(const Unit&) const {}
    __device__ __forceinline__ void done(const Unit&) const {}
};

typedef f32x4 Acc[2][2][4][2];
template <class Epi, class Sched>
__device__ __forceinline__ void gemm_phase(LAS unsigned char* lds, const Gemm g, const Sched& S, const Epi& E) {
    int tid = threadIdx.x; asm volatile("" : "+v"(tid));
    const int wid = __builtin_amdgcn_readfirstlane(tid >> 6), lane = tid & 63, wr = wid >> 2, wc = wid & 3, fr = lane & 15, fq = lane >> 4;
    const int K = g.K, nt = K / BK;
    unsigned voffA[2], voffB[2];
#pragma unroll
    for (int i = 0; i < 2; ++i) { int R, C; stage_rc(tid * 16 + i * 8192, R, C); const int Rb = Epi::PERM ? ((R & ~31) + perm32(R & 31)) : R;
        voffA[i] = (unsigned)(R * g.lda + C) * 2u; voffB[i] = (unsigned)(Rb * g.ldb + C) * 2u; }
    const size_t kstep = (size_t)(BK * 2);
    const size_t hstepA = (size_t)HALF * g.lda * 2, hstepB = (size_t)HALF * g.ldb * 2;
    const unsigned ldsw = (unsigned)wid * 1024u;
    const int aoff = lds_byte(wr * 64 + fr, fq * 8), boff = lds_byte(wc * 32 + fr, fq * 8);
#define PG8_SA(b, h) (((b) * 2 + (h)) * HTB)
#define PG8_SB(b, h) ((4 + (b) * 2 + (h)) * HTB)
#define PG8_STAGE(bufoff, gbase, voff) do { _Pragma("unroll") for (int _i = 0; _i < 2; ++_i) \
        __builtin_amdgcn_global_load_lds((const unsigned*)((const char*)(gbase) + (voff)[_i]), (LAS unsigned*)(lds + (bufoff) + ldsw + _i * 8192), 16, 0, 0); } while (0)
#define PG8_LDA(dst, b, h) do { _Pragma("unroll") for (int m = 0; m < 4; ++m) _Pragma("unroll") for (int k = 0; k < 2; ++k) dst[m][k] = *(const LAS bf16x8*)(lds + PG8_SA(b, h) + aoff + m * 2048 + k * 1024); } while (0)
#define PG8_LDB(dst, b, h) do { _Pragma("unroll") for (int n = 0; n < 2; ++n) _Pragma("unroll") for (int k = 0; k < 2; ++k) dst[n][k] = *(const LAS bf16x8*)(lds + PG8_SB(b, h) + boff + n * 2048 + k * 1024); } while (0)
#define PG8_MMA(ai, bj, At, Bt) do { __builtin_amdgcn_s_setprio(1); _Pragma("unroll") for (int m = 0; m < 4; ++m) _Pragma("unroll") for (int n = 0; n < 2; ++n) _Pragma("unroll") for (int k = 0; k < 2; ++k) \
        acc[ai][bj][m][n] = __builtin_amdgcn_mfma_f32_16x16x32_bf16(Bt[n][k], At[m][k], acc[ai][bj][m][n], 0, 0, 0); __builtin_amdgcn_s_setprio(0); } while (0)
#define PG8_WAIT_V(n) asm volatile("s_waitcnt vmcnt(" #n ")" ::: "memory")
#define PG8_WAIT_L(n) asm volatile("s_waitcnt lgkmcnt(" #n ")" ::: "memory")
#define PG8_BAR __builtin_amdgcn_s_barrier()
#define PG8_SCHED __builtin_amdgcn_sched_barrier(0)
    Unit cur, nxt; int ui = 0;
    if (!S.next(0, cur)) return;
    Acc acc;
#pragma unroll
    for (int a = 0; a < 2; ++a)
#pragma unroll
        for (int b = 0; b < 2; ++b)
#pragma unroll
            for (int m = 0; m < 4; ++m)
#pragma unroll
                for (int n = 0; n < 2; ++n) acc[a][b][m][n] = (f32x4){0.f, 0.f, 0.f, 0.f};
    bf16x8 At[4][2], B0[2][2], B1[2][2];
    const char* cA = (const char*)g.A + cur.ao; const char* cB = (const char*)g.Bt + cur.bo;
    S.a_ready(cur);
    PG8_STAGE(PG8_SB(0, 0), cB, voffB); PG8_STAGE(PG8_SA(0, 0), cA, voffA); PG8_STAGE(PG8_SB(0, 1), cB + hstepB, voffB); PG8_STAGE(PG8_SA(0, 1), cA + hstepA, voffA);
    if (wr == 1) PG8_BAR;
    PG8_WAIT_V(4); PG8_BAR;
    PG8_STAGE(PG8_SB(1, 0), cB + kstep, voffB); PG8_STAGE(PG8_SA(1, 0), cA + kstep, voffA); PG8_STAGE(PG8_SB(1, 1), cB + hstepB + kstep, voffB);
    PG8_WAIT_V(6); PG8_BAR;
    for (;;) {
        const bool has_next = S.next(ui + 1, nxt);
        const char* nA = has_next ? (const char*)g.A + nxt.ao : cA; const char* nB = has_next ? (const char*)g.Bt + nxt.bo : cB;
        for (int t = 0; t < nt; t += 2) {
            const bool last = (t == nt - 2);
            const char* a1 = cA + (size_t)(t + 1) * kstep;
            const char* a2 = last ? nA : cA + (size_t)(t + 2) * kstep; const char* b2 = last ? nB : cB + (size_t)(t + 2) * kstep;
            const char* a3 = a2 + kstep; const char* b3 = b2 + kstep;
            if (last && has_next) S.a_ready(nxt);
            PG8_LDB(B0, 0, 0); PG8_SCHED; PG8_LDA(At, 0, 0); PG8_STAGE(PG8_SA(1, 1), a1 + hstepA, voffA);
            PG8_WAIT_L(8); PG8_BAR; PG8_WAIT_L(0); PG8_MMA(0, 0, At, B0); PG8_BAR; PG8_SCHED;
            PG8_LDB(B1, 0, 1); PG8_STAGE(PG8_SB(0, 0), b2, voffB);
            PG8_BAR; PG8_WAIT_L(0); PG8_MMA(0, 1, At, B1); PG8_BAR;
            PG8_LDA(At, 0, 1); PG8_STAGE(PG8_SA(0, 0), a2, voffA);
            PG8_BAR; PG8_WAIT_L(0); PG8_MMA(1, 0, At, B0); PG8_BAR; PG8_SCHED;
            PG8_STAGE(PG8_SB(0, 1), b2 + hstepB, voffB);
            PG8_WAIT_V(6); PG8_BAR; PG8_MMA(1, 1, At, B1); PG8_BAR;
            PG8_LDB(B0, 1, 0); PG8_SCHED; PG8_LDA(At, 1, 0); PG8_STAGE(PG8_SA(0, 1), a2 + hstepA, voffA);
            PG8_WAIT_L(8); PG8_BAR; PG8_WAIT_L(0); PG8_MMA(0, 0, At, B0); PG8_BAR; PG8_SCHED;
            PG8_LDB(B1, 1, 1); PG8_STAGE(PG8_SB(1, 0), b3, voffB);
            PG8_BAR; PG8_WAIT_L(0); PG8_MMA(0, 1, At, B1); PG8_BAR;
            PG8_LDA(At, 1, 1); PG8_STAGE(PG8_SA(1, 0), a3, voffA);
            PG8_BAR; PG8_WAIT_L(0); PG8_MMA(1, 0, At, B0); PG8_BAR; PG8_SCHED;
            PG8_STAGE(PG8_SB(1, 1), b3 + hstepB, voffB);
            PG8_WAIT_V(6); PG8_BAR; PG8_MMA(1, 1, At, B1); PG8_BAR;
        }
        const bool keep = E(acc, cur, wr, wc, fr, fq); S.done(cur);
        if (!has_next) break;
        if (!keep) {
#pragma unroll
        for (int a = 0; a < 2; ++a)
#pragma unroll
            for (int b = 0; b < 2; ++b)
#pragma unroll
                for (int m = 0; m < 4; ++m)
#pragma unroll
                    for (int n = 0; n < 2; ++n) acc[a][b][m][n] = (f32x4){0.f, 0.f, 0.f, 0.f};
        }
        cur = nxt; cA = nA; cB = nB; ++ui;
    }
    PG8_WAIT_V(0);
    if (wr == 0) PG8_BAR;
    PG8_BAR;
#undef PG8_SA
#undef PG8_SB
#undef PG8_STAGE
#undef PG8_LDA
#undef PG8_LDB
#undef PG8_MMA
#undef PG8_WAIT_V
#undef PG8_WAIT_L
#undef PG8_BAR
#undef PG8_SCHED
}

struct EpiBf16Store {
    static constexpr bool PERM = true;
    bf16_t* O; int ldc;
    __device__ __forceinline__ bool operator()(Acc& acc, const Unit& u, int wr, int wc, int fr, int fq) const {
        const int row0 = u.pm * BM + wr * 64 + fr, col0 = u.pn * BM + wc * 32 + 8 * fq;
#pragma unroll
        for (int ai = 0; ai < 2; ++ai)
#pragma unroll
            for (int m = 0; m < 4; ++m) { bf16_t* rowp = O + (size_t)(row0 + ai * HALF + m * 16) * ldc + col0;
#pragma unroll
                for (int bj = 0; bj < 2; ++bj) { const f32x4 v0 = acc[ai][bj][m][0], v1 = acc[ai][bj][m][1];
                    u32x4 w; w.x = pk2(v0[0], v0[1]); w.y = pk2(v0[2], v0[3]); w.z = pk2(v1[0], v1[1]); w.w = pk2(v1[2], v1[3]);
                    *(u32x4*)(rowp + bj * HALF) = w; } }
        return false;
    }
};
struct EpiWin {
    static constexpr bool PERM = true;
    bf16_t* O; int ldc;
    __device__ __forceinline__ bool operator()(Acc& acc, const Unit& u, int wr, int wc, int fr, int fq) const {
        const int row0 = u.pm * BM + wr * 64 + fr, col0 = u.pn * BM + wc * 32 + 8 * fq;
#pragma unroll
        for (int bj = 0; bj < 2; ++bj) { const bool gate = (col0 + bj * HALF) >= GATE_OFF;
#pragma unroll
            for (int ai = 0; ai < 2; ++ai)
#pragma unroll
                for (int m = 0; m < 4; ++m) { f32x4 v0 = acc[ai][bj][m][0], v1 = acc[ai][bj][m][1];
                    if (gate) {
#pragma unroll
                        for (int j = 0; j < 4; ++j) { v0[j] = __builtin_amdgcn_rcpf(1.0f + __expf(-v0[j])); v1[j] = __builtin_amdgcn_rcpf(1.0f + __expf(-v1[j])); } }
                    u32x4 w; w.x = pk2(v0[0], v0[1]); w.y = pk2(v0[2], v0[3]); w.z = pk2(v1[0], v1[1]); w.w = pk2(v1[2], v1[3]);
                    *(u32x4*)(O + (size_t)(row0 + ai * HALF + m * 16) * ldc + col0 + bj * HALF) = w; } }
        return false;
    }
};
struct EpiNone { static constexpr bool PERM = true;
    __device__ __forceinline__ bool operator()(Acc& acc, const Unit&, int, int, int, int) const {
#pragma unroll
        for (int a = 0; a < 2; ++a)
#pragma unroll
            for (int b = 0; b < 2; ++b)
#pragma unroll
                for (int m = 0; m < 4; ++m)
#pragma unroll
                    for (int n = 0; n < 2; ++n) asm volatile("" :: "v"(acc[a][b][m][n]));
        return false; } };
struct EpiGlu {
    static constexpr bool PERM = true;
    const bf16_t* GG; const float* bias; bf16_t* Y4;
    __device__ __forceinline__ bool operator()(Acc& acc, const Unit& u, int wr, int wc, int fr, int fq) const {
        const int row0 = u.pm * BM + wr * 64 + fr, col0 = u.pn * BM + wc * 32 + 8 * fq;
#pragma unroll
        for (int bj = 0; bj < 2; ++bj) { const int col = col0 + bj * HALF; const f32x4 b0 = *(const f32x4*)(bias + col), b1 = *(const f32x4*)(bias + col + 4);
            u32x4 gq[2][4];
#pragma unroll
            for (int ai = 0; ai < 2; ++ai)
#pragma unroll
                for (int m = 0; m < 4; ++m) gq[ai][m] = *(const u32x4*)(GG + (size_t)(row0 + ai * HALF + m * 16) * BW + col);
#pragma unroll
            for (int ai = 0; ai < 2; ++ai)
#pragma unroll
                for (int m = 0; m < 4; ++m) { const size_t row = (size_t)(row0 + ai * HALF + m * 16);
                    float gg[8]; unpack8(gq[ai][m], gg);
                    const f32x4 v0 = acc[ai][bj][m][0] + b0, v1 = acc[ai][bj][m][1] + b1;
                    u32x4 w; w.x = pk2(gg[0] * sigmoidf_(v0[0]), gg[1] * sigmoidf_(v0[1])); w.y = pk2(gg[2] * sigmoidf_(v0[2]), gg[3] * sigmoidf_(v0[3]));
                    w.z = pk2(gg[4] * sigmoidf_(v1[0]), gg[5] * sigmoidf_(v1[1])); w.w = pk2(gg[6] * sigmoidf_(v1[2]), gg[7] * sigmoidf_(v1[3]));
                    *(u32x4*)(Y4 + row * DM + 1024 + col) = w; } }
        return false;
    }
};
struct EpiBranch {
    static constexpr bool PERM = true;
    const bf16_t* P; bf16_t* ACCb;
    __device__ __forceinline__ bool operator()(Acc& acc, const Unit& u, int wr, int wc, int fr, int fq) const {
        const int row0 = u.pm * BM + wr * 64 + fr, col0 = u.pn * BM + wc * 32 + 8 * fq; const int k = u.k;
        const bf16_t* gbase = P + (size_t)row0 * LDP + GATE_OFF + k * DM + col0;
        if (k < 3) {
#pragma unroll
            for (int ai = 0; ai < 2; ++ai) {
                u32x4 ga[8], gb[8];
#pragma unroll
                for (int m = 0; m < 4; ++m)
#pragma unroll
                    for (int bj = 0; bj < 2; ++bj) { const bf16_t* p = gbase + (size_t)(ai * HALF + m * 16) * LDP + bj * HALF; ga[m * 2 + bj] = *(const u32x4*)p; gb[m * 2 + bj] = *(const u32x4*)(p + DM); }
#pragma unroll
                for (int m = 0; m < 4; ++m)
#pragma unroll
                    for (int bj = 0; bj < 2; ++bj) { float g0[8], g1[8]; unpack8(ga[m * 2 + bj], g0); unpack8(gb[m * 2 + bj], g1);
                        float s[8];
#pragma unroll
                        for (int j = 0; j < 8; ++j) s[j] = g0[j] * __builtin_amdgcn_rcpf(g1[j]);
                        f32x4 v0 = acc[ai][bj][m][0], v1 = acc[ai][bj][m][1];
                        v0[0] *= s[0]; v0[1] *= s[1]; v0[2] *= s[2]; v0[3] *= s[3]; v1[0] *= s[4]; v1[1] *= s[5]; v1[2] *= s[6]; v1[3] *= s[7];
                        acc[ai][bj][m][0] = v0; acc[ai][bj][m][1] = v1; } }
            return true;
        }
#pragma unroll
        for (int ai = 0; ai < 2; ++ai) {
            u32x4 ga[8];
#pragma unroll
            for (int m = 0; m < 4; ++m)
#pragma unroll
                for (int bj = 0; bj < 2; ++bj) ga[m * 2 + bj] = *(const u32x4*)(gbase + (size_t)(ai * HALF + m * 16) * LDP + bj * HALF);
#pragma unroll
            for (int m = 0; m < 4; ++m)
#pragma unroll
                for (int bj = 0; bj < 2; ++bj) { float s[8]; unpack8(ga[m * 2 + bj], s);
                    f32x4 v0 = acc[ai][bj][m][0], v1 = acc[ai][bj][m][1];
                    v0[0] *= s[0]; v0[1] *= s[1]; v0[2] *= s[2]; v0[3] *= s[3]; v1[0] *= s[4]; v1[1] *= s[5]; v1[2] *= s[6]; v1[3] *= s[7];
                    u32x4 w; w.x = pk2(v0[0], v0[1]); w.y = pk2(v0[2], v0[3]); w.z = pk2(v1[0], v1[1]); w.w = pk2(v1[2], v1[3]);
                    *(u32x4*)(ACCb + (size_t)(row0 + ai * HALF + m * 16) * DM + col0 + bj * HALF) = w; } }
        return false;
    }
};
struct EpiPart {
    static constexpr bool PERM = true;
    const bf16_t* P; float* PART;
    __device__ __forceinline__ bool operator()(Acc& acc, const Unit& u, int wr, int wc, int fr, int fq) const {
        const int row0 = u.pm * BM + wr * 64 + fr, col0 = u.pn * BM + wc * 32 + 8 * fq; const int k = u.k;
        const bf16_t* gbase = P + (size_t)row0 * LDP + GATE_OFF + k * DM + col0;
        float* pbase = PART + ((size_t)k * (NTOK - NLAT) + (size_t)(row0 - NLAT)) * DM + col0;
#pragma unroll
        for (int ai = 0; ai < 2; ++ai) {
            u32x4 ga[8];
#pragma unroll
            for (int m = 0; m < 4; ++m)
#pragma unroll
                for (int bj = 0; bj < 2; ++bj) ga[m * 2 + bj] = *(const u32x4*)(gbase + (size_t)(ai * HALF + m * 16) * LDP + bj * HALF);
#pragma unroll
            for (int m = 0; m < 4; ++m)
#pragma unroll
                for (int bj = 0; bj < 2; ++bj) { float sg[8]; unpack8(ga[m * 2 + bj], sg);
                    f32x4 v0 = acc[ai][bj][m][0], v1 = acc[ai][bj][m][1];
                    v0[0] *= sg[0]; v0[1] *= sg[1]; v0[2] *= sg[2]; v0[3] *= sg[3]; v1[0] *= sg[4]; v1[1] *= sg[5]; v1[2] *= sg[6]; v1[3] *= sg[7];
                    float* pp = pbase + (size_t)(ai * HALF + m * 16) * DM + bj * HALF;
                    *(f32x4*)pp = v0; *(f32x4*)(pp + 4) = v1; } }
        return false;
    }
};
struct EpiPartK {
    static constexpr bool PERM = true;
    float* PART;
    __device__ __forceinline__ bool operator()(Acc& acc, const Unit& u, int wr, int wc, int fr, int fq) const {
        const int row0 = u.pm * BM + wr * 64 + fr, col0 = u.pn * BM + wc * 32 + 8 * fq;
        float* pbase = PART + ((size_t)u.k * (NTOK - NLAT) + (size_t)(row0 - NLAT)) * DM + col0;
#pragma unroll
        for (int ai = 0; ai < 2; ++ai)
#pragma unroll
            for (int m = 0; m < 4; ++m)
#pragma unroll
                for (int bj = 0; bj < 2; ++bj) { float* pp = pbase + (size_t)(ai * HALF + m * 16) * DM + bj * HALF; *(f32x4*)pp = acc[ai][bj][m][0]; *(f32x4*)(pp + 4) = acc[ai][bj][m][1]; }
        return false;
    }
};
struct EpiResid {
    static constexpr bool PERM = false;
    float* XS; const float* srcLat; const float* srcCtx; const float* MODl; int gidx;
    __device__ __forceinline__ bool operator()(Acc& acc, const Unit& u, int wr, int wc, int fr, int fq) const {
        const int row0 = u.pm * BM + wr * 64 + fr, col0 = u.pn * BM + wc * 32 + 4 * fq;
        const int r = (u.pm * BM) < NLAT ? (u.pm * BM) / SEQ : 4;
        const float* src = (u.pm * BM) < NLAT ? srcLat : srcCtx;
        const float* mg = MODl + (size_t)(r * 6 + gidx) * DM;
#pragma unroll
        for (int bj = 0; bj < 2; ++bj) {
            f32x4 gm[2], xs[2][2][4];
#pragma unroll
            for (int n = 0; n < 2; ++n) { const int col = col0 + bj * HALF + n * 16; gm[n] = *(const f32x4*)(mg + col);
#pragma unroll
                for (int ai = 0; ai < 2; ++ai)
#pragma unroll
                    for (int m = 0; m < 4; ++m) xs[n][ai][m] = *(const f32x4*)(src + (size_t)(row0 + ai * HALF + m * 16) * DM + col); }
#pragma unroll
            for (int n = 0; n < 2; ++n) { const int col = col0 + bj * HALF + n * 16;
#pragma unroll
                for (int ai = 0; ai < 2; ++ai)
#pragma unroll
                    for (int m = 0; m < 4; ++m) *(f32x4*)(XS + (size_t)(row0 + ai * HALF + m * 16) * DM + col) = xs[n][ai][m] + gm[n] * acc[ai][bj][m][n]; } }
        return false;
    }
};
struct EpiMoe1 {
    static constexpr bool PERM = true;
    bf16_t* HID;
    __device__ __forceinline__ bool operator()(Acc& acc, const Unit& u, int wr, int wc, int fr, int fq) const {
        const size_t row0 = (size_t)u.z * MOE_PAD + u.pm * BM + wr * 64 + fr; const int col0 = u.pn * HALF + wc * 32 + 8 * fq;
#pragma unroll
        for (int ai = 0; ai < 2; ++ai)
#pragma unroll
            for (int m = 0; m < 4; ++m) { const f32x4 g0 = acc[ai][0][m][0], g1 = acc[ai][0][m][1], u0 = acc[ai][1][m][0], u1 = acc[ai][1][m][1];
                float h[8];
#pragma unroll
                for (int j = 0; j < 4; ++j) { h[j] = g0[j] * __builtin_amdgcn_rcpf(1.0f + __expf(-g0[j])) * u0[j]; h[4 + j] = g1[j] * __builtin_amdgcn_rcpf(1.0f + __expf(-g1[j])) * u1[j]; }
                u32x4 w; w.x = pk2(h[0], h[1]); w.y = pk2(h[2], h[3]); w.z = pk2(h[4], h[5]); w.w = pk2(h[6], h[7]);
                *(u32x4*)(HID + (row0 + ai * HALF + m * 16) * DEXP + col0) = w; }
        return false;
    }
};
struct EpiMoeY {
    static constexpr bool PERM = true;
    bf16_t* O;
    __device__ __forceinline__ bool operator()(Acc& acc, const Unit& u, int wr, int wc, int fr, int fq) const {
        const size_t row0 = (size_t)u.z * MOE_PAD + u.pm * BM + wr * 64 + fr; const int col0 = u.pn * BM + wc * 32 + 8 * fq;
#pragma unroll
        for (int ai = 0; ai < 2; ++ai)
#pragma unroll
            for (int m = 0; m < 4; ++m) { bf16_t* rowp = O + (row0 + ai * HALF + m * 16) * DM + col0;
#pragma unroll
                for (int bj = 0; bj < 2; ++bj) { const f32x4 v0 = acc[ai][bj][m][0], v1 = acc[ai][bj][m][1];
                    u32x4 w; w.x = pk2(v0[0], v0[1]); w.y = pk2(v0[2], v0[3]); w.z = pk2(v1[0], v1[1]); w.w = pk2(v1[2], v1[3]);
                    *(u32x4*)(rowp + bj * HALF) = w; } }
        return false;
    }
};

struct SchedS5a {
    int c;
    __device__ __forceinline__ bool next(int i, Unit& u) const { if (i > 0 || c >= 64) return false; u.z = c >> 1; u.pm = c & 1; u.pn = 0; u.k = 0;
        u.ao = ((long long)u.z * 512 + u.pm * BM) * 768 * 2; u.bo = (long long)u.z * 256 * 512 * 2; return true; }
    __device__ __forceinline__ void a_ready(const Unit&) const {}
    __device__ __forceinline__ void done(const Unit&) const {}
};
struct SchedS5b {
    int c;
    __device__ __forceinline__ bool next(int i, Unit& u) const { if (i > 0 || c >= 128) return false; u.z = c >> 2; u.pm = (c >> 1) & 1; u.pn = c & 1; u.k = 0;
        u.ao = ((long long)u.z * 512 + u.pm * BM) * 768 * 2; u.bo = ((long long)u.z * 512 + u.pn * BM) * 768 * 2; return true; }
    __device__ __forceinline__ void a_ready(const Unit&) const {}
    __device__ __forceinline__ void done(const Unit&) const {}
};
struct EpiXloc {
    static constexpr bool PERM = false;
    float* XL;
    __device__ __forceinline__ bool operator()(Acc& acc, const Unit& u, int wr, int wc, int fr, int fq) const {
        const int row0 = u.pm * BM + wr * 64 + fr, col0 = wc * 32 + 4 * fq; float* base = XL + (size_t)u.z * 512 * 256;
#pragma unroll
        for (int ai = 0; ai < 2; ++ai)
#pragma unroll
            for (int m = 0; m < 4; ++m) { float* rowp = base + (size_t)(row0 + ai * HALF + m * 16) * 256 + col0;
#pragma unroll
                for (int bj = 0; bj < 2; ++bj)
#pragma unroll
                    for (int n = 0; n < 2; ++n) *(f32x4*)(rowp + bj * HALF + n * 16) = acc[ai][bj][m][n]; }
        return false;
    }
};
struct EpiS5Out {
    static constexpr bool PERM = true;
    const bf16_t* P; const float* dskip; bf16_t* GG;
    __device__ __forceinline__ bool operator()(Acc& acc, const Unit& u, int wr, int wc, int fr, int fq) const {
        const int row0 = u.pm * BM + wr * 64 + fr, col0 = u.pn * BM + wc * 32 + 8 * fq; const int g = u.z;
#pragma unroll
        for (int bj = 0; bj < 2; ++bj) { const int col = col0 + bj * HALF; const int t = col >> 4, c0 = col & 15;
            const f32x4 d0 = *(const f32x4*)(dskip + g * 16 + c0), d1 = *(const f32x4*)(dskip + g * 16 + c0 + 4);
            u32x4 uq[2][4];
#pragma unroll
            for (int ai = 0; ai < 2; ++ai)
#pragma unroll
                for (int m = 0; m < 4; ++m) uq[ai][m] = *(const u32x4*)(P + ((size_t)(row0 + ai * HALF + m * 16) * 32 + t) * LDP + S5_OFF + g * 16 + c0);
#pragma unroll
            for (int ai = 0; ai < 2; ++ai)
#pragma unroll
                for (int m = 0; m < 4; ++m) { const size_t tok = (size_t)(row0 + ai * HALF + m * 16) * 32 + t;
                    float uu[8]; unpack8(uq[ai][m], uu);
                    const f32x4 v0 = acc[ai][bj][m][0], v1 = acc[ai][bj][m][1];
                    float y[8] = {v0[0] + d0[0] * uu[0], v0[1] + d0[1] * uu[1], v0[2] + d0[2] * uu[2], v0[3] + d0[3] * uu[3], v1[0] + d1[0] * uu[4], v1[1] + d1[1] * uu[5], v1[2] + d1[2] * uu[6], v1[3] + d1[3] * uu[7]};
#pragma unroll
                    for (int j = 0; j < 8; ++j) y[j] = 0.5f * y[j] * (1.0f + tanhf(0.7978845608028654f * (y[j] + 0.044715f * y[j] * y[j] * y[j])));
                    u32x4 w; w.x = pk2(y[0], y[1]); w.y = pk2(y[2], y[3]); w.z = pk2(y[4], y[5]); w.w = pk2(y[6], y[7]);
                    *(u32x4*)(GG + tok * BW + g * 16 + c0) = w; } }
        return false;
    }
};
}


__device__ __forceinline__ float wave_scan_incl(float v, int lane) {
#pragma unroll
    for (int o = 1; o < 64; o <<= 1) { const float t = __shfl_up(v, o); if (lane >= o) v += t; }
    return v;
}
__device__ __forceinline__ float wave_scanmax_incl(float v, int lane) {
#pragma unroll
    for (int o = 1; o < 64; o <<= 1) { const float t = __shfl_up(v, o); if (lane >= o) v = fmaxf(v, t); }
    return v;
}
__device__ __forceinline__ float wave_max(float v) {
#pragma unroll
    for (int o = 32; o >= 1; o >>= 1) v = fmaxf(v, __shfl_xor(v, o));
    return v;
}
__device__ __forceinline__ void unpack8h(const u32x4 w, bf16_t (&h)[8]) {
    h[0] = (bf16_t)(w.x & 0xFFFFu); h[1] = (bf16_t)(w.x >> 16); h[2] = (bf16_t)(w.y & 0xFFFFu); h[3] = (bf16_t)(w.y >> 16);
    h[4] = (bf16_t)(w.z & 0xFFFFu); h[5] = (bf16_t)(w.z >> 16); h[6] = (bf16_t)(w.w & 0xFFFFu); h[7] = (bf16_t)(w.w >> 16);
}

__device__ __forceinline__ int tokblock_of(int b, int dir, int c) { if (c < 4) return 256 + b * 4 + (dir ? 3 - c : c); const int j = c - 4; return b * 64 + (dir ? 63 - j : j); }
__device__ __forceinline__ u32x4 rev8h(const u32x4 v) { u32x4 r; r.x = (v.w >> 16) | (v.w << 16); r.y = (v.z >> 16) | (v.z << 16); r.z = (v.y >> 16) | (v.y << 16); r.w = (v.x >> 16) | (v.x << 16); return r; }
__device__ __forceinline__ u32x4 scale8h(const u32x4 v, const float4 a, const float4 b) { float f[8]; unpack8(v, f); u32x4 r; r.x = pk2(f[0] * a.x, f[1] * a.y); r.y = pk2(f[2] * a.z, f[3] * a.w); r.z = pk2(f[4] * b.x, f[5] * b.y); r.w = pk2(f[6] * b.z, f[7] * b.w); return r; }
__device__ __forceinline__ float dot8h(const u32x4 v, const float4 a, const float4 b) { float f[8]; unpack8(v, f); return (f[0] * a.x + f[1] * a.y) + (f[2] * a.z + f[3] * a.w) + (f[4] * b.x + f[5] * b.y) + (f[6] * b.z + f[7] * b.w); }
#define ML_FRAG_LOAD(KF, VF, cc_) do { const int tb_ = tokblock_of(b, dir, (cc_)); const bf16_t* kb_ = KTg + ((size_t)tb_ * 512 + h * 128 + 32 * wd + r16) * 64 + q4 * 8; const bf16_t* vb_ = VTg + ((size_t)tb_ * 512 + h * 128 + 64 * half + 32 * we + r16) * 64 + q4 * 8; \
        _Pragma("unroll") for (int ks_ = 0; ks_ < 2; ++ks_) _Pragma("unroll") for (int j_ = 0; j_ < 2; ++j_) { VF[j_][ks_] = *(const u32x4*)(vb_ + (size_t)j_ * 16 * 64 + ks_ * 32); KF[j_][ks_] = *(const u32x4*)(kb_ + (size_t)j_ * 16 * 64 + ks_ * 32); } } while (0)
#define ML_CHUNK(c_, KF, VF, KFN, VFN) do { const int c = (c_); \
        if (c + 1 < 68) ML_FRAG_LOAD(KFN, VFN, c + 1);                        \
        const float dec = sDEC[c]; \
        {   bf16_t* cs = CST + (size_t)(chain * 68 + c) * 128 * 128; \
            _Pragma("unroll") for (int je = 0; je < 2; ++je) _Pragma("unroll") for (int jd = 0; jd < 2; ++jd) { const int e = 64 * half + 32 * we + 16 * je + r16, d0 = 32 * wd + 16 * jd + q4 * 4; \
                u32x2 pk; pk.x = pk2(acc[je][jd][0], acc[je][jd][1]); pk.y = pk2(acc[je][jd][2], acc[je][jd][3]); *(u32x2*)(cs + (size_t)e * 128 + d0) = pk; } \
            if (nown) { _Pragma("unroll") for (int jd = 0; jd < 2; ++jd) { float nv = npart[jd]; nv += __shfl_xor(nv, 16); nv += __shfl_xor(nv, 32); if (q4 == 0) NST[(size_t)(chain * 68 + c) * 128 + 32 * wd + 16 * jd + r16] = nv; } } } \
        bf16x8 vfr[2][2]; \
        _Pragma("unroll") for (int ks = 0; ks < 2; ++ks) { const float4 wa = *(const float4*)(sWS + c * 64 + ks * 32 + q4 * 8), wb = *(const float4*)(sWS + c * 64 + ks * 32 + q4 * 8 + 4); \
            _Pragma("unroll") for (int je = 0; je < 2; ++je) { const u32x4 sv = scale8h(VF[je][ks], wa, wb); vfr[je][ks] = *(const bf16x8*)&sv; } \
            if (nown) { _Pragma("unroll") for (int jd = 0; jd < 2; ++jd) npart[jd] = (ks == 0 ? dec * npart[jd] : npart[jd]) + dot8h(KF[jd][ks], wa, wb); } } \
        _Pragma("unroll") for (int je = 0; je < 2; ++je) _Pragma("unroll") for (int jd = 0; jd < 2; ++jd) acc[je][jd] = acc[je][jd] * dec; \
        _Pragma("unroll") for (int ks = 0; ks < 2; ++ks) _Pragma("unroll") for (int je = 0; je < 2; ++je) _Pragma("unroll") for (int jd = 0; jd < 2; ++jd) \
            acc[je][jd] = __builtin_amdgcn_mfma_f32_16x16x32_bf16(*(const bf16x8*)&KF[jd][ks], vfr[je][ks], acc[je][jd], 0, 0, 0); } while (0)
__device__ __forceinline__ void mlstm_state_pass(const int chain, const int half, const bf16_t* __restrict__ Pm, const bf16_t* __restrict__ KTg, const bf16_t* __restrict__ VTg, const float* __restrict__ gate_b,
                                                 bf16_t* __restrict__ CST, float* __restrict__ NST, float* __restrict__ MST, unsigned char* shm, const int tid) {
    const int dir = chain & 1, h = (chain >> 1) & 3, b = chain >> 3, lane = tid & 63, w = tid >> 6, we = w >> 2, wd = w & 3, q4 = lane >> 4, r16 = lane & 15;
    const bool nown = (half == 0) && (we == 0);
    float* sE = (float*)shm; float* sWS = sE + 68 * 64; float* sAL = sWS + 68 * 64; float* sBE = sAL + 68; float* sMO = sBE + 68; float* sDEC = sMO + 68; float* sMB = sDEC + 68;
    const float gbi = gate_b[(dir * 2 + 0) * 4 + h], gbf = gate_b[(dir * 2 + 1) * 4 + h];
    const int gcol_i = ML_OFF + 2048 + (dir * 2 + 0) * 4 + h, gcol_f = ML_OFF + 2048 + (dir * 2 + 1) * 4 + h;
    u32x4 kfA[2][2], vfA[2][2], kfB[2][2], vfB[2][2];
    ML_FRAG_LOAD(kfA, vfA, 0);
    __syncthreads();
    unsigned gi_[9], gf_[9];
#pragma unroll
    for (int q = 0; q < 9; ++q) { const int c = min(w + 8 * q, 67); const size_t tokl = (size_t)step_tok(b, dir, c * 64 + lane); gi_[q] = Pm[tokl * LDP + gcol_i]; gf_[q] = Pm[tokl * LDP + gcol_f]; }
#pragma unroll
    for (int q = 0; q < 9; ++q) { const int c = w + 8 * q; if (c >= 68) break;
        const float ig = __uint_as_float(gi_[q] << 16) + gbi, fg = __uint_as_float(gf_[q] << 16) + gbf;
        const float lf = fminf(fg, 0.f) - log1pf(expf(-fabsf(fg)));
        const float bcs = wave_scan_incl(lf, lane); const float blast = __shfl(bcs, 63); const float ei = blast - bcs + ig; const float beta = wave_max(ei);
        sE[c * 64 + lane] = ei; if (lane == 0) { sAL[c] = blast; sBE[c] = beta; } }
    __syncthreads();
    if (tid == 0) { float m = 0.f; for (int c = 0; c < 68; ++c) { sMB[c] = m; const float mo = fmaxf(m + sAL[c], sBE[c]); sDEC[c] = expf(sAL[c] + m - mo); sMO[c] = mo; m = mo; } }
    __syncthreads();
    for (int idx = tid; idx < 68 * 64; idx += NTHR) { const int c = idx >> 6, i = idx & 63; sWS[c * 64 + (dir ? 63 - i : i)] = expf(sE[idx] - sMO[c]); }
    if (half == 0 && tid < 68) MST[chain * 68 + tid] = sMB[tid];
    __syncthreads();
    f32x4 acc[2][2];
#pragma unroll
    for (int je = 0; je < 2; ++je)
#pragma unroll
        for (int jd = 0; jd < 2; ++jd) acc[je][jd] = (f32x4){0.f, 0.f, 0.f, 0.f};
    float npart[2] = {0.f, 0.f};
    for (int c2 = 0; c2 < 68; c2 += 2) { ML_CHUNK(c2, kfA, vfA, kfB, vfB); ML_CHUNK(c2 + 1, kfB, vfB, kfA, vfA); }
    __syncthreads();
}
#undef ML_CHUNK
#undef ML_FRAG_LOAD
__device__ __forceinline__ void mlstm_out_item(const int chain, const int c, const bf16_t* __restrict__ Pm, const bf16_t* __restrict__ QKb, const bf16_t* __restrict__ VTg, const float* __restrict__ gate_b,
                                               const bf16_t* __restrict__ CST, const float* __restrict__ NST, const float* __restrict__ MST, float* __restrict__ Hout, unsigned char* shm, const int tid) {
    const int dir = chain & 1, h = (chain >> 1) & 3, b = chain >> 3, lane = tid & 63, w = tid >> 6;
    bf16_t* Qs = (bf16_t*)shm; bf16_t* Ks = (bf16_t*)(shm + 17408); bf16_t* VT = (bf16_t*)(shm + 34816); bf16_t* Cs = (bf16_t*)(shm + 53248); bf16_t* Ss = (bf16_t*)(shm + 88064);
    float* sc = (float*)(shm + 97280);
    __syncthreads();
    u32x4 gq[2], gk[2], gv[2], gc[4]; float gn = 0.f;
#pragma unroll
    for (int i = 0; i < 2; ++i) { const int pid = tid + i * 512; const int s = pid >> 4, x0 = (pid & 15) * 8; const size_t toks = (size_t)step_tok(b, dir, c * 64 + s);
        gq[i] = *(const u32x4*)(QKb + toks * 1024 + h * 128 + x0);
        gk[i] = *(const u32x4*)(QKb + toks * 1024 + 512 + h * 128 + x0);
        { const int e = pid >> 3, o = pid & 7;
          gv[i] = *(const u32x4*)(VTg + ((size_t)tokblock_of(b, dir, c) * 512 + h * 128 + e) * 64 + (dir ? 7 - o : o) * 8); } }
#pragma unroll
    for (int i = 0; i < 4; ++i) { const int pid = tid + i * 512; const int e = pid >> 4, x0 = (pid & 15) * 8;
        gc[i] = *(const u32x4*)(CST + ((size_t)(chain * 68 + c) * 128 + e) * 128 + x0); }
    if (tid < 128) gn = NST[(size_t)(chain * 68 + c) * 128 + tid];
    unsigned gi_ = 0u, gf_ = 0u; float gbi = 0.f, gbf = 0.f, m_in = 0.f;
    if (w == 0) { const size_t tokl = (size_t)step_tok(b, dir, c * 64 + lane);
        gi_ = Pm[tokl * LDP + ML_OFF + 2048 + (dir * 2 + 0) * 4 + h]; gf_ = Pm[tokl * LDP + ML_OFF + 2048 + (dir * 2 + 1) * 4 + h];
        gbi = gate_b[(dir * 2 + 0) * 4 + h]; gbf = gate_b[(dir * 2 + 1) * 4 + h]; m_in = MST[chain * 68 + c]; }
#pragma unroll
    for (int i = 0; i < 2; ++i) { const int pid = tid + i * 512; const int s = pid >> 4, x0 = (pid & 15) * 8;
        *(u32x4*)(Qs + s * 136 + x0) = gq[i]; *(u32x4*)(Ks + s * 136 + x0) = gk[i];
        { const int e = pid >> 3, o = pid & 7; *(u32x4*)(VT + e * 72 + o * 8) = dir ? rev8h(gv[i]) : gv[i]; } }
#pragma unroll
    for (int i = 0; i < 4; ++i) { const int pid = tid + i * 512; const int e = pid >> 4, x0 = (pid & 15) * 8; *(u32x4*)(Cs + e * 136 + x0) = gc[i]; }
    if (tid < 128) sc[384 + tid] = gn;
    if (w == 0) {
        const float ig = __uint_as_float(gi_ << 16) + gbi;
        const float fg = __uint_as_float(gf_ << 16) + gbf;
        const float lf = fminf(fg, 0.f) - log1pf(expf(-fabsf(fg)));
        const float bcs = wave_scan_incl(lf, lane); const float gsv = ig - bcs; const float pm = wave_scanmax_incl(gsv, lane);
        const float mt = bcs + fmaxf(m_in, pm);
        sc[lane] = bcs; sc[64 + lane] = gsv; sc[128 + lane] = mt; sc[192 + lane] = expf(bcs + m_in - mt); sc[256 + lane] = expf(-mt);
    }
    __syncthreads();
    const int tt = w >> 1;
    {   f32x4 aS[2] = {(f32x4){0.f, 0.f, 0.f, 0.f}, (f32x4){0.f, 0.f, 0.f, 0.f}};
#pragma unroll
        for (int ks = 0; ks < 4; ++ks) { const bf16x8 af = *(const bf16x8*)(Qs + (16 * tt + (lane & 15)) * 136 + ks * 32 + (lane >> 4) * 8);
#pragma unroll
            for (int i = 0; i < 2; ++i) { const int st = (w & 1) * 2 + i; const bf16x8 bfr = *(const bf16x8*)(Ks + (16 * st + (lane & 15)) * 136 + ks * 32 + (lane >> 4) * 8);
                aS[i] = __builtin_amdgcn_mfma_f32_16x16x32_bf16(af, bfr, aS[i], 0, 0, 0); } }
        float rs[4] = {0.f, 0.f, 0.f, 0.f};
#pragma unroll
        for (int i = 0; i < 2; ++i) { const int s = 16 * ((w & 1) * 2 + i) + (lane & 15); const float gsv = sc[64 + s];
#pragma unroll
            for (int q = 0; q < 4; ++q) { const int t = 16 * tt + (lane >> 4) * 4 + q; const float val = (s <= t) ? aS[i][q] * expf(sc[t] + gsv - sc[128 + t]) : 0.f; Ss[t * 72 + s] = f2bf(val); rs[q] += val; } }
#pragma unroll
        for (int q = 0; q < 4; ++q) { float r = rs[q]; r += __shfl_xor(r, 1); r += __shfl_xor(r, 2); r += __shfl_xor(r, 4); r += __shfl_xor(r, 8);
            if ((lane & 15) == 0) sc[512 + (w & 1) * 64 + 16 * tt + (lane >> 4) * 4 + q] = r; }
        {   const int t = tid >> 3, part = tid & 7; float dot = 0.f;
#pragma unroll
            for (int j = 0; j < 16; ++j) dot += bf2f(Qs[t * 136 + part * 16 + j]) * sc[384 + part * 16 + j];
            dot += __shfl_xor(dot, 1); dot += __shfl_xor(dot, 2); dot += __shfl_xor(dot, 4);
            if (part == 0) sc[640 + t] = sc[192 + t] * dot; }
    }
    __syncthreads();
    {   f32x4 aN[4];
#pragma unroll
        for (int i = 0; i < 4; ++i) aN[i] = (f32x4){0.f, 0.f, 0.f, 0.f};
#pragma unroll
        for (int ks = 0; ks < 4; ++ks) { const bf16x8 af = *(const bf16x8*)(Qs + (16 * tt + (lane & 15)) * 136 + ks * 32 + (lane >> 4) * 8);
#pragma unroll
            for (int i = 0; i < 4; ++i) { const int et = (w & 1) * 4 + i; const bf16x8 bfr = *(const bf16x8*)(Cs + (16 * et + (lane & 15)) * 136 + ks * 32 + (lane >> 4) * 8);
                aN[i] = __builtin_amdgcn_mfma_f32_16x16x32_bf16(af, bfr, aN[i], 0, 0, 0); } }
#pragma unroll
        for (int q = 0; q < 4; ++q) { const float it = sc[192 + 16 * tt + (lane >> 4) * 4 + q];
#pragma unroll
            for (int i = 0; i < 4; ++i) aN[i][q] *= it; }
#pragma unroll
        for (int ks = 0; ks < 2; ++ks) { const bf16x8 af = *(const bf16x8*)(Ss + (16 * tt + (lane & 15)) * 72 + ks * 32 + (lane >> 4) * 8);
#pragma unroll
            for (int i = 0; i < 4; ++i) { const int et = (w & 1) * 4 + i; const bf16x8 bfr = *(const bf16x8*)(VT + (16 * et + (lane & 15)) * 72 + ks * 32 + (lane >> 4) * 8);
                aN[i] = __builtin_amdgcn_mfma_f32_16x16x32_bf16(af, bfr, aN[i], 0, 0, 0); } }
#pragma unroll
        for (int q = 0; q < 4; ++q) { const int t = 16 * tt + (lane >> 4) * 4 + q; const size_t tokt = (size_t)step_tok(b, dir, c * 64 + t); const float dn = fmaxf(fabsf((sc[512 + t] + sc[576 + t]) + sc[640 + t]), sc[256 + t]);
#pragma unroll
            for (int i = 0; i < 4; ++i) { const int e = 16 * ((w & 1) * 4 + i) + (lane & 15); Hout[tokt * BW + h * 128 + e] = aN[i][q] / dn; } }
    }
}


#define SD_FRAG_LOAD(BF, XF, cc_) do { const int tb_ = tokblock_of(b, dir, (cc_)); const bf16_t* bb_ = BTg + ((size_t)tb_ * 256 + grp * 128 + 64 * (w >> 2) + r16) * 64 + q4 * 8; const bf16_t* xb_ = XTg + ((size_t)tb_ * 512 + h * 64 + 16 * (w & 3) + r16) * 64 + q4 * 8; \
        _Pragma("unroll") for (int ks_ = 0; ks_ < 2; ++ks_) { XF[ks_] = *(const u32x4*)(xb_ + ks_ * 32); _Pragma("unroll") for (int j_ = 0; j_ < 4; ++j_) BF[j_][ks_] = *(const u32x4*)(bb_ + (size_t)j_ * 16 * 64 + ks_ * 32); } } while (0)
#define SD_CHUNK(c_, BF, XF, BFN, XFN) do { const int c = (c_); \
        if (c + 1 < 68) SD_FRAG_LOAD(BFN, XFN, c + 1); \
        const float dec = sDEC[c]; \
        {   bf16_t* ss = SSTb + (size_t)(chain * 68 + c) * 64 * 128; const int p = 16 * (w & 3) + r16; \
            _Pragma("unroll") for (int j = 0; j < 4; ++j) { const int n0 = 16 * ((w >> 2) * 4 + j) + q4 * 4; u32x2 pk; pk.x = pk2(acc[j][0], acc[j][1]); pk.y = pk2(acc[j][2], acc[j][3]); *(u32x2*)(ss + (size_t)p * 128 + n0) = pk; } } \
        bf16x8 xfr[2]; \
        _Pragma("unroll") for (int ks = 0; ks < 2; ++ks) { const float4 wa = *(const float4*)(sSC + c * 64 + ks * 32 + q4 * 8), wb = *(const float4*)(sSC + c * 64 + ks * 32 + q4 * 8 + 4); const u32x4 sv = scale8h(XF[ks], wa, wb); xfr[ks] = *(const bf16x8*)&sv; } \
        _Pragma("unroll") for (int j = 0; j < 4; ++j) acc[j] = acc[j] * dec; \
        _Pragma("unroll") for (int ks = 0; ks < 2; ++ks) _Pragma("unroll") for (int j = 0; j < 4; ++j) acc[j] = __builtin_amdgcn_mfma_f32_16x16x32_bf16(*(const bf16x8*)&BF[j][ks], xfr[ks], acc[j], 0, 0, 0); } while (0)
__device__ __forceinline__ void ssd_state_pass(const int chain, const bf16_t* __restrict__ Pm, const bf16_t* __restrict__ BTg, const bf16_t* __restrict__ XTg, const float Aa, const float dtb,
                                               bf16_t* __restrict__ SSTb, unsigned char* shm, const int tid) {
    const int dir = chain & 1, h = (chain >> 1) & 7, b = chain >> 4, grp = h >> 2, lane = tid & 63, w = tid >> 6, q4 = lane >> 4, r16 = lane & 15;
    float* sSC = (float*)shm; float* sDEC = sSC + 68 * 64;
    const int dcol = SSD_OFF + 1536 + dir * 8 + h;
    u32x4 bfA[4][2], xfA[2], bfB[4][2], xfB[2];
    SD_FRAG_LOAD(bfA, xfA, 0);
    __syncthreads();
    unsigned dt_[9];
#pragma unroll
    for (int q = 0; q < 9; ++q) { const int c = min(w + 8 * q, 67); dt_[q] = Pm[(size_t)step_tok(b, dir, c * 64 + lane) * LDP + dcol]; }
#pragma unroll
    for (int q = 0; q < 9; ++q) { const int c = w + 8 * q; if (c >= 68) break;
        const float xv = __uint_as_float(dt_[q] << 16) + dtb; const float dtv = xv > 20.f ? xv : log1pf(expf(xv));
        const float cs = wave_scan_incl(dtv * Aa, lane); const float cl = __shfl(cs, 63);
        sSC[c * 64 + (dir ? 63 - lane : lane)] = dtv * expf(cl - cs); if (lane == 0) sDEC[c] = expf(cl); }
    __syncthreads();
    f32x4 acc[4];
#pragma unroll
    for (int j = 0; j < 4; ++j) acc[j] = (f32x4){0.f, 0.f, 0.f, 0.f};
    for (int c2 = 0; c2 < 68; c2 += 2) { SD_CHUNK(c2, bfA, xfA, bfB, xfB); SD_CHUNK(c2 + 1, bfB, xfB, bfA, xfA); }
    __syncthreads();
}
#undef SD_CHUNK
#undef SD_FRAG_LOAD
__device__ __forceinline__ void ssd_out_item(const int chain, const int c, const bf16_t* __restrict__ Pm, const bf16_t* __restrict__ XBb, const bf16_t* __restrict__ XTg, const float Aa, const float dtb,
                                             const bf16_t* __restrict__ SSTb, float* __restrict__ Yout, unsigned char* shm, const int tid) {
    const int dir = chain & 1, h = (chain >> 1) & 7, b = chain >> 4, grp = h >> 2, lane = tid & 63, w = tid >> 6;
    bf16_t* Cs = (bf16_t*)shm; bf16_t* Bs = (bf16_t*)(shm + 17408); bf16_t* XT = (bf16_t*)(shm + 34816); bf16_t* Sin = (bf16_t*)(shm + 44032); bf16_t* Gs = (bf16_t*)(shm + 61440);
    float* sc = (float*)(shm + 70656);
    __syncthreads();
    u32x4 gb[2], gcc[2], gs[2], gx; unsigned gd_ = 0u;
#pragma unroll
    for (int i = 0; i < 2; ++i) { const int pid = tid + i * 512; const int s = pid >> 4, x0 = (pid & 15) * 8; const size_t toks = (size_t)step_tok(b, dir, c * 64 + s);
        gb[i] = *(const u32x4*)(XBb + toks * 1024 + 512 + grp * 128 + x0);
        gcc[i] = *(const u32x4*)(XBb + toks * 1024 + 768 + grp * 128 + x0);
        const int p = pid >> 4;
        gs[i] = *(const u32x4*)(SSTb + ((size_t)(chain * 68 + c) * 64 + p) * 128 + x0); }
    {   const int p = tid >> 3, o = tid & 7;
        gx = *(const u32x4*)(XTg + ((size_t)tokblock_of(b, dir, c) * 512 + h * 64 + p) * 64 + (dir ? 7 - o : o) * 8); }
    if (w == 0) gd_ = Pm[(size_t)step_tok(b, dir, c * 64 + lane) * LDP + SSD_OFF + 1536 + dir * 8 + h];
#pragma unroll
    for (int i = 0; i < 2; ++i) { const int pid = tid + i * 512; const int s = pid >> 4, x0 = (pid & 15) * 8;
        *(u32x4*)(Bs + s * 136 + x0) = gb[i]; *(u32x4*)(Cs + s * 136 + x0) = gcc[i]; *(u32x4*)(Sin + s * 136 + x0) = gs[i]; }
    {   const int p = tid >> 3, o = tid & 7; *(u32x4*)(XT + p * 72 + o * 8) = dir ? rev8h(gx) : gx; }
    if (w == 0) {
        const float xv = __uint_as_float(gd_ << 16) + dtb; const float dtv = xv > 20.f ? xv : log1pf(expf(xv));
        sc[lane] = wave_scan_incl(dtv * Aa, lane); sc[64 + lane] = dtv; }
    __syncthreads();
    {   const int lt = w >> 1;
        f32x4 aG[2] = {(f32x4){0.f, 0.f, 0.f, 0.f}, (f32x4){0.f, 0.f, 0.f, 0.f}};
#pragma unroll
        for (int ks = 0; ks < 4; ++ks) { const bf16x8 af = *(const bf16x8*)(Cs + (16 * lt + (lane & 15)) * 136 + ks * 32 + (lane >> 4) * 8);
#pragma unroll
            for (int i = 0; i < 2; ++i) { const int st = (w & 1) * 2 + i; const bf16x8 bfr = *(const bf16x8*)(Bs + (16 * st + (lane & 15)) * 136 + ks * 32 + (lane >> 4) * 8);
                aG[i] = __builtin_amdgcn_mfma_f32_16x16x32_bf16(af, bfr, aG[i], 0, 0, 0); } }
#pragma unroll
        for (int i = 0; i < 2; ++i) { const int s = 16 * ((w & 1) * 2 + i) + (lane & 15); const float css = sc[s], dts = sc[64 + s];
#pragma unroll
            for (int q = 0; q < 4; ++q) { const int t = 16 * lt + (lane >> 4) * 4 + q; const float val = (s <= t) ? aG[i][q] * expf(sc[t] - css) * dts : 0.f; Gs[t * 72 + s] = f2bf(val); } }
    }
    __syncthreads();
    {   const int lt = w >> 1;
        f32x4 aY[2] = {(f32x4){0.f, 0.f, 0.f, 0.f}, (f32x4){0.f, 0.f, 0.f, 0.f}};
#pragma unroll
        for (int ks = 0; ks < 4; ++ks) { const bf16x8 af = *(const bf16x8*)(Cs + (16 * lt + (lane & 15)) * 136 + ks * 32 + (lane >> 4) * 8);
#pragma unroll
            for (int i = 0; i < 2; ++i) { const int pt = (w & 1) * 2 + i; const bf16x8 bfr = *(const bf16x8*)(Sin + (16 * pt + (lane & 15)) * 136 + ks * 32 + (lane >> 4) * 8);
                aY[i] = __builtin_amdgcn_mfma_f32_16x16x32_bf16(af, bfr, aY[i], 0, 0, 0); } }
#pragma unroll
        for (int q = 0; q < 4; ++q) { const float ec = expf(sc[16 * lt + (lane >> 4) * 4 + q]); aY[0][q] *= ec; aY[1][q] *= ec; }
#pragma unroll
        for (int ks = 0; ks < 2; ++ks) { const bf16x8 af = *(const bf16x8*)(Gs + (16 * lt + (lane & 15)) * 72 + ks * 32 + (lane >> 4) * 8);
#pragma unroll
            for (int i = 0; i < 2; ++i) { const int pt = (w & 1) * 2 + i; const bf16x8 bfr = *(const bf16x8*)(XT + (16 * pt + (lane & 15)) * 72 + ks * 32 + (lane >> 4) * 8);
                aY[i] = __builtin_amdgcn_mfma_f32_16x16x32_bf16(af, bfr, aY[i], 0, 0, 0); } }
#pragma unroll
        for (int q = 0; q < 4; ++q) { const int t = 16 * lt + (lane >> 4) * 4 + q; const size_t tokt = (size_t)step_tok(b, dir, c * 64 + t);
#pragma unroll
            for (int i = 0; i < 2; ++i) { const int p = 16 * ((w & 1) * 2 + i) + (lane & 15); Yout[tokt * BW + h * 64 + p] = aY[i][q]; } }
    }
}


#define FIDX(i) ((i) + ((i) >> 4))
#define FFT_X_BYTES 69632
__device__ constexpr float FFT_CW_RE[6][16] = {{0.f, 0.f, 0.f, 0.f, 0.f, 0.f, 0.f, 0.f, 0.f, 0.f, 0.f, 0.f, 0.f, 0.f, 0.f, 0.f}, {1.0f, 0.f, 0.f, 0.f, 0.f, 0.f, 0.f, 0.f, 0.f, 0.f, 0.f, 0.f, 0.f, 0.f, 0.f, 0.f}, {1.0f, 6.123233995736766e-17f, 0.f, 0.f, 0.f, 0.f, 0.f, 0.f, 0.f, 0.f, 0.f, 0.f, 0.f, 0.f, 0.f, 0.f}, {1.0f, 0.7071067811865476f, 6.123233995736766e-17f, -0.7071067811865475f, 0.f, 0.f, 0.f, 0.f, 0.f, 0.f, 0.f, 0.f, 0.f, 0.f, 0.f, 0.f}, {1.0f, 0.9238795325112867f, 0.7071067811865476f, 0.38268343236508984f, 6.123233995736766e-17f, -0.3826834323650897f, -0.7071067811865475f, -0.9238795325112867f, 0.f, 0.f, 0.f, 0.f, 0.f, 0.f, 0.f, 0.f}, {1.0f, 0.9807852804032304f, 0.9238795325112867f, 0.8314696123025452f, 0.7071067811865476f, 0.5555702330196023f, 0.38268343236508984f, 0.19509032201612833f, 6.123233995736766e-17f, -0.1950903220161282f, -0.3826834323650897f, -0.555570233019602f, -0.7071067811865475f, -0.8314696123025453f, -0.9238795325112867f, -0.9807852804032304f}};
__device__ constexpr float FFT_CW_IM[6][16] = {{0.f, 0.f, 0.f, 0.f, 0.f, 0.f, 0.f, 0.f, 0.f, 0.f, 0.f, 0.f, 0.f, 0.f, 0.f, 0.f}, {-0.0f, 0.f, 0.f, 0.f, 0.f, 0.f, 0.f, 0.f, 0.f, 0.f, 0.f, 0.f, 0.f, 0.f, 0.f, 0.f}, {-0.0f, -1.0f, 0.f, 0.f, 0.f, 0.f, 0.f, 0.f, 0.f, 0.f, 0.f, 0.f, 0.f, 0.f, 0.f, 0.f}, {-0.0f, -0.7071067811865475f, -1.0f, -0.7071067811865476f, 0.f, 0.f, 0.f, 0.f, 0.f, 0.f, 0.f, 0.f, 0.f, 0.f, 0.f, 0.f}, {-0.0f, -0.3826834323650898f, -0.7071067811865475f, -0.9238795325112867f, -1.0f, -0.9238795325112867f, -0.7071067811865476f, -0.3826834323650899f, 0.f, 0.f, 0.f, 0.f, 0.f, 0.f, 0.f, 0.f}, {-0.0f, -0.19509032201612825f, -0.3826834323650898f, -0.5555702330196022f, -0.7071067811865475f, -0.8314696123025452f, -0.9238795325112867f, -0.9807852804032304f, -1.0f, -0.9807852804032304f, -0.9238795325112867f, -0.8314696123025455f, -0.7071067811865476f, -0.5555702330196022f, -0.3826834323650899f, -0.1950903220161286f}};
__host__ __device__ constexpr int fft_bitrev(int k, int R) { int r = 0; for (int i = 0; i < R; ++i) if (k & (1 << i)) r |= 1 << (R - 1 - i); return r; }
template <int R, bool INV>
__device__ __forceinline__ void fft_pass(float2* __restrict__ X, const float2* __restrict__ TW, const int s0, const int gidx) {
    const int lowbits = 13 - s0 - R; const int stride = 1 << lowbits;
    const int low = gidx & (stride - 1), high = gidx >> lowbits; const int base = (high << (lowbits + R)) | low;
    const int p0 = FIDX(base);
#define FFT_SLOT(k) (lowbits >= 4 ? p0 + (k) * (stride + (stride >> 4)) : p0 + (k) + ((k) >> 4))
    float2 v[1 << R];
#pragma unroll
    for (int k = 0; k < (1 << R); ++k) v[k] = X[FFT_SLOT(k)];
    const int lw = low << s0;
    if (!INV) {
#pragma unroll
        for (int j = 0; j < R; ++j) { const int hk = 1 << (R - 1 - j);
#pragma unroll
            for (int k = 0; k < (1 << R); ++k) if (!(k & hk)) { const int kk = k & (hk - 1);
                const float2 a = v[k], b = v[k + hk]; v[k] = make_float2(a.x + b.x, a.y + b.y); const float dx = a.x - b.x, dy = a.y - b.y;
                if (kk == 0) v[k + hk] = make_float2(dx, dy);
                else if (2 * kk == hk) v[k + hk] = make_float2(dy, -dx);
                else { const float cr = FFT_CW_RE[R - j][kk], ci = FFT_CW_IM[R - j][kk]; v[k + hk] = make_float2(dx * cr - dy * ci, dx * ci + dy * cr); } } }
        if (lowbits > 0) {
#pragma unroll
            for (int k = 1; k < (1 << R); ++k) { const float2 w = TW[(lw * fft_bitrev(k, R)) & 8191]; const float2 a = v[k]; v[k] = make_float2(a.x * w.x - a.y * w.y, a.x * w.y + a.y * w.x); } }
    } else {
        if (lowbits > 0) {
#pragma unroll
            for (int k = 1; k < (1 << R); ++k) { const float2 w = TW[(lw * fft_bitrev(k, R)) & 8191]; const float2 a = v[k]; v[k] = make_float2(a.x * w.x + a.y * w.y, a.y * w.x - a.x * w.y); } }
#pragma unroll
        for (int j = R - 1; j >= 0; --j) { const int hk = 1 << (R - 1 - j);
#pragma unroll
            for (int k = 0; k < (1 << R); ++k) if (!(k & hk)) { const int kk = k & (hk - 1);
                const float2 a = v[k], b = v[k + hk]; float tx, ty;
                if (kk == 0) { tx = b.x; ty = b.y; }
                else if (2 * kk == hk) { tx = -b.y; ty = b.x; }
                else { const float cr = FFT_CW_RE[R - j][kk], ci = FFT_CW_IM[R - j][kk]; tx = b.x * cr + b.y * ci; ty = b.y * cr - b.x * ci; }
                v[k] = make_float2(a.x + tx, a.y + ty); v[k + hk] = make_float2(a.x - tx, a.y - ty); } }
    }
#pragma unroll
    for (int k = 0; k < (1 << R); ++k) X[FFT_SLOT(k)] = v[k];
#undef FFT_SLOT
}
__device__ __forceinline__ void fft_fwd(float2* X, const float2* TW, const int tid) {
    fft_pass<4, false>(X, TW, 0, tid); __syncthreads(); fft_pass<4, false>(X, TW, 4, tid); __syncthreads(); if (tid < 256) fft_pass<5, false>(X, TW, 8, tid); __syncthreads(); }
__device__ __forceinline__ void fft_inv(float2* X, const float2* TW, const int tid) {
    if (tid < 256) fft_pass<5, true>(X, TW, 8, tid); __syncthreads(); fft_pass<4, true>(X, TW, 4, tid); __syncthreads(); fft_pass<4, true>(X, TW, 0, tid); __syncthreads(); }
__device__ __forceinline__ void fft_twiddles(float2* TW, const int tid) {
#pragma unroll
    for (int k = 0; k < 16; ++k) { const int m = tid + k * 512; const float xx = (float)m * (1.0f / 4096.0f); TW[m] = make_float2(cospif(xx), -sinpif(xx)); }
}
__device__ __forceinline__ void hyena_spec_item(const int oc, const float* __restrict__ HR, const float* __restrict__ nrm, float2* __restrict__ HSPEC, unsigned char* shm, const int tid) {
    float2* X = (float2*)shm; const float2* TW = (const float2*)(shm + FFT_X_BYTES);
    const int o = oc >> 9, c = oc & 511; const float inv = 1.0f / nrm[oc];
    __syncthreads();
    float hv[16];
#pragma unroll
    for (int k = 0; k < 16; ++k) { const int j = tid + k * 512;
        const unsigned off = j < SEQ ? (unsigned)j * 2048u + o * 1024 + c : j == SEQ ? (unsigned)(o * 1024 + c) : (unsigned)(2 * SEQ - j) * 2048u + o * 1024 + 512 + c;
        hv[k] = HR[off]; }
#pragma unroll
    for (int k = 0; k < 16; ++k) { const int j = tid + k * 512; X[FIDX(j)] = make_float2(j == SEQ ? 0.f : hv[k] * inv, 0.f); }
    __syncthreads();
    fft_fwd(X, TW, tid);
    float4* out = (float4*)(HSPEC + (size_t)oc * 8192 + tid * 16); const float2* xs = X + 17 * tid;
#pragma unroll
    for (int k = 0; k < 8; ++k) { const float2 x0 = xs[2 * k], x1 = xs[2 * k + 1]; out[k] = make_float4(x0.x * (1.0f / 8192.0f), x0.y * (1.0f / 8192.0f), x1.x * (1.0f / 8192.0f), x1.y * (1.0f / 8192.0f)); }
}
__device__ __forceinline__ void fft_mul_spec(float2* X, const float2* __restrict__ H, const int tid) {
    const float4* h4 = (const float4*)(H + tid * 16); float2* xs = X + 17 * tid;
#pragma unroll
    for (int k = 0; k < 8; ++k) { const float4 hv = h4[k]; const float2 x0 = xs[2 * k], x1 = xs[2 * k + 1];
        xs[2 * k] = make_float2(x0.x * hv.x - x0.y * hv.y, x0.x * hv.y + x0.y * hv.x); xs[2 * k + 1] = make_float2(x1.x * hv.z - x1.y * hv.w, x1.x * hv.w + x1.y * hv.z); }
}
__device__ __forceinline__ void hyena_fft_item(const int item, const float* __restrict__ UT, const float2* __restrict__ HSPEC, const float* __restrict__ bias, float* __restrict__ YT, unsigned char* shm, const int tid) {
    float2* X = (float2*)shm; const float2* TW = (const float2*)(shm + FFT_X_BYTES);
    const int c = item >> 1, b0 = (item & 1) * 2, b1 = b0 + 1;
    const float* u0 = UT + (size_t)(b0 * 1536 + c) * SEQ + tid * 8; const float* u1 = UT + (size_t)(b1 * 1536 + c) * SEQ + tid * 8;
    const float bias0 = bias[c], bias1 = bias[512 + c];
    float2* xs = X + FIDX(8 * tid);
    float vr[8], vi[8];
    __syncthreads();
    { const float4 a0 = *(const float4*)u0, a1 = *(const float4*)(u0 + 4), c0 = *(const float4*)u1, c1 = *(const float4*)(u1 + 4);
      vr[0] = a0.x; vr[1] = a0.y; vr[2] = a0.z; vr[3] = a0.w; vr[4] = a1.x; vr[5] = a1.y; vr[6] = a1.z; vr[7] = a1.w;
      vi[0] = c0.x; vi[1] = c0.y; vi[2] = c0.z; vi[3] = c0.w; vi[4] = c1.x; vi[5] = c1.y; vi[6] = c1.z; vi[7] = c1.w; }
#pragma unroll
    for (int k = 0; k < 8; ++k) { xs[k] = make_float2(vr[k], vi[k]); xs[4352 + k] = make_float2(0.f, 0.f); }
    __syncthreads();
    fft_fwd(X, TW, tid);
    fft_mul_spec(X, HSPEC + (size_t)c * 8192, tid);
    __syncthreads();
    fft_inv(X, TW, tid);
    { const float* p0 = u0 + (size_t)512 * SEQ; const float* p1 = u1 + (size_t)512 * SEQ;
      const float4 a0 = *(const float4*)p0, a1 = *(const float4*)(p0 + 4), c0 = *(const float4*)p1, c1 = *(const float4*)(p1 + 4);
      const float xr[8] = {a0.x, a0.y, a0.z, a0.w, a1.x, a1.y, a1.z, a1.w}, xi[8] = {c0.x, c0.y, c0.z, c0.w, c1.x, c1.y, c1.z, c1.w};
#pragma unroll
      for (int k = 0; k < 8; ++k) { const float2 cv = xs[k]; const float zr = xr[k] * (cv.x + bias0 * vr[k]), zi = xi[k] * (cv.y + bias0 * vi[k]);
          vr[k] = zr; vi[k] = zi; xs[k] = make_float2(zr, zi); xs[4352 + k] = make_float2(0.f, 0.f); } }
    __syncthreads();
    fft_fwd(X, TW, tid);
    fft_mul_spec(X, HSPEC + (size_t)(512 + c) * 8192, tid);
    __syncthreads();
    fft_inv(X, TW, tid);
    { const float* p0 = u0 + (size_t)1024 * SEQ; const float* p1 = u1 + (size_t)1024 * SEQ;
      const float4 a0 = *(const float4*)p0, a1 = *(const float4*)(p0 + 4), c0 = *(const float4*)p1, c1 = *(const float4*)(p1 + 4);
      const float xr[8] = {a0.x, a0.y, a0.z, a0.w, a1.x, a1.y, a1.z, a1.w}, xi[8] = {c0.x, c0.y, c0.z, c0.w, c1.x, c1.y, c1.z, c1.w};
      float yr[8], yi[8];
#pragma unroll
      for (int k = 0; k < 8; ++k) { const float2 cv = xs[k]; yr[k] = xr[k] * (cv.x + bias1 * vr[k]); yi[k] = xi[k] * (cv.y + bias1 * vi[k]); }
      float* y0 = YT + (size_t)(b0 * 512 + c) * SEQ + tid * 8; float* y1 = YT + (size_t)(b1 * 512 + c) * SEQ + tid * 8;
      *(float4*)y0 = make_float4(yr[0], yr[1], yr[2], yr[3]); *(float4*)(y0 + 4) = make_float4(yr[4], yr[5], yr[6], yr[7]);
      *(float4*)y1 = make_float4(yi[0], yi[1], yi[2], yi[3]); *(float4*)(y1 + 4) = make_float4(yi[4], yi[5], yi[6], yi[7]); }
}

constexpr size_t al256(size_t x) { return (x + 255) & ~(size_t)255; }
constexpr size_t O_BAR = 0;
constexpr size_t O_MOD = 16384;
constexpr size_t O_NORM = O_MOD + al256((size_t)2 * 5 * 6 * DM * 4);
constexpr size_t O_QCTR = O_NORM + al256((size_t)2 * 2 * 1024 * 4);
constexpr size_t O_ZERO_END = O_QCTR + 512;
constexpr size_t O_XS = O_ZERO_END;
constexpr size_t O_HB = O_XS + al256((size_t)NTOK * DM * 4);
constexpr size_t O_P = O_HB + al256((size_t)NTOK * DM * 2);
constexpr size_t O_WIN = O_P + al256((size_t)NTOK * LDP * 2);
constexpr size_t O_WBR = O_WIN + al256((size_t)LDP * DM * 2);
constexpr size_t O_WOUT = O_WBR + al256((size_t)4 * DM * BW * 2);
constexpr size_t O_WGU = O_WOUT + al256((size_t)DM * DM * 2);
constexpr size_t O_WD = O_WGU + al256((size_t)NEXP * 2 * DEXP * DM * 2);
constexpr size_t O_GLU = O_WD + al256((size_t)NEXP * DM * DEXP * 2);
constexpr size_t O_Y4 = O_GLU + al256((size_t)BW * BW * 2);
constexpr size_t O_U = O_Y4 + al256((size_t)NTOK * DM * 2);
constexpr size_t O_QKB = O_U + al256((size_t)NTOK * 1536 * 4);
constexpr size_t O_CST = O_QKB + al256((size_t)NTOK * 1024 * 2);
constexpr size_t O_NST = O_CST + al256((size_t)32 * 68 * 128 * 128 * 2);
constexpr size_t O_MST = O_NST + al256((size_t)32 * 68 * 128 * 4);
constexpr size_t O_XBC = O_MST + al256((size_t)32 * 68 * 4);
constexpr size_t O_SST = O_XBC + al256((size_t)NTOK * 1024 * 2);
constexpr size_t O_HF = O_SST + al256((size_t)64 * 68 * 64 * 128 * 2);
constexpr size_t O_YF = O_HF + al256((size_t)2 * NTOK * BW * 4);
constexpr size_t O_SF = O_YF + al256((size_t)2 * NTOK * BW * 4);
constexpr size_t O_LDT = O_SF + al256((size_t)2 * NCTX * BW * 4);
constexpr size_t O_AP = O_LDT + al256((size_t)4096 * 16);
constexpr size_t O_BBT = O_AP + al256((size_t)4096 * 33 * 8);
constexpr size_t O_KT = O_BBT + al256((size_t)4096 * 16 * 8);
constexpr size_t O_S5A = O_KT + al256((size_t)32 * 2 * 32 * 256 * 4);
constexpr size_t O_S5B = O_S5A + al256((size_t)32 * 512 * 768 * 2);
constexpr size_t O_XCTX = O_S5B + al256((size_t)32 * 512 * 768 * 2);
constexpr size_t O_Z = O_XCTX + al256((size_t)4 * 32 * 2 * 64 * 8);
constexpr size_t O_HRAW = O_Z + al256((size_t)NTOK * BW * 4);
constexpr size_t O_HSPEC = O_HRAW + al256((size_t)(SEQ + CTXL) * 2048 * 4);
constexpr size_t O_K2C = O_HSPEC + al256((size_t)1024 * 8192 * 8);
constexpr size_t O_GG = O_K2C + al256((size_t)(2 * CTXL) * 1024 * 4);
constexpr size_t O_PROBS = O_GG + al256((size_t)NTOK * BW * 2);
constexpr size_t O_ROWTOK = O_PROBS + al256((size_t)NTOK * 16 * 4);
constexpr size_t O_ROWGATE = O_ROWTOK + al256((size_t)NEXP * MOE_PAD * 4);
constexpr size_t O_INV = O_ROWGATE + al256((size_t)NEXP * MOE_PAD * 4);
constexpr size_t O_NORMP = O_INV + al256((size_t)NTOK * 16 * 4);
constexpr size_t WS_END = O_NORMP + al256((size_t)4 * 256 * 2048 * 4);
constexpr size_t O_XG = O_P;
constexpr size_t O_HID = O_P + al256((size_t)NEXP * MOE_PAD * DM * 2);
constexpr size_t O_YEXP = O_HID + al256((size_t)NEXP * MOE_PAD * DEXP * 2);
static_assert(O_YEXP + (size_t)NEXP * MOE_PAD * DM * 2 <= O_WIN, "MoE temporaries must fit inside P");
static_assert((size_t)NTOK * DM * 2 <= (size_t)NTOK * 1536 * 4, "ACCb must fit inside U");
static_assert((size_t)26214400 + (size_t)2 * 17825792 + (size_t)272 * 256 * 64 * 2 <= (size_t)NTOK * DM * 2, "strip buffers must fit inside HB");
static_assert(WS_END <= (size_t)1851000000, "workspace map exceeds the guaranteed size");

struct Args {
    const float* in[47];
    float* out; unsigned char* ws;
    int ph_lo, ph_hi;
};

__device__ __forceinline__ void conv_tile(const float* __restrict__ src, int ldsrc, int nvalid, int k0, int n0, bf16_t* __restrict__ dst, int lddst, int mode, float* T, int tid) {
    { const int n = tid & 63, kr = tid >> 6;
#pragma unroll
      for (int i = 0; i < 8; ++i) { const int k = i * 8 + kr; T[k * 65 + n] = (n0 + n < nvalid) ? src[(size_t)(k0 + k) * ldsrc + n0 + n] : 0.f; } }
    __syncthreads();
    { const int n = tid >> 3, kc = (tid & 7) * 8; const int gn = n0 + n;
      const int drow = mode == 0 ? gn : (32 * (gn >> 4) + (mode == 2 ? 16 : 0) + (gn & 15));
      u32x4 w; w.x = pk2(T[(kc + 0) * 65 + n], T[(kc + 1) * 65 + n]); w.y = pk2(T[(kc + 2) * 65 + n], T[(kc + 3) * 65 + n]);
      w.z = pk2(T[(kc + 4) * 65 + n], T[(kc + 5) * 65 + n]); w.w = pk2(T[(kc + 6) * 65 + n], T[(kc + 7) * 65 + n]);
      *(u32x4*)(dst + (size_t)drow * lddst + k0 + kc) = w; }
    __syncthreads();
}

#define IN(id) (lo <= (id) && (id) < hi)
#define SEAM(id) do { if (hi > (id) + 1) xcd_barrier(bar); } while (0)
#define PH_BEGIN int tid = threadIdx.x; asm volatile("" : "+v"(tid) :: "memory"); const int lane = tid & 63, wave = tid >> 6; (void)lane; (void)wave;

#define x_in (PT(0))
#define c_in (PT(1))
#define ctx_in (PT(2))
#define cctx_in (PT(3))
#define ada_w (PT(4))
#define ada_b (PT(5))
#define norm_mix (PT(6))
#define norm_ffn (PT(7))
#define w_in (PT(8))
#define XS ((float*)(a.ws + O_XS))
#define MOD ((float*)(a.ws + O_MOD))
#define NORM ((float*)(a.ws + O_NORM))
#define NORMP ((float*)(a.ws + O_NORMP))
#define MODl (MOD + (size_t)l * 5 * 6 * DM)
#define HB ((bf16_t*)(a.ws + O_HB))
#define P ((bf16_t*)(a.ws + O_P))
#define WIN ((bf16_t*)(a.ws + O_WIN))
#define WBR ((bf16_t*)(a.ws + O_WBR))
#define WOUT ((bf16_t*)(a.ws + O_WOUT))
#define WGU ((bf16_t*)(a.ws + O_WGU))
#define WD ((bf16_t*)(a.ws + O_WD))
#define GLU ((bf16_t*)(a.ws + O_GLU))
#define Y4 ((bf16_t*)(a.ws + O_Y4))
#define U ((float*)(a.ws + O_U))
#define ACCb ((bf16_t*)(a.ws + O_U))
#define QKB ((bf16_t*)(a.ws + O_QKB))
#define CST ((bf16_t*)(a.ws + O_CST))
#define NST ((float*)(a.ws + O_NST))
#define MST ((float*)(a.ws + O_MST))
#define XBC ((bf16_t*)(a.ws + O_XBC))
#define SSTB ((bf16_t*)(a.ws + O_SST))
#define HF ((float*)(a.ws + O_HF))
#define HBk (HF + (size_t)NTOK * BW)
#define YF ((float*)(a.ws + O_YF))
#define YB (YF + (size_t)NTOK * BW)
#define SF ((float*)(a.ws + O_SF))
#define SB (SF + (size_t)NCTX * BW)
#define LDT ((double2*)(a.ws + O_LDT))
#define APW ((float2*)(a.ws + O_AP))
#define BBT ((float2*)(a.ws + O_BBT))
#define KTB ((float*)(a.ws + O_KT))
#define S5A ((bf16_t*)(a.ws + O_S5A))
#define S5B ((bf16_t*)(a.ws + O_S5B))
#define XCTX ((float2*)(a.ws + O_XCTX))
#define S5P ((bf16_t*)(a.ws + O_HB))
#define XLOC ((float*)(a.ws + O_HB + (size_t)32 * 256 * 512 * 2))
#define KTG ((bf16_t*)(a.ws + O_HB + (size_t)26214400))
#define VTG ((bf16_t*)(a.ws + O_HB + (size_t)26214400 + (size_t)17825792))
#define BTG ((bf16_t*)(a.ws + O_HB + (size_t)26214400 + (size_t)2 * 17825792))
#define XTG ((bf16_t*)(a.ws + O_GG))
#define Z ((float*)(a.ws + O_Z))
#define HRAW ((float*)(a.ws + O_HRAW))
#define HSPEC ((float2*)(a.ws + O_HSPEC))
#define UT ((float*)(a.ws + O_U))
#define YT ((float*)(a.ws + O_Z))
#define QCTR ((int*)(a.ws + O_QCTR))
#define K2C ((float*)(a.ws + O_K2C))
#define GG ((bf16_t*)(a.ws + O_GG))
#define PROBS ((float*)(a.ws + O_PROBS))
#define ROWTOK ((int*)(a.ws + O_ROWTOK))
#define ROWGATE ((float*)(a.ws + O_ROWGATE))
#define XG ((bf16_t*)(a.ws + O_XG))
#define HID ((bf16_t*)(a.ws + O_HID))
#define YEXP ((bf16_t*)(a.ws + O_YEXP))
#define INV ((int*)(a.ws + O_INV))


__device__ __forceinline__ void moe_pair(float4 (&a)[8], const int r1, const int r2, const float g2scale, const int lane, const float* __restrict__ rowgate, const bf16_t* __restrict__ yexp) {
    const float gt1 = rowgate[r1], gt2 = rowgate[r2] * g2scale;
    const bf16_t* y1 = yexp + (size_t)r1 * DM + lane * 4; const bf16_t* y2 = yexp + (size_t)r2 * DM + lane * 4;
    u32x2 w1[8], w2[8];
#pragma unroll
    for (int i = 0; i < 8; ++i) { w1[i] = *(const u32x2*)(y1 + i * 256); w2[i] = *(const u32x2*)(y2 + i * 256); }
#pragma unroll
    for (int i = 0; i < 8; ++i) {
        a[i].x += gt1 * __uint_as_float(w1[i].x << 16); a[i].y += gt1 * __uint_as_float(w1[i].x & 0xFFFF0000u); a[i].z += gt1 * __uint_as_float(w1[i].y << 16); a[i].w += gt1 * __uint_as_float(w1[i].y & 0xFFFF0000u);
        a[i].x += gt2 * __uint_as_float(w2[i].x << 16); a[i].y += gt2 * __uint_as_float(w2[i].x & 0xFFFF0000u); a[i].z += gt2 * __uint_as_float(w2[i].y << 16); a[i].w += gt2 * __uint_as_float(w2[i].y & 0xFFFF0000u); }
}
__device__ __forceinline__ void moe_combine(float4 (&v)[8], const int tok, const int lane, const int* __restrict__ inv, const float* __restrict__ rowgate, const bf16_t* __restrict__ yexp, const float* __restrict__ m5) {
    float4 a[8], mm[8];
#pragma unroll
    for (int i = 0; i < 8; ++i) { a[i] = make_float4(0.f, 0.f, 0.f, 0.f); mm[i] = *(const float4*)(m5 + i * 256 + lane * 4); }
    const int4* ip = (const int4*)(inv + (size_t)tok * 16);
    const int4 q0 = ip[0], q1 = ip[1], q2 = ip[2], q3 = ip[3];
    const int rows[16] = {q0.x, q0.y, q0.z, q0.w, q1.x, q1.y, q1.z, q1.w, q2.x, q2.y, q2.z, q2.w, q3.x, q3.y, q3.z, q3.w};
    int prow = -1;
#pragma unroll
    for (int e = 0; e < 16; ++e) { const int row = __builtin_amdgcn_readfirstlane(rows[e]);
        if (row >= 0) { if (prow >= 0) { moe_pair(a, prow, row, 1.0f, lane, rowgate, yexp); prow = -1; } else prow = row; } }
    if (prow >= 0) moe_pair(a, prow, prow, 0.0f, lane, rowgate, yexp);
#pragma unroll
    for (int i = 0; i < 8; ++i) { v[i].x += mm[i].x * a[i].x; v[i].y += mm[i].y * a[i].y; v[i].z += mm[i].z * a[i].z; v[i].w += mm[i].w * a[i].w; }
}
struct CvU { const float* src; bf16_t* dst; int ldsrc, nvalid, k0, n0, lddst, mode; };
__device__ __forceinline__ void cv_load(const CvU& u, float4 (&r)[8], const int tid) {
#pragma unroll
    for (int i = 0; i < 8; ++i) { const int idx = tid + i * 512; const int k = idx >> 6, n = u.n0 + (idx & 63) * 4;
        r[i] = (n < u.nvalid) ? *(const float4*)(u.src + (size_t)(u.k0 + k) * u.ldsrc + n) : make_float4(0.f, 0.f, 0.f, 0.f); }
}
__device__ __forceinline__ void cv_stage(float* T, const float4 (&r)[8], const int tid) {
#pragma unroll
    for (int i = 0; i < 8; ++i) { const int idx = tid + i * 512; float* p = T + (idx >> 6) * 257 + (idx & 63) * 4; p[0] = r[i].x; p[1] = r[i].y; p[2] = r[i].z; p[3] = r[i].w; }
}
__device__ __forceinline__ void cv_store(const CvU& u, const float* T, const int tid) {
#pragma unroll
    for (int j = 0; j < 4; ++j) { const int o = tid + j * 512; const int kc = (o & 7) * 8, n = o >> 3; const int gn = u.n0 + n;
        const int drow = u.mode == 0 ? gn : (256 * (gn >> 7) + (u.mode == 2 ? 128 : 0) + (gn & 127));
        const float* t = T + kc * 257 + n;
        u32x4 w; w.x = pk2(t[0], t[257]); w.y = pk2(t[2 * 257], t[3 * 257]); w.z = pk2(t[4 * 257], t[5 * 257]); w.w = pk2(t[6 * 257], t[7 * 257]);
        *(u32x4*)(u.dst + (size_t)drow * u.lddst + u.k0 + kc) = w; }
}
#define CV_RUN(LL, QSTART, QSTEP, QEND) do { \
                const float* wbr = PT(40) + (size_t)(LL) * 4 * BW * DM; const float* wout = PT(41) + (size_t)(LL) * DM * DM; \
                const float* wg = PT(43) + (size_t)(LL) * NEXP * DM * DEXP; const float* wu = PT(44) + (size_t)(LL) * NEXP * DM * DEXP; const float* wd = PT(45) + (size_t)(LL) * NEXP * DEXP * DM; \
                const float* wglu = PT(32) + (size_t)(LL) * BW * BW; const float* win = w_in + (size_t)(LL) * DM * IN_W; \
                const int cv_step = (QSTEP), cv_end = (QEND); \
                __syncthreads(); \
                int q = (QSTART); int buf = 0; CvU u; float4 r[8]; \
                if (q < cv_end) { CV_DECODE(q, u); cv_load(u, r, tid); } \
                while (q < cv_end) { \
                    float* T = sf + buf * (64 * 257); \
                    cv_stage(T, r, tid); \
                    __syncthreads(); \
                    const CvU cur = u; const int qn = q + cv_step; \
                    if (qn < cv_end) { CV_DECODE(qn, u); cv_load(u, r, tid); } \
                    cv_store(cur, T, tid); \
                    buf ^= 1; q = qn; \
                } \
                __syncthreads(); } while (0)
#define CV_DECODE(q_, u_) do { int qq_ = (q_); \
                    if (qq_ < n_win) { u_ = CvU{win, WIN, IN_W, IN_W, (qq_ / 55) * 64, (qq_ % 55) * 256, DM, 0}; } else { qq_ -= n_win; \
                    if (qq_ < n_br) { const int k = qq_ >> 6, r = qq_ & 63; u_ = CvU{wbr + (size_t)k * BW * DM, WBR + (size_t)k * DM * BW, DM, DM, (r >> 3) * 64, (r & 7) * 256, BW, 0}; } else { qq_ -= n_br; \
                    if (qq_ < n_out) { u_ = CvU{wout, WOUT, DM, DM, (qq_ >> 3) * 64, (qq_ & 7) * 256, DM, 0}; } else { qq_ -= n_out; \
                    if (qq_ < n_glu) { u_ = CvU{wglu, GLU, BW, BW, (qq_ >> 1) * 64, (qq_ & 1) * 256, BW, 0}; } else { qq_ -= n_glu; \
                    if (qq_ < n_gu) { const int e = qq_ / 384, r = qq_ % 384, up = r / 192, r2 = r % 192; u_ = CvU{(up ? wu : wg) + (size_t)e * DM * DEXP, WGU + (size_t)e * 2 * DEXP * DM, DEXP, DEXP, (r2 / 6) * 64, (r2 % 6) * 256, DM, 1 + up}; } else { qq_ -= n_gu; \
                    { const int e = qq_ / 192, r = qq_ % 192; u_ = CvU{wd + (size_t)e * DEXP * DM, WD + (size_t)e * DM * DEXP, DM, DM, (r >> 3) * 64, (r & 7) * 256, DEXP, 0}; } } } } } } } while (0)
template <int LAYER>
__device__ __forceinline__ void layer_body(const Args& a, const XcdBarrier& bar, const int lo, const int hi, const int bid, const int G, unsigned char* const shm, float* const sf, const float** const ptab) {
        constexpr int l = LAYER;
        constexpr int PB = 1 + 16 * l;
        const bool lastl = (l == 1);

        const int nPanels = lastl ? 64 : 68;
        const int M2 = nPanels * 256;

        if (IN(PB + 0)) for (int rep_ = 0; rep_ < (l == 0 ? PROBE_REPS(0) : 1); ++rep_) {
            PH_BEGIN
            {   const int n_win = 32 * 55, n_br = 4 * 64, n_out = 32 * 8, n_glu = 16, n_gu = 16 * 2 * 192, n_d = 16 * 192;
                const int n_grp1 = n_win + n_br + n_out + n_glu, total = n_grp1 + n_gu + n_d;
                const int q_lo = (l > 0 && G > 128) ? n_win : 0;
                CV_RUN(l, q_lo + bid, G, total);
            }
            for (int set = 0; set < (lastl ? 1 : 2); ++set) {
                const int L = set ? CTXL : SEQ; float* HR = HRAW + (set ? (size_t)SEQ * 2048 : 0);
                const float* w1 = PT(11) + l * 33 * 64; const float* b1 = PT(12) + l * 64; const float* fr1 = PT(13) + l * 64; const float* w2 = PT(14) + l * 64 * 64; const float* b2 = PT(15) + l * 64;
                const float* fr2 = PT(16) + l * 64; const float* w3 = PT(17) + l * 64 * 2048; const float* decay = PT(18) + l * 2048;
                float* feats = sf; float* h1 = sf + 16 * 33; float* h2 = h1 + 16 * 64;
                float nacc[4] = {0.f, 0.f, 0.f, 0.f};
                for (int base = bid; base < L; base += 16 * G) {
                    __syncthreads();
                    for (int e = tid; e < 16 * 33; e += NTHR) { const int ti = e / 33, fi = e % 33; int t = base + ti * G; if (t > L - 1) t = L - 1;
                        float v;
                        if (fi == 0) v = (float)t / (float)(L - 1);
                        else { const int j = (fi - 1) & 15; const double fr = 1e-4 + (double)j * ((15.0 - 1e-4) / 15.0); const double ang = (2.0 * 3.14159265358979323846 / (double)L) * (double)t * fr; v = fi <= 16 ? (float)cos(ang) : (float)(-sin(ang)); }
                        feats[e] = v; }
                    __syncthreads();
                    { const int j = tid & 63, ti = tid >> 6; float s0 = b1[j], s1 = s0;
_Pragma("unroll 3")
                      for (int i = 0; i < 33; ++i) { const float wv = w1[i * 64 + j]; s0 += feats[ti * 33 + i] * wv; s1 += feats[(ti + 8) * 33 + i] * wv; }
                      const float f1 = fr1[j]; h1[ti * 64 + j] = sinf(f1 * s0); h1[(ti + 8) * 64 + j] = sinf(f1 * s1); }
                    __syncthreads();
                    { const int j = tid & 63, ti = tid >> 6; float s0 = b2[j], s1 = s0;
_Pragma("unroll 4")
                      for (int i = 0; i < 64; ++i) { const float wv = w2[i * 64 + j]; s0 += h1[ti * 64 + i] * wv; s1 += h1[(ti + 8) * 64 + i] * wv; }
                      const float f2 = fr2[j]; h2[ti * 64 + j] = sinf(f2 * s0); h2[(ti + 8) * 64 + j] = sinf(f2 * s1); }
                    __syncthreads();
                    float acc[16][4];
#pragma unroll
                    for (int ti = 0; ti < 16; ++ti) { acc[ti][0] = 0.f; acc[ti][1] = 0.f; acc[ti][2] = 0.f; acc[ti][3] = 0.f; }
#pragma unroll 2
                    for (int i = 0; i < 64; ++i) { const float* wrow = w3 + (size_t)i * 2048 + tid; const float wa = wrow[0], wb = wrow[512], wc2 = wrow[1024], wd2 = wrow[1536];
#pragma unroll
                        for (int ti = 0; ti < 16; ++ti) { const float hv = h2[ti * 64 + i]; acc[ti][0] += hv * wa; acc[ti][1] += hv * wb; acc[ti][2] += hv * wc2; acc[ti][3] += hv * wd2; } }
                    float dk[4];
#pragma unroll
                    for (int k = 0; k < 4; ++k) dk[k] = fabsf(decay[tid + k * 512]);
#pragma unroll
                    for (int ti = 0; ti < 16; ++ti) { const int t = base + ti * G; if (t < L) { const float tn = (float)t / (float)(L - 1);
#pragma unroll
                        for (int k = 0; k < 4; ++k) { const float v = acc[ti][k] * expf(-tn * dk[k]); HR[(size_t)t * 2048 + tid + k * 512] = v; nacc[k] += fabsf(v); } } }
                }
                float* nrp = NORMP + ((size_t)(l * 2 + set) * 256 + bid) * 2048;
#pragma unroll
                for (int k = 0; k < 4; ++k) nrp[tid + k * 512] = nacc[k];
            }
            for (int idx = bid * NTHR + tid; idx < 4096; idx += G * NTHR) { const int n = idx & 63, g = (idx >> 6) & 31, dir = idx >> 11;
                const double are = (double)(PT(24) + l * 4096)[idx], aim = (double)(PT(25) + l * 4096)[idx]; const double lam = are < -1e-4 ? are : -1e-4; const double dt = exp((double)(PT(26) + l * 64)[dir * 32 + g]);
                const double ldre = lam * dt, ldim = aim * dt; LDT[idx] = make_double2(ldre, ldim);
                const double mag = exp(ldre); const double ar = mag * cos(ldim), ai = mag * sin(ldim);
                const double den = lam * lam + aim * aim; const double nr = ar - 1.0, ni = ai; const double fre = (nr * lam + ni * aim) / den, fim = (ni * lam - nr * aim) / den;
                const float* b_re = PT(27) + l * 32 * 64 * 16; const float* b_im = PT(28) + l * 32 * 64 * 16;
#pragma unroll 4
                for (int c = 0; c < 16; ++c) { const double br = (double)b_re[(g * 64 + n) * 16 + c], bi = (double)b_im[(g * 64 + n) * 16 + c]; BBT[idx * 16 + c] = make_float2((float)(fre * br - fim * bi), (float)(fre * bi + fim * br)); }
            }
            for (int e2 = bid * NTHR + tid; e2 < 4096 * 33; e2 += G * NTHR) { const int idx = e2 / 33, k = e2 - idx * 33; const int g = (idx >> 6) & 31, dir = idx >> 11;
                const double are = (double)(PT(24) + l * 4096)[idx], aim = (double)(PT(25) + l * 4096)[idx]; const double lam = are < -1e-4 ? are : -1e-4; const double dt = exp((double)(PT(26) + l * 64)[dir * 32 + g]);
                const double ldre = lam * dt, ldim = aim * dt; const double mk = exp(ldre * k); APW[e2] = make_float2((float)(mk * cos(ldim * k)), (float)(mk * sin(ldim * k))); }
            if (l == 0 && lo == 0) xcd_barrier(bar);
            for (int tok = bid * 8 + wave; tok < NTOK; tok += G * 8) {
                const int r = tok < NLAT ? tok / SEQ : 4; const float* xr = l == 0 ? (tok < NLAT ? x_in + (size_t)tok * DM : ctx_in + (size_t)(tok - NLAT) * DM) : XS + (size_t)tok * DM; const float* gn = norm_mix + l * DM;
                const float* sh = MODl + (size_t)(r * 6 + 0) * DM; const float* sc = MODl + (size_t)(r * 6 + 1) * DM;
                float4 v[8]; float ss = 0.f;
#pragma unroll
                for (int i = 0; i < 8; ++i) v[i] = *(const float4*)(xr + i * 256 + lane * 4);
                if (l > 0) {
                    moe_combine(v, tok, lane, INV, ROWGATE, YEXP, MOD + (size_t)((l - 1) * 5 + r) * 6 * DM + 5 * DM);
#pragma unroll
                    for (int i = 0; i < 8; ++i) *(float4*)(XS + (size_t)tok * DM + i * 256 + lane * 4) = v[i]; }
#pragma unroll
                for (int i = 0; i < 8; ++i) ss += v[i].x * v[i].x + v[i].y * v[i].y + v[i].z * v[i].z + v[i].w * v[i].w;
                ss = wave_sum(ss); const float rs = rsqrtf(ss * (1.0f / DM) + 1e-6f);
#pragma unroll
                for (int i = 0; i < 8; ++i) { const int d = i * 256 + lane * 4; const float4 g4 = *(const float4*)(gn + d), s4 = *(const float4*)(sc + d), h4 = *(const float4*)(sh + d);
                    v[i].x = v[i].x * rs * g4.x * (1.f + s4.x) + h4.x; v[i].y = v[i].y * rs * g4.y * (1.f + s4.y) + h4.y; v[i].z = v[i].z * rs * g4.z * (1.f + s4.z) + h4.z; v[i].w = v[i].w * rs * g4.w * (1.f + s4.w) + h4.w; }
#pragma unroll
                for (int i = 0; i < 8; ++i) { u32x2 w; w.x = pk2(v[i].x, v[i].y); w.y = pk2(v[i].z, v[i].w); *(u32x2*)(HB + (size_t)tok * DM + i * 256 + lane * 4) = w; }
            }
            SEAM(PB + 0);
        }

        if (IN(PB + 1)) for (int rep_ = 0; rep_ < PROBE_REPS(1); ++rep_) {
            PH_BEGIN
            for (int base = bid * 8; base < (lastl ? 1 : 2) * 1024; base += G * 8) {
                const int idx = base + (tid & 7), sl = tid >> 3; const int set = idx >> 10, oc = idx & 1023, o = oc >> 9, c = oc & 511;
                const float* pp = NORMP + (size_t)(l * 2 + set) * 256 * 2048 + o * 1024 + c + (size_t)(sl * 4) * 2048; float sacc = 0.f;
#pragma unroll
                for (int j = 0; j < 4; ++j) { const float p0 = pp[(size_t)j * 2048], p1 = pp[(size_t)j * 2048 + 512]; sacc += (sl * 4 + j < G) ? p0 + p1 : 0.f; }
                sf[sl * 8 + (tid & 7)] = sacc; __syncthreads();
                if (tid < 8) { float t = 0.f;
#pragma unroll 8
                    for (int q = 0; q < 64; ++q) t += sf[q * 8 + tid];
                    NORM[(size_t)(l * 2 + set) * 1024 + oc] = t; }
                __syncthreads(); }
            for (int idx = (G - 1 - bid) * NTHR + tid; idx < 32768; idx += G * NTHR) { const int c = idx & 15, lag = (idx >> 4) & 31, dir = (idx >> 9) & 1, g = idx >> 10;
                const float* c_re = PT(29) + l * 32 * 16 * 64 + (g * 16 + c) * 64; const float* c_im = PT(30) + l * 32 * 16 * 64 + (g * 16 + c) * 64;
                float acc[16];
#pragma unroll
                for (int j = 0; j < 16; ++j) acc[j] = 0.f;
#pragma unroll 2
                for (int n = 0; n < 64; ++n) { const int pi = (dir * 32 + g) * 64 + n; const float2 ap = APW[pi * 33 + lag]; const float cr = c_re[n], ci = c_im[n]; const float wr_ = cr * ap.x - ci * ap.y, wi_ = cr * ap.y + ci * ap.x;
                    const float4* bb = (const float4*)(BBT + pi * 16);
#pragma unroll
                    for (int j = 0; j < 8; ++j) { const float4 b2 = bb[j]; acc[2 * j] += wr_ * b2.x - wi_ * b2.y; acc[2 * j + 1] += wr_ * b2.z - wi_ * b2.w; } }
                float4* o = (float4*)(KTB + (size_t)idx * 16);
                o[0] = make_float4(acc[0], acc[1], acc[2], acc[3]); o[1] = make_float4(acc[4], acc[5], acc[6], acc[7]); o[2] = make_float4(acc[8], acc[9], acc[10], acc[11]); o[3] = make_float4(acc[12], acc[13], acc[14], acc[15]);
            }
            __syncthreads();
            pg8::Gemm g{HB, WIN, DM, DM, DM}; pg8::SchedStd S{68, 55, G, bid, DM, DM}; pg8::EpiWin E{P, LDP};
            pg8::gemm_phase(( LAS unsigned char*)shm, g, S, E);
#if defined(PROBE_BNOEPI)
            { __syncthreads(); pg8::EpiNone E0; pg8::gemm_phase((LAS unsigned char*)shm, g, S, E0); }
#endif
            SEAM(PB + 1);
        }

        if (IN(PB + 2)) for (int rep_ = 0; rep_ < PROBE_REPS(2); ++rep_) {
            PH_BEGIN
            const float* hcw = PT(9) + l * 3 * 1536; const float* hcb = PT(10) + l * 1536; const float* mcw = PT(20) + l * 3 * 1024; const float* mcb = PT(21) + l * 1024;
            const float* scw = PT(34) + l * 3 * 1024; const float* scb = PT(35) + l * 1024;
            for (int unit = bid; unit < 272 * 3; unit += G) { const int seg = unit / 3, kind = unit % 3; const bool lat = seg < 256; const size_t tok0 = lat ? (size_t)seg * 64 : (size_t)NLAT + (size_t)(seg - 256) * 64;
                if (kind < 2) { const int hf = kind;
                    const int c = tid * 2; const int col = (hf ? SSD_OFF + 512 : ML_OFF) + c; const float* w = hf ? scw : mcw; const float* bsp = hf ? scb : mcb; bf16_t* dst = (hf ? XBC : QKB) + tok0 * 1024 + c;
                    const float2 w0 = *(const float2*)(w + c), w1 = *(const float2*)(w + 1024 + c), w2 = *(const float2*)(w + 2048 + c), bb = *(const float2*)(bsp + c);
                    const float osc = (!hf && c >= 512) ? 0.08838834764831845f : 1.0f;
                    const bool hasPrev = !lat && ((tok0 - NLAT) & (CTXL - 1)) != 0, hasNext = !lat && (((tok0 - NLAT) + 63) & (CTXL - 1)) != CTXL - 1;
                    bf16_t* strip = nullptr;
                    if (!hf) { if (c >= 512) strip = KTG + ((size_t)seg * 512 + (c - 512)) * 64; }
                    else { if (c < 512) strip = XTG + ((size_t)seg * 512 + c) * 64; else if (c < 768) strip = BTG + ((size_t)seg * 256 + (c - 512)) * 64; }
                    const bf16_t* pp = P + tok0 * LDP + col;
                    unsigned raw[66];
#pragma unroll
                    for (int t = 0; t < 66; ++t) raw[t] = ((t == 0 && !hasPrev) || (t == 65 && !hasNext)) ? 0u : *(const unsigned*)(pp + (ptrdiff_t)(t - 1) * LDP);
#pragma unroll
                    for (int t8 = 0; t8 < 8; ++t8) { float v0[8], v1[8];
#pragma unroll
                        for (int tt = 0; tt < 8; ++tt) { const int t = t8 * 8 + tt; const unsigned p0 = raw[t], p1 = raw[t + 1], p2 = raw[t + 2];
                            float a0 = bb.x + w0.x * __uint_as_float(p0 << 16) + w1.x * __uint_as_float(p1 << 16) + w2.x * __uint_as_float(p2 << 16);
                            float a1 = bb.y + w0.y * __uint_as_float(p0 & 0xFFFF0000u) + w1.y * __uint_as_float(p1 & 0xFFFF0000u) + w2.y * __uint_as_float(p2 & 0xFFFF0000u);
                            a0 = siluf_(a0) * osc; a1 = siluf_(a1) * osc; v0[tt] = a0; v1[tt] = a1;
                            *(unsigned*)(dst + (size_t)t * 1024) = pk2(a0, a1); }
                        if (strip) { u32x4 s0, s1; s0.x = pk2(v0[0], v0[1]); s0.y = pk2(v0[2], v0[3]); s0.z = pk2(v0[4], v0[5]); s0.w = pk2(v0[6], v0[7]); s1.x = pk2(v1[0], v1[1]); s1.y = pk2(v1[2], v1[3]); s1.z = pk2(v1[4], v1[5]); s1.w = pk2(v1[6], v1[7]);
                            *(u32x4*)(strip + t8 * 8) = s0; *(u32x4*)(strip + 64 + t8 * 8) = s1; } }
                } else {
                    const int c = (tid & 255) * 2, th = tid >> 8; const bf16_t* pp = P + (tok0 + th * 32) * LDP + ML_OFF + 1024 + c; bf16_t* strip = VTG + ((size_t)seg * 512 + c) * 64 + th * 32;
                    unsigned rv[32];
#pragma unroll
                    for (int t = 0; t < 32; ++t) rv[t] = *(const unsigned*)(pp + (size_t)t * LDP);
#pragma unroll
                    for (int t8 = 0; t8 < 4; ++t8) { u32x4 s0, s1;
                        s0.x = (rv[t8 * 8 + 0] & 0xFFFFu) | (rv[t8 * 8 + 1] << 16); s0.y = (rv[t8 * 8 + 2] & 0xFFFFu) | (rv[t8 * 8 + 3] << 16); s0.z = (rv[t8 * 8 + 4] & 0xFFFFu) | (rv[t8 * 8 + 5] << 16); s0.w = (rv[t8 * 8 + 6] & 0xFFFFu) | (rv[t8 * 8 + 7] << 16);
                        s1.x = (rv[t8 * 8 + 0] >> 16) | (rv[t8 * 8 + 1] & 0xFFFF0000u); s1.y = (rv[t8 * 8 + 2] >> 16) | (rv[t8 * 8 + 3] & 0xFFFF0000u); s1.z = (rv[t8 * 8 + 4] >> 16) | (rv[t8 * 8 + 5] & 0xFFFF0000u); s1.w = (rv[t8 * 8 + 6] >> 16) | (rv[t8 * 8 + 7] & 0xFFFF0000u);
                        *(u32x4*)(strip + t8 * 8) = s0; *(u32x4*)(strip + 64 + t8 * 8) = s1; }
                }
            }
            if (!lastl) for (int tok = NLAT + bid; tok < NTOK; tok += G) {
                const int t = (tok - NLAT) & (CTXL - 1); const bool hasL = (t != 0), hasR = (t != CTXL - 1); const bf16_t* pr = P + (size_t)tok * LDP;
                const bf16_t* prL = hasL ? pr - LDP : pr; const bf16_t* prR = hasR ? pr + LDP : pr;
                unsigned xc[3], xl[3], xr[3];
#pragma unroll
                for (int j = 0; j < 3; ++j) { const int cc = tid + j * 512; xc[j] = pr[HY_OFF + cc]; xl[j] = prL[HY_OFF + cc]; xr[j] = prR[HY_OFF + cc]; }
#pragma unroll
                for (int j = 0; j < 3; ++j) { const int cc = tid + j * 512;
                    float acc = hcb[cc] + hcw[1536 + cc] * __uint_as_float(xc[j] << 16);
                    acc += hasL ? hcw[cc] * __uint_as_float(xl[j] << 16) : 0.f;
                    acc += hasR ? hcw[2 * 1536 + cc] * __uint_as_float(xr[j] << 16) : 0.f;
                    U[(size_t)tok * 1536 + cc] = acc; }
            }
            for (int idx0 = bid * NTHR + tid; idx0 < 16384 * 64; idx0 += 4 * G * NTHR) { u32x4 t4[4];
#pragma unroll
                for (int q = 0; q < 4; ++q) { const int idx = idx0 + q * G * NTHR; const int half = idx & 1, g = (idx >> 1) & 31, tok = idx >> 6;
                    if (idx < 16384 * 64) t4[q] = *(const u32x4*)(P + (size_t)tok * LDP + S5_OFF + g * 16 + half * 8); }
#pragma unroll
                for (int q = 0; q < 4; ++q) { const int idx = idx0 + q * G * NTHR; const int half = idx & 1, g = (idx >> 1) & 31, tok = idx >> 6;
                    if (idx < 16384 * 64) *(u32x4*)(S5A + ((size_t)g * 512 + (tok >> 5)) * 768 + (tok & 31) * 16 + half * 8) = t4[q]; } }
            for (int idx = bid * NTHR + tid; idx < 32 * 512 * 32 * 2; idx += G * NTHR) { const int half = idx & 1, sI = (idx >> 1) & 31, row = (idx >> 6) & 511, g = idx >> 15; const int t = row >> 4, c = row & 15; const int lag = t - sI;
                float v[8];
                if (lag > 0) { const float4* k4 = (const float4*)(KTB + ((size_t)((g * 2 + 0) * 32 + lag) * 16 + c) * 16 + half * 8); const float4 a0 = k4[0], a1 = k4[1]; v[0] = a0.x; v[1] = a0.y; v[2] = a0.z; v[3] = a0.w; v[4] = a1.x; v[5] = a1.y; v[6] = a1.z; v[7] = a1.w; }
                else if (lag < 0) { const float4* k4 = (const float4*)(KTB + ((size_t)((g * 2 + 1) * 32 - lag) * 16 + c) * 16 + half * 8); const float4 a0 = k4[0], a1 = k4[1]; v[0] = a0.x; v[1] = a0.y; v[2] = a0.z; v[3] = a0.w; v[4] = a1.x; v[5] = a1.y; v[6] = a1.z; v[7] = a1.w; }
                else { const float4* k4 = (const float4*)(KTB + ((size_t)((g * 2 + 0) * 32) * 16 + c) * 16 + half * 8); const float4* q4 = (const float4*)(KTB + ((size_t)((g * 2 + 1) * 32) * 16 + c) * 16 + half * 8); const float4 a0 = k4[0], a1 = k4[1], b0 = q4[0], b1 = q4[1];
                    v[0] = a0.x + b0.x; v[1] = a0.y + b0.y; v[2] = a0.z + b0.z; v[3] = a0.w + b0.w; v[4] = a1.x + b1.x; v[5] = a1.y + b1.y; v[6] = a1.z + b1.z; v[7] = a1.w + b1.w; }
                u32x4 w; w.x = pk2(v[0], v[1]); w.y = pk2(v[2], v[3]); w.z = pk2(v[4], v[5]); w.w = pk2(v[6], v[7]);
                *(u32x4*)(S5B + ((size_t)g * 512 + row) * 768 + sI * 16 + half * 8) = w; }
            for (int idx = bid * NTHR + tid; idx < 32 * 512 * 64; idx += G * NTHR) { const int n = idx & 63, row = (idx >> 6) & 511, g = idx >> 15; const int t = row >> 4, c = row & 15;
                const float cr = (PT(29) + l * 32 * 16 * 64)[(g * 16 + c) * 64 + n], ci = (PT(30) + l * 32 * 16 * 64)[(g * 16 + c) * 64 + n];
                const float2 af = APW[((0 * 32 + g) * 64 + n) * 33 + t + 1], ab = APW[((1 * 32 + g) * 64 + n) * 33 + 32 - t];
                bf16_t* d = S5B + ((size_t)g * 512 + row) * 768 + 512 + 2 * n;
                *(unsigned*)d = pk2(cr * af.x - ci * af.y, -(cr * af.y + ci * af.x)); *(unsigned*)(d + 128) = pk2(cr * ab.x - ci * ab.y, -(cr * ab.y + ci * ab.x)); }
            for (int idx = bid * NTHR + tid; idx < 32 * 2 * 64 * 32; idx += G * NTHR) { const int sI = idx & 31, n = (idx >> 5) & 63, dir = (idx >> 11) & 1, g = idx >> 12; const int pi = (dir * 32 + g) * 64 + n;
                const float2 pw = APW[pi * 33 + (dir ? sI : 31 - sI)]; const float4* bb = (const float4*)(BBT + pi * 16);
                float re[16], im[16];
#pragma unroll
                for (int j = 0; j < 8; ++j) { const float4 b2 = bb[j]; re[2 * j] = pw.x * b2.x - pw.y * b2.y; im[2 * j] = pw.x * b2.y + pw.y * b2.x; re[2 * j + 1] = pw.x * b2.z - pw.y * b2.w; im[2 * j + 1] = pw.x * b2.w + pw.y * b2.z; }
                bf16_t* d = S5P + ((size_t)g * 256 + dir * 128 + 2 * n) * 512 + sI * 16;
                u32x4 w0, w1; w0.x = pk2(re[0], re[1]); w0.y = pk2(re[2], re[3]); w0.z = pk2(re[4], re[5]); w0.w = pk2(re[6], re[7]); w1.x = pk2(re[8], re[9]); w1.y = pk2(re[10], re[11]); w1.z = pk2(re[12], re[13]); w1.w = pk2(re[14], re[15]);
                *(u32x4*)d = w0; *(u32x4*)(d + 8) = w1;
                w0.x = pk2(im[0], im[1]); w0.y = pk2(im[2], im[3]); w0.z = pk2(im[4], im[5]); w0.w = pk2(im[6], im[7]); w1.x = pk2(im[8], im[9]); w1.y = pk2(im[10], im[11]); w1.z = pk2(im[12], im[13]); w1.w = pk2(im[14], im[15]);
                *(u32x4*)(d + 512) = w0; *(u32x4*)(d + 520) = w1; }
            {   float* T = sf;
                for (int unit = bid; unit < 4 * 64 * 24; unit += G) { const int b = unit / (64 * 24), r = (unit / 24) % 64, c0 = (unit % 24) * 64; const size_t tok0 = (size_t)b * SEQ + r * 64;
                    __syncthreads();
#pragma unroll
                    for (int i = 0; i < 8; ++i) { const int c = tid & 63, t = (tid >> 6) + 8 * i; T[t * 65 + c] = bf2f(P[(tok0 + t) * LDP + HY_OFF + c0 + c]); }
                    __syncthreads();
                    const int c = tid >> 3, tq = (tid & 7) * 8, cc = c0 + c; const float w0 = hcw[cc], w1 = hcw[1536 + cc], w2 = hcw[3072 + cc], bb = hcb[cc];
                    float o8[8];
#pragma unroll
                    for (int i = 0; i < 8; ++i) { const int t = tq + i; float acc = bb + w1 * T[t * 65 + c]; if (t > 0) acc += w0 * T[(t - 1) * 65 + c]; if (t < 63) acc += w2 * T[(t + 1) * 65 + c]; o8[i] = acc; }
                    float* dst = UT + ((size_t)b * 1536 + cc) * SEQ + r * 64 + tq;
                    *(float4*)dst = make_float4(o8[0], o8[1], o8[2], o8[3]); *(float4*)(dst + 4) = make_float4(o8[4], o8[5], o8[6], o8[7]);
                } }
            if (!lastl) {
                const int L = CTXL; const float* HR = HRAW + (size_t)SEQ * 2048; float* K2 = K2C; const float* nrm = NORM + (size_t)(l * 2 + 1) * 1024;
                const size_t total = (size_t)(2 * L - 1) * 1024;
                for (size_t i = (size_t)bid * NTHR + tid; i < total; i += (size_t)G * NTHR) { const int j = (int)(i >> 10), oc = (int)(i & 1023), o = oc >> 9, c = oc & 511; const int lag = j - (L - 1);
                    const float v = lag >= 0 ? HR[(size_t)lag * 2048 + o * 1024 + c] : HR[(size_t)(-lag) * 2048 + o * 1024 + 512 + c];
                    K2[((size_t)j * 2 + o) * 512 + c] = v / nrm[oc]; }
            }
            {   __syncthreads(); fft_twiddles((float2*)(shm + FFT_X_BYTES), tid);
                for (int oc = bid; oc < 1024; oc += G) hyena_spec_item(oc, HRAW, NORM + (size_t)(l * 2 + 0) * 1024, HSPEC, shm, tid);
                __syncthreads(); }
            SEAM(PB + 2);
        }

        if (IN(PB + 3)) for (int rep_ = 0; rep_ < PROBE_REPS(3); ++rep_) {
            PH_BEGIN
            if (rep_ > 0) { if (bid == 0 && tid == 0) __hip_atomic_store(QCTR + l * 64, 0, __ATOMIC_RELAXED, __HIP_MEMORY_SCOPE_AGENT); xcd_barrier(bar); }
            if (bid < 64) {
                mlstm_state_pass(bid >> 1, bid & 1, P, KTG, VTG, PT(22) + l * 16, CST, NST, MST, shm, tid);
            } else if (bid < 128) {
                { const int ch = bid - 64; const int dir_ = ch & 1, h_ = (ch >> 1) & 7; ssd_state_pass(ch, P, BTG, XTG, -expf(PT(37)[l * 16 + dir_ * 8 + h_]), PT(36)[l * 16 + dir_ * 8 + h_], SSTB, shm, tid); }
            } else if (bid < 160) {
                const int widx = (bid - 128) * 8 + wave; const int dir = widx & 1, g = (widx >> 1) & 31, b = widx >> 6; const int n = lane;
                float2* xb = (float2*)(shm + (size_t)wave * 16640); float2* ctab = xb + 16 * 65;
                const float* a_re = PT(24) + l * 2 * 32 * 64; const float* a_im = PT(25) + l * 2 * 32 * 64; const float* log_dt = PT(26) + l * 64;
                const float* b_re = PT(27) + l * 32 * 64 * 16; const float* b_im = PT(28) + l * 32 * 64 * 16; const float* c_re = PT(29) + l * 32 * 16 * 64; const float* c_im = PT(30) + l * 32 * 16 * 64;
#pragma unroll
                for (int c = 0; c < 16; ++c) ctab[c * 65 + lane] = make_float2(c_re[(g * 16 + c) * 64 + lane], c_im[(g * 16 + c) * 64 + lane]);
                float abr, abi, bbr[16], bbi[16];
                {   const double are = (double)a_re[(dir * 32 + g) * 64 + n], aim = (double)a_im[(dir * 32 + g) * 64 + n];
                    const double lam = are < -1e-4 ? are : -1e-4; const double dt = exp((double)log_dt[dir * 32 + g]);
                    const double mag = exp(lam * dt); const double ar = mag * cos(aim * dt), ai = mag * sin(aim * dt);
                    const double den = lam * lam + aim * aim; const double nr = ar - 1.0, ni = ai;
                    const double fre = (nr * lam + ni * aim) / den, fim = (ni * lam - nr * aim) / den;
                    abr = (float)ar; abi = (float)ai;
#pragma unroll
                    for (int c = 0; c < 16; ++c) { const double br = (double)b_re[(g * 64 + n) * 16 + c], bi = (double)b_im[(g * 64 + n) * 16 + c]; bbr[c] = (float)(fre * br - fim * bi); bbi[c] = (float)(fre * bi + fim * br); }
                }
                float xr = 0.f, xi = 0.f; float* Sout = (dir ? SB : SF) - (size_t)NLAT * BW;
                const int s = lane >> 2, cg = lane & 3;
                for (int i0 = 0; i0 < CTXL; i0 += 16) {
#pragma unroll 4
                    for (int ss = 0; ss < 16; ++ss) {
                        const size_t tok = (size_t)step_tok(b, dir, i0 + ss);
                        const u32x4* up = (const u32x4*)(P + tok * LDP + S5_OFF + g * 16);
                        float t0[8], t1[8]; unpack8(up[0], t0); unpack8(up[1], t1);
                        float bur = 0.f, bui = 0.f;
#pragma unroll
                        for (int c = 0; c < 8; ++c) { bur += t0[c] * bbr[c] + t1[c] * bbr[8 + c]; bui += t0[c] * bbi[c] + t1[c] * bbi[8 + c]; }
                        const float nxr = abr * xr - abi * xi + bur, nxi = abr * xi + abi * xr + bui; xr = nxr; xi = nxi;
                        xb[ss * 65 + lane] = make_float2(xr, xi);
                    }
                    asm volatile("s_waitcnt lgkmcnt(0)" ::: "memory");
                    float y0 = 0.f, y1 = 0.f, y2 = 0.f, y3 = 0.f;
                    for (int nn2 = 0; nn2 < 64; ++nn2) { const float2 xv = xb[s * 65 + nn2];
                        const float2 c0 = ctab[(cg * 4 + 0) * 65 + nn2], c1 = ctab[(cg * 4 + 1) * 65 + nn2], c2 = ctab[(cg * 4 + 2) * 65 + nn2], c3 = ctab[(cg * 4 + 3) * 65 + nn2];
                        y0 += xv.x * c0.x - xv.y * c0.y; y1 += xv.x * c1.x - xv.y * c1.y; y2 += xv.x * c2.x - xv.y * c2.y; y3 += xv.x * c3.x - xv.y * c3.y; }
                    const size_t toks = (size_t)step_tok(b, dir, i0 + s);
                    *(float4*)(Sout + toks * BW + g * 16 + cg * 4) = make_float4(y0, y1, y2, y3);
                    asm volatile("s_waitcnt lgkmcnt(0)" ::: "memory");
                }
                XCTX[((b * 32 + g) * 2 + dir) * 64 + n] = make_float2(xr, xi);
            } else {
                if (bid < 224) {
                    pg8::Gemm gg_{S5A, S5P, 768, 512, 512}; pg8::SchedS5a S_{bid - 160}; pg8::EpiXloc E_{XLOC};
                    pg8::gemm_phase((LAS unsigned char*)shm, gg_, S_, E_);
                    __syncthreads();
                }
                const int nhb = G - 160, hb = bid - 160; const float* bias = PT(19) + l * 1024; const int c = tid;
                const int nitems = lastl ? 0 : 4 * (CTXL / 8);
                for (int it = hb; it < nitems; it += nhb) {
                    int L, tokbase, b, t0; const float* K2;
                    { const int q = it; L = CTXL; tokbase = NLAT; b = q / (CTXL / 8); t0 = (q % (CTXL / 8)) * 8; K2 = K2C; }
                    const float* zb = U + (size_t)(tokbase + b * L) * 1536 + c;
                    float acc[8];
#pragma unroll
                    for (int i = 0; i < 8; ++i) acc[i] = 0.f;
                    const int base = t0 + L - 1;
                    for (int s = 0; s < L; s += 8) {
                        float k[15];
#pragma unroll
                        for (int mm = 0; mm < 15; ++mm) k[mm] = K2[((size_t)(base - s - 7 + mm) * 2 + 0) * 512 + c];
#pragma unroll
                        for (int ds = 0; ds < 8; ++ds) { const float z = zb[(size_t)(s + ds) * 1536];
#pragma unroll
                            for (int i = 0; i < 8; ++i) acc[i] += k[i - ds + 7] * z; }
                    }
#pragma unroll
                    for (int i = 0; i < 8; ++i) { const size_t tok = (size_t)(tokbase + b * L + t0 + i); const float zt = U[tok * 1536 + c]; Z[tok * BW + c] = (acc[i] + bias[c] * zt) * U[tok * 1536 + 512 + c]; }
                }
            }
            {   __syncthreads(); fft_twiddles((float2*)(shm + FFT_X_BYTES), tid);
                int* qslot = (int*)(shm + FFT_X_BYTES + 65536);
                for (;;) { __syncthreads(); if (tid == 0) *qslot = atomicAdd(QCTR + l * 64, 1); __syncthreads(); const int it = *qslot; if (it >= 1024) break;
                    hyena_fft_item(it, UT, HSPEC, PT(19) + l * 1024, YT, shm, tid); }
            }
            SEAM(PB + 3);
        }

        if (IN(PB + 4)) for (int rep_ = 0; rep_ < PROBE_REPS(4); ++rep_) {
            PH_BEGIN
            if (rep_ > 0) { if (bid == 0 && tid == 0) __hip_atomic_store(QCTR + l * 64 + 32, 0, __ATOMIC_RELAXED, __HIP_MEMORY_SCOPE_AGENT); xcd_barrier(bar); }
            if (bid >= G - 32) for (int idx = (bid - (G - 32)) * NTHR + tid; idx < 16384; idx += 32 * NTHR) { const int n = idx & 63, dir = (idx >> 6) & 1, b = (idx >> 7) & 3, g = idx >> 9;
                const float2 a32 = APW[((dir * 32 + g) * 64 + n) * 33 + 32]; float2 X = XCTX[((b * 32 + g) * 2 + dir) * 64 + n];
                const float* __restrict__ xl = XLOC + ((size_t)g * 512 + b * 128) * 256 + dir * 128 + 2 * n; bf16_t* __restrict__ dst = S5A + ((size_t)g * 512 + b * 128) * 768 + 512 + dir * 128 + 2 * n;
#pragma unroll 1
                for (int j0 = 0; j0 < 128; j0 += 16) { float2 xv[16];
#pragma unroll
                    for (int q = 0; q < 16; ++q) { const int j = dir ? 127 - (j0 + q) : j0 + q; xv[q] = *(const float2*)(xl + (size_t)j * 256); }
#pragma unroll
                    for (int q = 0; q < 16; ++q) { const int j = dir ? 127 - (j0 + q) : j0 + q;
                        *(unsigned*)(dst + (size_t)j * 768) = pk2(X.x, X.y);
                        const float nx = a32.x * X.x - a32.y * X.y + xv[q].x, ny = a32.x * X.y + a32.y * X.x + xv[q].y; X.x = nx; X.y = ny; } } }
            {   int* qslot = (int*)(shm + 102400);
                __syncthreads(); if (tid == 0) *qslot = atomicAdd(QCTR + l * 64 + 32, 1); __syncthreads();
                for (;;) { const int it = *qslot; if (it >= 32 * 68 + 64 * 68) break;
                    int nxt_ = 0; if (tid == 0) nxt_ = atomicAdd(QCTR + l * 64 + 32, 1);
                    if (it < 32 * 68) { const int chain = it / 68, c = it % 68; mlstm_out_item(chain, c, P, QKB, VTG, PT(22) + l * 16, CST, NST, MST, (chain & 1) ? HBk : HF, shm, tid); }
                    else { const int i2 = it - 32 * 68; const int chain = i2 / 68, c = i2 % 68; const int dir_ = chain & 1, h_ = (chain >> 1) & 7;
                        ssd_out_item(chain, c, P, XBC, XTG, -expf(PT(37)[l * 16 + dir_ * 8 + h_]), PT(36)[l * 16 + dir_ * 8 + h_], SSTB, dir_ ? YB : YF, shm, tid); }
                    __syncthreads(); if (tid == 0) *qslot = nxt_; __syncthreads(); }
            }
            __syncthreads();
            {   const float* bias = PT(19) + l * 1024 + 512; const int c = tid;
                const int nitems = lastl ? 0 : 4 * (CTXL / 8);
                for (int it = bid; it < nitems; it += G) {
                    int L, tokbase, b, t0; const float* K2;
                    { const int q = it; L = CTXL; tokbase = NLAT; b = q / (CTXL / 8); t0 = (q % (CTXL / 8)) * 8; K2 = K2C; }
                    const float* zb = Z + (size_t)(tokbase + b * L) * BW + c;
                    float acc[8];
#pragma unroll
                    for (int i = 0; i < 8; ++i) acc[i] = 0.f;
                    const int base = t0 + L - 1;
                    for (int s = 0; s < L; s += 8) {
                        float k[15];
#pragma unroll
                        for (int mm = 0; mm < 15; ++mm) k[mm] = K2[((size_t)(base - s - 7 + mm) * 2 + 1) * 512 + c];
#pragma unroll
                        for (int ds = 0; ds < 8; ++ds) { const float z = zb[(size_t)(s + ds) * BW];
#pragma unroll
                            for (int i = 0; i < 8; ++i) acc[i] += k[i - ds + 7] * z; }
                    }
#pragma unroll
                    for (int i = 0; i < 8; ++i) { const size_t tok = (size_t)(tokbase + b * L + t0 + i); const float zt = Z[tok * BW + c]; Y4[tok * DM + c] = f2bf((acc[i] + bias[c] * zt) * U[tok * 1536 + 1024 + c]); }
                }
            }
            SEAM(PB + 4);
        }

        if (IN(PB + 5)) for (int rep_ = 0; rep_ < PROBE_REPS(5); ++rep_) {
            PH_BEGIN
            const float* ml_norm = PT(23) + l * BW; const float* ssd_d = PT(38) + l * 8; const float* ssd_norm = PT(39) + l * BW; const float* s5_d = PT(31) + l * BW;
            if (bid < 128) {
                pg8::Gemm gg_{S5A, S5B, 768, 768, 768}; pg8::SchedS5b S_{bid}; pg8::EpiS5Out E_{P, s5_d, GG};
                pg8::gemm_phase((LAS unsigned char*)shm, gg_, S_, E_);
                __syncthreads();
            }
            for (int tok = bid * 8 + wave; tok < NTOK; tok += G * 8) {
                const int c0 = lane * 8; const bf16_t* pr = P + (size_t)tok * LDP; const size_t o5 = (size_t)tok * BW + c0;
                float hm[8], ys[8];
                const u32x4 ooq = *(const u32x4*)(pr + ML_OFF + 1536 + c0);
                const float4 g0 = *(const float4*)(ml_norm + c0), g1 = *(const float4*)(ml_norm + c0 + 4), n0 = *(const float4*)(ssd_norm + c0), n1 = *(const float4*)(ssd_norm + c0 + 4);
                { const float4 a0 = *(const float4*)(HF + o5), a1 = *(const float4*)(HF + o5 + 4), b0 = *(const float4*)(HBk + o5), b1 = *(const float4*)(HBk + o5 + 4);
                  hm[0] = a0.x + b0.x; hm[1] = a0.y + b0.y; hm[2] = a0.z + b0.z; hm[3] = a0.w + b0.w; hm[4] = a1.x + b1.x; hm[5] = a1.y + b1.y; hm[6] = a1.z + b1.z; hm[7] = a1.w + b1.w; }
                { const float4 a0 = *(const float4*)(YF + o5), a1 = *(const float4*)(YF + o5 + 4), b0 = *(const float4*)(YB + o5), b1 = *(const float4*)(YB + o5 + 4);
                  float xx[8], zz[8]; unpack8(*(const u32x4*)(XBC + (size_t)tok * 1024 + c0), xx); unpack8(*(const u32x4*)(pr + SSD_OFF + c0), zz); const float dsk = ssd_d[c0 >> 6];
                  ys[0] = a0.x + b0.x; ys[1] = a0.y + b0.y; ys[2] = a0.z + b0.z; ys[3] = a0.w + b0.w; ys[4] = a1.x + b1.x; ys[5] = a1.y + b1.y; ys[6] = a1.z + b1.z; ys[7] = a1.w + b1.w;
#pragma unroll
                  for (int j = 0; j < 8; ++j) ys[j] = (ys[j] + dsk * xx[j]) * siluf_(zz[j]); }
                float s1 = 0.f, s2 = 0.f;
#pragma unroll
                for (int j = 0; j < 8; ++j) { s1 += hm[j] * hm[j]; s2 += ys[j] * ys[j]; }
                s1 += __shfl_xor(s1, 1); s1 += __shfl_xor(s1, 2); s1 += __shfl_xor(s1, 4); s1 += __shfl_xor(s1, 8);
                s2 = wave_sum(s2);
                const float r1 = rsqrtf(s1 * (1.0f / 128.0f) + 1e-6f), r2 = rsqrtf(s2 * (1.0f / BW) + 1e-6f);
                float oo[8]; unpack8(ooq, oo);
                const float gm[8] = {g0.x, g0.y, g0.z, g0.w, g1.x, g1.y, g1.z, g1.w}, gs[8] = {n0.x, n0.y, n0.z, n0.w, n1.x, n1.y, n1.z, n1.w};
                u32x4 w;
                w.x = pk2(hm[0] * r1 * gm[0] * sigmoidf_(oo[0]), hm[1] * r1 * gm[1] * sigmoidf_(oo[1])); w.y = pk2(hm[2] * r1 * gm[2] * sigmoidf_(oo[2]), hm[3] * r1 * gm[3] * sigmoidf_(oo[3]));
                w.z = pk2(hm[4] * r1 * gm[4] * sigmoidf_(oo[4]), hm[5] * r1 * gm[5] * sigmoidf_(oo[5])); w.w = pk2(hm[6] * r1 * gm[6] * sigmoidf_(oo[6]), hm[7] * r1 * gm[7] * sigmoidf_(oo[7]));
                *(u32x4*)(Y4 + (size_t)tok * DM + 512 + c0) = w;
                w.x = pk2(ys[0] * r2 * gs[0], ys[1] * r2 * gs[1]); w.y = pk2(ys[2] * r2 * gs[2], ys[3] * r2 * gs[3]); w.z = pk2(ys[4] * r2 * gs[4], ys[5] * r2 * gs[5]); w.w = pk2(ys[6] * r2 * gs[6], ys[7] * r2 * gs[7]);
                *(u32x4*)(Y4 + (size_t)tok * DM + 1536 + c0) = w;
                if (tok >= NLAT) { const size_t oc = (size_t)(tok - NLAT) * BW + c0; float uu[8]; unpack8(*(const u32x4*)(pr + S5_OFF + c0), uu);
                    const float4 a0 = *(const float4*)(SF + oc), a1 = *(const float4*)(SF + oc + 4), b0 = *(const float4*)(SB + oc), b1 = *(const float4*)(SB + oc + 4), d0 = *(const float4*)(s5_d + c0), d1 = *(const float4*)(s5_d + c0 + 4);
                    float y[8] = {a0.x + b0.x + d0.x * uu[0], a0.y + b0.y + d0.y * uu[1], a0.z + b0.z + d0.z * uu[2], a0.w + b0.w + d0.w * uu[3], a1.x + b1.x + d1.x * uu[4], a1.y + b1.y + d1.y * uu[5], a1.z + b1.z + d1.z * uu[6], a1.w + b1.w + d1.w * uu[7]};
#pragma unroll
                    for (int j = 0; j < 8; ++j) y[j] = 0.5f * y[j] * (1.0f + tanhf(0.7978845608028654f * (y[j] + 0.044715f * y[j] * y[j] * y[j])));
                    w.x = pk2(y[0], y[1]); w.y = pk2(y[2], y[3]); w.z = pk2(y[4], y[5]); w.w = pk2(y[6], y[7]);
                    *(u32x4*)(GG + (size_t)tok * BW + c0) = w; }
            }
            __syncthreads();
            {   float* T = sf;
                for (int unit = (G > 128 ? bid - 128 : bid); unit >= 0 && unit < 4 * 64 * 8; unit += (G > 128 ? G - 128 : G)) { const int b = unit / 512, t0 = ((unit >> 3) & 63) * 64, c0 = (unit & 7) * 64;
                    __syncthreads();
#pragma unroll
                    for (int i = 0; i < 8; ++i) { const int t = tid & 63, c = (tid >> 6) + 8 * i; T[c * 65 + t] = YT[((size_t)b * 512 + c0 + c) * SEQ + t0 + t]; }
                    __syncthreads();
                    const int t = tid >> 3, cq = (tid & 7) * 8;
                    u32x4 w; w.x = pk2(T[(cq + 0) * 65 + t], T[(cq + 1) * 65 + t]); w.y = pk2(T[(cq + 2) * 65 + t], T[(cq + 3) * 65 + t]); w.z = pk2(T[(cq + 4) * 65 + t], T[(cq + 5) * 65 + t]); w.w = pk2(T[(cq + 6) * 65 + t], T[(cq + 7) * 65 + t]);
                    *(u32x4*)(Y4 + ((size_t)b * SEQ + t0 + t) * DM + c0 + cq) = w;
                } }
            SEAM(PB + 5);
        }

        if (IN(PB + 6)) for (int rep_ = 0; rep_ < PROBE_REPS(6); ++rep_) {
            PH_BEGIN
            pg8::Gemm g{GG, GLU, BW, BW, BW}; pg8::SchedStd S{68, 2, G, bid, BW, BW}; pg8::EpiGlu E{GG, PT(33) + l * BW, Y4};
            pg8::gemm_phase((LAS unsigned char*)shm, g, S, E);
            SEAM(PB + 6);
        }
        if (IN(PB + 7)) for (int rep_ = 0; rep_ < PROBE_REPS(7); ++rep_) {
            PH_BEGIN
            pg8::Gemm g{Y4, WBR, DM, BW, BW}; pg8::SchedBranch S{64, 8, G, bid}; pg8::EpiBranch E{P, ACCb};
            pg8::gemm_phase((LAS unsigned char*)shm, g, S, E);
            if (!lastl) { __syncthreads(); pg8::SchedTail S2{G, bid}; pg8::EpiPart E2{P, (float*)HSPEC}; pg8::gemm_phase((LAS unsigned char*)shm, g, S2, E2); }
            SEAM(PB + 7);
        }
        if (IN(PB + 8)) for (int rep_ = 0; rep_ < PROBE_REPS(8); ++rep_) {
            PH_BEGIN
            if (!lastl) {
                const float* PART = (const float*)HSPEC;
                for (int idx = bid * NTHR + tid; idx < (NTOK - NLAT) * DM / 8; idx += G * NTHR) { const size_t o = (size_t)idx * 8; f32x4 p[4][2];
#pragma unroll
                    for (int k = 0; k < 4; ++k) { p[k][0] = *(const f32x4*)(PART + (size_t)k * (NTOK - NLAT) * DM + o); p[k][1] = *(const f32x4*)(PART + (size_t)k * (NTOK - NLAT) * DM + o + 4); }
                    const f32x4 s0 = ((p[0][0] + p[1][0]) + p[2][0]) + p[3][0], s1 = ((p[0][1] + p[1][1]) + p[2][1]) + p[3][1];
                    u32x4 w; w.x = pk2(s0[0], s0[1]); w.y = pk2(s0[2], s0[3]); w.z = pk2(s1[0], s1[1]); w.w = pk2(s1[2], s1[3]);
                    *(u32x4*)(ACCb + (size_t)NLAT * DM + o) = w; }
                xcd_barrier(bar);
            }
            pg8::Gemm g{ACCb, WOUT, DM, DM, DM}; pg8::SchedStd S{64, 8, G, bid, DM, DM}; pg8::EpiResid E{XS, l == 0 ? x_in : (const float*)XS, l == 0 ? ctx_in - (size_t)NLAT * DM : (const float*)XS, MODl, 2};
            pg8::gemm_phase((LAS unsigned char*)shm, g, S, E);
            if (!lastl) { __syncthreads(); pg8::Gemm g2{ACCb, WOUT, DM, DM, 512}; pg8::SchedTailK S2{G, bid}; pg8::EpiPartK E2{(float*)HSPEC + (size_t)4 * (NTOK - NLAT) * DM}; pg8::gemm_phase((LAS unsigned char*)shm, g2, S2, E2); }
            SEAM(PB + 8);
        }
        if (IN(PB + 9)) for (int rep_ = 0; rep_ < PROBE_REPS(9); ++rep_) {
            PH_BEGIN
            if (!lastl) {
                const float* PART = (const float*)HSPEC + (size_t)4 * (NTOK - NLAT) * DM; const float* mg = MODl + (size_t)(4 * 6 + 2) * DM;
                const float* src = l == 0 ? ctx_in : (const float*)XS + (size_t)NLAT * DM;
                for (int idx = bid * NTHR + tid; idx < (NTOK - NLAT) * DM / 4; idx += G * NTHR) { const size_t o = (size_t)idx * 4; const int col = (int)(o & (DM - 1));
                    const f32x4 p0 = *(const f32x4*)(PART + o), p1 = *(const f32x4*)(PART + (size_t)(NTOK - NLAT) * DM + o), p2 = *(const f32x4*)(PART + (size_t)2 * (NTOK - NLAT) * DM + o), p3 = *(const f32x4*)(PART + (size_t)3 * (NTOK - NLAT) * DM + o);
                    const f32x4 sv = *(const f32x4*)(src + o), gm = *(const f32x4*)(mg + col);
                    *(f32x4*)(XS + (size_t)NLAT * DM + o) = sv + gm * (((p0 + p1) + p2) + p3); }
                xcd_barrier(bar);
            }
            for (int i = bid * NTHR + tid; i < NEXP * MOE_PAD; i += G * NTHR) ROWTOK[i] = -1;
            for (int i = bid * NTHR + tid; i < NTOK * 16; i += G * NTHR) INV[i] = -1;
            const float* wr = PT(42) + (size_t)l * DM * 16; const float* gn = norm_ffn + l * DM;
            for (int tok0 = (bid * 8 + wave) * 4; tok0 < M2; tok0 += G * 32) {
                const int r = tok0 < NLAT ? tok0 / SEQ : 4; const float* xr = XS + (size_t)tok0 * DM;
                const float* sh = MODl + (size_t)(r * 6 + 3) * DM; const float* sc = MODl + (size_t)(r * 6 + 4) * DM;
                float rs[4];
#pragma unroll
                for (int tk = 0; tk < 4; ++tk) { float ss = 0.f;
#pragma unroll 4
                    for (int i = 0; i < 8; ++i) { const float4 t4 = *(const float4*)(xr + (size_t)tk * DM + i * 256 + lane * 4); ss += t4.x * t4.x + t4.y * t4.y + t4.z * t4.z + t4.w * t4.w; }
                    ss = wave_sum(ss); rs[tk] = rsqrtf(ss * (1.0f / DM) + 1e-6f); }
                float lg[4][16];
#pragma unroll
                for (int tk = 0; tk < 4; ++tk)
#pragma unroll
                    for (int e = 0; e < 16; ++e) lg[tk][e] = 0.f;
#pragma unroll 1
                for (int i = 0; i < 8; ++i) { const int d = i * 256 + lane * 4;
                    const float4 g4 = *(const float4*)(gn + d), s4 = *(const float4*)(sc + d), h4 = *(const float4*)(sh + d);
                    float4 xq[4], ww[16];
#pragma unroll
                    for (int tk = 0; tk < 4; ++tk) xq[tk] = *(const float4*)(xr + (size_t)tk * DM + d);
                    const float4* wq = (const float4*)(wr + (size_t)d * 16);
#pragma unroll
                    for (int q = 0; q < 16; ++q) ww[q] = wq[q];
                    float hv[4][4];
#pragma unroll
                    for (int tk = 0; tk < 4; ++tk) { const float4 xv = xq[tk]; const float rr = rs[tk];
                        hv[tk][0] = xv.x * rr * g4.x * (1.f + s4.x) + h4.x; hv[tk][1] = xv.y * rr * g4.y * (1.f + s4.y) + h4.y; hv[tk][2] = xv.z * rr * g4.z * (1.f + s4.z) + h4.z; hv[tk][3] = xv.w * rr * g4.w * (1.f + s4.w) + h4.w;
                        u32x2 w; w.x = pk2(hv[tk][0], hv[tk][1]); w.y = pk2(hv[tk][2], hv[tk][3]); *(u32x2*)(HB + (size_t)(tok0 + tk) * DM + d) = w; }
#pragma unroll
                    for (int q = 0; q < 4; ++q) { const float4 w0 = ww[q * 4 + 0], w1 = ww[q * 4 + 1], w2 = ww[q * 4 + 2], w3 = ww[q * 4 + 3];
#pragma unroll
                        for (int tk = 0; tk < 4; ++tk) { const float hq = hv[tk][q];
                            lg[tk][0] += hq * w0.x; lg[tk][1] += hq * w0.y; lg[tk][2] += hq * w0.z; lg[tk][3] += hq * w0.w; lg[tk][4] += hq * w1.x; lg[tk][5] += hq * w1.y; lg[tk][6] += hq * w1.z; lg[tk][7] += hq * w1.w;
                            lg[tk][8] += hq * w2.x; lg[tk][9] += hq * w2.y; lg[tk][10] += hq * w2.z; lg[tk][11] += hq * w2.w; lg[tk][12] += hq * w3.x; lg[tk][13] += hq * w3.y; lg[tk][14] += hq * w3.z; lg[tk][15] += hq * w3.w; } } }
#pragma unroll
                for (int tk = 0; tk < 4; ++tk) { float mx = -1e30f;
#pragma unroll
                    for (int e = 0; e < 16; ++e) { lg[tk][e] = wave_sum(lg[tk][e]); mx = fmaxf(mx, lg[tk][e]); }
                    float sm = 0.f;
#pragma unroll
                    for (int e = 0; e < 16; ++e) { lg[tk][e] = expf(lg[tk][e] - mx); sm += lg[tk][e]; }
                    const float inv = 1.0f / sm;
                    if (lane == 0) {
#pragma unroll
                        for (int e = 0; e < 16; e += 4) *(float4*)(PROBS + (size_t)(tok0 + tk) * 16 + e) = make_float4(lg[tk][e] * inv, lg[tk][e + 1] * inv, lg[tk][e + 2] * inv, lg[tk][e + 3] * inv); } }
            }
            SEAM(PB + 9);
        }
        if (IN(PB + 10)) for (int rep_ = 0; rep_ < PROBE_REPS(10); ++rep_) {
            PH_BEGIN
            const int nitems = 64 + (lastl ? 0 : 64);
            unsigned long long* keys = (unsigned long long*)shm;
            for (int it = bid; it < nitems; it += G) {
                const int set = it >> 6, e = it & 15, b = (it >> 4) & 3;
                const int n = set ? CTXL : SEQ, cap = set ? 32 : 512, tokbase = set ? NLAT + b * CTXL : b * SEQ;
                __syncthreads();
                for (int i = tid; i < n; i += NTHR) keys[i] = ((unsigned long long)__float_as_uint(PROBS[(size_t)(tokbase + i) * 16 + e]) << 32) | (unsigned long long)(0xFFFFFFFFu - (unsigned)i);
                __syncthreads();
                for (int k = 2; k <= n; k <<= 1)
                    for (int j = k >> 1; j > 0; j >>= 1) {
                        for (int p = tid; p < (n >> 1); p += NTHR) { const int i = ((p & ~(j - 1)) << 1) | (p & (j - 1)); const int m = i | j;
                            const unsigned long long ka = keys[i], kb = keys[m]; const bool desc = ((i & k) == 0);
                            if ((ka < kb) == desc) { keys[i] = kb; keys[m] = ka; } }
                        __syncthreads();
                    }
                for (int r = tid; r < cap; r += NTHR) { const unsigned long long kk = keys[r]; const int row = e * MOE_PAD + (set ? 2048 + b * 32 + r : b * 512 + r);
                    const int tk_ = tokbase + (int)(0xFFFFFFFFu - (unsigned)(kk & 0xFFFFFFFFull)); ROWTOK[row] = tk_; ROWGATE[row] = __uint_as_float((unsigned)(kk >> 32)); INV[tk_ * 16 + e] = row; }
                for (int rb = 0; rb < cap; rb += 32) {
                    u32x4 t4[4][4];
#pragma unroll
                    for (int q = 0; q < 4; ++q) { const int r = rb + wave + 8 * q; const int tok = tokbase + (int)(0xFFFFFFFFu - (unsigned)(keys[r] & 0xFFFFFFFFull));
                        const u32x4* sp = (const u32x4*)(HB + (size_t)tok * DM);
#pragma unroll
                        for (int i = 0; i < 4; ++i) t4[q][i] = sp[i * 64 + lane]; }
#pragma unroll
                    for (int q = 0; q < 4; ++q) { const int r = rb + wave + 8 * q; const int row = e * MOE_PAD + (set ? 2048 + b * 32 + r : b * 512 + r);
                        u32x4* dp = (u32x4*)(XG + (size_t)row * DM);
#pragma unroll
                        for (int i = 0; i < 4; ++i) dp[i * 64 + lane] = t4[q][i]; } }
            }
            if (!lastl && G > 128 && bid >= 128) {
                const int n_win = 32 * 55, n_br = 4 * 64, n_out = 32 * 8, n_glu = 16, n_gu = 16 * 2 * 192; (void)n_gu;
                CV_RUN(l + 1, bid - 128, G - 128, n_win); (void)n_br; (void)n_out; (void)n_glu;
            }
            {   const int pad0 = lastl ? 2048 : MOE_ROWS, npad = MOE_PAD - pad0;
                for (int R = bid * 8 + wave; R < NEXP * npad; R += G * 8) { const int e = R / npad, rr = pad0 + R % npad; u32x4* dp = (u32x4*)(XG + ((size_t)e * MOE_PAD + rr) * DM);
#pragma unroll
                    for (int i = 0; i < 4; ++i) dp[i * 64 + lane] = (u32x4){0u, 0u, 0u, 0u}; } }
            SEAM(PB + 10);
        }
        if (IN(PB + 12)) for (int rep_ = 0; rep_ < PROBE_REPS(12); ++rep_) {
            PH_BEGIN
            pg8::Gemm g{XG, WGU, DM, DM, DM}; pg8::SchedMoe S{lastl ? 8 : 9, 12, G, bid, DM, DM, 2 * DEXP}; pg8::EpiMoe1 E{HID};
            pg8::gemm_phase((LAS unsigned char*)shm, g, S, E);
            SEAM(PB + 12);
        }
        if (IN(PB + 13)) for (int rep_ = 0; rep_ < PROBE_REPS(13); ++rep_) {
            PH_BEGIN
            pg8::Gemm g{HID, WD, DEXP, DEXP, DEXP}; pg8::SchedMoe S{lastl ? 8 : 9, 8, G, bid, DEXP, DEXP, DM}; pg8::EpiMoeY E{YEXP};
            pg8::gemm_phase((LAS unsigned char*)shm, g, S, E);
            SEAM(PB + 13);
        }

}

__global__ __launch_bounds__(NTHR, 2) void fwd(Args a) {
    extern __shared__ __attribute__((aligned(16))) unsigned char shm[];
    const int bid = blockIdx.x, G = gridDim.x;
    float* const sf = (float*)shm;
    volatile LAS unsigned* xbw = (volatile LAS unsigned*)((LAS unsigned char*)shm + (LDS_BYTES - 16));
    if (threadIdx.x == 0) { xbw[0] = 0u; xbw[1] = 0u; xbw[2] = 0u; xbw[3] = 0u; }
    const float** const ptab = (const float**)(shm + (LDS_BYTES - 16 - 512));
    if (threadIdx.x == 0) {
#pragma unroll
        for (int i = 0; i < 47; ++i) ptab[i] = a.in[i]; }
    __syncthreads();
    XcdBarrier bar = xcd_barrier_post((unsigned*)(a.ws + O_BAR), xbw);
    const int lo = a.ph_lo, hi = a.ph_hi;
    if (IN(0)) {
        PH_BEGIN
        {
            __syncthreads();
            for (int i = tid; i < 5 * DM; i += NTHR) { const int r = i >> 11, k = i & (DM - 1); const float v = r < 4 ? c_in[r * DM + k] : cctx_in[k]; sf[i] = siluf_(v); }
            __syncthreads();
            float* red = sf + 5 * DM;
            for (int unit = bid; unit < 2 * 96; unit += G) { const int l = unit / 96, j = (unit % 96) * 128 + (tid & 127), kq = tid >> 7;
                const float* w = ada_w + (size_t)l * DM * (6 * DM) + (size_t)(kq * 512) * (6 * DM) + j; const float* sv = sf + kq * 512;
                float a0 = 0.f, a1 = 0.f, a2 = 0.f, a3 = 0.f, a4 = 0.f;
#pragma unroll 8
                for (int k = 0; k < 512; ++k) { const float wv = w[(size_t)k * (6 * DM)]; a0 += sv[k] * wv; a1 += sv[DM + k] * wv; a2 += sv[2 * DM + k] * wv; a3 += sv[3 * DM + k] * wv; a4 += sv[4 * DM + k] * wv; }
                __syncthreads();
                { float* rp = red + (kq * 5) * 128 + (tid & 127); rp[0] = a0; rp[128] = a1; rp[256] = a2; rp[384] = a3; rp[512] = a4; }
                __syncthreads();
                if (tid < 128) { const float bb = ada_b[l * 6 * DM + j]; float* o = MOD + (size_t)l * 5 * 6 * DM + j;
#pragma unroll
                    for (int r = 0; r < 5; ++r) o[(size_t)r * 6 * DM] = ((red[(0 * 5 + r) * 128 + tid] + red[(1 * 5 + r) * 128 + tid]) + (red[(2 * 5 + r) * 128 + tid] + red[(3 * 5 + r) * 128 + tid])) + bb; }
            }
        }
    }

    layer_body<0>(a, bar, lo, hi, bid, G, shm, sf, ptab);
    layer_body<1>(a, bar, lo, hi, bid, G, shm, sf, ptab);
    if (IN(33)) {
        PH_BEGIN
        const float* gn = PT(46);
        for (int tok = bid * 8 + wave; tok < NLAT; tok += G * 8) {
            const float* xr = XS + (size_t)tok * DM; float4 v[8]; float ss = 0.f;
#pragma unroll
            for (int i = 0; i < 8; ++i) v[i] = *(const float4*)(xr + i * 256 + lane * 4);
            moe_combine(v, tok, lane, INV, ROWGATE, YEXP, MOD + (size_t)(1 * 5 + tok / SEQ) * 6 * DM + 5 * DM);
#pragma unroll
            for (int i = 0; i < 8; ++i) {                 ss += v[i].x * v[i].x + v[i].y * v[i].y + v[i].z * v[i].z + v[i].w * v[i].w; }
            ss = wave_sum(ss); const float rs = rsqrtf(ss * (1.0f / DM) + 1e-6f);
#pragma unroll
            for (int i = 0; i < 8; ++i) { const int d = i * 256 + lane * 4; const float4 g4 = *(const float4*)(gn + d);
                *(float4*)(a.out + (size_t)tok * DM + d) = make_float4(v[i].x * rs * g4.x, v[i].y * rs * g4.y, v[i].z * rs * g4.z, v[i].w * rs * g4.w); }
        }
    }
#undef IN
#undef SEAM
}


extern "C" void kernel_launch(void* const* d_in, const int* in_sizes, int n_in, void* d_out, int out_size, void* d_ws, size_t ws_size, hipStream_t stream) {
    static int grid = 0;
    if (grid == 0) {
        if (n_in != 47 || ws_size < WS_END) { fprintf(stderr, "kernel_launch: expected 47 inputs and >= %zu bytes of workspace; got %d, %zu\n", (size_t)WS_END, n_in, ws_size); grid = -1; return; }
        int dev = 0, cus = 0;
        if (hipGetDevice(&dev) != hipSuccess || hipDeviceGetAttribute(&cus, hipDeviceAttributeMultiprocessorCount, dev) != hipSuccess) { grid = -1; return; }
        if (hipFuncSetAttribute((const void*)fwd, hipFuncAttributeMaxDynamicSharedMemorySize, LDS_BYTES) != hipSuccess) { fprintf(stderr, "kernel_launch: hipFuncSetAttribute failed\n"); grid = -1; return; }
        int per_cu = 0;
        if (hipOccupancyMaxActiveBlocksPerMultiprocessor(&per_cu, (const void*)fwd, NTHR, LDS_BYTES) != hipSuccess || per_cu < 1) fprintf(stderr, "kernel_launch: occupancy query reports %d\n", per_cu);
        (void)hipGetLastError();
        grid = cus > 256 ? 256 : cus;
        if (grid < 224) { fprintf(stderr, "kernel_launch: needs >= 224 CUs (got %d)\n", grid); grid = -1; return; }
    }
    if (grid < 0) return;
    (void)hipMemsetAsync((char*)d_ws, 0, O_ZERO_END, stream);
    Args a{};
    for (int i = 0; i < 47; ++i) a.in[i] = (const float*)d_in[i];
    a.out = (float*)d_out; a.ws = (unsigned char*)d_ws;
#if MK_ONE_LAUNCH
    a.ph_lo = 0; a.ph_hi = 64;
    hipLaunchKernelGGL(fwd, dim3(grid), dim3(NTHR), LDS_BYTES, stream, a);
#else
    const int ids[] = {0, 1,2,3,4,5,6,7,8,9,10,11,12,13,14, 17,18,19,20,21,22,23,24,25,26,27,28,29,30, 33};
    for (int k = 0; k < (int)(sizeof(ids) / sizeof(ids[0])); ++k) { a.ph_lo = ids[k]; a.ph_hi = ids[k] + 1; hipLaunchKernelGGL(fwd, dim3(grid), dim3(NTHR), LDS_BYTES, stream, a); }
#endif
}
```

```cpp
#include <hip/hip_runtime.h>
#include <stdint.h>
#include <stdio.h>

#ifndef PROBE_MASK
#define PROBE_MASK 0
#endif
#ifndef PROBE_SP
#define PROBE_SP 1
#endif
#define PROBE_REPS(k) ((((PROBE_MASK) >> (k)) & 1) + 1)
#ifndef MK_ONE_LAUNCH
#define MK_ONE_LAUNCH 1
#endif

#define DM 2048
#define NB 4
#define SEQ 4096
#define CTXL 256
#define BW 512
#define NLAT 16384
#define NCTX 1024
#define NTOK 17408
#define IN_W 13856
#define LDP 14080
#define HY_OFF 0
#define ML_OFF 1536
#define S5_OFF 3600
#define SSD_OFF 4112
#define GATE_OFF 5664
#define NEXP 16
#define DEXP 1536
#define MOE_ROWS 2176
#define MOE_PAD 2304
#define NTHR 512
#define LDS_BYTES 147456
#define LAS __attribute__((address_space(3)))

typedef unsigned short bf16_t;
typedef short bf16x8 __attribute__((ext_vector_type(8)));
typedef float f32x4 __attribute__((ext_vector_type(4)));
typedef unsigned u32x4 __attribute__((ext_vector_type(4)));
typedef unsigned u32x2 __attribute__((ext_vector_type(2)));

#define XB_TMO      128
#define XB_XCNT(j)  (256  + 64 * (j))
#define XB_XSUB(j)  (1280 + 64 * (j))
#define XB_XGEN(j)  (2304 + 64 * (j))
#define XB_TOP      3328
#define XB_TOPGEN   3392
#define XCD_BAR_WORDS 3456
#define XB_SPIN_CAP (1u << 18)
__device__ __forceinline__ unsigned xb_ld(unsigned* p)              { return __hip_atomic_load(p, __ATOMIC_RELAXED, __HIP_MEMORY_SCOPE_AGENT); }
__device__ __forceinline__ unsigned xb_add(unsigned* p, unsigned v) { return __hip_atomic_fetch_add(p, v, __ATOMIC_RELAXED, __HIP_MEMORY_SCOPE_AGENT); }
__device__ __forceinline__ unsigned xb_xcc_id() { return (unsigned)__builtin_amdgcn_s_getreg((3 << 11) | 20) & 0xFu; }
#define XB_SPIN(cond, bar) do { unsigned _sp = 0; while (cond) { __builtin_amdgcn_s_sleep(1); \
    if ((++_sp & 255u) == 0u) { if (xb_ld(&(bar)[XB_TMO])) break; if (_sp > XB_SPIN_CAP) { atomicAdd(&(bar)[XB_TMO], 1u); break; } } } } while (0)
struct XcdBarrier { unsigned* bar; unsigned x; volatile LAS unsigned* st; };
__device__ __forceinline__ XcdBarrier xcd_barrier_post(unsigned* bar, volatile LAS unsigned* st) {
    XcdBarrier b; b.bar = bar; b.x = xb_xcc_id(); b.st = st;
    if (threadIdx.x == 0) (void)xb_add(&bar[XB_XCNT(b.x)], 1u);
    return b;
}
__device__ __forceinline__ void xcd_barrier_complete(unsigned* bar, unsigned x, unsigned& nloc, unsigned& nx) {
    const unsigned G = gridDim.x * gridDim.y * gridDim.z;
    unsigned sum, cnt, mine, sp = 0u;
    for (;;) {
        sum = 0u; cnt = 0u; mine = 0u;
#pragma unroll
        for (unsigned j = 0; j < 16; ++j) { const unsigned c = xb_ld(&bar[XB_XCNT(j)]); sum += c; cnt += (c > 0u) ? 1u : 0u; mine = (j == x) ? c : mine; }
        if (sum == G) break;
        __builtin_amdgcn_s_sleep(1);
        if ((++sp & 255u) == 0u) { if (xb_ld(&bar[XB_TMO])) break; if (sp > XB_SPIN_CAP) { atomicAdd(&bar[XB_TMO], 1u); break; } }
    }
    nloc = mine > 0u ? mine : 1u; nx = cnt > 0u ? cnt : 1u;
}
__device__ __forceinline__ void xcd_barrier(const XcdBarrier& b) {
    asm volatile("s_waitcnt vmcnt(0)" ::: "memory");
    __syncthreads();
    if (threadIdx.x == 0) {
        unsigned* bar = b.bar;
        __builtin_amdgcn_s_waitcnt(0);
        unsigned nloc = b.st[0], nx = b.st[1];
        if (nloc == 0u) { xcd_barrier_complete(bar, b.x, nloc, nx); b.st[0] = nloc; b.st[1] = nx; }
        const unsigned old = xb_add(&bar[XB_XSUB(b.x)], 1u);
        const unsigned gen = old / nloc;
        if (old + 1u == (gen + 1u) * nloc) {
            __builtin_amdgcn_fence(__ATOMIC_RELEASE, "agent");
            asm volatile("s_waitcnt vmcnt(0)" ::: "memory");
            const unsigned og = xb_add(&bar[XB_TOP], 1u);
            const unsigned tg = og / nx;
            if (og + 1u == (tg + 1u) * nx) xb_add(&bar[XB_TOPGEN], 1u);
            else XB_SPIN(xb_ld(&bar[XB_TOPGEN]) == tg, bar);
            __builtin_amdgcn_fence(__ATOMIC_ACQUIRE, "agent");
            xb_add(&bar[XB_XGEN(b.x)], 1u);
            asm volatile("s_waitcnt vmcnt(0)" ::: "memory");
        } else {
            XB_SPIN(xb_ld(&bar[XB_XGEN(b.x)]) == gen, bar);
            __builtin_amdgcn_fence(__ATOMIC_ACQUIRE, "agent");
            asm volatile("s_waitcnt vmcnt(0)" ::: "memory");
        }
    }
    __syncthreads();
}

__device__ __forceinline__ unsigned short f2bf(float f) { unsigned u = __float_as_uint(f); u += 0x7FFFu + ((u >> 16) & 1u); return (unsigned short)(u >> 16); }
__device__ __forceinline__ float bf2f(unsigned short b) { return __uint_as_float(((unsigned)b) << 16); }
__device__ __forceinline__ unsigned pk2(float lo, float hi) { unsigned r; asm("v_cvt_pk_bf16_f32 %0, %1, %2" : "=v"(r) : "v"(lo), "v"(hi)); return r; }
__device__ __forceinline__ float sigmoidf_(float x) { return 1.0f / (1.0f + expf(-x)); }
__device__ __forceinline__ float siluf_(float x) { return x / (1.0f + expf(-x)); }
__device__ __forceinline__ float wave_sum(float v) {
#pragma unroll
    for (int o = 32; o >= 1; o >>= 1) v += __shfl_xor(v, o);
    return v;
}
__device__ __forceinline__ const float* uptr(const float* p) { const unsigned long long v = (unsigned long long)p;
    const unsigned lo = __builtin_amdgcn_readfirstlane((unsigned)v), hi = __builtin_amdgcn_readfirstlane((unsigned)(v >> 32)); return (const float*)(((unsigned long long)hi << 32) | lo); }
#define PT(k) uptr(ptab[k])
__device__ __forceinline__ int step_tok(int b, int dir, int i) {
    if (i < CTXL) { const int tt = dir ? (CTXL - 1 - i) : i; return NLAT + b * CTXL + tt; }
    const int j = i - CTXL; const int tt = dir ? (SEQ - 1 - j) : j; return b * SEQ + tt;
}
__device__ __forceinline__ void unpack8(const u32x4 w, float (&f)[8]) {
    f[0] = __uint_as_float(w.x << 16); f[1] = __uint_as_float(w.x & 0xFFFF0000u); f[2] = __uint_as_float(w.y << 16); f[3] = __uint_as_float(w.y & 0xFFFF0000u);
    f[4] = __uint_as_float(w.z << 16); f[5] = __uint_as_float(w.z & 0xFFFF0000u); f[6] = __uint_as_float(w.w << 16); f[7] = __uint_as_float(w.w & 0xFFFF0000u);
}

namespace pg8 {
constexpr int BM = 256, BK = 64, HALF = 128, HTB = HALF * BK * 2, STAGE_BYTES = 8 * HTB, NXCD = 8, WGM = 8;
__host__ __device__ __forceinline__ int lds_byte(int r, int c) { const int st = (r >> 4) * 2 + (c >> 5), rr = r & 15, cc = c & 31, ob = rr * 64 + cc * 2; return st * 1024 + (ob ^ (((ob >> 9) & 1) << 5)); }
__host__ __device__ __forceinline__ void stage_rc(int b, int& R, int& C) { const int st = b / 1024, sb = b % 1024, swz = sb ^ (((sb >> 9) & 1) << 5); R = (st >> 1) * 16 + swz / 64; C = (st & 1) * 32 + (swz % 64) / 2; }
__host__ __device__ __forceinline__ int perm32(int rho) { const int n = rho >> 4, i = rho & 15; return 8 * (i >> 2) + 4 * n + (i & 3); }
struct Unit { int pm, pn, z, k; long long ao, bo; };
struct Gemm { const bf16_t* A; const bf16_t* Bt; int lda, ldb, K; };

__device__ __forceinline__ void tile_of(int wgid, int nM, int nN, int& pm, int& pn) {
    const int nwg = nM * nN; { const int q = nwg / NXCD, r = nwg % NXCD, xcd = wgid % NXCD, off = wgid / NXCD; wgid = (xcd < r ? xcd * (q + 1) : r * (q + 1) + (xcd - r) * q) + off; }
    const int nig = WGM * nN, gid = wgid / nig, fm = gid * WGM, gsz = (nM - fm) < WGM ? (nM - fm) : WGM;
    pm = fm + ((wgid % nig) % gsz); pn = (wgid % nig) / gsz;
}
struct SchedStd {
    int nM, nN, G, c, lda, ldb;
    __device__ __forceinline__ bool next(int i, Unit& u) const { const long L = (long)i * G + c; if (L >= (long)nM * nN) return false; tile_of((int)L, nM, nN, u.pm, u.pn); u.z = 0; u.k = 0;
        u.ao = (long long)u.pm * BM * lda * 2; u.bo = (long long)u.pn * BM * ldb * 2; return true; }
    __device__ __forceinline__ void a_ready(const Unit&) const {}
    __device__ __forceinline__ void done(const Unit&) const {}
};
struct SchedBranch {
    int nM, nN, G, c;
    __device__ __forceinline__ bool next(int i, Unit& u) const { const long L = (long)(i >> 2) * G + c; if (L >= (long)nM * nN) return false; tile_of((int)L, nM, nN, u.pm, u.pn); u.z = 0; u.k = i & 3;
        u.ao = ((long long)u.pm * BM * DM + u.k * BW) * 2; u.bo = ((long long)u.k * DM + u.pn * BM) * BW * 2; return true; }
    __device__ __forceinline__ void a_ready(const Unit&) const {}
    __device__ __forceinline__ void done(const Unit&) const {}
};
struct SchedTail {
    int G, c;
    __device__ __forceinline__ bool next(int i, Unit& u) const { const long T = (long)i * G + c; if (T >= 128) return false; const int t = (int)(T >> 2); u.pm = 64 + (t >> 3); u.pn = t & 7; u.z = 1; u.k = (int)(T & 3);
        u.ao = ((long long)u.pm * BM * DM + u.k * BW) * 2; u.bo = ((long long)u.k * DM + u.pn * BM) * BW * 2; return true; }
    __device__ __forceinline__ void a_ready(const Unit&) const {}
    __device__ __forceinline__ void done(const Unit&) const {}
};
struct SchedTailK {
    int G, c;
    __device__ __forceinline__ bool next(int i, Unit& u) const { const long T = (long)i * G + c; if (T >= 128) return false; const int t = (int)(T >> 2); u.pm = 64 + (t >> 3); u.pn = t & 7; u.z = 1; u.k = (int)(T & 3);
        u.ao = ((long long)u.pm * BM * DM + u.k * 512) * 2; u.bo = ((long long)u.pn * BM * DM + u.k * 512) * 2; return true; }
    __device__ __forceinline__ void a_ready(const Unit&) const {}
    __device__ __forceinline__ void done(const Unit&) const {}
};
struct SchedMoe {
    int nPm, nPn, G, c, lda, ldb, nBrows;
    __device__ __forceinline__ bool next(int i, Unit& u) const { const long L = (long)i * G + c; const int per = nPm * nPn; if (L >= (long)NEXP * per) return false; const int e = (int)(L / per), rem = (int)(L % per);
        u.z = e; u.k = 0; u.pm = rem % nPm; u.pn = rem / nPm; u.ao = ((long long)e * MOE_PAD + u.pm * BM) * lda * 2; u.bo = ((long long)e * nBrows + u.pn * BM) * ldb * 2; return true; }
    __device__ __forceinline__ void a_ready(const Unit&) const {}
    __device__ __forceinline__ void done(const Unit&) const {}
};

typedef f32x4 Acc[2][2][4][2];
template <class Epi, class Sched>
__device__ __forceinline__ void gemm_phase(LAS unsigned char* lds, const Gemm g, const Sched& S, const Epi& E) {
    int tid = threadIdx.x; asm volatile("" : "+v"(tid));
    const int wid = __builtin_amdgcn_readfirstlane(tid >> 6), lane = tid & 63, wr = wid >> 2, wc = wid & 3, fr = lane & 15, fq = lane >> 4;
    const int K = g.K, nt = K / BK;
    unsigned voffA[2], voffB[2];
#pragma unroll
    for (int i = 0; i < 2; ++i) { int R, C; stage_rc(tid * 16 + i * 8192, R, C); const int Rb = Epi::PERM ? ((R & ~31) + perm32(R & 31)) : R;
        voffA[i] = (unsigned)(R * g.lda + C) * 2u; voffB[i] = (unsigned)(Rb * g.ldb + C) * 2u; }
    const size_t kstep = (size_t)(BK * 2);
    const size_t hstepA = (size_t)HALF * g.lda * 2, hstepB = (size_t)HALF * g.ldb * 2;
    const unsigned ldsw = (unsigned)wid * 1024u;
    const int aoff = lds_byte(wr * 64 + fr, fq * 8), boff = lds_byte(wc * 32 + fr, fq * 8);
#define PG8_SA(b, h) (((b) * 2 + (h)) * HTB)
#define PG8_SB(b, h) ((4 + (b) * 2 + (h)) * HTB)
#define PG8_STAGE(bufoff, gbase, voff) do { _Pragma("unroll") for (int _i = 0; _i < 2; ++_i) \
        __builtin_amdgcn_global_load_lds((const unsigned*)((const char*)(gbase) + (voff)[_i]), (LAS unsigned*)(lds + (bufoff) + ldsw + _i * 8192), 16, 0, 0); } while (0)
#define PG8_LDA(dst, b, h) do { _Pragma("unroll") for (int m = 0; m < 4; ++m) _Pragma("unroll") for (int k = 0; k < 2; ++k) dst[m][k] = *(const LAS bf16x8*)(lds + PG8_SA(b, h) + aoff + m * 2048 + k * 1024); } while (0)
#define PG8_LDB(dst, b, h) do { _Pragma("unroll") for (int n = 0; n < 2; ++n) _Pragma("unroll") for (int k = 0; k < 2; ++k) dst[n][k] = *(const LAS bf16x8*)(lds + PG8_SB(b, h) + boff + n * 2048 + k * 1024); } while (0)
#define PG8_MMA(ai, bj, At, Bt) do { __builtin_amdgcn_s_setprio(1); _Pragma("unroll") for (int m = 0; m < 4; ++m) _Pragma("unroll") for (int n = 0; n < 2; ++n) _Pragma("unroll") for (int k = 0; k < 2; ++k) \
        acc[ai][bj][m][n] = __builtin_amdgcn_mfma_f32_16x16x32_bf16(Bt[n][k], At[m][k], acc[ai][bj][m][n], 0, 0, 0); __builtin_amdgcn_s_setprio(0); } while (0)
#define PG8_WAIT_V(n) asm volatile("s_waitcnt vmcnt(" #n ")" ::: "memory")
#define PG8_WAIT_L(n) asm volatile("s_waitcnt lgkmcnt(" #n ")" ::: "memory")
#define PG8_BAR __builtin_amdgcn_s_barrier()
#define PG8_SCHED __builtin_amdgcn_sched_barrier(0)
    Unit cur, nxt; int ui = 0;
    if (!S.next(0, cur)) return;
    Acc acc;
#pragma unroll
    for (int a = 0; a < 2; ++a)
#pragma unroll
        for (int b = 0; b < 2; ++b)
#pragma unroll
            for (int m = 0; m < 4; ++m)
#pragma unroll
                for (int n = 0; n < 2; ++n) acc[a][b][m][n] = (f32x4){0.f, 0.f, 0.f, 0.f};
    bf16x8 At[4][2], B0[2][2], B1[2][2];
    const char* cA = (const char*)g.A + cur.ao; const char* cB = (const char*)g.Bt + cur.bo;
    S.a_ready(cur);
    PG8_STAGE(PG8_SB(0, 0), cB, voffB); PG8_STAGE(PG8_SA(0, 0), cA, voffA); PG8_STAGE(PG8_SB(0, 1), cB + hstepB, voffB); PG8_STAGE(PG8_SA(0, 1), cA + hstepA, voffA);
    if (wr == 1) PG8_BAR;
    PG8_WAIT_V(4); PG8_BAR;
    PG8_STAGE(PG8_SB(1, 0), cB + kstep, voffB); PG8_STAGE(PG8_SA(1, 0), cA + kstep, voffA); PG8_STAGE(PG8_SB(1, 1), cB + hstepB + kstep, voffB);
    PG8_WAIT_V(6); PG8_BAR;
    for (;;) {
        const bool has_next = S.next(ui + 1, nxt);
        const char* nA = has_next ? (const char*)g.A + nxt.ao : cA; const char* nB = has_next ? (const char*)g.Bt + nxt.bo : cB;
        for (int t = 0; t < nt; t += 2) {
            const bool last = (t == nt - 2);
            const char* a1 = cA + (size_t)(t + 1) * kstep;
            const char* a2 = last ? nA : cA + (size_t)(t + 2) * kstep; const char* b2 = last ? nB : cB + (size_t)(t + 2) * kstep;
            const char* a3 = a2 + kstep; const char* b3 = b2 + kstep;
            if (last && has_next) S.a_ready(nxt);
            PG8_LDB(B0, 0, 0); PG8_SCHED; PG8_LDA(At, 0, 0); PG8_STAGE(PG8_SA(1, 1), a1 + hstepA, voffA);
            PG8_WAIT_L(8); PG8_BAR; PG8_WAIT_L(0); PG8_MMA(0, 0, At, B0); PG8_BAR; PG8_SCHED;
            PG8_LDB(B1, 0, 1); PG8_STAGE(PG8_SB(0, 0), b2, voffB);
            PG8_BAR; PG8_WAIT_L(0); PG8_MMA(0, 1, At, B1); PG8_BAR;
            PG8_LDA(At, 0, 1); PG8_STAGE(PG8_SA(0, 0), a2, voffA);
            PG8_BAR; PG8_WAIT_L(0); PG8_MMA(1, 0, At, B0); PG8_BAR; PG8_SCHED;
            PG8_STAGE(PG8_SB(0, 1), b2 + hstepB, voffB);
            PG8_WAIT_V(6); PG8_BAR; PG8_MMA(1, 1, At, B1); PG8_BAR;
            PG8_LDB(B0, 1, 0); PG8_SCHED; PG8_LDA(At, 1, 0); PG8_STAGE(PG8_SA(0, 1), a2 + hstepA, voffA);
            PG8_WAIT_L(8); PG8_BAR; PG8_WAIT_L(0); PG8_MMA(0, 0, At, B0); PG8_BAR; PG8_SCHED;
            PG8_LDB(B1, 1, 1); PG8_STAGE(PG8_SB(1, 0), b3, voffB);
            PG8_BAR; PG8_WAIT_L(0); PG8_MMA(0, 1, At, B1); PG8_BAR;
            PG8_LDA(At, 1, 1); PG8_STAGE(PG8_SA(1, 0), a3, voffA);
            PG8_BAR; PG8_WAIT_L(0); PG8_MMA(1, 0, At, B0); PG8_BAR; PG8_SCHED;
            PG8_STAGE(PG8_SB(1, 1), b3 + hstepB, voffB);
            PG8_WAIT_V(6); PG8_BAR; PG8_MMA(1, 1, At, B1); PG8_BAR;
        }
        const bool keep = E(acc, cur, wr, wc, fr, fq); S.done(cur);
        if (!has_next) break;
        if (!keep) {
#pragma unroll
        for (int a = 0; a < 2; ++a)
#pragma unroll
            for (int b = 0; b < 2; ++b)
#pragma unroll
                for (int m = 0; m < 4; ++m)
#pragma unroll
                    for (int n = 0; n < 2; ++n) acc[a][b][m][n] = (f32x4){0.f, 0.f, 0.f, 0.f};
        }
        cur = nxt; cA = nA; cB = nB; ++ui;
    }
    PG8_WAIT_V(0);
    if (wr == 0) PG8_BAR;
    PG8_BAR;
#undef PG8_SA
#undef PG8_SB
#undef PG8_STAGE
#undef PG8_LDA
#undef PG8_LDB
#undef PG8_MMA
#undef PG8_WAIT_V
#undef PG8_WAIT_L
#undef PG8_BAR
#undef PG8_SCHED
}

struct EpiBf16Store {
    static constexpr bool PERM = true;
    bf16_t* O; int ldc;
    __device__ __forceinline__ bool operator()(Acc& acc, const Unit& u, int wr, int wc, int fr, int fq) const {
        const int row0 = u.pm * BM + wr * 64 + fr, col0 = u.pn * BM + wc * 32 + 8 * fq;
#pragma unroll
        for (int ai = 0; ai < 2; ++ai)
#pragma unroll
            for (int m = 0; m < 4; ++m) { bf16_t* rowp = O + (size_t)(row0 + ai * HALF + m * 16) * ldc + col0;
#pragma unroll
                for (int bj = 0; bj < 2; ++bj) { const f32x4 v0 = acc[ai][bj][m][0], v1 = acc[ai][bj][m][1];
                    u32x4 w; w.x = pk2(v0[0], v0[1]); w.y = pk2(v0[2], v0[3]); w.z = pk2(v1[0], v1[1]); w.w = pk2(v1[2], v1[3]);
                    *(u32x4*)(rowp + bj * HALF) = w; } }
        return false;
    }
};
struct EpiWin {
    static constexpr bool PERM = true;
    bf16_t* O; int ldc;
    __device__ __forceinline__ bool operator()(Acc& acc, const Unit& u, int wr, int wc, int fr, int fq) const {
        const int row0 = u.pm * BM + wr * 64 + fr, col0 = u.pn * BM + wc * 32 + 8 * fq;
#pragma unroll
        for (int bj = 0; bj < 2; ++bj) { const bool gate = (col0 + bj * HALF) >= GATE_OFF;
#pragma unroll
            for (int ai = 0; ai < 2; ++ai)
#pragma unroll
                for (int m = 0; m < 4; ++m) { f32x4 v0 = acc[ai][bj][m][0], v1 = acc[ai][bj][m][1];
                    if (gate) {
#pragma unroll
                        for (int j = 0; j < 4; ++j) { v0[j] = __builtin_amdgcn_rcpf(1.0f + __expf(-v0[j])); v1[j] = __builtin_amdgcn_rcpf(1.0f + __expf(-v1[j])); } }
                    u32x4 w; w.x = pk2(v0[0], v0[1]); w.y = pk2(v0[2], v0[3]); w.z = pk2(v1[0], v1[1]); w.w = pk2(v1[2], v1[3]);
                    *(u32x4*)(O + (size_t)(row0 + ai * HALF + m * 16) * ldc + col0 + bj * HALF) = w; } }
        return false;
    }
};
struct EpiNone { static constexpr bool PERM = true;
    __device__ __forceinline__ bool operator()(Acc& acc, const Unit&, int, int, int, int) const {
#pragma unroll
        for (int a = 0; a < 2; ++a)
#pragma unroll
            for (int b = 0; b < 2; ++b)
#pragma unroll
                for (int m = 0; m < 4; ++m)
#pragma unroll
                    for (int n = 0; n < 2; ++n) asm volatile("" :: "v"(acc[a][b][m][n]));
        return false; } };
struct EpiGlu {
    static constexpr bool PERM = true;
    const bf16_t* GG; const float* bias; bf16_t* Y4;
    __device__ __forceinline__ bool operator()(Acc& acc, const Unit& u, int wr, int wc, int fr, int fq) const {
        const int row0 = u.pm * BM + wr * 64 + fr, col0 = u.pn * BM + wc * 32 + 8 * fq;
#pragma unroll
        for (int bj = 0; bj < 2; ++bj) { const int col = col0 + bj * HALF; const f32x4 b0 = *(const f32x4*)(bias + col), b1 = *(const f32x4*)(bias + col + 4);
            u32x4 gq[2][4];
#pragma unroll
            for (int ai = 0; ai < 2; ++ai)
#pragma unroll
                for (int m = 0; m < 4; ++m) gq[ai][m] = *(const u32x4*)(GG + (size_t)(row0 + ai * HALF + m * 16) * BW + col);
#pragma unroll
            for (int ai = 0; ai < 2; ++ai)
#pragma unroll
                for (int m = 0; m < 4; ++m) { const size_t row = (size_t)(row0 + ai * HALF + m * 16);
                    float gg[8]; unpack8(gq[ai][m], gg);
                    const f32x4 v0 = acc[ai][bj][m][0] + b0, v1 = acc[ai][bj][m][1] + b1;
                    u32x4 w; w.x = pk2(gg[0] * sigmoidf_(v0[0]), gg[1] * sigmoidf_(v0[1])); w.y = pk2(gg[2] * sigmoidf_(v0[2]), gg[3] * sigmoidf_(v0[3]));
                    w.z = pk2(gg[4] * sigmoidf_(v1[0]), gg[5] * sigmoidf_(v1[1])); w.w = pk2(gg[6] * sigmoidf_(v1[2]), gg[7] * sigmoidf_(v1[3]));
                    *(u32x4*)(Y4 + row * DM + 1024 + col) = w; } }
        return false;
    }
};
struct EpiBranch {
    static constexpr bool PERM = true;
    const bf16_t* P; bf16_t* ACCb;
    __device__ __forceinline__ bool operator()(Acc& acc, const Unit& u, int wr, int wc, int fr, int fq) const {
        const int row0 = u.pm * BM + wr * 64 + fr, col0 = u.pn * BM + wc * 32 + 8 * fq; const int k = u.k;
        const bf16_t* gbase = P + (size_t)row0 * LDP + GATE_OFF + k * DM + col0;
        if (k < 3) {
#pragma unroll
            for (int ai = 0; ai < 2; ++ai) {
                u32x4 ga[8], gb[8];
#pragma unroll
                for (int m = 0; m < 4; ++m)
#pragma unroll
                    for (int bj = 0; bj < 2; ++bj) { const bf16_t* p = gbase + (size_t)(ai * HALF + m * 16) * LDP + bj * HALF; ga[m * 2 + bj] = *(const u32x4*)p; gb[m * 2 + bj] = *(const u32x4*)(p + DM); }
#pragma unroll
                for (int m = 0; m < 4; ++m)
#pragma unroll
                    for (int bj = 0; bj < 2; ++bj) { float g0[8], g1[8]; unpack8(ga[m * 2 + bj], g0); unpack8(gb[m * 2 + bj], g1);
                        float s[8];
#pragma unroll
                        for (int j = 0; j < 8; ++j) s[j] = g0[j] * __builtin_amdgcn_rcpf(g1[j]);
                        f32x4 v0 = acc[ai][bj][m][0], v1 = acc[ai][bj][m][1];
                        v0[0] *= s[0]; v0[1] *= s[1]; v0[2] *= s[2]; v0[3] *= s[3]; v1[0] *= s[4]; v1[1] *= s[5]; v1[2] *= s[6]; v1[3] *= s[7];
                        acc[ai][bj][m][0] = v0; acc[ai][bj][m][1] = v1; } }
            return true;
        }
#pragma unroll
        for (int ai = 0; ai < 2; ++ai) {
            u32x4 ga[8];
#pragma unroll
            for (int m = 0; m < 4; ++m)
#pragma unroll
                for (int bj = 0; bj < 2; ++bj) ga[m * 2 + bj] = *(const u32x4*)(gbase + (size_t)(ai * HALF + m * 16) * LDP + bj * HALF);
#pragma unroll
            for (int m = 0; m < 4; ++m)
#pragma unroll
                for (int bj = 0; bj < 2; ++bj) { float s[8]; unpack8(ga[m * 2 + bj], s);
                    f32x4 v0 = acc[ai][bj][m][0], v1 = acc[ai][bj][m][1];
                    v0[0] *= s[0]; v0[1] *= s[1]; v0[2] *= s[2]; v0[3] *= s[3]; v1[0] *= s[4]; v1[1] *= s[5]; v1[2] *= s[6]; v1[3] *= s[7];
                    u32x4 w; w.x = pk2(v0[0], v0[1]); w.y = pk2(v0[2], v0[3]); w.z = pk2(v1[0], v1[1]); w.w = pk2(v1[2], v1[3]);
                    *(u32x4*)(ACCb + (size_t)(row0 + ai * HALF + m * 16) * DM + col0 + bj * HALF) = w; } }
        return false;
    }
};
struct EpiPart {
    static constexpr bool PERM = true;
    const bf16_t* P; float* PART;
    __device__ __forceinline__ bool operator()(Acc& acc, const Unit& u, int wr, int wc, int fr, int fq) const {
        const int row0 = u.pm * BM + wr * 64 + fr, col0 = u.pn * BM + wc * 32 + 8 * fq; const int k = u.k;
        const bf16_t* gbase = P + (size_t)row0 * LDP + GATE_OFF + k * DM + col0;
        float* pbase = PART + ((size_t)k * (NTOK - NLAT) + (size_t)(row0 - NLAT)) * DM + col0;
#pragma unroll
        for (int ai = 0; ai < 2; ++ai) {
            u32x4 ga[8];
#pragma unroll
            for (int m = 0; m < 4; ++m)
#pragma unroll
                for (int bj = 0; bj < 2; ++bj) ga[m * 2 + bj] = *(const u32x4*)(gbase + (size_t)(ai * HALF + m * 16) * LDP + bj * HALF);
#pragma unroll
            for (int m = 0; m < 4; ++m)
#pragma unroll
                for (int bj = 0; bj < 2; ++bj) { float sg[8]; unpack8(ga[m * 2 + bj], sg);
                    f32x4 v0 = acc[ai][bj][m][0], v1 = acc[ai][bj][m][1];
                    v0[0] *= sg[0]; v0[1] *= sg[1]; v0[2] *= sg[2]; v0[3] *= sg[3]; v1[0] *= sg[4]; v1[1] *= sg[5]; v1[2] *= sg[6]; v1[3] *= sg[7];
                    float* pp = pbase + (size_t)(ai * HALF + m * 16) * DM + bj * HALF;
                    *(f32x4*)pp = v0; *(f32x4*)(pp + 4) = v1; } }
        return false;
    }
};
struct EpiPartK {
    static constexpr bool PERM = true;
    float* PART;
    __device__ __forceinline__ bool operator()(Acc& acc, const Unit& u, int wr, int wc, int fr, int fq) const {
        const int row0 = u.pm * BM + wr * 64 + fr, col0 = u.pn * BM + wc * 32 + 8 * fq;
        float* pbase = PART + ((size_t)u.k * (NTOK - NLAT) + (size_t)(row0 - NLAT)) * DM + col0;
#pragma unroll
        for (int ai = 0; ai < 2; ++ai)
#pragma unroll
            for (int m = 0; m < 4; ++m)
#pragma unroll
                for (int bj = 0; bj < 2; ++bj) { float* pp = pbase + (size_t)(ai * HALF + m * 16) * DM + bj * HALF; *(f32x4*)pp = acc[ai][bj][m][0]; *(f32x4*)(pp + 4) = acc[ai][bj][m][1]; }
        return false;
    }
};
struct EpiResid {
    static constexpr bool PERM = false;
    float* XS; const float* srcLat; const float* srcCtx; const float* MODl; int gidx;
    __device__ __forceinline__ bool operator()(Acc& acc, const Unit& u, int wr, int wc, int fr, int fq) const {
        const int row0 = u.pm * BM + wr * 64 + fr, col0 = u.pn * BM + wc * 32 + 4 * fq;
        const int r = (u.pm * BM) < NLAT ? (u.pm * BM) / SEQ : 4;
        const float* src = (u.pm * BM) < NLAT ? srcLat : srcCtx;
        const float* mg = MODl + (size_t)(r * 6 + gidx) * DM;
#pragma unroll
        for (int bj = 0; bj < 2; ++bj) {
            f32x4 gm[2], xs[2][2][4];
#pragma unroll
            for (int n = 0; n < 2; ++n) { const int col = col0 + bj * HALF + n * 16; gm[n] = *(const f32x4*)(mg + col);
#pragma unroll
                for (int ai = 0; ai < 2; ++ai)
#pragma unroll
                    for (int m = 0; m < 4; ++m) xs[n][ai][m] = *(const f32x4*)(src + (size_t)(row0 + ai * HALF + m * 16) * DM + col); }
#pragma unroll
            for (int n = 0; n < 2; ++n) { const int col = col0 + bj * HALF + n * 16;
#pragma unroll
                for (int ai = 0; ai < 2; ++ai)
#pragma unroll
                    for (int m = 0; m < 4; ++m) *(f32x4*)(XS + (size_t)(row0 + ai * HALF + m * 16) * DM + col) = xs[n][ai][m] + gm[n] * acc[ai][bj][m][n]; } }
        return false;
    }
};
struct EpiMoe1 {
    static constexpr bool PERM = true;
    bf16_t* HID;
    __device__ __forceinline__ bool operator()(Acc& acc, const Unit& u, int wr, int wc, int fr, int fq) const {
        const size_t row0 = (size_t)u.z * MOE_PAD + u.pm * BM + wr * 64 + fr; const int col0 = u.pn * HALF + wc * 32 + 8 * fq;
#pragma unroll
        for (int ai = 0; ai < 2; ++ai)
#pragma unroll
            for (int m = 0; m < 4; ++m) { const f32x4 g0 = acc[ai][0][m][0], g1 = acc[ai][0][m][1], u0 = acc[ai][1][m][0], u1 = acc[ai][1][m][1];
                float h[8];
#pragma unroll
                for (int j = 0; j < 4; ++j) { h[j] = g0[j] * __builtin_amdgcn_rcpf(1.0f + __expf(-g0[j])) * u0[j]; h[4 + j] = g1[j] * __builtin_amdgcn_rcpf(1.0f + __expf(-g1[j])) * u1[j]; }
                u32x4 w; w.x = pk2(h[0], h[1]); w.y = pk2(h[2], h[3]); w.z = pk2(h[4], h[5]); w.w = pk2(h[6], h[7]);
                *(u32x4*)(HID + (row0 + ai * HALF + m * 16) * DEXP + col0) = w; }
        return false;
    }
};
struct EpiMoeY {
    static constexpr bool PERM = true;
    bf16_t* O;
    __device__ __forceinline__ bool operator()(Acc& acc, const Unit& u, int wr, int wc, int fr, int fq) const {
        const size_t row0 = (size_t)u.z * MOE_PAD + u.pm * BM + wr * 64 + fr; const int col0 = u.pn * BM + wc * 32 + 8 * fq;
#pragma unroll
        for (int ai = 0; ai < 2; ++ai)
#pragma unroll
            for (int m = 0; m < 4; ++m) { bf16_t* rowp = O + (row0 + ai * HALF + m * 16) * DM + col0;
#pragma unroll
                for (int bj = 0; bj < 2; ++bj) { const f32x4 v0 = acc[ai][bj][m][0], v1 = acc[ai][bj][m][1];
                    u32x4 w; w.x = pk2(v0[0], v0[1]); w.y = pk2(v0[2], v0[3]); w.z = pk2(v1[0], v1[1]); w.w = pk2(v1[2], v1[3]);
                    *(u32x4*)(rowp + bj * HALF) = w; } }
        return false;
    }
};

struct SchedS5a {
    int c;
    __device__ __forceinline__ bool next(int i, Unit& u) const { if (i > 0 || c >= 64) return false; u.z = c >> 1; u.pm = c & 1; u.pn = 0; u.k = 0;
        u.ao = ((long long)u.z * 512 + u.pm * BM) * 768 * 2; u.bo = (long long)u.z * 256 * 512 * 2; return true; }
    __device__ __forceinline__ void a_ready(const Unit&) const {}
    __device__ __forceinline__ void done(const Unit&) const {}
};
struct SchedS5b {
    int c;
    __device__ __forceinline__ bool next(int i, Unit& u) const { if (i > 0 || c >= 128) return false; u.z = c >> 2; u.pm = (c >> 1) & 1; u.pn = c & 1; u.k = 0;
        u.ao = ((long long)u.z * 512 + u.pm * BM) * 768 * 2; u.bo = ((long long)u.z * 512 + u.pn * BM) * 768 * 2; return true; }
    __device__ __forceinline__ void a_ready(const Unit&) const {}
    __device__ __forceinline__ void done(const Unit&) const {}
};
struct EpiXloc {
    static constexpr bool PERM = false;
    float* XL;
    __device__ __forceinline__ bool operator()(Acc& acc, const Unit& u, int wr, int wc, int fr, int fq) const {
        const int row0 = u.pm * BM + wr * 64 + fr, col0 = wc * 32 + 4 * fq; float* base = XL + (size_t)u.z * 512 * 256;
#pragma unroll
        for (int ai = 0; ai < 2; ++ai)
#pragma unroll
            for (int m = 0; m < 4; ++m) { float* rowp = base + (size_t)(row0 + ai * HALF + m * 16) * 256 + col0;
#pragma unroll
                for (int bj = 0; bj < 2; ++bj)
#pragma unroll
                    for (int n = 0; n < 2; ++n) *(f32x4*)(rowp + bj * HALF + n * 16) = acc[ai][bj][m][n]; }
        return false;
    }
};
struct EpiS5Out {
    static constexpr bool PERM = true;
    const bf16_t* P; const float* dskip; bf16_t* GG;
    __device__ __forceinline__ bool operator()(Acc& acc, const Unit& u, int wr, int wc, int fr, int fq) const {
        const int row0 = u.pm * BM + wr * 64 + fr, col0 = u.pn * BM + wc * 32 + 8 * fq; const int g = u.z;
#pragma unroll
        for (int bj = 0; bj < 2; ++bj) { const int col = col0 + bj * HALF; const int t = col >> 4, c0 = col & 15;
            const f32x4 d0 = *(const f32x4*)(dskip + g * 16 + c0), d1 = *(const f32x4*)(dskip + g * 16 + c0 + 4);
            u32x4 uq[2][4];
#pragma unroll
            for (int ai = 0; ai < 2; ++ai)
#pragma unroll
                for (int m = 0; m < 4; ++m) uq[ai][m] = *(const u32x4*)(P + ((size_t)(row0 + ai * HALF + m * 16) * 32 + t) * LDP + S5_OFF + g * 16 + c0);
#pragma unroll
            for (int ai = 0; ai < 2; ++ai)
#pragma unroll
                for (int m = 0; m < 4; ++m) { const size_t tok = (size_t)(row0 + ai * HALF + m * 16) * 32 + t;
                    float uu[8]; unpack8(uq[ai][m], uu);
                    const f32x4 v0 = acc[ai][bj][m][0], v1 = acc[ai][bj][m][1];
                    float y[8] = {v0[0] + d0[0] * uu[0], v0[1] + d0[1] * uu[1], v0[2] + d0[2] * uu[2], v0[3] + d0[3] * uu[3], v1[0] + d1[0] * uu[4], v1[1] + d1[1] * uu[5], v1[2] + d1[2] * uu[6], v1[3] + d1[3] * uu[7]};
#pragma unroll
                    for (int j = 0; j < 8; ++j) y[j] = 0.5f * y[j] * (1.0f + tanhf(0.7978845608028654f * (y[j] + 0.044715f * y[j] * y[j] * y[j])));
                    u32x4 w; w.x = pk2(y[0], y[1]); w.y = pk2(y[2], y[3]); w.z = pk2(y[4], y[5]); w.w = pk2(y[6], y[7]);
                    *(u32x4*)(GG + tok * BW + g * 16 + c0) = w; } }
        return false;
    }
};
}


__device__ __forceinline__ float wave_scan_incl(float v, int lane) {
#pragma unroll
    for (int o = 1; o < 64; o <<= 1) { const float t = __shfl_up(v, o); if (lane >= o) v += t; }
    return v;
}
__device__ __forceinline__ float wave_scanmax_incl(float v, int lane) {
#pragma unroll
    for (int o = 1; o < 64; o <<= 1) { const float t = __shfl_up(v, o); if (lane >= o) v = fmaxf(v, t); }
    return v;
}
__device__ __forceinline__ float wave_max(float v) {
#pragma unroll
    for (int o = 32; o >= 1; o >>= 1) v = fmaxf(v, __shfl_xor(v, o));
    return v;
}
__device__ __forceinline__ void unpack8h(const u32x4 w, bf16_t (&h)[8]) {
    h[0] = (bf16_t)(w.x & 0xFFFFu); h[1] = (bf16_t)(w.x >> 16); h[2] = (bf16_t)(w.y & 0xFFFFu); h[3] = (bf16_t)(w.y >> 16);
    h[4] = (bf16_t)(w.z & 0xFFFFu); h[5] = (bf16_t)(w.z >> 16); h[6] = (bf16_t)(w.w & 0xFFFFu); h[7] = (bf16_t)(w.w >> 16);
}

__device__ __forceinline__ int tokblock_of(int b, int dir, int c) { if (c < 4) return 256 + b * 4 + (dir ? 3 - c : c); const int j = c - 4; return b * 64 + (dir ? 63 - j : j); }
__device__ __forceinline__ u32x4 rev8h(const u32x4 v) { u32x4 r; r.x = (v.w >> 16) | (v.w << 16); r.y = (v.z >> 16) | (v.z << 16); r.z = (v.y >> 16) | (v.y << 16); r.w = (v.x >> 16) | (v.x << 16); return r; }
__device__ __forceinline__ u32x4 scale8h(const u32x4 v, const float4 a, const float4 b) { float f[8]; unpack8(v, f); u32x4 r; r.x = pk2(f[0] * a.x, f[1] * a.y); r.y = pk2(f[2] * a.z, f[3] * a.w); r.z = pk2(f[4] * b.x, f[5] * b.y); r.w = pk2(f[6] * b.z, f[7] * b.w); return r; }
__device__ __forceinline__ float dot8h(const u32x4 v, const float4 a, const float4 b) { float f[8]; unpack8(v, f); return (f[0] * a.x + f[1] * a.y) + (f[2] * a.z + f[3] * a.w) + (f[4] * b.x + f[5] * b.y) + (f[6] * b.z + f[7] * b.w); }
#define ML_FRAG_LOAD(KF, VF, cc_) do { const int tb_ = tokblock_of(b, dir, (cc_)); const bf16_t* kb_ = KTg + ((size_t)tb_ * 512 + h * 128 + 32 * wd + r16) * 64 + q4 * 8; const bf16_t* vb_ = VTg + ((size_t)tb_ * 512 + h * 128 + 64 * half + 32 * we + r16) * 64 + q4 * 8; \
        _Pragma("unroll") for (int ks_ = 0; ks_ < 2; ++ks_) _Pragma("unroll") for (int j_ = 0; j_ < 2; ++j_) { VF[j_][ks_] = *(const u32x4*)(vb_ + (size_t)j_ * 16 * 64 + ks_ * 32); KF[j_][ks_] = *(const u32x4*)(kb_ + (size_t)j_ * 16 * 64 + ks_ * 32); } } while (0)
#define ML_CHUNK(c_, KF, VF, KFN, VFN) do { const int c = (c_); \
        if (c + 1 < 68) ML_FRAG_LOAD(KFN, VFN, c + 1);                        \
        const float dec = sDEC[c]; \
        {   bf16_t* cs = CST + (size_t)(chain * 68 + c) * 128 * 128; \
            _Pragma("unroll") for (int je = 0; je < 2; ++je) _Pragma("unroll") for (int jd = 0; jd < 2; ++jd) { const int e = 64 * half + 32 * we + 16 * je + r16, d0 = 32 * wd + 16 * jd + q4 * 4; \
                u32x2 pk; pk.x = pk2(acc[je][jd][0], acc[je][jd][1]); pk.y = pk2(acc[je][jd][2], acc[je][jd][3]); *(u32x2*)(cs + (size_t)e * 128 + d0) = pk; } \
            if (nown) { _Pragma("unroll") for (int jd = 0; jd < 2; ++jd) { float nv = npart[jd]; nv += __shfl_xor(nv, 16); nv += __shfl_xor(nv, 32); if (q4 == 0) NST[(size_t)(chain * 68 + c) * 128 + 32 * wd + 16 * jd + r16] = nv; } } } \
        bf16x8 vfr[2][2]; \
        _Pragma("unroll") for (int ks = 0; ks < 2; ++ks) { const float4 wa = *(const float4*)(sWS + c * 64 + ks * 32 + q4 * 8), wb = *(const float4*)(sWS + c * 64 + ks * 32 + q4 * 8 + 4); \
            _Pragma("unroll") for (int je = 0; je < 2; ++je) { const u32x4 sv = scale8h(VF[je][ks], wa, wb); vfr[je][ks] = *(const bf16x8*)&sv; } \
            if (nown) { _Pragma("unroll") for (int jd = 0; jd < 2; ++jd) npart[jd] = (ks == 0 ? dec * npart[jd] : npart[jd]) + dot8h(KF[jd][ks], wa, wb); } } \
        _Pragma("unroll") for (int je = 0; je < 2; ++je) _Pragma("unroll") for (int jd = 0; jd < 2; ++jd) acc[je][jd] = acc[je][jd] * dec; \
        _Pragma("unroll") for (int ks = 0; ks < 2; ++ks) _Pragma("unroll") for (int je = 0; je < 2; ++je) _Pragma("unroll") for (int jd = 0; jd < 2; ++jd) \
            acc[je][jd] = __builtin_amdgcn_mfma_f32_16x16x32_bf16(*(const bf16x8*)&KF[jd][ks], vfr[je][ks], acc[je][jd], 0, 0, 0); } while (0)
__device__ __forceinline__ void mlstm_state_pass(const int chain, const int half, const bf16_t* __restrict__ Pm, const bf16_t* __restrict__ KTg, const bf16_t* __restrict__ VTg, const float* __restrict__ gate_b,
                                                 bf16_t* __restrict__ CST, float* __restrict__ NST, float* __restrict__ MST, unsigned char* shm, const int tid) {
    const int dir = chain & 1, h = (chain >> 1) & 3, b = chain >> 3, lane = tid & 63, w = tid >> 6, we = w >> 2, wd = w & 3, q4 = lane >> 4, r16 = lane & 15;
    const bool nown = (half == 0) && (we == 0);
    float* sE = (float*)shm; float* sWS = sE + 68 * 64; float* sAL = sWS + 68 * 64; float* sBE = sAL + 68; float* sMO = sBE + 68; float* sDEC = sMO + 68; float* sMB = sDEC + 68;
    const float gbi = gate_b[(dir * 2 + 0) * 4 + h], gbf = gate_b[(dir * 2 + 1) * 4 + h];
    const int gcol_i = ML_OFF + 2048 + (dir * 2 + 0) * 4 + h, gcol_f = ML_OFF + 2048 + (dir * 2 + 1) * 4 + h;
    u32x4 kfA[2][2], vfA[2][2], kfB[2][2], vfB[2][2];
    ML_FRAG_LOAD(kfA, vfA, 0);
    __syncthreads();
    unsigned gi_[9], gf_[9];
#pragma unroll
    for (int q = 0; q < 9; ++q) { const int c = min(w + 8 * q, 67); const size_t tokl = (size_t)step_tok(b, dir, c * 64 + lane); gi_[q] = Pm[tokl * LDP + gcol_i]; gf_[q] = Pm[tokl * LDP + gcol_f]; }
#pragma unroll
    for (int q = 0; q < 9; ++q) { const int c = w + 8 * q; if (c >= 68) break;
        const float ig = __uint_as_float(gi_[q] << 16) + gbi, fg = __uint_as_float(gf_[q] << 16) + gbf;
        const float lf = fminf(fg, 0.f) - log1pf(expf(-fabsf(fg)));
        const float bcs = wave_scan_incl(lf, lane); const float blast = __shfl(bcs, 63); const float ei = blast - bcs + ig; const float beta = wave_max(ei);
        sE[c * 64 + lane] = ei; if (lane == 0) { sAL[c] = blast; sBE[c] = beta; } }
    __syncthreads();
    if (tid == 0) { float m = 0.f; for (int c = 0; c < 68; ++c) { sMB[c] = m; const float mo = fmaxf(m + sAL[c], sBE[c]); sDEC[c] = expf(sAL[c] + m - mo); sMO[c] = mo; m = mo; } }
    __syncthreads();
    for (int idx = tid; idx < 68 * 64; idx += NTHR) { const int c = idx >> 6, i = idx & 63; sWS[c * 64 + (dir ? 63 - i : i)] = expf(sE[idx] - sMO[c]); }
    if (half == 0 && tid < 68) MST[chain * 68 + tid] = sMB[tid];
    __syncthreads();
    f32x4 acc[2][2];
#pragma unroll
    for (int je = 0; je < 2; ++je)
#pragma unroll
        for (int jd = 0; jd < 2; ++jd) acc[je][jd] = (f32x4){0.f, 0.f, 0.f, 0.f};
    float npart[2] = {0.f, 0.f};
    for (int c2 = 0; c2 < 68; c2 += 2) { ML_CHUNK(c2, kfA, vfA, kfB, vfB); ML_CHUNK(c2 + 1, kfB, vfB, kfA, vfA); }
    __syncthreads();
}
#undef ML_CHUNK
#undef ML_FRAG_LOAD
__device__ __forceinline__ void mlstm_out_item(const int chain, const int c, const bf16_t* __restrict__ Pm, const bf16_t* __restrict__ QKb, const bf16_t* __restrict__ VTg, const float* __restrict__ gate_b,
                                               const bf16_t* __restrict__ CST, const float* __restrict__ NST, const float* __restrict__ MST, bf16_t* __restrict__ Hout, unsigned char* shm, const int tid) {
    const int dir = chain & 1, h = (chain >> 1) & 3, b = chain >> 3, lane = tid & 63, w = tid >> 6;
    bf16_t* Qs = (bf16_t*)shm; bf16_t* Ks = (bf16_t*)(shm + 17408); bf16_t* VT = (bf16_t*)(shm + 34816); bf16_t* Cs = (bf16_t*)(shm + 53248); bf16_t* Ss = (bf16_t*)(shm + 88064);
    float* sc = (float*)(shm + 97280);
    __syncthreads();
    u32x4 gq[2], gk[2], gv[2], gc[4]; float gn = 0.f;
#pragma unroll
    for (int i = 0; i < 2; ++i) { const int pid = tid + i * 512; const int s = pid >> 4, x0 = (pid & 15) * 8; const size_t toks = (size_t)step_tok(b, dir, c * 64 + s);
        gq[i] = *(const u32x4*)(QKb + toks * 1024 + h * 128 + x0);
        gk[i] = *(const u32x4*)(QKb + toks * 1024 + 512 + h * 128 + x0);
        { const int e = pid >> 3, o = pid & 7;
          gv[i] = *(const u32x4*)(VTg + ((size_t)tokblock_of(b, dir, c) * 512 + h * 128 + e) * 64 + (dir ? 7 - o : o) * 8); } }
#pragma unroll
    for (int i = 0; i < 4; ++i) { const int pid = tid + i * 512; const int e = pid >> 4, x0 = (pid & 15) * 8;
        gc[i] = *(const u32x4*)(CST + ((size_t)(chain * 68 + c) * 128 + e) * 128 + x0); }
    if (tid < 128) gn = NST[(size_t)(chain * 68 + c) * 128 + tid];
    unsigned gi_ = 0u, gf_ = 0u; float gbi = 0.f, gbf = 0.f, m_in = 0.f;
    if (w == 0) { const size_t tokl = (size_t)step_tok(b, dir, c * 64 + lane);
        gi_ = Pm[tokl * LDP + ML_OFF + 2048 + (dir * 2 + 0) * 4 + h]; gf_ = Pm[tokl * LDP + ML_OFF + 2048 + (dir * 2 + 1) * 4 + h];
        gbi = gate_b[(dir * 2 + 0) * 4 + h]; gbf = gate_b[(dir * 2 + 1) * 4 + h]; m_in = MST[chain * 68 + c]; }
#pragma unroll
    for (int i = 0; i < 2; ++i) { const int pid = tid + i * 512; const int s = pid >> 4, x0 = (pid & 15) * 8;
        *(u32x4*)(Qs + s * 136 + x0) = gq[i]; *(u32x4*)(Ks + s * 136 + x0) = gk[i];
        { const int e = pid >> 3, o = pid & 7; *(u32x4*)(VT + e * 72 + o * 8) = dir ? rev8h(gv[i]) : gv[i]; } }
#pragma unroll
    for (int i = 0; i < 4; ++i) { const int pid = tid + i * 512; const int e = pid >> 4, x0 = (pid & 15) * 8; *(u32x4*)(Cs + e * 136 + x0) = gc[i]; }
    if (tid < 128) sc[384 + tid] = gn;
    if (w == 0) {
        const float ig = __uint_as_float(gi_ << 16) + gbi;
        const float fg = __uint_as_float(gf_ << 16) + gbf;
        const float lf = fminf(fg, 0.f) - log1pf(expf(-fabsf(fg)));
        const float bcs = wave_scan_incl(lf, lane); const float gsv = ig - bcs; const float pm = wave_scanmax_incl(gsv, lane);
        const float mt = bcs + fmaxf(m_in, pm);
        sc[lane] = bcs; sc[64 + lane] = gsv; sc[128 + lane] = mt; sc[192 + lane] = expf(bcs + m_in - mt); sc[256 + lane] = expf(-mt);
    }
    __syncthreads();
    const int tt = w >> 1;
    {   f32x4 aS[2] = {(f32x4){0.f, 0.f, 0.f, 0.f}, (f32x4){0.f, 0.f, 0.f, 0.f}};
#pragma unroll
        for (int ks = 0; ks < 4; ++ks) { const bf16x8 af = *(const bf16x8*)(Qs + (16 * tt + (lane & 15)) * 136 + ks * 32 + (lane >> 4) * 8);
#pragma unroll
            for (int i = 0; i < 2; ++i) { const int st = (w & 1) * 2 + i; const bf16x8 bfr = *(const bf16x8*)(Ks + (16 * st + (lane & 15)) * 136 + ks * 32 + (lane >> 4) * 8);
                aS[i] = __builtin_amdgcn_mfma_f32_16x16x32_bf16(af, bfr, aS[i], 0, 0, 0); } }
        float rs[4] = {0.f, 0.f, 0.f, 0.f};
#pragma unroll
        for (int i = 0; i < 2; ++i) { const int s = 16 * ((w & 1) * 2 + i) + (lane & 15); const float gsv = sc[64 + s];
#pragma unroll
            for (int q = 0; q < 4; ++q) { const int t = 16 * tt + (lane >> 4) * 4 + q; const float val = (s <= t) ? aS[i][q] * expf(sc[t] + gsv - sc[128 + t]) : 0.f; Ss[t * 72 + s] = f2bf(val); rs[q] += val; } }
#pragma unroll
        for (int q = 0; q < 4; ++q) { float r = rs[q]; r += __shfl_xor(r, 1); r += __shfl_xor(r, 2); r += __shfl_xor(r, 4); r += __shfl_xor(r, 8);
            if ((lane & 15) == 0) sc[512 + (w & 1) * 64 + 16 * tt + (lane >> 4) * 4 + q] = r; }
        {   const int t = tid >> 3, part = tid & 7; float dot = 0.f;
#pragma unroll
            for (int j = 0; j < 16; ++j) dot += bf2f(Qs[t * 136 + part * 16 + j]) * sc[384 + part * 16 + j];
            dot += __shfl_xor(dot, 1); dot += __shfl_xor(dot, 2); dot += __shfl_xor(dot, 4);
            if (part == 0) sc[640 + t] = sc[192 + t] * dot; }
    }
    __syncthreads();
    {   f32x4 aN[4];
#pragma unroll
        for (int i = 0; i < 4; ++i) aN[i] = (f32x4){0.f, 0.f, 0.f, 0.f};
#pragma unroll
        for (int ks = 0; ks < 4; ++ks) { const bf16x8 af = *(const bf16x8*)(Qs + (16 * tt + (lane & 15)) * 136 + ks * 32 + (lane >> 4) * 8);
#pragma unroll
            for (int i = 0; i < 4; ++i) { const int et = (w & 1) * 4 + i; const bf16x8 bfr = *(const bf16x8*)(Cs + (16 * et + (lane & 15)) * 136 + ks * 32 + (lane >> 4) * 8);
                aN[i] = __builtin_amdgcn_mfma_f32_16x16x32_bf16(bfr, af, aN[i], 0, 0, 0); } }
        const int t = 16 * tt + (lane & 15);
        {   const float it = sc[192 + t];
#pragma unroll
            for (int i = 0; i < 4; ++i) { aN[i][0] *= it; aN[i][1] *= it; aN[i][2] *= it; aN[i][3] *= it; } }
#pragma unroll
        for (int ks = 0; ks < 2; ++ks) { const bf16x8 af = *(const bf16x8*)(Ss + (16 * tt + (lane & 15)) * 72 + ks * 32 + (lane >> 4) * 8);
#pragma unroll
            for (int i = 0; i < 4; ++i) { const int et = (w & 1) * 4 + i; const bf16x8 bfr = *(const bf16x8*)(VT + (16 * et + (lane & 15)) * 72 + ks * 32 + (lane >> 4) * 8);
                aN[i] = __builtin_amdgcn_mfma_f32_16x16x32_bf16(bfr, af, aN[i], 0, 0, 0); } }
        {   const size_t tokt = (size_t)step_tok(b, dir, c * 64 + t); const float dn = fmaxf(fabsf((sc[512 + t] + sc[576 + t]) + sc[640 + t]), sc[256 + t]);
#pragma unroll
            for (int i = 0; i < 4; ++i) { const int e0 = 16 * ((w & 1) * 4 + i) + (lane >> 4) * 4;
                u32x2 wv; wv.x = pk2(aN[i][0] / dn, aN[i][1] / dn); wv.y = pk2(aN[i][2] / dn, aN[i][3] / dn);
                *(u32x2*)(Hout + tokt * BW + h * 128 + e0) = wv; } }
    }
}


#define SD_FRAG_LOAD(BF, XF, cc_) do { const int tb_ = tokblock_of(b, dir, (cc_)); const bf16_t* bb_ = BTg + ((size_t)tb_ * 256 + grp * 128 + 64 * (w >> 2) + r16) * 64 + q4 * 8; const bf16_t* xb_ = XTg + ((size_t)tb_ * 512 + h * 64 + 16 * (w & 3) + r16) * 64 + q4 * 8; \
        _Pragma("unroll") for (int ks_ = 0; ks_ < 2; ++ks_) { XF[ks_] = *(const u32x4*)(xb_ + ks_ * 32); _Pragma("unroll") for (int j_ = 0; j_ < 4; ++j_) BF[j_][ks_] = *(const u32x4*)(bb_ + (size_t)j_ * 16 * 64 + ks_ * 32); } } while (0)
#define SD_CHUNK(c_, BF, XF, BFN, XFN) do { const int c = (c_); \
        if (c + 1 < 68) SD_FRAG_LOAD(BFN, XFN, c + 1); \
        const float dec = sDEC[c]; \
        {   bf16_t* ss = SSTb + (size_t)(chain * 68 + c) * 64 * 128; const int p = 16 * (w & 3) + r16; \
            _Pragma("unroll") for (int j = 0; j < 4; ++j) { const int n0 = 16 * ((w >> 2) * 4 + j) + q4 * 4; u32x2 pk; pk.x = pk2(acc[j][0], acc[j][1]); pk.y = pk2(acc[j][2], acc[j][3]); *(u32x2*)(ss + (size_t)p * 128 + n0) = pk; } } \
        bf16x8 xfr[2]; \
        _Pragma("unroll") for (int ks = 0; ks < 2; ++ks) { const float4 wa = *(const float4*)(sSC + c * 64 + ks * 32 + q4 * 8), wb = *(const float4*)(sSC + c * 64 + ks * 32 + q4 * 8 + 4); const u32x4 sv = scale8h(XF[ks], wa, wb); xfr[ks] = *(const bf16x8*)&sv; } \
        _Pragma("unroll") for (int j = 0; j < 4; ++j) acc[j] = acc[j] * dec; \
        _Pragma("unroll") for (int ks = 0; ks < 2; ++ks) _Pragma("unroll") for (int j = 0; j < 4; ++j) acc[j] = __builtin_amdgcn_mfma_f32_16x16x32_bf16(*(const bf16x8*)&BF[j][ks], xfr[ks], acc[j], 0, 0, 0); } while (0)
__device__ __forceinline__ void ssd_state_pass(const int chain, const bf16_t* __restrict__ Pm, const bf16_t* __restrict__ BTg, const bf16_t* __restrict__ XTg, const float Aa, const float dtb,
                                               bf16_t* __restrict__ SSTb, unsigned char* shm, const int tid) {
    const int dir = chain & 1, h = (chain >> 1) & 7, b = chain >> 4, grp = h >> 2, lane = tid & 63, w = tid >> 6, q4 = lane >> 4, r16 = lane & 15;
    float* sSC = (float*)shm; float* sDEC = sSC + 68 * 64;
    const int dcol = SSD_OFF + 1536 + dir * 8 + h;
    u32x4 bfA[4][2], xfA[2], bfB[4][2], xfB[2];
    SD_FRAG_LOAD(bfA, xfA, 0);
    __syncthreads();
    unsigned dt_[9];
#pragma unroll
    for (int q = 0; q < 9; ++q) { const int c = min(w + 8 * q, 67); dt_[q] = Pm[(size_t)step_tok(b, dir, c * 64 + lane) * LDP + dcol]; }
#pragma unroll
    for (int q = 0; q < 9; ++q) { const int c = w + 8 * q; if (c >= 68) break;
        const float xv = __uint_as_float(dt_[q] << 16) + dtb; const float dtv = xv > 20.f ? xv : log1pf(expf(xv));
        const float cs = wave_scan_incl(dtv * Aa, lane); const float cl = __shfl(cs, 63);
        sSC[c * 64 + (dir ? 63 - lane : lane)] = dtv * expf(cl - cs); if (lane == 0) sDEC[c] = expf(cl); }
    __syncthreads();
    f32x4 acc[4];
#pragma unroll
    for (int j = 0; j < 4; ++j) acc[j] = (f32x4){0.f, 0.f, 0.f, 0.f};
    for (int c2 = 0; c2 < 68; c2 += 2) { SD_CHUNK(c2, bfA, xfA, bfB, xfB); SD_CHUNK(c2 + 1, bfB, xfB, bfA, xfA); }
    __syncthreads();
}
#undef SD_CHUNK
#undef SD_FRAG_LOAD
__device__ __forceinline__ void ssd_out_item(const int chain, const int c, const bf16_t* __restrict__ Pm, const bf16_t* __restrict__ XBb, const bf16_t* __restrict__ XTg, const float Aa, const float dtb,
                                             const bf16_t* __restrict__ SSTb, bf16_t* __restrict__ Yout, unsigned char* shm, const int tid) {
    const int dir = chain & 1, h = (chain >> 1) & 7, b = chain >> 4, grp = h >> 2, lane = tid & 63, w = tid >> 6;
    bf16_t* Cs = (bf16_t*)shm; bf16_t* Bs = (bf16_t*)(shm + 17408); bf16_t* XT = (bf16_t*)(shm + 34816); bf16_t* Sin = (bf16_t*)(shm + 44032); bf16_t* Gs = (bf16_t*)(shm + 61440);
    float* sc = (float*)(shm + 70656);
    __syncthreads();
    u32x4 gb[2], gcc[2], gs[2], gx; unsigned gd_ = 0u;
#pragma unroll
    for (int i = 0; i < 2; ++i) { const int pid = tid + i * 512; const int s = pid >> 4, x0 = (pid & 15) * 8; const size_t toks = (size_t)step_tok(b, dir, c * 64 + s);
        gb[i] = *(const u32x4*)(XBb + toks * 1024 + 512 + grp * 128 + x0);
        gcc[i] = *(const u32x4*)(XBb + toks * 1024 + 768 + grp * 128 + x0);
        const int p = pid >> 4;
        gs[i] = *(const u32x4*)(SSTb + ((size_t)(chain * 68 + c) * 64 + p) * 128 + x0); }
    {   const int p = tid >> 3, o = tid & 7;
        gx = *(const u32x4*)(XTg + ((size_t)tokblock_of(b, dir, c) * 512 + h * 64 + p) * 64 + (dir ? 7 - o : o) * 8); }
    if (w == 0) gd_ = Pm[(size_t)step_tok(b, dir, c * 64 + lane) * LDP + SSD_OFF + 1536 + dir * 8 + h];
#pragma unroll
    for (int i = 0; i < 2; ++i) { const int pid = tid + i * 512; const int s = pid >> 4, x0 = (pid & 15) * 8;
        *(u32x4*)(Bs + s * 136 + x0) = gb[i]; *(u32x4*)(Cs + s * 136 + x0) = gcc[i]; *(u32x4*)(Sin + s * 136 + x0) = gs[i]; }
    {   const int p = tid >> 3, o = tid & 7; *(u32x4*)(XT + p * 72 + o * 8) = dir ? rev8h(gx) : gx; }
    if (w == 0) {
        const float xv = __uint_as_float(gd_ << 16) + dtb; const float dtv = xv > 20.f ? xv : log1pf(expf(xv));
        sc[lane] = wave_scan_incl(dtv * Aa, lane); sc[64 + lane] = dtv; }
    __syncthreads();
    {   const int lt = w >> 1;
        f32x4 aG[2] = {(f32x4){0.f, 0.f, 0.f, 0.f}, (f32x4){0.f, 0.f, 0.f, 0.f}};
#pragma unroll
        for (int ks = 0; ks < 4; ++ks) { const bf16x8 af = *(const bf16x8*)(Cs + (16 * lt + (lane & 15)) * 136 + ks * 32 + (lane >> 4) * 8);
#pragma unroll
            for (int i = 0; i < 2; ++i) { const int st = (w & 1) * 2 + i; const bf16x8 bfr = *(const bf16x8*)(Bs + (16 * st + (lane & 15)) * 136 + ks * 32 + (lane >> 4) * 8);
                aG[i] = __builtin_amdgcn_mfma_f32_16x16x32_bf16(af, bfr, aG[i], 0, 0, 0); } }
#pragma unroll
        for (int i = 0; i < 2; ++i) { const int s = 16 * ((w & 1) * 2 + i) + (lane & 15); const float css = sc[s], dts = sc[64 + s];
#pragma unroll
            for (int q = 0; q < 4; ++q) { const int t = 16 * lt + (lane >> 4) * 4 + q; const float val = (s <= t) ? aG[i][q] * expf(sc[t] - css) * dts : 0.f; Gs[t * 72 + s] = f2bf(val); } }
    }
    __syncthreads();
    {   const int lt = w >> 1;
        f32x4 aY[2] = {(f32x4){0.f, 0.f, 0.f, 0.f}, (f32x4){0.f, 0.f, 0.f, 0.f}};
#pragma unroll
        for (int ks = 0; ks < 4; ++ks) { const bf16x8 af = *(const bf16x8*)(Cs + (16 * lt + (lane & 15)) * 136 + ks * 32 + (lane >> 4) * 8);
#pragma unroll
            for (int i = 0; i < 2; ++i) { const int pt = (w & 1) * 2 + i; const bf16x8 bfr = *(const bf16x8*)(Sin + (16 * pt + (lane & 15)) * 136 + ks * 32 + (lane >> 4) * 8);
                aY[i] = __builtin_amdgcn_mfma_f32_16x16x32_bf16(bfr, af, aY[i], 0, 0, 0); } }
        const int t = 16 * lt + (lane & 15);
        {   const float ec = expf(sc[t]);
#pragma unroll
            for (int i = 0; i < 2; ++i) { aY[i][0] *= ec; aY[i][1] *= ec; aY[i][2] *= ec; aY[i][3] *= ec; } }
#pragma unroll
        for (int ks = 0; ks < 2; ++ks) { const bf16x8 af = *(const bf16x8*)(Gs + (16 * lt + (lane & 15)) * 72 + ks * 32 + (lane >> 4) * 8);
#pragma unroll
            for (int i = 0; i < 2; ++i) { const int pt = (w & 1) * 2 + i; const bf16x8 bfr = *(const bf16x8*)(XT + (16 * pt + (lane & 15)) * 72 + ks * 32 + (lane >> 4) * 8);
                aY[i] = __builtin_amdgcn_mfma_f32_16x16x32_bf16(bfr, af, aY[i], 0, 0, 0); } }
        {   const size_t tokt = (size_t)step_tok(b, dir, c * 64 + t);
#pragma unroll
            for (int i = 0; i < 2; ++i) { const int p0 = 16 * ((w & 1) * 2 + i) + (lane >> 4) * 4;
                u32x2 wv; wv.x = pk2(aY[i][0], aY[i][1]); wv.y = pk2(aY[i][2], aY[i][3]);
                *(u32x2*)(Yout + tokt * BW + h * 64 + p0) = wv; } }
    }
}


#define FIDX(i) ((i) + ((i) >> 4))
#define FFT_X_BYTES 69632
__device__ constexpr float FFT_CW_RE[6][16] = {{0.f, 0.f, 0.f, 0.f, 0.f, 0.f, 0.f, 0.f, 0.f, 0.f, 0.f, 0.f, 0.f, 0.f, 0.f, 0.f}, {1.0f, 0.f, 0.f, 0.f, 0.f, 0.f, 0.f, 0.f, 0.f, 0.f, 0.f, 0.f, 0.f, 0.f, 0.f, 0.f}, {1.0f, 6.123233995736766e-17f, 0.f, 0.f, 0.f, 0.f, 0.f, 0.f, 0.f, 0.f, 0.f, 0.f, 0.f, 0.f, 0.f, 0.f}, {1.0f, 0.7071067811865476f, 6.123233995736766e-17f, -0.7071067811865475f, 0.f, 0.f, 0.f, 0.f, 0.f, 0.f, 0.f, 0.f, 0.f, 0.f, 0.f, 0.f}, {1.0f, 0.9238795325112867f, 0.7071067811865476f, 0.38268343236508984f, 6.123233995736766e-17f, -0.3826834323650897f, -0.7071067811865475f, -0.9238795325112867f, 0.f, 0.f, 0.f, 0.f, 0.f, 0.f, 0.f, 0.f}, {1.0f, 0.9807852804032304f, 0.9238795325112867f, 0.8314696123025452f, 0.7071067811865476f, 0.5555702330196023f, 0.38268343236508984f, 0.19509032201612833f, 6.123233995736766e-17f, -0.1950903220161282f, -0.3826834323650897f, -0.555570233019602f, -0.7071067811865475f, -0.8314696123025453f, -0.9238795325112867f, -0.9807852804032304f}};
__device__ constexpr float FFT_CW_IM[6][16] = {{0.f, 0.f, 0.f, 0.f, 0.f, 0.f, 0.f, 0.f, 0.f, 0.f, 0.f, 0.f, 0.f, 0.f, 0.f, 0.f}, {-0.0f, 0.f, 0.f, 0.f, 0.f, 0.f, 0.f, 0.f, 0.f, 0.f, 0.f, 0.f, 0.f, 0.f, 0.f, 0.f}, {-0.0f, -1.0f, 0.f, 0.f, 0.f, 0.f, 0.f, 0.f, 0.f, 0.f, 0.f, 0.f, 0.f, 0.f, 0.f, 0.f}, {-0.0f, -0.7071067811865475f, -1.0f, -0.7071067811865476f, 0.f, 0.f, 0.f, 0.f, 0.f, 0.f, 0.f, 0.f, 0.f, 0.f, 0.f, 0.f}, {-0.0f, -0.3826834323650898f, -0.7071067811865475f, -0.9238795325112867f, -1.0f, -0.9238795325112867f, -0.7071067811865476f, -0.3826834323650899f, 0.f, 0.f, 0.f, 0.f, 0.f, 0.f, 0.f, 0.f}, {-0.0f, -0.19509032201612825f, -0.3826834323650898f, -0.5555702330196022f, -0.7071067811865475f, -0.8314696123025452f, -0.9238795325112867f, -0.9807852804032304f, -1.0f, -0.9807852804032304f, -0.9238795325112867f, -0.8314696123025455f, -0.7071067811865476f, -0.5555702330196022f, -0.3826834323650899f, -0.1950903220161286f}};
__host__ __device__ constexpr int fft_bitrev(int k, int R) { int r = 0; for (int i = 0; i < R; ++i) if (k & (1 << i)) r |= 1 << (R - 1 - i); return r; }
template <int R, bool INV>
__device__ __forceinline__ void fft_pass(float2* __restrict__ X, const float2* __restrict__ TW, const int s0, const int gidx) {
    const int lowbits = 13 - s0 - R; const int stride = 1 << lowbits;
    const int low = gidx & (stride - 1), high = gidx >> lowbits; const int base = (high << (lowbits + R)) | low;
    const int p0 = FIDX(base);
#define FFT_SLOT(k) (lowbits >= 4 ? p0 + (k) * (stride + (stride >> 4)) : p0 + (k) + ((k) >> 4))
    float2 v[1 << R];
#pragma unroll
    for (int k = 0; k < (1 << R); ++k) v[k] = X[FFT_SLOT(k)];
    const int lw = low << s0;
    if (!INV) {
#pragma unroll
        for (int j = 0; j < R; ++j) { const int hk = 1 << (R - 1 - j);
#pragma unroll
            for (int k = 0; k < (1 << R); ++k) if (!(k & hk)) { const int kk = k & (hk - 1);
                const float2 a = v[k], b = v[k + hk]; v[k] = make_float2(a.x + b.x, a.y + b.y); const float dx = a.x - b.x, dy = a.y - b.y;
                if (kk == 0) v[k + hk] = make_float2(dx, dy);
                else if (2 * kk == hk) v[k + hk] = make_float2(dy, -dx);
                else { const float cr = FFT_CW_RE[R - j][kk], ci = FFT_CW_IM[R - j][kk]; v[k + hk] = make_float2(dx * cr - dy * ci, dx * ci + dy * cr); } } }
        if (lowbits > 0) {
#pragma unroll
            for (int k = 1; k < (1 << R); ++k) { const float2 w = TW[(lw * fft_bitrev(k, R)) & 8191]; const float2 a = v[k]; v[k] = make_float2(a.x * w.x - a.y * w.y, a.x * w.y + a.y * w.x); } }
    } else {
        if (lowbits > 0) {
#pragma unroll
            for (int k = 1; k < (1 << R); ++k) { const float2 w = TW[(lw * fft_bitrev(k, R)) & 8191]; const float2 a = v[k]; v[k] = make_float2(a.x * w.x + a.y * w.y, a.y * w.x - a.x * w.y); } }
#pragma unroll
        for (int j = R - 1; j >= 0; --j) { const int hk = 1 << (R - 1 - j);
#pragma unroll
            for (int k = 0; k < (1 << R); ++k) if (!(k & hk)) { const int kk = k & (hk - 1);
                const float2 a = v[k], b = v[k + hk]; float tx, ty;
                if (kk == 0) { tx = b.x; ty = b.y; }
                else if (2 * kk == hk) { tx = -b.y; ty = b.x; }
                else { const float cr = FFT_CW_RE[R - j][kk], ci = FFT_CW_IM[R - j][kk]; tx = b.x * cr + b.y * ci; ty = b.y * cr - b.x * ci; }
                v[k] = make_float2(a.x + tx, a.y + ty); v[k + hk] = make_float2(a.x - tx, a.y - ty); } }
    }
#pragma unroll
    for (int k = 0; k < (1 << R); ++k) X[FFT_SLOT(k)] = v[k];
#undef FFT_SLOT
}
__device__ __forceinline__ void fft_fwd(float2* X, const float2* TW, const int tid) {
    fft_pass<4, false>(X, TW, 0, tid); __syncthreads(); fft_pass<4, false>(X, TW, 4, tid); __syncthreads(); if (tid < 256) fft_pass<5, false>(X, TW, 8, tid); __syncthreads(); }
__device__ __forceinline__ void fft_inv(float2* X, const float2* TW, const int tid) {
    if (tid < 256) fft_pass<5, true>(X, TW, 8, tid); __syncthreads(); fft_pass<4, true>(X, TW, 4, tid); __syncthreads(); fft_pass<4, true>(X, TW, 0, tid); __syncthreads(); }
__device__ __forceinline__ void fft_twiddles(float2* TW, const int tid) {
#pragma unroll
    for (int k = 0; k < 16; ++k) { const int m = tid + k * 512; const float xx = (float)m * (1.0f / 4096.0f); TW[m] = make_float2(cospif(xx), -sinpif(xx)); }
}
__device__ __forceinline__ void hyena_spec_item(const int oc, const float* __restrict__ HR, const float* __restrict__ nrm, float2* __restrict__ HSPEC, unsigned char* shm, const int tid) {
    float2* X = (float2*)shm; const float2* TW = (const float2*)(shm + FFT_X_BYTES);
    const int o = oc >> 9, c = oc & 511; const float inv = 1.0f / nrm[oc];
    __syncthreads();
    float hv[16];
#pragma unroll
    for (int k = 0; k < 16; ++k) { const int j = tid + k * 512;
        const unsigned off = j < SEQ ? (unsigned)j * 2048u + o * 1024 + c : j == SEQ ? (unsigned)(o * 1024 + c) : (unsigned)(2 * SEQ - j) * 2048u + o * 1024 + 512 + c;
        hv[k] = HR[off]; }
#pragma unroll
    for (int k = 0; k < 16; ++k) { const int j = tid + k * 512; X[FIDX(j)] = make_float2(j == SEQ ? 0.f : hv[k] * inv, 0.f); }
    __syncthreads();
    fft_fwd(X, TW, tid);
    float4* out = (float4*)(HSPEC + (size_t)oc * 8192 + tid * 16); const float2* xs = X + 17 * tid;
#pragma unroll
    for (int k = 0; k < 8; ++k) { const float2 x0 = xs[2 * k], x1 = xs[2 * k + 1]; out[k] = make_float4(x0.x * (1.0f / 8192.0f), x0.y * (1.0f / 8192.0f), x1.x * (1.0f / 8192.0f), x1.y * (1.0f / 8192.0f)); }
}
__device__ __forceinline__ void fft_mul_spec(float2* X, const float2* __restrict__ H, const int tid) {
    const float4* h4 = (const float4*)(H + tid * 16); float2* xs = X + 17 * tid;
#pragma unroll
    for (int k = 0; k < 8; ++k) { const float4 hv = h4[k]; const float2 x0 = xs[2 * k], x1 = xs[2 * k + 1];
        xs[2 * k] = make_float2(x0.x * hv.x - x0.y * hv.y, x0.x * hv.y + x0.y * hv.x); xs[2 * k + 1] = make_float2(x1.x * hv.z - x1.y * hv.w, x1.x * hv.w + x1.y * hv.z); }
}
__device__ __forceinline__ void hyena_fft_item(const int item, const float* __restrict__ UT, const float2* __restrict__ HSPEC, const float* __restrict__ bias, float* __restrict__ YT, unsigned char* shm, const int tid) {
    float2* X = (float2*)shm; const float2* TW = (const float2*)(shm + FFT_X_BYTES);
    const int c = item >> 1, b0 = (item & 1) * 2, b1 = b0 + 1;
    const float* u0 = UT + (size_t)(b0 * 1536 + c) * SEQ + tid * 8; const float* u1 = UT + (size_t)(b1 * 1536 + c) * SEQ + tid * 8;
    const float bias0 = bias[c], bias1 = bias[512 + c];
    float2* xs = X + FIDX(8 * tid);
    float vr[8], vi[8];
    __syncthreads();
    { const float4 a0 = *(const float4*)u0, a1 = *(const float4*)(u0 + 4), c0 = *(const float4*)u1, c1 = *(const float4*)(u1 + 4);
      vr[0] = a0.x; vr[1] = a0.y; vr[2] = a0.z; vr[3] = a0.w; vr[4] = a1.x; vr[5] = a1.y; vr[6] = a1.z; vr[7] = a1.w;
      vi[0] = c0.x; vi[1] = c0.y; vi[2] = c0.z; vi[3] = c0.w; vi[4] = c1.x; vi[5] = c1.y; vi[6] = c1.z; vi[7] = c1.w; }
#pragma unroll
    for (int k = 0; k < 8; ++k) { xs[k] = make_float2(vr[k], vi[k]); xs[4352 + k] = make_float2(0.f, 0.f); }
    __syncthreads();
    fft_fwd(X, TW, tid);
    fft_mul_spec(X, HSPEC + (size_t)c * 8192, tid);
    __syncthreads();
    fft_inv(X, TW, tid);
    { const float* p0 = u0 + (size_t)512 * SEQ; const float* p1 = u1 + (size_t)512 * SEQ;
      const float4 a0 = *(const float4*)p0, a1 = *(const float4*)(p0 + 4), c0 = *(const float4*)p1, c1 = *(const float4*)(p1 + 4);
      const float xr[8] = {a0.x, a0.y, a0.z, a0.w, a1.x, a1.y, a1.z, a1.w}, xi[8] = {c0.x, c0.y, c0.z, c0.w, c1.x, c1.y, c1.z, c1.w};
#pragma unroll
      for (int k = 0; k < 8; ++k) { const float2 cv = xs[k]; const float zr = xr[k] * (cv.x + bias0 * vr[k]), zi = xi[k] * (cv.y + bias0 * vi[k]);
          vr[k] = zr; vi[k] = zi; xs[k] = make_float2(zr, zi); xs[4352 + k] = make_float2(0.f, 0.f); } }
    __syncthreads();
    fft_fwd(X, TW, tid);
    fft_mul_spec(X, HSPEC + (size_t)(512 + c) * 8192, tid);
    __syncthreads();
    fft_inv(X, TW, tid);
    { const float* p0 = u0 + (size_t)1024 * SEQ; const float* p1 = u1 + (size_t)1024 * SEQ;
      const float4 a0 = *(const float4*)p0, a1 = *(const float4*)(p0 + 4), c0 = *(const float4*)p1, c1 = *(const float4*)(p1 + 4);
      const float xr[8] = {a0.x, a0.y, a0.z, a0.w, a1.x, a1.y, a1.z, a1.w}, xi[8] = {c0.x, c0.y, c0.z, c0.w, c1.x, c1.y, c1.z, c1.w};
      float yr[8], yi[8];
#pragma unroll
      for (int k = 0; k < 8; ++k) { const float2 cv = xs[k]; yr[k] = xr[k] * (cv.x + bias1 * vr[k]); yi[k] = xi[k] * (cv.y + bias1 * vi[k]); }
      float* y0 = YT + (size_t)(b0 * 512 + c) * SEQ + tid * 8; float* y1 = YT + (size_t)(b1 * 512 + c) * SEQ + tid * 8;
      *(float4*)y0 = make_float4(yr[0], yr[1], yr[2], yr[3]); *(float4*)(y0 + 4) = make_float4(yr[4], yr[5], yr[6], yr[7]);
      *(float4*)y1 = make_float4(yi[0], yi[1], yi[2], yi[3]); *(float4*)(y1 + 4) = make_float4(yi[4], yi[5], yi[6], yi[7]); }
}

constexpr size_t al256(size_t x) { return (x + 255) & ~(size_t)255; }
constexpr size_t O_BAR = 0;
constexpr size_t O_MOD = 16384;
constexpr size_t O_NORM = O_MOD + al256((size_t)2 * 5 * 6 * DM * 4);
constexpr size_t O_QCTR = O_NORM + al256((size_t)2 * 2 * 1024 * 4);
constexpr size_t O_ZERO_END = O_QCTR + 512;
constexpr size_t O_XS = O_ZERO_END;
constexpr size_t O_HB = O_XS + al256((size_t)NTOK * DM * 4);
constexpr size_t O_P = O_HB + al256((size_t)NTOK * DM * 2);
constexpr size_t O_WIN = O_P + al256((size_t)NTOK * LDP * 2);
constexpr size_t O_WBR = O_WIN + al256((size_t)LDP * DM * 2);
constexpr size_t O_WOUT = O_WBR + al256((size_t)4 * DM * BW * 2);
constexpr size_t O_WGU = O_WOUT + al256((size_t)DM * DM * 2);
constexpr size_t O_WD = O_WGU + al256((size_t)NEXP * 2 * DEXP * DM * 2);
constexpr size_t O_GLU = O_WD + al256((size_t)NEXP * DM * DEXP * 2);
constexpr size_t O_Y4 = O_GLU + al256((size_t)BW * BW * 2);
constexpr size_t O_U = O_Y4 + al256((size_t)NTOK * DM * 2);
constexpr size_t O_QKB = O_U + al256((size_t)NTOK * 1536 * 4);
constexpr size_t O_CST = O_QKB + al256((size_t)NTOK * 1024 * 2);
constexpr size_t O_NST = O_CST + al256((size_t)32 * 68 * 128 * 128 * 2);
constexpr size_t O_MST = O_NST + al256((size_t)32 * 68 * 128 * 4);
constexpr size_t O_XBC = O_MST + al256((size_t)32 * 68 * 4);
constexpr size_t O_SST = O_XBC + al256((size_t)NTOK * 1024 * 2);
constexpr size_t O_HF = O_SST + al256((size_t)64 * 68 * 64 * 128 * 2);
constexpr size_t O_YF = O_HF + al256((size_t)2 * NTOK * BW * 4);
constexpr size_t O_SF = O_YF + al256((size_t)2 * NTOK * BW * 4);
constexpr size_t O_LDT = O_SF + al256((size_t)2 * NCTX * BW * 4);
constexpr size_t O_AP = O_LDT + al256((size_t)4096 * 16);
constexpr size_t O_BBT = O_AP + al256((size_t)4096 * 33 * 8);
constexpr size_t O_KT = O_BBT + al256((size_t)4096 * 16 * 8);
constexpr size_t O_S5A = O_KT + al256((size_t)32 * 2 * 32 * 256 * 4);
constexpr size_t O_S5B = O_S5A + al256((size_t)32 * 512 * 768 * 2);
constexpr size_t O_XCTX = O_S5B + al256((size_t)32 * 512 * 768 * 2);
constexpr size_t O_Z = O_XCTX + al256((size_t)4 * 32 * 2 * 64 * 8);
constexpr size_t O_HRAW = O_Z + al256((size_t)NTOK * BW * 4);
constexpr size_t O_HSPEC = O_HRAW + al256((size_t)(SEQ + CTXL) * 2048 * 4);
constexpr size_t O_K2C = O_HSPEC + al256((size_t)1024 * 8192 * 8);
constexpr size_t O_GG = O_K2C + al256((size_t)(2 * CTXL) * 1024 * 4);
constexpr size_t O_PROBS = O_GG + al256((size_t)NTOK * BW * 2);
constexpr size_t O_ROWTOK = O_PROBS + al256((size_t)NTOK * 16 * 4);
constexpr size_t O_ROWGATE = O_ROWTOK + al256((size_t)NEXP * MOE_PAD * 4);
constexpr size_t O_INV = O_ROWGATE + al256((size_t)NEXP * MOE_PAD * 4);
constexpr size_t O_NORMP = O_INV + al256((size_t)NTOK * 16 * 4);
constexpr size_t WS_END = O_NORMP + al256((size_t)4 * 256 * 2048 * 4);
constexpr size_t O_XG = O_P;
constexpr size_t O_HID = O_P + al256((size_t)NEXP * MOE_PAD * DM * 2);
constexpr size_t O_YEXP = O_HID + al256((size_t)NEXP * MOE_PAD * DEXP * 2);
static_assert(O_YEXP + (size_t)NEXP * MOE_PAD * DM * 2 <= O_WIN, "MoE temporaries must fit inside P");
static_assert((size_t)NTOK * DM * 2 <= (size_t)NTOK * 1536 * 4, "ACCb must fit inside U");
static_assert((size_t)26214400 + (size_t)2 * 17825792 + (size_t)272 * 256 * 64 * 2 <= (size_t)NTOK * DM * 2, "strip buffers must fit inside HB");
static_assert(WS_END <= (size_t)1851000000, "workspace map exceeds the guaranteed size");

struct Args {
    const float* in[47];
    float* out; unsigned char* ws;
    int ph_lo, ph_hi;
};

__device__ __forceinline__ void conv_tile(const float* __restrict__ src, int ldsrc, int nvalid, int k0, int n0, bf16_t* __restrict__ dst, int lddst, int mode, float* T, int tid) {
    { const int n = tid & 63, kr = tid >> 6;
#pragma unroll
      for (int i = 0; i < 8; ++i) { const int k = i * 8 + kr; T[k * 65 + n] = (n0 + n < nvalid) ? src[(size_t)(k0 + k) * ldsrc + n0 + n] : 0.f; } }
    __syncthreads();
    { const int n = tid >> 3, kc = (tid & 7) * 8; const int gn = n0 + n;
      const int drow = mode == 0 ? gn : (32 * (gn >> 4) + (mode == 2 ? 16 : 0) + (gn & 15));
      u32x4 w; w.x = pk2(T[(kc + 0) * 65 + n], T[(kc + 1) * 65 + n]); w.y = pk2(T[(kc + 2) * 65 + n], T[(kc + 3) * 65 + n]);
      w.z = pk2(T[(kc + 4) * 65 + n], T[(kc + 5) * 65 + n]); w.w = pk2(T[(kc + 6) * 65 + n], T[(kc + 7) * 65 + n]);
      *(u32x4*)(dst + (size_t)drow * lddst + k0 + kc) = w; }
    __syncthreads();
}

#define IN(id) (lo <= (id) && (id) < hi)
#define SEAM(id) do { if (hi > (id) + 1) xcd_barrier(bar); } while (0)
#define PH_BEGIN int tid = threadIdx.x; asm volatile("" : "+v"(tid) :: "memory"); const int lane = tid & 63, wave = tid >> 6; (void)lane; (void)wave;

#define x_in (PT(0))
#define c_in (PT(1))
#define ctx_in (PT(2))
#define cctx_in (PT(3))
#define ada_w (PT(4))
#define ada_b (PT(5))
#define norm_mix (PT(6))
#define norm_ffn (PT(7))
#define w_in (PT(8))
#define XS ((float*)(a.ws + O_XS))
#define MOD ((float*)(a.ws + O_MOD))
#define NORM ((float*)(a.ws + O_NORM))
#define NORMP ((float*)(a.ws + O_NORMP))
#define MODl (MOD + (size_t)l * 5 * 6 * DM)
#define HB ((bf16_t*)(a.ws + O_HB))
#define P ((bf16_t*)(a.ws + O_P))
#define WIN ((bf16_t*)(a.ws + O_WIN))
#define WBR ((bf16_t*)(a.ws + O_WBR))
#define WOUT ((bf16_t*)(a.ws + O_WOUT))
#define WGU ((bf16_t*)(a.ws + O_WGU))
#define WD ((bf16_t*)(a.ws + O_WD))
#define GLU ((bf16_t*)(a.ws + O_GLU))
#define Y4 ((bf16_t*)(a.ws + O_Y4))
#define U ((float*)(a.ws + O_U))
#define ACCb ((bf16_t*)(a.ws + O_U))
#define QKB ((bf16_t*)(a.ws + O_QKB))
#define CST ((bf16_t*)(a.ws + O_CST))
#define NST ((float*)(a.ws + O_NST))
#define MST ((float*)(a.ws + O_MST))
#define XBC ((bf16_t*)(a.ws + O_XBC))
#define SSTB ((bf16_t*)(a.ws + O_SST))
#define HF ((bf16_t*)(a.ws + O_HF))
#define HBk (HF + (size_t)NTOK * BW)
#define YF ((bf16_t*)(a.ws + O_YF))
#define YB (YF + (size_t)NTOK * BW)
#define SF ((float*)(a.ws + O_SF))
#define SB (SF + (size_t)NCTX * BW)
#define LDT ((double2*)(a.ws + O_LDT))
#define APW ((float2*)(a.ws + O_AP))
#define BBT ((float2*)(a.ws + O_BBT))
#define KTB ((float*)(a.ws + O_KT))
#define S5A ((bf16_t*)(a.ws + O_S5A))
#define S5B ((bf16_t*)(a.ws + O_S5B))
#define XCTX ((float2*)(a.ws + O_XCTX))
#define S5P ((bf16_t*)(a.ws + O_HB))
#define XLOC ((float*)(a.ws + O_HB + (size_t)32 * 256 * 512 * 2))
#define KTG ((bf16_t*)(a.ws + O_HB + (size_t)26214400))
#define VTG ((bf16_t*)(a.ws + O_HB + (size_t)26214400 + (size_t)17825792))
#define BTG ((bf16_t*)(a.ws + O_HB + (size_t)26214400 + (size_t)2 * 17825792))
#define XTG ((bf16_t*)(a.ws + O_GG))
#define Z ((float*)(a.ws + O_Z))
#define HRAW ((float*)(a.ws + O_HRAW))
#define HSPEC ((float2*)(a.ws + O_HSPEC))
#define UT ((float*)(a.ws + O_U))
#define YT ((float*)(a.ws + O_Z))
#define QCTR ((int*)(a.ws + O_QCTR))
#define K2C ((float*)(a.ws + O_K2C))
#define GG ((bf16_t*)(a.ws + O_GG))
#define PROBS ((float*)(a.ws + O_PROBS))
#define ROWTOK ((int*)(a.ws + O_ROWTOK))
#define ROWGATE ((float*)(a.ws + O_ROWGATE))
#define XG ((bf16_t*)(a.ws + O_XG))
#define HID ((bf16_t*)(a.ws + O_HID))
#define YEXP ((bf16_t*)(a.ws + O_YEXP))
#define INV ((int*)(a.ws + O_INV))


__device__ __forceinline__ void moe_pair(float4 (&a)[8], const int r1, const int r2, const float g2scale, const int lane, const float* __restrict__ rowgate, const bf16_t* __restrict__ yexp) {
    const float gt1 = rowgate[r1], gt2 = rowgate[r2] * g2scale;
    const bf16_t* y1 = yexp + (size_t)r1 * DM + lane * 4; const bf16_t* y2 = yexp + (size_t)r2 * DM + lane * 4;
    u32x2 w1[8], w2[8];
#pragma unroll
    for (int i = 0; i < 8; ++i) { w1[i] = *(const u32x2*)(y1 + i * 256); w2[i] = *(const u32x2*)(y2 + i * 256); }
#pragma unroll
    for (int i = 0; i < 8; ++i) {
        a[i].x += gt1 * __uint_as_float(w1[i].x << 16); a[i].y += gt1 * __uint_as_float(w1[i].x & 0xFFFF0000u); a[i].z += gt1 * __uint_as_float(w1[i].y << 16); a[i].w += gt1 * __uint_as_float(w1[i].y & 0xFFFF0000u);
        a[i].x += gt2 * __uint_as_float(w2[i].x << 16); a[i].y += gt2 * __uint_as_float(w2[i].x & 0xFFFF0000u); a[i].z += gt2 * __uint_as_float(w2[i].y << 16); a[i].w += gt2 * __uint_as_float(w2[i].y & 0xFFFF0000u); }
}
__device__ __forceinline__ void moe_combine(float4 (&v)[8], const int tok, const int lane, const int* __restrict__ inv, const float* __restrict__ rowgate, const bf16_t* __restrict__ yexp, const float* __restrict__ m5) {
    float4 a[8], mm[8];
#pragma unroll
    for (int i = 0; i < 8; ++i) { a[i] = make_float4(0.f, 0.f, 0.f, 0.f); mm[i] = *(const float4*)(m5 + i * 256 + lane * 4); }
    const int4* ip = (const int4*)(inv + (size_t)tok * 16);
    const int4 q0 = ip[0], q1 = ip[1], q2 = ip[2], q3 = ip[3];
    const int rows[16] = {q0.x, q0.y, q0.z, q0.w, q1.x, q1.y, q1.z, q1.w, q2.x, q2.y, q2.z, q2.w, q3.x, q3.y, q3.z, q3.w};
    int prow = -1;
#pragma unroll
    for (int e = 0; e < 16; ++e) { const int row = __builtin_amdgcn_readfirstlane(rows[e]);
        if (row >= 0) { if (prow >= 0) { moe_pair(a, prow, row, 1.0f, lane, rowgate, yexp); prow = -1; } else prow = row; } }
    if (prow >= 0) moe_pair(a, prow, prow, 0.0f, lane, rowgate, yexp);
#pragma unroll
    for (int i = 0; i < 8; ++i) { v[i].x += mm[i].x * a[i].x; v[i].y += mm[i].y * a[i].y; v[i].z += mm[i].z * a[i].z; v[i].w += mm[i].w * a[i].w; }
}
struct CvU { const float* src; bf16_t* dst; int ldsrc, nvalid, k0, n0, lddst, mode; };
__device__ __forceinline__ void cv_load(const CvU& u, float4 (&r)[8], const int tid) {
#pragma unroll
    for (int i = 0; i < 8; ++i) { const int idx = tid + i * 512; const int k = idx >> 6, n = u.n0 + (idx & 63) * 4;
        r[i] = (n < u.nvalid) ? *(const float4*)(u.src + (size_t)(u.k0 + k) * u.ldsrc + n) : make_float4(0.f, 0.f, 0.f, 0.f); }
}
__device__ __forceinline__ void cv_stage(float* T, const float4 (&r)[8], const int tid) {
#pragma unroll
    for (int i = 0; i < 8; ++i) { const int idx = tid + i * 512; float* p = T + (idx >> 6) * 257 + (idx & 63) * 4; p[0] = r[i].x; p[1] = r[i].y; p[2] = r[i].z; p[3] = r[i].w; }
}
__device__ __forceinline__ void cv_store(const CvU& u, const float* T, const int tid) {
#pragma unroll
    for (int j = 0; j < 4; ++j) { const int o = tid + j * 512; const int kc = (o & 7) * 8, n = o >> 3; const int gn = u.n0 + n;
        const int drow = u.mode == 0 ? gn : (256 * (gn >> 7) + (u.mode == 2 ? 128 : 0) + (gn & 127));
        const float* t = T + kc * 257 + n;
        u32x4 w; w.x = pk2(t[0], t[257]); w.y = pk2(t[2 * 257], t[3 * 257]); w.z = pk2(t[4 * 257], t[5 * 257]); w.w = pk2(t[6 * 257], t[7 * 257]);
        *(u32x4*)(u.dst + (size_t)drow * u.lddst + u.k0 + kc) = w; }
}
#define CV_RUN(LL, QSTART, QSTEP, QEND) do { \
                const float* wbr = PT(40) + (size_t)(LL) * 4 * BW * DM; const float* wout = PT(41) + (size_t)(LL) * DM * DM; \
                const float* wg = PT(43) + (size_t)(LL) * NEXP * DM * DEXP; const float* wu = PT(44) + (size_t)(LL) * NEXP * DM * DEXP; const float* wd = PT(45) + (size_t)(LL) * NEXP * DEXP * DM; \
                const float* wglu = PT(32) + (size_t)(LL) * BW * BW; const float* win = w_in + (size_t)(LL) * DM * IN_W; \
                const int cv_step = (QSTEP), cv_end = (QEND); \
                __syncthreads(); \
                int q = (QSTART); int buf = 0; CvU u; float4 r[8]; \
                if (q < cv_end) { CV_DECODE(q, u); cv_load(u, r, tid); } \
                while (q < cv_end) { \
                    float* T = sf + buf * (64 * 257); \
                    cv_stage(T, r, tid); \
                    __syncthreads(); \
                    const CvU cur = u; const int qn = q + cv_step; \
                    if (qn < cv_end) { CV_DECODE(qn, u); cv_load(u, r, tid); } \
                    cv_store(cur, T, tid); \
                    buf ^= 1; q = qn; \
                } \
                __syncthreads(); } while (0)
#define CV_DECODE(q_, u_) do { int qq_ = (q_); \
                    if (qq_ < n_win) { u_ = CvU{win, WIN, IN_W, IN_W, (qq_ / 55) * 64, (qq_ % 55) * 256, DM, 0}; } else { qq_ -= n_win; \
                    if (qq_ < n_br) { const int k = qq_ >> 6, r = qq_ & 63; u_ = CvU{wbr + (size_t)k * BW * DM, WBR + (size_t)k * DM * BW, DM, DM, (r >> 3) * 64, (r & 7) * 256, BW, 0}; } else { qq_ -= n_br; \
                    if (qq_ < n_out) { u_ = CvU{wout, WOUT, DM, DM, (qq_ >> 3) * 64, (qq_ & 7) * 256, DM, 0}; } else { qq_ -= n_out; \
                    if (qq_ < n_glu) { u_ = CvU{wglu, GLU, BW, BW, (qq_ >> 1) * 64, (qq_ & 1) * 256, BW, 0}; } else { qq_ -= n_glu; \
                    if (qq_ < n_gu) { const int e = qq_ / 384, r = qq_ % 384, up = r / 192, r2 = r % 192; u_ = CvU{(up ? wu : wg) + (size_t)e * DM * DEXP, WGU + (size_t)e * 2 * DEXP * DM, DEXP, DEXP, (r2 / 6) * 64, (r2 % 6) * 256, DM, 1 + up}; } else { qq_ -= n_gu; \
                    { const int e = qq_ / 192, r = qq_ % 192; u_ = CvU{wd + (size_t)e * DEXP * DM, WD + (size_t)e * DM * DEXP, DM, DM, (r >> 3) * 64, (r & 7) * 256, DEXP, 0}; } } } } } } } while (0)
template <int LAYER>
__device__ __forceinline__ void layer_body(const Args& a, const XcdBarrier& bar, const int lo, const int hi, const int bid, const int G, unsigned char* const shm, float* const sf, const float** const ptab) {
        constexpr int l = LAYER;
        constexpr int PB = 1 + 16 * l;
        const bool lastl = (l == 1);

        const int nPanels = lastl ? 64 : 68;
        const int M2 = nPanels * 256;

        if (IN(PB + 0)) for (int rep_ = 0; rep_ < (l == 0 ? PROBE_REPS(0) : 1); ++rep_) {
            PH_BEGIN
            {   const int n_win = 32 * 55, n_br = 4 * 64, n_out = 32 * 8, n_glu = 16, n_gu = 16 * 2 * 192, n_d = 16 * 192;
                const int n_grp1 = n_win + n_br + n_out + n_glu, total = n_grp1 + n_gu + n_d;
                const int q_lo = (l > 0 && G > 128) ? n_win : 0;
                CV_RUN(l, q_lo + bid, G, total);
            }
            for (int set = 0; set < (lastl ? 1 : 2); ++set) {
                const int L = set ? CTXL : SEQ; float* HR = HRAW + (set ? (size_t)SEQ * 2048 : 0);
                const float* w1 = PT(11) + l * 33 * 64; const float* b1 = PT(12) + l * 64; const float* fr1 = PT(13) + l * 64; const float* w2 = PT(14) + l * 64 * 64; const float* b2 = PT(15) + l * 64;
                const float* fr2 = PT(16) + l * 64; const float* w3 = PT(17) + l * 64 * 2048; const float* decay = PT(18) + l * 2048;
                float* feats = sf; float* h1 = sf + 16 * 33; float* h2 = h1 + 16 * 64;
                float nacc[4] = {0.f, 0.f, 0.f, 0.f};
                for (int base = bid; base < L; base += 16 * G) {
                    __syncthreads();
                    for (int e = tid; e < 16 * 33; e += NTHR) { const int ti = e / 33, fi = e % 33; int t = base + ti * G; if (t > L - 1) t = L - 1;
                        float v;
                        if (fi == 0) v = (float)t / (float)(L - 1);
                        else { const int j = (fi - 1) & 15; const double fr = 1e-4 + (double)j * ((15.0 - 1e-4) / 15.0); const double ang = (2.0 * 3.14159265358979323846 / (double)L) * (double)t * fr; v = fi <= 16 ? (float)cos(ang) : (float)(-sin(ang)); }
                        feats[e] = v; }
                    __syncthreads();
                    { const int j = tid & 63, ti = tid >> 6; float s0 = b1[j], s1 = s0;
_Pragma("unroll 3")
                      for (int i = 0; i < 33; ++i) { const float wv = w1[i * 64 + j]; s0 += feats[ti * 33 + i] * wv; s1 += feats[(ti + 8) * 33 + i] * wv; }
                      const float f1 = fr1[j]; h1[ti * 64 + j] = sinf(f1 * s0); h1[(ti + 8) * 64 + j] = sinf(f1 * s1); }
                    __syncthreads();
                    { const int j = tid & 63, ti = tid >> 6; float s0 = b2[j], s1 = s0;
_Pragma("unroll 4")
                      for (int i = 0; i < 64; ++i) { const float wv = w2[i * 64 + j]; s0 += h1[ti * 64 + i] * wv; s1 += h1[(ti + 8) * 64 + i] * wv; }
                      const float f2 = fr2[j]; h2[ti * 64 + j] = sinf(f2 * s0); h2[(ti + 8) * 64 + j] = sinf(f2 * s1); }
                    __syncthreads();
                    float acc[16][4];
#pragma unroll
                    for (int ti = 0; ti < 16; ++ti) { acc[ti][0] = 0.f; acc[ti][1] = 0.f; acc[ti][2] = 0.f; acc[ti][3] = 0.f; }
#pragma unroll 2
                    for (int i = 0; i < 64; ++i) { const float* wrow = w3 + (size_t)i * 2048 + tid; const float wa = wrow[0], wb = wrow[512], wc2 = wrow[1024], wd2 = wrow[1536];
#pragma unroll
                        for (int ti = 0; ti < 16; ++ti) { const float hv = h2[ti * 64 + i]; acc[ti][0] += hv * wa; acc[ti][1] += hv * wb; acc[ti][2] += hv * wc2; acc[ti][3] += hv * wd2; } }
                    float dk[4];
#pragma unroll
                    for (int k = 0; k < 4; ++k) dk[k] = fabsf(decay[tid + k * 512]);
#pragma unroll
                    for (int ti = 0; ti < 16; ++ti) { const int t = base + ti * G; if (t < L) { const float tn = (float)t / (float)(L - 1);
#pragma unroll
                        for (int k = 0; k < 4; ++k) { const float v = acc[ti][k] * expf(-tn * dk[k]); HR[(size_t)t * 2048 + tid + k * 512] = v; nacc[k] += fabsf(v); } } }
                }
                float* nrp = NORMP + ((size_t)(l * 2 + set) * 256 + bid) * 2048;
#pragma unroll
                for (int k = 0; k < 4; ++k) nrp[tid + k * 512] = nacc[k];
            }
            for (int idx = bid * NTHR + tid; idx < 4096; idx += G * NTHR) { const int n = idx & 63, g = (idx >> 6) & 31, dir = idx >> 11;
                const double are = (double)(PT(24) + l * 4096)[idx], aim = (double)(PT(25) + l * 4096)[idx]; const double lam = are < -1e-4 ? are : -1e-4; const double dt = exp((double)(PT(26) + l * 64)[dir * 32 + g]);
                const double ldre = lam * dt, ldim = aim * dt; LDT[idx] = make_double2(ldre, ldim);
                const double mag = exp(ldre); const double ar = mag * cos(ldim), ai = mag * sin(ldim);
                const double den = lam * lam + aim * aim; const double nr = ar - 1.0, ni = ai; const double fre = (nr * lam + ni * aim) / den, fim = (ni * lam - nr * aim) / den;
                const float* b_re = PT(27) + l * 32 * 64 * 16; const float* b_im = PT(28) + l * 32 * 64 * 16;
#pragma unroll 4
                for (int c = 0; c < 16; ++c) { const double br = (double)b_re[(g * 64 + n) * 16 + c], bi = (double)b_im[(g * 64 + n) * 16 + c]; BBT[idx * 16 + c] = make_float2((float)(fre * br - fim * bi), (float)(fre * bi + fim * br)); }
            }
            for (int e2 = bid * NTHR + tid; e2 < 4096 * 33; e2 += G * NTHR) { const int idx = e2 / 33, k = e2 - idx * 33; const int g = (idx >> 6) & 31, dir = idx >> 11;
                const double are = (double)(PT(24) + l * 4096)[idx], aim = (double)(PT(25) + l * 4096)[idx]; const double lam = are < -1e-4 ? are : -1e-4; const double dt = exp((double)(PT(26) + l * 64)[dir * 32 + g]);
                const double ldre = lam * dt, ldim = aim * dt; const double mk = exp(ldre * k); APW[e2] = make_float2((float)(mk * cos(ldim * k)), (float)(mk * sin(ldim * k))); }
            if (l == 0 && lo == 0) xcd_barrier(bar);
            for (int tok = bid * 8 + wave; tok < NTOK; tok += G * 8) {
                const int r = tok < NLAT ? tok / SEQ : 4; const float* xr = l == 0 ? (tok < NLAT ? x_in + (size_t)tok * DM : ctx_in + (size_t)(tok - NLAT) * DM) : XS + (size_t)tok * DM; const float* gn = norm_mix + l * DM;
                const float* sh = MODl + (size_t)(r * 6 + 0) * DM; const float* sc = MODl + (size_t)(r * 6 + 1) * DM;
                float4 v[8]; float ss = 0.f;
#pragma unroll
                for (int i = 0; i < 8; ++i) v[i] = *(const float4*)(xr + i * 256 + lane * 4);
                if (l > 0) {
                    moe_combine(v, tok, lane, INV, ROWGATE, YEXP, MOD + (size_t)((l - 1) * 5 + r) * 6 * DM + 5 * DM);
#pragma unroll
                    for (int i = 0; i < 8; ++i) *(float4*)(XS + (size_t)tok * DM + i * 256 + lane * 4) = v[i]; }
#pragma unroll
                for (int i = 0; i < 8; ++i) ss += v[i].x * v[i].x + v[i].y * v[i].y + v[i].z * v[i].z + v[i].w * v[i].w;
                ss = wave_sum(ss); const float rs = rsqrtf(ss * (1.0f / DM) + 1e-6f);
#pragma unroll
                for (int i = 0; i < 8; ++i) { const int d = i * 256 + lane * 4; const float4 g4 = *(const float4*)(gn + d), s4 = *(const float4*)(sc + d), h4 = *(const float4*)(sh + d);
                    v[i].x = v[i].x * rs * g4.x * (1.f + s4.x) + h4.x; v[i].y = v[i].y * rs * g4.y * (1.f + s4.y) + h4.y; v[i].z = v[i].z * rs * g4.z * (1.f + s4.z) + h4.z; v[i].w = v[i].w * rs * g4.w * (1.f + s4.w) + h4.w; }
#pragma unroll
                for (int i = 0; i < 8; ++i) { u32x2 w; w.x = pk2(v[i].x, v[i].y); w.y = pk2(v[i].z, v[i].w); *(u32x2*)(HB + (size_t)tok * DM + i * 256 + lane * 4) = w; }
            }
            SEAM(PB + 0);
        }

        if (IN(PB + 1)) for (int rep_ = 0; rep_ < PROBE_REPS(1); ++rep_) {
            PH_BEGIN
            for (int base = bid * 8; base < (lastl ? 1 : 2) * 1024; base += G * 8) {
                const int idx = base + (tid & 7), sl = tid >> 3; const int set = idx >> 10, oc = idx & 1023, o = oc >> 9, c = oc & 511;
                const float* pp = NORMP + (size_t)(l * 2 + set) * 256 * 2048 + o * 1024 + c + (size_t)(sl * 4) * 2048; float sacc = 0.f;
#pragma unroll
                for (int j = 0; j < 4; ++j) { const float p0 = pp[(size_t)j * 2048], p1 = pp[(size_t)j * 2048 + 512]; sacc += (sl * 4 + j < G) ? p0 + p1 : 0.f; }
                sf[sl * 8 + (tid & 7)] = sacc; __syncthreads();
                if (tid < 8) { float t = 0.f;
#pragma unroll 8
                    for (int q = 0; q < 64; ++q) t += sf[q * 8 + tid];
                    NORM[(size_t)(l * 2 + set) * 1024 + oc] = t; }
                __syncthreads(); }
            for (int idx = (G - 1 - bid) * NTHR + tid; idx < 32768; idx += G * NTHR) { const int c = idx & 15, lag = (idx >> 4) & 31, dir = (idx >> 9) & 1, g = idx >> 10;
                const float* c_re = PT(29) + l * 32 * 16 * 64 + (g * 16 + c) * 64; const float* c_im = PT(30) + l * 32 * 16 * 64 + (g * 16 + c) * 64;
                float acc[16];
#pragma unroll
                for (int j = 0; j < 16; ++j) acc[j] = 0.f;
#pragma unroll 2
                for (int n = 0; n < 64; ++n) { const int pi = (dir * 32 + g) * 64 + n; const float2 ap = APW[pi * 33 + lag]; const float cr = c_re[n], ci = c_im[n]; const float wr_ = cr * ap.x - ci * ap.y, wi_ = cr * ap.y + ci * ap.x;
                    const float4* bb = (const float4*)(BBT + pi * 16);
#pragma unroll
                    for (int j = 0; j < 8; ++j) { const float4 b2 = bb[j]; acc[2 * j] += wr_ * b2.x - wi_ * b2.y; acc[2 * j + 1] += wr_ * b2.z - wi_ * b2.w; } }
                float4* o = (float4*)(KTB + (size_t)idx * 16);
                o[0] = make_float4(acc[0], acc[1], acc[2], acc[3]); o[1] = make_float4(acc[4], acc[5], acc[6], acc[7]); o[2] = make_float4(acc[8], acc[9], acc[10], acc[11]); o[3] = make_float4(acc[12], acc[13], acc[14], acc[15]);
            }
            __syncthreads();
            pg8::Gemm g{HB, WIN, DM, DM, DM}; pg8::SchedStd S{68, 55, G, bid, DM, DM}; pg8::EpiWin E{P, LDP};
            pg8::gemm_phase(( LAS unsigned char*)shm, g, S, E);
#if defined(PROBE_BNOEPI)
            { __syncthreads(); pg8::EpiNone E0; pg8::gemm_phase((LAS unsigned char*)shm, g, S, E0); }
#endif
            SEAM(PB + 1);
        }

        if (IN(PB + 2)) for (int rep_ = 0; rep_ < PROBE_REPS(2); ++rep_) {
            PH_BEGIN
            const float* hcw = PT(9) + l * 3 * 1536; const float* hcb = PT(10) + l * 1536; const float* mcw = PT(20) + l * 3 * 1024; const float* mcb = PT(21) + l * 1024;
            const float* scw = PT(34) + l * 3 * 1024; const float* scb = PT(35) + l * 1024;
            for (int unit = bid; unit < 272 * 3; unit += G) { const int seg = unit / 3, kind = unit % 3; const bool lat = seg < 256; const size_t tok0 = lat ? (size_t)seg * 64 : (size_t)NLAT + (size_t)(seg - 256) * 64;
                if (kind < 2) { const int hf = kind;
                    const int c = tid * 2; const int col = (hf ? SSD_OFF + 512 : ML_OFF) + c; const float* w = hf ? scw : mcw; const float* bsp = hf ? scb : mcb; bf16_t* dst = (hf ? XBC : QKB) + tok0 * 1024 + c;
                    const float2 w0 = *(const float2*)(w + c), w1 = *(const float2*)(w + 1024 + c), w2 = *(const float2*)(w + 2048 + c), bb = *(const float2*)(bsp + c);
                    const float osc = (!hf && c >= 512) ? 0.08838834764831845f : 1.0f;
                    const bool hasPrev = !lat && ((tok0 - NLAT) & (CTXL - 1)) != 0, hasNext = !lat && (((tok0 - NLAT) + 63) & (CTXL - 1)) != CTXL - 1;
                    bf16_t* strip = nullptr;
                    if (!hf) { if (c >= 512) strip = KTG + ((size_t)seg * 512 + (c - 512)) * 64; }
                    else { if (c < 512) strip = XTG + ((size_t)seg * 512 + c) * 64; else if (c < 768) strip = BTG + ((size_t)seg * 256 + (c - 512)) * 64; }
                    const bf16_t* pp = P + tok0 * LDP + col;
                    unsigned raw[66];
#pragma unroll
                    for (int t = 0; t < 66; ++t) raw[t] = ((t == 0 && !hasPrev) || (t == 65 && !hasNext)) ? 0u : *(const unsigned*)(pp + (ptrdiff_t)(t - 1) * LDP);
#pragma unroll
                    for (int t8 = 0; t8 < 8; ++t8) { float v0[8], v1[8];
#pragma unroll
                        for (int tt = 0; tt < 8; ++tt) { const int t = t8 * 8 + tt; const unsigned p0 = raw[t], p1 = raw[t + 1], p2 = raw[t + 2];
                            float a0 = bb.x + w0.x * __uint_as_float(p0 << 16) + w1.x * __uint_as_float(p1 << 16) + w2.x * __uint_as_float(p2 << 16);
                            float a1 = bb.y + w0.y * __uint_as_float(p0 & 0xFFFF0000u) + w1.y * __uint_as_float(p1 & 0xFFFF0000u) + w2.y * __uint_as_float(p2 & 0xFFFF0000u);
                            a0 = siluf_(a0) * osc; a1 = siluf_(a1) * osc; v0[tt] = a0; v1[tt] = a1;
                            *(unsigned*)(dst + (size_t)t * 1024) = pk2(a0, a1); }
                        if (strip) { u32x4 s0, s1; s0.x = pk2(v0[0], v0[1]); s0.y = pk2(v0[2], v0[3]); s0.z = pk2(v0[4], v0[5]); s0.w = pk2(v0[6], v0[7]); s1.x = pk2(v1[0], v1[1]); s1.y = pk2(v1[2], v1[3]); s1.z = pk2(v1[4], v1[5]); s1.w = pk2(v1[6], v1[7]);
                            *(u32x4*)(strip + t8 * 8) = s0; *(u32x4*)(strip + 64 + t8 * 8) = s1; } }
                } else {
                    const int c = (tid & 255) * 2, th = tid >> 8; const bf16_t* pp = P + (tok0 + th * 32) * LDP + ML_OFF + 1024 + c; bf16_t* strip = VTG + ((size_t)seg * 512 + c) * 64 + th * 32;
                    unsigned rv[32];
#pragma unroll
                    for (int t = 0; t < 32; ++t) rv[t] = *(const unsigned*)(pp + (size_t)t * LDP);
#pragma unroll
                    for (int t8 = 0; t8 < 4; ++t8) { u32x4 s0, s1;
                        s0.x = (rv[t8 * 8 + 0] & 0xFFFFu) | (rv[t8 * 8 + 1] << 16); s0.y = (rv[t8 * 8 + 2] & 0xFFFFu) | (rv[t8 * 8 + 3] << 16); s0.z = (rv[t8 * 8 + 4] & 0xFFFFu) | (rv[t8 * 8 + 5] << 16); s0.w = (rv[t8 * 8 + 6] & 0xFFFFu) | (rv[t8 * 8 + 7] << 16);
                        s1.x = (rv[t8 * 8 + 0] >> 16) | (rv[t8 * 8 + 1] & 0xFFFF0000u); s1.y = (rv[t8 * 8 + 2] >> 16) | (rv[t8 * 8 + 3] & 0xFFFF0000u); s1.z = (rv[t8 * 8 + 4] >> 16) | (rv[t8 * 8 + 5] & 0xFFFF0000u); s1.w = (rv[t8 * 8 + 6] >> 16) | (rv[t8 * 8 + 7] & 0xFFFF0000u);
                        *(u32x4*)(strip + t8 * 8) = s0; *(u32x4*)(strip + 64 + t8 * 8) = s1; }
                }
            }
            if (!lastl) for (int tok = NLAT + bid; tok < NTOK; tok += G) {
                const int t = (tok - NLAT) & (CTXL - 1); const bool hasL = (t != 0), hasR = (t != CTXL - 1); const bf16_t* pr = P + (size_t)tok * LDP;
                const bf16_t* prL = hasL ? pr - LDP : pr; const bf16_t* prR = hasR ? pr + LDP : pr;
                unsigned xc[3], xl[3], xr[3];
#pragma unroll
                for (int j = 0; j < 3; ++j) { const int cc = tid + j * 512; xc[j] = pr[HY_OFF + cc]; xl[j] = prL[HY_OFF + cc]; xr[j] = prR[HY_OFF + cc]; }
#pragma unroll
                for (int j = 0; j < 3; ++j) { const int cc = tid + j * 512;
                    float acc = hcb[cc] + hcw[1536 + cc] * __uint_as_float(xc[j] << 16);
                    acc += hasL ? hcw[cc] * __uint_as_float(xl[j] << 16) : 0.f;
                    acc += hasR ? hcw[2 * 1536 + cc] * __uint_as_float(xr[j] << 16) : 0.f;
                    U[(size_t)tok * 1536 + cc] = acc; }
            }
            for (int idx0 = bid * NTHR + tid; idx0 < 16384 * 64; idx0 += 4 * G * NTHR) { u32x4 t4[4];
#pragma unroll
                for (int q = 0; q < 4; ++q) { const int idx = idx0 + q * G * NTHR; const int half = idx & 1, g = (idx >> 1) & 31, tok = idx >> 6;
                    if (idx < 16384 * 64) t4[q] = *(const u32x4*)(P + (size_t)tok * LDP + S5_OFF + g * 16 + half * 8); }
#pragma unroll
                for (int q = 0; q < 4; ++q) { const int idx = idx0 + q * G * NTHR; const int half = idx & 1, g = (idx >> 1) & 31, tok = idx >> 6;
                    if (idx < 16384 * 64) *(u32x4*)(S5A + ((size_t)g * 512 + (tok >> 5)) * 768 + (tok & 31) * 16 + half * 8) = t4[q]; } }
            for (int idx = bid * NTHR + tid; idx < 32 * 512 * 32 * 2; idx += G * NTHR) { const int half = idx & 1, sI = (idx >> 1) & 31, row = (idx >> 6) & 511, g = idx >> 15; const int t = row >> 4, c = row & 15; const int lag = t - sI;
                float v[8];
                if (lag > 0) { const float4* k4 = (const float4*)(KTB + ((size_t)((g * 2 + 0) * 32 + lag) * 16 + c) * 16 + half * 8); const float4 a0 = k4[0], a1 = k4[1]; v[0] = a0.x; v[1] = a0.y; v[2] = a0.z; v[3] = a0.w; v[4] = a1.x; v[5] = a1.y; v[6] = a1.z; v[7] = a1.w; }
                else if (lag < 0) { const float4* k4 = (const float4*)(KTB + ((size_t)((g * 2 + 1) * 32 - lag) * 16 + c) * 16 + half * 8); const float4 a0 = k4[0], a1 = k4[1]; v[0] = a0.x; v[1] = a0.y; v[2] = a0.z; v[3] = a0.w; v[4] = a1.x; v[5] = a1.y; v[6] = a1.z; v[7] = a1.w; }
                else { const float4* k4 = (const float4*)(KTB + ((size_t)((g * 2 + 0) * 32) * 16 + c) * 16 + half * 8); const float4* q4 = (const float4*)(KTB + ((size_t)((g * 2 + 1) * 32) * 16 + c) * 16 + half * 8); const float4 a0 = k4[0], a1 = k4[1], b0 = q4[0], b1 = q4[1];
                    v[0] = a0.x + b0.x; v[1] = a0.y + b0.y; v[2] = a0.z + b0.z; v[3] = a0.w + b0.w; v[4] = a1.x + b1.x; v[5] = a1.y + b1.y; v[6] = a1.z + b1.z; v[7] = a1.w + b1.w; }
                u32x4 w; w.x = pk2(v[0], v[1]); w.y = pk2(v[2], v[3]); w.z = pk2(v[4], v[5]); w.w = pk2(v[6], v[7]);
                *(u32x4*)(S5B + ((size_t)g * 512 + row) * 768 + sI * 16 + half * 8) = w; }
            for (int idx = bid * NTHR + tid; idx < 32 * 512 * 64; idx += G * NTHR) { const int n = idx & 63, row = (idx >> 6) & 511, g = idx >> 15; const int t = row >> 4, c = row & 15;
                const float cr = (PT(29) + l * 32 * 16 * 64)[(g * 16 + c) * 64 + n], ci = (PT(30) + l * 32 * 16 * 64)[(g * 16 + c) * 64 + n];
                const float2 af = APW[((0 * 32 + g) * 64 + n) * 33 + t + 1], ab = APW[((1 * 32 + g) * 64 + n) * 33 + 32 - t];
                bf16_t* d = S5B + ((size_t)g * 512 + row) * 768 + 512 + 2 * n;
                *(unsigned*)d = pk2(cr * af.x - ci * af.y, -(cr * af.y + ci * af.x)); *(unsigned*)(d + 128) = pk2(cr * ab.x - ci * ab.y, -(cr * ab.y + ci * ab.x)); }
            for (int idx = bid * NTHR + tid; idx < 32 * 2 * 64 * 32; idx += G * NTHR) { const int sI = idx & 31, n = (idx >> 5) & 63, dir = (idx >> 11) & 1, g = idx >> 12; const int pi = (dir * 32 + g) * 64 + n;
                const float2 pw = APW[pi * 33 + (dir ? sI : 31 - sI)]; const float4* bb = (const float4*)(BBT + pi * 16);
                float re[16], im[16];
#pragma unroll
                for (int j = 0; j < 8; ++j) { const float4 b2 = bb[j]; re[2 * j] = pw.x * b2.x - pw.y * b2.y; im[2 * j] = pw.x * b2.y + pw.y * b2.x; re[2 * j + 1] = pw.x * b2.z - pw.y * b2.w; im[2 * j + 1] = pw.x * b2.w + pw.y * b2.z; }
                bf16_t* d = S5P + ((size_t)g * 256 + dir * 128 + 2 * n) * 512 + sI * 16;
                u32x4 w0, w1; w0.x = pk2(re[0], re[1]); w0.y = pk2(re[2], re[3]); w0.z = pk2(re[4], re[5]); w0.w = pk2(re[6], re[7]); w1.x = pk2(re[8], re[9]); w1.y = pk2(re[10], re[11]); w1.z = pk2(re[12], re[13]); w1.w = pk2(re[14], re[15]);
                *(u32x4*)d = w0; *(u32x4*)(d + 8) = w1;
                w0.x = pk2(im[0], im[1]); w0.y = pk2(im[2], im[3]); w0.z = pk2(im[4], im[5]); w0.w = pk2(im[6], im[7]); w1.x = pk2(im[8], im[9]); w1.y = pk2(im[10], im[11]); w1.z = pk2(im[12], im[13]); w1.w = pk2(im[14], im[15]);
                *(u32x4*)(d + 512) = w0; *(u32x4*)(d + 520) = w1; }
            {   float* T = sf;
                for (int unit = bid; unit < 4 * 64 * 24; unit += G) { const int b = unit / (64 * 24), r = (unit / 24) % 64, c0 = (unit % 24) * 64; const size_t tok0 = (size_t)b * SEQ + r * 64;
                    __syncthreads();
#pragma unroll
                    for (int i = 0; i < 8; ++i) { const int c = tid & 63, t = (tid >> 6) + 8 * i; T[t * 65 + c] = bf2f(P[(tok0 + t) * LDP + HY_OFF + c0 + c]); }
                    __syncthreads();
                    const int c = tid >> 3, tq = (tid & 7) * 8, cc = c0 + c; const float w0 = hcw[cc], w1 = hcw[1536 + cc], w2 = hcw[3072 + cc], bb = hcb[cc];
                    float o8[8];
#pragma unroll
                    for (int i = 0; i < 8; ++i) { const int t = tq + i; float acc = bb + w1 * T[t * 65 + c]; if (t > 0) acc += w0 * T[(t - 1) * 65 + c]; if (t < 63) acc += w2 * T[(t + 1) * 65 + c]; o8[i] = acc; }
                    float* dst = UT + ((size_t)b * 1536 + cc) * SEQ + r * 64 + tq;
                    *(float4*)dst = make_float4(o8[0], o8[1], o8[2], o8[3]); *(float4*)(dst + 4) = make_float4(o8[4], o8[5], o8[6], o8[7]);
                } }
            if (!lastl) {
                const int L = CTXL; const float* HR = HRAW + (size_t)SEQ * 2048; float* K2 = K2C; const float* nrm = NORM + (size_t)(l * 2 + 1) * 1024;
                const size_t total = (size_t)(2 * L - 1) * 1024;
                for (size_t i = (size_t)bid * NTHR + tid; i < total; i += (size_t)G * NTHR) { const int j = (int)(i >> 10), oc = (int)(i & 1023), o = oc >> 9, c = oc & 511; const int lag = j - (L - 1);
                    const float v = lag >= 0 ? HR[(size_t)lag * 2048 + o * 1024 + c] : HR[(size_t)(-lag) * 2048 + o * 1024 + 512 + c];
                    K2[((size_t)j * 2 + o) * 512 + c] = v / nrm[oc]; }
            }
            {   __syncthreads(); fft_twiddles((float2*)(shm + FFT_X_BYTES), tid);
                for (int oc = bid; oc < 1024; oc += G) hyena_spec_item(oc, HRAW, NORM + (size_t)(l * 2 + 0) * 1024, HSPEC, shm, tid);
                __syncthreads(); }
            SEAM(PB + 2);
        }

        if (IN(PB + 3)) for (int rep_ = 0; rep_ < PROBE_REPS(3); ++rep_) {
            PH_BEGIN
            if (rep_ > 0) { if (bid == 0 && tid == 0) __hip_atomic_store(QCTR + l * 64, 0, __ATOMIC_RELAXED, __HIP_MEMORY_SCOPE_AGENT); xcd_barrier(bar); }
            if (bid < 64) {
                mlstm_state_pass(bid >> 1, bid & 1, P, KTG, VTG, PT(22) + l * 16, CST, NST, MST, shm, tid);
            } else if (bid < 128) {
                { const int ch = bid - 64; const int dir_ = ch & 1, h_ = (ch >> 1) & 7; ssd_state_pass(ch, P, BTG, XTG, -expf(PT(37)[l * 16 + dir_ * 8 + h_]), PT(36)[l * 16 + dir_ * 8 + h_], SSTB, shm, tid); }
            } else if (bid < 160) {
                const int widx = (bid - 128) * 8 + wave; const int dir = widx & 1, g = (widx >> 1) & 31, b = widx >> 6; const int n = lane;
                float2* xb = (float2*)(shm + (size_t)wave * 16640); float2* ctab = xb + 16 * 65;
                const float* a_re = PT(24) + l * 2 * 32 * 64; const float* a_im = PT(25) + l * 2 * 32 * 64; const float* log_dt = PT(26) + l * 64;
                const float* b_re = PT(27) + l * 32 * 64 * 16; const float* b_im = PT(28) + l * 32 * 64 * 16; const float* c_re = PT(29) + l * 32 * 16 * 64; const float* c_im = PT(30) + l * 32 * 16 * 64;
#pragma unroll
                for (int c = 0; c < 16; ++c) ctab[c * 65 + lane] = make_float2(c_re[(g * 16 + c) * 64 + lane], c_im[(g * 16 + c) * 64 + lane]);
                float abr, abi, bbr[16], bbi[16];
                {   const double are = (double)a_re[(dir * 32 + g) * 64 + n], aim = (double)a_im[(dir * 32 + g) * 64 + n];
                    const double lam = are < -1e-4 ? are : -1e-4; const double dt = exp((double)log_dt[dir * 32 + g]);
                    const double mag = exp(lam * dt); const double ar = mag * cos(aim * dt), ai = mag * sin(aim * dt);
                    const double den = lam * lam + aim * aim; const double nr = ar - 1.0, ni = ai;
                    const double fre = (nr * lam + ni * aim) / den, fim = (ni * lam - nr * aim) / den;
                    abr = (float)ar; abi = (float)ai;
#pragma unroll
                    for (int c = 0; c < 16; ++c) { const double br = (double)b_re[(g * 64 + n) * 16 + c], bi = (double)b_im[(g * 64 + n) * 16 + c]; bbr[c] = (float)(fre * br - fim * bi); bbi[c] = (float)(fre * bi + fim * br); }
                }
                float xr = 0.f, xi = 0.f; float* Sout = (dir ? SB : SF) - (size_t)NLAT * BW;
                const int s = lane >> 2, cg = lane & 3;
                for (int i0 = 0; i0 < CTXL; i0 += 16) {
#pragma unroll 4
                    for (int ss = 0; ss < 16; ++ss) {
                        const size_t tok = (size_t)step_tok(b, dir, i0 + ss);
                        const u32x4* up = (const u32x4*)(P + tok * LDP + S5_OFF + g * 16);
                        float t0[8], t1[8]; unpack8(up[0], t0); unpack8(up[1], t1);
                        float bur = 0.f, bui = 0.f;
#pragma unroll
                        for (int c = 0; c < 8; ++c) { bur += t0[c] * bbr[c] + t1[c] * bbr[8 + c]; bui += t0[c] * bbi[c] + t1[c] * bbi[8 + c]; }
                        const float nxr = abr * xr - abi * xi + bur, nxi = abr * xi + abi * xr + bui; xr = nxr; xi = nxi;
                        xb[ss * 65 + lane] = make_float2(xr, xi);
                    }
                    asm volatile("s_waitcnt lgkmcnt(0)" ::: "memory");
                    float y0 = 0.f, y1 = 0.f, y2 = 0.f, y3 = 0.f;
                    for (int nn2 = 0; nn2 < 64; ++nn2) { const float2 xv = xb[s * 65 + nn2];
                        const float2 c0 = ctab[(cg * 4 + 0) * 65 + nn2], c1 = ctab[(cg * 4 + 1) * 65 + nn2], c2 = ctab[(cg * 4 + 2) * 65 + nn2], c3 = ctab[(cg * 4 + 3) * 65 + nn2];
                        y0 += xv.x * c0.x - xv.y * c0.y; y1 += xv.x * c1.x - xv.y * c1.y; y2 += xv.x * c2.x - xv.y * c2.y; y3 += xv.x * c3.x - xv.y * c3.y; }
                    const size_t toks = (size_t)step_tok(b, dir, i0 + s);
                    *(float4*)(Sout + toks * BW + g * 16 + cg * 4) = make_float4(y0, y1, y2, y3);
                    asm volatile("s_waitcnt lgkmcnt(0)" ::: "memory");
                }
                XCTX[((b * 32 + g) * 2 + dir) * 64 + n] = make_float2(xr, xi);
            } else {
                if (bid < 224) {
                    pg8::Gemm gg_{S5A, S5P, 768, 512, 512}; pg8::SchedS5a S_{bid - 160}; pg8::EpiXloc E_{XLOC};
                    pg8::gemm_phase((LAS unsigned char*)shm, gg_, S_, E_);
                    __syncthreads();
                }
                const int nhb = G - 160, hb = bid - 160; const float* bias = PT(19) + l * 1024; const int c = tid;
                const int nitems = lastl ? 0 : 4 * (CTXL / 8);
                for (int it = hb; it < nitems; it += nhb) {
                    int L, tokbase, b, t0; const float* K2;
                    { const int q = it; L = CTXL; tokbase = NLAT; b = q / (CTXL / 8); t0 = (q % (CTXL / 8)) * 8; K2 = K2C; }
                    const float* zb = U + (size_t)(tokbase + b * L) * 1536 + c;
                    float acc[8];
#pragma unroll
                    for (int i = 0; i < 8; ++i) acc[i] = 0.f;
                    const int base = t0 + L - 1;
                    for (int s = 0; s < L; s += 8) {
                        float k[15];
#pragma unroll
                        for (int mm = 0; mm < 15; ++mm) k[mm] = K2[((size_t)(base - s - 7 + mm) * 2 + 0) * 512 + c];
#pragma unroll
                        for (int ds = 0; ds < 8; ++ds) { const float z = zb[(size_t)(s + ds) * 1536];
#pragma unroll
                            for (int i = 0; i < 8; ++i) acc[i] += k[i - ds + 7] * z; }
                    }
#pragma unroll
                    for (int i = 0; i < 8; ++i) { const size_t tok = (size_t)(tokbase + b * L + t0 + i); const float zt = U[tok * 1536 + c]; Z[tok * BW + c] = (acc[i] + bias[c] * zt) * U[tok * 1536 + 512 + c]; }
                }
            }
            {   __syncthreads(); fft_twiddles((float2*)(shm + FFT_X_BYTES), tid);
                int* qslot = (int*)(shm + FFT_X_BYTES + 65536);
                for (;;) { __syncthreads(); if (tid == 0) *qslot = atomicAdd(QCTR + l * 64, 1); __syncthreads(); const int it = *qslot; if (it >= 1024) break;
                    hyena_fft_item(it, UT, HSPEC, PT(19) + l * 1024, YT, shm, tid); }
            }
            SEAM(PB + 3);
        }

        if (IN(PB + 4)) for (int rep_ = 0; rep_ < PROBE_REPS(4); ++rep_) {
            PH_BEGIN
            if (rep_ > 0) { if (bid == 0 && tid == 0) __hip_atomic_store(QCTR + l * 64 + 32, 0, __ATOMIC_RELAXED, __HIP_MEMORY_SCOPE_AGENT); xcd_barrier(bar); }
            if (bid >= G - 32) for (int idx = (bid - (G - 32)) * NTHR + tid; idx < 16384; idx += 32 * NTHR) { const int n = idx & 63, dir = (idx >> 6) & 1, b = (idx >> 7) & 3, g = idx >> 9;
                const float2 a32 = APW[((dir * 32 + g) * 64 + n) * 33 + 32]; float2 X = XCTX[((b * 32 + g) * 2 + dir) * 64 + n];
                const float* __restrict__ xl = XLOC + ((size_t)g * 512 + b * 128) * 256 + dir * 128 + 2 * n; bf16_t* __restrict__ dst = S5A + ((size_t)g * 512 + b * 128) * 768 + 512 + dir * 128 + 2 * n;
#pragma unroll 1
                for (int j0 = 0; j0 < 128; j0 += 16) { float2 xv[16];
#pragma unroll
                    for (int q = 0; q < 16; ++q) { const int j = dir ? 127 - (j0 + q) : j0 + q; xv[q] = *(const float2*)(xl + (size_t)j * 256); }
#pragma unroll
                    for (int q = 0; q < 16; ++q) { const int j = dir ? 127 - (j0 + q) : j0 + q;
                        *(unsigned*)(dst + (size_t)j * 768) = pk2(X.x, X.y);
                        const float nx = a32.x * X.x - a32.y * X.y + xv[q].x, ny = a32.x * X.y + a32.y * X.x + xv[q].y; X.x = nx; X.y = ny; } } }
            {   int* qslot = (int*)(shm + 102400);
                __syncthreads(); if (tid == 0) *qslot = atomicAdd(QCTR + l * 64 + 32, 1); __syncthreads();
                for (;;) { const int it = *qslot; if (it >= 32 * 68 + 64 * 68) break;
                    int nxt_ = 0; if (tid == 0) nxt_ = atomicAdd(QCTR + l * 64 + 32, 1);
                    if (it < 32 * 68) { const int chain = it / 68, c = it % 68; mlstm_out_item(chain, c, P, QKB, VTG, PT(22) + l * 16, CST, NST, MST, (chain & 1) ? HBk : HF, shm, tid); }
                    else { const int i2 = it - 32 * 68; const int chain = i2 / 68, c = i2 % 68; const int dir_ = chain & 1, h_ = (chain >> 1) & 7;
                        ssd_out_item(chain, c, P, XBC, XTG, -expf(PT(37)[l * 16 + dir_ * 8 + h_]), PT(36)[l * 16 + dir_ * 8 + h_], SSTB, dir_ ? YB : YF, shm, tid); }
                    __syncthreads(); if (tid == 0) *qslot = nxt_; __syncthreads(); }
            }
            __syncthreads();
            {   const float* bias = PT(19) + l * 1024 + 512; const int c = tid;
                const int nitems = lastl ? 0 : 4 * (CTXL / 8);
                for (int it = bid; it < nitems; it += G) {
                    int L, tokbase, b, t0; const float* K2;
                    { const int q = it; L = CTXL; tokbase = NLAT; b = q / (CTXL / 8); t0 = (q % (CTXL / 8)) * 8; K2 = K2C; }
                    const float* zb = Z + (size_t)(tokbase + b * L) * BW + c;
                    float acc[8];
#pragma unroll
                    for (int i = 0; i < 8; ++i) acc[i] = 0.f;
                    const int base = t0 + L - 1;
                    for (int s = 0; s < L; s += 8) {
                        float k[15];
#pragma unroll
                        for (int mm = 0; mm < 15; ++mm) k[mm] = K2[((size_t)(base - s - 7 + mm) * 2 + 1) * 512 + c];
#pragma unroll
                        for (int ds = 0; ds < 8; ++ds) { const float z = zb[(size_t)(s + ds) * BW];
#pragma unroll
                            for (int i = 0; i < 8; ++i) acc[i] += k[i - ds + 7] * z; }
                    }
#pragma unroll
                    for (int i = 0; i < 8; ++i) { const size_t tok = (size_t)(tokbase + b * L + t0 + i); const float zt = Z[tok * BW + c]; Y4[tok * DM + c] = f2bf((acc[i] + bias[c] * zt) * U[tok * 1536 + 1024 + c]); }
                }
            }
            SEAM(PB + 4);
        }

        if (IN(PB + 5)) for (int rep_ = 0; rep_ < PROBE_REPS(5); ++rep_) {
            PH_BEGIN
            const float* ml_norm = PT(23) + l * BW; const float* ssd_d = PT(38) + l * 8; const float* ssd_norm = PT(39) + l * BW; const float* s5_d = PT(31) + l * BW;
            if (bid < 128) {
                pg8::Gemm gg_{S5A, S5B, 768, 768, 768}; pg8::SchedS5b S_{bid}; pg8::EpiS5Out E_{P, s5_d, GG};
                pg8::gemm_phase((LAS unsigned char*)shm, gg_, S_, E_);
                __syncthreads();
            }
            for (int tok = bid * 8 + wave; tok < NTOK; tok += G * 8) {
                const int c0 = lane * 8; const bf16_t* pr = P + (size_t)tok * LDP; const size_t o5 = (size_t)tok * BW + c0;
                float hm[8], ys[8];
                const u32x4 ooq = *(const u32x4*)(pr + ML_OFF + 1536 + c0);
                const float4 g0 = *(const float4*)(ml_norm + c0), g1 = *(const float4*)(ml_norm + c0 + 4), n0 = *(const float4*)(ssd_norm + c0), n1 = *(const float4*)(ssd_norm + c0 + 4);
                { float fa[8], fb[8]; unpack8(*(const u32x4*)(HF + o5), fa); unpack8(*(const u32x4*)(HBk + o5), fb);
#pragma unroll
                  for (int j = 0; j < 8; ++j) hm[j] = fa[j] + fb[j]; }
                { float ya[8], yb[8]; unpack8(*(const u32x4*)(YF + o5), ya); unpack8(*(const u32x4*)(YB + o5), yb);
                  float xx[8], zz[8]; unpack8(*(const u32x4*)(XBC + (size_t)tok * 1024 + c0), xx); unpack8(*(const u32x4*)(pr + SSD_OFF + c0), zz); const float dsk = ssd_d[c0 >> 6];
#pragma unroll
                  for (int j = 0; j < 8; ++j) ys[j] = ya[j] + yb[j];
#pragma unroll
                  for (int j = 0; j < 8; ++j) ys[j] = (ys[j] + dsk * xx[j]) * siluf_(zz[j]); }
                float s1 = 0.f, s2 = 0.f;
#pragma unroll
                for (int j = 0; j < 8; ++j) { s1 += hm[j] * hm[j]; s2 += ys[j] * ys[j]; }
                s1 += __shfl_xor(s1, 1); s1 += __shfl_xor(s1, 2); s1 += __shfl_xor(s1, 4); s1 += __shfl_xor(s1, 8);
                s2 = wave_sum(s2);
                const float r1 = rsqrtf(s1 * (1.0f / 128.0f) + 1e-6f), r2 = rsqrtf(s2 * (1.0f / BW) + 1e-6f);
                float oo[8]; unpack8(ooq, oo);
                const float gm[8] = {g0.x, g0.y, g0.z, g0.w, g1.x, g1.y, g1.z, g1.w}, gs[8] = {n0.x, n0.y, n0.z, n0.w, n1.x, n1.y, n1.z, n1.w};
                u32x4 w;
                w.x = pk2(hm[0] * r1 * gm[0] * sigmoidf_(oo[0]), hm[1] * r1 * gm[1] * sigmoidf_(oo[1])); w.y = pk2(hm[2] * r1 * gm[2] * sigmoidf_(oo[2]), hm[3] * r1 * gm[3] * sigmoidf_(oo[3]));
                w.z = pk2(hm[4] * r1 * gm[4] * sigmoidf_(oo[4]), hm[5] * r1 * gm[5] * sigmoidf_(oo[5])); w.w = pk2(hm[6] * r1 * gm[6] * sigmoidf_(oo[6]), hm[7] * r1 * gm[7] * sigmoidf_(oo[7]));
                *(u32x4*)(Y4 + (size_t)tok * DM + 512 + c0) = w;
                w.x = pk2(ys[0] * r2 * gs[0], ys[1] * r2 * gs[1]); w.y = pk2(ys[2] * r2 * gs[2], ys[3] * r2 * gs[3]); w.z = pk2(ys[4] * r2 * gs[4], ys[5] * r2 * gs[5]); w.w = pk2(ys[6] * r2 * gs[6], ys[7] * r2 * gs[7]);
                *(u32x4*)(Y4 + (size_t)tok * DM + 1536 + c0) = w;
                if (tok >= NLAT) { const size_t oc = (size_t)(tok - NLAT) * BW + c0; float uu[8]; unpack8(*(const u32x4*)(pr + S5_OFF + c0), uu);
                    const float4 a0 = *(const float4*)(SF + oc), a1 = *(const float4*)(SF + oc + 4), b0 = *(const float4*)(SB + oc), b1 = *(const float4*)(SB + oc + 4), d0 = *(const float4*)(s5_d + c0), d1 = *(const float4*)(s5_d + c0 + 4);
                    float y[8] = {a0.x + b0.x + d0.x * uu[0], a0.y + b0.y + d0.y * uu[1], a0.z + b0.z + d0.z * uu[2], a0.w + b0.w + d0.w * uu[3], a1.x + b1.x + d1.x * uu[4], a1.y + b1.y + d1.y * uu[5], a1.z + b1.z + d1.z * uu[6], a1.w + b1.w + d1.w * uu[7]};
#pragma unroll
                    for (int j = 0; j < 8; ++j) y[j] = 0.5f * y[j] * (1.0f + tanhf(0.7978845608028654f * (y[j] + 0.044715f * y[j] * y[j] * y[j])));
                    w.x = pk2(y[0], y[1]); w.y = pk2(y[2], y[3]); w.z = pk2(y[4], y[5]); w.w = pk2(y[6], y[7]);
                    *(u32x4*)(GG + (size_t)tok * BW + c0) = w; }
            }
            __syncthreads();
            {   float* T = sf;
                for (int unit = (G > 128 ? bid - 128 : bid); unit >= 0 && unit < 4 * 64 * 8; unit += (G > 128 ? G - 128 : G)) { const int b = unit / 512, t0 = ((unit >> 3) & 63) * 64, c0 = (unit & 7) * 64;
                    __syncthreads();
#pragma unroll
                    for (int i = 0; i < 8; ++i) { const int t = tid & 63, c = (tid >> 6) + 8 * i; T[c * 65 + t] = YT[((size_t)b * 512 + c0 + c) * SEQ + t0 + t]; }
                    __syncthreads();
                    const int t = tid >> 3, cq = (tid & 7) * 8;
                    u32x4 w; w.x = pk2(T[(cq + 0) * 65 + t], T[(cq + 1) * 65 + t]); w.y = pk2(T[(cq + 2) * 65 + t], T[(cq + 3) * 65 + t]); w.z = pk2(T[(cq + 4) * 65 + t], T[(cq + 5) * 65 + t]); w.w = pk2(T[(cq + 6) * 65 + t], T[(cq + 7) * 65 + t]);
                    *(u32x4*)(Y4 + ((size_t)b * SEQ + t0 + t) * DM + c0 + cq) = w;
                } }
            SEAM(PB + 5);
        }

        if (IN(PB + 6)) for (int rep_ = 0; rep_ < PROBE_REPS(6); ++rep_) {
            PH_BEGIN
            pg8::Gemm g{GG, GLU, BW, BW, BW}; pg8::SchedStd S{68, 2, G, bid, BW, BW}; pg8::EpiGlu E{GG, PT(33) + l * BW, Y4};
            pg8::gemm_phase((LAS unsigned char*)shm, g, S, E);
            SEAM(PB + 6);
        }
        if (IN(PB + 7)) for (int rep_ = 0; rep_ < PROBE_REPS(7); ++rep_) {
            PH_BEGIN
            pg8::Gemm g{Y4, WBR, DM, BW, BW}; pg8::SchedBranch S{64, 8, G, bid}; pg8::EpiBranch E{P, ACCb};
            pg8::gemm_phase((LAS unsigned char*)shm, g, S, E);
            if (!lastl) { __syncthreads(); pg8::SchedTail S2{G, bid}; pg8::EpiPart E2{P, (float*)HSPEC}; pg8::gemm_phase((LAS unsigned char*)shm, g, S2, E2); }
            SEAM(PB + 7);
        }
        if (IN(PB + 8)) for (int rep_ = 0; rep_ < PROBE_REPS(8); ++rep_) {
            PH_BEGIN
            if (!lastl) {
                const float* PART = (const float*)HSPEC;
                for (int idx = bid * NTHR + tid; idx < (NTOK - NLAT) * DM / 8; idx += G * NTHR) { const size_t o = (size_t)idx * 8; f32x4 p[4][2];
#pragma unroll
                    for (int k = 0; k < 4; ++k) { p[k][0] = *(const f32x4*)(PART + (size_t)k * (NTOK - NLAT) * DM + o); p[k][1] = *(const f32x4*)(PART + (size_t)k * (NTOK - NLAT) * DM + o + 4); }
                    const f32x4 s0 = ((p[0][0] + p[1][0]) + p[2][0]) + p[3][0], s1 = ((p[0][1] + p[1][1]) + p[2][1]) + p[3][1];
                    u32x4 w; w.x = pk2(s0[0], s0[1]); w.y = pk2(s0[2], s0[3]); w.z = pk2(s1[0], s1[1]); w.w = pk2(s1[2], s1[3]);
                    *(u32x4*)(ACCb + (size_t)NLAT * DM + o) = w; }
                xcd_barrier(bar);
            }
            pg8::Gemm g{ACCb, WOUT, DM, DM, DM}; pg8::SchedStd S{64, 8, G, bid, DM, DM}; pg8::EpiResid E{XS, l == 0 ? x_in : (const float*)XS, l == 0 ? ctx_in - (size_t)NLAT * DM : (const float*)XS, MODl, 2};
            pg8::gemm_phase((LAS unsigned char*)shm, g, S, E);
            if (!lastl) { __syncthreads(); pg8::Gemm g2{ACCb, WOUT, DM, DM, 512}; pg8::SchedTailK S2{G, bid}; pg8::EpiPartK E2{(float*)HSPEC + (size_t)4 * (NTOK - NLAT) * DM}; pg8::gemm_phase((LAS unsigned char*)shm, g2, S2, E2); }
            SEAM(PB + 8);
        }
        if (IN(PB + 9)) for (int rep_ = 0; rep_ < PROBE_REPS(9); ++rep_) {
            PH_BEGIN
            if (!lastl) {
                const float* PART = (const float*)HSPEC + (size_t)4 * (NTOK - NLAT) * DM; const float* mg = MODl + (size_t)(4 * 6 + 2) * DM;
                const float* src = l == 0 ? ctx_in : (const float*)XS + (size_t)NLAT * DM;
                for (int idx = bid * NTHR + tid; idx < (NTOK - NLAT) * DM / 4; idx += G * NTHR) { const size_t o = (size_t)idx * 4; const int col = (int)(o & (DM - 1));
                    const f32x4 p0 = *(const f32x4*)(PART + o), p1 = *(const f32x4*)(PART + (size_t)(NTOK - NLAT) * DM + o), p2 = *(const f32x4*)(PART + (size_t)2 * (NTOK - NLAT) * DM + o), p3 = *(const f32x4*)(PART + (size_t)3 * (NTOK - NLAT) * DM + o);
                    const f32x4 sv = *(const f32x4*)(src + o), gm = *(const f32x4*)(mg + col);
                    *(f32x4*)(XS + (size_t)NLAT * DM + o) = sv + gm * (((p0 + p1) + p2) + p3); }
                xcd_barrier(bar);
            }
            for (int i = bid * NTHR + tid; i < NEXP * MOE_PAD; i += G * NTHR) ROWTOK[i] = -1;
            for (int i = bid * NTHR + tid; i < NTOK * 16; i += G * NTHR) INV[i] = -1;
            const float* wr = PT(42) + (size_t)l * DM * 16; const float* gn = norm_ffn + l * DM;
            for (int tok0 = (bid * 8 + wave) * 4; tok0 < M2; tok0 += G * 32) {
                const int r = tok0 < NLAT ? tok0 / SEQ : 4; const float* xr = XS + (size_t)tok0 * DM;
                const float* sh = MODl + (size_t)(r * 6 + 3) * DM; const float* sc = MODl + (size_t)(r * 6 + 4) * DM;
                float rs[4];
#pragma unroll
                for (int tk = 0; tk < 4; ++tk) { float ss = 0.f;
#pragma unroll 4
                    for (int i = 0; i < 8; ++i) { const float4 t4 = *(const float4*)(xr + (size_t)tk * DM + i * 256 + lane * 4); ss += t4.x * t4.x + t4.y * t4.y + t4.z * t4.z + t4.w * t4.w; }
                    ss = wave_sum(ss); rs[tk] = rsqrtf(ss * (1.0f / DM) + 1e-6f); }
                float lg[4][16];
#pragma unroll
                for (int tk = 0; tk < 4; ++tk)
#pragma unroll
                    for (int e = 0; e < 16; ++e) lg[tk][e] = 0.f;
#pragma unroll 1
                for (int i = 0; i < 8; ++i) { const int d = i * 256 + lane * 4;
                    const float4 g4 = *(const float4*)(gn + d), s4 = *(const float4*)(sc + d), h4 = *(const float4*)(sh + d);
                    float4 xq[4], ww[16];
#pragma unroll
                    for (int tk = 0; tk < 4; ++tk) xq[tk] = *(const float4*)(xr + (size_t)tk * DM + d);
                    const float4* wq = (const float4*)(wr + (size_t)d * 16);
#pragma unroll
                    for (int q = 0; q < 16; ++q) ww[q] = wq[q];
                    float hv[4][4];
#pragma unroll
                    for (int tk = 0; tk < 4; ++tk) { const float4 xv = xq[tk]; const float rr = rs[tk];
                        hv[tk][0] = xv.x * rr * g4.x * (1.f + s4.x) + h4.x; hv[tk][1] = xv.y * rr * g4.y * (1.f + s4.y) + h4.y; hv[tk][2] = xv.z * rr * g4.z * (1.f + s4.z) + h4.z; hv[tk][3] = xv.w * rr * g4.w * (1.f + s4.w) + h4.w;
                        u32x2 w; w.x = pk2(hv[tk][0], hv[tk][1]); w.y = pk2(hv[tk][2], hv[tk][3]); *(u32x2*)(HB + (size_t)(tok0 + tk) * DM + d) = w; }
#pragma unroll
                    for (int q = 0; q < 4; ++q) { const float4 w0 = ww[q * 4 + 0], w1 = ww[q * 4 + 1], w2 = ww[q * 4 + 2], w3 = ww[q * 4 + 3];
#pragma unroll
                        for (int tk = 0; tk < 4; ++tk) { const float hq = hv[tk][q];
                            lg[tk][0] += hq * w0.x; lg[tk][1] += hq * w0.y; lg[tk][2] += hq * w0.z; lg[tk][3] += hq * w0.w; lg[tk][4] += hq * w1.x; lg[tk][5] += hq * w1.y; lg[tk][6] += hq * w1.z; lg[tk][7] += hq * w1.w;
                            lg[tk][8] += hq * w2.x; lg[tk][9] += hq * w2.y; lg[tk][10] += hq * w2.z; lg[tk][11] += hq * w2.w; lg[tk][12] += hq * w3.x; lg[tk][13] += hq * w3.y; lg[tk][14] += hq * w3.z; lg[tk][15] += hq * w3.w; } } }
#pragma unroll
                for (int tk = 0; tk < 4; ++tk) { float mx = -1e30f;
#pragma unroll
                    for (int e = 0; e < 16; ++e) { lg[tk][e] = wave_sum(lg[tk][e]); mx = fmaxf(mx, lg[tk][e]); }
                    float sm = 0.f;
#pragma unroll
                    for (int e = 0; e < 16; ++e) { lg[tk][e] = expf(lg[tk][e] - mx); sm += lg[tk][e]; }
                    const float inv = 1.0f / sm;
                    if (lane == 0) {
#pragma unroll
                        for (int e = 0; e < 16; e += 4) *(float4*)(PROBS + (size_t)(tok0 + tk) * 16 + e) = make_float4(lg[tk][e] * inv, lg[tk][e + 1] * inv, lg[tk][e + 2] * inv, lg[tk][e + 3] * inv); } }
            }
            SEAM(PB + 9);
        }
        if (IN(PB + 10)) for (int rep_ = 0; rep_ < PROBE_REPS(10); ++rep_) {
            PH_BEGIN
            const int nitems = 64 + (lastl ? 0 : 64);
            unsigned long long* keys = (unsigned long long*)shm;
            for (int it = bid; it < nitems; it += G) {
                const int set = it >> 6, e = it & 15, b = (it >> 4) & 3;
                const int n = set ? CTXL : SEQ, cap = set ? 32 : 512, tokbase = set ? NLAT + b * CTXL : b * SEQ;
                __syncthreads();
                for (int i = tid; i < n; i += NTHR) keys[i] = ((unsigned long long)__float_as_uint(PROBS[(size_t)(tokbase + i) * 16 + e]) << 32) | (unsigned long long)(0xFFFFFFFFu - (unsigned)i);
                __syncthreads();
                for (int k = 2; k <= n; k <<= 1)
                    for (int j = k >> 1; j > 0; j >>= 1) {
                        for (int p = tid; p < (n >> 1); p += NTHR) { const int i = ((p & ~(j - 1)) << 1) | (p & (j - 1)); const int m = i | j;
                            const unsigned long long ka = keys[i], kb = keys[m]; const bool desc = ((i & k) == 0);
                            if ((ka < kb) == desc) { keys[i] = kb; keys[m] = ka; } }
                        __syncthreads();
                    }
                for (int r = tid; r < cap; r += NTHR) { const unsigned long long kk = keys[r]; const int row = e * MOE_PAD + (set ? 2048 + b * 32 + r : b * 512 + r);
                    const int tk_ = tokbase + (int)(0xFFFFFFFFu - (unsigned)(kk & 0xFFFFFFFFull)); ROWTOK[row] = tk_; ROWGATE[row] = __uint_as_float((unsigned)(kk >> 32)); INV[tk_ * 16 + e] = row; }
                for (int rb = 0; rb < cap; rb += 32) {
                    u32x4 t4[4][4];
#pragma unroll
                    for (int q = 0; q < 4; ++q) { const int r = rb + wave + 8 * q; const int tok = tokbase + (int)(0xFFFFFFFFu - (unsigned)(keys[r] & 0xFFFFFFFFull));
                        const u32x4* sp = (const u32x4*)(HB + (size_t)tok * DM);
#pragma unroll
                        for (int i = 0; i < 4; ++i) t4[q][i] = sp[i * 64 + lane]; }
#pragma unroll
                    for (int q = 0; q < 4; ++q) { const int r = rb + wave + 8 * q; const int row = e * MOE_PAD + (set ? 2048 + b * 32 + r : b * 512 + r);
                        u32x4* dp = (u32x4*)(XG + (size_t)row * DM);
#pragma unroll
                        for (int i = 0; i < 4; ++i) dp[i * 64 + lane] = t4[q][i]; } }
            }
            if (!lastl && G > 128 && bid >= 128) {
                const int n_win = 32 * 55, n_br = 4 * 64, n_out = 32 * 8, n_glu = 16, n_gu = 16 * 2 * 192; (void)n_gu;
                CV_RUN(l + 1, bid - 128, G - 128, n_win); (void)n_br; (void)n_out; (void)n_glu;
            }
            {   const int pad0 = lastl ? 2048 : MOE_ROWS, npad = MOE_PAD - pad0;
                for (int R = bid * 8 + wave; R < NEXP * npad; R += G * 8) { const int e = R / npad, rr = pad0 + R % npad; u32x4* dp = (u32x4*)(XG + ((size_t)e * MOE_PAD + rr) * DM);
#pragma unroll
                    for (int i = 0; i < 4; ++i) dp[i * 64 + lane] = (u32x4){0u, 0u, 0u, 0u}; } }
            SEAM(PB + 10);
        }
        if (IN(PB + 12)) for (int rep_ = 0; rep_ < PROBE_REPS(12); ++rep_) {
            PH_BEGIN
            pg8::Gemm g{XG, WGU, DM, DM, DM}; pg8::SchedMoe S{lastl ? 8 : 9, 12, G, bid, DM, DM, 2 * DEXP}; pg8::EpiMoe1 E{HID};
            pg8::gemm_phase((LAS unsigned char*)shm, g, S, E);
            SEAM(PB + 12);
        }
        if (IN(PB + 13)) for (int rep_ = 0; rep_ < PROBE_REPS(13); ++rep_) {
            PH_BEGIN
            pg8::Gemm g{HID, WD, DEXP, DEXP, DEXP}; pg8::SchedMoe S{lastl ? 8 : 9, 8, G, bid, DEXP, DEXP, DM}; pg8::EpiMoeY E{YEXP};
            pg8::gemm_phase((LAS unsigned char*)shm, g, S, E);
            SEAM(PB + 13);
        }

}

__global__ __launch_bounds__(NTHR, 2) void fwd(Args a) {
    extern __shared__ __attribute__((aligned(16))) unsigned char shm[];
    const int bid = blockIdx.x, G = gridDim.x;
    float* const sf = (float*)shm;
    volatile LAS unsigned* xbw = (volatile LAS unsigned*)((LAS unsigned char*)shm + (LDS_BYTES - 16));
    if (threadIdx.x == 0) { xbw[0] = 0u; xbw[1] = 0u; xbw[2] = 0u; xbw[3] = 0u; }
    const float** const ptab = (const float**)(shm + (LDS_BYTES - 16 - 512));
    if (threadIdx.x == 0) {
#pragma unroll
        for (int i = 0; i < 47; ++i) ptab[i] = a.in[i]; }
    __syncthreads();
    XcdBarrier bar = xcd_barrier_post((unsigned*)(a.ws + O_BAR), xbw);
    const int lo = a.ph_lo, hi = a.ph_hi;
    if (IN(0)) {
        PH_BEGIN
        {
            __syncthreads();
            for (int i = tid; i < 5 * DM; i += NTHR) { const int r = i >> 11, k = i & (DM - 1); const float v = r < 4 ? c_in[r * DM + k] : cctx_in[k]; sf[i] = siluf_(v); }
            __syncthreads();
            float* red = sf + 5 * DM;
            for (int unit = bid; unit < 2 * 96; unit += G) { const int l = unit / 96, j = (unit % 96) * 128 + (tid & 127), kq = tid >> 7;
                const float* w = ada_w + (size_t)l * DM * (6 * DM) + (size_t)(kq * 512) * (6 * DM) + j; const float* sv = sf + kq * 512;
                float a0 = 0.f, a1 = 0.f, a2 = 0.f, a3 = 0.f, a4 = 0.f;
#pragma unroll 8
                for (int k = 0; k < 512; ++k) { const float wv = w[(size_t)k * (6 * DM)]; a0 += sv[k] * wv; a1 += sv[DM + k] * wv; a2 += sv[2 * DM + k] * wv; a3 += sv[3 * DM + k] * wv; a4 += sv[4 * DM + k] * wv; }
                __syncthreads();
                { float* rp = red + (kq * 5) * 128 + (tid & 127); rp[0] = a0; rp[128] = a1; rp[256] = a2; rp[384] = a3; rp[512] = a4; }
                __syncthreads();
                if (tid < 128) { const float bb = ada_b[l * 6 * DM + j]; float* o = MOD + (size_t)l * 5 * 6 * DM + j;
#pragma unroll
                    for (int r = 0; r < 5; ++r) o[(size_t)r * 6 * DM] = ((red[(0 * 5 + r) * 128 + tid] + red[(1 * 5 + r) * 128 + tid]) + (red[(2 * 5 + r) * 128 + tid] + red[(3 * 5 + r) * 128 + tid])) + bb; }
            }
        }
    }

    layer_body<0>(a, bar, lo, hi, bid, G, shm, sf, ptab);
    layer_body<1>(a, bar, lo, hi, bid, G, shm, sf, ptab);
    if (IN(33)) {
        PH_BEGIN
        const float* gn = PT(46);
        for (int tok = bid * 8 + wave; tok < NLAT; tok += G * 8) {
            const float* xr = XS + (size_t)tok * DM; float4 v[8]; float ss = 0.f;
#pragma unroll
            for (int i = 0; i < 8; ++i) v[i] = *(const float4*)(xr + i * 256 + lane * 4);
            moe_combine(v, tok, lane, INV, ROWGATE, YEXP, MOD + (size_t)(1 * 5 + tok / SEQ) * 6 * DM + 5 * DM);
#pragma unroll
            for (int i = 0; i < 8; ++i) {                 ss += v[i].x * v[i].x + v[i].y * v[i].y + v[i].z * v[i].z + v[i].w * v[i].w; }
            ss = wave_sum(ss); const float rs = rsqrtf(ss * (1.0f / DM) + 1e-6f);
#pragma unroll
            for (int i = 0; i < 8; ++i) { const int d = i * 256 + lane * 4; const float4 g4 = *(const float4*)(gn + d);
                *(float4*)(a.out + (size_t)tok * DM + d) = make_float4(v[i].x * rs * g4.x, v[i].y * rs * g4.y, v[i].z * rs * g4.z, v[i].w * rs * g4.w); }
        }
    }
#undef IN
#undef SEAM
}


extern "C" void kernel_launch(void* const* d_in, const int* in_sizes, int n_in, void* d_out, int out_size, void* d_ws, size_t ws_size, hipStream_t stream) {
    static int grid = 0;
    if (grid == 0) {
        if (n_in != 47 || ws_size < WS_END) { fprintf(stderr, "kernel_launch: expected 47 inputs and >= %zu bytes of workspace; got %d, %zu\n", (size_t)WS_END, n_in, ws_size); grid = -1; return; }
        int dev = 0, cus = 0;
        if (hipGetDevice(&dev) != hipSuccess || hipDeviceGetAttribute(&cus, hipDeviceAttributeMultiprocessorCount, dev) != hipSuccess) { grid = -1; return; }
        if (hipFuncSetAttribute((const void*)fwd, hipFuncAttributeMaxDynamicSharedMemorySize, LDS_BYTES) != hipSuccess) { fprintf(stderr, "kernel_launch: hipFuncSetAttribute failed\n"); grid = -1; return; }
        int per_cu = 0;
        if (hipOccupancyMaxActiveBlocksPerMultiprocessor(&per_cu, (const void*)fwd, NTHR, LDS_BYTES) != hipSuccess || per_cu < 1) fprintf(stderr, "kernel_launch: occupancy query reports %d\n", per_cu);
        (void)hipGetLastError();
        grid = cus > 256 ? 256 : cus;
        if (grid < 224) { fprintf(stderr, "kernel_launch: needs >= 224 CUs (got %d)\n", grid); grid = -1; return; }
    }
    if (grid < 0) return;
    (void)hipMemsetAsync((char*)d_ws, 0, O_ZERO_END, stream);
    Args a{};
    for (int i = 0; i < 47; ++i) a.in[i] = (const float*)d_in[i];
    a.out = (float*)d_out; a.ws = (unsigned char*)d_ws;
#if MK_ONE_LAUNCH
    a.ph_lo = 0; a.ph_hi = 64;
    hipLaunchKernelGGL(fwd, dim3(grid), dim3(NTHR), LDS_BYTES, stream, a);
#else
    const int ids[] = {0, 1,2,3,4,5,6,7,8,9,10,11,12,13,14, 17,18,19,20,21,22,23,24,25,26,27,28,29,30, 33};
    for (int k = 0; k < (int)(sizeof(ids) / sizeof(ids[0])); ++k) { a.ph_lo = ids[k]; a.ph_hi = ids[k] + 1; hipLaunchKernelGGL(fwd, dim3(grid), dim3(NTHR), LDS_BYTES, stream, a); }
#endif
}
```

```cpp
#include <hip/hip_runtime.h>
#include <stdint.h>
#include <stdio.h>

#ifndef PROBE_MASK
#define PROBE_MASK 0
#endif
#ifndef PROBE_SP
#define PROBE_SP 1
#endif
#define PROBE_REPS(k) ((((PROBE_MASK) >> (k)) & 1) + 1)
#ifndef MK_ONE_LAUNCH
#define MK_ONE_LAUNCH 1
#endif

#define DM 2048
#define NB 4
#define SEQ 4096
#define CTXL 256
#define BW 512
#define NLAT 16384
#define NCTX 1024
#define NTOK 17408
#define IN_W 13856
#define LDP 14080
#define HY_OFF 0
#define ML_OFF 1536
#define S5_OFF 3600
#define SSD_OFF 4112
#define GATE_OFF 5664
#define NEXP 16
#define DEXP 1536
#define MOE_ROWS 2176
#define MOE_PAD 2304
#define NTHR 512
#define LDS_BYTES 147456
#define LAS __attribute__((address_space(3)))

typedef unsigned short bf16_t;
typedef short bf16x8 __attribute__((ext_vector_type(8)));
typedef float f32x4 __attribute__((ext_vector_type(4)));
typedef unsigned u32x4 __attribute__((ext_vector_type(4)));
typedef unsigned u32x2 __attribute__((ext_vector_type(2)));

#define XB_TMO      128
#define XB_XCNT(j)  (256  + 64 * (j))
#define XB_XSUB(j)  (1280 + 64 * (j))
#define XB_XGEN(j)  (2304 + 64 * (j))
#define XB_TOP      3328
#define XB_TOPGEN   3392
#define XCD_BAR_WORDS 3456
#define XB_SPIN_CAP (1u << 18)
__device__ __forceinline__ unsigned xb_ld(unsigned* p)              { return __hip_atomic_load(p, __ATOMIC_RELAXED, __HIP_MEMORY_SCOPE_AGENT); }
__device__ __forceinline__ unsigned xb_add(unsigned* p, unsigned v) { return __hip_atomic_fetch_add(p, v, __ATOMIC_RELAXED, __HIP_MEMORY_SCOPE_AGENT); }
__device__ __forceinline__ unsigned xb_xcc_id() { return (unsigned)__builtin_amdgcn_s_getreg((3 << 11) | 20) & 0xFu; }
#define XB_SPIN(cond, bar) do { unsigned _sp = 0; while (cond) { __builtin_amdgcn_s_sleep(1); \
    if ((++_sp & 255u) == 0u) { if (xb_ld(&(bar)[XB_TMO])) break; if (_sp > XB_SPIN_CAP) { atomicAdd(&(bar)[XB_TMO], 1u); break; } } } } while (0)
struct XcdBarrier { unsigned* bar; unsigned x; volatile LAS unsigned* st; };
__device__ __forceinline__ XcdBarrier xcd_barrier_post(unsigned* bar, volatile LAS unsigned* st) {
    XcdBarrier b; b.bar = bar; b.x = xb_xcc_id(); b.st = st;
    if (threadIdx.x == 0) (void)xb_add(&bar[XB_XCNT(b.x)], 1u);
    return b;
}
__device__ __forceinline__ void xcd_barrier_complete(unsigned* bar, unsigned x, unsigned& nloc, unsigned& nx) {
    const unsigned G = gridDim.x * gridDim.y * gridDim.z;
    unsigned sum, cnt, mine, sp = 0u;
    for (;;) {
        sum = 0u; cnt = 0u; mine = 0u;
#pragma unroll
        for (unsigned j = 0; j < 16; ++j) { const unsigned c = xb_ld(&bar[XB_XCNT(j)]); sum += c; cnt += (c > 0u) ? 1u : 0u; mine = (j == x) ? c : mine; }
        if (sum == G) break;
        __builtin_amdgcn_s_sleep(1);
        if ((++sp & 255u) == 0u) { if (xb_ld(&bar[XB_TMO])) break; if (sp > XB_SPIN_CAP) { atomicAdd(&bar[XB_TMO], 1u); break; } }
    }
    nloc = mine > 0u ? mine : 1u; nx = cnt > 0u ? cnt : 1u;
}
__device__ __forceinline__ void xcd_barrier(const XcdBarrier& b) {
    asm volatile("s_waitcnt vmcnt(0)" ::: "memory");
    __syncthreads();
    if (threadIdx.x == 0) {
        unsigned* bar = b.bar;
        __builtin_amdgcn_s_waitcnt(0);
        unsigned nloc = b.st[0], nx = b.st[1];
        if (nloc == 0u) { xcd_barrier_complete(bar, b.x, nloc, nx); b.st[0] = nloc; b.st[1] = nx; }
        const unsigned old = xb_add(&bar[XB_XSUB(b.x)], 1u);
        const unsigned gen = old / nloc;
        if (old + 1u == (gen + 1u) * nloc) {
            __builtin_amdgcn_fence(__ATOMIC_RELEASE, "agent");
            asm volatile("s_waitcnt vmcnt(0)" ::: "memory");
            const unsigned og = xb_add(&bar[XB_TOP], 1u);
            const unsigned tg = og / nx;
            if (og + 1u == (tg + 1u) * nx) xb_add(&bar[XB_TOPGEN], 1u);
            else XB_SPIN(xb_ld(&bar[XB_TOPGEN]) == tg, bar);
            __builtin_amdgcn_fence(__ATOMIC_ACQUIRE, "agent");
            xb_add(&bar[XB_XGEN(b.x)], 1u);
            asm volatile("s_waitcnt vmcnt(0)" ::: "memory");
        } else {
            XB_SPIN(xb_ld(&bar[XB_XGEN(b.x)]) == gen, bar);
            __builtin_amdgcn_fence(__ATOMIC_ACQUIRE, "agent");
            asm volatile("s_waitcnt vmcnt(0)" ::: "memory");
        }
    }
    __syncthreads();
}

__device__ __forceinline__ unsigned short f2bf(float f) { unsigned u = __float_as_uint(f); u += 0x7FFFu + ((u >> 16) & 1u); return (unsigned short)(u >> 16); }
__device__ __forceinline__ float bf2f(unsigned short b) { return __uint_as_float(((unsigned)b) << 16); }
__device__ __forceinline__ unsigned pk2(float lo, float hi) { unsigned r; asm("v_cvt_pk_bf16_f32 %0, %1, %2" : "=v"(r) : "v"(lo), "v"(hi)); return r; }
__device__ __forceinline__ float sigmoidf_(float x) { return 1.0f / (1.0f + expf(-x)); }
__device__ __forceinline__ float siluf_(float x) { return x / (1.0f + expf(-x)); }
__device__ __forceinline__ float wave_sum(float v) {
#pragma unroll
    for (int o = 32; o >= 1; o >>= 1) v += __shfl_xor(v, o);
    return v;
}
__device__ __forceinline__ const float* uptr(const float* p) { const unsigned long long v = (unsigned long long)p;
    const unsigned lo = __builtin_amdgcn_readfirstlane((unsigned)v), hi = __builtin_amdgcn_readfirstlane((unsigned)(v >> 32)); return (const float*)(((unsigned long long)hi << 32) | lo); }
#define PT(k) uptr(ptab[k])
__device__ __forceinline__ int step_tok(int b, int dir, int i) {
    if (i < CTXL) { const int tt = dir ? (CTXL - 1 - i) : i; return NLAT + b * CTXL + tt; }
    const int j = i - CTXL; const int tt = dir ? (SEQ - 1 - j) : j; return b * SEQ + tt;
}
__device__ __forceinline__ void unpack8(const u32x4 w, float (&f)[8]) {
    f[0] = __uint_as_float(w.x << 16); f[1] = __uint_as_float(w.x & 0xFFFF0000u); f[2] = __uint_as_float(w.y << 16); f[3] = __uint_as_float(w.y & 0xFFFF0000u);
    f[4] = __uint_as_float(w.z << 16); f[5] = __uint_as_float(w.z & 0xFFFF0000u); f[6] = __uint_as_float(w.w << 16); f[7] = __uint_as_float(w.w & 0xFFFF0000u);
}

namespace pg8 {
constexpr int BM = 256, BK = 64, HALF = 128, HTB = HALF * BK * 2, STAGE_BYTES = 8 * HTB, NXCD = 8, WGM = 8;
__host__ __device__ __forceinline__ int lds_byte(int r, int c) { const int st = (r >> 4) * 2 + (c >> 5), rr = r & 15, cc = c & 31, ob = rr * 64 + cc * 2; return st * 1024 + (ob ^ (((ob >> 9) & 1) << 5)); }
__host__ __device__ __forceinline__ void stage_rc(int b, int& R, int& C) { const int st = b / 1024, sb = b % 1024, swz = sb ^ (((sb >> 9) & 1) << 5); R = (st >> 1) * 16 + swz / 64; C = (st & 1) * 32 + (swz % 64) / 2; }
__host__ __device__ __forceinline__ int perm32(int rho) { const int n = rho >> 4, i = rho & 15; return 8 * (i >> 2) + 4 * n + (i & 3); }
struct Unit { int pm, pn, z, k; long long ao, bo; };
struct Gemm { const bf16_t* A; const bf16_t* Bt; int lda, ldb, K; };

__device__ __forceinline__ void tile_of(int wgid, int nM, int nN, int& pm, int& pn) {
    const int nwg = nM * nN; { const int q = nwg / NXCD, r = nwg % NXCD, xcd = wgid % NXCD, off = wgid / NXCD; wgid = (xcd < r ? xcd * (q + 1) : r * (q + 1) + (xcd - r) * q) + off; }
    const int nig = WGM * nN, gid = wgid / nig, fm = gid * WGM, gsz = (nM - fm) < WGM ? (nM - fm) : WGM;
    pm = fm + ((wgid % nig) % gsz); pn = (wgid % nig) / gsz;
}
struct SchedStd {
    int nM, nN, G, c, lda, ldb;
    __device__ __forceinline__ bool next(int i, Unit& u) const { const long L = (long)i * G + c; if (L >= (long)nM * nN) return false; tile_of((int)L, nM, nN, u.pm, u.pn); u.z = 0; u.k = 0;
        u.ao = (long long)u.pm * BM * lda * 2; u.bo = (long long)u.pn * BM * ldb * 2; return true; }
    __device__ __forceinline__ void a_ready(const Unit&) const {}
    __device__ __forceinline__ void done(const Unit&) const {}
};
struct SchedBranch {
    int nM, nN, G, c;
    __device__ __forceinline__ bool next(int i, Unit& u) const { const long L = (long)(i >> 2) * G + c; if (L >= (long)nM * nN) return false; tile_of((int)L, nM, nN, u.pm, u.pn); u.z = 0; u.k = i & 3;
        u.ao = ((long long)u.pm * BM * DM + u.k * BW) * 2; u.bo = ((long long)u.k * DM + u.pn * BM) * BW * 2; return true; }
    __device__ __forceinline__ void a_ready(const Unit&) const {}
    __device__ __forceinline__ void done(const Unit&) const {}
};
struct SchedTail {
    int G, c;
    __device__ __forceinline__ bool next(int i, Unit& u) const { const long T = (long)i * G + c; if (T >= 128) return false; const int t = (int)(T >> 2); u.pm = 64 + (t >> 3); u.pn = t & 7; u.z = 1; u.k = (int)(T & 3);
        u.ao = ((long long)u.pm * BM * DM + u.k * BW) * 2; u.bo = ((long long)u.k * DM + u.pn * BM) * BW * 2; return true; }
    __device__ __forceinline__ void a_ready(const Unit&) const {}
    __device__ __forceinline__ void done(const Unit&) const {}
};
struct SchedTailK {
    int G, c;
    __device__ __forceinline__ bool next(int i, Unit& u) const { const long T = (long)i * G + c; if (T >= 128) return false; const int t = (int)(T >> 2); u.pm = 64 + (t >> 3); u.pn = t & 7; u.z = 1; u.k = (int)(T & 3);
        u.ao = ((long long)u.pm * BM * DM + u.k * 512) * 2; u.bo = ((long long)u.pn * BM * DM + u.k * 512) * 2; return true; }
    __device__ __forceinline__ void a_ready(const Unit&) const {}
    __device__ __forceinline__ void done(const Unit&) const {}
};
struct SchedMoe {
    int nPm, nPn, G, c, lda, ldb, nBrows;
    __device__ __forceinline__ bool next(int i, Unit& u) const { const long L = (long)i * G + c; const int per = nPm * nPn; if (L >= (long)NEXP * per) return false; const int e = (int)(L / per), rem = (int)(L % per);
        u.z = e; u.k = 0; u.pm = rem % nPm; u.pn = rem / nPm; u.ao = ((long long)e * MOE_PAD + u.pm * BM) * lda * 2; u.bo = ((long long)e * nBrows + u.pn * BM) * ldb * 2; return true; }
    __device__ __forceinline__ void a_ready(const Unit&) const {}
    __device__ __forceinline__ void done(const Unit&) const {}
};

typedef f32x4 Acc[2][2][4][2];
template <class Epi, class Sched>
__device__ __forceinline__ void gemm_phase(LAS unsigned char* lds, const Gemm g, const Sched& S, const Epi& E) {
    int tid = threadIdx.x; asm volatile("" : "+v"(tid));
    const int wid = __builtin_amdgcn_readfirstlane(tid >> 6), lane = tid & 63, wr = wid >> 2, wc = wid & 3, fr = lane & 15, fq = lane >> 4;
    const int K = g.K, nt = K / BK;
    unsigned voffA[2], voffB[2];
#pragma unroll
    for (int i = 0; i < 2; ++i) { int R, C; stage_rc(tid * 16 + i * 8192, R, C); const int Rb = Epi::PERM ? ((R & ~31) + perm32(R & 31)) : R;
        voffA[i] = (unsigned)(R * g.lda + C) * 2u; voffB[i] = (unsigned)(Rb * g.ldb + C) * 2u; }
    const size_t kstep = (size_t)(BK * 2);
    const size_t hstepA = (size_t)HALF * g.lda * 2, hstepB = (size_t)HALF * g.ldb * 2;
    const unsigned ldsw = (unsigned)wid * 1024u;
    const int aoff = lds_byte(wr * 64 + fr, fq * 8), boff = lds_byte(wc * 32 + fr, fq * 8);
#define PG8_SA(b, h) (((b) * 2 + (h)) * HTB)
#define PG8_SB(b, h) ((4 + (b) * 2 + (h)) * HTB)
#define PG8_STAGE(bufoff, gbase, voff) do { _Pragma("unroll") for (int _i = 0; _i < 2; ++_i) \
        __builtin_amdgcn_global_load_lds((const unsigned*)((const char*)(gbase) + (voff)[_i]), (LAS unsigned*)(lds + (bufoff) + ldsw + _i * 8192), 16, 0, 0); } while (0)
#define PG8_LDA(dst, b, h) do { _Pragma("unroll") for (int m = 0; m < 4; ++m) _Pragma("unroll") for (int k = 0; k < 2; ++k) dst[m][k] = *(const LAS bf16x8*)(lds + PG8_SA(b, h) + aoff + m * 2048 + k * 1024); } while (0)
#define PG8_LDB(dst, b, h) do { _Pragma("unroll") for (int n = 0; n < 2; ++n) _Pragma("unroll") for (int k = 0; k < 2; ++k) dst[n][k] = *(const LAS bf16x8*)(lds + PG8_SB(b, h) + boff + n * 2048 + k * 1024); } while (0)
#define PG8_MMA(ai, bj, At, Bt) do { __builtin_amdgcn_s_setprio(1); _Pragma("unroll") for (int m = 0; m < 4; ++m) _Pragma("unroll") for (int n = 0; n < 2; ++n) _Pragma("unroll") for (int k = 0; k < 2; ++k) \
        acc[ai][bj][m][n] = __builtin_amdgcn_mfma_f32_16x16x32_bf16(Bt[n][k], At[m][k], acc[ai][bj][m][n], 0, 0, 0); __builtin_amdgcn_s_setprio(0); } while (0)
#define PG8_WAIT_V(n) asm volatile("s_waitcnt vmcnt(" #n ")" ::: "memory")
#define PG8_WAIT_L(n) asm volatile("s_waitcnt lgkmcnt(" #n ")" ::: "memory")
#define PG8_BAR __builtin_amdgcn_s_barrier()
#define PG8_SCHED __builtin_amdgcn_sched_barrier(0)
    Unit cur, nxt; int ui = 0;
    if (!S.next(0, cur)) return;
    Acc acc;
#pragma unroll
    for (int a = 0; a < 2; ++a)
#pragma unroll
        for (int b = 0; b < 2; ++b)
#pragma unroll
            for (int m = 0; m < 4; ++m)
#pragma unroll
                for (int n = 0; n < 2; ++n) acc[a][b][m][n] = (f32x4){0.f, 0.f, 0.f, 0.f};
    bf16x8 At[4][2], B0[2][2], B1[2][2];
    const char* cA = (const char*)g.A + cur.ao; const char* cB = (const char*)g.Bt + cur.bo;
    S.a_ready(cur);
    PG8_STAGE(PG8_SB(0, 0), cB, voffB); PG8_STAGE(PG8_SA(0, 0), cA, voffA); PG8_STAGE(PG8_SB(0, 1), cB + hstepB, voffB); PG8_STAGE(PG8_SA(0, 1), cA + hstepA, voffA);
    if (wr == 1) PG8_BAR;
    PG8_WAIT_V(4); PG8_BAR;
    PG8_STAGE(PG8_SB(1, 0), cB + kstep, voffB); PG8_STAGE(PG8_SA(1, 0), cA + kstep, voffA); PG8_STAGE(PG8_SB(1, 1), cB + hstepB + kstep, voffB);
    PG8_WAIT_V(6); PG8_BAR;
    for (;;) {
        const bool has_next = S.next(ui + 1, nxt);
        const char* nA = has_next ? (const char*)g.A + nxt.ao : cA; const char* nB = has_next ? (const char*)g.Bt + nxt.bo : cB;
        for (int t = 0; t < nt; t += 2) {
            const bool last = (t == nt - 2);
            const char* a1 = cA + (size_t)(t + 1) * kstep;
            const char* a2 = last ? nA : cA + (size_t)(t + 2) * kstep; const char* b2 = last ? nB : cB + (size_t)(t + 2) * kstep;
            const char* a3 = a2 + kstep; const char* b3 = b2 + kstep;
            if (last && has_next) S.a_ready(nxt);
            PG8_LDB(B0, 0, 0); PG8_SCHED; PG8_LDA(At, 0, 0); PG8_STAGE(PG8_SA(1, 1), a1 + hstepA, voffA);
            PG8_WAIT_L(8); PG8_BAR; PG8_WAIT_L(0); PG8_MMA(0, 0, At, B0); PG8_BAR; PG8_SCHED;
            PG8_LDB(B1, 0, 1); PG8_STAGE(PG8_SB(0, 0), b2, voffB);
            PG8_BAR; PG8_WAIT_L(0); PG8_MMA(0, 1, At, B1); PG8_BAR;
            PG8_LDA(At, 0, 1); PG8_STAGE(PG8_SA(0, 0), a2, voffA);
            PG8_BAR; PG8_WAIT_L(0); PG8_MMA(1, 0, At, B0); PG8_BAR; PG8_SCHED;
            PG8_STAGE(PG8_SB(0, 1), b2 + hstepB, voffB);
            PG8_WAIT_V(6); PG8_BAR; PG8_MMA(1, 1, At, B1); PG8_BAR;
            PG8_LDB(B0, 1, 0); PG8_SCHED; PG8_LDA(At, 1, 0); PG8_STAGE(PG8_SA(0, 1), a2 + hstepA, voffA);
            PG8_WAIT_L(8); PG8_BAR; PG8_WAIT_L(0); PG8_MMA(0, 0, At, B0); PG8_BAR; PG8_SCHED;
            PG8_LDB(B1, 1, 1); PG8_STAGE(PG8_SB(1, 0), b3, voffB);
            PG8_BAR; PG8_WAIT_L(0); PG8_MMA(0, 1, At, B1); PG8_BAR;
            PG8_LDA(At, 1, 1); PG8_STAGE(PG8_SA(1, 0), a3, voffA);
            PG8_BAR; PG8_WAIT_L(0); PG8_MMA(1, 0, At, B0); PG8_BAR; PG8_SCHED;
            PG8_STAGE(PG8_SB(1, 1), b3 + hstepB, voffB);
            PG8_WAIT_V(6); PG8_BAR; PG8_MMA(1, 1, At, B1); PG8_BAR;
        }
        const bool keep = E(acc, cur, wr, wc, fr, fq); S.done(cur);
        if (!has_next) break;
        if (!keep) {
#pragma unroll
        for (int a = 0; a < 2; ++a)
#pragma unroll
            for (int b = 0; b < 2; ++b)
#pragma unroll
                for (int m = 0; m < 4; ++m)
#pragma unroll
                    for (int n = 0; n < 2; ++n) acc[a][b][m][n] = (f32x4){0.f, 0.f, 0.f, 0.f};
        }
        cur = nxt; cA = nA; cB = nB; ++ui;
    }
    PG8_WAIT_V(0);
    if (wr == 0) PG8_BAR;
    PG8_BAR;
#undef PG8_SA
#undef PG8_SB
#undef PG8_STAGE
#undef PG8_LDA
#undef PG8_LDB
#undef PG8_MMA
#undef PG8_WAIT_V
#undef PG8_WAIT_L
#undef PG8_BAR
#undef PG8_SCHED
}

struct EpiBf16Store {
    static constexpr bool PERM = true;
    bf16_t* O; int ldc;
    __device__ __forceinline__ bool operator()(Acc& acc, const Unit& u, int wr, int wc, int fr, int fq) const {
        const int row0 = u.pm * BM + wr * 64 + fr, col0 = u.pn * BM + wc * 32 + 8 * fq;
#pragma unroll
        for (int ai = 0; ai < 2; ++ai)
#pragma unroll
            for (int m = 0; m < 4; ++m) { bf16_t* rowp = O + (size_t)(row0 + ai * HALF + m * 16) * ldc + col0;
#pragma unroll
                for (int bj = 0; bj < 2; ++bj) { const f32x4 v0 = acc[ai][bj][m][0], v1 = acc[ai][bj][m][1];
                    u32x4 w; w.x = pk2(v0[0], v0[1]); w.y = pk2(v0[2], v0[3]); w.z = pk2(v1[0], v1[1]); w.w = pk2(v1[2], v1[3]);
                    *(u32x4*)(rowp + bj * HALF) = w; } }
        return false;
    }
};
struct EpiWin {
    static constexpr bool PERM = true;
    bf16_t* O; int ldc;
    __device__ __forceinline__ bool operator()(Acc& acc, const Unit& u, int wr, int wc, int fr, int fq) const {
        const int row0 = u.pm * BM + wr * 64 + fr, col0 = u.pn * BM + wc * 32 + 8 * fq;
#pragma unroll
        for (int bj = 0; bj < 2; ++bj) { const bool gate = (col0 + bj * HALF) >= GATE_OFF;
#pragma unroll
            for (int ai = 0; ai < 2; ++ai)
#pragma unroll
                for (int m = 0; m < 4; ++m) { f32x4 v0 = acc[ai][bj][m][0], v1 = acc[ai][bj][m][1];
                    if (gate) {
#pragma unroll
                        for (int j = 0; j < 4; ++j) { v0[j] = __builtin_amdgcn_rcpf(1.0f + __expf(-v0[j])); v1[j] = __builtin_amdgcn_rcpf(1.0f + __expf(-v1[j])); } }
                    u32x4 w; w.x = pk2(v0[0], v0[1]); w.y = pk2(v0[2], v0[3]); w.z = pk2(v1[0], v1[1]); w.w = pk2(v1[2], v1[3]);
                    *(u32x4*)(O + (size_t)(row0 + ai * HALF + m * 16) * ldc + col0 + bj * HALF) = w; } }
        return false;
    }
};
struct EpiNone { static constexpr bool PERM = true;
    __device__ __forceinline__ bool operator()(Acc& acc, const Unit&, int, int, int, int) const {
#pragma unroll
        for (int a = 0; a < 2; ++a)
#pragma unroll
            for (int b = 0; b < 2; ++b)
#pragma unroll
                for (int m = 0; m < 4; ++m)
#pragma unroll
                    for (int n = 0; n < 2; ++n) asm volatile("" :: "v"(acc[a][b][m][n]));
        return false; } };
struct EpiGlu {
    static constexpr bool PERM = true;
    const bf16_t* GG; const float* bias; bf16_t* Y4;
    __device__ __forceinline__ bool operator()(Acc& acc, const Unit& u, int wr, int wc, int fr, int fq) const {
        const int row0 = u.pm * BM + wr * 64 + fr, col0 = u.pn * BM + wc * 32 + 8 * fq;
#pragma unroll
        for (int bj = 0; bj < 2; ++bj) { const int col = col0 + bj * HALF; const f32x4 b0 = *(const f32x4*)(bias + col), b1 = *(const f32x4*)(bias + col + 4);
            u32x4 gq[2][4];
#pragma unroll
            for (int ai = 0; ai < 2; ++ai)
#pragma unroll
                for (int m = 0; m < 4; ++m) gq[ai][m] = *(const u32x4*)(GG + (size_t)(row0 + ai * HALF + m * 16) * BW + col);
#pragma unroll
            for (int ai = 0; ai < 2; ++ai)
#pragma unroll
                for (int m = 0; m < 4; ++m) { const size_t row = (size_t)(row0 + ai * HALF + m * 16);
                    float gg[8]; unpack8(gq[ai][m], gg);
                    const f32x4 v0 = acc[ai][bj][m][0] + b0, v1 = acc[ai][bj][m][1] + b1;
                    u32x4 w; w.x = pk2(gg[0] * sigmoidf_(v0[0]), gg[1] * sigmoidf_(v0[1])); w.y = pk2(gg[2] * sigmoidf_(v0[2]), gg[3] * sigmoidf_(v0[3]));
                    w.z = pk2(gg[4] * sigmoidf_(v1[0]), gg[5] * sigmoidf_(v1[1])); w.w = pk2(gg[6] * sigmoidf_(v1[2]), gg[7] * sigmoidf_(v1[3]));
                    *(u32x4*)(Y4 + row * DM + 1024 + col) = w; } }
        return false;
    }
};
struct EpiBranch {
    static constexpr bool PERM = true;
    const bf16_t* P; bf16_t* ACCb;
    __device__ __forceinline__ bool operator()(Acc& acc, const Unit& u, int wr, int wc, int fr, int fq) const {
        const int row0 = u.pm * BM + wr * 64 + fr, col0 = u.pn * BM + wc * 32 + 8 * fq; const int k = u.k;
        const bf16_t* gbase = P + (size_t)row0 * LDP + GATE_OFF + k * DM + col0;
        if (k < 3) {
#pragma unroll
            for (int ai = 0; ai < 2; ++ai) {
                u32x4 ga[8], gb[8];
#pragma unroll
                for (int m = 0; m < 4; ++m)
#pragma unroll
                    for (int bj = 0; bj < 2; ++bj) { const bf16_t* p = gbase + (size_t)(ai * HALF + m * 16) * LDP + bj * HALF; ga[m * 2 + bj] = *(const u32x4*)p; gb[m * 2 + bj] = *(const u32x4*)(p + DM); }
#pragma unroll
                for (int m = 0; m < 4; ++m)
#pragma unroll
                    for (int bj = 0; bj < 2; ++bj) { float g0[8], g1[8]; unpack8(ga[m * 2 + bj], g0); unpack8(gb[m * 2 + bj], g1);
                        float s[8];
#pragma unroll
                        for (int j = 0; j < 8; ++j) s[j] = g0[j] * __builtin_amdgcn_rcpf(g1[j]);
                        f32x4 v0 = acc[ai][bj][m][0], v1 = acc[ai][bj][m][1];
                        v0[0] *= s[0]; v0[1] *= s[1]; v0[2] *= s[2]; v0[3] *= s[3]; v1[0] *= s[4]; v1[1] *= s[5]; v1[2] *= s[6]; v1[3] *= s[7];
                        acc[ai][bj][m][0] = v0; acc[ai][bj][m][1] = v1; } }
            return true;
        }
#pragma unroll
        for (int ai = 0; ai < 2; ++ai) {
            u32x4 ga[8];
#pragma unroll
            for (int m = 0; m < 4; ++m)
#pragma unroll
                for (int bj = 0; bj < 2; ++bj) ga[m * 2 + bj] = *(const u32x4*)(gbase + (size_t)(ai * HALF + m * 16) * LDP + bj * HALF);
#pragma unroll
            for (int m = 0; m < 4; ++m)
#pragma unroll
                for (int bj = 0; bj < 2; ++bj) { float s[8]; unpack8(ga[m * 2 + bj], s);
                    f32x4 v0 = acc[ai][bj][m][0], v1 = acc[ai][bj][m][1];
                    v0[0] *= s[0]; v0[1] *= s[1]; v0[2] *= s[2]; v0[3] *= s[3]; v1[0] *= s[4]; v1[1] *= s[5]; v1[2] *= s[6]; v1[3] *= s[7];
                    u32x4 w; w.x = pk2(v0[0], v0[1]); w.y = pk2(v0[2], v0[3]); w.z = pk2(v1[0], v1[1]); w.w = pk2(v1[2], v1[3]);
                    *(u32x4*)(ACCb + (size_t)(row0 + ai * HALF + m * 16) * DM + col0 + bj * HALF) = w; } }
        return false;
    }
};
struct EpiPart {
    static constexpr bool PERM = true;
    const bf16_t* P; float* PART;
    __device__ __forceinline__ bool operator()(Acc& acc, const Unit& u, int wr, int wc, int fr, int fq) const {
        const int row0 = u.pm * BM + wr * 64 + fr, col0 = u.pn * BM + wc * 32 + 8 * fq; const int k = u.k;
        const bf16_t* gbase = P + (size_t)row0 * LDP + GATE_OFF + k * DM + col0;
        float* pbase = PART + ((size_t)k * (NTOK - NLAT) + (size_t)(row0 - NLAT)) * DM + col0;
#pragma unroll
        for (int ai = 0; ai < 2; ++ai) {
            u32x4 ga[8];
#pragma unroll
            for (int m = 0; m < 4; ++m)
#pragma unroll
                for (int bj = 0; bj < 2; ++bj) ga[m * 2 + bj] = *(const u32x4*)(gbase + (size_t)(ai * HALF + m * 16) * LDP + bj * HALF);
#pragma unroll
            for (int m = 0; m < 4; ++m)
#pragma unroll
                for (int bj = 0; bj < 2; ++bj) { float sg[8]; unpack8(ga[m * 2 + bj], sg);
                    f32x4 v0 = acc[ai][bj][m][0], v1 = acc[ai][bj][m][1];
                    v0[0] *= sg[0]; v0[1] *= sg[1]; v0[2] *= sg[2]; v0[3] *= sg[3]; v1[0] *= sg[4]; v1[1] *= sg[5]; v1[2] *= sg[6]; v1[3] *= sg[7];
                    float* pp = pbase + (size_t)(ai * HALF + m * 16) * DM + bj * HALF;
                    *(f32x4*)pp = v0; *(f32x4*)(pp + 4) = v1; } }
        return false;
    }
};
struct EpiPartK {
    static constexpr bool PERM = true;
    float* PART;
    __device__ __forceinline__ bool operator()(Acc& acc, const Unit& u, int wr, int wc, int fr, int fq) const {
        const int row0 = u.pm * BM + wr * 64 + fr, col0 = u.pn * BM + wc * 32 + 8 * fq;
        float* pbase = PART + ((size_t)u.k * (NTOK - NLAT) + (size_t)(row0 - NLAT)) * DM + col0;
#pragma unroll
        for (int ai = 0; ai < 2; ++ai)
#pragma unroll
            for (int m = 0; m < 4; ++m)
#pragma unroll
                for (int bj = 0; bj < 2; ++bj) { float* pp = pbase + (size_t)(ai * HALF + m * 16) * DM + bj * HALF; *(f32x4*)pp = acc[ai][bj][m][0]; *(f32x4*)(pp + 4) = acc[ai][bj][m][1]; }
        return false;
    }
};
struct EpiResid {
    static constexpr bool PERM = false;
    float* XS; const float* srcLat; const float* srcCtx; const float* MODl; int gidx;
    __device__ __forceinline__ bool operator()(Acc& acc, const Unit& u, int wr, int wc, int fr, int fq) const {
        const int row0 = u.pm * BM + wr * 64 + fr, col0 = u.pn * BM + wc * 32 + 4 * fq;
        const int r = (u.pm * BM) < NLAT ? (u.pm * BM) / SEQ : 4;
        const float* src = (u.pm * BM) < NLAT ? srcLat : srcCtx;
        const float* mg = MODl + (size_t)(r * 6 + gidx) * DM;
#pragma unroll
        for (int bj = 0; bj < 2; ++bj) {
            f32x4 gm[2], xs[2][2][4];
#pragma unroll
            for (int n = 0; n < 2; ++n) { const int col = col0 + bj * HALF + n * 16; gm[n] = *(const f32x4*)(mg + col);
#pragma unroll
                for (int ai = 0; ai < 2; ++ai)
#pragma unroll
                    for (int m = 0; m < 4; ++m) xs[n][ai][m] = *(const f32x4*)(src + (size_t)(row0 + ai * HALF + m * 16) * DM + col); }
#pragma unroll
            for (int n = 0; n < 2; ++n) { const int col = col0 + bj * HALF + n * 16;
#pragma unroll
                for (int ai = 0; ai < 2; ++ai)
#pragma unroll
                    for (int m = 0; m < 4; ++m) *(f32x4*)(XS + (size_t)(row0 + ai * HALF + m * 16) * DM + col) = xs[n][ai][m] + gm[n] * acc[ai][bj][m][n]; } }
        return false;
    }
};
struct EpiMoe1 {
    static constexpr bool PERM = true;
    bf16_t* HID;
    __device__ __forceinline__ bool operator()(Acc& acc, const Unit& u, int wr, int wc, int fr, int fq) const {
        const size_t row0 = (size_t)u.z * MOE_PAD + u.pm * BM + wr * 64 + fr; const int col0 = u.pn * HALF + wc * 32 + 8 * fq;
#pragma unroll
        for (int ai = 0; ai < 2; ++ai)
#pragma unroll
            for (int m = 0; m < 4; ++m) { const f32x4 g0 = acc[ai][0][m][0], g1 = acc[ai][0][m][1], u0 = acc[ai][1][m][0], u1 = acc[ai][1][m][1];
                float h[8];
#pragma unroll
                for (int j = 0; j < 4; ++j) { h[j] = g0[j] * __builtin_amdgcn_rcpf(1.0f + __expf(-g0[j])) * u0[j]; h[4 + j] = g1[j] * __builtin_amdgcn_rcpf(1.0f + __expf(-g1[j])) * u1[j]; }
                u32x4 w; w.x = pk2(h[0], h[1]); w.y = pk2(h[2], h[3]); w.z = pk2(h[4], h[5]); w.w = pk2(h[6], h[7]);
                *(u32x4*)(HID + (row0 + ai * HALF + m * 16) * DEXP + col0) = w; }
        return false;
    }
};
struct EpiMoeY {
    static constexpr bool PERM = true;
    bf16_t* O;
    __device__ __forceinline__ bool operator()(Acc& acc, const Unit& u, int wr, int wc, int fr, int fq) const {
        const size_t row0 = (size_t)u.z * MOE_PAD + u.pm * BM + wr * 64 + fr; const int col0 = u.pn * BM + wc * 32 + 8 * fq;
#pragma unroll
        for (int ai = 0; ai < 2; ++ai)
#pragma unroll
            for (int m = 0; m < 4; ++m) { bf16_t* rowp = O + (row0 + ai * HALF + m * 16) * DM + col0;
#pragma unroll
                for (int bj = 0; bj < 2; ++bj) { const f32x4 v0 = acc[ai][bj][m][0], v1 = acc[ai][bj][m][1];
                    u32x4 w; w.x = pk2(v0[0], v0[1]); w.y = pk2(v0[2], v0[3]); w.z = pk2(v1[0], v1[1]); w.w = pk2(v1[2], v1[3]);
                    *(u32x4*)(rowp + bj * HALF) = w; } }
        return false;
    }
};

struct SchedS5a {
    int c;
    __device__ __forceinline__ bool next(int i, Unit& u) const { if (i > 0 || c >= 64) return false; u.z = c >> 1; u.pm = c & 1; u.pn = 0; u.k = 0;
        u.ao = ((long long)u.z * 512 + u.pm * BM) * 768 * 2; u.bo = (long long)u.z * 256 * 512 * 2; return true; }
    __device__ __forceinline__ void a_ready(const Unit&) const {}
    __device__ __forceinline__ void done(const Unit&) const {}
};
struct SchedS5b {
    int c;
    __device__ __forceinline__ bool next(int i, Unit& u) const { if (i > 0 || c >= 128) return false; u.z = c >> 2; u.pm = (c >> 1) & 1; u.pn = c & 1; u.k = 0;
        u.ao = ((long long)u.z * 512 + u.pm * BM) * 768 * 2; u.bo = ((long long)u.z * 512 + u.pn * BM) * 768 * 2; return true; }
    __device__ __forceinline__ void a_ready(const Unit&) const {}
    __device__ __forceinline__ void done(const Unit&) const {}
};
struct EpiXloc {
    static constexpr bool PERM = false;
    float* XL;
    __device__ __forceinline__ bool operator()(Acc& acc, const Unit& u, int wr, int wc, int fr, int fq) const {
        const int row0 = u.pm * BM + wr * 64 + fr, col0 = wc * 32 + 4 * fq; float* base = XL + (size_t)u.z * 512 * 256;
#pragma unroll
        for (int ai = 0; ai < 2; ++ai)
#pragma unroll
            for (int m = 0; m < 4; ++m) { float* rowp = base + (size_t)(row0 + ai * HALF + m * 16) * 256 + col0;
#pragma unroll
                for (int bj = 0; bj < 2; ++bj)
#pragma unroll
                    for (int n = 0; n < 2; ++n) *(f32x4*)(rowp + bj * HALF + n * 16) = acc[ai][bj][m][n]; }
        return false;
    }
};
struct EpiS5Out {
    static constexpr bool PERM = true;
    const bf16_t* P; const float* dskip; bf16_t* GG;
    __device__ __forceinline__ bool operator()(Acc& acc, const Unit& u, int wr, int wc, int fr, int fq) const {
        const int row0 = u.pm * BM + wr * 64 + fr, col0 = u.pn * BM + wc * 32 + 8 * fq; const int g = u.z;
#pragma unroll
        for (int bj = 0; bj < 2; ++bj) { const int col = col0 + bj * HALF; const int t = col >> 4, c0 = col & 15;
            const f32x4 d0 = *(const f32x4*)(dskip + g * 16 + c0), d1 = *(const f32x4*)(dskip + g * 16 + c0 + 4);
            u32x4 uq[2][4];
#pragma unroll
            for (int ai = 0; ai < 2; ++ai)
#pragma unroll
                for (int m = 0; m < 4; ++m) uq[ai][m] = *(const u32x4*)(P + ((size_t)(row0 + ai * HALF + m * 16) * 32 + t) * LDP + S5_OFF + g * 16 + c0);
#pragma unroll
            for (int ai = 0; ai < 2; ++ai)
#pragma unroll
                for (int m = 0; m < 4; ++m) { const size_t tok = (size_t)(row0 + ai * HALF + m * 16) * 32 + t;
                    float uu[8]; unpack8(uq[ai][m], uu);
                    const f32x4 v0 = acc[ai][bj][m][0], v1 = acc[ai][bj][m][1];
                    float y[8] = {v0[0] + d0[0] * uu[0], v0[1] + d0[1] * uu[1], v0[2] + d0[2] * uu[2], v0[3] + d0[3] * uu[3], v1[0] + d1[0] * uu[4], v1[1] + d1[1] * uu[5], v1[2] + d1[2] * uu[6], v1[3] + d1[3] * uu[7]};
#pragma unroll
                    for (int j = 0; j < 8; ++j) y[j] = 0.5f * y[j] * (1.0f + tanhf(0.7978845608028654f * (y[j] + 0.044715f * y[j] * y[j] * y[j])));
                    u32x4 w; w.x = pk2(y[0], y[1]); w.y = pk2(y[2], y[3]); w.z = pk2(y[4], y[5]); w.w = pk2(y[6], y[7]);
                    *(u32x4*)(GG + tok * BW + g * 16 + c0) = w; } }
        return false;
    }
};
}


__device__ __forceinline__ float wave_scan_incl(float v, int lane) {
#pragma unroll
    for (int o = 1; o < 64; o <<= 1) { const float t = __shfl_up(v, o); if (lane >= o) v += t; }
    return v;
}
__device__ __forceinline__ float wave_scanmax_incl(float v, int lane) {
#pragma unroll
    for (int o = 1; o < 64; o <<= 1) { const float t = __shfl_up(v, o); if (lane >= o) v = fmaxf(v, t); }
    return v;
}
__device__ __forceinline__ float wave_max(float v) {
#pragma unroll
    for (int o = 32; o >= 1; o >>= 1) v = fmaxf(v, __shfl_xor(v, o));
    return v;
}
__device__ __forceinline__ void unpack8h(const u32x4 w, bf16_t (&h)[8]) {
    h[0] = (bf16_t)(w.x & 0xFFFFu); h[1] = (bf16_t)(w.x >> 16); h[2] = (bf16_t)(w.y & 0xFFFFu); h[3] = (bf16_t)(w.y >> 16);
    h[4] = (bf16_t)(w.z & 0xFFFFu); h[5] = (bf16_t)(w.z >> 16); h[6] = (bf16_t)(w.w & 0xFFFFu); h[7] = (bf16_t)(w.w >> 16);
}

__device__ __forceinline__ int tokblock_of(int b, int dir, int c) { if (c < 4) return 256 + b * 4 + (dir ? 3 - c : c); const int j = c - 4; return b * 64 + (dir ? 63 - j : j); }
__device__ __forceinline__ u32x4 rev8h(const u32x4 v) { u32x4 r; r.x = (v.w >> 16) | (v.w << 16); r.y = (v.z >> 16) | (v.z << 16); r.z = (v.y >> 16) | (v.y << 16); r.w = (v.x >> 16) | (v.x << 16); return r; }
__device__ __forceinline__ u32x4 scale8h(const u32x4 v, const float4 a, const float4 b) { float f[8]; unpack8(v, f); u32x4 r; r.x = pk2(f[0] * a.x, f[1] * a.y); r.y = pk2(f[2] * a.z, f[3] * a.w); r.z = pk2(f[4] * b.x, f[5] * b.y); r.w = pk2(f[6] * b.z, f[7] * b.w); return r; }
__device__ __forceinline__ float dot8h(const u32x4 v, const float4 a, const float4 b) { float f[8]; unpack8(v, f); return (f[0] * a.x + f[1] * a.y) + (f[2] * a.z + f[3] * a.w) + (f[4] * b.x + f[5] * b.y) + (f[6] * b.z + f[7] * b.w); }
#define ML_FRAG_LOAD(KF, VF, cc_) do { const int tb_ = tokblock_of(b, dir, (cc_)); const bf16_t* kb_ = KTg + ((size_t)tb_ * 512 + h * 128 + 32 * wd + r16) * 64 + q4 * 8; const bf16_t* vb_ = VTg + ((size_t)tb_ * 512 + h * 128 + 64 * half + 32 * we + r16) * 64 + q4 * 8; \
        _Pragma("unroll") for (int ks_ = 0; ks_ < 2; ++ks_) _Pragma("unroll") for (int j_ = 0; j_ < 2; ++j_) { VF[j_][ks_] = *(const u32x4*)(vb_ + (size_t)j_ * 16 * 64 + ks_ * 32); KF[j_][ks_] = *(const u32x4*)(kb_ + (size_t)j_ * 16 * 64 + ks_ * 32); } } while (0)
#define ML_CHUNK(c_, KF, VF, KFN, VFN) do { const int c = (c_); \
        if (c + 1 < 68) ML_FRAG_LOAD(KFN, VFN, c + 1);                        \
        const float dec = sDEC[c]; \
        {   bf16_t* cs = CST + (size_t)(chain * 68 + c) * 128 * 128; \
            _Pragma("unroll") for (int je = 0; je < 2; ++je) _Pragma("unroll") for (int jd = 0; jd < 2; ++jd) { const int e = 64 * half + 32 * we + 16 * je + r16, d0 = 32 * wd + 16 * jd + q4 * 4; \
                u32x2 pk; pk.x = pk2(acc[je][jd][0], acc[je][jd][1]); pk.y = pk2(acc[je][jd][2], acc[je][jd][3]); *(u32x2*)(cs + (size_t)e * 128 + d0) = pk; } \
            if (nown) { _Pragma("unroll") for (int jd = 0; jd < 2; ++jd) { float nv = npart[jd]; nv += __shfl_xor(nv, 16); nv += __shfl_xor(nv, 32); if (q4 == 0) NST[(size_t)(chain * 68 + c) * 128 + 32 * wd + 16 * jd + r16] = nv; } } } \
        bf16x8 vfr[2][2]; \
        _Pragma("unroll") for (int ks = 0; ks < 2; ++ks) { const float4 wa = *(const float4*)(sWS + c * 64 + ks * 32 + q4 * 8), wb = *(const float4*)(sWS + c * 64 + ks * 32 + q4 * 8 + 4); \
            _Pragma("unroll") for (int je = 0; je < 2; ++je) { const u32x4 sv = scale8h(VF[je][ks], wa, wb); vfr[je][ks] = *(const bf16x8*)&sv; } \
            if (nown) { _Pragma("unroll") for (int jd = 0; jd < 2; ++jd) npart[jd] = (ks == 0 ? dec * npart[jd] : npart[jd]) + dot8h(KF[jd][ks], wa, wb); } } \
        _Pragma("unroll") for (int je = 0; je < 2; ++je) _Pragma("unroll") for (int jd = 0; jd < 2; ++jd) acc[je][jd] = acc[je][jd] * dec; \
        _Pragma("unroll") for (int ks = 0; ks < 2; ++ks) _Pragma("unroll") for (int je = 0; je < 2; ++je) _Pragma("unroll") for (int jd = 0; jd < 2; ++jd) \
            acc[je][jd] = __builtin_amdgcn_mfma_f32_16x16x32_bf16(*(const bf16x8*)&KF[jd][ks], vfr[je][ks], acc[je][jd], 0, 0, 0); } while (0)
__device__ __forceinline__ void mlstm_state_pass(const int chain, const int half, const bf16_t* __restrict__ Pm, const bf16_t* __restrict__ KTg, const bf16_t* __restrict__ VTg, const float* __restrict__ gate_b,
                                                 bf16_t* __restrict__ CST, float* __restrict__ NST, float* __restrict__ MST, unsigned char* shm, const int tid) {
    const int dir = chain & 1, h = (chain >> 1) & 3, b = chain >> 3, lane = tid & 63, w = tid >> 6, we = w >> 2, wd = w & 3, q4 = lane >> 4, r16 = lane & 15;
    const bool nown = (half == 0) && (we == 0);
    float* sE = (float*)shm; float* sWS = sE + 68 * 64; float* sAL = sWS + 68 * 64; float* sBE = sAL + 68; float* sMO = sBE + 68; float* sDEC = sMO + 68; float* sMB = sDEC + 68;
    const float gbi = gate_b[(dir * 2 + 0) * 4 + h], gbf = gate_b[(dir * 2 + 1) * 4 + h];
    const int gcol_i = ML_OFF + 2048 + (dir * 2 + 0) * 4 + h, gcol_f = ML_OFF + 2048 + (dir * 2 + 1) * 4 + h;
    u32x4 kfA[2][2], vfA[2][2], kfB[2][2], vfB[2][2];
    ML_FRAG_LOAD(kfA, vfA, 0);
    __syncthreads();
    unsigned gi_[9], gf_[9];
#pragma unroll
    for (int q = 0; q < 9; ++q) { const int c = min(w + 8 * q, 67); const size_t tokl = (size_t)step_tok(b, dir, c * 64 + lane); gi_[q] = Pm[tokl * LDP + gcol_i]; gf_[q] = Pm[tokl * LDP + gcol_f]; }
#pragma unroll
    for (int q = 0; q < 9; ++q) { const int c = w + 8 * q; if (c >= 68) break;
        const float ig = __uint_as_float(gi_[q] << 16) + gbi, fg = __uint_as_float(gf_[q] << 16) + gbf;
        const float lf = fminf(fg, 0.f) - log1pf(expf(-fabsf(fg)));
        const float bcs = wave_scan_incl(lf, lane); const float blast = __shfl(bcs, 63); const float ei = blast - bcs + ig; const float beta = wave_max(ei);
        sE[c * 64 + lane] = ei; if (lane == 0) { sAL[c] = blast; sBE[c] = beta; } }
    __syncthreads();
    if (tid == 0) { float m = 0.f; for (int c = 0; c < 68; ++c) { sMB[c] = m; const float mo = fmaxf(m + sAL[c], sBE[c]); sDEC[c] = expf(sAL[c] + m - mo); sMO[c] = mo; m = mo; } }
    __syncthreads();
    for (int idx = tid; idx < 68 * 64; idx += NTHR) { const int c = idx >> 6, i = idx & 63; sWS[c * 64 + (dir ? 63 - i : i)] = expf(sE[idx] - sMO[c]); }
    if (half == 0 && tid < 68) MST[chain * 68 + tid] = sMB[tid];
    __syncthreads();
    f32x4 acc[2][2];
#pragma unroll
    for (int je = 0; je < 2; ++je)
#pragma unroll
        for (int jd = 0; jd < 2; ++jd) acc[je][jd] = (f32x4){0.f, 0.f, 0.f, 0.f};
    float npart[2] = {0.f, 0.f};
    for (int c2 = 0; c2 < 68; c2 += 2) { ML_CHUNK(c2, kfA, vfA, kfB, vfB); ML_CHUNK(c2 + 1, kfB, vfB, kfA, vfA); }
    __syncthreads();
}
#undef ML_CHUNK
#undef ML_FRAG_LOAD
__device__ __forceinline__ void mlstm_out_item(const int chain, const int c, const bf16_t* __restrict__ Pm, const bf16_t* __restrict__ QKb, const bf16_t* __restrict__ VTg, const float* __restrict__ gate_b,
                                               const bf16_t* __restrict__ CST, const float* __restrict__ NST, const float* __restrict__ MST, bf16_t* __restrict__ Hout, unsigned char* shm, const int tid) {
    const int dir = chain & 1, h = (chain >> 1) & 3, b = chain >> 3, lane = tid & 63, w = tid >> 6;
    bf16_t* Qs = (bf16_t*)shm; bf16_t* Ks = (bf16_t*)(shm + 17408); bf16_t* VT = (bf16_t*)(shm + 34816); bf16_t* Cs = (bf16_t*)(shm + 53248); bf16_t* Ss = (bf16_t*)(shm + 88064);
    float* sc = (float*)(shm + 97280);
    __syncthreads();
    u32x4 gq[2], gk[2], gv[2], gc[4]; float gn = 0.f;
#pragma unroll
    for (int i = 0; i < 2; ++i) { const int pid = tid + i * 512; const int s = pid >> 4, x0 = (pid & 15) * 8; const size_t toks = (size_t)step_tok(b, dir, c * 64 + s);
        gq[i] = *(const u32x4*)(QKb + toks * 1024 + h * 128 + x0);
        gk[i] = *(const u32x4*)(QKb + toks * 1024 + 512 + h * 128 + x0);
        { const int e = pid >> 3, o = pid & 7;
          gv[i] = *(const u32x4*)(VTg + ((size_t)tokblock_of(b, dir, c) * 512 + h * 128 + e) * 64 + (dir ? 7 - o : o) * 8); } }
#pragma unroll
    for (int i = 0; i < 4; ++i) { const int pid = tid + i * 512; const int e = pid >> 4, x0 = (pid & 15) * 8;
        gc[i] = *(const u32x4*)(CST + ((size_t)(chain * 68 + c) * 128 + e) * 128 + x0); }
    if (tid < 128) gn = NST[(size_t)(chain * 68 + c) * 128 + tid];
    unsigned gi_ = 0u, gf_ = 0u; float gbi = 0.f, gbf = 0.f, m_in = 0.f;
    if (w == 0) { const size_t tokl = (size_t)step_tok(b, dir, c * 64 + lane);
        gi_ = Pm[tokl * LDP + ML_OFF + 2048 + (dir * 2 + 0) * 4 + h]; gf_ = Pm[tokl * LDP + ML_OFF + 2048 + (dir * 2 + 1) * 4 + h];
        gbi = gate_b[(dir * 2 + 0) * 4 + h]; gbf = gate_b[(dir * 2 + 1) * 4 + h]; m_in = MST[chain * 68 + c]; }
#pragma unroll
    for (int i = 0; i < 2; ++i) { const int pid = tid + i * 512; const int s = pid >> 4, x0 = (pid & 15) * 8;
        *(u32x4*)(Qs + s * 136 + x0) = gq[i]; *(u32x4*)(Ks + s * 136 + x0) = gk[i];
        { const int e = pid >> 3, o = pid & 7; *(u32x4*)(VT + e * 72 + o * 8) = dir ? rev8h(gv[i]) : gv[i]; } }
#pragma unroll
    for (int i = 0; i < 4; ++i) { const int pid = tid + i * 512; const int e = pid >> 4, x0 = (pid & 15) * 8; *(u32x4*)(Cs + e * 136 + x0) = gc[i]; }
    if (tid < 128) sc[384 + tid] = gn;
    if (w == 0) {
        const float ig = __uint_as_float(gi_ << 16) + gbi;
        const float fg = __uint_as_float(gf_ << 16) + gbf;
        const float lf = fminf(fg, 0.f) - log1pf(expf(-fabsf(fg)));
        const float bcs = wave_scan_incl(lf, lane); const float gsv = ig - bcs; const float pm = wave_scanmax_incl(gsv, lane);
        const float mt = bcs + fmaxf(m_in, pm);
        sc[lane] = bcs; sc[64 + lane] = gsv; sc[128 + lane] = mt; sc[192 + lane] = expf(bcs + m_in - mt); sc[256 + lane] = expf(-mt);
    }
    __syncthreads();
    const int tt = w >> 1;
    {   f32x4 aS[2] = {(f32x4){0.f, 0.f, 0.f, 0.f}, (f32x4){0.f, 0.f, 0.f, 0.f}};
#pragma unroll
        for (int ks = 0; ks < 4; ++ks) { const bf16x8 af = *(const bf16x8*)(Qs + (16 * tt + (lane & 15)) * 136 + ks * 32 + (lane >> 4) * 8);
#pragma unroll
            for (int i = 0; i < 2; ++i) { const int st = (w & 1) * 2 + i; const bf16x8 bfr = *(const bf16x8*)(Ks + (16 * st + (lane & 15)) * 136 + ks * 32 + (lane >> 4) * 8);
                aS[i] = __builtin_amdgcn_mfma_f32_16x16x32_bf16(af, bfr, aS[i], 0, 0, 0); } }
        float rs[4] = {0.f, 0.f, 0.f, 0.f};
#pragma unroll
        for (int i = 0; i < 2; ++i) { const int s = 16 * ((w & 1) * 2 + i) + (lane & 15); const float gsv = sc[64 + s];
#pragma unroll
            for (int q = 0; q < 4; ++q) { const int t = 16 * tt + (lane >> 4) * 4 + q; const float val = (s <= t) ? aS[i][q] * expf(sc[t] + gsv - sc[128 + t]) : 0.f; Ss[t * 72 + s] = f2bf(val); rs[q] += val; } }
#pragma unroll
        for (int q = 0; q < 4; ++q) { float r = rs[q]; r += __shfl_xor(r, 1); r += __shfl_xor(r, 2); r += __shfl_xor(r, 4); r += __shfl_xor(r, 8);
            if ((lane & 15) == 0) sc[512 + (w & 1) * 64 + 16 * tt + (lane >> 4) * 4 + q] = r; }
        {   const int t = tid >> 3, part = tid & 7; float dot = 0.f;
#pragma unroll
            for (int j = 0; j < 16; ++j) dot += bf2f(Qs[t * 136 + part * 16 + j]) * sc[384 + part * 16 + j];
            dot += __shfl_xor(dot, 1); dot += __shfl_xor(dot, 2); dot += __shfl_xor(dot, 4);
            if (part == 0) sc[640 + t] = sc[192 + t] * dot; }
    }
    __syncthreads();
    {   f32x4 aN[4];
#pragma unroll
        for (int i = 0; i < 4; ++i) aN[i] = (f32x4){0.f, 0.f, 0.f, 0.f};
#pragma unroll
        for (int ks = 0; ks < 4; ++ks) { const bf16x8 af = *(const bf16x8*)(Qs + (16 * tt + (lane & 15)) * 136 + ks * 32 + (lane >> 4) * 8);
#pragma unroll
            for (int i = 0; i < 4; ++i) { const int et = (w & 1) * 4 + i; const bf16x8 bfr = *(const bf16x8*)(Cs + (16 * et + (lane & 15)) * 136 + ks * 32 + (lane >> 4) * 8);
                aN[i] = __builtin_amdgcn_mfma_f32_16x16x32_bf16(bfr, af, aN[i], 0, 0, 0); } }
        const int t = 16 * tt + (lane & 15);
        {   const float it = sc[192 + t];
#pragma unroll
            for (int i = 0; i < 4; ++i) { aN[i][0] *= it; aN[i][1] *= it; aN[i][2] *= it; aN[i][3] *= it; } }
#pragma unroll
        for (int ks = 0; ks < 2; ++ks) { const bf16x8 af = *(const bf16x8*)(Ss + (16 * tt + (lane & 15)) * 72 + ks * 32 + (lane >> 4) * 8);
#pragma unroll
            for (int i = 0; i < 4; ++i) { const int et = (w & 1) * 4 + i; const bf16x8 bfr = *(const bf16x8*)(VT + (16 * et + (lane & 15)) * 72 + ks * 32 + (lane >> 4) * 8);
                aN[i] = __builtin_amdgcn_mfma_f32_16x16x32_bf16(bfr, af, aN[i], 0, 0, 0); } }
        {   const size_t tokt = (size_t)step_tok(b, dir, c * 64 + t); const float dn = fmaxf(fabsf((sc[512 + t] + sc[576 + t]) + sc[640 + t]), sc[256 + t]);
#pragma unroll
            for (int i = 0; i < 4; ++i) { const int e0 = 16 * ((w & 1) * 4 + i) + (lane >> 4) * 4;
                u32x2 wv; wv.x = pk2(aN[i][0] / dn, aN[i][1] / dn); wv.y = pk2(aN[i][2] / dn, aN[i][3] / dn);
                *(u32x2*)(Hout + tokt * BW + h * 128 + e0) = wv; } }
    }
}


#define SD_FRAG_LOAD(BF, XF, cc_) do { const int tb_ = tokblock_of(b, dir, (cc_)); const bf16_t* bb_ = BTg + ((size_t)tb_ * 256 + grp * 128 + 64 * (w >> 2) + r16) * 64 + q4 * 8; const bf16_t* xb_ = XTg + ((size_t)tb_ * 512 + h * 64 + 16 * (w & 3) + r16) * 64 + q4 * 8; \
        _Pragma("unroll") for (int ks_ = 0; ks_ < 2; ++ks_) { XF[ks_] = *(const u32x4*)(xb_ + ks_ * 32); _Pragma("unroll") for (int j_ = 0; j_ < 4; ++j_) BF[j_][ks_] = *(const u32x4*)(bb_ + (size_t)j_ * 16 * 64 + ks_ * 32); } } while (0)
#define SD_CHUNK(c_, BF, XF, BFN, XFN) do { const int c = (c_); \
        if (c + 1 < 68) SD_FRAG_LOAD(BFN, XFN, c + 1); \
        const float dec = sDEC[c]; \
        {   bf16_t* ss = SSTb + (size_t)(chain * 68 + c) * 64 * 128; const int p = 16 * (w & 3) + r16; \
            _Pragma("unroll") for (int j = 0; j < 4; ++j) { const int n0 = 16 * ((w >> 2) * 4 + j) + q4 * 4; u32x2 pk; pk.x = pk2(acc[j][0], acc[j][1]); pk.y = pk2(acc[j][2], acc[j][3]); *(u32x2*)(ss + (size_t)p * 128 + n0) = pk; } } \
        bf16x8 xfr[2]; \
        _Pragma("unroll") for (int ks = 0; ks < 2; ++ks) { const float4 wa = *(const float4*)(sSC + c * 64 + ks * 32 + q4 * 8), wb = *(const float4*)(sSC + c * 64 + ks * 32 + q4 * 8 + 4); const u32x4 sv = scale8h(XF[ks], wa, wb); xfr[ks] = *(const bf16x8*)&sv; } \
        _Pragma("unroll") for (int j = 0; j < 4; ++j) acc[j] = acc[j] * dec; \
        _Pragma("unroll") for (int ks = 0; ks < 2; ++ks) _Pragma("unroll") for (int j = 0; j < 4; ++j) acc[j] = __builtin_amdgcn_mfma_f32_16x16x32_bf16(*(const bf16x8*)&BF[j][ks], xfr[ks], acc[j], 0, 0, 0); } while (0)
__device__ __forceinline__ void ssd_state_pass(const int chain, const bf16_t* __restrict__ Pm, const bf16_t* __restrict__ BTg, const bf16_t* __restrict__ XTg, const float Aa, const float dtb,
                                               bf16_t* __restrict__ SSTb, unsigned char* shm, const int tid) {
    const int dir = chain & 1, h = (chain >> 1) & 7, b = chain >> 4, grp = h >> 2, lane = tid & 63, w = tid >> 6, q4 = lane >> 4, r16 = lane & 15;
    float* sSC = (float*)shm; float* sDEC = sSC + 68 * 64;
    const int dcol = SSD_OFF + 1536 + dir * 8 + h;
    u32x4 bfA[4][2], xfA[2], bfB[4][2], xfB[2];
    SD_FRAG_LOAD(bfA, xfA, 0);
    __syncthreads();
    unsigned dt_[9];
#pragma unroll
    for (int q = 0; q < 9; ++q) { const int c = min(w + 8 * q, 67); dt_[q] = Pm[(size_t)step_tok(b, dir, c * 64 + lane) * LDP + dcol]; }
#pragma unroll
    for (int q = 0; q < 9; ++q) { const int c = w + 8 * q; if (c >= 68) break;
        const float xv = __uint_as_float(dt_[q] << 16) + dtb; const float dtv = xv > 20.f ? xv : log1pf(expf(xv));
        const float cs = wave_scan_incl(dtv * Aa, lane); const float cl = __shfl(cs, 63);
        sSC[c * 64 + (dir ? 63 - lane : lane)] = dtv * expf(cl - cs); if (lane == 0) sDEC[c] = expf(cl); }
    __syncthreads();
    f32x4 acc[4];
#pragma unroll
    for (int j = 0; j < 4; ++j) acc[j] = (f32x4){0.f, 0.f, 0.f, 0.f};
    for (int c2 = 0; c2 < 68; c2 += 2) { SD_CHUNK(c2, bfA, xfA, bfB, xfB); SD_CHUNK(c2 + 1, bfB, xfB, bfA, xfA); }
    __syncthreads();
}
#undef SD_CHUNK
#undef SD_FRAG_LOAD
__device__ __forceinline__ void ssd_out_item(const int chain, const int c, const bf16_t* __restrict__ Pm, const bf16_t* __restrict__ XBb, const bf16_t* __restrict__ XTg, const float Aa, const float dtb,
                                             const bf16_t* __restrict__ SSTb, bf16_t* __restrict__ Yout, unsigned char* shm, const int tid) {
    const int dir = chain & 1, h = (chain >> 1) & 7, b = chain >> 4, grp = h >> 2, lane = tid & 63, w = tid >> 6;
    bf16_t* Cs = (bf16_t*)shm; bf16_t* Bs = (bf16_t*)(shm + 17408); bf16_t* XT = (bf16_t*)(shm + 34816); bf16_t* Sin = (bf16_t*)(shm + 44032); bf16_t* Gs = (bf16_t*)(shm + 61440);
    float* sc = (float*)(shm + 70656);
    __syncthreads();
    u32x4 gb[2], gcc[2], gs[2], gx; unsigned gd_ = 0u;
#pragma unroll
    for (int i = 0; i < 2; ++i) { const int pid = tid + i * 512; const int s = pid >> 4, x0 = (pid & 15) * 8; const size_t toks = (size_t)step_tok(b, dir, c * 64 + s);
        gb[i] = *(const u32x4*)(XBb + toks * 1024 + 512 + grp * 128 + x0);
        gcc[i] = *(const u32x4*)(XBb + toks * 1024 + 768 + grp * 128 + x0);
        const int p = pid >> 4;
        gs[i] = *(const u32x4*)(SSTb + ((size_t)(chain * 68 + c) * 64 + p) * 128 + x0); }
    {   const int p = tid >> 3, o = tid & 7;
        gx = *(const u32x4*)(XTg + ((size_t)tokblock_of(b, dir, c) * 512 + h * 64 + p) * 64 + (dir ? 7 - o : o) * 8); }
    if (w == 0) gd_ = Pm[(size_t)step_tok(b, dir, c * 64 + lane) * LDP + SSD_OFF + 1536 + dir * 8 + h];
#pragma unroll
    for (int i = 0; i < 2; ++i) { const int pid = tid + i * 512; const int s = pid >> 4, x0 = (pid & 15) * 8;
        *(u32x4*)(Bs + s * 136 + x0) = gb[i]; *(u32x4*)(Cs + s * 136 + x0) = gcc[i]; *(u32x4*)(Sin + s * 136 + x0) = gs[i]; }
    {   const int p = tid >> 3, o = tid & 7; *(u32x4*)(XT + p * 72 + o * 8) = dir ? rev8h(gx) : gx; }
    if (w == 0) {
        const float xv = __uint_as_float(gd_ << 16) + dtb; const float dtv = xv > 20.f ? xv : log1pf(expf(xv));
        sc[lane] = wave_scan_incl(dtv * Aa, lane); sc[64 + lane] = dtv; }
    __syncthreads();
    {   const int lt = w >> 1;
        f32x4 aG[2] = {(f32x4){0.f, 0.f, 0.f, 0.f}, (f32x4){0.f, 0.f, 0.f, 0.f}};
#pragma unroll
        for (int ks = 0; ks < 4; ++ks) { const bf16x8 af = *(const bf16x8*)(Cs + (16 * lt + (lane & 15)) * 136 + ks * 32 + (lane >> 4) * 8);
#pragma unroll
            for (int i = 0; i < 2; ++i) { const int st = (w & 1) * 2 + i; const bf16x8 bfr = *(const bf16x8*)(Bs + (16 * st + (lane & 15)) * 136 + ks * 32 + (lane >> 4) * 8);
                aG[i] = __builtin_amdgcn_mfma_f32_16x16x32_bf16(af, bfr, aG[i], 0, 0, 0); } }
#pragma unroll
        for (int i = 0; i < 2; ++i) { const int s = 16 * ((w & 1) * 2 + i) + (lane & 15); const float css = sc[s], dts = sc[64 + s];
#pragma unroll
            for (int q = 0; q < 4; ++q) { const int t = 16 * lt + (lane >> 4) * 4 + q; const float val = (s <= t) ? aG[i][q] * expf(sc[t] - css) * dts : 0.f; Gs[t * 72 + s] = f2bf(val); } }
    }
    __syncthreads();
    {   const int lt = w >> 1;
        f32x4 aY[2] = {(f32x4){0.f, 0.f, 0.f, 0.f}, (f32x4){0.f, 0.f, 0.f, 0.f}};
#pragma unroll
        for (int ks = 0; ks < 4; ++ks) { const bf16x8 af = *(const bf16x8*)(Cs + (16 * lt + (lane & 15)) * 136 + ks * 32 + (lane >> 4) * 8);
#pragma unroll
            for (int i = 0; i < 2; ++i) { const int pt = (w & 1) * 2 + i; const bf16x8 bfr = *(const bf16x8*)(Sin + (16 * pt + (lane & 15)) * 136 + ks * 32 + (lane >> 4) * 8);
                aY[i] = __builtin_amdgcn_mfma_f32_16x16x32_bf16(bfr, af, aY[i], 0, 0, 0); } }
        const int t = 16 * lt + (lane & 15);
        {   const float ec = expf(sc[t]);
#pragma unroll
            for (int i = 0; i < 2; ++i) { aY[i][0] *= ec; aY[i][1] *= ec; aY[i][2] *= ec; aY[i][3] *= ec; } }
#pragma unroll
        for (int ks = 0; ks < 2; ++ks) { const bf16x8 af = *(const bf16x8*)(Gs + (16 * lt + (lane & 15)) * 72 + ks * 32 + (lane >> 4) * 8);
#pragma unroll
            for (int i = 0; i < 2; ++i) { const int pt = (w & 1) * 2 + i; const bf16x8 bfr = *(const bf16x8*)(XT + (16 * pt + (lane & 15)) * 72 + ks * 32 + (lane >> 4) * 8);
                aY[i] = __builtin_amdgcn_mfma_f32_16x16x32_bf16(bfr, af, aY[i], 0, 0, 0); } }
        {   const size_t tokt = (size_t)step_tok(b, dir, c * 64 + t);
#pragma unroll
            for (int i = 0; i < 2; ++i) { const int p0 = 16 * ((w & 1) * 2 + i) + (lane >> 4) * 4;
                u32x2 wv; wv.x = pk2(aY[i][0], aY[i][1]); wv.y = pk2(aY[i][2], aY[i][3]);
                *(u32x2*)(Yout + tokt * BW + h * 64 + p0) = wv; } }
    }
}


#define FIDX(i) ((i) + ((i) >> 4))
#define FFT_X_BYTES 69632
__device__ constexpr float FFT_CW_RE[6][16] = {{0.f, 0.f, 0.f, 0.f, 0.f, 0.f, 0.f, 0.f, 0.f, 0.f, 0.f, 0.f, 0.f, 0.f, 0.f, 0.f}, {1.0f, 0.f, 0.f, 0.f, 0.f, 0.f, 0.f, 0.f, 0.f, 0.f, 0.f, 0.f, 0.f, 0.f, 0.f, 0.f}, {1.0f, 6.123233995736766e-17f, 0.f, 0.f, 0.f, 0.f, 0.f, 0.f, 0.f, 0.f, 0.f, 0.f, 0.f, 0.f, 0.f, 0.f}, {1.0f, 0.7071067811865476f, 6.123233995736766e-17f, -0.7071067811865475f, 0.f, 0.f, 0.f, 0.f, 0.f, 0.f, 0.f, 0.f, 0.f, 0.f, 0.f, 0.f}, {1.0f, 0.9238795325112867f, 0.7071067811865476f, 0.38268343236508984f, 6.123233995736766e-17f, -0.3826834323650897f, -0.7071067811865475f, -0.9238795325112867f, 0.f, 0.f, 0.f, 0.f, 0.f, 0.f, 0.f, 0.f}, {1.0f, 0.9807852804032304f, 0.9238795325112867f, 0.8314696123025452f, 0.7071067811865476f, 0.5555702330196023f, 0.38268343236508984f, 0.19509032201612833f, 6.123233995736766e-17f, -0.1950903220161282f, -0.3826834323650897f, -0.555570233019602f, -0.7071067811865475f, -0.8314696123025453f, -0.9238795325112867f, -0.9807852804032304f}};
__device__ constexpr float FFT_CW_IM[6][16] = {{0.f, 0.f, 0.f, 0.f, 0.f, 0.f, 0.f, 0.f, 0.f, 0.f, 0.f, 0.f, 0.f, 0.f, 0.f, 0.f}, {-0.0f, 0.f, 0.f, 0.f, 0.f, 0.f, 0.f, 0.f, 0.f, 0.f, 0.f, 0.f, 0.f, 0.f, 0.f, 0.f}, {-0.0f, -1.0f, 0.f, 0.f, 0.f, 0.f, 0.f, 0.f, 0.f, 0.f, 0.f, 0.f, 0.f, 0.f, 0.f, 0.f}, {-0.0f, -0.7071067811865475f, -1.0f, -0.7071067811865476f, 0.f, 0.f, 0.f, 0.f, 0.f, 0.f, 0.f, 0.f, 0.f, 0.f, 0.f, 0.f}, {-0.0f, -0.3826834323650898f, -0.7071067811865475f, -0.9238795325112867f, -1.0f, -0.9238795325112867f, -0.7071067811865476f, -0.3826834323650899f, 0.f, 0.f, 0.f, 0.f, 0.f, 0.f, 0.f, 0.f}, {-0.0f, -0.19509032201612825f, -0.3826834323650898f, -0.5555702330196022f, -0.7071067811865475f, -0.8314696123025452f, -0.9238795325112867f, -0.9807852804032304f, -1.0f, -0.9807852804032304f, -0.9238795325112867f, -0.8314696123025455f, -0.7071067811865476f, -0.5555702330196022f, -0.3826834323650899f, -0.1950903220161286f}};
__host__ __device__ constexpr int fft_bitrev(int k, int R) { int r = 0; for (int i = 0; i < R; ++i) if (k & (1 << i)) r |= 1 << (R - 1 - i); return r; }
template <int R, bool INV>
__device__ __forceinline__ void fft_pass(float2* __restrict__ X, const float2* __restrict__ TW, const int s0, const int gidx) {
    const int lowbits = 13 - s0 - R; const int stride = 1 << lowbits;
    const int low = gidx & (stride - 1), high = gidx >> lowbits; const int base = (high << (lowbits + R)) | low;
    const int p0 = FIDX(base);
#define FFT_SLOT(k) (lowbits >= 4 ? p0 + (k) * (stride + (stride >> 4)) : p0 + (k) + ((k) >> 4))
    float2 v[1 << R];
#pragma unroll
    for (int k = 0; k < (1 << R); ++k) v[k] = X[FFT_SLOT(k)];
    const int lw = low << s0;
    if (!INV) {
#pragma unroll
        for (int j = 0; j < R; ++j) { const int hk = 1 << (R - 1 - j);
#pragma unroll
            for (int k = 0; k < (1 << R); ++k) if (!(k & hk)) { const int kk = k & (hk - 1);
                const float2 a = v[k], b = v[k + hk]; v[k] = make_float2(a.x + b.x, a.y + b.y); const float dx = a.x - b.x, dy = a.y - b.y;
                if (kk == 0) v[k + hk] = make_float2(dx, dy);
                else if (2 * kk == hk) v[k + hk] = make_float2(dy, -dx);
                else { const float cr = FFT_CW_RE[R - j][kk], ci = FFT_CW_IM[R - j][kk]; v[k + hk] = make_float2(dx * cr - dy * ci, dx * ci + dy * cr); } } }
        if (lowbits > 0) {
#pragma unroll
            for (int k = 1; k < (1 << R); ++k) { const float2 w = TW[(lw * fft_bitrev(k, R)) & 8191]; const float2 a = v[k]; v[k] = make_float2(a.x * w.x - a.y * w.y, a.x * w.y + a.y * w.x); } }
    } else {
        if (lowbits > 0) {
#pragma unroll
            for (int k = 1; k < (1 << R); ++k) { const float2 w = TW[(lw * fft_bitrev(k, R)) & 8191]; const float2 a = v[k]; v[k] = make_float2(a.x * w.x + a.y * w.y, a.y * w.x - a.x * w.y); } }
#pragma unroll
        for (int j = R - 1; j >= 0; --j) { const int hk = 1 << (R - 1 - j);
#pragma unroll
            for (int k = 0; k < (1 << R); ++k) if (!(k & hk)) { const int kk = k & (hk - 1);
                const float2 a = v[k], b = v[k + hk]; float tx, ty;
                if (kk == 0) { tx = b.x; ty = b.y; }
                else if (2 * kk == hk) { tx = -b.y; ty = b.x; }
                else { const float cr = FFT_CW_RE[R - j][kk], ci = FFT_CW_IM[R - j][kk]; tx = b.x * cr + b.y * ci; ty = b.y * cr - b.x * ci; }
                v[k] = make_float2(a.x + tx, a.y + ty); v[k + hk] = make_float2(a.x - tx, a.y - ty); } }
    }
#pragma unroll
    for (int k = 0; k < (1 << R); ++k) X[FFT_SLOT(k)] = v[k];
#undef FFT_SLOT
}
__device__ __forceinline__ void fft_fwd(float2* X, const float2* TW, const int tid) {
    fft_pass<4, false>(X, TW, 0, tid); __syncthreads(); fft_pass<4, false>(X, TW, 4, tid); __syncthreads(); if (tid < 256) fft_pass<5, false>(X, TW, 8, tid); __syncthreads(); }
__device__ __forceinline__ void fft_inv(float2* X, const float2* TW, const int tid) {
    if (tid < 256) fft_pass<5, true>(X, TW, 8, tid); __syncthreads(); fft_pass<4, true>(X, TW, 4, tid); __syncthreads(); fft_pass<4, true>(X, TW, 0, tid); __syncthreads(); }
__device__ __forceinline__ void fft_twiddles(float2* TW, const int tid) {
#pragma unroll
    for (int k = 0; k < 16; ++k) { const int m = tid + k * 512; const float xx = (float)m * (1.0f / 4096.0f); TW[m] = make_float2(cospif(xx), -sinpif(xx)); }
}
__device__ __forceinline__ void hyena_spec_item(const int oc, const float* __restrict__ HR, const float* __restrict__ nrm, float2* __restrict__ HSPEC, unsigned char* shm, const int tid) {
    float2* X = (float2*)shm; const float2* TW = (const float2*)(shm + FFT_X_BYTES);
    const int o = oc >> 9, c = oc & 511; const float inv = 1.0f / nrm[oc];
    __syncthreads();
    float hv[16];
#pragma unroll
    for (int k = 0; k < 16; ++k) { const int j = tid + k * 512;
        const unsigned off = j < SEQ ? (unsigned)j * 2048u + o * 1024 + c : j == SEQ ? (unsigned)(o * 1024 + c) : (unsigned)(2 * SEQ - j) * 2048u + o * 1024 + 512 + c;
        hv[k] = HR[off]; }
#pragma unroll
    for (int k = 0; k < 16; ++k) { const int j = tid + k * 512; X[FIDX(j)] = make_float2(j == SEQ ? 0.f : hv[k] * inv, 0.f); }
    __syncthreads();
    fft_fwd(X, TW, tid);
    float4* out = (float4*)(HSPEC + (size_t)oc * 8192 + tid * 16); const float2* xs = X + 17 * tid;
#pragma unroll
    for (int k = 0; k < 8; ++k) { const float2 x0 = xs[2 * k], x1 = xs[2 * k + 1]; out[k] = make_float4(x0.x * (1.0f / 8192.0f), x0.y * (1.0f / 8192.0f), x1.x * (1.0f / 8192.0f), x1.y * (1.0f / 8192.0f)); }
}
__device__ __forceinline__ void fft_mul_spec(float2* X, const float2* __restrict__ H, const int tid) {
    const float4* h4 = (const float4*)(H + tid * 16); float2* xs = X + 17 * tid;
#pragma unroll
    for (int k = 0; k < 8; ++k) { const float4 hv = h4[k]; const float2 x0 = xs[2 * k], x1 = xs[2 * k + 1];
        xs[2 * k] = make_float2(x0.x * hv.x - x0.y * hv.y, x0.x * hv.y + x0.y * hv.x); xs[2 * k + 1] = make_float2(x1.x * hv.z - x1.y * hv.w, x1.x * hv.w + x1.y * hv.z); }
}
__device__ __forceinline__ void hyena_fft_item(const int item, const bf16_t* __restrict__ UT, const float2* __restrict__ HSPEC, const float* __restrict__ bias, float* __restrict__ YT, unsigned char* shm, const int tid) {
    float2* X = (float2*)shm; const float2* TW = (const float2*)(shm + FFT_X_BYTES);
    const int c = item >> 1, b0 = (item & 1) * 2, b1 = b0 + 1;
    const bf16_t* u0 = UT + (size_t)(b0 * 1536 + c) * SEQ + tid * 8; const bf16_t* u1 = UT + (size_t)(b1 * 1536 + c) * SEQ + tid * 8;
    const float bias0 = bias[c], bias1 = bias[512 + c];
    float2* xs = X + FIDX(8 * tid);
    float vr[8], vi[8];
    __syncthreads();
    { const u32x4 a0 = *(const u32x4*)u0, c0 = *(const u32x4*)u1; unpack8(a0, vr); unpack8(c0, vi); }
#pragma unroll
    for (int k = 0; k < 8; ++k) { xs[k] = make_float2(vr[k], vi[k]); xs[4352 + k] = make_float2(0.f, 0.f); }
    __syncthreads();
    fft_fwd(X, TW, tid);
    fft_mul_spec(X, HSPEC + (size_t)c * 8192, tid);
    __syncthreads();
    fft_inv(X, TW, tid);
    { const bf16_t* p0 = u0 + (size_t)512 * SEQ; const bf16_t* p1 = u1 + (size_t)512 * SEQ;
      float xr[8], xi[8]; { const u32x4 a0 = *(const u32x4*)p0, c0 = *(const u32x4*)p1; unpack8(a0, xr); unpack8(c0, xi); }
#pragma unroll
      for (int k = 0; k < 8; ++k) { const float2 cv = xs[k]; const float zr = xr[k] * (cv.x + bias0 * vr[k]), zi = xi[k] * (cv.y + bias0 * vi[k]);
          vr[k] = zr; vi[k] = zi; xs[k] = make_float2(zr, zi); xs[4352 + k] = make_float2(0.f, 0.f); } }
    __syncthreads();
    fft_fwd(X, TW, tid);
    fft_mul_spec(X, HSPEC + (size_t)(512 + c) * 8192, tid);
    __syncthreads();
    fft_inv(X, TW, tid);
    { const bf16_t* p0 = u0 + (size_t)1024 * SEQ; const bf16_t* p1 = u1 + (size_t)1024 * SEQ;
      float xr[8], xi[8]; { const u32x4 a0 = *(const u32x4*)p0, c0 = *(const u32x4*)p1; unpack8(a0, xr); unpack8(c0, xi); }
      float yr[8], yi[8];
#pragma unroll
      for (int k = 0; k < 8; ++k) { const float2 cv = xs[k]; yr[k] = xr[k] * (cv.x + bias1 * vr[k]); yi[k] = xi[k] * (cv.y + bias1 * vi[k]); }
      float* y0 = YT + (size_t)(b0 * 512 + c) * SEQ + tid * 8; float* y1 = YT + (size_t)(b1 * 512 + c) * SEQ + tid * 8;
      *(float4*)y0 = make_float4(yr[0], yr[1], yr[2], yr[3]); *(float4*)(y0 + 4) = make_float4(yr[4], yr[5], yr[6], yr[7]);
      *(float4*)y1 = make_float4(yi[0], yi[1], yi[2], yi[3]); *(float4*)(y1 + 4) = make_float4(yi[4], yi[5], yi[6], yi[7]); }
}

constexpr size_t al256(size_t x) { return (x + 255) & ~(size_t)255; }
constexpr size_t O_BAR = 0;
constexpr size_t O_MOD = 16384;
constexpr size_t O_NORM = O_MOD + al256((size_t)2 * 5 * 6 * DM * 4);
constexpr size_t O_QCTR = O_NORM + al256((size_t)2 * 2 * 1024 * 4);
constexpr size_t O_ZERO_END = O_QCTR + 512;
constexpr size_t O_XS = O_ZERO_END;
constexpr size_t O_HB = O_XS + al256((size_t)NTOK * DM * 4);
constexpr size_t O_P = O_HB + al256((size_t)NTOK * DM * 2);
constexpr size_t O_WIN = O_P + al256((size_t)NTOK * LDP * 2);
constexpr size_t O_WBR = O_WIN + al256((size_t)LDP * DM * 2);
constexpr size_t O_WOUT = O_WBR + al256((size_t)4 * DM * BW * 2);
constexpr size_t O_WGU = O_WOUT + al256((size_t)DM * DM * 2);
constexpr size_t O_WD = O_WGU + al256((size_t)NEXP * 2 * DEXP * DM * 2);
constexpr size_t O_GLU = O_WD + al256((size_t)NEXP * DM * DEXP * 2);
constexpr size_t O_Y4 = O_GLU + al256((size_t)BW * BW * 2);
constexpr size_t O_U = O_Y4 + al256((size_t)NTOK * DM * 2);
constexpr size_t O_QKB = O_U + al256((size_t)NTOK * 1536 * 4);
constexpr size_t O_CST = O_QKB + al256((size_t)NTOK * 1024 * 2);
constexpr size_t O_NST = O_CST + al256((size_t)32 * 68 * 128 * 128 * 2);
constexpr size_t O_MST = O_NST + al256((size_t)32 * 68 * 128 * 4);
constexpr size_t O_XBC = O_MST + al256((size_t)32 * 68 * 4);
constexpr size_t O_SST = O_XBC + al256((size_t)NTOK * 1024 * 2);
constexpr size_t O_HF = O_SST + al256((size_t)64 * 68 * 64 * 128 * 2);
constexpr size_t O_YF = O_HF + al256((size_t)2 * NTOK * BW * 4);
constexpr size_t O_SF = O_YF + al256((size_t)2 * NTOK * BW * 4);
constexpr size_t O_LDT = O_SF + al256((size_t)2 * NCTX * BW * 4);
constexpr size_t O_AP = O_LDT + al256((size_t)4096 * 16);
constexpr size_t O_BBT = O_AP + al256((size_t)4096 * 33 * 8);
constexpr size_t O_KT = O_BBT + al256((size_t)4096 * 16 * 8);
constexpr size_t O_S5A = O_KT + al256((size_t)32 * 2 * 32 * 256 * 4);
constexpr size_t O_S5B = O_S5A + al256((size_t)32 * 512 * 768 * 2);
constexpr size_t O_XCTX = O_S5B + al256((size_t)32 * 512 * 768 * 2);
constexpr size_t O_Z = O_XCTX + al256((size_t)4 * 32 * 2 * 64 * 8);
constexpr size_t O_HRAW = O_Z + al256((size_t)NTOK * BW * 4);
constexpr size_t O_HSPEC = O_HRAW + al256((size_t)(SEQ + CTXL) * 2048 * 4);
constexpr size_t O_K2C = O_HSPEC + al256((size_t)1024 * 8192 * 8);
constexpr size_t O_GG = O_K2C + al256((size_t)(2 * CTXL) * 1024 * 4);
constexpr size_t O_PROBS = O_GG + al256((size_t)NTOK * BW * 2);
constexpr size_t O_ROWTOK = O_PROBS + al256((size_t)NTOK * 16 * 4);
constexpr size_t O_ROWGATE = O_ROWTOK + al256((size_t)NEXP * MOE_PAD * 4);
constexpr size_t O_INV = O_ROWGATE + al256((size_t)NEXP * MOE_PAD * 4);
constexpr size_t O_NORMP = O_INV + al256((size_t)NTOK * 16 * 4);
constexpr size_t WS_END = O_NORMP + al256((size_t)4 * 256 * 2048 * 4);
constexpr size_t O_XG = O_P;
constexpr size_t O_HID = O_P + al256((size_t)NEXP * MOE_PAD * DM * 2);
constexpr size_t O_YEXP = O_HID + al256((size_t)NEXP * MOE_PAD * DEXP * 2);
static_assert(O_YEXP + (size_t)NEXP * MOE_PAD * DM * 2 <= O_WIN, "MoE temporaries must fit inside P");
static_assert((size_t)NTOK * DM * 2 <= (size_t)NTOK * 1536 * 4, "ACCb must fit inside U");
static_assert((size_t)26214400 + (size_t)2 * 17825792 + (size_t)272 * 256 * 64 * 2 <= (size_t)NTOK * DM * 2, "strip buffers must fit inside HB");
static_assert(WS_END <= (size_t)1851000000, "workspace map exceeds the guaranteed size");

struct Args {
    const float* in[47];
    float* out; unsigned char* ws;
    int ph_lo, ph_hi;
};

__device__ __forceinline__ void conv_tile(const float* __restrict__ src, int ldsrc, int nvalid, int k0, int n0, bf16_t* __restrict__ dst, int lddst, int mode, float* T, int tid) {
    { const int n = tid & 63, kr = tid >> 6;
#pragma unroll
      for (int i = 0; i < 8; ++i) { const int k = i * 8 + kr; T[k * 65 + n] = (n0 + n < nvalid) ? src[(size_t)(k0 + k) * ldsrc + n0 + n] : 0.f; } }
    __syncthreads();
    { const int n = tid >> 3, kc = (tid & 7) * 8; const int gn = n0 + n;
      const int drow = mode == 0 ? gn : (32 * (gn >> 4) + (mode == 2 ? 16 : 0) + (gn & 15));
      u32x4 w; w.x = pk2(T[(kc + 0) * 65 + n], T[(kc + 1) * 65 + n]); w.y = pk2(T[(kc + 2) * 65 + n], T[(kc + 3) * 65 + n]);
      w.z = pk2(T[(kc + 4) * 65 + n], T[(kc + 5) * 65 + n]); w.w = pk2(T[(kc + 6) * 65 + n], T[(kc + 7) * 65 + n]);
      *(u32x4*)(dst + (size_t)drow * lddst + k0 + kc) = w; }
    __syncthreads();
}

#define IN(id) (lo <= (id) && (id) < hi)
#define SEAM(id) do { if (hi > (id) + 1) xcd_barrier(bar); } while (0)
#define PH_BEGIN int tid = threadIdx.x; asm volatile("" : "+v"(tid) :: "memory"); const int lane = tid & 63, wave = tid >> 6; (void)lane; (void)wave;

#define x_in (PT(0))
#define c_in (PT(1))
#define ctx_in (PT(2))
#define cctx_in (PT(3))
#define ada_w (PT(4))
#define ada_b (PT(5))
#define norm_mix (PT(6))
#define norm_ffn (PT(7))
#define w_in (PT(8))
#define XS ((float*)(a.ws + O_XS))
#define MOD ((float*)(a.ws + O_MOD))
#define NORM ((float*)(a.ws + O_NORM))
#define NORMP ((float*)(a.ws + O_NORMP))
#define MODl (MOD + (size_t)l * 5 * 6 * DM)
#define HB ((bf16_t*)(a.ws + O_HB))
#define P ((bf16_t*)(a.ws + O_P))
#define WIN ((bf16_t*)(a.ws + O_WIN))
#define WBR ((bf16_t*)(a.ws + O_WBR))
#define WOUT ((bf16_t*)(a.ws + O_WOUT))
#define WGU ((bf16_t*)(a.ws + O_WGU))
#define WD ((bf16_t*)(a.ws + O_WD))
#define GLU ((bf16_t*)(a.ws + O_GLU))
#define Y4 ((bf16_t*)(a.ws + O_Y4))
#define U ((float*)(a.ws + O_U))
#define ACCb ((bf16_t*)(a.ws + O_U))
#define QKB ((bf16_t*)(a.ws + O_QKB))
#define CST ((bf16_t*)(a.ws + O_CST))
#define NST ((float*)(a.ws + O_NST))
#define MST ((float*)(a.ws + O_MST))
#define XBC ((bf16_t*)(a.ws + O_XBC))
#define SSTB ((bf16_t*)(a.ws + O_SST))
#define HF ((bf16_t*)(a.ws + O_HF))
#define HBk (HF + (size_t)NTOK * BW)
#define YF ((bf16_t*)(a.ws + O_YF))
#define YB (YF + (size_t)NTOK * BW)
#define SF ((float*)(a.ws + O_SF))
#define SB (SF + (size_t)NCTX * BW)
#define LDT ((double2*)(a.ws + O_LDT))
#define APW ((float2*)(a.ws + O_AP))
#define BBT ((float2*)(a.ws + O_BBT))
#define KTB ((float*)(a.ws + O_KT))
#define S5A ((bf16_t*)(a.ws + O_S5A))
#define S5B ((bf16_t*)(a.ws + O_S5B))
#define XCTX ((float2*)(a.ws + O_XCTX))
#define S5P ((bf16_t*)(a.ws + O_HB))
#define XLOC ((float*)(a.ws + O_HB + (size_t)32 * 256 * 512 * 2))
#define KTG ((bf16_t*)(a.ws + O_HB + (size_t)26214400))
#define VTG ((bf16_t*)(a.ws + O_HB + (size_t)26214400 + (size_t)17825792))
#define BTG ((bf16_t*)(a.ws + O_HB + (size_t)26214400 + (size_t)2 * 17825792))
#define XTG ((bf16_t*)(a.ws + O_GG))
#define Z ((float*)(a.ws + O_Z))
#define HRAW ((float*)(a.ws + O_HRAW))
#define HSPEC ((float2*)(a.ws + O_HSPEC))
#define UT ((bf16_t*)(a.ws + O_U))
#define YT ((float*)(a.ws + O_Z))
#define QCTR ((int*)(a.ws + O_QCTR))
#define K2C ((float*)(a.ws + O_K2C))
#define GG ((bf16_t*)(a.ws + O_GG))
#define PROBS ((float*)(a.ws + O_PROBS))
#define ROWTOK ((int*)(a.ws + O_ROWTOK))
#define ROWGATE ((float*)(a.ws + O_ROWGATE))
#define XG ((bf16_t*)(a.ws + O_XG))
#define HID ((bf16_t*)(a.ws + O_HID))
#define YEXP ((bf16_t*)(a.ws + O_YEXP))
#define INV ((int*)(a.ws + O_INV))


__device__ __forceinline__ void moe_pair(float4 (&a)[8], const int r1, const int r2, const float g2scale, const int lane, const float* __restrict__ rowgate, const bf16_t* __restrict__ yexp) {
    const float gt1 = rowgate[r1], gt2 = rowgate[r2] * g2scale;
    const bf16_t* y1 = yexp + (size_t)r1 * DM + lane * 4; const bf16_t* y2 = yexp + (size_t)r2 * DM + lane * 4;
    u32x2 w1[8], w2[8];
#pragma unroll
    for (int i = 0; i < 8; ++i) { w1[i] = *(const u32x2*)(y1 + i * 256); w2[i] = *(const u32x2*)(y2 + i * 256); }
#pragma unroll
    for (int i = 0; i < 8; ++i) {
        a[i].x += gt1 * __uint_as_float(w1[i].x << 16); a[i].y += gt1 * __uint_as_float(w1[i].x & 0xFFFF0000u); a[i].z += gt1 * __uint_as_float(w1[i].y << 16); a[i].w += gt1 * __uint_as_float(w1[i].y & 0xFFFF0000u);
        a[i].x += gt2 * __uint_as_float(w2[i].x << 16); a[i].y += gt2 * __uint_as_float(w2[i].x & 0xFFFF0000u); a[i].z += gt2 * __uint_as_float(w2[i].y << 16); a[i].w += gt2 * __uint_as_float(w2[i].y & 0xFFFF0000u); }
}
__device__ __forceinline__ void moe_combine(float4 (&v)[8], const int tok, const int lane, const int* __restrict__ inv, const float* __restrict__ rowgate, const bf16_t* __restrict__ yexp, const float* __restrict__ m5) {
    float4 a[8], mm[8];
#pragma unroll
    for (int i = 0; i < 8; ++i) { a[i] = make_float4(0.f, 0.f, 0.f, 0.f); mm[i] = *(const float4*)(m5 + i * 256 + lane * 4); }
    const int4* ip = (const int4*)(inv + (size_t)tok * 16);
    const int4 q0 = ip[0], q1 = ip[1], q2 = ip[2], q3 = ip[3];
    const int rows[16] = {q0.x, q0.y, q0.z, q0.w, q1.x, q1.y, q1.z, q1.w, q2.x, q2.y, q2.z, q2.w, q3.x, q3.y, q3.z, q3.w};
    int prow = -1;
#pragma unroll
    for (int e = 0; e < 16; ++e) { const int row = __builtin_amdgcn_readfirstlane(rows[e]);
        if (row >= 0) { if (prow >= 0) { moe_pair(a, prow, row, 1.0f, lane, rowgate, yexp); prow = -1; } else prow = row; } }
    if (prow >= 0) moe_pair(a, prow, prow, 0.0f, lane, rowgate, yexp);
#pragma unroll
    for (int i = 0; i < 8; ++i) { v[i].x += mm[i].x * a[i].x; v[i].y += mm[i].y * a[i].y; v[i].z += mm[i].z * a[i].z; v[i].w += mm[i].w * a[i].w; }
}
struct CvU { const float* src; bf16_t* dst; int ldsrc, nvalid, k0, n0, lddst, mode; };
__device__ __forceinline__ void cv_load(const CvU& u, float4 (&r)[8], const int tid) {
#pragma unroll
    for (int i = 0; i < 8; ++i) { const int idx = tid + i * 512; const int k = idx >> 6, n = u.n0 + (idx & 63) * 4;
        r[i] = (n < u.nvalid) ? *(const float4*)(u.src + (size_t)(u.k0 + k) * u.ldsrc + n) : make_float4(0.f, 0.f, 0.f, 0.f); }
}
__device__ __forceinline__ void cv_stage(float* T, const float4 (&r)[8], const int tid) {
#pragma unroll
    for (int i = 0; i < 8; ++i) { const int idx = tid + i * 512; float* p = T + (idx >> 6) * 257 + (idx & 63) * 4; p[0] = r[i].x; p[1] = r[i].y; p[2] = r[i].z; p[3] = r[i].w; }
}
__device__ __forceinline__ void cv_store(const CvU& u, const float* T, const int tid) {
#pragma unroll
    for (int j = 0; j < 4; ++j) { const int o = tid + j * 512; const int kc = (o & 7) * 8, n = o >> 3; const int gn = u.n0 + n;
        const int drow = u.mode == 0 ? gn : (256 * (gn >> 7) + (u.mode == 2 ? 128 : 0) + (gn & 127));
        const float* t = T + kc * 257 + n;
        u32x4 w; w.x = pk2(t[0], t[257]); w.y = pk2(t[2 * 257], t[3 * 257]); w.z = pk2(t[4 * 257], t[5 * 257]); w.w = pk2(t[6 * 257], t[7 * 257]);
        *(u32x4*)(u.dst + (size_t)drow * u.lddst + u.k0 + kc) = w; }
}
#define CV_RUN(LL, QSTART, QSTEP, QEND) do { \
                const float* wbr = PT(40) + (size_t)(LL) * 4 * BW * DM; const float* wout = PT(41) + (size_t)(LL) * DM * DM; \
                const float* wg = PT(43) + (size_t)(LL) * NEXP * DM * DEXP; const float* wu = PT(44) + (size_t)(LL) * NEXP * DM * DEXP; const float* wd = PT(45) + (size_t)(LL) * NEXP * DEXP * DM; \
                const float* wglu = PT(32) + (size_t)(LL) * BW * BW; const float* win = w_in + (size_t)(LL) * DM * IN_W; \
                const int cv_step = (QSTEP), cv_end = (QEND); \
                __syncthreads(); \
                int q = (QSTART); int buf = 0; CvU u; float4 r[8]; \
                if (q < cv_end) { CV_DECODE(q, u); cv_load(u, r, tid); } \
                while (q < cv_end) { \
                    float* T = sf + buf * (64 * 257); \
                    cv_stage(T, r, tid); \
                    __syncthreads(); \
                    const CvU cur = u; const int qn = q + cv_step; \
                    if (qn < cv_end) { CV_DECODE(qn, u); cv_load(u, r, tid); } \
                    cv_store(cur, T, tid); \
                    buf ^= 1; q = qn; \
                } \
                __syncthreads(); } while (0)
#define CV_DECODE(q_, u_) do { int qq_ = (q_); \
                    if (qq_ < n_win) { u_ = CvU{win, WIN, IN_W, IN_W, (qq_ / 55) * 64, (qq_ % 55) * 256, DM, 0}; } else { qq_ -= n_win; \
                    if (qq_ < n_br) { const int k = qq_ >> 6, r = qq_ & 63; u_ = CvU{wbr + (size_t)k * BW * DM, WBR + (size_t)k * DM * BW, DM, DM, (r >> 3) * 64, (r & 7) * 256, BW, 0}; } else { qq_ -= n_br; \
                    if (qq_ < n_out) { u_ = CvU{wout, WOUT, DM, DM, (qq_ >> 3) * 64, (qq_ & 7) * 256, DM, 0}; } else { qq_ -= n_out; \
                    if (qq_ < n_glu) { u_ = CvU{wglu, GLU, BW, BW, (qq_ >> 1) * 64, (qq_ & 1) * 256, BW, 0}; } else { qq_ -= n_glu; \
                    if (qq_ < n_gu) { const int e = qq_ / 384, r = qq_ % 384, up = r / 192, r2 = r % 192; u_ = CvU{(up ? wu : wg) + (size_t)e * DM * DEXP, WGU + (size_t)e * 2 * DEXP * DM, DEXP, DEXP, (r2 / 6) * 64, (r2 % 6) * 256, DM, 1 + up}; } else { qq_ -= n_gu; \
                    { const int e = qq_ / 192, r = qq_ % 192; u_ = CvU{wd + (size_t)e * DEXP * DM, WD + (size_t)e * DM * DEXP, DM, DM, (r >> 3) * 64, (r & 7) * 256, DEXP, 0}; } } } } } } } while (0)
template <int LAYER>
__device__ __forceinline__ void layer_body(const Args& a, const XcdBarrier& bar, const int lo, const int hi, const int bid, const int G, unsigned char* const shm, float* const sf, const float** const ptab) {
        constexpr int l = LAYER;
        constexpr int PB = 1 + 16 * l;
        const bool lastl = (l == 1);

        const int nPanels = lastl ? 64 : 68;
        const int M2 = nPanels * 256;

        if (IN(PB + 0)) for (int rep_ = 0; rep_ < (l == 0 ? PROBE_REPS(0) : 1); ++rep_) {
            PH_BEGIN
            {   const int n_win = 32 * 55, n_br = 4 * 64, n_out = 32 * 8, n_glu = 16, n_gu = 16 * 2 * 192, n_d = 16 * 192;
                const int n_grp1 = n_win + n_br + n_out + n_glu, total = n_grp1 + n_gu + n_d;
                const int q_lo = (l > 0 && G > 128) ? n_win : 0;
                CV_RUN(l, q_lo + bid, G, total);
            }
            for (int set = 0; set < (lastl ? 1 : 2); ++set) {
                const int L = set ? CTXL : SEQ; float* HR = HRAW + (set ? (size_t)SEQ * 2048 : 0);
                const float* w1 = PT(11) + l * 33 * 64; const float* b1 = PT(12) + l * 64; const float* fr1 = PT(13) + l * 64; const float* w2 = PT(14) + l * 64 * 64; const float* b2 = PT(15) + l * 64;
                const float* fr2 = PT(16) + l * 64; const float* w3 = PT(17) + l * 64 * 2048; const float* decay = PT(18) + l * 2048;
                float* feats = sf; float* h1 = sf + 16 * 33; float* h2 = h1 + 16 * 64;
                float nacc[4] = {0.f, 0.f, 0.f, 0.f};
                for (int base = bid; base < L; base += 16 * G) {
                    __syncthreads();
                    for (int e = tid; e < 16 * 33; e += NTHR) { const int ti = e / 33, fi = e % 33; int t = base + ti * G; if (t > L - 1) t = L - 1;
                        float v;
                        if (fi == 0) v = (float)t / (float)(L - 1);
                        else { const int j = (fi - 1) & 15; const double fr = 1e-4 + (double)j * ((15.0 - 1e-4) / 15.0); const double ang = (2.0 * 3.14159265358979323846 / (double)L) * (double)t * fr; v = fi <= 16 ? (float)cos(ang) : (float)(-sin(ang)); }
                        feats[e] = v; }
                    __syncthreads();
                    { const int j = tid & 63, ti = tid >> 6; float s0 = b1[j], s1 = s0;
_Pragma("unroll 3")
                      for (int i = 0; i < 33; ++i) { const float wv = w1[i * 64 + j]; s0 += feats[ti * 33 + i] * wv; s1 += feats[(ti + 8) * 33 + i] * wv; }
                      const float f1 = fr1[j]; h1[ti * 64 + j] = sinf(f1 * s0); h1[(ti + 8) * 64 + j] = sinf(f1 * s1); }
                    __syncthreads();
                    { const int j = tid & 63, ti = tid >> 6; float s0 = b2[j], s1 = s0;
_Pragma("unroll 4")
                      for (int i = 0; i < 64; ++i) { const float wv = w2[i * 64 + j]; s0 += h1[ti * 64 + i] * wv; s1 += h1[(ti + 8) * 64 + i] * wv; }
                      const float f2 = fr2[j]; h2[ti * 64 + j] = sinf(f2 * s0); h2[(ti + 8) * 64 + j] = sinf(f2 * s1); }
                    __syncthreads();
                    float acc[16][4];
#pragma unroll
                    for (int ti = 0; ti < 16; ++ti) { acc[ti][0] = 0.f; acc[ti][1] = 0.f; acc[ti][2] = 0.f; acc[ti][3] = 0.f; }
#pragma unroll 2
                    for (int i = 0; i < 64; ++i) { const float* wrow = w3 + (size_t)i * 2048 + tid; const float wa = wrow[0], wb = wrow[512], wc2 = wrow[1024], wd2 = wrow[1536];
#pragma unroll
                        for (int ti = 0; ti < 16; ++ti) { const float hv = h2[ti * 64 + i]; acc[ti][0] += hv * wa; acc[ti][1] += hv * wb; acc[ti][2] += hv * wc2; acc[ti][3] += hv * wd2; } }
                    float dk[4];
#pragma unroll
                    for (int k = 0; k < 4; ++k) dk[k] = fabsf(decay[tid + k * 512]);
#pragma unroll
                    for (int ti = 0; ti < 16; ++ti) { const int t = base + ti * G; if (t < L) { const float tn = (float)t / (float)(L - 1);
#pragma unroll
                        for (int k = 0; k < 4; ++k) { const float v = acc[ti][k] * expf(-tn * dk[k]); HR[(size_t)t * 2048 + tid + k * 512] = v; nacc[k] += fabsf(v); } } }
                }
                float* nrp = NORMP + ((size_t)(l * 2 + set) * 256 + bid) * 2048;
#pragma unroll
                for (int k = 0; k < 4; ++k) nrp[tid + k * 512] = nacc[k];
            }
            for (int idx = bid * NTHR + tid; idx < 4096; idx += G * NTHR) { const int n = idx & 63, g = (idx >> 6) & 31, dir = idx >> 11;
                const double are = (double)(PT(24) + l * 4096)[idx], aim = (double)(PT(25) + l * 4096)[idx]; const double lam = are < -1e-4 ? are : -1e-4; const double dt = exp((double)(PT(26) + l * 64)[dir * 32 + g]);
                const double ldre = lam * dt, ldim = aim * dt; LDT[idx] = make_double2(ldre, ldim);
                const double mag = exp(ldre); const double ar = mag * cos(ldim), ai = mag * sin(ldim);
                const double den = lam * lam + aim * aim; const double nr = ar - 1.0, ni = ai; const double fre = (nr * lam + ni * aim) / den, fim = (ni * lam - nr * aim) / den;
                const float* b_re = PT(27) + l * 32 * 64 * 16; const float* b_im = PT(28) + l * 32 * 64 * 16;
#pragma unroll 4
                for (int c = 0; c < 16; ++c) { const double br = (double)b_re[(g * 64 + n) * 16 + c], bi = (double)b_im[(g * 64 + n) * 16 + c]; BBT[idx * 16 + c] = make_float2((float)(fre * br - fim * bi), (float)(fre * bi + fim * br)); }
            }
            for (int e2 = bid * NTHR + tid; e2 < 4096 * 33; e2 += G * NTHR) { const int idx = e2 / 33, k = e2 - idx * 33; const int g = (idx >> 6) & 31, dir = idx >> 11;
                const double are = (double)(PT(24) + l * 4096)[idx], aim = (double)(PT(25) + l * 4096)[idx]; const double lam = are < -1e-4 ? are : -1e-4; const double dt = exp((double)(PT(26) + l * 64)[dir * 32 + g]);
                const double ldre = lam * dt, ldim = aim * dt; const double mk = exp(ldre * k); APW[e2] = make_float2((float)(mk * cos(ldim * k)), (float)(mk * sin(ldim * k))); }
            if (l == 0 && lo == 0) xcd_barrier(bar);
            for (int tok = bid * 8 + wave; tok < NTOK; tok += G * 8) {
                const int r = tok < NLAT ? tok / SEQ : 4; const float* xr = l == 0 ? (tok < NLAT ? x_in + (size_t)tok * DM : ctx_in + (size_t)(tok - NLAT) * DM) : XS + (size_t)tok * DM; const float* gn = norm_mix + l * DM;
                const float* sh = MODl + (size_t)(r * 6 + 0) * DM; const float* sc = MODl + (size_t)(r * 6 + 1) * DM;
                float4 v[8]; float ss = 0.f;
#pragma unroll
                for (int i = 0; i < 8; ++i) v[i] = *(const float4*)(xr + i * 256 + lane * 4);
                if (l > 0) {
                    moe_combine(v, tok, lane, INV, ROWGATE, YEXP, MOD + (size_t)((l - 1) * 5 + r) * 6 * DM + 5 * DM);
#pragma unroll
                    for (int i = 0; i < 8; ++i) *(float4*)(XS + (size_t)tok * DM + i * 256 + lane * 4) = v[i]; }
#pragma unroll
                for (int i = 0; i < 8; ++i) ss += v[i].x * v[i].x + v[i].y * v[i].y + v[i].z * v[i].z + v[i].w * v[i].w;
                ss = wave_sum(ss); const float rs = rsqrtf(ss * (1.0f / DM) + 1e-6f);
#pragma unroll
                for (int i = 0; i < 8; ++i) { const int d = i * 256 + lane * 4; const float4 g4 = *(const float4*)(gn + d), s4 = *(const float4*)(sc + d), h4 = *(const float4*)(sh + d);
                    v[i].x = v[i].x * rs * g4.x * (1.f + s4.x) + h4.x; v[i].y = v[i].y * rs * g4.y * (1.f + s4.y) + h4.y; v[i].z = v[i].z * rs * g4.z * (1.f + s4.z) + h4.z; v[i].w = v[i].w * rs * g4.w * (1.f + s4.w) + h4.w; }
#pragma unroll
                for (int i = 0; i < 8; ++i) { u32x2 w; w.x = pk2(v[i].x, v[i].y); w.y = pk2(v[i].z, v[i].w); *(u32x2*)(HB + (size_t)tok * DM + i * 256 + lane * 4) = w; }
            }
            SEAM(PB + 0);
        }

        if (IN(PB + 1)) for (int rep_ = 0; rep_ < PROBE_REPS(1); ++rep_) {
            PH_BEGIN
            for (int base = bid * 8; base < (lastl ? 1 : 2) * 1024; base += G * 8) {
                const int idx = base + (tid & 7), sl = tid >> 3; const int set = idx >> 10, oc = idx & 1023, o = oc >> 9, c = oc & 511;
                const float* pp = NORMP + (size_t)(l * 2 + set) * 256 * 2048 + o * 1024 + c + (size_t)(sl * 4) * 2048; float sacc = 0.f;
#pragma unroll
                for (int j = 0; j < 4; ++j) { const float p0 = pp[(size_t)j * 2048], p1 = pp[(size_t)j * 2048 + 512]; sacc += (sl * 4 + j < G) ? p0 + p1 : 0.f; }
                sf[sl * 8 + (tid & 7)] = sacc; __syncthreads();
                if (tid < 8) { float t = 0.f;
#pragma unroll 8
                    for (int q = 0; q < 64; ++q) t += sf[q * 8 + tid];
                    NORM[(size_t)(l * 2 + set) * 1024 + oc] = t; }
                __syncthreads(); }
            for (int idx = (G - 1 - bid) * NTHR + tid; idx < 32768; idx += G * NTHR) { const int c = idx & 15, lag = (idx >> 4) & 31, dir = (idx >> 9) & 1, g = idx >> 10;
                const float* c_re = PT(29) + l * 32 * 16 * 64 + (g * 16 + c) * 64; const float* c_im = PT(30) + l * 32 * 16 * 64 + (g * 16 + c) * 64;
                float acc[16];
#pragma unroll
                for (int j = 0; j < 16; ++j) acc[j] = 0.f;
#pragma unroll 2
                for (int n = 0; n < 64; ++n) { const int pi = (dir * 32 + g) * 64 + n; const float2 ap = APW[pi * 33 + lag]; const float cr = c_re[n], ci = c_im[n]; const float wr_ = cr * ap.x - ci * ap.y, wi_ = cr * ap.y + ci * ap.x;
                    const float4* bb = (const float4*)(BBT + pi * 16);
#pragma unroll
                    for (int j = 0; j < 8; ++j) { const float4 b2 = bb[j]; acc[2 * j] += wr_ * b2.x - wi_ * b2.y; acc[2 * j + 1] += wr_ * b2.z - wi_ * b2.w; } }
                float4* o = (float4*)(KTB + (size_t)idx * 16);
                o[0] = make_float4(acc[0], acc[1], acc[2], acc[3]); o[1] = make_float4(acc[4], acc[5], acc[6], acc[7]); o[2] = make_float4(acc[8], acc[9], acc[10], acc[11]); o[3] = make_float4(acc[12], acc[13], acc[14], acc[15]);
            }
            __syncthreads();
            pg8::Gemm g{HB, WIN, DM, DM, DM}; pg8::SchedStd S{68, 55, G, bid, DM, DM}; pg8::EpiWin E{P, LDP};
            pg8::gemm_phase(( LAS unsigned char*)shm, g, S, E);
#if defined(PROBE_BNOEPI)
            { __syncthreads(); pg8::EpiNone E0; pg8::gemm_phase((LAS unsigned char*)shm, g, S, E0); }
#endif
            SEAM(PB + 1);
        }

        if (IN(PB + 2)) for (int rep_ = 0; rep_ < PROBE_REPS(2); ++rep_) {
            PH_BEGIN
            const float* hcw = PT(9) + l * 3 * 1536; const float* hcb = PT(10) + l * 1536; const float* mcw = PT(20) + l * 3 * 1024; const float* mcb = PT(21) + l * 1024;
            const float* scw = PT(34) + l * 3 * 1024; const float* scb = PT(35) + l * 1024;
            for (int unit = bid; unit < 272 * 3; unit += G) { const int seg = unit / 3, kind = unit % 3; const bool lat = seg < 256; const size_t tok0 = lat ? (size_t)seg * 64 : (size_t)NLAT + (size_t)(seg - 256) * 64;
                if (kind < 2) { const int hf = kind;
                    const int c = tid * 2; const int col = (hf ? SSD_OFF + 512 : ML_OFF) + c; const float* w = hf ? scw : mcw; const float* bsp = hf ? scb : mcb; bf16_t* dst = (hf ? XBC : QKB) + tok0 * 1024 + c;
                    const float2 w0 = *(const float2*)(w + c), w1 = *(const float2*)(w + 1024 + c), w2 = *(const float2*)(w + 2048 + c), bb = *(const float2*)(bsp + c);
                    const float osc = (!hf && c >= 512) ? 0.08838834764831845f : 1.0f;
                    const bool hasPrev = !lat && ((tok0 - NLAT) & (CTXL - 1)) != 0, hasNext = !lat && (((tok0 - NLAT) + 63) & (CTXL - 1)) != CTXL - 1;
                    bf16_t* strip = nullptr;
                    if (!hf) { if (c >= 512) strip = KTG + ((size_t)seg * 512 + (c - 512)) * 64; }
                    else { if (c < 512) strip = XTG + ((size_t)seg * 512 + c) * 64; else if (c < 768) strip = BTG + ((size_t)seg * 256 + (c - 512)) * 64; }
                    const bf16_t* pp = P + tok0 * LDP + col;
                    unsigned raw[66];
#pragma unroll
                    for (int t = 0; t < 66; ++t) raw[t] = ((t == 0 && !hasPrev) || (t == 65 && !hasNext)) ? 0u : *(const unsigned*)(pp + (ptrdiff_t)(t - 1) * LDP);
#pragma unroll
                    for (int t8 = 0; t8 < 8; ++t8) { float v0[8], v1[8];
#pragma unroll
                        for (int tt = 0; tt < 8; ++tt) { const int t = t8 * 8 + tt; const unsigned p0 = raw[t], p1 = raw[t + 1], p2 = raw[t + 2];
                            float a0 = bb.x + w0.x * __uint_as_float(p0 << 16) + w1.x * __uint_as_float(p1 << 16) + w2.x * __uint_as_float(p2 << 16);
                            float a1 = bb.y + w0.y * __uint_as_float(p0 & 0xFFFF0000u) + w1.y * __uint_as_float(p1 & 0xFFFF0000u) + w2.y * __uint_as_float(p2 & 0xFFFF0000u);
                            a0 = siluf_(a0) * osc; a1 = siluf_(a1) * osc; v0[tt] = a0; v1[tt] = a1;
                            *(unsigned*)(dst + (size_t)t * 1024) = pk2(a0, a1); }
                        if (strip) { u32x4 s0, s1; s0.x = pk2(v0[0], v0[1]); s0.y = pk2(v0[2], v0[3]); s0.z = pk2(v0[4], v0[5]); s0.w = pk2(v0[6], v0[7]); s1.x = pk2(v1[0], v1[1]); s1.y = pk2(v1[2], v1[3]); s1.z = pk2(v1[4], v1[5]); s1.w = pk2(v1[6], v1[7]);
                            *(u32x4*)(strip + t8 * 8) = s0; *(u32x4*)(strip + 64 + t8 * 8) = s1; } }
                } else {
                    const int c = (tid & 255) * 2, th = tid >> 8; const bf16_t* pp = P + (tok0 + th * 32) * LDP + ML_OFF + 1024 + c; bf16_t* strip = VTG + ((size_t)seg * 512 + c) * 64 + th * 32;
                    unsigned rv[32];
#pragma unroll
                    for (int t = 0; t < 32; ++t) rv[t] = *(const unsigned*)(pp + (size_t)t * LDP);
#pragma unroll
                    for (int t8 = 0; t8 < 4; ++t8) { u32x4 s0, s1;
                        s0.x = (rv[t8 * 8 + 0] & 0xFFFFu) | (rv[t8 * 8 + 1] << 16); s0.y = (rv[t8 * 8 + 2] & 0xFFFFu) | (rv[t8 * 8 + 3] << 16); s0.z = (rv[t8 * 8 + 4] & 0xFFFFu) | (rv[t8 * 8 + 5] << 16); s0.w = (rv[t8 * 8 + 6] & 0xFFFFu) | (rv[t8 * 8 + 7] << 16);
                        s1.x = (rv[t8 * 8 + 0] >> 16) | (rv[t8 * 8 + 1] & 0xFFFF0000u); s1.y = (rv[t8 * 8 + 2] >> 16) | (rv[t8 * 8 + 3] & 0xFFFF0000u); s1.z = (rv[t8 * 8 + 4] >> 16) | (rv[t8 * 8 + 5] & 0xFFFF0000u); s1.w = (rv[t8 * 8 + 6] >> 16) | (rv[t8 * 8 + 7] & 0xFFFF0000u);
                        *(u32x4*)(strip + t8 * 8) = s0; *(u32x4*)(strip + 64 + t8 * 8) = s1; }
                }
            }
            if (!lastl) for (int tok = NLAT + bid; tok < NTOK; tok += G) {
                const int t = (tok - NLAT) & (CTXL - 1); const bool hasL = (t != 0), hasR = (t != CTXL - 1); const bf16_t* pr = P + (size_t)tok * LDP;
                const bf16_t* prL = hasL ? pr - LDP : pr; const bf16_t* prR = hasR ? pr + LDP : pr;
                unsigned xc[3], xl[3], xr[3];
#pragma unroll
                for (int j = 0; j < 3; ++j) { const int cc = tid + j * 512; xc[j] = pr[HY_OFF + cc]; xl[j] = prL[HY_OFF + cc]; xr[j] = prR[HY_OFF + cc]; }
#pragma unroll
                for (int j = 0; j < 3; ++j) { const int cc = tid + j * 512;
                    float acc = hcb[cc] + hcw[1536 + cc] * __uint_as_float(xc[j] << 16);
                    acc += hasL ? hcw[cc] * __uint_as_float(xl[j] << 16) : 0.f;
                    acc += hasR ? hcw[2 * 1536 + cc] * __uint_as_float(xr[j] << 16) : 0.f;
                    U[(size_t)tok * 1536 + cc] = acc; }
            }
            for (int idx0 = bid * NTHR + tid; idx0 < 16384 * 64; idx0 += 4 * G * NTHR) { u32x4 t4[4];
#pragma unroll
                for (int q = 0; q < 4; ++q) { const int idx = idx0 + q * G * NTHR; const int half = idx & 1, g = (idx >> 1) & 31, tok = idx >> 6;
                    if (idx < 16384 * 64) t4[q] = *(const u32x4*)(P + (size_t)tok * LDP + S5_OFF + g * 16 + half * 8); }
#pragma unroll
                for (int q = 0; q < 4; ++q) { const int idx = idx0 + q * G * NTHR; const int half = idx & 1, g = (idx >> 1) & 31, tok = idx >> 6;
                    if (idx < 16384 * 64) *(u32x4*)(S5A + ((size_t)g * 512 + (tok >> 5)) * 768 + (tok & 31) * 16 + half * 8) = t4[q]; } }
            for (int idx = bid * NTHR + tid; idx < 32 * 512 * 32 * 2; idx += G * NTHR) { const int half = idx & 1, sI = (idx >> 1) & 31, row = (idx >> 6) & 511, g = idx >> 15; const int t = row >> 4, c = row & 15; const int lag = t - sI;
                float v[8];
                if (lag > 0) { const float4* k4 = (const float4*)(KTB + ((size_t)((g * 2 + 0) * 32 + lag) * 16 + c) * 16 + half * 8); const float4 a0 = k4[0], a1 = k4[1]; v[0] = a0.x; v[1] = a0.y; v[2] = a0.z; v[3] = a0.w; v[4] = a1.x; v[5] = a1.y; v[6] = a1.z; v[7] = a1.w; }
                else if (lag < 0) { const float4* k4 = (const float4*)(KTB + ((size_t)((g * 2 + 1) * 32 - lag) * 16 + c) * 16 + half * 8); const float4 a0 = k4[0], a1 = k4[1]; v[0] = a0.x; v[1] = a0.y; v[2] = a0.z; v[3] = a0.w; v[4] = a1.x; v[5] = a1.y; v[6] = a1.z; v[7] = a1.w; }
                else { const float4* k4 = (const float4*)(KTB + ((size_t)((g * 2 + 0) * 32) * 16 + c) * 16 + half * 8); const float4* q4 = (const float4*)(KTB + ((size_t)((g * 2 + 1) * 32) * 16 + c) * 16 + half * 8); const float4 a0 = k4[0], a1 = k4[1], b0 = q4[0], b1 = q4[1];
                    v[0] = a0.x + b0.x; v[1] = a0.y + b0.y; v[2] = a0.z + b0.z; v[3] = a0.w + b0.w; v[4] = a1.x + b1.x; v[5] = a1.y + b1.y; v[6] = a1.z + b1.z; v[7] = a1.w + b1.w; }
                u32x4 w; w.x = pk2(v[0], v[1]); w.y = pk2(v[2], v[3]); w.z = pk2(v[4], v[5]); w.w = pk2(v[6], v[7]);
                *(u32x4*)(S5B + ((size_t)g * 512 + row) * 768 + sI * 16 + half * 8) = w; }
            for (int idx = bid * NTHR + tid; idx < 32 * 512 * 64; idx += G * NTHR) { const int n = idx & 63, row = (idx >> 6) & 511, g = idx >> 15; const int t = row >> 4, c = row & 15;
                const float cr = (PT(29) + l * 32 * 16 * 64)[(g * 16 + c) * 64 + n], ci = (PT(30) + l * 32 * 16 * 64)[(g * 16 + c) * 64 + n];
                const float2 af = APW[((0 * 32 + g) * 64 + n) * 33 + t + 1], ab = APW[((1 * 32 + g) * 64 + n) * 33 + 32 - t];
                bf16_t* d = S5B + ((size_t)g * 512 + row) * 768 + 512 + 2 * n;
                *(unsigned*)d = pk2(cr * af.x - ci * af.y, -(cr * af.y + ci * af.x)); *(unsigned*)(d + 128) = pk2(cr * ab.x - ci * ab.y, -(cr * ab.y + ci * ab.x)); }
            for (int idx = bid * NTHR + tid; idx < 32 * 2 * 64 * 32; idx += G * NTHR) { const int sI = idx & 31, n = (idx >> 5) & 63, dir = (idx >> 11) & 1, g = idx >> 12; const int pi = (dir * 32 + g) * 64 + n;
                const float2 pw = APW[pi * 33 + (dir ? sI : 31 - sI)]; const float4* bb = (const float4*)(BBT + pi * 16);
                float re[16], im[16];
#pragma unroll
                for (int j = 0; j < 8; ++j) { const float4 b2 = bb[j]; re[2 * j] = pw.x * b2.x - pw.y * b2.y; im[2 * j] = pw.x * b2.y + pw.y * b2.x; re[2 * j + 1] = pw.x * b2.z - pw.y * b2.w; im[2 * j + 1] = pw.x * b2.w + pw.y * b2.z; }
                bf16_t* d = S5P + ((size_t)g * 256 + dir * 128 + 2 * n) * 512 + sI * 16;
                u32x4 w0, w1; w0.x = pk2(re[0], re[1]); w0.y = pk2(re[2], re[3]); w0.z = pk2(re[4], re[5]); w0.w = pk2(re[6], re[7]); w1.x = pk2(re[8], re[9]); w1.y = pk2(re[10], re[11]); w1.z = pk2(re[12], re[13]); w1.w = pk2(re[14], re[15]);
                *(u32x4*)d = w0; *(u32x4*)(d + 8) = w1;
                w0.x = pk2(im[0], im[1]); w0.y = pk2(im[2], im[3]); w0.z = pk2(im[4], im[5]); w0.w = pk2(im[6], im[7]); w1.x = pk2(im[8], im[9]); w1.y = pk2(im[10], im[11]); w1.z = pk2(im[12], im[13]); w1.w = pk2(im[14], im[15]);
                *(u32x4*)(d + 512) = w0; *(u32x4*)(d + 520) = w1; }
            {   float* T = sf;
                for (int unit = bid; unit < 4 * 64 * 24; unit += G) { const int b = unit / (64 * 24), r = (unit / 24) % 64, c0 = (unit % 24) * 64; const size_t tok0 = (size_t)b * SEQ + r * 64;
                    __syncthreads();
#pragma unroll
                    for (int i = 0; i < 8; ++i) { const int c = tid & 63, t = (tid >> 6) + 8 * i; T[t * 65 + c] = bf2f(P[(tok0 + t) * LDP + HY_OFF + c0 + c]); }
                    __syncthreads();
                    const int c = tid >> 3, tq = (tid & 7) * 8, cc = c0 + c; const float w0 = hcw[cc], w1 = hcw[1536 + cc], w2 = hcw[3072 + cc], bb = hcb[cc];
                    float o8[8];
#pragma unroll
                    for (int i = 0; i < 8; ++i) { const int t = tq + i; float acc = bb + w1 * T[t * 65 + c]; if (t > 0) acc += w0 * T[(t - 1) * 65 + c]; if (t < 63) acc += w2 * T[(t + 1) * 65 + c]; o8[i] = acc; }
                    bf16_t* dst = UT + ((size_t)b * 1536 + cc) * SEQ + r * 64 + tq;
                    { u32x4 wv; wv.x = pk2(o8[0], o8[1]); wv.y = pk2(o8[2], o8[3]); wv.z = pk2(o8[4], o8[5]); wv.w = pk2(o8[6], o8[7]); *(u32x4*)dst = wv; }
                } }
            if (!lastl) {
                const int L = CTXL; const float* HR = HRAW + (size_t)SEQ * 2048; float* K2 = K2C; const float* nrm = NORM + (size_t)(l * 2 + 1) * 1024;
                const size_t total = (size_t)(2 * L - 1) * 1024;
                for (size_t i = (size_t)bid * NTHR + tid; i < total; i += (size_t)G * NTHR) { const int j = (int)(i >> 10), oc = (int)(i & 1023), o = oc >> 9, c = oc & 511; const int lag = j - (L - 1);
                    const float v = lag >= 0 ? HR[(size_t)lag * 2048 + o * 1024 + c] : HR[(size_t)(-lag) * 2048 + o * 1024 + 512 + c];
                    K2[((size_t)j * 2 + o) * 512 + c] = v / nrm[oc]; }
            }
            {   __syncthreads(); fft_twiddles((float2*)(shm + FFT_X_BYTES), tid);
                for (int oc = bid; oc < 1024; oc += G) hyena_spec_item(oc, HRAW, NORM + (size_t)(l * 2 + 0) * 1024, HSPEC, shm, tid);
                __syncthreads(); }
            SEAM(PB + 2);
        }

        if (IN(PB + 3)) for (int rep_ = 0; rep_ < PROBE_REPS(3); ++rep_) {
            PH_BEGIN
            if (rep_ > 0) { if (bid == 0 && tid == 0) __hip_atomic_store(QCTR + l * 64, 0, __ATOMIC_RELAXED, __HIP_MEMORY_SCOPE_AGENT); xcd_barrier(bar); }
            if (bid < 64) {
                mlstm_state_pass(bid >> 1, bid & 1, P, KTG, VTG, PT(22) + l * 16, CST, NST, MST, shm, tid);
            } else if (bid < 128) {
                { const int ch = bid - 64; const int dir_ = ch & 1, h_ = (ch >> 1) & 7; ssd_state_pass(ch, P, BTG, XTG, -expf(PT(37)[l * 16 + dir_ * 8 + h_]), PT(36)[l * 16 + dir_ * 8 + h_], SSTB, shm, tid); }
            } else if (bid < 160) {
                const int widx = (bid - 128) * 8 + wave; const int dir = widx & 1, g = (widx >> 1) & 31, b = widx >> 6; const int n = lane;
                float2* xb = (float2*)(shm + (size_t)wave * 16640); float2* ctab = xb + 16 * 65;
                const float* a_re = PT(24) + l * 2 * 32 * 64; const float* a_im = PT(25) + l * 2 * 32 * 64; const float* log_dt = PT(26) + l * 64;
                const float* b_re = PT(27) + l * 32 * 64 * 16; const float* b_im = PT(28) + l * 32 * 64 * 16; const float* c_re = PT(29) + l * 32 * 16 * 64; const float* c_im = PT(30) + l * 32 * 16 * 64;
#pragma unroll
                for (int c = 0; c < 16; ++c) ctab[c * 65 + lane] = make_float2(c_re[(g * 16 + c) * 64 + lane], c_im[(g * 16 + c) * 64 + lane]);
                float abr, abi, bbr[16], bbi[16];
                {   const double are = (double)a_re[(dir * 32 + g) * 64 + n], aim = (double)a_im[(dir * 32 + g) * 64 + n];
                    const double lam = are < -1e-4 ? are : -1e-4; const double dt = exp((double)log_dt[dir * 32 + g]);
                    const double mag = exp(lam * dt); const double ar = mag * cos(aim * dt), ai = mag * sin(aim * dt);
                    const double den = lam * lam + aim * aim; const double nr = ar - 1.0, ni = ai;
                    const double fre = (nr * lam + ni * aim) / den, fim = (ni * lam - nr * aim) / den;
                    abr = (float)ar; abi = (float)ai;
#pragma unroll
                    for (int c = 0; c < 16; ++c) { const double br = (double)b_re[(g * 64 + n) * 16 + c], bi = (double)b_im[(g * 64 + n) * 16 + c]; bbr[c] = (float)(fre * br - fim * bi); bbi[c] = (float)(fre * bi + fim * br); }
                }
                float xr = 0.f, xi = 0.f; float* Sout = (dir ? SB : SF) - (size_t)NLAT * BW;
                const int s = lane >> 2, cg = lane & 3;
                for (int i0 = 0; i0 < CTXL; i0 += 16) {
#pragma unroll 4
                    for (int ss = 0; ss < 16; ++ss) {
                        const size_t tok = (size_t)step_tok(b, dir, i0 + ss);
                        const u32x4* up = (const u32x4*)(P + tok * LDP + S5_OFF + g * 16);
                        float t0[8], t1[8]; unpack8(up[0], t0); unpack8(up[1], t1);
                        float bur = 0.f, bui = 0.f;
#pragma unroll
                        for (int c = 0; c < 8; ++c) { bur += t0[c] * bbr[c] + t1[c] * bbr[8 + c]; bui += t0[c] * bbi[c] + t1[c] * bbi[8 + c]; }
                        const float nxr = abr * xr - abi * xi + bur, nxi = abr * xi + abi * xr + bui; xr = nxr; xi = nxi;
                        xb[ss * 65 + lane] = make_float2(xr, xi);
                    }
                    asm volatile("s_waitcnt lgkmcnt(0)" ::: "memory");
                    float y0 = 0.f, y1 = 0.f, y2 = 0.f, y3 = 0.f;
                    for (int nn2 = 0; nn2 < 64; ++nn2) { const float2 xv = xb[s * 65 + nn2];
                        const float2 c0 = ctab[(cg * 4 + 0) * 65 + nn2], c1 = ctab[(cg * 4 + 1) * 65 + nn2], c2 = ctab[(cg * 4 + 2) * 65 + nn2], c3 = ctab[(cg * 4 + 3) * 65 + nn2];
                        y0 += xv.x * c0.x - xv.y * c0.y; y1 += xv.x * c1.x - xv.y * c1.y; y2 += xv.x * c2.x - xv.y * c2.y; y3 += xv.x * c3.x - xv.y * c3.y; }
                    const size_t toks = (size_t)step_tok(b, dir, i0 + s);
                    *(float4*)(Sout + toks * BW + g * 16 + cg * 4) = make_float4(y0, y1, y2, y3);
                    asm volatile("s_waitcnt lgkmcnt(0)" ::: "memory");
                }
                XCTX[((b * 32 + g) * 2 + dir) * 64 + n] = make_float2(xr, xi);
            } else {
                if (bid < 224) {
                    pg8::Gemm gg_{S5A, S5P, 768, 512, 512}; pg8::SchedS5a S_{bid - 160}; pg8::EpiXloc E_{XLOC};
                    pg8::gemm_phase((LAS unsigned char*)shm, gg_, S_, E_);
                    __syncthreads();
                }
                const int nhb = G - 160, hb = bid - 160; const float* bias = PT(19) + l * 1024; const int c = tid;
                const int nitems = lastl ? 0 : 4 * (CTXL / 8);
                for (int it = hb; it < nitems; it += nhb) {
                    int L, tokbase, b, t0; const float* K2;
                    { const int q = it; L = CTXL; tokbase = NLAT; b = q / (CTXL / 8); t0 = (q % (CTXL / 8)) * 8; K2 = K2C; }
                    const float* zb = U + (size_t)(tokbase + b * L) * 1536 + c;
                    float acc[8];
#pragma unroll
                    for (int i = 0; i < 8; ++i) acc[i] = 0.f;
                    const int base = t0 + L - 1;
                    for (int s = 0; s < L; s += 8) {
                        float k[15];
#pragma unroll
                        for (int mm = 0; mm < 15; ++mm) k[mm] = K2[((size_t)(base - s - 7 + mm) * 2 + 0) * 512 + c];
#pragma unroll
                        for (int ds = 0; ds < 8; ++ds) { const float z = zb[(size_t)(s + ds) * 1536];
#pragma unroll
                            for (int i = 0; i < 8; ++i) acc[i] += k[i - ds + 7] * z; }
                    }
#pragma unroll
                    for (int i = 0; i < 8; ++i) { const size_t tok = (size_t)(tokbase + b * L + t0 + i); const float zt = U[tok * 1536 + c]; Z[tok * BW + c] = (acc[i] + bias[c] * zt) * U[tok * 1536 + 512 + c]; }
                }
            }
            {   __syncthreads(); fft_twiddles((float2*)(shm + FFT_X_BYTES), tid);
                int* qslot = (int*)(shm + FFT_X_BYTES + 65536);
                for (;;) { __syncthreads(); if (tid == 0) *qslot = atomicAdd(QCTR + l * 64, 1); __syncthreads(); const int it = *qslot; if (it >= 1024) break;
                    hyena_fft_item(it, UT, HSPEC, PT(19) + l * 1024, YT, shm, tid); }
            }
            SEAM(PB + 3);
        }

        if (IN(PB + 4)) for (int rep_ = 0; rep_ < PROBE_REPS(4); ++rep_) {
            PH_BEGIN
            if (rep_ > 0) { if (bid == 0 && tid == 0) __hip_atomic_store(QCTR + l * 64 + 32, 0, __ATOMIC_RELAXED, __HIP_MEMORY_SCOPE_AGENT); xcd_barrier(bar); }
            if (bid >= G - 32) for (int idx = (bid - (G - 32)) * NTHR + tid; idx < 16384; idx += 32 * NTHR) { const int n = idx & 63, dir = (idx >> 6) & 1, b = (idx >> 7) & 3, g = idx >> 9;
                const float2 a32 = APW[((dir * 32 + g) * 64 + n) * 33 + 32]; float2 X = XCTX[((b * 32 + g) * 2 + dir) * 64 + n];
                const float* __restrict__ xl = XLOC + ((size_t)g * 512 + b * 128) * 256 + dir * 128 + 2 * n; bf16_t* __restrict__ dst = S5A + ((size_t)g * 512 + b * 128) * 768 + 512 + dir * 128 + 2 * n;
#pragma unroll 1
                for (int j0 = 0; j0 < 128; j0 += 16) { float2 xv[16];
#pragma unroll
                    for (int q = 0; q < 16; ++q) { const int j = dir ? 127 - (j0 + q) : j0 + q; xv[q] = *(const float2*)(xl + (size_t)j * 256); }
#pragma unroll
                    for (int q = 0; q < 16; ++q) { const int j = dir ? 127 - (j0 + q) : j0 + q;
                        *(unsigned*)(dst + (size_t)j * 768) = pk2(X.x, X.y);
                        const float nx = a32.x * X.x - a32.y * X.y + xv[q].x, ny = a32.x * X.y + a32.y * X.x + xv[q].y; X.x = nx; X.y = ny; } } }
            {   int* qslot = (int*)(shm + 102400);
                __syncthreads(); if (tid == 0) *qslot = atomicAdd(QCTR + l * 64 + 32, 1); __syncthreads();
                for (;;) { const int it = *qslot; if (it >= 32 * 68 + 64 * 68) break;
                    int nxt_ = 0; if (tid == 0) nxt_ = atomicAdd(QCTR + l * 64 + 32, 1);
                    if (it < 32 * 68) { const int chain = it / 68, c = it % 68; mlstm_out_item(chain, c, P, QKB, VTG, PT(22) + l * 16, CST, NST, MST, (chain & 1) ? HBk : HF, shm, tid); }
                    else { const int i2 = it - 32 * 68; const int chain = i2 / 68, c = i2 % 68; const int dir_ = chain & 1, h_ = (chain >> 1) & 7;
                        ssd_out_item(chain, c, P, XBC, XTG, -expf(PT(37)[l * 16 + dir_ * 8 + h_]), PT(36)[l * 16 + dir_ * 8 + h_], SSTB, dir_ ? YB : YF, shm, tid); }
                    __syncthreads(); if (tid == 0) *qslot = nxt_; __syncthreads(); }
            }
            __syncthreads();
            {   const float* bias = PT(19) + l * 1024 + 512; const int c = tid;
                const int nitems = lastl ? 0 : 4 * (CTXL / 8);
                for (int it = bid; it < nitems; it += G) {
                    int L, tokbase, b, t0; const float* K2;
                    { const int q = it; L = CTXL; tokbase = NLAT; b = q / (CTXL / 8); t0 = (q % (CTXL / 8)) * 8; K2 = K2C; }
                    const float* zb = Z + (size_t)(tokbase + b * L) * BW + c;
                    float acc[8];
#pragma unroll
                    for (int i = 0; i < 8; ++i) acc[i] = 0.f;
                    const int base = t0 + L - 1;
                    for (int s = 0; s < L; s += 8) {
                        float k[15];
#pragma unroll
                        for (int mm = 0; mm < 15; ++mm) k[mm] = K2[((size_t)(base - s - 7 + mm) * 2 + 1) * 512 + c];
#pragma unroll
                        for (int ds = 0; ds < 8; ++ds) { const float z = zb[(size_t)(s + ds) * BW];
#pragma unroll
                            for (int i = 0; i < 8; ++i) acc[i] += k[i - ds + 7] * z; }
                    }
#pragma unroll
                    for (int i = 0; i < 8; ++i) { const size_t tok = (size_t)(tokbase + b * L + t0 + i); const float zt = Z[tok * BW + c]; Y4[tok * DM + c] = f2bf((acc[i] + bias[c] * zt) * U[tok * 1536 + 1024 + c]); }
                }
            }
            SEAM(PB + 4);
        }

        if (IN(PB + 5)) for (int rep_ = 0; rep_ < PROBE_REPS(5); ++rep_) {
            PH_BEGIN
            const float* ml_norm = PT(23) + l * BW; const float* ssd_d = PT(38) + l * 8; const float* ssd_norm = PT(39) + l * BW; const float* s5_d = PT(31) + l * BW;
            if (bid < 128) {
                pg8::Gemm gg_{S5A, S5B, 768, 768, 768}; pg8::SchedS5b S_{bid}; pg8::EpiS5Out E_{P, s5_d, GG};
                pg8::gemm_phase((LAS unsigned char*)shm, gg_, S_, E_);
                __syncthreads();
            }
            for (int tok = bid * 8 + wave; tok < NTOK; tok += G * 8) {
                const int c0 = lane * 8; const bf16_t* pr = P + (size_t)tok * LDP; const size_t o5 = (size_t)tok * BW + c0;
                float hm[8], ys[8];
                const u32x4 ooq = *(const u32x4*)(pr + ML_OFF + 1536 + c0);
                const float4 g0 = *(const float4*)(ml_norm + c0), g1 = *(const float4*)(ml_norm + c0 + 4), n0 = *(const float4*)(ssd_norm + c0), n1 = *(const float4*)(ssd_norm + c0 + 4);
                { float fa[8], fb[8]; unpack8(*(const u32x4*)(HF + o5), fa); unpack8(*(const u32x4*)(HBk + o5), fb);
#pragma unroll
                  for (int j = 0; j < 8; ++j) hm[j] = fa[j] + fb[j]; }
                { float ya[8], yb[8]; unpack8(*(const u32x4*)(YF + o5), ya); unpack8(*(const u32x4*)(YB + o5), yb);
                  float xx[8], zz[8]; unpack8(*(const u32x4*)(XBC + (size_t)tok * 1024 + c0), xx); unpack8(*(const u32x4*)(pr + SSD_OFF + c0), zz); const float dsk = ssd_d[c0 >> 6];
#pragma unroll
                  for (int j = 0; j < 8; ++j) ys[j] = ya[j] + yb[j];
#pragma unroll
                  for (int j = 0; j < 8; ++j) ys[j] = (ys[j] + dsk * xx[j]) * siluf_(zz[j]); }
                float s1 = 0.f, s2 = 0.f;
#pragma unroll
                for (int j = 0; j < 8; ++j) { s1 += hm[j] * hm[j]; s2 += ys[j] * ys[j]; }
                s1 += __shfl_xor(s1, 1); s1 += __shfl_xor(s1, 2); s1 += __shfl_xor(s1, 4); s1 += __shfl_xor(s1, 8);
                s2 = wave_sum(s2);
                const float r1 = rsqrtf(s1 * (1.0f / 128.0f) + 1e-6f), r2 = rsqrtf(s2 * (1.0f / BW) + 1e-6f);
                float oo[8]; unpack8(ooq, oo);
                const float gm[8] = {g0.x, g0.y, g0.z, g0.w, g1.x, g1.y, g1.z, g1.w}, gs[8] = {n0.x, n0.y, n0.z, n0.w, n1.x, n1.y, n1.z, n1.w};
                u32x4 w;
                w.x = pk2(hm[0] * r1 * gm[0] * sigmoidf_(oo[0]), hm[1] * r1 * gm[1] * sigmoidf_(oo[1])); w.y = pk2(hm[2] * r1 * gm[2] * sigmoidf_(oo[2]), hm[3] * r1 * gm[3] * sigmoidf_(oo[3]));
                w.z = pk2(hm[4] * r1 * gm[4] * sigmoidf_(oo[4]), hm[5] * r1 * gm[5] * sigmoidf_(oo[5])); w.w = pk2(hm[6] * r1 * gm[6] * sigmoidf_(oo[6]), hm[7] * r1 * gm[7] * sigmoidf_(oo[7]));
                *(u32x4*)(Y4 + (size_t)tok * DM + 512 + c0) = w;
                w.x = pk2(ys[0] * r2 * gs[0], ys[1] * r2 * gs[1]); w.y = pk2(ys[2] * r2 * gs[2], ys[3] * r2 * gs[3]); w.z = pk2(ys[4] * r2 * gs[4], ys[5] * r2 * gs[5]); w.w = pk2(ys[6] * r2 * gs[6], ys[7] * r2 * gs[7]);
                *(u32x4*)(Y4 + (size_t)tok * DM + 1536 + c0) = w;
                if (tok >= NLAT) { const size_t oc = (size_t)(tok - NLAT) * BW + c0; float uu[8]; unpack8(*(const u32x4*)(pr + S5_OFF + c0), uu);
                    const float4 a0 = *(const float4*)(SF + oc), a1 = *(const float4*)(SF + oc + 4), b0 = *(const float4*)(SB + oc), b1 = *(const float4*)(SB + oc + 4), d0 = *(const float4*)(s5_d + c0), d1 = *(const float4*)(s5_d + c0 + 4);
                    float y[8] = {a0.x + b0.x + d0.x * uu[0], a0.y + b0.y + d0.y * uu[1], a0.z + b0.z + d0.z * uu[2], a0.w + b0.w + d0.w * uu[3], a1.x + b1.x + d1.x * uu[4], a1.y + b1.y + d1.y * uu[5], a1.z + b1.z + d1.z * uu[6], a1.w + b1.w + d1.w * uu[7]};
#pragma unroll
                    for (int j = 0; j < 8; ++j) y[j] = 0.5f * y[j] * (1.0f + tanhf(0.7978845608028654f * (y[j] + 0.044715f * y[j] * y[j] * y[j])));
                    w.x = pk2(y[0], y[1]); w.y = pk2(y[2], y[3]); w.z = pk2(y[4], y[5]); w.w = pk2(y[6], y[7]);
                    *(u32x4*)(GG + (size_t)tok * BW + c0) = w; }
            }
            __syncthreads();
            {   float* T = sf;
                for (int unit = (G > 128 ? bid - 128 : bid); unit >= 0 && unit < 4 * 64 * 8; unit += (G > 128 ? G - 128 : G)) { const int b = unit / 512, t0 = ((unit >> 3) & 63) * 64, c0 = (unit & 7) * 64;
                    __syncthreads();
#pragma unroll
                    for (int i = 0; i < 8; ++i) { const int t = tid & 63, c = (tid >> 6) + 8 * i; T[c * 65 + t] = YT[((size_t)b * 512 + c0 + c) * SEQ + t0 + t]; }
                    __syncthreads();
                    const int t = tid >> 3, cq = (tid & 7) * 8;
                    u32x4 w; w.x = pk2(T[(cq + 0) * 65 + t], T[(cq + 1) * 65 + t]); w.y = pk2(T[(cq + 2) * 65 + t], T[(cq + 3) * 65 + t]); w.z = pk2(T[(cq + 4) * 65 + t], T[(cq + 5) * 65 + t]); w.w = pk2(T[(cq + 6) * 65 + t], T[(cq + 7) * 65 + t]);
                    *(u32x4*)(Y4 + ((size_t)b * SEQ + t0 + t) * DM + c0 + cq) = w;
                } }
            SEAM(PB + 5);
        }

        if (IN(PB + 6)) for (int rep_ = 0; rep_ < PROBE_REPS(6); ++rep_) {
            PH_BEGIN
            pg8::Gemm g{GG, GLU, BW, BW, BW}; pg8::SchedStd S{68, 2, G, bid, BW, BW}; pg8::EpiGlu E{GG, PT(33) + l * BW, Y4};
            pg8::gemm_phase((LAS unsigned char*)shm, g, S, E);
            SEAM(PB + 6);
        }
        if (IN(PB + 7)) for (int rep_ = 0; rep_ < PROBE_REPS(7); ++rep_) {
            PH_BEGIN
            pg8::Gemm g{Y4, WBR, DM, BW, BW}; pg8::SchedBranch S{64, 8, G, bid}; pg8::EpiBranch E{P, ACCb};
            pg8::gemm_phase((LAS unsigned char*)shm, g, S, E);
            if (!lastl) { __syncthreads(); pg8::SchedTail S2{G, bid}; pg8::EpiPart E2{P, (float*)HSPEC}; pg8::gemm_phase((LAS unsigned char*)shm, g, S2, E2); }
            SEAM(PB + 7);
        }
        if (IN(PB + 8)) for (int rep_ = 0; rep_ < PROBE_REPS(8); ++rep_) {
            PH_BEGIN
            if (!lastl) {
                const float* PART = (const float*)HSPEC;
                for (int idx = bid * NTHR + tid; idx < (NTOK - NLAT) * DM / 8; idx += G * NTHR) { const size_t o = (size_t)idx * 8; f32x4 p[4][2];
#pragma unroll
                    for (int k = 0; k < 4; ++k) { p[k][0] = *(const f32x4*)(PART + (size_t)k * (NTOK - NLAT) * DM + o); p[k][1] = *(const f32x4*)(PART + (size_t)k * (NTOK - NLAT) * DM + o + 4); }
                    const f32x4 s0 = ((p[0][0] + p[1][0]) + p[2][0]) + p[3][0], s1 = ((p[0][1] + p[1][1]) + p[2][1]) + p[3][1];
                    u32x4 w; w.x = pk2(s0[0], s0[1]); w.y = pk2(s0[2], s0[3]); w.z = pk2(s1[0], s1[1]); w.w = pk2(s1[2], s1[3]);
                    *(u32x4*)(ACCb + (size_t)NLAT * DM + o) = w; }
                xcd_barrier(bar);
            }
            pg8::Gemm g{ACCb, WOUT, DM, DM, DM}; pg8::SchedStd S{64, 8, G, bid, DM, DM}; pg8::EpiResid E{XS, l == 0 ? x_in : (const float*)XS, l == 0 ? ctx_in - (size_t)NLAT * DM : (const float*)XS, MODl, 2};
            pg8::gemm_phase((LAS unsigned char*)shm, g, S, E);
            if (!lastl) { __syncthreads(); pg8::Gemm g2{ACCb, WOUT, DM, DM, 512}; pg8::SchedTailK S2{G, bid}; pg8::EpiPartK E2{(float*)HSPEC + (size_t)4 * (NTOK - NLAT) * DM}; pg8::gemm_phase((LAS unsigned char*)shm, g2, S2, E2); }
            SEAM(PB + 8);
        }
        if (IN(PB + 9)) for (int rep_ = 0; rep_ < PROBE_REPS(9); ++rep_) {
            PH_BEGIN
            if (!lastl) {
                const float* PART = (const float*)HSPEC + (size_t)4 * (NTOK - NLAT) * DM; const float* mg = MODl + (size_t)(4 * 6 + 2) * DM;
                const float* src = l == 0 ? ctx_in : (const float*)XS + (size_t)NLAT * DM;
                for (int idx = bid * NTHR + tid; idx < (NTOK - NLAT) * DM / 4; idx += G * NTHR) { const size_t o = (size_t)idx * 4; const int col = (int)(o & (DM - 1));
                    const f32x4 p0 = *(const f32x4*)(PART + o), p1 = *(const f32x4*)(PART + (size_t)(NTOK - NLAT) * DM + o), p2 = *(const f32x4*)(PART + (size_t)2 * (NTOK - NLAT) * DM + o), p3 = *(const f32x4*)(PART + (size_t)3 * (NTOK - NLAT) * DM + o);
                    const f32x4 sv = *(const f32x4*)(src + o), gm = *(const f32x4*)(mg + col);
                    *(f32x4*)(XS + (size_t)NLAT * DM + o) = sv + gm * (((p0 + p1) + p2) + p3); }
                xcd_barrier(bar);
            }
            for (int i = bid * NTHR + tid; i < NEXP * MOE_PAD; i += G * NTHR) ROWTOK[i] = -1;
            for (int i = bid * NTHR + tid; i < NTOK * 16; i += G * NTHR) INV[i] = -1;
            const float* wr = PT(42) + (size_t)l * DM * 16; const float* gn = norm_ffn + l * DM;
            for (int tok0 = (bid * 8 + wave) * 4; tok0 < M2; tok0 += G * 32) {
                const int r = tok0 < NLAT ? tok0 / SEQ : 4; const float* xr = XS + (size_t)tok0 * DM;
                const float* sh = MODl + (size_t)(r * 6 + 3) * DM; const float* sc = MODl + (size_t)(r * 6 + 4) * DM;
                float rs[4];
#pragma unroll
                for (int tk = 0; tk < 4; ++tk) { float ss = 0.f;
#pragma unroll 4
                    for (int i = 0; i < 8; ++i) { const float4 t4 = *(const float4*)(xr + (size_t)tk * DM + i * 256 + lane * 4); ss += t4.x * t4.x + t4.y * t4.y + t4.z * t4.z + t4.w * t4.w; }
                    ss = wave_sum(ss); rs[tk] = rsqrtf(ss * (1.0f / DM) + 1e-6f); }
                float lg[4][16];
#pragma unroll
                for (int tk = 0; tk < 4; ++tk)
#pragma unroll
                    for (int e = 0; e < 16; ++e) lg[tk][e] = 0.f;
#pragma unroll 1
                for (int i = 0; i < 8; ++i) { const int d = i * 256 + lane * 4;
                    const float4 g4 = *(const float4*)(gn + d), s4 = *(const float4*)(sc + d), h4 = *(const float4*)(sh + d);
                    float4 xq[4], ww[16];
#pragma unroll
                    for (int tk = 0; tk < 4; ++tk) xq[tk] = *(const float4*)(xr + (size_t)tk * DM + d);
                    const float4* wq = (const float4*)(wr + (size_t)d * 16);
#pragma unroll
                    for (int q = 0; q < 16; ++q) ww[q] = wq[q];
                    float hv[4][4];
#pragma unroll
                    for (int tk = 0; tk < 4; ++tk) { const float4 xv = xq[tk]; const float rr = rs[tk];
                        hv[tk][0] = xv.x * rr * g4.x * (1.f + s4.x) + h4.x; hv[tk][1] = xv.y * rr * g4.y * (1.f + s4.y) + h4.y; hv[tk][2] = xv.z * rr * g4.z * (1.f + s4.z) + h4.z; hv[tk][3] = xv.w * rr * g4.w * (1.f + s4.w) + h4.w;
                        u32x2 w; w.x = pk2(hv[tk][0], hv[tk][1]); w.y = pk2(hv[tk][2], hv[tk][3]); *(u32x2*)(HB + (size_t)(tok0 + tk) * DM + d) = w; }
#pragma unroll
                    for (int q = 0; q < 4; ++q) { const float4 w0 = ww[q * 4 + 0], w1 = ww[q * 4 + 1], w2 = ww[q * 4 + 2], w3 = ww[q * 4 + 3];
#pragma unroll
                        for (int tk = 0; tk < 4; ++tk) { const float hq = hv[tk][q];
                            lg[tk][0] += hq * w0.x; lg[tk][1] += hq * w0.y; lg[tk][2] += hq * w0.z; lg[tk][3] += hq * w0.w; lg[tk][4] += hq * w1.x; lg[tk][5] += hq * w1.y; lg[tk][6] += hq * w1.z; lg[tk][7] += hq * w1.w;
                            lg[tk][8] += hq * w2.x; lg[tk][9] += hq * w2.y; lg[tk][10] += hq * w2.z; lg[tk][11] += hq * w2.w; lg[tk][12] += hq * w3.x; lg[tk][13] += hq * w3.y; lg[tk][14] += hq * w3.z; lg[tk][15] += hq * w3.w; } } }
#pragma unroll
                for (int tk = 0; tk < 4; ++tk) { float mx = -1e30f;
#pragma unroll
                    for (int e = 0; e < 16; ++e) { lg[tk][e] = wave_sum(lg[tk][e]); mx = fmaxf(mx, lg[tk][e]); }
                    float sm = 0.f;
#pragma unroll
                    for (int e = 0; e < 16; ++e) { lg[tk][e] = expf(lg[tk][e] - mx); sm += lg[tk][e]; }
                    const float inv = 1.0f / sm;
                    if (lane == 0) {
#pragma unroll
                        for (int e = 0; e < 16; e += 4) *(float4*)(PROBS + (size_t)(tok0 + tk) * 16 + e) = make_float4(lg[tk][e] * inv, lg[tk][e + 1] * inv, lg[tk][e + 2] * inv, lg[tk][e + 3] * inv); } }
            }
            SEAM(PB + 9);
        }
        if (IN(PB + 10)) for (int rep_ = 0; rep_ < PROBE_REPS(10); ++rep_) {
            PH_BEGIN
            const int nitems = 64 + (lastl ? 0 : 64);
            unsigned long long* keys = (unsigned long long*)shm;
            for (int it = bid; it < nitems; it += G) {
                const int set = it >> 6, e = it & 15, b = (it >> 4) & 3;
                const int n = set ? CTXL : SEQ, cap = set ? 32 : 512, tokbase = set ? NLAT + b * CTXL : b * SEQ;
                __syncthreads();
                for (int i = tid; i < n; i += NTHR) keys[i] = ((unsigned long long)__float_as_uint(PROBS[(size_t)(tokbase + i) * 16 + e]) << 32) | (unsigned long long)(0xFFFFFFFFu - (unsigned)i);
                __syncthreads();
                for (int k = 2; k <= n; k <<= 1)
                    for (int j = k >> 1; j > 0; j >>= 1) {
                        for (int p = tid; p < (n >> 1); p += NTHR) { const int i = ((p & ~(j - 1)) << 1) | (p & (j - 1)); const int m = i | j;
                            const unsigned long long ka = keys[i], kb = keys[m]; const bool desc = ((i & k) == 0);
                            if ((ka < kb) == desc) { keys[i] = kb; keys[m] = ka; } }
                        __syncthreads();
                    }
                for (int r = tid; r < cap; r += NTHR) { const unsigned long long kk = keys[r]; const int row = e * MOE_PAD + (set ? 2048 + b * 32 + r : b * 512 + r);
                    const int tk_ = tokbase + (int)(0xFFFFFFFFu - (unsigned)(kk & 0xFFFFFFFFull)); ROWTOK[row] = tk_; ROWGATE[row] = __uint_as_float((unsigned)(kk >> 32)); INV[tk_ * 16 + e] = row; }
                for (int rb = 0; rb < cap; rb += 32) {
                    u32x4 t4[4][4];
#pragma unroll
                    for (int q = 0; q < 4; ++q) { const int r = rb + wave + 8 * q; const int tok = tokbase + (int)(0xFFFFFFFFu - (unsigned)(keys[r] & 0xFFFFFFFFull));
                        const u32x4* sp = (const u32x4*)(HB + (size_t)tok * DM);
#pragma unroll
                        for (int i = 0; i < 4; ++i) t4[q][i] = sp[i * 64 + lane]; }
#pragma unroll
                    for (int q = 0; q < 4; ++q) { const int r = rb + wave + 8 * q; const int row = e * MOE_PAD + (set ? 2048 + b * 32 + r : b * 512 + r);
                        u32x4* dp = (u32x4*)(XG + (size_t)row * DM);
#pragma unroll
                        for (int i = 0; i < 4; ++i) dp[i * 64 + lane] = t4[q][i]; } }
            }
            if (!lastl && G > 128 && bid >= 128) {
                const int n_win = 32 * 55, n_br = 4 * 64, n_out = 32 * 8, n_glu = 16, n_gu = 16 * 2 * 192; (void)n_gu;
                CV_RUN(l + 1, bid - 128, G - 128, n_win); (void)n_br; (void)n_out; (void)n_glu;
            }
            {   const int pad0 = lastl ? 2048 : MOE_ROWS, npad = MOE_PAD - pad0;
                for (int R = bid * 8 + wave; R < NEXP * npad; R += G * 8) { const int e = R / npad, rr = pad0 + R % npad; u32x4* dp = (u32x4*)(XG + ((size_t)e * MOE_PAD + rr) * DM);
#pragma unroll
                    for (int i = 0; i < 4; ++i) dp[i * 64 + lane] = (u32x4){0u, 0u, 0u, 0u}; } }
            SEAM(PB + 10);
        }
        if (IN(PB + 12)) for (int rep_ = 0; rep_ < PROBE_REPS(12); ++rep_) {
            PH_BEGIN
            pg8::Gemm g{XG, WGU, DM, DM, DM}; pg8::SchedMoe S{lastl ? 8 : 9, 12, G, bid, DM, DM, 2 * DEXP}; pg8::EpiMoe1 E{HID};
            pg8::gemm_phase((LAS unsigned char*)shm, g, S, E);
            SEAM(PB + 12);
        }
        if (IN(PB + 13)) for (int rep_ = 0; rep_ < PROBE_REPS(13); ++rep_) {
            PH_BEGIN
            pg8::Gemm g{HID, WD, DEXP, DEXP, DEXP}; pg8::SchedMoe S{lastl ? 8 : 9, 8, G, bid, DEXP, DEXP, DM}; pg8::EpiMoeY E{YEXP};
            pg8::gemm_phase((LAS unsigned char*)shm, g, S, E);
            SEAM(PB + 13);
        }

}

__global__ __launch_bounds__(NTHR, 2) void fwd(Args a) {
    extern __shared__ __attribute__((aligned(16))) unsigned char shm[];
    const int bid = blockIdx.x, G = gridDim.x;
    float* const sf = (float*)shm;
    volatile LAS unsigned* xbw = (volatile LAS unsigned*)((LAS unsigned char*)shm + (LDS_BYTES - 16));
    if (threadIdx.x == 0) { xbw[0] = 0u; xbw[1] = 0u; xbw[2] = 0u; xbw[3] = 0u; }
    const float** const ptab = (const float**)(shm + (LDS_BYTES - 16 - 512));
    if (threadIdx.x == 0) {
#pragma unroll
        for (int i = 0; i < 47; ++i) ptab[i] = a.in[i]; }
    __syncthreads();
    XcdBarrier bar = xcd_barrier_post((unsigned*)(a.ws + O_BAR), xbw);
    const int lo = a.ph_lo, hi = a.ph_hi;
    if (IN(0)) {
        PH_BEGIN
        {
            __syncthreads();
            for (int i = tid; i < 5 * DM; i += NTHR) { const int r = i >> 11, k = i & (DM - 1); const float v = r < 4 ? c_in[r * DM + k] : cctx_in[k]; sf[i] = siluf_(v); }
            __syncthreads();
            float* red = sf + 5 * DM;
            for (int unit = bid; unit < 2 * 96; unit += G) { const int l = unit / 96, j = (unit % 96) * 128 + (tid & 127), kq = tid >> 7;
                const float* w = ada_w + (size_t)l * DM * (6 * DM) + (size_t)(kq * 512) * (6 * DM) + j; const float* sv = sf + kq * 512;
                float a0 = 0.f, a1 = 0.f, a2 = 0.f, a3 = 0.f, a4 = 0.f;
#pragma unroll 8
                for (int k = 0; k < 512; ++k) { const float wv = w[(size_t)k * (6 * DM)]; a0 += sv[k] * wv; a1 += sv[DM + k] * wv; a2 += sv[2 * DM + k] * wv; a3 += sv[3 * DM + k] * wv; a4 += sv[4 * DM + k] * wv; }
                __syncthreads();
                { float* rp = red + (kq * 5) * 128 + (tid & 127); rp[0] = a0; rp[128] = a1; rp[256] = a2; rp[384] = a3; rp[512] = a4; }
                __syncthreads();
                if (tid < 128) { const float bb = ada_b[l * 6 * DM + j]; float* o = MOD + (size_t)l * 5 * 6 * DM + j;
#pragma unroll
                    for (int r = 0; r < 5; ++r) o[(size_t)r * 6 * DM] = ((red[(0 * 5 + r) * 128 + tid] + red[(1 * 5 + r) * 128 + tid]) + (red[(2 * 5 + r) * 128 + tid] + red[(3 * 5 + r) * 128 + tid])) + bb; }
            }
        }
    }

    layer_body<0>(a, bar, lo, hi, bid, G, shm, sf, ptab);
    layer_body<1>(a, bar, lo, hi, bid, G, shm, sf, ptab);
    if (IN(33)) {
        PH_BEGIN
        const float* gn = PT(46);
        for (int tok = bid * 8 + wave; tok < NLAT; tok += G * 8) {
            const float* xr = XS + (size_t)tok * DM; float4 v[8]; float ss = 0.f;
#pragma unroll
            for (int i = 0; i < 8; ++i) v[i] = *(const float4*)(xr + i * 256 + lane * 4);
            moe_combine(v, tok, lane, INV, ROWGATE, YEXP, MOD + (size_t)(1 * 5 + tok / SEQ) * 6 * DM + 5 * DM);
#pragma unroll
            for (int i = 0; i < 8; ++i) {                 ss += v[i].x * v[i].x + v[i].y * v[i].y + v[i].z * v[i].z + v[i].w * v[i].w; }
            ss = wave_sum(ss); const float rs = rsqrtf(ss * (1.0f / DM) + 1e-6f);
#pragma unroll
            for (int i = 0; i < 8; ++i) { const int d = i * 256 + lane * 4; const float4 g4 = *(const float4*)(gn + d);
                *(float4*)(a.out + (size_t)tok * DM + d) = make_float4(v[i].x * rs * g4.x, v[i].y * rs * g4.y, v[i].z * rs * g4.z, v[i].w * rs * g4.w); }
        }
    }
#undef IN
#undef SEAM
}


extern "C" void kernel_launch(void* const* d_in, const int* in_sizes, int n_in, void* d_out, int out_size, void* d_ws, size_t ws_size, hipStream_t stream) {
    static int grid = 0;
    if (grid == 0) {
        if (n_in != 47 || ws_size < WS_END) { fprintf(stderr, "kernel_launch: expected 47 inputs and >= %zu bytes of workspace; got %d, %zu\n", (size_t)WS_END, n_in, ws_size); grid = -1; return; }
        int dev = 0, cus = 0;
        if (hipGetDevice(&dev) != hipSuccess || hipDeviceGetAttribute(&cus, hipDeviceAttributeMultiprocessorCount, dev) != hipSuccess) { grid = -1; return; }
        if (hipFuncSetAttribute((const void*)fwd, hipFuncAttributeMaxDynamicSharedMemorySize, LDS_BYTES) != hipSuccess) { fprintf(stderr, "kernel_launch: hipFuncSetAttribute failed\n"); grid = -1; return; }
        int per_cu = 0;
        if (hipOccupancyMaxActiveBlocksPerMultiprocessor(&per_cu, (const void*)fwd, NTHR, LDS_BYTES) != hipSuccess || per_cu < 1) fprintf(stderr, "kernel_launch: occupancy query reports %d\n", per_cu);
        (void)hipGetLastError();
        grid = cus > 256 ? 256 : cus;
        if (grid < 224) { fprintf(stderr, "kernel_launch: needs >= 224 CUs (got %d)\n", grid); grid = -1; return; }
    }
    if (grid < 0) return;
    (void)hipMemsetAsync((char*)d_ws, 0, O_ZERO_END, stream);
    Args a{};
    for (int i = 0; i < 47; ++i) a.in[i] = (const float*)d_in[i];
    a.out = (float*)d_out; a.ws = (unsigned char*)d_ws;
#if MK_ONE_LAUNCH
    a.ph_lo = 0; a.ph_hi = 64;
    hipLaunchKernelGGL(fwd, dim3(grid), dim3(NTHR), LDS_BYTES, stream, a);
#else
    const int ids[] = {0, 1,2,3,4,5,6,7,8,9,10,11,12,13,14, 17,18,19,20,21,22,23,24,25,26,27,28,29,30, 33};
    for (int k = 0; k < (int)(sizeof(ids) / sizeof(ids[0])); ++k) { a.ph_lo = ids[k]; a.ph_hi = ids[k] + 1; hipLaunchKernelGGL(fwd, dim3(grid), dim3(NTHR), LDS_BYTES, stream, a); }
#endif
}
```

```cpp
#include <hip/hip_runtime.h>
#include <stdint.h>
#include <stdio.h>

#ifndef PROBE_MASK
#define PROBE_MASK 0
#endif
#ifndef PROBE_SP
#define PROBE_SP 1
#endif
#define PROBE_REPS(k) ((((PROBE_MASK) >> (k)) & 1) + 1)
#ifndef MK_ONE_LAUNCH
#define MK_ONE_LAUNCH 1
#endif

#define DM 2048
#define NB 4
#define SEQ 4096
#define CTXL 256
#define BW 512
#define NLAT 16384
#define NCTX 1024
#define NTOK 17408
#define IN_W 13856
#define LDP 14080
#define HY_OFF 0
#define ML_OFF 1536
#define S5_OFF 3600
#define SSD_OFF 4112
#define GATE_OFF 5664
#define NEXP 16
#define DEXP 1536
#define MOE_ROWS 2176
#define MOE_PAD 2304
#define NTHR 512
#define LDS_BYTES 147456
#define LAS __attribute__((address_space(3)))

typedef unsigned short bf16_t;
typedef short bf16x8 __attribute__((ext_vector_type(8)));
typedef float f32x4 __attribute__((ext_vector_type(4)));
typedef unsigned u32x4 __attribute__((ext_vector_type(4)));
typedef unsigned u32x2 __attribute__((ext_vector_type(2)));

#define XB_TMO      128
#define XB_XCNT(j)  (256  + 64 * (j))
#define XB_XSUB(j)  (1280 + 64 * (j))
#define XB_XGEN(j)  (2304 + 64 * (j))
#define XB_TOP      3328
#define XB_TOPGEN   3392
#define XCD_BAR_WORDS 3456
#define XB_SPIN_CAP (1u << 18)
__device__ __forceinline__ unsigned xb_ld(unsigned* p)              { return __hip_atomic_load(p, __ATOMIC_RELAXED, __HIP_MEMORY_SCOPE_AGENT); }
__device__ __forceinline__ unsigned xb_add(unsigned* p, unsigned v) { return __hip_atomic_fetch_add(p, v, __ATOMIC_RELAXED, __HIP_MEMORY_SCOPE_AGENT); }
__device__ __forceinline__ unsigned xb_xcc_id() { return (unsigned)__builtin_amdgcn_s_getreg((3 << 11) | 20) & 0xFu; }
#define XB_SPIN(cond, bar) do { unsigned _sp = 0; while (cond) { __builtin_amdgcn_s_sleep(1); \
    if ((++_sp & 255u) == 0u) { if (xb_ld(&(bar)[XB_TMO])) break; if (_sp > XB_SPIN_CAP) { atomicAdd(&(bar)[XB_TMO], 1u); break; } } } } while (0)
struct XcdBarrier { unsigned* bar; unsigned x; volatile LAS unsigned* st; };
__device__ __forceinline__ XcdBarrier xcd_barrier_post(unsigned* bar, volatile LAS unsigned* st) {
    XcdBarrier b; b.bar = bar; b.x = xb_xcc_id(); b.st = st;
    if (threadIdx.x == 0) (void)xb_add(&bar[XB_XCNT(b.x)], 1u);
    return b;
}
__device__ __forceinline__ void xcd_barrier_complete(unsigned* bar, unsigned x, unsigned& nloc, unsigned& nx) {
    const unsigned G = gridDim.x * gridDim.y * gridDim.z;
    unsigned sum, cnt, mine, sp = 0u;
    for (;;) {
        sum = 0u; cnt = 0u; mine = 0u;
#pragma unroll
        for (unsigned j = 0; j < 16; ++j) { const unsigned c = xb_ld(&bar[XB_XCNT(j)]); sum += c; cnt += (c > 0u) ? 1u : 0u; mine = (j == x) ? c : mine; }
        if (sum == G) break;
        __builtin_amdgcn_s_sleep(1);
        if ((++sp & 255u) == 0u) { if (xb_ld(&bar[XB_TMO])) break; if (sp > XB_SPIN_CAP) { atomicAdd(&bar[XB_TMO], 1u); break; } }
    }
    nloc = mine > 0u ? mine : 1u; nx = cnt > 0u ? cnt : 1u;
}
__device__ __forceinline__ void xcd_barrier(const XcdBarrier& b) {
    asm volatile("s_waitcnt vmcnt(0)" ::: "memory");
    __syncthreads();
    if (threadIdx.x == 0) {
        unsigned* bar = b.bar;
        __builtin_amdgcn_s_waitcnt(0);
        unsigned nloc = b.st[0], nx = b.st[1];
        if (nloc == 0u) { xcd_barrier_complete(bar, b.x, nloc, nx); b.st[0] = nloc; b.st[1] = nx; }
        const unsigned old = xb_add(&bar[XB_XSUB(b.x)], 1u);
        const unsigned gen = old / nloc;
        if (old + 1u == (gen + 1u) * nloc) {
            __builtin_amdgcn_fence(__ATOMIC_RELEASE, "agent");
            asm volatile("s_waitcnt vmcnt(0)" ::: "memory");
            const unsigned og = xb_add(&bar[XB_TOP], 1u);
            const unsigned tg = og / nx;
            if (og + 1u == (tg + 1u) * nx) xb_add(&bar[XB_TOPGEN], 1u);
            else XB_SPIN(xb_ld(&bar[XB_TOPGEN]) == tg, bar);
            __builtin_amdgcn_fence(__ATOMIC_ACQUIRE, "agent");
            xb_add(&bar[XB_XGEN(b.x)], 1u);
            asm volatile("s_waitcnt vmcnt(0)" ::: "memory");
        } else {
            XB_SPIN(xb_ld(&bar[XB_XGEN(b.x)]) == gen, bar);
            __builtin_amdgcn_fence(__ATOMIC_ACQUIRE, "agent");
            asm volatile("s_waitcnt vmcnt(0)" ::: "memory");
        }
    }
    __syncthreads();
}

__device__ __forceinline__ unsigned short f2bf(float f) { unsigned u = __float_as_uint(f); u += 0x7FFFu + ((u >> 16) & 1u); return (unsigned short)(u >> 16); }
__device__ __forceinline__ float bf2f(unsigned short b) { return __uint_as_float(((unsigned)b) << 16); }
__device__ __forceinline__ unsigned pk2(float lo, float hi) { unsigned r; asm("v_cvt_pk_bf16_f32 %0, %1, %2" : "=v"(r) : "v"(lo), "v"(hi)); return r; }
__device__ __forceinline__ float sigmoidf_(float x) { return 1.0f / (1.0f + expf(-x)); }
__device__ __forceinline__ float siluf_(float x) { return x / (1.0f + expf(-x)); }
__device__ __forceinline__ float wave_sum(float v) {
#pragma unroll
    for (int o = 32; o >= 1; o >>= 1) v += __shfl_xor(v, o);
    return v;
}
__device__ __forceinline__ const float* uptr(const float* p) { const unsigned long long v = (unsigned long long)p;
    const unsigned lo = __builtin_amdgcn_readfirstlane((unsigned)v), hi = __builtin_amdgcn_readfirstlane((unsigned)(v >> 32)); return (const float*)(((unsigned long long)hi << 32) | lo); }
#define PT(k) uptr(ptab[k])
__device__ __forceinline__ int step_tok(int b, int dir, int i) {
    if (i < CTXL) { const int tt = dir ? (CTXL - 1 - i) : i; return NLAT + b * CTXL + tt; }
    const int j = i - CTXL; const int tt = dir ? (SEQ - 1 - j) : j; return b * SEQ + tt;
}
__device__ __forceinline__ void unpack8(const u32x4 w, float (&f)[8]) {
    f[0] = __uint_as_float(w.x << 16); f[1] = __uint_as_float(w.x & 0xFFFF0000u); f[2] = __uint_as_float(w.y << 16); f[3] = __uint_as_float(w.y & 0xFFFF0000u);
    f[4] = __uint_as_float(w.z << 16); f[5] = __uint_as_float(w.z & 0xFFFF0000u); f[6] = __uint_as_float(w.w << 16); f[7] = __uint_as_float(w.w & 0xFFFF0000u);
}

namespace pg8 {
constexpr int BM = 256, BK = 64, HALF = 128, HTB = HALF * BK * 2, STAGE_BYTES = 8 * HTB, NXCD = 8, WGM = 8;
__host__ __device__ __forceinline__ int lds_byte(int r, int c) { const int st = (r >> 4) * 2 + (c >> 5), rr = r & 15, cc = c & 31, ob = rr * 64 + cc * 2; return st * 1024 + (ob ^ (((ob >> 9) & 1) << 5)); }
__host__ __device__ __forceinline__ void stage_rc(int b, int& R, int& C) { const int st = b / 1024, sb = b % 1024, swz = sb ^ (((sb >> 9) & 1) << 5); R = (st >> 1) * 16 + swz / 64; C = (st & 1) * 32 + (swz % 64) / 2; }
__host__ __device__ __forceinline__ int perm32(int rho) { const int n = rho >> 4, i = rho & 15; return 8 * (i >> 2) + 4 * n + (i & 3); }
struct Unit { int pm, pn, z, k; long long ao, bo; };
struct Gemm { const bf16_t* A; const bf16_t* Bt; int lda, ldb, K; };

__device__ __forceinline__ void tile_of(int wgid, int nM, int nN, int& pm, int& pn) {
    const int nwg = nM * nN; { const int q = nwg / NXCD, r = nwg % NXCD, xcd = wgid % NXCD, off = wgid / NXCD; wgid = (xcd < r ? xcd * (q + 1) : r * (q + 1) + (xcd - r) * q) + off; }
    const int nig = WGM * nN, gid = wgid / nig, fm = gid * WGM, gsz = (nM - fm) < WGM ? (nM - fm) : WGM;
    pm = fm + ((wgid % nig) % gsz); pn = (wgid % nig) / gsz;
}
struct SchedStd {
    int nM, nN, G, c, lda, ldb;
    __device__ __forceinline__ bool next(int i, Unit& u) const { const long L = (long)i * G + c; if (L >= (long)nM * nN) return false; tile_of((int)L, nM, nN, u.pm, u.pn); u.z = 0; u.k = 0;
        u.ao = (long long)u.pm * BM * lda * 2; u.bo = (long long)u.pn * BM * ldb * 2; return true; }
    __device__ __forceinline__ void a_ready(const Unit&) const {}
    __device__ __forceinline__ void done(const Unit&) const {}
};
struct SchedBranch {
    int nM, nN, G, c;
    __device__ __forceinline__ bool next(int i, Unit& u) const { const long L = (long)(i >> 2) * G + c; if (L >= (long)nM * nN) return false; tile_of((int)L, nM, nN, u.pm, u.pn); u.z = 0; u.k = i & 3;
        u.ao = ((long long)u.pm * BM * DM + u.k * BW) * 2; u.bo = ((long long)u.k * DM + u.pn * BM) * BW * 2; return true; }
    __device__ __forceinline__ void a_ready(const Unit&) const {}
    __device__ __forceinline__ void done(const Unit&) const {}
};
struct SchedTail {
    int G, c;
    __device__ __forceinline__ bool next(int i, Unit& u) const { const long T = (long)i * G + c; if (T >= 128) return false; const int t = (int)(T >> 2); u.pm = 64 + (t >> 3); u.pn = t & 7; u.z = 1; u.k = (int)(T & 3);
        u.ao = ((long long)u.pm * BM * DM + u.k * BW) * 2; u.bo = ((long long)u.k * DM + u.pn * BM) * BW * 2; return true; }
    __device__ __forceinline__ void a_ready(const Unit&) const {}
    __device__ __forceinline__ void done(const Unit&) const {}
};
struct SchedTailK {
    int G, c;
    __device__ __forceinline__ bool next(int i, Unit& u) const { const long T = (long)i * G + c; if (T >= 128) return false; const int t = (int)(T >> 2); u.pm = 64 + (t >> 3); u.pn = t & 7; u.z = 1; u.k = (int)(T & 3);
        u.ao = ((long long)u.pm * BM * DM + u.k * 512) * 2; u.bo = ((long long)u.pn * BM * DM + u.k * 512) * 2; return true; }
    __device__ __forceinline__ void a_ready(const Unit&) const {}
    __device__ __forceinline__ void done(const Unit&) const {}
};
struct SchedMoe {
    int nPm, nPn, G, c, lda, ldb, nBrows;
    __device__ __forceinline__ bool next(int i, Unit& u) const { const long L = (long)i * G + c; const int per = nPm * nPn; if (L >= (long)NEXP * per) return false; const int e = (int)(L / per), rem = (int)(L % per);
        u.z = e; u.k = 0; u.pm = rem % nPm; u.pn = rem / nPm; u.ao = ((long long)e * MOE_PAD + u.pm * BM) * lda * 2; u.bo = ((long long)e * nBrows + u.pn * BM) * ldb * 2; return true; }
    __device__ __forceinline__ void a_ready(const Unit&) const {}
    __device__ __forceinline__ void done(const Unit&) const {}
};

typedef f32x4 Acc[2][2][4][2];
template <class Epi, class Sched>
__device__ __forceinline__ void gemm_phase(LAS unsigned char* lds, const Gemm g, const Sched& S, const Epi& E) {
    int tid = threadIdx.x; asm volatile("" : "+v"(tid));
    const int wid = __builtin_amdgcn_readfirstlane(tid >> 6), lane = tid & 63, wr = wid >> 2, wc = wid & 3, fr = lane & 15, fq = lane >> 4;
    const int K = g.K, nt = K / BK;
    unsigned voffA[2], voffB[2];
#pragma unroll
    for (int i = 0; i < 2; ++i) { int R, C; stage_rc(tid * 16 + i * 8192, R, C); const int Rb = Epi::PERM ? ((R & ~31) + perm32(R & 31)) : R;
        voffA[i] = (unsigned)(R * g.lda + C) * 2u; voffB[i] = (unsigned)(Rb * g.ldb + C) * 2u; }
    const size_t kstep = (size_t)(BK * 2);
    const size_t hstepA = (size_t)HALF * g.lda * 2, hstepB = (size_t)HALF * g.ldb * 2;
    const unsigned ldsw = (unsigned)wid * 1024u;
    const int aoff = lds_byte(wr * 64 + fr, fq * 8), boff = lds_byte(wc * 32 + fr, fq * 8);
#define PG8_SA(b, h) (((b) * 2 + (h)) * HTB)
#define PG8_SB(b, h) ((4 + (b) * 2 + (h)) * HTB)
#define PG8_STAGE(bufoff, gbase, voff) do { _Pragma("unroll") for (int _i = 0; _i < 2; ++_i) \
        __builtin_amdgcn_global_load_lds((const unsigned*)((const char*)(gbase) + (voff)[_i]), (LAS unsigned*)(lds + (bufoff) + ldsw + _i * 8192), 16, 0, 0); } while (0)
#define PG8_LDA(dst, b, h) do { _Pragma("unroll") for (int m = 0; m < 4; ++m) _Pragma("unroll") for (int k = 0; k < 2; ++k) dst[m][k] = *(const LAS bf16x8*)(lds + PG8_SA(b, h) + aoff + m * 2048 + k * 1024); } while (0)
#define PG8_LDB(dst, b, h) do { _Pragma("unroll") for (int n = 0; n < 2; ++n) _Pragma("unroll") for (int k = 0; k < 2; ++k) dst[n][k] = *(const LAS bf16x8*)(lds + PG8_SB(b, h) + boff + n * 2048 + k * 1024); } while (0)
#define PG8_MMA(ai, bj, At, Bt) do { __builtin_amdgcn_s_setprio(1); _Pragma("unroll") for (int m = 0; m < 4; ++m) _Pragma("unroll") for (int n = 0; n < 2; ++n) _Pragma("unroll") for (int k = 0; k < 2; ++k) \
        acc[ai][bj][m][n] = __builtin_amdgcn_mfma_f32_16x16x32_bf16(Bt[n][k], At[m][k], acc[ai][bj][m][n], 0, 0, 0); __builtin_amdgcn_s_setprio(0); } while (0)
#define PG8_WAIT_V(n) asm volatile("s_waitcnt vmcnt(" #n ")" ::: "memory")
#define PG8_WAIT_L(n) asm volatile("s_waitcnt lgkmcnt(" #n ")" ::: "memory")
#define PG8_BAR __builtin_amdgcn_s_barrier()
#define PG8_SCHED __builtin_amdgcn_sched_barrier(0)
    Unit cur, nxt; int ui = 0;
    if (!S.next(0, cur)) return;
    Acc acc;
#pragma unroll
    for (int a = 0; a < 2; ++a)
#pragma unroll
        for (int b = 0; b < 2; ++b)
#pragma unroll
            for (int m = 0; m < 4; ++m)
#pragma unroll
                for (int n = 0; n < 2; ++n) acc[a][b][m][n] = (f32x4){0.f, 0.f, 0.f, 0.f};
    bf16x8 At[4][2], B0[2][2], B1[2][2];
    const char* cA = (const char*)g.A + cur.ao; const char* cB = (const char*)g.Bt + cur.bo;
    S.a_ready(cur);
    PG8_STAGE(PG8_SB(0, 0), cB, voffB); PG8_STAGE(PG8_SA(0, 0), cA, voffA); PG8_STAGE(PG8_SB(0, 1), cB + hstepB, voffB); PG8_STAGE(PG8_SA(0, 1), cA + hstepA, voffA);
    if (wr == 1) PG8_BAR;
    PG8_WAIT_V(4); PG8_BAR;
    PG8_STAGE(PG8_SB(1, 0), cB + kstep, voffB); PG8_STAGE(PG8_SA(1, 0), cA + kstep, voffA); PG8_STAGE(PG8_SB(1, 1), cB + hstepB + kstep, voffB);
    PG8_WAIT_V(6); PG8_BAR;
    for (;;) {
        const bool has_next = S.next(ui + 1, nxt);
        const char* nA = has_next ? (const char*)g.A + nxt.ao : cA; const char* nB = has_next ? (const char*)g.Bt + nxt.bo : cB;
        for (int t = 0; t < nt; t += 2) {
            const bool last = (t == nt - 2);
            const char* a1 = cA + (size_t)(t + 1) * kstep;
            const char* a2 = last ? nA : cA + (size_t)(t + 2) * kstep; const char* b2 = last ? nB : cB + (size_t)(t + 2) * kstep;
            const char* a3 = a2 + kstep; const char* b3 = b2 + kstep;
            if (last && has_next) S.a_ready(nxt);
            PG8_LDB(B0, 0, 0); PG8_SCHED; PG8_LDA(At, 0, 0); PG8_STAGE(PG8_SA(1, 1), a1 + hstepA, voffA);
            PG8_WAIT_L(8); PG8_BAR; PG8_WAIT_L(0); PG8_MMA(0, 0, At, B0); PG8_BAR; PG8_SCHED;
            PG8_LDB(B1, 0, 1); PG8_STAGE(PG8_SB(0, 0), b2, voffB);
            PG8_BAR; PG8_WAIT_L(0); PG8_MMA(0, 1, At, B1); PG8_BAR;
            PG8_LDA(At, 0, 1); PG8_STAGE(PG8_SA(0, 0), a2, voffA);
            PG8_BAR; PG8_WAIT_L(0); PG8_MMA(1, 0, At, B0); PG8_BAR; PG8_SCHED;
            PG8_STAGE(PG8_SB(0, 1), b2 + hstepB, voffB);
            PG8_WAIT_V(6); PG8_BAR; PG8_MMA(1, 1, At, B1); PG8_BAR;
            PG8_LDB(B0, 1, 0); PG8_SCHED; PG8_LDA(At, 1, 0); PG8_STAGE(PG8_SA(0, 1), a2 + hstepA, voffA);
            PG8_WAIT_L(8); PG8_BAR; PG8_WAIT_L(0); PG8_MMA(0, 0, At, B0); PG8_BAR; PG8_SCHED;
            PG8_LDB(B1, 1, 1); PG8_STAGE(PG8_SB(1, 0), b3, voffB);
            PG8_BAR; PG8_WAIT_L(0); PG8_MMA(0, 1, At, B1); PG8_BAR;
            PG8_LDA(At, 1, 1); PG8_STAGE(PG8_SA(1, 0), a3, voffA);
            PG8_BAR; PG8_WAIT_L(0); PG8_MMA(1, 0, At, B0); PG8_BAR; PG8_SCHED;
            PG8_STAGE(PG8_SB(1, 1), b3 + hstepB, voffB);
            PG8_WAIT_V(6); PG8_BAR; PG8_MMA(1, 1, At, B1); PG8_BAR;
        }
        const bool keep = E(acc, cur, wr, wc, fr, fq); S.done(cur);
        if (!has_next) break;
        if (!keep) {
#pragma unroll
        for (int a = 0; a < 2; ++a)
#pragma unroll
            for (int b = 0; b < 2; ++b)
#pragma unroll
                for (int m = 0; m < 4; ++m)
#pragma unroll
                    for (int n = 0; n < 2; ++n) acc[a][b][m][n] = (f32x4){0.f, 0.f, 0.f, 0.f};
        }
        cur = nxt; cA = nA; cB = nB; ++ui;
    }
    PG8_WAIT_V(0);
    if (wr == 0) PG8_BAR;
    PG8_BAR;
#undef PG8_SA
#undef PG8_SB
#undef PG8_STAGE
#undef PG8_LDA
#undef PG8_LDB
#undef PG8_MMA
#undef PG8_WAIT_V
#undef PG8_WAIT_L
#undef PG8_BAR
#undef PG8_SCHED
}

struct EpiBf16Store {
    static constexpr bool PERM = true;
    bf16_t* O; int ldc;
    __device__ __forceinline__ bool operator()(Acc& acc, const Unit& u, int wr, int wc, int fr, int fq) const {
        const int row0 = u.pm * BM + wr * 64 + fr, col0 = u.pn * BM + wc * 32 + 8 * fq;
#pragma unroll
        for (int ai = 0; ai < 2; ++ai)
#pragma unroll
            for (int m = 0; m < 4; ++m) { bf16_t* rowp = O + (size_t)(row0 + ai * HALF + m * 16) * ldc + col0;
#pragma unroll
                for (int bj = 0; bj < 2; ++bj) { const f32x4 v0 = acc[ai][bj][m][0], v1 = acc[ai][bj][m][1];
                    u32x4 w; w.x = pk2(v0[0], v0[1]); w.y = pk2(v0[2], v0[3]); w.z = pk2(v1[0], v1[1]); w.w = pk2(v1[2], v1[3]);
                    *(u32x4*)(rowp + bj * HALF) = w; } }
        return false;
    }
};
struct EpiWin {
    static constexpr bool PERM = true;
    bf16_t* O; int ldc;
    __device__ __forceinline__ bool operator()(Acc& acc, const Unit& u, int wr, int wc, int fr, int fq) const {
        const int row0 = u.pm * BM + wr * 64 + fr, col0 = u.pn * BM + wc * 32 + 8 * fq;
#pragma unroll
        for (int bj = 0; bj < 2; ++bj) { const bool gate = (col0 + bj * HALF) >= GATE_OFF;
#pragma unroll
            for (int ai = 0; ai < 2; ++ai)
#pragma unroll
                for (int m = 0; m < 4; ++m) { f32x4 v0 = acc[ai][bj][m][0], v1 = acc[ai][bj][m][1];
                    if (gate) {
#pragma unroll
                        for (int j = 0; j < 4; ++j) { v0[j] = __builtin_amdgcn_rcpf(1.0f + __expf(-v0[j])); v1[j] = __builtin_amdgcn_rcpf(1.0f + __expf(-v1[j])); } }
                    u32x4 w; w.x = pk2(v0[0], v0[1]); w.y = pk2(v0[2], v0[3]); w.z = pk2(v1[0], v1[1]); w.w = pk2(v1[2], v1[3]);
                    *(u32x4*)(O + (size_t)(row0 + ai * HALF + m * 16) * ldc + col0 + bj * HALF) = w; } }
        return false;
    }
};
struct EpiNone { static constexpr bool PERM = true;
    __device__ __forceinline__ bool operator()(Acc& acc, const Unit&, int, int, int, int) const {
#pragma unroll
        for (int a = 0; a < 2; ++a)
#pragma unroll
            for (int b = 0; b < 2; ++b)
#pragma unroll
                for (int m = 0; m < 4; ++m)
#pragma unroll
                    for (int n = 0; n < 2; ++n) asm volatile("" :: "v"(acc[a][b][m][n]));
        return false; } };
struct EpiGlu {
    static constexpr bool PERM = true;
    const bf16_t* GG; const float* bias; bf16_t* Y4;
    __device__ __forceinline__ bool operator()(Acc& acc, const Unit& u, int wr, int wc, int fr, int fq) const {
        const int row0 = u.pm * BM + wr * 64 + fr, col0 = u.pn * BM + wc * 32 + 8 * fq;
#pragma unroll
        for (int bj = 0; bj < 2; ++bj) { const int col = col0 + bj * HALF; const f32x4 b0 = *(const f32x4*)(bias + col), b1 = *(const f32x4*)(bias + col + 4);
            u32x4 gq[2][4];
#pragma unroll
            for (int ai = 0; ai < 2; ++ai)
#pragma unroll
                for (int m = 0; m < 4; ++m) gq[ai][m] = *(const u32x4*)(GG + (size_t)(row0 + ai * HALF + m * 16) * BW + col);
#pragma unroll
            for (int ai = 0; ai < 2; ++ai)
#pragma unroll
                for (int m = 0; m < 4; ++m) { const size_t row = (size_t)(row0 + ai * HALF + m * 16);
                    float gg[8]; unpack8(gq[ai][m], gg);
                    const f32x4 v0 = acc[ai][bj][m][0] + b0, v1 = acc[ai][bj][m][1] + b1;
                    u32x4 w; w.x = pk2(gg[0] * sigmoidf_(v0[0]), gg[1] * sigmoidf_(v0[1])); w.y = pk2(gg[2] * sigmoidf_(v0[2]), gg[3] * sigmoidf_(v0[3]));
                    w.z = pk2(gg[4] * sigmoidf_(v1[0]), gg[5] * sigmoidf_(v1[1])); w.w = pk2(gg[6] * sigmoidf_(v1[2]), gg[7] * sigmoidf_(v1[3]));
                    *(u32x4*)(Y4 + row * DM + 1024 + col) = w; } }
        return false;
    }
};
struct EpiBranch {
    static constexpr bool PERM = true;
    const bf16_t* P; bf16_t* ACCb;
    __device__ __forceinline__ bool operator()(Acc& acc, const Unit& u, int wr, int wc, int fr, int fq) const {
        const int row0 = u.pm * BM + wr * 64 + fr, col0 = u.pn * BM + wc * 32 + 8 * fq; const int k = u.k;
        const bf16_t* gbase = P + (size_t)row0 * LDP + GATE_OFF + k * DM + col0;
        if (k < 3) {
#pragma unroll
            for (int ai = 0; ai < 2; ++ai) {
                u32x4 ga[8], gb[8];
#pragma unroll
                for (int m = 0; m < 4; ++m)
#pragma unroll
                    for (int bj = 0; bj < 2; ++bj) { const bf16_t* p = gbase + (size_t)(ai * HALF + m * 16) * LDP + bj * HALF; ga[m * 2 + bj] = *(const u32x4*)p; gb[m * 2 + bj] = *(const u32x4*)(p + DM); }
#pragma unroll
                for (int m = 0; m < 4; ++m)
#pragma unroll
                    for (int bj = 0; bj < 2; ++bj) { float g0[8], g1[8]; unpack8(ga[m * 2 + bj], g0); unpack8(gb[m * 2 + bj], g1);
                        float s[8];
#pragma unroll
                        for (int j = 0; j < 8; ++j) s[j] = g0[j] * __builtin_amdgcn_rcpf(g1[j]);
                        f32x4 v0 = acc[ai][bj][m][0], v1 = acc[ai][bj][m][1];
                        v0[0] *= s[0]; v0[1] *= s[1]; v0[2] *= s[2]; v0[3] *= s[3]; v1[0] *= s[4]; v1[1] *= s[5]; v1[2] *= s[6]; v1[3] *= s[7];
                        acc[ai][bj][m][0] = v0; acc[ai][bj][m][1] = v1; } }
            return true;
        }
#pragma unroll
        for (int ai = 0; ai < 2; ++ai) {
            u32x4 ga[8];
#pragma unroll
            for (int m = 0; m < 4; ++m)
#pragma unroll
                for (int bj = 0; bj < 2; ++bj) ga[m * 2 + bj] = *(const u32x4*)(gbase + (size_t)(ai * HALF + m * 16) * LDP + bj * HALF);
#pragma unroll
            for (int m = 0; m < 4; ++m)
#pragma unroll
                for (int bj = 0; bj < 2; ++bj) { float s[8]; unpack8(ga[m * 2 + bj], s);
                    f32x4 v0 = acc[ai][bj][m][0], v1 = acc[ai][bj][m][1];
                    v0[0] *= s[0]; v0[1] *= s[1]; v0[2] *= s[2]; v0[3] *= s[3]; v1[0] *= s[4]; v1[1] *= s[5]; v1[2] *= s[6]; v1[3] *= s[7];
                    u32x4 w; w.x = pk2(v0[0], v0[1]); w.y = pk2(v0[2], v0[3]); w.z = pk2(v1[0], v1[1]); w.w = pk2(v1[2], v1[3]);
                    *(u32x4*)(ACCb + (size_t)(row0 + ai * HALF + m * 16) * DM + col0 + bj * HALF) = w; } }
        return false;
    }
};
struct EpiPart {
    static constexpr bool PERM = true;
    const bf16_t* P; float* PART;
    __device__ __forceinline__ bool operator()(Acc& acc, const Unit& u, int wr, int wc, int fr, int fq) const {
        const int row0 = u.pm * BM + wr * 64 + fr, col0 = u.pn * BM + wc * 32 + 8 * fq; const int k = u.k;
        const bf16_t* gbase = P + (size_t)row0 * LDP + GATE_OFF + k * DM + col0;
        float* pbase = PART + ((size_t)k * (NTOK - NLAT) + (size_t)(row0 - NLAT)) * DM + col0;
#pragma unroll
        for (int ai = 0; ai < 2; ++ai) {
            u32x4 ga[8];
#pragma unroll
            for (int m = 0; m < 4; ++m)
#pragma unroll
                for (int bj = 0; bj < 2; ++bj) ga[m * 2 + bj] = *(const u32x4*)(gbase + (size_t)(ai * HALF + m * 16) * LDP + bj * HALF);
#pragma unroll
            for (int m = 0; m < 4; ++m)
#pragma unroll
                for (int bj = 0; bj < 2; ++bj) { float sg[8]; unpack8(ga[m * 2 + bj], sg);
                    f32x4 v0 = acc[ai][bj][m][0], v1 = acc[ai][bj][m][1];
                    v0[0] *= sg[0]; v0[1] *= sg[1]; v0[2] *= sg[2]; v0[3] *= sg[3]; v1[0] *= sg[4]; v1[1] *= sg[5]; v1[2] *= sg[6]; v1[3] *= sg[7];
                    float* pp = pbase + (size_t)(ai * HALF + m * 16) * DM + bj * HALF;
                    *(f32x4*)pp = v0; *(f32x4*)(pp + 4) = v1; } }
        return false;
    }
};
struct EpiPartK {
    static constexpr bool PERM = true;
    float* PART;
    __device__ __forceinline__ bool operator()(Acc& acc, const Unit& u, int wr, int wc, int fr, int fq) const {
        const int row0 = u.pm * BM + wr * 64 + fr, col0 = u.pn * BM + wc * 32 + 8 * fq;
        float* pbase = PART + ((size_t)u.k * (NTOK - NLAT) + (size_t)(row0 - NLAT)) * DM + col0;
#pragma unroll
        for (int ai = 0; ai < 2; ++ai)
#pragma unroll
            for (int m = 0; m < 4; ++m)
#pragma unroll
                for (int bj = 0; bj < 2; ++bj) { float* pp = pbase + (size_t)(ai * HALF + m * 16) * DM + bj * HALF; *(f32x4*)pp = acc[ai][bj][m][0]; *(f32x4*)(pp + 4) = acc[ai][bj][m][1]; }
        return false;
    }
};
struct EpiResid {
    static constexpr bool PERM = false;
    float* XS; const float* srcLat; const float* srcCtx; const float* MODl; int gidx;
    __device__ __forceinline__ bool operator()(Acc& acc, const Unit& u, int wr, int wc, int fr, int fq) const {
        const int row0 = u.pm * BM + wr * 64 + fr, col0 = u.pn * BM + wc * 32 + 4 * fq;
        const int r = (u.pm * BM) < NLAT ? (u.pm * BM) / SEQ : 4;
        const float* src = (u.pm * BM) < NLAT ? srcLat : srcCtx;
        const float* mg = MODl + (size_t)(r * 6 + gidx) * DM;
#pragma unroll
        for (int bj = 0; bj < 2; ++bj) {
            f32x4 gm[2], xs[2][2][4];
#pragma unroll
            for (int n = 0; n < 2; ++n) { const int col = col0 + bj * HALF + n * 16; gm[n] = *(const f32x4*)(mg + col);
#pragma unroll
                for (int ai = 0; ai < 2; ++ai)
#pragma unroll
                    for (int m = 0; m < 4; ++m) xs[n][ai][m] = *(const f32x4*)(src + (size_t)(row0 + ai * HALF + m * 16) * DM + col); }
#pragma unroll
            for (int n = 0; n < 2; ++n) { const int col = col0 + bj * HALF + n * 16;
#pragma unroll
                for (int ai = 0; ai < 2; ++ai)
#pragma unroll
                    for (int m = 0; m < 4; ++m) *(f32x4*)(XS + (size_t)(row0 + ai * HALF + m * 16) * DM + col) = xs[n][ai][m] + gm[n] * acc[ai][bj][m][n]; } }
        return false;
    }
};
struct EpiMoe1 {
    static constexpr bool PERM = true;
    bf16_t* HID;
    __device__ __forceinline__ bool operator()(Acc& acc, const Unit& u, int wr, int wc, int fr, int fq) const {
        const size_t row0 = (size_t)u.z * MOE_PAD + u.pm * BM + wr * 64 + fr; const int col0 = u.pn * HALF + wc * 32 + 8 * fq;
#pragma unroll
        for (int ai = 0; ai < 2; ++ai)
#pragma unroll
            for (int m = 0; m < 4; ++m) { const f32x4 g0 = acc[ai][0][m][0], g1 = acc[ai][0][m][1], u0 = acc[ai][1][m][0], u1 = acc[ai][1][m][1];
                float h[8];
#pragma unroll
                for (int j = 0; j < 4; ++j) { h[j] = g0[j] * __builtin_amdgcn_rcpf(1.0f + __expf(-g0[j])) * u0[j]; h[4 + j] = g1[j] * __builtin_amdgcn_rcpf(1.0f + __expf(-g1[j])) * u1[j]; }
                u32x4 w; w.x = pk2(h[0], h[1]); w.y = pk2(h[2], h[3]); w.z = pk2(h[4], h[5]); w.w = pk2(h[6], h[7]);
                *(u32x4*)(HID + (row0 + ai * HALF + m * 16) * DEXP + col0) = w; }
        return false;
    }
};
struct EpiMoeY {
    static constexpr bool PERM = true;
    bf16_t* O;
    __device__ __forceinline__ bool operator()(Acc& acc, const Unit& u, int wr, int wc, int fr, int fq) const {
        const size_t row0 = (size_t)u.z * MOE_PAD + u.pm * BM + wr * 64 + fr; const int col0 = u.pn * BM + wc * 32 + 8 * fq;
#pragma unroll
        for (int ai = 0; ai < 2; ++ai)
#pragma unroll
            for (int m = 0; m < 4; ++m) { bf16_t* rowp = O + (row0 + ai * HALF + m * 16) * DM + col0;
#pragma unroll
                for (int bj = 0; bj < 2; ++bj) { const f32x4 v0 = acc[ai][bj][m][0], v1 = acc[ai][bj][m][1];
                    u32x4 w; w.x = pk2(v0[0], v0[1]); w.y = pk2(v0[2], v0[3]); w.z = pk2(v1[0], v1[1]); w.w = pk2(v1[2], v1[3]);
                    *(u32x4*)(rowp + bj * HALF) = w; } }
        return false;
    }
};

struct SchedS5a {
    int c;
    __device__ __forceinline__ bool next(int i, Unit& u) const { if (i > 0 || c >= 64) return false; u.z = c >> 1; u.pm = c & 1; u.pn = 0; u.k = 0;
        u.ao = ((long long)u.z * 512 + u.pm * BM) * 768 * 2; u.bo = (long long)u.z * 256 * 512 * 2; return true; }
    __device__ __forceinline__ void a_ready(const Unit&) const {}
    __device__ __forceinline__ void done(const Unit&) const {}
};
struct SchedS5b {
    int c;
    __device__ __forceinline__ bool next(int i, Unit& u) const { if (i > 0 || c >= 128) return false; u.z = c >> 2; u.pm = (c >> 1) & 1; u.pn = c & 1; u.k = 0;
        u.ao = ((long long)u.z * 512 + u.pm * BM) * 768 * 2; u.bo = ((long long)u.z * 512 + u.pn * BM) * 768 * 2; return true; }
    __device__ __forceinline__ void a_ready(const Unit&) const {}
    __device__ __forceinline__ void done(const Unit&) const {}
};
struct EpiXloc {
    static constexpr bool PERM = false;
    float* XL;
    __device__ __forceinline__ bool operator()(Acc& acc, const Unit& u, int wr, int wc, int fr, int fq) const {
        const int row0 = u.pm * BM + wr * 64 + fr, col0 = wc * 32 + 4 * fq; float* base = XL + (size_t)u.z * 512 * 256;
#pragma unroll
        for (int ai = 0; ai < 2; ++ai)
#pragma unroll
            for (int m = 0; m < 4; ++m) { float* rowp = base + (size_t)(row0 + ai * HALF + m * 16) * 256 + col0;
#pragma unroll
                for (int bj = 0; bj < 2; ++bj)
#pragma unroll
                    for (int n = 0; n < 2; ++n) *(f32x4*)(rowp + bj * HALF + n * 16) = acc[ai][bj][m][n]; }
        return false;
    }
};
struct EpiS5Out {
    static constexpr bool PERM = true;
    const bf16_t* P; const float* dskip; bf16_t* GG;
    __device__ __forceinline__ bool operator()(Acc& acc, const Unit& u, int wr, int wc, int fr, int fq) const {
        const int row0 = u.pm * BM + wr * 64 + fr, col0 = u.pn * BM + wc * 32 + 8 * fq; const int g = u.z;
#pragma unroll
        for (int bj = 0; bj < 2; ++bj) { const int col = col0 + bj * HALF; const int t = col >> 4, c0 = col & 15;
            const f32x4 d0 = *(const f32x4*)(dskip + g * 16 + c0), d1 = *(const f32x4*)(dskip + g * 16 + c0 + 4);
            u32x4 uq[2][4];
#pragma unroll
            for (int ai = 0; ai < 2; ++ai)
#pragma unroll
                for (int m = 0; m < 4; ++m) uq[ai][m] = *(const u32x4*)(P + ((size_t)(row0 + ai * HALF + m * 16) * 32 + t) * LDP + S5_OFF + g * 16 + c0);
#pragma unroll
            for (int ai = 0; ai < 2; ++ai)
#pragma unroll
                for (int m = 0; m < 4; ++m) { const size_t tok = (size_t)(row0 + ai * HALF + m * 16) * 32 + t;
                    float uu[8]; unpack8(uq[ai][m], uu);
                    const f32x4 v0 = acc[ai][bj][m][0], v1 = acc[ai][bj][m][1];
                    float y[8] = {v0[0] + d0[0] * uu[0], v0[1] + d0[1] * uu[1], v0[2] + d0[2] * uu[2], v0[3] + d0[3] * uu[3], v1[0] + d1[0] * uu[4], v1[1] + d1[1] * uu[5], v1[2] + d1[2] * uu[6], v1[3] + d1[3] * uu[7]};
#pragma unroll
                    for (int j = 0; j < 8; ++j) y[j] = 0.5f * y[j] * (1.0f + tanhf(0.7978845608028654f * (y[j] + 0.044715f * y[j] * y[j] * y[j])));
                    u32x4 w; w.x = pk2(y[0], y[1]); w.y = pk2(y[2], y[3]); w.z = pk2(y[4], y[5]); w.w = pk2(y[6], y[7]);
                    *(u32x4*)(GG + tok * BW + g * 16 + c0) = w; } }
        return false;
    }
};
}


__device__ __forceinline__ float wave_scan_incl(float v, int lane) {
#pragma unroll
    for (int o = 1; o < 64; o <<= 1) { const float t = __shfl_up(v, o); if (lane >= o) v += t; }
    return v;
}
__device__ __forceinline__ float wave_scanmax_incl(float v, int lane) {
#pragma unroll
    for (int o = 1; o < 64; o <<= 1) { const float t = __shfl_up(v, o); if (lane >= o) v = fmaxf(v, t); }
    return v;
}
__device__ __forceinline__ float wave_max(float v) {
#pragma unroll
    for (int o = 32; o >= 1; o >>= 1) v = fmaxf(v, __shfl_xor(v, o));
    return v;
}
__device__ __forceinline__ void unpack8h(const u32x4 w, bf16_t (&h)[8]) {
    h[0] = (bf16_t)(w.x & 0xFFFFu); h[1] = (bf16_t)(w.x >> 16); h[2] = (bf16_t)(w.y & 0xFFFFu); h[3] = (bf16_t)(w.y >> 16);
    h[4] = (bf16_t)(w.z & 0xFFFFu); h[5] = (bf16_t)(w.z >> 16); h[6] = (bf16_t)(w.w & 0xFFFFu); h[7] = (bf16_t)(w.w >> 16);
}

__device__ __forceinline__ int tokblock_of(int b, int dir, int c) { if (c < 4) return 256 + b * 4 + (dir ? 3 - c : c); const int j = c - 4; return b * 64 + (dir ? 63 - j : j); }
__device__ __forceinline__ u32x4 rev8h(const u32x4 v) { u32x4 r; r.x = (v.w >> 16) | (v.w << 16); r.y = (v.z >> 16) | (v.z << 16); r.z = (v.y >> 16) | (v.y << 16); r.w = (v.x >> 16) | (v.x << 16); return r; }
__device__ __forceinline__ u32x4 scale8h(const u32x4 v, const float4 a, const float4 b) { float f[8]; unpack8(v, f); u32x4 r; r.x = pk2(f[0] * a.x, f[1] * a.y); r.y = pk2(f[2] * a.z, f[3] * a.w); r.z = pk2(f[4] * b.x, f[5] * b.y); r.w = pk2(f[6] * b.z, f[7] * b.w); return r; }
__device__ __forceinline__ float dot8h(const u32x4 v, const float4 a, const float4 b) { float f[8]; unpack8(v, f); return (f[0] * a.x + f[1] * a.y) + (f[2] * a.z + f[3] * a.w) + (f[4] * b.x + f[5] * b.y) + (f[6] * b.z + f[7] * b.w); }
#define ML_FRAG_LOAD(KF, VF, cc_) do { const int tb_ = tokblock_of(b, dir, (cc_)); const bf16_t* kb_ = KTg + ((size_t)tb_ * 512 + h * 128 + 32 * wd + r16) * 64 + q4 * 8; const bf16_t* vb_ = VTg + ((size_t)tb_ * 512 + h * 128 + 64 * half + 32 * we + r16) * 64 + q4 * 8; \
        _Pragma("unroll") for (int ks_ = 0; ks_ < 2; ++ks_) _Pragma("unroll") for (int j_ = 0; j_ < 2; ++j_) { VF[j_][ks_] = *(const u32x4*)(vb_ + (size_t)j_ * 16 * 64 + ks_ * 32); KF[j_][ks_] = *(const u32x4*)(kb_ + (size_t)j_ * 16 * 64 + ks_ * 32); } } while (0)
#define ML_CHUNK(c_, KF, VF, KFN, VFN) do { const int c = (c_); \
        if (c + 1 < 68) ML_FRAG_LOAD(KFN, VFN, c + 1);                        \
        const float dec = sDEC[c]; \
        {   bf16_t* cs = CST + (size_t)(chain * 68 + c) * 128 * 128; \
            _Pragma("unroll") for (int je = 0; je < 2; ++je) _Pragma("unroll") for (int jd = 0; jd < 2; ++jd) { const int e = 64 * half + 32 * we + 16 * je + r16, d0 = 32 * wd + 16 * jd + q4 * 4; \
                u32x2 pk; pk.x = pk2(acc[je][jd][0], acc[je][jd][1]); pk.y = pk2(acc[je][jd][2], acc[je][jd][3]); *(u32x2*)(cs + (size_t)e * 128 + d0) = pk; } \
            if (nown) { _Pragma("unroll") for (int jd = 0; jd < 2; ++jd) { float nv = npart[jd]; nv += __shfl_xor(nv, 16); nv += __shfl_xor(nv, 32); if (q4 == 0) NST[(size_t)(chain * 68 + c) * 128 + 32 * wd + 16 * jd + r16] = nv; } } } \
        bf16x8 vfr[2][2]; \
        _Pragma("unroll") for (int ks = 0; ks < 2; ++ks) { const float4 wa = *(const float4*)(sWS + c * 64 + ks * 32 + q4 * 8), wb = *(const float4*)(sWS + c * 64 + ks * 32 + q4 * 8 + 4); \
            _Pragma("unroll") for (int je = 0; je < 2; ++je) { const u32x4 sv = scale8h(VF[je][ks], wa, wb); vfr[je][ks] = *(const bf16x8*)&sv; } \
            if (nown) { _Pragma("unroll") for (int jd = 0; jd < 2; ++jd) npart[jd] = (ks == 0 ? dec * npart[jd] : npart[jd]) + dot8h(KF[jd][ks], wa, wb); } } \
        _Pragma("unroll") for (int je = 0; je < 2; ++je) _Pragma("unroll") for (int jd = 0; jd < 2; ++jd) acc[je][jd] = acc[je][jd] * dec; \
        _Pragma("unroll") for (int ks = 0; ks < 2; ++ks) _Pragma("unroll") for (int je = 0; je < 2; ++je) _Pragma("unroll") for (int jd = 0; jd < 2; ++jd) \
            acc[je][jd] = __builtin_amdgcn_mfma_f32_16x16x32_bf16(*(const bf16x8*)&KF[jd][ks], vfr[je][ks], acc[je][jd], 0, 0, 0); } while (0)
__device__ __forceinline__ void mlstm_state_pass(const int chain, const int half, const bf16_t* __restrict__ Pm, const bf16_t* __restrict__ KTg, const bf16_t* __restrict__ VTg, const float* __restrict__ gate_b,
                                                 bf16_t* __restrict__ CST, float* __restrict__ NST, float* __restrict__ MST, unsigned char* shm, const int tid) {
    const int dir = chain & 1, h = (chain >> 1) & 3, b = chain >> 3, lane = tid & 63, w = tid >> 6, we = w >> 2, wd = w & 3, q4 = lane >> 4, r16 = lane & 15;
    const bool nown = (half == 0) && (we == 0);
    float* sE = (float*)shm; float* sWS = sE + 68 * 64; float* sAL = sWS + 68 * 64; float* sBE = sAL + 68; float* sMO = sBE + 68; float* sDEC = sMO + 68; float* sMB = sDEC + 68;
    const float gbi = gate_b[(dir * 2 + 0) * 4 + h], gbf = gate_b[(dir * 2 + 1) * 4 + h];
    const int gcol_i = ML_OFF + 2048 + (dir * 2 + 0) * 4 + h, gcol_f = ML_OFF + 2048 + (dir * 2 + 1) * 4 + h;
    u32x4 kfA[2][2], vfA[2][2], kfB[2][2], vfB[2][2];
    ML_FRAG_LOAD(kfA, vfA, 0);
    __syncthreads();
    unsigned gi_[9], gf_[9];
#pragma unroll
    for (int q = 0; q < 9; ++q) { const int c = min(w + 8 * q, 67); const size_t tokl = (size_t)step_tok(b, dir, c * 64 + lane); gi_[q] = Pm[tokl * LDP + gcol_i]; gf_[q] = Pm[tokl * LDP + gcol_f]; }
#pragma unroll
    for (int q = 0; q < 9; ++q) { const int c = w + 8 * q; if (c >= 68) break;
        const float ig = __uint_as_float(gi_[q] << 16) + gbi, fg = __uint_as_float(gf_[q] << 16) + gbf;
        const float lf = fminf(fg, 0.f) - log1pf(expf(-fabsf(fg)));
        const float bcs = wave_scan_incl(lf, lane); const float blast = __shfl(bcs, 63); const float ei = blast - bcs + ig; const float beta = wave_max(ei);
        sE[c * 64 + lane] = ei; if (lane == 0) { sAL[c] = blast; sBE[c] = beta; } }
    __syncthreads();
    if (tid == 0) { float m = 0.f; for (int c = 0; c < 68; ++c) { sMB[c] = m; const float mo = fmaxf(m + sAL[c], sBE[c]); sDEC[c] = expf(sAL[c] + m - mo); sMO[c] = mo; m = mo; } }
    __syncthreads();
    for (int idx = tid; idx < 68 * 64; idx += NTHR) { const int c = idx >> 6, i = idx & 63; sWS[c * 64 + (dir ? 63 - i : i)] = expf(sE[idx] - sMO[c]); }
    if (half == 0 && tid < 68) MST[chain * 68 + tid] = sMB[tid];
    __syncthreads();
    f32x4 acc[2][2];
#pragma unroll
    for (int je = 0; je < 2; ++je)
#pragma unroll
        for (int jd = 0; jd < 2; ++jd) acc[je][jd] = (f32x4){0.f, 0.f, 0.f, 0.f};
    float npart[2] = {0.f, 0.f};
    for (int c2 = 0; c2 < 68; c2 += 2) { ML_CHUNK(c2, kfA, vfA, kfB, vfB); ML_CHUNK(c2 + 1, kfB, vfB, kfA, vfA); }
    __syncthreads();
}
#undef ML_CHUNK
#undef ML_FRAG_LOAD
__device__ __forceinline__ void mlstm_out_item(const int chain, const int c, const bf16_t* __restrict__ Pm, const bf16_t* __restrict__ QKb, const bf16_t* __restrict__ VTg, const float* __restrict__ gate_b,
                                               const bf16_t* __restrict__ CST, const float* __restrict__ NST, const float* __restrict__ MST, bf16_t* __restrict__ Hout, unsigned char* shm, const int tid) {
    const int dir = chain & 1, h = (chain >> 1) & 3, b = chain >> 3, lane = tid & 63, w = tid >> 6;
    bf16_t* Qs = (bf16_t*)shm; bf16_t* Ks = (bf16_t*)(shm + 17408); bf16_t* VT = (bf16_t*)(shm + 34816); bf16_t* Cs = (bf16_t*)(shm + 53248); bf16_t* Ss = (bf16_t*)(shm + 88064);
    float* sc = (float*)(shm + 97280);
    __syncthreads();
    u32x4 gq[2], gk[2], gv[2], gc[4]; float gn = 0.f;
#pragma unroll
    for (int i = 0; i < 2; ++i) { const int pid = tid + i * 512; const int s = pid >> 4, x0 = (pid & 15) * 8; const size_t toks = (size_t)step_tok(b, dir, c * 64 + s);
        gq[i] = *(const u32x4*)(QKb + toks * 1024 + h * 128 + x0);
        gk[i] = *(const u32x4*)(QKb + toks * 1024 + 512 + h * 128 + x0);
        { const int e = pid >> 3, o = pid & 7;
          gv[i] = *(const u32x4*)(VTg + ((size_t)tokblock_of(b, dir, c) * 512 + h * 128 + e) * 64 + (dir ? 7 - o : o) * 8); } }
#pragma unroll
    for (int i = 0; i < 4; ++i) { const int pid = tid + i * 512; const int e = pid >> 4, x0 = (pid & 15) * 8;
        gc[i] = *(const u32x4*)(CST + ((size_t)(chain * 68 + c) * 128 + e) * 128 + x0); }
    if (tid < 128) gn = NST[(size_t)(chain * 68 + c) * 128 + tid];
    unsigned gi_ = 0u, gf_ = 0u; float gbi = 0.f, gbf = 0.f, m_in = 0.f;
    if (w == 0) { const size_t tokl = (size_t)step_tok(b, dir, c * 64 + lane);
        gi_ = Pm[tokl * LDP + ML_OFF + 2048 + (dir * 2 + 0) * 4 + h]; gf_ = Pm[tokl * LDP + ML_OFF + 2048 + (dir * 2 + 1) * 4 + h];
        gbi = gate_b[(dir * 2 + 0) * 4 + h]; gbf = gate_b[(dir * 2 + 1) * 4 + h]; m_in = MST[chain * 68 + c]; }
#pragma unroll
    for (int i = 0; i < 2; ++i) { const int pid = tid + i * 512; const int s = pid >> 4, x0 = (pid & 15) * 8;
        *(u32x4*)(Qs + s * 136 + x0) = gq[i]; *(u32x4*)(Ks + s * 136 + x0) = gk[i];
        { const int e = pid >> 3, o = pid & 7; *(u32x4*)(VT + e * 72 + o * 8) = dir ? rev8h(gv[i]) : gv[i]; } }
#pragma unroll
    for (int i = 0; i < 4; ++i) { const int pid = tid + i * 512; const int e = pid >> 4, x0 = (pid & 15) * 8; *(u32x4*)(Cs + e * 136 + x0) = gc[i]; }
    if (tid < 128) sc[384 + tid] = gn;
    if (w == 0) {
        const float ig = __uint_as_float(gi_ << 16) + gbi;
        const float fg = __uint_as_float(gf_ << 16) + gbf;
        const float lf = fminf(fg, 0.f) - log1pf(expf(-fabsf(fg)));
        const float bcs = wave_scan_incl(lf, lane); const float gsv = ig - bcs; const float pm = wave_scanmax_incl(gsv, lane);
        const float mt = bcs + fmaxf(m_in, pm);
        sc[lane] = bcs; sc[64 + lane] = gsv; sc[128 + lane] = mt; sc[192 + lane] = expf(bcs + m_in - mt); sc[256 + lane] = expf(-mt);
    }
    __syncthreads();
    const int tt = w >> 1;
    {   f32x4 aS[2] = {(f32x4){0.f, 0.f, 0.f, 0.f}, (f32x4){0.f, 0.f, 0.f, 0.f}};
#pragma unroll
        for (int ks = 0; ks < 4; ++ks) { const bf16x8 af = *(const bf16x8*)(Qs + (16 * tt + (lane & 15)) * 136 + ks * 32 + (lane >> 4) * 8);
#pragma unroll
            for (int i = 0; i < 2; ++i) { const int st = (w & 1) * 2 + i; const bf16x8 bfr = *(const bf16x8*)(Ks + (16 * st + (lane & 15)) * 136 + ks * 32 + (lane >> 4) * 8);
                aS[i] = __builtin_amdgcn_mfma_f32_16x16x32_bf16(af, bfr, aS[i], 0, 0, 0); } }
        float rs[4] = {0.f, 0.f, 0.f, 0.f};
#pragma unroll
        for (int i = 0; i < 2; ++i) { const int s = 16 * ((w & 1) * 2 + i) + (lane & 15); const float gsv = sc[64 + s];
#pragma unroll
            for (int q = 0; q < 4; ++q) { const int t = 16 * tt + (lane >> 4) * 4 + q; const float val = (s <= t) ? aS[i][q] * expf(sc[t] + gsv - sc[128 + t]) : 0.f; Ss[t * 72 + s] = f2bf(val); rs[q] += val; } }
#pragma unroll
        for (int q = 0; q < 4; ++q) { float r = rs[q]; r += __shfl_xor(r, 1); r += __shfl_xor(r, 2); r += __shfl_xor(r, 4); r += __shfl_xor(r, 8);
            if ((lane & 15) == 0) sc[512 + (w & 1) * 64 + 16 * tt + (lane >> 4) * 4 + q] = r; }
        {   const int t = tid >> 3, part = tid & 7; float dot = 0.f;
#pragma unroll
            for (int j = 0; j < 16; ++j) dot += bf2f(Qs[t * 136 + part * 16 + j]) * sc[384 + part * 16 + j];
            dot += __shfl_xor(dot, 1); dot += __shfl_xor(dot, 2); dot += __shfl_xor(dot, 4);
            if (part == 0) sc[640 + t] = sc[192 + t] * dot; }
    }
    __syncthreads();
    {   f32x4 aN[4];
#pragma unroll
        for (int i = 0; i < 4; ++i) aN[i] = (f32x4){0.f, 0.f, 0.f, 0.f};
#pragma unroll
        for (int ks = 0; ks < 4; ++ks) { const bf16x8 af = *(const bf16x8*)(Qs + (16 * tt + (lane & 15)) * 136 + ks * 32 + (lane >> 4) * 8);
#pragma unroll
            for (int i = 0; i < 4; ++i) { const int et = (w & 1) * 4 + i; const bf16x8 bfr = *(const bf16x8*)(Cs + (16 * et + (lane & 15)) * 136 + ks * 32 + (lane >> 4) * 8);
                aN[i] = __builtin_amdgcn_mfma_f32_16x16x32_bf16(bfr, af, aN[i], 0, 0, 0); } }
        const int t = 16 * tt + (lane & 15);
        {   const float it = sc[192 + t];
#pragma unroll
            for (int i = 0; i < 4; ++i) { aN[i][0] *= it; aN[i][1] *= it; aN[i][2] *= it; aN[i][3] *= it; } }
#pragma unroll
        for (int ks = 0; ks < 2; ++ks) { const bf16x8 af = *(const bf16x8*)(Ss + (16 * tt + (lane & 15)) * 72 + ks * 32 + (lane >> 4) * 8);
#pragma unroll
            for (int i = 0; i < 4; ++i) { const int et = (w & 1) * 4 + i; const bf16x8 bfr = *(const bf16x8*)(VT + (16 * et + (lane & 15)) * 72 + ks * 32 + (lane >> 4) * 8);
                aN[i] = __builtin_amdgcn_mfma_f32_16x16x32_bf16(bfr, af, aN[i], 0, 0, 0); } }
        {   const size_t tokt = (size_t)step_tok(b, dir, c * 64 + t); const float dn = fmaxf(fabsf((sc[512 + t] + sc[576 + t]) + sc[640 + t]), sc[256 + t]);
#pragma unroll
            for (int i = 0; i < 4; ++i) { const int e0 = 16 * ((w & 1) * 4 + i) + (lane >> 4) * 4;
                u32x2 wv; wv.x = pk2(aN[i][0] / dn, aN[i][1] / dn); wv.y = pk2(aN[i][2] / dn, aN[i][3] / dn);
                *(u32x2*)(Hout + tokt * BW + h * 128 + e0) = wv; } }
    }
}


#define SD_FRAG_LOAD(BF, XF, cc_) do { const int tb_ = tokblock_of(b, dir, (cc_)); const bf16_t* bb_ = BTg + ((size_t)tb_ * 256 + grp * 128 + 64 * (w >> 2) + r16) * 64 + q4 * 8; const bf16_t* xb_ = XTg + ((size_t)tb_ * 512 + h * 64 + 16 * (w & 3) + r16) * 64 + q4 * 8; \
        _Pragma("unroll") for (int ks_ = 0; ks_ < 2; ++ks_) { XF[ks_] = *(const u32x4*)(xb_ + ks_ * 32); _Pragma("unroll") for (int j_ = 0; j_ < 4; ++j_) BF[j_][ks_] = *(const u32x4*)(bb_ + (size_t)j_ * 16 * 64 + ks_ * 32); } } while (0)
#define SD_CHUNK(c_, BF, XF, BFN, XFN) do { const int c = (c_); \
        if (c + 1 < 68) SD_FRAG_LOAD(BFN, XFN, c + 1); \
        const float dec = sDEC[c]; \
        {   bf16_t* ss = SSTb + (size_t)(chain * 68 + c) * 64 * 128; const int p = 16 * (w & 3) + r16; \
            _Pragma("unroll") for (int j = 0; j < 4; ++j) { const int n0 = 16 * ((w >> 2) * 4 + j) + q4 * 4; u32x2 pk; pk.x = pk2(acc[j][0], acc[j][1]); pk.y = pk2(acc[j][2], acc[j][3]); *(u32x2*)(ss + (size_t)p * 128 + n0) = pk; } } \
        bf16x8 xfr[2]; \
        _Pragma("unroll") for (int ks = 0; ks < 2; ++ks) { const float4 wa = *(const float4*)(sSC + c * 64 + ks * 32 + q4 * 8), wb = *(const float4*)(sSC + c * 64 + ks * 32 + q4 * 8 + 4); const u32x4 sv = scale8h(XF[ks], wa, wb); xfr[ks] = *(const bf16x8*)&sv; } \
        _Pragma("unroll") for (int j = 0; j < 4; ++j) acc[j] = acc[j] * dec; \
        _Pragma("unroll") for (int ks = 0; ks < 2; ++ks) _Pragma("unroll") for (int j = 0; j < 4; ++j) acc[j] = __builtin_amdgcn_mfma_f32_16x16x32_bf16(*(const bf16x8*)&BF[j][ks], xfr[ks], acc[j], 0, 0, 0); } while (0)
__device__ __forceinline__ void ssd_state_pass(const int chain, const bf16_t* __restrict__ Pm, const bf16_t* __restrict__ BTg, const bf16_t* __restrict__ XTg, const float Aa, const float dtb,
                                               bf16_t* __restrict__ SSTb, unsigned char* shm, const int tid) {
    const int dir = chain & 1, h = (chain >> 1) & 7, b = chain >> 4, grp = h >> 2, lane = tid & 63, w = tid >> 6, q4 = lane >> 4, r16 = lane & 15;
    float* sSC = (float*)shm; float* sDEC = sSC + 68 * 64;
    const int dcol = SSD_OFF + 1536 + dir * 8 + h;
    u32x4 bfA[4][2], xfA[2], bfB[4][2], xfB[2];
    SD_FRAG_LOAD(bfA, xfA, 0);
    __syncthreads();
    unsigned dt_[9];
#pragma unroll
    for (int q = 0; q < 9; ++q) { const int c = min(w + 8 * q, 67); dt_[q] = Pm[(size_t)step_tok(b, dir, c * 64 + lane) * LDP + dcol]; }
#pragma unroll
    for (int q = 0; q < 9; ++q) { const int c = w + 8 * q; if (c >= 68) break;
        const float xv = __uint_as_float(dt_[q] << 16) + dtb; const float dtv = xv > 20.f ? xv : log1pf(expf(xv));
        const float cs = wave_scan_incl(dtv * Aa, lane); const float cl = __shfl(cs, 63);
        sSC[c * 64 + (dir ? 63 - lane : lane)] = dtv * expf(cl - cs); if (lane == 0) sDEC[c] = expf(cl); }
    __syncthreads();
    f32x4 acc[4];
#pragma unroll
    for (int j = 0; j < 4; ++j) acc[j] = (f32x4){0.f, 0.f, 0.f, 0.f};
    for (int c2 = 0; c2 < 68; c2 += 2) { SD_CHUNK(c2, bfA, xfA, bfB, xfB); SD_CHUNK(c2 + 1, bfB, xfB, bfA, xfA); }
    __syncthreads();
}
#undef SD_CHUNK
#undef SD_FRAG_LOAD
__device__ __forceinline__ void ssd_out_item(const int chain, const int c, const bf16_t* __restrict__ Pm, const bf16_t* __restrict__ XBb, const bf16_t* __restrict__ XTg, const float Aa, const float dtb,
                                             const bf16_t* __restrict__ SSTb, bf16_t* __restrict__ Yout, unsigned char* shm, const int tid) {
    const int dir = chain & 1, h = (chain >> 1) & 7, b = chain >> 4, grp = h >> 2, lane = tid & 63, w = tid >> 6;
    bf16_t* Cs = (bf16_t*)shm; bf16_t* Bs = (bf16_t*)(shm + 17408); bf16_t* XT = (bf16_t*)(shm + 34816); bf16_t* Sin = (bf16_t*)(shm + 44032); bf16_t* Gs = (bf16_t*)(shm + 61440);
    float* sc = (float*)(shm + 70656);
    __syncthreads();
    u32x4 gb[2], gcc[2], gs[2], gx; unsigned gd_ = 0u;
#pragma unroll
    for (int i = 0; i < 2; ++i) { const int pid = tid + i * 512; const int s = pid >> 4, x0 = (pid & 15) * 8; const size_t toks = (size_t)step_tok(b, dir, c * 64 + s);
        gb[i] = *(const u32x4*)(XBb + toks * 1024 + 512 + grp * 128 + x0);
        gcc[i] = *(const u32x4*)(XBb + toks * 1024 + 768 + grp * 128 + x0);
        const int p = pid >> 4;
        gs[i] = *(const u32x4*)(SSTb + ((size_t)(chain * 68 + c) * 64 + p) * 128 + x0); }
    {   const int p = tid >> 3, o = tid & 7;
        gx = *(const u32x4*)(XTg + ((size_t)tokblock_of(b, dir, c) * 512 + h * 64 + p) * 64 + (dir ? 7 - o : o) * 8); }
    if (w == 0) gd_ = Pm[(size_t)step_tok(b, dir, c * 64 + lane) * LDP + SSD_OFF + 1536 + dir * 8 + h];
#pragma unroll
    for (int i = 0; i < 2; ++i) { const int pid = tid + i * 512; const int s = pid >> 4, x0 = (pid & 15) * 8;
        *(u32x4*)(Bs + s * 136 + x0) = gb[i]; *(u32x4*)(Cs + s * 136 + x0) = gcc[i]; *(u32x4*)(Sin + s * 136 + x0) = gs[i]; }
    {   const int p = tid >> 3, o = tid & 7; *(u32x4*)(XT + p * 72 + o * 8) = dir ? rev8h(gx) : gx; }
    if (w == 0) {
        const float xv = __uint_as_float(gd_ << 16) + dtb; const float dtv = xv > 20.f ? xv : log1pf(expf(xv));
        sc[lane] = wave_scan_incl(dtv * Aa, lane); sc[64 + lane] = dtv; }
    __syncthreads();
    {   const int lt = w >> 1;
        f32x4 aG[2] = {(f32x4){0.f, 0.f, 0.f, 0.f}, (f32x4){0.f, 0.f, 0.f, 0.f}};
#pragma unroll
        for (int ks = 0; ks < 4; ++ks) { const bf16x8 af = *(const bf16x8*)(Cs + (16 * lt + (lane & 15)) * 136 + ks * 32 + (lane >> 4) * 8);
#pragma unroll
            for (int i = 0; i < 2; ++i) { const int st = (w & 1) * 2 + i; const bf16x8 bfr = *(const bf16x8*)(Bs + (16 * st + (lane & 15)) * 136 + ks * 32 + (lane >> 4) * 8);
                aG[i] = __builtin_amdgcn_mfma_f32_16x16x32_bf16(af, bfr, aG[i], 0, 0, 0); } }
#pragma unroll
        for (int i = 0; i < 2; ++i) { const int s = 16 * ((w & 1) * 2 + i) + (lane & 15); const float css = sc[s], dts = sc[64 + s];
#pragma unroll
            for (int q = 0; q < 4; ++q) { const int t = 16 * lt + (lane >> 4) * 4 + q; const float val = (s <= t) ? aG[i][q] * expf(sc[t] - css) * dts : 0.f; Gs[t * 72 + s] = f2bf(val); } }
    }
    __syncthreads();
    {   const int lt = w >> 1;
        f32x4 aY[2] = {(f32x4){0.f, 0.f, 0.f, 0.f}, (f32x4){0.f, 0.f, 0.f, 0.f}};
#pragma unroll
        for (int ks = 0; ks < 4; ++ks) { const bf16x8 af = *(const bf16x8*)(Cs + (16 * lt + (lane & 15)) * 136 + ks * 32 + (lane >> 4) * 8);
#pragma unroll
            for (int i = 0; i < 2; ++i) { const int pt = (w & 1) * 2 + i; const bf16x8 bfr = *(const bf16x8*)(Sin + (16 * pt + (lane & 15)) * 136 + ks * 32 + (lane >> 4) * 8);
                aY[i] = __builtin_amdgcn_mfma_f32_16x16x32_bf16(bfr, af, aY[i], 0, 0, 0); } }
        const int t = 16 * lt + (lane & 15);
        {   const float ec = expf(sc[t]);
#pragma unroll
            for (int i = 0; i < 2; ++i) { aY[i][0] *= ec; aY[i][1] *= ec; aY[i][2] *= ec; aY[i][3] *= ec; } }
#pragma unroll
        for (int ks = 0; ks < 2; ++ks) { const bf16x8 af = *(const bf16x8*)(Gs + (16 * lt + (lane & 15)) * 72 + ks * 32 + (lane >> 4) * 8);
#pragma unroll
            for (int i = 0; i < 2; ++i) { const int pt = (w & 1) * 2 + i; const bf16x8 bfr = *(const bf16x8*)(XT + (16 * pt + (lane & 15)) * 72 + ks * 32 + (lane >> 4) * 8);
                aY[i] = __builtin_amdgcn_mfma_f32_16x16x32_bf16(bfr, af, aY[i], 0, 0, 0); } }
        {   const size_t tokt = (size_t)step_tok(b, dir, c * 64 + t);
#pragma unroll
            for (int i = 0; i < 2; ++i) { const int p0 = 16 * ((w & 1) * 2 + i) + (lane >> 4) * 4;
                u32x2 wv; wv.x = pk2(aY[i][0], aY[i][1]); wv.y = pk2(aY[i][2], aY[i][3]);
                *(u32x2*)(Yout + tokt * BW + h * 64 + p0) = wv; } }
    }
}


#define FIDX(i) ((i) + ((i) >> 4))
#define FFT_X_BYTES 69632
__device__ constexpr float FFT_CW_RE[6][16] = {{0.f, 0.f, 0.f, 0.f, 0.f, 0.f, 0.f, 0.f, 0.f, 0.f, 0.f, 0.f, 0.f, 0.f, 0.f, 0.f}, {1.0f, 0.f, 0.f, 0.f, 0.f, 0.f, 0.f, 0.f, 0.f, 0.f, 0.f, 0.f, 0.f, 0.f, 0.f, 0.f}, {1.0f, 6.123233995736766e-17f, 0.f, 0.f, 0.f, 0.f, 0.f, 0.f, 0.f, 0.f, 0.f, 0.f, 0.f, 0.f, 0.f, 0.f}, {1.0f, 0.7071067811865476f, 6.123233995736766e-17f, -0.7071067811865475f, 0.f, 0.f, 0.f, 0.f, 0.f, 0.f, 0.f, 0.f, 0.f, 0.f, 0.f, 0.f}, {1.0f, 0.9238795325112867f, 0.7071067811865476f, 0.38268343236508984f, 6.123233995736766e-17f, -0.3826834323650897f, -0.7071067811865475f, -0.9238795325112867f, 0.f, 0.f, 0.f, 0.f, 0.f, 0.f, 0.f, 0.f}, {1.0f, 0.9807852804032304f, 0.9238795325112867f, 0.8314696123025452f, 0.7071067811865476f, 0.5555702330196023f, 0.38268343236508984f, 0.19509032201612833f, 6.123233995736766e-17f, -0.1950903220161282f, -0.3826834323650897f, -0.555570233019602f, -0.7071067811865475f, -0.8314696123025453f, -0.9238795325112867f, -0.9807852804032304f}};
__device__ constexpr float FFT_CW_IM[6][16] = {{0.f, 0.f, 0.f, 0.f, 0.f, 0.f, 0.f, 0.f, 0.f, 0.f, 0.f, 0.f, 0.f, 0.f, 0.f, 0.f}, {-0.0f, 0.f, 0.f, 0.f, 0.f, 0.f, 0.f, 0.f, 0.f, 0.f, 0.f, 0.f, 0.f, 0.f, 0.f, 0.f}, {-0.0f, -1.0f, 0.f, 0.f, 0.f, 0.f, 0.f, 0.f, 0.f, 0.f, 0.f, 0.f, 0.f, 0.f, 0.f, 0.f}, {-0.0f, -0.7071067811865475f, -1.0f, -0.7071067811865476f, 0.f, 0.f, 0.f, 0.f, 0.f, 0.f, 0.f, 0.f, 0.f, 0.f, 0.f, 0.f}, {-0.0f, -0.3826834323650898f, -0.7071067811865475f, -0.9238795325112867f, -1.0f, -0.9238795325112867f, -0.7071067811865476f, -0.3826834323650899f, 0.f, 0.f, 0.f, 0.f, 0.f, 0.f, 0.f, 0.f}, {-0.0f, -0.19509032201612825f, -0.3826834323650898f, -0.5555702330196022f, -0.7071067811865475f, -0.8314696123025452f, -0.9238795325112867f, -0.9807852804032304f, -1.0f, -0.9807852804032304f, -0.9238795325112867f, -0.8314696123025455f, -0.7071067811865476f, -0.5555702330196022f, -0.3826834323650899f, -0.1950903220161286f}};
__host__ __device__ constexpr int fft_bitrev(int k, int R) { int r = 0; for (int i = 0; i < R; ++i) if (k & (1 << i)) r |= 1 << (R - 1 - i); return r; }
template <int R, bool INV>
__device__ __forceinline__ void fft_pass(float2* __restrict__ X, const float2* __restrict__ TW, const int s0, const int gidx) {
    const int lowbits = 13 - s0 - R; const int stride = 1 << lowbits;
    const int low = gidx & (stride - 1), high = gidx >> lowbits; const int base = (high << (lowbits + R)) | low;
    const int p0 = FIDX(base);
#define FFT_SLOT(k) (lowbits >= 4 ? p0 + (k) * (stride + (stride >> 4)) : p0 + (k) + ((k) >> 4))
    float2 v[1 << R];
#pragma unroll
    for (int k = 0; k < (1 << R); ++k) v[k] = X[FFT_SLOT(k)];
    const int lw = low << s0;
    if (!INV) {
#pragma unroll
        for (int j = 0; j < R; ++j) { const int hk = 1 << (R - 1 - j);
#pragma unroll
            for (int k = 0; k < (1 << R); ++k) if (!(k & hk)) { const int kk = k & (hk - 1);
                const float2 a = v[k], b = v[k + hk]; v[k] = make_float2(a.x + b.x, a.y + b.y); const float dx = a.x - b.x, dy = a.y - b.y;
                if (kk == 0) v[k + hk] = make_float2(dx, dy);
                else if (2 * kk == hk) v[k + hk] = make_float2(dy, -dx);
                else { const float cr = FFT_CW_RE[R - j][kk], ci = FFT_CW_IM[R - j][kk]; v[k + hk] = make_float2(dx * cr - dy * ci, dx * ci + dy * cr); } } }
        if (lowbits > 0) {
#pragma unroll
            for (int k = 1; k < (1 << R); ++k) { const float2 w = TW[(lw * fft_bitrev(k, R)) & 8191]; const float2 a = v[k]; v[k] = make_float2(a.x * w.x - a.y * w.y, a.x * w.y + a.y * w.x); } }
    } else {
        if (lowbits > 0) {
#pragma unroll
            for (int k = 1; k < (1 << R); ++k) { const float2 w = TW[(lw * fft_bitrev(k, R)) & 8191]; const float2 a = v[k]; v[k] = make_float2(a.x * w.x + a.y * w.y, a.y * w.x - a.x * w.y); } }
#pragma unroll
        for (int j = R - 1; j >= 0; --j) { const int hk = 1 << (R - 1 - j);
#pragma unroll
            for (int k = 0; k < (1 << R); ++k) if (!(k & hk)) { const int kk = k & (hk - 1);
                const float2 a = v[k], b = v[k + hk]; float tx, ty;
                if (kk == 0) { tx = b.x; ty = b.y; }
                else if (2 * kk == hk) { tx = -b.y; ty = b.x; }
                else { const float cr = FFT_CW_RE[R - j][kk], ci = FFT_CW_IM[R - j][kk]; tx = b.x * cr + b.y * ci; ty = b.y * cr - b.x * ci; }
                v[k] = make_float2(a.x + tx, a.y + ty); v[k + hk] = make_float2(a.x - tx, a.y - ty); } }
    }
#pragma unroll
    for (int k = 0; k < (1 << R); ++k) X[FFT_SLOT(k)] = v[k];
#undef FFT_SLOT
}
__device__ __forceinline__ void fft_fwd(float2* X, const float2* TW, const int tid) {
    fft_pass<4, false>(X, TW, 0, tid); __syncthreads(); fft_pass<4, false>(X, TW, 4, tid); __syncthreads(); if (tid < 256) fft_pass<5, false>(X, TW, 8, tid); __syncthreads(); }
__device__ __forceinline__ void fft_inv(float2* X, const float2* TW, const int tid) {
    if (tid < 256) fft_pass<5, true>(X, TW, 8, tid); __syncthreads(); fft_pass<4, true>(X, TW, 4, tid); __syncthreads(); fft_pass<4, true>(X, TW, 0, tid); __syncthreads(); }
__device__ __forceinline__ void fft_twiddles(float2* TW, const int tid) {
#pragma unroll
    for (int k = 0; k < 16; ++k) { const int m = tid + k * 512; const float xx = (float)m * (1.0f / 4096.0f); TW[m] = make_float2(cospif(xx), -sinpif(xx)); }
}
__device__ __forceinline__ void hyena_spec_item(const int pr, const float* __restrict__ HR, const float* __restrict__ nrm, float2* __restrict__ HSPEC, unsigned char* shm, const int tid) {
    float2* X = (float2*)shm; const float2* TW = (const float2*)(shm + FFT_X_BYTES);
    const int o = pr >> 8, c = (pr & 255) * 2, oc = o * 512 + c; const float inva = 1.0f / nrm[oc], invb = 1.0f / nrm[oc + 1];
    __syncthreads();
    float2 hv[16];
#pragma unroll
    for (int k = 0; k < 16; ++k) { const int j = tid + k * 512;
        const unsigned off = j < SEQ ? (unsigned)j * 2048u + o * 1024 + c : j == SEQ ? (unsigned)(o * 1024 + c) : (unsigned)(2 * SEQ - j) * 2048u + o * 1024 + 512 + c;
        hv[k] = *(const float2*)(HR + off); }
#pragma unroll
    for (int k = 0; k < 16; ++k) { const int j = tid + k * 512; X[FIDX(j)] = j == SEQ ? make_float2(0.f, 0.f) : make_float2(hv[k].x * inva, hv[k].y * invb); }
    __syncthreads();
    fft_fwd(X, TW, tid);
    float4* outa = (float4*)(HSPEC + (size_t)oc * 8192 + tid * 16); float4* outb = (float4*)(HSPEC + (size_t)(oc + 1) * 8192 + tid * 16); const float2* xs = X + 17 * tid;
    const float sc_ = 0.5f / 8192.0f;
#pragma unroll
    for (int k = 0; k < 8; ++k) { float2 ha[2], hb[2];
#pragma unroll
        for (int q = 0; q < 2; ++q) { const int p = 16 * tid + 2 * k + q; const int kf = (int)(__builtin_bitreverse32((unsigned)p) >> 19); const int p2 = (int)(__builtin_bitreverse32((unsigned)((8192 - kf) & 8191)) >> 19);
            const float2 xp = xs[2 * k + q], xq = X[FIDX(p2)];
            ha[q] = make_float2((xp.x + xq.x) * sc_, (xp.y - xq.y) * sc_);
            hb[q] = make_float2((xp.y + xq.y) * sc_, (xq.x - xp.x) * sc_); }
        outa[k] = make_float4(ha[0].x, ha[0].y, ha[1].x, ha[1].y); outb[k] = make_float4(hb[0].x, hb[0].y, hb[1].x, hb[1].y); }
}
__device__ __forceinline__ void fft_mul_spec(float2* X, const float2* __restrict__ H, const int tid) {
    const float4* h4 = (const float4*)(H + tid * 16); float2* xs = X + 17 * tid;
#pragma unroll
    for (int k = 0; k < 8; ++k) { const float4 hv = h4[k]; const float2 x0 = xs[2 * k], x1 = xs[2 * k + 1];
        xs[2 * k] = make_float2(x0.x * hv.x - x0.y * hv.y, x0.x * hv.y + x0.y * hv.x); xs[2 * k + 1] = make_float2(x1.x * hv.z - x1.y * hv.w, x1.x * hv.w + x1.y * hv.z); }
}
__device__ __forceinline__ void hyena_fft_item(const int item, const bf16_t* __restrict__ UT, const float2* __restrict__ HSPEC, const float* __restrict__ bias, float* __restrict__ YT, unsigned char* shm, const int tid) {
    float2* X = (float2*)shm; const float2* TW = (const float2*)(shm + FFT_X_BYTES);
    const int c = item >> 1, b0 = (item & 1) * 2, b1 = b0 + 1;
    const bf16_t* u0 = UT + (size_t)(b0 * 1536 + c) * SEQ + tid * 8; const bf16_t* u1 = UT + (size_t)(b1 * 1536 + c) * SEQ + tid * 8;
    const float bias0 = bias[c], bias1 = bias[512 + c];
    float2* xs = X + FIDX(8 * tid);
    float vr[8], vi[8];
    __syncthreads();
    { const u32x4 a0 = *(const u32x4*)u0, c0 = *(const u32x4*)u1; unpack8(a0, vr); unpack8(c0, vi); }
#pragma unroll
    for (int k = 0; k < 8; ++k) { xs[k] = make_float2(vr[k], vi[k]); xs[4352 + k] = make_float2(0.f, 0.f); }
    __syncthreads();
    fft_fwd(X, TW, tid);
    fft_mul_spec(X, HSPEC + (size_t)c * 8192, tid);
    __syncthreads();
    fft_inv(X, TW, tid);
    { const bf16_t* p0 = u0 + (size_t)512 * SEQ; const bf16_t* p1 = u1 + (size_t)512 * SEQ;
      float xr[8], xi[8]; { const u32x4 a0 = *(const u32x4*)p0, c0 = *(const u32x4*)p1; unpack8(a0, xr); unpack8(c0, xi); }
#pragma unroll
      for (int k = 0; k < 8; ++k) { const float2 cv = xs[k]; const float zr = xr[k] * (cv.x + bias0 * vr[k]), zi = xi[k] * (cv.y + bias0 * vi[k]);
          vr[k] = zr; vi[k] = zi; xs[k] = make_float2(zr, zi); xs[4352 + k] = make_float2(0.f, 0.f); } }
    __syncthreads();
    fft_fwd(X, TW, tid);
    fft_mul_spec(X, HSPEC + (size_t)(512 + c) * 8192, tid);
    __syncthreads();
    fft_inv(X, TW, tid);
    { const bf16_t* p0 = u0 + (size_t)1024 * SEQ; const bf16_t* p1 = u1 + (size_t)1024 * SEQ;
      float xr[8], xi[8]; { const u32x4 a0 = *(const u32x4*)p0, c0 = *(const u32x4*)p1; unpack8(a0, xr); unpack8(c0, xi); }
      float yr[8], yi[8];
#pragma unroll
      for (int k = 0; k < 8; ++k) { const float2 cv = xs[k]; yr[k] = xr[k] * (cv.x + bias1 * vr[k]); yi[k] = xi[k] * (cv.y + bias1 * vi[k]); }
      float* y0 = YT + (size_t)(b0 * 512 + c) * SEQ + tid * 8; float* y1 = YT + (size_t)(b1 * 512 + c) * SEQ + tid * 8;
      *(float4*)y0 = make_float4(yr[0], yr[1], yr[2], yr[3]); *(float4*)(y0 + 4) = make_float4(yr[4], yr[5], yr[6], yr[7]);
      *(float4*)y1 = make_float4(yi[0], yi[1], yi[2], yi[3]); *(float4*)(y1 + 4) = make_float4(yi[4], yi[5], yi[6], yi[7]); }
}

constexpr size_t al256(size_t x) { return (x + 255) & ~(size_t)255; }
constexpr size_t O_BAR = 0;
constexpr size_t O_MOD = 16384;
constexpr size_t O_NORM = O_MOD + al256((size_t)2 * 5 * 6 * DM * 4);
constexpr size_t O_QCTR = O_NORM + al256((size_t)2 * 2 * 1024 * 4);
constexpr size_t O_ZERO_END = O_QCTR + 512;
constexpr size_t O_XS = O_ZERO_END;
constexpr size_t O_HB = O_XS + al256((size_t)NTOK * DM * 4);
constexpr size_t O_P = O_HB + al256((size_t)NTOK * DM * 2);
constexpr size_t O_WIN = O_P + al256((size_t)NTOK * LDP * 2);
constexpr size_t O_WBR = O_WIN + al256((size_t)LDP * DM * 2);
constexpr size_t O_WOUT = O_WBR + al256((size_t)4 * DM * BW * 2);
constexpr size_t O_WGU = O_WOUT + al256((size_t)DM * DM * 2);
constexpr size_t O_WD = O_WGU + al256((size_t)NEXP * 2 * DEXP * DM * 2);
constexpr size_t O_GLU = O_WD + al256((size_t)NEXP * DM * DEXP * 2);
constexpr size_t O_Y4 = O_GLU + al256((size_t)BW * BW * 2);
constexpr size_t O_U = O_Y4 + al256((size_t)NTOK * DM * 2);
constexpr size_t O_QKB = O_U + al256((size_t)NTOK * 1536 * 4);
constexpr size_t O_CST = O_QKB + al256((size_t)NTOK * 1024 * 2);
constexpr size_t O_NST = O_CST + al256((size_t)32 * 68 * 128 * 128 * 2);
constexpr size_t O_MST = O_NST + al256((size_t)32 * 68 * 128 * 4);
constexpr size_t O_XBC = O_MST + al256((size_t)32 * 68 * 4);
constexpr size_t O_SST = O_XBC + al256((size_t)NTOK * 1024 * 2);
constexpr size_t O_HF = O_SST + al256((size_t)64 * 68 * 64 * 128 * 2);
constexpr size_t O_YF = O_HF + al256((size_t)2 * NTOK * BW * 4);
constexpr size_t O_SF = O_YF + al256((size_t)2 * NTOK * BW * 4);
constexpr size_t O_LDT = O_SF + al256((size_t)2 * NCTX * BW * 4);
constexpr size_t O_AP = O_LDT + al256((size_t)4096 * 16);
constexpr size_t O_BBT = O_AP + al256((size_t)4096 * 33 * 8);
constexpr size_t O_KT = O_BBT + al256((size_t)4096 * 16 * 8);
constexpr size_t O_S5A = O_KT + al256((size_t)32 * 2 * 32 * 256 * 4);
constexpr size_t O_S5B = O_S5A + al256((size_t)32 * 512 * 768 * 2);
constexpr size_t O_XCTX = O_S5B + al256((size_t)32 * 512 * 768 * 2);
constexpr size_t O_Z = O_XCTX + al256((size_t)4 * 32 * 2 * 64 * 8);
constexpr size_t O_HRAW = O_Z + al256((size_t)NTOK * BW * 4);
constexpr size_t O_HSPEC = O_HRAW + al256((size_t)(SEQ + CTXL) * 2048 * 4);
constexpr size_t O_K2C = O_HSPEC + al256((size_t)1024 * 8192 * 8);
constexpr size_t O_GG = O_K2C + al256((size_t)(2 * CTXL) * 1024 * 4);
constexpr size_t O_PROBS = O_GG + al256((size_t)NTOK * BW * 2);
constexpr size_t O_ROWTOK = O_PROBS + al256((size_t)NTOK * 16 * 4);
constexpr size_t O_ROWGATE = O_ROWTOK + al256((size_t)NEXP * MOE_PAD * 4);
constexpr size_t O_INV = O_ROWGATE + al256((size_t)NEXP * MOE_PAD * 4);
constexpr size_t O_NORMP = O_INV + al256((size_t)NTOK * 16 * 4);
constexpr size_t WS_END = O_NORMP + al256((size_t)4 * 256 * 2048 * 4);
constexpr size_t O_XG = O_P;
constexpr size_t O_HID = O_P + al256((size_t)NEXP * MOE_PAD * DM * 2);
constexpr size_t O_YEXP = O_HID + al256((size_t)NEXP * MOE_PAD * DEXP * 2);
static_assert(O_YEXP + (size_t)NEXP * MOE_PAD * DM * 2 <= O_WIN, "MoE temporaries must fit inside P");
static_assert((size_t)NTOK * DM * 2 <= (size_t)NTOK * 1536 * 4, "ACCb must fit inside U");
static_assert((size_t)26214400 + (size_t)2 * 17825792 + (size_t)272 * 256 * 64 * 2 <= (size_t)NTOK * DM * 2, "strip buffers must fit inside HB");
static_assert(WS_END <= (size_t)1851000000, "workspace map exceeds the guaranteed size");

struct Args {
    const float* in[47];
    float* out; unsigned char* ws;
    int ph_lo, ph_hi;
};

__device__ __forceinline__ void conv_tile(const float* __restrict__ src, int ldsrc, int nvalid, int k0, int n0, bf16_t* __restrict__ dst, int lddst, int mode, float* T, int tid) {
    { const int n = tid & 63, kr = tid >> 6;
#pragma unroll
      for (int i = 0; i < 8; ++i) { const int k = i * 8 + kr; T[k * 65 + n] = (n0 + n < nvalid) ? src[(size_t)(k0 + k) * ldsrc + n0 + n] : 0.f; } }
    __syncthreads();
    { const int n = tid >> 3, kc = (tid & 7) * 8; const int gn = n0 + n;
      const int drow = mode == 0 ? gn : (32 * (gn >> 4) + (mode == 2 ? 16 : 0) + (gn & 15));
      u32x4 w; w.x = pk2(T[(kc + 0) * 65 + n], T[(kc + 1) * 65 + n]); w.y = pk2(T[(kc + 2) * 65 + n], T[(kc + 3) * 65 + n]);
      w.z = pk2(T[(kc + 4) * 65 + n], T[(kc + 5) * 65 + n]); w.w = pk2(T[(kc + 6) * 65 + n], T[(kc + 7) * 65 + n]);
      *(u32x4*)(dst + (size_t)drow * lddst + k0 + kc) = w; }
    __syncthreads();
}

#define IN(id) (lo <= (id) && (id) < hi)
#define SEAM(id) do { if (hi > (id) + 1) xcd_barrier(bar); } while (0)
#define PH_BEGIN int tid = threadIdx.x; asm volatile("" : "+v"(tid) :: "memory"); const int lane = tid & 63, wave = tid >> 6; (void)lane; (void)wave;

#define x_in (PT(0))
#define c_in (PT(1))
#define ctx_in (PT(2))
#define cctx_in (PT(3))
#define ada_w (PT(4))
#define ada_b (PT(5))
#define norm_mix (PT(6))
#define norm_ffn (PT(7))
#define w_in (PT(8))
#define XS ((float*)(a.ws + O_XS))
#define MOD ((float*)(a.ws + O_MOD))
#define NORM ((float*)(a.ws + O_NORM))
#define NORMP ((float*)(a.ws + O_NORMP))
#define MODl (MOD + (size_t)l * 5 * 6 * DM)
#define HB ((bf16_t*)(a.ws + O_HB))
#define P ((bf16_t*)(a.ws + O_P))
#define WIN ((bf16_t*)(a.ws + O_WIN))
#define WBR ((bf16_t*)(a.ws + O_WBR))
#define WOUT ((bf16_t*)(a.ws + O_WOUT))
#define WGU ((bf16_t*)(a.ws + O_WGU))
#define WD ((bf16_t*)(a.ws + O_WD))
#define GLU ((bf16_t*)(a.ws + O_GLU))
#define Y4 ((bf16_t*)(a.ws + O_Y4))
#define U ((float*)(a.ws + O_U))
#define ACCb ((bf16_t*)(a.ws + O_U))
#define QKB ((bf16_t*)(a.ws + O_QKB))
#define CST ((bf16_t*)(a.ws + O_CST))
#define NST ((float*)(a.ws + O_NST))
#define MST ((float*)(a.ws + O_MST))
#define XBC ((bf16_t*)(a.ws + O_XBC))
#define SSTB ((bf16_t*)(a.ws + O_SST))
#define HF ((bf16_t*)(a.ws + O_HF))
#define HBk (HF + (size_t)NTOK * BW)
#define YF ((bf16_t*)(a.ws + O_YF))
#define YB (YF + (size_t)NTOK * BW)
#define SF ((float*)(a.ws + O_SF))
#define SB (SF + (size_t)NCTX * BW)
#define LDT ((double2*)(a.ws + O_LDT))
#define APW ((float2*)(a.ws + O_AP))
#define BBT ((float2*)(a.ws + O_BBT))
#define KTB ((float*)(a.ws + O_KT))
#define S5A ((bf16_t*)(a.ws + O_S5A))
#define S5B ((bf16_t*)(a.ws + O_S5B))
#define XCTX ((float2*)(a.ws + O_XCTX))
#define S5P ((bf16_t*)(a.ws + O_HB))
#define XLOC ((float*)(a.ws + O_HB + (size_t)32 * 256 * 512 * 2))
#define KTG ((bf16_t*)(a.ws + O_HB + (size_t)26214400))
#define VTG ((bf16_t*)(a.ws + O_HB + (size_t)26214400 + (size_t)17825792))
#define BTG ((bf16_t*)(a.ws + O_HB + (size_t)26214400 + (size_t)2 * 17825792))
#define XTG ((bf16_t*)(a.ws + O_GG))
#define Z ((float*)(a.ws + O_Z))
#define HRAW ((float*)(a.ws + O_HRAW))
#define HSPEC ((float2*)(a.ws + O_HSPEC))
#define UT ((bf16_t*)(a.ws + O_U))
#define YT ((float*)(a.ws + O_Z))
#define QCTR ((int*)(a.ws + O_QCTR))
#define K2C ((float*)(a.ws + O_K2C))
#define GG ((bf16_t*)(a.ws + O_GG))
#define PROBS ((float*)(a.ws + O_PROBS))
#define ROWTOK ((int*)(a.ws + O_ROWTOK))
#define ROWGATE ((float*)(a.ws + O_ROWGATE))
#define XG ((bf16_t*)(a.ws + O_XG))
#define HID ((bf16_t*)(a.ws + O_HID))
#define YEXP ((bf16_t*)(a.ws + O_YEXP))
#define INV ((int*)(a.ws + O_INV))


__device__ __forceinline__ void moe_pair(float4 (&a)[8], const int r1, const int r2, const float g2scale, const int lane, const float* __restrict__ rowgate, const bf16_t* __restrict__ yexp) {
    const float gt1 = rowgate[r1], gt2 = rowgate[r2] * g2scale;
    const bf16_t* y1 = yexp + (size_t)r1 * DM + lane * 4; const bf16_t* y2 = yexp + (size_t)r2 * DM + lane * 4;
    u32x2 w1[8], w2[8];
#pragma unroll
    for (int i = 0; i < 8; ++i) { w1[i] = *(const u32x2*)(y1 + i * 256); w2[i] = *(const u32x2*)(y2 + i * 256); }
#pragma unroll
    for (int i = 0; i < 8; ++i) {
        a[i].x += gt1 * __uint_as_float(w1[i].x << 16); a[i].y += gt1 * __uint_as_float(w1[i].x & 0xFFFF0000u); a[i].z += gt1 * __uint_as_float(w1[i].y << 16); a[i].w += gt1 * __uint_as_float(w1[i].y & 0xFFFF0000u);
        a[i].x += gt2 * __uint_as_float(w2[i].x << 16); a[i].y += gt2 * __uint_as_float(w2[i].x & 0xFFFF0000u); a[i].z += gt2 * __uint_as_float(w2[i].y << 16); a[i].w += gt2 * __uint_as_float(w2[i].y & 0xFFFF0000u); }
}
__device__ __forceinline__ void moe_combine(float4 (&v)[8], const int tok, const int lane, const int* __restrict__ inv, const float* __restrict__ rowgate, const bf16_t* __restrict__ yexp, const float* __restrict__ m5) {
    float4 a[8], mm[8];
#pragma unroll
    for (int i = 0; i < 8; ++i) { a[i] = make_float4(0.f, 0.f, 0.f, 0.f); mm[i] = *(const float4*)(m5 + i * 256 + lane * 4); }
    const int4* ip = (const int4*)(inv + (size_t)tok * 16);
    const int4 q0 = ip[0], q1 = ip[1], q2 = ip[2], q3 = ip[3];
    const int rows[16] = {q0.x, q0.y, q0.z, q0.w, q1.x, q1.y, q1.z, q1.w, q2.x, q2.y, q2.z, q2.w, q3.x, q3.y, q3.z, q3.w};
    int prow = -1;
#pragma unroll
    for (int e = 0; e < 16; ++e) { const int row = __builtin_amdgcn_readfirstlane(rows[e]);
        if (row >= 0) { if (prow >= 0) { moe_pair(a, prow, row, 1.0f, lane, rowgate, yexp); prow = -1; } else prow = row; } }
    if (prow >= 0) moe_pair(a, prow, prow, 0.0f, lane, rowgate, yexp);
#pragma unroll
    for (int i = 0; i < 8; ++i) { v[i].x += mm[i].x * a[i].x; v[i].y += mm[i].y * a[i].y; v[i].z += mm[i].z * a[i].z; v[i].w += mm[i].w * a[i].w; }
}
struct CvU { const float* src; bf16_t* dst; int ldsrc, nvalid, k0, n0, lddst, mode; };
__device__ __forceinline__ void cv_load(const CvU& u, float4 (&r)[8], const int tid) {
#pragma unroll
    for (int i = 0; i < 8; ++i) { const int idx = tid + i * 512; const int k = idx >> 6, n = u.n0 + (idx & 63) * 4;
        r[i] = (n < u.nvalid) ? *(const float4*)(u.src + (size_t)(u.k0 + k) * u.ldsrc + n) : make_float4(0.f, 0.f, 0.f, 0.f); }
}
__device__ __forceinline__ void cv_stage(float* T, const float4 (&r)[8], const int tid) {
#pragma unroll
    for (int i = 0; i < 8; ++i) { const int idx = tid + i * 512; float* p = T + (idx >> 6) * 257 + (idx & 63) * 4; p[0] = r[i].x; p[1] = r[i].y; p[2] = r[i].z; p[3] = r[i].w; }
}
__device__ __forceinline__ void cv_store(const CvU& u, const float* T, const int tid) {
#pragma unroll
    for (int j = 0; j < 4; ++j) { const int o = tid + j * 512; const int kc = (o & 7) * 8, n = o >> 3; const int gn = u.n0 + n;
        const int drow = u.mode == 0 ? gn : (256 * (gn >> 7) + (u.mode == 2 ? 128 : 0) + (gn & 127));
        const float* t = T + kc * 257 + n;
        u32x4 w; w.x = pk2(t[0], t[257]); w.y = pk2(t[2 * 257], t[3 * 257]); w.z = pk2(t[4 * 257], t[5 * 257]); w.w = pk2(t[6 * 257], t[7 * 257]);
        *(u32x4*)(u.dst + (size_t)drow * u.lddst + u.k0 + kc) = w; }
}
#define CV_RUN(LL, QSTART, QSTEP, QEND) do { \
                const float* wbr = PT(40) + (size_t)(LL) * 4 * BW * DM; const float* wout = PT(41) + (size_t)(LL) * DM * DM; \
                const float* wg = PT(43) + (size_t)(LL) * NEXP * DM * DEXP; const float* wu = PT(44) + (size_t)(LL) * NEXP * DM * DEXP; const float* wd = PT(45) + (size_t)(LL) * NEXP * DEXP * DM; \
                const float* wglu = PT(32) + (size_t)(LL) * BW * BW; const float* win = w_in + (size_t)(LL) * DM * IN_W; \
                const int cv_step = (QSTEP), cv_end = (QEND); \
                __syncthreads(); \
                int q = (QSTART); int buf = 0; CvU u; float4 r[8]; \
                if (q < cv_end) { CV_DECODE(q, u); cv_load(u, r, tid); } \
                while (q < cv_end) { \
                    float* T = sf + buf * (64 * 257); \
                    cv_stage(T, r, tid); \
                    __syncthreads(); \
                    const CvU cur = u; const int qn = q + cv_step; \
                    if (qn < cv_end) { CV_DECODE(qn, u); cv_load(u, r, tid); } \
                    cv_store(cur, T, tid); \
                    buf ^= 1; q = qn; \
                } \
                __syncthreads(); } while (0)
#define CV_DECODE(q_, u_) do { int qq_ = (q_); \
                    if (qq_ < n_win) { u_ = CvU{win, WIN, IN_W, IN_W, (qq_ / 55) * 64, (qq_ % 55) * 256, DM, 0}; } else { qq_ -= n_win; \
                    if (qq_ < n_br) { const int k = qq_ >> 6, r = qq_ & 63; u_ = CvU{wbr + (size_t)k * BW * DM, WBR + (size_t)k * DM * BW, DM, DM, (r >> 3) * 64, (r & 7) * 256, BW, 0}; } else { qq_ -= n_br; \
                    if (qq_ < n_out) { u_ = CvU{wout, WOUT, DM, DM, (qq_ >> 3) * 64, (qq_ & 7) * 256, DM, 0}; } else { qq_ -= n_out; \
                    if (qq_ < n_glu) { u_ = CvU{wglu, GLU, BW, BW, (qq_ >> 1) * 64, (qq_ & 1) * 256, BW, 0}; } else { qq_ -= n_glu; \
                    if (qq_ < n_gu) { const int e = qq_ / 384, r = qq_ % 384, up = r / 192, r2 = r % 192; u_ = CvU{(up ? wu : wg) + (size_t)e * DM * DEXP, WGU + (size_t)e * 2 * DEXP * DM, DEXP, DEXP, (r2 / 6) * 64, (r2 % 6) * 256, DM, 1 + up}; } else { qq_ -= n_gu; \
                    { const int e = qq_ / 192, r = qq_ % 192; u_ = CvU{wd + (size_t)e * DEXP * DM, WD + (size_t)e * DM * DEXP, DM, DM, (r >> 3) * 64, (r & 7) * 256, DEXP, 0}; } } } } } } } while (0)
template <int LAYER>
__device__ __forceinline__ void layer_body(const Args& a, const XcdBarrier& bar, const int lo, const int hi, const int bid, const int G, unsigned char* const shm, float* const sf, const float** const ptab) {
        constexpr int l = LAYER;
        constexpr int PB = 1 + 16 * l;
        const bool lastl = (l == 1);

        const int nPanels = lastl ? 64 : 68;
        const int M2 = nPanels * 256;

        if (IN(PB + 0)) for (int rep_ = 0; rep_ < (l == 0 ? PROBE_REPS(0) : 1); ++rep_) {
            PH_BEGIN
            {   const int n_win = 32 * 55, n_br = 4 * 64, n_out = 32 * 8, n_glu = 16, n_gu = 16 * 2 * 192, n_d = 16 * 192;
                const int n_grp1 = n_win + n_br + n_out + n_glu, total = n_grp1 + n_gu + n_d;
                const int q_lo = (l > 0 && G > 128) ? n_win : 0;
                CV_RUN(l, q_lo + bid, G, total);
            }
            for (int set = 0; set < (lastl ? 1 : 2); ++set) {
                const int L = set ? CTXL : SEQ; float* HR = HRAW + (set ? (size_t)SEQ * 2048 : 0);
                const float* w1 = PT(11) + l * 33 * 64; const float* b1 = PT(12) + l * 64; const float* fr1 = PT(13) + l * 64; const float* w2 = PT(14) + l * 64 * 64; const float* b2 = PT(15) + l * 64;
                const float* fr2 = PT(16) + l * 64; const float* w3 = PT(17) + l * 64 * 2048; const float* decay = PT(18) + l * 2048;
                float* feats = sf; float* h1 = sf + 16 * 33; float* h2 = h1 + 16 * 64;
                float nacc[4] = {0.f, 0.f, 0.f, 0.f};
                for (int base = bid; base < L; base += 16 * G) {
                    __syncthreads();
                    for (int e = tid; e < 16 * 33; e += NTHR) { const int ti = e / 33, fi = e % 33; int t = base + ti * G; if (t > L - 1) t = L - 1;
                        float v;
                        if (fi == 0) v = (float)t / (float)(L - 1);
                        else { const int j = (fi - 1) & 15; const double fr = 1e-4 + (double)j * ((15.0 - 1e-4) / 15.0); const double ang = (2.0 * 3.14159265358979323846 / (double)L) * (double)t * fr; v = fi <= 16 ? (float)cos(ang) : (float)(-sin(ang)); }
                        feats[e] = v; }
                    __syncthreads();
                    { const int j = tid & 63, ti = tid >> 6; float s0 = b1[j], s1 = s0;
_Pragma("unroll 3")
                      for (int i = 0; i < 33; ++i) { const float wv = w1[i * 64 + j]; s0 += feats[ti * 33 + i] * wv; s1 += feats[(ti + 8) * 33 + i] * wv; }
                      const float f1 = fr1[j]; h1[ti * 64 + j] = sinf(f1 * s0); h1[(ti + 8) * 64 + j] = sinf(f1 * s1); }
                    __syncthreads();
                    { const int j = tid & 63, ti = tid >> 6; float s0 = b2[j], s1 = s0;
_Pragma("unroll 4")
                      for (int i = 0; i < 64; ++i) { const float wv = w2[i * 64 + j]; s0 += h1[ti * 64 + i] * wv; s1 += h1[(ti + 8) * 64 + i] * wv; }
                      const float f2 = fr2[j]; h2[ti * 64 + j] = sinf(f2 * s0); h2[(ti + 8) * 64 + j] = sinf(f2 * s1); }
                    __syncthreads();
                    float acc[16][4];
#pragma unroll
                    for (int ti = 0; ti < 16; ++ti) { acc[ti][0] = 0.f; acc[ti][1] = 0.f; acc[ti][2] = 0.f; acc[ti][3] = 0.f; }
#pragma unroll 2
                    for (int i = 0; i < 64; ++i) { const float* wrow = w3 + (size_t)i * 2048 + tid; const float wa = wrow[0], wb = wrow[512], wc2 = wrow[1024], wd2 = wrow[1536];
#pragma unroll
                        for (int ti = 0; ti < 16; ++ti) { const float hv = h2[ti * 64 + i]; acc[ti][0] += hv * wa; acc[ti][1] += hv * wb; acc[ti][2] += hv * wc2; acc[ti][3] += hv * wd2; } }
                    float dk[4];
#pragma unroll
                    for (int k = 0; k < 4; ++k) dk[k] = fabsf(decay[tid + k * 512]);
#pragma unroll
                    for (int ti = 0; ti < 16; ++ti) { const int t = base + ti * G; if (t < L) { const float tn = (float)t / (float)(L - 1);
#pragma unroll
                        for (int k = 0; k < 4; ++k) { const float v = acc[ti][k] * expf(-tn * dk[k]); HR[(size_t)t * 2048 + tid + k * 512] = v; nacc[k] += fabsf(v); } } }
                }
                float* nrp = NORMP + ((size_t)(l * 2 + set) * 256 + bid) * 2048;
#pragma unroll
                for (int k = 0; k < 4; ++k) nrp[tid + k * 512] = nacc[k];
            }
            for (int idx = bid * NTHR + tid; idx < 4096; idx += G * NTHR) { const int n = idx & 63, g = (idx >> 6) & 31, dir = idx >> 11;
                const double are = (double)(PT(24) + l * 4096)[idx], aim = (double)(PT(25) + l * 4096)[idx]; const double lam = are < -1e-4 ? are : -1e-4; const double dt = exp((double)(PT(26) + l * 64)[dir * 32 + g]);
                const double ldre = lam * dt, ldim = aim * dt; LDT[idx] = make_double2(ldre, ldim);
                const double mag = exp(ldre); const double ar = mag * cos(ldim), ai = mag * sin(ldim);
                const double den = lam * lam + aim * aim; const double nr = ar - 1.0, ni = ai; const double fre = (nr * lam + ni * aim) / den, fim = (ni * lam - nr * aim) / den;
                const float* b_re = PT(27) + l * 32 * 64 * 16; const float* b_im = PT(28) + l * 32 * 64 * 16;
#pragma unroll 4
                for (int c = 0; c < 16; ++c) { const double br = (double)b_re[(g * 64 + n) * 16 + c], bi = (double)b_im[(g * 64 + n) * 16 + c]; BBT[idx * 16 + c] = make_float2((float)(fre * br - fim * bi), (float)(fre * bi + fim * br)); }
            }
            for (int e2 = bid * NTHR + tid; e2 < 4096 * 33; e2 += G * NTHR) { const int idx = e2 / 33, k = e2 - idx * 33; const int g = (idx >> 6) & 31, dir = idx >> 11;
                const double are = (double)(PT(24) + l * 4096)[idx], aim = (double)(PT(25) + l * 4096)[idx]; const double lam = are < -1e-4 ? are : -1e-4; const double dt = exp((double)(PT(26) + l * 64)[dir * 32 + g]);
                const double ldre = lam * dt, ldim = aim * dt; const double mk = exp(ldre * k); APW[e2] = make_float2((float)(mk * cos(ldim * k)), (float)(mk * sin(ldim * k))); }
            if (l == 0 && lo == 0) xcd_barrier(bar);
            for (int tok = bid * 8 + wave; tok < NTOK; tok += G * 8) {
                const int r = tok < NLAT ? tok / SEQ : 4; const float* xr = l == 0 ? (tok < NLAT ? x_in + (size_t)tok * DM : ctx_in + (size_t)(tok - NLAT) * DM) : XS + (size_t)tok * DM; const float* gn = norm_mix + l * DM;
                const float* sh = MODl + (size_t)(r * 6 + 0) * DM; const float* sc = MODl + (size_t)(r * 6 + 1) * DM;
                float4 v[8]; float ss = 0.f;
#pragma unroll
                for (int i = 0; i < 8; ++i) v[i] = *(const float4*)(xr + i * 256 + lane * 4);
                if (l > 0) {
                    moe_combine(v, tok, lane, INV, ROWGATE, YEXP, MOD + (size_t)((l - 1) * 5 + r) * 6 * DM + 5 * DM);
#pragma unroll
                    for (int i = 0; i < 8; ++i) *(float4*)(XS + (size_t)tok * DM + i * 256 + lane * 4) = v[i]; }
#pragma unroll
                for (int i = 0; i < 8; ++i) ss += v[i].x * v[i].x + v[i].y * v[i].y + v[i].z * v[i].z + v[i].w * v[i].w;
                ss = wave_sum(ss); const float rs = rsqrtf(ss * (1.0f / DM) + 1e-6f);
#pragma unroll
                for (int i = 0; i < 8; ++i) { const int d = i * 256 + lane * 4; const float4 g4 = *(const float4*)(gn + d), s4 = *(const float4*)(sc + d), h4 = *(const float4*)(sh + d);
                    v[i].x = v[i].x * rs * g4.x * (1.f + s4.x) + h4.x; v[i].y = v[i].y * rs * g4.y * (1.f + s4.y) + h4.y; v[i].z = v[i].z * rs * g4.z * (1.f + s4.z) + h4.z; v[i].w = v[i].w * rs * g4.w * (1.f + s4.w) + h4.w; }
#pragma unroll
                for (int i = 0; i < 8; ++i) { u32x2 w; w.x = pk2(v[i].x, v[i].y); w.y = pk2(v[i].z, v[i].w); *(u32x2*)(HB + (size_t)tok * DM + i * 256 + lane * 4) = w; }
            }
            SEAM(PB + 0);
        }

        if (IN(PB + 1)) for (int rep_ = 0; rep_ < PROBE_REPS(1); ++rep_) {
            PH_BEGIN
            for (int base = bid * 8; base < (lastl ? 1 : 2) * 1024; base += G * 8) {
                const int idx = base + (tid & 7), sl = tid >> 3; const int set = idx >> 10, oc = idx & 1023, o = oc >> 9, c = oc & 511;
                const float* pp = NORMP + (size_t)(l * 2 + set) * 256 * 2048 + o * 1024 + c + (size_t)(sl * 4) * 2048; float sacc = 0.f;
#pragma unroll
                for (int j = 0; j < 4; ++j) { const float p0 = pp[(size_t)j * 2048], p1 = pp[(size_t)j * 2048 + 512]; sacc += (sl * 4 + j < G) ? p0 + p1 : 0.f; }
                sf[sl * 8 + (tid & 7)] = sacc; __syncthreads();
                if (tid < 8) { float t = 0.f;
#pragma unroll 8
                    for (int q = 0; q < 64; ++q) t += sf[q * 8 + tid];
                    NORM[(size_t)(l * 2 + set) * 1024 + oc] = t; }
                __syncthreads(); }
            for (int idx = (G - 1 - bid) * NTHR + tid; idx < 32768; idx += G * NTHR) { const int c = idx & 15, lag = (idx >> 4) & 31, dir = (idx >> 9) & 1, g = idx >> 10;
                const float* c_re = PT(29) + l * 32 * 16 * 64 + (g * 16 + c) * 64; const float* c_im = PT(30) + l * 32 * 16 * 64 + (g * 16 + c) * 64;
                float acc[16];
#pragma unroll
                for (int j = 0; j < 16; ++j) acc[j] = 0.f;
#pragma unroll 2
                for (int n = 0; n < 64; ++n) { const int pi = (dir * 32 + g) * 64 + n; const float2 ap = APW[pi * 33 + lag]; const float cr = c_re[n], ci = c_im[n]; const float wr_ = cr * ap.x - ci * ap.y, wi_ = cr * ap.y + ci * ap.x;
                    const float4* bb = (const float4*)(BBT + pi * 16);
#pragma unroll
                    for (int j = 0; j < 8; ++j) { const float4 b2 = bb[j]; acc[2 * j] += wr_ * b2.x - wi_ * b2.y; acc[2 * j + 1] += wr_ * b2.z - wi_ * b2.w; } }
                float4* o = (float4*)(KTB + (size_t)idx * 16);
                o[0] = make_float4(acc[0], acc[1], acc[2], acc[3]); o[1] = make_float4(acc[4], acc[5], acc[6], acc[7]); o[2] = make_float4(acc[8], acc[9], acc[10], acc[11]); o[3] = make_float4(acc[12], acc[13], acc[14], acc[15]);
            }
            __syncthreads();
            pg8::Gemm g{HB, WIN, DM, DM, DM}; pg8::SchedStd S{68, 55, G, bid, DM, DM}; pg8::EpiWin E{P, LDP};
            pg8::gemm_phase(( LAS unsigned char*)shm, g, S, E);
#if defined(PROBE_BNOEPI)
            { __syncthreads(); pg8::EpiNone E0; pg8::gemm_phase((LAS unsigned char*)shm, g, S, E0); }
#endif
            SEAM(PB + 1);
        }

        if (IN(PB + 2)) for (int rep_ = 0; rep_ < PROBE_REPS(2); ++rep_) {
            PH_BEGIN
            const float* hcw = PT(9) + l * 3 * 1536; const float* hcb = PT(10) + l * 1536; const float* mcw = PT(20) + l * 3 * 1024; const float* mcb = PT(21) + l * 1024;
            const float* scw = PT(34) + l * 3 * 1024; const float* scb = PT(35) + l * 1024;
            for (int unit = bid; unit < 272 * 3; unit += G) { const int seg = unit / 3, kind = unit % 3; const bool lat = seg < 256; const size_t tok0 = lat ? (size_t)seg * 64 : (size_t)NLAT + (size_t)(seg - 256) * 64;
                if (kind < 2) { const int hf = kind;
                    const int c = tid * 2; const int col = (hf ? SSD_OFF + 512 : ML_OFF) + c; const float* w = hf ? scw : mcw; const float* bsp = hf ? scb : mcb; bf16_t* dst = (hf ? XBC : QKB) + tok0 * 1024 + c;
                    const float2 w0 = *(const float2*)(w + c), w1 = *(const float2*)(w + 1024 + c), w2 = *(const float2*)(w + 2048 + c), bb = *(const float2*)(bsp + c);
                    const float osc = (!hf && c >= 512) ? 0.08838834764831845f : 1.0f;
                    const bool hasPrev = !lat && ((tok0 - NLAT) & (CTXL - 1)) != 0, hasNext = !lat && (((tok0 - NLAT) + 63) & (CTXL - 1)) != CTXL - 1;
                    bf16_t* strip = nullptr;
                    if (!hf) { if (c >= 512) strip = KTG + ((size_t)seg * 512 + (c - 512)) * 64; }
                    else { if (c < 512) strip = XTG + ((size_t)seg * 512 + c) * 64; else if (c < 768) strip = BTG + ((size_t)seg * 256 + (c - 512)) * 64; }
                    const bf16_t* pp = P + tok0 * LDP + col;
                    unsigned raw[66];
#pragma unroll
                    for (int t = 0; t < 66; ++t) raw[t] = ((t == 0 && !hasPrev) || (t == 65 && !hasNext)) ? 0u : *(const unsigned*)(pp + (ptrdiff_t)(t - 1) * LDP);
#pragma unroll
                    for (int t8 = 0; t8 < 8; ++t8) { float v0[8], v1[8];
#pragma unroll
                        for (int tt = 0; tt < 8; ++tt) { const int t = t8 * 8 + tt; const unsigned p0 = raw[t], p1 = raw[t + 1], p2 = raw[t + 2];
                            float a0 = bb.x + w0.x * __uint_as_float(p0 << 16) + w1.x * __uint_as_float(p1 << 16) + w2.x * __uint_as_float(p2 << 16);
                            float a1 = bb.y + w0.y * __uint_as_float(p0 & 0xFFFF0000u) + w1.y * __uint_as_float(p1 & 0xFFFF0000u) + w2.y * __uint_as_float(p2 & 0xFFFF0000u);
                            a0 = siluf_(a0) * osc; a1 = siluf_(a1) * osc; v0[tt] = a0; v1[tt] = a1;
                            *(unsigned*)(dst + (size_t)t * 1024) = pk2(a0, a1); }
                        if (strip) { u32x4 s0, s1; s0.x = pk2(v0[0], v0[1]); s0.y = pk2(v0[2], v0[3]); s0.z = pk2(v0[4], v0[5]); s0.w = pk2(v0[6], v0[7]); s1.x = pk2(v1[0], v1[1]); s1.y = pk2(v1[2], v1[3]); s1.z = pk2(v1[4], v1[5]); s1.w = pk2(v1[6], v1[7]);
                            *(u32x4*)(strip + t8 * 8) = s0; *(u32x4*)(strip + 64 + t8 * 8) = s1; } }
                } else {
                    const int c = (tid & 255) * 2, th = tid >> 8; const bf16_t* pp = P + (tok0 + th * 32) * LDP + ML_OFF + 1024 + c; bf16_t* strip = VTG + ((size_t)seg * 512 + c) * 64 + th * 32;
                    unsigned rv[32];
#pragma unroll
                    for (int t = 0; t < 32; ++t) rv[t] = *(const unsigned*)(pp + (size_t)t * LDP);
#pragma unroll
                    for (int t8 = 0; t8 < 4; ++t8) { u32x4 s0, s1;
                        s0.x = (rv[t8 * 8 + 0] & 0xFFFFu) | (rv[t8 * 8 + 1] << 16); s0.y = (rv[t8 * 8 + 2] & 0xFFFFu) | (rv[t8 * 8 + 3] << 16); s0.z = (rv[t8 * 8 + 4] & 0xFFFFu) | (rv[t8 * 8 + 5] << 16); s0.w = (rv[t8 * 8 + 6] & 0xFFFFu) | (rv[t8 * 8 + 7] << 16);
                        s1.x = (rv[t8 * 8 + 0] >> 16) | (rv[t8 * 8 + 1] & 0xFFFF0000u); s1.y = (rv[t8 * 8 + 2] >> 16) | (rv[t8 * 8 + 3] & 0xFFFF0000u); s1.z = (rv[t8 * 8 + 4] >> 16) | (rv[t8 * 8 + 5] & 0xFFFF0000u); s1.w = (rv[t8 * 8 + 6] >> 16) | (rv[t8 * 8 + 7] & 0xFFFF0000u);
                        *(u32x4*)(strip + t8 * 8) = s0; *(u32x4*)(strip + 64 + t8 * 8) = s1; }
                }
            }
            if (!lastl) for (int tok = NLAT + bid; tok < NTOK; tok += G) {
                const int t = (tok - NLAT) & (CTXL - 1); const bool hasL = (t != 0), hasR = (t != CTXL - 1); const bf16_t* pr = P + (size_t)tok * LDP;
                const bf16_t* prL = hasL ? pr - LDP : pr; const bf16_t* prR = hasR ? pr + LDP : pr;
                unsigned xc[3], xl[3], xr[3];
#pragma unroll
                for (int j = 0; j < 3; ++j) { const int cc = tid + j * 512; xc[j] = pr[HY_OFF + cc]; xl[j] = prL[HY_OFF + cc]; xr[j] = prR[HY_OFF + cc]; }
#pragma unroll
                for (int j = 0; j < 3; ++j) { const int cc = tid + j * 512;
                    float acc = hcb[cc] + hcw[1536 + cc] * __uint_as_float(xc[j] << 16);
                    acc += hasL ? hcw[cc] * __uint_as_float(xl[j] << 16) : 0.f;
                    acc += hasR ? hcw[2 * 1536 + cc] * __uint_as_float(xr[j] << 16) : 0.f;
                    U[(size_t)tok * 1536 + cc] = acc; }
            }
            for (int idx0 = bid * NTHR + tid; idx0 < 16384 * 64; idx0 += 4 * G * NTHR) { u32x4 t4[4];
#pragma unroll
                for (int q = 0; q < 4; ++q) { const int idx = idx0 + q * G * NTHR; const int half = idx & 1, g = (idx >> 1) & 31, tok = idx >> 6;
                    if (idx < 16384 * 64) t4[q] = *(const u32x4*)(P + (size_t)tok * LDP + S5_OFF + g * 16 + half * 8); }
#pragma unroll
                for (int q = 0; q < 4; ++q) { const int idx = idx0 + q * G * NTHR; const int half = idx & 1, g = (idx >> 1) & 31, tok = idx >> 6;
                    if (idx < 16384 * 64) *(u32x4*)(S5A + ((size_t)g * 512 + (tok >> 5)) * 768 + (tok & 31) * 16 + half * 8) = t4[q]; } }
            for (int idx = bid * NTHR + tid; idx < 32 * 512 * 32 * 2; idx += G * NTHR) { const int half = idx & 1, sI = (idx >> 1) & 31, row = (idx >> 6) & 511, g = idx >> 15; const int t = row >> 4, c = row & 15; const int lag = t - sI;
                float v[8];
                if (lag > 0) { const float4* k4 = (const float4*)(KTB + ((size_t)((g * 2 + 0) * 32 + lag) * 16 + c) * 16 + half * 8); const float4 a0 = k4[0], a1 = k4[1]; v[0] = a0.x; v[1] = a0.y; v[2] = a0.z; v[3] = a0.w; v[4] = a1.x; v[5] = a1.y; v[6] = a1.z; v[7] = a1.w; }
                else if (lag < 0) { const float4* k4 = (const float4*)(KTB + ((size_t)((g * 2 + 1) * 32 - lag) * 16 + c) * 16 + half * 8); const float4 a0 = k4[0], a1 = k4[1]; v[0] = a0.x; v[1] = a0.y; v[2] = a0.z; v[3] = a0.w; v[4] = a1.x; v[5] = a1.y; v[6] = a1.z; v[7] = a1.w; }
                else { const float4* k4 = (const float4*)(KTB + ((size_t)((g * 2 + 0) * 32) * 16 + c) * 16 + half * 8); const float4* q4 = (const float4*)(KTB + ((size_t)((g * 2 + 1) * 32) * 16 + c) * 16 + half * 8); const float4 a0 = k4[0], a1 = k4[1], b0 = q4[0], b1 = q4[1];
                    v[0] = a0.x + b0.x; v[1] = a0.y + b0.y; v[2] = a0.z + b0.z; v[3] = a0.w + b0.w; v[4] = a1.x + b1.x; v[5] = a1.y + b1.y; v[6] = a1.z + b1.z; v[7] = a1.w + b1.w; }
                u32x4 w; w.x = pk2(v[0], v[1]); w.y = pk2(v[2], v[3]); w.z = pk2(v[4], v[5]); w.w = pk2(v[6], v[7]);
                *(u32x4*)(S5B + ((size_t)g * 512 + row) * 768 + sI * 16 + half * 8) = w; }
            for (int idx = bid * NTHR + tid; idx < 32 * 512 * 64; idx += G * NTHR) { const int n = idx & 63, row = (idx >> 6) & 511, g = idx >> 15; const int t = row >> 4, c = row & 15;
                const float cr = (PT(29) + l * 32 * 16 * 64)[(g * 16 + c) * 64 + n], ci = (PT(30) + l * 32 * 16 * 64)[(g * 16 + c) * 64 + n];
                const float2 af = APW[((0 * 32 + g) * 64 + n) * 33 + t + 1], ab = APW[((1 * 32 + g) * 64 + n) * 33 + 32 - t];
                bf16_t* d = S5B + ((size_t)g * 512 + row) * 768 + 512 + 2 * n;
                *(unsigned*)d = pk2(cr * af.x - ci * af.y, -(cr * af.y + ci * af.x)); *(unsigned*)(d + 128) = pk2(cr * ab.x - ci * ab.y, -(cr * ab.y + ci * ab.x)); }
            for (int idx = bid * NTHR + tid; idx < 32 * 2 * 64 * 32; idx += G * NTHR) { const int sI = idx & 31, n = (idx >> 5) & 63, dir = (idx >> 11) & 1, g = idx >> 12; const int pi = (dir * 32 + g) * 64 + n;
                const float2 pw = APW[pi * 33 + (dir ? sI : 31 - sI)]; const float4* bb = (const float4*)(BBT + pi * 16);
                float re[16], im[16];
#pragma unroll
                for (int j = 0; j < 8; ++j) { const float4 b2 = bb[j]; re[2 * j] = pw.x * b2.x - pw.y * b2.y; im[2 * j] = pw.x * b2.y + pw.y * b2.x; re[2 * j + 1] = pw.x * b2.z - pw.y * b2.w; im[2 * j + 1] = pw.x * b2.w + pw.y * b2.z; }
                bf16_t* d = S5P + ((size_t)g * 256 + dir * 128 + 2 * n) * 512 + sI * 16;
                u32x4 w0, w1; w0.x = pk2(re[0], re[1]); w0.y = pk2(re[2], re[3]); w0.z = pk2(re[4], re[5]); w0.w = pk2(re[6], re[7]); w1.x = pk2(re[8], re[9]); w1.y = pk2(re[10], re[11]); w1.z = pk2(re[12], re[13]); w1.w = pk2(re[14], re[15]);
                *(u32x4*)d = w0; *(u32x4*)(d + 8) = w1;
                w0.x = pk2(im[0], im[1]); w0.y = pk2(im[2], im[3]); w0.z = pk2(im[4], im[5]); w0.w = pk2(im[6], im[7]); w1.x = pk2(im[8], im[9]); w1.y = pk2(im[10], im[11]); w1.z = pk2(im[12], im[13]); w1.w = pk2(im[14], im[15]);
                *(u32x4*)(d + 512) = w0; *(u32x4*)(d + 520) = w1; }
            {   float* T = sf;
                for (int unit = bid; unit < 4 * 64 * 24; unit += G) { const int b = unit / (64 * 24), r = (unit / 24) % 64, c0 = (unit % 24) * 64; const size_t tok0 = (size_t)b * SEQ + r * 64;
                    __syncthreads();
#pragma unroll
                    for (int i = 0; i < 8; ++i) { const int c = tid & 63, t = (tid >> 6) + 8 * i; T[t * 65 + c] = bf2f(P[(tok0 + t) * LDP + HY_OFF + c0 + c]); }
                    __syncthreads();
                    const int c = tid >> 3, tq = (tid & 7) * 8, cc = c0 + c; const float w0 = hcw[cc], w1 = hcw[1536 + cc], w2 = hcw[3072 + cc], bb = hcb[cc];
                    float o8[8];
#pragma unroll
                    for (int i = 0; i < 8; ++i) { const int t = tq + i; float acc = bb + w1 * T[t * 65 + c]; if (t > 0) acc += w0 * T[(t - 1) * 65 + c]; if (t < 63) acc += w2 * T[(t + 1) * 65 + c]; o8[i] = acc; }
                    bf16_t* dst = UT + ((size_t)b * 1536 + cc) * SEQ + r * 64 + tq;
                    { u32x4 wv; wv.x = pk2(o8[0], o8[1]); wv.y = pk2(o8[2], o8[3]); wv.z = pk2(o8[4], o8[5]); wv.w = pk2(o8[6], o8[7]); *(u32x4*)dst = wv; }
                } }
            if (!lastl) {
                const int L = CTXL; const float* HR = HRAW + (size_t)SEQ * 2048; float* K2 = K2C; const float* nrm = NORM + (size_t)(l * 2 + 1) * 1024;
                const size_t total = (size_t)(2 * L - 1) * 1024;
                for (size_t i = (size_t)bid * NTHR + tid; i < total; i += (size_t)G * NTHR) { const int j = (int)(i >> 10), oc = (int)(i & 1023), o = oc >> 9, c = oc & 511; const int lag = j - (L - 1);
                    const float v = lag >= 0 ? HR[(size_t)lag * 2048 + o * 1024 + c] : HR[(size_t)(-lag) * 2048 + o * 1024 + 512 + c];
                    K2[((size_t)j * 2 + o) * 512 + c] = v / nrm[oc]; }
            }
            {   __syncthreads(); fft_twiddles((float2*)(shm + FFT_X_BYTES), tid);
                for (int pr = bid; pr < 512; pr += G) hyena_spec_item(pr, HRAW, NORM + (size_t)(l * 2 + 0) * 1024, HSPEC, shm, tid);
                __syncthreads(); }
            SEAM(PB + 2);
        }

        if (IN(PB + 3)) for (int rep_ = 0; rep_ < PROBE_REPS(3); ++rep_) {
            PH_BEGIN
            if (rep_ > 0) { if (bid == 0 && tid == 0) __hip_atomic_store(QCTR + l * 64, 0, __ATOMIC_RELAXED, __HIP_MEMORY_SCOPE_AGENT); xcd_barrier(bar); }
            if (bid < 64) {
                mlstm_state_pass(bid >> 1, bid & 1, P, KTG, VTG, PT(22) + l * 16, CST, NST, MST, shm, tid);
            } else if (bid < 128) {
                { const int ch = bid - 64; const int dir_ = ch & 1, h_ = (ch >> 1) & 7; ssd_state_pass(ch, P, BTG, XTG, -expf(PT(37)[l * 16 + dir_ * 8 + h_]), PT(36)[l * 16 + dir_ * 8 + h_], SSTB, shm, tid); }
            } else if (bid < 160) {
                const int widx = (bid - 128) * 8 + wave; const int dir = widx & 1, g = (widx >> 1) & 31, b = widx >> 6; const int n = lane;
                float2* xb = (float2*)(shm + (size_t)wave * 16640); float2* ctab = xb + 16 * 65;
                const float* a_re = PT(24) + l * 2 * 32 * 64; const float* a_im = PT(25) + l * 2 * 32 * 64; const float* log_dt = PT(26) + l * 64;
                const float* b_re = PT(27) + l * 32 * 64 * 16; const float* b_im = PT(28) + l * 32 * 64 * 16; const float* c_re = PT(29) + l * 32 * 16 * 64; const float* c_im = PT(30) + l * 32 * 16 * 64;
#pragma unroll
                for (int c = 0; c < 16; ++c) ctab[c * 65 + lane] = make_float2(c_re[(g * 16 + c) * 64 + lane], c_im[(g * 16 + c) * 64 + lane]);
                float abr, abi, bbr[16], bbi[16];
                {   const double are = (double)a_re[(dir * 32 + g) * 64 + n], aim = (double)a_im[(dir * 32 + g) * 64 + n];
                    const double lam = are < -1e-4 ? are : -1e-4; const double dt = exp((double)log_dt[dir * 32 + g]);
                    const double mag = exp(lam * dt); const double ar = mag * cos(aim * dt), ai = mag * sin(aim * dt);
                    const double den = lam * lam + aim * aim; const double nr = ar - 1.0, ni = ai;
                    const double fre = (nr * lam + ni * aim) / den, fim = (ni * lam - nr * aim) / den;
                    abr = (float)ar; abi = (float)ai;
#pragma unroll
                    for (int c = 0; c < 16; ++c) { const double br = (double)b_re[(g * 64 + n) * 16 + c], bi = (double)b_im[(g * 64 + n) * 16 + c]; bbr[c] = (float)(fre * br - fim * bi); bbi[c] = (float)(fre * bi + fim * br); }
                }
                float xr = 0.f, xi = 0.f; float* Sout = (dir ? SB : SF) - (size_t)NLAT * BW;
                const int s = lane >> 2, cg = lane & 3;
                for (int i0 = 0; i0 < CTXL; i0 += 16) {
#pragma unroll 4
                    for (int ss = 0; ss < 16; ++ss) {
                        const size_t tok = (size_t)step_tok(b, dir, i0 + ss);
                        const u32x4* up = (const u32x4*)(P + tok * LDP + S5_OFF + g * 16);
                        float t0[8], t1[8]; unpack8(up[0], t0); unpack8(up[1], t1);
                        float bur = 0.f, bui = 0.f;
#pragma unroll
                        for (int c = 0; c < 8; ++c) { bur += t0[c] * bbr[c] + t1[c] * bbr[8 + c]; bui += t0[c] * bbi[c] + t1[c] * bbi[8 + c]; }
                        const float nxr = abr * xr - abi * xi + bur, nxi = abr * xi + abi * xr + bui; xr = nxr; xi = nxi;
                        xb[ss * 65 + lane] = make_float2(xr, xi);
                    }
                    asm volatile("s_waitcnt lgkmcnt(0)" ::: "memory");
                    float y0 = 0.f, y1 = 0.f, y2 = 0.f, y3 = 0.f;
                    for (int nn2 = 0; nn2 < 64; ++nn2) { const float2 xv = xb[s * 65 + nn2];
                        const float2 c0 = ctab[(cg * 4 + 0) * 65 + nn2], c1 = ctab[(cg * 4 + 1) * 65 + nn2], c2 = ctab[(cg * 4 + 2) * 65 + nn2], c3 = ctab[(cg * 4 + 3) * 65 + nn2];
                        y0 += xv.x * c0.x - xv.y * c0.y; y1 += xv.x * c1.x - xv.y * c1.y; y2 += xv.x * c2.x - xv.y * c2.y; y3 += xv.x * c3.x - xv.y * c3.y; }
                    const size_t toks = (size_t)step_tok(b, dir, i0 + s);
                    *(float4*)(Sout + toks * BW + g * 16 + cg * 4) = make_float4(y0, y1, y2, y3);
                    asm volatile("s_waitcnt lgkmcnt(0)" ::: "memory");
                }
                XCTX[((b * 32 + g) * 2 + dir) * 64 + n] = make_float2(xr, xi);
            } else {
                if (bid < 224) {
                    pg8::Gemm gg_{S5A, S5P, 768, 512, 512}; pg8::SchedS5a S_{bid - 160}; pg8::EpiXloc E_{XLOC};
                    pg8::gemm_phase((LAS unsigned char*)shm, gg_, S_, E_);
                    __syncthreads();
                }
                const int nhb = G - 160, hb = bid - 160; const float* bias = PT(19) + l * 1024; const int c = tid;
                const int nitems = lastl ? 0 : 4 * (CTXL / 8);
                for (int it = hb; it < nitems; it += nhb) {
                    int L, tokbase, b, t0; const float* K2;
                    { const int q = it; L = CTXL; tokbase = NLAT; b = q / (CTXL / 8); t0 = (q % (CTXL / 8)) * 8; K2 = K2C; }
                    const float* zb = U + (size_t)(tokbase + b * L) * 1536 + c;
                    float acc[8];
#pragma unroll
                    for (int i = 0; i < 8; ++i) acc[i] = 0.f;
                    const int base = t0 + L - 1;
                    for (int s = 0; s < L; s += 8) {
                        float k[15];
#pragma unroll
                        for (int mm = 0; mm < 15; ++mm) k[mm] = K2[((size_t)(base - s - 7 + mm) * 2 + 0) * 512 + c];
#pragma unroll
                        for (int ds = 0; ds < 8; ++ds) { const float z = zb[(size_t)(s + ds) * 1536];
#pragma unroll
                            for (int i = 0; i < 8; ++i) acc[i] += k[i - ds + 7] * z; }
                    }
#pragma unroll
                    for (int i = 0; i < 8; ++i) { const size_t tok = (size_t)(tokbase + b * L + t0 + i); const float zt = U[tok * 1536 + c]; Z[tok * BW + c] = (acc[i] + bias[c] * zt) * U[tok * 1536 + 512 + c]; }
                }
            }
            {   __syncthreads(); fft_twiddles((float2*)(shm + FFT_X_BYTES), tid);
                int* qslot = (int*)(shm + FFT_X_BYTES + 65536);
                for (;;) { __syncthreads(); if (tid == 0) *qslot = atomicAdd(QCTR + l * 64, 1); __syncthreads(); const int it = *qslot; if (it >= 1024) break;
                    hyena_fft_item(it, UT, HSPEC, PT(19) + l * 1024, YT, shm, tid); }
            }
            SEAM(PB + 3);
        }

        if (IN(PB + 4)) for (int rep_ = 0; rep_ < PROBE_REPS(4); ++rep_) {
            PH_BEGIN
            if (rep_ > 0) { if (bid == 0 && tid == 0) __hip_atomic_store(QCTR + l * 64 + 32, 0, __ATOMIC_RELAXED, __HIP_MEMORY_SCOPE_AGENT); xcd_barrier(bar); }
            if (bid >= G - 32) for (int idx = (bid - (G - 32)) * NTHR + tid; idx < 16384; idx += 32 * NTHR) { const int n = idx & 63, dir = (idx >> 6) & 1, b = (idx >> 7) & 3, g = idx >> 9;
                const float2 a32 = APW[((dir * 32 + g) * 64 + n) * 33 + 32]; float2 X = XCTX[((b * 32 + g) * 2 + dir) * 64 + n];
                const float* __restrict__ xl = XLOC + ((size_t)g * 512 + b * 128) * 256 + dir * 128 + 2 * n; bf16_t* __restrict__ dst = S5A + ((size_t)g * 512 + b * 128) * 768 + 512 + dir * 128 + 2 * n;
#pragma unroll 1
                for (int j0 = 0; j0 < 128; j0 += 16) { float2 xv[16];
#pragma unroll
                    for (int q = 0; q < 16; ++q) { const int j = dir ? 127 - (j0 + q) : j0 + q; xv[q] = *(const float2*)(xl + (size_t)j * 256); }
#pragma unroll
                    for (int q = 0; q < 16; ++q) { const int j = dir ? 127 - (j0 + q) : j0 + q;
                        *(unsigned*)(dst + (size_t)j * 768) = pk2(X.x, X.y);
                        const float nx = a32.x * X.x - a32.y * X.y + xv[q].x, ny = a32.x * X.y + a32.y * X.x + xv[q].y; X.x = nx; X.y = ny; } } }
            {   int* qslot = (int*)(shm + 102400);
                __syncthreads(); if (tid == 0) *qslot = atomicAdd(QCTR + l * 64 + 32, 1); __syncthreads();
                for (;;) { const int it = *qslot; if (it >= 32 * 68 + 64 * 68) break;
                    int nxt_ = 0; if (tid == 0) nxt_ = atomicAdd(QCTR + l * 64 + 32, 1);
                    if (it < 32 * 68) { const int chain = it / 68, c = it % 68; mlstm_out_item(chain, c, P, QKB, VTG, PT(22) + l * 16, CST, NST, MST, (chain & 1) ? HBk : HF, shm, tid); }
                    else { const int i2 = it - 32 * 68; const int chain = i2 / 68, c = i2 % 68; const int dir_ = chain & 1, h_ = (chain >> 1) & 7;
                        ssd_out_item(chain, c, P, XBC, XTG, -expf(PT(37)[l * 16 + dir_ * 8 + h_]), PT(36)[l * 16 + dir_ * 8 + h_], SSTB, dir_ ? YB : YF, shm, tid); }
                    __syncthreads(); if (tid == 0) *qslot = nxt_; __syncthreads(); }
            }
            __syncthreads();
            {   const float* bias = PT(19) + l * 1024 + 512; const int c = tid;
                const int nitems = lastl ? 0 : 4 * (CTXL / 8);
                for (int it = bid; it < nitems; it += G) {
                    int L, tokbase, b, t0; const float* K2;
                    { const int q = it; L = CTXL; tokbase = NLAT; b = q / (CTXL / 8); t0 = (q % (CTXL / 8)) * 8; K2 = K2C; }
                    const float* zb = Z + (size_t)(tokbase + b * L) * BW + c;
                    float acc[8];
#pragma unroll
                    for (int i = 0; i < 8; ++i) acc[i] = 0.f;
                    const int base = t0 + L - 1;
                    for (int s = 0; s < L; s += 8) {
                        float k[15];
#pragma unroll
                        for (int mm = 0; mm < 15; ++mm) k[mm] = K2[((size_t)(base - s - 7 + mm) * 2 + 1) * 512 + c];
#pragma unroll
                        for (int ds = 0; ds < 8; ++ds) { const float z = zb[(size_t)(s + ds) * BW];
#pragma unroll
                            for (int i = 0; i < 8; ++i) acc[i] += k[i - ds + 7] * z; }
                    }
#pragma unroll
                    for (int i = 0; i < 8; ++i) { const size_t tok = (size_t)(tokbase + b * L + t0 + i); const float zt = Z[tok * BW + c]; Y4[tok * DM + c] = f2bf((acc[i] + bias[c] * zt) * U[tok * 1536 + 1024 + c]); }
                }
            }
            SEAM(PB + 4);
        }

        if (IN(PB + 5)) for (int rep_ = 0; rep_ < PROBE_REPS(5); ++rep_) {
            PH_BEGIN
            const float* ml_norm = PT(23) + l * BW; const float* ssd_d = PT(38) + l * 8; const float* ssd_norm = PT(39) + l * BW; const float* s5_d = PT(31) + l * BW;
            if (bid < 128) {
                pg8::Gemm gg_{S5A, S5B, 768, 768, 768}; pg8::SchedS5b S_{bid}; pg8::EpiS5Out E_{P, s5_d, GG};
                pg8::gemm_phase((LAS unsigned char*)shm, gg_, S_, E_);
                __syncthreads();
            }
            for (int tok = bid * 8 + wave; tok < NTOK; tok += G * 8) {
                const int c0 = lane * 8; const bf16_t* pr = P + (size_t)tok * LDP; const size_t o5 = (size_t)tok * BW + c0;
                float hm[8], ys[8];
                const u32x4 ooq = *(const u32x4*)(pr + ML_OFF + 1536 + c0);
                const float4 g0 = *(const float4*)(ml_norm + c0), g1 = *(const float4*)(ml_norm + c0 + 4), n0 = *(const float4*)(ssd_norm + c0), n1 = *(const float4*)(ssd_norm + c0 + 4);
                { float fa[8], fb[8]; unpack8(*(const u32x4*)(HF + o5), fa); unpack8(*(const u32x4*)(HBk + o5), fb);
#pragma unroll
                  for (int j = 0; j < 8; ++j) hm[j] = fa[j] + fb[j]; }
                { float ya[8], yb[8]; unpack8(*(const u32x4*)(YF + o5), ya); unpack8(*(const u32x4*)(YB + o5), yb);
                  float xx[8], zz[8]; unpack8(*(const u32x4*)(XBC + (size_t)tok * 1024 + c0), xx); unpack8(*(const u32x4*)(pr + SSD_OFF + c0), zz); const float dsk = ssd_d[c0 >> 6];
#pragma unroll
                  for (int j = 0; j < 8; ++j) ys[j] = ya[j] + yb[j];
#pragma unroll
                  for (int j = 0; j < 8; ++j) ys[j] = (ys[j] + dsk * xx[j]) * siluf_(zz[j]); }
                float s1 = 0.f, s2 = 0.f;
#pragma unroll
                for (int j = 0; j < 8; ++j) { s1 += hm[j] * hm[j]; s2 += ys[j] * ys[j]; }
                s1 += __shfl_xor(s1, 1); s1 += __shfl_xor(s1, 2); s1 += __shfl_xor(s1, 4); s1 += __shfl_xor(s1, 8);
                s2 = wave_sum(s2);
                const float r1 = rsqrtf(s1 * (1.0f / 128.0f) + 1e-6f), r2 = rsqrtf(s2 * (1.0f / BW) + 1e-6f);
                float oo[8]; unpack8(ooq, oo);
                const float gm[8] = {g0.x, g0.y, g0.z, g0.w, g1.x, g1.y, g1.z, g1.w}, gs[8] = {n0.x, n0.y, n0.z, n0.w, n1.x, n1.y, n1.z, n1.w};
                u32x4 w;
                w.x = pk2(hm[0] * r1 * gm[0] * sigmoidf_(oo[0]), hm[1] * r1 * gm[1] * sigmoidf_(oo[1])); w.y = pk2(hm[2] * r1 * gm[2] * sigmoidf_(oo[2]), hm[3] * r1 * gm[3] * sigmoidf_(oo[3]));
                w.z = pk2(hm[4] * r1 * gm[4] * sigmoidf_(oo[4]), hm[5] * r1 * gm[5] * sigmoidf_(oo[5])); w.w = pk2(hm[6] * r1 * gm[6] * sigmoidf_(oo[6]), hm[7] * r1 * gm[7] * sigmoidf_(oo[7]));
                *(u32x4*)(Y4 + (size_t)tok * DM + 512 + c0) = w;
                w.x = pk2(ys[0] * r2 * gs[0], ys[1] * r2 * gs[1]); w.y = pk2(ys[2] * r2 * gs[2], ys[3] * r2 * gs[3]); w.z = pk2(ys[4] * r2 * gs[4], ys[5] * r2 * gs[5]); w.w = pk2(ys[6] * r2 * gs[6], ys[7] * r2 * gs[7]);
                *(u32x4*)(Y4 + (size_t)tok * DM + 1536 + c0) = w;
                if (tok >= NLAT) { const size_t oc = (size_t)(tok - NLAT) * BW + c0; float uu[8]; unpack8(*(const u32x4*)(pr + S5_OFF + c0), uu);
                    const float4 a0 = *(const float4*)(SF + oc), a1 = *(const float4*)(SF + oc + 4), b0 = *(const float4*)(SB + oc), b1 = *(const float4*)(SB + oc + 4), d0 = *(const float4*)(s5_d + c0), d1 = *(const float4*)(s5_d + c0 + 4);
                    float y[8] = {a0.x + b0.x + d0.x * uu[0], a0.y + b0.y + d0.y * uu[1], a0.z + b0.z + d0.z * uu[2], a0.w + b0.w + d0.w * uu[3], a1.x + b1.x + d1.x * uu[4], a1.y + b1.y + d1.y * uu[5], a1.z + b1.z + d1.z * uu[6], a1.w + b1.w + d1.w * uu[7]};
#pragma unroll
                    for (int j = 0; j < 8; ++j) y[j] = 0.5f * y[j] * (1.0f + tanhf(0.7978845608028654f * (y[j] + 0.044715f * y[j] * y[j] * y[j])));
                    w.x = pk2(y[0], y[1]); w.y = pk2(y[2], y[3]); w.z = pk2(y[4], y[5]); w.w = pk2(y[6], y[7]);
                    *(u32x4*)(GG + (size_t)tok * BW + c0) = w; }
            }
            __syncthreads();
            {   float* T = sf;
                for (int unit = (G > 128 ? bid - 128 : bid); unit >= 0 && unit < 4 * 64 * 8; unit += (G > 128 ? G - 128 : G)) { const int b = unit / 512, t0 = ((unit >> 3) & 63) * 64, c0 = (unit & 7) * 64;
                    __syncthreads();
#pragma unroll
                    for (int i = 0; i < 8; ++i) { const int t = tid & 63, c = (tid >> 6) + 8 * i; T[c * 65 + t] = YT[((size_t)b * 512 + c0 + c) * SEQ + t0 + t]; }
                    __syncthreads();
                    const int t = tid >> 3, cq = (tid & 7) * 8;
                    u32x4 w; w.x = pk2(T[(cq + 0) * 65 + t], T[(cq + 1) * 65 + t]); w.y = pk2(T[(cq + 2) * 65 + t], T[(cq + 3) * 65 + t]); w.z = pk2(T[(cq + 4) * 65 + t], T[(cq + 5) * 65 + t]); w.w = pk2(T[(cq + 6) * 65 + t], T[(cq + 7) * 65 + t]);
                    *(u32x4*)(Y4 + ((size_t)b * SEQ + t0 + t) * DM + c0 + cq) = w;
                } }
            SEAM(PB + 5);
        }

        if (IN(PB + 6)) for (int rep_ = 0; rep_ < PROBE_REPS(6); ++rep_) {
            PH_BEGIN
            pg8::Gemm g{GG, GLU, BW, BW, BW}; pg8::SchedStd S{68, 2, G, bid, BW, BW}; pg8::EpiGlu E{GG, PT(33) + l * BW, Y4};
            pg8::gemm_phase((LAS unsigned char*)shm, g, S, E);
            SEAM(PB + 6);
        }
        if (IN(PB + 7)) for (int rep_ = 0; rep_ < PROBE_REPS(7); ++rep_) {
            PH_BEGIN
            pg8::Gemm g{Y4, WBR, DM, BW, BW}; pg8::SchedBranch S{64, 8, G, bid}; pg8::EpiBranch E{P, ACCb};
            pg8::gemm_phase((LAS unsigned char*)shm, g, S, E);
            if (!lastl) { __syncthreads(); pg8::SchedTail S2{G, bid}; pg8::EpiPart E2{P, (float*)HSPEC}; pg8::gemm_phase((LAS unsigned char*)shm, g, S2, E2); }
            SEAM(PB + 7);
        }
        if (IN(PB + 8)) for (int rep_ = 0; rep_ < PROBE_REPS(8); ++rep_) {
            PH_BEGIN
            if (!lastl) {
                const float* PART = (const float*)HSPEC;
                for (int idx = bid * NTHR + tid; idx < (NTOK - NLAT) * DM / 8; idx += G * NTHR) { const size_t o = (size_t)idx * 8; f32x4 p[4][2];
#pragma unroll
                    for (int k = 0; k < 4; ++k) { p[k][0] = *(const f32x4*)(PART + (size_t)k * (NTOK - NLAT) * DM + o); p[k][1] = *(const f32x4*)(PART + (size_t)k * (NTOK - NLAT) * DM + o + 4); }
                    const f32x4 s0 = ((p[0][0] + p[1][0]) + p[2][0]) + p[3][0], s1 = ((p[0][1] + p[1][1]) + p[2][1]) + p[3][1];
                    u32x4 w; w.x = pk2(s0[0], s0[1]); w.y = pk2(s0[2], s0[3]); w.z = pk2(s1[0], s1[1]); w.w = pk2(s1[2], s1[3]);
                    *(u32x4*)(ACCb + (size_t)NLAT * DM + o) = w; }
                xcd_barrier(bar);
            }
            pg8::Gemm g{ACCb, WOUT, DM, DM, DM}; pg8::SchedStd S{64, 8, G, bid, DM, DM}; pg8::EpiResid E{XS, l == 0 ? x_in : (const float*)XS, l == 0 ? ctx_in - (size_t)NLAT * DM : (const float*)XS, MODl, 2};
            pg8::gemm_phase((LAS unsigned char*)shm, g, S, E);
            if (!lastl) { __syncthreads(); pg8::Gemm g2{ACCb, WOUT, DM, DM, 512}; pg8::SchedTailK S2{G, bid}; pg8::EpiPartK E2{(float*)HSPEC + (size_t)4 * (NTOK - NLAT) * DM}; pg8::gemm_phase((LAS unsigned char*)shm, g2, S2, E2); }
            SEAM(PB + 8);
        }
        if (IN(PB + 9)) for (int rep_ = 0; rep_ < PROBE_REPS(9); ++rep_) {
            PH_BEGIN
            if (!lastl) {
                const float* PART = (const float*)HSPEC + (size_t)4 * (NTOK - NLAT) * DM; const float* mg = MODl + (size_t)(4 * 6 + 2) * DM;
                const float* src = l == 0 ? ctx_in : (const float*)XS + (size_t)NLAT * DM;
                for (int idx = bid * NTHR + tid; idx < (NTOK - NLAT) * DM / 4; idx += G * NTHR) { const size_t o = (size_t)idx * 4; const int col = (int)(o & (DM - 1));
                    const f32x4 p0 = *(const f32x4*)(PART + o), p1 = *(const f32x4*)(PART + (size_t)(NTOK - NLAT) * DM + o), p2 = *(const f32x4*)(PART + (size_t)2 * (NTOK - NLAT) * DM + o), p3 = *(const f32x4*)(PART + (size_t)3 * (NTOK - NLAT) * DM + o);
                    const f32x4 sv = *(const f32x4*)(src + o), gm = *(const f32x4*)(mg + col);
                    *(f32x4*)(XS + (size_t)NLAT * DM + o) = sv + gm * (((p0 + p1) + p2) + p3); }
                xcd_barrier(bar);
            }
            for (int i = bid * NTHR + tid; i < NEXP * MOE_PAD; i += G * NTHR) ROWTOK[i] = -1;
            for (int i = bid * NTHR + tid; i < NTOK * 16; i += G * NTHR) INV[i] = -1;
            const float* wr = PT(42) + (size_t)l * DM * 16; const float* gn = norm_ffn + l * DM;
            for (int tok0 = (bid * 8 + wave) * 4; tok0 < M2; tok0 += G * 32) {
                const int r = tok0 < NLAT ? tok0 / SEQ : 4; const float* xr = XS + (size_t)tok0 * DM;
                const float* sh = MODl + (size_t)(r * 6 + 3) * DM; const float* sc = MODl + (size_t)(r * 6 + 4) * DM;
                float rs[4];
#pragma unroll
                for (int tk = 0; tk < 4; ++tk) { float ss = 0.f;
#pragma unroll 4
                    for (int i = 0; i < 8; ++i) { const float4 t4 = *(const float4*)(xr + (size_t)tk * DM + i * 256 + lane * 4); ss += t4.x * t4.x + t4.y * t4.y + t4.z * t4.z + t4.w * t4.w; }
                    ss = wave_sum(ss); rs[tk] = rsqrtf(ss * (1.0f / DM) + 1e-6f); }
                float lg[4][16];
#pragma unroll
                for (int tk = 0; tk < 4; ++tk)
#pragma unroll
                    for (int e = 0; e < 16; ++e) lg[tk][e] = 0.f;
#pragma unroll 1
                for (int i = 0; i < 8; ++i) { const int d = i * 256 + lane * 4;
                    const float4 g4 = *(const float4*)(gn + d), s4 = *(const float4*)(sc + d), h4 = *(const float4*)(sh + d);
                    float4 xq[4], ww[16];
#pragma unroll
                    for (int tk = 0; tk < 4; ++tk) xq[tk] = *(const float4*)(xr + (size_t)tk * DM + d);
                    const float4* wq = (const float4*)(wr + (size_t)d * 16);
#pragma unroll
                    for (int q = 0; q < 16; ++q) ww[q] = wq[q];
                    float hv[4][4];
#pragma unroll
                    for (int tk = 0; tk < 4; ++tk) { const float4 xv = xq[tk]; const float rr = rs[tk];
                        hv[tk][0] = xv.x * rr * g4.x * (1.f + s4.x) + h4.x; hv[tk][1] = xv.y * rr * g4.y * (1.f + s4.y) + h4.y; hv[tk][2] = xv.z * rr * g4.z * (1.f + s4.z) + h4.z; hv[tk][3] = xv.w * rr * g4.w * (1.f + s4.w) + h4.w;
                        u32x2 w; w.x = pk2(hv[tk][0], hv[tk][1]); w.y = pk2(hv[tk][2], hv[tk][3]); *(u32x2*)(HB + (size_t)(tok0 + tk) * DM + d) = w; }
#pragma unroll
                    for (int q = 0; q < 4; ++q) { const float4 w0 = ww[q * 4 + 0], w1 = ww[q * 4 + 1], w2 = ww[q * 4 + 2], w3 = ww[q * 4 + 3];
#pragma unroll
                        for (int tk = 0; tk < 4; ++tk) { const float hq = hv[tk][q];
                            lg[tk][0] += hq * w0.x; lg[tk][1] += hq * w0.y; lg[tk][2] += hq * w0.z; lg[tk][3] += hq * w0.w; lg[tk][4] += hq * w1.x; lg[tk][5] += hq * w1.y; lg[tk][6] += hq * w1.z; lg[tk][7] += hq * w1.w;
                            lg[tk][8] += hq * w2.x; lg[tk][9] += hq * w2.y; lg[tk][10] += hq * w2.z; lg[tk][11] += hq * w2.w; lg[tk][12] += hq * w3.x; lg[tk][13] += hq * w3.y; lg[tk][14] += hq * w3.z; lg[tk][15] += hq * w3.w; } } }
#pragma unroll
                for (int tk = 0; tk < 4; ++tk) { float mx = -1e30f;
#pragma unroll
                    for (int e = 0; e < 16; ++e) { lg[tk][e] = wave_sum(lg[tk][e]); mx = fmaxf(mx, lg[tk][e]); }
                    float sm = 0.f;
#pragma unroll
                    for (int e = 0; e < 16; ++e) { lg[tk][e] = expf(lg[tk][e] - mx); sm += lg[tk][e]; }
                    const float inv = 1.0f / sm;
                    if (lane == 0) {
#pragma unroll
                        for (int e = 0; e < 16; e += 4) *(float4*)(PROBS + (size_t)(tok0 + tk) * 16 + e) = make_float4(lg[tk][e] * inv, lg[tk][e + 1] * inv, lg[tk][e + 2] * inv, lg[tk][e + 3] * inv); } }
            }
            SEAM(PB + 9);
        }
        if (IN(PB + 10)) for (int rep_ = 0; rep_ < PROBE_REPS(10); ++rep_) {
            PH_BEGIN
            const int nitems = 64 + (lastl ? 0 : 64);
            unsigned long long* keys = (unsigned long long*)shm;
            for (int it = bid; it < nitems; it += G) {
                const int set = it >> 6, e = it & 15, b = (it >> 4) & 3;
                const int n = set ? CTXL : SEQ, cap = set ? 32 : 512, tokbase = set ? NLAT + b * CTXL : b * SEQ;
                __syncthreads();
                for (int i = tid; i < n; i += NTHR) keys[i] = ((unsigned long long)__float_as_uint(PROBS[(size_t)(tokbase + i) * 16 + e]) << 32) | (unsigned long long)(0xFFFFFFFFu - (unsigned)i);
                __syncthreads();
                for (int k = 2; k <= n; k <<= 1)
                    for (int j = k >> 1; j > 0; j >>= 1) {
                        for (int p = tid; p < (n >> 1); p += NTHR) { const int i = ((p & ~(j - 1)) << 1) | (p & (j - 1)); const int m = i | j;
                            const unsigned long long ka = keys[i], kb = keys[m]; const bool desc = ((i & k) == 0);
                            if ((ka < kb) == desc) { keys[i] = kb; keys[m] = ka; } }
                        __syncthreads();
                    }
                for (int r = tid; r < cap; r += NTHR) { const unsigned long long kk = keys[r]; const int row = e * MOE_PAD + (set ? 2048 + b * 32 + r : b * 512 + r);
                    const int tk_ = tokbase + (int)(0xFFFFFFFFu - (unsigned)(kk & 0xFFFFFFFFull)); ROWTOK[row] = tk_; ROWGATE[row] = __uint_as_float((unsigned)(kk >> 32)); INV[tk_ * 16 + e] = row; }
                for (int rb = 0; rb < cap; rb += 32) {
                    u32x4 t4[4][4];
#pragma unroll
                    for (int q = 0; q < 4; ++q) { const int r = rb + wave + 8 * q; const int tok = tokbase + (int)(0xFFFFFFFFu - (unsigned)(keys[r] & 0xFFFFFFFFull));
                        const u32x4* sp = (const u32x4*)(HB + (size_t)tok * DM);
#pragma unroll
                        for (int i = 0; i < 4; ++i) t4[q][i] = sp[i * 64 + lane]; }
#pragma unroll
                    for (int q = 0; q < 4; ++q) { const int r = rb + wave + 8 * q; const int row = e * MOE_PAD + (set ? 2048 + b * 32 + r : b * 512 + r);
                        u32x4* dp = (u32x4*)(XG + (size_t)row * DM);
#pragma unroll
                        for (int i = 0; i < 4; ++i) dp[i * 64 + lane] = t4[q][i]; } }
            }
            if (!lastl && G > 128 && bid >= 128) {
                const int n_win = 32 * 55, n_br = 4 * 64, n_out = 32 * 8, n_glu = 16, n_gu = 16 * 2 * 192; (void)n_gu;
                CV_RUN(l + 1, bid - 128, G - 128, n_win); (void)n_br; (void)n_out; (void)n_glu;
            }
            {   const int pad0 = lastl ? 2048 : MOE_ROWS, npad = MOE_PAD - pad0;
                for (int R = bid * 8 + wave; R < NEXP * npad; R += G * 8) { const int e = R / npad, rr = pad0 + R % npad; u32x4* dp = (u32x4*)(XG + ((size_t)e * MOE_PAD + rr) * DM);
#pragma unroll
                    for (int i = 0; i < 4; ++i) dp[i * 64 + lane] = (u32x4){0u, 0u, 0u, 0u}; } }
            SEAM(PB + 10);
        }
        if (IN(PB + 12)) for (int rep_ = 0; rep_ < PROBE_REPS(12); ++rep_) {
            PH_BEGIN
            pg8::Gemm g{XG, WGU, DM, DM, DM}; pg8::SchedMoe S{lastl ? 8 : 9, 12, G, bid, DM, DM, 2 * DEXP}; pg8::EpiMoe1 E{HID};
            pg8::gemm_phase((LAS unsigned char*)shm, g, S, E);
            SEAM(PB + 12);
        }
        if (IN(PB + 13)) for (int rep_ = 0; rep_ < PROBE_REPS(13); ++rep_) {
            PH_BEGIN
            pg8::Gemm g{HID, WD, DEXP, DEXP, DEXP}; pg8::SchedMoe S{lastl ? 8 : 9, 8, G, bid, DEXP, DEXP, DM}; pg8::EpiMoeY E{YEXP};
            pg8::gemm_phase((LAS unsigned char*)shm, g, S, E);
            SEAM(PB + 13);
        }

}

__global__ __launch_bounds__(NTHR, 2) void fwd(Args a) {
    extern __shared__ __attribute__((aligned(16))) unsigned char shm[];
    const int bid = blockIdx.x, G = gridDim.x;
    float* const sf = (float*)shm;
    volatile LAS unsigned* xbw = (volatile LAS unsigned*)((LAS unsigned char*)shm + (LDS_BYTES - 16));
    if (threadIdx.x == 0) { xbw[0] = 0u; xbw[1] = 0u; xbw[2] = 0u; xbw[3] = 0u; }
    const float** const ptab = (const float**)(shm + (LDS_BYTES - 16 - 512));
    if (threadIdx.x == 0) {
#pragma unroll
        for (int i = 0; i < 47; ++i) ptab[i] = a.in[i]; }
    __syncthreads();
    XcdBarrier bar = xcd_barrier_post((unsigned*)(a.ws + O_BAR), xbw);
    const int lo = a.ph_lo, hi = a.ph_hi;
    if (IN(0)) {
        PH_BEGIN
        {
            __syncthreads();
            for (int i = tid; i < 5 * DM; i += NTHR) { const int r = i >> 11, k = i & (DM - 1); const float v = r < 4 ? c_in[r * DM + k] : cctx_in[k]; sf[i] = siluf_(v); }
            __syncthreads();
            float* red = sf + 5 * DM;
            for (int unit = bid; unit < 2 * 96; unit += G) { const int l = unit / 96, j = (unit % 96) * 128 + (tid & 127), kq = tid >> 7;
                const float* w = ada_w + (size_t)l * DM * (6 * DM) + (size_t)(kq * 512) * (6 * DM) + j; const float* sv = sf + kq * 512;
                float a0 = 0.f, a1 = 0.f, a2 = 0.f, a3 = 0.f, a4 = 0.f;
#pragma unroll 8
                for (int k = 0; k < 512; ++k) { const float wv = w[(size_t)k * (6 * DM)]; a0 += sv[k] * wv; a1 += sv[DM + k] * wv; a2 += sv[2 * DM + k] * wv; a3 += sv[3 * DM + k] * wv; a4 += sv[4 * DM + k] * wv; }
                __syncthreads();
                { float* rp = red + (kq * 5) * 128 + (tid & 127); rp[0] = a0; rp[128] = a1; rp[256] = a2; rp[384] = a3; rp[512] = a4; }
                __syncthreads();
                if (tid < 128) { const float bb = ada_b[l * 6 * DM + j]; float* o = MOD + (size_t)l * 5 * 6 * DM + j;
#pragma unroll
                    for (int r = 0; r < 5; ++r) o[(size_t)r * 6 * DM] = ((red[(0 * 5 + r) * 128 + tid] + red[(1 * 5 + r) * 128 + tid]) + (red[(2 * 5 + r) * 128 + tid] + red[(3 * 5 + r) * 128 + tid])) + bb; }
            }
        }
    }

    layer_body<0>(a, bar, lo, hi, bid, G, shm, sf, ptab);
    layer_body<1>(a, bar, lo, hi, bid, G, shm, sf, ptab);
    if (IN(33)) {
        PH_BEGIN
        const float* gn = PT(46);
        for (int tok = bid * 8 + wave; tok < NLAT; tok += G * 8) {
            const float* xr = XS + (size_t)tok * DM; float4 v[8]; float ss = 0.f;
#pragma unroll
            for (int i = 0; i < 8; ++i) v[i] = *(const float4*)(xr + i * 256 + lane * 4);
            moe_combine(v, tok, lane, INV, ROWGATE, YEXP, MOD + (size_t)(1 * 5 + tok / SEQ) * 6 * DM + 5 * DM);
#pragma unroll
            for (int i = 0; i < 8; ++i) {                 ss += v[i].x * v[i].x + v[i].y * v[i].y + v[i].z * v[i].z + v[i].w * v[i].w; }
            ss = wave_sum(ss); const float rs = rsqrtf(ss * (1.0f / DM) + 1e-6f);
#pragma unroll
            for (int i = 0; i < 8; ++i) { const int d = i * 256 + lane * 4; const float4 g4 = *(const float4*)(gn + d);
                *(float4*)(a.out + (size_t)tok * DM + d) = make_float4(v[i].x * rs * g4.x, v[i].y * rs * g4.y, v[i].z * rs * g4.z, v[i].w * rs * g4.w); }
        }
    }
#undef IN
#undef SEAM
}


extern "C" void kernel_launch(void* const* d_in, const int* in_sizes, int n_in, void* d_out, int out_size, void* d_ws, size_t ws_size, hipStream_t stream) {
    static int grid = 0;
    if (grid == 0) {
        if (n_in != 47 || ws_size < WS_END) { fprintf(stderr, "kernel_launch: expected 47 inputs and >= %zu bytes of workspace; got %d, %zu\n", (size_t)WS_END, n_in, ws_size); grid = -1; return; }
        int dev = 0, cus = 0;
        if (hipGetDevice(&dev) != hipSuccess || hipDeviceGetAttribute(&cus, hipDeviceAttributeMultiprocessorCount, dev) != hipSuccess) { grid = -1; return; }
        if (hipFuncSetAttribute((const void*)fwd, hipFuncAttributeMaxDynamicSharedMemorySize, LDS_BYTES) != hipSuccess) { fprintf(stderr, "kernel_launch: hipFuncSetAttribute failed\n"); grid = -1; return; }
        int per_cu = 0;
        if (hipOccupancyMaxActiveBlocksPerMultiprocessor(&per_cu, (const void*)fwd, NTHR, LDS_BYTES) != hipSuccess || per_cu < 1) fprintf(stderr, "kernel_launch: occupancy query reports %d\n", per_cu);
        (void)hipGetLastError();
        grid = cus > 256 ? 256 : cus;
        if (grid < 224) { fprintf(stderr, "kernel_launch: needs >= 224 CUs (got %d)\n", grid); grid = -1; return; }
    }
    if (grid < 0) return;
    (void)hipMemsetAsync((char*)d_ws, 0, O_ZERO_END, stream);
    Args a{};
    for (int i = 0; i < 47; ++i) a.in[i] = (const float*)d_in[i];
    a.out = (float*)d_out; a.ws = (unsigned char*)d_ws;
#if MK_ONE_LAUNCH
    a.ph_lo = 0; a.ph_hi = 64;
    hipLaunchKernelGGL(fwd, dim3(grid), dim3(NTHR), LDS_BYTES, stream, a);
#else
    const int ids[] = {0, 1,2,3,4,5,6,7,8,9,10,11,12,13,14, 17,18,19,20,21,22,23,24,25,26,27,28,29,30, 33};
    for (int k = 0; k < (int)(sizeof(ids) / sizeof(ids[0])); ++k) { a.ph_lo = ids[k]; a.ph_hi = ids[k] + 1; hipLaunchKernelGGL(fwd, dim3(grid), dim3(NTHR), LDS_BYTES, stream, a); }
#endif
}
```

```cpp
#include <hip/hip_runtime.h>
#include <stdint.h>
#include <stdio.h>

#ifndef PROBE_MASK
#define PROBE_MASK 0
#endif
#ifndef PROBE_SP
#define PROBE_SP 1
#endif
#define PROBE_REPS(k) ((((PROBE_MASK) >> (k)) & 1) + 1)
#ifndef MK_ONE_LAUNCH
#define MK_ONE_LAUNCH 1
#endif

#define DM 2048
#define NB 4
#define SEQ 4096
#define CTXL 256
#define BW 512
#define NLAT 16384
#define NCTX 1024
#define NTOK 17408
#define IN_W 13856
#define LDP 14080
#define HY_OFF 0
#define ML_OFF 1536
#define S5_OFF 3600
#define SSD_OFF 4112
#define GATE_OFF 5664
#define NEXP 16
#define DEXP 1536
#define MOE_ROWS 2176
#define MOE_PAD 2304
#define NTHR 512
#define LDS_BYTES 147456
#define LAS __attribute__((address_space(3)))

typedef unsigned short bf16_t;
typedef short bf16x8 __attribute__((ext_vector_type(8)));
typedef float f32x4 __attribute__((ext_vector_type(4)));
typedef unsigned u32x4 __attribute__((ext_vector_type(4)));
typedef unsigned u32x2 __attribute__((ext_vector_type(2)));

#define XB_TMO      128
#define XB_XCNT(j)  (256  + 64 * (j))
#define XB_XSUB(j)  (1280 + 64 * (j))
#define XB_XGEN(j)  (2304 + 64 * (j))
#define XB_TOP      3328
#define XB_TOPGEN   3392
#define XCD_BAR_WORDS 3456
#define XB_SPIN_CAP (1u << 18)
__device__ __forceinline__ unsigned xb_ld(unsigned* p)              { return __hip_atomic_load(p, __ATOMIC_RELAXED, __HIP_MEMORY_SCOPE_AGENT); }
__device__ __forceinline__ unsigned xb_add(unsigned* p, unsigned v) { return __hip_atomic_fetch_add(p, v, __ATOMIC_RELAXED, __HIP_MEMORY_SCOPE_AGENT); }
__device__ __forceinline__ unsigned xb_xcc_id() { return (unsigned)__builtin_amdgcn_s_getreg((3 << 11) | 20) & 0xFu; }
#define XB_SPIN(cond, bar) do { unsigned _sp = 0; while (cond) { __builtin_amdgcn_s_sleep(1); \
    if ((++_sp & 255u) == 0u) { if (xb_ld(&(bar)[XB_TMO])) break; if (_sp > XB_SPIN_CAP) { atomicAdd(&(bar)[XB_TMO], 1u); break; } } } } while (0)
struct XcdBarrier { unsigned* bar; unsigned x; volatile LAS unsigned* st; };
__device__ __forceinline__ XcdBarrier xcd_barrier_post(unsigned* bar, volatile LAS unsigned* st) {
    XcdBarrier b; b.bar = bar; b.x = xb_xcc_id(); b.st = st;
    if (threadIdx.x == 0) (void)xb_add(&bar[XB_XCNT(b.x)], 1u);
    return b;
}
__device__ __forceinline__ void xcd_barrier_complete(unsigned* bar, unsigned x, unsigned& nloc, unsigned& nx) {
    const unsigned G = gridDim.x * gridDim.y * gridDim.z;
    unsigned sum, cnt, mine, sp = 0u;
    for (;;) {
        sum = 0u; cnt = 0u; mine = 0u;
#pragma unroll
        for (unsigned j = 0; j < 16; ++j) { const unsigned c = xb_ld(&bar[XB_XCNT(j)]); sum += c; cnt += (c > 0u) ? 1u : 0u; mine = (j == x) ? c : mine; }
        if (sum == G) break;
        __builtin_amdgcn_s_sleep(1);
        if ((++sp & 255u) == 0u) { if (xb_ld(&bar[XB_TMO])) break; if (sp > XB_SPIN_CAP) { atomicAdd(&bar[XB_TMO], 1u); break; } }
    }
    nloc = mine > 0u ? mine : 1u; nx = cnt > 0u ? cnt : 1u;
}
__device__ __forceinline__ void xcd_barrier(const XcdBarrier& b) {
    asm volatile("s_waitcnt vmcnt(0)" ::: "memory");
    __syncthreads();
    if (threadIdx.x == 0) {
        unsigned* bar = b.bar;
        __builtin_amdgcn_s_waitcnt(0);
        unsigned nloc = b.st[0], nx = b.st[1];
        if (nloc == 0u) { xcd_barrier_complete(bar, b.x, nloc, nx); b.st[0] = nloc; b.st[1] = nx; }
        const unsigned old = xb_add(&bar[XB_XSUB(b.x)], 1u);
        const unsigned gen = old / nloc;
        if (old + 1u == (gen + 1u) * nloc) {
            __builtin_amdgcn_fence(__ATOMIC_RELEASE, "agent");
            asm volatile("s_waitcnt vmcnt(0)" ::: "memory");
            const unsigned og = xb_add(&bar[XB_TOP], 1u);
            const unsigned tg = og / nx;
            if (og + 1u == (tg + 1u) * nx) xb_add(&bar[XB_TOPGEN], 1u);
            else XB_SPIN(xb_ld(&bar[XB_TOPGEN]) == tg, bar);
            __builtin_amdgcn_fence(__ATOMIC_ACQUIRE, "agent");
            xb_add(&bar[XB_XGEN(b.x)], 1u);
            asm volatile("s_waitcnt vmcnt(0)" ::: "memory");
        } else {
            XB_SPIN(xb_ld(&bar[XB_XGEN(b.x)]) == gen, bar);
            __builtin_amdgcn_fence(__ATOMIC_ACQUIRE, "agent");
            asm volatile("s_waitcnt vmcnt(0)" ::: "memory");
        }
    }
    __syncthreads();
}

__device__ __forceinline__ unsigned short f2bf(float f) { unsigned u = __float_as_uint(f); u += 0x7FFFu + ((u >> 16) & 1u); return (unsigned short)(u >> 16); }
__device__ __forceinline__ float bf2f(unsigned short b) { return __uint_as_float(((unsigned)b) << 16); }
__device__ __forceinline__ unsigned pk2(float lo, float hi) { unsigned r; asm("v_cvt_pk_bf16_f32 %0, %1, %2" : "=v"(r) : "v"(lo), "v"(hi)); return r; }
__device__ __forceinline__ float sigmoidf_(float x) { return 1.0f / (1.0f + expf(-x)); }
__device__ __forceinline__ float siluf_(float x) { return x / (1.0f + expf(-x)); }
__device__ __forceinline__ float wave_sum(float v) {
#pragma unroll
    for (int o = 32; o >= 1; o >>= 1) v += __shfl_xor(v, o);
    return v;
}
__device__ __forceinline__ const float* uptr(const float* p) { const unsigned long long v = (unsigned long long)p;
    const unsigned lo = __builtin_amdgcn_readfirstlane((unsigned)v), hi = __builtin_amdgcn_readfirstlane((unsigned)(v >> 32)); return (const float*)(((unsigned long long)hi << 32) | lo); }
#define PT(k) uptr(ptab[k])
__device__ __forceinline__ int step_tok(int b, int dir, int i) {
    if (i < CTXL) { const int tt = dir ? (CTXL - 1 - i) : i; return NLAT + b * CTXL + tt; }
    const int j = i - CTXL; const int tt = dir ? (SEQ - 1 - j) : j; return b * SEQ + tt;
}
__device__ __forceinline__ void unpack8(const u32x4 w, float (&f)[8]) {
    f[0] = __uint_as_float(w.x << 16); f[1] = __uint_as_float(w.x & 0xFFFF0000u); f[2] = __uint_as_float(w.y << 16); f[3] = __uint_as_float(w.y & 0xFFFF0000u);
    f[4] = __uint_as_float(w.z << 16); f[5] = __uint_as_float(w.z & 0xFFFF0000u); f[6] = __uint_as_float(w.w << 16); f[7] = __uint_as_float(w.w & 0xFFFF0000u);
}

namespace pg8 {
constexpr int BM = 256, BK = 64, HALF = 128, HTB = HALF * BK * 2, STAGE_BYTES = 8 * HTB, NXCD = 8, WGM = 8;
__host__ __device__ __forceinline__ int lds_byte(int r, int c) { const int st = (r >> 4) * 2 + (c >> 5), rr = r & 15, cc = c & 31, ob = rr * 64 + cc * 2; return st * 1024 + (ob ^ (((ob >> 9) & 1) << 5)); }
__host__ __device__ __forceinline__ void stage_rc(int b, int& R, int& C) { const int st = b / 1024, sb = b % 1024, swz = sb ^ (((sb >> 9) & 1) << 5); R = (st >> 1) * 16 + swz / 64; C = (st & 1) * 32 + (swz % 64) / 2; }
__host__ __device__ __forceinline__ int perm32(int rho) { const int n = rho >> 4, i = rho & 15; return 8 * (i >> 2) + 4 * n + (i & 3); }
struct Unit { int pm, pn, z, k; long long ao, bo; };
struct Gemm { const bf16_t* A; const bf16_t* Bt; int lda, ldb, K; };

__device__ __forceinline__ void tile_of(int wgid, int nM, int nN, int& pm, int& pn) {
    const int nwg = nM * nN; { const int q = nwg / NXCD, r = nwg % NXCD, xcd = wgid % NXCD, off = wgid / NXCD; wgid = (xcd < r ? xcd * (q + 1) : r * (q + 1) + (xcd - r) * q) + off; }
    const int nig = WGM * nN, gid = wgid / nig, fm = gid * WGM, gsz = (nM - fm) < WGM ? (nM - fm) : WGM;
    pm = fm + ((wgid % nig) % gsz); pn = (wgid % nig) / gsz;
}
struct SchedStd {
    int nM, nN, G, c, lda, ldb;
    __device__ __forceinline__ bool next(int i, Unit& u) const { const long L = (long)i * G + c; if (L >= (long)nM * nN) return false; tile_of((int)L, nM, nN, u.pm, u.pn); u.z = 0; u.k = 0;
        u.ao = (long long)u.pm * BM * lda * 2; u.bo = (long long)u.pn * BM * ldb * 2; return true; }
    __device__ __forceinline__ void a_ready(const Unit&) const {}
    __device__ __forceinline__ void done(const Unit&) const {}
};
struct SchedBranch {
    int nM, nN, G, c;
    __device__ __forceinline__ bool next(int i, Unit& u) const { const long L = (long)(i >> 2) * G + c; if (L >= (long)nM * nN) return false; tile_of((int)L, nM, nN, u.pm, u.pn); u.z = 0; u.k = i & 3;
        u.ao = ((long long)u.pm * BM * DM + u.k * BW) * 2; u.bo = ((long long)u.k * DM + u.pn * BM) * BW * 2; return true; }
    __device__ __forceinline__ void a_ready(const Unit&) const {}
    __device__ __forceinline__ void done(const Unit&) const {}
};
struct SchedTail {
    int G, c;
    __device__ __forceinline__ bool next(int i, Unit& u) const { const long T = (long)i * G + c; if (T >= 128) return false; const int t = (int)(T >> 2); u.pm = 64 + (t >> 3); u.pn = t & 7; u.z = 1; u.k = (int)(T & 3);
        u.ao = ((long long)u.pm * BM * DM + u.k * BW) * 2; u.bo = ((long long)u.k * DM + u.pn * BM) * BW * 2; return true; }
    __device__ __forceinline__ void a_ready(const Unit&) const {}
    __device__ __forceinline__ void done(const Unit&) const {}
};
struct SchedTailK {
    int G, c;
    __device__ __forceinline__ bool next(int i, Unit& u) const { const long T = (long)i * G + c; if (T >= 128) return false; const int t = (int)(T >> 2); u.pm = 64 + (t >> 3); u.pn = t & 7; u.z = 1; u.k = (int)(T & 3);
        u.ao = ((long long)u.pm * BM * DM + u.k * 512) * 2; u.bo = ((long long)u.pn * BM * DM + u.k * 512) * 2; return true; }
    __device__ __forceinline__ void a_ready(const Unit&) const {}
    __device__ __forceinline__ void done(const Unit&) const {}
};
struct SchedMoe {
    int nPm, nPn, G, c, lda, ldb, nBrows;
    __device__ __forceinline__ bool next(int i, Unit& u) const { const long L = (long)i * G + c; const int per = nPm * nPn; if (L >= (long)NEXP * per) return false; const int e = (int)(L / per), rem = (int)(L % per);
        u.z = e; u.k = 0; u.pm = rem % nPm; u.pn = rem / nPm; u.ao = ((long long)e * MOE_PAD + u.pm * BM) * lda * 2; u.bo = ((long long)e * nBrows + u.pn * BM) * ldb * 2; return true; }
    __device__ __forceinline__ void a_ready(const Unit&) const {}
    __device__ __forceinline__ void done(const Unit&) const {}
};

typedef f32x4 Acc[2][2][4][2];
template <class Epi, class Sched>
__device__ __forceinline__ void gemm_phase(LAS unsigned char* lds, const Gemm g, const Sched& S, const Epi& E) {
    int tid = threadIdx.x; asm volatile("" : "+v"(tid));
    const int wid = __builtin_amdgcn_readfirstlane(tid >> 6), lane = tid & 63, wr = wid >> 2, wc = wid & 3, fr = lane & 15, fq = lane >> 4;
    const int K = g.K, nt = K / BK;
    unsigned voffA[2], voffB[2];
#pragma unroll
    for (int i = 0; i < 2; ++i) { int R, C; stage_rc(tid * 16 + i * 8192, R, C); const int Rb = Epi::PERM ? ((R & ~31) + perm32(R & 31)) : R;
        voffA[i] = (unsigned)(R * g.lda + C) * 2u; voffB[i] = (unsigned)(Rb * g.ldb + C) * 2u; }
    const size_t kstep = (size_t)(BK * 2);
    const size_t hstepA = (size_t)HALF * g.lda * 2, hstepB = (size_t)HALF * g.ldb * 2;
    const unsigned ldsw = (unsigned)wid * 1024u;
    const int aoff = lds_byte(wr * 64 + fr, fq * 8), boff = lds_byte(wc * 32 + fr, fq * 8);
#define PG8_SA(b, h) (((b) * 2 + (h)) * HTB)
#define PG8_SB(b, h) ((4 + (b) * 2 + (h)) * HTB)
#define PG8_STAGE(bufoff, gbase, voff) do { _Pragma("unroll") for (int _i = 0; _i < 2; ++_i) \
        __builtin_amdgcn_global_load_lds((const unsigned*)((const char*)(gbase) + (voff)[_i]), (LAS unsigned*)(lds + (bufoff) + ldsw + _i * 8192), 16, 0, 0); } while (0)
#define PG8_LDA(dst, b, h) do { _Pragma("unroll") for (int m = 0; m < 4; ++m) _Pragma("unroll") for (int k = 0; k < 2; ++k) dst[m][k] = *(const LAS bf16x8*)(lds + PG8_SA(b, h) + aoff + m * 2048 + k * 1024); } while (0)
#define PG8_LDB(dst, b, h) do { _Pragma("unroll") for (int n = 0; n < 2; ++n) _Pragma("unroll") for (int k = 0; k < 2; ++k) dst[n][k] = *(const LAS bf16x8*)(lds + PG8_SB(b, h) + boff + n * 2048 + k * 1024); } while (0)
#define PG8_MMA(ai, bj, At, Bt) do { __builtin_amdgcn_s_setprio(1); _Pragma("unroll") for (int m = 0; m < 4; ++m) _Pragma("unroll") for (int n = 0; n < 2; ++n) _Pragma("unroll") for (int k = 0; k < 2; ++k) \
        acc[ai][bj][m][n] = __builtin_amdgcn_mfma_f32_16x16x32_bf16(Bt[n][k], At[m][k], acc[ai][bj][m][n], 0, 0, 0); __builtin_amdgcn_s_setprio(0); } while (0)
#define PG8_WAIT_V(n) asm volatile("s_waitcnt vmcnt(" #n ")" ::: "memory")
#define PG8_WAIT_L(n) asm volatile("s_waitcnt lgkmcnt(" #n ")" ::: "memory")
#define PG8_BAR __builtin_amdgcn_s_barrier()
#define PG8_SCHED __builtin_amdgcn_sched_barrier(0)
    Unit cur, nxt; int ui = 0;
    if (!S.next(0, cur)) return;
    Acc acc;
#pragma unroll
    for (int a = 0; a < 2; ++a)
#pragma unroll
        for (int b = 0; b < 2; ++b)
#pragma unroll
            for (int m = 0; m < 4; ++m)
#pragma unroll
                for (int n = 0; n < 2; ++n) acc[a][b][m][n] = (f32x4){0.f, 0.f, 0.f, 0.f};
    bf16x8 At[4][2], B0[2][2], B1[2][2];
    const char* cA = (const char*)g.A + cur.ao; const char* cB = (const char*)g.Bt + cur.bo;
    S.a_ready(cur);
    PG8_STAGE(PG8_SB(0, 0), cB, voffB); PG8_STAGE(PG8_SA(0, 0), cA, voffA); PG8_STAGE(PG8_SB(0, 1), cB + hstepB, voffB); PG8_STAGE(PG8_SA(0, 1), cA + hstepA, voffA);
    if (wr == 1) PG8_BAR;
    PG8_WAIT_V(4); PG8_BAR;
    PG8_STAGE(PG8_SB(1, 0), cB + kstep, voffB); PG8_STAGE(PG8_SA(1, 0), cA + kstep, voffA); PG8_STAGE(PG8_SB(1, 1), cB + hstepB + kstep, voffB);
    PG8_WAIT_V(6); PG8_BAR;
    for (;;) {
        const bool has_next = S.next(ui + 1, nxt);
        const char* nA = has_next ? (const char*)g.A + nxt.ao : cA; const char* nB = has_next ? (const char*)g.Bt + nxt.bo : cB;
        for (int t = 0; t < nt; t += 2) {
            const bool last = (t == nt - 2);
            const char* a1 = cA + (size_t)(t + 1) * kstep;
            const char* a2 = last ? nA : cA + (size_t)(t + 2) * kstep; const char* b2 = last ? nB : cB + (size_t)(t + 2) * kstep;
            const char* a3 = a2 + kstep; const char* b3 = b2 + kstep;
            if (last && has_next) S.a_ready(nxt);
            PG8_LDB(B0, 0, 0); PG8_SCHED; PG8_LDA(At, 0, 0); PG8_STAGE(PG8_SA(1, 1), a1 + hstepA, voffA);
            PG8_WAIT_L(8); PG8_BAR; PG8_WAIT_L(0); PG8_MMA(0, 0, At, B0); PG8_BAR; PG8_SCHED;
            PG8_LDB(B1, 0, 1); PG8_STAGE(PG8_SB(0, 0), b2, voffB);
            PG8_BAR; PG8_WAIT_L(0); PG8_MMA(0, 1, At, B1); PG8_BAR;
            PG8_LDA(At, 0, 1); PG8_STAGE(PG8_SA(0, 0), a2, voffA);
            PG8_BAR; PG8_WAIT_L(0); PG8_MMA(1, 0, At, B0); PG8_BAR; PG8_SCHED;
            PG8_STAGE(PG8_SB(0, 1), b2 + hstepB, voffB);
            PG8_WAIT_V(6); PG8_BAR; PG8_MMA(1, 1, At, B1); PG8_BAR;
            PG8_LDB(B0, 1, 0); PG8_SCHED; PG8_LDA(At, 1, 0); PG8_STAGE(PG8_SA(0, 1), a2 + hstepA, voffA);
            PG8_WAIT_L(8); PG8_BAR; PG8_WAIT_L(0); PG8_MMA(0, 0, At, B0); PG8_BAR; PG8_SCHED;
            PG8_LDB(B1, 1, 1); PG8_STAGE(PG8_SB(1, 0), b3, voffB);
            PG8_BAR; PG8_WAIT_L(0); PG8_MMA(0, 1, At, B1); PG8_BAR;
            PG8_LDA(At, 1, 1); PG8_STAGE(PG8_SA(1, 0), a3, voffA);
            PG8_BAR; PG8_WAIT_L(0); PG8_MMA(1, 0, At, B0); PG8_BAR; PG8_SCHED;
            PG8_STAGE(PG8_SB(1, 1), b3 + hstepB, voffB);
            PG8_WAIT_V(6); PG8_BAR; PG8_MMA(1, 1, At, B1); PG8_BAR;
        }
        const bool keep = E(acc, cur, wr, wc, fr, fq); S.done(cur);
        if (!has_next) break;
        if (!keep) {
#pragma unroll
        for (int a = 0; a < 2; ++a)
#pragma unroll
            for (int b = 0; b < 2; ++b)
#pragma unroll
                for (int m = 0; m < 4; ++m)
#pragma unroll
                    for (int n = 0; n < 2; ++n) acc[a][b][m][n] = (f32x4){0.f, 0.f, 0.f, 0.f};
        }
        cur = nxt; cA = nA; cB = nB; ++ui;
    }
    PG8_WAIT_V(0);
    if (wr == 0) PG8_BAR;
    PG8_BAR;
#undef PG8_SA
#undef PG8_SB
#undef PG8_STAGE
#undef PG8_LDA
#undef PG8_LDB
#undef PG8_MMA
#undef PG8_WAIT_V
#undef PG8_WAIT_L
#undef PG8_BAR
#undef PG8_SCHED
}

struct EpiBf16Store {
    static constexpr bool PERM = true;
    bf16_t* O; int ldc;
    __device__ __forceinline__ bool operator()(Acc& acc, const Unit& u, int wr, int wc, int fr, int fq) const {
        const int row0 = u.pm * BM + wr * 64 + fr, col0 = u.pn * BM + wc * 32 + 8 * fq;
#pragma unroll
        for (int ai = 0; ai < 2; ++ai)
#pragma unroll
            for (int m = 0; m < 4; ++m) { bf16_t* rowp = O + (size_t)(row0 + ai * HALF + m * 16) * ldc + col0;
#pragma unroll
                for (int bj = 0; bj < 2; ++bj) { const f32x4 v0 = acc[ai][bj][m][0], v1 = acc[ai][bj][m][1];
                    u32x4 w; w.x = pk2(v0[0], v0[1]); w.y = pk2(v0[2], v0[3]); w.z = pk2(v1[0], v1[1]); w.w = pk2(v1[2], v1[3]);
                    *(u32x4*)(rowp + bj * HALF) = w; } }
        return false;
    }
};
struct EpiWin {
    static constexpr bool PERM = true;
    bf16_t* O; int ldc;
    __device__ __forceinline__ bool operator()(Acc& acc, const Unit& u, int wr, int wc, int fr, int fq) const {
        const int row0 = u.pm * BM + wr * 64 + fr, col0 = u.pn * BM + wc * 32 + 8 * fq;
#pragma unroll
        for (int bj = 0; bj < 2; ++bj) { const bool gate = (col0 + bj * HALF) >= GATE_OFF;
#pragma unroll
            for (int ai = 0; ai < 2; ++ai)
#pragma unroll
                for (int m = 0; m < 4; ++m) { f32x4 v0 = acc[ai][bj][m][0], v1 = acc[ai][bj][m][1];
                    if (gate) {
#pragma unroll
                        for (int j = 0; j < 4; ++j) { v0[j] = __builtin_amdgcn_rcpf(1.0f + __expf(-v0[j])); v1[j] = __builtin_amdgcn_rcpf(1.0f + __expf(-v1[j])); } }
                    u32x4 w; w.x = pk2(v0[0], v0[1]); w.y = pk2(v0[2], v0[3]); w.z = pk2(v1[0], v1[1]); w.w = pk2(v1[2], v1[3]);
                    *(u32x4*)(O + (size_t)(row0 + ai * HALF + m * 16) * ldc + col0 + bj * HALF) = w; } }
        return false;
    }
};
struct EpiNone { static constexpr bool PERM = true;
    __device__ __forceinline__ bool operator()(Acc& acc, const Unit&, int, int, int, int) const {
#pragma unroll
        for (int a = 0; a < 2; ++a)
#pragma unroll
            for (int b = 0; b < 2; ++b)
#pragma unroll
                for (int m = 0; m < 4; ++m)
#pragma unroll
                    for (int n = 0; n < 2; ++n) asm volatile("" :: "v"(acc[a][b][m][n]));
        return false; } };
struct EpiGlu {
    static constexpr bool PERM = true;
    const bf16_t* GG; const float* bias; bf16_t* Y4;
    __device__ __forceinline__ bool operator()(Acc& acc, const Unit& u, int wr, int wc, int fr, int fq) const {
        const int row0 = u.pm * BM + wr * 64 + fr, col0 = u.pn * BM + wc * 32 + 8 * fq;
#pragma unroll
        for (int bj = 0; bj < 2; ++bj) { const int col = col0 + bj * HALF; const f32x4 b0 = *(const f32x4*)(bias + col), b1 = *(const f32x4*)(bias + col + 4);
            u32x4 gq[2][4];
#pragma unroll
            for (int ai = 0; ai < 2; ++ai)
#pragma unroll
                for (int m = 0; m < 4; ++m) gq[ai][m] = *(const u32x4*)(GG + (size_t)(row0 + ai * HALF + m * 16) * BW + col);
#pragma unroll
            for (int ai = 0; ai < 2; ++ai)
#pragma unroll
                for (int m = 0; m < 4; ++m) { const size_t row = (size_t)(row0 + ai * HALF + m * 16);
                    float gg[8]; unpack8(gq[ai][m], gg);
                    const f32x4 v0 = acc[ai][bj][m][0] + b0, v1 = acc[ai][bj][m][1] + b1;
                    u32x4 w; w.x = pk2(gg[0] * sigmoidf_(v0[0]), gg[1] * sigmoidf_(v0[1])); w.y = pk2(gg[2] * sigmoidf_(v0[2]), gg[3] * sigmoidf_(v0[3]));
                    w.z = pk2(gg[4] * sigmoidf_(v1[0]), gg[5] * sigmoidf_(v1[1])); w.w = pk2(gg[6] * sigmoidf_(v1[2]), gg[7] * sigmoidf_(v1[3]));
                    *(u32x4*)(Y4 + row * DM + 1024 + col) = w; } }
        return false;
    }
};
struct EpiBranch {
    static constexpr bool PERM = true;
    const bf16_t* P; bf16_t* ACCb;
    __device__ __forceinline__ bool operator()(Acc& acc, const Unit& u, int wr, int wc, int fr, int fq) const {
        const int row0 = u.pm * BM + wr * 64 + fr, col0 = u.pn * BM + wc * 32 + 8 * fq; const int k = u.k;
        const bf16_t* gbase = P + (size_t)row0 * LDP + GATE_OFF + k * DM + col0;
        if (k < 3) {
#pragma unroll
            for (int ai = 0; ai < 2; ++ai) {
                u32x4 ga[8], gb[8];
#pragma unroll
                for (int m = 0; m < 4; ++m)
#pragma unroll
                    for (int bj = 0; bj < 2; ++bj) { const bf16_t* p = gbase + (size_t)(ai * HALF + m * 16) * LDP + bj * HALF; ga[m * 2 + bj] = *(const u32x4*)p; gb[m * 2 + bj] = *(const u32x4*)(p + DM); }
#pragma unroll
                for (int m = 0; m < 4; ++m)
#pragma unroll
                    for (int bj = 0; bj < 2; ++bj) { float g0[8], g1[8]; unpack8(ga[m * 2 + bj], g0); unpack8(gb[m * 2 + bj], g1);
                        float s[8];
#pragma unroll
                        for (int j = 0; j < 8; ++j) s[j] = g0[j] * __builtin_amdgcn_rcpf(g1[j]);
                        f32x4 v0 = acc[ai][bj][m][0], v1 = acc[ai][bj][m][1];
                        v0[0] *= s[0]; v0[1] *= s[1]; v0[2] *= s[2]; v0[3] *= s[3]; v1[0] *= s[4]; v1[1] *= s[5]; v1[2] *= s[6]; v1[3] *= s[7];
                        acc[ai][bj][m][0] = v0; acc[ai][bj][m][1] = v1; } }
            return true;
        }
#pragma unroll
        for (int ai = 0; ai < 2; ++ai) {
            u32x4 ga[8];
#pragma unroll
            for (int m = 0; m < 4; ++m)
#pragma unroll
                for (int bj = 0; bj < 2; ++bj) ga[m * 2 + bj] = *(const u32x4*)(gbase + (size_t)(ai * HALF + m * 16) * LDP + bj * HALF);
#pragma unroll
            for (int m = 0; m < 4; ++m)
#pragma unroll
                for (int bj = 0; bj < 2; ++bj) { float s[8]; unpack8(ga[m * 2 + bj], s);
                    f32x4 v0 = acc[ai][bj][m][0], v1 = acc[ai][bj][m][1];
                    v0[0] *= s[0]; v0[1] *= s[1]; v0[2] *= s[2]; v0[3] *= s[3]; v1[0] *= s[4]; v1[1] *= s[5]; v1[2] *= s[6]; v1[3] *= s[7];
                    u32x4 w; w.x = pk2(v0[0], v0[1]); w.y = pk2(v0[2], v0[3]); w.z = pk2(v1[0], v1[1]); w.w = pk2(v1[2], v1[3]);
                    *(u32x4*)(ACCb + (size_t)(row0 + ai * HALF + m * 16) * DM + col0 + bj * HALF) = w; } }
        return false;
    }
};
struct EpiPart {
    static constexpr bool PERM = true;
    const bf16_t* P; float* PART;
    __device__ __forceinline__ bool operator()(Acc& acc, const Unit& u, int wr, int wc, int fr, int fq) const {
        const int row0 = u.pm * BM + wr * 64 + fr, col0 = u.pn * BM + wc * 32 + 8 * fq; const int k = u.k;
        const bf16_t* gbase = P + (size_t)row0 * LDP + GATE_OFF + k * DM + col0;
        float* pbase = PART + ((size_t)k * (NTOK - NLAT) + (size_t)(row0 - NLAT)) * DM + col0;
#pragma unroll
        for (int ai = 0; ai < 2; ++ai) {
            u32x4 ga[8];
#pragma unroll
            for (int m = 0; m < 4; ++m)
#pragma unroll
                for (int bj = 0; bj < 2; ++bj) ga[m * 2 + bj] = *(const u32x4*)(gbase + (size_t)(ai * HALF + m * 16) * LDP + bj * HALF);
#pragma unroll
            for (int m = 0; m < 4; ++m)
#pragma unroll
                for (int bj = 0; bj < 2; ++bj) { float sg[8]; unpack8(ga[m * 2 + bj], sg);
                    f32x4 v0 = acc[ai][bj][m][0], v1 = acc[ai][bj][m][1];
                    v0[0] *= sg[0]; v0[1] *= sg[1]; v0[2] *= sg[2]; v0[3] *= sg[3]; v1[0] *= sg[4]; v1[1] *= sg[5]; v1[2] *= sg[6]; v1[3] *= sg[7];
                    float* pp = pbase + (size_t)(ai * HALF + m * 16) * DM + bj * HALF;
                    *(f32x4*)pp = v0; *(f32x4*)(pp + 4) = v1; } }
        return false;
    }
};
struct EpiPartK {
    static constexpr bool PERM = true;
    float* PART;
    __device__ __forceinline__ bool operator()(Acc& acc, const Unit& u, int wr, int wc, int fr, int fq) const {
        const int row0 = u.pm * BM + wr * 64 + fr, col0 = u.pn * BM + wc * 32 + 8 * fq;
        float* pbase = PART + ((size_t)u.k * (NTOK - NLAT) + (size_t)(row0 - NLAT)) * DM + col0;
#pragma unroll
        for (int ai = 0; ai < 2; ++ai)
#pragma unroll
            for (int m = 0; m < 4; ++m)
#pragma unroll
                for (int bj = 0; bj < 2; ++bj) { float* pp = pbase + (size_t)(ai * HALF + m * 16) * DM + bj * HALF; *(f32x4*)pp = acc[ai][bj][m][0]; *(f32x4*)(pp + 4) = acc[ai][bj][m][1]; }
        return false;
    }
};
struct EpiResid {
    static constexpr bool PERM = false;
    float* XS; const float* srcLat; const float* srcCtx; const float* MODl; int gidx;
    __device__ __forceinline__ bool operator()(Acc& acc, const Unit& u, int wr, int wc, int fr, int fq) const {
        const int row0 = u.pm * BM + wr * 64 + fr, col0 = u.pn * BM + wc * 32 + 4 * fq;
        const int r = (u.pm * BM) < NLAT ? (u.pm * BM) / SEQ : 4;
        const float* src = (u.pm * BM) < NLAT ? srcLat : srcCtx;
        const float* mg = MODl + (size_t)(r * 6 + gidx) * DM;
#pragma unroll
        for (int bj = 0; bj < 2; ++bj) {
            f32x4 gm[2], xs[2][2][4];
#pragma unroll
            for (int n = 0; n < 2; ++n) { const int col = col0 + bj * HALF + n * 16; gm[n] = *(const f32x4*)(mg + col);
#pragma unroll
                for (int ai = 0; ai < 2; ++ai)
#pragma unroll
                    for (int m = 0; m < 4; ++m) xs[n][ai][m] = *(const f32x4*)(src + (size_t)(row0 + ai * HALF + m * 16) * DM + col); }
#pragma unroll
            for (int n = 0; n < 2; ++n) { const int col = col0 + bj * HALF + n * 16;
#pragma unroll
                for (int ai = 0; ai < 2; ++ai)
#pragma unroll
                    for (int m = 0; m < 4; ++m) *(f32x4*)(XS + (size_t)(row0 + ai * HALF + m * 16) * DM + col) = xs[n][ai][m] + gm[n] * acc[ai][bj][m][n]; } }
        return false;
    }
};
struct EpiMoe1 {
    static constexpr bool PERM = true;
    bf16_t* HID;
    __device__ __forceinline__ bool operator()(Acc& acc, const Unit& u, int wr, int wc, int fr, int fq) const {
        const size_t row0 = (size_t)u.z * MOE_PAD + u.pm * BM + wr * 64 + fr; const int col0 = u.pn * HALF + wc * 32 + 8 * fq;
#pragma unroll
        for (int ai = 0; ai < 2; ++ai)
#pragma unroll
            for (int m = 0; m < 4; ++m) { const f32x4 g0 = acc[ai][0][m][0], g1 = acc[ai][0][m][1], u0 = acc[ai][1][m][0], u1 = acc[ai][1][m][1];
                float h[8];
#pragma unroll
                for (int j = 0; j < 4; ++j) { h[j] = g0[j] * __builtin_amdgcn_rcpf(1.0f + __expf(-g0[j])) * u0[j]; h[4 + j] = g1[j] * __builtin_amdgcn_rcpf(1.0f + __expf(-g1[j])) * u1[j]; }
                u32x4 w; w.x = pk2(h[0], h[1]); w.y = pk2(h[2], h[3]); w.z = pk2(h[4], h[5]); w.w = pk2(h[6], h[7]);
                *(u32x4*)(HID + (row0 + ai * HALF + m * 16) * DEXP + col0) = w; }
        return false;
    }
};
struct EpiMoeY {
    static constexpr bool PERM = true;
    bf16_t* O;
    __device__ __forceinline__ bool operator()(Acc& acc, const Unit& u, int wr, int wc, int fr, int fq) const {
        const size_t row0 = (size_t)u.z * MOE_PAD + u.pm * BM + wr * 64 + fr; const int col0 = u.pn * BM + wc * 32 + 8 * fq;
#pragma unroll
        for (int ai = 0; ai < 2; ++ai)
#pragma unroll
            for (int m = 0; m < 4; ++m) { bf16_t* rowp = O + (row0 + ai * HALF + m * 16) * DM + col0;
#pragma unroll
                for (int bj = 0; bj < 2; ++bj) { const f32x4 v0 = acc[ai][bj][m][0], v1 = acc[ai][bj][m][1];
                    u32x4 w; w.x = pk2(v0[0], v0[1]); w.y = pk2(v0[2], v0[3]); w.z = pk2(v1[0], v1[1]); w.w = pk2(v1[2], v1[3]);
                    *(u32x4*)(rowp + bj * HALF) = w; } }
        return false;
    }
};

struct SchedS5a {
    int c;
    __device__ __forceinline__ bool next(int i, Unit& u) const { if (i > 0 || c >= 64) return false; u.z = c >> 1; u.pm = c & 1; u.pn = 0; u.k = 0;
        u.ao = ((long long)u.z * 512 + u.pm * BM) * 768 * 2; u.bo = (long long)u.z * 256 * 512 * 2; return true; }
    __device__ __forceinline__ void a_ready(const Unit&) const {}
    __device__ __forceinline__ void done(const Unit&) const {}
};
struct SchedS5b {
    int c;
    __device__ __forceinline__ bool next(int i, Unit& u) const { if (i > 0 || c >= 128) return false; u.z = c >> 2; u.pm = (c >> 1) & 1; u.pn = c & 1; u.k = 0;
        u.ao = ((long long)u.z * 512 + u.pm * BM) * 768 * 2; u.bo = ((long long)u.z * 512 + u.pn * BM) * 768 * 2; return true; }
    __device__ __forceinline__ void a_ready(const Unit&) const {}
    __device__ __forceinline__ void done(const Unit&) const {}
};
struct EpiXloc {
    static constexpr bool PERM = false;
    float* XL;
    __device__ __forceinline__ bool operator()(Acc& acc, const Unit& u, int wr, int wc, int fr, int fq) const {
        const int row0 = u.pm * BM + wr * 64 + fr, col0 = wc * 32 + 4 * fq; float* base = XL + (size_t)u.z * 512 * 256;
#pragma unroll
        for (int ai = 0; ai < 2; ++ai)
#pragma unroll
            for (int m = 0; m < 4; ++m) { float* rowp = base + (size_t)(row0 + ai * HALF + m * 16) * 256 + col0;
#pragma unroll
                for (int bj = 0; bj < 2; ++bj)
#pragma unroll
                    for (int n = 0; n < 2; ++n) *(f32x4*)(rowp + bj * HALF + n * 16) = acc[ai][bj][m][n]; }
        return false;
    }
};
struct EpiS5Out {
    static constexpr bool PERM = true;
    const bf16_t* P; const float* dskip; bf16_t* GG;
    __device__ __forceinline__ bool operator()(Acc& acc, const Unit& u, int wr, int wc, int fr, int fq) const {
        const int row0 = u.pm * BM + wr * 64 + fr, col0 = u.pn * BM + wc * 32 + 8 * fq; const int g = u.z;
#pragma unroll
        for (int bj = 0; bj < 2; ++bj) { const int col = col0 + bj * HALF; const int t = col >> 4, c0 = col & 15;
            const f32x4 d0 = *(const f32x4*)(dskip + g * 16 + c0), d1 = *(const f32x4*)(dskip + g * 16 + c0 + 4);
            u32x4 uq[2][4];
#pragma unroll
            for (int ai = 0; ai < 2; ++ai)
#pragma unroll
                for (int m = 0; m < 4; ++m) uq[ai][m] = *(const u32x4*)(P + ((size_t)(row0 + ai * HALF + m * 16) * 32 + t) * LDP + S5_OFF + g * 16 + c0);
#pragma unroll
            for (int ai = 0; ai < 2; ++ai)
#pragma unroll
                for (int m = 0; m < 4; ++m) { const size_t tok = (size_t)(row0 + ai * HALF + m * 16) * 32 + t;
                    float uu[8]; unpack8(uq[ai][m], uu);
                    const f32x4 v0 = acc[ai][bj][m][0], v1 = acc[ai][bj][m][1];
                    float y[8] = {v0[0] + d0[0] * uu[0], v0[1] + d0[1] * uu[1], v0[2] + d0[2] * uu[2], v0[3] + d0[3] * uu[3], v1[0] + d1[0] * uu[4], v1[1] + d1[1] * uu[5], v1[2] + d1[2] * uu[6], v1[3] + d1[3] * uu[7]};
#pragma unroll
                    for (int j = 0; j < 8; ++j) y[j] = 0.5f * y[j] * (1.0f + tanhf(0.7978845608028654f * (y[j] + 0.044715f * y[j] * y[j] * y[j])));
                    u32x4 w; w.x = pk2(y[0], y[1]); w.y = pk2(y[2], y[3]); w.z = pk2(y[4], y[5]); w.w = pk2(y[6], y[7]);
                    *(u32x4*)(GG + tok * BW + g * 16 + c0) = w; } }
        return false;
    }
};
}


__device__ __forceinline__ float wave_scan_incl(float v, int lane) {
#pragma unroll
    for (int o = 1; o < 64; o <<= 1) { const float t = __shfl_up(v, o); if (lane >= o) v += t; }
    return v;
}
__device__ __forceinline__ float wave_scanmax_incl(float v, int lane) {
#pragma unroll
    for (int o = 1; o < 64; o <<= 1) { const float t = __shfl_up(v, o); if (lane >= o) v = fmaxf(v, t); }
    return v;
}
__device__ __forceinline__ float wave_max(float v) {
#pragma unroll
    for (int o = 32; o >= 1; o >>= 1) v = fmaxf(v, __shfl_xor(v, o));
    return v;
}
__device__ __forceinline__ void unpack8h(const u32x4 w, bf16_t (&h)[8]) {
    h[0] = (bf16_t)(w.x & 0xFFFFu); h[1] = (bf16_t)(w.x >> 16); h[2] = (bf16_t)(w.y & 0xFFFFu); h[3] = (bf16_t)(w.y >> 16);
    h[4] = (bf16_t)(w.z & 0xFFFFu); h[5] = (bf16_t)(w.z >> 16); h[6] = (bf16_t)(w.w & 0xFFFFu); h[7] = (bf16_t)(w.w >> 16);
}

__device__ __forceinline__ int tokblock_of(int b, int dir, int c) { if (c < 4) return 256 + b * 4 + (dir ? 3 - c : c); const int j = c - 4; return b * 64 + (dir ? 63 - j : j); }
__device__ __forceinline__ u32x4 rev8h(const u32x4 v) { u32x4 r; r.x = (v.w >> 16) | (v.w << 16); r.y = (v.z >> 16) | (v.z << 16); r.z = (v.y >> 16) | (v.y << 16); r.w = (v.x >> 16) | (v.x << 16); return r; }
__device__ __forceinline__ u32x4 scale8h(const u32x4 v, const float4 a, const float4 b) { float f[8]; unpack8(v, f); u32x4 r; r.x = pk2(f[0] * a.x, f[1] * a.y); r.y = pk2(f[2] * a.z, f[3] * a.w); r.z = pk2(f[4] * b.x, f[5] * b.y); r.w = pk2(f[6] * b.z, f[7] * b.w); return r; }
__device__ __forceinline__ float dot8h(const u32x4 v, const float4 a, const float4 b) { float f[8]; unpack8(v, f); return (f[0] * a.x + f[1] * a.y) + (f[2] * a.z + f[3] * a.w) + (f[4] * b.x + f[5] * b.y) + (f[6] * b.z + f[7] * b.w); }
#define ML_FRAG_LOAD(KF, VF, cc_) do { const int tb_ = tokblock_of(b, dir, (cc_)); const bf16_t* kb_ = KTg + ((size_t)tb_ * 512 + h * 128 + 32 * wd + r16) * 64 + q4 * 8; const bf16_t* vb_ = VTg + ((size_t)tb_ * 512 + h * 128 + 64 * half + 32 * we + r16) * 64 + q4 * 8; \
        _Pragma("unroll") for (int ks_ = 0; ks_ < 2; ++ks_) _Pragma("unroll") for (int j_ = 0; j_ < 2; ++j_) { VF[j_][ks_] = *(const u32x4*)(vb_ + (size_t)j_ * 16 * 64 + ks_ * 32); KF[j_][ks_] = *(const u32x4*)(kb_ + (size_t)j_ * 16 * 64 + ks_ * 32); } } while (0)
#define ML_CHUNK(c_, KF, VF, KFN, VFN) do { const int c = (c_); \
        if (c + 1 < 68) ML_FRAG_LOAD(KFN, VFN, c + 1);                        \
        const float dec = sDEC[c]; \
        {   bf16_t* cs = CST + (size_t)(chain * 68 + c) * 128 * 128; \
            _Pragma("unroll") for (int je = 0; je < 2; ++je) _Pragma("unroll") for (int jd = 0; jd < 2; ++jd) { const int e = 64 * half + 32 * we + 16 * je + r16, d0 = 32 * wd + 16 * jd + q4 * 4; \
                u32x2 pk; pk.x = pk2(acc[je][jd][0], acc[je][jd][1]); pk.y = pk2(acc[je][jd][2], acc[je][jd][3]); *(u32x2*)(cs + (size_t)e * 128 + d0) = pk; } \
            if (nown) { _Pragma("unroll") for (int jd = 0; jd < 2; ++jd) { float nv = npart[jd]; nv += __shfl_xor(nv, 16); nv += __shfl_xor(nv, 32); if (q4 == 0) NST[(size_t)(chain * 68 + c) * 128 + 32 * wd + 16 * jd + r16] = nv; } } } \
        bf16x8 vfr[2][2]; \
        _Pragma("unroll") for (int ks = 0; ks < 2; ++ks) { const float4 wa = *(const float4*)(sWS + c * 64 + ks * 32 + q4 * 8), wb = *(const float4*)(sWS + c * 64 + ks * 32 + q4 * 8 + 4); \
            _Pragma("unroll") for (int je = 0; je < 2; ++je) { const u32x4 sv = scale8h(VF[je][ks], wa, wb); vfr[je][ks] = *(const bf16x8*)&sv; } \
            if (nown) { _Pragma("unroll") for (int jd = 0; jd < 2; ++jd) npart[jd] = (ks == 0 ? dec * npart[jd] : npart[jd]) + dot8h(KF[jd][ks], wa, wb); } } \
        _Pragma("unroll") for (int je = 0; je < 2; ++je) _Pragma("unroll") for (int jd = 0; jd < 2; ++jd) acc[je][jd] = acc[je][jd] * dec; \
        _Pragma("unroll") for (int ks = 0; ks < 2; ++ks) _Pragma("unroll") for (int je = 0; je < 2; ++je) _Pragma("unroll") for (int jd = 0; jd < 2; ++jd) \
            acc[je][jd] = __builtin_amdgcn_mfma_f32_16x16x32_bf16(*(const bf16x8*)&KF[jd][ks], vfr[je][ks], acc[je][jd], 0, 0, 0); } while (0)
__device__ __forceinline__ void mlstm_state_pass(const int chain, const int half, const bf16_t* __restrict__ Pm, const bf16_t* __restrict__ KTg, const bf16_t* __restrict__ VTg, const float* __restrict__ gate_b,
                                                 bf16_t* __restrict__ CST, float* __restrict__ NST, float* __restrict__ MST, unsigned char* shm, const int tid) {
    const int dir = chain & 1, h = (chain >> 1) & 3, b = chain >> 3, lane = tid & 63, w = tid >> 6, we = w >> 2, wd = w & 3, q4 = lane >> 4, r16 = lane & 15;
    const bool nown = (half == 0) && (we == 0);
    float* sE = (float*)shm; float* sWS = sE + 68 * 64; float* sAL = sWS + 68 * 64; float* sBE = sAL + 68; float* sMO = sBE + 68; float* sDEC = sMO + 68; float* sMB = sDEC + 68;
    const float gbi = gate_b[(dir * 2 + 0) * 4 + h], gbf = gate_b[(dir * 2 + 1) * 4 + h];
    const int gcol_i = ML_OFF + 2048 + (dir * 2 + 0) * 4 + h, gcol_f = ML_OFF + 2048 + (dir * 2 + 1) * 4 + h;
    u32x4 kfA[2][2], vfA[2][2], kfB[2][2], vfB[2][2];
    ML_FRAG_LOAD(kfA, vfA, 0);
    __syncthreads();
    unsigned gi_[9], gf_[9];
#pragma unroll
    for (int q = 0; q < 9; ++q) { const int c = min(w + 8 * q, 67); const size_t tokl = (size_t)step_tok(b, dir, c * 64 + lane); gi_[q] = Pm[tokl * LDP + gcol_i]; gf_[q] = Pm[tokl * LDP + gcol_f]; }
#pragma unroll
    for (int q = 0; q < 9; ++q) { const int c = w + 8 * q; if (c >= 68) break;
        const float ig = __uint_as_float(gi_[q] << 16) + gbi, fg = __uint_as_float(gf_[q] << 16) + gbf;
        const float lf = fminf(fg, 0.f) - log1pf(expf(-fabsf(fg)));
        const float bcs = wave_scan_incl(lf, lane); const float blast = __shfl(bcs, 63); const float ei = blast - bcs + ig; const float beta = wave_max(ei);
        sE[c * 64 + lane] = ei; if (lane == 0) { sAL[c] = blast; sBE[c] = beta; } }
    __syncthreads();
    if (tid == 0) { float m = 0.f; for (int c = 0; c < 68; ++c) { sMB[c] = m; const float mo = fmaxf(m + sAL[c], sBE[c]); sDEC[c] = expf(sAL[c] + m - mo); sMO[c] = mo; m = mo; } }
    __syncthreads();
    for (int idx = tid; idx < 68 * 64; idx += NTHR) { const int c = idx >> 6, i = idx & 63; sWS[c * 64 + (dir ? 63 - i : i)] = expf(sE[idx] - sMO[c]); }
    if (half == 0 && tid < 68) MST[chain * 68 + tid] = sMB[tid];
    __syncthreads();
    f32x4 acc[2][2];
#pragma unroll
    for (int je = 0; je < 2; ++je)
#pragma unroll
        for (int jd = 0; jd < 2; ++jd) acc[je][jd] = (f32x4){0.f, 0.f, 0.f, 0.f};
    float npart[2] = {0.f, 0.f};
    for (int c2 = 0; c2 < 68; c2 += 2) { ML_CHUNK(c2, kfA, vfA, kfB, vfB); ML_CHUNK(c2 + 1, kfB, vfB, kfA, vfA); }
    __syncthreads();
}
#undef ML_CHUNK
#undef ML_FRAG_LOAD
__device__ __forceinline__ void mlstm_out_item(const int chain, const int c, const bf16_t* __restrict__ Pm, const bf16_t* __restrict__ QKb, const bf16_t* __restrict__ VTg, const float* __restrict__ gate_b,
                                               const bf16_t* __restrict__ CST, const float* __restrict__ NST, const float* __restrict__ MST, bf16_t* __restrict__ Hout, unsigned char* shm, const int tid) {
    const int dir = chain & 1, h = (chain >> 1) & 3, b = chain >> 3, lane = tid & 63, w = tid >> 6;
    bf16_t* Qs = (bf16_t*)shm; bf16_t* Ks = (bf16_t*)(shm + 17408); bf16_t* VT = (bf16_t*)(shm + 34816); bf16_t* Cs = (bf16_t*)(shm + 53248); bf16_t* Ss = (bf16_t*)(shm + 88064);
    float* sc = (float*)(shm + 97280);
    __syncthreads();
    u32x4 gq[2], gk[2], gv[2], gc[4]; float gn = 0.f;
#pragma unroll
    for (int i = 0; i < 2; ++i) { const int pid = tid + i * 512; const int s = pid >> 4, x0 = (pid & 15) * 8; const size_t toks = (size_t)step_tok(b, dir, c * 64 + s);
        gq[i] = *(const u32x4*)(QKb + toks * 1024 + h * 128 + x0);
        gk[i] = *(const u32x4*)(QKb + toks * 1024 + 512 + h * 128 + x0);
        { const int e = pid >> 3, o = pid & 7;
          gv[i] = *(const u32x4*)(VTg + ((size_t)tokblock_of(b, dir, c) * 512 + h * 128 + e) * 64 + (dir ? 7 - o : o) * 8); } }
#pragma unroll
    for (int i = 0; i < 4; ++i) { const int pid = tid + i * 512; const int e = pid >> 4, x0 = (pid & 15) * 8;
        gc[i] = *(const u32x4*)(CST + ((size_t)(chain * 68 + c) * 128 + e) * 128 + x0); }
    if (tid < 128) gn = NST[(size_t)(chain * 68 + c) * 128 + tid];
    unsigned gi_ = 0u, gf_ = 0u; float gbi = 0.f, gbf = 0.f, m_in = 0.f;
    if (w == 0) { const size_t tokl = (size_t)step_tok(b, dir, c * 64 + lane);
        gi_ = Pm[tokl * LDP + ML_OFF + 2048 + (dir * 2 + 0) * 4 + h]; gf_ = Pm[tokl * LDP + ML_OFF + 2048 + (dir * 2 + 1) * 4 + h];
        gbi = gate_b[(dir * 2 + 0) * 4 + h]; gbf = gate_b[(dir * 2 + 1) * 4 + h]; m_in = MST[chain * 68 + c]; }
#pragma unroll
    for (int i = 0; i < 2; ++i) { const int pid = tid + i * 512; const int s = pid >> 4, x0 = (pid & 15) * 8;
        *(u32x4*)(Qs + s * 136 + x0) = gq[i]; *(u32x4*)(Ks + s * 136 + x0) = gk[i];
        { const int e = pid >> 3, o = pid & 7; *(u32x4*)(VT + e * 72 + o * 8) = dir ? rev8h(gv[i]) : gv[i]; } }
#pragma unroll
    for (int i = 0; i < 4; ++i) { const int pid = tid + i * 512; const int e = pid >> 4, x0 = (pid & 15) * 8; *(u32x4*)(Cs + e * 136 + x0) = gc[i]; }
    if (tid < 128) sc[384 + tid] = gn;
    if (w == 0) {
        const float ig = __uint_as_float(gi_ << 16) + gbi;
        const float fg = __uint_as_float(gf_ << 16) + gbf;
        const float lf = fminf(fg, 0.f) - log1pf(expf(-fabsf(fg)));
        const float bcs = wave_scan_incl(lf, lane); const float gsv = ig - bcs; const float pm = wave_scanmax_incl(gsv, lane);
        const float mt = bcs + fmaxf(m_in, pm);
        sc[lane] = bcs; sc[64 + lane] = gsv; sc[128 + lane] = mt; sc[192 + lane] = expf(bcs + m_in - mt); sc[256 + lane] = expf(-mt);
    }
    __syncthreads();
    const int tt = w >> 1;
    {   f32x4 aS[2] = {(f32x4){0.f, 0.f, 0.f, 0.f}, (f32x4){0.f, 0.f, 0.f, 0.f}};
#pragma unroll
        for (int ks = 0; ks < 4; ++ks) { const bf16x8 af = *(const bf16x8*)(Qs + (16 * tt + (lane & 15)) * 136 + ks * 32 + (lane >> 4) * 8);
#pragma unroll
            for (int i = 0; i < 2; ++i) { const int st = (w & 1) * 2 + i; const bf16x8 bfr = *(const bf16x8*)(Ks + (16 * st + (lane & 15)) * 136 + ks * 32 + (lane >> 4) * 8);
                aS[i] = __builtin_amdgcn_mfma_f32_16x16x32_bf16(af, bfr, aS[i], 0, 0, 0); } }
        float rs[4] = {0.f, 0.f, 0.f, 0.f};
#pragma unroll
        for (int i = 0; i < 2; ++i) { const int s = 16 * ((w & 1) * 2 + i) + (lane & 15); const float gsv = sc[64 + s];
#pragma unroll
            for (int q = 0; q < 4; ++q) { const int t = 16 * tt + (lane >> 4) * 4 + q; const float val = (s <= t) ? aS[i][q] * expf(sc[t] + gsv - sc[128 + t]) : 0.f; Ss[t * 72 + s] = f2bf(val); rs[q] += val; } }
#pragma unroll
        for (int q = 0; q < 4; ++q) { float r = rs[q]; r += __shfl_xor(r, 1); r += __shfl_xor(r, 2); r += __shfl_xor(r, 4); r += __shfl_xor(r, 8);
            if ((lane & 15) == 0) sc[512 + (w & 1) * 64 + 16 * tt + (lane >> 4) * 4 + q] = r; }
        {   const int t = tid >> 3, part = tid & 7; float dot = 0.f;
#pragma unroll
            for (int j = 0; j < 16; ++j) dot += bf2f(Qs[t * 136 + part * 16 + j]) * sc[384 + part * 16 + j];
            dot += __shfl_xor(dot, 1); dot += __shfl_xor(dot, 2); dot += __shfl_xor(dot, 4);
            if (part == 0) sc[640 + t] = sc[192 + t] * dot; }
    }
    __syncthreads();
    {   f32x4 aN[4];
#pragma unroll
        for (int i = 0; i < 4; ++i) aN[i] = (f32x4){0.f, 0.f, 0.f, 0.f};
#pragma unroll
        for (int ks = 0; ks < 4; ++ks) { const bf16x8 af = *(const bf16x8*)(Qs + (16 * tt + (lane & 15)) * 136 + ks * 32 + (lane >> 4) * 8);
#pragma unroll
            for (int i = 0; i < 4; ++i) { const int et = (w & 1) * 4 + i; const bf16x8 bfr = *(const bf16x8*)(Cs + (16 * et + (lane & 15)) * 136 + ks * 32 + (lane >> 4) * 8);
                aN[i] = __builtin_amdgcn_mfma_f32_16x16x32_bf16(bfr, af, aN[i], 0, 0, 0); } }
        const int t = 16 * tt + (lane & 15);
        {   const float it = sc[192 + t];
#pragma unroll
            for (int i = 0; i < 4; ++i) { aN[i][0] *= it; aN[i][1] *= it; aN[i][2] *= it; aN[i][3] *= it; } }
#pragma unroll
        for (int ks = 0; ks < 2; ++ks) { const bf16x8 af = *(const bf16x8*)(Ss + (16 * tt + (lane & 15)) * 72 + ks * 32 + (lane >> 4) * 8);
#pragma unroll
            for (int i = 0; i < 4; ++i) { const int et = (w & 1) * 4 + i; const bf16x8 bfr = *(const bf16x8*)(VT + (16 * et + (lane & 15)) * 72 + ks * 32 + (lane >> 4) * 8);
                aN[i] = __builtin_amdgcn_mfma_f32_16x16x32_bf16(bfr, af, aN[i], 0, 0, 0); } }
        {   const size_t tokt = (size_t)step_tok(b, dir, c * 64 + t); const float dn = fmaxf(fabsf((sc[512 + t] + sc[576 + t]) + sc[640 + t]), sc[256 + t]);
#pragma unroll
            for (int i = 0; i < 4; ++i) { const int e0 = 16 * ((w & 1) * 4 + i) + (lane >> 4) * 4;
                u32x2 wv; wv.x = pk2(aN[i][0] / dn, aN[i][1] / dn); wv.y = pk2(aN[i][2] / dn, aN[i][3] / dn);
                *(u32x2*)(Hout + tokt * BW + h * 128 + e0) = wv; } }
    }
}


#define SD_FRAG_LOAD(BF, XF, cc_) do { const int tb_ = tokblock_of(b, dir, (cc_)); const bf16_t* bb_ = BTg + ((size_t)tb_ * 256 + grp * 128 + 64 * (w >> 2) + r16) * 64 + q4 * 8; const bf16_t* xb_ = XTg + ((size_t)tb_ * 512 + h * 64 + 16 * (w & 3) + r16) * 64 + q4 * 8; \
        _Pragma("unroll") for (int ks_ = 0; ks_ < 2; ++ks_) { XF[ks_] = *(const u32x4*)(xb_ + ks_ * 32); _Pragma("unroll") for (int j_ = 0; j_ < 4; ++j_) BF[j_][ks_] = *(const u32x4*)(bb_ + (size_t)j_ * 16 * 64 + ks_ * 32); } } while (0)
#define SD_CHUNK(c_, BF, XF, BFN, XFN) do { const int c = (c_); \
        if (c + 1 < 68) SD_FRAG_LOAD(BFN, XFN, c + 1); \
        const float dec = sDEC[c]; \
        {   bf16_t* ss = SSTb + (size_t)(chain * 68 + c) * 64 * 128; const int p = 16 * (w & 3) + r16; \
            _Pragma("unroll") for (int j = 0; j < 4; ++j) { const int n0 = 16 * ((w >> 2) * 4 + j) + q4 * 4; u32x2 pk; pk.x = pk2(acc[j][0], acc[j][1]); pk.y = pk2(acc[j][2], acc[j][3]); *(u32x2*)(ss + (size_t)p * 128 + n0) = pk; } } \
        bf16x8 xfr[2]; \
        _Pragma("unroll") for (int ks = 0; ks < 2; ++ks) { const float4 wa = *(const float4*)(sSC + c * 64 + ks * 32 + q4 * 8), wb = *(const float4*)(sSC + c * 64 + ks * 32 + q4 * 8 + 4); const u32x4 sv = scale8h(XF[ks], wa, wb); xfr[ks] = *(const bf16x8*)&sv; } \
        _Pragma("unroll") for (int j = 0; j < 4; ++j) acc[j] = acc[j] * dec; \
        _Pragma("unroll") for (int ks = 0; ks < 2; ++ks) _Pragma("unroll") for (int j = 0; j < 4; ++j) acc[j] = __builtin_amdgcn_mfma_f32_16x16x32_bf16(*(const bf16x8*)&BF[j][ks], xfr[ks], acc[j], 0, 0, 0); } while (0)
__device__ __forceinline__ void ssd_state_pass(const int chain, const bf16_t* __restrict__ Pm, const bf16_t* __restrict__ BTg, const bf16_t* __restrict__ XTg, const float Aa, const float dtb,
                                               bf16_t* __restrict__ SSTb, unsigned char* shm, const int tid) {
    const int dir = chain & 1, h = (chain >> 1) & 7, b = chain >> 4, grp = h >> 2, lane = tid & 63, w = tid >> 6, q4 = lane >> 4, r16 = lane & 15;
    float* sSC = (float*)shm; float* sDEC = sSC + 68 * 64;
    const int dcol = SSD_OFF + 1536 + dir * 8 + h;
    u32x4 bfA[4][2], xfA[2], bfB[4][2], xfB[2];
    SD_FRAG_LOAD(bfA, xfA, 0);
    __syncthreads();
    unsigned dt_[9];
#pragma unroll
    for (int q = 0; q < 9; ++q) { const int c = min(w + 8 * q, 67); dt_[q] = Pm[(size_t)step_tok(b, dir, c * 64 + lane) * LDP + dcol]; }
#pragma unroll
    for (int q = 0; q < 9; ++q) { const int c = w + 8 * q; if (c >= 68) break;
        const float xv = __uint_as_float(dt_[q] << 16) + dtb; const float dtv = xv > 20.f ? xv : log1pf(expf(xv));
        const float cs = wave_scan_incl(dtv * Aa, lane); const float cl = __shfl(cs, 63);
        sSC[c * 64 + (dir ? 63 - lane : lane)] = dtv * expf(cl - cs); if (lane == 0) sDEC[c] = expf(cl); }
    __syncthreads();
    f32x4 acc[4];
#pragma unroll
    for (int j = 0; j < 4; ++j) acc[j] = (f32x4){0.f, 0.f, 0.f, 0.f};
    for (int c2 = 0; c2 < 68; c2 += 2) { SD_CHUNK(c2, bfA, xfA, bfB, xfB); SD_CHUNK(c2 + 1, bfB, xfB, bfA, xfA); }
    __syncthreads();
}
#undef SD_CHUNK
#undef SD_FRAG_LOAD
__device__ __forceinline__ void ssd_out_item(const int chain, const int c, const bf16_t* __restrict__ Pm, const bf16_t* __restrict__ XBb, const bf16_t* __restrict__ XTg, const float Aa, const float dtb,
                                             const bf16_t* __restrict__ SSTb, bf16_t* __restrict__ Yout, unsigned char* shm, const int tid) {
    const int dir = chain & 1, h = (chain >> 1) & 7, b = chain >> 4, grp = h >> 2, lane = tid & 63, w = tid >> 6;
    bf16_t* Cs = (bf16_t*)shm; bf16_t* Bs = (bf16_t*)(shm + 17408); bf16_t* XT = (bf16_t*)(shm + 34816); bf16_t* Sin = (bf16_t*)(shm + 44032); bf16_t* Gs = (bf16_t*)(shm + 61440);
    float* sc = (float*)(shm + 70656);
    __syncthreads();
    u32x4 gb[2], gcc[2], gs[2], gx; unsigned gd_ = 0u;
#pragma unroll
    for (int i = 0; i < 2; ++i) { const int pid = tid + i * 512; const int s = pid >> 4, x0 = (pid & 15) * 8; const size_t toks = (size_t)step_tok(b, dir, c * 64 + s);
        gb[i] = *(const u32x4*)(XBb + toks * 1024 + 512 + grp * 128 + x0);
        gcc[i] = *(const u32x4*)(XBb + toks * 1024 + 768 + grp * 128 + x0);
        const int p = pid >> 4;
        gs[i] = *(const u32x4*)(SSTb + ((size_t)(chain * 68 + c) * 64 + p) * 128 + x0); }
    {   const int p = tid >> 3, o = tid & 7;
        gx = *(const u32x4*)(XTg + ((size_t)tokblock_of(b, dir, c) * 512 + h * 64 + p) * 64 + (dir ? 7 - o : o) * 8); }
    if (w == 0) gd_ = Pm[(size_t)step_tok(b, dir, c * 64 + lane) * LDP + SSD_OFF + 1536 + dir * 8 + h];
#pragma unroll
    for (int i = 0; i < 2; ++i) { const int pid = tid + i * 512; const int s = pid >> 4, x0 = (pid & 15) * 8;
        *(u32x4*)(Bs + s * 136 + x0) = gb[i]; *(u32x4*)(Cs + s * 136 + x0) = gcc[i]; *(u32x4*)(Sin + s * 136 + x0) = gs[i]; }
    {   const int p = tid >> 3, o = tid & 7; *(u32x4*)(XT + p * 72 + o * 8) = dir ? rev8h(gx) : gx; }
    if (w == 0) {
        const float xv = __uint_as_float(gd_ << 16) + dtb; const float dtv = xv > 20.f ? xv : log1pf(expf(xv));
        sc[lane] = wave_scan_incl(dtv * Aa, lane); sc[64 + lane] = dtv; }
    __syncthreads();
    {   const int lt = w >> 1;
        f32x4 aG[2] = {(f32x4){0.f, 0.f, 0.f, 0.f}, (f32x4){0.f, 0.f, 0.f, 0.f}};
#pragma unroll
        for (int ks = 0; ks < 4; ++ks) { const bf16x8 af = *(const bf16x8*)(Cs + (16 * lt + (lane & 15)) * 136 + ks * 32 + (lane >> 4) * 8);
#pragma unroll
            for (int i = 0; i < 2; ++i) { const int st = (w & 1) * 2 + i; const bf16x8 bfr = *(const bf16x8*)(Bs + (16 * st + (lane & 15)) * 136 + ks * 32 + (lane >> 4) * 8);
                aG[i] = __builtin_amdgcn_mfma_f32_16x16x32_bf16(af, bfr, aG[i], 0, 0, 0); } }
#pragma unroll
        for (int i = 0; i < 2; ++i) { const int s = 16 * ((w & 1) * 2 + i) + (lane & 15); const float css = sc[s], dts = sc[64 + s];
#pragma unroll
            for (int q = 0; q < 4; ++q) { const int t = 16 * lt + (lane >> 4) * 4 + q; const float val = (s <= t) ? aG[i][q] * expf(sc[t] - css) * dts : 0.f; Gs[t * 72 + s] = f2bf(val); } }
    }
    __syncthreads();
    {   const int lt = w >> 1;
        f32x4 aY[2] = {(f32x4){0.f, 0.f, 0.f, 0.f}, (f32x4){0.f, 0.f, 0.f, 0.f}};
#pragma unroll
        for (int ks = 0; ks < 4; ++ks) { const bf16x8 af = *(const bf16x8*)(Cs + (16 * lt + (lane & 15)) * 136 + ks * 32 + (lane >> 4) * 8);
#pragma unroll
            for (int i = 0; i < 2; ++i) { const int pt = (w & 1) * 2 + i; const bf16x8 bfr = *(const bf16x8*)(Sin + (16 * pt + (lane & 15)) * 136 + ks * 32 + (lane >> 4) * 8);
                aY[i] = __builtin_amdgcn_mfma_f32_16x16x32_bf16(bfr, af, aY[i], 0, 0, 0); } }
        const int t = 16 * lt + (lane & 15);
        {   const float ec = expf(sc[t]);
#pragma unroll
            for (int i = 0; i < 2; ++i) { aY[i][0] *= ec; aY[i][1] *= ec; aY[i][2] *= ec; aY[i][3] *= ec; } }
#pragma unroll
        for (int ks = 0; ks < 2; ++ks) { const bf16x8 af = *(const bf16x8*)(Gs + (16 * lt + (lane & 15)) * 72 + ks * 32 + (lane >> 4) * 8);
#pragma unroll
            for (int i = 0; i < 2; ++i) { const int pt = (w & 1) * 2 + i; const bf16x8 bfr = *(const bf16x8*)(XT + (16 * pt + (lane & 15)) * 72 + ks * 32 + (lane >> 4) * 8);
                aY[i] = __builtin_amdgcn_mfma_f32_16x16x32_bf16(bfr, af, aY[i], 0, 0, 0); } }
        {   const size_t tokt = (size_t)step_tok(b, dir, c * 64 + t);
#pragma unroll
            for (int i = 0; i < 2; ++i) { const int p0 = 16 * ((w & 1) * 2 + i) + (lane >> 4) * 4;
                u32x2 wv; wv.x = pk2(aY[i][0], aY[i][1]); wv.y = pk2(aY[i][2], aY[i][3]);
                *(u32x2*)(Yout + tokt * BW + h * 64 + p0) = wv; } }
    }
}


#define FIDX(i) ((i) + ((i) >> 4))
#define FFT_X_BYTES 69632
__device__ constexpr float FFT_CW_RE[6][16] = {{0.f, 0.f, 0.f, 0.f, 0.f, 0.f, 0.f, 0.f, 0.f, 0.f, 0.f, 0.f, 0.f, 0.f, 0.f, 0.f}, {1.0f, 0.f, 0.f, 0.f, 0.f, 0.f, 0.f, 0.f, 0.f, 0.f, 0.f, 0.f, 0.f, 0.f, 0.f, 0.f}, {1.0f, 6.123233995736766e-17f, 0.f, 0.f, 0.f, 0.f, 0.f, 0.f, 0.f, 0.f, 0.f, 0.f, 0.f, 0.f, 0.f, 0.f}, {1.0f, 0.7071067811865476f, 6.123233995736766e-17f, -0.7071067811865475f, 0.f, 0.f, 0.f, 0.f, 0.f, 0.f, 0.f, 0.f, 0.f, 0.f, 0.f, 0.f}, {1.0f, 0.9238795325112867f, 0.7071067811865476f, 0.38268343236508984f, 6.123233995736766e-17f, -0.3826834323650897f, -0.7071067811865475f, -0.9238795325112867f, 0.f, 0.f, 0.f, 0.f, 0.f, 0.f, 0.f, 0.f}, {1.0f, 0.9807852804032304f, 0.9238795325112867f, 0.8314696123025452f, 0.7071067811865476f, 0.5555702330196023f, 0.38268343236508984f, 0.19509032201612833f, 6.123233995736766e-17f, -0.1950903220161282f, -0.3826834323650897f, -0.555570233019602f, -0.7071067811865475f, -0.8314696123025453f, -0.9238795325112867f, -0.9807852804032304f}};
__device__ constexpr float FFT_CW_IM[6][16] = {{0.f, 0.f, 0.f, 0.f, 0.f, 0.f, 0.f, 0.f, 0.f, 0.f, 0.f, 0.f, 0.f, 0.f, 0.f, 0.f}, {-0.0f, 0.f, 0.f, 0.f, 0.f, 0.f, 0.f, 0.f, 0.f, 0.f, 0.f, 0.f, 0.f, 0.f, 0.f, 0.f}, {-0.0f, -1.0f, 0.f, 0.f, 0.f, 0.f, 0.f, 0.f, 0.f, 0.f, 0.f, 0.f, 0.f, 0.f, 0.f, 0.f}, {-0.0f, -0.7071067811865475f, -1.0f, -0.7071067811865476f, 0.f, 0.f, 0.f, 0.f, 0.f, 0.f, 0.f, 0.f, 0.f, 0.f, 0.f, 0.f}, {-0.0f, -0.3826834323650898f, -0.7071067811865475f, -0.9238795325112867f, -1.0f, -0.9238795325112867f, -0.7071067811865476f, -0.3826834323650899f, 0.f, 0.f, 0.f, 0.f, 0.f, 0.f, 0.f, 0.f}, {-0.0f, -0.19509032201612825f, -0.3826834323650898f, -0.5555702330196022f, -0.7071067811865475f, -0.8314696123025452f, -0.9238795325112867f, -0.9807852804032304f, -1.0f, -0.9807852804032304f, -0.9238795325112867f, -0.8314696123025455f, -0.7071067811865476f, -0.5555702330196022f, -0.3826834323650899f, -0.1950903220161286f}};
__host__ __device__ constexpr int fft_bitrev(int k, int R) { int r = 0; for (int i = 0; i < R; ++i) if (k & (1 << i)) r |= 1 << (R - 1 - i); return r; }
template <int R, bool INV>
__device__ __forceinline__ void fft_pass(float2* __restrict__ X, const float2* __restrict__ TW, const int s0, const int gidx) {
    const int lowbits = 13 - s0 - R; const int stride = 1 << lowbits;
    const int low = gidx & (stride - 1), high = gidx >> lowbits; const int base = (high << (lowbits + R)) | low;
    const int p0 = FIDX(base);
#define FFT_SLOT(k) (lowbits >= 4 ? p0 + (k) * (stride + (stride >> 4)) : p0 + (k) + ((k) >> 4))
    float2 v[1 << R];
#pragma unroll
    for (int k = 0; k < (1 << R); ++k) v[k] = X[FFT_SLOT(k)];
    const int lw = low << s0;
    if (!INV) {
#pragma unroll
        for (int j = 0; j < R; ++j) { const int hk = 1 << (R - 1 - j);
#pragma unroll
            for (int k = 0; k < (1 << R); ++k) if (!(k & hk)) { const int kk = k & (hk - 1);
                const float2 a = v[k], b = v[k + hk]; v[k] = make_float2(a.x + b.x, a.y + b.y); const float dx = a.x - b.x, dy = a.y - b.y;
                if (kk == 0) v[k + hk] = make_float2(dx, dy);
                else if (2 * kk == hk) v[k + hk] = make_float2(dy, -dx);
                else { const float cr = FFT_CW_RE[R - j][kk], ci = FFT_CW_IM[R - j][kk]; v[k + hk] = make_float2(dx * cr - dy * ci, dx * ci + dy * cr); } } }
        if (lowbits > 0) {
#pragma unroll
            for (int k = 1; k < (1 << R); ++k) { const float2 w = TW[(lw * fft_bitrev(k, R)) & 8191]; const float2 a = v[k]; v[k] = make_float2(a.x * w.x - a.y * w.y, a.x * w.y + a.y * w.x); } }
    } else {
        if (lowbits > 0) {
#pragma unroll
            for (int k = 1; k < (1 << R); ++k) { const float2 w = TW[(lw * fft_bitrev(k, R)) & 8191]; const float2 a = v[k]; v[k] = make_float2(a.x * w.x + a.y * w.y, a.y * w.x - a.x * w.y); } }
#pragma unroll
        for (int j = R - 1; j >= 0; --j) { const int hk = 1 << (R - 1 - j);
#pragma unroll
            for (int k = 0; k < (1 << R); ++k) if (!(k & hk)) { const int kk = k & (hk - 1);
                const float2 a = v[k], b = v[k + hk]; float tx, ty;
                if (kk == 0) { tx = b.x; ty = b.y; }
                else if (2 * kk == hk) { tx = -b.y; ty = b.x; }
                else { const float cr = FFT_CW_RE[R - j][kk], ci = FFT_CW_IM[R - j][kk]; tx = b.x * cr + b.y * ci; ty = b.y * cr - b.x * ci; }
                v[k] = make_float2(a.x + tx, a.y + ty); v[k + hk] = make_float2(a.x - tx, a.y - ty); } }
    }
#pragma unroll
    for (int k = 0; k < (1 << R); ++k) X[FFT_SLOT(k)] = v[k];
#undef FFT_SLOT
}
__device__ __forceinline__ void fft_fwd(float2* X, const float2* TW, const int tid) {
    fft_pass<4, false>(X, TW, 0, tid); __syncthreads(); fft_pass<4, false>(X, TW, 4, tid); __syncthreads(); if (tid < 256) fft_pass<5, false>(X, TW, 8, tid); __syncthreads(); }
__device__ __forceinline__ void fft_inv(float2* X, const float2* TW, const int tid) {
    if (tid < 256) fft_pass<5, true>(X, TW, 8, tid); __syncthreads(); fft_pass<4, true>(X, TW, 4, tid); __syncthreads(); fft_pass<4, true>(X, TW, 0, tid); __syncthreads(); }
__device__ __forceinline__ void fft_twiddles(float2* TW, const int tid) {
#pragma unroll
    for (int k = 0; k < 16; ++k) { const int m = tid + k * 512; const float xx = (float)m * (1.0f / 4096.0f); TW[m] = make_float2(cospif(xx), -sinpif(xx)); }
}
__device__ __forceinline__ void hyena_spec_item(const int pr, const float* __restrict__ HR, const float* __restrict__ nrm, float2* __restrict__ HSPEC, unsigned char* shm, const int tid) {
    float2* X = (float2*)shm; const float2* TW = (const float2*)(shm + FFT_X_BYTES);
    const int o = pr >> 8, c = (pr & 255) * 2, oc = o * 512 + c; const float inva = 1.0f / nrm[oc], invb = 1.0f / nrm[oc + 1];
    __syncthreads();
    float2 hv[16];
#pragma unroll
    for (int k = 0; k < 16; ++k) { const int j = tid + k * 512;
        const unsigned off = j < SEQ ? (unsigned)j * 2048u + o * 1024 + c : j == SEQ ? (unsigned)(o * 1024 + c) : (unsigned)(2 * SEQ - j) * 2048u + o * 1024 + 512 + c;
        hv[k] = *(const float2*)(HR + off); }
#pragma unroll
    for (int k = 0; k < 16; ++k) { const int j = tid + k * 512; X[FIDX(j)] = j == SEQ ? make_float2(0.f, 0.f) : make_float2(hv[k].x * inva, hv[k].y * invb); }
    __syncthreads();
    fft_fwd(X, TW, tid);
    float4* outa = (float4*)(HSPEC + (size_t)oc * 8192 + tid * 16); float4* outb = (float4*)(HSPEC + (size_t)(oc + 1) * 8192 + tid * 16); const float2* xs = X + 17 * tid;
    const float sc_ = 0.5f / 8192.0f;
#pragma unroll
    for (int k = 0; k < 8; ++k) { float2 ha[2], hb[2];
#pragma unroll
        for (int q = 0; q < 2; ++q) { const int p = 16 * tid + 2 * k + q; const int kf = (int)(__builtin_bitreverse32((unsigned)p) >> 19); const int p2 = (int)(__builtin_bitreverse32((unsigned)((8192 - kf) & 8191)) >> 19);
            const float2 xp = xs[2 * k + q], xq = X[FIDX(p2)];
            ha[q] = make_float2((xp.x + xq.x) * sc_, (xp.y - xq.y) * sc_);
            hb[q] = make_float2((xp.y + xq.y) * sc_, (xq.x - xp.x) * sc_); }
        outa[k] = make_float4(ha[0].x, ha[0].y, ha[1].x, ha[1].y); outb[k] = make_float4(hb[0].x, hb[0].y, hb[1].x, hb[1].y); }
}
__device__ __forceinline__ void fft_mul_spec(float2* X, const float2* __restrict__ H, const int tid) {
    const float4* h4 = (const float4*)(H + tid * 16); float2* xs = X + 17 * tid;
#pragma unroll
    for (int k = 0; k < 8; ++k) { const float4 hv = h4[k]; const float2 x0 = xs[2 * k], x1 = xs[2 * k + 1];
        xs[2 * k] = make_float2(x0.x * hv.x - x0.y * hv.y, x0.x * hv.y + x0.y * hv.x); xs[2 * k + 1] = make_float2(x1.x * hv.z - x1.y * hv.w, x1.x * hv.w + x1.y * hv.z); }
}
__device__ __forceinline__ void hyena_fft_item(const int item, const bf16_t* __restrict__ UT, const float2* __restrict__ HSPEC, const float* __restrict__ bias, float* __restrict__ YT, unsigned char* shm, const int tid) {
    float2* X = (float2*)shm; const float2* TW = (const float2*)(shm + FFT_X_BYTES);
    const int c = item >> 1, b0 = (item & 1) * 2, b1 = b0 + 1;
    const bf16_t* u0 = UT + (size_t)(b0 * 1536 + c) * SEQ + tid * 8; const bf16_t* u1 = UT + (size_t)(b1 * 1536 + c) * SEQ + tid * 8;
    const float bias0 = bias[c], bias1 = bias[512 + c];
    float2* xs = X + FIDX(8 * tid);
    float vr[8], vi[8];
    __syncthreads();
    { const u32x4 a0 = *(const u32x4*)u0, c0 = *(const u32x4*)u1; unpack8(a0, vr); unpack8(c0, vi); }
#pragma unroll
    for (int k = 0; k < 8; ++k) { xs[k] = make_float2(vr[k], vi[k]); xs[4352 + k] = make_float2(0.f, 0.f); }
    __syncthreads();
    fft_fwd(X, TW, tid);
    fft_mul_spec(X, HSPEC + (size_t)c * 8192, tid);
    __syncthreads();
    fft_inv(X, TW, tid);
    { const bf16_t* p0 = u0 + (size_t)512 * SEQ; const bf16_t* p1 = u1 + (size_t)512 * SEQ;
      float xr[8], xi[8]; { const u32x4 a0 = *(const u32x4*)p0, c0 = *(const u32x4*)p1; unpack8(a0, xr); unpack8(c0, xi); }
#pragma unroll
      for (int k = 0; k < 8; ++k) { const float2 cv = xs[k]; const float zr = xr[k] * (cv.x + bias0 * vr[k]), zi = xi[k] * (cv.y + bias0 * vi[k]);
          vr[k] = zr; vi[k] = zi; xs[k] = make_float2(zr, zi); xs[4352 + k] = make_float2(0.f, 0.f); } }
    __syncthreads();
    fft_fwd(X, TW, tid);
    fft_mul_spec(X, HSPEC + (size_t)(512 + c) * 8192, tid);
    __syncthreads();
    fft_inv(X, TW, tid);
    { const bf16_t* p0 = u0 + (size_t)1024 * SEQ; const bf16_t* p1 = u1 + (size_t)1024 * SEQ;
      float xr[8], xi[8]; { const u32x4 a0 = *(const u32x4*)p0, c0 = *(const u32x4*)p1; unpack8(a0, xr); unpack8(c0, xi); }
      float yr[8], yi[8];
#pragma unroll
      for (int k = 0; k < 8; ++k) { const float2 cv = xs[k]; yr[k] = xr[k] * (cv.x + bias1 * vr[k]); yi[k] = xi[k] * (cv.y + bias1 * vi[k]); }
      float* y0 = YT + (size_t)(b0 * 512 + c) * SEQ + tid * 8; float* y1 = YT + (size_t)(b1 * 512 + c) * SEQ + tid * 8;
      *(float4*)y0 = make_float4(yr[0], yr[1], yr[2], yr[3]); *(float4*)(y0 + 4) = make_float4(yr[4], yr[5], yr[6], yr[7]);
      *(float4*)y1 = make_float4(yi[0], yi[1], yi[2], yi[3]); *(float4*)(y1 + 4) = make_float4(yi[4], yi[5], yi[6], yi[7]); }
}

constexpr size_t al256(size_t x) { return (x + 255) & ~(size_t)255; }
constexpr size_t O_BAR = 0;
constexpr size_t O_MOD = 16384;
constexpr size_t O_NORM = O_MOD + al256((size_t)2 * 5 * 6 * DM * 4);
constexpr size_t O_QCTR = O_NORM + al256((size_t)2 * 2 * 1024 * 4);
constexpr size_t O_ZERO_END = O_QCTR + 512;
constexpr size_t O_XS = O_ZERO_END;
constexpr size_t O_HB = O_XS + al256((size_t)NTOK * DM * 4);
constexpr size_t O_P = O_HB + al256((size_t)NTOK * DM * 2);
constexpr size_t O_WIN = O_P + al256((size_t)NTOK * LDP * 2);
constexpr size_t O_WBR = O_WIN + al256((size_t)LDP * DM * 2);
constexpr size_t O_WOUT = O_WBR + al256((size_t)4 * DM * BW * 2);
constexpr size_t O_WGU = O_WOUT + al256((size_t)DM * DM * 2);
constexpr size_t O_WD = O_WGU + al256((size_t)NEXP * 2 * DEXP * DM * 2);
constexpr size_t O_GLU = O_WD + al256((size_t)NEXP * DM * DEXP * 2);
constexpr size_t O_Y4 = O_GLU + al256((size_t)BW * BW * 2);
constexpr size_t O_U = O_Y4 + al256((size_t)NTOK * DM * 2);
constexpr size_t O_QKB = O_U + al256((size_t)NTOK * 1536 * 4);
constexpr size_t O_CST = O_QKB + al256((size_t)NTOK * 1024 * 2);
constexpr size_t O_NST = O_CST + al256((size_t)32 * 68 * 128 * 128 * 2);
constexpr size_t O_MST = O_NST + al256((size_t)32 * 68 * 128 * 4);
constexpr size_t O_XBC = O_MST + al256((size_t)32 * 68 * 4);
constexpr size_t O_SST = O_XBC + al256((size_t)NTOK * 1024 * 2);
constexpr size_t O_HF = O_SST + al256((size_t)64 * 68 * 64 * 128 * 2);
constexpr size_t O_YF = O_HF + al256((size_t)2 * NTOK * BW * 4);
constexpr size_t O_SF = O_YF + al256((size_t)2 * NTOK * BW * 4);
constexpr size_t O_LDT = O_SF + al256((size_t)2 * NCTX * BW * 4);
constexpr size_t O_AP = O_LDT + al256((size_t)4096 * 16);
constexpr size_t O_BBT = O_AP + al256((size_t)4096 * 33 * 8);
constexpr size_t O_KT = O_BBT + al256((size_t)4096 * 16 * 8);
constexpr size_t O_S5A = O_KT + al256((size_t)32 * 2 * 32 * 256 * 4);
constexpr size_t O_S5B = O_S5A + al256((size_t)32 * 512 * 768 * 2);
constexpr size_t O_XCTX = O_S5B + al256((size_t)32 * 512 * 768 * 2);
constexpr size_t O_Z = O_XCTX + al256((size_t)4 * 32 * 2 * 64 * 8);
constexpr size_t O_HRAW = O_Z + al256((size_t)NTOK * BW * 4);
constexpr size_t O_HSPEC = O_HRAW + al256((size_t)(SEQ + CTXL) * 2048 * 4);
constexpr size_t O_K2C = O_HSPEC + al256((size_t)1024 * 8192 * 8);
constexpr size_t O_GG = O_K2C + al256((size_t)(2 * CTXL) * 1024 * 4);
constexpr size_t O_PROBS = O_GG + al256((size_t)NTOK * BW * 2);
constexpr size_t O_ROWTOK = O_PROBS + al256((size_t)NTOK * 16 * 4);
constexpr size_t O_ROWGATE = O_ROWTOK + al256((size_t)NEXP * MOE_PAD * 4);
constexpr size_t O_INV = O_ROWGATE + al256((size_t)NEXP * MOE_PAD * 4);
constexpr size_t O_NORMP = O_INV + al256((size_t)NTOK * 16 * 4);
constexpr size_t WS_END = O_NORMP + al256((size_t)4 * 256 * 2048 * 4);
constexpr size_t O_XG = O_P;
constexpr size_t O_HID = O_P + al256((size_t)NEXP * MOE_PAD * DM * 2);
constexpr size_t O_YEXP = O_HID + al256((size_t)NEXP * MOE_PAD * DEXP * 2);
static_assert(O_YEXP + (size_t)NEXP * MOE_PAD * DM * 2 <= O_WIN, "MoE temporaries must fit inside P");
static_assert((size_t)NTOK * DM * 2 <= (size_t)NTOK * 1536 * 4, "ACCb must fit inside U");
static_assert((size_t)26214400 + (size_t)2 * 17825792 + (size_t)272 * 256 * 64 * 2 <= (size_t)NTOK * DM * 2, "strip buffers must fit inside HB");
static_assert(WS_END <= (size_t)1851000000, "workspace map exceeds the guaranteed size");

struct Args {
    const float* in[47];
    float* out; unsigned char* ws;
    int ph_lo, ph_hi;
};

__device__ __forceinline__ void conv_tile(const float* __restrict__ src, int ldsrc, int nvalid, int k0, int n0, bf16_t* __restrict__ dst, int lddst, int mode, float* T, int tid) {
    { const int n = tid & 63, kr = tid >> 6;
#pragma unroll
      for (int i = 0; i < 8; ++i) { const int k = i * 8 + kr; T[k * 65 + n] = (n0 + n < nvalid) ? src[(size_t)(k0 + k) * ldsrc + n0 + n] : 0.f; } }
    __syncthreads();
    { const int n = tid >> 3, kc = (tid & 7) * 8; const int gn = n0 + n;
      const int drow = mode == 0 ? gn : (32 * (gn >> 4) + (mode == 2 ? 16 : 0) + (gn & 15));
      u32x4 w; w.x = pk2(T[(kc + 0) * 65 + n], T[(kc + 1) * 65 + n]); w.y = pk2(T[(kc + 2) * 65 + n], T[(kc + 3) * 65 + n]);
      w.z = pk2(T[(kc + 4) * 65 + n], T[(kc + 5) * 65 + n]); w.w = pk2(T[(kc + 6) * 65 + n], T[(kc + 7) * 65 + n]);
      *(u32x4*)(dst + (size_t)drow * lddst + k0 + kc) = w; }
    __syncthreads();
}

#define IN(id) (lo <= (id) && (id) < hi)
#define SEAM(id) do { if (hi > (id) + 1) xcd_barrier(bar); } while (0)
#define PH_BEGIN int tid = threadIdx.x; asm volatile("" : "+v"(tid) :: "memory"); const int lane = tid & 63, wave = tid >> 6; (void)lane; (void)wave;

#define x_in (PT(0))
#define c_in (PT(1))
#define ctx_in (PT(2))
#define cctx_in (PT(3))
#define ada_w (PT(4))
#define ada_b (PT(5))
#define norm_mix (PT(6))
#define norm_ffn (PT(7))
#define w_in (PT(8))
#define XS ((float*)(a.ws + O_XS))
#define MOD ((float*)(a.ws + O_MOD))
#define NORM ((float*)(a.ws + O_NORM))
#define NORMP ((float*)(a.ws + O_NORMP))
#define MODl (MOD + (size_t)l * 5 * 6 * DM)
#define HB ((bf16_t*)(a.ws + O_HB))
#define P ((bf16_t*)(a.ws + O_P))
#define WIN ((bf16_t*)(a.ws + O_WIN))
#define WBR ((bf16_t*)(a.ws + O_WBR))
#define WOUT ((bf16_t*)(a.ws + O_WOUT))
#define WGU ((bf16_t*)(a.ws + O_WGU))
#define WD ((bf16_t*)(a.ws + O_WD))
#define GLU ((bf16_t*)(a.ws + O_GLU))
#define Y4 ((bf16_t*)(a.ws + O_Y4))
#define U ((float*)(a.ws + O_U))
#define ACCb ((bf16_t*)(a.ws + O_U))
#define QKB ((bf16_t*)(a.ws + O_QKB))
#define CST ((bf16_t*)(a.ws + O_CST))
#define NST ((float*)(a.ws + O_NST))
#define MST ((float*)(a.ws + O_MST))
#define XBC ((bf16_t*)(a.ws + O_XBC))
#define SSTB ((bf16_t*)(a.ws + O_SST))
#define HF ((bf16_t*)(a.ws + O_HF))
#define HBk (HF + (size_t)NTOK * BW)
#define YF ((bf16_t*)(a.ws + O_YF))
#define YB (YF + (size_t)NTOK * BW)
#define SF ((float*)(a.ws + O_SF))
#define SB (SF + (size_t)NCTX * BW)
#define LDT ((double2*)(a.ws + O_LDT))
#define APW ((float2*)(a.ws + O_AP))
#define BBT ((float2*)(a.ws + O_BBT))
#define KTB ((float*)(a.ws + O_KT))
#define S5A ((bf16_t*)(a.ws + O_S5A))
#define S5B ((bf16_t*)(a.ws + O_S5B))
#define XCTX ((float2*)(a.ws + O_XCTX))
#define S5P ((bf16_t*)(a.ws + O_HB))
#define XLOC ((float*)(a.ws + O_HB + (size_t)32 * 256 * 512 * 2))
#define KTG ((bf16_t*)(a.ws + O_HB + (size_t)26214400))
#define VTG ((bf16_t*)(a.ws + O_HB + (size_t)26214400 + (size_t)17825792))
#define BTG ((bf16_t*)(a.ws + O_HB + (size_t)26214400 + (size_t)2 * 17825792))
#define XTG ((bf16_t*)(a.ws + O_GG))
#define Z ((float*)(a.ws + O_Z))
#define HRAW ((float*)(a.ws + O_HRAW))
#define HSPEC ((float2*)(a.ws + O_HSPEC))
#define UT ((bf16_t*)(a.ws + O_U))
#define YT ((float*)(a.ws + O_Z))
#define QCTR ((int*)(a.ws + O_QCTR))
#define K2C ((float*)(a.ws + O_K2C))
#define GG ((bf16_t*)(a.ws + O_GG))
#define PROBS ((float*)(a.ws + O_PROBS))
#define ROWTOK ((int*)(a.ws + O_ROWTOK))
#define ROWGATE ((float*)(a.ws + O_ROWGATE))
#define XG ((bf16_t*)(a.ws + O_XG))
#define HID ((bf16_t*)(a.ws + O_HID))
#define YEXP ((bf16_t*)(a.ws + O_YEXP))
#define INV ((int*)(a.ws + O_INV))


__device__ __forceinline__ void moe_pair(float4 (&a)[8], const int r1, const int r2, const float g2scale, const int lane, const float* __restrict__ rowgate, const bf16_t* __restrict__ yexp) {
    const float gt1 = rowgate[r1], gt2 = rowgate[r2] * g2scale;
    const bf16_t* y1 = yexp + (size_t)r1 * DM + lane * 4; const bf16_t* y2 = yexp + (size_t)r2 * DM + lane * 4;
    u32x2 w1[8], w2[8];
#pragma unroll
    for (int i = 0; i < 8; ++i) { w1[i] = *(const u32x2*)(y1 + i * 256); w2[i] = *(const u32x2*)(y2 + i * 256); }
#pragma unroll
    for (int i = 0; i < 8; ++i) {
        a[i].x += gt1 * __uint_as_float(w1[i].x << 16); a[i].y += gt1 * __uint_as_float(w1[i].x & 0xFFFF0000u); a[i].z += gt1 * __uint_as_float(w1[i].y << 16); a[i].w += gt1 * __uint_as_float(w1[i].y & 0xFFFF0000u);
        a[i].x += gt2 * __uint_as_float(w2[i].x << 16); a[i].y += gt2 * __uint_as_float(w2[i].x & 0xFFFF0000u); a[i].z += gt2 * __uint_as_float(w2[i].y << 16); a[i].w += gt2 * __uint_as_float(w2[i].y & 0xFFFF0000u); }
}
__device__ __forceinline__ void moe_combine(float4 (&v)[8], const int tok, const int lane, const int* __restrict__ inv, const float* __restrict__ rowgate, const bf16_t* __restrict__ yexp, const float* __restrict__ m5) {
    float4 a[8], mm[8];
#pragma unroll
    for (int i = 0; i < 8; ++i) { a[i] = make_float4(0.f, 0.f, 0.f, 0.f); mm[i] = *(const float4*)(m5 + i * 256 + lane * 4); }
    const int4* ip = (const int4*)(inv + (size_t)tok * 16);
    const int4 q0 = ip[0], q1 = ip[1], q2 = ip[2], q3 = ip[3];
    const int rows[16] = {q0.x, q0.y, q0.z, q0.w, q1.x, q1.y, q1.z, q1.w, q2.x, q2.y, q2.z, q2.w, q3.x, q3.y, q3.z, q3.w};
    int prow = -1;
#pragma unroll
    for (int e = 0; e < 16; ++e) { const int row = __builtin_amdgcn_readfirstlane(rows[e]);
        if (row >= 0) { if (prow >= 0) { moe_pair(a, prow, row, 1.0f, lane, rowgate, yexp); prow = -1; } else prow = row; } }
    if (prow >= 0) moe_pair(a, prow, prow, 0.0f, lane, rowgate, yexp);
#pragma unroll
    for (int i = 0; i < 8; ++i) { v[i].x += mm[i].x * a[i].x; v[i].y += mm[i].y * a[i].y; v[i].z += mm[i].z * a[i].z; v[i].w += mm[i].w * a[i].w; }
}
struct CvU { const float* src; bf16_t* dst; int ldsrc, nvalid, k0, n0, lddst, mode; };
__device__ __forceinline__ void cv_load(const CvU& u, float4 (&r)[8], const int tid) {
#pragma unroll
    for (int i = 0; i < 8; ++i) { const int idx = tid + i * 512; const int k = idx >> 6, n = u.n0 + (idx & 63) * 4;
        r[i] = (n < u.nvalid) ? *(const float4*)(u.src + (size_t)(u.k0 + k) * u.ldsrc + n) : make_float4(0.f, 0.f, 0.f, 0.f); }
}
__device__ __forceinline__ void cv_stage(float* T, const float4 (&r)[8], const int tid) {
#pragma unroll
    for (int i = 0; i < 8; ++i) { const int idx = tid + i * 512; float* p = T + (idx >> 6) * 257 + (idx & 63) * 4; p[0] = r[i].x; p[1] = r[i].y; p[2] = r[i].z; p[3] = r[i].w; }
}
__device__ __forceinline__ void cv_store(const CvU& u, const float* T, const int tid) {
#pragma unroll
    for (int j = 0; j < 4; ++j) { const int o = tid + j * 512; const int kc = (o & 7) * 8, n = o >> 3; const int gn = u.n0 + n;
        const int drow = u.mode == 0 ? gn : (256 * (gn >> 7) + (u.mode == 2 ? 128 : 0) + (gn & 127));
        const float* t = T + kc * 257 + n;
        u32x4 w; w.x = pk2(t[0], t[257]); w.y = pk2(t[2 * 257], t[3 * 257]); w.z = pk2(t[4 * 257], t[5 * 257]); w.w = pk2(t[6 * 257], t[7 * 257]);
        *(u32x4*)(u.dst + (size_t)drow * u.lddst + u.k0 + kc) = w; }
}
#define CV_RUN(LL, QSTART, QSTEP, QEND) do { \
                const float* wbr = PT(40) + (size_t)(LL) * 4 * BW * DM; const float* wout = PT(41) + (size_t)(LL) * DM * DM; \
                const float* wg = PT(43) + (size_t)(LL) * NEXP * DM * DEXP; const float* wu = PT(44) + (size_t)(LL) * NEXP * DM * DEXP; const float* wd = PT(45) + (size_t)(LL) * NEXP * DEXP * DM; \
                const float* wglu = PT(32) + (size_t)(LL) * BW * BW; const float* win = w_in + (size_t)(LL) * DM * IN_W; \
                const int cv_step = (QSTEP), cv_end = (QEND); \
                __syncthreads(); \
                int q = (QSTART); int buf = 0; CvU u; float4 r[8]; \
                if (q < cv_end) { CV_DECODE(q, u); cv_load(u, r, tid); } \
                while (q < cv_end) { \
                    float* T = sf + buf * (64 * 257); \
                    cv_stage(T, r, tid); \
                    __syncthreads(); \
                    const CvU cur = u; const int qn = q + cv_step; \
                    if (qn < cv_end) { CV_DECODE(qn, u); cv_load(u, r, tid); } \
                    cv_store(cur, T, tid); \
                    buf ^= 1; q = qn; \
                } \
                __syncthreads(); } while (0)
#define CV_DECODE(q_, u_) do { int qq_ = (q_); \
                    if (qq_ < n_win) { u_ = CvU{win, WIN, IN_W, IN_W, (qq_ / 55) * 64, (qq_ % 55) * 256, DM, 0}; } else { qq_ -= n_win; \
                    if (qq_ < n_br) { const int k = qq_ >> 6, r = qq_ & 63; u_ = CvU{wbr + (size_t)k * BW * DM, WBR + (size_t)k * DM * BW, DM, DM, (r >> 3) * 64, (r & 7) * 256, BW, 0}; } else { qq_ -= n_br; \
                    if (qq_ < n_out) { u_ = CvU{wout, WOUT, DM, DM, (qq_ >> 3) * 64, (qq_ & 7) * 256, DM, 0}; } else { qq_ -= n_out; \
                    if (qq_ < n_glu) { u_ = CvU{wglu, GLU, BW, BW, (qq_ >> 1) * 64, (qq_ & 1) * 256, BW, 0}; } else { qq_ -= n_glu; \
                    if (qq_ < n_gu) { const int e = qq_ / 384, r = qq_ % 384, up = r / 192, r2 = r % 192; u_ = CvU{(up ? wu : wg) + (size_t)e * DM * DEXP, WGU + (size_t)e * 2 * DEXP * DM, DEXP, DEXP, (r2 / 6) * 64, (r2 % 6) * 256, DM, 1 + up}; } else { qq_ -= n_gu; \
                    { const int e = qq_ / 192, r = qq_ % 192; u_ = CvU{wd + (size_t)e * DEXP * DM, WD + (size_t)e * DM * DEXP, DM, DM, (r >> 3) * 64, (r & 7) * 256, DEXP, 0}; } } } } } } } while (0)
template <int LAYER>
__device__ __forceinline__ void layer_body(const Args& a, const XcdBarrier& bar, const int lo, const int hi, const int bid, const int G, unsigned char* const shm, float* const sf, const float** const ptab) {
        constexpr int l = LAYER;
        constexpr int PB = 1 + 16 * l;
        const bool lastl = (l == 1);

        const int nPanels = lastl ? 64 : 68;
        const int M2 = nPanels * 256;

        if (IN(PB + 0)) for (int rep_ = 0; rep_ < (l == 0 ? PROBE_REPS(0) : 1); ++rep_) {
            PH_BEGIN
            {   const int n_win = 32 * 55, n_br = 4 * 64, n_out = 32 * 8, n_glu = 16, n_gu = 16 * 2 * 192, n_d = 16 * 192;
                const int n_grp1 = n_win + n_br + n_out + n_glu, total = n_grp1 + n_gu + n_d;
                const int q_lo = (l > 0 && G > 128) ? n_win : 0;
                CV_RUN(l, q_lo + bid, G, total);
            }
            for (int set = 0; set < (lastl ? 1 : 2); ++set) {
                const int L = set ? CTXL : SEQ; float* HR = HRAW + (set ? (size_t)SEQ * 2048 : 0);
                const float* w1 = PT(11) + l * 33 * 64; const float* b1 = PT(12) + l * 64; const float* fr1 = PT(13) + l * 64; const float* w2 = PT(14) + l * 64 * 64; const float* b2 = PT(15) + l * 64;
                const float* fr2 = PT(16) + l * 64; const float* w3 = PT(17) + l * 64 * 2048; const float* decay = PT(18) + l * 2048;
                float* feats = sf; float* h1 = sf + 16 * 33; float* h2 = h1 + 16 * 64;
                float nacc[4] = {0.f, 0.f, 0.f, 0.f};
                for (int base = bid; base < L; base += 16 * G) {
                    __syncthreads();
                    for (int e = tid; e < 16 * 33; e += NTHR) { const int ti = e / 33, fi = e % 33; int t = base + ti * G; if (t > L - 1) t = L - 1;
                        float v;
                        if (fi == 0) v = (float)t / (float)(L - 1);
                        else { const int j = (fi - 1) & 15; const double fr = 1e-4 + (double)j * ((15.0 - 1e-4) / 15.0); const double ang = (2.0 * 3.14159265358979323846 / (double)L) * (double)t * fr; v = fi <= 16 ? (float)cos(ang) : (float)(-sin(ang)); }
                        feats[e] = v; }
                    __syncthreads();
                    { const int j = tid & 63, ti = tid >> 6; float s0 = b1[j], s1 = s0;
_Pragma("unroll 3")
                      for (int i = 0; i < 33; ++i) { const float wv = w1[i * 64 + j]; s0 += feats[ti * 33 + i] * wv; s1 += feats[(ti + 8) * 33 + i] * wv; }
                      const float f1 = fr1[j]; h1[ti * 64 + j] = sinf(f1 * s0); h1[(ti + 8) * 64 + j] = sinf(f1 * s1); }
                    __syncthreads();
                    { const int j = tid & 63, ti = tid >> 6; float s0 = b2[j], s1 = s0;
_Pragma("unroll 4")
                      for (int i = 0; i < 64; ++i) { const float wv = w2[i * 64 + j]; s0 += h1[ti * 64 + i] * wv; s1 += h1[(ti + 8) * 64 + i] * wv; }
                      const float f2 = fr2[j]; h2[ti * 64 + j] = sinf(f2 * s0); h2[(ti + 8) * 64 + j] = sinf(f2 * s1); }
                    __syncthreads();
                    float acc[16][4];
#pragma unroll
                    for (int ti = 0; ti < 16; ++ti) { acc[ti][0] = 0.f; acc[ti][1] = 0.f; acc[ti][2] = 0.f; acc[ti][3] = 0.f; }
#pragma unroll 2
                    for (int i = 0; i < 64; ++i) { const float* wrow = w3 + (size_t)i * 2048 + tid; const float wa = wrow[0], wb = wrow[512], wc2 = wrow[1024], wd2 = wrow[1536];
#pragma unroll
                        for (int ti = 0; ti < 16; ++ti) { const float hv = h2[ti * 64 + i]; acc[ti][0] += hv * wa; acc[ti][1] += hv * wb; acc[ti][2] += hv * wc2; acc[ti][3] += hv * wd2; } }
                    float dk[4];
#pragma unroll
                    for (int k = 0; k < 4; ++k) dk[k] = fabsf(decay[tid + k * 512]);
#pragma unroll
                    for (int ti = 0; ti < 16; ++ti) { const int t = base + ti * G; if (t < L) { const float tn = (float)t / (float)(L - 1);
#pragma unroll
                        for (int k = 0; k < 4; ++k) { const float v = acc[ti][k] * expf(-tn * dk[k]); HR[(size_t)t * 2048 + tid + k * 512] = v; nacc[k] += fabsf(v); } } }
                }
                float* nrp = NORMP + ((size_t)(l * 2 + set) * 256 + bid) * 2048;
#pragma unroll
                for (int k = 0; k < 4; ++k) nrp[tid + k * 512] = nacc[k];
            }
            for (int idx = bid * NTHR + tid; idx < 4096; idx += G * NTHR) { const int n = idx & 63, g = (idx >> 6) & 31, dir = idx >> 11;
                const double are = (double)(PT(24) + l * 4096)[idx], aim = (double)(PT(25) + l * 4096)[idx]; const double lam = are < -1e-4 ? are : -1e-4; const double dt = exp((double)(PT(26) + l * 64)[dir * 32 + g]);
                const double ldre = lam * dt, ldim = aim * dt; LDT[idx] = make_double2(ldre, ldim);
                const double mag = exp(ldre); const double ar = mag * cos(ldim), ai = mag * sin(ldim);
                const double den = lam * lam + aim * aim; const double nr = ar - 1.0, ni = ai; const double fre = (nr * lam + ni * aim) / den, fim = (ni * lam - nr * aim) / den;
                const float* b_re = PT(27) + l * 32 * 64 * 16; const float* b_im = PT(28) + l * 32 * 64 * 16;
#pragma unroll 4
                for (int c = 0; c < 16; ++c) { const double br = (double)b_re[(g * 64 + n) * 16 + c], bi = (double)b_im[(g * 64 + n) * 16 + c]; BBT[idx * 16 + c] = make_float2((float)(fre * br - fim * bi), (float)(fre * bi + fim * br)); }
            }
            for (int e2 = bid * NTHR + tid; e2 < 4096 * 33; e2 += G * NTHR) { const int idx = e2 / 33, k = e2 - idx * 33; const int g = (idx >> 6) & 31, dir = idx >> 11;
                const double are = (double)(PT(24) + l * 4096)[idx], aim = (double)(PT(25) + l * 4096)[idx]; const double lam = are < -1e-4 ? are : -1e-4; const double dt = exp((double)(PT(26) + l * 64)[dir * 32 + g]);
                const double ldre = lam * dt, ldim = aim * dt; const double mk = exp(ldre * k); APW[e2] = make_float2((float)(mk * cos(ldim * k)), (float)(mk * sin(ldim * k))); }
            if (l == 0 && lo == 0) xcd_barrier(bar);
            for (int tok = bid * 8 + wave; tok < NTOK; tok += G * 8) {
                const int r = tok < NLAT ? tok / SEQ : 4; const float* xr = l == 0 ? (tok < NLAT ? x_in + (size_t)tok * DM : ctx_in + (size_t)(tok - NLAT) * DM) : XS + (size_t)tok * DM; const float* gn = norm_mix + l * DM;
                const float* sh = MODl + (size_t)(r * 6 + 0) * DM; const float* sc = MODl + (size_t)(r * 6 + 1) * DM;
                float4 v[8]; float ss = 0.f;
#pragma unroll
                for (int i = 0; i < 8; ++i) v[i] = *(const float4*)(xr + i * 256 + lane * 4);
                if (l > 0) {
                    moe_combine(v, tok, lane, INV, ROWGATE, YEXP, MOD + (size_t)((l - 1) * 5 + r) * 6 * DM + 5 * DM);
#pragma unroll
                    for (int i = 0; i < 8; ++i) *(float4*)(XS + (size_t)tok * DM + i * 256 + lane * 4) = v[i]; }
#pragma unroll
                for (int i = 0; i < 8; ++i) ss += v[i].x * v[i].x + v[i].y * v[i].y + v[i].z * v[i].z + v[i].w * v[i].w;
                ss = wave_sum(ss); const float rs = rsqrtf(ss * (1.0f / DM) + 1e-6f);
#pragma unroll
                for (int i = 0; i < 8; ++i) { const int d = i * 256 + lane * 4; const float4 g4 = *(const float4*)(gn + d), s4 = *(const float4*)(sc + d), h4 = *(const float4*)(sh + d);
                    v[i].x = v[i].x * rs * g4.x * (1.f + s4.x) + h4.x; v[i].y = v[i].y * rs * g4.y * (1.f + s4.y) + h4.y; v[i].z = v[i].z * rs * g4.z * (1.f + s4.z) + h4.z; v[i].w = v[i].w * rs * g4.w * (1.f + s4.w) + h4.w; }
#pragma unroll
                for (int i = 0; i < 8; ++i) { u32x2 w; w.x = pk2(v[i].x, v[i].y); w.y = pk2(v[i].z, v[i].w); *(u32x2*)(HB + (size_t)tok * DM + i * 256 + lane * 4) = w; }
            }
            SEAM(PB + 0);
        }

        if (IN(PB + 1)) for (int rep_ = 0; rep_ < PROBE_REPS(1); ++rep_) {
            PH_BEGIN
            for (int base = bid * 8; base < (lastl ? 1 : 2) * 1024; base += G * 8) {
                const int idx = base + (tid & 7), sl = tid >> 3; const int set = idx >> 10, oc = idx & 1023, o = oc >> 9, c = oc & 511;
                const float* pp = NORMP + (size_t)(l * 2 + set) * 256 * 2048 + o * 1024 + c + (size_t)(sl * 4) * 2048; float sacc = 0.f;
#pragma unroll
                for (int j = 0; j < 4; ++j) { const float p0 = pp[(size_t)j * 2048], p1 = pp[(size_t)j * 2048 + 512]; sacc += (sl * 4 + j < G) ? p0 + p1 : 0.f; }
                sf[sl * 8 + (tid & 7)] = sacc; __syncthreads();
                if (tid < 8) { float t = 0.f;
#pragma unroll 8
                    for (int q = 0; q < 64; ++q) t += sf[q * 8 + tid];
                    NORM[(size_t)(l * 2 + set) * 1024 + oc] = t; }
                __syncthreads(); }
            for (int idx = (G - 1 - bid) * NTHR + tid; idx < 32768; idx += G * NTHR) { const int c = idx & 15, lag = (idx >> 4) & 31, dir = (idx >> 9) & 1, g = idx >> 10;
                const float* c_re = PT(29) + l * 32 * 16 * 64 + (g * 16 + c) * 64; const float* c_im = PT(30) + l * 32 * 16 * 64 + (g * 16 + c) * 64;
                float acc[16];
#pragma unroll
                for (int j = 0; j < 16; ++j) acc[j] = 0.f;
#pragma unroll 2
                for (int n = 0; n < 64; ++n) { const int pi = (dir * 32 + g) * 64 + n; const float2 ap = APW[pi * 33 + lag]; const float cr = c_re[n], ci = c_im[n]; const float wr_ = cr * ap.x - ci * ap.y, wi_ = cr * ap.y + ci * ap.x;
                    const float4* bb = (const float4*)(BBT + pi * 16);
#pragma unroll
                    for (int j = 0; j < 8; ++j) { const float4 b2 = bb[j]; acc[2 * j] += wr_ * b2.x - wi_ * b2.y; acc[2 * j + 1] += wr_ * b2.z - wi_ * b2.w; } }
                float4* o = (float4*)(KTB + (size_t)idx * 16);
                o[0] = make_float4(acc[0], acc[1], acc[2], acc[3]); o[1] = make_float4(acc[4], acc[5], acc[6], acc[7]); o[2] = make_float4(acc[8], acc[9], acc[10], acc[11]); o[3] = make_float4(acc[12], acc[13], acc[14], acc[15]);
            }
            __syncthreads();
            pg8::Gemm g{HB, WIN, DM, DM, DM}; pg8::SchedStd S{68, 55, G, bid, DM, DM}; pg8::EpiWin E{P, LDP};
            pg8::gemm_phase(( LAS unsigned char*)shm, g, S, E);
#if defined(PROBE_BNOEPI)
            { __syncthreads(); pg8::EpiNone E0; pg8::gemm_phase((LAS unsigned char*)shm, g, S, E0); }
#endif
            SEAM(PB + 1);
        }

        if (IN(PB + 2)) for (int rep_ = 0; rep_ < PROBE_REPS(2); ++rep_) {
            PH_BEGIN
            const float* hcw = PT(9) + l * 3 * 1536; const float* hcb = PT(10) + l * 1536; const float* mcw = PT(20) + l * 3 * 1024; const float* mcb = PT(21) + l * 1024;
            const float* scw = PT(34) + l * 3 * 1024; const float* scb = PT(35) + l * 1024;
            for (int unit = bid; unit < 272 * 3; unit += G) { const int seg = unit / 3, kind = unit % 3; const bool lat = seg < 256; const size_t tok0 = lat ? (size_t)seg * 64 : (size_t)NLAT + (size_t)(seg - 256) * 64;
                if (kind < 2) { const int hf = kind;
                    const int c = tid * 2; const int col = (hf ? SSD_OFF + 512 : ML_OFF) + c; const float* w = hf ? scw : mcw; const float* bsp = hf ? scb : mcb; bf16_t* dst = (hf ? XBC : QKB) + tok0 * 1024 + c;
                    const float2 w0 = *(const float2*)(w + c), w1 = *(const float2*)(w + 1024 + c), w2 = *(const float2*)(w + 2048 + c), bb = *(const float2*)(bsp + c);
                    const float osc = (!hf && c >= 512) ? 0.08838834764831845f : 1.0f;
                    const bool hasPrev = !lat && ((tok0 - NLAT) & (CTXL - 1)) != 0, hasNext = !lat && (((tok0 - NLAT) + 63) & (CTXL - 1)) != CTXL - 1;
                    bf16_t* strip = nullptr;
                    if (!hf) { if (c >= 512) strip = KTG + ((size_t)seg * 512 + (c - 512)) * 64; }
                    else { if (c < 512) strip = XTG + ((size_t)seg * 512 + c) * 64; else if (c < 768) strip = BTG + ((size_t)seg * 256 + (c - 512)) * 64; }
                    const bf16_t* pp = P + tok0 * LDP + col;
                    unsigned raw[66];
#pragma unroll
                    for (int t = 0; t < 66; ++t) raw[t] = ((t == 0 && !hasPrev) || (t == 65 && !hasNext)) ? 0u : *(const unsigned*)(pp + (ptrdiff_t)(t - 1) * LDP);
#pragma unroll
                    for (int t8 = 0; t8 < 8; ++t8) { float v0[8], v1[8];
#pragma unroll
                        for (int tt = 0; tt < 8; ++tt) { const int t = t8 * 8 + tt; const unsigned p0 = raw[t], p1 = raw[t + 1], p2 = raw[t + 2];
                            float a0 = bb.x + w0.x * __uint_as_float(p0 << 16) + w1.x * __uint_as_float(p1 << 16) + w2.x * __uint_as_float(p2 << 16);
                            float a1 = bb.y + w0.y * __uint_as_float(p0 & 0xFFFF0000u) + w1.y * __uint_as_float(p1 & 0xFFFF0000u) + w2.y * __uint_as_float(p2 & 0xFFFF0000u);
                            a0 = siluf_(a0) * osc; a1 = siluf_(a1) * osc; v0[tt] = a0; v1[tt] = a1;
                            *(unsigned*)(dst + (size_t)t * 1024) = pk2(a0, a1); }
                        if (strip) { u32x4 s0, s1; s0.x = pk2(v0[0], v0[1]); s0.y = pk2(v0[2], v0[3]); s0.z = pk2(v0[4], v0[5]); s0.w = pk2(v0[6], v0[7]); s1.x = pk2(v1[0], v1[1]); s1.y = pk2(v1[2], v1[3]); s1.z = pk2(v1[4], v1[5]); s1.w = pk2(v1[6], v1[7]);
                            *(u32x4*)(strip + t8 * 8) = s0; *(u32x4*)(strip + 64 + t8 * 8) = s1; } }
                } else {
                    const int c = (tid & 255) * 2, th = tid >> 8; const bf16_t* pp = P + (tok0 + th * 32) * LDP + ML_OFF + 1024 + c; bf16_t* strip = VTG + ((size_t)seg * 512 + c) * 64 + th * 32;
                    unsigned rv[32];
#pragma unroll
                    for (int t = 0; t < 32; ++t) rv[t] = *(const unsigned*)(pp + (size_t)t * LDP);
#pragma unroll
                    for (int t8 = 0; t8 < 4; ++t8) { u32x4 s0, s1;
                        s0.x = (rv[t8 * 8 + 0] & 0xFFFFu) | (rv[t8 * 8 + 1] << 16); s0.y = (rv[t8 * 8 + 2] & 0xFFFFu) | (rv[t8 * 8 + 3] << 16); s0.z = (rv[t8 * 8 + 4] & 0xFFFFu) | (rv[t8 * 8 + 5] << 16); s0.w = (rv[t8 * 8 + 6] & 0xFFFFu) | (rv[t8 * 8 + 7] << 16);
                        s1.x = (rv[t8 * 8 + 0] >> 16) | (rv[t8 * 8 + 1] & 0xFFFF0000u); s1.y = (rv[t8 * 8 + 2] >> 16) | (rv[t8 * 8 + 3] & 0xFFFF0000u); s1.z = (rv[t8 * 8 + 4] >> 16) | (rv[t8 * 8 + 5] & 0xFFFF0000u); s1.w = (rv[t8 * 8 + 6] >> 16) | (rv[t8 * 8 + 7] & 0xFFFF0000u);
                        *(u32x4*)(strip + t8 * 8) = s0; *(u32x4*)(strip + 64 + t8 * 8) = s1; }
                }
            }
            if (!lastl) for (int tok = NLAT + bid; tok < NTOK; tok += G) {
                const int t = (tok - NLAT) & (CTXL - 1); const bool hasL = (t != 0), hasR = (t != CTXL - 1); const bf16_t* pr = P + (size_t)tok * LDP;
                const bf16_t* prL = hasL ? pr - LDP : pr; const bf16_t* prR = hasR ? pr + LDP : pr;
                unsigned xc[3], xl[3], xr[3];
#pragma unroll
                for (int j = 0; j < 3; ++j) { const int cc = tid + j * 512; xc[j] = pr[HY_OFF + cc]; xl[j] = prL[HY_OFF + cc]; xr[j] = prR[HY_OFF + cc]; }
#pragma unroll
                for (int j = 0; j < 3; ++j) { const int cc = tid + j * 512;
                    float acc = hcb[cc] + hcw[1536 + cc] * __uint_as_float(xc[j] << 16);
                    acc += hasL ? hcw[cc] * __uint_as_float(xl[j] << 16) : 0.f;
                    acc += hasR ? hcw[2 * 1536 + cc] * __uint_as_float(xr[j] << 16) : 0.f;
                    U[(size_t)tok * 1536 + cc] = acc; }
            }
            for (int idx0 = bid * NTHR + tid; idx0 < 16384 * 64; idx0 += 4 * G * NTHR) { u32x4 t4[4];
#pragma unroll
                for (int q = 0; q < 4; ++q) { const int idx = idx0 + q * G * NTHR; const int half = idx & 1, g = (idx >> 1) & 31, tok = idx >> 6;
                    if (idx < 16384 * 64) t4[q] = *(const u32x4*)(P + (size_t)tok * LDP + S5_OFF + g * 16 + half * 8); }
#pragma unroll
                for (int q = 0; q < 4; ++q) { const int idx = idx0 + q * G * NTHR; const int half = idx & 1, g = (idx >> 1) & 31, tok = idx >> 6;
                    if (idx < 16384 * 64) *(u32x4*)(S5A + ((size_t)g * 512 + (tok >> 5)) * 768 + (tok & 31) * 16 + half * 8) = t4[q]; } }
            for (int idx = bid * NTHR + tid; idx < 32 * 512 * 32 * 2; idx += G * NTHR) { const int half = idx & 1, sI = (idx >> 1) & 31, row = (idx >> 6) & 511, g = idx >> 15; const int t = row >> 4, c = row & 15; const int lag = t - sI;
                float v[8];
                if (lag > 0) { const float4* k4 = (const float4*)(KTB + ((size_t)((g * 2 + 0) * 32 + lag) * 16 + c) * 16 + half * 8); const float4 a0 = k4[0], a1 = k4[1]; v[0] = a0.x; v[1] = a0.y; v[2] = a0.z; v[3] = a0.w; v[4] = a1.x; v[5] = a1.y; v[6] = a1.z; v[7] = a1.w; }
                else if (lag < 0) { const float4* k4 = (const float4*)(KTB + ((size_t)((g * 2 + 1) * 32 - lag) * 16 + c) * 16 + half * 8); const float4 a0 = k4[0], a1 = k4[1]; v[0] = a0.x; v[1] = a0.y; v[2] = a0.z; v[3] = a0.w; v[4] = a1.x; v[5] = a1.y; v[6] = a1.z; v[7] = a1.w; }
                else { const float4* k4 = (const float4*)(KTB + ((size_t)((g * 2 + 0) * 32) * 16 + c) * 16 + half * 8); const float4* q4 = (const float4*)(KTB + ((size_t)((g * 2 + 1) * 32) * 16 + c) * 16 + half * 8); const float4 a0 = k4[0], a1 = k4[1], b0 = q4[0], b1 = q4[1];
                    v[0] = a0.x + b0.x; v[1] = a0.y + b0.y; v[2] = a0.z + b0.z; v[3] = a0.w + b0.w; v[4] = a1.x + b1.x; v[5] = a1.y + b1.y; v[6] = a1.z + b1.z; v[7] = a1.w + b1.w; }
                u32x4 w; w.x = pk2(v[0], v[1]); w.y = pk2(v[2], v[3]); w.z = pk2(v[4], v[5]); w.w = pk2(v[6], v[7]);
                *(u32x4*)(S5B + ((size_t)g * 512 + row) * 768 + sI * 16 + half * 8) = w; }
            for (int idx = bid * NTHR + tid; idx < 32 * 512 * 64; idx += G * NTHR) { const int n = idx & 63, row = (idx >> 6) & 511, g = idx >> 15; const int t = row >> 4, c = row & 15;
                const float cr = (PT(29) + l * 32 * 16 * 64)[(g * 16 + c) * 64 + n], ci = (PT(30) + l * 32 * 16 * 64)[(g * 16 + c) * 64 + n];
                const float2 af = APW[((0 * 32 + g) * 64 + n) * 33 + t + 1], ab = APW[((1 * 32 + g) * 64 + n) * 33 + 32 - t];
                bf16_t* d = S5B + ((size_t)g * 512 + row) * 768 + 512 + 2 * n;
                *(unsigned*)d = pk2(cr * af.x - ci * af.y, -(cr * af.y + ci * af.x)); *(unsigned*)(d + 128) = pk2(cr * ab.x - ci * ab.y, -(cr * ab.y + ci * ab.x)); }
            for (int idx = bid * NTHR + tid; idx < 32 * 2 * 64 * 32; idx += G * NTHR) { const int sI = idx & 31, n = (idx >> 5) & 63, dir = (idx >> 11) & 1, g = idx >> 12; const int pi = (dir * 32 + g) * 64 + n;
                const float2 pw = APW[pi * 33 + (dir ? sI : 31 - sI)]; const float4* bb = (const float4*)(BBT + pi * 16);
                float re[16], im[16];
#pragma unroll
                for (int j = 0; j < 8; ++j) { const float4 b2 = bb[j]; re[2 * j] = pw.x * b2.x - pw.y * b2.y; im[2 * j] = pw.x * b2.y + pw.y * b2.x; re[2 * j + 1] = pw.x * b2.z - pw.y * b2.w; im[2 * j + 1] = pw.x * b2.w + pw.y * b2.z; }
                bf16_t* d = S5P + ((size_t)g * 256 + dir * 128 + 2 * n) * 512 + sI * 16;
                u32x4 w0, w1; w0.x = pk2(re[0], re[1]); w0.y = pk2(re[2], re[3]); w0.z = pk2(re[4], re[5]); w0.w = pk2(re[6], re[7]); w1.x = pk2(re[8], re[9]); w1.y = pk2(re[10], re[11]); w1.z = pk2(re[12], re[13]); w1.w = pk2(re[14], re[15]);
                *(u32x4*)d = w0; *(u32x4*)(d + 8) = w1;
                w0.x = pk2(im[0], im[1]); w0.y = pk2(im[2], im[3]); w0.z = pk2(im[4], im[5]); w0.w = pk2(im[6], im[7]); w1.x = pk2(im[8], im[9]); w1.y = pk2(im[10], im[11]); w1.z = pk2(im[12], im[13]); w1.w = pk2(im[14], im[15]);
                *(u32x4*)(d + 512) = w0; *(u32x4*)(d + 520) = w1; }
            {   float* T0 = sf; float* T1 = sf + 64 * 65;
                const int NU = 4 * 64 * 24; const int cL = tid & 63, tL = tid >> 6, c = tid >> 3, tq = (tid & 7) * 8;
                for (int unit = bid; unit < NU; unit += 2 * G) { const bool has2 = unit + G < NU; const int unit2 = has2 ? unit + G : unit;
                    const int ba = unit / (64 * 24), ra = (unit / 24) % 64, c0a = (unit % 24) * 64; const size_t toka = (size_t)ba * SEQ + ra * 64;
                    const int bb_ = unit2 / (64 * 24), rb = (unit2 / 24) % 64, c0b = (unit2 % 24) * 64; const size_t tokb = (size_t)bb_ * SEQ + rb * 64;
                    unsigned pa[8], pb[8];
#pragma unroll
                    for (int i = 0; i < 8; ++i) { pa[i] = P[(toka + tL + 8 * i) * LDP + HY_OFF + c0a + cL]; pb[i] = P[(tokb + tL + 8 * i) * LDP + HY_OFF + c0b + cL]; }
                    const int cca = c0a + c, ccb = c0b + c;
                    const float w0a = hcw[cca], w1a = hcw[1536 + cca], w2a = hcw[3072 + cca], bia = hcb[cca], w0b = hcw[ccb], w1b = hcw[1536 + ccb], w2b = hcw[3072 + ccb], bib = hcb[ccb];
                    __syncthreads();
#pragma unroll
                    for (int i = 0; i < 8; ++i) { T0[(tL + 8 * i) * 65 + cL] = __uint_as_float(pa[i] << 16); T1[(tL + 8 * i) * 65 + cL] = __uint_as_float(pb[i] << 16); }
                    __syncthreads();
                    {   float o8[8];
#pragma unroll
                        for (int i = 0; i < 8; ++i) { const int t = tq + i; float acc = bia + w1a * T0[t * 65 + c]; if (t > 0) acc += w0a * T0[(t - 1) * 65 + c]; if (t < 63) acc += w2a * T0[(t + 1) * 65 + c]; o8[i] = acc; }
                        u32x4 wv; wv.x = pk2(o8[0], o8[1]); wv.y = pk2(o8[2], o8[3]); wv.z = pk2(o8[4], o8[5]); wv.w = pk2(o8[6], o8[7]);
                        *(u32x4*)(UT + ((size_t)ba * 1536 + cca) * SEQ + ra * 64 + tq) = wv; }
                    if (has2) { float o8[8];
#pragma unroll
                        for (int i = 0; i < 8; ++i) { const int t = tq + i; float acc = bib + w1b * T1[t * 65 + c]; if (t > 0) acc += w0b * T1[(t - 1) * 65 + c]; if (t < 63) acc += w2b * T1[(t + 1) * 65 + c]; o8[i] = acc; }
                        u32x4 wv; wv.x = pk2(o8[0], o8[1]); wv.y = pk2(o8[2], o8[3]); wv.z = pk2(o8[4], o8[5]); wv.w = pk2(o8[6], o8[7]);
                        *(u32x4*)(UT + ((size_t)bb_ * 1536 + ccb) * SEQ + rb * 64 + tq) = wv; }
                } }
            if (!lastl) {
                const int L = CTXL; const float* HR = HRAW + (size_t)SEQ * 2048; float* K2 = K2C; const float* nrm = NORM + (size_t)(l * 2 + 1) * 1024;
                const size_t total = (size_t)(2 * L - 1) * 1024;
                for (size_t i = (size_t)bid * NTHR + tid; i < total; i += (size_t)G * NTHR) { const int j = (int)(i >> 10), oc = (int)(i & 1023), o = oc >> 9, c = oc & 511; const int lag = j - (L - 1);
                    const float v = lag >= 0 ? HR[(size_t)lag * 2048 + o * 1024 + c] : HR[(size_t)(-lag) * 2048 + o * 1024 + 512 + c];
                    K2[((size_t)j * 2 + o) * 512 + c] = v / nrm[oc]; }
            }
            {   __syncthreads(); fft_twiddles((float2*)(shm + FFT_X_BYTES), tid);
                for (int pr = bid; pr < 512; pr += G) hyena_spec_item(pr, HRAW, NORM + (size_t)(l * 2 + 0) * 1024, HSPEC, shm, tid);
                __syncthreads(); }
            SEAM(PB + 2);
        }

        if (IN(PB + 3)) for (int rep_ = 0; rep_ < PROBE_REPS(3); ++rep_) {
            PH_BEGIN
            if (rep_ > 0) { if (bid == 0 && tid == 0) __hip_atomic_store(QCTR + l * 64, 0, __ATOMIC_RELAXED, __HIP_MEMORY_SCOPE_AGENT); xcd_barrier(bar); }
            if (bid < 64) {
                mlstm_state_pass(bid >> 1, bid & 1, P, KTG, VTG, PT(22) + l * 16, CST, NST, MST, shm, tid);
            } else if (bid < 128) {
                { const int ch = bid - 64; const int dir_ = ch & 1, h_ = (ch >> 1) & 7; ssd_state_pass(ch, P, BTG, XTG, -expf(PT(37)[l * 16 + dir_ * 8 + h_]), PT(36)[l * 16 + dir_ * 8 + h_], SSTB, shm, tid); }
            } else if (bid < 160) {
                const int widx = (bid - 128) * 8 + wave; const int dir = widx & 1, g = (widx >> 1) & 31, b = widx >> 6; const int n = lane;
                float2* xb = (float2*)(shm + (size_t)wave * 16640); float2* ctab = xb + 16 * 65;
                const float* a_re = PT(24) + l * 2 * 32 * 64; const float* a_im = PT(25) + l * 2 * 32 * 64; const float* log_dt = PT(26) + l * 64;
                const float* b_re = PT(27) + l * 32 * 64 * 16; const float* b_im = PT(28) + l * 32 * 64 * 16; const float* c_re = PT(29) + l * 32 * 16 * 64; const float* c_im = PT(30) + l * 32 * 16 * 64;
#pragma unroll
                for (int c = 0; c < 16; ++c) ctab[c * 65 + lane] = make_float2(c_re[(g * 16 + c) * 64 + lane], c_im[(g * 16 + c) * 64 + lane]);
                float abr, abi, bbr[16], bbi[16];
                {   const double are = (double)a_re[(dir * 32 + g) * 64 + n], aim = (double)a_im[(dir * 32 + g) * 64 + n];
                    const double lam = are < -1e-4 ? are : -1e-4; const double dt = exp((double)log_dt[dir * 32 + g]);
                    const double mag = exp(lam * dt); const double ar = mag * cos(aim * dt), ai = mag * sin(aim * dt);
                    const double den = lam * lam + aim * aim; const double nr = ar - 1.0, ni = ai;
                    const double fre = (nr * lam + ni * aim) / den, fim = (ni * lam - nr * aim) / den;
                    abr = (float)ar; abi = (float)ai;
#pragma unroll
                    for (int c = 0; c < 16; ++c) { const double br = (double)b_re[(g * 64 + n) * 16 + c], bi = (double)b_im[(g * 64 + n) * 16 + c]; bbr[c] = (float)(fre * br - fim * bi); bbi[c] = (float)(fre * bi + fim * br); }
                }
                float xr = 0.f, xi = 0.f; float* Sout = (dir ? SB : SF) - (size_t)NLAT * BW;
                const int s = lane >> 2, cg = lane & 3;
                for (int i0 = 0; i0 < CTXL; i0 += 16) {
#pragma unroll 4
                    for (int ss = 0; ss < 16; ++ss) {
                        const size_t tok = (size_t)step_tok(b, dir, i0 + ss);
                        const u32x4* up = (const u32x4*)(P + tok * LDP + S5_OFF + g * 16);
                        float t0[8], t1[8]; unpack8(up[0], t0); unpack8(up[1], t1);
                        float bur = 0.f, bui = 0.f;
#pragma unroll
                        for (int c = 0; c < 8; ++c) { bur += t0[c] * bbr[c] + t1[c] * bbr[8 + c]; bui += t0[c] * bbi[c] + t1[c] * bbi[8 + c]; }
                        const float nxr = abr * xr - abi * xi + bur, nxi = abr * xi + abi * xr + bui; xr = nxr; xi = nxi;
                        xb[ss * 65 + lane] = make_float2(xr, xi);
                    }
                    asm volatile("s_waitcnt lgkmcnt(0)" ::: "memory");
                    float y0 = 0.f, y1 = 0.f, y2 = 0.f, y3 = 0.f;
                    for (int nn2 = 0; nn2 < 64; ++nn2) { const float2 xv = xb[s * 65 + nn2];
                        const float2 c0 = ctab[(cg * 4 + 0) * 65 + nn2], c1 = ctab[(cg * 4 + 1) * 65 + nn2], c2 = ctab[(cg * 4 + 2) * 65 + nn2], c3 = ctab[(cg * 4 + 3) * 65 + nn2];
                        y0 += xv.x * c0.x - xv.y * c0.y; y1 += xv.x * c1.x - xv.y * c1.y; y2 += xv.x * c2.x - xv.y * c2.y; y3 += xv.x * c3.x - xv.y * c3.y; }
                    const size_t toks = (size_t)step_tok(b, dir, i0 + s);
                    *(float4*)(Sout + toks * BW + g * 16 + cg * 4) = make_float4(y0, y1, y2, y3);
                    asm volatile("s_waitcnt lgkmcnt(0)" ::: "memory");
                }
                XCTX[((b * 32 + g) * 2 + dir) * 64 + n] = make_float2(xr, xi);
            } else {
                if (bid < 224) {
                    pg8::Gemm gg_{S5A, S5P, 768, 512, 512}; pg8::SchedS5a S_{bid - 160}; pg8::EpiXloc E_{XLOC};
                    pg8::gemm_phase((LAS unsigned char*)shm, gg_, S_, E_);
                    __syncthreads();
                }
                const int nhb = G - 160, hb = bid - 160; const float* bias = PT(19) + l * 1024; const int c = tid;
                const int nitems = lastl ? 0 : 4 * (CTXL / 8);
                for (int it = hb; it < nitems; it += nhb) {
                    int L, tokbase, b, t0; const float* K2;
                    { const int q = it; L = CTXL; tokbase = NLAT; b = q / (CTXL / 8); t0 = (q % (CTXL / 8)) * 8; K2 = K2C; }
                    const float* zb = U + (size_t)(tokbase + b * L) * 1536 + c;
                    float acc[8];
#pragma unroll
                    for (int i = 0; i < 8; ++i) acc[i] = 0.f;
                    const int base = t0 + L - 1;
                    for (int s = 0; s < L; s += 8) {
                        float k[15];
#pragma unroll
                        for (int mm = 0; mm < 15; ++mm) k[mm] = K2[((size_t)(base - s - 7 + mm) * 2 + 0) * 512 + c];
#pragma unroll
                        for (int ds = 0; ds < 8; ++ds) { const float z = zb[(size_t)(s + ds) * 1536];
#pragma unroll
                            for (int i = 0; i < 8; ++i) acc[i] += k[i - ds + 7] * z; }
                    }
#pragma unroll
                    for (int i = 0; i < 8; ++i) { const size_t tok = (size_t)(tokbase + b * L + t0 + i); const float zt = U[tok * 1536 + c]; Z[tok * BW + c] = (acc[i] + bias[c] * zt) * U[tok * 1536 + 512 + c]; }
                }
            }
            {   __syncthreads(); fft_twiddles((float2*)(shm + FFT_X_BYTES), tid);
                int* qslot = (int*)(shm + FFT_X_BYTES + 65536);
                for (;;) { __syncthreads(); if (tid == 0) *qslot = atomicAdd(QCTR + l * 64, 1); __syncthreads(); const int it = *qslot; if (it >= 1024) break;
                    hyena_fft_item(it, UT, HSPEC, PT(19) + l * 1024, YT, shm, tid); }
            }
            SEAM(PB + 3);
        }

        if (IN(PB + 4)) for (int rep_ = 0; rep_ < PROBE_REPS(4); ++rep_) {
            PH_BEGIN
            if (rep_ > 0) { if (bid == 0 && tid == 0) __hip_atomic_store(QCTR + l * 64 + 32, 0, __ATOMIC_RELAXED, __HIP_MEMORY_SCOPE_AGENT); xcd_barrier(bar); }
            if (bid >= G - 32) for (int idx = (bid - (G - 32)) * NTHR + tid; idx < 16384; idx += 32 * NTHR) { const int n = idx & 63, dir = (idx >> 6) & 1, b = (idx >> 7) & 3, g = idx >> 9;
                const float2 a32 = APW[((dir * 32 + g) * 64 + n) * 33 + 32]; float2 X = XCTX[((b * 32 + g) * 2 + dir) * 64 + n];
                const float* __restrict__ xl = XLOC + ((size_t)g * 512 + b * 128) * 256 + dir * 128 + 2 * n; bf16_t* __restrict__ dst = S5A + ((size_t)g * 512 + b * 128) * 768 + 512 + dir * 128 + 2 * n;
#pragma unroll 1
                for (int j0 = 0; j0 < 128; j0 += 16) { float2 xv[16];
#pragma unroll
                    for (int q = 0; q < 16; ++q) { const int j = dir ? 127 - (j0 + q) : j0 + q; xv[q] = *(const float2*)(xl + (size_t)j * 256); }
#pragma unroll
                    for (int q = 0; q < 16; ++q) { const int j = dir ? 127 - (j0 + q) : j0 + q;
                        *(unsigned*)(dst + (size_t)j * 768) = pk2(X.x, X.y);
                        const float nx = a32.x * X.x - a32.y * X.y + xv[q].x, ny = a32.x * X.y + a32.y * X.x + xv[q].y; X.x = nx; X.y = ny; } } }
            {   int* qslot = (int*)(shm + 102400);
                __syncthreads(); if (tid == 0) *qslot = atomicAdd(QCTR + l * 64 + 32, 1); __syncthreads();
                for (;;) { const int it = *qslot; if (it >= 32 * 68 + 64 * 68) break;
                    int nxt_ = 0; if (tid == 0) nxt_ = atomicAdd(QCTR + l * 64 + 32, 1);
                    if (it < 32 * 68) { const int chain = it / 68, c = it % 68; mlstm_out_item(chain, c, P, QKB, VTG, PT(22) + l * 16, CST, NST, MST, (chain & 1) ? HBk : HF, shm, tid); }
                    else { const int i2 = it - 32 * 68; const int chain = i2 / 68, c = i2 % 68; const int dir_ = chain & 1, h_ = (chain >> 1) & 7;
                        ssd_out_item(chain, c, P, XBC, XTG, -expf(PT(37)[l * 16 + dir_ * 8 + h_]), PT(36)[l * 16 + dir_ * 8 + h_], SSTB, dir_ ? YB : YF, shm, tid); }
                    __syncthreads(); if (tid == 0) *qslot = nxt_; __syncthreads(); }
            }
            __syncthreads();
            {   const float* bias = PT(19) + l * 1024 + 512; const int c = tid;
                const int nitems = lastl ? 0 : 4 * (CTXL / 8);
                for (int it = bid; it < nitems; it += G) {
                    int L, tokbase, b, t0; const float* K2;
                    { const int q = it; L = CTXL; tokbase = NLAT; b = q / (CTXL / 8); t0 = (q % (CTXL / 8)) * 8; K2 = K2C; }
                    const float* zb = Z + (size_t)(tokbase + b * L) * BW + c;
                    float acc[8];
#pragma unroll
                    for (int i = 0; i < 8; ++i) acc[i] = 0.f;
                    const int base = t0 + L - 1;
                    for (int s = 0; s < L; s += 8) {
                        float k[15];
#pragma unroll
                        for (int mm = 0; mm < 15; ++mm) k[mm] = K2[((size_t)(base - s - 7 + mm) * 2 + 1) * 512 + c];
#pragma unroll
                        for (int ds = 0; ds < 8; ++ds) { const float z = zb[(size_t)(s + ds) * BW];
#pragma unroll
                            for (int i = 0; i < 8; ++i) acc[i] += k[i - ds + 7] * z; }
                    }
#pragma unroll
                    for (int i = 0; i < 8; ++i) { const size_t tok = (size_t)(tokbase + b * L + t0 + i); const float zt = Z[tok * BW + c]; Y4[tok * DM + c] = f2bf((acc[i] + bias[c] * zt) * U[tok * 1536 + 1024 + c]); }
                }
            }
            SEAM(PB + 4);
        }

        if (IN(PB + 5)) for (int rep_ = 0; rep_ < PROBE_REPS(5); ++rep_) {
            PH_BEGIN
            const float* ml_norm = PT(23) + l * BW; const float* ssd_d = PT(38) + l * 8; const float* ssd_norm = PT(39) + l * BW; const float* s5_d = PT(31) + l * BW;
            if (bid < 128) {
                pg8::Gemm gg_{S5A, S5B, 768, 768, 768}; pg8::SchedS5b S_{bid}; pg8::EpiS5Out E_{P, s5_d, GG};
                pg8::gemm_phase((LAS unsigned char*)shm, gg_, S_, E_);
                __syncthreads();
            }
            for (int tok = bid * 8 + wave; tok < NTOK; tok += G * 8) {
                const int c0 = lane * 8; const bf16_t* pr = P + (size_t)tok * LDP; const size_t o5 = (size_t)tok * BW + c0;
                float hm[8], ys[8];
                const u32x4 ooq = *(const u32x4*)(pr + ML_OFF + 1536 + c0);
                const float4 g0 = *(const float4*)(ml_norm + c0), g1 = *(const float4*)(ml_norm + c0 + 4), n0 = *(const float4*)(ssd_norm + c0), n1 = *(const float4*)(ssd_norm + c0 + 4);
                { float fa[8], fb[8]; unpack8(*(const u32x4*)(HF + o5), fa); unpack8(*(const u32x4*)(HBk + o5), fb);
#pragma unroll
                  for (int j = 0; j < 8; ++j) hm[j] = fa[j] + fb[j]; }
                { float ya[8], yb[8]; unpack8(*(const u32x4*)(YF + o5), ya); unpack8(*(const u32x4*)(YB + o5), yb);
                  float xx[8], zz[8]; unpack8(*(const u32x4*)(XBC + (size_t)tok * 1024 + c0), xx); unpack8(*(const u32x4*)(pr + SSD_OFF + c0), zz); const float dsk = ssd_d[c0 >> 6];
#pragma unroll
                  for (int j = 0; j < 8; ++j) ys[j] = ya[j] + yb[j];
#pragma unroll
                  for (int j = 0; j < 8; ++j) ys[j] = (ys[j] + dsk * xx[j]) * siluf_(zz[j]); }
                float s1 = 0.f, s2 = 0.f;
#pragma unroll
                for (int j = 0; j < 8; ++j) { s1 += hm[j] * hm[j]; s2 += ys[j] * ys[j]; }
                s1 += __shfl_xor(s1, 1); s1 += __shfl_xor(s1, 2); s1 += __shfl_xor(s1, 4); s1 += __shfl_xor(s1, 8);
                s2 = wave_sum(s2);
                const float r1 = rsqrtf(s1 * (1.0f / 128.0f) + 1e-6f), r2 = rsqrtf(s2 * (1.0f / BW) + 1e-6f);
                float oo[8]; unpack8(ooq, oo);
                const float gm[8] = {g0.x, g0.y, g0.z, g0.w, g1.x, g1.y, g1.z, g1.w}, gs[8] = {n0.x, n0.y, n0.z, n0.w, n1.x, n1.y, n1.z, n1.w};
                u32x4 w;
                w.x = pk2(hm[0] * r1 * gm[0] * sigmoidf_(oo[0]), hm[1] * r1 * gm[1] * sigmoidf_(oo[1])); w.y = pk2(hm[2] * r1 * gm[2] * sigmoidf_(oo[2]), hm[3] * r1 * gm[3] * sigmoidf_(oo[3]));
                w.z = pk2(hm[4] * r1 * gm[4] * sigmoidf_(oo[4]), hm[5] * r1 * gm[5] * sigmoidf_(oo[5])); w.w = pk2(hm[6] * r1 * gm[6] * sigmoidf_(oo[6]), hm[7] * r1 * gm[7] * sigmoidf_(oo[7]));
                *(u32x4*)(Y4 + (size_t)tok * DM + 512 + c0) = w;
                w.x = pk2(ys[0] * r2 * gs[0], ys[1] * r2 * gs[1]); w.y = pk2(ys[2] * r2 * gs[2], ys[3] * r2 * gs[3]); w.z = pk2(ys[4] * r2 * gs[4], ys[5] * r2 * gs[5]); w.w = pk2(ys[6] * r2 * gs[6], ys[7] * r2 * gs[7]);
                *(u32x4*)(Y4 + (size_t)tok * DM + 1536 + c0) = w;
                if (tok >= NLAT) { const size_t oc = (size_t)(tok - NLAT) * BW + c0; float uu[8]; unpack8(*(const u32x4*)(pr + S5_OFF + c0), uu);
                    const float4 a0 = *(const float4*)(SF + oc), a1 = *(const float4*)(SF + oc + 4), b0 = *(const float4*)(SB + oc), b1 = *(const float4*)(SB + oc + 4), d0 = *(const float4*)(s5_d + c0), d1 = *(const float4*)(s5_d + c0 + 4);
                    float y[8] = {a0.x + b0.x + d0.x * uu[0], a0.y + b0.y + d0.y * uu[1], a0.z + b0.z + d0.z * uu[2], a0.w + b0.w + d0.w * uu[3], a1.x + b1.x + d1.x * uu[4], a1.y + b1.y + d1.y * uu[5], a1.z + b1.z + d1.z * uu[6], a1.w + b1.w + d1.w * uu[7]};
#pragma unroll
                    for (int j = 0; j < 8; ++j) y[j] = 0.5f * y[j] * (1.0f + tanhf(0.7978845608028654f * (y[j] + 0.044715f * y[j] * y[j] * y[j])));
                    w.x = pk2(y[0], y[1]); w.y = pk2(y[2], y[3]); w.z = pk2(y[4], y[5]); w.w = pk2(y[6], y[7]);
                    *(u32x4*)(GG + (size_t)tok * BW + c0) = w; }
            }
            __syncthreads();
            {   float* T = sf;
                for (int unit = (G > 128 ? bid - 128 : bid); unit >= 0 && unit < 4 * 64 * 8; unit += (G > 128 ? G - 128 : G)) { const int b = unit / 512, t0 = ((unit >> 3) & 63) * 64, c0 = (unit & 7) * 64;
                    __syncthreads();
#pragma unroll
                    for (int i = 0; i < 8; ++i) { const int t = tid & 63, c = (tid >> 6) + 8 * i; T[c * 65 + t] = YT[((size_t)b * 512 + c0 + c) * SEQ + t0 + t]; }
                    __syncthreads();
                    const int t = tid >> 3, cq = (tid & 7) * 8;
                    u32x4 w; w.x = pk2(T[(cq + 0) * 65 + t], T[(cq + 1) * 65 + t]); w.y = pk2(T[(cq + 2) * 65 + t], T[(cq + 3) * 65 + t]); w.z = pk2(T[(cq + 4) * 65 + t], T[(cq + 5) * 65 + t]); w.w = pk2(T[(cq + 6) * 65 + t], T[(cq + 7) * 65 + t]);
                    *(u32x4*)(Y4 + ((size_t)b * SEQ + t0 + t) * DM + c0 + cq) = w;
                } }
            SEAM(PB + 5);
        }

        if (IN(PB + 6)) for (int rep_ = 0; rep_ < PROBE_REPS(6); ++rep_) {
            PH_BEGIN
            pg8::Gemm g{GG, GLU, BW, BW, BW}; pg8::SchedStd S{68, 2, G, bid, BW, BW}; pg8::EpiGlu E{GG, PT(33) + l * BW, Y4};
            pg8::gemm_phase((LAS unsigned char*)shm, g, S, E);
            SEAM(PB + 6);
        }
        if (IN(PB + 7)) for (int rep_ = 0; rep_ < PROBE_REPS(7); ++rep_) {
            PH_BEGIN
            pg8::Gemm g{Y4, WBR, DM, BW, BW}; pg8::SchedBranch S{64, 8, G, bid}; pg8::EpiBranch E{P, ACCb};
            pg8::gemm_phase((LAS unsigned char*)shm, g, S, E);
            if (!lastl) { __syncthreads(); pg8::SchedTail S2{G, bid}; pg8::EpiPart E2{P, (float*)HSPEC}; pg8::gemm_phase((LAS unsigned char*)shm, g, S2, E2); }
            SEAM(PB + 7);
        }
        if (IN(PB + 8)) for (int rep_ = 0; rep_ < PROBE_REPS(8); ++rep_) {
            PH_BEGIN
            if (!lastl) {
                const float* PART = (const float*)HSPEC;
                for (int idx = bid * NTHR + tid; idx < (NTOK - NLAT) * DM / 8; idx += G * NTHR) { const size_t o = (size_t)idx * 8; f32x4 p[4][2];
#pragma unroll
                    for (int k = 0; k < 4; ++k) { p[k][0] = *(const f32x4*)(PART + (size_t)k * (NTOK - NLAT) * DM + o); p[k][1] = *(const f32x4*)(PART + (size_t)k * (NTOK - NLAT) * DM + o + 4); }
                    const f32x4 s0 = ((p[0][0] + p[1][0]) + p[2][0]) + p[3][0], s1 = ((p[0][1] + p[1][1]) + p[2][1]) + p[3][1];
                    u32x4 w; w.x = pk2(s0[0], s0[1]); w.y = pk2(s0[2], s0[3]); w.z = pk2(s1[0], s1[1]); w.w = pk2(s1[2], s1[3]);
                    *(u32x4*)(ACCb + (size_t)NLAT * DM + o) = w; }
                xcd_barrier(bar);
            }
            pg8::Gemm g{ACCb, WOUT, DM, DM, DM}; pg8::SchedStd S{64, 8, G, bid, DM, DM}; pg8::EpiResid E{XS, l == 0 ? x_in : (const float*)XS, l == 0 ? ctx_in - (size_t)NLAT * DM : (const float*)XS, MODl, 2};
            pg8::gemm_phase((LAS unsigned char*)shm, g, S, E);
            if (!lastl) { __syncthreads(); pg8::Gemm g2{ACCb, WOUT, DM, DM, 512}; pg8::SchedTailK S2{G, bid}; pg8::EpiPartK E2{(float*)HSPEC + (size_t)4 * (NTOK - NLAT) * DM}; pg8::gemm_phase((LAS unsigned char*)shm, g2, S2, E2); }
            SEAM(PB + 8);
        }
        if (IN(PB + 9)) for (int rep_ = 0; rep_ < PROBE_REPS(9); ++rep_) {
            PH_BEGIN
            if (!lastl) {
                const float* PART = (const float*)HSPEC + (size_t)4 * (NTOK - NLAT) * DM; const float* mg = MODl + (size_t)(4 * 6 + 2) * DM;
                const float* src = l == 0 ? ctx_in : (const float*)XS + (size_t)NLAT * DM;
                for (int idx = bid * NTHR + tid; idx < (NTOK - NLAT) * DM / 4; idx += G * NTHR) { const size_t o = (size_t)idx * 4; const int col = (int)(o & (DM - 1));
                    const f32x4 p0 = *(const f32x4*)(PART + o), p1 = *(const f32x4*)(PART + (size_t)(NTOK - NLAT) * DM + o), p2 = *(const f32x4*)(PART + (size_t)2 * (NTOK - NLAT) * DM + o), p3 = *(const f32x4*)(PART + (size_t)3 * (NTOK - NLAT) * DM + o);
                    const f32x4 sv = *(const f32x4*)(src + o), gm = *(const f32x4*)(mg + col);
                    *(f32x4*)(XS + (size_t)NLAT * DM + o) = sv + gm * (((p0 + p1) + p2) + p3); }
                xcd_barrier(bar);
            }
            for (int i = bid * NTHR + tid; i < NEXP * MOE_PAD; i += G * NTHR) ROWTOK[i] = -1;
            for (int i = bid * NTHR + tid; i < NTOK * 16; i += G * NTHR) INV[i] = -1;
            const float* wr = PT(42) + (size_t)l * DM * 16; const float* gn = norm_ffn + l * DM;
            for (int tok0 = (bid * 8 + wave) * 4; tok0 < M2; tok0 += G * 32) {
                const int r = tok0 < NLAT ? tok0 / SEQ : 4; const float* xr = XS + (size_t)tok0 * DM;
                const float* sh = MODl + (size_t)(r * 6 + 3) * DM; const float* sc = MODl + (size_t)(r * 6 + 4) * DM;
                float rs[4];
#pragma unroll
                for (int tk = 0; tk < 4; ++tk) { float ss = 0.f;
#pragma unroll 4
                    for (int i = 0; i < 8; ++i) { const float4 t4 = *(const float4*)(xr + (size_t)tk * DM + i * 256 + lane * 4); ss += t4.x * t4.x + t4.y * t4.y + t4.z * t4.z + t4.w * t4.w; }
                    ss = wave_sum(ss); rs[tk] = rsqrtf(ss * (1.0f / DM) + 1e-6f); }
                float lg[4][16];
#pragma unroll
                for (int tk = 0; tk < 4; ++tk)
#pragma unroll
                    for (int e = 0; e < 16; ++e) lg[tk][e] = 0.f;
#pragma unroll 1
                for (int i = 0; i < 8; ++i) { const int d = i * 256 + lane * 4;
                    const float4 g4 = *(const float4*)(gn + d), s4 = *(const float4*)(sc + d), h4 = *(const float4*)(sh + d);
                    float4 xq[4], ww[16];
#pragma unroll
                    for (int tk = 0; tk < 4; ++tk) xq[tk] = *(const float4*)(xr + (size_t)tk * DM + d);
                    const float4* wq = (const float4*)(wr + (size_t)d * 16);
#pragma unroll
                    for (int q = 0; q < 16; ++q) ww[q] = wq[q];
                    float hv[4][4];
#pragma unroll
                    for (int tk = 0; tk < 4; ++tk) { const float4 xv = xq[tk]; const float rr = rs[tk];
                        hv[tk][0] = xv.x * rr * g4.x * (1.f + s4.x) + h4.x; hv[tk][1] = xv.y * rr * g4.y * (1.f + s4.y) + h4.y; hv[tk][2] = xv.z * rr * g4.z * (1.f + s4.z) + h4.z; hv[tk][3] = xv.w * rr * g4.w * (1.f + s4.w) + h4.w;
                        u32x2 w; w.x = pk2(hv[tk][0], hv[tk][1]); w.y = pk2(hv[tk][2], hv[tk][3]); *(u32x2*)(HB + (size_t)(tok0 + tk) * DM + d) = w; }
#pragma unroll
                    for (int q = 0; q < 4; ++q) { const float4 w0 = ww[q * 4 + 0], w1 = ww[q * 4 + 1], w2 = ww[q * 4 + 2], w3 = ww[q * 4 + 3];
#pragma unroll
                        for (int tk = 0; tk < 4; ++tk) { const float hq = hv[tk][q];
                            lg[tk][0] += hq * w0.x; lg[tk][1] += hq * w0.y; lg[tk][2] += hq * w0.z; lg[tk][3] += hq * w0.w; lg[tk][4] += hq * w1.x; lg[tk][5] += hq * w1.y; lg[tk][6] += hq * w1.z; lg[tk][7] += hq * w1.w;
                            lg[tk][8] += hq * w2.x; lg[tk][9] += hq * w2.y; lg[tk][10] += hq * w2.z; lg[tk][11] += hq * w2.w; lg[tk][12] += hq * w3.x; lg[tk][13] += hq * w3.y; lg[tk][14] += hq * w3.z; lg[tk][15] += hq * w3.w; } } }
#pragma unroll
                for (int tk = 0; tk < 4; ++tk) { float mx = -1e30f;
#pragma unroll
                    for (int e = 0; e < 16; ++e) { lg[tk][e] = wave_sum(lg[tk][e]); mx = fmaxf(mx, lg[tk][e]); }
                    float sm = 0.f;
#pragma unroll
                    for (int e = 0; e < 16; ++e) { lg[tk][e] = expf(lg[tk][e] - mx); sm += lg[tk][e]; }
                    const float inv = 1.0f / sm;
                    if (lane == 0) {
#pragma unroll
                        for (int e = 0; e < 16; e += 4) *(float4*)(PROBS + (size_t)(tok0 + tk) * 16 + e) = make_float4(lg[tk][e] * inv, lg[tk][e + 1] * inv, lg[tk][e + 2] * inv, lg[tk][e + 3] * inv); } }
            }
            SEAM(PB + 9);
        }
        if (IN(PB + 10)) for (int rep_ = 0; rep_ < PROBE_REPS(10); ++rep_) {
            PH_BEGIN
            const int nitems = 64 + (lastl ? 0 : 64);
            unsigned long long* keys = (unsigned long long*)shm;
            for (int it = bid; it < nitems; it += G) {
                const int set = it >> 6, e = it & 15, b = (it >> 4) & 3;
                const int n = set ? CTXL : SEQ, cap = set ? 32 : 512, tokbase = set ? NLAT + b * CTXL : b * SEQ;
                __syncthreads();
                for (int i = tid; i < n; i += NTHR) keys[i] = ((unsigned long long)__float_as_uint(PROBS[(size_t)(tokbase + i) * 16 + e]) << 32) | (unsigned long long)(0xFFFFFFFFu - (unsigned)i);
                __syncthreads();
                for (int k = 2; k <= n; k <<= 1)
                    for (int j = k >> 1; j > 0; j >>= 1) {
                        for (int p = tid; p < (n >> 1); p += NTHR) { const int i = ((p & ~(j - 1)) << 1) | (p & (j - 1)); const int m = i | j;
                            const unsigned long long ka = keys[i], kb = keys[m]; const bool desc = ((i & k) == 0);
                            if ((ka < kb) == desc) { keys[i] = kb; keys[m] = ka; } }
                        __syncthreads();
                    }
                for (int r = tid; r < cap; r += NTHR) { const unsigned long long kk = keys[r]; const int row = e * MOE_PAD + (set ? 2048 + b * 32 + r : b * 512 + r);
                    const int tk_ = tokbase + (int)(0xFFFFFFFFu - (unsigned)(kk & 0xFFFFFFFFull)); ROWTOK[row] = tk_; ROWGATE[row] = __uint_as_float((unsigned)(kk >> 32)); INV[tk_ * 16 + e] = row; }
                for (int rb = 0; rb < cap; rb += 32) {
                    u32x4 t4[4][4];
#pragma unroll
                    for (int q = 0; q < 4; ++q) { const int r = rb + wave + 8 * q; const int tok = tokbase + (int)(0xFFFFFFFFu - (unsigned)(keys[r] & 0xFFFFFFFFull));
                        const u32x4* sp = (const u32x4*)(HB + (size_t)tok * DM);
#pragma unroll
                        for (int i = 0; i < 4; ++i) t4[q][i] = sp[i * 64 + lane]; }
#pragma unroll
                    for (int q = 0; q < 4; ++q) { const int r = rb + wave + 8 * q; const int row = e * MOE_PAD + (set ? 2048 + b * 32 + r : b * 512 + r);
                        u32x4* dp = (u32x4*)(XG + (size_t)row * DM);
#pragma unroll
                        for (int i = 0; i < 4; ++i) dp[i * 64 + lane] = t4[q][i]; } }
            }
            if (!lastl && G > 128 && bid >= 128) {
                const int n_win = 32 * 55, n_br = 4 * 64, n_out = 32 * 8, n_glu = 16, n_gu = 16 * 2 * 192; (void)n_gu;
                CV_RUN(l + 1, bid - 128, G - 128, n_win); (void)n_br; (void)n_out; (void)n_glu;
            }
            {   const int pad0 = lastl ? 2048 : MOE_ROWS, npad = MOE_PAD - pad0;
                for (int R = bid * 8 + wave; R < NEXP * npad; R += G * 8) { const int e = R / npad, rr = pad0 + R % npad; u32x4* dp = (u32x4*)(XG + ((size_t)e * MOE_PAD + rr) * DM);
#pragma unroll
                    for (int i = 0; i < 4; ++i) dp[i * 64 + lane] = (u32x4){0u, 0u, 0u, 0u}; } }
            SEAM(PB + 10);
        }
        if (IN(PB + 12)) for (int rep_ = 0; rep_ < PROBE_REPS(12); ++rep_) {
            PH_BEGIN
            pg8::Gemm g{XG, WGU, DM, DM, DM}; pg8::SchedMoe S{lastl ? 8 : 9, 12, G, bid, DM, DM, 2 * DEXP}; pg8::EpiMoe1 E{HID};
            pg8::gemm_phase((LAS unsigned char*)shm, g, S, E);
            SEAM(PB + 12);
        }
        if (IN(PB + 13)) for (int rep_ = 0; rep_ < PROBE_REPS(13); ++rep_) {
            PH_BEGIN
            pg8::Gemm g{HID, WD, DEXP, DEXP, DEXP}; pg8::SchedMoe S{lastl ? 8 : 9, 8, G, bid, DEXP, DEXP, DM}; pg8::EpiMoeY E{YEXP};
            pg8::gemm_phase((LAS unsigned char*)shm, g, S, E);
            SEAM(PB + 13);
        }

}

__global__ __launch_bounds__(NTHR, 2) void fwd(Args a) {
    extern __shared__ __attribute__((aligned(16))) unsigned char shm[];
    const int bid = blockIdx.x, G = gridDim.x;
    float* const sf = (float*)shm;
    volatile LAS unsigned* xbw = (volatile LAS unsigned*)((LAS unsigned char*)shm + (LDS_BYTES - 16));
    if (threadIdx.x == 0) { xbw[0] = 0u; xbw[1] = 0u; xbw[2] = 0u; xbw[3] = 0u; }
    const float** const ptab = (const float**)(shm + (LDS_BYTES - 16 - 512));
    if (threadIdx.x == 0) {
#pragma unroll
        for (int i = 0; i < 47; ++i) ptab[i] = a.in[i]; }
    __syncthreads();
    XcdBarrier bar = xcd_barrier_post((unsigned*)(a.ws + O_BAR), xbw);
    const int lo = a.ph_lo, hi = a.ph_hi;
    if (IN(0)) {
        PH_BEGIN
        {
            __syncthreads();
            for (int i = tid; i < 5 * DM; i += NTHR) { const int r = i >> 11, k = i & (DM - 1); const float v = r < 4 ? c_in[r * DM + k] : cctx_in[k]; sf[i] = siluf_(v); }
            __syncthreads();
            float* red = sf + 5 * DM;
            for (int unit = bid; unit < 2 * 96; unit += G) { const int l = unit / 96, j = (unit % 96) * 128 + (tid & 127), kq = tid >> 7;
                const float* w = ada_w + (size_t)l * DM * (6 * DM) + (size_t)(kq * 512) * (6 * DM) + j; const float* sv = sf + kq * 512;
                float a0 = 0.f, a1 = 0.f, a2 = 0.f, a3 = 0.f, a4 = 0.f;
#pragma unroll 8
                for (int k = 0; k < 512; ++k) { const float wv = w[(size_t)k * (6 * DM)]; a0 += sv[k] * wv; a1 += sv[DM + k] * wv; a2 += sv[2 * DM + k] * wv; a3 += sv[3 * DM + k] * wv; a4 += sv[4 * DM + k] * wv; }
                __syncthreads();
                { float* rp = red + (kq * 5) * 128 + (tid & 127); rp[0] = a0; rp[128] = a1; rp[256] = a2; rp[384] = a3; rp[512] = a4; }
                __syncthreads();
                if (tid < 128) { const float bb = ada_b[l * 6 * DM + j]; float* o = MOD + (size_t)l * 5 * 6 * DM + j;
#pragma unroll
                    for (int r = 0; r < 5; ++r) o[(size_t)r * 6 * DM] = ((red[(0 * 5 + r) * 128 + tid] + red[(1 * 5 + r) * 128 + tid]) + (red[(2 * 5 + r) * 128 + tid] + red[(3 * 5 + r) * 128 + tid])) + bb; }
            }
        }
    }

    layer_body<0>(a, bar, lo, hi, bid, G, shm, sf, ptab);
    layer_body<1>(a, bar, lo, hi, bid, G, shm, sf, ptab);
    if (IN(33)) {
        PH_BEGIN
        const float* gn = PT(46);
        for (int tok = bid * 8 + wave; tok < NLAT; tok += G * 8) {
            const float* xr = XS + (size_t)tok * DM; float4 v[8]; float ss = 0.f;
#pragma unroll
            for (int i = 0; i < 8; ++i) v[i] = *(const float4*)(xr + i * 256 + lane * 4);
            moe_combine(v, tok, lane, INV, ROWGATE, YEXP, MOD + (size_t)(1 * 5 + tok / SEQ) * 6 * DM + 5 * DM);
#pragma unroll
            for (int i = 0; i < 8; ++i) {                 ss += v[i].x * v[i].x + v[i].y * v[i].y + v[i].z * v[i].z + v[i].w * v[i].w; }
            ss = wave_sum(ss); const float rs = rsqrtf(ss * (1.0f / DM) + 1e-6f);
#pragma unroll
            for (int i = 0; i < 8; ++i) { const int d = i * 256 + lane * 4; const float4 g4 = *(const float4*)(gn + d);
                *(float4*)(a.out + (size_t)tok * DM + d) = make_float4(v[i].x * rs * g4.x, v[i].y * rs * g4.y, v[i].z * rs * g4.z, v[i].w * rs * g4.w); }
        }
    }
#undef IN
#undef SEAM
}


extern "C" void kernel_launch(void* const* d_in, const int* in_sizes, int n_in, void* d_out, int out_size, void* d_ws, size_t ws_size, hipStream_t stream) {
    static int grid = 0;
    if (grid == 0) {
        if (n_in != 47 || ws_size < WS_END) { fprintf(stderr, "kernel_launch: expected 47 inputs and >= %zu bytes of workspace; got %d, %zu\n", (size_t)WS_END, n_in, ws_size); grid = -1; return; }
        int dev = 0, cus = 0;
        if (hipGetDevice(&dev) != hipSuccess || hipDeviceGetAttribute(&cus, hipDeviceAttributeMultiprocessorCount, dev) != hipSuccess) { grid = -1; return; }
        if (hipFuncSetAttribute((const void*)fwd, hipFuncAttributeMaxDynamicSharedMemorySize, LDS_BYTES) != hipSuccess) { fprintf(stderr, "kernel_launch: hipFuncSetAttribute failed\n"); grid = -1; return; }
        int per_cu = 0;
        if (hipOccupancyMaxActiveBlocksPerMultiprocessor(&per_cu, (const void*)fwd, NTHR, LDS_BYTES) != hipSuccess || per_cu < 1) fprintf(stderr, "kernel_launch: occupancy query reports %d\n", per_cu);
        (void)hipGetLastError();
        grid = cus > 256 ? 256 : cus;
        if (grid < 224) { fprintf(stderr, "kernel_launch: needs >= 224 CUs (got %d)\n", grid); grid = -1; return; }
    }
    if (grid < 0) return;
    (void)hipMemsetAsync((char*)d_ws, 0, O_ZERO_END, stream);
    Args a{};
    for (int i = 0; i < 47; ++i) a.in[i] = (const float*)d_in[i];
    a.out = (float*)d_out; a.ws = (unsigned char*)d_ws;
#if MK_ONE_LAUNCH
    a.ph_lo = 0; a.ph_hi = 64;
    hipLaunchKernelGGL(fwd, dim3(grid), dim3(NTHR), LDS_BYTES, stream, a);
#else
    const int ids[] = {0, 1,2,3,4,5,6,7,8,9,10,11,12,13,14, 17,18,19,20,21,22,23,24,25,26,27,28,29,30, 33};
    for (int k = 0; k < (int)(sizeof(ids) / sizeof(ids[0])); ++k) { a.ph_lo = ids[k]; a.ph_hi = ids[k] + 1; hipLaunchKernelGGL(fwd, dim3(grid), dim3(NTHR), LDS_BYTES, stream, a); }
#endif
}
```

```cpp
#include <hip/hip_runtime.h>
#include <stdint.h>
#include <stdio.h>

#ifndef PROBE_MASK
#define PROBE_MASK 0
#endif
#ifndef PROBE_SP
#define PROBE_SP 1
#endif
#define PROBE_REPS(k) ((((PROBE_MASK) >> (k)) & 1) + 1)
#ifndef MK_ONE_LAUNCH
#define MK_ONE_LAUNCH 1
#endif

#define DM 2048
#define NB 4
#define SEQ 4096
#define CTXL 256
#define BW 512
#define NLAT 16384
#define NCTX 1024
#define NTOK 17408
#define IN_W 13856
#define LDP 14080
#define HY_OFF 0
#define ML_OFF 1536
#define S5_OFF 3600
#define SSD_OFF 4112
#define GATE_OFF 5664
#define NEXP 16
#define DEXP 1536
#define MOE_ROWS 2176
#define MOE_PAD 2304
#define NTHR 512
#define LDS_BYTES 147456
#define LAS __attribute__((address_space(3)))

typedef unsigned short bf16_t;
typedef short bf16x8 __attribute__((ext_vector_type(8)));
typedef float f32x4 __attribute__((ext_vector_type(4)));
typedef unsigned u32x4 __attribute__((ext_vector_type(4)));
typedef unsigned u32x2 __attribute__((ext_vector_type(2)));

#define XB_TMO      128
#define XB_XCNT(j)  (256  + 64 * (j))
#define XB_XSUB(j)  (1280 + 64 * (j))
#define XB_XGEN(j)  (2304 + 64 * (j))
#define XB_TOP      3328
#define XB_TOPGEN   3392
#define XCD_BAR_WORDS 3456
#define XB_SPIN_CAP (1u << 18)
__device__ __forceinline__ unsigned xb_ld(unsigned* p)              { return __hip_atomic_load(p, __ATOMIC_RELAXED, __HIP_MEMORY_SCOPE_AGENT); }
__device__ __forceinline__ unsigned xb_add(unsigned* p, unsigned v) { return __hip_atomic_fetch_add(p, v, __ATOMIC_RELAXED, __HIP_MEMORY_SCOPE_AGENT); }
__device__ __forceinline__ unsigned xb_xcc_id() { return (unsigned)__builtin_amdgcn_s_getreg((3 << 11) | 20) & 0xFu; }
#define XB_SPIN(cond, bar) do { unsigned _sp = 0; while (cond) { __builtin_amdgcn_s_sleep(1); \
    if ((++_sp & 255u) == 0u) { if (xb_ld(&(bar)[XB_TMO])) break; if (_sp > XB_SPIN_CAP) { atomicAdd(&(bar)[XB_TMO], 1u); break; } } } } while (0)
struct XcdBarrier { unsigned* bar; unsigned x; volatile LAS unsigned* st; };
__device__ __forceinline__ XcdBarrier xcd_barrier_post(unsigned* bar, volatile LAS unsigned* st) {
    XcdBarrier b; b.bar = bar; b.x = xb_xcc_id(); b.st = st;
    if (threadIdx.x == 0) (void)xb_add(&bar[XB_XCNT(b.x)], 1u);
    return b;
}
__device__ __forceinline__ void xcd_barrier_complete(unsigned* bar, unsigned x, unsigned& nloc, unsigned& nx) {
    const unsigned G = gridDim.x * gridDim.y * gridDim.z;
    unsigned sum, cnt, mine, sp = 0u;
    for (;;) {
        sum = 0u; cnt = 0u; mine = 0u;
#pragma unroll
        for (unsigned j = 0; j < 16; ++j) { const unsigned c = xb_ld(&bar[XB_XCNT(j)]); sum += c; cnt += (c > 0u) ? 1u : 0u; mine = (j == x) ? c : mine; }
        if (sum == G) break;
        __builtin_amdgcn_s_sleep(1);
        if ((++sp & 255u) == 0u) { if (xb_ld(&bar[XB_TMO])) break; if (sp > XB_SPIN_CAP) { atomicAdd(&bar[XB_TMO], 1u); break; } }
    }
    nloc = mine > 0u ? mine : 1u; nx = cnt > 0u ? cnt : 1u;
}
__device__ __forceinline__ void xcd_barrier(const XcdBarrier& b) {
    asm volatile("s_waitcnt vmcnt(0)" ::: "memory");
    __syncthreads();
    if (threadIdx.x == 0) {
        unsigned* bar = b.bar;
        __builtin_amdgcn_s_waitcnt(0);
        unsigned nloc = b.st[0], nx = b.st[1];
        if (nloc == 0u) { xcd_barrier_complete(bar, b.x, nloc, nx); b.st[0] = nloc; b.st[1] = nx; }
        const unsigned old = xb_add(&bar[XB_XSUB(b.x)], 1u);
        const unsigned gen = old / nloc;
        if (old + 1u == (gen + 1u) * nloc) {
            __builtin_amdgcn_fence(__ATOMIC_RELEASE, "agent");
            asm volatile("s_waitcnt vmcnt(0)" ::: "memory");
            const unsigned og = xb_add(&bar[XB_TOP], 1u);
            const unsigned tg = og / nx;
            if (og + 1u == (tg + 1u) * nx) xb_add(&bar[XB_TOPGEN], 1u);
            else XB_SPIN(xb_ld(&bar[XB_TOPGEN]) == tg, bar);
            __builtin_amdgcn_fence(__ATOMIC_ACQUIRE, "agent");
            xb_add(&bar[XB_XGEN(b.x)], 1u);
            asm volatile("s_waitcnt vmcnt(0)" ::: "memory");
        } else {
            XB_SPIN(xb_ld(&bar[XB_XGEN(b.x)]) == gen, bar);
            __builtin_amdgcn_fence(__ATOMIC_ACQUIRE, "agent");
            asm volatile("s_waitcnt vmcnt(0)" ::: "memory");
        }
    }
    __syncthreads();
}

__device__ __forceinline__ unsigned short f2bf(float f) { unsigned u = __float_as_uint(f); u += 0x7FFFu + ((u >> 16) & 1u); return (unsigned short)(u >> 16); }
__device__ __forceinline__ float bf2f(unsigned short b) { return __uint_as_float(((unsigned)b) << 16); }
__device__ __forceinline__ unsigned pk2(float lo, float hi) { unsigned r; asm("v_cvt_pk_bf16_f32 %0, %1, %2" : "=v"(r) : "v"(lo), "v"(hi)); return r; }
__device__ __forceinline__ float sigmoidf_(float x) { return 1.0f / (1.0f + expf(-x)); }
__device__ __forceinline__ float siluf_(float x) { return x / (1.0f + expf(-x)); }
__device__ __forceinline__ float wave_sum(float v) {
#pragma unroll
    for (int o = 32; o >= 1; o >>= 1) v += __shfl_xor(v, o);
    return v;
}
__device__ __forceinline__ const float* uptr(const float* p) { const unsigned long long v = (unsigned long long)p;
    const unsigned lo = __builtin_amdgcn_readfirstlane((unsigned)v), hi = __builtin_amdgcn_readfirstlane((unsigned)(v >> 32)); return (const float*)(((unsigned long long)hi << 32) | lo); }
#define PT(k) uptr(ptab[k])
__device__ __forceinline__ int step_tok(int b, int dir, int i) {
    if (i < CTXL) { const int tt = dir ? (CTXL - 1 - i) : i; return NLAT + b * CTXL + tt; }
    const int j = i - CTXL; const int tt = dir ? (SEQ - 1 - j) : j; return b * SEQ + tt;
}
__device__ __forceinline__ void unpack8(const u32x4 w, float (&f)[8]) {
    f[0] = __uint_as_float(w.x << 16); f[1] = __uint_as_float(w.x & 0xFFFF0000u); f[2] = __uint_as_float(w.y << 16); f[3] = __uint_as_float(w.y & 0xFFFF0000u);
    f[4] = __uint_as_float(w.z << 16); f[5] = __uint_as_float(w.z & 0xFFFF0000u); f[6] = __uint_as_float(w.w << 16); f[7] = __uint_as_float(w.w & 0xFFFF0000u);
}

namespace pg8 {
constexpr int BM = 256, BK = 64, HALF = 128, HTB = HALF * BK * 2, STAGE_BYTES = 8 * HTB, NXCD = 8, WGM = 8;
__host__ __device__ __forceinline__ int lds_byte(int r, int c) { const int st = (r >> 4) * 2 + (c >> 5), rr = r & 15, cc = c & 31, ob = rr * 64 + cc * 2; return st * 1024 + (ob ^ (((ob >> 9) & 1) << 5)); }
__host__ __device__ __forceinline__ void stage_rc(int b, int& R, int& C) { const int st = b / 1024, sb = b % 1024, swz = sb ^ (((sb >> 9) & 1) << 5); R = (st >> 1) * 16 + swz / 64; C = (st & 1) * 32 + (swz % 64) / 2; }
__host__ __device__ __forceinline__ int perm32(int rho) { const int n = rho >> 4, i = rho & 15; return 8 * (i >> 2) + 4 * n + (i & 3); }
struct Unit { int pm, pn, z, k; long long ao, bo; };
struct Gemm { const bf16_t* A; const bf16_t* Bt; int lda, ldb, K; };

__device__ __forceinline__ void tile_of(int wgid, int nM, int nN, int& pm, int& pn) {
    const int nwg = nM * nN; { const int q = nwg / NXCD, r = nwg % NXCD, xcd = wgid % NXCD, off = wgid / NXCD; wgid = (xcd < r ? xcd * (q + 1) : r * (q + 1) + (xcd - r) * q) + off; }
    const int nig = WGM * nN, gid = wgid / nig, fm = gid * WGM, gsz = (nM - fm) < WGM ? (nM - fm) : WGM;
    pm = fm + ((wgid % nig) % gsz); pn = (wgid % nig) / gsz;
}
struct SchedStd {
    int nM, nN, G, c, lda, ldb;
    __device__ __forceinline__ bool next(int i, Unit& u) const { const long L = (long)i * G + c; if (L >= (long)nM * nN) return false; tile_of((int)L, nM, nN, u.pm, u.pn); u.z = 0; u.k = 0;
        u.ao = (long long)u.pm * BM * lda * 2; u.bo = (long long)u.pn * BM * ldb * 2; return true; }
    __device__ __forceinline__ void a_ready(const Unit&) const {}
    __device__ __forceinline__ void done(const Unit&) const {}
};
struct SchedBranch {
    int nM, nN, G, c;
    __device__ __forceinline__ bool next(int i, Unit& u) const { const long L = (long)(i >> 2) * G + c; if (L >= (long)nM * nN) return false; tile_of((int)L, nM, nN, u.pm, u.pn); u.z = 0; u.k = i & 3;
        u.ao = ((long long)u.pm * BM * DM + u.k * BW) * 2; u.bo = ((long long)u.k * DM + u.pn * BM) * BW * 2; return true; }
    __device__ __forceinline__ void a_ready(const Unit&) const {}
    __device__ __forceinline__ void done(const Unit&) const {}
};
struct SchedTail {
    int G, c;
    __device__ __forceinline__ bool next(int i, Unit& u) const { const long T = (long)i * G + c; if (T >= 128) return false; const int t = (int)(T >> 2); u.pm = 64 + (t >> 3); u.pn = t & 7; u.z = 1; u.k = (int)(T & 3);
        u.ao = ((long long)u.pm * BM * DM + u.k * BW) * 2; u.bo = ((long long)u.k * DM + u.pn * BM) * BW * 2; return true; }
    __device__ __forceinline__ void a_ready(const Unit&) const {}
    __device__ __forceinline__ void done(const Unit&) const {}
};
struct SchedTailK {
    int G, c;
    __device__ __forceinline__ bool next(int i, Unit& u) const { const long T = (long)i * G + c; if (T >= 128) return false; const int t = (int)(T >> 2); u.pm = 64 + (t >> 3); u.pn = t & 7; u.z = 1; u.k = (int)(T & 3);
        u.ao = ((long long)u.pm * BM * DM + u.k * 512) * 2; u.bo = ((long long)u.pn * BM * DM + u.k * 512) * 2; return true; }
    __device__ __forceinline__ void a_ready(const Unit&) const {}
    __device__ __forceinline__ void done(const Unit&) const {}
};
struct SchedMoe {
    int nPm, nPn, G, c, lda, ldb, nBrows;
    __device__ __forceinline__ bool next(int i, Unit& u) const { const long L = (long)i * G + c; const int per = nPm * nPn; if (L >= (long)NEXP * per) return false; const int e = (int)(L / per), rem = (int)(L % per);
        u.z = e; u.k = 0; u.pm = rem % nPm; u.pn = rem / nPm; u.ao = ((long long)e * MOE_PAD + u.pm * BM) * lda * 2; u.bo = ((long long)e * nBrows + u.pn * BM) * ldb * 2; return true; }
    __device__ __forceinline__ void a_ready(const Unit&) const {}
    __device__ __forceinline__ void done(const Unit&) const {}
};

typedef f32x4 Acc[2][2][4][2];
template <class Epi, class Sched>
__device__ __forceinline__ void gemm_phase(LAS unsigned char* lds, const Gemm g, const Sched& S, const Epi& E) {
    int tid = threadIdx.x; asm volatile("" : "+v"(tid));
    const int wid = __builtin_amdgcn_readfirstlane(tid >> 6), lane = tid & 63, wr = wid >> 2, wc = wid & 3, fr = lane & 15, fq = lane >> 4;
    const int K = g.K, nt = K / BK;
    unsigned voffA[2], voffB[2];
#pragma unroll
    for (int i = 0; i < 2; ++i) { int R, C; stage_rc(tid * 16 + i * 8192, R, C); const int Rb = Epi::PERM ? ((R & ~31) + perm32(R & 31)) : R;
        voffA[i] = (unsigned)(R * g.lda + C) * 2u; voffB[i] = (unsigned)(Rb * g.ldb + C) * 2u; }
    const size_t kstep = (size_t)(BK * 2);
    const size_t hstepA = (size_t)HALF * g.lda * 2, hstepB = (size_t)HALF * g.ldb * 2;
    const unsigned ldsw = (unsigned)wid * 1024u;
    const int aoff = lds_byte(wr * 64 + fr, fq * 8), boff = lds_byte(wc * 32 + fr, fq * 8);
#define PG8_SA(b, h) (((b) * 2 + (h)) * HTB)
#define PG8_SB(b, h) ((4 + (b) * 2 + (h)) * HTB)
#define PG8_STAGE(bufoff, gbase, voff) do { _Pragma("unroll") for (int _i = 0; _i < 2; ++_i) \
        __builtin_amdgcn_global_load_lds((const unsigned*)((const char*)(gbase) + (voff)[_i]), (LAS unsigned*)(lds + (bufoff) + ldsw + _i * 8192), 16, 0, 0); } while (0)
#define PG8_LDA(dst, b, h) do { _Pragma("unroll") for (int m = 0; m < 4; ++m) _Pragma("unroll") for (int k = 0; k < 2; ++k) dst[m][k] = *(const LAS bf16x8*)(lds + PG8_SA(b, h) + aoff + m * 2048 + k * 1024); } while (0)
#define PG8_LDB(dst, b, h) do { _Pragma("unroll") for (int n = 0; n < 2; ++n) _Pragma("unroll") for (int k = 0; k < 2; ++k) dst[n][k] = *(const LAS bf16x8*)(lds + PG8_SB(b, h) + boff + n * 2048 + k * 1024); } while (0)
#define PG8_MMA(ai, bj, At, Bt) do { __builtin_amdgcn_s_setprio(1); _Pragma("unroll") for (int m = 0; m < 4; ++m) _Pragma("unroll") for (int n = 0; n < 2; ++n) _Pragma("unroll") for (int k = 0; k < 2; ++k) \
        acc[ai][bj][m][n] = __builtin_amdgcn_mfma_f32_16x16x32_bf16(Bt[n][k], At[m][k], acc[ai][bj][m][n], 0, 0, 0); __builtin_amdgcn_s_setprio(0); } while (0)
#define PG8_WAIT_V(n) asm volatile("s_waitcnt vmcnt(" #n ")" ::: "memory")
#define PG8_WAIT_L(n) asm volatile("s_waitcnt lgkmcnt(" #n ")" ::: "memory")
#define PG8_BAR __builtin_amdgcn_s_barrier()
#define PG8_SCHED __builtin_amdgcn_sched_barrier(0)
    Unit cur, nxt; int ui = 0;
    if (!S.next(0, cur)) return;
    Acc acc;
#pragma unroll
    for (int a = 0; a < 2; ++a)
#pragma unroll
        for (int b = 0; b < 2; ++b)
#pragma unroll
            for (int m = 0; m < 4; ++m)
#pragma unroll
                for (int n = 0; n < 2; ++n) acc[a][b][m][n] = (f32x4){0.f, 0.f, 0.f, 0.f};
    bf16x8 At[4][2], B0[2][2], B1[2][2];
    const char* cA = (const char*)g.A + cur.ao; const char* cB = (const char*)g.Bt + cur.bo;
    S.a_ready(cur);
    PG8_STAGE(PG8_SB(0, 0), cB, voffB); PG8_STAGE(PG8_SA(0, 0), cA, voffA); PG8_STAGE(PG8_SB(0, 1), cB + hstepB, voffB); PG8_STAGE(PG8_SA(0, 1), cA + hstepA, voffA);
    if (wr == 1) PG8_BAR;
    PG8_WAIT_V(4); PG8_BAR;
    PG8_STAGE(PG8_SB(1, 0), cB + kstep, voffB); PG8_STAGE(PG8_SA(1, 0), cA + kstep, voffA); PG8_STAGE(PG8_SB(1, 1), cB + hstepB + kstep, voffB);
    PG8_WAIT_V(6); PG8_BAR;
    for (;;) {
        const bool has_next = S.next(ui + 1, nxt);
        const char* nA = has_next ? (const char*)g.A + nxt.ao : cA; const char* nB = has_next ? (const char*)g.Bt + nxt.bo : cB;
        for (int t = 0; t < nt; t += 2) {
            const bool last = (t == nt - 2);
            const char* a1 = cA + (size_t)(t + 1) * kstep;
            const char* a2 = last ? nA : cA + (size_t)(t + 2) * kstep; const char* b2 = last ? nB : cB + (size_t)(t + 2) * kstep;
            const char* a3 = a2 + kstep; const char* b3 = b2 + kstep;
            if (last && has_next) S.a_ready(nxt);
            PG8_LDB(B0, 0, 0); PG8_SCHED; PG8_LDA(At, 0, 0); PG8_STAGE(PG8_SA(1, 1), a1 + hstepA, voffA);
            PG8_WAIT_L(8); PG8_BAR; PG8_WAIT_L(0); PG8_MMA(0, 0, At, B0); PG8_BAR; PG8_SCHED;
            PG8_LDB(B1, 0, 1); PG8_STAGE(PG8_SB(0, 0), b2, voffB);
            PG8_BAR; PG8_WAIT_L(0); PG8_MMA(0, 1, At, B1); PG8_BAR;
            PG8_LDA(At, 0, 1); PG8_STAGE(PG8_SA(0, 0), a2, voffA);
            PG8_BAR; PG8_WAIT_L(0); PG8_MMA(1, 0, At, B0); PG8_BAR; PG8_SCHED;
            PG8_STAGE(PG8_SB(0, 1), b2 + hstepB, voffB);
            PG8_WAIT_V(6); PG8_BAR; PG8_MMA(1, 1, At, B1); PG8_BAR;
            PG8_LDB(B0, 1, 0); PG8_SCHED; PG8_LDA(At, 1, 0); PG8_STAGE(PG8_SA(0, 1), a2 + hstepA, voffA);
            PG8_WAIT_L(8); PG8_BAR; PG8_WAIT_L(0); PG8_MMA(0, 0, At, B0); PG8_BAR; PG8_SCHED;
            PG8_LDB(B1, 1, 1); PG8_STAGE(PG8_SB(1, 0), b3, voffB);
            PG8_BAR; PG8_WAIT_L(0); PG8_MMA(0, 1, At, B1); PG8_BAR;
            PG8_LDA(At, 1, 1); PG8_STAGE(PG8_SA(1, 0), a3, voffA);
            PG8_BAR; PG8_WAIT_L(0); PG8_MMA(1, 0, At, B0); PG8_BAR; PG8_SCHED;
            PG8_STAGE(PG8_SB(1, 1), b3 + hstepB, voffB);
            PG8_WAIT_V(6); PG8_BAR; PG8_MMA(1, 1, At, B1); PG8_BAR;
        }
        const bool keep = E(acc, cur, wr, wc, fr, fq); S.done(cur);
        if (!has_next) break;
        if (!keep) {
#pragma unroll
        for (int a = 0; a < 2; ++a)
#pragma unroll
            for (int b = 0; b < 2; ++b)
#pragma unroll
                for (int m = 0; m < 4; ++m)
#pragma unroll
                    for (int n = 0; n < 2; ++n) acc[a][b][m][n] = (f32x4){0.f, 0.f, 0.f, 0.f};
        }
        cur = nxt; cA = nA; cB = nB; ++ui;
    }
    PG8_WAIT_V(0);
    if (wr == 0) PG8_BAR;
    PG8_BAR;
#undef PG8_SA
#undef PG8_SB
#undef PG8_STAGE
#undef PG8_LDA
#undef PG8_LDB
#undef PG8_MMA
#undef PG8_WAIT_V
#undef PG8_WAIT_L
#undef PG8_BAR
#undef PG8_SCHED
}

struct EpiBf16Store {
    static constexpr bool PERM = true;
    bf16_t* O; int ldc;
    __device__ __forceinline__ bool operator()(Acc& acc, const Unit& u, int wr, int wc, int fr, int fq) const {
        const int row0 = u.pm * BM + wr * 64 + fr, col0 = u.pn * BM + wc * 32 + 8 * fq;
#pragma unroll
        for (int ai = 0; ai < 2; ++ai)
#pragma unroll
            for (int m = 0; m < 4; ++m) { bf16_t* rowp = O + (size_t)(row0 + ai * HALF + m * 16) * ldc + col0;
#pragma unroll
                for (int bj = 0; bj < 2; ++bj) { const f32x4 v0 = acc[ai][bj][m][0], v1 = acc[ai][bj][m][1];
                    u32x4 w; w.x = pk2(v0[0], v0[1]); w.y = pk2(v0[2], v0[3]); w.z = pk2(v1[0], v1[1]); w.w = pk2(v1[2], v1[3]);
                    *(u32x4*)(rowp + bj * HALF) = w; } }
        return false;
    }
};
struct EpiWin {
    static constexpr bool PERM = true;
    bf16_t* O; int ldc;
    __device__ __forceinline__ bool operator()(Acc& acc, const Unit& u, int wr, int wc, int fr, int fq) const {
        const int row0 = u.pm * BM + wr * 64 + fr, col0 = u.pn * BM + wc * 32 + 8 * fq;
#pragma unroll
        for (int bj = 0; bj < 2; ++bj) { const bool gate = (col0 + bj * HALF) >= GATE_OFF;
#pragma unroll
            for (int ai = 0; ai < 2; ++ai)
#pragma unroll
                for (int m = 0; m < 4; ++m) { f32x4 v0 = acc[ai][bj][m][0], v1 = acc[ai][bj][m][1];
                    if (gate) {
#pragma unroll
                        for (int j = 0; j < 4; ++j) { v0[j] = __builtin_amdgcn_rcpf(1.0f + __expf(-v0[j])); v1[j] = __builtin_amdgcn_rcpf(1.0f + __expf(-v1[j])); } }
                    u32x4 w; w.x = pk2(v0[0], v0[1]); w.y = pk2(v0[2], v0[3]); w.z = pk2(v1[0], v1[1]); w.w = pk2(v1[2], v1[3]);
                    *(u32x4*)(O + (size_t)(row0 + ai * HALF + m * 16) * ldc + col0 + bj * HALF) = w; } }
        return false;
    }
};
struct EpiNone { static constexpr bool PERM = true;
    __device__ __forceinline__ bool operator()(Acc& acc, const Unit&, int, int, int, int) const {
#pragma unroll
        for (int a = 0; a < 2; ++a)
#pragma unroll
            for (int b = 0; b < 2; ++b)
#pragma unroll
                for (int m = 0; m < 4; ++m)
#pragma unroll
                    for (int n = 0; n < 2; ++n) asm volatile("" :: "v"(acc[a][b][m][n]));
        return false; } };
struct EpiGlu {
    static constexpr bool PERM = true;
    const bf16_t* GG; const float* bias; bf16_t* Y4;
    __device__ __forceinline__ bool operator()(Acc& acc, const Unit& u, int wr, int wc, int fr, int fq) const {
        const int row0 = u.pm * BM + wr * 64 + fr, col0 = u.pn * BM + wc * 32 + 8 * fq;
#pragma unroll
        for (int bj = 0; bj < 2; ++bj) { const int col = col0 + bj * HALF; const f32x4 b0 = *(const f32x4*)(bias + col), b1 = *(const f32x4*)(bias + col + 4);
            u32x4 gq[2][4];
#pragma unroll
            for (int ai = 0; ai < 2; ++ai)
#pragma unroll
                for (int m = 0; m < 4; ++m) gq[ai][m] = *(const u32x4*)(GG + (size_t)(row0 + ai * HALF + m * 16) * BW + col);
#pragma unroll
            for (int ai = 0; ai < 2; ++ai)
#pragma unroll
                for (int m = 0; m < 4; ++m) { const size_t row = (size_t)(row0 + ai * HALF + m * 16);
                    float gg[8]; unpack8(gq[ai][m], gg);
                    const f32x4 v0 = acc[ai][bj][m][0] + b0, v1 = acc[ai][bj][m][1] + b1;
                    u32x4 w; w.x = pk2(gg[0] * sigmoidf_(v0[0]), gg[1] * sigmoidf_(v0[1])); w.y = pk2(gg[2] * sigmoidf_(v0[2]), gg[3] * sigmoidf_(v0[3]));
                    w.z = pk2(gg[4] * sigmoidf_(v1[0]), gg[5] * sigmoidf_(v1[1])); w.w = pk2(gg[6] * sigmoidf_(v1[2]), gg[7] * sigmoidf_(v1[3]));
                    *(u32x4*)(Y4 + row * DM + 1024 + col) = w; } }
        return false;
    }
};
struct EpiBranch {
    static constexpr bool PERM = true;
    const bf16_t* P; bf16_t* ACCb;
    __device__ __forceinline__ bool operator()(Acc& acc, const Unit& u, int wr, int wc, int fr, int fq) const {
        const int row0 = u.pm * BM + wr * 64 + fr, col0 = u.pn * BM + wc * 32 + 8 * fq; const int k = u.k;
        const bf16_t* gbase = P + (size_t)row0 * LDP + GATE_OFF + k * DM + col0;
        if (k < 3) {
#pragma unroll
            for (int ai = 0; ai < 2; ++ai) {
                u32x4 ga[8], gb[8];
#pragma unroll
                for (int m = 0; m < 4; ++m)
#pragma unroll
                    for (int bj = 0; bj < 2; ++bj) { const bf16_t* p = gbase + (size_t)(ai * HALF + m * 16) * LDP + bj * HALF; ga[m * 2 + bj] = *(const u32x4*)p; gb[m * 2 + bj] = *(const u32x4*)(p + DM); }
#pragma unroll
                for (int m = 0; m < 4; ++m)
#pragma unroll
                    for (int bj = 0; bj < 2; ++bj) { float g0[8], g1[8]; unpack8(ga[m * 2 + bj], g0); unpack8(gb[m * 2 + bj], g1);
                        float s[8];
#pragma unroll
                        for (int j = 0; j < 8; ++j) s[j] = g0[j] * __builtin_amdgcn_rcpf(g1[j]);
                        f32x4 v0 = acc[ai][bj][m][0], v1 = acc[ai][bj][m][1];
                        v0[0] *= s[0]; v0[1] *= s[1]; v0[2] *= s[2]; v0[3] *= s[3]; v1[0] *= s[4]; v1[1] *= s[5]; v1[2] *= s[6]; v1[3] *= s[7];
                        acc[ai][bj][m][0] = v0; acc[ai][bj][m][1] = v1; } }
            return true;
        }
#pragma unroll
        for (int ai = 0; ai < 2; ++ai) {
            u32x4 ga[8];
#pragma unroll
            for (int m = 0; m < 4; ++m)
#pragma unroll
                for (int bj = 0; bj < 2; ++bj) ga[m * 2 + bj] = *(const u32x4*)(gbase + (size_t)(ai * HALF + m * 16) * LDP + bj * HALF);
#pragma unroll
            for (int m = 0; m < 4; ++m)
#pragma unroll
                for (int bj = 0; bj < 2; ++bj) { float s[8]; unpack8(ga[m * 2 + bj], s);
                    f32x4 v0 = acc[ai][bj][m][0], v1 = acc[ai][bj][m][1];
                    v0[0] *= s[0]; v0[1] *= s[1]; v0[2] *= s[2]; v0[3] *= s[3]; v1[0] *= s[4]; v1[1] *= s[5]; v1[2] *= s[6]; v1[3] *= s[7];
                    u32x4 w; w.x = pk2(v0[0], v0[1]); w.y = pk2(v0[2], v0[3]); w.z = pk2(v1[0], v1[1]); w.w = pk2(v1[2], v1[3]);
                    *(u32x4*)(ACCb + (size_t)(row0 + ai * HALF + m * 16) * DM + col0 + bj * HALF) = w; } }
        return false;
    }
};
struct EpiPart {
    static constexpr bool PERM = true;
    const bf16_t* P; float* PART;
    __device__ __forceinline__ bool operator()(Acc& acc, const Unit& u, int wr, int wc, int fr, int fq) const {
        const int row0 = u.pm * BM + wr * 64 + fr, col0 = u.pn * BM + wc * 32 + 8 * fq; const int k = u.k;
        const bf16_t* gbase = P + (size_t)row0 * LDP + GATE_OFF + k * DM + col0;
        float* pbase = PART + ((size_t)k * (NTOK - NLAT) + (size_t)(row0 - NLAT)) * DM + col0;
#pragma unroll
        for (int ai = 0; ai < 2; ++ai) {
            u32x4 ga[8];
#pragma unroll
            for (int m = 0; m < 4; ++m)
#pragma unroll
                for (int bj = 0; bj < 2; ++bj) ga[m * 2 + bj] = *(const u32x4*)(gbase + (size_t)(ai * HALF + m * 16) * LDP + bj * HALF);
#pragma unroll
            for (int m = 0; m < 4; ++m)
#pragma unroll
                for (int bj = 0; bj < 2; ++bj) { float sg[8]; unpack8(ga[m * 2 + bj], sg);
                    f32x4 v0 = acc[ai][bj][m][0], v1 = acc[ai][bj][m][1];
                    v0[0] *= sg[0]; v0[1] *= sg[1]; v0[2] *= sg[2]; v0[3] *= sg[3]; v1[0] *= sg[4]; v1[1] *= sg[5]; v1[2] *= sg[6]; v1[3] *= sg[7];
                    float* pp = pbase + (size_t)(ai * HALF + m * 16) * DM + bj * HALF;
                    *(f32x4*)pp = v0; *(f32x4*)(pp + 4) = v1; } }
        return false;
    }
};
struct EpiPartK {
    static constexpr bool PERM = true;
    float* PART;
    __device__ __forceinline__ bool operator()(Acc& acc, const Unit& u, int wr, int wc, int fr, int fq) const {
        const int row0 = u.pm * BM + wr * 64 + fr, col0 = u.pn * BM + wc * 32 + 8 * fq;
        float* pbase = PART + ((size_t)u.k * (NTOK - NLAT) + (size_t)(row0 - NLAT)) * DM + col0;
#pragma unroll
        for (int ai = 0; ai < 2; ++ai)
#pragma unroll
            for (int m = 0; m < 4; ++m)
#pragma unroll
                for (int bj = 0; bj < 2; ++bj) { float* pp = pbase + (size_t)(ai * HALF + m * 16) * DM + bj * HALF; *(f32x4*)pp = acc[ai][bj][m][0]; *(f32x4*)(pp + 4) = acc[ai][bj][m][1]; }
        return false;
    }
};
struct EpiResid {
    static constexpr bool PERM = false;
    float* XS; const float* srcLat; const float* srcCtx; const float* MODl; int gidx;
    __device__ __forceinline__ bool operator()(Acc& acc, const Unit& u, int wr, int wc, int fr, int fq) const {
        const int row0 = u.pm * BM + wr * 64 + fr, col0 = u.pn * BM + wc * 32 + 4 * fq;
        const int r = (u.pm * BM) < NLAT ? (u.pm * BM) / SEQ : 4;
        const float* src = (u.pm * BM) < NLAT ? srcLat : srcCtx;
        const float* mg = MODl + (size_t)(r * 6 + gidx) * DM;
#pragma unroll
        for (int bj = 0; bj < 2; ++bj) {
            f32x4 gm[2], xs[2][2][4];
#pragma unroll
            for (int n = 0; n < 2; ++n) { const int col = col0 + bj * HALF + n * 16; gm[n] = *(const f32x4*)(mg + col);
#pragma unroll
                for (int ai = 0; ai < 2; ++ai)
#pragma unroll
                    for (int m = 0; m < 4; ++m) xs[n][ai][m] = *(const f32x4*)(src + (size_t)(row0 + ai * HALF + m * 16) * DM + col); }
#pragma unroll
            for (int n = 0; n < 2; ++n) { const int col = col0 + bj * HALF + n * 16;
#pragma unroll
                for (int ai = 0; ai < 2; ++ai)
#pragma unroll
                    for (int m = 0; m < 4; ++m) *(f32x4*)(XS + (size_t)(row0 + ai * HALF + m * 16) * DM + col) = xs[n][ai][m] + gm[n] * acc[ai][bj][m][n]; } }
        return false;
    }
};
struct EpiMoe1 {
    static constexpr bool PERM = true;
    bf16_t* HID;
    __device__ __forceinline__ bool operator()(Acc& acc, const Unit& u, int wr, int wc, int fr, int fq) const {
        const size_t row0 = (size_t)u.z * MOE_PAD + u.pm * BM + wr * 64 + fr; const int col0 = u.pn * HALF + wc * 32 + 8 * fq;
#pragma unroll
        for (int ai = 0; ai < 2; ++ai)
#pragma unroll
            for (int m = 0; m < 4; ++m) { const f32x4 g0 = acc[ai][0][m][0], g1 = acc[ai][0][m][1], u0 = acc[ai][1][m][0], u1 = acc[ai][1][m][1];
                float h[8];
#pragma unroll
                for (int j = 0; j < 4; ++j) { h[j] = g0[j] * __builtin_amdgcn_rcpf(1.0f + __expf(-g0[j])) * u0[j]; h[4 + j] = g1[j] * __builtin_amdgcn_rcpf(1.0f + __expf(-g1[j])) * u1[j]; }
                u32x4 w; w.x = pk2(h[0], h[1]); w.y = pk2(h[2], h[3]); w.z = pk2(h[4], h[5]); w.w = pk2(h[6], h[7]);
                *(u32x4*)(HID + (row0 + ai * HALF + m * 16) * DEXP + col0) = w; }
        return false;
    }
};
struct EpiMoeY {
    static constexpr bool PERM = true;
    bf16_t* O;
    __device__ __forceinline__ bool operator()(Acc& acc, const Unit& u, int wr, int wc, int fr, int fq) const {
        const size_t row0 = (size_t)u.z * MOE_PAD + u.pm * BM + wr * 64 + fr; const int col0 = u.pn * BM + wc * 32 + 8 * fq;
#pragma unroll
        for (int ai = 0; ai < 2; ++ai)
#pragma unroll
            for (int m = 0; m < 4; ++m) { bf16_t* rowp = O + (row0 + ai * HALF + m * 16) * DM + col0;
#pragma unroll
                for (int bj = 0; bj < 2; ++bj) { const f32x4 v0 = acc[ai][bj][m][0], v1 = acc[ai][bj][m][1];
                    u32x4 w; w.x = pk2(v0[0], v0[1]); w.y = pk2(v0[2], v0[3]); w.z = pk2(v1[0], v1[1]); w.w = pk2(v1[2], v1[3]);
                    *(u32x4*)(rowp + bj * HALF) = w; } }
        return false;
    }
};

struct SchedS5a {
    int c;
    __device__ __forceinline__ bool next(int i, Unit& u) const { if (i > 0 || c >= 64) return false; u.z = c >> 1; u.pm = c & 1; u.pn = 0; u.k = 0;
        u.ao = ((long long)u.z * 512 + u.pm * BM) * 768 * 2; u.bo = (long long)u.z * 256 * 512 * 2; return true; }
    __device__ __forceinline__ void a_ready(const Unit&) const {}
    __device__ __forceinline__ void done(const Unit&) const {}
};
struct SchedS5b {
    int c;
    __device__ __forceinline__ bool next(int i, Unit& u) const { if (i > 0 || c >= 128) return false; u.z = c >> 2; u.pm = (c >> 1) & 1; u.pn = c & 1; u.k = 0;
        u.ao = ((long long)u.z * 512 + u.pm * BM) * 768 * 2; u.bo = ((long long)u.z * 512 + u.pn * BM) * 768 * 2; return true; }
    __device__ __forceinline__ void a_ready(const Unit&) const {}
    __device__ __forceinline__ void done(const Unit&) const {}
};
struct EpiXloc {
    static constexpr bool PERM = false;
    float* XL;
    __device__ __forceinline__ bool operator()(Acc& acc, const Unit& u, int wr, int wc, int fr, int fq) const {
        const int row0 = u.pm * BM + wr * 64 + fr, col0 = wc * 32 + 4 * fq; float* base = XL + (size_t)u.z * 512 * 256;
#pragma unroll
        for (int ai = 0; ai < 2; ++ai)
#pragma unroll
            for (int m = 0; m < 4; ++m) { float* rowp = base + (size_t)(row0 + ai * HALF + m * 16) * 256 + col0;
#pragma unroll
                for (int bj = 0; bj < 2; ++bj)
#pragma unroll
                    for (int n = 0; n < 2; ++n) *(f32x4*)(rowp + bj * HALF + n * 16) = acc[ai][bj][m][n]; }
        return false;
    }
};
struct EpiS5Out {
    static constexpr bool PERM = true;
    const bf16_t* P; const float* dskip; bf16_t* GG;
    __device__ __forceinline__ bool operator()(Acc& acc, const Unit& u, int wr, int wc, int fr, int fq) const {
        const int row0 = u.pm * BM + wr * 64 + fr, col0 = u.pn * BM + wc * 32 + 8 * fq; const int g = u.z;
#pragma unroll
        for (int bj = 0; bj < 2; ++bj) { const int col = col0 + bj * HALF; const int t = col >> 4, c0 = col & 15;
            const f32x4 d0 = *(const f32x4*)(dskip + g * 16 + c0), d1 = *(const f32x4*)(dskip + g * 16 + c0 + 4);
            u32x4 uq[2][4];
#pragma unroll
            for (int ai = 0; ai < 2; ++ai)
#pragma unroll
                for (int m = 0; m < 4; ++m) uq[ai][m] = *(const u32x4*)(P + ((size_t)(row0 + ai * HALF + m * 16) * 32 + t) * LDP + S5_OFF + g * 16 + c0);
#pragma unroll
            for (int ai = 0; ai < 2; ++ai)
#pragma unroll
                for (int m = 0; m < 4; ++m) { const size_t tok = (size_t)(row0 + ai * HALF + m * 16) * 32 + t;
                    float uu[8]; unpack8(uq[ai][m], uu);
                    const f32x4 v0 = acc[ai][bj][m][0], v1 = acc[ai][bj][m][1];
                    float y[8] = {v0[0] + d0[0] * uu[0], v0[1] + d0[1] * uu[1], v0[2] + d0[2] * uu[2], v0[3] + d0[3] * uu[3], v1[0] + d1[0] * uu[4], v1[1] + d1[1] * uu[5], v1[2] + d1[2] * uu[6], v1[3] + d1[3] * uu[7]};
#pragma unroll
                    for (int j = 0; j < 8; ++j) y[j] = 0.5f * y[j] * (1.0f + tanhf(0.7978845608028654f * (y[j] + 0.044715f * y[j] * y[j] * y[j])));
                    u32x4 w; w.x = pk2(y[0], y[1]); w.y = pk2(y[2], y[3]); w.z = pk2(y[4], y[5]); w.w = pk2(y[6], y[7]);
                    *(u32x4*)(GG + tok * BW + g * 16 + c0) = w; } }
        return false;
    }
};
}


__device__ __forceinline__ float wave_scan_incl(float v, int lane) {
#pragma unroll
    for (int o = 1; o < 64; o <<= 1) { const float t = __shfl_up(v, o); if (lane >= o) v += t; }
    return v;
}
__device__ __forceinline__ float wave_scanmax_incl(float v, int lane) {
#pragma unroll
    for (int o = 1; o < 64; o <<= 1) { const float t = __shfl_up(v, o); if (lane >= o) v = fmaxf(v, t); }
    return v;
}
__device__ __forceinline__ float wave_max(float v) {
#pragma unroll
    for (int o = 32; o >= 1; o >>= 1) v = fmaxf(v, __shfl_xor(v, o));
    return v;
}
__device__ __forceinline__ void unpack8h(const u32x4 w, bf16_t (&h)[8]) {
    h[0] = (bf16_t)(w.x & 0xFFFFu); h[1] = (bf16_t)(w.x >> 16); h[2] = (bf16_t)(w.y & 0xFFFFu); h[3] = (bf16_t)(w.y >> 16);
    h[4] = (bf16_t)(w.z & 0xFFFFu); h[5] = (bf16_t)(w.z >> 16); h[6] = (bf16_t)(w.w & 0xFFFFu); h[7] = (bf16_t)(w.w >> 16);
}

__device__ __forceinline__ int tokblock_of(int b, int dir, int c) { if (c < 4) return 256 + b * 4 + (dir ? 3 - c : c); const int j = c - 4; return b * 64 + (dir ? 63 - j : j); }
__device__ __forceinline__ u32x4 rev8h(const u32x4 v) { u32x4 r; r.x = (v.w >> 16) | (v.w << 16); r.y = (v.z >> 16) | (v.z << 16); r.z = (v.y >> 16) | (v.y << 16); r.w = (v.x >> 16) | (v.x << 16); return r; }
__device__ __forceinline__ u32x4 scale8h(const u32x4 v, const float4 a, const float4 b) { float f[8]; unpack8(v, f); u32x4 r; r.x = pk2(f[0] * a.x, f[1] * a.y); r.y = pk2(f[2] * a.z, f[3] * a.w); r.z = pk2(f[4] * b.x, f[5] * b.y); r.w = pk2(f[6] * b.z, f[7] * b.w); return r; }
__device__ __forceinline__ float dot8h(const u32x4 v, const float4 a, const float4 b) { float f[8]; unpack8(v, f); return (f[0] * a.x + f[1] * a.y) + (f[2] * a.z + f[3] * a.w) + (f[4] * b.x + f[5] * b.y) + (f[6] * b.z + f[7] * b.w); }
#define ML_FRAG_LOAD(KF, VF, cc_) do { const int tb_ = tokblock_of(b, dir, (cc_)); const bf16_t* kb_ = KTg + ((size_t)tb_ * 512 + h * 128 + 32 * wd + r16) * 64 + q4 * 8; const bf16_t* vb_ = VTg + ((size_t)tb_ * 512 + h * 128 + 64 * half + 32 * we + r16) * 64 + q4 * 8; \
        _Pragma("unroll") for (int ks_ = 0; ks_ < 2; ++ks_) _Pragma("unroll") for (int j_ = 0; j_ < 2; ++j_) { VF[j_][ks_] = *(const u32x4*)(vb_ + (size_t)j_ * 16 * 64 + ks_ * 32); KF[j_][ks_] = *(const u32x4*)(kb_ + (size_t)j_ * 16 * 64 + ks_ * 32); } } while (0)
#define ML_CHUNK(c_, KF, VF, KFN, VFN) do { const int c = (c_); \
        if (c + 1 < 68) ML_FRAG_LOAD(KFN, VFN, c + 1);                        \
        const float dec = sDEC[c]; \
        {   bf16_t* cs = CST + (size_t)(chain * 68 + c) * 128 * 128; \
            _Pragma("unroll") for (int je = 0; je < 2; ++je) _Pragma("unroll") for (int jd = 0; jd < 2; ++jd) { const int e = 64 * half + 32 * we + 16 * je + r16, d0 = 32 * wd + 16 * jd + q4 * 4; \
                u32x2 pk; pk.x = pk2(acc[je][jd][0], acc[je][jd][1]); pk.y = pk2(acc[je][jd][2], acc[je][jd][3]); *(u32x2*)(cs + (size_t)e * 128 + d0) = pk; } \
            if (nown) { _Pragma("unroll") for (int jd = 0; jd < 2; ++jd) { float nv = npart[jd]; nv += __shfl_xor(nv, 16); nv += __shfl_xor(nv, 32); if (q4 == 0) NST[(size_t)(chain * 68 + c) * 128 + 32 * wd + 16 * jd + r16] = nv; } } } \
        bf16x8 vfr[2][2]; \
        _Pragma("unroll") for (int ks = 0; ks < 2; ++ks) { const float4 wa = *(const float4*)(sWS + c * 64 + ks * 32 + q4 * 8), wb = *(const float4*)(sWS + c * 64 + ks * 32 + q4 * 8 + 4); \
            _Pragma("unroll") for (int je = 0; je < 2; ++je) { const u32x4 sv = scale8h(VF[je][ks], wa, wb); vfr[je][ks] = *(const bf16x8*)&sv; } \
            if (nown) { _Pragma("unroll") for (int jd = 0; jd < 2; ++jd) npart[jd] = (ks == 0 ? dec * npart[jd] : npart[jd]) + dot8h(KF[jd][ks], wa, wb); } } \
        _Pragma("unroll") for (int je = 0; je < 2; ++je) _Pragma("unroll") for (int jd = 0; jd < 2; ++jd) acc[je][jd] = acc[je][jd] * dec; \
        _Pragma("unroll") for (int ks = 0; ks < 2; ++ks) _Pragma("unroll") for (int je = 0; je < 2; ++je) _Pragma("unroll") for (int jd = 0; jd < 2; ++jd) \
            acc[je][jd] = __builtin_amdgcn_mfma_f32_16x16x32_bf16(*(const bf16x8*)&KF[jd][ks], vfr[je][ks], acc[je][jd], 0, 0, 0); } while (0)
__device__ __forceinline__ void mlstm_state_pass(const int chain, const int half, const bf16_t* __restrict__ Pm, const bf16_t* __restrict__ KTg, const bf16_t* __restrict__ VTg, const float* __restrict__ gate_b,
                                                 bf16_t* __restrict__ CST, float* __restrict__ NST, float* __restrict__ MST, unsigned char* shm, const int tid) {
    const int dir = chain & 1, h = (chain >> 1) & 3, b = chain >> 3, lane = tid & 63, w = tid >> 6, we = w >> 2, wd = w & 3, q4 = lane >> 4, r16 = lane & 15;
    const bool nown = (half == 0) && (we == 0);
    float* sE = (float*)shm; float* sWS = sE + 68 * 64; float* sAL = sWS + 68 * 64; float* sBE = sAL + 68; float* sMO = sBE + 68; float* sDEC = sMO + 68; float* sMB = sDEC + 68;
    const float gbi = gate_b[(dir * 2 + 0) * 4 + h], gbf = gate_b[(dir * 2 + 1) * 4 + h];
    const int gcol_i = ML_OFF + 2048 + (dir * 2 + 0) * 4 + h, gcol_f = ML_OFF + 2048 + (dir * 2 + 1) * 4 + h;
    u32x4 kfA[2][2], vfA[2][2], kfB[2][2], vfB[2][2];
    ML_FRAG_LOAD(kfA, vfA, 0);
    __syncthreads();
    unsigned gi_[9], gf_[9];
#pragma unroll
    for (int q = 0; q < 9; ++q) { const int c = min(w + 8 * q, 67); const size_t tokl = (size_t)step_tok(b, dir, c * 64 + lane); gi_[q] = Pm[tokl * LDP + gcol_i]; gf_[q] = Pm[tokl * LDP + gcol_f]; }
#pragma unroll
    for (int q = 0; q < 9; ++q) { const int c = w + 8 * q; if (c >= 68) break;
        const float ig = __uint_as_float(gi_[q] << 16) + gbi, fg = __uint_as_float(gf_[q] << 16) + gbf;
        const float lf = fminf(fg, 0.f) - log1pf(expf(-fabsf(fg)));
        const float bcs = wave_scan_incl(lf, lane); const float blast = __shfl(bcs, 63); const float ei = blast - bcs + ig; const float beta = wave_max(ei);
        sE[c * 64 + lane] = ei; if (lane == 0) { sAL[c] = blast; sBE[c] = beta; } }
    __syncthreads();
    if (tid == 0) { float m = 0.f; for (int c = 0; c < 68; ++c) { sMB[c] = m; const float mo = fmaxf(m + sAL[c], sBE[c]); sDEC[c] = expf(sAL[c] + m - mo); sMO[c] = mo; m = mo; } }
    __syncthreads();
    for (int idx = tid; idx < 68 * 64; idx += NTHR) { const int c = idx >> 6, i = idx & 63; sWS[c * 64 + (dir ? 63 - i : i)] = expf(sE[idx] - sMO[c]); }
    if (half == 0 && tid < 68) MST[chain * 68 + tid] = sMB[tid];
    __syncthreads();
    f32x4 acc[2][2];
#pragma unroll
    for (int je = 0; je < 2; ++je)
#pragma unroll
        for (int jd = 0; jd < 2; ++jd) acc[je][jd] = (f32x4){0.f, 0.f, 0.f, 0.f};
    float npart[2] = {0.f, 0.f};
    for (int c2 = 0; c2 < 68; c2 += 2) { ML_CHUNK(c2, kfA, vfA, kfB, vfB); ML_CHUNK(c2 + 1, kfB, vfB, kfA, vfA); }
    __syncthreads();
}
#undef ML_CHUNK
#undef ML_FRAG_LOAD
__device__ __forceinline__ void mlstm_out_item(const int chain, const int c, const bf16_t* __restrict__ Pm, const bf16_t* __restrict__ QKb, const bf16_t* __restrict__ VTg, const float* __restrict__ gate_b,
                                               const bf16_t* __restrict__ CST, const float* __restrict__ NST, const float* __restrict__ MST, bf16_t* __restrict__ Hout, unsigned char* shm, const int tid) {
    const int dir = chain & 1, h = (chain >> 1) & 3, b = chain >> 3, lane = tid & 63, w = tid >> 6;
    bf16_t* Qs = (bf16_t*)shm; bf16_t* Ks = (bf16_t*)(shm + 17408); bf16_t* VT = (bf16_t*)(shm + 34816); bf16_t* Cs = (bf16_t*)(shm + 53248); bf16_t* Ss = (bf16_t*)(shm + 88064);
    float* sc = (float*)(shm + 97280);
    __syncthreads();
    u32x4 gq[2], gk[2], gv[2], gc[4]; float gn = 0.f;
#pragma unroll
    for (int i = 0; i < 2; ++i) { const int pid = tid + i * 512; const int s = pid >> 4, x0 = (pid & 15) * 8; const size_t toks = (size_t)step_tok(b, dir, c * 64 + s);
        gq[i] = *(const u32x4*)(QKb + toks * 1024 + h * 128 + x0);
        gk[i] = *(const u32x4*)(QKb + toks * 1024 + 512 + h * 128 + x0);
        { const int e = pid >> 3, o = pid & 7;
          gv[i] = *(const u32x4*)(VTg + ((size_t)tokblock_of(b, dir, c) * 512 + h * 128 + e) * 64 + (dir ? 7 - o : o) * 8); } }
#pragma unroll
    for (int i = 0; i < 4; ++i) { const int pid = tid + i * 512; const int e = pid >> 4, x0 = (pid & 15) * 8;
        gc[i] = *(const u32x4*)(CST + ((size_t)(chain * 68 + c) * 128 + e) * 128 + x0); }
    if (tid < 128) gn = NST[(size_t)(chain * 68 + c) * 128 + tid];
    unsigned gi_ = 0u, gf_ = 0u; float gbi = 0.f, gbf = 0.f, m_in = 0.f;
    if (w == 0) { const size_t tokl = (size_t)step_tok(b, dir, c * 64 + lane);
        gi_ = Pm[tokl * LDP + ML_OFF + 2048 + (dir * 2 + 0) * 4 + h]; gf_ = Pm[tokl * LDP + ML_OFF + 2048 + (dir * 2 + 1) * 4 + h];
        gbi = gate_b[(dir * 2 + 0) * 4 + h]; gbf = gate_b[(dir * 2 + 1) * 4 + h]; m_in = MST[chain * 68 + c]; }
#pragma unroll
    for (int i = 0; i < 2; ++i) { const int pid = tid + i * 512; const int s = pid >> 4, x0 = (pid & 15) * 8;
        *(u32x4*)(Qs + s * 136 + x0) = gq[i]; *(u32x4*)(Ks + s * 136 + x0) = gk[i];
        { const int e = pid >> 3, o = pid & 7; *(u32x4*)(VT + e * 72 + o * 8) = dir ? rev8h(gv[i]) : gv[i]; } }
#pragma unroll
    for (int i = 0; i < 4; ++i) { const int pid = tid + i * 512; const int e = pid >> 4, x0 = (pid & 15) * 8; *(u32x4*)(Cs + e * 136 + x0) = gc[i]; }
    if (tid < 128) sc[384 + tid] = gn;
    if (w == 0) {
        const float ig = __uint_as_float(gi_ << 16) + gbi;
        const float fg = __uint_as_float(gf_ << 16) + gbf;
        const float lf = fminf(fg, 0.f) - log1pf(expf(-fabsf(fg)));
        const float bcs = wave_scan_incl(lf, lane); const float gsv = ig - bcs; const float pm = wave_scanmax_incl(gsv, lane);
        const float mt = bcs + fmaxf(m_in, pm);
        sc[lane] = bcs; sc[64 + lane] = gsv; sc[128 + lane] = mt; sc[192 + lane] = expf(bcs + m_in - mt); sc[256 + lane] = expf(-mt);
    }
    __syncthreads();
    const int tt = w >> 1;
    {   f32x4 aS[2] = {(f32x4){0.f, 0.f, 0.f, 0.f}, (f32x4){0.f, 0.f, 0.f, 0.f}};
#pragma unroll
        for (int ks = 0; ks < 4; ++ks) { const bf16x8 af = *(const bf16x8*)(Qs + (16 * tt + (lane & 15)) * 136 + ks * 32 + (lane >> 4) * 8);
#pragma unroll
            for (int i = 0; i < 2; ++i) { const int st = (w & 1) * 2 + i; const bf16x8 bfr = *(const bf16x8*)(Ks + (16 * st + (lane & 15)) * 136 + ks * 32 + (lane >> 4) * 8);
                aS[i] = __builtin_amdgcn_mfma_f32_16x16x32_bf16(af, bfr, aS[i], 0, 0, 0); } }
        float rs[4] = {0.f, 0.f, 0.f, 0.f};
#pragma unroll
        for (int i = 0; i < 2; ++i) { const int s = 16 * ((w & 1) * 2 + i) + (lane & 15); const float gsv = sc[64 + s];
#pragma unroll
            for (int q = 0; q < 4; ++q) { const int t = 16 * tt + (lane >> 4) * 4 + q; const float val = (s <= t) ? aS[i][q] * expf(sc[t] + gsv - sc[128 + t]) : 0.f; Ss[t * 72 + s] = f2bf(val); rs[q] += val; } }
#pragma unroll
        for (int q = 0; q < 4; ++q) { float r = rs[q]; r += __shfl_xor(r, 1); r += __shfl_xor(r, 2); r += __shfl_xor(r, 4); r += __shfl_xor(r, 8);
            if ((lane & 15) == 0) sc[512 + (w & 1) * 64 + 16 * tt + (lane >> 4) * 4 + q] = r; }
        {   const int t = tid >> 3, part = tid & 7; float dot = 0.f;
#pragma unroll
            for (int j = 0; j < 16; ++j) dot += bf2f(Qs[t * 136 + part * 16 + j]) * sc[384 + part * 16 + j];
            dot += __shfl_xor(dot, 1); dot += __shfl_xor(dot, 2); dot += __shfl_xor(dot, 4);
            if (part == 0) sc[640 + t] = sc[192 + t] * dot; }
    }
    __syncthreads();
    {   f32x4 aN[4];
#pragma unroll
        for (int i = 0; i < 4; ++i) aN[i] = (f32x4){0.f, 0.f, 0.f, 0.f};
#pragma unroll
        for (int ks = 0; ks < 4; ++ks) { const bf16x8 af = *(const bf16x8*)(Qs + (16 * tt + (lane & 15)) * 136 + ks * 32 + (lane >> 4) * 8);
#pragma unroll
            for (int i = 0; i < 4; ++i) { const int et = (w & 1) * 4 + i; const bf16x8 bfr = *(const bf16x8*)(Cs + (16 * et + (lane & 15)) * 136 + ks * 32 + (lane >> 4) * 8);
                aN[i] = __builtin_amdgcn_mfma_f32_16x16x32_bf16(bfr, af, aN[i], 0, 0, 0); } }
        const int t = 16 * tt + (lane & 15);
        {   const float it = sc[192 + t];
#pragma unroll
            for (int i = 0; i < 4; ++i) { aN[i][0] *= it; aN[i][1] *= it; aN[i][2] *= it; aN[i][3] *= it; } }
#pragma unroll
        for (int ks = 0; ks < 2; ++ks) { const bf16x8 af = *(const bf16x8*)(Ss + (16 * tt + (lane & 15)) * 72 + ks * 32 + (lane >> 4) * 8);
#pragma unroll
            for (int i = 0; i < 4; ++i) { const int et = (w & 1) * 4 + i; const bf16x8 bfr = *(const bf16x8*)(VT + (16 * et + (lane & 15)) * 72 + ks * 32 + (lane >> 4) * 8);
                aN[i] = __builtin_amdgcn_mfma_f32_16x16x32_bf16(bfr, af, aN[i], 0, 0, 0); } }
        {   const size_t tokt = (size_t)step_tok(b, dir, c * 64 + t); const float dn = fmaxf(fabsf((sc[512 + t] + sc[576 + t]) + sc[640 + t]), sc[256 + t]);
#pragma unroll
            for (int i = 0; i < 4; ++i) { const int e0 = 16 * ((w & 1) * 4 + i) + (lane >> 4) * 4;
                u32x2 wv; wv.x = pk2(aN[i][0] / dn, aN[i][1] / dn); wv.y = pk2(aN[i][2] / dn, aN[i][3] / dn);
                *(u32x2*)(Hout + tokt * BW + h * 128 + e0) = wv; } }
    }
}


#define SD_FRAG_LOAD(BF, XF, cc_) do { const int tb_ = tokblock_of(b, dir, (cc_)); const bf16_t* bb_ = BTg + ((size_t)tb_ * 256 + grp * 128 + 64 * (w >> 2) + r16) * 64 + q4 * 8; const bf16_t* xb_ = XTg + ((size_t)tb_ * 512 + h * 64 + 16 * (w & 3) + r16) * 64 + q4 * 8; \
        _Pragma("unroll") for (int ks_ = 0; ks_ < 2; ++ks_) { XF[ks_] = *(const u32x4*)(xb_ + ks_ * 32); _Pragma("unroll") for (int j_ = 0; j_ < 4; ++j_) BF[j_][ks_] = *(const u32x4*)(bb_ + (size_t)j_ * 16 * 64 + ks_ * 32); } } while (0)
#define SD_CHUNK(c_, BF, XF, BFN, XFN) do { const int c = (c_); \
        if (c + 1 < 68) SD_FRAG_LOAD(BFN, XFN, c + 1); \
        const float dec = sDEC[c]; \
        {   bf16_t* ss = SSTb + (size_t)(chain * 68 + c) * 64 * 128; const int p = 16 * (w & 3) + r16; \
            _Pragma("unroll") for (int j = 0; j < 4; ++j) { const int n0 = 16 * ((w >> 2) * 4 + j) + q4 * 4; u32x2 pk; pk.x = pk2(acc[j][0], acc[j][1]); pk.y = pk2(acc[j][2], acc[j][3]); *(u32x2*)(ss + (size_t)p * 128 + n0) = pk; } } \
        bf16x8 xfr[2]; \
        _Pragma("unroll") for (int ks = 0; ks < 2; ++ks) { const float4 wa = *(const float4*)(sSC + c * 64 + ks * 32 + q4 * 8), wb = *(const float4*)(sSC + c * 64 + ks * 32 + q4 * 8 + 4); const u32x4 sv = scale8h(XF[ks], wa, wb); xfr[ks] = *(const bf16x8*)&sv; } \
        _Pragma("unroll") for (int j = 0; j < 4; ++j) acc[j] = acc[j] * dec; \
        _Pragma("unroll") for (int ks = 0; ks < 2; ++ks) _Pragma("unroll") for (int j = 0; j < 4; ++j) acc[j] = __builtin_amdgcn_mfma_f32_16x16x32_bf16(*(const bf16x8*)&BF[j][ks], xfr[ks], acc[j], 0, 0, 0); } while (0)
__device__ __forceinline__ void ssd_state_pass(const int chain, const bf16_t* __restrict__ Pm, const bf16_t* __restrict__ BTg, const bf16_t* __restrict__ XTg, const float Aa, const float dtb,
                                               bf16_t* __restrict__ SSTb, unsigned char* shm, const int tid) {
    const int dir = chain & 1, h = (chain >> 1) & 7, b = chain >> 4, grp = h >> 2, lane = tid & 63, w = tid >> 6, q4 = lane >> 4, r16 = lane & 15;
    float* sSC = (float*)shm; float* sDEC = sSC + 68 * 64;
    const int dcol = SSD_OFF + 1536 + dir * 8 + h;
    u32x4 bfA[4][2], xfA[2], bfB[4][2], xfB[2];
    SD_FRAG_LOAD(bfA, xfA, 0);
    __syncthreads();
    unsigned dt_[9];
#pragma unroll
    for (int q = 0; q < 9; ++q) { const int c = min(w + 8 * q, 67); dt_[q] = Pm[(size_t)step_tok(b, dir, c * 64 + lane) * LDP + dcol]; }
#pragma unroll
    for (int q = 0; q < 9; ++q) { const int c = w + 8 * q; if (c >= 68) break;
        const float xv = __uint_as_float(dt_[q] << 16) + dtb; const float dtv = xv > 20.f ? xv : log1pf(expf(xv));
        const float cs = wave_scan_incl(dtv * Aa, lane); const float cl = __shfl(cs, 63);
        sSC[c * 64 + (dir ? 63 - lane : lane)] = dtv * expf(cl - cs); if (lane == 0) sDEC[c] = expf(cl); }
    __syncthreads();
    f32x4 acc[4];
#pragma unroll
    for (int j = 0; j < 4; ++j) acc[j] = (f32x4){0.f, 0.f, 0.f, 0.f};
    for (int c2 = 0; c2 < 68; c2 += 2) { SD_CHUNK(c2, bfA, xfA, bfB, xfB); SD_CHUNK(c2 + 1, bfB, xfB, bfA, xfA); }
    __syncthreads();
}
#undef SD_CHUNK
#undef SD_FRAG_LOAD
__device__ __forceinline__ void ssd_out_item(const int chain, const int c, const bf16_t* __restrict__ Pm, const bf16_t* __restrict__ XBb, const bf16_t* __restrict__ XTg, const float Aa, const float dtb,
                                             const bf16_t* __restrict__ SSTb, bf16_t* __restrict__ Yout, unsigned char* shm, const int tid) {
    const int dir = chain & 1, h = (chain >> 1) & 7, b = chain >> 4, grp = h >> 2, lane = tid & 63, w = tid >> 6;
    bf16_t* Cs = (bf16_t*)shm; bf16_t* Bs = (bf16_t*)(shm + 17408); bf16_t* XT = (bf16_t*)(shm + 34816); bf16_t* Sin = (bf16_t*)(shm + 44032); bf16_t* Gs = (bf16_t*)(shm + 61440);
    float* sc = (float*)(shm + 70656);
    __syncthreads();
    u32x4 gb[2], gcc[2], gs[2], gx; unsigned gd_ = 0u;
#pragma unroll
    for (int i = 0; i < 2; ++i) { const int pid = tid + i * 512; const int s = pid >> 4, x0 = (pid & 15) * 8; const size_t toks = (size_t)step_tok(b, dir, c * 64 + s);
        gb[i] = *(const u32x4*)(XBb + toks * 1024 + 512 + grp * 128 + x0);
        gcc[i] = *(const u32x4*)(XBb + toks * 1024 + 768 + grp * 128 + x0);
        const int p = pid >> 4;
        gs[i] = *(const u32x4*)(SSTb + ((size_t)(chain * 68 + c) * 64 + p) * 128 + x0); }
    {   const int p = tid >> 3, o = tid & 7;
        gx = *(const u32x4*)(XTg + ((size_t)tokblock_of(b, dir, c) * 512 + h * 64 + p) * 64 + (dir ? 7 - o : o) * 8); }
    if (w == 0) gd_ = Pm[(size_t)step_tok(b, dir, c * 64 + lane) * LDP + SSD_OFF + 1536 + dir * 8 + h];
#pragma unroll
    for (int i = 0; i < 2; ++i) { const int pid = tid + i * 512; const int s = pid >> 4, x0 = (pid & 15) * 8;
        *(u32x4*)(Bs + s * 136 + x0) = gb[i]; *(u32x4*)(Cs + s * 136 + x0) = gcc[i]; *(u32x4*)(Sin + s * 136 + x0) = gs[i]; }
    {   const int p = tid >> 3, o = tid & 7; *(u32x4*)(XT + p * 72 + o * 8) = dir ? rev8h(gx) : gx; }
    if (w == 0) {
        const float xv = __uint_as_float(gd_ << 16) + dtb; const float dtv = xv > 20.f ? xv : log1pf(expf(xv));
        sc[lane] = wave_scan_incl(dtv * Aa, lane); sc[64 + lane] = dtv; }
    __syncthreads();
    {   const int lt = w >> 1;
        f32x4 aG[2] = {(f32x4){0.f, 0.f, 0.f, 0.f}, (f32x4){0.f, 0.f, 0.f, 0.f}};
#pragma unroll
        for (int ks = 0; ks < 4; ++ks) { const bf16x8 af = *(const bf16x8*)(Cs + (16 * lt + (lane & 15)) * 136 + ks * 32 + (lane >> 4) * 8);
#pragma unroll
            for (int i = 0; i < 2; ++i) { const int st = (w & 1) * 2 + i; const bf16x8 bfr = *(const bf16x8*)(Bs + (16 * st + (lane & 15)) * 136 + ks * 32 + (lane >> 4) * 8);
                aG[i] = __builtin_amdgcn_mfma_f32_16x16x32_bf16(af, bfr, aG[i], 0, 0, 0); } }
#pragma unroll
        for (int i = 0; i < 2; ++i) { const int s = 16 * ((w & 1) * 2 + i) + (lane & 15); const float css = sc[s], dts = sc[64 + s];
#pragma unroll
            for (int q = 0; q < 4; ++q) { const int t = 16 * lt + (lane >> 4) * 4 + q; const float val = (s <= t) ? aG[i][q] * expf(sc[t] - css) * dts : 0.f; Gs[t * 72 + s] = f2bf(val); } }
    }
    __syncthreads();
    {   const int lt = w >> 1;
        f32x4 aY[2] = {(f32x4){0.f, 0.f, 0.f, 0.f}, (f32x4){0.f, 0.f, 0.f, 0.f}};
#pragma unroll
        for (int ks = 0; ks < 4; ++ks) { const bf16x8 af = *(const bf16x8*)(Cs + (16 * lt + (lane & 15)) * 136 + ks * 32 + (lane >> 4) * 8);
#pragma unroll
            for (int i = 0; i < 2; ++i) { const int pt = (w & 1) * 2 + i; const bf16x8 bfr = *(const bf16x8*)(Sin + (16 * pt + (lane & 15)) * 136 + ks * 32 + (lane >> 4) * 8);
                aY[i] = __builtin_amdgcn_mfma_f32_16x16x32_bf16(bfr, af, aY[i], 0, 0, 0); } }
        const int t = 16 * lt + (lane & 15);
        {   const float ec = expf(sc[t]);
#pragma unroll
            for (int i = 0; i < 2; ++i) { aY[i][0] *= ec; aY[i][1] *= ec; aY[i][2] *= ec; aY[i][3] *= ec; } }
#pragma unroll
        for (int ks = 0; ks < 2; ++ks) { const bf16x8 af = *(const bf16x8*)(Gs + (16 * lt + (lane & 15)) * 72 + ks * 32 + (lane >> 4) * 8);
#pragma unroll
            for (int i = 0; i < 2; ++i) { const int pt = (w & 1) * 2 + i; const bf16x8 bfr = *(const bf16x8*)(XT + (16 * pt + (lane & 15)) * 72 + ks * 32 + (lane >> 4) * 8);
                aY[i] = __builtin_amdgcn_mfma_f32_16x16x32_bf16(bfr, af, aY[i], 0, 0, 0); } }
        {   const size_t tokt = (size_t)step_tok(b, dir, c * 64 + t);
#pragma unroll
            for (int i = 0; i < 2; ++i) { const int p0 = 16 * ((w & 1) * 2 + i) + (lane >> 4) * 4;
                u32x2 wv; wv.x = pk2(aY[i][0], aY[i][1]); wv.y = pk2(aY[i][2], aY[i][3]);
                *(u32x2*)(Yout + tokt * BW + h * 64 + p0) = wv; } }
    }
}


#define FIDX(i) ((i) + ((i) >> 4))
#define FFT_X_BYTES 69632
__device__ constexpr float FFT_CW_RE[6][16] = {{0.f, 0.f, 0.f, 0.f, 0.f, 0.f, 0.f, 0.f, 0.f, 0.f, 0.f, 0.f, 0.f, 0.f, 0.f, 0.f}, {1.0f, 0.f, 0.f, 0.f, 0.f, 0.f, 0.f, 0.f, 0.f, 0.f, 0.f, 0.f, 0.f, 0.f, 0.f, 0.f}, {1.0f, 6.123233995736766e-17f, 0.f, 0.f, 0.f, 0.f, 0.f, 0.f, 0.f, 0.f, 0.f, 0.f, 0.f, 0.f, 0.f, 0.f}, {1.0f, 0.7071067811865476f, 6.123233995736766e-17f, -0.7071067811865475f, 0.f, 0.f, 0.f, 0.f, 0.f, 0.f, 0.f, 0.f, 0.f, 0.f, 0.f, 0.f}, {1.0f, 0.9238795325112867f, 0.7071067811865476f, 0.38268343236508984f, 6.123233995736766e-17f, -0.3826834323650897f, -0.7071067811865475f, -0.9238795325112867f, 0.f, 0.f, 0.f, 0.f, 0.f, 0.f, 0.f, 0.f}, {1.0f, 0.9807852804032304f, 0.9238795325112867f, 0.8314696123025452f, 0.7071067811865476f, 0.5555702330196023f, 0.38268343236508984f, 0.19509032201612833f, 6.123233995736766e-17f, -0.1950903220161282f, -0.3826834323650897f, -0.555570233019602f, -0.7071067811865475f, -0.8314696123025453f, -0.9238795325112867f, -0.9807852804032304f}};
__device__ constexpr float FFT_CW_IM[6][16] = {{0.f, 0.f, 0.f, 0.f, 0.f, 0.f, 0.f, 0.f, 0.f, 0.f, 0.f, 0.f, 0.f, 0.f, 0.f, 0.f}, {-0.0f, 0.f, 0.f, 0.f, 0.f, 0.f, 0.f, 0.f, 0.f, 0.f, 0.f, 0.f, 0.f, 0.f, 0.f, 0.f}, {-0.0f, -1.0f, 0.f, 0.f, 0.f, 0.f, 0.f, 0.f, 0.f, 0.f, 0.f, 0.f, 0.f, 0.f, 0.f, 0.f}, {-0.0f, -0.7071067811865475f, -1.0f, -0.7071067811865476f, 0.f, 0.f, 0.f, 0.f, 0.f, 0.f, 0.f, 0.f, 0.f, 0.f, 0.f, 0.f}, {-0.0f, -0.3826834323650898f, -0.7071067811865475f, -0.9238795325112867f, -1.0f, -0.9238795325112867f, -0.7071067811865476f, -0.3826834323650899f, 0.f, 0.f, 0.f, 0.f, 0.f, 0.f, 0.f, 0.f}, {-0.0f, -0.19509032201612825f, -0.3826834323650898f, -0.5555702330196022f, -0.7071067811865475f, -0.8314696123025452f, -0.9238795325112867f, -0.9807852804032304f, -1.0f, -0.9807852804032304f, -0.9238795325112867f, -0.8314696123025455f, -0.7071067811865476f, -0.5555702330196022f, -0.3826834323650899f, -0.1950903220161286f}};
__host__ __device__ constexpr int fft_bitrev(int k, int R) { int r = 0; for (int i = 0; i < R; ++i) if (k & (1 << i)) r |= 1 << (R - 1 - i); return r; }
template <int R, bool INV>
__device__ __forceinline__ void fft_pass(float2* __restrict__ X, const float2* __restrict__ TW, const int s0, const int gidx) {
    const int lowbits = 13 - s0 - R; const int stride = 1 << lowbits;
    const int low = gidx & (stride - 1), high = gidx >> lowbits; const int base = (high << (lowbits + R)) | low;
    const int p0 = FIDX(base);
#define FFT_SLOT(k) (lowbits >= 4 ? p0 + (k) * (stride + (stride >> 4)) : p0 + (k) + ((k) >> 4))
    float2 v[1 << R];
#pragma unroll
    for (int k = 0; k < (1 << R); ++k) v[k] = X[FFT_SLOT(k)];
    const int lw = low << s0;
    if (!INV) {
#pragma unroll
        for (int j = 0; j < R; ++j) { const int hk = 1 << (R - 1 - j);
#pragma unroll
            for (int k = 0; k < (1 << R); ++k) if (!(k & hk)) { const int kk = k & (hk - 1);
                const float2 a = v[k], b = v[k + hk]; v[k] = make_float2(a.x + b.x, a.y + b.y); const float dx = a.x - b.x, dy = a.y - b.y;
                if (kk == 0) v[k + hk] = make_float2(dx, dy);
                else if (2 * kk == hk) v[k + hk] = make_float2(dy, -dx);
                else { const float cr = FFT_CW_RE[R - j][kk], ci = FFT_CW_IM[R - j][kk]; v[k + hk] = make_float2(dx * cr - dy * ci, dx * ci + dy * cr); } } }
        if (lowbits > 0) {
#pragma unroll
            for (int k = 1; k < (1 << R); ++k) { const float2 w = TW[(lw * fft_bitrev(k, R)) & 8191]; const float2 a = v[k]; v[k] = make_float2(a.x * w.x - a.y * w.y, a.x * w.y + a.y * w.x); } }
    } else {
        if (lowbits > 0) {
#pragma unroll
            for (int k = 1; k < (1 << R); ++k) { const float2 w = TW[(lw * fft_bitrev(k, R)) & 8191]; const float2 a = v[k]; v[k] = make_float2(a.x * w.x + a.y * w.y, a.y * w.x - a.x * w.y); } }
#pragma unroll
        for (int j = R - 1; j >= 0; --j) { const int hk = 1 << (R - 1 - j);
#pragma unroll
            for (int k = 0; k < (1 << R); ++k) if (!(k & hk)) { const int kk = k & (hk - 1);
                const float2 a = v[k], b = v[k + hk]; float tx, ty;
                if (kk == 0) { tx = b.x; ty = b.y; }
                else if (2 * kk == hk) { tx = -b.y; ty = b.x; }
                else { const float cr = FFT_CW_RE[R - j][kk], ci = FFT_CW_IM[R - j][kk]; tx = b.x * cr + b.y * ci; ty = b.y * cr - b.x * ci; }
                v[k] = make_float2(a.x + tx, a.y + ty); v[k + hk] = make_float2(a.x - tx, a.y - ty); } }
    }
#pragma unroll
    for (int k = 0; k < (1 << R); ++k) X[FFT_SLOT(k)] = v[k];
#undef FFT_SLOT
}
__device__ __forceinline__ void fft_fwd(float2* X, const float2* TW, const int tid) {
    fft_pass<4, false>(X, TW, 0, tid); __syncthreads(); fft_pass<4, false>(X, TW, 4, tid); __syncthreads(); if (tid < 256) fft_pass<5, false>(X, TW, 8, tid); __syncthreads(); }
__device__ __forceinline__ void fft_inv(float2* X, const float2* TW, const int tid) {
    if (tid < 256) fft_pass<5, true>(X, TW, 8, tid); __syncthreads(); fft_pass<4, true>(X, TW, 4, tid); __syncthreads(); fft_pass<4, true>(X, TW, 0, tid); __syncthreads(); }
__device__ __forceinline__ void fft_twiddles(float2* TW, const int tid) {
#pragma unroll
    for (int k = 0; k < 16; ++k) { const int m = tid + k * 512; const float xx = (float)m * (1.0f / 4096.0f); TW[m] = make_float2(cospif(xx), -sinpif(xx)); }
}
__device__ __forceinline__ void hyena_spec_item(const int pr, const float* __restrict__ HR, const float* __restrict__ nrm, float2* __restrict__ HSPEC, unsigned char* shm, const int tid) {
    float2* X = (float2*)shm; const float2* TW = (const float2*)(shm + FFT_X_BYTES);
    const int o = pr >> 8, c = (pr & 255) * 2, oc = o * 512 + c; const float inva = 1.0f / nrm[oc], invb = 1.0f / nrm[oc + 1];
    __syncthreads();
    float2 hv[16];
#pragma unroll
    for (int k = 0; k < 16; ++k) { const int j = tid + k * 512;
        const unsigned off = j < SEQ ? (unsigned)j * 2048u + o * 1024 + c : j == SEQ ? (unsigned)(o * 1024 + c) : (unsigned)(2 * SEQ - j) * 2048u + o * 1024 + 512 + c;
        hv[k] = *(const float2*)(HR + off); }
#pragma unroll
    for (int k = 0; k < 16; ++k) { const int j = tid + k * 512; X[FIDX(j)] = j == SEQ ? make_float2(0.f, 0.f) : make_float2(hv[k].x * inva, hv[k].y * invb); }
    __syncthreads();
    fft_fwd(X, TW, tid);
    float4* outa = (float4*)(HSPEC + (size_t)oc * 8192 + tid * 16); float4* outb = (float4*)(HSPEC + (size_t)(oc + 1) * 8192 + tid * 16); const float2* xs = X + 17 * tid;
    const float sc_ = 0.5f / 8192.0f;
#pragma unroll
    for (int k = 0; k < 8; ++k) { float2 ha[2], hb[2];
#pragma unroll
        for (int q = 0; q < 2; ++q) { const int p = 16 * tid + 2 * k + q; const int kf = (int)(__builtin_bitreverse32((unsigned)p) >> 19); const int p2 = (int)(__builtin_bitreverse32((unsigned)((8192 - kf) & 8191)) >> 19);
            const float2 xp = xs[2 * k + q], xq = X[FIDX(p2)];
            ha[q] = make_float2((xp.x + xq.x) * sc_, (xp.y - xq.y) * sc_);
            hb[q] = make_float2((xp.y + xq.y) * sc_, (xq.x - xp.x) * sc_); }
        outa[k] = make_float4(ha[0].x, ha[0].y, ha[1].x, ha[1].y); outb[k] = make_float4(hb[0].x, hb[0].y, hb[1].x, hb[1].y); }
}
__device__ __forceinline__ void fft_mul_spec(float2* X, const float2* __restrict__ H, const int tid) {
    const float4* h4 = (const float4*)(H + tid * 16); float2* xs = X + 17 * tid;
#pragma unroll
    for (int k = 0; k < 8; ++k) { const float4 hv = h4[k]; const float2 x0 = xs[2 * k], x1 = xs[2 * k + 1];
        xs[2 * k] = make_float2(x0.x * hv.x - x0.y * hv.y, x0.x * hv.y + x0.y * hv.x); xs[2 * k + 1] = make_float2(x1.x * hv.z - x1.y * hv.w, x1.x * hv.w + x1.y * hv.z); }
}
__device__ __forceinline__ void hyena_fft_item(const int item, const bf16_t* __restrict__ UT, const float2* __restrict__ HSPEC, const float* __restrict__ bias, float* __restrict__ YT, unsigned char* shm, const int tid) {
    float2* X = (float2*)shm; const float2* TW = (const float2*)(shm + FFT_X_BYTES);
    const int c = item >> 1, b0 = (item & 1) * 2, b1 = b0 + 1;
    const bf16_t* u0 = UT + (size_t)(b0 * 1536 + c) * SEQ + tid * 8; const bf16_t* u1 = UT + (size_t)(b1 * 1536 + c) * SEQ + tid * 8;
    const float bias0 = bias[c], bias1 = bias[512 + c];
    float2* xs = X + FIDX(8 * tid);
    float vr[8], vi[8];
    __syncthreads();
    { const u32x4 a0 = *(const u32x4*)u0, c0 = *(const u32x4*)u1; unpack8(a0, vr); unpack8(c0, vi); }
#pragma unroll
    for (int k = 0; k < 8; ++k) { xs[k] = make_float2(vr[k], vi[k]); xs[4352 + k] = make_float2(0.f, 0.f); }
    __syncthreads();
    fft_fwd(X, TW, tid);
    fft_mul_spec(X, HSPEC + (size_t)c * 8192, tid);
    __syncthreads();
    fft_inv(X, TW, tid);
    { const bf16_t* p0 = u0 + (size_t)512 * SEQ; const bf16_t* p1 = u1 + (size_t)512 * SEQ;
      float xr[8], xi[8]; { const u32x4 a0 = *(const u32x4*)p0, c0 = *(const u32x4*)p1; unpack8(a0, xr); unpack8(c0, xi); }
#pragma unroll
      for (int k = 0; k < 8; ++k) { const float2 cv = xs[k]; const float zr = xr[k] * (cv.x + bias0 * vr[k]), zi = xi[k] * (cv.y + bias0 * vi[k]);
          vr[k] = zr; vi[k] = zi; xs[k] = make_float2(zr, zi); xs[4352 + k] = make_float2(0.f, 0.f); } }
    __syncthreads();
    fft_fwd(X, TW, tid);
    fft_mul_spec(X, HSPEC + (size_t)(512 + c) * 8192, tid);
    __syncthreads();
    fft_inv(X, TW, tid);
    { const bf16_t* p0 = u0 + (size_t)1024 * SEQ; const bf16_t* p1 = u1 + (size_t)1024 * SEQ;
      float xr[8], xi[8]; { const u32x4 a0 = *(const u32x4*)p0, c0 = *(const u32x4*)p1; unpack8(a0, xr); unpack8(c0, xi); }
      float yr[8], yi[8];
#pragma unroll
      for (int k = 0; k < 8; ++k) { const float2 cv = xs[k]; yr[k] = xr[k] * (cv.x + bias1 * vr[k]); yi[k] = xi[k] * (cv.y + bias1 * vi[k]); }
      float* y0 = YT + (size_t)(b0 * 512 + c) * SEQ + tid * 8; float* y1 = YT + (size_t)(b1 * 512 + c) * SEQ + tid * 8;
      *(float4*)y0 = make_float4(yr[0], yr[1], yr[2], yr[3]); *(float4*)(y0 + 4) = make_float4(yr[4], yr[5], yr[6], yr[7]);
      *(float4*)y1 = make_float4(yi[0], yi[1], yi[2], yi[3]); *(float4*)(y1 + 4) = make_float4(yi[4], yi[5], yi[6], yi[7]); }
}

constexpr size_t al256(size_t x) { return (x + 255) & ~(size_t)255; }
constexpr size_t O_BAR = 0;
constexpr size_t O_MOD = 16384;
constexpr size_t O_NORM = O_MOD + al256((size_t)2 * 5 * 6 * DM * 4);
constexpr size_t O_QCTR = O_NORM + al256((size_t)2 * 2 * 1024 * 4);
constexpr size_t O_ZERO_END = O_QCTR + 512;
constexpr size_t O_XS = O_ZERO_END;
constexpr size_t O_HB = O_XS + al256((size_t)NTOK * DM * 4);
constexpr size_t O_P = O_HB + al256((size_t)NTOK * DM * 2);
constexpr size_t O_WIN = O_P + al256((size_t)NTOK * LDP * 2);
constexpr size_t O_WBR = O_WIN + al256((size_t)LDP * DM * 2);
constexpr size_t O_WOUT = O_WBR + al256((size_t)4 * DM * BW * 2);
constexpr size_t O_WGU = O_WOUT + al256((size_t)DM * DM * 2);
constexpr size_t O_WD = O_WGU + al256((size_t)NEXP * 2 * DEXP * DM * 2);
constexpr size_t O_GLU = O_WD + al256((size_t)NEXP * DM * DEXP * 2);
constexpr size_t O_Y4 = O_GLU + al256((size_t)BW * BW * 2);
constexpr size_t O_U = O_Y4 + al256((size_t)NTOK * DM * 2);
constexpr size_t O_QKB = O_U + al256((size_t)NTOK * 1536 * 4);
constexpr size_t O_CST = O_QKB + al256((size_t)NTOK * 1024 * 2);
constexpr size_t O_NST = O_CST + al256((size_t)32 * 68 * 128 * 128 * 2);
constexpr size_t O_MST = O_NST + al256((size_t)32 * 68 * 128 * 4);
constexpr size_t O_XBC = O_MST + al256((size_t)32 * 68 * 4);
constexpr size_t O_SST = O_XBC + al256((size_t)NTOK * 1024 * 2);
constexpr size_t O_HF = O_SST + al256((size_t)64 * 68 * 64 * 128 * 2);
constexpr size_t O_YF = O_HF + al256((size_t)2 * NTOK * BW * 4);
constexpr size_t O_SF = O_YF + al256((size_t)2 * NTOK * BW * 4);
constexpr size_t O_LDT = O_SF + al256((size_t)2 * NCTX * BW * 4);
constexpr size_t O_AP = O_LDT + al256((size_t)4096 * 16);
constexpr size_t O_BBT = O_AP + al256((size_t)4096 * 33 * 8);
constexpr size_t O_KT = O_BBT + al256((size_t)4096 * 16 * 8);
constexpr size_t O_S5A = O_KT + al256((size_t)32 * 2 * 32 * 256 * 4);
constexpr size_t O_S5B = O_S5A + al256((size_t)32 * 512 * 768 * 2);
constexpr size_t O_XCTX = O_S5B + al256((size_t)32 * 512 * 768 * 2);
constexpr size_t O_Z = O_XCTX + al256((size_t)4 * 32 * 2 * 64 * 8);
constexpr size_t O_HRAW = O_Z + al256((size_t)NTOK * BW * 4);
constexpr size_t O_HSPEC = O_HRAW + al256((size_t)(SEQ + CTXL) * 2048 * 4);
constexpr size_t O_K2C = O_HSPEC + al256((size_t)1024 * 8192 * 8);
constexpr size_t O_GG = O_K2C + al256((size_t)(2 * CTXL) * 1024 * 4);
constexpr size_t O_PROBS = O_GG + al256((size_t)NTOK * BW * 2);
constexpr size_t O_ROWTOK = O_PROBS + al256((size_t)NTOK * 16 * 4);
constexpr size_t O_ROWGATE = O_ROWTOK + al256((size_t)NEXP * MOE_PAD * 4);
constexpr size_t O_INV = O_ROWGATE + al256((size_t)NEXP * MOE_PAD * 4);
constexpr size_t O_NORMP = O_INV + al256((size_t)NTOK * 16 * 4);
constexpr size_t WS_END = O_NORMP + al256((size_t)4 * 256 * 2048 * 4);
constexpr size_t O_XG = O_P;
constexpr size_t O_HID = O_P + al256((size_t)NEXP * MOE_PAD * DM * 2);
constexpr size_t O_YEXP = O_HID + al256((size_t)NEXP * MOE_PAD * DEXP * 2);
static_assert(O_YEXP + (size_t)NEXP * MOE_PAD * DM * 2 <= O_WIN, "MoE temporaries must fit inside P");
static_assert((size_t)NTOK * DM * 2 <= (size_t)NTOK * 1536 * 4, "ACCb must fit inside U");
static_assert((size_t)26214400 + (size_t)2 * 17825792 + (size_t)272 * 256 * 64 * 2 <= (size_t)NTOK * DM * 2, "strip buffers must fit inside HB");
static_assert(WS_END <= (size_t)1851000000, "workspace map exceeds the guaranteed size");

struct Args {
    const float* in[47];
    float* out; unsigned char* ws;
    int ph_lo, ph_hi;
};

__device__ __forceinline__ void conv_tile(const float* __restrict__ src, int ldsrc, int nvalid, int k0, int n0, bf16_t* __restrict__ dst, int lddst, int mode, float* T, int tid) {
    { const int n = tid & 63, kr = tid >> 6;
#pragma unroll
      for (int i = 0; i < 8; ++i) { const int k = i * 8 + kr; T[k * 65 + n] = (n0 + n < nvalid) ? src[(size_t)(k0 + k) * ldsrc + n0 + n] : 0.f; } }
    __syncthreads();
    { const int n = tid >> 3, kc = (tid & 7) * 8; const int gn = n0 + n;
      const int drow = mode == 0 ? gn : (32 * (gn >> 4) + (mode == 2 ? 16 : 0) + (gn & 15));
      u32x4 w; w.x = pk2(T[(kc + 0) * 65 + n], T[(kc + 1) * 65 + n]); w.y = pk2(T[(kc + 2) * 65 + n], T[(kc + 3) * 65 + n]);
      w.z = pk2(T[(kc + 4) * 65 + n], T[(kc + 5) * 65 + n]); w.w = pk2(T[(kc + 6) * 65 + n], T[(kc + 7) * 65 + n]);
      *(u32x4*)(dst + (size_t)drow * lddst + k0 + kc) = w; }
    __syncthreads();
}

#define IN(id) (lo <= (id) && (id) < hi)
#define SEAM(id) do { if (hi > (id) + 1) xcd_barrier(bar); } while (0)
#define PH_BEGIN int tid = threadIdx.x; asm volatile("" : "+v"(tid) :: "memory"); const int lane = tid & 63, wave = tid >> 6; (void)lane; (void)wave;

#define x_in (PT(0))
#define c_in (PT(1))
#define ctx_in (PT(2))
#define cctx_in (PT(3))
#define ada_w (PT(4))
#define ada_b (PT(5))
#define norm_mix (PT(6))
#define norm_ffn (PT(7))
#define w_in (PT(8))
#define XS ((float*)(a.ws + O_XS))
#define MOD ((float*)(a.ws + O_MOD))
#define NORM ((float*)(a.ws + O_NORM))
#define NORMP ((float*)(a.ws + O_NORMP))
#define MODl (MOD + (size_t)l * 5 * 6 * DM)
#define HB ((bf16_t*)(a.ws + O_HB))
#define P ((bf16_t*)(a.ws + O_P))
#define WIN ((bf16_t*)(a.ws + O_WIN))
#define WBR ((bf16_t*)(a.ws + O_WBR))
#define WOUT ((bf16_t*)(a.ws + O_WOUT))
#define WGU ((bf16_t*)(a.ws + O_WGU))
#define WD ((bf16_t*)(a.ws + O_WD))
#define GLU ((bf16_t*)(a.ws + O_GLU))
#define Y4 ((bf16_t*)(a.ws + O_Y4))
#define U ((float*)(a.ws + O_U))
#define ACCb ((bf16_t*)(a.ws + O_U))
#define QKB ((bf16_t*)(a.ws + O_QKB))
#define CST ((bf16_t*)(a.ws + O_CST))
#define NST ((float*)(a.ws + O_NST))
#define MST ((float*)(a.ws + O_MST))
#define XBC ((bf16_t*)(a.ws + O_XBC))
#define SSTB ((bf16_t*)(a.ws + O_SST))
#define HF ((bf16_t*)(a.ws + O_HF))
#define HBk (HF + (size_t)NTOK * BW)
#define YF ((bf16_t*)(a.ws + O_YF))
#define YB (YF + (size_t)NTOK * BW)
#define SF ((float*)(a.ws + O_SF))
#define SB (SF + (size_t)NCTX * BW)
#define LDT ((double2*)(a.ws + O_LDT))
#define APW ((float2*)(a.ws + O_AP))
#define BBT ((float2*)(a.ws + O_BBT))
#define KTB ((float*)(a.ws + O_KT))
#define S5A ((bf16_t*)(a.ws + O_S5A))
#define S5B ((bf16_t*)(a.ws + O_S5B))
#define XCTX ((float2*)(a.ws + O_XCTX))
#define S5P ((bf16_t*)(a.ws + O_HB))
#define XLOC ((float*)(a.ws + O_HB + (size_t)32 * 256 * 512 * 2))
#define KTG ((bf16_t*)(a.ws + O_HB + (size_t)26214400))
#define VTG ((bf16_t*)(a.ws + O_HB + (size_t)26214400 + (size_t)17825792))
#define BTG ((bf16_t*)(a.ws + O_HB + (size_t)26214400 + (size_t)2 * 17825792))
#define XTG ((bf16_t*)(a.ws + O_GG))
#define Z ((float*)(a.ws + O_Z))
#define HRAW ((float*)(a.ws + O_HRAW))
#define HSPEC ((float2*)(a.ws + O_HSPEC))
#define UT ((bf16_t*)(a.ws + O_U))
#define YT ((float*)(a.ws + O_Z))
#define QCTR ((int*)(a.ws + O_QCTR))
#define K2C ((float*)(a.ws + O_K2C))
#define GG ((bf16_t*)(a.ws + O_GG))
#define PROBS ((float*)(a.ws + O_PROBS))
#define ROWTOK ((int*)(a.ws + O_ROWTOK))
#define ROWGATE ((float*)(a.ws + O_ROWGATE))
#define XG ((bf16_t*)(a.ws + O_XG))
#define HID ((bf16_t*)(a.ws + O_HID))
#define YEXP ((bf16_t*)(a.ws + O_YEXP))
#define INV ((int*)(a.ws + O_INV))


__device__ __forceinline__ void moe_pair(float4 (&a)[8], const int r1, const int r2, const float g2scale, const int lane, const float* __restrict__ rowgate, const bf16_t* __restrict__ yexp) {
    const float gt1 = rowgate[r1], gt2 = rowgate[r2] * g2scale;
    const bf16_t* y1 = yexp + (size_t)r1 * DM + lane * 4; const bf16_t* y2 = yexp + (size_t)r2 * DM + lane * 4;
    u32x2 w1[8], w2[8];
#pragma unroll
    for (int i = 0; i < 8; ++i) { w1[i] = *(const u32x2*)(y1 + i * 256); w2[i] = *(const u32x2*)(y2 + i * 256); }
#pragma unroll
    for (int i = 0; i < 8; ++i) {
        a[i].x += gt1 * __uint_as_float(w1[i].x << 16); a[i].y += gt1 * __uint_as_float(w1[i].x & 0xFFFF0000u); a[i].z += gt1 * __uint_as_float(w1[i].y << 16); a[i].w += gt1 * __uint_as_float(w1[i].y & 0xFFFF0000u);
        a[i].x += gt2 * __uint_as_float(w2[i].x << 16); a[i].y += gt2 * __uint_as_float(w2[i].x & 0xFFFF0000u); a[i].z += gt2 * __uint_as_float(w2[i].y << 16); a[i].w += gt2 * __uint_as_float(w2[i].y & 0xFFFF0000u); }
}
__device__ __forceinline__ void moe_combine(float4 (&v)[8], const int tok, const int lane, const int* __restrict__ inv, const float* __restrict__ rowgate, const bf16_t* __restrict__ yexp, const float* __restrict__ m5) {
    float4 a[8], mm[8];
#pragma unroll
    for (int i = 0; i < 8; ++i) { a[i] = make_float4(0.f, 0.f, 0.f, 0.f); mm[i] = *(const float4*)(m5 + i * 256 + lane * 4); }
    const int4* ip = (const int4*)(inv + (size_t)tok * 16);
    const int4 q0 = ip[0], q1 = ip[1], q2 = ip[2], q3 = ip[3];
    const int rows[16] = {q0.x, q0.y, q0.z, q0.w, q1.x, q1.y, q1.z, q1.w, q2.x, q2.y, q2.z, q2.w, q3.x, q3.y, q3.z, q3.w};
    int prow = -1;
#pragma unroll
    for (int e = 0; e < 16; ++e) { const int row = __builtin_amdgcn_readfirstlane(rows[e]);
        if (row >= 0) { if (prow >= 0) { moe_pair(a, prow, row, 1.0f, lane, rowgate, yexp); prow = -1; } else prow = row; } }
    if (prow >= 0) moe_pair(a, prow, prow, 0.0f, lane, rowgate, yexp);
#pragma unroll
    for (int i = 0; i < 8; ++i) { v[i].x += mm[i].x * a[i].x; v[i].y += mm[i].y * a[i].y; v[i].z += mm[i].z * a[i].z; v[i].w += mm[i].w * a[i].w; }
}
struct CvU { const float* src; bf16_t* dst; int ldsrc, nvalid, k0, n0, lddst, mode; };
__device__ __forceinline__ void cv_load(const CvU& u, float4 (&r)[8], const int tid) {
#pragma unroll
    for (int i = 0; i < 8; ++i) { const int idx = tid + i * 512; const int k = idx >> 6, n = u.n0 + (idx & 63) * 4;
        r[i] = (n < u.nvalid) ? *(const float4*)(u.src + (size_t)(u.k0 + k) * u.ldsrc + n) : make_float4(0.f, 0.f, 0.f, 0.f); }
}
__device__ __forceinline__ void cv_stage(float* T, const float4 (&r)[8], const int tid) {
#pragma unroll
    for (int i = 0; i < 8; ++i) { const int idx = tid + i * 512; float* p = T + (idx >> 6) * 257 + (idx & 63) * 4; p[0] = r[i].x; p[1] = r[i].y; p[2] = r[i].z; p[3] = r[i].w; }
}
__device__ __forceinline__ void cv_store(const CvU& u, const float* T, const int tid) {
#pragma unroll
    for (int j = 0; j < 4; ++j) { const int o = tid + j * 512; const int kc = (o & 7) * 8, n = o >> 3; const int gn = u.n0 + n;
        const int drow = u.mode == 0 ? gn : (256 * (gn >> 7) + (u.mode == 2 ? 128 : 0) + (gn & 127));
        const float* t = T + kc * 257 + n;
        u32x4 w; w.x = pk2(t[0], t[257]); w.y = pk2(t[2 * 257], t[3 * 257]); w.z = pk2(t[4 * 257], t[5 * 257]); w.w = pk2(t[6 * 257], t[7 * 257]);
        *(u32x4*)(u.dst + (size_t)drow * u.lddst + u.k0 + kc) = w; }
}
#define CV_RUN(LL, QSTART, QSTEP, QEND) do { \
                const float* wbr = PT(40) + (size_t)(LL) * 4 * BW * DM; const float* wout = PT(41) + (size_t)(LL) * DM * DM; \
                const float* wg = PT(43) + (size_t)(LL) * NEXP * DM * DEXP; const float* wu = PT(44) + (size_t)(LL) * NEXP * DM * DEXP; const float* wd = PT(45) + (size_t)(LL) * NEXP * DEXP * DM; \
                const float* wglu = PT(32) + (size_t)(LL) * BW * BW; const float* win = w_in + (size_t)(LL) * DM * IN_W; \
                const int cv_step = (QSTEP), cv_end = (QEND); \
                __syncthreads(); \
                int q = (QSTART); int buf = 0; CvU u; float4 r[8]; \
                if (q < cv_end) { CV_DECODE(q, u); cv_load(u, r, tid); } \
                while (q < cv_end) { \
                    float* T = sf + buf * (64 * 257); \
                    cv_stage(T, r, tid); \
                    __syncthreads(); \
                    const CvU cur = u; const int qn = q + cv_step; \
                    if (qn < cv_end) { CV_DECODE(qn, u); cv_load(u, r, tid); } \
                    cv_store(cur, T, tid); \
                    buf ^= 1; q = qn; \
                } \
                __syncthreads(); } while (0)
#define CV_DECODE(q_, u_) do { int qq_ = (q_); \
                    if (qq_ < n_win) { u_ = CvU{win, WIN, IN_W, IN_W, (qq_ / 55) * 64, (qq_ % 55) * 256, DM, 0}; } else { qq_ -= n_win; \
                    if (qq_ < n_br) { const int k = qq_ >> 6, r = qq_ & 63; u_ = CvU{wbr + (size_t)k * BW * DM, WBR + (size_t)k * DM * BW, DM, DM, (r >> 3) * 64, (r & 7) * 256, BW, 0}; } else { qq_ -= n_br; \
                    if (qq_ < n_out) { u_ = CvU{wout, WOUT, DM, DM, (qq_ >> 3) * 64, (qq_ & 7) * 256, DM, 0}; } else { qq_ -= n_out; \
                    if (qq_ < n_glu) { u_ = CvU{wglu, GLU, BW, BW, (qq_ >> 1) * 64, (qq_ & 1) * 256, BW, 0}; } else { qq_ -= n_glu; \
                    if (qq_ < n_gu) { const int e = qq_ / 384, r = qq_ % 384, up = r / 192, r2 = r % 192; u_ = CvU{(up ? wu : wg) + (size_t)e * DM * DEXP, WGU + (size_t)e * 2 * DEXP * DM, DEXP, DEXP, (r2 / 6) * 64, (r2 % 6) * 256, DM, 1 + up}; } else { qq_ -= n_gu; \
                    { const int e = qq_ / 192, r = qq_ % 192; u_ = CvU{wd + (size_t)e * DEXP * DM, WD + (size_t)e * DM * DEXP, DM, DM, (r >> 3) * 64, (r & 7) * 256, DEXP, 0}; } } } } } } } while (0)
template <int LAYER>
__device__ __forceinline__ void layer_body(const Args& a, const XcdBarrier& bar, const int lo, const int hi, const int bid, const int G, unsigned char* const shm, float* const sf, const float** const ptab) {
        constexpr int l = LAYER;
        constexpr int PB = 1 + 16 * l;
        const bool lastl = (l == 1);

        const int nPanels = lastl ? 64 : 68;
        const int M2 = nPanels * 256;

        if (IN(PB + 0)) for (int rep_ = 0; rep_ < (l == 0 ? PROBE_REPS(0) : 1); ++rep_) {
            PH_BEGIN
            {   const int n_win = 32 * 55, n_br = 4 * 64, n_out = 32 * 8, n_glu = 16, n_gu = 16 * 2 * 192, n_d = 16 * 192;
                const int n_grp1 = n_win + n_br + n_out + n_glu, total = n_grp1 + n_gu + n_d;
                const int q_lo = (l > 0 && G > 128) ? n_win : 0;
                CV_RUN(l, q_lo + bid, G, total);
            }
            for (int set = 0; set < (lastl ? 1 : 2); ++set) {
                const int L = set ? CTXL : SEQ; float* HR = HRAW + (set ? (size_t)SEQ * 2048 : 0);
                const float* w1 = PT(11) + l * 33 * 64; const float* b1 = PT(12) + l * 64; const float* fr1 = PT(13) + l * 64; const float* w2 = PT(14) + l * 64 * 64; const float* b2 = PT(15) + l * 64;
                const float* fr2 = PT(16) + l * 64; const float* w3 = PT(17) + l * 64 * 2048; const float* decay = PT(18) + l * 2048;
                float* feats = sf; float* h1 = sf + 16 * 33; float* h2 = h1 + 16 * 64;
                float nacc[4] = {0.f, 0.f, 0.f, 0.f};
                for (int base = bid; base < L; base += 16 * G) {
                    __syncthreads();
                    for (int e = tid; e < 16 * 33; e += NTHR) { const int ti = e / 33, fi = e % 33; int t = base + ti * G; if (t > L - 1) t = L - 1;
                        float v;
                        if (fi == 0) v = (float)t / (float)(L - 1);
                        else { const int j = (fi - 1) & 15; const double fr = 1e-4 + (double)j * ((15.0 - 1e-4) / 15.0); const double ang = (2.0 * 3.14159265358979323846 / (double)L) * (double)t * fr; v = fi <= 16 ? (float)cos(ang) : (float)(-sin(ang)); }
                        feats[e] = v; }
                    __syncthreads();
                    { const int j = tid & 63, ti = tid >> 6; float s0 = b1[j], s1 = s0;
_Pragma("unroll 3")
                      for (int i = 0; i < 33; ++i) { const float wv = w1[i * 64 + j]; s0 += feats[ti * 33 + i] * wv; s1 += feats[(ti + 8) * 33 + i] * wv; }
                      const float f1 = fr1[j]; h1[ti * 64 + j] = sinf(f1 * s0); h1[(ti + 8) * 64 + j] = sinf(f1 * s1); }
                    __syncthreads();
                    { const int j = tid & 63, ti = tid >> 6; float s0 = b2[j], s1 = s0;
_Pragma("unroll 4")
                      for (int i = 0; i < 64; ++i) { const float wv = w2[i * 64 + j]; s0 += h1[ti * 64 + i] * wv; s1 += h1[(ti + 8) * 64 + i] * wv; }
                      const float f2 = fr2[j]; h2[ti * 64 + j] = sinf(f2 * s0); h2[(ti + 8) * 64 + j] = sinf(f2 * s1); }
                    __syncthreads();
                    float acc[16][4];
#pragma unroll
                    for (int ti = 0; ti < 16; ++ti) { acc[ti][0] = 0.f; acc[ti][1] = 0.f; acc[ti][2] = 0.f; acc[ti][3] = 0.f; }
#pragma unroll 2
                    for (int i = 0; i < 64; ++i) { const float* wrow = w3 + (size_t)i * 2048 + tid; const float wa = wrow[0], wb = wrow[512], wc2 = wrow[1024], wd2 = wrow[1536];
#pragma unroll
                        for (int ti = 0; ti < 16; ++ti) { const float hv = h2[ti * 64 + i]; acc[ti][0] += hv * wa; acc[ti][1] += hv * wb; acc[ti][2] += hv * wc2; acc[ti][3] += hv * wd2; } }
                    float dk[4];
#pragma unroll
                    for (int k = 0; k < 4; ++k) dk[k] = fabsf(decay[tid + k * 512]);
#pragma unroll
                    for (int ti = 0; ti < 16; ++ti) { const int t = base + ti * G; if (t < L) { const float tn = (float)t / (float)(L - 1);
#pragma unroll
                        for (int k = 0; k < 4; ++k) { const float v = acc[ti][k] * expf(-tn * dk[k]); HR[(size_t)t * 2048 + tid + k * 512] = v; nacc[k] += fabsf(v); } } }
                }
                float* nrp = NORMP + ((size_t)(l * 2 + set) * 256 + bid) * 2048;
#pragma unroll
                for (int k = 0; k < 4; ++k) nrp[tid + k * 512] = nacc[k];
            }
            for (int idx = bid * NTHR + tid; idx < 4096; idx += G * NTHR) { const int n = idx & 63, g = (idx >> 6) & 31, dir = idx >> 11;
                const double are = (double)(PT(24) + l * 4096)[idx], aim = (double)(PT(25) + l * 4096)[idx]; const double lam = are < -1e-4 ? are : -1e-4; const double dt = exp((double)(PT(26) + l * 64)[dir * 32 + g]);
                const double ldre = lam * dt, ldim = aim * dt; LDT[idx] = make_double2(ldre, ldim);
                const double mag = exp(ldre); const double ar = mag * cos(ldim), ai = mag * sin(ldim);
                const double den = lam * lam + aim * aim; const double nr = ar - 1.0, ni = ai; const double fre = (nr * lam + ni * aim) / den, fim = (ni * lam - nr * aim) / den;
                const float* b_re = PT(27) + l * 32 * 64 * 16; const float* b_im = PT(28) + l * 32 * 64 * 16;
#pragma unroll 4
                for (int c = 0; c < 16; ++c) { const double br = (double)b_re[(g * 64 + n) * 16 + c], bi = (double)b_im[(g * 64 + n) * 16 + c]; BBT[idx * 16 + c] = make_float2((float)(fre * br - fim * bi), (float)(fre * bi + fim * br)); }
            }
            for (int e2 = bid * NTHR + tid; e2 < 4096 * 33; e2 += G * NTHR) { const int idx = e2 / 33, k = e2 - idx * 33; const int g = (idx >> 6) & 31, dir = idx >> 11;
                const double are = (double)(PT(24) + l * 4096)[idx], aim = (double)(PT(25) + l * 4096)[idx]; const double lam = are < -1e-4 ? are : -1e-4; const double dt = exp((double)(PT(26) + l * 64)[dir * 32 + g]);
                const double ldre = lam * dt, ldim = aim * dt; const double mk = exp(ldre * k); APW[e2] = make_float2((float)(mk * cos(ldim * k)), (float)(mk * sin(ldim * k))); }
            if (l == 0 && lo == 0) xcd_barrier(bar);
            for (int tok = bid * 8 + wave; tok < NTOK; tok += G * 8) {
                const int r = tok < NLAT ? tok / SEQ : 4; const float* xr = l == 0 ? (tok < NLAT ? x_in + (size_t)tok * DM : ctx_in + (size_t)(tok - NLAT) * DM) : XS + (size_t)tok * DM; const float* gn = norm_mix + l * DM;
                const float* sh = MODl + (size_t)(r * 6 + 0) * DM; const float* sc = MODl + (size_t)(r * 6 + 1) * DM;
                float4 v[8]; float ss = 0.f;
#pragma unroll
                for (int i = 0; i < 8; ++i) v[i] = *(const float4*)(xr + i * 256 + lane * 4);
                if (l > 0) {
                    moe_combine(v, tok, lane, INV, ROWGATE, YEXP, MOD + (size_t)((l - 1) * 5 + r) * 6 * DM + 5 * DM);
#pragma unroll
                    for (int i = 0; i < 8; ++i) *(float4*)(XS + (size_t)tok * DM + i * 256 + lane * 4) = v[i]; }
#pragma unroll
                for (int i = 0; i < 8; ++i) ss += v[i].x * v[i].x + v[i].y * v[i].y + v[i].z * v[i].z + v[i].w * v[i].w;
                ss = wave_sum(ss); const float rs = rsqrtf(ss * (1.0f / DM) + 1e-6f);
#pragma unroll
                for (int i = 0; i < 8; ++i) { const int d = i * 256 + lane * 4; const float4 g4 = *(const float4*)(gn + d), s4 = *(const float4*)(sc + d), h4 = *(const float4*)(sh + d);
                    v[i].x = v[i].x * rs * g4.x * (1.f + s4.x) + h4.x; v[i].y = v[i].y * rs * g4.y * (1.f + s4.y) + h4.y; v[i].z = v[i].z * rs * g4.z * (1.f + s4.z) + h4.z; v[i].w = v[i].w * rs * g4.w * (1.f + s4.w) + h4.w; }
#pragma unroll
                for (int i = 0; i < 8; ++i) { u32x2 w; w.x = pk2(v[i].x, v[i].y); w.y = pk2(v[i].z, v[i].w); *(u32x2*)(HB + (size_t)tok * DM + i * 256 + lane * 4) = w; }
            }
            SEAM(PB + 0);
        }

        if (IN(PB + 1)) for (int rep_ = 0; rep_ < PROBE_REPS(1); ++rep_) {
            PH_BEGIN
            for (int base = bid * 8; base < (lastl ? 1 : 2) * 1024; base += G * 8) {
                const int idx = base + (tid & 7), sl = tid >> 3; const int set = idx >> 10, oc = idx & 1023, o = oc >> 9, c = oc & 511;
                const float* pp = NORMP + (size_t)(l * 2 + set) * 256 * 2048 + o * 1024 + c + (size_t)(sl * 4) * 2048; float sacc = 0.f;
#pragma unroll
                for (int j = 0; j < 4; ++j) { const float p0 = pp[(size_t)j * 2048], p1 = pp[(size_t)j * 2048 + 512]; sacc += (sl * 4 + j < G) ? p0 + p1 : 0.f; }
                sf[sl * 8 + (tid & 7)] = sacc; __syncthreads();
                if (tid < 8) { float t = 0.f;
#pragma unroll 8
                    for (int q = 0; q < 64; ++q) t += sf[q * 8 + tid];
                    NORM[(size_t)(l * 2 + set) * 1024 + oc] = t; }
                __syncthreads(); }
            for (int idx = (G - 1 - bid) * NTHR + tid; idx < 32768; idx += G * NTHR) { const int c = idx & 15, lag = (idx >> 4) & 31, dir = (idx >> 9) & 1, g = idx >> 10;
                const float* c_re = PT(29) + l * 32 * 16 * 64 + (g * 16 + c) * 64; const float* c_im = PT(30) + l * 32 * 16 * 64 + (g * 16 + c) * 64;
                float acc[16];
#pragma unroll
                for (int j = 0; j < 16; ++j) acc[j] = 0.f;
#pragma unroll 2
                for (int n = 0; n < 64; ++n) { const int pi = (dir * 32 + g) * 64 + n; const float2 ap = APW[pi * 33 + lag]; const float cr = c_re[n], ci = c_im[n]; const float wr_ = cr * ap.x - ci * ap.y, wi_ = cr * ap.y + ci * ap.x;
                    const float4* bb = (const float4*)(BBT + pi * 16);
#pragma unroll
                    for (int j = 0; j < 8; ++j) { const float4 b2 = bb[j]; acc[2 * j] += wr_ * b2.x - wi_ * b2.y; acc[2 * j + 1] += wr_ * b2.z - wi_ * b2.w; } }
                float4* o = (float4*)(KTB + (size_t)idx * 16);
                o[0] = make_float4(acc[0], acc[1], acc[2], acc[3]); o[1] = make_float4(acc[4], acc[5], acc[6], acc[7]); o[2] = make_float4(acc[8], acc[9], acc[10], acc[11]); o[3] = make_float4(acc[12], acc[13], acc[14], acc[15]);
            }
            __syncthreads();
            pg8::Gemm g{HB, WIN, DM, DM, DM}; pg8::SchedStd S{68, 55, G, bid, DM, DM}; pg8::EpiWin E{P, LDP};
            pg8::gemm_phase(( LAS unsigned char*)shm, g, S, E);
#if defined(PROBE_BNOEPI)
            { __syncthreads(); pg8::EpiNone E0; pg8::gemm_phase((LAS unsigned char*)shm, g, S, E0); }
#endif
            SEAM(PB + 1);
        }

        if (IN(PB + 2)) for (int rep_ = 0; rep_ < PROBE_REPS(2); ++rep_) {
            PH_BEGIN
            const float* hcw = PT(9) + l * 3 * 1536; const float* hcb = PT(10) + l * 1536; const float* mcw = PT(20) + l * 3 * 1024; const float* mcb = PT(21) + l * 1024;
            const float* scw = PT(34) + l * 3 * 1024; const float* scb = PT(35) + l * 1024;
            for (int unit = bid; unit < 272 * 3; unit += G) { const int seg = unit / 3, kind = unit % 3; const bool lat = seg < 256; const size_t tok0 = lat ? (size_t)seg * 64 : (size_t)NLAT + (size_t)(seg - 256) * 64;
                if (kind < 2) { const int hf = kind;
                    const int c = tid * 2; const int col = (hf ? SSD_OFF + 512 : ML_OFF) + c; const float* w = hf ? scw : mcw; const float* bsp = hf ? scb : mcb; bf16_t* dst = (hf ? XBC : QKB) + tok0 * 1024 + c;
                    const float2 w0 = *(const float2*)(w + c), w1 = *(const float2*)(w + 1024 + c), w2 = *(const float2*)(w + 2048 + c), bb = *(const float2*)(bsp + c);
                    const float osc = (!hf && c >= 512) ? 0.08838834764831845f : 1.0f;
                    const bool hasPrev = !lat && ((tok0 - NLAT) & (CTXL - 1)) != 0, hasNext = !lat && (((tok0 - NLAT) + 63) & (CTXL - 1)) != CTXL - 1;
                    bf16_t* strip = nullptr;
                    if (!hf) { if (c >= 512) strip = KTG + ((size_t)seg * 512 + (c - 512)) * 64; }
                    else { if (c < 512) strip = XTG + ((size_t)seg * 512 + c) * 64; else if (c < 768) strip = BTG + ((size_t)seg * 256 + (c - 512)) * 64; }
                    const bf16_t* pp = P + tok0 * LDP + col;
                    unsigned raw[66];
#pragma unroll
                    for (int t = 0; t < 66; ++t) raw[t] = ((t == 0 && !hasPrev) || (t == 65 && !hasNext)) ? 0u : *(const unsigned*)(pp + (ptrdiff_t)(t - 1) * LDP);
#pragma unroll
                    for (int t8 = 0; t8 < 8; ++t8) { float v0[8], v1[8];
#pragma unroll
                        for (int tt = 0; tt < 8; ++tt) { const int t = t8 * 8 + tt; const unsigned p0 = raw[t], p1 = raw[t + 1], p2 = raw[t + 2];
                            float a0 = bb.x + w0.x * __uint_as_float(p0 << 16) + w1.x * __uint_as_float(p1 << 16) + w2.x * __uint_as_float(p2 << 16);
                            float a1 = bb.y + w0.y * __uint_as_float(p0 & 0xFFFF0000u) + w1.y * __uint_as_float(p1 & 0xFFFF0000u) + w2.y * __uint_as_float(p2 & 0xFFFF0000u);
                            a0 = siluf_(a0) * osc; a1 = siluf_(a1) * osc; v0[tt] = a0; v1[tt] = a1;
                            *(unsigned*)(dst + (size_t)t * 1024) = pk2(a0, a1); }
                        if (strip) { u32x4 s0, s1; s0.x = pk2(v0[0], v0[1]); s0.y = pk2(v0[2], v0[3]); s0.z = pk2(v0[4], v0[5]); s0.w = pk2(v0[6], v0[7]); s1.x = pk2(v1[0], v1[1]); s1.y = pk2(v1[2], v1[3]); s1.z = pk2(v1[4], v1[5]); s1.w = pk2(v1[6], v1[7]);
                            *(u32x4*)(strip + t8 * 8) = s0; *(u32x4*)(strip + 64 + t8 * 8) = s1; } }
                } else {
                    const int c = (tid & 255) * 2, th = tid >> 8; const bf16_t* pp = P + (tok0 + th * 32) * LDP + ML_OFF + 1024 + c; bf16_t* strip = VTG + ((size_t)seg * 512 + c) * 64 + th * 32;
                    unsigned rv[32];
#pragma unroll
                    for (int t = 0; t < 32; ++t) rv[t] = *(const unsigned*)(pp + (size_t)t * LDP);
#pragma unroll
                    for (int t8 = 0; t8 < 4; ++t8) { u32x4 s0, s1;
                        s0.x = (rv[t8 * 8 + 0] & 0xFFFFu) | (rv[t8 * 8 + 1] << 16); s0.y = (rv[t8 * 8 + 2] & 0xFFFFu) | (rv[t8 * 8 + 3] << 16); s0.z = (rv[t8 * 8 + 4] & 0xFFFFu) | (rv[t8 * 8 + 5] << 16); s0.w = (rv[t8 * 8 + 6] & 0xFFFFu) | (rv[t8 * 8 + 7] << 16);
                        s1.x = (rv[t8 * 8 + 0] >> 16) | (rv[t8 * 8 + 1] & 0xFFFF0000u); s1.y = (rv[t8 * 8 + 2] >> 16) | (rv[t8 * 8 + 3] & 0xFFFF0000u); s1.z = (rv[t8 * 8 + 4] >> 16) | (rv[t8 * 8 + 5] & 0xFFFF0000u); s1.w = (rv[t8 * 8 + 6] >> 16) | (rv[t8 * 8 + 7] & 0xFFFF0000u);
                        *(u32x4*)(strip + t8 * 8) = s0; *(u32x4*)(strip + 64 + t8 * 8) = s1; }
                }
            }
            if (!lastl) for (int tok = NLAT + bid; tok < NTOK; tok += G) {
                const int t = (tok - NLAT) & (CTXL - 1); const bool hasL = (t != 0), hasR = (t != CTXL - 1); const bf16_t* pr = P + (size_t)tok * LDP;
                const bf16_t* prL = hasL ? pr - LDP : pr; const bf16_t* prR = hasR ? pr + LDP : pr;
                unsigned xc[3], xl[3], xr[3];
#pragma unroll
                for (int j = 0; j < 3; ++j) { const int cc = tid + j * 512; xc[j] = pr[HY_OFF + cc]; xl[j] = prL[HY_OFF + cc]; xr[j] = prR[HY_OFF + cc]; }
#pragma unroll
                for (int j = 0; j < 3; ++j) { const int cc = tid + j * 512;
                    float acc = hcb[cc] + hcw[1536 + cc] * __uint_as_float(xc[j] << 16);
                    acc += hasL ? hcw[cc] * __uint_as_float(xl[j] << 16) : 0.f;
                    acc += hasR ? hcw[2 * 1536 + cc] * __uint_as_float(xr[j] << 16) : 0.f;
                    U[(size_t)tok * 1536 + cc] = acc; }
            }
            for (int idx0 = bid * NTHR + tid; idx0 < 16384 * 64; idx0 += 4 * G * NTHR) { u32x4 t4[4];
#pragma unroll
                for (int q = 0; q < 4; ++q) { const int idx = idx0 + q * G * NTHR; const int half = idx & 1, g = (idx >> 1) & 31, tok = idx >> 6;
                    if (idx < 16384 * 64) t4[q] = *(const u32x4*)(P + (size_t)tok * LDP + S5_OFF + g * 16 + half * 8); }
#pragma unroll
                for (int q = 0; q < 4; ++q) { const int idx = idx0 + q * G * NTHR; const int half = idx & 1, g = (idx >> 1) & 31, tok = idx >> 6;
                    if (idx < 16384 * 64) *(u32x4*)(S5A + ((size_t)g * 512 + (tok >> 5)) * 768 + (tok & 31) * 16 + half * 8) = t4[q]; } }
            for (int idx = bid * NTHR + tid; idx < 32 * 512 * 32 * 2; idx += G * NTHR) { const int half = idx & 1, sI = (idx >> 1) & 31, row = (idx >> 6) & 511, g = idx >> 15; const int t = row >> 4, c = row & 15; const int lag = t - sI;
                float v[8];
                if (lag > 0) { const float4* k4 = (const float4*)(KTB + ((size_t)((g * 2 + 0) * 32 + lag) * 16 + c) * 16 + half * 8); const float4 a0 = k4[0], a1 = k4[1]; v[0] = a0.x; v[1] = a0.y; v[2] = a0.z; v[3] = a0.w; v[4] = a1.x; v[5] = a1.y; v[6] = a1.z; v[7] = a1.w; }
                else if (lag < 0) { const float4* k4 = (const float4*)(KTB + ((size_t)((g * 2 + 1) * 32 - lag) * 16 + c) * 16 + half * 8); const float4 a0 = k4[0], a1 = k4[1]; v[0] = a0.x; v[1] = a0.y; v[2] = a0.z; v[3] = a0.w; v[4] = a1.x; v[5] = a1.y; v[6] = a1.z; v[7] = a1.w; }
                else { const float4* k4 = (const float4*)(KTB + ((size_t)((g * 2 + 0) * 32) * 16 + c) * 16 + half * 8); const float4* q4 = (const float4*)(KTB + ((size_t)((g * 2 + 1) * 32) * 16 + c) * 16 + half * 8); const float4 a0 = k4[0], a1 = k4[1], b0 = q4[0], b1 = q4[1];
                    v[0] = a0.x + b0.x; v[1] = a0.y + b0.y; v[2] = a0.z + b0.z; v[3] = a0.w + b0.w; v[4] = a1.x + b1.x; v[5] = a1.y + b1.y; v[6] = a1.z + b1.z; v[7] = a1.w + b1.w; }
                u32x4 w; w.x = pk2(v[0], v[1]); w.y = pk2(v[2], v[3]); w.z = pk2(v[4], v[5]); w.w = pk2(v[6], v[7]);
                *(u32x4*)(S5B + ((size_t)g * 512 + row) * 768 + sI * 16 + half * 8) = w; }
            for (int idx = bid * NTHR + tid; idx < 32 * 512 * 64; idx += G * NTHR) { const int n = idx & 63, row = (idx >> 6) & 511, g = idx >> 15; const int t = row >> 4, c = row & 15;
                const float cr = (PT(29) + l * 32 * 16 * 64)[(g * 16 + c) * 64 + n], ci = (PT(30) + l * 32 * 16 * 64)[(g * 16 + c) * 64 + n];
                const float2 af = APW[((0 * 32 + g) * 64 + n) * 33 + t + 1], ab = APW[((1 * 32 + g) * 64 + n) * 33 + 32 - t];
                bf16_t* d = S5B + ((size_t)g * 512 + row) * 768 + 512 + 2 * n;
                *(unsigned*)d = pk2(cr * af.x - ci * af.y, -(cr * af.y + ci * af.x)); *(unsigned*)(d + 128) = pk2(cr * ab.x - ci * ab.y, -(cr * ab.y + ci * ab.x)); }
            for (int idx = bid * NTHR + tid; idx < 32 * 2 * 64 * 32; idx += G * NTHR) { const int sI = idx & 31, n = (idx >> 5) & 63, dir = (idx >> 11) & 1, g = idx >> 12; const int pi = (dir * 32 + g) * 64 + n;
                const float2 pw = APW[pi * 33 + (dir ? sI : 31 - sI)]; const float4* bb = (const float4*)(BBT + pi * 16);
                float re[16], im[16];
#pragma unroll
                for (int j = 0; j < 8; ++j) { const float4 b2 = bb[j]; re[2 * j] = pw.x * b2.x - pw.y * b2.y; im[2 * j] = pw.x * b2.y + pw.y * b2.x; re[2 * j + 1] = pw.x * b2.z - pw.y * b2.w; im[2 * j + 1] = pw.x * b2.w + pw.y * b2.z; }
                bf16_t* d = S5P + ((size_t)g * 256 + dir * 128 + 2 * n) * 512 + sI * 16;
                u32x4 w0, w1; w0.x = pk2(re[0], re[1]); w0.y = pk2(re[2], re[3]); w0.z = pk2(re[4], re[5]); w0.w = pk2(re[6], re[7]); w1.x = pk2(re[8], re[9]); w1.y = pk2(re[10], re[11]); w1.z = pk2(re[12], re[13]); w1.w = pk2(re[14], re[15]);
                *(u32x4*)d = w0; *(u32x4*)(d + 8) = w1;
                w0.x = pk2(im[0], im[1]); w0.y = pk2(im[2], im[3]); w0.z = pk2(im[4], im[5]); w0.w = pk2(im[6], im[7]); w1.x = pk2(im[8], im[9]); w1.y = pk2(im[10], im[11]); w1.z = pk2(im[12], im[13]); w1.w = pk2(im[14], im[15]);
                *(u32x4*)(d + 512) = w0; *(u32x4*)(d + 520) = w1; }
            {   float* T0 = sf; float* T1 = sf + 64 * 65;
                const int NU = 4 * 64 * 24; const int cL = tid & 63, tL = tid >> 6, c = tid >> 3, tq = (tid & 7) * 8;
                for (int unit = bid; unit < NU; unit += 2 * G) { const bool has2 = unit + G < NU; const int unit2 = has2 ? unit + G : unit;
                    const int ba = unit / (64 * 24), ra = (unit / 24) % 64, c0a = (unit % 24) * 64; const size_t toka = (size_t)ba * SEQ + ra * 64;
                    const int bb_ = unit2 / (64 * 24), rb = (unit2 / 24) % 64, c0b = (unit2 % 24) * 64; const size_t tokb = (size_t)bb_ * SEQ + rb * 64;
                    unsigned pa[8], pb[8];
#pragma unroll
                    for (int i = 0; i < 8; ++i) { pa[i] = P[(toka + tL + 8 * i) * LDP + HY_OFF + c0a + cL]; pb[i] = P[(tokb + tL + 8 * i) * LDP + HY_OFF + c0b + cL]; }
                    const int cca = c0a + c, ccb = c0b + c;
                    const float w0a = hcw[cca], w1a = hcw[1536 + cca], w2a = hcw[3072 + cca], bia = hcb[cca], w0b = hcw[ccb], w1b = hcw[1536 + ccb], w2b = hcw[3072 + ccb], bib = hcb[ccb];
                    __syncthreads();
#pragma unroll
                    for (int i = 0; i < 8; ++i) { T0[(tL + 8 * i) * 65 + cL] = __uint_as_float(pa[i] << 16); T1[(tL + 8 * i) * 65 + cL] = __uint_as_float(pb[i] << 16); }
                    __syncthreads();
                    {   float o8[8];
#pragma unroll
                        for (int i = 0; i < 8; ++i) { const int t = tq + i; float acc = bia + w1a * T0[t * 65 + c]; if (t > 0) acc += w0a * T0[(t - 1) * 65 + c]; if (t < 63) acc += w2a * T0[(t + 1) * 65 + c]; o8[i] = acc; }
                        u32x4 wv; wv.x = pk2(o8[0], o8[1]); wv.y = pk2(o8[2], o8[3]); wv.z = pk2(o8[4], o8[5]); wv.w = pk2(o8[6], o8[7]);
                        *(u32x4*)(UT + ((size_t)ba * 1536 + cca) * SEQ + ra * 64 + tq) = wv; }
                    if (has2) { float o8[8];
#pragma unroll
                        for (int i = 0; i < 8; ++i) { const int t = tq + i; float acc = bib + w1b * T1[t * 65 + c]; if (t > 0) acc += w0b * T1[(t - 1) * 65 + c]; if (t < 63) acc += w2b * T1[(t + 1) * 65 + c]; o8[i] = acc; }
                        u32x4 wv; wv.x = pk2(o8[0], o8[1]); wv.y = pk2(o8[2], o8[3]); wv.z = pk2(o8[4], o8[5]); wv.w = pk2(o8[6], o8[7]);
                        *(u32x4*)(UT + ((size_t)bb_ * 1536 + ccb) * SEQ + rb * 64 + tq) = wv; }
                } }
            if (!lastl) {
                const int L = CTXL; const float* HR = HRAW + (size_t)SEQ * 2048; float* K2 = K2C; const float* nrm = NORM + (size_t)(l * 2 + 1) * 1024;
                const size_t total = (size_t)(2 * L - 1) * 1024;
                for (size_t i = (size_t)bid * NTHR + tid; i < total; i += (size_t)G * NTHR) { const int j = (int)(i >> 10), oc = (int)(i & 1023), o = oc >> 9, c = oc & 511; const int lag = j - (L - 1);
                    const float v = lag >= 0 ? HR[(size_t)lag * 2048 + o * 1024 + c] : HR[(size_t)(-lag) * 2048 + o * 1024 + 512 + c];
                    K2[((size_t)j * 2 + o) * 512 + c] = v / nrm[oc]; }
            }
            {   __syncthreads(); fft_twiddles((float2*)(shm + FFT_X_BYTES), tid);
                for (int pr = bid; pr < 512; pr += G) hyena_spec_item(pr, HRAW, NORM + (size_t)(l * 2 + 0) * 1024, HSPEC, shm, tid);
                __syncthreads(); }
            SEAM(PB + 2);
        }

        if (IN(PB + 3)) for (int rep_ = 0; rep_ < PROBE_REPS(3); ++rep_) {
            PH_BEGIN
            if (rep_ > 0) { if (bid == 0 && tid == 0) __hip_atomic_store(QCTR + l * 64, 0, __ATOMIC_RELAXED, __HIP_MEMORY_SCOPE_AGENT); xcd_barrier(bar); }
            if (bid < 64) {
                mlstm_state_pass(bid >> 1, bid & 1, P, KTG, VTG, PT(22) + l * 16, CST, NST, MST, shm, tid);
            } else if (bid < 128) {
                { const int ch = bid - 64; const int dir_ = ch & 1, h_ = (ch >> 1) & 7; ssd_state_pass(ch, P, BTG, XTG, -expf(PT(37)[l * 16 + dir_ * 8 + h_]), PT(36)[l * 16 + dir_ * 8 + h_], SSTB, shm, tid); }
            } else if (bid < 160) {
                const int widx = (bid - 128) * 8 + wave; const int dir = widx & 1, g = (widx >> 1) & 31, b = widx >> 6; const int n = lane;
                float2* xb = (float2*)(shm + (size_t)wave * 16640); float2* ctab = xb + 16 * 65;
                const float* a_re = PT(24) + l * 2 * 32 * 64; const float* a_im = PT(25) + l * 2 * 32 * 64; const float* log_dt = PT(26) + l * 64;
                const float* b_re = PT(27) + l * 32 * 64 * 16; const float* b_im = PT(28) + l * 32 * 64 * 16; const float* c_re = PT(29) + l * 32 * 16 * 64; const float* c_im = PT(30) + l * 32 * 16 * 64;
#pragma unroll
                for (int c = 0; c < 16; ++c) ctab[c * 65 + lane] = make_float2(c_re[(g * 16 + c) * 64 + lane], c_im[(g * 16 + c) * 64 + lane]);
                float abr, abi, bbr[16], bbi[16];
                {   const double are = (double)a_re[(dir * 32 + g) * 64 + n], aim = (double)a_im[(dir * 32 + g) * 64 + n];
                    const double lam = are < -1e-4 ? are : -1e-4; const double dt = exp((double)log_dt[dir * 32 + g]);
                    const double mag = exp(lam * dt); const double ar = mag * cos(aim * dt), ai = mag * sin(aim * dt);
                    const double den = lam * lam + aim * aim; const double nr = ar - 1.0, ni = ai;
                    const double fre = (nr * lam + ni * aim) / den, fim = (ni * lam - nr * aim) / den;
                    abr = (float)ar; abi = (float)ai;
#pragma unroll
                    for (int c = 0; c < 16; ++c) { const double br = (double)b_re[(g * 64 + n) * 16 + c], bi = (double)b_im[(g * 64 + n) * 16 + c]; bbr[c] = (float)(fre * br - fim * bi); bbi[c] = (float)(fre * bi + fim * br); }
                }
                float xr = 0.f, xi = 0.f; float* Sout = (dir ? SB : SF) - (size_t)NLAT * BW;
                const int s = lane >> 2, cg = lane & 3;
                for (int i0 = 0; i0 < CTXL; i0 += 16) {
#pragma unroll 4
                    for (int ss = 0; ss < 16; ++ss) {
                        const size_t tok = (size_t)step_tok(b, dir, i0 + ss);
                        const u32x4* up = (const u32x4*)(P + tok * LDP + S5_OFF + g * 16);
                        float t0[8], t1[8]; unpack8(up[0], t0); unpack8(up[1], t1);
                        float bur = 0.f, bui = 0.f;
#pragma unroll
                        for (int c = 0; c < 8; ++c) { bur += t0[c] * bbr[c] + t1[c] * bbr[8 + c]; bui += t0[c] * bbi[c] + t1[c] * bbi[8 + c]; }
                        const float nxr = abr * xr - abi * xi + bur, nxi = abr * xi + abi * xr + bui; xr = nxr; xi = nxi;
                        xb[ss * 65 + lane] = make_float2(xr, xi);
                    }
                    asm volatile("s_waitcnt lgkmcnt(0)" ::: "memory");
                    float y0 = 0.f, y1 = 0.f, y2 = 0.f, y3 = 0.f;
                    for (int nn2 = 0; nn2 < 64; ++nn2) { const float2 xv = xb[s * 65 + nn2];
                        const float2 c0 = ctab[(cg * 4 + 0) * 65 + nn2], c1 = ctab[(cg * 4 + 1) * 65 + nn2], c2 = ctab[(cg * 4 + 2) * 65 + nn2], c3 = ctab[(cg * 4 + 3) * 65 + nn2];
                        y0 += xv.x * c0.x - xv.y * c0.y; y1 += xv.x * c1.x - xv.y * c1.y; y2 += xv.x * c2.x - xv.y * c2.y; y3 += xv.x * c3.x - xv.y * c3.y; }
                    const size_t toks = (size_t)step_tok(b, dir, i0 + s);
                    *(float4*)(Sout + toks * BW + g * 16 + cg * 4) = make_float4(y0, y1, y2, y3);
                    asm volatile("s_waitcnt lgkmcnt(0)" ::: "memory");
                }
                XCTX[((b * 32 + g) * 2 + dir) * 64 + n] = make_float2(xr, xi);
            } else {
                if (bid < 224) {
                    pg8::Gemm gg_{S5A, S5P, 768, 512, 512}; pg8::SchedS5a S_{bid - 160}; pg8::EpiXloc E_{XLOC};
                    pg8::gemm_phase((LAS unsigned char*)shm, gg_, S_, E_);
                    __syncthreads();
                }
                const int nhb = G - 160, hb = bid - 160; const float* bias = PT(19) + l * 1024; const int c = tid;
                const int nitems = lastl ? 0 : 4 * (CTXL / 8);
                for (int it = hb; it < nitems; it += nhb) {
                    int L, tokbase, b, t0; const float* K2;
                    { const int q = it; L = CTXL; tokbase = NLAT; b = q / (CTXL / 8); t0 = (q % (CTXL / 8)) * 8; K2 = K2C; }
                    const float* zb = U + (size_t)(tokbase + b * L) * 1536 + c;
                    float acc[8];
#pragma unroll
                    for (int i = 0; i < 8; ++i) acc[i] = 0.f;
                    const int base = t0 + L - 1;
                    for (int s = 0; s < L; s += 8) {
                        float k[15];
#pragma unroll
                        for (int mm = 0; mm < 15; ++mm) k[mm] = K2[((size_t)(base - s - 7 + mm) * 2 + 0) * 512 + c];
#pragma unroll
                        for (int ds = 0; ds < 8; ++ds) { const float z = zb[(size_t)(s + ds) * 1536];
#pragma unroll
                            for (int i = 0; i < 8; ++i) acc[i] += k[i - ds + 7] * z; }
                    }
#pragma unroll
                    for (int i = 0; i < 8; ++i) { const size_t tok = (size_t)(tokbase + b * L + t0 + i); const float zt = U[tok * 1536 + c]; Z[tok * BW + c] = (acc[i] + bias[c] * zt) * U[tok * 1536 + 512 + c]; }
                }
            }
            {   __syncthreads(); fft_twiddles((float2*)(shm + FFT_X_BYTES), tid);
                int* qslot = (int*)(shm + FFT_X_BYTES + 65536);
                for (;;) { __syncthreads(); if (tid == 0) *qslot = atomicAdd(QCTR + l * 64, 1); __syncthreads(); const int it = *qslot; if (it >= 1024) break;
                    hyena_fft_item(it, UT, HSPEC, PT(19) + l * 1024, YT, shm, tid); }
            }
            SEAM(PB + 3);
        }

        if (IN(PB + 4)) for (int rep_ = 0; rep_ < PROBE_REPS(4); ++rep_) {
            PH_BEGIN
            if (rep_ > 0) { if (bid == 0 && tid == 0) __hip_atomic_store(QCTR + l * 64 + 32, 0, __ATOMIC_RELAXED, __HIP_MEMORY_SCOPE_AGENT); xcd_barrier(bar); }
            if (bid >= G - 32) for (int idx = (bid - (G - 32)) * NTHR + tid; idx < 16384; idx += 32 * NTHR) { const int n = idx & 63, dir = (idx >> 6) & 1, b = (idx >> 7) & 3, g = idx >> 9;
                const float2 a32 = APW[((dir * 32 + g) * 64 + n) * 33 + 32]; float2 X = XCTX[((b * 32 + g) * 2 + dir) * 64 + n];
                const float* __restrict__ xl = XLOC + ((size_t)g * 512 + b * 128) * 256 + dir * 128 + 2 * n; bf16_t* __restrict__ dst = S5A + ((size_t)g * 512 + b * 128) * 768 + 512 + dir * 128 + 2 * n;
#pragma unroll 1
                for (int j0 = 0; j0 < 128; j0 += 16) { float2 xv[16];
#pragma unroll
                    for (int q = 0; q < 16; ++q) { const int j = dir ? 127 - (j0 + q) : j0 + q; xv[q] = *(const float2*)(xl + (size_t)j * 256); }
#pragma unroll
                    for (int q = 0; q < 16; ++q) { const int j = dir ? 127 - (j0 + q) : j0 + q;
                        *(unsigned*)(dst + (size_t)j * 768) = pk2(X.x, X.y);
                        const float nx = a32.x * X.x - a32.y * X.y + xv[q].x, ny = a32.x * X.y + a32.y * X.x + xv[q].y; X.x = nx; X.y = ny; } } }
            {   int* qslot = (int*)(shm + 102400);
                __syncthreads(); if (tid == 0) *qslot = atomicAdd(QCTR + l * 64 + 32, 1); __syncthreads();
                for (;;) { const int it = *qslot; if (it >= 32 * 68 + 64 * 68) break;
                    int nxt_ = 0; if (tid == 0) nxt_ = atomicAdd(QCTR + l * 64 + 32, 1);
                    if (it < 32 * 68) { const int chain = it / 68, c = it % 68; mlstm_out_item(chain, c, P, QKB, VTG, PT(22) + l * 16, CST, NST, MST, (chain & 1) ? HBk : HF, shm, tid); }
                    else { const int i2 = it - 32 * 68; const int chain = i2 / 68, c = i2 % 68; const int dir_ = chain & 1, h_ = (chain >> 1) & 7;
                        ssd_out_item(chain, c, P, XBC, XTG, -expf(PT(37)[l * 16 + dir_ * 8 + h_]), PT(36)[l * 16 + dir_ * 8 + h_], SSTB, dir_ ? YB : YF, shm, tid); }
                    __syncthreads(); if (tid == 0) *qslot = nxt_; __syncthreads(); }
            }
            __syncthreads();
            {   const float* bias = PT(19) + l * 1024 + 512; const int c = tid;
                const int nitems = lastl ? 0 : 4 * (CTXL / 8);
                for (int it = bid; it < nitems; it += G) {
                    int L, tokbase, b, t0; const float* K2;
                    { const int q = it; L = CTXL; tokbase = NLAT; b = q / (CTXL / 8); t0 = (q % (CTXL / 8)) * 8; K2 = K2C; }
                    const float* zb = Z + (size_t)(tokbase + b * L) * BW + c;
                    float acc[8];
#pragma unroll
                    for (int i = 0; i < 8; ++i) acc[i] = 0.f;
                    const int base = t0 + L - 1;
                    for (int s = 0; s < L; s += 8) {
                        float k[15];
#pragma unroll
                        for (int mm = 0; mm < 15; ++mm) k[mm] = K2[((size_t)(base - s - 7 + mm) * 2 + 1) * 512 + c];
#pragma unroll
                        for (int ds = 0; ds < 8; ++ds) { const float z = zb[(size_t)(s + ds) * BW];
#pragma unroll
                            for (int i = 0; i < 8; ++i) acc[i] += k[i - ds + 7] * z; }
                    }
#pragma unroll
                    for (int i = 0; i < 8; ++i) { const size_t tok = (size_t)(tokbase + b * L + t0 + i); const float zt = Z[tok * BW + c]; Y4[tok * DM + c] = f2bf((acc[i] + bias[c] * zt) * U[tok * 1536 + 1024 + c]); }
                }
            }
            SEAM(PB + 4);
        }

        if (IN(PB + 5)) for (int rep_ = 0; rep_ < PROBE_REPS(5); ++rep_) {
            PH_BEGIN
            const float* ml_norm = PT(23) + l * BW; const float* ssd_d = PT(38) + l * 8; const float* ssd_norm = PT(39) + l * BW; const float* s5_d = PT(31) + l * BW;
            if (bid < 128) {
                pg8::Gemm gg_{S5A, S5B, 768, 768, 768}; pg8::SchedS5b S_{bid}; pg8::EpiS5Out E_{P, s5_d, GG};
                pg8::gemm_phase((LAS unsigned char*)shm, gg_, S_, E_);
                __syncthreads();
            }
            for (int tok = bid * 8 + wave; tok < NTOK; tok += G * 8) {
                const int c0 = lane * 8; const bf16_t* pr = P + (size_t)tok * LDP; const size_t o5 = (size_t)tok * BW + c0;
                float hm[8], ys[8];
                const u32x4 ooq = *(const u32x4*)(pr + ML_OFF + 1536 + c0);
                const float4 g0 = *(const float4*)(ml_norm + c0), g1 = *(const float4*)(ml_norm + c0 + 4), n0 = *(const float4*)(ssd_norm + c0), n1 = *(const float4*)(ssd_norm + c0 + 4);
                { float fa[8], fb[8]; unpack8(*(const u32x4*)(HF + o5), fa); unpack8(*(const u32x4*)(HBk + o5), fb);
#pragma unroll
                  for (int j = 0; j < 8; ++j) hm[j] = fa[j] + fb[j]; }
                { float ya[8], yb[8]; unpack8(*(const u32x4*)(YF + o5), ya); unpack8(*(const u32x4*)(YB + o5), yb);
                  float xx[8], zz[8]; unpack8(*(const u32x4*)(XBC + (size_t)tok * 1024 + c0), xx); unpack8(*(const u32x4*)(pr + SSD_OFF + c0), zz); const float dsk = ssd_d[c0 >> 6];
#pragma unroll
                  for (int j = 0; j < 8; ++j) ys[j] = ya[j] + yb[j];
#pragma unroll
                  for (int j = 0; j < 8; ++j) ys[j] = (ys[j] + dsk * xx[j]) * siluf_(zz[j]); }
                float s1 = 0.f, s2 = 0.f;
#pragma unroll
                for (int j = 0; j < 8; ++j) { s1 += hm[j] * hm[j]; s2 += ys[j] * ys[j]; }
                s1 += __shfl_xor(s1, 1); s1 += __shfl_xor(s1, 2); s1 += __shfl_xor(s1, 4); s1 += __shfl_xor(s1, 8);
                s2 = wave_sum(s2);
                const float r1 = rsqrtf(s1 * (1.0f / 128.0f) + 1e-6f), r2 = rsqrtf(s2 * (1.0f / BW) + 1e-6f);
                float oo[8]; unpack8(ooq, oo);
                const float gm[8] = {g0.x, g0.y, g0.z, g0.w, g1.x, g1.y, g1.z, g1.w}, gs[8] = {n0.x, n0.y, n0.z, n0.w, n1.x, n1.y, n1.z, n1.w};
                u32x4 w;
                w.x = pk2(hm[0] * r1 * gm[0] * sigmoidf_(oo[0]), hm[1] * r1 * gm[1] * sigmoidf_(oo[1])); w.y = pk2(hm[2] * r1 * gm[2] * sigmoidf_(oo[2]), hm[3] * r1 * gm[3] * sigmoidf_(oo[3]));
                w.z = pk2(hm[4] * r1 * gm[4] * sigmoidf_(oo[4]), hm[5] * r1 * gm[5] * sigmoidf_(oo[5])); w.w = pk2(hm[6] * r1 * gm[6] * sigmoidf_(oo[6]), hm[7] * r1 * gm[7] * sigmoidf_(oo[7]));
                *(u32x4*)(Y4 + (size_t)tok * DM + 512 + c0) = w;
                w.x = pk2(ys[0] * r2 * gs[0], ys[1] * r2 * gs[1]); w.y = pk2(ys[2] * r2 * gs[2], ys[3] * r2 * gs[3]); w.z = pk2(ys[4] * r2 * gs[4], ys[5] * r2 * gs[5]); w.w = pk2(ys[6] * r2 * gs[6], ys[7] * r2 * gs[7]);
                *(u32x4*)(Y4 + (size_t)tok * DM + 1536 + c0) = w;
                if (tok >= NLAT) { const size_t oc = (size_t)(tok - NLAT) * BW + c0; float uu[8]; unpack8(*(const u32x4*)(pr + S5_OFF + c0), uu);
                    const float4 a0 = *(const float4*)(SF + oc), a1 = *(const float4*)(SF + oc + 4), b0 = *(const float4*)(SB + oc), b1 = *(const float4*)(SB + oc + 4), d0 = *(const float4*)(s5_d + c0), d1 = *(const float4*)(s5_d + c0 + 4);
                    float y[8] = {a0.x + b0.x + d0.x * uu[0], a0.y + b0.y + d0.y * uu[1], a0.z + b0.z + d0.z * uu[2], a0.w + b0.w + d0.w * uu[3], a1.x + b1.x + d1.x * uu[4], a1.y + b1.y + d1.y * uu[5], a1.z + b1.z + d1.z * uu[6], a1.w + b1.w + d1.w * uu[7]};
#pragma unroll
                    for (int j = 0; j < 8; ++j) y[j] = 0.5f * y[j] * (1.0f + tanhf(0.7978845608028654f * (y[j] + 0.044715f * y[j] * y[j] * y[j])));
                    w.x = pk2(y[0], y[1]); w.y = pk2(y[2], y[3]); w.z = pk2(y[4], y[5]); w.w = pk2(y[6], y[7]);
                    *(u32x4*)(GG + (size_t)tok * BW + c0) = w; }
            }
            __syncthreads();
            {   float* T = sf;
                for (int unit = (G > 128 ? bid - 128 : bid); unit >= 0 && unit < 4 * 64 * 8; unit += (G > 128 ? G - 128 : G)) { const int b = unit / 512, t0 = ((unit >> 3) & 63) * 64, c0 = (unit & 7) * 64;
                    __syncthreads();
#pragma unroll
                    for (int i = 0; i < 8; ++i) { const int t = tid & 63, c = (tid >> 6) + 8 * i; T[c * 65 + t] = YT[((size_t)b * 512 + c0 + c) * SEQ + t0 + t]; }
                    __syncthreads();
                    const int t = tid >> 3, cq = (tid & 7) * 8;
                    u32x4 w; w.x = pk2(T[(cq + 0) * 65 + t], T[(cq + 1) * 65 + t]); w.y = pk2(T[(cq + 2) * 65 + t], T[(cq + 3) * 65 + t]); w.z = pk2(T[(cq + 4) * 65 + t], T[(cq + 5) * 65 + t]); w.w = pk2(T[(cq + 6) * 65 + t], T[(cq + 7) * 65 + t]);
                    *(u32x4*)(Y4 + ((size_t)b * SEQ + t0 + t) * DM + c0 + cq) = w;
                } }
            SEAM(PB + 5);
        }

        if (IN(PB + 6)) for (int rep_ = 0; rep_ < PROBE_REPS(6); ++rep_) {
            PH_BEGIN
            pg8::Gemm g{GG, GLU, BW, BW, BW}; pg8::SchedStd S{68, 2, G, bid, BW, BW}; pg8::EpiGlu E{GG, PT(33) + l * BW, Y4};
            pg8::gemm_phase((LAS unsigned char*)shm, g, S, E);
            SEAM(PB + 6);
        }
        if (IN(PB + 7)) for (int rep_ = 0; rep_ < PROBE_REPS(7); ++rep_) {
            PH_BEGIN
            pg8::Gemm g{Y4, WBR, DM, BW, BW}; pg8::SchedBranch S{64, 8, G, bid}; pg8::EpiBranch E{P, ACCb};
            pg8::gemm_phase((LAS unsigned char*)shm, g, S, E);
            if (!lastl) { __syncthreads(); pg8::SchedTail S2{G, bid}; pg8::EpiPart E2{P, (float*)HSPEC}; pg8::gemm_phase((LAS unsigned char*)shm, g, S2, E2); }
            SEAM(PB + 7);
        }
        if (IN(PB + 8)) for (int rep_ = 0; rep_ < PROBE_REPS(8); ++rep_) {
            PH_BEGIN
            if (!lastl) {
                const float* PART = (const float*)HSPEC;
                for (int idx = bid * NTHR + tid; idx < (NTOK - NLAT) * DM / 8; idx += G * NTHR) { const size_t o = (size_t)idx * 8; f32x4 p[4][2];
#pragma unroll
                    for (int k = 0; k < 4; ++k) { p[k][0] = *(const f32x4*)(PART + (size_t)k * (NTOK - NLAT) * DM + o); p[k][1] = *(const f32x4*)(PART + (size_t)k * (NTOK - NLAT) * DM + o + 4); }
                    const f32x4 s0 = ((p[0][0] + p[1][0]) + p[2][0]) + p[3][0], s1 = ((p[0][1] + p[1][1]) + p[2][1]) + p[3][1];
                    u32x4 w; w.x = pk2(s0[0], s0[1]); w.y = pk2(s0[2], s0[3]); w.z = pk2(s1[0], s1[1]); w.w = pk2(s1[2], s1[3]);
                    *(u32x4*)(ACCb + (size_t)NLAT * DM + o) = w; }
                xcd_barrier(bar);
            }
            pg8::Gemm g{ACCb, WOUT, DM, DM, DM}; pg8::SchedStd S{64, 8, G, bid, DM, DM}; pg8::EpiResid E{XS, l == 0 ? x_in : (const float*)XS, l == 0 ? ctx_in - (size_t)NLAT * DM : (const float*)XS, MODl, 2};
            pg8::gemm_phase((LAS unsigned char*)shm, g, S, E);
            if (!lastl) { __syncthreads(); pg8::Gemm g2{ACCb, WOUT, DM, DM, 512}; pg8::SchedTailK S2{G, bid}; pg8::EpiPartK E2{(float*)HSPEC + (size_t)4 * (NTOK - NLAT) * DM}; pg8::gemm_phase((LAS unsigned char*)shm, g2, S2, E2); }
            SEAM(PB + 8);
        }
        if (IN(PB + 9)) for (int rep_ = 0; rep_ < PROBE_REPS(9); ++rep_) {
            PH_BEGIN
            if (!lastl) {
                const float* PART = (const float*)HSPEC + (size_t)4 * (NTOK - NLAT) * DM; const float* mg = MODl + (size_t)(4 * 6 + 2) * DM;
                const float* src = l == 0 ? ctx_in : (const float*)XS + (size_t)NLAT * DM;
                for (int idx = bid * NTHR + tid; idx < (NTOK - NLAT) * DM / 4; idx += G * NTHR) { const size_t o = (size_t)idx * 4; const int col = (int)(o & (DM - 1));
                    const f32x4 p0 = *(const f32x4*)(PART + o), p1 = *(const f32x4*)(PART + (size_t)(NTOK - NLAT) * DM + o), p2 = *(const f32x4*)(PART + (size_t)2 * (NTOK - NLAT) * DM + o), p3 = *(const f32x4*)(PART + (size_t)3 * (NTOK - NLAT) * DM + o);
                    const f32x4 sv = *(const f32x4*)(src + o), gm = *(const f32x4*)(mg + col);
                    *(f32x4*)(XS + (size_t)NLAT * DM + o) = sv + gm * (((p0 + p1) + p2) + p3); }
                xcd_barrier(bar);
            }
            for (int i = bid * NTHR + tid; i < NEXP * MOE_PAD; i += G * NTHR) ROWTOK[i] = -1;
            for (int i = bid * NTHR + tid; i < NTOK * 16; i += G * NTHR) INV[i] = -1;
            const float* wr = PT(42) + (size_t)l * DM * 16; const float* gn = norm_ffn + l * DM;
            float* wl = sf;
            __syncthreads();
#pragma unroll 1
            for (int q0 = 0; q0 < 16; q0 += 4) {
                const float4 a0 = ((const float4*)wr)[(q0 + 0) * 512 + tid], a1 = ((const float4*)wr)[(q0 + 1) * 512 + tid], a2 = ((const float4*)wr)[(q0 + 2) * 512 + tid], a3 = ((const float4*)wr)[(q0 + 3) * 512 + tid];
                { const int f4 = (q0 + 0) * 512 + tid; *(float4*)(wl + (size_t)(f4 >> 4) * 68 + (f4 & 15) * 4) = a0; }
                { const int f4 = (q0 + 1) * 512 + tid; *(float4*)(wl + (size_t)(f4 >> 4) * 68 + (f4 & 15) * 4) = a1; }
                { const int f4 = (q0 + 2) * 512 + tid; *(float4*)(wl + (size_t)(f4 >> 4) * 68 + (f4 & 15) * 4) = a2; }
                { const int f4 = (q0 + 3) * 512 + tid; *(float4*)(wl + (size_t)(f4 >> 4) * 68 + (f4 & 15) * 4) = a3; } }
            __syncthreads();
            for (int tok0 = (bid * 8 + wave) * 4; tok0 < M2; tok0 += G * 32) {
                const int r = tok0 < NLAT ? tok0 / SEQ : 4; const float* xr = XS + (size_t)tok0 * DM;
                const float* sh = MODl + (size_t)(r * 6 + 3) * DM; const float* sc = MODl + (size_t)(r * 6 + 4) * DM;
                float rs[4];
#pragma unroll
                for (int tk = 0; tk < 4; ++tk) { float ss = 0.f;
#pragma unroll 4
                    for (int i = 0; i < 8; ++i) { const float4 t4 = *(const float4*)(xr + (size_t)tk * DM + i * 256 + lane * 4); ss += t4.x * t4.x + t4.y * t4.y + t4.z * t4.z + t4.w * t4.w; }
                    ss = wave_sum(ss); rs[tk] = rsqrtf(ss * (1.0f / DM) + 1e-6f); }
                float lg[4][16];
#pragma unroll
                for (int tk = 0; tk < 4; ++tk)
#pragma unroll
                    for (int e = 0; e < 16; ++e) lg[tk][e] = 0.f;
#pragma unroll 1
                for (int i = 0; i < 8; ++i) { const int d = i * 256 + lane * 4;
                    const float4 g4 = *(const float4*)(gn + d), s4 = *(const float4*)(sc + d), h4 = *(const float4*)(sh + d);
                    float4 xq[4], ww[16];
#pragma unroll
                    for (int tk = 0; tk < 4; ++tk) xq[tk] = *(const float4*)(xr + (size_t)tk * DM + d);
                    const float4* wq = (const float4*)(wl + (size_t)(i * 64 + lane) * 68);
#pragma unroll
                    for (int q = 0; q < 16; ++q) ww[q] = wq[q];
                    float hv[4][4];
#pragma unroll
                    for (int tk = 0; tk < 4; ++tk) { const float4 xv = xq[tk]; const float rr = rs[tk];
                        hv[tk][0] = xv.x * rr * g4.x * (1.f + s4.x) + h4.x; hv[tk][1] = xv.y * rr * g4.y * (1.f + s4.y) + h4.y; hv[tk][2] = xv.z * rr * g4.z * (1.f + s4.z) + h4.z; hv[tk][3] = xv.w * rr * g4.w * (1.f + s4.w) + h4.w;
                        u32x2 w; w.x = pk2(hv[tk][0], hv[tk][1]); w.y = pk2(hv[tk][2], hv[tk][3]); *(u32x2*)(HB + (size_t)(tok0 + tk) * DM + d) = w; }
#pragma unroll
                    for (int q = 0; q < 4; ++q) { const float4 w0 = ww[q * 4 + 0], w1 = ww[q * 4 + 1], w2 = ww[q * 4 + 2], w3 = ww[q * 4 + 3];
#pragma unroll
                        for (int tk = 0; tk < 4; ++tk) { const float hq = hv[tk][q];
                            lg[tk][0] += hq * w0.x; lg[tk][1] += hq * w0.y; lg[tk][2] += hq * w0.z; lg[tk][3] += hq * w0.w; lg[tk][4] += hq * w1.x; lg[tk][5] += hq * w1.y; lg[tk][6] += hq * w1.z; lg[tk][7] += hq * w1.w;
                            lg[tk][8] += hq * w2.x; lg[tk][9] += hq * w2.y; lg[tk][10] += hq * w2.z; lg[tk][11] += hq * w2.w; lg[tk][12] += hq * w3.x; lg[tk][13] += hq * w3.y; lg[tk][14] += hq * w3.z; lg[tk][15] += hq * w3.w; } } }
#pragma unroll
                for (int tk = 0; tk < 4; ++tk) { float mx = -1e30f;
#pragma unroll
                    for (int e = 0; e < 16; ++e) { lg[tk][e] = wave_sum(lg[tk][e]); mx = fmaxf(mx, lg[tk][e]); }
                    float sm = 0.f;
#pragma unroll
                    for (int e = 0; e < 16; ++e) { lg[tk][e] = expf(lg[tk][e] - mx); sm += lg[tk][e]; }
                    const float inv = 1.0f / sm;
                    if (lane == 0) {
#pragma unroll
                        for (int e = 0; e < 16; e += 4) *(float4*)(PROBS + (size_t)(tok0 + tk) * 16 + e) = make_float4(lg[tk][e] * inv, lg[tk][e + 1] * inv, lg[tk][e + 2] * inv, lg[tk][e + 3] * inv); } }
            }
            SEAM(PB + 9);
        }
        if (IN(PB + 10)) for (int rep_ = 0; rep_ < PROBE_REPS(10); ++rep_) {
            PH_BEGIN
            const int nitems = 64 + (lastl ? 0 : 64);
            unsigned long long* keys = (unsigned long long*)shm;
            for (int it = bid; it < nitems; it += G) {
                const int set = it >> 6, e = it & 15, b = (it >> 4) & 3;
                const int n = set ? CTXL : SEQ, cap = set ? 32 : 512, tokbase = set ? NLAT + b * CTXL : b * SEQ;
                __syncthreads();
                for (int i = tid; i < n; i += NTHR) keys[i] = ((unsigned long long)__float_as_uint(PROBS[(size_t)(tokbase + i) * 16 + e]) << 32) | (unsigned long long)(0xFFFFFFFFu - (unsigned)i);
                __syncthreads();
                for (int k = 2; k <= n; k <<= 1)
                    for (int j = k >> 1; j > 0; j >>= 1) {
                        for (int p = tid; p < (n >> 1); p += NTHR) { const int i = ((p & ~(j - 1)) << 1) | (p & (j - 1)); const int m = i | j;
                            const unsigned long long ka = keys[i], kb = keys[m]; const bool desc = ((i & k) == 0);
                            if ((ka < kb) == desc) { keys[i] = kb; keys[m] = ka; } }
                        __syncthreads();
                    }
                for (int r = tid; r < cap; r += NTHR) { const unsigned long long kk = keys[r]; const int row = e * MOE_PAD + (set ? 2048 + b * 32 + r : b * 512 + r);
                    const int tk_ = tokbase + (int)(0xFFFFFFFFu - (unsigned)(kk & 0xFFFFFFFFull)); ROWTOK[row] = tk_; ROWGATE[row] = __uint_as_float((unsigned)(kk >> 32)); INV[tk_ * 16 + e] = row; }
                for (int rb = 0; rb < cap; rb += 32) {
                    u32x4 t4[4][4];
#pragma unroll
                    for (int q = 0; q < 4; ++q) { const int r = rb + wave + 8 * q; const int tok = tokbase + (int)(0xFFFFFFFFu - (unsigned)(keys[r] & 0xFFFFFFFFull));
                        const u32x4* sp = (const u32x4*)(HB + (size_t)tok * DM);
#pragma unroll
                        for (int i = 0; i < 4; ++i) t4[q][i] = sp[i * 64 + lane]; }
#pragma unroll
                    for (int q = 0; q < 4; ++q) { const int r = rb + wave + 8 * q; const int row = e * MOE_PAD + (set ? 2048 + b * 32 + r : b * 512 + r);
                        u32x4* dp = (u32x4*)(XG + (size_t)row * DM);
#pragma unroll
                        for (int i = 0; i < 4; ++i) dp[i * 64 + lane] = t4[q][i]; } }
            }
            if (!lastl && G > 128 && bid >= 128) {
                const int n_win = 32 * 55, n_br = 4 * 64, n_out = 32 * 8, n_glu = 16, n_gu = 16 * 2 * 192; (void)n_gu;
                CV_RUN(l + 1, bid - 128, G - 128, n_win); (void)n_br; (void)n_out; (void)n_glu;
            }
            {   const int pad0 = lastl ? 2048 : MOE_ROWS, npad = MOE_PAD - pad0;
                for (int R = bid * 8 + wave; R < NEXP * npad; R += G * 8) { const int e = R / npad, rr = pad0 + R % npad; u32x4* dp = (u32x4*)(XG + ((size_t)e * MOE_PAD + rr) * DM);
#pragma unroll
                    for (int i = 0; i < 4; ++i) dp[i * 64 + lane] = (u32x4){0u, 0u, 0u, 0u}; } }
            SEAM(PB + 10);
        }
        if (IN(PB + 12)) for (int rep_ = 0; rep_ < PROBE_REPS(12); ++rep_) {
            PH_BEGIN
            pg8::Gemm g{XG, WGU, DM, DM, DM}; pg8::SchedMoe S{lastl ? 8 : 9, 12, G, bid, DM, DM, 2 * DEXP}; pg8::EpiMoe1 E{HID};
            pg8::gemm_phase((LAS unsigned char*)shm, g, S, E);
            SEAM(PB + 12);
        }
        if (IN(PB + 13)) for (int rep_ = 0; rep_ < PROBE_REPS(13); ++rep_) {
            PH_BEGIN
            pg8::Gemm g{HID, WD, DEXP, DEXP, DEXP}; pg8::SchedMoe S{lastl ? 8 : 9, 8, G, bid, DEXP, DEXP, DM}; pg8::EpiMoeY E{YEXP};
            pg8::gemm_phase((LAS unsigned char*)shm, g, S, E);
            SEAM(PB + 13);
        }

}

__global__ __launch_bounds__(NTHR, 2) void fwd(Args a) {
    extern __shared__ __attribute__((aligned(16))) unsigned char shm[];
    const int bid = blockIdx.x, G = gridDim.x;
    float* const sf = (float*)shm;
    volatile LAS unsigned* xbw = (volatile LAS unsigned*)((LAS unsigned char*)shm + (LDS_BYTES - 16));
    if (threadIdx.x == 0) { xbw[0] = 0u; xbw[1] = 0u; xbw[2] = 0u; xbw[3] = 0u; }
    const float** const ptab = (const float**)(shm + (LDS_BYTES - 16 - 512));
    if (threadIdx.x == 0) {
#pragma unroll
        for (int i = 0; i < 47; ++i) ptab[i] = a.in[i]; }
    __syncthreads();
    XcdBarrier bar = xcd_barrier_post((unsigned*)(a.ws + O_BAR), xbw);
    const int lo = a.ph_lo, hi = a.ph_hi;
    if (IN(0)) {
        PH_BEGIN
        {
            __syncthreads();
            for (int i = tid; i < 5 * DM; i += NTHR) { const int r = i >> 11, k = i & (DM - 1); const float v = r < 4 ? c_in[r * DM + k] : cctx_in[k]; sf[i] = siluf_(v); }
            __syncthreads();
            float* red = sf + 5 * DM;
            for (int unit = bid; unit < 2 * 96; unit += G) { const int l = unit / 96, j = (unit % 96) * 128 + (tid & 127), kq = tid >> 7;
                const float* w = ada_w + (size_t)l * DM * (6 * DM) + (size_t)(kq * 512) * (6 * DM) + j; const float* sv = sf + kq * 512;
                float a0 = 0.f, a1 = 0.f, a2 = 0.f, a3 = 0.f, a4 = 0.f;
#pragma unroll 8
                for (int k = 0; k < 512; ++k) { const float wv = w[(size_t)k * (6 * DM)]; a0 += sv[k] * wv; a1 += sv[DM + k] * wv; a2 += sv[2 * DM + k] * wv; a3 += sv[3 * DM + k] * wv; a4 += sv[4 * DM + k] * wv; }
                __syncthreads();
                { float* rp = red + (kq * 5) * 128 + (tid & 127); rp[0] = a0; rp[128] = a1; rp[256] = a2; rp[384] = a3; rp[512] = a4; }
                __syncthreads();
                if (tid < 128) { const float bb = ada_b[l * 6 * DM + j]; float* o = MOD + (size_t)l * 5 * 6 * DM + j;
#pragma unroll
                    for (int r = 0; r < 5; ++r) o[(size_t)r * 6 * DM] = ((red[(0 * 5 + r) * 128 + tid] + red[(1 * 5 + r) * 128 + tid]) + (red[(2 * 5 + r) * 128 + tid] + red[(3 * 5 + r) * 128 + tid])) + bb; }
            }
        }
    }

    layer_body<0>(a, bar, lo, hi, bid, G, shm, sf, ptab);
    layer_body<1>(a, bar, lo, hi, bid, G, shm, sf, ptab);
    if (IN(33)) {
        PH_BEGIN
        const float* gn = PT(46);
        for (int tok = bid * 8 + wave; tok < NLAT; tok += G * 8) {
            const float* xr = XS + (size_t)tok * DM; float4 v[8]; float ss = 0.f;
#pragma unroll
            for (int i = 0; i < 8; ++i) v[i] = *(const float4*)(xr + i * 256 + lane * 4);
            moe_combine(v, tok, lane, INV, ROWGATE, YEXP, MOD + (size_t)(1 * 5 + tok / SEQ) * 6 * DM + 5 * DM);
#pragma unroll
            for (int i = 0; i < 8; ++i) {                 ss += v[i].x * v[i].x + v[i].y * v[i].y + v[i].z * v[i].z + v[i].w * v[i].w; }
            ss = wave_sum(ss); const float rs = rsqrtf(ss * (1.0f / DM) + 1e-6f);
#pragma unroll
            for (int i = 0; i < 8; ++i) { const int d = i * 256 + lane * 4; const float4 g4 = *(const float4*)(gn + d);
                *(float4*)(a.out + (size_t)tok * DM + d) = make_float4(v[i].x * rs * g4.x, v[i].y * rs * g4.y, v[i].z * rs * g4.z, v[i].w * rs * g4.w); }
        }
    }
#undef IN
#undef SEAM
}


extern "C" void kernel_launch(void* const* d_in, const int* in_sizes, int n_in, void* d_out, int out_size, void* d_ws, size_t ws_size, hipStream_t stream) {
    static int grid = 0;
    if (grid == 0) {
        if (n_in != 47 || ws_size < WS_END) { fprintf(stderr, "kernel_launch: expected 47 inputs and >= %zu bytes of workspace; got %d, %zu\n", (size_t)WS_END, n_in, ws_size); grid = -1; return; }
        int dev = 0, cus = 0;
        if (hipGetDevice(&dev) != hipSuccess || hipDeviceGetAttribute(&cus, hipDeviceAttributeMultiprocessorCount, dev) != hipSuccess) { grid = -1; return; }
        if (hipFuncSetAttribute((const void*)fwd, hipFuncAttributeMaxDynamicSharedMemorySize, LDS_BYTES) != hipSuccess) { fprintf(stderr, "kernel_launch: hipFuncSetAttribute failed\n"); grid = -1; return; }
        int per_cu = 0;
        if (hipOccupancyMaxActiveBlocksPerMultiprocessor(&per_cu, (const void*)fwd, NTHR, LDS_BYTES) != hipSuccess || per_cu < 1) fprintf(stderr, "kernel_launch: occupancy query reports %d\n", per_cu);
        (void)hipGetLastError();
        grid = cus > 256 ? 256 : cus;
        if (grid < 224) { fprintf(stderr, "kernel_launch: needs >= 224 CUs (got %d)\n", grid); grid = -1; return; }
    }
    if (grid < 0) return;
    (void)hipMemsetAsync((char*)d_ws, 0, O_ZERO_END, stream);
    Args a{};
    for (int i = 0; i < 47; ++i) a.in[i] = (const float*)d_in[i];
    a.out = (float*)d_out; a.ws = (unsigned char*)d_ws;
#if MK_ONE_LAUNCH
    a.ph_lo = 0; a.ph_hi = 64;
    hipLaunchKernelGGL(fwd, dim3(grid), dim3(NTHR), LDS_BYTES, stream, a);
#else
    const int ids[] = {0, 1,2,3,4,5,6,7,8,9,10,11,12,13,14, 17,18,19,20,21,22,23,24,25,26,27,28,29,30, 33};
    for (int k = 0; k < (int)(sizeof(ids) / sizeof(ids[0])); ++k) { a.ph_lo = ids[k]; a.ph_hi = ids[k] + 1; hipLaunchKernelGGL(fwd, dim3(grid), dim3(NTHR), LDS_BYTES, stream, a); }
#endif
}
```

```cpp
#include <hip/hip_runtime.h>
#include <stdint.h>
#include <stdio.h>

#ifndef PROBE_MASK
#define PROBE_MASK 0
#endif
#ifndef PROBE_SP
#define PROBE_SP 1
#endif
#define PROBE_REPS(k) ((((PROBE_MASK) >> (k)) & 1) + 1)
#ifndef MK_ONE_LAUNCH
#define MK_ONE_LAUNCH 1
#endif

#define DM 2048
#define NB 4
#define SEQ 4096
#define CTXL 256
#define BW 512
#define NLAT 16384
#define NCTX 1024
#define NTOK 17408
#define IN_W 13856
#define GATE2 5888
#define LDP 14080
#define HY_OFF 0
#define ML_OFF 1536
#define S5_OFF 3600
#define SSD_OFF 4112
#define GATE_OFF 5664
#define NEXP 16
#define DEXP 1536
#define MOE_ROWS 2176
#define MOE_PAD 2304
#define NTHR 512
#define LDS_BYTES 147456
#define LAS __attribute__((address_space(3)))

typedef unsigned short bf16_t;
typedef short bf16x8 __attribute__((ext_vector_type(8)));
typedef float f32x4 __attribute__((ext_vector_type(4)));
typedef unsigned u32x4 __attribute__((ext_vector_type(4)));
typedef unsigned u32x2 __attribute__((ext_vector_type(2)));

#define XB_TMO      128
#define XB_XCNT(j)  (256  + 64 * (j))
#define XB_XSUB(j)  (1280 + 64 * (j))
#define XB_XGEN(j)  (2304 + 64 * (j))
#define XB_TOP      3328
#define XB_TOPGEN   3392
#define XCD_BAR_WORDS 3456
#define XB_SPIN_CAP (1u << 18)
__device__ __forceinline__ unsigned xb_ld(unsigned* p)              { return __hip_atomic_load(p, __ATOMIC_RELAXED, __HIP_MEMORY_SCOPE_AGENT); }
__device__ __forceinline__ unsigned xb_add(unsigned* p, unsigned v) { return __hip_atomic_fetch_add(p, v, __ATOMIC_RELAXED, __HIP_MEMORY_SCOPE_AGENT); }
__device__ __forceinline__ unsigned xb_xcc_id() { return (unsigned)__builtin_amdgcn_s_getreg((3 << 11) | 20) & 0xFu; }
#define XB_SPIN(cond, bar) do { unsigned _sp = 0; while (cond) { __builtin_amdgcn_s_sleep(1); \
    if ((++_sp & 255u) == 0u) { if (xb_ld(&(bar)[XB_TMO])) break; if (_sp > XB_SPIN_CAP) { atomicAdd(&(bar)[XB_TMO], 1u); break; } } } } while (0)
struct XcdBarrier { unsigned* bar; unsigned x; volatile LAS unsigned* st; };
__device__ __forceinline__ XcdBarrier xcd_barrier_post(unsigned* bar, volatile LAS unsigned* st) {
    XcdBarrier b; b.bar = bar; b.x = xb_xcc_id(); b.st = st;
    if (threadIdx.x == 0) (void)xb_add(&bar[XB_XCNT(b.x)], 1u);
    return b;
}
__device__ __forceinline__ void xcd_barrier_complete(unsigned* bar, unsigned x, unsigned& nloc, unsigned& nx) {
    const unsigned G = gridDim.x * gridDim.y * gridDim.z;
    unsigned sum, cnt, mine, sp = 0u;
    for (;;) {
        sum = 0u; cnt = 0u; mine = 0u;
#pragma unroll
        for (unsigned j = 0; j < 16; ++j) { const unsigned c = xb_ld(&bar[XB_XCNT(j)]); sum += c; cnt += (c > 0u) ? 1u : 0u; mine = (j == x) ? c : mine; }
        if (sum == G) break;
        __builtin_amdgcn_s_sleep(1);
        if ((++sp & 255u) == 0u) { if (xb_ld(&bar[XB_TMO])) break; if (sp > XB_SPIN_CAP) { atomicAdd(&bar[XB_TMO], 1u); break; } }
    }
    nloc = mine > 0u ? mine : 1u; nx = cnt > 0u ? cnt : 1u;
}
__device__ __forceinline__ void xcd_barrier(const XcdBarrier& b) {
    asm volatile("s_waitcnt vmcnt(0)" ::: "memory");
    __syncthreads();
    if (threadIdx.x == 0) {
        unsigned* bar = b.bar;
        __builtin_amdgcn_s_waitcnt(0);
        unsigned nloc = b.st[0], nx = b.st[1];
        if (nloc == 0u) { xcd_barrier_complete(bar, b.x, nloc, nx); b.st[0] = nloc; b.st[1] = nx; }
        const unsigned old = xb_add(&bar[XB_XSUB(b.x)], 1u);
        const unsigned gen = old / nloc;
        if (old + 1u == (gen + 1u) * nloc) {
            __builtin_amdgcn_fence(__ATOMIC_RELEASE, "agent");
            asm volatile("s_waitcnt vmcnt(0)" ::: "memory");
            const unsigned og = xb_add(&bar[XB_TOP], 1u);
            const unsigned tg = og / nx;
            if (og + 1u == (tg + 1u) * nx) xb_add(&bar[XB_TOPGEN], 1u);
            else XB_SPIN(xb_ld(&bar[XB_TOPGEN]) == tg, bar);
            __builtin_amdgcn_fence(__ATOMIC_ACQUIRE, "agent");
            xb_add(&bar[XB_XGEN(b.x)], 1u);
            asm volatile("s_waitcnt vmcnt(0)" ::: "memory");
        } else {
            XB_SPIN(xb_ld(&bar[XB_XGEN(b.x)]) == gen, bar);
            __builtin_amdgcn_fence(__ATOMIC_ACQUIRE, "agent");
            asm volatile("s_waitcnt vmcnt(0)" ::: "memory");
        }
    }
    __syncthreads();
}

__device__ __forceinline__ unsigned short f2bf(float f) { unsigned u = __float_as_uint(f); u += 0x7FFFu + ((u >> 16) & 1u); return (unsigned short)(u >> 16); }
__device__ __forceinline__ float bf2f(unsigned short b) { return __uint_as_float(((unsigned)b) << 16); }
__device__ __forceinline__ unsigned pk2(float lo, float hi) { unsigned r; asm("v_cvt_pk_bf16_f32 %0, %1, %2" : "=v"(r) : "v"(lo), "v"(hi)); return r; }
__device__ __forceinline__ float sigmoidf_(float x) { return 1.0f / (1.0f + expf(-x)); }
__device__ __forceinline__ float siluf_(float x) { return x / (1.0f + expf(-x)); }
__device__ __forceinline__ float wave_sum(float v) {
#pragma unroll
    for (int o = 32; o >= 1; o >>= 1) v += __shfl_xor(v, o);
    return v;
}
__device__ __forceinline__ const float* uptr(const float* p) { const unsigned long long v = (unsigned long long)p;
    const unsigned lo = __builtin_amdgcn_readfirstlane((unsigned)v), hi = __builtin_amdgcn_readfirstlane((unsigned)(v >> 32)); return (const float*)(((unsigned long long)hi << 32) | lo); }
#define PT(k) uptr(ptab[k])
__device__ __forceinline__ int step_tok(int b, int dir, int i) {
    if (i < CTXL) { const int tt = dir ? (CTXL - 1 - i) : i; return NLAT + b * CTXL + tt; }
    const int j = i - CTXL; const int tt = dir ? (SEQ - 1 - j) : j; return b * SEQ + tt;
}
__device__ __forceinline__ void unpack8(const u32x4 w, float (&f)[8]) {
    f[0] = __uint_as_float(w.x << 16); f[1] = __uint_as_float(w.x & 0xFFFF0000u); f[2] = __uint_as_float(w.y << 16); f[3] = __uint_as_float(w.y & 0xFFFF0000u);
    f[4] = __uint_as_float(w.z << 16); f[5] = __uint_as_float(w.z & 0xFFFF0000u); f[6] = __uint_as_float(w.w << 16); f[7] = __uint_as_float(w.w & 0xFFFF0000u);
}

namespace pg8 {
constexpr int BM = 256, BK = 64, HALF = 128, HTB = HALF * BK * 2, STAGE_BYTES = 8 * HTB, NXCD = 8, WGM = 8;
__host__ __device__ __forceinline__ int lds_byte(int r, int c) { const int st = (r >> 4) * 2 + (c >> 5), rr = r & 15, cc = c & 31, ob = rr * 64 + cc * 2; return st * 1024 + (ob ^ (((ob >> 9) & 1) << 5)); }
__host__ __device__ __forceinline__ void stage_rc(int b, int& R, int& C) { const int st = b / 1024, sb = b % 1024, swz = sb ^ (((sb >> 9) & 1) << 5); R = (st >> 1) * 16 + swz / 64; C = (st & 1) * 32 + (swz % 64) / 2; }
__host__ __device__ __forceinline__ int perm32(int rho) { const int n = rho >> 4, i = rho & 15; return 8 * (i >> 2) + 4 * n + (i & 3); }
struct Unit { int pm, pn, z, k; long long ao, bo; };
struct Gemm { const bf16_t* A; const bf16_t* Bt; int lda, ldb, K; };

__device__ __forceinline__ void tile_of(int wgid, int nM, int nN, int& pm, int& pn) {
    const int nwg = nM * nN; { const int q = nwg / NXCD, r = nwg % NXCD, xcd = wgid % NXCD, off = wgid / NXCD; wgid = (xcd < r ? xcd * (q + 1) : r * (q + 1) + (xcd - r) * q) + off; }
    const int nig = WGM * nN, gid = wgid / nig, fm = gid * WGM, gsz = (nM - fm) < WGM ? (nM - fm) : WGM;
    pm = fm + ((wgid % nig) % gsz); pn = (wgid % nig) / gsz;
}
struct SchedStd {
    int nM, nN, G, c, lda, ldb;
    __device__ __forceinline__ bool next(int i, Unit& u) const { const long L = (long)i * G + c; if (L >= (long)nM * nN) return false; tile_of((int)L, nM, nN, u.pm, u.pn); u.z = 0; u.k = 0;
        u.ao = (long long)u.pm * BM * lda * 2; u.bo = (long long)u.pn * BM * ldb * 2; return true; }
    __device__ __forceinline__ void a_ready(const Unit&) const {}
    __device__ __forceinline__ void done(const Unit&) const {}
};
struct SchedBranch {
    int nM, nN, G, c;
    __device__ __forceinline__ bool next(int i, Unit& u) const { const long L = (long)(i >> 2) * G + c; if (L >= (long)nM * nN) return false; tile_of((int)L, nM, nN, u.pm, u.pn); u.z = 0; u.k = i & 3;
        u.ao = ((long long)u.pm * BM * DM + u.k * BW) * 2; u.bo = ((long long)u.k * DM + u.pn * BM) * BW * 2; return true; }
    __device__ __forceinline__ void a_ready(const Unit&) const {}
    __device__ __forceinline__ void done(const Unit&) const {}
};
struct SchedTail {
    int G, c;
    __device__ __forceinline__ bool next(int i, Unit& u) const { const long T = (long)i * G + c; if (T >= 128) return false; const int t = (int)(T >> 2); u.pm = 64 + (t >> 3); u.pn = t & 7; u.z = 1; u.k = (int)(T & 3);
        u.ao = ((long long)u.pm * BM * DM + u.k * BW) * 2; u.bo = ((long long)u.k * DM + u.pn * BM) * BW * 2; return true; }
    __device__ __forceinline__ void a_ready(const Unit&) const {}
    __device__ __forceinline__ void done(const Unit&) const {}
};
struct SchedTailK {
    int G, c;
    __device__ __forceinline__ bool next(int i, Unit& u) const { const long T = (long)i * G + c; if (T >= 128) return false; const int t = (int)(T >> 2); u.pm = 64 + (t >> 3); u.pn = t & 7; u.z = 1; u.k = (int)(T & 3);
        u.ao = ((long long)u.pm * BM * DM + u.k * 512) * 2; u.bo = ((long long)u.pn * BM * DM + u.k * 512) * 2; return true; }
    __device__ __forceinline__ void a_ready(const Unit&) const {}
    __device__ __forceinline__ void done(const Unit&) const {}
};
struct SchedMoe {
    int nPm, nPn, G, c, lda, ldb, nBrows;
    __device__ __forceinline__ bool next(int i, Unit& u) const { const long L = (long)i * G + c; const int per = nPm * nPn; if (L >= (long)NEXP * per) return false; const int e = (int)(L / per), rem = (int)(L % per);
        u.z = e; u.k = 0; u.pm = rem % nPm; u.pn = rem / nPm; u.ao = ((long long)e * MOE_PAD + u.pm * BM) * lda * 2; u.bo = ((long long)e * nBrows + u.pn * BM) * ldb * 2; return true; }
    __device__ __forceinline__ void a_ready(const Unit&) const {}
    __device__ __forceinline__ void done(const Unit&) const {}
};

typedef f32x4 Acc[2][2][4][2];
template <class Epi, class Sched>
__device__ __forceinline__ void gemm_phase(LAS unsigned char* lds, const Gemm g, const Sched& S, const Epi& E) {
    int tid = threadIdx.x; asm volatile("" : "+v"(tid));
    const int wid = __builtin_amdgcn_readfirstlane(tid >> 6), lane = tid & 63, wr = wid >> 2, wc = wid & 3, fr = lane & 15, fq = lane >> 4;
    const int K = g.K, nt = K / BK;
    unsigned voffA[2], voffB[2];
#pragma unroll
    for (int i = 0; i < 2; ++i) { int R, C; stage_rc(tid * 16 + i * 8192, R, C); const int Rb = Epi::PERM ? ((R & ~31) + perm32(R & 31)) : R;
        voffA[i] = (unsigned)(R * g.lda + C) * 2u; voffB[i] = (unsigned)(Rb * g.ldb + C) * 2u; }
    const size_t kstep = (size_t)(BK * 2);
    const size_t hstepA = (size_t)HALF * g.lda * 2, hstepB = (size_t)HALF * g.ldb * 2;
    const unsigned ldsw = (unsigned)wid * 1024u;
    const int aoff = lds_byte(wr * 64 + fr, fq * 8), boff = lds_byte(wc * 32 + fr, fq * 8);
#define PG8_SA(b, h) (((b) * 2 + (h)) * HTB)
#define PG8_SB(b, h) ((4 + (b) * 2 + (h)) * HTB)
#define PG8_STAGE(bufoff, gbase, voff) do { _Pragma("unroll") for (int _i = 0; _i < 2; ++_i) \
        __builtin_amdgcn_global_load_lds((const unsigned*)((const char*)(gbase) + (voff)[_i]), (LAS unsigned*)(lds + (bufoff) + ldsw + _i * 8192), 16, 0, 0); } while (0)
#define PG8_LDA(dst, b, h) do { _Pragma("unroll") for (int m = 0; m < 4; ++m) _Pragma("unroll") for (int k = 0; k < 2; ++k) dst[m][k] = *(const LAS bf16x8*)(lds + PG8_SA(b, h) + aoff + m * 2048 + k * 1024); } while (0)
#define PG8_LDB(dst, b, h) do { _Pragma("unroll") for (int n = 0; n < 2; ++n) _Pragma("unroll") for (int k = 0; k < 2; ++k) dst[n][k] = *(const LAS bf16x8*)(lds + PG8_SB(b, h) + boff + n * 2048 + k * 1024); } while (0)
#define PG8_MMA(ai, bj, At, Bt) do { __builtin_amdgcn_s_setprio(1); _Pragma("unroll") for (int m = 0; m < 4; ++m) _Pragma("unroll") for (int n = 0; n < 2; ++n) _Pragma("unroll") for (int k = 0; k < 2; ++k) \
        acc[ai][bj][m][n] = __builtin_amdgcn_mfma_f32_16x16x32_bf16(Bt[n][k], At[m][k], acc[ai][bj][m][n], 0, 0, 0); __builtin_amdgcn_s_setprio(0); } while (0)
#define PG8_WAIT_V(n) asm volatile("s_waitcnt vmcnt(" #n ")" ::: "memory")
#define PG8_WAIT_L(n) asm volatile("s_waitcnt lgkmcnt(" #n ")" ::: "memory")
#define PG8_BAR __builtin_amdgcn_s_barrier()
#define PG8_SCHED __builtin_amdgcn_sched_barrier(0)
    Unit cur, nxt; int ui = 0;
    if (!S.next(0, cur)) return;
    Acc acc;
#pragma unroll
    for (int a = 0; a < 2; ++a)
#pragma unroll
        for (int b = 0; b < 2; ++b)
#pragma unroll
            for (int m = 0; m < 4; ++m)
#pragma unroll
                for (int n = 0; n < 2; ++n) acc[a][b][m][n] = (f32x4){0.f, 0.f, 0.f, 0.f};
    bf16x8 At[4][2], B0[2][2], B1[2][2];
    const char* cA = (const char*)g.A + cur.ao; const char* cB = (const char*)g.Bt + cur.bo;
    S.a_ready(cur);
    PG8_STAGE(PG8_SB(0, 0), cB, voffB); PG8_STAGE(PG8_SA(0, 0), cA, voffA); PG8_STAGE(PG8_SB(0, 1), cB + hstepB, voffB); PG8_STAGE(PG8_SA(0, 1), cA + hstepA, voffA);
    if (wr == 1) PG8_BAR;
    PG8_WAIT_V(4); PG8_BAR;
    PG8_STAGE(PG8_SB(1, 0), cB + kstep, voffB); PG8_STAGE(PG8_SA(1, 0), cA + kstep, voffA); PG8_STAGE(PG8_SB(1, 1), cB + hstepB + kstep, voffB);
    PG8_WAIT_V(6); PG8_BAR;
    for (;;) {
        const bool has_next = S.next(ui + 1, nxt);
        const char* nA = has_next ? (const char*)g.A + nxt.ao : cA; const char* nB = has_next ? (const char*)g.Bt + nxt.bo : cB;
        for (int t = 0; t < nt; t += 2) {
            const bool last = (t == nt - 2);
            const char* a1 = cA + (size_t)(t + 1) * kstep;
            const char* a2 = last ? nA : cA + (size_t)(t + 2) * kstep; const char* b2 = last ? nB : cB + (size_t)(t + 2) * kstep;
            const char* a3 = a2 + kstep; const char* b3 = b2 + kstep;
            if (last && has_next) S.a_ready(nxt);
            PG8_LDB(B0, 0, 0); PG8_SCHED; PG8_LDA(At, 0, 0); PG8_STAGE(PG8_SA(1, 1), a1 + hstepA, voffA);
            PG8_WAIT_L(8); PG8_BAR; PG8_WAIT_L(0); PG8_MMA(0, 0, At, B0); PG8_BAR; PG8_SCHED;
            PG8_LDB(B1, 0, 1); PG8_STAGE(PG8_SB(0, 0), b2, voffB);
            PG8_BAR; PG8_WAIT_L(0); PG8_MMA(0, 1, At, B1); PG8_BAR;
            PG8_LDA(At, 0, 1); PG8_STAGE(PG8_SA(0, 0), a2, voffA);
            PG8_BAR; PG8_WAIT_L(0); PG8_MMA(1, 0, At, B0); PG8_BAR; PG8_SCHED;
            PG8_STAGE(PG8_SB(0, 1), b2 + hstepB, voffB);
            PG8_WAIT_V(6); PG8_BAR; PG8_MMA(1, 1, At, B1); PG8_BAR;
            PG8_LDB(B0, 1, 0); PG8_SCHED; PG8_LDA(At, 1, 0); PG8_STAGE(PG8_SA(0, 1), a2 + hstepA, voffA);
            PG8_WAIT_L(8); PG8_BAR; PG8_WAIT_L(0); PG8_MMA(0, 0, At, B0); PG8_BAR; PG8_SCHED;
            PG8_LDB(B1, 1, 1); PG8_STAGE(PG8_SB(1, 0), b3, voffB);
            PG8_BAR; PG8_WAIT_L(0); PG8_MMA(0, 1, At, B1); PG8_BAR;
            PG8_LDA(At, 1, 1); PG8_STAGE(PG8_SA(1, 0), a3, voffA);
            PG8_BAR; PG8_WAIT_L(0); PG8_MMA(1, 0, At, B0); PG8_BAR; PG8_SCHED;
            PG8_STAGE(PG8_SB(1, 1), b3 + hstepB, voffB);
            PG8_WAIT_V(6); PG8_BAR; PG8_MMA(1, 1, At, B1); PG8_BAR;
        }
        const bool keep = E(acc, cur, wr, wc, fr, fq); S.done(cur);
        if (!has_next) break;
        if (!keep) {
#pragma unroll
        for (int a = 0; a < 2; ++a)
#pragma unroll
            for (int b = 0; b < 2; ++b)
#pragma unroll
                for (int m = 0; m < 4; ++m)
#pragma unroll
                    for (int n = 0; n < 2; ++n) acc[a][b][m][n] = (f32x4){0.f, 0.f, 0.f, 0.f};
        }
        cur = nxt; cA = nA; cB = nB; ++ui;
    }
    PG8_WAIT_V(0);
    if (wr == 0) PG8_BAR;
    PG8_BAR;
#undef PG8_SA
#undef PG8_SB
#undef PG8_STAGE
#undef PG8_LDA
#undef PG8_LDB
#undef PG8_MMA
#undef PG8_WAIT_V
#undef PG8_WAIT_L
#undef PG8_BAR
#undef PG8_SCHED
}

struct EpiBf16Store {
    static constexpr bool PERM = true;
    bf16_t* O; int ldc;
    __device__ __forceinline__ bool operator()(Acc& acc, const Unit& u, int wr, int wc, int fr, int fq) const {
        const int row0 = u.pm * BM + wr * 64 + fr, col0 = u.pn * BM + wc * 32 + 8 * fq;
#pragma unroll
        for (int ai = 0; ai < 2; ++ai)
#pragma unroll
            for (int m = 0; m < 4; ++m) { bf16_t* rowp = O + (size_t)(row0 + ai * HALF + m * 16) * ldc + col0;
#pragma unroll
                for (int bj = 0; bj < 2; ++bj) { const f32x4 v0 = acc[ai][bj][m][0], v1 = acc[ai][bj][m][1];
                    u32x4 w; w.x = pk2(v0[0], v0[1]); w.y = pk2(v0[2], v0[3]); w.z = pk2(v1[0], v1[1]); w.w = pk2(v1[2], v1[3]);
                    *(u32x4*)(rowp + bj * HALF) = w; } }
        return false;
    }
};
struct EpiWin {
    static constexpr bool PERM = true;
    bf16_t* O; int ldc;
    __device__ __forceinline__ bool operator()(Acc& acc, const Unit& u, int wr, int wc, int fr, int fq) const {
        const int row0 = u.pm * BM + wr * 64 + fr;
        if (u.pn < 23) { const int col0 = u.pn * BM + wc * 32 + 8 * fq;
#pragma unroll
            for (int ai = 0; ai < 2; ++ai)
#pragma unroll
                for (int m = 0; m < 4; ++m)
#pragma unroll
                    for (int bj = 0; bj < 2; ++bj) { const f32x4 v0 = acc[ai][bj][m][0], v1 = acc[ai][bj][m][1];
                        u32x4 w; w.x = pk2(v0[0], v0[1]); w.y = pk2(v0[2], v0[3]); w.z = pk2(v1[0], v1[1]); w.w = pk2(v1[2], v1[3]);
                        *(u32x4*)(O + (size_t)(row0 + ai * HALF + m * 16) * ldc + col0 + bj * HALF) = w; }
        } else { const int colb = GATE2 + 64 * (u.pn - 23) + 16 * wc + 4 * fq;
#pragma unroll
            for (int ai = 0; ai < 2; ++ai)
#pragma unroll
                for (int m = 0; m < 4; ++m) { f32x4 sg[4];
#pragma unroll
                    for (int bj = 0; bj < 2; ++bj)
#pragma unroll
                        for (int n = 0; n < 2; ++n) { const f32x4 v = acc[ai][bj][m][n];
#pragma unroll
                            for (int j = 0; j < 4; ++j) sg[2 * bj + n][j] = __builtin_amdgcn_rcpf(1.0f + __expf(-v[j])); }
                    bf16_t* op = O + (size_t)(row0 + ai * HALF + m * 16) * ldc + colb;
#pragma unroll
                    for (int k = 0; k < 4; ++k) { f32x4 r = sg[k];
                        if (k < 3) {
#pragma unroll
                            for (int j = 0; j < 4; ++j) r[j] *= __builtin_amdgcn_rcpf(sg[k + 1][j]); }
                        u32x2 w; w.x = pk2(r[0], r[1]); w.y = pk2(r[2], r[3]); *(u32x2*)(op + k * DM) = w; } }
        }
        return false;
    }
};
struct EpiNone { static constexpr bool PERM = true;
    __device__ __forceinline__ bool operator()(Acc& acc, const Unit&, int, int, int, int) const {
#pragma unroll
        for (int a = 0; a < 2; ++a)
#pragma unroll
            for (int b = 0; b < 2; ++b)
#pragma unroll
                for (int m = 0; m < 4; ++m)
#pragma unroll
                    for (int n = 0; n < 2; ++n) asm volatile("" :: "v"(acc[a][b][m][n]));
        return false; } };
struct EpiGlu {
    static constexpr bool PERM = true;
    const bf16_t* GG; const float* bias; bf16_t* Y4;
    __device__ __forceinline__ bool operator()(Acc& acc, const Unit& u, int wr, int wc, int fr, int fq) const {
        const int row0 = u.pm * BM + wr * 64 + fr, col0 = u.pn * BM + wc * 32 + 8 * fq;
#pragma unroll
        for (int bj = 0; bj < 2; ++bj) { const int col = col0 + bj * HALF; const f32x4 b0 = *(const f32x4*)(bias + col), b1 = *(const f32x4*)(bias + col + 4);
            u32x4 gq[2][4];
#pragma unroll
            for (int ai = 0; ai < 2; ++ai)
#pragma unroll
                for (int m = 0; m < 4; ++m) gq[ai][m] = *(const u32x4*)(GG + (size_t)(row0 + ai * HALF + m * 16) * BW + col);
#pragma unroll
            for (int ai = 0; ai < 2; ++ai)
#pragma unroll
                for (int m = 0; m < 4; ++m) { const size_t row = (size_t)(row0 + ai * HALF + m * 16);
                    float gg[8]; unpack8(gq[ai][m], gg);
                    const f32x4 v0 = acc[ai][bj][m][0] + b0, v1 = acc[ai][bj][m][1] + b1;
                    u32x4 w; w.x = pk2(gg[0] * sigmoidf_(v0[0]), gg[1] * sigmoidf_(v0[1])); w.y = pk2(gg[2] * sigmoidf_(v0[2]), gg[3] * sigmoidf_(v0[3]));
                    w.z = pk2(gg[4] * sigmoidf_(v1[0]), gg[5] * sigmoidf_(v1[1])); w.w = pk2(gg[6] * sigmoidf_(v1[2]), gg[7] * sigmoidf_(v1[3]));
                    *(u32x4*)(Y4 + row * DM + 1024 + col) = w; } }
        return false;
    }
};
struct EpiBranch {
    static constexpr bool PERM = true;
    const bf16_t* P; bf16_t* ACCb;
    __device__ __forceinline__ bool operator()(Acc& acc, const Unit& u, int wr, int wc, int fr, int fq) const {
        const int row0 = u.pm * BM + wr * 64 + fr, col0 = u.pn * BM + wc * 32 + 8 * fq; const int k = u.k;
        const bf16_t* gbase = P + (size_t)row0 * LDP + GATE2 + k * DM + col0;
#pragma unroll
        for (int ai = 0; ai < 2; ++ai) {
            u32x4 ga[8];
#pragma unroll
            for (int m = 0; m < 4; ++m)
#pragma unroll
                for (int bj = 0; bj < 2; ++bj) ga[m * 2 + bj] = *(const u32x4*)(gbase + (size_t)(ai * HALF + m * 16) * LDP + bj * HALF);
#pragma unroll
            for (int m = 0; m < 4; ++m)
#pragma unroll
                for (int bj = 0; bj < 2; ++bj) { float sr[8]; unpack8(ga[m * 2 + bj], sr);
                    f32x4 v0 = acc[ai][bj][m][0], v1 = acc[ai][bj][m][1];
                    v0[0] *= sr[0]; v0[1] *= sr[1]; v0[2] *= sr[2]; v0[3] *= sr[3]; v1[0] *= sr[4]; v1[1] *= sr[5]; v1[2] *= sr[6]; v1[3] *= sr[7];
                    if (k < 3) { acc[ai][bj][m][0] = v0; acc[ai][bj][m][1] = v1; }
                    else { u32x4 w; w.x = pk2(v0[0], v0[1]); w.y = pk2(v0[2], v0[3]); w.z = pk2(v1[0], v1[1]); w.w = pk2(v1[2], v1[3]); *(u32x4*)(ACCb + (size_t)(row0 + ai * HALF + m * 16) * DM + col0 + bj * HALF) = w; } } }
        return k < 3;
    }
};
struct EpiPartK {
    static constexpr bool PERM = true;
    float* PART;
    __device__ __forceinline__ bool operator()(Acc& acc, const Unit& u, int wr, int wc, int fr, int fq) const {
        const int row0 = u.pm * BM + wr * 64 + fr, col0 = u.pn * BM + wc * 32 + 8 * fq;
        float* pbase = PART + ((size_t)u.k * (NTOK - NLAT) + (size_t)(row0 - NLAT)) * DM + col0;
#pragma unroll
        for (int ai = 0; ai < 2; ++ai)
#pragma unroll
            for (int m = 0; m < 4; ++m)
#pragma unroll
                for (int bj = 0; bj < 2; ++bj) { float* pp = pbase + (size_t)(ai * HALF + m * 16) * DM + bj * HALF; *(f32x4*)pp = acc[ai][bj][m][0]; *(f32x4*)(pp + 4) = acc[ai][bj][m][1]; }
        return false;
    }
};
struct EpiResid {
    static constexpr bool PERM = false;
    float* XS; const float* srcLat; const float* srcCtx; const float* MODl; int gidx;
    __device__ __forceinline__ bool operator()(Acc& acc, const Unit& u, int wr, int wc, int fr, int fq) const {
        const int row0 = u.pm * BM + wr * 64 + fr, col0 = u.pn * BM + wc * 32 + 4 * fq;
        const int r = (u.pm * BM) < NLAT ? (u.pm * BM) / SEQ : 4;
        const float* src = (u.pm * BM) < NLAT ? srcLat : srcCtx;
        const float* mg = MODl + (size_t)(r * 6 + gidx) * DM;
#pragma unroll
        for (int bj = 0; bj < 2; ++bj) {
            f32x4 gm[2], xs[2][2][4];
#pragma unroll
            for (int n = 0; n < 2; ++n) { const int col = col0 + bj * HALF + n * 16; gm[n] = *(const f32x4*)(mg + col);
#pragma unroll
                for (int ai = 0; ai < 2; ++ai)
#pragma unroll
                    for (int m = 0; m < 4; ++m) xs[n][ai][m] = *(const f32x4*)(src + (size_t)(row0 + ai * HALF + m * 16) * DM + col); }
#pragma unroll
            for (int n = 0; n < 2; ++n) { const int col = col0 + bj * HALF + n * 16;
#pragma unroll
                for (int ai = 0; ai < 2; ++ai)
#pragma unroll
                    for (int m = 0; m < 4; ++m) *(f32x4*)(XS + (size_t)(row0 + ai * HALF + m * 16) * DM + col) = xs[n][ai][m] + gm[n] * acc[ai][bj][m][n]; } }
        return false;
    }
};
struct EpiMoe1 {
    static constexpr bool PERM = true;
    bf16_t* HID;
    __device__ __forceinline__ bool operator()(Acc& acc, const Unit& u, int wr, int wc, int fr, int fq) const {
        const size_t row0 = (size_t)u.z * MOE_PAD + u.pm * BM + wr * 64 + fr; const int col0 = u.pn * HALF + wc * 32 + 8 * fq;
#pragma unroll
        for (int ai = 0; ai < 2; ++ai)
#pragma unroll
            for (int m = 0; m < 4; ++m) { const f32x4 g0 = acc[ai][0][m][0], g1 = acc[ai][0][m][1], u0 = acc[ai][1][m][0], u1 = acc[ai][1][m][1];
                float h[8];
#pragma unroll
                for (int j = 0; j < 4; ++j) { h[j] = g0[j] * __builtin_amdgcn_rcpf(1.0f + __expf(-g0[j])) * u0[j]; h[4 + j] = g1[j] * __builtin_amdgcn_rcpf(1.0f + __expf(-g1[j])) * u1[j]; }
                u32x4 w; w.x = pk2(h[0], h[1]); w.y = pk2(h[2], h[3]); w.z = pk2(h[4], h[5]); w.w = pk2(h[6], h[7]);
                *(u32x4*)(HID + (row0 + ai * HALF + m * 16) * DEXP + col0) = w; }
        return false;
    }
};
struct EpiMoeY {
    static constexpr bool PERM = true;
    bf16_t* O;
    __device__ __forceinline__ bool operator()(Acc& acc, const Unit& u, int wr, int wc, int fr, int fq) const {
        const size_t row0 = (size_t)u.z * MOE_PAD + u.pm * BM + wr * 64 + fr; const int col0 = u.pn * BM + wc * 32 + 8 * fq;
#pragma unroll
        for (int ai = 0; ai < 2; ++ai)
#pragma unroll
            for (int m = 0; m < 4; ++m) { bf16_t* rowp = O + (row0 + ai * HALF + m * 16) * DM + col0;
#pragma unroll
                for (int bj = 0; bj < 2; ++bj) { const f32x4 v0 = acc[ai][bj][m][0], v1 = acc[ai][bj][m][1];
                    u32x4 w; w.x = pk2(v0[0], v0[1]); w.y = pk2(v0[2], v0[3]); w.z = pk2(v1[0], v1[1]); w.w = pk2(v1[2], v1[3]);
                    *(u32x4*)(rowp + bj * HALF) = w; } }
        return false;
    }
};

struct SchedS5a {
    int c;
    __device__ __forceinline__ bool next(int i, Unit& u) const { if (i > 0 || c >= 64) return false; u.z = c >> 1; u.pm = c & 1; u.pn = 0; u.k = 0;
        u.ao = ((long long)u.z * 512 + u.pm * BM) * 768 * 2; u.bo = (long long)u.z * 256 * 512 * 2; return true; }
    __device__ __forceinline__ void a_ready(const Unit&) const {}
    __device__ __forceinline__ void done(const Unit&) const {}
};
struct SchedS5b {
    int c;
    __device__ __forceinline__ bool next(int i, Unit& u) const { if (i > 0 || c >= 128) return false; u.z = c >> 2; u.pm = (c >> 1) & 1; u.pn = c & 1; u.k = 0;
        u.ao = ((long long)u.z * 512 + u.pm * BM) * 768 * 2; u.bo = ((long long)u.z * 512 + u.pn * BM) * 768 * 2; return true; }
    __device__ __forceinline__ void a_ready(const Unit&) const {}
    __device__ __forceinline__ void done(const Unit&) const {}
};
struct EpiXloc {
    static constexpr bool PERM = false;
    float* XL;
    __device__ __forceinline__ bool operator()(Acc& acc, const Unit& u, int wr, int wc, int fr, int fq) const {
        const int row0 = u.pm * BM + wr * 64 + fr, col0 = wc * 32 + 4 * fq; float* base = XL + (size_t)u.z * 512 * 256;
#pragma unroll
        for (int ai = 0; ai < 2; ++ai)
#pragma unroll
            for (int m = 0; m < 4; ++m) { float* rowp = base + (size_t)(row0 + ai * HALF + m * 16) * 256 + col0;
#pragma unroll
                for (int bj = 0; bj < 2; ++bj)
#pragma unroll
                    for (int n = 0; n < 2; ++n) *(f32x4*)(rowp + bj * HALF + n * 16) = acc[ai][bj][m][n]; }
        return false;
    }
};
struct EpiS5Out {
    static constexpr bool PERM = true;
    const bf16_t* P; const float* dskip; bf16_t* GG;
    __device__ __forceinline__ bool operator()(Acc& acc, const Unit& u, int wr, int wc, int fr, int fq) const {
        const int row0 = u.pm * BM + wr * 64 + fr, col0 = u.pn * BM + wc * 32 + 8 * fq; const int g = u.z;
#pragma unroll
        for (int bj = 0; bj < 2; ++bj) { const int col = col0 + bj * HALF; const int t = col >> 4, c0 = col & 15;
            const f32x4 d0 = *(const f32x4*)(dskip + g * 16 + c0), d1 = *(const f32x4*)(dskip + g * 16 + c0 + 4);
            u32x4 uq[2][4];
#pragma unroll
            for (int ai = 0; ai < 2; ++ai)
#pragma unroll
                for (int m = 0; m < 4; ++m) uq[ai][m] = *(const u32x4*)(P + ((size_t)(row0 + ai * HALF + m * 16) * 32 + t) * LDP + S5_OFF + g * 16 + c0);
#pragma unroll
            for (int ai = 0; ai < 2; ++ai)
#pragma unroll
                for (int m = 0; m < 4; ++m) { const size_t tok = (size_t)(row0 + ai * HALF + m * 16) * 32 + t;
                    float uu[8]; unpack8(uq[ai][m], uu);
                    const f32x4 v0 = acc[ai][bj][m][0], v1 = acc[ai][bj][m][1];
                    float y[8] = {v0[0] + d0[0] * uu[0], v0[1] + d0[1] * uu[1], v0[2] + d0[2] * uu[2], v0[3] + d0[3] * uu[3], v1[0] + d1[0] * uu[4], v1[1] + d1[1] * uu[5], v1[2] + d1[2] * uu[6], v1[3] + d1[3] * uu[7]};
#pragma unroll
                    for (int j = 0; j < 8; ++j) y[j] = 0.5f * y[j] * (1.0f + tanhf(0.7978845608028654f * (y[j] + 0.044715f * y[j] * y[j] * y[j])));
                    u32x4 w; w.x = pk2(y[0], y[1]); w.y = pk2(y[2], y[3]); w.z = pk2(y[4], y[5]); w.w = pk2(y[6], y[7]);
                    *(u32x4*)(GG + tok * BW + g * 16 + c0) = w; } }
        return false;
    }
};
}


__device__ __forceinline__ float wave_scan_incl(float v, int lane) {
#pragma unroll
    for (int o = 1; o < 64; o <<= 1) { const float t = __shfl_up(v, o); if (lane >= o) v += t; }
    return v;
}
__device__ __forceinline__ float wave_scanmax_incl(float v, int lane) {
#pragma unroll
    for (int o = 1; o < 64; o <<= 1) { const float t = __shfl_up(v, o); if (lane >= o) v = fmaxf(v, t); }
    return v;
}
__device__ __forceinline__ float wave_max(float v) {
#pragma unroll
    for (int o = 32; o >= 1; o >>= 1) v = fmaxf(v, __shfl_xor(v, o));
    return v;
}
__device__ __forceinline__ void unpack8h(const u32x4 w, bf16_t (&h)[8]) {
    h[0] = (bf16_t)(w.x & 0xFFFFu); h[1] = (bf16_t)(w.x >> 16); h[2] = (bf16_t)(w.y & 0xFFFFu); h[3] = (bf16_t)(w.y >> 16);
    h[4] = (bf16_t)(w.z & 0xFFFFu); h[5] = (bf16_t)(w.z >> 16); h[6] = (bf16_t)(w.w & 0xFFFFu); h[7] = (bf16_t)(w.w >> 16);
}

__device__ __forceinline__ int tokblock_of(int b, int dir, int c) { if (c < 4) return 256 + b * 4 + (dir ? 3 - c : c); const int j = c - 4; return b * 64 + (dir ? 63 - j : j); }
__device__ __forceinline__ u32x4 rev8h(const u32x4 v) { u32x4 r; r.x = (v.w >> 16) | (v.w << 16); r.y = (v.z >> 16) | (v.z << 16); r.z = (v.y >> 16) | (v.y << 16); r.w = (v.x >> 16) | (v.x << 16); return r; }
__device__ __forceinline__ u32x4 scale8h(const u32x4 v, const float4 a, const float4 b) { float f[8]; unpack8(v, f); u32x4 r; r.x = pk2(f[0] * a.x, f[1] * a.y); r.y = pk2(f[2] * a.z, f[3] * a.w); r.z = pk2(f[4] * b.x, f[5] * b.y); r.w = pk2(f[6] * b.z, f[7] * b.w); return r; }
__device__ __forceinline__ float dot8h(const u32x4 v, const float4 a, const float4 b) { float f[8]; unpack8(v, f); return (f[0] * a.x + f[1] * a.y) + (f[2] * a.z + f[3] * a.w) + (f[4] * b.x + f[5] * b.y) + (f[6] * b.z + f[7] * b.w); }
#define ML_FRAG_LOAD(KF, VF, cc_) do { const int tb_ = tokblock_of(b, dir, (cc_)); const bf16_t* kb_ = KTg + ((size_t)tb_ * 512 + h * 128 + 32 * wd + r16) * 64 + q4 * 8; const bf16_t* vb_ = VTg + ((size_t)tb_ * 512 + h * 128 + 64 * half + 32 * we + r16) * 64 + q4 * 8; \
        _Pragma("unroll") for (int ks_ = 0; ks_ < 2; ++ks_) _Pragma("unroll") for (int j_ = 0; j_ < 2; ++j_) { VF[j_][ks_] = *(const u32x4*)(vb_ + (size_t)j_ * 16 * 64 + ks_ * 32); KF[j_][ks_] = *(const u32x4*)(kb_ + (size_t)j_ * 16 * 64 + ks_ * 32); } } while (0)
#define ML_CHUNK(c_, KF, VF, KFN, VFN) do { const int c = (c_); \
        if (c + 1 < 68) ML_FRAG_LOAD(KFN, VFN, c + 1);                        \
        const float dec = sDEC[c]; \
        {   bf16_t* cs = CST + (size_t)(chain * 68 + c) * 128 * 128; \
            _Pragma("unroll") for (int je = 0; je < 2; ++je) _Pragma("unroll") for (int jd = 0; jd < 2; ++jd) { const int e = 64 * half + 32 * we + 16 * je + r16, d0 = 32 * wd + 16 * jd + q4 * 4; \
                u32x2 pk; pk.x = pk2(acc[je][jd][0], acc[je][jd][1]); pk.y = pk2(acc[je][jd][2], acc[je][jd][3]); *(u32x2*)(cs + (size_t)e * 128 + d0) = pk; } \
            if (nown) { _Pragma("unroll") for (int jd = 0; jd < 2; ++jd) { float nv = npart[jd]; nv += __shfl_xor(nv, 16); nv += __shfl_xor(nv, 32); if (q4 == 0) NST[(size_t)(chain * 68 + c) * 128 + 32 * wd + 16 * jd + r16] = nv; } } } \
        bf16x8 vfr[2][2]; \
        _Pragma("unroll") for (int ks = 0; ks < 2; ++ks) { const float4 wa = *(const float4*)(sWS + c * 64 + ks * 32 + q4 * 8), wb = *(const float4*)(sWS + c * 64 + ks * 32 + q4 * 8 + 4); \
            _Pragma("unroll") for (int je = 0; je < 2; ++je) { const u32x4 sv = scale8h(VF[je][ks], wa, wb); vfr[je][ks] = *(const bf16x8*)&sv; } \
            if (nown) { _Pragma("unroll") for (int jd = 0; jd < 2; ++jd) npart[jd] = (ks == 0 ? dec * npart[jd] : npart[jd]) + dot8h(KF[jd][ks], wa, wb); } } \
        _Pragma("unroll") for (int je = 0; je < 2; ++je) _Pragma("unroll") for (int jd = 0; jd < 2; ++jd) acc[je][jd] = acc[je][jd] * dec; \
        _Pragma("unroll") for (int ks = 0; ks < 2; ++ks) _Pragma("unroll") for (int je = 0; je < 2; ++je) _Pragma("unroll") for (int jd = 0; jd < 2; ++jd) \
            acc[je][jd] = __builtin_amdgcn_mfma_f32_16x16x32_bf16(*(const bf16x8*)&KF[jd][ks], vfr[je][ks], acc[je][jd], 0, 0, 0); } while (0)
__device__ __forceinline__ void mlstm_state_pass(const int chain, const int half, const bf16_t* __restrict__ Pm, const bf16_t* __restrict__ KTg, const bf16_t* __restrict__ VTg, const float* __restrict__ gate_b,
                                                 bf16_t* __restrict__ CST, float* __restrict__ NST, float* __restrict__ MST, unsigned char* shm, const int tid) {
    const int dir = chain & 1, h = (chain >> 1) & 3, b = chain >> 3, lane = tid & 63, w = tid >> 6, we = w >> 2, wd = w & 3, q4 = lane >> 4, r16 = lane & 15;
    const bool nown = (half == 0) && (we == 0);
    float* sE = (float*)shm; float* sWS = sE + 68 * 64; float* sAL = sWS + 68 * 64; float* sBE = sAL + 68; float* sMO = sBE + 68; float* sDEC = sMO + 68; float* sMB = sDEC + 68;
    const float gbi = gate_b[(dir * 2 + 0) * 4 + h], gbf = gate_b[(dir * 2 + 1) * 4 + h];
    const int gcol_i = ML_OFF + 2048 + (dir * 2 + 0) * 4 + h, gcol_f = ML_OFF + 2048 + (dir * 2 + 1) * 4 + h;
    u32x4 kfA[2][2], vfA[2][2], kfB[2][2], vfB[2][2];
    ML_FRAG_LOAD(kfA, vfA, 0);
    __syncthreads();
    unsigned gi_[9], gf_[9];
#pragma unroll
    for (int q = 0; q < 9; ++q) { const int c = min(w + 8 * q, 67); const size_t tokl = (size_t)step_tok(b, dir, c * 64 + lane); gi_[q] = Pm[tokl * LDP + gcol_i]; gf_[q] = Pm[tokl * LDP + gcol_f]; }
#pragma unroll
    for (int q = 0; q < 9; ++q) { const int c = w + 8 * q; if (c >= 68) break;
        const float ig = __uint_as_float(gi_[q] << 16) + gbi, fg = __uint_as_float(gf_[q] << 16) + gbf;
        const float lf = fminf(fg, 0.f) - log1pf(expf(-fabsf(fg)));
        const float bcs = wave_scan_incl(lf, lane); const float blast = __shfl(bcs, 63); const float ei = blast - bcs + ig; const float beta = wave_max(ei);
        sE[c * 64 + lane] = ei; if (lane == 0) { sAL[c] = blast; sBE[c] = beta; } }
    __syncthreads();
    if (tid == 0) { float m = 0.f; for (int c = 0; c < 68; ++c) { sMB[c] = m; const float mo = fmaxf(m + sAL[c], sBE[c]); sDEC[c] = expf(sAL[c] + m - mo); sMO[c] = mo; m = mo; } }
    __syncthreads();
    for (int idx = tid; idx < 68 * 64; idx += NTHR) { const int c = idx >> 6, i = idx & 63; sWS[c * 64 + (dir ? 63 - i : i)] = expf(sE[idx] - sMO[c]); }
    if (half == 0 && tid < 68) MST[chain * 68 + tid] = sMB[tid];
    __syncthreads();
    f32x4 acc[2][2];
#pragma unroll
    for (int je = 0; je < 2; ++je)
#pragma unroll
        for (int jd = 0; jd < 2; ++jd) acc[je][jd] = (f32x4){0.f, 0.f, 0.f, 0.f};
    float npart[2] = {0.f, 0.f};
    for (int c2 = 0; c2 < 68; c2 += 2) { ML_CHUNK(c2, kfA, vfA, kfB, vfB); ML_CHUNK(c2 + 1, kfB, vfB, kfA, vfA); }
    __syncthreads();
}
#undef ML_CHUNK
#undef ML_FRAG_LOAD
__device__ __forceinline__ void mlstm_out_item(const int chain, const int c, const bf16_t* __restrict__ Pm, const bf16_t* __restrict__ QKb, const bf16_t* __restrict__ VTg, const float* __restrict__ gate_b,
                                               const bf16_t* __restrict__ CST, const float* __restrict__ NST, const float* __restrict__ MST, bf16_t* __restrict__ Hout, unsigned char* shm, const int tid) {
    const int dir = chain & 1, h = (chain >> 1) & 3, b = chain >> 3, lane = tid & 63, w = tid >> 6;
    bf16_t* Qs = (bf16_t*)shm; bf16_t* Ks = (bf16_t*)(shm + 17408); bf16_t* VT = (bf16_t*)(shm + 34816); bf16_t* Cs = (bf16_t*)(shm + 53248); bf16_t* Ss = (bf16_t*)(shm + 88064);
    float* sc = (float*)(shm + 97280);
    __syncthreads();
    u32x4 gq[2], gk[2], gv[2], gc[4]; float gn = 0.f;
#pragma unroll
    for (int i = 0; i < 2; ++i) { const int pid = tid + i * 512; const int s = pid >> 4, x0 = (pid & 15) * 8; const size_t toks = (size_t)step_tok(b, dir, c * 64 + s);
        gq[i] = *(const u32x4*)(QKb + toks * 1024 + h * 128 + x0);
        gk[i] = *(const u32x4*)(QKb + toks * 1024 + 512 + h * 128 + x0);
        { const int e = pid >> 3, o = pid & 7;
          gv[i] = *(const u32x4*)(VTg + ((size_t)tokblock_of(b, dir, c) * 512 + h * 128 + e) * 64 + (dir ? 7 - o : o) * 8); } }
#pragma unroll
    for (int i = 0; i < 4; ++i) { const int pid = tid + i * 512; const int e = pid >> 4, x0 = (pid & 15) * 8;
        gc[i] = *(const u32x4*)(CST + ((size_t)(chain * 68 + c) * 128 + e) * 128 + x0); }
    if (tid < 128) gn = NST[(size_t)(chain * 68 + c) * 128 + tid];
    unsigned gi_ = 0u, gf_ = 0u; float gbi = 0.f, gbf = 0.f, m_in = 0.f;
    if (w == 0) { const size_t tokl = (size_t)step_tok(b, dir, c * 64 + lane);
        gi_ = Pm[tokl * LDP + ML_OFF + 2048 + (dir * 2 + 0) * 4 + h]; gf_ = Pm[tokl * LDP + ML_OFF + 2048 + (dir * 2 + 1) * 4 + h];
        gbi = gate_b[(dir * 2 + 0) * 4 + h]; gbf = gate_b[(dir * 2 + 1) * 4 + h]; m_in = MST[chain * 68 + c]; }
#pragma unroll
    for (int i = 0; i < 2; ++i) { const int pid = tid + i * 512; const int s = pid >> 4, x0 = (pid & 15) * 8;
        *(u32x4*)(Qs + s * 136 + x0) = gq[i]; *(u32x4*)(Ks + s * 136 + x0) = gk[i];
        { const int e = pid >> 3, o = pid & 7; *(u32x4*)(VT + e * 72 + o * 8) = dir ? rev8h(gv[i]) : gv[i]; } }
#pragma unroll
    for (int i = 0; i < 4; ++i) { const int pid = tid + i * 512; const int e = pid >> 4, x0 = (pid & 15) * 8; *(u32x4*)(Cs + e * 136 + x0) = gc[i]; }
    if (tid < 128) sc[384 + tid] = gn;
    if (w == 0) {
        const float ig = __uint_as_float(gi_ << 16) + gbi;
        const float fg = __uint_as_float(gf_ << 16) + gbf;
        const float lf = fminf(fg, 0.f) - log1pf(expf(-fabsf(fg)));
        const float bcs = wave_scan_incl(lf, lane); const float gsv = ig - bcs; const float pm = wave_scanmax_incl(gsv, lane);
        const float mt = bcs + fmaxf(m_in, pm);
        sc[lane] = bcs; sc[64 + lane] = gsv; sc[128 + lane] = mt; sc[192 + lane] = expf(bcs + m_in - mt); sc[256 + lane] = expf(-mt);
    }
    __syncthreads();
    const int tt = w >> 1;
    {   f32x4 aS[2] = {(f32x4){0.f, 0.f, 0.f, 0.f}, (f32x4){0.f, 0.f, 0.f, 0.f}};
#pragma unroll
        for (int ks = 0; ks < 4; ++ks) { const bf16x8 af = *(const bf16x8*)(Qs + (16 * tt + (lane & 15)) * 136 + ks * 32 + (lane >> 4) * 8);
#pragma unroll
            for (int i = 0; i < 2; ++i) { const int st = (w & 1) * 2 + i; const bf16x8 bfr = *(const bf16x8*)(Ks + (16 * st + (lane & 15)) * 136 + ks * 32 + (lane >> 4) * 8);
                aS[i] = __builtin_amdgcn_mfma_f32_16x16x32_bf16(af, bfr, aS[i], 0, 0, 0); } }
        float rs[4] = {0.f, 0.f, 0.f, 0.f};
#pragma unroll
        for (int i = 0; i < 2; ++i) { const int s = 16 * ((w & 1) * 2 + i) + (lane & 15); const float gsv = sc[64 + s];
#pragma unroll
            for (int q = 0; q < 4; ++q) { const int t = 16 * tt + (lane >> 4) * 4 + q; const float val = (s <= t) ? aS[i][q] * expf(sc[t] + gsv - sc[128 + t]) : 0.f; Ss[t * 72 + s] = f2bf(val); rs[q] += val; } }
#pragma unroll
        for (int q = 0; q < 4; ++q) { float r = rs[q]; r += __shfl_xor(r, 1); r += __shfl_xor(r, 2); r += __shfl_xor(r, 4); r += __shfl_xor(r, 8);
            if ((lane & 15) == 0) sc[512 + (w & 1) * 64 + 16 * tt + (lane >> 4) * 4 + q] = r; }
        {   const int t = tid >> 3, part = tid & 7; float dot = 0.f;
#pragma unroll
            for (int j = 0; j < 16; ++j) dot += bf2f(Qs[t * 136 + part * 16 + j]) * sc[384 + part * 16 + j];
            dot += __shfl_xor(dot, 1); dot += __shfl_xor(dot, 2); dot += __shfl_xor(dot, 4);
            if (part == 0) sc[640 + t] = sc[192 + t] * dot; }
    }
    __syncthreads();
    {   f32x4 aN[4];
#pragma unroll
        for (int i = 0; i < 4; ++i) aN[i] = (f32x4){0.f, 0.f, 0.f, 0.f};
#pragma unroll
        for (int ks = 0; ks < 4; ++ks) { const bf16x8 af = *(const bf16x8*)(Qs + (16 * tt + (lane & 15)) * 136 + ks * 32 + (lane >> 4) * 8);
#pragma unroll
            for (int i = 0; i < 4; ++i) { const int et = (w & 1) * 4 + i; const bf16x8 bfr = *(const bf16x8*)(Cs + (16 * et + (lane & 15)) * 136 + ks * 32 + (lane >> 4) * 8);
                aN[i] = __builtin_amdgcn_mfma_f32_16x16x32_bf16(bfr, af, aN[i], 0, 0, 0); } }
        const int t = 16 * tt + (lane & 15);
        {   const float it = sc[192 + t];
#pragma unroll
            for (int i = 0; i < 4; ++i) { aN[i][0] *= it; aN[i][1] *= it; aN[i][2] *= it; aN[i][3] *= it; } }
#pragma unroll
        for (int ks = 0; ks < 2; ++ks) { const bf16x8 af = *(const bf16x8*)(Ss + (16 * tt + (lane & 15)) * 72 + ks * 32 + (lane >> 4) * 8);
#pragma unroll
            for (int i = 0; i < 4; ++i) { const int et = (w & 1) * 4 + i; const bf16x8 bfr = *(const bf16x8*)(VT + (16 * et + (lane & 15)) * 72 + ks * 32 + (lane >> 4) * 8);
                aN[i] = __builtin_amdgcn_mfma_f32_16x16x32_bf16(bfr, af, aN[i], 0, 0, 0); } }
        {   const size_t tokt = (size_t)step_tok(b, dir, c * 64 + t); const float dn = fmaxf(fabsf((sc[512 + t] + sc[576 + t]) + sc[640 + t]), sc[256 + t]);
#pragma unroll
            for (int i = 0; i < 4; ++i) { const int e0 = 16 * ((w & 1) * 4 + i) + (lane >> 4) * 4;
                u32x2 wv; wv.x = pk2(aN[i][0] / dn, aN[i][1] / dn); wv.y = pk2(aN[i][2] / dn, aN[i][3] / dn);
                *(u32x2*)(Hout + tokt * BW + h * 128 + e0) = wv; } }
    }
}


#define SD_FRAG_LOAD(BF, XF, cc_) do { const int tb_ = tokblock_of(b, dir, (cc_)); const bf16_t* bb_ = BTg + ((size_t)tb_ * 256 + grp * 128 + 64 * (w >> 2) + r16) * 64 + q4 * 8; const bf16_t* xb_ = XTg + ((size_t)tb_ * 512 + h * 64 + 16 * (w & 3) + r16) * 64 + q4 * 8; \
        _Pragma("unroll") for (int ks_ = 0; ks_ < 2; ++ks_) { XF[ks_] = *(const u32x4*)(xb_ + ks_ * 32); _Pragma("unroll") for (int j_ = 0; j_ < 4; ++j_) BF[j_][ks_] = *(const u32x4*)(bb_ + (size_t)j_ * 16 * 64 + ks_ * 32); } } while (0)
#define SD_CHUNK(c_, BF, XF, BFN, XFN) do { const int c = (c_); \
        if (c + 1 < 68) SD_FRAG_LOAD(BFN, XFN, c + 1); \
        const float dec = sDEC[c]; \
        {   bf16_t* ss = SSTb + (size_t)(chain * 68 + c) * 64 * 128; const int p = 16 * (w & 3) + r16; \
            _Pragma("unroll") for (int j = 0; j < 4; ++j) { const int n0 = 16 * ((w >> 2) * 4 + j) + q4 * 4; u32x2 pk; pk.x = pk2(acc[j][0], acc[j][1]); pk.y = pk2(acc[j][2], acc[j][3]); *(u32x2*)(ss + (size_t)p * 128 + n0) = pk; } } \
        bf16x8 xfr[2]; \
        _Pragma("unroll") for (int ks = 0; ks < 2; ++ks) { const float4 wa = *(const float4*)(sSC + c * 64 + ks * 32 + q4 * 8), wb = *(const float4*)(sSC + c * 64 + ks * 32 + q4 * 8 + 4); const u32x4 sv = scale8h(XF[ks], wa, wb); xfr[ks] = *(const bf16x8*)&sv; } \
        _Pragma("unroll") for (int j = 0; j < 4; ++j) acc[j] = acc[j] * dec; \
        _Pragma("unroll") for (int ks = 0; ks < 2; ++ks) _Pragma("unroll") for (int j = 0; j < 4; ++j) acc[j] = __builtin_amdgcn_mfma_f32_16x16x32_bf16(*(const bf16x8*)&BF[j][ks], xfr[ks], acc[j], 0, 0, 0); } while (0)
__device__ __forceinline__ void ssd_state_pass(const int chain, const bf16_t* __restrict__ Pm, const bf16_t* __restrict__ BTg, const bf16_t* __restrict__ XTg, const float Aa, const float dtb,
                                               bf16_t* __restrict__ SSTb, unsigned char* shm, const int tid) {
    const int dir = chain & 1, h = (chain >> 1) & 7, b = chain >> 4, grp = h >> 2, lane = tid & 63, w = tid >> 6, q4 = lane >> 4, r16 = lane & 15;
    float* sSC = (float*)shm; float* sDEC = sSC + 68 * 64;
    const int dcol = SSD_OFF + 1536 + dir * 8 + h;
    u32x4 bfA[4][2], xfA[2], bfB[4][2], xfB[2];
    SD_FRAG_LOAD(bfA, xfA, 0);
    __syncthreads();
    unsigned dt_[9];
#pragma unroll
    for (int q = 0; q < 9; ++q) { const int c = min(w + 8 * q, 67); dt_[q] = Pm[(size_t)step_tok(b, dir, c * 64 + lane) * LDP + dcol]; }
#pragma unroll
    for (int q = 0; q < 9; ++q) { const int c = w + 8 * q; if (c >= 68) break;
        const float xv = __uint_as_float(dt_[q] << 16) + dtb; const float dtv = xv > 20.f ? xv : log1pf(expf(xv));
        const float cs = wave_scan_incl(dtv * Aa, lane); const float cl = __shfl(cs, 63);
        sSC[c * 64 + (dir ? 63 - lane : lane)] = dtv * expf(cl - cs); if (lane == 0) sDEC[c] = expf(cl); }
    __syncthreads();
    f32x4 acc[4];
#pragma unroll
    for (int j = 0; j < 4; ++j) acc[j] = (f32x4){0.f, 0.f, 0.f, 0.f};
    for (int c2 = 0; c2 < 68; c2 += 2) { SD_CHUNK(c2, bfA, xfA, bfB, xfB); SD_CHUNK(c2 + 1, bfB, xfB, bfA, xfA); }
    __syncthreads();
}
#undef SD_CHUNK
#undef SD_FRAG_LOAD
__device__ __forceinline__ void ssd_out_item(const int chain, const int c, const bf16_t* __restrict__ Pm, const bf16_t* __restrict__ XBb, const bf16_t* __restrict__ XTg, const float Aa, const float dtb,
                                             const bf16_t* __restrict__ SSTb, bf16_t* __restrict__ Yout, unsigned char* shm, const int tid) {
    const int dir = chain & 1, h = (chain >> 1) & 7, b = chain >> 4, grp = h >> 2, lane = tid & 63, w = tid >> 6;
    bf16_t* Cs = (bf16_t*)shm; bf16_t* Bs = (bf16_t*)(shm + 17408); bf16_t* XT = (bf16_t*)(shm + 34816); bf16_t* Sin = (bf16_t*)(shm + 44032); bf16_t* Gs = (bf16_t*)(shm + 61440);
    float* sc = (float*)(shm + 70656);
    __syncthreads();
    u32x4 gb[2], gcc[2], gs[2], gx; unsigned gd_ = 0u;
#pragma unroll
    for (int i = 0; i < 2; ++i) { const int pid = tid + i * 512; const int s = pid >> 4, x0 = (pid & 15) * 8; const size_t toks = (size_t)step_tok(b, dir, c * 64 + s);
        gb[i] = *(const u32x4*)(XBb + toks * 1024 + 512 + grp * 128 + x0);
        gcc[i] = *(const u32x4*)(XBb + toks * 1024 + 768 + grp * 128 + x0);
        const int p = pid >> 4;
        gs[i] = *(const u32x4*)(SSTb + ((size_t)(chain * 68 + c) * 64 + p) * 128 + x0); }
    {   const int p = tid >> 3, o = tid & 7;
        gx = *(const u32x4*)(XTg + ((size_t)tokblock_of(b, dir, c) * 512 + h * 64 + p) * 64 + (dir ? 7 - o : o) * 8); }
    if (w == 0) gd_ = Pm[(size_t)step_tok(b, dir, c * 64 + lane) * LDP + SSD_OFF + 1536 + dir * 8 + h];
#pragma unroll
    for (int i = 0; i < 2; ++i) { const int pid = tid + i * 512; const int s = pid >> 4, x0 = (pid & 15) * 8;
        *(u32x4*)(Bs + s * 136 + x0) = gb[i]; *(u32x4*)(Cs + s * 136 + x0) = gcc[i]; *(u32x4*)(Sin + s * 136 + x0) = gs[i]; }
    {   const int p = tid >> 3, o = tid & 7; *(u32x4*)(XT + p * 72 + o * 8) = dir ? rev8h(gx) : gx; }
    if (w == 0) {
        const float xv = __uint_as_float(gd_ << 16) + dtb; const float dtv = xv > 20.f ? xv : log1pf(expf(xv));
        sc[lane] = wave_scan_incl(dtv * Aa, lane); sc[64 + lane] = dtv; }
    __syncthreads();
    {   const int lt = w >> 1;
        f32x4 aG[2] = {(f32x4){0.f, 0.f, 0.f, 0.f}, (f32x4){0.f, 0.f, 0.f, 0.f}};
#pragma unroll
        for (int ks = 0; ks < 4; ++ks) { const bf16x8 af = *(const bf16x8*)(Cs + (16 * lt + (lane & 15)) * 136 + ks * 32 + (lane >> 4) * 8);
#pragma unroll
            for (int i = 0; i < 2; ++i) { const int st = (w & 1) * 2 + i; const bf16x8 bfr = *(const bf16x8*)(Bs + (16 * st + (lane & 15)) * 136 + ks * 32 + (lane >> 4) * 8);
                aG[i] = __builtin_amdgcn_mfma_f32_16x16x32_bf16(af, bfr, aG[i], 0, 0, 0); } }
#pragma unroll
        for (int i = 0; i < 2; ++i) { const int s = 16 * ((w & 1) * 2 + i) + (lane & 15); const float css = sc[s], dts = sc[64 + s];
#pragma unroll
            for (int q = 0; q < 4; ++q) { const int t = 16 * lt + (lane >> 4) * 4 + q; const float val = (s <= t) ? aG[i][q] * expf(sc[t] - css) * dts : 0.f; Gs[t * 72 + s] = f2bf(val); } }
    }
    __syncthreads();
    {   const int lt = w >> 1;
        f32x4 aY[2] = {(f32x4){0.f, 0.f, 0.f, 0.f}, (f32x4){0.f, 0.f, 0.f, 0.f}};
#pragma unroll
        for (int ks = 0; ks < 4; ++ks) { const bf16x8 af = *(const bf16x8*)(Cs + (16 * lt + (lane & 15)) * 136 + ks * 32 + (lane >> 4) * 8);
#pragma unroll
            for (int i = 0; i < 2; ++i) { const int pt = (w & 1) * 2 + i; const bf16x8 bfr = *(const bf16x8*)(Sin + (16 * pt + (lane & 15)) * 136 + ks * 32 + (lane >> 4) * 8);
                aY[i] = __builtin_amdgcn_mfma_f32_16x16x32_bf16(bfr, af, aY[i], 0, 0, 0); } }
        const int t = 16 * lt + (lane & 15);
        {   const float ec = expf(sc[t]);
#pragma unroll
            for (int i = 0; i < 2; ++i) { aY[i][0] *= ec; aY[i][1] *= ec; aY[i][2] *= ec; aY[i][3] *= ec; } }
#pragma unroll
        for (int ks = 0; ks < 2; ++ks) { const bf16x8 af = *(const bf16x8*)(Gs + (16 * lt + (lane & 15)) * 72 + ks * 32 + (lane >> 4) * 8);
#pragma unroll
            for (int i = 0; i < 2; ++i) { const int pt = (w & 1) * 2 + i; const bf16x8 bfr = *(const bf16x8*)(XT + (16 * pt + (lane & 15)) * 72 + ks * 32 + (lane >> 4) * 8);
                aY[i] = __builtin_amdgcn_mfma_f32_16x16x32_bf16(bfr, af, aY[i], 0, 0, 0); } }
        {   const size_t tokt = (size_t)step_tok(b, dir, c * 64 + t);
#pragma unroll
            for (int i = 0; i < 2; ++i) { const int p0 = 16 * ((w & 1) * 2 + i) + (lane >> 4) * 4;
                u32x2 wv; wv.x = pk2(aY[i][0], aY[i][1]); wv.y = pk2(aY[i][2], aY[i][3]);
                *(u32x2*)(Yout + tokt * BW + h * 64 + p0) = wv; } }
    }
}


#define FIDX(i) ((i) + ((i) >> 4))
#define FFT_X_BYTES 69632
__device__ constexpr float FFT_CW_RE[6][16] = {{0.f, 0.f, 0.f, 0.f, 0.f, 0.f, 0.f, 0.f, 0.f, 0.f, 0.f, 0.f, 0.f, 0.f, 0.f, 0.f}, {1.0f, 0.f, 0.f, 0.f, 0.f, 0.f, 0.f, 0.f, 0.f, 0.f, 0.f, 0.f, 0.f, 0.f, 0.f, 0.f}, {1.0f, 6.123233995736766e-17f, 0.f, 0.f, 0.f, 0.f, 0.f, 0.f, 0.f, 0.f, 0.f, 0.f, 0.f, 0.f, 0.f, 0.f}, {1.0f, 0.7071067811865476f, 6.123233995736766e-17f, -0.7071067811865475f, 0.f, 0.f, 0.f, 0.f, 0.f, 0.f, 0.f, 0.f, 0.f, 0.f, 0.f, 0.f}, {1.0f, 0.9238795325112867f, 0.7071067811865476f, 0.38268343236508984f, 6.123233995736766e-17f, -0.3826834323650897f, -0.7071067811865475f, -0.9238795325112867f, 0.f, 0.f, 0.f, 0.f, 0.f, 0.f, 0.f, 0.f}, {1.0f, 0.9807852804032304f, 0.9238795325112867f, 0.8314696123025452f, 0.7071067811865476f, 0.5555702330196023f, 0.38268343236508984f, 0.19509032201612833f, 6.123233995736766e-17f, -0.1950903220161282f, -0.3826834323650897f, -0.555570233019602f, -0.7071067811865475f, -0.8314696123025453f, -0.9238795325112867f, -0.9807852804032304f}};
__device__ constexpr float FFT_CW_IM[6][16] = {{0.f, 0.f, 0.f, 0.f, 0.f, 0.f, 0.f, 0.f, 0.f, 0.f, 0.f, 0.f, 0.f, 0.f, 0.f, 0.f}, {-0.0f, 0.f, 0.f, 0.f, 0.f, 0.f, 0.f, 0.f, 0.f, 0.f, 0.f, 0.f, 0.f, 0.f, 0.f, 0.f}, {-0.0f, -1.0f, 0.f, 0.f, 0.f, 0.f, 0.f, 0.f, 0.f, 0.f, 0.f, 0.f, 0.f, 0.f, 0.f, 0.f}, {-0.0f, -0.7071067811865475f, -1.0f, -0.7071067811865476f, 0.f, 0.f, 0.f, 0.f, 0.f, 0.f, 0.f, 0.f, 0.f, 0.f, 0.f, 0.f}, {-0.0f, -0.3826834323650898f, -0.7071067811865475f, -0.9238795325112867f, -1.0f, -0.9238795325112867f, -0.7071067811865476f, -0.3826834323650899f, 0.f, 0.f, 0.f, 0.f, 0.f, 0.f, 0.f, 0.f}, {-0.0f, -0.19509032201612825f, -0.3826834323650898f, -0.5555702330196022f, -0.7071067811865475f, -0.8314696123025452f, -0.9238795325112867f, -0.9807852804032304f, -1.0f, -0.9807852804032304f, -0.9238795325112867f, -0.8314696123025455f, -0.7071067811865476f, -0.5555702330196022f, -0.3826834323650899f, -0.1950903220161286f}};
__host__ __device__ constexpr int fft_bitrev(int k, int R) { int r = 0; for (int i = 0; i < R; ++i) if (k & (1 << i)) r |= 1 << (R - 1 - i); return r; }
template <int R, bool INV>
__device__ __forceinline__ void fft_pass(float2* __restrict__ X, const float2* __restrict__ TW, const int s0, const int gidx) {
    const int lowbits = 13 - s0 - R; const int stride = 1 << lowbits;
    const int low = gidx & (stride - 1), high = gidx >> lowbits; const int base = (high << (lowbits + R)) | low;
    const int p0 = FIDX(base);
#define FFT_SLOT(k) (lowbits >= 4 ? p0 + (k) * (stride + (stride >> 4)) : p0 + (k) + ((k) >> 4))
    float2 v[1 << R];
#pragma unroll
    for (int k = 0; k < (1 << R); ++k) v[k] = X[FFT_SLOT(k)];
    const int lw = low << s0;
    if (!INV) {
#pragma unroll
        for (int j = 0; j < R; ++j) { const int hk = 1 << (R - 1 - j);
#pragma unroll
            for (int k = 0; k < (1 << R); ++k) if (!(k & hk)) { const int kk = k & (hk - 1);
                const float2 a = v[k], b = v[k + hk]; v[k] = make_float2(a.x + b.x, a.y + b.y); const float dx = a.x - b.x, dy = a.y - b.y;
                if (kk == 0) v[k + hk] = make_float2(dx, dy);
                else if (2 * kk == hk) v[k + hk] = make_float2(dy, -dx);
                else { const float cr = FFT_CW_RE[R - j][kk], ci = FFT_CW_IM[R - j][kk]; v[k + hk] = make_float2(dx * cr - dy * ci, dx * ci + dy * cr); } } }
        if (lowbits > 0) {
#pragma unroll
            for (int k = 1; k < (1 << R); ++k) { const float2 w = TW[(lw * fft_bitrev(k, R)) & 8191]; const float2 a = v[k]; v[k] = make_float2(a.x * w.x - a.y * w.y, a.x * w.y + a.y * w.x); } }
    } else {
        if (lowbits > 0) {
#pragma unroll
            for (int k = 1; k < (1 << R); ++k) { const float2 w = TW[(lw * fft_bitrev(k, R)) & 8191]; const float2 a = v[k]; v[k] = make_float2(a.x * w.x + a.y * w.y, a.y * w.x - a.x * w.y); } }
#pragma unroll
        for (int j = R - 1; j >= 0; --j) { const int hk = 1 << (R - 1 - j);
#pragma unroll
            for (int k = 0; k < (1 << R); ++k) if (!(k & hk)) { const int kk = k & (hk - 1);
                const float2 a = v[k], b = v[k + hk]; float tx, ty;
                if (kk == 0) { tx = b.x; ty = b.y; }
                else if (2 * kk == hk) { tx = -b.y; ty = b.x; }
                else { const float cr = FFT_CW_RE[R - j][kk], ci = FFT_CW_IM[R - j][kk]; tx = b.x * cr + b.y * ci; ty = b.y * cr - b.x * ci; }
                v[k] = make_float2(a.x + tx, a.y + ty); v[k + hk] = make_float2(a.x - tx, a.y - ty); } }
    }
#pragma unroll
    for (int k = 0; k < (1 << R); ++k) X[FFT_SLOT(k)] = v[k];
#undef FFT_SLOT
}
__device__ __forceinline__ void fft_fwd(float2* X, const float2* TW, const int tid) {
    fft_pass<4, false>(X, TW, 0, tid); __syncthreads(); fft_pass<4, false>(X, TW, 4, tid); __syncthreads(); if (tid < 256) fft_pass<5, false>(X, TW, 8, tid); __syncthreads(); }
__device__ __forceinline__ void fft_inv(float2* X, const float2* TW, const int tid) {
    if (tid < 256) fft_pass<5, true>(X, TW, 8, tid); __syncthreads(); fft_pass<4, true>(X, TW, 4, tid); __syncthreads(); fft_pass<4, true>(X, TW, 0, tid); __syncthreads(); }
__device__ __forceinline__ void fft_twiddles(float2* TW, const int tid) {
#pragma unroll
    for (int k = 0; k < 16; ++k) { const int m = tid + k * 512; const float xx = (float)m * (1.0f / 4096.0f); TW[m] = make_float2(cospif(xx), -sinpif(xx)); }
}
__device__ __forceinline__ void hyena_spec_item(const int pr, const float* __restrict__ HR, const float* __restrict__ nrm, float2* __restrict__ HSPEC, unsigned char* shm, const int tid) {
    float2* X = (float2*)shm; const float2* TW = (const float2*)(shm + FFT_X_BYTES);
    const int o = pr >> 8, c = (pr & 255) * 2, oc = o * 512 + c; const float inva = 1.0f / nrm[oc], invb = 1.0f / nrm[oc + 1];
    __syncthreads();
    float2 hv[16];
#pragma unroll
    for (int k = 0; k < 16; ++k) { const int j = tid + k * 512;
        const unsigned off = j < SEQ ? (unsigned)j * 2048u + o * 1024 + c : j == SEQ ? (unsigned)(o * 1024 + c) : (unsigned)(2 * SEQ - j) * 2048u + o * 1024 + 512 + c;
        hv[k] = *(const float2*)(HR + off); }
#pragma unroll
    for (int k = 0; k < 16; ++k) { const int j = tid + k * 512; X[FIDX(j)] = j == SEQ ? make_float2(0.f, 0.f) : make_float2(hv[k].x * inva, hv[k].y * invb); }
    __syncthreads();
    fft_fwd(X, TW, tid);
    float4* outa = (float4*)(HSPEC + (size_t)oc * 8192 + tid * 16); float4* outb = (float4*)(HSPEC + (size_t)(oc + 1) * 8192 + tid * 16); const float2* xs = X + 17 * tid;
    const float sc_ = 0.5f / 8192.0f;
#pragma unroll
    for (int k = 0; k < 8; ++k) { float2 ha[2], hb[2];
#pragma unroll
        for (int q = 0; q < 2; ++q) { const int p = 16 * tid + 2 * k + q; const int kf = (int)(__builtin_bitreverse32((unsigned)p) >> 19); const int p2 = (int)(__builtin_bitreverse32((unsigned)((8192 - kf) & 8191)) >> 19);
            const float2 xp = xs[2 * k + q], xq = X[FIDX(p2)];
            ha[q] = make_float2((xp.x + xq.x) * sc_, (xp.y - xq.y) * sc_);
            hb[q] = make_float2((xp.y + xq.y) * sc_, (xq.x - xp.x) * sc_); }
        outa[k] = make_float4(ha[0].x, ha[0].y, ha[1].x, ha[1].y); outb[k] = make_float4(hb[0].x, hb[0].y, hb[1].x, hb[1].y); }
}
__device__ __forceinline__ void fft_mul_spec(float2* X, const float2* __restrict__ H, const int tid) {
    const float4* h4 = (const float4*)(H + tid * 16); float2* xs = X + 17 * tid;
#pragma unroll
    for (int k = 0; k < 8; ++k) { const float4 hv = h4[k]; const float2 x0 = xs[2 * k], x1 = xs[2 * k + 1];
        xs[2 * k] = make_float2(x0.x * hv.x - x0.y * hv.y, x0.x * hv.y + x0.y * hv.x); xs[2 * k + 1] = make_float2(x1.x * hv.z - x1.y * hv.w, x1.x * hv.w + x1.y * hv.z); }
}
__device__ __forceinline__ void hyena_fft_item(const int item, const bf16_t* __restrict__ UT, const float2* __restrict__ HSPEC, const float* __restrict__ bias, float* __restrict__ YT, unsigned char* shm, const int tid) {
    float2* X = (float2*)shm; const float2* TW = (const float2*)(shm + FFT_X_BYTES);
    const int c = item >> 1, b0 = (item & 1) * 2, b1 = b0 + 1;
    const bf16_t* u0 = UT + (size_t)(b0 * 1536 + c) * SEQ + tid * 8; const bf16_t* u1 = UT + (size_t)(b1 * 1536 + c) * SEQ + tid * 8;
    const float bias0 = bias[c], bias1 = bias[512 + c];
    float2* xs = X + FIDX(8 * tid);
    float vr[8], vi[8];
    __syncthreads();
    { const u32x4 a0 = *(const u32x4*)u0, c0 = *(const u32x4*)u1; unpack8(a0, vr); unpack8(c0, vi); }
#pragma unroll
    for (int k = 0; k < 8; ++k) { xs[k] = make_float2(vr[k], vi[k]); xs[4352 + k] = make_float2(0.f, 0.f); }
    __syncthreads();
    fft_fwd(X, TW, tid);
    fft_mul_spec(X, HSPEC + (size_t)c * 8192, tid);
    __syncthreads();
    fft_inv(X, TW, tid);
    { const bf16_t* p0 = u0 + (size_t)512 * SEQ; const bf16_t* p1 = u1 + (size_t)512 * SEQ;
      float xr[8], xi[8]; { const u32x4 a0 = *(const u32x4*)p0, c0 = *(const u32x4*)p1; unpack8(a0, xr); unpack8(c0, xi); }
#pragma unroll
      for (int k = 0; k < 8; ++k) { const float2 cv = xs[k]; const float zr = xr[k] * (cv.x + bias0 * vr[k]), zi = xi[k] * (cv.y + bias0 * vi[k]);
          vr[k] = zr; vi[k] = zi; xs[k] = make_float2(zr, zi); xs[4352 + k] = make_float2(0.f, 0.f); } }
    __syncthreads();
    fft_fwd(X, TW, tid);
    fft_mul_spec(X, HSPEC + (size_t)(512 + c) * 8192, tid);
    __syncthreads();
    fft_inv(X, TW, tid);
    { const bf16_t* p0 = u0 + (size_t)1024 * SEQ; const bf16_t* p1 = u1 + (size_t)1024 * SEQ;
      float xr[8], xi[8]; { const u32x4 a0 = *(const u32x4*)p0, c0 = *(const u32x4*)p1; unpack8(a0, xr); unpack8(c0, xi); }
      float yr[8], yi[8];
#pragma unroll
      for (int k = 0; k < 8; ++k) { const float2 cv = xs[k]; yr[k] = xr[k] * (cv.x + bias1 * vr[k]); yi[k] = xi[k] * (cv.y + bias1 * vi[k]); }
      float* y0 = YT + (size_t)(b0 * 512 + c) * SEQ + tid * 8; float* y1 = YT + (size_t)(b1 * 512 + c) * SEQ + tid * 8;
      *(float4*)y0 = make_float4(yr[0], yr[1], yr[2], yr[3]); *(float4*)(y0 + 4) = make_float4(yr[4], yr[5], yr[6], yr[7]);
      *(float4*)y1 = make_float4(yi[0], yi[1], yi[2], yi[3]); *(float4*)(y1 + 4) = make_float4(yi[4], yi[5], yi[6], yi[7]); }
}

constexpr size_t al256(size_t x) { return (x + 255) & ~(size_t)255; }
constexpr size_t O_BAR = 0;
constexpr size_t O_MOD = 16384;
constexpr size_t O_NORM = O_MOD + al256((size_t)2 * 5 * 6 * DM * 4);
constexpr size_t O_QCTR = O_NORM + al256((size_t)2 * 2 * 1024 * 4);
constexpr size_t O_ZERO_END = O_QCTR + 512;
constexpr size_t O_XS = O_ZERO_END;
constexpr size_t O_HB = O_XS + al256((size_t)NTOK * DM * 4);
constexpr size_t O_P = O_HB + al256((size_t)NTOK * DM * 2);
constexpr size_t O_WIN = O_P + al256((size_t)NTOK * LDP * 2);
constexpr size_t O_WBR = O_WIN + al256((size_t)LDP * DM * 2);
constexpr size_t O_WOUT = O_WBR + al256((size_t)4 * DM * BW * 2);
constexpr size_t O_WGU = O_WOUT + al256((size_t)DM * DM * 2);
constexpr size_t O_WD = O_WGU + al256((size_t)NEXP * 2 * DEXP * DM * 2);
constexpr size_t O_GLU = O_WD + al256((size_t)NEXP * DM * DEXP * 2);
constexpr size_t O_Y4 = O_GLU + al256((size_t)BW * BW * 2);
constexpr size_t O_U = O_Y4 + al256((size_t)NTOK * DM * 2);
constexpr size_t O_QKB = O_U + al256((size_t)NTOK * 1536 * 4);
constexpr size_t O_CST = O_QKB + al256((size_t)NTOK * 1024 * 2);
constexpr size_t O_NST = O_CST + al256((size_t)32 * 68 * 128 * 128 * 2);
constexpr size_t O_MST = O_NST + al256((size_t)32 * 68 * 128 * 4);
constexpr size_t O_XBC = O_MST + al256((size_t)32 * 68 * 4);
constexpr size_t O_SST = O_XBC + al256((size_t)NTOK * 1024 * 2);
constexpr size_t O_HF = O_SST + al256((size_t)64 * 68 * 64 * 128 * 2);
constexpr size_t O_YF = O_HF + al256((size_t)2 * NTOK * BW * 4);
constexpr size_t O_SF = O_YF + al256((size_t)2 * NTOK * BW * 4);
constexpr size_t O_LDT = O_SF + al256((size_t)2 * NCTX * BW * 4);
constexpr size_t O_AP = O_LDT + al256((size_t)4096 * 16);
constexpr size_t O_BBT = O_AP + al256((size_t)4096 * 33 * 8);
constexpr size_t O_KT = O_BBT + al256((size_t)4096 * 16 * 8);
constexpr size_t O_S5A = O_KT + al256((size_t)32 * 2 * 32 * 256 * 4);
constexpr size_t O_S5B = O_S5A + al256((size_t)32 * 512 * 768 * 2);
constexpr size_t O_XCTX = O_S5B + al256((size_t)32 * 512 * 768 * 2);
constexpr size_t O_Z = O_XCTX + al256((size_t)4 * 32 * 2 * 64 * 8);
constexpr size_t O_HRAW = O_Z + al256((size_t)NTOK * BW * 4);
constexpr size_t O_HSPEC = O_HRAW + al256((size_t)(SEQ + CTXL) * 2048 * 4);
constexpr size_t O_K2C = O_HSPEC + al256((size_t)1024 * 8192 * 8);
constexpr size_t O_GG = O_K2C + al256((size_t)(2 * CTXL) * 1024 * 4);
constexpr size_t O_PROBS = O_GG + al256((size_t)NTOK * BW * 2);
constexpr size_t O_ROWTOK = O_PROBS + al256((size_t)NTOK * 16 * 4);
constexpr size_t O_ROWGATE = O_ROWTOK + al256((size_t)NEXP * MOE_PAD * 4);
constexpr size_t O_INV = O_ROWGATE + al256((size_t)NEXP * MOE_PAD * 4);
constexpr size_t O_NORMP = O_INV + al256((size_t)NTOK * 16 * 4);
constexpr size_t WS_END = O_NORMP + al256((size_t)4 * 256 * 2048 * 4);
constexpr size_t O_XG = O_P;
constexpr size_t O_HID = O_P + al256((size_t)NEXP * MOE_PAD * DM * 2);
constexpr size_t O_YEXP = O_HID + al256((size_t)NEXP * MOE_PAD * DEXP * 2);
static_assert(O_YEXP + (size_t)NEXP * MOE_PAD * DM * 2 <= O_WIN, "MoE temporaries must fit inside P");
static_assert((size_t)NTOK * DM * 2 <= (size_t)NTOK * 1536 * 4, "ACCb must fit inside U");
static_assert((size_t)26214400 + (size_t)2 * 17825792 + (size_t)272 * 256 * 64 * 2 <= (size_t)NTOK * DM * 2, "strip buffers must fit inside HB");
static_assert(WS_END <= (size_t)1851000000, "workspace map exceeds the guaranteed size");

struct Args {
    const float* in[47];
    float* out; unsigned char* ws;
    int ph_lo, ph_hi;
};

__device__ __forceinline__ void conv_tile(const float* __restrict__ src, int ldsrc, int nvalid, int k0, int n0, bf16_t* __restrict__ dst, int lddst, int mode, float* T, int tid) {
    { const int n = tid & 63, kr = tid >> 6;
#pragma unroll
      for (int i = 0; i < 8; ++i) { const int k = i * 8 + kr; T[k * 65 + n] = (n0 + n < nvalid) ? src[(size_t)(k0 + k) * ldsrc + n0 + n] : 0.f; } }
    __syncthreads();
    { const int n = tid >> 3, kc = (tid & 7) * 8; const int gn = n0 + n;
      const int drow = mode == 0 ? gn : (32 * (gn >> 4) + (mode == 2 ? 16 : 0) + (gn & 15));
      u32x4 w; w.x = pk2(T[(kc + 0) * 65 + n], T[(kc + 1) * 65 + n]); w.y = pk2(T[(kc + 2) * 65 + n], T[(kc + 3) * 65 + n]);
      w.z = pk2(T[(kc + 4) * 65 + n], T[(kc + 5) * 65 + n]); w.w = pk2(T[(kc + 6) * 65 + n], T[(kc + 7) * 65 + n]);
      *(u32x4*)(dst + (size_t)drow * lddst + k0 + kc) = w; }
    __syncthreads();
}

#define IN(id) (lo <= (id) && (id) < hi)
#define SEAM(id) do { if (hi > (id) + 1) xcd_barrier(bar); } while (0)
#define PH_BEGIN int tid = threadIdx.x; asm volatile("" : "+v"(tid) :: "memory"); const int lane = tid & 63, wave = tid >> 6; (void)lane; (void)wave;

#define x_in (PT(0))
#define c_in (PT(1))
#define ctx_in (PT(2))
#define cctx_in (PT(3))
#define ada_w (PT(4))
#define ada_b (PT(5))
#define norm_mix (PT(6))
#define norm_ffn (PT(7))
#define w_in (PT(8))
#define XS ((float*)(a.ws + O_XS))
#define MOD ((float*)(a.ws + O_MOD))
#define NORM ((float*)(a.ws + O_NORM))
#define NORMP ((float*)(a.ws + O_NORMP))
#define MODl (MOD + (size_t)l * 5 * 6 * DM)
#define HB ((bf16_t*)(a.ws + O_HB))
#define P ((bf16_t*)(a.ws + O_P))
#define WIN ((bf16_t*)(a.ws + O_WIN))
#define WBR ((bf16_t*)(a.ws + O_WBR))
#define WOUT ((bf16_t*)(a.ws + O_WOUT))
#define WGU ((bf16_t*)(a.ws + O_WGU))
#define WD ((bf16_t*)(a.ws + O_WD))
#define GLU ((bf16_t*)(a.ws + O_GLU))
#define Y4 ((bf16_t*)(a.ws + O_Y4))
#define U ((float*)(a.ws + O_U))
#define ACCb ((bf16_t*)(a.ws + O_U))
#define QKB ((bf16_t*)(a.ws + O_QKB))
#define CST ((bf16_t*)(a.ws + O_CST))
#define NST ((float*)(a.ws + O_NST))
#define MST ((float*)(a.ws + O_MST))
#define XBC ((bf16_t*)(a.ws + O_XBC))
#define SSTB ((bf16_t*)(a.ws + O_SST))
#define HF ((bf16_t*)(a.ws + O_HF))
#define HBk (HF + (size_t)NTOK * BW)
#define YF ((bf16_t*)(a.ws + O_YF))
#define YB (YF + (size_t)NTOK * BW)
#define SF ((float*)(a.ws + O_SF))
#define SB (SF + (size_t)NCTX * BW)
#define LDT ((double2*)(a.ws + O_LDT))
#define APW ((float2*)(a.ws + O_AP))
#define BBT ((float2*)(a.ws + O_BBT))
#define KTB ((float*)(a.ws + O_KT))
#define S5A ((bf16_t*)(a.ws + O_S5A))
#define S5B ((bf16_t*)(a.ws + O_S5B))
#define XCTX ((float2*)(a.ws + O_XCTX))
#define S5P ((bf16_t*)(a.ws + O_HB))
#define XLOC ((float*)(a.ws + O_HB + (size_t)32 * 256 * 512 * 2))
#define KTG ((bf16_t*)(a.ws + O_HB + (size_t)26214400))
#define VTG ((bf16_t*)(a.ws + O_HB + (size_t)26214400 + (size_t)17825792))
#define BTG ((bf16_t*)(a.ws + O_HB + (size_t)26214400 + (size_t)2 * 17825792))
#define XTG ((bf16_t*)(a.ws + O_GG))
#define Z ((float*)(a.ws + O_Z))
#define HRAW ((float*)(a.ws + O_HRAW))
#define HSPEC ((float2*)(a.ws + O_HSPEC))
#define UT ((bf16_t*)(a.ws + O_U))
#define YT ((float*)(a.ws + O_Z))
#define QCTR ((int*)(a.ws + O_QCTR))
#define K2C ((float*)(a.ws + O_K2C))
#define GG ((bf16_t*)(a.ws + O_GG))
#define PROBS ((float*)(a.ws + O_PROBS))
#define ROWTOK ((int*)(a.ws + O_ROWTOK))
#define ROWGATE ((float*)(a.ws + O_ROWGATE))
#define XG ((bf16_t*)(a.ws + O_XG))
#define HID ((bf16_t*)(a.ws + O_HID))
#define YEXP ((bf16_t*)(a.ws + O_YEXP))
#define INV ((int*)(a.ws + O_INV))


__device__ __forceinline__ void moe_pair(float4 (&a)[8], const int r1, const int r2, const float g2scale, const int lane, const float* __restrict__ rowgate, const bf16_t* __restrict__ yexp) {
    const float gt1 = rowgate[r1], gt2 = rowgate[r2] * g2scale;
    const bf16_t* y1 = yexp + (size_t)r1 * DM + lane * 4; const bf16_t* y2 = yexp + (size_t)r2 * DM + lane * 4;
    u32x2 w1[8], w2[8];
#pragma unroll
    for (int i = 0; i < 8; ++i) { w1[i] = *(const u32x2*)(y1 + i * 256); w2[i] = *(const u32x2*)(y2 + i * 256); }
#pragma unroll
    for (int i = 0; i < 8; ++i) {
        a[i].x += gt1 * __uint_as_float(w1[i].x << 16); a[i].y += gt1 * __uint_as_float(w1[i].x & 0xFFFF0000u); a[i].z += gt1 * __uint_as_float(w1[i].y << 16); a[i].w += gt1 * __uint_as_float(w1[i].y & 0xFFFF0000u);
        a[i].x += gt2 * __uint_as_float(w2[i].x << 16); a[i].y += gt2 * __uint_as_float(w2[i].x & 0xFFFF0000u); a[i].z += gt2 * __uint_as_float(w2[i].y << 16); a[i].w += gt2 * __uint_as_float(w2[i].y & 0xFFFF0000u); }
}
__device__ __forceinline__ void moe_combine(float4 (&v)[8], const int tok, const int lane, const int* __restrict__ inv, const float* __restrict__ rowgate, const bf16_t* __restrict__ yexp, const float* __restrict__ m5) {
    float4 a[8], mm[8];
#pragma unroll
    for (int i = 0; i < 8; ++i) { a[i] = make_float4(0.f, 0.f, 0.f, 0.f); mm[i] = *(const float4*)(m5 + i * 256 + lane * 4); }
    const int4* ip = (const int4*)(inv + (size_t)tok * 16);
    const int4 q0 = ip[0], q1 = ip[1], q2 = ip[2], q3 = ip[3];
    const int rows[16] = {q0.x, q0.y, q0.z, q0.w, q1.x, q1.y, q1.z, q1.w, q2.x, q2.y, q2.z, q2.w, q3.x, q3.y, q3.z, q3.w};
    int prow = -1;
#pragma unroll
    for (int e = 0; e < 16; ++e) { const int row = __builtin_amdgcn_readfirstlane(rows[e]);
        if (row >= 0) { if (prow >= 0) { moe_pair(a, prow, row, 1.0f, lane, rowgate, yexp); prow = -1; } else prow = row; } }
    if (prow >= 0) moe_pair(a, prow, prow, 0.0f, lane, rowgate, yexp);
#pragma unroll
    for (int i = 0; i < 8; ++i) { v[i].x += mm[i].x * a[i].x; v[i].y += mm[i].y * a[i].y; v[i].z += mm[i].z * a[i].z; v[i].w += mm[i].w * a[i].w; }
}
struct CvU { const float* src; bf16_t* dst; int ldsrc, nvalid, k0, n0, lddst, mode; };
__device__ __forceinline__ void cv_load(const CvU& u, float4 (&r)[8], const int tid) {
#pragma unroll
    for (int i = 0; i < 8; ++i) { const int idx = tid + i * 512; const int k = idx >> 6, n = u.n0 + (idx & 63) * 4;
        r[i] = (n < u.nvalid) ? *(const float4*)(u.src + (size_t)(u.k0 + k) * u.ldsrc + n) : make_float4(0.f, 0.f, 0.f, 0.f); }
}
__device__ __forceinline__ void cv_stage(float* T, const float4 (&r)[8], const int tid) {
#pragma unroll
    for (int i = 0; i < 8; ++i) { const int idx = tid + i * 512; float* p = T + (idx >> 6) * 257 + (idx & 63) * 4; p[0] = r[i].x; p[1] = r[i].y; p[2] = r[i].z; p[3] = r[i].w; }
}
__device__ __forceinline__ void cv_store(const CvU& u, const float* T, const int tid) {
#pragma unroll
    for (int j = 0; j < 4; ++j) { const int o = tid + j * 512; const int kc = (o & 7) * 8, n = o >> 3; const int gn = u.n0 + n;
        int drow = u.mode == 0 ? gn : (256 * (gn >> 7) + (u.mode == 2 ? 128 : 0) + (gn & 127));
        if (u.mode == 3) {
            if (gn >= IN_W) continue;
            drow = gn;
            if (gn >= GATE_OFF) { const int g = gn - GATE_OFF, kb = g >> 11, col = g & 2047, j2 = col >> 6, rem = col & 63;
                drow = GATE2 + 256 * j2 + 128 * (kb >> 1) + 32 * (rem >> 4) + 8 * ((rem >> 2) & 3) + 4 * (kb & 1) + (rem & 3); } }
        const float* t = T + kc * 257 + n;
        u32x4 w; w.x = pk2(t[0], t[257]); w.y = pk2(t[2 * 257], t[3 * 257]); w.z = pk2(t[4 * 257], t[5 * 257]); w.w = pk2(t[6 * 257], t[7 * 257]);
        *(u32x4*)(u.dst + (size_t)drow * u.lddst + u.k0 + kc) = w; }
}
#define CV_RUN(LL, QSTART, QSTEP, QEND) do { \
                const float* wbr = PT(40) + (size_t)(LL) * 4 * BW * DM; const float* wout = PT(41) + (size_t)(LL) * DM * DM; \
                const float* wg = PT(43) + (size_t)(LL) * NEXP * DM * DEXP; const float* wu = PT(44) + (size_t)(LL) * NEXP * DM * DEXP; const float* wd = PT(45) + (size_t)(LL) * NEXP * DEXP * DM; \
                const float* wglu = PT(32) + (size_t)(LL) * BW * BW; const float* win = w_in + (size_t)(LL) * DM * IN_W; \
                const int cv_step = (QSTEP), cv_end = (QEND); \
                __syncthreads(); \
                int q = (QSTART); int buf = 0; CvU u; float4 r[8]; \
                if (q < cv_end) { CV_DECODE(q, u); cv_load(u, r, tid); } \
                while (q < cv_end) { \
                    float* T = sf + buf * (64 * 257); \
                    cv_stage(T, r, tid); \
                    __syncthreads(); \
                    const CvU cur = u; const int qn = q + cv_step; \
                    if (qn < cv_end) { CV_DECODE(qn, u); cv_load(u, r, tid); } \
                    cv_store(cur, T, tid); \
                    buf ^= 1; q = qn; \
                } \
                __syncthreads(); } while (0)
#define CV_DECODE(q_, u_) do { int qq_ = (q_); \
                    if (qq_ < n_win) { u_ = CvU{win, WIN, IN_W, IN_W, (qq_ / 55) * 64, (qq_ % 55) * 256, DM, 3}; } else { qq_ -= n_win; \
                    if (qq_ < n_br) { const int k = qq_ >> 6, r = qq_ & 63; u_ = CvU{wbr + (size_t)k * BW * DM, WBR + (size_t)k * DM * BW, DM, DM, (r >> 3) * 64, (r & 7) * 256, BW, 0}; } else { qq_ -= n_br; \
                    if (qq_ < n_out) { u_ = CvU{wout, WOUT, DM, DM, (qq_ >> 3) * 64, (qq_ & 7) * 256, DM, 0}; } else { qq_ -= n_out; \
                    if (qq_ < n_glu) { u_ = CvU{wglu, GLU, BW, BW, (qq_ >> 1) * 64, (qq_ & 1) * 256, BW, 0}; } else { qq_ -= n_glu; \
                    if (qq_ < n_gu) { const int e = qq_ / 384, r = qq_ % 384, up = r / 192, r2 = r % 192; u_ = CvU{(up ? wu : wg) + (size_t)e * DM * DEXP, WGU + (size_t)e * 2 * DEXP * DM, DEXP, DEXP, (r2 / 6) * 64, (r2 % 6) * 256, DM, 1 + up}; } else { qq_ -= n_gu; \
                    { const int e = qq_ / 192, r = qq_ % 192; u_ = CvU{wd + (size_t)e * DEXP * DM, WD + (size_t)e * DM * DEXP, DM, DM, (r >> 3) * 64, (r & 7) * 256, DEXP, 0}; } } } } } } } while (0)
template <int LAYER>
__device__ __forceinline__ void layer_body(const Args& a, const XcdBarrier& bar, const int lo, const int hi, const int bid, const int G, unsigned char* const shm, float* const sf, const float** const ptab) {
        constexpr int l = LAYER;
        constexpr int PB = 1 + 16 * l;
        const bool lastl = (l == 1);

        const int nPanels = lastl ? 64 : 68;
        const int M2 = nPanels * 256;

        if (IN(PB + 0)) for (int rep_ = 0; rep_ < (l == 0 ? PROBE_REPS(0) : 1); ++rep_) {
            PH_BEGIN
            {   const int n_win = 32 * 55, n_br = 4 * 64, n_out = 32 * 8, n_glu = 16, n_gu = 16 * 2 * 192, n_d = 16 * 192;
                const int n_grp1 = n_win + n_br + n_out + n_glu, total = n_grp1 + n_gu + n_d;
                const int q_lo = (l > 0 && G > 128) ? n_win : 0;
                CV_RUN(l, q_lo + bid, G, total);
                for (int i = bid * NTHR + tid; i < (GATE2 - GATE_OFF) * DM / 8; i += G * NTHR) ((u32x4*)(WIN + (size_t)GATE_OFF * DM))[i] = (u32x4){0u, 0u, 0u, 0u};
            }
            for (int set = 0; set < (lastl ? 1 : 2); ++set) {
                const int L = set ? CTXL : SEQ; float* HR = HRAW + (set ? (size_t)SEQ * 2048 : 0);
                const float* w1 = PT(11) + l * 33 * 64; const float* b1 = PT(12) + l * 64; const float* fr1 = PT(13) + l * 64; const float* w2 = PT(14) + l * 64 * 64; const float* b2 = PT(15) + l * 64;
                const float* fr2 = PT(16) + l * 64; const float* w3 = PT(17) + l * 64 * 2048; const float* decay = PT(18) + l * 2048;
                float* feats = sf; float* h1 = sf + 16 * 33; float* h2 = h1 + 16 * 64;
                float nacc[4] = {0.f, 0.f, 0.f, 0.f};
                for (int base = bid; base < L; base += 16 * G) {
                    __syncthreads();
                    for (int e = tid; e < 16 * 33; e += NTHR) { const int ti = e / 33, fi = e % 33; int t = base + ti * G; if (t > L - 1) t = L - 1;
                        float v;
                        if (fi == 0) v = (float)t / (float)(L - 1);
                        else { const int j = (fi - 1) & 15; const double fr = 1e-4 + (double)j * ((15.0 - 1e-4) / 15.0); const double ang = (2.0 * 3.14159265358979323846 / (double)L) * (double)t * fr; v = fi <= 16 ? (float)cos(ang) : (float)(-sin(ang)); }
                        feats[e] = v; }
                    __syncthreads();
                    { const int j = tid & 63, ti = tid >> 6; float s0 = b1[j], s1 = s0;
_Pragma("unroll 3")
                      for (int i = 0; i < 33; ++i) { const float wv = w1[i * 64 + j]; s0 += feats[ti * 33 + i] * wv; s1 += feats[(ti + 8) * 33 + i] * wv; }
                      const float f1 = fr1[j]; h1[ti * 64 + j] = sinf(f1 * s0); h1[(ti + 8) * 64 + j] = sinf(f1 * s1); }
                    __syncthreads();
                    { const int j = tid & 63, ti = tid >> 6; float s0 = b2[j], s1 = s0;
_Pragma("unroll 4")
                      for (int i = 0; i < 64; ++i) { const float wv = w2[i * 64 + j]; s0 += h1[ti * 64 + i] * wv; s1 += h1[(ti + 8) * 64 + i] * wv; }
                      const float f2 = fr2[j]; h2[ti * 64 + j] = sinf(f2 * s0); h2[(ti + 8) * 64 + j] = sinf(f2 * s1); }
                    __syncthreads();
                    float acc[16][4];
#pragma unroll
                    for (int ti = 0; ti < 16; ++ti) { acc[ti][0] = 0.f; acc[ti][1] = 0.f; acc[ti][2] = 0.f; acc[ti][3] = 0.f; }
#pragma unroll 2
                    for (int i = 0; i < 64; ++i) { const float* wrow = w3 + (size_t)i * 2048 + tid; const float wa = wrow[0], wb = wrow[512], wc2 = wrow[1024], wd2 = wrow[1536];
#pragma unroll
                        for (int ti = 0; ti < 16; ++ti) { const float hv = h2[ti * 64 + i]; acc[ti][0] += hv * wa; acc[ti][1] += hv * wb; acc[ti][2] += hv * wc2; acc[ti][3] += hv * wd2; } }
                    float dk[4];
#pragma unroll
                    for (int k = 0; k < 4; ++k) dk[k] = fabsf(decay[tid + k * 512]);
#pragma unroll
                    for (int ti = 0; ti < 16; ++ti) { const int t = base + ti * G; if (t < L) { const float tn = (float)t / (float)(L - 1);
#pragma unroll
                        for (int k = 0; k < 4; ++k) { const float v = acc[ti][k] * expf(-tn * dk[k]); HR[(size_t)t * 2048 + tid + k * 512] = v; nacc[k] += fabsf(v); } } }
                }
                float* nrp = NORMP + ((size_t)(l * 2 + set) * 256 + bid) * 2048;
#pragma unroll
                for (int k = 0; k < 4; ++k) nrp[tid + k * 512] = nacc[k];
            }
            for (int idx = bid * NTHR + tid; idx < 4096; idx += G * NTHR) { const int n = idx & 63, g = (idx >> 6) & 31, dir = idx >> 11;
                const double are = (double)(PT(24) + l * 4096)[idx], aim = (double)(PT(25) + l * 4096)[idx]; const double lam = are < -1e-4 ? are : -1e-4; const double dt = exp((double)(PT(26) + l * 64)[dir * 32 + g]);
                const double ldre = lam * dt, ldim = aim * dt; LDT[idx] = make_double2(ldre, ldim);
                const double mag = exp(ldre); const double ar = mag * cos(ldim), ai = mag * sin(ldim);
                const double den = lam * lam + aim * aim; const double nr = ar - 1.0, ni = ai; const double fre = (nr * lam + ni * aim) / den, fim = (ni * lam - nr * aim) / den;
                const float* b_re = PT(27) + l * 32 * 64 * 16; const float* b_im = PT(28) + l * 32 * 64 * 16;
#pragma unroll 4
                for (int c = 0; c < 16; ++c) { const double br = (double)b_re[(g * 64 + n) * 16 + c], bi = (double)b_im[(g * 64 + n) * 16 + c]; BBT[idx * 16 + c] = make_float2((float)(fre * br - fim * bi), (float)(fre * bi + fim * br)); }
            }
            for (int e2 = bid * NTHR + tid; e2 < 4096 * 33; e2 += G * NTHR) { const int idx = e2 / 33, k = e2 - idx * 33; const int g = (idx >> 6) & 31, dir = idx >> 11;
                const double are = (double)(PT(24) + l * 4096)[idx], aim = (double)(PT(25) + l * 4096)[idx]; const double lam = are < -1e-4 ? are : -1e-4; const double dt = exp((double)(PT(26) + l * 64)[dir * 32 + g]);
                const double ldre = lam * dt, ldim = aim * dt; const double mk = exp(ldre * k); APW[e2] = make_float2((float)(mk * cos(ldim * k)), (float)(mk * sin(ldim * k))); }
            if (l == 0 && lo == 0) xcd_barrier(bar);
            for (int tok = bid * 8 + wave; tok < NTOK; tok += G * 8) {
                const int r = tok < NLAT ? tok / SEQ : 4; const float* xr = l == 0 ? (tok < NLAT ? x_in + (size_t)tok * DM : ctx_in + (size_t)(tok - NLAT) * DM) : XS + (size_t)tok * DM; const float* gn = norm_mix + l * DM;
                const float* sh = MODl + (size_t)(r * 6 + 0) * DM; const float* sc = MODl + (size_t)(r * 6 + 1) * DM;
                float4 v[8]; float ss = 0.f;
#pragma unroll
                for (int i = 0; i < 8; ++i) v[i] = *(const float4*)(xr + i * 256 + lane * 4);
                if (l > 0) {
                    moe_combine(v, tok, lane, INV, ROWGATE, YEXP, MOD + (size_t)((l - 1) * 5 + r) * 6 * DM + 5 * DM);
#pragma unroll
                    for (int i = 0; i < 8; ++i) *(float4*)(XS + (size_t)tok * DM + i * 256 + lane * 4) = v[i]; }
#pragma unroll
                for (int i = 0; i < 8; ++i) ss += v[i].x * v[i].x + v[i].y * v[i].y + v[i].z * v[i].z + v[i].w * v[i].w;
                ss = wave_sum(ss); const float rs = rsqrtf(ss * (1.0f / DM) + 1e-6f);
#pragma unroll
                for (int i = 0; i < 8; ++i) { const int d = i * 256 + lane * 4; const float4 g4 = *(const float4*)(gn + d), s4 = *(const float4*)(sc + d), h4 = *(const float4*)(sh + d);
                    v[i].x = v[i].x * rs * g4.x * (1.f + s4.x) + h4.x; v[i].y = v[i].y * rs * g4.y * (1.f + s4.y) + h4.y; v[i].z = v[i].z * rs * g4.z * (1.f + s4.z) + h4.z; v[i].w = v[i].w * rs * g4.w * (1.f + s4.w) + h4.w; }
#pragma unroll
                for (int i = 0; i < 8; ++i) { u32x2 w; w.x = pk2(v[i].x, v[i].y); w.y = pk2(v[i].z, v[i].w); *(u32x2*)(HB + (size_t)tok * DM + i * 256 + lane * 4) = w; }
            }
            SEAM(PB + 0);
        }

        if (IN(PB + 1)) for (int rep_ = 0; rep_ < PROBE_REPS(1); ++rep_) {
            PH_BEGIN
            for (int base = bid * 8; base < (lastl ? 1 : 2) * 1024; base += G * 8) {
                const int idx = base + (tid & 7), sl = tid >> 3; const int set = idx >> 10, oc = idx & 1023, o = oc >> 9, c = oc & 511;
                const float* pp = NORMP + (size_t)(l * 2 + set) * 256 * 2048 + o * 1024 + c + (size_t)(sl * 4) * 2048; float sacc = 0.f;
#pragma unroll
                for (int j = 0; j < 4; ++j) { const float p0 = pp[(size_t)j * 2048], p1 = pp[(size_t)j * 2048 + 512]; sacc += (sl * 4 + j < G) ? p0 + p1 : 0.f; }
                sf[sl * 8 + (tid & 7)] = sacc; __syncthreads();
                if (tid < 8) { float t = 0.f;
#pragma unroll 8
                    for (int q = 0; q < 64; ++q) t += sf[q * 8 + tid];
                    NORM[(size_t)(l * 2 + set) * 1024 + oc] = t; }
                __syncthreads(); }
            for (int idx = (G - 1 - bid) * NTHR + tid; idx < 32768; idx += G * NTHR) { const int c = idx & 15, lag = (idx >> 4) & 31, dir = (idx >> 9) & 1, g = idx >> 10;
                const float* c_re = PT(29) + l * 32 * 16 * 64 + (g * 16 + c) * 64; const float* c_im = PT(30) + l * 32 * 16 * 64 + (g * 16 + c) * 64;
                float acc[16];
#pragma unroll
                for (int j = 0; j < 16; ++j) acc[j] = 0.f;
#pragma unroll 2
                for (int n = 0; n < 64; ++n) { const int pi = (dir * 32 + g) * 64 + n; const float2 ap = APW[pi * 33 + lag]; const float cr = c_re[n], ci = c_im[n]; const float wr_ = cr * ap.x - ci * ap.y, wi_ = cr * ap.y + ci * ap.x;
                    const float4* bb = (const float4*)(BBT + pi * 16);
#pragma unroll
                    for (int j = 0; j < 8; ++j) { const float4 b2 = bb[j]; acc[2 * j] += wr_ * b2.x - wi_ * b2.y; acc[2 * j + 1] += wr_ * b2.z - wi_ * b2.w; } }
                float4* o = (float4*)(KTB + (size_t)idx * 16);
                o[0] = make_float4(acc[0], acc[1], acc[2], acc[3]); o[1] = make_float4(acc[4], acc[5], acc[6], acc[7]); o[2] = make_float4(acc[8], acc[9], acc[10], acc[11]); o[3] = make_float4(acc[12], acc[13], acc[14], acc[15]);
            }
            __syncthreads();
            pg8::Gemm g{HB, WIN, DM, DM, DM}; pg8::SchedStd S{68, 55, G, bid, DM, DM}; pg8::EpiWin E{P, LDP};
            pg8::gemm_phase(( LAS unsigned char*)shm, g, S, E);
#if defined(PROBE_BNOEPI)
            { __syncthreads(); pg8::EpiNone E0; pg8::gemm_phase((LAS unsigned char*)shm, g, S, E0); }
#endif
            SEAM(PB + 1);
        }

        if (IN(PB + 2)) for (int rep_ = 0; rep_ < PROBE_REPS(2); ++rep_) {
            PH_BEGIN
            const float* hcw = PT(9) + l * 3 * 1536; const float* hcb = PT(10) + l * 1536; const float* mcw = PT(20) + l * 3 * 1024; const float* mcb = PT(21) + l * 1024;
            const float* scw = PT(34) + l * 3 * 1024; const float* scb = PT(35) + l * 1024;
            for (int unit = bid; unit < 272 * 3; unit += G) { const int seg = unit / 3, kind = unit % 3; const bool lat = seg < 256; const size_t tok0 = lat ? (size_t)seg * 64 : (size_t)NLAT + (size_t)(seg - 256) * 64;
                if (kind < 2) { const int hf = kind;
                    const int c = tid * 2; const int col = (hf ? SSD_OFF + 512 : ML_OFF) + c; const float* w = hf ? scw : mcw; const float* bsp = hf ? scb : mcb; bf16_t* dst = (hf ? XBC : QKB) + tok0 * 1024 + c;
                    const float2 w0 = *(const float2*)(w + c), w1 = *(const float2*)(w + 1024 + c), w2 = *(const float2*)(w + 2048 + c), bb = *(const float2*)(bsp + c);
                    const float osc = (!hf && c >= 512) ? 0.08838834764831845f : 1.0f;
                    const bool hasPrev = !lat && ((tok0 - NLAT) & (CTXL - 1)) != 0, hasNext = !lat && (((tok0 - NLAT) + 63) & (CTXL - 1)) != CTXL - 1;
                    bf16_t* strip = nullptr;
                    if (!hf) { if (c >= 512) strip = KTG + ((size_t)seg * 512 + (c - 512)) * 64; }
                    else { if (c < 512) strip = XTG + ((size_t)seg * 512 + c) * 64; else if (c < 768) strip = BTG + ((size_t)seg * 256 + (c - 512)) * 64; }
                    const bf16_t* pp = P + tok0 * LDP + col;
                    unsigned raw[66];
#pragma unroll
                    for (int t = 0; t < 66; ++t) raw[t] = ((t == 0 && !hasPrev) || (t == 65 && !hasNext)) ? 0u : *(const unsigned*)(pp + (ptrdiff_t)(t - 1) * LDP);
#pragma unroll
                    for (int t8 = 0; t8 < 8; ++t8) { float v0[8], v1[8];
#pragma unroll
                        for (int tt = 0; tt < 8; ++tt) { const int t = t8 * 8 + tt; const unsigned p0 = raw[t], p1 = raw[t + 1], p2 = raw[t + 2];
                            float a0 = bb.x + w0.x * __uint_as_float(p0 << 16) + w1.x * __uint_as_float(p1 << 16) + w2.x * __uint_as_float(p2 << 16);
                            float a1 = bb.y + w0.y * __uint_as_float(p0 & 0xFFFF0000u) + w1.y * __uint_as_float(p1 & 0xFFFF0000u) + w2.y * __uint_as_float(p2 & 0xFFFF0000u);
                            a0 = siluf_(a0) * osc; a1 = siluf_(a1) * osc; v0[tt] = a0; v1[tt] = a1;
                            *(unsigned*)(dst + (size_t)t * 1024) = pk2(a0, a1); }
                        if (strip) { u32x4 s0, s1; s0.x = pk2(v0[0], v0[1]); s0.y = pk2(v0[2], v0[3]); s0.z = pk2(v0[4], v0[5]); s0.w = pk2(v0[6], v0[7]); s1.x = pk2(v1[0], v1[1]); s1.y = pk2(v1[2], v1[3]); s1.z = pk2(v1[4], v1[5]); s1.w = pk2(v1[6], v1[7]);
                            *(u32x4*)(strip + t8 * 8) = s0; *(u32x4*)(strip + 64 + t8 * 8) = s1; } }
                } else {
                    const int c = (tid & 255) * 2, th = tid >> 8; const bf16_t* pp = P + (tok0 + th * 32) * LDP + ML_OFF + 1024 + c; bf16_t* strip = VTG + ((size_t)seg * 512 + c) * 64 + th * 32;
                    unsigned rv[32];
#pragma unroll
                    for (int t = 0; t < 32; ++t) rv[t] = *(const unsigned*)(pp + (size_t)t * LDP);
#pragma unroll
                    for (int t8 = 0; t8 < 4; ++t8) { u32x4 s0, s1;
                        s0.x = (rv[t8 * 8 + 0] & 0xFFFFu) | (rv[t8 * 8 + 1] << 16); s0.y = (rv[t8 * 8 + 2] & 0xFFFFu) | (rv[t8 * 8 + 3] << 16); s0.z = (rv[t8 * 8 + 4] & 0xFFFFu) | (rv[t8 * 8 + 5] << 16); s0.w = (rv[t8 * 8 + 6] & 0xFFFFu) | (rv[t8 * 8 + 7] << 16);
                        s1.x = (rv[t8 * 8 + 0] >> 16) | (rv[t8 * 8 + 1] & 0xFFFF0000u); s1.y = (rv[t8 * 8 + 2] >> 16) | (rv[t8 * 8 + 3] & 0xFFFF0000u); s1.z = (rv[t8 * 8 + 4] >> 16) | (rv[t8 * 8 + 5] & 0xFFFF0000u); s1.w = (rv[t8 * 8 + 6] >> 16) | (rv[t8 * 8 + 7] & 0xFFFF0000u);
                        *(u32x4*)(strip + t8 * 8) = s0; *(u32x4*)(strip + 64 + t8 * 8) = s1; }
                }
            }
            if (!lastl) for (int tok = NLAT + bid; tok < NTOK; tok += G) {
                const int t = (tok - NLAT) & (CTXL - 1); const bool hasL = (t != 0), hasR = (t != CTXL - 1); const bf16_t* pr = P + (size_t)tok * LDP;
                const bf16_t* prL = hasL ? pr - LDP : pr; const bf16_t* prR = hasR ? pr + LDP : pr;
                unsigned xc[3], xl[3], xr[3];
#pragma unroll
                for (int j = 0; j < 3; ++j) { const int cc = tid + j * 512; xc[j] = pr[HY_OFF + cc]; xl[j] = prL[HY_OFF + cc]; xr[j] = prR[HY_OFF + cc]; }
#pragma unroll
                for (int j = 0; j < 3; ++j) { const int cc = tid + j * 512;
                    float acc = hcb[cc] + hcw[1536 + cc] * __uint_as_float(xc[j] << 16);
                    acc += hasL ? hcw[cc] * __uint_as_float(xl[j] << 16) : 0.f;
                    acc += hasR ? hcw[2 * 1536 + cc] * __uint_as_float(xr[j] << 16) : 0.f;
                    U[(size_t)tok * 1536 + cc] = acc; }
            }
            for (int idx0 = bid * NTHR + tid; idx0 < 16384 * 64; idx0 += 4 * G * NTHR) { u32x4 t4[4];
#pragma unroll
                for (int q = 0; q < 4; ++q) { const int idx = idx0 + q * G * NTHR; const int half = idx & 1, g = (idx >> 1) & 31, tok = idx >> 6;
                    if (idx < 16384 * 64) t4[q] = *(const u32x4*)(P + (size_t)tok * LDP + S5_OFF + g * 16 + half * 8); }
#pragma unroll
                for (int q = 0; q < 4; ++q) { const int idx = idx0 + q * G * NTHR; const int half = idx & 1, g = (idx >> 1) & 31, tok = idx >> 6;
                    if (idx < 16384 * 64) *(u32x4*)(S5A + ((size_t)g * 512 + (tok >> 5)) * 768 + (tok & 31) * 16 + half * 8) = t4[q]; } }
            for (int idx = bid * NTHR + tid; idx < 32 * 512 * 32 * 2; idx += G * NTHR) { const int half = idx & 1, sI = (idx >> 1) & 31, row = (idx >> 6) & 511, g = idx >> 15; const int t = row >> 4, c = row & 15; const int lag = t - sI;
                float v[8];
                if (lag > 0) { const float4* k4 = (const float4*)(KTB + ((size_t)((g * 2 + 0) * 32 + lag) * 16 + c) * 16 + half * 8); const float4 a0 = k4[0], a1 = k4[1]; v[0] = a0.x; v[1] = a0.y; v[2] = a0.z; v[3] = a0.w; v[4] = a1.x; v[5] = a1.y; v[6] = a1.z; v[7] = a1.w; }
                else if (lag < 0) { const float4* k4 = (const float4*)(KTB + ((size_t)((g * 2 + 1) * 32 - lag) * 16 + c) * 16 + half * 8); const float4 a0 = k4[0], a1 = k4[1]; v[0] = a0.x; v[1] = a0.y; v[2] = a0.z; v[3] = a0.w; v[4] = a1.x; v[5] = a1.y; v[6] = a1.z; v[7] = a1.w; }
                else { const float4* k4 = (const float4*)(KTB + ((size_t)((g * 2 + 0) * 32) * 16 + c) * 16 + half * 8); const float4* q4 = (const float4*)(KTB + ((size_t)((g * 2 + 1) * 32) * 16 + c) * 16 + half * 8); const float4 a0 = k4[0], a1 = k4[1], b0 = q4[0], b1 = q4[1];
                    v[0] = a0.x + b0.x; v[1] = a0.y + b0.y; v[2] = a0.z + b0.z; v[3] = a0.w + b0.w; v[4] = a1.x + b1.x; v[5] = a1.y + b1.y; v[6] = a1.z + b1.z; v[7] = a1.w + b1.w; }
                u32x4 w; w.x = pk2(v[0], v[1]); w.y = pk2(v[2], v[3]); w.z = pk2(v[4], v[5]); w.w = pk2(v[6], v[7]);
                *(u32x4*)(S5B + ((size_t)g * 512 + row) * 768 + sI * 16 + half * 8) = w; }
            for (int idx = bid * NTHR + tid; idx < 32 * 512 * 64; idx += G * NTHR) { const int n = idx & 63, row = (idx >> 6) & 511, g = idx >> 15; const int t = row >> 4, c = row & 15;
                const float cr = (PT(29) + l * 32 * 16 * 64)[(g * 16 + c) * 64 + n], ci = (PT(30) + l * 32 * 16 * 64)[(g * 16 + c) * 64 + n];
                const float2 af = APW[((0 * 32 + g) * 64 + n) * 33 + t + 1], ab = APW[((1 * 32 + g) * 64 + n) * 33 + 32 - t];
                bf16_t* d = S5B + ((size_t)g * 512 + row) * 768 + 512 + 2 * n;
                *(unsigned*)d = pk2(cr * af.x - ci * af.y, -(cr * af.y + ci * af.x)); *(unsigned*)(d + 128) = pk2(cr * ab.x - ci * ab.y, -(cr * ab.y + ci * ab.x)); }
            for (int idx = bid * NTHR + tid; idx < 32 * 2 * 64 * 32; idx += G * NTHR) { const int sI = idx & 31, n = (idx >> 5) & 63, dir = (idx >> 11) & 1, g = idx >> 12; const int pi = (dir * 32 + g) * 64 + n;
                const float2 pw = APW[pi * 33 + (dir ? sI : 31 - sI)]; const float4* bb = (const float4*)(BBT + pi * 16);
                float re[16], im[16];
#pragma unroll
                for (int j = 0; j < 8; ++j) { const float4 b2 = bb[j]; re[2 * j] = pw.x * b2.x - pw.y * b2.y; im[2 * j] = pw.x * b2.y + pw.y * b2.x; re[2 * j + 1] = pw.x * b2.z - pw.y * b2.w; im[2 * j + 1] = pw.x * b2.w + pw.y * b2.z; }
                bf16_t* d = S5P + ((size_t)g * 256 + dir * 128 + 2 * n) * 512 + sI * 16;
                u32x4 w0, w1; w0.x = pk2(re[0], re[1]); w0.y = pk2(re[2], re[3]); w0.z = pk2(re[4], re[5]); w0.w = pk2(re[6], re[7]); w1.x = pk2(re[8], re[9]); w1.y = pk2(re[10], re[11]); w1.z = pk2(re[12], re[13]); w1.w = pk2(re[14], re[15]);
                *(u32x4*)d = w0; *(u32x4*)(d + 8) = w1;
                w0.x = pk2(im[0], im[1]); w0.y = pk2(im[2], im[3]); w0.z = pk2(im[4], im[5]); w0.w = pk2(im[6], im[7]); w1.x = pk2(im[8], im[9]); w1.y = pk2(im[10], im[11]); w1.z = pk2(im[12], im[13]); w1.w = pk2(im[14], im[15]);
                *(u32x4*)(d + 512) = w0; *(u32x4*)(d + 520) = w1; }
            {   float* T0 = sf; float* T1 = sf + 64 * 65;
                const int NU = 4 * 64 * 24; const int cL = tid & 63, tL = tid >> 6, c = tid >> 3, tq = (tid & 7) * 8;
                for (int unit = bid; unit < NU; unit += 2 * G) { const bool has2 = unit + G < NU; const int unit2 = has2 ? unit + G : unit;
                    const int ba = unit / (64 * 24), ra = (unit / 24) % 64, c0a = (unit % 24) * 64; const size_t toka = (size_t)ba * SEQ + ra * 64;
                    const int bb_ = unit2 / (64 * 24), rb = (unit2 / 24) % 64, c0b = (unit2 % 24) * 64; const size_t tokb = (size_t)bb_ * SEQ + rb * 64;
                    unsigned pa[8], pb[8];
#pragma unroll
                    for (int i = 0; i < 8; ++i) { pa[i] = P[(toka + tL + 8 * i) * LDP + HY_OFF + c0a + cL]; pb[i] = P[(tokb + tL + 8 * i) * LDP + HY_OFF + c0b + cL]; }
                    const int cca = c0a + c, ccb = c0b + c;
                    const float w0a = hcw[cca], w1a = hcw[1536 + cca], w2a = hcw[3072 + cca], bia = hcb[cca], w0b = hcw[ccb], w1b = hcw[1536 + ccb], w2b = hcw[3072 + ccb], bib = hcb[ccb];
                    __syncthreads();
#pragma unroll
                    for (int i = 0; i < 8; ++i) { T0[(tL + 8 * i) * 65 + cL] = __uint_as_float(pa[i] << 16); T1[(tL + 8 * i) * 65 + cL] = __uint_as_float(pb[i] << 16); }
                    __syncthreads();
                    {   float o8[8];
#pragma unroll
                        for (int i = 0; i < 8; ++i) { const int t = tq + i; float acc = bia + w1a * T0[t * 65 + c]; if (t > 0) acc += w0a * T0[(t - 1) * 65 + c]; if (t < 63) acc += w2a * T0[(t + 1) * 65 + c]; o8[i] = acc; }
                        u32x4 wv; wv.x = pk2(o8[0], o8[1]); wv.y = pk2(o8[2], o8[3]); wv.z = pk2(o8[4], o8[5]); wv.w = pk2(o8[6], o8[7]);
                        *(u32x4*)(UT + ((size_t)ba * 1536 + cca) * SEQ + ra * 64 + tq) = wv; }
                    if (has2) { float o8[8];
#pragma unroll
                        for (int i = 0; i < 8; ++i) { const int t = tq + i; float acc = bib + w1b * T1[t * 65 + c]; if (t > 0) acc += w0b * T1[(t - 1) * 65 + c]; if (t < 63) acc += w2b * T1[(t + 1) * 65 + c]; o8[i] = acc; }
                        u32x4 wv; wv.x = pk2(o8[0], o8[1]); wv.y = pk2(o8[2], o8[3]); wv.z = pk2(o8[4], o8[5]); wv.w = pk2(o8[6], o8[7]);
                        *(u32x4*)(UT + ((size_t)bb_ * 1536 + ccb) * SEQ + rb * 64 + tq) = wv; }
                } }
            if (!lastl) {
                const int L = CTXL; const float* HR = HRAW + (size_t)SEQ * 2048; float* K2 = K2C; const float* nrm = NORM + (size_t)(l * 2 + 1) * 1024;
                const size_t total = (size_t)(2 * L - 1) * 1024;
                for (size_t i = (size_t)bid * NTHR + tid; i < total; i += (size_t)G * NTHR) { const int j = (int)(i >> 10), oc = (int)(i & 1023), o = oc >> 9, c = oc & 511; const int lag = j - (L - 1);
                    const float v = lag >= 0 ? HR[(size_t)lag * 2048 + o * 1024 + c] : HR[(size_t)(-lag) * 2048 + o * 1024 + 512 + c];
                    K2[((size_t)j * 2 + o) * 512 + c] = v / nrm[oc]; }
            }
            {   __syncthreads(); fft_twiddles((float2*)(shm + FFT_X_BYTES), tid);
                for (int pr = bid; pr < 512; pr += G) hyena_spec_item(pr, HRAW, NORM + (size_t)(l * 2 + 0) * 1024, HSPEC, shm, tid);
                __syncthreads(); }
            SEAM(PB + 2);
        }

        if (IN(PB + 3)) for (int rep_ = 0; rep_ < PROBE_REPS(3); ++rep_) {
            PH_BEGIN
            if (rep_ > 0) { if (bid == 0 && tid == 0) __hip_atomic_store(QCTR + l * 64, 0, __ATOMIC_RELAXED, __HIP_MEMORY_SCOPE_AGENT); xcd_barrier(bar); }
            if (bid < 64) {
                mlstm_state_pass(bid >> 1, bid & 1, P, KTG, VTG, PT(22) + l * 16, CST, NST, MST, shm, tid);
            } else if (bid < 128) {
                { const int ch = bid - 64; const int dir_ = ch & 1, h_ = (ch >> 1) & 7; ssd_state_pass(ch, P, BTG, XTG, -expf(PT(37)[l * 16 + dir_ * 8 + h_]), PT(36)[l * 16 + dir_ * 8 + h_], SSTB, shm, tid); }
            } else if (bid < 160) {
                const int widx = (bid - 128) * 8 + wave; const int dir = widx & 1, g = (widx >> 1) & 31, b = widx >> 6; const int n = lane;
                float2* xb = (float2*)(shm + (size_t)wave * 16640); float2* ctab = xb + 16 * 65;
                const float* a_re = PT(24) + l * 2 * 32 * 64; const float* a_im = PT(25) + l * 2 * 32 * 64; const float* log_dt = PT(26) + l * 64;
                const float* b_re = PT(27) + l * 32 * 64 * 16; const float* b_im = PT(28) + l * 32 * 64 * 16; const float* c_re = PT(29) + l * 32 * 16 * 64; const float* c_im = PT(30) + l * 32 * 16 * 64;
#pragma unroll
                for (int c = 0; c < 16; ++c) ctab[c * 65 + lane] = make_float2(c_re[(g * 16 + c) * 64 + lane], c_im[(g * 16 + c) * 64 + lane]);
                float abr, abi, bbr[16], bbi[16];
                {   const double are = (double)a_re[(dir * 32 + g) * 64 + n], aim = (double)a_im[(dir * 32 + g) * 64 + n];
                    const double lam = are < -1e-4 ? are : -1e-4; const double dt = exp((double)log_dt[dir * 32 + g]);
                    const double mag = exp(lam * dt); const double ar = mag * cos(aim * dt), ai = mag * sin(aim * dt);
                    const double den = lam * lam + aim * aim; const double nr = ar - 1.0, ni = ai;
                    const double fre = (nr * lam + ni * aim) / den, fim = (ni * lam - nr * aim) / den;
                    abr = (float)ar; abi = (float)ai;
#pragma unroll
                    for (int c = 0; c < 16; ++c) { const double br = (double)b_re[(g * 64 + n) * 16 + c], bi = (double)b_im[(g * 64 + n) * 16 + c]; bbr[c] = (float)(fre * br - fim * bi); bbi[c] = (float)(fre * bi + fim * br); }
                }
                float xr = 0.f, xi = 0.f; float* Sout = (dir ? SB : SF) - (size_t)NLAT * BW;
                const int s = lane >> 2, cg = lane & 3;
                for (int i0 = 0; i0 < CTXL; i0 += 16) {
#pragma unroll 4
                    for (int ss = 0; ss < 16; ++ss) {
                        const size_t tok = (size_t)step_tok(b, dir, i0 + ss);
                        const u32x4* up = (const u32x4*)(P + tok * LDP + S5_OFF + g * 16);
                        float t0[8], t1[8]; unpack8(up[0], t0); unpack8(up[1], t1);
                        float bur = 0.f, bui = 0.f;
#pragma unroll
                        for (int c = 0; c < 8; ++c) { bur += t0[c] * bbr[c] + t1[c] * bbr[8 + c]; bui += t0[c] * bbi[c] + t1[c] * bbi[8 + c]; }
                        const float nxr = abr * xr - abi * xi + bur, nxi = abr * xi + abi * xr + bui; xr = nxr; xi = nxi;
                        xb[ss * 65 + lane] = make_float2(xr, xi);
                    }
                    asm volatile("s_waitcnt lgkmcnt(0)" ::: "memory");
                    float y0 = 0.f, y1 = 0.f, y2 = 0.f, y3 = 0.f;
                    for (int nn2 = 0; nn2 < 64; ++nn2) { const float2 xv = xb[s * 65 + nn2];
                        const float2 c0 = ctab[(cg * 4 + 0) * 65 + nn2], c1 = ctab[(cg * 4 + 1) * 65 + nn2], c2 = ctab[(cg * 4 + 2) * 65 + nn2], c3 = ctab[(cg * 4 + 3) * 65 + nn2];
                        y0 += xv.x * c0.x - xv.y * c0.y; y1 += xv.x * c1.x - xv.y * c1.y; y2 += xv.x * c2.x - xv.y * c2.y; y3 += xv.x * c3.x - xv.y * c3.y; }
                    const size_t toks = (size_t)step_tok(b, dir, i0 + s);
                    *(float4*)(Sout + toks * BW + g * 16 + cg * 4) = make_float4(y0, y1, y2, y3);
                    asm volatile("s_waitcnt lgkmcnt(0)" ::: "memory");
                }
                XCTX[((b * 32 + g) * 2 + dir) * 64 + n] = make_float2(xr, xi);
            } else {
                if (bid < 224) {
                    pg8::Gemm gg_{S5A, S5P, 768, 512, 512}; pg8::SchedS5a S_{bid - 160}; pg8::EpiXloc E_{XLOC};
                    pg8::gemm_phase((LAS unsigned char*)shm, gg_, S_, E_);
                    __syncthreads();
                }
                const int nhb = G - 160, hb = bid - 160; const float* bias = PT(19) + l * 1024; const int c = tid;
                const int nitems = lastl ? 0 : 4 * (CTXL / 8);
                for (int it = hb; it < nitems; it += nhb) {
                    int L, tokbase, b, t0; const float* K2;
                    { const int q = it; L = CTXL; tokbase = NLAT; b = q / (CTXL / 8); t0 = (q % (CTXL / 8)) * 8; K2 = K2C; }
                    const float* zb = U + (size_t)(tokbase + b * L) * 1536 + c;
                    float acc[8];
#pragma unroll
                    for (int i = 0; i < 8; ++i) acc[i] = 0.f;
                    const int base = t0 + L - 1;
                    for (int s = 0; s < L; s += 8) {
                        float k[15];
#pragma unroll
                        for (int mm = 0; mm < 15; ++mm) k[mm] = K2[((size_t)(base - s - 7 + mm) * 2 + 0) * 512 + c];
#pragma unroll
                        for (int ds = 0; ds < 8; ++ds) { const float z = zb[(size_t)(s + ds) * 1536];
#pragma unroll
                            for (int i = 0; i < 8; ++i) acc[i] += k[i - ds + 7] * z; }
                    }
#pragma unroll
                    for (int i = 0; i < 8; ++i) { const size_t tok = (size_t)(tokbase + b * L + t0 + i); const float zt = U[tok * 1536 + c]; Z[tok * BW + c] = (acc[i] + bias[c] * zt) * U[tok * 1536 + 512 + c]; }
                }
            }
            {   __syncthreads(); fft_twiddles((float2*)(shm + FFT_X_BYTES), tid);
                int* qslot = (int*)(shm + FFT_X_BYTES + 65536);
                for (;;) { __syncthreads(); if (tid == 0) *qslot = atomicAdd(QCTR + l * 64, 1); __syncthreads(); const int it = *qslot; if (it >= 1024) break;
                    hyena_fft_item(it, UT, HSPEC, PT(19) + l * 1024, YT, shm, tid); }
            }
            SEAM(PB + 3);
        }

        if (IN(PB + 4)) for (int rep_ = 0; rep_ < PROBE_REPS(4); ++rep_) {
            PH_BEGIN
            if (rep_ > 0) { if (bid == 0 && tid == 0) __hip_atomic_store(QCTR + l * 64 + 32, 0, __ATOMIC_RELAXED, __HIP_MEMORY_SCOPE_AGENT); xcd_barrier(bar); }
            if (bid >= G - 32) for (int idx = (bid - (G - 32)) * NTHR + tid; idx < 16384; idx += 32 * NTHR) { const int n = idx & 63, dir = (idx >> 6) & 1, b = (idx >> 7) & 3, g = idx >> 9;
                const float2 a32 = APW[((dir * 32 + g) * 64 + n) * 33 + 32]; float2 X = XCTX[((b * 32 + g) * 2 + dir) * 64 + n];
                const float* __restrict__ xl = XLOC + ((size_t)g * 512 + b * 128) * 256 + dir * 128 + 2 * n; bf16_t* __restrict__ dst = S5A + ((size_t)g * 512 + b * 128) * 768 + 512 + dir * 128 + 2 * n;
#pragma unroll 1
                for (int j0 = 0; j0 < 128; j0 += 16) { float2 xv[16];
#pragma unroll
                    for (int q = 0; q < 16; ++q) { const int j = dir ? 127 - (j0 + q) : j0 + q; xv[q] = *(const float2*)(xl + (size_t)j * 256); }
#pragma unroll
                    for (int q = 0; q < 16; ++q) { const int j = dir ? 127 - (j0 + q) : j0 + q;
                        *(unsigned*)(dst + (size_t)j * 768) = pk2(X.x, X.y);
                        const float nx = a32.x * X.x - a32.y * X.y + xv[q].x, ny = a32.x * X.y + a32.y * X.x + xv[q].y; X.x = nx; X.y = ny; } } }
            {   int* qslot = (int*)(shm + 102400);
                __syncthreads(); if (tid == 0) *qslot = atomicAdd(QCTR + l * 64 + 32, 1); __syncthreads();
                for (;;) { const int it = *qslot; if (it >= 32 * 68 + 64 * 68) break;
                    int nxt_ = 0; if (tid == 0) nxt_ = atomicAdd(QCTR + l * 64 + 32, 1);
                    if (it < 32 * 68) { const int chain = it / 68, c = it % 68; mlstm_out_item(chain, c, P, QKB, VTG, PT(22) + l * 16, CST, NST, MST, (chain & 1) ? HBk : HF, shm, tid); }
                    else { const int i2 = it - 32 * 68; const int chain = i2 / 68, c = i2 % 68; const int dir_ = chain & 1, h_ = (chain >> 1) & 7;
                        ssd_out_item(chain, c, P, XBC, XTG, -expf(PT(37)[l * 16 + dir_ * 8 + h_]), PT(36)[l * 16 + dir_ * 8 + h_], SSTB, dir_ ? YB : YF, shm, tid); }
                    __syncthreads(); if (tid == 0) *qslot = nxt_; __syncthreads(); }
            }
            __syncthreads();
            {   const float* bias = PT(19) + l * 1024 + 512; const int c = tid;
                const int nitems = lastl ? 0 : 4 * (CTXL / 8);
                for (int it = bid; it < nitems; it += G) {
                    int L, tokbase, b, t0; const float* K2;
                    { const int q = it; L = CTXL; tokbase = NLAT; b = q / (CTXL / 8); t0 = (q % (CTXL / 8)) * 8; K2 = K2C; }
                    const float* zb = Z + (size_t)(tokbase + b * L) * BW + c;
                    float acc[8];
#pragma unroll
                    for (int i = 0; i < 8; ++i) acc[i] = 0.f;
                    const int base = t0 + L - 1;
                    for (int s = 0; s < L; s += 8) {
                        float k[15];
#pragma unroll
                        for (int mm = 0; mm < 15; ++mm) k[mm] = K2[((size_t)(base - s - 7 + mm) * 2 + 1) * 512 + c];
#pragma unroll
                        for (int ds = 0; ds < 8; ++ds) { const float z = zb[(size_t)(s + ds) * BW];
#pragma unroll
                            for (int i = 0; i < 8; ++i) acc[i] += k[i - ds + 7] * z; }
                    }
#pragma unroll
                    for (int i = 0; i < 8; ++i) { const size_t tok = (size_t)(tokbase + b * L + t0 + i); const float zt = Z[tok * BW + c]; Y4[tok * DM + c] = f2bf((acc[i] + bias[c] * zt) * U[tok * 1536 + 1024 + c]); }
                }
            }
            SEAM(PB + 4);
        }

        if (IN(PB + 5)) for (int rep_ = 0; rep_ < PROBE_REPS(5); ++rep_) {
            PH_BEGIN
            const float* ml_norm = PT(23) + l * BW; const float* ssd_d = PT(38) + l * 8; const float* ssd_norm = PT(39) + l * BW; const float* s5_d = PT(31) + l * BW;
            if (bid < 128) {
                pg8::Gemm gg_{S5A, S5B, 768, 768, 768}; pg8::SchedS5b S_{bid}; pg8::EpiS5Out E_{P, s5_d, GG};
                pg8::gemm_phase((LAS unsigned char*)shm, gg_, S_, E_);
                __syncthreads();
            }
            for (int tok = bid * 8 + wave; tok < NTOK; tok += G * 8) {
                const int c0 = lane * 8; const bf16_t* pr = P + (size_t)tok * LDP; const size_t o5 = (size_t)tok * BW + c0;
                float hm[8], ys[8];
                const u32x4 ooq = *(const u32x4*)(pr + ML_OFF + 1536 + c0);
                const float4 g0 = *(const float4*)(ml_norm + c0), g1 = *(const float4*)(ml_norm + c0 + 4), n0 = *(const float4*)(ssd_norm + c0), n1 = *(const float4*)(ssd_norm + c0 + 4);
                { float fa[8], fb[8]; unpack8(*(const u32x4*)(HF + o5), fa); unpack8(*(const u32x4*)(HBk + o5), fb);
#pragma unroll
                  for (int j = 0; j < 8; ++j) hm[j] = fa[j] + fb[j]; }
                { float ya[8], yb[8]; unpack8(*(const u32x4*)(YF + o5), ya); unpack8(*(const u32x4*)(YB + o5), yb);
                  float xx[8], zz[8]; unpack8(*(const u32x4*)(XBC + (size_t)tok * 1024 + c0), xx); unpack8(*(const u32x4*)(pr + SSD_OFF + c0), zz); const float dsk = ssd_d[c0 >> 6];
#pragma unroll
                  for (int j = 0; j < 8; ++j) ys[j] = ya[j] + yb[j];
#pragma unroll
                  for (int j = 0; j < 8; ++j) ys[j] = (ys[j] + dsk * xx[j]) * siluf_(zz[j]); }
                float s1 = 0.f, s2 = 0.f;
#pragma unroll
                for (int j = 0; j < 8; ++j) { s1 += hm[j] * hm[j]; s2 += ys[j] * ys[j]; }
                s1 += __shfl_xor(s1, 1); s1 += __shfl_xor(s1, 2); s1 += __shfl_xor(s1, 4); s1 += __shfl_xor(s1, 8);
                s2 = wave_sum(s2);
                const float r1 = rsqrtf(s1 * (1.0f / 128.0f) + 1e-6f), r2 = rsqrtf(s2 * (1.0f / BW) + 1e-6f);
                float oo[8]; unpack8(ooq, oo);
                const float gm[8] = {g0.x, g0.y, g0.z, g0.w, g1.x, g1.y, g1.z, g1.w}, gs[8] = {n0.x, n0.y, n0.z, n0.w, n1.x, n1.y, n1.z, n1.w};
                u32x4 w;
                w.x = pk2(hm[0] * r1 * gm[0] * sigmoidf_(oo[0]), hm[1] * r1 * gm[1] * sigmoidf_(oo[1])); w.y = pk2(hm[2] * r1 * gm[2] * sigmoidf_(oo[2]), hm[3] * r1 * gm[3] * sigmoidf_(oo[3]));
                w.z = pk2(hm[4] * r1 * gm[4] * sigmoidf_(oo[4]), hm[5] * r1 * gm[5] * sigmoidf_(oo[5])); w.w = pk2(hm[6] * r1 * gm[6] * sigmoidf_(oo[6]), hm[7] * r1 * gm[7] * sigmoidf_(oo[7]));
                *(u32x4*)(Y4 + (size_t)tok * DM + 512 + c0) = w;
                w.x = pk2(ys[0] * r2 * gs[0], ys[1] * r2 * gs[1]); w.y = pk2(ys[2] * r2 * gs[2], ys[3] * r2 * gs[3]); w.z = pk2(ys[4] * r2 * gs[4], ys[5] * r2 * gs[5]); w.w = pk2(ys[6] * r2 * gs[6], ys[7] * r2 * gs[7]);
                *(u32x4*)(Y4 + (size_t)tok * DM + 1536 + c0) = w;
                if (tok >= NLAT) { const size_t oc = (size_t)(tok - NLAT) * BW + c0; float uu[8]; unpack8(*(const u32x4*)(pr + S5_OFF + c0), uu);
                    const float4 a0 = *(const float4*)(SF + oc), a1 = *(const float4*)(SF + oc + 4), b0 = *(const float4*)(SB + oc), b1 = *(const float4*)(SB + oc + 4), d0 = *(const float4*)(s5_d + c0), d1 = *(const float4*)(s5_d + c0 + 4);
                    float y[8] = {a0.x + b0.x + d0.x * uu[0], a0.y + b0.y + d0.y * uu[1], a0.z + b0.z + d0.z * uu[2], a0.w + b0.w + d0.w * uu[3], a1.x + b1.x + d1.x * uu[4], a1.y + b1.y + d1.y * uu[5], a1.z + b1.z + d1.z * uu[6], a1.w + b1.w + d1.w * uu[7]};
#pragma unroll
                    for (int j = 0; j < 8; ++j) y[j] = 0.5f * y[j] * (1.0f + tanhf(0.7978845608028654f * (y[j] + 0.044715f * y[j] * y[j] * y[j])));
                    w.x = pk2(y[0], y[1]); w.y = pk2(y[2], y[3]); w.z = pk2(y[4], y[5]); w.w = pk2(y[6], y[7]);
                    *(u32x4*)(GG + (size_t)tok * BW + c0) = w; }
            }
            __syncthreads();
            {   float* T = sf;
                for (int unit = (G > 128 ? bid - 128 : bid); unit >= 0 && unit < 4 * 64 * 8; unit += (G > 128 ? G - 128 : G)) { const int b = unit / 512, t0 = ((unit >> 3) & 63) * 64, c0 = (unit & 7) * 64;
                    __syncthreads();
#pragma unroll
                    for (int i = 0; i < 8; ++i) { const int t = tid & 63, c = (tid >> 6) + 8 * i; T[c * 65 + t] = YT[((size_t)b * 512 + c0 + c) * SEQ + t0 + t]; }
                    __syncthreads();
                    const int t = tid >> 3, cq = (tid & 7) * 8;
                    u32x4 w; w.x = pk2(T[(cq + 0) * 65 + t], T[(cq + 1) * 65 + t]); w.y = pk2(T[(cq + 2) * 65 + t], T[(cq + 3) * 65 + t]); w.z = pk2(T[(cq + 4) * 65 + t], T[(cq + 5) * 65 + t]); w.w = pk2(T[(cq + 6) * 65 + t], T[(cq + 7) * 65 + t]);
                    *(u32x4*)(Y4 + ((size_t)b * SEQ + t0 + t) * DM + c0 + cq) = w;
                } }
            SEAM(PB + 5);
        }

        if (IN(PB + 6)) for (int rep_ = 0; rep_ < PROBE_REPS(6); ++rep_) {
            PH_BEGIN
            pg8::Gemm g{GG, GLU, BW, BW, BW}; pg8::SchedStd S{68, 2, G, bid, BW, BW}; pg8::EpiGlu E{GG, PT(33) + l * BW, Y4};
            pg8::gemm_phase((LAS unsigned char*)shm, g, S, E);
            SEAM(PB + 6);
        }
        if (IN(PB + 7)) for (int rep_ = 0; rep_ < PROBE_REPS(7); ++rep_) {
            PH_BEGIN
            pg8::Gemm g{Y4, WBR, DM, BW, BW}; pg8::SchedBranch S{64, 8, G, bid}; pg8::EpiBranch E{P, ACCb};
            pg8::gemm_phase((LAS unsigned char*)shm, g, S, E);
            if (!lastl) { __syncthreads(); pg8::SchedTail S2{G, bid}; pg8::EpiPartK E2{(float*)HSPEC}; pg8::gemm_phase((LAS unsigned char*)shm, g, S2, E2); }
            SEAM(PB + 7);
        }
        if (IN(PB + 8)) for (int rep_ = 0; rep_ < PROBE_REPS(8); ++rep_) {
            PH_BEGIN
            if (!lastl) {
                const float* PART = (const float*)HSPEC;
                for (int idx = bid * NTHR + tid; idx < (NTOK - NLAT) * DM / 8; idx += G * NTHR) { const size_t o = (size_t)idx * 8; f32x4 p[4][2];
#pragma unroll
                    for (int k = 0; k < 4; ++k) { p[k][0] = *(const f32x4*)(PART + (size_t)k * (NTOK - NLAT) * DM + o); p[k][1] = *(const f32x4*)(PART + (size_t)k * (NTOK - NLAT) * DM + o + 4); }
                    f32x4 s0 = (f32x4){0.f, 0.f, 0.f, 0.f}, s1 = s0; const bf16_t* rp = P + (size_t)(NLAT + (o >> 11)) * LDP + GATE2 + (o & (DM - 1));
#pragma unroll
                    for (int k = 0; k < 4; ++k) { float rr[8]; unpack8(*(const u32x4*)(rp + k * DM), rr);
                        s0 = s0 + p[k][0]; s1 = s1 + p[k][1]; s0[0] *= rr[0]; s0[1] *= rr[1]; s0[2] *= rr[2]; s0[3] *= rr[3]; s1[0] *= rr[4]; s1[1] *= rr[5]; s1[2] *= rr[6]; s1[3] *= rr[7]; }
                    u32x4 w; w.x = pk2(s0[0], s0[1]); w.y = pk2(s0[2], s0[3]); w.z = pk2(s1[0], s1[1]); w.w = pk2(s1[2], s1[3]);
                    *(u32x4*)(ACCb + (size_t)NLAT * DM + o) = w; }
                xcd_barrier(bar);
            }
            pg8::Gemm g{ACCb, WOUT, DM, DM, DM}; pg8::SchedStd S{64, 8, G, bid, DM, DM}; pg8::EpiResid E{XS, l == 0 ? x_in : (const float*)XS, l == 0 ? ctx_in - (size_t)NLAT * DM : (const float*)XS, MODl, 2};
            pg8::gemm_phase((LAS unsigned char*)shm, g, S, E);
            if (!lastl) { __syncthreads(); pg8::Gemm g2{ACCb, WOUT, DM, DM, 512}; pg8::SchedTailK S2{G, bid}; pg8::EpiPartK E2{(float*)HSPEC + (size_t)4 * (NTOK - NLAT) * DM}; pg8::gemm_phase((LAS unsigned char*)shm, g2, S2, E2); }
            SEAM(PB + 8);
        }
        if (IN(PB + 9)) for (int rep_ = 0; rep_ < PROBE_REPS(9); ++rep_) {
            PH_BEGIN
            if (!lastl) {
                const float* PART = (const float*)HSPEC + (size_t)4 * (NTOK - NLAT) * DM; const float* mg = MODl + (size_t)(4 * 6 + 2) * DM;
                const float* src = l == 0 ? ctx_in : (const float*)XS + (size_t)NLAT * DM;
                for (int idx = bid * NTHR + tid; idx < (NTOK - NLAT) * DM / 4; idx += G * NTHR) { const size_t o = (size_t)idx * 4; const int col = (int)(o & (DM - 1));
                    const f32x4 p0 = *(const f32x4*)(PART + o), p1 = *(const f32x4*)(PART + (size_t)(NTOK - NLAT) * DM + o), p2 = *(const f32x4*)(PART + (size_t)2 * (NTOK - NLAT) * DM + o), p3 = *(const f32x4*)(PART + (size_t)3 * (NTOK - NLAT) * DM + o);
                    const f32x4 sv = *(const f32x4*)(src + o), gm = *(const f32x4*)(mg + col);
                    *(f32x4*)(XS + (size_t)NLAT * DM + o) = sv + gm * (((p0 + p1) + p2) + p3); }
                xcd_barrier(bar);
            }
            for (int i = bid * NTHR + tid; i < NEXP * MOE_PAD; i += G * NTHR) ROWTOK[i] = -1;
            for (int i = bid * NTHR + tid; i < NTOK * 16; i += G * NTHR) INV[i] = -1;
            const float* wr = PT(42) + (size_t)l * DM * 16; const float* gn = norm_ffn + l * DM;
            float* wl = sf;
            __syncthreads();
#pragma unroll 1
            for (int q0 = 0; q0 < 16; q0 += 4) {
                const float4 a0 = ((const float4*)wr)[(q0 + 0) * 512 + tid], a1 = ((const float4*)wr)[(q0 + 1) * 512 + tid], a2 = ((const float4*)wr)[(q0 + 2) * 512 + tid], a3 = ((const float4*)wr)[(q0 + 3) * 512 + tid];
                { const int f4 = (q0 + 0) * 512 + tid; *(float4*)(wl + (size_t)(f4 >> 4) * 68 + (f4 & 15) * 4) = a0; }
                { const int f4 = (q0 + 1) * 512 + tid; *(float4*)(wl + (size_t)(f4 >> 4) * 68 + (f4 & 15) * 4) = a1; }
                { const int f4 = (q0 + 2) * 512 + tid; *(float4*)(wl + (size_t)(f4 >> 4) * 68 + (f4 & 15) * 4) = a2; }
                { const int f4 = (q0 + 3) * 512 + tid; *(float4*)(wl + (size_t)(f4 >> 4) * 68 + (f4 & 15) * 4) = a3; } }
            __syncthreads();
            for (int tok0 = (bid * 8 + wave) * 4; tok0 < M2; tok0 += G * 32) {
                const int r = tok0 < NLAT ? tok0 / SEQ : 4; const float* xr = XS + (size_t)tok0 * DM;
                const float* sh = MODl + (size_t)(r * 6 + 3) * DM; const float* sc = MODl + (size_t)(r * 6 + 4) * DM;
                float rs[4];
#pragma unroll
                for (int tk = 0; tk < 4; ++tk) { float ss = 0.f;
#pragma unroll 4
                    for (int i = 0; i < 8; ++i) { const float4 t4 = *(const float4*)(xr + (size_t)tk * DM + i * 256 + lane * 4); ss += t4.x * t4.x + t4.y * t4.y + t4.z * t4.z + t4.w * t4.w; }
                    ss = wave_sum(ss); rs[tk] = rsqrtf(ss * (1.0f / DM) + 1e-6f); }
                float lg[4][16];
#pragma unroll
                for (int tk = 0; tk < 4; ++tk)
#pragma unroll
                    for (int e = 0; e < 16; ++e) lg[tk][e] = 0.f;
#pragma unroll 1
                for (int i = 0; i < 8; ++i) { const int d = i * 256 + lane * 4;
                    const float4 g4 = *(const float4*)(gn + d), s4 = *(const float4*)(sc + d), h4 = *(const float4*)(sh + d);
                    float4 xq[4], ww[16];
#pragma unroll
                    for (int tk = 0; tk < 4; ++tk) xq[tk] = *(const float4*)(xr + (size_t)tk * DM + d);
                    const float4* wq = (const float4*)(wl + (size_t)(i * 64 + lane) * 68);
#pragma unroll
                    for (int q = 0; q < 16; ++q) ww[q] = wq[q];
                    float hv[4][4];
#pragma unroll
                    for (int tk = 0; tk < 4; ++tk) { const float4 xv = xq[tk]; const float rr = rs[tk];
                        hv[tk][0] = xv.x * rr * g4.x * (1.f + s4.x) + h4.x; hv[tk][1] = xv.y * rr * g4.y * (1.f + s4.y) + h4.y; hv[tk][2] = xv.z * rr * g4.z * (1.f + s4.z) + h4.z; hv[tk][3] = xv.w * rr * g4.w * (1.f + s4.w) + h4.w;
                        u32x2 w; w.x = pk2(hv[tk][0], hv[tk][1]); w.y = pk2(hv[tk][2], hv[tk][3]); *(u32x2*)(HB + (size_t)(tok0 + tk) * DM + d) = w; }
#pragma unroll
                    for (int q = 0; q < 4; ++q) { const float4 w0 = ww[q * 4 + 0], w1 = ww[q * 4 + 1], w2 = ww[q * 4 + 2], w3 = ww[q * 4 + 3];
#pragma unroll
                        for (int tk = 0; tk < 4; ++tk) { const float hq = hv[tk][q];
                            lg[tk][0] += hq * w0.x; lg[tk][1] += hq * w0.y; lg[tk][2] += hq * w0.z; lg[tk][3] += hq * w0.w; lg[tk][4] += hq * w1.x; lg[tk][5] += hq * w1.y; lg[tk][6] += hq * w1.z; lg[tk][7] += hq * w1.w;
                            lg[tk][8] += hq * w2.x; lg[tk][9] += hq * w2.y; lg[tk][10] += hq * w2.z; lg[tk][11] += hq * w2.w; lg[tk][12] += hq * w3.x; lg[tk][13] += hq * w3.y; lg[tk][14] += hq * w3.z; lg[tk][15] += hq * w3.w; } } }
#pragma unroll
                for (int tk = 0; tk < 4; ++tk) { float mx = -1e30f;
#pragma unroll
                    for (int e = 0; e < 16; ++e) { lg[tk][e] = wave_sum(lg[tk][e]); mx = fmaxf(mx, lg[tk][e]); }
                    float sm = 0.f;
#pragma unroll
                    for (int e = 0; e < 16; ++e) { lg[tk][e] = expf(lg[tk][e] - mx); sm += lg[tk][e]; }
                    const float inv = 1.0f / sm;
                    if (lane == 0) {
#pragma unroll
                        for (int e = 0; e < 16; e += 4) *(float4*)(PROBS + (size_t)(tok0 + tk) * 16 + e) = make_float4(lg[tk][e] * inv, lg[tk][e + 1] * inv, lg[tk][e + 2] * inv, lg[tk][e + 3] * inv); } }
            }
            SEAM(PB + 9);
        }
        if (IN(PB + 10)) for (int rep_ = 0; rep_ < PROBE_REPS(10); ++rep_) {
            PH_BEGIN
            const int nitems = 64 + (lastl ? 0 : 64);
            unsigned long long* keys = (unsigned long long*)shm;
            for (int it = bid; it < nitems; it += G) {
                const int set = it >> 6, e = it & 15, b = (it >> 4) & 3;
                const int n = set ? CTXL : SEQ, cap = set ? 32 : 512, tokbase = set ? NLAT + b * CTXL : b * SEQ;
                __syncthreads();
                for (int i = tid; i < n; i += NTHR) keys[i] = ((unsigned long long)__float_as_uint(PROBS[(size_t)(tokbase + i) * 16 + e]) << 32) | (unsigned long long)(0xFFFFFFFFu - (unsigned)i);
                __syncthreads();
                for (int k = 2; k <= n; k <<= 1)
                    for (int j = k >> 1; j > 0; j >>= 1) {
                        for (int p = tid; p < (n >> 1); p += NTHR) { const int i = ((p & ~(j - 1)) << 1) | (p & (j - 1)); const int m = i | j;
                            const unsigned long long ka = keys[i], kb = keys[m]; const bool desc = ((i & k) == 0);
                            if ((ka < kb) == desc) { keys[i] = kb; keys[m] = ka; } }
                        __syncthreads();
                    }
                for (int r = tid; r < cap; r += NTHR) { const unsigned long long kk = keys[r]; const int row = e * MOE_PAD + (set ? 2048 + b * 32 + r : b * 512 + r);
                    const int tk_ = tokbase + (int)(0xFFFFFFFFu - (unsigned)(kk & 0xFFFFFFFFull)); ROWTOK[row] = tk_; ROWGATE[row] = __uint_as_float((unsigned)(kk >> 32)); INV[tk_ * 16 + e] = row; }
                for (int rb = 0; rb < cap; rb += 32) {
                    u32x4 t4[4][4];
#pragma unroll
                    for (int q = 0; q < 4; ++q) { const int r = rb + wave + 8 * q; const int tok = tokbase + (int)(0xFFFFFFFFu - (unsigned)(keys[r] & 0xFFFFFFFFull));
                        const u32x4* sp = (const u32x4*)(HB + (size_t)tok * DM);
#pragma unroll
                        for (int i = 0; i < 4; ++i) t4[q][i] = sp[i * 64 + lane]; }
#pragma unroll
                    for (int q = 0; q < 4; ++q) { const int r = rb + wave + 8 * q; const int row = e * MOE_PAD + (set ? 2048 + b * 32 + r : b * 512 + r);
                        u32x4* dp = (u32x4*)(XG + (size_t)row * DM);
#pragma unroll
                        for (int i = 0; i < 4; ++i) dp[i * 64 + lane] = t4[q][i]; } }
            }
            if (!lastl && G > 128 && bid >= 128) {
                const int n_win = 32 * 55, n_br = 4 * 64, n_out = 32 * 8, n_glu = 16, n_gu = 16 * 2 * 192; (void)n_gu;
                CV_RUN(l + 1, bid - 128, G - 128, n_win); (void)n_br; (void)n_out; (void)n_glu;
            }
            {   const int pad0 = lastl ? 2048 : MOE_ROWS, npad = MOE_PAD - pad0;
                for (int R = bid * 8 + wave; R < NEXP * npad; R += G * 8) { const int e = R / npad, rr = pad0 + R % npad; u32x4* dp = (u32x4*)(XG + ((size_t)e * MOE_PAD + rr) * DM);
#pragma unroll
                    for (int i = 0; i < 4; ++i) dp[i * 64 + lane] = (u32x4){0u, 0u, 0u, 0u}; } }
            SEAM(PB + 10);
        }
        if (IN(PB + 12)) for (int rep_ = 0; rep_ < PROBE_REPS(12); ++rep_) {
            PH_BEGIN
            pg8::Gemm g{XG, WGU, DM, DM, DM}; pg8::SchedMoe S{lastl ? 8 : 9, 12, G, bid, DM, DM, 2 * DEXP}; pg8::EpiMoe1 E{HID};
            pg8::gemm_phase((LAS unsigned char*)shm, g, S, E);
            SEAM(PB + 12);
        }
        if (IN(PB + 13)) for (int rep_ = 0; rep_ < PROBE_REPS(13); ++rep_) {
            PH_BEGIN
            pg8::Gemm g{HID, WD, DEXP, DEXP, DEXP}; pg8::SchedMoe S{lastl ? 8 : 9, 8, G, bid, DEXP, DEXP, DM}; pg8::EpiMoeY E{YEXP};
            pg8::gemm_phase((LAS unsigned char*)shm, g, S, E);
            SEAM(PB + 13);
        }

}

__global__ __launch_bounds__(NTHR, 2) void fwd(Args a) {
    extern __shared__ __attribute__((aligned(16))) unsigned char shm[];
    const int bid = blockIdx.x, G = gridDim.x;
    float* const sf = (float*)shm;
    volatile LAS unsigned* xbw = (volatile LAS unsigned*)((LAS unsigned char*)shm + (LDS_BYTES - 16));
    if (threadIdx.x == 0) { xbw[0] = 0u; xbw[1] = 0u; xbw[2] = 0u; xbw[3] = 0u; }
    const float** const ptab = (const float**)(shm + (LDS_BYTES - 16 - 512));
    if (threadIdx.x == 0) {
#pragma unroll
        for (int i = 0; i < 47; ++i) ptab[i] = a.in[i]; }
    __syncthreads();
    XcdBarrier bar = xcd_barrier_post((unsigned*)(a.ws + O_BAR), xbw);
    const int lo = a.ph_lo, hi = a.ph_hi;
    if (IN(0)) {
        PH_BEGIN
        {
            __syncthreads();
            for (int i = tid; i < 5 * DM; i += NTHR) { const int r = i >> 11, k = i & (DM - 1); const float v = r < 4 ? c_in[r * DM + k] : cctx_in[k]; sf[i] = siluf_(v); }
            __syncthreads();
            float* red = sf + 5 * DM;
            for (int unit = bid; unit < 2 * 96; unit += G) { const int l = unit / 96, j = (unit % 96) * 128 + (tid & 127), kq = tid >> 7;
                const float* w = ada_w + (size_t)l * DM * (6 * DM) + (size_t)(kq * 512) * (6 * DM) + j; const float* sv = sf + kq * 512;
                float a0 = 0.f, a1 = 0.f, a2 = 0.f, a3 = 0.f, a4 = 0.f;
#pragma unroll 8
                for (int k = 0; k < 512; ++k) { const float wv = w[(size_t)k * (6 * DM)]; a0 += sv[k] * wv; a1 += sv[DM + k] * wv; a2 += sv[2 * DM + k] * wv; a3 += sv[3 * DM + k] * wv; a4 += sv[4 * DM + k] * wv; }
                __syncthreads();
                { float* rp = red + (kq * 5) * 128 + (tid & 127); rp[0] = a0; rp[128] = a1; rp[256] = a2; rp[384] = a3; rp[512] = a4; }
                __syncthreads();
                if (tid < 128) { const float bb = ada_b[l * 6 * DM + j]; float* o = MOD + (size_t)l * 5 * 6 * DM + j;
#pragma unroll
                    for (int r = 0; r < 5; ++r) o[(size_t)r * 6 * DM] = ((red[(0 * 5 + r) * 128 + tid] + red[(1 * 5 + r) * 128 + tid]) + (red[(2 * 5 + r) * 128 + tid] + red[(3 * 5 + r) * 128 + tid])) + bb; }
            }
        }
    }

    layer_body<0>(a, bar, lo, hi, bid, G, shm, sf, ptab);
    layer_body<1>(a, bar, lo, hi, bid, G, shm, sf, ptab);
    if (IN(33)) {
        PH_BEGIN
        const float* gn = PT(46);
        for (int tok = bid * 8 + wave; tok < NLAT; tok += G * 8) {
            const float* xr = XS + (size_t)tok * DM; float4 v[8]; float ss = 0.f;
#pragma unroll
            for (int i = 0; i < 8; ++i) v[i] = *(const float4*)(xr + i * 256 + lane * 4);
            moe_combine(v, tok, lane, INV, ROWGATE, YEXP, MOD + (size_t)(1 * 5 + tok / SEQ) * 6 * DM + 5 * DM);
#pragma unroll
            for (int i = 0; i < 8; ++i) {                 ss += v[i].x * v[i].x + v[i].y * v[i].y + v[i].z * v[i].z + v[i].w * v[i].w; }
            ss = wave_sum(ss); const float rs = rsqrtf(ss * (1.0f / DM) + 1e-6f);
#pragma unroll
            for (int i = 0; i < 8; ++i) { const int d = i * 256 + lane * 4; const float4 g4 = *(const float4*)(gn + d);
                *(float4*)(a.out + (size_t)tok * DM + d) = make_float4(v[i].x * rs * g4.x, v[i].y * rs * g4.y, v[i].z * rs * g4.z, v[i].w * rs * g4.w); }
        }
    }
#undef IN
#undef SEAM
}


extern "C" void kernel_launch(void* const* d_in, const int* in_sizes, int n_in, void* d_out, int out_size, void* d_ws, size_t ws_size, hipStream_t stream) {
    static int grid = 0;
    if (grid == 0) {
        if (n_in != 47 || ws_size < WS_END) { fprintf(stderr, "kernel_launch: expected 47 inputs and >= %zu bytes of workspace; got %d, %zu\n", (size_t)WS_END, n_in, ws_size); grid = -1; return; }
        int dev = 0, cus = 0;
        if (hipGetDevice(&dev) != hipSuccess || hipDeviceGetAttribute(&cus, hipDeviceAttributeMultiprocessorCount, dev) != hipSuccess) { grid = -1; return; }
        if (hipFuncSetAttribute((const void*)fwd, hipFuncAttributeMaxDynamicSharedMemorySize, LDS_BYTES) != hipSuccess) { fprintf(stderr, "kernel_launch: hipFuncSetAttribute failed\n"); grid = -1; return; }
        int per_cu = 0;
        if (hipOccupancyMaxActiveBlocksPerMultiprocessor(&per_cu, (const void*)fwd, NTHR, LDS_BYTES) != hipSuccess || per_cu < 1) fprintf(stderr, "kernel_launch: occupancy query reports %d\n", per_cu);
        (void)hipGetLastError();
        grid = cus > 256 ? 256 : cus;
        if (grid < 224) { fprintf(stderr, "kernel_launch: needs >= 224 CUs (got %d)\n", grid); grid = -1; return; }
    }
    if (grid < 0) return;
    (void)hipMemsetAsync((char*)d_ws, 0, O_ZERO_END, stream);
    Args a{};
    for (int i = 0; i < 47; ++i) a.in[i] = (const float*)d_in[i];
    a.out = (float*)d_out; a.ws = (unsigned char*)d_ws;
#if MK_ONE_LAUNCH
    a.ph_lo = 0; a.ph_hi = 64;
    hipLaunchKernelGGL(fwd, dim3(grid), dim3(NTHR), LDS_BYTES, stream, a);
#else
    const int ids[] = {0, 1,2,3,4,5,6,7,8,9,10,11,12,13,14, 17,18,19,20,21,22,23,24,25,26,27,28,29,30, 33};
    for (int k = 0; k < (int)(sizeof(ids) / sizeof(ids[0])); ++k) { a.ph_lo = ids[k]; a.ph_hi = ids[k] + 1; hipLaunchKernelGGL(fwd, dim3(grid), dim3(NTHR), LDS_BYTES, stream, a); }
#endif
}
```

```cpp
#include <hip/hip_runtime.h>
#include <stdint.h>
#include <stdio.h>

#ifndef PROBE_MASK
#define PROBE_MASK 0
#endif
#ifndef PROBE_SP
#define PROBE_SP 1
#endif
#define PROBE_REPS(k) ((((PROBE_MASK) >> (k)) & 1) + 1)
#ifndef MK_ONE_LAUNCH
#define MK_ONE_LAUNCH 1
#endif

#define DM 2048
#define NB 4
#define SEQ 4096
#define CTXL 256
#define BW 512
#define NLAT 16384
#define NCTX 1024
#define NTOK 17408
#define IN_W 13856
#define GATE2 5888
#define LDP 14080
#define HY_OFF 0
#define ML_OFF 1536
#define S5_OFF 3600
#define SSD_OFF 4112
#define GATE_OFF 5664
#define NEXP 16
#define DEXP 1536
#define MOE_ROWS 2176
#define MOE_PAD 2304
#define NTHR 512
#define LDS_BYTES 147456
#define LAS __attribute__((address_space(3)))

typedef unsigned short bf16_t;
typedef short bf16x8 __attribute__((ext_vector_type(8)));
typedef float f32x4 __attribute__((ext_vector_type(4)));
typedef unsigned u32x4 __attribute__((ext_vector_type(4)));
typedef unsigned u32x2 __attribute__((ext_vector_type(2)));

#define XB_TMO      128
#define XB_XCNT(j)  (256  + 64 * (j))
#define XB_XSUB(j)  (1280 + 64 * (j))
#define XB_XGEN(j)  (2304 + 64 * (j))
#define XB_TOP      3328
#define XB_TOPGEN   3392
#define XCD_BAR_WORDS 3456
#define XB_SPIN_CAP (1u << 18)
__device__ __forceinline__ unsigned xb_ld(unsigned* p)              { return __hip_atomic_load(p, __ATOMIC_RELAXED, __HIP_MEMORY_SCOPE_AGENT); }
__device__ __forceinline__ unsigned xb_add(unsigned* p, unsigned v) { return __hip_atomic_fetch_add(p, v, __ATOMIC_RELAXED, __HIP_MEMORY_SCOPE_AGENT); }
__device__ __forceinline__ unsigned xb_xcc_id() { return (unsigned)__builtin_amdgcn_s_getreg((3 << 11) | 20) & 0xFu; }
#define XB_SPIN(cond, bar) do { unsigned _sp = 0; while (cond) { __builtin_amdgcn_s_sleep(1); \
    if ((++_sp & 255u) == 0u) { if (xb_ld(&(bar)[XB_TMO])) break; if (_sp > XB_SPIN_CAP) { atomicAdd(&(bar)[XB_TMO], 1u); break; } } } } while (0)
struct XcdBarrier { unsigned* bar; unsigned x; volatile LAS unsigned* st; };
__device__ __forceinline__ XcdBarrier xcd_barrier_post(unsigned* bar, volatile LAS unsigned* st) {
    XcdBarrier b; b.bar = bar; b.x = xb_xcc_id(); b.st = st;
    if (threadIdx.x == 0) (void)xb_add(&bar[XB_XCNT(b.x)], 1u);
    return b;
}
__device__ __forceinline__ void xcd_barrier_complete(unsigned* bar, unsigned x, unsigned& nloc, unsigned& nx) {
    const unsigned G = gridDim.x * gridDim.y * gridDim.z;
    unsigned sum, cnt, mine, sp = 0u;
    for (;;) {
        sum = 0u; cnt = 0u; mine = 0u;
#pragma unroll
        for (unsigned j = 0; j < 16; ++j) { const unsigned c = xb_ld(&bar[XB_XCNT(j)]); sum += c; cnt += (c > 0u) ? 1u : 0u; mine = (j == x) ? c : mine; }
        if (sum == G) break;
        __builtin_amdgcn_s_sleep(1);
        if ((++sp & 255u) == 0u) { if (xb_ld(&bar[XB_TMO])) break; if (sp > XB_SPIN_CAP) { atomicAdd(&bar[XB_TMO], 1u); break; } }
    }
    nloc = mine > 0u ? mine : 1u; nx = cnt > 0u ? cnt : 1u;
}
__device__ __forceinline__ void xcd_barrier(const XcdBarrier& b) {
    asm volatile("s_waitcnt vmcnt(0)" ::: "memory");
    __syncthreads();
    if (threadIdx.x == 0) {
        unsigned* bar = b.bar;
        __builtin_amdgcn_s_waitcnt(0);
        unsigned nloc = b.st[0], nx = b.st[1];
        if (nloc == 0u) { xcd_barrier_complete(bar, b.x, nloc, nx); b.st[0] = nloc; b.st[1] = nx; }
        const unsigned old = xb_add(&bar[XB_XSUB(b.x)], 1u);
        const unsigned gen = old / nloc;
        if (old + 1u == (gen + 1u) * nloc) {
            __builtin_amdgcn_fence(__ATOMIC_RELEASE, "agent");
            asm volatile("s_waitcnt vmcnt(0)" ::: "memory");
            const unsigned og = xb_add(&bar[XB_TOP], 1u);
            const unsigned tg = og / nx;
            if (og + 1u == (tg + 1u) * nx) xb_add(&bar[XB_TOPGEN], 1u);
            else XB_SPIN(xb_ld(&bar[XB_TOPGEN]) == tg, bar);
            __builtin_amdgcn_fence(__ATOMIC_ACQUIRE, "agent");
            xb_add(&bar[XB_XGEN(b.x)], 1u);
            asm volatile("s_waitcnt vmcnt(0)" ::: "memory");
        } else {
            XB_SPIN(xb_ld(&bar[XB_XGEN(b.x)]) == gen, bar);
            __builtin_amdgcn_fence(__ATOMIC_ACQUIRE, "agent");
            asm volatile("s_waitcnt vmcnt(0)" ::: "memory");
        }
    }
    __syncthreads();
}

__device__ __forceinline__ unsigned short f2bf(float f) { unsigned u = __float_as_uint(f); u += 0x7FFFu + ((u >> 16) & 1u); return (unsigned short)(u >> 16); }
__device__ __forceinline__ float bf2f(unsigned short b) { return __uint_as_float(((unsigned)b) << 16); }
__device__ __forceinline__ unsigned pk2(float lo, float hi) { unsigned r; asm("v_cvt_pk_bf16_f32 %0, %1, %2" : "=v"(r) : "v"(lo), "v"(hi)); return r; }
__device__ __forceinline__ float sigmoidf_(float x) { return 1.0f / (1.0f + expf(-x)); }
__device__ __forceinline__ float siluf_(float x) { return x / (1.0f + expf(-x)); }
__device__ __forceinline__ float wave_sum(float v) {
#pragma unroll
    for (int o = 32; o >= 1; o >>= 1) v += __shfl_xor(v, o);
    return v;
}
__device__ __forceinline__ const float* uptr(const float* p) { const unsigned long long v = (unsigned long long)p;
    const unsigned lo = __builtin_amdgcn_readfirstlane((unsigned)v), hi = __builtin_amdgcn_readfirstlane((unsigned)(v >> 32)); return (const float*)(((unsigned long long)hi << 32) | lo); }
#define PT(k) uptr(ptab[k])
__device__ __forceinline__ int step_tok(int b, int dir, int i) {
    if (i < CTXL) { const int tt = dir ? (CTXL - 1 - i) : i; return NLAT + b * CTXL + tt; }
    const int j = i - CTXL; const int tt = dir ? (SEQ - 1 - j) : j; return b * SEQ + tt;
}
__device__ __forceinline__ void unpack8(const u32x4 w, float (&f)[8]) {
    f[0] = __uint_as_float(w.x << 16); f[1] = __uint_as_float(w.x & 0xFFFF0000u); f[2] = __uint_as_float(w.y << 16); f[3] = __uint_as_float(w.y & 0xFFFF0000u);
    f[4] = __uint_as_float(w.z << 16); f[5] = __uint_as_float(w.z & 0xFFFF0000u); f[6] = __uint_as_float(w.w << 16); f[7] = __uint_as_float(w.w & 0xFFFF0000u);
}

namespace pg8 {
constexpr int BM = 256, BK = 64, HALF = 128, HTB = HALF * BK * 2, STAGE_BYTES = 8 * HTB, NXCD = 8, WGM = 8;
__host__ __device__ __forceinline__ int lds_byte(int r, int c) { const int st = (r >> 4) * 2 + (c >> 5), rr = r & 15, cc = c & 31, ob = rr * 64 + cc * 2; return st * 1024 + (ob ^ (((ob >> 9) & 1) << 5)); }
__host__ __device__ __forceinline__ void stage_rc(int b, int& R, int& C) { const int st = b / 1024, sb = b % 1024, swz = sb ^ (((sb >> 9) & 1) << 5); R = (st >> 1) * 16 + swz / 64; C = (st & 1) * 32 + (swz % 64) / 2; }
__host__ __device__ __forceinline__ int perm32(int rho) { const int n = rho >> 4, i = rho & 15; return 8 * (i >> 2) + 4 * n + (i & 3); }
struct Unit { int pm, pn, z, k; long long ao, bo; };
struct Gemm { const bf16_t* A; const bf16_t* Bt; int lda, ldb, K; };

__device__ __forceinline__ void tile_of(int wgid, int nM, int nN, int& pm, int& pn) {
    const int nwg = nM * nN; { const int q = nwg / NXCD, r = nwg % NXCD, xcd = wgid % NXCD, off = wgid / NXCD; wgid = (xcd < r ? xcd * (q + 1) : r * (q + 1) + (xcd - r) * q) + off; }
    const int nig = WGM * nN, gid = wgid / nig, fm = gid * WGM, gsz = (nM - fm) < WGM ? (nM - fm) : WGM;
    pm = fm + ((wgid % nig) % gsz); pn = (wgid % nig) / gsz;
}
struct SchedStd {
    int nM, nN, G, c, lda, ldb;
    __device__ __forceinline__ bool next(int i, Unit& u) const { const long L = (long)i * G + c; if (L >= (long)nM * nN) return false; tile_of((int)L, nM, nN, u.pm, u.pn); u.z = 0; u.k = 0;
        u.ao = (long long)u.pm * BM * lda * 2; u.bo = (long long)u.pn * BM * ldb * 2; return true; }
    __device__ __forceinline__ void a_ready(const Unit&) const {}
    __device__ __forceinline__ void done(const Unit&) const {}
};
struct SchedBranch {
    int nM, nN, G, c;
    __device__ __forceinline__ bool next(int i, Unit& u) const { const long L = (long)(i >> 2) * G + c; if (L >= (long)nM * nN) return false; tile_of((int)L, nM, nN, u.pm, u.pn); u.z = 0; u.k = i & 3;
        u.ao = ((long long)u.pm * BM * DM + u.k * BW) * 2; u.bo = ((long long)u.k * DM + u.pn * BM) * BW * 2; return true; }
    __device__ __forceinline__ void a_ready(const Unit&) const {}
    __device__ __forceinline__ void done(const Unit&) const {}
};
struct SchedTail {
    int G, c;
    __device__ __forceinline__ bool next(int i, Unit& u) const { const long T = (long)i * G + c; if (T >= 128) return false; const int t = (int)(T >> 2); u.pm = 64 + (t >> 3); u.pn = t & 7; u.z = 1; u.k = (int)(T & 3);
        u.ao = ((long long)u.pm * BM * DM + u.k * BW) * 2; u.bo = ((long long)u.k * DM + u.pn * BM) * BW * 2; return true; }
    __device__ __forceinline__ void a_ready(const Unit&) const {}
    __device__ __forceinline__ void done(const Unit&) const {}
};
struct SchedTailK {
    int G, c;
    __device__ __forceinline__ bool next(int i, Unit& u) const { const long T = (long)i * G + c; if (T >= 128) return false; const int t = (int)(T >> 2); u.pm = 64 + (t >> 3); u.pn = t & 7; u.z = 1; u.k = (int)(T & 3);
        u.ao = ((long long)u.pm * BM * DM + u.k * 512) * 2; u.bo = ((long long)u.pn * BM * DM + u.k * 512) * 2; return true; }
    __device__ __forceinline__ void a_ready(const Unit&) const {}
    __device__ __forceinline__ void done(const Unit&) const {}
};
struct SchedMoe {
    int nPm, nPn, G, c, lda, ldb, nBrows;
    __device__ __forceinline__ bool next(int i, Unit& u) const { const long L = (long)i * G + c; const int per = nPm * nPn; if (L >= (long)NEXP * per) return false; const int e = (int)(L / per), rem = (int)(L % per);
        u.z = e; u.k = 0; u.pm = rem % nPm; u.pn = rem / nPm; u.ao = ((long long)e * MOE_PAD + u.pm * BM) * lda * 2; u.bo = ((long long)e * nBrows + u.pn * BM) * ldb * 2; return true; }
    __device__ __forceinline__ void a_ready(const Unit&) const {}
    __device__ __forceinline__ void done(const Unit&) const {}
};

typedef f32x4 Acc[2][2][4][2];
template <class Epi, class Sched>
__device__ __forceinline__ void gemm_phase(LAS unsigned char* lds, const Gemm g, const Sched& S, const Epi& E) {
    int tid = threadIdx.x; asm volatile("" : "+v"(tid));
    const int wid = __builtin_amdgcn_readfirstlane(tid >> 6), lane = tid & 63, wr = wid >> 2, wc = wid & 3, fr = lane & 15, fq = lane >> 4;
    const int K = g.K, nt = K / BK;
    unsigned voffA[2], voffB[2];
#pragma unroll
    for (int i = 0; i < 2; ++i) { int R, C; stage_rc(tid * 16 + i * 8192, R, C); const int Rb = Epi::PERM ? ((R & ~31) + perm32(R & 31)) : R;
        voffA[i] = (unsigned)(R * g.lda + C) * 2u; voffB[i] = (unsigned)(Rb * g.ldb + C) * 2u; }
    const size_t kstep = (size_t)(BK * 2);
    const size_t hstepA = (size_t)HALF * g.lda * 2, hstepB = (size_t)HALF * g.ldb * 2;
    const unsigned ldsw = (unsigned)wid * 1024u;
    const int aoff = lds_byte(wr * 64 + fr, fq * 8), boff = lds_byte(wc * 32 + fr, fq * 8);
#define PG8_SA(b, h) (((b) * 2 + (h)) * HTB)
#define PG8_SB(b, h) ((4 + (b) * 2 + (h)) * HTB)
#define PG8_STAGE(bufoff, gbase, voff) do { _Pragma("unroll") for (int _i = 0; _i < 2; ++_i) \
        __builtin_amdgcn_global_load_lds((const unsigned*)((const char*)(gbase) + (voff)[_i]), (LAS unsigned*)(lds + (bufoff) + ldsw + _i * 8192), 16, 0, 0); } while (0)
#define PG8_LDA(dst, b, h) do { _Pragma("unroll") for (int m = 0; m < 4; ++m) _Pragma("unroll") for (int k = 0; k < 2; ++k) dst[m][k] = *(const LAS bf16x8*)(lds + PG8_SA(b, h) + aoff + m * 2048 + k * 1024); } while (0)
#define PG8_LDB(dst, b, h) do { _Pragma("unroll") for (int n = 0; n < 2; ++n) _Pragma("unroll") for (int k = 0; k < 2; ++k) dst[n][k] = *(const LAS bf16x8*)(lds + PG8_SB(b, h) + boff + n * 2048 + k * 1024); } while (0)
#define PG8_MMA(ai, bj, At, Bt) do { __builtin_amdgcn_s_setprio(1); _Pragma("unroll") for (int m = 0; m < 4; ++m) _Pragma("unroll") for (int n = 0; n < 2; ++n) _Pragma("unroll") for (int k = 0; k < 2; ++k) \
        acc[ai][bj][m][n] = __builtin_amdgcn_mfma_f32_16x16x32_bf16(Bt[n][k], At[m][k], acc[ai][bj][m][n], 0, 0, 0); __builtin_amdgcn_s_setprio(0); } while (0)
#define PG8_WAIT_V(n) asm volatile("s_waitcnt vmcnt(" #n ")" ::: "memory")
#define PG8_WAIT_L(n) asm volatile("s_waitcnt lgkmcnt(" #n ")" ::: "memory")
#define PG8_BAR __builtin_amdgcn_s_barrier()
#define PG8_SCHED __builtin_amdgcn_sched_barrier(0)
    Unit cur, nxt; int ui = 0;
    if (!S.next(0, cur)) return;
    Acc acc;
#pragma unroll
    for (int a = 0; a < 2; ++a)
#pragma unroll
        for (int b = 0; b < 2; ++b)
#pragma unroll
            for (int m = 0; m < 4; ++m)
#pragma unroll
                for (int n = 0; n < 2; ++n) acc[a][b][m][n] = (f32x4){0.f, 0.f, 0.f, 0.f};
    bf16x8 At[4][2], B0[2][2], B1[2][2];
    const char* cA = (const char*)g.A + cur.ao; const char* cB = (const char*)g.Bt + cur.bo;
    S.a_ready(cur);
    PG8_STAGE(PG8_SB(0, 0), cB, voffB); PG8_STAGE(PG8_SA(0, 0), cA, voffA); PG8_STAGE(PG8_SB(0, 1), cB + hstepB, voffB); PG8_STAGE(PG8_SA(0, 1), cA + hstepA, voffA);
    if (wr == 1) PG8_BAR;
    PG8_WAIT_V(4); PG8_BAR;
    PG8_STAGE(PG8_SB(1, 0), cB + kstep, voffB); PG8_STAGE(PG8_SA(1, 0), cA + kstep, voffA); PG8_STAGE(PG8_SB(1, 1), cB + hstepB + kstep, voffB);
    PG8_WAIT_V(6); PG8_BAR;
    for (;;) {
        const bool has_next = S.next(ui + 1, nxt);
        const char* nA = has_next ? (const char*)g.A + nxt.ao : cA; const char* nB = has_next ? (const char*)g.Bt + nxt.bo : cB;
        for (int t = 0; t < nt; t += 2) {
            const bool last = (t == nt - 2);
            const char* a1 = cA + (size_t)(t + 1) * kstep;
            const char* a2 = last ? nA : cA + (size_t)(t + 2) * kstep; const char* b2 = last ? nB : cB + (size_t)(t + 2) * kstep;
            const char* a3 = a2 + kstep; const char* b3 = b2 + kstep;
            if (last && has_next) S.a_ready(nxt);
            PG8_LDB(B0, 0, 0); PG8_SCHED; PG8_LDA(At, 0, 0); PG8_STAGE(PG8_SA(1, 1), a1 + hstepA, voffA);
            PG8_WAIT_L(8); PG8_BAR; PG8_WAIT_L(0); PG8_MMA(0, 0, At, B0); PG8_BAR; PG8_SCHED;
            PG8_LDB(B1, 0, 1); PG8_STAGE(PG8_SB(0, 0), b2, voffB);
            PG8_BAR; PG8_WAIT_L(0); PG8_MMA(0, 1, At, B1); PG8_BAR;
            PG8_LDA(At, 0, 1); PG8_STAGE(PG8_SA(0, 0), a2, voffA);
            PG8_BAR; PG8_WAIT_L(0); PG8_MMA(1, 0, At, B0); PG8_BAR; PG8_SCHED;
            PG8_STAGE(PG8_SB(0, 1), b2 + hstepB, voffB);
            PG8_WAIT_V(6); PG8_BAR; PG8_MMA(1, 1, At, B1); PG8_BAR;
            PG8_LDB(B0, 1, 0); PG8_SCHED; PG8_LDA(At, 1, 0); PG8_STAGE(PG8_SA(0, 1), a2 + hstepA, voffA);
            PG8_WAIT_L(8); PG8_BAR; PG8_WAIT_L(0); PG8_MMA(0, 0, At, B0); PG8_BAR; PG8_SCHED;
            PG8_LDB(B1, 1, 1); PG8_STAGE(PG8_SB(1, 0), b3, voffB);
            PG8_BAR; PG8_WAIT_L(0); PG8_MMA(0, 1, At, B1); PG8_BAR;
            PG8_LDA(At, 1, 1); PG8_STAGE(PG8_SA(1, 0), a3, voffA);
            PG8_BAR; PG8_WAIT_L(0); PG8_MMA(1, 0, At, B0); PG8_BAR; PG8_SCHED;
            PG8_STAGE(PG8_SB(1, 1), b3 + hstepB, voffB);
            PG8_WAIT_V(6); PG8_BAR; PG8_MMA(1, 1, At, B1); PG8_BAR;
        }
        const bool keep = E(acc, cur, wr, wc, fr, fq); S.done(cur);
        if (!has_next) break;
        if (!keep) {
#pragma unroll
        for (int a = 0; a < 2; ++a)
#pragma unroll
            for (int b = 0; b < 2; ++b)
#pragma unroll
                for (int m = 0; m < 4; ++m)
#pragma unroll
                    for (int n = 0; n < 2; ++n) acc[a][b][m][n] = (f32x4){0.f, 0.f, 0.f, 0.f};
        }
        cur = nxt; cA = nA; cB = nB; ++ui;
    }
    PG8_WAIT_V(0);
    if (wr == 0) PG8_BAR;
    PG8_BAR;
#undef PG8_SA
#undef PG8_SB
#undef PG8_STAGE
#undef PG8_LDA
#undef PG8_LDB
#undef PG8_MMA
#undef PG8_WAIT_V
#undef PG8_WAIT_L
#undef PG8_BAR
#undef PG8_SCHED
}

struct EpiBf16Store {
    static constexpr bool PERM = true;
    bf16_t* O; int ldc;
    __device__ __forceinline__ bool operator()(Acc& acc, const Unit& u, int wr, int wc, int fr, int fq) const {
        const int row0 = u.pm * BM + wr * 64 + fr, col0 = u.pn * BM + wc * 32 + 8 * fq;
#pragma unroll
        for (int ai = 0; ai < 2; ++ai)
#pragma unroll
            for (int m = 0; m < 4; ++m) { bf16_t* rowp = O + (size_t)(row0 + ai * HALF + m * 16) * ldc + col0;
#pragma unroll
                for (int bj = 0; bj < 2; ++bj) { const f32x4 v0 = acc[ai][bj][m][0], v1 = acc[ai][bj][m][1];
                    u32x4 w; w.x = pk2(v0[0], v0[1]); w.y = pk2(v0[2], v0[3]); w.z = pk2(v1[0], v1[1]); w.w = pk2(v1[2], v1[3]);
                    *(u32x4*)(rowp + bj * HALF) = w; } }
        return false;
    }
};
struct EpiWin {
    static constexpr bool PERM = true;
    bf16_t* O; int ldc;
    __device__ __forceinline__ bool operator()(Acc& acc, const Unit& u, int wr, int wc, int fr, int fq) const {
        const int row0 = u.pm * BM + wr * 64 + fr;
        if (u.pn < 23) { const int col0 = u.pn * BM + wc * 32 + 8 * fq;
#pragma unroll
            for (int ai = 0; ai < 2; ++ai)
#pragma unroll
                for (int m = 0; m < 4; ++m)
#pragma unroll
                    for (int bj = 0; bj < 2; ++bj) { const f32x4 v0 = acc[ai][bj][m][0], v1 = acc[ai][bj][m][1];
                        u32x4 w; w.x = pk2(v0[0], v0[1]); w.y = pk2(v0[2], v0[3]); w.z = pk2(v1[0], v1[1]); w.w = pk2(v1[2], v1[3]);
                        *(u32x4*)(O + (size_t)(row0 + ai * HALF + m * 16) * ldc + col0 + bj * HALF) = w; }
        } else { const int colb = GATE2 + 64 * (u.pn - 23) + 16 * wc + 4 * fq;
#pragma unroll
            for (int ai = 0; ai < 2; ++ai)
#pragma unroll
                for (int m = 0; m < 4; ++m) { f32x4 sg[4];
#pragma unroll
                    for (int bj = 0; bj < 2; ++bj)
#pragma unroll
                        for (int n = 0; n < 2; ++n) { const f32x4 v = acc[ai][bj][m][n];
#pragma unroll
                            for (int j = 0; j < 4; ++j) sg[2 * bj + n][j] = __builtin_amdgcn_rcpf(1.0f + __expf(-v[j])); }
                    bf16_t* op = O + (size_t)(row0 + ai * HALF + m * 16) * ldc + colb;
#pragma unroll
                    for (int k = 0; k < 4; ++k) { f32x4 r = sg[k];
                        if (k < 3) {
#pragma unroll
                            for (int j = 0; j < 4; ++j) r[j] *= __builtin_amdgcn_rcpf(sg[k + 1][j]); }
                        u32x2 w; w.x = pk2(r[0], r[1]); w.y = pk2(r[2], r[3]); *(u32x2*)(op + k * DM) = w; } }
        }
        return false;
    }
};
struct EpiNone { static constexpr bool PERM = true;
    __device__ __forceinline__ bool operator()(Acc& acc, const Unit&, int, int, int, int) const {
#pragma unroll
        for (int a = 0; a < 2; ++a)
#pragma unroll
            for (int b = 0; b < 2; ++b)
#pragma unroll
                for (int m = 0; m < 4; ++m)
#pragma unroll
                    for (int n = 0; n < 2; ++n) asm volatile("" :: "v"(acc[a][b][m][n]));
        return false; } };
struct EpiGlu {
    static constexpr bool PERM = true;
    const bf16_t* GG; const float* bias; bf16_t* Y4;
    __device__ __forceinline__ bool operator()(Acc& acc, const Unit& u, int wr, int wc, int fr, int fq) const {
        const int row0 = u.pm * BM + wr * 64 + fr, col0 = u.pn * BM + wc * 32 + 8 * fq;
#pragma unroll
        for (int bj = 0; bj < 2; ++bj) { const int col = col0 + bj * HALF; const f32x4 b0 = *(const f32x4*)(bias + col), b1 = *(const f32x4*)(bias + col + 4);
            u32x4 gq[2][4];
#pragma unroll
            for (int ai = 0; ai < 2; ++ai)
#pragma unroll
                for (int m = 0; m < 4; ++m) gq[ai][m] = *(const u32x4*)(GG + (size_t)(row0 + ai * HALF + m * 16) * BW + col);
#pragma unroll
            for (int ai = 0; ai < 2; ++ai)
#pragma unroll
                for (int m = 0; m < 4; ++m) { const size_t row = (size_t)(row0 + ai * HALF + m * 16);
                    float gg[8]; unpack8(gq[ai][m], gg);
                    const f32x4 v0 = acc[ai][bj][m][0] + b0, v1 = acc[ai][bj][m][1] + b1;
                    u32x4 w; w.x = pk2(gg[0] * sigmoidf_(v0[0]), gg[1] * sigmoidf_(v0[1])); w.y = pk2(gg[2] * sigmoidf_(v0[2]), gg[3] * sigmoidf_(v0[3]));
                    w.z = pk2(gg[4] * sigmoidf_(v1[0]), gg[5] * sigmoidf_(v1[1])); w.w = pk2(gg[6] * sigmoidf_(v1[2]), gg[7] * sigmoidf_(v1[3]));
                    *(u32x4*)(Y4 + row * DM + 1024 + col) = w; } }
        return false;
    }
};
struct EpiBranch {
    static constexpr bool PERM = true;
    const bf16_t* P; bf16_t* ACCb;
    __device__ __forceinline__ bool operator()(Acc& acc, const Unit& u, int wr, int wc, int fr, int fq) const {
        const int row0 = u.pm * BM + wr * 64 + fr, col0 = u.pn * BM + wc * 32 + 8 * fq; const int k = u.k;
        const bf16_t* gbase = P + (size_t)row0 * LDP + GATE2 + k * DM + col0;
#pragma unroll
        for (int ai = 0; ai < 2; ++ai) {
            u32x4 ga[8];
#pragma unroll
            for (int m = 0; m < 4; ++m)
#pragma unroll
                for (int bj = 0; bj < 2; ++bj) ga[m * 2 + bj] = *(const u32x4*)(gbase + (size_t)(ai * HALF + m * 16) * LDP + bj * HALF);
#pragma unroll
            for (int m = 0; m < 4; ++m)
#pragma unroll
                for (int bj = 0; bj < 2; ++bj) { float sr[8]; unpack8(ga[m * 2 + bj], sr);
                    f32x4 v0 = acc[ai][bj][m][0], v1 = acc[ai][bj][m][1];
                    v0[0] *= sr[0]; v0[1] *= sr[1]; v0[2] *= sr[2]; v0[3] *= sr[3]; v1[0] *= sr[4]; v1[1] *= sr[5]; v1[2] *= sr[6]; v1[3] *= sr[7];
                    if (k < 3) { acc[ai][bj][m][0] = v0; acc[ai][bj][m][1] = v1; }
                    else { u32x4 w; w.x = pk2(v0[0], v0[1]); w.y = pk2(v0[2], v0[3]); w.z = pk2(v1[0], v1[1]); w.w = pk2(v1[2], v1[3]); *(u32x4*)(ACCb + (size_t)(row0 + ai * HALF + m * 16) * DM + col0 + bj * HALF) = w; } } }
        return k < 3;
    }
};
struct EpiPartK {
    static constexpr bool PERM = true;
    float* PART;
    __device__ __forceinline__ bool operator()(Acc& acc, const Unit& u, int wr, int wc, int fr, int fq) const {
        const int row0 = u.pm * BM + wr * 64 + fr, col0 = u.pn * BM + wc * 32 + 8 * fq;
        float* pbase = PART + ((size_t)u.k * (NTOK - NLAT) + (size_t)(row0 - NLAT)) * DM + col0;
#pragma unroll
        for (int ai = 0; ai < 2; ++ai)
#pragma unroll
            for (int m = 0; m < 4; ++m)
#pragma unroll
                for (int bj = 0; bj < 2; ++bj) { float* pp = pbase + (size_t)(ai * HALF + m * 16) * DM + bj * HALF; *(f32x4*)pp = acc[ai][bj][m][0]; *(f32x4*)(pp + 4) = acc[ai][bj][m][1]; }
        return false;
    }
};
struct EpiResid {
    static constexpr bool PERM = false;
    float* XS; const float* srcLat; const float* srcCtx; const float* MODl; int gidx;
    __device__ __forceinline__ bool operator()(Acc& acc, const Unit& u, int wr, int wc, int fr, int fq) const {
        const int row0 = u.pm * BM + wr * 64 + fr, col0 = u.pn * BM + wc * 32 + 4 * fq;
        const int r = (u.pm * BM) < NLAT ? (u.pm * BM) / SEQ : 4;
        const float* src = (u.pm * BM) < NLAT ? srcLat : srcCtx;
        const float* mg = MODl + (size_t)(r * 6 + gidx) * DM;
#pragma unroll
        for (int bj = 0; bj < 2; ++bj) {
            f32x4 gm[2], xs[2][2][4];
#pragma unroll
            for (int n = 0; n < 2; ++n) { const int col = col0 + bj * HALF + n * 16; gm[n] = *(const f32x4*)(mg + col);
#pragma unroll
                for (int ai = 0; ai < 2; ++ai)
#pragma unroll
                    for (int m = 0; m < 4; ++m) xs[n][ai][m] = *(const f32x4*)(src + (size_t)(row0 + ai * HALF + m * 16) * DM + col); }
#pragma unroll
            for (int n = 0; n < 2; ++n) { const int col = col0 + bj * HALF + n * 16;
#pragma unroll
                for (int ai = 0; ai < 2; ++ai)
#pragma unroll
                    for (int m = 0; m < 4; ++m) *(f32x4*)(XS + (size_t)(row0 + ai * HALF + m * 16) * DM + col) = xs[n][ai][m] + gm[n] * acc[ai][bj][m][n]; } }
        return false;
    }
};
struct EpiMoe1 {
    static constexpr bool PERM = true;
    bf16_t* HID;
    __device__ __forceinline__ bool operator()(Acc& acc, const Unit& u, int wr, int wc, int fr, int fq) const {
        const size_t row0 = (size_t)u.z * MOE_PAD + u.pm * BM + wr * 64 + fr; const int col0 = u.pn * HALF + wc * 32 + 8 * fq;
#pragma unroll
        for (int ai = 0; ai < 2; ++ai)
#pragma unroll
            for (int m = 0; m < 4; ++m) { const f32x4 g0 = acc[ai][0][m][0], g1 = acc[ai][0][m][1], u0 = acc[ai][1][m][0], u1 = acc[ai][1][m][1];
                float h[8];
#pragma unroll
                for (int j = 0; j < 4; ++j) { h[j] = g0[j] * __builtin_amdgcn_rcpf(1.0f + __expf(-g0[j])) * u0[j]; h[4 + j] = g1[j] * __builtin_amdgcn_rcpf(1.0f + __expf(-g1[j])) * u1[j]; }
                u32x4 w; w.x = pk2(h[0], h[1]); w.y = pk2(h[2], h[3]); w.z = pk2(h[4], h[5]); w.w = pk2(h[6], h[7]);
                *(u32x4*)(HID + (row0 + ai * HALF + m * 16) * DEXP + col0) = w; }
        return false;
    }
};
struct EpiMoeY {
    static constexpr bool PERM = true;
    bf16_t* O;
    __device__ __forceinline__ bool operator()(Acc& acc, const Unit& u, int wr, int wc, int fr, int fq) const {
        const size_t row0 = (size_t)u.z * MOE_PAD + u.pm * BM + wr * 64 + fr; const int col0 = u.pn * BM + wc * 32 + 8 * fq;
#pragma unroll
        for (int ai = 0; ai < 2; ++ai)
#pragma unroll
            for (int m = 0; m < 4; ++m) { bf16_t* rowp = O + (row0 + ai * HALF + m * 16) * DM + col0;
#pragma unroll
                for (int bj = 0; bj < 2; ++bj) { const f32x4 v0 = acc[ai][bj][m][0], v1 = acc[ai][bj][m][1];
                    u32x4 w; w.x = pk2(v0[0], v0[1]); w.y = pk2(v0[2], v0[3]); w.z = pk2(v1[0], v1[1]); w.w = pk2(v1[2], v1[3]);
                    *(u32x4*)(rowp + bj * HALF) = w; } }
        return false;
    }
};

struct SchedS5a {
    int c;
    __device__ __forceinline__ bool next(int i, Unit& u) const { if (i > 0 || c >= 64) return false; u.z = c >> 1; u.pm = c & 1; u.pn = 0; u.k = 0;
        u.ao = ((long long)u.z * 512 + u.pm * BM) * 768 * 2; u.bo = (long long)u.z * 256 * 512 * 2; return true; }
    __device__ __forceinline__ void a_ready(const Unit&) const {}
    __device__ __forceinline__ void done(const Unit&) const {}
};
struct SchedS5b {
    int c;
    __device__ __forceinline__ bool next(int i, Unit& u) const { if (i > 0 || c >= 128) return false; u.z = c >> 2; u.pm = (c >> 1) & 1; u.pn = c & 1; u.k = 0;
        u.ao = ((long long)u.z * 512 + u.pm * BM) * 768 * 2; u.bo = ((long long)u.z * 512 + u.pn * BM) * 768 * 2; return true; }
    __device__ __forceinline__ void a_ready(const Unit&) const {}
    __device__ __forceinline__ void done(const Unit&) const {}
};
struct EpiXloc {
    static constexpr bool PERM = false;
    float* XL;
    __device__ __forceinline__ bool operator()(Acc& acc, const Unit& u, int wr, int wc, int fr, int fq) const {
        const int row0 = u.pm * BM + wr * 64 + fr, col0 = wc * 32 + 4 * fq; float* base = XL + (size_t)u.z * 512 * 256;
#pragma unroll
        for (int ai = 0; ai < 2; ++ai)
#pragma unroll
            for (int m = 0; m < 4; ++m) { float* rowp = base + (size_t)(row0 + ai * HALF + m * 16) * 256 + col0;
#pragma unroll
                for (int bj = 0; bj < 2; ++bj)
#pragma unroll
                    for (int n = 0; n < 2; ++n) *(f32x4*)(rowp + bj * HALF + n * 16) = acc[ai][bj][m][n]; }
        return false;
    }
};
struct EpiS5Out {
    static constexpr bool PERM = true;
    const bf16_t* P; const float* dskip; bf16_t* GG;
    __device__ __forceinline__ bool operator()(Acc& acc, const Unit& u, int wr, int wc, int fr, int fq) const {
        const int row0 = u.pm * BM + wr * 64 + fr, col0 = u.pn * BM + wc * 32 + 8 * fq; const int g = u.z;
#pragma unroll
        for (int bj = 0; bj < 2; ++bj) { const int col = col0 + bj * HALF; const int t = col >> 4, c0 = col & 15;
            const f32x4 d0 = *(const f32x4*)(dskip + g * 16 + c0), d1 = *(const f32x4*)(dskip + g * 16 + c0 + 4);
            u32x4 uq[2][4];
#pragma unroll
            for (int ai = 0; ai < 2; ++ai)
#pragma unroll
                for (int m = 0; m < 4; ++m) uq[ai][m] = *(const u32x4*)(P + ((size_t)(row0 + ai * HALF + m * 16) * 32 + t) * LDP + S5_OFF + g * 16 + c0);
#pragma unroll
            for (int ai = 0; ai < 2; ++ai)
#pragma unroll
                for (int m = 0; m < 4; ++m) { const size_t tok = (size_t)(row0 + ai * HALF + m * 16) * 32 + t;
                    float uu[8]; unpack8(uq[ai][m], uu);
                    const f32x4 v0 = acc[ai][bj][m][0], v1 = acc[ai][bj][m][1];
                    float y[8] = {v0[0] + d0[0] * uu[0], v0[1] + d0[1] * uu[1], v0[2] + d0[2] * uu[2], v0[3] + d0[3] * uu[3], v1[0] + d1[0] * uu[4], v1[1] + d1[1] * uu[5], v1[2] + d1[2] * uu[6], v1[3] + d1[3] * uu[7]};
#pragma unroll
                    for (int j = 0; j < 8; ++j) y[j] = 0.5f * y[j] * (1.0f + tanhf(0.7978845608028654f * (y[j] + 0.044715f * y[j] * y[j] * y[j])));
                    u32x4 w; w.x = pk2(y[0], y[1]); w.y = pk2(y[2], y[3]); w.z = pk2(y[4], y[5]); w.w = pk2(y[6], y[7]);
                    *(u32x4*)(GG + tok * BW + g * 16 + c0) = w; } }
        return false;
    }
};
}


__device__ __forceinline__ float wave_scan_incl(float v, int lane) {
#pragma unroll
    for (int o = 1; o < 64; o <<= 1) { const float t = __shfl_up(v, o); if (lane >= o) v += t; }
    return v;
}
__device__ __forceinline__ float wave_scanmax_incl(float v, int lane) {
#pragma unroll
    for (int o = 1; o < 64; o <<= 1) { const float t = __shfl_up(v, o); if (lane >= o) v = fmaxf(v, t); }
    return v;
}
__device__ __forceinline__ float wave_max(float v) {
#pragma unroll
    for (int o = 32; o >= 1; o >>= 1) v = fmaxf(v, __shfl_xor(v, o));
    return v;
}
__device__ __forceinline__ void unpack8h(const u32x4 w, bf16_t (&h)[8]) {
    h[0] = (bf16_t)(w.x & 0xFFFFu); h[1] = (bf16_t)(w.x >> 16); h[2] = (bf16_t)(w.y & 0xFFFFu); h[3] = (bf16_t)(w.y >> 16);
    h[4] = (bf16_t)(w.z & 0xFFFFu); h[5] = (bf16_t)(w.z >> 16); h[6] = (bf16_t)(w.w & 0xFFFFu); h[7] = (bf16_t)(w.w >> 16);
}

__device__ __forceinline__ int tokblock_of(int b, int dir, int c) { if (c < 4) return 256 + b * 4 + (dir ? 3 - c : c); const int j = c - 4; return b * 64 + (dir ? 63 - j : j); }
__device__ __forceinline__ u32x4 rev8h(const u32x4 v) { u32x4 r; r.x = (v.w >> 16) | (v.w << 16); r.y = (v.z >> 16) | (v.z << 16); r.z = (v.y >> 16) | (v.y << 16); r.w = (v.x >> 16) | (v.x << 16); return r; }
__device__ __forceinline__ u32x4 scale8h(const u32x4 v, const float4 a, const float4 b) { float f[8]; unpack8(v, f); u32x4 r; r.x = pk2(f[0] * a.x, f[1] * a.y); r.y = pk2(f[2] * a.z, f[3] * a.w); r.z = pk2(f[4] * b.x, f[5] * b.y); r.w = pk2(f[6] * b.z, f[7] * b.w); return r; }
__device__ __forceinline__ float dot8h(const u32x4 v, const float4 a, const float4 b) { float f[8]; unpack8(v, f); return (f[0] * a.x + f[1] * a.y) + (f[2] * a.z + f[3] * a.w) + (f[4] * b.x + f[5] * b.y) + (f[6] * b.z + f[7] * b.w); }
#define ML_FRAG_LOAD(KF, VF, cc_) do { const int tb_ = tokblock_of(b, dir, (cc_)); const bf16_t* kb_ = KTg + ((size_t)tb_ * 512 + h * 128 + 32 * wd + r16) * 64 + q4 * 8; const bf16_t* vb_ = VTg + ((size_t)tb_ * 512 + h * 128 + 64 * half + 32 * we + r16) * 64 + q4 * 8; \
        _Pragma("unroll") for (int ks_ = 0; ks_ < 2; ++ks_) _Pragma("unroll") for (int j_ = 0; j_ < 2; ++j_) { VF[j_][ks_] = *(const u32x4*)(vb_ + (size_t)j_ * 16 * 64 + ks_ * 32); KF[j_][ks_] = *(const u32x4*)(kb_ + (size_t)j_ * 16 * 64 + ks_ * 32); } } while (0)
#define ML_CHUNK(c_, KF, VF, KFN, VFN) do { const int c = (c_); \
        if (c + 1 < 68) ML_FRAG_LOAD(KFN, VFN, c + 1);                        \
        const float dec = sDEC[c]; \
        {   bf16_t* cs = CST + (size_t)(chain * 68 + c) * 128 * 128; \
            _Pragma("unroll") for (int je = 0; je < 2; ++je) _Pragma("unroll") for (int jd = 0; jd < 2; ++jd) { const int e = 64 * half + 32 * we + 16 * je + r16, d0 = 32 * wd + 16 * jd + q4 * 4; \
                u32x2 pk; pk.x = pk2(acc[je][jd][0], acc[je][jd][1]); pk.y = pk2(acc[je][jd][2], acc[je][jd][3]); *(u32x2*)(cs + (size_t)e * 128 + d0) = pk; } \
            if (nown) { _Pragma("unroll") for (int jd = 0; jd < 2; ++jd) { float nv = npart[jd]; nv += __shfl_xor(nv, 16); nv += __shfl_xor(nv, 32); if (q4 == 0) NST[(size_t)(chain * 68 + c) * 128 + 32 * wd + 16 * jd + r16] = nv; } } } \
        bf16x8 vfr[2][2]; \
        _Pragma("unroll") for (int ks = 0; ks < 2; ++ks) { const float4 wa = *(const float4*)(sWS + c * 64 + ks * 32 + q4 * 8), wb = *(const float4*)(sWS + c * 64 + ks * 32 + q4 * 8 + 4); \
            _Pragma("unroll") for (int je = 0; je < 2; ++je) { const u32x4 sv = scale8h(VF[je][ks], wa, wb); vfr[je][ks] = *(const bf16x8*)&sv; } \
            if (nown) { _Pragma("unroll") for (int jd = 0; jd < 2; ++jd) npart[jd] = (ks == 0 ? dec * npart[jd] : npart[jd]) + dot8h(KF[jd][ks], wa, wb); } } \
        _Pragma("unroll") for (int je = 0; je < 2; ++je) _Pragma("unroll") for (int jd = 0; jd < 2; ++jd) acc[je][jd] = acc[je][jd] * dec; \
        _Pragma("unroll") for (int ks = 0; ks < 2; ++ks) _Pragma("unroll") for (int je = 0; je < 2; ++je) _Pragma("unroll") for (int jd = 0; jd < 2; ++jd) \
            acc[je][jd] = __builtin_amdgcn_mfma_f32_16x16x32_bf16(*(const bf16x8*)&KF[jd][ks], vfr[je][ks], acc[je][jd], 0, 0, 0); } while (0)
__device__ __forceinline__ void mlstm_state_pass(const int chain, const int half, const bf16_t* __restrict__ Pm, const bf16_t* __restrict__ KTg, const bf16_t* __restrict__ VTg, const float* __restrict__ gate_b,
                                                 bf16_t* __restrict__ CST, float* __restrict__ NST, float* __restrict__ MST, unsigned char* shm, const int tid) {
    const int dir = chain & 1, h = (chain >> 1) & 3, b = chain >> 3, lane = tid & 63, w = tid >> 6, we = w >> 2, wd = w & 3, q4 = lane >> 4, r16 = lane & 15;
    const bool nown = (half == 0) && (we == 0);
    float* sE = (float*)shm; float* sWS = sE + 68 * 64; float* sAL = sWS + 68 * 64; float* sBE = sAL + 68; float* sMO = sBE + 68; float* sDEC = sMO + 68; float* sMB = sDEC + 68;
    const float gbi = gate_b[(dir * 2 + 0) * 4 + h], gbf = gate_b[(dir * 2 + 1) * 4 + h];
    const int gcol_i = ML_OFF + 2048 + (dir * 2 + 0) * 4 + h, gcol_f = ML_OFF + 2048 + (dir * 2 + 1) * 4 + h;
    u32x4 kfA[2][2], vfA[2][2], kfB[2][2], vfB[2][2];
    ML_FRAG_LOAD(kfA, vfA, 0);
    __syncthreads();
    unsigned gi_[9], gf_[9];
#pragma unroll
    for (int q = 0; q < 9; ++q) { const int c = min(w + 8 * q, 67); const size_t tokl = (size_t)step_tok(b, dir, c * 64 + lane); gi_[q] = Pm[tokl * LDP + gcol_i]; gf_[q] = Pm[tokl * LDP + gcol_f]; }
#pragma unroll
    for (int q = 0; q < 9; ++q) { const int c = w + 8 * q; if (c >= 68) break;
        const float ig = __uint_as_float(gi_[q] << 16) + gbi, fg = __uint_as_float(gf_[q] << 16) + gbf;
        const float lf = fminf(fg, 0.f) - log1pf(expf(-fabsf(fg)));
        const float bcs = wave_scan_incl(lf, lane); const float blast = __shfl(bcs, 63); const float ei = blast - bcs + ig; const float beta = wave_max(ei);
        sE[c * 64 + lane] = ei; if (lane == 0) { sAL[c] = blast; sBE[c] = beta; } }
    __syncthreads();
    if (tid == 0) { float m = 0.f; for (int c = 0; c < 68; ++c) { sMB[c] = m; const float mo = fmaxf(m + sAL[c], sBE[c]); sDEC[c] = expf(sAL[c] + m - mo); sMO[c] = mo; m = mo; } }
    __syncthreads();
    for (int idx = tid; idx < 68 * 64; idx += NTHR) { const int c = idx >> 6, i = idx & 63; sWS[c * 64 + (dir ? 63 - i : i)] = expf(sE[idx] - sMO[c]); }
    if (half == 0 && tid < 68) MST[chain * 68 + tid] = sMB[tid];
    __syncthreads();
    f32x4 acc[2][2];
#pragma unroll
    for (int je = 0; je < 2; ++je)
#pragma unroll
        for (int jd = 0; jd < 2; ++jd) acc[je][jd] = (f32x4){0.f, 0.f, 0.f, 0.f};
    float npart[2] = {0.f, 0.f};
    for (int c2 = 0; c2 < 68; c2 += 2) { ML_CHUNK(c2, kfA, vfA, kfB, vfB); ML_CHUNK(c2 + 1, kfB, vfB, kfA, vfA); }
    __syncthreads();
}
#undef ML_CHUNK
#undef ML_FRAG_LOAD
__device__ __forceinline__ void mlstm_out_item(const int chain, const int c, const bf16_t* __restrict__ Pm, const bf16_t* __restrict__ QKb, const bf16_t* __restrict__ VTg, const float* __restrict__ gate_b,
                                               const bf16_t* __restrict__ CST, const float* __restrict__ NST, const float* __restrict__ MST, bf16_t* __restrict__ Hout, unsigned char* shm, const int tid) {
    const int dir = chain & 1, h = (chain >> 1) & 3, b = chain >> 3, lane = tid & 63, w = tid >> 6;
    bf16_t* Qs = (bf16_t*)shm; bf16_t* Ks = (bf16_t*)(shm + 17408); bf16_t* VT = (bf16_t*)(shm + 34816); bf16_t* Cs = (bf16_t*)(shm + 53248); bf16_t* Ss = (bf16_t*)(shm + 88064);
    float* sc = (float*)(shm + 97280);
    __syncthreads();
    u32x4 gq[2], gk[2], gv[2], gc[4]; float gn = 0.f;
#pragma unroll
    for (int i = 0; i < 2; ++i) { const int pid = tid + i * 512; const int s = pid >> 4, x0 = (pid & 15) * 8; const size_t toks = (size_t)step_tok(b, dir, c * 64 + s);
        gq[i] = *(const u32x4*)(QKb + toks * 1024 + h * 128 + x0);
        gk[i] = *(const u32x4*)(QKb + toks * 1024 + 512 + h * 128 + x0);
        { const int e = pid >> 3, o = pid & 7;
          gv[i] = *(const u32x4*)(VTg + ((size_t)tokblock_of(b, dir, c) * 512 + h * 128 + e) * 64 + (dir ? 7 - o : o) * 8); } }
#pragma unroll
    for (int i = 0; i < 4; ++i) { const int pid = tid + i * 512; const int e = pid >> 4, x0 = (pid & 15) * 8;
        gc[i] = *(const u32x4*)(CST + ((size_t)(chain * 68 + c) * 128 + e) * 128 + x0); }
    if (tid < 128) gn = NST[(size_t)(chain * 68 + c) * 128 + tid];
    unsigned gi_ = 0u, gf_ = 0u; float gbi = 0.f, gbf = 0.f, m_in = 0.f;
    if (w == 0) { const size_t tokl = (size_t)step_tok(b, dir, c * 64 + lane);
        gi_ = Pm[tokl * LDP + ML_OFF + 2048 + (dir * 2 + 0) * 4 + h]; gf_ = Pm[tokl * LDP + ML_OFF + 2048 + (dir * 2 + 1) * 4 + h];
        gbi = gate_b[(dir * 2 + 0) * 4 + h]; gbf = gate_b[(dir * 2 + 1) * 4 + h]; m_in = MST[chain * 68 + c]; }
#pragma unroll
    for (int i = 0; i < 2; ++i) { const int pid = tid + i * 512; const int s = pid >> 4, x0 = (pid & 15) * 8;
        *(u32x4*)(Qs + s * 136 + x0) = gq[i]; *(u32x4*)(Ks + s * 136 + x0) = gk[i];
        { const int e = pid >> 3, o = pid & 7; *(u32x4*)(VT + e * 72 + o * 8) = dir ? rev8h(gv[i]) : gv[i]; } }
#pragma unroll
    for (int i = 0; i < 4; ++i) { const int pid = tid + i * 512; const int e = pid >> 4, x0 = (pid & 15) * 8; *(u32x4*)(Cs + e * 136 + x0) = gc[i]; }
    if (tid < 128) sc[384 + tid] = gn;
    if (w == 0) {
        const float ig = __uint_as_float(gi_ << 16) + gbi;
        const float fg = __uint_as_float(gf_ << 16) + gbf;
        const float lf = fminf(fg, 0.f) - log1pf(expf(-fabsf(fg)));
        const float bcs = wave_scan_incl(lf, lane); const float gsv = ig - bcs; const float pm = wave_scanmax_incl(gsv, lane);
        const float mt = bcs + fmaxf(m_in, pm);
        sc[lane] = bcs; sc[64 + lane] = gsv; sc[128 + lane] = mt; sc[192 + lane] = expf(bcs + m_in - mt); sc[256 + lane] = expf(-mt);
    }
    __syncthreads();
    const int tt = w >> 1;
    {   f32x4 aS[2] = {(f32x4){0.f, 0.f, 0.f, 0.f}, (f32x4){0.f, 0.f, 0.f, 0.f}};
#pragma unroll
        for (int ks = 0; ks < 4; ++ks) { const bf16x8 af = *(const bf16x8*)(Qs + (16 * tt + (lane & 15)) * 136 + ks * 32 + (lane >> 4) * 8);
#pragma unroll
            for (int i = 0; i < 2; ++i) { const int st = (w & 1) * 2 + i; const bf16x8 bfr = *(const bf16x8*)(Ks + (16 * st + (lane & 15)) * 136 + ks * 32 + (lane >> 4) * 8);
                aS[i] = __builtin_amdgcn_mfma_f32_16x16x32_bf16(af, bfr, aS[i], 0, 0, 0); } }
        float rs[4] = {0.f, 0.f, 0.f, 0.f};
#pragma unroll
        for (int i = 0; i < 2; ++i) { const int s = 16 * ((w & 1) * 2 + i) + (lane & 15); const float gsv = sc[64 + s];
#pragma unroll
            for (int q = 0; q < 4; ++q) { const int t = 16 * tt + (lane >> 4) * 4 + q; const float val = (s <= t) ? aS[i][q] * expf(sc[t] + gsv - sc[128 + t]) : 0.f; Ss[t * 72 + s] = f2bf(val); rs[q] += val; } }
#pragma unroll
        for (int q = 0; q < 4; ++q) { float r = rs[q]; r += __shfl_xor(r, 1); r += __shfl_xor(r, 2); r += __shfl_xor(r, 4); r += __shfl_xor(r, 8);
            if ((lane & 15) == 0) sc[512 + (w & 1) * 64 + 16 * tt + (lane >> 4) * 4 + q] = r; }
        {   const int t = tid >> 3, part = tid & 7; float dot = 0.f;
#pragma unroll
            for (int j = 0; j < 16; ++j) dot += bf2f(Qs[t * 136 + part * 16 + j]) * sc[384 + part * 16 + j];
            dot += __shfl_xor(dot, 1); dot += __shfl_xor(dot, 2); dot += __shfl_xor(dot, 4);
            if (part == 0) sc[640 + t] = sc[192 + t] * dot; }
    }
    __syncthreads();
    {   f32x4 aN[4];
#pragma unroll
        for (int i = 0; i < 4; ++i) aN[i] = (f32x4){0.f, 0.f, 0.f, 0.f};
#pragma unroll
        for (int ks = 0; ks < 4; ++ks) { const bf16x8 af = *(const bf16x8*)(Qs + (16 * tt + (lane & 15)) * 136 + ks * 32 + (lane >> 4) * 8);
#pragma unroll
            for (int i = 0; i < 4; ++i) { const int et = (w & 1) * 4 + i; const bf16x8 bfr = *(const bf16x8*)(Cs + (16 * et + (lane & 15)) * 136 + ks * 32 + (lane >> 4) * 8);
                aN[i] = __builtin_amdgcn_mfma_f32_16x16x32_bf16(bfr, af, aN[i], 0, 0, 0); } }
        const int t = 16 * tt + (lane & 15);
        {   const float it = sc[192 + t];
#pragma unroll
            for (int i = 0; i < 4; ++i) { aN[i][0] *= it; aN[i][1] *= it; aN[i][2] *= it; aN[i][3] *= it; } }
#pragma unroll
        for (int ks = 0; ks < 2; ++ks) { const bf16x8 af = *(const bf16x8*)(Ss + (16 * tt + (lane & 15)) * 72 + ks * 32 + (lane >> 4) * 8);
#pragma unroll
            for (int i = 0; i < 4; ++i) { const int et = (w & 1) * 4 + i; const bf16x8 bfr = *(const bf16x8*)(VT + (16 * et + (lane & 15)) * 72 + ks * 32 + (lane >> 4) * 8);
                aN[i] = __builtin_amdgcn_mfma_f32_16x16x32_bf16(bfr, af, aN[i], 0, 0, 0); } }
        {   const size_t tokt = (size_t)step_tok(b, dir, c * 64 + t); const float dn = fmaxf(fabsf((sc[512 + t] + sc[576 + t]) + sc[640 + t]), sc[256 + t]);
#pragma unroll
            for (int i = 0; i < 4; ++i) { const int e0 = 16 * ((w & 1) * 4 + i) + (lane >> 4) * 4;
                u32x2 wv; wv.x = pk2(aN[i][0] / dn, aN[i][1] / dn); wv.y = pk2(aN[i][2] / dn, aN[i][3] / dn);
                *(u32x2*)(Hout + tokt * BW + h * 128 + e0) = wv; } }
    }
}


#define SD_FRAG_LOAD(BF, XF, cc_) do { const int tb_ = tokblock_of(b, dir, (cc_)); const bf16_t* bb_ = BTg + ((size_t)tb_ * 256 + grp * 128 + 64 * (w >> 2) + r16) * 64 + q4 * 8; const bf16_t* xb_ = XTg + ((size_t)tb_ * 512 + h * 64 + 16 * (w & 3) + r16) * 64 + q4 * 8; \
        _Pragma("unroll") for (int ks_ = 0; ks_ < 2; ++ks_) { XF[ks_] = *(const u32x4*)(xb_ + ks_ * 32); _Pragma("unroll") for (int j_ = 0; j_ < 4; ++j_) BF[j_][ks_] = *(const u32x4*)(bb_ + (size_t)j_ * 16 * 64 + ks_ * 32); } } while (0)
#define SD_CHUNK(c_, BF, XF, BFN, XFN) do { const int c = (c_); \
        if (c + 1 < 68) SD_FRAG_LOAD(BFN, XFN, c + 1); \
        const float dec = sDEC[c]; \
        {   bf16_t* ss = SSTb + (size_t)(chain * 68 + c) * 64 * 128; const int p = 16 * (w & 3) + r16; \
            _Pragma("unroll") for (int j = 0; j < 4; ++j) { const int n0 = 16 * ((w >> 2) * 4 + j) + q4 * 4; u32x2 pk; pk.x = pk2(acc[j][0], acc[j][1]); pk.y = pk2(acc[j][2], acc[j][3]); *(u32x2*)(ss + (size_t)p * 128 + n0) = pk; } } \
        bf16x8 xfr[2]; \
        _Pragma("unroll") for (int ks = 0; ks < 2; ++ks) { const float4 wa = *(const float4*)(sSC + c * 64 + ks * 32 + q4 * 8), wb = *(const float4*)(sSC + c * 64 + ks * 32 + q4 * 8 + 4); const u32x4 sv = scale8h(XF[ks], wa, wb); xfr[ks] = *(const bf16x8*)&sv; } \
        _Pragma("unroll") for (int j = 0; j < 4; ++j) acc[j] = acc[j] * dec; \
        _Pragma("unroll") for (int ks = 0; ks < 2; ++ks) _Pragma("unroll") for (int j = 0; j < 4; ++j) acc[j] = __builtin_amdgcn_mfma_f32_16x16x32_bf16(*(const bf16x8*)&BF[j][ks], xfr[ks], acc[j], 0, 0, 0); } while (0)
__device__ __forceinline__ void ssd_state_pass(const int chain, const bf16_t* __restrict__ Pm, const bf16_t* __restrict__ BTg, const bf16_t* __restrict__ XTg, const float Aa, const float dtb,
                                               bf16_t* __restrict__ SSTb, unsigned char* shm, const int tid) {
    const int dir = chain & 1, h = (chain >> 1) & 7, b = chain >> 4, grp = h >> 2, lane = tid & 63, w = tid >> 6, q4 = lane >> 4, r16 = lane & 15;
    float* sSC = (float*)shm; float* sDEC = sSC + 68 * 64;
    const int dcol = SSD_OFF + 1536 + dir * 8 + h;
    u32x4 bfA[4][2], xfA[2], bfB[4][2], xfB[2];
    SD_FRAG_LOAD(bfA, xfA, 0);
    __syncthreads();
    unsigned dt_[9];
#pragma unroll
    for (int q = 0; q < 9; ++q) { const int c = min(w + 8 * q, 67); dt_[q] = Pm[(size_t)step_tok(b, dir, c * 64 + lane) * LDP + dcol]; }
#pragma unroll
    for (int q = 0; q < 9; ++q) { const int c = w + 8 * q; if (c >= 68) break;
        const float xv = __uint_as_float(dt_[q] << 16) + dtb; const float dtv = xv > 20.f ? xv : log1pf(expf(xv));
        const float cs = wave_scan_incl(dtv * Aa, lane); const float cl = __shfl(cs, 63);
        sSC[c * 64 + (dir ? 63 - lane : lane)] = dtv * expf(cl - cs); if (lane == 0) sDEC[c] = expf(cl); }
    __syncthreads();
    f32x4 acc[4];
#pragma unroll
    for (int j = 0; j < 4; ++j) acc[j] = (f32x4){0.f, 0.f, 0.f, 0.f};
    for (int c2 = 0; c2 < 68; c2 += 2) { SD_CHUNK(c2, bfA, xfA, bfB, xfB); SD_CHUNK(c2 + 1, bfB, xfB, bfA, xfA); }
    __syncthreads();
}
#undef SD_CHUNK
#undef SD_FRAG_LOAD
__device__ __forceinline__ void ssd_out_item(const int chain, const int c, const bf16_t* __restrict__ Pm, const bf16_t* __restrict__ XBb, const bf16_t* __restrict__ XTg, const float Aa, const float dtb,
                                             const bf16_t* __restrict__ SSTb, bf16_t* __restrict__ Yout, unsigned char* shm, const int tid) {
    const int dir = chain & 1, h = (chain >> 1) & 7, b = chain >> 4, grp = h >> 2, lane = tid & 63, w = tid >> 6;
    bf16_t* Cs = (bf16_t*)shm; bf16_t* Bs = (bf16_t*)(shm + 17408); bf16_t* XT = (bf16_t*)(shm + 34816); bf16_t* Sin = (bf16_t*)(shm + 44032); bf16_t* Gs = (bf16_t*)(shm + 61440);
    float* sc = (float*)(shm + 70656);
    __syncthreads();
    u32x4 gb[2], gcc[2], gs[2], gx; unsigned gd_ = 0u;
#pragma unroll
    for (int i = 0; i < 2; ++i) { const int pid = tid + i * 512; const int s = pid >> 4, x0 = (pid & 15) * 8; const size_t toks = (size_t)step_tok(b, dir, c * 64 + s);
        gb[i] = *(const u32x4*)(XBb + toks * 1024 + 512 + grp * 128 + x0);
        gcc[i] = *(const u32x4*)(XBb + toks * 1024 + 768 + grp * 128 + x0);
        const int p = pid >> 4;
        gs[i] = *(const u32x4*)(SSTb + ((size_t)(chain * 68 + c) * 64 + p) * 128 + x0); }
    {   const int p = tid >> 3, o = tid & 7;
        gx = *(const u32x4*)(XTg + ((size_t)tokblock_of(b, dir, c) * 512 + h * 64 + p) * 64 + (dir ? 7 - o : o) * 8); }
    if (w == 0) gd_ = Pm[(size_t)step_tok(b, dir, c * 64 + lane) * LDP + SSD_OFF + 1536 + dir * 8 + h];
#pragma unroll
    for (int i = 0; i < 2; ++i) { const int pid = tid + i * 512; const int s = pid >> 4, x0 = (pid & 15) * 8;
        *(u32x4*)(Bs + s * 136 + x0) = gb[i]; *(u32x4*)(Cs + s * 136 + x0) = gcc[i]; *(u32x4*)(Sin + s * 136 + x0) = gs[i]; }
    {   const int p = tid >> 3, o = tid & 7; *(u32x4*)(XT + p * 72 + o * 8) = dir ? rev8h(gx) : gx; }
    if (w == 0) {
        const float xv = __uint_as_float(gd_ << 16) + dtb; const float dtv = xv > 20.f ? xv : log1pf(expf(xv));
        sc[lane] = wave_scan_incl(dtv * Aa, lane); sc[64 + lane] = dtv; }
    __syncthreads();
    {   const int lt = w >> 1;
        f32x4 aG[2] = {(f32x4){0.f, 0.f, 0.f, 0.f}, (f32x4){0.f, 0.f, 0.f, 0.f}};
#pragma unroll
        for (int ks = 0; ks < 4; ++ks) { const bf16x8 af = *(const bf16x8*)(Cs + (16 * lt + (lane & 15)) * 136 + ks * 32 + (lane >> 4) * 8);
#pragma unroll
            for (int i = 0; i < 2; ++i) { const int st = (w & 1) * 2 + i; const bf16x8 bfr = *(const bf16x8*)(Bs + (16 * st + (lane & 15)) * 136 + ks * 32 + (lane >> 4) * 8);
                aG[i] = __builtin_amdgcn_mfma_f32_16x16x32_bf16(af, bfr, aG[i], 0, 0, 0); } }
#pragma unroll
        for (int i = 0; i < 2; ++i) { const int s = 16 * ((w & 1) * 2 + i) + (lane & 15); const float css = sc[s], dts = sc[64 + s];
#pragma unroll
            for (int q = 0; q < 4; ++q) { const int t = 16 * lt + (lane >> 4) * 4 + q; const float val = (s <= t) ? aG[i][q] * expf(sc[t] - css) * dts : 0.f; Gs[t * 72 + s] = f2bf(val); } }
    }
    __syncthreads();
    {   const int lt = w >> 1;
        f32x4 aY[2] = {(f32x4){0.f, 0.f, 0.f, 0.f}, (f32x4){0.f, 0.f, 0.f, 0.f}};
#pragma unroll
        for (int ks = 0; ks < 4; ++ks) { const bf16x8 af = *(const bf16x8*)(Cs + (16 * lt + (lane & 15)) * 136 + ks * 32 + (lane >> 4) * 8);
#pragma unroll
            for (int i = 0; i < 2; ++i) { const int pt = (w & 1) * 2 + i; const bf16x8 bfr = *(const bf16x8*)(Sin + (16 * pt + (lane & 15)) * 136 + ks * 32 + (lane >> 4) * 8);
                aY[i] = __builtin_amdgcn_mfma_f32_16x16x32_bf16(bfr, af, aY[i], 0, 0, 0); } }
        const int t = 16 * lt + (lane & 15);
        {   const float ec = expf(sc[t]);
#pragma unroll
            for (int i = 0; i < 2; ++i) { aY[i][0] *= ec; aY[i][1] *= ec; aY[i][2] *= ec; aY[i][3] *= ec; } }
#pragma unroll
        for (int ks = 0; ks < 2; ++ks) { const bf16x8 af = *(const bf16x8*)(Gs + (16 * lt + (lane & 15)) * 72 + ks * 32 + (lane >> 4) * 8);
#pragma unroll
            for (int i = 0; i < 2; ++i) { const int pt = (w & 1) * 2 + i; const bf16x8 bfr = *(const bf16x8*)(XT + (16 * pt + (lane & 15)) * 72 + ks * 32 + (lane >> 4) * 8);
                aY[i] = __builtin_amdgcn_mfma_f32_16x16x32_bf16(bfr, af, aY[i], 0, 0, 0); } }
        {   const size_t tokt = (size_t)step_tok(b, dir, c * 64 + t);
#pragma unroll
            for (int i = 0; i < 2; ++i) { const int p0 = 16 * ((w & 1) * 2 + i) + (lane >> 4) * 4;
                u32x2 wv; wv.x = pk2(aY[i][0], aY[i][1]); wv.y = pk2(aY[i][2], aY[i][3]);
                *(u32x2*)(Yout + tokt * BW + h * 64 + p0) = wv; } }
    }
}


#define FIDX(i) ((i) + ((i) >> 4))
#define FFT_X_BYTES 69632
__device__ constexpr float FFT_CW_RE[6][16] = {{0.f, 0.f, 0.f, 0.f, 0.f, 0.f, 0.f, 0.f, 0.f, 0.f, 0.f, 0.f, 0.f, 0.f, 0.f, 0.f}, {1.0f, 0.f, 0.f, 0.f, 0.f, 0.f, 0.f, 0.f, 0.f, 0.f, 0.f, 0.f, 0.f, 0.f, 0.f, 0.f}, {1.0f, 6.123233995736766e-17f, 0.f, 0.f, 0.f, 0.f, 0.f, 0.f, 0.f, 0.f, 0.f, 0.f, 0.f, 0.f, 0.f, 0.f}, {1.0f, 0.7071067811865476f, 6.123233995736766e-17f, -0.7071067811865475f, 0.f, 0.f, 0.f, 0.f, 0.f, 0.f, 0.f, 0.f, 0.f, 0.f, 0.f, 0.f}, {1.0f, 0.9238795325112867f, 0.7071067811865476f, 0.38268343236508984f, 6.123233995736766e-17f, -0.3826834323650897f, -0.7071067811865475f, -0.9238795325112867f, 0.f, 0.f, 0.f, 0.f, 0.f, 0.f, 0.f, 0.f}, {1.0f, 0.9807852804032304f, 0.9238795325112867f, 0.8314696123025452f, 0.7071067811865476f, 0.5555702330196023f, 0.38268343236508984f, 0.19509032201612833f, 6.123233995736766e-17f, -0.1950903220161282f, -0.3826834323650897f, -0.555570233019602f, -0.7071067811865475f, -0.8314696123025453f, -0.9238795325112867f, -0.9807852804032304f}};
__device__ constexpr float FFT_CW_IM[6][16] = {{0.f, 0.f, 0.f, 0.f, 0.f, 0.f, 0.f, 0.f, 0.f, 0.f, 0.f, 0.f, 0.f, 0.f, 0.f, 0.f}, {-0.0f, 0.f, 0.f, 0.f, 0.f, 0.f, 0.f, 0.f, 0.f, 0.f, 0.f, 0.f, 0.f, 0.f, 0.f, 0.f}, {-0.0f, -1.0f, 0.f, 0.f, 0.f, 0.f, 0.f, 0.f, 0.f, 0.f, 0.f, 0.f, 0.f, 0.f, 0.f, 0.f}, {-0.0f, -0.7071067811865475f, -1.0f, -0.7071067811865476f, 0.f, 0.f, 0.f, 0.f, 0.f, 0.f, 0.f, 0.f, 0.f, 0.f, 0.f, 0.f}, {-0.0f, -0.3826834323650898f, -0.7071067811865475f, -0.9238795325112867f, -1.0f, -0.9238795325112867f, -0.7071067811865476f, -0.3826834323650899f, 0.f, 0.f, 0.f, 0.f, 0.f, 0.f, 0.f, 0.f}, {-0.0f, -0.19509032201612825f, -0.3826834323650898f, -0.5555702330196022f, -0.7071067811865475f, -0.8314696123025452f, -0.9238795325112867f, -0.9807852804032304f, -1.0f, -0.9807852804032304f, -0.9238795325112867f, -0.8314696123025455f, -0.7071067811865476f, -0.5555702330196022f, -0.3826834323650899f, -0.1950903220161286f}};
__host__ __device__ constexpr int fft_bitrev(int k, int R) { int r = 0; for (int i = 0; i < R; ++i) if (k & (1 << i)) r |= 1 << (R - 1 - i); return r; }
template <int R, bool INV>
__device__ __forceinline__ void fft_pass(float2* __restrict__ X, const float2* __restrict__ TW, const int s0, const int gidx) {
    const int lowbits = 13 - s0 - R; const int stride = 1 << lowbits;
    const int low = gidx & (stride - 1), high = gidx >> lowbits; const int base = (high << (lowbits + R)) | low;
    const int p0 = FIDX(base);
#define FFT_SLOT(k) (lowbits >= 4 ? p0 + (k) * (stride + (stride >> 4)) : p0 + (k) + ((k) >> 4))
    float2 v[1 << R];
#pragma unroll
    for (int k = 0; k < (1 << R); ++k) v[k] = X[FFT_SLOT(k)];
    const int lw = low << s0;
    if (!INV) {
#pragma unroll
        for (int j = 0; j < R; ++j) { const int hk = 1 << (R - 1 - j);
#pragma unroll
            for (int k = 0; k < (1 << R); ++k) if (!(k & hk)) { const int kk = k & (hk - 1);
                const float2 a = v[k], b = v[k + hk]; v[k] = make_float2(a.x + b.x, a.y + b.y); const float dx = a.x - b.x, dy = a.y - b.y;
                if (kk == 0) v[k + hk] = make_float2(dx, dy);
                else if (2 * kk == hk) v[k + hk] = make_float2(dy, -dx);
                else { const float cr = FFT_CW_RE[R - j][kk], ci = FFT_CW_IM[R - j][kk]; v[k + hk] = make_float2(dx * cr - dy * ci, dx * ci + dy * cr); } } }
        if (lowbits > 0) {
#pragma unroll
            for (int k = 1; k < (1 << R); ++k) { const float2 w = TW[(lw * fft_bitrev(k, R)) & 8191]; const float2 a = v[k]; v[k] = make_float2(a.x * w.x - a.y * w.y, a.x * w.y + a.y * w.x); } }
    } else {
        if (lowbits > 0) {
#pragma unroll
            for (int k = 1; k < (1 << R); ++k) { const float2 w = TW[(lw * fft_bitrev(k, R)) & 8191]; const float2 a = v[k]; v[k] = make_float2(a.x * w.x + a.y * w.y, a.y * w.x - a.x * w.y); } }
#pragma unroll
        for (int j = R - 1; j >= 0; --j) { const int hk = 1 << (R - 1 - j);
#pragma unroll
            for (int k = 0; k < (1 << R); ++k) if (!(k & hk)) { const int kk = k & (hk - 1);
                const float2 a = v[k], b = v[k + hk]; float tx, ty;
                if (kk == 0) { tx = b.x; ty = b.y; }
                else if (2 * kk == hk) { tx = -b.y; ty = b.x; }
                else { const float cr = FFT_CW_RE[R - j][kk], ci = FFT_CW_IM[R - j][kk]; tx = b.x * cr + b.y * ci; ty = b.y * cr - b.x * ci; }
                v[k] = make_float2(a.x + tx, a.y + ty); v[k + hk] = make_float2(a.x - tx, a.y - ty); } }
    }
#pragma unroll
    for (int k = 0; k < (1 << R); ++k) X[FFT_SLOT(k)] = v[k];
#undef FFT_SLOT
}
__device__ __forceinline__ void fft_fwd(float2* X, const float2* TW, const int tid) {
    fft_pass<4, false>(X, TW, 0, tid); __syncthreads(); fft_pass<4, false>(X, TW, 4, tid); __syncthreads(); if (tid < 256) fft_pass<5, false>(X, TW, 8, tid); __syncthreads(); }
__device__ __forceinline__ void fft_inv(float2* X, const float2* TW, const int tid) {
    if (tid < 256) fft_pass<5, true>(X, TW, 8, tid); __syncthreads(); fft_pass<4, true>(X, TW, 4, tid); __syncthreads(); fft_pass<4, true>(X, TW, 0, tid); __syncthreads(); }
__device__ __forceinline__ void fft_twiddles(float2* TW, const int tid) {
#pragma unroll
    for (int k = 0; k < 16; ++k) { const int m = tid + k * 512; const float xx = (float)m * (1.0f / 4096.0f); TW[m] = make_float2(cospif(xx), -sinpif(xx)); }
}
__device__ __forceinline__ void hyena_spec_item(const int pr, const float* __restrict__ HR, const float* __restrict__ nrm, float2* __restrict__ HSPEC, unsigned char* shm, const int tid) {
    float2* X = (float2*)shm; const float2* TW = (const float2*)(shm + FFT_X_BYTES);
    const int o = pr >> 8, c = (pr & 255) * 2, oc = o * 512 + c; const float inva = 1.0f / nrm[oc], invb = 1.0f / nrm[oc + 1];
    __syncthreads();
    float2 hv[16];
#pragma unroll
    for (int k = 0; k < 16; ++k) { const int j = tid + k * 512;
        const unsigned off = j < SEQ ? (unsigned)j * 2048u + o * 1024 + c : j == SEQ ? (unsigned)(o * 1024 + c) : (unsigned)(2 * SEQ - j) * 2048u + o * 1024 + 512 + c;
        hv[k] = *(const float2*)(HR + off); }
#pragma unroll
    for (int k = 0; k < 16; ++k) { const int j = tid + k * 512; X[FIDX(j)] = j == SEQ ? make_float2(0.f, 0.f) : make_float2(hv[k].x * inva, hv[k].y * invb); }
    __syncthreads();
    fft_fwd(X, TW, tid);
    float4* outa = (float4*)(HSPEC + (size_t)oc * 8192 + tid * 16); float4* outb = (float4*)(HSPEC + (size_t)(oc + 1) * 8192 + tid * 16); const float2* xs = X + 17 * tid;
    const float sc_ = 0.5f / 8192.0f;
#pragma unroll
    for (int k = 0; k < 8; ++k) { float2 ha[2], hb[2];
#pragma unroll
        for (int q = 0; q < 2; ++q) { const int p = 16 * tid + 2 * k + q; const int kf = (int)(__builtin_bitreverse32((unsigned)p) >> 19); const int p2 = (int)(__builtin_bitreverse32((unsigned)((8192 - kf) & 8191)) >> 19);
            const float2 xp = xs[2 * k + q], xq = X[FIDX(p2)];
            ha[q] = make_float2((xp.x + xq.x) * sc_, (xp.y - xq.y) * sc_);
            hb[q] = make_float2((xp.y + xq.y) * sc_, (xq.x - xp.x) * sc_); }
        outa[k] = make_float4(ha[0].x, ha[0].y, ha[1].x, ha[1].y); outb[k] = make_float4(hb[0].x, hb[0].y, hb[1].x, hb[1].y); }
}
__device__ __forceinline__ void fft_mul_spec(float2* X, const float2* __restrict__ H, const int tid) {
    const float4* h4 = (const float4*)(H + tid * 16); float2* xs = X + 17 * tid;
#pragma unroll
    for (int k = 0; k < 8; ++k) { const float4 hv = h4[k]; const float2 x0 = xs[2 * k], x1 = xs[2 * k + 1];
        xs[2 * k] = make_float2(x0.x * hv.x - x0.y * hv.y, x0.x * hv.y + x0.y * hv.x); xs[2 * k + 1] = make_float2(x1.x * hv.z - x1.y * hv.w, x1.x * hv.w + x1.y * hv.z); }
}
__device__ __forceinline__ void hyena_fft_item(const int item, const bf16_t* __restrict__ UT, const float2* __restrict__ HSPEC, const float* __restrict__ bias, float* __restrict__ YT, unsigned char* shm, const int tid) {
    float2* X = (float2*)shm; const float2* TW = (const float2*)(shm + FFT_X_BYTES);
    const int c = item >> 1, b0 = (item & 1) * 2, b1 = b0 + 1;
    const bf16_t* u0 = UT + (size_t)(b0 * 1536 + c) * SEQ + tid * 8; const bf16_t* u1 = UT + (size_t)(b1 * 1536 + c) * SEQ + tid * 8;
    const float bias0 = bias[c], bias1 = bias[512 + c];
    float2* xs = X + FIDX(8 * tid);
    float vr[8], vi[8];
    __syncthreads();
    { const u32x4 a0 = *(const u32x4*)u0, c0 = *(const u32x4*)u1; unpack8(a0, vr); unpack8(c0, vi); }
#pragma unroll
    for (int k = 0; k < 8; ++k) { xs[k] = make_float2(vr[k], vi[k]); xs[4352 + k] = make_float2(0.f, 0.f); }
    __syncthreads();
    fft_fwd(X, TW, tid);
    fft_mul_spec(X, HSPEC + (size_t)c * 8192, tid);
    __syncthreads();
    fft_inv(X, TW, tid);
    { const bf16_t* p0 = u0 + (size_t)512 * SEQ; const bf16_t* p1 = u1 + (size_t)512 * SEQ;
      float xr[8], xi[8]; { const u32x4 a0 = *(const u32x4*)p0, c0 = *(const u32x4*)p1; unpack8(a0, xr); unpack8(c0, xi); }
#pragma unroll
      for (int k = 0; k < 8; ++k) { const float2 cv = xs[k]; const float zr = xr[k] * (cv.x + bias0 * vr[k]), zi = xi[k] * (cv.y + bias0 * vi[k]);
          vr[k] = zr; vi[k] = zi; xs[k] = make_float2(zr, zi); xs[4352 + k] = make_float2(0.f, 0.f); } }
    __syncthreads();
    fft_fwd(X, TW, tid);
    fft_mul_spec(X, HSPEC + (size_t)(512 + c) * 8192, tid);
    __syncthreads();
    fft_inv(X, TW, tid);
    { const bf16_t* p0 = u0 + (size_t)1024 * SEQ; const bf16_t* p1 = u1 + (size_t)1024 * SEQ;
      float xr[8], xi[8]; { const u32x4 a0 = *(const u32x4*)p0, c0 = *(const u32x4*)p1; unpack8(a0, xr); unpack8(c0, xi); }
      float yr[8], yi[8];
#pragma unroll
      for (int k = 0; k < 8; ++k) { const float2 cv = xs[k]; yr[k] = xr[k] * (cv.x + bias1 * vr[k]); yi[k] = xi[k] * (cv.y + bias1 * vi[k]); }
      float* y0 = YT + (size_t)(b0 * 512 + c) * SEQ + tid * 8; float* y1 = YT + (size_t)(b1 * 512 + c) * SEQ + tid * 8;
      *(float4*)y0 = make_float4(yr[0], yr[1], yr[2], yr[3]); *(float4*)(y0 + 4) = make_float4(yr[4], yr[5], yr[6], yr[7]);
      *(float4*)y1 = make_float4(yi[0], yi[1], yi[2], yi[3]); *(float4*)(y1 + 4) = make_float4(yi[4], yi[5], yi[6], yi[7]); }
}

constexpr size_t al256(size_t x) { return (x + 255) & ~(size_t)255; }
constexpr size_t O_BAR = 0;
constexpr size_t O_MOD = 16384;
constexpr size_t O_NORM = O_MOD + al256((size_t)2 * 5 * 6 * DM * 4);
constexpr size_t O_QCTR = O_NORM + al256((size_t)2 * 2 * 1024 * 4);
constexpr size_t O_ZERO_END = O_QCTR + 512;
constexpr size_t O_XS = O_ZERO_END;
constexpr size_t O_HB = O_XS + al256((size_t)NTOK * DM * 4);
constexpr size_t O_P = O_HB + al256((size_t)NTOK * DM * 2);
constexpr size_t O_WIN = O_P + al256((size_t)NTOK * LDP * 2);
constexpr size_t O_WBR = O_WIN + al256((size_t)LDP * DM * 2);
constexpr size_t O_WOUT = O_WBR + al256((size_t)4 * DM * BW * 2);
constexpr size_t O_WGU = O_WOUT + al256((size_t)DM * DM * 2);
constexpr size_t O_WD = O_WGU + al256((size_t)NEXP * 2 * DEXP * DM * 2);
constexpr size_t O_GLU = O_WD + al256((size_t)NEXP * DM * DEXP * 2);
constexpr size_t O_Y4 = O_GLU + al256((size_t)BW * BW * 2);
constexpr size_t O_U = O_Y4 + al256((size_t)NTOK * DM * 2);
constexpr size_t O_QKB = O_U + al256((size_t)NTOK * 1536 * 4);
constexpr size_t O_CST = O_QKB + al256((size_t)NTOK * 1024 * 2);
constexpr size_t O_NST = O_CST + al256((size_t)32 * 68 * 128 * 128 * 2);
constexpr size_t O_MST = O_NST + al256((size_t)32 * 68 * 128 * 4);
constexpr size_t O_XBC = O_MST + al256((size_t)32 * 68 * 4);
constexpr size_t O_SST = O_XBC + al256((size_t)NTOK * 1024 * 2);
constexpr size_t O_HF = O_SST + al256((size_t)64 * 68 * 64 * 128 * 2);
constexpr size_t O_YF = O_HF + al256((size_t)2 * NTOK * BW * 4);
constexpr size_t O_SF = O_YF + al256((size_t)2 * NTOK * BW * 4);
constexpr size_t O_LDT = O_SF + al256((size_t)2 * NCTX * BW * 4);
constexpr size_t O_AP = O_LDT + al256((size_t)4096 * 16);
constexpr size_t O_BBT = O_AP + al256((size_t)4096 * 33 * 8);
constexpr size_t O_KT = O_BBT + al256((size_t)4096 * 16 * 8);
constexpr size_t O_S5A = O_KT + al256((size_t)32 * 2 * 32 * 256 * 4);
constexpr size_t O_S5B = O_S5A + al256((size_t)32 * 512 * 768 * 2);
constexpr size_t O_XCTX = O_S5B + al256((size_t)32 * 512 * 768 * 2);
constexpr size_t O_Z = O_XCTX + al256((size_t)4 * 32 * 2 * 64 * 8);
constexpr size_t O_HRAW = O_Z + al256((size_t)NTOK * BW * 4);
constexpr size_t O_HSPEC = O_HRAW + al256((size_t)(SEQ + CTXL) * 2048 * 4);
constexpr size_t O_K2C = O_HSPEC + al256((size_t)1024 * 8192 * 8);
constexpr size_t O_GG = O_K2C + al256((size_t)(2 * CTXL) * 1024 * 4);
constexpr size_t O_PROBS = O_GG + al256((size_t)NTOK * BW * 2);
constexpr size_t O_ROWTOK = O_PROBS + al256((size_t)NTOK * 16 * 4);
constexpr size_t O_ROWGATE = O_ROWTOK + al256((size_t)NEXP * MOE_PAD * 4);
constexpr size_t O_INV = O_ROWGATE + al256((size_t)NEXP * MOE_PAD * 4);
constexpr size_t O_NORMP = O_INV + al256((size_t)NTOK * 16 * 4);
constexpr size_t WS_END = O_NORMP + al256((size_t)4 * 256 * 2048 * 4);
constexpr size_t O_XG = O_P;
constexpr size_t O_HID = O_P + al256((size_t)NEXP * MOE_PAD * DM * 2);
constexpr size_t O_YEXP = O_HID + al256((size_t)NEXP * MOE_PAD * DEXP * 2);
static_assert(O_YEXP + (size_t)NEXP * MOE_PAD * DM * 2 <= O_WIN, "MoE temporaries must fit inside P");
static_assert((size_t)NTOK * DM * 2 <= (size_t)NTOK * 1536 * 4, "ACCb must fit inside U");
static_assert((size_t)26214400 + (size_t)2 * 17825792 + (size_t)272 * 256 * 64 * 2 <= (size_t)NTOK * DM * 2, "strip buffers must fit inside HB");
static_assert(WS_END <= (size_t)1851000000, "workspace map exceeds the guaranteed size");

struct Args {
    const float* in[47];
    float* out; unsigned char* ws;
    int ph_lo, ph_hi;
};

__device__ __forceinline__ void conv_tile(const float* __restrict__ src, int ldsrc, int nvalid, int k0, int n0, bf16_t* __restrict__ dst, int lddst, int mode, float* T, int tid) {
    { const int n = tid & 63, kr = tid >> 6;
#pragma unroll
      for (int i = 0; i < 8; ++i) { const int k = i * 8 + kr; T[k * 65 + n] = (n0 + n < nvalid) ? src[(size_t)(k0 + k) * ldsrc + n0 + n] : 0.f; } }
    __syncthreads();
    { const int n = tid >> 3, kc = (tid & 7) * 8; const int gn = n0 + n;
      const int drow = mode == 0 ? gn : (32 * (gn >> 4) + (mode == 2 ? 16 : 0) + (gn & 15));
      u32x4 w; w.x = pk2(T[(kc + 0) * 65 + n], T[(kc + 1) * 65 + n]); w.y = pk2(T[(kc + 2) * 65 + n], T[(kc + 3) * 65 + n]);
      w.z = pk2(T[(kc + 4) * 65 + n], T[(kc + 5) * 65 + n]); w.w = pk2(T[(kc + 6) * 65 + n], T[(kc + 7) * 65 + n]);
      *(u32x4*)(dst + (size_t)drow * lddst + k0 + kc) = w; }
    __syncthreads();
}

#define IN(id) (lo <= (id) && (id) < hi)
#define SEAM(id) do { if (hi > (id) + 1) xcd_barrier(bar); } while (0)
#define PH_BEGIN int tid = threadIdx.x; asm volatile("" : "+v"(tid) :: "memory"); const int lane = tid & 63, wave = tid >> 6; (void)lane; (void)wave;

#define x_in (PT(0))
#define c_in (PT(1))
#define ctx_in (PT(2))
#define cctx_in (PT(3))
#define ada_w (PT(4))
#define ada_b (PT(5))
#define norm_mix (PT(6))
#define norm_ffn (PT(7))
#define w_in (PT(8))
#define XS ((float*)(a.ws + O_XS))
#define MOD ((float*)(a.ws + O_MOD))
#define NORM ((float*)(a.ws + O_NORM))
#define NORMP ((float*)(a.ws + O_NORMP))
#define MODl (MOD + (size_t)l * 5 * 6 * DM)
#define HB ((bf16_t*)(a.ws + O_HB))
#define P ((bf16_t*)(a.ws + O_P))
#define WIN ((bf16_t*)(a.ws + O_WIN))
#define WBR ((bf16_t*)(a.ws + O_WBR))
#define WOUT ((bf16_t*)(a.ws + O_WOUT))
#define WGU ((bf16_t*)(a.ws + O_WGU))
#define WD ((bf16_t*)(a.ws + O_WD))
#define GLU ((bf16_t*)(a.ws + O_GLU))
#define Y4 ((bf16_t*)(a.ws + O_Y4))
#define U ((float*)(a.ws + O_U))
#define ACCb ((bf16_t*)(a.ws + O_U))
#define QKB ((bf16_t*)(a.ws + O_QKB))
#define CST ((bf16_t*)(a.ws + O_CST))
#define NST ((float*)(a.ws + O_NST))
#define MST ((float*)(a.ws + O_MST))
#define XBC ((bf16_t*)(a.ws + O_XBC))
#define SSTB ((bf16_t*)(a.ws + O_SST))
#define HF ((bf16_t*)(a.ws + O_HF))
#define HBk (HF + (size_t)NTOK * BW)
#define YF ((bf16_t*)(a.ws + O_YF))
#define YB (YF + (size_t)NTOK * BW)
#define SF ((float*)(a.ws + O_SF))
#define SB (SF + (size_t)NCTX * BW)
#define LDT ((double2*)(a.ws + O_LDT))
#define APW ((float2*)(a.ws + O_AP))
#define BBT ((float2*)(a.ws + O_BBT))
#define KTB ((float*)(a.ws + O_KT))
#define S5A ((bf16_t*)(a.ws + O_S5A))
#define S5B ((bf16_t*)(a.ws + O_S5B))
#define XCTX ((float2*)(a.ws + O_XCTX))
#define S5P ((bf16_t*)(a.ws + O_HB))
#define XLOC ((float*)(a.ws + O_HB + (size_t)32 * 256 * 512 * 2))
#define KTG ((bf16_t*)(a.ws + O_HB + (size_t)26214400))
#define VTG ((bf16_t*)(a.ws + O_HB + (size_t)26214400 + (size_t)17825792))
#define BTG ((bf16_t*)(a.ws + O_HB + (size_t)26214400 + (size_t)2 * 17825792))
#define XTG ((bf16_t*)(a.ws + O_GG))
#define Z ((float*)(a.ws + O_Z))
#define HRAW ((float*)(a.ws + O_HRAW))
#define HSPEC ((float2*)(a.ws + O_HSPEC))
#define UT ((bf16_t*)(a.ws + O_U))
#define YT ((float*)(a.ws + O_Z))
#define QCTR ((int*)(a.ws + O_QCTR))
#define K2C ((float*)(a.ws + O_K2C))
#define GG ((bf16_t*)(a.ws + O_GG))
#define PROBS ((float*)(a.ws + O_PROBS))
#define ROWTOK ((int*)(a.ws + O_ROWTOK))
#define ROWGATE ((float*)(a.ws + O_ROWGATE))
#define XG ((bf16_t*)(a.ws + O_XG))
#define HID ((bf16_t*)(a.ws + O_HID))
#define YEXP ((bf16_t*)(a.ws + O_YEXP))
#define INV ((int*)(a.ws + O_INV))


__device__ __forceinline__ void moe_pair(float4 (&a)[8], const int r1, const int r2, const float g2scale, const int lane, const float* __restrict__ rowgate, const bf16_t* __restrict__ yexp) {
    const float gt1 = rowgate[r1], gt2 = rowgate[r2] * g2scale;
    const bf16_t* y1 = yexp + (size_t)r1 * DM + lane * 4; const bf16_t* y2 = yexp + (size_t)r2 * DM + lane * 4;
    u32x2 w1[8], w2[8];
#pragma unroll
    for (int i = 0; i < 8; ++i) { w1[i] = *(const u32x2*)(y1 + i * 256); w2[i] = *(const u32x2*)(y2 + i * 256); }
#pragma unroll
    for (int i = 0; i < 8; ++i) {
        a[i].x += gt1 * __uint_as_float(w1[i].x << 16); a[i].y += gt1 * __uint_as_float(w1[i].x & 0xFFFF0000u); a[i].z += gt1 * __uint_as_float(w1[i].y << 16); a[i].w += gt1 * __uint_as_float(w1[i].y & 0xFFFF0000u);
        a[i].x += gt2 * __uint_as_float(w2[i].x << 16); a[i].y += gt2 * __uint_as_float(w2[i].x & 0xFFFF0000u); a[i].z += gt2 * __uint_as_float(w2[i].y << 16); a[i].w += gt2 * __uint_as_float(w2[i].y & 0xFFFF0000u); }
}
__device__ __forceinline__ void moe_combine(float4 (&v)[8], const int tok, const int lane, const int* __restrict__ inv, const float* __restrict__ rowgate, const bf16_t* __restrict__ yexp, const float* __restrict__ m5) {
    float4 a[8], mm[8];
#pragma unroll
    for (int i = 0; i < 8; ++i) { a[i] = make_float4(0.f, 0.f, 0.f, 0.f); mm[i] = *(const float4*)(m5 + i * 256 + lane * 4); }
    const int4* ip = (const int4*)(inv + (size_t)tok * 16);
    const int4 q0 = ip[0], q1 = ip[1], q2 = ip[2], q3 = ip[3];
    const int rows[16] = {q0.x, q0.y, q0.z, q0.w, q1.x, q1.y, q1.z, q1.w, q2.x, q2.y, q2.z, q2.w, q3.x, q3.y, q3.z, q3.w};
    int prow = -1;
#pragma unroll
    for (int e = 0; e < 16; ++e) { const int row = __builtin_amdgcn_readfirstlane(rows[e]);
        if (row >= 0) { if (prow >= 0) { moe_pair(a, prow, row, 1.0f, lane, rowgate, yexp); prow = -1; } else prow = row; } }
    if (prow >= 0) moe_pair(a, prow, prow, 0.0f, lane, rowgate, yexp);
#pragma unroll
    for (int i = 0; i < 8; ++i) { v[i].x += mm[i].x * a[i].x; v[i].y += mm[i].y * a[i].y; v[i].z += mm[i].z * a[i].z; v[i].w += mm[i].w * a[i].w; }
}
struct CvU { const float* src; bf16_t* dst; int ldsrc, nvalid, k0, n0, lddst, mode; };
__device__ __forceinline__ void cv_load(const CvU& u, float4 (&r)[8], const int tid) {
#pragma unroll
    for (int i = 0; i < 8; ++i) { const int idx = tid + i * 512; const int k = idx >> 6, n = u.n0 + (idx & 63) * 4;
        r[i] = (n < u.nvalid) ? *(const float4*)(u.src + (size_t)(u.k0 + k) * u.ldsrc + n) : make_float4(0.f, 0.f, 0.f, 0.f); }
}
__device__ __forceinline__ void cv_stage(float* T, const float4 (&r)[8], const int tid) {
#pragma unroll
    for (int i = 0; i < 8; ++i) { const int idx = tid + i * 512; float* p = T + (idx >> 6) * 257 + (idx & 63) * 4; p[0] = r[i].x; p[1] = r[i].y; p[2] = r[i].z; p[3] = r[i].w; }
}
__device__ __forceinline__ void cv_store(const CvU& u, const float* T, const int tid) {
#pragma unroll
    for (int j = 0; j < 4; ++j) { const int o = tid + j * 512; const int kc = (o & 7) * 8, n = o >> 3; const int gn = u.n0 + n;
        int drow = u.mode == 0 ? gn : (256 * (gn >> 7) + (u.mode == 2 ? 128 : 0) + (gn & 127));
        if (u.mode == 3) {
            if (gn >= IN_W) continue;
            drow = gn;
            if (gn >= GATE_OFF) { const int g = gn - GATE_OFF, kb = g >> 11, col = g & 2047, j2 = col >> 6, rem = col & 63;
                drow = GATE2 + 256 * j2 + 128 * (kb >> 1) + 32 * (rem >> 4) + 8 * ((rem >> 2) & 3) + 4 * (kb & 1) + (rem & 3); } }
        const float* t = T + kc * 257 + n;
        u32x4 w; w.x = pk2(t[0], t[257]); w.y = pk2(t[2 * 257], t[3 * 257]); w.z = pk2(t[4 * 257], t[5 * 257]); w.w = pk2(t[6 * 257], t[7 * 257]);
        *(u32x4*)(u.dst + (size_t)drow * u.lddst + u.k0 + kc) = w; }
}
#define CV_RUN(LL, QSTART, QSTEP, QEND) do { \
                const float* wbr = PT(40) + (size_t)(LL) * 4 * BW * DM; const float* wout = PT(41) + (size_t)(LL) * DM * DM; \
                const float* wg = PT(43) + (size_t)(LL) * NEXP * DM * DEXP; const float* wu = PT(44) + (size_t)(LL) * NEXP * DM * DEXP; const float* wd = PT(45) + (size_t)(LL) * NEXP * DEXP * DM; \
                const float* wglu = PT(32) + (size_t)(LL) * BW * BW; const float* win = w_in + (size_t)(LL) * DM * IN_W; \
                const int cv_step = (QSTEP), cv_end = (QEND); \
                __syncthreads(); \
                int q = (QSTART); int buf = 0; CvU u; float4 r[8]; \
                if (q < cv_end) { CV_DECODE(q, u); cv_load(u, r, tid); } \
                while (q < cv_end) { \
                    float* T = sf + buf * (64 * 257); \
                    cv_stage(T, r, tid); \
                    __syncthreads(); \
                    const CvU cur = u; const int qn = q + cv_step; \
                    if (qn < cv_end) { CV_DECODE(qn, u); cv_load(u, r, tid); } \
                    cv_store(cur, T, tid); \
                    buf ^= 1; q = qn; \
                } \
                __syncthreads(); } while (0)
#define CV_DECODE(q_, u_) do { int qq_ = (q_); \
                    if (qq_ < n_win) { u_ = CvU{win, WIN, IN_W, IN_W, (qq_ / 55) * 64, (qq_ % 55) * 256, DM, 3}; } else { qq_ -= n_win; \
                    if (qq_ < n_br) { const int k = qq_ >> 6, r = qq_ & 63; u_ = CvU{wbr + (size_t)k * BW * DM, WBR + (size_t)k * DM * BW, DM, DM, (r >> 3) * 64, (r & 7) * 256, BW, 0}; } else { qq_ -= n_br; \
                    if (qq_ < n_out) { u_ = CvU{wout, WOUT, DM, DM, (qq_ >> 3) * 64, (qq_ & 7) * 256, DM, 0}; } else { qq_ -= n_out; \
                    if (qq_ < n_glu) { u_ = CvU{wglu, GLU, BW, BW, (qq_ >> 1) * 64, (qq_ & 1) * 256, BW, 0}; } else { qq_ -= n_glu; \
                    if (qq_ < n_gu) { const int e = qq_ / 384, r = qq_ % 384, up = r / 192, r2 = r % 192; u_ = CvU{(up ? wu : wg) + (size_t)e * DM * DEXP, WGU + (size_t)e * 2 * DEXP * DM, DEXP, DEXP, (r2 / 6) * 64, (r2 % 6) * 256, DM, 1 + up}; } else { qq_ -= n_gu; \
                    { const int e = qq_ / 192, r = qq_ % 192; u_ = CvU{wd + (size_t)e * DEXP * DM, WD + (size_t)e * DM * DEXP, DM, DM, (r >> 3) * 64, (r & 7) * 256, DEXP, 0}; } } } } } } } while (0)
template <int LAYER>
__device__ __forceinline__ void layer_body(const Args& a, const XcdBarrier& bar, const int lo, const int hi, const int bid, const int G, unsigned char* const shm, float* const sf, const float** const ptab) {
        constexpr int l = LAYER;
        constexpr int PB = 1 + 16 * l;
        const bool lastl = (l == 1);

        const int nPanels = lastl ? 64 : 68;
        const int M2 = nPanels * 256;

        if (IN(PB + 0)) for (int rep_ = 0; rep_ < (l == 0 ? PROBE_REPS(0) : 1); ++rep_) {
            PH_BEGIN
            {   const int n_win = 32 * 55, n_br = 4 * 64, n_out = 32 * 8, n_glu = 16, n_gu = 16 * 2 * 192, n_d = 16 * 192;
                const int n_grp1 = n_win + n_br + n_out + n_glu, total = n_grp1 + n_gu + n_d;
                const int q_lo = (l > 0 && G > 128) ? n_win : 0;
                const int q_hi = (lastl && G > 64) ? n_grp1 + n_gu : total;
                CV_RUN(l, q_lo + bid, G, q_hi);
                for (int i = bid * NTHR + tid; i < (GATE2 - GATE_OFF) * DM / 8; i += G * NTHR) ((u32x4*)(WIN + (size_t)GATE_OFF * DM))[i] = (u32x4){0u, 0u, 0u, 0u};
            }
            for (int set = 0; set < (lastl ? 1 : 2); ++set) {
                const int L = set ? CTXL : SEQ; float* HR = HRAW + (set ? (size_t)SEQ * 2048 : 0);
                const float* w1 = PT(11) + l * 33 * 64; const float* b1 = PT(12) + l * 64; const float* fr1 = PT(13) + l * 64; const float* w2 = PT(14) + l * 64 * 64; const float* b2 = PT(15) + l * 64;
                const float* fr2 = PT(16) + l * 64; const float* w3 = PT(17) + l * 64 * 2048; const float* decay = PT(18) + l * 2048;
                float* feats = sf; float* h1 = sf + 16 * 33; float* h2 = h1 + 16 * 64;
                float nacc[4] = {0.f, 0.f, 0.f, 0.f};
                for (int base = bid; base < L; base += 16 * G) {
                    __syncthreads();
                    for (int e = tid; e < 16 * 33; e += NTHR) { const int ti = e / 33, fi = e % 33; int t = base + ti * G; if (t > L - 1) t = L - 1;
                        float v;
                        if (fi == 0) v = (float)t / (float)(L - 1);
                        else { const int j = (fi - 1) & 15; const double fr = 1e-4 + (double)j * ((15.0 - 1e-4) / 15.0); const double ang = (2.0 * 3.14159265358979323846 / (double)L) * (double)t * fr; v = fi <= 16 ? (float)cos(ang) : (float)(-sin(ang)); }
                        feats[e] = v; }
                    __syncthreads();
                    { const int j = tid & 63, ti = tid >> 6; float s0 = b1[j], s1 = s0;
_Pragma("unroll 3")
                      for (int i = 0; i < 33; ++i) { const float wv = w1[i * 64 + j]; s0 += feats[ti * 33 + i] * wv; s1 += feats[(ti + 8) * 33 + i] * wv; }
                      const float f1 = fr1[j]; h1[ti * 64 + j] = sinf(f1 * s0); h1[(ti + 8) * 64 + j] = sinf(f1 * s1); }
                    __syncthreads();
                    { const int j = tid & 63, ti = tid >> 6; float s0 = b2[j], s1 = s0;
_Pragma("unroll 4")
                      for (int i = 0; i < 64; ++i) { const float wv = w2[i * 64 + j]; s0 += h1[ti * 64 + i] * wv; s1 += h1[(ti + 8) * 64 + i] * wv; }
                      const float f2 = fr2[j]; h2[ti * 64 + j] = sinf(f2 * s0); h2[(ti + 8) * 64 + j] = sinf(f2 * s1); }
                    __syncthreads();
                    float acc[16][4];
#pragma unroll
                    for (int ti = 0; ti < 16; ++ti) { acc[ti][0] = 0.f; acc[ti][1] = 0.f; acc[ti][2] = 0.f; acc[ti][3] = 0.f; }
#pragma unroll 2
                    for (int i = 0; i < 64; ++i) { const float* wrow = w3 + (size_t)i * 2048 + tid; const float wa = wrow[0], wb = wrow[512], wc2 = wrow[1024], wd2 = wrow[1536];
#pragma unroll
                        for (int ti = 0; ti < 16; ++ti) { const float hv = h2[ti * 64 + i]; acc[ti][0] += hv * wa; acc[ti][1] += hv * wb; acc[ti][2] += hv * wc2; acc[ti][3] += hv * wd2; } }
                    float dk[4];
#pragma unroll
                    for (int k = 0; k < 4; ++k) dk[k] = fabsf(decay[tid + k * 512]);
#pragma unroll
                    for (int ti = 0; ti < 16; ++ti) { const int t = base + ti * G; if (t < L) { const float tn = (float)t / (float)(L - 1);
#pragma unroll
                        for (int k = 0; k < 4; ++k) { const float v = acc[ti][k] * expf(-tn * dk[k]); HR[(size_t)t * 2048 + tid + k * 512] = v; nacc[k] += fabsf(v); } } }
                }
                float* nrp = NORMP + ((size_t)(l * 2 + set) * 256 + bid) * 2048;
#pragma unroll
                for (int k = 0; k < 4; ++k) nrp[tid + k * 512] = nacc[k];
            }
            for (int idx = bid * NTHR + tid; idx < 4096; idx += G * NTHR) { const int n = idx & 63, g = (idx >> 6) & 31, dir = idx >> 11;
                const double are = (double)(PT(24) + l * 4096)[idx], aim = (double)(PT(25) + l * 4096)[idx]; const double lam = are < -1e-4 ? are : -1e-4; const double dt = exp((double)(PT(26) + l * 64)[dir * 32 + g]);
                const double ldre = lam * dt, ldim = aim * dt; LDT[idx] = make_double2(ldre, ldim);
                const double mag = exp(ldre); const double ar = mag * cos(ldim), ai = mag * sin(ldim);
                const double den = lam * lam + aim * aim; const double nr = ar - 1.0, ni = ai; const double fre = (nr * lam + ni * aim) / den, fim = (ni * lam - nr * aim) / den;
                const float* b_re = PT(27) + l * 32 * 64 * 16; const float* b_im = PT(28) + l * 32 * 64 * 16;
#pragma unroll 4
                for (int c = 0; c < 16; ++c) { const double br = (double)b_re[(g * 64 + n) * 16 + c], bi = (double)b_im[(g * 64 + n) * 16 + c]; BBT[idx * 16 + c] = make_float2((float)(fre * br - fim * bi), (float)(fre * bi + fim * br)); }
            }
            for (int e2 = bid * NTHR + tid; e2 < 4096 * 33; e2 += G * NTHR) { const int idx = e2 / 33, k = e2 - idx * 33; const int g = (idx >> 6) & 31, dir = idx >> 11;
                const double are = (double)(PT(24) + l * 4096)[idx], aim = (double)(PT(25) + l * 4096)[idx]; const double lam = are < -1e-4 ? are : -1e-4; const double dt = exp((double)(PT(26) + l * 64)[dir * 32 + g]);
                const double ldre = lam * dt, ldim = aim * dt; const double mk = exp(ldre * k); APW[e2] = make_float2((float)(mk * cos(ldim * k)), (float)(mk * sin(ldim * k))); }
            if (l == 0 && lo == 0) xcd_barrier(bar);
            for (int tok = bid * 8 + wave; tok < NTOK; tok += G * 8) {
                const int r = tok < NLAT ? tok / SEQ : 4; const float* xr = l == 0 ? (tok < NLAT ? x_in + (size_t)tok * DM : ctx_in + (size_t)(tok - NLAT) * DM) : XS + (size_t)tok * DM; const float* gn = norm_mix + l * DM;
                const float* sh = MODl + (size_t)(r * 6 + 0) * DM; const float* sc = MODl + (size_t)(r * 6 + 1) * DM;
                float4 v[8]; float ss = 0.f;
#pragma unroll
                for (int i = 0; i < 8; ++i) v[i] = *(const float4*)(xr + i * 256 + lane * 4);
                if (l > 0) {
                    moe_combine(v, tok, lane, INV, ROWGATE, YEXP, MOD + (size_t)((l - 1) * 5 + r) * 6 * DM + 5 * DM);
#pragma unroll
                    for (int i = 0; i < 8; ++i) *(float4*)(XS + (size_t)tok * DM + i * 256 + lane * 4) = v[i]; }
#pragma unroll
                for (int i = 0; i < 8; ++i) ss += v[i].x * v[i].x + v[i].y * v[i].y + v[i].z * v[i].z + v[i].w * v[i].w;
                ss = wave_sum(ss); const float rs = rsqrtf(ss * (1.0f / DM) + 1e-6f);
#pragma unroll
                for (int i = 0; i < 8; ++i) { const int d = i * 256 + lane * 4; const float4 g4 = *(const float4*)(gn + d), s4 = *(const float4*)(sc + d), h4 = *(const float4*)(sh + d);
                    v[i].x = v[i].x * rs * g4.x * (1.f + s4.x) + h4.x; v[i].y = v[i].y * rs * g4.y * (1.f + s4.y) + h4.y; v[i].z = v[i].z * rs * g4.z * (1.f + s4.z) + h4.z; v[i].w = v[i].w * rs * g4.w * (1.f + s4.w) + h4.w; }
#pragma unroll
                for (int i = 0; i < 8; ++i) { u32x2 w; w.x = pk2(v[i].x, v[i].y); w.y = pk2(v[i].z, v[i].w); *(u32x2*)(HB + (size_t)tok * DM + i * 256 + lane * 4) = w; }
            }
            SEAM(PB + 0);
        }

        if (IN(PB + 1)) for (int rep_ = 0; rep_ < PROBE_REPS(1); ++rep_) {
            PH_BEGIN
            for (int base = bid * 8; base < (lastl ? 1 : 2) * 1024; base += G * 8) {
                const int idx = base + (tid & 7), sl = tid >> 3; const int set = idx >> 10, oc = idx & 1023, o = oc >> 9, c = oc & 511;
                const float* pp = NORMP + (size_t)(l * 2 + set) * 256 * 2048 + o * 1024 + c + (size_t)(sl * 4) * 2048; float sacc = 0.f;
#pragma unroll
                for (int j = 0; j < 4; ++j) { const float p0 = pp[(size_t)j * 2048], p1 = pp[(size_t)j * 2048 + 512]; sacc += (sl * 4 + j < G) ? p0 + p1 : 0.f; }
                sf[sl * 8 + (tid & 7)] = sacc; __syncthreads();
                if (tid < 8) { float t = 0.f;
#pragma unroll 8
                    for (int q = 0; q < 64; ++q) t += sf[q * 8 + tid];
                    NORM[(size_t)(l * 2 + set) * 1024 + oc] = t; }
                __syncthreads(); }
            for (int idx = (G - 1 - bid) * NTHR + tid; idx < 32768; idx += G * NTHR) { const int c = idx & 15, lag = (idx >> 4) & 31, dir = (idx >> 9) & 1, g = idx >> 10;
                const float* c_re = PT(29) + l * 32 * 16 * 64 + (g * 16 + c) * 64; const float* c_im = PT(30) + l * 32 * 16 * 64 + (g * 16 + c) * 64;
                float acc[16];
#pragma unroll
                for (int j = 0; j < 16; ++j) acc[j] = 0.f;
#pragma unroll 2
                for (int n = 0; n < 64; ++n) { const int pi = (dir * 32 + g) * 64 + n; const float2 ap = APW[pi * 33 + lag]; const float cr = c_re[n], ci = c_im[n]; const float wr_ = cr * ap.x - ci * ap.y, wi_ = cr * ap.y + ci * ap.x;
                    const float4* bb = (const float4*)(BBT + pi * 16);
#pragma unroll
                    for (int j = 0; j < 8; ++j) { const float4 b2 = bb[j]; acc[2 * j] += wr_ * b2.x - wi_ * b2.y; acc[2 * j + 1] += wr_ * b2.z - wi_ * b2.w; } }
                float4* o = (float4*)(KTB + (size_t)idx * 16);
                o[0] = make_float4(acc[0], acc[1], acc[2], acc[3]); o[1] = make_float4(acc[4], acc[5], acc[6], acc[7]); o[2] = make_float4(acc[8], acc[9], acc[10], acc[11]); o[3] = make_float4(acc[12], acc[13], acc[14], acc[15]);
            }
            __syncthreads();
            pg8::Gemm g{HB, WIN, DM, DM, DM}; pg8::SchedStd S{68, 55, G, bid, DM, DM}; pg8::EpiWin E{P, LDP};
            pg8::gemm_phase(( LAS unsigned char*)shm, g, S, E);
#if defined(PROBE_BNOEPI)
            { __syncthreads(); pg8::EpiNone E0; pg8::gemm_phase((LAS unsigned char*)shm, g, S, E0); }
#endif
            SEAM(PB + 1);
        }

        if (IN(PB + 2)) for (int rep_ = 0; rep_ < PROBE_REPS(2); ++rep_) {
            PH_BEGIN
            const float* hcw = PT(9) + l * 3 * 1536; const float* hcb = PT(10) + l * 1536; const float* mcw = PT(20) + l * 3 * 1024; const float* mcb = PT(21) + l * 1024;
            const float* scw = PT(34) + l * 3 * 1024; const float* scb = PT(35) + l * 1024;
            for (int unit = bid; unit < 272 * 3; unit += G) { const int seg = unit / 3, kind = unit % 3; const bool lat = seg < 256; const size_t tok0 = lat ? (size_t)seg * 64 : (size_t)NLAT + (size_t)(seg - 256) * 64;
                if (kind < 2) { const int hf = kind;
                    const int c = tid * 2; const int col = (hf ? SSD_OFF + 512 : ML_OFF) + c; const float* w = hf ? scw : mcw; const float* bsp = hf ? scb : mcb; bf16_t* dst = (hf ? XBC : QKB) + tok0 * 1024 + c;
                    const float2 w0 = *(const float2*)(w + c), w1 = *(const float2*)(w + 1024 + c), w2 = *(const float2*)(w + 2048 + c), bb = *(const float2*)(bsp + c);
                    const float osc = (!hf && c >= 512) ? 0.08838834764831845f : 1.0f;
                    const bool hasPrev = !lat && ((tok0 - NLAT) & (CTXL - 1)) != 0, hasNext = !lat && (((tok0 - NLAT) + 63) & (CTXL - 1)) != CTXL - 1;
                    bf16_t* strip = nullptr;
                    if (!hf) { if (c >= 512) strip = KTG + ((size_t)seg * 512 + (c - 512)) * 64; }
                    else { if (c < 512) strip = XTG + ((size_t)seg * 512 + c) * 64; else if (c < 768) strip = BTG + ((size_t)seg * 256 + (c - 512)) * 64; }
                    const bf16_t* pp = P + tok0 * LDP + col;
                    unsigned raw[66];
#pragma unroll
                    for (int t = 0; t < 66; ++t) raw[t] = ((t == 0 && !hasPrev) || (t == 65 && !hasNext)) ? 0u : *(const unsigned*)(pp + (ptrdiff_t)(t - 1) * LDP);
#pragma unroll
                    for (int t8 = 0; t8 < 8; ++t8) { float v0[8], v1[8];
#pragma unroll
                        for (int tt = 0; tt < 8; ++tt) { const int t = t8 * 8 + tt; const unsigned p0 = raw[t], p1 = raw[t + 1], p2 = raw[t + 2];
                            float a0 = bb.x + w0.x * __uint_as_float(p0 << 16) + w1.x * __uint_as_float(p1 << 16) + w2.x * __uint_as_float(p2 << 16);
                            float a1 = bb.y + w0.y * __uint_as_float(p0 & 0xFFFF0000u) + w1.y * __uint_as_float(p1 & 0xFFFF0000u) + w2.y * __uint_as_float(p2 & 0xFFFF0000u);
                            a0 = siluf_(a0) * osc; a1 = siluf_(a1) * osc; v0[tt] = a0; v1[tt] = a1;
                            *(unsigned*)(dst + (size_t)t * 1024) = pk2(a0, a1); }
                        if (strip) { u32x4 s0, s1; s0.x = pk2(v0[0], v0[1]); s0.y = pk2(v0[2], v0[3]); s0.z = pk2(v0[4], v0[5]); s0.w = pk2(v0[6], v0[7]); s1.x = pk2(v1[0], v1[1]); s1.y = pk2(v1[2], v1[3]); s1.z = pk2(v1[4], v1[5]); s1.w = pk2(v1[6], v1[7]);
                            *(u32x4*)(strip + t8 * 8) = s0; *(u32x4*)(strip + 64 + t8 * 8) = s1; } }
                } else {
                    const int c = (tid & 255) * 2, th = tid >> 8; const bf16_t* pp = P + (tok0 + th * 32) * LDP + ML_OFF + 1024 + c; bf16_t* strip = VTG + ((size_t)seg * 512 + c) * 64 + th * 32;
                    unsigned rv[32];
#pragma unroll
                    for (int t = 0; t < 32; ++t) rv[t] = *(const unsigned*)(pp + (size_t)t * LDP);
#pragma unroll
                    for (int t8 = 0; t8 < 4; ++t8) { u32x4 s0, s1;
                        s0.x = (rv[t8 * 8 + 0] & 0xFFFFu) | (rv[t8 * 8 + 1] << 16); s0.y = (rv[t8 * 8 + 2] & 0xFFFFu) | (rv[t8 * 8 + 3] << 16); s0.z = (rv[t8 * 8 + 4] & 0xFFFFu) | (rv[t8 * 8 + 5] << 16); s0.w = (rv[t8 * 8 + 6] & 0xFFFFu) | (rv[t8 * 8 + 7] << 16);
                        s1.x = (rv[t8 * 8 + 0] >> 16) | (rv[t8 * 8 + 1] & 0xFFFF0000u); s1.y = (rv[t8 * 8 + 2] >> 16) | (rv[t8 * 8 + 3] & 0xFFFF0000u); s1.z = (rv[t8 * 8 + 4] >> 16) | (rv[t8 * 8 + 5] & 0xFFFF0000u); s1.w = (rv[t8 * 8 + 6] >> 16) | (rv[t8 * 8 + 7] & 0xFFFF0000u);
                        *(u32x4*)(strip + t8 * 8) = s0; *(u32x4*)(strip + 64 + t8 * 8) = s1; }
                }
            }
            if (!lastl) for (int tok = NLAT + bid; tok < NTOK; tok += G) {
                const int t = (tok - NLAT) & (CTXL - 1); const bool hasL = (t != 0), hasR = (t != CTXL - 1); const bf16_t* pr = P + (size_t)tok * LDP;
                const bf16_t* prL = hasL ? pr - LDP : pr; const bf16_t* prR = hasR ? pr + LDP : pr;
                unsigned xc[3], xl[3], xr[3];
#pragma unroll
                for (int j = 0; j < 3; ++j) { const int cc = tid + j * 512; xc[j] = pr[HY_OFF + cc]; xl[j] = prL[HY_OFF + cc]; xr[j] = prR[HY_OFF + cc]; }
#pragma unroll
                for (int j = 0; j < 3; ++j) { const int cc = tid + j * 512;
                    float acc = hcb[cc] + hcw[1536 + cc] * __uint_as_float(xc[j] << 16);
                    acc += hasL ? hcw[cc] * __uint_as_float(xl[j] << 16) : 0.f;
                    acc += hasR ? hcw[2 * 1536 + cc] * __uint_as_float(xr[j] << 16) : 0.f;
                    U[(size_t)tok * 1536 + cc] = acc; }
            }
            for (int idx0 = bid * NTHR + tid; idx0 < 16384 * 64; idx0 += 4 * G * NTHR) { u32x4 t4[4];
#pragma unroll
                for (int q = 0; q < 4; ++q) { const int idx = idx0 + q * G * NTHR; const int half = idx & 1, g = (idx >> 1) & 31, tok = idx >> 6;
                    if (idx < 16384 * 64) t4[q] = *(const u32x4*)(P + (size_t)tok * LDP + S5_OFF + g * 16 + half * 8); }
#pragma unroll
                for (int q = 0; q < 4; ++q) { const int idx = idx0 + q * G * NTHR; const int half = idx & 1, g = (idx >> 1) & 31, tok = idx >> 6;
                    if (idx < 16384 * 64) *(u32x4*)(S5A + ((size_t)g * 512 + (tok >> 5)) * 768 + (tok & 31) * 16 + half * 8) = t4[q]; } }
            for (int idx = bid * NTHR + tid; idx < 32 * 512 * 32 * 2; idx += G * NTHR) { const int half = idx & 1, sI = (idx >> 1) & 31, row = (idx >> 6) & 511, g = idx >> 15; const int t = row >> 4, c = row & 15; const int lag = t - sI;
                float v[8];
                if (lag > 0) { const float4* k4 = (const float4*)(KTB + ((size_t)((g * 2 + 0) * 32 + lag) * 16 + c) * 16 + half * 8); const float4 a0 = k4[0], a1 = k4[1]; v[0] = a0.x; v[1] = a0.y; v[2] = a0.z; v[3] = a0.w; v[4] = a1.x; v[5] = a1.y; v[6] = a1.z; v[7] = a1.w; }
                else if (lag < 0) { const float4* k4 = (const float4*)(KTB + ((size_t)((g * 2 + 1) * 32 - lag) * 16 + c) * 16 + half * 8); const float4 a0 = k4[0], a1 = k4[1]; v[0] = a0.x; v[1] = a0.y; v[2] = a0.z; v[3] = a0.w; v[4] = a1.x; v[5] = a1.y; v[6] = a1.z; v[7] = a1.w; }
                else { const float4* k4 = (const float4*)(KTB + ((size_t)((g * 2 + 0) * 32) * 16 + c) * 16 + half * 8); const float4* q4 = (const float4*)(KTB + ((size_t)((g * 2 + 1) * 32) * 16 + c) * 16 + half * 8); const float4 a0 = k4[0], a1 = k4[1], b0 = q4[0], b1 = q4[1];
                    v[0] = a0.x + b0.x; v[1] = a0.y + b0.y; v[2] = a0.z + b0.z; v[3] = a0.w + b0.w; v[4] = a1.x + b1.x; v[5] = a1.y + b1.y; v[6] = a1.z + b1.z; v[7] = a1.w + b1.w; }
                u32x4 w; w.x = pk2(v[0], v[1]); w.y = pk2(v[2], v[3]); w.z = pk2(v[4], v[5]); w.w = pk2(v[6], v[7]);
                *(u32x4*)(S5B + ((size_t)g * 512 + row) * 768 + sI * 16 + half * 8) = w; }
            for (int idx = bid * NTHR + tid; idx < 32 * 512 * 64; idx += G * NTHR) { const int n = idx & 63, row = (idx >> 6) & 511, g = idx >> 15; const int t = row >> 4, c = row & 15;
                const float cr = (PT(29) + l * 32 * 16 * 64)[(g * 16 + c) * 64 + n], ci = (PT(30) + l * 32 * 16 * 64)[(g * 16 + c) * 64 + n];
                const float2 af = APW[((0 * 32 + g) * 64 + n) * 33 + t + 1], ab = APW[((1 * 32 + g) * 64 + n) * 33 + 32 - t];
                bf16_t* d = S5B + ((size_t)g * 512 + row) * 768 + 512 + 2 * n;
                *(unsigned*)d = pk2(cr * af.x - ci * af.y, -(cr * af.y + ci * af.x)); *(unsigned*)(d + 128) = pk2(cr * ab.x - ci * ab.y, -(cr * ab.y + ci * ab.x)); }
            for (int idx = bid * NTHR + tid; idx < 32 * 2 * 64 * 32; idx += G * NTHR) { const int sI = idx & 31, n = (idx >> 5) & 63, dir = (idx >> 11) & 1, g = idx >> 12; const int pi = (dir * 32 + g) * 64 + n;
                const float2 pw = APW[pi * 33 + (dir ? sI : 31 - sI)]; const float4* bb = (const float4*)(BBT + pi * 16);
                float re[16], im[16];
#pragma unroll
                for (int j = 0; j < 8; ++j) { const float4 b2 = bb[j]; re[2 * j] = pw.x * b2.x - pw.y * b2.y; im[2 * j] = pw.x * b2.y + pw.y * b2.x; re[2 * j + 1] = pw.x * b2.z - pw.y * b2.w; im[2 * j + 1] = pw.x * b2.w + pw.y * b2.z; }
                bf16_t* d = S5P + ((size_t)g * 256 + dir * 128 + 2 * n) * 512 + sI * 16;
                u32x4 w0, w1; w0.x = pk2(re[0], re[1]); w0.y = pk2(re[2], re[3]); w0.z = pk2(re[4], re[5]); w0.w = pk2(re[6], re[7]); w1.x = pk2(re[8], re[9]); w1.y = pk2(re[10], re[11]); w1.z = pk2(re[12], re[13]); w1.w = pk2(re[14], re[15]);
                *(u32x4*)d = w0; *(u32x4*)(d + 8) = w1;
                w0.x = pk2(im[0], im[1]); w0.y = pk2(im[2], im[3]); w0.z = pk2(im[4], im[5]); w0.w = pk2(im[6], im[7]); w1.x = pk2(im[8], im[9]); w1.y = pk2(im[10], im[11]); w1.z = pk2(im[12], im[13]); w1.w = pk2(im[14], im[15]);
                *(u32x4*)(d + 512) = w0; *(u32x4*)(d + 520) = w1; }
            {   float* T0 = sf; float* T1 = sf + 64 * 65;
                const int NU = 4 * 64 * 24; const int cL = tid & 63, tL = tid >> 6, c = tid >> 3, tq = (tid & 7) * 8;
                for (int unit = bid; unit < NU; unit += 2 * G) { const bool has2 = unit + G < NU; const int unit2 = has2 ? unit + G : unit;
                    const int ba = unit / (64 * 24), ra = (unit / 24) % 64, c0a = (unit % 24) * 64; const size_t toka = (size_t)ba * SEQ + ra * 64;
                    const int bb_ = unit2 / (64 * 24), rb = (unit2 / 24) % 64, c0b = (unit2 % 24) * 64; const size_t tokb = (size_t)bb_ * SEQ + rb * 64;
                    unsigned pa[8], pb[8];
#pragma unroll
                    for (int i = 0; i < 8; ++i) { pa[i] = P[(toka + tL + 8 * i) * LDP + HY_OFF + c0a + cL]; pb[i] = P[(tokb + tL + 8 * i) * LDP + HY_OFF + c0b + cL]; }
                    const int cca = c0a + c, ccb = c0b + c;
                    const float w0a = hcw[cca], w1a = hcw[1536 + cca], w2a = hcw[3072 + cca], bia = hcb[cca], w0b = hcw[ccb], w1b = hcw[1536 + ccb], w2b = hcw[3072 + ccb], bib = hcb[ccb];
                    __syncthreads();
#pragma unroll
                    for (int i = 0; i < 8; ++i) { T0[(tL + 8 * i) * 65 + cL] = __uint_as_float(pa[i] << 16); T1[(tL + 8 * i) * 65 + cL] = __uint_as_float(pb[i] << 16); }
                    __syncthreads();
                    {   float o8[8];
#pragma unroll
                        for (int i = 0; i < 8; ++i) { const int t = tq + i; float acc = bia + w1a * T0[t * 65 + c]; if (t > 0) acc += w0a * T0[(t - 1) * 65 + c]; if (t < 63) acc += w2a * T0[(t + 1) * 65 + c]; o8[i] = acc; }
                        u32x4 wv; wv.x = pk2(o8[0], o8[1]); wv.y = pk2(o8[2], o8[3]); wv.z = pk2(o8[4], o8[5]); wv.w = pk2(o8[6], o8[7]);
                        *(u32x4*)(UT + ((size_t)ba * 1536 + cca) * SEQ + ra * 64 + tq) = wv; }
                    if (has2) { float o8[8];
#pragma unroll
                        for (int i = 0; i < 8; ++i) { const int t = tq + i; float acc = bib + w1b * T1[t * 65 + c]; if (t > 0) acc += w0b * T1[(t - 1) * 65 + c]; if (t < 63) acc += w2b * T1[(t + 1) * 65 + c]; o8[i] = acc; }
                        u32x4 wv; wv.x = pk2(o8[0], o8[1]); wv.y = pk2(o8[2], o8[3]); wv.z = pk2(o8[4], o8[5]); wv.w = pk2(o8[6], o8[7]);
                        *(u32x4*)(UT + ((size_t)bb_ * 1536 + ccb) * SEQ + rb * 64 + tq) = wv; }
                } }
            if (!lastl) {
                const int L = CTXL; const float* HR = HRAW + (size_t)SEQ * 2048; float* K2 = K2C; const float* nrm = NORM + (size_t)(l * 2 + 1) * 1024;
                const size_t total = (size_t)(2 * L - 1) * 1024;
                for (size_t i = (size_t)bid * NTHR + tid; i < total; i += (size_t)G * NTHR) { const int j = (int)(i >> 10), oc = (int)(i & 1023), o = oc >> 9, c = oc & 511; const int lag = j - (L - 1);
                    const float v = lag >= 0 ? HR[(size_t)lag * 2048 + o * 1024 + c] : HR[(size_t)(-lag) * 2048 + o * 1024 + 512 + c];
                    K2[((size_t)j * 2 + o) * 512 + c] = v / nrm[oc]; }
            }
            {   __syncthreads(); fft_twiddles((float2*)(shm + FFT_X_BYTES), tid);
                for (int pr = bid; pr < 512; pr += G) hyena_spec_item(pr, HRAW, NORM + (size_t)(l * 2 + 0) * 1024, HSPEC, shm, tid);
                __syncthreads(); }
            SEAM(PB + 2);
        }

        if (IN(PB + 3)) for (int rep_ = 0; rep_ < PROBE_REPS(3); ++rep_) {
            PH_BEGIN
            if (rep_ > 0) { if (bid == 0 && tid == 0) __hip_atomic_store(QCTR + l * 64, 0, __ATOMIC_RELAXED, __HIP_MEMORY_SCOPE_AGENT); xcd_barrier(bar); }
            if (bid < 64) {
                mlstm_state_pass(bid >> 1, bid & 1, P, KTG, VTG, PT(22) + l * 16, CST, NST, MST, shm, tid);
            } else if (bid < 128) {
                { const int ch = bid - 64; const int dir_ = ch & 1, h_ = (ch >> 1) & 7; ssd_state_pass(ch, P, BTG, XTG, -expf(PT(37)[l * 16 + dir_ * 8 + h_]), PT(36)[l * 16 + dir_ * 8 + h_], SSTB, shm, tid); }
            } else if (bid < 160) {
                const int widx = (bid - 128) * 8 + wave; const int dir = widx & 1, g = (widx >> 1) & 31, b = widx >> 6; const int n = lane;
                float2* xb = (float2*)(shm + (size_t)wave * 16640); float2* ctab = xb + 16 * 65;
                const float* a_re = PT(24) + l * 2 * 32 * 64; const float* a_im = PT(25) + l * 2 * 32 * 64; const float* log_dt = PT(26) + l * 64;
                const float* b_re = PT(27) + l * 32 * 64 * 16; const float* b_im = PT(28) + l * 32 * 64 * 16; const float* c_re = PT(29) + l * 32 * 16 * 64; const float* c_im = PT(30) + l * 32 * 16 * 64;
#pragma unroll
                for (int c = 0; c < 16; ++c) ctab[c * 65 + lane] = make_float2(c_re[(g * 16 + c) * 64 + lane], c_im[(g * 16 + c) * 64 + lane]);
                float abr, abi, bbr[16], bbi[16];
                {   const double are = (double)a_re[(dir * 32 + g) * 64 + n], aim = (double)a_im[(dir * 32 + g) * 64 + n];
                    const double lam = are < -1e-4 ? are : -1e-4; const double dt = exp((double)log_dt[dir * 32 + g]);
                    const double mag = exp(lam * dt); const double ar = mag * cos(aim * dt), ai = mag * sin(aim * dt);
                    const double den = lam * lam + aim * aim; const double nr = ar - 1.0, ni = ai;
                    const double fre = (nr * lam + ni * aim) / den, fim = (ni * lam - nr * aim) / den;
                    abr = (float)ar; abi = (float)ai;
#pragma unroll
                    for (int c = 0; c < 16; ++c) { const double br = (double)b_re[(g * 64 + n) * 16 + c], bi = (double)b_im[(g * 64 + n) * 16 + c]; bbr[c] = (float)(fre * br - fim * bi); bbi[c] = (float)(fre * bi + fim * br); }
                }
                float xr = 0.f, xi = 0.f; float* Sout = (dir ? SB : SF) - (size_t)NLAT * BW;
                const int s = lane >> 2, cg = lane & 3;
                for (int i0 = 0; i0 < CTXL; i0 += 16) {
#pragma unroll 4
                    for (int ss = 0; ss < 16; ++ss) {
                        const size_t tok = (size_t)step_tok(b, dir, i0 + ss);
                        const u32x4* up = (const u32x4*)(P + tok * LDP + S5_OFF + g * 16);
                        float t0[8], t1[8]; unpack8(up[0], t0); unpack8(up[1], t1);
                        float bur = 0.f, bui = 0.f;
#pragma unroll
                        for (int c = 0; c < 8; ++c) { bur += t0[c] * bbr[c] + t1[c] * bbr[8 + c]; bui += t0[c] * bbi[c] + t1[c] * bbi[8 + c]; }
                        const float nxr = abr * xr - abi * xi + bur, nxi = abr * xi + abi * xr + bui; xr = nxr; xi = nxi;
                        xb[ss * 65 + lane] = make_float2(xr, xi);
                    }
                    asm volatile("s_waitcnt lgkmcnt(0)" ::: "memory");
                    float y0 = 0.f, y1 = 0.f, y2 = 0.f, y3 = 0.f;
                    for (int nn2 = 0; nn2 < 64; ++nn2) { const float2 xv = xb[s * 65 + nn2];
                        const float2 c0 = ctab[(cg * 4 + 0) * 65 + nn2], c1 = ctab[(cg * 4 + 1) * 65 + nn2], c2 = ctab[(cg * 4 + 2) * 65 + nn2], c3 = ctab[(cg * 4 + 3) * 65 + nn2];
                        y0 += xv.x * c0.x - xv.y * c0.y; y1 += xv.x * c1.x - xv.y * c1.y; y2 += xv.x * c2.x - xv.y * c2.y; y3 += xv.x * c3.x - xv.y * c3.y; }
                    const size_t toks = (size_t)step_tok(b, dir, i0 + s);
                    *(float4*)(Sout + toks * BW + g * 16 + cg * 4) = make_float4(y0, y1, y2, y3);
                    asm volatile("s_waitcnt lgkmcnt(0)" ::: "memory");
                }
                XCTX[((b * 32 + g) * 2 + dir) * 64 + n] = make_float2(xr, xi);
            } else {
                if (bid < 224) {
                    pg8::Gemm gg_{S5A, S5P, 768, 512, 512}; pg8::SchedS5a S_{bid - 160}; pg8::EpiXloc E_{XLOC};
                    pg8::gemm_phase((LAS unsigned char*)shm, gg_, S_, E_);
                    __syncthreads();
                }
                const int nhb = G - 160, hb = bid - 160; const float* bias = PT(19) + l * 1024; const int c = tid;
                const int nitems = lastl ? 0 : 4 * (CTXL / 8);
                for (int it = hb; it < nitems; it += nhb) {
                    int L, tokbase, b, t0; const float* K2;
                    { const int q = it; L = CTXL; tokbase = NLAT; b = q / (CTXL / 8); t0 = (q % (CTXL / 8)) * 8; K2 = K2C; }
                    const float* zb = U + (size_t)(tokbase + b * L) * 1536 + c;
                    float acc[8];
#pragma unroll
                    for (int i = 0; i < 8; ++i) acc[i] = 0.f;
                    const int base = t0 + L - 1;
                    for (int s = 0; s < L; s += 8) {
                        float k[15];
#pragma unroll
                        for (int mm = 0; mm < 15; ++mm) k[mm] = K2[((size_t)(base - s - 7 + mm) * 2 + 0) * 512 + c];
#pragma unroll
                        for (int ds = 0; ds < 8; ++ds) { const float z = zb[(size_t)(s + ds) * 1536];
#pragma unroll
                            for (int i = 0; i < 8; ++i) acc[i] += k[i - ds + 7] * z; }
                    }
#pragma unroll
                    for (int i = 0; i < 8; ++i) { const size_t tok = (size_t)(tokbase + b * L + t0 + i); const float zt = U[tok * 1536 + c]; Z[tok * BW + c] = (acc[i] + bias[c] * zt) * U[tok * 1536 + 512 + c]; }
                }
            }
            {   __syncthreads(); fft_twiddles((float2*)(shm + FFT_X_BYTES), tid);
                int* qslot = (int*)(shm + FFT_X_BYTES + 65536);
                for (;;) { __syncthreads(); if (tid == 0) *qslot = atomicAdd(QCTR + l * 64, 1); __syncthreads(); const int it = *qslot; if (it >= 1024) break;
                    hyena_fft_item(it, UT, HSPEC, PT(19) + l * 1024, YT, shm, tid); }
            }
            SEAM(PB + 3);
        }

        if (IN(PB + 4)) for (int rep_ = 0; rep_ < PROBE_REPS(4); ++rep_) {
            PH_BEGIN
            if (rep_ > 0) { if (bid == 0 && tid == 0) __hip_atomic_store(QCTR + l * 64 + 32, 0, __ATOMIC_RELAXED, __HIP_MEMORY_SCOPE_AGENT); xcd_barrier(bar); }
            if (bid >= G - 32) for (int idx = (bid - (G - 32)) * NTHR + tid; idx < 16384; idx += 32 * NTHR) { const int n = idx & 63, dir = (idx >> 6) & 1, b = (idx >> 7) & 3, g = idx >> 9;
                const float2 a32 = APW[((dir * 32 + g) * 64 + n) * 33 + 32]; float2 X = XCTX[((b * 32 + g) * 2 + dir) * 64 + n];
                const float* __restrict__ xl = XLOC + ((size_t)g * 512 + b * 128) * 256 + dir * 128 + 2 * n; bf16_t* __restrict__ dst = S5A + ((size_t)g * 512 + b * 128) * 768 + 512 + dir * 128 + 2 * n;
#pragma unroll 1
                for (int j0 = 0; j0 < 128; j0 += 16) { float2 xv[16];
#pragma unroll
                    for (int q = 0; q < 16; ++q) { const int j = dir ? 127 - (j0 + q) : j0 + q; xv[q] = *(const float2*)(xl + (size_t)j * 256); }
#pragma unroll
                    for (int q = 0; q < 16; ++q) { const int j = dir ? 127 - (j0 + q) : j0 + q;
                        *(unsigned*)(dst + (size_t)j * 768) = pk2(X.x, X.y);
                        const float nx = a32.x * X.x - a32.y * X.y + xv[q].x, ny = a32.x * X.y + a32.y * X.x + xv[q].y; X.x = nx; X.y = ny; } } }
            {   int* qslot = (int*)(shm + 102400);
                __syncthreads(); if (tid == 0) *qslot = atomicAdd(QCTR + l * 64 + 32, 1); __syncthreads();
                for (;;) { const int it = *qslot; if (it >= 32 * 68 + 64 * 68) break;
                    int nxt_ = 0; if (tid == 0) nxt_ = atomicAdd(QCTR + l * 64 + 32, 1);
                    if (it < 32 * 68) { const int chain = it / 68, c = it % 68; mlstm_out_item(chain, c, P, QKB, VTG, PT(22) + l * 16, CST, NST, MST, (chain & 1) ? HBk : HF, shm, tid); }
                    else { const int i2 = it - 32 * 68; const int chain = i2 / 68, c = i2 % 68; const int dir_ = chain & 1, h_ = (chain >> 1) & 7;
                        ssd_out_item(chain, c, P, XBC, XTG, -expf(PT(37)[l * 16 + dir_ * 8 + h_]), PT(36)[l * 16 + dir_ * 8 + h_], SSTB, dir_ ? YB : YF, shm, tid); }
                    __syncthreads(); if (tid == 0) *qslot = nxt_; __syncthreads(); }
            }
            __syncthreads();
            {   const float* bias = PT(19) + l * 1024 + 512; const int c = tid;
                const int nitems = lastl ? 0 : 4 * (CTXL / 8);
                for (int it = bid; it < nitems; it += G) {
                    int L, tokbase, b, t0; const float* K2;
                    { const int q = it; L = CTXL; tokbase = NLAT; b = q / (CTXL / 8); t0 = (q % (CTXL / 8)) * 8; K2 = K2C; }
                    const float* zb = Z + (size_t)(tokbase + b * L) * BW + c;
                    float acc[8];
#pragma unroll
                    for (int i = 0; i < 8; ++i) acc[i] = 0.f;
                    const int base = t0 + L - 1;
                    for (int s = 0; s < L; s += 8) {
                        float k[15];
#pragma unroll
                        for (int mm = 0; mm < 15; ++mm) k[mm] = K2[((size_t)(base - s - 7 + mm) * 2 + 1) * 512 + c];
#pragma unroll
                        for (int ds = 0; ds < 8; ++ds) { const float z = zb[(size_t)(s + ds) * BW];
#pragma unroll
                            for (int i = 0; i < 8; ++i) acc[i] += k[i - ds + 7] * z; }
                    }
#pragma unroll
                    for (int i = 0; i < 8; ++i) { const size_t tok = (size_t)(tokbase + b * L + t0 + i); const float zt = Z[tok * BW + c]; Y4[tok * DM + c] = f2bf((acc[i] + bias[c] * zt) * U[tok * 1536 + 1024 + c]); }
                }
            }
            SEAM(PB + 4);
        }

        if (IN(PB + 5)) for (int rep_ = 0; rep_ < PROBE_REPS(5); ++rep_) {
            PH_BEGIN
            const float* ml_norm = PT(23) + l * BW; const float* ssd_d = PT(38) + l * 8; const float* ssd_norm = PT(39) + l * BW; const float* s5_d = PT(31) + l * BW;
            if (bid < 128) {
                pg8::Gemm gg_{S5A, S5B, 768, 768, 768}; pg8::SchedS5b S_{bid}; pg8::EpiS5Out E_{P, s5_d, GG};
                pg8::gemm_phase((LAS unsigned char*)shm, gg_, S_, E_);
                __syncthreads();
            }
            for (int tok = bid * 8 + wave; tok < NTOK; tok += G * 8) {
                const int c0 = lane * 8; const bf16_t* pr = P + (size_t)tok * LDP; const size_t o5 = (size_t)tok * BW + c0;
                float hm[8], ys[8];
                const u32x4 ooq = *(const u32x4*)(pr + ML_OFF + 1536 + c0);
                const float4 g0 = *(const float4*)(ml_norm + c0), g1 = *(const float4*)(ml_norm + c0 + 4), n0 = *(const float4*)(ssd_norm + c0), n1 = *(const float4*)(ssd_norm + c0 + 4);
                { float fa[8], fb[8]; unpack8(*(const u32x4*)(HF + o5), fa); unpack8(*(const u32x4*)(HBk + o5), fb);
#pragma unroll
                  for (int j = 0; j < 8; ++j) hm[j] = fa[j] + fb[j]; }
                { float ya[8], yb[8]; unpack8(*(const u32x4*)(YF + o5), ya); unpack8(*(const u32x4*)(YB + o5), yb);
                  float xx[8], zz[8]; unpack8(*(const u32x4*)(XBC + (size_t)tok * 1024 + c0), xx); unpack8(*(const u32x4*)(pr + SSD_OFF + c0), zz); const float dsk = ssd_d[c0 >> 6];
#pragma unroll
                  for (int j = 0; j < 8; ++j) ys[j] = ya[j] + yb[j];
#pragma unroll
                  for (int j = 0; j < 8; ++j) ys[j] = (ys[j] + dsk * xx[j]) * siluf_(zz[j]); }
                float s1 = 0.f, s2 = 0.f;
#pragma unroll
                for (int j = 0; j < 8; ++j) { s1 += hm[j] * hm[j]; s2 += ys[j] * ys[j]; }
                s1 += __shfl_xor(s1, 1); s1 += __shfl_xor(s1, 2); s1 += __shfl_xor(s1, 4); s1 += __shfl_xor(s1, 8);
                s2 = wave_sum(s2);
                const float r1 = rsqrtf(s1 * (1.0f / 128.0f) + 1e-6f), r2 = rsqrtf(s2 * (1.0f / BW) + 1e-6f);
                float oo[8]; unpack8(ooq, oo);
                const float gm[8] = {g0.x, g0.y, g0.z, g0.w, g1.x, g1.y, g1.z, g1.w}, gs[8] = {n0.x, n0.y, n0.z, n0.w, n1.x, n1.y, n1.z, n1.w};
                u32x4 w;
                w.x = pk2(hm[0] * r1 * gm[0] * sigmoidf_(oo[0]), hm[1] * r1 * gm[1] * sigmoidf_(oo[1])); w.y = pk2(hm[2] * r1 * gm[2] * sigmoidf_(oo[2]), hm[3] * r1 * gm[3] * sigmoidf_(oo[3]));
                w.z = pk2(hm[4] * r1 * gm[4] * sigmoidf_(oo[4]), hm[5] * r1 * gm[5] * sigmoidf_(oo[5])); w.w = pk2(hm[6] * r1 * gm[6] * sigmoidf_(oo[6]), hm[7] * r1 * gm[7] * sigmoidf_(oo[7]));
                *(u32x4*)(Y4 + (size_t)tok * DM + 512 + c0) = w;
                w.x = pk2(ys[0] * r2 * gs[0], ys[1] * r2 * gs[1]); w.y = pk2(ys[2] * r2 * gs[2], ys[3] * r2 * gs[3]); w.z = pk2(ys[4] * r2 * gs[4], ys[5] * r2 * gs[5]); w.w = pk2(ys[6] * r2 * gs[6], ys[7] * r2 * gs[7]);
                *(u32x4*)(Y4 + (size_t)tok * DM + 1536 + c0) = w;
                if (tok >= NLAT) { const size_t oc = (size_t)(tok - NLAT) * BW + c0; float uu[8]; unpack8(*(const u32x4*)(pr + S5_OFF + c0), uu);
                    const float4 a0 = *(const float4*)(SF + oc), a1 = *(const float4*)(SF + oc + 4), b0 = *(const float4*)(SB + oc), b1 = *(const float4*)(SB + oc + 4), d0 = *(const float4*)(s5_d + c0), d1 = *(const float4*)(s5_d + c0 + 4);
                    float y[8] = {a0.x + b0.x + d0.x * uu[0], a0.y + b0.y + d0.y * uu[1], a0.z + b0.z + d0.z * uu[2], a0.w + b0.w + d0.w * uu[3], a1.x + b1.x + d1.x * uu[4], a1.y + b1.y + d1.y * uu[5], a1.z + b1.z + d1.z * uu[6], a1.w + b1.w + d1.w * uu[7]};
#pragma unroll
                    for (int j = 0; j < 8; ++j) y[j] = 0.5f * y[j] * (1.0f + tanhf(0.7978845608028654f * (y[j] + 0.044715f * y[j] * y[j] * y[j])));
                    w.x = pk2(y[0], y[1]); w.y = pk2(y[2], y[3]); w.z = pk2(y[4], y[5]); w.w = pk2(y[6], y[7]);
                    *(u32x4*)(GG + (size_t)tok * BW + c0) = w; }
            }
            __syncthreads();
            {   float* T = sf;
                for (int unit = (G > 128 ? bid - 128 : bid); unit >= 0 && unit < 4 * 64 * 8; unit += (G > 128 ? G - 128 : G)) { const int b = unit / 512, t0 = ((unit >> 3) & 63) * 64, c0 = (unit & 7) * 64;
                    __syncthreads();
#pragma unroll
                    for (int i = 0; i < 8; ++i) { const int t = tid & 63, c = (tid >> 6) + 8 * i; T[c * 65 + t] = YT[((size_t)b * 512 + c0 + c) * SEQ + t0 + t]; }
                    __syncthreads();
                    const int t = tid >> 3, cq = (tid & 7) * 8;
                    u32x4 w; w.x = pk2(T[(cq + 0) * 65 + t], T[(cq + 1) * 65 + t]); w.y = pk2(T[(cq + 2) * 65 + t], T[(cq + 3) * 65 + t]); w.z = pk2(T[(cq + 4) * 65 + t], T[(cq + 5) * 65 + t]); w.w = pk2(T[(cq + 6) * 65 + t], T[(cq + 7) * 65 + t]);
                    *(u32x4*)(Y4 + ((size_t)b * SEQ + t0 + t) * DM + c0 + cq) = w;
                } }
            SEAM(PB + 5);
        }

        if (IN(PB + 6)) for (int rep_ = 0; rep_ < PROBE_REPS(6); ++rep_) {
            PH_BEGIN
            pg8::Gemm g{GG, GLU, BW, BW, BW}; pg8::SchedStd S{68, 2, G, bid, BW, BW}; pg8::EpiGlu E{GG, PT(33) + l * BW, Y4};
            pg8::gemm_phase((LAS unsigned char*)shm, g, S, E);
            SEAM(PB + 6);
        }
        if (IN(PB + 7)) for (int rep_ = 0; rep_ < PROBE_REPS(7); ++rep_) {
            PH_BEGIN
            pg8::Gemm g{Y4, WBR, DM, BW, BW}; pg8::SchedBranch S{64, 8, G, bid}; pg8::EpiBranch E{P, ACCb};
            pg8::gemm_phase((LAS unsigned char*)shm, g, S, E);
            if (!lastl) { __syncthreads(); pg8::SchedTail S2{G, bid}; pg8::EpiPartK E2{(float*)HSPEC}; pg8::gemm_phase((LAS unsigned char*)shm, g, S2, E2); }
            SEAM(PB + 7);
        }
        if (IN(PB + 8)) for (int rep_ = 0; rep_ < PROBE_REPS(8); ++rep_) {
            PH_BEGIN
            if (!lastl) {
                const float* PART = (const float*)HSPEC;
                for (int idx = bid * NTHR + tid; idx < (NTOK - NLAT) * DM / 8; idx += G * NTHR) { const size_t o = (size_t)idx * 8; f32x4 p[4][2];
#pragma unroll
                    for (int k = 0; k < 4; ++k) { p[k][0] = *(const f32x4*)(PART + (size_t)k * (NTOK - NLAT) * DM + o); p[k][1] = *(const f32x4*)(PART + (size_t)k * (NTOK - NLAT) * DM + o + 4); }
                    f32x4 s0 = (f32x4){0.f, 0.f, 0.f, 0.f}, s1 = s0; const bf16_t* rp = P + (size_t)(NLAT + (o >> 11)) * LDP + GATE2 + (o & (DM - 1));
#pragma unroll
                    for (int k = 0; k < 4; ++k) { float rr[8]; unpack8(*(const u32x4*)(rp + k * DM), rr);
                        s0 = s0 + p[k][0]; s1 = s1 + p[k][1]; s0[0] *= rr[0]; s0[1] *= rr[1]; s0[2] *= rr[2]; s0[3] *= rr[3]; s1[0] *= rr[4]; s1[1] *= rr[5]; s1[2] *= rr[6]; s1[3] *= rr[7]; }
                    u32x4 w; w.x = pk2(s0[0], s0[1]); w.y = pk2(s0[2], s0[3]); w.z = pk2(s1[0], s1[1]); w.w = pk2(s1[2], s1[3]);
                    *(u32x4*)(ACCb + (size_t)NLAT * DM + o) = w; }
                xcd_barrier(bar);
            }
            pg8::Gemm g{ACCb, WOUT, DM, DM, DM}; pg8::SchedStd S{64, 8, G, bid, DM, DM}; pg8::EpiResid E{XS, l == 0 ? x_in : (const float*)XS, l == 0 ? ctx_in - (size_t)NLAT * DM : (const float*)XS, MODl, 2};
            pg8::gemm_phase((LAS unsigned char*)shm, g, S, E);
            if (!lastl) { __syncthreads(); pg8::Gemm g2{ACCb, WOUT, DM, DM, 512}; pg8::SchedTailK S2{G, bid}; pg8::EpiPartK E2{(float*)HSPEC + (size_t)4 * (NTOK - NLAT) * DM}; pg8::gemm_phase((LAS unsigned char*)shm, g2, S2, E2); }
            SEAM(PB + 8);
        }
        if (IN(PB + 9)) for (int rep_ = 0; rep_ < PROBE_REPS(9); ++rep_) {
            PH_BEGIN
            if (!lastl) {
                const float* PART = (const float*)HSPEC + (size_t)4 * (NTOK - NLAT) * DM; const float* mg = MODl + (size_t)(4 * 6 + 2) * DM;
                const float* src = l == 0 ? ctx_in : (const float*)XS + (size_t)NLAT * DM;
                for (int idx = bid * NTHR + tid; idx < (NTOK - NLAT) * DM / 4; idx += G * NTHR) { const size_t o = (size_t)idx * 4; const int col = (int)(o & (DM - 1));
                    const f32x4 p0 = *(const f32x4*)(PART + o), p1 = *(const f32x4*)(PART + (size_t)(NTOK - NLAT) * DM + o), p2 = *(const f32x4*)(PART + (size_t)2 * (NTOK - NLAT) * DM + o), p3 = *(const f32x4*)(PART + (size_t)3 * (NTOK - NLAT) * DM + o);
                    const f32x4 sv = *(const f32x4*)(src + o), gm = *(const f32x4*)(mg + col);
                    *(f32x4*)(XS + (size_t)NLAT * DM + o) = sv + gm * (((p0 + p1) + p2) + p3); }
                xcd_barrier(bar);
            }
            for (int i = bid * NTHR + tid; i < NEXP * MOE_PAD; i += G * NTHR) ROWTOK[i] = -1;
            for (int i = bid * NTHR + tid; i < NTOK * 16; i += G * NTHR) INV[i] = -1;
            const float* wr = PT(42) + (size_t)l * DM * 16; const float* gn = norm_ffn + l * DM;
            float* wl = sf;
            __syncthreads();
#pragma unroll 1
            for (int q0 = 0; q0 < 16; q0 += 4) {
                const float4 a0 = ((const float4*)wr)[(q0 + 0) * 512 + tid], a1 = ((const float4*)wr)[(q0 + 1) * 512 + tid], a2 = ((const float4*)wr)[(q0 + 2) * 512 + tid], a3 = ((const float4*)wr)[(q0 + 3) * 512 + tid];
                { const int f4 = (q0 + 0) * 512 + tid; *(float4*)(wl + (size_t)(f4 >> 4) * 68 + (f4 & 15) * 4) = a0; }
                { const int f4 = (q0 + 1) * 512 + tid; *(float4*)(wl + (size_t)(f4 >> 4) * 68 + (f4 & 15) * 4) = a1; }
                { const int f4 = (q0 + 2) * 512 + tid; *(float4*)(wl + (size_t)(f4 >> 4) * 68 + (f4 & 15) * 4) = a2; }
                { const int f4 = (q0 + 3) * 512 + tid; *(float4*)(wl + (size_t)(f4 >> 4) * 68 + (f4 & 15) * 4) = a3; } }
            __syncthreads();
            for (int tok0 = (bid * 8 + wave) * 4; tok0 < M2; tok0 += G * 32) {
                const int r = tok0 < NLAT ? tok0 / SEQ : 4; const float* xr = XS + (size_t)tok0 * DM;
                const float* sh = MODl + (size_t)(r * 6 + 3) * DM; const float* sc = MODl + (size_t)(r * 6 + 4) * DM;
                float rs[4];
#pragma unroll
                for (int tk = 0; tk < 4; ++tk) { float ss = 0.f;
#pragma unroll 4
                    for (int i = 0; i < 8; ++i) { const float4 t4 = *(const float4*)(xr + (size_t)tk * DM + i * 256 + lane * 4); ss += t4.x * t4.x + t4.y * t4.y + t4.z * t4.z + t4.w * t4.w; }
                    ss = wave_sum(ss); rs[tk] = rsqrtf(ss * (1.0f / DM) + 1e-6f); }
                float lg[4][16];
#pragma unroll
                for (int tk = 0; tk < 4; ++tk)
#pragma unroll
                    for (int e = 0; e < 16; ++e) lg[tk][e] = 0.f;
#pragma unroll 1
                for (int i = 0; i < 8; ++i) { const int d = i * 256 + lane * 4;
                    const float4 g4 = *(const float4*)(gn + d), s4 = *(const float4*)(sc + d), h4 = *(const float4*)(sh + d);
                    float4 xq[4], ww[16];
#pragma unroll
                    for (int tk = 0; tk < 4; ++tk) xq[tk] = *(const float4*)(xr + (size_t)tk * DM + d);
                    const float4* wq = (const float4*)(wl + (size_t)(i * 64 + lane) * 68);
#pragma unroll
                    for (int q = 0; q < 16; ++q) ww[q] = wq[q];
                    float hv[4][4];
#pragma unroll
                    for (int tk = 0; tk < 4; ++tk) { const float4 xv = xq[tk]; const float rr = rs[tk];
                        hv[tk][0] = xv.x * rr * g4.x * (1.f + s4.x) + h4.x; hv[tk][1] = xv.y * rr * g4.y * (1.f + s4.y) + h4.y; hv[tk][2] = xv.z * rr * g4.z * (1.f + s4.z) + h4.z; hv[tk][3] = xv.w * rr * g4.w * (1.f + s4.w) + h4.w;
                        u32x2 w; w.x = pk2(hv[tk][0], hv[tk][1]); w.y = pk2(hv[tk][2], hv[tk][3]); *(u32x2*)(HB + (size_t)(tok0 + tk) * DM + d) = w; }
#pragma unroll
                    for (int q = 0; q < 4; ++q) { const float4 w0 = ww[q * 4 + 0], w1 = ww[q * 4 + 1], w2 = ww[q * 4 + 2], w3 = ww[q * 4 + 3];
#pragma unroll
                        for (int tk = 0; tk < 4; ++tk) { const float hq = hv[tk][q];
                            lg[tk][0] += hq * w0.x; lg[tk][1] += hq * w0.y; lg[tk][2] += hq * w0.z; lg[tk][3] += hq * w0.w; lg[tk][4] += hq * w1.x; lg[tk][5] += hq * w1.y; lg[tk][6] += hq * w1.z; lg[tk][7] += hq * w1.w;
                            lg[tk][8] += hq * w2.x; lg[tk][9] += hq * w2.y; lg[tk][10] += hq * w2.z; lg[tk][11] += hq * w2.w; lg[tk][12] += hq * w3.x; lg[tk][13] += hq * w3.y; lg[tk][14] += hq * w3.z; lg[tk][15] += hq * w3.w; } } }
#pragma unroll
                for (int tk = 0; tk < 4; ++tk) { float mx = -1e30f;
#pragma unroll
                    for (int e = 0; e < 16; ++e) { lg[tk][e] = wave_sum(lg[tk][e]); mx = fmaxf(mx, lg[tk][e]); }
                    float sm = 0.f;
#pragma unroll
                    for (int e = 0; e < 16; ++e) { lg[tk][e] = expf(lg[tk][e] - mx); sm += lg[tk][e]; }
                    const float inv = 1.0f / sm;
                    if (lane == 0) {
#pragma unroll
                        for (int e = 0; e < 16; e += 4) *(float4*)(PROBS + (size_t)(tok0 + tk) * 16 + e) = make_float4(lg[tk][e] * inv, lg[tk][e + 1] * inv, lg[tk][e + 2] * inv, lg[tk][e + 3] * inv); } }
            }
            SEAM(PB + 9);
        }
        if (IN(PB + 10)) for (int rep_ = 0; rep_ < PROBE_REPS(10); ++rep_) {
            PH_BEGIN
            const int nitems = 64 + (lastl ? 0 : 64);
            unsigned long long* keys = (unsigned long long*)shm;
            for (int it = bid; it < nitems; it += G) {
                const int set = it >> 6, e = it & 15, b = (it >> 4) & 3;
                const int n = set ? CTXL : SEQ, cap = set ? 32 : 512, tokbase = set ? NLAT + b * CTXL : b * SEQ;
                __syncthreads();
                for (int i = tid; i < n; i += NTHR) keys[i] = ((unsigned long long)__float_as_uint(PROBS[(size_t)(tokbase + i) * 16 + e]) << 32) | (unsigned long long)(0xFFFFFFFFu - (unsigned)i);
                __syncthreads();
                for (int k = 2; k <= n; k <<= 1)
                    for (int j = k >> 1; j > 0; j >>= 1) {
                        for (int p = tid; p < (n >> 1); p += NTHR) { const int i = ((p & ~(j - 1)) << 1) | (p & (j - 1)); const int m = i | j;
                            const unsigned long long ka = keys[i], kb = keys[m]; const bool desc = ((i & k) == 0);
                            if ((ka < kb) == desc) { keys[i] = kb; keys[m] = ka; } }
                        __syncthreads();
                    }
                for (int r = tid; r < cap; r += NTHR) { const unsigned long long kk = keys[r]; const int row = e * MOE_PAD + (set ? 2048 + b * 32 + r : b * 512 + r);
                    const int tk_ = tokbase + (int)(0xFFFFFFFFu - (unsigned)(kk & 0xFFFFFFFFull)); ROWTOK[row] = tk_; ROWGATE[row] = __uint_as_float((unsigned)(kk >> 32)); INV[tk_ * 16 + e] = row; }
                for (int rb = 0; rb < cap; rb += 32) {
                    u32x4 t4[4][4];
#pragma unroll
                    for (int q = 0; q < 4; ++q) { const int r = rb + wave + 8 * q; const int tok = tokbase + (int)(0xFFFFFFFFu - (unsigned)(keys[r] & 0xFFFFFFFFull));
                        const u32x4* sp = (const u32x4*)(HB + (size_t)tok * DM);
#pragma unroll
                        for (int i = 0; i < 4; ++i) t4[q][i] = sp[i * 64 + lane]; }
#pragma unroll
                    for (int q = 0; q < 4; ++q) { const int r = rb + wave + 8 * q; const int row = e * MOE_PAD + (set ? 2048 + b * 32 + r : b * 512 + r);
                        u32x4* dp = (u32x4*)(XG + (size_t)row * DM);
#pragma unroll
                        for (int i = 0; i < 4; ++i) dp[i * 64 + lane] = t4[q][i]; } }
            }
            if (lastl && G > 64 && bid >= 64) {
                const int n_win = 32 * 55, n_br = 4 * 64, n_out = 32 * 8, n_glu = 16, n_gu = 16 * 2 * 192, n_d = 16 * 192;
                const int lo_d = n_win + n_br + n_out + n_glu + n_gu;
                CV_RUN(l, lo_d + bid - 64, G - 64, lo_d + n_d);
            }
            if (!lastl && G > 128 && bid >= 128) {
                const int n_win = 32 * 55, n_br = 4 * 64, n_out = 32 * 8, n_glu = 16, n_gu = 16 * 2 * 192; (void)n_gu;
                CV_RUN(l + 1, bid - 128, G - 128, n_win); (void)n_br; (void)n_out; (void)n_glu;
            }
            {   const int pad0 = lastl ? 2048 : MOE_ROWS, npad = MOE_PAD - pad0;
                for (int R = bid * 8 + wave; R < NEXP * npad; R += G * 8) { const int e = R / npad, rr = pad0 + R % npad; u32x4* dp = (u32x4*)(XG + ((size_t)e * MOE_PAD + rr) * DM);
#pragma unroll
                    for (int i = 0; i < 4; ++i) dp[i * 64 + lane] = (u32x4){0u, 0u, 0u, 0u}; } }
            SEAM(PB + 10);
        }
        if (IN(PB + 12)) for (int rep_ = 0; rep_ < PROBE_REPS(12); ++rep_) {
            PH_BEGIN
            pg8::Gemm g{XG, WGU, DM, DM, DM}; pg8::SchedMoe S{lastl ? 8 : 9, 12, G, bid, DM, DM, 2 * DEXP}; pg8::EpiMoe1 E{HID};
            pg8::gemm_phase((LAS unsigned char*)shm, g, S, E);
            SEAM(PB + 12);
        }
        if (IN(PB + 13)) for (int rep_ = 0; rep_ < PROBE_REPS(13); ++rep_) {
            PH_BEGIN
            pg8::Gemm g{HID, WD, DEXP, DEXP, DEXP}; pg8::SchedMoe S{lastl ? 8 : 9, 8, G, bid, DEXP, DEXP, DM}; pg8::EpiMoeY E{YEXP};
            pg8::gemm_phase((LAS unsigned char*)shm, g, S, E);
            SEAM(PB + 13);
        }

}

__global__ __launch_bounds__(NTHR, 2) void fwd(Args a) {
    extern __shared__ __attribute__((aligned(16))) unsigned char shm[];
    const int bid = blockIdx.x, G = gridDim.x;
    float* const sf = (float*)shm;
    volatile LAS unsigned* xbw = (volatile LAS unsigned*)((LAS unsigned char*)shm + (LDS_BYTES - 16));
    if (threadIdx.x == 0) { xbw[0] = 0u; xbw[1] = 0u; xbw[2] = 0u; xbw[3] = 0u; }
    const float** const ptab = (const float**)(shm + (LDS_BYTES - 16 - 512));
    if (threadIdx.x == 0) {
#pragma unroll
        for (int i = 0; i < 47; ++i) ptab[i] = a.in[i]; }
    __syncthreads();
    XcdBarrier bar = xcd_barrier_post((unsigned*)(a.ws + O_BAR), xbw);
    const int lo = a.ph_lo, hi = a.ph_hi;
    if (IN(0)) {
        PH_BEGIN
        {
            __syncthreads();
            for (int i = tid; i < 5 * DM; i += NTHR) { const int r = i >> 11, k = i & (DM - 1); const float v = r < 4 ? c_in[r * DM + k] : cctx_in[k]; sf[i] = siluf_(v); }
            __syncthreads();
            float* red = sf + 5 * DM;
            for (int unit = bid; unit < 2 * 96; unit += G) { const int l = unit / 96, j = (unit % 96) * 128 + (tid & 127), kq = tid >> 7;
                const float* w = ada_w + (size_t)l * DM * (6 * DM) + (size_t)(kq * 512) * (6 * DM) + j; const float* sv = sf + kq * 512;
                float a0 = 0.f, a1 = 0.f, a2 = 0.f, a3 = 0.f, a4 = 0.f;
#pragma unroll 8
                for (int k = 0; k < 512; ++k) { const float wv = w[(size_t)k * (6 * DM)]; a0 += sv[k] * wv; a1 += sv[DM + k] * wv; a2 += sv[2 * DM + k] * wv; a3 += sv[3 * DM + k] * wv; a4 += sv[4 * DM + k] * wv; }
                __syncthreads();
                { float* rp = red + (kq * 5) * 128 + (tid & 127); rp[0] = a0; rp[128] = a1; rp[256] = a2; rp[384] = a3; rp[512] = a4; }
                __syncthreads();
                if (tid < 128) { const float bb = ada_b[l * 6 * DM + j]; float* o = MOD + (size_t)l * 5 * 6 * DM + j;
#pragma unroll
                    for (int r = 0; r < 5; ++r) o[(size_t)r * 6 * DM] = ((red[(0 * 5 + r) * 128 + tid] + red[(1 * 5 + r) * 128 + tid]) + (red[(2 * 5 + r) * 128 + tid] + red[(3 * 5 + r) * 128 + tid])) + bb; }
            }
        }
    }

    layer_body<0>(a, bar, lo, hi, bid, G, shm, sf, ptab);
    layer_body<1>(a, bar, lo, hi, bid, G, shm, sf, ptab);
    if (IN(33)) {
        PH_BEGIN
        const float* gn = PT(46);
        for (int tok = bid * 8 + wave; tok < NLAT; tok += G * 8) {
            const float* xr = XS + (size_t)tok * DM; float4 v[8]; float ss = 0.f;
#pragma unroll
            for (int i = 0; i < 8; ++i) v[i] = *(const float4*)(xr + i * 256 + lane * 4);
            moe_combine(v, tok, lane, INV, ROWGATE, YEXP, MOD + (size_t)(1 * 5 + tok / SEQ) * 6 * DM + 5 * DM);
#pragma unroll
            for (int i = 0; i < 8; ++i) {                 ss += v[i].x * v[i].x + v[i].y * v[i].y + v[i].z * v[i].z + v[i].w * v[i].w; }
            ss = wave_sum(ss); const float rs = rsqrtf(ss * (1.0f / DM) + 1e-6f);
#pragma unroll
            for (int i = 0; i < 8; ++i) { const int d = i * 256 + lane * 4; const float4 g4 = *(const float4*)(gn + d);
                *(float4*)(a.out + (size_t)tok * DM + d) = make_float4(v[i].x * rs * g4.x, v[i].y * rs * g4.y, v[i].z * rs * g4.z, v[i].w * rs * g4.w); }
        }
    }
#undef IN
#undef SEAM
}


extern "C" void kernel_launch(void* const* d_in, const int* in_sizes, int n_in, void* d_out, int out_size, void* d_ws, size_t ws_size, hipStream_t stream) {
    static int grid = 0;
    if (grid == 0) {
        if (n_in != 47 || ws_size < WS_END) { fprintf(stderr, "kernel_launch: expected 47 inputs and >= %zu bytes of workspace; got %d, %zu\n", (size_t)WS_END, n_in, ws_size); grid = -1; return; }
        int dev = 0, cus = 0;
        if (hipGetDevice(&dev) != hipSuccess || hipDeviceGetAttribute(&cus, hipDeviceAttributeMultiprocessorCount, dev) != hipSuccess) { grid = -1; return; }
        if (hipFuncSetAttribute((const void*)fwd, hipFuncAttributeMaxDynamicSharedMemorySize, LDS_BYTES) != hipSuccess) { fprintf(stderr, "kernel_launch: hipFuncSetAttribute failed\n"); grid = -1; return; }
        int per_cu = 0;
        if (hipOccupancyMaxActiveBlocksPerMultiprocessor(&per_cu, (const void*)fwd, NTHR, LDS_BYTES) != hipSuccess || per_cu < 1) fprintf(stderr, "kernel_launch: occupancy query reports %d\n", per_cu);
        (void)hipGetLastError();
        grid = cus > 256 ? 256 : cus;
        if (grid < 224) { fprintf(stderr, "kernel_launch: needs >= 224 CUs (got %d)\n", grid); grid = -1; return; }
    }
    if (grid < 0) return;
    (void)hipMemsetAsync((char*)d_ws, 0, O_ZERO_END, stream);
    Args a{};
    for (int i = 0; i < 47; ++i) a.in[i] = (const float*)d_in[i];
    a.out = (float*)d_out; a.ws = (unsigned char*)d_ws;
#if MK_ONE_LAUNCH
    a.ph_lo = 0; a.ph_hi = 64;
    hipLaunchKernelGGL(fwd, dim3(grid), dim3(NTHR), LDS_BYTES, stream, a);
#else
    const int ids[] = {0, 1,2,3,4,5,6,7,8,9,10,11,12,13,14, 17,18,19,20,21,22,23,24,25,26,27,28,29,30, 33};
    for (int k = 0; k < (int)(sizeof(ids) / sizeof(ids[0])); ++k) { a.ph_lo = ids[k]; a.ph_hi = ids[k] + 1; hipLaunchKernelGGL(fwd, dim3(grid), dim3(NTHR), LDS_BYTES, stream, a); }
#endif
}
```

```cpp
#include <hip/hip_runtime.h>
#include <stdint.h>
#include <stdio.h>

#ifndef PROBE_MASK
#define PROBE_MASK 0
#endif
#ifndef PROBE_SP
#define PROBE_SP 1
#endif
#define PROBE_REPS(k) ((((PROBE_MASK) >> (k)) & 1) + 1)
#ifndef MK_ONE_LAUNCH
#define MK_ONE_LAUNCH 1
#endif

#define DM 2048
#define NB 4
#define SEQ 4096
#define CTXL 256
#define BW 512
#define NLAT 16384
#define NCTX 1024
#define NTOK 17408
#define IN_W 13856
#define GATE2 5888
#define LDP 14080
#define HY_OFF 0
#define ML_OFF 1536
#define S5_OFF 3600
#define SSD_OFF 4112
#define GATE_OFF 5664
#define NEXP 16
#define DEXP 1536
#define MOE_ROWS 2176
#define MOE_PAD 2304
#define NTHR 512
#define LDS_BYTES 147456
#define LAS __attribute__((address_space(3)))

typedef unsigned short bf16_t;
typedef short bf16x8 __attribute__((ext_vector_type(8)));
typedef float f32x4 __attribute__((ext_vector_type(4)));
typedef unsigned u32x4 __attribute__((ext_vector_type(4)));
typedef unsigned u32x2 __attribute__((ext_vector_type(2)));

#define XB_TMO      128
#define XB_XCNT(j)  (256  + 64 * (j))
#define XB_XSUB(j)  (1280 + 64 * (j))
#define XB_XGEN(j)  (2304 + 64 * (j))
#define XB_TOP      3328
#define XB_TOPGEN   3392
#define XCD_BAR_WORDS 3456
#define XB_SPIN_CAP (1u << 18)
__device__ __forceinline__ unsigned xb_ld(unsigned* p)              { return __hip_atomic_load(p, __ATOMIC_RELAXED, __HIP_MEMORY_SCOPE_AGENT); }
__device__ __forceinline__ unsigned xb_add(unsigned* p, unsigned v) { return __hip_atomic_fetch_add(p, v, __ATOMIC_RELAXED, __HIP_MEMORY_SCOPE_AGENT); }
__device__ __forceinline__ unsigned xb_xcc_id() { return (unsigned)__builtin_amdgcn_s_getreg((3 << 11) | 20) & 0xFu; }
#define XB_SPIN(cond, bar) do { unsigned _sp = 0; while (cond) { __builtin_amdgcn_s_sleep(1); \
    if ((++_sp & 255u) == 0u) { if (xb_ld(&(bar)[XB_TMO])) break; if (_sp > XB_SPIN_CAP) { atomicAdd(&(bar)[XB_TMO], 1u); break; } } } } while (0)
struct XcdBarrier { unsigned* bar; unsigned x; volatile LAS unsigned* st; };
__device__ __forceinline__ XcdBarrier xcd_barrier_post(unsigned* bar, volatile LAS unsigned* st) {
    XcdBarrier b; b.bar = bar; b.x = xb_xcc_id(); b.st = st;
    if (threadIdx.x == 0) (void)xb_add(&bar[XB_XCNT(b.x)], 1u);
    return b;
}
__device__ __forceinline__ void xcd_barrier_complete(unsigned* bar, unsigned x, unsigned& nloc, unsigned& nx) {
    const unsigned G = gridDim.x * gridDim.y * gridDim.z;
    unsigned sum, cnt, mine, sp = 0u;
    for (;;) {
        sum = 0u; cnt = 0u; mine = 0u;
#pragma unroll
        for (unsigned j = 0; j < 16; ++j) { const unsigned c = xb_ld(&bar[XB_XCNT(j)]); sum += c; cnt += (c > 0u) ? 1u : 0u; mine = (j == x) ? c : mine; }
        if (sum == G) break;
        __builtin_amdgcn_s_sleep(1);
        if ((++sp & 255u) == 0u) { if (xb_ld(&bar[XB_TMO])) break; if (sp > XB_SPIN_CAP) { atomicAdd(&bar[XB_TMO], 1u); break; } }
    }
    nloc = mine > 0u ? mine : 1u; nx = cnt > 0u ? cnt : 1u;
}
__device__ __forceinline__ void xcd_barrier(const XcdBarrier& b) {
    asm volatile("s_waitcnt vmcnt(0)" ::: "memory");
    __syncthreads();
    if (threadIdx.x == 0) {
        unsigned* bar = b.bar;
        __builtin_amdgcn_s_waitcnt(0);
        unsigned nloc = b.st[0], nx = b.st[1];
        if (nloc == 0u) { xcd_barrier_complete(bar, b.x, nloc, nx); b.st[0] = nloc; b.st[1] = nx; }
        const unsigned old = xb_add(&bar[XB_XSUB(b.x)], 1u);
        const unsigned gen = old / nloc;
        if (old + 1u == (gen + 1u) * nloc) {
            __builtin_amdgcn_fence(__ATOMIC_RELEASE, "agent");
            asm volatile("s_waitcnt vmcnt(0)" ::: "memory");
            const unsigned og = xb_add(&bar[XB_TOP], 1u);
            const unsigned tg = og / nx;
            if (og + 1u == (tg + 1u) * nx) xb_add(&bar[XB_TOPGEN], 1u);
            else XB_SPIN(xb_ld(&bar[XB_TOPGEN]) == tg, bar);
            __builtin_amdgcn_fence(__ATOMIC_ACQUIRE, "agent");
            xb_add(&bar[XB_XGEN(b.x)], 1u);
            asm volatile("s_waitcnt vmcnt(0)" ::: "memory");
        } else {
            XB_SPIN(xb_ld(&bar[XB_XGEN(b.x)]) == gen, bar);
            __builtin_amdgcn_fence(__ATOMIC_ACQUIRE, "agent");
            asm volatile("s_waitcnt vmcnt(0)" ::: "memory");
        }
    }
    __syncthreads();
}

__device__ __forceinline__ unsigned short f2bf(float f) { unsigned u = __float_as_uint(f); u += 0x7FFFu + ((u >> 16) & 1u); return (unsigned short)(u >> 16); }
__device__ __forceinline__ float bf2f(unsigned short b) { return __uint_as_float(((unsigned)b) << 16); }
__device__ __forceinline__ unsigned pk2(float lo, float hi) { unsigned r; asm("v_cvt_pk_bf16_f32 %0, %1, %2" : "=v"(r) : "v"(lo), "v"(hi)); return r; }
__device__ __forceinline__ float sigmoidf_(float x) { return 1.0f / (1.0f + expf(-x)); }
__device__ __forceinline__ float siluf_(float x) { return x / (1.0f + expf(-x)); }
__device__ __forceinline__ float wave_sum(float v) {
#pragma unroll
    for (int o = 32; o >= 1; o >>= 1) v += __shfl_xor(v, o);
    return v;
}
__device__ __forceinline__ const float* uptr(const float* p) { const unsigned long long v = (unsigned long long)p;
    const unsigned lo = __builtin_amdgcn_readfirstlane((unsigned)v), hi = __builtin_amdgcn_readfirstlane((unsigned)(v >> 32)); return (const float*)(((unsigned long long)hi << 32) | lo); }
#define PT(k) uptr(ptab[k])
__device__ __forceinline__ int step_tok(int b, int dir, int i) {
    if (i < CTXL) { const int tt = dir ? (CTXL - 1 - i) : i; return NLAT + b * CTXL + tt; }
    const int j = i - CTXL; const int tt = dir ? (SEQ - 1 - j) : j; return b * SEQ + tt;
}
__device__ __forceinline__ void unpack8(const u32x4 w, float (&f)[8]) {
    f[0] = __uint_as_float(w.x << 16); f[1] = __uint_as_float(w.x & 0xFFFF0000u); f[2] = __uint_as_float(w.y << 16); f[3] = __uint_as_float(w.y & 0xFFFF0000u);
    f[4] = __uint_as_float(w.z << 16); f[5] = __uint_as_float(w.z & 0xFFFF0000u); f[6] = __uint_as_float(w.w << 16); f[7] = __uint_as_float(w.w & 0xFFFF0000u);
}

namespace pg8 {
constexpr int BM = 256, BK = 64, HALF = 128, HTB = HALF * BK * 2, STAGE_BYTES = 8 * HTB, NXCD = 8, WGM = 8;
__host__ __device__ __forceinline__ int lds_byte(int r, int c) { const int st = (r >> 4) * 2 + (c >> 5), rr = r & 15, cc = c & 31, ob = rr * 64 + cc * 2; return st * 1024 + (ob ^ (((ob >> 9) & 1) << 5)); }
__host__ __device__ __forceinline__ void stage_rc(int b, int& R, int& C) { const int st = b / 1024, sb = b % 1024, swz = sb ^ (((sb >> 9) & 1) << 5); R = (st >> 1) * 16 + swz / 64; C = (st & 1) * 32 + (swz % 64) / 2; }
__host__ __device__ __forceinline__ int perm32(int rho) { const int n = rho >> 4, i = rho & 15; return 8 * (i >> 2) + 4 * n + (i & 3); }
struct Unit { int pm, pn, z, k; long long ao, bo; };
struct Gemm { const bf16_t* A; const bf16_t* Bt; int lda, ldb, K; };

__device__ __forceinline__ void tile_of(int wgid, int nM, int nN, int& pm, int& pn) {
    const int nwg = nM * nN; { const int q = nwg / NXCD, r = nwg % NXCD, xcd = wgid % NXCD, off = wgid / NXCD; wgid = (xcd < r ? xcd * (q + 1) : r * (q + 1) + (xcd - r) * q) + off; }
    const int nig = WGM * nN, gid = wgid / nig, fm = gid * WGM, gsz = (nM - fm) < WGM ? (nM - fm) : WGM;
    pm = fm + ((wgid % nig) % gsz); pn = (wgid % nig) / gsz;
}
struct SchedStd {
    int nM, nN, G, c, lda, ldb;
    __device__ __forceinline__ bool next(int i, Unit& u) const { const long L = (long)i * G + c; if (L >= (long)nM * nN) return false; tile_of((int)L, nM, nN, u.pm, u.pn); u.z = 0; u.k = 0;
        u.ao = (long long)u.pm * BM * lda * 2; u.bo = (long long)u.pn * BM * ldb * 2; return true; }
    __device__ __forceinline__ void a_ready(const Unit&) const {}
    __device__ __forceinline__ void done(const Unit&) const {}
};
struct SchedBranch {
    int nM, nN, G, c;
    __device__ __forceinline__ bool next(int i, Unit& u) const { const long L = (long)(i >> 2) * G + c; if (L >= (long)nM * nN) return false; tile_of((int)L, nM, nN, u.pm, u.pn); u.z = 0; u.k = i & 3;
        u.ao = ((long long)u.pm * BM * DM + u.k * BW) * 2; u.bo = ((long long)u.k * DM + u.pn * BM) * BW * 2; return true; }
    __device__ __forceinline__ void a_ready(const Unit&) const {}
    __device__ __forceinline__ void done(const Unit&) const {}
};
struct SchedTail {
    int G, c;
    __device__ __forceinline__ bool next(int i, Unit& u) const { const long T = (long)i * G + c; if (T >= 128) return false; const int t = (int)(T >> 2); u.pm = 64 + (t >> 3); u.pn = t & 7; u.z = 1; u.k = (int)(T & 3);
        u.ao = ((long long)u.pm * BM * DM + u.k * BW) * 2; u.bo = ((long long)u.k * DM + u.pn * BM) * BW * 2; return true; }
    __device__ __forceinline__ void a_ready(const Unit&) const {}
    __device__ __forceinline__ void done(const Unit&) const {}
};
struct SchedTailK {
    int G, c;
    __device__ __forceinline__ bool next(int i, Unit& u) const { const long T = (long)i * G + c; if (T >= 128) return false; const int t = (int)(T >> 2); u.pm = 64 + (t >> 3); u.pn = t & 7; u.z = 1; u.k = (int)(T & 3);
        u.ao = ((long long)u.pm * BM * DM + u.k * 512) * 2; u.bo = ((long long)u.pn * BM * DM + u.k * 512) * 2; return true; }
    __device__ __forceinline__ void a_ready(const Unit&) const {}
    __device__ __forceinline__ void done(const Unit&) const {}
};
struct SchedMoe {
    int nPm, nPn, G, c, lda, ldb, nBrows;
    __device__ __forceinline__ bool next(int i, Unit& u) const { const long L = (long)i * G + c; const int per = nPm * nPn; if (L >= (long)NEXP * per) return false; const int e = (int)(L / per), rem = (int)(L % per);
        u.z = e; u.k = 0; u.pm = rem % nPm; u.pn = rem / nPm; u.ao = ((long long)e * MOE_PAD + u.pm * BM) * lda * 2; u.bo = ((long long)e * nBrows + u.pn * BM) * ldb * 2; return true; }
    __device__ __forceinline__ void a_ready(const Unit&) const {}
    __device__ __forceinline__ void done(const Unit&) const {}
};

typedef f32x4 Acc[2][2][4][2];
template <class Epi, class Sched>
__device__ __forceinline__ void gemm_phase(LAS unsigned char* lds, const Gemm g, const Sched& S, const Epi& E) {
    int tid = threadIdx.x; asm volatile("" : "+v"(tid));
    const int wid = __builtin_amdgcn_readfirstlane(tid >> 6), lane = tid & 63, wr = wid >> 2, wc = wid & 3, fr = lane & 15, fq = lane >> 4;
    const int K = g.K, nt = K / BK;
    unsigned voffA[2], voffB[2];
#pragma unroll
    for (int i = 0; i < 2; ++i) { int R, C; stage_rc(tid * 16 + i * 8192, R, C); const int Rb = Epi::PERM ? ((R & ~31) + perm32(R & 31)) : R;
        voffA[i] = (unsigned)(R * g.lda + C) * 2u; voffB[i] = (unsigned)(Rb * g.ldb + C) * 2u; }
    const size_t kstep = (size_t)(BK * 2);
    const size_t hstepA = (size_t)HALF * g.lda * 2, hstepB = (size_t)HALF * g.ldb * 2;
    const unsigned ldsw = (unsigned)wid * 1024u;
    const int aoff = lds_byte(wr * 64 + fr, fq * 8), boff = lds_byte(wc * 32 + fr, fq * 8);
#define PG8_SA(b, h) (((b) * 2 + (h)) * HTB)
#define PG8_SB(b, h) ((4 + (b) * 2 + (h)) * HTB)
#define PG8_STAGE(bufoff, gbase, voff) do { _Pragma("unroll") for (int _i = 0; _i < 2; ++_i) \
        __builtin_amdgcn_global_load_lds((const unsigned*)((const char*)(gbase) + (voff)[_i]), (LAS unsigned*)(lds + (bufoff) + ldsw + _i * 8192), 16, 0, 0); } while (0)
#define PG8_LDA(dst, b, h) do { _Pragma("unroll") for (int m = 0; m < 4; ++m) _Pragma("unroll") for (int k = 0; k < 2; ++k) dst[m][k] = *(const LAS bf16x8*)(lds + PG8_SA(b, h) + aoff + m * 2048 + k * 1024); } while (0)
#define PG8_LDB(dst, b, h) do { _Pragma("unroll") for (int n = 0; n < 2; ++n) _Pragma("unroll") for (int k = 0; k < 2; ++k) dst[n][k] = *(const LAS bf16x8*)(lds + PG8_SB(b, h) + boff + n * 2048 + k * 1024); } while (0)
#define PG8_MMA(ai, bj, At, Bt) do { __builtin_amdgcn_s_setprio(1); _Pragma("unroll") for (int m = 0; m < 4; ++m) _Pragma("unroll") for (int n = 0; n < 2; ++n) _Pragma("unroll") for (int k = 0; k < 2; ++k) \
        acc[ai][bj][m][n] = __builtin_amdgcn_mfma_f32_16x16x32_bf16(Bt[n][k], At[m][k], acc[ai][bj][m][n], 0, 0, 0); __builtin_amdgcn_s_setprio(0); } while (0)
#define PG8_WAIT_V(n) asm volatile("s_waitcnt vmcnt(" #n ")" ::: "memory")
#define PG8_WAIT_L(n) asm volatile("s_waitcnt lgkmcnt(" #n ")" ::: "memory")
#define PG8_BAR __builtin_amdgcn_s_barrier()
#define PG8_SCHED __builtin_amdgcn_sched_barrier(0)
    Unit cur, nxt; int ui = 0;
    if (!S.next(0, cur)) return;
    Acc acc;
#pragma unroll
    for (int a = 0; a < 2; ++a)
#pragma unroll
        for (int b = 0; b < 2; ++b)
#pragma unroll
            for (int m = 0; m < 4; ++m)
#pragma unroll
                for (int n = 0; n < 2; ++n) acc[a][b][m][n] = (f32x4){0.f, 0.f, 0.f, 0.f};
    bf16x8 At[4][2], B0[2][2], B1[2][2];
    const char* cA = (const char*)g.A + cur.ao; const char* cB = (const char*)g.Bt + cur.bo;
    S.a_ready(cur);
    PG8_STAGE(PG8_SB(0, 0), cB, voffB); PG8_STAGE(PG8_SA(0, 0), cA, voffA); PG8_STAGE(PG8_SB(0, 1), cB + hstepB, voffB); PG8_STAGE(PG8_SA(0, 1), cA + hstepA, voffA);
    if (wr == 1) PG8_BAR;
    PG8_WAIT_V(4); PG8_BAR;
    PG8_STAGE(PG8_SB(1, 0), cB + kstep, voffB); PG8_STAGE(PG8_SA(1, 0), cA + kstep, voffA); PG8_STAGE(PG8_SB(1, 1), cB + hstepB + kstep, voffB);
    PG8_WAIT_V(6); PG8_BAR;
    for (;;) {
        const bool has_next = S.next(ui + 1, nxt);
        const char* nA = has_next ? (const char*)g.A + nxt.ao : cA; const char* nB = has_next ? (const char*)g.Bt + nxt.bo : cB;
        for (int t = 0; t < nt; t += 2) {
            const bool last = (t == nt - 2);
            const char* a1 = cA + (size_t)(t + 1) * kstep;
            const char* a2 = last ? nA : cA + (size_t)(t + 2) * kstep; const char* b2 = last ? nB : cB + (size_t)(t + 2) * kstep;
            const char* a3 = a2 + kstep; const char* b3 = b2 + kstep;
            if (last && has_next) S.a_ready(nxt);
            PG8_LDB(B0, 0, 0); PG8_SCHED; PG8_LDA(At, 0, 0); PG8_STAGE(PG8_SA(1, 1), a1 + hstepA, voffA);
            PG8_WAIT_L(8); PG8_BAR; PG8_WAIT_L(0); PG8_MMA(0, 0, At, B0); PG8_BAR; PG8_SCHED;
            PG8_LDB(B1, 0, 1); PG8_STAGE(PG8_SB(0, 0), b2, voffB);
            PG8_BAR; PG8_WAIT_L(0); PG8_MMA(0, 1, At, B1); PG8_BAR;
            PG8_LDA(At, 0, 1); PG8_STAGE(PG8_SA(0, 0), a2, voffA);
            PG8_BAR; PG8_WAIT_L(0); PG8_MMA(1, 0, At, B0); PG8_BAR; PG8_SCHED;
            PG8_STAGE(PG8_SB(0, 1), b2 + hstepB, voffB);
            PG8_WAIT_V(6); PG8_BAR; PG8_MMA(1, 1, At, B1); PG8_BAR;
            PG8_LDB(B0, 1, 0); PG8_SCHED; PG8_LDA(At, 1, 0); PG8_STAGE(PG8_SA(0, 1), a2 + hstepA, voffA);
            PG8_WAIT_L(8); PG8_BAR; PG8_WAIT_L(0); PG8_MMA(0, 0, At, B0); PG8_BAR; PG8_SCHED;
            PG8_LDB(B1, 1, 1); PG8_STAGE(PG8_SB(1, 0), b3, voffB);
            PG8_BAR; PG8_WAIT_L(0); PG8_MMA(0, 1, At, B1); PG8_BAR;
            PG8_LDA(At, 1, 1); PG8_STAGE(PG8_SA(1, 0), a3, voffA);
            PG8_BAR; PG8_WAIT_L(0); PG8_MMA(1, 0, At, B0); PG8_BAR; PG8_SCHED;
            PG8_STAGE(PG8_SB(1, 1), b3 + hstepB, voffB);
            PG8_WAIT_V(6); PG8_BAR; PG8_MMA(1, 1, At, B1); PG8_BAR;
        }
        const bool keep = E(acc, cur, wr, wc, fr, fq); S.done(cur);
        if (!has_next) break;
        if (!keep) {
#pragma unroll
        for (int a = 0; a < 2; ++a)
#pragma unroll
            for (int b = 0; b < 2; ++b)
#pragma unroll
                for (int m = 0; m < 4; ++m)
#pragma unroll
                    for (int n = 0; n < 2; ++n) acc[a][b][m][n] = (f32x4){0.f, 0.f, 0.f, 0.f};
        }
        cur = nxt; cA = nA; cB = nB; ++ui;
    }
    PG8_WAIT_V(0);
    if (wr == 0) PG8_BAR;
    PG8_BAR;
#undef PG8_SA
#undef PG8_SB
#undef PG8_STAGE
#undef PG8_LDA
#undef PG8_LDB
#undef PG8_MMA
#undef PG8_WAIT_V
#undef PG8_WAIT_L
#undef PG8_BAR
#undef PG8_SCHED
}

struct EpiBf16Store {
    static constexpr bool PERM = true;
    bf16_t* O; int ldc;
    __device__ __forceinline__ bool operator()(Acc& acc, const Unit& u, int wr, int wc, int fr, int fq) const {
        const int row0 = u.pm * BM + wr * 64 + fr, col0 = u.pn * BM + wc * 32 + 8 * fq;
#pragma unroll
        for (int ai = 0; ai < 2; ++ai)
#pragma unroll
            for (int m = 0; m < 4; ++m) { bf16_t* rowp = O + (size_t)(row0 + ai * HALF + m * 16) * ldc + col0;
#pragma unroll
                for (int bj = 0; bj < 2; ++bj) { const f32x4 v0 = acc[ai][bj][m][0], v1 = acc[ai][bj][m][1];
                    u32x4 w; w.x = pk2(v0[0], v0[1]); w.y = pk2(v0[2], v0[3]); w.z = pk2(v1[0], v1[1]); w.w = pk2(v1[2], v1[3]);
                    *(u32x4*)(rowp + bj * HALF) = w; } }
        return false;
    }
};
struct EpiWin {
    static constexpr bool PERM = true;
    bf16_t* O; int ldc;
    __device__ __forceinline__ bool operator()(Acc& acc, const Unit& u, int wr, int wc, int fr, int fq) const {
        const int row0 = u.pm * BM + wr * 64 + fr;
        if (u.pn < 23) { const int col0 = u.pn * BM + wc * 32 + 8 * fq;
#pragma unroll
            for (int ai = 0; ai < 2; ++ai)
#pragma unroll
                for (int m = 0; m < 4; ++m)
#pragma unroll
                    for (int bj = 0; bj < 2; ++bj) { const f32x4 v0 = acc[ai][bj][m][0], v1 = acc[ai][bj][m][1];
                        u32x4 w; w.x = pk2(v0[0], v0[1]); w.y = pk2(v0[2], v0[3]); w.z = pk2(v1[0], v1[1]); w.w = pk2(v1[2], v1[3]);
                        *(u32x4*)(O + (size_t)(row0 + ai * HALF + m * 16) * ldc + col0 + bj * HALF) = w; }
        } else { const int colb = GATE2 + 64 * (u.pn - 23) + 16 * wc + 4 * fq;
#pragma unroll
            for (int ai = 0; ai < 2; ++ai)
#pragma unroll
                for (int m = 0; m < 4; ++m) { f32x4 sg[4];
#pragma unroll
                    for (int bj = 0; bj < 2; ++bj)
#pragma unroll
                        for (int n = 0; n < 2; ++n) { const f32x4 v = acc[ai][bj][m][n];
#pragma unroll
                            for (int j = 0; j < 4; ++j) sg[2 * bj + n][j] = __builtin_amdgcn_rcpf(1.0f + __expf(-v[j])); }
                    bf16_t* op = O + (size_t)(row0 + ai * HALF + m * 16) * ldc + colb;
#pragma unroll
                    for (int k = 0; k < 4; ++k) { f32x4 r = sg[k];
                        if (k < 3) {
#pragma unroll
                            for (int j = 0; j < 4; ++j) r[j] *= __builtin_amdgcn_rcpf(sg[k + 1][j]); }
                        u32x2 w; w.x = pk2(r[0], r[1]); w.y = pk2(r[2], r[3]); *(u32x2*)(op + k * DM) = w; } }
        }
        return false;
    }
};
struct EpiNone { static constexpr bool PERM = true;
    __device__ __forceinline__ bool operator()(Acc& acc, const Unit&, int, int, int, int) const {
#pragma unroll
        for (int a = 0; a < 2; ++a)
#pragma unroll
            for (int b = 0; b < 2; ++b)
#pragma unroll
                for (int m = 0; m < 4; ++m)
#pragma unroll
                    for (int n = 0; n < 2; ++n) asm volatile("" :: "v"(acc[a][b][m][n]));
        return false; } };
struct EpiGlu {
    static constexpr bool PERM = true;
    const bf16_t* GG; const float* bias; bf16_t* Y4;
    __device__ __forceinline__ bool operator()(Acc& acc, const Unit& u, int wr, int wc, int fr, int fq) const {
        const int row0 = u.pm * BM + wr * 64 + fr, col0 = u.pn * BM + wc * 32 + 8 * fq;
#pragma unroll
        for (int bj = 0; bj < 2; ++bj) { const int col = col0 + bj * HALF; const f32x4 b0 = *(const f32x4*)(bias + col), b1 = *(const f32x4*)(bias + col + 4);
            u32x4 gq[2][4];
#pragma unroll
            for (int ai = 0; ai < 2; ++ai)
#pragma unroll
                for (int m = 0; m < 4; ++m) gq[ai][m] = *(const u32x4*)(GG + (size_t)(row0 + ai * HALF + m * 16) * BW + col);
#pragma unroll
            for (int ai = 0; ai < 2; ++ai)
#pragma unroll
                for (int m = 0; m < 4; ++m) { const size_t row = (size_t)(row0 + ai * HALF + m * 16);
                    float gg[8]; unpack8(gq[ai][m], gg);
                    const f32x4 v0 = acc[ai][bj][m][0] + b0, v1 = acc[ai][bj][m][1] + b1;
                    u32x4 w; w.x = pk2(gg[0] * sigmoidf_(v0[0]), gg[1] * sigmoidf_(v0[1])); w.y = pk2(gg[2] * sigmoidf_(v0[2]), gg[3] * sigmoidf_(v0[3]));
                    w.z = pk2(gg[4] * sigmoidf_(v1[0]), gg[5] * sigmoidf_(v1[1])); w.w = pk2(gg[6] * sigmoidf_(v1[2]), gg[7] * sigmoidf_(v1[3]));
                    *(u32x4*)(Y4 + row * DM + 1024 + col) = w; } }
        return false;
    }
};
struct EpiBranch {
    static constexpr bool PERM = true;
    const bf16_t* P; bf16_t* ACCb;
    __device__ __forceinline__ bool operator()(Acc& acc, const Unit& u, int wr, int wc, int fr, int fq) const {
        const int row0 = u.pm * BM + wr * 64 + fr, col0 = u.pn * BM + wc * 32 + 8 * fq; const int k = u.k;
        const bf16_t* gbase = P + (size_t)row0 * LDP + GATE2 + k * DM + col0;
#pragma unroll
        for (int ai = 0; ai < 2; ++ai) {
            u32x4 ga[8];
#pragma unroll
            for (int m = 0; m < 4; ++m)
#pragma unroll
                for (int bj = 0; bj < 2; ++bj) ga[m * 2 + bj] = *(const u32x4*)(gbase + (size_t)(ai * HALF + m * 16) * LDP + bj * HALF);
#pragma unroll
            for (int m = 0; m < 4; ++m)
#pragma unroll
                for (int bj = 0; bj < 2; ++bj) { float sr[8]; unpack8(ga[m * 2 + bj], sr);
                    f32x4 v0 = acc[ai][bj][m][0], v1 = acc[ai][bj][m][1];
                    v0[0] *= sr[0]; v0[1] *= sr[1]; v0[2] *= sr[2]; v0[3] *= sr[3]; v1[0] *= sr[4]; v1[1] *= sr[5]; v1[2] *= sr[6]; v1[3] *= sr[7];
                    if (k < 3) { acc[ai][bj][m][0] = v0; acc[ai][bj][m][1] = v1; }
                    else { u32x4 w; w.x = pk2(v0[0], v0[1]); w.y = pk2(v0[2], v0[3]); w.z = pk2(v1[0], v1[1]); w.w = pk2(v1[2], v1[3]); *(u32x4*)(ACCb + (size_t)(row0 + ai * HALF + m * 16) * DM + col0 + bj * HALF) = w; } } }
        return k < 3;
    }
};
struct EpiPartK {
    static constexpr bool PERM = true;
    float* PART;
    __device__ __forceinline__ bool operator()(Acc& acc, const Unit& u, int wr, int wc, int fr, int fq) const {
        const int row0 = u.pm * BM + wr * 64 + fr, col0 = u.pn * BM + wc * 32 + 8 * fq;
        float* pbase = PART + ((size_t)u.k * (NTOK - NLAT) + (size_t)(row0 - NLAT)) * DM + col0;
#pragma unroll
        for (int ai = 0; ai < 2; ++ai)
#pragma unroll
            for (int m = 0; m < 4; ++m)
#pragma unroll
                for (int bj = 0; bj < 2; ++bj) { float* pp = pbase + (size_t)(ai * HALF + m * 16) * DM + bj * HALF; *(f32x4*)pp = acc[ai][bj][m][0]; *(f32x4*)(pp + 4) = acc[ai][bj][m][1]; }
        return false;
    }
};
struct EpiResid {
    static constexpr bool PERM = false;
    float* XS; const float* srcLat; const float* srcCtx; const float* MODl; int gidx;
    __device__ __forceinline__ bool operator()(Acc& acc, const Unit& u, int wr, int wc, int fr, int fq) const {
        const int row0 = u.pm * BM + wr * 64 + fr, col0 = u.pn * BM + wc * 32 + 4 * fq;
        const int r = (u.pm * BM) < NLAT ? (u.pm * BM) / SEQ : 4;
        const float* src = (u.pm * BM) < NLAT ? srcLat : srcCtx;
        const float* mg = MODl + (size_t)(r * 6 + gidx) * DM;
#pragma unroll
        for (int bj = 0; bj < 2; ++bj) {
            f32x4 gm[2], xs[2][2][4];
#pragma unroll
            for (int n = 0; n < 2; ++n) { const int col = col0 + bj * HALF + n * 16; gm[n] = *(const f32x4*)(mg + col);
#pragma unroll
                for (int ai = 0; ai < 2; ++ai)
#pragma unroll
                    for (int m = 0; m < 4; ++m) xs[n][ai][m] = *(const f32x4*)(src + (size_t)(row0 + ai * HALF + m * 16) * DM + col); }
#pragma unroll
            for (int n = 0; n < 2; ++n) { const int col = col0 + bj * HALF + n * 16;
#pragma unroll
                for (int ai = 0; ai < 2; ++ai)
#pragma unroll
                    for (int m = 0; m < 4; ++m) *(f32x4*)(XS + (size_t)(row0 + ai * HALF + m * 16) * DM + col) = xs[n][ai][m] + gm[n] * acc[ai][bj][m][n]; } }
        return false;
    }
};
struct EpiMoe1 {
    static constexpr bool PERM = true;
    bf16_t* HID;
    __device__ __forceinline__ bool operator()(Acc& acc, const Unit& u, int wr, int wc, int fr, int fq) const {
        const size_t row0 = (size_t)u.z * MOE_PAD + u.pm * BM + wr * 64 + fr; const int col0 = u.pn * HALF + wc * 32 + 8 * fq;
#pragma unroll
        for (int ai = 0; ai < 2; ++ai)
#pragma unroll
            for (int m = 0; m < 4; ++m) { const f32x4 g0 = acc[ai][0][m][0], g1 = acc[ai][0][m][1], u0 = acc[ai][1][m][0], u1 = acc[ai][1][m][1];
                float h[8];
#pragma unroll
                for (int j = 0; j < 4; ++j) { h[j] = g0[j] * __builtin_amdgcn_rcpf(1.0f + __expf(-g0[j])) * u0[j]; h[4 + j] = g1[j] * __builtin_amdgcn_rcpf(1.0f + __expf(-g1[j])) * u1[j]; }
                u32x4 w; w.x = pk2(h[0], h[1]); w.y = pk2(h[2], h[3]); w.z = pk2(h[4], h[5]); w.w = pk2(h[6], h[7]);
                *(u32x4*)(HID + (row0 + ai * HALF + m * 16) * DEXP + col0) = w; }
        return false;
    }
};
struct EpiMoeY {
    static constexpr bool PERM = true;
    bf16_t* O;
    __device__ __forceinline__ bool operator()(Acc& acc, const Unit& u, int wr, int wc, int fr, int fq) const {
        const size_t row0 = (size_t)u.z * MOE_PAD + u.pm * BM + wr * 64 + fr; const int col0 = u.pn * BM + wc * 32 + 8 * fq;
#pragma unroll
        for (int ai = 0; ai < 2; ++ai)
#pragma unroll
            for (int m = 0; m < 4; ++m) { bf16_t* rowp = O + (row0 + ai * HALF + m * 16) * DM + col0;
#pragma unroll
                for (int bj = 0; bj < 2; ++bj) { const f32x4 v0 = acc[ai][bj][m][0], v1 = acc[ai][bj][m][1];
                    u32x4 w; w.x = pk2(v0[0], v0[1]); w.y = pk2(v0[2], v0[3]); w.z = pk2(v1[0], v1[1]); w.w = pk2(v1[2], v1[3]);
                    *(u32x4*)(rowp + bj * HALF) = w; } }
        return false;
    }
};

struct SchedS5a {
    int c;
    __device__ __forceinline__ bool next(int i, Unit& u) const { if (i > 0 || c >= 64) return false; u.z = c >> 1; u.pm = c & 1; u.pn = 0; u.k = 0;
        u.ao = ((long long)u.z * 512 + u.pm * BM) * 768 * 2; u.bo = (long long)u.z * 256 * 512 * 2; return true; }
    __device__ __forceinline__ void a_ready(const Unit&) const {}
    __device__ __forceinline__ void done(const Unit&) const {}
};
struct SchedS5b {
    int c;
    __device__ __forceinline__ bool next(int i, Unit& u) const { if (i > 0 || c >= 128) return false; u.z = c >> 2; u.pm = (c >> 1) & 1; u.pn = c & 1; u.k = 0;
        u.ao = ((long long)u.z * 512 + u.pm * BM) * 768 * 2; u.bo = ((long long)u.z * 512 + u.pn * BM) * 768 * 2; return true; }
    __device__ __forceinline__ void a_ready(const Unit&) const {}
    __device__ __forceinline__ void done(const Unit&) const {}
};
struct EpiXloc {
    static constexpr bool PERM = false;
    float* XL;
    __device__ __forceinline__ bool operator()(Acc& acc, const Unit& u, int wr, int wc, int fr, int fq) const {
        const int row0 = u.pm * BM + wr * 64 + fr, col0 = wc * 32 + 4 * fq; float* base = XL + (size_t)u.z * 512 * 256;
#pragma unroll
        for (int ai = 0; ai < 2; ++ai)
#pragma unroll
            for (int m = 0; m < 4; ++m) { float* rowp = base + (size_t)(row0 + ai * HALF + m * 16) * 256 + col0;
#pragma unroll
                for (int bj = 0; bj < 2; ++bj)
#pragma unroll
                    for (int n = 0; n < 2; ++n) *(f32x4*)(rowp + bj * HALF + n * 16) = acc[ai][bj][m][n]; }
        return false;
    }
};
struct EpiS5Out {
    static constexpr bool PERM = true;
    const bf16_t* P; const float* dskip; bf16_t* GG;
    __device__ __forceinline__ bool operator()(Acc& acc, const Unit& u, int wr, int wc, int fr, int fq) const {
        const int row0 = u.pm * BM + wr * 64 + fr, col0 = u.pn * BM + wc * 32 + 8 * fq; const int g = u.z;
#pragma unroll
        for (int bj = 0; bj < 2; ++bj) { const int col = col0 + bj * HALF; const int t = col >> 4, c0 = col & 15;
            const f32x4 d0 = *(const f32x4*)(dskip + g * 16 + c0), d1 = *(const f32x4*)(dskip + g * 16 + c0 + 4);
            u32x4 uq[2][4];
#pragma unroll
            for (int ai = 0; ai < 2; ++ai)
#pragma unroll
                for (int m = 0; m < 4; ++m) uq[ai][m] = *(const u32x4*)(P + ((size_t)(row0 + ai * HALF + m * 16) * 32 + t) * LDP + S5_OFF + g * 16 + c0);
#pragma unroll
            for (int ai = 0; ai < 2; ++ai)
#pragma unroll
                for (int m = 0; m < 4; ++m) { const size_t tok = (size_t)(row0 + ai * HALF + m * 16) * 32 + t;
                    float uu[8]; unpack8(uq[ai][m], uu);
                    const f32x4 v0 = acc[ai][bj][m][0], v1 = acc[ai][bj][m][1];
                    float y[8] = {v0[0] + d0[0] * uu[0], v0[1] + d0[1] * uu[1], v0[2] + d0[2] * uu[2], v0[3] + d0[3] * uu[3], v1[0] + d1[0] * uu[4], v1[1] + d1[1] * uu[5], v1[2] + d1[2] * uu[6], v1[3] + d1[3] * uu[7]};
#pragma unroll
                    for (int j = 0; j < 8; ++j) y[j] = 0.5f * y[j] * (1.0f + tanhf(0.7978845608028654f * (y[j] + 0.044715f * y[j] * y[j] * y[j])));
                    u32x4 w; w.x = pk2(y[0], y[1]); w.y = pk2(y[2], y[3]); w.z = pk2(y[4], y[5]); w.w = pk2(y[6], y[7]);
                    *(u32x4*)(GG + tok * BW + g * 16 + c0) = w; } }
        return false;
    }
};
}


__device__ __forceinline__ float wave_scan_incl(float v, int lane) {
#pragma unroll
    for (int o = 1; o < 64; o <<= 1) { const float t = __shfl_up(v, o); if (lane >= o) v += t; }
    return v;
}
__device__ __forceinline__ float wave_scanmax_incl(float v, int lane) {
#pragma unroll
    for (int o = 1; o < 64; o <<= 1) { const float t = __shfl_up(v, o); if (lane >= o) v = fmaxf(v, t); }
    return v;
}
__device__ __forceinline__ float wave_max(float v) {
#pragma unroll
    for (int o = 32; o >= 1; o >>= 1) v = fmaxf(v, __shfl_xor(v, o));
    return v;
}
__device__ __forceinline__ void unpack8h(const u32x4 w, bf16_t (&h)[8]) {
    h[0] = (bf16_t)(w.x & 0xFFFFu); h[1] = (bf16_t)(w.x >> 16); h[2] = (bf16_t)(w.y & 0xFFFFu); h[3] = (bf16_t)(w.y >> 16);
    h[4] = (bf16_t)(w.z & 0xFFFFu); h[5] = (bf16_t)(w.z >> 16); h[6] = (bf16_t)(w.w & 0xFFFFu); h[7] = (bf16_t)(w.w >> 16);
}

__device__ __forceinline__ int tokblock_of(int b, int dir, int c) { if (c < 4) return 256 + b * 4 + (dir ? 3 - c : c); const int j = c - 4; return b * 64 + (dir ? 63 - j : j); }
__device__ __forceinline__ u32x4 rev8h(const u32x4 v) { u32x4 r; r.x = (v.w >> 16) | (v.w << 16); r.y = (v.z >> 16) | (v.z << 16); r.z = (v.y >> 16) | (v.y << 16); r.w = (v.x >> 16) | (v.x << 16); return r; }
__device__ __forceinline__ u32x4 scale8h(const u32x4 v, const float4 a, const float4 b) { float f[8]; unpack8(v, f); u32x4 r; r.x = pk2(f[0] * a.x, f[1] * a.y); r.y = pk2(f[2] * a.z, f[3] * a.w); r.z = pk2(f[4] * b.x, f[5] * b.y); r.w = pk2(f[6] * b.z, f[7] * b.w); return r; }
__device__ __forceinline__ float dot8h(const u32x4 v, const float4 a, const float4 b) { float f[8]; unpack8(v, f); return (f[0] * a.x + f[1] * a.y) + (f[2] * a.z + f[3] * a.w) + (f[4] * b.x + f[5] * b.y) + (f[6] * b.z + f[7] * b.w); }
#define ML_FRAG_LOAD(KF, VF, cc_) do { const int tb_ = tokblock_of(b, dir, (cc_)); const bf16_t* kb_ = KTg + ((size_t)tb_ * 512 + h * 128 + 32 * wd + r16) * 64 + q4 * 8; const bf16_t* vb_ = VTg + ((size_t)tb_ * 512 + h * 128 + 64 * half + 32 * we + r16) * 64 + q4 * 8; \
        _Pragma("unroll") for (int ks_ = 0; ks_ < 2; ++ks_) _Pragma("unroll") for (int j_ = 0; j_ < 2; ++j_) { VF[j_][ks_] = *(const u32x4*)(vb_ + (size_t)j_ * 16 * 64 + ks_ * 32); KF[j_][ks_] = *(const u32x4*)(kb_ + (size_t)j_ * 16 * 64 + ks_ * 32); } } while (0)
#define ML_CHUNK(c_, KF, VF, KFN, VFN) do { const int c = (c_); \
        if (c + 1 < 68) ML_FRAG_LOAD(KFN, VFN, c + 1);                        \
        const float dec = sDEC[c]; \
        {   bf16_t* cs = CST + (size_t)(chain * 68 + c) * 128 * 128; \
            _Pragma("unroll") for (int je = 0; je < 2; ++je) _Pragma("unroll") for (int jd = 0; jd < 2; ++jd) { const int e = 64 * half + 32 * we + 16 * je + r16, d0 = 32 * wd + 16 * jd + q4 * 4; \
                u32x2 pk; pk.x = pk2(acc[je][jd][0], acc[je][jd][1]); pk.y = pk2(acc[je][jd][2], acc[je][jd][3]); *(u32x2*)(cs + (size_t)e * 128 + d0) = pk; } \
            if (nown) { _Pragma("unroll") for (int jd = 0; jd < 2; ++jd) { float nv = npart[jd]; nv += __shfl_xor(nv, 16); nv += __shfl_xor(nv, 32); if (q4 == 0) NST[(size_t)(chain * 68 + c) * 128 + 32 * wd + 16 * jd + r16] = nv; } } } \
        bf16x8 vfr[2][2]; \
        _Pragma("unroll") for (int ks = 0; ks < 2; ++ks) { const float4 wa = *(const float4*)(sWS + c * 64 + ks * 32 + q4 * 8), wb = *(const float4*)(sWS + c * 64 + ks * 32 + q4 * 8 + 4); \
            _Pragma("unroll") for (int je = 0; je < 2; ++je) { const u32x4 sv = scale8h(VF[je][ks], wa, wb); vfr[je][ks] = *(const bf16x8*)&sv; } \
            if (nown) { _Pragma("unroll") for (int jd = 0; jd < 2; ++jd) npart[jd] = (ks == 0 ? dec * npart[jd] : npart[jd]) + dot8h(KF[jd][ks], wa, wb); } } \
        _Pragma("unroll") for (int je = 0; je < 2; ++je) _Pragma("unroll") for (int jd = 0; jd < 2; ++jd) acc[je][jd] = acc[je][jd] * dec; \
        _Pragma("unroll") for (int ks = 0; ks < 2; ++ks) _Pragma("unroll") for (int je = 0; je < 2; ++je) _Pragma("unroll") for (int jd = 0; jd < 2; ++jd) \
            acc[je][jd] = __builtin_amdgcn_mfma_f32_16x16x32_bf16(*(const bf16x8*)&KF[jd][ks], vfr[je][ks], acc[je][jd], 0, 0, 0); } while (0)
__device__ __forceinline__ void mlstm_state_pass(const int chain, const int half, const bf16_t* __restrict__ Pm, const bf16_t* __restrict__ KTg, const bf16_t* __restrict__ VTg, const float* __restrict__ gate_b,
                                                 bf16_t* __restrict__ CST, float* __restrict__ NST, float* __restrict__ MST, unsigned char* shm, const int tid) {
    const int dir = chain & 1, h = (chain >> 1) & 3, b = chain >> 3, lane = tid & 63, w = tid >> 6, we = w >> 2, wd = w & 3, q4 = lane >> 4, r16 = lane & 15;
    const bool nown = (half == 0) && (we == 0);
    float* sE = (float*)shm; float* sWS = sE + 68 * 64; float* sAL = sWS + 68 * 64; float* sBE = sAL + 68; float* sMO = sBE + 68; float* sDEC = sMO + 68; float* sMB = sDEC + 68;
    const float gbi = gate_b[(dir * 2 + 0) * 4 + h], gbf = gate_b[(dir * 2 + 1) * 4 + h];
    const int gcol_i = ML_OFF + 2048 + (dir * 2 + 0) * 4 + h, gcol_f = ML_OFF + 2048 + (dir * 2 + 1) * 4 + h;
    u32x4 kfA[2][2], vfA[2][2], kfB[2][2], vfB[2][2];
    ML_FRAG_LOAD(kfA, vfA, 0);
    __syncthreads();
    unsigned gi_[9], gf_[9];
#pragma unroll
    for (int q = 0; q < 9; ++q) { const int c = min(w + 8 * q, 67); const size_t tokl = (size_t)step_tok(b, dir, c * 64 + lane); gi_[q] = Pm[tokl * LDP + gcol_i]; gf_[q] = Pm[tokl * LDP + gcol_f]; }
#pragma unroll
    for (int q = 0; q < 9; ++q) { const int c = w + 8 * q; if (c >= 68) break;
        const float ig = __uint_as_float(gi_[q] << 16) + gbi, fg = __uint_as_float(gf_[q] << 16) + gbf;
        const float lf = fminf(fg, 0.f) - log1pf(expf(-fabsf(fg)));
        const float bcs = wave_scan_incl(lf, lane); const float blast = __shfl(bcs, 63); const float ei = blast - bcs + ig; const float beta = wave_max(ei);
        sE[c * 64 + lane] = ei; if (lane == 0) { sAL[c] = blast; sBE[c] = beta; } }
    __syncthreads();
    if (tid == 0) { float m = 0.f; for (int c = 0; c < 68; ++c) { sMB[c] = m; const float mo = fmaxf(m + sAL[c], sBE[c]); sDEC[c] = expf(sAL[c] + m - mo); sMO[c] = mo; m = mo; } }
    __syncthreads();
    for (int idx = tid; idx < 68 * 64; idx += NTHR) { const int c = idx >> 6, i = idx & 63; sWS[c * 64 + (dir ? 63 - i : i)] = expf(sE[idx] - sMO[c]); }
    if (half == 0 && tid < 68) MST[chain * 68 + tid] = sMB[tid];
    __syncthreads();
    f32x4 acc[2][2];
#pragma unroll
    for (int je = 0; je < 2; ++je)
#pragma unroll
        for (int jd = 0; jd < 2; ++jd) acc[je][jd] = (f32x4){0.f, 0.f, 0.f, 0.f};
    float npart[2] = {0.f, 0.f};
    for (int c2 = 0; c2 < 68; c2 += 2) { ML_CHUNK(c2, kfA, vfA, kfB, vfB); ML_CHUNK(c2 + 1, kfB, vfB, kfA, vfA); }
    __syncthreads();
}
#undef ML_CHUNK
#undef ML_FRAG_LOAD
__device__ __forceinline__ void mlstm_out_item(const int chain, const int c, const bf16_t* __restrict__ Pm, const bf16_t* __restrict__ QKb, const bf16_t* __restrict__ VTg, const float* __restrict__ gate_b,
                                               const bf16_t* __restrict__ CST, const float* __restrict__ NST, const float* __restrict__ MST, bf16_t* __restrict__ Hout, unsigned char* shm, const int tid) {
    const int dir = chain & 1, h = (chain >> 1) & 3, b = chain >> 3, lane = tid & 63, w = tid >> 6;
    bf16_t* Qs = (bf16_t*)shm; bf16_t* Ks = (bf16_t*)(shm + 17408); bf16_t* VT = (bf16_t*)(shm + 34816); bf16_t* Cs = (bf16_t*)(shm + 53248); bf16_t* Ss = (bf16_t*)(shm + 88064);
    float* sc = (float*)(shm + 97280);
    __syncthreads();
    u32x4 gq[2], gk[2], gv[2], gc[4]; float gn = 0.f;
#pragma unroll
    for (int i = 0; i < 2; ++i) { const int pid = tid + i * 512; const int s = pid >> 4, x0 = (pid & 15) * 8; const size_t toks = (size_t)step_tok(b, dir, c * 64 + s);
        gq[i] = *(const u32x4*)(QKb + toks * 1024 + h * 128 + x0);
        gk[i] = *(const u32x4*)(QKb + toks * 1024 + 512 + h * 128 + x0);
        { const int e = pid >> 3, o = pid & 7;
          gv[i] = *(const u32x4*)(VTg + ((size_t)tokblock_of(b, dir, c) * 512 + h * 128 + e) * 64 + (dir ? 7 - o : o) * 8); } }
#pragma unroll
    for (int i = 0; i < 4; ++i) { const int pid = tid + i * 512; const int e = pid >> 4, x0 = (pid & 15) * 8;
        gc[i] = *(const u32x4*)(CST + ((size_t)(chain * 68 + c) * 128 + e) * 128 + x0); }
    if (tid < 128) gn = NST[(size_t)(chain * 68 + c) * 128 + tid];
    unsigned gi_ = 0u, gf_ = 0u; float gbi = 0.f, gbf = 0.f, m_in = 0.f;
    if (w == 0) { const size_t tokl = (size_t)step_tok(b, dir, c * 64 + lane);
        gi_ = Pm[tokl * LDP + ML_OFF + 2048 + (dir * 2 + 0) * 4 + h]; gf_ = Pm[tokl * LDP + ML_OFF + 2048 + (dir * 2 + 1) * 4 + h];
        gbi = gate_b[(dir * 2 + 0) * 4 + h]; gbf = gate_b[(dir * 2 + 1) * 4 + h]; m_in = MST[chain * 68 + c]; }
#pragma unroll
    for (int i = 0; i < 2; ++i) { const int pid = tid + i * 512; const int s = pid >> 4, x0 = (pid & 15) * 8;
        *(u32x4*)(Qs + s * 136 + x0) = gq[i]; *(u32x4*)(Ks + s * 136 + x0) = gk[i];
        { const int e = pid >> 3, o = pid & 7; *(u32x4*)(VT + e * 72 + o * 8) = dir ? rev8h(gv[i]) : gv[i]; } }
#pragma unroll
    for (int i = 0; i < 4; ++i) { const int pid = tid + i * 512; const int e = pid >> 4, x0 = (pid & 15) * 8; *(u32x4*)(Cs + e * 136 + x0) = gc[i]; }
    if (tid < 128) sc[384 + tid] = gn;
    if (w == 0) {
        const float ig = __uint_as_float(gi_ << 16) + gbi;
        const float fg = __uint_as_float(gf_ << 16) + gbf;
        const float lf = fminf(fg, 0.f) - log1pf(expf(-fabsf(fg)));
        const float bcs = wave_scan_incl(lf, lane); const float gsv = ig - bcs; const float pm = wave_scanmax_incl(gsv, lane);
        const float mt = bcs + fmaxf(m_in, pm);
        sc[lane] = bcs; sc[64 + lane] = gsv; sc[128 + lane] = mt; sc[192 + lane] = expf(bcs + m_in - mt); sc[256 + lane] = expf(-mt);
    }
    __syncthreads();
    const int tt = w >> 1;
    {   f32x4 aS[2] = {(f32x4){0.f, 0.f, 0.f, 0.f}, (f32x4){0.f, 0.f, 0.f, 0.f}};
#pragma unroll
        for (int ks = 0; ks < 4; ++ks) { const bf16x8 af = *(const bf16x8*)(Qs + (16 * tt + (lane & 15)) * 136 + ks * 32 + (lane >> 4) * 8);
#pragma unroll
            for (int i = 0; i < 2; ++i) { const int st = (w & 1) * 2 + i; const bf16x8 bfr = *(const bf16x8*)(Ks + (16 * st + (lane & 15)) * 136 + ks * 32 + (lane >> 4) * 8);
                aS[i] = __builtin_amdgcn_mfma_f32_16x16x32_bf16(af, bfr, aS[i], 0, 0, 0); } }
        float rs[4] = {0.f, 0.f, 0.f, 0.f};
#pragma unroll
        for (int i = 0; i < 2; ++i) { const int s = 16 * ((w & 1) * 2 + i) + (lane & 15); const float gsv = sc[64 + s];
#pragma unroll
            for (int q = 0; q < 4; ++q) { const int t = 16 * tt + (lane >> 4) * 4 + q; const float val = (s <= t) ? aS[i][q] * expf(sc[t] + gsv - sc[128 + t]) : 0.f; Ss[t * 72 + s] = f2bf(val); rs[q] += val; } }
#pragma unroll
        for (int q = 0; q < 4; ++q) { float r = rs[q]; r += __shfl_xor(r, 1); r += __shfl_xor(r, 2); r += __shfl_xor(r, 4); r += __shfl_xor(r, 8);
            if ((lane & 15) == 0) sc[512 + (w & 1) * 64 + 16 * tt + (lane >> 4) * 4 + q] = r; }
        {   const int t = tid >> 3, part = tid & 7; float dot = 0.f;
#pragma unroll
            for (int j = 0; j < 16; ++j) dot += bf2f(Qs[t * 136 + part * 16 + j]) * sc[384 + part * 16 + j];
            dot += __shfl_xor(dot, 1); dot += __shfl_xor(dot, 2); dot += __shfl_xor(dot, 4);
            if (part == 0) sc[640 + t] = sc[192 + t] * dot; }
    }
    __syncthreads();
    {   f32x4 aN[4];
#pragma unroll
        for (int i = 0; i < 4; ++i) aN[i] = (f32x4){0.f, 0.f, 0.f, 0.f};
#pragma unroll
        for (int ks = 0; ks < 4; ++ks) { const bf16x8 af = *(const bf16x8*)(Qs + (16 * tt + (lane & 15)) * 136 + ks * 32 + (lane >> 4) * 8);
#pragma unroll
            for (int i = 0; i < 4; ++i) { const int et = (w & 1) * 4 + i; const bf16x8 bfr = *(const bf16x8*)(Cs + (16 * et + (lane & 15)) * 136 + ks * 32 + (lane >> 4) * 8);
                aN[i] = __builtin_amdgcn_mfma_f32_16x16x32_bf16(bfr, af, aN[i], 0, 0, 0); } }
        const int t = 16 * tt + (lane & 15);
        {   const float it = sc[192 + t];
#pragma unroll
            for (int i = 0; i < 4; ++i) { aN[i][0] *= it; aN[i][1] *= it; aN[i][2] *= it; aN[i][3] *= it; } }
#pragma unroll
        for (int ks = 0; ks < 2; ++ks) { const bf16x8 af = *(const bf16x8*)(Ss + (16 * tt + (lane & 15)) * 72 + ks * 32 + (lane >> 4) * 8);
#pragma unroll
            for (int i = 0; i < 4; ++i) { const int et = (w & 1) * 4 + i; const bf16x8 bfr = *(const bf16x8*)(VT + (16 * et + (lane & 15)) * 72 + ks * 32 + (lane >> 4) * 8);
                aN[i] = __builtin_amdgcn_mfma_f32_16x16x32_bf16(bfr, af, aN[i], 0, 0, 0); } }
        {   const size_t tokt = (size_t)step_tok(b, dir, c * 64 + t); const float dn = fmaxf(fabsf((sc[512 + t] + sc[576 + t]) + sc[640 + t]), sc[256 + t]);
#pragma unroll
            for (int i = 0; i < 4; ++i) { const int e0 = 16 * ((w & 1) * 4 + i) + (lane >> 4) * 4;
                u32x2 wv; wv.x = pk2(aN[i][0] / dn, aN[i][1] / dn); wv.y = pk2(aN[i][2] / dn, aN[i][3] / dn);
                *(u32x2*)(Hout + tokt * BW + h * 128 + e0) = wv; } }
    }
}


#define SD_FRAG_LOAD(BF, XF, cc_) do { const int tb_ = tokblock_of(b, dir, (cc_)); const bf16_t* bb_ = BTg + ((size_t)tb_ * 256 + grp * 128 + 64 * (w >> 2) + r16) * 64 + q4 * 8; const bf16_t* xb_ = XTg + ((size_t)tb_ * 512 + h * 64 + 16 * (w & 3) + r16) * 64 + q4 * 8; \
        _Pragma("unroll") for (int ks_ = 0; ks_ < 2; ++ks_) { XF[ks_] = *(const u32x4*)(xb_ + ks_ * 32); _Pragma("unroll") for (int j_ = 0; j_ < 4; ++j_) BF[j_][ks_] = *(const u32x4*)(bb_ + (size_t)j_ * 16 * 64 + ks_ * 32); } } while (0)
#define SD_CHUNK(c_, BF, XF, BFN, XFN) do { const int c = (c_); \
        if (c + 1 < 68) SD_FRAG_LOAD(BFN, XFN, c + 1); \
        const float dec = sDEC[c]; \
        {   bf16_t* ss = SSTb + (size_t)(chain * 68 + c) * 64 * 128; const int p = 16 * (w & 3) + r16; \
            _Pragma("unroll") for (int j = 0; j < 4; ++j) { const int n0 = 16 * ((w >> 2) * 4 + j) + q4 * 4; u32x2 pk; pk.x = pk2(acc[j][0], acc[j][1]); pk.y = pk2(acc[j][2], acc[j][3]); *(u32x2*)(ss + (size_t)p * 128 + n0) = pk; } } \
        bf16x8 xfr[2]; \
        _Pragma("unroll") for (int ks = 0; ks < 2; ++ks) { const float4 wa = *(const float4*)(sSC + c * 64 + ks * 32 + q4 * 8), wb = *(const float4*)(sSC + c * 64 + ks * 32 + q4 * 8 + 4); const u32x4 sv = scale8h(XF[ks], wa, wb); xfr[ks] = *(const bf16x8*)&sv; } \
        _Pragma("unroll") for (int j = 0; j < 4; ++j) acc[j] = acc[j] * dec; \
        _Pragma("unroll") for (int ks = 0; ks < 2; ++ks) _Pragma("unroll") for (int j = 0; j < 4; ++j) acc[j] = __builtin_amdgcn_mfma_f32_16x16x32_bf16(*(const bf16x8*)&BF[j][ks], xfr[ks], acc[j], 0, 0, 0); } while (0)
__device__ __forceinline__ void ssd_state_pass(const int chain, const bf16_t* __restrict__ Pm, const bf16_t* __restrict__ BTg, const bf16_t* __restrict__ XTg, const float Aa, const float dtb,
                                               bf16_t* __restrict__ SSTb, unsigned char* shm, const int tid) {
    const int dir = chain & 1, h = (chain >> 1) & 7, b = chain >> 4, grp = h >> 2, lane = tid & 63, w = tid >> 6, q4 = lane >> 4, r16 = lane & 15;
    float* sSC = (float*)shm; float* sDEC = sSC + 68 * 64;
    const int dcol = SSD_OFF + 1536 + dir * 8 + h;
    u32x4 bfA[4][2], xfA[2], bfB[4][2], xfB[2];
    SD_FRAG_LOAD(bfA, xfA, 0);
    __syncthreads();
    unsigned dt_[9];
#pragma unroll
    for (int q = 0; q < 9; ++q) { const int c = min(w + 8 * q, 67); dt_[q] = Pm[(size_t)step_tok(b, dir, c * 64 + lane) * LDP + dcol]; }
#pragma unroll
    for (int q = 0; q < 9; ++q) { const int c = w + 8 * q; if (c >= 68) break;
        const float xv = __uint_as_float(dt_[q] << 16) + dtb; const float dtv = xv > 20.f ? xv : log1pf(expf(xv));
        const float cs = wave_scan_incl(dtv * Aa, lane); const float cl = __shfl(cs, 63);
        sSC[c * 64 + (dir ? 63 - lane : lane)] = dtv * expf(cl - cs); if (lane == 0) sDEC[c] = expf(cl); }
    __syncthreads();
    f32x4 acc[4];
#pragma unroll
    for (int j = 0; j < 4; ++j) acc[j] = (f32x4){0.f, 0.f, 0.f, 0.f};
    for (int c2 = 0; c2 < 68; c2 += 2) { SD_CHUNK(c2, bfA, xfA, bfB, xfB); SD_CHUNK(c2 + 1, bfB, xfB, bfA, xfA); }
    __syncthreads();
}
#undef SD_CHUNK
#undef SD_FRAG_LOAD
__device__ __forceinline__ void ssd_out_item(const int chain, const int c, const bf16_t* __restrict__ Pm, const bf16_t* __restrict__ XBb, const bf16_t* __restrict__ XTg, const float Aa, const float dtb,
                                             const bf16_t* __restrict__ SSTb, bf16_t* __restrict__ Yout, unsigned char* shm, const int tid) {
    const int dir = chain & 1, h = (chain >> 1) & 7, b = chain >> 4, grp = h >> 2, lane = tid & 63, w = tid >> 6;
    bf16_t* Cs = (bf16_t*)shm; bf16_t* Bs = (bf16_t*)(shm + 17408); bf16_t* XT = (bf16_t*)(shm + 34816); bf16_t* Sin = (bf16_t*)(shm + 44032); bf16_t* Gs = (bf16_t*)(shm + 61440);
    float* sc = (float*)(shm + 70656);
    __syncthreads();
    u32x4 gb[2], gcc[2], gs[2], gx; unsigned gd_ = 0u;
#pragma unroll
    for (int i = 0; i < 2; ++i) { const int pid = tid + i * 512; const int s = pid >> 4, x0 = (pid & 15) * 8; const size_t toks = (size_t)step_tok(b, dir, c * 64 + s);
        gb[i] = *(const u32x4*)(XBb + toks * 1024 + 512 + grp * 128 + x0);
        gcc[i] = *(const u32x4*)(XBb + toks * 1024 + 768 + grp * 128 + x0);
        const int p = pid >> 4;
        gs[i] = *(const u32x4*)(SSTb + ((size_t)(chain * 68 + c) * 64 + p) * 128 + x0); }
    {   const int p = tid >> 3, o = tid & 7;
        gx = *(const u32x4*)(XTg + ((size_t)tokblock_of(b, dir, c) * 512 + h * 64 + p) * 64 + (dir ? 7 - o : o) * 8); }
    if (w == 0) gd_ = Pm[(size_t)step_tok(b, dir, c * 64 + lane) * LDP + SSD_OFF + 1536 + dir * 8 + h];
#pragma unroll
    for (int i = 0; i < 2; ++i) { const int pid = tid + i * 512; const int s = pid >> 4, x0 = (pid & 15) * 8;
        *(u32x4*)(Bs + s * 136 + x0) = gb[i]; *(u32x4*)(Cs + s * 136 + x0) = gcc[i]; *(u32x4*)(Sin + s * 136 + x0) = gs[i]; }
    {   const int p = tid >> 3, o = tid & 7; *(u32x4*)(XT + p * 72 + o * 8) = dir ? rev8h(gx) : gx; }
    if (w == 0) {
        const float xv = __uint_as_float(gd_ << 16) + dtb; const float dtv = xv > 20.f ? xv : log1pf(expf(xv));
        sc[lane] = wave_scan_incl(dtv * Aa, lane); sc[64 + lane] = dtv; }
    __syncthreads();
    {   const int lt = w >> 1;
        f32x4 aG[2] = {(f32x4){0.f, 0.f, 0.f, 0.f}, (f32x4){0.f, 0.f, 0.f, 0.f}};
#pragma unroll
        for (int ks = 0; ks < 4; ++ks) { const bf16x8 af = *(const bf16x8*)(Cs + (16 * lt + (lane & 15)) * 136 + ks * 32 + (lane >> 4) * 8);
#pragma unroll
            for (int i = 0; i < 2; ++i) { const int st = (w & 1) * 2 + i; const bf16x8 bfr = *(const bf16x8*)(Bs + (16 * st + (lane & 15)) * 136 + ks * 32 + (lane >> 4) * 8);
                aG[i] = __builtin_amdgcn_mfma_f32_16x16x32_bf16(af, bfr, aG[i], 0, 0, 0); } }
#pragma unroll
        for (int i = 0; i < 2; ++i) { const int s = 16 * ((w & 1) * 2 + i) + (lane & 15); const float css = sc[s], dts = sc[64 + s];
#pragma unroll
            for (int q = 0; q < 4; ++q) { const int t = 16 * lt + (lane >> 4) * 4 + q; const float val = (s <= t) ? aG[i][q] * expf(sc[t] - css) * dts : 0.f; Gs[t * 72 + s] = f2bf(val); } }
    }
    __syncthreads();
    {   const int lt = w >> 1;
        f32x4 aY[2] = {(f32x4){0.f, 0.f, 0.f, 0.f}, (f32x4){0.f, 0.f, 0.f, 0.f}};
#pragma unroll
        for (int ks = 0; ks < 4; ++ks) { const bf16x8 af = *(const bf16x8*)(Cs + (16 * lt + (lane & 15)) * 136 + ks * 32 + (lane >> 4) * 8);
#pragma unroll
            for (int i = 0; i < 2; ++i) { const int pt = (w & 1) * 2 + i; const bf16x8 bfr = *(const bf16x8*)(Sin + (16 * pt + (lane & 15)) * 136 + ks * 32 + (lane >> 4) * 8);
                aY[i] = __builtin_amdgcn_mfma_f32_16x16x32_bf16(bfr, af, aY[i], 0, 0, 0); } }
        const int t = 16 * lt + (lane & 15);
        {   const float ec = expf(sc[t]);
#pragma unroll
            for (int i = 0; i < 2; ++i) { aY[i][0] *= ec; aY[i][1] *= ec; aY[i][2] *= ec; aY[i][3] *= ec; } }
#pragma unroll
        for (int ks = 0; ks < 2; ++ks) { const bf16x8 af = *(const bf16x8*)(Gs + (16 * lt + (lane & 15)) * 72 + ks * 32 + (lane >> 4) * 8);
#pragma unroll
            for (int i = 0; i < 2; ++i) { const int pt = (w & 1) * 2 + i; const bf16x8 bfr = *(const bf16x8*)(XT + (16 * pt + (lane & 15)) * 72 + ks * 32 + (lane >> 4) * 8);
                aY[i] = __builtin_amdgcn_mfma_f32_16x16x32_bf16(bfr, af, aY[i], 0, 0, 0); } }
        {   const size_t tokt = (size_t)step_tok(b, dir, c * 64 + t);
#pragma unroll
            for (int i = 0; i < 2; ++i) { const int p0 = 16 * ((w & 1) * 2 + i) + (lane >> 4) * 4;
                u32x2 wv; wv.x = pk2(aY[i][0], aY[i][1]); wv.y = pk2(aY[i][2], aY[i][3]);
                *(u32x2*)(Yout + tokt * BW + h * 64 + p0) = wv; } }
    }
}


#define FIDX(i) ((i) + ((i) >> 4))
#define FFT_X_BYTES 69632
__device__ constexpr float FFT_CW_RE[6][16] = {{0.f, 0.f, 0.f, 0.f, 0.f, 0.f, 0.f, 0.f, 0.f, 0.f, 0.f, 0.f, 0.f, 0.f, 0.f, 0.f}, {1.0f, 0.f, 0.f, 0.f, 0.f, 0.f, 0.f, 0.f, 0.f, 0.f, 0.f, 0.f, 0.f, 0.f, 0.f, 0.f}, {1.0f, 6.123233995736766e-17f, 0.f, 0.f, 0.f, 0.f, 0.f, 0.f, 0.f, 0.f, 0.f, 0.f, 0.f, 0.f, 0.f, 0.f}, {1.0f, 0.7071067811865476f, 6.123233995736766e-17f, -0.7071067811865475f, 0.f, 0.f, 0.f, 0.f, 0.f, 0.f, 0.f, 0.f, 0.f, 0.f, 0.f, 0.f}, {1.0f, 0.9238795325112867f, 0.7071067811865476f, 0.38268343236508984f, 6.123233995736766e-17f, -0.3826834323650897f, -0.7071067811865475f, -0.9238795325112867f, 0.f, 0.f, 0.f, 0.f, 0.f, 0.f, 0.f, 0.f}, {1.0f, 0.9807852804032304f, 0.9238795325112867f, 0.8314696123025452f, 0.7071067811865476f, 0.5555702330196023f, 0.38268343236508984f, 0.19509032201612833f, 6.123233995736766e-17f, -0.1950903220161282f, -0.3826834323650897f, -0.555570233019602f, -0.7071067811865475f, -0.8314696123025453f, -0.9238795325112867f, -0.9807852804032304f}};
__device__ constexpr float FFT_CW_IM[6][16] = {{0.f, 0.f, 0.f, 0.f, 0.f, 0.f, 0.f, 0.f, 0.f, 0.f, 0.f, 0.f, 0.f, 0.f, 0.f, 0.f}, {-0.0f, 0.f, 0.f, 0.f, 0.f, 0.f, 0.f, 0.f, 0.f, 0.f, 0.f, 0.f, 0.f, 0.f, 0.f, 0.f}, {-0.0f, -1.0f, 0.f, 0.f, 0.f, 0.f, 0.f, 0.f, 0.f, 0.f, 0.f, 0.f, 0.f, 0.f, 0.f, 0.f}, {-0.0f, -0.7071067811865475f, -1.0f, -0.7071067811865476f, 0.f, 0.f, 0.f, 0.f, 0.f, 0.f, 0.f, 0.f, 0.f, 0.f, 0.f, 0.f}, {-0.0f, -0.3826834323650898f, -0.7071067811865475f, -0.9238795325112867f, -1.0f, -0.9238795325112867f, -0.7071067811865476f, -0.3826834323650899f, 0.f, 0.f, 0.f, 0.f, 0.f, 0.f, 0.f, 0.f}, {-0.0f, -0.19509032201612825f, -0.3826834323650898f, -0.5555702330196022f, -0.7071067811865475f, -0.8314696123025452f, -0.9238795325112867f, -0.9807852804032304f, -1.0f, -0.9807852804032304f, -0.9238795325112867f, -0.8314696123025455f, -0.7071067811865476f, -0.5555702330196022f, -0.3826834323650899f, -0.1950903220161286f}};
__host__ __device__ constexpr int fft_bitrev(int k, int R) { int r = 0; for (int i = 0; i < R; ++i) if (k & (1 << i)) r |= 1 << (R - 1 - i); return r; }
template <int R, bool INV>
__device__ __forceinline__ void fft_pass(float2* __restrict__ X, const float2* __restrict__ TW, const int s0, const int gidx) {
    const int lowbits = 13 - s0 - R; const int stride = 1 << lowbits;
    const int low = gidx & (stride - 1), high = gidx >> lowbits; const int base = (high << (lowbits + R)) | low;
    const int p0 = FIDX(base);
#define FFT_SLOT(k) (lowbits >= 4 ? p0 + (k) * (stride + (stride >> 4)) : p0 + (k) + ((k) >> 4))
    float2 v[1 << R];
#pragma unroll
    for (int k = 0; k < (1 << R); ++k) v[k] = X[FFT_SLOT(k)];
    const int lw = low << s0;
    if (!INV) {
#pragma unroll
        for (int j = 0; j < R; ++j) { const int hk = 1 << (R - 1 - j);
#pragma unroll
            for (int k = 0; k < (1 << R); ++k) if (!(k & hk)) { const int kk = k & (hk - 1);
                const float2 a = v[k], b = v[k + hk]; v[k] = make_float2(a.x + b.x, a.y + b.y); const float dx = a.x - b.x, dy = a.y - b.y;
                if (kk == 0) v[k + hk] = make_float2(dx, dy);
                else if (2 * kk == hk) v[k + hk] = make_float2(dy, -dx);
                else { const float cr = FFT_CW_RE[R - j][kk], ci = FFT_CW_IM[R - j][kk]; v[k + hk] = make_float2(dx * cr - dy * ci, dx * ci + dy * cr); } } }
        if (lowbits > 0) {
#pragma unroll
            for (int k = 1; k < (1 << R); ++k) { const float2 w = TW[(lw * fft_bitrev(k, R)) & 8191]; const float2 a = v[k]; v[k] = make_float2(a.x * w.x - a.y * w.y, a.x * w.y + a.y * w.x); } }
    } else {
        if (lowbits > 0) {
#pragma unroll
            for (int k = 1; k < (1 << R); ++k) { const float2 w = TW[(lw * fft_bitrev(k, R)) & 8191]; const float2 a = v[k]; v[k] = make_float2(a.x * w.x + a.y * w.y, a.y * w.x - a.x * w.y); } }
#pragma unroll
        for (int j = R - 1; j >= 0; --j) { const int hk = 1 << (R - 1 - j);
#pragma unroll
            for (int k = 0; k < (1 << R); ++k) if (!(k & hk)) { const int kk = k & (hk - 1);
                const float2 a = v[k], b = v[k + hk]; float tx, ty;
                if (kk == 0) { tx = b.x; ty = b.y; }
                else if (2 * kk == hk) { tx = -b.y; ty = b.x; }
                else { const float cr = FFT_CW_RE[R - j][kk], ci = FFT_CW_IM[R - j][kk]; tx = b.x * cr + b.y * ci; ty = b.y * cr - b.x * ci; }
                v[k] = make_float2(a.x + tx, a.y + ty); v[k + hk] = make_float2(a.x - tx, a.y - ty); } }
    }
#pragma unroll
    for (int k = 0; k < (1 << R); ++k) X[FFT_SLOT(k)] = v[k];
#undef FFT_SLOT
}
__device__ __forceinline__ void fft_fwd(float2* X, const float2* TW, const int tid) {
    fft_pass<4, false>(X, TW, 0, tid); __syncthreads(); fft_pass<4, false>(X, TW, 4, tid); __syncthreads(); if (tid < 256) fft_pass<5, false>(X, TW, 8, tid); __syncthreads(); }
__device__ __forceinline__ void fft_inv(float2* X, const float2* TW, const int tid) {
    if (tid < 256) fft_pass<5, true>(X, TW, 8, tid); __syncthreads(); fft_pass<4, true>(X, TW, 4, tid); __syncthreads(); fft_pass<4, true>(X, TW, 0, tid); __syncthreads(); }
__device__ __forceinline__ void fft_twiddles(float2* TW, const int tid) {
#pragma unroll
    for (int k = 0; k < 16; ++k) { const int m = tid + k * 512; const float xx = (float)m * (1.0f / 4096.0f); TW[m] = make_float2(cospif(xx), -sinpif(xx)); }
}
__device__ __forceinline__ void hyena_spec_item(const int pr, const float* __restrict__ HR, const float* __restrict__ nrm, float2* __restrict__ HSPEC, unsigned char* shm, const int tid) {
    float2* X = (float2*)shm; const float2* TW = (const float2*)(shm + FFT_X_BYTES);
    const int o = pr >> 8, c = (pr & 255) * 2, oc = o * 512 + c; const float inva = 1.0f / nrm[oc], invb = 1.0f / nrm[oc + 1];
    __syncthreads();
    float2 hv[16];
#pragma unroll
    for (int k = 0; k < 16; ++k) { const int j = tid + k * 512;
        const unsigned off = j < SEQ ? (unsigned)j * 2048u + o * 1024 + c : j == SEQ ? (unsigned)(o * 1024 + c) : (unsigned)(2 * SEQ - j) * 2048u + o * 1024 + 512 + c;
        hv[k] = *(const float2*)(HR + off); }
#pragma unroll
    for (int k = 0; k < 16; ++k) { const int j = tid + k * 512; X[FIDX(j)] = j == SEQ ? make_float2(0.f, 0.f) : make_float2(hv[k].x * inva, hv[k].y * invb); }
    __syncthreads();
    fft_fwd(X, TW, tid);
    float4* outa = (float4*)(HSPEC + (size_t)oc * 8192 + tid * 16); float4* outb = (float4*)(HSPEC + (size_t)(oc + 1) * 8192 + tid * 16); const float2* xs = X + 17 * tid;
    const float sc_ = 0.5f / 8192.0f;
#pragma unroll
    for (int k = 0; k < 8; ++k) { float2 ha[2], hb[2];
#pragma unroll
        for (int q = 0; q < 2; ++q) { const int p = 16 * tid + 2 * k + q; const int kf = (int)(__builtin_bitreverse32((unsigned)p) >> 19); const int p2 = (int)(__builtin_bitreverse32((unsigned)((8192 - kf) & 8191)) >> 19);
            const float2 xp = xs[2 * k + q], xq = X[FIDX(p2)];
            ha[q] = make_float2((xp.x + xq.x) * sc_, (xp.y - xq.y) * sc_);
            hb[q] = make_float2((xp.y + xq.y) * sc_, (xq.x - xp.x) * sc_); }
        outa[k] = make_float4(ha[0].x, ha[0].y, ha[1].x, ha[1].y); outb[k] = make_float4(hb[0].x, hb[0].y, hb[1].x, hb[1].y); }
}
__device__ __forceinline__ void fft_mul_spec(float2* X, const float2* __restrict__ H, const int tid) {
    const float4* h4 = (const float4*)(H + tid * 16); float2* xs = X + 17 * tid;
#pragma unroll
    for (int k = 0; k < 8; ++k) { const float4 hv = h4[k]; const float2 x0 = xs[2 * k], x1 = xs[2 * k + 1];
        xs[2 * k] = make_float2(x0.x * hv.x - x0.y * hv.y, x0.x * hv.y + x0.y * hv.x); xs[2 * k + 1] = make_float2(x1.x * hv.z - x1.y * hv.w, x1.x * hv.w + x1.y * hv.z); }
}
__device__ __forceinline__ void hyena_fft_item(const int item, const bf16_t* __restrict__ UT, const float2* __restrict__ HSPEC, const float* __restrict__ bias, float* __restrict__ YT, unsigned char* shm, const int tid) {
    float2* X = (float2*)shm; const float2* TW = (const float2*)(shm + FFT_X_BYTES);
    const int c = item >> 1, b0 = (item & 1) * 2, b1 = b0 + 1;
    const bf16_t* u0 = UT + (size_t)(b0 * 1536 + c) * SEQ + tid * 8; const bf16_t* u1 = UT + (size_t)(b1 * 1536 + c) * SEQ + tid * 8;
    const float bias0 = bias[c], bias1 = bias[512 + c];
    float2* xs = X + FIDX(8 * tid);
    float vr[8], vi[8];
    __syncthreads();
    { const u32x4 a0 = *(const u32x4*)u0, c0 = *(const u32x4*)u1; unpack8(a0, vr); unpack8(c0, vi); }
#pragma unroll
    for (int k = 0; k < 8; ++k) { xs[k] = make_float2(vr[k], vi[k]); xs[4352 + k] = make_float2(0.f, 0.f); }
    __syncthreads();
    fft_fwd(X, TW, tid);
    fft_mul_spec(X, HSPEC + (size_t)c * 8192, tid);
    __syncthreads();
    fft_inv(X, TW, tid);
    { const bf16_t* p0 = u0 + (size_t)512 * SEQ; const bf16_t* p1 = u1 + (size_t)512 * SEQ;
      float xr[8], xi[8]; { const u32x4 a0 = *(const u32x4*)p0, c0 = *(const u32x4*)p1; unpack8(a0, xr); unpack8(c0, xi); }
#pragma unroll
      for (int k = 0; k < 8; ++k) { const float2 cv = xs[k]; const float zr = xr[k] * (cv.x + bias0 * vr[k]), zi = xi[k] * (cv.y + bias0 * vi[k]);
          vr[k] = zr; vi[k] = zi; xs[k] = make_float2(zr, zi); xs[4352 + k] = make_float2(0.f, 0.f); } }
    __syncthreads();
    fft_fwd(X, TW, tid);
    fft_mul_spec(X, HSPEC + (size_t)(512 + c) * 8192, tid);
    __syncthreads();
    fft_inv(X, TW, tid);
    { const bf16_t* p0 = u0 + (size_t)1024 * SEQ; const bf16_t* p1 = u1 + (size_t)1024 * SEQ;
      float xr[8], xi[8]; { const u32x4 a0 = *(const u32x4*)p0, c0 = *(const u32x4*)p1; unpack8(a0, xr); unpack8(c0, xi); }
      float yr[8], yi[8];
#pragma unroll
      for (int k = 0; k < 8; ++k) { const float2 cv = xs[k]; yr[k] = xr[k] * (cv.x + bias1 * vr[k]); yi[k] = xi[k] * (cv.y + bias1 * vi[k]); }
      float* y0 = YT + (size_t)(b0 * 512 + c) * SEQ + tid * 8; float* y1 = YT + (size_t)(b1 * 512 + c) * SEQ + tid * 8;
      *(float4*)y0 = make_float4(yr[0], yr[1], yr[2], yr[3]); *(float4*)(y0 + 4) = make_float4(yr[4], yr[5], yr[6], yr[7]);
      *(float4*)y1 = make_float4(yi[0], yi[1], yi[2], yi[3]); *(float4*)(y1 + 4) = make_float4(yi[4], yi[5], yi[6], yi[7]); }
}

constexpr size_t al256(size_t x) { return (x + 255) & ~(size_t)255; }
constexpr size_t O_BAR = 0;
constexpr size_t O_MOD = 16384;
constexpr size_t O_NORM = O_MOD + al256((size_t)2 * 5 * 6 * DM * 4);
constexpr size_t O_QCTR = O_NORM + al256((size_t)2 * 2 * 1024 * 4);
constexpr size_t O_ZERO_END = O_QCTR + 512;
constexpr size_t O_XS = O_ZERO_END;
constexpr size_t O_HB = O_XS + al256((size_t)NTOK * DM * 4);
constexpr size_t O_P = O_HB + al256((size_t)NTOK * DM * 2);
constexpr size_t O_WIN = O_P + al256((size_t)NTOK * LDP * 2);
constexpr size_t O_WBR = O_WIN + al256((size_t)LDP * DM * 2);
constexpr size_t O_WOUT = O_WBR + al256((size_t)4 * DM * BW * 2);
constexpr size_t O_WGU = O_WOUT + al256((size_t)DM * DM * 2);
constexpr size_t O_WD = O_WGU + al256((size_t)NEXP * 2 * DEXP * DM * 2);
constexpr size_t O_GLU = O_WD + al256((size_t)NEXP * DM * DEXP * 2);
constexpr size_t O_Y4 = O_GLU + al256((size_t)BW * BW * 2);
constexpr size_t O_U = O_Y4 + al256((size_t)NTOK * DM * 2);
constexpr size_t O_QKB = O_U + al256((size_t)NTOK * 1536 * 4);
constexpr size_t O_CST = O_QKB + al256((size_t)NTOK * 1024 * 2);
constexpr size_t O_NST = O_CST + al256((size_t)32 * 68 * 128 * 128 * 2);
constexpr size_t O_MST = O_NST + al256((size_t)32 * 68 * 128 * 4);
constexpr size_t O_XBC = O_MST + al256((size_t)32 * 68 * 4);
constexpr size_t O_SST = O_XBC + al256((size_t)NTOK * 1024 * 2);
constexpr size_t O_HF = O_SST + al256((size_t)64 * 68 * 64 * 128 * 2);
constexpr size_t O_YF = O_HF + al256((size_t)2 * NTOK * BW * 4);
constexpr size_t O_SF = O_YF + al256((size_t)2 * NTOK * BW * 4);
constexpr size_t O_LDT = O_SF + al256((size_t)2 * NCTX * BW * 4);
constexpr size_t O_AP = O_LDT + al256((size_t)4096 * 16);
constexpr size_t O_BBT = O_AP + al256((size_t)4096 * 33 * 8);
constexpr size_t O_KT = O_BBT + al256((size_t)4096 * 16 * 8);
constexpr size_t O_S5A = O_KT + al256((size_t)32 * 2 * 32 * 256 * 4);
constexpr size_t O_S5B = O_S5A + al256((size_t)32 * 512 * 768 * 2);
constexpr size_t O_XCTX = O_S5B + al256((size_t)32 * 512 * 768 * 2);
constexpr size_t O_Z = O_XCTX + al256((size_t)4 * 32 * 2 * 64 * 8);
constexpr size_t O_HRAW = O_Z + al256((size_t)NTOK * BW * 4);
constexpr size_t O_HSPEC = O_HRAW + al256((size_t)(SEQ + CTXL) * 2048 * 4);
constexpr size_t O_K2C = O_HSPEC + al256((size_t)1024 * 8192 * 8);
constexpr size_t O_GG = O_K2C + al256((size_t)(2 * CTXL) * 1024 * 4);
constexpr size_t O_PROBS = O_GG + al256((size_t)NTOK * BW * 2);
constexpr size_t O_ROWTOK = O_PROBS + al256((size_t)NTOK * 16 * 4);
constexpr size_t O_ROWGATE = O_ROWTOK + al256((size_t)NEXP * MOE_PAD * 4);
constexpr size_t O_INV = O_ROWGATE + al256((size_t)NEXP * MOE_PAD * 4);
constexpr size_t O_NORMP = O_INV + al256((size_t)NTOK * 16 * 4);
constexpr size_t WS_END = O_NORMP + al256((size_t)4 * 256 * 2048 * 4);
constexpr size_t O_XG = O_P;
constexpr size_t O_HID = O_P + al256((size_t)NEXP * MOE_PAD * DM * 2);
constexpr size_t O_YEXP = O_HID + al256((size_t)NEXP * MOE_PAD * DEXP * 2);
static_assert(O_YEXP + (size_t)NEXP * MOE_PAD * DM * 2 <= O_WIN, "MoE temporaries must fit inside P");
static_assert((size_t)NTOK * DM * 2 <= (size_t)NTOK * 1536 * 4, "ACCb must fit inside U");
static_assert((size_t)26214400 + (size_t)2 * 17825792 + (size_t)272 * 256 * 64 * 2 <= (size_t)NTOK * DM * 2, "strip buffers must fit inside HB");
static_assert(WS_END <= (size_t)1851000000, "workspace map exceeds the guaranteed size");

struct Args {
    const float* in[47];
    float* out; unsigned char* ws;
    int ph_lo, ph_hi;
};

__device__ __forceinline__ void conv_tile(const float* __restrict__ src, int ldsrc, int nvalid, int k0, int n0, bf16_t* __restrict__ dst, int lddst, int mode, float* T, int tid) {
    { const int n = tid & 63, kr = tid >> 6;
#pragma unroll
      for (int i = 0; i < 8; ++i) { const int k = i * 8 + kr; T[k * 65 + n] = (n0 + n < nvalid) ? src[(size_t)(k0 + k) * ldsrc + n0 + n] : 0.f; } }
    __syncthreads();
    { const int n = tid >> 3, kc = (tid & 7) * 8; const int gn = n0 + n;
      const int drow = mode == 0 ? gn : (32 * (gn >> 4) + (mode == 2 ? 16 : 0) + (gn & 15));
      u32x4 w; w.x = pk2(T[(kc + 0) * 65 + n], T[(kc + 1) * 65 + n]); w.y = pk2(T[(kc + 2) * 65 + n], T[(kc + 3) * 65 + n]);
      w.z = pk2(T[(kc + 4) * 65 + n], T[(kc + 5) * 65 + n]); w.w = pk2(T[(kc + 6) * 65 + n], T[(kc + 7) * 65 + n]);
      *(u32x4*)(dst + (size_t)drow * lddst + k0 + kc) = w; }
    __syncthreads();
}

#define IN(id) (lo <= (id) && (id) < hi)
#define SEAM(id) do { if (hi > (id) + 1) xcd_barrier(bar); } while (0)
#define PH_BEGIN int tid = threadIdx.x; asm volatile("" : "+v"(tid) :: "memory"); const int lane = tid & 63, wave = tid >> 6; (void)lane; (void)wave;

#define x_in (PT(0))
#define c_in (PT(1))
#define ctx_in (PT(2))
#define cctx_in (PT(3))
#define ada_w (PT(4))
#define ada_b (PT(5))
#define norm_mix (PT(6))
#define norm_ffn (PT(7))
#define w_in (PT(8))
#define XS ((float*)(a.ws + O_XS))
#define MOD ((float*)(a.ws + O_MOD))
#define NORM ((float*)(a.ws + O_NORM))
#define NORMP ((float*)(a.ws + O_NORMP))
#define MODl (MOD + (size_t)l * 5 * 6 * DM)
#define HB ((bf16_t*)(a.ws + O_HB))
#define P ((bf16_t*)(a.ws + O_P))
#define WIN ((bf16_t*)(a.ws + O_WIN))
#define WBR ((bf16_t*)(a.ws + O_WBR))
#define WOUT ((bf16_t*)(a.ws + O_WOUT))
#define WGU ((bf16_t*)(a.ws + O_WGU))
#define WD ((bf16_t*)(a.ws + O_WD))
#define GLU ((bf16_t*)(a.ws + O_GLU))
#define Y4 ((bf16_t*)(a.ws + O_Y4))
#define U ((float*)(a.ws + O_U))
#define ACCb ((bf16_t*)(a.ws + O_U))
#define QKB ((bf16_t*)(a.ws + O_QKB))
#define CST ((bf16_t*)(a.ws + O_CST))
#define NST ((float*)(a.ws + O_NST))
#define MST ((float*)(a.ws + O_MST))
#define XBC ((bf16_t*)(a.ws + O_XBC))
#define SSTB ((bf16_t*)(a.ws + O_SST))
#define HF ((bf16_t*)(a.ws + O_HF))
#define HBk (HF + (size_t)NTOK * BW)
#define YF ((bf16_t*)(a.ws + O_YF))
#define YB (YF + (size_t)NTOK * BW)
#define SF ((float*)(a.ws + O_SF))
#define SB (SF + (size_t)NCTX * BW)
#define LDT ((double2*)(a.ws + O_LDT))
#define APW ((float2*)(a.ws + O_AP))
#define BBT ((float2*)(a.ws + O_BBT))
#define KTB ((float*)(a.ws + O_KT))
#define S5A ((bf16_t*)(a.ws + O_S5A))
#define S5B ((bf16_t*)(a.ws + O_S5B))
#define XCTX ((float2*)(a.ws + O_XCTX))
#define S5P ((bf16_t*)(a.ws + O_HB))
#define XLOC ((float*)(a.ws + O_HB + (size_t)32 * 256 * 512 * 2))
#define KTG ((bf16_t*)(a.ws + O_HB + (size_t)26214400))
#define VTG ((bf16_t*)(a.ws + O_HB + (size_t)26214400 + (size_t)17825792))
#define BTG ((bf16_t*)(a.ws + O_HB + (size_t)26214400 + (size_t)2 * 17825792))
#define XTG ((bf16_t*)(a.ws + O_GG))
#define Z ((float*)(a.ws + O_Z))
#define HRAW ((float*)(a.ws + O_HRAW))
#define HSPEC ((float2*)(a.ws + O_HSPEC))
#define UT ((bf16_t*)(a.ws + O_U))
#define YT ((float*)(a.ws + O_Z))
#define QCTR ((int*)(a.ws + O_QCTR))
#define K2C ((float*)(a.ws + O_K2C))
#define GG ((bf16_t*)(a.ws + O_GG))
#define PROBS ((float*)(a.ws + O_PROBS))
#define ROWTOK ((int*)(a.ws + O_ROWTOK))
#define ROWGATE ((float*)(a.ws + O_ROWGATE))
#define XG ((bf16_t*)(a.ws + O_XG))
#define HID ((bf16_t*)(a.ws + O_HID))
#define YEXP ((bf16_t*)(a.ws + O_YEXP))
#define INV ((int*)(a.ws + O_INV))


__device__ __forceinline__ void moe_pair(float4 (&a)[8], const int r1, const int r2, const float g2scale, const int lane, const float* __restrict__ rowgate, const bf16_t* __restrict__ yexp) {
    const float gt1 = rowgate[r1], gt2 = rowgate[r2] * g2scale;
    const bf16_t* y1 = yexp + (size_t)r1 * DM + lane * 4; const bf16_t* y2 = yexp + (size_t)r2 * DM + lane * 4;
    u32x2 w1[8], w2[8];
#pragma unroll
    for (int i = 0; i < 8; ++i) { w1[i] = *(const u32x2*)(y1 + i * 256); w2[i] = *(const u32x2*)(y2 + i * 256); }
#pragma unroll
    for (int i = 0; i < 8; ++i) {
        a[i].x += gt1 * __uint_as_float(w1[i].x << 16); a[i].y += gt1 * __uint_as_float(w1[i].x & 0xFFFF0000u); a[i].z += gt1 * __uint_as_float(w1[i].y << 16); a[i].w += gt1 * __uint_as_float(w1[i].y & 0xFFFF0000u);
        a[i].x += gt2 * __uint_as_float(w2[i].x << 16); a[i].y += gt2 * __uint_as_float(w2[i].x & 0xFFFF0000u); a[i].z += gt2 * __uint_as_float(w2[i].y << 16); a[i].w += gt2 * __uint_as_float(w2[i].y & 0xFFFF0000u); }
}
__device__ __forceinline__ void moe_combine(float4 (&v)[8], const int tok, const int lane, const int* __restrict__ inv, const float* __restrict__ rowgate, const bf16_t* __restrict__ yexp, const float* __restrict__ m5) {
    float4 a[8], mm[8];
#pragma unroll
    for (int i = 0; i < 8; ++i) { a[i] = make_float4(0.f, 0.f, 0.f, 0.f); mm[i] = *(const float4*)(m5 + i * 256 + lane * 4); }
    const int4* ip = (const int4*)(inv + (size_t)tok * 16);
    const int4 q0 = ip[0], q1 = ip[1], q2 = ip[2], q3 = ip[3];
    const int rows[16] = {q0.x, q0.y, q0.z, q0.w, q1.x, q1.y, q1.z, q1.w, q2.x, q2.y, q2.z, q2.w, q3.x, q3.y, q3.z, q3.w};
    int prow = -1;
#pragma unroll
    for (int e = 0; e < 16; ++e) { const int row = __builtin_amdgcn_readfirstlane(rows[e]);
        if (row >= 0) { if (prow >= 0) { moe_pair(a, prow, row, 1.0f, lane, rowgate, yexp); prow = -1; } else prow = row; } }
    if (prow >= 0) moe_pair(a, prow, prow, 0.0f, lane, rowgate, yexp);
#pragma unroll
    for (int i = 0; i < 8; ++i) { v[i].x += mm[i].x * a[i].x; v[i].y += mm[i].y * a[i].y; v[i].z += mm[i].z * a[i].z; v[i].w += mm[i].w * a[i].w; }
}
struct CvU { const float* src; bf16_t* dst; int ldsrc, nvalid, k0, n0, lddst, mode; };
__device__ __forceinline__ void cv_load(const CvU& u, float4 (&r)[8], const int tid) {
#pragma unroll
    for (int i = 0; i < 8; ++i) { const int idx = tid + i * 512; const int k = idx >> 6, n = u.n0 + (idx & 63) * 4;
        r[i] = (n < u.nvalid) ? *(const float4*)(u.src + (size_t)(u.k0 + k) * u.ldsrc + n) : make_float4(0.f, 0.f, 0.f, 0.f); }
}
__device__ __forceinline__ void cv_stage(float* T, const float4 (&r)[8], const int tid) {
#pragma unroll
    for (int i = 0; i < 8; ++i) { const int idx = tid + i * 512; float* p = T + (idx >> 6) * 257 + (idx & 63) * 4; p[0] = r[i].x; p[1] = r[i].y; p[2] = r[i].z; p[3] = r[i].w; }
}
__device__ __forceinline__ void cv_store(const CvU& u, const float* T, const int tid) {
#pragma unroll
    for (int j = 0; j < 4; ++j) { const int o = tid + j * 512; const int kc = (o & 7) * 8, n = o >> 3; const int gn = u.n0 + n;
        int drow = u.mode == 0 ? gn : (256 * (gn >> 7) + (u.mode == 2 ? 128 : 0) + (gn & 127));
        if (u.mode == 3) {
            if (gn >= IN_W) continue;
            drow = gn;
            if (gn >= GATE_OFF) { const int g = gn - GATE_OFF, kb = g >> 11, col = g & 2047, j2 = col >> 6, rem = col & 63;
                drow = GATE2 + 256 * j2 + 128 * (kb >> 1) + 32 * (rem >> 4) + 8 * ((rem >> 2) & 3) + 4 * (kb & 1) + (rem & 3); } }
        const float* t = T + kc * 257 + n;
        u32x4 w; w.x = pk2(t[0], t[257]); w.y = pk2(t[2 * 257], t[3 * 257]); w.z = pk2(t[4 * 257], t[5 * 257]); w.w = pk2(t[6 * 257], t[7 * 257]);
        *(u32x4*)(u.dst + (size_t)drow * u.lddst + u.k0 + kc) = w; }
}
#define CV_RUN(LL, QSTART, QSTEP, QEND) do { \
                const float* wbr = PT(40) + (size_t)(LL) * 4 * BW * DM; const float* wout = PT(41) + (size_t)(LL) * DM * DM; \
                const float* wg = PT(43) + (size_t)(LL) * NEXP * DM * DEXP; const float* wu = PT(44) + (size_t)(LL) * NEXP * DM * DEXP; const float* wd = PT(45) + (size_t)(LL) * NEXP * DEXP * DM; \
                const float* wglu = PT(32) + (size_t)(LL) * BW * BW; const float* win = w_in + (size_t)(LL) * DM * IN_W; \
                const int cv_step = (QSTEP), cv_end = (QEND); \
                __syncthreads(); \
                int q = (QSTART); int buf = 0; CvU u; float4 r[8]; \
                if (q < cv_end) { CV_DECODE(q, u); cv_load(u, r, tid); } \
                while (q < cv_end) { \
                    float* T = sf + buf * (64 * 257); \
                    cv_stage(T, r, tid); \
                    __syncthreads(); \
                    const CvU cur = u; const int qn = q + cv_step; \
                    if (qn < cv_end) { CV_DECODE(qn, u); cv_load(u, r, tid); } \
                    cv_store(cur, T, tid); \
                    buf ^= 1; q = qn; \
                } \
                __syncthreads(); } while (0)
#define CV_DECODE(q_, u_) do { int qq_ = (q_); \
                    if (qq_ < n_win) { u_ = CvU{win, WIN, IN_W, IN_W, (qq_ / 55) * 64, (qq_ % 55) * 256, DM, 3}; } else { qq_ -= n_win; \
                    if (qq_ < n_br) { const int k = qq_ >> 6, r = qq_ & 63; u_ = CvU{wbr + (size_t)k * BW * DM, WBR + (size_t)k * DM * BW, DM, DM, (r >> 3) * 64, (r & 7) * 256, BW, 0}; } else { qq_ -= n_br; \
                    if (qq_ < n_out) { u_ = CvU{wout, WOUT, DM, DM, (qq_ >> 3) * 64, (qq_ & 7) * 256, DM, 0}; } else { qq_ -= n_out; \
                    if (qq_ < n_glu) { u_ = CvU{wglu, GLU, BW, BW, (qq_ >> 1) * 64, (qq_ & 1) * 256, BW, 0}; } else { qq_ -= n_glu; \
                    if (qq_ < n_gu) { const int e = qq_ / 384, r = qq_ % 384, up = r / 192, r2 = r % 192; u_ = CvU{(up ? wu : wg) + (size_t)e * DM * DEXP, WGU + (size_t)e * 2 * DEXP * DM, DEXP, DEXP, (r2 / 6) * 64, (r2 % 6) * 256, DM, 1 + up}; } else { qq_ -= n_gu; \
                    { const int e = qq_ / 192, r = qq_ % 192; u_ = CvU{wd + (size_t)e * DEXP * DM, WD + (size_t)e * DM * DEXP, DM, DM, (r >> 3) * 64, (r & 7) * 256, DEXP, 0}; } } } } } } } while (0)
template <int LAYER>
__device__ __forceinline__ void layer_body(const Args& a, const XcdBarrier& bar, const int lo, const int hi, const int bid, const int G, unsigned char* const shm, float* const sf, const float** const ptab) {
        constexpr int l = LAYER;
        constexpr int PB = 1 + 16 * l;
        const bool lastl = (l == 1);

        const int nPanels = lastl ? 64 : 68;
        const int M2 = nPanels * 256;

        if (IN(PB + 0)) for (int rep_ = 0; rep_ < (l == 0 ? PROBE_REPS(0) : 1); ++rep_) {
            PH_BEGIN
            {   const int n_win = 32 * 55, n_br = 4 * 64, n_out = 32 * 8, n_glu = 16, n_gu = 16 * 2 * 192, n_d = 16 * 192;
                const int n_grp1 = n_win + n_br + n_out + n_glu, total = n_grp1 + n_gu + n_d;
                const int q_lo = (l > 0 && G > 128) ? n_win : 0;
                const int q_hi = (lastl && G > 64) ? n_grp1 + n_gu - 768 : total;
                CV_RUN(l, q_lo + bid, G, q_hi);
                for (int i = bid * NTHR + tid; i < (GATE2 - GATE_OFF) * DM / 8; i += G * NTHR) ((u32x4*)(WIN + (size_t)GATE_OFF * DM))[i] = (u32x4){0u, 0u, 0u, 0u};
            }
            for (int set = 0; set < (lastl ? 1 : 2); ++set) {
                const int L = set ? CTXL : SEQ; float* HR = HRAW + (set ? (size_t)SEQ * 2048 : 0);
                const float* w1 = PT(11) + l * 33 * 64; const float* b1 = PT(12) + l * 64; const float* fr1 = PT(13) + l * 64; const float* w2 = PT(14) + l * 64 * 64; const float* b2 = PT(15) + l * 64;
                const float* fr2 = PT(16) + l * 64; const float* w3 = PT(17) + l * 64 * 2048; const float* decay = PT(18) + l * 2048;
                float* feats = sf; float* h1 = sf + 16 * 33; float* h2 = h1 + 16 * 64;
                float nacc[4] = {0.f, 0.f, 0.f, 0.f};
                for (int base = bid; base < L; base += 16 * G) {
                    __syncthreads();
                    for (int e = tid; e < 16 * 33; e += NTHR) { const int ti = e / 33, fi = e % 33; int t = base + ti * G; if (t > L - 1) t = L - 1;
                        float v;
                        if (fi == 0) v = (float)t / (float)(L - 1);
                        else { const int j = (fi - 1) & 15; const double fr = 1e-4 + (double)j * ((15.0 - 1e-4) / 15.0); const double ang = (2.0 * 3.14159265358979323846 / (double)L) * (double)t * fr; v = fi <= 16 ? (float)cos(ang) : (float)(-sin(ang)); }
                        feats[e] = v; }
                    __syncthreads();
                    { const int j = tid & 63, ti = tid >> 6; float s0 = b1[j], s1 = s0;
_Pragma("unroll 3")
                      for (int i = 0; i < 33; ++i) { const float wv = w1[i * 64 + j]; s0 += feats[ti * 33 + i] * wv; s1 += feats[(ti + 8) * 33 + i] * wv; }
                      const float f1 = fr1[j]; h1[ti * 64 + j] = sinf(f1 * s0); h1[(ti + 8) * 64 + j] = sinf(f1 * s1); }
                    __syncthreads();
                    { const int j = tid & 63, ti = tid >> 6; float s0 = b2[j], s1 = s0;
_Pragma("unroll 4")
                      for (int i = 0; i < 64; ++i) { const float wv = w2[i * 64 + j]; s0 += h1[ti * 64 + i] * wv; s1 += h1[(ti + 8) * 64 + i] * wv; }
                      const float f2 = fr2[j]; h2[ti * 64 + j] = sinf(f2 * s0); h2[(ti + 8) * 64 + j] = sinf(f2 * s1); }
                    __syncthreads();
                    float acc[16][4];
#pragma unroll
                    for (int ti = 0; ti < 16; ++ti) { acc[ti][0] = 0.f; acc[ti][1] = 0.f; acc[ti][2] = 0.f; acc[ti][3] = 0.f; }
#pragma unroll 2
                    for (int i = 0; i < 64; ++i) { const float* wrow = w3 + (size_t)i * 2048 + tid; const float wa = wrow[0], wb = wrow[512], wc2 = wrow[1024], wd2 = wrow[1536];
#pragma unroll
                        for (int ti = 0; ti < 16; ++ti) { const float hv = h2[ti * 64 + i]; acc[ti][0] += hv * wa; acc[ti][1] += hv * wb; acc[ti][2] += hv * wc2; acc[ti][3] += hv * wd2; } }
                    float dk[4];
#pragma unroll
                    for (int k = 0; k < 4; ++k) dk[k] = fabsf(decay[tid + k * 512]);
#pragma unroll
                    for (int ti = 0; ti < 16; ++ti) { const int t = base + ti * G; if (t < L) { const float tn = (float)t / (float)(L - 1);
#pragma unroll
                        for (int k = 0; k < 4; ++k) { const float v = acc[ti][k] * expf(-tn * dk[k]); HR[(size_t)t * 2048 + tid + k * 512] = v; nacc[k] += fabsf(v); } } }
                }
                float* nrp = NORMP + ((size_t)(l * 2 + set) * 256 + bid) * 2048;
#pragma unroll
                for (int k = 0; k < 4; ++k) nrp[tid + k * 512] = nacc[k];
            }
            for (int idx = bid * NTHR + tid; idx < 4096; idx += G * NTHR) { const int n = idx & 63, g = (idx >> 6) & 31, dir = idx >> 11;
                const double are = (double)(PT(24) + l * 4096)[idx], aim = (double)(PT(25) + l * 4096)[idx]; const double lam = are < -1e-4 ? are : -1e-4; const double dt = exp((double)(PT(26) + l * 64)[dir * 32 + g]);
                const double ldre = lam * dt, ldim = aim * dt; LDT[idx] = make_double2(ldre, ldim);
                const double mag = exp(ldre); const double ar = mag * cos(ldim), ai = mag * sin(ldim);
                const double den = lam * lam + aim * aim; const double nr = ar - 1.0, ni = ai; const double fre = (nr * lam + ni * aim) / den, fim = (ni * lam - nr * aim) / den;
                const float* b_re = PT(27) + l * 32 * 64 * 16; const float* b_im = PT(28) + l * 32 * 64 * 16;
#pragma unroll 4
                for (int c = 0; c < 16; ++c) { const double br = (double)b_re[(g * 64 + n) * 16 + c], bi = (double)b_im[(g * 64 + n) * 16 + c]; BBT[idx * 16 + c] = make_float2((float)(fre * br - fim * bi), (float)(fre * bi + fim * br)); }
            }
            for (int e2 = bid * NTHR + tid; e2 < 4096 * 33; e2 += G * NTHR) { const int idx = e2 / 33, k = e2 - idx * 33; const int g = (idx >> 6) & 31, dir = idx >> 11;
                const double are = (double)(PT(24) + l * 4096)[idx], aim = (double)(PT(25) + l * 4096)[idx]; const double lam = are < -1e-4 ? are : -1e-4; const double dt = exp((double)(PT(26) + l * 64)[dir * 32 + g]);
                const double ldre = lam * dt, ldim = aim * dt; const double mk = exp(ldre * k); APW[e2] = make_float2((float)(mk * cos(ldim * k)), (float)(mk * sin(ldim * k))); }
            if (l == 0 && lo == 0) xcd_barrier(bar);
            for (int tok = bid * 8 + wave; tok < NTOK; tok += G * 8) {
                const int r = tok < NLAT ? tok / SEQ : 4; const float* xr = l == 0 ? (tok < NLAT ? x_in + (size_t)tok * DM : ctx_in + (size_t)(tok - NLAT) * DM) : XS + (size_t)tok * DM; const float* gn = norm_mix + l * DM;
                const float* sh = MODl + (size_t)(r * 6 + 0) * DM; const float* sc = MODl + (size_t)(r * 6 + 1) * DM;
                float4 v[8]; float ss = 0.f;
#pragma unroll
                for (int i = 0; i < 8; ++i) v[i] = *(const float4*)(xr + i * 256 + lane * 4);
                if (l > 0) {
                    moe_combine(v, tok, lane, INV, ROWGATE, YEXP, MOD + (size_t)((l - 1) * 5 + r) * 6 * DM + 5 * DM);
#pragma unroll
                    for (int i = 0; i < 8; ++i) *(float4*)(XS + (size_t)tok * DM + i * 256 + lane * 4) = v[i]; }
#pragma unroll
                for (int i = 0; i < 8; ++i) ss += v[i].x * v[i].x + v[i].y * v[i].y + v[i].z * v[i].z + v[i].w * v[i].w;
                ss = wave_sum(ss); const float rs = rsqrtf(ss * (1.0f / DM) + 1e-6f);
#pragma unroll
                for (int i = 0; i < 8; ++i) { const int d = i * 256 + lane * 4; const float4 g4 = *(const float4*)(gn + d), s4 = *(const float4*)(sc + d), h4 = *(const float4*)(sh + d);
                    v[i].x = v[i].x * rs * g4.x * (1.f + s4.x) + h4.x; v[i].y = v[i].y * rs * g4.y * (1.f + s4.y) + h4.y; v[i].z = v[i].z * rs * g4.z * (1.f + s4.z) + h4.z; v[i].w = v[i].w * rs * g4.w * (1.f + s4.w) + h4.w; }
#pragma unroll
                for (int i = 0; i < 8; ++i) { u32x2 w; w.x = pk2(v[i].x, v[i].y); w.y = pk2(v[i].z, v[i].w); *(u32x2*)(HB + (size_t)tok * DM + i * 256 + lane * 4) = w; }
            }
            SEAM(PB + 0);
        }

        if (IN(PB + 1)) for (int rep_ = 0; rep_ < PROBE_REPS(1); ++rep_) {
            PH_BEGIN
            for (int base = bid * 8; base < (lastl ? 1 : 2) * 1024; base += G * 8) {
                const int idx = base + (tid & 7), sl = tid >> 3; const int set = idx >> 10, oc = idx & 1023, o = oc >> 9, c = oc & 511;
                const float* pp = NORMP + (size_t)(l * 2 + set) * 256 * 2048 + o * 1024 + c + (size_t)(sl * 4) * 2048; float sacc = 0.f;
#pragma unroll
                for (int j = 0; j < 4; ++j) { const float p0 = pp[(size_t)j * 2048], p1 = pp[(size_t)j * 2048 + 512]; sacc += (sl * 4 + j < G) ? p0 + p1 : 0.f; }
                sf[sl * 8 + (tid & 7)] = sacc; __syncthreads();
                if (tid < 8) { float t = 0.f;
#pragma unroll 8
                    for (int q = 0; q < 64; ++q) t += sf[q * 8 + tid];
                    NORM[(size_t)(l * 2 + set) * 1024 + oc] = t; }
                __syncthreads(); }
            for (int idx = (G - 1 - bid) * NTHR + tid; idx < 32768; idx += G * NTHR) { const int c = idx & 15, lag = (idx >> 4) & 31, dir = (idx >> 9) & 1, g = idx >> 10;
                const float* c_re = PT(29) + l * 32 * 16 * 64 + (g * 16 + c) * 64; const float* c_im = PT(30) + l * 32 * 16 * 64 + (g * 16 + c) * 64;
                float acc[16];
#pragma unroll
                for (int j = 0; j < 16; ++j) acc[j] = 0.f;
#pragma unroll 2
                for (int n = 0; n < 64; ++n) { const int pi = (dir * 32 + g) * 64 + n; const float2 ap = APW[pi * 33 + lag]; const float cr = c_re[n], ci = c_im[n]; const float wr_ = cr * ap.x - ci * ap.y, wi_ = cr * ap.y + ci * ap.x;
                    const float4* bb = (const float4*)(BBT + pi * 16);
#pragma unroll
                    for (int j = 0; j < 8; ++j) { const float4 b2 = bb[j]; acc[2 * j] += wr_ * b2.x - wi_ * b2.y; acc[2 * j + 1] += wr_ * b2.z - wi_ * b2.w; } }
                float4* o = (float4*)(KTB + (size_t)idx * 16);
                o[0] = make_float4(acc[0], acc[1], acc[2], acc[3]); o[1] = make_float4(acc[4], acc[5], acc[6], acc[7]); o[2] = make_float4(acc[8], acc[9], acc[10], acc[11]); o[3] = make_float4(acc[12], acc[13], acc[14], acc[15]);
            }
            __syncthreads();
            pg8::Gemm g{HB, WIN, DM, DM, DM}; pg8::SchedStd S{68, 55, G, bid, DM, DM}; pg8::EpiWin E{P, LDP};
            pg8::gemm_phase(( LAS unsigned char*)shm, g, S, E);
#if defined(PROBE_BNOEPI)
            { __syncthreads(); pg8::EpiNone E0; pg8::gemm_phase((LAS unsigned char*)shm, g, S, E0); }
#endif
            SEAM(PB + 1);
        }

        if (IN(PB + 2)) for (int rep_ = 0; rep_ < PROBE_REPS(2); ++rep_) {
            PH_BEGIN
            const float* hcw = PT(9) + l * 3 * 1536; const float* hcb = PT(10) + l * 1536; const float* mcw = PT(20) + l * 3 * 1024; const float* mcb = PT(21) + l * 1024;
            const float* scw = PT(34) + l * 3 * 1024; const float* scb = PT(35) + l * 1024;
            for (int unit = bid; unit < 272 * 3; unit += G) { const int seg = unit / 3, kind = unit % 3; const bool lat = seg < 256; const size_t tok0 = lat ? (size_t)seg * 64 : (size_t)NLAT + (size_t)(seg - 256) * 64;
                if (kind < 2) { const int hf = kind;
                    const int c = tid * 2; const int col = (hf ? SSD_OFF + 512 : ML_OFF) + c; const float* w = hf ? scw : mcw; const float* bsp = hf ? scb : mcb; bf16_t* dst = (hf ? XBC : QKB) + tok0 * 1024 + c;
                    const float2 w0 = *(const float2*)(w + c), w1 = *(const float2*)(w + 1024 + c), w2 = *(const float2*)(w + 2048 + c), bb = *(const float2*)(bsp + c);
                    const float osc = (!hf && c >= 512) ? 0.08838834764831845f : 1.0f;
                    const bool hasPrev = !lat && ((tok0 - NLAT) & (CTXL - 1)) != 0, hasNext = !lat && (((tok0 - NLAT) + 63) & (CTXL - 1)) != CTXL - 1;
                    bf16_t* strip = nullptr;
                    if (!hf) { if (c >= 512) strip = KTG + ((size_t)seg * 512 + (c - 512)) * 64; }
                    else { if (c < 512) strip = XTG + ((size_t)seg * 512 + c) * 64; else if (c < 768) strip = BTG + ((size_t)seg * 256 + (c - 512)) * 64; }
                    const bf16_t* pp = P + tok0 * LDP + col;
                    unsigned raw[66];
#pragma unroll
                    for (int t = 0; t < 66; ++t) raw[t] = ((t == 0 && !hasPrev) || (t == 65 && !hasNext)) ? 0u : *(const unsigned*)(pp + (ptrdiff_t)(t - 1) * LDP);
#pragma unroll
                    for (int t8 = 0; t8 < 8; ++t8) { float v0[8], v1[8];
#pragma unroll
                        for (int tt = 0; tt < 8; ++tt) { const int t = t8 * 8 + tt; const unsigned p0 = raw[t], p1 = raw[t + 1], p2 = raw[t + 2];
                            float a0 = bb.x + w0.x * __uint_as_float(p0 << 16) + w1.x * __uint_as_float(p1 << 16) + w2.x * __uint_as_float(p2 << 16);
                            float a1 = bb.y + w0.y * __uint_as_float(p0 & 0xFFFF0000u) + w1.y * __uint_as_float(p1 & 0xFFFF0000u) + w2.y * __uint_as_float(p2 & 0xFFFF0000u);
                            a0 = siluf_(a0) * osc; a1 = siluf_(a1) * osc; v0[tt] = a0; v1[tt] = a1;
                            *(unsigned*)(dst + (size_t)t * 1024) = pk2(a0, a1); }
                        if (strip) { u32x4 s0, s1; s0.x = pk2(v0[0], v0[1]); s0.y = pk2(v0[2], v0[3]); s0.z = pk2(v0[4], v0[5]); s0.w = pk2(v0[6], v0[7]); s1.x = pk2(v1[0], v1[1]); s1.y = pk2(v1[2], v1[3]); s1.z = pk2(v1[4], v1[5]); s1.w = pk2(v1[6], v1[7]);
                            *(u32x4*)(strip + t8 * 8) = s0; *(u32x4*)(strip + 64 + t8 * 8) = s1; } }
                } else {
                    const int c = (tid & 255) * 2, th = tid >> 8; const bf16_t* pp = P + (tok0 + th * 32) * LDP + ML_OFF + 1024 + c; bf16_t* strip = VTG + ((size_t)seg * 512 + c) * 64 + th * 32;
                    unsigned rv[32];
#pragma unroll
                    for (int t = 0; t < 32; ++t) rv[t] = *(const unsigned*)(pp + (size_t)t * LDP);
#pragma unroll
                    for (int t8 = 0; t8 < 4; ++t8) { u32x4 s0, s1;
                        s0.x = (rv[t8 * 8 + 0] & 0xFFFFu) | (rv[t8 * 8 + 1] << 16); s0.y = (rv[t8 * 8 + 2] & 0xFFFFu) | (rv[t8 * 8 + 3] << 16); s0.z = (rv[t8 * 8 + 4] & 0xFFFFu) | (rv[t8 * 8 + 5] << 16); s0.w = (rv[t8 * 8 + 6] & 0xFFFFu) | (rv[t8 * 8 + 7] << 16);
                        s1.x = (rv[t8 * 8 + 0] >> 16) | (rv[t8 * 8 + 1] & 0xFFFF0000u); s1.y = (rv[t8 * 8 + 2] >> 16) | (rv[t8 * 8 + 3] & 0xFFFF0000u); s1.z = (rv[t8 * 8 + 4] >> 16) | (rv[t8 * 8 + 5] & 0xFFFF0000u); s1.w = (rv[t8 * 8 + 6] >> 16) | (rv[t8 * 8 + 7] & 0xFFFF0000u);
                        *(u32x4*)(strip + t8 * 8) = s0; *(u32x4*)(strip + 64 + t8 * 8) = s1; }
                }
            }
            if (!lastl) for (int tok = NLAT + bid; tok < NTOK; tok += G) {
                const int t = (tok - NLAT) & (CTXL - 1); const bool hasL = (t != 0), hasR = (t != CTXL - 1); const bf16_t* pr = P + (size_t)tok * LDP;
                const bf16_t* prL = hasL ? pr - LDP : pr; const bf16_t* prR = hasR ? pr + LDP : pr;
                unsigned xc[3], xl[3], xr[3];
#pragma unroll
                for (int j = 0; j < 3; ++j) { const int cc = tid + j * 512; xc[j] = pr[HY_OFF + cc]; xl[j] = prL[HY_OFF + cc]; xr[j] = prR[HY_OFF + cc]; }
#pragma unroll
                for (int j = 0; j < 3; ++j) { const int cc = tid + j * 512;
                    float acc = hcb[cc] + hcw[1536 + cc] * __uint_as_float(xc[j] << 16);
                    acc += hasL ? hcw[cc] * __uint_as_float(xl[j] << 16) : 0.f;
                    acc += hasR ? hcw[2 * 1536 + cc] * __uint_as_float(xr[j] << 16) : 0.f;
                    U[(size_t)tok * 1536 + cc] = acc; }
            }
            for (int idx0 = bid * NTHR + tid; idx0 < 16384 * 64; idx0 += 4 * G * NTHR) { u32x4 t4[4];
#pragma unroll
                for (int q = 0; q < 4; ++q) { const int idx = idx0 + q * G * NTHR; const int half = idx & 1, g = (idx >> 1) & 31, tok = idx >> 6;
                    if (idx < 16384 * 64) t4[q] = *(const u32x4*)(P + (size_t)tok * LDP + S5_OFF + g * 16 + half * 8); }
#pragma unroll
                for (int q = 0; q < 4; ++q) { const int idx = idx0 + q * G * NTHR; const int half = idx & 1, g = (idx >> 1) & 31, tok = idx >> 6;
                    if (idx < 16384 * 64) *(u32x4*)(S5A + ((size_t)g * 512 + (tok >> 5)) * 768 + (tok & 31) * 16 + half * 8) = t4[q]; } }
            for (int idx = bid * NTHR + tid; idx < 32 * 512 * 32 * 2; idx += G * NTHR) { const int half = idx & 1, sI = (idx >> 1) & 31, row = (idx >> 6) & 511, g = idx >> 15; const int t = row >> 4, c = row & 15; const int lag = t - sI;
                float v[8];
                if (lag > 0) { const float4* k4 = (const float4*)(KTB + ((size_t)((g * 2 + 0) * 32 + lag) * 16 + c) * 16 + half * 8); const float4 a0 = k4[0], a1 = k4[1]; v[0] = a0.x; v[1] = a0.y; v[2] = a0.z; v[3] = a0.w; v[4] = a1.x; v[5] = a1.y; v[6] = a1.z; v[7] = a1.w; }
                else if (lag < 0) { const float4* k4 = (const float4*)(KTB + ((size_t)((g * 2 + 1) * 32 - lag) * 16 + c) * 16 + half * 8); const float4 a0 = k4[0], a1 = k4[1]; v[0] = a0.x; v[1] = a0.y; v[2] = a0.z; v[3] = a0.w; v[4] = a1.x; v[5] = a1.y; v[6] = a1.z; v[7] = a1.w; }
                else { const float4* k4 = (const float4*)(KTB + ((size_t)((g * 2 + 0) * 32) * 16 + c) * 16 + half * 8); const float4* q4 = (const float4*)(KTB + ((size_t)((g * 2 + 1) * 32) * 16 + c) * 16 + half * 8); const float4 a0 = k4[0], a1 = k4[1], b0 = q4[0], b1 = q4[1];
                    v[0] = a0.x + b0.x; v[1] = a0.y + b0.y; v[2] = a0.z + b0.z; v[3] = a0.w + b0.w; v[4] = a1.x + b1.x; v[5] = a1.y + b1.y; v[6] = a1.z + b1.z; v[7] = a1.w + b1.w; }
                u32x4 w; w.x = pk2(v[0], v[1]); w.y = pk2(v[2], v[3]); w.z = pk2(v[4], v[5]); w.w = pk2(v[6], v[7]);
                *(u32x4*)(S5B + ((size_t)g * 512 + row) * 768 + sI * 16 + half * 8) = w; }
            for (int idx = bid * NTHR + tid; idx < 32 * 512 * 64; idx += G * NTHR) { const int n = idx & 63, row = (idx >> 6) & 511, g = idx >> 15; const int t = row >> 4, c = row & 15;
                const float cr = (PT(29) + l * 32 * 16 * 64)[(g * 16 + c) * 64 + n], ci = (PT(30) + l * 32 * 16 * 64)[(g * 16 + c) * 64 + n];
                const float2 af = APW[((0 * 32 + g) * 64 + n) * 33 + t + 1], ab = APW[((1 * 32 + g) * 64 + n) * 33 + 32 - t];
                bf16_t* d = S5B + ((size_t)g * 512 + row) * 768 + 512 + 2 * n;
                *(unsigned*)d = pk2(cr * af.x - ci * af.y, -(cr * af.y + ci * af.x)); *(unsigned*)(d + 128) = pk2(cr * ab.x - ci * ab.y, -(cr * ab.y + ci * ab.x)); }
            for (int idx = bid * NTHR + tid; idx < 32 * 2 * 64 * 32; idx += G * NTHR) { const int sI = idx & 31, n = (idx >> 5) & 63, dir = (idx >> 11) & 1, g = idx >> 12; const int pi = (dir * 32 + g) * 64 + n;
                const float2 pw = APW[pi * 33 + (dir ? sI : 31 - sI)]; const float4* bb = (const float4*)(BBT + pi * 16);
                float re[16], im[16];
#pragma unroll
                for (int j = 0; j < 8; ++j) { const float4 b2 = bb[j]; re[2 * j] = pw.x * b2.x - pw.y * b2.y; im[2 * j] = pw.x * b2.y + pw.y * b2.x; re[2 * j + 1] = pw.x * b2.z - pw.y * b2.w; im[2 * j + 1] = pw.x * b2.w + pw.y * b2.z; }
                bf16_t* d = S5P + ((size_t)g * 256 + dir * 128 + 2 * n) * 512 + sI * 16;
                u32x4 w0, w1; w0.x = pk2(re[0], re[1]); w0.y = pk2(re[2], re[3]); w0.z = pk2(re[4], re[5]); w0.w = pk2(re[6], re[7]); w1.x = pk2(re[8], re[9]); w1.y = pk2(re[10], re[11]); w1.z = pk2(re[12], re[13]); w1.w = pk2(re[14], re[15]);
                *(u32x4*)d = w0; *(u32x4*)(d + 8) = w1;
                w0.x = pk2(im[0], im[1]); w0.y = pk2(im[2], im[3]); w0.z = pk2(im[4], im[5]); w0.w = pk2(im[6], im[7]); w1.x = pk2(im[8], im[9]); w1.y = pk2(im[10], im[11]); w1.z = pk2(im[12], im[13]); w1.w = pk2(im[14], im[15]);
                *(u32x4*)(d + 512) = w0; *(u32x4*)(d + 520) = w1; }
            {   float* T0 = sf; float* T1 = sf + 64 * 65;
                const int NU = 4 * 64 * 24; const int cL = tid & 63, tL = tid >> 6, c = tid >> 3, tq = (tid & 7) * 8;
                for (int unit = bid; unit < NU; unit += 2 * G) { const bool has2 = unit + G < NU; const int unit2 = has2 ? unit + G : unit;
                    const int ba = unit / (64 * 24), ra = (unit / 24) % 64, c0a = (unit % 24) * 64; const size_t toka = (size_t)ba * SEQ + ra * 64;
                    const int bb_ = unit2 / (64 * 24), rb = (unit2 / 24) % 64, c0b = (unit2 % 24) * 64; const size_t tokb = (size_t)bb_ * SEQ + rb * 64;
                    unsigned pa[8], pb[8];
#pragma unroll
                    for (int i = 0; i < 8; ++i) { pa[i] = P[(toka + tL + 8 * i) * LDP + HY_OFF + c0a + cL]; pb[i] = P[(tokb + tL + 8 * i) * LDP + HY_OFF + c0b + cL]; }
                    const int cca = c0a + c, ccb = c0b + c;
                    const float w0a = hcw[cca], w1a = hcw[1536 + cca], w2a = hcw[3072 + cca], bia = hcb[cca], w0b = hcw[ccb], w1b = hcw[1536 + ccb], w2b = hcw[3072 + ccb], bib = hcb[ccb];
                    __syncthreads();
#pragma unroll
                    for (int i = 0; i < 8; ++i) { T0[(tL + 8 * i) * 65 + cL] = __uint_as_float(pa[i] << 16); T1[(tL + 8 * i) * 65 + cL] = __uint_as_float(pb[i] << 16); }
                    __syncthreads();
                    {   float o8[8];
#pragma unroll
                        for (int i = 0; i < 8; ++i) { const int t = tq + i; float acc = bia + w1a * T0[t * 65 + c]; if (t > 0) acc += w0a * T0[(t - 1) * 65 + c]; if (t < 63) acc += w2a * T0[(t + 1) * 65 + c]; o8[i] = acc; }
                        u32x4 wv; wv.x = pk2(o8[0], o8[1]); wv.y = pk2(o8[2], o8[3]); wv.z = pk2(o8[4], o8[5]); wv.w = pk2(o8[6], o8[7]);
                        *(u32x4*)(UT + ((size_t)ba * 1536 + cca) * SEQ + ra * 64 + tq) = wv; }
                    if (has2) { float o8[8];
#pragma unroll
                        for (int i = 0; i < 8; ++i) { const int t = tq + i; float acc = bib + w1b * T1[t * 65 + c]; if (t > 0) acc += w0b * T1[(t - 1) * 65 + c]; if (t < 63) acc += w2b * T1[(t + 1) * 65 + c]; o8[i] = acc; }
                        u32x4 wv; wv.x = pk2(o8[0], o8[1]); wv.y = pk2(o8[2], o8[3]); wv.z = pk2(o8[4], o8[5]); wv.w = pk2(o8[6], o8[7]);
                        *(u32x4*)(UT + ((size_t)bb_ * 1536 + ccb) * SEQ + rb * 64 + tq) = wv; }
                } }
            if (!lastl) {
                const int L = CTXL; const float* HR = HRAW + (size_t)SEQ * 2048; float* K2 = K2C; const float* nrm = NORM + (size_t)(l * 2 + 1) * 1024;
                const size_t total = (size_t)(2 * L - 1) * 1024;
                for (size_t i = (size_t)bid * NTHR + tid; i < total; i += (size_t)G * NTHR) { const int j = (int)(i >> 10), oc = (int)(i & 1023), o = oc >> 9, c = oc & 511; const int lag = j - (L - 1);
                    const float v = lag >= 0 ? HR[(size_t)lag * 2048 + o * 1024 + c] : HR[(size_t)(-lag) * 2048 + o * 1024 + 512 + c];
                    K2[((size_t)j * 2 + o) * 512 + c] = v / nrm[oc]; }
            }
            {   __syncthreads(); fft_twiddles((float2*)(shm + FFT_X_BYTES), tid);
                for (int pr = bid; pr < 512; pr += G) hyena_spec_item(pr, HRAW, NORM + (size_t)(l * 2 + 0) * 1024, HSPEC, shm, tid);
                __syncthreads(); }
            SEAM(PB + 2);
        }

        if (IN(PB + 3)) for (int rep_ = 0; rep_ < PROBE_REPS(3); ++rep_) {
            PH_BEGIN
            if (rep_ > 0) { if (bid == 0 && tid == 0) __hip_atomic_store(QCTR + l * 64, 0, __ATOMIC_RELAXED, __HIP_MEMORY_SCOPE_AGENT); xcd_barrier(bar); }
            if (bid < 64) {
                mlstm_state_pass(bid >> 1, bid & 1, P, KTG, VTG, PT(22) + l * 16, CST, NST, MST, shm, tid);
            } else if (bid < 128) {
                { const int ch = bid - 64; const int dir_ = ch & 1, h_ = (ch >> 1) & 7; ssd_state_pass(ch, P, BTG, XTG, -expf(PT(37)[l * 16 + dir_ * 8 + h_]), PT(36)[l * 16 + dir_ * 8 + h_], SSTB, shm, tid); }
            } else if (bid < 160) {
                const int widx = (bid - 128) * 8 + wave; const int dir = widx & 1, g = (widx >> 1) & 31, b = widx >> 6; const int n = lane;
                float2* xb = (float2*)(shm + (size_t)wave * 16640); float2* ctab = xb + 16 * 65;
                const float* a_re = PT(24) + l * 2 * 32 * 64; const float* a_im = PT(25) + l * 2 * 32 * 64; const float* log_dt = PT(26) + l * 64;
                const float* b_re = PT(27) + l * 32 * 64 * 16; const float* b_im = PT(28) + l * 32 * 64 * 16; const float* c_re = PT(29) + l * 32 * 16 * 64; const float* c_im = PT(30) + l * 32 * 16 * 64;
#pragma unroll
                for (int c = 0; c < 16; ++c) ctab[c * 65 + lane] = make_float2(c_re[(g * 16 + c) * 64 + lane], c_im[(g * 16 + c) * 64 + lane]);
                float abr, abi, bbr[16], bbi[16];
                {   const double are = (double)a_re[(dir * 32 + g) * 64 + n], aim = (double)a_im[(dir * 32 + g) * 64 + n];
                    const double lam = are < -1e-4 ? are : -1e-4; const double dt = exp((double)log_dt[dir * 32 + g]);
                    const double mag = exp(lam * dt); const double ar = mag * cos(aim * dt), ai = mag * sin(aim * dt);
                    const double den = lam * lam + aim * aim; const double nr = ar - 1.0, ni = ai;
                    const double fre = (nr * lam + ni * aim) / den, fim = (ni * lam - nr * aim) / den;
                    abr = (float)ar; abi = (float)ai;
#pragma unroll
                    for (int c = 0; c < 16; ++c) { const double br = (double)b_re[(g * 64 + n) * 16 + c], bi = (double)b_im[(g * 64 + n) * 16 + c]; bbr[c] = (float)(fre * br - fim * bi); bbi[c] = (float)(fre * bi + fim * br); }
                }
                float xr = 0.f, xi = 0.f; float* Sout = (dir ? SB : SF) - (size_t)NLAT * BW;
                const int s = lane >> 2, cg = lane & 3;
                for (int i0 = 0; i0 < CTXL; i0 += 16) {
#pragma unroll 4
                    for (int ss = 0; ss < 16; ++ss) {
                        const size_t tok = (size_t)step_tok(b, dir, i0 + ss);
                        const u32x4* up = (const u32x4*)(P + tok * LDP + S5_OFF + g * 16);
                        float t0[8], t1[8]; unpack8(up[0], t0); unpack8(up[1], t1);
                        float bur = 0.f, bui = 0.f;
#pragma unroll
                        for (int c = 0; c < 8; ++c) { bur += t0[c] * bbr[c] + t1[c] * bbr[8 + c]; bui += t0[c] * bbi[c] + t1[c] * bbi[8 + c]; }
                        const float nxr = abr * xr - abi * xi + bur, nxi = abr * xi + abi * xr + bui; xr = nxr; xi = nxi;
                        xb[ss * 65 + lane] = make_float2(xr, xi);
                    }
                    asm volatile("s_waitcnt lgkmcnt(0)" ::: "memory");
                    float y0 = 0.f, y1 = 0.f, y2 = 0.f, y3 = 0.f;
                    for (int nn2 = 0; nn2 < 64; ++nn2) { const float2 xv = xb[s * 65 + nn2];
                        const float2 c0 = ctab[(cg * 4 + 0) * 65 + nn2], c1 = ctab[(cg * 4 + 1) * 65 + nn2], c2 = ctab[(cg * 4 + 2) * 65 + nn2], c3 = ctab[(cg * 4 + 3) * 65 + nn2];
                        y0 += xv.x * c0.x - xv.y * c0.y; y1 += xv.x * c1.x - xv.y * c1.y; y2 += xv.x * c2.x - xv.y * c2.y; y3 += xv.x * c3.x - xv.y * c3.y; }
                    const size_t toks = (size_t)step_tok(b, dir, i0 + s);
                    *(float4*)(Sout + toks * BW + g * 16 + cg * 4) = make_float4(y0, y1, y2, y3);
                    asm volatile("s_waitcnt lgkmcnt(0)" ::: "memory");
                }
                XCTX[((b * 32 + g) * 2 + dir) * 64 + n] = make_float2(xr, xi);
            } else {
                if (bid < 224) {
                    pg8::Gemm gg_{S5A, S5P, 768, 512, 512}; pg8::SchedS5a S_{bid - 160}; pg8::EpiXloc E_{XLOC};
                    pg8::gemm_phase((LAS unsigned char*)shm, gg_, S_, E_);
                    __syncthreads();
                }
                const int nhb = G - 160, hb = bid - 160; const float* bias = PT(19) + l * 1024; const int c = tid;
                const int nitems = lastl ? 0 : 4 * (CTXL / 8);
                for (int it = hb; it < nitems; it += nhb) {
                    int L, tokbase, b, t0; const float* K2;
                    { const int q = it; L = CTXL; tokbase = NLAT; b = q / (CTXL / 8); t0 = (q % (CTXL / 8)) * 8; K2 = K2C; }
                    const float* zb = U + (size_t)(tokbase + b * L) * 1536 + c;
                    float acc[8];
#pragma unroll
                    for (int i = 0; i < 8; ++i) acc[i] = 0.f;
                    const int base = t0 + L - 1;
                    for (int s = 0; s < L; s += 8) {
                        float k[15];
#pragma unroll
                        for (int mm = 0; mm < 15; ++mm) k[mm] = K2[((size_t)(base - s - 7 + mm) * 2 + 0) * 512 + c];
#pragma unroll
                        for (int ds = 0; ds < 8; ++ds) { const float z = zb[(size_t)(s + ds) * 1536];
#pragma unroll
                            for (int i = 0; i < 8; ++i) acc[i] += k[i - ds + 7] * z; }
                    }
#pragma unroll
                    for (int i = 0; i < 8; ++i) { const size_t tok = (size_t)(tokbase + b * L + t0 + i); const float zt = U[tok * 1536 + c]; Z[tok * BW + c] = (acc[i] + bias[c] * zt) * U[tok * 1536 + 512 + c]; }
                }
            }
            {   __syncthreads(); fft_twiddles((float2*)(shm + FFT_X_BYTES), tid);
                int* qslot = (int*)(shm + FFT_X_BYTES + 65536);
                for (;;) { __syncthreads(); if (tid == 0) *qslot = atomicAdd(QCTR + l * 64, 1); __syncthreads(); const int it = *qslot; if (it >= 1024) break;
                    hyena_fft_item(it, UT, HSPEC, PT(19) + l * 1024, YT, shm, tid); }
            }
            SEAM(PB + 3);
        }

        if (IN(PB + 4)) for (int rep_ = 0; rep_ < PROBE_REPS(4); ++rep_) {
            PH_BEGIN
            if (rep_ > 0) { if (bid == 0 && tid == 0) __hip_atomic_store(QCTR + l * 64 + 32, 0, __ATOMIC_RELAXED, __HIP_MEMORY_SCOPE_AGENT); xcd_barrier(bar); }
            if (bid >= G - 32) for (int idx = (bid - (G - 32)) * NTHR + tid; idx < 16384; idx += 32 * NTHR) { const int n = idx & 63, dir = (idx >> 6) & 1, b = (idx >> 7) & 3, g = idx >> 9;
                const float2 a32 = APW[((dir * 32 + g) * 64 + n) * 33 + 32]; float2 X = XCTX[((b * 32 + g) * 2 + dir) * 64 + n];
                const float* __restrict__ xl = XLOC + ((size_t)g * 512 + b * 128) * 256 + dir * 128 + 2 * n; bf16_t* __restrict__ dst = S5A + ((size_t)g * 512 + b * 128) * 768 + 512 + dir * 128 + 2 * n;
#pragma unroll 1
                for (int j0 = 0; j0 < 128; j0 += 16) { float2 xv[16];
#pragma unroll
                    for (int q = 0; q < 16; ++q) { const int j = dir ? 127 - (j0 + q) : j0 + q; xv[q] = *(const float2*)(xl + (size_t)j * 256); }
#pragma unroll
                    for (int q = 0; q < 16; ++q) { const int j = dir ? 127 - (j0 + q) : j0 + q;
                        *(unsigned*)(dst + (size_t)j * 768) = pk2(X.x, X.y);
                        const float nx = a32.x * X.x - a32.y * X.y + xv[q].x, ny = a32.x * X.y + a32.y * X.x + xv[q].y; X.x = nx; X.y = ny; } } }
            {   int* qslot = (int*)(shm + 102400);
                __syncthreads(); if (tid == 0) *qslot = atomicAdd(QCTR + l * 64 + 32, 1); __syncthreads();
                for (;;) { const int it = *qslot; if (it >= 32 * 68 + 64 * 68) break;
                    int nxt_ = 0; if (tid == 0) nxt_ = atomicAdd(QCTR + l * 64 + 32, 1);
                    if (it < 32 * 68) { const int chain = it / 68, c = it % 68; mlstm_out_item(chain, c, P, QKB, VTG, PT(22) + l * 16, CST, NST, MST, (chain & 1) ? HBk : HF, shm, tid); }
                    else { const int i2 = it - 32 * 68; const int chain = i2 / 68, c = i2 % 68; const int dir_ = chain & 1, h_ = (chain >> 1) & 7;
                        ssd_out_item(chain, c, P, XBC, XTG, -expf(PT(37)[l * 16 + dir_ * 8 + h_]), PT(36)[l * 16 + dir_ * 8 + h_], SSTB, dir_ ? YB : YF, shm, tid); }
                    __syncthreads(); if (tid == 0) *qslot = nxt_; __syncthreads(); }
            }
            __syncthreads();
            {   const float* bias = PT(19) + l * 1024 + 512; const int c = tid;
                const int nitems = lastl ? 0 : 4 * (CTXL / 8);
                for (int it = bid; it < nitems; it += G) {
                    int L, tokbase, b, t0; const float* K2;
                    { const int q = it; L = CTXL; tokbase = NLAT; b = q / (CTXL / 8); t0 = (q % (CTXL / 8)) * 8; K2 = K2C; }
                    const float* zb = Z + (size_t)(tokbase + b * L) * BW + c;
                    float acc[8];
#pragma unroll
                    for (int i = 0; i < 8; ++i) acc[i] = 0.f;
                    const int base = t0 + L - 1;
                    for (int s = 0; s < L; s += 8) {
                        float k[15];
#pragma unroll
                        for (int mm = 0; mm < 15; ++mm) k[mm] = K2[((size_t)(base - s - 7 + mm) * 2 + 1) * 512 + c];
#pragma unroll
                        for (int ds = 0; ds < 8; ++ds) { const float z = zb[(size_t)(s + ds) * BW];
#pragma unroll
                            for (int i = 0; i < 8; ++i) acc[i] += k[i - ds + 7] * z; }
                    }
#pragma unroll
                    for (int i = 0; i < 8; ++i) { const size_t tok = (size_t)(tokbase + b * L + t0 + i); const float zt = Z[tok * BW + c]; Y4[tok * DM + c] = f2bf((acc[i] + bias[c] * zt) * U[tok * 1536 + 1024 + c]); }
                }
            }
            SEAM(PB + 4);
        }

        if (IN(PB + 5)) for (int rep_ = 0; rep_ < PROBE_REPS(5); ++rep_) {
            PH_BEGIN
            const float* ml_norm = PT(23) + l * BW; const float* ssd_d = PT(38) + l * 8; const float* ssd_norm = PT(39) + l * BW; const float* s5_d = PT(31) + l * BW;
            if (bid < 128) {
                pg8::Gemm gg_{S5A, S5B, 768, 768, 768}; pg8::SchedS5b S_{bid}; pg8::EpiS5Out E_{P, s5_d, GG};
                pg8::gemm_phase((LAS unsigned char*)shm, gg_, S_, E_);
                __syncthreads();
            }
            for (int tok = bid * 8 + wave; tok < NTOK; tok += G * 8) {
                const int c0 = lane * 8; const bf16_t* pr = P + (size_t)tok * LDP; const size_t o5 = (size_t)tok * BW + c0;
                float hm[8], ys[8];
                const u32x4 ooq = *(const u32x4*)(pr + ML_OFF + 1536 + c0);
                const float4 g0 = *(const float4*)(ml_norm + c0), g1 = *(const float4*)(ml_norm + c0 + 4), n0 = *(const float4*)(ssd_norm + c0), n1 = *(const float4*)(ssd_norm + c0 + 4);
                { float fa[8], fb[8]; unpack8(*(const u32x4*)(HF + o5), fa); unpack8(*(const u32x4*)(HBk + o5), fb);
#pragma unroll
                  for (int j = 0; j < 8; ++j) hm[j] = fa[j] + fb[j]; }
                { float ya[8], yb[8]; unpack8(*(const u32x4*)(YF + o5), ya); unpack8(*(const u32x4*)(YB + o5), yb);
                  float xx[8], zz[8]; unpack8(*(const u32x4*)(XBC + (size_t)tok * 1024 + c0), xx); unpack8(*(const u32x4*)(pr + SSD_OFF + c0), zz); const float dsk = ssd_d[c0 >> 6];
#pragma unroll
                  for (int j = 0; j < 8; ++j) ys[j] = ya[j] + yb[j];
#pragma unroll
                  for (int j = 0; j < 8; ++j) ys[j] = (ys[j] + dsk * xx[j]) * siluf_(zz[j]); }
                float s1 = 0.f, s2 = 0.f;
#pragma unroll
                for (int j = 0; j < 8; ++j) { s1 += hm[j] * hm[j]; s2 += ys[j] * ys[j]; }
                s1 += __shfl_xor(s1, 1); s1 += __shfl_xor(s1, 2); s1 += __shfl_xor(s1, 4); s1 += __shfl_xor(s1, 8);
                s2 = wave_sum(s2);
                const float r1 = rsqrtf(s1 * (1.0f / 128.0f) + 1e-6f), r2 = rsqrtf(s2 * (1.0f / BW) + 1e-6f);
                float oo[8]; unpack8(ooq, oo);
                const float gm[8] = {g0.x, g0.y, g0.z, g0.w, g1.x, g1.y, g1.z, g1.w}, gs[8] = {n0.x, n0.y, n0.z, n0.w, n1.x, n1.y, n1.z, n1.w};
                u32x4 w;
                w.x = pk2(hm[0] * r1 * gm[0] * sigmoidf_(oo[0]), hm[1] * r1 * gm[1] * sigmoidf_(oo[1])); w.y = pk2(hm[2] * r1 * gm[2] * sigmoidf_(oo[2]), hm[3] * r1 * gm[3] * sigmoidf_(oo[3]));
                w.z = pk2(hm[4] * r1 * gm[4] * sigmoidf_(oo[4]), hm[5] * r1 * gm[5] * sigmoidf_(oo[5])); w.w = pk2(hm[6] * r1 * gm[6] * sigmoidf_(oo[6]), hm[7] * r1 * gm[7] * sigmoidf_(oo[7]));
                *(u32x4*)(Y4 + (size_t)tok * DM + 512 + c0) = w;
                w.x = pk2(ys[0] * r2 * gs[0], ys[1] * r2 * gs[1]); w.y = pk2(ys[2] * r2 * gs[2], ys[3] * r2 * gs[3]); w.z = pk2(ys[4] * r2 * gs[4], ys[5] * r2 * gs[5]); w.w = pk2(ys[6] * r2 * gs[6], ys[7] * r2 * gs[7]);
                *(u32x4*)(Y4 + (size_t)tok * DM + 1536 + c0) = w;
                if (tok >= NLAT) { const size_t oc = (size_t)(tok - NLAT) * BW + c0; float uu[8]; unpack8(*(const u32x4*)(pr + S5_OFF + c0), uu);
                    const float4 a0 = *(const float4*)(SF + oc), a1 = *(const float4*)(SF + oc + 4), b0 = *(const float4*)(SB + oc), b1 = *(const float4*)(SB + oc + 4), d0 = *(const float4*)(s5_d + c0), d1 = *(const float4*)(s5_d + c0 + 4);
                    float y[8] = {a0.x + b0.x + d0.x * uu[0], a0.y + b0.y + d0.y * uu[1], a0.z + b0.z + d0.z * uu[2], a0.w + b0.w + d0.w * uu[3], a1.x + b1.x + d1.x * uu[4], a1.y + b1.y + d1.y * uu[5], a1.z + b1.z + d1.z * uu[6], a1.w + b1.w + d1.w * uu[7]};
#pragma unroll
                    for (int j = 0; j < 8; ++j) y[j] = 0.5f * y[j] * (1.0f + tanhf(0.7978845608028654f * (y[j] + 0.044715f * y[j] * y[j] * y[j])));
                    w.x = pk2(y[0], y[1]); w.y = pk2(y[2], y[3]); w.z = pk2(y[4], y[5]); w.w = pk2(y[6], y[7]);
                    *(u32x4*)(GG + (size_t)tok * BW + c0) = w; }
            }
            __syncthreads();
            {   float* T = sf;
                for (int unit = (G > 128 ? bid - 128 : bid); unit >= 0 && unit < 4 * 64 * 8; unit += (G > 128 ? G - 128 : G)) { const int b = unit / 512, t0 = ((unit >> 3) & 63) * 64, c0 = (unit & 7) * 64;
                    __syncthreads();
#pragma unroll
                    for (int i = 0; i < 8; ++i) { const int t = tid & 63, c = (tid >> 6) + 8 * i; T[c * 65 + t] = YT[((size_t)b * 512 + c0 + c) * SEQ + t0 + t]; }
                    __syncthreads();
                    const int t = tid >> 3, cq = (tid & 7) * 8;
                    u32x4 w; w.x = pk2(T[(cq + 0) * 65 + t], T[(cq + 1) * 65 + t]); w.y = pk2(T[(cq + 2) * 65 + t], T[(cq + 3) * 65 + t]); w.z = pk2(T[(cq + 4) * 65 + t], T[(cq + 5) * 65 + t]); w.w = pk2(T[(cq + 6) * 65 + t], T[(cq + 7) * 65 + t]);
                    *(u32x4*)(Y4 + ((size_t)b * SEQ + t0 + t) * DM + c0 + cq) = w;
                } }
            SEAM(PB + 5);
        }

        if (IN(PB + 6)) for (int rep_ = 0; rep_ < PROBE_REPS(6); ++rep_) {
            PH_BEGIN
            pg8::Gemm g{GG, GLU, BW, BW, BW}; pg8::SchedStd S{68, 2, G, bid, BW, BW}; pg8::EpiGlu E{GG, PT(33) + l * BW, Y4};
            pg8::gemm_phase((LAS unsigned char*)shm, g, S, E);
            SEAM(PB + 6);
        }
        if (IN(PB + 7)) for (int rep_ = 0; rep_ < PROBE_REPS(7); ++rep_) {
            PH_BEGIN
            pg8::Gemm g{Y4, WBR, DM, BW, BW}; pg8::SchedBranch S{64, 8, G, bid}; pg8::EpiBranch E{P, ACCb};
            pg8::gemm_phase((LAS unsigned char*)shm, g, S, E);
            if (!lastl) { __syncthreads(); pg8::SchedTail S2{G, bid}; pg8::EpiPartK E2{(float*)HSPEC}; pg8::gemm_phase((LAS unsigned char*)shm, g, S2, E2); }
            SEAM(PB + 7);
        }
        if (IN(PB + 8)) for (int rep_ = 0; rep_ < PROBE_REPS(8); ++rep_) {
            PH_BEGIN
            if (!lastl) {
                const float* PART = (const float*)HSPEC;
                for (int idx = bid * NTHR + tid; idx < (NTOK - NLAT) * DM / 8; idx += G * NTHR) { const size_t o = (size_t)idx * 8; f32x4 p[4][2];
#pragma unroll
                    for (int k = 0; k < 4; ++k) { p[k][0] = *(const f32x4*)(PART + (size_t)k * (NTOK - NLAT) * DM + o); p[k][1] = *(const f32x4*)(PART + (size_t)k * (NTOK - NLAT) * DM + o + 4); }
                    f32x4 s0 = (f32x4){0.f, 0.f, 0.f, 0.f}, s1 = s0; const bf16_t* rp = P + (size_t)(NLAT + (o >> 11)) * LDP + GATE2 + (o & (DM - 1));
#pragma unroll
                    for (int k = 0; k < 4; ++k) { float rr[8]; unpack8(*(const u32x4*)(rp + k * DM), rr);
                        s0 = s0 + p[k][0]; s1 = s1 + p[k][1]; s0[0] *= rr[0]; s0[1] *= rr[1]; s0[2] *= rr[2]; s0[3] *= rr[3]; s1[0] *= rr[4]; s1[1] *= rr[5]; s1[2] *= rr[6]; s1[3] *= rr[7]; }
                    u32x4 w; w.x = pk2(s0[0], s0[1]); w.y = pk2(s0[2], s0[3]); w.z = pk2(s1[0], s1[1]); w.w = pk2(s1[2], s1[3]);
                    *(u32x4*)(ACCb + (size_t)NLAT * DM + o) = w; }
                xcd_barrier(bar);
            }
            pg8::Gemm g{ACCb, WOUT, DM, DM, DM}; pg8::SchedStd S{64, 8, G, bid, DM, DM}; pg8::EpiResid E{XS, l == 0 ? x_in : (const float*)XS, l == 0 ? ctx_in - (size_t)NLAT * DM : (const float*)XS, MODl, 2};
            pg8::gemm_phase((LAS unsigned char*)shm, g, S, E);
            if (!lastl) { __syncthreads(); pg8::Gemm g2{ACCb, WOUT, DM, DM, 512}; pg8::SchedTailK S2{G, bid}; pg8::EpiPartK E2{(float*)HSPEC + (size_t)4 * (NTOK - NLAT) * DM}; pg8::gemm_phase((LAS unsigned char*)shm, g2, S2, E2); }
            SEAM(PB + 8);
        }
        if (IN(PB + 9)) for (int rep_ = 0; rep_ < PROBE_REPS(9); ++rep_) {
            PH_BEGIN
            if (!lastl) {
                const float* PART = (const float*)HSPEC + (size_t)4 * (NTOK - NLAT) * DM; const float* mg = MODl + (size_t)(4 * 6 + 2) * DM;
                const float* src = l == 0 ? ctx_in : (const float*)XS + (size_t)NLAT * DM;
                for (int idx = bid * NTHR + tid; idx < (NTOK - NLAT) * DM / 4; idx += G * NTHR) { const size_t o = (size_t)idx * 4; const int col = (int)(o & (DM - 1));
                    const f32x4 p0 = *(const f32x4*)(PART + o), p1 = *(const f32x4*)(PART + (size_t)(NTOK - NLAT) * DM + o), p2 = *(const f32x4*)(PART + (size_t)2 * (NTOK - NLAT) * DM + o), p3 = *(const f32x4*)(PART + (size_t)3 * (NTOK - NLAT) * DM + o);
                    const f32x4 sv = *(const f32x4*)(src + o), gm = *(const f32x4*)(mg + col);
                    *(f32x4*)(XS + (size_t)NLAT * DM + o) = sv + gm * (((p0 + p1) + p2) + p3); }
                xcd_barrier(bar);
            }
            for (int i = bid * NTHR + tid; i < NEXP * MOE_PAD; i += G * NTHR) ROWTOK[i] = -1;
            for (int i = bid * NTHR + tid; i < NTOK * 16; i += G * NTHR) INV[i] = -1;
            const float* wr = PT(42) + (size_t)l * DM * 16; const float* gn = norm_ffn + l * DM;
            float* wl = sf;
            __syncthreads();
#pragma unroll 1
            for (int q0 = 0; q0 < 16; q0 += 4) {
                const float4 a0 = ((const float4*)wr)[(q0 + 0) * 512 + tid], a1 = ((const float4*)wr)[(q0 + 1) * 512 + tid], a2 = ((const float4*)wr)[(q0 + 2) * 512 + tid], a3 = ((const float4*)wr)[(q0 + 3) * 512 + tid];
                { const int f4 = (q0 + 0) * 512 + tid; *(float4*)(wl + (size_t)(f4 >> 4) * 68 + (f4 & 15) * 4) = a0; }
                { const int f4 = (q0 + 1) * 512 + tid; *(float4*)(wl + (size_t)(f4 >> 4) * 68 + (f4 & 15) * 4) = a1; }
                { const int f4 = (q0 + 2) * 512 + tid; *(float4*)(wl + (size_t)(f4 >> 4) * 68 + (f4 & 15) * 4) = a2; }
                { const int f4 = (q0 + 3) * 512 + tid; *(float4*)(wl + (size_t)(f4 >> 4) * 68 + (f4 & 15) * 4) = a3; } }
            __syncthreads();
            for (int tok0 = (bid * 8 + wave) * 4; tok0 < M2; tok0 += G * 32) {
                const int r = tok0 < NLAT ? tok0 / SEQ : 4; const float* xr = XS + (size_t)tok0 * DM;
                const float* sh = MODl + (size_t)(r * 6 + 3) * DM; const float* sc = MODl + (size_t)(r * 6 + 4) * DM;
                float rs[4];
#pragma unroll
                for (int tk = 0; tk < 4; ++tk) { float ss = 0.f;
#pragma unroll 4
                    for (int i = 0; i < 8; ++i) { const float4 t4 = *(const float4*)(xr + (size_t)tk * DM + i * 256 + lane * 4); ss += t4.x * t4.x + t4.y * t4.y + t4.z * t4.z + t4.w * t4.w; }
                    ss = wave_sum(ss); rs[tk] = rsqrtf(ss * (1.0f / DM) + 1e-6f); }
                float lg[4][16];
#pragma unroll
                for (int tk = 0; tk < 4; ++tk)
#pragma unroll
                    for (int e = 0; e < 16; ++e) lg[tk][e] = 0.f;
#pragma unroll 1
                for (int i = 0; i < 8; ++i) { const int d = i * 256 + lane * 4;
                    const float4 g4 = *(const float4*)(gn + d), s4 = *(const float4*)(sc + d), h4 = *(const float4*)(sh + d);
                    float4 xq[4], ww[16];
#pragma unroll
                    for (int tk = 0; tk < 4; ++tk) xq[tk] = *(const float4*)(xr + (size_t)tk * DM + d);
                    const float4* wq = (const float4*)(wl + (size_t)(i * 64 + lane) * 68);
#pragma unroll
                    for (int q = 0; q < 16; ++q) ww[q] = wq[q];
                    float hv[4][4];
#pragma unroll
                    for (int tk = 0; tk < 4; ++tk) { const float4 xv = xq[tk]; const float rr = rs[tk];
                        hv[tk][0] = xv.x * rr * g4.x * (1.f + s4.x) + h4.x; hv[tk][1] = xv.y * rr * g4.y * (1.f + s4.y) + h4.y; hv[tk][2] = xv.z * rr * g4.z * (1.f + s4.z) + h4.z; hv[tk][3] = xv.w * rr * g4.w * (1.f + s4.w) + h4.w;
                        u32x2 w; w.x = pk2(hv[tk][0], hv[tk][1]); w.y = pk2(hv[tk][2], hv[tk][3]); *(u32x2*)(HB + (size_t)(tok0 + tk) * DM + d) = w; }
#pragma unroll
                    for (int q = 0; q < 4; ++q) { const float4 w0 = ww[q * 4 + 0], w1 = ww[q * 4 + 1], w2 = ww[q * 4 + 2], w3 = ww[q * 4 + 3];
#pragma unroll
                        for (int tk = 0; tk < 4; ++tk) { const float hq = hv[tk][q];
                            lg[tk][0] += hq * w0.x; lg[tk][1] += hq * w0.y; lg[tk][2] += hq * w0.z; lg[tk][3] += hq * w0.w; lg[tk][4] += hq * w1.x; lg[tk][5] += hq * w1.y; lg[tk][6] += hq * w1.z; lg[tk][7] += hq * w1.w;
                            lg[tk][8] += hq * w2.x; lg[tk][9] += hq * w2.y; lg[tk][10] += hq * w2.z; lg[tk][11] += hq * w2.w; lg[tk][12] += hq * w3.x; lg[tk][13] += hq * w3.y; lg[tk][14] += hq * w3.z; lg[tk][15] += hq * w3.w; } } }
#pragma unroll
                for (int tk = 0; tk < 4; ++tk) { float mx = -1e30f;
#pragma unroll
                    for (int e = 0; e < 16; ++e) { lg[tk][e] = wave_sum(lg[tk][e]); mx = fmaxf(mx, lg[tk][e]); }
                    float sm = 0.f;
#pragma unroll
                    for (int e = 0; e < 16; ++e) { lg[tk][e] = expf(lg[tk][e] - mx); sm += lg[tk][e]; }
                    const float inv = 1.0f / sm;
                    if (lane == 0) {
#pragma unroll
                        for (int e = 0; e < 16; e += 4) *(float4*)(PROBS + (size_t)(tok0 + tk) * 16 + e) = make_float4(lg[tk][e] * inv, lg[tk][e + 1] * inv, lg[tk][e + 2] * inv, lg[tk][e + 3] * inv); } }
            }
            SEAM(PB + 9);
        }
        if (IN(PB + 10)) for (int rep_ = 0; rep_ < PROBE_REPS(10); ++rep_) {
            PH_BEGIN
            const int nitems = 64 + (lastl ? 0 : 64);
            unsigned long long* keys = (unsigned long long*)shm;
            for (int it = bid; it < nitems; it += G) {
                const int set = it >> 6, e = it & 15, b = (it >> 4) & 3;
                const int n = set ? CTXL : SEQ, cap = set ? 32 : 512, tokbase = set ? NLAT + b * CTXL : b * SEQ;
                __syncthreads();
                for (int i = tid; i < n; i += NTHR) keys[i] = ((unsigned long long)__float_as_uint(PROBS[(size_t)(tokbase + i) * 16 + e]) << 32) | (unsigned long long)(0xFFFFFFFFu - (unsigned)i);
                __syncthreads();
                for (int k = 2; k <= n; k <<= 1)
                    for (int j = k >> 1; j > 0; j >>= 1) {
                        for (int p = tid; p < (n >> 1); p += NTHR) { const int i = ((p & ~(j - 1)) << 1) | (p & (j - 1)); const int m = i | j;
                            const unsigned long long ka = keys[i], kb = keys[m]; const bool desc = ((i & k) == 0);
                            if ((ka < kb) == desc) { keys[i] = kb; keys[m] = ka; } }
                        __syncthreads();
                    }
                for (int r = tid; r < cap; r += NTHR) { const unsigned long long kk = keys[r]; const int row = e * MOE_PAD + (set ? 2048 + b * 32 + r : b * 512 + r);
                    const int tk_ = tokbase + (int)(0xFFFFFFFFu - (unsigned)(kk & 0xFFFFFFFFull)); ROWTOK[row] = tk_; ROWGATE[row] = __uint_as_float((unsigned)(kk >> 32)); INV[tk_ * 16 + e] = row; }
                for (int rb = 0; rb < cap; rb += 32) {
                    u32x4 t4[4][4];
#pragma unroll
                    for (int q = 0; q < 4; ++q) { const int r = rb + wave + 8 * q; const int tok = tokbase + (int)(0xFFFFFFFFu - (unsigned)(keys[r] & 0xFFFFFFFFull));
                        const u32x4* sp = (const u32x4*)(HB + (size_t)tok * DM);
#pragma unroll
                        for (int i = 0; i < 4; ++i) t4[q][i] = sp[i * 64 + lane]; }
#pragma unroll
                    for (int q = 0; q < 4; ++q) { const int r = rb + wave + 8 * q; const int row = e * MOE_PAD + (set ? 2048 + b * 32 + r : b * 512 + r);
                        u32x4* dp = (u32x4*)(XG + (size_t)row * DM);
#pragma unroll
                        for (int i = 0; i < 4; ++i) dp[i * 64 + lane] = t4[q][i]; } }
            }
            if (lastl && G > 64 && bid >= 64) {
                const int n_win = 32 * 55, n_br = 4 * 64, n_out = 32 * 8, n_glu = 16, n_gu = 16 * 2 * 192, n_d = 16 * 192;
                const int lo_d = n_win + n_br + n_out + n_glu + n_gu - 768;
                CV_RUN(l, lo_d + bid - 64, G - 64, lo_d + 768 + n_d);
            }
            if (!lastl && G > 128 && bid >= 128) {
                const int n_win = 32 * 55, n_br = 4 * 64, n_out = 32 * 8, n_glu = 16, n_gu = 16 * 2 * 192; (void)n_gu;
                CV_RUN(l + 1, bid - 128, G - 128, n_win); (void)n_br; (void)n_out; (void)n_glu;
            }
            {   const int pad0 = lastl ? 2048 : MOE_ROWS, npad = MOE_PAD - pad0;
                for (int R = bid * 8 + wave; R < NEXP * npad; R += G * 8) { const int e = R / npad, rr = pad0 + R % npad; u32x4* dp = (u32x4*)(XG + ((size_t)e * MOE_PAD + rr) * DM);
#pragma unroll
                    for (int i = 0; i < 4; ++i) dp[i * 64 + lane] = (u32x4){0u, 0u, 0u, 0u}; } }
            SEAM(PB + 10);
        }
        if (IN(PB + 12)) for (int rep_ = 0; rep_ < PROBE_REPS(12); ++rep_) {
            PH_BEGIN
            pg8::Gemm g{XG, WGU, DM, DM, DM}; pg8::SchedMoe S{lastl ? 8 : 9, 12, G, bid, DM, DM, 2 * DEXP}; pg8::EpiMoe1 E{HID};
            pg8::gemm_phase((LAS unsigned char*)shm, g, S, E);
            SEAM(PB + 12);
        }
        if (IN(PB + 13)) for (int rep_ = 0; rep_ < PROBE_REPS(13); ++rep_) {
            PH_BEGIN
            pg8::Gemm g{HID, WD, DEXP, DEXP, DEXP}; pg8::SchedMoe S{lastl ? 8 : 9, 8, G, bid, DEXP, DEXP, DM}; pg8::EpiMoeY E{YEXP};
            pg8::gemm_phase((LAS unsigned char*)shm, g, S, E);
            SEAM(PB + 13);
        }

}

__global__ __launch_bounds__(NTHR, 2) void fwd(Args a) {
    extern __shared__ __attribute__((aligned(16))) unsigned char shm[];
    const int bid = blockIdx.x, G = gridDim.x;
    float* const sf = (float*)shm;
    volatile LAS unsigned* xbw = (volatile LAS unsigned*)((LAS unsigned char*)shm + (LDS_BYTES - 16));
    if (threadIdx.x == 0) { xbw[0] = 0u; xbw[1] = 0u; xbw[2] = 0u; xbw[3] = 0u; }
    const float** const ptab = (const float**)(shm + (LDS_BYTES - 16 - 512));
    if (threadIdx.x == 0) {
#pragma unroll
        for (int i = 0; i < 47; ++i) ptab[i] = a.in[i]; }
    __syncthreads();
    XcdBarrier bar = xcd_barrier_post((unsigned*)(a.ws + O_BAR), xbw);
    const int lo = a.ph_lo, hi = a.ph_hi;
    if (IN(0)) {
        PH_BEGIN
        {
            __syncthreads();
            for (int i = tid; i < 5 * DM; i += NTHR) { const int r = i >> 11, k = i & (DM - 1); const float v = r < 4 ? c_in[r * DM + k] : cctx_in[k]; sf[i] = siluf_(v); }
            __syncthreads();
            float* red = sf + 5 * DM;
            for (int unit = bid; unit < 2 * 96; unit += G) { const int l = unit / 96, j = (unit % 96) * 128 + (tid & 127), kq = tid >> 7;
                const float* w = ada_w + (size_t)l * DM * (6 * DM) + (size_t)(kq * 512) * (6 * DM) + j; const float* sv = sf + kq * 512;
                float a0 = 0.f, a1 = 0.f, a2 = 0.f, a3 = 0.f, a4 = 0.f;
#pragma unroll 8
                for (int k = 0; k < 512; ++k) { const float wv = w[(size_t)k * (6 * DM)]; a0 += sv[k] * wv; a1 += sv[DM + k] * wv; a2 += sv[2 * DM + k] * wv; a3 += sv[3 * DM + k] * wv; a4 += sv[4 * DM + k] * wv; }
                __syncthreads();
                { float* rp = red + (kq * 5) * 128 + (tid & 127); rp[0] = a0; rp[128] = a1; rp[256] = a2; rp[384] = a3; rp[512] = a4; }
                __syncthreads();
                if (tid < 128) { const float bb = ada_b[l * 6 * DM + j]; float* o = MOD + (size_t)l * 5 * 6 * DM + j;
#pragma unroll
                    for (int r = 0; r < 5; ++r) o[(size_t)r * 6 * DM] = ((red[(0 * 5 + r) * 128 + tid] + red[(1 * 5 + r) * 128 + tid]) + (red[(2 * 5 + r) * 128 + tid] + red[(3 * 5 + r) * 128 + tid])) + bb; }
            }
        }
    }

    layer_body<0>(a, bar, lo, hi, bid, G, shm, sf, ptab);
    layer_body<1>(a, bar, lo, hi, bid, G, shm, sf, ptab);
    if (IN(33)) {
        PH_BEGIN
        const float* gn = PT(46);
        for (int tok = bid * 8 + wave; tok < NLAT; tok += G * 8) {
            const float* xr = XS + (size_t)tok * DM; float4 v[8]; float ss = 0.f;
#pragma unroll
            for (int i = 0; i < 8; ++i) v[i] = *(const float4*)(xr + i * 256 + lane * 4);
            moe_combine(v, tok, lane, INV, ROWGATE, YEXP, MOD + (size_t)(1 * 5 + tok / SEQ) * 6 * DM + 5 * DM);
#pragma unroll
            for (int i = 0; i < 8; ++i) {                 ss += v[i].x * v[i].x + v[i].y * v[i].y + v[i].z * v[i].z + v[i].w * v[i].w; }
            ss = wave_sum(ss); const float rs = rsqrtf(ss * (1.0f / DM) + 1e-6f);
#pragma unroll
            for (int i = 0; i < 8; ++i) { const int d = i * 256 + lane * 4; const float4 g4 = *(const float4*)(gn + d);
                *(float4*)(a.out + (size_t)tok * DM + d) = make_float4(v[i].x * rs * g4.x, v[i].y * rs * g4.y, v[i].z * rs * g4.z, v[i].w * rs * g4.w); }
        }
    }
#undef IN
#undef SEAM
}


extern "C" void kernel_launch(void* const* d_in, const int* in_sizes, int n_in, void* d_out, int out_size, void* d_ws, size_t ws_size, hipStream_t stream) {
    static int grid = 0;
    if (grid == 0) {
        if (n_in != 47 || ws_size < WS_END) { fprintf(stderr, "kernel_launch: expected 47 inputs and >= %zu bytes of workspace; got %d, %zu\n", (size_t)WS_END, n_in, ws_size); grid = -1; return; }
        int dev = 0, cus = 0;
        if (hipGetDevice(&dev) != hipSuccess || hipDeviceGetAttribute(&cus, hipDeviceAttributeMultiprocessorCount, dev) != hipSuccess) { grid = -1; return; }
        if (hipFuncSetAttribute((const void*)fwd, hipFuncAttributeMaxDynamicSharedMemorySize, LDS_BYTES) != hipSuccess) { fprintf(stderr, "kernel_launch: hipFuncSetAttribute failed\n"); grid = -1; return; }
        int per_cu = 0;
        if (hipOccupancyMaxActiveBlocksPerMultiprocessor(&per_cu, (const void*)fwd, NTHR, LDS_BYTES) != hipSuccess || per_cu < 1) fprintf(stderr, "kernel_launch: occupancy query reports %d\n", per_cu);
        (void)hipGetLastError();
        grid = cus > 256 ? 256 : cus;
        if (grid < 224) { fprintf(stderr, "kernel_launch: needs >= 224 CUs (got %d)\n", grid); grid = -1; return; }
    }
    if (grid < 0) return;
    (void)hipMemsetAsync((char*)d_ws, 0, O_ZERO_END, stream);
    Args a{};
    for (int i = 0; i < 47; ++i) a.in[i] = (const float*)d_in[i];
    a.out = (float*)d_out; a.ws = (unsigned char*)d_ws;
#if MK_ONE_LAUNCH
    a.ph_lo = 0; a.ph_hi = 64;
    hipLaunchKernelGGL(fwd, dim3(grid), dim3(NTHR), LDS_BYTES, stream, a);
#else
    const int ids[] = {0, 1,2,3,4,5,6,7,8,9,10,11,12,13,14, 17,18,19,20,21,22,23,24,25,26,27,28,29,30, 33};
    for (int k = 0; k < (int)(sizeof(ids) / sizeof(ids[0])); ++k) { a.ph_lo = ids[k]; a.ph_hi = ids[k] + 1; hipLaunchKernelGGL(fwd, dim3(grid), dim3(NTHR), LDS_BYTES, stream, a); }
#endif
}
```

```cpp
#include <hip/hip_runtime.h>
#include <stdint.h>
#include <stdio.h>

#ifndef PROBE_MASK
#define PROBE_MASK 0
#endif
#ifndef PROBE_SP
#define PROBE_SP 1
#endif
#define PROBE_REPS(k) ((((PROBE_MASK) >> (k)) & 1) + 1)
#ifndef MK_ONE_LAUNCH
#define MK_ONE_LAUNCH 1
#endif

#define DM 2048
#define NB 4
#define SEQ 4096
#define CTXL 256
#define BW 512
#define NLAT 16384
#define NCTX 1024
#define NTOK 17408
#define IN_W 13856
#define GATE2 5888
#define LDP 14080
#define HY_OFF 0
#define ML_OFF 1536
#define S5_OFF 3600
#define SSD_OFF 4112
#define GATE_OFF 5664
#define NEXP 16
#define DEXP 1536
#define MOE_ROWS 2176
#define MOE_PAD 2304
#define NTHR 512
#define LDS_BYTES 147456
#define LAS __attribute__((address_space(3)))

typedef unsigned short bf16_t;
typedef short bf16x8 __attribute__((ext_vector_type(8)));
typedef float f32x4 __attribute__((ext_vector_type(4)));
typedef unsigned u32x4 __attribute__((ext_vector_type(4)));
typedef unsigned u32x2 __attribute__((ext_vector_type(2)));

#define XB_TMO      128
#define XB_XCNT(j)  (256  + 64 * (j))
#define XB_XSUB(j)  (1280 + 64 * (j))
#define XB_XGEN(j)  (2304 + 64 * (j))
#define XB_TOP      3328
#define XB_TOPGEN   3392
#define XCD_BAR_WORDS 3456
#define XB_SPIN_CAP (1u << 18)
__device__ __forceinline__ unsigned xb_ld(unsigned* p)              { return __hip_atomic_load(p, __ATOMIC_RELAXED, __HIP_MEMORY_SCOPE_AGENT); }
__device__ __forceinline__ unsigned xb_add(unsigned* p, unsigned v) { return __hip_atomic_fetch_add(p, v, __ATOMIC_RELAXED, __HIP_MEMORY_SCOPE_AGENT); }
__device__ __forceinline__ unsigned xb_xcc_id() { return (unsigned)__builtin_amdgcn_s_getreg((3 << 11) | 20) & 0xFu; }
#define XB_SPIN(cond, bar) do { unsigned _sp = 0; while (cond) { __builtin_amdgcn_s_sleep(1); \
    if ((++_sp & 255u) == 0u) { if (xb_ld(&(bar)[XB_TMO])) break; if (_sp > XB_SPIN_CAP) { atomicAdd(&(bar)[XB_TMO], 1u); break; } } } } while (0)
struct XcdBarrier { unsigned* bar; unsigned x; volatile LAS unsigned* st; };
__device__ __forceinline__ XcdBarrier xcd_barrier_post(unsigned* bar, volatile LAS unsigned* st) {
    XcdBarrier b; b.bar = bar; b.x = xb_xcc_id(); b.st = st;
    if (threadIdx.x == 0) (void)xb_add(&bar[XB_XCNT(b.x)], 1u);
    return b;
}
__device__ __forceinline__ void xcd_barrier_complete(unsigned* bar, unsigned x, unsigned& nloc, unsigned& nx) {
    const unsigned G = gridDim.x * gridDim.y * gridDim.z;
    unsigned sum, cnt, mine, sp = 0u;
    for (;;) {
        sum = 0u; cnt = 0u; mine = 0u;
#pragma unroll
        for (unsigned j = 0; j < 16; ++j) { const unsigned c = xb_ld(&bar[XB_XCNT(j)]); sum += c; cnt += (c > 0u) ? 1u : 0u; mine = (j == x) ? c : mine; }
        if (sum == G) break;
        __builtin_amdgcn_s_sleep(1);
        if ((++sp & 255u) == 0u) { if (xb_ld(&bar[XB_TMO])) break; if (sp > XB_SPIN_CAP) { atomicAdd(&bar[XB_TMO], 1u); break; } }
    }
    nloc = mine > 0u ? mine : 1u; nx = cnt > 0u ? cnt : 1u;
}
__device__ __forceinline__ void xcd_barrier(const XcdBarrier& b) {
    asm volatile("s_waitcnt vmcnt(0)" ::: "memory");
    __syncthreads();
    if (threadIdx.x == 0) {
        unsigned* bar = b.bar;
        __builtin_amdgcn_s_waitcnt(0);
        unsigned nloc = b.st[0], nx = b.st[1];
        if (nloc == 0u) { xcd_barrier_complete(bar, b.x, nloc, nx); b.st[0] = nloc; b.st[1] = nx; }
        const unsigned old = xb_add(&bar[XB_XSUB(b.x)], 1u);
        const unsigned gen = old / nloc;
        if (old + 1u == (gen + 1u) * nloc) {
            __builtin_amdgcn_fence(__ATOMIC_RELEASE, "agent");
            asm volatile("s_waitcnt vmcnt(0)" ::: "memory");
            const unsigned og = xb_add(&bar[XB_TOP], 1u);
            const unsigned tg = og / nx;
            if (og + 1u == (tg + 1u) * nx) xb_add(&bar[XB_TOPGEN], 1u);
            else XB_SPIN(xb_ld(&bar[XB_TOPGEN]) == tg, bar);
            __builtin_amdgcn_fence(__ATOMIC_ACQUIRE, "agent");
            xb_add(&bar[XB_XGEN(b.x)], 1u);
            asm volatile("s_waitcnt vmcnt(0)" ::: "memory");
        } else {
            XB_SPIN(xb_ld(&bar[XB_XGEN(b.x)]) == gen, bar);
            __builtin_amdgcn_fence(__ATOMIC_ACQUIRE, "agent");
            asm volatile("s_waitcnt vmcnt(0)" ::: "memory");
        }
    }
    __syncthreads();
}

__device__ __forceinline__ unsigned short f2bf(float f) { unsigned u = __float_as_uint(f); u += 0x7FFFu + ((u >> 16) & 1u); return (unsigned short)(u >> 16); }
__device__ __forceinline__ float bf2f(unsigned short b) { return __uint_as_float(((unsigned)b) << 16); }
__device__ __forceinline__ unsigned pk2(float lo, float hi) { unsigned r; asm("v_cvt_pk_bf16_f32 %0, %1, %2" : "=v"(r) : "v"(lo), "v"(hi)); return r; }
__device__ __forceinline__ float sigmoidf_(float x) { return 1.0f / (1.0f + expf(-x)); }
__device__ __forceinline__ float siluf_(float x) { return x / (1.0f + expf(-x)); }
__device__ __forceinline__ float wave_sum(float v) {
#pragma unroll
    for (int o = 32; o >= 1; o >>= 1) v += __shfl_xor(v, o);
    return v;
}
__device__ __forceinline__ const float* uptr(const float* p) { const unsigned long long v = (unsigned long long)p;
    const unsigned lo = __builtin_amdgcn_readfirstlane((unsigned)v), hi = __builtin_amdgcn_readfirstlane((unsigned)(v >> 32)); return (const float*)(((unsigned long long)hi << 32) | lo); }
#define PT(k) uptr(ptab[k])
__device__ __forceinline__ int step_tok(int b, int dir, int i) {
    if (i < CTXL) { const int tt = dir ? (CTXL - 1 - i) : i; return NLAT + b * CTXL + tt; }
    const int j = i - CTXL; const int tt = dir ? (SEQ - 1 - j) : j; return b * SEQ + tt;
}
__device__ __forceinline__ void unpack8(const u32x4 w, float (&f)[8]) {
    f[0] = __uint_as_float(w.x << 16); f[1] = __uint_as_float(w.x & 0xFFFF0000u); f[2] = __uint_as_float(w.y << 16); f[3] = __uint_as_float(w.y & 0xFFFF0000u);
    f[4] = __uint_as_float(w.z << 16); f[5] = __uint_as_float(w.z & 0xFFFF0000u); f[6] = __uint_as_float(w.w << 16); f[7] = __uint_as_float(w.w & 0xFFFF0000u);
}

namespace pg8 {
constexpr int BM = 256, BK = 64, HALF = 128, HTB = HALF * BK * 2, STAGE_BYTES = 8 * HTB, NXCD = 8, WGM = 8;
__host__ __device__ __forceinline__ int lds_byte(int r, int c) { const int st = (r >> 4) * 2 + (c >> 5), rr = r & 15, cc = c & 31, ob = rr * 64 + cc * 2; return st * 1024 + (ob ^ (((ob >> 9) & 1) << 5)); }
__host__ __device__ __forceinline__ void stage_rc(int b, int& R, int& C) { const int st = b / 1024, sb = b % 1024, swz = sb ^ (((sb >> 9) & 1) << 5); R = (st >> 1) * 16 + swz / 64; C = (st & 1) * 32 + (swz % 64) / 2; }
__host__ __device__ __forceinline__ int perm32(int rho) { const int n = rho >> 4, i = rho & 15; return 8 * (i >> 2) + 4 * n + (i & 3); }
struct Unit { int pm, pn, z, k; long long ao, bo; };
struct Gemm { const bf16_t* A; const bf16_t* Bt; int lda, ldb, K; };

__device__ __forceinline__ void tile_of(int wgid, int nM, int nN, int& pm, int& pn) {
    const int nwg = nM * nN; { const int q = nwg / NXCD, r = nwg % NXCD, xcd = wgid % NXCD, off = wgid / NXCD; wgid = (xcd < r ? xcd * (q + 1) : r * (q + 1) + (xcd - r) * q) + off; }
    const int nig = WGM * nN, gid = wgid / nig, fm = gid * WGM, gsz = (nM - fm) < WGM ? (nM - fm) : WGM;
    pm = fm + ((wgid % nig) % gsz); pn = (wgid % nig) / gsz;
}
struct SchedStd {
    int nM, nN, G, c, lda, ldb;
    __device__ __forceinline__ bool next(int i, Unit& u) const { const long L = (long)i * G + c; if (L >= (long)nM * nN) return false; tile_of((int)L, nM, nN, u.pm, u.pn); u.z = 0; u.k = 0;
        u.ao = (long long)u.pm * BM * lda * 2; u.bo = (long long)u.pn * BM * ldb * 2; return true; }
    __device__ __forceinline__ void a_ready(const Unit&) const {}
    __device__ __forceinline__ void done(const Unit&) const {}
};
struct SchedBranch {
    int nM, nN, G, c;
    __device__ __forceinline__ bool next(int i, Unit& u) const { const long L = (long)(i >> 2) * G + c; if (L >= (long)nM * nN) return false; tile_of((int)L, nM, nN, u.pm, u.pn); u.z = 0; u.k = i & 3;
        u.ao = ((long long)u.pm * BM * DM + u.k * BW) * 2; u.bo = ((long long)u.k * DM + u.pn * BM) * BW * 2; return true; }
    __device__ __forceinline__ void a_ready(const Unit&) const {}
    __device__ __forceinline__ void done(const Unit&) const {}
};
struct SchedTail {
    int G, c;
    __device__ __forceinline__ bool next(int i, Unit& u) const { const long T = (long)i * G + c; if (T >= 128) return false; const int t = (int)(T >> 2); u.pm = 64 + (t >> 3); u.pn = t & 7; u.z = 1; u.k = (int)(T & 3);
        u.ao = ((long long)u.pm * BM * DM + u.k * BW) * 2; u.bo = ((long long)u.k * DM + u.pn * BM) * BW * 2; return true; }
    __device__ __forceinline__ void a_ready(const Unit&) const {}
    __device__ __forceinline__ void done(const Unit&) const {}
};
struct SchedTailK {
    int G, c;
    __device__ __forceinline__ bool next(int i, Unit& u) const { const long T = (long)i * G + c; if (T >= 128) return false; const int t = (int)(T >> 2); u.pm = 64 + (t >> 3); u.pn = t & 7; u.z = 1; u.k = (int)(T & 3);
        u.ao = ((long long)u.pm * BM * DM + u.k * 512) * 2; u.bo = ((long long)u.pn * BM * DM + u.k * 512) * 2; return true; }
    __device__ __forceinline__ void a_ready(const Unit&) const {}
    __device__ __forceinline__ void done(const Unit&) const {}
};
struct SchedMoe {
    int nPm, nPn, G, c, lda, ldb, nBrows;
    __device__ __forceinline__ bool next(int i, Unit& u) const { const long L = (long)i * G + c; const int per = nPm * nPn; if (L >= (long)NEXP * per) return false; const int e = (int)(L / per), rem = (int)(L % per);
        u.z = e; u.k = 0; u.pm = rem % nPm; u.pn = rem / nPm; u.ao = ((long long)e * MOE_PAD + u.pm * BM) * lda * 2; u.bo = ((long long)e * nBrows + u.pn * BM) * ldb * 2; return true; }
    __device__ __forceinline__ void a_ready(const Unit&) const {}
    __device__ __forceinline__ void done(const Unit&) const {}
};

typedef f32x4 Acc[2][2][4][2];
template <class Epi, class Sched>
__device__ __forceinline__ void gemm_phase(LAS unsigned char* lds, const Gemm g, const Sched& S, const Epi& E) {
    int tid = threadIdx.x; asm volatile("" : "+v"(tid));
    const int wid = __builtin_amdgcn_readfirstlane(tid >> 6), lane = tid & 63, wr = wid >> 2, wc = wid & 3, fr = lane & 15, fq = lane >> 4;
    const int K = g.K, nt = K / BK;
    unsigned voffA[2], voffB[2];
#pragma unroll
    for (int i = 0; i < 2; ++i) { int R, C; stage_rc(tid * 16 + i * 8192, R, C); const int Rb = Epi::PERM ? ((R & ~31) + perm32(R & 31)) : R;
        voffA[i] = (unsigned)(R * g.lda + C) * 2u; voffB[i] = (unsigned)(Rb * g.ldb + C) * 2u; }
    const size_t kstep = (size_t)(BK * 2);
    const size_t hstepA = (size_t)HALF * g.lda * 2, hstepB = (size_t)HALF * g.ldb * 2;
    const unsigned ldsw = (unsigned)wid * 1024u;
    const int aoff = lds_byte(wr * 64 + fr, fq * 8), boff = lds_byte(wc * 32 + fr, fq * 8);
#define PG8_SA(b, h) (((b) * 2 + (h)) * HTB)
#define PG8_SB(b, h) ((4 + (b) * 2 + (h)) * HTB)
#define PG8_STAGE(bufoff, gbase, voff) do { _Pragma("unroll") for (int _i = 0; _i < 2; ++_i) \
        __builtin_amdgcn_global_load_lds((const unsigned*)((const char*)(gbase) + (voff)[_i]), (LAS unsigned*)(lds + (bufoff) + ldsw + _i * 8192), 16, 0, 0); } while (0)
#define PG8_LDA(dst, b, h) do { _Pragma("unroll") for (int m = 0; m < 4; ++m) _Pragma("unroll") for (int k = 0; k < 2; ++k) dst[m][k] = *(const LAS bf16x8*)(lds + PG8_SA(b, h) + aoff + m * 2048 + k * 1024); } while (0)
#define PG8_LDB(dst, b, h) do { _Pragma("unroll") for (int n = 0; n < 2; ++n) _Pragma("unroll") for (int k = 0; k < 2; ++k) dst[n][k] = *(const LAS bf16x8*)(lds + PG8_SB(b, h) + boff + n * 2048 + k * 1024); } while (0)
#define PG8_MMA(ai, bj, At, Bt) do { __builtin_amdgcn_s_setprio(1); _Pragma("unroll") for (int m = 0; m < 4; ++m) _Pragma("unroll") for (int n = 0; n < 2; ++n) _Pragma("unroll") for (int k = 0; k < 2; ++k) \
        acc[ai][bj][m][n] = __builtin_amdgcn_mfma_f32_16x16x32_bf16(Bt[n][k], At[m][k], acc[ai][bj][m][n], 0, 0, 0); __builtin_amdgcn_s_setprio(0); } while (0)
#define PG8_WAIT_V(n) asm volatile("s_waitcnt vmcnt(" #n ")" ::: "memory")
#define PG8_WAIT_L(n) asm volatile("s_waitcnt lgkmcnt(" #n ")" ::: "memory")
#define PG8_BAR __builtin_amdgcn_s_barrier()
#define PG8_SCHED __builtin_amdgcn_sched_barrier(0)
    Unit cur, nxt; int ui = 0;
    if (!S.next(0, cur)) return;
    Acc acc;
#pragma unroll
    for (int a = 0; a < 2; ++a)
#pragma unroll
        for (int b = 0; b < 2; ++b)
#pragma unroll
            for (int m = 0; m < 4; ++m)
#pragma unroll
                for (int n = 0; n < 2; ++n) acc[a][b][m][n] = (f32x4){0.f, 0.f, 0.f, 0.f};
    bf16x8 At[4][2], B0[2][2], B1[2][2];
    const char* cA = (const char*)g.A + cur.ao; const char* cB = (const char*)g.Bt + cur.bo;
    S.a_ready(cur);
    PG8_STAGE(PG8_SB(0, 0), cB, voffB); PG8_STAGE(PG8_SA(0, 0), cA, voffA); PG8_STAGE(PG8_SB(0, 1), cB + hstepB, voffB); PG8_STAGE(PG8_SA(0, 1), cA + hstepA, voffA);
    if (wr == 1) PG8_BAR;
    PG8_WAIT_V(4); PG8_BAR;
    PG8_STAGE(PG8_SB(1, 0), cB + kstep, voffB); PG8_STAGE(PG8_SA(1, 0), cA + kstep, voffA); PG8_STAGE(PG8_SB(1, 1), cB + hstepB + kstep, voffB);
    PG8_WAIT_V(6); PG8_BAR;
    for (;;) {
        const bool has_next = S.next(ui + 1, nxt);
        const char* nA = has_next ? (const char*)g.A + nxt.ao : cA; const char* nB = has_next ? (const char*)g.Bt + nxt.bo : cB;
        for (int t = 0; t < nt; t += 2) {
            const bool last = (t == nt - 2);
            const char* a1 = cA + (size_t)(t + 1) * kstep;
            const char* a2 = last ? nA : cA + (size_t)(t + 2) * kstep; const char* b2 = last ? nB : cB + (size_t)(t + 2) * kstep;
            const char* a3 = a2 + kstep; const char* b3 = b2 + kstep;
            if (last && has_next) S.a_ready(nxt);
            PG8_LDB(B0, 0, 0); PG8_SCHED; PG8_LDA(At, 0, 0); PG8_STAGE(PG8_SA(1, 1), a1 + hstepA, voffA);
            PG8_WAIT_L(8); PG8_BAR; PG8_WAIT_L(0); PG8_MMA(0, 0, At, B0); PG8_BAR; PG8_SCHED;
            PG8_LDB(B1, 0, 1); PG8_STAGE(PG8_SB(0, 0), b2, voffB);
            PG8_BAR; PG8_WAIT_L(0); PG8_MMA(0, 1, At, B1); PG8_BAR;
            PG8_LDA(At, 0, 1); PG8_STAGE(PG8_SA(0, 0), a2, voffA);
            PG8_BAR; PG8_WAIT_L(0); PG8_MMA(1, 0, At, B0); PG8_BAR; PG8_SCHED;
            PG8_STAGE(PG8_SB(0, 1), b2 + hstepB, voffB);
            PG8_WAIT_V(6); PG8_BAR; PG8_MMA(1, 1, At, B1); PG8_BAR;
            PG8_LDB(B0, 1, 0); PG8_SCHED; PG8_LDA(At, 1, 0); PG8_STAGE(PG8_SA(0, 1), a2 + hstepA, voffA);
            PG8_WAIT_L(8); PG8_BAR; PG8_WAIT_L(0); PG8_MMA(0, 0, At, B0); PG8_BAR; PG8_SCHED;
            PG8_LDB(B1, 1, 1); PG8_STAGE(PG8_SB(1, 0), b3, voffB);
            PG8_BAR; PG8_WAIT_L(0); PG8_MMA(0, 1, At, B1); PG8_BAR;
            PG8_LDA(At, 1, 1); PG8_STAGE(PG8_SA(1, 0), a3, voffA);
            PG8_BAR; PG8_WAIT_L(0); PG8_MMA(1, 0, At, B0); PG8_BAR; PG8_SCHED;
            PG8_STAGE(PG8_SB(1, 1), b3 + hstepB, voffB);
            PG8_WAIT_V(6); PG8_BAR; PG8_MMA(1, 1, At, B1); PG8_BAR;
        }
        const bool keep = E(acc, cur, wr, wc, fr, fq); S.done(cur);
        if (!has_next) break;
        if (!keep) {
#pragma unroll
        for (int a = 0; a < 2; ++a)
#pragma unroll
            for (int b = 0; b < 2; ++b)
#pragma unroll
                for (int m = 0; m < 4; ++m)
#pragma unroll
                    for (int n = 0; n < 2; ++n) acc[a][b][m][n] = (f32x4){0.f, 0.f, 0.f, 0.f};
        }
        cur = nxt; cA = nA; cB = nB; ++ui;
    }
    PG8_WAIT_V(0);
    if (wr == 0) PG8_BAR;
    PG8_BAR;
#undef PG8_SA
#undef PG8_SB
#undef PG8_STAGE
#undef PG8_LDA
#undef PG8_LDB
#undef PG8_MMA
#undef PG8_WAIT_V
#undef PG8_WAIT_L
#undef PG8_BAR
#undef PG8_SCHED
}

struct EpiBf16Store {
    static constexpr bool PERM = true;
    bf16_t* O; int ldc;
    __device__ __forceinline__ bool operator()(Acc& acc, const Unit& u, int wr, int wc, int fr, int fq) const {
        const int row0 = u.pm * BM + wr * 64 + fr, col0 = u.pn * BM + wc * 32 + 8 * fq;
#pragma unroll
        for (int ai = 0; ai < 2; ++ai)
#pragma unroll
            for (int m = 0; m < 4; ++m) { bf16_t* rowp = O + (size_t)(row0 + ai * HALF + m * 16) * ldc + col0;
#pragma unroll
                for (int bj = 0; bj < 2; ++bj) { const f32x4 v0 = acc[ai][bj][m][0], v1 = acc[ai][bj][m][1];
                    u32x4 w; w.x = pk2(v0[0], v0[1]); w.y = pk2(v0[2], v0[3]); w.z = pk2(v1[0], v1[1]); w.w = pk2(v1[2], v1[3]);
                    *(u32x4*)(rowp + bj * HALF) = w; } }
        return false;
    }
};
struct EpiWin {
    static constexpr bool PERM = true;
    bf16_t* O; int ldc;
    __device__ __forceinline__ bool operator()(Acc& acc, const Unit& u, int wr, int wc, int fr, int fq) const {
        const int row0 = u.pm * BM + wr * 64 + fr;
        if (u.pn < 23) { const int col0 = u.pn * BM + wc * 32 + 8 * fq;
#pragma unroll
            for (int ai = 0; ai < 2; ++ai)
#pragma unroll
                for (int m = 0; m < 4; ++m)
#pragma unroll
                    for (int bj = 0; bj < 2; ++bj) { const f32x4 v0 = acc[ai][bj][m][0], v1 = acc[ai][bj][m][1];
                        u32x4 w; w.x = pk2(v0[0], v0[1]); w.y = pk2(v0[2], v0[3]); w.z = pk2(v1[0], v1[1]); w.w = pk2(v1[2], v1[3]);
                        *(u32x4*)(O + (size_t)(row0 + ai * HALF + m * 16) * ldc + col0 + bj * HALF) = w; }
        } else { const int colb = GATE2 + 64 * (u.pn - 23) + 16 * wc + 4 * fq;
#pragma unroll
            for (int ai = 0; ai < 2; ++ai)
#pragma unroll
                for (int m = 0; m < 4; ++m) { f32x4 sg[4];
#pragma unroll
                    for (int bj = 0; bj < 2; ++bj)
#pragma unroll
                        for (int n = 0; n < 2; ++n) { const f32x4 v = acc[ai][bj][m][n];
#pragma unroll
                            for (int j = 0; j < 4; ++j) sg[2 * bj + n][j] = __builtin_amdgcn_rcpf(1.0f + __expf(-v[j])); }
                    bf16_t* op = O + (size_t)(row0 + ai * HALF + m * 16) * ldc + colb;
#pragma unroll
                    for (int k = 0; k < 4; ++k) { f32x4 r = sg[k];
                        if (k < 3) {
#pragma unroll
                            for (int j = 0; j < 4; ++j) r[j] *= __builtin_amdgcn_rcpf(sg[k + 1][j]); }
                        u32x2 w; w.x = pk2(r[0], r[1]); w.y = pk2(r[2], r[3]); *(u32x2*)(op + k * DM) = w; } }
        }
        return false;
    }
};
struct EpiNone { static constexpr bool PERM = true;
    __device__ __forceinline__ bool operator()(Acc& acc, const Unit&, int, int, int, int) const {
#pragma unroll
        for (int a = 0; a < 2; ++a)
#pragma unroll
            for (int b = 0; b < 2; ++b)
#pragma unroll
                for (int m = 0; m < 4; ++m)
#pragma unroll
                    for (int n = 0; n < 2; ++n) asm volatile("" :: "v"(acc[a][b][m][n]));
        return false; } };
struct EpiGlu {
    static constexpr bool PERM = true;
    const bf16_t* GG; const float* bias; bf16_t* Y4;
    __device__ __forceinline__ bool operator()(Acc& acc, const Unit& u, int wr, int wc, int fr, int fq) const {
        const int row0 = u.pm * BM + wr * 64 + fr, col0 = u.pn * BM + wc * 32 + 8 * fq;
#pragma unroll
        for (int bj = 0; bj < 2; ++bj) { const int col = col0 + bj * HALF; const f32x4 b0 = *(const f32x4*)(bias + col), b1 = *(const f32x4*)(bias + col + 4);
            u32x4 gq[2][4];
#pragma unroll
            for (int ai = 0; ai < 2; ++ai)
#pragma unroll
                for (int m = 0; m < 4; ++m) gq[ai][m] = *(const u32x4*)(GG + (size_t)(row0 + ai * HALF + m * 16) * BW + col);
#pragma unroll
            for (int ai = 0; ai < 2; ++ai)
#pragma unroll
                for (int m = 0; m < 4; ++m) { const size_t row = (size_t)(row0 + ai * HALF + m * 16);
                    float gg[8]; unpack8(gq[ai][m], gg);
                    const f32x4 v0 = acc[ai][bj][m][0] + b0, v1 = acc[ai][bj][m][1] + b1;
                    u32x4 w; w.x = pk2(gg[0] * sigmoidf_(v0[0]), gg[1] * sigmoidf_(v0[1])); w.y = pk2(gg[2] * sigmoidf_(v0[2]), gg[3] * sigmoidf_(v0[3]));
                    w.z = pk2(gg[4] * sigmoidf_(v1[0]), gg[5] * sigmoidf_(v1[1])); w.w = pk2(gg[6] * sigmoidf_(v1[2]), gg[7] * sigmoidf_(v1[3]));
                    *(u32x4*)(Y4 + row * DM + 1024 + col) = w; } }
        return false;
    }
};
struct EpiBranch {
    static constexpr bool PERM = true;
    const bf16_t* P; bf16_t* ACCb;
    __device__ __forceinline__ bool operator()(Acc& acc, const Unit& u, int wr, int wc, int fr, int fq) const {
        const int row0 = u.pm * BM + wr * 64 + fr, col0 = u.pn * BM + wc * 32 + 8 * fq; const int k = u.k;
        const bf16_t* gbase = P + (size_t)row0 * LDP + GATE2 + k * DM + col0;
#pragma unroll
        for (int ai = 0; ai < 2; ++ai) {
            u32x4 ga[8];
#pragma unroll
            for (int m = 0; m < 4; ++m)
#pragma unroll
                for (int bj = 0; bj < 2; ++bj) ga[m * 2 + bj] = *(const u32x4*)(gbase + (size_t)(ai * HALF + m * 16) * LDP + bj * HALF);
#pragma unroll
            for (int m = 0; m < 4; ++m)
#pragma unroll
                for (int bj = 0; bj < 2; ++bj) { float sr[8]; unpack8(ga[m * 2 + bj], sr);
                    f32x4 v0 = acc[ai][bj][m][0], v1 = acc[ai][bj][m][1];
                    v0[0] *= sr[0]; v0[1] *= sr[1]; v0[2] *= sr[2]; v0[3] *= sr[3]; v1[0] *= sr[4]; v1[1] *= sr[5]; v1[2] *= sr[6]; v1[3] *= sr[7];
                    if (k < 3) { acc[ai][bj][m][0] = v0; acc[ai][bj][m][1] = v1; }
                    else { u32x4 w; w.x = pk2(v0[0], v0[1]); w.y = pk2(v0[2], v0[3]); w.z = pk2(v1[0], v1[1]); w.w = pk2(v1[2], v1[3]); *(u32x4*)(ACCb + (size_t)(row0 + ai * HALF + m * 16) * DM + col0 + bj * HALF) = w; } } }
        return k < 3;
    }
};
struct EpiPartK {
    static constexpr bool PERM = true;
    float* PART;
    __device__ __forceinline__ bool operator()(Acc& acc, const Unit& u, int wr, int wc, int fr, int fq) const {
        const int row0 = u.pm * BM + wr * 64 + fr, col0 = u.pn * BM + wc * 32 + 8 * fq;
        float* pbase = PART + ((size_t)u.k * (NTOK - NLAT) + (size_t)(row0 - NLAT)) * DM + col0;
#pragma unroll
        for (int ai = 0; ai < 2; ++ai)
#pragma unroll
            for (int m = 0; m < 4; ++m)
#pragma unroll
                for (int bj = 0; bj < 2; ++bj) { float* pp = pbase + (size_t)(ai * HALF + m * 16) * DM + bj * HALF; *(f32x4*)pp = acc[ai][bj][m][0]; *(f32x4*)(pp + 4) = acc[ai][bj][m][1]; }
        return false;
    }
};
struct EpiResid {
    static constexpr bool PERM = false;
    float* XS; const float* srcLat; const float* srcCtx; const float* MODl; int gidx;
    __device__ __forceinline__ bool operator()(Acc& acc, const Unit& u, int wr, int wc, int fr, int fq) const {
        const int row0 = u.pm * BM + wr * 64 + fr, col0 = u.pn * BM + wc * 32 + 4 * fq;
        const int r = (u.pm * BM) < NLAT ? (u.pm * BM) / SEQ : 4;
        const float* src = (u.pm * BM) < NLAT ? srcLat : srcCtx;
        const float* mg = MODl + (size_t)(r * 6 + gidx) * DM;
#pragma unroll
        for (int bj = 0; bj < 2; ++bj) {
            f32x4 gm[2], xs[2][2][4];
#pragma unroll
            for (int n = 0; n < 2; ++n) { const int col = col0 + bj * HALF + n * 16; gm[n] = *(const f32x4*)(mg + col);
#pragma unroll
                for (int ai = 0; ai < 2; ++ai)
#pragma unroll
                    for (int m = 0; m < 4; ++m) xs[n][ai][m] = *(const f32x4*)(src + (size_t)(row0 + ai * HALF + m * 16) * DM + col); }
#pragma unroll
            for (int n = 0; n < 2; ++n) { const int col = col0 + bj * HALF + n * 16;
#pragma unroll
                for (int ai = 0; ai < 2; ++ai)
#pragma unroll
                    for (int m = 0; m < 4; ++m) *(f32x4*)(XS + (size_t)(row0 + ai * HALF + m * 16) * DM + col) = xs[n][ai][m] + gm[n] * acc[ai][bj][m][n]; } }
        return false;
    }
};
struct EpiMoe1 {
    static constexpr bool PERM = true;
    bf16_t* HID;
    __device__ __forceinline__ bool operator()(Acc& acc, const Unit& u, int wr, int wc, int fr, int fq) const {
        const size_t row0 = (size_t)u.z * MOE_PAD + u.pm * BM + wr * 64 + fr; const int col0 = u.pn * HALF + wc * 32 + 8 * fq;
#pragma unroll
        for (int ai = 0; ai < 2; ++ai)
#pragma unroll
            for (int m = 0; m < 4; ++m) { const f32x4 g0 = acc[ai][0][m][0], g1 = acc[ai][0][m][1], u0 = acc[ai][1][m][0], u1 = acc[ai][1][m][1];
                float h[8];
#pragma unroll
                for (int j = 0; j < 4; ++j) { h[j] = g0[j] * __builtin_amdgcn_rcpf(1.0f + __expf(-g0[j])) * u0[j]; h[4 + j] = g1[j] * __builtin_amdgcn_rcpf(1.0f + __expf(-g1[j])) * u1[j]; }
                u32x4 w; w.x = pk2(h[0], h[1]); w.y = pk2(h[2], h[3]); w.z = pk2(h[4], h[5]); w.w = pk2(h[6], h[7]);
                *(u32x4*)(HID + (row0 + ai * HALF + m * 16) * DEXP + col0) = w; }
        return false;
    }
};
struct EpiMoeY {
    static constexpr bool PERM = true;
    bf16_t* O;
    __device__ __forceinline__ bool operator()(Acc& acc, const Unit& u, int wr, int wc, int fr, int fq) const {
        const size_t row0 = (size_t)u.z * MOE_PAD + u.pm * BM + wr * 64 + fr; const int col0 = u.pn * BM + wc * 32 + 8 * fq;
#pragma unroll
        for (int ai = 0; ai < 2; ++ai)
#pragma unroll
            for (int m = 0; m < 4; ++m) { bf16_t* rowp = O + (row0 + ai * HALF + m * 16) * DM + col0;
#pragma unroll
                for (int bj = 0; bj < 2; ++bj) { const f32x4 v0 = acc[ai][bj][m][0], v1 = acc[ai][bj][m][1];
                    u32x4 w; w.x = pk2(v0[0], v0[1]); w.y = pk2(v0[2], v0[3]); w.z = pk2(v1[0], v1[1]); w.w = pk2(v1[2], v1[3]);
                    *(u32x4*)(rowp + bj * HALF) = w; } }
        return false;
    }
};

struct SchedS5a {
    int c;
    __device__ __forceinline__ bool next(int i, Unit& u) const { if (i > 0 || c >= 64) return false; u.z = c >> 1; u.pm = c & 1; u.pn = 0; u.k = 0;
        u.ao = ((long long)u.z * 512 + u.pm * BM) * 768 * 2; u.bo = (long long)u.z * 256 * 512 * 2; return true; }
    __device__ __forceinline__ void a_ready(const Unit&) const {}
    __device__ __forceinline__ void done(const Unit&) const {}
};
struct SchedS5b {
    int c;
    __device__ __forceinline__ bool next(int i, Unit& u) const { if (i > 0 || c >= 128) return false; u.z = c >> 2; u.pm = (c >> 1) & 1; u.pn = c & 1; u.k = 0;
        u.ao = ((long long)u.z * 512 + u.pm * BM) * 768 * 2; u.bo = ((long long)u.z * 512 + u.pn * BM) * 768 * 2; return true; }
    __device__ __forceinline__ void a_ready(const Unit&) const {}
    __device__ __forceinline__ void done(const Unit&) const {}
};
struct EpiXloc {
    static constexpr bool PERM = false;
    float* XL;
    __device__ __forceinline__ bool operator()(Acc& acc, const Unit& u, int wr, int wc, int fr, int fq) const {
        const int row0 = u.pm * BM + wr * 64 + fr, col0 = wc * 32 + 4 * fq; float* base = XL + (size_t)u.z * 512 * 256;
#pragma unroll
        for (int ai = 0; ai < 2; ++ai)
#pragma unroll
            for (int m = 0; m < 4; ++m) { float* rowp = base + (size_t)(row0 + ai * HALF + m * 16) * 256 + col0;
#pragma unroll
                for (int bj = 0; bj < 2; ++bj)
#pragma unroll
                    for (int n = 0; n < 2; ++n) *(f32x4*)(rowp + bj * HALF + n * 16) = acc[ai][bj][m][n]; }
        return false;
    }
};
struct EpiS5Out {
    static constexpr bool PERM = true;
    const bf16_t* P; const float* dskip; bf16_t* GG;
    __device__ __forceinline__ bool operator()(Acc& acc, const Unit& u, int wr, int wc, int fr, int fq) const {
        const int row0 = u.pm * BM + wr * 64 + fr, col0 = u.pn * BM + wc * 32 + 8 * fq; const int g = u.z;
#pragma unroll
        for (int bj = 0; bj < 2; ++bj) { const int col = col0 + bj * HALF; const int t = col >> 4, c0 = col & 15;
            const f32x4 d0 = *(const f32x4*)(dskip + g * 16 + c0), d1 = *(const f32x4*)(dskip + g * 16 + c0 + 4);
            u32x4 uq[2][4];
#pragma unroll
            for (int ai = 0; ai < 2; ++ai)
#pragma unroll
                for (int m = 0; m < 4; ++m) uq[ai][m] = *(const u32x4*)(P + ((size_t)(row0 + ai * HALF + m * 16) * 32 + t) * LDP + S5_OFF + g * 16 + c0);
#pragma unroll
            for (int ai = 0; ai < 2; ++ai)
#pragma unroll
                for (int m = 0; m < 4; ++m) { const size_t tok = (size_t)(row0 + ai * HALF + m * 16) * 32 + t;
                    float uu[8]; unpack8(uq[ai][m], uu);
                    const f32x4 v0 = acc[ai][bj][m][0], v1 = acc[ai][bj][m][1];
                    float y[8] = {v0[0] + d0[0] * uu[0], v0[1] + d0[1] * uu[1], v0[2] + d0[2] * uu[2], v0[3] + d0[3] * uu[3], v1[0] + d1[0] * uu[4], v1[1] + d1[1] * uu[5], v1[2] + d1[2] * uu[6], v1[3] + d1[3] * uu[7]};
#pragma unroll
                    for (int j = 0; j < 8; ++j) y[j] = 0.5f * y[j] * (1.0f + tanhf(0.7978845608028654f * (y[j] + 0.044715f * y[j] * y[j] * y[j])));
                    u32x4 w; w.x = pk2(y[0], y[1]); w.y = pk2(y[2], y[3]); w.z = pk2(y[4], y[5]); w.w = pk2(y[6], y[7]);
                    *(u32x4*)(GG + tok * BW + g * 16 + c0) = w; } }
        return false;
    }
};
}


__device__ __forceinline__ float wave_scan_incl(float v, int lane) {
#pragma unroll
    for (int o = 1; o < 64; o <<= 1) { const float t = __shfl_up(v, o); if (lane >= o) v += t; }
    return v;
}
__device__ __forceinline__ float wave_scanmax_incl(float v, int lane) {
#pragma unroll
    for (int o = 1; o < 64; o <<= 1) { const float t = __shfl_up(v, o); if (lane >= o) v = fmaxf(v, t); }
    return v;
}
__device__ __forceinline__ float wave_max(float v) {
#pragma unroll
    for (int o = 32; o >= 1; o >>= 1) v = fmaxf(v, __shfl_xor(v, o));
    return v;
}
__device__ __forceinline__ void unpack8h(const u32x4 w, bf16_t (&h)[8]) {
    h[0] = (bf16_t)(w.x & 0xFFFFu); h[1] = (bf16_t)(w.x >> 16); h[2] = (bf16_t)(w.y & 0xFFFFu); h[3] = (bf16_t)(w.y >> 16);
    h[4] = (bf16_t)(w.z & 0xFFFFu); h[5] = (bf16_t)(w.z >> 16); h[6] = (bf16_t)(w.w & 0xFFFFu); h[7] = (bf16_t)(w.w >> 16);
}

__device__ __forceinline__ int tokblock_of(int b, int dir, int c) { if (c < 4) return 256 + b * 4 + (dir ? 3 - c : c); const int j = c - 4; return b * 64 + (dir ? 63 - j : j); }
__device__ __forceinline__ u32x4 rev8h(const u32x4 v) { u32x4 r; r.x = (v.w >> 16) | (v.w << 16); r.y = (v.z >> 16) | (v.z << 16); r.z = (v.y >> 16) | (v.y << 16); r.w = (v.x >> 16) | (v.x << 16); return r; }
__device__ __forceinline__ u32x4 scale8h(const u32x4 v, const float4 a, const float4 b) { float f[8]; unpack8(v, f); u32x4 r; r.x = pk2(f[0] * a.x, f[1] * a.y); r.y = pk2(f[2] * a.z, f[3] * a.w); r.z = pk2(f[4] * b.x, f[5] * b.y); r.w = pk2(f[6] * b.z, f[7] * b.w); return r; }
__device__ __forceinline__ float dot8h(const u32x4 v, const float4 a, const float4 b) { float f[8]; unpack8(v, f); return (f[0] * a.x + f[1] * a.y) + (f[2] * a.z + f[3] * a.w) + (f[4] * b.x + f[5] * b.y) + (f[6] * b.z + f[7] * b.w); }
#define ML_FRAG_LOAD(KF, VF, cc_) do { const int tb_ = tokblock_of(b, dir, (cc_)); const bf16_t* kb_ = KTg + ((size_t)tb_ * 512 + h * 128 + 32 * wd + r16) * 64 + q4 * 8; const bf16_t* vb_ = VTg + ((size_t)tb_ * 512 + h * 128 + 64 * half + 32 * we + r16) * 64 + q4 * 8; \
        _Pragma("unroll") for (int ks_ = 0; ks_ < 2; ++ks_) _Pragma("unroll") for (int j_ = 0; j_ < 2; ++j_) { VF[j_][ks_] = *(const u32x4*)(vb_ + (size_t)j_ * 16 * 64 + ks_ * 32); KF[j_][ks_] = *(const u32x4*)(kb_ + (size_t)j_ * 16 * 64 + ks_ * 32); } } while (0)
#define ML_CHUNK(c_, KF, VF, KFN, VFN) do { const int c = (c_); \
        if (c + 1 < 68) ML_FRAG_LOAD(KFN, VFN, c + 1);                        \
        const float dec = sDEC[c]; \
        {   bf16_t* cs = CST + (size_t)(chain * 68 + c) * 128 * 128; \
            _Pragma("unroll") for (int je = 0; je < 2; ++je) _Pragma("unroll") for (int jd = 0; jd < 2; ++jd) { const int e = 64 * half + 32 * we + 16 * je + r16, d0 = 32 * wd + 16 * jd + q4 * 4; \
                u32x2 pk; pk.x = pk2(acc[je][jd][0], acc[je][jd][1]); pk.y = pk2(acc[je][jd][2], acc[je][jd][3]); *(u32x2*)(cs + (size_t)e * 128 + d0) = pk; } \
            if (nown) { _Pragma("unroll") for (int jd = 0; jd < 2; ++jd) { float nv = npart[jd]; nv += __shfl_xor(nv, 16); nv += __shfl_xor(nv, 32); if (q4 == 0) NST[(size_t)(chain * 68 + c) * 128 + 32 * wd + 16 * jd + r16] = nv; } } } \
        bf16x8 vfr[2][2]; \
        _Pragma("unroll") for (int ks = 0; ks < 2; ++ks) { const float4 wa = *(const float4*)(sWS + c * 64 + ks * 32 + q4 * 8), wb = *(const float4*)(sWS + c * 64 + ks * 32 + q4 * 8 + 4); \
            _Pragma("unroll") for (int je = 0; je < 2; ++je) { const u32x4 sv = scale8h(VF[je][ks], wa, wb); vfr[je][ks] = *(const bf16x8*)&sv; } \
            if (nown) { _Pragma("unroll") for (int jd = 0; jd < 2; ++jd) npart[jd] = (ks == 0 ? dec * npart[jd] : npart[jd]) + dot8h(KF[jd][ks], wa, wb); } } \
        _Pragma("unroll") for (int je = 0; je < 2; ++je) _Pragma("unroll") for (int jd = 0; jd < 2; ++jd) acc[je][jd] = acc[je][jd] * dec; \
        _Pragma("unroll") for (int ks = 0; ks < 2; ++ks) _Pragma("unroll") for (int je = 0; je < 2; ++je) _Pragma("unroll") for (int jd = 0; jd < 2; ++jd) \
            acc[je][jd] = __builtin_amdgcn_mfma_f32_16x16x32_bf16(*(const bf16x8*)&KF[jd][ks], vfr[je][ks], acc[je][jd], 0, 0, 0); } while (0)
__device__ __forceinline__ void mlstm_state_pass(const int chain, const int half, const bf16_t* __restrict__ Pm, const bf16_t* __restrict__ KTg, const bf16_t* __restrict__ VTg, const float* __restrict__ gate_b,
                                                 bf16_t* __restrict__ CST, float* __restrict__ NST, float* __restrict__ MST, unsigned char* shm, const int tid) {
    const int dir = chain & 1, h = (chain >> 1) & 3, b = chain >> 3, lane = tid & 63, w = tid >> 6, we = w >> 2, wd = w & 3, q4 = lane >> 4, r16 = lane & 15;
    const bool nown = (half == 0) && (we == 0);
    float* sE = (float*)shm; float* sWS = sE + 68 * 64; float* sAL = sWS + 68 * 64; float* sBE = sAL + 68; float* sMO = sBE + 68; float* sDEC = sMO + 68; float* sMB = sDEC + 68;
    const float gbi = gate_b[(dir * 2 + 0) * 4 + h], gbf = gate_b[(dir * 2 + 1) * 4 + h];
    const int gcol_i = ML_OFF + 2048 + (dir * 2 + 0) * 4 + h, gcol_f = ML_OFF + 2048 + (dir * 2 + 1) * 4 + h;
    u32x4 kfA[2][2], vfA[2][2], kfB[2][2], vfB[2][2];
    ML_FRAG_LOAD(kfA, vfA, 0);
    __syncthreads();
    unsigned gi_[9], gf_[9];
#pragma unroll
    for (int q = 0; q < 9; ++q) { const int c = min(w + 8 * q, 67); const size_t tokl = (size_t)step_tok(b, dir, c * 64 + lane); gi_[q] = Pm[tokl * LDP + gcol_i]; gf_[q] = Pm[tokl * LDP + gcol_f]; }
#pragma unroll
    for (int q = 0; q < 9; ++q) { const int c = w + 8 * q; if (c >= 68) break;
        const float ig = __uint_as_float(gi_[q] << 16) + gbi, fg = __uint_as_float(gf_[q] << 16) + gbf;
        const float lf = fminf(fg, 0.f) - log1pf(expf(-fabsf(fg)));
        const float bcs = wave_scan_incl(lf, lane); const float blast = __shfl(bcs, 63); const float ei = blast - bcs + ig; const float beta = wave_max(ei);
        sE[c * 64 + lane] = ei; if (lane == 0) { sAL[c] = blast; sBE[c] = beta; } }
    __syncthreads();
    if (tid == 0) { float m = 0.f; for (int c = 0; c < 68; ++c) { sMB[c] = m; const float mo = fmaxf(m + sAL[c], sBE[c]); sDEC[c] = expf(sAL[c] + m - mo); sMO[c] = mo; m = mo; } }
    __syncthreads();
    for (int idx = tid; idx < 68 * 64; idx += NTHR) { const int c = idx >> 6, i = idx & 63; sWS[c * 64 + (dir ? 63 - i : i)] = expf(sE[idx] - sMO[c]); }
    if (half == 0 && tid < 68) MST[chain * 68 + tid] = sMB[tid];
    __syncthreads();
    f32x4 acc[2][2];
#pragma unroll
    for (int je = 0; je < 2; ++je)
#pragma unroll
        for (int jd = 0; jd < 2; ++jd) acc[je][jd] = (f32x4){0.f, 0.f, 0.f, 0.f};
    float npart[2] = {0.f, 0.f};
    for (int c2 = 0; c2 < 68; c2 += 2) { ML_CHUNK(c2, kfA, vfA, kfB, vfB); ML_CHUNK(c2 + 1, kfB, vfB, kfA, vfA); }
    __syncthreads();
}
#undef ML_CHUNK
#undef ML_FRAG_LOAD
__device__ __forceinline__ void mlstm_out_item(const int chain, const int c, const bf16_t* __restrict__ Pm, const bf16_t* __restrict__ QKb, const bf16_t* __restrict__ VTg, const float* __restrict__ gate_b,
                                               const bf16_t* __restrict__ CST, const float* __restrict__ NST, const float* __restrict__ MST, bf16_t* __restrict__ Hout, unsigned char* shm, const int tid) {
    const int dir = chain & 1, h = (chain >> 1) & 3, b = chain >> 3, lane = tid & 63, w = tid >> 6;
    bf16_t* Qs = (bf16_t*)shm; bf16_t* Ks = (bf16_t*)(shm + 17408); bf16_t* VT = (bf16_t*)(shm + 34816); bf16_t* Cs = (bf16_t*)(shm + 53248); bf16_t* Ss = (bf16_t*)(shm + 88064);
    float* sc = (float*)(shm + 97280);
    __syncthreads();
    u32x4 gq[2], gk[2], gv[2], gc[4]; float gn = 0.f;
#pragma unroll
    for (int i = 0; i < 2; ++i) { const int pid = tid + i * 512; const int s = pid >> 4, x0 = (pid & 15) * 8; const size_t toks = (size_t)step_tok(b, dir, c * 64 + s);
        gq[i] = *(const u32x4*)(QKb + toks * 1024 + h * 128 + x0);
        gk[i] = *(const u32x4*)(QKb + toks * 1024 + 512 + h * 128 + x0);
        { const int e = pid >> 3, o = pid & 7;
          gv[i] = *(const u32x4*)(VTg + ((size_t)tokblock_of(b, dir, c) * 512 + h * 128 + e) * 64 + (dir ? 7 - o : o) * 8); } }
#pragma unroll
    for (int i = 0; i < 4; ++i) { const int pid = tid + i * 512; const int e = pid >> 4, x0 = (pid & 15) * 8;
        gc[i] = *(const u32x4*)(CST + ((size_t)(chain * 68 + c) * 128 + e) * 128 + x0); }
    if (tid < 128) gn = NST[(size_t)(chain * 68 + c) * 128 + tid];
    unsigned gi_ = 0u, gf_ = 0u; float gbi = 0.f, gbf = 0.f, m_in = 0.f;
    if (w == 0) { const size_t tokl = (size_t)step_tok(b, dir, c * 64 + lane);
        gi_ = Pm[tokl * LDP + ML_OFF + 2048 + (dir * 2 + 0) * 4 + h]; gf_ = Pm[tokl * LDP + ML_OFF + 2048 + (dir * 2 + 1) * 4 + h];
        gbi = gate_b[(dir * 2 + 0) * 4 + h]; gbf = gate_b[(dir * 2 + 1) * 4 + h]; m_in = MST[chain * 68 + c]; }
#pragma unroll
    for (int i = 0; i < 2; ++i) { const int pid = tid + i * 512; const int s = pid >> 4, x0 = (pid & 15) * 8;
        *(u32x4*)(Qs + s * 136 + x0) = gq[i]; *(u32x4*)(Ks + s * 136 + x0) = gk[i];
        { const int e = pid >> 3, o = pid & 7; *(u32x4*)(VT + e * 72 + o * 8) = dir ? rev8h(gv[i]) : gv[i]; } }
#pragma unroll
    for (int i = 0; i < 4; ++i) { const int pid = tid + i * 512; const int e = pid >> 4, x0 = (pid & 15) * 8; *(u32x4*)(Cs + e * 136 + x0) = gc[i]; }
    if (tid < 128) sc[384 + tid] = gn;
    if (w == 0) {
        const float ig = __uint_as_float(gi_ << 16) + gbi;
        const float fg = __uint_as_float(gf_ << 16) + gbf;
        const float lf = fminf(fg, 0.f) - log1pf(expf(-fabsf(fg)));
        const float bcs = wave_scan_incl(lf, lane); const float gsv = ig - bcs; const float pm = wave_scanmax_incl(gsv, lane);
        const float mt = bcs + fmaxf(m_in, pm);
        sc[lane] = bcs; sc[64 + lane] = gsv; sc[128 + lane] = mt; sc[192 + lane] = expf(bcs + m_in - mt); sc[256 + lane] = expf(-mt);
    }
    __syncthreads();
    const int tt = w >> 1;
    {   f32x4 aS[2] = {(f32x4){0.f, 0.f, 0.f, 0.f}, (f32x4){0.f, 0.f, 0.f, 0.f}};
#pragma unroll
        for (int ks = 0; ks < 4; ++ks) { const bf16x8 af = *(const bf16x8*)(Qs + (16 * tt + (lane & 15)) * 136 + ks * 32 + (lane >> 4) * 8);
#pragma unroll
            for (int i = 0; i < 2; ++i) { const int st = (w & 1) * 2 + i; const bf16x8 bfr = *(const bf16x8*)(Ks + (16 * st + (lane & 15)) * 136 + ks * 32 + (lane >> 4) * 8);
                aS[i] = __builtin_amdgcn_mfma_f32_16x16x32_bf16(af, bfr, aS[i], 0, 0, 0); } }
        float rs[4] = {0.f, 0.f, 0.f, 0.f};
#pragma unroll
        for (int i = 0; i < 2; ++i) { const int s = 16 * ((w & 1) * 2 + i) + (lane & 15); const float gsv = sc[64 + s];
#pragma unroll
            for (int q = 0; q < 4; ++q) { const int t = 16 * tt + (lane >> 4) * 4 + q; const float val = (s <= t) ? aS[i][q] * expf(sc[t] + gsv - sc[128 + t]) : 0.f; Ss[t * 72 + s] = f2bf(val); rs[q] += val; } }
#pragma unroll
        for (int q = 0; q < 4; ++q) { float r = rs[q]; r += __shfl_xor(r, 1); r += __shfl_xor(r, 2); r += __shfl_xor(r, 4); r += __shfl_xor(r, 8);
            if ((lane & 15) == 0) sc[512 + (w & 1) * 64 + 16 * tt + (lane >> 4) * 4 + q] = r; }
        {   const int t = tid >> 3, part = tid & 7; float dot = 0.f;
#pragma unroll
            for (int j = 0; j < 16; ++j) dot += bf2f(Qs[t * 136 + part * 16 + j]) * sc[384 + part * 16 + j];
            dot += __shfl_xor(dot, 1); dot += __shfl_xor(dot, 2); dot += __shfl_xor(dot, 4);
            if (part == 0) sc[640 + t] = sc[192 + t] * dot; }
    }
    __syncthreads();
    {   f32x4 aN[4];
#pragma unroll
        for (int i = 0; i < 4; ++i) aN[i] = (f32x4){0.f, 0.f, 0.f, 0.f};
#pragma unroll
        for (int ks = 0; ks < 4; ++ks) { const bf16x8 af = *(const bf16x8*)(Qs + (16 * tt + (lane & 15)) * 136 + ks * 32 + (lane >> 4) * 8);
#pragma unroll
            for (int i = 0; i < 4; ++i) { const int et = (w & 1) * 4 + i; const bf16x8 bfr = *(const bf16x8*)(Cs + (16 * et + (lane & 15)) * 136 + ks * 32 + (lane >> 4) * 8);
                aN[i] = __builtin_amdgcn_mfma_f32_16x16x32_bf16(bfr, af, aN[i], 0, 0, 0); } }
        const int t = 16 * tt + (lane & 15);
        {   const float it = sc[192 + t];
#pragma unroll
            for (int i = 0; i < 4; ++i) { aN[i][0] *= it; aN[i][1] *= it; aN[i][2] *= it; aN[i][3] *= it; } }
#pragma unroll
        for (int ks = 0; ks < 2; ++ks) { const bf16x8 af = *(const bf16x8*)(Ss + (16 * tt + (lane & 15)) * 72 + ks * 32 + (lane >> 4) * 8);
#pragma unroll
            for (int i = 0; i < 4; ++i) { const int et = (w & 1) * 4 + i; const bf16x8 bfr = *(const bf16x8*)(VT + (16 * et + (lane & 15)) * 72 + ks * 32 + (lane >> 4) * 8);
                aN[i] = __builtin_amdgcn_mfma_f32_16x16x32_bf16(bfr, af, aN[i], 0, 0, 0); } }
        {   const size_t tokt = (size_t)step_tok(b, dir, c * 64 + t); const float dn = fmaxf(fabsf((sc[512 + t] + sc[576 + t]) + sc[640 + t]), sc[256 + t]);
#pragma unroll
            for (int i = 0; i < 4; ++i) { const int e0 = 16 * ((w & 1) * 4 + i) + (lane >> 4) * 4;
                u32x2 wv; wv.x = pk2(aN[i][0] / dn, aN[i][1] / dn); wv.y = pk2(aN[i][2] / dn, aN[i][3] / dn);
                *(u32x2*)(Hout + tokt * BW + h * 128 + e0) = wv; } }
    }
}


#define SD_FRAG_LOAD(BF, XF, cc_) do { const int tb_ = tokblock_of(b, dir, (cc_)); const bf16_t* bb_ = BTg + ((size_t)tb_ * 256 + grp * 128 + 64 * (w >> 2) + r16) * 64 + q4 * 8; const bf16_t* xb_ = XTg + ((size_t)tb_ * 512 + h * 64 + 16 * (w & 3) + r16) * 64 + q4 * 8; \
        _Pragma("unroll") for (int ks_ = 0; ks_ < 2; ++ks_) { XF[ks_] = *(const u32x4*)(xb_ + ks_ * 32); _Pragma("unroll") for (int j_ = 0; j_ < 4; ++j_) BF[j_][ks_] = *(const u32x4*)(bb_ + (size_t)j_ * 16 * 64 + ks_ * 32); } } while (0)
#define SD_CHUNK(c_, BF, XF, BFN, XFN) do { const int c = (c_); \
        if (c + 1 < 68) SD_FRAG_LOAD(BFN, XFN, c + 1); \
        const float dec = sDEC[c]; \
        {   bf16_t* ss = SSTb + (size_t)(chain * 68 + c) * 64 * 128; const int p = 16 * (w & 3) + r16; \
            _Pragma("unroll") for (int j = 0; j < 4; ++j) { const int n0 = 16 * ((w >> 2) * 4 + j) + q4 * 4; u32x2 pk; pk.x = pk2(acc[j][0], acc[j][1]); pk.y = pk2(acc[j][2], acc[j][3]); *(u32x2*)(ss + (size_t)p * 128 + n0) = pk; } } \
        bf16x8 xfr[2]; \
        _Pragma("unroll") for (int ks = 0; ks < 2; ++ks) { const float4 wa = *(const float4*)(sSC + c * 64 + ks * 32 + q4 * 8), wb = *(const float4*)(sSC + c * 64 + ks * 32 + q4 * 8 + 4); const u32x4 sv = scale8h(XF[ks], wa, wb); xfr[ks] = *(const bf16x8*)&sv; } \
        _Pragma("unroll") for (int j = 0; j < 4; ++j) acc[j] = acc[j] * dec; \
        _Pragma("unroll") for (int ks = 0; ks < 2; ++ks) _Pragma("unroll") for (int j = 0; j < 4; ++j) acc[j] = __builtin_amdgcn_mfma_f32_16x16x32_bf16(*(const bf16x8*)&BF[j][ks], xfr[ks], acc[j], 0, 0, 0); } while (0)
__device__ __forceinline__ void ssd_state_pass(const int chain, const bf16_t* __restrict__ Pm, const bf16_t* __restrict__ BTg, const bf16_t* __restrict__ XTg, const float Aa, const float dtb,
                                               bf16_t* __restrict__ SSTb, unsigned char* shm, const int tid) {
    const int dir = chain & 1, h = (chain >> 1) & 7, b = chain >> 4, grp = h >> 2, lane = tid & 63, w = tid >> 6, q4 = lane >> 4, r16 = lane & 15;
    float* sSC = (float*)shm; float* sDEC = sSC + 68 * 64;
    const int dcol = SSD_OFF + 1536 + dir * 8 + h;
    u32x4 bfA[4][2], xfA[2], bfB[4][2], xfB[2];
    SD_FRAG_LOAD(bfA, xfA, 0);
    __syncthreads();
    unsigned dt_[9];
#pragma unroll
    for (int q = 0; q < 9; ++q) { const int c = min(w + 8 * q, 67); dt_[q] = Pm[(size_t)step_tok(b, dir, c * 64 + lane) * LDP + dcol]; }
#pragma unroll
    for (int q = 0; q < 9; ++q) { const int c = w + 8 * q; if (c >= 68) break;
        const float xv = __uint_as_float(dt_[q] << 16) + dtb; const float dtv = xv > 20.f ? xv : log1pf(expf(xv));
        const float cs = wave_scan_incl(dtv * Aa, lane); const float cl = __shfl(cs, 63);
        sSC[c * 64 + (dir ? 63 - lane : lane)] = dtv * expf(cl - cs); if (lane == 0) sDEC[c] = expf(cl); }
    __syncthreads();
    f32x4 acc[4];
#pragma unroll
    for (int j = 0; j < 4; ++j) acc[j] = (f32x4){0.f, 0.f, 0.f, 0.f};
    for (int c2 = 0; c2 < 68; c2 += 2) { SD_CHUNK(c2, bfA, xfA, bfB, xfB); SD_CHUNK(c2 + 1, bfB, xfB, bfA, xfA); }
    __syncthreads();
}
#undef SD_CHUNK
#undef SD_FRAG_LOAD
__device__ __forceinline__ void ssd_out_item(const int chain, const int c, const bf16_t* __restrict__ Pm, const bf16_t* __restrict__ XBb, const bf16_t* __restrict__ XTg, const float Aa, const float dtb,
                                             const bf16_t* __restrict__ SSTb, bf16_t* __restrict__ Yout, unsigned char* shm, const int tid) {
    const int dir = chain & 1, h = (chain >> 1) & 7, b = chain >> 4, grp = h >> 2, lane = tid & 63, w = tid >> 6;
    bf16_t* Cs = (bf16_t*)shm; bf16_t* Bs = (bf16_t*)(shm + 17408); bf16_t* XT = (bf16_t*)(shm + 34816); bf16_t* Sin = (bf16_t*)(shm + 44032); bf16_t* Gs = (bf16_t*)(shm + 61440);
    float* sc = (float*)(shm + 70656);
    __syncthreads();
    u32x4 gb[2], gcc[2], gs[2], gx; unsigned gd_ = 0u;
#pragma unroll
    for (int i = 0; i < 2; ++i) { const int pid = tid + i * 512; const int s = pid >> 4, x0 = (pid & 15) * 8; const size_t toks = (size_t)step_tok(b, dir, c * 64 + s);
        gb[i] = *(const u32x4*)(XBb + toks * 1024 + 512 + grp * 128 + x0);
        gcc[i] = *(const u32x4*)(XBb + toks * 1024 + 768 + grp * 128 + x0);
        const int p = pid >> 4;
        gs[i] = *(const u32x4*)(SSTb + ((size_t)(chain * 68 + c) * 64 + p) * 128 + x0); }
    {   const int p = tid >> 3, o = tid & 7;
        gx = *(const u32x4*)(XTg + ((size_t)tokblock_of(b, dir, c) * 512 + h * 64 + p) * 64 + (dir ? 7 - o : o) * 8); }
    if (w == 0) gd_ = Pm[(size_t)step_tok(b, dir, c * 64 + lane) * LDP + SSD_OFF + 1536 + dir * 8 + h];
#pragma unroll
    for (int i = 0; i < 2; ++i) { const int pid = tid + i * 512; const int s = pid >> 4, x0 = (pid & 15) * 8;
        *(u32x4*)(Bs + s * 136 + x0) = gb[i]; *(u32x4*)(Cs + s * 136 + x0) = gcc[i]; *(u32x4*)(Sin + s * 136 + x0) = gs[i]; }
    {   const int p = tid >> 3, o = tid & 7; *(u32x4*)(XT + p * 72 + o * 8) = dir ? rev8h(gx) : gx; }
    if (w == 0) {
        const float xv = __uint_as_float(gd_ << 16) + dtb; const float dtv = xv > 20.f ? xv : log1pf(expf(xv));
        sc[lane] = wave_scan_incl(dtv * Aa, lane); sc[64 + lane] = dtv; }
    __syncthreads();
    {   const int lt = w >> 1;
        f32x4 aG[2] = {(f32x4){0.f, 0.f, 0.f, 0.f}, (f32x4){0.f, 0.f, 0.f, 0.f}};
#pragma unroll
        for (int ks = 0; ks < 4; ++ks) { const bf16x8 af = *(const bf16x8*)(Cs + (16 * lt + (lane & 15)) * 136 + ks * 32 + (lane >> 4) * 8);
#pragma unroll
            for (int i = 0; i < 2; ++i) { const int st = (w & 1) * 2 + i; const bf16x8 bfr = *(const bf16x8*)(Bs + (16 * st + (lane & 15)) * 136 + ks * 32 + (lane >> 4) * 8);
                aG[i] = __builtin_amdgcn_mfma_f32_16x16x32_bf16(af, bfr, aG[i], 0, 0, 0); } }
#pragma unroll
        for (int i = 0; i < 2; ++i) { const int s = 16 * ((w & 1) * 2 + i) + (lane & 15); const float css = sc[s], dts = sc[64 + s];
#pragma unroll
            for (int q = 0; q < 4; ++q) { const int t = 16 * lt + (lane >> 4) * 4 + q; const float val = (s <= t) ? aG[i][q] * expf(sc[t] - css) * dts : 0.f; Gs[t * 72 + s] = f2bf(val); } }
    }
    __syncthreads();
    {   const int lt = w >> 1;
        f32x4 aY[2] = {(f32x4){0.f, 0.f, 0.f, 0.f}, (f32x4){0.f, 0.f, 0.f, 0.f}};
#pragma unroll
        for (int ks = 0; ks < 4; ++ks) { const bf16x8 af = *(const bf16x8*)(Cs + (16 * lt + (lane & 15)) * 136 + ks * 32 + (lane >> 4) * 8);
#pragma unroll
            for (int i = 0; i < 2; ++i) { const int pt = (w & 1) * 2 + i; const bf16x8 bfr = *(const bf16x8*)(Sin + (16 * pt + (lane & 15)) * 136 + ks * 32 + (lane >> 4) * 8);
                aY[i] = __builtin_amdgcn_mfma_f32_16x16x32_bf16(bfr, af, aY[i], 0, 0, 0); } }
        const int t = 16 * lt + (lane & 15);
        {   const float ec = expf(sc[t]);
#pragma unroll
            for (int i = 0; i < 2; ++i) { aY[i][0] *= ec; aY[i][1] *= ec; aY[i][2] *= ec; aY[i][3] *= ec; } }
#pragma unroll
        for (int ks = 0; ks < 2; ++ks) { const bf16x8 af = *(const bf16x8*)(Gs + (16 * lt + (lane & 15)) * 72 + ks * 32 + (lane >> 4) * 8);
#pragma unroll
            for (int i = 0; i < 2; ++i) { const int pt = (w & 1) * 2 + i; const bf16x8 bfr = *(const bf16x8*)(XT + (16 * pt + (lane & 15)) * 72 + ks * 32 + (lane >> 4) * 8);
                aY[i] = __builtin_amdgcn_mfma_f32_16x16x32_bf16(bfr, af, aY[i], 0, 0, 0); } }
        {   const size_t tokt = (size_t)step_tok(b, dir, c * 64 + t);
#pragma unroll
            for (int i = 0; i < 2; ++i) { const int p0 = 16 * ((w & 1) * 2 + i) + (lane >> 4) * 4;
                u32x2 wv; wv.x = pk2(aY[i][0], aY[i][1]); wv.y = pk2(aY[i][2], aY[i][3]);
                *(u32x2*)(Yout + tokt * BW + h * 64 + p0) = wv; } }
    }
}


#define FIDX(i) ((i) + ((i) >> 4))
#define FFT_X_BYTES 69632
__device__ constexpr float FFT_CW_RE[6][16] = {{0.f, 0.f, 0.f, 0.f, 0.f, 0.f, 0.f, 0.f, 0.f, 0.f, 0.f, 0.f, 0.f, 0.f, 0.f, 0.f}, {1.0f, 0.f, 0.f, 0.f, 0.f, 0.f, 0.f, 0.f, 0.f, 0.f, 0.f, 0.f, 0.f, 0.f, 0.f, 0.f}, {1.0f, 6.123233995736766e-17f, 0.f, 0.f, 0.f, 0.f, 0.f, 0.f, 0.f, 0.f, 0.f, 0.f, 0.f, 0.f, 0.f, 0.f}, {1.0f, 0.7071067811865476f, 6.123233995736766e-17f, -0.7071067811865475f, 0.f, 0.f, 0.f, 0.f, 0.f, 0.f, 0.f, 0.f, 0.f, 0.f, 0.f, 0.f}, {1.0f, 0.9238795325112867f, 0.7071067811865476f, 0.38268343236508984f, 6.123233995736766e-17f, -0.3826834323650897f, -0.7071067811865475f, -0.9238795325112867f, 0.f, 0.f, 0.f, 0.f, 0.f, 0.f, 0.f, 0.f}, {1.0f, 0.9807852804032304f, 0.9238795325112867f, 0.8314696123025452f, 0.7071067811865476f, 0.5555702330196023f, 0.38268343236508984f, 0.19509032201612833f, 6.123233995736766e-17f, -0.1950903220161282f, -0.3826834323650897f, -0.555570233019602f, -0.7071067811865475f, -0.8314696123025453f, -0.9238795325112867f, -0.9807852804032304f}};
__device__ constexpr float FFT_CW_IM[6][16] = {{0.f, 0.f, 0.f, 0.f, 0.f, 0.f, 0.f, 0.f, 0.f, 0.f, 0.f, 0.f, 0.f, 0.f, 0.f, 0.f}, {-0.0f, 0.f, 0.f, 0.f, 0.f, 0.f, 0.f, 0.f, 0.f, 0.f, 0.f, 0.f, 0.f, 0.f, 0.f, 0.f}, {-0.0f, -1.0f, 0.f, 0.f, 0.f, 0.f, 0.f, 0.f, 0.f, 0.f, 0.f, 0.f, 0.f, 0.f, 0.f, 0.f}, {-0.0f, -0.7071067811865475f, -1.0f, -0.7071067811865476f, 0.f, 0.f, 0.f, 0.f, 0.f, 0.f, 0.f, 0.f, 0.f, 0.f, 0.f, 0.f}, {-0.0f, -0.3826834323650898f, -0.7071067811865475f, -0.9238795325112867f, -1.0f, -0.9238795325112867f, -0.7071067811865476f, -0.3826834323650899f, 0.f, 0.f, 0.f, 0.f, 0.f, 0.f, 0.f, 0.f}, {-0.0f, -0.19509032201612825f, -0.3826834323650898f, -0.5555702330196022f, -0.7071067811865475f, -0.8314696123025452f, -0.9238795325112867f, -0.9807852804032304f, -1.0f, -0.9807852804032304f, -0.9238795325112867f, -0.8314696123025455f, -0.7071067811865476f, -0.5555702330196022f, -0.3826834323650899f, -0.1950903220161286f}};
__host__ __device__ constexpr int fft_bitrev(int k, int R) { int r = 0; for (int i = 0; i < R; ++i) if (k & (1 << i)) r |= 1 << (R - 1 - i); return r; }
template <int R, bool INV>
__device__ __forceinline__ void fft_pass(float2* __restrict__ X, const float2* __restrict__ TW, const int s0, const int gidx) {
    const int lowbits = 13 - s0 - R; const int stride = 1 << lowbits;
    const int low = gidx & (stride - 1), high = gidx >> lowbits; const int base = (high << (lowbits + R)) | low;
    const int p0 = FIDX(base);
#define FFT_SLOT(k) (lowbits >= 4 ? p0 + (k) * (stride + (stride >> 4)) : p0 + (k) + ((k) >> 4))
    float2 v[1 << R];
#pragma unroll
    for (int k = 0; k < (1 << R); ++k) v[k] = X[FFT_SLOT(k)];
    const int lw = low << s0;
    if (!INV) {
#pragma unroll
        for (int j = 0; j < R; ++j) { const int hk = 1 << (R - 1 - j);
#pragma unroll
            for (int k = 0; k < (1 << R); ++k) if (!(k & hk)) { const int kk = k & (hk - 1);
                const float2 a = v[k], b = v[k + hk]; v[k] = make_float2(a.x + b.x, a.y + b.y); const float dx = a.x - b.x, dy = a.y - b.y;
                if (kk == 0) v[k + hk] = make_float2(dx, dy);
                else if (2 * kk == hk) v[k + hk] = make_float2(dy, -dx);
                else { const float cr = FFT_CW_RE[R - j][kk], ci = FFT_CW_IM[R - j][kk]; v[k + hk] = make_float2(dx * cr - dy * ci, dx * ci + dy * cr); } } }
        if (lowbits > 0) {
#pragma unroll
            for (int k = 1; k < (1 << R); ++k) { const float2 w = TW[(lw * fft_bitrev(k, R)) & 8191]; const float2 a = v[k]; v[k] = make_float2(a.x * w.x - a.y * w.y, a.x * w.y + a.y * w.x); } }
    } else {
        if (lowbits > 0) {
#pragma unroll
            for (int k = 1; k < (1 << R); ++k) { const float2 w = TW[(lw * fft_bitrev(k, R)) & 8191]; const float2 a = v[k]; v[k] = make_float2(a.x * w.x + a.y * w.y, a.y * w.x - a.x * w.y); } }
#pragma unroll
        for (int j = R - 1; j >= 0; --j) { const int hk = 1 << (R - 1 - j);
#pragma unroll
            for (int k = 0; k < (1 << R); ++k) if (!(k & hk)) { const int kk = k & (hk - 1);
                const float2 a = v[k], b = v[k + hk]; float tx, ty;
                if (kk == 0) { tx = b.x; ty = b.y; }
                else if (2 * kk == hk) { tx = -b.y; ty = b.x; }
                else { const float cr = FFT_CW_RE[R - j][kk], ci = FFT_CW_IM[R - j][kk]; tx = b.x * cr + b.y * ci; ty = b.y * cr - b.x * ci; }
                v[k] = make_float2(a.x + tx, a.y + ty); v[k + hk] = make_float2(a.x - tx, a.y - ty); } }
    }
#pragma unroll
    for (int k = 0; k < (1 << R); ++k) X[FFT_SLOT(k)] = v[k];
#undef FFT_SLOT
}
__device__ __forceinline__ void fft_fwd(float2* X, const float2* TW, const int tid) {
    fft_pass<4, false>(X, TW, 0, tid); __syncthreads(); fft_pass<4, false>(X, TW, 4, tid); __syncthreads(); if (tid < 256) fft_pass<5, false>(X, TW, 8, tid); __syncthreads(); }
__device__ __forceinline__ void fft_inv(float2* X, const float2* TW, const int tid) {
    if (tid < 256) fft_pass<5, true>(X, TW, 8, tid); __syncthreads(); fft_pass<4, true>(X, TW, 4, tid); __syncthreads(); fft_pass<4, true>(X, TW, 0, tid); __syncthreads(); }
__device__ __forceinline__ void fft_twiddles(float2* TW, const int tid) {
#pragma unroll
    for (int k = 0; k < 16; ++k) { const int m = tid + k * 512; const float xx = (float)m * (1.0f / 4096.0f); TW[m] = make_float2(cospif(xx), -sinpif(xx)); }
}
__device__ __forceinline__ void hyena_spec_item(const int pr, const float* __restrict__ HR, const float* __restrict__ nrm, float2* __restrict__ HSPEC, unsigned char* shm, const int tid) {
    float2* X = (float2*)shm; const float2* TW = (const float2*)(shm + FFT_X_BYTES);
    const int o = pr >> 8, c = (pr & 255) * 2, oc = o * 512 + c; const float inva = 1.0f / nrm[oc], invb = 1.0f / nrm[oc + 1];
    __syncthreads();
    float2 hv[16];
#pragma unroll
    for (int k = 0; k < 16; ++k) { const int j = tid + k * 512;
        const unsigned off = j < SEQ ? (unsigned)j * 2048u + o * 1024 + c : j == SEQ ? (unsigned)(o * 1024 + c) : (unsigned)(2 * SEQ - j) * 2048u + o * 1024 + 512 + c;
        hv[k] = *(const float2*)(HR + off); }
#pragma unroll
    for (int k = 0; k < 16; ++k) { const int j = tid + k * 512; X[FIDX(j)] = j == SEQ ? make_float2(0.f, 0.f) : make_float2(hv[k].x * inva, hv[k].y * invb); }
    __syncthreads();
    fft_fwd(X, TW, tid);
    float4* outa = (float4*)(HSPEC + (size_t)oc * 8192 + tid * 16); float4* outb = (float4*)(HSPEC + (size_t)(oc + 1) * 8192 + tid * 16); const float2* xs = X + 17 * tid;
    const float sc_ = 0.5f / 8192.0f;
#pragma unroll
    for (int k = 0; k < 8; ++k) { float2 ha[2], hb[2];
#pragma unroll
        for (int q = 0; q < 2; ++q) { const int p = 16 * tid + 2 * k + q; const int kf = (int)(__builtin_bitreverse32((unsigned)p) >> 19); const int p2 = (int)(__builtin_bitreverse32((unsigned)((8192 - kf) & 8191)) >> 19);
            const float2 xp = xs[2 * k + q], xq = X[FIDX(p2)];
            ha[q] = make_float2((xp.x + xq.x) * sc_, (xp.y - xq.y) * sc_);
            hb[q] = make_float2((xp.y + xq.y) * sc_, (xq.x - xp.x) * sc_); }
        outa[k] = make_float4(ha[0].x, ha[0].y, ha[1].x, ha[1].y); outb[k] = make_float4(hb[0].x, hb[0].y, hb[1].x, hb[1].y); }
}
__device__ __forceinline__ void fft_mul_spec(float2* X, const float2* __restrict__ H, const int tid) {
    const float4* h4 = (const float4*)(H + tid * 16); float2* xs = X + 17 * tid;
#pragma unroll
    for (int k = 0; k < 8; ++k) { const float4 hv = h4[k]; const float2 x0 = xs[2 * k], x1 = xs[2 * k + 1];
        xs[2 * k] = make_float2(x0.x * hv.x - x0.y * hv.y, x0.x * hv.y + x0.y * hv.x); xs[2 * k + 1] = make_float2(x1.x * hv.z - x1.y * hv.w, x1.x * hv.w + x1.y * hv.z); }
}
__device__ __forceinline__ void hyena_fft_item(const int item, const bf16_t* __restrict__ UT, const float2* __restrict__ HSPEC, const float* __restrict__ bias, float* __restrict__ YT, unsigned char* shm, const int tid) {
    float2* X = (float2*)shm; const float2* TW = (const float2*)(shm + FFT_X_BYTES);
    const int c = item >> 1, b0 = (item & 1) * 2, b1 = b0 + 1;
    const bf16_t* u0 = UT + (size_t)(b0 * 1536 + c) * SEQ + tid * 8; const bf16_t* u1 = UT + (size_t)(b1 * 1536 + c) * SEQ + tid * 8;
    const float bias0 = bias[c], bias1 = bias[512 + c];
    float2* xs = X + FIDX(8 * tid);
    float vr[8], vi[8];
    __syncthreads();
    { const u32x4 a0 = *(const u32x4*)u0, c0 = *(const u32x4*)u1; unpack8(a0, vr); unpack8(c0, vi); }
#pragma unroll
    for (int k = 0; k < 8; ++k) { xs[k] = make_float2(vr[k], vi[k]); xs[4352 + k] = make_float2(0.f, 0.f); }
    __syncthreads();
    fft_fwd(X, TW, tid);
    fft_mul_spec(X, HSPEC + (size_t)c * 8192, tid);
    __syncthreads();
    fft_inv(X, TW, tid);
    { const bf16_t* p0 = u0 + (size_t)512 * SEQ; const bf16_t* p1 = u1 + (size_t)512 * SEQ;
      float xr[8], xi[8]; { const u32x4 a0 = *(const u32x4*)p0, c0 = *(const u32x4*)p1; unpack8(a0, xr); unpack8(c0, xi); }
#pragma unroll
      for (int k = 0; k < 8; ++k) { const float2 cv = xs[k]; const float zr = xr[k] * (cv.x + bias0 * vr[k]), zi = xi[k] * (cv.y + bias0 * vi[k]);
          vr[k] = zr; vi[k] = zi; xs[k] = make_float2(zr, zi); xs[4352 + k] = make_float2(0.f, 0.f); } }
    __syncthreads();
    fft_fwd(X, TW, tid);
    fft_mul_spec(X, HSPEC + (size_t)(512 + c) * 8192, tid);
    __syncthreads();
    fft_inv(X, TW, tid);
    { const bf16_t* p0 = u0 + (size_t)1024 * SEQ; const bf16_t* p1 = u1 + (size_t)1024 * SEQ;
      float xr[8], xi[8]; { const u32x4 a0 = *(const u32x4*)p0, c0 = *(const u32x4*)p1; unpack8(a0, xr); unpack8(c0, xi); }
      float yr[8], yi[8];
#pragma unroll
      for (int k = 0; k < 8; ++k) { const float2 cv = xs[k]; yr[k] = xr[k] * (cv.x + bias1 * vr[k]); yi[k] = xi[k] * (cv.y + bias1 * vi[k]); }
      float* y0 = YT + (size_t)(b0 * 512 + c) * SEQ + tid * 8; float* y1 = YT + (size_t)(b1 * 512 + c) * SEQ + tid * 8;
      *(float4*)y0 = make_float4(yr[0], yr[1], yr[2], yr[3]); *(float4*)(y0 + 4) = make_float4(yr[4], yr[5], yr[6], yr[7]);
      *(float4*)y1 = make_float4(yi[0], yi[1], yi[2], yi[3]); *(float4*)(y1 + 4) = make_float4(yi[4], yi[5], yi[6], yi[7]); }
}

constexpr size_t al256(size_t x) { return (x + 255) & ~(size_t)255; }
constexpr size_t O_BAR = 0;
constexpr size_t O_MOD = 16384;
constexpr size_t O_NORM = O_MOD + al256((size_t)2 * 5 * 6 * DM * 4);
constexpr size_t O_QCTR = O_NORM + al256((size_t)2 * 2 * 1024 * 4);
constexpr size_t O_ZERO_END = O_QCTR + 512;
constexpr size_t O_XS = O_ZERO_END;
constexpr size_t O_HB = O_XS + al256((size_t)NTOK * DM * 4);
constexpr size_t O_P = O_HB + al256((size_t)NTOK * DM * 2);
constexpr size_t O_WIN = O_P + al256((size_t)NTOK * LDP * 2);
constexpr size_t O_WBR = O_WIN + al256((size_t)LDP * DM * 2);
constexpr size_t O_WOUT = O_WBR + al256((size_t)4 * DM * BW * 2);
constexpr size_t O_WGU = O_WOUT + al256((size_t)DM * DM * 2);
constexpr size_t O_WD = O_WGU + al256((size_t)NEXP * 2 * DEXP * DM * 2);
constexpr size_t O_GLU = O_WD + al256((size_t)NEXP * DM * DEXP * 2);
constexpr size_t O_Y4 = O_GLU + al256((size_t)BW * BW * 2);
constexpr size_t O_U = O_Y4 + al256((size_t)NTOK * DM * 2);
constexpr size_t O_QKB = O_U + al256((size_t)NTOK * 1536 * 4);
constexpr size_t O_CST = O_QKB + al256((size_t)NTOK * 1024 * 2);
constexpr size_t O_NST = O_CST + al256((size_t)32 * 68 * 128 * 128 * 2);
constexpr size_t O_MST = O_NST + al256((size_t)32 * 68 * 128 * 4);
constexpr size_t O_XBC = O_MST + al256((size_t)32 * 68 * 4);
constexpr size_t O_SST = O_XBC + al256((size_t)NTOK * 1024 * 2);
constexpr size_t O_HF = O_SST + al256((size_t)64 * 68 * 64 * 128 * 2);
constexpr size_t O_YF = O_HF + al256((size_t)2 * NTOK * BW * 4);
constexpr size_t O_SF = O_YF + al256((size_t)2 * NTOK * BW * 4);
constexpr size_t O_LDT = O_SF + al256((size_t)2 * NCTX * BW * 4);
constexpr size_t O_AP = O_LDT + al256((size_t)4096 * 16);
constexpr size_t O_BBT = O_AP + al256((size_t)4096 * 33 * 8);
constexpr size_t O_KT = O_BBT + al256((size_t)4096 * 16 * 8);
constexpr size_t O_S5A = O_KT + al256((size_t)32 * 2 * 32 * 256 * 4);
constexpr size_t O_S5B = O_S5A + al256((size_t)32 * 512 * 768 * 2);
constexpr size_t O_XCTX = O_S5B + al256((size_t)32 * 512 * 768 * 2);
constexpr size_t O_Z = O_XCTX + al256((size_t)4 * 32 * 2 * 64 * 8);
constexpr size_t O_HRAW = O_Z + al256((size_t)NTOK * BW * 4);
constexpr size_t O_HSPEC = O_HRAW + al256((size_t)(SEQ + CTXL) * 2048 * 4);
constexpr size_t O_K2C = O_HSPEC + al256((size_t)1024 * 8192 * 8);
constexpr size_t O_GG = O_K2C + al256((size_t)(2 * CTXL) * 1024 * 4);
constexpr size_t O_PROBS = O_GG + al256((size_t)NTOK * BW * 2);
constexpr size_t O_ROWTOK = O_PROBS + al256((size_t)NTOK * 16 * 4);
constexpr size_t O_ROWGATE = O_ROWTOK + al256((size_t)NEXP * MOE_PAD * 4);
constexpr size_t O_INV = O_ROWGATE + al256((size_t)NEXP * MOE_PAD * 4);
constexpr size_t O_NORMP = O_INV + al256((size_t)NTOK * 16 * 4);
constexpr size_t WS_END = O_NORMP + al256((size_t)4 * 256 * 2048 * 4);
constexpr size_t O_XG = O_P;
constexpr size_t O_HID = O_P + al256((size_t)NEXP * MOE_PAD * DM * 2);
constexpr size_t O_YEXP = O_HID + al256((size_t)NEXP * MOE_PAD * DEXP * 2);
static_assert(O_YEXP + (size_t)NEXP * MOE_PAD * DM * 2 <= O_WIN, "MoE temporaries must fit inside P");
static_assert((size_t)NTOK * DM * 2 <= (size_t)NTOK * 1536 * 4, "ACCb must fit inside U");
static_assert((size_t)26214400 + (size_t)2 * 17825792 + (size_t)272 * 256 * 64 * 2 <= (size_t)NTOK * DM * 2, "strip buffers must fit inside HB");
static_assert(WS_END <= (size_t)1851000000, "workspace map exceeds the guaranteed size");

struct Args {
    const float* in[47];
    float* out; unsigned char* ws;
    int ph_lo, ph_hi;
};

__device__ __forceinline__ void conv_tile(const float* __restrict__ src, int ldsrc, int nvalid, int k0, int n0, bf16_t* __restrict__ dst, int lddst, int mode, float* T, int tid) {
    { const int n = tid & 63, kr = tid >> 6;
#pragma unroll
      for (int i = 0; i < 8; ++i) { const int k = i * 8 + kr; T[k * 65 + n] = (n0 + n < nvalid) ? src[(size_t)(k0 + k) * ldsrc + n0 + n] : 0.f; } }
    __syncthreads();
    { const int n = tid >> 3, kc = (tid & 7) * 8; const int gn = n0 + n;
      const int drow = mode == 0 ? gn : (32 * (gn >> 4) + (mode == 2 ? 16 : 0) + (gn & 15));
      u32x4 w; w.x = pk2(T[(kc + 0) * 65 + n], T[(kc + 1) * 65 + n]); w.y = pk2(T[(kc + 2) * 65 + n], T[(kc + 3) * 65 + n]);
      w.z = pk2(T[(kc + 4) * 65 + n], T[(kc + 5) * 65 + n]); w.w = pk2(T[(kc + 6) * 65 + n], T[(kc + 7) * 65 + n]);
      *(u32x4*)(dst + (size_t)drow * lddst + k0 + kc) = w; }
    __syncthreads();
}

#define IN(id) (lo <= (id) && (id) < hi)
#define SEAM(id) do { if (hi > (id) + 1) xcd_barrier(bar); } while (0)
#define PH_BEGIN int tid = threadIdx.x; asm volatile("" : "+v"(tid) :: "memory"); const int lane = tid & 63, wave = tid >> 6; (void)lane; (void)wave;

#define x_in (PT(0))
#define c_in (PT(1))
#define ctx_in (PT(2))
#define cctx_in (PT(3))
#define ada_w (PT(4))
#define ada_b (PT(5))
#define norm_mix (PT(6))
#define norm_ffn (PT(7))
#define w_in (PT(8))
#define XS ((float*)(a.ws + O_XS))
#define MOD ((float*)(a.ws + O_MOD))
#define NORM ((float*)(a.ws + O_NORM))
#define NORMP ((float*)(a.ws + O_NORMP))
#define MODl (MOD + (size_t)l * 5 * 6 * DM)
#define HB ((bf16_t*)(a.ws + O_HB))
#define P ((bf16_t*)(a.ws + O_P))
#define WIN ((bf16_t*)(a.ws + O_WIN))
#define WBR ((bf16_t*)(a.ws + O_WBR))
#define WOUT ((bf16_t*)(a.ws + O_WOUT))
#define WGU ((bf16_t*)(a.ws + O_WGU))
#define WD ((bf16_t*)(a.ws + O_WD))
#define GLU ((bf16_t*)(a.ws + O_GLU))
#define Y4 ((bf16_t*)(a.ws + O_Y4))
#define U ((float*)(a.ws + O_U))
#define ACCb ((bf16_t*)(a.ws + O_U))
#define QKB ((bf16_t*)(a.ws + O_QKB))
#define CST ((bf16_t*)(a.ws + O_CST))
#define NST ((float*)(a.ws + O_NST))
#define MST ((float*)(a.ws + O_MST))
#define XBC ((bf16_t*)(a.ws + O_XBC))
#define SSTB ((bf16_t*)(a.ws + O_SST))
#define HF ((bf16_t*)(a.ws + O_HF))
#define HBk (HF + (size_t)NTOK * BW)
#define YF ((bf16_t*)(a.ws + O_YF))
#define YB (YF + (size_t)NTOK * BW)
#define SF ((float*)(a.ws + O_SF))
#define SB (SF + (size_t)NCTX * BW)
#define LDT ((double2*)(a.ws + O_LDT))
#define APW ((float2*)(a.ws + O_AP))
#define BBT ((float2*)(a.ws + O_BBT))
#define KTB ((float*)(a.ws + O_KT))
#define S5A ((bf16_t*)(a.ws + O_S5A))
#define S5B ((bf16_t*)(a.ws + O_S5B))
#define XCTX ((float2*)(a.ws + O_XCTX))
#define S5P ((bf16_t*)(a.ws + O_HB))
#define XLOC ((float*)(a.ws + O_HB + (size_t)32 * 256 * 512 * 2))
#define KTG ((bf16_t*)(a.ws + O_HB + (size_t)26214400))
#define VTG ((bf16_t*)(a.ws + O_HB + (size_t)26214400 + (size_t)17825792))
#define BTG ((bf16_t*)(a.ws + O_HB + (size_t)26214400 + (size_t)2 * 17825792))
#define XTG ((bf16_t*)(a.ws + O_GG))
#define Z ((float*)(a.ws + O_Z))
#define HRAW ((float*)(a.ws + O_HRAW))
#define HSPEC ((float2*)(a.ws + O_HSPEC))
#define UT ((bf16_t*)(a.ws + O_U))
#define YT ((float*)(a.ws + O_Z))
#define QCTR ((int*)(a.ws + O_QCTR))
#define K2C ((float*)(a.ws + O_K2C))
#define GG ((bf16_t*)(a.ws + O_GG))
#define PROBS ((float*)(a.ws + O_PROBS))
#define ROWTOK ((int*)(a.ws + O_ROWTOK))
#define ROWGATE ((float*)(a.ws + O_ROWGATE))
#define XG ((bf16_t*)(a.ws + O_XG))
#define HID ((bf16_t*)(a.ws + O_HID))
#define YEXP ((bf16_t*)(a.ws + O_YEXP))
#define INV ((int*)(a.ws + O_INV))


__device__ __forceinline__ void moe_pair(float4 (&a)[8], const int r1, const int r2, const float g2scale, const int lane, const float* __restrict__ rowgate, const bf16_t* __restrict__ yexp) {
    const float gt1 = rowgate[r1], gt2 = rowgate[r2] * g2scale;
    const bf16_t* y1 = yexp + (size_t)r1 * DM + lane * 4; const bf16_t* y2 = yexp + (size_t)r2 * DM + lane * 4;
    u32x2 w1[8], w2[8];
#pragma unroll
    for (int i = 0; i < 8; ++i) { w1[i] = *(const u32x2*)(y1 + i * 256); w2[i] = *(const u32x2*)(y2 + i * 256); }
#pragma unroll
    for (int i = 0; i < 8; ++i) {
        a[i].x += gt1 * __uint_as_float(w1[i].x << 16); a[i].y += gt1 * __uint_as_float(w1[i].x & 0xFFFF0000u); a[i].z += gt1 * __uint_as_float(w1[i].y << 16); a[i].w += gt1 * __uint_as_float(w1[i].y & 0xFFFF0000u);
        a[i].x += gt2 * __uint_as_float(w2[i].x << 16); a[i].y += gt2 * __uint_as_float(w2[i].x & 0xFFFF0000u); a[i].z += gt2 * __uint_as_float(w2[i].y << 16); a[i].w += gt2 * __uint_as_float(w2[i].y & 0xFFFF0000u); }
}
__device__ __forceinline__ void moe_combine(float4 (&v)[8], const int tok, const int lane, const int* __restrict__ inv, const float* __restrict__ rowgate, const bf16_t* __restrict__ yexp, const float* __restrict__ m5) {
    float4 a[8], mm[8];
#pragma unroll
    for (int i = 0; i < 8; ++i) { a[i] = make_float4(0.f, 0.f, 0.f, 0.f); mm[i] = *(const float4*)(m5 + i * 256 + lane * 4); }
    const int4* ip = (const int4*)(inv + (size_t)tok * 16);
    const int4 q0 = ip[0], q1 = ip[1], q2 = ip[2], q3 = ip[3];
    const int rows[16] = {q0.x, q0.y, q0.z, q0.w, q1.x, q1.y, q1.z, q1.w, q2.x, q2.y, q2.z, q2.w, q3.x, q3.y, q3.z, q3.w};
    int prow = -1;
#pragma unroll
    for (int e = 0; e < 16; ++e) { const int row = __builtin_amdgcn_readfirstlane(rows[e]);
        if (row >= 0) { if (prow >= 0) { moe_pair(a, prow, row, 1.0f, lane, rowgate, yexp); prow = -1; } else prow = row; } }
    if (prow >= 0) moe_pair(a, prow, prow, 0.0f, lane, rowgate, yexp);
#pragma unroll
    for (int i = 0; i < 8; ++i) { v[i].x += mm[i].x * a[i].x; v[i].y += mm[i].y * a[i].y; v[i].z += mm[i].z * a[i].z; v[i].w += mm[i].w * a[i].w; }
}
struct CvU { const float* src; bf16_t* dst; int ldsrc, nvalid, k0, n0, lddst, mode; };
__device__ __forceinline__ void cv_load(const CvU& u, float4 (&r)[8], const int tid) {
#pragma unroll
    for (int i = 0; i < 8; ++i) { const int idx = tid + i * 512; const int k = idx >> 6, n = u.n0 + (idx & 63) * 4;
        r[i] = (n < u.nvalid) ? *(const float4*)(u.src + (size_t)(u.k0 + k) * u.ldsrc + n) : make_float4(0.f, 0.f, 0.f, 0.f); }
}
__device__ __forceinline__ void cv_stage(float* T, const float4 (&r)[8], const int tid) {
#pragma unroll
    for (int i = 0; i < 8; ++i) { const int idx = tid + i * 512; float* p = T + (idx >> 6) * 257 + (idx & 63) * 4; p[0] = r[i].x; p[1] = r[i].y; p[2] = r[i].z; p[3] = r[i].w; }
}
__device__ __forceinline__ void cv_store(const CvU& u, const float* T, const int tid) {
#pragma unroll
    for (int j = 0; j < 4; ++j) { const int o = tid + j * 512; const int kc = (o & 7) * 8, n = o >> 3; const int gn = u.n0 + n;
        int drow = u.mode == 0 ? gn : (256 * (gn >> 7) + (u.mode == 2 ? 128 : 0) + (gn & 127));
        if (u.mode == 3) {
            if (gn >= IN_W) continue;
            drow = gn;
            if (gn >= GATE_OFF) { const int g = gn - GATE_OFF, kb = g >> 11, col = g & 2047, j2 = col >> 6, rem = col & 63;
                drow = GATE2 + 256 * j2 + 128 * (kb >> 1) + 32 * (rem >> 4) + 8 * ((rem >> 2) & 3) + 4 * (kb & 1) + (rem & 3); } }
        const float* t = T + kc * 257 + n;
        u32x4 w; w.x = pk2(t[0], t[257]); w.y = pk2(t[2 * 257], t[3 * 257]); w.z = pk2(t[4 * 257], t[5 * 257]); w.w = pk2(t[6 * 257], t[7 * 257]);
        *(u32x4*)(u.dst + (size_t)drow * u.lddst + u.k0 + kc) = w; }
}
#define CV_RUN(LL, QSTART, QSTEP, QEND) do { \
                const float* wbr = PT(40) + (size_t)(LL) * 4 * BW * DM; const float* wout = PT(41) + (size_t)(LL) * DM * DM; \
                const float* wg = PT(43) + (size_t)(LL) * NEXP * DM * DEXP; const float* wu = PT(44) + (size_t)(LL) * NEXP * DM * DEXP; const float* wd = PT(45) + (size_t)(LL) * NEXP * DEXP * DM; \
                const float* wglu = PT(32) + (size_t)(LL) * BW * BW; const float* win = w_in + (size_t)(LL) * DM * IN_W; \
                const int cv_step = (QSTEP), cv_end = (QEND); \
                __syncthreads(); \
                int q = (QSTART); int buf = 0; CvU u; float4 r[8]; \
                if (q < cv_end) { CV_DECODE(q, u); cv_load(u, r, tid); } \
                while (q < cv_end) { \
                    float* T = sf + buf * (64 * 257); \
                    cv_stage(T, r, tid); \
                    __syncthreads(); \
                    const CvU cur = u; const int qn = q + cv_step; \
                    if (qn < cv_end) { CV_DECODE(qn, u); cv_load(u, r, tid); } \
                    cv_store(cur, T, tid); \
                    buf ^= 1; q = qn; \
                } \
                __syncthreads(); } while (0)
#define CV_DECODE(q_, u_) do { int qq_ = (q_); \
                    if (qq_ < n_win) { u_ = CvU{win, WIN, IN_W, IN_W, (qq_ / 55) * 64, (qq_ % 55) * 256, DM, 3}; } else { qq_ -= n_win; \
                    if (qq_ < n_br) { const int k = qq_ >> 6, r = qq_ & 63; u_ = CvU{wbr + (size_t)k * BW * DM, WBR + (size_t)k * DM * BW, DM, DM, (r >> 3) * 64, (r & 7) * 256, BW, 0}; } else { qq_ -= n_br; \
                    if (qq_ < n_out) { u_ = CvU{wout, WOUT, DM, DM, (qq_ >> 3) * 64, (qq_ & 7) * 256, DM, 0}; } else { qq_ -= n_out; \
                    if (qq_ < n_glu) { u_ = CvU{wglu, GLU, BW, BW, (qq_ >> 1) * 64, (qq_ & 1) * 256, BW, 0}; } else { qq_ -= n_glu; \
                    if (qq_ < n_gu) { const int e = qq_ / 384, r = qq_ % 384, up = r / 192, r2 = r % 192; u_ = CvU{(up ? wu : wg) + (size_t)e * DM * DEXP, WGU + (size_t)e * 2 * DEXP * DM, DEXP, DEXP, (r2 / 6) * 64, (r2 % 6) * 256, DM, 1 + up}; } else { qq_ -= n_gu; \
                    { const int e = qq_ / 192, r = qq_ % 192; u_ = CvU{wd + (size_t)e * DEXP * DM, WD + (size_t)e * DM * DEXP, DM, DM, (r >> 3) * 64, (r & 7) * 256, DEXP, 0}; } } } } } } } while (0)
template <int LAYER>
__device__ __forceinline__ void layer_body(const Args& a, const XcdBarrier& bar, const int lo, const int hi, const int bid, const int G, unsigned char* const shm, float* const sf, const float** const ptab) {
        constexpr int l = LAYER;
        constexpr int PB = 1 + 16 * l;
        const bool lastl = (l == 1);

        const int nPanels = lastl ? 64 : 68;
        const int M2 = nPanels * 256;

        if (IN(PB + 0)) for (int rep_ = 0; rep_ < (l == 0 ? PROBE_REPS(0) : 1); ++rep_) {
            PH_BEGIN
            {   const int n_win = 32 * 55, n_br = 4 * 64, n_out = 32 * 8, n_glu = 16, n_gu = 16 * 2 * 192, n_d = 16 * 192;
                const int n_grp1 = n_win + n_br + n_out + n_glu, total = n_grp1 + n_gu + n_d;
                const int q_lo = (l > 0 && G > 128) ? n_win : 0;
                const int q_hi = (lastl && G > 64) ? n_grp1 + n_gu - 1536 : total;
                CV_RUN(l, q_lo + bid, G, q_hi);
                for (int i = bid * NTHR + tid; i < (GATE2 - GATE_OFF) * DM / 8; i += G * NTHR) ((u32x4*)(WIN + (size_t)GATE_OFF * DM))[i] = (u32x4){0u, 0u, 0u, 0u};
            }
            for (int set = 0; set < (lastl ? 1 : 2); ++set) {
                const int L = set ? CTXL : SEQ; float* HR = HRAW + (set ? (size_t)SEQ * 2048 : 0);
                const float* w1 = PT(11) + l * 33 * 64; const float* b1 = PT(12) + l * 64; const float* fr1 = PT(13) + l * 64; const float* w2 = PT(14) + l * 64 * 64; const float* b2 = PT(15) + l * 64;
                const float* fr2 = PT(16) + l * 64; const float* w3 = PT(17) + l * 64 * 2048; const float* decay = PT(18) + l * 2048;
                float* feats = sf; float* h1 = sf + 16 * 33; float* h2 = h1 + 16 * 64;
                float nacc[4] = {0.f, 0.f, 0.f, 0.f};
                for (int base = bid; base < L; base += 16 * G) {
                    __syncthreads();
                    for (int e = tid; e < 16 * 33; e += NTHR) { const int ti = e / 33, fi = e % 33; int t = base + ti * G; if (t > L - 1) t = L - 1;
                        float v;
                        if (fi == 0) v = (float)t / (float)(L - 1);
                        else { const int j = (fi - 1) & 15; const double fr = 1e-4 + (double)j * ((15.0 - 1e-4) / 15.0); const double ang = (2.0 * 3.14159265358979323846 / (double)L) * (double)t * fr; v = fi <= 16 ? (float)cos(ang) : (float)(-sin(ang)); }
                        feats[e] = v; }
                    __syncthreads();
                    { const int j = tid & 63, ti = tid >> 6; float s0 = b1[j], s1 = s0;
_Pragma("unroll 3")
                      for (int i = 0; i < 33; ++i) { const float wv = w1[i * 64 + j]; s0 += feats[ti * 33 + i] * wv; s1 += feats[(ti + 8) * 33 + i] * wv; }
                      const float f1 = fr1[j]; h1[ti * 64 + j] = sinf(f1 * s0); h1[(ti + 8) * 64 + j] = sinf(f1 * s1); }
                    __syncthreads();
                    { const int j = tid & 63, ti = tid >> 6; float s0 = b2[j], s1 = s0;
_Pragma("unroll 4")
                      for (int i = 0; i < 64; ++i) { const float wv = w2[i * 64 + j]; s0 += h1[ti * 64 + i] * wv; s1 += h1[(ti + 8) * 64 + i] * wv; }
                      const float f2 = fr2[j]; h2[ti * 64 + j] = sinf(f2 * s0); h2[(ti + 8) * 64 + j] = sinf(f2 * s1); }
                    __syncthreads();
                    float acc[16][4];
#pragma unroll
                    for (int ti = 0; ti < 16; ++ti) { acc[ti][0] = 0.f; acc[ti][1] = 0.f; acc[ti][2] = 0.f; acc[ti][3] = 0.f; }
#pragma unroll 2
                    for (int i = 0; i < 64; ++i) { const float* wrow = w3 + (size_t)i * 2048 + tid; const float wa = wrow[0], wb = wrow[512], wc2 = wrow[1024], wd2 = wrow[1536];
#pragma unroll
                        for (int ti = 0; ti < 16; ++ti) { const float hv = h2[ti * 64 + i]; acc[ti][0] += hv * wa; acc[ti][1] += hv * wb; acc[ti][2] += hv * wc2; acc[ti][3] += hv * wd2; } }
                    float dk[4];
#pragma unroll
                    for (int k = 0; k < 4; ++k) dk[k] = fabsf(decay[tid + k * 512]);
#pragma unroll
                    for (int ti = 0; ti < 16; ++ti) { const int t = base + ti * G; if (t < L) { const float tn = (float)t / (float)(L - 1);
#pragma unroll
                        for (int k = 0; k < 4; ++k) { const float v = acc[ti][k] * expf(-tn * dk[k]); HR[(size_t)t * 2048 + tid + k * 512] = v; nacc[k] += fabsf(v); } } }
                }
                float* nrp = NORMP + ((size_t)(l * 2 + set) * 256 + bid) * 2048;
#pragma unroll
                for (int k = 0; k < 4; ++k) nrp[tid + k * 512] = nacc[k];
            }
            for (int idx = bid * NTHR + tid; idx < 4096; idx += G * NTHR) { const int n = idx & 63, g = (idx >> 6) & 31, dir = idx >> 11;
                const double are = (double)(PT(24) + l * 4096)[idx], aim = (double)(PT(25) + l * 4096)[idx]; const double lam = are < -1e-4 ? are : -1e-4; const double dt = exp((double)(PT(26) + l * 64)[dir * 32 + g]);
                const double ldre = lam * dt, ldim = aim * dt; LDT[idx] = make_double2(ldre, ldim);
                const double mag = exp(ldre); const double ar = mag * cos(ldim), ai = mag * sin(ldim);
                const double den = lam * lam + aim * aim; const double nr = ar - 1.0, ni = ai; const double fre = (nr * lam + ni * aim) / den, fim = (ni * lam - nr * aim) / den;
                const float* b_re = PT(27) + l * 32 * 64 * 16; const float* b_im = PT(28) + l * 32 * 64 * 16;
#pragma unroll 4
                for (int c = 0; c < 16; ++c) { const double br = (double)b_re[(g * 64 + n) * 16 + c], bi = (double)b_im[(g * 64 + n) * 16 + c]; BBT[idx * 16 + c] = make_float2((float)(fre * br - fim * bi), (float)(fre * bi + fim * br)); }
            }
            for (int e2 = bid * NTHR + tid; e2 < 4096 * 33; e2 += G * NTHR) { const int idx = e2 / 33, k = e2 - idx * 33; const int g = (idx >> 6) & 31, dir = idx >> 11;
                const double are = (double)(PT(24) + l * 4096)[idx], aim = (double)(PT(25) + l * 4096)[idx]; const double lam = are < -1e-4 ? are : -1e-4; const double dt = exp((double)(PT(26) + l * 64)[dir * 32 + g]);
                const double ldre = lam * dt, ldim = aim * dt; const double mk = exp(ldre * k); APW[e2] = make_float2((float)(mk * cos(ldim * k)), (float)(mk * sin(ldim * k))); }
            if (l == 0 && lo == 0) xcd_barrier(bar);
            for (int tok = bid * 8 + wave; tok < NTOK; tok += G * 8) {
                const int r = tok < NLAT ? tok / SEQ : 4; const float* xr = l == 0 ? (tok < NLAT ? x_in + (size_t)tok * DM : ctx_in + (size_t)(tok - NLAT) * DM) : XS + (size_t)tok * DM; const float* gn = norm_mix + l * DM;
                const float* sh = MODl + (size_t)(r * 6 + 0) * DM; const float* sc = MODl + (size_t)(r * 6 + 1) * DM;
                float4 v[8]; float ss = 0.f;
#pragma unroll
                for (int i = 0; i < 8; ++i) v[i] = *(const float4*)(xr + i * 256 + lane * 4);
                if (l > 0) {
                    moe_combine(v, tok, lane, INV, ROWGATE, YEXP, MOD + (size_t)((l - 1) * 5 + r) * 6 * DM + 5 * DM);
#pragma unroll
                    for (int i = 0; i < 8; ++i) *(float4*)(XS + (size_t)tok * DM + i * 256 + lane * 4) = v[i]; }
#pragma unroll
                for (int i = 0; i < 8; ++i) ss += v[i].x * v[i].x + v[i].y * v[i].y + v[i].z * v[i].z + v[i].w * v[i].w;
                ss = wave_sum(ss); const float rs = rsqrtf(ss * (1.0f / DM) + 1e-6f);
#pragma unroll
                for (int i = 0; i < 8; ++i) { const int d = i * 256 + lane * 4; const float4 g4 = *(const float4*)(gn + d), s4 = *(const float4*)(sc + d), h4 = *(const float4*)(sh + d);
                    v[i].x = v[i].x * rs * g4.x * (1.f + s4.x) + h4.x; v[i].y = v[i].y * rs * g4.y * (1.f + s4.y) + h4.y; v[i].z = v[i].z * rs * g4.z * (1.f + s4.z) + h4.z; v[i].w = v[i].w * rs * g4.w * (1.f + s4.w) + h4.w; }
#pragma unroll
                for (int i = 0; i < 8; ++i) { u32x2 w; w.x = pk2(v[i].x, v[i].y); w.y = pk2(v[i].z, v[i].w); *(u32x2*)(HB + (size_t)tok * DM + i * 256 + lane * 4) = w; }
            }
            SEAM(PB + 0);
        }

        if (IN(PB + 1)) for (int rep_ = 0; rep_ < PROBE_REPS(1); ++rep_) {
            PH_BEGIN
            for (int base = bid * 8; base < (lastl ? 1 : 2) * 1024; base += G * 8) {
                const int idx = base + (tid & 7), sl = tid >> 3; const int set = idx >> 10, oc = idx & 1023, o = oc >> 9, c = oc & 511;
                const float* pp = NORMP + (size_t)(l * 2 + set) * 256 * 2048 + o * 1024 + c + (size_t)(sl * 4) * 2048; float sacc = 0.f;
#pragma unroll
                for (int j = 0; j < 4; ++j) { const float p0 = pp[(size_t)j * 2048], p1 = pp[(size_t)j * 2048 + 512]; sacc += (sl * 4 + j < G) ? p0 + p1 : 0.f; }
                sf[sl * 8 + (tid & 7)] = sacc; __syncthreads();
                if (tid < 8) { float t = 0.f;
#pragma unroll 8
                    for (int q = 0; q < 64; ++q) t += sf[q * 8 + tid];
                    NORM[(size_t)(l * 2 + set) * 1024 + oc] = t; }
                __syncthreads(); }
            for (int idx = (G - 1 - bid) * NTHR + tid; idx < 32768; idx += G * NTHR) { const int c = idx & 15, lag = (idx >> 4) & 31, dir = (idx >> 9) & 1, g = idx >> 10;
                const float* c_re = PT(29) + l * 32 * 16 * 64 + (g * 16 + c) * 64; const float* c_im = PT(30) + l * 32 * 16 * 64 + (g * 16 + c) * 64;
                float acc[16];
#pragma unroll
                for (int j = 0; j < 16; ++j) acc[j] = 0.f;
#pragma unroll 2
                for (int n = 0; n < 64; ++n) { const int pi = (dir * 32 + g) * 64 + n; const float2 ap = APW[pi * 33 + lag]; const float cr = c_re[n], ci = c_im[n]; const float wr_ = cr * ap.x - ci * ap.y, wi_ = cr * ap.y + ci * ap.x;
                    const float4* bb = (const float4*)(BBT + pi * 16);
#pragma unroll
                    for (int j = 0; j < 8; ++j) { const float4 b2 = bb[j]; acc[2 * j] += wr_ * b2.x - wi_ * b2.y; acc[2 * j + 1] += wr_ * b2.z - wi_ * b2.w; } }
                float4* o = (float4*)(KTB + (size_t)idx * 16);
                o[0] = make_float4(acc[0], acc[1], acc[2], acc[3]); o[1] = make_float4(acc[4], acc[5], acc[6], acc[7]); o[2] = make_float4(acc[8], acc[9], acc[10], acc[11]); o[3] = make_float4(acc[12], acc[13], acc[14], acc[15]);
            }
            __syncthreads();
            pg8::Gemm g{HB, WIN, DM, DM, DM}; pg8::SchedStd S{68, 55, G, bid, DM, DM}; pg8::EpiWin E{P, LDP};
            pg8::gemm_phase(( LAS unsigned char*)shm, g, S, E);
#if defined(PROBE_BNOEPI)
            { __syncthreads(); pg8::EpiNone E0; pg8::gemm_phase((LAS unsigned char*)shm, g, S, E0); }
#endif
            SEAM(PB + 1);
        }

        if (IN(PB + 2)) for (int rep_ = 0; rep_ < PROBE_REPS(2); ++rep_) {
            PH_BEGIN
            const float* hcw = PT(9) + l * 3 * 1536; const float* hcb = PT(10) + l * 1536; const float* mcw = PT(20) + l * 3 * 1024; const float* mcb = PT(21) + l * 1024;
            const float* scw = PT(34) + l * 3 * 1024; const float* scb = PT(35) + l * 1024;
            for (int unit = bid; unit < 272 * 3; unit += G) { const int seg = unit / 3, kind = unit % 3; const bool lat = seg < 256; const size_t tok0 = lat ? (size_t)seg * 64 : (size_t)NLAT + (size_t)(seg - 256) * 64;
                if (kind < 2) { const int hf = kind;
                    const int c = tid * 2; const int col = (hf ? SSD_OFF + 512 : ML_OFF) + c; const float* w = hf ? scw : mcw; const float* bsp = hf ? scb : mcb; bf16_t* dst = (hf ? XBC : QKB) + tok0 * 1024 + c;
                    const float2 w0 = *(const float2*)(w + c), w1 = *(const float2*)(w + 1024 + c), w2 = *(const float2*)(w + 2048 + c), bb = *(const float2*)(bsp + c);
                    const float osc = (!hf && c >= 512) ? 0.08838834764831845f : 1.0f;
                    const bool hasPrev = !lat && ((tok0 - NLAT) & (CTXL - 1)) != 0, hasNext = !lat && (((tok0 - NLAT) + 63) & (CTXL - 1)) != CTXL - 1;
                    bf16_t* strip = nullptr;
                    if (!hf) { if (c >= 512) strip = KTG + ((size_t)seg * 512 + (c - 512)) * 64; }
                    else { if (c < 512) strip = XTG + ((size_t)seg * 512 + c) * 64; else if (c < 768) strip = BTG + ((size_t)seg * 256 + (c - 512)) * 64; }
                    const bf16_t* pp = P + tok0 * LDP + col;
                    unsigned raw[66];
#pragma unroll
                    for (int t = 0; t < 66; ++t) raw[t] = ((t == 0 && !hasPrev) || (t == 65 && !hasNext)) ? 0u : *(const unsigned*)(pp + (ptrdiff_t)(t - 1) * LDP);
#pragma unroll
                    for (int t8 = 0; t8 < 8; ++t8) { float v0[8], v1[8];
#pragma unroll
                        for (int tt = 0; tt < 8; ++tt) { const int t = t8 * 8 + tt; const unsigned p0 = raw[t], p1 = raw[t + 1], p2 = raw[t + 2];
                            float a0 = bb.x + w0.x * __uint_as_float(p0 << 16) + w1.x * __uint_as_float(p1 << 16) + w2.x * __uint_as_float(p2 << 16);
                            float a1 = bb.y + w0.y * __uint_as_float(p0 & 0xFFFF0000u) + w1.y * __uint_as_float(p1 & 0xFFFF0000u) + w2.y * __uint_as_float(p2 & 0xFFFF0000u);
                            a0 = siluf_(a0) * osc; a1 = siluf_(a1) * osc; v0[tt] = a0; v1[tt] = a1;
                            *(unsigned*)(dst + (size_t)t * 1024) = pk2(a0, a1); }
                        if (strip) { u32x4 s0, s1; s0.x = pk2(v0[0], v0[1]); s0.y = pk2(v0[2], v0[3]); s0.z = pk2(v0[4], v0[5]); s0.w = pk2(v0[6], v0[7]); s1.x = pk2(v1[0], v1[1]); s1.y = pk2(v1[2], v1[3]); s1.z = pk2(v1[4], v1[5]); s1.w = pk2(v1[6], v1[7]);
                            *(u32x4*)(strip + t8 * 8) = s0; *(u32x4*)(strip + 64 + t8 * 8) = s1; } }
                } else {
                    const int c = (tid & 255) * 2, th = tid >> 8; const bf16_t* pp = P + (tok0 + th * 32) * LDP + ML_OFF + 1024 + c; bf16_t* strip = VTG + ((size_t)seg * 512 + c) * 64 + th * 32;
                    unsigned rv[32];
#pragma unroll
                    for (int t = 0; t < 32; ++t) rv[t] = *(const unsigned*)(pp + (size_t)t * LDP);
#pragma unroll
                    for (int t8 = 0; t8 < 4; ++t8) { u32x4 s0, s1;
                        s0.x = (rv[t8 * 8 + 0] & 0xFFFFu) | (rv[t8 * 8 + 1] << 16); s0.y = (rv[t8 * 8 + 2] & 0xFFFFu) | (rv[t8 * 8 + 3] << 16); s0.z = (rv[t8 * 8 + 4] & 0xFFFFu) | (rv[t8 * 8 + 5] << 16); s0.w = (rv[t8 * 8 + 6] & 0xFFFFu) | (rv[t8 * 8 + 7] << 16);
                        s1.x = (rv[t8 * 8 + 0] >> 16) | (rv[t8 * 8 + 1] & 0xFFFF0000u); s1.y = (rv[t8 * 8 + 2] >> 16) | (rv[t8 * 8 + 3] & 0xFFFF0000u); s1.z = (rv[t8 * 8 + 4] >> 16) | (rv[t8 * 8 + 5] & 0xFFFF0000u); s1.w = (rv[t8 * 8 + 6] >> 16) | (rv[t8 * 8 + 7] & 0xFFFF0000u);
                        *(u32x4*)(strip + t8 * 8) = s0; *(u32x4*)(strip + 64 + t8 * 8) = s1; }
                }
            }
            if (!lastl) for (int tok = NLAT + bid; tok < NTOK; tok += G) {
                const int t = (tok - NLAT) & (CTXL - 1); const bool hasL = (t != 0), hasR = (t != CTXL - 1); const bf16_t* pr = P + (size_t)tok * LDP;
                const bf16_t* prL = hasL ? pr - LDP : pr; const bf16_t* prR = hasR ? pr + LDP : pr;
                unsigned xc[3], xl[3], xr[3];
#pragma unroll
                for (int j = 0; j < 3; ++j) { const int cc = tid + j * 512; xc[j] = pr[HY_OFF + cc]; xl[j] = prL[HY_OFF + cc]; xr[j] = prR[HY_OFF + cc]; }
#pragma unroll
                for (int j = 0; j < 3; ++j) { const int cc = tid + j * 512;
                    float acc = hcb[cc] + hcw[1536 + cc] * __uint_as_float(xc[j] << 16);
                    acc += hasL ? hcw[cc] * __uint_as_float(xl[j] << 16) : 0.f;
                    acc += hasR ? hcw[2 * 1536 + cc] * __uint_as_float(xr[j] << 16) : 0.f;
                    U[(size_t)tok * 1536 + cc] = acc; }
            }
            for (int idx0 = bid * NTHR + tid; idx0 < 16384 * 64; idx0 += 4 * G * NTHR) { u32x4 t4[4];
#pragma unroll
                for (int q = 0; q < 4; ++q) { const int idx = idx0 + q * G * NTHR; const int half = idx & 1, g = (idx >> 1) & 31, tok = idx >> 6;
                    if (idx < 16384 * 64) t4[q] = *(const u32x4*)(P + (size_t)tok * LDP + S5_OFF + g * 16 + half * 8); }
#pragma unroll
                for (int q = 0; q < 4; ++q) { const int idx = idx0 + q * G * NTHR; const int half = idx & 1, g = (idx >> 1) & 31, tok = idx >> 6;
                    if (idx < 16384 * 64) *(u32x4*)(S5A + ((size_t)g * 512 + (tok >> 5)) * 768 + (tok & 31) * 16 + half * 8) = t4[q]; } }
            for (int idx = bid * NTHR + tid; idx < 32 * 512 * 32 * 2; idx += G * NTHR) { const int half = idx & 1, sI = (idx >> 1) & 31, row = (idx >> 6) & 511, g = idx >> 15; const int t = row >> 4, c = row & 15; const int lag = t - sI;
                float v[8];
                if (lag > 0) { const float4* k4 = (const float4*)(KTB + ((size_t)((g * 2 + 0) * 32 + lag) * 16 + c) * 16 + half * 8); const float4 a0 = k4[0], a1 = k4[1]; v[0] = a0.x; v[1] = a0.y; v[2] = a0.z; v[3] = a0.w; v[4] = a1.x; v[5] = a1.y; v[6] = a1.z; v[7] = a1.w; }
                else if (lag < 0) { const float4* k4 = (const float4*)(KTB + ((size_t)((g * 2 + 1) * 32 - lag) * 16 + c) * 16 + half * 8); const float4 a0 = k4[0], a1 = k4[1]; v[0] = a0.x; v[1] = a0.y; v[2] = a0.z; v[3] = a0.w; v[4] = a1.x; v[5] = a1.y; v[6] = a1.z; v[7] = a1.w; }
                else { const float4* k4 = (const float4*)(KTB + ((size_t)((g * 2 + 0) * 32) * 16 + c) * 16 + half * 8); const float4* q4 = (const float4*)(KTB + ((size_t)((g * 2 + 1) * 32) * 16 + c) * 16 + half * 8); const float4 a0 = k4[0], a1 = k4[1], b0 = q4[0], b1 = q4[1];
                    v[0] = a0.x + b0.x; v[1] = a0.y + b0.y; v[2] = a0.z + b0.z; v[3] = a0.w + b0.w; v[4] = a1.x + b1.x; v[5] = a1.y + b1.y; v[6] = a1.z + b1.z; v[7] = a1.w + b1.w; }
                u32x4 w; w.x = pk2(v[0], v[1]); w.y = pk2(v[2], v[3]); w.z = pk2(v[4], v[5]); w.w = pk2(v[6], v[7]);
                *(u32x4*)(S5B + ((size_t)g * 512 + row) * 768 + sI * 16 + half * 8) = w; }
            for (int idx = bid * NTHR + tid; idx < 32 * 512 * 64; idx += G * NTHR) { const int n = idx & 63, row = (idx >> 6) & 511, g = idx >> 15; const int t = row >> 4, c = row & 15;
                const float cr = (PT(29) + l * 32 * 16 * 64)[(g * 16 + c) * 64 + n], ci = (PT(30) + l * 32 * 16 * 64)[(g * 16 + c) * 64 + n];
                const float2 af = APW[((0 * 32 + g) * 64 + n) * 33 + t + 1], ab = APW[((1 * 32 + g) * 64 + n) * 33 + 32 - t];
                bf16_t* d = S5B + ((size_t)g * 512 + row) * 768 + 512 + 2 * n;
                *(unsigned*)d = pk2(cr * af.x - ci * af.y, -(cr * af.y + ci * af.x)); *(unsigned*)(d + 128) = pk2(cr * ab.x - ci * ab.y, -(cr * ab.y + ci * ab.x)); }
            for (int idx = bid * NTHR + tid; idx < 32 * 2 * 64 * 32; idx += G * NTHR) { const int sI = idx & 31, n = (idx >> 5) & 63, dir = (idx >> 11) & 1, g = idx >> 12; const int pi = (dir * 32 + g) * 64 + n;
                const float2 pw = APW[pi * 33 + (dir ? sI : 31 - sI)]; const float4* bb = (const float4*)(BBT + pi * 16);
                float re[16], im[16];
#pragma unroll
                for (int j = 0; j < 8; ++j) { const float4 b2 = bb[j]; re[2 * j] = pw.x * b2.x - pw.y * b2.y; im[2 * j] = pw.x * b2.y + pw.y * b2.x; re[2 * j + 1] = pw.x * b2.z - pw.y * b2.w; im[2 * j + 1] = pw.x * b2.w + pw.y * b2.z; }
                bf16_t* d = S5P + ((size_t)g * 256 + dir * 128 + 2 * n) * 512 + sI * 16;
                u32x4 w0, w1; w0.x = pk2(re[0], re[1]); w0.y = pk2(re[2], re[3]); w0.z = pk2(re[4], re[5]); w0.w = pk2(re[6], re[7]); w1.x = pk2(re[8], re[9]); w1.y = pk2(re[10], re[11]); w1.z = pk2(re[12], re[13]); w1.w = pk2(re[14], re[15]);
                *(u32x4*)d = w0; *(u32x4*)(d + 8) = w1;
                w0.x = pk2(im[0], im[1]); w0.y = pk2(im[2], im[3]); w0.z = pk2(im[4], im[5]); w0.w = pk2(im[6], im[7]); w1.x = pk2(im[8], im[9]); w1.y = pk2(im[10], im[11]); w1.z = pk2(im[12], im[13]); w1.w = pk2(im[14], im[15]);
                *(u32x4*)(d + 512) = w0; *(u32x4*)(d + 520) = w1; }
            {   float* T0 = sf; float* T1 = sf + 64 * 65;
                const int NU = 4 * 64 * 24; const int cL = tid & 63, tL = tid >> 6, c = tid >> 3, tq = (tid & 7) * 8;
                for (int unit = bid; unit < NU; unit += 2 * G) { const bool has2 = unit + G < NU; const int unit2 = has2 ? unit + G : unit;
                    const int ba = unit / (64 * 24), ra = (unit / 24) % 64, c0a = (unit % 24) * 64; const size_t toka = (size_t)ba * SEQ + ra * 64;
                    const int bb_ = unit2 / (64 * 24), rb = (unit2 / 24) % 64, c0b = (unit2 % 24) * 64; const size_t tokb = (size_t)bb_ * SEQ + rb * 64;
                    unsigned pa[8], pb[8];
#pragma unroll
                    for (int i = 0; i < 8; ++i) { pa[i] = P[(toka + tL + 8 * i) * LDP + HY_OFF + c0a + cL]; pb[i] = P[(tokb + tL + 8 * i) * LDP + HY_OFF + c0b + cL]; }
                    const int cca = c0a + c, ccb = c0b + c;
                    const float w0a = hcw[cca], w1a = hcw[1536 + cca], w2a = hcw[3072 + cca], bia = hcb[cca], w0b = hcw[ccb], w1b = hcw[1536 + ccb], w2b = hcw[3072 + ccb], bib = hcb[ccb];
                    __syncthreads();
#pragma unroll
                    for (int i = 0; i < 8; ++i) { T0[(tL + 8 * i) * 65 + cL] = __uint_as_float(pa[i] << 16); T1[(tL + 8 * i) * 65 + cL] = __uint_as_float(pb[i] << 16); }
                    __syncthreads();
                    {   float o8[8];
#pragma unroll
                        for (int i = 0; i < 8; ++i) { const int t = tq + i; float acc = bia + w1a * T0[t * 65 + c]; if (t > 0) acc += w0a * T0[(t - 1) * 65 + c]; if (t < 63) acc += w2a * T0[(t + 1) * 65 + c]; o8[i] = acc; }
                        u32x4 wv; wv.x = pk2(o8[0], o8[1]); wv.y = pk2(o8[2], o8[3]); wv.z = pk2(o8[4], o8[5]); wv.w = pk2(o8[6], o8[7]);
                        *(u32x4*)(UT + ((size_t)ba * 1536 + cca) * SEQ + ra * 64 + tq) = wv; }
                    if (has2) { float o8[8];
#pragma unroll
                        for (int i = 0; i < 8; ++i) { const int t = tq + i; float acc = bib + w1b * T1[t * 65 + c]; if (t > 0) acc += w0b * T1[(t - 1) * 65 + c]; if (t < 63) acc += w2b * T1[(t + 1) * 65 + c]; o8[i] = acc; }
                        u32x4 wv; wv.x = pk2(o8[0], o8[1]); wv.y = pk2(o8[2], o8[3]); wv.z = pk2(o8[4], o8[5]); wv.w = pk2(o8[6], o8[7]);
                        *(u32x4*)(UT + ((size_t)bb_ * 1536 + ccb) * SEQ + rb * 64 + tq) = wv; }
                } }
            if (!lastl) {
                const int L = CTXL; const float* HR = HRAW + (size_t)SEQ * 2048; float* K2 = K2C; const float* nrm = NORM + (size_t)(l * 2 + 1) * 1024;
                const size_t total = (size_t)(2 * L - 1) * 1024;
                for (size_t i = (size_t)bid * NTHR + tid; i < total; i += (size_t)G * NTHR) { const int j = (int)(i >> 10), oc = (int)(i & 1023), o = oc >> 9, c = oc & 511; const int lag = j - (L - 1);
                    const float v = lag >= 0 ? HR[(size_t)lag * 2048 + o * 1024 + c] : HR[(size_t)(-lag) * 2048 + o * 1024 + 512 + c];
                    K2[((size_t)j * 2 + o) * 512 + c] = v / nrm[oc]; }
            }
            {   __syncthreads(); fft_twiddles((float2*)(shm + FFT_X_BYTES), tid);
                for (int pr = bid; pr < 512; pr += G) hyena_spec_item(pr, HRAW, NORM + (size_t)(l * 2 + 0) * 1024, HSPEC, shm, tid);
                __syncthreads(); }
            SEAM(PB + 2);
        }

        if (IN(PB + 3)) for (int rep_ = 0; rep_ < PROBE_REPS(3); ++rep_) {
            PH_BEGIN
            if (rep_ > 0) { if (bid == 0 && tid == 0) __hip_atomic_store(QCTR + l * 64, 0, __ATOMIC_RELAXED, __HIP_MEMORY_SCOPE_AGENT); xcd_barrier(bar); }
            if (bid < 64) {
                mlstm_state_pass(bid >> 1, bid & 1, P, KTG, VTG, PT(22) + l * 16, CST, NST, MST, shm, tid);
            } else if (bid < 128) {
                { const int ch = bid - 64; const int dir_ = ch & 1, h_ = (ch >> 1) & 7; ssd_state_pass(ch, P, BTG, XTG, -expf(PT(37)[l * 16 + dir_ * 8 + h_]), PT(36)[l * 16 + dir_ * 8 + h_], SSTB, shm, tid); }
            } else if (bid < 160) {
                const int widx = (bid - 128) * 8 + wave; const int dir = widx & 1, g = (widx >> 1) & 31, b = widx >> 6; const int n = lane;
                float2* xb = (float2*)(shm + (size_t)wave * 16640); float2* ctab = xb + 16 * 65;
                const float* a_re = PT(24) + l * 2 * 32 * 64; const float* a_im = PT(25) + l * 2 * 32 * 64; const float* log_dt = PT(26) + l * 64;
                const float* b_re = PT(27) + l * 32 * 64 * 16; const float* b_im = PT(28) + l * 32 * 64 * 16; const float* c_re = PT(29) + l * 32 * 16 * 64; const float* c_im = PT(30) + l * 32 * 16 * 64;
#pragma unroll
                for (int c = 0; c < 16; ++c) ctab[c * 65 + lane] = make_float2(c_re[(g * 16 + c) * 64 + lane], c_im[(g * 16 + c) * 64 + lane]);
                float abr, abi, bbr[16], bbi[16];
                {   const double are = (double)a_re[(dir * 32 + g) * 64 + n], aim = (double)a_im[(dir * 32 + g) * 64 + n];
                    const double lam = are < -1e-4 ? are : -1e-4; const double dt = exp((double)log_dt[dir * 32 + g]);
                    const double mag = exp(lam * dt); const double ar = mag * cos(aim * dt), ai = mag * sin(aim * dt);
                    const double den = lam * lam + aim * aim; const double nr = ar - 1.0, ni = ai;
                    const double fre = (nr * lam + ni * aim) / den, fim = (ni * lam - nr * aim) / den;
                    abr = (float)ar; abi = (float)ai;
#pragma unroll
                    for (int c = 0; c < 16; ++c) { const double br = (double)b_re[(g * 64 + n) * 16 + c], bi = (double)b_im[(g * 64 + n) * 16 + c]; bbr[c] = (float)(fre * br - fim * bi); bbi[c] = (float)(fre * bi + fim * br); }
                }
                float xr = 0.f, xi = 0.f; float* Sout = (dir ? SB : SF) - (size_t)NLAT * BW;
                const int s = lane >> 2, cg = lane & 3;
                for (int i0 = 0; i0 < CTXL; i0 += 16) {
#pragma unroll 4
                    for (int ss = 0; ss < 16; ++ss) {
                        const size_t tok = (size_t)step_tok(b, dir, i0 + ss);
                        const u32x4* up = (const u32x4*)(P + tok * LDP + S5_OFF + g * 16);
                        float t0[8], t1[8]; unpack8(up[0], t0); unpack8(up[1], t1);
                        float bur = 0.f, bui = 0.f;
#pragma unroll
                        for (int c = 0; c < 8; ++c) { bur += t0[c] * bbr[c] + t1[c] * bbr[8 + c]; bui += t0[c] * bbi[c] + t1[c] * bbi[8 + c]; }
                        const float nxr = abr * xr - abi * xi + bur, nxi = abr * xi + abi * xr + bui; xr = nxr; xi = nxi;
                        xb[ss * 65 + lane] = make_float2(xr, xi);
                    }
                    asm volatile("s_waitcnt lgkmcnt(0)" ::: "memory");
                    float y0 = 0.f, y1 = 0.f, y2 = 0.f, y3 = 0.f;
                    for (int nn2 = 0; nn2 < 64; ++nn2) { const float2 xv = xb[s * 65 + nn2];
                        const float2 c0 = ctab[(cg * 4 + 0) * 65 + nn2], c1 = ctab[(cg * 4 + 1) * 65 + nn2], c2 = ctab[(cg * 4 + 2) * 65 + nn2], c3 = ctab[(cg * 4 + 3) * 65 + nn2];
                        y0 += xv.x * c0.x - xv.y * c0.y; y1 += xv.x * c1.x - xv.y * c1.y; y2 += xv.x * c2.x - xv.y * c2.y; y3 += xv.x * c3.x - xv.y * c3.y; }
                    const size_t toks = (size_t)step_tok(b, dir, i0 + s);
                    *(float4*)(Sout + toks * BW + g * 16 + cg * 4) = make_float4(y0, y1, y2, y3);
                    asm volatile("s_waitcnt lgkmcnt(0)" ::: "memory");
                }
                XCTX[((b * 32 + g) * 2 + dir) * 64 + n] = make_float2(xr, xi);
            } else {
                if (bid < 224) {
                    pg8::Gemm gg_{S5A, S5P, 768, 512, 512}; pg8::SchedS5a S_{bid - 160}; pg8::EpiXloc E_{XLOC};
                    pg8::gemm_phase((LAS unsigned char*)shm, gg_, S_, E_);
                    __syncthreads();
                }
                const int nhb = G - 160, hb = bid - 160; const float* bias = PT(19) + l * 1024; const int c = tid;
                const int nitems = lastl ? 0 : 4 * (CTXL / 8);
                for (int it = hb; it < nitems; it += nhb) {
                    int L, tokbase, b, t0; const float* K2;
                    { const int q = it; L = CTXL; tokbase = NLAT; b = q / (CTXL / 8); t0 = (q % (CTXL / 8)) * 8; K2 = K2C; }
                    const float* zb = U + (size_t)(tokbase + b * L) * 1536 + c;
                    float acc[8];
#pragma unroll
                    for (int i = 0; i < 8; ++i) acc[i] = 0.f;
                    const int base = t0 + L - 1;
                    for (int s = 0; s < L; s += 8) {
                        float k[15];
#pragma unroll
                        for (int mm = 0; mm < 15; ++mm) k[mm] = K2[((size_t)(base - s - 7 + mm) * 2 + 0) * 512 + c];
#pragma unroll
                        for (int ds = 0; ds < 8; ++ds) { const float z = zb[(size_t)(s + ds) * 1536];
#pragma unroll
                            for (int i = 0; i < 8; ++i) acc[i] += k[i - ds + 7] * z; }
                    }
#pragma unroll
                    for (int i = 0; i < 8; ++i) { const size_t tok = (size_t)(tokbase + b * L + t0 + i); const float zt = U[tok * 1536 + c]; Z[tok * BW + c] = (acc[i] + bias[c] * zt) * U[tok * 1536 + 512 + c]; }
                }
            }
            {   __syncthreads(); fft_twiddles((float2*)(shm + FFT_X_BYTES), tid);
                int* qslot = (int*)(shm + FFT_X_BYTES + 65536);
                for (;;) { __syncthreads(); if (tid == 0) *qslot = atomicAdd(QCTR + l * 64, 1); __syncthreads(); const int it = *qslot; if (it >= 1024) break;
                    hyena_fft_item(it, UT, HSPEC, PT(19) + l * 1024, YT, shm, tid); }
            }
            SEAM(PB + 3);
        }

        if (IN(PB + 4)) for (int rep_ = 0; rep_ < PROBE_REPS(4); ++rep_) {
            PH_BEGIN
            if (rep_ > 0) { if (bid == 0 && tid == 0) __hip_atomic_store(QCTR + l * 64 + 32, 0, __ATOMIC_RELAXED, __HIP_MEMORY_SCOPE_AGENT); xcd_barrier(bar); }
            if (bid >= G - 32) for (int idx = (bid - (G - 32)) * NTHR + tid; idx < 16384; idx += 32 * NTHR) { const int n = idx & 63, dir = (idx >> 6) & 1, b = (idx >> 7) & 3, g = idx >> 9;
                const float2 a32 = APW[((dir * 32 + g) * 64 + n) * 33 + 32]; float2 X = XCTX[((b * 32 + g) * 2 + dir) * 64 + n];
                const float* __restrict__ xl = XLOC + ((size_t)g * 512 + b * 128) * 256 + dir * 128 + 2 * n; bf16_t* __restrict__ dst = S5A + ((size_t)g * 512 + b * 128) * 768 + 512 + dir * 128 + 2 * n;
#pragma unroll 1
                for (int j0 = 0; j0 < 128; j0 += 16) { float2 xv[16];
#pragma unroll
                    for (int q = 0; q < 16; ++q) { const int j = dir ? 127 - (j0 + q) : j0 + q; xv[q] = *(const float2*)(xl + (size_t)j * 256); }
#pragma unroll
                    for (int q = 0; q < 16; ++q) { const int j = dir ? 127 - (j0 + q) : j0 + q;
                        *(unsigned*)(dst + (size_t)j * 768) = pk2(X.x, X.y);
                        const float nx = a32.x * X.x - a32.y * X.y + xv[q].x, ny = a32.x * X.y + a32.y * X.x + xv[q].y; X.x = nx; X.y = ny; } } }
            {   int* qslot = (int*)(shm + 102400);
                __syncthreads(); if (tid == 0) *qslot = atomicAdd(QCTR + l * 64 + 32, 1); __syncthreads();
                for (;;) { const int it = *qslot; if (it >= 32 * 68 + 64 * 68) break;
                    int nxt_ = 0; if (tid == 0) nxt_ = atomicAdd(QCTR + l * 64 + 32, 1);
                    if (it < 32 * 68) { const int chain = it / 68, c = it % 68; mlstm_out_item(chain, c, P, QKB, VTG, PT(22) + l * 16, CST, NST, MST, (chain & 1) ? HBk : HF, shm, tid); }
                    else { const int i2 = it - 32 * 68; const int chain = i2 / 68, c = i2 % 68; const int dir_ = chain & 1, h_ = (chain >> 1) & 7;
                        ssd_out_item(chain, c, P, XBC, XTG, -expf(PT(37)[l * 16 + dir_ * 8 + h_]), PT(36)[l * 16 + dir_ * 8 + h_], SSTB, dir_ ? YB : YF, shm, tid); }
                    __syncthreads(); if (tid == 0) *qslot = nxt_; __syncthreads(); }
            }
            __syncthreads();
            {   const float* bias = PT(19) + l * 1024 + 512; const int c = tid;
                const int nitems = lastl ? 0 : 4 * (CTXL / 8);
                for (int it = bid; it < nitems; it += G) {
                    int L, tokbase, b, t0; const float* K2;
                    { const int q = it; L = CTXL; tokbase = NLAT; b = q / (CTXL / 8); t0 = (q % (CTXL / 8)) * 8; K2 = K2C; }
                    const float* zb = Z + (size_t)(tokbase + b * L) * BW + c;
                    float acc[8];
#pragma unroll
                    for (int i = 0; i < 8; ++i) acc[i] = 0.f;
                    const int base = t0 + L - 1;
                    for (int s = 0; s < L; s += 8) {
                        float k[15];
#pragma unroll
                        for (int mm = 0; mm < 15; ++mm) k[mm] = K2[((size_t)(base - s - 7 + mm) * 2 + 1) * 512 + c];
#pragma unroll
                        for (int ds = 0; ds < 8; ++ds) { const float z = zb[(size_t)(s + ds) * BW];
#pragma unroll
                            for (int i = 0; i < 8; ++i) acc[i] += k[i - ds + 7] * z; }
                    }
#pragma unroll
                    for (int i = 0; i < 8; ++i) { const size_t tok = (size_t)(tokbase + b * L + t0 + i); const float zt = Z[tok * BW + c]; Y4[tok * DM + c] = f2bf((acc[i] + bias[c] * zt) * U[tok * 1536 + 1024 + c]); }
                }
            }
            SEAM(PB + 4);
        }

        if (IN(PB + 5)) for (int rep_ = 0; rep_ < PROBE_REPS(5); ++rep_) {
            PH_BEGIN
            const float* ml_norm = PT(23) + l * BW; const float* ssd_d = PT(38) + l * 8; const float* ssd_norm = PT(39) + l * BW; const float* s5_d = PT(31) + l * BW;
            if (bid < 128) {
                pg8::Gemm gg_{S5A, S5B, 768, 768, 768}; pg8::SchedS5b S_{bid}; pg8::EpiS5Out E_{P, s5_d, GG};
                pg8::gemm_phase((LAS unsigned char*)shm, gg_, S_, E_);
                __syncthreads();
            }
            for (int tok = bid * 8 + wave; tok < NTOK; tok += G * 8) {
                const int c0 = lane * 8; const bf16_t* pr = P + (size_t)tok * LDP; const size_t o5 = (size_t)tok * BW + c0;
                float hm[8], ys[8];
                const u32x4 ooq = *(const u32x4*)(pr + ML_OFF + 1536 + c0);
                const float4 g0 = *(const float4*)(ml_norm + c0), g1 = *(const float4*)(ml_norm + c0 + 4), n0 = *(const float4*)(ssd_norm + c0), n1 = *(const float4*)(ssd_norm + c0 + 4);
                { float fa[8], fb[8]; unpack8(*(const u32x4*)(HF + o5), fa); unpack8(*(const u32x4*)(HBk + o5), fb);
#pragma unroll
                  for (int j = 0; j < 8; ++j) hm[j] = fa[j] + fb[j]; }
                { float ya[8], yb[8]; unpack8(*(const u32x4*)(YF + o5), ya); unpack8(*(const u32x4*)(YB + o5), yb);
                  float xx[8], zz[8]; unpack8(*(const u32x4*)(XBC + (size_t)tok * 1024 + c0), xx); unpack8(*(const u32x4*)(pr + SSD_OFF + c0), zz); const float dsk = ssd_d[c0 >> 6];
#pragma unroll
                  for (int j = 0; j < 8; ++j) ys[j] = ya[j] + yb[j];
#pragma unroll
                  for (int j = 0; j < 8; ++j) ys[j] = (ys[j] + dsk * xx[j]) * siluf_(zz[j]); }
                float s1 = 0.f, s2 = 0.f;
#pragma unroll
                for (int j = 0; j < 8; ++j) { s1 += hm[j] * hm[j]; s2 += ys[j] * ys[j]; }
                s1 += __shfl_xor(s1, 1); s1 += __shfl_xor(s1, 2); s1 += __shfl_xor(s1, 4); s1 += __shfl_xor(s1, 8);
                s2 = wave_sum(s2);
                const float r1 = rsqrtf(s1 * (1.0f / 128.0f) + 1e-6f), r2 = rsqrtf(s2 * (1.0f / BW) + 1e-6f);
                float oo[8]; unpack8(ooq, oo);
                const float gm[8] = {g0.x, g0.y, g0.z, g0.w, g1.x, g1.y, g1.z, g1.w}, gs[8] = {n0.x, n0.y, n0.z, n0.w, n1.x, n1.y, n1.z, n1.w};
                u32x4 w;
                w.x = pk2(hm[0] * r1 * gm[0] * sigmoidf_(oo[0]), hm[1] * r1 * gm[1] * sigmoidf_(oo[1])); w.y = pk2(hm[2] * r1 * gm[2] * sigmoidf_(oo[2]), hm[3] * r1 * gm[3] * sigmoidf_(oo[3]));
                w.z = pk2(hm[4] * r1 * gm[4] * sigmoidf_(oo[4]), hm[5] * r1 * gm[5] * sigmoidf_(oo[5])); w.w = pk2(hm[6] * r1 * gm[6] * sigmoidf_(oo[6]), hm[7] * r1 * gm[7] * sigmoidf_(oo[7]));
                *(u32x4*)(Y4 + (size_t)tok * DM + 512 + c0) = w;
                w.x = pk2(ys[0] * r2 * gs[0], ys[1] * r2 * gs[1]); w.y = pk2(ys[2] * r2 * gs[2], ys[3] * r2 * gs[3]); w.z = pk2(ys[4] * r2 * gs[4], ys[5] * r2 * gs[5]); w.w = pk2(ys[6] * r2 * gs[6], ys[7] * r2 * gs[7]);
                *(u32x4*)(Y4 + (size_t)tok * DM + 1536 + c0) = w;
                if (tok >= NLAT) { const size_t oc = (size_t)(tok - NLAT) * BW + c0; float uu[8]; unpack8(*(const u32x4*)(pr + S5_OFF + c0), uu);
                    const float4 a0 = *(const float4*)(SF + oc), a1 = *(const float4*)(SF + oc + 4), b0 = *(const float4*)(SB + oc), b1 = *(const float4*)(SB + oc + 4), d0 = *(const float4*)(s5_d + c0), d1 = *(const float4*)(s5_d + c0 + 4);
                    float y[8] = {a0.x + b0.x + d0.x * uu[0], a0.y + b0.y + d0.y * uu[1], a0.z + b0.z + d0.z * uu[2], a0.w + b0.w + d0.w * uu[3], a1.x + b1.x + d1.x * uu[4], a1.y + b1.y + d1.y * uu[5], a1.z + b1.z + d1.z * uu[6], a1.w + b1.w + d1.w * uu[7]};
#pragma unroll
                    for (int j = 0; j < 8; ++j) y[j] = 0.5f * y[j] * (1.0f + tanhf(0.7978845608028654f * (y[j] + 0.044715f * y[j] * y[j] * y[j])));
                    w.x = pk2(y[0], y[1]); w.y = pk2(y[2], y[3]); w.z = pk2(y[4], y[5]); w.w = pk2(y[6], y[7]);
                    *(u32x4*)(GG + (size_t)tok * BW + c0) = w; }
            }
            __syncthreads();
            {   float* T = sf;
                for (int unit = (G > 128 ? bid - 128 : bid); unit >= 0 && unit < 4 * 64 * 8; unit += (G > 128 ? G - 128 : G)) { const int b = unit / 512, t0 = ((unit >> 3) & 63) * 64, c0 = (unit & 7) * 64;
                    __syncthreads();
#pragma unroll
                    for (int i = 0; i < 8; ++i) { const int t = tid & 63, c = (tid >> 6) + 8 * i; T[c * 65 + t] = YT[((size_t)b * 512 + c0 + c) * SEQ + t0 + t]; }
                    __syncthreads();
                    const int t = tid >> 3, cq = (tid & 7) * 8;
                    u32x4 w; w.x = pk2(T[(cq + 0) * 65 + t], T[(cq + 1) * 65 + t]); w.y = pk2(T[(cq + 2) * 65 + t], T[(cq + 3) * 65 + t]); w.z = pk2(T[(cq + 4) * 65 + t], T[(cq + 5) * 65 + t]); w.w = pk2(T[(cq + 6) * 65 + t], T[(cq + 7) * 65 + t]);
                    *(u32x4*)(Y4 + ((size_t)b * SEQ + t0 + t) * DM + c0 + cq) = w;
                } }
            SEAM(PB + 5);
        }

        if (IN(PB + 6)) for (int rep_ = 0; rep_ < PROBE_REPS(6); ++rep_) {
            PH_BEGIN
            pg8::Gemm g{GG, GLU, BW, BW, BW}; pg8::SchedStd S{68, 2, G, bid, BW, BW}; pg8::EpiGlu E{GG, PT(33) + l * BW, Y4};
            pg8::gemm_phase((LAS unsigned char*)shm, g, S, E);
            SEAM(PB + 6);
        }
        if (IN(PB + 7)) for (int rep_ = 0; rep_ < PROBE_REPS(7); ++rep_) {
            PH_BEGIN
            pg8::Gemm g{Y4, WBR, DM, BW, BW}; pg8::SchedBranch S{64, 8, G, bid}; pg8::EpiBranch E{P, ACCb};
            pg8::gemm_phase((LAS unsigned char*)shm, g, S, E);
            if (!lastl) { __syncthreads(); pg8::SchedTail S2{G, bid}; pg8::EpiPartK E2{(float*)HSPEC}; pg8::gemm_phase((LAS unsigned char*)shm, g, S2, E2); }
            SEAM(PB + 7);
        }
        if (IN(PB + 8)) for (int rep_ = 0; rep_ < PROBE_REPS(8); ++rep_) {
            PH_BEGIN
            if (!lastl) {
                const float* PART = (const float*)HSPEC;
                for (int idx = bid * NTHR + tid; idx < (NTOK - NLAT) * DM / 8; idx += G * NTHR) { const size_t o = (size_t)idx * 8; f32x4 p[4][2];
#pragma unroll
                    for (int k = 0; k < 4; ++k) { p[k][0] = *(const f32x4*)(PART + (size_t)k * (NTOK - NLAT) * DM + o); p[k][1] = *(const f32x4*)(PART + (size_t)k * (NTOK - NLAT) * DM + o + 4); }
                    f32x4 s0 = (f32x4){0.f, 0.f, 0.f, 0.f}, s1 = s0; const bf16_t* rp = P + (size_t)(NLAT + (o >> 11)) * LDP + GATE2 + (o & (DM - 1));
#pragma unroll
                    for (int k = 0; k < 4; ++k) { float rr[8]; unpack8(*(const u32x4*)(rp + k * DM), rr);
                        s0 = s0 + p[k][0]; s1 = s1 + p[k][1]; s0[0] *= rr[0]; s0[1] *= rr[1]; s0[2] *= rr[2]; s0[3] *= rr[3]; s1[0] *= rr[4]; s1[1] *= rr[5]; s1[2] *= rr[6]; s1[3] *= rr[7]; }
                    u32x4 w; w.x = pk2(s0[0], s0[1]); w.y = pk2(s0[2], s0[3]); w.z = pk2(s1[0], s1[1]); w.w = pk2(s1[2], s1[3]);
                    *(u32x4*)(ACCb + (size_t)NLAT * DM + o) = w; }
                xcd_barrier(bar);
            }
            pg8::Gemm g{ACCb, WOUT, DM, DM, DM}; pg8::SchedStd S{64, 8, G, bid, DM, DM}; pg8::EpiResid E{XS, l == 0 ? x_in : (const float*)XS, l == 0 ? ctx_in - (size_t)NLAT * DM : (const float*)XS, MODl, 2};
            pg8::gemm_phase((LAS unsigned char*)shm, g, S, E);
            if (!lastl) { __syncthreads(); pg8::Gemm g2{ACCb, WOUT, DM, DM, 512}; pg8::SchedTailK S2{G, bid}; pg8::EpiPartK E2{(float*)HSPEC + (size_t)4 * (NTOK - NLAT) * DM}; pg8::gemm_phase((LAS unsigned char*)shm, g2, S2, E2); }
            SEAM(PB + 8);
        }
        if (IN(PB + 9)) for (int rep_ = 0; rep_ < PROBE_REPS(9); ++rep_) {
            PH_BEGIN
            if (!lastl) {
                const float* PART = (const float*)HSPEC + (size_t)4 * (NTOK - NLAT) * DM; const float* mg = MODl + (size_t)(4 * 6 + 2) * DM;
                const float* src = l == 0 ? ctx_in : (const float*)XS + (size_t)NLAT * DM;
                for (int idx = bid * NTHR + tid; idx < (NTOK - NLAT) * DM / 4; idx += G * NTHR) { const size_t o = (size_t)idx * 4; const int col = (int)(o & (DM - 1));
                    const f32x4 p0 = *(const f32x4*)(PART + o), p1 = *(const f32x4*)(PART + (size_t)(NTOK - NLAT) * DM + o), p2 = *(const f32x4*)(PART + (size_t)2 * (NTOK - NLAT) * DM + o), p3 = *(const f32x4*)(PART + (size_t)3 * (NTOK - NLAT) * DM + o);
                    const f32x4 sv = *(const f32x4*)(src + o), gm = *(const f32x4*)(mg + col);
                    *(f32x4*)(XS + (size_t)NLAT * DM + o) = sv + gm * (((p0 + p1) + p2) + p3); }
                xcd_barrier(bar);
            }
            for (int i = bid * NTHR + tid; i < NEXP * MOE_PAD; i += G * NTHR) ROWTOK[i] = -1;
            for (int i = bid * NTHR + tid; i < NTOK * 16; i += G * NTHR) INV[i] = -1;
            const float* wr = PT(42) + (size_t)l * DM * 16; const float* gn = norm_ffn + l * DM;
            float* wl = sf;
            __syncthreads();
#pragma unroll 1
            for (int q0 = 0; q0 < 16; q0 += 4) {
                const float4 a0 = ((const float4*)wr)[(q0 + 0) * 512 + tid], a1 = ((const float4*)wr)[(q0 + 1) * 512 + tid], a2 = ((const float4*)wr)[(q0 + 2) * 512 + tid], a3 = ((const float4*)wr)[(q0 + 3) * 512 + tid];
                { const int f4 = (q0 + 0) * 512 + tid; *(float4*)(wl + (size_t)(f4 >> 4) * 68 + (f4 & 15) * 4) = a0; }
                { const int f4 = (q0 + 1) * 512 + tid; *(float4*)(wl + (size_t)(f4 >> 4) * 68 + (f4 & 15) * 4) = a1; }
                { const int f4 = (q0 + 2) * 512 + tid; *(float4*)(wl + (size_t)(f4 >> 4) * 68 + (f4 & 15) * 4) = a2; }
                { const int f4 = (q0 + 3) * 512 + tid; *(float4*)(wl + (size_t)(f4 >> 4) * 68 + (f4 & 15) * 4) = a3; } }
            __syncthreads();
            for (int tok0 = (bid * 8 + wave) * 4; tok0 < M2; tok0 += G * 32) {
                const int r = tok0 < NLAT ? tok0 / SEQ : 4; const float* xr = XS + (size_t)tok0 * DM;
                const float* sh = MODl + (size_t)(r * 6 + 3) * DM; const float* sc = MODl + (size_t)(r * 6 + 4) * DM;
                float rs[4];
#pragma unroll
                for (int tk = 0; tk < 4; ++tk) { float ss = 0.f;
#pragma unroll 4
                    for (int i = 0; i < 8; ++i) { const float4 t4 = *(const float4*)(xr + (size_t)tk * DM + i * 256 + lane * 4); ss += t4.x * t4.x + t4.y * t4.y + t4.z * t4.z + t4.w * t4.w; }
                    ss = wave_sum(ss); rs[tk] = rsqrtf(ss * (1.0f / DM) + 1e-6f); }
                float lg[4][16];
#pragma unroll
                for (int tk = 0; tk < 4; ++tk)
#pragma unroll
                    for (int e = 0; e < 16; ++e) lg[tk][e] = 0.f;
#pragma unroll 1
                for (int i = 0; i < 8; ++i) { const int d = i * 256 + lane * 4;
                    const float4 g4 = *(const float4*)(gn + d), s4 = *(const float4*)(sc + d), h4 = *(const float4*)(sh + d);
                    float4 xq[4], ww[16];
#pragma unroll
                    for (int tk = 0; tk < 4; ++tk) xq[tk] = *(const float4*)(xr + (size_t)tk * DM + d);
                    const float4* wq = (const float4*)(wl + (size_t)(i * 64 + lane) * 68);
#pragma unroll
                    for (int q = 0; q < 16; ++q) ww[q] = wq[q];
                    float hv[4][4];
#pragma unroll
                    for (int tk = 0; tk < 4; ++tk) { const float4 xv = xq[tk]; const float rr = rs[tk];
                        hv[tk][0] = xv.x * rr * g4.x * (1.f + s4.x) + h4.x; hv[tk][1] = xv.y * rr * g4.y * (1.f + s4.y) + h4.y; hv[tk][2] = xv.z * rr * g4.z * (1.f + s4.z) + h4.z; hv[tk][3] = xv.w * rr * g4.w * (1.f + s4.w) + h4.w;
                        u32x2 w; w.x = pk2(hv[tk][0], hv[tk][1]); w.y = pk2(hv[tk][2], hv[tk][3]); *(u32x2*)(HB + (size_t)(tok0 + tk) * DM + d) = w; }
#pragma unroll
                    for (int q = 0; q < 4; ++q) { const float4 w0 = ww[q * 4 + 0], w1 = ww[q * 4 + 1], w2 = ww[q * 4 + 2], w3 = ww[q * 4 + 3];
#pragma unroll
                        for (int tk = 0; tk < 4; ++tk) { const float hq = hv[tk][q];
                            lg[tk][0] += hq * w0.x; lg[tk][1] += hq * w0.y; lg[tk][2] += hq * w0.z; lg[tk][3] += hq * w0.w; lg[tk][4] += hq * w1.x; lg[tk][5] += hq * w1.y; lg[tk][6] += hq * w1.z; lg[tk][7] += hq * w1.w;
                            lg[tk][8] += hq * w2.x; lg[tk][9] += hq * w2.y; lg[tk][10] += hq * w2.z; lg[tk][11] += hq * w2.w; lg[tk][12] += hq * w3.x; lg[tk][13] += hq * w3.y; lg[tk][14] += hq * w3.z; lg[tk][15] += hq * w3.w; } } }
#pragma unroll
                for (int tk = 0; tk < 4; ++tk) { float mx = -1e30f;
#pragma unroll
                    for (int e = 0; e < 16; ++e) { lg[tk][e] = wave_sum(lg[tk][e]); mx = fmaxf(mx, lg[tk][e]); }
                    float sm = 0.f;
#pragma unroll
                    for (int e = 0; e < 16; ++e) { lg[tk][e] = expf(lg[tk][e] - mx); sm += lg[tk][e]; }
                    const float inv = 1.0f / sm;
                    if (lane == 0) {
#pragma unroll
                        for (int e = 0; e < 16; e += 4) *(float4*)(PROBS + (size_t)(tok0 + tk) * 16 + e) = make_float4(lg[tk][e] * inv, lg[tk][e + 1] * inv, lg[tk][e + 2] * inv, lg[tk][e + 3] * inv); } }
            }
            SEAM(PB + 9);
        }
        if (IN(PB + 10)) for (int rep_ = 0; rep_ < PROBE_REPS(10); ++rep_) {
            PH_BEGIN
            const int nitems = 64 + (lastl ? 0 : 64);
            unsigned long long* keys = (unsigned long long*)shm;
            for (int it = bid; it < nitems; it += G) {
                const int set = it >> 6, e = it & 15, b = (it >> 4) & 3;
                const int n = set ? CTXL : SEQ, cap = set ? 32 : 512, tokbase = set ? NLAT + b * CTXL : b * SEQ;
                __syncthreads();
                for (int i = tid; i < n; i += NTHR) keys[i] = ((unsigned long long)__float_as_uint(PROBS[(size_t)(tokbase + i) * 16 + e]) << 32) | (unsigned long long)(0xFFFFFFFFu - (unsigned)i);
                __syncthreads();
                for (int k = 2; k <= n; k <<= 1)
                    for (int j = k >> 1; j > 0; j >>= 1) {
                        for (int p = tid; p < (n >> 1); p += NTHR) { const int i = ((p & ~(j - 1)) << 1) | (p & (j - 1)); const int m = i | j;
                            const unsigned long long ka = keys[i], kb = keys[m]; const bool desc = ((i & k) == 0);
                            if ((ka < kb) == desc) { keys[i] = kb; keys[m] = ka; } }
                        __syncthreads();
                    }
                for (int r = tid; r < cap; r += NTHR) { const unsigned long long kk = keys[r]; const int row = e * MOE_PAD + (set ? 2048 + b * 32 + r : b * 512 + r);
                    const int tk_ = tokbase + (int)(0xFFFFFFFFu - (unsigned)(kk & 0xFFFFFFFFull)); ROWTOK[row] = tk_; ROWGATE[row] = __uint_as_float((unsigned)(kk >> 32)); INV[tk_ * 16 + e] = row; }
                for (int rb = 0; rb < cap; rb += 32) {
                    u32x4 t4[4][4];
#pragma unroll
                    for (int q = 0; q < 4; ++q) { const int r = rb + wave + 8 * q; const int tok = tokbase + (int)(0xFFFFFFFFu - (unsigned)(keys[r] & 0xFFFFFFFFull));
                        const u32x4* sp = (const u32x4*)(HB + (size_t)tok * DM);
#pragma unroll
                        for (int i = 0; i < 4; ++i) t4[q][i] = sp[i * 64 + lane]; }
#pragma unroll
                    for (int q = 0; q < 4; ++q) { const int r = rb + wave + 8 * q; const int row = e * MOE_PAD + (set ? 2048 + b * 32 + r : b * 512 + r);
                        u32x4* dp = (u32x4*)(XG + (size_t)row * DM);
#pragma unroll
                        for (int i = 0; i < 4; ++i) dp[i * 64 + lane] = t4[q][i]; } }
            }
            if (lastl && G > 64 && bid >= 64) {
                const int n_win = 32 * 55, n_br = 4 * 64, n_out = 32 * 8, n_glu = 16, n_gu = 16 * 2 * 192, n_d = 16 * 192;
                const int lo_d = n_win + n_br + n_out + n_glu + n_gu - 1536;
                CV_RUN(l, lo_d + bid - 64, G - 64, lo_d + 1536 + n_d);
            }
            if (!lastl && G > 128 && bid >= 128) {
                const int n_win = 32 * 55, n_br = 4 * 64, n_out = 32 * 8, n_glu = 16, n_gu = 16 * 2 * 192; (void)n_gu;
                CV_RUN(l + 1, bid - 128, G - 128, n_win); (void)n_br; (void)n_out; (void)n_glu;
            }
            {   const int pad0 = lastl ? 2048 : MOE_ROWS, npad = MOE_PAD - pad0;
                for (int R = bid * 8 + wave; R < NEXP * npad; R += G * 8) { const int e = R / npad, rr = pad0 + R % npad; u32x4* dp = (u32x4*)(XG + ((size_t)e * MOE_PAD + rr) * DM);
#pragma unroll
                    for (int i = 0; i < 4; ++i) dp[i * 64 + lane] = (u32x4){0u, 0u, 0u, 0u}; } }
            SEAM(PB + 10);
        }
        if (IN(PB + 12)) for (int rep_ = 0; rep_ < PROBE_REPS(12); ++rep_) {
            PH_BEGIN
            pg8::Gemm g{XG, WGU, DM, DM, DM}; pg8::SchedMoe S{lastl ? 8 : 9, 12, G, bid, DM, DM, 2 * DEXP}; pg8::EpiMoe1 E{HID};
            pg8::gemm_phase((LAS unsigned char*)shm, g, S, E);
            SEAM(PB + 12);
        }
        if (IN(PB + 13)) for (int rep_ = 0; rep_ < PROBE_REPS(13); ++rep_) {
            PH_BEGIN
            pg8::Gemm g{HID, WD, DEXP, DEXP, DEXP}; pg8::SchedMoe S{lastl ? 8 : 9, 8, G, bid, DEXP, DEXP, DM}; pg8::EpiMoeY E{YEXP};
            pg8::gemm_phase((LAS unsigned char*)shm, g, S, E);
            SEAM(PB + 13);
        }

}

__global__ __launch_bounds__(NTHR, 2) void fwd(Args a) {
    extern __shared__ __attribute__((aligned(16))) unsigned char shm[];
    const int bid = blockIdx.x, G = gridDim.x;
    float* const sf = (float*)shm;
    volatile LAS unsigned* xbw = (volatile LAS unsigned*)((LAS unsigned char*)shm + (LDS_BYTES - 16));
    if (threadIdx.x == 0) { xbw[0] = 0u; xbw[1] = 0u; xbw[2] = 0u; xbw[3] = 0u; }
    const float** const ptab = (const float**)(shm + (LDS_BYTES - 16 - 512));
    if (threadIdx.x == 0) {
#pragma unroll
        for (int i = 0; i < 47; ++i) ptab[i] = a.in[i]; }
    __syncthreads();
    XcdBarrier bar = xcd_barrier_post((unsigned*)(a.ws + O_BAR), xbw);
    const int lo = a.ph_lo, hi = a.ph_hi;
    if (IN(0)) {
        PH_BEGIN
        {
            __syncthreads();
            for (int i = tid; i < 5 * DM; i += NTHR) { const int r = i >> 11, k = i & (DM - 1); const float v = r < 4 ? c_in[r * DM + k] : cctx_in[k]; sf[i] = siluf_(v); }
            __syncthreads();
            float* red = sf + 5 * DM;
            for (int unit = bid; unit < 2 * 96; unit += G) { const int l = unit / 96, j = (unit % 96) * 128 + (tid & 127), kq = tid >> 7;
                const float* w = ada_w + (size_t)l * DM * (6 * DM) + (size_t)(kq * 512) * (6 * DM) + j; const float* sv = sf + kq * 512;
                float a0 = 0.f, a1 = 0.f, a2 = 0.f, a3 = 0.f, a4 = 0.f;
#pragma unroll 8
                for (int k = 0; k < 512; ++k) { const float wv = w[(size_t)k * (6 * DM)]; a0 += sv[k] * wv; a1 += sv[DM + k] * wv; a2 += sv[2 * DM + k] * wv; a3 += sv[3 * DM + k] * wv; a4 += sv[4 * DM + k] * wv; }
                __syncthreads();
                { float* rp = red + (kq * 5) * 128 + (tid & 127); rp[0] = a0; rp[128] = a1; rp[256] = a2; rp[384] = a3; rp[512] = a4; }
                __syncthreads();
                if (tid < 128) { const float bb = ada_b[l * 6 * DM + j]; float* o = MOD + (size_t)l * 5 * 6 * DM + j;
#pragma unroll
                    for (int r = 0; r < 5; ++r) o[(size_t)r * 6 * DM] = ((red[(0 * 5 + r) * 128 + tid] + red[(1 * 5 + r) * 128 + tid]) + (red[(2 * 5 + r) * 128 + tid] + red[(3 * 5 + r) * 128 + tid])) + bb; }
            }
        }
    }

    layer_body<0>(a, bar, lo, hi, bid, G, shm, sf, ptab);
    layer_body<1>(a, bar, lo, hi, bid, G, shm, sf, ptab);
    if (IN(33)) {
        PH_BEGIN
        const float* gn = PT(46);
        for (int tok = bid * 8 + wave; tok < NLAT; tok += G * 8) {
            const float* xr = XS + (size_t)tok * DM; float4 v[8]; float ss = 0.f;
#pragma unroll
            for (int i = 0; i < 8; ++i) v[i] = *(const float4*)(xr + i * 256 + lane * 4);
            moe_combine(v, tok, lane, INV, ROWGATE, YEXP, MOD + (size_t)(1 * 5 + tok / SEQ) * 6 * DM + 5 * DM);
#pragma unroll
            for (int i = 0; i < 8; ++i) {                 ss += v[i].x * v[i].x + v[i].y * v[i].y + v[i].z * v[i].z + v[i].w * v[i].w; }
            ss = wave_sum(ss); const float rs = rsqrtf(ss * (1.0f / DM) + 1e-6f);
#pragma unroll
            for (int i = 0; i < 8; ++i) { const int d = i * 256 + lane * 4; const float4 g4 = *(const float4*)(gn + d);
                *(float4*)(a.out + (size_t)tok * DM + d) = make_float4(v[i].x * rs * g4.x, v[i].y * rs * g4.y, v[i].z * rs * g4.z, v[i].w * rs * g4.w); }
        }
    }
#undef IN
#undef SEAM
}


extern "C" void kernel_launch(void* const* d_in, const int* in_sizes, int n_in, void* d_out, int out_size, void* d_ws, size_t ws_size, hipStream_t stream) {
    static int grid = 0;
    if (grid == 0) {
        if (n_in != 47 || ws_size < WS_END) { fprintf(stderr, "kernel_launch: expected 47 inputs and >= %zu bytes of workspace; got %d, %zu\n", (size_t)WS_END, n_in, ws_size); grid = -1; return; }
        int dev = 0, cus = 0;
        if (hipGetDevice(&dev) != hipSuccess || hipDeviceGetAttribute(&cus, hipDeviceAttributeMultiprocessorCount, dev) != hipSuccess) { grid = -1; return; }
        if (hipFuncSetAttribute((const void*)fwd, hipFuncAttributeMaxDynamicSharedMemorySize, LDS_BYTES) != hipSuccess) { fprintf(stderr, "kernel_launch: hipFuncSetAttribute failed\n"); grid = -1; return; }
        int per_cu = 0;
        if (hipOccupancyMaxActiveBlocksPerMultiprocessor(&per_cu, (const void*)fwd, NTHR, LDS_BYTES) != hipSuccess || per_cu < 1) fprintf(stderr, "kernel_launch: occupancy query reports %d\n", per_cu);
        (void)hipGetLastError();
        grid = cus > 256 ? 256 : cus;
        if (grid < 224) { fprintf(stderr, "kernel_launch: needs >= 224 CUs (got %d)\n", grid); grid = -1; return; }
    }
    if (grid < 0) return;
    (void)hipMemsetAsync((char*)d_ws, 0, O_ZERO_END, stream);
    Args a{};
    for (int i = 0; i < 47; ++i) a.in[i] = (const float*)d_in[i];
    a.out = (float*)d_out; a.ws = (unsigned char*)d_ws;
#if MK_ONE_LAUNCH
    a.ph_lo = 0; a.ph_hi = 64;
    hipLaunchKernelGGL(fwd, dim3(grid), dim3(NTHR), LDS_BYTES, stream, a);
#else
    const int ids[] = {0, 1,2,3,4,5,6,7,8,9,10,11,12,13,14, 17,18,19,20,21,22,23,24,25,26,27,28,29,30, 33};
    for (int k = 0; k < (int)(sizeof(ids) / sizeof(ids[0])); ++k) { a.ph_lo = ids[k]; a.ph_hi = ids[k] + 1; hipLaunchKernelGGL(fwd, dim3(grid), dim3(NTHR), LDS_BYTES, stream, a); }
#endif
}
```

```cpp
#include <hip/hip_runtime.h>
#include <stdint.h>
#include <stdio.h>

#ifndef PROBE_MASK
#define PROBE_MASK 0
#endif
#ifndef PROBE_SP
#define PROBE_SP 1
#endif
#define PROBE_REPS(k) ((((PROBE_MASK) >> (k)) & 1) + 1)
#ifndef MK_ONE_LAUNCH
#define MK_ONE_LAUNCH 1
#endif

#define DM 2048
#define NB 4
#define SEQ 4096
#define CTXL 256
#define BW 512
#define NLAT 16384
#define NCTX 1024
#define NTOK 17408
#define IN_W 13856
#define GATE2 5888
#define LDP 14080
#define HY_OFF 0
#define ML_OFF 1536
#define S5_OFF 3600
#define SSD_OFF 4112
#define GATE_OFF 5664
#define NEXP 16
#define DEXP 1536
#define MOE_ROWS 2176
#define MOE_PAD 2304
#define NTHR 512
#define LDS_BYTES 147456
#define LAS __attribute__((address_space(3)))

typedef unsigned short bf16_t;
typedef short bf16x8 __attribute__((ext_vector_type(8)));
typedef float f32x4 __attribute__((ext_vector_type(4)));
typedef unsigned u32x4 __attribute__((ext_vector_type(4)));
typedef unsigned u32x2 __attribute__((ext_vector_type(2)));

#define XB_TMO      128
#define XB_XCNT(j)  (256  + 64 * (j))
#define XB_XSUB(j)  (1280 + 64 * (j))
#define XB_XGEN(j)  (2304 + 64 * (j))
#define XB_TOP      3328
#define XB_TOPGEN   3392
#define XCD_BAR_WORDS 3456
#define XB_SPIN_CAP (1u << 18)
__device__ __forceinline__ unsigned xb_ld(unsigned* p)              { return __hip_atomic_load(p, __ATOMIC_RELAXED, __HIP_MEMORY_SCOPE_AGENT); }
__device__ __forceinline__ unsigned xb_add(unsigned* p, unsigned v) { return __hip_atomic_fetch_add(p, v, __ATOMIC_RELAXED, __HIP_MEMORY_SCOPE_AGENT); }
__device__ __forceinline__ unsigned xb_xcc_id() { return (unsigned)__builtin_amdgcn_s_getreg((3 << 11) | 20) & 0xFu; }
#define XB_SPIN(cond, bar) do { unsigned _sp = 0; while (cond) { __builtin_amdgcn_s_sleep(1); \
    if ((++_sp & 255u) == 0u) { if (xb_ld(&(bar)[XB_TMO])) break; if (_sp > XB_SPIN_CAP) { atomicAdd(&(bar)[XB_TMO], 1u); break; } } } } while (0)
struct XcdBarrier { unsigned* bar; unsigned x; volatile LAS unsigned* st; };
__device__ __forceinline__ XcdBarrier xcd_barrier_post(unsigned* bar, volatile LAS unsigned* st) {
    XcdBarrier b; b.bar = bar; b.x = xb_xcc_id(); b.st = st;
    if (threadIdx.x == 0) (void)xb_add(&bar[XB_XCNT(b.x)], 1u);
    return b;
}
__device__ __forceinline__ void xcd_barrier_complete(unsigned* bar, unsigned x, unsigned& nloc, unsigned& nx) {
    const unsigned G = gridDim.x * gridDim.y * gridDim.z;
    unsigned sum, cnt, mine, sp = 0u;
    for (;;) {
        sum = 0u; cnt = 0u; mine = 0u;
#pragma unroll
        for (unsigned j = 0; j < 16; ++j) { const unsigned c = xb_ld(&bar[XB_XCNT(j)]); sum += c; cnt += (c > 0u) ? 1u : 0u; mine = (j == x) ? c : mine; }
        if (sum == G) break;
        __builtin_amdgcn_s_sleep(1);
        if ((++sp & 255u) == 0u) { if (xb_ld(&bar[XB_TMO])) break; if (sp > XB_SPIN_CAP) { atomicAdd(&bar[XB_TMO], 1u); break; } }
    }
    nloc = mine > 0u ? mine : 1u; nx = cnt > 0u ? cnt : 1u;
}
__device__ __forceinline__ void xcd_barrier(const XcdBarrier& b) {
    asm volatile("s_waitcnt vmcnt(0)" ::: "memory");
    __syncthreads();
    if (threadIdx.x == 0) {
        unsigned* bar = b.bar;
        __builtin_amdgcn_s_waitcnt(0);
        unsigned nloc = b.st[0], nx = b.st[1];
        if (nloc == 0u) { xcd_barrier_complete(bar, b.x, nloc, nx); b.st[0] = nloc; b.st[1] = nx; }
        const unsigned old = xb_add(&bar[XB_XSUB(b.x)], 1u);
        const unsigned gen = old / nloc;
        if (old + 1u == (gen + 1u) * nloc) {
            __builtin_amdgcn_fence(__ATOMIC_RELEASE, "agent");
            asm volatile("s_waitcnt vmcnt(0)" ::: "memory");
            const unsigned og = xb_add(&bar[XB_TOP], 1u);
            const unsigned tg = og / nx;
            if (og + 1u == (tg + 1u) * nx) xb_add(&bar[XB_TOPGEN], 1u);
            else XB_SPIN(xb_ld(&bar[XB_TOPGEN]) == tg, bar);
            __builtin_amdgcn_fence(__ATOMIC_ACQUIRE, "agent");
            xb_add(&bar[XB_XGEN(b.x)], 1u);
            asm volatile("s_waitcnt vmcnt(0)" ::: "memory");
        } else {
            XB_SPIN(xb_ld(&bar[XB_XGEN(b.x)]) == gen, bar);
            __builtin_amdgcn_fence(__ATOMIC_ACQUIRE, "agent");
            asm volatile("s_waitcnt vmcnt(0)" ::: "memory");
        }
    }
    __syncthreads();
}

__device__ __forceinline__ unsigned short f2bf(float f) { unsigned u = __float_as_uint(f); u += 0x7FFFu + ((u >> 16) & 1u); return (unsigned short)(u >> 16); }
__device__ __forceinline__ float bf2f(unsigned short b) { return __uint_as_float(((unsigned)b) << 16); }
__device__ __forceinline__ unsigned pk2(float lo, float hi) { unsigned r; asm("v_cvt_pk_bf16_f32 %0, %1, %2" : "=v"(r) : "v"(lo), "v"(hi)); return r; }
__device__ __forceinline__ float sigmoidf_(float x) { return 1.0f / (1.0f + expf(-x)); }
__device__ __forceinline__ float siluf_(float x) { return x / (1.0f + expf(-x)); }
__device__ __forceinline__ float wave_sum(float v) {
#pragma unroll
    for (int o = 32; o >= 1; o >>= 1) v += __shfl_xor(v, o);
    return v;
}
__device__ __forceinline__ const float* uptr(const float* p) { const unsigned long long v = (unsigned long long)p;
    const unsigned lo = __builtin_amdgcn_readfirstlane((unsigned)v), hi = __builtin_amdgcn_readfirstlane((unsigned)(v >> 32)); return (const float*)(((unsigned long long)hi << 32) | lo); }
#define PT(k) uptr(ptab[k])
__device__ __forceinline__ int step_tok(int b, int dir, int i) {
    if (i < CTXL) { const int tt = dir ? (CTXL - 1 - i) : i; return NLAT + b * CTXL + tt; }
    const int j = i - CTXL; const int tt = dir ? (SEQ - 1 - j) : j; return b * SEQ + tt;
}
__device__ __forceinline__ void unpack8(const u32x4 w, float (&f)[8]) {
    f[0] = __uint_as_float(w.x << 16); f[1] = __uint_as_float(w.x & 0xFFFF0000u); f[2] = __uint_as_float(w.y << 16); f[3] = __uint_as_float(w.y & 0xFFFF0000u);
    f[4] = __uint_as_float(w.z << 16); f[5] = __uint_as_float(w.z & 0xFFFF0000u); f[6] = __uint_as_float(w.w << 16); f[7] = __uint_as_float(w.w & 0xFFFF0000u);
}

namespace pg8 {
constexpr int BM = 256, BK = 64, HALF = 128, HTB = HALF * BK * 2, STAGE_BYTES = 8 * HTB, NXCD = 8, WGM = 8;
__host__ __device__ __forceinline__ int lds_byte(int r, int c) { const int st = (r >> 4) * 2 + (c >> 5), rr = r & 15, cc = c & 31, ob = rr * 64 + cc * 2; return st * 1024 + (ob ^ (((ob >> 9) & 1) << 5)); }
__host__ __device__ __forceinline__ void stage_rc(int b, int& R, int& C) { const int st = b / 1024, sb = b % 1024, swz = sb ^ (((sb >> 9) & 1) << 5); R = (st >> 1) * 16 + swz / 64; C = (st & 1) * 32 + (swz % 64) / 2; }
__host__ __device__ __forceinline__ int perm32(int rho) { const int n = rho >> 4, i = rho & 15; return 8 * (i >> 2) + 4 * n + (i & 3); }
struct Unit { int pm, pn, z, k; long long ao, bo; };
struct Gemm { const bf16_t* A; const bf16_t* Bt; int lda, ldb, K; };

__device__ __forceinline__ void tile_of(int wgid, int nM, int nN, int& pm, int& pn) {
    const int nwg = nM * nN; { const int q = nwg / NXCD, r = nwg % NXCD, xcd = wgid % NXCD, off = wgid / NXCD; wgid = (xcd < r ? xcd * (q + 1) : r * (q + 1) + (xcd - r) * q) + off; }
    const int nig = WGM * nN, gid = wgid / nig, fm = gid * WGM, gsz = (nM - fm) < WGM ? (nM - fm) : WGM;
    pm = fm + ((wgid % nig) % gsz); pn = (wgid % nig) / gsz;
}
struct SchedStd {
    int nM, nN, G, c, lda, ldb;
    __device__ __forceinline__ bool next(int i, Unit& u) const { const long L = (long)i * G + c; if (L >= (long)nM * nN) return false; tile_of((int)L, nM, nN, u.pm, u.pn); u.z = 0; u.k = 0;
        u.ao = (long long)u.pm * BM * lda * 2; u.bo = (long long)u.pn * BM * ldb * 2; return true; }
    __device__ __forceinline__ void a_ready(const Unit&) const {}
    __device__ __forceinline__ void done(const Unit&) const {}
};
struct SchedBranch {
    int nM, nN, G, c;
    __device__ __forceinline__ bool next(int i, Unit& u) const { const long L = (long)(i >> 2) * G + c; if (L >= (long)nM * nN) return false; tile_of((int)L, nM, nN, u.pm, u.pn); u.z = 0; u.k = i & 3;
        u.ao = ((long long)u.pm * BM * DM + u.k * BW) * 2; u.bo = ((long long)u.k * DM + u.pn * BM) * BW * 2; return true; }
    __device__ __forceinline__ void a_ready(const Unit&) const {}
    __device__ __forceinline__ void done(const Unit&) const {}
};
struct SchedTail {
    int G, c;
    __device__ __forceinline__ bool next(int i, Unit& u) const { const long T = (long)i * G + c; if (T >= 128) return false; const int t = (int)(T >> 2); u.pm = 64 + (t >> 3); u.pn = t & 7; u.z = 1; u.k = (int)(T & 3);
        u.ao = ((long long)u.pm * BM * DM + u.k * BW) * 2; u.bo = ((long long)u.k * DM + u.pn * BM) * BW * 2; return true; }
    __device__ __forceinline__ void a_ready(const Unit&) const {}
    __device__ __forceinline__ void done(const Unit&) const {}
};
struct SchedTailK {
    int G, c;
    __device__ __forceinline__ bool next(int i, Unit& u) const { const long T = (long)i * G + c; if (T >= 128) return false; const int t = (int)(T >> 2); u.pm = 64 + (t >> 3); u.pn = t & 7; u.z = 1; u.k = (int)(T & 3);
        u.ao = ((long long)u.pm * BM * DM + u.k * 512) * 2; u.bo = ((long long)u.pn * BM * DM + u.k * 512) * 2; return true; }
    __device__ __forceinline__ void a_ready(const Unit&) const {}
    __device__ __forceinline__ void done(const Unit&) const {}
};
struct SchedMoe {
    int nPm, nPn, G, c, lda, ldb, nBrows;
    __device__ __forceinline__ bool next(int i, Unit& u) const { const long L = (long)i * G + c; const int per = nPm * nPn; if (L >= (long)NEXP * per) return false; const int e = (int)(L / per), rem = (int)(L % per);
        u.z = e; u.k = 0; u.pm = rem % nPm; u.pn = rem / nPm; u.ao = ((long long)e * MOE_PAD + u.pm * BM) * lda * 2; u.bo = ((long long)e * nBrows + u.pn * BM) * ldb * 2; return true; }
    __device__ __forceinline__ void a_ready(const Unit&) const {}
    __device__ __forceinline__ void done(const Unit&) const {}
};

typedef f32x4 Acc[2][2][4][2];
template <class Epi, class Sched>
__device__ __forceinline__ void gemm_phase(LAS unsigned char* lds, const Gemm g, const Sched& S, const Epi& E) {
    int tid = threadIdx.x; asm volatile("" : "+v"(tid));
    const int wid = __builtin_amdgcn_readfirstlane(tid >> 6), lane = tid & 63, wr = wid >> 2, wc = wid & 3, fr = lane & 15, fq = lane >> 4;
    const int K = g.K, nt = K / BK;
    unsigned voffA[2], voffB[2];
#pragma unroll
    for (int i = 0; i < 2; ++i) { int R, C; stage_rc(tid * 16 + i * 8192, R, C); const int Rb = Epi::PERM ? ((R & ~31) + perm32(R & 31)) : R;
        voffA[i] = (unsigned)(R * g.lda + C) * 2u; voffB[i] = (unsigned)(Rb * g.ldb + C) * 2u; }
    const size_t kstep = (size_t)(BK * 2);
    const size_t hstepA = (size_t)HALF * g.lda * 2, hstepB = (size_t)HALF * g.ldb * 2;
    const unsigned ldsw = (unsigned)wid * 1024u;
    const int aoff = lds_byte(wr * 64 + fr, fq * 8), boff = lds_byte(wc * 32 + fr, fq * 8);
#define PG8_SA(b, h) (((b) * 2 + (h)) * HTB)
#define PG8_SB(b, h) ((4 + (b) * 2 + (h)) * HTB)
#define PG8_STAGE(bufoff, gbase, voff) do { _Pragma("unroll") for (int _i = 0; _i < 2; ++_i) \
        __builtin_amdgcn_global_load_lds((const unsigned*)((const char*)(gbase) + (voff)[_i]), (LAS unsigned*)(lds + (bufoff) + ldsw + _i * 8192), 16, 0, 0); } while (0)
#define PG8_LDA(dst, b, h) do { _Pragma("unroll") for (int m = 0; m < 4; ++m) _Pragma("unroll") for (int k = 0; k < 2; ++k) dst[m][k] = *(const LAS bf16x8*)(lds + PG8_SA(b, h) + aoff + m * 2048 + k * 1024); } while (0)
#define PG8_LDB(dst, b, h) do { _Pragma("unroll") for (int n = 0; n < 2; ++n) _Pragma("unroll") for (int k = 0; k < 2; ++k) dst[n][k] = *(const LAS bf16x8*)(lds + PG8_SB(b, h) + boff + n * 2048 + k * 1024); } while (0)
#define PG8_MMA(ai, bj, At, Bt) do { __builtin_amdgcn_s_setprio(1); _Pragma("unroll") for (int m = 0; m < 4; ++m) _Pragma("unroll") for (int n = 0; n < 2; ++n) _Pragma("unroll") for (int k = 0; k < 2; ++k) \
        acc[ai][bj][m][n] = __builtin_amdgcn_mfma_f32_16x16x32_bf16(Bt[n][k], At[m][k], acc[ai][bj][m][n], 0, 0, 0); __builtin_amdgcn_s_setprio(0); } while (0)
#define PG8_WAIT_V(n) asm volatile("s_waitcnt vmcnt(" #n ")" ::: "memory")
#define PG8_WAIT_L(n) asm volatile("s_waitcnt lgkmcnt(" #n ")" ::: "memory")
#define PG8_BAR __builtin_amdgcn_s_barrier()
#define PG8_SCHED __builtin_amdgcn_sched_barrier(0)
    Unit cur, nxt; int ui = 0;
    if (!S.next(0, cur)) return;
    Acc acc;
#pragma unroll
    for (int a = 0; a < 2; ++a)
#pragma unroll
        for (int b = 0; b < 2; ++b)
#pragma unroll
            for (int m = 0; m < 4; ++m)
#pragma unroll
                for (int n = 0; n < 2; ++n) acc[a][b][m][n] = (f32x4){0.f, 0.f, 0.f, 0.f};
    bf16x8 At[4][2], B0[2][2], B1[2][2];
    const char* cA = (const char*)g.A + cur.ao; const char* cB = (const char*)g.Bt + cur.bo;
    S.a_ready(cur);
    PG8_STAGE(PG8_SB(0, 0), cB, voffB); PG8_STAGE(PG8_SA(0, 0), cA, voffA); PG8_STAGE(PG8_SB(0, 1), cB + hstepB, voffB); PG8_STAGE(PG8_SA(0, 1), cA + hstepA, voffA);
    if (wr == 1) PG8_BAR;
    PG8_WAIT_V(4); PG8_BAR;
    PG8_STAGE(PG8_SB(1, 0), cB + kstep, voffB); PG8_STAGE(PG8_SA(1, 0), cA + kstep, voffA); PG8_STAGE(PG8_SB(1, 1), cB + hstepB + kstep, voffB);
    PG8_WAIT_V(6); PG8_BAR;
    for (;;) {
        const bool has_next = S.next(ui + 1, nxt);
        const char* nA = has_next ? (const char*)g.A + nxt.ao : cA; const char* nB = has_next ? (const char*)g.Bt + nxt.bo : cB;
        for (int t = 0; t < nt; t += 2) {
            const bool last = (t == nt - 2);
            const char* a1 = cA + (size_t)(t + 1) * kstep;
            const char* a2 = last ? nA : cA + (size_t)(t + 2) * kstep; const char* b2 = last ? nB : cB + (size_t)(t + 2) * kstep;
            const char* a3 = a2 + kstep; const char* b3 = b2 + kstep;
            if (last && has_next) S.a_ready(nxt);
            PG8_LDB(B0, 0, 0); PG8_SCHED; PG8_LDA(At, 0, 0); PG8_STAGE(PG8_SA(1, 1), a1 + hstepA, voffA);
            PG8_WAIT_L(8); PG8_BAR; PG8_WAIT_L(0); PG8_MMA(0, 0, At, B0); PG8_BAR; PG8_SCHED;
            PG8_LDB(B1, 0, 1); PG8_STAGE(PG8_SB(0, 0), b2, voffB);
            PG8_BAR; PG8_WAIT_L(0); PG8_MMA(0, 1, At, B1); PG8_BAR;
            PG8_LDA(At, 0, 1); PG8_STAGE(PG8_SA(0, 0), a2, voffA);
            PG8_BAR; PG8_WAIT_L(0); PG8_MMA(1, 0, At, B0); PG8_BAR; PG8_SCHED;
            PG8_STAGE(PG8_SB(0, 1), b2 + hstepB, voffB);
            PG8_WAIT_V(6); PG8_BAR; PG8_MMA(1, 1, At, B1); PG8_BAR;
            PG8_LDB(B0, 1, 0); PG8_SCHED; PG8_LDA(At, 1, 0); PG8_STAGE(PG8_SA(0, 1), a2 + hstepA, voffA);
            PG8_WAIT_L(8); PG8_BAR; PG8_WAIT_L(0); PG8_MMA(0, 0, At, B0); PG8_BAR; PG8_SCHED;
            PG8_LDB(B1, 1, 1); PG8_STAGE(PG8_SB(1, 0), b3, voffB);
            PG8_BAR; PG8_WAIT_L(0); PG8_MMA(0, 1, At, B1); PG8_BAR;
            PG8_LDA(At, 1, 1); PG8_STAGE(PG8_SA(1, 0), a3, voffA);
            PG8_BAR; PG8_WAIT_L(0); PG8_MMA(1, 0, At, B0); PG8_BAR; PG8_SCHED;
            PG8_STAGE(PG8_SB(1, 1), b3 + hstepB, voffB);
            PG8_WAIT_V(6); PG8_BAR; PG8_MMA(1, 1, At, B1); PG8_BAR;
        }
        const bool keep = E(acc, cur, wr, wc, fr, fq); S.done(cur);
        if (!has_next) break;
        if (!keep) {
#pragma unroll
        for (int a = 0; a < 2; ++a)
#pragma unroll
            for (int b = 0; b < 2; ++b)
#pragma unroll
                for (int m = 0; m < 4; ++m)
#pragma unroll
                    for (int n = 0; n < 2; ++n) acc[a][b][m][n] = (f32x4){0.f, 0.f, 0.f, 0.f};
        }
        cur = nxt; cA = nA; cB = nB; ++ui;
    }
    PG8_WAIT_V(0);
    if (wr == 0) PG8_BAR;
    PG8_BAR;
#undef PG8_SA
#undef PG8_SB
#undef PG8_STAGE
#undef PG8_LDA
#undef PG8_LDB
#undef PG8_MMA
#undef PG8_WAIT_V
#undef PG8_WAIT_L
#undef PG8_BAR
#undef PG8_SCHED
}

struct EpiBf16Store {
    static constexpr bool PERM = true;
    bf16_t* O; int ldc;
    __device__ __forceinline__ bool operator()(Acc& acc, const Unit& u, int wr, int wc, int fr, int fq) const {
        const int row0 = u.pm * BM + wr * 64 + fr, col0 = u.pn * BM + wc * 32 + 8 * fq;
#pragma unroll
        for (int ai = 0; ai < 2; ++ai)
#pragma unroll
            for (int m = 0; m < 4; ++m) { bf16_t* rowp = O + (size_t)(row0 + ai * HALF + m * 16) * ldc + col0;
#pragma unroll
                for (int bj = 0; bj < 2; ++bj) { const f32x4 v0 = acc[ai][bj][m][0], v1 = acc[ai][bj][m][1];
                    u32x4 w; w.x = pk2(v0[0], v0[1]); w.y = pk2(v0[2], v0[3]); w.z = pk2(v1[0], v1[1]); w.w = pk2(v1[2], v1[3]);
                    *(u32x4*)(rowp + bj * HALF) = w; } }
        return false;
    }
};
struct EpiWin {
    static constexpr bool PERM = true;
    bf16_t* O; int ldc;
    __device__ __forceinline__ bool operator()(Acc& acc, const Unit& u, int wr, int wc, int fr, int fq) const {
        const int row0 = u.pm * BM + wr * 64 + fr;
        if (u.pn < 23) { const int col0 = u.pn * BM + wc * 32 + 8 * fq;
#pragma unroll
            for (int ai = 0; ai < 2; ++ai)
#pragma unroll
                for (int m = 0; m < 4; ++m)
#pragma unroll
                    for (int bj = 0; bj < 2; ++bj) { const f32x4 v0 = acc[ai][bj][m][0], v1 = acc[ai][bj][m][1];
                        u32x4 w; w.x = pk2(v0[0], v0[1]); w.y = pk2(v0[2], v0[3]); w.z = pk2(v1[0], v1[1]); w.w = pk2(v1[2], v1[3]);
                        *(u32x4*)(O + (size_t)(row0 + ai * HALF + m * 16) * ldc + col0 + bj * HALF) = w; }
        } else { const int colb = GATE2 + 64 * (u.pn - 23) + 16 * wc + 4 * fq;
#pragma unroll
            for (int ai = 0; ai < 2; ++ai)
#pragma unroll
                for (int m = 0; m < 4; ++m) { f32x4 sg[4];
#pragma unroll
                    for (int bj = 0; bj < 2; ++bj)
#pragma unroll
                        for (int n = 0; n < 2; ++n) { const f32x4 v = acc[ai][bj][m][n];
#pragma unroll
                            for (int j = 0; j < 4; ++j) sg[2 * bj + n][j] = __builtin_amdgcn_rcpf(1.0f + __expf(-v[j])); }
                    bf16_t* op = O + (size_t)(row0 + ai * HALF + m * 16) * ldc + colb;
#pragma unroll
                    for (int k = 0; k < 4; ++k) { f32x4 r = sg[k];
                        if (k < 3) {
#pragma unroll
                            for (int j = 0; j < 4; ++j) r[j] *= __builtin_amdgcn_rcpf(sg[k + 1][j]); }
                        u32x2 w; w.x = pk2(r[0], r[1]); w.y = pk2(r[2], r[3]); *(u32x2*)(op + k * DM) = w; } }
        }
        return false;
    }
};
struct EpiNone { static constexpr bool PERM = true;
    __device__ __forceinline__ bool operator()(Acc& acc, const Unit&, int, int, int, int) const {
#pragma unroll
        for (int a = 0; a < 2; ++a)
#pragma unroll
            for (int b = 0; b < 2; ++b)
#pragma unroll
                for (int m = 0; m < 4; ++m)
#pragma unroll
                    for (int n = 0; n < 2; ++n) asm volatile("" :: "v"(acc[a][b][m][n]));
        return false; } };
struct EpiGlu {
    static constexpr bool PERM = true;
    const bf16_t* GG; const float* bias; bf16_t* Y4;
    __device__ __forceinline__ bool operator()(Acc& acc, const Unit& u, int wr, int wc, int fr, int fq) const {
        const int row0 = u.pm * BM + wr * 64 + fr, col0 = u.pn * BM + wc * 32 + 8 * fq;
#pragma unroll
        for (int bj = 0; bj < 2; ++bj) { const int col = col0 + bj * HALF; const f32x4 b0 = *(const f32x4*)(bias + col), b1 = *(const f32x4*)(bias + col + 4);
            u32x4 gq[2][4];
#pragma unroll
            for (int ai = 0; ai < 2; ++ai)
#pragma unroll
                for (int m = 0; m < 4; ++m) gq[ai][m] = *(const u32x4*)(GG + (size_t)(row0 + ai * HALF + m * 16) * BW + col);
#pragma unroll
            for (int ai = 0; ai < 2; ++ai)
#pragma unroll
                for (int m = 0; m < 4; ++m) { const size_t row = (size_t)(row0 + ai * HALF + m * 16);
                    float gg[8]; unpack8(gq[ai][m], gg);
                    const f32x4 v0 = acc[ai][bj][m][0] + b0, v1 = acc[ai][bj][m][1] + b1;
                    u32x4 w; w.x = pk2(gg[0] * sigmoidf_(v0[0]), gg[1] * sigmoidf_(v0[1])); w.y = pk2(gg[2] * sigmoidf_(v0[2]), gg[3] * sigmoidf_(v0[3]));
                    w.z = pk2(gg[4] * sigmoidf_(v1[0]), gg[5] * sigmoidf_(v1[1])); w.w = pk2(gg[6] * sigmoidf_(v1[2]), gg[7] * sigmoidf_(v1[3]));
                    *(u32x4*)(Y4 + row * DM + 1024 + col) = w; } }
        return false;
    }
};
struct EpiBranch {
    static constexpr bool PERM = true;
    const bf16_t* P; bf16_t* ACCb;
    __device__ __forceinline__ bool operator()(Acc& acc, const Unit& u, int wr, int wc, int fr, int fq) const {
        const int row0 = u.pm * BM + wr * 64 + fr, col0 = u.pn * BM + wc * 32 + 8 * fq; const int k = u.k;
        const bf16_t* gbase = P + (size_t)row0 * LDP + GATE2 + k * DM + col0;
#pragma unroll
        for (int ai = 0; ai < 2; ++ai) {
            u32x4 ga[8];
#pragma unroll
            for (int m = 0; m < 4; ++m)
#pragma unroll
                for (int bj = 0; bj < 2; ++bj) ga[m * 2 + bj] = *(const u32x4*)(gbase + (size_t)(ai * HALF + m * 16) * LDP + bj * HALF);
#pragma unroll
            for (int m = 0; m < 4; ++m)
#pragma unroll
                for (int bj = 0; bj < 2; ++bj) { float sr[8]; unpack8(ga[m * 2 + bj], sr);
                    f32x4 v0 = acc[ai][bj][m][0], v1 = acc[ai][bj][m][1];
                    v0[0] *= sr[0]; v0[1] *= sr[1]; v0[2] *= sr[2]; v0[3] *= sr[3]; v1[0] *= sr[4]; v1[1] *= sr[5]; v1[2] *= sr[6]; v1[3] *= sr[7];
                    if (k < 3) { acc[ai][bj][m][0] = v0; acc[ai][bj][m][1] = v1; }
                    else { u32x4 w; w.x = pk2(v0[0], v0[1]); w.y = pk2(v0[2], v0[3]); w.z = pk2(v1[0], v1[1]); w.w = pk2(v1[2], v1[3]); *(u32x4*)(ACCb + (size_t)(row0 + ai * HALF + m * 16) * DM + col0 + bj * HALF) = w; } } }
        return k < 3;
    }
};
struct EpiPartK {
    static constexpr bool PERM = true;
    float* PART;
    __device__ __forceinline__ bool operator()(Acc& acc, const Unit& u, int wr, int wc, int fr, int fq) const {
        const int row0 = u.pm * BM + wr * 64 + fr, col0 = u.pn * BM + wc * 32 + 8 * fq;
        float* pbase = PART + ((size_t)u.k * (NTOK - NLAT) + (size_t)(row0 - NLAT)) * DM + col0;
#pragma unroll
        for (int ai = 0; ai < 2; ++ai)
#pragma unroll
            for (int m = 0; m < 4; ++m)
#pragma unroll
                for (int bj = 0; bj < 2; ++bj) { float* pp = pbase + (size_t)(ai * HALF + m * 16) * DM + bj * HALF; *(f32x4*)pp = acc[ai][bj][m][0]; *(f32x4*)(pp + 4) = acc[ai][bj][m][1]; }
        return false;
    }
};
struct EpiResid {
    static constexpr bool PERM = false;
    float* XS; const float* srcLat; const float* srcCtx; const float* MODl; int gidx;
    __device__ __forceinline__ bool operator()(Acc& acc, const Unit& u, int wr, int wc, int fr, int fq) const {
        const int row0 = u.pm * BM + wr * 64 + fr, col0 = u.pn * BM + wc * 32 + 4 * fq;
        const int r = (u.pm * BM) < NLAT ? (u.pm * BM) / SEQ : 4;
        const float* src = (u.pm * BM) < NLAT ? srcLat : srcCtx;
        const float* mg = MODl + (size_t)(r * 6 + gidx) * DM;
#pragma unroll
        for (int bj = 0; bj < 2; ++bj) {
            f32x4 gm[2], xs[2][2][4];
#pragma unroll
            for (int n = 0; n < 2; ++n) { const int col = col0 + bj * HALF + n * 16; gm[n] = *(const f32x4*)(mg + col);
#pragma unroll
                for (int ai = 0; ai < 2; ++ai)
#pragma unroll
                    for (int m = 0; m < 4; ++m) xs[n][ai][m] = *(const f32x4*)(src + (size_t)(row0 + ai * HALF + m * 16) * DM + col); }
#pragma unroll
            for (int n = 0; n < 2; ++n) { const int col = col0 + bj * HALF + n * 16;
#pragma unroll
                for (int ai = 0; ai < 2; ++ai)
#pragma unroll
                    for (int m = 0; m < 4; ++m) *(f32x4*)(XS + (size_t)(row0 + ai * HALF + m * 16) * DM + col) = xs[n][ai][m] + gm[n] * acc[ai][bj][m][n]; } }
        return false;
    }
};
struct EpiMoe1 {
    static constexpr bool PERM = true;
    bf16_t* HID;
    __device__ __forceinline__ bool operator()(Acc& acc, const Unit& u, int wr, int wc, int fr, int fq) const {
        const size_t row0 = (size_t)u.z * MOE_PAD + u.pm * BM + wr * 64 + fr; const int col0 = u.pn * HALF + wc * 32 + 8 * fq;
#pragma unroll
        for (int ai = 0; ai < 2; ++ai)
#pragma unroll
            for (int m = 0; m < 4; ++m) { const f32x4 g0 = acc[ai][0][m][0], g1 = acc[ai][0][m][1], u0 = acc[ai][1][m][0], u1 = acc[ai][1][m][1];
                float h[8];
#pragma unroll
                for (int j = 0; j < 4; ++j) { h[j] = g0[j] * __builtin_amdgcn_rcpf(1.0f + __expf(-g0[j])) * u0[j]; h[4 + j] = g1[j] * __builtin_amdgcn_rcpf(1.0f + __expf(-g1[j])) * u1[j]; }
                u32x4 w; w.x = pk2(h[0], h[1]); w.y = pk2(h[2], h[3]); w.z = pk2(h[4], h[5]); w.w = pk2(h[6], h[7]);
                *(u32x4*)(HID + (row0 + ai * HALF + m * 16) * DEXP + col0) = w; }
        return false;
    }
};
struct EpiMoeY {
    static constexpr bool PERM = true;
    bf16_t* O;
    __device__ __forceinline__ bool operator()(Acc& acc, const Unit& u, int wr, int wc, int fr, int fq) const {
        const size_t row0 = (size_t)u.z * MOE_PAD + u.pm * BM + wr * 64 + fr; const int col0 = u.pn * BM + wc * 32 + 8 * fq;
#pragma unroll
        for (int ai = 0; ai < 2; ++ai)
#pragma unroll
            for (int m = 0; m < 4; ++m) { bf16_t* rowp = O + (row0 + ai * HALF + m * 16) * DM + col0;
#pragma unroll
                for (int bj = 0; bj < 2; ++bj) { const f32x4 v0 = acc[ai][bj][m][0], v1 = acc[ai][bj][m][1];
                    u32x4 w; w.x = pk2(v0[0], v0[1]); w.y = pk2(v0[2], v0[3]); w.z = pk2(v1[0], v1[1]); w.w = pk2(v1[2], v1[3]);
                    *(u32x4*)(rowp + bj * HALF) = w; } }
        return false;
    }
};

struct SchedS5a {
    int c;
    __device__ __forceinline__ bool next(int i, Unit& u) const { if (i > 0 || c >= 64) return false; u.z = c >> 1; u.pm = c & 1; u.pn = 0; u.k = 0;
        u.ao = ((long long)u.z * 512 + u.pm * BM) * 768 * 2; u.bo = (long long)u.z * 256 * 512 * 2; return true; }
    __device__ __forceinline__ void a_ready(const Unit&) const {}
    __device__ __forceinline__ void done(const Unit&) const {}
};
struct SchedS5b {
    int c;
    __device__ __forceinline__ bool next(int i, Unit& u) const { if (i > 0 || c >= 128) return false; u.z = c >> 2; u.pm = (c >> 1) & 1; u.pn = c & 1; u.k = 0;
        u.ao = ((long long)u.z * 512 + u.pm * BM) * 768 * 2; u.bo = ((long long)u.z * 512 + u.pn * BM) * 768 * 2; return true; }
    __device__ __forceinline__ void a_ready(const Unit&) const {}
    __device__ __forceinline__ void done(const Unit&) const {}
};
struct EpiXloc {
    static constexpr bool PERM = false;
    float* XL;
    __device__ __forceinline__ bool operator()(Acc& acc, const Unit& u, int wr, int wc, int fr, int fq) const {
        const int row0 = u.pm * BM + wr * 64 + fr, col0 = wc * 32 + 4 * fq; float* base = XL + (size_t)u.z * 512 * 256;
#pragma unroll
        for (int ai = 0; ai < 2; ++ai)
#pragma unroll
            for (int m = 0; m < 4; ++m) { float* rowp = base + (size_t)(row0 + ai * HALF + m * 16) * 256 + col0;
#pragma unroll
                for (int bj = 0; bj < 2; ++bj)
#pragma unroll
                    for (int n = 0; n < 2; ++n) *(f32x4*)(rowp + bj * HALF + n * 16) = acc[ai][bj][m][n]; }
        return false;
    }
};
struct EpiS5Out {
    static constexpr bool PERM = true;
    const bf16_t* P; const float* dskip; bf16_t* GG;
    __device__ __forceinline__ bool operator()(Acc& acc, const Unit& u, int wr, int wc, int fr, int fq) const {
        const int row0 = u.pm * BM + wr * 64 + fr, col0 = u.pn * BM + wc * 32 + 8 * fq; const int g = u.z;
#pragma unroll
        for (int bj = 0; bj < 2; ++bj) { const int col = col0 + bj * HALF; const int t = col >> 4, c0 = col & 15;
            const f32x4 d0 = *(const f32x4*)(dskip + g * 16 + c0), d1 = *(const f32x4*)(dskip + g * 16 + c0 + 4);
            u32x4 uq[2][4];
#pragma unroll
            for (int ai = 0; ai < 2; ++ai)
#pragma unroll
                for (int m = 0; m < 4; ++m) uq[ai][m] = *(const u32x4*)(P + ((size_t)(row0 + ai * HALF + m * 16) * 32 + t) * LDP + S5_OFF + g * 16 + c0);
#pragma unroll
            for (int ai = 0; ai < 2; ++ai)
#pragma unroll
                for (int m = 0; m < 4; ++m) { const size_t tok = (size_t)(row0 + ai * HALF + m * 16) * 32 + t;
                    float uu[8]; unpack8(uq[ai][m], uu);
                    const f32x4 v0 = acc[ai][bj][m][0], v1 = acc[ai][bj][m][1];
                    float y[8] = {v0[0] + d0[0] * uu[0], v0[1] + d0[1] * uu[1], v0[2] + d0[2] * uu[2], v0[3] + d0[3] * uu[3], v1[0] + d1[0] * uu[4], v1[1] + d1[1] * uu[5], v1[2] + d1[2] * uu[6], v1[3] + d1[3] * uu[7]};
#pragma unroll
                    for (int j = 0; j < 8; ++j) y[j] = 0.5f * y[j] * (1.0f + tanhf(0.7978845608028654f * (y[j] + 0.044715f * y[j] * y[j] * y[j])));
                    u32x4 w; w.x = pk2(y[0], y[1]); w.y = pk2(y[2], y[3]); w.z = pk2(y[4], y[5]); w.w = pk2(y[6], y[7]);
                    *(u32x4*)(GG + tok * BW + g * 16 + c0) = w; } }
        return false;
    }
};
}


__device__ __forceinline__ float wave_scan_incl(float v, int lane) {
#pragma unroll
    for (int o = 1; o < 64; o <<= 1) { const float t = __shfl_up(v, o); if (lane >= o) v += t; }
    return v;
}
__device__ __forceinline__ float wave_scanmax_incl(float v, int lane) {
#pragma unroll
    for (int o = 1; o < 64; o <<= 1) { const float t = __shfl_up(v, o); if (lane >= o) v = fmaxf(v, t); }
    return v;
}
__device__ __forceinline__ float wave_max(float v) {
#pragma unroll
    for (int o = 32; o >= 1; o >>= 1) v = fmaxf(v, __shfl_xor(v, o));
    return v;
}
__device__ __forceinline__ void unpack8h(const u32x4 w, bf16_t (&h)[8]) {
    h[0] = (bf16_t)(w.x & 0xFFFFu); h[1] = (bf16_t)(w.x >> 16); h[2] = (bf16_t)(w.y & 0xFFFFu); h[3] = (bf16_t)(w.y >> 16);
    h[4] = (bf16_t)(w.z & 0xFFFFu); h[5] = (bf16_t)(w.z >> 16); h[6] = (bf16_t)(w.w & 0xFFFFu); h[7] = (bf16_t)(w.w >> 16);
}

__device__ __forceinline__ int tokblock_of(int b, int dir, int c) { if (c < 4) return 256 + b * 4 + (dir ? 3 - c : c); const int j = c - 4; return b * 64 + (dir ? 63 - j : j); }
__device__ __forceinline__ u32x4 rev8h(const u32x4 v) { u32x4 r; r.x = (v.w >> 16) | (v.w << 16); r.y = (v.z >> 16) | (v.z << 16); r.z = (v.y >> 16) | (v.y << 16); r.w = (v.x >> 16) | (v.x << 16); return r; }
__device__ __forceinline__ u32x4 scale8h(const u32x4 v, const float4 a, const float4 b) { float f[8]; unpack8(v, f); u32x4 r; r.x = pk2(f[0] * a.x, f[1] * a.y); r.y = pk2(f[2] * a.z, f[3] * a.w); r.z = pk2(f[4] * b.x, f[5] * b.y); r.w = pk2(f[6] * b.z, f[7] * b.w); return r; }
__device__ __forceinline__ float dot8h(const u32x4 v, const float4 a, const float4 b) { float f[8]; unpack8(v, f); return (f[0] * a.x + f[1] * a.y) + (f[2] * a.z + f[3] * a.w) + (f[4] * b.x + f[5] * b.y) + (f[6] * b.z + f[7] * b.w); }
#define ML_FRAG_LOAD(KF, VF, cc_) do { const int tb_ = tokblock_of(b, dir, (cc_)); const bf16_t* kb_ = KTg + ((size_t)tb_ * 512 + h * 128 + 32 * wd + r16) * 64 + q4 * 8; const bf16_t* vb_ = VTg + ((size_t)tb_ * 512 + h * 128 + 64 * half + 32 * we + r16) * 64 + q4 * 8; \
        _Pragma("unroll") for (int ks_ = 0; ks_ < 2; ++ks_) _Pragma("unroll") for (int j_ = 0; j_ < 2; ++j_) { VF[j_][ks_] = *(const u32x4*)(vb_ + (size_t)j_ * 16 * 64 + ks_ * 32); KF[j_][ks_] = *(const u32x4*)(kb_ + (size_t)j_ * 16 * 64 + ks_ * 32); } } while (0)
#define ML_CHUNK(c_, KF, VF, KFN, VFN) do { const int c = (c_); \
        if (c + 1 < 68) ML_FRAG_LOAD(KFN, VFN, c + 1);                        \
        const float dec = sDEC[c]; \
        {   bf16_t* cs = CST + (size_t)(chain * 68 + c) * 128 * 128; \
            _Pragma("unroll") for (int je = 0; je < 2; ++je) _Pragma("unroll") for (int jd = 0; jd < 2; ++jd) { const int e = 64 * half + 32 * we + 16 * je + r16, d0 = 32 * wd + 16 * jd + q4 * 4; \
                u32x2 pk; pk.x = pk2(acc[je][jd][0], acc[je][jd][1]); pk.y = pk2(acc[je][jd][2], acc[je][jd][3]); *(u32x2*)(cs + (size_t)e * 128 + d0) = pk; } \
            if (nown) { _Pragma("unroll") for (int jd = 0; jd < 2; ++jd) { float nv = npart[jd]; nv += __shfl_xor(nv, 16); nv += __shfl_xor(nv, 32); if (q4 == 0) NST[(size_t)(chain * 68 + c) * 128 + 32 * wd + 16 * jd + r16] = nv; } } } \
        bf16x8 vfr[2][2]; \
        _Pragma("unroll") for (int ks = 0; ks < 2; ++ks) { const float4 wa = *(const float4*)(sWS + c * 64 + ks * 32 + q4 * 8), wb = *(const float4*)(sWS + c * 64 + ks * 32 + q4 * 8 + 4); \
            _Pragma("unroll") for (int je = 0; je < 2; ++je) { const u32x4 sv = scale8h(VF[je][ks], wa, wb); vfr[je][ks] = *(const bf16x8*)&sv; } \
            if (nown) { _Pragma("unroll") for (int jd = 0; jd < 2; ++jd) npart[jd] = (ks == 0 ? dec * npart[jd] : npart[jd]) + dot8h(KF[jd][ks], wa, wb); } } \
        _Pragma("unroll") for (int je = 0; je < 2; ++je) _Pragma("unroll") for (int jd = 0; jd < 2; ++jd) acc[je][jd] = acc[je][jd] * dec; \
        _Pragma("unroll") for (int ks = 0; ks < 2; ++ks) _Pragma("unroll") for (int je = 0; je < 2; ++je) _Pragma("unroll") for (int jd = 0; jd < 2; ++jd) \
            acc[je][jd] = __builtin_amdgcn_mfma_f32_16x16x32_bf16(*(const bf16x8*)&KF[jd][ks], vfr[je][ks], acc[je][jd], 0, 0, 0); } while (0)
__device__ __forceinline__ void mlstm_state_pass(const int chain, const int half, const bf16_t* __restrict__ Pm, const bf16_t* __restrict__ KTg, const bf16_t* __restrict__ VTg, const float* __restrict__ gate_b,
                                                 bf16_t* __restrict__ CST, float* __restrict__ NST, float* __restrict__ MST, unsigned char* shm, const int tid) {
    const int dir = chain & 1, h = (chain >> 1) & 3, b = chain >> 3, lane = tid & 63, w = tid >> 6, we = w >> 2, wd = w & 3, q4 = lane >> 4, r16 = lane & 15;
    const bool nown = (half == 0) && (we == 0);
    float* sE = (float*)shm; float* sWS = sE + 68 * 64; float* sAL = sWS + 68 * 64; float* sBE = sAL + 68; float* sMO = sBE + 68; float* sDEC = sMO + 68; float* sMB = sDEC + 68;
    const float gbi = gate_b[(dir * 2 + 0) * 4 + h], gbf = gate_b[(dir * 2 + 1) * 4 + h];
    const int gcol_i = ML_OFF + 2048 + (dir * 2 + 0) * 4 + h, gcol_f = ML_OFF + 2048 + (dir * 2 + 1) * 4 + h;
    u32x4 kfA[2][2], vfA[2][2], kfB[2][2], vfB[2][2];
    ML_FRAG_LOAD(kfA, vfA, 0);
    __syncthreads();
    unsigned gi_[9], gf_[9];
#pragma unroll
    for (int q = 0; q < 9; ++q) { const int c = min(w + 8 * q, 67); const size_t tokl = (size_t)step_tok(b, dir, c * 64 + lane); gi_[q] = Pm[tokl * LDP + gcol_i]; gf_[q] = Pm[tokl * LDP + gcol_f]; }
#pragma unroll
    for (int q = 0; q < 9; ++q) { const int c = w + 8 * q; if (c >= 68) break;
        const float ig = __uint_as_float(gi_[q] << 16) + gbi, fg = __uint_as_float(gf_[q] << 16) + gbf;
        const float lf = fminf(fg, 0.f) - log1pf(expf(-fabsf(fg)));
        const float bcs = wave_scan_incl(lf, lane); const float blast = __shfl(bcs, 63); const float ei = blast - bcs + ig; const float beta = wave_max(ei);
        sE[c * 64 + lane] = ei; if (lane == 0) { sAL[c] = blast; sBE[c] = beta; } }
    __syncthreads();
    if (tid == 0) { float m = 0.f; for (int c = 0; c < 68; ++c) { sMB[c] = m; const float mo = fmaxf(m + sAL[c], sBE[c]); sDEC[c] = expf(sAL[c] + m - mo); sMO[c] = mo; m = mo; } }
    __syncthreads();
    for (int idx = tid; idx < 68 * 64; idx += NTHR) { const int c = idx >> 6, i = idx & 63; sWS[c * 64 + (dir ? 63 - i : i)] = expf(sE[idx] - sMO[c]); }
    if (half == 0 && tid < 68) MST[chain * 68 + tid] = sMB[tid];
    __syncthreads();
    f32x4 acc[2][2];
#pragma unroll
    for (int je = 0; je < 2; ++je)
#pragma unroll
        for (int jd = 0; jd < 2; ++jd) acc[je][jd] = (f32x4){0.f, 0.f, 0.f, 0.f};
    float npart[2] = {0.f, 0.f};
    for (int c2 = 0; c2 < 68; c2 += 2) { ML_CHUNK(c2, kfA, vfA, kfB, vfB); ML_CHUNK(c2 + 1, kfB, vfB, kfA, vfA); }
    __syncthreads();
}
#undef ML_CHUNK
#undef ML_FRAG_LOAD
__device__ __forceinline__ void mlstm_out_item(const int chain, const int c, const bf16_t* __restrict__ Pm, const bf16_t* __restrict__ QKb, const bf16_t* __restrict__ VTg, const float* __restrict__ gate_b,
                                               const bf16_t* __restrict__ CST, const float* __restrict__ NST, const float* __restrict__ MST, bf16_t* __restrict__ Hout, unsigned char* shm, const int tid) {
    const int dir = chain & 1, h = (chain >> 1) & 3, b = chain >> 3, lane = tid & 63, w = tid >> 6;
    bf16_t* Qs = (bf16_t*)shm; bf16_t* Ks = (bf16_t*)(shm + 17408); bf16_t* VT = (bf16_t*)(shm + 34816); bf16_t* Cs = (bf16_t*)(shm + 53248); bf16_t* Ss = (bf16_t*)(shm + 88064);
    float* sc = (float*)(shm + 97280);
    __syncthreads();
    u32x4 gq[2], gk[2], gv[2], gc[4]; float gn = 0.f;
#pragma unroll
    for (int i = 0; i < 2; ++i) { const int pid = tid + i * 512; const int s = pid >> 4, x0 = (pid & 15) * 8; const size_t toks = (size_t)step_tok(b, dir, c * 64 + s);
        gq[i] = *(const u32x4*)(QKb + toks * 1024 + h * 128 + x0);
        gk[i] = *(const u32x4*)(QKb + toks * 1024 + 512 + h * 128 + x0);
        { const int e = pid >> 3, o = pid & 7;
          gv[i] = *(const u32x4*)(VTg + ((size_t)tokblock_of(b, dir, c) * 512 + h * 128 + e) * 64 + (dir ? 7 - o : o) * 8); } }
#pragma unroll
    for (int i = 0; i < 4; ++i) { const int pid = tid + i * 512; const int e = pid >> 4, x0 = (pid & 15) * 8;
        gc[i] = *(const u32x4*)(CST + ((size_t)(chain * 68 + c) * 128 + e) * 128 + x0); }
    if (tid < 128) gn = NST[(size_t)(chain * 68 + c) * 128 + tid];
    unsigned gi_ = 0u, gf_ = 0u; float gbi = 0.f, gbf = 0.f, m_in = 0.f;
    if (w == 0) { const size_t tokl = (size_t)step_tok(b, dir, c * 64 + lane);
        gi_ = Pm[tokl * LDP + ML_OFF + 2048 + (dir * 2 + 0) * 4 + h]; gf_ = Pm[tokl * LDP + ML_OFF + 2048 + (dir * 2 + 1) * 4 + h];
        gbi = gate_b[(dir * 2 + 0) * 4 + h]; gbf = gate_b[(dir * 2 + 1) * 4 + h]; m_in = MST[chain * 68 + c]; }
#pragma unroll
    for (int i = 0; i < 2; ++i) { const int pid = tid + i * 512; const int s = pid >> 4, x0 = (pid & 15) * 8;
        *(u32x4*)(Qs + s * 136 + x0) = gq[i]; *(u32x4*)(Ks + s * 136 + x0) = gk[i];
        { const int e = pid >> 3, o = pid & 7; *(u32x4*)(VT + e * 72 + o * 8) = dir ? rev8h(gv[i]) : gv[i]; } }
#pragma unroll
    for (int i = 0; i < 4; ++i) { const int pid = tid + i * 512; const int e = pid >> 4, x0 = (pid & 15) * 8; *(u32x4*)(Cs + e * 136 + x0) = gc[i]; }
    if (tid < 128) sc[384 + tid] = gn;
    if (w == 0) {
        const float ig = __uint_as_float(gi_ << 16) + gbi;
        const float fg = __uint_as_float(gf_ << 16) + gbf;
        const float lf = fminf(fg, 0.f) - log1pf(expf(-fabsf(fg)));
        const float bcs = wave_scan_incl(lf, lane); const float gsv = ig - bcs; const float pm = wave_scanmax_incl(gsv, lane);
        const float mt = bcs + fmaxf(m_in, pm);
        sc[lane] = bcs; sc[64 + lane] = gsv; sc[128 + lane] = mt; sc[192 + lane] = expf(bcs + m_in - mt); sc[256 + lane] = expf(-mt);
    }
    __syncthreads();
    const int tt = w >> 1;
    {   f32x4 aS[2] = {(f32x4){0.f, 0.f, 0.f, 0.f}, (f32x4){0.f, 0.f, 0.f, 0.f}};
#pragma unroll
        for (int ks = 0; ks < 4; ++ks) { const bf16x8 af = *(const bf16x8*)(Qs + (16 * tt + (lane & 15)) * 136 + ks * 32 + (lane >> 4) * 8);
#pragma unroll
            for (int i = 0; i < 2; ++i) { const int st = (w & 1) * 2 + i; const bf16x8 bfr = *(const bf16x8*)(Ks + (16 * st + (lane & 15)) * 136 + ks * 32 + (lane >> 4) * 8);
                aS[i] = __builtin_amdgcn_mfma_f32_16x16x32_bf16(af, bfr, aS[i], 0, 0, 0); } }
        float rs[4] = {0.f, 0.f, 0.f, 0.f};
#pragma unroll
        for (int i = 0; i < 2; ++i) { const int s = 16 * ((w & 1) * 2 + i) + (lane & 15); const float gsv = sc[64 + s];
#pragma unroll
            for (int q = 0; q < 4; ++q) { const int t = 16 * tt + (lane >> 4) * 4 + q; const float val = (s <= t) ? aS[i][q] * expf(sc[t] + gsv - sc[128 + t]) : 0.f; Ss[t * 72 + s] = f2bf(val); rs[q] += val; } }
#pragma unroll
        for (int q = 0; q < 4; ++q) { float r = rs[q]; r += __shfl_xor(r, 1); r += __shfl_xor(r, 2); r += __shfl_xor(r, 4); r += __shfl_xor(r, 8);
            if ((lane & 15) == 0) sc[512 + (w & 1) * 64 + 16 * tt + (lane >> 4) * 4 + q] = r; }
        {   const int t = tid >> 3, part = tid & 7; float dot = 0.f;
#pragma unroll
            for (int j = 0; j < 16; ++j) dot += bf2f(Qs[t * 136 + part * 16 + j]) * sc[384 + part * 16 + j];
            dot += __shfl_xor(dot, 1); dot += __shfl_xor(dot, 2); dot += __shfl_xor(dot, 4);
            if (part == 0) sc[640 + t] = sc[192 + t] * dot; }
    }
    __syncthreads();
    {   f32x4 aN[4];
#pragma unroll
        for (int i = 0; i < 4; ++i) aN[i] = (f32x4){0.f, 0.f, 0.f, 0.f};
#pragma unroll
        for (int ks = 0; ks < 4; ++ks) { const bf16x8 af = *(const bf16x8*)(Qs + (16 * tt + (lane & 15)) * 136 + ks * 32 + (lane >> 4) * 8);
#pragma unroll
            for (int i = 0; i < 4; ++i) { const int et = (w & 1) * 4 + i; const bf16x8 bfr = *(const bf16x8*)(Cs + (16 * et + (lane & 15)) * 136 + ks * 32 + (lane >> 4) * 8);
                aN[i] = __builtin_amdgcn_mfma_f32_16x16x32_bf16(bfr, af, aN[i], 0, 0, 0); } }
        const int t = 16 * tt + (lane & 15);
        {   const float it = sc[192 + t];
#pragma unroll
            for (int i = 0; i < 4; ++i) { aN[i][0] *= it; aN[i][1] *= it; aN[i][2] *= it; aN[i][3] *= it; } }
#pragma unroll
        for (int ks = 0; ks < 2; ++ks) { const bf16x8 af = *(const bf16x8*)(Ss + (16 * tt + (lane & 15)) * 72 + ks * 32 + (lane >> 4) * 8);
#pragma unroll
            for (int i = 0; i < 4; ++i) { const int et = (w & 1) * 4 + i; const bf16x8 bfr = *(const bf16x8*)(VT + (16 * et + (lane & 15)) * 72 + ks * 32 + (lane >> 4) * 8);
                aN[i] = __builtin_amdgcn_mfma_f32_16x16x32_bf16(bfr, af, aN[i], 0, 0, 0); } }
        {   const size_t tokt = (size_t)step_tok(b, dir, c * 64 + t); const float dn = fmaxf(fabsf((sc[512 + t] + sc[576 + t]) + sc[640 + t]), sc[256 + t]);
#pragma unroll
            for (int i = 0; i < 4; ++i) { const int e0 = 16 * ((w & 1) * 4 + i) + (lane >> 4) * 4;
                u32x2 wv; wv.x = pk2(aN[i][0] / dn, aN[i][1] / dn); wv.y = pk2(aN[i][2] / dn, aN[i][3] / dn);
                *(u32x2*)(Hout + tokt * BW + h * 128 + e0) = wv; } }
    }
}


#define SD_FRAG_LOAD(BF, XF, cc_) do { const int tb_ = tokblock_of(b, dir, (cc_)); const bf16_t* bb_ = BTg + ((size_t)tb_ * 256 + grp * 128 + 64 * (w >> 2) + r16) * 64 + q4 * 8; const bf16_t* xb_ = XTg + ((size_t)tb_ * 512 + h * 64 + 16 * (w & 3) + r16) * 64 + q4 * 8; \
        _Pragma("unroll") for (int ks_ = 0; ks_ < 2; ++ks_) { XF[ks_] = *(const u32x4*)(xb_ + ks_ * 32); _Pragma("unroll") for (int j_ = 0; j_ < 4; ++j_) BF[j_][ks_] = *(const u32x4*)(bb_ + (size_t)j_ * 16 * 64 + ks_ * 32); } } while (0)
#define SD_CHUNK(c_, BF, XF, BFN, XFN) do { const int c = (c_); \
        if (c + 1 < 68) SD_FRAG_LOAD(BFN, XFN, c + 1); \
        const float dec = sDEC[c]; \
        {   bf16_t* ss = SSTb + (size_t)(chain * 68 + c) * 64 * 128; const int p = 16 * (w & 3) + r16; \
            _Pragma("unroll") for (int j = 0; j < 4; ++j) { const int n0 = 16 * ((w >> 2) * 4 + j) + q4 * 4; u32x2 pk; pk.x = pk2(acc[j][0], acc[j][1]); pk.y = pk2(acc[j][2], acc[j][3]); *(u32x2*)(ss + (size_t)p * 128 + n0) = pk; } } \
        bf16x8 xfr[2]; \
        _Pragma("unroll") for (int ks = 0; ks < 2; ++ks) { const float4 wa = *(const float4*)(sSC + c * 64 + ks * 32 + q4 * 8), wb = *(const float4*)(sSC + c * 64 + ks * 32 + q4 * 8 + 4); const u32x4 sv = scale8h(XF[ks], wa, wb); xfr[ks] = *(const bf16x8*)&sv; } \
        _Pragma("unroll") for (int j = 0; j < 4; ++j) acc[j] = acc[j] * dec; \
        _Pragma("unroll") for (int ks = 0; ks < 2; ++ks) _Pragma("unroll") for (int j = 0; j < 4; ++j) acc[j] = __builtin_amdgcn_mfma_f32_16x16x32_bf16(*(const bf16x8*)&BF[j][ks], xfr[ks], acc[j], 0, 0, 0); } while (0)
__device__ __forceinline__ void ssd_state_pass(const int chain, const bf16_t* __restrict__ Pm, const bf16_t* __restrict__ BTg, const bf16_t* __restrict__ XTg, const float Aa, const float dtb,
                                               bf16_t* __restrict__ SSTb, unsigned char* shm, const int tid) {
    const int dir = chain & 1, h = (chain >> 1) & 7, b = chain >> 4, grp = h >> 2, lane = tid & 63, w = tid >> 6, q4 = lane >> 4, r16 = lane & 15;
    float* sSC = (float*)shm; float* sDEC = sSC + 68 * 64;
    const int dcol = SSD_OFF + 1536 + dir * 8 + h;
    u32x4 bfA[4][2], xfA[2], bfB[4][2], xfB[2];
    SD_FRAG_LOAD(bfA, xfA, 0);
    __syncthreads();
    unsigned dt_[9];
#pragma unroll
    for (int q = 0; q < 9; ++q) { const int c = min(w + 8 * q, 67); dt_[q] = Pm[(size_t)step_tok(b, dir, c * 64 + lane) * LDP + dcol]; }
#pragma unroll
    for (int q = 0; q < 9; ++q) { const int c = w + 8 * q; if (c >= 68) break;
        const float xv = __uint_as_float(dt_[q] << 16) + dtb; const float dtv = xv > 20.f ? xv : log1pf(expf(xv));
        const float cs = wave_scan_incl(dtv * Aa, lane); const float cl = __shfl(cs, 63);
        sSC[c * 64 + (dir ? 63 - lane : lane)] = dtv * expf(cl - cs); if (lane == 0) sDEC[c] = expf(cl); }
    __syncthreads();
    f32x4 acc[4];
#pragma unroll
    for (int j = 0; j < 4; ++j) acc[j] = (f32x4){0.f, 0.f, 0.f, 0.f};
    for (int c2 = 0; c2 < 68; c2 += 2) { SD_CHUNK(c2, bfA, xfA, bfB, xfB); SD_CHUNK(c2 + 1, bfB, xfB, bfA, xfA); }
    __syncthreads();
}
#undef SD_CHUNK
#undef SD_FRAG_LOAD
__device__ __forceinline__ void ssd_out_item(const int chain, const int c, const bf16_t* __restrict__ Pm, const bf16_t* __restrict__ XBb, const bf16_t* __restrict__ XTg, const float Aa, const float dtb,
                                             const bf16_t* __restrict__ SSTb, bf16_t* __restrict__ Yout, unsigned char* shm, const int tid) {
    const int dir = chain & 1, h = (chain >> 1) & 7, b = chain >> 4, grp = h >> 2, lane = tid & 63, w = tid >> 6;
    bf16_t* Cs = (bf16_t*)shm; bf16_t* Bs = (bf16_t*)(shm + 17408); bf16_t* XT = (bf16_t*)(shm + 34816); bf16_t* Sin = (bf16_t*)(shm + 44032); bf16_t* Gs = (bf16_t*)(shm + 61440);
    float* sc = (float*)(shm + 70656);
    __syncthreads();
    u32x4 gb[2], gcc[2], gs[2], gx; unsigned gd_ = 0u;
#pragma unroll
    for (int i = 0; i < 2; ++i) { const int pid = tid + i * 512; const int s = pid >> 4, x0 = (pid & 15) * 8; const size_t toks = (size_t)step_tok(b, dir, c * 64 + s);
        gb[i] = *(const u32x4*)(XBb + toks * 1024 + 512 + grp * 128 + x0);
        gcc[i] = *(const u32x4*)(XBb + toks * 1024 + 768 + grp * 128 + x0);
        const int p = pid >> 4;
        gs[i] = *(const u32x4*)(SSTb + ((size_t)(chain * 68 + c) * 64 + p) * 128 + x0); }
    {   const int p = tid >> 3, o = tid & 7;
        gx = *(const u32x4*)(XTg + ((size_t)tokblock_of(b, dir, c) * 512 + h * 64 + p) * 64 + (dir ? 7 - o : o) * 8); }
    if (w == 0) gd_ = Pm[(size_t)step_tok(b, dir, c * 64 + lane) * LDP + SSD_OFF + 1536 + dir * 8 + h];
#pragma unroll
    for (int i = 0; i < 2; ++i) { const int pid = tid + i * 512; const int s = pid >> 4, x0 = (pid & 15) * 8;
        *(u32x4*)(Bs + s * 136 + x0) = gb[i]; *(u32x4*)(Cs + s * 136 + x0) = gcc[i]; *(u32x4*)(Sin + s * 136 + x0) = gs[i]; }
    {   const int p = tid >> 3, o = tid & 7; *(u32x4*)(XT + p * 72 + o * 8) = dir ? rev8h(gx) : gx; }
    if (w == 0) {
        const float xv = __uint_as_float(gd_ << 16) + dtb; const float dtv = xv > 20.f ? xv : log1pf(expf(xv));
        sc[lane] = wave_scan_incl(dtv * Aa, lane); sc[64 + lane] = dtv; }
    __syncthreads();
    {   const int lt = w >> 1;
        f32x4 aG[2] = {(f32x4){0.f, 0.f, 0.f, 0.f}, (f32x4){0.f, 0.f, 0.f, 0.f}};
#pragma unroll
        for (int ks = 0; ks < 4; ++ks) { const bf16x8 af = *(const bf16x8*)(Cs + (16 * lt + (lane & 15)) * 136 + ks * 32 + (lane >> 4) * 8);
#pragma unroll
            for (int i = 0; i < 2; ++i) { const int st = (w & 1) * 2 + i; const bf16x8 bfr = *(const bf16x8*)(Bs + (16 * st + (lane & 15)) * 136 + ks * 32 + (lane >> 4) * 8);
                aG[i] = __builtin_amdgcn_mfma_f32_16x16x32_bf16(af, bfr, aG[i], 0, 0, 0); } }
#pragma unroll
        for (int i = 0; i < 2; ++i) { const int s = 16 * ((w & 1) * 2 + i) + (lane & 15); const float css = sc[s], dts = sc[64 + s];
#pragma unroll
            for (int q = 0; q < 4; ++q) { const int t = 16 * lt + (lane >> 4) * 4 + q; const float val = (s <= t) ? aG[i][q] * expf(sc[t] - css) * dts : 0.f; Gs[t * 72 + s] = f2bf(val); } }
    }
    __syncthreads();
    {   const int lt = w >> 1;
        f32x4 aY[2] = {(f32x4){0.f, 0.f, 0.f, 0.f}, (f32x4){0.f, 0.f, 0.f, 0.f}};
#pragma unroll
        for (int ks = 0; ks < 4; ++ks) { const bf16x8 af = *(const bf16x8*)(Cs + (16 * lt + (lane & 15)) * 136 + ks * 32 + (lane >> 4) * 8);
#pragma unroll
            for (int i = 0; i < 2; ++i) { const int pt = (w & 1) * 2 + i; const bf16x8 bfr = *(const bf16x8*)(Sin + (16 * pt + (lane & 15)) * 136 + ks * 32 + (lane >> 4) * 8);
                aY[i] = __builtin_amdgcn_mfma_f32_16x16x32_bf16(bfr, af, aY[i], 0, 0, 0); } }
        const int t = 16 * lt + (lane & 15);
        {   const float ec = expf(sc[t]);
#pragma unroll
            for (int i = 0; i < 2; ++i) { aY[i][0] *= ec; aY[i][1] *= ec; aY[i][2] *= ec; aY[i][3] *= ec; } }
#pragma unroll
        for (int ks = 0; ks < 2; ++ks) { const bf16x8 af = *(const bf16x8*)(Gs + (16 * lt + (lane & 15)) * 72 + ks * 32 + (lane >> 4) * 8);
#pragma unroll
            for (int i = 0; i < 2; ++i) { const int pt = (w & 1) * 2 + i; const bf16x8 bfr = *(const bf16x8*)(XT + (16 * pt + (lane & 15)) * 72 + ks * 32 + (lane >> 4) * 8);
                aY[i] = __builtin_amdgcn_mfma_f32_16x16x32_bf16(bfr, af, aY[i], 0, 0, 0); } }
        {   const size_t tokt = (size_t)step_tok(b, dir, c * 64 + t);
#pragma unroll
            for (int i = 0; i < 2; ++i) { const int p0 = 16 * ((w & 1) * 2 + i) + (lane >> 4) * 4;
                u32x2 wv; wv.x = pk2(aY[i][0], aY[i][1]); wv.y = pk2(aY[i][2], aY[i][3]);
                *(u32x2*)(Yout + tokt * BW + h * 64 + p0) = wv; } }
    }
}


#define FIDX(i) ((i) + ((i) >> 4))
#define FFT_X_BYTES 69632
__device__ constexpr float FFT_CW_RE[6][16] = {{0.f, 0.f, 0.f, 0.f, 0.f, 0.f, 0.f, 0.f, 0.f, 0.f, 0.f, 0.f, 0.f, 0.f, 0.f, 0.f}, {1.0f, 0.f, 0.f, 0.f, 0.f, 0.f, 0.f, 0.f, 0.f, 0.f, 0.f, 0.f, 0.f, 0.f, 0.f, 0.f}, {1.0f, 6.123233995736766e-17f, 0.f, 0.f, 0.f, 0.f, 0.f, 0.f, 0.f, 0.f, 0.f, 0.f, 0.f, 0.f, 0.f, 0.f}, {1.0f, 0.7071067811865476f, 6.123233995736766e-17f, -0.7071067811865475f, 0.f, 0.f, 0.f, 0.f, 0.f, 0.f, 0.f, 0.f, 0.f, 0.f, 0.f, 0.f}, {1.0f, 0.9238795325112867f, 0.7071067811865476f, 0.38268343236508984f, 6.123233995736766e-17f, -0.3826834323650897f, -0.7071067811865475f, -0.9238795325112867f, 0.f, 0.f, 0.f, 0.f, 0.f, 0.f, 0.f, 0.f}, {1.0f, 0.9807852804032304f, 0.9238795325112867f, 0.8314696123025452f, 0.7071067811865476f, 0.5555702330196023f, 0.38268343236508984f, 0.19509032201612833f, 6.123233995736766e-17f, -0.1950903220161282f, -0.3826834323650897f, -0.555570233019602f, -0.7071067811865475f, -0.8314696123025453f, -0.9238795325112867f, -0.9807852804032304f}};
__device__ constexpr float FFT_CW_IM[6][16] = {{0.f, 0.f, 0.f, 0.f, 0.f, 0.f, 0.f, 0.f, 0.f, 0.f, 0.f, 0.f, 0.f, 0.f, 0.f, 0.f}, {-0.0f, 0.f, 0.f, 0.f, 0.f, 0.f, 0.f, 0.f, 0.f, 0.f, 0.f, 0.f, 0.f, 0.f, 0.f, 0.f}, {-0.0f, -1.0f, 0.f, 0.f, 0.f, 0.f, 0.f, 0.f, 0.f, 0.f, 0.f, 0.f, 0.f, 0.f, 0.f, 0.f}, {-0.0f, -0.7071067811865475f, -1.0f, -0.7071067811865476f, 0.f, 0.f, 0.f, 0.f, 0.f, 0.f, 0.f, 0.f, 0.f, 0.f, 0.f, 0.f}, {-0.0f, -0.3826834323650898f, -0.7071067811865475f, -0.9238795325112867f, -1.0f, -0.9238795325112867f, -0.7071067811865476f, -0.3826834323650899f, 0.f, 0.f, 0.f, 0.f, 0.f, 0.f, 0.f, 0.f}, {-0.0f, -0.19509032201612825f, -0.3826834323650898f, -0.5555702330196022f, -0.7071067811865475f, -0.8314696123025452f, -0.9238795325112867f, -0.9807852804032304f, -1.0f, -0.9807852804032304f, -0.9238795325112867f, -0.8314696123025455f, -0.7071067811865476f, -0.5555702330196022f, -0.3826834323650899f, -0.1950903220161286f}};
__host__ __device__ constexpr int fft_bitrev(int k, int R) { int r = 0; for (int i = 0; i < R; ++i) if (k & (1 << i)) r |= 1 << (R - 1 - i); return r; }
template <int R, bool INV>
__device__ __forceinline__ void fft_pass(float2* __restrict__ X, const float2* __restrict__ TW, const int s0, const int gidx) {
    const int lowbits = 13 - s0 - R; const int stride = 1 << lowbits;
    const int low = gidx & (stride - 1), high = gidx >> lowbits; const int base = (high << (lowbits + R)) | low;
    const int p0 = FIDX(base);
#define FFT_SLOT(k) (lowbits >= 4 ? p0 + (k) * (stride + (stride >> 4)) : p0 + (k) + ((k) >> 4))
    float2 v[1 << R];
#pragma unroll
    for (int k = 0; k < (1 << R); ++k) v[k] = X[FFT_SLOT(k)];
    const int lw = low << s0;
    if (!INV) {
#pragma unroll
        for (int j = 0; j < R; ++j) { const int hk = 1 << (R - 1 - j);
#pragma unroll
            for (int k = 0; k < (1 << R); ++k) if (!(k & hk)) { const int kk = k & (hk - 1);
                const float2 a = v[k], b = v[k + hk]; v[k] = make_float2(a.x + b.x, a.y + b.y); const float dx = a.x - b.x, dy = a.y - b.y;
                if (kk == 0) v[k + hk] = make_float2(dx, dy);
                else if (2 * kk == hk) v[k + hk] = make_float2(dy, -dx);
                else { const float cr = FFT_CW_RE[R - j][kk], ci = FFT_CW_IM[R - j][kk]; v[k + hk] = make_float2(dx * cr - dy * ci, dx * ci + dy * cr); } } }
        if (lowbits > 0) {
#pragma unroll
            for (int k = 1; k < (1 << R); ++k) { const float2 w = TW[(lw * fft_bitrev(k, R)) & 8191]; const float2 a = v[k]; v[k] = make_float2(a.x * w.x - a.y * w.y, a.x * w.y + a.y * w.x); } }
    } else {
        if (lowbits > 0) {
#pragma unroll
            for (int k = 1; k < (1 << R); ++k) { const float2 w = TW[(lw * fft_bitrev(k, R)) & 8191]; const float2 a = v[k]; v[k] = make_float2(a.x * w.x + a.y * w.y, a.y * w.x - a.x * w.y); } }
#pragma unroll
        for (int j = R - 1; j >= 0; --j) { const int hk = 1 << (R - 1 - j);
#pragma unroll
            for (int k = 0; k < (1 << R); ++k) if (!(k & hk)) { const int kk = k & (hk - 1);
                const float2 a = v[k], b = v[k + hk]; float tx, ty;
                if (kk == 0) { tx = b.x; ty = b.y; }
                else if (2 * kk == hk) { tx = -b.y; ty = b.x; }
                else { const float cr = FFT_CW_RE[R - j][kk], ci = FFT_CW_IM[R - j][kk]; tx = b.x * cr + b.y * ci; ty = b.y * cr - b.x * ci; }
                v[k] = make_float2(a.x + tx, a.y + ty); v[k + hk] = make_float2(a.x - tx, a.y - ty); } }
    }
#pragma unroll
    for (int k = 0; k < (1 << R); ++k) X[FFT_SLOT(k)] = v[k];
#undef FFT_SLOT
}
__device__ __forceinline__ void fft_fwd(float2* X, const float2* TW, const int tid) {
    fft_pass<4, false>(X, TW, 0, tid); __syncthreads(); fft_pass<4, false>(X, TW, 4, tid); __syncthreads(); if (tid < 256) fft_pass<5, false>(X, TW, 8, tid); __syncthreads(); }
__device__ __forceinline__ void fft_inv(float2* X, const float2* TW, const int tid) {
    if (tid < 256) fft_pass<5, true>(X, TW, 8, tid); __syncthreads(); fft_pass<4, true>(X, TW, 4, tid); __syncthreads(); fft_pass<4, true>(X, TW, 0, tid); __syncthreads(); }
__device__ __forceinline__ void fft_twiddles(float2* TW, const int tid) {
#pragma unroll
    for (int k = 0; k < 16; ++k) { const int m = tid + k * 512; const float xx = (float)m * (1.0f / 4096.0f); TW[m] = make_float2(cospif(xx), -sinpif(xx)); }
}
__device__ __forceinline__ void hyena_spec_item(const int pr, const float* __restrict__ HR, const float* __restrict__ nrm, float2* __restrict__ HSPEC, unsigned char* shm, const int tid) {
    float2* X = (float2*)shm; const float2* TW = (const float2*)(shm + FFT_X_BYTES);
    const int o = pr >> 8, c = (pr & 255) * 2, oc = o * 512 + c; const float inva = 1.0f / nrm[oc], invb = 1.0f / nrm[oc + 1];
    __syncthreads();
    float2 hv[16];
#pragma unroll
    for (int k = 0; k < 16; ++k) { const int j = tid + k * 512;
        const unsigned off = j < SEQ ? (unsigned)j * 2048u + o * 1024 + c : j == SEQ ? (unsigned)(o * 1024 + c) : (unsigned)(2 * SEQ - j) * 2048u + o * 1024 + 512 + c;
        hv[k] = *(const float2*)(HR + off); }
#pragma unroll
    for (int k = 0; k < 16; ++k) { const int j = tid + k * 512; X[FIDX(j)] = j == SEQ ? make_float2(0.f, 0.f) : make_float2(hv[k].x * inva, hv[k].y * invb); }
    __syncthreads();
    fft_fwd(X, TW, tid);
    float4* outa = (float4*)(HSPEC + (size_t)oc * 8192 + tid * 16); float4* outb = (float4*)(HSPEC + (size_t)(oc + 1) * 8192 + tid * 16); const float2* xs = X + 17 * tid;
    const float sc_ = 0.5f / 8192.0f;
#pragma unroll
    for (int k = 0; k < 8; ++k) { float2 ha[2], hb[2];
#pragma unroll
        for (int q = 0; q < 2; ++q) { const int p = 16 * tid + 2 * k + q; const int kf = (int)(__builtin_bitreverse32((unsigned)p) >> 19); const int p2 = (int)(__builtin_bitreverse32((unsigned)((8192 - kf) & 8191)) >> 19);
            const float2 xp = xs[2 * k + q], xq = X[FIDX(p2)];
            ha[q] = make_float2((xp.x + xq.x) * sc_, (xp.y - xq.y) * sc_);
            hb[q] = make_float2((xp.y + xq.y) * sc_, (xq.x - xp.x) * sc_); }
        outa[k] = make_float4(ha[0].x, ha[0].y, ha[1].x, ha[1].y); outb[k] = make_float4(hb[0].x, hb[0].y, hb[1].x, hb[1].y); }
}
__device__ __forceinline__ void fft_mul_spec(float2* X, const float2* __restrict__ H, const int tid) {
    const float4* h4 = (const float4*)(H + tid * 16); float2* xs = X + 17 * tid;
#pragma unroll
    for (int k = 0; k < 8; ++k) { const float4 hv = h4[k]; const float2 x0 = xs[2 * k], x1 = xs[2 * k + 1];
        xs[2 * k] = make_float2(x0.x * hv.x - x0.y * hv.y, x0.x * hv.y + x0.y * hv.x); xs[2 * k + 1] = make_float2(x1.x * hv.z - x1.y * hv.w, x1.x * hv.w + x1.y * hv.z); }
}
__device__ __forceinline__ void hyena_fft_item(const int item, const bf16_t* __restrict__ UT, const float2* __restrict__ HSPEC, const float* __restrict__ bias, bf16_t* __restrict__ YT, unsigned char* shm, const int tid) {
    float2* X = (float2*)shm; const float2* TW = (const float2*)(shm + FFT_X_BYTES);
    const int c = item >> 1, b0 = (item & 1) * 2, b1 = b0 + 1;
    const bf16_t* u0 = UT + (size_t)(b0 * 1536 + c) * SEQ + tid * 8; const bf16_t* u1 = UT + (size_t)(b1 * 1536 + c) * SEQ + tid * 8;
    const float bias0 = bias[c], bias1 = bias[512 + c];
    float2* xs = X + FIDX(8 * tid);
    float vr[8], vi[8];
    __syncthreads();
    { const u32x4 a0 = *(const u32x4*)u0, c0 = *(const u32x4*)u1; unpack8(a0, vr); unpack8(c0, vi); }
#pragma unroll
    for (int k = 0; k < 8; ++k) { xs[k] = make_float2(vr[k], vi[k]); xs[4352 + k] = make_float2(0.f, 0.f); }
    __syncthreads();
    fft_fwd(X, TW, tid);
    fft_mul_spec(X, HSPEC + (size_t)c * 8192, tid);
    __syncthreads();
    fft_inv(X, TW, tid);
    { const bf16_t* p0 = u0 + (size_t)512 * SEQ; const bf16_t* p1 = u1 + (size_t)512 * SEQ;
      float xr[8], xi[8]; { const u32x4 a0 = *(const u32x4*)p0, c0 = *(const u32x4*)p1; unpack8(a0, xr); unpack8(c0, xi); }
#pragma unroll
      for (int k = 0; k < 8; ++k) { const float2 cv = xs[k]; const float zr = xr[k] * (cv.x + bias0 * vr[k]), zi = xi[k] * (cv.y + bias0 * vi[k]);
          vr[k] = zr; vi[k] = zi; xs[k] = make_float2(zr, zi); xs[4352 + k] = make_float2(0.f, 0.f); } }
    __syncthreads();
    fft_fwd(X, TW, tid);
    fft_mul_spec(X, HSPEC + (size_t)(512 + c) * 8192, tid);
    __syncthreads();
    fft_inv(X, TW, tid);
    { const bf16_t* p0 = u0 + (size_t)1024 * SEQ; const bf16_t* p1 = u1 + (size_t)1024 * SEQ;
      float xr[8], xi[8]; { const u32x4 a0 = *(const u32x4*)p0, c0 = *(const u32x4*)p1; unpack8(a0, xr); unpack8(c0, xi); }
      float yr[8], yi[8];
#pragma unroll
      for (int k = 0; k < 8; ++k) { const float2 cv = xs[k]; yr[k] = xr[k] * (cv.x + bias1 * vr[k]); yi[k] = xi[k] * (cv.y + bias1 * vi[k]); }
      bf16_t* y0 = YT + (size_t)(b0 * 512 + c) * SEQ + tid * 8; bf16_t* y1 = YT + (size_t)(b1 * 512 + c) * SEQ + tid * 8;
      { u32x4 w; w.x = pk2(yr[0], yr[1]); w.y = pk2(yr[2], yr[3]); w.z = pk2(yr[4], yr[5]); w.w = pk2(yr[6], yr[7]); *(u32x4*)y0 = w; }
      { u32x4 w; w.x = pk2(yi[0], yi[1]); w.y = pk2(yi[2], yi[3]); w.z = pk2(yi[4], yi[5]); w.w = pk2(yi[6], yi[7]); *(u32x4*)y1 = w; } }
}

constexpr size_t al256(size_t x) { return (x + 255) & ~(size_t)255; }
constexpr size_t O_BAR = 0;
constexpr size_t O_MOD = 16384;
constexpr size_t O_NORM = O_MOD + al256((size_t)2 * 5 * 6 * DM * 4);
constexpr size_t O_QCTR = O_NORM + al256((size_t)2 * 2 * 1024 * 4);
constexpr size_t O_ZERO_END = O_QCTR + 512;
constexpr size_t O_XS = O_ZERO_END;
constexpr size_t O_HB = O_XS + al256((size_t)NTOK * DM * 4);
constexpr size_t O_P = O_HB + al256((size_t)NTOK * DM * 2);
constexpr size_t O_WIN = O_P + al256((size_t)NTOK * LDP * 2);
constexpr size_t O_WBR = O_WIN + al256((size_t)LDP * DM * 2);
constexpr size_t O_WOUT = O_WBR + al256((size_t)4 * DM * BW * 2);
constexpr size_t O_WGU = O_WOUT + al256((size_t)DM * DM * 2);
constexpr size_t O_WD = O_WGU + al256((size_t)NEXP * 2 * DEXP * DM * 2);
constexpr size_t O_GLU = O_WD + al256((size_t)NEXP * DM * DEXP * 2);
constexpr size_t O_Y4 = O_GLU + al256((size_t)BW * BW * 2);
constexpr size_t O_U = O_Y4 + al256((size_t)NTOK * DM * 2);
constexpr size_t O_QKB = O_U + al256((size_t)NTOK * 1536 * 4);
constexpr size_t O_CST = O_QKB + al256((size_t)NTOK * 1024 * 2);
constexpr size_t O_NST = O_CST + al256((size_t)32 * 68 * 128 * 128 * 2);
constexpr size_t O_MST = O_NST + al256((size_t)32 * 68 * 128 * 4);
constexpr size_t O_XBC = O_MST + al256((size_t)32 * 68 * 4);
constexpr size_t O_SST = O_XBC + al256((size_t)NTOK * 1024 * 2);
constexpr size_t O_HF = O_SST + al256((size_t)64 * 68 * 64 * 128 * 2);
constexpr size_t O_YF = O_HF + al256((size_t)2 * NTOK * BW * 4);
constexpr size_t O_SF = O_YF + al256((size_t)2 * NTOK * BW * 4);
constexpr size_t O_LDT = O_SF + al256((size_t)2 * NCTX * BW * 4);
constexpr size_t O_AP = O_LDT + al256((size_t)4096 * 16);
constexpr size_t O_BBT = O_AP + al256((size_t)4096 * 33 * 8);
constexpr size_t O_KT = O_BBT + al256((size_t)4096 * 16 * 8);
constexpr size_t O_S5A = O_KT + al256((size_t)32 * 2 * 32 * 256 * 4);
constexpr size_t O_S5B = O_S5A + al256((size_t)32 * 512 * 768 * 2);
constexpr size_t O_XCTX = O_S5B + al256((size_t)32 * 512 * 768 * 2);
constexpr size_t O_Z = O_XCTX + al256((size_t)4 * 32 * 2 * 64 * 8);
constexpr size_t O_HRAW = O_Z + al256((size_t)NTOK * BW * 4);
constexpr size_t O_HSPEC = O_HRAW + al256((size_t)(SEQ + CTXL) * 2048 * 4);
constexpr size_t O_K2C = O_HSPEC + al256((size_t)1024 * 8192 * 8);
constexpr size_t O_GG = O_K2C + al256((size_t)(2 * CTXL) * 1024 * 4);
constexpr size_t O_PROBS = O_GG + al256((size_t)NTOK * BW * 2);
constexpr size_t O_ROWTOK = O_PROBS + al256((size_t)NTOK * 16 * 4);
constexpr size_t O_ROWGATE = O_ROWTOK + al256((size_t)NEXP * MOE_PAD * 4);
constexpr size_t O_INV = O_ROWGATE + al256((size_t)NEXP * MOE_PAD * 4);
constexpr size_t O_NORMP = O_INV + al256((size_t)NTOK * 16 * 4);
constexpr size_t WS_END = O_NORMP + al256((size_t)4 * 256 * 2048 * 4);
constexpr size_t O_XG = O_P;
constexpr size_t O_HID = O_P + al256((size_t)NEXP * MOE_PAD * DM * 2);
constexpr size_t O_YEXP = O_HID + al256((size_t)NEXP * MOE_PAD * DEXP * 2);
static_assert(O_YEXP + (size_t)NEXP * MOE_PAD * DM * 2 <= O_WIN, "MoE temporaries must fit inside P");
static_assert((size_t)NTOK * DM * 2 <= (size_t)NTOK * 1536 * 4, "ACCb must fit inside U");
static_assert((size_t)26214400 + (size_t)2 * 17825792 + (size_t)272 * 256 * 64 * 2 <= (size_t)NTOK * DM * 2, "strip buffers must fit inside HB");
static_assert(WS_END <= (size_t)1851000000, "workspace map exceeds the guaranteed size");

struct Args {
    const float* in[47];
    float* out; unsigned char* ws;
    int ph_lo, ph_hi;
};

__device__ __forceinline__ void conv_tile(const float* __restrict__ src, int ldsrc, int nvalid, int k0, int n0, bf16_t* __restrict__ dst, int lddst, int mode, float* T, int tid) {
    { const int n = tid & 63, kr = tid >> 6;
#pragma unroll
      for (int i = 0; i < 8; ++i) { const int k = i * 8 + kr; T[k * 65 + n] = (n0 + n < nvalid) ? src[(size_t)(k0 + k) * ldsrc + n0 + n] : 0.f; } }
    __syncthreads();
    { const int n = tid >> 3, kc = (tid & 7) * 8; const int gn = n0 + n;
      const int drow = mode == 0 ? gn : (32 * (gn >> 4) + (mode == 2 ? 16 : 0) + (gn & 15));
      u32x4 w; w.x = pk2(T[(kc + 0) * 65 + n], T[(kc + 1) * 65 + n]); w.y = pk2(T[(kc + 2) * 65 + n], T[(kc + 3) * 65 + n]);
      w.z = pk2(T[(kc + 4) * 65 + n], T[(kc + 5) * 65 + n]); w.w = pk2(T[(kc + 6) * 65 + n], T[(kc + 7) * 65 + n]);
      *(u32x4*)(dst + (size_t)drow * lddst + k0 + kc) = w; }
    __syncthreads();
}

#define IN(id) (lo <= (id) && (id) < hi)
#define SEAM(id) do { if (hi > (id) + 1) xcd_barrier(bar); } while (0)
#define PH_BEGIN int tid = threadIdx.x; asm volatile("" : "+v"(tid) :: "memory"); const int lane = tid & 63, wave = tid >> 6; (void)lane; (void)wave;

#define x_in (PT(0))
#define c_in (PT(1))
#define ctx_in (PT(2))
#define cctx_in (PT(3))
#define ada_w (PT(4))
#define ada_b (PT(5))
#define norm_mix (PT(6))
#define norm_ffn (PT(7))
#define w_in (PT(8))
#define XS ((float*)(a.ws + O_XS))
#define MOD ((float*)(a.ws + O_MOD))
#define NORM ((float*)(a.ws + O_NORM))
#define NORMP ((float*)(a.ws + O_NORMP))
#define MODl (MOD + (size_t)l * 5 * 6 * DM)
#define HB ((bf16_t*)(a.ws + O_HB))
#define P ((bf16_t*)(a.ws + O_P))
#define WIN ((bf16_t*)(a.ws + O_WIN))
#define WBR ((bf16_t*)(a.ws + O_WBR))
#define WOUT ((bf16_t*)(a.ws + O_WOUT))
#define WGU ((bf16_t*)(a.ws + O_WGU))
#define WD ((bf16_t*)(a.ws + O_WD))
#define GLU ((bf16_t*)(a.ws + O_GLU))
#define Y4 ((bf16_t*)(a.ws + O_Y4))
#define U ((float*)(a.ws + O_U))
#define ACCb ((bf16_t*)(a.ws + O_U))
#define QKB ((bf16_t*)(a.ws + O_QKB))
#define CST ((bf16_t*)(a.ws + O_CST))
#define NST ((float*)(a.ws + O_NST))
#define MST ((float*)(a.ws + O_MST))
#define XBC ((bf16_t*)(a.ws + O_XBC))
#define SSTB ((bf16_t*)(a.ws + O_SST))
#define HF ((bf16_t*)(a.ws + O_HF))
#define HBk (HF + (size_t)NTOK * BW)
#define YF ((bf16_t*)(a.ws + O_YF))
#define YB (YF + (size_t)NTOK * BW)
#define SF ((float*)(a.ws + O_SF))
#define SB (SF + (size_t)NCTX * BW)
#define LDT ((double2*)(a.ws + O_LDT))
#define APW ((float2*)(a.ws + O_AP))
#define BBT ((float2*)(a.ws + O_BBT))
#define KTB ((float*)(a.ws + O_KT))
#define S5A ((bf16_t*)(a.ws + O_S5A))
#define S5B ((bf16_t*)(a.ws + O_S5B))
#define XCTX ((float2*)(a.ws + O_XCTX))
#define S5P ((bf16_t*)(a.ws + O_HB))
#define XLOC ((float*)(a.ws + O_HB + (size_t)32 * 256 * 512 * 2))
#define KTG ((bf16_t*)(a.ws + O_HB + (size_t)26214400))
#define VTG ((bf16_t*)(a.ws + O_HB + (size_t)26214400 + (size_t)17825792))
#define BTG ((bf16_t*)(a.ws + O_HB + (size_t)26214400 + (size_t)2 * 17825792))
#define XTG ((bf16_t*)(a.ws + O_GG))
#define Z ((float*)(a.ws + O_Z))
#define HRAW ((float*)(a.ws + O_HRAW))
#define HSPEC ((float2*)(a.ws + O_HSPEC))
#define UT ((bf16_t*)(a.ws + O_U))
#define YT ((bf16_t*)(a.ws + O_Z))
#define QCTR ((int*)(a.ws + O_QCTR))
#define K2C ((float*)(a.ws + O_K2C))
#define GG ((bf16_t*)(a.ws + O_GG))
#define PROBS ((float*)(a.ws + O_PROBS))
#define ROWTOK ((int*)(a.ws + O_ROWTOK))
#define ROWGATE ((float*)(a.ws + O_ROWGATE))
#define XG ((bf16_t*)(a.ws + O_XG))
#define HID ((bf16_t*)(a.ws + O_HID))
#define YEXP ((bf16_t*)(a.ws + O_YEXP))
#define INV ((int*)(a.ws + O_INV))


__device__ __forceinline__ void moe_pair(float4 (&a)[8], const int r1, const int r2, const float g2scale, const int lane, const float* __restrict__ rowgate, const bf16_t* __restrict__ yexp) {
    const float gt1 = rowgate[r1], gt2 = rowgate[r2] * g2scale;
    const bf16_t* y1 = yexp + (size_t)r1 * DM + lane * 4; const bf16_t* y2 = yexp + (size_t)r2 * DM + lane * 4;
    u32x2 w1[8], w2[8];
#pragma unroll
    for (int i = 0; i < 8; ++i) { w1[i] = *(const u32x2*)(y1 + i * 256); w2[i] = *(const u32x2*)(y2 + i * 256); }
#pragma unroll
    for (int i = 0; i < 8; ++i) {
        a[i].x += gt1 * __uint_as_float(w1[i].x << 16); a[i].y += gt1 * __uint_as_float(w1[i].x & 0xFFFF0000u); a[i].z += gt1 * __uint_as_float(w1[i].y << 16); a[i].w += gt1 * __uint_as_float(w1[i].y & 0xFFFF0000u);
        a[i].x += gt2 * __uint_as_float(w2[i].x << 16); a[i].y += gt2 * __uint_as_float(w2[i].x & 0xFFFF0000u); a[i].z += gt2 * __uint_as_float(w2[i].y << 16); a[i].w += gt2 * __uint_as_float(w2[i].y & 0xFFFF0000u); }
}
__device__ __forceinline__ void moe_combine(float4 (&v)[8], const int tok, const int lane, const int* __restrict__ inv, const float* __restrict__ rowgate, const bf16_t* __restrict__ yexp, const float* __restrict__ m5) {
    float4 a[8], mm[8];
#pragma unroll
    for (int i = 0; i < 8; ++i) { a[i] = make_float4(0.f, 0.f, 0.f, 0.f); mm[i] = *(const float4*)(m5 + i * 256 + lane * 4); }
    const int4* ip = (const int4*)(inv + (size_t)tok * 16);
    const int4 q0 = ip[0], q1 = ip[1], q2 = ip[2], q3 = ip[3];
    const int rows[16] = {q0.x, q0.y, q0.z, q0.w, q1.x, q1.y, q1.z, q1.w, q2.x, q2.y, q2.z, q2.w, q3.x, q3.y, q3.z, q3.w};
    int prow = -1;
#pragma unroll
    for (int e = 0; e < 16; ++e) { const int row = __builtin_amdgcn_readfirstlane(rows[e]);
        if (row >= 0) { if (prow >= 0) { moe_pair(a, prow, row, 1.0f, lane, rowgate, yexp); prow = -1; } else prow = row; } }
    if (prow >= 0) moe_pair(a, prow, prow, 0.0f, lane, rowgate, yexp);
#pragma unroll
    for (int i = 0; i < 8; ++i) { v[i].x += mm[i].x * a[i].x; v[i].y += mm[i].y * a[i].y; v[i].z += mm[i].z * a[i].z; v[i].w += mm[i].w * a[i].w; }
}
struct CvU { const float* src; bf16_t* dst; int ldsrc, nvalid, k0, n0, lddst, mode; };
__device__ __forceinline__ void cv_load(const CvU& u, float4 (&r)[8], const int tid) {
#pragma unroll
    for (int i = 0; i < 8; ++i) { const int idx = tid + i * 512; const int k = idx >> 6, n = u.n0 + (idx & 63) * 4;
        r[i] = (n < u.nvalid) ? *(const float4*)(u.src + (size_t)(u.k0 + k) * u.ldsrc + n) : make_float4(0.f, 0.f, 0.f, 0.f); }
}
__device__ __forceinline__ void cv_stage(float* T, const float4 (&r)[8], const int tid) {
#pragma unroll
    for (int i = 0; i < 8; ++i) { const int idx = tid + i * 512; float* p = T + (idx >> 6) * 257 + (idx & 63) * 4; p[0] = r[i].x; p[1] = r[i].y; p[2] = r[i].z; p[3] = r[i].w; }
}
__device__ __forceinline__ void cv_store(const CvU& u, const float* T, const int tid) {
#pragma unroll
    for (int j = 0; j < 4; ++j) { const int o = tid + j * 512; const int kc = (o & 7) * 8, n = o >> 3; const int gn = u.n0 + n;
        int drow = u.mode == 0 ? gn : (256 * (gn >> 7) + (u.mode == 2 ? 128 : 0) + (gn & 127));
        if (u.mode == 3) {
            if (gn >= IN_W) continue;
            drow = gn;
            if (gn >= GATE_OFF) { const int g = gn - GATE_OFF, kb = g >> 11, col = g & 2047, j2 = col >> 6, rem = col & 63;
                drow = GATE2 + 256 * j2 + 128 * (kb >> 1) + 32 * (rem >> 4) + 8 * ((rem >> 2) & 3) + 4 * (kb & 1) + (rem & 3); } }
        const float* t = T + kc * 257 + n;
        u32x4 w; w.x = pk2(t[0], t[257]); w.y = pk2(t[2 * 257], t[3 * 257]); w.z = pk2(t[4 * 257], t[5 * 257]); w.w = pk2(t[6 * 257], t[7 * 257]);
        *(u32x4*)(u.dst + (size_t)drow * u.lddst + u.k0 + kc) = w; }
}
#define CV_RUN(LL, QSTART, QSTEP, QEND) do { \
                const float* wbr = PT(40) + (size_t)(LL) * 4 * BW * DM; const float* wout = PT(41) + (size_t)(LL) * DM * DM; \
                const float* wg = PT(43) + (size_t)(LL) * NEXP * DM * DEXP; const float* wu = PT(44) + (size_t)(LL) * NEXP * DM * DEXP; const float* wd = PT(45) + (size_t)(LL) * NEXP * DEXP * DM; \
                const float* wglu = PT(32) + (size_t)(LL) * BW * BW; const float* win = w_in + (size_t)(LL) * DM * IN_W; \
                const int cv_step = (QSTEP), cv_end = (QEND); \
                __syncthreads(); \
                int q = (QSTART); int buf = 0; CvU u; float4 r[8]; \
                if (q < cv_end) { CV_DECODE(q, u); cv_load(u, r, tid); } \
                while (q < cv_end) { \
                    float* T = sf + buf * (64 * 257); \
                    cv_stage(T, r, tid); \
                    __syncthreads(); \
                    const CvU cur = u; const int qn = q + cv_step; \
                    if (qn < cv_end) { CV_DECODE(qn, u); cv_load(u, r, tid); } \
                    cv_store(cur, T, tid); \
                    buf ^= 1; q = qn; \
                } \
                __syncthreads(); } while (0)
#define CV_DECODE(q_, u_) do { int qq_ = (q_); \
                    if (qq_ < n_win) { u_ = CvU{win, WIN, IN_W, IN_W, (qq_ / 55) * 64, (qq_ % 55) * 256, DM, 3}; } else { qq_ -= n_win; \
                    if (qq_ < n_br) { const int k = qq_ >> 6, r = qq_ & 63; u_ = CvU{wbr + (size_t)k * BW * DM, WBR + (size_t)k * DM * BW, DM, DM, (r >> 3) * 64, (r & 7) * 256, BW, 0}; } else { qq_ -= n_br; \
                    if (qq_ < n_out) { u_ = CvU{wout, WOUT, DM, DM, (qq_ >> 3) * 64, (qq_ & 7) * 256, DM, 0}; } else { qq_ -= n_out; \
                    if (qq_ < n_glu) { u_ = CvU{wglu, GLU, BW, BW, (qq_ >> 1) * 64, (qq_ & 1) * 256, BW, 0}; } else { qq_ -= n_glu; \
                    if (qq_ < n_gu) { const int e = qq_ / 384, r = qq_ % 384, up = r / 192, r2 = r % 192; u_ = CvU{(up ? wu : wg) + (size_t)e * DM * DEXP, WGU + (size_t)e * 2 * DEXP * DM, DEXP, DEXP, (r2 / 6) * 64, (r2 % 6) * 256, DM, 1 + up}; } else { qq_ -= n_gu; \
                    { const int e = qq_ / 192, r = qq_ % 192; u_ = CvU{wd + (size_t)e * DEXP * DM, WD + (size_t)e * DM * DEXP, DM, DM, (r >> 3) * 64, (r & 7) * 256, DEXP, 0}; } } } } } } } while (0)
template <int LAYER>
__device__ __forceinline__ void layer_body(const Args& a, const XcdBarrier& bar, const int lo, const int hi, const int bid, const int G, unsigned char* const shm, float* const sf, const float** const ptab) {
        constexpr int l = LAYER;
        constexpr int PB = 1 + 16 * l;
        const bool lastl = (l == 1);

        const int nPanels = lastl ? 64 : 68;
        const int M2 = nPanels * 256;

        if (IN(PB + 0)) for (int rep_ = 0; rep_ < (l == 0 ? PROBE_REPS(0) : 1); ++rep_) {
            PH_BEGIN
            {   const int n_win = 32 * 55, n_br = 4 * 64, n_out = 32 * 8, n_glu = 16, n_gu = 16 * 2 * 192, n_d = 16 * 192;
                const int n_grp1 = n_win + n_br + n_out + n_glu, total = n_grp1 + n_gu + n_d;
                const int q_lo = (l > 0 && G > 128) ? n_win : 0;
                const int q_hi = (lastl && G > 64) ? n_grp1 + n_gu - 1536 : total;
                CV_RUN(l, q_lo + bid, G, q_hi);
                for (int i = bid * NTHR + tid; i < (GATE2 - GATE_OFF) * DM / 8; i += G * NTHR) ((u32x4*)(WIN + (size_t)GATE_OFF * DM))[i] = (u32x4){0u, 0u, 0u, 0u};
            }
            for (int set = 0; set < (lastl ? 1 : 2); ++set) {
                const int L = set ? CTXL : SEQ; float* HR = HRAW + (set ? (size_t)SEQ * 2048 : 0);
                const float* w1 = PT(11) + l * 33 * 64; const float* b1 = PT(12) + l * 64; const float* fr1 = PT(13) + l * 64; const float* w2 = PT(14) + l * 64 * 64; const float* b2 = PT(15) + l * 64;
                const float* fr2 = PT(16) + l * 64; const float* w3 = PT(17) + l * 64 * 2048; const float* decay = PT(18) + l * 2048;
                float* feats = sf; float* h1 = sf + 16 * 33; float* h2 = h1 + 16 * 64;
                float nacc[4] = {0.f, 0.f, 0.f, 0.f};
                for (int base = bid; base < L; base += 16 * G) {
                    __syncthreads();
                    for (int e = tid; e < 16 * 33; e += NTHR) { const int ti = e / 33, fi = e % 33; int t = base + ti * G; if (t > L - 1) t = L - 1;
                        float v;
                        if (fi == 0) v = (float)t / (float)(L - 1);
                        else { const int j = (fi - 1) & 15; const double fr = 1e-4 + (double)j * ((15.0 - 1e-4) / 15.0); const double ang = (2.0 * 3.14159265358979323846 / (double)L) * (double)t * fr; v = fi <= 16 ? (float)cos(ang) : (float)(-sin(ang)); }
                        feats[e] = v; }
                    __syncthreads();
                    { const int j = tid & 63, ti = tid >> 6; float s0 = b1[j], s1 = s0;
_Pragma("unroll 3")
                      for (int i = 0; i < 33; ++i) { const float wv = w1[i * 64 + j]; s0 += feats[ti * 33 + i] * wv; s1 += feats[(ti + 8) * 33 + i] * wv; }
                      const float f1 = fr1[j]; h1[ti * 64 + j] = sinf(f1 * s0); h1[(ti + 8) * 64 + j] = sinf(f1 * s1); }
                    __syncthreads();
                    { const int j = tid & 63, ti = tid >> 6; float s0 = b2[j], s1 = s0;
_Pragma("unroll 4")
                      for (int i = 0; i < 64; ++i) { const float wv = w2[i * 64 + j]; s0 += h1[ti * 64 + i] * wv; s1 += h1[(ti + 8) * 64 + i] * wv; }
                      const float f2 = fr2[j]; h2[ti * 64 + j] = sinf(f2 * s0); h2[(ti + 8) * 64 + j] = sinf(f2 * s1); }
                    __syncthreads();
                    float acc[16][4];
#pragma unroll
                    for (int ti = 0; ti < 16; ++ti) { acc[ti][0] = 0.f; acc[ti][1] = 0.f; acc[ti][2] = 0.f; acc[ti][3] = 0.f; }
#pragma unroll 2
                    for (int i = 0; i < 64; ++i) { const float* wrow = w3 + (size_t)i * 2048 + tid; const float wa = wrow[0], wb = wrow[512], wc2 = wrow[1024], wd2 = wrow[1536];
#pragma unroll
                        for (int ti = 0; ti < 16; ++ti) { const float hv = h2[ti * 64 + i]; acc[ti][0] += hv * wa; acc[ti][1] += hv * wb; acc[ti][2] += hv * wc2; acc[ti][3] += hv * wd2; } }
                    float dk[4];
#pragma unroll
                    for (int k = 0; k < 4; ++k) dk[k] = fabsf(decay[tid + k * 512]);
#pragma unroll
                    for (int ti = 0; ti < 16; ++ti) { const int t = base + ti * G; if (t < L) { const float tn = (float)t / (float)(L - 1);
#pragma unroll
                        for (int k = 0; k < 4; ++k) { const float v = acc[ti][k] * expf(-tn * dk[k]); HR[(size_t)t * 2048 + tid + k * 512] = v; nacc[k] += fabsf(v); } } }
                }
                float* nrp = NORMP + ((size_t)(l * 2 + set) * 256 + bid) * 2048;
#pragma unroll
                for (int k = 0; k < 4; ++k) nrp[tid + k * 512] = nacc[k];
            }
            for (int idx = bid * NTHR + tid; idx < 4096; idx += G * NTHR) { const int n = idx & 63, g = (idx >> 6) & 31, dir = idx >> 11;
                const double are = (double)(PT(24) + l * 4096)[idx], aim = (double)(PT(25) + l * 4096)[idx]; const double lam = are < -1e-4 ? are : -1e-4; const double dt = exp((double)(PT(26) + l * 64)[dir * 32 + g]);
                const double ldre = lam * dt, ldim = aim * dt; LDT[idx] = make_double2(ldre, ldim);
                const double mag = exp(ldre); const double ar = mag * cos(ldim), ai = mag * sin(ldim);
                const double den = lam * lam + aim * aim; const double nr = ar - 1.0, ni = ai; const double fre = (nr * lam + ni * aim) / den, fim = (ni * lam - nr * aim) / den;
                const float* b_re = PT(27) + l * 32 * 64 * 16; const float* b_im = PT(28) + l * 32 * 64 * 16;
#pragma unroll 4
                for (int c = 0; c < 16; ++c) { const double br = (double)b_re[(g * 64 + n) * 16 + c], bi = (double)b_im[(g * 64 + n) * 16 + c]; BBT[idx * 16 + c] = make_float2((float)(fre * br - fim * bi), (float)(fre * bi + fim * br)); }
            }
            for (int e2 = bid * NTHR + tid; e2 < 4096 * 33; e2 += G * NTHR) { const int idx = e2 / 33, k = e2 - idx * 33; const int g = (idx >> 6) & 31, dir = idx >> 11;
                const double are = (double)(PT(24) + l * 4096)[idx], aim = (double)(PT(25) + l * 4096)[idx]; const double lam = are < -1e-4 ? are : -1e-4; const double dt = exp((double)(PT(26) + l * 64)[dir * 32 + g]);
                const double ldre = lam * dt, ldim = aim * dt; const double mk = exp(ldre * k); APW[e2] = make_float2((float)(mk * cos(ldim * k)), (float)(mk * sin(ldim * k))); }
            if (l == 0 && lo == 0) xcd_barrier(bar);
            for (int tok = bid * 8 + wave; tok < NTOK; tok += G * 8) {
                const int r = tok < NLAT ? tok / SEQ : 4; const float* xr = l == 0 ? (tok < NLAT ? x_in + (size_t)tok * DM : ctx_in + (size_t)(tok - NLAT) * DM) : XS + (size_t)tok * DM; const float* gn = norm_mix + l * DM;
                const float* sh = MODl + (size_t)(r * 6 + 0) * DM; const float* sc = MODl + (size_t)(r * 6 + 1) * DM;
                float4 v[8]; float ss = 0.f;
#pragma unroll
                for (int i = 0; i < 8; ++i) v[i] = *(const float4*)(xr + i * 256 + lane * 4);
                if (l > 0) {
                    moe_combine(v, tok, lane, INV, ROWGATE, YEXP, MOD + (size_t)((l - 1) * 5 + r) * 6 * DM + 5 * DM);
#pragma unroll
                    for (int i = 0; i < 8; ++i) *(float4*)(XS + (size_t)tok * DM + i * 256 + lane * 4) = v[i]; }
#pragma unroll
                for (int i = 0; i < 8; ++i) ss += v[i].x * v[i].x + v[i].y * v[i].y + v[i].z * v[i].z + v[i].w * v[i].w;
                ss = wave_sum(ss); const float rs = rsqrtf(ss * (1.0f / DM) + 1e-6f);
#pragma unroll
                for (int i = 0; i < 8; ++i) { const int d = i * 256 + lane * 4; const float4 g4 = *(const float4*)(gn + d), s4 = *(const float4*)(sc + d), h4 = *(const float4*)(sh + d);
                    v[i].x = v[i].x * rs * g4.x * (1.f + s4.x) + h4.x; v[i].y = v[i].y * rs * g4.y * (1.f + s4.y) + h4.y; v[i].z = v[i].z * rs * g4.z * (1.f + s4.z) + h4.z; v[i].w = v[i].w * rs * g4.w * (1.f + s4.w) + h4.w; }
#pragma unroll
                for (int i = 0; i < 8; ++i) { u32x2 w; w.x = pk2(v[i].x, v[i].y); w.y = pk2(v[i].z, v[i].w); *(u32x2*)(HB + (size_t)tok * DM + i * 256 + lane * 4) = w; }
            }
            SEAM(PB + 0);
        }

        if (IN(PB + 1)) for (int rep_ = 0; rep_ < PROBE_REPS(1); ++rep_) {
            PH_BEGIN
            for (int base = bid * 8; base < (lastl ? 1 : 2) * 1024; base += G * 8) {
                const int idx = base + (tid & 7), sl = tid >> 3; const int set = idx >> 10, oc = idx & 1023, o = oc >> 9, c = oc & 511;
                const float* pp = NORMP + (size_t)(l * 2 + set) * 256 * 2048 + o * 1024 + c + (size_t)(sl * 4) * 2048; float sacc = 0.f;
#pragma unroll
                for (int j = 0; j < 4; ++j) { const float p0 = pp[(size_t)j * 2048], p1 = pp[(size_t)j * 2048 + 512]; sacc += (sl * 4 + j < G) ? p0 + p1 : 0.f; }
                sf[sl * 8 + (tid & 7)] = sacc; __syncthreads();
                if (tid < 8) { float t = 0.f;
#pragma unroll 8
                    for (int q = 0; q < 64; ++q) t += sf[q * 8 + tid];
                    NORM[(size_t)(l * 2 + set) * 1024 + oc] = t; }
                __syncthreads(); }
            for (int idx = (G - 1 - bid) * NTHR + tid; idx < 32768; idx += G * NTHR) { const int c = idx & 15, lag = (idx >> 4) & 31, dir = (idx >> 9) & 1, g = idx >> 10;
                const float* c_re = PT(29) + l * 32 * 16 * 64 + (g * 16 + c) * 64; const float* c_im = PT(30) + l * 32 * 16 * 64 + (g * 16 + c) * 64;
                float acc[16];
#pragma unroll
                for (int j = 0; j < 16; ++j) acc[j] = 0.f;
#pragma unroll 2
                for (int n = 0; n < 64; ++n) { const int pi = (dir * 32 + g) * 64 + n; const float2 ap = APW[pi * 33 + lag]; const float cr = c_re[n], ci = c_im[n]; const float wr_ = cr * ap.x - ci * ap.y, wi_ = cr * ap.y + ci * ap.x;
                    const float4* bb = (const float4*)(BBT + pi * 16);
#pragma unroll
                    for (int j = 0; j < 8; ++j) { const float4 b2 = bb[j]; acc[2 * j] += wr_ * b2.x - wi_ * b2.y; acc[2 * j + 1] += wr_ * b2.z - wi_ * b2.w; } }
                float4* o = (float4*)(KTB + (size_t)idx * 16);
                o[0] = make_float4(acc[0], acc[1], acc[2], acc[3]); o[1] = make_float4(acc[4], acc[5], acc[6], acc[7]); o[2] = make_float4(acc[8], acc[9], acc[10], acc[11]); o[3] = make_float4(acc[12], acc[13], acc[14], acc[15]);
            }
            __syncthreads();
            pg8::Gemm g{HB, WIN, DM, DM, DM}; pg8::SchedStd S{68, 55, G, bid, DM, DM}; pg8::EpiWin E{P, LDP};
            pg8::gemm_phase(( LAS unsigned char*)shm, g, S, E);
#if defined(PROBE_BNOEPI)
            { __syncthreads(); pg8::EpiNone E0; pg8::gemm_phase((LAS unsigned char*)shm, g, S, E0); }
#endif
            SEAM(PB + 1);
        }

        if (IN(PB + 2)) for (int rep_ = 0; rep_ < PROBE_REPS(2); ++rep_) {
            PH_BEGIN
            const float* hcw = PT(9) + l * 3 * 1536; const float* hcb = PT(10) + l * 1536; const float* mcw = PT(20) + l * 3 * 1024; const float* mcb = PT(21) + l * 1024;
            const float* scw = PT(34) + l * 3 * 1024; const float* scb = PT(35) + l * 1024;
            for (int unit = bid; unit < 272 * 3; unit += G) { const int seg = unit / 3, kind = unit % 3; const bool lat = seg < 256; const size_t tok0 = lat ? (size_t)seg * 64 : (size_t)NLAT + (size_t)(seg - 256) * 64;
                if (kind < 2) { const int hf = kind;
                    const int c = tid * 2; const int col = (hf ? SSD_OFF + 512 : ML_OFF) + c; const float* w = hf ? scw : mcw; const float* bsp = hf ? scb : mcb; bf16_t* dst = (hf ? XBC : QKB) + tok0 * 1024 + c;
                    const float2 w0 = *(const float2*)(w + c), w1 = *(const float2*)(w + 1024 + c), w2 = *(const float2*)(w + 2048 + c), bb = *(const float2*)(bsp + c);
                    const float osc = (!hf && c >= 512) ? 0.08838834764831845f : 1.0f;
                    const bool hasPrev = !lat && ((tok0 - NLAT) & (CTXL - 1)) != 0, hasNext = !lat && (((tok0 - NLAT) + 63) & (CTXL - 1)) != CTXL - 1;
                    bf16_t* strip = nullptr;
                    if (!hf) { if (c >= 512) strip = KTG + ((size_t)seg * 512 + (c - 512)) * 64; }
                    else { if (c < 512) strip = XTG + ((size_t)seg * 512 + c) * 64; else if (c < 768) strip = BTG + ((size_t)seg * 256 + (c - 512)) * 64; }
                    const bf16_t* pp = P + tok0 * LDP + col;
                    unsigned raw[66];
#pragma unroll
                    for (int t = 0; t < 66; ++t) raw[t] = ((t == 0 && !hasPrev) || (t == 65 && !hasNext)) ? 0u : *(const unsigned*)(pp + (ptrdiff_t)(t - 1) * LDP);
#pragma unroll
                    for (int t8 = 0; t8 < 8; ++t8) { float v0[8], v1[8];
#pragma unroll
                        for (int tt = 0; tt < 8; ++tt) { const int t = t8 * 8 + tt; const unsigned p0 = raw[t], p1 = raw[t + 1], p2 = raw[t + 2];
                            float a0 = bb.x + w0.x * __uint_as_float(p0 << 16) + w1.x * __uint_as_float(p1 << 16) + w2.x * __uint_as_float(p2 << 16);
                            float a1 = bb.y + w0.y * __uint_as_float(p0 & 0xFFFF0000u) + w1.y * __uint_as_float(p1 & 0xFFFF0000u) + w2.y * __uint_as_float(p2 & 0xFFFF0000u);
                            a0 = siluf_(a0) * osc; a1 = siluf_(a1) * osc; v0[tt] = a0; v1[tt] = a1;
                            *(unsigned*)(dst + (size_t)t * 1024) = pk2(a0, a1); }
                        if (strip) { u32x4 s0, s1; s0.x = pk2(v0[0], v0[1]); s0.y = pk2(v0[2], v0[3]); s0.z = pk2(v0[4], v0[5]); s0.w = pk2(v0[6], v0[7]); s1.x = pk2(v1[0], v1[1]); s1.y = pk2(v1[2], v1[3]); s1.z = pk2(v1[4], v1[5]); s1.w = pk2(v1[6], v1[7]);
                            *(u32x4*)(strip + t8 * 8) = s0; *(u32x4*)(strip + 64 + t8 * 8) = s1; } }
                } else {
                    const int c = (tid & 255) * 2, th = tid >> 8; const bf16_t* pp = P + (tok0 + th * 32) * LDP + ML_OFF + 1024 + c; bf16_t* strip = VTG + ((size_t)seg * 512 + c) * 64 + th * 32;
                    unsigned rv[32];
#pragma unroll
                    for (int t = 0; t < 32; ++t) rv[t] = *(const unsigned*)(pp + (size_t)t * LDP);
#pragma unroll
                    for (int t8 = 0; t8 < 4; ++t8) { u32x4 s0, s1;
                        s0.x = (rv[t8 * 8 + 0] & 0xFFFFu) | (rv[t8 * 8 + 1] << 16); s0.y = (rv[t8 * 8 + 2] & 0xFFFFu) | (rv[t8 * 8 + 3] << 16); s0.z = (rv[t8 * 8 + 4] & 0xFFFFu) | (rv[t8 * 8 + 5] << 16); s0.w = (rv[t8 * 8 + 6] & 0xFFFFu) | (rv[t8 * 8 + 7] << 16);
                        s1.x = (rv[t8 * 8 + 0] >> 16) | (rv[t8 * 8 + 1] & 0xFFFF0000u); s1.y = (rv[t8 * 8 + 2] >> 16) | (rv[t8 * 8 + 3] & 0xFFFF0000u); s1.z = (rv[t8 * 8 + 4] >> 16) | (rv[t8 * 8 + 5] & 0xFFFF0000u); s1.w = (rv[t8 * 8 + 6] >> 16) | (rv[t8 * 8 + 7] & 0xFFFF0000u);
                        *(u32x4*)(strip + t8 * 8) = s0; *(u32x4*)(strip + 64 + t8 * 8) = s1; }
                }
            }
            if (!lastl) for (int tok = NLAT + bid; tok < NTOK; tok += G) {
                const int t = (tok - NLAT) & (CTXL - 1); const bool hasL = (t != 0), hasR = (t != CTXL - 1); const bf16_t* pr = P + (size_t)tok * LDP;
                const bf16_t* prL = hasL ? pr - LDP : pr; const bf16_t* prR = hasR ? pr + LDP : pr;
                unsigned xc[3], xl[3], xr[3];
#pragma unroll
                for (int j = 0; j < 3; ++j) { const int cc = tid + j * 512; xc[j] = pr[HY_OFF + cc]; xl[j] = prL[HY_OFF + cc]; xr[j] = prR[HY_OFF + cc]; }
#pragma unroll
                for (int j = 0; j < 3; ++j) { const int cc = tid + j * 512;
                    float acc = hcb[cc] + hcw[1536 + cc] * __uint_as_float(xc[j] << 16);
                    acc += hasL ? hcw[cc] * __uint_as_float(xl[j] << 16) : 0.f;
                    acc += hasR ? hcw[2 * 1536 + cc] * __uint_as_float(xr[j] << 16) : 0.f;
                    U[(size_t)tok * 1536 + cc] = acc; }
            }
            for (int idx0 = bid * NTHR + tid; idx0 < 16384 * 64; idx0 += 4 * G * NTHR) { u32x4 t4[4];
#pragma unroll
                for (int q = 0; q < 4; ++q) { const int idx = idx0 + q * G * NTHR; const int half = idx & 1, g = (idx >> 1) & 31, tok = idx >> 6;
                    if (idx < 16384 * 64) t4[q] = *(const u32x4*)(P + (size_t)tok * LDP + S5_OFF + g * 16 + half * 8); }
#pragma unroll
                for (int q = 0; q < 4; ++q) { const int idx = idx0 + q * G * NTHR; const int half = idx & 1, g = (idx >> 1) & 31, tok = idx >> 6;
                    if (idx < 16384 * 64) *(u32x4*)(S5A + ((size_t)g * 512 + (tok >> 5)) * 768 + (tok & 31) * 16 + half * 8) = t4[q]; } }
            for (int idx = bid * NTHR + tid; idx < 32 * 512 * 32 * 2; idx += G * NTHR) { const int half = idx & 1, sI = (idx >> 1) & 31, row = (idx >> 6) & 511, g = idx >> 15; const int t = row >> 4, c = row & 15; const int lag = t - sI;
                float v[8];
                if (lag > 0) { const float4* k4 = (const float4*)(KTB + ((size_t)((g * 2 + 0) * 32 + lag) * 16 + c) * 16 + half * 8); const float4 a0 = k4[0], a1 = k4[1]; v[0] = a0.x; v[1] = a0.y; v[2] = a0.z; v[3] = a0.w; v[4] = a1.x; v[5] = a1.y; v[6] = a1.z; v[7] = a1.w; }
                else if (lag < 0) { const float4* k4 = (const float4*)(KTB + ((size_t)((g * 2 + 1) * 32 - lag) * 16 + c) * 16 + half * 8); const float4 a0 = k4[0], a1 = k4[1]; v[0] = a0.x; v[1] = a0.y; v[2] = a0.z; v[3] = a0.w; v[4] = a1.x; v[5] = a1.y; v[6] = a1.z; v[7] = a1.w; }
                else { const float4* k4 = (const float4*)(KTB + ((size_t)((g * 2 + 0) * 32) * 16 + c) * 16 + half * 8); const float4* q4 = (const float4*)(KTB + ((size_t)((g * 2 + 1) * 32) * 16 + c) * 16 + half * 8); const float4 a0 = k4[0], a1 = k4[1], b0 = q4[0], b1 = q4[1];
                    v[0] = a0.x + b0.x; v[1] = a0.y + b0.y; v[2] = a0.z + b0.z; v[3] = a0.w + b0.w; v[4] = a1.x + b1.x; v[5] = a1.y + b1.y; v[6] = a1.z + b1.z; v[7] = a1.w + b1.w; }
                u32x4 w; w.x = pk2(v[0], v[1]); w.y = pk2(v[2], v[3]); w.z = pk2(v[4], v[5]); w.w = pk2(v[6], v[7]);
                *(u32x4*)(S5B + ((size_t)g * 512 + row) * 768 + sI * 16 + half * 8) = w; }
            for (int idx = bid * NTHR + tid; idx < 32 * 512 * 64; idx += G * NTHR) { const int n = idx & 63, row = (idx >> 6) & 511, g = idx >> 15; const int t = row >> 4, c = row & 15;
                const float cr = (PT(29) + l * 32 * 16 * 64)[(g * 16 + c) * 64 + n], ci = (PT(30) + l * 32 * 16 * 64)[(g * 16 + c) * 64 + n];
                const float2 af = APW[((0 * 32 + g) * 64 + n) * 33 + t + 1], ab = APW[((1 * 32 + g) * 64 + n) * 33 + 32 - t];
                bf16_t* d = S5B + ((size_t)g * 512 + row) * 768 + 512 + 2 * n;
                *(unsigned*)d = pk2(cr * af.x - ci * af.y, -(cr * af.y + ci * af.x)); *(unsigned*)(d + 128) = pk2(cr * ab.x - ci * ab.y, -(cr * ab.y + ci * ab.x)); }
            for (int idx = bid * NTHR + tid; idx < 32 * 2 * 64 * 32; idx += G * NTHR) { const int sI = idx & 31, n = (idx >> 5) & 63, dir = (idx >> 11) & 1, g = idx >> 12; const int pi = (dir * 32 + g) * 64 + n;
                const float2 pw = APW[pi * 33 + (dir ? sI : 31 - sI)]; const float4* bb = (const float4*)(BBT + pi * 16);
                float re[16], im[16];
#pragma unroll
                for (int j = 0; j < 8; ++j) { const float4 b2 = bb[j]; re[2 * j] = pw.x * b2.x - pw.y * b2.y; im[2 * j] = pw.x * b2.y + pw.y * b2.x; re[2 * j + 1] = pw.x * b2.z - pw.y * b2.w; im[2 * j + 1] = pw.x * b2.w + pw.y * b2.z; }
                bf16_t* d = S5P + ((size_t)g * 256 + dir * 128 + 2 * n) * 512 + sI * 16;
                u32x4 w0, w1; w0.x = pk2(re[0], re[1]); w0.y = pk2(re[2], re[3]); w0.z = pk2(re[4], re[5]); w0.w = pk2(re[6], re[7]); w1.x = pk2(re[8], re[9]); w1.y = pk2(re[10], re[11]); w1.z = pk2(re[12], re[13]); w1.w = pk2(re[14], re[15]);
                *(u32x4*)d = w0; *(u32x4*)(d + 8) = w1;
                w0.x = pk2(im[0], im[1]); w0.y = pk2(im[2], im[3]); w0.z = pk2(im[4], im[5]); w0.w = pk2(im[6], im[7]); w1.x = pk2(im[8], im[9]); w1.y = pk2(im[10], im[11]); w1.z = pk2(im[12], im[13]); w1.w = pk2(im[14], im[15]);
                *(u32x4*)(d + 512) = w0; *(u32x4*)(d + 520) = w1; }
            {   float* T0 = sf; float* T1 = sf + 64 * 65;
                const int NU = 4 * 64 * 24; const int cL = tid & 63, tL = tid >> 6, c = tid >> 3, tq = (tid & 7) * 8;
                for (int unit = bid; unit < NU; unit += 2 * G) { const bool has2 = unit + G < NU; const int unit2 = has2 ? unit + G : unit;
                    const int ba = unit / (64 * 24), ra = (unit / 24) % 64, c0a = (unit % 24) * 64; const size_t toka = (size_t)ba * SEQ + ra * 64;
                    const int bb_ = unit2 / (64 * 24), rb = (unit2 / 24) % 64, c0b = (unit2 % 24) * 64; const size_t tokb = (size_t)bb_ * SEQ + rb * 64;
                    unsigned pa[8], pb[8];
#pragma unroll
                    for (int i = 0; i < 8; ++i) { pa[i] = P[(toka + tL + 8 * i) * LDP + HY_OFF + c0a + cL]; pb[i] = P[(tokb + tL + 8 * i) * LDP + HY_OFF + c0b + cL]; }
                    const int cca = c0a + c, ccb = c0b + c;
                    const float w0a = hcw[cca], w1a = hcw[1536 + cca], w2a = hcw[3072 + cca], bia = hcb[cca], w0b = hcw[ccb], w1b = hcw[1536 + ccb], w2b = hcw[3072 + ccb], bib = hcb[ccb];
                    __syncthreads();
#pragma unroll
                    for (int i = 0; i < 8; ++i) { T0[(tL + 8 * i) * 65 + cL] = __uint_as_float(pa[i] << 16); T1[(tL + 8 * i) * 65 + cL] = __uint_as_float(pb[i] << 16); }
                    __syncthreads();
                    {   float o8[8];
#pragma unroll
                        for (int i = 0; i < 8; ++i) { const int t = tq + i; float acc = bia + w1a * T0[t * 65 + c]; if (t > 0) acc += w0a * T0[(t - 1) * 65 + c]; if (t < 63) acc += w2a * T0[(t + 1) * 65 + c]; o8[i] = acc; }
                        u32x4 wv; wv.x = pk2(o8[0], o8[1]); wv.y = pk2(o8[2], o8[3]); wv.z = pk2(o8[4], o8[5]); wv.w = pk2(o8[6], o8[7]);
                        *(u32x4*)(UT + ((size_t)ba * 1536 + cca) * SEQ + ra * 64 + tq) = wv; }
                    if (has2) { float o8[8];
#pragma unroll
                        for (int i = 0; i < 8; ++i) { const int t = tq + i; float acc = bib + w1b * T1[t * 65 + c]; if (t > 0) acc += w0b * T1[(t - 1) * 65 + c]; if (t < 63) acc += w2b * T1[(t + 1) * 65 + c]; o8[i] = acc; }
                        u32x4 wv; wv.x = pk2(o8[0], o8[1]); wv.y = pk2(o8[2], o8[3]); wv.z = pk2(o8[4], o8[5]); wv.w = pk2(o8[6], o8[7]);
                        *(u32x4*)(UT + ((size_t)bb_ * 1536 + ccb) * SEQ + rb * 64 + tq) = wv; }
                } }
            if (!lastl) {
                const int L = CTXL; const float* HR = HRAW + (size_t)SEQ * 2048; float* K2 = K2C; const float* nrm = NORM + (size_t)(l * 2 + 1) * 1024;
                const size_t total = (size_t)(2 * L - 1) * 1024;
                for (size_t i = (size_t)bid * NTHR + tid; i < total; i += (size_t)G * NTHR) { const int j = (int)(i >> 10), oc = (int)(i & 1023), o = oc >> 9, c = oc & 511; const int lag = j - (L - 1);
                    const float v = lag >= 0 ? HR[(size_t)lag * 2048 + o * 1024 + c] : HR[(size_t)(-lag) * 2048 + o * 1024 + 512 + c];
                    K2[((size_t)j * 2 + o) * 512 + c] = v / nrm[oc]; }
            }
            {   __syncthreads(); fft_twiddles((float2*)(shm + FFT_X_BYTES), tid);
                for (int pr = bid; pr < 512; pr += G) hyena_spec_item(pr, HRAW, NORM + (size_t)(l * 2 + 0) * 1024, HSPEC, shm, tid);
                __syncthreads(); }
            SEAM(PB + 2);
        }

        if (IN(PB + 3)) for (int rep_ = 0; rep_ < PROBE_REPS(3); ++rep_) {
            PH_BEGIN
            if (rep_ > 0) { if (bid == 0 && tid == 0) __hip_atomic_store(QCTR + l * 64, 0, __ATOMIC_RELAXED, __HIP_MEMORY_SCOPE_AGENT); xcd_barrier(bar); }
            if (bid < 64) {
                mlstm_state_pass(bid >> 1, bid & 1, P, KTG, VTG, PT(22) + l * 16, CST, NST, MST, shm, tid);
            } else if (bid < 128) {
                { const int ch = bid - 64; const int dir_ = ch & 1, h_ = (ch >> 1) & 7; ssd_state_pass(ch, P, BTG, XTG, -expf(PT(37)[l * 16 + dir_ * 8 + h_]), PT(36)[l * 16 + dir_ * 8 + h_], SSTB, shm, tid); }
            } else if (bid < 160) {
                const int widx = (bid - 128) * 8 + wave; const int dir = widx & 1, g = (widx >> 1) & 31, b = widx >> 6; const int n = lane;
                float2* xb = (float2*)(shm + (size_t)wave * 16640); float2* ctab = xb + 16 * 65;
                const float* a_re = PT(24) + l * 2 * 32 * 64; const float* a_im = PT(25) + l * 2 * 32 * 64; const float* log_dt = PT(26) + l * 64;
                const float* b_re = PT(27) + l * 32 * 64 * 16; const float* b_im = PT(28) + l * 32 * 64 * 16; const float* c_re = PT(29) + l * 32 * 16 * 64; const float* c_im = PT(30) + l * 32 * 16 * 64;
#pragma unroll
                for (int c = 0; c < 16; ++c) ctab[c * 65 + lane] = make_float2(c_re[(g * 16 + c) * 64 + lane], c_im[(g * 16 + c) * 64 + lane]);
                float abr, abi, bbr[16], bbi[16];
                {   const double are = (double)a_re[(dir * 32 + g) * 64 + n], aim = (double)a_im[(dir * 32 + g) * 64 + n];
                    const double lam = are < -1e-4 ? are : -1e-4; const double dt = exp((double)log_dt[dir * 32 + g]);
                    const double mag = exp(lam * dt); const double ar = mag * cos(aim * dt), ai = mag * sin(aim * dt);
                    const double den = lam * lam + aim * aim; const double nr = ar - 1.0, ni = ai;
                    const double fre = (nr * lam + ni * aim) / den, fim = (ni * lam - nr * aim) / den;
                    abr = (float)ar; abi = (float)ai;
#pragma unroll
                    for (int c = 0; c < 16; ++c) { const double br = (double)b_re[(g * 64 + n) * 16 + c], bi = (double)b_im[(g * 64 + n) * 16 + c]; bbr[c] = (float)(fre * br - fim * bi); bbi[c] = (float)(fre * bi + fim * br); }
                }
                float xr = 0.f, xi = 0.f; float* Sout = (dir ? SB : SF) - (size_t)NLAT * BW;
                const int s = lane >> 2, cg = lane & 3;
                for (int i0 = 0; i0 < CTXL; i0 += 16) {
#pragma unroll 4
                    for (int ss = 0; ss < 16; ++ss) {
                        const size_t tok = (size_t)step_tok(b, dir, i0 + ss);
                        const u32x4* up = (const u32x4*)(P + tok * LDP + S5_OFF + g * 16);
                        float t0[8], t1[8]; unpack8(up[0], t0); unpack8(up[1], t1);
                        float bur = 0.f, bui = 0.f;
#pragma unroll
                        for (int c = 0; c < 8; ++c) { bur += t0[c] * bbr[c] + t1[c] * bbr[8 + c]; bui += t0[c] * bbi[c] + t1[c] * bbi[8 + c]; }
                        const float nxr = abr * xr - abi * xi + bur, nxi = abr * xi + abi * xr + bui; xr = nxr; xi = nxi;
                        xb[ss * 65 + lane] = make_float2(xr, xi);
                    }
                    asm volatile("s_waitcnt lgkmcnt(0)" ::: "memory");
                    float y0 = 0.f, y1 = 0.f, y2 = 0.f, y3 = 0.f;
                    for (int nn2 = 0; nn2 < 64; ++nn2) { const float2 xv = xb[s * 65 + nn2];
                        const float2 c0 = ctab[(cg * 4 + 0) * 65 + nn2], c1 = ctab[(cg * 4 + 1) * 65 + nn2], c2 = ctab[(cg * 4 + 2) * 65 + nn2], c3 = ctab[(cg * 4 + 3) * 65 + nn2];
                        y0 += xv.x * c0.x - xv.y * c0.y; y1 += xv.x * c1.x - xv.y * c1.y; y2 += xv.x * c2.x - xv.y * c2.y; y3 += xv.x * c3.x - xv.y * c3.y; }
                    const size_t toks = (size_t)step_tok(b, dir, i0 + s);
                    *(float4*)(Sout + toks * BW + g * 16 + cg * 4) = make_float4(y0, y1, y2, y3);
                    asm volatile("s_waitcnt lgkmcnt(0)" ::: "memory");
                }
                XCTX[((b * 32 + g) * 2 + dir) * 64 + n] = make_float2(xr, xi);
            } else {
                if (bid < 224) {
                    pg8::Gemm gg_{S5A, S5P, 768, 512, 512}; pg8::SchedS5a S_{bid - 160}; pg8::EpiXloc E_{XLOC};
                    pg8::gemm_phase((LAS unsigned char*)shm, gg_, S_, E_);
                    __syncthreads();
                }
                const int nhb = G - 160, hb = bid - 160; const float* bias = PT(19) + l * 1024; const int c = tid;
                const int nitems = lastl ? 0 : 4 * (CTXL / 8);
                for (int it = hb; it < nitems; it += nhb) {
                    int L, tokbase, b, t0; const float* K2;
                    { const int q = it; L = CTXL; tokbase = NLAT; b = q / (CTXL / 8); t0 = (q % (CTXL / 8)) * 8; K2 = K2C; }
                    const float* zb = U + (size_t)(tokbase + b * L) * 1536 + c;
                    float acc[8];
#pragma unroll
                    for (int i = 0; i < 8; ++i) acc[i] = 0.f;
                    const int base = t0 + L - 1;
                    for (int s = 0; s < L; s += 8) {
                        float k[15];
#pragma unroll
                        for (int mm = 0; mm < 15; ++mm) k[mm] = K2[((size_t)(base - s - 7 + mm) * 2 + 0) * 512 + c];
#pragma unroll
                        for (int ds = 0; ds < 8; ++ds) { const float z = zb[(size_t)(s + ds) * 1536];
#pragma unroll
                            for (int i = 0; i < 8; ++i) acc[i] += k[i - ds + 7] * z; }
                    }
#pragma unroll
                    for (int i = 0; i < 8; ++i) { const size_t tok = (size_t)(tokbase + b * L + t0 + i); const float zt = U[tok * 1536 + c]; Z[tok * BW + c] = (acc[i] + bias[c] * zt) * U[tok * 1536 + 512 + c]; }
                }
            }
            {   __syncthreads(); fft_twiddles((float2*)(shm + FFT_X_BYTES), tid);
                int* qslot = (int*)(shm + FFT_X_BYTES + 65536);
                for (;;) { __syncthreads(); if (tid == 0) *qslot = atomicAdd(QCTR + l * 64, 1); __syncthreads(); const int it = *qslot; if (it >= 1024) break;
                    hyena_fft_item(it, UT, HSPEC, PT(19) + l * 1024, YT, shm, tid); }
            }
            SEAM(PB + 3);
        }

        if (IN(PB + 4)) for (int rep_ = 0; rep_ < PROBE_REPS(4); ++rep_) {
            PH_BEGIN
            if (rep_ > 0) { if (bid == 0 && tid == 0) __hip_atomic_store(QCTR + l * 64 + 32, 0, __ATOMIC_RELAXED, __HIP_MEMORY_SCOPE_AGENT); xcd_barrier(bar); }
            if (bid >= G - 32) for (int idx = (bid - (G - 32)) * NTHR + tid; idx < 16384; idx += 32 * NTHR) { const int n = idx & 63, dir = (idx >> 6) & 1, b = (idx >> 7) & 3, g = idx >> 9;
                const float2 a32 = APW[((dir * 32 + g) * 64 + n) * 33 + 32]; float2 X = XCTX[((b * 32 + g) * 2 + dir) * 64 + n];
                const float* __restrict__ xl = XLOC + ((size_t)g * 512 + b * 128) * 256 + dir * 128 + 2 * n; bf16_t* __restrict__ dst = S5A + ((size_t)g * 512 + b * 128) * 768 + 512 + dir * 128 + 2 * n;
#pragma unroll 1
                for (int j0 = 0; j0 < 128; j0 += 16) { float2 xv[16];
#pragma unroll
                    for (int q = 0; q < 16; ++q) { const int j = dir ? 127 - (j0 + q) : j0 + q; xv[q] = *(const float2*)(xl + (size_t)j * 256); }
#pragma unroll
                    for (int q = 0; q < 16; ++q) { const int j = dir ? 127 - (j0 + q) : j0 + q;
                        *(unsigned*)(dst + (size_t)j * 768) = pk2(X.x, X.y);
                        const float nx = a32.x * X.x - a32.y * X.y + xv[q].x, ny = a32.x * X.y + a32.y * X.x + xv[q].y; X.x = nx; X.y = ny; } } }
            {   int* qslot = (int*)(shm + 102400);
                __syncthreads(); if (tid == 0) *qslot = atomicAdd(QCTR + l * 64 + 32, 1); __syncthreads();
                for (;;) { const int it = *qslot; if (it >= 32 * 68 + 64 * 68) break;
                    int nxt_ = 0; if (tid == 0) nxt_ = atomicAdd(QCTR + l * 64 + 32, 1);
                    if (it < 32 * 68) { const int chain = it / 68, c = it % 68; mlstm_out_item(chain, c, P, QKB, VTG, PT(22) + l * 16, CST, NST, MST, (chain & 1) ? HBk : HF, shm, tid); }
                    else { const int i2 = it - 32 * 68; const int chain = i2 / 68, c = i2 % 68; const int dir_ = chain & 1, h_ = (chain >> 1) & 7;
                        ssd_out_item(chain, c, P, XBC, XTG, -expf(PT(37)[l * 16 + dir_ * 8 + h_]), PT(36)[l * 16 + dir_ * 8 + h_], SSTB, dir_ ? YB : YF, shm, tid); }
                    __syncthreads(); if (tid == 0) *qslot = nxt_; __syncthreads(); }
            }
            __syncthreads();
            {   const float* bias = PT(19) + l * 1024 + 512; const int c = tid;
                const int nitems = lastl ? 0 : 4 * (CTXL / 8);
                for (int it = bid; it < nitems; it += G) {
                    int L, tokbase, b, t0; const float* K2;
                    { const int q = it; L = CTXL; tokbase = NLAT; b = q / (CTXL / 8); t0 = (q % (CTXL / 8)) * 8; K2 = K2C; }
                    const float* zb = Z + (size_t)(tokbase + b * L) * BW + c;
                    float acc[8];
#pragma unroll
                    for (int i = 0; i < 8; ++i) acc[i] = 0.f;
                    const int base = t0 + L - 1;
                    for (int s = 0; s < L; s += 8) {
                        float k[15];
#pragma unroll
                        for (int mm = 0; mm < 15; ++mm) k[mm] = K2[((size_t)(base - s - 7 + mm) * 2 + 1) * 512 + c];
#pragma unroll
                        for (int ds = 0; ds < 8; ++ds) { const float z = zb[(size_t)(s + ds) * BW];
#pragma unroll
                            for (int i = 0; i < 8; ++i) acc[i] += k[i - ds + 7] * z; }
                    }
#pragma unroll
                    for (int i = 0; i < 8; ++i) { const size_t tok = (size_t)(tokbase + b * L + t0 + i); const float zt = Z[tok * BW + c]; Y4[tok * DM + c] = f2bf((acc[i] + bias[c] * zt) * U[tok * 1536 + 1024 + c]); }
                }
            }
            SEAM(PB + 4);
        }

        if (IN(PB + 5)) for (int rep_ = 0; rep_ < PROBE_REPS(5); ++rep_) {
            PH_BEGIN
            const float* ml_norm = PT(23) + l * BW; const float* ssd_d = PT(38) + l * 8; const float* ssd_norm = PT(39) + l * BW; const float* s5_d = PT(31) + l * BW;
            if (bid < 128) {
                pg8::Gemm gg_{S5A, S5B, 768, 768, 768}; pg8::SchedS5b S_{bid}; pg8::EpiS5Out E_{P, s5_d, GG};
                pg8::gemm_phase((LAS unsigned char*)shm, gg_, S_, E_);
                __syncthreads();
            }
            for (int tok = bid * 8 + wave; tok < NTOK; tok += G * 8) {
                const int c0 = lane * 8; const bf16_t* pr = P + (size_t)tok * LDP; const size_t o5 = (size_t)tok * BW + c0;
                float hm[8], ys[8];
                const u32x4 ooq = *(const u32x4*)(pr + ML_OFF + 1536 + c0);
                const float4 g0 = *(const float4*)(ml_norm + c0), g1 = *(const float4*)(ml_norm + c0 + 4), n0 = *(const float4*)(ssd_norm + c0), n1 = *(const float4*)(ssd_norm + c0 + 4);
                { float fa[8], fb[8]; unpack8(*(const u32x4*)(HF + o5), fa); unpack8(*(const u32x4*)(HBk + o5), fb);
#pragma unroll
                  for (int j = 0; j < 8; ++j) hm[j] = fa[j] + fb[j]; }
                { float ya[8], yb[8]; unpack8(*(const u32x4*)(YF + o5), ya); unpack8(*(const u32x4*)(YB + o5), yb);
                  float xx[8], zz[8]; unpack8(*(const u32x4*)(XBC + (size_t)tok * 1024 + c0), xx); unpack8(*(const u32x4*)(pr + SSD_OFF + c0), zz); const float dsk = ssd_d[c0 >> 6];
#pragma unroll
                  for (int j = 0; j < 8; ++j) ys[j] = ya[j] + yb[j];
#pragma unroll
                  for (int j = 0; j < 8; ++j) ys[j] = (ys[j] + dsk * xx[j]) * siluf_(zz[j]); }
                float s1 = 0.f, s2 = 0.f;
#pragma unroll
                for (int j = 0; j < 8; ++j) { s1 += hm[j] * hm[j]; s2 += ys[j] * ys[j]; }
                s1 += __shfl_xor(s1, 1); s1 += __shfl_xor(s1, 2); s1 += __shfl_xor(s1, 4); s1 += __shfl_xor(s1, 8);
                s2 = wave_sum(s2);
                const float r1 = rsqrtf(s1 * (1.0f / 128.0f) + 1e-6f), r2 = rsqrtf(s2 * (1.0f / BW) + 1e-6f);
                float oo[8]; unpack8(ooq, oo);
                const float gm[8] = {g0.x, g0.y, g0.z, g0.w, g1.x, g1.y, g1.z, g1.w}, gs[8] = {n0.x, n0.y, n0.z, n0.w, n1.x, n1.y, n1.z, n1.w};
                u32x4 w;
                w.x = pk2(hm[0] * r1 * gm[0] * sigmoidf_(oo[0]), hm[1] * r1 * gm[1] * sigmoidf_(oo[1])); w.y = pk2(hm[2] * r1 * gm[2] * sigmoidf_(oo[2]), hm[3] * r1 * gm[3] * sigmoidf_(oo[3]));
                w.z = pk2(hm[4] * r1 * gm[4] * sigmoidf_(oo[4]), hm[5] * r1 * gm[5] * sigmoidf_(oo[5])); w.w = pk2(hm[6] * r1 * gm[6] * sigmoidf_(oo[6]), hm[7] * r1 * gm[7] * sigmoidf_(oo[7]));
                *(u32x4*)(Y4 + (size_t)tok * DM + 512 + c0) = w;
                w.x = pk2(ys[0] * r2 * gs[0], ys[1] * r2 * gs[1]); w.y = pk2(ys[2] * r2 * gs[2], ys[3] * r2 * gs[3]); w.z = pk2(ys[4] * r2 * gs[4], ys[5] * r2 * gs[5]); w.w = pk2(ys[6] * r2 * gs[6], ys[7] * r2 * gs[7]);
                *(u32x4*)(Y4 + (size_t)tok * DM + 1536 + c0) = w;
                if (tok >= NLAT) { const size_t oc = (size_t)(tok - NLAT) * BW + c0; float uu[8]; unpack8(*(const u32x4*)(pr + S5_OFF + c0), uu);
                    const float4 a0 = *(const float4*)(SF + oc), a1 = *(const float4*)(SF + oc + 4), b0 = *(const float4*)(SB + oc), b1 = *(const float4*)(SB + oc + 4), d0 = *(const float4*)(s5_d + c0), d1 = *(const float4*)(s5_d + c0 + 4);
                    float y[8] = {a0.x + b0.x + d0.x * uu[0], a0.y + b0.y + d0.y * uu[1], a0.z + b0.z + d0.z * uu[2], a0.w + b0.w + d0.w * uu[3], a1.x + b1.x + d1.x * uu[4], a1.y + b1.y + d1.y * uu[5], a1.z + b1.z + d1.z * uu[6], a1.w + b1.w + d1.w * uu[7]};
#pragma unroll
                    for (int j = 0; j < 8; ++j) y[j] = 0.5f * y[j] * (1.0f + tanhf(0.7978845608028654f * (y[j] + 0.044715f * y[j] * y[j] * y[j])));
                    w.x = pk2(y[0], y[1]); w.y = pk2(y[2], y[3]); w.z = pk2(y[4], y[5]); w.w = pk2(y[6], y[7]);
                    *(u32x4*)(GG + (size_t)tok * BW + c0) = w; }
            }
            __syncthreads();
            {   float* T = sf;
                for (int unit = (G > 128 ? bid - 128 : bid); unit >= 0 && unit < 4 * 64 * 8; unit += (G > 128 ? G - 128 : G)) { const int b = unit / 512, t0 = ((unit >> 3) & 63) * 64, c0 = (unit & 7) * 64;
                    __syncthreads();
#pragma unroll
                    for (int i = 0; i < 8; ++i) { const int t = tid & 63, c = (tid >> 6) + 8 * i; T[c * 65 + t] = __uint_as_float((unsigned)YT[((size_t)b * 512 + c0 + c) * SEQ + t0 + t] << 16); }
                    __syncthreads();
                    const int t = tid >> 3, cq = (tid & 7) * 8;
                    u32x4 w; w.x = pk2(T[(cq + 0) * 65 + t], T[(cq + 1) * 65 + t]); w.y = pk2(T[(cq + 2) * 65 + t], T[(cq + 3) * 65 + t]); w.z = pk2(T[(cq + 4) * 65 + t], T[(cq + 5) * 65 + t]); w.w = pk2(T[(cq + 6) * 65 + t], T[(cq + 7) * 65 + t]);
                    *(u32x4*)(Y4 + ((size_t)b * SEQ + t0 + t) * DM + c0 + cq) = w;
                } }
            SEAM(PB + 5);
        }

        if (IN(PB + 6)) for (int rep_ = 0; rep_ < PROBE_REPS(6); ++rep_) {
            PH_BEGIN
            pg8::Gemm g{GG, GLU, BW, BW, BW}; pg8::SchedStd S{68, 2, G, bid, BW, BW}; pg8::EpiGlu E{GG, PT(33) + l * BW, Y4};
            pg8::gemm_phase((LAS unsigned char*)shm, g, S, E);
            SEAM(PB + 6);
        }
        if (IN(PB + 7)) for (int rep_ = 0; rep_ < PROBE_REPS(7); ++rep_) {
            PH_BEGIN
            pg8::Gemm g{Y4, WBR, DM, BW, BW}; pg8::SchedBranch S{64, 8, G, bid}; pg8::EpiBranch E{P, ACCb};
            pg8::gemm_phase((LAS unsigned char*)shm, g, S, E);
            if (!lastl) { __syncthreads(); pg8::SchedTail S2{G, bid}; pg8::EpiPartK E2{(float*)HSPEC}; pg8::gemm_phase((LAS unsigned char*)shm, g, S2, E2); }
            SEAM(PB + 7);
        }
        if (IN(PB + 8)) for (int rep_ = 0; rep_ < PROBE_REPS(8); ++rep_) {
            PH_BEGIN
            if (!lastl) {
                const float* PART = (const float*)HSPEC;
                for (int idx = bid * NTHR + tid; idx < (NTOK - NLAT) * DM / 8; idx += G * NTHR) { const size_t o = (size_t)idx * 8; f32x4 p[4][2];
#pragma unroll
                    for (int k = 0; k < 4; ++k) { p[k][0] = *(const f32x4*)(PART + (size_t)k * (NTOK - NLAT) * DM + o); p[k][1] = *(const f32x4*)(PART + (size_t)k * (NTOK - NLAT) * DM + o + 4); }
                    f32x4 s0 = (f32x4){0.f, 0.f, 0.f, 0.f}, s1 = s0; const bf16_t* rp = P + (size_t)(NLAT + (o >> 11)) * LDP + GATE2 + (o & (DM - 1));
#pragma unroll
                    for (int k = 0; k < 4; ++k) { float rr[8]; unpack8(*(const u32x4*)(rp + k * DM), rr);
                        s0 = s0 + p[k][0]; s1 = s1 + p[k][1]; s0[0] *= rr[0]; s0[1] *= rr[1]; s0[2] *= rr[2]; s0[3] *= rr[3]; s1[0] *= rr[4]; s1[1] *= rr[5]; s1[2] *= rr[6]; s1[3] *= rr[7]; }
                    u32x4 w; w.x = pk2(s0[0], s0[1]); w.y = pk2(s0[2], s0[3]); w.z = pk2(s1[0], s1[1]); w.w = pk2(s1[2], s1[3]);
                    *(u32x4*)(ACCb + (size_t)NLAT * DM + o) = w; }
                xcd_barrier(bar);
            }
            pg8::Gemm g{ACCb, WOUT, DM, DM, DM}; pg8::SchedStd S{64, 8, G, bid, DM, DM}; pg8::EpiResid E{XS, l == 0 ? x_in : (const float*)XS, l == 0 ? ctx_in - (size_t)NLAT * DM : (const float*)XS, MODl, 2};
            pg8::gemm_phase((LAS unsigned char*)shm, g, S, E);
            if (!lastl) { __syncthreads(); pg8::Gemm g2{ACCb, WOUT, DM, DM, 512}; pg8::SchedTailK S2{G, bid}; pg8::EpiPartK E2{(float*)HSPEC + (size_t)4 * (NTOK - NLAT) * DM}; pg8::gemm_phase((LAS unsigned char*)shm, g2, S2, E2); }
            SEAM(PB + 8);
        }
        if (IN(PB + 9)) for (int rep_ = 0; rep_ < PROBE_REPS(9); ++rep_) {
            PH_BEGIN
            if (!lastl) {
                const float* PART = (const float*)HSPEC + (size_t)4 * (NTOK - NLAT) * DM; const float* mg = MODl + (size_t)(4 * 6 + 2) * DM;
                const float* src = l == 0 ? ctx_in : (const float*)XS + (size_t)NLAT * DM;
                for (int idx = bid * NTHR + tid; idx < (NTOK - NLAT) * DM / 4; idx += G * NTHR) { const size_t o = (size_t)idx * 4; const int col = (int)(o & (DM - 1));
                    const f32x4 p0 = *(const f32x4*)(PART + o), p1 = *(const f32x4*)(PART + (size_t)(NTOK - NLAT) * DM + o), p2 = *(const f32x4*)(PART + (size_t)2 * (NTOK - NLAT) * DM + o), p3 = *(const f32x4*)(PART + (size_t)3 * (NTOK - NLAT) * DM + o);
                    const f32x4 sv = *(const f32x4*)(src + o), gm = *(const f32x4*)(mg + col);
                    *(f32x4*)(XS + (size_t)NLAT * DM + o) = sv + gm * (((p0 + p1) + p2) + p3); }
                xcd_barrier(bar);
            }
            for (int i = bid * NTHR + tid; i < NEXP * MOE_PAD; i += G * NTHR) ROWTOK[i] = -1;
            for (int i = bid * NTHR + tid; i < NTOK * 16; i += G * NTHR) INV[i] = -1;
            const float* wr = PT(42) + (size_t)l * DM * 16; const float* gn = norm_ffn + l * DM;
            float* wl = sf;
            __syncthreads();
#pragma unroll 1
            for (int q0 = 0; q0 < 16; q0 += 4) {
                const float4 a0 = ((const float4*)wr)[(q0 + 0) * 512 + tid], a1 = ((const float4*)wr)[(q0 + 1) * 512 + tid], a2 = ((const float4*)wr)[(q0 + 2) * 512 + tid], a3 = ((const float4*)wr)[(q0 + 3) * 512 + tid];
                { const int f4 = (q0 + 0) * 512 + tid; *(float4*)(wl + (size_t)(f4 >> 4) * 68 + (f4 & 15) * 4) = a0; }
                { const int f4 = (q0 + 1) * 512 + tid; *(float4*)(wl + (size_t)(f4 >> 4) * 68 + (f4 & 15) * 4) = a1; }
                { const int f4 = (q0 + 2) * 512 + tid; *(float4*)(wl + (size_t)(f4 >> 4) * 68 + (f4 & 15) * 4) = a2; }
                { const int f4 = (q0 + 3) * 512 + tid; *(float4*)(wl + (size_t)(f4 >> 4) * 68 + (f4 & 15) * 4) = a3; } }
            __syncthreads();
            for (int tok0 = (bid * 8 + wave) * 4; tok0 < M2; tok0 += G * 32) {
                const int r = tok0 < NLAT ? tok0 / SEQ : 4; const float* xr = XS + (size_t)tok0 * DM;
                const float* sh = MODl + (size_t)(r * 6 + 3) * DM; const float* sc = MODl + (size_t)(r * 6 + 4) * DM;
                float rs[4];
#pragma unroll
                for (int tk = 0; tk < 4; ++tk) { float ss = 0.f;
#pragma unroll 4
                    for (int i = 0; i < 8; ++i) { const float4 t4 = *(const float4*)(xr + (size_t)tk * DM + i * 256 + lane * 4); ss += t4.x * t4.x + t4.y * t4.y + t4.z * t4.z + t4.w * t4.w; }
                    ss = wave_sum(ss); rs[tk] = rsqrtf(ss * (1.0f / DM) + 1e-6f); }
                float lg[4][16];
#pragma unroll
                for (int tk = 0; tk < 4; ++tk)
#pragma unroll
                    for (int e = 0; e < 16; ++e) lg[tk][e] = 0.f;
#pragma unroll 1
                for (int i = 0; i < 8; ++i) { const int d = i * 256 + lane * 4;
                    const float4 g4 = *(const float4*)(gn + d), s4 = *(const float4*)(sc + d), h4 = *(const float4*)(sh + d);
                    float4 xq[4], ww[16];
#pragma unroll
                    for (int tk = 0; tk < 4; ++tk) xq[tk] = *(const float4*)(xr + (size_t)tk * DM + d);
                    const float4* wq = (const float4*)(wl + (size_t)(i * 64 + lane) * 68);
#pragma unroll
                    for (int q = 0; q < 16; ++q) ww[q] = wq[q];
                    float hv[4][4];
#pragma unroll
                    for (int tk = 0; tk < 4; ++tk) { const float4 xv = xq[tk]; const float rr = rs[tk];
                        hv[tk][0] = xv.x * rr * g4.x * (1.f + s4.x) + h4.x; hv[tk][1] = xv.y * rr * g4.y * (1.f + s4.y) + h4.y; hv[tk][2] = xv.z * rr * g4.z * (1.f + s4.z) + h4.z; hv[tk][3] = xv.w * rr * g4.w * (1.f + s4.w) + h4.w;
                        u32x2 w; w.x = pk2(hv[tk][0], hv[tk][1]); w.y = pk2(hv[tk][2], hv[tk][3]); *(u32x2*)(HB + (size_t)(tok0 + tk) * DM + d) = w; }
#pragma unroll
                    for (int q = 0; q < 4; ++q) { const float4 w0 = ww[q * 4 + 0], w1 = ww[q * 4 + 1], w2 = ww[q * 4 + 2], w3 = ww[q * 4 + 3];
#pragma unroll
                        for (int tk = 0; tk < 4; ++tk) { const float hq = hv[tk][q];
                            lg[tk][0] += hq * w0.x; lg[tk][1] += hq * w0.y; lg[tk][2] += hq * w0.z; lg[tk][3] += hq * w0.w; lg[tk][4] += hq * w1.x; lg[tk][5] += hq * w1.y; lg[tk][6] += hq * w1.z; lg[tk][7] += hq * w1.w;
                            lg[tk][8] += hq * w2.x; lg[tk][9] += hq * w2.y; lg[tk][10] += hq * w2.z; lg[tk][11] += hq * w2.w; lg[tk][12] += hq * w3.x; lg[tk][13] += hq * w3.y; lg[tk][14] += hq * w3.z; lg[tk][15] += hq * w3.w; } } }
#pragma unroll
                for (int tk = 0; tk < 4; ++tk) { float mx = -1e30f;
#pragma unroll
                    for (int e = 0; e < 16; ++e) { lg[tk][e] = wave_sum(lg[tk][e]); mx = fmaxf(mx, lg[tk][e]); }
                    float sm = 0.f;
#pragma unroll
                    for (int e = 0; e < 16; ++e) { lg[tk][e] = expf(lg[tk][e] - mx); sm += lg[tk][e]; }
                    const float inv = 1.0f / sm;
                    if (lane == 0) {
#pragma unroll
                        for (int e = 0; e < 16; e += 4) *(float4*)(PROBS + (size_t)(tok0 + tk) * 16 + e) = make_float4(lg[tk][e] * inv, lg[tk][e + 1] * inv, lg[tk][e + 2] * inv, lg[tk][e + 3] * inv); } }
            }
            SEAM(PB + 9);
        }
        if (IN(PB + 10)) for (int rep_ = 0; rep_ < PROBE_REPS(10); ++rep_) {
            PH_BEGIN
            const int nitems = 64 + (lastl ? 0 : 64);
            unsigned long long* keys = (unsigned long long*)shm;
            for (int it = bid; it < nitems; it += G) {
                const int set = it >> 6, e = it & 15, b = (it >> 4) & 3;
                const int n = set ? CTXL : SEQ, cap = set ? 32 : 512, tokbase = set ? NLAT + b * CTXL : b * SEQ;
                __syncthreads();
                for (int i = tid; i < n; i += NTHR) keys[i] = ((unsigned long long)__float_as_uint(PROBS[(size_t)(tokbase + i) * 16 + e]) << 32) | (unsigned long long)(0xFFFFFFFFu - (unsigned)i);
                __syncthreads();
                for (int k = 2; k <= n; k <<= 1)
                    for (int j = k >> 1; j > 0; j >>= 1) {
                        for (int p = tid; p < (n >> 1); p += NTHR) { const int i = ((p & ~(j - 1)) << 1) | (p & (j - 1)); const int m = i | j;
                            const unsigned long long ka = keys[i], kb = keys[m]; const bool desc = ((i & k) == 0);
                            if ((ka < kb) == desc) { keys[i] = kb; keys[m] = ka; } }
                        __syncthreads();
                    }
                for (int r = tid; r < cap; r += NTHR) { const unsigned long long kk = keys[r]; const int row = e * MOE_PAD + (set ? 2048 + b * 32 + r : b * 512 + r);
                    const int tk_ = tokbase + (int)(0xFFFFFFFFu - (unsigned)(kk & 0xFFFFFFFFull)); ROWTOK[row] = tk_; ROWGATE[row] = __uint_as_float((unsigned)(kk >> 32)); INV[tk_ * 16 + e] = row; }
                for (int rb = 0; rb < cap; rb += 32) {
                    u32x4 t4[4][4];
#pragma unroll
                    for (int q = 0; q < 4; ++q) { const int r = rb + wave + 8 * q; const int tok = tokbase + (int)(0xFFFFFFFFu - (unsigned)(keys[r] & 0xFFFFFFFFull));
                        const u32x4* sp = (const u32x4*)(HB + (size_t)tok * DM);
#pragma unroll
                        for (int i = 0; i < 4; ++i) t4[q][i] = sp[i * 64 + lane]; }
#pragma unroll
                    for (int q = 0; q < 4; ++q) { const int r = rb + wave + 8 * q; const int row = e * MOE_PAD + (set ? 2048 + b * 32 + r : b * 512 + r);
                        u32x4* dp = (u32x4*)(XG + (size_t)row * DM);
#pragma unroll
                        for (int i = 0; i < 4; ++i) dp[i * 64 + lane] = t4[q][i]; } }
            }
            if (lastl && G > 64 && bid >= 64) {
                const int n_win = 32 * 55, n_br = 4 * 64, n_out = 32 * 8, n_glu = 16, n_gu = 16 * 2 * 192, n_d = 16 * 192;
                const int lo_d = n_win + n_br + n_out + n_glu + n_gu - 1536;
                CV_RUN(l, lo_d + bid - 64, G - 64, lo_d + 1536 + n_d);
            }
            if (!lastl && G > 128 && bid >= 128) {
                const int n_win = 32 * 55, n_br = 4 * 64, n_out = 32 * 8, n_glu = 16, n_gu = 16 * 2 * 192; (void)n_gu;
                CV_RUN(l + 1, bid - 128, G - 128, n_win); (void)n_br; (void)n_out; (void)n_glu;
            }
            {   const int pad0 = lastl ? 2048 : MOE_ROWS, npad = MOE_PAD - pad0;
                for (int R = bid * 8 + wave; R < NEXP * npad; R += G * 8) { const int e = R / npad, rr = pad0 + R % npad; u32x4* dp = (u32x4*)(XG + ((size_t)e * MOE_PAD + rr) * DM);
#pragma unroll
                    for (int i = 0; i < 4; ++i) dp[i * 64 + lane] = (u32x4){0u, 0u, 0u, 0u}; } }
            SEAM(PB + 10);
        }
        if (IN(PB + 12)) for (int rep_ = 0; rep_ < PROBE_REPS(12); ++rep_) {
            PH_BEGIN
            pg8::Gemm g{XG, WGU, DM, DM, DM}; pg8::SchedMoe S{lastl ? 8 : 9, 12, G, bid, DM, DM, 2 * DEXP}; pg8::EpiMoe1 E{HID};
            pg8::gemm_phase((LAS unsigned char*)shm, g, S, E);
            SEAM(PB + 12);
        }
        if (IN(PB + 13)) for (int rep_ = 0; rep_ < PROBE_REPS(13); ++rep_) {
            PH_BEGIN
            pg8::Gemm g{HID, WD, DEXP, DEXP, DEXP}; pg8::SchedMoe S{lastl ? 8 : 9, 8, G, bid, DEXP, DEXP, DM}; pg8::EpiMoeY E{YEXP};
            pg8::gemm_phase((LAS unsigned char*)shm, g, S, E);
            SEAM(PB + 13);
        }

}

__global__ __launch_bounds__(NTHR, 2) void fwd(Args a) {
    extern __shared__ __attribute__((aligned(16))) unsigned char shm[];
    const int bid = blockIdx.x, G = gridDim.x;
    float* const sf = (float*)shm;
    volatile LAS unsigned* xbw = (volatile LAS unsigned*)((LAS unsigned char*)shm + (LDS_BYTES - 16));
    if (threadIdx.x == 0) { xbw[0] = 0u; xbw[1] = 0u; xbw[2] = 0u; xbw[3] = 0u; }
    const float** const ptab = (const float**)(shm + (LDS_BYTES - 16 - 512));
    if (threadIdx.x == 0) {
#pragma unroll
        for (int i = 0; i < 47; ++i) ptab[i] = a.in[i]; }
    __syncthreads();
    XcdBarrier bar = xcd_barrier_post((unsigned*)(a.ws + O_BAR), xbw);
    const int lo = a.ph_lo, hi = a.ph_hi;
    if (IN(0)) {
        PH_BEGIN
        {
            __syncthreads();
            for (int i = tid; i < 5 * DM; i += NTHR) { const int r = i >> 11, k = i & (DM - 1); const float v = r < 4 ? c_in[r * DM + k] : cctx_in[k]; sf[i] = siluf_(v); }
            __syncthreads();
            float* red = sf + 5 * DM;
            for (int unit = bid; unit < 2 * 96; unit += G) { const int l = unit / 96, j = (unit % 96) * 128 + (tid & 127), kq = tid >> 7;
                const float* w = ada_w + (size_t)l * DM * (6 * DM) + (size_t)(kq * 512) * (6 * DM) + j; const float* sv = sf + kq * 512;
                float a0 = 0.f, a1 = 0.f, a2 = 0.f, a3 = 0.f, a4 = 0.f;
#pragma unroll 8
                for (int k = 0; k < 512; ++k) { const float wv = w[(size_t)k * (6 * DM)]; a0 += sv[k] * wv; a1 += sv[DM + k] * wv; a2 += sv[2 * DM + k] * wv; a3 += sv[3 * DM + k] * wv; a4 += sv[4 * DM + k] * wv; }
                __syncthreads();
                { float* rp = red + (kq * 5) * 128 + (tid & 127); rp[0] = a0; rp[128] = a1; rp[256] = a2; rp[384] = a3; rp[512] = a4; }
                __syncthreads();
                if (tid < 128) { const float bb = ada_b[l * 6 * DM + j]; float* o = MOD + (size_t)l * 5 * 6 * DM + j;
#pragma unroll
                    for (int r = 0; r < 5; ++r) o[(size_t)r * 6 * DM] = ((red[(0 * 5 + r) * 128 + tid] + red[(1 * 5 + r) * 128 + tid]) + (red[(2 * 5 + r) * 128 + tid] + red[(3 * 5 + r) * 128 + tid])) + bb; }
            }
        }
    }

    layer_body<0>(a, bar, lo, hi, bid, G, shm, sf, ptab);
    layer_body<1>(a, bar, lo, hi, bid, G, shm, sf, ptab);
    if (IN(33)) {
        PH_BEGIN
        const float* gn = PT(46);
        for (int tok = bid * 8 + wave; tok < NLAT; tok += G * 8) {
            const float* xr = XS + (size_t)tok * DM; float4 v[8]; float ss = 0.f;
#pragma unroll
            for (int i = 0; i < 8; ++i) v[i] = *(const float4*)(xr + i * 256 + lane * 4);
            moe_combine(v, tok, lane, INV, ROWGATE, YEXP, MOD + (size_t)(1 * 5 + tok / SEQ) * 6 * DM + 5 * DM);
#pragma unroll
            for (int i = 0; i < 8; ++i) {                 ss += v[i].x * v[i].x + v[i].y * v[i].y + v[i].z * v[i].z + v[i].w * v[i].w; }
            ss = wave_sum(ss); const float rs = rsqrtf(ss * (1.0f / DM) + 1e-6f);
#pragma unroll
            for (int i = 0; i < 8; ++i) { const int d = i * 256 + lane * 4; const float4 g4 = *(const float4*)(gn + d);
                *(float4*)(a.out + (size_t)tok * DM + d) = make_float4(v[i].x * rs * g4.x, v[i].y * rs * g4.y, v[i].z * rs * g4.z, v[i].w * rs * g4.w); }
        }
    }
#undef IN
#undef SEAM
}


extern "C" void kernel_launch(void* const* d_in, const int* in_sizes, int n_in, void* d_out, int out_size, void* d_ws, size_t ws_size, hipStream_t stream) {
    static int grid = 0;
    if (grid == 0) {
        if (n_in != 47 || ws_size < WS_END) { fprintf(stderr, "kernel_launch: expected 47 inputs and >= %zu bytes of workspace; got %d, %zu\n", (size_t)WS_END, n_in, ws_size); grid = -1; return; }
        int dev = 0, cus = 0;
        if (hipGetDevice(&dev) != hipSuccess || hipDeviceGetAttribute(&cus, hipDeviceAttributeMultiprocessorCount, dev) != hipSuccess) { grid = -1; return; }
        if (hipFuncSetAttribute((const void*)fwd, hipFuncAttributeMaxDynamicSharedMemorySize, LDS_BYTES) != hipSuccess) { fprintf(stderr, "kernel_launch: hipFuncSetAttribute failed\n"); grid = -1; return; }
        int per_cu = 0;
        if (hipOccupancyMaxActiveBlocksPerMultiprocessor(&per_cu, (const void*)fwd, NTHR, LDS_BYTES) != hipSuccess || per_cu < 1) fprintf(stderr, "kernel_launch: occupancy query reports %d\n", per_cu);
        (void)hipGetLastError();
        grid = cus > 256 ? 256 : cus;
        if (grid < 224) { fprintf(stderr, "kernel_launch: needs >= 224 CUs (got %d)\n", grid); grid = -1; return; }
    }
    if (grid < 0) return;
    (void)hipMemsetAsync((char*)d_ws, 0, O_ZERO_END, stream);
    Args a{};
    for (int i = 0; i < 47; ++i) a.in[i] = (const float*)d_in[i];
    a.out = (float*)d_out; a.ws = (unsigned char*)d_ws;
#if MK_ONE_LAUNCH
    a.ph_lo = 0; a.ph_hi = 64;
    hipLaunchKernelGGL(fwd, dim3(grid), dim3(NTHR), LDS_BYTES, stream, a);
#else
    const int ids[] = {0, 1,2,3,4,5,6,7,8,9,10,11,12,13,14, 17,18,19,20,21,22,23,24,25,26,27,28,29,30, 33};
    for (int k = 0; k < (int)(sizeof(ids) / sizeof(ids[0])); ++k) { a.ph_lo = ids[k]; a.ph_hi = ids[k] + 1; hipLaunchKernelGGL(fwd, dim3(grid), dim3(NTHR), LDS_BYTES, stream, a); }
#endif
}
```

```cpp
#include <hip/hip_runtime.h>
#include <stdint.h>
#include <stdio.h>

#ifndef PROBE_MASK
#define PROBE_MASK 0
#endif
#ifndef PROBE_SP
#define PROBE_SP 1
#endif
#define PROBE_REPS(k) ((((PROBE_MASK) >> (k)) & 1) + 1)
#ifndef MK_ONE_LAUNCH
#define MK_ONE_LAUNCH 1
#endif

#define DM 2048
#define NB 4
#define SEQ 4096
#define CTXL 256
#define BW 512
#define NLAT 16384
#define NCTX 1024
#define NTOK 17408
#define IN_W 13856
#define GATE2 5888
#define LDP 14080
#define HY_OFF 0
#define ML_OFF 1536
#define S5_OFF 3600
#define SSD_OFF 4112
#define GATE_OFF 5664
#define NEXP 16
#define DEXP 1536
#define MOE_ROWS 2176
#define MOE_PAD 2304
#define NTHR 512
#define LDS_BYTES 147456
#define LAS __attribute__((address_space(3)))

typedef unsigned short bf16_t;
typedef short bf16x8 __attribute__((ext_vector_type(8)));
typedef float f32x4 __attribute__((ext_vector_type(4)));
typedef unsigned u32x4 __attribute__((ext_vector_type(4)));
typedef unsigned u32x2 __attribute__((ext_vector_type(2)));

#define XB_TMO      128
#define XB_XCNT(j)  (256  + 64 * (j))
#define XB_XSUB(j)  (1280 + 64 * (j))
#define XB_XGEN(j)  (2304 + 64 * (j))
#define XB_TOP      3328
#define XB_TOPGEN   3392
#define XCD_BAR_WORDS 3456
#define XB_SPIN_CAP (1u << 18)
__device__ __forceinline__ unsigned xb_ld(unsigned* p)              { return __hip_atomic_load(p, __ATOMIC_RELAXED, __HIP_MEMORY_SCOPE_AGENT); }
__device__ __forceinline__ unsigned xb_add(unsigned* p, unsigned v) { return __hip_atomic_fetch_add(p, v, __ATOMIC_RELAXED, __HIP_MEMORY_SCOPE_AGENT); }
__device__ __forceinline__ unsigned xb_xcc_id() { return (unsigned)__builtin_amdgcn_s_getreg((3 << 11) | 20) & 0xFu; }
#define XB_SPIN(cond, bar) do { unsigned _sp = 0; while (cond) { __builtin_amdgcn_s_sleep(1); \
    if ((++_sp & 255u) == 0u) { if (xb_ld(&(bar)[XB_TMO])) break; if (_sp > XB_SPIN_CAP) { atomicAdd(&(bar)[XB_TMO], 1u); break; } } } } while (0)
struct XcdBarrier { unsigned* bar; unsigned x; volatile LAS unsigned* st; };
__device__ __forceinline__ XcdBarrier xcd_barrier_post(unsigned* bar, volatile LAS unsigned* st) {
    XcdBarrier b; b.bar = bar; b.x = xb_xcc_id(); b.st = st;
    if (threadIdx.x == 0) (void)xb_add(&bar[XB_XCNT(b.x)], 1u);
    return b;
}
__device__ __forceinline__ void xcd_barrier_complete(unsigned* bar, unsigned x, unsigned& nloc, unsigned& nx) {
    const unsigned G = gridDim.x * gridDim.y * gridDim.z;
    unsigned sum, cnt, mine, sp = 0u;
    for (;;) {
        sum = 0u; cnt = 0u; mine = 0u;
#pragma unroll
        for (unsigned j = 0; j < 16; ++j) { const unsigned c = xb_ld(&bar[XB_XCNT(j)]); sum += c; cnt += (c > 0u) ? 1u : 0u; mine = (j == x) ? c : mine; }
        if (sum == G) break;
        __builtin_amdgcn_s_sleep(1);
        if ((++sp & 255u) == 0u) { if (xb_ld(&bar[XB_TMO])) break; if (sp > XB_SPIN_CAP) { atomicAdd(&bar[XB_TMO], 1u); break; } }
    }
    nloc = mine > 0u ? mine : 1u; nx = cnt > 0u ? cnt : 1u;
}
__device__ __forceinline__ void xcd_barrier(const XcdBarrier& b) {
    asm volatile("s_waitcnt vmcnt(0)" ::: "memory");
    __syncthreads();
    if (threadIdx.x == 0) {
        unsigned* bar = b.bar;
        __builtin_amdgcn_s_waitcnt(0);
        unsigned nloc = b.st[0], nx = b.st[1];
        if (nloc == 0u) { xcd_barrier_complete(bar, b.x, nloc, nx); b.st[0] = nloc; b.st[1] = nx; }
        const unsigned old = xb_add(&bar[XB_XSUB(b.x)], 1u);
        const unsigned gen = old / nloc;
        if (old + 1u == (gen + 1u) * nloc) {
            __builtin_amdgcn_fence(__ATOMIC_RELEASE, "agent");
            asm volatile("s_waitcnt vmcnt(0)" ::: "memory");
            const unsigned og = xb_add(&bar[XB_TOP], 1u);
            const unsigned tg = og / nx;
            if (og + 1u == (tg + 1u) * nx) xb_add(&bar[XB_TOPGEN], 1u);
            else XB_SPIN(xb_ld(&bar[XB_TOPGEN]) == tg, bar);
            __builtin_amdgcn_fence(__ATOMIC_ACQUIRE, "agent");
            xb_add(&bar[XB_XGEN(b.x)], 1u);
            asm volatile("s_waitcnt vmcnt(0)" ::: "memory");
        } else {
            XB_SPIN(xb_ld(&bar[XB_XGEN(b.x)]) == gen, bar);
            __builtin_amdgcn_fence(__ATOMIC_ACQUIRE, "agent");
            asm volatile("s_waitcnt vmcnt(0)" ::: "memory");
        }
    }
    __syncthreads();
}

__device__ __forceinline__ unsigned short f2bf(float f) { unsigned u = __float_as_uint(f); u += 0x7FFFu + ((u >> 16) & 1u); return (unsigned short)(u >> 16); }
__device__ __forceinline__ float bf2f(unsigned short b) { return __uint_as_float(((unsigned)b) << 16); }
__device__ __forceinline__ unsigned pk2(float lo, float hi) { unsigned r; asm("v_cvt_pk_bf16_f32 %0, %1, %2" : "=v"(r) : "v"(lo), "v"(hi)); return r; }
__device__ __forceinline__ float sigmoidf_(float x) { return 1.0f / (1.0f + expf(-x)); }
__device__ __forceinline__ float siluf_(float x) { return x / (1.0f + expf(-x)); }
__device__ __forceinline__ float wave_sum(float v) {
#pragma unroll
    for (int o = 32; o >= 1; o >>= 1) v += __shfl_xor(v, o);
    return v;
}
__device__ __forceinline__ const float* uptr(const float* p) { const unsigned long long v = (unsigned long long)p;
    const unsigned lo = __builtin_amdgcn_readfirstlane((unsigned)v), hi = __builtin_amdgcn_readfirstlane((unsigned)(v >> 32)); return (const float*)(((unsigned long long)hi << 32) | lo); }
#define PT(k) uptr(ptab[k])
__device__ __forceinline__ int step_tok(int b, int dir, int i) {
    if (i < CTXL) { const int tt = dir ? (CTXL - 1 - i) : i; return NLAT + b * CTXL + tt; }
    const int j = i - CTXL; const int tt = dir ? (SEQ - 1 - j) : j; return b * SEQ + tt;
}
__device__ __forceinline__ void unpack8(const u32x4 w, float (&f)[8]) {
    f[0] = __uint_as_float(w.x << 16); f[1] = __uint_as_float(w.x & 0xFFFF0000u); f[2] = __uint_as_float(w.y << 16); f[3] = __uint_as_float(w.y & 0xFFFF0000u);
    f[4] = __uint_as_float(w.z << 16); f[5] = __uint_as_float(w.z & 0xFFFF0000u); f[6] = __uint_as_float(w.w << 16); f[7] = __uint_as_float(w.w & 0xFFFF0000u);
}

namespace pg8 {
constexpr int BM = 256, BK = 64, HALF = 128, HTB = HALF * BK * 2, STAGE_BYTES = 8 * HTB, NXCD = 8, WGM = 8;
__host__ __device__ __forceinline__ int lds_byte(int r, int c) { const int st = (r >> 4) * 2 + (c >> 5), rr = r & 15, cc = c & 31, ob = rr * 64 + cc * 2; return st * 1024 + (ob ^ (((ob >> 9) & 1) << 5)); }
__host__ __device__ __forceinline__ void stage_rc(int b, int& R, int& C) { const int st = b / 1024, sb = b % 1024, swz = sb ^ (((sb >> 9) & 1) << 5); R = (st >> 1) * 16 + swz / 64; C = (st & 1) * 32 + (swz % 64) / 2; }
__host__ __device__ __forceinline__ int perm32(int rho) { const int n = rho >> 4, i = rho & 15; return 8 * (i >> 2) + 4 * n + (i & 3); }
struct Unit { int pm, pn, z, k; long long ao, bo; };
struct Gemm { const bf16_t* A; const bf16_t* Bt; int lda, ldb, K; };

__device__ __forceinline__ void tile_of(int wgid, int nM, int nN, int& pm, int& pn) {
    const int nwg = nM * nN; { const int q = nwg / NXCD, r = nwg % NXCD, xcd = wgid % NXCD, off = wgid / NXCD; wgid = (xcd < r ? xcd * (q + 1) : r * (q + 1) + (xcd - r) * q) + off; }
    const int nig = WGM * nN, gid = wgid / nig, fm = gid * WGM, gsz = (nM - fm) < WGM ? (nM - fm) : WGM;
    pm = fm + ((wgid % nig) % gsz); pn = (wgid % nig) / gsz;
}
struct SchedStd {
    int nM, nN, G, c, lda, ldb;
    __device__ __forceinline__ bool next(int i, Unit& u) const { const long L = (long)i * G + c; if (L >= (long)nM * nN) return false; tile_of((int)L, nM, nN, u.pm, u.pn); u.z = 0; u.k = 0;
        u.ao = (long long)u.pm * BM * lda * 2; u.bo = (long long)u.pn * BM * ldb * 2; return true; }
    __device__ __forceinline__ void a_ready(const Unit&) const {}
    __device__ __forceinline__ void done(const Unit&) const {}
};
struct SchedBranch {
    int nM, nN, G, c;
    __device__ __forceinline__ bool next(int i, Unit& u) const { const long L = (long)(i >> 2) * G + c; if (L >= (long)nM * nN) return false; tile_of((int)L, nM, nN, u.pm, u.pn); u.z = 0; u.k = i & 3;
        u.ao = ((long long)u.pm * BM * DM + u.k * BW) * 2; u.bo = ((long long)u.k * DM + u.pn * BM) * BW * 2; return true; }
    __device__ __forceinline__ void a_ready(const Unit&) const {}
    __device__ __forceinline__ void done(const Unit&) const {}
};
struct SchedTail {
    int G, c;
    __device__ __forceinline__ bool next(int i, Unit& u) const { const long T = (long)i * G + c; if (T >= 128) return false; const int t = (int)(T >> 2); u.pm = 64 + (t >> 3); u.pn = t & 7; u.z = 1; u.k = (int)(T & 3);
        u.ao = ((long long)u.pm * BM * DM + u.k * BW) * 2; u.bo = ((long long)u.k * DM + u.pn * BM) * BW * 2; return true; }
    __device__ __forceinline__ void a_ready(const Unit&) const {}
    __device__ __forceinline__ void done(const Unit&) const {}
};
struct SchedTailK {
    int G, c;
    __device__ __forceinline__ bool next(int i, Unit& u) const { const long T = (long)i * G + c; if (T >= 128) return false; const int t = (int)(T >> 2); u.pm = 64 + (t >> 3); u.pn = t & 7; u.z = 1; u.k = (int)(T & 3);
        u.ao = ((long long)u.pm * BM * DM + u.k * 512) * 2; u.bo = ((long long)u.pn * BM * DM + u.k * 512) * 2; return true; }
    __device__ __forceinline__ void a_ready(const Unit&) const {}
    __device__ __forceinline__ void done(const Unit&) const {}
};
struct SchedMoe {
    int nPm, nPn, G, c, lda, ldb, nBrows;
    __device__ __forceinline__ bool next(int i, Unit& u) const { const long L = (long)i * G + c; const int per = nPm * nPn; if (L >= (long)NEXP * per) return false; const int e = (int)(L / per), rem = (int)(L % per);
        u.z = e; u.k = 0; u.pm = rem % nPm; u.pn = rem / nPm; u.ao = ((long long)e * MOE_PAD + u.pm * BM) * lda * 2; u.bo = ((long long)e * nBrows + u.pn * BM) * ldb * 2; return true; }
    __device__ __forceinline__ void a_ready(const Unit&) const {}
    __device__ __forceinline__ void done(const Unit&) const {}
};

typedef f32x4 Acc[2][2][4][2];
template <class Epi, class Sched>
__device__ __forceinline__ void gemm_phase(LAS unsigned char* lds, const Gemm g, const Sched& S, const Epi& E) {
    int tid = threadIdx.x; asm volatile("" : "+v"(tid));
    const int wid = __builtin_amdgcn_readfirstlane(tid >> 6), lane = tid & 63, wr = wid >> 2, wc = wid & 3, fr = lane & 15, fq = lane >> 4;
    const int K = g.K, nt = K / BK;
    unsigned voffA[2], voffB[2];
#pragma unroll
    for (int i = 0; i < 2; ++i) { int R, C; stage_rc(tid * 16 + i * 8192, R, C); const int Rb = Epi::PERM ? ((R & ~31) + perm32(R & 31)) : R;
        voffA[i] = (unsigned)(R * g.lda + C) * 2u; voffB[i] = (unsigned)(Rb * g.ldb + C) * 2u; }
    const size_t kstep = (size_t)(BK * 2);
    const size_t hstepA = (size_t)HALF * g.lda * 2, hstepB = (size_t)HALF * g.ldb * 2;
    const unsigned ldsw = (unsigned)wid * 1024u;
    const int aoff = lds_byte(wr * 64 + fr, fq * 8), boff = lds_byte(wc * 32 + fr, fq * 8);
#define PG8_SA(b, h) (((b) * 2 + (h)) * HTB)
#define PG8_SB(b, h) ((4 + (b) * 2 + (h)) * HTB)
#define PG8_STAGE(bufoff, gbase, voff) do { _Pragma("unroll") for (int _i = 0; _i < 2; ++_i) \
        __builtin_amdgcn_global_load_lds((const unsigned*)((const char*)(gbase) + (voff)[_i]), (LAS unsigned*)(lds + (bufoff) + ldsw + _i * 8192), 16, 0, 0); } while (0)
#define PG8_LDA(dst, b, h) do { _Pragma("unroll") for (int m = 0; m < 4; ++m) _Pragma("unroll") for (int k = 0; k < 2; ++k) dst[m][k] = *(const LAS bf16x8*)(lds + PG8_SA(b, h) + aoff + m * 2048 + k * 1024); } while (0)
#define PG8_LDB(dst, b, h) do { _Pragma("unroll") for (int n = 0; n < 2; ++n) _Pragma("unroll") for (int k = 0; k < 2; ++k) dst[n][k] = *(const LAS bf16x8*)(lds + PG8_SB(b, h) + boff + n * 2048 + k * 1024); } while (0)
#define PG8_MMA(ai, bj, At, Bt) do { __builtin_amdgcn_s_setprio(1); _Pragma("unroll") for (int m = 0; m < 4; ++m) _Pragma("unroll") for (int n = 0; n < 2; ++n) _Pragma("unroll") for (int k = 0; k < 2; ++k) \
        acc[ai][bj][m][n] = __builtin_amdgcn_mfma_f32_16x16x32_bf16(Bt[n][k], At[m][k], acc[ai][bj][m][n], 0, 0, 0); __builtin_amdgcn_s_setprio(0); } while (0)
#define PG8_WAIT_V(n) asm volatile("s_waitcnt vmcnt(" #n ")" ::: "memory")
#define PG8_WAIT_L(n) asm volatile("s_waitcnt lgkmcnt(" #n ")" ::: "memory")
#define PG8_BAR __builtin_amdgcn_s_barrier()
#define PG8_SCHED __builtin_amdgcn_sched_barrier(0)
    Unit cur, nxt; int ui = 0;
    if (!S.next(0, cur)) return;
    Acc acc;
#pragma unroll
    for (int a = 0; a < 2; ++a)
#pragma unroll
        for (int b = 0; b < 2; ++b)
#pragma unroll
            for (int m = 0; m < 4; ++m)
#pragma unroll
                for (int n = 0; n < 2; ++n) acc[a][b][m][n] = (f32x4){0.f, 0.f, 0.f, 0.f};
    bf16x8 At[4][2], B0[2][2], B1[2][2];
    const char* cA = (const char*)g.A + cur.ao; const char* cB = (const char*)g.Bt + cur.bo;
    S.a_ready(cur);
    PG8_STAGE(PG8_SB(0, 0), cB, voffB); PG8_STAGE(PG8_SA(0, 0), cA, voffA); PG8_STAGE(PG8_SB(0, 1), cB + hstepB, voffB); PG8_STAGE(PG8_SA(0, 1), cA + hstepA, voffA);
    if (wr == 1) PG8_BAR;
    PG8_WAIT_V(4); PG8_BAR;
    PG8_STAGE(PG8_SB(1, 0), cB + kstep, voffB); PG8_STAGE(PG8_SA(1, 0), cA + kstep, voffA); PG8_STAGE(PG8_SB(1, 1), cB + hstepB + kstep, voffB);
    PG8_WAIT_V(6); PG8_BAR;
    for (;;) {
        const bool has_next = S.next(ui + 1, nxt);
        const char* nA = has_next ? (const char*)g.A + nxt.ao : cA; const char* nB = has_next ? (const char*)g.Bt + nxt.bo : cB;
        for (int t = 0; t < nt; t += 2) {
            const bool last = (t == nt - 2);
            const char* a1 = cA + (size_t)(t + 1) * kstep;
            const char* a2 = last ? nA : cA + (size_t)(t + 2) * kstep; const char* b2 = last ? nB : cB + (size_t)(t + 2) * kstep;
            const char* a3 = a2 + kstep; const char* b3 = b2 + kstep;
            if (last && has_next) S.a_ready(nxt);
            PG8_LDB(B0, 0, 0); PG8_SCHED; PG8_LDA(At, 0, 0); PG8_STAGE(PG8_SA(1, 1), a1 + hstepA, voffA);
            PG8_WAIT_L(8); PG8_BAR; PG8_WAIT_L(0); PG8_MMA(0, 0, At, B0); PG8_BAR; PG8_SCHED;
            PG8_LDB(B1, 0, 1); PG8_STAGE(PG8_SB(0, 0), b2, voffB);
            PG8_BAR; PG8_WAIT_L(0); PG8_MMA(0, 1, At, B1); PG8_BAR;
            PG8_LDA(At, 0, 1); PG8_STAGE(PG8_SA(0, 0), a2, voffA);
            PG8_BAR; PG8_WAIT_L(0); PG8_MMA(1, 0, At, B0); PG8_BAR; PG8_SCHED;
            PG8_STAGE(PG8_SB(0, 1), b2 + hstepB, voffB);
            PG8_WAIT_V(6); PG8_BAR; PG8_MMA(1, 1, At, B1); PG8_BAR;
            PG8_LDB(B0, 1, 0); PG8_SCHED; PG8_LDA(At, 1, 0); PG8_STAGE(PG8_SA(0, 1), a2 + hstepA, voffA);
            PG8_WAIT_L(8); PG8_BAR; PG8_WAIT_L(0); PG8_MMA(0, 0, At, B0); PG8_BAR; PG8_SCHED;
            PG8_LDB(B1, 1, 1); PG8_STAGE(PG8_SB(1, 0), b3, voffB);
            PG8_BAR; PG8_WAIT_L(0); PG8_MMA(0, 1, At, B1); PG8_BAR;
            PG8_LDA(At, 1, 1); PG8_STAGE(PG8_SA(1, 0), a3, voffA);
            PG8_BAR; PG8_WAIT_L(0); PG8_MMA(1, 0, At, B0); PG8_BAR; PG8_SCHED;
            PG8_STAGE(PG8_SB(1, 1), b3 + hstepB, voffB);
            PG8_WAIT_V(6); PG8_BAR; PG8_MMA(1, 1, At, B1); PG8_BAR;
        }
        const bool keep = E(acc, cur, wr, wc, fr, fq); S.done(cur);
        if (!has_next) break;
        if (!keep) {
#pragma unroll
        for (int a = 0; a < 2; ++a)
#pragma unroll
            for (int b = 0; b < 2; ++b)
#pragma unroll
                for (int m = 0; m < 4; ++m)
#pragma unroll
                    for (int n = 0; n < 2; ++n) acc[a][b][m][n] = (f32x4){0.f, 0.f, 0.f, 0.f};
        }
        cur = nxt; cA = nA; cB = nB; ++ui;
    }
    PG8_WAIT_V(0);
    if (wr == 0) PG8_BAR;
    PG8_BAR;
#undef PG8_SA
#undef PG8_SB
#undef PG8_STAGE
#undef PG8_LDA
#undef PG8_LDB
#undef PG8_MMA
#undef PG8_WAIT_V
#undef PG8_WAIT_L
#undef PG8_BAR
#undef PG8_SCHED
}

struct EpiBf16Store {
    static constexpr bool PERM = true;
    bf16_t* O; int ldc;
    __device__ __forceinline__ bool operator()(Acc& acc, const Unit& u, int wr, int wc, int fr, int fq) const {
        const int row0 = u.pm * BM + wr * 64 + fr, col0 = u.pn * BM + wc * 32 + 8 * fq;
#pragma unroll
        for (int ai = 0; ai < 2; ++ai)
#pragma unroll
            for (int m = 0; m < 4; ++m) { bf16_t* rowp = O + (size_t)(row0 + ai * HALF + m * 16) * ldc + col0;
#pragma unroll
                for (int bj = 0; bj < 2; ++bj) { const f32x4 v0 = acc[ai][bj][m][0], v1 = acc[ai][bj][m][1];
                    u32x4 w; w.x = pk2(v0[0], v0[1]); w.y = pk2(v0[2], v0[3]); w.z = pk2(v1[0], v1[1]); w.w = pk2(v1[2], v1[3]);
                    *(u32x4*)(rowp + bj * HALF) = w; } }
        return false;
    }
};
struct EpiWin {
    static constexpr bool PERM = true;
    bf16_t* O; int ldc;
    __device__ __forceinline__ bool operator()(Acc& acc, const Unit& u, int wr, int wc, int fr, int fq) const {
        const int row0 = u.pm * BM + wr * 64 + fr;
        if (u.pn < 23) { const int col0 = u.pn * BM + wc * 32 + 8 * fq;
#pragma unroll
            for (int ai = 0; ai < 2; ++ai)
#pragma unroll
                for (int m = 0; m < 4; ++m)
#pragma unroll
                    for (int bj = 0; bj < 2; ++bj) { const f32x4 v0 = acc[ai][bj][m][0], v1 = acc[ai][bj][m][1];
                        u32x4 w; w.x = pk2(v0[0], v0[1]); w.y = pk2(v0[2], v0[3]); w.z = pk2(v1[0], v1[1]); w.w = pk2(v1[2], v1[3]);
                        *(u32x4*)(O + (size_t)(row0 + ai * HALF + m * 16) * ldc + col0 + bj * HALF) = w; }
        } else { const int colb = GATE2 + 64 * (u.pn - 23) + 16 * wc + 4 * fq;
#pragma unroll
            for (int ai = 0; ai < 2; ++ai)
#pragma unroll
                for (int m = 0; m < 4; ++m) { f32x4 sg[4];
#pragma unroll
                    for (int bj = 0; bj < 2; ++bj)
#pragma unroll
                        for (int n = 0; n < 2; ++n) { const f32x4 v = acc[ai][bj][m][n];
#pragma unroll
                            for (int j = 0; j < 4; ++j) sg[2 * bj + n][j] = 1.0f + __expf(-v[j]); }
                    bf16_t* op = O + (size_t)(row0 + ai * HALF + m * 16) * ldc + colb;
#pragma unroll
                    for (int k = 0; k < 4; ++k) { f32x4 r;
#pragma unroll
                        for (int j = 0; j < 4; ++j) { const float ia = __builtin_amdgcn_rcpf(sg[k][j]); r[j] = k < 3 ? sg[k + 1][j] * ia : ia; }
                        u32x2 w; w.x = pk2(r[0], r[1]); w.y = pk2(r[2], r[3]); *(u32x2*)(op + k * DM) = w; } }
        }
        return false;
    }
};
struct EpiNone { static constexpr bool PERM = true;
    __device__ __forceinline__ bool operator()(Acc& acc, const Unit&, int, int, int, int) const {
#pragma unroll
        for (int a = 0; a < 2; ++a)
#pragma unroll
            for (int b = 0; b < 2; ++b)
#pragma unroll
                for (int m = 0; m < 4; ++m)
#pragma unroll
                    for (int n = 0; n < 2; ++n) asm volatile("" :: "v"(acc[a][b][m][n]));
        return false; } };
struct EpiGlu {
    static constexpr bool PERM = true;
    const bf16_t* GG; const float* bias; bf16_t* Y4;
    __device__ __forceinline__ bool operator()(Acc& acc, const Unit& u, int wr, int wc, int fr, int fq) const {
        const int row0 = u.pm * BM + wr * 64 + fr, col0 = u.pn * BM + wc * 32 + 8 * fq;
#pragma unroll
        for (int bj = 0; bj < 2; ++bj) { const int col = col0 + bj * HALF; const f32x4 b0 = *(const f32x4*)(bias + col), b1 = *(const f32x4*)(bias + col + 4);
            u32x4 gq[2][4];
#pragma unroll
            for (int ai = 0; ai < 2; ++ai)
#pragma unroll
                for (int m = 0; m < 4; ++m) gq[ai][m] = *(const u32x4*)(GG + (size_t)(row0 + ai * HALF + m * 16) * BW + col);
#pragma unroll
            for (int ai = 0; ai < 2; ++ai)
#pragma unroll
                for (int m = 0; m < 4; ++m) { const size_t row = (size_t)(row0 + ai * HALF + m * 16);
                    float gg[8]; unpack8(gq[ai][m], gg);
                    const f32x4 v0 = acc[ai][bj][m][0] + b0, v1 = acc[ai][bj][m][1] + b1;
                    u32x4 w; w.x = pk2(gg[0] * sigmoidf_(v0[0]), gg[1] * sigmoidf_(v0[1])); w.y = pk2(gg[2] * sigmoidf_(v0[2]), gg[3] * sigmoidf_(v0[3]));
                    w.z = pk2(gg[4] * sigmoidf_(v1[0]), gg[5] * sigmoidf_(v1[1])); w.w = pk2(gg[6] * sigmoidf_(v1[2]), gg[7] * sigmoidf_(v1[3]));
                    *(u32x4*)(Y4 + row * DM + 1024 + col) = w; } }
        return false;
    }
};
struct EpiBranch {
    static constexpr bool PERM = true;
    const bf16_t* P; bf16_t* ACCb;
    __device__ __forceinline__ bool operator()(Acc& acc, const Unit& u, int wr, int wc, int fr, int fq) const {
        const int row0 = u.pm * BM + wr * 64 + fr, col0 = u.pn * BM + wc * 32 + 8 * fq; const int k = u.k;
        const bf16_t* gbase = P + (size_t)row0 * LDP + GATE2 + k * DM + col0;
#pragma unroll
        for (int ai = 0; ai < 2; ++ai) {
            u32x4 ga[8];
#pragma unroll
            for (int m = 0; m < 4; ++m)
#pragma unroll
                for (int bj = 0; bj < 2; ++bj) ga[m * 2 + bj] = *(const u32x4*)(gbase + (size_t)(ai * HALF + m * 16) * LDP + bj * HALF);
#pragma unroll
            for (int m = 0; m < 4; ++m)
#pragma unroll
                for (int bj = 0; bj < 2; ++bj) { float sr[8]; unpack8(ga[m * 2 + bj], sr);
                    f32x4 v0 = acc[ai][bj][m][0], v1 = acc[ai][bj][m][1];
                    v0[0] *= sr[0]; v0[1] *= sr[1]; v0[2] *= sr[2]; v0[3] *= sr[3]; v1[0] *= sr[4]; v1[1] *= sr[5]; v1[2] *= sr[6]; v1[3] *= sr[7];
                    if (k < 3) { acc[ai][bj][m][0] = v0; acc[ai][bj][m][1] = v1; }
                    else { u32x4 w; w.x = pk2(v0[0], v0[1]); w.y = pk2(v0[2], v0[3]); w.z = pk2(v1[0], v1[1]); w.w = pk2(v1[2], v1[3]); *(u32x4*)(ACCb + (size_t)(row0 + ai * HALF + m * 16) * DM + col0 + bj * HALF) = w; } } }
        return k < 3;
    }
};
struct EpiPartK {
    static constexpr bool PERM = true;
    float* PART;
    __device__ __forceinline__ bool operator()(Acc& acc, const Unit& u, int wr, int wc, int fr, int fq) const {
        const int row0 = u.pm * BM + wr * 64 + fr, col0 = u.pn * BM + wc * 32 + 8 * fq;
        float* pbase = PART + ((size_t)u.k * (NTOK - NLAT) + (size_t)(row0 - NLAT)) * DM + col0;
#pragma unroll
        for (int ai = 0; ai < 2; ++ai)
#pragma unroll
            for (int m = 0; m < 4; ++m)
#pragma unroll
                for (int bj = 0; bj < 2; ++bj) { float* pp = pbase + (size_t)(ai * HALF + m * 16) * DM + bj * HALF; *(f32x4*)pp = acc[ai][bj][m][0]; *(f32x4*)(pp + 4) = acc[ai][bj][m][1]; }
        return false;
    }
};
struct EpiResid {
    static constexpr bool PERM = false;
    float* XS; const float* srcLat; const float* srcCtx; const float* MODl; int gidx;
    __device__ __forceinline__ bool operator()(Acc& acc, const Unit& u, int wr, int wc, int fr, int fq) const {
        const int row0 = u.pm * BM + wr * 64 + fr, col0 = u.pn * BM + wc * 32 + 4 * fq;
        const int r = (u.pm * BM) < NLAT ? (u.pm * BM) / SEQ : 4;
        const float* src = (u.pm * BM) < NLAT ? srcLat : srcCtx;
        const float* mg = MODl + (size_t)(r * 6 + gidx) * DM;
#pragma unroll
        for (int bj = 0; bj < 2; ++bj) {
            f32x4 gm[2], xs[2][2][4];
#pragma unroll
            for (int n = 0; n < 2; ++n) { const int col = col0 + bj * HALF + n * 16; gm[n] = *(const f32x4*)(mg + col);
#pragma unroll
                for (int ai = 0; ai < 2; ++ai)
#pragma unroll
                    for (int m = 0; m < 4; ++m) xs[n][ai][m] = *(const f32x4*)(src + (size_t)(row0 + ai * HALF + m * 16) * DM + col); }
#pragma unroll
            for (int n = 0; n < 2; ++n) { const int col = col0 + bj * HALF + n * 16;
#pragma unroll
                for (int ai = 0; ai < 2; ++ai)
#pragma unroll
                    for (int m = 0; m < 4; ++m) *(f32x4*)(XS + (size_t)(row0 + ai * HALF + m * 16) * DM + col) = xs[n][ai][m] + gm[n] * acc[ai][bj][m][n]; } }
        return false;
    }
};
struct EpiMoe1 {
    static constexpr bool PERM = true;
    bf16_t* HID;
    __device__ __forceinline__ bool operator()(Acc& acc, const Unit& u, int wr, int wc, int fr, int fq) const {
        const size_t row0 = (size_t)u.z * MOE_PAD + u.pm * BM + wr * 64 + fr; const int col0 = u.pn * HALF + wc * 32 + 8 * fq;
#pragma unroll
        for (int ai = 0; ai < 2; ++ai)
#pragma unroll
            for (int m = 0; m < 4; ++m) { const f32x4 g0 = acc[ai][0][m][0], g1 = acc[ai][0][m][1], u0 = acc[ai][1][m][0], u1 = acc[ai][1][m][1];
                float h[8];
#pragma unroll
                for (int j = 0; j < 4; ++j) { h[j] = g0[j] * __builtin_amdgcn_rcpf(1.0f + __expf(-g0[j])) * u0[j]; h[4 + j] = g1[j] * __builtin_amdgcn_rcpf(1.0f + __expf(-g1[j])) * u1[j]; }
                u32x4 w; w.x = pk2(h[0], h[1]); w.y = pk2(h[2], h[3]); w.z = pk2(h[4], h[5]); w.w = pk2(h[6], h[7]);
                *(u32x4*)(HID + (row0 + ai * HALF + m * 16) * DEXP + col0) = w; }
        return false;
    }
};
struct EpiMoeY {
    static constexpr bool PERM = true;
    bf16_t* O;
    __device__ __forceinline__ bool operator()(Acc& acc, const Unit& u, int wr, int wc, int fr, int fq) const {
        const size_t row0 = (size_t)u.z * MOE_PAD + u.pm * BM + wr * 64 + fr; const int col0 = u.pn * BM + wc * 32 + 8 * fq;
#pragma unroll
        for (int ai = 0; ai < 2; ++ai)
#pragma unroll
            for (int m = 0; m < 4; ++m) { bf16_t* rowp = O + (row0 + ai * HALF + m * 16) * DM + col0;
#pragma unroll
                for (int bj = 0; bj < 2; ++bj) { const f32x4 v0 = acc[ai][bj][m][0], v1 = acc[ai][bj][m][1];
                    u32x4 w; w.x = pk2(v0[0], v0[1]); w.y = pk2(v0[2], v0[3]); w.z = pk2(v1[0], v1[1]); w.w = pk2(v1[2], v1[3]);
                    *(u32x4*)(rowp + bj * HALF) = w; } }
        return false;
    }
};

struct SchedS5a {
    int c;
    __device__ __forceinline__ bool next(int i, Unit& u) const { if (i > 0 || c >= 64) return false; u.z = c >> 1; u.pm = c & 1; u.pn = 0; u.k = 0;
        u.ao = ((long long)u.z * 512 + u.pm * BM) * 768 * 2; u.bo = (long long)u.z * 256 * 512 * 2; return true; }
    __device__ __forceinline__ void a_ready(const Unit&) const {}
    __device__ __forceinline__ void done(const Unit&) const {}
};
struct SchedS5b {
    int c;
    __device__ __forceinline__ bool next(int i, Unit& u) const { if (i > 0 || c >= 128) return false; u.z = c >> 2; u.pm = (c >> 1) & 1; u.pn = c & 1; u.k = 0;
        u.ao = ((long long)u.z * 512 + u.pm * BM) * 768 * 2; u.bo = ((long long)u.z * 512 + u.pn * BM) * 768 * 2; return true; }
    __device__ __forceinline__ void a_ready(const Unit&) const {}
    __device__ __forceinline__ void done(const Unit&) const {}
};
struct EpiXloc {
    static constexpr bool PERM = false;
    float* XL;
    __device__ __forceinline__ bool operator()(Acc& acc, const Unit& u, int wr, int wc, int fr, int fq) const {
        const int row0 = u.pm * BM + wr * 64 + fr, col0 = wc * 32 + 4 * fq; float* base = XL + (size_t)u.z * 512 * 256;
#pragma unroll
        for (int ai = 0; ai < 2; ++ai)
#pragma unroll
            for (int m = 0; m < 4; ++m) { float* rowp = base + (size_t)(row0 + ai * HALF + m * 16) * 256 + col0;
#pragma unroll
                for (int bj = 0; bj < 2; ++bj)
#pragma unroll
                    for (int n = 0; n < 2; ++n) *(f32x4*)(rowp + bj * HALF + n * 16) = acc[ai][bj][m][n]; }
        return false;
    }
};
struct EpiS5Out {
    static constexpr bool PERM = true;
    const bf16_t* P; const float* dskip; bf16_t* GG;
    __device__ __forceinline__ bool operator()(Acc& acc, const Unit& u, int wr, int wc, int fr, int fq) const {
        const int row0 = u.pm * BM + wr * 64 + fr, col0 = u.pn * BM + wc * 32 + 8 * fq; const int g = u.z;
#pragma unroll
        for (int bj = 0; bj < 2; ++bj) { const int col = col0 + bj * HALF; const int t = col >> 4, c0 = col & 15;
            const f32x4 d0 = *(const f32x4*)(dskip + g * 16 + c0), d1 = *(const f32x4*)(dskip + g * 16 + c0 + 4);
            u32x4 uq[2][4];
#pragma unroll
            for (int ai = 0; ai < 2; ++ai)
#pragma unroll
                for (int m = 0; m < 4; ++m) uq[ai][m] = *(const u32x4*)(P + ((size_t)(row0 + ai * HALF + m * 16) * 32 + t) * LDP + S5_OFF + g * 16 + c0);
#pragma unroll
            for (int ai = 0; ai < 2; ++ai)
#pragma unroll
                for (int m = 0; m < 4; ++m) { const size_t tok = (size_t)(row0 + ai * HALF + m * 16) * 32 + t;
                    float uu[8]; unpack8(uq[ai][m], uu);
                    const f32x4 v0 = acc[ai][bj][m][0], v1 = acc[ai][bj][m][1];
                    float y[8] = {v0[0] + d0[0] * uu[0], v0[1] + d0[1] * uu[1], v0[2] + d0[2] * uu[2], v0[3] + d0[3] * uu[3], v1[0] + d1[0] * uu[4], v1[1] + d1[1] * uu[5], v1[2] + d1[2] * uu[6], v1[3] + d1[3] * uu[7]};
#pragma unroll
                    for (int j = 0; j < 8; ++j) y[j] = 0.5f * y[j] * (1.0f + tanhf(0.7978845608028654f * (y[j] + 0.044715f * y[j] * y[j] * y[j])));
                    u32x4 w; w.x = pk2(y[0], y[1]); w.y = pk2(y[2], y[3]); w.z = pk2(y[4], y[5]); w.w = pk2(y[6], y[7]);
                    *(u32x4*)(GG + tok * BW + g * 16 + c0) = w; } }
        return false;
    }
};
}


__device__ __forceinline__ float wave_scan_incl(float v, int lane) {
#pragma unroll
    for (int o = 1; o < 64; o <<= 1) { const float t = __shfl_up(v, o); if (lane >= o) v += t; }
    return v;
}
__device__ __forceinline__ float wave_scanmax_incl(float v, int lane) {
#pragma unroll
    for (int o = 1; o < 64; o <<= 1) { const float t = __shfl_up(v, o); if (lane >= o) v = fmaxf(v, t); }
    return v;
}
__device__ __forceinline__ float wave_max(float v) {
#pragma unroll
    for (int o = 32; o >= 1; o >>= 1) v = fmaxf(v, __shfl_xor(v, o));
    return v;
}
__device__ __forceinline__ void unpack8h(const u32x4 w, bf16_t (&h)[8]) {
    h[0] = (bf16_t)(w.x & 0xFFFFu); h[1] = (bf16_t)(w.x >> 16); h[2] = (bf16_t)(w.y & 0xFFFFu); h[3] = (bf16_t)(w.y >> 16);
    h[4] = (bf16_t)(w.z & 0xFFFFu); h[5] = (bf16_t)(w.z >> 16); h[6] = (bf16_t)(w.w & 0xFFFFu); h[7] = (bf16_t)(w.w >> 16);
}

__device__ __forceinline__ int tokblock_of(int b, int dir, int c) { if (c < 4) return 256 + b * 4 + (dir ? 3 - c : c); const int j = c - 4; return b * 64 + (dir ? 63 - j : j); }
__device__ __forceinline__ u32x4 rev8h(const u32x4 v) { u32x4 r; r.x = (v.w >> 16) | (v.w << 16); r.y = (v.z >> 16) | (v.z << 16); r.z = (v.y >> 16) | (v.y << 16); r.w = (v.x >> 16) | (v.x << 16); return r; }
__device__ __forceinline__ u32x4 scale8h(const u32x4 v, const float4 a, const float4 b) { float f[8]; unpack8(v, f); u32x4 r; r.x = pk2(f[0] * a.x, f[1] * a.y); r.y = pk2(f[2] * a.z, f[3] * a.w); r.z = pk2(f[4] * b.x, f[5] * b.y); r.w = pk2(f[6] * b.z, f[7] * b.w); return r; }
__device__ __forceinline__ float dot8h(const u32x4 v, const float4 a, const float4 b) { float f[8]; unpack8(v, f); return (f[0] * a.x + f[1] * a.y) + (f[2] * a.z + f[3] * a.w) + (f[4] * b.x + f[5] * b.y) + (f[6] * b.z + f[7] * b.w); }
#define ML_FRAG_LOAD(KF, VF, cc_) do { const int tb_ = tokblock_of(b, dir, (cc_)); const bf16_t* kb_ = KTg + ((size_t)tb_ * 512 + h * 128 + 32 * wd + r16) * 64 + q4 * 8; const bf16_t* vb_ = VTg + ((size_t)tb_ * 512 + h * 128 + 64 * half + 32 * we + r16) * 64 + q4 * 8; \
        _Pragma("unroll") for (int ks_ = 0; ks_ < 2; ++ks_) _Pragma("unroll") for (int j_ = 0; j_ < 2; ++j_) { VF[j_][ks_] = *(const u32x4*)(vb_ + (size_t)j_ * 16 * 64 + ks_ * 32); KF[j_][ks_] = *(const u32x4*)(kb_ + (size_t)j_ * 16 * 64 + ks_ * 32); } } while (0)
#define ML_CHUNK(c_, KF, VF, KFN, VFN) do { const int c = (c_); \
        if (c + 1 < 68) ML_FRAG_LOAD(KFN, VFN, c + 1);                        \
        const float dec = sDEC[c]; \
        {   bf16_t* cs = CST + (size_t)(chain * 68 + c) * 128 * 128; \
            _Pragma("unroll") for (int je = 0; je < 2; ++je) _Pragma("unroll") for (int jd = 0; jd < 2; ++jd) { const int e = 64 * half + 32 * we + 16 * je + r16, d0 = 32 * wd + 16 * jd + q4 * 4; \
                u32x2 pk; pk.x = pk2(acc[je][jd][0], acc[je][jd][1]); pk.y = pk2(acc[je][jd][2], acc[je][jd][3]); *(u32x2*)(cs + (size_t)e * 128 + d0) = pk; } \
            if (nown) { _Pragma("unroll") for (int jd = 0; jd < 2; ++jd) { float nv = npart[jd]; nv += __shfl_xor(nv, 16); nv += __shfl_xor(nv, 32); if (q4 == 0) NST[(size_t)(chain * 68 + c) * 128 + 32 * wd + 16 * jd + r16] = nv; } } } \
        bf16x8 vfr[2][2]; \
        _Pragma("unroll") for (int ks = 0; ks < 2; ++ks) { const float4 wa = *(const float4*)(sWS + c * 64 + ks * 32 + q4 * 8), wb = *(const float4*)(sWS + c * 64 + ks * 32 + q4 * 8 + 4); \
            _Pragma("unroll") for (int je = 0; je < 2; ++je) { const u32x4 sv = scale8h(VF[je][ks], wa, wb); vfr[je][ks] = *(const bf16x8*)&sv; } \
            if (nown) { _Pragma("unroll") for (int jd = 0; jd < 2; ++jd) npart[jd] = (ks == 0 ? dec * npart[jd] : npart[jd]) + dot8h(KF[jd][ks], wa, wb); } } \
        _Pragma("unroll") for (int je = 0; je < 2; ++je) _Pragma("unroll") for (int jd = 0; jd < 2; ++jd) acc[je][jd] = acc[je][jd] * dec; \
        _Pragma("unroll") for (int ks = 0; ks < 2; ++ks) _Pragma("unroll") for (int je = 0; je < 2; ++je) _Pragma("unroll") for (int jd = 0; jd < 2; ++jd) \
            acc[je][jd] = __builtin_amdgcn_mfma_f32_16x16x32_bf16(*(const bf16x8*)&KF[jd][ks], vfr[je][ks], acc[je][jd], 0, 0, 0); } while (0)
__device__ __forceinline__ void mlstm_state_pass(const int chain, const int half, const bf16_t* __restrict__ Pm, const bf16_t* __restrict__ KTg, const bf16_t* __restrict__ VTg, const float* __restrict__ gate_b,
                                                 bf16_t* __restrict__ CST, float* __restrict__ NST, float* __restrict__ MST, unsigned char* shm, const int tid) {
    const int dir = chain & 1, h = (chain >> 1) & 3, b = chain >> 3, lane = tid & 63, w = tid >> 6, we = w >> 2, wd = w & 3, q4 = lane >> 4, r16 = lane & 15;
    const bool nown = (half == 0) && (we == 0);
    float* sE = (float*)shm; float* sWS = sE + 68 * 64; float* sAL = sWS + 68 * 64; float* sBE = sAL + 68; float* sMO = sBE + 68; float* sDEC = sMO + 68; float* sMB = sDEC + 68;
    const float gbi = gate_b[(dir * 2 + 0) * 4 + h], gbf = gate_b[(dir * 2 + 1) * 4 + h];
    const int gcol_i = ML_OFF + 2048 + (dir * 2 + 0) * 4 + h, gcol_f = ML_OFF + 2048 + (dir * 2 + 1) * 4 + h;
    u32x4 kfA[2][2], vfA[2][2], kfB[2][2], vfB[2][2];
    ML_FRAG_LOAD(kfA, vfA, 0);
    __syncthreads();
    unsigned gi_[9], gf_[9];
#pragma unroll
    for (int q = 0; q < 9; ++q) { const int c = min(w + 8 * q, 67); const size_t tokl = (size_t)step_tok(b, dir, c * 64 + lane); gi_[q] = Pm[tokl * LDP + gcol_i]; gf_[q] = Pm[tokl * LDP + gcol_f]; }
#pragma unroll
    for (int q = 0; q < 9; ++q) { const int c = w + 8 * q; if (c >= 68) break;
        const float ig = __uint_as_float(gi_[q] << 16) + gbi, fg = __uint_as_float(gf_[q] << 16) + gbf;
        const float lf = fminf(fg, 0.f) - log1pf(expf(-fabsf(fg)));
        const float bcs = wave_scan_incl(lf, lane); const float blast = __shfl(bcs, 63); const float ei = blast - bcs + ig; const float beta = wave_max(ei);
        sE[c * 64 + lane] = ei; if (lane == 0) { sAL[c] = blast; sBE[c] = beta; } }
    __syncthreads();
    if (tid == 0) { float m = 0.f; for (int c = 0; c < 68; ++c) { sMB[c] = m; const float mo = fmaxf(m + sAL[c], sBE[c]); sDEC[c] = expf(sAL[c] + m - mo); sMO[c] = mo; m = mo; } }
    __syncthreads();
    for (int idx = tid; idx < 68 * 64; idx += NTHR) { const int c = idx >> 6, i = idx & 63; sWS[c * 64 + (dir ? 63 - i : i)] = expf(sE[idx] - sMO[c]); }
    if (half == 0 && tid < 68) MST[chain * 68 + tid] = sMB[tid];
    __syncthreads();
    f32x4 acc[2][2];
#pragma unroll
    for (int je = 0; je < 2; ++je)
#pragma unroll
        for (int jd = 0; jd < 2; ++jd) acc[je][jd] = (f32x4){0.f, 0.f, 0.f, 0.f};
    float npart[2] = {0.f, 0.f};
    for (int c2 = 0; c2 < 68; c2 += 2) { ML_CHUNK(c2, kfA, vfA, kfB, vfB); ML_CHUNK(c2 + 1, kfB, vfB, kfA, vfA); }
    __syncthreads();
}
#undef ML_CHUNK
#undef ML_FRAG_LOAD
__device__ __forceinline__ void mlstm_out_item(const int chain, const int c, const bf16_t* __restrict__ Pm, const bf16_t* __restrict__ QKb, const bf16_t* __restrict__ VTg, const float* __restrict__ gate_b,
                                               const bf16_t* __restrict__ CST, const float* __restrict__ NST, const float* __restrict__ MST, bf16_t* __restrict__ Hout, unsigned char* shm, const int tid) {
    const int dir = chain & 1, h = (chain >> 1) & 3, b = chain >> 3, lane = tid & 63, w = tid >> 6;
    bf16_t* Qs = (bf16_t*)shm; bf16_t* Ks = (bf16_t*)(shm + 17408); bf16_t* VT = (bf16_t*)(shm + 34816); bf16_t* Cs = (bf16_t*)(shm + 53248); bf16_t* Ss = (bf16_t*)(shm + 88064);
    float* sc = (float*)(shm + 97280);
    __syncthreads();
    u32x4 gq[2], gk[2], gv[2], gc[4]; float gn = 0.f;
#pragma unroll
    for (int i = 0; i < 2; ++i) { const int pid = tid + i * 512; const int s = pid >> 4, x0 = (pid & 15) * 8; const size_t toks = (size_t)step_tok(b, dir, c * 64 + s);
        gq[i] = *(const u32x4*)(QKb + toks * 1024 + h * 128 + x0);
        gk[i] = *(const u32x4*)(QKb + toks * 1024 + 512 + h * 128 + x0);
        { const int e = pid >> 3, o = pid & 7;
          gv[i] = *(const u32x4*)(VTg + ((size_t)tokblock_of(b, dir, c) * 512 + h * 128 + e) * 64 + (dir ? 7 - o : o) * 8); } }
#pragma unroll
    for (int i = 0; i < 4; ++i) { const int pid = tid + i * 512; const int e = pid >> 4, x0 = (pid & 15) * 8;
        gc[i] = *(const u32x4*)(CST + ((size_t)(chain * 68 + c) * 128 + e) * 128 + x0); }
    if (tid < 128) gn = NST[(size_t)(chain * 68 + c) * 128 + tid];
    unsigned gi_ = 0u, gf_ = 0u; float gbi = 0.f, gbf = 0.f, m_in = 0.f;
    if (w == 0) { const size_t tokl = (size_t)step_tok(b, dir, c * 64 + lane);
        gi_ = Pm[tokl * LDP + ML_OFF + 2048 + (dir * 2 + 0) * 4 + h]; gf_ = Pm[tokl * LDP + ML_OFF + 2048 + (dir * 2 + 1) * 4 + h];
        gbi = gate_b[(dir * 2 + 0) * 4 + h]; gbf = gate_b[(dir * 2 + 1) * 4 + h]; m_in = MST[chain * 68 + c]; }
#pragma unroll
    for (int i = 0; i < 2; ++i) { const int pid = tid + i * 512; const int s = pid >> 4, x0 = (pid & 15) * 8;
        *(u32x4*)(Qs + s * 136 + x0) = gq[i]; *(u32x4*)(Ks + s * 136 + x0) = gk[i];
        { const int e = pid >> 3, o = pid & 7; *(u32x4*)(VT + e * 72 + o * 8) = dir ? rev8h(gv[i]) : gv[i]; } }
#pragma unroll
    for (int i = 0; i < 4; ++i) { const int pid = tid + i * 512; const int e = pid >> 4, x0 = (pid & 15) * 8; *(u32x4*)(Cs + e * 136 + x0) = gc[i]; }
    if (tid < 128) sc[384 + tid] = gn;
    if (w == 0) {
        const float ig = __uint_as_float(gi_ << 16) + gbi;
        const float fg = __uint_as_float(gf_ << 16) + gbf;
        const float lf = fminf(fg, 0.f) - log1pf(expf(-fabsf(fg)));
        const float bcs = wave_scan_incl(lf, lane); const float gsv = ig - bcs; const float pm = wave_scanmax_incl(gsv, lane);
        const float mt = bcs + fmaxf(m_in, pm);
        sc[lane] = bcs; sc[64 + lane] = gsv; sc[128 + lane] = mt; sc[192 + lane] = expf(bcs + m_in - mt); sc[256 + lane] = expf(-mt);
    }
    __syncthreads();
    const int tt = w >> 1;
    {   f32x4 aS[2] = {(f32x4){0.f, 0.f, 0.f, 0.f}, (f32x4){0.f, 0.f, 0.f, 0.f}};
#pragma unroll
        for (int ks = 0; ks < 4; ++ks) { const bf16x8 af = *(const bf16x8*)(Qs + (16 * tt + (lane & 15)) * 136 + ks * 32 + (lane >> 4) * 8);
#pragma unroll
            for (int i = 0; i < 2; ++i) { const int st = (w & 1) * 2 + i; const bf16x8 bfr = *(const bf16x8*)(Ks + (16 * st + (lane & 15)) * 136 + ks * 32 + (lane >> 4) * 8);
                aS[i] = __builtin_amdgcn_mfma_f32_16x16x32_bf16(af, bfr, aS[i], 0, 0, 0); } }
        float rs[4] = {0.f, 0.f, 0.f, 0.f};
#pragma unroll
        for (int i = 0; i < 2; ++i) { const int s = 16 * ((w & 1) * 2 + i) + (lane & 15); const float gsv = sc[64 + s];
#pragma unroll
            for (int q = 0; q < 4; ++q) { const int t = 16 * tt + (lane >> 4) * 4 + q; const float val = (s <= t) ? aS[i][q] * expf(sc[t] + gsv - sc[128 + t]) : 0.f; Ss[t * 72 + s] = f2bf(val); rs[q] += val; } }
#pragma unroll
        for (int q = 0; q < 4; ++q) { float r = rs[q]; r += __shfl_xor(r, 1); r += __shfl_xor(r, 2); r += __shfl_xor(r, 4); r += __shfl_xor(r, 8);
            if ((lane & 15) == 0) sc[512 + (w & 1) * 64 + 16 * tt + (lane >> 4) * 4 + q] = r; }
        {   const int t = tid >> 3, part = tid & 7; float dot = 0.f;
#pragma unroll
            for (int j = 0; j < 16; ++j) dot += bf2f(Qs[t * 136 + part * 16 + j]) * sc[384 + part * 16 + j];
            dot += __shfl_xor(dot, 1); dot += __shfl_xor(dot, 2); dot += __shfl_xor(dot, 4);
            if (part == 0) sc[640 + t] = sc[192 + t] * dot; }
    }
    __syncthreads();
    {   f32x4 aN[4];
#pragma unroll
        for (int i = 0; i < 4; ++i) aN[i] = (f32x4){0.f, 0.f, 0.f, 0.f};
#pragma unroll
        for (int ks = 0; ks < 4; ++ks) { const bf16x8 af = *(const bf16x8*)(Qs + (16 * tt + (lane & 15)) * 136 + ks * 32 + (lane >> 4) * 8);
#pragma unroll
            for (int i = 0; i < 4; ++i) { const int et = (w & 1) * 4 + i; const bf16x8 bfr = *(const bf16x8*)(Cs + (16 * et + (lane & 15)) * 136 + ks * 32 + (lane >> 4) * 8);
                aN[i] = __builtin_amdgcn_mfma_f32_16x16x32_bf16(bfr, af, aN[i], 0, 0, 0); } }
        const int t = 16 * tt + (lane & 15);
        {   const float it = sc[192 + t];
#pragma unroll
            for (int i = 0; i < 4; ++i) { aN[i][0] *= it; aN[i][1] *= it; aN[i][2] *= it; aN[i][3] *= it; } }
#pragma unroll
        for (int ks = 0; ks < 2; ++ks) { const bf16x8 af = *(const bf16x8*)(Ss + (16 * tt + (lane & 15)) * 72 + ks * 32 + (lane >> 4) * 8);
#pragma unroll
            for (int i = 0; i < 4; ++i) { const int et = (w & 1) * 4 + i; const bf16x8 bfr = *(const bf16x8*)(VT + (16 * et + (lane & 15)) * 72 + ks * 32 + (lane >> 4) * 8);
                aN[i] = __builtin_amdgcn_mfma_f32_16x16x32_bf16(bfr, af, aN[i], 0, 0, 0); } }
        {   const size_t tokt = (size_t)step_tok(b, dir, c * 64 + t); const float dn = fmaxf(fabsf((sc[512 + t] + sc[576 + t]) + sc[640 + t]), sc[256 + t]);
#pragma unroll
            for (int i = 0; i < 4; ++i) { const int e0 = 16 * ((w & 1) * 4 + i) + (lane >> 4) * 4;
                u32x2 wv; wv.x = pk2(aN[i][0] / dn, aN[i][1] / dn); wv.y = pk2(aN[i][2] / dn, aN[i][3] / dn);
                *(u32x2*)(Hout + tokt * BW + h * 128 + e0) = wv; } }
    }
}


#define SD_FRAG_LOAD(BF, XF, cc_) do { const int tb_ = tokblock_of(b, dir, (cc_)); const bf16_t* bb_ = BTg + ((size_t)tb_ * 256 + grp * 128 + 64 * (w >> 2) + r16) * 64 + q4 * 8; const bf16_t* xb_ = XTg + ((size_t)tb_ * 512 + h * 64 + 16 * (w & 3) + r16) * 64 + q4 * 8; \
        _Pragma("unroll") for (int ks_ = 0; ks_ < 2; ++ks_) { XF[ks_] = *(const u32x4*)(xb_ + ks_ * 32); _Pragma("unroll") for (int j_ = 0; j_ < 4; ++j_) BF[j_][ks_] = *(const u32x4*)(bb_ + (size_t)j_ * 16 * 64 + ks_ * 32); } } while (0)
#define SD_CHUNK(c_, BF, XF, BFN, XFN) do { const int c = (c_); \
        if (c + 1 < 68) SD_FRAG_LOAD(BFN, XFN, c + 1); \
        const float dec = sDEC[c]; \
        {   bf16_t* ss = SSTb + (size_t)(chain * 68 + c) * 64 * 128; const int p = 16 * (w & 3) + r16; \
            _Pragma("unroll") for (int j = 0; j < 4; ++j) { const int n0 = 16 * ((w >> 2) * 4 + j) + q4 * 4; u32x2 pk; pk.x = pk2(acc[j][0], acc[j][1]); pk.y = pk2(acc[j][2], acc[j][3]); *(u32x2*)(ss + (size_t)p * 128 + n0) = pk; } } \
        bf16x8 xfr[2]; \
        _Pragma("unroll") for (int ks = 0; ks < 2; ++ks) { const float4 wa = *(const float4*)(sSC + c * 64 + ks * 32 + q4 * 8), wb = *(const float4*)(sSC + c * 64 + ks * 32 + q4 * 8 + 4); const u32x4 sv = scale8h(XF[ks], wa, wb); xfr[ks] = *(const bf16x8*)&sv; } \
        _Pragma("unroll") for (int j = 0; j < 4; ++j) acc[j] = acc[j] * dec; \
        _Pragma("unroll") for (int ks = 0; ks < 2; ++ks) _Pragma("unroll") for (int j = 0; j < 4; ++j) acc[j] = __builtin_amdgcn_mfma_f32_16x16x32_bf16(*(const bf16x8*)&BF[j][ks], xfr[ks], acc[j], 0, 0, 0); } while (0)
__device__ __forceinline__ void ssd_state_pass(const int chain, const bf16_t* __restrict__ Pm, const bf16_t* __restrict__ BTg, const bf16_t* __restrict__ XTg, const float Aa, const float dtb,
                                               bf16_t* __restrict__ SSTb, unsigned char* shm, const int tid) {
    const int dir = chain & 1, h = (chain >> 1) & 7, b = chain >> 4, grp = h >> 2, lane = tid & 63, w = tid >> 6, q4 = lane >> 4, r16 = lane & 15;
    float* sSC = (float*)shm; float* sDEC = sSC + 68 * 64;
    const int dcol = SSD_OFF + 1536 + dir * 8 + h;
    u32x4 bfA[4][2], xfA[2], bfB[4][2], xfB[2];
    SD_FRAG_LOAD(bfA, xfA, 0);
    __syncthreads();
    unsigned dt_[9];
#pragma unroll
    for (int q = 0; q < 9; ++q) { const int c = min(w + 8 * q, 67); dt_[q] = Pm[(size_t)step_tok(b, dir, c * 64 + lane) * LDP + dcol]; }
#pragma unroll
    for (int q = 0; q < 9; ++q) { const int c = w + 8 * q; if (c >= 68) break;
        const float xv = __uint_as_float(dt_[q] << 16) + dtb; const float dtv = xv > 20.f ? xv : log1pf(expf(xv));
        const float cs = wave_scan_incl(dtv * Aa, lane); const float cl = __shfl(cs, 63);
        sSC[c * 64 + (dir ? 63 - lane : lane)] = dtv * expf(cl - cs); if (lane == 0) sDEC[c] = expf(cl); }
    __syncthreads();
    f32x4 acc[4];
#pragma unroll
    for (int j = 0; j < 4; ++j) acc[j] = (f32x4){0.f, 0.f, 0.f, 0.f};
    for (int c2 = 0; c2 < 68; c2 += 2) { SD_CHUNK(c2, bfA, xfA, bfB, xfB); SD_CHUNK(c2 + 1, bfB, xfB, bfA, xfA); }
    __syncthreads();
}
#undef SD_CHUNK
#undef SD_FRAG_LOAD
__device__ __forceinline__ void ssd_out_item(const int chain, const int c, const bf16_t* __restrict__ Pm, const bf16_t* __restrict__ XBb, const bf16_t* __restrict__ XTg, const float Aa, const float dtb,
                                             const bf16_t* __restrict__ SSTb, bf16_t* __restrict__ Yout, unsigned char* shm, const int tid) {
    const int dir = chain & 1, h = (chain >> 1) & 7, b = chain >> 4, grp = h >> 2, lane = tid & 63, w = tid >> 6;
    bf16_t* Cs = (bf16_t*)shm; bf16_t* Bs = (bf16_t*)(shm + 17408); bf16_t* XT = (bf16_t*)(shm + 34816); bf16_t* Sin = (bf16_t*)(shm + 44032); bf16_t* Gs = (bf16_t*)(shm + 61440);
    float* sc = (float*)(shm + 70656);
    __syncthreads();
    u32x4 gb[2], gcc[2], gs[2], gx; unsigned gd_ = 0u;
#pragma unroll
    for (int i = 0; i < 2; ++i) { const int pid = tid + i * 512; const int s = pid >> 4, x0 = (pid & 15) * 8; const size_t toks = (size_t)step_tok(b, dir, c * 64 + s);
        gb[i] = *(const u32x4*)(XBb + toks * 1024 + 512 + grp * 128 + x0);
        gcc[i] = *(const u32x4*)(XBb + toks * 1024 + 768 + grp * 128 + x0);
        const int p = pid >> 4;
        gs[i] = *(const u32x4*)(SSTb + ((size_t)(chain * 68 + c) * 64 + p) * 128 + x0); }
    {   const int p = tid >> 3, o = tid & 7;
        gx = *(const u32x4*)(XTg + ((size_t)tokblock_of(b, dir, c) * 512 + h * 64 + p) * 64 + (dir ? 7 - o : o) * 8); }
    if (w == 0) gd_ = Pm[(size_t)step_tok(b, dir, c * 64 + lane) * LDP + SSD_OFF + 1536 + dir * 8 + h];
#pragma unroll
    for (int i = 0; i < 2; ++i) { const int pid = tid + i * 512; const int s = pid >> 4, x0 = (pid & 15) * 8;
        *(u32x4*)(Bs + s * 136 + x0) = gb[i]; *(u32x4*)(Cs + s * 136 + x0) = gcc[i]; *(u32x4*)(Sin + s * 136 + x0) = gs[i]; }
    {   const int p = tid >> 3, o = tid & 7; *(u32x4*)(XT + p * 72 + o * 8) = dir ? rev8h(gx) : gx; }
    if (w == 0) {
        const float xv = __uint_as_float(gd_ << 16) + dtb; const float dtv = xv > 20.f ? xv : log1pf(expf(xv));
        sc[lane] = wave_scan_incl(dtv * Aa, lane); sc[64 + lane] = dtv; }
    __syncthreads();
    {   const int lt = w >> 1;
        f32x4 aG[2] = {(f32x4){0.f, 0.f, 0.f, 0.f}, (f32x4){0.f, 0.f, 0.f, 0.f}};
#pragma unroll
        for (int ks = 0; ks < 4; ++ks) { const bf16x8 af = *(const bf16x8*)(Cs + (16 * lt + (lane & 15)) * 136 + ks * 32 + (lane >> 4) * 8);
#pragma unroll
            for (int i = 0; i < 2; ++i) { const int st = (w & 1) * 2 + i; const bf16x8 bfr = *(const bf16x8*)(Bs + (16 * st + (lane & 15)) * 136 + ks * 32 + (lane >> 4) * 8);
                aG[i] = __builtin_amdgcn_mfma_f32_16x16x32_bf16(af, bfr, aG[i], 0, 0, 0); } }
#pragma unroll
        for (int i = 0; i < 2; ++i) { const int s = 16 * ((w & 1) * 2 + i) + (lane & 15); const float css = sc[s], dts = sc[64 + s];
#pragma unroll
            for (int q = 0; q < 4; ++q) { const int t = 16 * lt + (lane >> 4) * 4 + q; const float val = (s <= t) ? aG[i][q] * expf(sc[t] - css) * dts : 0.f; Gs[t * 72 + s] = f2bf(val); } }
    }
    __syncthreads();
    {   const int lt = w >> 1;
        f32x4 aY[2] = {(f32x4){0.f, 0.f, 0.f, 0.f}, (f32x4){0.f, 0.f, 0.f, 0.f}};
#pragma unroll
        for (int ks = 0; ks < 4; ++ks) { const bf16x8 af = *(const bf16x8*)(Cs + (16 * lt + (lane & 15)) * 136 + ks * 32 + (lane >> 4) * 8);
#pragma unroll
            for (int i = 0; i < 2; ++i) { const int pt = (w & 1) * 2 + i; const bf16x8 bfr = *(const bf16x8*)(Sin + (16 * pt + (lane & 15)) * 136 + ks * 32 + (lane >> 4) * 8);
                aY[i] = __builtin_amdgcn_mfma_f32_16x16x32_bf16(bfr, af, aY[i], 0, 0, 0); } }
        const int t = 16 * lt + (lane & 15);
        {   const float ec = expf(sc[t]);
#pragma unroll
            for (int i = 0; i < 2; ++i) { aY[i][0] *= ec; aY[i][1] *= ec; aY[i][2] *= ec; aY[i][3] *= ec; } }
#pragma unroll
        for (int ks = 0; ks < 2; ++ks) { const bf16x8 af = *(const bf16x8*)(Gs + (16 * lt + (lane & 15)) * 72 + ks * 32 + (lane >> 4) * 8);
#pragma unroll
            for (int i = 0; i < 2; ++i) { const int pt = (w & 1) * 2 + i; const bf16x8 bfr = *(const bf16x8*)(XT + (16 * pt + (lane & 15)) * 72 + ks * 32 + (lane >> 4) * 8);
                aY[i] = __builtin_amdgcn_mfma_f32_16x16x32_bf16(bfr, af, aY[i], 0, 0, 0); } }
        {   const size_t tokt = (size_t)step_tok(b, dir, c * 64 + t);
#pragma unroll
            for (int i = 0; i < 2; ++i) { const int p0 = 16 * ((w & 1) * 2 + i) + (lane >> 4) * 4;
                u32x2 wv; wv.x = pk2(aY[i][0], aY[i][1]); wv.y = pk2(aY[i][2], aY[i][3]);
                *(u32x2*)(Yout + tokt * BW + h * 64 + p0) = wv; } }
    }
}


#define FIDX(i) ((i) + ((i) >> 4))
#define FFT_X_BYTES 69632
__device__ constexpr float FFT_CW_RE[6][16] = {{0.f, 0.f, 0.f, 0.f, 0.f, 0.f, 0.f, 0.f, 0.f, 0.f, 0.f, 0.f, 0.f, 0.f, 0.f, 0.f}, {1.0f, 0.f, 0.f, 0.f, 0.f, 0.f, 0.f, 0.f, 0.f, 0.f, 0.f, 0.f, 0.f, 0.f, 0.f, 0.f}, {1.0f, 6.123233995736766e-17f, 0.f, 0.f, 0.f, 0.f, 0.f, 0.f, 0.f, 0.f, 0.f, 0.f, 0.f, 0.f, 0.f, 0.f}, {1.0f, 0.7071067811865476f, 6.123233995736766e-17f, -0.7071067811865475f, 0.f, 0.f, 0.f, 0.f, 0.f, 0.f, 0.f, 0.f, 0.f, 0.f, 0.f, 0.f}, {1.0f, 0.9238795325112867f, 0.7071067811865476f, 0.38268343236508984f, 6.123233995736766e-17f, -0.3826834323650897f, -0.7071067811865475f, -0.9238795325112867f, 0.f, 0.f, 0.f, 0.f, 0.f, 0.f, 0.f, 0.f}, {1.0f, 0.9807852804032304f, 0.9238795325112867f, 0.8314696123025452f, 0.7071067811865476f, 0.5555702330196023f, 0.38268343236508984f, 0.19509032201612833f, 6.123233995736766e-17f, -0.1950903220161282f, -0.3826834323650897f, -0.555570233019602f, -0.7071067811865475f, -0.8314696123025453f, -0.9238795325112867f, -0.9807852804032304f}};
__device__ constexpr float FFT_CW_IM[6][16] = {{0.f, 0.f, 0.f, 0.f, 0.f, 0.f, 0.f, 0.f, 0.f, 0.f, 0.f, 0.f, 0.f, 0.f, 0.f, 0.f}, {-0.0f, 0.f, 0.f, 0.f, 0.f, 0.f, 0.f, 0.f, 0.f, 0.f, 0.f, 0.f, 0.f, 0.f, 0.f, 0.f}, {-0.0f, -1.0f, 0.f, 0.f, 0.f, 0.f, 0.f, 0.f, 0.f, 0.f, 0.f, 0.f, 0.f, 0.f, 0.f, 0.f}, {-0.0f, -0.7071067811865475f, -1.0f, -0.7071067811865476f, 0.f, 0.f, 0.f, 0.f, 0.f, 0.f, 0.f, 0.f, 0.f, 0.f, 0.f, 0.f}, {-0.0f, -0.3826834323650898f, -0.7071067811865475f, -0.9238795325112867f, -1.0f, -0.9238795325112867f, -0.7071067811865476f, -0.3826834323650899f, 0.f, 0.f, 0.f, 0.f, 0.f, 0.f, 0.f, 0.f}, {-0.0f, -0.19509032201612825f, -0.3826834323650898f, -0.5555702330196022f, -0.7071067811865475f, -0.8314696123025452f, -0.9238795325112867f, -0.9807852804032304f, -1.0f, -0.9807852804032304f, -0.9238795325112867f, -0.8314696123025455f, -0.7071067811865476f, -0.5555702330196022f, -0.3826834323650899f, -0.1950903220161286f}};
__host__ __device__ constexpr int fft_bitrev(int k, int R) { int r = 0; for (int i = 0; i < R; ++i) if (k & (1 << i)) r |= 1 << (R - 1 - i); return r; }
template <int R, bool INV>
__device__ __forceinline__ void fft_pass(float2* __restrict__ X, const float2* __restrict__ TW, const int s0, const int gidx) {
    const int lowbits = 13 - s0 - R; const int stride = 1 << lowbits;
    const int low = gidx & (stride - 1), high = gidx >> lowbits; const int base = (high << (lowbits + R)) | low;
    const int p0 = FIDX(base);
#define FFT_SLOT(k) (lowbits >= 4 ? p0 + (k) * (stride + (stride >> 4)) : p0 + (k) + ((k) >> 4))
    float2 v[1 << R];
#pragma unroll
    for (int k = 0; k < (1 << R); ++k) v[k] = X[FFT_SLOT(k)];
    const int lw = low << s0;
    if (!INV) {
#pragma unroll
        for (int j = 0; j < R; ++j) { const int hk = 1 << (R - 1 - j);
#pragma unroll
            for (int k = 0; k < (1 << R); ++k) if (!(k & hk)) { const int kk = k & (hk - 1);
                const float2 a = v[k], b = v[k + hk]; v[k] = make_float2(a.x + b.x, a.y + b.y); const float dx = a.x - b.x, dy = a.y - b.y;
                if (kk == 0) v[k + hk] = make_float2(dx, dy);
                else if (2 * kk == hk) v[k + hk] = make_float2(dy, -dx);
                else { const float cr = FFT_CW_RE[R - j][kk], ci = FFT_CW_IM[R - j][kk]; v[k + hk] = make_float2(dx * cr - dy * ci, dx * ci + dy * cr); } } }
        if (lowbits > 0) {
#pragma unroll
            for (int k = 1; k < (1 << R); ++k) { const float2 w = TW[(lw * fft_bitrev(k, R)) & 8191]; const float2 a = v[k]; v[k] = make_float2(a.x * w.x - a.y * w.y, a.x * w.y + a.y * w.x); } }
    } else {
        if (lowbits > 0) {
#pragma unroll
            for (int k = 1; k < (1 << R); ++k) { const float2 w = TW[(lw * fft_bitrev(k, R)) & 8191]; const float2 a = v[k]; v[k] = make_float2(a.x * w.x + a.y * w.y, a.y * w.x - a.x * w.y); } }
#pragma unroll
        for (int j = R - 1; j >= 0; --j) { const int hk = 1 << (R - 1 - j);
#pragma unroll
            for (int k = 0; k < (1 << R); ++k) if (!(k & hk)) { const int kk = k & (hk - 1);
                const float2 a = v[k], b = v[k + hk]; float tx, ty;
                if (kk == 0) { tx = b.x; ty = b.y; }
                else if (2 * kk == hk) { tx = -b.y; ty = b.x; }
                else { const float cr = FFT_CW_RE[R - j][kk], ci = FFT_CW_IM[R - j][kk]; tx = b.x * cr + b.y * ci; ty = b.y * cr - b.x * ci; }
                v[k] = make_float2(a.x + tx, a.y + ty); v[k + hk] = make_float2(a.x - tx, a.y - ty); } }
    }
#pragma unroll
    for (int k = 0; k < (1 << R); ++k) X[FFT_SLOT(k)] = v[k];
#undef FFT_SLOT
}
__device__ __forceinline__ void fft_fwd(float2* X, const float2* TW, const int tid) {
    fft_pass<4, false>(X, TW, 0, tid); __syncthreads(); fft_pass<4, false>(X, TW, 4, tid); __syncthreads(); if (tid < 256) fft_pass<5, false>(X, TW, 8, tid); __syncthreads(); }
__device__ __forceinline__ void fft_inv(float2* X, const float2* TW, const int tid) {
    if (tid < 256) fft_pass<5, true>(X, TW, 8, tid); __syncthreads(); fft_pass<4, true>(X, TW, 4, tid); __syncthreads(); fft_pass<4, true>(X, TW, 0, tid); __syncthreads(); }
__device__ __forceinline__ void fft_twiddles(float2* TW, const int tid) {
#pragma unroll
    for (int k = 0; k < 16; ++k) { const int m = tid + k * 512; const float xx = (float)m * (1.0f / 4096.0f); TW[m] = make_float2(cospif(xx), -sinpif(xx)); }
}
__device__ __forceinline__ void hyena_spec_item(const int pr, const float* __restrict__ HR, const float* __restrict__ nrm, float2* __restrict__ HSPEC, unsigned char* shm, const int tid) {
    float2* X = (float2*)shm; const float2* TW = (const float2*)(shm + FFT_X_BYTES);
    const int o = pr >> 8, c = (pr & 255) * 2, oc = o * 512 + c; const float inva = 1.0f / nrm[oc], invb = 1.0f / nrm[oc + 1];
    __syncthreads();
    float2 hv[16];
#pragma unroll
    for (int k = 0; k < 16; ++k) { const int j = tid + k * 512;
        const unsigned off = j < SEQ ? (unsigned)j * 2048u + o * 1024 + c : j == SEQ ? (unsigned)(o * 1024 + c) : (unsigned)(2 * SEQ - j) * 2048u + o * 1024 + 512 + c;
        hv[k] = *(const float2*)(HR + off); }
#pragma unroll
    for (int k = 0; k < 16; ++k) { const int j = tid + k * 512; X[FIDX(j)] = j == SEQ ? make_float2(0.f, 0.f) : make_float2(hv[k].x * inva, hv[k].y * invb); }
    __syncthreads();
    fft_fwd(X, TW, tid);
    float4* outa = (float4*)(HSPEC + (size_t)oc * 8192 + tid * 16); float4* outb = (float4*)(HSPEC + (size_t)(oc + 1) * 8192 + tid * 16); const float2* xs = X + 17 * tid;
    const float sc_ = 0.5f / 8192.0f;
#pragma unroll
    for (int k = 0; k < 8; ++k) { float2 ha[2], hb[2];
#pragma unroll
        for (int q = 0; q < 2; ++q) { const int p = 16 * tid + 2 * k + q; const int kf = (int)(__builtin_bitreverse32((unsigned)p) >> 19); const int p2 = (int)(__builtin_bitreverse32((unsigned)((8192 - kf) & 8191)) >> 19);
            const float2 xp = xs[2 * k + q], xq = X[FIDX(p2)];
            ha[q] = make_float2((xp.x + xq.x) * sc_, (xp.y - xq.y) * sc_);
            hb[q] = make_float2((xp.y + xq.y) * sc_, (xq.x - xp.x) * sc_); }
        outa[k] = make_float4(ha[0].x, ha[0].y, ha[1].x, ha[1].y); outb[k] = make_float4(hb[0].x, hb[0].y, hb[1].x, hb[1].y); }
}
__device__ __forceinline__ void fft_mul_spec(float2* X, const float2* __restrict__ H, const int tid) {
    const float4* h4 = (const float4*)(H + tid * 16); float2* xs = X + 17 * tid;
#pragma unroll
    for (int k = 0; k < 8; ++k) { const float4 hv = h4[k]; const float2 x0 = xs[2 * k], x1 = xs[2 * k + 1];
        xs[2 * k] = make_float2(x0.x * hv.x - x0.y * hv.y, x0.x * hv.y + x0.y * hv.x); xs[2 * k + 1] = make_float2(x1.x * hv.z - x1.y * hv.w, x1.x * hv.w + x1.y * hv.z); }
}
__device__ __forceinline__ void hyena_fft_item(const int item, const bf16_t* __restrict__ UT, const float2* __restrict__ HSPEC, const float* __restrict__ bias, bf16_t* __restrict__ YT, unsigned char* shm, const int tid) {
    float2* X = (float2*)shm; const float2* TW = (const float2*)(shm + FFT_X_BYTES);
    const int c = item >> 1, b0 = (item & 1) * 2, b1 = b0 + 1;
    const bf16_t* u0 = UT + (size_t)(b0 * 1536 + c) * SEQ + tid * 8; const bf16_t* u1 = UT + (size_t)(b1 * 1536 + c) * SEQ + tid * 8;
    const float bias0 = bias[c], bias1 = bias[512 + c];
    float2* xs = X + FIDX(8 * tid);
    float vr[8], vi[8];
    __syncthreads();
    { const u32x4 a0 = *(const u32x4*)u0, c0 = *(const u32x4*)u1; unpack8(a0, vr); unpack8(c0, vi); }
#pragma unroll
    for (int k = 0; k < 8; ++k) { xs[k] = make_float2(vr[k], vi[k]); xs[4352 + k] = make_float2(0.f, 0.f); }
    __syncthreads();
    fft_fwd(X, TW, tid);
    fft_mul_spec(X, HSPEC + (size_t)c * 8192, tid);
    __syncthreads();
    fft_inv(X, TW, tid);
    { const bf16_t* p0 = u0 + (size_t)512 * SEQ; const bf16_t* p1 = u1 + (size_t)512 * SEQ;
      float xr[8], xi[8]; { const u32x4 a0 = *(const u32x4*)p0, c0 = *(const u32x4*)p1; unpack8(a0, xr); unpack8(c0, xi); }
#pragma unroll
      for (int k = 0; k < 8; ++k) { const float2 cv = xs[k]; const float zr = xr[k] * (cv.x + bias0 * vr[k]), zi = xi[k] * (cv.y + bias0 * vi[k]);
          vr[k] = zr; vi[k] = zi; xs[k] = make_float2(zr, zi); xs[4352 + k] = make_float2(0.f, 0.f); } }
    __syncthreads();
    fft_fwd(X, TW, tid);
    fft_mul_spec(X, HSPEC + (size_t)(512 + c) * 8192, tid);
    __syncthreads();
    fft_inv(X, TW, tid);
    { const bf16_t* p0 = u0 + (size_t)1024 * SEQ; const bf16_t* p1 = u1 + (size_t)1024 * SEQ;
      float xr[8], xi[8]; { const u32x4 a0 = *(const u32x4*)p0, c0 = *(const u32x4*)p1; unpack8(a0, xr); unpack8(c0, xi); }
      float yr[8], yi[8];
#pragma unroll
      for (int k = 0; k < 8; ++k) { const float2 cv = xs[k]; yr[k] = xr[k] * (cv.x + bias1 * vr[k]); yi[k] = xi[k] * (cv.y + bias1 * vi[k]); }
      bf16_t* y0 = YT + (size_t)(b0 * 512 + c) * SEQ + tid * 8; bf16_t* y1 = YT + (size_t)(b1 * 512 + c) * SEQ + tid * 8;
      { u32x4 w; w.x = pk2(yr[0], yr[1]); w.y = pk2(yr[2], yr[3]); w.z = pk2(yr[4], yr[5]); w.w = pk2(yr[6], yr[7]); *(u32x4*)y0 = w; }
      { u32x4 w; w.x = pk2(yi[0], yi[1]); w.y = pk2(yi[2], yi[3]); w.z = pk2(yi[4], yi[5]); w.w = pk2(yi[6], yi[7]); *(u32x4*)y1 = w; } }
}

constexpr size_t al256(size_t x) { return (x + 255) & ~(size_t)255; }
constexpr size_t O_BAR = 0;
constexpr size_t O_MOD = 16384;
constexpr size_t O_NORM = O_MOD + al256((size_t)2 * 5 * 6 * DM * 4);
constexpr size_t O_QCTR = O_NORM + al256((size_t)2 * 2 * 1024 * 4);
constexpr size_t O_ZERO_END = O_QCTR + 512;
constexpr size_t O_XS = O_ZERO_END;
constexpr size_t O_HB = O_XS + al256((size_t)NTOK * DM * 4);
constexpr size_t O_P = O_HB + al256((size_t)NTOK * DM * 2);
constexpr size_t O_WIN = O_P + al256((size_t)NTOK * LDP * 2);
constexpr size_t O_WBR = O_WIN + al256((size_t)LDP * DM * 2);
constexpr size_t O_WOUT = O_WBR + al256((size_t)4 * DM * BW * 2);
constexpr size_t O_WGU = O_WOUT + al256((size_t)DM * DM * 2);
constexpr size_t O_WD = O_WGU + al256((size_t)NEXP * 2 * DEXP * DM * 2);
constexpr size_t O_GLU = O_WD + al256((size_t)NEXP * DM * DEXP * 2);
constexpr size_t O_Y4 = O_GLU + al256((size_t)BW * BW * 2);
constexpr size_t O_U = O_Y4 + al256((size_t)NTOK * DM * 2);
constexpr size_t O_QKB = O_U + al256((size_t)NTOK * 1536 * 4);
constexpr size_t O_CST = O_QKB + al256((size_t)NTOK * 1024 * 2);
constexpr size_t O_NST = O_CST + al256((size_t)32 * 68 * 128 * 128 * 2);
constexpr size_t O_MST = O_NST + al256((size_t)32 * 68 * 128 * 4);
constexpr size_t O_XBC = O_MST + al256((size_t)32 * 68 * 4);
constexpr size_t O_SST = O_XBC + al256((size_t)NTOK * 1024 * 2);
constexpr size_t O_HF = O_SST + al256((size_t)64 * 68 * 64 * 128 * 2);
constexpr size_t O_YF = O_HF + al256((size_t)2 * NTOK * BW * 4);
constexpr size_t O_SF = O_YF + al256((size_t)2 * NTOK * BW * 4);
constexpr size_t O_LDT = O_SF + al256((size_t)2 * NCTX * BW * 4);
constexpr size_t O_AP = O_LDT + al256((size_t)4096 * 16);
constexpr size_t O_BBT = O_AP + al256((size_t)4096 * 33 * 8);
constexpr size_t O_KT = O_BBT + al256((size_t)4096 * 16 * 8);
constexpr size_t O_S5A = O_KT + al256((size_t)32 * 2 * 32 * 256 * 4);
constexpr size_t O_S5B = O_S5A + al256((size_t)32 * 512 * 768 * 2);
constexpr size_t O_XCTX = O_S5B + al256((size_t)32 * 512 * 768 * 2);
constexpr size_t O_Z = O_XCTX + al256((size_t)4 * 32 * 2 * 64 * 8);
constexpr size_t O_HRAW = O_Z + al256((size_t)NTOK * BW * 4);
constexpr size_t O_HSPEC = O_HRAW + al256((size_t)(SEQ + CTXL) * 2048 * 4);
constexpr size_t O_K2C = O_HSPEC + al256((size_t)1024 * 8192 * 8);
constexpr size_t O_GG = O_K2C + al256((size_t)(2 * CTXL) * 1024 * 4);
constexpr size_t O_PROBS = O_GG + al256((size_t)NTOK * BW * 2);
constexpr size_t O_ROWTOK = O_PROBS + al256((size_t)NTOK * 16 * 4);
constexpr size_t O_ROWGATE = O_ROWTOK + al256((size_t)NEXP * MOE_PAD * 4);
constexpr size_t O_INV = O_ROWGATE + al256((size_t)NEXP * MOE_PAD * 4);
constexpr size_t O_NORMP = O_INV + al256((size_t)NTOK * 16 * 4);
constexpr size_t WS_END = O_NORMP + al256((size_t)4 * 256 * 2048 * 4);
constexpr size_t O_XG = O_P;
constexpr size_t O_HID = O_P + al256((size_t)NEXP * MOE_PAD * DM * 2);
constexpr size_t O_YEXP = O_HID + al256((size_t)NEXP * MOE_PAD * DEXP * 2);
static_assert(O_YEXP + (size_t)NEXP * MOE_PAD * DM * 2 <= O_WIN, "MoE temporaries must fit inside P");
static_assert((size_t)NTOK * DM * 2 <= (size_t)NTOK * 1536 * 4, "ACCb must fit inside U");
static_assert((size_t)26214400 + (size_t)2 * 17825792 + (size_t)272 * 256 * 64 * 2 <= (size_t)NTOK * DM * 2, "strip buffers must fit inside HB");
static_assert(WS_END <= (size_t)1851000000, "workspace map exceeds the guaranteed size");

struct Args {
    const float* in[47];
    float* out; unsigned char* ws;
    int ph_lo, ph_hi;
};

__device__ __forceinline__ void conv_tile(const float* __restrict__ src, int ldsrc, int nvalid, int k0, int n0, bf16_t* __restrict__ dst, int lddst, int mode, float* T, int tid) {
    { const int n = tid & 63, kr = tid >> 6;
#pragma unroll
      for (int i = 0; i < 8; ++i) { const int k = i * 8 + kr; T[k * 65 + n] = (n0 + n < nvalid) ? src[(size_t)(k0 + k) * ldsrc + n0 + n] : 0.f; } }
    __syncthreads();
    { const int n = tid >> 3, kc = (tid & 7) * 8; const int gn = n0 + n;
      const int drow = mode == 0 ? gn : (32 * (gn >> 4) + (mode == 2 ? 16 : 0) + (gn & 15));
      u32x4 w; w.x = pk2(T[(kc + 0) * 65 + n], T[(kc + 1) * 65 + n]); w.y = pk2(T[(kc + 2) * 65 + n], T[(kc + 3) * 65 + n]);
      w.z = pk2(T[(kc + 4) * 65 + n], T[(kc + 5) * 65 + n]); w.w = pk2(T[(kc + 6) * 65 + n], T[(kc + 7) * 65 + n]);
      *(u32x4*)(dst + (size_t)drow * lddst + k0 + kc) = w; }
    __syncthreads();
}

#define IN(id) (lo <= (id) && (id) < hi)
#define SEAM(id) do { if (hi > (id) + 1) xcd_barrier(bar); } while (0)
#define PH_BEGIN int tid = threadIdx.x; asm volatile("" : "+v"(tid) :: "memory"); const int lane = tid & 63, wave = tid >> 6; (void)lane; (void)wave;

#define x_in (PT(0))
#define c_in (PT(1))
#define ctx_in (PT(2))
#define cctx_in (PT(3))
#define ada_w (PT(4))
#define ada_b (PT(5))
#define norm_mix (PT(6))
#define norm_ffn (PT(7))
#define w_in (PT(8))
#define XS ((float*)(a.ws + O_XS))
#define MOD ((float*)(a.ws + O_MOD))
#define NORM ((float*)(a.ws + O_NORM))
#define NORMP ((float*)(a.ws + O_NORMP))
#define MODl (MOD + (size_t)l * 5 * 6 * DM)
#define HB ((bf16_t*)(a.ws + O_HB))
#define P ((bf16_t*)(a.ws + O_P))
#define WIN ((bf16_t*)(a.ws + O_WIN))
#define WBR ((bf16_t*)(a.ws + O_WBR))
#define WOUT ((bf16_t*)(a.ws + O_WOUT))
#define WGU ((bf16_t*)(a.ws + O_WGU))
#define WD ((bf16_t*)(a.ws + O_WD))
#define GLU ((bf16_t*)(a.ws + O_GLU))
#define Y4 ((bf16_t*)(a.ws + O_Y4))
#define U ((float*)(a.ws + O_U))
#define ACCb ((bf16_t*)(a.ws + O_U))
#define QKB ((bf16_t*)(a.ws + O_QKB))
#define CST ((bf16_t*)(a.ws + O_CST))
#define NST ((float*)(a.ws + O_NST))
#define MST ((float*)(a.ws + O_MST))
#define XBC ((bf16_t*)(a.ws + O_XBC))
#define SSTB ((bf16_t*)(a.ws + O_SST))
#define HF ((bf16_t*)(a.ws + O_HF))
#define HBk (HF + (size_t)NTOK * BW)
#define YF ((bf16_t*)(a.ws + O_YF))
#define YB (YF + (size_t)NTOK * BW)
#define SF ((float*)(a.ws + O_SF))
#define SB (SF + (size_t)NCTX * BW)
#define LDT ((double2*)(a.ws + O_LDT))
#define APW ((float2*)(a.ws + O_AP))
#define BBT ((float2*)(a.ws + O_BBT))
#define KTB ((float*)(a.ws + O_KT))
#define S5A ((bf16_t*)(a.ws + O_S5A))
#define S5B ((bf16_t*)(a.ws + O_S5B))
#define XCTX ((float2*)(a.ws + O_XCTX))
#define S5P ((bf16_t*)(a.ws + O_HB))
#define XLOC ((float*)(a.ws + O_HB + (size_t)32 * 256 * 512 * 2))
#define KTG ((bf16_t*)(a.ws + O_HB + (size_t)26214400))
#define VTG ((bf16_t*)(a.ws + O_HB + (size_t)26214400 + (size_t)17825792))
#define BTG ((bf16_t*)(a.ws + O_HB + (size_t)26214400 + (size_t)2 * 17825792))
#define XTG ((bf16_t*)(a.ws + O_GG))
#define Z ((float*)(a.ws + O_Z))
#define HRAW ((float*)(a.ws + O_HRAW))
#define HSPEC ((float2*)(a.ws + O_HSPEC))
#define UT ((bf16_t*)(a.ws + O_U))
#define YT ((bf16_t*)(a.ws + O_Z))
#define QCTR ((int*)(a.ws + O_QCTR))
#define K2C ((float*)(a.ws + O_K2C))
#define GG ((bf16_t*)(a.ws + O_GG))
#define PROBS ((float*)(a.ws + O_PROBS))
#define ROWTOK ((int*)(a.ws + O_ROWTOK))
#define ROWGATE ((float*)(a.ws + O_ROWGATE))
#define XG ((bf16_t*)(a.ws + O_XG))
#define HID ((bf16_t*)(a.ws + O_HID))
#define YEXP ((bf16_t*)(a.ws + O_YEXP))
#define INV ((int*)(a.ws + O_INV))


__device__ __forceinline__ void moe_pair(float4 (&a)[8], const int r1, const int r2, const float g2scale, const int lane, const float* __restrict__ rowgate, const bf16_t* __restrict__ yexp) {
    const float gt1 = rowgate[r1], gt2 = rowgate[r2] * g2scale;
    const bf16_t* y1 = yexp + (size_t)r1 * DM + lane * 4; const bf16_t* y2 = yexp + (size_t)r2 * DM + lane * 4;
    u32x2 w1[8], w2[8];
#pragma unroll
    for (int i = 0; i < 8; ++i) { w1[i] = *(const u32x2*)(y1 + i * 256); w2[i] = *(const u32x2*)(y2 + i * 256); }
#pragma unroll
    for (int i = 0; i < 8; ++i) {
        a[i].x += gt1 * __uint_as_float(w1[i].x << 16); a[i].y += gt1 * __uint_as_float(w1[i].x & 0xFFFF0000u); a[i].z += gt1 * __uint_as_float(w1[i].y << 16); a[i].w += gt1 * __uint_as_float(w1[i].y & 0xFFFF0000u);
        a[i].x += gt2 * __uint_as_float(w2[i].x << 16); a[i].y += gt2 * __uint_as_float(w2[i].x & 0xFFFF0000u); a[i].z += gt2 * __uint_as_float(w2[i].y << 16); a[i].w += gt2 * __uint_as_float(w2[i].y & 0xFFFF0000u); }
}
__device__ __forceinline__ void moe_combine(float4 (&v)[8], const int tok, const int lane, const int* __restrict__ inv, const float* __restrict__ rowgate, const bf16_t* __restrict__ yexp, const float* __restrict__ m5) {
    float4 a[8], mm[8];
#pragma unroll
    for (int i = 0; i < 8; ++i) { a[i] = make_float4(0.f, 0.f, 0.f, 0.f); mm[i] = *(const float4*)(m5 + i * 256 + lane * 4); }
    const int4* ip = (const int4*)(inv + (size_t)tok * 16);
    const int4 q0 = ip[0], q1 = ip[1], q2 = ip[2], q3 = ip[3];
    const int rows[16] = {q0.x, q0.y, q0.z, q0.w, q1.x, q1.y, q1.z, q1.w, q2.x, q2.y, q2.z, q2.w, q3.x, q3.y, q3.z, q3.w};
    int prow = -1;
#pragma unroll
    for (int e = 0; e < 16; ++e) { const int row = __builtin_amdgcn_readfirstlane(rows[e]);
        if (row >= 0) { if (prow >= 0) { moe_pair(a, prow, row, 1.0f, lane, rowgate, yexp); prow = -1; } else prow = row; } }
    if (prow >= 0) moe_pair(a, prow, prow, 0.0f, lane, rowgate, yexp);
#pragma unroll
    for (int i = 0; i < 8; ++i) { v[i].x += mm[i].x * a[i].x; v[i].y += mm[i].y * a[i].y; v[i].z += mm[i].z * a[i].z; v[i].w += mm[i].w * a[i].w; }
}
struct CvU { const float* src; bf16_t* dst; int ldsrc, nvalid, k0, n0, lddst, mode; };
__device__ __forceinline__ void cv_load(const CvU& u, float4 (&r)[8], const int tid) {
#pragma unroll
    for (int i = 0; i < 8; ++i) { const int idx = tid + i * 512; const int k = idx >> 6, n = u.n0 + (idx & 63) * 4;
        r[i] = (n < u.nvalid) ? *(const float4*)(u.src + (size_t)(u.k0 + k) * u.ldsrc + n) : make_float4(0.f, 0.f, 0.f, 0.f); }
}
__device__ __forceinline__ void cv_stage(float* T, const float4 (&r)[8], const int tid) {
#pragma unroll
    for (int i = 0; i < 8; ++i) { const int idx = tid + i * 512; float* p = T + (idx >> 6) * 257 + (idx & 63) * 4; p[0] = r[i].x; p[1] = r[i].y; p[2] = r[i].z; p[3] = r[i].w; }
}
__device__ __forceinline__ void cv_store(const CvU& u, const float* T, const int tid) {
#pragma unroll
    for (int j = 0; j < 4; ++j) { const int o = tid + j * 512; const int kc = (o & 7) * 8, n = o >> 3; const int gn = u.n0 + n;
        int drow = u.mode == 0 ? gn : (256 * (gn >> 7) + (u.mode == 2 ? 128 : 0) + (gn & 127));
        if (u.mode == 3) {
            if (gn >= IN_W) continue;
            drow = gn;
            if (gn >= GATE_OFF) { const int g = gn - GATE_OFF, kb = g >> 11, col = g & 2047, j2 = col >> 6, rem = col & 63;
                drow = GATE2 + 256 * j2 + 128 * (kb >> 1) + 32 * (rem >> 4) + 8 * ((rem >> 2) & 3) + 4 * (kb & 1) + (rem & 3); } }
        const float* t = T + kc * 257 + n;
        u32x4 w; w.x = pk2(t[0], t[257]); w.y = pk2(t[2 * 257], t[3 * 257]); w.z = pk2(t[4 * 257], t[5 * 257]); w.w = pk2(t[6 * 257], t[7 * 257]);
        *(u32x4*)(u.dst + (size_t)drow * u.lddst + u.k0 + kc) = w; }
}
#define CV_RUN(LL, QSTART, QSTEP, QEND) do { \
                const float* wbr = PT(40) + (size_t)(LL) * 4 * BW * DM; const float* wout = PT(41) + (size_t)(LL) * DM * DM; \
                const float* wg = PT(43) + (size_t)(LL) * NEXP * DM * DEXP; const float* wu = PT(44) + (size_t)(LL) * NEXP * DM * DEXP; const float* wd = PT(45) + (size_t)(LL) * NEXP * DEXP * DM; \
                const float* wglu = PT(32) + (size_t)(LL) * BW * BW; const float* win = w_in + (size_t)(LL) * DM * IN_W; \
                const int cv_step = (QSTEP), cv_end = (QEND); \
                __syncthreads(); \
                int q = (QSTART); int buf = 0; CvU u; float4 r[8]; \
                if (q < cv_end) { CV_DECODE(q, u); cv_load(u, r, tid); } \
                while (q < cv_end) { \
                    float* T = sf + buf * (64 * 257); \
                    cv_stage(T, r, tid); \
                    __syncthreads(); \
                    const CvU cur = u; const int qn = q + cv_step; \
                    if (qn < cv_end) { CV_DECODE(qn, u); cv_load(u, r, tid); } \
                    cv_store(cur, T, tid); \
                    buf ^= 1; q = qn; \
                } \
                __syncthreads(); } while (0)
#define CV_DECODE(q_, u_) do { int qq_ = (q_); \
                    if (qq_ < n_win) { u_ = CvU{win, WIN, IN_W, IN_W, (qq_ / 55) * 64, (qq_ % 55) * 256, DM, 3}; } else { qq_ -= n_win; \
                    if (qq_ < n_br) { const int k = qq_ >> 6, r = qq_ & 63; u_ = CvU{wbr + (size_t)k * BW * DM, WBR + (size_t)k * DM * BW, DM, DM, (r >> 3) * 64, (r & 7) * 256, BW, 0}; } else { qq_ -= n_br; \
                    if (qq_ < n_out) { u_ = CvU{wout, WOUT, DM, DM, (qq_ >> 3) * 64, (qq_ & 7) * 256, DM, 0}; } else { qq_ -= n_out; \
                    if (qq_ < n_glu) { u_ = CvU{wglu, GLU, BW, BW, (qq_ >> 1) * 64, (qq_ & 1) * 256, BW, 0}; } else { qq_ -= n_glu; \
                    if (qq_ < n_gu) { const int e = qq_ / 384, r = qq_ % 384, up = r / 192, r2 = r % 192; u_ = CvU{(up ? wu : wg) + (size_t)e * DM * DEXP, WGU + (size_t)e * 2 * DEXP * DM, DEXP, DEXP, (r2 / 6) * 64, (r2 % 6) * 256, DM, 1 + up}; } else { qq_ -= n_gu; \
                    { const int e = qq_ / 192, r = qq_ % 192; u_ = CvU{wd + (size_t)e * DEXP * DM, WD + (size_t)e * DM * DEXP, DM, DM, (r >> 3) * 64, (r & 7) * 256, DEXP, 0}; } } } } } } } while (0)
template <int LAYER>
__device__ __forceinline__ void layer_body(const Args& a, const XcdBarrier& bar, const int lo, const int hi, const int bid, const int G, unsigned char* const shm, float* const sf, const float** const ptab) {
        constexpr int l = LAYER;
        constexpr int PB = 1 + 16 * l;
        const bool lastl = (l == 1);

        const int nPanels = lastl ? 64 : 68;
        const int M2 = nPanels * 256;

        if (IN(PB + 0)) for (int rep_ = 0; rep_ < (l == 0 ? PROBE_REPS(0) : 1); ++rep_) {
            PH_BEGIN
            {   const int n_win = 32 * 55, n_br = 4 * 64, n_out = 32 * 8, n_glu = 16, n_gu = 16 * 2 * 192, n_d = 16 * 192;
                const int n_grp1 = n_win + n_br + n_out + n_glu, total = n_grp1 + n_gu + n_d;
                const int q_lo = (l > 0 && G > 128) ? n_win : 0;
                const int q_hi = (lastl && G > 64) ? n_grp1 + n_gu - 1536 : total;
                CV_RUN(l, q_lo + bid, G, q_hi);
                for (int i = bid * NTHR + tid; i < (GATE2 - GATE_OFF) * DM / 8; i += G * NTHR) ((u32x4*)(WIN + (size_t)GATE_OFF * DM))[i] = (u32x4){0u, 0u, 0u, 0u};
            }
            for (int set = 0; set < (lastl ? 1 : 2); ++set) {
                const int L = set ? CTXL : SEQ; float* HR = HRAW + (set ? (size_t)SEQ * 2048 : 0);
                const float* w1 = PT(11) + l * 33 * 64; const float* b1 = PT(12) + l * 64; const float* fr1 = PT(13) + l * 64; const float* w2 = PT(14) + l * 64 * 64; const float* b2 = PT(15) + l * 64;
                const float* fr2 = PT(16) + l * 64; const float* w3 = PT(17) + l * 64 * 2048; const float* decay = PT(18) + l * 2048;
                float* feats = sf; float* h1 = sf + 16 * 33; float* h2 = h1 + 16 * 64;
                float nacc[4] = {0.f, 0.f, 0.f, 0.f};
                for (int base = bid; base < L; base += 16 * G) {
                    __syncthreads();
                    for (int e = tid; e < 16 * 33; e += NTHR) { const int ti = e / 33, fi = e % 33; int t = base + ti * G; if (t > L - 1) t = L - 1;
                        float v;
                        if (fi == 0) v = (float)t / (float)(L - 1);
                        else { const int j = (fi - 1) & 15; const double fr = 1e-4 + (double)j * ((15.0 - 1e-4) / 15.0); const double ang = (2.0 * 3.14159265358979323846 / (double)L) * (double)t * fr; v = fi <= 16 ? (float)cos(ang) : (float)(-sin(ang)); }
                        feats[e] = v; }
                    __syncthreads();
                    { const int j = tid & 63, ti = tid >> 6; float s0 = b1[j], s1 = s0;
_Pragma("unroll 3")
                      for (int i = 0; i < 33; ++i) { const float wv = w1[i * 64 + j]; s0 += feats[ti * 33 + i] * wv; s1 += feats[(ti + 8) * 33 + i] * wv; }
                      const float f1 = fr1[j]; h1[ti * 64 + j] = sinf(f1 * s0); h1[(ti + 8) * 64 + j] = sinf(f1 * s1); }
                    __syncthreads();
                    { const int j = tid & 63, ti = tid >> 6; float s0 = b2[j], s1 = s0;
_Pragma("unroll 4")
                      for (int i = 0; i < 64; ++i) { const float wv = w2[i * 64 + j]; s0 += h1[ti * 64 + i] * wv; s1 += h1[(ti + 8) * 64 + i] * wv; }
                      const float f2 = fr2[j]; h2[ti * 64 + j] = sinf(f2 * s0); h2[(ti + 8) * 64 + j] = sinf(f2 * s1); }
                    __syncthreads();
                    float acc[16][4];
#pragma unroll
                    for (int ti = 0; ti < 16; ++ti) { acc[ti][0] = 0.f; acc[ti][1] = 0.f; acc[ti][2] = 0.f; acc[ti][3] = 0.f; }
#pragma unroll 2
                    for (int i = 0; i < 64; ++i) { const float* wrow = w3 + (size_t)i * 2048 + tid; const float wa = wrow[0], wb = wrow[512], wc2 = wrow[1024], wd2 = wrow[1536];
#pragma unroll
                        for (int ti = 0; ti < 16; ++ti) { const float hv = h2[ti * 64 + i]; acc[ti][0] += hv * wa; acc[ti][1] += hv * wb; acc[ti][2] += hv * wc2; acc[ti][3] += hv * wd2; } }
                    float dk[4];
#pragma unroll
                    for (int k = 0; k < 4; ++k) dk[k] = fabsf(decay[tid + k * 512]);
#pragma unroll
                    for (int ti = 0; ti < 16; ++ti) { const int t = base + ti * G; if (t < L) { const float tn = (float)t / (float)(L - 1);
#pragma unroll
                        for (int k = 0; k < 4; ++k) { const float v = acc[ti][k] * expf(-tn * dk[k]); HR[(size_t)t * 2048 + tid + k * 512] = v; nacc[k] += fabsf(v); } } }
                }
                float* nrp = NORMP + ((size_t)(l * 2 + set) * 256 + bid) * 2048;
#pragma unroll
                for (int k = 0; k < 4; ++k) nrp[tid + k * 512] = nacc[k];
            }
            for (int idx = bid * NTHR + tid; idx < 4096; idx += G * NTHR) { const int n = idx & 63, g = (idx >> 6) & 31, dir = idx >> 11;
                const double are = (double)(PT(24) + l * 4096)[idx], aim = (double)(PT(25) + l * 4096)[idx]; const double lam = are < -1e-4 ? are : -1e-4; const double dt = exp((double)(PT(26) + l * 64)[dir * 32 + g]);
                const double ldre = lam * dt, ldim = aim * dt; LDT[idx] = make_double2(ldre, ldim);
                const double mag = exp(ldre); const double ar = mag * cos(ldim), ai = mag * sin(ldim);
                const double den = lam * lam + aim * aim; const double nr = ar - 1.0, ni = ai; const double fre = (nr * lam + ni * aim) / den, fim = (ni * lam - nr * aim) / den;
                const float* b_re = PT(27) + l * 32 * 64 * 16; const float* b_im = PT(28) + l * 32 * 64 * 16;
#pragma unroll 4
                for (int c = 0; c < 16; ++c) { const double br = (double)b_re[(g * 64 + n) * 16 + c], bi = (double)b_im[(g * 64 + n) * 16 + c]; BBT[idx * 16 + c] = make_float2((float)(fre * br - fim * bi), (float)(fre * bi + fim * br)); }
            }
            for (int e2 = bid * NTHR + tid; e2 < 4096 * 33; e2 += G * NTHR) { const int idx = e2 / 33, k = e2 - idx * 33; const int g = (idx >> 6) & 31, dir = idx >> 11;
                const double are = (double)(PT(24) + l * 4096)[idx], aim = (double)(PT(25) + l * 4096)[idx]; const double lam = are < -1e-4 ? are : -1e-4; const double dt = exp((double)(PT(26) + l * 64)[dir * 32 + g]);
                const double ldre = lam * dt, ldim = aim * dt; const double mk = exp(ldre * k); APW[e2] = make_float2((float)(mk * cos(ldim * k)), (float)(mk * sin(ldim * k))); }
            if (l == 0 && lo == 0) xcd_barrier(bar);
            for (int tok = bid * 8 + wave; tok < NTOK; tok += G * 8) {
                const int r = tok < NLAT ? tok / SEQ : 4; const float* xr = l == 0 ? (tok < NLAT ? x_in + (size_t)tok * DM : ctx_in + (size_t)(tok - NLAT) * DM) : XS + (size_t)tok * DM; const float* gn = norm_mix + l * DM;
                const float* sh = MODl + (size_t)(r * 6 + 0) * DM; const float* sc = MODl + (size_t)(r * 6 + 1) * DM;
                float4 v[8]; float ss = 0.f;
#pragma unroll
                for (int i = 0; i < 8; ++i) v[i] = *(const float4*)(xr + i * 256 + lane * 4);
                if (l > 0) {
                    moe_combine(v, tok, lane, INV, ROWGATE, YEXP, MOD + (size_t)((l - 1) * 5 + r) * 6 * DM + 5 * DM);
#pragma unroll
                    for (int i = 0; i < 8; ++i) *(float4*)(XS + (size_t)tok * DM + i * 256 + lane * 4) = v[i]; }
#pragma unroll
                for (int i = 0; i < 8; ++i) ss += v[i].x * v[i].x + v[i].y * v[i].y + v[i].z * v[i].z + v[i].w * v[i].w;
                ss = wave_sum(ss); const float rs = rsqrtf(ss * (1.0f / DM) + 1e-6f);
#pragma unroll
                for (int i = 0; i < 8; ++i) { const int d = i * 256 + lane * 4; const float4 g4 = *(const float4*)(gn + d), s4 = *(const float4*)(sc + d), h4 = *(const float4*)(sh + d);
                    v[i].x = v[i].x * rs * g4.x * (1.f + s4.x) + h4.x; v[i].y = v[i].y * rs * g4.y * (1.f + s4.y) + h4.y; v[i].z = v[i].z * rs * g4.z * (1.f + s4.z) + h4.z; v[i].w = v[i].w * rs * g4.w * (1.f + s4.w) + h4.w; }
#pragma unroll
                for (int i = 0; i < 8; ++i) { u32x2 w; w.x = pk2(v[i].x, v[i].y); w.y = pk2(v[i].z, v[i].w); *(u32x2*)(HB + (size_t)tok * DM + i * 256 + lane * 4) = w; }
            }
            SEAM(PB + 0);
        }

        if (IN(PB + 1)) for (int rep_ = 0; rep_ < PROBE_REPS(1); ++rep_) {
            PH_BEGIN
            for (int base = bid * 8; base < (lastl ? 1 : 2) * 1024; base += G * 8) {
                const int idx = base + (tid & 7), sl = tid >> 3; const int set = idx >> 10, oc = idx & 1023, o = oc >> 9, c = oc & 511;
                const float* pp = NORMP + (size_t)(l * 2 + set) * 256 * 2048 + o * 1024 + c + (size_t)(sl * 4) * 2048; float sacc = 0.f;
#pragma unroll
                for (int j = 0; j < 4; ++j) { const float p0 = pp[(size_t)j * 2048], p1 = pp[(size_t)j * 2048 + 512]; sacc += (sl * 4 + j < G) ? p0 + p1 : 0.f; }
                sf[sl * 8 + (tid & 7)] = sacc; __syncthreads();
                if (tid < 8) { float t = 0.f;
#pragma unroll 8
                    for (int q = 0; q < 64; ++q) t += sf[q * 8 + tid];
                    NORM[(size_t)(l * 2 + set) * 1024 + oc] = t; }
                __syncthreads(); }
            for (int idx = (G - 1 - bid) * NTHR + tid; idx < 32768; idx += G * NTHR) { const int c = idx & 15, lag = (idx >> 4) & 31, dir = (idx >> 9) & 1, g = idx >> 10;
                const float* c_re = PT(29) + l * 32 * 16 * 64 + (g * 16 + c) * 64; const float* c_im = PT(30) + l * 32 * 16 * 64 + (g * 16 + c) * 64;
                float acc[16];
#pragma unroll
                for (int j = 0; j < 16; ++j) acc[j] = 0.f;
#pragma unroll 2
                for (int n = 0; n < 64; ++n) { const int pi = (dir * 32 + g) * 64 + n; const float2 ap = APW[pi * 33 + lag]; const float cr = c_re[n], ci = c_im[n]; const float wr_ = cr * ap.x - ci * ap.y, wi_ = cr * ap.y + ci * ap.x;
                    const float4* bb = (const float4*)(BBT + pi * 16);
#pragma unroll
                    for (int j = 0; j < 8; ++j) { const float4 b2 = bb[j]; acc[2 * j] += wr_ * b2.x - wi_ * b2.y; acc[2 * j + 1] += wr_ * b2.z - wi_ * b2.w; } }
                float4* o = (float4*)(KTB + (size_t)idx * 16);
                o[0] = make_float4(acc[0], acc[1], acc[2], acc[3]); o[1] = make_float4(acc[4], acc[5], acc[6], acc[7]); o[2] = make_float4(acc[8], acc[9], acc[10], acc[11]); o[3] = make_float4(acc[12], acc[13], acc[14], acc[15]);
            }
            __syncthreads();
            pg8::Gemm g{HB, WIN, DM, DM, DM}; pg8::SchedStd S{68, 55, G, bid, DM, DM}; pg8::EpiWin E{P, LDP};
            pg8::gemm_phase(( LAS unsigned char*)shm, g, S, E);
#if defined(PROBE_BNOEPI)
            { __syncthreads(); pg8::EpiNone E0; pg8::gemm_phase((LAS unsigned char*)shm, g, S, E0); }
#endif
            SEAM(PB + 1);
        }

        if (IN(PB + 2)) for (int rep_ = 0; rep_ < PROBE_REPS(2); ++rep_) {
            PH_BEGIN
            const float* hcw = PT(9) + l * 3 * 1536; const float* hcb = PT(10) + l * 1536; const float* mcw = PT(20) + l * 3 * 1024; const float* mcb = PT(21) + l * 1024;
            const float* scw = PT(34) + l * 3 * 1024; const float* scb = PT(35) + l * 1024;
            for (int unit = bid; unit < 272 * 3; unit += G) { const int seg = unit / 3, kind = unit % 3; const bool lat = seg < 256; const size_t tok0 = lat ? (size_t)seg * 64 : (size_t)NLAT + (size_t)(seg - 256) * 64;
                if (kind < 2) { const int hf = kind;
                    const int c = tid * 2; const int col = (hf ? SSD_OFF + 512 : ML_OFF) + c; const float* w = hf ? scw : mcw; const float* bsp = hf ? scb : mcb; bf16_t* dst = (hf ? XBC : QKB) + tok0 * 1024 + c;
                    const float2 w0 = *(const float2*)(w + c), w1 = *(const float2*)(w + 1024 + c), w2 = *(const float2*)(w + 2048 + c), bb = *(const float2*)(bsp + c);
                    const float osc = (!hf && c >= 512) ? 0.08838834764831845f : 1.0f;
                    const bool hasPrev = !lat && ((tok0 - NLAT) & (CTXL - 1)) != 0, hasNext = !lat && (((tok0 - NLAT) + 63) & (CTXL - 1)) != CTXL - 1;
                    bf16_t* strip = nullptr;
                    if (!hf) { if (c >= 512) strip = KTG + ((size_t)seg * 512 + (c - 512)) * 64; }
                    else { if (c < 512) strip = XTG + ((size_t)seg * 512 + c) * 64; else if (c < 768) strip = BTG + ((size_t)seg * 256 + (c - 512)) * 64; }
                    const bf16_t* pp = P + tok0 * LDP + col;
                    unsigned raw[66];
#pragma unroll
                    for (int t = 0; t < 66; ++t) raw[t] = ((t == 0 && !hasPrev) || (t == 65 && !hasNext)) ? 0u : *(const unsigned*)(pp + (ptrdiff_t)(t - 1) * LDP);
#pragma unroll
                    for (int t8 = 0; t8 < 8; ++t8) { float v0[8], v1[8];
#pragma unroll
                        for (int tt = 0; tt < 8; ++tt) { const int t = t8 * 8 + tt; const unsigned p0 = raw[t], p1 = raw[t + 1], p2 = raw[t + 2];
                            float a0 = bb.x + w0.x * __uint_as_float(p0 << 16) + w1.x * __uint_as_float(p1 << 16) + w2.x * __uint_as_float(p2 << 16);
                            float a1 = bb.y + w0.y * __uint_as_float(p0 & 0xFFFF0000u) + w1.y * __uint_as_float(p1 & 0xFFFF0000u) + w2.y * __uint_as_float(p2 & 0xFFFF0000u);
                            a0 = siluf_(a0) * osc; a1 = siluf_(a1) * osc; v0[tt] = a0; v1[tt] = a1;
                            *(unsigned*)(dst + (size_t)t * 1024) = pk2(a0, a1); }
                        if (strip) { u32x4 s0, s1; s0.x = pk2(v0[0], v0[1]); s0.y = pk2(v0[2], v0[3]); s0.z = pk2(v0[4], v0[5]); s0.w = pk2(v0[6], v0[7]); s1.x = pk2(v1[0], v1[1]); s1.y = pk2(v1[2], v1[3]); s1.z = pk2(v1[4], v1[5]); s1.w = pk2(v1[6], v1[7]);
                            *(u32x4*)(strip + t8 * 8) = s0; *(u32x4*)(strip + 64 + t8 * 8) = s1; } }
                } else {
                    const int c = (tid & 255) * 2, th = tid >> 8; const bf16_t* pp = P + (tok0 + th * 32) * LDP + ML_OFF + 1024 + c; bf16_t* strip = VTG + ((size_t)seg * 512 + c) * 64 + th * 32;
                    unsigned rv[32];
#pragma unroll
                    for (int t = 0; t < 32; ++t) rv[t] = *(const unsigned*)(pp + (size_t)t * LDP);
#pragma unroll
                    for (int t8 = 0; t8 < 4; ++t8) { u32x4 s0, s1;
                        s0.x = (rv[t8 * 8 + 0] & 0xFFFFu) | (rv[t8 * 8 + 1] << 16); s0.y = (rv[t8 * 8 + 2] & 0xFFFFu) | (rv[t8 * 8 + 3] << 16); s0.z = (rv[t8 * 8 + 4] & 0xFFFFu) | (rv[t8 * 8 + 5] << 16); s0.w = (rv[t8 * 8 + 6] & 0xFFFFu) | (rv[t8 * 8 + 7] << 16);
                        s1.x = (rv[t8 * 8 + 0] >> 16) | (rv[t8 * 8 + 1] & 0xFFFF0000u); s1.y = (rv[t8 * 8 + 2] >> 16) | (rv[t8 * 8 + 3] & 0xFFFF0000u); s1.z = (rv[t8 * 8 + 4] >> 16) | (rv[t8 * 8 + 5] & 0xFFFF0000u); s1.w = (rv[t8 * 8 + 6] >> 16) | (rv[t8 * 8 + 7] & 0xFFFF0000u);
                        *(u32x4*)(strip + t8 * 8) = s0; *(u32x4*)(strip + 64 + t8 * 8) = s1; }
                }
            }
            if (!lastl) for (int tok = NLAT + bid; tok < NTOK; tok += G) {
                const int t = (tok - NLAT) & (CTXL - 1); const bool hasL = (t != 0), hasR = (t != CTXL - 1); const bf16_t* pr = P + (size_t)tok * LDP;
                const bf16_t* prL = hasL ? pr - LDP : pr; const bf16_t* prR = hasR ? pr + LDP : pr;
                unsigned xc[3], xl[3], xr[3];
#pragma unroll
                for (int j = 0; j < 3; ++j) { const int cc = tid + j * 512; xc[j] = pr[HY_OFF + cc]; xl[j] = prL[HY_OFF + cc]; xr[j] = prR[HY_OFF + cc]; }
#pragma unroll
                for (int j = 0; j < 3; ++j) { const int cc = tid + j * 512;
                    float acc = hcb[cc] + hcw[1536 + cc] * __uint_as_float(xc[j] << 16);
                    acc += hasL ? hcw[cc] * __uint_as_float(xl[j] << 16) : 0.f;
                    acc += hasR ? hcw[2 * 1536 + cc] * __uint_as_float(xr[j] << 16) : 0.f;
                    U[(size_t)tok * 1536 + cc] = acc; }
            }
            for (int idx0 = bid * NTHR + tid; idx0 < 16384 * 64; idx0 += 4 * G * NTHR) { u32x4 t4[4];
#pragma unroll
                for (int q = 0; q < 4; ++q) { const int idx = idx0 + q * G * NTHR; const int half = idx & 1, g = (idx >> 1) & 31, tok = idx >> 6;
                    if (idx < 16384 * 64) t4[q] = *(const u32x4*)(P + (size_t)tok * LDP + S5_OFF + g * 16 + half * 8); }
#pragma unroll
                for (int q = 0; q < 4; ++q) { const int idx = idx0 + q * G * NTHR; const int half = idx & 1, g = (idx >> 1) & 31, tok = idx >> 6;
                    if (idx < 16384 * 64) *(u32x4*)(S5A + ((size_t)g * 512 + (tok >> 5)) * 768 + (tok & 31) * 16 + half * 8) = t4[q]; } }
            for (int idx = bid * NTHR + tid; idx < 32 * 512 * 32 * 2; idx += G * NTHR) { const int half = idx & 1, sI = (idx >> 1) & 31, row = (idx >> 6) & 511, g = idx >> 15; const int t = row >> 4, c = row & 15; const int lag = t - sI;
                float v[8];
                if (lag > 0) { const float4* k4 = (const float4*)(KTB + ((size_t)((g * 2 + 0) * 32 + lag) * 16 + c) * 16 + half * 8); const float4 a0 = k4[0], a1 = k4[1]; v[0] = a0.x; v[1] = a0.y; v[2] = a0.z; v[3] = a0.w; v[4] = a1.x; v[5] = a1.y; v[6] = a1.z; v[7] = a1.w; }
                else if (lag < 0) { const float4* k4 = (const float4*)(KTB + ((size_t)((g * 2 + 1) * 32 - lag) * 16 + c) * 16 + half * 8); const float4 a0 = k4[0], a1 = k4[1]; v[0] = a0.x; v[1] = a0.y; v[2] = a0.z; v[3] = a0.w; v[4] = a1.x; v[5] = a1.y; v[6] = a1.z; v[7] = a1.w; }
                else { const float4* k4 = (const float4*)(KTB + ((size_t)((g * 2 + 0) * 32) * 16 + c) * 16 + half * 8); const float4* q4 = (const float4*)(KTB + ((size_t)((g * 2 + 1) * 32) * 16 + c) * 16 + half * 8); const float4 a0 = k4[0], a1 = k4[1], b0 = q4[0], b1 = q4[1];
                    v[0] = a0.x + b0.x; v[1] = a0.y + b0.y; v[2] = a0.z + b0.z; v[3] = a0.w + b0.w; v[4] = a1.x + b1.x; v[5] = a1.y + b1.y; v[6] = a1.z + b1.z; v[7] = a1.w + b1.w; }
                u32x4 w; w.x = pk2(v[0], v[1]); w.y = pk2(v[2], v[3]); w.z = pk2(v[4], v[5]); w.w = pk2(v[6], v[7]);
                *(u32x4*)(S5B + ((size_t)g * 512 + row) * 768 + sI * 16 + half * 8) = w; }
            for (int idx = bid * NTHR + tid; idx < 32 * 512 * 64; idx += G * NTHR) { const int n = idx & 63, row = (idx >> 6) & 511, g = idx >> 15; const int t = row >> 4, c = row & 15;
                const float cr = (PT(29) + l * 32 * 16 * 64)[(g * 16 + c) * 64 + n], ci = (PT(30) + l * 32 * 16 * 64)[(g * 16 + c) * 64 + n];
                const float2 af = APW[((0 * 32 + g) * 64 + n) * 33 + t + 1], ab = APW[((1 * 32 + g) * 64 + n) * 33 + 32 - t];
                bf16_t* d = S5B + ((size_t)g * 512 + row) * 768 + 512 + 2 * n;
                *(unsigned*)d = pk2(cr * af.x - ci * af.y, -(cr * af.y + ci * af.x)); *(unsigned*)(d + 128) = pk2(cr * ab.x - ci * ab.y, -(cr * ab.y + ci * ab.x)); }
            for (int idx = bid * NTHR + tid; idx < 32 * 2 * 64 * 32; idx += G * NTHR) { const int sI = idx & 31, n = (idx >> 5) & 63, dir = (idx >> 11) & 1, g = idx >> 12; const int pi = (dir * 32 + g) * 64 + n;
                const float2 pw = APW[pi * 33 + (dir ? sI : 31 - sI)]; const float4* bb = (const float4*)(BBT + pi * 16);
                float re[16], im[16];
#pragma unroll
                for (int j = 0; j < 8; ++j) { const float4 b2 = bb[j]; re[2 * j] = pw.x * b2.x - pw.y * b2.y; im[2 * j] = pw.x * b2.y + pw.y * b2.x; re[2 * j + 1] = pw.x * b2.z - pw.y * b2.w; im[2 * j + 1] = pw.x * b2.w + pw.y * b2.z; }
                bf16_t* d = S5P + ((size_t)g * 256 + dir * 128 + 2 * n) * 512 + sI * 16;
                u32x4 w0, w1; w0.x = pk2(re[0], re[1]); w0.y = pk2(re[2], re[3]); w0.z = pk2(re[4], re[5]); w0.w = pk2(re[6], re[7]); w1.x = pk2(re[8], re[9]); w1.y = pk2(re[10], re[11]); w1.z = pk2(re[12], re[13]); w1.w = pk2(re[14], re[15]);
                *(u32x4*)d = w0; *(u32x4*)(d + 8) = w1;
                w0.x = pk2(im[0], im[1]); w0.y = pk2(im[2], im[3]); w0.z = pk2(im[4], im[5]); w0.w = pk2(im[6], im[7]); w1.x = pk2(im[8], im[9]); w1.y = pk2(im[10], im[11]); w1.z = pk2(im[12], im[13]); w1.w = pk2(im[14], im[15]);
                *(u32x4*)(d + 512) = w0; *(u32x4*)(d + 520) = w1; }
            {   float* T0 = sf; float* T1 = sf + 64 * 65;
                const int NU = 4 * 64 * 24; const int cL = tid & 63, tL = tid >> 6, c = tid >> 3, tq = (tid & 7) * 8;
                for (int unit = bid; unit < NU; unit += 2 * G) { const bool has2 = unit + G < NU; const int unit2 = has2 ? unit + G : unit;
                    const int ba = unit / (64 * 24), ra = (unit / 24) % 64, c0a = (unit % 24) * 64; const size_t toka = (size_t)ba * SEQ + ra * 64;
                    const int bb_ = unit2 / (64 * 24), rb = (unit2 / 24) % 64, c0b = (unit2 % 24) * 64; const size_t tokb = (size_t)bb_ * SEQ + rb * 64;
                    unsigned pa[8], pb[8];
#pragma unroll
                    for (int i = 0; i < 8; ++i) { pa[i] = P[(toka + tL + 8 * i) * LDP + HY_OFF + c0a + cL]; pb[i] = P[(tokb + tL + 8 * i) * LDP + HY_OFF + c0b + cL]; }
                    const int cca = c0a + c, ccb = c0b + c;
                    const float w0a = hcw[cca], w1a = hcw[1536 + cca], w2a = hcw[3072 + cca], bia = hcb[cca], w0b = hcw[ccb], w1b = hcw[1536 + ccb], w2b = hcw[3072 + ccb], bib = hcb[ccb];
                    __syncthreads();
#pragma unroll
                    for (int i = 0; i < 8; ++i) { T0[(tL + 8 * i) * 65 + cL] = __uint_as_float(pa[i] << 16); T1[(tL + 8 * i) * 65 + cL] = __uint_as_float(pb[i] << 16); }
                    __syncthreads();
                    {   float o8[8];
#pragma unroll
                        for (int i = 0; i < 8; ++i) { const int t = tq + i; float acc = bia + w1a * T0[t * 65 + c]; if (t > 0) acc += w0a * T0[(t - 1) * 65 + c]; if (t < 63) acc += w2a * T0[(t + 1) * 65 + c]; o8[i] = acc; }
                        u32x4 wv; wv.x = pk2(o8[0], o8[1]); wv.y = pk2(o8[2], o8[3]); wv.z = pk2(o8[4], o8[5]); wv.w = pk2(o8[6], o8[7]);
                        *(u32x4*)(UT + ((size_t)ba * 1536 + cca) * SEQ + ra * 64 + tq) = wv; }
                    if (has2) { float o8[8];
#pragma unroll
                        for (int i = 0; i < 8; ++i) { const int t = tq + i; float acc = bib + w1b * T1[t * 65 + c]; if (t > 0) acc += w0b * T1[(t - 1) * 65 + c]; if (t < 63) acc += w2b * T1[(t + 1) * 65 + c]; o8[i] = acc; }
                        u32x4 wv; wv.x = pk2(o8[0], o8[1]); wv.y = pk2(o8[2], o8[3]); wv.z = pk2(o8[4], o8[5]); wv.w = pk2(o8[6], o8[7]);
                        *(u32x4*)(UT + ((size_t)bb_ * 1536 + ccb) * SEQ + rb * 64 + tq) = wv; }
                } }
            if (!lastl) {
                const int L = CTXL; const float* HR = HRAW + (size_t)SEQ * 2048; float* K2 = K2C; const float* nrm = NORM + (size_t)(l * 2 + 1) * 1024;
                const size_t total = (size_t)(2 * L - 1) * 1024;
                for (size_t i = (size_t)bid * NTHR + tid; i < total; i += (size_t)G * NTHR) { const int j = (int)(i >> 10), oc = (int)(i & 1023), o = oc >> 9, c = oc & 511; const int lag = j - (L - 1);
                    const float v = lag >= 0 ? HR[(size_t)lag * 2048 + o * 1024 + c] : HR[(size_t)(-lag) * 2048 + o * 1024 + 512 + c];
                    K2[((size_t)j * 2 + o) * 512 + c] = v / nrm[oc]; }
            }
            {   __syncthreads(); fft_twiddles((float2*)(shm + FFT_X_BYTES), tid);
                for (int pr = bid; pr < 512; pr += G) hyena_spec_item(pr, HRAW, NORM + (size_t)(l * 2 + 0) * 1024, HSPEC, shm, tid);
                __syncthreads(); }
            SEAM(PB + 2);
        }

        if (IN(PB + 3)) for (int rep_ = 0; rep_ < PROBE_REPS(3); ++rep_) {
            PH_BEGIN
            if (rep_ > 0) { if (bid == 0 && tid == 0) __hip_atomic_store(QCTR + l * 64, 0, __ATOMIC_RELAXED, __HIP_MEMORY_SCOPE_AGENT); xcd_barrier(bar); }
            if (bid < 64) {
                mlstm_state_pass(bid >> 1, bid & 1, P, KTG, VTG, PT(22) + l * 16, CST, NST, MST, shm, tid);
            } else if (bid < 128) {
                { const int ch = bid - 64; const int dir_ = ch & 1, h_ = (ch >> 1) & 7; ssd_state_pass(ch, P, BTG, XTG, -expf(PT(37)[l * 16 + dir_ * 8 + h_]), PT(36)[l * 16 + dir_ * 8 + h_], SSTB, shm, tid); }
            } else if (bid < 160) {
                const int widx = (bid - 128) * 8 + wave; const int dir = widx & 1, g = (widx >> 1) & 31, b = widx >> 6; const int n = lane;
                float2* xb = (float2*)(shm + (size_t)wave * 16640); float2* ctab = xb + 16 * 65;
                const float* a_re = PT(24) + l * 2 * 32 * 64; const float* a_im = PT(25) + l * 2 * 32 * 64; const float* log_dt = PT(26) + l * 64;
                const float* b_re = PT(27) + l * 32 * 64 * 16; const float* b_im = PT(28) + l * 32 * 64 * 16; const float* c_re = PT(29) + l * 32 * 16 * 64; const float* c_im = PT(30) + l * 32 * 16 * 64;
#pragma unroll
                for (int c = 0; c < 16; ++c) ctab[c * 65 + lane] = make_float2(c_re[(g * 16 + c) * 64 + lane], c_im[(g * 16 + c) * 64 + lane]);
                float abr, abi, bbr[16], bbi[16];
                {   const double are = (double)a_re[(dir * 32 + g) * 64 + n], aim = (double)a_im[(dir * 32 + g) * 64 + n];
                    const double lam = are < -1e-4 ? are : -1e-4; const double dt = exp((double)log_dt[dir * 32 + g]);
                    const double mag = exp(lam * dt); const double ar = mag * cos(aim * dt), ai = mag * sin(aim * dt);
                    const double den = lam * lam + aim * aim; const double nr = ar - 1.0, ni = ai;
                    const double fre = (nr * lam + ni * aim) / den, fim = (ni * lam - nr * aim) / den;
                    abr = (float)ar; abi = (float)ai;
#pragma unroll
                    for (int c = 0; c < 16; ++c) { const double br = (double)b_re[(g * 64 + n) * 16 + c], bi = (double)b_im[(g * 64 + n) * 16 + c]; bbr[c] = (float)(fre * br - fim * bi); bbi[c] = (float)(fre * bi + fim * br); }
                }
                float xr = 0.f, xi = 0.f; float* Sout = (dir ? SB : SF) - (size_t)NLAT * BW;
                const int s = lane >> 2, cg = lane & 3;
                for (int i0 = 0; i0 < CTXL; i0 += 16) {
#pragma unroll 4
                    for (int ss = 0; ss < 16; ++ss) {
                        const size_t tok = (size_t)step_tok(b, dir, i0 + ss);
                        const u32x4* up = (const u32x4*)(P + tok * LDP + S5_OFF + g * 16);
                        float t0[8], t1[8]; unpack8(up[0], t0); unpack8(up[1], t1);
                        float bur = 0.f, bui = 0.f;
#pragma unroll
                        for (int c = 0; c < 8; ++c) { bur += t0[c] * bbr[c] + t1[c] * bbr[8 + c]; bui += t0[c] * bbi[c] + t1[c] * bbi[8 + c]; }
                        const float nxr = abr * xr - abi * xi + bur, nxi = abr * xi + abi * xr + bui; xr = nxr; xi = nxi;
                        xb[ss * 65 + lane] = make_float2(xr, xi);
                    }
                    asm volatile("s_waitcnt lgkmcnt(0)" ::: "memory");
                    float y0 = 0.f, y1 = 0.f, y2 = 0.f, y3 = 0.f;
                    for (int nn2 = 0; nn2 < 64; ++nn2) { const float2 xv = xb[s * 65 + nn2];
                        const float2 c0 = ctab[(cg * 4 + 0) * 65 + nn2], c1 = ctab[(cg * 4 + 1) * 65 + nn2], c2 = ctab[(cg * 4 + 2) * 65 + nn2], c3 = ctab[(cg * 4 + 3) * 65 + nn2];
                        y0 += xv.x * c0.x - xv.y * c0.y; y1 += xv.x * c1.x - xv.y * c1.y; y2 += xv.x * c2.x - xv.y * c2.y; y3 += xv.x * c3.x - xv.y * c3.y; }
                    const size_t toks = (size_t)step_tok(b, dir, i0 + s);
                    *(float4*)(Sout + toks * BW + g * 16 + cg * 4) = make_float4(y0, y1, y2, y3);
                    asm volatile("s_waitcnt lgkmcnt(0)" ::: "memory");
                }
                XCTX[((b * 32 + g) * 2 + dir) * 64 + n] = make_float2(xr, xi);
            } else {
                if (bid < 224) {
                    pg8::Gemm gg_{S5A, S5P, 768, 512, 512}; pg8::SchedS5a S_{bid - 160}; pg8::EpiXloc E_{XLOC};
                    pg8::gemm_phase((LAS unsigned char*)shm, gg_, S_, E_);
                    __syncthreads();
                }
                const int nhb = G - 160, hb = bid - 160; const float* bias = PT(19) + l * 1024; const int c = tid;
                const int nitems = lastl ? 0 : 4 * (CTXL / 8);
                for (int it = hb; it < nitems; it += nhb) {
                    int L, tokbase, b, t0; const float* K2;
                    { const int q = it; L = CTXL; tokbase = NLAT; b = q / (CTXL / 8); t0 = (q % (CTXL / 8)) * 8; K2 = K2C; }
                    const float* zb = U + (size_t)(tokbase + b * L) * 1536 + c;
                    float acc[8];
#pragma unroll
                    for (int i = 0; i < 8; ++i) acc[i] = 0.f;
                    const int base = t0 + L - 1;
                    for (int s = 0; s < L; s += 8) {
                        float k[15];
#pragma unroll
                        for (int mm = 0; mm < 15; ++mm) k[mm] = K2[((size_t)(base - s - 7 + mm) * 2 + 0) * 512 + c];
#pragma unroll
                        for (int ds = 0; ds < 8; ++ds) { const float z = zb[(size_t)(s + ds) * 1536];
#pragma unroll
                            for (int i = 0; i < 8; ++i) acc[i] += k[i - ds + 7] * z; }
                    }
#pragma unroll
                    for (int i = 0; i < 8; ++i) { const size_t tok = (size_t)(tokbase + b * L + t0 + i); const float zt = U[tok * 1536 + c]; Z[tok * BW + c] = (acc[i] + bias[c] * zt) * U[tok * 1536 + 512 + c]; }
                }
            }
            {   __syncthreads(); fft_twiddles((float2*)(shm + FFT_X_BYTES), tid);
                int* qslot = (int*)(shm + FFT_X_BYTES + 65536);
                for (;;) { __syncthreads(); if (tid == 0) *qslot = atomicAdd(QCTR + l * 64, 1); __syncthreads(); const int it = *qslot; if (it >= 1024) break;
                    hyena_fft_item(it, UT, HSPEC, PT(19) + l * 1024, YT, shm, tid); }
            }
            SEAM(PB + 3);
        }

        if (IN(PB + 4)) for (int rep_ = 0; rep_ < PROBE_REPS(4); ++rep_) {
            PH_BEGIN
            if (rep_ > 0) { if (bid == 0 && tid == 0) __hip_atomic_store(QCTR + l * 64 + 32, 0, __ATOMIC_RELAXED, __HIP_MEMORY_SCOPE_AGENT); xcd_barrier(bar); }
            if (bid >= G - 32) for (int idx = (bid - (G - 32)) * NTHR + tid; idx < 16384; idx += 32 * NTHR) { const int n = idx & 63, dir = (idx >> 6) & 1, b = (idx >> 7) & 3, g = idx >> 9;
                const float2 a32 = APW[((dir * 32 + g) * 64 + n) * 33 + 32]; float2 X = XCTX[((b * 32 + g) * 2 + dir) * 64 + n];
                const float* __restrict__ xl = XLOC + ((size_t)g * 512 + b * 128) * 256 + dir * 128 + 2 * n; bf16_t* __restrict__ dst = S5A + ((size_t)g * 512 + b * 128) * 768 + 512 + dir * 128 + 2 * n;
#pragma unroll 1
                for (int j0 = 0; j0 < 128; j0 += 16) { float2 xv[16];
#pragma unroll
                    for (int q = 0; q < 16; ++q) { const int j = dir ? 127 - (j0 + q) : j0 + q; xv[q] = *(const float2*)(xl + (size_t)j * 256); }
#pragma unroll
                    for (int q = 0; q < 16; ++q) { const int j = dir ? 127 - (j0 + q) : j0 + q;
                        *(unsigned*)(dst + (size_t)j * 768) = pk2(X.x, X.y);
                        const float nx = a32.x * X.x - a32.y * X.y + xv[q].x, ny = a32.x * X.y + a32.y * X.x + xv[q].y; X.x = nx; X.y = ny; } } }
            {   int* qslot = (int*)(shm + 102400);
                __syncthreads(); if (tid == 0) *qslot = atomicAdd(QCTR + l * 64 + 32, 1); __syncthreads();
                for (;;) { const int it = *qslot; if (it >= 32 * 68 + 64 * 68) break;
                    int nxt_ = 0; if (tid == 0) nxt_ = atomicAdd(QCTR + l * 64 + 32, 1);
                    if (it < 32 * 68) { const int chain = it / 68, c = it % 68; mlstm_out_item(chain, c, P, QKB, VTG, PT(22) + l * 16, CST, NST, MST, (chain & 1) ? HBk : HF, shm, tid); }
                    else { const int i2 = it - 32 * 68; const int chain = i2 / 68, c = i2 % 68; const int dir_ = chain & 1, h_ = (chain >> 1) & 7;
                        ssd_out_item(chain, c, P, XBC, XTG, -expf(PT(37)[l * 16 + dir_ * 8 + h_]), PT(36)[l * 16 + dir_ * 8 + h_], SSTB, dir_ ? YB : YF, shm, tid); }
                    __syncthreads(); if (tid == 0) *qslot = nxt_; __syncthreads(); }
            }
            __syncthreads();
            {   const float* bias = PT(19) + l * 1024 + 512; const int c = tid;
                const int nitems = lastl ? 0 : 4 * (CTXL / 8);
                for (int it = bid; it < nitems; it += G) {
                    int L, tokbase, b, t0; const float* K2;
                    { const int q = it; L = CTXL; tokbase = NLAT; b = q / (CTXL / 8); t0 = (q % (CTXL / 8)) * 8; K2 = K2C; }
                    const float* zb = Z + (size_t)(tokbase + b * L) * BW + c;
                    float acc[8];
#pragma unroll
                    for (int i = 0; i < 8; ++i) acc[i] = 0.f;
                    const int base = t0 + L - 1;
                    for (int s = 0; s < L; s += 8) {
                        float k[15];
#pragma unroll
                        for (int mm = 0; mm < 15; ++mm) k[mm] = K2[((size_t)(base - s - 7 + mm) * 2 + 1) * 512 + c];
#pragma unroll
                        for (int ds = 0; ds < 8; ++ds) { const float z = zb[(size_t)(s + ds) * BW];
#pragma unroll
                            for (int i = 0; i < 8; ++i) acc[i] += k[i - ds + 7] * z; }
                    }
#pragma unroll
                    for (int i = 0; i < 8; ++i) { const size_t tok = (size_t)(tokbase + b * L + t0 + i); const float zt = Z[tok * BW + c]; Y4[tok * DM + c] = f2bf((acc[i] + bias[c] * zt) * U[tok * 1536 + 1024 + c]); }
                }
            }
            SEAM(PB + 4);
        }

        if (IN(PB + 5)) for (int rep_ = 0; rep_ < PROBE_REPS(5); ++rep_) {
            PH_BEGIN
            const float* ml_norm = PT(23) + l * BW; const float* ssd_d = PT(38) + l * 8; const float* ssd_norm = PT(39) + l * BW; const float* s5_d = PT(31) + l * BW;
            if (bid < 128) {
                pg8::Gemm gg_{S5A, S5B, 768, 768, 768}; pg8::SchedS5b S_{bid}; pg8::EpiS5Out E_{P, s5_d, GG};
                pg8::gemm_phase((LAS unsigned char*)shm, gg_, S_, E_);
                __syncthreads();
            }
            for (int tok = bid * 8 + wave; tok < NTOK; tok += G * 8) {
                const int c0 = lane * 8; const bf16_t* pr = P + (size_t)tok * LDP; const size_t o5 = (size_t)tok * BW + c0;
                float hm[8], ys[8];
                const u32x4 ooq = *(const u32x4*)(pr + ML_OFF + 1536 + c0);
                const float4 g0 = *(const float4*)(ml_norm + c0), g1 = *(const float4*)(ml_norm + c0 + 4), n0 = *(const float4*)(ssd_norm + c0), n1 = *(const float4*)(ssd_norm + c0 + 4);
                { float fa[8], fb[8]; unpack8(*(const u32x4*)(HF + o5), fa); unpack8(*(const u32x4*)(HBk + o5), fb);
#pragma unroll
                  for (int j = 0; j < 8; ++j) hm[j] = fa[j] + fb[j]; }
                { float ya[8], yb[8]; unpack8(*(const u32x4*)(YF + o5), ya); unpack8(*(const u32x4*)(YB + o5), yb);
                  float xx[8], zz[8]; unpack8(*(const u32x4*)(XBC + (size_t)tok * 1024 + c0), xx); unpack8(*(const u32x4*)(pr + SSD_OFF + c0), zz); const float dsk = ssd_d[c0 >> 6];
#pragma unroll
                  for (int j = 0; j < 8; ++j) ys[j] = ya[j] + yb[j];
#pragma unroll
                  for (int j = 0; j < 8; ++j) ys[j] = (ys[j] + dsk * xx[j]) * siluf_(zz[j]); }
                float s1 = 0.f, s2 = 0.f;
#pragma unroll
                for (int j = 0; j < 8; ++j) { s1 += hm[j] * hm[j]; s2 += ys[j] * ys[j]; }
                s1 += __shfl_xor(s1, 1); s1 += __shfl_xor(s1, 2); s1 += __shfl_xor(s1, 4); s1 += __shfl_xor(s1, 8);
                s2 = wave_sum(s2);
                const float r1 = rsqrtf(s1 * (1.0f / 128.0f) + 1e-6f), r2 = rsqrtf(s2 * (1.0f / BW) + 1e-6f);
                float oo[8]; unpack8(ooq, oo);
                const float gm[8] = {g0.x, g0.y, g0.z, g0.w, g1.x, g1.y, g1.z, g1.w}, gs[8] = {n0.x, n0.y, n0.z, n0.w, n1.x, n1.y, n1.z, n1.w};
                u32x4 w;
                w.x = pk2(hm[0] * r1 * gm[0] * sigmoidf_(oo[0]), hm[1] * r1 * gm[1] * sigmoidf_(oo[1])); w.y = pk2(hm[2] * r1 * gm[2] * sigmoidf_(oo[2]), hm[3] * r1 * gm[3] * sigmoidf_(oo[3]));
                w.z = pk2(hm[4] * r1 * gm[4] * sigmoidf_(oo[4]), hm[5] * r1 * gm[5] * sigmoidf_(oo[5])); w.w = pk2(hm[6] * r1 * gm[6] * sigmoidf_(oo[6]), hm[7] * r1 * gm[7] * sigmoidf_(oo[7]));
                *(u32x4*)(Y4 + (size_t)tok * DM + 512 + c0) = w;
                w.x = pk2(ys[0] * r2 * gs[0], ys[1] * r2 * gs[1]); w.y = pk2(ys[2] * r2 * gs[2], ys[3] * r2 * gs[3]); w.z = pk2(ys[4] * r2 * gs[4], ys[5] * r2 * gs[5]); w.w = pk2(ys[6] * r2 * gs[6], ys[7] * r2 * gs[7]);
                *(u32x4*)(Y4 + (size_t)tok * DM + 1536 + c0) = w;
                if (tok >= NLAT) { const size_t oc = (size_t)(tok - NLAT) * BW + c0; float uu[8]; unpack8(*(const u32x4*)(pr + S5_OFF + c0), uu);
                    const float4 a0 = *(const float4*)(SF + oc), a1 = *(const float4*)(SF + oc + 4), b0 = *(const float4*)(SB + oc), b1 = *(const float4*)(SB + oc + 4), d0 = *(const float4*)(s5_d + c0), d1 = *(const float4*)(s5_d + c0 + 4);
                    float y[8] = {a0.x + b0.x + d0.x * uu[0], a0.y + b0.y + d0.y * uu[1], a0.z + b0.z + d0.z * uu[2], a0.w + b0.w + d0.w * uu[3], a1.x + b1.x + d1.x * uu[4], a1.y + b1.y + d1.y * uu[5], a1.z + b1.z + d1.z * uu[6], a1.w + b1.w + d1.w * uu[7]};
#pragma unroll
                    for (int j = 0; j < 8; ++j) y[j] = 0.5f * y[j] * (1.0f + tanhf(0.7978845608028654f * (y[j] + 0.044715f * y[j] * y[j] * y[j])));
                    w.x = pk2(y[0], y[1]); w.y = pk2(y[2], y[3]); w.z = pk2(y[4], y[5]); w.w = pk2(y[6], y[7]);
                    *(u32x4*)(GG + (size_t)tok * BW + c0) = w; }
            }
            __syncthreads();
            {   float* T = sf;
                for (int unit = (G > 128 ? bid - 128 : bid); unit >= 0 && unit < 4 * 64 * 8; unit += (G > 128 ? G - 128 : G)) { const int b = unit / 512, t0 = ((unit >> 3) & 63) * 64, c0 = (unit & 7) * 64;
                    __syncthreads();
#pragma unroll
                    for (int i = 0; i < 8; ++i) { const int t = tid & 63, c = (tid >> 6) + 8 * i; T[c * 65 + t] = __uint_as_float((unsigned)YT[((size_t)b * 512 + c0 + c) * SEQ + t0 + t] << 16); }
                    __syncthreads();
                    const int t = tid >> 3, cq = (tid & 7) * 8;
                    u32x4 w; w.x = pk2(T[(cq + 0) * 65 + t], T[(cq + 1) * 65 + t]); w.y = pk2(T[(cq + 2) * 65 + t], T[(cq + 3) * 65 + t]); w.z = pk2(T[(cq + 4) * 65 + t], T[(cq + 5) * 65 + t]); w.w = pk2(T[(cq + 6) * 65 + t], T[(cq + 7) * 65 + t]);
                    *(u32x4*)(Y4 + ((size_t)b * SEQ + t0 + t) * DM + c0 + cq) = w;
                } }
            SEAM(PB + 5);
        }

        if (IN(PB + 6)) for (int rep_ = 0; rep_ < PROBE_REPS(6); ++rep_) {
            PH_BEGIN
            pg8::Gemm g{GG, GLU, BW, BW, BW}; pg8::SchedStd S{68, 2, G, bid, BW, BW}; pg8::EpiGlu E{GG, PT(33) + l * BW, Y4};
            pg8::gemm_phase((LAS unsigned char*)shm, g, S, E);
            SEAM(PB + 6);
        }
        if (IN(PB + 7)) for (int rep_ = 0; rep_ < PROBE_REPS(7); ++rep_) {
            PH_BEGIN
            pg8::Gemm g{Y4, WBR, DM, BW, BW}; pg8::SchedBranch S{64, 8, G, bid}; pg8::EpiBranch E{P, ACCb};
            pg8::gemm_phase((LAS unsigned char*)shm, g, S, E);
            if (!lastl) { __syncthreads(); pg8::SchedTail S2{G, bid}; pg8::EpiPartK E2{(float*)HSPEC}; pg8::gemm_phase((LAS unsigned char*)shm, g, S2, E2); }
            SEAM(PB + 7);
        }
        if (IN(PB + 8)) for (int rep_ = 0; rep_ < PROBE_REPS(8); ++rep_) {
            PH_BEGIN
            if (!lastl) {
                const float* PART = (const float*)HSPEC;
                for (int idx = bid * NTHR + tid; idx < (NTOK - NLAT) * DM / 8; idx += G * NTHR) { const size_t o = (size_t)idx * 8; f32x4 p[4][2];
#pragma unroll
                    for (int k = 0; k < 4; ++k) { p[k][0] = *(const f32x4*)(PART + (size_t)k * (NTOK - NLAT) * DM + o); p[k][1] = *(const f32x4*)(PART + (size_t)k * (NTOK - NLAT) * DM + o + 4); }
                    f32x4 s0 = (f32x4){0.f, 0.f, 0.f, 0.f}, s1 = s0; const bf16_t* rp = P + (size_t)(NLAT + (o >> 11)) * LDP + GATE2 + (o & (DM - 1));
#pragma unroll
                    for (int k = 0; k < 4; ++k) { float rr[8]; unpack8(*(const u32x4*)(rp + k * DM), rr);
                        s0 = s0 + p[k][0]; s1 = s1 + p[k][1]; s0[0] *= rr[0]; s0[1] *= rr[1]; s0[2] *= rr[2]; s0[3] *= rr[3]; s1[0] *= rr[4]; s1[1] *= rr[5]; s1[2] *= rr[6]; s1[3] *= rr[7]; }
                    u32x4 w; w.x = pk2(s0[0], s0[1]); w.y = pk2(s0[2], s0[3]); w.z = pk2(s1[0], s1[1]); w.w = pk2(s1[2], s1[3]);
                    *(u32x4*)(ACCb + (size_t)NLAT * DM + o) = w; }
                xcd_barrier(bar);
            }
            pg8::Gemm g{ACCb, WOUT, DM, DM, DM}; pg8::SchedStd S{64, 8, G, bid, DM, DM}; pg8::EpiResid E{XS, l == 0 ? x_in : (const float*)XS, l == 0 ? ctx_in - (size_t)NLAT * DM : (const float*)XS, MODl, 2};
            pg8::gemm_phase((LAS unsigned char*)shm, g, S, E);
            if (!lastl) { __syncthreads(); pg8::Gemm g2{ACCb, WOUT, DM, DM, 512}; pg8::SchedTailK S2{G, bid}; pg8::EpiPartK E2{(float*)HSPEC + (size_t)4 * (NTOK - NLAT) * DM}; pg8::gemm_phase((LAS unsigned char*)shm, g2, S2, E2); }
            SEAM(PB + 8);
        }
        if (IN(PB + 9)) for (int rep_ = 0; rep_ < PROBE_REPS(9); ++rep_) {
            PH_BEGIN
            if (!lastl) {
                const float* PART = (const float*)HSPEC + (size_t)4 * (NTOK - NLAT) * DM; const float* mg = MODl + (size_t)(4 * 6 + 2) * DM;
                const float* src = l == 0 ? ctx_in : (const float*)XS + (size_t)NLAT * DM;
                for (int idx = bid * NTHR + tid; idx < (NTOK - NLAT) * DM / 4; idx += G * NTHR) { const size_t o = (size_t)idx * 4; const int col = (int)(o & (DM - 1));
                    const f32x4 p0 = *(const f32x4*)(PART + o), p1 = *(const f32x4*)(PART + (size_t)(NTOK - NLAT) * DM + o), p2 = *(const f32x4*)(PART + (size_t)2 * (NTOK - NLAT) * DM + o), p3 = *(const f32x4*)(PART + (size_t)3 * (NTOK - NLAT) * DM + o);
                    const f32x4 sv = *(const f32x4*)(src + o), gm = *(const f32x4*)(mg + col);
                    *(f32x4*)(XS + (size_t)NLAT * DM + o) = sv + gm * (((p0 + p1) + p2) + p3); }
                xcd_barrier(bar);
            }
            for (int i = bid * NTHR + tid; i < NEXP * MOE_PAD; i += G * NTHR) ROWTOK[i] = -1;
            for (int i = bid * NTHR + tid; i < NTOK * 16; i += G * NTHR) INV[i] = -1;
            const float* wr = PT(42) + (size_t)l * DM * 16; const float* gn = norm_ffn + l * DM;
            float* wl = sf;
            __syncthreads();
#pragma unroll 1
            for (int q0 = 0; q0 < 16; q0 += 4) {
                const float4 a0 = ((const float4*)wr)[(q0 + 0) * 512 + tid], a1 = ((const float4*)wr)[(q0 + 1) * 512 + tid], a2 = ((const float4*)wr)[(q0 + 2) * 512 + tid], a3 = ((const float4*)wr)[(q0 + 3) * 512 + tid];
                { const int f4 = (q0 + 0) * 512 + tid; *(float4*)(wl + (size_t)(f4 >> 4) * 68 + (f4 & 15) * 4) = a0; }
                { const int f4 = (q0 + 1) * 512 + tid; *(float4*)(wl + (size_t)(f4 >> 4) * 68 + (f4 & 15) * 4) = a1; }
                { const int f4 = (q0 + 2) * 512 + tid; *(float4*)(wl + (size_t)(f4 >> 4) * 68 + (f4 & 15) * 4) = a2; }
                { const int f4 = (q0 + 3) * 512 + tid; *(float4*)(wl + (size_t)(f4 >> 4) * 68 + (f4 & 15) * 4) = a3; } }
            __syncthreads();
            for (int tok0 = (bid * 8 + wave) * 4; tok0 < M2; tok0 += G * 32) {
                const int r = tok0 < NLAT ? tok0 / SEQ : 4; const float* xr = XS + (size_t)tok0 * DM;
                const float* sh = MODl + (size_t)(r * 6 + 3) * DM; const float* sc = MODl + (size_t)(r * 6 + 4) * DM;
                float rs[4];
#pragma unroll
                for (int tk = 0; tk < 4; ++tk) { float ss = 0.f;
#pragma unroll 4
                    for (int i = 0; i < 8; ++i) { const float4 t4 = *(const float4*)(xr + (size_t)tk * DM + i * 256 + lane * 4); ss += t4.x * t4.x + t4.y * t4.y + t4.z * t4.z + t4.w * t4.w; }
                    ss = wave_sum(ss); rs[tk] = rsqrtf(ss * (1.0f / DM) + 1e-6f); }
                float lg[4][16];
#pragma unroll
                for (int tk = 0; tk < 4; ++tk)
#pragma unroll
                    for (int e = 0; e < 16; ++e) lg[tk][e] = 0.f;
#pragma unroll 1
                for (int i = 0; i < 8; ++i) { const int d = i * 256 + lane * 4;
                    const float4 g4 = *(const float4*)(gn + d), s4 = *(const float4*)(sc + d), h4 = *(const float4*)(sh + d);
                    float4 xq[4], ww[16];
#pragma unroll
                    for (int tk = 0; tk < 4; ++tk) xq[tk] = *(const float4*)(xr + (size_t)tk * DM + d);
                    const float4* wq = (const float4*)(wl + (size_t)(i * 64 + lane) * 68);
#pragma unroll
                    for (int q = 0; q < 16; ++q) ww[q] = wq[q];
                    float hv[4][4];
#pragma unroll
                    for (int tk = 0; tk < 4; ++tk) { const float4 xv = xq[tk]; const float rr = rs[tk];
                        hv[tk][0] = xv.x * rr * g4.x * (1.f + s4.x) + h4.x; hv[tk][1] = xv.y * rr * g4.y * (1.f + s4.y) + h4.y; hv[tk][2] = xv.z * rr * g4.z * (1.f + s4.z) + h4.z; hv[tk][3] = xv.w * rr * g4.w * (1.f + s4.w) + h4.w;
                        u32x2 w; w.x = pk2(hv[tk][0], hv[tk][1]); w.y = pk2(hv[tk][2], hv[tk][3]); *(u32x2*)(HB + (size_t)(tok0 + tk) * DM + d) = w; }
#pragma unroll
                    for (int q = 0; q < 4; ++q) { const float4 w0 = ww[q * 4 + 0], w1 = ww[q * 4 + 1], w2 = ww[q * 4 + 2], w3 = ww[q * 4 + 3];
#pragma unroll
                        for (int tk = 0; tk < 4; ++tk) { const float hq = hv[tk][q];
                            lg[tk][0] += hq * w0.x; lg[tk][1] += hq * w0.y; lg[tk][2] += hq * w0.z; lg[tk][3] += hq * w0.w; lg[tk][4] += hq * w1.x; lg[tk][5] += hq * w1.y; lg[tk][6] += hq * w1.z; lg[tk][7] += hq * w1.w;
                            lg[tk][8] += hq * w2.x; lg[tk][9] += hq * w2.y; lg[tk][10] += hq * w2.z; lg[tk][11] += hq * w2.w; lg[tk][12] += hq * w3.x; lg[tk][13] += hq * w3.y; lg[tk][14] += hq * w3.z; lg[tk][15] += hq * w3.w; } } }
#pragma unroll
                for (int tk = 0; tk < 4; ++tk) { float mx = -1e30f;
#pragma unroll
                    for (int e = 0; e < 16; ++e) { lg[tk][e] = wave_sum(lg[tk][e]); mx = fmaxf(mx, lg[tk][e]); }
                    float sm = 0.f;
#pragma unroll
                    for (int e = 0; e < 16; ++e) { lg[tk][e] = expf(lg[tk][e] - mx); sm += lg[tk][e]; }
                    const float inv = 1.0f / sm;
                    if (lane == 0) {
#pragma unroll
                        for (int e = 0; e < 16; e += 4) *(float4*)(PROBS + (size_t)(tok0 + tk) * 16 + e) = make_float4(lg[tk][e] * inv, lg[tk][e + 1] * inv, lg[tk][e + 2] * inv, lg[tk][e + 3] * inv); } }
            }
            SEAM(PB + 9);
        }
        if (IN(PB + 10)) for (int rep_ = 0; rep_ < PROBE_REPS(10); ++rep_) {
            PH_BEGIN
            const int nitems = 64 + (lastl ? 0 : 64);
            unsigned long long* keys = (unsigned long long*)shm;
            for (int it = bid; it < nitems; it += G) {
                const int set = it >> 6, e = it & 15, b = (it >> 4) & 3;
                const int n = set ? CTXL : SEQ, cap = set ? 32 : 512, tokbase = set ? NLAT + b * CTXL : b * SEQ;
                __syncthreads();
                for (int i = tid; i < n; i += NTHR) keys[i] = ((unsigned long long)__float_as_uint(PROBS[(size_t)(tokbase + i) * 16 + e]) << 32) | (unsigned long long)(0xFFFFFFFFu - (unsigned)i);
                __syncthreads();
                for (int k = 2; k <= n; k <<= 1)
                    for (int j = k >> 1; j > 0; j >>= 1) {
                        for (int p = tid; p < (n >> 1); p += NTHR) { const int i = ((p & ~(j - 1)) << 1) | (p & (j - 1)); const int m = i | j;
                            const unsigned long long ka = keys[i], kb = keys[m]; const bool desc = ((i & k) == 0);
                            if ((ka < kb) == desc) { keys[i] = kb; keys[m] = ka; } }
                        __syncthreads();
                    }
                for (int r = tid; r < cap; r += NTHR) { const unsigned long long kk = keys[r]; const int row = e * MOE_PAD + (set ? 2048 + b * 32 + r : b * 512 + r);
                    const int tk_ = tokbase + (int)(0xFFFFFFFFu - (unsigned)(kk & 0xFFFFFFFFull)); ROWTOK[row] = tk_; ROWGATE[row] = __uint_as_float((unsigned)(kk >> 32)); INV[tk_ * 16 + e] = row; }
                for (int rb = 0; rb < cap; rb += 32) {
                    u32x4 t4[4][4];
#pragma unroll
                    for (int q = 0; q < 4; ++q) { const int r = rb + wave + 8 * q; const int tok = tokbase + (int)(0xFFFFFFFFu - (unsigned)(keys[r] & 0xFFFFFFFFull));
                        const u32x4* sp = (const u32x4*)(HB + (size_t)tok * DM);
#pragma unroll
                        for (int i = 0; i < 4; ++i) t4[q][i] = sp[i * 64 + lane]; }
#pragma unroll
                    for (int q = 0; q < 4; ++q) { const int r = rb + wave + 8 * q; const int row = e * MOE_PAD + (set ? 2048 + b * 32 + r : b * 512 + r);
                        u32x4* dp = (u32x4*)(XG + (size_t)row * DM);
#pragma unroll
                        for (int i = 0; i < 4; ++i) dp[i * 64 + lane] = t4[q][i]; } }
            }
            if (lastl && G > 64 && bid >= 64) {
                const int n_win = 32 * 55, n_br = 4 * 64, n_out = 32 * 8, n_glu = 16, n_gu = 16 * 2 * 192, n_d = 16 * 192;
                const int lo_d = n_win + n_br + n_out + n_glu + n_gu - 1536;
                CV_RUN(l, lo_d + bid - 64, G - 64, lo_d + 1536 + n_d);
            }
            if (!lastl && G > 128 && bid >= 128) {
                const int n_win = 32 * 55, n_br = 4 * 64, n_out = 32 * 8, n_glu = 16, n_gu = 16 * 2 * 192; (void)n_gu;
                CV_RUN(l + 1, bid - 128, G - 128, n_win); (void)n_br; (void)n_out; (void)n_glu;
            }
            {   const int pad0 = lastl ? 2048 : MOE_ROWS, npad = MOE_PAD - pad0;
                for (int R = bid * 8 + wave; R < NEXP * npad; R += G * 8) { const int e = R / npad, rr = pad0 + R % npad; u32x4* dp = (u32x4*)(XG + ((size_t)e * MOE_PAD + rr) * DM);
#pragma unroll
                    for (int i = 0; i < 4; ++i) dp[i * 64 + lane] = (u32x4){0u, 0u, 0u, 0u}; } }
            SEAM(PB + 10);
        }
        if (IN(PB + 12)) for (int rep_ = 0; rep_ < PROBE_REPS(12); ++rep_) {
            PH_BEGIN
            pg8::Gemm g{XG, WGU, DM, DM, DM}; pg8::SchedMoe S{lastl ? 8 : 9, 12, G, bid, DM, DM, 2 * DEXP}; pg8::EpiMoe1 E{HID};
            pg8::gemm_phase((LAS unsigned char*)shm, g, S, E);
            SEAM(PB + 12);
        }
        if (IN(PB + 13)) for (int rep_ = 0; rep_ < PROBE_REPS(13); ++rep_) {
            PH_BEGIN
            pg8::Gemm g{HID, WD, DEXP, DEXP, DEXP}; pg8::SchedMoe S{lastl ? 8 : 9, 8, G, bid, DEXP, DEXP, DM}; pg8::EpiMoeY E{YEXP};
            pg8::gemm_phase((LAS unsigned char*)shm, g, S, E);
            SEAM(PB + 13);
        }

}

__global__ __launch_bounds__(NTHR, 2) void fwd(Args a) {
    extern __shared__ __attribute__((aligned(16))) unsigned char shm[];
    const int bid = blockIdx.x, G = gridDim.x;
    float* const sf = (float*)shm;
    volatile LAS unsigned* xbw = (volatile LAS unsigned*)((LAS unsigned char*)shm + (LDS_BYTES - 16));
    if (threadIdx.x == 0) { xbw[0] = 0u; xbw[1] = 0u; xbw[2] = 0u; xbw[3] = 0u; }
    const float** const ptab = (const float**)(shm + (LDS_BYTES - 16 - 512));
    if (threadIdx.x == 0) {
#pragma unroll
        for (int i = 0; i < 47; ++i) ptab[i] = a.in[i]; }
    __syncthreads();
    XcdBarrier bar = xcd_barrier_post((unsigned*)(a.ws + O_BAR), xbw);
    const int lo = a.ph_lo, hi = a.ph_hi;
    if (IN(0)) {
        PH_BEGIN
        {
            __syncthreads();
            for (int i = tid; i < 5 * DM; i += NTHR) { const int r = i >> 11, k = i & (DM - 1); const float v = r < 4 ? c_in[r * DM + k] : cctx_in[k]; sf[i] = siluf_(v); }
            __syncthreads();
            float* red = sf + 5 * DM;
            for (int unit = bid; unit < 2 * 96; unit += G) { const int l = unit / 96, j = (unit % 96) * 128 + (tid & 127), kq = tid >> 7;
                const float* w = ada_w + (size_t)l * DM * (6 * DM) + (size_t)(kq * 512) * (6 * DM) + j; const float* sv = sf + kq * 512;
                float a0 = 0.f, a1 = 0.f, a2 = 0.f, a3 = 0.f, a4 = 0.f;
#pragma unroll 8
                for (int k = 0; k < 512; ++k) { const float wv = w[(size_t)k * (6 * DM)]; a0 += sv[k] * wv; a1 += sv[DM + k] * wv; a2 += sv[2 * DM + k] * wv; a3 += sv[3 * DM + k] * wv; a4 += sv[4 * DM + k] * wv; }
                __syncthreads();
                { float* rp = red + (kq * 5) * 128 + (tid & 127); rp[0] = a0; rp[128] = a1; rp[256] = a2; rp[384] = a3; rp[512] = a4; }
                __syncthreads();
                if (tid < 128) { const float bb = ada_b[l * 6 * DM + j]; float* o = MOD + (size_t)l * 5 * 6 * DM + j;
#pragma unroll
                    for (int r = 0; r < 5; ++r) o[(size_t)r * 6 * DM] = ((red[(0 * 5 + r) * 128 + tid] + red[(1 * 5 + r) * 128 + tid]) + (red[(2 * 5 + r) * 128 + tid] + red[(3 * 5 + r) * 128 + tid])) + bb; }
            }
        }
    }

    layer_body<0>(a, bar, lo, hi, bid, G, shm, sf, ptab);
    layer_body<1>(a, bar, lo, hi, bid, G, shm, sf, ptab);
    if (IN(33)) {
        PH_BEGIN
        const float* gn = PT(46);
        for (int tok = bid * 8 + wave; tok < NLAT; tok += G * 8) {
            const float* xr = XS + (size_t)tok * DM; float4 v[8]; float ss = 0.f;
#pragma unroll
            for (int i = 0; i < 8; ++i) v[i] = *(const float4*)(xr + i * 256 + lane * 4);
            moe_combine(v, tok, lane, INV, ROWGATE, YEXP, MOD + (size_t)(1 * 5 + tok / SEQ) * 6 * DM + 5 * DM);
#pragma unroll
            for (int i = 0; i < 8; ++i) {                 ss += v[i].x * v[i].x + v[i].y * v[i].y + v[i].z * v[i].z + v[i].w * v[i].w; }
            ss = wave_sum(ss); const float rs = rsqrtf(ss * (1.0f / DM) + 1e-6f);
#pragma unroll
            for (int i = 0; i < 8; ++i) { const int d = i * 256 + lane * 4; const float4 g4 = *(const float4*)(gn + d);
                *(float4*)(a.out + (size_t)tok * DM + d) = make_float4(v[i].x * rs * g4.x, v[i].y * rs * g4.y, v[i].z * rs * g4.z, v[i].w * rs * g4.w); }
        }
    }
#undef IN
#undef SEAM
}


extern "C" void kernel_launch(void* const* d_in, const int* in_sizes, int n_in, void* d_out, int out_size, void* d_ws, size_t ws_size, hipStream_t stream) {
    static int grid = 0;
    if (grid == 0) {
        if (n_in != 47 || ws_size < WS_END) { fprintf(stderr, "kernel_launch: expected 47 inputs and >= %zu bytes of workspace; got %d, %zu\n", (size_t)WS_END, n_in, ws_size); grid = -1; return; }
        int dev = 0, cus = 0;
        if (hipGetDevice(&dev) != hipSuccess || hipDeviceGetAttribute(&cus, hipDeviceAttributeMultiprocessorCount, dev) != hipSuccess) { grid = -1; return; }
        if (hipFuncSetAttribute((const void*)fwd, hipFuncAttributeMaxDynamicSharedMemorySize, LDS_BYTES) != hipSuccess) { fprintf(stderr, "kernel_launch: hipFuncSetAttribute failed\n"); grid = -1; return; }
        int per_cu = 0;
        if (hipOccupancyMaxActiveBlocksPerMultiprocessor(&per_cu, (const void*)fwd, NTHR, LDS_BYTES) != hipSuccess || per_cu < 1) fprintf(stderr, "kernel_launch: occupancy query reports %d\n", per_cu);
        (void)hipGetLastError();
        grid = cus > 256 ? 256 : cus;
        if (grid < 224) { fprintf(stderr, "kernel_launch: needs >= 224 CUs (got %d)\n", grid); grid = -1; return; }
    }
    if (grid < 0) return;
    (void)hipMemsetAsync((char*)d_ws, 0, O_ZERO_END, stream);
    Args a{};
    for (int i = 0; i < 47; ++i) a.in[i] = (const float*)d_in[i];
    a.out = (float*)d_out; a.ws = (unsigned char*)d_ws;
#if MK_ONE_LAUNCH
    a.ph_lo = 0; a.ph_hi = 64;
    hipLaunchKernelGGL(fwd, dim3(grid), dim3(NTHR), LDS_BYTES, stream, a);
#else
    const int ids[] = {0, 1,2,3,4,5,6,7,8,9,10,11,12,13,14, 17,18,19,20,21,22,23,24,25,26,27,28,29,30, 33};
    for (int k = 0; k < (int)(sizeof(ids) / sizeof(ids[0])); ++k) { a.ph_lo = ids[k]; a.ph_hi = ids[k] + 1; hipLaunchKernelGGL(fwd, dim3(grid), dim3(NTHR), LDS_BYTES, stream, a); }
#endif
}
```

```cpp
#include <hip/hip_runtime.h>
#include <stdint.h>
#include <stdio.h>

#ifndef PROBE_MASK
#define PROBE_MASK 0
#endif
#ifndef PROBE_SP
#define PROBE_SP 1
#endif
#define PROBE_REPS(k) ((((PROBE_MASK) >> (k)) & 1) + 1)
#ifndef MK_ONE_LAUNCH
#define MK_ONE_LAUNCH 1
#endif

#define DM 2048
#define NB 4
#define SEQ 4096
#define CTXL 256
#define BW 512
#define NLAT 16384
#define NCTX 1024
#define NTOK 17408
#define IN_W 13856
#define GATE2 5888
#define LDP 14080
#define HY_OFF 0
#define ML_OFF 1536
#define S5_OFF 3600
#define SSD_OFF 4112
#define GATE_OFF 5664
#define NEXP 16
#define DEXP 1536
#define MOE_ROWS 2176
#define MOE_PAD 2304
#define NTHR 512
#define LDS_BYTES 147456
#define LAS __attribute__((address_space(3)))

typedef unsigned short bf16_t;
typedef short bf16x8 __attribute__((ext_vector_type(8)));
typedef float f32x4 __attribute__((ext_vector_type(4)));
typedef unsigned u32x4 __attribute__((ext_vector_type(4)));
typedef unsigned u32x2 __attribute__((ext_vector_type(2)));

#define XB_TMO      128
#define XB_XCNT(j)  (256  + 64 * (j))
#define XB_XSUB(j)  (1280 + 64 * (j))
#define XB_XGEN(j)  (2304 + 64 * (j))
#define XB_TOP      3328
#define XB_TOPGEN   3392
#define XCD_BAR_WORDS 3456
#define XB_SPIN_CAP (1u << 18)
__device__ __forceinline__ unsigned xb_ld(unsigned* p)              { return __hip_atomic_load(p, __ATOMIC_RELAXED, __HIP_MEMORY_SCOPE_AGENT); }
__device__ __forceinline__ unsigned xb_add(unsigned* p, unsigned v) { return __hip_atomic_fetch_add(p, v, __ATOMIC_RELAXED, __HIP_MEMORY_SCOPE_AGENT); }
__device__ __forceinline__ unsigned xb_xcc_id() { return (unsigned)__builtin_amdgcn_s_getreg((3 << 11) | 20) & 0xFu; }
#define XB_SPIN(cond, bar) do { unsigned _sp = 0; while (cond) { __builtin_amdgcn_s_sleep(1); \
    if ((++_sp & 255u) == 0u) { if (xb_ld(&(bar)[XB_TMO])) break; if (_sp > XB_SPIN_CAP) { atomicAdd(&(bar)[XB_TMO], 1u); break; } } } } while (0)
struct XcdBarrier { unsigned* bar; unsigned x; volatile LAS unsigned* st; };
__device__ __forceinline__ XcdBarrier xcd_barrier_post(unsigned* bar, volatile LAS unsigned* st) {
    XcdBarrier b; b.bar = bar; b.x = xb_xcc_id(); b.st = st;
    if (threadIdx.x == 0) (void)xb_add(&bar[XB_XCNT(b.x)], 1u);
    return b;
}
__device__ __forceinline__ void xcd_barrier_complete(unsigned* bar, unsigned x, unsigned& nloc, unsigned& nx) {
    const unsigned G = gridDim.x * gridDim.y * gridDim.z;
    unsigned sum, cnt, mine, sp = 0u;
    for (;;) {
        sum = 0u; cnt = 0u; mine = 0u;
#pragma unroll
        for (unsigned j = 0; j < 16; ++j) { const unsigned c = xb_ld(&bar[XB_XCNT(j)]); sum += c; cnt += (c > 0u) ? 1u : 0u; mine = (j == x) ? c : mine; }
        if (sum == G) break;
        __builtin_amdgcn_s_sleep(1);
        if ((++sp & 255u) == 0u) { if (xb_ld(&bar[XB_TMO])) break; if (sp > XB_SPIN_CAP) { atomicAdd(&bar[XB_TMO], 1u); break; } }
    }
    nloc = mine > 0u ? mine : 1u; nx = cnt > 0u ? cnt : 1u;
}
__device__ __forceinline__ void xcd_barrier(const XcdBarrier& b) {
    asm volatile("s_waitcnt vmcnt(0)" ::: "memory");
    __syncthreads();
    if (threadIdx.x == 0) {
        unsigned* bar = b.bar;
        __builtin_amdgcn_s_waitcnt(0);
        unsigned nloc = b.st[0], nx = b.st[1];
        if (nloc == 0u) { xcd_barrier_complete(bar, b.x, nloc, nx); b.st[0] = nloc; b.st[1] = nx; }
        const unsigned old = xb_add(&bar[XB_XSUB(b.x)], 1u);
        const unsigned gen = old / nloc;
        if (old + 1u == (gen + 1u) * nloc) {
            __builtin_amdgcn_fence(__ATOMIC_RELEASE, "agent");
            asm volatile("s_waitcnt vmcnt(0)" ::: "memory");
            const unsigned og = xb_add(&bar[XB_TOP], 1u);
            const unsigned tg = og / nx;
            if (og + 1u == (tg + 1u) * nx) xb_add(&bar[XB_TOPGEN], 1u);
            else XB_SPIN(xb_ld(&bar[XB_TOPGEN]) == tg, bar);
            __builtin_amdgcn_fence(__ATOMIC_ACQUIRE, "agent");
            xb_add(&bar[XB_XGEN(b.x)], 1u);
            asm volatile("s_waitcnt vmcnt(0)" ::: "memory");
        } else {
            XB_SPIN(xb_ld(&bar[XB_XGEN(b.x)]) == gen, bar);
            __builtin_amdgcn_fence(__ATOMIC_ACQUIRE, "agent");
            asm volatile("s_waitcnt vmcnt(0)" ::: "memory");
        }
    }
    __syncthreads();
}

__device__ __forceinline__ unsigned short f2bf(float f) { unsigned u = __float_as_uint(f); u += 0x7FFFu + ((u >> 16) & 1u); return (unsigned short)(u >> 16); }
__device__ __forceinline__ float bf2f(unsigned short b) { return __uint_as_float(((unsigned)b) << 16); }
__device__ __forceinline__ unsigned pk2(float lo, float hi) { unsigned r; asm("v_cvt_pk_bf16_f32 %0, %1, %2" : "=v"(r) : "v"(lo), "v"(hi)); return r; }
__device__ __forceinline__ float sigmoidf_(float x) { return 1.0f / (1.0f + expf(-x)); }
__device__ __forceinline__ float siluf_(float x) { return x / (1.0f + expf(-x)); }
__device__ __forceinline__ float wave_sum(float v) {
#pragma unroll
    for (int o = 32; o >= 1; o >>= 1) v += __shfl_xor(v, o);
    return v;
}
__device__ __forceinline__ const float* uptr(const float* p) { const unsigned long long v = (unsigned long long)p;
    const unsigned lo = __builtin_amdgcn_readfirstlane((unsigned)v), hi = __builtin_amdgcn_readfirstlane((unsigned)(v >> 32)); return (const float*)(((unsigned long long)hi << 32) | lo); }
#define PT(k) uptr(ptab[k])
__device__ __forceinline__ int step_tok(int b, int dir, int i) {
    if (i < CTXL) { const int tt = dir ? (CTXL - 1 - i) : i; return NLAT + b * CTXL + tt; }
    const int j = i - CTXL; const int tt = dir ? (SEQ - 1 - j) : j; return b * SEQ + tt;
}
__device__ __forceinline__ void unpack8(const u32x4 w, float (&f)[8]) {
    f[0] = __uint_as_float(w.x << 16); f[1] = __uint_as_float(w.x & 0xFFFF0000u); f[2] = __uint_as_float(w.y << 16); f[3] = __uint_as_float(w.y & 0xFFFF0000u);
    f[4] = __uint_as_float(w.z << 16); f[5] = __uint_as_float(w.z & 0xFFFF0000u); f[6] = __uint_as_float(w.w << 16); f[7] = __uint_as_float(w.w & 0xFFFF0000u);
}

namespace pg8 {
constexpr int BM = 256, BK = 64, HALF = 128, HTB = HALF * BK * 2, STAGE_BYTES = 8 * HTB, NXCD = 8, WGM = 8;
__host__ __device__ __forceinline__ int lds_byte(int r, int c) { const int st = (r >> 4) * 2 + (c >> 5), rr = r & 15, cc = c & 31, ob = rr * 64 + cc * 2; return st * 1024 + (ob ^ (((ob >> 9) & 1) << 5)); }
__host__ __device__ __forceinline__ void stage_rc(int b, int& R, int& C) { const int st = b / 1024, sb = b % 1024, swz = sb ^ (((sb >> 9) & 1) << 5); R = (st >> 1) * 16 + swz / 64; C = (st & 1) * 32 + (swz % 64) / 2; }
__host__ __device__ __forceinline__ int perm32(int rho) { const int n = rho >> 4, i = rho & 15; return 8 * (i >> 2) + 4 * n + (i & 3); }
struct Unit { int pm, pn, z, k; long long ao, bo; };
struct Gemm { const bf16_t* A; const bf16_t* Bt; int lda, ldb, K; };

__device__ __forceinline__ void tile_of(int wgid, int nM, int nN, int& pm, int& pn) {
    const int nwg = nM * nN; { const int q = nwg / NXCD, r = nwg % NXCD, xcd = wgid % NXCD, off = wgid / NXCD; wgid = (xcd < r ? xcd * (q + 1) : r * (q + 1) + (xcd - r) * q) + off; }
    const int nig = WGM * nN, gid = wgid / nig, fm = gid * WGM, gsz = (nM - fm) < WGM ? (nM - fm) : WGM;
    pm = fm + ((wgid % nig) % gsz); pn = (wgid % nig) / gsz;
}
struct SchedStd {
    int nM, nN, G, c, lda, ldb;
    __device__ __forceinline__ bool next(int i, Unit& u) const { const long L = (long)i * G + c; if (L >= (long)nM * nN) return false; tile_of((int)L, nM, nN, u.pm, u.pn); u.z = 0; u.k = 0;
        u.ao = (long long)u.pm * BM * lda * 2; u.bo = (long long)u.pn * BM * ldb * 2; return true; }
    __device__ __forceinline__ void a_ready(const Unit&) const {}
    __device__ __forceinline__ void done(const Unit&) const {}
};
struct SchedBranch {
    int nM, nN, G, c;
    __device__ __forceinline__ bool next(int i, Unit& u) const { const long L = (long)(i >> 2) * G + c; if (L >= (long)nM * nN) return false; tile_of((int)L, nM, nN, u.pm, u.pn); u.z = 0; u.k = i & 3;
        u.ao = ((long long)u.pm * BM * DM + u.k * BW) * 2; u.bo = ((long long)u.k * DM + u.pn * BM) * BW * 2; return true; }
    __device__ __forceinline__ void a_ready(const Unit&) const {}
    __device__ __forceinline__ void done(const Unit&) const {}
};
struct SchedTail {
    int G, c;
    __device__ __forceinline__ bool next(int i, Unit& u) const { const long T = (long)i * G + c; if (T >= 128) return false; const int t = (int)(T >> 2); u.pm = 64 + (t >> 3); u.pn = t & 7; u.z = 1; u.k = (int)(T & 3);
        u.ao = ((long long)u.pm * BM * DM + u.k * BW) * 2; u.bo = ((long long)u.k * DM + u.pn * BM) * BW * 2; return true; }
    __device__ __forceinline__ void a_ready(const Unit&) const {}
    __device__ __forceinline__ void done(const Unit&) const {}
};
struct SchedTailK {
    int G, c;
    __device__ __forceinline__ bool next(int i, Unit& u) const { const long T = (long)i * G + c; if (T >= 128) return false; const int t = (int)(T >> 2); u.pm = 64 + (t >> 3); u.pn = t & 7; u.z = 1; u.k = (int)(T & 3);
        u.ao = ((long long)u.pm * BM * DM + u.k * 512) * 2; u.bo = ((long long)u.pn * BM * DM + u.k * 512) * 2; return true; }
    __device__ __forceinline__ void a_ready(const Unit&) const {}
    __device__ __forceinline__ void done(const Unit&) const {}
};
struct SchedMoe {
    int nPm, nPn, G, c, lda, ldb, nBrows;
    __device__ __forceinline__ bool next(int i, Unit& u) const { const long L = (long)i * G + c; const int per = nPm * nPn; if (L >= (long)NEXP * per) return false; const int e = (int)(L / per), rem = (int)(L % per);
        u.z = e; u.k = 0; u.pm = rem % nPm; u.pn = rem / nPm; u.ao = ((long long)e * MOE_PAD + u.pm * BM) * lda * 2; u.bo = ((long long)e * nBrows + u.pn * BM) * ldb * 2; return true; }
    __device__ __forceinline__ void a_ready(const Unit&) const {}
    __device__ __forceinline__ void done(const Unit&) const {}
};

typedef f32x4 Acc[2][2][4][2];
template <class Epi, class Sched>
__device__ __forceinline__ void gemm_phase(LAS unsigned char* lds, const Gemm g, const Sched& S, const Epi& E) {
    int tid = threadIdx.x; asm volatile("" : "+v"(tid));
    const int wid = __builtin_amdgcn_readfirstlane(tid >> 6), lane = tid & 63, wr = wid >> 2, wc = wid & 3, fr = lane & 15, fq = lane >> 4;
    const int K = g.K, nt = K / BK;
    unsigned voffA[2], voffB[2];
#pragma unroll
    for (int i = 0; i < 2; ++i) { int R, C; stage_rc(tid * 16 + i * 8192, R, C); const int Rb = Epi::PERM ? ((R & ~31) + perm32(R & 31)) : R;
        voffA[i] = (unsigned)(R * g.lda + C) * 2u; voffB[i] = (unsigned)(Rb * g.ldb + C) * 2u; }
    const size_t kstep = (size_t)(BK * 2);
    const size_t hstepA = (size_t)HALF * g.lda * 2, hstepB = (size_t)HALF * g.ldb * 2;
    const unsigned ldsw = (unsigned)wid * 1024u;
    const int aoff = lds_byte(wr * 64 + fr, fq * 8), boff = lds_byte(wc * 32 + fr, fq * 8);
#define PG8_SA(b, h) (((b) * 2 + (h)) * HTB)
#define PG8_SB(b, h) ((4 + (b) * 2 + (h)) * HTB)
#define PG8_STAGE(bufoff, gbase, voff) do { _Pragma("unroll") for (int _i = 0; _i < 2; ++_i) \
        __builtin_amdgcn_global_load_lds((const unsigned*)((const char*)(gbase) + (voff)[_i]), (LAS unsigned*)(lds + (bufoff) + ldsw + _i * 8192), 16, 0, 0); } while (0)
#define PG8_LDA(dst, b, h) do { _Pragma("unroll") for (int m = 0; m < 4; ++m) _Pragma("unroll") for (int k = 0; k < 2; ++k) dst[m][k] = *(const LAS bf16x8*)(lds + PG8_SA(b, h) + aoff + m * 2048 + k * 1024); } while (0)
#define PG8_LDB(dst, b, h) do { _Pragma("unroll") for (int n = 0; n < 2; ++n) _Pragma("unroll") for (int k = 0; k < 2; ++k) dst[n][k] = *(const LAS bf16x8*)(lds + PG8_SB(b, h) + boff + n * 2048 + k * 1024); } while (0)
#define PG8_MMA(ai, bj, At, Bt) do { __builtin_amdgcn_s_setprio(1); _Pragma("unroll") for (int m = 0; m < 4; ++m) _Pragma("unroll") for (int n = 0; n < 2; ++n) _Pragma("unroll") for (int k = 0; k < 2; ++k) \
        acc[ai][bj][m][n] = __builtin_amdgcn_mfma_f32_16x16x32_bf16(Bt[n][k], At[m][k], acc[ai][bj][m][n], 0, 0, 0); __builtin_amdgcn_s_setprio(0); } while (0)
#define PG8_WAIT_V(n) asm volatile("s_waitcnt vmcnt(" #n ")" ::: "memory")
#define PG8_WAIT_L(n) asm volatile("s_waitcnt lgkmcnt(" #n ")" ::: "memory")
#define PG8_BAR __builtin_amdgcn_s_barrier()
#define PG8_SCHED __builtin_amdgcn_sched_barrier(0)
    Unit cur, nxt; int ui = 0;
    if (!S.next(0, cur)) return;
    Acc acc;
#pragma unroll
    for (int a = 0; a < 2; ++a)
#pragma unroll
        for (int b = 0; b < 2; ++b)
#pragma unroll
            for (int m = 0; m < 4; ++m)
#pragma unroll
                for (int n = 0; n < 2; ++n) acc[a][b][m][n] = (f32x4){0.f, 0.f, 0.f, 0.f};
    bf16x8 At[4][2], B0[2][2], B1[2][2];
    const char* cA = (const char*)g.A + cur.ao; const char* cB = (const char*)g.Bt + cur.bo;
    S.a_ready(cur);
    PG8_STAGE(PG8_SB(0, 0), cB, voffB); PG8_STAGE(PG8_SA(0, 0), cA, voffA); PG8_STAGE(PG8_SB(0, 1), cB + hstepB, voffB); PG8_STAGE(PG8_SA(0, 1), cA + hstepA, voffA);
    if (wr == 1) PG8_BAR;
    PG8_WAIT_V(4); PG8_BAR;
    PG8_STAGE(PG8_SB(1, 0), cB + kstep, voffB); PG8_STAGE(PG8_SA(1, 0), cA + kstep, voffA); PG8_STAGE(PG8_SB(1, 1), cB + hstepB + kstep, voffB);
    PG8_WAIT_V(6); PG8_BAR;
    for (;;) {
        const bool has_next = S.next(ui + 1, nxt);
        const char* nA = has_next ? (const char*)g.A + nxt.ao : cA; const char* nB = has_next ? (const char*)g.Bt + nxt.bo : cB;
        for (int t = 0; t < nt; t += 2) {
            const bool last = (t == nt - 2);
            const char* a1 = cA + (size_t)(t + 1) * kstep;
            const char* a2 = last ? nA : cA + (size_t)(t + 2) * kstep; const char* b2 = last ? nB : cB + (size_t)(t + 2) * kstep;
            const char* a3 = a2 + kstep; const char* b3 = b2 + kstep;
            if (last && has_next) S.a_ready(nxt);
            PG8_LDB(B0, 0, 0); PG8_SCHED; PG8_LDA(At, 0, 0); PG8_STAGE(PG8_SA(1, 1), a1 + hstepA, voffA);
            PG8_WAIT_L(8); PG8_BAR; PG8_WAIT_L(0); PG8_MMA(0, 0, At, B0); PG8_BAR; PG8_SCHED;
            PG8_LDB(B1, 0, 1); PG8_STAGE(PG8_SB(0, 0), b2, voffB);
            PG8_BAR; PG8_WAIT_L(0); PG8_MMA(0, 1, At, B1); PG8_BAR;
            PG8_LDA(At, 0, 1); PG8_STAGE(PG8_SA(0, 0), a2, voffA);
            PG8_BAR; PG8_WAIT_L(0); PG8_MMA(1, 0, At, B0); PG8_BAR; PG8_SCHED;
            PG8_STAGE(PG8_SB(0, 1), b2 + hstepB, voffB);
            PG8_WAIT_V(6); PG8_BAR; PG8_MMA(1, 1, At, B1); PG8_BAR;
            PG8_LDB(B0, 1, 0); PG8_SCHED; PG8_LDA(At, 1, 0); PG8_STAGE(PG8_SA(0, 1), a2 + hstepA, voffA);
            PG8_WAIT_L(8); PG8_BAR; PG8_WAIT_L(0); PG8_MMA(0, 0, At, B0); PG8_BAR; PG8_SCHED;
            PG8_LDB(B1, 1, 1); PG8_STAGE(PG8_SB(1, 0), b3, voffB);
            PG8_BAR; PG8_WAIT_L(0); PG8_MMA(0, 1, At, B1); PG8_BAR;
            PG8_LDA(At, 1, 1); PG8_STAGE(PG8_SA(1, 0), a3, voffA);
            PG8_BAR; PG8_WAIT_L(0); PG8_MMA(1, 0, At, B0); PG8_BAR; PG8_SCHED;
            PG8_STAGE(PG8_SB(1, 1), b3 + hstepB, voffB);
            PG8_WAIT_V(6); PG8_BAR; PG8_MMA(1, 1, At, B1); PG8_BAR;
        }
        const bool keep = E(acc, cur, wr, wc, fr, fq); S.done(cur);
        if (!has_next) break;
        if (!keep) {
#pragma unroll
        for (int a = 0; a < 2; ++a)
#pragma unroll
            for (int b = 0; b < 2; ++b)
#pragma unroll
                for (int m = 0; m < 4; ++m)
#pragma unroll
                    for (int n = 0; n < 2; ++n) acc[a][b][m][n] = (f32x4){0.f, 0.f, 0.f, 0.f};
        }
        cur = nxt; cA = nA; cB = nB; ++ui;
    }
    PG8_WAIT_V(0);
    if (wr == 0) PG8_BAR;
    PG8_BAR;
#undef PG8_SA
#undef PG8_SB
#undef PG8_STAGE
#undef PG8_LDA
#undef PG8_LDB
#undef PG8_MMA
#undef PG8_WAIT_V
#undef PG8_WAIT_L
#undef PG8_BAR
#undef PG8_SCHED
}

struct EpiBf16Store {
    static constexpr bool PERM = true;
    bf16_t* O; int ldc;
    __device__ __forceinline__ bool operator()(Acc& acc, const Unit& u, int wr, int wc, int fr, int fq) const {
        const int row0 = u.pm * BM + wr * 64 + fr, col0 = u.pn * BM + wc * 32 + 8 * fq;
#pragma unroll
        for (int ai = 0; ai < 2; ++ai)
#pragma unroll
            for (int m = 0; m < 4; ++m) { bf16_t* rowp = O + (size_t)(row0 + ai * HALF + m * 16) * ldc + col0;
#pragma unroll
                for (int bj = 0; bj < 2; ++bj) { const f32x4 v0 = acc[ai][bj][m][0], v1 = acc[ai][bj][m][1];
                    u32x4 w; w.x = pk2(v0[0], v0[1]); w.y = pk2(v0[2], v0[3]); w.z = pk2(v1[0], v1[1]); w.w = pk2(v1[2], v1[3]);
                    *(u32x4*)(rowp + bj * HALF) = w; } }
        return false;
    }
};
struct EpiWin {
    static constexpr bool PERM = true;
    bf16_t* O; int ldc;
    __device__ __forceinline__ bool operator()(Acc& acc, const Unit& u, int wr, int wc, int fr, int fq) const {
        const int row0 = u.pm * BM + wr * 64 + fr;
        if (u.pn < 23) { const int col0 = u.pn * BM + wc * 32 + 8 * fq;
#pragma unroll
            for (int ai = 0; ai < 2; ++ai)
#pragma unroll
                for (int m = 0; m < 4; ++m)
#pragma unroll
                    for (int bj = 0; bj < 2; ++bj) { const f32x4 v0 = acc[ai][bj][m][0], v1 = acc[ai][bj][m][1];
                        u32x4 w; w.x = pk2(v0[0], v0[1]); w.y = pk2(v0[2], v0[3]); w.z = pk2(v1[0], v1[1]); w.w = pk2(v1[2], v1[3]);
                        *(u32x4*)(O + (size_t)(row0 + ai * HALF + m * 16) * ldc + col0 + bj * HALF) = w; }
        } else { const int colb = GATE2 + 64 * (u.pn - 23) + 16 * wc + 4 * fq;
#pragma unroll
            for (int ai = 0; ai < 2; ++ai)
#pragma unroll
                for (int m = 0; m < 4; ++m) { f32x4 sg[4];
#pragma unroll
                    for (int bj = 0; bj < 2; ++bj)
#pragma unroll
                        for (int n = 0; n < 2; ++n) { const f32x4 v = acc[ai][bj][m][n];
#pragma unroll
                            for (int j = 0; j < 4; ++j) sg[2 * bj + n][j] = 1.0f + __expf(-v[j]); }
                    bf16_t* op = O + (size_t)(row0 + ai * HALF + m * 16) * ldc + colb;
#pragma unroll
                    for (int k = 0; k < 4; ++k) { f32x4 r;
#pragma unroll
                        for (int j = 0; j < 4; ++j) { const float ia = __builtin_amdgcn_rcpf(sg[k][j]); r[j] = k < 3 ? sg[k + 1][j] * ia : ia; }
                        u32x2 w; w.x = pk2(r[0], r[1]); w.y = pk2(r[2], r[3]); *(u32x2*)(op + k * DM) = w; } }
        }
        return false;
    }
};
struct EpiNone { static constexpr bool PERM = true;
    __device__ __forceinline__ bool operator()(Acc& acc, const Unit&, int, int, int, int) const {
#pragma unroll
        for (int a = 0; a < 2; ++a)
#pragma unroll
            for (int b = 0; b < 2; ++b)
#pragma unroll
                for (int m = 0; m < 4; ++m)
#pragma unroll
                    for (int n = 0; n < 2; ++n) asm volatile("" :: "v"(acc[a][b][m][n]));
        return false; } };
struct EpiGlu {
    static constexpr bool PERM = true;
    const bf16_t* GG; const float* bias; bf16_t* Y4;
    __device__ __forceinline__ bool operator()(Acc& acc, const Unit& u, int wr, int wc, int fr, int fq) const {
        const int row0 = u.pm * BM + wr * 64 + fr, col0 = u.pn * BM + wc * 32 + 8 * fq;
#pragma unroll
        for (int bj = 0; bj < 2; ++bj) { const int col = col0 + bj * HALF; const f32x4 b0 = *(const f32x4*)(bias + col), b1 = *(const f32x4*)(bias + col + 4);
            u32x4 gq[2][4];
#pragma unroll
            for (int ai = 0; ai < 2; ++ai)
#pragma unroll
                for (int m = 0; m < 4; ++m) gq[ai][m] = *(const u32x4*)(GG + (size_t)(row0 + ai * HALF + m * 16) * BW + col);
#pragma unroll
            for (int ai = 0; ai < 2; ++ai)
#pragma unroll
                for (int m = 0; m < 4; ++m) { const size_t row = (size_t)(row0 + ai * HALF + m * 16);
                    float gg[8]; unpack8(gq[ai][m], gg);
                    const f32x4 v0 = acc[ai][bj][m][0] + b0, v1 = acc[ai][bj][m][1] + b1;
                    u32x4 w; w.x = pk2(gg[0] * sigmoidf_(v0[0]), gg[1] * sigmoidf_(v0[1])); w.y = pk2(gg[2] * sigmoidf_(v0[2]), gg[3] * sigmoidf_(v0[3]));
                    w.z = pk2(gg[4] * sigmoidf_(v1[0]), gg[5] * sigmoidf_(v1[1])); w.w = pk2(gg[6] * sigmoidf_(v1[2]), gg[7] * sigmoidf_(v1[3]));
                    *(u32x4*)(Y4 + row * DM + 1024 + col) = w; } }
        return false;
    }
};
struct EpiBranch {
    static constexpr bool PERM = true;
    const bf16_t* P; bf16_t* ACCb;
    __device__ __forceinline__ bool operator()(Acc& acc, const Unit& u, int wr, int wc, int fr, int fq) const {
        const int row0 = u.pm * BM + wr * 64 + fr, col0 = u.pn * BM + wc * 32 + 8 * fq; const int k = u.k;
        const bf16_t* gbase = P + (size_t)row0 * LDP + GATE2 + k * DM + col0;
        u32x4 ga[2][8];
#pragma unroll
        for (int ai = 0; ai < 2; ++ai)
#pragma unroll
            for (int m = 0; m < 4; ++m)
#pragma unroll
                for (int bj = 0; bj < 2; ++bj) ga[ai][m * 2 + bj] = *(const u32x4*)(gbase + (size_t)(ai * HALF + m * 16) * LDP + bj * HALF);
#pragma unroll
        for (int ai = 0; ai < 2; ++ai)
#pragma unroll
            for (int m = 0; m < 4; ++m)
#pragma unroll
                for (int bj = 0; bj < 2; ++bj) { float sr[8]; unpack8(ga[ai][m * 2 + bj], sr);
                    f32x4 v0 = acc[ai][bj][m][0], v1 = acc[ai][bj][m][1];
                    v0[0] *= sr[0]; v0[1] *= sr[1]; v0[2] *= sr[2]; v0[3] *= sr[3]; v1[0] *= sr[4]; v1[1] *= sr[5]; v1[2] *= sr[6]; v1[3] *= sr[7];
                    if (k < 3) { acc[ai][bj][m][0] = v0; acc[ai][bj][m][1] = v1; }
                    else { u32x4 w; w.x = pk2(v0[0], v0[1]); w.y = pk2(v0[2], v0[3]); w.z = pk2(v1[0], v1[1]); w.w = pk2(v1[2], v1[3]); *(u32x4*)(ACCb + (size_t)(row0 + ai * HALF + m * 16) * DM + col0 + bj * HALF) = w; } }
        return k < 3;
    }
};
struct EpiPartK {
    static constexpr bool PERM = true;
    float* PART;
    __device__ __forceinline__ bool operator()(Acc& acc, const Unit& u, int wr, int wc, int fr, int fq) const {
        const int row0 = u.pm * BM + wr * 64 + fr, col0 = u.pn * BM + wc * 32 + 8 * fq;
        float* pbase = PART + ((size_t)u.k * (NTOK - NLAT) + (size_t)(row0 - NLAT)) * DM + col0;
#pragma unroll
        for (int ai = 0; ai < 2; ++ai)
#pragma unroll
            for (int m = 0; m < 4; ++m)
#pragma unroll
                for (int bj = 0; bj < 2; ++bj) { float* pp = pbase + (size_t)(ai * HALF + m * 16) * DM + bj * HALF; *(f32x4*)pp = acc[ai][bj][m][0]; *(f32x4*)(pp + 4) = acc[ai][bj][m][1]; }
        return false;
    }
};
struct EpiResid {
    static constexpr bool PERM = false;
    float* XS; const float* srcLat; const float* srcCtx; const float* MODl; int gidx;
    __device__ __forceinline__ bool operator()(Acc& acc, const Unit& u, int wr, int wc, int fr, int fq) const {
        const int row0 = u.pm * BM + wr * 64 + fr, col0 = u.pn * BM + wc * 32 + 4 * fq;
        const int r = (u.pm * BM) < NLAT ? (u.pm * BM) / SEQ : 4;
        const float* src = (u.pm * BM) < NLAT ? srcLat : srcCtx;
        const float* mg = MODl + (size_t)(r * 6 + gidx) * DM;
#pragma unroll
        for (int bj = 0; bj < 2; ++bj) {
            f32x4 gm[2], xs[2][2][4];
#pragma unroll
            for (int n = 0; n < 2; ++n) { const int col = col0 + bj * HALF + n * 16; gm[n] = *(const f32x4*)(mg + col);
#pragma unroll
                for (int ai = 0; ai < 2; ++ai)
#pragma unroll
                    for (int m = 0; m < 4; ++m) xs[n][ai][m] = *(const f32x4*)(src + (size_t)(row0 + ai * HALF + m * 16) * DM + col); }
#pragma unroll
            for (int n = 0; n < 2; ++n) { const int col = col0 + bj * HALF + n * 16;
#pragma unroll
                for (int ai = 0; ai < 2; ++ai)
#pragma unroll
                    for (int m = 0; m < 4; ++m) *(f32x4*)(XS + (size_t)(row0 + ai * HALF + m * 16) * DM + col) = xs[n][ai][m] + gm[n] * acc[ai][bj][m][n]; } }
        return false;
    }
};
struct EpiMoe1 {
    static constexpr bool PERM = true;
    bf16_t* HID;
    __device__ __forceinline__ bool operator()(Acc& acc, const Unit& u, int wr, int wc, int fr, int fq) const {
        const size_t row0 = (size_t)u.z * MOE_PAD + u.pm * BM + wr * 64 + fr; const int col0 = u.pn * HALF + wc * 32 + 8 * fq;
#pragma unroll
        for (int ai = 0; ai < 2; ++ai)
#pragma unroll
            for (int m = 0; m < 4; ++m) { const f32x4 g0 = acc[ai][0][m][0], g1 = acc[ai][0][m][1], u0 = acc[ai][1][m][0], u1 = acc[ai][1][m][1];
                float h[8];
#pragma unroll
                for (int j = 0; j < 4; ++j) { h[j] = g0[j] * __builtin_amdgcn_rcpf(1.0f + __expf(-g0[j])) * u0[j]; h[4 + j] = g1[j] * __builtin_amdgcn_rcpf(1.0f + __expf(-g1[j])) * u1[j]; }
                u32x4 w; w.x = pk2(h[0], h[1]); w.y = pk2(h[2], h[3]); w.z = pk2(h[4], h[5]); w.w = pk2(h[6], h[7]);
                *(u32x4*)(HID + (row0 + ai * HALF + m * 16) * DEXP + col0) = w; }
        return false;
    }
};
struct EpiMoeY {
    static constexpr bool PERM = true;
    bf16_t* O;
    __device__ __forceinline__ bool operator()(Acc& acc, const Unit& u, int wr, int wc, int fr, int fq) const {
        const size_t row0 = (size_t)u.z * MOE_PAD + u.pm * BM + wr * 64 + fr; const int col0 = u.pn * BM + wc * 32 + 8 * fq;
#pragma unroll
        for (int ai = 0; ai < 2; ++ai)
#pragma unroll
            for (int m = 0; m < 4; ++m) { bf16_t* rowp = O + (row0 + ai * HALF + m * 16) * DM + col0;
#pragma unroll
                for (int bj = 0; bj < 2; ++bj) { const f32x4 v0 = acc[ai][bj][m][0], v1 = acc[ai][bj][m][1];
                    u32x4 w; w.x = pk2(v0[0], v0[1]); w.y = pk2(v0[2], v0[3]); w.z = pk2(v1[0], v1[1]); w.w = pk2(v1[2], v1[3]);
                    *(u32x4*)(rowp + bj * HALF) = w; } }
        return false;
    }
};

struct SchedS5a {
    int c;
    __device__ __forceinline__ bool next(int i, Unit& u) const { if (i > 0 || c >= 64) return false; u.z = c >> 1; u.pm = c & 1; u.pn = 0; u.k = 0;
        u.ao = ((long long)u.z * 512 + u.pm * BM) * 768 * 2; u.bo = (long long)u.z * 256 * 512 * 2; return true; }
    __device__ __forceinline__ void a_ready(const Unit&) const {}
    __device__ __forceinline__ void done(const Unit&) const {}
};
struct SchedS5b {
    int c;
    __device__ __forceinline__ bool next(int i, Unit& u) const { if (i > 0 || c >= 128) return false; u.z = c >> 2; u.pm = (c >> 1) & 1; u.pn = c & 1; u.k = 0;
        u.ao = ((long long)u.z * 512 + u.pm * BM) * 768 * 2; u.bo = ((long long)u.z * 512 + u.pn * BM) * 768 * 2; return true; }
    __device__ __forceinline__ void a_ready(const Unit&) const {}
    __device__ __forceinline__ void done(const Unit&) const {}
};
struct EpiXloc {
    static constexpr bool PERM = false;
    float* XL;
    __device__ __forceinline__ bool operator()(Acc& acc, const Unit& u, int wr, int wc, int fr, int fq) const {
        const int row0 = u.pm * BM + wr * 64 + fr, col0 = wc * 32 + 4 * fq; float* base = XL + (size_t)u.z * 512 * 256;
#pragma unroll
        for (int ai = 0; ai < 2; ++ai)
#pragma unroll
            for (int m = 0; m < 4; ++m) { float* rowp = base + (size_t)(row0 + ai * HALF + m * 16) * 256 + col0;
#pragma unroll
                for (int bj = 0; bj < 2; ++bj)
#pragma unroll
                    for (int n = 0; n < 2; ++n) *(f32x4*)(rowp + bj * HALF + n * 16) = acc[ai][bj][m][n]; }
        return false;
    }
};
struct EpiS5Out {
    static constexpr bool PERM = true;
    const bf16_t* P; const float* dskip; bf16_t* GG;
    __device__ __forceinline__ bool operator()(Acc& acc, const Unit& u, int wr, int wc, int fr, int fq) const {
        const int row0 = u.pm * BM + wr * 64 + fr, col0 = u.pn * BM + wc * 32 + 8 * fq; const int g = u.z;
#pragma unroll
        for (int bj = 0; bj < 2; ++bj) { const int col = col0 + bj * HALF; const int t = col >> 4, c0 = col & 15;
            const f32x4 d0 = *(const f32x4*)(dskip + g * 16 + c0), d1 = *(const f32x4*)(dskip + g * 16 + c0 + 4);
            u32x4 uq[2][4];
#pragma unroll
            for (int ai = 0; ai < 2; ++ai)
#pragma unroll
                for (int m = 0; m < 4; ++m) uq[ai][m] = *(const u32x4*)(P + ((size_t)(row0 + ai * HALF + m * 16) * 32 + t) * LDP + S5_OFF + g * 16 + c0);
#pragma unroll
            for (int ai = 0; ai < 2; ++ai)
#pragma unroll
                for (int m = 0; m < 4; ++m) { const size_t tok = (size_t)(row0 + ai * HALF + m * 16) * 32 + t;
                    float uu[8]; unpack8(uq[ai][m], uu);
                    const f32x4 v0 = acc[ai][bj][m][0], v1 = acc[ai][bj][m][1];
                    float y[8] = {v0[0] + d0[0] * uu[0], v0[1] + d0[1] * uu[1], v0[2] + d0[2] * uu[2], v0[3] + d0[3] * uu[3], v1[0] + d1[0] * uu[4], v1[1] + d1[1] * uu[5], v1[2] + d1[2] * uu[6], v1[3] + d1[3] * uu[7]};
#pragma unroll
                    for (int j = 0; j < 8; ++j) y[j] = 0.5f * y[j] * (1.0f + tanhf(0.7978845608028654f * (y[j] + 0.044715f * y[j] * y[j] * y[j])));
                    u32x4 w; w.x = pk2(y[0], y[1]); w.y = pk2(y[2], y[3]); w.z = pk2(y[4], y[5]); w.w = pk2(y[6], y[7]);
                    *(u32x4*)(GG + tok * BW + g * 16 + c0) = w; } }
        return false;
    }
};
}


__device__ __forceinline__ float wave_scan_incl(float v, int lane) {
#pragma unroll
    for (int o = 1; o < 64; o <<= 1) { const float t = __shfl_up(v, o); if (lane >= o) v += t; }
    return v;
}
__device__ __forceinline__ float wave_scanmax_incl(float v, int lane) {
#pragma unroll
    for (int o = 1; o < 64; o <<= 1) { const float t = __shfl_up(v, o); if (lane >= o) v = fmaxf(v, t); }
    return v;
}
__device__ __forceinline__ float wave_max(float v) {
#pragma unroll
    for (int o = 32; o >= 1; o >>= 1) v = fmaxf(v, __shfl_xor(v, o));
    return v;
}
__device__ __forceinline__ void unpack8h(const u32x4 w, bf16_t (&h)[8]) {
    h[0] = (bf16_t)(w.x & 0xFFFFu); h[1] = (bf16_t)(w.x >> 16); h[2] = (bf16_t)(w.y & 0xFFFFu); h[3] = (bf16_t)(w.y >> 16);
    h[4] = (bf16_t)(w.z & 0xFFFFu); h[5] = (bf16_t)(w.z >> 16); h[6] = (bf16_t)(w.w & 0xFFFFu); h[7] = (bf16_t)(w.w >> 16);
}

__device__ __forceinline__ int tokblock_of(int b, int dir, int c) { if (c < 4) return 256 + b * 4 + (dir ? 3 - c : c); const int j = c - 4; return b * 64 + (dir ? 63 - j : j); }
__device__ __forceinline__ u32x4 rev8h(const u32x4 v) { u32x4 r; r.x = (v.w >> 16) | (v.w << 16); r.y = (v.z >> 16) | (v.z << 16); r.z = (v.y >> 16) | (v.y << 16); r.w = (v.x >> 16) | (v.x << 16); return r; }
__device__ __forceinline__ u32x4 scale8h(const u32x4 v, const float4 a, const float4 b) { float f[8]; unpack8(v, f); u32x4 r; r.x = pk2(f[0] * a.x, f[1] * a.y); r.y = pk2(f[2] * a.z, f[3] * a.w); r.z = pk2(f[4] * b.x, f[5] * b.y); r.w = pk2(f[6] * b.z, f[7] * b.w); return r; }
__device__ __forceinline__ float dot8h(const u32x4 v, const float4 a, const float4 b) { float f[8]; unpack8(v, f); return (f[0] * a.x + f[1] * a.y) + (f[2] * a.z + f[3] * a.w) + (f[4] * b.x + f[5] * b.y) + (f[6] * b.z + f[7] * b.w); }
#define ML_FRAG_LOAD(KF, VF, cc_) do { const int tb_ = tokblock_of(b, dir, (cc_)); const bf16_t* kb_ = KTg + ((size_t)tb_ * 512 + h * 128 + 32 * wd + r16) * 64 + q4 * 8; const bf16_t* vb_ = VTg + ((size_t)tb_ * 512 + h * 128 + 64 * half + 32 * we + r16) * 64 + q4 * 8; \
        _Pragma("unroll") for (int ks_ = 0; ks_ < 2; ++ks_) _Pragma("unroll") for (int j_ = 0; j_ < 2; ++j_) { VF[j_][ks_] = *(const u32x4*)(vb_ + (size_t)j_ * 16 * 64 + ks_ * 32); KF[j_][ks_] = *(const u32x4*)(kb_ + (size_t)j_ * 16 * 64 + ks_ * 32); } } while (0)
#define ML_CHUNK(c_, KF, VF, KFN, VFN) do { const int c = (c_); \
        if (c + 1 < 68) ML_FRAG_LOAD(KFN, VFN, c + 1);                        \
        const float dec = sDEC[c]; \
        {   bf16_t* cs = CST + (size_t)(chain * 68 + c) * 128 * 128; \
            _Pragma("unroll") for (int je = 0; je < 2; ++je) _Pragma("unroll") for (int jd = 0; jd < 2; ++jd) { const int e = 64 * half + 32 * we + 16 * je + r16, d0 = 32 * wd + 16 * jd + q4 * 4; \
                u32x2 pk; pk.x = pk2(acc[je][jd][0], acc[je][jd][1]); pk.y = pk2(acc[je][jd][2], acc[je][jd][3]); *(u32x2*)(cs + (size_t)e * 128 + d0) = pk; } \
            if (nown) { _Pragma("unroll") for (int jd = 0; jd < 2; ++jd) { float nv = npart[jd]; nv += __shfl_xor(nv, 16); nv += __shfl_xor(nv, 32); if (q4 == 0) NST[(size_t)(chain * 68 + c) * 128 + 32 * wd + 16 * jd + r16] = nv; } } } \
        bf16x8 vfr[2][2]; \
        _Pragma("unroll") for (int ks = 0; ks < 2; ++ks) { const float4 wa = *(const float4*)(sWS + c * 64 + ks * 32 + q4 * 8), wb = *(const float4*)(sWS + c * 64 + ks * 32 + q4 * 8 + 4); \
            _Pragma("unroll") for (int je = 0; je < 2; ++je) { const u32x4 sv = scale8h(VF[je][ks], wa, wb); vfr[je][ks] = *(const bf16x8*)&sv; } \
            if (nown) { _Pragma("unroll") for (int jd = 0; jd < 2; ++jd) npart[jd] = (ks == 0 ? dec * npart[jd] : npart[jd]) + dot8h(KF[jd][ks], wa, wb); } } \
        _Pragma("unroll") for (int je = 0; je < 2; ++je) _Pragma("unroll") for (int jd = 0; jd < 2; ++jd) acc[je][jd] = acc[je][jd] * dec; \
        _Pragma("unroll") for (int ks = 0; ks < 2; ++ks) _Pragma("unroll") for (int je = 0; je < 2; ++je) _Pragma("unroll") for (int jd = 0; jd < 2; ++jd) \
            acc[je][jd] = __builtin_amdgcn_mfma_f32_16x16x32_bf16(*(const bf16x8*)&KF[jd][ks], vfr[je][ks], acc[je][jd], 0, 0, 0); } while (0)
__device__ __forceinline__ void mlstm_state_pass(const int chain, const int half, const bf16_t* __restrict__ Pm, const bf16_t* __restrict__ KTg, const bf16_t* __restrict__ VTg, const float* __restrict__ gate_b,
                                                 bf16_t* __restrict__ CST, float* __restrict__ NST, float* __restrict__ MST, unsigned char* shm, const int tid) {
    const int dir = chain & 1, h = (chain >> 1) & 3, b = chain >> 3, lane = tid & 63, w = tid >> 6, we = w >> 2, wd = w & 3, q4 = lane >> 4, r16 = lane & 15;
    const bool nown = (half == 0) && (we == 0);
    float* sE = (float*)shm; float* sWS = sE + 68 * 64; float* sAL = sWS + 68 * 64; float* sBE = sAL + 68; float* sMO = sBE + 68; float* sDEC = sMO + 68; float* sMB = sDEC + 68;
    const float gbi = gate_b[(dir * 2 + 0) * 4 + h], gbf = gate_b[(dir * 2 + 1) * 4 + h];
    const int gcol_i = ML_OFF + 2048 + (dir * 2 + 0) * 4 + h, gcol_f = ML_OFF + 2048 + (dir * 2 + 1) * 4 + h;
    u32x4 kfA[2][2], vfA[2][2], kfB[2][2], vfB[2][2];
    ML_FRAG_LOAD(kfA, vfA, 0);
    __syncthreads();
    unsigned gi_[9], gf_[9];
#pragma unroll
    for (int q = 0; q < 9; ++q) { const int c = min(w + 8 * q, 67); const size_t tokl = (size_t)step_tok(b, dir, c * 64 + lane); gi_[q] = Pm[tokl * LDP + gcol_i]; gf_[q] = Pm[tokl * LDP + gcol_f]; }
#pragma unroll
    for (int q = 0; q < 9; ++q) { const int c = w + 8 * q; if (c >= 68) break;
        const float ig = __uint_as_float(gi_[q] << 16) + gbi, fg = __uint_as_float(gf_[q] << 16) + gbf;
        const float lf = fminf(fg, 0.f) - log1pf(expf(-fabsf(fg)));
        const float bcs = wave_scan_incl(lf, lane); const float blast = __shfl(bcs, 63); const float ei = blast - bcs + ig; const float beta = wave_max(ei);
        sE[c * 64 + lane] = ei; if (lane == 0) { sAL[c] = blast; sBE[c] = beta; } }
    __syncthreads();
    if (tid == 0) { float m = 0.f; for (int c = 0; c < 68; ++c) { sMB[c] = m; const float mo = fmaxf(m + sAL[c], sBE[c]); sDEC[c] = expf(sAL[c] + m - mo); sMO[c] = mo; m = mo; } }
    __syncthreads();
    for (int idx = tid; idx < 68 * 64; idx += NTHR) { const int c = idx >> 6, i = idx & 63; sWS[c * 64 + (dir ? 63 - i : i)] = expf(sE[idx] - sMO[c]); }
    if (half == 0 && tid < 68) MST[chain * 68 + tid] = sMB[tid];
    __syncthreads();
    f32x4 acc[2][2];
#pragma unroll
    for (int je = 0; je < 2; ++je)
#pragma unroll
        for (int jd = 0; jd < 2; ++jd) acc[je][jd] = (f32x4){0.f, 0.f, 0.f, 0.f};
    float npart[2] = {0.f, 0.f};
    for (int c2 = 0; c2 < 68; c2 += 2) { ML_CHUNK(c2, kfA, vfA, kfB, vfB); ML_CHUNK(c2 + 1, kfB, vfB, kfA, vfA); }
    __syncthreads();
}
#undef ML_CHUNK
#undef ML_FRAG_LOAD
__device__ __forceinline__ void mlstm_out_item(const int chain, const int c, const bf16_t* __restrict__ Pm, const bf16_t* __restrict__ QKb, const bf16_t* __restrict__ VTg, const float* __restrict__ gate_b,
                                               const bf16_t* __restrict__ CST, const float* __restrict__ NST, const float* __restrict__ MST, bf16_t* __restrict__ Hout, unsigned char* shm, const int tid) {
    const int dir = chain & 1, h = (chain >> 1) & 3, b = chain >> 3, lane = tid & 63, w = tid >> 6;
    bf16_t* Qs = (bf16_t*)shm; bf16_t* Ks = (bf16_t*)(shm + 17408); bf16_t* VT = (bf16_t*)(shm + 34816); bf16_t* Cs = (bf16_t*)(shm + 53248); bf16_t* Ss = (bf16_t*)(shm + 88064);
    float* sc = (float*)(shm + 97280);
    __syncthreads();
    u32x4 gq[2], gk[2], gv[2], gc[4]; float gn = 0.f;
#pragma unroll
    for (int i = 0; i < 2; ++i) { const int pid = tid + i * 512; const int s = pid >> 4, x0 = (pid & 15) * 8; const size_t toks = (size_t)step_tok(b, dir, c * 64 + s);
        gq[i] = *(const u32x4*)(QKb + toks * 1024 + h * 128 + x0);
        gk[i] = *(const u32x4*)(QKb + toks * 1024 + 512 + h * 128 + x0);
        { const int e = pid >> 3, o = pid & 7;
          gv[i] = *(const u32x4*)(VTg + ((size_t)tokblock_of(b, dir, c) * 512 + h * 128 + e) * 64 + (dir ? 7 - o : o) * 8); } }
#pragma unroll
    for (int i = 0; i < 4; ++i) { const int pid = tid + i * 512; const int e = pid >> 4, x0 = (pid & 15) * 8;
        gc[i] = *(const u32x4*)(CST + ((size_t)(chain * 68 + c) * 128 + e) * 128 + x0); }
    if (tid < 128) gn = NST[(size_t)(chain * 68 + c) * 128 + tid];
    unsigned gi_ = 0u, gf_ = 0u; float gbi = 0.f, gbf = 0.f, m_in = 0.f;
    if (w == 0) { const size_t tokl = (size_t)step_tok(b, dir, c * 64 + lane);
        gi_ = Pm[tokl * LDP + ML_OFF + 2048 + (dir * 2 + 0) * 4 + h]; gf_ = Pm[tokl * LDP + ML_OFF + 2048 + (dir * 2 + 1) * 4 + h];
        gbi = gate_b[(dir * 2 + 0) * 4 + h]; gbf = gate_b[(dir * 2 + 1) * 4 + h]; m_in = MST[chain * 68 + c]; }
#pragma unroll
    for (int i = 0; i < 2; ++i) { const int pid = tid + i * 512; const int s = pid >> 4, x0 = (pid & 15) * 8;
        *(u32x4*)(Qs + s * 136 + x0) = gq[i]; *(u32x4*)(Ks + s * 136 + x0) = gk[i];
        { const int e = pid >> 3, o = pid & 7; *(u32x4*)(VT + e * 72 + o * 8) = dir ? rev8h(gv[i]) : gv[i]; } }
#pragma unroll
    for (int i = 0; i < 4; ++i) { const int pid = tid + i * 512; const int e = pid >> 4, x0 = (pid & 15) * 8; *(u32x4*)(Cs + e * 136 + x0) = gc[i]; }
    if (tid < 128) sc[384 + tid] = gn;
    if (w == 0) {
        const float ig = __uint_as_float(gi_ << 16) + gbi;
        const float fg = __uint_as_float(gf_ << 16) + gbf;
        const float lf = fminf(fg, 0.f) - log1pf(expf(-fabsf(fg)));
        const float bcs = wave_scan_incl(lf, lane); const float gsv = ig - bcs; const float pm = wave_scanmax_incl(gsv, lane);
        const float mt = bcs + fmaxf(m_in, pm);
        sc[lane] = bcs; sc[64 + lane] = gsv; sc[128 + lane] = mt; sc[192 + lane] = expf(bcs + m_in - mt); sc[256 + lane] = expf(-mt);
    }
    __syncthreads();
    const int tt = w >> 1;
    {   f32x4 aS[2] = {(f32x4){0.f, 0.f, 0.f, 0.f}, (f32x4){0.f, 0.f, 0.f, 0.f}};
#pragma unroll
        for (int ks = 0; ks < 4; ++ks) { const bf16x8 af = *(const bf16x8*)(Qs + (16 * tt + (lane & 15)) * 136 + ks * 32 + (lane >> 4) * 8);
#pragma unroll
            for (int i = 0; i < 2; ++i) { const int st = (w & 1) * 2 + i; const bf16x8 bfr = *(const bf16x8*)(Ks + (16 * st + (lane & 15)) * 136 + ks * 32 + (lane >> 4) * 8);
                aS[i] = __builtin_amdgcn_mfma_f32_16x16x32_bf16(af, bfr, aS[i], 0, 0, 0); } }
        float rs[4] = {0.f, 0.f, 0.f, 0.f};
#pragma unroll
        for (int i = 0; i < 2; ++i) { const int s = 16 * ((w & 1) * 2 + i) + (lane & 15); const float gsv = sc[64 + s];
#pragma unroll
            for (int q = 0; q < 4; ++q) { const int t = 16 * tt + (lane >> 4) * 4 + q; const float val = (s <= t) ? aS[i][q] * expf(sc[t] + gsv - sc[128 + t]) : 0.f; Ss[t * 72 + s] = f2bf(val); rs[q] += val; } }
#pragma unroll
        for (int q = 0; q < 4; ++q) { float r = rs[q]; r += __shfl_xor(r, 1); r += __shfl_xor(r, 2); r += __shfl_xor(r, 4); r += __shfl_xor(r, 8);
            if ((lane & 15) == 0) sc[512 + (w & 1) * 64 + 16 * tt + (lane >> 4) * 4 + q] = r; }
        {   const int t = tid >> 3, part = tid & 7; float dot = 0.f;
#pragma unroll
            for (int j = 0; j < 16; ++j) dot += bf2f(Qs[t * 136 + part * 16 + j]) * sc[384 + part * 16 + j];
            dot += __shfl_xor(dot, 1); dot += __shfl_xor(dot, 2); dot += __shfl_xor(dot, 4);
            if (part == 0) sc[640 + t] = sc[192 + t] * dot; }
    }
    __syncthreads();
    {   f32x4 aN[4];
#pragma unroll
        for (int i = 0; i < 4; ++i) aN[i] = (f32x4){0.f, 0.f, 0.f, 0.f};
#pragma unroll
        for (int ks = 0; ks < 4; ++ks) { const bf16x8 af = *(const bf16x8*)(Qs + (16 * tt + (lane & 15)) * 136 + ks * 32 + (lane >> 4) * 8);
#pragma unroll
            for (int i = 0; i < 4; ++i) { const int et = (w & 1) * 4 + i; const bf16x8 bfr = *(const bf16x8*)(Cs + (16 * et + (lane & 15)) * 136 + ks * 32 + (lane >> 4) * 8);
                aN[i] = __builtin_amdgcn_mfma_f32_16x16x32_bf16(bfr, af, aN[i], 0, 0, 0); } }
        const int t = 16 * tt + (lane & 15);
        {   const float it = sc[192 + t];
#pragma unroll
            for (int i = 0; i < 4; ++i) { aN[i][0] *= it; aN[i][1] *= it; aN[i][2] *= it; aN[i][3] *= it; } }
#pragma unroll
        for (int ks = 0; ks < 2; ++ks) { const bf16x8 af = *(const bf16x8*)(Ss + (16 * tt + (lane & 15)) * 72 + ks * 32 + (lane >> 4) * 8);
#pragma unroll
            for (int i = 0; i < 4; ++i) { const int et = (w & 1) * 4 + i; const bf16x8 bfr = *(const bf16x8*)(VT + (16 * et + (lane & 15)) * 72 + ks * 32 + (lane >> 4) * 8);
                aN[i] = __builtin_amdgcn_mfma_f32_16x16x32_bf16(bfr, af, aN[i], 0, 0, 0); } }
        {   const size_t tokt = (size_t)step_tok(b, dir, c * 64 + t); const float dn = fmaxf(fabsf((sc[512 + t] + sc[576 + t]) + sc[640 + t]), sc[256 + t]);
#pragma unroll
            for (int i = 0; i < 4; ++i) { const int e0 = 16 * ((w & 1) * 4 + i) + (lane >> 4) * 4;
                u32x2 wv; wv.x = pk2(aN[i][0] / dn, aN[i][1] / dn); wv.y = pk2(aN[i][2] / dn, aN[i][3] / dn);
                *(u32x2*)(Hout + tokt * BW + h * 128 + e0) = wv; } }
    }
}


#define SD_FRAG_LOAD(BF, XF, cc_) do { const int tb_ = tokblock_of(b, dir, (cc_)); const bf16_t* bb_ = BTg + ((size_t)tb_ * 256 + grp * 128 + 64 * (w >> 2) + r16) * 64 + q4 * 8; const bf16_t* xb_ = XTg + ((size_t)tb_ * 512 + h * 64 + 16 * (w & 3) + r16) * 64 + q4 * 8; \
        _Pragma("unroll") for (int ks_ = 0; ks_ < 2; ++ks_) { XF[ks_] = *(const u32x4*)(xb_ + ks_ * 32); _Pragma("unroll") for (int j_ = 0; j_ < 4; ++j_) BF[j_][ks_] = *(const u32x4*)(bb_ + (size_t)j_ * 16 * 64 + ks_ * 32); } } while (0)
#define SD_CHUNK(c_, BF, XF, BFN, XFN) do { const int c = (c_); \
        if (c + 1 < 68) SD_FRAG_LOAD(BFN, XFN, c + 1); \
        const float dec = sDEC[c]; \
        {   bf16_t* ss = SSTb + (size_t)(chain * 68 + c) * 64 * 128; const int p = 16 * (w & 3) + r16; \
            _Pragma("unroll") for (int j = 0; j < 4; ++j) { const int n0 = 16 * ((w >> 2) * 4 + j) + q4 * 4; u32x2 pk; pk.x = pk2(acc[j][0], acc[j][1]); pk.y = pk2(acc[j][2], acc[j][3]); *(u32x2*)(ss + (size_t)p * 128 + n0) = pk; } } \
        bf16x8 xfr[2]; \
        _Pragma("unroll") for (int ks = 0; ks < 2; ++ks) { const float4 wa = *(const float4*)(sSC + c * 64 + ks * 32 + q4 * 8), wb = *(const float4*)(sSC + c * 64 + ks * 32 + q4 * 8 + 4); const u32x4 sv = scale8h(XF[ks], wa, wb); xfr[ks] = *(const bf16x8*)&sv; } \
        _Pragma("unroll") for (int j = 0; j < 4; ++j) acc[j] = acc[j] * dec; \
        _Pragma("unroll") for (int ks = 0; ks < 2; ++ks) _Pragma("unroll") for (int j = 0; j < 4; ++j) acc[j] = __builtin_amdgcn_mfma_f32_16x16x32_bf16(*(const bf16x8*)&BF[j][ks], xfr[ks], acc[j], 0, 0, 0); } while (0)
__device__ __forceinline__ void ssd_state_pass(const int chain, const bf16_t* __restrict__ Pm, const bf16_t* __restrict__ BTg, const bf16_t* __restrict__ XTg, const float Aa, const float dtb,
                                               bf16_t* __restrict__ SSTb, unsigned char* shm, const int tid) {
    const int dir = chain & 1, h = (chain >> 1) & 7, b = chain >> 4, grp = h >> 2, lane = tid & 63, w = tid >> 6, q4 = lane >> 4, r16 = lane & 15;
    float* sSC = (float*)shm; float* sDEC = sSC + 68 * 64;
    const int dcol = SSD_OFF + 1536 + dir * 8 + h;
    u32x4 bfA[4][2], xfA[2], bfB[4][2], xfB[2];
    SD_FRAG_LOAD(bfA, xfA, 0);
    __syncthreads();
    unsigned dt_[9];
#pragma unroll
    for (int q = 0; q < 9; ++q) { const int c = min(w + 8 * q, 67); dt_[q] = Pm[(size_t)step_tok(b, dir, c * 64 + lane) * LDP + dcol]; }
#pragma unroll
    for (int q = 0; q < 9; ++q) { const int c = w + 8 * q; if (c >= 68) break;
        const float xv = __uint_as_float(dt_[q] << 16) + dtb; const float dtv = xv > 20.f ? xv : log1pf(expf(xv));
        const float cs = wave_scan_incl(dtv * Aa, lane); const float cl = __shfl(cs, 63);
        sSC[c * 64 + (dir ? 63 - lane : lane)] = dtv * expf(cl - cs); if (lane == 0) sDEC[c] = expf(cl); }
    __syncthreads();
    f32x4 acc[4];
#pragma unroll
    for (int j = 0; j < 4; ++j) acc[j] = (f32x4){0.f, 0.f, 0.f, 0.f};
    for (int c2 = 0; c2 < 68; c2 += 2) { SD_CHUNK(c2, bfA, xfA, bfB, xfB); SD_CHUNK(c2 + 1, bfB, xfB, bfA, xfA); }
    __syncthreads();
}
#undef SD_CHUNK
#undef SD_FRAG_LOAD
__device__ __forceinline__ void ssd_out_item(const int chain, const int c, const bf16_t* __restrict__ Pm, const bf16_t* __restrict__ XBb, const bf16_t* __restrict__ XTg, const float Aa, const float dtb,
                                             const bf16_t* __restrict__ SSTb, bf16_t* __restrict__ Yout, unsigned char* shm, const int tid) {
    const int dir = chain & 1, h = (chain >> 1) & 7, b = chain >> 4, grp = h >> 2, lane = tid & 63, w = tid >> 6;
    bf16_t* Cs = (bf16_t*)shm; bf16_t* Bs = (bf16_t*)(shm + 17408); bf16_t* XT = (bf16_t*)(shm + 34816); bf16_t* Sin = (bf16_t*)(shm + 44032); bf16_t* Gs = (bf16_t*)(shm + 61440);
    float* sc = (float*)(shm + 70656);
    __syncthreads();
    u32x4 gb[2], gcc[2], gs[2], gx; unsigned gd_ = 0u;
#pragma unroll
    for (int i = 0; i < 2; ++i) { const int pid = tid + i * 512; const int s = pid >> 4, x0 = (pid & 15) * 8; const size_t toks = (size_t)step_tok(b, dir, c * 64 + s);
        gb[i] = *(const u32x4*)(XBb + toks * 1024 + 512 + grp * 128 + x0);
        gcc[i] = *(const u32x4*)(XBb + toks * 1024 + 768 + grp * 128 + x0);
        const int p = pid >> 4;
        gs[i] = *(const u32x4*)(SSTb + ((size_t)(chain * 68 + c) * 64 + p) * 128 + x0); }
    {   const int p = tid >> 3, o = tid & 7;
        gx = *(const u32x4*)(XTg + ((size_t)tokblock_of(b, dir, c) * 512 + h * 64 + p) * 64 + (dir ? 7 - o : o) * 8); }
    if (w == 0) gd_ = Pm[(size_t)step_tok(b, dir, c * 64 + lane) * LDP + SSD_OFF + 1536 + dir * 8 + h];
#pragma unroll
    for (int i = 0; i < 2; ++i) { const int pid = tid + i * 512; const int s = pid >> 4, x0 = (pid & 15) * 8;
        *(u32x4*)(Bs + s * 136 + x0) = gb[i]; *(u32x4*)(Cs + s * 136 + x0) = gcc[i]; *(u32x4*)(Sin + s * 136 + x0) = gs[i]; }
    {   const int p = tid >> 3, o = tid & 7; *(u32x4*)(XT + p * 72 + o * 8) = dir ? rev8h(gx) : gx; }
    if (w == 0) {
        const float xv = __uint_as_float(gd_ << 16) + dtb; const float dtv = xv > 20.f ? xv : log1pf(expf(xv));
        sc[lane] = wave_scan_incl(dtv * Aa, lane); sc[64 + lane] = dtv; }
    __syncthreads();
    {   const int lt = w >> 1;
        f32x4 aG[2] = {(f32x4){0.f, 0.f, 0.f, 0.f}, (f32x4){0.f, 0.f, 0.f, 0.f}};
#pragma unroll
        for (int ks = 0; ks < 4; ++ks) { const bf16x8 af = *(const bf16x8*)(Cs + (16 * lt + (lane & 15)) * 136 + ks * 32 + (lane >> 4) * 8);
#pragma unroll
            for (int i = 0; i < 2; ++i) { const int st = (w & 1) * 2 + i; const bf16x8 bfr = *(const bf16x8*)(Bs + (16 * st + (lane & 15)) * 136 + ks * 32 + (lane >> 4) * 8);
                aG[i] = __builtin_amdgcn_mfma_f32_16x16x32_bf16(af, bfr, aG[i], 0, 0, 0); } }
#pragma unroll
        for (int i = 0; i < 2; ++i) { const int s = 16 * ((w & 1) * 2 + i) + (lane & 15); const float css = sc[s], dts = sc[64 + s];
#pragma unroll
            for (int q = 0; q < 4; ++q) { const int t = 16 * lt + (lane >> 4) * 4 + q; const float val = (s <= t) ? aG[i][q] * expf(sc[t] - css) * dts : 0.f; Gs[t * 72 + s] = f2bf(val); } }
    }
    __syncthreads();
    {   const int lt = w >> 1;
        f32x4 aY[2] = {(f32x4){0.f, 0.f, 0.f, 0.f}, (f32x4){0.f, 0.f, 0.f, 0.f}};
#pragma unroll
        for (int ks = 0; ks < 4; ++ks) { const bf16x8 af = *(const bf16x8*)(Cs + (16 * lt + (lane & 15)) * 136 + ks * 32 + (lane >> 4) * 8);
#pragma unroll
            for (int i = 0; i < 2; ++i) { const int pt = (w & 1) * 2 + i; const bf16x8 bfr = *(const bf16x8*)(Sin + (16 * pt + (lane & 15)) * 136 + ks * 32 + (lane >> 4) * 8);
                aY[i] = __builtin_amdgcn_mfma_f32_16x16x32_bf16(bfr, af, aY[i], 0, 0, 0); } }
        const int t = 16 * lt + (lane & 15);
        {   const float ec = expf(sc[t]);
#pragma unroll
            for (int i = 0; i < 2; ++i) { aY[i][0] *= ec; aY[i][1] *= ec; aY[i][2] *= ec; aY[i][3] *= ec; } }
#pragma unroll
        for (int ks = 0; ks < 2; ++ks) { const bf16x8 af = *(const bf16x8*)(Gs + (16 * lt + (lane & 15)) * 72 + ks * 32 + (lane >> 4) * 8);
#pragma unroll
            for (int i = 0; i < 2; ++i) { const int pt = (w & 1) * 2 + i; const bf16x8 bfr = *(const bf16x8*)(XT + (16 * pt + (lane & 15)) * 72 + ks * 32 + (lane >> 4) * 8);
                aY[i] = __builtin_amdgcn_mfma_f32_16x16x32_bf16(bfr, af, aY[i], 0, 0, 0); } }
        {   const size_t tokt = (size_t)step_tok(b, dir, c * 64 + t);
#pragma unroll
            for (int i = 0; i < 2; ++i) { const int p0 = 16 * ((w & 1) * 2 + i) + (lane >> 4) * 4;
                u32x2 wv; wv.x = pk2(aY[i][0], aY[i][1]); wv.y = pk2(aY[i][2], aY[i][3]);
                *(u32x2*)(Yout + tokt * BW + h * 64 + p0) = wv; } }
    }
}


#define FIDX(i) ((i) + ((i) >> 4))
#define FFT_X_BYTES 69632
__device__ constexpr float FFT_CW_RE[6][16] = {{0.f, 0.f, 0.f, 0.f, 0.f, 0.f, 0.f, 0.f, 0.f, 0.f, 0.f, 0.f, 0.f, 0.f, 0.f, 0.f}, {1.0f, 0.f, 0.f, 0.f, 0.f, 0.f, 0.f, 0.f, 0.f, 0.f, 0.f, 0.f, 0.f, 0.f, 0.f, 0.f}, {1.0f, 6.123233995736766e-17f, 0.f, 0.f, 0.f, 0.f, 0.f, 0.f, 0.f, 0.f, 0.f, 0.f, 0.f, 0.f, 0.f, 0.f}, {1.0f, 0.7071067811865476f, 6.123233995736766e-17f, -0.7071067811865475f, 0.f, 0.f, 0.f, 0.f, 0.f, 0.f, 0.f, 0.f, 0.f, 0.f, 0.f, 0.f}, {1.0f, 0.9238795325112867f, 0.7071067811865476f, 0.38268343236508984f, 6.123233995736766e-17f, -0.3826834323650897f, -0.7071067811865475f, -0.9238795325112867f, 0.f, 0.f, 0.f, 0.f, 0.f, 0.f, 0.f, 0.f}, {1.0f, 0.9807852804032304f, 0.9238795325112867f, 0.8314696123025452f, 0.7071067811865476f, 0.5555702330196023f, 0.38268343236508984f, 0.19509032201612833f, 6.123233995736766e-17f, -0.1950903220161282f, -0.3826834323650897f, -0.555570233019602f, -0.7071067811865475f, -0.8314696123025453f, -0.9238795325112867f, -0.9807852804032304f}};
__device__ constexpr float FFT_CW_IM[6][16] = {{0.f, 0.f, 0.f, 0.f, 0.f, 0.f, 0.f, 0.f, 0.f, 0.f, 0.f, 0.f, 0.f, 0.f, 0.f, 0.f}, {-0.0f, 0.f, 0.f, 0.f, 0.f, 0.f, 0.f, 0.f, 0.f, 0.f, 0.f, 0.f, 0.f, 0.f, 0.f, 0.f}, {-0.0f, -1.0f, 0.f, 0.f, 0.f, 0.f, 0.f, 0.f, 0.f, 0.f, 0.f, 0.f, 0.f, 0.f, 0.f, 0.f}, {-0.0f, -0.7071067811865475f, -1.0f, -0.7071067811865476f, 0.f, 0.f, 0.f, 0.f, 0.f, 0.f, 0.f, 0.f, 0.f, 0.f, 0.f, 0.f}, {-0.0f, -0.3826834323650898f, -0.7071067811865475f, -0.9238795325112867f, -1.0f, -0.9238795325112867f, -0.7071067811865476f, -0.3826834323650899f, 0.f, 0.f, 0.f, 0.f, 0.f, 0.f, 0.f, 0.f}, {-0.0f, -0.19509032201612825f, -0.3826834323650898f, -0.5555702330196022f, -0.7071067811865475f, -0.8314696123025452f, -0.9238795325112867f, -0.9807852804032304f, -1.0f, -0.9807852804032304f, -0.9238795325112867f, -0.8314696123025455f, -0.7071067811865476f, -0.5555702330196022f, -0.3826834323650899f, -0.1950903220161286f}};
__host__ __device__ constexpr int fft_bitrev(int k, int R) { int r = 0; for (int i = 0; i < R; ++i) if (k & (1 << i)) r |= 1 << (R - 1 - i); return r; }
template <int R, bool INV>
__device__ __forceinline__ void fft_pass(float2* __restrict__ X, const float2* __restrict__ TW, const int s0, const int gidx) {
    const int lowbits = 13 - s0 - R; const int stride = 1 << lowbits;
    const int low = gidx & (stride - 1), high = gidx >> lowbits; const int base = (high << (lowbits + R)) | low;
    const int p0 = FIDX(base);
#define FFT_SLOT(k) (lowbits >= 4 ? p0 + (k) * (stride + (stride >> 4)) : p0 + (k) + ((k) >> 4))
    float2 v[1 << R];
#pragma unroll
    for (int k = 0; k < (1 << R); ++k) v[k] = X[FFT_SLOT(k)];
    const int lw = low << s0;
    if (!INV) {
#pragma unroll
        for (int j = 0; j < R; ++j) { const int hk = 1 << (R - 1 - j);
#pragma unroll
            for (int k = 0; k < (1 << R); ++k) if (!(k & hk)) { const int kk = k & (hk - 1);
                const float2 a = v[k], b = v[k + hk]; v[k] = make_float2(a.x + b.x, a.y + b.y); const float dx = a.x - b.x, dy = a.y - b.y;
                if (kk == 0) v[k + hk] = make_float2(dx, dy);
                else if (2 * kk == hk) v[k + hk] = make_float2(dy, -dx);
                else { const float cr = FFT_CW_RE[R - j][kk], ci = FFT_CW_IM[R - j][kk]; v[k + hk] = make_float2(dx * cr - dy * ci, dx * ci + dy * cr); } } }
        if (lowbits > 0) {
#pragma unroll
            for (int k = 1; k < (1 << R); ++k) { const float2 w = TW[(lw * fft_bitrev(k, R)) & 8191]; const float2 a = v[k]; v[k] = make_float2(a.x * w.x - a.y * w.y, a.x * w.y + a.y * w.x); } }
    } else {
        if (lowbits > 0) {
#pragma unroll
            for (int k = 1; k < (1 << R); ++k) { const float2 w = TW[(lw * fft_bitrev(k, R)) & 8191]; const float2 a = v[k]; v[k] = make_float2(a.x * w.x + a.y * w.y, a.y * w.x - a.x * w.y); } }
#pragma unroll
        for (int j = R - 1; j >= 0; --j) { const int hk = 1 << (R - 1 - j);
#pragma unroll
            for (int k = 0; k < (1 << R); ++k) if (!(k & hk)) { const int kk = k & (hk - 1);
                const float2 a = v[k], b = v[k + hk]; float tx, ty;
                if (kk == 0) { tx = b.x; ty = b.y; }
                else if (2 * kk == hk) { tx = -b.y; ty = b.x; }
                else { const float cr = FFT_CW_RE[R - j][kk], ci = FFT_CW_IM[R - j][kk]; tx = b.x * cr + b.y * ci; ty = b.y * cr - b.x * ci; }
                v[k] = make_float2(a.x + tx, a.y + ty); v[k + hk] = make_float2(a.x - tx, a.y - ty); } }
    }
#pragma unroll
    for (int k = 0; k < (1 << R); ++k) X[FFT_SLOT(k)] = v[k];
#undef FFT_SLOT
}
__device__ __forceinline__ void fft_fwd(float2* X, const float2* TW, const int tid) {
    fft_pass<4, false>(X, TW, 0, tid); __syncthreads(); fft_pass<4, false>(X, TW, 4, tid); __syncthreads(); if (tid < 256) fft_pass<5, false>(X, TW, 8, tid); __syncthreads(); }
__device__ __forceinline__ void fft_inv(float2* X, const float2* TW, const int tid) {
    if (tid < 256) fft_pass<5, true>(X, TW, 8, tid); __syncthreads(); fft_pass<4, true>(X, TW, 4, tid); __syncthreads(); fft_pass<4, true>(X, TW, 0, tid); __syncthreads(); }
__device__ __forceinline__ void fft_twiddles(float2* TW, const int tid) {
#pragma unroll
    for (int k = 0; k < 16; ++k) { const int m = tid + k * 512; const float xx = (float)m * (1.0f / 4096.0f); TW[m] = make_float2(cospif(xx), -sinpif(xx)); }
}
__device__ __forceinline__ void hyena_spec_item(const int pr, const float* __restrict__ HR, const float* __restrict__ nrm, float2* __restrict__ HSPEC, unsigned char* shm, const int tid) {
    float2* X = (float2*)shm; const float2* TW = (const float2*)(shm + FFT_X_BYTES);
    const int o = pr >> 8, c = (pr & 255) * 2, oc = o * 512 + c; const float inva = 1.0f / nrm[oc], invb = 1.0f / nrm[oc + 1];
    __syncthreads();
    float2 hv[16];
#pragma unroll
    for (int k = 0; k < 16; ++k) { const int j = tid + k * 512;
        const unsigned off = j < SEQ ? (unsigned)j * 2048u + o * 1024 + c : j == SEQ ? (unsigned)(o * 1024 + c) : (unsigned)(2 * SEQ - j) * 2048u + o * 1024 + 512 + c;
        hv[k] = *(const float2*)(HR + off); }
#pragma unroll
    for (int k = 0; k < 16; ++k) { const int j = tid + k * 512; X[FIDX(j)] = j == SEQ ? make_float2(0.f, 0.f) : make_float2(hv[k].x * inva, hv[k].y * invb); }
    __syncthreads();
    fft_fwd(X, TW, tid);
    float4* outa = (float4*)(HSPEC + (size_t)oc * 8192 + tid * 16); float4* outb = (float4*)(HSPEC + (size_t)(oc + 1) * 8192 + tid * 16); const float2* xs = X + 17 * tid;
    const float sc_ = 0.5f / 8192.0f;
#pragma unroll
    for (int k = 0; k < 8; ++k) { float2 ha[2], hb[2];
#pragma unroll
        for (int q = 0; q < 2; ++q) { const int p = 16 * tid + 2 * k + q; const int kf = (int)(__builtin_bitreverse32((unsigned)p) >> 19); const int p2 = (int)(__builtin_bitreverse32((unsigned)((8192 - kf) & 8191)) >> 19);
            const float2 xp = xs[2 * k + q], xq = X[FIDX(p2)];
            ha[q] = make_float2((xp.x + xq.x) * sc_, (xp.y - xq.y) * sc_);
            hb[q] = make_float2((xp.y + xq.y) * sc_, (xq.x - xp.x) * sc_); }
        outa[k] = make_float4(ha[0].x, ha[0].y, ha[1].x, ha[1].y); outb[k] = make_float4(hb[0].x, hb[0].y, hb[1].x, hb[1].y); }
}
__device__ __forceinline__ void fft_mul_spec(float2* X, const float2* __restrict__ H, const int tid) {
    const float4* h4 = (const float4*)(H + tid * 16); float2* xs = X + 17 * tid;
#pragma unroll
    for (int k = 0; k < 8; ++k) { const float4 hv = h4[k]; const float2 x0 = xs[2 * k], x1 = xs[2 * k + 1];
        xs[2 * k] = make_float2(x0.x * hv.x - x0.y * hv.y, x0.x * hv.y + x0.y * hv.x); xs[2 * k + 1] = make_float2(x1.x * hv.z - x1.y * hv.w, x1.x * hv.w + x1.y * hv.z); }
}
__device__ __forceinline__ void hyena_fft_item(const int item, const bf16_t* __restrict__ UT, const float2* __restrict__ HSPEC, const float* __restrict__ bias, bf16_t* __restrict__ YT, unsigned char* shm, const int tid) {
    float2* X = (float2*)shm; const float2* TW = (const float2*)(shm + FFT_X_BYTES);
    const int c = item >> 1, b0 = (item & 1) * 2, b1 = b0 + 1;
    const bf16_t* u0 = UT + (size_t)(b0 * 1536 + c) * SEQ + tid * 8; const bf16_t* u1 = UT + (size_t)(b1 * 1536 + c) * SEQ + tid * 8;
    const float bias0 = bias[c], bias1 = bias[512 + c];
    float2* xs = X + FIDX(8 * tid);
    float vr[8], vi[8];
    __syncthreads();
    { const u32x4 a0 = *(const u32x4*)u0, c0 = *(const u32x4*)u1; unpack8(a0, vr); unpack8(c0, vi); }
#pragma unroll
    for (int k = 0; k < 8; ++k) { xs[k] = make_float2(vr[k], vi[k]); xs[4352 + k] = make_float2(0.f, 0.f); }
    __syncthreads();
    fft_fwd(X, TW, tid);
    fft_mul_spec(X, HSPEC + (size_t)c * 8192, tid);
    __syncthreads();
    fft_inv(X, TW, tid);
    { const bf16_t* p0 = u0 + (size_t)512 * SEQ; const bf16_t* p1 = u1 + (size_t)512 * SEQ;
      float xr[8], xi[8]; { const u32x4 a0 = *(const u32x4*)p0, c0 = *(const u32x4*)p1; unpack8(a0, xr); unpack8(c0, xi); }
#pragma unroll
      for (int k = 0; k < 8; ++k) { const float2 cv = xs[k]; const float zr = xr[k] * (cv.x + bias0 * vr[k]), zi = xi[k] * (cv.y + bias0 * vi[k]);
          vr[k] = zr; vi[k] = zi; xs[k] = make_float2(zr, zi); xs[4352 + k] = make_float2(0.f, 0.f); } }
    __syncthreads();
    fft_fwd(X, TW, tid);
    fft_mul_spec(X, HSPEC + (size_t)(512 + c) * 8192, tid);
    __syncthreads();
    fft_inv(X, TW, tid);
    { const bf16_t* p0 = u0 + (size_t)1024 * SEQ; const bf16_t* p1 = u1 + (size_t)1024 * SEQ;
      float xr[8], xi[8]; { const u32x4 a0 = *(const u32x4*)p0, c0 = *(const u32x4*)p1; unpack8(a0, xr); unpack8(c0, xi); }
      float yr[8], yi[8];
#pragma unroll
      for (int k = 0; k < 8; ++k) { const float2 cv = xs[k]; yr[k] = xr[k] * (cv.x + bias1 * vr[k]); yi[k] = xi[k] * (cv.y + bias1 * vi[k]); }
      bf16_t* y0 = YT + (size_t)(b0 * 512 + c) * SEQ + tid * 8; bf16_t* y1 = YT + (size_t)(b1 * 512 + c) * SEQ + tid * 8;
      { u32x4 w; w.x = pk2(yr[0], yr[1]); w.y = pk2(yr[2], yr[3]); w.z = pk2(yr[4], yr[5]); w.w = pk2(yr[6], yr[7]); *(u32x4*)y0 = w; }
      { u32x4 w; w.x = pk2(yi[0], yi[1]); w.y = pk2(yi[2], yi[3]); w.z = pk2(yi[4], yi[5]); w.w = pk2(yi[6], yi[7]); *(u32x4*)y1 = w; } }
}

constexpr size_t al256(size_t x) { return (x + 255) & ~(size_t)255; }
constexpr size_t O_BAR = 0;
constexpr size_t O_MOD = 16384;
constexpr size_t O_NORM = O_MOD + al256((size_t)2 * 5 * 6 * DM * 4);
constexpr size_t O_QCTR = O_NORM + al256((size_t)2 * 2 * 1024 * 4);
constexpr size_t O_ZERO_END = O_QCTR + 512;
constexpr size_t O_XS = O_ZERO_END;
constexpr size_t O_HB = O_XS + al256((size_t)NTOK * DM * 4);
constexpr size_t O_P = O_HB + al256((size_t)NTOK * DM * 2);
constexpr size_t O_WIN = O_P + al256((size_t)NTOK * LDP * 2);
constexpr size_t O_WBR = O_WIN + al256((size_t)LDP * DM * 2);
constexpr size_t O_WOUT = O_WBR + al256((size_t)4 * DM * BW * 2);
constexpr size_t O_WGU = O_WOUT + al256((size_t)DM * DM * 2);
constexpr size_t O_WD = O_WGU + al256((size_t)NEXP * 2 * DEXP * DM * 2);
constexpr size_t O_GLU = O_WD + al256((size_t)NEXP * DM * DEXP * 2);
constexpr size_t O_Y4 = O_GLU + al256((size_t)BW * BW * 2);
constexpr size_t O_U = O_Y4 + al256((size_t)NTOK * DM * 2);
constexpr size_t O_QKB = O_U + al256((size_t)NTOK * 1536 * 4);
constexpr size_t O_CST = O_QKB + al256((size_t)NTOK * 1024 * 2);
constexpr size_t O_NST = O_CST + al256((size_t)32 * 68 * 128 * 128 * 2);
constexpr size_t O_MST = O_NST + al256((size_t)32 * 68 * 128 * 4);
constexpr size_t O_XBC = O_MST + al256((size_t)32 * 68 * 4);
constexpr size_t O_SST = O_XBC + al256((size_t)NTOK * 1024 * 2);
constexpr size_t O_HF = O_SST + al256((size_t)64 * 68 * 64 * 128 * 2);
constexpr size_t O_YF = O_HF + al256((size_t)2 * NTOK * BW * 4);
constexpr size_t O_SF = O_YF + al256((size_t)2 * NTOK * BW * 4);
constexpr size_t O_LDT = O_SF + al256((size_t)2 * NCTX * BW * 4);
constexpr size_t O_AP = O_LDT + al256((size_t)4096 * 16);
constexpr size_t O_BBT = O_AP + al256((size_t)4096 * 33 * 8);
constexpr size_t O_KT = O_BBT + al256((size_t)4096 * 16 * 8);
constexpr size_t O_S5A = O_KT + al256((size_t)32 * 2 * 32 * 256 * 4);
constexpr size_t O_S5B = O_S5A + al256((size_t)32 * 512 * 768 * 2);
constexpr size_t O_XCTX = O_S5B + al256((size_t)32 * 512 * 768 * 2);
constexpr size_t O_Z = O_XCTX + al256((size_t)4 * 32 * 2 * 64 * 8);
constexpr size_t O_HRAW = O_Z + al256((size_t)NTOK * BW * 4);
constexpr size_t O_HSPEC = O_HRAW + al256((size_t)(SEQ + CTXL) * 2048 * 4);
constexpr size_t O_K2C = O_HSPEC + al256((size_t)1024 * 8192 * 8);
constexpr size_t O_GG = O_K2C + al256((size_t)(2 * CTXL) * 1024 * 4);
constexpr size_t O_PROBS = O_GG + al256((size_t)NTOK * BW * 2);
constexpr size_t O_ROWTOK = O_PROBS + al256((size_t)NTOK * 16 * 4);
constexpr size_t O_ROWGATE = O_ROWTOK + al256((size_t)NEXP * MOE_PAD * 4);
constexpr size_t O_INV = O_ROWGATE + al256((size_t)NEXP * MOE_PAD * 4);
constexpr size_t O_NORMP = O_INV + al256((size_t)NTOK * 16 * 4);
constexpr size_t WS_END = O_NORMP + al256((size_t)4 * 256 * 2048 * 4);
constexpr size_t O_XG = O_P;
constexpr size_t O_HID = O_P + al256((size_t)NEXP * MOE_PAD * DM * 2);
constexpr size_t O_YEXP = O_HID + al256((size_t)NEXP * MOE_PAD * DEXP * 2);
static_assert(O_YEXP + (size_t)NEXP * MOE_PAD * DM * 2 <= O_WIN, "MoE temporaries must fit inside P");
static_assert((size_t)NTOK * DM * 2 <= (size_t)NTOK * 1536 * 4, "ACCb must fit inside U");
static_assert((size_t)26214400 + (size_t)2 * 17825792 + (size_t)272 * 256 * 64 * 2 <= (size_t)NTOK * DM * 2, "strip buffers must fit inside HB");
static_assert(WS_END <= (size_t)1851000000, "workspace map exceeds the guaranteed size");

struct Args {
    const float* in[47];
    float* out; unsigned char* ws;
    int ph_lo, ph_hi;
};

__device__ __forceinline__ void conv_tile(const float* __restrict__ src, int ldsrc, int nvalid, int k0, int n0, bf16_t* __restrict__ dst, int lddst, int mode, float* T, int tid) {
    { const int n = tid & 63, kr = tid >> 6;
#pragma unroll
      for (int i = 0; i < 8; ++i) { const int k = i * 8 + kr; T[k * 65 + n] = (n0 + n < nvalid) ? src[(size_t)(k0 + k) * ldsrc + n0 + n] : 0.f; } }
    __syncthreads();
    { const int n = tid >> 3, kc = (tid & 7) * 8; const int gn = n0 + n;
      const int drow = mode == 0 ? gn : (32 * (gn >> 4) + (mode == 2 ? 16 : 0) + (gn & 15));
      u32x4 w; w.x = pk2(T[(kc + 0) * 65 + n], T[(kc + 1) * 65 + n]); w.y = pk2(T[(kc + 2) * 65 + n], T[(kc + 3) * 65 + n]);
      w.z = pk2(T[(kc + 4) * 65 + n], T[(kc + 5) * 65 + n]); w.w = pk2(T[(kc + 6) * 65 + n], T[(kc + 7) * 65 + n]);
      *(u32x4*)(dst + (size_t)drow * lddst + k0 + kc) = w; }
    __syncthreads();
}

#define IN(id) (lo <= (id) && (id) < hi)
#define SEAM(id) do { if (hi > (id) + 1) xcd_barrier(bar); } while (0)
#define PH_BEGIN int tid = threadIdx.x; asm volatile("" : "+v"(tid) :: "memory"); const int lane = tid & 63, wave = tid >> 6; (void)lane; (void)wave;

#define x_in (PT(0))
#define c_in (PT(1))
#define ctx_in (PT(2))
#define cctx_in (PT(3))
#define ada_w (PT(4))
#define ada_b (PT(5))
#define norm_mix (PT(6))
#define norm_ffn (PT(7))
#define w_in (PT(8))
#define XS ((float*)(a.ws + O_XS))
#define MOD ((float*)(a.ws + O_MOD))
#define NORM ((float*)(a.ws + O_NORM))
#define NORMP ((float*)(a.ws + O_NORMP))
#define MODl (MOD + (size_t)l * 5 * 6 * DM)
#define HB ((bf16_t*)(a.ws + O_HB))
#define P ((bf16_t*)(a.ws + O_P))
#define WIN ((bf16_t*)(a.ws + O_WIN))
#define WBR ((bf16_t*)(a.ws + O_WBR))
#define WOUT ((bf16_t*)(a.ws + O_WOUT))
#define WGU ((bf16_t*)(a.ws + O_WGU))
#define WD ((bf16_t*)(a.ws + O_WD))
#define GLU ((bf16_t*)(a.ws + O_GLU))
#define Y4 ((bf16_t*)(a.ws + O_Y4))
#define U ((float*)(a.ws + O_U))
#define ACCb ((bf16_t*)(a.ws + O_U))
#define QKB ((bf16_t*)(a.ws + O_QKB))
#define CST ((bf16_t*)(a.ws + O_CST))
#define NST ((float*)(a.ws + O_NST))
#define MST ((float*)(a.ws + O_MST))
#define XBC ((bf16_t*)(a.ws + O_XBC))
#define SSTB ((bf16_t*)(a.ws + O_SST))
#define HF ((bf16_t*)(a.ws + O_HF))
#define HBk (HF + (size_t)NTOK * BW)
#define YF ((bf16_t*)(a.ws + O_YF))
#define YB (YF + (size_t)NTOK * BW)
#define SF ((float*)(a.ws + O_SF))
#define SB (SF + (size_t)NCTX * BW)
#define LDT ((double2*)(a.ws + O_LDT))
#define APW ((float2*)(a.ws + O_AP))
#define BBT ((float2*)(a.ws + O_BBT))
#define KTB ((float*)(a.ws + O_KT))
#define S5A ((bf16_t*)(a.ws + O_S5A))
#define S5B ((bf16_t*)(a.ws + O_S5B))
#define XCTX ((float2*)(a.ws + O_XCTX))
#define S5P ((bf16_t*)(a.ws + O_HB))
#define XLOC ((float*)(a.ws + O_HB + (size_t)32 * 256 * 512 * 2))
#define KTG ((bf16_t*)(a.ws + O_HB + (size_t)26214400))
#define VTG ((bf16_t*)(a.ws + O_HB + (size_t)26214400 + (size_t)17825792))
#define BTG ((bf16_t*)(a.ws + O_HB + (size_t)26214400 + (size_t)2 * 17825792))
#define XTG ((bf16_t*)(a.ws + O_GG))
#define Z ((float*)(a.ws + O_Z))
#define HRAW ((float*)(a.ws + O_HRAW))
#define HSPEC ((float2*)(a.ws + O_HSPEC))
#define UT ((bf16_t*)(a.ws + O_U))
#define YT ((bf16_t*)(a.ws + O_Z))
#define QCTR ((int*)(a.ws + O_QCTR))
#define K2C ((float*)(a.ws + O_K2C))
#define GG ((bf16_t*)(a.ws + O_GG))
#define PROBS ((float*)(a.ws + O_PROBS))
#define ROWTOK ((int*)(a.ws + O_ROWTOK))
#define ROWGATE ((float*)(a.ws + O_ROWGATE))
#define XG ((bf16_t*)(a.ws + O_XG))
#define HID ((bf16_t*)(a.ws + O_HID))
#define YEXP ((bf16_t*)(a.ws + O_YEXP))
#define INV ((int*)(a.ws + O_INV))


__device__ __forceinline__ void moe_pair(float4 (&a)[8], const int r1, const int r2, const float g2scale, const int lane, const float* __restrict__ rowgate, const bf16_t* __restrict__ yexp) {
    const float gt1 = rowgate[r1], gt2 = rowgate[r2] * g2scale;
    const bf16_t* y1 = yexp + (size_t)r1 * DM + lane * 4; const bf16_t* y2 = yexp + (size_t)r2 * DM + lane * 4;
    u32x2 w1[8], w2[8];
#pragma unroll
    for (int i = 0; i < 8; ++i) { w1[i] = *(const u32x2*)(y1 + i * 256); w2[i] = *(const u32x2*)(y2 + i * 256); }
#pragma unroll
    for (int i = 0; i < 8; ++i) {
        a[i].x += gt1 * __uint_as_float(w1[i].x << 16); a[i].y += gt1 * __uint_as_float(w1[i].x & 0xFFFF0000u); a[i].z += gt1 * __uint_as_float(w1[i].y << 16); a[i].w += gt1 * __uint_as_float(w1[i].y & 0xFFFF0000u);
        a[i].x += gt2 * __uint_as_float(w2[i].x << 16); a[i].y += gt2 * __uint_as_float(w2[i].x & 0xFFFF0000u); a[i].z += gt2 * __uint_as_float(w2[i].y << 16); a[i].w += gt2 * __uint_as_float(w2[i].y & 0xFFFF0000u); }
}
__device__ __forceinline__ void moe_combine(float4 (&v)[8], const int tok, const int lane, const int* __restrict__ inv, const float* __restrict__ rowgate, const bf16_t* __restrict__ yexp, const float* __restrict__ m5) {
    float4 a[8], mm[8];
#pragma unroll
    for (int i = 0; i < 8; ++i) { a[i] = make_float4(0.f, 0.f, 0.f, 0.f); mm[i] = *(const float4*)(m5 + i * 256 + lane * 4); }
    const int4* ip = (const int4*)(inv + (size_t)tok * 16);
    const int4 q0 = ip[0], q1 = ip[1], q2 = ip[2], q3 = ip[3];
    const int rows[16] = {q0.x, q0.y, q0.z, q0.w, q1.x, q1.y, q1.z, q1.w, q2.x, q2.y, q2.z, q2.w, q3.x, q3.y, q3.z, q3.w};
    int prow = -1;
#pragma unroll
    for (int e = 0; e < 16; ++e) { const int row = __builtin_amdgcn_readfirstlane(rows[e]);
        if (row >= 0) { if (prow >= 0) { moe_pair(a, prow, row, 1.0f, lane, rowgate, yexp); prow = -1; } else prow = row; } }
    if (prow >= 0) moe_pair(a, prow, prow, 0.0f, lane, rowgate, yexp);
#pragma unroll
    for (int i = 0; i < 8; ++i) { v[i].x += mm[i].x * a[i].x; v[i].y += mm[i].y * a[i].y; v[i].z += mm[i].z * a[i].z; v[i].w += mm[i].w * a[i].w; }
}
struct CvU { const float* src; bf16_t* dst; int ldsrc, nvalid, k0, n0, lddst, mode; };
__device__ __forceinline__ void cv_load(const CvU& u, float4 (&r)[8], const int tid) {
#pragma unroll
    for (int i = 0; i < 8; ++i) { const int idx = tid + i * 512; const int k = idx >> 6, n = u.n0 + (idx & 63) * 4;
        r[i] = (n < u.nvalid) ? *(const float4*)(u.src + (size_t)(u.k0 + k) * u.ldsrc + n) : make_float4(0.f, 0.f, 0.f, 0.f); }
}
__device__ __forceinline__ void cv_stage(float* T, const float4 (&r)[8], const int tid) {
#pragma unroll
    for (int i = 0; i < 8; ++i) { const int idx = tid + i * 512; float* p = T + (idx >> 6) * 257 + (idx & 63) * 4; p[0] = r[i].x; p[1] = r[i].y; p[2] = r[i].z; p[3] = r[i].w; }
}
__device__ __forceinline__ void cv_store(const CvU& u, const float* T, const int tid) {
#pragma unroll
    for (int j = 0; j < 4; ++j) { const int o = tid + j * 512; const int kc = (o & 7) * 8, n = o >> 3; const int gn = u.n0 + n;
        int drow = u.mode == 0 ? gn : (256 * (gn >> 7) + (u.mode == 2 ? 128 : 0) + (gn & 127));
        if (u.mode == 3) {
            if (gn >= IN_W) continue;
            drow = gn;
            if (gn >= GATE_OFF) { const int g = gn - GATE_OFF, kb = g >> 11, col = g & 2047, j2 = col >> 6, rem = col & 63;
                drow = GATE2 + 256 * j2 + 128 * (kb >> 1) + 32 * (rem >> 4) + 8 * ((rem >> 2) & 3) + 4 * (kb & 1) + (rem & 3); } }
        const float* t = T + kc * 257 + n;
        u32x4 w; w.x = pk2(t[0], t[257]); w.y = pk2(t[2 * 257], t[3 * 257]); w.z = pk2(t[4 * 257], t[5 * 257]); w.w = pk2(t[6 * 257], t[7 * 257]);
        *(u32x4*)(u.dst + (size_t)drow * u.lddst + u.k0 + kc) = w; }
}
#define CV_RUN(LL, QSTART, QSTEP, QEND) do { \
                const float* wbr = PT(40) + (size_t)(LL) * 4 * BW * DM; const float* wout = PT(41) + (size_t)(LL) * DM * DM; \
                const float* wg = PT(43) + (size_t)(LL) * NEXP * DM * DEXP; const float* wu = PT(44) + (size_t)(LL) * NEXP * DM * DEXP; const float* wd = PT(45) + (size_t)(LL) * NEXP * DEXP * DM; \
                const float* wglu = PT(32) + (size_t)(LL) * BW * BW; const float* win = w_in + (size_t)(LL) * DM * IN_W; \
                const int cv_step = (QSTEP), cv_end = (QEND); \
                __syncthreads(); \
                int q = (QSTART); int buf = 0; CvU u; float4 r[8]; \
                if (q < cv_end) { CV_DECODE(q, u); cv_load(u, r, tid); } \
                while (q < cv_end) { \
                    float* T = sf + buf * (64 * 257); \
                    cv_stage(T, r, tid); \
                    __syncthreads(); \
                    const CvU cur = u; const int qn = q + cv_step; \
                    if (qn < cv_end) { CV_DECODE(qn, u); cv_load(u, r, tid); } \
                    cv_store(cur, T, tid); \
                    buf ^= 1; q = qn; \
                } \
                __syncthreads(); } while (0)
#define CV_DECODE(q_, u_) do { int qq_ = (q_); \
                    if (qq_ < n_win) { u_ = CvU{win, WIN, IN_W, IN_W, (qq_ / 55) * 64, (qq_ % 55) * 256, DM, 3}; } else { qq_ -= n_win; \
                    if (qq_ < n_br) { const int k = qq_ >> 6, r = qq_ & 63; u_ = CvU{wbr + (size_t)k * BW * DM, WBR + (size_t)k * DM * BW, DM, DM, (r >> 3) * 64, (r & 7) * 256, BW, 0}; } else { qq_ -= n_br; \
                    if (qq_ < n_out) { u_ = CvU{wout, WOUT, DM, DM, (qq_ >> 3) * 64, (qq_ & 7) * 256, DM, 0}; } else { qq_ -= n_out; \
                    if (qq_ < n_glu) { u_ = CvU{wglu, GLU, BW, BW, (qq_ >> 1) * 64, (qq_ & 1) * 256, BW, 0}; } else { qq_ -= n_glu; \
                    if (qq_ < n_gu) { const int e = qq_ / 384, r = qq_ % 384, up = r / 192, r2 = r % 192; u_ = CvU{(up ? wu : wg) + (size_t)e * DM * DEXP, WGU + (size_t)e * 2 * DEXP * DM, DEXP, DEXP, (r2 / 6) * 64, (r2 % 6) * 256, DM, 1 + up}; } else { qq_ -= n_gu; \
                    { const int e = qq_ / 192, r = qq_ % 192; u_ = CvU{wd + (size_t)e * DEXP * DM, WD + (size_t)e * DM * DEXP, DM, DM, (r >> 3) * 64, (r & 7) * 256, DEXP, 0}; } } } } } } } while (0)
template <int LAYER>
__device__ __forceinline__ void layer_body(const Args& a, const XcdBarrier& bar, const int lo, const int hi, const int bid, const int G, unsigned char* const shm, float* const sf, const float** const ptab) {
        constexpr int l = LAYER;
        constexpr int PB = 1 + 16 * l;
        const bool lastl = (l == 1);

        const int nPanels = lastl ? 64 : 68;
        const int M2 = nPanels * 256;

        if (IN(PB + 0)) for (int rep_ = 0; rep_ < (l == 0 ? PROBE_REPS(0) : 1); ++rep_) {
            PH_BEGIN
            {   const int n_win = 32 * 55, n_br = 4 * 64, n_out = 32 * 8, n_glu = 16, n_gu = 16 * 2 * 192, n_d = 16 * 192;
                const int n_grp1 = n_win + n_br + n_out + n_glu, total = n_grp1 + n_gu + n_d;
                const int q_lo = (l > 0 && G > 128) ? n_win : 0;
                const int q_hi = (lastl && G > 64) ? n_grp1 + n_gu - 1536 : total;
                CV_RUN(l, q_lo + bid, G, q_hi);
                for (int i = bid * NTHR + tid; i < (GATE2 - GATE_OFF) * DM / 8; i += G * NTHR) ((u32x4*)(WIN + (size_t)GATE_OFF * DM))[i] = (u32x4){0u, 0u, 0u, 0u};
            }
            for (int set = 0; set < (lastl ? 1 : 2); ++set) {
                const int L = set ? CTXL : SEQ; float* HR = HRAW + (set ? (size_t)SEQ * 2048 : 0);
                const float* w1 = PT(11) + l * 33 * 64; const float* b1 = PT(12) + l * 64; const float* fr1 = PT(13) + l * 64; const float* w2 = PT(14) + l * 64 * 64; const float* b2 = PT(15) + l * 64;
                const float* fr2 = PT(16) + l * 64; const float* w3 = PT(17) + l * 64 * 2048; const float* decay = PT(18) + l * 2048;
                float* feats = sf; float* h1 = sf + 16 * 33; float* h2 = h1 + 16 * 64;
                float nacc[4] = {0.f, 0.f, 0.f, 0.f};
                for (int base = bid; base < L; base += 16 * G) {
                    __syncthreads();
                    for (int e = tid; e < 16 * 33; e += NTHR) { const int ti = e / 33, fi = e % 33; int t = base + ti * G; if (t > L - 1) t = L - 1;
                        float v;
                        if (fi == 0) v = (float)t / (float)(L - 1);
                        else { const int j = (fi - 1) & 15; const double fr = 1e-4 + (double)j * ((15.0 - 1e-4) / 15.0); const double ang = (2.0 * 3.14159265358979323846 / (double)L) * (double)t * fr; v = fi <= 16 ? (float)cos(ang) : (float)(-sin(ang)); }
                        feats[e] = v; }
                    __syncthreads();
                    { const int j = tid & 63, ti = tid >> 6; float s0 = b1[j], s1 = s0;
_Pragma("unroll 3")
                      for (int i = 0; i < 33; ++i) { const float wv = w1[i * 64 + j]; s0 += feats[ti * 33 + i] * wv; s1 += feats[(ti + 8) * 33 + i] * wv; }
                      const float f1 = fr1[j]; h1[ti * 64 + j] = sinf(f1 * s0); h1[(ti + 8) * 64 + j] = sinf(f1 * s1); }
                    __syncthreads();
                    { const int j = tid & 63, ti = tid >> 6; float s0 = b2[j], s1 = s0;
_Pragma("unroll 4")
                      for (int i = 0; i < 64; ++i) { const float wv = w2[i * 64 + j]; s0 += h1[ti * 64 + i] * wv; s1 += h1[(ti + 8) * 64 + i] * wv; }
                      const float f2 = fr2[j]; h2[ti * 64 + j] = sinf(f2 * s0); h2[(ti + 8) * 64 + j] = sinf(f2 * s1); }
                    __syncthreads();
                    float acc[16][4];
#pragma unroll
                    for (int ti = 0; ti < 16; ++ti) { acc[ti][0] = 0.f; acc[ti][1] = 0.f; acc[ti][2] = 0.f; acc[ti][3] = 0.f; }
#pragma unroll 2
                    for (int i = 0; i < 64; ++i) { const float* wrow = w3 + (size_t)i * 2048 + tid; const float wa = wrow[0], wb = wrow[512], wc2 = wrow[1024], wd2 = wrow[1536];
#pragma unroll
                        for (int ti = 0; ti < 16; ++ti) { const float hv = h2[ti * 64 + i]; acc[ti][0] += hv * wa; acc[ti][1] += hv * wb; acc[ti][2] += hv * wc2; acc[ti][3] += hv * wd2; } }
                    float dk[4];
#pragma unroll
                    for (int k = 0; k < 4; ++k) dk[k] = fabsf(decay[tid + k * 512]);
#pragma unroll
                    for (int ti = 0; ti < 16; ++ti) { const int t = base + ti * G; if (t < L) { const float tn = (float)t / (float)(L - 1);
#pragma unroll
                        for (int k = 0; k < 4; ++k) { const float v = acc[ti][k] * expf(-tn * dk[k]); HR[(size_t)t * 2048 + tid + k * 512] = v; nacc[k] += fabsf(v); } } }
                }
                float* nrp = NORMP + ((size_t)(l * 2 + set) * 256 + bid) * 2048;
#pragma unroll
                for (int k = 0; k < 4; ++k) nrp[tid + k * 512] = nacc[k];
            }
            for (int idx = bid * NTHR + tid; idx < 4096; idx += G * NTHR) { const int n = idx & 63, g = (idx >> 6) & 31, dir = idx >> 11;
                const double are = (double)(PT(24) + l * 4096)[idx], aim = (double)(PT(25) + l * 4096)[idx]; const double lam = are < -1e-4 ? are : -1e-4; const double dt = exp((double)(PT(26) + l * 64)[dir * 32 + g]);
                const double ldre = lam * dt, ldim = aim * dt; LDT[idx] = make_double2(ldre, ldim);
                const double mag = exp(ldre); const double ar = mag * cos(ldim), ai = mag * sin(ldim);
                const double den = lam * lam + aim * aim; const double nr = ar - 1.0, ni = ai; const double fre = (nr * lam + ni * aim) / den, fim = (ni * lam - nr * aim) / den;
                const float* b_re = PT(27) + l * 32 * 64 * 16; const float* b_im = PT(28) + l * 32 * 64 * 16;
#pragma unroll 4
                for (int c = 0; c < 16; ++c) { const double br = (double)b_re[(g * 64 + n) * 16 + c], bi = (double)b_im[(g * 64 + n) * 16 + c]; BBT[idx * 16 + c] = make_float2((float)(fre * br - fim * bi), (float)(fre * bi + fim * br)); }
            }
            for (int e2 = bid * NTHR + tid; e2 < 4096 * 33; e2 += G * NTHR) { const int idx = e2 / 33, k = e2 - idx * 33; const int g = (idx >> 6) & 31, dir = idx >> 11;
                const double are = (double)(PT(24) + l * 4096)[idx], aim = (double)(PT(25) + l * 4096)[idx]; const double lam = are < -1e-4 ? are : -1e-4; const double dt = exp((double)(PT(26) + l * 64)[dir * 32 + g]);
                const double ldre = lam * dt, ldim = aim * dt; const double mk = exp(ldre * k); APW[e2] = make_float2((float)(mk * cos(ldim * k)), (float)(mk * sin(ldim * k))); }
            if (l == 0 && lo == 0) xcd_barrier(bar);
            for (int tok = bid * 8 + wave; tok < NTOK; tok += G * 8) {
                const int r = tok < NLAT ? tok / SEQ : 4; const float* xr = l == 0 ? (tok < NLAT ? x_in + (size_t)tok * DM : ctx_in + (size_t)(tok - NLAT) * DM) : XS + (size_t)tok * DM; const float* gn = norm_mix + l * DM;
                const float* sh = MODl + (size_t)(r * 6 + 0) * DM; const float* sc = MODl + (size_t)(r * 6 + 1) * DM;
                float4 v[8]; float ss = 0.f;
#pragma unroll
                for (int i = 0; i < 8; ++i) v[i] = *(const float4*)(xr + i * 256 + lane * 4);
                if (l > 0) {
                    moe_combine(v, tok, lane, INV, ROWGATE, YEXP, MOD + (size_t)((l - 1) * 5 + r) * 6 * DM + 5 * DM);
#pragma unroll
                    for (int i = 0; i < 8; ++i) *(float4*)(XS + (size_t)tok * DM + i * 256 + lane * 4) = v[i]; }
#pragma unroll
                for (int i = 0; i < 8; ++i) ss += v[i].x * v[i].x + v[i].y * v[i].y + v[i].z * v[i].z + v[i].w * v[i].w;
                ss = wave_sum(ss); const float rs = rsqrtf(ss * (1.0f / DM) + 1e-6f);
#pragma unroll
                for (int i = 0; i < 8; ++i) { const int d = i * 256 + lane * 4; const float4 g4 = *(const float4*)(gn + d), s4 = *(const float4*)(sc + d), h4 = *(const float4*)(sh + d);
                    v[i].x = v[i].x * rs * g4.x * (1.f + s4.x) + h4.x; v[i].y = v[i].y * rs * g4.y * (1.f + s4.y) + h4.y; v[i].z = v[i].z * rs * g4.z * (1.f + s4.z) + h4.z; v[i].w = v[i].w * rs * g4.w * (1.f + s4.w) + h4.w; }
#pragma unroll
                for (int i = 0; i < 8; ++i) { u32x2 w; w.x = pk2(v[i].x, v[i].y); w.y = pk2(v[i].z, v[i].w); *(u32x2*)(HB + (size_t)tok * DM + i * 256 + lane * 4) = w; }
            }
            SEAM(PB + 0);
        }

        if (IN(PB + 1)) for (int rep_ = 0; rep_ < PROBE_REPS(1); ++rep_) {
            PH_BEGIN
            for (int base = bid * 8; base < (lastl ? 1 : 2) * 1024; base += G * 8) {
                const int idx = base + (tid & 7), sl = tid >> 3; const int set = idx >> 10, oc = idx & 1023, o = oc >> 9, c = oc & 511;
                const float* pp = NORMP + (size_t)(l * 2 + set) * 256 * 2048 + o * 1024 + c + (size_t)(sl * 4) * 2048; float sacc = 0.f;
#pragma unroll
                for (int j = 0; j < 4; ++j) { const float p0 = pp[(size_t)j * 2048], p1 = pp[(size_t)j * 2048 + 512]; sacc += (sl * 4 + j < G) ? p0 + p1 : 0.f; }
                sf[sl * 8 + (tid & 7)] = sacc; __syncthreads();
                if (tid < 8) { float t = 0.f;
#pragma unroll 8
                    for (int q = 0; q < 64; ++q) t += sf[q * 8 + tid];
                    NORM[(size_t)(l * 2 + set) * 1024 + oc] = t; }
                __syncthreads(); }
            for (int idx = (G - 1 - bid) * NTHR + tid; idx < 32768; idx += G * NTHR) { const int c = idx & 15, lag = (idx >> 4) & 31, dir = (idx >> 9) & 1, g = idx >> 10;
                const float* c_re = PT(29) + l * 32 * 16 * 64 + (g * 16 + c) * 64; const float* c_im = PT(30) + l * 32 * 16 * 64 + (g * 16 + c) * 64;
                float acc[16];
#pragma unroll
                for (int j = 0; j < 16; ++j) acc[j] = 0.f;
#pragma unroll 2
                for (int n = 0; n < 64; ++n) { const int pi = (dir * 32 + g) * 64 + n; const float2 ap = APW[pi * 33 + lag]; const float cr = c_re[n], ci = c_im[n]; const float wr_ = cr * ap.x - ci * ap.y, wi_ = cr * ap.y + ci * ap.x;
                    const float4* bb = (const float4*)(BBT + pi * 16);
#pragma unroll
                    for (int j = 0; j < 8; ++j) { const float4 b2 = bb[j]; acc[2 * j] += wr_ * b2.x - wi_ * b2.y; acc[2 * j + 1] += wr_ * b2.z - wi_ * b2.w; } }
                float4* o = (float4*)(KTB + (size_t)idx * 16);
                o[0] = make_float4(acc[0], acc[1], acc[2], acc[3]); o[1] = make_float4(acc[4], acc[5], acc[6], acc[7]); o[2] = make_float4(acc[8], acc[9], acc[10], acc[11]); o[3] = make_float4(acc[12], acc[13], acc[14], acc[15]);
            }
            __syncthreads();
            pg8::Gemm g{HB, WIN, DM, DM, DM}; pg8::SchedStd S{68, 55, G, bid, DM, DM}; pg8::EpiWin E{P, LDP};
            pg8::gemm_phase(( LAS unsigned char*)shm, g, S, E);
#if defined(PROBE_BNOEPI)
            { __syncthreads(); pg8::EpiNone E0; pg8::gemm_phase((LAS unsigned char*)shm, g, S, E0); }
#endif
            SEAM(PB + 1);
        }

        if (IN(PB + 2)) for (int rep_ = 0; rep_ < PROBE_REPS(2); ++rep_) {
            PH_BEGIN
            const float* hcw = PT(9) + l * 3 * 1536; const float* hcb = PT(10) + l * 1536; const float* mcw = PT(20) + l * 3 * 1024; const float* mcb = PT(21) + l * 1024;
            const float* scw = PT(34) + l * 3 * 1024; const float* scb = PT(35) + l * 1024;
            for (int unit = bid; unit < 272 * 3; unit += G) { const int seg = unit / 3, kind = unit % 3; const bool lat = seg < 256; const size_t tok0 = lat ? (size_t)seg * 64 : (size_t)NLAT + (size_t)(seg - 256) * 64;
                if (kind < 2) { const int hf = kind;
                    const int c = tid * 2; const int col = (hf ? SSD_OFF + 512 : ML_OFF) + c; const float* w = hf ? scw : mcw; const float* bsp = hf ? scb : mcb; bf16_t* dst = (hf ? XBC : QKB) + tok0 * 1024 + c;
                    const float2 w0 = *(const float2*)(w + c), w1 = *(const float2*)(w + 1024 + c), w2 = *(const float2*)(w + 2048 + c), bb = *(const float2*)(bsp + c);
                    const float osc = (!hf && c >= 512) ? 0.08838834764831845f : 1.0f;
                    const bool hasPrev = !lat && ((tok0 - NLAT) & (CTXL - 1)) != 0, hasNext = !lat && (((tok0 - NLAT) + 63) & (CTXL - 1)) != CTXL - 1;
                    bf16_t* strip = nullptr;
                    if (!hf) { if (c >= 512) strip = KTG + ((size_t)seg * 512 + (c - 512)) * 64; }
                    else { if (c < 512) strip = XTG + ((size_t)seg * 512 + c) * 64; else if (c < 768) strip = BTG + ((size_t)seg * 256 + (c - 512)) * 64; }
                    const bf16_t* pp = P + tok0 * LDP + col;
                    unsigned raw[66];
#pragma unroll
                    for (int t = 0; t < 66; ++t) raw[t] = ((t == 0 && !hasPrev) || (t == 65 && !hasNext)) ? 0u : *(const unsigned*)(pp + (ptrdiff_t)(t - 1) * LDP);
#pragma unroll
                    for (int t8 = 0; t8 < 8; ++t8) { float v0[8], v1[8];
#pragma unroll
                        for (int tt = 0; tt < 8; ++tt) { const int t = t8 * 8 + tt; const unsigned p0 = raw[t], p1 = raw[t + 1], p2 = raw[t + 2];
                            float a0 = bb.x + w0.x * __uint_as_float(p0 << 16) + w1.x * __uint_as_float(p1 << 16) + w2.x * __uint_as_float(p2 << 16);
                            float a1 = bb.y + w0.y * __uint_as_float(p0 & 0xFFFF0000u) + w1.y * __uint_as_float(p1 & 0xFFFF0000u) + w2.y * __uint_as_float(p2 & 0xFFFF0000u);
                            a0 = siluf_(a0) * osc; a1 = siluf_(a1) * osc; v0[tt] = a0; v1[tt] = a1;
                            *(unsigned*)(dst + (size_t)t * 1024) = pk2(a0, a1); }
                        if (strip) { u32x4 s0, s1; s0.x = pk2(v0[0], v0[1]); s0.y = pk2(v0[2], v0[3]); s0.z = pk2(v0[4], v0[5]); s0.w = pk2(v0[6], v0[7]); s1.x = pk2(v1[0], v1[1]); s1.y = pk2(v1[2], v1[3]); s1.z = pk2(v1[4], v1[5]); s1.w = pk2(v1[6], v1[7]);
                            *(u32x4*)(strip + t8 * 8) = s0; *(u32x4*)(strip + 64 + t8 * 8) = s1; } }
                } else {
                    const int c = (tid & 255) * 2, th = tid >> 8; const bf16_t* pp = P + (tok0 + th * 32) * LDP + ML_OFF + 1024 + c; bf16_t* strip = VTG + ((size_t)seg * 512 + c) * 64 + th * 32;
                    unsigned rv[32];
#pragma unroll
                    for (int t = 0; t < 32; ++t) rv[t] = *(const unsigned*)(pp + (size_t)t * LDP);
#pragma unroll
                    for (int t8 = 0; t8 < 4; ++t8) { u32x4 s0, s1;
                        s0.x = (rv[t8 * 8 + 0] & 0xFFFFu) | (rv[t8 * 8 + 1] << 16); s0.y = (rv[t8 * 8 + 2] & 0xFFFFu) | (rv[t8 * 8 + 3] << 16); s0.z = (rv[t8 * 8 + 4] & 0xFFFFu) | (rv[t8 * 8 + 5] << 16); s0.w = (rv[t8 * 8 + 6] & 0xFFFFu) | (rv[t8 * 8 + 7] << 16);
                        s1.x = (rv[t8 * 8 + 0] >> 16) | (rv[t8 * 8 + 1] & 0xFFFF0000u); s1.y = (rv[t8 * 8 + 2] >> 16) | (rv[t8 * 8 + 3] & 0xFFFF0000u); s1.z = (rv[t8 * 8 + 4] >> 16) | (rv[t8 * 8 + 5] & 0xFFFF0000u); s1.w = (rv[t8 * 8 + 6] >> 16) | (rv[t8 * 8 + 7] & 0xFFFF0000u);
                        *(u32x4*)(strip + t8 * 8) = s0; *(u32x4*)(strip + 64 + t8 * 8) = s1; }
                }
            }
            if (!lastl) for (int tok = NLAT + bid; tok < NTOK; tok += G) {
                const int t = (tok - NLAT) & (CTXL - 1); const bool hasL = (t != 0), hasR = (t != CTXL - 1); const bf16_t* pr = P + (size_t)tok * LDP;
                const bf16_t* prL = hasL ? pr - LDP : pr; const bf16_t* prR = hasR ? pr + LDP : pr;
                unsigned xc[3], xl[3], xr[3];
#pragma unroll
                for (int j = 0; j < 3; ++j) { const int cc = tid + j * 512; xc[j] = pr[HY_OFF + cc]; xl[j] = prL[HY_OFF + cc]; xr[j] = prR[HY_OFF + cc]; }
#pragma unroll
                for (int j = 0; j < 3; ++j) { const int cc = tid + j * 512;
                    float acc = hcb[cc] + hcw[1536 + cc] * __uint_as_float(xc[j] << 16);
                    acc += hasL ? hcw[cc] * __uint_as_float(xl[j] << 16) : 0.f;
                    acc += hasR ? hcw[2 * 1536 + cc] * __uint_as_float(xr[j] << 16) : 0.f;
                    U[(size_t)tok * 1536 + cc] = acc; }
            }
            for (int idx0 = bid * NTHR + tid; idx0 < 16384 * 64; idx0 += 4 * G * NTHR) { u32x4 t4[4];
#pragma unroll
                for (int q = 0; q < 4; ++q) { const int idx = idx0 + q * G * NTHR; const int half = idx & 1, g = (idx >> 1) & 31, tok = idx >> 6;
                    if (idx < 16384 * 64) t4[q] = *(const u32x4*)(P + (size_t)tok * LDP + S5_OFF + g * 16 + half * 8); }
#pragma unroll
                for (int q = 0; q < 4; ++q) { const int idx = idx0 + q * G * NTHR; const int half = idx & 1, g = (idx >> 1) & 31, tok = idx >> 6;
                    if (idx < 16384 * 64) *(u32x4*)(S5A + ((size_t)g * 512 + (tok >> 5)) * 768 + (tok & 31) * 16 + half * 8) = t4[q]; } }
            for (int idx = bid * NTHR + tid; idx < 32 * 512 * 32 * 2; idx += G * NTHR) { const int half = idx & 1, sI = (idx >> 1) & 31, row = (idx >> 6) & 511, g = idx >> 15; const int t = row >> 4, c = row & 15; const int lag = t - sI;
                float v[8];
                if (lag > 0) { const float4* k4 = (const float4*)(KTB + ((size_t)((g * 2 + 0) * 32 + lag) * 16 + c) * 16 + half * 8); const float4 a0 = k4[0], a1 = k4[1]; v[0] = a0.x; v[1] = a0.y; v[2] = a0.z; v[3] = a0.w; v[4] = a1.x; v[5] = a1.y; v[6] = a1.z; v[7] = a1.w; }
                else if (lag < 0) { const float4* k4 = (const float4*)(KTB + ((size_t)((g * 2 + 1) * 32 - lag) * 16 + c) * 16 + half * 8); const float4 a0 = k4[0], a1 = k4[1]; v[0] = a0.x; v[1] = a0.y; v[2] = a0.z; v[3] = a0.w; v[4] = a1.x; v[5] = a1.y; v[6] = a1.z; v[7] = a1.w; }
                else { const float4* k4 = (const float4*)(KTB + ((size_t)((g * 2 + 0) * 32) * 16 + c) * 16 + half * 8); const float4* q4 = (const float4*)(KTB + ((size_t)((g * 2 + 1) * 32) * 16 + c) * 16 + half * 8); const float4 a0 = k4[0], a1 = k4[1], b0 = q4[0], b1 = q4[1];
                    v[0] = a0.x + b0.x; v[1] = a0.y + b0.y; v[2] = a0.z + b0.z; v[3] = a0.w + b0.w; v[4] = a1.x + b1.x; v[5] = a1.y + b1.y; v[6] = a1.z + b1.z; v[7] = a1.w + b1.w; }
                u32x4 w; w.x = pk2(v[0], v[1]); w.y = pk2(v[2], v[3]); w.z = pk2(v[4], v[5]); w.w = pk2(v[6], v[7]);
                *(u32x4*)(S5B + ((size_t)g * 512 + row) * 768 + sI * 16 + half * 8) = w; }
            for (int idx = bid * NTHR + tid; idx < 32 * 512 * 64; idx += G * NTHR) { const int n = idx & 63, row = (idx >> 6) & 511, g = idx >> 15; const int t = row >> 4, c = row & 15;
                const float cr = (PT(29) + l * 32 * 16 * 64)[(g * 16 + c) * 64 + n], ci = (PT(30) + l * 32 * 16 * 64)[(g * 16 + c) * 64 + n];
                const float2 af = APW[((0 * 32 + g) * 64 + n) * 33 + t + 1], ab = APW[((1 * 32 + g) * 64 + n) * 33 + 32 - t];
                bf16_t* d = S5B + ((size_t)g * 512 + row) * 768 + 512 + 2 * n;
                *(unsigned*)d = pk2(cr * af.x - ci * af.y, -(cr * af.y + ci * af.x)); *(unsigned*)(d + 128) = pk2(cr * ab.x - ci * ab.y, -(cr * ab.y + ci * ab.x)); }
            for (int idx = bid * NTHR + tid; idx < 32 * 2 * 64 * 32; idx += G * NTHR) { const int sI = idx & 31, n = (idx >> 5) & 63, dir = (idx >> 11) & 1, g = idx >> 12; const int pi = (dir * 32 + g) * 64 + n;
                const float2 pw = APW[pi * 33 + (dir ? sI : 31 - sI)]; const float4* bb = (const float4*)(BBT + pi * 16);
                float re[16], im[16];
#pragma unroll
                for (int j = 0; j < 8; ++j) { const float4 b2 = bb[j]; re[2 * j] = pw.x * b2.x - pw.y * b2.y; im[2 * j] = pw.x * b2.y + pw.y * b2.x; re[2 * j + 1] = pw.x * b2.z - pw.y * b2.w; im[2 * j + 1] = pw.x * b2.w + pw.y * b2.z; }
                bf16_t* d = S5P + ((size_t)g * 256 + dir * 128 + 2 * n) * 512 + sI * 16;
                u32x4 w0, w1; w0.x = pk2(re[0], re[1]); w0.y = pk2(re[2], re[3]); w0.z = pk2(re[4], re[5]); w0.w = pk2(re[6], re[7]); w1.x = pk2(re[8], re[9]); w1.y = pk2(re[10], re[11]); w1.z = pk2(re[12], re[13]); w1.w = pk2(re[14], re[15]);
                *(u32x4*)d = w0; *(u32x4*)(d + 8) = w1;
                w0.x = pk2(im[0], im[1]); w0.y = pk2(im[2], im[3]); w0.z = pk2(im[4], im[5]); w0.w = pk2(im[6], im[7]); w1.x = pk2(im[8], im[9]); w1.y = pk2(im[10], im[11]); w1.z = pk2(im[12], im[13]); w1.w = pk2(im[14], im[15]);
                *(u32x4*)(d + 512) = w0; *(u32x4*)(d + 520) = w1; }
            {   float* T0 = sf; float* T1 = sf + 64 * 65;
                const int NU = 4 * 64 * 24; const int cL = tid & 63, tL = tid >> 6, c = tid >> 3, tq = (tid & 7) * 8;
                for (int unit = bid; unit < NU; unit += 2 * G) { const bool has2 = unit + G < NU; const int unit2 = has2 ? unit + G : unit;
                    const int ba = unit / (64 * 24), ra = (unit / 24) % 64, c0a = (unit % 24) * 64; const size_t toka = (size_t)ba * SEQ + ra * 64;
                    const int bb_ = unit2 / (64 * 24), rb = (unit2 / 24) % 64, c0b = (unit2 % 24) * 64; const size_t tokb = (size_t)bb_ * SEQ + rb * 64;
                    unsigned pa[8], pb[8];
#pragma unroll
                    for (int i = 0; i < 8; ++i) { pa[i] = P[(toka + tL + 8 * i) * LDP + HY_OFF + c0a + cL]; pb[i] = P[(tokb + tL + 8 * i) * LDP + HY_OFF + c0b + cL]; }
                    const int cca = c0a + c, ccb = c0b + c;
                    const float w0a = hcw[cca], w1a = hcw[1536 + cca], w2a = hcw[3072 + cca], bia = hcb[cca], w0b = hcw[ccb], w1b = hcw[1536 + ccb], w2b = hcw[3072 + ccb], bib = hcb[ccb];
                    __syncthreads();
#pragma unroll
                    for (int i = 0; i < 8; ++i) { T0[(tL + 8 * i) * 65 + cL] = __uint_as_float(pa[i] << 16); T1[(tL + 8 * i) * 65 + cL] = __uint_as_float(pb[i] << 16); }
                    __syncthreads();
                    {   float o8[8];
#pragma unroll
                        for (int i = 0; i < 8; ++i) { const int t = tq + i; float acc = bia + w1a * T0[t * 65 + c]; if (t > 0) acc += w0a * T0[(t - 1) * 65 + c]; if (t < 63) acc += w2a * T0[(t + 1) * 65 + c]; o8[i] = acc; }
                        u32x4 wv; wv.x = pk2(o8[0], o8[1]); wv.y = pk2(o8[2], o8[3]); wv.z = pk2(o8[4], o8[5]); wv.w = pk2(o8[6], o8[7]);
                        *(u32x4*)(UT + ((size_t)ba * 1536 + cca) * SEQ + ra * 64 + tq) = wv; }
                    if (has2) { float o8[8];
#pragma unroll
                        for (int i = 0; i < 8; ++i) { const int t = tq + i; float acc = bib + w1b * T1[t * 65 + c]; if (t > 0) acc += w0b * T1[(t - 1) * 65 + c]; if (t < 63) acc += w2b * T1[(t + 1) * 65 + c]; o8[i] = acc; }
                        u32x4 wv; wv.x = pk2(o8[0], o8[1]); wv.y = pk2(o8[2], o8[3]); wv.z = pk2(o8[4], o8[5]); wv.w = pk2(o8[6], o8[7]);
                        *(u32x4*)(UT + ((size_t)bb_ * 1536 + ccb) * SEQ + rb * 64 + tq) = wv; }
                } }
            if (!lastl) {
                const int L = CTXL; const float* HR = HRAW + (size_t)SEQ * 2048; float* K2 = K2C; const float* nrm = NORM + (size_t)(l * 2 + 1) * 1024;
                const size_t total = (size_t)(2 * L - 1) * 1024;
                for (size_t i = (size_t)bid * NTHR + tid; i < total; i += (size_t)G * NTHR) { const int j = (int)(i >> 10), oc = (int)(i & 1023), o = oc >> 9, c = oc & 511; const int lag = j - (L - 1);
                    const float v = lag >= 0 ? HR[(size_t)lag * 2048 + o * 1024 + c] : HR[(size_t)(-lag) * 2048 + o * 1024 + 512 + c];
                    K2[((size_t)j * 2 + o) * 512 + c] = v / nrm[oc]; }
            }
            {   __syncthreads(); fft_twiddles((float2*)(shm + FFT_X_BYTES), tid);
                for (int pr = bid; pr < 512; pr += G) hyena_spec_item(pr, HRAW, NORM + (size_t)(l * 2 + 0) * 1024, HSPEC, shm, tid);
                __syncthreads(); }
            SEAM(PB + 2);
        }

        if (IN(PB + 3)) for (int rep_ = 0; rep_ < PROBE_REPS(3); ++rep_) {
            PH_BEGIN
            if (rep_ > 0) { if (bid == 0 && tid == 0) __hip_atomic_store(QCTR + l * 64, 0, __ATOMIC_RELAXED, __HIP_MEMORY_SCOPE_AGENT); xcd_barrier(bar); }
            if (bid < 64) {
                mlstm_state_pass(bid >> 1, bid & 1, P, KTG, VTG, PT(22) + l * 16, CST, NST, MST, shm, tid);
            } else if (bid < 128) {
                { const int ch = bid - 64; const int dir_ = ch & 1, h_ = (ch >> 1) & 7; ssd_state_pass(ch, P, BTG, XTG, -expf(PT(37)[l * 16 + dir_ * 8 + h_]), PT(36)[l * 16 + dir_ * 8 + h_], SSTB, shm, tid); }
            } else if (bid < 160) {
                const int widx = (bid - 128) * 8 + wave; const int dir = widx & 1, g = (widx >> 1) & 31, b = widx >> 6; const int n = lane;
                float2* xb = (float2*)(shm + (size_t)wave * 16640); float2* ctab = xb + 16 * 65;
                const float* a_re = PT(24) + l * 2 * 32 * 64; const float* a_im = PT(25) + l * 2 * 32 * 64; const float* log_dt = PT(26) + l * 64;
                const float* b_re = PT(27) + l * 32 * 64 * 16; const float* b_im = PT(28) + l * 32 * 64 * 16; const float* c_re = PT(29) + l * 32 * 16 * 64; const float* c_im = PT(30) + l * 32 * 16 * 64;
#pragma unroll
                for (int c = 0; c < 16; ++c) ctab[c * 65 + lane] = make_float2(c_re[(g * 16 + c) * 64 + lane], c_im[(g * 16 + c) * 64 + lane]);
                float abr, abi, bbr[16], bbi[16];
                {   const double are = (double)a_re[(dir * 32 + g) * 64 + n], aim = (double)a_im[(dir * 32 + g) * 64 + n];
                    const double lam = are < -1e-4 ? are : -1e-4; const double dt = exp((double)log_dt[dir * 32 + g]);
                    const double mag = exp(lam * dt); const double ar = mag * cos(aim * dt), ai = mag * sin(aim * dt);
                    const double den = lam * lam + aim * aim; const double nr = ar - 1.0, ni = ai;
                    const double fre = (nr * lam + ni * aim) / den, fim = (ni * lam - nr * aim) / den;
                    abr = (float)ar; abi = (float)ai;
#pragma unroll
                    for (int c = 0; c < 16; ++c) { const double br = (double)b_re[(g * 64 + n) * 16 + c], bi = (double)b_im[(g * 64 + n) * 16 + c]; bbr[c] = (float)(fre * br - fim * bi); bbi[c] = (float)(fre * bi + fim * br); }
                }
                float xr = 0.f, xi = 0.f; float* Sout = (dir ? SB : SF) - (size_t)NLAT * BW;
                const int s = lane >> 2, cg = lane & 3;
                for (int i0 = 0; i0 < CTXL; i0 += 16) {
#pragma unroll 4
                    for (int ss = 0; ss < 16; ++ss) {
                        const size_t tok = (size_t)step_tok(b, dir, i0 + ss);
                        const u32x4* up = (const u32x4*)(P + tok * LDP + S5_OFF + g * 16);
                        float t0[8], t1[8]; unpack8(up[0], t0); unpack8(up[1], t1);
                        float bur = 0.f, bui = 0.f;
#pragma unroll
                        for (int c = 0; c < 8; ++c) { bur += t0[c] * bbr[c] + t1[c] * bbr[8 + c]; bui += t0[c] * bbi[c] + t1[c] * bbi[8 + c]; }
                        const float nxr = abr * xr - abi * xi + bur, nxi = abr * xi + abi * xr + bui; xr = nxr; xi = nxi;
                        xb[ss * 65 + lane] = make_float2(xr, xi);
                    }
                    asm volatile("s_waitcnt lgkmcnt(0)" ::: "memory");
                    float y0 = 0.f, y1 = 0.f, y2 = 0.f, y3 = 0.f;
                    for (int nn2 = 0; nn2 < 64; ++nn2) { const float2 xv = xb[s * 65 + nn2];
                        const float2 c0 = ctab[(cg * 4 + 0) * 65 + nn2], c1 = ctab[(cg * 4 + 1) * 65 + nn2], c2 = ctab[(cg * 4 + 2) * 65 + nn2], c3 = ctab[(cg * 4 + 3) * 65 + nn2];
                        y0 += xv.x * c0.x - xv.y * c0.y; y1 += xv.x * c1.x - xv.y * c1.y; y2 += xv.x * c2.x - xv.y * c2.y; y3 += xv.x * c3.x - xv.y * c3.y; }
                    const size_t toks = (size_t)step_tok(b, dir, i0 + s);
                    *(float4*)(Sout + toks * BW + g * 16 + cg * 4) = make_float4(y0, y1, y2, y3);
                    asm volatile("s_waitcnt lgkmcnt(0)" ::: "memory");
                }
                XCTX[((b * 32 + g) * 2 + dir) * 64 + n] = make_float2(xr, xi);
            } else {
                if (bid < 224) {
                    pg8::Gemm gg_{S5A, S5P, 768, 512, 512}; pg8::SchedS5a S_{bid - 160}; pg8::EpiXloc E_{XLOC};
                    pg8::gemm_phase((LAS unsigned char*)shm, gg_, S_, E_);
                    __syncthreads();
                }
                const int nhb = G - 160, hb = bid - 160; const float* bias = PT(19) + l * 1024; const int c = tid;
                const int nitems = lastl ? 0 : 4 * (CTXL / 8);
                for (int it = hb; it < nitems; it += nhb) {
                    int L, tokbase, b, t0; const float* K2;
                    { const int q = it; L = CTXL; tokbase = NLAT; b = q / (CTXL / 8); t0 = (q % (CTXL / 8)) * 8; K2 = K2C; }
                    const float* zb = U + (size_t)(tokbase + b * L) * 1536 + c;
                    float acc[8];
#pragma unroll
                    for (int i = 0; i < 8; ++i) acc[i] = 0.f;
                    const int base = t0 + L - 1;
                    for (int s = 0; s < L; s += 8) {
                        float k[15];
#pragma unroll
                        for (int mm = 0; mm < 15; ++mm) k[mm] = K2[((size_t)(base - s - 7 + mm) * 2 + 0) * 512 + c];
#pragma unroll
                        for (int ds = 0; ds < 8; ++ds) { const float z = zb[(size_t)(s + ds) * 1536];
#pragma unroll
                            for (int i = 0; i < 8; ++i) acc[i] += k[i - ds + 7] * z; }
                    }
#pragma unroll
                    for (int i = 0; i < 8; ++i) { const size_t tok = (size_t)(tokbase + b * L + t0 + i); const float zt = U[tok * 1536 + c]; Z[tok * BW + c] = (acc[i] + bias[c] * zt) * U[tok * 1536 + 512 + c]; }
                }
            }
            {   __syncthreads(); fft_twiddles((float2*)(shm + FFT_X_BYTES), tid);
                int* qslot = (int*)(shm + FFT_X_BYTES + 65536);
                for (;;) { __syncthreads(); if (tid == 0) *qslot = atomicAdd(QCTR + l * 64, 1); __syncthreads(); const int it = *qslot; if (it >= 1024) break;
                    hyena_fft_item(it, UT, HSPEC, PT(19) + l * 1024, YT, shm, tid); }
            }
            SEAM(PB + 3);
        }

        if (IN(PB + 4)) for (int rep_ = 0; rep_ < PROBE_REPS(4); ++rep_) {
            PH_BEGIN
            if (rep_ > 0) { if (bid == 0 && tid == 0) __hip_atomic_store(QCTR + l * 64 + 32, 0, __ATOMIC_RELAXED, __HIP_MEMORY_SCOPE_AGENT); xcd_barrier(bar); }
            if (bid >= G - 32) for (int idx = (bid - (G - 32)) * NTHR + tid; idx < 16384; idx += 32 * NTHR) { const int n = idx & 63, dir = (idx >> 6) & 1, b = (idx >> 7) & 3, g = idx >> 9;
                const float2 a32 = APW[((dir * 32 + g) * 64 + n) * 33 + 32]; float2 X = XCTX[((b * 32 + g) * 2 + dir) * 64 + n];
                const float* __restrict__ xl = XLOC + ((size_t)g * 512 + b * 128) * 256 + dir * 128 + 2 * n; bf16_t* __restrict__ dst = S5A + ((size_t)g * 512 + b * 128) * 768 + 512 + dir * 128 + 2 * n;
#pragma unroll 1
                for (int j0 = 0; j0 < 128; j0 += 16) { float2 xv[16];
#pragma unroll
                    for (int q = 0; q < 16; ++q) { const int j = dir ? 127 - (j0 + q) : j0 + q; xv[q] = *(const float2*)(xl + (size_t)j * 256); }
#pragma unroll
                    for (int q = 0; q < 16; ++q) { const int j = dir ? 127 - (j0 + q) : j0 + q;
                        *(unsigned*)(dst + (size_t)j * 768) = pk2(X.x, X.y);
                        const float nx = a32.x * X.x - a32.y * X.y + xv[q].x, ny = a32.x * X.y + a32.y * X.x + xv[q].y; X.x = nx; X.y = ny; } } }
            {   int* qslot = (int*)(shm + 102400);
                __syncthreads(); if (tid == 0) *qslot = atomicAdd(QCTR + l * 64 + 32, 1); __syncthreads();
                for (;;) { const int it = *qslot; if (it >= 32 * 68 + 64 * 68) break;
                    int nxt_ = 0; if (tid == 0) nxt_ = atomicAdd(QCTR + l * 64 + 32, 1);
                    if (it < 32 * 68) { const int chain = it / 68, c = it % 68; mlstm_out_item(chain, c, P, QKB, VTG, PT(22) + l * 16, CST, NST, MST, (chain & 1) ? HBk : HF, shm, tid); }
                    else { const int i2 = it - 32 * 68; const int chain = i2 / 68, c = i2 % 68; const int dir_ = chain & 1, h_ = (chain >> 1) & 7;
                        ssd_out_item(chain, c, P, XBC, XTG, -expf(PT(37)[l * 16 + dir_ * 8 + h_]), PT(36)[l * 16 + dir_ * 8 + h_], SSTB, dir_ ? YB : YF, shm, tid); }
                    __syncthreads(); if (tid == 0) *qslot = nxt_; __syncthreads(); }
            }
            __syncthreads();
            {   const float* bias = PT(19) + l * 1024 + 512; const int c = tid;
                const int nitems = lastl ? 0 : 4 * (CTXL / 8);
                for (int it = bid; it < nitems; it += G) {
                    int L, tokbase, b, t0; const float* K2;
                    { const int q = it; L = CTXL; tokbase = NLAT; b = q / (CTXL / 8); t0 = (q % (CTXL / 8)) * 8; K2 = K2C; }
                    const float* zb = Z + (size_t)(tokbase + b * L) * BW + c;
                    float acc[8];
#pragma unroll
                    for (int i = 0; i < 8; ++i) acc[i] = 0.f;
                    const int base = t0 + L - 1;
                    for (int s = 0; s < L; s += 8) {
                        float k[15];
#pragma unroll
                        for (int mm = 0; mm < 15; ++mm) k[mm] = K2[((size_t)(base - s - 7 + mm) * 2 + 1) * 512 + c];
#pragma unroll
                        for (int ds = 0; ds < 8; ++ds) { const float z = zb[(size_t)(s + ds) * BW];
#pragma unroll
                            for (int i = 0; i < 8; ++i) acc[i] += k[i - ds + 7] * z; }
                    }
#pragma unroll
                    for (int i = 0; i < 8; ++i) { const size_t tok = (size_t)(tokbase + b * L + t0 + i); const float zt = Z[tok * BW + c]; Y4[tok * DM + c] = f2bf((acc[i] + bias[c] * zt) * U[tok * 1536 + 1024 + c]); }
                }
            }
            SEAM(PB + 4);
        }

        if (IN(PB + 5)) for (int rep_ = 0; rep_ < PROBE_REPS(5); ++rep_) {
            PH_BEGIN
            const float* ml_norm = PT(23) + l * BW; const float* ssd_d = PT(38) + l * 8; const float* ssd_norm = PT(39) + l * BW; const float* s5_d = PT(31) + l * BW;
            if (bid < 128) {
                pg8::Gemm gg_{S5A, S5B, 768, 768, 768}; pg8::SchedS5b S_{bid}; pg8::EpiS5Out E_{P, s5_d, GG};
                pg8::gemm_phase((LAS unsigned char*)shm, gg_, S_, E_);
                __syncthreads();
            }
            for (int tok = bid * 8 + wave; tok < NTOK; tok += G * 8) {
                const int c0 = lane * 8; const bf16_t* pr = P + (size_t)tok * LDP; const size_t o5 = (size_t)tok * BW + c0;
                float hm[8], ys[8];
                const u32x4 ooq = *(const u32x4*)(pr + ML_OFF + 1536 + c0);
                const float4 g0 = *(const float4*)(ml_norm + c0), g1 = *(const float4*)(ml_norm + c0 + 4), n0 = *(const float4*)(ssd_norm + c0), n1 = *(const float4*)(ssd_norm + c0 + 4);
                { float fa[8], fb[8]; unpack8(*(const u32x4*)(HF + o5), fa); unpack8(*(const u32x4*)(HBk + o5), fb);
#pragma unroll
                  for (int j = 0; j < 8; ++j) hm[j] = fa[j] + fb[j]; }
                { float ya[8], yb[8]; unpack8(*(const u32x4*)(YF + o5), ya); unpack8(*(const u32x4*)(YB + o5), yb);
                  float xx[8], zz[8]; unpack8(*(const u32x4*)(XBC + (size_t)tok * 1024 + c0), xx); unpack8(*(const u32x4*)(pr + SSD_OFF + c0), zz); const float dsk = ssd_d[c0 >> 6];
#pragma unroll
                  for (int j = 0; j < 8; ++j) ys[j] = ya[j] + yb[j];
#pragma unroll
                  for (int j = 0; j < 8; ++j) ys[j] = (ys[j] + dsk * xx[j]) * siluf_(zz[j]); }
                float s1 = 0.f, s2 = 0.f;
#pragma unroll
                for (int j = 0; j < 8; ++j) { s1 += hm[j] * hm[j]; s2 += ys[j] * ys[j]; }
                s1 += __shfl_xor(s1, 1); s1 += __shfl_xor(s1, 2); s1 += __shfl_xor(s1, 4); s1 += __shfl_xor(s1, 8);
                s2 = wave_sum(s2);
                const float r1 = rsqrtf(s1 * (1.0f / 128.0f) + 1e-6f), r2 = rsqrtf(s2 * (1.0f / BW) + 1e-6f);
                float oo[8]; unpack8(ooq, oo);
                const float gm[8] = {g0.x, g0.y, g0.z, g0.w, g1.x, g1.y, g1.z, g1.w}, gs[8] = {n0.x, n0.y, n0.z, n0.w, n1.x, n1.y, n1.z, n1.w};
                u32x4 w;
                w.x = pk2(hm[0] * r1 * gm[0] * sigmoidf_(oo[0]), hm[1] * r1 * gm[1] * sigmoidf_(oo[1])); w.y = pk2(hm[2] * r1 * gm[2] * sigmoidf_(oo[2]), hm[3] * r1 * gm[3] * sigmoidf_(oo[3]));
                w.z = pk2(hm[4] * r1 * gm[4] * sigmoidf_(oo[4]), hm[5] * r1 * gm[5] * sigmoidf_(oo[5])); w.w = pk2(hm[6] * r1 * gm[6] * sigmoidf_(oo[6]), hm[7] * r1 * gm[7] * sigmoidf_(oo[7]));
                *(u32x4*)(Y4 + (size_t)tok * DM + 512 + c0) = w;
                w.x = pk2(ys[0] * r2 * gs[0], ys[1] * r2 * gs[1]); w.y = pk2(ys[2] * r2 * gs[2], ys[3] * r2 * gs[3]); w.z = pk2(ys[4] * r2 * gs[4], ys[5] * r2 * gs[5]); w.w = pk2(ys[6] * r2 * gs[6], ys[7] * r2 * gs[7]);
                *(u32x4*)(Y4 + (size_t)tok * DM + 1536 + c0) = w;
                if (tok >= NLAT) { const size_t oc = (size_t)(tok - NLAT) * BW + c0; float uu[8]; unpack8(*(const u32x4*)(pr + S5_OFF + c0), uu);
                    const float4 a0 = *(const float4*)(SF + oc), a1 = *(const float4*)(SF + oc + 4), b0 = *(const float4*)(SB + oc), b1 = *(const float4*)(SB + oc + 4), d0 = *(const float4*)(s5_d + c0), d1 = *(const float4*)(s5_d + c0 + 4);
                    float y[8] = {a0.x + b0.x + d0.x * uu[0], a0.y + b0.y + d0.y * uu[1], a0.z + b0.z + d0.z * uu[2], a0.w + b0.w + d0.w * uu[3], a1.x + b1.x + d1.x * uu[4], a1.y + b1.y + d1.y * uu[5], a1.z + b1.z + d1.z * uu[6], a1.w + b1.w + d1.w * uu[7]};
#pragma unroll
                    for (int j = 0; j < 8; ++j) y[j] = 0.5f * y[j] * (1.0f + tanhf(0.7978845608028654f * (y[j] + 0.044715f * y[j] * y[j] * y[j])));
                    w.x = pk2(y[0], y[1]); w.y = pk2(y[2], y[3]); w.z = pk2(y[4], y[5]); w.w = pk2(y[6], y[7]);
                    *(u32x4*)(GG + (size_t)tok * BW + c0) = w; }
            }
            __syncthreads();
            {   float* T = sf;
                for (int unit = (G > 128 ? bid - 128 : bid); unit >= 0 && unit < 4 * 64 * 8; unit += (G > 128 ? G - 128 : G)) { const int b = unit / 512, t0 = ((unit >> 3) & 63) * 64, c0 = (unit & 7) * 64;
                    __syncthreads();
#pragma unroll
                    for (int i = 0; i < 8; ++i) { const int t = tid & 63, c = (tid >> 6) + 8 * i; T[c * 65 + t] = __uint_as_float((unsigned)YT[((size_t)b * 512 + c0 + c) * SEQ + t0 + t] << 16); }
                    __syncthreads();
                    const int t = tid >> 3, cq = (tid & 7) * 8;
                    u32x4 w; w.x = pk2(T[(cq + 0) * 65 + t], T[(cq + 1) * 65 + t]); w.y = pk2(T[(cq + 2) * 65 + t], T[(cq + 3) * 65 + t]); w.z = pk2(T[(cq + 4) * 65 + t], T[(cq + 5) * 65 + t]); w.w = pk2(T[(cq + 6) * 65 + t], T[(cq + 7) * 65 + t]);
                    *(u32x4*)(Y4 + ((size_t)b * SEQ + t0 + t) * DM + c0 + cq) = w;
                } }
            SEAM(PB + 5);
        }

        if (IN(PB + 6)) for (int rep_ = 0; rep_ < PROBE_REPS(6); ++rep_) {
            PH_BEGIN
            pg8::Gemm g{GG, GLU, BW, BW, BW}; pg8::SchedStd S{68, 2, G, bid, BW, BW}; pg8::EpiGlu E{GG, PT(33) + l * BW, Y4};
            pg8::gemm_phase((LAS unsigned char*)shm, g, S, E);
            SEAM(PB + 6);
        }
        if (IN(PB + 7)) for (int rep_ = 0; rep_ < PROBE_REPS(7); ++rep_) {
            PH_BEGIN
            pg8::Gemm g{Y4, WBR, DM, BW, BW}; pg8::SchedBranch S{64, 8, G, bid}; pg8::EpiBranch E{P, ACCb};
            pg8::gemm_phase((LAS unsigned char*)shm, g, S, E);
            if (!lastl) { __syncthreads(); pg8::SchedTail S2{G, bid}; pg8::EpiPartK E2{(float*)HSPEC}; pg8::gemm_phase((LAS unsigned char*)shm, g, S2, E2); }
            SEAM(PB + 7);
        }
        if (IN(PB + 8)) for (int rep_ = 0; rep_ < PROBE_REPS(8); ++rep_) {
            PH_BEGIN
            if (!lastl) {
                const float* PART = (const float*)HSPEC;
                for (int idx = bid * NTHR + tid; idx < (NTOK - NLAT) * DM / 8; idx += G * NTHR) { const size_t o = (size_t)idx * 8; f32x4 p[4][2];
#pragma unroll
                    for (int k = 0; k < 4; ++k) { p[k][0] = *(const f32x4*)(PART + (size_t)k * (NTOK - NLAT) * DM + o); p[k][1] = *(const f32x4*)(PART + (size_t)k * (NTOK - NLAT) * DM + o + 4); }
                    f32x4 s0 = (f32x4){0.f, 0.f, 0.f, 0.f}, s1 = s0; const bf16_t* rp = P + (size_t)(NLAT + (o >> 11)) * LDP + GATE2 + (o & (DM - 1));
#pragma unroll
                    for (int k = 0; k < 4; ++k) { float rr[8]; unpack8(*(const u32x4*)(rp + k * DM), rr);
                        s0 = s0 + p[k][0]; s1 = s1 + p[k][1]; s0[0] *= rr[0]; s0[1] *= rr[1]; s0[2] *= rr[2]; s0[3] *= rr[3]; s1[0] *= rr[4]; s1[1] *= rr[5]; s1[2] *= rr[6]; s1[3] *= rr[7]; }
                    u32x4 w; w.x = pk2(s0[0], s0[1]); w.y = pk2(s0[2], s0[3]); w.z = pk2(s1[0], s1[1]); w.w = pk2(s1[2], s1[3]);
                    *(u32x4*)(ACCb + (size_t)NLAT * DM + o) = w; }
                xcd_barrier(bar);
            }
            pg8::Gemm g{ACCb, WOUT, DM, DM, DM}; pg8::SchedStd S{64, 8, G, bid, DM, DM}; pg8::EpiResid E{XS, l == 0 ? x_in : (const float*)XS, l == 0 ? ctx_in - (size_t)NLAT * DM : (const float*)XS, MODl, 2};
            pg8::gemm_phase((LAS unsigned char*)shm, g, S, E);
            if (!lastl) { __syncthreads(); pg8::Gemm g2{ACCb, WOUT, DM, DM, 512}; pg8::SchedTailK S2{G, bid}; pg8::EpiPartK E2{(float*)HSPEC + (size_t)4 * (NTOK - NLAT) * DM}; pg8::gemm_phase((LAS unsigned char*)shm, g2, S2, E2); }
            SEAM(PB + 8);
        }
        if (IN(PB + 9)) for (int rep_ = 0; rep_ < PROBE_REPS(9); ++rep_) {
            PH_BEGIN
            if (!lastl) {
                const float* PART = (const float*)HSPEC + (size_t)4 * (NTOK - NLAT) * DM; const float* mg = MODl + (size_t)(4 * 6 + 2) * DM;
                const float* src = l == 0 ? ctx_in : (const float*)XS + (size_t)NLAT * DM;
                for (int idx = bid * NTHR + tid; idx < (NTOK - NLAT) * DM / 4; idx += G * NTHR) { const size_t o = (size_t)idx * 4; const int col = (int)(o & (DM - 1));
                    const f32x4 p0 = *(const f32x4*)(PART + o), p1 = *(const f32x4*)(PART + (size_t)(NTOK - NLAT) * DM + o), p2 = *(const f32x4*)(PART + (size_t)2 * (NTOK - NLAT) * DM + o), p3 = *(const f32x4*)(PART + (size_t)3 * (NTOK - NLAT) * DM + o);
                    const f32x4 sv = *(const f32x4*)(src + o), gm = *(const f32x4*)(mg + col);
                    *(f32x4*)(XS + (size_t)NLAT * DM + o) = sv + gm * (((p0 + p1) + p2) + p3); }
                xcd_barrier(bar);
            }
            for (int i = bid * NTHR + tid; i < NEXP * MOE_PAD; i += G * NTHR) ROWTOK[i] = -1;
            for (int i = bid * NTHR + tid; i < NTOK * 16; i += G * NTHR) INV[i] = -1;
            const float* wr = PT(42) + (size_t)l * DM * 16; const float* gn = norm_ffn + l * DM;
            float* wl = sf;
            __syncthreads();
#pragma unroll 1
            for (int q0 = 0; q0 < 16; q0 += 4) {
                const float4 a0 = ((const float4*)wr)[(q0 + 0) * 512 + tid], a1 = ((const float4*)wr)[(q0 + 1) * 512 + tid], a2 = ((const float4*)wr)[(q0 + 2) * 512 + tid], a3 = ((const float4*)wr)[(q0 + 3) * 512 + tid];
                { const int f4 = (q0 + 0) * 512 + tid; *(float4*)(wl + (size_t)(f4 >> 4) * 68 + (f4 & 15) * 4) = a0; }
                { const int f4 = (q0 + 1) * 512 + tid; *(float4*)(wl + (size_t)(f4 >> 4) * 68 + (f4 & 15) * 4) = a1; }
                { const int f4 = (q0 + 2) * 512 + tid; *(float4*)(wl + (size_t)(f4 >> 4) * 68 + (f4 & 15) * 4) = a2; }
                { const int f4 = (q0 + 3) * 512 + tid; *(float4*)(wl + (size_t)(f4 >> 4) * 68 + (f4 & 15) * 4) = a3; } }
            __syncthreads();
            for (int tok0 = (bid * 8 + wave) * 4; tok0 < M2; tok0 += G * 32) {
                const int r = tok0 < NLAT ? tok0 / SEQ : 4; const float* xr = XS + (size_t)tok0 * DM;
                const float* sh = MODl + (size_t)(r * 6 + 3) * DM; const float* sc = MODl + (size_t)(r * 6 + 4) * DM;
                float rs[4];
#pragma unroll
                for (int tk = 0; tk < 4; ++tk) { float ss = 0.f;
#pragma unroll 4
                    for (int i = 0; i < 8; ++i) { const float4 t4 = *(const float4*)(xr + (size_t)tk * DM + i * 256 + lane * 4); ss += t4.x * t4.x + t4.y * t4.y + t4.z * t4.z + t4.w * t4.w; }
                    ss = wave_sum(ss); rs[tk] = rsqrtf(ss * (1.0f / DM) + 1e-6f); }
                float lg[4][16];
#pragma unroll
                for (int tk = 0; tk < 4; ++tk)
#pragma unroll
                    for (int e = 0; e < 16; ++e) lg[tk][e] = 0.f;
#pragma unroll 1
                for (int i = 0; i < 8; ++i) { const int d = i * 256 + lane * 4;
                    const float4 g4 = *(const float4*)(gn + d), s4 = *(const float4*)(sc + d), h4 = *(const float4*)(sh + d);
                    float4 xq[4], ww[16];
#pragma unroll
                    for (int tk = 0; tk < 4; ++tk) xq[tk] = *(const float4*)(xr + (size_t)tk * DM + d);
                    const float4* wq = (const float4*)(wl + (size_t)(i * 64 + lane) * 68);
#pragma unroll
                    for (int q = 0; q < 16; ++q) ww[q] = wq[q];
                    float hv[4][4];
#pragma unroll
                    for (int tk = 0; tk < 4; ++tk) { const float4 xv = xq[tk]; const float rr = rs[tk];
                        hv[tk][0] = xv.x * rr * g4.x * (1.f + s4.x) + h4.x; hv[tk][1] = xv.y * rr * g4.y * (1.f + s4.y) + h4.y; hv[tk][2] = xv.z * rr * g4.z * (1.f + s4.z) + h4.z; hv[tk][3] = xv.w * rr * g4.w * (1.f + s4.w) + h4.w;
                        u32x2 w; w.x = pk2(hv[tk][0], hv[tk][1]); w.y = pk2(hv[tk][2], hv[tk][3]); *(u32x2*)(HB + (size_t)(tok0 + tk) * DM + d) = w; }
#pragma unroll
                    for (int q = 0; q < 4; ++q) { const float4 w0 = ww[q * 4 + 0], w1 = ww[q * 4 + 1], w2 = ww[q * 4 + 2], w3 = ww[q * 4 + 3];
#pragma unroll
                        for (int tk = 0; tk < 4; ++tk) { const float hq = hv[tk][q];
                            lg[tk][0] += hq * w0.x; lg[tk][1] += hq * w0.y; lg[tk][2] += hq * w0.z; lg[tk][3] += hq * w0.w; lg[tk][4] += hq * w1.x; lg[tk][5] += hq * w1.y; lg[tk][6] += hq * w1.z; lg[tk][7] += hq * w1.w;
                            lg[tk][8] += hq * w2.x; lg[tk][9] += hq * w2.y; lg[tk][10] += hq * w2.z; lg[tk][11] += hq * w2.w; lg[tk][12] += hq * w3.x; lg[tk][13] += hq * w3.y; lg[tk][14] += hq * w3.z; lg[tk][15] += hq * w3.w; } } }
#pragma unroll
                for (int tk = 0; tk < 4; ++tk) { float mx = -1e30f;
#pragma unroll
                    for (int e = 0; e < 16; ++e) { lg[tk][e] = wave_sum(lg[tk][e]); mx = fmaxf(mx, lg[tk][e]); }
                    float sm = 0.f;
#pragma unroll
                    for (int e = 0; e < 16; ++e) { lg[tk][e] = expf(lg[tk][e] - mx); sm += lg[tk][e]; }
                    const float inv = 1.0f / sm;
                    if (lane == 0) {
#pragma unroll
                        for (int e = 0; e < 16; e += 4) *(float4*)(PROBS + (size_t)(tok0 + tk) * 16 + e) = make_float4(lg[tk][e] * inv, lg[tk][e + 1] * inv, lg[tk][e + 2] * inv, lg[tk][e + 3] * inv); } }
            }
            SEAM(PB + 9);
        }
        if (IN(PB + 10)) for (int rep_ = 0; rep_ < PROBE_REPS(10); ++rep_) {
            PH_BEGIN
            const int nitems = 64 + (lastl ? 0 : 64);
            unsigned long long* keys = (unsigned long long*)shm;
            for (int it = bid; it < nitems; it += G) {
                const int set = it >> 6, e = it & 15, b = (it >> 4) & 3;
                const int n = set ? CTXL : SEQ, cap = set ? 32 : 512, tokbase = set ? NLAT + b * CTXL : b * SEQ;
                __syncthreads();
                for (int i = tid; i < n; i += NTHR) keys[i] = ((unsigned long long)__float_as_uint(PROBS[(size_t)(tokbase + i) * 16 + e]) << 32) | (unsigned long long)(0xFFFFFFFFu - (unsigned)i);
                __syncthreads();
                for (int k = 2; k <= n; k <<= 1)
                    for (int j = k >> 1; j > 0; j >>= 1) {
                        for (int p = tid; p < (n >> 1); p += NTHR) { const int i = ((p & ~(j - 1)) << 1) | (p & (j - 1)); const int m = i | j;
                            const unsigned long long ka = keys[i], kb = keys[m]; const bool desc = ((i & k) == 0);
                            if ((ka < kb) == desc) { keys[i] = kb; keys[m] = ka; } }
                        __syncthreads();
                    }
                for (int r = tid; r < cap; r += NTHR) { const unsigned long long kk = keys[r]; const int row = e * MOE_PAD + (set ? 2048 + b * 32 + r : b * 512 + r);
                    const int tk_ = tokbase + (int)(0xFFFFFFFFu - (unsigned)(kk & 0xFFFFFFFFull)); ROWTOK[row] = tk_; ROWGATE[row] = __uint_as_float((unsigned)(kk >> 32)); INV[tk_ * 16 + e] = row; }
                for (int rb = 0; rb < cap; rb += 32) {
                    u32x4 t4[4][4];
#pragma unroll
                    for (int q = 0; q < 4; ++q) { const int r = rb + wave + 8 * q; const int tok = tokbase + (int)(0xFFFFFFFFu - (unsigned)(keys[r] & 0xFFFFFFFFull));
                        const u32x4* sp = (const u32x4*)(HB + (size_t)tok * DM);
#pragma unroll
                        for (int i = 0; i < 4; ++i) t4[q][i] = sp[i * 64 + lane]; }
#pragma unroll
                    for (int q = 0; q < 4; ++q) { const int r = rb + wave + 8 * q; const int row = e * MOE_PAD + (set ? 2048 + b * 32 + r : b * 512 + r);
                        u32x4* dp = (u32x4*)(XG + (size_t)row * DM);
#pragma unroll
                        for (int i = 0; i < 4; ++i) dp[i * 64 + lane] = t4[q][i]; } }
            }
            if (lastl && G > 64 && bid >= 64) {
                const int n_win = 32 * 55, n_br = 4 * 64, n_out = 32 * 8, n_glu = 16, n_gu = 16 * 2 * 192, n_d = 16 * 192;
                const int lo_d = n_win + n_br + n_out + n_glu + n_gu - 1536;
                CV_RUN(l, lo_d + bid - 64, G - 64, lo_d + 1536 + n_d);
            }
            if (!lastl && G > 128 && bid >= 128) {
                const int n_win = 32 * 55, n_br = 4 * 64, n_out = 32 * 8, n_glu = 16, n_gu = 16 * 2 * 192; (void)n_gu;
                CV_RUN(l + 1, bid - 128, G - 128, n_win); (void)n_br; (void)n_out; (void)n_glu;
            }
            {   const int pad0 = lastl ? 2048 : MOE_ROWS, npad = MOE_PAD - pad0;
                for (int R = bid * 8 + wave; R < NEXP * npad; R += G * 8) { const int e = R / npad, rr = pad0 + R % npad; u32x4* dp = (u32x4*)(XG + ((size_t)e * MOE_PAD + rr) * DM);
#pragma unroll
                    for (int i = 0; i < 4; ++i) dp[i * 64 + lane] = (u32x4){0u, 0u, 0u, 0u}; } }
            SEAM(PB + 10);
        }
        if (IN(PB + 12)) for (int rep_ = 0; rep_ < PROBE_REPS(12); ++rep_) {
            PH_BEGIN
            pg8::Gemm g{XG, WGU, DM, DM, DM}; pg8::SchedMoe S{lastl ? 8 : 9, 12, G, bid, DM, DM, 2 * DEXP}; pg8::EpiMoe1 E{HID};
            pg8::gemm_phase((LAS unsigned char*)shm, g, S, E);
            SEAM(PB + 12);
        }
        if (IN(PB + 13)) for (int rep_ = 0; rep_ < PROBE_REPS(13); ++rep_) {
            PH_BEGIN
            pg8::Gemm g{HID, WD, DEXP, DEXP, DEXP}; pg8::SchedMoe S{lastl ? 8 : 9, 8, G, bid, DEXP, DEXP, DM}; pg8::EpiMoeY E{YEXP};
            pg8::gemm_phase((LAS unsigned char*)shm, g, S, E);
            SEAM(PB + 13);
        }

}

__global__ __launch_bounds__(NTHR, 2) void fwd(Args a) {
    extern __shared__ __attribute__((aligned(16))) unsigned char shm[];
    const int bid = blockIdx.x, G = gridDim.x;
    float* const sf = (float*)shm;
    volatile LAS unsigned* xbw = (volatile LAS unsigned*)((LAS unsigned char*)shm + (LDS_BYTES - 16));
    if (threadIdx.x == 0) { xbw[0] = 0u; xbw[1] = 0u; xbw[2] = 0u; xbw[3] = 0u; }
    const float** const ptab = (const float**)(shm + (LDS_BYTES - 16 - 512));
    if (threadIdx.x == 0) {
#pragma unroll
        for (int i = 0; i < 47; ++i) ptab[i] = a.in[i]; }
    __syncthreads();
    XcdBarrier bar = xcd_barrier_post((unsigned*)(a.ws + O_BAR), xbw);
    const int lo = a.ph_lo, hi = a.ph_hi;
    if (IN(0)) {
        PH_BEGIN
        {
            __syncthreads();
            for (int i = tid; i < 5 * DM; i += NTHR) { const int r = i >> 11, k = i & (DM - 1); const float v = r < 4 ? c_in[r * DM + k] : cctx_in[k]; sf[i] = siluf_(v); }
            __syncthreads();
            float* red = sf + 5 * DM;
            for (int unit = bid; unit < 2 * 96; unit += G) { const int l = unit / 96, j = (unit % 96) * 128 + (tid & 127), kq = tid >> 7;
                const float* w = ada_w + (size_t)l * DM * (6 * DM) + (size_t)(kq * 512) * (6 * DM) + j; const float* sv = sf + kq * 512;
                float a0 = 0.f, a1 = 0.f, a2 = 0.f, a3 = 0.f, a4 = 0.f;
#pragma unroll 8
                for (int k = 0; k < 512; ++k) { const float wv = w[(size_t)k * (6 * DM)]; a0 += sv[k] * wv; a1 += sv[DM + k] * wv; a2 += sv[2 * DM + k] * wv; a3 += sv[3 * DM + k] * wv; a4 += sv[4 * DM + k] * wv; }
                __syncthreads();
                { float* rp = red + (kq * 5) * 128 + (tid & 127); rp[0] = a0; rp[128] = a1; rp[256] = a2; rp[384] = a3; rp[512] = a4; }
                __syncthreads();
                if (tid < 128) { const float bb = ada_b[l * 6 * DM + j]; float* o = MOD + (size_t)l * 5 * 6 * DM + j;
#pragma unroll
                    for (int r = 0; r < 5; ++r) o[(size_t)r * 6 * DM] = ((red[(0 * 5 + r) * 128 + tid] + red[(1 * 5 + r) * 128 + tid]) + (red[(2 * 5 + r) * 128 + tid] + red[(3 * 5 + r) * 128 + tid])) + bb; }
            }
        }
    }

    layer_body<0>(a, bar, lo, hi, bid, G, shm, sf, ptab);
    layer_body<1>(a, bar, lo, hi, bid, G, shm, sf, ptab);
    if (IN(33)) {
        PH_BEGIN
        const float* gn = PT(46);
        for (int tok = bid * 8 + wave; tok < NLAT; tok += G * 8) {
            const float* xr = XS + (size_t)tok * DM; float4 v[8]; float ss = 0.f;
#pragma unroll
            for (int i = 0; i < 8; ++i) v[i] = *(const float4*)(xr + i * 256 + lane * 4);
            moe_combine(v, tok, lane, INV, ROWGATE, YEXP, MOD + (size_t)(1 * 5 + tok / SEQ) * 6 * DM + 5 * DM);
#pragma unroll
            for (int i = 0; i < 8; ++i) {                 ss += v[i].x * v[i].x + v[i].y * v[i].y + v[i].z * v[i].z + v[i].w * v[i].w; }
            ss = wave_sum(ss); const float rs = rsqrtf(ss * (1.0f / DM) + 1e-6f);
#pragma unroll
            for (int i = 0; i < 8; ++i) { const int d = i * 256 + lane * 4; const float4 g4 = *(const float4*)(gn + d);
                *(float4*)(a.out + (size_t)tok * DM + d) = make_float4(v[i].x * rs * g4.x, v[i].y * rs * g4.y, v[i].z * rs * g4.z, v[i].w * rs * g4.w); }
        }
    }
#undef IN
#undef SEAM
}


extern "C" void kernel_launch(void* const* d_in, const int* in_sizes, int n_in, void* d_out, int out_size, void* d_ws, size_t ws_size, hipStream_t stream) {
    static int grid = 0;
    if (grid == 0) {
        if (n_in != 47 || ws_size < WS_END) { fprintf(stderr, "kernel_launch: expected 47 inputs and >= %zu bytes of workspace; got %d, %zu\n", (size_t)WS_END, n_in, ws_size); grid = -1; return; }
        int dev = 0, cus = 0;
        if (hipGetDevice(&dev) != hipSuccess || hipDeviceGetAttribute(&cus, hipDeviceAttributeMultiprocessorCount, dev) != hipSuccess) { grid = -1; return; }
        if (hipFuncSetAttribute((const void*)fwd, hipFuncAttributeMaxDynamicSharedMemorySize, LDS_BYTES) != hipSuccess) { fprintf(stderr, "kernel_launch: hipFuncSetAttribute failed\n"); grid = -1; return; }
        int per_cu = 0;
        if (hipOccupancyMaxActiveBlocksPerMultiprocessor(&per_cu, (const void*)fwd, NTHR, LDS_BYTES) != hipSuccess || per_cu < 1) fprintf(stderr, "kernel_launch: occupancy query reports %d\n", per_cu);
        (void)hipGetLastError();
        grid = cus > 256 ? 256 : cus;
        if (grid < 224) { fprintf(stderr, "kernel_launch: needs >= 224 CUs (got %d)\n", grid); grid = -1; return; }
    }
    if (grid < 0) return;
    (void)hipMemsetAsync((char*)d_ws, 0, O_ZERO_END, stream);
    Args a{};
    for (int i = 0; i < 47; ++i) a.in[i] = (const float*)d_in[i];
    a.out = (float*)d_out; a.ws = (unsigned char*)d_ws;
#if MK_ONE_LAUNCH
    a.ph_lo = 0; a.ph_hi = 64;
    hipLaunchKernelGGL(fwd, dim3(grid), dim3(NTHR), LDS_BYTES, stream, a);
#else
    const int ids[] = {0, 1,2,3,4,5,6,7,8,9,10,11,12,13,14, 17,18,19,20,21,22,23,24,25,26,27,28,29,30, 33};
    for (int k = 0; k < (int)(sizeof(ids) / sizeof(ids[0])); ++k) { a.ph_lo = ids[k]; a.ph_hi = ids[k] + 1; hipLaunchKernelGGL(fwd, dim3(grid), dim3(NTHR), LDS_BYTES, stream, a); }
#endif
}
```
